# Optimizing an MI355X kernel written in HIP

```python
import math
import jax
import jax.numpy as jnp
from jax import lax
import numpy as np

D_MODEL = 1024
BATCH = 4
SEQ = 8192
DEPTH = 2

HEAD_DIM = 64
MIX_WIDTH = D_MODEL // 4
N_BRANCH = 4
Q_BLOCK = 128

LRU_WIDTH = MIX_WIDTH
LRU_BLOCKS = 4
LRU_BLOCK = LRU_WIDTH // LRU_BLOCKS
CONV_WIDTH = 4
LRU_C = 8.0
LRU_A_MIN = 0.9
LRU_A_MAX = 0.999

SWA_HEADS = MIX_WIDTH // HEAD_DIM
SWA_KV_HEADS = 2
SWA_WINDOW = 128

DIFF_HEADS = 4
DIFF_DIM = MIX_WIDTH // (2 * DIFF_HEADS)
DIFF_SUBLN_EPS = 1e-5

NSA_HEADS = MIX_WIDTH // HEAD_DIM
NSA_CMP_LEN = 32
NSA_CMP_STRIDE = 16
NSA_SLC_LEN = 64
NSA_TOPK = 16
NSA_WINDOW = 512
NSA_FORCED_SCORE = 1e4

REL_BUCKETS = 32
REL_MAX_DIST = 128
N_BIAS_HEADS = SWA_HEADS + DIFF_HEADS + NSA_HEADS

N_GROUPS = 4
EXPERTS_PER_GROUP = 8
N_EXPERTS = N_GROUPS * EXPERTS_PER_GROUP
TOPK_IN_GROUP = 2
EXPERT_FF = D_MODEL // 4
ROUTER_BIAS_SCALE = 0.01

NORM_EPS = 1e-6
NEG_INF = -1e30
TINY = 1e-30

IN_SPLITS = (
    LRU_WIDTH, LRU_WIDTH,
    SWA_HEADS * HEAD_DIM, SWA_KV_HEADS * HEAD_DIM, SWA_KV_HEADS * HEAD_DIM,
    2 * DIFF_HEADS * DIFF_DIM, 2 * DIFF_HEADS * DIFF_DIM, 2 * DIFF_HEADS * DIFF_DIM,
    NSA_HEADS * HEAD_DIM,
    HEAD_DIM, HEAD_DIM, HEAD_DIM, HEAD_DIM, HEAD_DIM, HEAD_DIM,
    3 * NSA_HEADS,
)
N_IN = sum(IN_SPLITS)

kernel_name = 'hybrid_griffin_gated_nsa_diff_moe'


def rmsnorm(x, g, eps=NORM_EPS):
    xf = x.astype(jnp.float32)
    y = xf * lax.rsqrt(jnp.mean(xf * xf, axis=-1, keepdims=True) + eps)
    return (y * g.astype(jnp.float32)).astype(x.dtype)


def t5_bucket(dist):
    n = jnp.maximum(dist, 0)
    exact = REL_BUCKETS // 2
    scaled = jnp.log(jnp.maximum(n, 1).astype(jnp.float32) / exact) / math.log(REL_MAX_DIST / exact)
    large = jnp.minimum(exact + (scaled * (REL_BUCKETS - exact)).astype(jnp.int32), REL_BUCKETS - 1)
    return jnp.where(n < exact, n, large)


def masked_softmax(s, mask, sink=None):
    s = jnp.where(mask, s, NEG_INF)
    m = jnp.max(s, axis=-1, keepdims=True)
    if sink is not None:
        m = jnp.maximum(m, sink)
    p = jnp.where(mask, jnp.exp(s - m), 0.0)
    denom = jnp.sum(p, axis=-1, keepdims=True)
    if sink is not None:
        denom = denom + jnp.exp(sink - m)
    return p / jnp.maximum(denom, TINY)


def split_columns(proj):
    offs = np.cumsum(IN_SPLITS)[:-1].tolist()
    return jnp.split(proj, offs, axis=-1)


def rglru_mixer(xa, gate, conv_w, conv_b, w_a, b_a, w_x, b_x, lam):
    f32 = jnp.float32
    Bsz, S, W = xa.shape
    xp = jnp.pad(xa.astype(f32), ((0, 0), (CONV_WIDTH - 1, 0), (0, 0)))
    xc = conv_b.astype(f32) + xp[:, 0:S] * conv_w[0].astype(f32)
    for i in range(1, CONV_WIDTH):
        xc = xc + xp[:, i:i + S] * conv_w[i].astype(f32)
    xb = xc.reshape(Bsz, S, LRU_BLOCKS, LRU_BLOCK)
    r = jax.nn.sigmoid(jnp.einsum('bshi,hij->bshj', xb, w_a.astype(f32)).reshape(Bsz, S, W) + b_a.astype(f32))
    i_g = jax.nn.sigmoid(jnp.einsum('bshi,hij->bshj', xb, w_x.astype(f32)).reshape(Bsz, S, W) + b_x.astype(f32))
    log_a = -LRU_C * r * jax.nn.softplus(-lam.astype(f32))
    a = jnp.exp(log_a)
    mult = jnp.sqrt(-jnp.expm1(2.0 * log_a))
    mult = jnp.where(jnp.arange(S)[None, :, None] == 0, 1.0, mult)
    b = mult * i_g * xc

    def combine(e, l):
        return (e[0] * l[0], l[0] * e[1] + l[1])

    _, hs = lax.associative_scan(combine, (a, b), axis=1)
    return (hs * jax.nn.gelu(gate.astype(f32))).astype(xa.dtype)


def banded_attention(q, k, v, window, bias_tab, sinks=None):
    f32 = jnp.float32
    Bsz, S, Hq, dh = q.shape
    Hkv = k.shape[2]
    G = Hq // Hkv
    nb = S // Q_BLOCK
    nback = -(-window // Q_BLOCK)
    kw_len = (nback + 1) * Q_BLOCK

    def windows(t):
        tp = jnp.pad(t.astype(f32), ((0, 0), (nback * Q_BLOCK, 0), (0, 0), (0, 0)))
        tp = tp.reshape(Bsz, nb + nback, Q_BLOCK, Hkv, dh)
        return jnp.concatenate([tp[:, i:i + nb] for i in range(nback + 1)], axis=2)

    kb, vb = windows(k), windows(v)
    qb = q.astype(f32).reshape(Bsz, nb, Q_BLOCK, Hkv, G, dh)
    s = jnp.einsum('bnqhgd,bnkhd->bnhgqk', qb, kb) * dh ** -0.5
    dist = jnp.arange(Q_BLOCK)[:, None] - jnp.arange(kw_len)[None, :] + nback * Q_BLOCK
    kpos = (jnp.arange(nb)[:, None, None] - nback) * Q_BLOCK + jnp.arange(kw_len)[None, None, :]
    mask = (dist >= 0) & (dist < window) & (kpos >= 0)
    bias = jnp.transpose(bias_tab[t5_bucket(dist)], (2, 0, 1)).reshape(Hkv, G, Q_BLOCK, kw_len)
    sink = None if sinks is None else sinks.astype(f32).reshape(1, 1, Hkv, G, 1, 1)
    p = masked_softmax(s + bias, mask[None, :, None, None], sink)
    o = jnp.einsum('bnhgqk,bnkhd->bnqhgd', p, vb)
    return o.reshape(Bsz, S, Hq * dh).astype(q.dtype)


def diff_lambda_init(layer):
    return 0.8 - 0.6 * math.exp(-0.3 * layer)


def diff_attention(q, k, v, lq1, lk1, lq2, lk2, subln_g, lambda_init, bias_tab):
    f32 = jnp.float32
    Bsz, S, H, _, d = q.shape
    nb = S // Q_BLOCK
    lam = (jnp.exp(jnp.sum(lq1.astype(f32) * lk1.astype(f32)))
           - jnp.exp(jnp.sum(lq2.astype(f32) * lk2.astype(f32))) + lambda_init)
    kf = k.astype(f32)
    vf = v.astype(f32)
    qb = jnp.moveaxis(q.astype(f32).reshape(Bsz, nb, Q_BLOCK, H, 2, d), 1, 0)
    kpos = jnp.arange(S)

    def one_block(args):
        q_blk, n = args
        qpos = n * Q_BLOCK + jnp.arange(Q_BLOCK)
        dist = qpos[:, None] - kpos[None, :]
        bias = jnp.transpose(bias_tab[t5_bucket(dist)], (2, 0, 1))[None, :, None]
        s = jnp.einsum('bqhmd,bkhmd->bhmqk', q_blk, kf) * d ** -0.5 + bias
        p = masked_softmax(s, dist >= 0)
        attn = p[:, :, 0] - lam * p[:, :, 1]
        return jnp.einsum('bhqk,bkhe->bqhe', attn, vf)

    o = lax.map(one_block, (qb, jnp.arange(nb)))
    o = jnp.moveaxis(o, 0, 1).reshape(Bsz, S, H, 2 * d)
    o = rmsnorm(o, subln_g, DIFF_SUBLN_EPS) * (1.0 - lambda_init)
    return o.reshape(Bsz, S, H * 2 * d).astype(q.dtype)


def nsa_compress(t, pos_emb, w1, w2, cmp_idx):
    f32 = jnp.float32
    blocks = t.astype(f32)[:, cmp_idx] + pos_emb.astype(f32)
    flat = blocks.reshape(t.shape[0], cmp_idx.shape[0], -1)
    return jax.nn.gelu(flat @ w1.astype(f32)) @ w2.astype(f32)


def nsa_selection_aggregator(n_cmp, n_slc):
    ratio_s = NSA_SLC_LEN // NSA_CMP_STRIDE
    ratio_c = NSA_CMP_LEN // NSA_CMP_STRIDE
    w = np.convolve(np.ones(ratio_s), np.ones(ratio_c)).astype(np.float32)
    cj = np.arange(n_slc)[:, None] * ratio_s - (ratio_c - 1) + np.arange(w.size)[None, :]
    jj = np.broadcast_to(np.arange(n_slc)[:, None], cj.shape)
    ww = np.broadcast_to(w[None, :], cj.shape)
    keep = (cj >= 0) & (cj < n_cmp)
    agg = np.zeros((n_cmp, n_slc), np.float32)
    np.add.at(agg, (cj[keep], jj[keep]), ww[keep])
    return jnp.asarray(agg)


def nsa_attention(q, k_cmp, v_cmp, k_slc, v_slc, k_win, v_win, gates,
                  pos_k, w1_k, w2_k, pos_v, w1_v, w2_v, bias_tab):
    f32 = jnp.float32
    Bsz, S, H, dh = q.shape
    nb = S // Q_BLOCK
    n_cmp = (S - NSA_CMP_LEN) // NSA_CMP_STRIDE + 1
    n_slc = S // NSA_SLC_LEN
    top_n = min(NSA_TOPK, n_slc)
    cmp_idx = jnp.asarray(np.arange(n_cmp)[:, None] * NSA_CMP_STRIDE + np.arange(NSA_CMP_LEN)[None, :])
    kc = nsa_compress(k_cmp, pos_k, w1_k, w2_k, cmp_idx)
    vc = nsa_compress(v_cmp, pos_v, w1_v, w2_v, cmp_idx)
    cmp_end = jnp.arange(n_cmp) * NSA_CMP_STRIDE + NSA_CMP_LEN - 1
    agg = nsa_selection_aggregator(n_cmp, n_slc)
    slc_ids = jnp.arange(n_slc)
    slc_start = slc_ids * NSA_SLC_LEN
    ks = k_slc.astype(f32)
    vs = v_slc.astype(f32)
    scale = dh ** -0.5
    qb = jnp.moveaxis(q.astype(f32).reshape(Bsz, nb, Q_BLOCK, H, dh), 1, 0)

    def one_block(args):
        q_blk, n = args
        qpos = n * Q_BLOCK + jnp.arange(Q_BLOCK)
        dist_c = qpos[:, None] - cmp_end[None, :]
        bias_c = jnp.transpose(bias_tab[t5_bucket(dist_c)], (2, 0, 1))
        s_c = jnp.einsum('bqhd,bcd->bhqc', q_blk, kc) * scale + bias_c
        p_c = masked_softmax(s_c, dist_c >= 0)
        o_c = jnp.einsum('bhqc,bcd->bqhd', p_c, vc)
        imp = jnp.einsum('bhqc,cj->bqj', p_c, agg)
        cur = qpos // NSA_SLC_LEN
        valid = slc_start[None, :] <= qpos[:, None]
        forced = ((slc_ids[None, :] == 0) | (slc_ids[None, :] == cur[:, None])
                  | (slc_ids[None, :] == cur[:, None] - 1))
        imp = jnp.where(forced, NSA_FORCED_SCORE, jnp.where(valid, imp, -1.0))
        _, sel = lax.top_k(imp, top_n)
        kpos = (sel[..., None] * NSA_SLC_LEN + jnp.arange(NSA_SLC_LEN)).reshape(Bsz, Q_BLOCK, top_n * NSA_SLC_LEN)
        kg = jax.vmap(lambda kk, pp: kk[pp])(ks, kpos)
        vg = jax.vmap(lambda vv, pp: vv[pp])(vs, kpos)
        dist_s = qpos[None, :, None] - kpos
        bias_s = jnp.moveaxis(bias_tab[t5_bucket(dist_s)], -1, 1)
        s_s = jnp.einsum('bqhd,bqkd->bhqk', q_blk, kg) * scale + bias_s
        p_s = masked_softmax(s_s, (dist_s >= 0)[:, None])
        o_s = jnp.einsum('bhqk,bqkd->bqhd', p_s, vg)
        return o_c, o_s

    o_c, o_s = lax.map(one_block, (qb, jnp.arange(nb)))
    o_c = jnp.moveaxis(o_c, 0, 1).reshape(Bsz, S, H, dh)
    o_s = jnp.moveaxis(o_s, 0, 1).reshape(Bsz, S, H, dh)
    o_w = banded_attention(q, k_win[:, :, None], v_win[:, :, None], NSA_WINDOW, bias_tab)
    o_w = o_w.astype(f32).reshape(Bsz, S, H, dh)
    g = jax.nn.sigmoid(gates.astype(f32))
    o = g[..., 0:1] * o_c + g[..., 1:2] * o_s + g[..., 2:3] * o_w
    return o.reshape(Bsz, S, H * dh).astype(q.dtype)


def hier_moe(h, w_grp, b_grp, w_exp, b_exp, w_g, w_u, w_d):
    f32 = jnp.float32
    Bsz, S, D = h.shape
    t = h.reshape(-1, D)
    T = t.shape[0]
    grp_logits = (t @ w_grp).astype(f32) + b_grp.astype(f32)
    grp_prob = jax.nn.softmax(grp_logits, axis=-1)
    _, g_sel = lax.top_k(grp_logits, 1)
    g_w = jnp.take_along_axis(grp_prob, g_sel, axis=-1)
    exp_logits = ((t @ w_exp).astype(f32) + b_exp.astype(f32)).reshape(T, N_GROUPS, EXPERTS_PER_GROUP)
    in_grp = jnp.take_along_axis(exp_logits, g_sel[:, :, None], axis=1)[:, 0]
    top_v, top_i = lax.top_k(in_grp, TOPK_IN_GROUP)
    top_w = jax.nn.softmax(top_v, axis=-1) * g_w
    eid = g_sel * EXPERTS_PER_GROUP + top_i
    combine = jnp.sum(jax.nn.one_hot(eid, N_EXPERTS, dtype=f32) * top_w[..., None], axis=1)
    y = jnp.zeros((T, D), f32)
    for e in range(N_EXPERTS):
        he = jax.nn.silu(t @ w_g[e]) * (t @ w_u[e])
        y = y + combine[:, e:e + 1] * (he @ w_d[e]).astype(f32)
    return y.reshape(Bsz, S, D).astype(h.dtype)


def setup_inputs(seed: int = 0) -> dict:
    key = jax.random.key(seed)
    ks = iter(jax.random.split(key, 64))
    f32 = jnp.float32
    L = DEPTH

    def nrm(shape, scale):
        return jax.random.normal(next(ks), shape, f32) * scale

    def gain(shape):
        return 1.0 + nrm(shape, 0.02)

    x = nrm((BATCH, SEQ, D_MODEL), 1.0)
    u = jax.random.uniform(next(ks), (L, LRU_WIDTH), f32, LRU_A_MIN, LRU_A_MAX)
    a0 = u ** (1.0 / LRU_C)
    lru_lambda = jnp.log(a0) - jnp.log1p(-a0)
    flat_cmp = NSA_CMP_LEN * HEAD_DIM
    return {
        'x': x,
        'rel_bias': nrm((REL_BUCKETS, N_BIAS_HEADS), 0.5),
        'final_norm_g': gain((D_MODEL,)),
        'mix_norm_g': gain((L, D_MODEL)),
        'w_in': nrm((L, D_MODEL, N_IN), D_MODEL ** -0.5),
        'conv_w': nrm((L, CONV_WIDTH, LRU_WIDTH), CONV_WIDTH ** -0.5),
        'conv_b': nrm((L, LRU_WIDTH), 0.01),
        'lru_w_a': nrm((L, LRU_BLOCKS, LRU_BLOCK, LRU_BLOCK), LRU_BLOCK ** -0.5),
        'lru_b_a': nrm((L, LRU_WIDTH), 0.01),
        'lru_w_x': nrm((L, LRU_BLOCKS, LRU_BLOCK, LRU_BLOCK), LRU_BLOCK ** -0.5),
        'lru_b_x': nrm((L, LRU_WIDTH), 0.01),
        'lru_lambda': lru_lambda,
        'swa_sinks': nrm((L, SWA_HEADS), 0.5),
        'diff_lq1': nrm((L, DIFF_DIM), 0.1),
        'diff_lk1': nrm((L, DIFF_DIM), 0.1),
        'diff_lq2': nrm((L, DIFF_DIM), 0.1),
        'diff_lk2': nrm((L, DIFF_DIM), 0.1),
        'diff_subln_g': gain((L, 2 * DIFF_DIM)),
        'nsa_pos_k': nrm((L, NSA_CMP_LEN, HEAD_DIM), 0.02),
        'nsa_w1_k': nrm((L, flat_cmp, HEAD_DIM), flat_cmp ** -0.5),
        'nsa_w2_k': nrm((L, HEAD_DIM, HEAD_DIM), HEAD_DIM ** -0.5),
        'nsa_pos_v': nrm((L, NSA_CMP_LEN, HEAD_DIM), 0.02),
        'nsa_w1_v': nrm((L, flat_cmp, HEAD_DIM), flat_cmp ** -0.5),
        'nsa_w2_v': nrm((L, HEAD_DIM, HEAD_DIM), HEAD_DIM ** -0.5),
        'w_gate': nrm((L, N_BRANCH, D_MODEL, D_MODEL), D_MODEL ** -0.5),
        'b_gate': nrm((L, N_BRANCH, D_MODEL), 0.01),
        'w_branch': nrm((L, N_BRANCH, MIX_WIDTH, D_MODEL), MIX_WIDTH ** -0.5),
        'w_out': nrm((L, D_MODEL, D_MODEL), D_MODEL ** -0.5),
        'ffn_norm_g': gain((L, D_MODEL)),
        'w_router_grp': nrm((L, D_MODEL, N_GROUPS), D_MODEL ** -0.5),
        'b_router_grp': nrm((L, N_GROUPS), ROUTER_BIAS_SCALE),
        'w_router_exp': nrm((L, D_MODEL, N_EXPERTS), D_MODEL ** -0.5),
        'b_router_exp': nrm((L, N_EXPERTS), ROUTER_BIAS_SCALE),
        'w_exp_gate': nrm((L, N_EXPERTS, D_MODEL, EXPERT_FF), D_MODEL ** -0.5),
        'w_exp_up': nrm((L, N_EXPERTS, D_MODEL, EXPERT_FF), D_MODEL ** -0.5),
        'w_exp_down': nrm((L, N_EXPERTS, EXPERT_FF, D_MODEL), EXPERT_FF ** -0.5),
    }


def reference(x, rel_bias, final_norm_g, mix_norm_g, w_in, conv_w, conv_b, lru_w_a, lru_b_a,
              lru_w_x, lru_b_x, lru_lambda, swa_sinks, diff_lq1, diff_lk1, diff_lq2, diff_lk2,
              diff_subln_g, nsa_pos_k, nsa_w1_k, nsa_w2_k, nsa_pos_v, nsa_w1_v, nsa_w2_v,
              w_gate, b_gate, w_branch, w_out, ffn_norm_g, w_router_grp, b_router_grp,
              w_router_exp, b_router_exp, w_exp_gate, w_exp_up, w_exp_down):
    Bsz, S, _ = x.shape
    bias_f = rel_bias.astype(jnp.float32)
    bias_swa = bias_f[:, :SWA_HEADS]
    bias_diff = bias_f[:, SWA_HEADS:SWA_HEADS + DIFF_HEADS]
    bias_nsa = bias_f[:, SWA_HEADS + DIFF_HEADS:]
    for l in range(DEPTH):
        h = rmsnorm(x, mix_norm_g[l])
        (a_x, a_g, b_q, b_k, b_v, c_q, c_k, c_v, d_q,
         d_kc, d_vc, d_ks, d_vs, d_kw, d_vw, d_g) = split_columns(h @ w_in[l])
        y_a = rglru_mixer(a_x, a_g, conv_w[l], conv_b[l], lru_w_a[l], lru_b_a[l],
                          lru_w_x[l], lru_b_x[l], lru_lambda[l])
        y_b = banded_attention(b_q.reshape(Bsz, S, SWA_HEADS, HEAD_DIM),
                               b_k.reshape(Bsz, S, SWA_KV_HEADS, HEAD_DIM),
                               b_v.reshape(Bsz, S, SWA_KV_HEADS, HEAD_DIM),
                               SWA_WINDOW, bias_swa, swa_sinks[l])
        y_c = diff_attention(c_q.reshape(Bsz, S, DIFF_HEADS, 2, DIFF_DIM),
                             c_k.reshape(Bsz, S, DIFF_HEADS, 2, DIFF_DIM),
                             c_v.reshape(Bsz, S, DIFF_HEADS, 2 * DIFF_DIM),
                             diff_lq1[l], diff_lk1[l], diff_lq2[l], diff_lk2[l],
                             diff_subln_g[l], diff_lambda_init(l), bias_diff)
        y_d = nsa_attention(d_q.reshape(Bsz, S, NSA_HEADS, HEAD_DIM), d_kc, d_vc, d_ks, d_vs,
                            d_kw, d_vw, d_g.reshape(Bsz, S, NSA_HEADS, 3),
                            nsa_pos_k[l], nsa_w1_k[l], nsa_w2_k[l],
                            nsa_pos_v[l], nsa_w1_v[l], nsa_w2_v[l], bias_nsa)
        ys = (y_a, y_b, y_c, y_d)
        merged = jnp.zeros_like(x)
        for br in range(N_BRANCH):
            gate = jax.nn.sigmoid(h @ w_gate[l, br] + b_gate[l, br])
            merged = merged + gate * (ys[br] @ w_branch[l, br])
        x = x + merged @ w_out[l]
        x = x + hier_moe(rmsnorm(x, ffn_norm_g[l]), w_router_grp[l], b_router_grp[l],
                         w_router_exp[l], b_router_exp[l], w_exp_gate[l], w_exp_up[l], w_exp_down[l])
    return rmsnorm(x, final_norm_g)
```

```cpp
#include <hip/hip_runtime.h>
#include <cstdio>
#include <cstdint>

#ifndef MK_ONE_LAUNCH
#define MK_ONE_LAUNCH 0
#endif

#define DI __device__ __forceinline__
#define GAS __attribute__((address_space(1)))
#define LAS __attribute__((address_space(3)))
typedef unsigned short bf16;
typedef short bf16x8 __attribute__((ext_vector_type(8)));
typedef float f32x4 __attribute__((ext_vector_type(4)));
typedef unsigned u32x4 __attribute__((ext_vector_type(4)));
typedef unsigned u32x2 __attribute__((ext_vector_type(2)));

constexpr int BATCH = 4, SEQ = 8192, T = BATCH * SEQ, D = 1024, DEPTH = 2;
constexpr int NIN = 2444, PLD = 2560, N1 = 6656, GLD = 4096;
constexpr int C_AX = 0, C_AG = 256, C_BQ = 512, C_BK = 768, C_BV = 896, C_CQ = 1024, C_CK = 1280, C_CV = 1536, C_DQ = 1792,
              C_KC = 2048, C_VC = 2112, C_KS = 2176, C_VS = 2240, C_KW = 2304, C_VW = 2368, C_DG = 2432;
constexpr int NCMP = 511;
constexpr int MOE_ROWS = 73728;
constexpr int NPH = 21;

constexpr size_t MiB = 1u << 20;
constexpr size_t WS_CTL = 0, CTL_ZERO_BYTES = 1 * MiB;
constexpr size_t WS_KCVC = 1 * MiB;
constexpr size_t WS_LRUSUM = 2 * MiB;
constexpr size_t WS_REC = 2 * MiB + 256 * 1024;
constexpr size_t WS_ROWTOK = 3 * MiB;
constexpr size_t WS_ROWW = 3 * MiB + 512 * 1024;
constexpr size_t WS_WIN = 4 * MiB;
constexpr size_t WS_WBR = 17 * MiB;
constexpr size_t WS_WOUT = 19 * MiB;
constexpr size_t WS_HB = 21 * MiB;
constexpr size_t WS_PROJ = 85 * MiB;
constexpr size_t WS_GATES = 245 * MiB;
constexpr size_t WS_WGU = 245 * MiB;
constexpr size_t WS_WD = 277 * MiB;
constexpr size_t WS_XS = 293 * MiB;
constexpr size_t WS_HMID = 437 * MiB;
constexpr size_t WS_END = 501 * MiB;
constexpr int CW_BAR = 4096;
constexpr int CW_CNT = 16384;

constexpr int RING_BYTES = 131072;
constexpr int MISC_OFF = RING_BYTES;
constexpr int BIAS_OFF = MISC_OFF + 256;
constexpr int OFFT_OFF = BIAS_OFF + 129 * 12 * 4;
constexpr int LDS_BYTES = 147456;
static_assert(OFFT_OFF + (40 + 288) * 4 <= LDS_BYTES, "LDS map");

DI float bf2f(bf16 v) { return __builtin_bit_cast(float, (unsigned)v << 16); }
DI float lo_bf(unsigned w) { return __builtin_bit_cast(float, w << 16); }
DI float hi_bf(unsigned w) { return __builtin_bit_cast(float, w & 0xffff0000u); }
DI unsigned f2bf(float f) { unsigned u = __builtin_bit_cast(unsigned, f); return (u + 0x7fffu + ((u >> 16) & 1u)) >> 16; }
DI unsigned pk2(float lo, float hi) { return f2bf(lo) | (f2bf(hi) << 16); }
DI float rl(float v, int i) { return __builtin_bit_cast(float, __builtin_amdgcn_readlane(__builtin_bit_cast(int, v), i)); }
DI int rli(int v, int i) { return __builtin_amdgcn_readlane(v, i); }
DI float wave_sum(float v) {
#pragma unroll
    for (int o = 1; o < 64; o <<= 1) v += __shfl_xor(v, o);
    return v;
}
DI float wave_max(float v) {
#pragma unroll
    for (int o = 1; o < 64; o <<= 1) v = fmaxf(v, __shfl_xor(v, o));
    return v;
}
DI float sigmoidf_(float x) { return 1.f / (1.f + __expf(-x)); }
DI float gelu_tanh(float x) { const float u = 0.7978845608028654f * (x + 0.044715f * x * x * x); const float e = __expf(2.f * u); const float th = 1.f - 2.f / (e + 1.f); return 0.5f * x * (1.f + th); }
DI float softplusf_(float x) { return fmaxf(x, 0.f) + log1pf(__expf(-fabsf(x))); }
#define LDS_WAIT() asm volatile("s_waitcnt lgkmcnt(0)" ::: "memory")
#define VM_WAIT() asm volatile("s_waitcnt vmcnt(0)" ::: "memory")

__device__ const unsigned char T5_BUCKET[128] = {
0,1,2,3,4,5,6,7,8,9,10,11,12,13,14,15,16,16,16,17,17,18,18,18,19,19,19,20,20,20,20,21,21,21,21,22,22,22,22,22,23,23,23,23,23,23,24,24,24,24,24,24,25,25,25,25,25,25,25,26,26,26,26,26,26,26,26,27,27,27,27,27,27,27,27,27,27,28,28,28,28,28,28,28,28,28,28,29,29,29,29,29,29,29,29,29,29,29,29,30,30,30,30,30,30,30,30,30,30,30,30,30,30,31,31,31,31,31,31,31,31,31,31,31,31,31,31,31};

#define XB_TMO      128
#define XB_XCNT(j)  (256  + 64 * (j))
#define XB_XSUB(j)  (1280 + 64 * (j))
#define XB_XGEN(j)  (2304 + 64 * (j))
#define XB_TOP      3328
#define XB_TOPGEN   3392
#define XCD_BAR_WORDS 3456
#define XB_SPIN_CAP (1u << 22)
DI unsigned xb_ld(unsigned* p)              { return __hip_atomic_load(p, __ATOMIC_RELAXED, __HIP_MEMORY_SCOPE_AGENT); }
DI unsigned xb_add(unsigned* p, unsigned v) { return __hip_atomic_fetch_add(p, v, __ATOMIC_RELAXED, __HIP_MEMORY_SCOPE_AGENT); }
DI unsigned xb_xcc_id() { return (unsigned)__builtin_amdgcn_s_getreg((3 << 11) | 20) & 0xFu; }
#define XB_SPIN(cond, bar) do { unsigned _sp = 0; while (cond) { __builtin_amdgcn_s_sleep(1); \
    if ((++_sp & 255u) == 0u) { if (xb_ld(&(bar)[XB_TMO])) break; if (_sp > XB_SPIN_CAP) { atomicAdd(&(bar)[XB_TMO], 1u); break; } } } } while (0)
struct XcdBarrier { unsigned* bar; unsigned x; volatile LAS unsigned* st; };
DI XcdBarrier xcd_barrier_post(unsigned* bar, volatile LAS unsigned* st) {
    XcdBarrier b; b.bar = bar; b.x = xb_xcc_id(); b.st = st;
    if (threadIdx.x == 0) (void)xb_add(&bar[XB_XCNT(b.x)], 1u);
    return b;
}
DI void xcd_barrier_complete(unsigned* bar, unsigned x, unsigned& nloc, unsigned& nx) {
    const unsigned G = gridDim.x * gridDim.y * gridDim.z;
    unsigned sum, cnt, mine, sp = 0u;
    for (;;) {
        sum = 0u; cnt = 0u; mine = 0u;
#pragma unroll
        for (unsigned j = 0; j < 16; ++j) { const unsigned c = xb_ld(&bar[XB_XCNT(j)]); sum += c; cnt += (c > 0u) ? 1u : 0u; mine = (j == x) ? c : mine; }
        if (sum == G) break;
        __builtin_amdgcn_s_sleep(1);
        if ((++sp & 255u) == 0u) { if (xb_ld(&bar[XB_TMO])) break; if (sp > XB_SPIN_CAP) { atomicAdd(&bar[XB_TMO], 1u); break; } }
    }
    nloc = mine > 0u ? mine : 1u; nx = cnt > 0u ? cnt : 1u;
}
DI void xcd_barrier(const XcdBarrier& b) {
    asm volatile("s_waitcnt vmcnt(0)" ::: "memory");
    __syncthreads();
    if (threadIdx.x == 0) {
        unsigned* bar = b.bar;
        __builtin_amdgcn_s_waitcnt(0);
        unsigned nloc = b.st[0], nx = b.st[1];
        if (nloc == 0u) { xcd_barrier_complete(bar, b.x, nloc, nx); b.st[0] = nloc; b.st[1] = nx; }
        const unsigned old = xb_add(&bar[XB_XSUB(b.x)], 1u);
        const unsigned gen = old / nloc;
        if (old + 1u == (gen + 1u) * nloc) {
            __builtin_amdgcn_fence(__ATOMIC_RELEASE, "agent");
            asm volatile("s_waitcnt vmcnt(0)" ::: "memory");
            const unsigned og = xb_add(&bar[XB_TOP], 1u);
            const unsigned tg = og / nx;
            if (og + 1u == (tg + 1u) * nx) xb_add(&bar[XB_TOPGEN], 1u);
            else XB_SPIN(xb_ld(&bar[XB_TOPGEN]) == tg, bar);
            __builtin_amdgcn_fence(__ATOMIC_ACQUIRE, "agent");
            xb_add(&bar[XB_XGEN(b.x)], 1u);
            asm volatile("s_waitcnt vmcnt(0)" ::: "memory");
        } else {
            XB_SPIN(xb_ld(&bar[XB_XGEN(b.x)]) == gen, bar);
            __builtin_amdgcn_fence(__ATOMIC_ACQUIRE, "agent");
            asm volatile("s_waitcnt vmcnt(0)" ::: "memory");
        }
    }
    __syncthreads();
}

namespace pg8 {
constexpr int BM = 256, BK = 64, HALF = 128, HTB = HALF * BK * 2;
__host__ __device__ __forceinline__ int lds_byte(int r, int c) { const int st = (r >> 4) * 2 + (c >> 5), rr = r & 15, cc = c & 31, ob = rr * 64 + cc * 2; return st * 1024 + (ob ^ (((ob >> 9) & 1) << 5)); }
__host__ __device__ __forceinline__ void stage_rc(int b, int& R, int& C) { const int st = b / 1024, sb = b % 1024, swz = sb ^ (((sb >> 9) & 1) << 5); R = (st >> 1) * 16 + swz / 64; C = (st & 1) * 32 + (swz % 64) / 2; }
__host__ __device__ __forceinline__ int perm32(int rho) { const int n = rho >> 4, i = rho & 15; return 8 * (i >> 2) + 4 * n + (i & 3); }
struct Unit { const char* a; const char* b; int pm, pn, aux, pad; };
struct Gemm { int K, lda, ldb; };
template <class Epi, class Sched>
DI void gemm_phase(LAS unsigned char* lds, const Gemm g, const Sched& S, const Epi& E) {
    int tid = threadIdx.x; asm volatile("" : "+v"(tid));
    const int wid = __builtin_amdgcn_readfirstlane(tid >> 6), lane = tid & 63, wr = wid >> 2, wc = wid & 3, fr = lane & 15, fq = lane >> 4;
    const int K = g.K, nt = K / BK;
    unsigned voffA[2], voffB[2];
#pragma unroll
    for (int i = 0; i < 2; ++i) { int R, C; stage_rc(tid * 16 + i * 8192, R, C); const int Rb = (R & ~31) + perm32(R & 31);
        voffA[i] = (unsigned)(R * g.lda + C) * 2u; voffB[i] = (unsigned)(Rb * g.ldb + C) * 2u; }
    const size_t kstep = (size_t)(BK * 2);
    const size_t hstepA = (size_t)HALF * g.lda * 2, hstepB = (size_t)HALF * g.ldb * 2;
    const unsigned ldsw = (unsigned)wid * 1024u;
    const int aoff = lds_byte(wr * 64 + fr, fq * 8), boff = lds_byte(wc * 32 + fr, fq * 8);
#define PG8_SA(b, h) (((b) * 2 + (h)) * HTB)
#define PG8_SB(b, h) ((4 + (b) * 2 + (h)) * HTB)
#define PG8_STAGE(bufoff, gbase, voff) do { _Pragma("unroll") for (int _i = 0; _i < 2; ++_i) \
        __builtin_amdgcn_global_load_lds((const unsigned*)((const char*)(gbase) + (voff)[_i]), (LAS unsigned*)(lds + (bufoff) + ldsw + _i * 8192), 16, 0, 0); } while (0)
#define PG8_LDA(dst, b, h) do { _Pragma("unroll") for (int m = 0; m < 4; ++m) _Pragma("unroll") for (int k = 0; k < 2; ++k) dst[m][k] = *(const LAS bf16x8*)(lds + PG8_SA(b, h) + aoff + m * 2048 + k * 1024); } while (0)
#define PG8_LDB(dst, b, h) do { _Pragma("unroll") for (int n = 0; n < 2; ++n) _Pragma("unroll") for (int k = 0; k < 2; ++k) dst[n][k] = *(const LAS bf16x8*)(lds + PG8_SB(b, h) + boff + n * 2048 + k * 1024); } while (0)
#define PG8_MMA(ai, bj, At, Bt) do { __builtin_amdgcn_s_setprio(1); _Pragma("unroll") for (int m = 0; m < 4; ++m) _Pragma("unroll") for (int n = 0; n < 2; ++n) _Pragma("unroll") for (int k = 0; k < 2; ++k) \
        acc[ai][bj][m][n] = __builtin_amdgcn_mfma_f32_16x16x32_bf16(Bt[n][k], At[m][k], acc[ai][bj][m][n], 0, 0, 0); __builtin_amdgcn_s_setprio(0); } while (0)
#define PG8_WAIT_V(n) asm volatile("s_waitcnt vmcnt(" #n ")" ::: "memory")
#define PG8_WAIT_L(n) asm volatile("s_waitcnt lgkmcnt(" #n ")" ::: "memory")
#define PG8_BAR __builtin_amdgcn_s_barrier()
#define PG8_SCHED __builtin_amdgcn_sched_barrier(0)
    Unit cur, nxt; int ui = 0;
    if (!S.next(0, cur)) return;
    f32x4 acc[2][2][4][2];
#pragma unroll
    for (int a = 0; a < 2; ++a)
#pragma unroll
        for (int b = 0; b < 2; ++b)
#pragma unroll
            for (int m = 0; m < 4; ++m)
#pragma unroll
                for (int n = 0; n < 2; ++n) acc[a][b][m][n] = (f32x4){0.f, 0.f, 0.f, 0.f};
    bf16x8 At[4][2], B0[2][2], B1[2][2];
    const char* cA = cur.a; const char* cB = cur.b;
    PG8_STAGE(PG8_SB(0, 0), cB, voffB); PG8_STAGE(PG8_SB(0, 1), cB + hstepB, voffB); PG8_STAGE(PG8_SA(0, 0), cA, voffA); PG8_STAGE(PG8_SA(0, 1), cA + hstepA, voffA);
    if (wr == 1) PG8_BAR;
    PG8_WAIT_V(2); PG8_BAR;
    PG8_STAGE(PG8_SB(1, 0), cB + kstep, voffB); PG8_STAGE(PG8_SA(1, 0), cA + kstep, voffA); PG8_STAGE(PG8_SB(1, 1), cB + hstepB + kstep, voffB);
    PG8_WAIT_V(6); PG8_BAR;
    for (;;) {
        const bool has_next = S.next(ui + 1, nxt);
        const char* nA = has_next ? nxt.a : cA; const char* nB = has_next ? nxt.b : cB;
        for (int t = 0; t < nt; t += 2) {
            const bool last = (t == nt - 2);
            const char* a1 = cA + (size_t)(t + 1) * kstep;
            const char* a2 = last ? nA : cA + (size_t)(t + 2) * kstep; const char* b2 = last ? nB : cB + (size_t)(t + 2) * kstep;
            const char* a3 = a2 + kstep; const char* b3 = b2 + kstep;
            PG8_LDB(B0, 0, 0); PG8_LDB(B1, 0, 1); PG8_SCHED; PG8_LDA(At, 0, 0); PG8_STAGE(PG8_SA(1, 1), a1 + hstepA, voffA);
            PG8_WAIT_V(8); PG8_WAIT_L(0); PG8_BAR; PG8_MMA(0, 0, At, B0); PG8_MMA(0, 1, At, B1); PG8_BAR; PG8_SCHED;
            PG8_LDA(At, 0, 1); PG8_STAGE(PG8_SB(0, 0), b2, voffB); PG8_STAGE(PG8_SB(0, 1), b2 + hstepB, voffB); PG8_STAGE(PG8_SA(0, 0), a2, voffA);
            PG8_WAIT_V(8); PG8_WAIT_L(0); PG8_BAR; PG8_MMA(1, 0, At, B0); PG8_MMA(1, 1, At, B1); PG8_BAR; PG8_SCHED;
            PG8_LDB(B0, 1, 0); PG8_LDB(B1, 1, 1); PG8_SCHED; PG8_LDA(At, 1, 0); PG8_STAGE(PG8_SA(0, 1), a2 + hstepA, voffA);
            PG8_WAIT_V(8); PG8_WAIT_L(0); PG8_BAR; PG8_MMA(0, 0, At, B0); PG8_MMA(0, 1, At, B1); PG8_BAR; PG8_SCHED;
            PG8_LDA(At, 1, 1); PG8_STAGE(PG8_SB(1, 0), b3, voffB); PG8_STAGE(PG8_SB(1, 1), b3 + hstepB, voffB); PG8_STAGE(PG8_SA(1, 0), a3, voffA);
            PG8_WAIT_V(8); PG8_WAIT_L(0); PG8_BAR; PG8_MMA(1, 0, At, B0); PG8_MMA(1, 1, At, B1); PG8_BAR; PG8_SCHED;
        }
        if (wr == 0) PG8_BAR;
        { int efr = fr, efq = fq; asm volatile("" : "+v"(efr), "+v"(efq)); E(acc, cur, wr, wc, efr, efq); }
        if (!has_next) break;
#pragma unroll
        for (int a = 0; a < 2; ++a)
#pragma unroll
            for (int b = 0; b < 2; ++b)
#pragma unroll
                for (int m = 0; m < 4; ++m)
#pragma unroll
                    for (int n = 0; n < 2; ++n) acc[a][b][m][n] = (f32x4){0.f, 0.f, 0.f, 0.f};
        cur = nxt; cA = nA; cB = nB; ++ui;
        if (wr == 1) PG8_BAR;
    }
    PG8_WAIT_V(0);
    PG8_BAR;
#undef PG8_SA
#undef PG8_SB
#undef PG8_STAGE
#undef PG8_LDA
#undef PG8_LDB
#undef PG8_MMA
#undef PG8_WAIT_V
#undef PG8_WAIT_L
#undef PG8_BAR
#undef PG8_SCHED
}
}
using pg8::Unit;

DI unsigned cvt_pk_bf16(float lo, float hi) { unsigned r; asm volatile("v_cvt_pk_bf16_f32 %0, %1, %2" : "=v"(r) : "v"(lo), "v"(hi)); return r; }
DI u32x4 pack8(const f32x4& v0, const f32x4& v1) { u32x4 w; w.x = cvt_pk_bf16(v0[0], v0[1]); w.y = cvt_pk_bf16(v0[2], v0[3]); w.z = cvt_pk_bf16(v1[0], v1[1]); w.w = cvt_pk_bf16(v1[2], v1[3]); return w; }

struct SchedP1 {
    const char* A; const char* B; int G, c;
    DI bool next(int i, Unit& u) const {
        constexpr int nM = 128, nN = 26, nwg = nM * nN, NXCD = 8, WGM = 8;
        const long L = (long)i * G + c; if (L >= nwg) return false;
        int wgid = (int)L; { const int q = nwg / NXCD, r = nwg % NXCD, xcd = wgid % NXCD, off = wgid / NXCD; wgid = (xcd < r ? xcd * (q + 1) : r * (q + 1) + (xcd - r) * q) + off; }
        const int nig = WGM * nN, gid = wgid / nig, fm = gid * WGM, gsz = (nM - fm) < WGM ? (nM - fm) : WGM;
        u.pm = fm + ((wgid % nig) % gsz); u.pn = (wgid % nig) / gsz; u.aux = 0; u.pad = 0;
        u.a = A + (size_t)u.pm * 256 * 1024 * 2; u.b = B + (size_t)u.pn * 256 * 1024 * 2; return true;
    }
};
struct SchedP3a {
    const char* ys; const char* wbr; int G, c;
    DI bool next(int i, Unit& u) const {
        const int tile = (i >> 2) * G + c; if (tile >= 512) return false;
        const int br = i & 3; u.pm = tile >> 2; u.pn = tile & 3; u.aux = br; u.pad = 0;
        u.a = ys + ((size_t)u.pm * 256 * 1024 + br * 256) * 2; u.b = wbr + ((size_t)br * 1024 * 256 + (size_t)u.pn * 256 * 256) * 2; return true;
    }
};
struct SchedP3b {
    const char* A; const char* B; int G, c;
    DI bool next(int i, Unit& u) const {
        const int L = i * G + c; if (L >= 512) return false;
        u.pm = L >> 2; u.pn = L & 3; u.aux = 0; u.pad = 0;
        u.a = A + (size_t)u.pm * 256 * 1024 * 2; u.b = B + (size_t)u.pn * 256 * 1024 * 2; return true;
    }
};
struct SchedM2 {
    const char* xs; const char* wgu; const LAS int* offt; int G, c;
    DI bool next(int i, Unit& u) const {
        const int NT = __builtin_amdgcn_readfirstlane(offt[32]) >> 8; const int L = i * G + c; if (L >= NT * 2) return false;
        const int rt = L >> 1, pn = L & 1; const int e = __builtin_amdgcn_readfirstlane(offt[40 + rt]);
        u.pm = rt; u.pn = pn; u.aux = e; u.pad = 0;
        u.a = xs + (size_t)rt * 256 * 1024 * 2; u.b = wgu + ((size_t)e * 512 + pn * 256) * 1024 * 2; return true;
    }
};
struct SchedM3 {
    const char* hmid; const char* wd; const LAS int* offt; int G, c;
    DI bool next(int i, Unit& u) const {
        const int NT = __builtin_amdgcn_readfirstlane(offt[32]) >> 8; const int L = i * G + c; if (L >= NT * 4) return false;
        const int rt = L >> 2, pn = L & 3; const int e = __builtin_amdgcn_readfirstlane(offt[40 + rt]);
        u.pm = rt; u.pn = pn; u.aux = e; u.pad = 0;
        u.a = hmid + (size_t)rt * 256 * 256 * 2; u.b = wd + ((size_t)e * 1024 + pn * 256) * 256 * 2; return true;
    }
};

struct EpiP1 {
    bf16* proj; bf16* gates; const float* bgate;
    DI void operator()(const f32x4 (&acc)[2][2][4][2], const Unit& u, int wr, int wc, int fr, int fq) const {
        const int row0 = u.pm * 256 + wr * 64 + fr; const int colt = u.pn * 256 + wc * 32 + 8 * fq;
        if (u.pn < 10) {
#pragma unroll
            for (int ai = 0; ai < 2; ++ai)
#pragma unroll
                for (int m = 0; m < 4; ++m) { bf16* rowp = proj + (size_t)(row0 + ai * 128 + m * 16) * PLD + colt;
#pragma unroll
                    for (int bj = 0; bj < 2; ++bj) *(u32x4*)(rowp + bj * 128) = pack8(acc[ai][bj][m][0], acc[ai][bj][m][1]); }
        } else {
            const int gcol = colt - 2560;
            f32x4 bv[2][2];
#pragma unroll
            for (int bj = 0; bj < 2; ++bj)
#pragma unroll
                for (int n = 0; n < 2; ++n) bv[bj][n] = *(const f32x4*)(bgate + gcol + bj * 128 + 4 * n);
#pragma unroll
            for (int ai = 0; ai < 2; ++ai)
#pragma unroll
                for (int m = 0; m < 4; ++m) { bf16* rowp = gates + (size_t)(row0 + ai * 128 + m * 16) * GLD + gcol;
#pragma unroll
                    for (int bj = 0; bj < 2; ++bj) { f32x4 v0 = acc[ai][bj][m][0] + bv[bj][0], v1 = acc[ai][bj][m][1] + bv[bj][1];
#pragma unroll
                        for (int e = 0; e < 4; ++e) { v0[e] = sigmoidf_(v0[e]); v1[e] = sigmoidf_(v1[e]); }
                        *(u32x4*)(rowp + bj * 128) = pack8(v0, v1); }
                    __builtin_amdgcn_sched_barrier(0); }
        }
    }
};
struct EpiP3a {
    bf16* merged; const bf16* gates;
    DI void operator()(const f32x4 (&acc)[2][2][4][2], const Unit& u, int wr, int wc, int fr, int fq) const {
        const int row0 = u.pm * 256 + wr * 64 + fr; const int colt = u.pn * 256 + wc * 32 + 8 * fq; const int br = u.aux;
#pragma unroll
        for (int ai = 0; ai < 2; ++ai)
#pragma unroll
            for (int m = 0; m < 4; ++m) { const size_t row = (size_t)(row0 + ai * 128 + m * 16);
#pragma unroll
                for (int bj = 0; bj < 2; ++bj) {
                    const u32x4 gw = *(const u32x4*)(gates + row * GLD + br * 1024 + colt + bj * 128);
                    bf16* mp = merged + row * 1024 + colt + bj * 128;
                    f32x4 v0 = acc[ai][bj][m][0], v1 = acc[ai][bj][m][1];
                    v0[0] *= lo_bf(gw.x); v0[1] *= hi_bf(gw.x); v0[2] *= lo_bf(gw.y); v0[3] *= hi_bf(gw.y);
                    v1[0] *= lo_bf(gw.z); v1[1] *= hi_bf(gw.z); v1[2] *= lo_bf(gw.w); v1[3] *= hi_bf(gw.w);
                    if (br != 0) { const u32x4 mw = *(const u32x4*)mp;
                        v0[0] += lo_bf(mw.x); v0[1] += hi_bf(mw.x); v0[2] += lo_bf(mw.y); v0[3] += hi_bf(mw.y);
                        v1[0] += lo_bf(mw.z); v1[1] += hi_bf(mw.z); v1[2] += lo_bf(mw.w); v1[3] += hi_bf(mw.w); }
                    *(u32x4*)mp = pack8(v0, v1); }
                __builtin_amdgcn_sched_barrier(0); }
    }
};
struct EpiP3b {
    const float* xin; float* out;
    DI void operator()(const f32x4 (&acc)[2][2][4][2], const Unit& u, int wr, int wc, int fr, int fq) const {
        const int row0 = u.pm * 256 + wr * 64 + fr; const int colt = u.pn * 256 + wc * 32 + 8 * fq;
#pragma unroll
        for (int ai = 0; ai < 2; ++ai)
#pragma unroll
            for (int m = 0; m < 4; ++m) { const size_t off = (size_t)(row0 + ai * 128 + m * 16) * 1024 + colt;
#pragma unroll
                for (int bj = 0; bj < 2; ++bj)
#pragma unroll
                    for (int n = 0; n < 2; ++n) { const f32x4 xv = *(const f32x4*)(xin + off + bj * 128 + 4 * n); *(f32x4*)(out + off + bj * 128 + 4 * n) = xv + acc[ai][bj][m][n]; }
                __builtin_amdgcn_sched_barrier(0); }
    }
};
struct EpiM2 {
    bf16* hmid;
    DI void operator()(const f32x4 (&acc)[2][2][4][2], const Unit& u, int wr, int wc, int fr, int fq) const {
        const int row0 = u.pm * 256 + wr * 64 + fr; const int col = u.pn * 128 + wc * 32 + 8 * fq;
#pragma unroll
        for (int ai = 0; ai < 2; ++ai)
#pragma unroll
            for (int m = 0; m < 4; ++m) { f32x4 h0, h1;
#pragma unroll
                for (int e = 0; e < 4; ++e) { const float g0 = acc[ai][0][m][0][e], g1 = acc[ai][0][m][1][e];
                    h0[e] = g0 * sigmoidf_(g0) * acc[ai][1][m][0][e]; h1[e] = g1 * sigmoidf_(g1) * acc[ai][1][m][1][e]; }
                *(u32x4*)(hmid + (size_t)(row0 + ai * 128 + m * 16) * 256 + col) = pack8(h0, h1); }
    }
};
struct EpiM3 {
    bf16* eo; const int* rowtok; const float* roww;
    DI void operator()(const f32x4 (&acc)[2][2][4][2], const Unit& u, int wr, int wc, int fr, int fq) const {
        const int row0 = u.pm * 256 + wr * 64 + fr; const int colt = u.pn * 256 + wc * 32 + 8 * fq;
#pragma unroll
        for (int ai = 0; ai < 2; ++ai)
#pragma unroll
            for (int m = 0; m < 4; ++m) { const int row = row0 + ai * 128 + m * 16; const int tk = rowtok[row];
                if (tk >= 0) { const float w = roww[row]; bf16* op = eo + (size_t)tk * 1024 + colt;
#pragma unroll
                    for (int bj = 0; bj < 2; ++bj) *(u32x4*)(op + bj * 128) = pack8(acc[ai][bj][m][0] * w, acc[ai][bj][m][1] * w); }
                __builtin_amdgcn_sched_barrier(0); }
    }
};

struct Args { const float* in[36]; float* out; unsigned char* ws; int ph_lo, ph_hi; };

DI void transpose_item(const float* W, int ldw, int nvalid, bf16* WT, int ldt, int k0, int n0, int dst_row0, LAS float* scr, int lane) {
    const bool nok = (n0 + (lane & 31)) < nvalid;
#pragma unroll 8
    for (int i = 0; i < 32; ++i) { const int kk = 2 * i + (lane >> 5); scr[kk * 33 + (lane & 31)] = nok ? W[(size_t)(k0 + kk) * ldw + n0 + (lane & 31)] : 0.f; }
    LDS_WAIT(); asm volatile("" ::: "memory");
    const int c = lane & 7;
#pragma unroll
    for (int j = 0; j < 4; ++j) { const int n = (lane >> 3) + 8 * j; const LAS float* s = scr + (8 * c) * 33 + n;
        u32x4 o; o.x = pk2(s[0 * 33], s[1 * 33]); o.y = pk2(s[2 * 33], s[3 * 33]); o.z = pk2(s[4 * 33], s[5 * 33]); o.w = pk2(s[6 * 33], s[7 * 33]);
        if (n0 + n < nvalid) *(u32x4*)(WT + (size_t)(dst_row0 + n) * ldt + k0 + 8 * c) = o; }
    LDS_WAIT(); asm volatile("" ::: "memory");
}
DI void phase0_weights(const Args& a, int l, LAS unsigned char* lds, int gw, int NGW, int wave, int lane) {
    LAS float* scr = (LAS float*)(lds + wave * 16384);
    const float* w_in = a.in[4] + (size_t)l * 1024 * NIN;
    const float* w_gate = a.in[24] + (size_t)l * 4 * 1024 * 1024;
    const float* w_br = a.in[26] + (size_t)l * 4 * 256 * 1024;
    const float* w_out = a.in[27] + (size_t)l * 1024 * 1024;
    bf16* Wt_in = (bf16*)(a.ws + WS_WIN); bf16* Wt_br = (bf16*)(a.ws + WS_WBR); bf16* Wt_out = (bf16*)(a.ws + WS_WOUT);
    constexpr int I_IN = 16 * 77, I_G = 4 * 16 * 32, I_B = 4 * 4 * 32, I_O = 16 * 32, NIT = I_IN + I_G + I_B + I_O;
    for (int it = gw; it < NIT; it += NGW) {
        int r = it;
        if (r < I_IN) { const int kb = r / 77, nb = r % 77; transpose_item(w_in, NIN, NIN, Wt_in, 1024, kb * 64, nb * 32, nb * 32, scr, lane); continue; } r -= I_IN;
        if (r < I_G) { const int br = r / 512, q = r % 512, kb = q / 32, nb = q % 32; transpose_item(w_gate + (size_t)br * 1024 * 1024, 1024, 1024, Wt_in, 1024, kb * 64, nb * 32, 2560 + br * 1024 + nb * 32, scr, lane); continue; } r -= I_G;
        if (r < I_B) { const int br = r / 128, q = r % 128, kb = q / 32, nb = q % 32; transpose_item(w_br + (size_t)br * 256 * 1024, 1024, 1024, Wt_br + (size_t)br * 1024 * 256, 256, kb * 64, nb * 32, nb * 32, scr, lane); continue; } r -= I_B;
        { const int kb = r / 32, nb = r % 32; transpose_item(w_out, 1024, 1024, Wt_out, 1024, kb * 64, nb * 32, nb * 32, scr, lane); }
    }
}
DI void phase0_rows(const Args& a, int l, int mode, int gw, int NGW, int lane) {
    const float* xin = (l == 0) ? a.in[0] : a.out;
    const bf16* eo = (const bf16*)(a.ws + WS_PROJ);
    bf16* hb = (bf16*)(a.ws + WS_HB);
    const float* g = mode ? a.in[2] : (a.in[3] + (size_t)l * 1024);
    for (int m = gw; m < T; m += NGW) {
        f32x4 v[4]; float ss = 0.f;
#pragma unroll
        for (int j = 0; j < 4; ++j) { v[j] = *(const f32x4*)(xin + (size_t)m * 1024 + 4 * (lane + 64 * j));
            if (l > 0) {
                const u32x2 e0 = *(const u32x2*)(eo + (size_t)(2 * m) * 1024 + 4 * (lane + 64 * j));
                const u32x2 e1 = *(const u32x2*)(eo + (size_t)(2 * m + 1) * 1024 + 4 * (lane + 64 * j));
                v[j][0] += lo_bf(e0.x) + lo_bf(e1.x); v[j][1] += hi_bf(e0.x) + hi_bf(e1.x); v[j][2] += lo_bf(e0.y) + lo_bf(e1.y); v[j][3] += hi_bf(e0.y) + hi_bf(e1.y);
            }
            ss += (v[j][0] * v[j][0] + v[j][1] * v[j][1]) + (v[j][2] * v[j][2] + v[j][3] * v[j][3]); }
        const float r = 1.f / sqrtf(wave_sum(ss) * (1.f / 1024.f) + 1e-6f);
#pragma unroll
        for (int j = 0; j < 4; ++j) { const f32x4 gv = *(const f32x4*)(g + 4 * (lane + 64 * j)); const f32x4 y = v[j] * r * gv;
            if (mode) *(f32x4*)(a.out + (size_t)m * 1024 + 4 * (lane + 64 * j)) = y;
            else { if (l > 0) *(f32x4*)(a.out + (size_t)m * 1024 + 4 * (lane + 64 * j)) = v[j];
                   u32x2 w; w.x = pk2(y[0], y[1]); w.y = pk2(y[2], y[3]); *(u32x2*)(hb + (size_t)m * 1024 + 4 * (lane + 64 * j)) = w; } }
    }
}

DI void lru_task(const Args& a, int l, const bf16* proj, bf16* ys, float* sums, int task, int lane, bool final) {
    const int chunk = task & 31, hbk = (task >> 5) & 3, b = task >> 7; const int c = hbk * 64 + lane;
    const float* w_a = a.in[7] + ((size_t)l * 4 + hbk) * 4096; const float* w_x = a.in[9] + ((size_t)l * 4 + hbk) * 4096;
    float wa[64], wx[64];
#pragma unroll
    for (int i = 0; i < 64; ++i) { wa[i] = w_a[i * 64 + lane]; wx[i] = w_x[i * 64 + lane]; }
    const float* cw = a.in[5] + (size_t)l * 4 * 256;
    const float cw0 = cw[c], cw1 = cw[256 + c], cw2 = cw[512 + c], cw3 = cw[768 + c];
    const float cb = a.in[6][l * 256 + c], ba = a.in[8][l * 256 + c], bx = a.in[10][l * 256 + c];
    const float c8 = -8.f * softplusf_(-a.in[11][l * 256 + c]);
    const int t0 = chunk * 256; const size_t rowb = (size_t)b * SEQ;
    float x3 = (t0 >= 3) ? bf2f(proj[(rowb + t0 - 3) * PLD + C_AX + c]) : 0.f;
    float x2 = (t0 >= 2) ? bf2f(proj[(rowb + t0 - 2) * PLD + C_AX + c]) : 0.f;
    float x1 = (t0 >= 1) ? bf2f(proj[(rowb + t0 - 1) * PLD + C_AX + c]) : 0.f;
    float h = 0.f, Ap = 1.f;
    if (final) { for (int cc = 0; cc < chunk; ++cc) { const float* sp = sums + ((size_t)((b * 4 + hbk) * 32 + cc) * 64 + lane) * 2; h = sp[0] * h + sp[1]; } }
    for (int t = t0; t < t0 + 256; ++t) {
        const float x0 = bf2f(proj[(rowb + t) * PLD + C_AX + c]);
        const float xc = cb + cw0 * x3 + cw1 * x2 + cw2 * x1 + cw3 * x0;
        float ra = ba, rx = bx;
#pragma unroll
        for (int i = 0; i < 64; ++i) { const float s = rl(xc, i); ra += s * wa[i]; rx += s * wx[i]; }
        const float r = sigmoidf_(ra), ig = sigmoidf_(rx);
        const float la = c8 * r; const float av = __expf(la);
        const float mult = (t == 0) ? 1.f : sqrtf(fmaxf(1.f - __expf(2.f * la), 0.f));
        const float bb = mult * ig * xc;
        h = av * h + bb; Ap *= av;
        if (final) { const float gt = bf2f(proj[(rowb + t) * PLD + C_AG + c]); ys[(rowb + t) * 1024 + c] = (bf16)f2bf(h * gelu_tanh(gt)); }
        x3 = x2; x2 = x1; x1 = x0;
    }
    if (!final) { float* sp = sums + ((size_t)((b * 4 + hbk) * 32 + chunk) * 64 + lane) * 2; sp[0] = Ap; sp[1] = h; }
}

template <int NH>
DI void dot_row64(const bf16* krow, const LAS float* qs, float (&acc)[NH]) {
#pragma unroll
    for (int h = 0; h < NH; ++h) acc[h] = 0.f;
#pragma unroll 1
    for (int c8 = 0; c8 < 8; ++c8) {
        const u32x4 w = *(const u32x4*)(krow + c8 * 8);
        const float k0 = lo_bf(w.x), k1 = hi_bf(w.x), k2 = lo_bf(w.y), k3 = hi_bf(w.y), k4 = lo_bf(w.z), k5 = hi_bf(w.z), k6 = lo_bf(w.w), k7 = hi_bf(w.w);
#pragma unroll
        for (int h = 0; h < NH; ++h) { const f32x4 qa = *(const LAS f32x4*)(qs + h * 64 + c8 * 8), qb = *(const LAS f32x4*)(qs + h * 64 + c8 * 8 + 4);
            acc[h] += qa[0] * k0; acc[h] += qa[1] * k1; acc[h] += qa[2] * k2; acc[h] += qa[3] * k3;
            acc[h] += qb[0] * k4; acc[h] += qb[1] * k5; acc[h] += qb[2] * k6; acc[h] += qb[3] * k7; } }
}
template <int NH>
DI void dot_row64_f32(const float* krow, const LAS float* qs, float (&acc)[NH]) {
#pragma unroll
    for (int h = 0; h < NH; ++h) acc[h] = 0.f;
#pragma unroll 1
    for (int d8 = 0; d8 < 8; ++d8) {
        const f32x4 ka = *(const f32x4*)(krow + d8 * 8), kb = *(const f32x4*)(krow + d8 * 8 + 4);
#pragma unroll
        for (int h = 0; h < NH; ++h) { const f32x4 qa = *(const LAS f32x4*)(qs + h * 64 + d8 * 8), qb = *(const LAS f32x4*)(qs + h * 64 + d8 * 8 + 4);
            acc[h] += qa[0] * ka[0]; acc[h] += qa[1] * ka[1]; acc[h] += qa[2] * ka[2]; acc[h] += qa[3] * ka[3];
            acc[h] += qb[0] * kb[0]; acc[h] += qb[1] * kb[1]; acc[h] += qb[2] * kb[2]; acc[h] += qb[3] * kb[3]; } }
}

DI void swa_token(const Args& a, int l, const bf16* proj, bf16* ys, const LAS float* biasd, LAS float* qs, int tok, int lane) {
    const int b = tok / SEQ, t = tok % SEQ; const size_t rowb = (size_t)b * SEQ;
#pragma unroll
    for (int h = 0; h < 4; ++h) qs[h * 64 + lane] = bf2f(proj[(size_t)tok * PLD + C_BQ + h * 64 + lane]) * 0.125f;
    LDS_WAIT();
#pragma unroll
    for (int g = 0; g < 2; ++g) {
        float s[2][2]; int ktok[2];
#pragma unroll
        for (int j = 0; j < 2; ++j) { const int dist = 64 * j + lane; const int kpos = t - dist; const bool valid = kpos >= 0; const int kp = valid ? kpos : 0; ktok[j] = (int)rowb + kp;
            float acc[2]; dot_row64<2>(proj + (size_t)ktok[j] * PLD + C_BK + g * 64, qs + g * 128, acc);
#pragma unroll
            for (int i = 0; i < 2; ++i) s[i][j] = valid ? acc[i] + biasd[dist * 12 + 2 * g + i] : -1e30f; }
        float o[2] = {0.f, 0.f};
#pragma unroll
        for (int i = 0; i < 2; ++i) { const float sink = a.in[12][l * 4 + 2 * g + i];
            float mx = fmaxf(wave_max(fmaxf(s[i][0], s[i][1])), sink);
            const float p0 = (s[i][0] > -1e29f) ? __expf(s[i][0] - mx) : 0.f, p1 = (s[i][1] > -1e29f) ? __expf(s[i][1] - mx) : 0.f;
            const float den = wave_sum(p0 + p1) + __expf(sink - mx); const float inv = 1.f / fmaxf(den, 1e-30f);
            s[i][0] = p0 * inv; s[i][1] = p1 * inv; }
#pragma unroll
        for (int j = 0; j < 2; ++j) {
#pragma unroll 4
            for (int kl = 0; kl < 64; ++kl) { const int kpos = t - (64 * j + kl); if (kpos < 0) break;
                const float vv = bf2f(proj[(rowb + kpos) * PLD + C_BV + g * 64 + lane]);
                o[0] += rl(s[0][j], kl) * vv; o[1] += rl(s[1][j], kl) * vv; } }
#pragma unroll
        for (int i = 0; i < 2; ++i) ys[(size_t)tok * 1024 + 256 + (2 * g + i) * 64 + lane] = (bf16)f2bf(o[i]);
    }
}

DI void diff_task(const Args& a, int l, const bf16* proj, bf16* ys, const LAS float* biasd, float lam, float lam_init, int task, int lane) {
    const int qg = task >> 4, bh = task & 15, b = bh >> 2, h = bh & 3; const int mp = lane >> 5; const int q = qg * 32 + (lane & 31);
    const size_t rowb = (size_t)b * SEQ; const size_t tok = rowb + q;
    const float scale = 0.17677669529663687f;
    float qr[32];
    { const bf16* qp = proj + tok * PLD + C_CQ + h * 64 + mp * 32;
#pragma unroll
      for (int c = 0; c < 4; ++c) { const u32x4 w = *(const u32x4*)(qp + c * 8);
        qr[c * 8 + 0] = lo_bf(w.x) * scale; qr[c * 8 + 1] = hi_bf(w.x) * scale; qr[c * 8 + 2] = lo_bf(w.y) * scale; qr[c * 8 + 3] = hi_bf(w.y) * scale;
        qr[c * 8 + 4] = lo_bf(w.z) * scale; qr[c * 8 + 5] = hi_bf(w.z) * scale; qr[c * 8 + 6] = lo_bf(w.w) * scale; qr[c * 8 + 7] = hi_bf(w.w) * scale; } }
    float o[64];
#pragma unroll
    for (int d = 0; d < 64; ++d) o[d] = 0.f;
    float mrun = -1e30f, lrun = 0.f;
    const int kend = qg * 32 + 31;
    for (int k = 0; k <= kend; ++k) {
        const bf16* kp = proj + (rowb + k) * PLD + C_CK + h * 64 + mp * 32;
        float s = 0.f;
#pragma unroll
        for (int c = 0; c < 4; ++c) { const u32x4 w = *(const u32x4*)(kp + c * 8);
            s += qr[c * 8 + 0] * lo_bf(w.x); s += qr[c * 8 + 1] * hi_bf(w.x); s += qr[c * 8 + 2] * lo_bf(w.y); s += qr[c * 8 + 3] * hi_bf(w.y);
            s += qr[c * 8 + 4] * lo_bf(w.z); s += qr[c * 8 + 5] * hi_bf(w.z); s += qr[c * 8 + 6] * lo_bf(w.w); s += qr[c * 8 + 7] * hi_bf(w.w); }
        const int dist = q - k; const bool valid = dist >= 0; const int di = valid ? (dist < 128 ? dist : 128) : 0;
        s += biasd[di * 12 + 4 + h];
        if (valid && s > mrun) { const float al = __expf(mrun - s); lrun *= al;
#pragma unroll
            for (int d = 0; d < 64; ++d) o[d] *= al;
            mrun = s; }
        const float p = valid ? __expf(s - mrun) : 0.f; lrun += p;
        const bf16* vp = proj + (rowb + k) * PLD + C_CV + h * 64;
#pragma unroll
        for (int c = 0; c < 8; ++c) { const u32x4 w = *(const u32x4*)(vp + c * 8);
            o[c * 8 + 0] += p * lo_bf(w.x); o[c * 8 + 1] += p * hi_bf(w.x); o[c * 8 + 2] += p * lo_bf(w.y); o[c * 8 + 3] += p * hi_bf(w.y);
            o[c * 8 + 4] += p * lo_bf(w.z); o[c * 8 + 5] += p * hi_bf(w.z); o[c * 8 + 6] += p * lo_bf(w.w); o[c * 8 + 7] += p * hi_bf(w.w); }
    }
    const float inv = 1.f / fmaxf(lrun, 1e-30f);
    float ss = 0.f;
#pragma unroll
    for (int d = 0; d < 64; ++d) { const float mine = o[d] * inv; const float other = __shfl_xor(mine, 32); const float at = mine - lam * other; o[d] = at; ss += at * at; }
    const float r = 1.f / sqrtf(ss * (1.f / 64.f) + 1e-5f) * (1.f - lam_init);
    if (mp == 0) { const float* sg = a.in[17] + l * 64; bf16* op = ys + tok * 1024 + 512 + h * 64;
#pragma unroll
        for (int c = 0; c < 8; ++c) { u32x4 w; w.x = pk2(o[c * 8 + 0] * r * sg[c * 8 + 0], o[c * 8 + 1] * r * sg[c * 8 + 1]); w.y = pk2(o[c * 8 + 2] * r * sg[c * 8 + 2], o[c * 8 + 3] * r * sg[c * 8 + 3]);
            w.z = pk2(o[c * 8 + 4] * r * sg[c * 8 + 4], o[c * 8 + 5] * r * sg[c * 8 + 5]); w.w = pk2(o[c * 8 + 6] * r * sg[c * 8 + 6], o[c * 8 + 7] * r * sg[c * 8 + 7]); *(u32x4*)(op + c * 8) = w; } }
}

DI void cmp_task(const Args& a, int l, const bf16* proj, float* kcvc, int task, int lane) {
    const int kv = task / (BATCH * NCMP), r = task % (BATCH * NCMP), b = r / NCMP, c = r % NCMP;
    const float* pos = a.in[kv ? 21 : 18] + (size_t)l * 2048; const float* w1 = a.in[kv ? 22 : 19] + (size_t)l * 2048 * 64; const float* w2 = a.in[kv ? 23 : 20] + (size_t)l * 4096;
    const size_t tokb = (size_t)b * SEQ + 16 * c; const int col0 = kv ? C_VC : C_KC;
    float h1 = 0.f;
    for (int li = 0; li < 32; ++li) { const float v = bf2f(proj[(tokb + li) * PLD + col0 + lane]) + pos[li * 64 + lane]; const float* wr = w1 + (size_t)(li * 64) * 64 + lane;
#pragma unroll
        for (int d = 0; d < 64; ++d) h1 += rl(v, d) * wr[d * 64]; }
    const float g = gelu_tanh(h1); float o = 0.f;
#pragma unroll
    for (int j = 0; j < 64; ++j) o += rl(g, j) * w2[j * 64 + lane];
    kcvc[((size_t)(kv * BATCH + b) * NCMP + c) * 64 + lane] = o;
}

DI void attn_block4(const bf16* proj, int keytok, bool valid, int dist, int kcol, int vcol, const LAS float* biasd, const LAS float* qs, float (&m)[4], float (&lsum)[4], float (&o)[4], int lane) {
    float acc[4]; dot_row64<4>(proj + (size_t)keytok * PLD + kcol, qs, acc);
    const int di = valid ? (dist < 128 ? dist : 128) : 0; float p[4];
#pragma unroll
    for (int h = 0; h < 4; ++h) { const float s = valid ? acc[h] + biasd[di * 12 + 8 + h] : -1e30f;
        const float bm = wave_max(s); const float mn = fmaxf(m[h], bm); const float al = __expf(m[h] - mn);
        p[h] = valid ? __expf(s - mn) : 0.f; lsum[h] = lsum[h] * al + wave_sum(p[h]); o[h] *= al; m[h] = mn; }
    const bf16* vb = proj + vcol + lane;
#pragma unroll 2
    for (int kl = 0; kl < 64; ++kl) { const int vt = rli(keytok, kl); const float vv = bf2f(vb[(size_t)vt * PLD]);
#pragma unroll
        for (int h = 0; h < 4; ++h) o[h] += rl(p[h], kl) * vv; }
}

DI void nsa_token(const Args& a, int l, const bf16* proj, bf16* ys, const float* kcvc, const LAS float* biasd, LAS float* wl, int tok, int lane) {
    LAS float* ps = wl; LAS float* qs = wl + 512; LAS float* scl = wl + 768; LAS int* sell = (LAS int*)(wl + 768 + 2048);
    const int b = tok / SEQ, t = tok % SEQ; const size_t rowb = (size_t)b * SEQ; const bf16* prow = proj + (size_t)tok * PLD;
#pragma unroll
    for (int h = 0; h < 4; ++h) qs[h * 64 + lane] = bf2f(prow[C_DQ + h * 64 + lane]) * 0.125f;
    LDS_WAIT(); asm volatile("" ::: "memory");
    const int ncv = (t >= 31) ? (((t - 31) >> 4) + 1 < NCMP ? ((t - 31) >> 4) + 1 : NCMP) : 0;
    const float* kc = kcvc + (size_t)(0 * BATCH + b) * NCMP * 64; const float* vc = kcvc + (size_t)(1 * BATCH + b) * NCMP * 64;
    float mx[4] = {-1e30f, -1e30f, -1e30f, -1e30f};
#pragma unroll 1
    for (int jc = 0; jc * 64 < ncv; ++jc) { const int c = jc * 64 + lane; const bool valid = c < ncv; const int cc = c < NCMP ? c : NCMP - 1;
        float acc[4]; dot_row64_f32<4>(kc + (size_t)cc * 64, qs, acc);
        const int dist = t - (16 * c + 31); const int di = valid ? (dist < 128 ? dist : 128) : 0;
#pragma unroll
        for (int h = 0; h < 4; ++h) { const float sv = valid ? acc[h] + biasd[di * 12 + 8 + h] : -1e30f; scl[h * 512 + c] = sv; mx[h] = fmaxf(mx[h], sv); } }
    float sum[4] = {0.f, 0.f, 0.f, 0.f};
#pragma unroll
    for (int h = 0; h < 4; ++h) mx[h] = wave_max(mx[h]);
    asm volatile("" ::: "memory");
#pragma unroll 1
    for (int jc = 0; jc * 64 < ncv; ++jc) { const int c = jc * 64 + lane;
#pragma unroll
        for (int h = 0; h < 4; ++h) { const float sv = scl[h * 512 + c]; const float p = (sv > -1e29f) ? __expf(sv - mx[h]) : 0.f; scl[h * 512 + c] = p; sum[h] += p; } }
#pragma unroll
    for (int h = 0; h < 4; ++h) sum[h] = 1.f / fmaxf(wave_sum(sum[h]), 1e-30f);
    asm volatile("" ::: "memory");
#pragma unroll 1
    for (int jc = 0; jc < 8; ++jc) { const int c = jc * 64 + lane; float tsum = 0.f;
        if (jc * 64 < ncv) {
#pragma unroll
            for (int h = 0; h < 4; ++h) { const float p = scl[h * 512 + c] * sum[h]; scl[h * 512 + c] = p; tsum += p; } }
        ps[c] = tsum; }
    LDS_WAIT(); asm volatile("" ::: "memory");
    float oc[4] = {0.f, 0.f, 0.f, 0.f};
#pragma unroll 2
    for (int c = 0; c < ncv; ++c) { const float vv = vc[(size_t)c * 64 + lane];
#pragma unroll
        for (int h = 0; h < 4; ++h) oc[h] += scl[h * 512 + c] * vv; }
    const int cur = t >> 6;
    float cand[2];
#pragma unroll
    for (int jj = 0; jj < 2; ++jj) { const int j = lane + 64 * jj; const int i0 = 4 * j;
        const float imp = (j > 0 ? ps[i0 - 1] : 0.f) + 2.f * (ps[i0] + ps[i0 + 1] + ps[i0 + 2]) + ps[i0 + 3];
        const bool forced = (j == 0) || (j == cur) || (j == cur - 1);
        cand[jj] = forced ? 1e4f : (j <= cur ? imp : -1.f); }
#pragma unroll 1
    for (int r = 0; r < 16; ++r) {
        float bv = cand[0]; int bi = lane; if (cand[1] > bv) { bv = cand[1]; bi = lane + 64; }
#pragma unroll
        for (int off = 32; off >= 1; off >>= 1) { const float ov = __shfl_xor(bv, off); const int oi = __shfl_xor(bi, off); if (ov > bv || (ov == bv && oi < bi)) { bv = ov; bi = oi; } }
        bi = __builtin_amdgcn_readfirstlane(bi);
        if (lane == 0) sell[r] = bi;
        if (bi == lane) cand[0] = -3.f; if (bi == lane + 64) cand[1] = -3.f;
    }
    LDS_WAIT(); asm volatile("" ::: "memory");
    float ms[4] = {-1e30f, -1e30f, -1e30f, -1e30f}, ls[4] = {0.f, 0.f, 0.f, 0.f}, os[4] = {0.f, 0.f, 0.f, 0.f};
#pragma unroll 1
    for (int r = 0; r < 16; ++r) { const int j = __builtin_amdgcn_readfirstlane(sell[r]);
        if (j > cur) continue;
        const int kpos = 64 * j + lane; const bool valid = kpos <= t;
        attn_block4(proj, (int)rowb + kpos, valid, t - kpos, C_KS, C_VS, biasd, qs, ms, ls, os, lane); }
    float mw[4] = {-1e30f, -1e30f, -1e30f, -1e30f}, lw[4] = {0.f, 0.f, 0.f, 0.f}, ow[4] = {0.f, 0.f, 0.f, 0.f};
#pragma unroll 1
    for (int jc = 0; jc < 8; ++jc) { if (t - 64 * jc < 0) break;
        const int dist = 64 * jc + lane; const int kpos = t - dist; const bool valid = kpos >= 0;
        attn_block4(proj, (int)rowb + (valid ? kpos : 0), valid, dist, C_KW, C_VW, biasd, qs, mw, lw, ow, lane); }
#pragma unroll
    for (int h = 0; h < 4; ++h) { const float g0 = sigmoidf_(bf2f(prow[C_DG + h * 3 + 0])), g1 = sigmoidf_(bf2f(prow[C_DG + h * 3 + 1])), g2 = sigmoidf_(bf2f(prow[C_DG + h * 3 + 2]));
        const float y = g0 * oc[h] + g1 * os[h] / fmaxf(ls[h], 1e-30f) + g2 * ow[h] / fmaxf(lw[h], 1e-30f);
        ys[(size_t)tok * 1024 + 768 + h * 64 + lane] = (bf16)f2bf(y); }
    asm volatile("" ::: "memory");
}

DI void route_token(const Args& a, int l, bf16* x2b, int* rec_e, int* rec_slot, float* rec_w, unsigned* cnt, int tok, int lane) {
    const float* xr = a.out + (size_t)tok * 1024; const float* g = a.in[28] + (size_t)l * 1024;
    f32x4 v[4]; float ss = 0.f;
#pragma unroll
    for (int j = 0; j < 4; ++j) { v[j] = *(const f32x4*)(xr + 4 * (lane + 64 * j)); ss += (v[j][0] * v[j][0] + v[j][1] * v[j][1]) + (v[j][2] * v[j][2] + v[j][3] * v[j][3]); }
    const float r = 1.f / sqrtf(wave_sum(ss) * (1.f / 1024.f) + 1e-6f);
    const float* wg = a.in[29] + (size_t)l * 1024 * 4; const float* we = a.in[31] + (size_t)l * 1024 * 32;
    float lg[36];
#pragma unroll
    for (int i = 0; i < 36; ++i) lg[i] = 0.f;
#pragma unroll
    for (int j = 0; j < 4; ++j) { const f32x4 gv = *(const f32x4*)(g + 4 * (lane + 64 * j)); const f32x4 xn = v[j] * r * gv;
        u32x2 w; w.x = pk2(xn[0], xn[1]); w.y = pk2(xn[2], xn[3]); *(u32x2*)(x2b + (size_t)tok * 1024 + 4 * (lane + 64 * j)) = w;
#pragma unroll
        for (int e = 0; e < 4; ++e) { const int k = 4 * (lane + 64 * j) + e; const float xk = xn[e];
            const f32x4 g4 = *(const f32x4*)(wg + (size_t)k * 4);
            lg[0] += xk * g4[0]; lg[1] += xk * g4[1]; lg[2] += xk * g4[2]; lg[3] += xk * g4[3];
#pragma unroll
            for (int q = 0; q < 8; ++q) { const f32x4 e4 = *(const f32x4*)(we + (size_t)k * 32 + q * 4);
                lg[4 + q * 4 + 0] += xk * e4[0]; lg[4 + q * 4 + 1] += xk * e4[1]; lg[4 + q * 4 + 2] += xk * e4[2]; lg[4 + q * 4 + 3] += xk * e4[3]; } } }
#pragma unroll
    for (int i = 0; i < 36; ++i) lg[i] = wave_sum(lg[i]);
    const float* bg = a.in[30] + l * 4; const float* be = a.in[32] + l * 32;
#pragma unroll
    for (int i = 0; i < 4; ++i) lg[i] += bg[i];
#pragma unroll
    for (int i = 0; i < 32; ++i) lg[4 + i] += be[i];
    int gsel = 0; float gm = lg[0];
#pragma unroll
    for (int i = 1; i < 4; ++i) if (lg[i] > gm) { gm = lg[i]; gsel = i; }
    float gs = 0.f;
#pragma unroll
    for (int i = 0; i < 4; ++i) gs += __expf(lg[i] - gm);
    const float gwt = 1.f / gs;
    float v8[8];
#pragma unroll
    for (int i = 0; i < 8; ++i) { float x = lg[4 + i];
#pragma unroll
        for (int gq = 1; gq < 4; ++gq) x = (gsel == gq) ? lg[4 + gq * 8 + i] : x;
        v8[i] = x; }
    int i0 = 0; float m0 = v8[0];
#pragma unroll
    for (int i = 1; i < 8; ++i) if (v8[i] > m0) { m0 = v8[i]; i0 = i; }
    int i1 = -1; float m1 = -3e38f;
#pragma unroll
    for (int i = 0; i < 8; ++i) if (i != i0 && v8[i] > m1) { m1 = v8[i]; i1 = i; }
    const float w0 = 1.f / (1.f + __expf(m1 - m0)); const float w1 = 1.f - w0;
    if (lane == 0) {
        const int e0 = gsel * 8 + i0, e1 = gsel * 8 + i1;
        const unsigned s0 = __hip_atomic_fetch_add(cnt + e0, 1u, __ATOMIC_RELAXED, __HIP_MEMORY_SCOPE_AGENT);
        const unsigned s1 = __hip_atomic_fetch_add(cnt + e1, 1u, __ATOMIC_RELAXED, __HIP_MEMORY_SCOPE_AGENT);
        rec_e[tok * 2] = e0; rec_e[tok * 2 + 1] = e1; rec_slot[tok * 2] = (int)s0; rec_slot[tok * 2 + 1] = (int)s1; rec_w[tok * 2] = w0 * gwt; rec_w[tok * 2 + 1] = w1 * gwt;
    }
}
DI void expert_weights(const Args& a, int l, LAS unsigned char* lds, int gw, int NGW, int wave, int lane) {
    LAS float* scr = (LAS float*)(lds + wave * 16384);
    const float* wgt = a.in[33] + (size_t)l * 32 * 1024 * 256; const float* wup = a.in[34] + (size_t)l * 32 * 1024 * 256; const float* wdn = a.in[35] + (size_t)l * 32 * 256 * 1024;
    bf16* Wgu = (bf16*)(a.ws + WS_WGU); bf16* Wd = (bf16*)(a.ws + WS_WD);
    constexpr int I_E = 16 * 8, I_D = 4 * 32;
    constexpr int NIT = 32 * (2 * I_E + I_D);
    for (int it = gw; it < NIT; it += NGW) {
        const int e = it / (2 * I_E + I_D); int r = it % (2 * I_E + I_D);
        if (r < 2 * I_E) { const int up = r / I_E, q = r % I_E, kb = q / 8, nb = q % 8; const int n0 = nb * 32;
            const int drow = (n0 >> 7) * 256 + up * 128 + (n0 & 127);
            transpose_item((up ? wup : wgt) + (size_t)e * 1024 * 256, 256, 256, Wgu + (size_t)e * 512 * 1024, 1024, kb * 64, n0, drow, scr, lane);
        } else { r -= 2 * I_E; const int kb = r / 32, nb = r % 32;
            transpose_item(wdn + (size_t)e * 256 * 1024, 1024, 1024, Wd + (size_t)e * 1024 * 256, 256, kb * 64, nb * 32, nb * 32, scr, lane); }
    }
}
DI void build_offsets(const unsigned* cnt, LAS int* offt) {
    if (threadIdx.x == 0) { int o = 0; for (int e = 0; e < 32; ++e) { offt[e] = o; const int c = (int)__hip_atomic_load(cnt + e, __ATOMIC_RELAXED, __HIP_MEMORY_SCOPE_AGENT); o += (c + 255) & ~255; } offt[32] = o; }
    __syncthreads();
    for (int rt = threadIdx.x; rt < (MOE_ROWS >> 8); rt += 512) { int e = 0; for (int j = 1; j < 32; ++j) e += (offt[j] <= rt * 256) ? 1 : 0; offt[40 + rt] = e; }
    __syncthreads();
}

template <unsigned PM>
__global__ void __launch_bounds__(512, 2) mk_fwd(Args a) {
    extern __shared__ __attribute__((aligned(16))) unsigned char lds_raw[];
    LAS unsigned char* lds = (LAS unsigned char*)lds_raw;
    const int tid = threadIdx.x;
    const int G = gridDim.x, bid = blockIdx.x, NGW = G * 8;
#define PHASE_IDS() int tid_ = threadIdx.x; asm volatile("" : "+v"(tid_)); const int lane = tid_ & 63, wave = __builtin_amdgcn_readfirstlane(tid_ >> 6), gw = bid * 8 + wave; (void)lane; (void)wave; (void)gw
    volatile LAS unsigned* MISC = (volatile LAS unsigned*)(lds + MISC_OFF);
    LAS float* biasd = (LAS float*)(lds + BIAS_OFF);
    LAS int* offt = (LAS int*)(lds + OFFT_OFF);
    if (tid < 64) MISC[tid] = 0u;
    for (int i = tid; i < 129 * 12; i += 512) { const int d = i / 12, hd = i % 12; const int bk = d < 128 ? T5_BUCKET[d] : 31; biasd[i] = a.in[1][bk * 12 + hd]; }
    __syncthreads();
    unsigned* ctl = (unsigned*)(a.ws + WS_CTL);
    const int lo = a.ph_lo, hi = a.ph_hi;
    XcdBarrier bar; bar.bar = ctl + CW_BAR; bar.x = 0; bar.st = nullptr;
    if (hi - lo > 1) bar = xcd_barrier_post(ctl + CW_BAR, MISC + 8);
#ifndef SUB_MASK
#define SUB_MASK 0xFFu
#endif
#define SUB(k) ((SUB_MASK >> (k)) & 1u)
#define HASP(k) ((PM >> ((k) % 10 + ((k) >= 20 ? 10 : 0))) & 1u)
#define IN(k) (HASP(k) && lo <= (k) && (k) < hi)
#define SEAM(k) do { if ((k) + 1 < hi) xcd_barrier(bar); } while (0)
    bf16* hb = (bf16*)(a.ws + WS_HB); bf16* proj = (bf16*)(a.ws + WS_PROJ); bf16* gates = (bf16*)(a.ws + WS_GATES);
    bf16* ys = hb; bf16* x2b = hb; bf16* merged = proj; bf16* eo = proj;
    float* kcvc = (float*)(a.ws + WS_KCVC); float* lrusum = (float*)(a.ws + WS_LRUSUM);
    int* rec_e = (int*)(a.ws + WS_REC); int* rec_slot = rec_e + T * 2; float* rec_w = (float*)(rec_slot + T * 2);
    int* rowtok = (int*)(a.ws + WS_ROWTOK); float* roww = (float*)(a.ws + WS_ROWW);
    bf16* xs = (bf16*)(a.ws + WS_XS); bf16* hmid = (bf16*)(a.ws + WS_HMID);

    for (int l = 0; l < DEPTH; ++l) {
        const int pb = l * 10;
        if (IN(pb + 0)) { PHASE_IDS(); phase0_weights(a, l, lds, gw, NGW, wave, lane); phase0_rows(a, l, 0, gw, NGW, lane); SEAM(pb + 0); }
        if (IN(pb + 1)) {
            pg8::Gemm g{1024, 1024, 1024}; SchedP1 S{(const char*)hb, (const char*)(a.ws + WS_WIN), G, bid};
            EpiP1 E{proj, gates, a.in[25] + (size_t)l * 4096};
            pg8::gemm_phase<EpiP1, SchedP1>(lds, g, S, E); SEAM(pb + 1);
        }
        if (IN(pb + 2)) {
            PHASE_IDS();
            float s1 = 0.f, s2 = 0.f;
            for (int i = 0; i < 32; ++i) { s1 += a.in[13][l * 32 + i] * a.in[14][l * 32 + i]; s2 += a.in[15][l * 32 + i] * a.in[16][l * 32 + i]; }
            const float lam_init = 0.8f - 0.6f * __expf(-0.3f * (float)l); const float lam = __expf(s1) - __expf(s2) + lam_init;
            if (SUB(0)) for (int p = gw; p < 2048; p += NGW) { diff_task(a, l, proj, ys, biasd, lam, lam_init, 4095 - p, lane); diff_task(a, l, proj, ys, biasd, lam, lam_init, p, lane); }
            if (SUB(1)) for (int task = gw; task < 512; task += NGW) lru_task(a, l, proj, ys, lrusum, task, lane, false);
            if (SUB(2)) for (int task = gw; task < 2 * BATCH * NCMP; task += NGW) cmp_task(a, l, proj, kcvc, task, lane);
            if (SUB(3)) { LAS float* qs = (LAS float*)(lds + wave * 4096); for (int tok = gw; tok < T; tok += NGW) swa_token(a, l, proj, ys, biasd, qs, tok, lane); }
            SEAM(pb + 2);
        }
        if (IN(pb + 3)) {
            PHASE_IDS();
            if (SUB(1)) for (int task = gw; task < 512; task += NGW) lru_task(a, l, proj, ys, lrusum, task, lane, true);
            LAS float* ps = (LAS float*)(lds + wave * 12288);
            if (SUB(4)) for (int tok = gw; tok < T; tok += NGW) nsa_token(a, l, proj, ys, kcvc, biasd, ps, tok, lane);
            SEAM(pb + 3);
        }
        if (IN(pb + 4)) {
            pg8::Gemm g{256, 1024, 256}; SchedP3a S{(const char*)ys, (const char*)(a.ws + WS_WBR), G, bid};
            EpiP3a E{merged, gates};
            pg8::gemm_phase<EpiP3a, SchedP3a>(lds, g, S, E); SEAM(pb + 4);
        }
        if (IN(pb + 5)) {
            pg8::Gemm g{1024, 1024, 1024}; SchedP3b S{(const char*)merged, (const char*)(a.ws + WS_WOUT), G, bid};
            EpiP3b E{(l == 0) ? a.in[0] : a.out, a.out};
            pg8::gemm_phase<EpiP3b, SchedP3b>(lds, g, S, E); SEAM(pb + 5);
        }
        if (IN(pb + 6)) {
            PHASE_IDS();
            expert_weights(a, l, lds, gw, NGW, wave, lane);
            for (int tok = gw; tok < T; tok += NGW) route_token(a, l, x2b, rec_e, rec_slot, rec_w, ctl + CW_CNT + l * 32, tok, lane);
            SEAM(pb + 6);
        }
        if (IN(pb + 7)) {
            PHASE_IDS();
            build_offsets(ctl + CW_CNT + l * 32, offt);
            if (bid < 32) { const int e = bid; const int c = (int)__hip_atomic_load(ctl + CW_CNT + l * 32 + e, __ATOMIC_RELAXED, __HIP_MEMORY_SCOPE_AGENT);
                for (int p = offt[e] + c + tid_; p < offt[e + 1]; p += 512) rowtok[p] = -1; }
            for (int tok = gw; tok < T; tok += NGW) {
#pragma unroll
                for (int k = 0; k < 2; ++k) { const int e = rec_e[tok * 2 + k], slot = rec_slot[tok * 2 + k]; const int pos = offt[e] + slot;
                    const u32x4 v0 = *(const u32x4*)(x2b + (size_t)tok * 1024 + lane * 8), v1 = *(const u32x4*)(x2b + (size_t)tok * 1024 + 512 + lane * 8);
                    *(u32x4*)(xs + (size_t)pos * 1024 + lane * 8) = v0; *(u32x4*)(xs + (size_t)pos * 1024 + 512 + lane * 8) = v1;
                    if (lane == 0) { rowtok[pos] = tok * 2 + k; roww[pos] = rec_w[tok * 2 + k]; } } }
            SEAM(pb + 7);
        }
        if (IN(pb + 8)) {
            build_offsets(ctl + CW_CNT + l * 32, offt);
            pg8::Gemm g{1024, 1024, 1024}; SchedM2 S{(const char*)xs, (const char*)(a.ws + WS_WGU), offt, G, bid};
            EpiM2 E{hmid};
            pg8::gemm_phase<EpiM2, SchedM2>(lds, g, S, E); SEAM(pb + 8);
        }
        if (IN(pb + 9)) {
            build_offsets(ctl + CW_CNT + l * 32, offt);
            pg8::Gemm g{256, 256, 256}; SchedM3 S{(const char*)hmid, (const char*)(a.ws + WS_WD), offt, G, bid};
            EpiM3 E{eo, rowtok, roww};
            pg8::gemm_phase<EpiM3, SchedM3>(lds, g, S, E); SEAM(pb + 9);
        }
    }
    if (IN(20)) { PHASE_IDS(); phase0_rows(a, DEPTH, 1, gw, NGW, lane); }
#undef IN
#undef SEAM
}

typedef void (*kern_t)(Args);
template <unsigned PM> static bool setup_kernel() {
    if (hipFuncSetAttribute((const void*)mk_fwd<PM>, hipFuncAttributeMaxDynamicSharedMemorySize, LDS_BYTES) != hipSuccess) { fprintf(stderr, "kernel_launch: hipFuncSetAttribute failed\n"); return false; }
    return true;
}
extern "C" void kernel_launch(void* const* d_in, const int* in_sizes, int n_in, void* d_out, int out_size, void* d_ws, size_t ws_size, hipStream_t stream) {
    static int grid = 0;
    if (grid == 0) {
        if (n_in != 36 || out_size != T * D || ws_size < WS_END) { fprintf(stderr, "kernel_launch: unexpected shapes (n_in %d out %d ws %zu)\n", n_in, out_size, ws_size); grid = -1; return; }
        int dev = 0, cus = 0;
        if (hipGetDevice(&dev) != hipSuccess || hipDeviceGetAttribute(&cus, hipDeviceAttributeMultiprocessorCount, dev) != hipSuccess) { grid = -1; return; }
        bool ok = true;
#if MK_ONE_LAUNCH
        ok = setup_kernel<0x7FFu>();
#else
        ok = setup_kernel<1u>() && setup_kernel<2u>() && setup_kernel<4u>() && setup_kernel<8u>() && setup_kernel<16u>() && setup_kernel<32u>() && setup_kernel<64u>() && setup_kernel<128u>() && setup_kernel<256u>() && setup_kernel<512u>() && setup_kernel<1024u>();
#endif
        if (!ok) { grid = -1; return; }
        (void)hipGetLastError();
        grid = cus;
    }
    if (grid < 0) return;
    if (hipMemsetAsync((char*)d_ws + WS_CTL, 0, CTL_ZERO_BYTES, stream) != hipSuccess) return;
    Args a{};
    for (int i = 0; i < 36; ++i) a.in[i] = (const float*)d_in[i];
    a.out = (float*)d_out; a.ws = (unsigned char*)d_ws;
#if MK_ONE_LAUNCH
    a.ph_lo = 0; a.ph_hi = NPH;
    hipLaunchKernelGGL(mk_fwd<0x7FFu>, dim3(grid), dim3(512), LDS_BYTES, stream, a);
#else
    static const kern_t kerns[11] = { mk_fwd<1u>, mk_fwd<2u>, mk_fwd<4u>, mk_fwd<8u>, mk_fwd<16u>, mk_fwd<32u>, mk_fwd<64u>, mk_fwd<128u>, mk_fwd<256u>, mk_fwd<512u>, mk_fwd<1024u> };
    for (int p = 0; p < NPH; ++p) { a.ph_lo = p; a.ph_hi = p + 1; hipLaunchKernelGGL(kerns[p < 20 ? p % 10 : 10], dim3(grid), dim3(512), LDS_BYTES, stream, a); }
#endif
}
```

```cpp
#include <hip/hip_runtime.h>
#include <cstdio>
#include <cstdint>

#ifndef MK_ONE_LAUNCH
#define MK_ONE_LAUNCH 1
#endif

#define DI __device__ __forceinline__
#define GAS __attribute__((address_space(1)))
#define LAS __attribute__((address_space(3)))
typedef unsigned short bf16;
typedef short bf16x8 __attribute__((ext_vector_type(8)));
typedef float f32x4 __attribute__((ext_vector_type(4)));
typedef unsigned u32x4 __attribute__((ext_vector_type(4)));
typedef unsigned u32x2 __attribute__((ext_vector_type(2)));

constexpr int BATCH = 4, SEQ = 8192, T = BATCH * SEQ, D = 1024, DEPTH = 2;
constexpr int NIN = 2444, PLD = 2560, N1 = 6656, GLD = 4096;
constexpr int C_AX = 0, C_AG = 256, C_BQ = 512, C_BK = 768, C_BV = 896, C_CQ = 1024, C_CK = 1280, C_CV = 1536, C_DQ = 1792,
              C_KC = 2048, C_VC = 2112, C_KS = 2176, C_VS = 2240, C_KW = 2304, C_VW = 2368, C_DG = 2432;
constexpr int NCMP = 511;
constexpr int MOE_ROWS = 73728;
constexpr int NPH = 21;

constexpr size_t MiB = 1u << 20;
constexpr size_t WS_CTL = 0, CTL_ZERO_BYTES = 1 * MiB;
constexpr size_t WS_KCVC = 1 * MiB;
constexpr size_t WS_LRUSUM = 2 * MiB;
constexpr size_t WS_REC = 2 * MiB + 256 * 1024;
constexpr size_t WS_ROWTOK = 3 * MiB;
constexpr size_t WS_ROWW = 3 * MiB + 512 * 1024;
constexpr size_t WS_WIN = 4 * MiB;
constexpr size_t WS_WBR = 17 * MiB;
constexpr size_t WS_WOUT = 19 * MiB;
constexpr size_t WS_HB = 21 * MiB;
constexpr size_t WS_PROJ = 85 * MiB;
constexpr size_t WS_GATES = 245 * MiB;
constexpr size_t WS_WGU = 245 * MiB;
constexpr size_t WS_WD = 277 * MiB;
constexpr size_t WS_XS = 293 * MiB;
constexpr size_t WS_HMID = 437 * MiB;
constexpr size_t WS_END = 501 * MiB;
constexpr int CW_BAR = 4096;
constexpr int CW_CNT = 16384;

constexpr int RING_BYTES = 131072;
constexpr int MISC_OFF = RING_BYTES;
constexpr int BIAS_OFF = MISC_OFF + 256;
constexpr int OFFT_OFF = BIAS_OFF + 129 * 12 * 4;
constexpr int PTAB_OFF = OFFT_OFF + (40 + 288) * 4;
constexpr int LDS_BYTES = 147456;
static_assert(PTAB_OFF % 8 == 0 && PTAB_OFF + 36 * 8 <= LDS_BYTES, "LDS map");

DI float bf2f(bf16 v) { return __builtin_bit_cast(float, (unsigned)v << 16); }
DI float lo_bf(unsigned w) { return __builtin_bit_cast(float, w << 16); }
DI float hi_bf(unsigned w) { return __builtin_bit_cast(float, w & 0xffff0000u); }
DI unsigned f2bf(float f) { unsigned u = __builtin_bit_cast(unsigned, f); return (u + 0x7fffu + ((u >> 16) & 1u)) >> 16; }
DI unsigned pk2(float lo, float hi) { return f2bf(lo) | (f2bf(hi) << 16); }
DI float rl(float v, int i) { return __builtin_bit_cast(float, __builtin_amdgcn_readlane(__builtin_bit_cast(int, v), i)); }
DI int rli(int v, int i) { return __builtin_amdgcn_readlane(v, i); }
DI int my_lane() { int l; asm volatile("v_mbcnt_lo_u32_b32 %0, -1, 0\n\tv_mbcnt_hi_u32_b32 %0, -1, %0" : "=v"(l)); return l; }
template <int O> DI int xshfl_i(int v) {
    if constexpr (O < 32) return __builtin_amdgcn_ds_swizzle(v, (O << 10) | 0x1f);
    else { const int l = my_lane(); return __builtin_amdgcn_ds_bpermute((l ^ 32) << 2, v); }
}
template <int O> DI float xshfl(float v) { return __builtin_bit_cast(float, xshfl_i<O>(__builtin_bit_cast(int, v))); }
DI float wave_sum(float v) { v += xshfl<1>(v); v += xshfl<2>(v); v += xshfl<4>(v); v += xshfl<8>(v); v += xshfl<16>(v); v += xshfl<32>(v); return v; }
DI float wave_max(float v) { v = fmaxf(v, xshfl<1>(v)); v = fmaxf(v, xshfl<2>(v)); v = fmaxf(v, xshfl<4>(v)); v = fmaxf(v, xshfl<8>(v)); v = fmaxf(v, xshfl<16>(v)); v = fmaxf(v, xshfl<32>(v)); return v; }
DI float sigmoidf_(float x) { return 1.f / (1.f + __expf(-x)); }
DI float gelu_tanh(float x) { const float u = 0.7978845608028654f * (x + 0.044715f * x * x * x); const float e = __expf(2.f * u); const float th = 1.f - 2.f / (e + 1.f); return 0.5f * x * (1.f + th); }
DI float softplusf_(float x) { return fmaxf(x, 0.f) + log1pf(__expf(-fabsf(x))); }
#define LDS_WAIT() asm volatile("s_waitcnt lgkmcnt(0)" ::: "memory")
#define VM_WAIT() asm volatile("s_waitcnt vmcnt(0)" ::: "memory")

__device__ const unsigned char T5_BUCKET[128] = {
0,1,2,3,4,5,6,7,8,9,10,11,12,13,14,15,16,16,16,17,17,18,18,18,19,19,19,20,20,20,20,21,21,21,21,22,22,22,22,22,23,23,23,23,23,23,24,24,24,24,24,24,25,25,25,25,25,25,25,26,26,26,26,26,26,26,26,27,27,27,27,27,27,27,27,27,27,28,28,28,28,28,28,28,28,28,28,29,29,29,29,29,29,29,29,29,29,29,29,30,30,30,30,30,30,30,30,30,30,30,30,30,30,31,31,31,31,31,31,31,31,31,31,31,31,31,31,31};

#define XB_TMO      128
#define XB_XCNT(j)  (256  + 64 * (j))
#define XB_XSUB(j)  (1280 + 64 * (j))
#define XB_XGEN(j)  (2304 + 64 * (j))
#define XB_TOP      3328
#define XB_TOPGEN   3392
#define XCD_BAR_WORDS 3456
#define XB_SPIN_CAP (1u << 22)
DI unsigned xb_ld(unsigned* p)              { return __hip_atomic_load(p, __ATOMIC_RELAXED, __HIP_MEMORY_SCOPE_AGENT); }
DI unsigned xb_add(unsigned* p, unsigned v) { return __hip_atomic_fetch_add(p, v, __ATOMIC_RELAXED, __HIP_MEMORY_SCOPE_AGENT); }
DI unsigned xb_xcc_id() { return (unsigned)__builtin_amdgcn_s_getreg((3 << 11) | 20) & 0xFu; }
#define XB_SPIN(cond, bar) do { unsigned _sp = 0; while (cond) { __builtin_amdgcn_s_sleep(1); \
    if ((++_sp & 255u) == 0u) { if (xb_ld(&(bar)[XB_TMO])) break; if (_sp > XB_SPIN_CAP) { atomicAdd(&(bar)[XB_TMO], 1u); break; } } } } while (0)
struct XcdBarrier { unsigned* bar; unsigned x; volatile LAS unsigned* st; };
DI XcdBarrier xcd_barrier_post(unsigned* bar, volatile LAS unsigned* st, bool leader) {
    XcdBarrier b; b.bar = bar; b.x = xb_xcc_id(); b.st = st;
    if (leader) (void)xb_add(&bar[XB_XCNT(b.x)], 1u);
    return b;
}
DI void xcd_barrier_complete(unsigned* bar, unsigned x, unsigned& nloc, unsigned& nx) {
    const unsigned G = gridDim.x * gridDim.y * gridDim.z;
    unsigned sum, cnt, mine, sp = 0u;
    for (;;) {
        sum = 0u; cnt = 0u; mine = 0u;
#pragma unroll
        for (unsigned j = 0; j < 16; ++j) { const unsigned c = xb_ld(&bar[XB_XCNT(j)]); sum += c; cnt += (c > 0u) ? 1u : 0u; mine = (j == x) ? c : mine; }
        if (sum == G) break;
        __builtin_amdgcn_s_sleep(1);
        if ((++sp & 255u) == 0u) { if (xb_ld(&bar[XB_TMO])) break; if (sp > XB_SPIN_CAP) { atomicAdd(&bar[XB_TMO], 1u); break; } }
    }
    nloc = mine > 0u ? mine : 1u; nx = cnt > 0u ? cnt : 1u;
}
DI void xcd_barrier(const XcdBarrier& b, bool leader) {
    asm volatile("s_waitcnt vmcnt(0)" ::: "memory");
    __syncthreads();
    if (leader) {
        unsigned* bar = b.bar;
        __builtin_amdgcn_s_waitcnt(0);
        unsigned nloc = b.st[0], nx = b.st[1];
        if (nloc == 0u) { xcd_barrier_complete(bar, b.x, nloc, nx); b.st[0] = nloc; b.st[1] = nx; }
        const unsigned old = xb_add(&bar[XB_XSUB(b.x)], 1u);
        const unsigned gen = old / nloc;
        if (old + 1u == (gen + 1u) * nloc) {
            __builtin_amdgcn_fence(__ATOMIC_RELEASE, "agent");
            asm volatile("s_waitcnt vmcnt(0)" ::: "memory");
            const unsigned og = xb_add(&bar[XB_TOP], 1u);
            const unsigned tg = og / nx;
            if (og + 1u == (tg + 1u) * nx) xb_add(&bar[XB_TOPGEN], 1u);
            else XB_SPIN(xb_ld(&bar[XB_TOPGEN]) == tg, bar);
            __builtin_amdgcn_fence(__ATOMIC_ACQUIRE, "agent");
            xb_add(&bar[XB_XGEN(b.x)], 1u);
            asm volatile("s_waitcnt vmcnt(0)" ::: "memory");
        } else {
            XB_SPIN(xb_ld(&bar[XB_XGEN(b.x)]) == gen, bar);
            __builtin_amdgcn_fence(__ATOMIC_ACQUIRE, "agent");
            asm volatile("s_waitcnt vmcnt(0)" ::: "memory");
        }
    }
    __syncthreads();
}

namespace pg8 {
constexpr int BM = 256, BK = 64, HALF = 128, HTB = HALF * BK * 2;
__host__ __device__ __forceinline__ int lds_byte(int r, int c) { const int st = (r >> 4) * 2 + (c >> 5), rr = r & 15, cc = c & 31, ob = rr * 64 + cc * 2; return st * 1024 + (ob ^ (((ob >> 9) & 1) << 5)); }
__host__ __device__ __forceinline__ void stage_rc(int b, int& R, int& C) { const int st = b / 1024, sb = b % 1024, swz = sb ^ (((sb >> 9) & 1) << 5); R = (st >> 1) * 16 + swz / 64; C = (st & 1) * 32 + (swz % 64) / 2; }
__host__ __device__ __forceinline__ int perm32(int rho) { const int n = rho >> 4, i = rho & 15; return 8 * (i >> 2) + 4 * n + (i & 3); }
struct Unit { const char* a; const char* b; int pm, pn, aux, pad; };
struct Gemm { int K, lda, ldb; };
template <class Epi, class Sched>
DI void gemm_phase(LAS unsigned char* lds, const Gemm g, const Sched& S, const Epi& E, int tid_in) {
    int tid = tid_in; asm volatile("" : "+v"(tid));
    const int wid = __builtin_amdgcn_readfirstlane(tid >> 6), lane = tid & 63, wr = wid >> 2, wc = wid & 3, fr = lane & 15, fq = lane >> 4;
    const int K = g.K, nt = K / BK;
    unsigned voffA[2], voffB[2];
#pragma unroll
    for (int i = 0; i < 2; ++i) { int R, C; stage_rc(tid * 16 + i * 8192, R, C); const int Rb = (R & ~31) + perm32(R & 31);
        voffA[i] = (unsigned)(R * g.lda + C) * 2u; voffB[i] = (unsigned)(Rb * g.ldb + C) * 2u; }
    const size_t kstep = (size_t)(BK * 2);
    const size_t hstepA = (size_t)HALF * g.lda * 2, hstepB = (size_t)HALF * g.ldb * 2;
    const unsigned ldsw = (unsigned)wid * 1024u;
    const int aoff = lds_byte(wr * 64 + fr, fq * 8), boff = lds_byte(wc * 32 + fr, fq * 8);
#define PG8_SA(b, h) (((b) * 2 + (h)) * HTB)
#define PG8_SB(b, h) ((4 + (b) * 2 + (h)) * HTB)
#define PG8_STAGE(bufoff, gbase, voff) do { _Pragma("unroll") for (int _i = 0; _i < 2; ++_i) \
        __builtin_amdgcn_global_load_lds((const unsigned*)((const char*)(gbase) + (voff)[_i]), (LAS unsigned*)(lds + (bufoff) + ldsw + _i * 8192), 16, 0, 0); } while (0)
#define PG8_LDA(dst, b, h) do { _Pragma("unroll") for (int m = 0; m < 4; ++m) _Pragma("unroll") for (int k = 0; k < 2; ++k) dst[m][k] = *(const LAS bf16x8*)(lds + PG8_SA(b, h) + aoff + m * 2048 + k * 1024); } while (0)
#define PG8_LDB(dst, b, h) do { _Pragma("unroll") for (int n = 0; n < 2; ++n) _Pragma("unroll") for (int k = 0; k < 2; ++k) dst[n][k] = *(const LAS bf16x8*)(lds + PG8_SB(b, h) + boff + n * 2048 + k * 1024); } while (0)
#define PG8_MMA(ai, bj, At, Bt) do { __builtin_amdgcn_s_setprio(1); _Pragma("unroll") for (int m = 0; m < 4; ++m) _Pragma("unroll") for (int n = 0; n < 2; ++n) _Pragma("unroll") for (int k = 0; k < 2; ++k) \
        acc[ai][bj][m][n] = __builtin_amdgcn_mfma_f32_16x16x32_bf16(Bt[n][k], At[m][k], acc[ai][bj][m][n], 0, 0, 0); __builtin_amdgcn_s_setprio(0); } while (0)
#define PG8_WAIT_V(n) asm volatile("s_waitcnt vmcnt(" #n ")" ::: "memory")
#define PG8_WAIT_L(n) asm volatile("s_waitcnt lgkmcnt(" #n ")" ::: "memory")
#define PG8_BAR __builtin_amdgcn_s_barrier()
#define PG8_SCHED __builtin_amdgcn_sched_barrier(0)
    Unit cur, nxt; int ui = 0;
    if (!S.next(0, cur)) return;
    f32x4 acc[2][2][4][2];
#pragma unroll
    for (int a = 0; a < 2; ++a)
#pragma unroll
        for (int b = 0; b < 2; ++b)
#pragma unroll
            for (int m = 0; m < 4; ++m)
#pragma unroll
                for (int n = 0; n < 2; ++n) acc[a][b][m][n] = (f32x4){0.f, 0.f, 0.f, 0.f};
    bf16x8 At[4][2], B0[2][2], B1[2][2];
    const char* cA = cur.a; const char* cB = cur.b;
    PG8_STAGE(PG8_SB(0, 0), cB, voffB); PG8_STAGE(PG8_SB(0, 1), cB + hstepB, voffB); PG8_STAGE(PG8_SA(0, 0), cA, voffA); PG8_STAGE(PG8_SA(0, 1), cA + hstepA, voffA);
    if (wr == 1) PG8_BAR;
    PG8_WAIT_V(2); PG8_BAR;
    PG8_STAGE(PG8_SB(1, 0), cB + kstep, voffB); PG8_STAGE(PG8_SA(1, 0), cA + kstep, voffA); PG8_STAGE(PG8_SB(1, 1), cB + hstepB + kstep, voffB);
    PG8_WAIT_V(6); PG8_BAR;
    for (;;) {
        const bool has_next = S.next(ui + 1, nxt);
        const char* nA = has_next ? nxt.a : cA; const char* nB = has_next ? nxt.b : cB;
        for (int t = 0; t < nt; t += 2) {
            const bool last = (t == nt - 2);
            const char* a1 = cA + (size_t)(t + 1) * kstep;
            const char* a2 = last ? nA : cA + (size_t)(t + 2) * kstep; const char* b2 = last ? nB : cB + (size_t)(t + 2) * kstep;
            const char* a3 = a2 + kstep; const char* b3 = b2 + kstep;
            PG8_LDB(B0, 0, 0); PG8_LDB(B1, 0, 1); PG8_SCHED; PG8_LDA(At, 0, 0); PG8_STAGE(PG8_SA(1, 1), a1 + hstepA, voffA);
            PG8_WAIT_V(8); PG8_WAIT_L(0); PG8_BAR; PG8_MMA(0, 0, At, B0); PG8_MMA(0, 1, At, B1); PG8_BAR; PG8_SCHED;
            PG8_LDA(At, 0, 1); PG8_STAGE(PG8_SB(0, 0), b2, voffB); PG8_STAGE(PG8_SB(0, 1), b2 + hstepB, voffB); PG8_STAGE(PG8_SA(0, 0), a2, voffA);
            PG8_WAIT_V(8); PG8_WAIT_L(0); PG8_BAR; PG8_MMA(1, 0, At, B0); PG8_MMA(1, 1, At, B1); PG8_BAR; PG8_SCHED;
            PG8_LDB(B0, 1, 0); PG8_LDB(B1, 1, 1); PG8_SCHED; PG8_LDA(At, 1, 0); PG8_STAGE(PG8_SA(0, 1), a2 + hstepA, voffA);
            PG8_WAIT_V(8); PG8_WAIT_L(0); PG8_BAR; PG8_MMA(0, 0, At, B0); PG8_MMA(0, 1, At, B1); PG8_BAR; PG8_SCHED;
            PG8_LDA(At, 1, 1); PG8_STAGE(PG8_SB(1, 0), b3, voffB); PG8_STAGE(PG8_SB(1, 1), b3 + hstepB, voffB); PG8_STAGE(PG8_SA(1, 0), a3, voffA);
            PG8_WAIT_V(8); PG8_WAIT_L(0); PG8_BAR; PG8_MMA(1, 0, At, B0); PG8_MMA(1, 1, At, B1); PG8_BAR; PG8_SCHED;
        }
        if (wr == 0) PG8_BAR;
        { const int el = my_lane(); E(acc, cur, wr, wc, el & 15, el >> 4); }
        if (!has_next) break;
#pragma unroll
        for (int a = 0; a < 2; ++a)
#pragma unroll
            for (int b = 0; b < 2; ++b)
#pragma unroll
                for (int m = 0; m < 4; ++m)
#pragma unroll
                    for (int n = 0; n < 2; ++n) acc[a][b][m][n] = (f32x4){0.f, 0.f, 0.f, 0.f};
        cur = nxt; cA = nA; cB = nB; ++ui;
        if (wr == 1) PG8_BAR;
    }
    PG8_WAIT_V(0);
    PG8_BAR;
#undef PG8_SA
#undef PG8_SB
#undef PG8_STAGE
#undef PG8_LDA
#undef PG8_LDB
#undef PG8_MMA
#undef PG8_WAIT_V
#undef PG8_WAIT_L
#undef PG8_BAR
#undef PG8_SCHED
}
}
using pg8::Unit;

DI unsigned cvt_pk_bf16(float lo, float hi) { unsigned r; asm volatile("v_cvt_pk_bf16_f32 %0, %1, %2" : "=v"(r) : "v"(lo), "v"(hi)); return r; }
DI u32x4 pack8(const f32x4& v0, const f32x4& v1) { u32x4 w; w.x = cvt_pk_bf16(v0[0], v0[1]); w.y = cvt_pk_bf16(v0[2], v0[3]); w.z = cvt_pk_bf16(v1[0], v1[1]); w.w = cvt_pk_bf16(v1[2], v1[3]); return w; }

struct SchedP1 {
    const char* A; const char* B; int G, c;
    DI bool next(int i, Unit& u) const {
        constexpr int nM = 128, nN = 26, nwg = nM * nN, NXCD = 8, WGM = 8;
        const long L = (long)i * G + c; if (L >= nwg) return false;
        int wgid = (int)L; { const int q = nwg / NXCD, r = nwg % NXCD, xcd = wgid % NXCD, off = wgid / NXCD; wgid = (xcd < r ? xcd * (q + 1) : r * (q + 1) + (xcd - r) * q) + off; }
        const int nig = WGM * nN, gid = wgid / nig, fm = gid * WGM, gsz = (nM - fm) < WGM ? (nM - fm) : WGM;
        u.pm = fm + ((wgid % nig) % gsz); u.pn = (wgid % nig) / gsz; u.aux = 0; u.pad = 0;
        u.a = A + (size_t)u.pm * 256 * 1024 * 2; u.b = B + (size_t)u.pn * 256 * 1024 * 2; return true;
    }
};
struct SchedP3a {
    const char* ys; const char* wbr; int G, c;
    DI bool next(int i, Unit& u) const {
        const int tile = (i >> 2) * G + c; if (tile >= 512) return false;
        const int br = i & 3; u.pm = tile >> 2; u.pn = tile & 3; u.aux = br; u.pad = 0;
        u.a = ys + ((size_t)u.pm * 256 * 1024 + br * 256) * 2; u.b = wbr + ((size_t)br * 1024 * 256 + (size_t)u.pn * 256 * 256) * 2; return true;
    }
};
struct SchedP3b {
    const char* A; const char* B; int G, c;
    DI bool next(int i, Unit& u) const {
        const int L = i * G + c; if (L >= 512) return false;
        u.pm = L >> 2; u.pn = L & 3; u.aux = 0; u.pad = 0;
        u.a = A + (size_t)u.pm * 256 * 1024 * 2; u.b = B + (size_t)u.pn * 256 * 1024 * 2; return true;
    }
};
struct SchedM2 {
    const char* xs; const char* wgu; const LAS int* offt; int G, c;
    DI bool next(int i, Unit& u) const {
        const int NT = __builtin_amdgcn_readfirstlane(offt[32]) >> 8; const int L = i * G + c; if (L >= NT * 2) return false;
        const int rt = L >> 1, pn = L & 1; const int e = __builtin_amdgcn_readfirstlane(offt[40 + rt]);
        u.pm = rt; u.pn = pn; u.aux = e; u.pad = 0;
        u.a = xs + (size_t)rt * 256 * 1024 * 2; u.b = wgu + ((size_t)e * 512 + pn * 256) * 1024 * 2; return true;
    }
};
struct SchedM3 {
    const char* hmid; const char* wd; const LAS int* offt; int G, c;
    DI bool next(int i, Unit& u) const {
        const int NT = __builtin_amdgcn_readfirstlane(offt[32]) >> 8; const int L = i * G + c; if (L >= NT * 4) return false;
        const int rt = L >> 2, pn = L & 3; const int e = __builtin_amdgcn_readfirstlane(offt[40 + rt]);
        u.pm = rt; u.pn = pn; u.aux = e; u.pad = 0;
        u.a = hmid + (size_t)rt * 256 * 256 * 2; u.b = wd + ((size_t)e * 1024 + pn * 256) * 256 * 2; return true;
    }
};

struct EpiP1 {
    bf16* proj; bf16* gates; const float* bgate;
    DI void operator()(const f32x4 (&acc)[2][2][4][2], const Unit& u, int wr, int wc, int fr, int fq) const {
        const int row0 = u.pm * 256 + wr * 64 + fr; const int colt = u.pn * 256 + wc * 32 + 8 * fq;
        if (u.pn < 10) {
#pragma unroll
            for (int ai = 0; ai < 2; ++ai)
#pragma unroll
                for (int m = 0; m < 4; ++m) { bf16* rowp = proj + (size_t)(row0 + ai * 128 + m * 16) * PLD + colt;
#pragma unroll
                    for (int bj = 0; bj < 2; ++bj) *(u32x4*)(rowp + bj * 128) = pack8(acc[ai][bj][m][0], acc[ai][bj][m][1]); }
        } else {
            const int gcol = colt - 2560;
            f32x4 bv[2][2];
#pragma unroll
            for (int bj = 0; bj < 2; ++bj)
#pragma unroll
                for (int n = 0; n < 2; ++n) bv[bj][n] = *(const f32x4*)(bgate + gcol + bj * 128 + 4 * n);
#pragma unroll
            for (int ai = 0; ai < 2; ++ai)
#pragma unroll
                for (int m = 0; m < 4; ++m) { bf16* rowp = gates + (size_t)(row0 + ai * 128 + m * 16) * GLD + gcol;
#pragma unroll
                    for (int bj = 0; bj < 2; ++bj) { f32x4 v0 = acc[ai][bj][m][0] + bv[bj][0], v1 = acc[ai][bj][m][1] + bv[bj][1];
#pragma unroll
                        for (int e = 0; e < 4; ++e) { v0[e] = sigmoidf_(v0[e]); v1[e] = sigmoidf_(v1[e]); }
                        *(u32x4*)(rowp + bj * 128) = pack8(v0, v1); }
                    __builtin_amdgcn_sched_barrier(0); }
        }
    }
};
struct EpiP3a {
    bf16* merged; const bf16* gates;
    DI void operator()(const f32x4 (&acc)[2][2][4][2], const Unit& u, int wr, int wc, int fr, int fq) const {
        const int row0 = u.pm * 256 + wr * 64 + fr; const int colt = u.pn * 256 + wc * 32 + 8 * fq; const int br = u.aux;
#pragma unroll
        for (int ai = 0; ai < 2; ++ai)
#pragma unroll
            for (int m = 0; m < 4; ++m) { const size_t row = (size_t)(row0 + ai * 128 + m * 16);
#pragma unroll
                for (int bj = 0; bj < 2; ++bj) {
                    const u32x4 gw = *(const u32x4*)(gates + row * GLD + br * 1024 + colt + bj * 128);
                    bf16* mp = merged + row * 1024 + colt + bj * 128;
                    f32x4 v0 = acc[ai][bj][m][0], v1 = acc[ai][bj][m][1];
                    v0[0] *= lo_bf(gw.x); v0[1] *= hi_bf(gw.x); v0[2] *= lo_bf(gw.y); v0[3] *= hi_bf(gw.y);
                    v1[0] *= lo_bf(gw.z); v1[1] *= hi_bf(gw.z); v1[2] *= lo_bf(gw.w); v1[3] *= hi_bf(gw.w);
                    if (br != 0) { const u32x4 mw = *(const u32x4*)mp;
                        v0[0] += lo_bf(mw.x); v0[1] += hi_bf(mw.x); v0[2] += lo_bf(mw.y); v0[3] += hi_bf(mw.y);
                        v1[0] += lo_bf(mw.z); v1[1] += hi_bf(mw.z); v1[2] += lo_bf(mw.w); v1[3] += hi_bf(mw.w); }
                    *(u32x4*)mp = pack8(v0, v1); }
                __builtin_amdgcn_sched_barrier(0); }
    }
};
struct EpiP3b {
    const float* xin; float* out;
    DI void operator()(const f32x4 (&acc)[2][2][4][2], const Unit& u, int wr, int wc, int fr, int fq) const {
        const int row0 = u.pm * 256 + wr * 64 + fr; const int colt = u.pn * 256 + wc * 32 + 8 * fq;
#pragma unroll
        for (int ai = 0; ai < 2; ++ai)
#pragma unroll
            for (int m = 0; m < 4; ++m) { const size_t off = (size_t)(row0 + ai * 128 + m * 16) * 1024 + colt;
#pragma unroll
                for (int bj = 0; bj < 2; ++bj)
#pragma unroll
                    for (int n = 0; n < 2; ++n) { const f32x4 xv = *(const f32x4*)(xin + off + bj * 128 + 4 * n); *(f32x4*)(out + off + bj * 128 + 4 * n) = xv + acc[ai][bj][m][n]; }
                __builtin_amdgcn_sched_barrier(0); }
    }
};
struct EpiM2 {
    bf16* hmid;
    DI void operator()(const f32x4 (&acc)[2][2][4][2], const Unit& u, int wr, int wc, int fr, int fq) const {
        const int row0 = u.pm * 256 + wr * 64 + fr; const int col = u.pn * 128 + wc * 32 + 8 * fq;
#pragma unroll
        for (int ai = 0; ai < 2; ++ai)
#pragma unroll
            for (int m = 0; m < 4; ++m) { f32x4 h0, h1;
#pragma unroll
                for (int e = 0; e < 4; ++e) { const float g0 = acc[ai][0][m][0][e], g1 = acc[ai][0][m][1][e];
                    h0[e] = g0 * sigmoidf_(g0) * acc[ai][1][m][0][e]; h1[e] = g1 * sigmoidf_(g1) * acc[ai][1][m][1][e]; }
                *(u32x4*)(hmid + (size_t)(row0 + ai * 128 + m * 16) * 256 + col) = pack8(h0, h1); }
    }
};
struct EpiM3 {
    bf16* eo; const int* rowtok; const float* roww;
    DI void operator()(const f32x4 (&acc)[2][2][4][2], const Unit& u, int wr, int wc, int fr, int fq) const {
        const int row0 = u.pm * 256 + wr * 64 + fr; const int colt = u.pn * 256 + wc * 32 + 8 * fq;
#pragma unroll
        for (int ai = 0; ai < 2; ++ai)
#pragma unroll
            for (int m = 0; m < 4; ++m) { const int row = row0 + ai * 128 + m * 16; const int tk = rowtok[row];
                if (tk >= 0) { const float w = roww[row]; bf16* op = eo + (size_t)tk * 1024 + colt;
#pragma unroll
                    for (int bj = 0; bj < 2; ++bj) *(u32x4*)(op + bj * 128) = pack8(acc[ai][bj][m][0] * w, acc[ai][bj][m][1] * w); }
                __builtin_amdgcn_sched_barrier(0); }
    }
};

struct Args { const float* in[36]; float* out; unsigned char* ws; int ph_lo, ph_hi; };
struct InTab { unsigned base;
    DI const float* operator[](int i) const { unsigned long long v; const unsigned addr = base + (unsigned)i * 8u;
        asm volatile("ds_read_b64 %0, %1\n\ts_waitcnt lgkmcnt(0)" : "=v"(v) : "v"(addr) : "memory");
        const unsigned lo = __builtin_amdgcn_readfirstlane((unsigned)v), hi = __builtin_amdgcn_readfirstlane((unsigned)(v >> 32));
        return (const float*)(((unsigned long long)hi << 32) | lo); } };
struct KA { InTab in; float* out; unsigned char* ws; };

DI void transpose_item(const float* W, int ldw, int nvalid, bf16* WT, int ldt, int k0, int n0, int dst_row0, LAS float* scr, int lane) {
    const bool nok = (n0 + (lane & 31)) < nvalid;
#pragma unroll 8
    for (int i = 0; i < 32; ++i) { const int kk = 2 * i + (lane >> 5); scr[kk * 33 + (lane & 31)] = nok ? W[(size_t)(k0 + kk) * ldw + n0 + (lane & 31)] : 0.f; }
    LDS_WAIT(); asm volatile("" ::: "memory");
    const int c = lane & 7;
#pragma unroll
    for (int j = 0; j < 4; ++j) { const int n = (lane >> 3) + 8 * j; const LAS float* s = scr + (8 * c) * 33 + n;
        u32x4 o; o.x = pk2(s[0 * 33], s[1 * 33]); o.y = pk2(s[2 * 33], s[3 * 33]); o.z = pk2(s[4 * 33], s[5 * 33]); o.w = pk2(s[6 * 33], s[7 * 33]);
        if (n0 + n < nvalid) *(u32x4*)(WT + (size_t)(dst_row0 + n) * ldt + k0 + 8 * c) = o; }
    LDS_WAIT(); asm volatile("" ::: "memory");
}
DI void phase0_weights(const KA& a, int l, LAS unsigned char* lds, int gw, int NGW, int wave, int lane) {
    LAS float* scr = (LAS float*)(lds + wave * 16384);
    const float* w_in = a.in[4] + (size_t)l * 1024 * NIN;
    const float* w_gate = a.in[24] + (size_t)l * 4 * 1024 * 1024;
    const float* w_br = a.in[26] + (size_t)l * 4 * 256 * 1024;
    const float* w_out = a.in[27] + (size_t)l * 1024 * 1024;
    bf16* Wt_in = (bf16*)(a.ws + WS_WIN); bf16* Wt_br = (bf16*)(a.ws + WS_WBR); bf16* Wt_out = (bf16*)(a.ws + WS_WOUT);
    constexpr int I_IN = 16 * 77, I_G = 4 * 16 * 32, I_B = 4 * 4 * 32, I_O = 16 * 32, NIT = I_IN + I_G + I_B + I_O;
    for (int it = gw; it < NIT; it += NGW) {
        int r = it;
        if (r < I_IN) { const int kb = r / 77, nb = r % 77; transpose_item(w_in, NIN, NIN, Wt_in, 1024, kb * 64, nb * 32, nb * 32, scr, lane); continue; } r -= I_IN;
        if (r < I_G) { const int br = r / 512, q = r % 512, kb = q / 32, nb = q % 32; transpose_item(w_gate + (size_t)br * 1024 * 1024, 1024, 1024, Wt_in, 1024, kb * 64, nb * 32, 2560 + br * 1024 + nb * 32, scr, lane); continue; } r -= I_G;
        if (r < I_B) { const int br = r / 128, q = r % 128, kb = q / 32, nb = q % 32; transpose_item(w_br + (size_t)br * 256 * 1024, 1024, 1024, Wt_br + (size_t)br * 1024 * 256, 256, kb * 64, nb * 32, nb * 32, scr, lane); continue; } r -= I_B;
        { const int kb = r / 32, nb = r % 32; transpose_item(w_out, 1024, 1024, Wt_out, 1024, kb * 64, nb * 32, nb * 32, scr, lane); }
    }
}
DI void phase0_rows(const KA& a, int l, int mode, int gw, int NGW, int lane) {
    const float* xin = (l == 0) ? a.in[0] : a.out;
    const bf16* eo = (const bf16*)(a.ws + WS_PROJ);
    bf16* hb = (bf16*)(a.ws + WS_HB);
    const float* g = mode ? a.in[2] : (a.in[3] + (size_t)l * 1024);
    for (int m = gw; m < T; m += NGW) {
        f32x4 v[4]; float ss = 0.f;
#pragma unroll
        for (int j = 0; j < 4; ++j) { v[j] = *(const f32x4*)(xin + (size_t)m * 1024 + 4 * (lane + 64 * j));
            if (l > 0) {
                const u32x2 e0 = *(const u32x2*)(eo + (size_t)(2 * m) * 1024 + 4 * (lane + 64 * j));
                const u32x2 e1 = *(const u32x2*)(eo + (size_t)(2 * m + 1) * 1024 + 4 * (lane + 64 * j));
                v[j][0] += lo_bf(e0.x) + lo_bf(e1.x); v[j][1] += hi_bf(e0.x) + hi_bf(e1.x); v[j][2] += lo_bf(e0.y) + lo_bf(e1.y); v[j][3] += hi_bf(e0.y) + hi_bf(e1.y);
            }
            ss += (v[j][0] * v[j][0] + v[j][1] * v[j][1]) + (v[j][2] * v[j][2] + v[j][3] * v[j][3]); }
        const float r = 1.f / sqrtf(wave_sum(ss) * (1.f / 1024.f) + 1e-6f);
#pragma unroll
        for (int j = 0; j < 4; ++j) { const f32x4 gv = *(const f32x4*)(g + 4 * (lane + 64 * j)); const f32x4 y = v[j] * r * gv;
            if (mode) *(f32x4*)(a.out + (size_t)m * 1024 + 4 * (lane + 64 * j)) = y;
            else { if (l > 0) *(f32x4*)(a.out + (size_t)m * 1024 + 4 * (lane + 64 * j)) = v[j];
                   u32x2 w; w.x = pk2(y[0], y[1]); w.y = pk2(y[2], y[3]); *(u32x2*)(hb + (size_t)m * 1024 + 4 * (lane + 64 * j)) = w; } }
    }
}

DI void lru_task(const KA& a, int l, const bf16* proj, bf16* ys, float* sums, int task, int lane, bool final) {
    const int chunk = task & 31, hbk = (task >> 5) & 3, b = task >> 7; const int c = hbk * 64 + lane;
    const float* w_a = a.in[7] + ((size_t)l * 4 + hbk) * 4096; const float* w_x = a.in[9] + ((size_t)l * 4 + hbk) * 4096;
    float wa[64], wx[64];
#pragma unroll
    for (int i = 0; i < 64; ++i) { wa[i] = w_a[i * 64 + lane]; wx[i] = w_x[i * 64 + lane]; }
    const float* cw = a.in[5] + (size_t)l * 4 * 256;
    const float cw0 = cw[c], cw1 = cw[256 + c], cw2 = cw[512 + c], cw3 = cw[768 + c];
    const float cb = a.in[6][l * 256 + c], ba = a.in[8][l * 256 + c], bx = a.in[10][l * 256 + c];
    const float c8 = -8.f * softplusf_(-a.in[11][l * 256 + c]);
    const int t0 = chunk * 256; const size_t rowb = (size_t)b * SEQ;
    float x3 = (t0 >= 3) ? bf2f(proj[(rowb + t0 - 3) * PLD + C_AX + c]) : 0.f;
    float x2 = (t0 >= 2) ? bf2f(proj[(rowb + t0 - 2) * PLD + C_AX + c]) : 0.f;
    float x1 = (t0 >= 1) ? bf2f(proj[(rowb + t0 - 1) * PLD + C_AX + c]) : 0.f;
    float h = 0.f, Ap = 1.f;
    if (final) { for (int cc = 0; cc < chunk; ++cc) { const float* sp = sums + ((size_t)((b * 4 + hbk) * 32 + cc) * 64 + lane) * 2; h = sp[0] * h + sp[1]; } }
    for (int t = t0; t < t0 + 256; ++t) {
        const float x0 = bf2f(proj[(rowb + t) * PLD + C_AX + c]);
        const float xc = cb + cw0 * x3 + cw1 * x2 + cw2 * x1 + cw3 * x0;
        float ra = ba, rx = bx;
#pragma unroll
        for (int i = 0; i < 64; ++i) { const float s = rl(xc, i); ra += s * wa[i]; rx += s * wx[i]; }
        const float r = sigmoidf_(ra), ig = sigmoidf_(rx);
        const float la = c8 * r; const float av = __expf(la);
        const float mult = (t == 0) ? 1.f : sqrtf(fmaxf(1.f - __expf(2.f * la), 0.f));
        const float bb = mult * ig * xc;
        h = av * h + bb; Ap *= av;
        if (final) { const float gt = bf2f(proj[(rowb + t) * PLD + C_AG + c]); ys[(rowb + t) * 1024 + c] = (bf16)f2bf(h * gelu_tanh(gt)); }
        x3 = x2; x2 = x1; x1 = x0;
    }
    if (!final) { float* sp = sums + ((size_t)((b * 4 + hbk) * 32 + chunk) * 64 + lane) * 2; sp[0] = Ap; sp[1] = h; }
}

template <int NH>
DI void dot_row64(const bf16* krow, const LAS float* qs, float (&acc)[NH]) {
#pragma unroll
    for (int h = 0; h < NH; ++h) acc[h] = 0.f;
#pragma unroll 1
    for (int c8 = 0; c8 < 8; ++c8) {
        const u32x4 w = *(const u32x4*)(krow + c8 * 8);
        const float k0 = lo_bf(w.x), k1 = hi_bf(w.x), k2 = lo_bf(w.y), k3 = hi_bf(w.y), k4 = lo_bf(w.z), k5 = hi_bf(w.z), k6 = lo_bf(w.w), k7 = hi_bf(w.w);
#pragma unroll
        for (int h = 0; h < NH; ++h) { const f32x4 qa = *(const LAS f32x4*)(qs + h * 64 + c8 * 8), qb = *(const LAS f32x4*)(qs + h * 64 + c8 * 8 + 4);
            acc[h] += qa[0] * k0; acc[h] += qa[1] * k1; acc[h] += qa[2] * k2; acc[h] += qa[3] * k3;
            acc[h] += qb[0] * k4; acc[h] += qb[1] * k5; acc[h] += qb[2] * k6; acc[h] += qb[3] * k7; } }
}
template <int NH>
DI void dot_row64_f32(const float* krow, const LAS float* qs, float (&acc)[NH]) {
#pragma unroll
    for (int h = 0; h < NH; ++h) acc[h] = 0.f;
#pragma unroll 1
    for (int d8 = 0; d8 < 8; ++d8) {
        const f32x4 ka = *(const f32x4*)(krow + d8 * 8), kb = *(const f32x4*)(krow + d8 * 8 + 4);
#pragma unroll
        for (int h = 0; h < NH; ++h) { const f32x4 qa = *(const LAS f32x4*)(qs + h * 64 + d8 * 8), qb = *(const LAS f32x4*)(qs + h * 64 + d8 * 8 + 4);
            acc[h] += qa[0] * ka[0]; acc[h] += qa[1] * ka[1]; acc[h] += qa[2] * ka[2]; acc[h] += qa[3] * ka[3];
            acc[h] += qb[0] * kb[0]; acc[h] += qb[1] * kb[1]; acc[h] += qb[2] * kb[2]; acc[h] += qb[3] * kb[3]; } }
}

DI void swa_token(const KA& a, int l, const bf16* proj, bf16* ys, const LAS float* biasd, LAS float* qs, int tok, int lane) {
    const int b = tok / SEQ, t = tok % SEQ; const size_t rowb = (size_t)b * SEQ;
#pragma unroll
    for (int h = 0; h < 4; ++h) qs[h * 64 + lane] = bf2f(proj[(size_t)tok * PLD + C_BQ + h * 64 + lane]) * 0.125f;
    LDS_WAIT();
#pragma unroll
    for (int g = 0; g < 2; ++g) {
        float s[2][2]; int ktok[2];
#pragma unroll
        for (int j = 0; j < 2; ++j) { const int dist = 64 * j + lane; const int kpos = t - dist; const bool valid = kpos >= 0; const int kp = valid ? kpos : 0; ktok[j] = (int)rowb + kp;
            float acc[2]; dot_row64<2>(proj + (size_t)ktok[j] * PLD + C_BK + g * 64, qs + g * 128, acc);
#pragma unroll
            for (int i = 0; i < 2; ++i) s[i][j] = valid ? acc[i] + biasd[dist * 12 + 2 * g + i] : -1e30f; }
        float o[2] = {0.f, 0.f};
#pragma unroll
        for (int i = 0; i < 2; ++i) { const float sink = a.in[12][l * 4 + 2 * g + i];
            float mx = fmaxf(wave_max(fmaxf(s[i][0], s[i][1])), sink);
            const float p0 = (s[i][0] > -1e29f) ? __expf(s[i][0] - mx) : 0.f, p1 = (s[i][1] > -1e29f) ? __expf(s[i][1] - mx) : 0.f;
            const float den = wave_sum(p0 + p1) + __expf(sink - mx); const float inv = 1.f / fmaxf(den, 1e-30f);
            s[i][0] = p0 * inv; s[i][1] = p1 * inv; }
#pragma unroll
        for (int j = 0; j < 2; ++j) {
#pragma unroll 4
            for (int kl = 0; kl < 64; ++kl) { const int kpos = t - (64 * j + kl); if (kpos < 0) break;
                const float vv = bf2f(proj[(rowb + kpos) * PLD + C_BV + g * 64 + lane]);
                o[0] += rl(s[0][j], kl) * vv; o[1] += rl(s[1][j], kl) * vv; } }
#pragma unroll
        for (int i = 0; i < 2; ++i) ys[(size_t)tok * 1024 + 256 + (2 * g + i) * 64 + lane] = (bf16)f2bf(o[i]);
    }
}

DI void diff_task(const KA& a, int l, const bf16* proj, bf16* ys, const LAS float* biasd, float lam, float lam_init, int task, int lane) {
    const int qg = task >> 4, bh = task & 15, b = bh >> 2, h = bh & 3; const int mp = lane >> 5; const int q = qg * 32 + (lane & 31);
    const size_t rowb = (size_t)b * SEQ; const size_t tok = rowb + q;
    const float scale = 0.17677669529663687f;
    float qr[32];
    { const bf16* qp = proj + tok * PLD + C_CQ + h * 64 + mp * 32;
#pragma unroll
      for (int c = 0; c < 4; ++c) { const u32x4 w = *(const u32x4*)(qp + c * 8);
        qr[c * 8 + 0] = lo_bf(w.x) * scale; qr[c * 8 + 1] = hi_bf(w.x) * scale; qr[c * 8 + 2] = lo_bf(w.y) * scale; qr[c * 8 + 3] = hi_bf(w.y) * scale;
        qr[c * 8 + 4] = lo_bf(w.z) * scale; qr[c * 8 + 5] = hi_bf(w.z) * scale; qr[c * 8 + 6] = lo_bf(w.w) * scale; qr[c * 8 + 7] = hi_bf(w.w) * scale; } }
    float o[64];
#pragma unroll
    for (int d = 0; d < 64; ++d) o[d] = 0.f;
    float mrun = -1e30f, lrun = 0.f;
    const int kend = qg * 32 + 31;
    for (int k = 0; k <= kend; ++k) {
        const bf16* kp = proj + (rowb + k) * PLD + C_CK + h * 64 + mp * 32;
        float s = 0.f;
#pragma unroll
        for (int c = 0; c < 4; ++c) { const u32x4 w = *(const u32x4*)(kp + c * 8);
            s += qr[c * 8 + 0] * lo_bf(w.x); s += qr[c * 8 + 1] * hi_bf(w.x); s += qr[c * 8 + 2] * lo_bf(w.y); s += qr[c * 8 + 3] * hi_bf(w.y);
            s += qr[c * 8 + 4] * lo_bf(w.z); s += qr[c * 8 + 5] * hi_bf(w.z); s += qr[c * 8 + 6] * lo_bf(w.w); s += qr[c * 8 + 7] * hi_bf(w.w); }
        const int dist = q - k; const bool valid = dist >= 0; const int di = valid ? (dist < 128 ? dist : 128) : 0;
        s += biasd[di * 12 + 4 + h];
        if (valid && s > mrun) { const float al = __expf(mrun - s); lrun *= al;
#pragma unroll
            for (int d = 0; d < 64; ++d) o[d] *= al;
            mrun = s; }
        const float p = valid ? __expf(s - mrun) : 0.f; lrun += p;
        const bf16* vp = proj + (rowb + k) * PLD + C_CV + h * 64;
#pragma unroll
        for (int c = 0; c < 8; ++c) { const u32x4 w = *(const u32x4*)(vp + c * 8);
            o[c * 8 + 0] += p * lo_bf(w.x); o[c * 8 + 1] += p * hi_bf(w.x); o[c * 8 + 2] += p * lo_bf(w.y); o[c * 8 + 3] += p * hi_bf(w.y);
            o[c * 8 + 4] += p * lo_bf(w.z); o[c * 8 + 5] += p * hi_bf(w.z); o[c * 8 + 6] += p * lo_bf(w.w); o[c * 8 + 7] += p * hi_bf(w.w); }
    }
    const float inv = 1.f / fmaxf(lrun, 1e-30f);
    float ss = 0.f;
#pragma unroll
    for (int d = 0; d < 64; ++d) { const float mine = o[d] * inv; const float other = xshfl<32>(mine); const float at = mine - lam * other; o[d] = at; ss += at * at; }
    const float r = 1.f / sqrtf(ss * (1.f / 64.f) + 1e-5f) * (1.f - lam_init);
    if (mp == 0) { const float* sg = a.in[17] + l * 64; bf16* op = ys + tok * 1024 + 512 + h * 64;
#pragma unroll
        for (int c = 0; c < 8; ++c) { u32x4 w; w.x = pk2(o[c * 8 + 0] * r * sg[c * 8 + 0], o[c * 8 + 1] * r * sg[c * 8 + 1]); w.y = pk2(o[c * 8 + 2] * r * sg[c * 8 + 2], o[c * 8 + 3] * r * sg[c * 8 + 3]);
            w.z = pk2(o[c * 8 + 4] * r * sg[c * 8 + 4], o[c * 8 + 5] * r * sg[c * 8 + 5]); w.w = pk2(o[c * 8 + 6] * r * sg[c * 8 + 6], o[c * 8 + 7] * r * sg[c * 8 + 7]); *(u32x4*)(op + c * 8) = w; } }
}

DI void cmp_task(const KA& a, int l, const bf16* proj, float* kcvc, int task, int lane) {
    const int kv = task / (BATCH * NCMP), r = task % (BATCH * NCMP), b = r / NCMP, c = r % NCMP;
    const float* pos = a.in[kv ? 21 : 18] + (size_t)l * 2048; const float* w1 = a.in[kv ? 22 : 19] + (size_t)l * 2048 * 64; const float* w2 = a.in[kv ? 23 : 20] + (size_t)l * 4096;
    const size_t tokb = (size_t)b * SEQ + 16 * c; const int col0 = kv ? C_VC : C_KC;
    float h1 = 0.f;
    for (int li = 0; li < 32; ++li) { const float v = bf2f(proj[(tokb + li) * PLD + col0 + lane]) + pos[li * 64 + lane]; const float* wr = w1 + (size_t)(li * 64) * 64 + lane;
#pragma unroll
        for (int d = 0; d < 64; ++d) h1 += rl(v, d) * wr[d * 64]; }
    const float g = gelu_tanh(h1); float o = 0.f;
#pragma unroll
    for (int j = 0; j < 64; ++j) o += rl(g, j) * w2[j * 64 + lane];
    kcvc[((size_t)(kv * BATCH + b) * NCMP + c) * 64 + lane] = o;
}

DI void attn_block4(const bf16* proj, int keytok, bool valid, int dist, int kcol, int vcol, const LAS float* biasd, const LAS float* qs, float (&m)[4], float (&lsum)[4], float (&o)[4], int lane) {
    float acc[4]; dot_row64<4>(proj + (size_t)keytok * PLD + kcol, qs, acc);
    const int di = valid ? (dist < 128 ? dist : 128) : 0; float p[4];
#pragma unroll
    for (int h = 0; h < 4; ++h) { const float s = valid ? acc[h] + biasd[di * 12 + 8 + h] : -1e30f;
        const float bm = wave_max(s); const float mn = fmaxf(m[h], bm); const float al = __expf(m[h] - mn);
        p[h] = valid ? __expf(s - mn) : 0.f; lsum[h] = lsum[h] * al + wave_sum(p[h]); o[h] *= al; m[h] = mn; }
    const bf16* vb = proj + vcol + lane;
#pragma unroll 2
    for (int kl = 0; kl < 64; ++kl) { const int vt = rli(keytok, kl); const float vv = bf2f(vb[(size_t)vt * PLD]);
#pragma unroll
        for (int h = 0; h < 4; ++h) o[h] += rl(p[h], kl) * vv; }
}

DI void nsa_token(const KA& a, int l, const bf16* proj, bf16* ys, const float* kcvc, const LAS float* biasd, LAS float* wl, int tok, int lane) {
    LAS float* ps = wl; LAS float* qs = wl + 512; LAS float* scl = wl + 768; LAS int* sell = (LAS int*)(wl + 768 + 2048);
    const int b = tok / SEQ, t = tok % SEQ; const size_t rowb = (size_t)b * SEQ; const bf16* prow = proj + (size_t)tok * PLD;
#pragma unroll
    for (int h = 0; h < 4; ++h) qs[h * 64 + lane] = bf2f(prow[C_DQ + h * 64 + lane]) * 0.125f;
    LDS_WAIT(); asm volatile("" ::: "memory");
    const int ncv = (t >= 31) ? (((t - 31) >> 4) + 1 < NCMP ? ((t - 31) >> 4) + 1 : NCMP) : 0;
    const float* kc = kcvc + (size_t)(0 * BATCH + b) * NCMP * 64; const float* vc = kcvc + (size_t)(1 * BATCH + b) * NCMP * 64;
    float mx[4] = {-1e30f, -1e30f, -1e30f, -1e30f};
#pragma unroll 1
    for (int jc = 0; jc * 64 < ncv; ++jc) { const int c = jc * 64 + lane; const bool valid = c < ncv; const int cc = c < NCMP ? c : NCMP - 1;
        float acc[4]; dot_row64_f32<4>(kc + (size_t)cc * 64, qs, acc);
        const int dist = t - (16 * c + 31); const int di = valid ? (dist < 128 ? dist : 128) : 0;
#pragma unroll
        for (int h = 0; h < 4; ++h) { const float sv = valid ? acc[h] + biasd[di * 12 + 8 + h] : -1e30f; scl[h * 512 + c] = sv; mx[h] = fmaxf(mx[h], sv); } }
    float sum[4] = {0.f, 0.f, 0.f, 0.f};
#pragma unroll
    for (int h = 0; h < 4; ++h) mx[h] = wave_max(mx[h]);
    asm volatile("" ::: "memory");
#pragma unroll 1
    for (int jc = 0; jc * 64 < ncv; ++jc) { const int c = jc * 64 + lane;
#pragma unroll
        for (int h = 0; h < 4; ++h) { const float sv = scl[h * 512 + c]; const float p = (sv > -1e29f) ? __expf(sv - mx[h]) : 0.f; scl[h * 512 + c] = p; sum[h] += p; } }
#pragma unroll
    for (int h = 0; h < 4; ++h) sum[h] = 1.f / fmaxf(wave_sum(sum[h]), 1e-30f);
    asm volatile("" ::: "memory");
#pragma unroll 1
    for (int jc = 0; jc < 8; ++jc) { const int c = jc * 64 + lane; float tsum = 0.f;
        if (jc * 64 < ncv) {
#pragma unroll
            for (int h = 0; h < 4; ++h) { const float p = scl[h * 512 + c] * sum[h]; scl[h * 512 + c] = p; tsum += p; } }
        ps[c] = tsum; }
    LDS_WAIT(); asm volatile("" ::: "memory");
    float oc[4] = {0.f, 0.f, 0.f, 0.f};
#pragma unroll 2
    for (int c = 0; c < ncv; ++c) { const float vv = vc[(size_t)c * 64 + lane];
#pragma unroll
        for (int h = 0; h < 4; ++h) oc[h] += scl[h * 512 + c] * vv; }
    const int cur = t >> 6;
    float cand[2];
#pragma unroll
    for (int jj = 0; jj < 2; ++jj) { const int j = lane + 64 * jj; const int i0 = 4 * j;
        const float imp = (j > 0 ? ps[i0 - 1] : 0.f) + 2.f * (ps[i0] + ps[i0 + 1] + ps[i0 + 2]) + ps[i0 + 3];
        const bool forced = (j == 0) || (j == cur) || (j == cur - 1);
        cand[jj] = forced ? 1e4f : (j <= cur ? imp : -1.f); }
#pragma unroll 1
    for (int r = 0; r < 16; ++r) {
        float bv = cand[0]; int bi = lane; if (cand[1] > bv) { bv = cand[1]; bi = lane + 64; }
#define TOPK_STEP(O) { const float ov = xshfl<O>(bv); const int oi = xshfl_i<O>(bi); if (ov > bv || (ov == bv && oi < bi)) { bv = ov; bi = oi; } }
        TOPK_STEP(32) TOPK_STEP(16) TOPK_STEP(8) TOPK_STEP(4) TOPK_STEP(2) TOPK_STEP(1)
#undef TOPK_STEP
        bi = __builtin_amdgcn_readfirstlane(bi);
        if (lane == 0) sell[r] = bi;
        if (bi == lane) cand[0] = -3.f; if (bi == lane + 64) cand[1] = -3.f;
    }
    LDS_WAIT(); asm volatile("" ::: "memory");
    float ms[4] = {-1e30f, -1e30f, -1e30f, -1e30f}, ls[4] = {0.f, 0.f, 0.f, 0.f}, os[4] = {0.f, 0.f, 0.f, 0.f};
#pragma unroll 1
    for (int r = 0; r < 16; ++r) { const int j = __builtin_amdgcn_readfirstlane(sell[r]);
        if (j > cur) continue;
        const int kpos = 64 * j + lane; const bool valid = kpos <= t;
        attn_block4(proj, (int)rowb + kpos, valid, t - kpos, C_KS, C_VS, biasd, qs, ms, ls, os, lane); }
    float mw[4] = {-1e30f, -1e30f, -1e30f, -1e30f}, lw[4] = {0.f, 0.f, 0.f, 0.f}, ow[4] = {0.f, 0.f, 0.f, 0.f};
#pragma unroll 1
    for (int jc = 0; jc < 8; ++jc) { if (t - 64 * jc < 0) break;
        const int dist = 64 * jc + lane; const int kpos = t - dist; const bool valid = kpos >= 0;
        attn_block4(proj, (int)rowb + (valid ? kpos : 0), valid, dist, C_KW, C_VW, biasd, qs, mw, lw, ow, lane); }
#pragma unroll
    for (int h = 0; h < 4; ++h) { const float g0 = sigmoidf_(bf2f(prow[C_DG + h * 3 + 0])), g1 = sigmoidf_(bf2f(prow[C_DG + h * 3 + 1])), g2 = sigmoidf_(bf2f(prow[C_DG + h * 3 + 2]));
        const float y = g0 * oc[h] + g1 * os[h] / fmaxf(ls[h], 1e-30f) + g2 * ow[h] / fmaxf(lw[h], 1e-30f);
        ys[(size_t)tok * 1024 + 768 + h * 64 + lane] = (bf16)f2bf(y); }
    asm volatile("" ::: "memory");
}

DI void route_token(const KA& a, int l, bf16* x2b, int* rec_e, int* rec_slot, float* rec_w, unsigned* cnt, int tok, int lane_) {
    int lane = lane_; asm volatile("" : "+v"(lane));
    const float* xr = a.out + (size_t)tok * 1024; const float* g = a.in[28] + (size_t)l * 1024;
    float ss = 0.f;
#pragma unroll
    for (int j = 0; j < 4; ++j) { const f32x4 v = *(const f32x4*)(xr + 4 * (lane + 64 * j)); ss += (v[0] * v[0] + v[1] * v[1]) + (v[2] * v[2] + v[3] * v[3]); }
    const float r = 1.f / sqrtf(wave_sum(ss) * (1.f / 1024.f) + 1e-6f);
    const float* wg = a.in[29] + (size_t)l * 1024 * 4; const float* we = a.in[31] + (size_t)l * 1024 * 32;
    float lg[36];
#pragma unroll
    for (int i = 0; i < 36; ++i) lg[i] = 0.f;
#pragma unroll 1
    for (int j = 0; j < 4; ++j) { const int k0 = 4 * (lane + 64 * j);
        const f32x4 v = *(const f32x4*)(xr + k0); const f32x4 gv = *(const f32x4*)(g + k0); const f32x4 xn = v * r * gv;
        u32x2 w; w.x = pk2(xn[0], xn[1]); w.y = pk2(xn[2], xn[3]); *(u32x2*)(x2b + (size_t)tok * 1024 + k0) = w;
#pragma unroll
        for (int e = 0; e < 4; ++e) { const int k = k0 + e; const float xk = xn[e];
            const f32x4 g4 = *(const f32x4*)(wg + (size_t)k * 4);
            lg[0] += xk * g4[0]; lg[1] += xk * g4[1]; lg[2] += xk * g4[2]; lg[3] += xk * g4[3];
#pragma unroll
            for (int q = 0; q < 8; ++q) { const f32x4 e4 = *(const f32x4*)(we + (size_t)k * 32 + q * 4);
                lg[4 + q * 4 + 0] += xk * e4[0]; lg[4 + q * 4 + 1] += xk * e4[1]; lg[4 + q * 4 + 2] += xk * e4[2]; lg[4 + q * 4 + 3] += xk * e4[3]; }
            __builtin_amdgcn_sched_barrier(0); } }
#pragma unroll
    for (int i = 0; i < 36; ++i) lg[i] = wave_sum(lg[i]);
    const float* bg = a.in[30] + l * 4; const float* be = a.in[32] + l * 32;
#pragma unroll
    for (int i = 0; i < 4; ++i) lg[i] += bg[i];
#pragma unroll
    for (int i = 0; i < 32; ++i) lg[4 + i] += be[i];
    int gsel = 0; float gm = lg[0];
#pragma unroll
    for (int i = 1; i < 4; ++i) if (lg[i] > gm) { gm = lg[i]; gsel = i; }
    float gs = 0.f;
#pragma unroll
    for (int i = 0; i < 4; ++i) gs += __expf(lg[i] - gm);
    const float gwt = 1.f / gs;
    float v8[8];
#pragma unroll
    for (int i = 0; i < 8; ++i) { float x = lg[4 + i];
#pragma unroll
        for (int gq = 1; gq < 4; ++gq) x = (gsel == gq) ? lg[4 + gq * 8 + i] : x;
        v8[i] = x; }
    int i0 = 0; float m0 = v8[0];
#pragma unroll
    for (int i = 1; i < 8; ++i) if (v8[i] > m0) { m0 = v8[i]; i0 = i; }
    int i1 = -1; float m1 = -3e38f;
#pragma unroll
    for (int i = 0; i < 8; ++i) if (i != i0 && v8[i] > m1) { m1 = v8[i]; i1 = i; }
    const float w0 = 1.f / (1.f + __expf(m1 - m0)); const float w1 = 1.f - w0;
    if (lane == 0) {
        const int e0 = gsel * 8 + i0, e1 = gsel * 8 + i1;
        const unsigned s0 = __hip_atomic_fetch_add(cnt + e0, 1u, __ATOMIC_RELAXED, __HIP_MEMORY_SCOPE_AGENT);
        const unsigned s1 = __hip_atomic_fetch_add(cnt + e1, 1u, __ATOMIC_RELAXED, __HIP_MEMORY_SCOPE_AGENT);
        rec_e[tok * 2] = e0; rec_e[tok * 2 + 1] = e1; rec_slot[tok * 2] = (int)s0; rec_slot[tok * 2 + 1] = (int)s1; rec_w[tok * 2] = w0 * gwt; rec_w[tok * 2 + 1] = w1 * gwt;
    }
}
DI void expert_weights(const KA& a, int l, LAS unsigned char* lds, int gw, int NGW, int wave, int lane) {
    LAS float* scr = (LAS float*)(lds + wave * 16384);
    const float* wgt = a.in[33] + (size_t)l * 32 * 1024 * 256; const float* wup = a.in[34] + (size_t)l * 32 * 1024 * 256; const float* wdn = a.in[35] + (size_t)l * 32 * 256 * 1024;
    bf16* Wgu = (bf16*)(a.ws + WS_WGU); bf16* Wd = (bf16*)(a.ws + WS_WD);
    constexpr int I_E = 16 * 8, I_D = 4 * 32;
    constexpr int NIT = 32 * (2 * I_E + I_D);
    for (int it = gw; it < NIT; it += NGW) {
        const int e = it / (2 * I_E + I_D); int r = it % (2 * I_E + I_D);
        if (r < 2 * I_E) { const int up = r / I_E, q = r % I_E, kb = q / 8, nb = q % 8; const int n0 = nb * 32;
            const int drow = (n0 >> 7) * 256 + up * 128 + (n0 & 127);
            transpose_item((up ? wup : wgt) + (size_t)e * 1024 * 256, 256, 256, Wgu + (size_t)e * 512 * 1024, 1024, kb * 64, n0, drow, scr, lane);
        } else { r -= 2 * I_E; const int kb = r / 32, nb = r % 32;
            transpose_item(wdn + (size_t)e * 256 * 1024, 1024, 1024, Wd + (size_t)e * 1024 * 256, 256, kb * 64, nb * 32, nb * 32, scr, lane); }
    }
}
DI void build_offsets(const unsigned* cnt, LAS int* offt, int tid) {
    if (tid == 0) { int o = 0; for (int e = 0; e < 32; ++e) { offt[e] = o; const int c = (int)__hip_atomic_load(cnt + e, __ATOMIC_RELAXED, __HIP_MEMORY_SCOPE_AGENT); o += (c + 255) & ~255; } offt[32] = o; }
    __syncthreads();
    for (int rt = tid; rt < (MOE_ROWS >> 8); rt += 512) { int e = 0; for (int j = 1; j < 32; ++j) e += (offt[j] <= rt * 256) ? 1 : 0; offt[40 + rt] = e; }
    __syncthreads();
}

template <unsigned PM>
__global__ void __launch_bounds__(512, 2) mk_fwd(Args a_) {
    extern __shared__ __attribute__((aligned(16))) unsigned char lds_raw[];
    LAS unsigned char* lds = (LAS unsigned char*)lds_raw;
    const int wave0 = __builtin_amdgcn_readfirstlane((int)threadIdx.x >> 6);
    if (threadIdx.x < 36) ((LAS unsigned long long*)(lds + PTAB_OFF))[threadIdx.x] = (unsigned long long)a_.in[threadIdx.x];
    __syncthreads();
    KA a; a.in.base = (unsigned)(size_t)(lds + PTAB_OFF); a.out = a_.out; a.ws = a_.ws;
    const int G = gridDim.x, bid = blockIdx.x, NGW = G * 8;
#define PHASE_IDS() int wave = wave0; asm volatile("" : "+s"(wave)); const int lane = my_lane(); const int tid_ = wave * 64 + lane, gw = bid * 8 + wave; (void)tid_; (void)gw; \
    KA ap = a; asm volatile("" : "+s"(ap.ws), "+s"(ap.out), "+s"(ap.in.base)); \
    bf16* hb = (bf16*)(ap.ws + WS_HB); bf16* proj = (bf16*)(ap.ws + WS_PROJ); bf16* gates = (bf16*)(ap.ws + WS_GATES); \
    bf16* ys = hb; bf16* x2b = hb; bf16* merged = proj; bf16* eo = proj; \
    float* kcvc = (float*)(ap.ws + WS_KCVC); float* lrusum = (float*)(ap.ws + WS_LRUSUM); \
    int* rec_e = (int*)(ap.ws + WS_REC); int* rec_slot = rec_e + T * 2; float* rec_w = (float*)(rec_slot + T * 2); \
    int* rowtok = (int*)(ap.ws + WS_ROWTOK); float* roww = (float*)(ap.ws + WS_ROWW); \
    bf16* xs = (bf16*)(ap.ws + WS_XS); bf16* hmid = (bf16*)(ap.ws + WS_HMID); unsigned* ctl = (unsigned*)(ap.ws + WS_CTL); \
    (void)hb; (void)proj; (void)gates; (void)ys; (void)x2b; (void)merged; (void)eo; (void)kcvc; (void)lrusum; (void)rec_e; (void)rec_slot; (void)rec_w; (void)rowtok; (void)roww; (void)xs; (void)hmid; (void)ctl
    volatile LAS unsigned* MISC = (volatile LAS unsigned*)(lds + MISC_OFF);
    LAS float* biasd = (LAS float*)(lds + BIAS_OFF);
    LAS int* offt = (LAS int*)(lds + OFFT_OFF);
    { PHASE_IDS();
    if (tid_ < 64) MISC[tid_] = 0u;
    for (int i = tid_; i < 129 * 12; i += 512) { const int d = i / 12, hd = i % 12; const int bk = d < 128 ? T5_BUCKET[d] : 31; biasd[i] = a.in[1][bk * 12 + hd]; } }
    __syncthreads();
    const int lo = a_.ph_lo, hi = a_.ph_hi;
    XcdBarrier bar; bar.bar = (unsigned*)(a.ws + WS_CTL) + CW_BAR; bar.x = 0; bar.st = nullptr;
    if (hi - lo > 1) { PHASE_IDS(); bar = xcd_barrier_post(ctl + CW_BAR, MISC + 8, tid_ == 0); }
#ifndef SUB_MASK
#define SUB_MASK 0xFFu
#endif
#define SUB(k) ((SUB_MASK >> (k)) & 1u)
#define HASP(k) ((PM >> ((k) % 10 + ((k) >= 20 ? 10 : 0))) & 1u)
#define IN(k) (HASP(k) && lo <= (k) && (k) < hi)
#define SEAM(k) do { if ((k) + 1 < hi) { const int sl_ = my_lane(); int sw_ = wave0; asm volatile("" : "+s"(sw_)); xcd_barrier(bar, sw_ == 0 && sl_ == 0); } } while (0)
    for (int l = 0; l < DEPTH; ++l) {
        const int pb = l * 10;
        if (IN(pb + 0)) { PHASE_IDS(); phase0_weights(ap, l, lds, gw, NGW, wave, lane); phase0_rows(ap, l, 0, gw, NGW, lane); SEAM(pb + 0); }
        if (IN(pb + 1)) {
            PHASE_IDS();
            pg8::Gemm g{1024, 1024, 1024}; SchedP1 S{(const char*)hb, (const char*)(ap.ws + WS_WIN), G, bid};
            EpiP1 E{proj, gates, ap.in[25] + (size_t)l * 4096};
            pg8::gemm_phase<EpiP1, SchedP1>(lds, g, S, E, tid_); SEAM(pb + 1);
        }
        if (IN(pb + 2)) {
            PHASE_IDS();
            float s1 = 0.f, s2 = 0.f;
            for (int i = 0; i < 32; ++i) { s1 += ap.in[13][l * 32 + i] * ap.in[14][l * 32 + i]; s2 += ap.in[15][l * 32 + i] * ap.in[16][l * 32 + i]; }
            const float lam_init = 0.8f - 0.6f * __expf(-0.3f * (float)l); const float lam = __expf(s1) - __expf(s2) + lam_init;
            if (SUB(0)) for (int p = gw; p < 2048; p += NGW) { diff_task(ap, l, proj, ys, biasd, lam, lam_init, 4095 - p, lane); diff_task(ap, l, proj, ys, biasd, lam, lam_init, p, lane); }
            if (SUB(1)) for (int task = gw; task < 512; task += NGW) lru_task(ap, l, proj, ys, lrusum, task, lane, false);
            if (SUB(2)) for (int task = gw; task < 2 * BATCH * NCMP; task += NGW) cmp_task(ap, l, proj, kcvc, task, lane);
            if (SUB(3)) { LAS float* qs = (LAS float*)(lds + wave * 4096); for (int tok = gw; tok < T; tok += NGW) swa_token(ap, l, proj, ys, biasd, qs, tok, lane); }
            SEAM(pb + 2);
        }
        if (IN(pb + 3)) {
            PHASE_IDS();
            if (SUB(1)) for (int task = gw; task < 512; task += NGW) lru_task(ap, l, proj, ys, lrusum, task, lane, true);
            LAS float* ps = (LAS float*)(lds + wave * 12288);
            if (SUB(4)) for (int tok = gw; tok < T; tok += NGW) nsa_token(ap, l, proj, ys, kcvc, biasd, ps, tok, lane);
            SEAM(pb + 3);
        }
        if (IN(pb + 4)) {
            PHASE_IDS();
            pg8::Gemm g{256, 1024, 256}; SchedP3a S{(const char*)ys, (const char*)(ap.ws + WS_WBR), G, bid};
            EpiP3a E{merged, gates};
            pg8::gemm_phase<EpiP3a, SchedP3a>(lds, g, S, E, tid_); SEAM(pb + 4);
        }
        if (IN(pb + 5)) {
            PHASE_IDS();
            pg8::Gemm g{1024, 1024, 1024}; SchedP3b S{(const char*)merged, (const char*)(ap.ws + WS_WOUT), G, bid};
            EpiP3b E{(l == 0) ? ap.in[0] : ap.out, ap.out};
            pg8::gemm_phase<EpiP3b, SchedP3b>(lds, g, S, E, tid_); SEAM(pb + 5);
        }
        if (IN(pb + 6)) {
            PHASE_IDS();
            expert_weights(ap, l, lds, gw, NGW, wave, lane);
            for (int tok = gw; tok < T; tok += NGW) route_token(ap, l, x2b, rec_e, rec_slot, rec_w, ctl + CW_CNT + l * 32, tok, lane);
            SEAM(pb + 6);
        }
        if (IN(pb + 7)) {
            PHASE_IDS();
            build_offsets(ctl + CW_CNT + l * 32, offt, tid_);
            if (bid < 32) { const int e = bid; const int c = (int)__hip_atomic_load(ctl + CW_CNT + l * 32 + e, __ATOMIC_RELAXED, __HIP_MEMORY_SCOPE_AGENT);
                for (int p = offt[e] + c + tid_; p < offt[e + 1]; p += 512) rowtok[p] = -1; }
            for (int tok = gw; tok < T; tok += NGW) {
#pragma unroll
                for (int k = 0; k < 2; ++k) { const int e = rec_e[tok * 2 + k], slot = rec_slot[tok * 2 + k]; const int pos = offt[e] + slot;
                    const u32x4 v0 = *(const u32x4*)(x2b + (size_t)tok * 1024 + lane * 8), v1 = *(const u32x4*)(x2b + (size_t)tok * 1024 + 512 + lane * 8);
                    *(u32x4*)(xs + (size_t)pos * 1024 + lane * 8) = v0; *(u32x4*)(xs + (size_t)pos * 1024 + 512 + lane * 8) = v1;
                    if (lane == 0) { rowtok[pos] = tok * 2 + k; roww[pos] = rec_w[tok * 2 + k]; } } }
            SEAM(pb + 7);
        }
        if (IN(pb + 8)) {
            PHASE_IDS();
            build_offsets(ctl + CW_CNT + l * 32, offt, tid_);
            pg8::Gemm g{1024, 1024, 1024}; SchedM2 S{(const char*)xs, (const char*)(ap.ws + WS_WGU), offt, G, bid};
            EpiM2 E{hmid};
            pg8::gemm_phase<EpiM2, SchedM2>(lds, g, S, E, tid_); SEAM(pb + 8);
        }
        if (IN(pb + 9)) {
            PHASE_IDS();
            build_offsets(ctl + CW_CNT + l * 32, offt, tid_);
            pg8::Gemm g{256, 256, 256}; SchedM3 S{(const char*)hmid, (const char*)(ap.ws + WS_WD), offt, G, bid};
            EpiM3 E{eo, rowtok, roww};
            pg8::gemm_phase<EpiM3, SchedM3>(lds, g, S, E, tid_); SEAM(pb + 9);
        }
    }
    if (IN(20)) { PHASE_IDS(); phase0_rows(ap, DEPTH, 1, gw, NGW, lane); }
#undef IN
#undef SEAM
}

typedef void (*kern_t)(Args);
template <unsigned PM> static bool setup_kernel() {
    if (hipFuncSetAttribute((const void*)mk_fwd<PM>, hipFuncAttributeMaxDynamicSharedMemorySize, LDS_BYTES) != hipSuccess) { fprintf(stderr, "kernel_launch: hipFuncSetAttribute failed\n"); return false; }
    return true;
}
extern "C" void kernel_launch(void* const* d_in, const int* in_sizes, int n_in, void* d_out, int out_size, void* d_ws, size_t ws_size, hipStream_t stream) {
    static int grid = 0;
    if (grid == 0) {
        if (n_in != 36 || out_size != T * D || ws_size < WS_END) { fprintf(stderr, "kernel_launch: unexpected shapes (n_in %d out %d ws %zu)\n", n_in, out_size, ws_size); grid = -1; return; }
        int dev = 0, cus = 0;
        if (hipGetDevice(&dev) != hipSuccess || hipDeviceGetAttribute(&cus, hipDeviceAttributeMultiprocessorCount, dev) != hipSuccess) { grid = -1; return; }
        bool ok = true;
#if MK_ONE_LAUNCH
        ok = setup_kernel<0x7FFu>();
#else
        ok = setup_kernel<1u>() && setup_kernel<2u>() && setup_kernel<4u>() && setup_kernel<8u>() && setup_kernel<16u>() && setup_kernel<32u>() && setup_kernel<64u>() && setup_kernel<128u>() && setup_kernel<256u>() && setup_kernel<512u>() && setup_kernel<1024u>();
#endif
        if (!ok) { grid = -1; return; }
        (void)hipGetLastError();
        grid = cus;
    }
    if (grid < 0) return;
    if (hipMemsetAsync((char*)d_ws + WS_CTL, 0, CTL_ZERO_BYTES, stream) != hipSuccess) return;
    Args a{};
    for (int i = 0; i < 36; ++i) a.in[i] = (const float*)d_in[i];
    a.out = (float*)d_out; a.ws = (unsigned char*)d_ws;
#if MK_ONE_LAUNCH
    a.ph_lo = 0; a.ph_hi = NPH;
    hipLaunchKernelGGL(mk_fwd<0x7FFu>, dim3(grid), dim3(512), LDS_BYTES, stream, a);
#else
    static const kern_t kerns[11] = { mk_fwd<1u>, mk_fwd<2u>, mk_fwd<4u>, mk_fwd<8u>, mk_fwd<16u>, mk_fwd<32u>, mk_fwd<64u>, mk_fwd<128u>, mk_fwd<256u>, mk_fwd<512u>, mk_fwd<1024u> };
    for (int p = 0; p < NPH; ++p) { a.ph_lo = p; a.ph_hi = p + 1; hipLaunchKernelGGL(kerns[p < 20 ? p % 10 : 10], dim3(grid), dim3(512), LDS_BYTES, stream, a); }
#endif
}
```

```cpp
#include <hip/hip_runtime.h>
#include <cstdio>
#include <cstdint>

#ifndef MK_ONE_LAUNCH
#define MK_ONE_LAUNCH 1
#endif

#define DI __device__ __forceinline__
#define GAS __attribute__((address_space(1)))
#define LAS __attribute__((address_space(3)))
typedef unsigned short bf16;
typedef short bf16x8 __attribute__((ext_vector_type(8)));
typedef float f32x4 __attribute__((ext_vector_type(4)));
typedef unsigned u32x4 __attribute__((ext_vector_type(4)));
typedef unsigned u32x2 __attribute__((ext_vector_type(2)));
typedef float f32x16 __attribute__((ext_vector_type(16)));
typedef float f32x2 __attribute__((ext_vector_type(2)));
typedef short s16x4 __attribute__((ext_vector_type(4)));
typedef __bf16 bf16x2_t __attribute__((ext_vector_type(2)));
typedef short v4i16_t __attribute__((__vector_size__(4 * sizeof(short))));
#define MFMA32(a, b, c) __builtin_amdgcn_mfma_f32_32x32x16_bf16((a), (b), (c), 0, 0, 0)

constexpr int BATCH = 4, SEQ = 8192, T = BATCH * SEQ, D = 1024, DEPTH = 2;
constexpr int NIN = 2444, PLD = 2560, N1 = 6656, GLD = 4096;
constexpr int C_AX = 0, C_AG = 256, C_BQ = 512, C_BK = 768, C_BV = 896, C_CQ = 1024, C_CK = 1280, C_CV = 1536, C_DQ = 1792,
              C_KC = 2048, C_VC = 2112, C_KS = 2176, C_VS = 2240, C_KW = 2304, C_VW = 2368, C_DG = 2432;
constexpr int NCMP = 511;
constexpr int MOE_ROWS = 73728;
constexpr int NPH = 21;

constexpr size_t MiB = 1u << 20;
constexpr size_t WS_CTL = 0, CTL_ZERO_BYTES = 1 * MiB;
constexpr size_t WS_KCVC = 1 * MiB;
constexpr size_t WS_LRUSUM = 2 * MiB;
constexpr size_t WS_REC = 2 * MiB + 256 * 1024;
constexpr size_t WS_ROWTOK = 3 * MiB;
constexpr size_t WS_ROWW = 3 * MiB + 512 * 1024;
constexpr size_t WS_WIN = 4 * MiB;
constexpr size_t WS_WBR = 17 * MiB;
constexpr size_t WS_WOUT = 19 * MiB;
constexpr size_t WS_HB = 21 * MiB;
constexpr size_t WS_PROJ = 85 * MiB;
constexpr size_t WS_GATES = 245 * MiB;
constexpr size_t WS_WGU = 245 * MiB;
constexpr size_t WS_WD = 277 * MiB;
constexpr size_t WS_XS = 293 * MiB;
constexpr size_t WS_HMID = 437 * MiB;
constexpr size_t WS_END = 501 * MiB;
constexpr int CW_BAR = 4096;
constexpr int CW_CNT = 16384;

constexpr int RING_BYTES = 131072;
constexpr int MISC_OFF = RING_BYTES;
constexpr int BIAS_OFF = MISC_OFF + 256;
constexpr int OFFT_OFF = BIAS_OFF + 129 * 12 * 4;
constexpr int PTAB_OFF = OFFT_OFF + (40 + 288) * 4;
constexpr int BIAS2_OFF = PTAB_OFF + 36 * 8;
constexpr int LDS_BYTES = 147456;
static_assert(PTAB_OFF % 8 == 0 && BIAS2_OFF + 129 * 12 * 4 <= LDS_BYTES, "LDS map");

DI float bf2f(bf16 v) { return __builtin_bit_cast(float, (unsigned)v << 16); }
DI float lo_bf(unsigned w) { return __builtin_bit_cast(float, w << 16); }
DI float hi_bf(unsigned w) { return __builtin_bit_cast(float, w & 0xffff0000u); }
DI unsigned f2bf(float f) { unsigned u = __builtin_bit_cast(unsigned, f); return (u + 0x7fffu + ((u >> 16) & 1u)) >> 16; }
DI unsigned pk2(float lo, float hi) { return f2bf(lo) | (f2bf(hi) << 16); }
DI float rl(float v, int i) { return __builtin_bit_cast(float, __builtin_amdgcn_readlane(__builtin_bit_cast(int, v), i)); }
DI int rli(int v, int i) { return __builtin_amdgcn_readlane(v, i); }
DI int my_lane() { int l; asm volatile("v_mbcnt_lo_u32_b32 %0, -1, 0\n\tv_mbcnt_hi_u32_b32 %0, -1, %0" : "=v"(l)); return l; }
template <int O> DI int xshfl_i(int v) {
    if constexpr (O < 32) return __builtin_amdgcn_ds_swizzle(v, (O << 10) | 0x1f);
    else { const int l = my_lane(); return __builtin_amdgcn_ds_bpermute((l ^ 32) << 2, v); }
}
template <int O> DI float xshfl(float v) { return __builtin_bit_cast(float, xshfl_i<O>(__builtin_bit_cast(int, v))); }
DI float wave_sum(float v) { v += xshfl<1>(v); v += xshfl<2>(v); v += xshfl<4>(v); v += xshfl<8>(v); v += xshfl<16>(v); v += xshfl<32>(v); return v; }
DI float wave_max(float v) { v = fmaxf(v, xshfl<1>(v)); v = fmaxf(v, xshfl<2>(v)); v = fmaxf(v, xshfl<4>(v)); v = fmaxf(v, xshfl<8>(v)); v = fmaxf(v, xshfl<16>(v)); v = fmaxf(v, xshfl<32>(v)); return v; }
DI float sigmoidf_(float x) { return 1.f / (1.f + __expf(-x)); }
DI float gelu_tanh(float x) { const float u = 0.7978845608028654f * (x + 0.044715f * x * x * x); const float e = __expf(2.f * u); const float th = 1.f - 2.f / (e + 1.f); return 0.5f * x * (1.f + th); }
DI float softplusf_(float x) { return fmaxf(x, 0.f) + log1pf(__expf(-fabsf(x))); }
#define LDS_WAIT() asm volatile("s_waitcnt lgkmcnt(0)" ::: "memory")
#define VM_WAIT() asm volatile("s_waitcnt vmcnt(0)" ::: "memory")

__device__ const unsigned char T5_BUCKET[128] = {
0,1,2,3,4,5,6,7,8,9,10,11,12,13,14,15,16,16,16,17,17,18,18,18,19,19,19,20,20,20,20,21,21,21,21,22,22,22,22,22,23,23,23,23,23,23,24,24,24,24,24,24,25,25,25,25,25,25,25,26,26,26,26,26,26,26,26,27,27,27,27,27,27,27,27,27,27,28,28,28,28,28,28,28,28,28,28,29,29,29,29,29,29,29,29,29,29,29,29,30,30,30,30,30,30,30,30,30,30,30,30,30,30,31,31,31,31,31,31,31,31,31,31,31,31,31,31,31};

#define XB_TMO      128
#define XB_XCNT(j)  (256  + 64 * (j))
#define XB_XSUB(j)  (1280 + 64 * (j))
#define XB_XGEN(j)  (2304 + 64 * (j))
#define XB_TOP      3328
#define XB_TOPGEN   3392
#define XCD_BAR_WORDS 3456
#define XB_SPIN_CAP (1u << 22)
DI unsigned xb_ld(unsigned* p)              { return __hip_atomic_load(p, __ATOMIC_RELAXED, __HIP_MEMORY_SCOPE_AGENT); }
DI unsigned xb_add(unsigned* p, unsigned v) { return __hip_atomic_fetch_add(p, v, __ATOMIC_RELAXED, __HIP_MEMORY_SCOPE_AGENT); }
DI unsigned xb_xcc_id() { return (unsigned)__builtin_amdgcn_s_getreg((3 << 11) | 20) & 0xFu; }
#define XB_SPIN(cond, bar) do { unsigned _sp = 0; while (cond) { __builtin_amdgcn_s_sleep(1); \
    if ((++_sp & 255u) == 0u) { if (xb_ld(&(bar)[XB_TMO])) break; if (_sp > XB_SPIN_CAP) { atomicAdd(&(bar)[XB_TMO], 1u); break; } } } } while (0)
struct XcdBarrier { unsigned* bar; unsigned x; volatile LAS unsigned* st; };
DI XcdBarrier xcd_barrier_post(unsigned* bar, volatile LAS unsigned* st, bool leader) {
    XcdBarrier b; b.bar = bar; b.x = xb_xcc_id(); b.st = st;
    if (leader) (void)xb_add(&bar[XB_XCNT(b.x)], 1u);
    return b;
}
DI void xcd_barrier_complete(unsigned* bar, unsigned x, unsigned& nloc, unsigned& nx) {
    const unsigned G = gridDim.x * gridDim.y * gridDim.z;
    unsigned sum, cnt, mine, sp = 0u;
    for (;;) {
        sum = 0u; cnt = 0u; mine = 0u;
#pragma unroll
        for (unsigned j = 0; j < 16; ++j) { const unsigned c = xb_ld(&bar[XB_XCNT(j)]); sum += c; cnt += (c > 0u) ? 1u : 0u; mine = (j == x) ? c : mine; }
        if (sum == G) break;
        __builtin_amdgcn_s_sleep(1);
        if ((++sp & 255u) == 0u) { if (xb_ld(&bar[XB_TMO])) break; if (sp > XB_SPIN_CAP) { atomicAdd(&bar[XB_TMO], 1u); break; } }
    }
    nloc = mine > 0u ? mine : 1u; nx = cnt > 0u ? cnt : 1u;
}
DI void xcd_barrier(const XcdBarrier& b, bool leader) {
    asm volatile("s_waitcnt vmcnt(0)" ::: "memory");
    __syncthreads();
    if (leader) {
        unsigned* bar = b.bar;
        __builtin_amdgcn_s_waitcnt(0);
        unsigned nloc = b.st[0], nx = b.st[1];
        if (nloc == 0u) { xcd_barrier_complete(bar, b.x, nloc, nx); b.st[0] = nloc; b.st[1] = nx; }
        const unsigned old = xb_add(&bar[XB_XSUB(b.x)], 1u);
        const unsigned gen = old / nloc;
        if (old + 1u == (gen + 1u) * nloc) {
            __builtin_amdgcn_fence(__ATOMIC_RELEASE, "agent");
            asm volatile("s_waitcnt vmcnt(0)" ::: "memory");
            const unsigned og = xb_add(&bar[XB_TOP], 1u);
            const unsigned tg = og / nx;
            if (og + 1u == (tg + 1u) * nx) xb_add(&bar[XB_TOPGEN], 1u);
            else XB_SPIN(xb_ld(&bar[XB_TOPGEN]) == tg, bar);
            __builtin_amdgcn_fence(__ATOMIC_ACQUIRE, "agent");
            xb_add(&bar[XB_XGEN(b.x)], 1u);
            asm volatile("s_waitcnt vmcnt(0)" ::: "memory");
        } else {
            XB_SPIN(xb_ld(&bar[XB_XGEN(b.x)]) == gen, bar);
            __builtin_amdgcn_fence(__ATOMIC_ACQUIRE, "agent");
            asm volatile("s_waitcnt vmcnt(0)" ::: "memory");
        }
    }
    __syncthreads();
}

namespace pg8 {
constexpr int BM = 256, BK = 64, HALF = 128, HTB = HALF * BK * 2;
__host__ __device__ __forceinline__ int lds_byte(int r, int c) { const int st = (r >> 4) * 2 + (c >> 5), rr = r & 15, cc = c & 31, ob = rr * 64 + cc * 2; return st * 1024 + (ob ^ (((ob >> 9) & 1) << 5)); }
__host__ __device__ __forceinline__ void stage_rc(int b, int& R, int& C) { const int st = b / 1024, sb = b % 1024, swz = sb ^ (((sb >> 9) & 1) << 5); R = (st >> 1) * 16 + swz / 64; C = (st & 1) * 32 + (swz % 64) / 2; }
__host__ __device__ __forceinline__ int perm32(int rho) { const int n = rho >> 4, i = rho & 15; return 8 * (i >> 2) + 4 * n + (i & 3); }
struct Unit { const char* a; const char* b; int pm, pn, aux, pad; };
struct Gemm { int K, lda, ldb; };
template <class Epi, class Sched>
DI void gemm_phase(LAS unsigned char* lds, const Gemm g, const Sched& S, const Epi& E, int tid_in) {
    int tid = tid_in; asm volatile("" : "+v"(tid));
    const int wid = __builtin_amdgcn_readfirstlane(tid >> 6), lane = tid & 63, wr = wid >> 2, wc = wid & 3, fr = lane & 15, fq = lane >> 4;
    const int K = g.K, nt = K / BK;
    unsigned voffA[2], voffB[2];
#pragma unroll
    for (int i = 0; i < 2; ++i) { int R, C; stage_rc(tid * 16 + i * 8192, R, C); const int Rb = (R & ~31) + perm32(R & 31);
        voffA[i] = (unsigned)(R * g.lda + C) * 2u; voffB[i] = (unsigned)(Rb * g.ldb + C) * 2u; }
    const size_t kstep = (size_t)(BK * 2);
    const size_t hstepA = (size_t)HALF * g.lda * 2, hstepB = (size_t)HALF * g.ldb * 2;
    const unsigned ldsw = (unsigned)wid * 1024u;
    const int aoff = lds_byte(wr * 64 + fr, fq * 8), boff = lds_byte(wc * 32 + fr, fq * 8);
#define PG8_SA(b, h) (((b) * 2 + (h)) * HTB)
#define PG8_SB(b, h) ((4 + (b) * 2 + (h)) * HTB)
#define PG8_STAGE(bufoff, gbase, voff) do { _Pragma("unroll") for (int _i = 0; _i < 2; ++_i) \
        __builtin_amdgcn_global_load_lds((const unsigned*)((const char*)(gbase) + (voff)[_i]), (LAS unsigned*)(lds + (bufoff) + ldsw + _i * 8192), 16, 0, 0); } while (0)
#define PG8_LDA(dst, b, h) do { _Pragma("unroll") for (int m = 0; m < 4; ++m) _Pragma("unroll") for (int k = 0; k < 2; ++k) dst[m][k] = *(const LAS bf16x8*)(lds + PG8_SA(b, h) + aoff + m * 2048 + k * 1024); } while (0)
#define PG8_LDB(dst, b, h) do { _Pragma("unroll") for (int n = 0; n < 2; ++n) _Pragma("unroll") for (int k = 0; k < 2; ++k) dst[n][k] = *(const LAS bf16x8*)(lds + PG8_SB(b, h) + boff + n * 2048 + k * 1024); } while (0)
#define PG8_MMA(ai, bj, At, Bt) do { __builtin_amdgcn_s_setprio(1); _Pragma("unroll") for (int m = 0; m < 4; ++m) _Pragma("unroll") for (int n = 0; n < 2; ++n) _Pragma("unroll") for (int k = 0; k < 2; ++k) \
        acc[ai][bj][m][n] = __builtin_amdgcn_mfma_f32_16x16x32_bf16(Bt[n][k], At[m][k], acc[ai][bj][m][n], 0, 0, 0); __builtin_amdgcn_s_setprio(0); } while (0)
#define PG8_WAIT_V(n) asm volatile("s_waitcnt vmcnt(" #n ")" ::: "memory")
#define PG8_WAIT_L(n) asm volatile("s_waitcnt lgkmcnt(" #n ")" ::: "memory")
#define PG8_BAR __builtin_amdgcn_s_barrier()
#define PG8_SCHED __builtin_amdgcn_sched_barrier(0)
    Unit cur, nxt; int ui = 0;
    if (!S.next(0, cur)) return;
    f32x4 acc[2][2][4][2];
#pragma unroll
    for (int a = 0; a < 2; ++a)
#pragma unroll
        for (int b = 0; b < 2; ++b)
#pragma unroll
            for (int m = 0; m < 4; ++m)
#pragma unroll
                for (int n = 0; n < 2; ++n) acc[a][b][m][n] = (f32x4){0.f, 0.f, 0.f, 0.f};
    bf16x8 At[4][2], B0[2][2], B1[2][2];
    const char* cA = cur.a; const char* cB = cur.b;
    PG8_STAGE(PG8_SB(0, 0), cB, voffB); PG8_STAGE(PG8_SB(0, 1), cB + hstepB, voffB); PG8_STAGE(PG8_SA(0, 0), cA, voffA); PG8_STAGE(PG8_SA(0, 1), cA + hstepA, voffA);
    if (wr == 1) PG8_BAR;
    PG8_WAIT_V(2); PG8_BAR;
    PG8_STAGE(PG8_SB(1, 0), cB + kstep, voffB); PG8_STAGE(PG8_SA(1, 0), cA + kstep, voffA); PG8_STAGE(PG8_SB(1, 1), cB + hstepB + kstep, voffB);
    PG8_WAIT_V(6); PG8_BAR;
    for (;;) {
        const bool has_next = S.next(ui + 1, nxt);
        const char* nA = has_next ? nxt.a : cA; const char* nB = has_next ? nxt.b : cB;
        for (int t = 0; t < nt; t += 2) {
            const bool last = (t == nt - 2);
            const char* a1 = cA + (size_t)(t + 1) * kstep;
            const char* a2 = last ? nA : cA + (size_t)(t + 2) * kstep; const char* b2 = last ? nB : cB + (size_t)(t + 2) * kstep;
            const char* a3 = a2 + kstep; const char* b3 = b2 + kstep;
            PG8_LDB(B0, 0, 0); PG8_LDB(B1, 0, 1); PG8_SCHED; PG8_LDA(At, 0, 0); PG8_STAGE(PG8_SA(1, 1), a1 + hstepA, voffA);
            PG8_WAIT_V(8); PG8_WAIT_L(0); PG8_BAR; PG8_MMA(0, 0, At, B0); PG8_MMA(0, 1, At, B1); PG8_BAR; PG8_SCHED;
            PG8_LDA(At, 0, 1); PG8_STAGE(PG8_SB(0, 0), b2, voffB); PG8_STAGE(PG8_SB(0, 1), b2 + hstepB, voffB); PG8_STAGE(PG8_SA(0, 0), a2, voffA);
            PG8_WAIT_V(8); PG8_WAIT_L(0); PG8_BAR; PG8_MMA(1, 0, At, B0); PG8_MMA(1, 1, At, B1); PG8_BAR; PG8_SCHED;
            PG8_LDB(B0, 1, 0); PG8_LDB(B1, 1, 1); PG8_SCHED; PG8_LDA(At, 1, 0); PG8_STAGE(PG8_SA(0, 1), a2 + hstepA, voffA);
            PG8_WAIT_V(8); PG8_WAIT_L(0); PG8_BAR; PG8_MMA(0, 0, At, B0); PG8_MMA(0, 1, At, B1); PG8_BAR; PG8_SCHED;
            PG8_LDA(At, 1, 1); PG8_STAGE(PG8_SB(1, 0), b3, voffB); PG8_STAGE(PG8_SB(1, 1), b3 + hstepB, voffB); PG8_STAGE(PG8_SA(1, 0), a3, voffA);
            PG8_WAIT_V(8); PG8_WAIT_L(0); PG8_BAR; PG8_MMA(1, 0, At, B0); PG8_MMA(1, 1, At, B1); PG8_BAR; PG8_SCHED;
        }
        if (wr == 0) PG8_BAR;
        { const int el = my_lane(); E(acc, cur, wr, wc, el & 15, el >> 4); }
        if (!has_next) break;
#pragma unroll
        for (int a = 0; a < 2; ++a)
#pragma unroll
            for (int b = 0; b < 2; ++b)
#pragma unroll
                for (int m = 0; m < 4; ++m)
#pragma unroll
                    for (int n = 0; n < 2; ++n) acc[a][b][m][n] = (f32x4){0.f, 0.f, 0.f, 0.f};
        cur = nxt; cA = nA; cB = nB; ++ui;
        if (wr == 1) PG8_BAR;
    }
    PG8_WAIT_V(0);
    PG8_BAR;
#undef PG8_SA
#undef PG8_SB
#undef PG8_STAGE
#undef PG8_LDA
#undef PG8_LDB
#undef PG8_MMA
#undef PG8_WAIT_V
#undef PG8_WAIT_L
#undef PG8_BAR
#undef PG8_SCHED
}
}
using pg8::Unit;

DI unsigned cvt_pk_bf16(float lo, float hi) { unsigned r; asm volatile("v_cvt_pk_bf16_f32 %0, %1, %2" : "=v"(r) : "v"(lo), "v"(hi)); return r; }
DI u32x4 pack8(const f32x4& v0, const f32x4& v1) { u32x4 w; w.x = cvt_pk_bf16(v0[0], v0[1]); w.y = cvt_pk_bf16(v0[2], v0[3]); w.z = cvt_pk_bf16(v1[0], v1[1]); w.w = cvt_pk_bf16(v1[2], v1[3]); return w; }

struct SchedP1 {
    const char* A; const char* B; int G, c;
    DI bool next(int i, Unit& u) const {
        constexpr int nM = 128, nN = 26, nwg = nM * nN, NXCD = 8, WGM = 8;
        const long L = (long)i * G + c; if (L >= nwg) return false;
        int wgid = (int)L; { const int q = nwg / NXCD, r = nwg % NXCD, xcd = wgid % NXCD, off = wgid / NXCD; wgid = (xcd < r ? xcd * (q + 1) : r * (q + 1) + (xcd - r) * q) + off; }
        const int nig = WGM * nN, gid = wgid / nig, fm = gid * WGM, gsz = (nM - fm) < WGM ? (nM - fm) : WGM;
        u.pm = fm + ((wgid % nig) % gsz); u.pn = (wgid % nig) / gsz; u.aux = 0; u.pad = 0;
        u.a = A + (size_t)u.pm * 256 * 1024 * 2; u.b = B + (size_t)u.pn * 256 * 1024 * 2; return true;
    }
};
struct SchedP3a {
    const char* ys; const char* wbr; int G, c;
    DI bool next(int i, Unit& u) const {
        const int tile = (i >> 2) * G + c; if (tile >= 512) return false;
        const int br = i & 3; u.pm = tile >> 2; u.pn = tile & 3; u.aux = br; u.pad = 0;
        u.a = ys + ((size_t)u.pm * 256 * 1024 + br * 256) * 2; u.b = wbr + ((size_t)br * 1024 * 256 + (size_t)u.pn * 256 * 256) * 2; return true;
    }
};
struct SchedP3b {
    const char* A; const char* B; int G, c;
    DI bool next(int i, Unit& u) const {
        const int L = i * G + c; if (L >= 512) return false;
        u.pm = L >> 2; u.pn = L & 3; u.aux = 0; u.pad = 0;
        u.a = A + (size_t)u.pm * 256 * 1024 * 2; u.b = B + (size_t)u.pn * 256 * 1024 * 2; return true;
    }
};
struct SchedM2 {
    const char* xs; const char* wgu; const LAS int* offt; int G, c;
    DI bool next(int i, Unit& u) const {
        const int NT = __builtin_amdgcn_readfirstlane(offt[32]) >> 8; const int L = i * G + c; if (L >= NT * 2) return false;
        const int rt = L >> 1, pn = L & 1; const int e = __builtin_amdgcn_readfirstlane(offt[40 + rt]);
        u.pm = rt; u.pn = pn; u.aux = e; u.pad = 0;
        u.a = xs + (size_t)rt * 256 * 1024 * 2; u.b = wgu + ((size_t)e * 512 + pn * 256) * 1024 * 2; return true;
    }
};
struct SchedM3 {
    const char* hmid; const char* wd; const LAS int* offt; int G, c;
    DI bool next(int i, Unit& u) const {
        const int NT = __builtin_amdgcn_readfirstlane(offt[32]) >> 8; const int L = i * G + c; if (L >= NT * 4) return false;
        const int rt = L >> 2, pn = L & 3; const int e = __builtin_amdgcn_readfirstlane(offt[40 + rt]);
        u.pm = rt; u.pn = pn; u.aux = e; u.pad = 0;
        u.a = hmid + (size_t)rt * 256 * 256 * 2; u.b = wd + ((size_t)e * 1024 + pn * 256) * 256 * 2; return true;
    }
};

struct EpiP1 {
    bf16* proj; bf16* gates; const float* bgate;
    DI void operator()(const f32x4 (&acc)[2][2][4][2], const Unit& u, int wr, int wc, int fr, int fq) const {
        const int row0 = u.pm * 256 + wr * 64 + fr; const int colt = u.pn * 256 + wc * 32 + 8 * fq;
        if (u.pn < 10) {
#pragma unroll
            for (int ai = 0; ai < 2; ++ai)
#pragma unroll
                for (int m = 0; m < 4; ++m) { bf16* rowp = proj + (size_t)(row0 + ai * 128 + m * 16) * PLD + colt;
#pragma unroll
                    for (int bj = 0; bj < 2; ++bj) *(u32x4*)(rowp + bj * 128) = pack8(acc[ai][bj][m][0], acc[ai][bj][m][1]); }
        } else {
            const int gcol = colt - 2560;
            f32x4 bv[2][2];
#pragma unroll
            for (int bj = 0; bj < 2; ++bj)
#pragma unroll
                for (int n = 0; n < 2; ++n) bv[bj][n] = *(const f32x4*)(bgate + gcol + bj * 128 + 4 * n);
#pragma unroll
            for (int ai = 0; ai < 2; ++ai)
#pragma unroll
                for (int m = 0; m < 4; ++m) { bf16* rowp = gates + (size_t)(row0 + ai * 128 + m * 16) * GLD + gcol;
#pragma unroll
                    for (int bj = 0; bj < 2; ++bj) { f32x4 v0 = acc[ai][bj][m][0] + bv[bj][0], v1 = acc[ai][bj][m][1] + bv[bj][1];
#pragma unroll
                        for (int e = 0; e < 4; ++e) { v0[e] = sigmoidf_(v0[e]); v1[e] = sigmoidf_(v1[e]); }
                        *(u32x4*)(rowp + bj * 128) = pack8(v0, v1); }
                    __builtin_amdgcn_sched_barrier(0); }
        }
    }
};
struct EpiP3a {
    bf16* merged; const bf16* gates;
    DI void operator()(const f32x4 (&acc)[2][2][4][2], const Unit& u, int wr, int wc, int fr, int fq) const {
        const int row0 = u.pm * 256 + wr * 64 + fr; const int colt = u.pn * 256 + wc * 32 + 8 * fq; const int br = u.aux;
#pragma unroll
        for (int ai = 0; ai < 2; ++ai)
#pragma unroll
            for (int m = 0; m < 4; ++m) { const size_t row = (size_t)(row0 + ai * 128 + m * 16);
#pragma unroll
                for (int bj = 0; bj < 2; ++bj) {
                    const u32x4 gw = *(const u32x4*)(gates + row * GLD + br * 1024 + colt + bj * 128);
                    bf16* mp = merged + row * 1024 + colt + bj * 128;
                    f32x4 v0 = acc[ai][bj][m][0], v1 = acc[ai][bj][m][1];
                    v0[0] *= lo_bf(gw.x); v0[1] *= hi_bf(gw.x); v0[2] *= lo_bf(gw.y); v0[3] *= hi_bf(gw.y);
                    v1[0] *= lo_bf(gw.z); v1[1] *= hi_bf(gw.z); v1[2] *= lo_bf(gw.w); v1[3] *= hi_bf(gw.w);
                    if (br != 0) { const u32x4 mw = *(const u32x4*)mp;
                        v0[0] += lo_bf(mw.x); v0[1] += hi_bf(mw.x); v0[2] += lo_bf(mw.y); v0[3] += hi_bf(mw.y);
                        v1[0] += lo_bf(mw.z); v1[1] += hi_bf(mw.z); v1[2] += lo_bf(mw.w); v1[3] += hi_bf(mw.w); }
                    *(u32x4*)mp = pack8(v0, v1); }
                __builtin_amdgcn_sched_barrier(0); }
    }
};
struct EpiP3b {
    const float* xin; float* out;
    DI void operator()(const f32x4 (&acc)[2][2][4][2], const Unit& u, int wr, int wc, int fr, int fq) const {
        const int row0 = u.pm * 256 + wr * 64 + fr; const int colt = u.pn * 256 + wc * 32 + 8 * fq;
#pragma unroll
        for (int ai = 0; ai < 2; ++ai)
#pragma unroll
            for (int m = 0; m < 4; ++m) { const size_t off = (size_t)(row0 + ai * 128 + m * 16) * 1024 + colt;
#pragma unroll
                for (int bj = 0; bj < 2; ++bj)
#pragma unroll
                    for (int n = 0; n < 2; ++n) { const f32x4 xv = *(const f32x4*)(xin + off + bj * 128 + 4 * n); *(f32x4*)(out + off + bj * 128 + 4 * n) = xv + acc[ai][bj][m][n]; }
                __builtin_amdgcn_sched_barrier(0); }
    }
};
struct EpiM2 {
    bf16* hmid;
    DI void operator()(const f32x4 (&acc)[2][2][4][2], const Unit& u, int wr, int wc, int fr, int fq) const {
        const int row0 = u.pm * 256 + wr * 64 + fr; const int col = u.pn * 128 + wc * 32 + 8 * fq;
#pragma unroll
        for (int ai = 0; ai < 2; ++ai)
#pragma unroll
            for (int m = 0; m < 4; ++m) { f32x4 h0, h1;
#pragma unroll
                for (int e = 0; e < 4; ++e) { const float g0 = acc[ai][0][m][0][e], g1 = acc[ai][0][m][1][e];
                    h0[e] = g0 * sigmoidf_(g0) * acc[ai][1][m][0][e]; h1[e] = g1 * sigmoidf_(g1) * acc[ai][1][m][1][e]; }
                *(u32x4*)(hmid + (size_t)(row0 + ai * 128 + m * 16) * 256 + col) = pack8(h0, h1); }
    }
};
struct EpiM3 {
    bf16* eo; const int* rowtok; const float* roww;
    DI void operator()(const f32x4 (&acc)[2][2][4][2], const Unit& u, int wr, int wc, int fr, int fq) const {
        const int row0 = u.pm * 256 + wr * 64 + fr; const int colt = u.pn * 256 + wc * 32 + 8 * fq;
#pragma unroll
        for (int ai = 0; ai < 2; ++ai)
#pragma unroll
            for (int m = 0; m < 4; ++m) { const int row = row0 + ai * 128 + m * 16; const int tk = rowtok[row];
                if (tk >= 0) { const float w = roww[row]; bf16* op = eo + (size_t)tk * 1024 + colt;
#pragma unroll
                    for (int bj = 0; bj < 2; ++bj) *(u32x4*)(op + bj * 128) = pack8(acc[ai][bj][m][0] * w, acc[ai][bj][m][1] * w); }
                __builtin_amdgcn_sched_barrier(0); }
    }
};

struct Args { const float* in[36]; float* out; unsigned char* ws; int ph_lo, ph_hi; };
struct InTab { unsigned base;
    DI const float* operator[](int i) const { unsigned long long v; const unsigned addr = base + (unsigned)i * 8u;
        asm volatile("ds_read_b64 %0, %1\n\ts_waitcnt lgkmcnt(0)" : "=v"(v) : "v"(addr) : "memory");
        const unsigned lo = __builtin_amdgcn_readfirstlane((unsigned)v), hi = __builtin_amdgcn_readfirstlane((unsigned)(v >> 32));
        return (const float*)(((unsigned long long)hi << 32) | lo); } };
struct KA { InTab in; float* out; unsigned char* ws; };

DI void transpose_item(const float* W, int ldw, int nvalid, bf16* WT, int ldt, int k0, int n0, int dst_row0, LAS float* scr, int lane) {
    const bool nok = (n0 + (lane & 31)) < nvalid;
#pragma unroll 8
    for (int i = 0; i < 32; ++i) { const int kk = 2 * i + (lane >> 5); scr[kk * 33 + (lane & 31)] = nok ? W[(size_t)(k0 + kk) * ldw + n0 + (lane & 31)] : 0.f; }
    LDS_WAIT(); asm volatile("" ::: "memory");
    const int c = lane & 7;
#pragma unroll
    for (int j = 0; j < 4; ++j) { const int n = (lane >> 3) + 8 * j; const LAS float* s = scr + (8 * c) * 33 + n;
        u32x4 o; o.x = pk2(s[0 * 33], s[1 * 33]); o.y = pk2(s[2 * 33], s[3 * 33]); o.z = pk2(s[4 * 33], s[5 * 33]); o.w = pk2(s[6 * 33], s[7 * 33]);
        if (n0 + n < nvalid) *(u32x4*)(WT + (size_t)(dst_row0 + n) * ldt + k0 + 8 * c) = o; }
    LDS_WAIT(); asm volatile("" ::: "memory");
}
DI void phase0_weights(const KA& a, int l, LAS unsigned char* lds, int gw, int NGW, int wave, int lane) {
    LAS float* scr = (LAS float*)(lds + wave * 16384);
    const float* w_in = a.in[4] + (size_t)l * 1024 * NIN;
    const float* w_gate = a.in[24] + (size_t)l * 4 * 1024 * 1024;
    const float* w_br = a.in[26] + (size_t)l * 4 * 256 * 1024;
    const float* w_out = a.in[27] + (size_t)l * 1024 * 1024;
    bf16* Wt_in = (bf16*)(a.ws + WS_WIN); bf16* Wt_br = (bf16*)(a.ws + WS_WBR); bf16* Wt_out = (bf16*)(a.ws + WS_WOUT);
    constexpr int I_IN = 16 * 77, I_G = 4 * 16 * 32, I_B = 4 * 4 * 32, I_O = 16 * 32, NIT = I_IN + I_G + I_B + I_O;
    for (int it = gw; it < NIT; it += NGW) {
        int r = it;
        if (r < I_IN) { const int kb = r / 77, nb = r % 77; transpose_item(w_in, NIN, NIN, Wt_in, 1024, kb * 64, nb * 32, nb * 32, scr, lane); continue; } r -= I_IN;
        if (r < I_G) { const int br = r / 512, q = r % 512, kb = q / 32, nb = q % 32; transpose_item(w_gate + (size_t)br * 1024 * 1024, 1024, 1024, Wt_in, 1024, kb * 64, nb * 32, 2560 + br * 1024 + nb * 32, scr, lane); continue; } r -= I_G;
        if (r < I_B) { const int br = r / 128, q = r % 128, kb = q / 32, nb = q % 32; transpose_item(w_br + (size_t)br * 256 * 1024, 1024, 1024, Wt_br + (size_t)br * 1024 * 256, 256, kb * 64, nb * 32, nb * 32, scr, lane); continue; } r -= I_B;
        { const int kb = r / 32, nb = r % 32; transpose_item(w_out, 1024, 1024, Wt_out, 1024, kb * 64, nb * 32, nb * 32, scr, lane); }
    }
}
DI void phase0_rows(const KA& a, int l, int mode, int gw, int NGW, int lane) {
    const float* xin = (l == 0) ? a.in[0] : a.out;
    const bf16* eo = (const bf16*)(a.ws + WS_PROJ);
    bf16* hb = (bf16*)(a.ws + WS_HB);
    const float* g = mode ? a.in[2] : (a.in[3] + (size_t)l * 1024);
    for (int m = gw; m < T; m += NGW) {
        f32x4 v[4]; float ss = 0.f;
#pragma unroll
        for (int j = 0; j < 4; ++j) { v[j] = *(const f32x4*)(xin + (size_t)m * 1024 + 4 * (lane + 64 * j));
            if (l > 0) {
                const u32x2 e0 = *(const u32x2*)(eo + (size_t)(2 * m) * 1024 + 4 * (lane + 64 * j));
                const u32x2 e1 = *(const u32x2*)(eo + (size_t)(2 * m + 1) * 1024 + 4 * (lane + 64 * j));
                v[j][0] += lo_bf(e0.x) + lo_bf(e1.x); v[j][1] += hi_bf(e0.x) + hi_bf(e1.x); v[j][2] += lo_bf(e0.y) + lo_bf(e1.y); v[j][3] += hi_bf(e0.y) + hi_bf(e1.y);
            }
            ss += (v[j][0] * v[j][0] + v[j][1] * v[j][1]) + (v[j][2] * v[j][2] + v[j][3] * v[j][3]); }
        const float r = 1.f / sqrtf(wave_sum(ss) * (1.f / 1024.f) + 1e-6f);
#pragma unroll
        for (int j = 0; j < 4; ++j) { const f32x4 gv = *(const f32x4*)(g + 4 * (lane + 64 * j)); const f32x4 y = v[j] * r * gv;
            if (mode) *(f32x4*)(a.out + (size_t)m * 1024 + 4 * (lane + 64 * j)) = y;
            else { if (l > 0) *(f32x4*)(a.out + (size_t)m * 1024 + 4 * (lane + 64 * j)) = v[j];
                   u32x2 w; w.x = pk2(y[0], y[1]); w.y = pk2(y[2], y[3]); *(u32x2*)(hb + (size_t)m * 1024 + 4 * (lane + 64 * j)) = w; } }
    }
}

DI void lru_task(const KA& a, int l, const bf16* proj, bf16* ys, float* sums, int task, int lane, bool final) {
    const int chunk = task & 31, hbk = (task >> 5) & 3, b = task >> 7; const int c = hbk * 64 + lane;
    const float* w_a = a.in[7] + ((size_t)l * 4 + hbk) * 4096; const float* w_x = a.in[9] + ((size_t)l * 4 + hbk) * 4096;
    float wa[64], wx[64];
#pragma unroll
    for (int i = 0; i < 64; ++i) { wa[i] = w_a[i * 64 + lane]; wx[i] = w_x[i * 64 + lane]; }
    const float* cw = a.in[5] + (size_t)l * 4 * 256;
    const float cw0 = cw[c], cw1 = cw[256 + c], cw2 = cw[512 + c], cw3 = cw[768 + c];
    const float cb = a.in[6][l * 256 + c], ba = a.in[8][l * 256 + c], bx = a.in[10][l * 256 + c];
    const float c8 = -8.f * softplusf_(-a.in[11][l * 256 + c]);
    const int t0 = chunk * 256; const size_t rowb = (size_t)b * SEQ;
    float x3 = (t0 >= 3) ? bf2f(proj[(rowb + t0 - 3) * PLD + C_AX + c]) : 0.f;
    float x2 = (t0 >= 2) ? bf2f(proj[(rowb + t0 - 2) * PLD + C_AX + c]) : 0.f;
    float x1 = (t0 >= 1) ? bf2f(proj[(rowb + t0 - 1) * PLD + C_AX + c]) : 0.f;
    float h = 0.f, Ap = 1.f;
    if (final) { for (int cc = 0; cc < chunk; ++cc) { const float* sp = sums + ((size_t)((b * 4 + hbk) * 32 + cc) * 64 + lane) * 2; h = sp[0] * h + sp[1]; } }
    for (int t = t0; t < t0 + 256; ++t) {
        const float x0 = bf2f(proj[(rowb + t) * PLD + C_AX + c]);
        const float xc = cb + cw0 * x3 + cw1 * x2 + cw2 * x1 + cw3 * x0;
        float ra = ba, rx = bx;
#pragma unroll
        for (int i = 0; i < 64; ++i) { const float s = rl(xc, i); ra += s * wa[i]; rx += s * wx[i]; }
        const float r = sigmoidf_(ra), ig = sigmoidf_(rx);
        const float la = c8 * r; const float av = __expf(la);
        const float mult = (t == 0) ? 1.f : sqrtf(fmaxf(1.f - __expf(2.f * la), 0.f));
        const float bb = mult * ig * xc;
        h = av * h + bb; Ap *= av;
        if (final) { const float gt = bf2f(proj[(rowb + t) * PLD + C_AG + c]); ys[(rowb + t) * 1024 + c] = (bf16)f2bf(h * gelu_tanh(gt)); }
        x3 = x2; x2 = x1; x1 = x0;
    }
    if (!final) { float* sp = sums + ((size_t)((b * 4 + hbk) * 32 + chunk) * 64 + lane) * 2; sp[0] = Ap; sp[1] = h; }
}

template <int NH>
DI void dot_row64(const bf16* krow, const LAS float* qs, float (&acc)[NH]) {
#pragma unroll
    for (int h = 0; h < NH; ++h) acc[h] = 0.f;
#pragma unroll 1
    for (int c8 = 0; c8 < 8; ++c8) {
        const u32x4 w = *(const u32x4*)(krow + c8 * 8);
        const float k0 = lo_bf(w.x), k1 = hi_bf(w.x), k2 = lo_bf(w.y), k3 = hi_bf(w.y), k4 = lo_bf(w.z), k5 = hi_bf(w.z), k6 = lo_bf(w.w), k7 = hi_bf(w.w);
#pragma unroll
        for (int h = 0; h < NH; ++h) { const f32x4 qa = *(const LAS f32x4*)(qs + h * 64 + c8 * 8), qb = *(const LAS f32x4*)(qs + h * 64 + c8 * 8 + 4);
            acc[h] += qa[0] * k0; acc[h] += qa[1] * k1; acc[h] += qa[2] * k2; acc[h] += qa[3] * k3;
            acc[h] += qb[0] * k4; acc[h] += qb[1] * k5; acc[h] += qb[2] * k6; acc[h] += qb[3] * k7; } }
}
template <int NH>
DI void dot_row64_f32(const float* krow, const LAS float* qs, float (&acc)[NH]) {
#pragma unroll
    for (int h = 0; h < NH; ++h) acc[h] = 0.f;
#pragma unroll 1
    for (int d8 = 0; d8 < 8; ++d8) {
        const f32x4 ka = *(const f32x4*)(krow + d8 * 8), kb = *(const f32x4*)(krow + d8 * 8 + 4);
#pragma unroll
        for (int h = 0; h < NH; ++h) { const f32x4 qa = *(const LAS f32x4*)(qs + h * 64 + d8 * 8), qb = *(const LAS f32x4*)(qs + h * 64 + d8 * 8 + 4);
            acc[h] += qa[0] * ka[0]; acc[h] += qa[1] * ka[1]; acc[h] += qa[2] * ka[2]; acc[h] += qa[3] * ka[3];
            acc[h] += qb[0] * kb[0]; acc[h] += qb[1] * kb[1]; acc[h] += qb[2] * kb[2]; acc[h] += qb[3] * kb[3]; } }
}

DI void swa_token(const KA& a, int l, const bf16* proj, bf16* ys, const LAS float* biasd, LAS float* qs, int tok, int lane) {
    const int b = tok / SEQ, t = tok % SEQ; const size_t rowb = (size_t)b * SEQ;
#pragma unroll
    for (int h = 0; h < 4; ++h) qs[h * 64 + lane] = bf2f(proj[(size_t)tok * PLD + C_BQ + h * 64 + lane]) * 0.125f;
    LDS_WAIT();
#pragma unroll
    for (int g = 0; g < 2; ++g) {
        float s[2][2]; int ktok[2];
#pragma unroll
        for (int j = 0; j < 2; ++j) { const int dist = 64 * j + lane; const int kpos = t - dist; const bool valid = kpos >= 0; const int kp = valid ? kpos : 0; ktok[j] = (int)rowb + kp;
            float acc[2]; dot_row64<2>(proj + (size_t)ktok[j] * PLD + C_BK + g * 64, qs + g * 128, acc);
#pragma unroll
            for (int i = 0; i < 2; ++i) s[i][j] = valid ? acc[i] + biasd[dist * 12 + 2 * g + i] : -1e30f; }
        float o[2] = {0.f, 0.f};
#pragma unroll
        for (int i = 0; i < 2; ++i) { const float sink = a.in[12][l * 4 + 2 * g + i];
            float mx = fmaxf(wave_max(fmaxf(s[i][0], s[i][1])), sink);
            const float p0 = (s[i][0] > -1e29f) ? __expf(s[i][0] - mx) : 0.f, p1 = (s[i][1] > -1e29f) ? __expf(s[i][1] - mx) : 0.f;
            const float den = wave_sum(p0 + p1) + __expf(sink - mx); const float inv = 1.f / fmaxf(den, 1e-30f);
            s[i][0] = p0 * inv; s[i][1] = p1 * inv; }
#pragma unroll
        for (int j = 0; j < 2; ++j) {
#pragma unroll 4
            for (int kl = 0; kl < 64; ++kl) { const int kpos = t - (64 * j + kl); if (kpos < 0) break;
                const float vv = bf2f(proj[(rowb + kpos) * PLD + C_BV + g * 64 + lane]);
                o[0] += rl(s[0][j], kl) * vv; o[1] += rl(s[1][j], kl) * vv; } }
#pragma unroll
        for (int i = 0; i < 2; ++i) ys[(size_t)tok * 1024 + 256 + (2 * g + i) * 64 + lane] = (bf16)f2bf(o[i]);
    }
}

DI void diff_task(const KA& a, int l, const bf16* proj, bf16* ys, const LAS float* biasd, float lam, float lam_init, int task, int lane) {
    const int qg = task >> 4, bh = task & 15, b = bh >> 2, h = bh & 3; const int mp = lane >> 5; const int q = qg * 32 + (lane & 31);
    const size_t rowb = (size_t)b * SEQ; const size_t tok = rowb + q;
    const float scale = 0.17677669529663687f;
    float qr[32];
    { const bf16* qp = proj + tok * PLD + C_CQ + h * 64 + mp * 32;
#pragma unroll
      for (int c = 0; c < 4; ++c) { const u32x4 w = *(const u32x4*)(qp + c * 8);
        qr[c * 8 + 0] = lo_bf(w.x) * scale; qr[c * 8 + 1] = hi_bf(w.x) * scale; qr[c * 8 + 2] = lo_bf(w.y) * scale; qr[c * 8 + 3] = hi_bf(w.y) * scale;
        qr[c * 8 + 4] = lo_bf(w.z) * scale; qr[c * 8 + 5] = hi_bf(w.z) * scale; qr[c * 8 + 6] = lo_bf(w.w) * scale; qr[c * 8 + 7] = hi_bf(w.w) * scale; } }
    float o[64];
#pragma unroll
    for (int d = 0; d < 64; ++d) o[d] = 0.f;
    float mrun = -1e30f, lrun = 0.f;
    const int kend = qg * 32 + 31;
    for (int k = 0; k <= kend; ++k) {
        const bf16* kp = proj + (rowb + k) * PLD + C_CK + h * 64 + mp * 32;
        float s = 0.f;
#pragma unroll
        for (int c = 0; c < 4; ++c) { const u32x4 w = *(const u32x4*)(kp + c * 8);
            s += qr[c * 8 + 0] * lo_bf(w.x); s += qr[c * 8 + 1] * hi_bf(w.x); s += qr[c * 8 + 2] * lo_bf(w.y); s += qr[c * 8 + 3] * hi_bf(w.y);
            s += qr[c * 8 + 4] * lo_bf(w.z); s += qr[c * 8 + 5] * hi_bf(w.z); s += qr[c * 8 + 6] * lo_bf(w.w); s += qr[c * 8 + 7] * hi_bf(w.w); }
        const int dist = q - k; const bool valid = dist >= 0; const int di = valid ? (dist < 128 ? dist : 128) : 0;
        s += biasd[di * 12 + 4 + h];
        if (valid && s > mrun) { const float al = __expf(mrun - s); lrun *= al;
#pragma unroll
            for (int d = 0; d < 64; ++d) o[d] *= al;
            mrun = s; }
        const float p = valid ? __expf(s - mrun) : 0.f; lrun += p;
        const bf16* vp = proj + (rowb + k) * PLD + C_CV + h * 64;
#pragma unroll
        for (int c = 0; c < 8; ++c) { const u32x4 w = *(const u32x4*)(vp + c * 8);
            o[c * 8 + 0] += p * lo_bf(w.x); o[c * 8 + 1] += p * hi_bf(w.x); o[c * 8 + 2] += p * lo_bf(w.y); o[c * 8 + 3] += p * hi_bf(w.y);
            o[c * 8 + 4] += p * lo_bf(w.z); o[c * 8 + 5] += p * hi_bf(w.z); o[c * 8 + 6] += p * lo_bf(w.w); o[c * 8 + 7] += p * hi_bf(w.w); }
    }
    const float inv = 1.f / fmaxf(lrun, 1e-30f);
    float ss = 0.f;
#pragma unroll
    for (int d = 0; d < 64; ++d) { const float mine = o[d] * inv; const float other = xshfl<32>(mine); const float at = mine - lam * other; o[d] = at; ss += at * at; }
    const float r = 1.f / sqrtf(ss * (1.f / 64.f) + 1e-5f) * (1.f - lam_init);
    if (mp == 0) { const float* sg = a.in[17] + l * 64; bf16* op = ys + tok * 1024 + 512 + h * 64;
#pragma unroll
        for (int c = 0; c < 8; ++c) { u32x4 w; w.x = pk2(o[c * 8 + 0] * r * sg[c * 8 + 0], o[c * 8 + 1] * r * sg[c * 8 + 1]); w.y = pk2(o[c * 8 + 2] * r * sg[c * 8 + 2], o[c * 8 + 3] * r * sg[c * 8 + 3]);
            w.z = pk2(o[c * 8 + 4] * r * sg[c * 8 + 4], o[c * 8 + 5] * r * sg[c * 8 + 5]); w.w = pk2(o[c * 8 + 6] * r * sg[c * 8 + 6], o[c * 8 + 7] * r * sg[c * 8 + 7]); *(u32x4*)(op + c * 8) = w; } }
}


constexpr int DK_STR = 144, DV_STR = 192, DBUF_BYTES = 64 * DK_STR + 64 * DV_STR;
DI int crow(int i, int hh) { return (i & 3) + 8 * (i >> 2) + 4 * hh; }
DI unsigned cvtpk(float lo, float hi) { f32x2 v = {lo, hi}; bf16x2_t b = __builtin_convertvector(v, bf16x2_t); return __builtin_bit_cast(unsigned, b); }
DI bf16x8 pack_half(const f32x16& x, int s2) { u32x4 p;
    if (s2 == 0) { p.x = cvtpk(x[0], x[1]); p.y = cvtpk(x[2], x[3]); p.z = cvtpk(x[4], x[5]); p.w = cvtpk(x[6], x[7]); }
    else { p.x = cvtpk(x[8], x[9]); p.y = cvtpk(x[10], x[11]); p.z = cvtpk(x[12], x[13]); p.w = cvtpk(x[14], x[15]); }
    return __builtin_bit_cast(bf16x8, p); }
DI s16x4 vtr(const LAS unsigned char* p) { return __builtin_bit_cast(s16x4, __builtin_amdgcn_ds_read_tr16_b64_v4i16((LAS v4i16_t*)p)); }
DI float max16(const f32x16& x) { float a = fmaxf(fmaxf(x[0], x[1]), fmaxf(x[2], x[3])), b = fmaxf(fmaxf(x[4], x[5]), fmaxf(x[6], x[7])), c = fmaxf(fmaxf(x[8], x[9]), fmaxf(x[10], x[11])), d = fmaxf(fmaxf(x[12], x[13]), fmaxf(x[14], x[15])); return fmaxf(fmaxf(a, b), fmaxf(c, d)); }
DI void diff_unit(const GAS bf16* proj, GAS bf16* ys, LAS unsigned char* lds, const LAS float* bias2, const GAS float* subg, float lam, float lam_init, int b, int h, int qb, int tid, int lane, int wave) {
    const int q0 = qb * 256 + wave * 32; const int ql = lane & 31, hh = lane >> 5; const int q = q0 + ql;
    const size_t rowb = (size_t)b * SEQ;
    const float SC = 0.17677669529663687f * 1.4426950408889634f;
    bf16x8 qf[2][2];
    { const GAS bf16* qp = proj + (rowb + q) * PLD + C_CQ + h * 64 + hh * 8;
#pragma unroll
      for (int m = 0; m < 2; ++m)
#pragma unroll
        for (int s = 0; s < 2; ++s) { const u32x4 w = *(const GAS u32x4*)(qp + m * 32 + s * 16); u32x4 o;
            o.x = cvtpk(lo_bf(w.x) * SC, hi_bf(w.x) * SC); o.y = cvtpk(lo_bf(w.y) * SC, hi_bf(w.y) * SC); o.z = cvtpk(lo_bf(w.z) * SC, hi_bf(w.z) * SC); o.w = cvtpk(lo_bf(w.w) * SC, hi_bf(w.w) * SC);
            qf[m][s] = __builtin_bit_cast(bf16x8, o); } }
    f32x16 O[2][2], negm[2];
#pragma unroll
    for (int i = 0; i < 16; ++i) { O[0][0][i] = 0.f; O[0][1][i] = 0.f; O[1][0][i] = 0.f; O[1][1][i] = 0.f; negm[0][i] = 0.f; negm[1][i] = 0.f; }
    float lsum[2] = {0.f, 0.f};
    const int nsteps = 4 * qb + 4, mysteps = 4 * qb + (wave >> 1) + 1;
    const int skey = tid >> 3, sch = tid & 7;
    const GAS unsigned char* kgb = (const GAS unsigned char*)(proj + rowb * PLD + C_CK + h * 64);
    const GAS unsigned char* vgb = (const GAS unsigned char*)(proj + rowb * PLD + C_CV + h * 64);
    const unsigned soff = (unsigned)(skey * PLD + sch * 8) * 2u;
    u32x4 kr = *(const GAS u32x4*)(kgb + soff), vr = *(const GAS u32x4*)(vgb + soff);
    *(LAS u32x4*)(lds + skey * DK_STR + sch * 16) = kr; *(LAS u32x4*)(lds + 64 * DK_STR + skey * DV_STR + sch * 16) = vr;
    __syncthreads();
    const int i16 = lane & 15, blk = (lane >> 4) & 1;
    const int kboff = ql * DK_STR + hh * 16;
    const int vboff = 64 * DK_STR + (4 * hh + (i16 >> 2)) * DV_STR + (16 * blk + 4 * (i16 & 3)) * 2;
#pragma unroll 1
    for (int kt = 0; kt < nsteps; ++kt) {
        const LAS unsigned char* cur = lds + (kt & 1) * DBUF_BYTES; LAS unsigned char* nxt = lds + ((kt + 1) & 1) * DBUF_BYTES;
        if (kt + 1 < nsteps) { const unsigned so = soff + (unsigned)(kt + 1) * (64u * PLD * 2u); kr = *(const GAS u32x4*)(kgb + so); vr = *(const GAS u32x4*)(vgb + so); }
        if (kt < mysteps) {
            const int kbase = kt * 64;
            const bool near = (q0 - (kbase + 63) < 113);
#pragma unroll
            for (int m = 0; m < 2; ++m) {
                bf16x8 pk[2][2];
                f32x16 S[2];
                {   bf16x8 kf[2][2];
#pragma unroll
                    for (int t = 0; t < 2; ++t)
#pragma unroll
                        for (int s = 0; s < 2; ++s) kf[t][s] = *(const LAS bf16x8*)(cur + kboff + t * 32 * DK_STR + m * 64 + s * 32);
#pragma unroll
                    for (int t = 0; t < 2; ++t) { S[t] = MFMA32(kf[t][0], qf[m][0], negm[m]); S[t] = MFMA32(kf[t][1], qf[m][1], S[t]); } }
                if (near) {
#pragma unroll
                    for (int t = 0; t < 2; ++t)
#pragma unroll
                        for (int i = 0; i < 16; ++i) { const int dist = q - (kbase + 32 * t + crow(i, hh)); const int di = dist < 128 ? dist : 128;
                            const float bv = dist >= 0 ? bias2[di * 12 + 4 + h] : -1e30f; S[t][i] += bv; } }
                float tm = fmaxf(max16(S[0]), max16(S[1]));
                const bool need = (tm > 8.f) || (kt == 0);
                if (__builtin_amdgcn_ballot_w64(need) != 0ull) {
                    tm = fmaxf(tm, xshfl<32>(tm));
                    const float sh = (kt == 0) ? tm : fmaxf(tm, 0.f);
                    const float al = __builtin_amdgcn_exp2f(-sh);
                    lsum[m] *= al;
#pragma unroll
                    for (int i = 0; i < 16; ++i) { O[m][0][i] *= al; O[m][1][i] *= al; negm[m][i] -= sh; S[0][i] -= sh; S[1][i] -= sh; }
                }
#pragma unroll
                for (int t = 0; t < 2; ++t) {
#pragma unroll
                    for (int i = 0; i < 16; ++i) { const float p = __builtin_amdgcn_exp2f(S[t][i]); S[t][i] = p; lsum[m] += p; }
                    pk[t][0] = pack_half(S[t], 0); pk[t][1] = pack_half(S[t], 1); }
#pragma unroll
                for (int t = 0; t < 2; ++t)
#pragma unroll
                    for (int s2 = 0; s2 < 2; ++s2)
#pragma unroll
                        for (int db = 0; db < 2; ++db) {
                            const s16x4 lo = vtr(cur + vboff + (32 * t + 16 * s2) * DV_STR + db * 64), hi = vtr(cur + vboff + (32 * t + 16 * s2 + 8) * DV_STR + db * 64);
                            const bf16x8 vf = __builtin_shufflevector(lo, hi, 0, 1, 2, 3, 4, 5, 6, 7);
                            O[m][db] = MFMA32(vf, pk[t][s2], O[m][db]); }
                __builtin_amdgcn_sched_barrier(0);
            }
        }
        if (kt + 1 < nsteps) { *(LAS u32x4*)(nxt + skey * DK_STR + sch * 16) = kr; *(LAS u32x4*)(nxt + 64 * DK_STR + skey * DV_STR + sch * 16) = vr; }
        __syncthreads();
    }
    const float l0 = lsum[0] + xshfl<32>(lsum[0]), l1 = lsum[1] + xshfl<32>(lsum[1]);
    const float i0 = 1.f / fmaxf(l0, 1e-30f), i1 = lam / fmaxf(l1, 1e-30f);
    float ss = 0.f;
#pragma unroll
    for (int db = 0; db < 2; ++db)
#pragma unroll
        for (int i = 0; i < 16; ++i) { const float at = O[0][db][i] * i0 - O[1][db][i] * i1; O[0][db][i] = at; ss += at * at; }
    ss += xshfl<32>(ss);
    const float r = (1.f - lam_init) / sqrtf(ss * (1.f / 64.f) + 1e-5f);
    GAS bf16* op = ys + (rowb + q) * 1024 + 512 + h * 64;
#pragma unroll
    for (int db = 0; db < 2; ++db)
#pragma unroll
        for (int gq = 0; gq < 4; ++gq) { const int d0 = 32 * db + 8 * gq + 4 * hh; const f32x4 sg = *(const GAS f32x4*)(subg + d0);
            u32x2 w; w.x = cvtpk(O[0][db][4 * gq + 0] * r * sg[0], O[0][db][4 * gq + 1] * r * sg[1]); w.y = cvtpk(O[0][db][4 * gq + 2] * r * sg[2], O[0][db][4 * gq + 3] * r * sg[3]);
            *(GAS u32x2*)(op + d0) = w; }
}

DI void cmp_task(const KA& a, int l, const bf16* proj, float* kcvc, int task, int lane) {
    const int kv = task / (BATCH * NCMP), r = task % (BATCH * NCMP), b = r / NCMP, c = r % NCMP;
    const float* pos = a.in[kv ? 21 : 18] + (size_t)l * 2048; const float* w1 = a.in[kv ? 22 : 19] + (size_t)l * 2048 * 64; const float* w2 = a.in[kv ? 23 : 20] + (size_t)l * 4096;
    const size_t tokb = (size_t)b * SEQ + 16 * c; const int col0 = kv ? C_VC : C_KC;
    float h1 = 0.f;
    for (int li = 0; li < 32; ++li) { const float v = bf2f(proj[(tokb + li) * PLD + col0 + lane]) + pos[li * 64 + lane]; const float* wr = w1 + (size_t)(li * 64) * 64 + lane;
#pragma unroll
        for (int d = 0; d < 64; ++d) h1 += rl(v, d) * wr[d * 64]; }
    const float g = gelu_tanh(h1); float o = 0.f;
#pragma unroll
    for (int j = 0; j < 64; ++j) o += rl(g, j) * w2[j * 64 + lane];
    kcvc[((size_t)(kv * BATCH + b) * NCMP + c) * 64 + lane] = o;
}

DI void attn_block4(const bf16* proj, int keytok, bool valid, int dist, int kcol, int vcol, const LAS float* biasd, const LAS float* qs, float (&m)[4], float (&lsum)[4], float (&o)[4], int lane) {
    float acc[4]; dot_row64<4>(proj + (size_t)keytok * PLD + kcol, qs, acc);
    const int di = valid ? (dist < 128 ? dist : 128) : 0; float p[4];
#pragma unroll
    for (int h = 0; h < 4; ++h) { const float s = valid ? acc[h] + biasd[di * 12 + 8 + h] : -1e30f;
        const float bm = wave_max(s); const float mn = fmaxf(m[h], bm); const float al = __expf(m[h] - mn);
        p[h] = valid ? __expf(s - mn) : 0.f; lsum[h] = lsum[h] * al + wave_sum(p[h]); o[h] *= al; m[h] = mn; }
    const bf16* vb = proj + vcol + lane;
#pragma unroll 2
    for (int kl = 0; kl < 64; ++kl) { const int vt = rli(keytok, kl); const float vv = bf2f(vb[(size_t)vt * PLD]);
#pragma unroll
        for (int h = 0; h < 4; ++h) o[h] += rl(p[h], kl) * vv; }
}

DI void nsa_token(const KA& a, int l, const bf16* proj, bf16* ys, const float* kcvc, const LAS float* biasd, LAS float* wl, int tok, int lane) {
    LAS float* ps = wl; LAS float* qs = wl + 512; LAS float* scl = wl + 768; LAS int* sell = (LAS int*)(wl + 768 + 2048);
    const int b = tok / SEQ, t = tok % SEQ; const size_t rowb = (size_t)b * SEQ; const bf16* prow = proj + (size_t)tok * PLD;
#pragma unroll
    for (int h = 0; h < 4; ++h) qs[h * 64 + lane] = bf2f(prow[C_DQ + h * 64 + lane]) * 0.125f;
    LDS_WAIT(); asm volatile("" ::: "memory");
    const int ncv = (t >= 31) ? (((t - 31) >> 4) + 1 < NCMP ? ((t - 31) >> 4) + 1 : NCMP) : 0;
    const float* kc = kcvc + (size_t)(0 * BATCH + b) * NCMP * 64; const float* vc = kcvc + (size_t)(1 * BATCH + b) * NCMP * 64;
    float mx[4] = {-1e30f, -1e30f, -1e30f, -1e30f};
#pragma unroll 1
    for (int jc = 0; jc * 64 < ncv; ++jc) { const int c = jc * 64 + lane; const bool valid = c < ncv; const int cc = c < NCMP ? c : NCMP - 1;
        float acc[4]; dot_row64_f32<4>(kc + (size_t)cc * 64, qs, acc);
        const int dist = t - (16 * c + 31); const int di = valid ? (dist < 128 ? dist : 128) : 0;
#pragma unroll
        for (int h = 0; h < 4; ++h) { const float sv = valid ? acc[h] + biasd[di * 12 + 8 + h] : -1e30f; scl[h * 512 + c] = sv; mx[h] = fmaxf(mx[h], sv); } }
    float sum[4] = {0.f, 0.f, 0.f, 0.f};
#pragma unroll
    for (int h = 0; h < 4; ++h) mx[h] = wave_max(mx[h]);
    asm volatile("" ::: "memory");
#pragma unroll 1
    for (int jc = 0; jc * 64 < ncv; ++jc) { const int c = jc * 64 + lane;
#pragma unroll
        for (int h = 0; h < 4; ++h) { const float sv = scl[h * 512 + c]; const float p = (sv > -1e29f) ? __expf(sv - mx[h]) : 0.f; scl[h * 512 + c] = p; sum[h] += p; } }
#pragma unroll
    for (int h = 0; h < 4; ++h) sum[h] = 1.f / fmaxf(wave_sum(sum[h]), 1e-30f);
    asm volatile("" ::: "memory");
#pragma unroll 1
    for (int jc = 0; jc < 8; ++jc) { const int c = jc * 64 + lane; float tsum = 0.f;
        if (jc * 64 < ncv) {
#pragma unroll
            for (int h = 0; h < 4; ++h) { const float p = scl[h * 512 + c] * sum[h]; scl[h * 512 + c] = p; tsum += p; } }
        ps[c] = tsum; }
    LDS_WAIT(); asm volatile("" ::: "memory");
    float oc[4] = {0.f, 0.f, 0.f, 0.f};
#pragma unroll 2
    for (int c = 0; c < ncv; ++c) { const float vv = vc[(size_t)c * 64 + lane];
#pragma unroll
        for (int h = 0; h < 4; ++h) oc[h] += scl[h * 512 + c] * vv; }
    const int cur = t >> 6;
    float cand[2];
#pragma unroll
    for (int jj = 0; jj < 2; ++jj) { const int j = lane + 64 * jj; const int i0 = 4 * j;
        const float imp = (j > 0 ? ps[i0 - 1] : 0.f) + 2.f * (ps[i0] + ps[i0 + 1] + ps[i0 + 2]) + ps[i0 + 3];
        const bool forced = (j == 0) || (j == cur) || (j == cur - 1);
        cand[jj] = forced ? 1e4f : (j <= cur ? imp : -1.f); }
#pragma unroll 1
    for (int r = 0; r < 16; ++r) {
        float bv = cand[0]; int bi = lane; if (cand[1] > bv) { bv = cand[1]; bi = lane + 64; }
#define TOPK_STEP(O) { const float ov = xshfl<O>(bv); const int oi = xshfl_i<O>(bi); if (ov > bv || (ov == bv && oi < bi)) { bv = ov; bi = oi; } }
        TOPK_STEP(32) TOPK_STEP(16) TOPK_STEP(8) TOPK_STEP(4) TOPK_STEP(2) TOPK_STEP(1)
#undef TOPK_STEP
        bi = __builtin_amdgcn_readfirstlane(bi);
        if (lane == 0) sell[r] = bi;
        if (bi == lane) cand[0] = -3.f; if (bi == lane + 64) cand[1] = -3.f;
    }
    LDS_WAIT(); asm volatile("" ::: "memory");
    float ms[4] = {-1e30f, -1e30f, -1e30f, -1e30f}, ls[4] = {0.f, 0.f, 0.f, 0.f}, os[4] = {0.f, 0.f, 0.f, 0.f};
#pragma unroll 1
    for (int r = 0; r < 16; ++r) { const int j = __builtin_amdgcn_readfirstlane(sell[r]);
        if (j > cur) continue;
        const int kpos = 64 * j + lane; const bool valid = kpos <= t;
        attn_block4(proj, (int)rowb + kpos, valid, t - kpos, C_KS, C_VS, biasd, qs, ms, ls, os, lane); }
    float mw[4] = {-1e30f, -1e30f, -1e30f, -1e30f}, lw[4] = {0.f, 0.f, 0.f, 0.f}, ow[4] = {0.f, 0.f, 0.f, 0.f};
#pragma unroll 1
    for (int jc = 0; jc < 8; ++jc) { if (t - 64 * jc < 0) break;
        const int dist = 64 * jc + lane; const int kpos = t - dist; const bool valid = kpos >= 0;
        attn_block4(proj, (int)rowb + (valid ? kpos : 0), valid, dist, C_KW, C_VW, biasd, qs, mw, lw, ow, lane); }
#pragma unroll
    for (int h = 0; h < 4; ++h) { const float g0 = sigmoidf_(bf2f(prow[C_DG + h * 3 + 0])), g1 = sigmoidf_(bf2f(prow[C_DG + h * 3 + 1])), g2 = sigmoidf_(bf2f(prow[C_DG + h * 3 + 2]));
        const float y = g0 * oc[h] + g1 * os[h] / fmaxf(ls[h], 1e-30f) + g2 * ow[h] / fmaxf(lw[h], 1e-30f);
        ys[(size_t)tok * 1024 + 768 + h * 64 + lane] = (bf16)f2bf(y); }
    asm volatile("" ::: "memory");
}

DI void route_token(const KA& a, int l, bf16* x2b, int* rec_e, int* rec_slot, float* rec_w, unsigned* cnt, int tok, int lane_) {
    int lane = lane_; asm volatile("" : "+v"(lane));
    const float* xr = a.out + (size_t)tok * 1024; const float* g = a.in[28] + (size_t)l * 1024;
    float ss = 0.f;
#pragma unroll
    for (int j = 0; j < 4; ++j) { const f32x4 v = *(const f32x4*)(xr + 4 * (lane + 64 * j)); ss += (v[0] * v[0] + v[1] * v[1]) + (v[2] * v[2] + v[3] * v[3]); }
    const float r = 1.f / sqrtf(wave_sum(ss) * (1.f / 1024.f) + 1e-6f);
    const float* wg = a.in[29] + (size_t)l * 1024 * 4; const float* we = a.in[31] + (size_t)l * 1024 * 32;
    float lg[36];
#pragma unroll
    for (int i = 0; i < 36; ++i) lg[i] = 0.f;
#pragma unroll 1
    for (int j = 0; j < 4; ++j) { const int k0 = 4 * (lane + 64 * j);
        const f32x4 v = *(const f32x4*)(xr + k0); const f32x4 gv = *(const f32x4*)(g + k0); const f32x4 xn = v * r * gv;
        u32x2 w; w.x = pk2(xn[0], xn[1]); w.y = pk2(xn[2], xn[3]); *(u32x2*)(x2b + (size_t)tok * 1024 + k0) = w;
#pragma unroll
        for (int e = 0; e < 4; ++e) { const int k = k0 + e; const float xk = xn[e];
            const f32x4 g4 = *(const f32x4*)(wg + (size_t)k * 4);
            lg[0] += xk * g4[0]; lg[1] += xk * g4[1]; lg[2] += xk * g4[2]; lg[3] += xk * g4[3];
#pragma unroll
            for (int q = 0; q < 8; ++q) { const f32x4 e4 = *(const f32x4*)(we + (size_t)k * 32 + q * 4);
                lg[4 + q * 4 + 0] += xk * e4[0]; lg[4 + q * 4 + 1] += xk * e4[1]; lg[4 + q * 4 + 2] += xk * e4[2]; lg[4 + q * 4 + 3] += xk * e4[3]; }
            __builtin_amdgcn_sched_barrier(0); } }
#pragma unroll
    for (int i = 0; i < 36; ++i) lg[i] = wave_sum(lg[i]);
    const float* bg = a.in[30] + l * 4; const float* be = a.in[32] + l * 32;
#pragma unroll
    for (int i = 0; i < 4; ++i) lg[i] += bg[i];
#pragma unroll
    for (int i = 0; i < 32; ++i) lg[4 + i] += be[i];
    int gsel = 0; float gm = lg[0];
#pragma unroll
    for (int i = 1; i < 4; ++i) if (lg[i] > gm) { gm = lg[i]; gsel = i; }
    float gs = 0.f;
#pragma unroll
    for (int i = 0; i < 4; ++i) gs += __expf(lg[i] - gm);
    const float gwt = 1.f / gs;
    float v8[8];
#pragma unroll
    for (int i = 0; i < 8; ++i) { float x = lg[4 + i];
#pragma unroll
        for (int gq = 1; gq < 4; ++gq) x = (gsel == gq) ? lg[4 + gq * 8 + i] : x;
        v8[i] = x; }
    int i0 = 0; float m0 = v8[0];
#pragma unroll
    for (int i = 1; i < 8; ++i) if (v8[i] > m0) { m0 = v8[i]; i0 = i; }
    int i1 = -1; float m1 = -3e38f;
#pragma unroll
    for (int i = 0; i < 8; ++i) if (i != i0 && v8[i] > m1) { m1 = v8[i]; i1 = i; }
    const float w0 = 1.f / (1.f + __expf(m1 - m0)); const float w1 = 1.f - w0;
    if (lane == 0) {
        const int e0 = gsel * 8 + i0, e1 = gsel * 8 + i1;
        const unsigned s0 = __hip_atomic_fetch_add(cnt + e0, 1u, __ATOMIC_RELAXED, __HIP_MEMORY_SCOPE_AGENT);
        const unsigned s1 = __hip_atomic_fetch_add(cnt + e1, 1u, __ATOMIC_RELAXED, __HIP_MEMORY_SCOPE_AGENT);
        rec_e[tok * 2] = e0; rec_e[tok * 2 + 1] = e1; rec_slot[tok * 2] = (int)s0; rec_slot[tok * 2 + 1] = (int)s1; rec_w[tok * 2] = w0 * gwt; rec_w[tok * 2 + 1] = w1 * gwt;
    }
}
DI void expert_weights(const KA& a, int l, LAS unsigned char* lds, int gw, int NGW, int wave, int lane) {
    LAS float* scr = (LAS float*)(lds + wave * 16384);
    const float* wgt = a.in[33] + (size_t)l * 32 * 1024 * 256; const float* wup = a.in[34] + (size_t)l * 32 * 1024 * 256; const float* wdn = a.in[35] + (size_t)l * 32 * 256 * 1024;
    bf16* Wgu = (bf16*)(a.ws + WS_WGU); bf16* Wd = (bf16*)(a.ws + WS_WD);
    constexpr int I_E = 16 * 8, I_D = 4 * 32;
    constexpr int NIT = 32 * (2 * I_E + I_D);
    for (int it = gw; it < NIT; it += NGW) {
        const int e = it / (2 * I_E + I_D); int r = it % (2 * I_E + I_D);
        if (r < 2 * I_E) { const int up = r / I_E, q = r % I_E, kb = q / 8, nb = q % 8; const int n0 = nb * 32;
            const int drow = (n0 >> 7) * 256 + up * 128 + (n0 & 127);
            transpose_item((up ? wup : wgt) + (size_t)e * 1024 * 256, 256, 256, Wgu + (size_t)e * 512 * 1024, 1024, kb * 64, n0, drow, scr, lane);
        } else { r -= 2 * I_E; const int kb = r / 32, nb = r % 32;
            transpose_item(wdn + (size_t)e * 256 * 1024, 1024, 1024, Wd + (size_t)e * 1024 * 256, 256, kb * 64, nb * 32, nb * 32, scr, lane); }
    }
}
DI void build_offsets(const unsigned* cnt, LAS int* offt, int tid) {
    if (tid == 0) { int o = 0; for (int e = 0; e < 32; ++e) { offt[e] = o; const int c = (int)__hip_atomic_load(cnt + e, __ATOMIC_RELAXED, __HIP_MEMORY_SCOPE_AGENT); o += (c + 255) & ~255; } offt[32] = o; }
    __syncthreads();
    for (int rt = tid; rt < (MOE_ROWS >> 8); rt += 512) { int e = 0; for (int j = 1; j < 32; ++j) e += (offt[j] <= rt * 256) ? 1 : 0; offt[40 + rt] = e; }
    __syncthreads();
}

template <unsigned PM>
__global__ void __launch_bounds__(512, 2) mk_fwd(Args a_) {
    extern __shared__ __attribute__((aligned(16))) unsigned char lds_raw[];
    LAS unsigned char* lds = (LAS unsigned char*)lds_raw;
    const int wave0 = __builtin_amdgcn_readfirstlane((int)threadIdx.x >> 6);
    if (threadIdx.x < 36) ((LAS unsigned long long*)(lds + PTAB_OFF))[threadIdx.x] = (unsigned long long)a_.in[threadIdx.x];
    __syncthreads();
    KA a; a.in.base = (unsigned)(size_t)(lds + PTAB_OFF); a.out = a_.out; a.ws = a_.ws;
    const int G = gridDim.x, bid = blockIdx.x, NGW = G * 8;
#define PHASE_IDS() int wave = wave0; asm volatile("" : "+s"(wave)); const int lane = my_lane(); const int tid_ = wave * 64 + lane, gw = bid * 8 + wave; (void)tid_; (void)gw; \
    KA ap = a; asm volatile("" : "+s"(ap.ws), "+s"(ap.out), "+s"(ap.in.base)); \
    bf16* hb = (bf16*)(ap.ws + WS_HB); bf16* proj = (bf16*)(ap.ws + WS_PROJ); bf16* gates = (bf16*)(ap.ws + WS_GATES); \
    bf16* ys = hb; bf16* x2b = hb; bf16* merged = proj; bf16* eo = proj; \
    float* kcvc = (float*)(ap.ws + WS_KCVC); float* lrusum = (float*)(ap.ws + WS_LRUSUM); \
    int* rec_e = (int*)(ap.ws + WS_REC); int* rec_slot = rec_e + T * 2; float* rec_w = (float*)(rec_slot + T * 2); \
    int* rowtok = (int*)(ap.ws + WS_ROWTOK); float* roww = (float*)(ap.ws + WS_ROWW); \
    bf16* xs = (bf16*)(ap.ws + WS_XS); bf16* hmid = (bf16*)(ap.ws + WS_HMID); unsigned* ctl = (unsigned*)(ap.ws + WS_CTL); \
    (void)hb; (void)proj; (void)gates; (void)ys; (void)x2b; (void)merged; (void)eo; (void)kcvc; (void)lrusum; (void)rec_e; (void)rec_slot; (void)rec_w; (void)rowtok; (void)roww; (void)xs; (void)hmid; (void)ctl
    volatile LAS unsigned* MISC = (volatile LAS unsigned*)(lds + MISC_OFF);
    LAS float* biasd = (LAS float*)(lds + BIAS_OFF);
    LAS int* offt = (LAS int*)(lds + OFFT_OFF);
    { PHASE_IDS();
    if (tid_ < 64) MISC[tid_] = 0u;
    for (int i = tid_; i < 129 * 12; i += 512) { const int d = i / 12, hd = i % 12; const int bk = d < 128 ? T5_BUCKET[d] : 31; const float* rb = a.in[1]; biasd[i] = rb[bk * 12 + hd]; ((LAS float*)(lds + BIAS2_OFF))[i] = (rb[bk * 12 + hd] - rb[31 * 12 + hd]) * 1.4426950408889634f; } }
    __syncthreads();
    const int lo = a_.ph_lo, hi = a_.ph_hi;
    XcdBarrier bar; bar.bar = (unsigned*)(a.ws + WS_CTL) + CW_BAR; bar.x = 0; bar.st = nullptr;
    if (hi - lo > 1) { PHASE_IDS(); bar = xcd_barrier_post(ctl + CW_BAR, MISC + 8, tid_ == 0); }
#ifndef SUB_MASK
#define SUB_MASK 0xFFu
#endif
#define SUB(k) ((SUB_MASK >> (k)) & 1u)
#define HASP(k) ((PM >> ((k) % 10 + ((k) >= 20 ? 10 : 0))) & 1u)
#define IN(k) (HASP(k) && lo <= (k) && (k) < hi)
#define SEAM(k) do { if ((k) + 1 < hi) { const int sl_ = my_lane(); int sw_ = wave0; asm volatile("" : "+s"(sw_)); xcd_barrier(bar, sw_ == 0 && sl_ == 0); } } while (0)
    for (int l = 0; l < DEPTH; ++l) {
        const int pb = l * 10;
        if (IN(pb + 0)) { PHASE_IDS(); phase0_weights(ap, l, lds, gw, NGW, wave, lane); phase0_rows(ap, l, 0, gw, NGW, lane); SEAM(pb + 0); }
        if (IN(pb + 1)) {
            PHASE_IDS();
            pg8::Gemm g{1024, 1024, 1024}; SchedP1 S{(const char*)hb, (const char*)(ap.ws + WS_WIN), G, bid};
            EpiP1 E{proj, gates, ap.in[25] + (size_t)l * 4096};
            pg8::gemm_phase<EpiP1, SchedP1>(lds, g, S, E, tid_); SEAM(pb + 1);
        }
        if (IN(pb + 2)) {
            PHASE_IDS();
            float s1 = 0.f, s2 = 0.f;
            for (int i = 0; i < 32; ++i) { s1 += ap.in[13][l * 32 + i] * ap.in[14][l * 32 + i]; s2 += ap.in[15][l * 32 + i] * ap.in[16][l * 32 + i]; }
            const float lam_init = 0.8f - 0.6f * __expf(-0.3f * (float)l); const float lam = __expf(s1) - __expf(s2) + lam_init;
            if (SUB(0)) { const LAS float* bias2 = (const LAS float*)(lds + BIAS2_OFF); const GAS float* subg = (const GAS float*)(ap.in[17] + l * 64);
                for (int pi = bid; pi < 256; pi += G) { const int bh = pi >> 4, qlo = pi & 15;
                    diff_unit((const GAS bf16*)proj, (GAS bf16*)ys, lds, bias2, subg, lam, lam_init, bh >> 2, bh & 3, 31 - qlo, tid_, lane, wave);
                    diff_unit((const GAS bf16*)proj, (GAS bf16*)ys, lds, bias2, subg, lam, lam_init, bh >> 2, bh & 3, qlo, tid_, lane, wave); } }
            if (SUB(1)) for (int task = gw; task < 512; task += NGW) lru_task(ap, l, proj, ys, lrusum, task, lane, false);
            if (SUB(2)) for (int task = gw; task < 2 * BATCH * NCMP; task += NGW) cmp_task(ap, l, proj, kcvc, task, lane);
            if (SUB(3)) { LAS float* qs = (LAS float*)(lds + wave * 4096); for (int tok = gw; tok < T; tok += NGW) swa_token(ap, l, proj, ys, biasd, qs, tok, lane); }
            SEAM(pb + 2);
        }
        if (IN(pb + 3)) {
            PHASE_IDS();
            if (SUB(1)) for (int task = gw; task < 512; task += NGW) lru_task(ap, l, proj, ys, lrusum, task, lane, true);
            LAS float* ps = (LAS float*)(lds + wave * 12288);
            if (SUB(4)) for (int tok = gw; tok < T; tok += NGW) nsa_token(ap, l, proj, ys, kcvc, biasd, ps, tok, lane);
            SEAM(pb + 3);
        }
        if (IN(pb + 4)) {
            PHASE_IDS();
            pg8::Gemm g{256, 1024, 256}; SchedP3a S{(const char*)ys, (const char*)(ap.ws + WS_WBR), G, bid};
            EpiP3a E{merged, gates};
            pg8::gemm_phase<EpiP3a, SchedP3a>(lds, g, S, E, tid_); SEAM(pb + 4);
        }
        if (IN(pb + 5)) {
            PHASE_IDS();
            pg8::Gemm g{1024, 1024, 1024}; SchedP3b S{(const char*)merged, (const char*)(ap.ws + WS_WOUT), G, bid};
            EpiP3b E{(l == 0) ? ap.in[0] : ap.out, ap.out};
            pg8::gemm_phase<EpiP3b, SchedP3b>(lds, g, S, E, tid_); SEAM(pb + 5);
        }
        if (IN(pb + 6)) {
            PHASE_IDS();
            expert_weights(ap, l, lds, gw, NGW, wave, lane);
            for (int tok = gw; tok < T; tok += NGW) route_token(ap, l, x2b, rec_e, rec_slot, rec_w, ctl + CW_CNT + l * 32, tok, lane);
            SEAM(pb + 6);
        }
        if (IN(pb + 7)) {
            PHASE_IDS();
            build_offsets(ctl + CW_CNT + l * 32, offt, tid_);
            if (bid < 32) { const int e = bid; const int c = (int)__hip_atomic_load(ctl + CW_CNT + l * 32 + e, __ATOMIC_RELAXED, __HIP_MEMORY_SCOPE_AGENT);
                for (int p = offt[e] + c + tid_; p < offt[e + 1]; p += 512) rowtok[p] = -1; }
            for (int tok = gw; tok < T; tok += NGW) {
#pragma unroll
                for (int k = 0; k < 2; ++k) { const int e = rec_e[tok * 2 + k], slot = rec_slot[tok * 2 + k]; const int pos = offt[e] + slot;
                    const u32x4 v0 = *(const u32x4*)(x2b + (size_t)tok * 1024 + lane * 8), v1 = *(const u32x4*)(x2b + (size_t)tok * 1024 + 512 + lane * 8);
                    *(u32x4*)(xs + (size_t)pos * 1024 + lane * 8) = v0; *(u32x4*)(xs + (size_t)pos * 1024 + 512 + lane * 8) = v1;
                    if (lane == 0) { rowtok[pos] = tok * 2 + k; roww[pos] = rec_w[tok * 2 + k]; } } }
            SEAM(pb + 7);
        }
        if (IN(pb + 8)) {
            PHASE_IDS();
            build_offsets(ctl + CW_CNT + l * 32, offt, tid_);
            pg8::Gemm g{1024, 1024, 1024}; SchedM2 S{(const char*)xs, (const char*)(ap.ws + WS_WGU), offt, G, bid};
            EpiM2 E{hmid};
            pg8::gemm_phase<EpiM2, SchedM2>(lds, g, S, E, tid_); SEAM(pb + 8);
        }
        if (IN(pb + 9)) {
            PHASE_IDS();
            build_offsets(ctl + CW_CNT + l * 32, offt, tid_);
            pg8::Gemm g{256, 256, 256}; SchedM3 S{(const char*)hmid, (const char*)(ap.ws + WS_WD), offt, G, bid};
            EpiM3 E{eo, rowtok, roww};
            pg8::gemm_phase<EpiM3, SchedM3>(lds, g, S, E, tid_); SEAM(pb + 9);
        }
    }
    if (IN(20)) { PHASE_IDS(); phase0_rows(ap, DEPTH, 1, gw, NGW, lane); }
#undef IN
#undef SEAM
}

typedef void (*kern_t)(Args);
template <unsigned PM> static bool setup_kernel() {
    if (hipFuncSetAttribute((const void*)mk_fwd<PM>, hipFuncAttributeMaxDynamicSharedMemorySize, LDS_BYTES) != hipSuccess) { fprintf(stderr, "kernel_launch: hipFuncSetAttribute failed\n"); return false; }
    return true;
}
extern "C" void kernel_launch(void* const* d_in, const int* in_sizes, int n_in, void* d_out, int out_size, void* d_ws, size_t ws_size, hipStream_t stream) {
    static int grid = 0;
    if (grid == 0) {
        if (n_in != 36 || out_size != T * D || ws_size < WS_END) { fprintf(stderr, "kernel_launch: unexpected shapes (n_in %d out %d ws %zu)\n", n_in, out_size, ws_size); grid = -1; return; }
        int dev = 0, cus = 0;
        if (hipGetDevice(&dev) != hipSuccess || hipDeviceGetAttribute(&cus, hipDeviceAttributeMultiprocessorCount, dev) != hipSuccess) { grid = -1; return; }
        bool ok = true;
#if MK_ONE_LAUNCH
        ok = setup_kernel<0x7FFu>();
#else
        ok = setup_kernel<1u>() && setup_kernel<2u>() && setup_kernel<4u>() && setup_kernel<8u>() && setup_kernel<16u>() && setup_kernel<32u>() && setup_kernel<64u>() && setup_kernel<128u>() && setup_kernel<256u>() && setup_kernel<512u>() && setup_kernel<1024u>();
#endif
        if (!ok) { grid = -1; return; }
        (void)hipGetLastError();
        grid = cus;
    }
    if (grid < 0) return;
    if (hipMemsetAsync((char*)d_ws + WS_CTL, 0, CTL_ZERO_BYTES, stream) != hipSuccess) return;
    Args a{};
    for (int i = 0; i < 36; ++i) a.in[i] = (const float*)d_in[i];
    a.out = (float*)d_out; a.ws = (unsigned char*)d_ws;
#if MK_ONE_LAUNCH
    a.ph_lo = 0; a.ph_hi = NPH;
    hipLaunchKernelGGL(mk_fwd<0x7FFu>, dim3(grid), dim3(512), LDS_BYTES, stream, a);
#else
    static const kern_t kerns[11] = { mk_fwd<1u>, mk_fwd<2u>, mk_fwd<4u>, mk_fwd<8u>, mk_fwd<16u>, mk_fwd<32u>, mk_fwd<64u>, mk_fwd<128u>, mk_fwd<256u>, mk_fwd<512u>, mk_fwd<1024u> };
    for (int p = 0; p < NPH; ++p) { a.ph_lo = p; a.ph_hi = p + 1; hipLaunchKernelGGL(kerns[p < 20 ? p % 10 : 10], dim3(grid), dim3(512), LDS_BYTES, stream, a); }
#endif
}
```

```cpp
#include <hip/hip_runtime.h>
#include <cstdio>
#include <cstdint>

#ifndef MK_ONE_LAUNCH
#define MK_ONE_LAUNCH 1
#endif

#define DI __device__ __forceinline__
#define GAS __attribute__((address_space(1)))
#define LAS __attribute__((address_space(3)))
typedef unsigned short bf16;
typedef short bf16x8 __attribute__((ext_vector_type(8)));
typedef float f32x4 __attribute__((ext_vector_type(4)));
typedef unsigned u32x4 __attribute__((ext_vector_type(4)));
typedef unsigned u32x2 __attribute__((ext_vector_type(2)));
typedef float f32x16 __attribute__((ext_vector_type(16)));
typedef float f32x2 __attribute__((ext_vector_type(2)));
typedef short s16x4 __attribute__((ext_vector_type(4)));
typedef __bf16 bf16x2_t __attribute__((ext_vector_type(2)));
typedef short v4i16_t __attribute__((__vector_size__(4 * sizeof(short))));
#define MFMA32(a, b, c) __builtin_amdgcn_mfma_f32_32x32x16_bf16((a), (b), (c), 0, 0, 0)

constexpr int BATCH = 4, SEQ = 8192, T = BATCH * SEQ, D = 1024, DEPTH = 2;
constexpr int NIN = 2444, PLD = 2560, N1 = 6656, GLD = 4096;
constexpr int C_AX = 0, C_AG = 256, C_BQ = 512, C_BK = 768, C_BV = 896, C_CQ = 1024, C_CK = 1280, C_CV = 1536, C_DQ = 1792,
              C_KC = 2048, C_VC = 2112, C_KS = 2176, C_VS = 2240, C_KW = 2304, C_VW = 2368, C_DG = 2432;
constexpr int NCMP = 511;
constexpr int MOE_ROWS = 73728;
constexpr int NPH = 21;

constexpr size_t MiB = 1u << 20;
constexpr size_t WS_CTL = 0, CTL_ZERO_BYTES = 1 * MiB;
constexpr size_t WS_KCVC = 1 * MiB;
constexpr size_t WS_LRUSUM = 2 * MiB;
constexpr size_t WS_REC = 2 * MiB + 256 * 1024;
constexpr size_t WS_ROWTOK = 3 * MiB;
constexpr size_t WS_ROWW = 3 * MiB + 512 * 1024;
constexpr size_t WS_WIN = 4 * MiB;
constexpr size_t WS_WBR = 17 * MiB;
constexpr size_t WS_WOUT = 19 * MiB;
constexpr size_t WS_HB = 21 * MiB;
constexpr size_t WS_PROJ = 85 * MiB;
constexpr size_t WS_GATES = 245 * MiB;
constexpr size_t WS_WGU = 245 * MiB;
constexpr size_t WS_WD = 277 * MiB;
constexpr size_t WS_XS = 293 * MiB;
constexpr size_t WS_HMID = 437 * MiB;
constexpr size_t WS_END = 501 * MiB;
constexpr int CW_BAR = 4096;
constexpr int CW_CNT = 16384;

constexpr int RING_BYTES = 131072;
constexpr int MISC_OFF = RING_BYTES;
constexpr int BIAS_OFF = MISC_OFF + 256;
constexpr int OFFT_OFF = BIAS_OFF + 129 * 12 * 4;
constexpr int PTAB_OFF = OFFT_OFF + (40 + 288) * 4;
constexpr int BIAS2_OFF = PTAB_OFF + 36 * 8;
constexpr int LDS_BYTES = 147456;
static_assert(PTAB_OFF % 8 == 0 && BIAS2_OFF + 129 * 12 * 4 <= LDS_BYTES, "LDS map");

DI float bf2f(bf16 v) { return __builtin_bit_cast(float, (unsigned)v << 16); }
DI float lo_bf(unsigned w) { return __builtin_bit_cast(float, w << 16); }
DI float hi_bf(unsigned w) { return __builtin_bit_cast(float, w & 0xffff0000u); }
DI unsigned f2bf(float f) { unsigned u = __builtin_bit_cast(unsigned, f); return (u + 0x7fffu + ((u >> 16) & 1u)) >> 16; }
DI unsigned pk2(float lo, float hi) { return f2bf(lo) | (f2bf(hi) << 16); }
DI float rl(float v, int i) { return __builtin_bit_cast(float, __builtin_amdgcn_readlane(__builtin_bit_cast(int, v), i)); }
DI int rli(int v, int i) { return __builtin_amdgcn_readlane(v, i); }
DI int my_lane() { int l; asm volatile("v_mbcnt_lo_u32_b32 %0, -1, 0\n\tv_mbcnt_hi_u32_b32 %0, -1, %0" : "=v"(l)); return l; }
template <int O> DI int xshfl_i(int v) {
    if constexpr (O < 32) return __builtin_amdgcn_ds_swizzle(v, (O << 10) | 0x1f);
    else { const int l = my_lane(); return __builtin_amdgcn_ds_bpermute((l ^ 32) << 2, v); }
}
template <int O> DI float xshfl(float v) { return __builtin_bit_cast(float, xshfl_i<O>(__builtin_bit_cast(int, v))); }
DI float wave_sum(float v) { v += xshfl<1>(v); v += xshfl<2>(v); v += xshfl<4>(v); v += xshfl<8>(v); v += xshfl<16>(v); v += xshfl<32>(v); return v; }
DI float wave_max(float v) { v = fmaxf(v, xshfl<1>(v)); v = fmaxf(v, xshfl<2>(v)); v = fmaxf(v, xshfl<4>(v)); v = fmaxf(v, xshfl<8>(v)); v = fmaxf(v, xshfl<16>(v)); v = fmaxf(v, xshfl<32>(v)); return v; }
DI float sigmoidf_(float x) { return 1.f / (1.f + __expf(-x)); }
DI float gelu_tanh(float x) { const float u = 0.7978845608028654f * (x + 0.044715f * x * x * x); const float e = __expf(2.f * u); const float th = 1.f - 2.f / (e + 1.f); return 0.5f * x * (1.f + th); }
DI float softplusf_(float x) { return fmaxf(x, 0.f) + log1pf(__expf(-fabsf(x))); }
#define LDS_WAIT() asm volatile("s_waitcnt lgkmcnt(0)" ::: "memory")
#define VM_WAIT() asm volatile("s_waitcnt vmcnt(0)" ::: "memory")

__device__ const unsigned char T5_BUCKET[128] = {
0,1,2,3,4,5,6,7,8,9,10,11,12,13,14,15,16,16,16,17,17,18,18,18,19,19,19,20,20,20,20,21,21,21,21,22,22,22,22,22,23,23,23,23,23,23,24,24,24,24,24,24,25,25,25,25,25,25,25,26,26,26,26,26,26,26,26,27,27,27,27,27,27,27,27,27,27,28,28,28,28,28,28,28,28,28,28,29,29,29,29,29,29,29,29,29,29,29,29,30,30,30,30,30,30,30,30,30,30,30,30,30,30,31,31,31,31,31,31,31,31,31,31,31,31,31,31,31};

#define XB_TMO      128
#define XB_XCNT(j)  (256  + 64 * (j))
#define XB_XSUB(j)  (1280 + 64 * (j))
#define XB_XGEN(j)  (2304 + 64 * (j))
#define XB_TOP      3328
#define XB_TOPGEN   3392
#define XCD_BAR_WORDS 3456
#define XB_SPIN_CAP (1u << 22)
DI unsigned xb_ld(unsigned* p)              { return __hip_atomic_load(p, __ATOMIC_RELAXED, __HIP_MEMORY_SCOPE_AGENT); }
DI unsigned xb_add(unsigned* p, unsigned v) { return __hip_atomic_fetch_add(p, v, __ATOMIC_RELAXED, __HIP_MEMORY_SCOPE_AGENT); }
DI unsigned xb_xcc_id() { return (unsigned)__builtin_amdgcn_s_getreg((3 << 11) | 20) & 0xFu; }
#define XB_SPIN(cond, bar) do { unsigned _sp = 0; while (cond) { __builtin_amdgcn_s_sleep(1); \
    if ((++_sp & 255u) == 0u) { if (xb_ld(&(bar)[XB_TMO])) break; if (_sp > XB_SPIN_CAP) { atomicAdd(&(bar)[XB_TMO], 1u); break; } } } } while (0)
struct XcdBarrier { unsigned* bar; unsigned x; volatile LAS unsigned* st; };
DI XcdBarrier xcd_barrier_post(unsigned* bar, volatile LAS unsigned* st, bool leader) {
    XcdBarrier b; b.bar = bar; b.x = xb_xcc_id(); b.st = st;
    if (leader) (void)xb_add(&bar[XB_XCNT(b.x)], 1u);
    return b;
}
DI void xcd_barrier_complete(unsigned* bar, unsigned x, unsigned& nloc, unsigned& nx) {
    const unsigned G = gridDim.x * gridDim.y * gridDim.z;
    unsigned sum, cnt, mine, sp = 0u;
    for (;;) {
        sum = 0u; cnt = 0u; mine = 0u;
#pragma unroll
        for (unsigned j = 0; j < 16; ++j) { const unsigned c = xb_ld(&bar[XB_XCNT(j)]); sum += c; cnt += (c > 0u) ? 1u : 0u; mine = (j == x) ? c : mine; }
        if (sum == G) break;
        __builtin_amdgcn_s_sleep(1);
        if ((++sp & 255u) == 0u) { if (xb_ld(&bar[XB_TMO])) break; if (sp > XB_SPIN_CAP) { atomicAdd(&bar[XB_TMO], 1u); break; } }
    }
    nloc = mine > 0u ? mine : 1u; nx = cnt > 0u ? cnt : 1u;
}
DI void xcd_barrier(const XcdBarrier& b, bool leader) {
    asm volatile("s_waitcnt vmcnt(0)" ::: "memory");
    __syncthreads();
    if (leader) {
        unsigned* bar = b.bar;
        __builtin_amdgcn_s_waitcnt(0);
        unsigned nloc = b.st[0], nx = b.st[1];
        if (nloc == 0u) { xcd_barrier_complete(bar, b.x, nloc, nx); b.st[0] = nloc; b.st[1] = nx; }
        const unsigned old = xb_add(&bar[XB_XSUB(b.x)], 1u);
        const unsigned gen = old / nloc;
        if (old + 1u == (gen + 1u) * nloc) {
            __builtin_amdgcn_fence(__ATOMIC_RELEASE, "agent");
            asm volatile("s_waitcnt vmcnt(0)" ::: "memory");
            const unsigned og = xb_add(&bar[XB_TOP], 1u);
            const unsigned tg = og / nx;
            if (og + 1u == (tg + 1u) * nx) xb_add(&bar[XB_TOPGEN], 1u);
            else XB_SPIN(xb_ld(&bar[XB_TOPGEN]) == tg, bar);
            __builtin_amdgcn_fence(__ATOMIC_ACQUIRE, "agent");
            xb_add(&bar[XB_XGEN(b.x)], 1u);
            asm volatile("s_waitcnt vmcnt(0)" ::: "memory");
        } else {
            XB_SPIN(xb_ld(&bar[XB_XGEN(b.x)]) == gen, bar);
            __builtin_amdgcn_fence(__ATOMIC_ACQUIRE, "agent");
            asm volatile("s_waitcnt vmcnt(0)" ::: "memory");
        }
    }
    __syncthreads();
}

namespace pg8 {
constexpr int BM = 256, BK = 64, HALF = 128, HTB = HALF * BK * 2;
__host__ __device__ __forceinline__ int lds_byte(int r, int c) { const int st = (r >> 4) * 2 + (c >> 5), rr = r & 15, cc = c & 31, ob = rr * 64 + cc * 2; return st * 1024 + (ob ^ (((ob >> 9) & 1) << 5)); }
__host__ __device__ __forceinline__ void stage_rc(int b, int& R, int& C) { const int st = b / 1024, sb = b % 1024, swz = sb ^ (((sb >> 9) & 1) << 5); R = (st >> 1) * 16 + swz / 64; C = (st & 1) * 32 + (swz % 64) / 2; }
__host__ __device__ __forceinline__ int perm32(int rho) { const int n = rho >> 4, i = rho & 15; return 8 * (i >> 2) + 4 * n + (i & 3); }
struct Unit { const char* a; const char* b; int pm, pn, aux, pad; };
struct Gemm { int K, lda, ldb; };
template <class Epi, class Sched>
DI void gemm_phase(LAS unsigned char* lds, const Gemm g, const Sched& S, const Epi& E, int tid_in) {
    int tid = tid_in; asm volatile("" : "+v"(tid));
    const int wid = __builtin_amdgcn_readfirstlane(tid >> 6), lane = tid & 63, wr = wid >> 2, wc = wid & 3, fr = lane & 15, fq = lane >> 4;
    const int K = g.K, nt = K / BK;
    unsigned voffA[2], voffB[2];
#pragma unroll
    for (int i = 0; i < 2; ++i) { int R, C; stage_rc(tid * 16 + i * 8192, R, C); const int Rb = (R & ~31) + perm32(R & 31);
        voffA[i] = (unsigned)(R * g.lda + C) * 2u; voffB[i] = (unsigned)(Rb * g.ldb + C) * 2u; }
    const size_t kstep = (size_t)(BK * 2);
    const size_t hstepA = (size_t)HALF * g.lda * 2, hstepB = (size_t)HALF * g.ldb * 2;
    const unsigned ldsw = (unsigned)wid * 1024u;
    const int aoff = lds_byte(wr * 64 + fr, fq * 8), boff = lds_byte(wc * 32 + fr, fq * 8);
#define PG8_SA(b, h) (((b) * 2 + (h)) * HTB)
#define PG8_SB(b, h) ((4 + (b) * 2 + (h)) * HTB)
#define PG8_STAGE(bufoff, gbase, voff) do { _Pragma("unroll") for (int _i = 0; _i < 2; ++_i) \
        __builtin_amdgcn_global_load_lds((const unsigned*)((const char*)(gbase) + (voff)[_i]), (LAS unsigned*)(lds + (bufoff) + ldsw + _i * 8192), 16, 0, 0); } while (0)
#define PG8_LDA(dst, b, h) do { _Pragma("unroll") for (int m = 0; m < 4; ++m) _Pragma("unroll") for (int k = 0; k < 2; ++k) dst[m][k] = *(const LAS bf16x8*)(lds + PG8_SA(b, h) + aoff + m * 2048 + k * 1024); } while (0)
#define PG8_LDB(dst, b, h) do { _Pragma("unroll") for (int n = 0; n < 2; ++n) _Pragma("unroll") for (int k = 0; k < 2; ++k) dst[n][k] = *(const LAS bf16x8*)(lds + PG8_SB(b, h) + boff + n * 2048 + k * 1024); } while (0)
#define PG8_MMA(ai, bj, At, Bt) do { __builtin_amdgcn_s_setprio(1); _Pragma("unroll") for (int m = 0; m < 4; ++m) _Pragma("unroll") for (int n = 0; n < 2; ++n) _Pragma("unroll") for (int k = 0; k < 2; ++k) \
        acc[ai][bj][m][n] = __builtin_amdgcn_mfma_f32_16x16x32_bf16(Bt[n][k], At[m][k], acc[ai][bj][m][n], 0, 0, 0); __builtin_amdgcn_s_setprio(0); } while (0)
#define PG8_WAIT_V(n) asm volatile("s_waitcnt vmcnt(" #n ")" ::: "memory")
#define PG8_WAIT_L(n) asm volatile("s_waitcnt lgkmcnt(" #n ")" ::: "memory")
#define PG8_BAR __builtin_amdgcn_s_barrier()
#define PG8_SCHED __builtin_amdgcn_sched_barrier(0)
    Unit cur, nxt; int ui = 0;
    if (!S.next(0, cur)) return;
    f32x4 acc[2][2][4][2];
#pragma unroll
    for (int a = 0; a < 2; ++a)
#pragma unroll
        for (int b = 0; b < 2; ++b)
#pragma unroll
            for (int m = 0; m < 4; ++m)
#pragma unroll
                for (int n = 0; n < 2; ++n) acc[a][b][m][n] = (f32x4){0.f, 0.f, 0.f, 0.f};
    bf16x8 At[4][2], B0[2][2], B1[2][2];
    const char* cA = cur.a; const char* cB = cur.b;
    PG8_STAGE(PG8_SB(0, 0), cB, voffB); PG8_STAGE(PG8_SB(0, 1), cB + hstepB, voffB); PG8_STAGE(PG8_SA(0, 0), cA, voffA); PG8_STAGE(PG8_SA(0, 1), cA + hstepA, voffA);
    if (wr == 1) PG8_BAR;
    PG8_WAIT_V(2); PG8_BAR;
    PG8_STAGE(PG8_SB(1, 0), cB + kstep, voffB); PG8_STAGE(PG8_SA(1, 0), cA + kstep, voffA); PG8_STAGE(PG8_SB(1, 1), cB + hstepB + kstep, voffB);
    PG8_WAIT_V(6); PG8_BAR;
    for (;;) {
        const bool has_next = S.next(ui + 1, nxt);
        const char* nA = has_next ? nxt.a : cA; const char* nB = has_next ? nxt.b : cB;
        for (int t = 0; t < nt; t += 2) {
            const bool last = (t == nt - 2);
            const char* a1 = cA + (size_t)(t + 1) * kstep;
            const char* a2 = last ? nA : cA + (size_t)(t + 2) * kstep; const char* b2 = last ? nB : cB + (size_t)(t + 2) * kstep;
            const char* a3 = a2 + kstep; const char* b3 = b2 + kstep;
            PG8_LDB(B0, 0, 0); PG8_LDB(B1, 0, 1); PG8_SCHED; PG8_LDA(At, 0, 0); PG8_STAGE(PG8_SA(1, 1), a1 + hstepA, voffA);
            PG8_WAIT_V(8); PG8_WAIT_L(0); PG8_BAR; PG8_MMA(0, 0, At, B0); PG8_MMA(0, 1, At, B1); PG8_BAR; PG8_SCHED;
            PG8_LDA(At, 0, 1); PG8_STAGE(PG8_SB(0, 0), b2, voffB); PG8_STAGE(PG8_SB(0, 1), b2 + hstepB, voffB); PG8_STAGE(PG8_SA(0, 0), a2, voffA);
            PG8_WAIT_V(8); PG8_WAIT_L(0); PG8_BAR; PG8_MMA(1, 0, At, B0); PG8_MMA(1, 1, At, B1); PG8_BAR; PG8_SCHED;
            PG8_LDB(B0, 1, 0); PG8_LDB(B1, 1, 1); PG8_SCHED; PG8_LDA(At, 1, 0); PG8_STAGE(PG8_SA(0, 1), a2 + hstepA, voffA);
            PG8_WAIT_V(8); PG8_WAIT_L(0); PG8_BAR; PG8_MMA(0, 0, At, B0); PG8_MMA(0, 1, At, B1); PG8_BAR; PG8_SCHED;
            PG8_LDA(At, 1, 1); PG8_STAGE(PG8_SB(1, 0), b3, voffB); PG8_STAGE(PG8_SB(1, 1), b3 + hstepB, voffB); PG8_STAGE(PG8_SA(1, 0), a3, voffA);
            PG8_WAIT_V(8); PG8_WAIT_L(0); PG8_BAR; PG8_MMA(1, 0, At, B0); PG8_MMA(1, 1, At, B1); PG8_BAR; PG8_SCHED;
        }
        if (wr == 0) PG8_BAR;
        { const int el = my_lane(); E(acc, cur, wr, wc, el & 15, el >> 4); }
        if (!has_next) break;
#pragma unroll
        for (int a = 0; a < 2; ++a)
#pragma unroll
            for (int b = 0; b < 2; ++b)
#pragma unroll
                for (int m = 0; m < 4; ++m)
#pragma unroll
                    for (int n = 0; n < 2; ++n) acc[a][b][m][n] = (f32x4){0.f, 0.f, 0.f, 0.f};
        cur = nxt; cA = nA; cB = nB; ++ui;
        if (wr == 1) PG8_BAR;
    }
    PG8_WAIT_V(0);
    PG8_BAR;
#undef PG8_SA
#undef PG8_SB
#undef PG8_STAGE
#undef PG8_LDA
#undef PG8_LDB
#undef PG8_MMA
#undef PG8_WAIT_V
#undef PG8_WAIT_L
#undef PG8_BAR
#undef PG8_SCHED
}
}
using pg8::Unit;

DI unsigned cvt_pk_bf16(float lo, float hi) { unsigned r; asm volatile("v_cvt_pk_bf16_f32 %0, %1, %2" : "=v"(r) : "v"(lo), "v"(hi)); return r; }
DI u32x4 pack8(const f32x4& v0, const f32x4& v1) { u32x4 w; w.x = cvt_pk_bf16(v0[0], v0[1]); w.y = cvt_pk_bf16(v0[2], v0[3]); w.z = cvt_pk_bf16(v1[0], v1[1]); w.w = cvt_pk_bf16(v1[2], v1[3]); return w; }

struct SchedP1 {
    const char* A; const char* B; int G, c;
    DI bool next(int i, Unit& u) const {
        constexpr int nM = 128, nN = 26, nwg = nM * nN, NXCD = 8, WGM = 8;
        const long L = (long)i * G + c; if (L >= nwg) return false;
        int wgid = (int)L; { const int q = nwg / NXCD, r = nwg % NXCD, xcd = wgid % NXCD, off = wgid / NXCD; wgid = (xcd < r ? xcd * (q + 1) : r * (q + 1) + (xcd - r) * q) + off; }
        const int nig = WGM * nN, gid = wgid / nig, fm = gid * WGM, gsz = (nM - fm) < WGM ? (nM - fm) : WGM;
        u.pm = fm + ((wgid % nig) % gsz); u.pn = (wgid % nig) / gsz; u.aux = 0; u.pad = 0;
        u.a = A + (size_t)u.pm * 256 * 1024 * 2; u.b = B + (size_t)u.pn * 256 * 1024 * 2; return true;
    }
};
struct SchedP3a {
    const char* ys; const char* wbr; int G, c;
    DI bool next(int i, Unit& u) const {
        const int tile = (i >> 2) * G + c; if (tile >= 512) return false;
        const int br = i & 3; u.pm = tile >> 2; u.pn = tile & 3; u.aux = br; u.pad = 0;
        u.a = ys + ((size_t)u.pm * 256 * 1024 + br * 256) * 2; u.b = wbr + ((size_t)br * 1024 * 256 + (size_t)u.pn * 256 * 256) * 2; return true;
    }
};
struct SchedP3b {
    const char* A; const char* B; int G, c;
    DI bool next(int i, Unit& u) const {
        const int L = i * G + c; if (L >= 512) return false;
        u.pm = L >> 2; u.pn = L & 3; u.aux = 0; u.pad = 0;
        u.a = A + (size_t)u.pm * 256 * 1024 * 2; u.b = B + (size_t)u.pn * 256 * 1024 * 2; return true;
    }
};
struct SchedM2 {
    const char* xs; const char* wgu; const LAS int* offt; int G, c;
    DI bool next(int i, Unit& u) const {
        const int NT = __builtin_amdgcn_readfirstlane(offt[32]) >> 8; const int L = i * G + c; if (L >= NT * 2) return false;
        const int rt = L >> 1, pn = L & 1; const int e = __builtin_amdgcn_readfirstlane(offt[40 + rt]);
        u.pm = rt; u.pn = pn; u.aux = e; u.pad = 0;
        u.a = xs + (size_t)rt * 256 * 1024 * 2; u.b = wgu + ((size_t)e * 512 + pn * 256) * 1024 * 2; return true;
    }
};
struct SchedM3 {
    const char* hmid; const char* wd; const LAS int* offt; int G, c;
    DI bool next(int i, Unit& u) const {
        const int NT = __builtin_amdgcn_readfirstlane(offt[32]) >> 8; const int L = i * G + c; if (L >= NT * 4) return false;
        const int rt = L >> 2, pn = L & 3; const int e = __builtin_amdgcn_readfirstlane(offt[40 + rt]);
        u.pm = rt; u.pn = pn; u.aux = e; u.pad = 0;
        u.a = hmid + (size_t)rt * 256 * 256 * 2; u.b = wd + ((size_t)e * 1024 + pn * 256) * 256 * 2; return true;
    }
};

struct EpiP1 {
    bf16* proj; bf16* gates; const float* bgate;
    DI void operator()(const f32x4 (&acc)[2][2][4][2], const Unit& u, int wr, int wc, int fr, int fq) const {
        const int row0 = u.pm * 256 + wr * 64 + fr; const int colt = u.pn * 256 + wc * 32 + 8 * fq;
        if (u.pn < 10) {
#pragma unroll
            for (int ai = 0; ai < 2; ++ai)
#pragma unroll
                for (int m = 0; m < 4; ++m) { bf16* rowp = proj + (size_t)(row0 + ai * 128 + m * 16) * PLD + colt;
#pragma unroll
                    for (int bj = 0; bj < 2; ++bj) *(u32x4*)(rowp + bj * 128) = pack8(acc[ai][bj][m][0], acc[ai][bj][m][1]); }
        } else {
            const int gcol = colt - 2560;
            f32x4 bv[2][2];
#pragma unroll
            for (int bj = 0; bj < 2; ++bj)
#pragma unroll
                for (int n = 0; n < 2; ++n) bv[bj][n] = *(const f32x4*)(bgate + gcol + bj * 128 + 4 * n);
#pragma unroll
            for (int ai = 0; ai < 2; ++ai)
#pragma unroll
                for (int m = 0; m < 4; ++m) { bf16* rowp = gates + (size_t)(row0 + ai * 128 + m * 16) * GLD + gcol;
#pragma unroll
                    for (int bj = 0; bj < 2; ++bj) { f32x4 v0 = acc[ai][bj][m][0] + bv[bj][0], v1 = acc[ai][bj][m][1] + bv[bj][1];
#pragma unroll
                        for (int e = 0; e < 4; ++e) { v0[e] = sigmoidf_(v0[e]); v1[e] = sigmoidf_(v1[e]); }
                        *(u32x4*)(rowp + bj * 128) = pack8(v0, v1); }
                    __builtin_amdgcn_sched_barrier(0); }
        }
    }
};
struct EpiP3a {
    bf16* merged; const bf16* gates;
    DI void operator()(const f32x4 (&acc)[2][2][4][2], const Unit& u, int wr, int wc, int fr, int fq) const {
        const int row0 = u.pm * 256 + wr * 64 + fr; const int colt = u.pn * 256 + wc * 32 + 8 * fq; const int br = u.aux;
#pragma unroll
        for (int ai = 0; ai < 2; ++ai)
#pragma unroll
            for (int m = 0; m < 4; ++m) { const size_t row = (size_t)(row0 + ai * 128 + m * 16);
#pragma unroll
                for (int bj = 0; bj < 2; ++bj) {
                    const u32x4 gw = *(const u32x4*)(gates + row * GLD + br * 1024 + colt + bj * 128);
                    bf16* mp = merged + row * 1024 + colt + bj * 128;
                    f32x4 v0 = acc[ai][bj][m][0], v1 = acc[ai][bj][m][1];
                    v0[0] *= lo_bf(gw.x); v0[1] *= hi_bf(gw.x); v0[2] *= lo_bf(gw.y); v0[3] *= hi_bf(gw.y);
                    v1[0] *= lo_bf(gw.z); v1[1] *= hi_bf(gw.z); v1[2] *= lo_bf(gw.w); v1[3] *= hi_bf(gw.w);
                    if (br != 0) { const u32x4 mw = *(const u32x4*)mp;
                        v0[0] += lo_bf(mw.x); v0[1] += hi_bf(mw.x); v0[2] += lo_bf(mw.y); v0[3] += hi_bf(mw.y);
                        v1[0] += lo_bf(mw.z); v1[1] += hi_bf(mw.z); v1[2] += lo_bf(mw.w); v1[3] += hi_bf(mw.w); }
                    *(u32x4*)mp = pack8(v0, v1); }
                __builtin_amdgcn_sched_barrier(0); }
    }
};
struct EpiP3b {
    const float* xin; float* out;
    DI void operator()(const f32x4 (&acc)[2][2][4][2], const Unit& u, int wr, int wc, int fr, int fq) const {
        const int row0 = u.pm * 256 + wr * 64 + fr; const int colt = u.pn * 256 + wc * 32 + 8 * fq;
#pragma unroll
        for (int ai = 0; ai < 2; ++ai)
#pragma unroll
            for (int m = 0; m < 4; ++m) { const size_t off = (size_t)(row0 + ai * 128 + m * 16) * 1024 + colt;
#pragma unroll
                for (int bj = 0; bj < 2; ++bj)
#pragma unroll
                    for (int n = 0; n < 2; ++n) { const f32x4 xv = *(const f32x4*)(xin + off + bj * 128 + 4 * n); *(f32x4*)(out + off + bj * 128 + 4 * n) = xv + acc[ai][bj][m][n]; }
                __builtin_amdgcn_sched_barrier(0); }
    }
};
struct EpiM2 {
    bf16* hmid;
    DI void operator()(const f32x4 (&acc)[2][2][4][2], const Unit& u, int wr, int wc, int fr, int fq) const {
        const int row0 = u.pm * 256 + wr * 64 + fr; const int col = u.pn * 128 + wc * 32 + 8 * fq;
#pragma unroll
        for (int ai = 0; ai < 2; ++ai)
#pragma unroll
            for (int m = 0; m < 4; ++m) { f32x4 h0, h1;
#pragma unroll
                for (int e = 0; e < 4; ++e) { const float g0 = acc[ai][0][m][0][e], g1 = acc[ai][0][m][1][e];
                    h0[e] = g0 * sigmoidf_(g0) * acc[ai][1][m][0][e]; h1[e] = g1 * sigmoidf_(g1) * acc[ai][1][m][1][e]; }
                *(u32x4*)(hmid + (size_t)(row0 + ai * 128 + m * 16) * 256 + col) = pack8(h0, h1); }
    }
};
struct EpiM3 {
    bf16* eo; const int* rowtok; const float* roww;
    DI void operator()(const f32x4 (&acc)[2][2][4][2], const Unit& u, int wr, int wc, int fr, int fq) const {
        const int row0 = u.pm * 256 + wr * 64 + fr; const int colt = u.pn * 256 + wc * 32 + 8 * fq;
#pragma unroll
        for (int ai = 0; ai < 2; ++ai)
#pragma unroll
            for (int m = 0; m < 4; ++m) { const int row = row0 + ai * 128 + m * 16; const int tk = rowtok[row];
                if (tk >= 0) { const float w = roww[row]; bf16* op = eo + (size_t)tk * 1024 + colt;
#pragma unroll
                    for (int bj = 0; bj < 2; ++bj) *(u32x4*)(op + bj * 128) = pack8(acc[ai][bj][m][0] * w, acc[ai][bj][m][1] * w); }
                __builtin_amdgcn_sched_barrier(0); }
    }
};

struct Args { const float* in[36]; float* out; unsigned char* ws; int ph_lo, ph_hi; };
struct InTab { unsigned base;
    DI const float* operator[](int i) const { unsigned long long v; const unsigned addr = base + (unsigned)i * 8u;
        asm volatile("ds_read_b64 %0, %1\n\ts_waitcnt lgkmcnt(0)" : "=v"(v) : "v"(addr) : "memory");
        const unsigned lo = __builtin_amdgcn_readfirstlane((unsigned)v), hi = __builtin_amdgcn_readfirstlane((unsigned)(v >> 32));
        return (const float*)(((unsigned long long)hi << 32) | lo); } };
struct KA { InTab in; float* out; unsigned char* ws; };

DI void transpose_item(const float* W, int ldw, int nvalid, bf16* WT, int ldt, int k0, int n0, int dst_row0, LAS float* scr, int lane) {
    const bool nok = (n0 + (lane & 31)) < nvalid;
#pragma unroll 8
    for (int i = 0; i < 32; ++i) { const int kk = 2 * i + (lane >> 5); scr[kk * 33 + (lane & 31)] = nok ? W[(size_t)(k0 + kk) * ldw + n0 + (lane & 31)] : 0.f; }
    LDS_WAIT(); asm volatile("" ::: "memory");
    const int c = lane & 7;
#pragma unroll
    for (int j = 0; j < 4; ++j) { const int n = (lane >> 3) + 8 * j; const LAS float* s = scr + (8 * c) * 33 + n;
        u32x4 o; o.x = pk2(s[0 * 33], s[1 * 33]); o.y = pk2(s[2 * 33], s[3 * 33]); o.z = pk2(s[4 * 33], s[5 * 33]); o.w = pk2(s[6 * 33], s[7 * 33]);
        if (n0 + n < nvalid) *(u32x4*)(WT + (size_t)(dst_row0 + n) * ldt + k0 + 8 * c) = o; }
    LDS_WAIT(); asm volatile("" ::: "memory");
}
DI void phase0_weights(const KA& a, int l, LAS unsigned char* lds, int gw, int NGW, int wave, int lane) {
    LAS float* scr = (LAS float*)(lds + wave * 16384);
    const float* w_in = a.in[4] + (size_t)l * 1024 * NIN;
    const float* w_gate = a.in[24] + (size_t)l * 4 * 1024 * 1024;
    const float* w_br = a.in[26] + (size_t)l * 4 * 256 * 1024;
    const float* w_out = a.in[27] + (size_t)l * 1024 * 1024;
    bf16* Wt_in = (bf16*)(a.ws + WS_WIN); bf16* Wt_br = (bf16*)(a.ws + WS_WBR); bf16* Wt_out = (bf16*)(a.ws + WS_WOUT);
    constexpr int I_IN = 16 * 77, I_G = 4 * 16 * 32, I_B = 4 * 4 * 32, I_O = 16 * 32, NIT = I_IN + I_G + I_B + I_O;
    for (int it = gw; it < NIT; it += NGW) {
        int r = it;
        if (r < I_IN) { const int kb = r / 77, nb = r % 77; transpose_item(w_in, NIN, NIN, Wt_in, 1024, kb * 64, nb * 32, nb * 32, scr, lane); continue; } r -= I_IN;
        if (r < I_G) { const int br = r / 512, q = r % 512, kb = q / 32, nb = q % 32; transpose_item(w_gate + (size_t)br * 1024 * 1024, 1024, 1024, Wt_in, 1024, kb * 64, nb * 32, 2560 + br * 1024 + nb * 32, scr, lane); continue; } r -= I_G;
        if (r < I_B) { const int br = r / 128, q = r % 128, kb = q / 32, nb = q % 32; transpose_item(w_br + (size_t)br * 256 * 1024, 1024, 1024, Wt_br + (size_t)br * 1024 * 256, 256, kb * 64, nb * 32, nb * 32, scr, lane); continue; } r -= I_B;
        { const int kb = r / 32, nb = r % 32; transpose_item(w_out, 1024, 1024, Wt_out, 1024, kb * 64, nb * 32, nb * 32, scr, lane); }
    }
}
DI void phase0_rows(const KA& a, int l, int mode, int gw, int NGW, int lane) {
    const float* xin = (l == 0) ? a.in[0] : a.out;
    const bf16* eo = (const bf16*)(a.ws + WS_PROJ);
    bf16* hb = (bf16*)(a.ws + WS_HB);
    const float* g = mode ? a.in[2] : (a.in[3] + (size_t)l * 1024);
    for (int m = gw; m < T; m += NGW) {
        f32x4 v[4]; float ss = 0.f;
#pragma unroll
        for (int j = 0; j < 4; ++j) { v[j] = *(const f32x4*)(xin + (size_t)m * 1024 + 4 * (lane + 64 * j));
            if (l > 0) {
                const u32x2 e0 = *(const u32x2*)(eo + (size_t)(2 * m) * 1024 + 4 * (lane + 64 * j));
                const u32x2 e1 = *(const u32x2*)(eo + (size_t)(2 * m + 1) * 1024 + 4 * (lane + 64 * j));
                v[j][0] += lo_bf(e0.x) + lo_bf(e1.x); v[j][1] += hi_bf(e0.x) + hi_bf(e1.x); v[j][2] += lo_bf(e0.y) + lo_bf(e1.y); v[j][3] += hi_bf(e0.y) + hi_bf(e1.y);
            }
            ss += (v[j][0] * v[j][0] + v[j][1] * v[j][1]) + (v[j][2] * v[j][2] + v[j][3] * v[j][3]); }
        const float r = 1.f / sqrtf(wave_sum(ss) * (1.f / 1024.f) + 1e-6f);
#pragma unroll
        for (int j = 0; j < 4; ++j) { const f32x4 gv = *(const f32x4*)(g + 4 * (lane + 64 * j)); const f32x4 y = v[j] * r * gv;
            if (mode) *(f32x4*)(a.out + (size_t)m * 1024 + 4 * (lane + 64 * j)) = y;
            else { if (l > 0) *(f32x4*)(a.out + (size_t)m * 1024 + 4 * (lane + 64 * j)) = v[j];
                   u32x2 w; w.x = pk2(y[0], y[1]); w.y = pk2(y[2], y[3]); *(u32x2*)(hb + (size_t)m * 1024 + 4 * (lane + 64 * j)) = w; } }
    }
}

DI void lru_task(const KA& a, int l, const bf16* proj, bf16* ys, float* sums, int task, int lane, bool final) {
    const int chunk = task & 31, hbk = (task >> 5) & 3, b = task >> 7; const int c = hbk * 64 + lane;
    const float* w_a = a.in[7] + ((size_t)l * 4 + hbk) * 4096; const float* w_x = a.in[9] + ((size_t)l * 4 + hbk) * 4096;
    float wa[64], wx[64];
#pragma unroll
    for (int i = 0; i < 64; ++i) { wa[i] = w_a[i * 64 + lane]; wx[i] = w_x[i * 64 + lane]; }
    const float* cw = a.in[5] + (size_t)l * 4 * 256;
    const float cw0 = cw[c], cw1 = cw[256 + c], cw2 = cw[512 + c], cw3 = cw[768 + c];
    const float cb = a.in[6][l * 256 + c], ba = a.in[8][l * 256 + c], bx = a.in[10][l * 256 + c];
    const float c8 = -8.f * softplusf_(-a.in[11][l * 256 + c]);
    const int t0 = chunk * 256; const size_t rowb = (size_t)b * SEQ;
    float x3 = (t0 >= 3) ? bf2f(proj[(rowb + t0 - 3) * PLD + C_AX + c]) : 0.f;
    float x2 = (t0 >= 2) ? bf2f(proj[(rowb + t0 - 2) * PLD + C_AX + c]) : 0.f;
    float x1 = (t0 >= 1) ? bf2f(proj[(rowb + t0 - 1) * PLD + C_AX + c]) : 0.f;
    float h = 0.f, Ap = 1.f;
    if (final) { for (int cc = 0; cc < chunk; ++cc) { const float* sp = sums + ((size_t)((b * 4 + hbk) * 32 + cc) * 64 + lane) * 2; h = sp[0] * h + sp[1]; } }
    for (int t = t0; t < t0 + 256; ++t) {
        const float x0 = bf2f(proj[(rowb + t) * PLD + C_AX + c]);
        const float xc = cb + cw0 * x3 + cw1 * x2 + cw2 * x1 + cw3 * x0;
        float ra = ba, rx = bx;
#pragma unroll
        for (int i = 0; i < 64; ++i) { const float s = rl(xc, i); ra += s * wa[i]; rx += s * wx[i]; }
        const float r = sigmoidf_(ra), ig = sigmoidf_(rx);
        const float la = c8 * r; const float av = __expf(la);
        const float mult = (t == 0) ? 1.f : sqrtf(fmaxf(1.f - __expf(2.f * la), 0.f));
        const float bb = mult * ig * xc;
        h = av * h + bb; Ap *= av;
        if (final) { const float gt = bf2f(proj[(rowb + t) * PLD + C_AG + c]); ys[(rowb + t) * 1024 + c] = (bf16)f2bf(h * gelu_tanh(gt)); }
        x3 = x2; x2 = x1; x1 = x0;
    }
    if (!final) { float* sp = sums + ((size_t)((b * 4 + hbk) * 32 + chunk) * 64 + lane) * 2; sp[0] = Ap; sp[1] = h; }
}

template <int NH>
DI void dot_row64(const bf16* krow, const LAS float* qs, float (&acc)[NH]) {
#pragma unroll
    for (int h = 0; h < NH; ++h) acc[h] = 0.f;
#pragma unroll 1
    for (int c8 = 0; c8 < 8; ++c8) {
        const u32x4 w = *(const u32x4*)(krow + c8 * 8);
        const float k0 = lo_bf(w.x), k1 = hi_bf(w.x), k2 = lo_bf(w.y), k3 = hi_bf(w.y), k4 = lo_bf(w.z), k5 = hi_bf(w.z), k6 = lo_bf(w.w), k7 = hi_bf(w.w);
#pragma unroll
        for (int h = 0; h < NH; ++h) { const f32x4 qa = *(const LAS f32x4*)(qs + h * 64 + c8 * 8), qb = *(const LAS f32x4*)(qs + h * 64 + c8 * 8 + 4);
            acc[h] += qa[0] * k0; acc[h] += qa[1] * k1; acc[h] += qa[2] * k2; acc[h] += qa[3] * k3;
            acc[h] += qb[0] * k4; acc[h] += qb[1] * k5; acc[h] += qb[2] * k6; acc[h] += qb[3] * k7; } }
}
DI void swa_token(const KA& a, int l, const bf16* proj, bf16* ys, const LAS float* biasd, LAS float* qs, int tok, int lane) {
    const int b = tok / SEQ, t = tok % SEQ; const size_t rowb = (size_t)b * SEQ;
#pragma unroll
    for (int h = 0; h < 4; ++h) qs[h * 64 + lane] = bf2f(proj[(size_t)tok * PLD + C_BQ + h * 64 + lane]) * 0.125f;
    LDS_WAIT();
#pragma unroll
    for (int g = 0; g < 2; ++g) {
        float s[2][2]; int ktok[2];
#pragma unroll
        for (int j = 0; j < 2; ++j) { const int dist = 64 * j + lane; const int kpos = t - dist; const bool valid = kpos >= 0; const int kp = valid ? kpos : 0; ktok[j] = (int)rowb + kp;
            float acc[2]; dot_row64<2>(proj + (size_t)ktok[j] * PLD + C_BK + g * 64, qs + g * 128, acc);
#pragma unroll
            for (int i = 0; i < 2; ++i) s[i][j] = valid ? acc[i] + biasd[dist * 12 + 2 * g + i] : -1e30f; }
        float o[2] = {0.f, 0.f};
#pragma unroll
        for (int i = 0; i < 2; ++i) { const float sink = a.in[12][l * 4 + 2 * g + i];
            float mx = fmaxf(wave_max(fmaxf(s[i][0], s[i][1])), sink);
            const float p0 = (s[i][0] > -1e29f) ? __expf(s[i][0] - mx) : 0.f, p1 = (s[i][1] > -1e29f) ? __expf(s[i][1] - mx) : 0.f;
            const float den = wave_sum(p0 + p1) + __expf(sink - mx); const float inv = 1.f / fmaxf(den, 1e-30f);
            s[i][0] = p0 * inv; s[i][1] = p1 * inv; }
#pragma unroll
        for (int j = 0; j < 2; ++j) {
#pragma unroll 4
            for (int kl = 0; kl < 64; ++kl) { const int kpos = t - (64 * j + kl); if (kpos < 0) break;
                const float vv = bf2f(proj[(rowb + kpos) * PLD + C_BV + g * 64 + lane]);
                o[0] += rl(s[0][j], kl) * vv; o[1] += rl(s[1][j], kl) * vv; } }
#pragma unroll
        for (int i = 0; i < 2; ++i) ys[(size_t)tok * 1024 + 256 + (2 * g + i) * 64 + lane] = (bf16)f2bf(o[i]);
    }
}

DI void diff_task(const KA& a, int l, const bf16* proj, bf16* ys, const LAS float* biasd, float lam, float lam_init, int task, int lane) {
    const int qg = task >> 4, bh = task & 15, b = bh >> 2, h = bh & 3; const int mp = lane >> 5; const int q = qg * 32 + (lane & 31);
    const size_t rowb = (size_t)b * SEQ; const size_t tok = rowb + q;
    const float scale = 0.17677669529663687f;
    float qr[32];
    { const bf16* qp = proj + tok * PLD + C_CQ + h * 64 + mp * 32;
#pragma unroll
      for (int c = 0; c < 4; ++c) { const u32x4 w = *(const u32x4*)(qp + c * 8);
        qr[c * 8 + 0] = lo_bf(w.x) * scale; qr[c * 8 + 1] = hi_bf(w.x) * scale; qr[c * 8 + 2] = lo_bf(w.y) * scale; qr[c * 8 + 3] = hi_bf(w.y) * scale;
        qr[c * 8 + 4] = lo_bf(w.z) * scale; qr[c * 8 + 5] = hi_bf(w.z) * scale; qr[c * 8 + 6] = lo_bf(w.w) * scale; qr[c * 8 + 7] = hi_bf(w.w) * scale; } }
    float o[64];
#pragma unroll
    for (int d = 0; d < 64; ++d) o[d] = 0.f;
    float mrun = -1e30f, lrun = 0.f;
    const int kend = qg * 32 + 31;
    for (int k = 0; k <= kend; ++k) {
        const bf16* kp = proj + (rowb + k) * PLD + C_CK + h * 64 + mp * 32;
        float s = 0.f;
#pragma unroll
        for (int c = 0; c < 4; ++c) { const u32x4 w = *(const u32x4*)(kp + c * 8);
            s += qr[c * 8 + 0] * lo_bf(w.x); s += qr[c * 8 + 1] * hi_bf(w.x); s += qr[c * 8 + 2] * lo_bf(w.y); s += qr[c * 8 + 3] * hi_bf(w.y);
            s += qr[c * 8 + 4] * lo_bf(w.z); s += qr[c * 8 + 5] * hi_bf(w.z); s += qr[c * 8 + 6] * lo_bf(w.w); s += qr[c * 8 + 7] * hi_bf(w.w); }
        const int dist = q - k; const bool valid = dist >= 0; const int di = valid ? (dist < 128 ? dist : 128) : 0;
        s += biasd[di * 12 + 4 + h];
        if (valid && s > mrun) { const float al = __expf(mrun - s); lrun *= al;
#pragma unroll
            for (int d = 0; d < 64; ++d) o[d] *= al;
            mrun = s; }
        const float p = valid ? __expf(s - mrun) : 0.f; lrun += p;
        const bf16* vp = proj + (rowb + k) * PLD + C_CV + h * 64;
#pragma unroll
        for (int c = 0; c < 8; ++c) { const u32x4 w = *(const u32x4*)(vp + c * 8);
            o[c * 8 + 0] += p * lo_bf(w.x); o[c * 8 + 1] += p * hi_bf(w.x); o[c * 8 + 2] += p * lo_bf(w.y); o[c * 8 + 3] += p * hi_bf(w.y);
            o[c * 8 + 4] += p * lo_bf(w.z); o[c * 8 + 5] += p * hi_bf(w.z); o[c * 8 + 6] += p * lo_bf(w.w); o[c * 8 + 7] += p * hi_bf(w.w); }
    }
    const float inv = 1.f / fmaxf(lrun, 1e-30f);
    float ss = 0.f;
#pragma unroll
    for (int d = 0; d < 64; ++d) { const float mine = o[d] * inv; const float other = xshfl<32>(mine); const float at = mine - lam * other; o[d] = at; ss += at * at; }
    const float r = 1.f / sqrtf(ss * (1.f / 64.f) + 1e-5f) * (1.f - lam_init);
    if (mp == 0) { const float* sg = a.in[17] + l * 64; bf16* op = ys + tok * 1024 + 512 + h * 64;
#pragma unroll
        for (int c = 0; c < 8; ++c) { u32x4 w; w.x = pk2(o[c * 8 + 0] * r * sg[c * 8 + 0], o[c * 8 + 1] * r * sg[c * 8 + 1]); w.y = pk2(o[c * 8 + 2] * r * sg[c * 8 + 2], o[c * 8 + 3] * r * sg[c * 8 + 3]);
            w.z = pk2(o[c * 8 + 4] * r * sg[c * 8 + 4], o[c * 8 + 5] * r * sg[c * 8 + 5]); w.w = pk2(o[c * 8 + 6] * r * sg[c * 8 + 6], o[c * 8 + 7] * r * sg[c * 8 + 7]); *(u32x4*)(op + c * 8) = w; } }
}


constexpr int DK_STR = 144, DV_STR = 192, DBUF_BYTES = 64 * DK_STR + 64 * DV_STR;
DI int crow(int i, int hh) { return (i & 3) + 8 * (i >> 2) + 4 * hh; }
DI unsigned cvtpk(float lo, float hi) { f32x2 v = {lo, hi}; bf16x2_t b = __builtin_convertvector(v, bf16x2_t); return __builtin_bit_cast(unsigned, b); }
DI bf16x8 pack_half(const f32x16& x, int s2) { u32x4 p;
    if (s2 == 0) { p.x = cvtpk(x[0], x[1]); p.y = cvtpk(x[2], x[3]); p.z = cvtpk(x[4], x[5]); p.w = cvtpk(x[6], x[7]); }
    else { p.x = cvtpk(x[8], x[9]); p.y = cvtpk(x[10], x[11]); p.z = cvtpk(x[12], x[13]); p.w = cvtpk(x[14], x[15]); }
    return __builtin_bit_cast(bf16x8, p); }
DI s16x4 vtr(const LAS unsigned char* p) { return __builtin_bit_cast(s16x4, __builtin_amdgcn_ds_read_tr16_b64_v4i16((LAS v4i16_t*)p)); }
DI float max16(const f32x16& x) { float a = fmaxf(fmaxf(x[0], x[1]), fmaxf(x[2], x[3])), b = fmaxf(fmaxf(x[4], x[5]), fmaxf(x[6], x[7])), c = fmaxf(fmaxf(x[8], x[9]), fmaxf(x[10], x[11])), d = fmaxf(fmaxf(x[12], x[13]), fmaxf(x[14], x[15])); return fmaxf(fmaxf(a, b), fmaxf(c, d)); }
DI void diff_unit(const GAS bf16* proj, GAS bf16* ys, LAS unsigned char* lds, const LAS float* bias2, const GAS float* subg, float lam, float lam_init, int b, int h, int qb, int tid_in, int lane_in, int wave_in) {
    int tid = tid_in, lane = lane_in, wave = wave_in; asm volatile("" : "+v"(tid), "+v"(lane), "+s"(wave));
    const int q0 = qb * 256 + wave * 32; const int ql = lane & 31, hh = lane >> 5; const int q = q0 + ql;
    const size_t rowb = (size_t)b * SEQ;
    const float SC = 0.17677669529663687f * 1.4426950408889634f;
    bf16x8 qf[2][2];
    { const GAS bf16* qp = proj + (rowb + q) * PLD + C_CQ + h * 64 + hh * 8;
#pragma unroll
      for (int m = 0; m < 2; ++m)
#pragma unroll
        for (int s = 0; s < 2; ++s) { const u32x4 w = *(const GAS u32x4*)(qp + m * 32 + s * 16); u32x4 o;
            o.x = cvtpk(lo_bf(w.x) * SC, hi_bf(w.x) * SC); o.y = cvtpk(lo_bf(w.y) * SC, hi_bf(w.y) * SC); o.z = cvtpk(lo_bf(w.z) * SC, hi_bf(w.z) * SC); o.w = cvtpk(lo_bf(w.w) * SC, hi_bf(w.w) * SC);
            qf[m][s] = __builtin_bit_cast(bf16x8, o); } }
    f32x16 O[2][2], negm[2];
#pragma unroll
    for (int i = 0; i < 16; ++i) { O[0][0][i] = 0.f; O[0][1][i] = 0.f; O[1][0][i] = 0.f; O[1][1][i] = 0.f; negm[0][i] = 0.f; negm[1][i] = 0.f; }
    float lsum[2] = {0.f, 0.f};
    const int nsteps = 4 * qb + 4, mysteps = 4 * qb + (wave >> 1) + 1;
    const int skey = tid >> 3, sch = tid & 7;
    const GAS unsigned char* kgb = (const GAS unsigned char*)(proj + rowb * PLD + C_CK + h * 64);
    const GAS unsigned char* vgb = (const GAS unsigned char*)(proj + rowb * PLD + C_CV + h * 64);
    const unsigned soff = (unsigned)(skey * PLD + sch * 8) * 2u;
    u32x4 kr = *(const GAS u32x4*)(kgb + soff), vr = *(const GAS u32x4*)(vgb + soff);
    *(LAS u32x4*)(lds + skey * DK_STR + sch * 16) = kr; *(LAS u32x4*)(lds + 64 * DK_STR + skey * DV_STR + sch * 16) = vr;
    __syncthreads();
    const int i16 = lane & 15, blk = (lane >> 4) & 1;
    const int kboff = ql * DK_STR + hh * 16;
    const int vboff = 64 * DK_STR + (4 * hh + (i16 >> 2)) * DV_STR + (16 * blk + 4 * (i16 & 3)) * 2;
#pragma unroll 1
    for (int kt = 0; kt < nsteps; ++kt) {
        const LAS unsigned char* cur = lds + (kt & 1) * DBUF_BYTES; LAS unsigned char* nxt = lds + ((kt + 1) & 1) * DBUF_BYTES;
        if (kt + 1 < nsteps) { const unsigned so = soff + (unsigned)(kt + 1) * (64u * PLD * 2u); kr = *(const GAS u32x4*)(kgb + so); vr = *(const GAS u32x4*)(vgb + so); }
        if (kt < mysteps) {
            const int kbase = kt * 64;
            const bool near = (q0 - (kbase + 63) < 113);
#pragma unroll
            for (int m = 0; m < 2; ++m) {
                bf16x8 pk[2][2];
                f32x16 S[2];
                {   bf16x8 kf[2][2];
#pragma unroll
                    for (int t = 0; t < 2; ++t)
#pragma unroll
                        for (int s = 0; s < 2; ++s) kf[t][s] = *(const LAS bf16x8*)(cur + kboff + t * 32 * DK_STR + m * 64 + s * 32);
#pragma unroll
                    for (int t = 0; t < 2; ++t) { S[t] = MFMA32(kf[t][0], qf[m][0], negm[m]); S[t] = MFMA32(kf[t][1], qf[m][1], S[t]); } }
                if (near) {
#pragma unroll
                    for (int t = 0; t < 2; ++t)
#pragma unroll
                        for (int i = 0; i < 16; ++i) { const int dist = q - (kbase + 32 * t + crow(i, hh)); const int di = dist < 128 ? dist : 128;
                            const float bv = dist >= 0 ? bias2[di * 12 + 4 + h] : -1e30f; S[t][i] += bv; } }
                float tm = fmaxf(max16(S[0]), max16(S[1]));
                const bool need = (tm > 8.f) || (kt == 0);
                if (__builtin_amdgcn_ballot_w64(need) != 0ull) {
                    tm = fmaxf(tm, xshfl<32>(tm));
                    const float sh = (kt == 0) ? tm : fmaxf(tm, 0.f);
                    const float al = __builtin_amdgcn_exp2f(-sh);
                    lsum[m] *= al;
#pragma unroll
                    for (int i = 0; i < 16; ++i) { O[m][0][i] *= al; O[m][1][i] *= al; negm[m][i] -= sh; S[0][i] -= sh; S[1][i] -= sh; }
                }
#pragma unroll
                for (int t = 0; t < 2; ++t) {
#pragma unroll
                    for (int i = 0; i < 16; ++i) { const float p = __builtin_amdgcn_exp2f(S[t][i]); S[t][i] = p; lsum[m] += p; }
                    pk[t][0] = pack_half(S[t], 0); pk[t][1] = pack_half(S[t], 1); }
#pragma unroll
                for (int t = 0; t < 2; ++t)
#pragma unroll
                    for (int s2 = 0; s2 < 2; ++s2)
#pragma unroll
                        for (int db = 0; db < 2; ++db) {
                            const s16x4 lo = vtr(cur + vboff + (32 * t + 16 * s2) * DV_STR + db * 64), hi = vtr(cur + vboff + (32 * t + 16 * s2 + 8) * DV_STR + db * 64);
                            const bf16x8 vf = __builtin_shufflevector(lo, hi, 0, 1, 2, 3, 4, 5, 6, 7);
                            O[m][db] = MFMA32(vf, pk[t][s2], O[m][db]); }
                __builtin_amdgcn_sched_barrier(0);
            }
        }
        if (kt + 1 < nsteps) { *(LAS u32x4*)(nxt + skey * DK_STR + sch * 16) = kr; *(LAS u32x4*)(nxt + 64 * DK_STR + skey * DV_STR + sch * 16) = vr; }
        __syncthreads();
    }
    const float l0 = lsum[0] + xshfl<32>(lsum[0]), l1 = lsum[1] + xshfl<32>(lsum[1]);
    const float i0 = 1.f / fmaxf(l0, 1e-30f), i1 = lam / fmaxf(l1, 1e-30f);
    float ss = 0.f;
#pragma unroll
    for (int db = 0; db < 2; ++db)
#pragma unroll
        for (int i = 0; i < 16; ++i) { const float at = O[0][db][i] * i0 - O[1][db][i] * i1; O[0][db][i] = at; ss += at * at; }
    ss += xshfl<32>(ss);
    const float r = (1.f - lam_init) / sqrtf(ss * (1.f / 64.f) + 1e-5f);
    GAS bf16* op = ys + (rowb + q) * 1024 + 512 + h * 64;
#pragma unroll
    for (int db = 0; db < 2; ++db)
#pragma unroll
        for (int gq = 0; gq < 4; ++gq) { const int d0 = 32 * db + 8 * gq + 4 * hh; const f32x4 sg = *(const GAS f32x4*)(subg + d0);
            u32x2 w; w.x = cvtpk(O[0][db][4 * gq + 0] * r * sg[0], O[0][db][4 * gq + 1] * r * sg[1]); w.y = cvtpk(O[0][db][4 * gq + 2] * r * sg[2], O[0][db][4 * gq + 3] * r * sg[3]);
            *(GAS u32x2*)(op + d0) = w; }
}

DI void cmp_task(const KA& a, int l, const bf16* proj, bf16* kcb, int task, int lane) {
    const int kv = task / (BATCH * NCMP), r = task % (BATCH * NCMP), b = r / NCMP, c = r % NCMP;
    const float* pos = a.in[kv ? 21 : 18] + (size_t)l * 2048; const float* w1 = a.in[kv ? 22 : 19] + (size_t)l * 2048 * 64; const float* w2 = a.in[kv ? 23 : 20] + (size_t)l * 4096;
    const size_t tokb = (size_t)b * SEQ + 16 * c; const int col0 = kv ? C_VC : C_KC;
    float h1 = 0.f;
    for (int li = 0; li < 32; ++li) { const float v = bf2f(proj[(tokb + li) * PLD + col0 + lane]) + pos[li * 64 + lane]; const float* wr = w1 + (size_t)(li * 64) * 64 + lane;
#pragma unroll
        for (int d = 0; d < 64; ++d) h1 += rl(v, d) * wr[d * 64]; }
    const float g = gelu_tanh(h1); float o = 0.f;
#pragma unroll
    for (int j = 0; j < 64; ++j) o += rl(g, j) * w2[j * 64 + lane];
    kcb[((size_t)(kv * BATCH + b) * 512 + c) * 64 + lane] = (bf16)f2bf(o);
    if (c == NCMP - 1) kcb[((size_t)(kv * BATCH + b) * 512 + NCMP) * 64 + lane] = 0;
}


DI void st_load(const GAS unsigned char* kb, const GAS unsigned char* vb, unsigned off, u32x4& kr, u32x4& vr) { kr = *(const GAS u32x4*)(kb + off); vr = *(const GAS u32x4*)(vb + off); }
DI void st_write(LAS unsigned char* buf, int skey, int sch, const u32x4& kr, const u32x4& vr) { *(LAS u32x4*)(buf + skey * DK_STR + sch * 16) = kr; *(LAS u32x4*)(buf + 64 * DK_STR + skey * DV_STR + sch * 16) = vr; }
DI void qk64(const LAS unsigned char* cur, int kboff, const bf16x8 (&qf)[4], const f32x16& cinit, f32x16 (&S)[2]) {
#pragma unroll
    for (int t = 0; t < 2; ++t) { S[t] = cinit;
#pragma unroll
        for (int s = 0; s < 4; ++s) { const bf16x8 kf = *(const LAS bf16x8*)(cur + kboff + t * 32 * DK_STR + s * 32); S[t] = MFMA32(kf, qf[s], S[t]); } }
}
DI void qk32z(const LAS unsigned char* kt32, const bf16x8 (&qf)[4], f32x16& S) {
#pragma unroll
    for (int s = 0; s < 4; ++s) { const bf16x8 kf = *(const LAS bf16x8*)(kt32 + s * 32);
        if (s == 0) { f32x16 z;
#pragma unroll
            for (int i = 0; i < 16; ++i) z[i] = 0.f;
            S = MFMA32(kf, qf[s], z); } else S = MFMA32(kf, qf[s], S); }
}
DI void pv32(const LAS unsigned char* vt32, const bf16x8 (&pk)[2], f32x16 (&O)[2]) {
#pragma unroll
    for (int s2 = 0; s2 < 2; ++s2)
#pragma unroll
        for (int db = 0; db < 2; ++db) {
            const s16x4 lo = vtr(vt32 + (16 * s2) * DV_STR + db * 64), hi = vtr(vt32 + (16 * s2 + 8) * DV_STR + db * 64);
            const bf16x8 vf = __builtin_shufflevector(lo, hi, 0, 1, 2, 3, 4, 5, 6, 7);
            O[db] = MFMA32(vf, pk[s2], O[db]); }
}
DI void mask_bias_cmp32(f32x16& S, int tcol, int cbase, int hh, const LAS float* b2h, float msub) {
#pragma unroll
    for (int i = 0; i < 16; ++i) { const int c = cbase + crow(i, hh); const int dist = tcol - 31 - 16 * c; const bool ok = dist >= 0 && c < NCMP;
        const int di = dist < 0 ? 0 : (dist < 128 ? dist : 128); S[i] = ok ? S[i] + (b2h[di * 12] - msub) : -1e30f; }
}
DI void pv64(const LAS unsigned char* cur, int vboff, const bf16x8 (&pk)[2][2], f32x16 (&O)[2]) {
#pragma unroll
    for (int t = 0; t < 2; ++t)
#pragma unroll
        for (int s2 = 0; s2 < 2; ++s2)
#pragma unroll
            for (int db = 0; db < 2; ++db) {
                const s16x4 lo = vtr(cur + vboff + (32 * t + 16 * s2) * DV_STR + db * 64), hi = vtr(cur + vboff + (32 * t + 16 * s2 + 8) * DV_STR + db * 64);
                const bf16x8 vf = __builtin_shufflevector(lo, hi, 0, 1, 2, 3, 4, 5, 6, 7);
                O[db] = MFMA32(vf, pk[t][s2], O[db]); }
}
DI void softmax_step(f32x16 (&S)[2], f32x16 (&O)[2], f32x16& negm, float& lsum, bf16x8 (&pk)[2][2]) {
    float tm = fmaxf(max16(S[0]), max16(S[1]));
    if (__builtin_amdgcn_ballot_w64(tm > 8.f) != 0ull) {
        tm = fmaxf(tm, xshfl<32>(tm)); const float sh = fmaxf(tm, 0.f); const float al = __builtin_amdgcn_exp2f(-sh);
        lsum *= al;
#pragma unroll
        for (int i = 0; i < 16; ++i) { O[0][i] *= al; O[1][i] *= al; negm[i] -= sh; S[0][i] -= sh; S[1][i] -= sh; } }
#pragma unroll
    for (int t = 0; t < 2; ++t) {
#pragma unroll
        for (int i = 0; i < 16; ++i) { const float p = __builtin_amdgcn_exp2f(S[t][i]); S[t][i] = p; lsum += p; }
        pk[t][0] = pack_half(S[t], 0); pk[t][1] = pack_half(S[t], 1); }
}
DI void mask_bias(f32x16 (&S)[2], int tcol, int kbase, int hh, int W, bool colsel, const LAS float* b2h) {
#pragma unroll
    for (int t = 0; t < 2; ++t)
#pragma unroll
        for (int i = 0; i < 16; ++i) { const int dist = tcol - (kbase + 32 * t + crow(i, hh)); const bool ok = colsel && dist >= 0 && dist < W;
            const int di = dist < 0 ? 0 : (dist < 128 ? dist : 128); S[t][i] = ok ? S[t][i] + b2h[di * 12] : -1e30f; }
}
DI void nsa_unit(const GAS bf16* proj, GAS bf16* ys, const GAS bf16* kcb, LAS unsigned char* lds, const LAS float* bias2, int b, int u, int tid_in, int lane_in, int wave_in) {
    int tid = tid_in, lane = lane_in, wave = wave_in; asm volatile("" : "+v"(tid), "+v"(lane), "+s"(wave));
    const int t0 = u * 64; const int col = lane & 31, hh = lane >> 5, tl = col >> 2, head = col & 3;
    const int t = t0 + wave * 8 + tl; const int tw0 = t0 + wave * 8;
    const size_t rowb = (size_t)b * SEQ;
    const LAS float* b2h = bias2 + 8 + head;
    bf16x8 qf[4];
    { const float SC = 0.125f * 1.4426950408889634f; const GAS bf16* qp = proj + (rowb + t) * PLD + C_DQ + head * 64 + hh * 8;
#pragma unroll
      for (int s = 0; s < 4; ++s) { const u32x4 w = *(const GAS u32x4*)(qp + s * 16); u32x4 o;
          o.x = cvtpk(lo_bf(w.x) * SC, hi_bf(w.x) * SC); o.y = cvtpk(lo_bf(w.y) * SC, hi_bf(w.y) * SC); o.z = cvtpk(lo_bf(w.z) * SC, hi_bf(w.z) * SC); o.w = cvtpk(lo_bf(w.w) * SC, hi_bf(w.w) * SC);
          qf[s] = __builtin_bit_cast(bf16x8, o); } }
    const int skey = tid >> 3, sch = tid & 7;
    const int i16 = lane & 15, blk = (lane >> 4) & 1;
    const int kboff = col * DK_STR + hh * 16;
    const int vboff = 64 * DK_STR + (4 * hh + (i16 >> 2)) * DV_STR + (16 * blk + 4 * (i16 & 3)) * 2;
    u32x4 kr, vr;
    const int ncvm = (4 * u + 3) < NCMP ? (4 * u + 3) : NCMP;
    const int nsc = (ncvm + 63) >> 6;
    const GAS unsigned char* kcp = (const GAS unsigned char*)(kcb + (size_t)(0 * BATCH + b) * 512 * 64);
    const GAS unsigned char* vcp = (const GAS unsigned char*)(kcb + (size_t)(1 * BATCH + b) * 512 * 64);
    const unsigned soffc = (unsigned)(skey * 64 + sch * 8) * 2u;
    float m1 = -120.f, l1 = 0.f;
    st_load(kcp, vcp, soffc, kr, vr); st_write(lds, skey, sch, kr, vr); __syncthreads();
#pragma unroll 1
    for (int kt = 0; kt < nsc; ++kt) {
        const LAS unsigned char* cur = lds + (kt & 1) * DBUF_BYTES; LAS unsigned char* nxt = lds + ((kt + 1) & 1) * DBUF_BYTES;
        if (kt + 1 < nsc) st_load(kcp, vcp, soffc + (unsigned)(kt + 1) * 8192u, kr, vr);
#pragma unroll
        for (int tt = 0; tt < 2; ++tt) { f32x16 S; qk32z(cur + kboff + tt * 32 * DK_STR, qf, S); mask_bias_cmp32(S, t, kt * 64 + tt * 32, hh, b2h, 0.f);
          const float tm = max16(S); const float mn = fmaxf(m1, tm); float acc = 0.f;
#pragma unroll
          for (int i = 0; i < 16; ++i) acc += __builtin_amdgcn_exp2f(S[i] - mn);
          l1 = l1 * __builtin_amdgcn_exp2f(m1 - mn) + acc; m1 = mn; }
        if (kt + 1 < nsc) st_write(nxt, skey, sch, kr, vr);
        __syncthreads();
    }
    float mf, inv;
    { const float mo = xshfl<32>(m1), lo = xshfl<32>(l1); mf = fmaxf(m1, mo); const float lf = l1 * __builtin_amdgcn_exp2f(m1 - mf) + lo * __builtin_amdgcn_exp2f(mo - mf); inv = lf > 0.f ? 1.f / lf : 0.f; }
    f32x16 Oc[2], imp[4];
#pragma unroll
    for (int i = 0; i < 16; ++i) { Oc[0][i] = 0.f; Oc[1][i] = 0.f; imp[0][i] = 0.f; imp[1][i] = 0.f; imp[2][i] = 0.f; imp[3][i] = 0.f; }
    {   st_load(kcp, vcp, soffc, kr, vr); st_write(lds, skey, sch, kr, vr); __syncthreads();
#pragma unroll 1
        for (int kt = 0; kt < nsc; ++kt) {
            const LAS unsigned char* cur = lds + (kt & 1) * DBUF_BYTES; LAS unsigned char* nxt = lds + ((kt + 1) & 1) * DBUF_BYTES;
            if (kt + 1 < nsc) st_load(kcp, vcp, soffc + (unsigned)(kt + 1) * 8192u, kr, vr);
#pragma unroll
            for (int tt = 0; tt < 2; ++tt) {
                f32x16 S; qk32z(cur + kboff + tt * 32 * DK_STR, qf, S); mask_bias_cmp32(S, t, kt * 64 + tt * 32, hh, b2h, mf);
#pragma unroll
                for (int i = 0; i < 16; ++i) S[i] = __builtin_amdgcn_exp2f(S[i]) * inv;
                bf16x8 pk[2]; pk[0] = pack_half(S, 0); pk[1] = pack_half(S, 1);
                pv32(cur + vboff + tt * 32 * DV_STR, pk, Oc);
                const int Tq = (2 * kt + tt) & 3, MB = (2 * kt + tt) >> 2;
#pragma unroll
                for (int s2 = 0; s2 < 2; ++s2) { u32x4 aw; unsigned e[8];
#pragma unroll
                    for (int jj = 0; jj < 8; ++jj) { const int kk = 16 * s2 + 8 * (jj >> 2) + 4 * hh + (jj & 3); const int delta = 32 * Tq + kk - 4 * col;
                        e[jj] = (delta == -1 || delta == 3) ? 0x3F80u : ((unsigned)delta <= 2u ? 0x4000u : 0u); }
                    aw.x = e[0] | (e[1] << 16); aw.y = e[2] | (e[3] << 16); aw.z = e[4] | (e[5] << 16); aw.w = e[6] | (e[7] << 16);
                    const bf16x8 af = __builtin_bit_cast(bf16x8, aw);
                    if (MB == 0) imp[0] = MFMA32(af, pk[s2], imp[0]); else if (MB == 1) imp[1] = MFMA32(af, pk[s2], imp[1]); else if (MB == 2) imp[2] = MFMA32(af, pk[s2], imp[2]); else imp[3] = MFMA32(af, pk[s2], imp[3]); }
                if (Tq == 3 && MB < 3) { u32x4 aw; aw.x = 0u; aw.y = 0u; aw.z = 0u; aw.w = (lane == 32) ? 0x3F800000u : 0u;
                    const bf16x8 af = __builtin_bit_cast(bf16x8, aw);
                    if (MB == 0) imp[1] = MFMA32(af, pk[1], imp[1]); else if (MB == 1) imp[2] = MFMA32(af, pk[1], imp[2]); else imp[3] = MFMA32(af, pk[1], imp[3]); }
            }
            if (kt + 1 < nsc) st_write(nxt, skey, sch, kr, vr);
            __syncthreads();
        }
    }
    unsigned ocp[2][8];
#pragma unroll
    for (int db = 0; db < 2; ++db)
#pragma unroll
        for (int i = 0; i < 8; ++i) ocp[db][i] = cvtpk(Oc[db][2 * i], Oc[db][2 * i + 1]);
    unsigned sm0 = 0u, sm1 = 0u, sm2 = 0u, sm3 = 0u;
    {   const int cur_t = t >> 6; unsigned key[16];
#pragma unroll
        for (int i = 0; i < 16; ++i) {
            float v0 = imp[0][i], v1 = imp[1][i], v2 = imp[2][i], v3 = imp[3][i];
            v0 += xshfl<1>(v0); v0 += xshfl<2>(v0); v1 += xshfl<1>(v1); v1 += xshfl<2>(v1); v2 += xshfl<1>(v2); v2 += xshfl<2>(v2); v3 += xshfl<1>(v3); v3 += xshfl<2>(v3);
            const float val = head == 0 ? v0 : (head == 1 ? v1 : (head == 2 ? v2 : v3));
            const int j = 32 * head + crow(i, hh);
            const bool forced = (j == 0) || (j == cur_t) || (j == cur_t - 1);
            unsigned fx = (unsigned)(fminf(fmaxf(val, 0.f), 31.f) * 1048576.f) + 1u;
            fx = forced ? 0x1FFFFFFu : (j <= cur_t ? fx : 0u);
            key[i] = (fx << 7) | (unsigned)(127 - j); }
#pragma unroll 1
        for (int r = 0; r < 16; ++r) {
            unsigned w = key[0];
#pragma unroll
            for (int i = 1; i < 16; ++i) w = w > key[i] ? w : key[i];
            { unsigned o = (unsigned)xshfl_i<1>((int)w); w = w > o ? w : o; o = (unsigned)xshfl_i<2>((int)w); w = w > o ? w : o; o = (unsigned)xshfl_i<32>((int)w); w = w > o ? w : o; }
            if ((w >> 7) != 0u) { const int j = 127 - (int)(w & 127u); const unsigned bit = 1u << (j & 31); const int jb = j >> 5;
                sm0 |= (jb == 0) ? bit : 0u; sm1 |= (jb == 1) ? bit : 0u; sm2 |= (jb == 2) ? bit : 0u; sm3 |= (jb == 3) ? bit : 0u; }
#pragma unroll
            for (int i = 0; i < 16; ++i) key[i] = (key[i] == w) ? 0u : key[i];
        }
    }
    f32x16 Ow[2]; float lw = 0.f;
#pragma unroll
    for (int i = 0; i < 16; ++i) { Ow[0][i] = 0.f; Ow[1][i] = 0.f; }
    {   f32x16 negm;
#pragma unroll
        for (int i = 0; i < 16; ++i) negm[i] = 120.f;
        const GAS unsigned char* kwp = (const GAS unsigned char*)(proj + rowb * PLD + C_KW); const GAS unsigned char* vwp = (const GAS unsigned char*)(proj + rowb * PLD + C_VW);
        const unsigned soffp = (unsigned)(skey * PLD + sch * 8) * 2u;
        const int s0 = (u < 8) ? 8 - u : 0;
        st_load(kwp, vwp, soffp + (unsigned)(u - 8 + s0) * (64u * PLD * 2u), kr, vr); st_write(lds, skey, sch, kr, vr); __syncthreads();
#pragma unroll 1
        for (int s = s0; s < 9; ++s) {
            const int par = (s - s0) & 1; const LAS unsigned char* cur = lds + par * DBUF_BYTES; LAS unsigned char* nxt = lds + (par ^ 1) * DBUF_BYTES;
            if (s + 1 < 9) st_load(kwp, vwp, soffp + (unsigned)(u - 8 + s + 1) * (64u * PLD * 2u), kr, vr);
            {   f32x16 S[2]; qk64(cur, kboff, qf, negm, S);
                if (s == 0 || s >= 6) mask_bias(S, t, (u - 8 + s) * 64, hh, 512, true, b2h);
                bf16x8 pk[2][2]; softmax_step(S, Ow, negm, lw, pk); pv64(cur, vboff, pk, Ow); }
            if (s + 1 < 9) st_write(nxt, skey, sch, kr, vr);
            __syncthreads();
        }
    }
    unsigned owp[2][8];
#pragma unroll
    for (int db = 0; db < 2; ++db)
#pragma unroll
        for (int i = 0; i < 8; ++i) owp[db][i] = cvtpk(Ow[db][2 * i], Ow[db][2 * i + 1]);
    f32x16 Os[2]; float lsel = 0.f;
#pragma unroll
    for (int i = 0; i < 16; ++i) { Os[0][i] = 0.f; Os[1][i] = 0.f; }
    {   f32x16 negm;
#pragma unroll
        for (int i = 0; i < 16; ++i) negm[i] = 120.f;
        const GAS unsigned char* ksp = (const GAS unsigned char*)(proj + rowb * PLD + C_KS); const GAS unsigned char* vsp = (const GAS unsigned char*)(proj + rowb * PLD + C_VS);
        const unsigned soffp = (unsigned)(skey * PLD + sch * 8) * 2u;
        st_load(ksp, vsp, soffp, kr, vr); st_write(lds, skey, sch, kr, vr); __syncthreads();
#pragma unroll 1
        for (int j = 0; j <= u; ++j) {
            const LAS unsigned char* cur = lds + (j & 1) * DBUF_BYTES; LAS unsigned char* nxt = lds + ((j + 1) & 1) * DBUF_BYTES;
            if (j + 1 <= u) st_load(ksp, vsp, soffp + (unsigned)(j + 1) * (64u * PLD * 2u), kr, vr);
            const int jb = j >> 5; const unsigned smw = jb == 0 ? sm0 : (jb == 1 ? sm1 : (jb == 2 ? sm2 : sm3));
            const bool bit = ((smw >> (j & 31)) & 1u) != 0u;
            if (__builtin_amdgcn_ballot_w64(bit) != 0ull) {
                f32x16 S[2]; qk64(cur, kboff, qf, negm, S);
                if (64 * j + 63 > tw0 - 113) mask_bias(S, t, 64 * j, hh, 1 << 30, bit, b2h);
                else if (!bit) {
#pragma unroll
                    for (int i = 0; i < 16; ++i) { S[0][i] = -1e30f; S[1][i] = -1e30f; } }
                bf16x8 pk[2][2]; softmax_step(S, Os, negm, lsel, pk); pv64(cur, vboff, pk, Os); }
            if (j + 1 <= u) st_write(nxt, skey, sch, kr, vr);
            __syncthreads();
        }
    }
    {   const float lwt = lw + xshfl<32>(lw), lst = lsel + xshfl<32>(lsel);
        const GAS bf16* gp = proj + (rowb + t) * PLD + C_DG + head * 3;
        const float g0 = sigmoidf_(bf2f(gp[0])), g1 = sigmoidf_(bf2f(gp[1])) / fmaxf(lst, 1e-30f), g2 = sigmoidf_(bf2f(gp[2])) / fmaxf(lwt, 1e-30f);
        GAS bf16* op = ys + (rowb + t) * 1024 + 768 + head * 64;
#pragma unroll
        for (int db = 0; db < 2; ++db)
#pragma unroll
            for (int gq = 0; gq < 4; ++gq) { const int d0 = 32 * db + 8 * gq + 4 * hh; float y[4];
#pragma unroll
                for (int e = 0; e < 4; ++e) { const unsigned cw = ocp[db][2 * gq + (e >> 1)], ww = owp[db][2 * gq + (e >> 1)];
                    y[e] = g0 * ((e & 1) ? hi_bf(cw) : lo_bf(cw)) + g1 * Os[db][4 * gq + e] + g2 * ((e & 1) ? hi_bf(ww) : lo_bf(ww)); }
                u32x2 w; w.x = cvtpk(y[0], y[1]); w.y = cvtpk(y[2], y[3]); *(GAS u32x2*)(op + d0) = w; }
    }
}

DI void route_token(const KA& a, int l, bf16* x2b, int* rec_e, int* rec_slot, float* rec_w, unsigned* cnt, int tok, int lane_) {
    int lane = lane_; asm volatile("" : "+v"(lane));
    const float* xr = a.out + (size_t)tok * 1024; const float* g = a.in[28] + (size_t)l * 1024;
    float ss = 0.f;
#pragma unroll
    for (int j = 0; j < 4; ++j) { const f32x4 v = *(const f32x4*)(xr + 4 * (lane + 64 * j)); ss += (v[0] * v[0] + v[1] * v[1]) + (v[2] * v[2] + v[3] * v[3]); }
    const float r = 1.f / sqrtf(wave_sum(ss) * (1.f / 1024.f) + 1e-6f);
    const float* wg = a.in[29] + (size_t)l * 1024 * 4; const float* we = a.in[31] + (size_t)l * 1024 * 32;
    float lg[36];
#pragma unroll
    for (int i = 0; i < 36; ++i) lg[i] = 0.f;
#pragma unroll 1
    for (int j = 0; j < 4; ++j) { const int k0 = 4 * (lane + 64 * j);
        const f32x4 v = *(const f32x4*)(xr + k0); const f32x4 gv = *(const f32x4*)(g + k0); const f32x4 xn = v * r * gv;
        u32x2 w; w.x = pk2(xn[0], xn[1]); w.y = pk2(xn[2], xn[3]); *(u32x2*)(x2b + (size_t)tok * 1024 + k0) = w;
#pragma unroll
        for (int e = 0; e < 4; ++e) { const int k = k0 + e; const float xk = xn[e];
            const f32x4 g4 = *(const f32x4*)(wg + (size_t)k * 4);
            lg[0] += xk * g4[0]; lg[1] += xk * g4[1]; lg[2] += xk * g4[2]; lg[3] += xk * g4[3];
#pragma unroll
            for (int q = 0; q < 8; ++q) { const f32x4 e4 = *(const f32x4*)(we + (size_t)k * 32 + q * 4);
                lg[4 + q * 4 + 0] += xk * e4[0]; lg[4 + q * 4 + 1] += xk * e4[1]; lg[4 + q * 4 + 2] += xk * e4[2]; lg[4 + q * 4 + 3] += xk * e4[3]; }
            __builtin_amdgcn_sched_barrier(0); } }
#pragma unroll
    for (int i = 0; i < 36; ++i) lg[i] = wave_sum(lg[i]);
    const float* bg = a.in[30] + l * 4; const float* be = a.in[32] + l * 32;
#pragma unroll
    for (int i = 0; i < 4; ++i) lg[i] += bg[i];
#pragma unroll
    for (int i = 0; i < 32; ++i) lg[4 + i] += be[i];
    int gsel = 0; float gm = lg[0];
#pragma unroll
    for (int i = 1; i < 4; ++i) if (lg[i] > gm) { gm = lg[i]; gsel = i; }
    float gs = 0.f;
#pragma unroll
    for (int i = 0; i < 4; ++i) gs += __expf(lg[i] - gm);
    const float gwt = 1.f / gs;
    float v8[8];
#pragma unroll
    for (int i = 0; i < 8; ++i) { float x = lg[4 + i];
#pragma unroll
        for (int gq = 1; gq < 4; ++gq) x = (gsel == gq) ? lg[4 + gq * 8 + i] : x;
        v8[i] = x; }
    int i0 = 0; float m0 = v8[0];
#pragma unroll
    for (int i = 1; i < 8; ++i) if (v8[i] > m0) { m0 = v8[i]; i0 = i; }
    int i1 = -1; float m1 = -3e38f;
#pragma unroll
    for (int i = 0; i < 8; ++i) if (i != i0 && v8[i] > m1) { m1 = v8[i]; i1 = i; }
    const float w0 = 1.f / (1.f + __expf(m1 - m0)); const float w1 = 1.f - w0;
    if (lane == 0) {
        const int e0 = gsel * 8 + i0, e1 = gsel * 8 + i1;
        const unsigned s0 = __hip_atomic_fetch_add(cnt + e0, 1u, __ATOMIC_RELAXED, __HIP_MEMORY_SCOPE_AGENT);
        const unsigned s1 = __hip_atomic_fetch_add(cnt + e1, 1u, __ATOMIC_RELAXED, __HIP_MEMORY_SCOPE_AGENT);
        rec_e[tok * 2] = e0; rec_e[tok * 2 + 1] = e1; rec_slot[tok * 2] = (int)s0; rec_slot[tok * 2 + 1] = (int)s1; rec_w[tok * 2] = w0 * gwt; rec_w[tok * 2 + 1] = w1 * gwt;
    }
}
DI void expert_weights(const KA& a, int l, LAS unsigned char* lds, int gw, int NGW, int wave, int lane) {
    LAS float* scr = (LAS float*)(lds + wave * 16384);
    const float* wgt = a.in[33] + (size_t)l * 32 * 1024 * 256; const float* wup = a.in[34] + (size_t)l * 32 * 1024 * 256; const float* wdn = a.in[35] + (size_t)l * 32 * 256 * 1024;
    bf16* Wgu = (bf16*)(a.ws + WS_WGU); bf16* Wd = (bf16*)(a.ws + WS_WD);
    constexpr int I_E = 16 * 8, I_D = 4 * 32;
    constexpr int NIT = 32 * (2 * I_E + I_D);
    for (int it = gw; it < NIT; it += NGW) {
        const int e = it / (2 * I_E + I_D); int r = it % (2 * I_E + I_D);
        if (r < 2 * I_E) { const int up = r / I_E, q = r % I_E, kb = q / 8, nb = q % 8; const int n0 = nb * 32;
            const int drow = (n0 >> 7) * 256 + up * 128 + (n0 & 127);
            transpose_item((up ? wup : wgt) + (size_t)e * 1024 * 256, 256, 256, Wgu + (size_t)e * 512 * 1024, 1024, kb * 64, n0, drow, scr, lane);
        } else { r -= 2 * I_E; const int kb = r / 32, nb = r % 32;
            transpose_item(wdn + (size_t)e * 256 * 1024, 1024, 1024, Wd + (size_t)e * 1024 * 256, 256, kb * 64, nb * 32, nb * 32, scr, lane); }
    }
}
DI void build_offsets(const unsigned* cnt, LAS int* offt, int tid) {
    if (tid == 0) { int o = 0; for (int e = 0; e < 32; ++e) { offt[e] = o; const int c = (int)__hip_atomic_load(cnt + e, __ATOMIC_RELAXED, __HIP_MEMORY_SCOPE_AGENT); o += (c + 255) & ~255; } offt[32] = o; }
    __syncthreads();
    for (int rt = tid; rt < (MOE_ROWS >> 8); rt += 512) { int e = 0; for (int j = 1; j < 32; ++j) e += (offt[j] <= rt * 256) ? 1 : 0; offt[40 + rt] = e; }
    __syncthreads();
}

template <unsigned PM>
__global__ void __launch_bounds__(512, 2) mk_fwd(Args a_) {
    extern __shared__ __attribute__((aligned(16))) unsigned char lds_raw[];
    LAS unsigned char* lds = (LAS unsigned char*)lds_raw;
    const int wave0 = __builtin_amdgcn_readfirstlane((int)threadIdx.x >> 6);
    if (threadIdx.x < 36) ((LAS unsigned long long*)(lds + PTAB_OFF))[threadIdx.x] = (unsigned long long)a_.in[threadIdx.x];
    __syncthreads();
    KA a; a.in.base = (unsigned)(size_t)(lds + PTAB_OFF); a.out = a_.out; a.ws = a_.ws;
    const int G = gridDim.x, bid = blockIdx.x, NGW = G * 8;
#define PHASE_IDS() int wave = wave0; asm volatile("" : "+s"(wave)); const int lane = my_lane(); const int tid_ = wave * 64 + lane, gw = bid * 8 + wave; (void)tid_; (void)gw; \
    KA ap = a; asm volatile("" : "+s"(ap.ws), "+s"(ap.out), "+s"(ap.in.base)); \
    bf16* hb = (bf16*)(ap.ws + WS_HB); bf16* proj = (bf16*)(ap.ws + WS_PROJ); bf16* gates = (bf16*)(ap.ws + WS_GATES); \
    bf16* ys = hb; bf16* x2b = hb; bf16* merged = proj; bf16* eo = proj; \
    bf16* kcb = (bf16*)(ap.ws + WS_KCVC); float* lrusum = (float*)(ap.ws + WS_LRUSUM); \
    int* rec_e = (int*)(ap.ws + WS_REC); int* rec_slot = rec_e + T * 2; float* rec_w = (float*)(rec_slot + T * 2); \
    int* rowtok = (int*)(ap.ws + WS_ROWTOK); float* roww = (float*)(ap.ws + WS_ROWW); \
    bf16* xs = (bf16*)(ap.ws + WS_XS); bf16* hmid = (bf16*)(ap.ws + WS_HMID); unsigned* ctl = (unsigned*)(ap.ws + WS_CTL); \
    (void)hb; (void)proj; (void)gates; (void)ys; (void)x2b; (void)merged; (void)eo; (void)kcb; (void)lrusum; (void)rec_e; (void)rec_slot; (void)rec_w; (void)rowtok; (void)roww; (void)xs; (void)hmid; (void)ctl
    volatile LAS unsigned* MISC = (volatile LAS unsigned*)(lds + MISC_OFF);
    LAS float* biasd = (LAS float*)(lds + BIAS_OFF);
    LAS int* offt = (LAS int*)(lds + OFFT_OFF);
    { PHASE_IDS();
    if (tid_ < 64) MISC[tid_] = 0u;
    for (int i = tid_; i < 129 * 12; i += 512) { const int d = i / 12, hd = i % 12; const int bk = d < 128 ? T5_BUCKET[d] : 31; const float* rb = a.in[1]; biasd[i] = rb[bk * 12 + hd]; ((LAS float*)(lds + BIAS2_OFF))[i] = (rb[bk * 12 + hd] - rb[31 * 12 + hd]) * 1.4426950408889634f; } }
    __syncthreads();
    const int lo = a_.ph_lo, hi = a_.ph_hi;
    XcdBarrier bar; bar.bar = (unsigned*)(a.ws + WS_CTL) + CW_BAR; bar.x = 0; bar.st = nullptr;
    if (hi - lo > 1) { PHASE_IDS(); bar = xcd_barrier_post(ctl + CW_BAR, MISC + 8, tid_ == 0); }
#ifndef SUB_MASK
#define SUB_MASK 0xFFu
#endif
#define SUB(k) ((SUB_MASK >> (k)) & 1u)
#define HASP(k) ((PM >> ((k) % 10 + ((k) >= 20 ? 10 : 0))) & 1u)
#define IN(k) (HASP(k) && lo <= (k) && (k) < hi)
#define SEAM(k) do { if ((k) + 1 < hi) { const int sl_ = my_lane(); int sw_ = wave0; asm volatile("" : "+s"(sw_)); xcd_barrier(bar, sw_ == 0 && sl_ == 0); } } while (0)
    for (int l = 0; l < DEPTH; ++l) {
        const int pb = l * 10;
        if (IN(pb + 0)) { PHASE_IDS(); phase0_weights(ap, l, lds, gw, NGW, wave, lane); phase0_rows(ap, l, 0, gw, NGW, lane); SEAM(pb + 0); }
        if (IN(pb + 1)) {
            PHASE_IDS();
            pg8::Gemm g{1024, 1024, 1024}; SchedP1 S{(const char*)hb, (const char*)(ap.ws + WS_WIN), G, bid};
            EpiP1 E{proj, gates, ap.in[25] + (size_t)l * 4096};
            pg8::gemm_phase<EpiP1, SchedP1>(lds, g, S, E, tid_); SEAM(pb + 1);
        }
        if (IN(pb + 2)) {
            PHASE_IDS();
            float s1 = 0.f, s2 = 0.f;
            for (int i = 0; i < 32; ++i) { s1 += ap.in[13][l * 32 + i] * ap.in[14][l * 32 + i]; s2 += ap.in[15][l * 32 + i] * ap.in[16][l * 32 + i]; }
            const float lam_init = 0.8f - 0.6f * __expf(-0.3f * (float)l); const float lam = __expf(s1) - __expf(s2) + lam_init;
            if (SUB(0)) { const LAS float* bias2 = (const LAS float*)(lds + BIAS2_OFF); const GAS float* subg = (const GAS float*)(ap.in[17] + l * 64);
                for (int pi = bid; pi < 256; pi += G) { const int bh = pi >> 4, qlo = pi & 15;
                    diff_unit((const GAS bf16*)proj, (GAS bf16*)ys, lds, bias2, subg, lam, lam_init, bh >> 2, bh & 3, 31 - qlo, tid_, lane, wave);
                    diff_unit((const GAS bf16*)proj, (GAS bf16*)ys, lds, bias2, subg, lam, lam_init, bh >> 2, bh & 3, qlo, tid_, lane, wave); } }
            if (SUB(1)) for (int task = gw; task < 512; task += NGW) lru_task(ap, l, proj, ys, lrusum, task, lane, false);
            if (SUB(2)) for (int task = gw; task < 2 * BATCH * NCMP; task += NGW) cmp_task(ap, l, proj, kcb, task, lane);
            if (SUB(3)) { LAS float* qs = (LAS float*)(lds + wave * 4096); for (int tok = gw; tok < T; tok += NGW) swa_token(ap, l, proj, ys, biasd, qs, tok, lane); }
            SEAM(pb + 2);
        }
        if (IN(pb + 3)) {
            PHASE_IDS();
            if (SUB(1)) for (int task = gw; task < 512; task += NGW) lru_task(ap, l, proj, ys, lrusum, task, lane, true);
            if (SUB(4)) { __syncthreads(); const LAS float* bias2 = (const LAS float*)(lds + BIAS2_OFF);
                for (int pi = bid; pi < 256; pi += G) { const int bb = pi >> 6, ulo = pi & 63;
                    nsa_unit((const GAS bf16*)proj, (GAS bf16*)ys, (const GAS bf16*)kcb, lds, bias2, bb, 127 - ulo, tid_, lane, wave);
                    nsa_unit((const GAS bf16*)proj, (GAS bf16*)ys, (const GAS bf16*)kcb, lds, bias2, bb, ulo, tid_, lane, wave); } }
            SEAM(pb + 3);
        }
        if (IN(pb + 4)) {
            PHASE_IDS();
            pg8::Gemm g{256, 1024, 256}; SchedP3a S{(const char*)ys, (const char*)(ap.ws + WS_WBR), G, bid};
            EpiP3a E{merged, gates};
            pg8::gemm_phase<EpiP3a, SchedP3a>(lds, g, S, E, tid_); SEAM(pb + 4);
        }
        if (IN(pb + 5)) {
            PHASE_IDS();
            pg8::Gemm g{1024, 1024, 1024}; SchedP3b S{(const char*)merged, (const char*)(ap.ws + WS_WOUT), G, bid};
            EpiP3b E{(l == 0) ? ap.in[0] : ap.out, ap.out};
            pg8::gemm_phase<EpiP3b, SchedP3b>(lds, g, S, E, tid_); SEAM(pb + 5);
        }
        if (IN(pb + 6)) {
            PHASE_IDS();
            expert_weights(ap, l, lds, gw, NGW, wave, lane);
            for (int tok = gw; tok < T; tok += NGW) route_token(ap, l, x2b, rec_e, rec_slot, rec_w, ctl + CW_CNT + l * 32, tok, lane);
            SEAM(pb + 6);
        }
        if (IN(pb + 7)) {
            PHASE_IDS();
            build_offsets(ctl + CW_CNT + l * 32, offt, tid_);
            if (bid < 32) { const int e = bid; const int c = (int)__hip_atomic_load(ctl + CW_CNT + l * 32 + e, __ATOMIC_RELAXED, __HIP_MEMORY_SCOPE_AGENT);
                for (int p = offt[e] + c + tid_; p < offt[e + 1]; p += 512) rowtok[p] = -1; }
            for (int tok = gw; tok < T; tok += NGW) {
#pragma unroll
                for (int k = 0; k < 2; ++k) { const int e = rec_e[tok * 2 + k], slot = rec_slot[tok * 2 + k]; const int pos = offt[e] + slot;
                    const u32x4 v0 = *(const u32x4*)(x2b + (size_t)tok * 1024 + lane * 8), v1 = *(const u32x4*)(x2b + (size_t)tok * 1024 + 512 + lane * 8);
                    *(u32x4*)(xs + (size_t)pos * 1024 + lane * 8) = v0; *(u32x4*)(xs + (size_t)pos * 1024 + 512 + lane * 8) = v1;
                    if (lane == 0) { rowtok[pos] = tok * 2 + k; roww[pos] = rec_w[tok * 2 + k]; } } }
            SEAM(pb + 7);
        }
        if (IN(pb + 8)) {
            PHASE_IDS();
            build_offsets(ctl + CW_CNT + l * 32, offt, tid_);
            pg8::Gemm g{1024, 1024, 1024}; SchedM2 S{(const char*)xs, (const char*)(ap.ws + WS_WGU), offt, G, bid};
            EpiM2 E{hmid};
            pg8::gemm_phase<EpiM2, SchedM2>(lds, g, S, E, tid_); SEAM(pb + 8);
        }
        if (IN(pb + 9)) {
            PHASE_IDS();
            build_offsets(ctl + CW_CNT + l * 32, offt, tid_);
            pg8::Gemm g{256, 256, 256}; SchedM3 S{(const char*)hmid, (const char*)(ap.ws + WS_WD), offt, G, bid};
            EpiM3 E{eo, rowtok, roww};
            pg8::gemm_phase<EpiM3, SchedM3>(lds, g, S, E, tid_); SEAM(pb + 9);
        }
    }
    if (IN(20)) { PHASE_IDS(); phase0_rows(ap, DEPTH, 1, gw, NGW, lane); }
#undef IN
#undef SEAM
}

typedef void (*kern_t)(Args);
template <unsigned PM> static bool setup_kernel() {
    if (hipFuncSetAttribute((const void*)mk_fwd<PM>, hipFuncAttributeMaxDynamicSharedMemorySize, LDS_BYTES) != hipSuccess) { fprintf(stderr, "kernel_launch: hipFuncSetAttribute failed\n"); return false; }
    return true;
}
extern "C" void kernel_launch(void* const* d_in, const int* in_sizes, int n_in, void* d_out, int out_size, void* d_ws, size_t ws_size, hipStream_t stream) {
    static int grid = 0;
    if (grid == 0) {
        if (n_in != 36 || out_size != T * D || ws_size < WS_END) { fprintf(stderr, "kernel_launch: unexpected shapes (n_in %d out %d ws %zu)\n", n_in, out_size, ws_size); grid = -1; return; }
        int dev = 0, cus = 0;
        if (hipGetDevice(&dev) != hipSuccess || hipDeviceGetAttribute(&cus, hipDeviceAttributeMultiprocessorCount, dev) != hipSuccess) { grid = -1; return; }
        bool ok = true;
#if MK_ONE_LAUNCH
        ok = setup_kernel<0x7FFu>();
#else
        ok = setup_kernel<1u>() && setup_kernel<2u>() && setup_kernel<4u>() && setup_kernel<8u>() && setup_kernel<16u>() && setup_kernel<32u>() && setup_kernel<64u>() && setup_kernel<128u>() && setup_kernel<256u>() && setup_kernel<512u>() && setup_kernel<1024u>();
#endif
        if (!ok) { grid = -1; return; }
        (void)hipGetLastError();
        grid = cus;
    }
    if (grid < 0) return;
    if (hipMemsetAsync((char*)d_ws + WS_CTL, 0, CTL_ZERO_BYTES, stream) != hipSuccess) return;
    Args a{};
    for (int i = 0; i < 36; ++i) a.in[i] = (const float*)d_in[i];
    a.out = (float*)d_out; a.ws = (unsigned char*)d_ws;
#if MK_ONE_LAUNCH
    a.ph_lo = 0; a.ph_hi = NPH;
    hipLaunchKernelGGL(mk_fwd<0x7FFu>, dim3(grid), dim3(512), LDS_BYTES, stream, a);
#else
    static const kern_t kerns[11] = { mk_fwd<1u>, mk_fwd<2u>, mk_fwd<4u>, mk_fwd<8u>, mk_fwd<16u>, mk_fwd<32u>, mk_fwd<64u>, mk_fwd<128u>, mk_fwd<256u>, mk_fwd<512u>, mk_fwd<1024u> };
    for (int p = 0; p < NPH; ++p) { a.ph_lo = p; a.ph_hi = p + 1; hipLaunchKernelGGL(kerns[p < 20 ? p % 10 : 10], dim3(grid), dim3(512), LDS_BYTES, stream, a); }
#endif
}
```

```cpp
#include <hip/hip_runtime.h>
#include <cstdio>
#include <cstdint>

#ifndef MK_ONE_LAUNCH
#define MK_ONE_LAUNCH 1
#endif

#define DI __device__ __forceinline__
#define GAS __attribute__((address_space(1)))
#define LAS __attribute__((address_space(3)))
typedef unsigned short bf16;
typedef short bf16x8 __attribute__((ext_vector_type(8)));
typedef float f32x4 __attribute__((ext_vector_type(4)));
typedef unsigned u32x4 __attribute__((ext_vector_type(4)));
typedef unsigned u32x2 __attribute__((ext_vector_type(2)));
typedef float f32x16 __attribute__((ext_vector_type(16)));
typedef float f32x2 __attribute__((ext_vector_type(2)));
typedef short s16x4 __attribute__((ext_vector_type(4)));
typedef __bf16 bf16x2_t __attribute__((ext_vector_type(2)));
typedef short v4i16_t __attribute__((__vector_size__(4 * sizeof(short))));
#define MFMA32(a, b, c) __builtin_amdgcn_mfma_f32_32x32x16_bf16((a), (b), (c), 0, 0, 0)

constexpr int BATCH = 4, SEQ = 8192, T = BATCH * SEQ, D = 1024, DEPTH = 2;
constexpr int NIN = 2444, PLD = 2560, N1 = 6656, GLD = 4096;
constexpr int C_AX = 0, C_AG = 256, C_BQ = 512, C_BK = 768, C_BV = 896, C_CQ = 1024, C_CK = 1280, C_CV = 1536, C_DQ = 1792,
              C_KC = 2048, C_VC = 2112, C_KS = 2176, C_VS = 2240, C_KW = 2304, C_VW = 2368, C_DG = 2432;
constexpr int NCMP = 511;
constexpr int MOE_ROWS = 73728;
constexpr int NPH = 21;

constexpr size_t MiB = 1u << 20;
constexpr size_t WS_CTL = 0, CTL_ZERO_BYTES = 1 * MiB;
constexpr size_t WS_KCVC = 1 * MiB;
constexpr size_t WS_LRUSUM = 2 * MiB;
constexpr size_t WS_REC = 2 * MiB + 256 * 1024;
constexpr size_t WS_ROWTOK = 3 * MiB;
constexpr size_t WS_ROWW = 3 * MiB + 512 * 1024;
constexpr size_t WS_WIN = 4 * MiB;
constexpr size_t WS_WBR = 17 * MiB;
constexpr size_t WS_WOUT = 19 * MiB;
constexpr size_t WS_HB = 21 * MiB;
constexpr size_t WS_PROJ = 85 * MiB;
constexpr size_t WS_GATES = 245 * MiB;
constexpr size_t WS_WGU = 245 * MiB;
constexpr size_t WS_WD = 277 * MiB;
constexpr size_t WS_XS = 293 * MiB;
constexpr size_t WS_HMID = 437 * MiB;
constexpr size_t WS_END = 501 * MiB;
constexpr int CW_BAR = 4096;
constexpr int CW_CNT = 16384;

constexpr int RING_BYTES = 131072;
constexpr int MISC_OFF = RING_BYTES;
constexpr int BIAS_OFF = MISC_OFF + 256;
constexpr int OFFT_OFF = BIAS_OFF + 129 * 12 * 4;
constexpr int PTAB_OFF = OFFT_OFF + (40 + 288) * 4;
constexpr int BIAS2_OFF = PTAB_OFF + 36 * 8;
constexpr int LDS_BYTES = 147456;
static_assert(PTAB_OFF % 8 == 0 && BIAS2_OFF + 129 * 12 * 4 <= LDS_BYTES, "LDS map");

DI float bf2f(bf16 v) { return __builtin_bit_cast(float, (unsigned)v << 16); }
DI float lo_bf(unsigned w) { return __builtin_bit_cast(float, w << 16); }
DI float hi_bf(unsigned w) { return __builtin_bit_cast(float, w & 0xffff0000u); }
DI unsigned f2bf(float f) { unsigned u = __builtin_bit_cast(unsigned, f); return (u + 0x7fffu + ((u >> 16) & 1u)) >> 16; }
DI unsigned pk2(float lo, float hi) { return f2bf(lo) | (f2bf(hi) << 16); }
DI float rl(float v, int i) { return __builtin_bit_cast(float, __builtin_amdgcn_readlane(__builtin_bit_cast(int, v), i)); }
DI int rli(int v, int i) { return __builtin_amdgcn_readlane(v, i); }
DI int my_lane() { int l; asm volatile("v_mbcnt_lo_u32_b32 %0, -1, 0\n\tv_mbcnt_hi_u32_b32 %0, -1, %0" : "=v"(l)); return l; }
template <int O> DI int xshfl_i(int v) {
    if constexpr (O < 32) return __builtin_amdgcn_ds_swizzle(v, (O << 10) | 0x1f);
    else { const int l = my_lane(); return __builtin_amdgcn_ds_bpermute((l ^ 32) << 2, v); }
}
template <int O> DI float xshfl(float v) { return __builtin_bit_cast(float, xshfl_i<O>(__builtin_bit_cast(int, v))); }
DI float wave_sum(float v) { v += xshfl<1>(v); v += xshfl<2>(v); v += xshfl<4>(v); v += xshfl<8>(v); v += xshfl<16>(v); v += xshfl<32>(v); return v; }
DI float wave_max(float v) { v = fmaxf(v, xshfl<1>(v)); v = fmaxf(v, xshfl<2>(v)); v = fmaxf(v, xshfl<4>(v)); v = fmaxf(v, xshfl<8>(v)); v = fmaxf(v, xshfl<16>(v)); v = fmaxf(v, xshfl<32>(v)); return v; }
DI float sigmoidf_(float x) { return 1.f / (1.f + __expf(-x)); }
DI float gelu_tanh(float x) { const float u = 0.7978845608028654f * (x + 0.044715f * x * x * x); const float e = __expf(2.f * u); const float th = 1.f - 2.f / (e + 1.f); return 0.5f * x * (1.f + th); }
DI float softplusf_(float x) { return fmaxf(x, 0.f) + log1pf(__expf(-fabsf(x))); }
#define LDS_WAIT() asm volatile("s_waitcnt lgkmcnt(0)" ::: "memory")
#define VM_WAIT() asm volatile("s_waitcnt vmcnt(0)" ::: "memory")

__device__ const unsigned char T5_BUCKET[128] = {
0,1,2,3,4,5,6,7,8,9,10,11,12,13,14,15,16,16,16,17,17,18,18,18,19,19,19,20,20,20,20,21,21,21,21,22,22,22,22,22,23,23,23,23,23,23,24,24,24,24,24,24,25,25,25,25,25,25,25,26,26,26,26,26,26,26,26,27,27,27,27,27,27,27,27,27,27,28,28,28,28,28,28,28,28,28,28,29,29,29,29,29,29,29,29,29,29,29,29,30,30,30,30,30,30,30,30,30,30,30,30,30,30,31,31,31,31,31,31,31,31,31,31,31,31,31,31,31};

#define XB_TMO      128
#define XB_XCNT(j)  (256  + 64 * (j))
#define XB_XSUB(j)  (1280 + 64 * (j))
#define XB_XGEN(j)  (2304 + 64 * (j))
#define XB_TOP      3328
#define XB_TOPGEN   3392
#define XCD_BAR_WORDS 3456
#define XB_SPIN_CAP (1u << 22)
DI unsigned xb_ld(unsigned* p)              { return __hip_atomic_load(p, __ATOMIC_RELAXED, __HIP_MEMORY_SCOPE_AGENT); }
DI unsigned xb_add(unsigned* p, unsigned v) { return __hip_atomic_fetch_add(p, v, __ATOMIC_RELAXED, __HIP_MEMORY_SCOPE_AGENT); }
DI unsigned xb_xcc_id() { return (unsigned)__builtin_amdgcn_s_getreg((3 << 11) | 20) & 0xFu; }
#define XB_SPIN(cond, bar) do { unsigned _sp = 0; while (cond) { __builtin_amdgcn_s_sleep(1); \
    if ((++_sp & 255u) == 0u) { if (xb_ld(&(bar)[XB_TMO])) break; if (_sp > XB_SPIN_CAP) { atomicAdd(&(bar)[XB_TMO], 1u); break; } } } } while (0)
struct XcdBarrier { unsigned* bar; unsigned x; volatile LAS unsigned* st; };
DI XcdBarrier xcd_barrier_post(unsigned* bar, volatile LAS unsigned* st, bool leader) {
    XcdBarrier b; b.bar = bar; b.x = xb_xcc_id(); b.st = st;
    if (leader) (void)xb_add(&bar[XB_XCNT(b.x)], 1u);
    return b;
}
DI void xcd_barrier_complete(unsigned* bar, unsigned x, unsigned& nloc, unsigned& nx) {
    const unsigned G = gridDim.x * gridDim.y * gridDim.z;
    unsigned sum, cnt, mine, sp = 0u;
    for (;;) {
        sum = 0u; cnt = 0u; mine = 0u;
#pragma unroll
        for (unsigned j = 0; j < 16; ++j) { const unsigned c = xb_ld(&bar[XB_XCNT(j)]); sum += c; cnt += (c > 0u) ? 1u : 0u; mine = (j == x) ? c : mine; }
        if (sum == G) break;
        __builtin_amdgcn_s_sleep(1);
        if ((++sp & 255u) == 0u) { if (xb_ld(&bar[XB_TMO])) break; if (sp > XB_SPIN_CAP) { atomicAdd(&bar[XB_TMO], 1u); break; } }
    }
    nloc = mine > 0u ? mine : 1u; nx = cnt > 0u ? cnt : 1u;
}
DI void xcd_barrier(const XcdBarrier& b, bool leader) {
    asm volatile("s_waitcnt vmcnt(0)" ::: "memory");
    __syncthreads();
    if (leader) {
        unsigned* bar = b.bar;
        __builtin_amdgcn_s_waitcnt(0);
        unsigned nloc = b.st[0], nx = b.st[1];
        if (nloc == 0u) { xcd_barrier_complete(bar, b.x, nloc, nx); b.st[0] = nloc; b.st[1] = nx; }
        const unsigned old = xb_add(&bar[XB_XSUB(b.x)], 1u);
        const unsigned gen = old / nloc;
        if (old + 1u == (gen + 1u) * nloc) {
            __builtin_amdgcn_fence(__ATOMIC_RELEASE, "agent");
            asm volatile("s_waitcnt vmcnt(0)" ::: "memory");
            const unsigned og = xb_add(&bar[XB_TOP], 1u);
            const unsigned tg = og / nx;
            if (og + 1u == (tg + 1u) * nx) xb_add(&bar[XB_TOPGEN], 1u);
            else XB_SPIN(xb_ld(&bar[XB_TOPGEN]) == tg, bar);
            __builtin_amdgcn_fence(__ATOMIC_ACQUIRE, "agent");
            xb_add(&bar[XB_XGEN(b.x)], 1u);
            asm volatile("s_waitcnt vmcnt(0)" ::: "memory");
        } else {
            XB_SPIN(xb_ld(&bar[XB_XGEN(b.x)]) == gen, bar);
            __builtin_amdgcn_fence(__ATOMIC_ACQUIRE, "agent");
            asm volatile("s_waitcnt vmcnt(0)" ::: "memory");
        }
    }
    __syncthreads();
}

namespace pg8 {
constexpr int BM = 256, BK = 64, HALF = 128, HTB = HALF * BK * 2;
__host__ __device__ __forceinline__ int lds_byte(int r, int c) { const int st = (r >> 4) * 2 + (c >> 5), rr = r & 15, cc = c & 31, ob = rr * 64 + cc * 2; return st * 1024 + (ob ^ (((ob >> 9) & 1) << 5)); }
__host__ __device__ __forceinline__ void stage_rc(int b, int& R, int& C) { const int st = b / 1024, sb = b % 1024, swz = sb ^ (((sb >> 9) & 1) << 5); R = (st >> 1) * 16 + swz / 64; C = (st & 1) * 32 + (swz % 64) / 2; }
__host__ __device__ __forceinline__ int perm32(int rho) { const int n = rho >> 4, i = rho & 15; return 8 * (i >> 2) + 4 * n + (i & 3); }
struct Unit { const char* a; const char* b; int pm, pn, aux, pad; };
struct Gemm { int K, lda, ldb; };
template <class Epi, class Sched>
DI void gemm_phase(LAS unsigned char* lds, const Gemm g, const Sched& S, const Epi& E, int tid_in) {
    int tid = tid_in; asm volatile("" : "+v"(tid));
    const int wid = __builtin_amdgcn_readfirstlane(tid >> 6), lane = tid & 63, wr = wid >> 2, wc = wid & 3, fr = lane & 15, fq = lane >> 4;
    const int K = g.K, nt = K / BK;
    unsigned voffA[2], voffB[2];
#pragma unroll
    for (int i = 0; i < 2; ++i) { int R, C; stage_rc(tid * 16 + i * 8192, R, C); const int Rb = (R & ~31) + perm32(R & 31);
        voffA[i] = (unsigned)(R * g.lda + C) * 2u; voffB[i] = (unsigned)(Rb * g.ldb + C) * 2u; }
    const size_t kstep = (size_t)(BK * 2);
    const size_t hstepA = (size_t)HALF * g.lda * 2, hstepB = (size_t)HALF * g.ldb * 2;
    const unsigned ldsw = (unsigned)wid * 1024u;
    const int aoff = lds_byte(wr * 64 + fr, fq * 8), boff = lds_byte(wc * 32 + fr, fq * 8);
#define PG8_SA(b, h) (((b) * 2 + (h)) * HTB)
#define PG8_SB(b, h) ((4 + (b) * 2 + (h)) * HTB)
#define PG8_STAGE(bufoff, gbase, voff) do { _Pragma("unroll") for (int _i = 0; _i < 2; ++_i) \
        __builtin_amdgcn_global_load_lds((const unsigned*)((const char*)(gbase) + (voff)[_i]), (LAS unsigned*)(lds + (bufoff) + ldsw + _i * 8192), 16, 0, 0); } while (0)
#define PG8_LDA(dst, b, h) do { _Pragma("unroll") for (int m = 0; m < 4; ++m) _Pragma("unroll") for (int k = 0; k < 2; ++k) dst[m][k] = *(const LAS bf16x8*)(lds + PG8_SA(b, h) + aoff + m * 2048 + k * 1024); } while (0)
#define PG8_LDB(dst, b, h) do { _Pragma("unroll") for (int n = 0; n < 2; ++n) _Pragma("unroll") for (int k = 0; k < 2; ++k) dst[n][k] = *(const LAS bf16x8*)(lds + PG8_SB(b, h) + boff + n * 2048 + k * 1024); } while (0)
#define PG8_MMA(ai, bj, At, Bt) do { __builtin_amdgcn_s_setprio(1); _Pragma("unroll") for (int m = 0; m < 4; ++m) _Pragma("unroll") for (int n = 0; n < 2; ++n) _Pragma("unroll") for (int k = 0; k < 2; ++k) \
        acc[ai][bj][m][n] = __builtin_amdgcn_mfma_f32_16x16x32_bf16(Bt[n][k], At[m][k], acc[ai][bj][m][n], 0, 0, 0); __builtin_amdgcn_s_setprio(0); } while (0)
#define PG8_WAIT_V(n) asm volatile("s_waitcnt vmcnt(" #n ")" ::: "memory")
#define PG8_WAIT_L(n) asm volatile("s_waitcnt lgkmcnt(" #n ")" ::: "memory")
#define PG8_BAR __builtin_amdgcn_s_barrier()
#define PG8_SCHED __builtin_amdgcn_sched_barrier(0)
    Unit cur, nxt; int ui = 0;
    if (!S.next(0, cur)) return;
    f32x4 acc[2][2][4][2];
#pragma unroll
    for (int a = 0; a < 2; ++a)
#pragma unroll
        for (int b = 0; b < 2; ++b)
#pragma unroll
            for (int m = 0; m < 4; ++m)
#pragma unroll
                for (int n = 0; n < 2; ++n) acc[a][b][m][n] = (f32x4){0.f, 0.f, 0.f, 0.f};
    bf16x8 At[4][2], B0[2][2], B1[2][2];
    const char* cA = cur.a; const char* cB = cur.b;
    PG8_STAGE(PG8_SB(0, 0), cB, voffB); PG8_STAGE(PG8_SB(0, 1), cB + hstepB, voffB); PG8_STAGE(PG8_SA(0, 0), cA, voffA); PG8_STAGE(PG8_SA(0, 1), cA + hstepA, voffA);
    if (wr == 1) PG8_BAR;
    PG8_WAIT_V(2); PG8_BAR;
    PG8_STAGE(PG8_SB(1, 0), cB + kstep, voffB); PG8_STAGE(PG8_SA(1, 0), cA + kstep, voffA); PG8_STAGE(PG8_SB(1, 1), cB + hstepB + kstep, voffB);
    PG8_WAIT_V(6); PG8_BAR;
    for (;;) {
        const bool has_next = S.next(ui + 1, nxt);
        const char* nA = has_next ? nxt.a : cA; const char* nB = has_next ? nxt.b : cB;
        for (int t = 0; t < nt; t += 2) {
            const bool last = (t == nt - 2);
            const char* a1 = cA + (size_t)(t + 1) * kstep;
            const char* a2 = last ? nA : cA + (size_t)(t + 2) * kstep; const char* b2 = last ? nB : cB + (size_t)(t + 2) * kstep;
            const char* a3 = a2 + kstep; const char* b3 = b2 + kstep;
            PG8_LDB(B0, 0, 0); PG8_LDB(B1, 0, 1); PG8_SCHED; PG8_LDA(At, 0, 0); PG8_STAGE(PG8_SA(1, 1), a1 + hstepA, voffA);
            PG8_WAIT_V(8); PG8_WAIT_L(0); PG8_BAR; PG8_MMA(0, 0, At, B0); PG8_MMA(0, 1, At, B1); PG8_BAR; PG8_SCHED;
            PG8_LDA(At, 0, 1); PG8_STAGE(PG8_SB(0, 0), b2, voffB); PG8_STAGE(PG8_SB(0, 1), b2 + hstepB, voffB); PG8_STAGE(PG8_SA(0, 0), a2, voffA);
            PG8_WAIT_V(8); PG8_WAIT_L(0); PG8_BAR; PG8_MMA(1, 0, At, B0); PG8_MMA(1, 1, At, B1); PG8_BAR; PG8_SCHED;
            PG8_LDB(B0, 1, 0); PG8_LDB(B1, 1, 1); PG8_SCHED; PG8_LDA(At, 1, 0); PG8_STAGE(PG8_SA(0, 1), a2 + hstepA, voffA);
            PG8_WAIT_V(8); PG8_WAIT_L(0); PG8_BAR; PG8_MMA(0, 0, At, B0); PG8_MMA(0, 1, At, B1); PG8_BAR; PG8_SCHED;
            PG8_LDA(At, 1, 1); PG8_STAGE(PG8_SB(1, 0), b3, voffB); PG8_STAGE(PG8_SB(1, 1), b3 + hstepB, voffB); PG8_STAGE(PG8_SA(1, 0), a3, voffA);
            PG8_WAIT_V(8); PG8_WAIT_L(0); PG8_BAR; PG8_MMA(1, 0, At, B0); PG8_MMA(1, 1, At, B1); PG8_BAR; PG8_SCHED;
        }
        if (wr == 0) PG8_BAR;
        { const int el = my_lane(); E(acc, cur, wr, wc, el & 15, el >> 4); }
        if (!has_next) break;
#pragma unroll
        for (int a = 0; a < 2; ++a)
#pragma unroll
            for (int b = 0; b < 2; ++b)
#pragma unroll
                for (int m = 0; m < 4; ++m)
#pragma unroll
                    for (int n = 0; n < 2; ++n) acc[a][b][m][n] = (f32x4){0.f, 0.f, 0.f, 0.f};
        cur = nxt; cA = nA; cB = nB; ++ui;
        if (wr == 1) PG8_BAR;
    }
    PG8_WAIT_V(0);
    PG8_BAR;
#undef PG8_SA
#undef PG8_SB
#undef PG8_STAGE
#undef PG8_LDA
#undef PG8_LDB
#undef PG8_MMA
#undef PG8_WAIT_V
#undef PG8_WAIT_L
#undef PG8_BAR
#undef PG8_SCHED
}
}
using pg8::Unit;

DI unsigned cvt_pk_bf16(float lo, float hi) { unsigned r; asm volatile("v_cvt_pk_bf16_f32 %0, %1, %2" : "=v"(r) : "v"(lo), "v"(hi)); return r; }
DI u32x4 pack8(const f32x4& v0, const f32x4& v1) { u32x4 w; w.x = cvt_pk_bf16(v0[0], v0[1]); w.y = cvt_pk_bf16(v0[2], v0[3]); w.z = cvt_pk_bf16(v1[0], v1[1]); w.w = cvt_pk_bf16(v1[2], v1[3]); return w; }

struct SchedP1 {
    const char* A; const char* B; int G, c;
    DI bool next(int i, Unit& u) const {
        constexpr int nM = 128, nN = 26, nwg = nM * nN, NXCD = 8, WGM = 8;
        const long L = (long)i * G + c; if (L >= nwg) return false;
        int wgid = (int)L; { const int q = nwg / NXCD, r = nwg % NXCD, xcd = wgid % NXCD, off = wgid / NXCD; wgid = (xcd < r ? xcd * (q + 1) : r * (q + 1) + (xcd - r) * q) + off; }
        const int nig = WGM * nN, gid = wgid / nig, fm = gid * WGM, gsz = (nM - fm) < WGM ? (nM - fm) : WGM;
        u.pm = fm + ((wgid % nig) % gsz); u.pn = (wgid % nig) / gsz; u.aux = 0; u.pad = 0;
        u.a = A + (size_t)u.pm * 256 * 1024 * 2; u.b = B + (size_t)u.pn * 256 * 1024 * 2; return true;
    }
};
struct SchedP3a {
    const char* ys; const char* wbr; int G, c;
    DI bool next(int i, Unit& u) const {
        const int tile = (i >> 2) * G + c; if (tile >= 512) return false;
        const int br = i & 3; u.pm = tile >> 2; u.pn = tile & 3; u.aux = br; u.pad = 0;
        u.a = ys + ((size_t)u.pm * 256 * 1024 + br * 256) * 2; u.b = wbr + ((size_t)br * 1024 * 256 + (size_t)u.pn * 256 * 256) * 2; return true;
    }
};
struct SchedP3b {
    const char* A; const char* B; int G, c;
    DI bool next(int i, Unit& u) const {
        const int L = i * G + c; if (L >= 512) return false;
        u.pm = L >> 2; u.pn = L & 3; u.aux = 0; u.pad = 0;
        u.a = A + (size_t)u.pm * 256 * 1024 * 2; u.b = B + (size_t)u.pn * 256 * 1024 * 2; return true;
    }
};
struct SchedM2 {
    const char* xs; const char* wgu; const LAS int* offt; int G, c;
    DI bool next(int i, Unit& u) const {
        const int NT = __builtin_amdgcn_readfirstlane(offt[32]) >> 8; const int L = i * G + c; if (L >= NT * 2) return false;
        const int rt = L >> 1, pn = L & 1; const int e = __builtin_amdgcn_readfirstlane(offt[40 + rt]);
        u.pm = rt; u.pn = pn; u.aux = e; u.pad = 0;
        u.a = xs + (size_t)rt * 256 * 1024 * 2; u.b = wgu + ((size_t)e * 512 + pn * 256) * 1024 * 2; return true;
    }
};
struct SchedM3 {
    const char* hmid; const char* wd; const LAS int* offt; int G, c;
    DI bool next(int i, Unit& u) const {
        const int NT = __builtin_amdgcn_readfirstlane(offt[32]) >> 8; const int L = i * G + c; if (L >= NT * 4) return false;
        const int rt = L >> 2, pn = L & 3; const int e = __builtin_amdgcn_readfirstlane(offt[40 + rt]);
        u.pm = rt; u.pn = pn; u.aux = e; u.pad = 0;
        u.a = hmid + (size_t)rt * 256 * 256 * 2; u.b = wd + ((size_t)e * 1024 + pn * 256) * 256 * 2; return true;
    }
};

struct EpiP1 {
    bf16* proj; bf16* gates; const float* bgate;
    DI void operator()(const f32x4 (&acc)[2][2][4][2], const Unit& u, int wr, int wc, int fr, int fq) const {
        const int row0 = u.pm * 256 + wr * 64 + fr; const int colt = u.pn * 256 + wc * 32 + 8 * fq;
        if (u.pn < 10) {
#pragma unroll
            for (int ai = 0; ai < 2; ++ai)
#pragma unroll
                for (int m = 0; m < 4; ++m) { bf16* rowp = proj + (size_t)(row0 + ai * 128 + m * 16) * PLD + colt;
#pragma unroll
                    for (int bj = 0; bj < 2; ++bj) *(u32x4*)(rowp + bj * 128) = pack8(acc[ai][bj][m][0], acc[ai][bj][m][1]); }
        } else {
            const int gcol = colt - 2560;
            f32x4 bv[2][2];
#pragma unroll
            for (int bj = 0; bj < 2; ++bj)
#pragma unroll
                for (int n = 0; n < 2; ++n) bv[bj][n] = *(const f32x4*)(bgate + gcol + bj * 128 + 4 * n);
#pragma unroll
            for (int ai = 0; ai < 2; ++ai)
#pragma unroll
                for (int m = 0; m < 4; ++m) { bf16* rowp = gates + (size_t)(row0 + ai * 128 + m * 16) * GLD + gcol;
#pragma unroll
                    for (int bj = 0; bj < 2; ++bj) { f32x4 v0 = acc[ai][bj][m][0] + bv[bj][0], v1 = acc[ai][bj][m][1] + bv[bj][1];
#pragma unroll
                        for (int e = 0; e < 4; ++e) { v0[e] = sigmoidf_(v0[e]); v1[e] = sigmoidf_(v1[e]); }
                        *(u32x4*)(rowp + bj * 128) = pack8(v0, v1); }
                    __builtin_amdgcn_sched_barrier(0); }
        }
    }
};
struct EpiP3a {
    bf16* merged; const bf16* gates;
    DI void operator()(const f32x4 (&acc)[2][2][4][2], const Unit& u, int wr, int wc, int fr, int fq) const {
        const int row0 = u.pm * 256 + wr * 64 + fr; const int colt = u.pn * 256 + wc * 32 + 8 * fq; const int br = u.aux;
#pragma unroll
        for (int ai = 0; ai < 2; ++ai)
#pragma unroll
            for (int m = 0; m < 4; ++m) { const size_t row = (size_t)(row0 + ai * 128 + m * 16);
#pragma unroll
                for (int bj = 0; bj < 2; ++bj) {
                    const u32x4 gw = *(const u32x4*)(gates + row * GLD + br * 1024 + colt + bj * 128);
                    bf16* mp = merged + row * 1024 + colt + bj * 128;
                    f32x4 v0 = acc[ai][bj][m][0], v1 = acc[ai][bj][m][1];
                    v0[0] *= lo_bf(gw.x); v0[1] *= hi_bf(gw.x); v0[2] *= lo_bf(gw.y); v0[3] *= hi_bf(gw.y);
                    v1[0] *= lo_bf(gw.z); v1[1] *= hi_bf(gw.z); v1[2] *= lo_bf(gw.w); v1[3] *= hi_bf(gw.w);
                    if (br != 0) { const u32x4 mw = *(const u32x4*)mp;
                        v0[0] += lo_bf(mw.x); v0[1] += hi_bf(mw.x); v0[2] += lo_bf(mw.y); v0[3] += hi_bf(mw.y);
                        v1[0] += lo_bf(mw.z); v1[1] += hi_bf(mw.z); v1[2] += lo_bf(mw.w); v1[3] += hi_bf(mw.w); }
                    *(u32x4*)mp = pack8(v0, v1); }
                __builtin_amdgcn_sched_barrier(0); }
    }
};
struct EpiP3b {
    const float* xin; float* out;
    DI void operator()(const f32x4 (&acc)[2][2][4][2], const Unit& u, int wr, int wc, int fr, int fq) const {
        const int row0 = u.pm * 256 + wr * 64 + fr; const int colt = u.pn * 256 + wc * 32 + 8 * fq;
#pragma unroll
        for (int ai = 0; ai < 2; ++ai)
#pragma unroll
            for (int m = 0; m < 4; ++m) { const size_t off = (size_t)(row0 + ai * 128 + m * 16) * 1024 + colt;
#pragma unroll
                for (int bj = 0; bj < 2; ++bj)
#pragma unroll
                    for (int n = 0; n < 2; ++n) { const f32x4 xv = *(const f32x4*)(xin + off + bj * 128 + 4 * n); *(f32x4*)(out + off + bj * 128 + 4 * n) = xv + acc[ai][bj][m][n]; }
                __builtin_amdgcn_sched_barrier(0); }
    }
};
struct EpiM2 {
    bf16* hmid;
    DI void operator()(const f32x4 (&acc)[2][2][4][2], const Unit& u, int wr, int wc, int fr, int fq) const {
        const int row0 = u.pm * 256 + wr * 64 + fr; const int col = u.pn * 128 + wc * 32 + 8 * fq;
#pragma unroll
        for (int ai = 0; ai < 2; ++ai)
#pragma unroll
            for (int m = 0; m < 4; ++m) { f32x4 h0, h1;
#pragma unroll
                for (int e = 0; e < 4; ++e) { const float g0 = acc[ai][0][m][0][e], g1 = acc[ai][0][m][1][e];
                    h0[e] = g0 * sigmoidf_(g0) * acc[ai][1][m][0][e]; h1[e] = g1 * sigmoidf_(g1) * acc[ai][1][m][1][e]; }
                *(u32x4*)(hmid + (size_t)(row0 + ai * 128 + m * 16) * 256 + col) = pack8(h0, h1); }
    }
};
struct EpiM3 {
    bf16* eo; const int* rowtok; const float* roww;
    DI void operator()(const f32x4 (&acc)[2][2][4][2], const Unit& u, int wr, int wc, int fr, int fq) const {
        const int row0 = u.pm * 256 + wr * 64 + fr; const int colt = u.pn * 256 + wc * 32 + 8 * fq;
#pragma unroll
        for (int ai = 0; ai < 2; ++ai)
#pragma unroll
            for (int m = 0; m < 4; ++m) { const int row = row0 + ai * 128 + m * 16; const int tk = rowtok[row];
                if (tk >= 0) { const float w = roww[row]; bf16* op = eo + (size_t)tk * 1024 + colt;
#pragma unroll
                    for (int bj = 0; bj < 2; ++bj) *(u32x4*)(op + bj * 128) = pack8(acc[ai][bj][m][0] * w, acc[ai][bj][m][1] * w); }
                __builtin_amdgcn_sched_barrier(0); }
    }
};

struct Args { const float* in[36]; float* out; unsigned char* ws; int ph_lo, ph_hi; };
struct InTab { unsigned base;
    DI const float* operator[](int i) const { unsigned long long v; const unsigned addr = base + (unsigned)i * 8u;
        asm volatile("ds_read_b64 %0, %1\n\ts_waitcnt lgkmcnt(0)" : "=v"(v) : "v"(addr) : "memory");
        const unsigned lo = __builtin_amdgcn_readfirstlane((unsigned)v), hi = __builtin_amdgcn_readfirstlane((unsigned)(v >> 32));
        return (const float*)(((unsigned long long)hi << 32) | lo); } };
struct KA { InTab in; float* out; unsigned char* ws; };

DI void transpose_item(const float* W, int ldw, int nvalid, bf16* WT, int ldt, int k0, int n0, int dst_row0, LAS float* scr, int lane) {
    const bool nok = (n0 + (lane & 31)) < nvalid;
#pragma unroll 8
    for (int i = 0; i < 32; ++i) { const int kk = 2 * i + (lane >> 5); scr[kk * 33 + (lane & 31)] = nok ? W[(size_t)(k0 + kk) * ldw + n0 + (lane & 31)] : 0.f; }
    LDS_WAIT(); asm volatile("" ::: "memory");
    const int c = lane & 7;
#pragma unroll
    for (int j = 0; j < 4; ++j) { const int n = (lane >> 3) + 8 * j; const LAS float* s = scr + (8 * c) * 33 + n;
        u32x4 o; o.x = pk2(s[0 * 33], s[1 * 33]); o.y = pk2(s[2 * 33], s[3 * 33]); o.z = pk2(s[4 * 33], s[5 * 33]); o.w = pk2(s[6 * 33], s[7 * 33]);
        if (n0 + n < nvalid) *(u32x4*)(WT + (size_t)(dst_row0 + n) * ldt + k0 + 8 * c) = o; }
    LDS_WAIT(); asm volatile("" ::: "memory");
}
DI void phase0_weights(const KA& a, int l, LAS unsigned char* lds, int gw, int NGW, int wave, int lane) {
    LAS float* scr = (LAS float*)(lds + wave * 16384);
    const float* w_in = a.in[4] + (size_t)l * 1024 * NIN;
    const float* w_gate = a.in[24] + (size_t)l * 4 * 1024 * 1024;
    const float* w_br = a.in[26] + (size_t)l * 4 * 256 * 1024;
    const float* w_out = a.in[27] + (size_t)l * 1024 * 1024;
    bf16* Wt_in = (bf16*)(a.ws + WS_WIN); bf16* Wt_br = (bf16*)(a.ws + WS_WBR); bf16* Wt_out = (bf16*)(a.ws + WS_WOUT);
    constexpr int I_IN = 16 * 77, I_G = 4 * 16 * 32, I_B = 4 * 4 * 32, I_O = 16 * 32, NIT = I_IN + I_G + I_B + I_O;
    for (int it = gw; it < NIT; it += NGW) {
        int r = it;
        if (r < I_IN) { const int kb = r / 77, nb = r % 77; transpose_item(w_in, NIN, NIN, Wt_in, 1024, kb * 64, nb * 32, nb * 32, scr, lane); continue; } r -= I_IN;
        if (r < I_G) { const int br = r / 512, q = r % 512, kb = q / 32, nb = q % 32; transpose_item(w_gate + (size_t)br * 1024 * 1024, 1024, 1024, Wt_in, 1024, kb * 64, nb * 32, 2560 + br * 1024 + nb * 32, scr, lane); continue; } r -= I_G;
        if (r < I_B) { const int br = r / 128, q = r % 128, kb = q / 32, nb = q % 32; transpose_item(w_br + (size_t)br * 256 * 1024, 1024, 1024, Wt_br + (size_t)br * 1024 * 256, 256, kb * 64, nb * 32, nb * 32, scr, lane); continue; } r -= I_B;
        { const int kb = r / 32, nb = r % 32; transpose_item(w_out, 1024, 1024, Wt_out, 1024, kb * 64, nb * 32, nb * 32, scr, lane); }
    }
}
DI void phase0_rows(const KA& a, int l, int mode, int gw, int NGW, int lane) {
    const float* xin = (l == 0) ? a.in[0] : a.out;
    const bf16* eo = (const bf16*)(a.ws + WS_PROJ);
    bf16* hb = (bf16*)(a.ws + WS_HB);
    const float* g = mode ? a.in[2] : (a.in[3] + (size_t)l * 1024);
    for (int m = gw; m < T; m += NGW) {
        f32x4 v[4]; float ss = 0.f;
#pragma unroll
        for (int j = 0; j < 4; ++j) { v[j] = *(const f32x4*)(xin + (size_t)m * 1024 + 4 * (lane + 64 * j));
            if (l > 0) {
                const u32x2 e0 = *(const u32x2*)(eo + (size_t)(2 * m) * 1024 + 4 * (lane + 64 * j));
                const u32x2 e1 = *(const u32x2*)(eo + (size_t)(2 * m + 1) * 1024 + 4 * (lane + 64 * j));
                v[j][0] += lo_bf(e0.x) + lo_bf(e1.x); v[j][1] += hi_bf(e0.x) + hi_bf(e1.x); v[j][2] += lo_bf(e0.y) + lo_bf(e1.y); v[j][3] += hi_bf(e0.y) + hi_bf(e1.y);
            }
            ss += (v[j][0] * v[j][0] + v[j][1] * v[j][1]) + (v[j][2] * v[j][2] + v[j][3] * v[j][3]); }
        const float r = 1.f / sqrtf(wave_sum(ss) * (1.f / 1024.f) + 1e-6f);
#pragma unroll
        for (int j = 0; j < 4; ++j) { const f32x4 gv = *(const f32x4*)(g + 4 * (lane + 64 * j)); const f32x4 y = v[j] * r * gv;
            if (mode) *(f32x4*)(a.out + (size_t)m * 1024 + 4 * (lane + 64 * j)) = y;
            else { if (l > 0) *(f32x4*)(a.out + (size_t)m * 1024 + 4 * (lane + 64 * j)) = v[j];
                   u32x2 w; w.x = pk2(y[0], y[1]); w.y = pk2(y[2], y[3]); *(u32x2*)(hb + (size_t)m * 1024 + 4 * (lane + 64 * j)) = w; } }
    }
}

DI void lru_task(const KA& a, int l, const bf16* proj, bf16* ys, float* sums, int task, int lane, bool final) {
    const int chunk = task & 31, hbk = (task >> 5) & 3, b = task >> 7; const int c = hbk * 64 + lane;
    const float* w_a = a.in[7] + ((size_t)l * 4 + hbk) * 4096; const float* w_x = a.in[9] + ((size_t)l * 4 + hbk) * 4096;
    float wa[64], wx[64];
#pragma unroll
    for (int i = 0; i < 64; ++i) { wa[i] = w_a[i * 64 + lane]; wx[i] = w_x[i * 64 + lane]; }
    const float* cw = a.in[5] + (size_t)l * 4 * 256;
    const float cw0 = cw[c], cw1 = cw[256 + c], cw2 = cw[512 + c], cw3 = cw[768 + c];
    const float cb = a.in[6][l * 256 + c], ba = a.in[8][l * 256 + c], bx = a.in[10][l * 256 + c];
    const float c8 = -8.f * softplusf_(-a.in[11][l * 256 + c]);
    const int t0 = chunk * 256; const size_t rowb = (size_t)b * SEQ;
    float x3 = (t0 >= 3) ? bf2f(proj[(rowb + t0 - 3) * PLD + C_AX + c]) : 0.f;
    float x2 = (t0 >= 2) ? bf2f(proj[(rowb + t0 - 2) * PLD + C_AX + c]) : 0.f;
    float x1 = (t0 >= 1) ? bf2f(proj[(rowb + t0 - 1) * PLD + C_AX + c]) : 0.f;
    float h = 0.f, Ap = 1.f;
    if (final) { for (int cc = 0; cc < chunk; ++cc) { const float* sp = sums + ((size_t)((b * 4 + hbk) * 32 + cc) * 64 + lane) * 2; h = sp[0] * h + sp[1]; } }
    for (int t = t0; t < t0 + 256; ++t) {
        const float x0 = bf2f(proj[(rowb + t) * PLD + C_AX + c]);
        const float xc = cb + cw0 * x3 + cw1 * x2 + cw2 * x1 + cw3 * x0;
        float ra = ba, rx = bx;
#pragma unroll
        for (int i = 0; i < 64; ++i) { const float s = rl(xc, i); ra += s * wa[i]; rx += s * wx[i]; }
        const float r = sigmoidf_(ra), ig = sigmoidf_(rx);
        const float la = c8 * r; const float av = __expf(la);
        const float mult = (t == 0) ? 1.f : sqrtf(fmaxf(1.f - __expf(2.f * la), 0.f));
        const float bb = mult * ig * xc;
        h = av * h + bb; Ap *= av;
        if (final) { const float gt = bf2f(proj[(rowb + t) * PLD + C_AG + c]); ys[(rowb + t) * 1024 + c] = (bf16)f2bf(h * gelu_tanh(gt)); }
        x3 = x2; x2 = x1; x1 = x0;
    }
    if (!final) { float* sp = sums + ((size_t)((b * 4 + hbk) * 32 + chunk) * 64 + lane) * 2; sp[0] = Ap; sp[1] = h; }
}

constexpr int DK_STR = 144, DV_STR = 192, DBUF_BYTES = 64 * DK_STR + 64 * DV_STR;
DI int crow(int i, int hh) { return (i & 3) + 8 * (i >> 2) + 4 * hh; }
DI unsigned cvtpk(float lo, float hi) { f32x2 v = {lo, hi}; bf16x2_t b = __builtin_convertvector(v, bf16x2_t); return __builtin_bit_cast(unsigned, b); }
DI bf16x8 pack_half(const f32x16& x, int s2) { u32x4 p;
    if (s2 == 0) { p.x = cvtpk(x[0], x[1]); p.y = cvtpk(x[2], x[3]); p.z = cvtpk(x[4], x[5]); p.w = cvtpk(x[6], x[7]); }
    else { p.x = cvtpk(x[8], x[9]); p.y = cvtpk(x[10], x[11]); p.z = cvtpk(x[12], x[13]); p.w = cvtpk(x[14], x[15]); }
    return __builtin_bit_cast(bf16x8, p); }
DI s16x4 vtr(const LAS unsigned char* p) { return __builtin_bit_cast(s16x4, __builtin_amdgcn_ds_read_tr16_b64_v4i16((LAS v4i16_t*)p)); }
DI float max16(const f32x16& x) { float a = fmaxf(fmaxf(x[0], x[1]), fmaxf(x[2], x[3])), b = fmaxf(fmaxf(x[4], x[5]), fmaxf(x[6], x[7])), c = fmaxf(fmaxf(x[8], x[9]), fmaxf(x[10], x[11])), d = fmaxf(fmaxf(x[12], x[13]), fmaxf(x[14], x[15])); return fmaxf(fmaxf(a, b), fmaxf(c, d)); }
DI void diff_unit(const GAS bf16* proj, GAS bf16* ys, LAS unsigned char* lds, const LAS float* bias2, const GAS float* subg, float lam, float lam_init, int b, int h, int qb, int tid_in, int lane_in, int wave_in) {
    int tid = tid_in, lane = lane_in, wave = wave_in; asm volatile("" : "+v"(tid), "+v"(lane), "+s"(wave));
    const int q0 = qb * 256 + wave * 32; const int ql = lane & 31, hh = lane >> 5; const int q = q0 + ql;
    const size_t rowb = (size_t)b * SEQ;
    const float SC = 0.17677669529663687f * 1.4426950408889634f;
    bf16x8 qf[2][2];
    { const GAS bf16* qp = proj + (rowb + q) * PLD + C_CQ + h * 64 + hh * 8;
#pragma unroll
      for (int m = 0; m < 2; ++m)
#pragma unroll
        for (int s = 0; s < 2; ++s) { const u32x4 w = *(const GAS u32x4*)(qp + m * 32 + s * 16); u32x4 o;
            o.x = cvtpk(lo_bf(w.x) * SC, hi_bf(w.x) * SC); o.y = cvtpk(lo_bf(w.y) * SC, hi_bf(w.y) * SC); o.z = cvtpk(lo_bf(w.z) * SC, hi_bf(w.z) * SC); o.w = cvtpk(lo_bf(w.w) * SC, hi_bf(w.w) * SC);
            qf[m][s] = __builtin_bit_cast(bf16x8, o); } }
    f32x16 O[2][2], negm[2];
#pragma unroll
    for (int i = 0; i < 16; ++i) { O[0][0][i] = 0.f; O[0][1][i] = 0.f; O[1][0][i] = 0.f; O[1][1][i] = 0.f; negm[0][i] = 0.f; negm[1][i] = 0.f; }
    float lsum[2] = {0.f, 0.f};
    const int nsteps = 4 * qb + 4, mysteps = 4 * qb + (wave >> 1) + 1;
    const int skey = tid >> 3, sch = tid & 7;
    const GAS unsigned char* kgb = (const GAS unsigned char*)(proj + rowb * PLD + C_CK + h * 64);
    const GAS unsigned char* vgb = (const GAS unsigned char*)(proj + rowb * PLD + C_CV + h * 64);
    const unsigned soff = (unsigned)(skey * PLD + sch * 8) * 2u;
    u32x4 kr = *(const GAS u32x4*)(kgb + soff), vr = *(const GAS u32x4*)(vgb + soff);
    *(LAS u32x4*)(lds + skey * DK_STR + sch * 16) = kr; *(LAS u32x4*)(lds + 64 * DK_STR + skey * DV_STR + sch * 16) = vr;
    __syncthreads();
    const int i16 = lane & 15, blk = (lane >> 4) & 1;
    const int kboff = ql * DK_STR + hh * 16;
    const int vboff = 64 * DK_STR + (4 * hh + (i16 >> 2)) * DV_STR + (16 * blk + 4 * (i16 & 3)) * 2;
#pragma unroll 1
    for (int kt = 0; kt < nsteps; ++kt) {
        const LAS unsigned char* cur = lds + (kt & 1) * DBUF_BYTES; LAS unsigned char* nxt = lds + ((kt + 1) & 1) * DBUF_BYTES;
        if (kt + 1 < nsteps) { const unsigned so = soff + (unsigned)(kt + 1) * (64u * PLD * 2u); kr = *(const GAS u32x4*)(kgb + so); vr = *(const GAS u32x4*)(vgb + so); }
        if (kt < mysteps) {
            const int kbase = kt * 64;
            const bool near = (q0 - (kbase + 63) < 113);
#pragma unroll
            for (int m = 0; m < 2; ++m) {
                bf16x8 pk[2][2];
                f32x16 S[2];
                {   bf16x8 kf[2][2];
#pragma unroll
                    for (int t = 0; t < 2; ++t)
#pragma unroll
                        for (int s = 0; s < 2; ++s) kf[t][s] = *(const LAS bf16x8*)(cur + kboff + t * 32 * DK_STR + m * 64 + s * 32);
#pragma unroll
                    for (int t = 0; t < 2; ++t) { S[t] = MFMA32(kf[t][0], qf[m][0], negm[m]); S[t] = MFMA32(kf[t][1], qf[m][1], S[t]); } }
                if (near) {
#pragma unroll
                    for (int t = 0; t < 2; ++t)
#pragma unroll
                        for (int i = 0; i < 16; ++i) { const int dist = q - (kbase + 32 * t + crow(i, hh)); const int di = dist < 128 ? dist : 128;
                            const float bv = dist >= 0 ? bias2[di * 12 + 4 + h] : -1e30f; S[t][i] += bv; } }
                float tm = fmaxf(max16(S[0]), max16(S[1]));
                const bool need = (tm > 8.f) || (kt == 0);
                if (__builtin_amdgcn_ballot_w64(need) != 0ull) {
                    tm = fmaxf(tm, xshfl<32>(tm));
                    const float sh = (kt == 0) ? tm : fmaxf(tm, 0.f);
                    const float al = __builtin_amdgcn_exp2f(-sh);
                    lsum[m] *= al;
#pragma unroll
                    for (int i = 0; i < 16; ++i) { O[m][0][i] *= al; O[m][1][i] *= al; negm[m][i] -= sh; S[0][i] -= sh; S[1][i] -= sh; }
                }
#pragma unroll
                for (int t = 0; t < 2; ++t) {
#pragma unroll
                    for (int i = 0; i < 16; ++i) { const float p = __builtin_amdgcn_exp2f(S[t][i]); S[t][i] = p; lsum[m] += p; }
                    pk[t][0] = pack_half(S[t], 0); pk[t][1] = pack_half(S[t], 1); }
#pragma unroll
                for (int t = 0; t < 2; ++t)
#pragma unroll
                    for (int s2 = 0; s2 < 2; ++s2)
#pragma unroll
                        for (int db = 0; db < 2; ++db) {
                            const s16x4 lo = vtr(cur + vboff + (32 * t + 16 * s2) * DV_STR + db * 64), hi = vtr(cur + vboff + (32 * t + 16 * s2 + 8) * DV_STR + db * 64);
                            const bf16x8 vf = __builtin_shufflevector(lo, hi, 0, 1, 2, 3, 4, 5, 6, 7);
                            O[m][db] = MFMA32(vf, pk[t][s2], O[m][db]); }
                __builtin_amdgcn_sched_barrier(0);
            }
        }
        if (kt + 1 < nsteps) { *(LAS u32x4*)(nxt + skey * DK_STR + sch * 16) = kr; *(LAS u32x4*)(nxt + 64 * DK_STR + skey * DV_STR + sch * 16) = vr; }
        __syncthreads();
    }
    const float l0 = lsum[0] + xshfl<32>(lsum[0]), l1 = lsum[1] + xshfl<32>(lsum[1]);
    const float i0 = 1.f / fmaxf(l0, 1e-30f), i1 = lam / fmaxf(l1, 1e-30f);
    float ss = 0.f;
#pragma unroll
    for (int db = 0; db < 2; ++db)
#pragma unroll
        for (int i = 0; i < 16; ++i) { const float at = O[0][db][i] * i0 - O[1][db][i] * i1; O[0][db][i] = at; ss += at * at; }
    ss += xshfl<32>(ss);
    const float r = (1.f - lam_init) / sqrtf(ss * (1.f / 64.f) + 1e-5f);
    GAS bf16* op = ys + (rowb + q) * 1024 + 512 + h * 64;
#pragma unroll
    for (int db = 0; db < 2; ++db)
#pragma unroll
        for (int gq = 0; gq < 4; ++gq) { const int d0 = 32 * db + 8 * gq + 4 * hh; const f32x4 sg = *(const GAS f32x4*)(subg + d0);
            u32x2 w; w.x = cvtpk(O[0][db][4 * gq + 0] * r * sg[0], O[0][db][4 * gq + 1] * r * sg[1]); w.y = cvtpk(O[0][db][4 * gq + 2] * r * sg[2], O[0][db][4 * gq + 3] * r * sg[3]);
            *(GAS u32x2*)(op + d0) = w; }
}

DI void cmp_task(const KA& a, int l, const bf16* proj, bf16* kcb, int task, int lane) {
    const int kv = task / (BATCH * NCMP), r = task % (BATCH * NCMP), b = r / NCMP, c = r % NCMP;
    const float* pos = a.in[kv ? 21 : 18] + (size_t)l * 2048; const float* w1 = a.in[kv ? 22 : 19] + (size_t)l * 2048 * 64; const float* w2 = a.in[kv ? 23 : 20] + (size_t)l * 4096;
    const size_t tokb = (size_t)b * SEQ + 16 * c; const int col0 = kv ? C_VC : C_KC;
    float h1 = 0.f;
    for (int li = 0; li < 32; ++li) { const float v = bf2f(proj[(tokb + li) * PLD + col0 + lane]) + pos[li * 64 + lane]; const float* wr = w1 + (size_t)(li * 64) * 64 + lane;
#pragma unroll
        for (int d = 0; d < 64; ++d) h1 += rl(v, d) * wr[d * 64]; }
    const float g = gelu_tanh(h1); float o = 0.f;
#pragma unroll
    for (int j = 0; j < 64; ++j) o += rl(g, j) * w2[j * 64 + lane];
    kcb[((size_t)(kv * BATCH + b) * 512 + c) * 64 + lane] = (bf16)f2bf(o);
    if (c == NCMP - 1) kcb[((size_t)(kv * BATCH + b) * 512 + NCMP) * 64 + lane] = 0;
}


DI void st_load(const GAS unsigned char* kb, const GAS unsigned char* vb, unsigned off, u32x4& kr, u32x4& vr) { kr = *(const GAS u32x4*)(kb + off); vr = *(const GAS u32x4*)(vb + off); }
DI void st_write(LAS unsigned char* buf, int skey, int sch, const u32x4& kr, const u32x4& vr) { *(LAS u32x4*)(buf + skey * DK_STR + sch * 16) = kr; *(LAS u32x4*)(buf + 64 * DK_STR + skey * DV_STR + sch * 16) = vr; }
DI void qk64(const LAS unsigned char* cur, int kboff, const bf16x8 (&qf)[4], const f32x16& cinit, f32x16 (&S)[2]) {
#pragma unroll
    for (int t = 0; t < 2; ++t) { S[t] = cinit;
#pragma unroll
        for (int s = 0; s < 4; ++s) { const bf16x8 kf = *(const LAS bf16x8*)(cur + kboff + t * 32 * DK_STR + s * 32); S[t] = MFMA32(kf, qf[s], S[t]); } }
}
DI void qk32z(const LAS unsigned char* kt32, const bf16x8 (&qf)[4], f32x16& S) {
#pragma unroll
    for (int s = 0; s < 4; ++s) { const bf16x8 kf = *(const LAS bf16x8*)(kt32 + s * 32);
        if (s == 0) { f32x16 z;
#pragma unroll
            for (int i = 0; i < 16; ++i) z[i] = 0.f;
            S = MFMA32(kf, qf[s], z); } else S = MFMA32(kf, qf[s], S); }
}
DI void pv32(const LAS unsigned char* vt32, const bf16x8 (&pk)[2], f32x16 (&O)[2]) {
#pragma unroll
    for (int s2 = 0; s2 < 2; ++s2)
#pragma unroll
        for (int db = 0; db < 2; ++db) {
            const s16x4 lo = vtr(vt32 + (16 * s2) * DV_STR + db * 64), hi = vtr(vt32 + (16 * s2 + 8) * DV_STR + db * 64);
            const bf16x8 vf = __builtin_shufflevector(lo, hi, 0, 1, 2, 3, 4, 5, 6, 7);
            O[db] = MFMA32(vf, pk[s2], O[db]); }
}
DI void mask_bias_cmp32(f32x16& S, int tcol, int cbase, int hh, const LAS float* b2h, float msub) {
#pragma unroll
    for (int i = 0; i < 16; ++i) { const int c = cbase + crow(i, hh); const int dist = tcol - 31 - 16 * c; const bool ok = dist >= 0 && c < NCMP;
        const int di = dist < 0 ? 0 : (dist < 128 ? dist : 128); S[i] = ok ? S[i] + (b2h[di * 12] - msub) : -1e30f; }
}
DI void pv64(const LAS unsigned char* cur, int vboff, const bf16x8 (&pk)[2][2], f32x16 (&O)[2]) {
#pragma unroll
    for (int t = 0; t < 2; ++t)
#pragma unroll
        for (int s2 = 0; s2 < 2; ++s2)
#pragma unroll
            for (int db = 0; db < 2; ++db) {
                const s16x4 lo = vtr(cur + vboff + (32 * t + 16 * s2) * DV_STR + db * 64), hi = vtr(cur + vboff + (32 * t + 16 * s2 + 8) * DV_STR + db * 64);
                const bf16x8 vf = __builtin_shufflevector(lo, hi, 0, 1, 2, 3, 4, 5, 6, 7);
                O[db] = MFMA32(vf, pk[t][s2], O[db]); }
}
DI void softmax_step(f32x16 (&S)[2], f32x16 (&O)[2], f32x16& negm, float& lsum, bf16x8 (&pk)[2][2]) {
    float tm = fmaxf(max16(S[0]), max16(S[1]));
    if (__builtin_amdgcn_ballot_w64(tm > 8.f) != 0ull) {
        tm = fmaxf(tm, xshfl<32>(tm)); const float sh = fmaxf(tm, 0.f); const float al = __builtin_amdgcn_exp2f(-sh);
        lsum *= al;
#pragma unroll
        for (int i = 0; i < 16; ++i) { O[0][i] *= al; O[1][i] *= al; negm[i] -= sh; S[0][i] -= sh; S[1][i] -= sh; } }
#pragma unroll
    for (int t = 0; t < 2; ++t) {
#pragma unroll
        for (int i = 0; i < 16; ++i) { const float p = __builtin_amdgcn_exp2f(S[t][i]); S[t][i] = p; lsum += p; }
        pk[t][0] = pack_half(S[t], 0); pk[t][1] = pack_half(S[t], 1); }
}
DI void mask_bias(f32x16 (&S)[2], int tcol, int kbase, int hh, int W, bool colsel, const LAS float* b2h) {
#pragma unroll
    for (int t = 0; t < 2; ++t)
#pragma unroll
        for (int i = 0; i < 16; ++i) { const int dist = tcol - (kbase + 32 * t + crow(i, hh)); const bool ok = colsel && dist >= 0 && dist < W;
            const int di = dist < 0 ? 0 : (dist < 128 ? dist : 128); S[t][i] = ok ? S[t][i] + b2h[di * 12] : -1e30f; }
}
DI void nsa_unit(const GAS bf16* proj, GAS bf16* ys, const GAS bf16* kcb, LAS unsigned char* lds, const LAS float* bias2, int b, int u, int tid_in, int lane_in, int wave_in) {
    int tid = tid_in, lane = lane_in, wave = wave_in; asm volatile("" : "+v"(tid), "+v"(lane), "+s"(wave));
    const int t0 = u * 64; const int col = lane & 31, hh = lane >> 5, tl = col >> 2, head = col & 3;
    const int t = t0 + wave * 8 + tl; const int tw0 = t0 + wave * 8;
    const size_t rowb = (size_t)b * SEQ;
    const LAS float* b2h = bias2 + 8 + head;
    bf16x8 qf[4];
    { const float SC = 0.125f * 1.4426950408889634f; const GAS bf16* qp = proj + (rowb + t) * PLD + C_DQ + head * 64 + hh * 8;
#pragma unroll
      for (int s = 0; s < 4; ++s) { const u32x4 w = *(const GAS u32x4*)(qp + s * 16); u32x4 o;
          o.x = cvtpk(lo_bf(w.x) * SC, hi_bf(w.x) * SC); o.y = cvtpk(lo_bf(w.y) * SC, hi_bf(w.y) * SC); o.z = cvtpk(lo_bf(w.z) * SC, hi_bf(w.z) * SC); o.w = cvtpk(lo_bf(w.w) * SC, hi_bf(w.w) * SC);
          qf[s] = __builtin_bit_cast(bf16x8, o); } }
    const int skey = tid >> 3, sch = tid & 7;
    const int i16 = lane & 15, blk = (lane >> 4) & 1;
    const int kboff = col * DK_STR + hh * 16;
    const int vboff = 64 * DK_STR + (4 * hh + (i16 >> 2)) * DV_STR + (16 * blk + 4 * (i16 & 3)) * 2;
    u32x4 kr, vr;
    const int ncvm = (4 * u + 3) < NCMP ? (4 * u + 3) : NCMP;
    const int nsc = (ncvm + 63) >> 6;
    const GAS unsigned char* kcp = (const GAS unsigned char*)(kcb + (size_t)(0 * BATCH + b) * 512 * 64);
    const GAS unsigned char* vcp = (const GAS unsigned char*)(kcb + (size_t)(1 * BATCH + b) * 512 * 64);
    const unsigned soffc = (unsigned)(skey * 64 + sch * 8) * 2u;
    float m1 = -120.f, l1 = 0.f;
    st_load(kcp, vcp, soffc, kr, vr); st_write(lds, skey, sch, kr, vr); __syncthreads();
#pragma unroll 1
    for (int kt = 0; kt < nsc; ++kt) {
        const LAS unsigned char* cur = lds + (kt & 1) * DBUF_BYTES; LAS unsigned char* nxt = lds + ((kt + 1) & 1) * DBUF_BYTES;
        if (kt + 1 < nsc) st_load(kcp, vcp, soffc + (unsigned)(kt + 1) * 8192u, kr, vr);
#pragma unroll
        for (int tt = 0; tt < 2; ++tt) { f32x16 S; qk32z(cur + kboff + tt * 32 * DK_STR, qf, S); mask_bias_cmp32(S, t, kt * 64 + tt * 32, hh, b2h, 0.f);
          const float tm = max16(S); const float mn = fmaxf(m1, tm); float acc = 0.f;
#pragma unroll
          for (int i = 0; i < 16; ++i) acc += __builtin_amdgcn_exp2f(S[i] - mn);
          l1 = l1 * __builtin_amdgcn_exp2f(m1 - mn) + acc; m1 = mn; }
        if (kt + 1 < nsc) st_write(nxt, skey, sch, kr, vr);
        __syncthreads();
    }
    float mf, inv;
    { const float mo = xshfl<32>(m1), lo = xshfl<32>(l1); mf = fmaxf(m1, mo); const float lf = l1 * __builtin_amdgcn_exp2f(m1 - mf) + lo * __builtin_amdgcn_exp2f(mo - mf); inv = lf > 0.f ? 1.f / lf : 0.f; }
    f32x16 Oc[2], imp[4];
#pragma unroll
    for (int i = 0; i < 16; ++i) { Oc[0][i] = 0.f; Oc[1][i] = 0.f; imp[0][i] = 0.f; imp[1][i] = 0.f; imp[2][i] = 0.f; imp[3][i] = 0.f; }
    {   st_load(kcp, vcp, soffc, kr, vr); st_write(lds, skey, sch, kr, vr); __syncthreads();
#pragma unroll 1
        for (int kt = 0; kt < nsc; ++kt) {
            const LAS unsigned char* cur = lds + (kt & 1) * DBUF_BYTES; LAS unsigned char* nxt = lds + ((kt + 1) & 1) * DBUF_BYTES;
            if (kt + 1 < nsc) st_load(kcp, vcp, soffc + (unsigned)(kt + 1) * 8192u, kr, vr);
#pragma unroll
            for (int tt = 0; tt < 2; ++tt) {
                f32x16 S; qk32z(cur + kboff + tt * 32 * DK_STR, qf, S); mask_bias_cmp32(S, t, kt * 64 + tt * 32, hh, b2h, mf);
#pragma unroll
                for (int i = 0; i < 16; ++i) S[i] = __builtin_amdgcn_exp2f(S[i]) * inv;
                bf16x8 pk[2]; pk[0] = pack_half(S, 0); pk[1] = pack_half(S, 1);
                pv32(cur + vboff + tt * 32 * DV_STR, pk, Oc);
                const int Tq = (2 * kt + tt) & 3, MB = (2 * kt + tt) >> 2;
#pragma unroll
                for (int s2 = 0; s2 < 2; ++s2) { u32x4 aw; unsigned e[8];
#pragma unroll
                    for (int jj = 0; jj < 8; ++jj) { const int kk = 16 * s2 + 8 * (jj >> 2) + 4 * hh + (jj & 3); const int delta = 32 * Tq + kk - 4 * col;
                        e[jj] = (delta == -1 || delta == 3) ? 0x3F80u : ((unsigned)delta <= 2u ? 0x4000u : 0u); }
                    aw.x = e[0] | (e[1] << 16); aw.y = e[2] | (e[3] << 16); aw.z = e[4] | (e[5] << 16); aw.w = e[6] | (e[7] << 16);
                    const bf16x8 af = __builtin_bit_cast(bf16x8, aw);
                    if (MB == 0) imp[0] = MFMA32(af, pk[s2], imp[0]); else if (MB == 1) imp[1] = MFMA32(af, pk[s2], imp[1]); else if (MB == 2) imp[2] = MFMA32(af, pk[s2], imp[2]); else imp[3] = MFMA32(af, pk[s2], imp[3]); }
                if (Tq == 3 && MB < 3) { u32x4 aw; aw.x = 0u; aw.y = 0u; aw.z = 0u; aw.w = (lane == 32) ? 0x3F800000u : 0u;
                    const bf16x8 af = __builtin_bit_cast(bf16x8, aw);
                    if (MB == 0) imp[1] = MFMA32(af, pk[1], imp[1]); else if (MB == 1) imp[2] = MFMA32(af, pk[1], imp[2]); else imp[3] = MFMA32(af, pk[1], imp[3]); }
            }
            if (kt + 1 < nsc) st_write(nxt, skey, sch, kr, vr);
            __syncthreads();
        }
    }
    unsigned ocp[2][8];
#pragma unroll
    for (int db = 0; db < 2; ++db)
#pragma unroll
        for (int i = 0; i < 8; ++i) ocp[db][i] = cvtpk(Oc[db][2 * i], Oc[db][2 * i + 1]);
    unsigned sm0 = 0u, sm1 = 0u, sm2 = 0u, sm3 = 0u;
    {   const int cur_t = t >> 6; unsigned key[16];
#pragma unroll
        for (int i = 0; i < 16; ++i) {
            float v0 = imp[0][i], v1 = imp[1][i], v2 = imp[2][i], v3 = imp[3][i];
            v0 += xshfl<1>(v0); v0 += xshfl<2>(v0); v1 += xshfl<1>(v1); v1 += xshfl<2>(v1); v2 += xshfl<1>(v2); v2 += xshfl<2>(v2); v3 += xshfl<1>(v3); v3 += xshfl<2>(v3);
            const float val = head == 0 ? v0 : (head == 1 ? v1 : (head == 2 ? v2 : v3));
            const int j = 32 * head + crow(i, hh);
            const bool forced = (j == 0) || (j == cur_t) || (j == cur_t - 1);
            unsigned fx = (unsigned)(fminf(fmaxf(val, 0.f), 31.f) * 1048576.f) + 1u;
            fx = forced ? 0x1FFFFFFu : (j <= cur_t ? fx : 0u);
            key[i] = (fx << 7) | (unsigned)(127 - j); }
#pragma unroll 1
        for (int r = 0; r < 16; ++r) {
            unsigned w = key[0];
#pragma unroll
            for (int i = 1; i < 16; ++i) w = w > key[i] ? w : key[i];
            { unsigned o = (unsigned)xshfl_i<1>((int)w); w = w > o ? w : o; o = (unsigned)xshfl_i<2>((int)w); w = w > o ? w : o; o = (unsigned)xshfl_i<32>((int)w); w = w > o ? w : o; }
            if ((w >> 7) != 0u) { const int j = 127 - (int)(w & 127u); const unsigned bit = 1u << (j & 31); const int jb = j >> 5;
                sm0 |= (jb == 0) ? bit : 0u; sm1 |= (jb == 1) ? bit : 0u; sm2 |= (jb == 2) ? bit : 0u; sm3 |= (jb == 3) ? bit : 0u; }
#pragma unroll
            for (int i = 0; i < 16; ++i) key[i] = (key[i] == w) ? 0u : key[i];
        }
    }
    f32x16 Ow[2]; float lw = 0.f;
#pragma unroll
    for (int i = 0; i < 16; ++i) { Ow[0][i] = 0.f; Ow[1][i] = 0.f; }
    {   f32x16 negm;
#pragma unroll
        for (int i = 0; i < 16; ++i) negm[i] = 120.f;
        const GAS unsigned char* kwp = (const GAS unsigned char*)(proj + rowb * PLD + C_KW); const GAS unsigned char* vwp = (const GAS unsigned char*)(proj + rowb * PLD + C_VW);
        const unsigned soffp = (unsigned)(skey * PLD + sch * 8) * 2u;
        const int s0 = (u < 8) ? 8 - u : 0;
        st_load(kwp, vwp, soffp + (unsigned)(u - 8 + s0) * (64u * PLD * 2u), kr, vr); st_write(lds, skey, sch, kr, vr); __syncthreads();
#pragma unroll 1
        for (int s = s0; s < 9; ++s) {
            const int par = (s - s0) & 1; const LAS unsigned char* cur = lds + par * DBUF_BYTES; LAS unsigned char* nxt = lds + (par ^ 1) * DBUF_BYTES;
            if (s + 1 < 9) st_load(kwp, vwp, soffp + (unsigned)(u - 8 + s + 1) * (64u * PLD * 2u), kr, vr);
            {   f32x16 S[2]; qk64(cur, kboff, qf, negm, S);
                if (s == 0 || s >= 6) mask_bias(S, t, (u - 8 + s) * 64, hh, 512, true, b2h);
                bf16x8 pk[2][2]; softmax_step(S, Ow, negm, lw, pk); pv64(cur, vboff, pk, Ow); }
            if (s + 1 < 9) st_write(nxt, skey, sch, kr, vr);
            __syncthreads();
        }
    }
    unsigned owp[2][8];
#pragma unroll
    for (int db = 0; db < 2; ++db)
#pragma unroll
        for (int i = 0; i < 8; ++i) owp[db][i] = cvtpk(Ow[db][2 * i], Ow[db][2 * i + 1]);
    f32x16 Os[2]; float lsel = 0.f;
#pragma unroll
    for (int i = 0; i < 16; ++i) { Os[0][i] = 0.f; Os[1][i] = 0.f; }
    {   f32x16 negm;
#pragma unroll
        for (int i = 0; i < 16; ++i) negm[i] = 120.f;
        const GAS unsigned char* ksp = (const GAS unsigned char*)(proj + rowb * PLD + C_KS); const GAS unsigned char* vsp = (const GAS unsigned char*)(proj + rowb * PLD + C_VS);
        const unsigned soffp = (unsigned)(skey * PLD + sch * 8) * 2u;
        st_load(ksp, vsp, soffp, kr, vr); st_write(lds, skey, sch, kr, vr); __syncthreads();
#pragma unroll 1
        for (int j = 0; j <= u; ++j) {
            const LAS unsigned char* cur = lds + (j & 1) * DBUF_BYTES; LAS unsigned char* nxt = lds + ((j + 1) & 1) * DBUF_BYTES;
            if (j + 1 <= u) st_load(ksp, vsp, soffp + (unsigned)(j + 1) * (64u * PLD * 2u), kr, vr);
            const int jb = j >> 5; const unsigned smw = jb == 0 ? sm0 : (jb == 1 ? sm1 : (jb == 2 ? sm2 : sm3));
            const bool bit = ((smw >> (j & 31)) & 1u) != 0u;
            if (__builtin_amdgcn_ballot_w64(bit) != 0ull) {
                f32x16 S[2]; qk64(cur, kboff, qf, negm, S);
                if (64 * j + 63 > tw0 - 113) mask_bias(S, t, 64 * j, hh, 1 << 30, bit, b2h);
                else if (!bit) {
#pragma unroll
                    for (int i = 0; i < 16; ++i) { S[0][i] = -1e30f; S[1][i] = -1e30f; } }
                bf16x8 pk[2][2]; softmax_step(S, Os, negm, lsel, pk); pv64(cur, vboff, pk, Os); }
            if (j + 1 <= u) st_write(nxt, skey, sch, kr, vr);
            __syncthreads();
        }
    }
    {   const float lwt = lw + xshfl<32>(lw), lst = lsel + xshfl<32>(lsel);
        const GAS bf16* gp = proj + (rowb + t) * PLD + C_DG + head * 3;
        const float g0 = sigmoidf_(bf2f(gp[0])), g1 = sigmoidf_(bf2f(gp[1])) / fmaxf(lst, 1e-30f), g2 = sigmoidf_(bf2f(gp[2])) / fmaxf(lwt, 1e-30f);
        GAS bf16* op = ys + (rowb + t) * 1024 + 768 + head * 64;
#pragma unroll
        for (int db = 0; db < 2; ++db)
#pragma unroll
            for (int gq = 0; gq < 4; ++gq) { const int d0 = 32 * db + 8 * gq + 4 * hh; float y[4];
#pragma unroll
                for (int e = 0; e < 4; ++e) { const unsigned cw = ocp[db][2 * gq + (e >> 1)], ww = owp[db][2 * gq + (e >> 1)];
                    y[e] = g0 * ((e & 1) ? hi_bf(cw) : lo_bf(cw)) + g1 * Os[db][4 * gq + e] + g2 * ((e & 1) ? hi_bf(ww) : lo_bf(ww)); }
                u32x2 w; w.x = cvtpk(y[0], y[1]); w.y = cvtpk(y[2], y[3]); *(GAS u32x2*)(op + d0) = w; }
    }
}


DI void swa_unit(const GAS bf16* proj, GAS bf16* ys, LAS unsigned char* lds, const LAS float* bias2, const LAS float* biasd, const GAS float* sinks, int b, int u, int tid_in, int lane_in, int wave_in) {
    int tid = tid_in, lane = lane_in, wave = wave_in; asm volatile("" : "+v"(tid), "+v"(lane), "+s"(wave));
    const int t0 = u * 64; const int col = lane & 31, hh = lane >> 5, tl = col >> 1, kv = wave & 1, head = 2 * kv + (col & 1);
    const int t = t0 + (wave >> 1) * 16 + tl;
    const size_t rowb = (size_t)b * SEQ;
    const LAS float* b2h = bias2 + head;
    bf16x8 qf[4];
    { const float SC = 0.125f * 1.4426950408889634f; const GAS bf16* qp = proj + (rowb + t) * PLD + C_BQ + head * 64 + hh * 8;
#pragma unroll
      for (int s = 0; s < 4; ++s) { const u32x4 w = *(const GAS u32x4*)(qp + s * 16); u32x4 o;
          o.x = cvtpk(lo_bf(w.x) * SC, hi_bf(w.x) * SC); o.y = cvtpk(lo_bf(w.y) * SC, hi_bf(w.y) * SC); o.z = cvtpk(lo_bf(w.z) * SC, hi_bf(w.z) * SC); o.w = cvtpk(lo_bf(w.w) * SC, hi_bf(w.w) * SC);
          qf[s] = __builtin_bit_cast(bf16x8, o); } }
    const int skey = tid >> 3, sch = tid & 7;
    const int i16 = lane & 15, blk = (lane >> 4) & 1;
    const int kboff = kv * DBUF_BYTES + col * DK_STR + hh * 16;
    const int vboff = kv * DBUF_BYTES + 64 * DK_STR + (4 * hh + (i16 >> 2)) * DV_STR + (16 * blk + 4 * (i16 & 3)) * 2;
    const GAS unsigned char* kp = (const GAS unsigned char*)(proj + rowb * PLD + C_BK); const GAS unsigned char* vp = (const GAS unsigned char*)(proj + rowb * PLD + C_BV);
    const unsigned soffp = (unsigned)(skey * PLD + sch * 8) * 2u;
    u32x4 k0, v0, k1, v1;
    f32x16 O[2], negm; float lsum = 0.f;
#pragma unroll
    for (int i = 0; i < 16; ++i) { O[0][i] = 0.f; O[1][i] = 0.f; negm[i] = 120.f; }
    const int s0 = (u < 2) ? 2 - u : 0;
    { const unsigned so = soffp + (unsigned)(u - 2 + s0) * (64u * PLD * 2u); st_load(kp, vp, so, k0, v0); st_load(kp + 128, vp + 128, so, k1, v1);
      st_write(lds, skey, sch, k0, v0); st_write(lds + DBUF_BYTES, skey, sch, k1, v1); }
    __syncthreads();
#pragma unroll 1
    for (int s = s0; s < 3; ++s) {
        const int par = (s - s0) & 1; const LAS unsigned char* cur = lds + par * 2 * DBUF_BYTES; LAS unsigned char* nxt = lds + (par ^ 1) * 2 * DBUF_BYTES;
        if (s + 1 < 3) { const unsigned so = soffp + (unsigned)(u - 2 + s + 1) * (64u * PLD * 2u); st_load(kp, vp, so, k0, v0); st_load(kp + 128, vp + 128, so, k1, v1); }
        {   f32x16 S[2]; qk64(cur, kboff, qf, negm, S);
            mask_bias(S, t, (u - 2 + s) * 64, hh, 128, true, b2h);
            bf16x8 pk[2][2]; softmax_step(S, O, negm, lsum, pk); pv64(cur, vboff, pk, O); }
        if (s + 1 < 3) { st_write(nxt, skey, sch, k0, v0); st_write(nxt + DBUF_BYTES, skey, sch, k1, v1); }
        __syncthreads();
    }
    {   const float sinkp = (sinks[head] - biasd[128 * 12 + head]) * 1.4426950408889634f;
        const float lt = lsum + xshfl<32>(lsum) + __builtin_amdgcn_exp2f(sinkp + negm[0]);
        const float inv = 1.f / fmaxf(lt, 1e-30f);
        GAS bf16* op = ys + (rowb + t) * 1024 + 256 + head * 64;
#pragma unroll
        for (int db = 0; db < 2; ++db)
#pragma unroll
            for (int gq = 0; gq < 4; ++gq) { const int d0 = 32 * db + 8 * gq + 4 * hh;
                u32x2 w; w.x = cvtpk(O[db][4 * gq + 0] * inv, O[db][4 * gq + 1] * inv); w.y = cvtpk(O[db][4 * gq + 2] * inv, O[db][4 * gq + 3] * inv); *(GAS u32x2*)(op + d0) = w; }
    }
}

DI void route_token(const KA& a, int l, bf16* x2b, int* rec_e, int* rec_slot, float* rec_w, unsigned* cnt, int tok, int lane_) {
    int lane = lane_; asm volatile("" : "+v"(lane));
    const float* xr = a.out + (size_t)tok * 1024; const float* g = a.in[28] + (size_t)l * 1024;
    float ss = 0.f;
#pragma unroll
    for (int j = 0; j < 4; ++j) { const f32x4 v = *(const f32x4*)(xr + 4 * (lane + 64 * j)); ss += (v[0] * v[0] + v[1] * v[1]) + (v[2] * v[2] + v[3] * v[3]); }
    const float r = 1.f / sqrtf(wave_sum(ss) * (1.f / 1024.f) + 1e-6f);
    const float* wg = a.in[29] + (size_t)l * 1024 * 4; const float* we = a.in[31] + (size_t)l * 1024 * 32;
    float lg[36];
#pragma unroll
    for (int i = 0; i < 36; ++i) lg[i] = 0.f;
#pragma unroll 1
    for (int j = 0; j < 4; ++j) { const int k0 = 4 * (lane + 64 * j);
        const f32x4 v = *(const f32x4*)(xr + k0); const f32x4 gv = *(const f32x4*)(g + k0); const f32x4 xn = v * r * gv;
        u32x2 w; w.x = pk2(xn[0], xn[1]); w.y = pk2(xn[2], xn[3]); *(u32x2*)(x2b + (size_t)tok * 1024 + k0) = w;
#pragma unroll
        for (int e = 0; e < 4; ++e) { const int k = k0 + e; const float xk = xn[e];
            const f32x4 g4 = *(const f32x4*)(wg + (size_t)k * 4);
            lg[0] += xk * g4[0]; lg[1] += xk * g4[1]; lg[2] += xk * g4[2]; lg[3] += xk * g4[3];
#pragma unroll
            for (int q = 0; q < 8; ++q) { const f32x4 e4 = *(const f32x4*)(we + (size_t)k * 32 + q * 4);
                lg[4 + q * 4 + 0] += xk * e4[0]; lg[4 + q * 4 + 1] += xk * e4[1]; lg[4 + q * 4 + 2] += xk * e4[2]; lg[4 + q * 4 + 3] += xk * e4[3]; }
            __builtin_amdgcn_sched_barrier(0); } }
#pragma unroll
    for (int i = 0; i < 36; ++i) lg[i] = wave_sum(lg[i]);
    const float* bg = a.in[30] + l * 4; const float* be = a.in[32] + l * 32;
#pragma unroll
    for (int i = 0; i < 4; ++i) lg[i] += bg[i];
#pragma unroll
    for (int i = 0; i < 32; ++i) lg[4 + i] += be[i];
    int gsel = 0; float gm = lg[0];
#pragma unroll
    for (int i = 1; i < 4; ++i) if (lg[i] > gm) { gm = lg[i]; gsel = i; }
    float gs = 0.f;
#pragma unroll
    for (int i = 0; i < 4; ++i) gs += __expf(lg[i] - gm);
    const float gwt = 1.f / gs;
    float v8[8];
#pragma unroll
    for (int i = 0; i < 8; ++i) { float x = lg[4 + i];
#pragma unroll
        for (int gq = 1; gq < 4; ++gq) x = (gsel == gq) ? lg[4 + gq * 8 + i] : x;
        v8[i] = x; }
    int i0 = 0; float m0 = v8[0];
#pragma unroll
    for (int i = 1; i < 8; ++i) if (v8[i] > m0) { m0 = v8[i]; i0 = i; }
    int i1 = -1; float m1 = -3e38f;
#pragma unroll
    for (int i = 0; i < 8; ++i) if (i != i0 && v8[i] > m1) { m1 = v8[i]; i1 = i; }
    const float w0 = 1.f / (1.f + __expf(m1 - m0)); const float w1 = 1.f - w0;
    if (lane == 0) {
        const int e0 = gsel * 8 + i0, e1 = gsel * 8 + i1;
        const unsigned s0 = __hip_atomic_fetch_add(cnt + e0, 1u, __ATOMIC_RELAXED, __HIP_MEMORY_SCOPE_AGENT);
        const unsigned s1 = __hip_atomic_fetch_add(cnt + e1, 1u, __ATOMIC_RELAXED, __HIP_MEMORY_SCOPE_AGENT);
        rec_e[tok * 2] = e0; rec_e[tok * 2 + 1] = e1; rec_slot[tok * 2] = (int)s0; rec_slot[tok * 2 + 1] = (int)s1; rec_w[tok * 2] = w0 * gwt; rec_w[tok * 2 + 1] = w1 * gwt;
    }
}
DI void expert_weights(const KA& a, int l, LAS unsigned char* lds, int gw, int NGW, int wave, int lane) {
    LAS float* scr = (LAS float*)(lds + wave * 16384);
    const float* wgt = a.in[33] + (size_t)l * 32 * 1024 * 256; const float* wup = a.in[34] + (size_t)l * 32 * 1024 * 256; const float* wdn = a.in[35] + (size_t)l * 32 * 256 * 1024;
    bf16* Wgu = (bf16*)(a.ws + WS_WGU); bf16* Wd = (bf16*)(a.ws + WS_WD);
    constexpr int I_E = 16 * 8, I_D = 4 * 32;
    constexpr int NIT = 32 * (2 * I_E + I_D);
    for (int it = gw; it < NIT; it += NGW) {
        const int e = it / (2 * I_E + I_D); int r = it % (2 * I_E + I_D);
        if (r < 2 * I_E) { const int up = r / I_E, q = r % I_E, kb = q / 8, nb = q % 8; const int n0 = nb * 32;
            const int drow = (n0 >> 7) * 256 + up * 128 + (n0 & 127);
            transpose_item((up ? wup : wgt) + (size_t)e * 1024 * 256, 256, 256, Wgu + (size_t)e * 512 * 1024, 1024, kb * 64, n0, drow, scr, lane);
        } else { r -= 2 * I_E; const int kb = r / 32, nb = r % 32;
            transpose_item(wdn + (size_t)e * 256 * 1024, 1024, 1024, Wd + (size_t)e * 1024 * 256, 256, kb * 64, nb * 32, nb * 32, scr, lane); }
    }
}
DI void build_offsets(const unsigned* cnt, LAS int* offt, int tid) {
    if (tid == 0) { int o = 0; for (int e = 0; e < 32; ++e) { offt[e] = o; const int c = (int)__hip_atomic_load(cnt + e, __ATOMIC_RELAXED, __HIP_MEMORY_SCOPE_AGENT); o += (c + 255) & ~255; } offt[32] = o; }
    __syncthreads();
    for (int rt = tid; rt < (MOE_ROWS >> 8); rt += 512) { int e = 0; for (int j = 1; j < 32; ++j) e += (offt[j] <= rt * 256) ? 1 : 0; offt[40 + rt] = e; }
    __syncthreads();
}

template <unsigned PM>
__global__ void __launch_bounds__(512, 2) mk_fwd(Args a_) {
    extern __shared__ __attribute__((aligned(16))) unsigned char lds_raw[];
    LAS unsigned char* lds = (LAS unsigned char*)lds_raw;
    const int wave0 = __builtin_amdgcn_readfirstlane((int)threadIdx.x >> 6);
    if (threadIdx.x < 36) ((LAS unsigned long long*)(lds + PTAB_OFF))[threadIdx.x] = (unsigned long long)a_.in[threadIdx.x];
    __syncthreads();
    KA a; a.in.base = (unsigned)(size_t)(lds + PTAB_OFF); a.out = a_.out; a.ws = a_.ws;
    const int G = gridDim.x, bid = blockIdx.x, NGW = G * 8;
#define PHASE_IDS() int wave = wave0; asm volatile("" : "+s"(wave)); const int lane = my_lane(); const int tid_ = wave * 64 + lane, gw = bid * 8 + wave; (void)tid_; (void)gw; \
    KA ap = a; asm volatile("" : "+s"(ap.ws), "+s"(ap.out), "+s"(ap.in.base)); \
    bf16* hb = (bf16*)(ap.ws + WS_HB); bf16* proj = (bf16*)(ap.ws + WS_PROJ); bf16* gates = (bf16*)(ap.ws + WS_GATES); \
    bf16* ys = hb; bf16* x2b = hb; bf16* merged = proj; bf16* eo = proj; \
    bf16* kcb = (bf16*)(ap.ws + WS_KCVC); float* lrusum = (float*)(ap.ws + WS_LRUSUM); \
    int* rec_e = (int*)(ap.ws + WS_REC); int* rec_slot = rec_e + T * 2; float* rec_w = (float*)(rec_slot + T * 2); \
    int* rowtok = (int*)(ap.ws + WS_ROWTOK); float* roww = (float*)(ap.ws + WS_ROWW); \
    bf16* xs = (bf16*)(ap.ws + WS_XS); bf16* hmid = (bf16*)(ap.ws + WS_HMID); unsigned* ctl = (unsigned*)(ap.ws + WS_CTL); \
    (void)hb; (void)proj; (void)gates; (void)ys; (void)x2b; (void)merged; (void)eo; (void)kcb; (void)lrusum; (void)rec_e; (void)rec_slot; (void)rec_w; (void)rowtok; (void)roww; (void)xs; (void)hmid; (void)ctl
    volatile LAS unsigned* MISC = (volatile LAS unsigned*)(lds + MISC_OFF);
    LAS float* biasd = (LAS float*)(lds + BIAS_OFF);
    LAS int* offt = (LAS int*)(lds + OFFT_OFF);
    { PHASE_IDS();
    if (tid_ < 64) MISC[tid_] = 0u;
    for (int i = tid_; i < 129 * 12; i += 512) { const int d = i / 12, hd = i % 12; const int bk = d < 128 ? T5_BUCKET[d] : 31; const float* rb = a.in[1]; biasd[i] = rb[bk * 12 + hd]; ((LAS float*)(lds + BIAS2_OFF))[i] = (rb[bk * 12 + hd] - rb[31 * 12 + hd]) * 1.4426950408889634f; } }
    __syncthreads();
    const int lo = a_.ph_lo, hi = a_.ph_hi;
    XcdBarrier bar; bar.bar = (unsigned*)(a.ws + WS_CTL) + CW_BAR; bar.x = 0; bar.st = nullptr;
    if (hi - lo > 1) { PHASE_IDS(); bar = xcd_barrier_post(ctl + CW_BAR, MISC + 8, tid_ == 0); }
#ifndef SUB_MASK
#define SUB_MASK 0xFFu
#endif
#define SUB(k) ((SUB_MASK >> (k)) & 1u)
#define HASP(k) ((PM >> ((k) % 10 + ((k) >= 20 ? 10 : 0))) & 1u)
#define IN(k) (HASP(k) && lo <= (k) && (k) < hi)
#define SEAM(k) do { if ((k) + 1 < hi) { const int sl_ = my_lane(); int sw_ = wave0; asm volatile("" : "+s"(sw_)); xcd_barrier(bar, sw_ == 0 && sl_ == 0); } } while (0)
    for (int l = 0; l < DEPTH; ++l) {
        const int pb = l * 10;
        if (IN(pb + 0)) { PHASE_IDS(); phase0_weights(ap, l, lds, gw, NGW, wave, lane); phase0_rows(ap, l, 0, gw, NGW, lane); SEAM(pb + 0); }
        if (IN(pb + 1)) {
            PHASE_IDS();
            pg8::Gemm g{1024, 1024, 1024}; SchedP1 S{(const char*)hb, (const char*)(ap.ws + WS_WIN), G, bid};
            EpiP1 E{proj, gates, ap.in[25] + (size_t)l * 4096};
            pg8::gemm_phase<EpiP1, SchedP1>(lds, g, S, E, tid_); SEAM(pb + 1);
        }
        if (IN(pb + 2)) {
            PHASE_IDS();
            float s1 = 0.f, s2 = 0.f;
            for (int i = 0; i < 32; ++i) { s1 += ap.in[13][l * 32 + i] * ap.in[14][l * 32 + i]; s2 += ap.in[15][l * 32 + i] * ap.in[16][l * 32 + i]; }
            const float lam_init = 0.8f - 0.6f * __expf(-0.3f * (float)l); const float lam = __expf(s1) - __expf(s2) + lam_init;
            if (SUB(0)) { const LAS float* bias2 = (const LAS float*)(lds + BIAS2_OFF); const GAS float* subg = (const GAS float*)(ap.in[17] + l * 64);
                for (int pi = bid; pi < 256; pi += G) { const int bh = pi >> 4, qlo = pi & 15;
                    diff_unit((const GAS bf16*)proj, (GAS bf16*)ys, lds, bias2, subg, lam, lam_init, bh >> 2, bh & 3, 31 - qlo, tid_, lane, wave);
                    diff_unit((const GAS bf16*)proj, (GAS bf16*)ys, lds, bias2, subg, lam, lam_init, bh >> 2, bh & 3, qlo, tid_, lane, wave); } }
            if (SUB(3)) { __syncthreads(); const LAS float* bias2 = (const LAS float*)(lds + BIAS2_OFF); const GAS float* sinks = (const GAS float*)(ap.in[12] + l * 4);
                for (int pi = bid; pi < 512; pi += G) swa_unit((const GAS bf16*)proj, (GAS bf16*)ys, lds, bias2, biasd, sinks, pi >> 7, pi & 127, tid_, lane, wave); }
            if (SUB(1)) for (int task = gw; task < 512; task += NGW) lru_task(ap, l, proj, ys, lrusum, task, lane, false);
            if (SUB(2)) for (int task = gw; task < 2 * BATCH * NCMP; task += NGW) cmp_task(ap, l, proj, kcb, task, lane);
            SEAM(pb + 2);
        }
        if (IN(pb + 3)) {
            PHASE_IDS();
            if (SUB(1)) for (int task = gw; task < 512; task += NGW) lru_task(ap, l, proj, ys, lrusum, task, lane, true);
            if (SUB(4)) { __syncthreads(); const LAS float* bias2 = (const LAS float*)(lds + BIAS2_OFF);
                for (int pi = bid; pi < 256; pi += G) { const int bb = pi >> 6, ulo = pi & 63;
                    nsa_unit((const GAS bf16*)proj, (GAS bf16*)ys, (const GAS bf16*)kcb, lds, bias2, bb, 127 - ulo, tid_, lane, wave);
                    nsa_unit((const GAS bf16*)proj, (GAS bf16*)ys, (const GAS bf16*)kcb, lds, bias2, bb, ulo, tid_, lane, wave); } }
            SEAM(pb + 3);
        }
        if (IN(pb + 4)) {
            PHASE_IDS();
            pg8::Gemm g{256, 1024, 256}; SchedP3a S{(const char*)ys, (const char*)(ap.ws + WS_WBR), G, bid};
            EpiP3a E{merged, gates};
            pg8::gemm_phase<EpiP3a, SchedP3a>(lds, g, S, E, tid_); SEAM(pb + 4);
        }
        if (IN(pb + 5)) {
            PHASE_IDS();
            pg8::Gemm g{1024, 1024, 1024}; SchedP3b S{(const char*)merged, (const char*)(ap.ws + WS_WOUT), G, bid};
            EpiP3b E{(l == 0) ? ap.in[0] : ap.out, ap.out};
            pg8::gemm_phase<EpiP3b, SchedP3b>(lds, g, S, E, tid_); SEAM(pb + 5);
        }
        if (IN(pb + 6)) {
            PHASE_IDS();
            expert_weights(ap, l, lds, gw, NGW, wave, lane);
            for (int tok = gw; tok < T; tok += NGW) route_token(ap, l, x2b, rec_e, rec_slot, rec_w, ctl + CW_CNT + l * 32, tok, lane);
            SEAM(pb + 6);
        }
        if (IN(pb + 7)) {
            PHASE_IDS();
            build_offsets(ctl + CW_CNT + l * 32, offt, tid_);
            if (bid < 32) { const int e = bid; const int c = (int)__hip_atomic_load(ctl + CW_CNT + l * 32 + e, __ATOMIC_RELAXED, __HIP_MEMORY_SCOPE_AGENT);
                for (int p = offt[e] + c + tid_; p < offt[e + 1]; p += 512) rowtok[p] = -1; }
            for (int tok = gw; tok < T; tok += NGW) {
#pragma unroll
                for (int k = 0; k < 2; ++k) { const int e = rec_e[tok * 2 + k], slot = rec_slot[tok * 2 + k]; const int pos = offt[e] + slot;
                    const u32x4 v0 = *(const u32x4*)(x2b + (size_t)tok * 1024 + lane * 8), v1 = *(const u32x4*)(x2b + (size_t)tok * 1024 + 512 + lane * 8);
                    *(u32x4*)(xs + (size_t)pos * 1024 + lane * 8) = v0; *(u32x4*)(xs + (size_t)pos * 1024 + 512 + lane * 8) = v1;
                    if (lane == 0) { rowtok[pos] = tok * 2 + k; roww[pos] = rec_w[tok * 2 + k]; } } }
            SEAM(pb + 7);
        }
        if (IN(pb + 8)) {
            PHASE_IDS();
            build_offsets(ctl + CW_CNT + l * 32, offt, tid_);
            pg8::Gemm g{1024, 1024, 1024}; SchedM2 S{(const char*)xs, (const char*)(ap.ws + WS_WGU), offt, G, bid};
            EpiM2 E{hmid};
            pg8::gemm_phase<EpiM2, SchedM2>(lds, g, S, E, tid_); SEAM(pb + 8);
        }
        if (IN(pb + 9)) {
            PHASE_IDS();
            build_offsets(ctl + CW_CNT + l * 32, offt, tid_);
            pg8::Gemm g{256, 256, 256}; SchedM3 S{(const char*)hmid, (const char*)(ap.ws + WS_WD), offt, G, bid};
            EpiM3 E{eo, rowtok, roww};
            pg8::gemm_phase<EpiM3, SchedM3>(lds, g, S, E, tid_); SEAM(pb + 9);
        }
    }
    if (IN(20)) { PHASE_IDS(); phase0_rows(ap, DEPTH, 1, gw, NGW, lane); }
#undef IN
#undef SEAM
}

typedef void (*kern_t)(Args);
template <unsigned PM> static bool setup_kernel() {
    if (hipFuncSetAttribute((const void*)mk_fwd<PM>, hipFuncAttributeMaxDynamicSharedMemorySize, LDS_BYTES) != hipSuccess) { fprintf(stderr, "kernel_launch: hipFuncSetAttribute failed\n"); return false; }
    return true;
}
extern "C" void kernel_launch(void* const* d_in, const int* in_sizes, int n_in, void* d_out, int out_size, void* d_ws, size_t ws_size, hipStream_t stream) {
    static int grid = 0;
    if (grid == 0) {
        if (n_in != 36 || out_size != T * D || ws_size < WS_END) { fprintf(stderr, "kernel_launch: unexpected shapes (n_in %d out %d ws %zu)\n", n_in, out_size, ws_size); grid = -1; return; }
        int dev = 0, cus = 0;
        if (hipGetDevice(&dev) != hipSuccess || hipDeviceGetAttribute(&cus, hipDeviceAttributeMultiprocessorCount, dev) != hipSuccess) { grid = -1; return; }
        bool ok = true;
#if MK_ONE_LAUNCH
        ok = setup_kernel<0x7FFu>();
#else
        ok = setup_kernel<1u>() && setup_kernel<2u>() && setup_kernel<4u>() && setup_kernel<8u>() && setup_kernel<16u>() && setup_kernel<32u>() && setup_kernel<64u>() && setup_kernel<128u>() && setup_kernel<256u>() && setup_kernel<512u>() && setup_kernel<1024u>();
#endif
        if (!ok) { grid = -1; return; }
        (void)hipGetLastError();
        grid = cus;
    }
    if (grid < 0) return;
    if (hipMemsetAsync((char*)d_ws + WS_CTL, 0, CTL_ZERO_BYTES, stream) != hipSuccess) return;
    Args a{};
    for (int i = 0; i < 36; ++i) a.in[i] = (const float*)d_in[i];
    a.out = (float*)d_out; a.ws = (unsigned char*)d_ws;
#if MK_ONE_LAUNCH
    a.ph_lo = 0; a.ph_hi = NPH;
    hipLaunchKernelGGL(mk_fwd<0x7FFu>, dim3(grid), dim3(512), LDS_BYTES, stream, a);
#else
    static const kern_t kerns[11] = { mk_fwd<1u>, mk_fwd<2u>, mk_fwd<4u>, mk_fwd<8u>, mk_fwd<16u>, mk_fwd<32u>, mk_fwd<64u>, mk_fwd<128u>, mk_fwd<256u>, mk_fwd<512u>, mk_fwd<1024u> };
    for (int p = 0; p < NPH; ++p) { a.ph_lo = p; a.ph_hi = p + 1; hipLaunchKernelGGL(kerns[p < 20 ? p % 10 : 10], dim3(grid), dim3(512), LDS_BYTES, stream, a); }
#endif
}
```

```cpp
#include <hip/hip_runtime.h>
#include <cstdio>
#include <cstdint>

#ifndef MK_ONE_LAUNCH
#define MK_ONE_LAUNCH 1
#endif

#define DI __device__ __forceinline__
#define GAS __attribute__((address_space(1)))
#define LAS __attribute__((address_space(3)))
typedef unsigned short bf16;
typedef short bf16x8 __attribute__((ext_vector_type(8)));
typedef float f32x4 __attribute__((ext_vector_type(4)));
typedef unsigned u32x4 __attribute__((ext_vector_type(4)));
typedef unsigned u32x2 __attribute__((ext_vector_type(2)));
typedef float f32x16 __attribute__((ext_vector_type(16)));
typedef float f32x2 __attribute__((ext_vector_type(2)));
typedef short s16x4 __attribute__((ext_vector_type(4)));
typedef __bf16 bf16x2_t __attribute__((ext_vector_type(2)));
typedef short v4i16_t __attribute__((__vector_size__(4 * sizeof(short))));
#define MFMA32(a, b, c) __builtin_amdgcn_mfma_f32_32x32x16_bf16((a), (b), (c), 0, 0, 0)

constexpr int BATCH = 4, SEQ = 8192, T = BATCH * SEQ, D = 1024, DEPTH = 2;
constexpr int NIN = 2444, PLD = 2560, N1 = 6656, GLD = 4096;
constexpr int C_AX = 0, C_AG = 256, C_BQ = 512, C_BK = 768, C_BV = 896, C_CQ = 1024, C_CK = 1280, C_CV = 1536, C_DQ = 1792,
              C_KC = 2048, C_VC = 2112, C_KS = 2176, C_VS = 2240, C_KW = 2304, C_VW = 2368, C_DG = 2432;
constexpr int NCMP = 511;
constexpr int MOE_ROWS = 73728;
constexpr int PPL = 11;
constexpr int NPH = 2 * PPL + 1;

constexpr size_t MiB = 1u << 20;
constexpr size_t WS_CTL = 0, CTL_ZERO_BYTES = 1 * MiB;
constexpr size_t WS_KCVC = 1 * MiB;
constexpr size_t WS_LRUSUM = 2 * MiB;
constexpr size_t WS_REC = 2 * MiB + 256 * 1024;
constexpr size_t WS_ROWTOK = 3 * MiB;
constexpr size_t WS_ROWW = 3 * MiB + 512 * 1024;
constexpr size_t WS_WIN = 4 * MiB;
constexpr size_t WS_WBR = 17 * MiB;
constexpr size_t WS_WOUT = 19 * MiB;
constexpr size_t WS_HB = 21 * MiB;
constexpr size_t WS_PROJ = 85 * MiB;
constexpr size_t WS_GATES = 245 * MiB;
constexpr size_t WS_WGU = 245 * MiB;
constexpr size_t WS_WD = 277 * MiB;
constexpr size_t WS_XS = 293 * MiB;
constexpr size_t WS_HMID = 437 * MiB;
constexpr size_t WS_XR = 85 * MiB;
constexpr size_t WS_RLOG = 213 * MiB;
constexpr size_t WS_WR = 501 * MiB;
constexpr size_t WS_WCMP = 502 * MiB;
constexpr size_t WS_CMPAB = 503 * MiB;
constexpr size_t WS_END = 506 * MiB;
constexpr int CW_BAR = 4096;
constexpr int CW_CNT = 16384;

constexpr int RING_BYTES = 131072;
constexpr int MISC_OFF = RING_BYTES;
constexpr int BIAS_OFF = MISC_OFF + 256;
constexpr int OFFT_OFF = BIAS_OFF + 129 * 12 * 4;
constexpr int PTAB_OFF = OFFT_OFF + (40 + 288) * 4;
constexpr int BIAS2_OFF = PTAB_OFF + 36 * 8;
constexpr int LDS_BYTES = 147456;
static_assert(PTAB_OFF % 8 == 0 && BIAS2_OFF + 129 * 12 * 4 <= LDS_BYTES, "LDS map");

DI float bf2f(bf16 v) { return __builtin_bit_cast(float, (unsigned)v << 16); }
DI float lo_bf(unsigned w) { return __builtin_bit_cast(float, w << 16); }
DI float hi_bf(unsigned w) { return __builtin_bit_cast(float, w & 0xffff0000u); }
DI unsigned f2bf(float f) { unsigned u = __builtin_bit_cast(unsigned, f); return (u + 0x7fffu + ((u >> 16) & 1u)) >> 16; }
DI unsigned pk2(float lo, float hi) { return f2bf(lo) | (f2bf(hi) << 16); }
DI float rl(float v, int i) { return __builtin_bit_cast(float, __builtin_amdgcn_readlane(__builtin_bit_cast(int, v), i)); }
DI int rli(int v, int i) { return __builtin_amdgcn_readlane(v, i); }
DI int my_lane() { int l; asm volatile("v_mbcnt_lo_u32_b32 %0, -1, 0\n\tv_mbcnt_hi_u32_b32 %0, -1, %0" : "=v"(l)); return l; }
template <int O> DI int xshfl_i(int v) {
    if constexpr (O < 32) return __builtin_amdgcn_ds_swizzle(v, (O << 10) | 0x1f);
    else { const int l = my_lane(); return __builtin_amdgcn_ds_bpermute((l ^ 32) << 2, v); }
}
template <int O> DI float xshfl(float v) { return __builtin_bit_cast(float, xshfl_i<O>(__builtin_bit_cast(int, v))); }
DI float wave_sum(float v) { v += xshfl<1>(v); v += xshfl<2>(v); v += xshfl<4>(v); v += xshfl<8>(v); v += xshfl<16>(v); v += xshfl<32>(v); return v; }
DI float wave_max(float v) { v = fmaxf(v, xshfl<1>(v)); v = fmaxf(v, xshfl<2>(v)); v = fmaxf(v, xshfl<4>(v)); v = fmaxf(v, xshfl<8>(v)); v = fmaxf(v, xshfl<16>(v)); v = fmaxf(v, xshfl<32>(v)); return v; }
DI float sigmoidf_(float x) { return 1.f / (1.f + __expf(-x)); }
DI float gelu_tanh(float x) { const float u = 0.7978845608028654f * (x + 0.044715f * x * x * x); const float e = __expf(2.f * u); const float th = 1.f - 2.f / (e + 1.f); return 0.5f * x * (1.f + th); }
DI float softplusf_(float x) { return fmaxf(x, 0.f) + log1pf(__expf(-fabsf(x))); }
#define LDS_WAIT() asm volatile("s_waitcnt lgkmcnt(0)" ::: "memory")
#define VM_WAIT() asm volatile("s_waitcnt vmcnt(0)" ::: "memory")

__device__ const unsigned char T5_BUCKET[128] = {
0,1,2,3,4,5,6,7,8,9,10,11,12,13,14,15,16,16,16,17,17,18,18,18,19,19,19,20,20,20,20,21,21,21,21,22,22,22,22,22,23,23,23,23,23,23,24,24,24,24,24,24,25,25,25,25,25,25,25,26,26,26,26,26,26,26,26,27,27,27,27,27,27,27,27,27,27,28,28,28,28,28,28,28,28,28,28,29,29,29,29,29,29,29,29,29,29,29,29,30,30,30,30,30,30,30,30,30,30,30,30,30,30,31,31,31,31,31,31,31,31,31,31,31,31,31,31,31};

#define XB_TMO      128
#define XB_XCNT(j)  (256  + 64 * (j))
#define XB_XSUB(j)  (1280 + 64 * (j))
#define XB_XGEN(j)  (2304 + 64 * (j))
#define XB_TOP      3328
#define XB_TOPGEN   3392
#define XCD_BAR_WORDS 3456
#define XB_SPIN_CAP (1u << 22)
DI unsigned xb_ld(unsigned* p)              { return __hip_atomic_load(p, __ATOMIC_RELAXED, __HIP_MEMORY_SCOPE_AGENT); }
DI unsigned xb_add(unsigned* p, unsigned v) { return __hip_atomic_fetch_add(p, v, __ATOMIC_RELAXED, __HIP_MEMORY_SCOPE_AGENT); }
DI unsigned xb_xcc_id() { return (unsigned)__builtin_amdgcn_s_getreg((3 << 11) | 20) & 0xFu; }
#define XB_SPIN(cond, bar) do { unsigned _sp = 0; while (cond) { __builtin_amdgcn_s_sleep(1); \
    if ((++_sp & 255u) == 0u) { if (xb_ld(&(bar)[XB_TMO])) break; if (_sp > XB_SPIN_CAP) { atomicAdd(&(bar)[XB_TMO], 1u); break; } } } } while (0)
struct XcdBarrier { unsigned* bar; unsigned x; volatile LAS unsigned* st; };
DI XcdBarrier xcd_barrier_post(unsigned* bar, volatile LAS unsigned* st, bool leader) {
    XcdBarrier b; b.bar = bar; b.x = xb_xcc_id(); b.st = st;
    if (leader) (void)xb_add(&bar[XB_XCNT(b.x)], 1u);
    return b;
}
DI void xcd_barrier_complete(unsigned* bar, unsigned x, unsigned& nloc, unsigned& nx) {
    const unsigned G = gridDim.x * gridDim.y * gridDim.z;
    unsigned sum, cnt, mine, sp = 0u;
    for (;;) {
        sum = 0u; cnt = 0u; mine = 0u;
#pragma unroll
        for (unsigned j = 0; j < 16; ++j) { const unsigned c = xb_ld(&bar[XB_XCNT(j)]); sum += c; cnt += (c > 0u) ? 1u : 0u; mine = (j == x) ? c : mine; }
        if (sum == G) break;
        __builtin_amdgcn_s_sleep(1);
        if ((++sp & 255u) == 0u) { if (xb_ld(&bar[XB_TMO])) break; if (sp > XB_SPIN_CAP) { atomicAdd(&bar[XB_TMO], 1u); break; } }
    }
    nloc = mine > 0u ? mine : 1u; nx = cnt > 0u ? cnt : 1u;
}
DI void xcd_barrier(const XcdBarrier& b, bool leader) {
    asm volatile("s_waitcnt vmcnt(0)" ::: "memory");
    __syncthreads();
    if (leader) {
        unsigned* bar = b.bar;
        __builtin_amdgcn_s_waitcnt(0);
        unsigned nloc = b.st[0], nx = b.st[1];
        if (nloc == 0u) { xcd_barrier_complete(bar, b.x, nloc, nx); b.st[0] = nloc; b.st[1] = nx; }
        const unsigned old = xb_add(&bar[XB_XSUB(b.x)], 1u);
        const unsigned gen = old / nloc;
        if (old + 1u == (gen + 1u) * nloc) {
            __builtin_amdgcn_fence(__ATOMIC_RELEASE, "agent");
            asm volatile("s_waitcnt vmcnt(0)" ::: "memory");
            const unsigned og = xb_add(&bar[XB_TOP], 1u);
            const unsigned tg = og / nx;
            if (og + 1u == (tg + 1u) * nx) xb_add(&bar[XB_TOPGEN], 1u);
            else XB_SPIN(xb_ld(&bar[XB_TOPGEN]) == tg, bar);
            __builtin_amdgcn_fence(__ATOMIC_ACQUIRE, "agent");
            xb_add(&bar[XB_XGEN(b.x)], 1u);
            asm volatile("s_waitcnt vmcnt(0)" ::: "memory");
        } else {
            XB_SPIN(xb_ld(&bar[XB_XGEN(b.x)]) == gen, bar);
            __builtin_amdgcn_fence(__ATOMIC_ACQUIRE, "agent");
            asm volatile("s_waitcnt vmcnt(0)" ::: "memory");
        }
    }
    __syncthreads();
}

namespace pg8 {
constexpr int BM = 256, BK = 64, HALF = 128, HTB = HALF * BK * 2;
__host__ __device__ __forceinline__ int lds_byte(int r, int c) { const int st = (r >> 4) * 2 + (c >> 5), rr = r & 15, cc = c & 31, ob = rr * 64 + cc * 2; return st * 1024 + (ob ^ (((ob >> 9) & 1) << 5)); }
__host__ __device__ __forceinline__ void stage_rc(int b, int& R, int& C) { const int st = b / 1024, sb = b % 1024, swz = sb ^ (((sb >> 9) & 1) << 5); R = (st >> 1) * 16 + swz / 64; C = (st & 1) * 32 + (swz % 64) / 2; }
__host__ __device__ __forceinline__ int perm32(int rho) { const int n = rho >> 4, i = rho & 15; return 8 * (i >> 2) + 4 * n + (i & 3); }
struct Unit { const char* a; const char* b; int pm, pn, aux, pad; };
struct Gemm { int K, lda, ldb, kstepA; };
template <class Epi, class Sched>
DI void gemm_phase(LAS unsigned char* lds, const Gemm g, const Sched& S, const Epi& E, int tid_in) {
    int tid = tid_in; asm volatile("" : "+v"(tid));
    const int wid = __builtin_amdgcn_readfirstlane(tid >> 6), lane = tid & 63, wr = wid >> 2, wc = wid & 3, fr = lane & 15, fq = lane >> 4;
    const int K = g.K, nt = K / BK;
    unsigned voffA[2], voffB[2];
#pragma unroll
    for (int i = 0; i < 2; ++i) { int R, C; stage_rc(tid * 16 + i * 8192, R, C); const int Rb = (R & ~31) + perm32(R & 31);
        voffA[i] = (unsigned)(R * g.lda + C) * 2u; voffB[i] = (unsigned)(Rb * g.ldb + C) * 2u; }
    const size_t kstep = (size_t)(BK * 2), kstepA = (size_t)g.kstepA;
    const size_t hstepA = (size_t)HALF * g.lda * 2, hstepB = (size_t)HALF * g.ldb * 2;
    const unsigned ldsw = (unsigned)wid * 1024u;
    const int aoff = lds_byte(wr * 64 + fr, fq * 8), boff = lds_byte(wc * 32 + fr, fq * 8);
#define PG8_SA(b, h) (((b) * 2 + (h)) * HTB)
#define PG8_SB(b, h) ((4 + (b) * 2 + (h)) * HTB)
#define PG8_STAGE(bufoff, gbase, voff) do { _Pragma("unroll") for (int _i = 0; _i < 2; ++_i) \
        __builtin_amdgcn_global_load_lds((const unsigned*)((const char*)(gbase) + (voff)[_i]), (LAS unsigned*)(lds + (bufoff) + ldsw + _i * 8192), 16, 0, 0); } while (0)
#define PG8_LDA(dst, b, h) do { _Pragma("unroll") for (int m = 0; m < 4; ++m) _Pragma("unroll") for (int k = 0; k < 2; ++k) dst[m][k] = *(const LAS bf16x8*)(lds + PG8_SA(b, h) + aoff + m * 2048 + k * 1024); } while (0)
#define PG8_LDB(dst, b, h) do { _Pragma("unroll") for (int n = 0; n < 2; ++n) _Pragma("unroll") for (int k = 0; k < 2; ++k) dst[n][k] = *(const LAS bf16x8*)(lds + PG8_SB(b, h) + boff + n * 2048 + k * 1024); } while (0)
#define PG8_MMA(ai, bj, At, Bt) do { __builtin_amdgcn_s_setprio(1); _Pragma("unroll") for (int m = 0; m < 4; ++m) _Pragma("unroll") for (int n = 0; n < 2; ++n) _Pragma("unroll") for (int k = 0; k < 2; ++k) \
        acc[ai][bj][m][n] = __builtin_amdgcn_mfma_f32_16x16x32_bf16(Bt[n][k], At[m][k], acc[ai][bj][m][n], 0, 0, 0); __builtin_amdgcn_s_setprio(0); } while (0)
#define PG8_WAIT_V(n) asm volatile("s_waitcnt vmcnt(" #n ")" ::: "memory")
#define PG8_WAIT_L(n) asm volatile("s_waitcnt lgkmcnt(" #n ")" ::: "memory")
#define PG8_BAR __builtin_amdgcn_s_barrier()
#define PG8_SCHED __builtin_amdgcn_sched_barrier(0)
    Unit cur, nxt; int ui = 0;
    if (!S.next(0, cur)) return;
    f32x4 acc[2][2][4][2];
#pragma unroll
    for (int a = 0; a < 2; ++a)
#pragma unroll
        for (int b = 0; b < 2; ++b)
#pragma unroll
            for (int m = 0; m < 4; ++m)
#pragma unroll
                for (int n = 0; n < 2; ++n) acc[a][b][m][n] = (f32x4){0.f, 0.f, 0.f, 0.f};
    bf16x8 At[4][2], B0[2][2], B1[2][2];
    const char* cA = cur.a; const char* cB = cur.b;
    PG8_STAGE(PG8_SB(0, 0), cB, voffB); PG8_STAGE(PG8_SB(0, 1), cB + hstepB, voffB); PG8_STAGE(PG8_SA(0, 0), cA, voffA); PG8_STAGE(PG8_SA(0, 1), cA + hstepA, voffA);
    if (wr == 1) PG8_BAR;
    PG8_WAIT_V(2); PG8_BAR;
    PG8_STAGE(PG8_SB(1, 0), cB + kstep, voffB); PG8_STAGE(PG8_SA(1, 0), cA + kstepA, voffA); PG8_STAGE(PG8_SB(1, 1), cB + hstepB + kstep, voffB);
    PG8_WAIT_V(6); PG8_BAR;
    for (;;) {
        const bool has_next = S.next(ui + 1, nxt);
        const char* nA = has_next ? nxt.a : cA; const char* nB = has_next ? nxt.b : cB;
        for (int t = 0; t < nt; t += 2) {
            const bool last = (t == nt - 2);
            const char* a1 = cA + (size_t)(t + 1) * kstepA;
            const char* a2 = last ? nA : cA + (size_t)(t + 2) * kstepA; const char* b2 = last ? nB : cB + (size_t)(t + 2) * kstep;
            const char* a3 = a2 + kstepA; const char* b3 = b2 + kstep;
            PG8_LDB(B0, 0, 0); PG8_LDB(B1, 0, 1); PG8_SCHED; PG8_LDA(At, 0, 0); PG8_STAGE(PG8_SA(1, 1), a1 + hstepA, voffA);
            PG8_WAIT_V(8); PG8_WAIT_L(0); PG8_BAR; PG8_MMA(0, 0, At, B0); PG8_MMA(0, 1, At, B1); PG8_BAR; PG8_SCHED;
            PG8_LDA(At, 0, 1); PG8_STAGE(PG8_SB(0, 0), b2, voffB); PG8_STAGE(PG8_SB(0, 1), b2 + hstepB, voffB); PG8_STAGE(PG8_SA(0, 0), a2, voffA);
            PG8_WAIT_V(8); PG8_WAIT_L(0); PG8_BAR; PG8_MMA(1, 0, At, B0); PG8_MMA(1, 1, At, B1); PG8_BAR; PG8_SCHED;
            PG8_LDB(B0, 1, 0); PG8_LDB(B1, 1, 1); PG8_SCHED; PG8_LDA(At, 1, 0); PG8_STAGE(PG8_SA(0, 1), a2 + hstepA, voffA);
            PG8_WAIT_V(8); PG8_WAIT_L(0); PG8_BAR; PG8_MMA(0, 0, At, B0); PG8_MMA(0, 1, At, B1); PG8_BAR; PG8_SCHED;
            PG8_LDA(At, 1, 1); PG8_STAGE(PG8_SB(1, 0), b3, voffB); PG8_STAGE(PG8_SB(1, 1), b3 + hstepB, voffB); PG8_STAGE(PG8_SA(1, 0), a3, voffA);
            PG8_WAIT_V(8); PG8_WAIT_L(0); PG8_BAR; PG8_MMA(1, 0, At, B0); PG8_MMA(1, 1, At, B1); PG8_BAR; PG8_SCHED;
        }
        if (wr == 0) PG8_BAR;
        { const int el = my_lane(); E(acc, cur, wr, wc, el & 15, el >> 4); }
        if (!has_next) break;
#pragma unroll
        for (int a = 0; a < 2; ++a)
#pragma unroll
            for (int b = 0; b < 2; ++b)
#pragma unroll
                for (int m = 0; m < 4; ++m)
#pragma unroll
                    for (int n = 0; n < 2; ++n) acc[a][b][m][n] = (f32x4){0.f, 0.f, 0.f, 0.f};
        cur = nxt; cA = nA; cB = nB; ++ui;
        if (wr == 1) PG8_BAR;
    }
    PG8_WAIT_V(0);
    PG8_BAR;
#undef PG8_SA
#undef PG8_SB
#undef PG8_STAGE
#undef PG8_LDA
#undef PG8_LDB
#undef PG8_MMA
#undef PG8_WAIT_V
#undef PG8_WAIT_L
#undef PG8_BAR
#undef PG8_SCHED
}
}
using pg8::Unit;

DI unsigned cvt_pk_bf16(float lo, float hi) { unsigned r; asm volatile("v_cvt_pk_bf16_f32 %0, %1, %2" : "=v"(r) : "v"(lo), "v"(hi)); return r; }
DI u32x4 pack8(const f32x4& v0, const f32x4& v1) { u32x4 w; w.x = cvt_pk_bf16(v0[0], v0[1]); w.y = cvt_pk_bf16(v0[2], v0[3]); w.z = cvt_pk_bf16(v1[0], v1[1]); w.w = cvt_pk_bf16(v1[2], v1[3]); return w; }

struct SchedP1 {
    const char* A; const char* B; int G, c;
    DI bool next(int i, Unit& u) const {
        constexpr int nM = 128, nN = 26, nwg = nM * nN, NXCD = 8, WGM = 8;
        const long L = (long)i * G + c; if (L >= nwg) return false;
        int wgid = (int)L; { const int q = nwg / NXCD, r = nwg % NXCD, xcd = wgid % NXCD, off = wgid / NXCD; wgid = (xcd < r ? xcd * (q + 1) : r * (q + 1) + (xcd - r) * q) + off; }
        const int nig = WGM * nN, gid = wgid / nig, fm = gid * WGM, gsz = (nM - fm) < WGM ? (nM - fm) : WGM;
        u.pm = fm + ((wgid % nig) % gsz); u.pn = (wgid % nig) / gsz; u.aux = 0; u.pad = 0;
        u.a = A + (size_t)u.pm * 256 * 1024 * 2; u.b = B + (size_t)u.pn * 256 * 1024 * 2; return true;
    }
};
struct SchedP3a {
    const char* ys; const char* wbr; int G, c;
    DI bool next(int i, Unit& u) const {
        const int tile = (i >> 2) * G + c; if (tile >= 512) return false;
        const int br = i & 3; u.pm = tile >> 2; u.pn = tile & 3; u.aux = br; u.pad = 0;
        u.a = ys + ((size_t)u.pm * 256 * 1024 + br * 256) * 2; u.b = wbr + ((size_t)br * 1024 * 256 + (size_t)u.pn * 256 * 256) * 2; return true;
    }
};
struct SchedP3b {
    const char* A; const char* B; int G, c;
    DI bool next(int i, Unit& u) const {
        const int L = i * G + c; if (L >= 512) return false;
        u.pm = L >> 2; u.pn = L & 3; u.aux = 0; u.pad = 0;
        u.a = A + (size_t)u.pm * 256 * 1024 * 2; u.b = B + (size_t)u.pn * 256 * 1024 * 2; return true;
    }
};
struct SchedM2 {
    const char* xs; const char* wgu; const LAS int* offt; int G, c;
    DI bool next(int i, Unit& u) const {
        const int NT = __builtin_amdgcn_readfirstlane(offt[32]) >> 8; const int L = i * G + c; if (L >= NT * 2) return false;
        const int rt = L >> 1, pn = L & 1; const int e = __builtin_amdgcn_readfirstlane(offt[40 + rt]);
        u.pm = rt; u.pn = pn; u.aux = e; u.pad = 0;
        u.a = xs + (size_t)rt * 256 * 1024 * 2; u.b = wgu + ((size_t)e * 512 + pn * 256) * 1024 * 2; return true;
    }
};
struct SchedM3 {
    const char* hmid; const char* wd; const LAS int* offt; int G, c;
    DI bool next(int i, Unit& u) const {
        const int NT = __builtin_amdgcn_readfirstlane(offt[32]) >> 8; const int L = i * G + c; if (L >= NT * 4) return false;
        const int rt = L >> 2, pn = L & 3; const int e = __builtin_amdgcn_readfirstlane(offt[40 + rt]);
        u.pm = rt; u.pn = pn; u.aux = e; u.pad = 0;
        u.a = hmid + (size_t)rt * 256 * 256 * 2; u.b = wd + ((size_t)e * 1024 + pn * 256) * 256 * 2; return true;
    }
};

struct EpiP1 {
    bf16* proj; bf16* gates; const float* bgate;
    DI void operator()(const f32x4 (&acc)[2][2][4][2], const Unit& u, int wr, int wc, int fr, int fq) const {
        const int row0 = u.pm * 256 + wr * 64 + fr; const int colt = u.pn * 256 + wc * 32 + 8 * fq;
        if (u.pn < 10) {
#pragma unroll
            for (int ai = 0; ai < 2; ++ai)
#pragma unroll
                for (int m = 0; m < 4; ++m) { bf16* rowp = proj + (size_t)(row0 + ai * 128 + m * 16) * PLD + colt;
#pragma unroll
                    for (int bj = 0; bj < 2; ++bj) *(u32x4*)(rowp + bj * 128) = pack8(acc[ai][bj][m][0], acc[ai][bj][m][1]); }
        } else {
            const int gcol = colt - 2560;
            f32x4 bv[2][2];
#pragma unroll
            for (int bj = 0; bj < 2; ++bj)
#pragma unroll
                for (int n = 0; n < 2; ++n) bv[bj][n] = *(const f32x4*)(bgate + gcol + bj * 128 + 4 * n);
#pragma unroll
            for (int ai = 0; ai < 2; ++ai)
#pragma unroll
                for (int m = 0; m < 4; ++m) { bf16* rowp = gates + (size_t)(row0 + ai * 128 + m * 16) * GLD + gcol;
#pragma unroll
                    for (int bj = 0; bj < 2; ++bj) { f32x4 v0 = acc[ai][bj][m][0] + bv[bj][0], v1 = acc[ai][bj][m][1] + bv[bj][1];
#pragma unroll
                        for (int e = 0; e < 4; ++e) { v0[e] = sigmoidf_(v0[e]); v1[e] = sigmoidf_(v1[e]); }
                        *(u32x4*)(rowp + bj * 128) = pack8(v0, v1); }
                    __builtin_amdgcn_sched_barrier(0); }
        }
    }
};
struct EpiP3a {
    bf16* merged; const bf16* gates;
    DI void operator()(const f32x4 (&acc)[2][2][4][2], const Unit& u, int wr, int wc, int fr, int fq) const {
        const int row0 = u.pm * 256 + wr * 64 + fr; const int colt = u.pn * 256 + wc * 32 + 8 * fq; const int br = u.aux;
#pragma unroll
        for (int ai = 0; ai < 2; ++ai)
#pragma unroll
            for (int m = 0; m < 4; ++m) { const size_t row = (size_t)(row0 + ai * 128 + m * 16);
#pragma unroll
                for (int bj = 0; bj < 2; ++bj) {
                    const u32x4 gw = *(const u32x4*)(gates + row * GLD + br * 1024 + colt + bj * 128);
                    bf16* mp = merged + row * 1024 + colt + bj * 128;
                    f32x4 v0 = acc[ai][bj][m][0], v1 = acc[ai][bj][m][1];
                    v0[0] *= lo_bf(gw.x); v0[1] *= hi_bf(gw.x); v0[2] *= lo_bf(gw.y); v0[3] *= hi_bf(gw.y);
                    v1[0] *= lo_bf(gw.z); v1[1] *= hi_bf(gw.z); v1[2] *= lo_bf(gw.w); v1[3] *= hi_bf(gw.w);
                    if (br != 0) { const u32x4 mw = *(const u32x4*)mp;
                        v0[0] += lo_bf(mw.x); v0[1] += hi_bf(mw.x); v0[2] += lo_bf(mw.y); v0[3] += hi_bf(mw.y);
                        v1[0] += lo_bf(mw.z); v1[1] += hi_bf(mw.z); v1[2] += lo_bf(mw.w); v1[3] += hi_bf(mw.w); }
                    *(u32x4*)mp = pack8(v0, v1); }
                __builtin_amdgcn_sched_barrier(0); }
    }
};
struct EpiP3b {
    const float* xin; float* out;
    DI void operator()(const f32x4 (&acc)[2][2][4][2], const Unit& u, int wr, int wc, int fr, int fq) const {
        const int row0 = u.pm * 256 + wr * 64 + fr; const int colt = u.pn * 256 + wc * 32 + 8 * fq;
#pragma unroll
        for (int ai = 0; ai < 2; ++ai)
#pragma unroll
            for (int m = 0; m < 4; ++m) { const size_t off = (size_t)(row0 + ai * 128 + m * 16) * 1024 + colt;
#pragma unroll
                for (int bj = 0; bj < 2; ++bj)
#pragma unroll
                    for (int n = 0; n < 2; ++n) { const f32x4 xv = *(const f32x4*)(xin + off + bj * 128 + 4 * n); *(f32x4*)(out + off + bj * 128 + 4 * n) = xv + acc[ai][bj][m][n]; }
                __builtin_amdgcn_sched_barrier(0); }
    }
};
struct EpiM2 {
    bf16* hmid;
    DI void operator()(const f32x4 (&acc)[2][2][4][2], const Unit& u, int wr, int wc, int fr, int fq) const {
        const int row0 = u.pm * 256 + wr * 64 + fr; const int col = u.pn * 128 + wc * 32 + 8 * fq;
#pragma unroll
        for (int ai = 0; ai < 2; ++ai)
#pragma unroll
            for (int m = 0; m < 4; ++m) { f32x4 h0, h1;
#pragma unroll
                for (int e = 0; e < 4; ++e) { const float g0 = acc[ai][0][m][0][e], g1 = acc[ai][0][m][1][e];
                    h0[e] = g0 * sigmoidf_(g0) * acc[ai][1][m][0][e]; h1[e] = g1 * sigmoidf_(g1) * acc[ai][1][m][1][e]; }
                *(u32x4*)(hmid + (size_t)(row0 + ai * 128 + m * 16) * 256 + col) = pack8(h0, h1); }
    }
};
struct EpiM3 {
    bf16* eo; const int* rowtok; const float* roww;
    DI void operator()(const f32x4 (&acc)[2][2][4][2], const Unit& u, int wr, int wc, int fr, int fq) const {
        const int row0 = u.pm * 256 + wr * 64 + fr; const int colt = u.pn * 256 + wc * 32 + 8 * fq;
#pragma unroll
        for (int ai = 0; ai < 2; ++ai)
#pragma unroll
            for (int m = 0; m < 4; ++m) { const int row = row0 + ai * 128 + m * 16; const int tk = rowtok[row];
                if (tk >= 0) { const float w = roww[row]; bf16* op = eo + (size_t)tk * 1024 + colt;
#pragma unroll
                    for (int bj = 0; bj < 2; ++bj) *(u32x4*)(op + bj * 128) = pack8(acc[ai][bj][m][0] * w, acc[ai][bj][m][1] * w); }
                __builtin_amdgcn_sched_barrier(0); }
    }
};

struct Args { const float* in[36]; float* out; unsigned char* ws; int ph_lo, ph_hi; };
struct InTab { unsigned base;
    DI const float* operator[](int i) const { unsigned long long v; const unsigned addr = base + (unsigned)i * 8u;
        asm volatile("ds_read_b64 %0, %1\n\ts_waitcnt lgkmcnt(0)" : "=v"(v) : "v"(addr) : "memory");
        const unsigned lo = __builtin_amdgcn_readfirstlane((unsigned)v), hi = __builtin_amdgcn_readfirstlane((unsigned)(v >> 32));
        return (const float*)(((unsigned long long)hi << 32) | lo); } };
struct KA { InTab in; float* out; unsigned char* ws; };

DI void transpose_item(const float* W, int ldw, int nvalid, bf16* WT, int ldt, int k0, int n0, int dst_row0, LAS float* scr, int lane) {
    const bool nok = (n0 + (lane & 31)) < nvalid;
#pragma unroll 8
    for (int i = 0; i < 32; ++i) { const int kk = 2 * i + (lane >> 5); scr[kk * 33 + (lane & 31)] = nok ? W[(size_t)(k0 + kk) * ldw + n0 + (lane & 31)] : 0.f; }
    LDS_WAIT(); asm volatile("" ::: "memory");
    const int c = lane & 7;
#pragma unroll
    for (int j = 0; j < 4; ++j) { const int n = (lane >> 3) + 8 * j; const LAS float* s = scr + (8 * c) * 33 + n;
        u32x4 o; o.x = pk2(s[0 * 33], s[1 * 33]); o.y = pk2(s[2 * 33], s[3 * 33]); o.z = pk2(s[4 * 33], s[5 * 33]); o.w = pk2(s[6 * 33], s[7 * 33]);
        if (n0 + n < nvalid) *(u32x4*)(WT + (size_t)(dst_row0 + n) * ldt + k0 + 8 * c) = o; }
    LDS_WAIT(); asm volatile("" ::: "memory");
}
DI void phase0_weights(const KA& a, int l, LAS unsigned char* lds, int gw, int NGW, int wave, int lane) {
    LAS float* scr = (LAS float*)(lds + wave * 16384);
    const float* w_in = a.in[4] + (size_t)l * 1024 * NIN;
    const float* w_gate = a.in[24] + (size_t)l * 4 * 1024 * 1024;
    const float* w_br = a.in[26] + (size_t)l * 4 * 256 * 1024;
    const float* w_out = a.in[27] + (size_t)l * 1024 * 1024;
    bf16* Wt_in = (bf16*)(a.ws + WS_WIN); bf16* Wt_br = (bf16*)(a.ws + WS_WBR); bf16* Wt_out = (bf16*)(a.ws + WS_WOUT);
    constexpr int I_IN = 16 * 77, I_G = 4 * 16 * 32, I_B = 4 * 4 * 32, I_O = 16 * 32, NIT = I_IN + I_G + I_B + I_O;
    for (int it = gw; it < NIT; it += NGW) {
        int r = it;
        if (r < I_IN) { const int kb = r / 77, nb = r % 77; transpose_item(w_in, NIN, NIN, Wt_in, 1024, kb * 64, nb * 32, nb * 32, scr, lane); continue; } r -= I_IN;
        if (r < I_G) { const int br = r / 512, q = r % 512, kb = q / 32, nb = q % 32; transpose_item(w_gate + (size_t)br * 1024 * 1024, 1024, 1024, Wt_in, 1024, kb * 64, nb * 32, 2560 + br * 1024 + nb * 32, scr, lane); continue; } r -= I_G;
        if (r < I_B) { const int br = r / 128, q = r % 128, kb = q / 32, nb = q % 32; transpose_item(w_br + (size_t)br * 256 * 1024, 1024, 1024, Wt_br + (size_t)br * 1024 * 256, 256, kb * 64, nb * 32, nb * 32, scr, lane); continue; } r -= I_B;
        { const int kb = r / 32, nb = r % 32; transpose_item(w_out, 1024, 1024, Wt_out, 1024, kb * 64, nb * 32, nb * 32, scr, lane); }
    }
}

DI void router_weights(const KA& a, int l, int gw, int NGW, int lane) {
    bf16* Wr = (bf16*)(a.ws + WS_WR);
    const float* wg = a.in[29] + (size_t)l * 1024 * 4; const float* we = a.in[31] + (size_t)l * 1024 * 32;
    for (int n = gw; n < 36; n += NGW) {
        for (int i = 0; i < 16; ++i) { const int k = lane + 64 * i; const float w = (n < 4) ? wg[k * 4 + n] : we[k * 32 + (n - 4)];
            const unsigned hi = f2bf(w); const float hf = __builtin_bit_cast(float, hi << 16); const unsigned lo = f2bf(w - hf);
            Wr[(size_t)n * 2048 + k] = (bf16)hi; Wr[(size_t)n * 2048 + 1024 + k] = (bf16)hi; Wr[(size_t)(64 + n) * 2048 + k] = (bf16)lo; Wr[(size_t)(64 + n) * 2048 + 1024 + k] = 0; }
    }
}

DI void cmp_weights(const KA& a, int l, LAS unsigned char* lds, int gw, int NGW, int wave, int lane) {
    LAS float* scr = (LAS float*)(lds + wave * 16384);
    bf16* Wc = (bf16*)(a.ws + WS_WCMP); float* pt = (float*)(a.ws + WS_CMPAB + 2 * MiB);
    for (int it = gw; it < 2 * 32 * 2 + 2; it += NGW) {
        if (it < 128) { const int kv = it >> 6, q = it & 63, kb = q >> 1, nb = q & 1; const float* w1 = a.in[kv ? 22 : 19] + (size_t)l * 2048 * 64;
            bf16* dst = Wc + (size_t)kv * 256 * 1024 - (kb >= 16 ? 1024 : 0);
            transpose_item(w1, 64, 64, dst, 1024, kb * 64, nb * 32, (kb >= 16 ? 64 : 0) + nb * 32, scr, lane);
        } else { const int kv = it - 128; const float* w1 = a.in[kv ? 22 : 19] + (size_t)l * 2048 * 64; const float* pos = a.in[kv ? 21 : 18] + (size_t)l * 2048;
            float acc = 0.f;
            for (int k = 0; k < 2048; ++k) acc += pos[k] * w1[(size_t)k * 64 + lane];
            pt[kv * 64 + lane] = acc; }
    }
}
DI void phase0_rows(const KA& a, int l, int mode, int gw, int NGW, int lane) {
    const float* xin = (l == 0) ? a.in[0] : a.out;
    const bf16* eo = (const bf16*)(a.ws + WS_PROJ);
    bf16* hb = (bf16*)(a.ws + WS_HB);
    const float* g = mode ? a.in[2] : (a.in[3] + (size_t)l * 1024);
    for (int m = gw; m < T; m += NGW) {
        f32x4 v[4]; float ss = 0.f;
#pragma unroll
        for (int j = 0; j < 4; ++j) { v[j] = *(const f32x4*)(xin + (size_t)m * 1024 + 4 * (lane + 64 * j));
            if (l > 0) {
                const u32x2 e0 = *(const u32x2*)(eo + (size_t)(2 * m) * 1024 + 4 * (lane + 64 * j));
                const u32x2 e1 = *(const u32x2*)(eo + (size_t)(2 * m + 1) * 1024 + 4 * (lane + 64 * j));
                v[j][0] += lo_bf(e0.x) + lo_bf(e1.x); v[j][1] += hi_bf(e0.x) + hi_bf(e1.x); v[j][2] += lo_bf(e0.y) + lo_bf(e1.y); v[j][3] += hi_bf(e0.y) + hi_bf(e1.y);
            }
            ss += (v[j][0] * v[j][0] + v[j][1] * v[j][1]) + (v[j][2] * v[j][2] + v[j][3] * v[j][3]); }
        const float r = 1.f / sqrtf(wave_sum(ss) * (1.f / 1024.f) + 1e-6f);
#pragma unroll
        for (int j = 0; j < 4; ++j) { const f32x4 gv = *(const f32x4*)(g + 4 * (lane + 64 * j)); const f32x4 y = v[j] * r * gv;
            if (mode) *(f32x4*)(a.out + (size_t)m * 1024 + 4 * (lane + 64 * j)) = y;
            else { if (l > 0) *(f32x4*)(a.out + (size_t)m * 1024 + 4 * (lane + 64 * j)) = v[j];
                   u32x2 w; w.x = pk2(y[0], y[1]); w.y = pk2(y[2], y[3]); *(u32x2*)(hb + (size_t)m * 1024 + 4 * (lane + 64 * j)) = w; } }
    }
}

DI void lru_task(const KA& a, int l, const bf16* proj, bf16* ys, float* sums, int task, int lane, bool final) {
    const int chunk = task & 31, hbk = (task >> 5) & 3, b = task >> 7; const int c = hbk * 64 + lane;
    const float* w_a = a.in[7] + ((size_t)l * 4 + hbk) * 4096; const float* w_x = a.in[9] + ((size_t)l * 4 + hbk) * 4096;
    float wa[64], wx[64];
#pragma unroll
    for (int i = 0; i < 64; ++i) { wa[i] = w_a[i * 64 + lane]; wx[i] = w_x[i * 64 + lane]; }
    const float* cw = a.in[5] + (size_t)l * 4 * 256;
    const float cw0 = cw[c], cw1 = cw[256 + c], cw2 = cw[512 + c], cw3 = cw[768 + c];
    const float cb = a.in[6][l * 256 + c], ba = a.in[8][l * 256 + c], bx = a.in[10][l * 256 + c];
    const float c8 = -8.f * softplusf_(-a.in[11][l * 256 + c]);
    const int t0 = chunk * 256; const size_t rowb = (size_t)b * SEQ;
    float x3 = (t0 >= 3) ? bf2f(proj[(rowb + t0 - 3) * PLD + C_AX + c]) : 0.f;
    float x2 = (t0 >= 2) ? bf2f(proj[(rowb + t0 - 2) * PLD + C_AX + c]) : 0.f;
    float x1 = (t0 >= 1) ? bf2f(proj[(rowb + t0 - 1) * PLD + C_AX + c]) : 0.f;
    float h = 0.f, Ap = 1.f;
    if (final) { for (int cc = 0; cc < chunk; ++cc) { const float* sp = sums + ((size_t)((b * 4 + hbk) * 32 + cc) * 64 + lane) * 2; h = sp[0] * h + sp[1]; } }
    for (int t = t0; t < t0 + 256; ++t) {
        const float x0 = bf2f(proj[(rowb + t) * PLD + C_AX + c]);
        const float xc = cb + cw0 * x3 + cw1 * x2 + cw2 * x1 + cw3 * x0;
        float ra = ba, rx = bx;
#pragma unroll
        for (int i = 0; i < 64; ++i) { const float s = rl(xc, i); ra += s * wa[i]; rx += s * wx[i]; }
        const float r = sigmoidf_(ra), ig = sigmoidf_(rx);
        const float la = c8 * r; const float av = __expf(la);
        const float mult = (t == 0) ? 1.f : sqrtf(fmaxf(1.f - __expf(2.f * la), 0.f));
        const float bb = mult * ig * xc;
        h = av * h + bb; Ap *= av;
        if (final) { const float gt = bf2f(proj[(rowb + t) * PLD + C_AG + c]); ys[(rowb + t) * 1024 + c] = (bf16)f2bf(h * gelu_tanh(gt)); }
        x3 = x2; x2 = x1; x1 = x0;
    }
    if (!final) { float* sp = sums + ((size_t)((b * 4 + hbk) * 32 + chunk) * 64 + lane) * 2; sp[0] = Ap; sp[1] = h; }
}

constexpr int DK_STR = 144, DV_STR = 192, DBUF_BYTES = 64 * DK_STR + 64 * DV_STR;
DI int crow(int i, int hh) { return (i & 3) + 8 * (i >> 2) + 4 * hh; }
DI unsigned cvtpk(float lo, float hi) { f32x2 v = {lo, hi}; bf16x2_t b = __builtin_convertvector(v, bf16x2_t); return __builtin_bit_cast(unsigned, b); }
DI bf16x8 pack_half(const f32x16& x, int s2) { u32x4 p;
    if (s2 == 0) { p.x = cvtpk(x[0], x[1]); p.y = cvtpk(x[2], x[3]); p.z = cvtpk(x[4], x[5]); p.w = cvtpk(x[6], x[7]); }
    else { p.x = cvtpk(x[8], x[9]); p.y = cvtpk(x[10], x[11]); p.z = cvtpk(x[12], x[13]); p.w = cvtpk(x[14], x[15]); }
    return __builtin_bit_cast(bf16x8, p); }
DI s16x4 vtr(const LAS unsigned char* p) { return __builtin_bit_cast(s16x4, __builtin_amdgcn_ds_read_tr16_b64_v4i16((LAS v4i16_t*)p)); }
DI float max16(const f32x16& x) { float a = fmaxf(fmaxf(x[0], x[1]), fmaxf(x[2], x[3])), b = fmaxf(fmaxf(x[4], x[5]), fmaxf(x[6], x[7])), c = fmaxf(fmaxf(x[8], x[9]), fmaxf(x[10], x[11])), d = fmaxf(fmaxf(x[12], x[13]), fmaxf(x[14], x[15])); return fmaxf(fmaxf(a, b), fmaxf(c, d)); }
DI void diff_unit(const GAS bf16* proj, GAS bf16* ys, LAS unsigned char* lds, const LAS float* bias2, const GAS float* subg, float lam, float lam_init, int b, int h, int qb, int tid_in, int lane_in, int wave_in) {
    int tid = tid_in, lane = lane_in, wave = wave_in; asm volatile("" : "+v"(tid), "+v"(lane), "+s"(wave));
    const int q0 = qb * 256 + wave * 32; const int ql = lane & 31, hh = lane >> 5; const int q = q0 + ql;
    const size_t rowb = (size_t)b * SEQ;
    const float SC = 0.17677669529663687f * 1.4426950408889634f;
    bf16x8 qf[2][2];
    { const GAS bf16* qp = proj + (rowb + q) * PLD + C_CQ + h * 64 + hh * 8;
#pragma unroll
      for (int m = 0; m < 2; ++m)
#pragma unroll
        for (int s = 0; s < 2; ++s) { const u32x4 w = *(const GAS u32x4*)(qp + m * 32 + s * 16); u32x4 o;
            o.x = cvtpk(lo_bf(w.x) * SC, hi_bf(w.x) * SC); o.y = cvtpk(lo_bf(w.y) * SC, hi_bf(w.y) * SC); o.z = cvtpk(lo_bf(w.z) * SC, hi_bf(w.z) * SC); o.w = cvtpk(lo_bf(w.w) * SC, hi_bf(w.w) * SC);
            qf[m][s] = __builtin_bit_cast(bf16x8, o); } }
    f32x16 O[2][2], negm[2];
#pragma unroll
    for (int i = 0; i < 16; ++i) { O[0][0][i] = 0.f; O[0][1][i] = 0.f; O[1][0][i] = 0.f; O[1][1][i] = 0.f; negm[0][i] = 0.f; negm[1][i] = 0.f; }
    float lsum[2] = {0.f, 0.f};
    const int nsteps = 4 * qb + 4, mysteps = 4 * qb + (wave >> 1) + 1;
    const int skey = tid >> 3, sch = tid & 7;
    const GAS unsigned char* kgb = (const GAS unsigned char*)(proj + rowb * PLD + C_CK + h * 64);
    const GAS unsigned char* vgb = (const GAS unsigned char*)(proj + rowb * PLD + C_CV + h * 64);
    const unsigned soff = (unsigned)(skey * PLD + sch * 8) * 2u;
    u32x4 kr = *(const GAS u32x4*)(kgb + soff), vr = *(const GAS u32x4*)(vgb + soff);
    *(LAS u32x4*)(lds + skey * DK_STR + sch * 16) = kr; *(LAS u32x4*)(lds + 64 * DK_STR + skey * DV_STR + sch * 16) = vr;
    __syncthreads();
    const int i16 = lane & 15, blk = (lane >> 4) & 1;
    const int kboff = ql * DK_STR + hh * 16;
    const int vboff = 64 * DK_STR + (4 * hh + (i16 >> 2)) * DV_STR + (16 * blk + 4 * (i16 & 3)) * 2;
#pragma unroll 1
    for (int kt = 0; kt < nsteps; ++kt) {
        const LAS unsigned char* cur = lds + (kt & 1) * DBUF_BYTES; LAS unsigned char* nxt = lds + ((kt + 1) & 1) * DBUF_BYTES;
        if (kt + 1 < nsteps) { const unsigned so = soff + (unsigned)(kt + 1) * (64u * PLD * 2u); kr = *(const GAS u32x4*)(kgb + so); vr = *(const GAS u32x4*)(vgb + so); }
        if (kt < mysteps) {
            const int kbase = kt * 64;
            const bool near = (q0 - (kbase + 63) < 113);
#pragma unroll
            for (int m = 0; m < 2; ++m) {
                bf16x8 pk[2][2];
                f32x16 S[2];
                {   bf16x8 kf[2][2];
#pragma unroll
                    for (int t = 0; t < 2; ++t)
#pragma unroll
                        for (int s = 0; s < 2; ++s) kf[t][s] = *(const LAS bf16x8*)(cur + kboff + t * 32 * DK_STR + m * 64 + s * 32);
#pragma unroll
                    for (int t = 0; t < 2; ++t) { S[t] = MFMA32(kf[t][0], qf[m][0], negm[m]); S[t] = MFMA32(kf[t][1], qf[m][1], S[t]); } }
                if (near) {
#pragma unroll
                    for (int t = 0; t < 2; ++t)
#pragma unroll
                        for (int i = 0; i < 16; ++i) { const int dist = q - (kbase + 32 * t + crow(i, hh)); const int di = dist < 128 ? dist : 128;
                            const float bv = dist >= 0 ? bias2[di * 12 + 4 + h] : -1e30f; S[t][i] += bv; } }
                float tm = fmaxf(max16(S[0]), max16(S[1]));
                const bool need = (tm > 8.f) || (kt == 0);
                if (__builtin_amdgcn_ballot_w64(need) != 0ull) {
                    tm = fmaxf(tm, xshfl<32>(tm));
                    const float sh = (kt == 0) ? tm : fmaxf(tm, 0.f);
                    const float al = __builtin_amdgcn_exp2f(-sh);
                    lsum[m] *= al;
#pragma unroll
                    for (int i = 0; i < 16; ++i) { O[m][0][i] *= al; O[m][1][i] *= al; negm[m][i] -= sh; S[0][i] -= sh; S[1][i] -= sh; }
                }
#pragma unroll
                for (int t = 0; t < 2; ++t) {
#pragma unroll
                    for (int i = 0; i < 16; ++i) { const float p = __builtin_amdgcn_exp2f(S[t][i]); S[t][i] = p; lsum[m] += p; }
                    pk[t][0] = pack_half(S[t], 0); pk[t][1] = pack_half(S[t], 1); }
#pragma unroll
                for (int t = 0; t < 2; ++t)
#pragma unroll
                    for (int s2 = 0; s2 < 2; ++s2)
#pragma unroll
                        for (int db = 0; db < 2; ++db) {
                            const s16x4 lo = vtr(cur + vboff + (32 * t + 16 * s2) * DV_STR + db * 64), hi = vtr(cur + vboff + (32 * t + 16 * s2 + 8) * DV_STR + db * 64);
                            const bf16x8 vf = __builtin_shufflevector(lo, hi, 0, 1, 2, 3, 4, 5, 6, 7);
                            O[m][db] = MFMA32(vf, pk[t][s2], O[m][db]); }
                __builtin_amdgcn_sched_barrier(0);
            }
        }
        if (kt + 1 < nsteps) { *(LAS u32x4*)(nxt + skey * DK_STR + sch * 16) = kr; *(LAS u32x4*)(nxt + 64 * DK_STR + skey * DV_STR + sch * 16) = vr; }
        __syncthreads();
    }
    const float l0 = lsum[0] + xshfl<32>(lsum[0]), l1 = lsum[1] + xshfl<32>(lsum[1]);
    const float i0 = 1.f / fmaxf(l0, 1e-30f), i1 = lam / fmaxf(l1, 1e-30f);
    float ss = 0.f;
#pragma unroll
    for (int db = 0; db < 2; ++db)
#pragma unroll
        for (int i = 0; i < 16; ++i) { const float at = O[0][db][i] * i0 - O[1][db][i] * i1; O[0][db][i] = at; ss += at * at; }
    ss += xshfl<32>(ss);
    const float r = (1.f - lam_init) / sqrtf(ss * (1.f / 64.f) + 1e-5f);
    GAS bf16* op = ys + (rowb + q) * 1024 + 512 + h * 64;
#pragma unroll
    for (int db = 0; db < 2; ++db)
#pragma unroll
        for (int gq = 0; gq < 4; ++gq) { const int d0 = 32 * db + 8 * gq + 4 * hh; const f32x4 sg = *(const GAS f32x4*)(subg + d0);
            u32x2 w; w.x = cvtpk(O[0][db][4 * gq + 0] * r * sg[0], O[0][db][4 * gq + 1] * r * sg[1]); w.y = cvtpk(O[0][db][4 * gq + 2] * r * sg[2], O[0][db][4 * gq + 3] * r * sg[3]);
            *(GAS u32x2*)(op + d0) = w; }
}

struct SchedCmp { const char* proj; const char* wc; int G, c;
    DI bool next(int i, Unit& u) const { const int L = i * G + c; if (L >= 16) return false; const int kv = L >> 3, rt = L & 7;
        u.pm = rt; u.pn = 0; u.aux = kv; u.pad = 0; u.a = proj + ((size_t)rt * 256 * 16 * PLD + (kv ? C_VC : C_KC)) * 2; u.b = wc + (size_t)kv * 256 * 1024 * 2; return true; } };
struct EpiCmp { float* ab;
    DI void operator()(const f32x4 (&acc)[2][2][4][2], const Unit& u, int wr, int wc, int fr, int fq) const {
        const int row0 = u.pm * 256 + wr * 64 + fr; const int col = wc * 32 + 8 * fq;
#pragma unroll
        for (int ai = 0; ai < 2; ++ai)
#pragma unroll
            for (int m = 0; m < 4; ++m) { float* rp = ab + ((size_t)u.aux * 2048 + row0 + ai * 128 + m * 16) * 128 + col; *(f32x4*)rp = acc[ai][0][m][0]; *(f32x4*)(rp + 4) = acc[ai][0][m][1]; }
    }
};
DI void cmp_finish(const KA& a, int l, const float* ab, bf16* kcb, int task, int lane) {
    const int kv = task / (BATCH * NCMP), r = task % (BATCH * NCMP), b = r / NCMP, c = r % NCMP;
    const float* w2 = a.in[kv ? 23 : 20] + (size_t)l * 4096; const float* pt = ab + 2 * 2048 * 128;
    const size_t g = (size_t)kv * 2048 + b * 512 + c;
    const float h1 = ab[g * 128 + lane] + ab[(g + 1) * 128 + 64 + lane] + pt[kv * 64 + lane];
    const float gl = gelu_tanh(h1); float o = 0.f;
#pragma unroll
    for (int j = 0; j < 64; ++j) o += rl(gl, j) * w2[j * 64 + lane];
    kcb[((size_t)(kv * BATCH + b) * 512 + c) * 64 + lane] = (bf16)f2bf(o);
    if (c == NCMP - 1) kcb[((size_t)(kv * BATCH + b) * 512 + NCMP) * 64 + lane] = 0;
}

DI void st_load(const GAS unsigned char* kb, const GAS unsigned char* vb, unsigned off, u32x4& kr, u32x4& vr) { kr = *(const GAS u32x4*)(kb + off); vr = *(const GAS u32x4*)(vb + off); }
DI void st_write(LAS unsigned char* buf, int skey, int sch, const u32x4& kr, const u32x4& vr) { *(LAS u32x4*)(buf + skey * DK_STR + sch * 16) = kr; *(LAS u32x4*)(buf + 64 * DK_STR + skey * DV_STR + sch * 16) = vr; }
DI void qk64(const LAS unsigned char* cur, int kboff, const bf16x8 (&qf)[4], const f32x16& cinit, f32x16 (&S)[2]) {
#pragma unroll
    for (int t = 0; t < 2; ++t) { S[t] = cinit;
#pragma unroll
        for (int s = 0; s < 4; ++s) { const bf16x8 kf = *(const LAS bf16x8*)(cur + kboff + t * 32 * DK_STR + s * 32); S[t] = MFMA32(kf, qf[s], S[t]); } }
}
DI void qk32z(const LAS unsigned char* kt32, const bf16x8 (&qf)[4], f32x16& S) {
#pragma unroll
    for (int s = 0; s < 4; ++s) { const bf16x8 kf = *(const LAS bf16x8*)(kt32 + s * 32);
        if (s == 0) { f32x16 z;
#pragma unroll
            for (int i = 0; i < 16; ++i) z[i] = 0.f;
            S = MFMA32(kf, qf[s], z); } else S = MFMA32(kf, qf[s], S); }
}
DI void pv32(const LAS unsigned char* vt32, const bf16x8 (&pk)[2], f32x16 (&O)[2]) {
#pragma unroll
    for (int s2 = 0; s2 < 2; ++s2)
#pragma unroll
        for (int db = 0; db < 2; ++db) {
            const s16x4 lo = vtr(vt32 + (16 * s2) * DV_STR + db * 64), hi = vtr(vt32 + (16 * s2 + 8) * DV_STR + db * 64);
            const bf16x8 vf = __builtin_shufflevector(lo, hi, 0, 1, 2, 3, 4, 5, 6, 7);
            O[db] = MFMA32(vf, pk[s2], O[db]); }
}
DI void mask_bias_cmp32(f32x16& S, int tcol, int cbase, int hh, const LAS float* b2h, float msub) {
#pragma unroll
    for (int i = 0; i < 16; ++i) { const int c = cbase + crow(i, hh); const int dist = tcol - 31 - 16 * c; const bool ok = dist >= 0 && c < NCMP;
        const int di = dist < 0 ? 0 : (dist < 128 ? dist : 128); S[i] = ok ? S[i] + (b2h[di * 12] - msub) : -1e30f; }
}
DI void pv64(const LAS unsigned char* cur, int vboff, const bf16x8 (&pk)[2][2], f32x16 (&O)[2]) {
#pragma unroll
    for (int t = 0; t < 2; ++t)
#pragma unroll
        for (int s2 = 0; s2 < 2; ++s2)
#pragma unroll
            for (int db = 0; db < 2; ++db) {
                const s16x4 lo = vtr(cur + vboff + (32 * t + 16 * s2) * DV_STR + db * 64), hi = vtr(cur + vboff + (32 * t + 16 * s2 + 8) * DV_STR + db * 64);
                const bf16x8 vf = __builtin_shufflevector(lo, hi, 0, 1, 2, 3, 4, 5, 6, 7);
                O[db] = MFMA32(vf, pk[t][s2], O[db]); }
}
DI void softmax_step(f32x16 (&S)[2], f32x16 (&O)[2], f32x16& negm, float& lsum, bf16x8 (&pk)[2][2]) {
    float tm = fmaxf(max16(S[0]), max16(S[1]));
    if (__builtin_amdgcn_ballot_w64(tm > 8.f) != 0ull) {
        tm = fmaxf(tm, xshfl<32>(tm)); const float sh = fmaxf(tm, 0.f); const float al = __builtin_amdgcn_exp2f(-sh);
        lsum *= al;
#pragma unroll
        for (int i = 0; i < 16; ++i) { O[0][i] *= al; O[1][i] *= al; negm[i] -= sh; S[0][i] -= sh; S[1][i] -= sh; } }
#pragma unroll
    for (int t = 0; t < 2; ++t) {
#pragma unroll
        for (int i = 0; i < 16; ++i) { const float p = __builtin_amdgcn_exp2f(S[t][i]); S[t][i] = p; lsum += p; }
        pk[t][0] = pack_half(S[t], 0); pk[t][1] = pack_half(S[t], 1); }
}
DI void mask_bias(f32x16 (&S)[2], int tcol, int kbase, int hh, int W, bool colsel, const LAS float* b2h) {
#pragma unroll
    for (int t = 0; t < 2; ++t)
#pragma unroll
        for (int i = 0; i < 16; ++i) { const int dist = tcol - (kbase + 32 * t + crow(i, hh)); const bool ok = colsel && dist >= 0 && dist < W;
            const int di = dist < 0 ? 0 : (dist < 128 ? dist : 128); S[t][i] = ok ? S[t][i] + b2h[di * 12] : -1e30f; }
}
DI void nsa_unit(const GAS bf16* proj, GAS bf16* ys, const GAS bf16* kcb, LAS unsigned char* lds, const LAS float* bias2, int b, int u, int tid_in, int lane_in, int wave_in) {
    int tid = tid_in, lane = lane_in, wave = wave_in; asm volatile("" : "+v"(tid), "+v"(lane), "+s"(wave));
    const int t0 = u * 64; const int col = lane & 31, hh = lane >> 5, tl = col >> 2, head = col & 3;
    const int t = t0 + wave * 8 + tl; const int tw0 = t0 + wave * 8;
    const size_t rowb = (size_t)b * SEQ;
    const LAS float* b2h = bias2 + 8 + head;
    bf16x8 qf[4];
    { const float SC = 0.125f * 1.4426950408889634f; const GAS bf16* qp = proj + (rowb + t) * PLD + C_DQ + head * 64 + hh * 8;
#pragma unroll
      for (int s = 0; s < 4; ++s) { const u32x4 w = *(const GAS u32x4*)(qp + s * 16); u32x4 o;
          o.x = cvtpk(lo_bf(w.x) * SC, hi_bf(w.x) * SC); o.y = cvtpk(lo_bf(w.y) * SC, hi_bf(w.y) * SC); o.z = cvtpk(lo_bf(w.z) * SC, hi_bf(w.z) * SC); o.w = cvtpk(lo_bf(w.w) * SC, hi_bf(w.w) * SC);
          qf[s] = __builtin_bit_cast(bf16x8, o); } }
    const int skey = tid >> 3, sch = tid & 7;
    const int i16 = lane & 15, blk = (lane >> 4) & 1;
    const int kboff = col * DK_STR + hh * 16;
    const int vboff = 64 * DK_STR + (4 * hh + (i16 >> 2)) * DV_STR + (16 * blk + 4 * (i16 & 3)) * 2;
    u32x4 kr, vr;
    const int ncvm = (4 * u + 3) < NCMP ? (4 * u + 3) : NCMP;
    const int nsc = (ncvm + 63) >> 6;
    const GAS unsigned char* kcp = (const GAS unsigned char*)(kcb + (size_t)(0 * BATCH + b) * 512 * 64);
    const GAS unsigned char* vcp = (const GAS unsigned char*)(kcb + (size_t)(1 * BATCH + b) * 512 * 64);
    const unsigned soffc = (unsigned)(skey * 64 + sch * 8) * 2u;
    float m1 = -120.f, l1 = 0.f;
    st_load(kcp, vcp, soffc, kr, vr); st_write(lds, skey, sch, kr, vr); __syncthreads();
#pragma unroll 1
    for (int kt = 0; kt < nsc; ++kt) {
        const LAS unsigned char* cur = lds + (kt & 1) * DBUF_BYTES; LAS unsigned char* nxt = lds + ((kt + 1) & 1) * DBUF_BYTES;
        if (kt + 1 < nsc) st_load(kcp, vcp, soffc + (unsigned)(kt + 1) * 8192u, kr, vr);
#pragma unroll
        for (int tt = 0; tt < 2; ++tt) { f32x16 S; qk32z(cur + kboff + tt * 32 * DK_STR, qf, S); mask_bias_cmp32(S, t, kt * 64 + tt * 32, hh, b2h, 0.f);
          const float tm = max16(S); const float mn = fmaxf(m1, tm); float acc = 0.f;
#pragma unroll
          for (int i = 0; i < 16; ++i) acc += __builtin_amdgcn_exp2f(S[i] - mn);
          l1 = l1 * __builtin_amdgcn_exp2f(m1 - mn) + acc; m1 = mn; }
        if (kt + 1 < nsc) st_write(nxt, skey, sch, kr, vr);
        __syncthreads();
    }
    float mf, inv;
    { const float mo = xshfl<32>(m1), lo = xshfl<32>(l1); mf = fmaxf(m1, mo); const float lf = l1 * __builtin_amdgcn_exp2f(m1 - mf) + lo * __builtin_amdgcn_exp2f(mo - mf); inv = lf > 0.f ? 1.f / lf : 0.f; }
    f32x16 Oc[2], imp[4];
#pragma unroll
    for (int i = 0; i < 16; ++i) { Oc[0][i] = 0.f; Oc[1][i] = 0.f; imp[0][i] = 0.f; imp[1][i] = 0.f; imp[2][i] = 0.f; imp[3][i] = 0.f; }
    {   st_load(kcp, vcp, soffc, kr, vr); st_write(lds, skey, sch, kr, vr); __syncthreads();
#pragma unroll 1
        for (int kt = 0; kt < nsc; ++kt) {
            const LAS unsigned char* cur = lds + (kt & 1) * DBUF_BYTES; LAS unsigned char* nxt = lds + ((kt + 1) & 1) * DBUF_BYTES;
            if (kt + 1 < nsc) st_load(kcp, vcp, soffc + (unsigned)(kt + 1) * 8192u, kr, vr);
#pragma unroll
            for (int tt = 0; tt < 2; ++tt) {
                f32x16 S; qk32z(cur + kboff + tt * 32 * DK_STR, qf, S); mask_bias_cmp32(S, t, kt * 64 + tt * 32, hh, b2h, mf);
#pragma unroll
                for (int i = 0; i < 16; ++i) S[i] = __builtin_amdgcn_exp2f(S[i]) * inv;
                bf16x8 pk[2]; pk[0] = pack_half(S, 0); pk[1] = pack_half(S, 1);
                pv32(cur + vboff + tt * 32 * DV_STR, pk, Oc);
                const int Tq = (2 * kt + tt) & 3, MB = (2 * kt + tt) >> 2;
#pragma unroll
                for (int s2 = 0; s2 < 2; ++s2) { u32x4 aw; unsigned e[8];
#pragma unroll
                    for (int jj = 0; jj < 8; ++jj) { const int kk = 16 * s2 + 8 * (jj >> 2) + 4 * hh + (jj & 3); const int delta = 32 * Tq + kk - 4 * col;
                        e[jj] = (delta == -1 || delta == 3) ? 0x3F80u : ((unsigned)delta <= 2u ? 0x4000u : 0u); }
                    aw.x = e[0] | (e[1] << 16); aw.y = e[2] | (e[3] << 16); aw.z = e[4] | (e[5] << 16); aw.w = e[6] | (e[7] << 16);
                    const bf16x8 af = __builtin_bit_cast(bf16x8, aw);
                    if (MB == 0) imp[0] = MFMA32(af, pk[s2], imp[0]); else if (MB == 1) imp[1] = MFMA32(af, pk[s2], imp[1]); else if (MB == 2) imp[2] = MFMA32(af, pk[s2], imp[2]); else imp[3] = MFMA32(af, pk[s2], imp[3]); }
                if (Tq == 3 && MB < 3) { u32x4 aw; aw.x = 0u; aw.y = 0u; aw.z = 0u; aw.w = (lane == 32) ? 0x3F800000u : 0u;
                    const bf16x8 af = __builtin_bit_cast(bf16x8, aw);
                    if (MB == 0) imp[1] = MFMA32(af, pk[1], imp[1]); else if (MB == 1) imp[2] = MFMA32(af, pk[1], imp[2]); else imp[3] = MFMA32(af, pk[1], imp[3]); }
            }
            if (kt + 1 < nsc) st_write(nxt, skey, sch, kr, vr);
            __syncthreads();
        }
    }
    unsigned ocp[2][8];
#pragma unroll
    for (int db = 0; db < 2; ++db)
#pragma unroll
        for (int i = 0; i < 8; ++i) ocp[db][i] = cvtpk(Oc[db][2 * i], Oc[db][2 * i + 1]);
    unsigned sm0 = 0u, sm1 = 0u, sm2 = 0u, sm3 = 0u;
    {   const int cur_t = t >> 6; unsigned key[16];
#pragma unroll
        for (int i = 0; i < 16; ++i) {
            float v0 = imp[0][i], v1 = imp[1][i], v2 = imp[2][i], v3 = imp[3][i];
            v0 += xshfl<1>(v0); v0 += xshfl<2>(v0); v1 += xshfl<1>(v1); v1 += xshfl<2>(v1); v2 += xshfl<1>(v2); v2 += xshfl<2>(v2); v3 += xshfl<1>(v3); v3 += xshfl<2>(v3);
            const float val = head == 0 ? v0 : (head == 1 ? v1 : (head == 2 ? v2 : v3));
            const int j = 32 * head + crow(i, hh);
            const bool forced = (j == 0) || (j == cur_t) || (j == cur_t - 1);
            unsigned fx = (unsigned)(fminf(fmaxf(val, 0.f), 31.f) * 1048576.f) + 1u;
            fx = forced ? 0x1FFFFFFu : (j <= cur_t ? fx : 0u);
            key[i] = (fx << 7) | (unsigned)(127 - j); }
#pragma unroll 1
        for (int r = 0; r < 16; ++r) {
            unsigned w = key[0];
#pragma unroll
            for (int i = 1; i < 16; ++i) w = w > key[i] ? w : key[i];
            { unsigned o = (unsigned)xshfl_i<1>((int)w); w = w > o ? w : o; o = (unsigned)xshfl_i<2>((int)w); w = w > o ? w : o; o = (unsigned)xshfl_i<32>((int)w); w = w > o ? w : o; }
            if ((w >> 7) != 0u) { const int j = 127 - (int)(w & 127u); const unsigned bit = 1u << (j & 31); const int jb = j >> 5;
                sm0 |= (jb == 0) ? bit : 0u; sm1 |= (jb == 1) ? bit : 0u; sm2 |= (jb == 2) ? bit : 0u; sm3 |= (jb == 3) ? bit : 0u; }
#pragma unroll
            for (int i = 0; i < 16; ++i) key[i] = (key[i] == w) ? 0u : key[i];
        }
    }
    f32x16 Ow[2]; float lw = 0.f;
#pragma unroll
    for (int i = 0; i < 16; ++i) { Ow[0][i] = 0.f; Ow[1][i] = 0.f; }
    {   f32x16 negm;
#pragma unroll
        for (int i = 0; i < 16; ++i) negm[i] = 120.f;
        const GAS unsigned char* kwp = (const GAS unsigned char*)(proj + rowb * PLD + C_KW); const GAS unsigned char* vwp = (const GAS unsigned char*)(proj + rowb * PLD + C_VW);
        const unsigned soffp = (unsigned)(skey * PLD + sch * 8) * 2u;
        const int s0 = (u < 8) ? 8 - u : 0;
        st_load(kwp, vwp, soffp + (unsigned)(u - 8 + s0) * (64u * PLD * 2u), kr, vr); st_write(lds, skey, sch, kr, vr); __syncthreads();
#pragma unroll 1
        for (int s = s0; s < 9; ++s) {
            const int par = (s - s0) & 1; const LAS unsigned char* cur = lds + par * DBUF_BYTES; LAS unsigned char* nxt = lds + (par ^ 1) * DBUF_BYTES;
            if (s + 1 < 9) st_load(kwp, vwp, soffp + (unsigned)(u - 8 + s + 1) * (64u * PLD * 2u), kr, vr);
            {   f32x16 S[2]; qk64(cur, kboff, qf, negm, S);
                if (s == 0 || s >= 6) mask_bias(S, t, (u - 8 + s) * 64, hh, 512, true, b2h);
                bf16x8 pk[2][2]; softmax_step(S, Ow, negm, lw, pk); pv64(cur, vboff, pk, Ow); }
            if (s + 1 < 9) st_write(nxt, skey, sch, kr, vr);
            __syncthreads();
        }
    }
    unsigned owp[2][8];
#pragma unroll
    for (int db = 0; db < 2; ++db)
#pragma unroll
        for (int i = 0; i < 8; ++i) owp[db][i] = cvtpk(Ow[db][2 * i], Ow[db][2 * i + 1]);
    f32x16 Os[2]; float lsel = 0.f;
#pragma unroll
    for (int i = 0; i < 16; ++i) { Os[0][i] = 0.f; Os[1][i] = 0.f; }
    {   f32x16 negm;
#pragma unroll
        for (int i = 0; i < 16; ++i) negm[i] = 120.f;
        const GAS unsigned char* ksp = (const GAS unsigned char*)(proj + rowb * PLD + C_KS); const GAS unsigned char* vsp = (const GAS unsigned char*)(proj + rowb * PLD + C_VS);
        const unsigned soffp = (unsigned)(skey * PLD + sch * 8) * 2u;
        st_load(ksp, vsp, soffp, kr, vr); st_write(lds, skey, sch, kr, vr); __syncthreads();
#pragma unroll 1
        for (int j = 0; j <= u; ++j) {
            const LAS unsigned char* cur = lds + (j & 1) * DBUF_BYTES; LAS unsigned char* nxt = lds + ((j + 1) & 1) * DBUF_BYTES;
            if (j + 1 <= u) st_load(ksp, vsp, soffp + (unsigned)(j + 1) * (64u * PLD * 2u), kr, vr);
            const int jb = j >> 5; const unsigned smw = jb == 0 ? sm0 : (jb == 1 ? sm1 : (jb == 2 ? sm2 : sm3));
            const bool bit = ((smw >> (j & 31)) & 1u) != 0u;
            if (__builtin_amdgcn_ballot_w64(bit) != 0ull) {
                f32x16 S[2]; qk64(cur, kboff, qf, negm, S);
                if (64 * j + 63 > tw0 - 113) mask_bias(S, t, 64 * j, hh, 1 << 30, bit, b2h);
                else if (!bit) {
#pragma unroll
                    for (int i = 0; i < 16; ++i) { S[0][i] = -1e30f; S[1][i] = -1e30f; } }
                bf16x8 pk[2][2]; softmax_step(S, Os, negm, lsel, pk); pv64(cur, vboff, pk, Os); }
            if (j + 1 <= u) st_write(nxt, skey, sch, kr, vr);
            __syncthreads();
        }
    }
    {   const float lwt = lw + xshfl<32>(lw), lst = lsel + xshfl<32>(lsel);
        const GAS bf16* gp = proj + (rowb + t) * PLD + C_DG + head * 3;
        const float g0 = sigmoidf_(bf2f(gp[0])), g1 = sigmoidf_(bf2f(gp[1])) / fmaxf(lst, 1e-30f), g2 = sigmoidf_(bf2f(gp[2])) / fmaxf(lwt, 1e-30f);
        GAS bf16* op = ys + (rowb + t) * 1024 + 768 + head * 64;
#pragma unroll
        for (int db = 0; db < 2; ++db)
#pragma unroll
            for (int gq = 0; gq < 4; ++gq) { const int d0 = 32 * db + 8 * gq + 4 * hh; float y[4];
#pragma unroll
                for (int e = 0; e < 4; ++e) { const unsigned cw = ocp[db][2 * gq + (e >> 1)], ww = owp[db][2 * gq + (e >> 1)];
                    y[e] = g0 * ((e & 1) ? hi_bf(cw) : lo_bf(cw)) + g1 * Os[db][4 * gq + e] + g2 * ((e & 1) ? hi_bf(ww) : lo_bf(ww)); }
                u32x2 w; w.x = cvtpk(y[0], y[1]); w.y = cvtpk(y[2], y[3]); *(GAS u32x2*)(op + d0) = w; }
    }
}


DI void swa_unit(const GAS bf16* proj, GAS bf16* ys, LAS unsigned char* lds, const LAS float* bias2, const LAS float* biasd, const GAS float* sinks, int b, int u, int tid_in, int lane_in, int wave_in) {
    int tid = tid_in, lane = lane_in, wave = wave_in; asm volatile("" : "+v"(tid), "+v"(lane), "+s"(wave));
    const int t0 = u * 64; const int col = lane & 31, hh = lane >> 5, tl = col >> 1, kv = wave & 1, head = 2 * kv + (col & 1);
    const int t = t0 + (wave >> 1) * 16 + tl;
    const size_t rowb = (size_t)b * SEQ;
    const LAS float* b2h = bias2 + head;
    bf16x8 qf[4];
    { const float SC = 0.125f * 1.4426950408889634f; const GAS bf16* qp = proj + (rowb + t) * PLD + C_BQ + head * 64 + hh * 8;
#pragma unroll
      for (int s = 0; s < 4; ++s) { const u32x4 w = *(const GAS u32x4*)(qp + s * 16); u32x4 o;
          o.x = cvtpk(lo_bf(w.x) * SC, hi_bf(w.x) * SC); o.y = cvtpk(lo_bf(w.y) * SC, hi_bf(w.y) * SC); o.z = cvtpk(lo_bf(w.z) * SC, hi_bf(w.z) * SC); o.w = cvtpk(lo_bf(w.w) * SC, hi_bf(w.w) * SC);
          qf[s] = __builtin_bit_cast(bf16x8, o); } }
    const int skey = tid >> 3, sch = tid & 7;
    const int i16 = lane & 15, blk = (lane >> 4) & 1;
    const int kboff = kv * DBUF_BYTES + col * DK_STR + hh * 16;
    const int vboff = kv * DBUF_BYTES + 64 * DK_STR + (4 * hh + (i16 >> 2)) * DV_STR + (16 * blk + 4 * (i16 & 3)) * 2;
    const GAS unsigned char* kp = (const GAS unsigned char*)(proj + rowb * PLD + C_BK); const GAS unsigned char* vp = (const GAS unsigned char*)(proj + rowb * PLD + C_BV);
    const unsigned soffp = (unsigned)(skey * PLD + sch * 8) * 2u;
    u32x4 k0, v0, k1, v1;
    f32x16 O[2], negm; float lsum = 0.f;
#pragma unroll
    for (int i = 0; i < 16; ++i) { O[0][i] = 0.f; O[1][i] = 0.f; negm[i] = 120.f; }
    const int s0 = (u < 2) ? 2 - u : 0;
    { const unsigned so = soffp + (unsigned)(u - 2 + s0) * (64u * PLD * 2u); st_load(kp, vp, so, k0, v0); st_load(kp + 128, vp + 128, so, k1, v1);
      st_write(lds, skey, sch, k0, v0); st_write(lds + DBUF_BYTES, skey, sch, k1, v1); }
    __syncthreads();
#pragma unroll 1
    for (int s = s0; s < 3; ++s) {
        const int par = (s - s0) & 1; const LAS unsigned char* cur = lds + par * 2 * DBUF_BYTES; LAS unsigned char* nxt = lds + (par ^ 1) * 2 * DBUF_BYTES;
        if (s + 1 < 3) { const unsigned so = soffp + (unsigned)(u - 2 + s + 1) * (64u * PLD * 2u); st_load(kp, vp, so, k0, v0); st_load(kp + 128, vp + 128, so, k1, v1); }
        {   f32x16 S[2]; qk64(cur, kboff, qf, negm, S);
            mask_bias(S, t, (u - 2 + s) * 64, hh, 128, true, b2h);
            bf16x8 pk[2][2]; softmax_step(S, O, negm, lsum, pk); pv64(cur, vboff, pk, O); }
        if (s + 1 < 3) { st_write(nxt, skey, sch, k0, v0); st_write(nxt + DBUF_BYTES, skey, sch, k1, v1); }
        __syncthreads();
    }
    {   const float sinkp = (sinks[head] - biasd[128 * 12 + head]) * 1.4426950408889634f;
        const float lt = lsum + xshfl<32>(lsum) + __builtin_amdgcn_exp2f(sinkp + negm[0]);
        const float inv = 1.f / fmaxf(lt, 1e-30f);
        GAS bf16* op = ys + (rowb + t) * 1024 + 256 + head * 64;
#pragma unroll
        for (int db = 0; db < 2; ++db)
#pragma unroll
            for (int gq = 0; gq < 4; ++gq) { const int d0 = 32 * db + 8 * gq + 4 * hh;
                u32x2 w; w.x = cvtpk(O[db][4 * gq + 0] * inv, O[db][4 * gq + 1] * inv); w.y = cvtpk(O[db][4 * gq + 2] * inv, O[db][4 * gq + 3] * inv); *(GAS u32x2*)(op + d0) = w; }
    }
}

DI void route_row(const KA& a, int l, bf16* xr, int tok, int lane_) {
    int lane = lane_; asm volatile("" : "+v"(lane));
    const float* xrow = a.out + (size_t)tok * 1024; const float* g = a.in[28] + (size_t)l * 1024;
    f32x4 v[4]; float ss = 0.f;
#pragma unroll
    for (int j = 0; j < 4; ++j) { v[j] = *(const f32x4*)(xrow + 4 * (lane + 64 * j)); ss += (v[j][0] * v[j][0] + v[j][1] * v[j][1]) + (v[j][2] * v[j][2] + v[j][3] * v[j][3]); }
    const float r = 1.f / sqrtf(wave_sum(ss) * (1.f / 1024.f) + 1e-6f);
#pragma unroll
    for (int j = 0; j < 4; ++j) { const int k0 = 4 * (lane + 64 * j); const f32x4 gv = *(const f32x4*)(g + k0); const f32x4 xn = v[j] * r * gv;
        unsigned hi[4]; float lo[4];
#pragma unroll
        for (int e = 0; e < 4; ++e) { hi[e] = f2bf(xn[e]); lo[e] = xn[e] - __builtin_bit_cast(float, hi[e] << 16); }
        u32x2 wh, wl; wh.x = hi[0] | (hi[1] << 16); wh.y = hi[2] | (hi[3] << 16); wl.x = pk2(lo[0], lo[1]); wl.y = pk2(lo[2], lo[3]);
        *(u32x2*)(xr + (size_t)tok * 2048 + k0) = wh; *(u32x2*)(xr + (size_t)tok * 2048 + 1024 + k0) = wl; }
}
struct SchedRoute { const char* A; const char* B; int pm;
    DI bool next(int i, Unit& u) const { if (i > 0) return false; u.pm = pm; u.pn = 0; u.aux = 0; u.pad = 0; u.a = A + (size_t)pm * 256 * 2048 * 2; u.b = B; return true; } };
struct EpiRoute { float* rlog;
    DI void operator()(const f32x4 (&acc)[2][2][4][2], const Unit& u, int wr, int wc, int fr, int fq) const {
        const int row0 = u.pm * 256 + wr * 64 + fr; const int col = wc * 32 + 8 * fq;
#pragma unroll
        for (int ai = 0; ai < 2; ++ai)
#pragma unroll
            for (int m = 0; m < 4; ++m) { float* rp = rlog + (size_t)(row0 + ai * 128 + m * 16) * 128 + col; *(f32x4*)rp = acc[ai][0][m][0]; *(f32x4*)(rp + 4) = acc[ai][0][m][1]; }
    }
};
DI void route_decide(const KA& a, int l, const float* rl_row, int* rec_e, int* rec_slot, float* rec_w, unsigned* cnt, int tok) {
    float lg[36];
    const float* bg = a.in[30] + l * 4; const float* be = a.in[32] + l * 32;
#pragma unroll
    for (int q = 0; q < 9; ++q) { const f32x4 h = *(const f32x4*)(rl_row + 4 * q), lo = *(const f32x4*)(rl_row + 64 + 4 * q);
        lg[4 * q + 0] = h[0] + lo[0]; lg[4 * q + 1] = h[1] + lo[1]; lg[4 * q + 2] = h[2] + lo[2]; lg[4 * q + 3] = h[3] + lo[3]; }
#pragma unroll
    for (int i = 0; i < 4; ++i) lg[i] += bg[i];
#pragma unroll
    for (int i = 0; i < 32; ++i) lg[4 + i] += be[i];
    int gsel = 0; float gm = lg[0];
#pragma unroll
    for (int i = 1; i < 4; ++i) if (lg[i] > gm) { gm = lg[i]; gsel = i; }
    float gs = 0.f;
#pragma unroll
    for (int i = 0; i < 4; ++i) gs += __expf(lg[i] - gm);
    const float gwt = 1.f / gs;
    float v8[8];
#pragma unroll
    for (int i = 0; i < 8; ++i) { float x = lg[4 + i];
#pragma unroll
        for (int gq = 1; gq < 4; ++gq) x = (gsel == gq) ? lg[4 + gq * 8 + i] : x;
        v8[i] = x; }
    int i0 = 0; float m0 = v8[0];
#pragma unroll
    for (int i = 1; i < 8; ++i) if (v8[i] > m0) { m0 = v8[i]; i0 = i; }
    int i1 = -1; float m1 = -3e38f;
#pragma unroll
    for (int i = 0; i < 8; ++i) if (i != i0 && v8[i] > m1) { m1 = v8[i]; i1 = i; }
    const float w0 = 1.f / (1.f + __expf(m1 - m0)); const float w1 = 1.f - w0;
    const int e0 = gsel * 8 + i0, e1 = gsel * 8 + i1;
    const unsigned s0 = __hip_atomic_fetch_add(cnt + e0, 1u, __ATOMIC_RELAXED, __HIP_MEMORY_SCOPE_AGENT);
    const unsigned s1 = __hip_atomic_fetch_add(cnt + e1, 1u, __ATOMIC_RELAXED, __HIP_MEMORY_SCOPE_AGENT);
    rec_e[tok * 2] = e0; rec_e[tok * 2 + 1] = e1; rec_slot[tok * 2] = (int)s0; rec_slot[tok * 2 + 1] = (int)s1; rec_w[tok * 2] = w0 * gwt; rec_w[tok * 2 + 1] = w1 * gwt;
}
DI void expert_weights(const KA& a, int l, LAS unsigned char* lds, int it0, int it1, int gw, int NGW, int wave, int lane) {
    LAS float* scr = (LAS float*)(lds + wave * 16384);
    const float* wgt = a.in[33] + (size_t)l * 32 * 1024 * 256; const float* wup = a.in[34] + (size_t)l * 32 * 1024 * 256; const float* wdn = a.in[35] + (size_t)l * 32 * 256 * 1024;
    bf16* Wgu = (bf16*)(a.ws + WS_WGU); bf16* Wd = (bf16*)(a.ws + WS_WD);
    constexpr int I_E = 16 * 8, I_D = 4 * 32;
    constexpr int NIT = 32 * (2 * I_E + I_D);
    (void)NIT;
    for (int it = it0 + gw; it < it1; it += NGW) {
        const int e = it / (2 * I_E + I_D); int r = it % (2 * I_E + I_D);
        if (r < 2 * I_E) { const int up = r / I_E, q = r % I_E, kb = q / 8, nb = q % 8; const int n0 = nb * 32;
            const int drow = (n0 >> 7) * 256 + up * 128 + (n0 & 127);
            transpose_item((up ? wup : wgt) + (size_t)e * 1024 * 256, 256, 256, Wgu + (size_t)e * 512 * 1024, 1024, kb * 64, n0, drow, scr, lane);
        } else { r -= 2 * I_E; const int kb = r / 32, nb = r % 32;
            transpose_item(wdn + (size_t)e * 256 * 1024, 1024, 1024, Wd + (size_t)e * 1024 * 256, 256, kb * 64, nb * 32, nb * 32, scr, lane); }
    }
}
DI void build_offsets(const unsigned* cnt, LAS int* offt, int tid) {
    if (tid == 0) { int o = 0; for (int e = 0; e < 32; ++e) { offt[e] = o; const int c = (int)__hip_atomic_load(cnt + e, __ATOMIC_RELAXED, __HIP_MEMORY_SCOPE_AGENT); o += (c + 255) & ~255; } offt[32] = o; }
    __syncthreads();
    for (int rt = tid; rt < (MOE_ROWS >> 8); rt += 512) { int e = 0; for (int j = 1; j < 32; ++j) e += (offt[j] <= rt * 256) ? 1 : 0; offt[40 + rt] = e; }
    __syncthreads();
}

template <unsigned PM>
__global__ void __launch_bounds__(512, 2) mk_fwd(Args a_) {
    extern __shared__ __attribute__((aligned(16))) unsigned char lds_raw[];
    LAS unsigned char* lds = (LAS unsigned char*)lds_raw;
    const int wave0 = __builtin_amdgcn_readfirstlane((int)threadIdx.x >> 6);
    if (threadIdx.x < 36) ((LAS unsigned long long*)(lds + PTAB_OFF))[threadIdx.x] = (unsigned long long)a_.in[threadIdx.x];
    __syncthreads();
    KA a; a.in.base = (unsigned)(size_t)(lds + PTAB_OFF); a.out = a_.out; a.ws = a_.ws;
    const int G = gridDim.x, bid = blockIdx.x, NGW = G * 8;
#define PHASE_IDS() int wave = wave0; asm volatile("" : "+s"(wave)); const int lane = my_lane(); const int tid_ = wave * 64 + lane, gw = bid * 8 + wave; (void)tid_; (void)gw; \
    KA ap = a; asm volatile("" : "+s"(ap.ws), "+s"(ap.out), "+s"(ap.in.base)); \
    bf16* hb = (bf16*)(ap.ws + WS_HB); bf16* proj = (bf16*)(ap.ws + WS_PROJ); bf16* gates = (bf16*)(ap.ws + WS_GATES); \
    bf16* ys = hb; bf16* x2b = hb; bf16* merged = proj; bf16* eo = proj; \
    bf16* kcb = (bf16*)(ap.ws + WS_KCVC); float* lrusum = (float*)(ap.ws + WS_LRUSUM); \
    int* rec_e = (int*)(ap.ws + WS_REC); int* rec_slot = rec_e + T * 2; float* rec_w = (float*)(rec_slot + T * 2); \
    int* rowtok = (int*)(ap.ws + WS_ROWTOK); float* roww = (float*)(ap.ws + WS_ROWW); \
    bf16* xs = (bf16*)(ap.ws + WS_XS); bf16* hmid = (bf16*)(ap.ws + WS_HMID); unsigned* ctl = (unsigned*)(ap.ws + WS_CTL); \
    (void)hb; (void)proj; (void)gates; (void)ys; (void)x2b; (void)merged; (void)eo; (void)kcb; (void)lrusum; (void)rec_e; (void)rec_slot; (void)rec_w; (void)rowtok; (void)roww; (void)xs; (void)hmid; (void)ctl
    volatile LAS unsigned* MISC = (volatile LAS unsigned*)(lds + MISC_OFF);
    LAS float* biasd = (LAS float*)(lds + BIAS_OFF);
    LAS int* offt = (LAS int*)(lds + OFFT_OFF);
    { PHASE_IDS();
    if (tid_ < 64) MISC[tid_] = 0u;
    for (int i = tid_; i < 129 * 12; i += 512) { const int d = i / 12, hd = i % 12; const int bk = d < 128 ? T5_BUCKET[d] : 31; const float* rb = a.in[1]; biasd[i] = rb[bk * 12 + hd]; ((LAS float*)(lds + BIAS2_OFF))[i] = (rb[bk * 12 + hd] - rb[31 * 12 + hd]) * 1.4426950408889634f; } }
    __syncthreads();
    const int lo = a_.ph_lo, hi = a_.ph_hi;
    XcdBarrier bar; bar.bar = (unsigned*)(a.ws + WS_CTL) + CW_BAR; bar.x = 0; bar.st = nullptr;
    if (hi - lo > 1) { PHASE_IDS(); bar = xcd_barrier_post(ctl + CW_BAR, MISC + 8, tid_ == 0); }
#ifndef SUB_MASK
#define SUB_MASK 0xFFu
#endif
#define SUB(k) ((SUB_MASK >> (k)) & 1u)
#define HASP(k) ((PM >> ((k) % PPL + ((k) >= 2 * PPL ? PPL : 0))) & 1u)
#define IN(k) (HASP(k) && lo <= (k) && (k) < hi)
#define SEAM(k) do { if ((k) + 1 < hi) { const int sl_ = my_lane(); int sw_ = wave0; asm volatile("" : "+s"(sw_)); xcd_barrier(bar, sw_ == 0 && sl_ == 0); } } while (0)
    for (int l = 0; l < DEPTH; ++l) {
        const int pb = l * PPL;
        if (IN(pb + 0)) { PHASE_IDS(); router_weights(ap, l, gw, NGW, lane); cmp_weights(ap, l, lds, gw, NGW, wave, lane); phase0_weights(ap, l, lds, gw, NGW, wave, lane); phase0_rows(ap, l, 0, gw, NGW, lane); SEAM(pb + 0); }
        if (IN(pb + 1)) {
            PHASE_IDS();
            pg8::Gemm g{1024, 1024, 1024, 128}; SchedP1 S{(const char*)hb, (const char*)(ap.ws + WS_WIN), G, bid};
            EpiP1 E{proj, gates, ap.in[25] + (size_t)l * 4096};
            pg8::gemm_phase<EpiP1, SchedP1>(lds, g, S, E, tid_); SEAM(pb + 1);
        }
        if (IN(pb + 2)) {
            PHASE_IDS();
            float s1 = 0.f, s2 = 0.f;
            for (int i = 0; i < 32; ++i) { s1 += ap.in[13][l * 32 + i] * ap.in[14][l * 32 + i]; s2 += ap.in[15][l * 32 + i] * ap.in[16][l * 32 + i]; }
            const float lam_init = 0.8f - 0.6f * __expf(-0.3f * (float)l); const float lam = __expf(s1) - __expf(s2) + lam_init;
            if (SUB(0)) { const LAS float* bias2 = (const LAS float*)(lds + BIAS2_OFF); const GAS float* subg = (const GAS float*)(ap.in[17] + l * 64);
                for (int pi = bid; pi < 256; pi += G) { const int bh = pi >> 4, qlo = pi & 15;
                    diff_unit((const GAS bf16*)proj, (GAS bf16*)ys, lds, bias2, subg, lam, lam_init, bh >> 2, bh & 3, 31 - qlo, tid_, lane, wave);
                    diff_unit((const GAS bf16*)proj, (GAS bf16*)ys, lds, bias2, subg, lam, lam_init, bh >> 2, bh & 3, qlo, tid_, lane, wave); } }
            if (SUB(3)) { __syncthreads(); const LAS float* bias2 = (const LAS float*)(lds + BIAS2_OFF); const GAS float* sinks = (const GAS float*)(ap.in[12] + l * 4);
                for (int pi = bid; pi < 512; pi += G) swa_unit((const GAS bf16*)proj, (GAS bf16*)ys, lds, bias2, biasd, sinks, pi >> 7, pi & 127, tid_, lane, wave); }
            if (SUB(2)) { pg8::Gemm g{1024, 16 * PLD, 1024, PLD * 2}; SchedCmp S{(const char*)proj, (const char*)(ap.ws + WS_WCMP), G, bid}; EpiCmp E{(float*)(ap.ws + WS_CMPAB)};
                pg8::gemm_phase<EpiCmp, SchedCmp>(lds, g, S, E, tid_); }
            if (SUB(1)) for (int task = wave * G + bid; task < 512; task += 8 * G) lru_task(ap, l, proj, ys, lrusum, task, lane, false);
            SEAM(pb + 2);
        }
        if (IN(pb + 3)) {
            PHASE_IDS();
            for (int task = gw; task < 2 * BATCH * NCMP; task += NGW) cmp_finish(ap, l, (const float*)(ap.ws + WS_CMPAB), kcb, task, lane);
            SEAM(pb + 3);
        }
        if (IN(pb + 4)) {
            PHASE_IDS();
            if (SUB(4)) { const LAS float* bias2 = (const LAS float*)(lds + BIAS2_OFF);
                for (int pi = bid; pi < 256; pi += G) { const int bb = pi >> 6, ulo = pi & 63;
                    nsa_unit((const GAS bf16*)proj, (GAS bf16*)ys, (const GAS bf16*)kcb, lds, bias2, bb, 127 - ulo, tid_, lane, wave);
                    nsa_unit((const GAS bf16*)proj, (GAS bf16*)ys, (const GAS bf16*)kcb, lds, bias2, bb, ulo, tid_, lane, wave); } }
            if (SUB(1)) for (int task = wave * G + bid; task < 512; task += 8 * G) lru_task(ap, l, proj, ys, lrusum, task, lane, true);
            SEAM(pb + 4);
        }
        if (IN(pb + 5)) {
            PHASE_IDS();
            pg8::Gemm g{256, 1024, 256, 128}; SchedP3a S{(const char*)ys, (const char*)(ap.ws + WS_WBR), G, bid};
            EpiP3a E{merged, gates};
            pg8::gemm_phase<EpiP3a, SchedP3a>(lds, g, S, E, tid_); SEAM(pb + 5);
        }
        if (IN(pb + 6)) {
            PHASE_IDS();
            pg8::Gemm g{1024, 1024, 1024, 128}; SchedP3b S{(const char*)merged, (const char*)(ap.ws + WS_WOUT), G, bid};
            EpiP3b E{(l == 0) ? ap.in[0] : ap.out, ap.out};
            pg8::gemm_phase<EpiP3b, SchedP3b>(lds, g, S, E, tid_); SEAM(pb + 6);
        }
        if (IN(pb + 7)) {
            PHASE_IDS();
            bf16* xr = (bf16*)(ap.ws + WS_XR); float* rlog = (float*)(ap.ws + WS_RLOG);
            constexpr int NITW = 32 * (2 * 16 * 8 + 4 * 32);
            constexpr int NITA = (NITW * 2) / 3;
            if (bid < 128) {
                for (int r = wave; r < 256; r += 8) route_row(ap, l, xr, bid * 256 + r, lane);
                asm volatile("s_waitcnt vmcnt(0)" ::: "memory"); __syncthreads();
                { pg8::Gemm g{2048, 2048, 2048, 128}; SchedRoute S{(const char*)xr, (const char*)(ap.ws + WS_WR), bid}; EpiRoute E{rlog};
                  pg8::gemm_phase<EpiRoute, SchedRoute>(lds, g, S, E, tid_); }
                asm volatile("s_waitcnt vmcnt(0)" ::: "memory"); __syncthreads();
                if (tid_ < 256) route_decide(ap, l, rlog + (size_t)(bid * 256 + tid_) * 128, rec_e, rec_slot, rec_w, ctl + CW_CNT + l * 32, bid * 256 + tid_);
                __syncthreads();
                expert_weights(ap, l, lds, NITA, NITW, gw, 128 * 8, wave, lane);
            } else {
                expert_weights(ap, l, lds, 0, NITA, gw - 128 * 8, NGW - 128 * 8, wave, lane);
            }
            SEAM(pb + 7);
        }
        if (IN(pb + 8)) {
            PHASE_IDS();
            build_offsets(ctl + CW_CNT + l * 32, offt, tid_);
            if (bid < 32) { const int e = bid; const int c = (int)__hip_atomic_load(ctl + CW_CNT + l * 32 + e, __ATOMIC_RELAXED, __HIP_MEMORY_SCOPE_AGENT);
                for (int p = offt[e] + c + tid_; p < offt[e + 1]; p += 512) rowtok[p] = -1; }
            for (int tok = gw; tok < T; tok += NGW) {
#pragma unroll
                for (int k = 0; k < 2; ++k) { const int e = rec_e[tok * 2 + k], slot = rec_slot[tok * 2 + k]; const int pos = offt[e] + slot;
                    const bf16* xr = (const bf16*)(ap.ws + WS_XR); const u32x4 v0 = *(const u32x4*)(xr + (size_t)tok * 2048 + lane * 8), v1 = *(const u32x4*)(xr + (size_t)tok * 2048 + 512 + lane * 8);
                    *(u32x4*)(xs + (size_t)pos * 1024 + lane * 8) = v0; *(u32x4*)(xs + (size_t)pos * 1024 + 512 + lane * 8) = v1;
                    if (lane == 0) { rowtok[pos] = tok * 2 + k; roww[pos] = rec_w[tok * 2 + k]; } } }
            SEAM(pb + 8);
        }
        if (IN(pb + 9)) {
            PHASE_IDS();
            build_offsets(ctl + CW_CNT + l * 32, offt, tid_);
            pg8::Gemm g{1024, 1024, 1024, 128}; SchedM2 S{(const char*)xs, (const char*)(ap.ws + WS_WGU), offt, G, bid};
            EpiM2 E{hmid};
            pg8::gemm_phase<EpiM2, SchedM2>(lds, g, S, E, tid_); SEAM(pb + 9);
        }
        if (IN(pb + 10)) {
            PHASE_IDS();
            build_offsets(ctl + CW_CNT + l * 32, offt, tid_);
            pg8::Gemm g{256, 256, 256, 128}; SchedM3 S{(const char*)hmid, (const char*)(ap.ws + WS_WD), offt, G, bid};
            EpiM3 E{eo, rowtok, roww};
            pg8::gemm_phase<EpiM3, SchedM3>(lds, g, S, E, tid_); SEAM(pb + 10);
        }
    }
    if (IN(2 * PPL)) { PHASE_IDS(); phase0_rows(ap, DEPTH, 1, gw, NGW, lane); }
#undef IN
#undef SEAM
}

typedef void (*kern_t)(Args);
template <unsigned PM> static bool setup_kernel() {
    if (hipFuncSetAttribute((const void*)mk_fwd<PM>, hipFuncAttributeMaxDynamicSharedMemorySize, LDS_BYTES) != hipSuccess) { fprintf(stderr, "kernel_launch: hipFuncSetAttribute failed\n"); return false; }
    return true;
}
extern "C" void kernel_launch(void* const* d_in, const int* in_sizes, int n_in, void* d_out, int out_size, void* d_ws, size_t ws_size, hipStream_t stream) {
    static int grid = 0;
    if (grid == 0) {
        if (n_in != 36 || out_size != T * D || ws_size < WS_END) { fprintf(stderr, "kernel_launch: unexpected shapes (n_in %d out %d ws %zu)\n", n_in, out_size, ws_size); grid = -1; return; }
        int dev = 0, cus = 0;
        if (hipGetDevice(&dev) != hipSuccess || hipDeviceGetAttribute(&cus, hipDeviceAttributeMultiprocessorCount, dev) != hipSuccess) { grid = -1; return; }
        bool ok = true;
#if MK_ONE_LAUNCH
        ok = setup_kernel<0xFFFu>();
#endif
        if (!ok) { grid = -1; return; }
        (void)hipGetLastError();
        grid = cus;
    }
    if (grid < 0) return;
    if (hipMemsetAsync((char*)d_ws + WS_CTL, 0, CTL_ZERO_BYTES, stream) != hipSuccess) return;
    Args a{};
    for (int i = 0; i < 36; ++i) a.in[i] = (const float*)d_in[i];
    a.out = (float*)d_out; a.ws = (unsigned char*)d_ws;
#if MK_ONE_LAUNCH
    a.ph_lo = 0; a.ph_hi = NPH;
    hipLaunchKernelGGL(mk_fwd<0xFFFu>, dim3(grid), dim3(512), LDS_BYTES, stream, a);
#endif
}
```

```cpp
#include <hip/hip_runtime.h>
#include <cstdio>
#include <cstdint>

#ifndef MK_ONE_LAUNCH
#define MK_ONE_LAUNCH 1
#endif

#define DI __device__ __forceinline__
#define GAS __attribute__((address_space(1)))
#define LAS __attribute__((address_space(3)))
typedef unsigned short bf16;
typedef short bf16x8 __attribute__((ext_vector_type(8)));
typedef float f32x4 __attribute__((ext_vector_type(4)));
typedef unsigned u32x4 __attribute__((ext_vector_type(4)));
typedef unsigned u32x2 __attribute__((ext_vector_type(2)));
typedef float f32x16 __attribute__((ext_vector_type(16)));
typedef float f32x2 __attribute__((ext_vector_type(2)));
typedef short s16x4 __attribute__((ext_vector_type(4)));
typedef __bf16 bf16x2_t __attribute__((ext_vector_type(2)));
typedef short v4i16_t __attribute__((__vector_size__(4 * sizeof(short))));
#define MFMA32(a, b, c) __builtin_amdgcn_mfma_f32_32x32x16_bf16((a), (b), (c), 0, 0, 0)

constexpr int BATCH = 4, SEQ = 8192, T = BATCH * SEQ, D = 1024, DEPTH = 2;
constexpr int NIN = 2444, PLD = 2560, N1 = 6656, GLD = 4096;
constexpr int C_AX = 0, C_AG = 256, C_BQ = 512, C_BK = 768, C_BV = 896, C_CQ = 1024, C_CK = 1280, C_CV = 1536, C_DQ = 1792,
              C_KC = 2048, C_VC = 2112, C_KS = 2176, C_VS = 2240, C_KW = 2304, C_VW = 2368, C_DG = 2432;
constexpr int NCMP = 511;
constexpr int MOE_ROWS = 73728;
constexpr int PPL = 11;
constexpr int NPH = 2 * PPL + 1;

constexpr size_t MiB = 1u << 20;
constexpr size_t WS_CTL = 0, CTL_ZERO_BYTES = 1 * MiB;
constexpr size_t WS_KCVC = 1 * MiB;
constexpr size_t WS_LRUSUM = 2 * MiB;
constexpr size_t WS_REC = 2 * MiB + 256 * 1024;
constexpr size_t WS_ROWTOK = 3 * MiB;
constexpr size_t WS_ROWW = 3 * MiB + 512 * 1024;
constexpr size_t WS_WIN = 4 * MiB;
constexpr size_t WS_WBR = 17 * MiB;
constexpr size_t WS_WOUT = 19 * MiB;
constexpr size_t WS_HB = 21 * MiB;
constexpr size_t WS_PROJ = 85 * MiB;
constexpr size_t WS_GATES = 245 * MiB;
constexpr size_t WS_WGU = 245 * MiB;
constexpr size_t WS_WD = 277 * MiB;
constexpr size_t WS_XS = 293 * MiB;
constexpr size_t WS_HMID = 437 * MiB;
constexpr size_t WS_XR = 85 * MiB;
constexpr size_t WS_RLOG = 213 * MiB;
constexpr size_t WS_WR = 501 * MiB;
constexpr size_t WS_WCMP = 502 * MiB;
constexpr size_t WS_CMPAB = 503 * MiB;
constexpr size_t WS_END = 506 * MiB;
constexpr int CW_BAR = 4096;
constexpr int CW_CNT = 16384;

constexpr int RING_BYTES = 131072;
constexpr int MISC_OFF = RING_BYTES;
constexpr int BIAS_OFF = MISC_OFF + 256;
constexpr int OFFT_OFF = BIAS_OFF + 129 * 12 * 4;
constexpr int PTAB_OFF = OFFT_OFF + (40 + 288) * 4;
constexpr int BIAS2_OFF = PTAB_OFF + 36 * 8;
constexpr int LRUEX_OFF = BIAS2_OFF + 129 * 12 * 4;
constexpr int LDS_BYTES = 163840;
static_assert(PTAB_OFF % 8 == 0 && LRUEX_OFF + 8 * 64 * 2 * 4 <= LDS_BYTES, "LDS map");

DI float bf2f(bf16 v) { return __builtin_bit_cast(float, (unsigned)v << 16); }
DI float lo_bf(unsigned w) { return __builtin_bit_cast(float, w << 16); }
DI float hi_bf(unsigned w) { return __builtin_bit_cast(float, w & 0xffff0000u); }
DI unsigned f2bf(float f) { unsigned u = __builtin_bit_cast(unsigned, f); return (u + 0x7fffu + ((u >> 16) & 1u)) >> 16; }
DI unsigned pk2(float lo, float hi) { return f2bf(lo) | (f2bf(hi) << 16); }
DI float rl(float v, int i) { return __builtin_bit_cast(float, __builtin_amdgcn_readlane(__builtin_bit_cast(int, v), i)); }
DI int rli(int v, int i) { return __builtin_amdgcn_readlane(v, i); }
DI int my_lane() { int l; asm volatile("v_mbcnt_lo_u32_b32 %0, -1, 0\n\tv_mbcnt_hi_u32_b32 %0, -1, %0" : "=v"(l)); return l; }
template <int O> DI int xshfl_i(int v) {
    if constexpr (O < 32) return __builtin_amdgcn_ds_swizzle(v, (O << 10) | 0x1f);
    else { const int l = my_lane(); return __builtin_amdgcn_ds_bpermute((l ^ 32) << 2, v); }
}
template <int O> DI float xshfl(float v) { return __builtin_bit_cast(float, xshfl_i<O>(__builtin_bit_cast(int, v))); }
DI float wave_sum(float v) { v += xshfl<1>(v); v += xshfl<2>(v); v += xshfl<4>(v); v += xshfl<8>(v); v += xshfl<16>(v); v += xshfl<32>(v); return v; }
DI float wave_max(float v) { v = fmaxf(v, xshfl<1>(v)); v = fmaxf(v, xshfl<2>(v)); v = fmaxf(v, xshfl<4>(v)); v = fmaxf(v, xshfl<8>(v)); v = fmaxf(v, xshfl<16>(v)); v = fmaxf(v, xshfl<32>(v)); return v; }
DI float sigmoidf_(float x) { return 1.f / (1.f + __expf(-x)); }
DI float gelu_tanh(float x) { const float u = 0.7978845608028654f * (x + 0.044715f * x * x * x); const float e = __expf(2.f * u); const float th = 1.f - 2.f / (e + 1.f); return 0.5f * x * (1.f + th); }
DI float softplusf_(float x) { return fmaxf(x, 0.f) + log1pf(__expf(-fabsf(x))); }
#define LDS_WAIT() asm volatile("s_waitcnt lgkmcnt(0)" ::: "memory")
#define VM_WAIT() asm volatile("s_waitcnt vmcnt(0)" ::: "memory")

__device__ const unsigned char T5_BUCKET[128] = {
0,1,2,3,4,5,6,7,8,9,10,11,12,13,14,15,16,16,16,17,17,18,18,18,19,19,19,20,20,20,20,21,21,21,21,22,22,22,22,22,23,23,23,23,23,23,24,24,24,24,24,24,25,25,25,25,25,25,25,26,26,26,26,26,26,26,26,27,27,27,27,27,27,27,27,27,27,28,28,28,28,28,28,28,28,28,28,29,29,29,29,29,29,29,29,29,29,29,29,30,30,30,30,30,30,30,30,30,30,30,30,30,30,31,31,31,31,31,31,31,31,31,31,31,31,31,31,31};

#define XB_TMO      128
#define XB_XCNT(j)  (256  + 64 * (j))
#define XB_XSUB(j)  (1280 + 64 * (j))
#define XB_XGEN(j)  (2304 + 64 * (j))
#define XB_TOP      3328
#define XB_TOPGEN   3392
#define XCD_BAR_WORDS 3456
#define XB_SPIN_CAP (1u << 22)
DI unsigned xb_ld(unsigned* p)              { return __hip_atomic_load(p, __ATOMIC_RELAXED, __HIP_MEMORY_SCOPE_AGENT); }
DI unsigned xb_add(unsigned* p, unsigned v) { return __hip_atomic_fetch_add(p, v, __ATOMIC_RELAXED, __HIP_MEMORY_SCOPE_AGENT); }
DI unsigned xb_xcc_id() { return (unsigned)__builtin_amdgcn_s_getreg((3 << 11) | 20) & 0xFu; }
#define XB_SPIN(cond, bar) do { unsigned _sp = 0; while (cond) { __builtin_amdgcn_s_sleep(1); \
    if ((++_sp & 255u) == 0u) { if (xb_ld(&(bar)[XB_TMO])) break; if (_sp > XB_SPIN_CAP) { atomicAdd(&(bar)[XB_TMO], 1u); break; } } } } while (0)
struct XcdBarrier { unsigned* bar; unsigned x; volatile LAS unsigned* st; };
DI XcdBarrier xcd_barrier_post(unsigned* bar, volatile LAS unsigned* st, bool leader) {
    XcdBarrier b; b.bar = bar; b.x = xb_xcc_id(); b.st = st;
    if (leader) (void)xb_add(&bar[XB_XCNT(b.x)], 1u);
    return b;
}
DI void xcd_barrier_complete(unsigned* bar, unsigned x, unsigned& nloc, unsigned& nx) {
    const unsigned G = gridDim.x * gridDim.y * gridDim.z;
    unsigned sum, cnt, mine, sp = 0u;
    for (;;) {
        sum = 0u; cnt = 0u; mine = 0u;
#pragma unroll
        for (unsigned j = 0; j < 16; ++j) { const unsigned c = xb_ld(&bar[XB_XCNT(j)]); sum += c; cnt += (c > 0u) ? 1u : 0u; mine = (j == x) ? c : mine; }
        if (sum == G) break;
        __builtin_amdgcn_s_sleep(1);
        if ((++sp & 255u) == 0u) { if (xb_ld(&bar[XB_TMO])) break; if (sp > XB_SPIN_CAP) { atomicAdd(&bar[XB_TMO], 1u); break; } }
    }
    nloc = mine > 0u ? mine : 1u; nx = cnt > 0u ? cnt : 1u;
}
DI void xcd_barrier(const XcdBarrier& b, bool leader) {
    asm volatile("s_waitcnt vmcnt(0)" ::: "memory");
    __syncthreads();
    if (leader) {
        unsigned* bar = b.bar;
        __builtin_amdgcn_s_waitcnt(0);
        unsigned nloc = b.st[0], nx = b.st[1];
        if (nloc == 0u) { xcd_barrier_complete(bar, b.x, nloc, nx); b.st[0] = nloc; b.st[1] = nx; }
        const unsigned old = xb_add(&bar[XB_XSUB(b.x)], 1u);
        const unsigned gen = old / nloc;
        if (old + 1u == (gen + 1u) * nloc) {
            __builtin_amdgcn_fence(__ATOMIC_RELEASE, "agent");
            asm volatile("s_waitcnt vmcnt(0)" ::: "memory");
            const unsigned og = xb_add(&bar[XB_TOP], 1u);
            const unsigned tg = og / nx;
            if (og + 1u == (tg + 1u) * nx) xb_add(&bar[XB_TOPGEN], 1u);
            else XB_SPIN(xb_ld(&bar[XB_TOPGEN]) == tg, bar);
            __builtin_amdgcn_fence(__ATOMIC_ACQUIRE, "agent");
            xb_add(&bar[XB_XGEN(b.x)], 1u);
            asm volatile("s_waitcnt vmcnt(0)" ::: "memory");
        } else {
            XB_SPIN(xb_ld(&bar[XB_XGEN(b.x)]) == gen, bar);
            __builtin_amdgcn_fence(__ATOMIC_ACQUIRE, "agent");
            asm volatile("s_waitcnt vmcnt(0)" ::: "memory");
        }
    }
    __syncthreads();
}

namespace pg8 {
constexpr int BM = 256, BK = 64, HALF = 128, HTB = HALF * BK * 2;
__host__ __device__ __forceinline__ int lds_byte(int r, int c) { const int st = (r >> 4) * 2 + (c >> 5), rr = r & 15, cc = c & 31, ob = rr * 64 + cc * 2; return st * 1024 + (ob ^ (((ob >> 9) & 1) << 5)); }
__host__ __device__ __forceinline__ void stage_rc(int b, int& R, int& C) { const int st = b / 1024, sb = b % 1024, swz = sb ^ (((sb >> 9) & 1) << 5); R = (st >> 1) * 16 + swz / 64; C = (st & 1) * 32 + (swz % 64) / 2; }
__host__ __device__ __forceinline__ int perm32(int rho) { const int n = rho >> 4, i = rho & 15; return 8 * (i >> 2) + 4 * n + (i & 3); }
struct Unit { const char* a; const char* b; int pm, pn, aux, pad; };
struct Gemm { int K, lda, ldb, kstepA, hstepA; };
template <class Epi, class Sched>
DI void gemm_phase(LAS unsigned char* lds, const Gemm g, const Sched& S, const Epi& E, int tid_in) {
    int tid = tid_in; asm volatile("" : "+v"(tid));
    const int wid = __builtin_amdgcn_readfirstlane(tid >> 6), lane = tid & 63, wr = wid >> 2, wc = wid & 3, fr = lane & 15, fq = lane >> 4;
    const int K = g.K, nt = K / BK;
    unsigned voffA[2], voffB[2];
#pragma unroll
    for (int i = 0; i < 2; ++i) { int R, C; stage_rc(tid * 16 + i * 8192, R, C); const int Rb = (R & ~31) + perm32(R & 31);
        voffA[i] = (unsigned)(R * g.lda + C) * 2u; voffB[i] = (unsigned)(Rb * g.ldb + C) * 2u; }
    const size_t kstep = (size_t)(BK * 2), kstepA = (size_t)g.kstepA;
    const size_t hstepA = g.hstepA < 0 ? (size_t)HALF * g.lda * 2 : (size_t)g.hstepA, hstepB = (size_t)HALF * g.ldb * 2;
    const unsigned ldsw = (unsigned)wid * 1024u;
    const int aoff = lds_byte(wr * 64 + fr, fq * 8), boff = lds_byte(wc * 32 + fr, fq * 8);
#define PG8_SA(b, h) (((b) * 2 + (h)) * HTB)
#define PG8_SB(b, h) ((4 + (b) * 2 + (h)) * HTB)
#define PG8_STAGE(bufoff, gbase, voff) do { _Pragma("unroll") for (int _i = 0; _i < 2; ++_i) \
        __builtin_amdgcn_global_load_lds((const unsigned*)((const char*)(gbase) + (voff)[_i]), (LAS unsigned*)(lds + (bufoff) + ldsw + _i * 8192), 16, 0, 0); } while (0)
#define PG8_LDA(dst, b, h) do { _Pragma("unroll") for (int m = 0; m < 4; ++m) _Pragma("unroll") for (int k = 0; k < 2; ++k) dst[m][k] = *(const LAS bf16x8*)(lds + PG8_SA(b, h) + aoff + m * 2048 + k * 1024); } while (0)
#define PG8_LDB(dst, b, h) do { _Pragma("unroll") for (int n = 0; n < 2; ++n) _Pragma("unroll") for (int k = 0; k < 2; ++k) dst[n][k] = *(const LAS bf16x8*)(lds + PG8_SB(b, h) + boff + n * 2048 + k * 1024); } while (0)
#define PG8_MMA(ai, bj, At, Bt) do { __builtin_amdgcn_s_setprio(1); _Pragma("unroll") for (int m = 0; m < 4; ++m) _Pragma("unroll") for (int n = 0; n < 2; ++n) _Pragma("unroll") for (int k = 0; k < 2; ++k) \
        acc[ai][bj][m][n] = __builtin_amdgcn_mfma_f32_16x16x32_bf16(Bt[n][k], At[m][k], acc[ai][bj][m][n], 0, 0, 0); __builtin_amdgcn_s_setprio(0); } while (0)
#define PG8_WAIT_V(n) asm volatile("s_waitcnt vmcnt(" #n ")" ::: "memory")
#define PG8_WAIT_L(n) asm volatile("s_waitcnt lgkmcnt(" #n ")" ::: "memory")
#define PG8_BAR __builtin_amdgcn_s_barrier()
#define PG8_SCHED __builtin_amdgcn_sched_barrier(0)
    Unit cur, nxt; int ui = 0;
    if (!S.next(0, cur)) return;
    f32x4 acc[2][2][4][2];
#pragma unroll
    for (int a = 0; a < 2; ++a)
#pragma unroll
        for (int b = 0; b < 2; ++b)
#pragma unroll
            for (int m = 0; m < 4; ++m)
#pragma unroll
                for (int n = 0; n < 2; ++n) acc[a][b][m][n] = (f32x4){0.f, 0.f, 0.f, 0.f};
    bf16x8 At[4][2], B0[2][2], B1[2][2];
    const char* cA = cur.a; const char* cB = cur.b;
    PG8_STAGE(PG8_SB(0, 0), cB, voffB); PG8_STAGE(PG8_SB(0, 1), cB + hstepB, voffB); PG8_STAGE(PG8_SA(0, 0), cA, voffA); PG8_STAGE(PG8_SA(0, 1), cA + hstepA, voffA);
    if (wr == 1) PG8_BAR;
    PG8_WAIT_V(2); PG8_BAR;
    PG8_STAGE(PG8_SB(1, 0), cB + kstep, voffB); PG8_STAGE(PG8_SA(1, 0), cA + kstepA, voffA); PG8_STAGE(PG8_SB(1, 1), cB + hstepB + kstep, voffB);
    PG8_WAIT_V(6); PG8_BAR;
    for (;;) {
        const bool has_next = S.next(ui + 1, nxt);
        const char* nA = has_next ? nxt.a : cA; const char* nB = has_next ? nxt.b : cB;
        for (int t = 0; t < nt; t += 2) {
            const bool last = (t == nt - 2);
            const char* a1 = cA + (size_t)(t + 1) * kstepA;
            const char* a2 = last ? nA : cA + (size_t)(t + 2) * kstepA; const char* b2 = last ? nB : cB + (size_t)(t + 2) * kstep;
            const char* a3 = a2 + kstepA; const char* b3 = b2 + kstep;
            PG8_LDB(B0, 0, 0); PG8_LDB(B1, 0, 1); PG8_SCHED; PG8_LDA(At, 0, 0); PG8_STAGE(PG8_SA(1, 1), a1 + hstepA, voffA);
            PG8_WAIT_V(8); PG8_WAIT_L(0); PG8_BAR; PG8_MMA(0, 0, At, B0); PG8_MMA(0, 1, At, B1); PG8_BAR; PG8_SCHED;
            PG8_LDA(At, 0, 1); PG8_STAGE(PG8_SB(0, 0), b2, voffB); PG8_STAGE(PG8_SB(0, 1), b2 + hstepB, voffB); PG8_STAGE(PG8_SA(0, 0), a2, voffA);
            PG8_WAIT_V(8); PG8_WAIT_L(0); PG8_BAR; PG8_MMA(1, 0, At, B0); PG8_MMA(1, 1, At, B1); PG8_BAR; PG8_SCHED;
            PG8_LDB(B0, 1, 0); PG8_LDB(B1, 1, 1); PG8_SCHED; PG8_LDA(At, 1, 0); PG8_STAGE(PG8_SA(0, 1), a2 + hstepA, voffA);
            PG8_WAIT_V(8); PG8_WAIT_L(0); PG8_BAR; PG8_MMA(0, 0, At, B0); PG8_MMA(0, 1, At, B1); PG8_BAR; PG8_SCHED;
            PG8_LDA(At, 1, 1); PG8_STAGE(PG8_SB(1, 0), b3, voffB); PG8_STAGE(PG8_SB(1, 1), b3 + hstepB, voffB); PG8_STAGE(PG8_SA(1, 0), a3, voffA);
            PG8_WAIT_V(8); PG8_WAIT_L(0); PG8_BAR; PG8_MMA(1, 0, At, B0); PG8_MMA(1, 1, At, B1); PG8_BAR; PG8_SCHED;
        }
        if (wr == 0) PG8_BAR;
        { const int el = my_lane(); E(acc, cur, wr, wc, el & 15, el >> 4); }
        if (!has_next) break;
#pragma unroll
        for (int a = 0; a < 2; ++a)
#pragma unroll
            for (int b = 0; b < 2; ++b)
#pragma unroll
                for (int m = 0; m < 4; ++m)
#pragma unroll
                    for (int n = 0; n < 2; ++n) acc[a][b][m][n] = (f32x4){0.f, 0.f, 0.f, 0.f};
        cur = nxt; cA = nA; cB = nB; ++ui;
        if (wr == 1) PG8_BAR;
    }
    PG8_WAIT_V(0);
    PG8_BAR;
#undef PG8_SA
#undef PG8_SB
#undef PG8_STAGE
#undef PG8_LDA
#undef PG8_LDB
#undef PG8_MMA
#undef PG8_WAIT_V
#undef PG8_WAIT_L
#undef PG8_BAR
#undef PG8_SCHED
}
}
using pg8::Unit;

DI unsigned cvt_pk_bf16(float lo, float hi) { unsigned r; asm volatile("v_cvt_pk_bf16_f32 %0, %1, %2" : "=v"(r) : "v"(lo), "v"(hi)); return r; }
DI u32x4 pack8(const f32x4& v0, const f32x4& v1) { u32x4 w; w.x = cvt_pk_bf16(v0[0], v0[1]); w.y = cvt_pk_bf16(v0[2], v0[3]); w.z = cvt_pk_bf16(v1[0], v1[1]); w.w = cvt_pk_bf16(v1[2], v1[3]); return w; }

struct SchedP1 {
    const char* A; const char* B; int G, c;
    DI bool next(int i, Unit& u) const {
        constexpr int nM = 128, nN = 26, nwg = nM * nN, NXCD = 8, WGM = 8;
        const long L = (long)i * G + c; if (L >= nwg) return false;
        int wgid = (int)L; { const int q = nwg / NXCD, r = nwg % NXCD, xcd = wgid % NXCD, off = wgid / NXCD; wgid = (xcd < r ? xcd * (q + 1) : r * (q + 1) + (xcd - r) * q) + off; }
        const int nig = WGM * nN, gid = wgid / nig, fm = gid * WGM, gsz = (nM - fm) < WGM ? (nM - fm) : WGM;
        u.pm = fm + ((wgid % nig) % gsz); u.pn = (wgid % nig) / gsz; u.aux = 0; u.pad = 0;
        u.a = A + (size_t)u.pm * 256 * 1024 * 2; u.b = B + (size_t)u.pn * 256 * 1024 * 2; return true;
    }
};
struct SchedP3a {
    const char* ys; const char* wbr; int G, c;
    DI bool next(int i, Unit& u) const {
        const int tile = (i >> 2) * G + c; if (tile >= 512) return false;
        const int br = i & 3; u.pm = tile >> 2; u.pn = tile & 3; u.aux = br; u.pad = 0;
        u.a = ys + ((size_t)u.pm * 256 * 1024 + br * 256) * 2; u.b = wbr + ((size_t)br * 1024 * 256 + (size_t)u.pn * 256 * 256) * 2; return true;
    }
};
struct SchedP3b {
    const char* A; const char* B; int G, c;
    DI bool next(int i, Unit& u) const {
        const int L = i * G + c; if (L >= 512) return false;
        u.pm = L >> 2; u.pn = L & 3; u.aux = 0; u.pad = 0;
        u.a = A + (size_t)u.pm * 256 * 1024 * 2; u.b = B + (size_t)u.pn * 256 * 1024 * 2; return true;
    }
};
struct SchedM2 {
    const char* xs; const char* wgu; const LAS int* offt; int G, c;
    DI bool next(int i, Unit& u) const {
        const int NT = __builtin_amdgcn_readfirstlane(offt[32]) >> 8; const int L = i * G + c; if (L >= NT * 2) return false;
        const int rt = L >> 1, pn = L & 1; const int e = __builtin_amdgcn_readfirstlane(offt[40 + rt]);
        u.pm = rt; u.pn = pn; u.aux = e; u.pad = 0;
        u.a = xs + (size_t)rt * 256 * 1024 * 2; u.b = wgu + ((size_t)e * 512 + pn * 256) * 1024 * 2; return true;
    }
};
struct SchedM3 {
    const char* hmid; const char* wd; const LAS int* offt; int G, c;
    DI bool next(int i, Unit& u) const {
        const int NT = __builtin_amdgcn_readfirstlane(offt[32]) >> 8; const int L = i * G + c; if (L >= NT * 4) return false;
        const int rt = L >> 2, pn = L & 3; const int e = __builtin_amdgcn_readfirstlane(offt[40 + rt]);
        u.pm = rt; u.pn = pn; u.aux = e; u.pad = 0;
        u.a = hmid + (size_t)rt * 256 * 256 * 2; u.b = wd + ((size_t)e * 1024 + pn * 256) * 256 * 2; return true;
    }
};

struct EpiP1 {
    bf16* proj; bf16* gates; const float* bgate;
    DI void operator()(const f32x4 (&acc)[2][2][4][2], const Unit& u, int wr, int wc, int fr, int fq) const {
        const int row0 = u.pm * 256 + wr * 64 + fr; const int colt = u.pn * 256 + wc * 32 + 8 * fq;
        if (u.pn < 10) {
#pragma unroll
            for (int ai = 0; ai < 2; ++ai)
#pragma unroll
                for (int m = 0; m < 4; ++m) { bf16* rowp = proj + (size_t)(row0 + ai * 128 + m * 16) * PLD + colt;
#pragma unroll
                    for (int bj = 0; bj < 2; ++bj) *(u32x4*)(rowp + bj * 128) = pack8(acc[ai][bj][m][0], acc[ai][bj][m][1]); }
        } else {
            const int gcol = colt - 2560;
            f32x4 bv[2][2];
#pragma unroll
            for (int bj = 0; bj < 2; ++bj)
#pragma unroll
                for (int n = 0; n < 2; ++n) bv[bj][n] = *(const f32x4*)(bgate + gcol + bj * 128 + 4 * n);
#pragma unroll
            for (int ai = 0; ai < 2; ++ai)
#pragma unroll
                for (int m = 0; m < 4; ++m) { bf16* rowp = gates + (size_t)(row0 + ai * 128 + m * 16) * GLD + gcol;
#pragma unroll
                    for (int bj = 0; bj < 2; ++bj) { f32x4 v0 = acc[ai][bj][m][0] + bv[bj][0], v1 = acc[ai][bj][m][1] + bv[bj][1];
#pragma unroll
                        for (int e = 0; e < 4; ++e) { v0[e] = sigmoidf_(v0[e]); v1[e] = sigmoidf_(v1[e]); }
                        *(u32x4*)(rowp + bj * 128) = pack8(v0, v1); }
                    __builtin_amdgcn_sched_barrier(0); }
        }
    }
};
struct EpiP3a {
    bf16* merged; const bf16* gates;
    DI void operator()(const f32x4 (&acc)[2][2][4][2], const Unit& u, int wr, int wc, int fr, int fq) const {
        const int row0 = u.pm * 256 + wr * 64 + fr; const int colt = u.pn * 256 + wc * 32 + 8 * fq; const int br = u.aux;
#pragma unroll
        for (int ai = 0; ai < 2; ++ai)
#pragma unroll
            for (int m = 0; m < 4; ++m) { const size_t row = (size_t)(row0 + ai * 128 + m * 16);
#pragma unroll
                for (int bj = 0; bj < 2; ++bj) {
                    const u32x4 gw = *(const u32x4*)(gates + row * GLD + br * 1024 + colt + bj * 128);
                    bf16* mp = merged + row * 1024 + colt + bj * 128;
                    f32x4 v0 = acc[ai][bj][m][0], v1 = acc[ai][bj][m][1];
                    v0[0] *= lo_bf(gw.x); v0[1] *= hi_bf(gw.x); v0[2] *= lo_bf(gw.y); v0[3] *= hi_bf(gw.y);
                    v1[0] *= lo_bf(gw.z); v1[1] *= hi_bf(gw.z); v1[2] *= lo_bf(gw.w); v1[3] *= hi_bf(gw.w);
                    if (br != 0) { const u32x4 mw = *(const u32x4*)mp;
                        v0[0] += lo_bf(mw.x); v0[1] += hi_bf(mw.x); v0[2] += lo_bf(mw.y); v0[3] += hi_bf(mw.y);
                        v1[0] += lo_bf(mw.z); v1[1] += hi_bf(mw.z); v1[2] += lo_bf(mw.w); v1[3] += hi_bf(mw.w); }
                    *(u32x4*)mp = pack8(v0, v1); }
                __builtin_amdgcn_sched_barrier(0); }
    }
};
struct EpiP3b {
    const float* xin; float* out;
    DI void operator()(const f32x4 (&acc)[2][2][4][2], const Unit& u, int wr, int wc, int fr, int fq) const {
        const int row0 = u.pm * 256 + wr * 64 + fr; const int colt = u.pn * 256 + wc * 32 + 8 * fq;
#pragma unroll
        for (int ai = 0; ai < 2; ++ai)
#pragma unroll
            for (int m = 0; m < 4; ++m) { const size_t off = (size_t)(row0 + ai * 128 + m * 16) * 1024 + colt;
#pragma unroll
                for (int bj = 0; bj < 2; ++bj)
#pragma unroll
                    for (int n = 0; n < 2; ++n) { const f32x4 xv = *(const f32x4*)(xin + off + bj * 128 + 4 * n); *(f32x4*)(out + off + bj * 128 + 4 * n) = xv + acc[ai][bj][m][n]; }
                __builtin_amdgcn_sched_barrier(0); }
    }
};
struct EpiM2 {
    bf16* hmid;
    DI void operator()(const f32x4 (&acc)[2][2][4][2], const Unit& u, int wr, int wc, int fr, int fq) const {
        const int row0 = u.pm * 256 + wr * 64 + fr; const int col = u.pn * 128 + wc * 32 + 8 * fq;
#pragma unroll
        for (int ai = 0; ai < 2; ++ai)
#pragma unroll
            for (int m = 0; m < 4; ++m) { f32x4 h0, h1;
#pragma unroll
                for (int e = 0; e < 4; ++e) { const float g0 = acc[ai][0][m][0][e], g1 = acc[ai][0][m][1][e];
                    h0[e] = g0 * sigmoidf_(g0) * acc[ai][1][m][0][e]; h1[e] = g1 * sigmoidf_(g1) * acc[ai][1][m][1][e]; }
                *(u32x4*)(hmid + (size_t)(row0 + ai * 128 + m * 16) * 256 + col) = pack8(h0, h1); }
    }
};
struct EpiM3 {
    bf16* eo; const int* rowtok; const float* roww;
    DI void operator()(const f32x4 (&acc)[2][2][4][2], const Unit& u, int wr, int wc, int fr, int fq) const {
        const int row0 = u.pm * 256 + wr * 64 + fr; const int colt = u.pn * 256 + wc * 32 + 8 * fq;
#pragma unroll
        for (int ai = 0; ai < 2; ++ai)
#pragma unroll
            for (int m = 0; m < 4; ++m) { const int row = row0 + ai * 128 + m * 16; const int tk = rowtok[row];
                if (tk >= 0) { const float w = roww[row]; bf16* op = eo + (size_t)tk * 1024 + colt;
#pragma unroll
                    for (int bj = 0; bj < 2; ++bj) *(u32x4*)(op + bj * 128) = pack8(acc[ai][bj][m][0] * w, acc[ai][bj][m][1] * w); }
                __builtin_amdgcn_sched_barrier(0); }
    }
};

struct Args { const float* in[36]; float* out; unsigned char* ws; int ph_lo, ph_hi; };
struct InTab { unsigned base;
    DI const float* operator[](int i) const { unsigned long long v; const unsigned addr = base + (unsigned)i * 8u;
        asm volatile("ds_read_b64 %0, %1\n\ts_waitcnt lgkmcnt(0)" : "=v"(v) : "v"(addr) : "memory");
        const unsigned lo = __builtin_amdgcn_readfirstlane((unsigned)v), hi = __builtin_amdgcn_readfirstlane((unsigned)(v >> 32));
        return (const float*)(((unsigned long long)hi << 32) | lo); } };
struct KA { InTab in; float* out; unsigned char* ws; };

DI void transpose_item(const float* W, int ldw, int nvalid, bf16* WT, int ldt, int k0, int n0, int dst_row0, LAS float* scr, int lane) {
    const bool nok = (n0 + (lane & 31)) < nvalid;
#pragma unroll 8
    for (int i = 0; i < 32; ++i) { const int kk = 2 * i + (lane >> 5); scr[kk * 33 + (lane & 31)] = nok ? W[(size_t)(k0 + kk) * ldw + n0 + (lane & 31)] : 0.f; }
    LDS_WAIT(); asm volatile("" ::: "memory");
    const int c = lane & 7;
#pragma unroll
    for (int j = 0; j < 4; ++j) { const int n = (lane >> 3) + 8 * j; const LAS float* s = scr + (8 * c) * 33 + n;
        u32x4 o; o.x = pk2(s[0 * 33], s[1 * 33]); o.y = pk2(s[2 * 33], s[3 * 33]); o.z = pk2(s[4 * 33], s[5 * 33]); o.w = pk2(s[6 * 33], s[7 * 33]);
        if (n0 + n < nvalid) *(u32x4*)(WT + (size_t)(dst_row0 + n) * ldt + k0 + 8 * c) = o; }
    LDS_WAIT(); asm volatile("" ::: "memory");
}
DI void phase0_weights(const KA& a, int l, LAS unsigned char* lds, int gw, int NGW, int wave, int lane) {
    LAS float* scr = (LAS float*)(lds + wave * 16384);
    const float* w_in = a.in[4] + (size_t)l * 1024 * NIN;
    const float* w_gate = a.in[24] + (size_t)l * 4 * 1024 * 1024;
    const float* w_br = a.in[26] + (size_t)l * 4 * 256 * 1024;
    const float* w_out = a.in[27] + (size_t)l * 1024 * 1024;
    bf16* Wt_in = (bf16*)(a.ws + WS_WIN); bf16* Wt_br = (bf16*)(a.ws + WS_WBR); bf16* Wt_out = (bf16*)(a.ws + WS_WOUT);
    constexpr int I_IN = 16 * 77, I_G = 4 * 16 * 32, I_B = 4 * 4 * 32, I_O = 16 * 32, NIT = I_IN + I_G + I_B + I_O;
    for (int it = gw; it < NIT; it += NGW) {
        int r = it;
        if (r < I_IN) { const int kb = r / 77, nb = r % 77; transpose_item(w_in, NIN, NIN, Wt_in, 1024, kb * 64, nb * 32, nb * 32, scr, lane); continue; } r -= I_IN;
        if (r < I_G) { const int br = r / 512, q = r % 512, kb = q / 32, nb = q % 32; transpose_item(w_gate + (size_t)br * 1024 * 1024, 1024, 1024, Wt_in, 1024, kb * 64, nb * 32, 2560 + br * 1024 + nb * 32, scr, lane); continue; } r -= I_G;
        if (r < I_B) { const int br = r / 128, q = r % 128, kb = q / 32, nb = q % 32; transpose_item(w_br + (size_t)br * 256 * 1024, 1024, 1024, Wt_br + (size_t)br * 1024 * 256, 256, kb * 64, nb * 32, nb * 32, scr, lane); continue; } r -= I_B;
        { const int kb = r / 32, nb = r % 32; transpose_item(w_out, 1024, 1024, Wt_out, 1024, kb * 64, nb * 32, nb * 32, scr, lane); }
    }
}

DI void router_weights(const KA& a, int l, int gw, int NGW, int lane) {
    bf16* Wr = (bf16*)(a.ws + WS_WR);
    const float* wg = a.in[29] + (size_t)l * 1024 * 4; const float* we = a.in[31] + (size_t)l * 1024 * 32;
    for (int n = gw; n < 36; n += NGW) {
        for (int i = 0; i < 16; ++i) { const int k = lane + 64 * i; const float w = (n < 4) ? wg[k * 4 + n] : we[k * 32 + (n - 4)];
            const unsigned hi = f2bf(w); const float hf = __builtin_bit_cast(float, hi << 16); const unsigned lo = f2bf(w - hf);
            Wr[(size_t)n * 2048 + k] = (bf16)hi; Wr[(size_t)n * 2048 + 1024 + k] = (bf16)hi; Wr[(size_t)(64 + n) * 2048 + k] = (bf16)lo; Wr[(size_t)(64 + n) * 2048 + 1024 + k] = 0; }
    }
}

DI void cmp_weights(const KA& a, int l, LAS unsigned char* lds, int gw, int NGW, int wave, int lane) {
    LAS float* scr = (LAS float*)(lds + wave * 16384);
    bf16* Wc = (bf16*)(a.ws + WS_WCMP); float* pt = (float*)(a.ws + WS_CMPAB + 2 * MiB);
    for (int it = gw; it < 2 * 32 * 2 + 2; it += NGW) {
        if (it < 128) { const int kv = it >> 6, q = it & 63, kb = q >> 1, nb = q & 1; const float* w1 = a.in[kv ? 22 : 19] + (size_t)l * 2048 * 64;
            bf16* dst = Wc + (size_t)kv * 256 * 1024 - (kb >= 16 ? 1024 : 0);
            transpose_item(w1, 64, 64, dst, 1024, kb * 64, nb * 32, (kb >= 16 ? 64 : 0) + nb * 32, scr, lane);
        } else { const int kv = it - 128; const float* w1 = a.in[kv ? 22 : 19] + (size_t)l * 2048 * 64; const float* pos = a.in[kv ? 21 : 18] + (size_t)l * 2048;
            float acc = 0.f;
            for (int k = 0; k < 2048; ++k) acc += pos[k] * w1[(size_t)k * 64 + lane];
            pt[kv * 64 + lane] = acc; }
    }
}
DI void phase0_rows(const KA& a, int l, int mode, int gw, int NGW, int lane) {
    const GAS float* xin = (const GAS float*)((l == 0) ? a.in[0] : a.out);
    const GAS bf16* eo = (const GAS bf16*)(a.ws + WS_PROJ);
    GAS bf16* hb = (GAS bf16*)(a.ws + WS_HB); GAS float* outp = (GAS float*)a.out;
    const GAS float* g = (const GAS float*)(mode ? a.in[2] : (a.in[3] + (size_t)l * 1024));
    f32x4 gv[4];
#pragma unroll
    for (int j = 0; j < 4; ++j) gv[j] = *(const GAS f32x4*)(g + 4 * (lane + 64 * j));
    for (int m0 = gw * 4; m0 < T; m0 += NGW * 4) {
        f32x4 v[4][4]; float ss[4];
#pragma unroll
        for (int rr = 0; rr < 4; ++rr)
#pragma unroll
            for (int j = 0; j < 4; ++j) v[rr][j] = *(const GAS f32x4*)(xin + (size_t)(m0 + rr) * 1024 + 4 * (lane + 64 * j));
        if (l > 0) {
#pragma unroll
            for (int rr = 0; rr < 4; ++rr)
#pragma unroll
                for (int j = 0; j < 4; ++j) {
                    const u32x2 e0 = *(const GAS u32x2*)(eo + (size_t)(2 * (m0 + rr)) * 1024 + 4 * (lane + 64 * j));
                    const u32x2 e1 = *(const GAS u32x2*)(eo + (size_t)(2 * (m0 + rr) + 1) * 1024 + 4 * (lane + 64 * j));
                    v[rr][j][0] += lo_bf(e0.x) + lo_bf(e1.x); v[rr][j][1] += hi_bf(e0.x) + hi_bf(e1.x); v[rr][j][2] += lo_bf(e0.y) + lo_bf(e1.y); v[rr][j][3] += hi_bf(e0.y) + hi_bf(e1.y); } }
#pragma unroll
        for (int rr = 0; rr < 4; ++rr) { float t = 0.f;
#pragma unroll
            for (int j = 0; j < 4; ++j) t += (v[rr][j][0] * v[rr][j][0] + v[rr][j][1] * v[rr][j][1]) + (v[rr][j][2] * v[rr][j][2] + v[rr][j][3] * v[rr][j][3]);
            ss[rr] = t; }
#pragma unroll
        for (int rr = 0; rr < 4; ++rr) ss[rr] = wave_sum(ss[rr]);
#pragma unroll
        for (int rr = 0; rr < 4; ++rr) { const float r = 1.f / sqrtf(ss[rr] * (1.f / 1024.f) + 1e-6f); const size_t m = (size_t)(m0 + rr);
#pragma unroll
            for (int j = 0; j < 4; ++j) { const f32x4 y = v[rr][j] * r * gv[j];
                if (mode) *(GAS f32x4*)(outp + m * 1024 + 4 * (lane + 64 * j)) = y;
                else { if (l > 0) *(GAS f32x4*)(outp + m * 1024 + 4 * (lane + 64 * j)) = v[rr][j];
                       u32x2 w; w.x = pk2(y[0], y[1]); w.y = pk2(y[2], y[3]); *(GAS u32x2*)(hb + m * 1024 + 4 * (lane + 64 * j)) = w; } } }
    }
}

DI void lru_unit(const KA& a, int l, const GAS bf16* proj, GAS bf16* ys, GAS float* sums, LAS unsigned char* lds, int task, int lane_in, int wave_in, bool final) {
    int lane = lane_in, wave = wave_in; asm volatile("" : "+v"(lane), "+s"(wave));
    const int chunk = task & 31, hbk = (task >> 5) & 3, b = task >> 7; const int c = hbk * 64 + lane;
    const GAS float* w_a = (const GAS float*)(a.in[7] + ((size_t)l * 4 + hbk) * 4096); const GAS float* w_x = (const GAS float*)(a.in[9] + ((size_t)l * 4 + hbk) * 4096);
    float wa[64], wx[64];
#pragma unroll
    for (int i = 0; i < 64; ++i) { wa[i] = w_a[i * 64 + lane]; wx[i] = w_x[i * 64 + lane]; }
    const GAS float* cw = (const GAS float*)(a.in[5] + (size_t)l * 4 * 256);
    const float cw0 = cw[c], cw1 = cw[256 + c], cw2 = cw[512 + c], cw3 = cw[768 + c];
    const float cb = a.in[6][l * 256 + c], ba = a.in[8][l * 256 + c], bx = a.in[10][l * 256 + c];
    const float c8 = -8.f * softplusf_(-a.in[11][l * 256 + c]);
    const int ts = chunk * 256 + wave * 32; const size_t rowb = (size_t)b * SEQ;
    float x3 = (ts >= 3) ? bf2f(proj[(rowb + ts - 3) * PLD + C_AX + c]) : 0.f;
    float x2 = (ts >= 2) ? bf2f(proj[(rowb + ts - 2) * PLD + C_AX + c]) : 0.f;
    float x1 = (ts >= 1) ? bf2f(proj[(rowb + ts - 1) * PLD + C_AX + c]) : 0.f;
    LAS f32x2* ab = (LAS f32x2*)(lds + wave * 16384);
    LAS float* ex = (LAS float*)(lds + LRUEX_OFF);
    float h = 0.f, Ap = 1.f;
#pragma unroll 1
    for (int i = 0; i < 32; ++i) { const int t = ts + i;
        const float x0 = bf2f(proj[(rowb + t) * PLD + C_AX + c]);
        const float xc = cb + cw0 * x3 + cw1 * x2 + cw2 * x1 + cw3 * x0;
        float ra = ba, rx = bx;
#pragma unroll
        for (int k = 0; k < 64; ++k) { const float sv = rl(xc, k); ra += sv * wa[k]; rx += sv * wx[k]; }
        const float r = sigmoidf_(ra), ig = sigmoidf_(rx);
        const float la = c8 * r; const float av = __expf(la);
        const float mult = (t == 0) ? 1.f : sqrtf(fmaxf(1.f - __expf(2.f * la), 0.f));
        const float bb = mult * ig * xc;
        if (final) ab[i * 64 + lane] = (f32x2){av, bb};
        h = av * h + bb; Ap *= av;
        x3 = x2; x2 = x1; x1 = x0; }
    ex[(wave * 64 + lane) * 2] = Ap; ex[(wave * 64 + lane) * 2 + 1] = h;
    __syncthreads();
    if (!final) {
        if (wave == 0) { float hh = 0.f, aa = 1.f;
#pragma unroll
            for (int w = 0; w < 8; ++w) { const float A_ = ex[(w * 64 + lane) * 2], H_ = ex[(w * 64 + lane) * 2 + 1]; hh = A_ * hh + H_; aa *= A_; }
            GAS float* sp = sums + ((size_t)((b * 4 + hbk) * 32 + chunk) * 64 + lane) * 2; sp[0] = aa; sp[1] = hh; }
    } else {
        float hh = 0.f;
        for (int cc = 0; cc < chunk; ++cc) { const GAS float* sp = sums + ((size_t)((b * 4 + hbk) * 32 + cc) * 64 + lane) * 2; hh = sp[0] * hh + sp[1]; }
        for (int w = 0; w < wave; ++w) { const float A_ = ex[(w * 64 + lane) * 2], H_ = ex[(w * 64 + lane) * 2 + 1]; hh = A_ * hh + H_; }
#pragma unroll 4
        for (int i = 0; i < 32; ++i) { const f32x2 v = ab[i * 64 + lane]; hh = v[0] * hh + v[1];
            const float gt = bf2f(proj[(rowb + ts + i) * PLD + C_AG + c]); ys[(rowb + ts + i) * 1024 + c] = (bf16)f2bf(hh * gelu_tanh(gt)); }
    }
    __syncthreads();
}

constexpr int DK_STR = 144, DV_STR = 192, DBUF_BYTES = 64 * DK_STR + 64 * DV_STR;
DI int crow(int i, int hh) { return (i & 3) + 8 * (i >> 2) + 4 * hh; }
DI unsigned cvtpk(float lo, float hi) { f32x2 v = {lo, hi}; bf16x2_t b = __builtin_convertvector(v, bf16x2_t); return __builtin_bit_cast(unsigned, b); }
DI bf16x8 pack_half(const f32x16& x, int s2) { u32x4 p;
    if (s2 == 0) { p.x = cvtpk(x[0], x[1]); p.y = cvtpk(x[2], x[3]); p.z = cvtpk(x[4], x[5]); p.w = cvtpk(x[6], x[7]); }
    else { p.x = cvtpk(x[8], x[9]); p.y = cvtpk(x[10], x[11]); p.z = cvtpk(x[12], x[13]); p.w = cvtpk(x[14], x[15]); }
    return __builtin_bit_cast(bf16x8, p); }
DI s16x4 vtr(const LAS unsigned char* p) { return __builtin_bit_cast(s16x4, __builtin_amdgcn_ds_read_tr16_b64_v4i16((LAS v4i16_t*)p)); }
DI float max16(const f32x16& x) { float a = fmaxf(fmaxf(x[0], x[1]), fmaxf(x[2], x[3])), b = fmaxf(fmaxf(x[4], x[5]), fmaxf(x[6], x[7])), c = fmaxf(fmaxf(x[8], x[9]), fmaxf(x[10], x[11])), d = fmaxf(fmaxf(x[12], x[13]), fmaxf(x[14], x[15])); return fmaxf(fmaxf(a, b), fmaxf(c, d)); }
DI void diff_unit(const GAS bf16* proj, GAS bf16* ys, LAS unsigned char* lds, const LAS float* bias2, const GAS float* subg, float lam, float lam_init, int b, int h, int qb, int tid_in, int lane_in, int wave_in) {
    int tid = tid_in, lane = lane_in, wave = wave_in; asm volatile("" : "+v"(tid), "+v"(lane), "+s"(wave));
    const int q0 = qb * 256 + wave * 32; const int ql = lane & 31, hh = lane >> 5; const int q = q0 + ql;
    const size_t rowb = (size_t)b * SEQ;
    const float SC = 0.17677669529663687f * 1.4426950408889634f;
    bf16x8 qf[2][2];
    { const GAS bf16* qp = proj + (rowb + q) * PLD + C_CQ + h * 64 + hh * 8;
#pragma unroll
      for (int m = 0; m < 2; ++m)
#pragma unroll
        for (int s = 0; s < 2; ++s) { const u32x4 w = *(const GAS u32x4*)(qp + m * 32 + s * 16); u32x4 o;
            o.x = cvtpk(lo_bf(w.x) * SC, hi_bf(w.x) * SC); o.y = cvtpk(lo_bf(w.y) * SC, hi_bf(w.y) * SC); o.z = cvtpk(lo_bf(w.z) * SC, hi_bf(w.z) * SC); o.w = cvtpk(lo_bf(w.w) * SC, hi_bf(w.w) * SC);
            qf[m][s] = __builtin_bit_cast(bf16x8, o); } }
    f32x16 O[2][2], negm[2];
#pragma unroll
    for (int i = 0; i < 16; ++i) { O[0][0][i] = 0.f; O[0][1][i] = 0.f; O[1][0][i] = 0.f; O[1][1][i] = 0.f; negm[0][i] = 0.f; negm[1][i] = 0.f; }
    float lsum[2] = {0.f, 0.f};
    const int nsteps = 4 * qb + 4, mysteps = 4 * qb + (wave >> 1) + 1;
    const int skey = tid >> 3, sch = tid & 7;
    const GAS unsigned char* kgb = (const GAS unsigned char*)(proj + rowb * PLD + C_CK + h * 64);
    const GAS unsigned char* vgb = (const GAS unsigned char*)(proj + rowb * PLD + C_CV + h * 64);
    const unsigned soff = (unsigned)(skey * PLD + sch * 8) * 2u;
    u32x4 kr = *(const GAS u32x4*)(kgb + soff), vr = *(const GAS u32x4*)(vgb + soff);
    *(LAS u32x4*)(lds + skey * DK_STR + sch * 16) = kr; *(LAS u32x4*)(lds + 64 * DK_STR + skey * DV_STR + sch * 16) = vr;
    __syncthreads();
    const int i16 = lane & 15, blk = (lane >> 4) & 1;
    const int kboff = ql * DK_STR + hh * 16;
    const int vboff = 64 * DK_STR + (4 * hh + (i16 >> 2)) * DV_STR + (16 * blk + 4 * (i16 & 3)) * 2;
#pragma unroll 1
    for (int kt = 0; kt < nsteps; ++kt) {
        const LAS unsigned char* cur = lds + (kt & 1) * DBUF_BYTES; LAS unsigned char* nxt = lds + ((kt + 1) & 1) * DBUF_BYTES;
        if (kt + 1 < nsteps) { const unsigned so = soff + (unsigned)(kt + 1) * (64u * PLD * 2u); kr = *(const GAS u32x4*)(kgb + so); vr = *(const GAS u32x4*)(vgb + so); }
        if (kt < mysteps) {
            const int kbase = kt * 64;
            const bool near = (q0 - (kbase + 63) < 113);
#pragma unroll
            for (int m = 0; m < 2; ++m) {
                bf16x8 pk[2][2];
                f32x16 S[2];
                {   bf16x8 kf[2][2];
#pragma unroll
                    for (int t = 0; t < 2; ++t)
#pragma unroll
                        for (int s = 0; s < 2; ++s) kf[t][s] = *(const LAS bf16x8*)(cur + kboff + t * 32 * DK_STR + m * 64 + s * 32);
#pragma unroll
                    for (int t = 0; t < 2; ++t) { S[t] = MFMA32(kf[t][0], qf[m][0], negm[m]); S[t] = MFMA32(kf[t][1], qf[m][1], S[t]); } }
                if (near) {
#pragma unroll
                    for (int t = 0; t < 2; ++t)
#pragma unroll
                        for (int i = 0; i < 16; ++i) { const int dist = q - (kbase + 32 * t + crow(i, hh)); const int di = dist < 128 ? dist : 128;
                            const float bv = dist >= 0 ? bias2[di * 12 + 4 + h] : -1e30f; S[t][i] += bv; } }
                float tm = fmaxf(max16(S[0]), max16(S[1]));
                const bool need = (tm > 8.f) || (kt == 0);
                if (__builtin_amdgcn_ballot_w64(need) != 0ull) {
                    tm = fmaxf(tm, xshfl<32>(tm));
                    const float sh = (kt == 0) ? tm : fmaxf(tm, 0.f);
                    const float al = __builtin_amdgcn_exp2f(-sh);
                    lsum[m] *= al;
#pragma unroll
                    for (int i = 0; i < 16; ++i) { O[m][0][i] *= al; O[m][1][i] *= al; negm[m][i] -= sh; S[0][i] -= sh; S[1][i] -= sh; }
                }
#pragma unroll
                for (int t = 0; t < 2; ++t) {
#pragma unroll
                    for (int i = 0; i < 16; ++i) { const float p = __builtin_amdgcn_exp2f(S[t][i]); S[t][i] = p; lsum[m] += p; }
                    pk[t][0] = pack_half(S[t], 0); pk[t][1] = pack_half(S[t], 1); }
#pragma unroll
                for (int t = 0; t < 2; ++t)
#pragma unroll
                    for (int s2 = 0; s2 < 2; ++s2)
#pragma unroll
                        for (int db = 0; db < 2; ++db) {
                            const s16x4 lo = vtr(cur + vboff + (32 * t + 16 * s2) * DV_STR + db * 64), hi = vtr(cur + vboff + (32 * t + 16 * s2 + 8) * DV_STR + db * 64);
                            const bf16x8 vf = __builtin_shufflevector(lo, hi, 0, 1, 2, 3, 4, 5, 6, 7);
                            O[m][db] = MFMA32(vf, pk[t][s2], O[m][db]); }
                __builtin_amdgcn_sched_barrier(0);
            }
        }
        if (kt + 1 < nsteps) { *(LAS u32x4*)(nxt + skey * DK_STR + sch * 16) = kr; *(LAS u32x4*)(nxt + 64 * DK_STR + skey * DV_STR + sch * 16) = vr; }
        __syncthreads();
    }
    const float l0 = lsum[0] + xshfl<32>(lsum[0]), l1 = lsum[1] + xshfl<32>(lsum[1]);
    const float i0 = 1.f / fmaxf(l0, 1e-30f), i1 = lam / fmaxf(l1, 1e-30f);
    float ss = 0.f;
#pragma unroll
    for (int db = 0; db < 2; ++db)
#pragma unroll
        for (int i = 0; i < 16; ++i) { const float at = O[0][db][i] * i0 - O[1][db][i] * i1; O[0][db][i] = at; ss += at * at; }
    ss += xshfl<32>(ss);
    const float r = (1.f - lam_init) / sqrtf(ss * (1.f / 64.f) + 1e-5f);
    GAS bf16* op = ys + (rowb + q) * 1024 + 512 + h * 64;
#pragma unroll
    for (int db = 0; db < 2; ++db)
#pragma unroll
        for (int gq = 0; gq < 4; ++gq) { const int d0 = 32 * db + 8 * gq + 4 * hh; const f32x4 sg = *(const GAS f32x4*)(subg + d0);
            u32x2 w; w.x = cvtpk(O[0][db][4 * gq + 0] * r * sg[0], O[0][db][4 * gq + 1] * r * sg[1]); w.y = cvtpk(O[0][db][4 * gq + 2] * r * sg[2], O[0][db][4 * gq + 3] * r * sg[3]);
            *(GAS u32x2*)(op + d0) = w; }
}

struct SchedCmp { const char* proj; const char* wc; int G, c;
    DI bool next(int i, Unit& u) const { const int L = i * G + c; if (L >= 16) return false; const int kv = L >> 3, rt = L & 7;
        u.pm = rt; u.pn = 0; u.aux = kv; u.pad = 0; u.a = proj + ((size_t)rt * 256 * 16 * PLD + (kv ? C_VC : C_KC)) * 2; u.b = wc + (size_t)kv * 256 * 1024 * 2; return true; } };
struct EpiCmp { float* ab;
    DI void operator()(const f32x4 (&acc)[2][2][4][2], const Unit& u, int wr, int wc, int fr, int fq) const {
        const int row0 = u.pm * 256 + wr * 64 + fr; const int col = wc * 32 + 8 * fq;
#pragma unroll
        for (int ai = 0; ai < 2; ++ai)
#pragma unroll
            for (int m = 0; m < 4; ++m) { float* rp = ab + ((size_t)u.aux * 2048 + row0 + ai * 128 + m * 16) * 128 + col; *(f32x4*)rp = acc[ai][0][m][0]; *(f32x4*)(rp + 4) = acc[ai][0][m][1]; }
    }
};
DI void cmp_finish(const KA& a, int l, const float* ab, bf16* kcb, int task, int lane) {
    const int kv = task / (BATCH * NCMP), r = task % (BATCH * NCMP), b = r / NCMP, c = r % NCMP;
    const float* w2 = a.in[kv ? 23 : 20] + (size_t)l * 4096; const float* pt = ab + 2 * 2048 * 128;
    const size_t g = (size_t)kv * 2048 + b * 512 + c;
    const float h1 = ab[g * 128 + lane] + ab[(g + 1) * 128 + 64 + lane] + pt[kv * 64 + lane];
    const float gl = gelu_tanh(h1); float o = 0.f;
#pragma unroll
    for (int j = 0; j < 64; ++j) o += rl(gl, j) * w2[j * 64 + lane];
    kcb[((size_t)(kv * BATCH + b) * 512 + c) * 64 + lane] = (bf16)f2bf(o);
    if (c == NCMP - 1) kcb[((size_t)(kv * BATCH + b) * 512 + NCMP) * 64 + lane] = 0;
}

DI void st_load(const GAS unsigned char* kb, const GAS unsigned char* vb, unsigned off, u32x4& kr, u32x4& vr) { kr = *(const GAS u32x4*)(kb + off); vr = *(const GAS u32x4*)(vb + off); }
DI void st_write(LAS unsigned char* buf, int skey, int sch, const u32x4& kr, const u32x4& vr) { *(LAS u32x4*)(buf + skey * DK_STR + sch * 16) = kr; *(LAS u32x4*)(buf + 64 * DK_STR + skey * DV_STR + sch * 16) = vr; }
DI void qk64(const LAS unsigned char* cur, int kboff, const bf16x8 (&qf)[4], const f32x16& cinit, f32x16 (&S)[2]) {
#pragma unroll
    for (int t = 0; t < 2; ++t) { S[t] = cinit;
#pragma unroll
        for (int s = 0; s < 4; ++s) { const bf16x8 kf = *(const LAS bf16x8*)(cur + kboff + t * 32 * DK_STR + s * 32); S[t] = MFMA32(kf, qf[s], S[t]); } }
}
DI void qk32z(const LAS unsigned char* kt32, const bf16x8 (&qf)[4], f32x16& S) {
#pragma unroll
    for (int s = 0; s < 4; ++s) { const bf16x8 kf = *(const LAS bf16x8*)(kt32 + s * 32);
        if (s == 0) { f32x16 z;
#pragma unroll
            for (int i = 0; i < 16; ++i) z[i] = 0.f;
            S = MFMA32(kf, qf[s], z); } else S = MFMA32(kf, qf[s], S); }
}
DI void pv32(const LAS unsigned char* vt32, const bf16x8 (&pk)[2], f32x16 (&O)[2]) {
#pragma unroll
    for (int s2 = 0; s2 < 2; ++s2)
#pragma unroll
        for (int db = 0; db < 2; ++db) {
            const s16x4 lo = vtr(vt32 + (16 * s2) * DV_STR + db * 64), hi = vtr(vt32 + (16 * s2 + 8) * DV_STR + db * 64);
            const bf16x8 vf = __builtin_shufflevector(lo, hi, 0, 1, 2, 3, 4, 5, 6, 7);
            O[db] = MFMA32(vf, pk[s2], O[db]); }
}
DI void mask_bias_cmp32(f32x16& S, int tcol, int cbase, int hh, const LAS float* b2h, float msub) {
#pragma unroll
    for (int i = 0; i < 16; ++i) { const int c = cbase + crow(i, hh); const int dist = tcol - 31 - 16 * c; const bool ok = dist >= 0 && c < NCMP;
        const int di = dist < 0 ? 0 : (dist < 128 ? dist : 128); S[i] = ok ? S[i] + (b2h[di * 12] - msub) : -1e30f; }
}
DI void pv64(const LAS unsigned char* cur, int vboff, const bf16x8 (&pk)[2][2], f32x16 (&O)[2]) {
#pragma unroll
    for (int t = 0; t < 2; ++t)
#pragma unroll
        for (int s2 = 0; s2 < 2; ++s2)
#pragma unroll
            for (int db = 0; db < 2; ++db) {
                const s16x4 lo = vtr(cur + vboff + (32 * t + 16 * s2) * DV_STR + db * 64), hi = vtr(cur + vboff + (32 * t + 16 * s2 + 8) * DV_STR + db * 64);
                const bf16x8 vf = __builtin_shufflevector(lo, hi, 0, 1, 2, 3, 4, 5, 6, 7);
                O[db] = MFMA32(vf, pk[t][s2], O[db]); }
}
DI void softmax_step(f32x16 (&S)[2], f32x16 (&O)[2], f32x16& negm, float& lsum, bf16x8 (&pk)[2][2]) {
    float tm = fmaxf(max16(S[0]), max16(S[1]));
    if (__builtin_amdgcn_ballot_w64(tm > 8.f) != 0ull) {
        tm = fmaxf(tm, xshfl<32>(tm)); const float sh = fmaxf(tm, 0.f); const float al = __builtin_amdgcn_exp2f(-sh);
        lsum *= al;
#pragma unroll
        for (int i = 0; i < 16; ++i) { O[0][i] *= al; O[1][i] *= al; negm[i] -= sh; S[0][i] -= sh; S[1][i] -= sh; } }
#pragma unroll
    for (int t = 0; t < 2; ++t) {
#pragma unroll
        for (int i = 0; i < 16; ++i) { const float p = __builtin_amdgcn_exp2f(S[t][i]); S[t][i] = p; lsum += p; }
        pk[t][0] = pack_half(S[t], 0); pk[t][1] = pack_half(S[t], 1); }
}
DI void mask_bias(f32x16 (&S)[2], int tcol, int kbase, int hh, int W, bool colsel, const LAS float* b2h) {
#pragma unroll
    for (int t = 0; t < 2; ++t)
#pragma unroll
        for (int i = 0; i < 16; ++i) { const int dist = tcol - (kbase + 32 * t + crow(i, hh)); const bool ok = colsel && dist >= 0 && dist < W;
            const int di = dist < 0 ? 0 : (dist < 128 ? dist : 128); S[t][i] = ok ? S[t][i] + b2h[di * 12] : -1e30f; }
}
DI void nsa_unit(const GAS bf16* proj, GAS bf16* ys, const GAS bf16* kcb, LAS unsigned char* lds, const LAS float* bias2, int b, int u, int tid_in, int lane_in, int wave_in) {
    int tid = tid_in, lane = lane_in, wave = wave_in; asm volatile("" : "+v"(tid), "+v"(lane), "+s"(wave));
    const int t0 = u * 64; const int col = lane & 31, hh = lane >> 5, tl = col >> 2, head = col & 3;
    const int t = t0 + wave * 8 + tl; const int tw0 = t0 + wave * 8;
    const size_t rowb = (size_t)b * SEQ;
    const LAS float* b2h = bias2 + 8 + head;
    bf16x8 qf[4];
    { const float SC = 0.125f * 1.4426950408889634f; const GAS bf16* qp = proj + (rowb + t) * PLD + C_DQ + head * 64 + hh * 8;
#pragma unroll
      for (int s = 0; s < 4; ++s) { const u32x4 w = *(const GAS u32x4*)(qp + s * 16); u32x4 o;
          o.x = cvtpk(lo_bf(w.x) * SC, hi_bf(w.x) * SC); o.y = cvtpk(lo_bf(w.y) * SC, hi_bf(w.y) * SC); o.z = cvtpk(lo_bf(w.z) * SC, hi_bf(w.z) * SC); o.w = cvtpk(lo_bf(w.w) * SC, hi_bf(w.w) * SC);
          qf[s] = __builtin_bit_cast(bf16x8, o); } }
    const int skey = tid >> 3, sch = tid & 7;
    const int i16 = lane & 15, blk = (lane >> 4) & 1;
    const int kboff = col * DK_STR + hh * 16;
    const int vboff = 64 * DK_STR + (4 * hh + (i16 >> 2)) * DV_STR + (16 * blk + 4 * (i16 & 3)) * 2;
    u32x4 kr, vr;
    const int ncvm = (4 * u + 3) < NCMP ? (4 * u + 3) : NCMP;
    const int nsc = (ncvm + 63) >> 6;
    const GAS unsigned char* kcp = (const GAS unsigned char*)(kcb + (size_t)(0 * BATCH + b) * 512 * 64);
    const GAS unsigned char* vcp = (const GAS unsigned char*)(kcb + (size_t)(1 * BATCH + b) * 512 * 64);
    const unsigned soffc = (unsigned)(skey * 64 + sch * 8) * 2u;
    float m1 = -120.f, l1 = 0.f;
    st_load(kcp, vcp, soffc, kr, vr); st_write(lds, skey, sch, kr, vr); __syncthreads();
#pragma unroll 1
    for (int kt = 0; kt < nsc; ++kt) {
        const LAS unsigned char* cur = lds + (kt & 1) * DBUF_BYTES; LAS unsigned char* nxt = lds + ((kt + 1) & 1) * DBUF_BYTES;
        if (kt + 1 < nsc) st_load(kcp, vcp, soffc + (unsigned)(kt + 1) * 8192u, kr, vr);
#pragma unroll
        for (int tt = 0; tt < 2; ++tt) { f32x16 S; qk32z(cur + kboff + tt * 32 * DK_STR, qf, S); mask_bias_cmp32(S, t, kt * 64 + tt * 32, hh, b2h, 0.f);
          const float tm = max16(S); const float mn = fmaxf(m1, tm); float acc = 0.f;
#pragma unroll
          for (int i = 0; i < 16; ++i) acc += __builtin_amdgcn_exp2f(S[i] - mn);
          l1 = l1 * __builtin_amdgcn_exp2f(m1 - mn) + acc; m1 = mn; }
        if (kt + 1 < nsc) st_write(nxt, skey, sch, kr, vr);
        __syncthreads();
    }
    float mf, inv;
    { const float mo = xshfl<32>(m1), lo = xshfl<32>(l1); mf = fmaxf(m1, mo); const float lf = l1 * __builtin_amdgcn_exp2f(m1 - mf) + lo * __builtin_amdgcn_exp2f(mo - mf); inv = lf > 0.f ? 1.f / lf : 0.f; }
    f32x16 Oc[2], imp[4];
#pragma unroll
    for (int i = 0; i < 16; ++i) { Oc[0][i] = 0.f; Oc[1][i] = 0.f; imp[0][i] = 0.f; imp[1][i] = 0.f; imp[2][i] = 0.f; imp[3][i] = 0.f; }
    {   st_load(kcp, vcp, soffc, kr, vr); st_write(lds, skey, sch, kr, vr); __syncthreads();
#pragma unroll 1
        for (int kt = 0; kt < nsc; ++kt) {
            const LAS unsigned char* cur = lds + (kt & 1) * DBUF_BYTES; LAS unsigned char* nxt = lds + ((kt + 1) & 1) * DBUF_BYTES;
            if (kt + 1 < nsc) st_load(kcp, vcp, soffc + (unsigned)(kt + 1) * 8192u, kr, vr);
#pragma unroll
            for (int tt = 0; tt < 2; ++tt) {
                f32x16 S; qk32z(cur + kboff + tt * 32 * DK_STR, qf, S); mask_bias_cmp32(S, t, kt * 64 + tt * 32, hh, b2h, mf);
#pragma unroll
                for (int i = 0; i < 16; ++i) S[i] = __builtin_amdgcn_exp2f(S[i]) * inv;
                bf16x8 pk[2]; pk[0] = pack_half(S, 0); pk[1] = pack_half(S, 1);
                pv32(cur + vboff + tt * 32 * DV_STR, pk, Oc);
                const int Tq = (2 * kt + tt) & 3, MB = (2 * kt + tt) >> 2;
#pragma unroll
                for (int s2 = 0; s2 < 2; ++s2) { u32x4 aw; unsigned e[8];
#pragma unroll
                    for (int jj = 0; jj < 8; ++jj) { const int kk = 16 * s2 + 8 * (jj >> 2) + 4 * hh + (jj & 3); const int delta = 32 * Tq + kk - 4 * col;
                        e[jj] = (delta == -1 || delta == 3) ? 0x3F80u : ((unsigned)delta <= 2u ? 0x4000u : 0u); }
                    aw.x = e[0] | (e[1] << 16); aw.y = e[2] | (e[3] << 16); aw.z = e[4] | (e[5] << 16); aw.w = e[6] | (e[7] << 16);
                    const bf16x8 af = __builtin_bit_cast(bf16x8, aw);
                    if (MB == 0) imp[0] = MFMA32(af, pk[s2], imp[0]); else if (MB == 1) imp[1] = MFMA32(af, pk[s2], imp[1]); else if (MB == 2) imp[2] = MFMA32(af, pk[s2], imp[2]); else imp[3] = MFMA32(af, pk[s2], imp[3]); }
                if (Tq == 3 && MB < 3) { u32x4 aw; aw.x = 0u; aw.y = 0u; aw.z = 0u; aw.w = (lane == 32) ? 0x3F800000u : 0u;
                    const bf16x8 af = __builtin_bit_cast(bf16x8, aw);
                    if (MB == 0) imp[1] = MFMA32(af, pk[1], imp[1]); else if (MB == 1) imp[2] = MFMA32(af, pk[1], imp[2]); else imp[3] = MFMA32(af, pk[1], imp[3]); }
            }
            if (kt + 1 < nsc) st_write(nxt, skey, sch, kr, vr);
            __syncthreads();
        }
    }
    unsigned ocp[2][8];
#pragma unroll
    for (int db = 0; db < 2; ++db)
#pragma unroll
        for (int i = 0; i < 8; ++i) ocp[db][i] = cvtpk(Oc[db][2 * i], Oc[db][2 * i + 1]);
    unsigned sm0 = 0u, sm1 = 0u, sm2 = 0u, sm3 = 0u;
    {   const int cur_t = t >> 6; unsigned key[16];
#pragma unroll
        for (int i = 0; i < 16; ++i) {
            float v0 = imp[0][i], v1 = imp[1][i], v2 = imp[2][i], v3 = imp[3][i];
            v0 += xshfl<1>(v0); v0 += xshfl<2>(v0); v1 += xshfl<1>(v1); v1 += xshfl<2>(v1); v2 += xshfl<1>(v2); v2 += xshfl<2>(v2); v3 += xshfl<1>(v3); v3 += xshfl<2>(v3);
            const float val = head == 0 ? v0 : (head == 1 ? v1 : (head == 2 ? v2 : v3));
            const int j = 32 * head + crow(i, hh);
            const bool forced = (j == 0) || (j == cur_t) || (j == cur_t - 1);
            unsigned fx = (unsigned)(fminf(fmaxf(val, 0.f), 31.f) * 1048576.f) + 1u;
            fx = forced ? 0x1FFFFFFu : (j <= cur_t ? fx : 0u);
            key[i] = (fx << 7) | (unsigned)(127 - j); }
#pragma unroll 1
        for (int r = 0; r < 16; ++r) {
            unsigned w = key[0];
#pragma unroll
            for (int i = 1; i < 16; ++i) w = w > key[i] ? w : key[i];
            { unsigned o = (unsigned)xshfl_i<1>((int)w); w = w > o ? w : o; o = (unsigned)xshfl_i<2>((int)w); w = w > o ? w : o; o = (unsigned)xshfl_i<32>((int)w); w = w > o ? w : o; }
            if ((w >> 7) != 0u) { const int j = 127 - (int)(w & 127u); const unsigned bit = 1u << (j & 31); const int jb = j >> 5;
                sm0 |= (jb == 0) ? bit : 0u; sm1 |= (jb == 1) ? bit : 0u; sm2 |= (jb == 2) ? bit : 0u; sm3 |= (jb == 3) ? bit : 0u; }
#pragma unroll
            for (int i = 0; i < 16; ++i) key[i] = (key[i] == w) ? 0u : key[i];
        }
    }
    f32x16 Ow[2]; float lw = 0.f;
#pragma unroll
    for (int i = 0; i < 16; ++i) { Ow[0][i] = 0.f; Ow[1][i] = 0.f; }
    {   f32x16 negm;
#pragma unroll
        for (int i = 0; i < 16; ++i) negm[i] = 120.f;
        const GAS unsigned char* kwp = (const GAS unsigned char*)(proj + rowb * PLD + C_KW); const GAS unsigned char* vwp = (const GAS unsigned char*)(proj + rowb * PLD + C_VW);
        const unsigned soffp = (unsigned)(skey * PLD + sch * 8) * 2u;
        const int s0 = (u < 8) ? 8 - u : 0;
        st_load(kwp, vwp, soffp + (unsigned)(u - 8 + s0) * (64u * PLD * 2u), kr, vr); st_write(lds, skey, sch, kr, vr); __syncthreads();
#pragma unroll 1
        for (int s = s0; s < 9; ++s) {
            const int par = (s - s0) & 1; const LAS unsigned char* cur = lds + par * DBUF_BYTES; LAS unsigned char* nxt = lds + (par ^ 1) * DBUF_BYTES;
            if (s + 1 < 9) st_load(kwp, vwp, soffp + (unsigned)(u - 8 + s + 1) * (64u * PLD * 2u), kr, vr);
            {   f32x16 S[2]; qk64(cur, kboff, qf, negm, S);
                if (s == 0 || s >= 6) mask_bias(S, t, (u - 8 + s) * 64, hh, 512, true, b2h);
                bf16x8 pk[2][2]; softmax_step(S, Ow, negm, lw, pk); pv64(cur, vboff, pk, Ow); }
            if (s + 1 < 9) st_write(nxt, skey, sch, kr, vr);
            __syncthreads();
        }
    }
    unsigned owp[2][8];
#pragma unroll
    for (int db = 0; db < 2; ++db)
#pragma unroll
        for (int i = 0; i < 8; ++i) owp[db][i] = cvtpk(Ow[db][2 * i], Ow[db][2 * i + 1]);
    f32x16 Os[2]; float lsel = 0.f;
#pragma unroll
    for (int i = 0; i < 16; ++i) { Os[0][i] = 0.f; Os[1][i] = 0.f; }
    {   f32x16 negm;
#pragma unroll
        for (int i = 0; i < 16; ++i) negm[i] = 120.f;
        const GAS unsigned char* ksp = (const GAS unsigned char*)(proj + rowb * PLD + C_KS); const GAS unsigned char* vsp = (const GAS unsigned char*)(proj + rowb * PLD + C_VS);
        const unsigned soffp = (unsigned)(skey * PLD + sch * 8) * 2u;
        st_load(ksp, vsp, soffp, kr, vr); st_write(lds, skey, sch, kr, vr); __syncthreads();
#pragma unroll 1
        for (int j = 0; j <= u; ++j) {
            const LAS unsigned char* cur = lds + (j & 1) * DBUF_BYTES; LAS unsigned char* nxt = lds + ((j + 1) & 1) * DBUF_BYTES;
            if (j + 1 <= u) st_load(ksp, vsp, soffp + (unsigned)(j + 1) * (64u * PLD * 2u), kr, vr);
            const int jb = j >> 5; const unsigned smw = jb == 0 ? sm0 : (jb == 1 ? sm1 : (jb == 2 ? sm2 : sm3));
            const bool bit = ((smw >> (j & 31)) & 1u) != 0u;
            if (__builtin_amdgcn_ballot_w64(bit) != 0ull) {
                f32x16 S[2]; qk64(cur, kboff, qf, negm, S);
                if (64 * j + 63 > tw0 - 113) mask_bias(S, t, 64 * j, hh, 1 << 30, bit, b2h);
                else if (!bit) {
#pragma unroll
                    for (int i = 0; i < 16; ++i) { S[0][i] = -1e30f; S[1][i] = -1e30f; } }
                bf16x8 pk[2][2]; softmax_step(S, Os, negm, lsel, pk); pv64(cur, vboff, pk, Os); }
            if (j + 1 <= u) st_write(nxt, skey, sch, kr, vr);
            __syncthreads();
        }
    }
    {   const float lwt = lw + xshfl<32>(lw), lst = lsel + xshfl<32>(lsel);
        const GAS bf16* gp = proj + (rowb + t) * PLD + C_DG + head * 3;
        const float g0 = sigmoidf_(bf2f(gp[0])), g1 = sigmoidf_(bf2f(gp[1])) / fmaxf(lst, 1e-30f), g2 = sigmoidf_(bf2f(gp[2])) / fmaxf(lwt, 1e-30f);
        GAS bf16* op = ys + (rowb + t) * 1024 + 768 + head * 64;
#pragma unroll
        for (int db = 0; db < 2; ++db)
#pragma unroll
            for (int gq = 0; gq < 4; ++gq) { const int d0 = 32 * db + 8 * gq + 4 * hh; float y[4];
#pragma unroll
                for (int e = 0; e < 4; ++e) { const unsigned cw = ocp[db][2 * gq + (e >> 1)], ww = owp[db][2 * gq + (e >> 1)];
                    y[e] = g0 * ((e & 1) ? hi_bf(cw) : lo_bf(cw)) + g1 * Os[db][4 * gq + e] + g2 * ((e & 1) ? hi_bf(ww) : lo_bf(ww)); }
                u32x2 w; w.x = cvtpk(y[0], y[1]); w.y = cvtpk(y[2], y[3]); *(GAS u32x2*)(op + d0) = w; }
    }
}


DI void swa_unit(const GAS bf16* proj, GAS bf16* ys, LAS unsigned char* lds, const LAS float* bias2, const LAS float* biasd, const GAS float* sinks, int b, int u, int tid_in, int lane_in, int wave_in) {
    int tid = tid_in, lane = lane_in, wave = wave_in; asm volatile("" : "+v"(tid), "+v"(lane), "+s"(wave));
    const int t0 = u * 64; const int col = lane & 31, hh = lane >> 5, tl = col >> 1, kv = wave & 1, head = 2 * kv + (col & 1);
    const int t = t0 + (wave >> 1) * 16 + tl;
    const size_t rowb = (size_t)b * SEQ;
    const LAS float* b2h = bias2 + head;
    bf16x8 qf[4];
    { const float SC = 0.125f * 1.4426950408889634f; const GAS bf16* qp = proj + (rowb + t) * PLD + C_BQ + head * 64 + hh * 8;
#pragma unroll
      for (int s = 0; s < 4; ++s) { const u32x4 w = *(const GAS u32x4*)(qp + s * 16); u32x4 o;
          o.x = cvtpk(lo_bf(w.x) * SC, hi_bf(w.x) * SC); o.y = cvtpk(lo_bf(w.y) * SC, hi_bf(w.y) * SC); o.z = cvtpk(lo_bf(w.z) * SC, hi_bf(w.z) * SC); o.w = cvtpk(lo_bf(w.w) * SC, hi_bf(w.w) * SC);
          qf[s] = __builtin_bit_cast(bf16x8, o); } }
    const int skey = tid >> 3, sch = tid & 7;
    const int i16 = lane & 15, blk = (lane >> 4) & 1;
    const int kboff = kv * DBUF_BYTES + col * DK_STR + hh * 16;
    const int vboff = kv * DBUF_BYTES + 64 * DK_STR + (4 * hh + (i16 >> 2)) * DV_STR + (16 * blk + 4 * (i16 & 3)) * 2;
    const GAS unsigned char* kp = (const GAS unsigned char*)(proj + rowb * PLD + C_BK); const GAS unsigned char* vp = (const GAS unsigned char*)(proj + rowb * PLD + C_BV);
    const unsigned soffp = (unsigned)(skey * PLD + sch * 8) * 2u;
    u32x4 k0, v0, k1, v1;
    f32x16 O[2], negm; float lsum = 0.f;
#pragma unroll
    for (int i = 0; i < 16; ++i) { O[0][i] = 0.f; O[1][i] = 0.f; negm[i] = 120.f; }
    const int s0 = (u < 2) ? 2 - u : 0;
    { const unsigned so = soffp + (unsigned)(u - 2 + s0) * (64u * PLD * 2u); st_load(kp, vp, so, k0, v0); st_load(kp + 128, vp + 128, so, k1, v1);
      st_write(lds, skey, sch, k0, v0); st_write(lds + DBUF_BYTES, skey, sch, k1, v1); }
    __syncthreads();
#pragma unroll 1
    for (int s = s0; s < 3; ++s) {
        const int par = (s - s0) & 1; const LAS unsigned char* cur = lds + par * 2 * DBUF_BYTES; LAS unsigned char* nxt = lds + (par ^ 1) * 2 * DBUF_BYTES;
        if (s + 1 < 3) { const unsigned so = soffp + (unsigned)(u - 2 + s + 1) * (64u * PLD * 2u); st_load(kp, vp, so, k0, v0); st_load(kp + 128, vp + 128, so, k1, v1); }
        {   f32x16 S[2]; qk64(cur, kboff, qf, negm, S);
            mask_bias(S, t, (u - 2 + s) * 64, hh, 128, true, b2h);
            bf16x8 pk[2][2]; softmax_step(S, O, negm, lsum, pk); pv64(cur, vboff, pk, O); }
        if (s + 1 < 3) { st_write(nxt, skey, sch, k0, v0); st_write(nxt + DBUF_BYTES, skey, sch, k1, v1); }
        __syncthreads();
    }
    {   const float sinkp = (sinks[head] - biasd[128 * 12 + head]) * 1.4426950408889634f;
        const float lt = lsum + xshfl<32>(lsum) + __builtin_amdgcn_exp2f(sinkp + negm[0]);
        const float inv = 1.f / fmaxf(lt, 1e-30f);
        GAS bf16* op = ys + (rowb + t) * 1024 + 256 + head * 64;
#pragma unroll
        for (int db = 0; db < 2; ++db)
#pragma unroll
            for (int gq = 0; gq < 4; ++gq) { const int d0 = 32 * db + 8 * gq + 4 * hh;
                u32x2 w; w.x = cvtpk(O[db][4 * gq + 0] * inv, O[db][4 * gq + 1] * inv); w.y = cvtpk(O[db][4 * gq + 2] * inv, O[db][4 * gq + 3] * inv); *(GAS u32x2*)(op + d0) = w; }
    }
}

DI void route_rows4(const KA& a, int l, bf16* xr_, int tok0, int lane_) {
    int lane = lane_; asm volatile("" : "+v"(lane));
    const GAS float* xrow = (const GAS float*)a.out + (size_t)tok0 * 1024; const GAS float* g = (const GAS float*)(a.in[28] + (size_t)l * 1024); GAS bf16* xr = (GAS bf16*)xr_;
    f32x4 v[4][4]; float ss[4];
#pragma unroll
    for (int rr = 0; rr < 4; ++rr)
#pragma unroll
        for (int j = 0; j < 4; ++j) v[rr][j] = *(const GAS f32x4*)(xrow + (size_t)rr * 1024 + 4 * (lane + 64 * j));
#pragma unroll
    for (int rr = 0; rr < 4; ++rr) { float t = 0.f;
#pragma unroll
        for (int j = 0; j < 4; ++j) t += (v[rr][j][0] * v[rr][j][0] + v[rr][j][1] * v[rr][j][1]) + (v[rr][j][2] * v[rr][j][2] + v[rr][j][3] * v[rr][j][3]);
        ss[rr] = t; }
#pragma unroll
    for (int rr = 0; rr < 4; ++rr) ss[rr] = wave_sum(ss[rr]);
#pragma unroll
    for (int j = 0; j < 4; ++j) { const int k0 = 4 * (lane + 64 * j); const f32x4 gv = *(const GAS f32x4*)(g + k0);
#pragma unroll
        for (int rr = 0; rr < 4; ++rr) { const float r = 1.f / sqrtf(ss[rr] * (1.f / 1024.f) + 1e-6f); const f32x4 xn = v[rr][j] * r * gv;
            unsigned hi[4]; float lo[4];
#pragma unroll
            for (int e = 0; e < 4; ++e) { hi[e] = f2bf(xn[e]); lo[e] = xn[e] - __builtin_bit_cast(float, hi[e] << 16); }
            u32x2 wh, wl; wh.x = hi[0] | (hi[1] << 16); wh.y = hi[2] | (hi[3] << 16); wl.x = pk2(lo[0], lo[1]); wl.y = pk2(lo[2], lo[3]);
            *(GAS u32x2*)(xr + (size_t)(tok0 + rr) * 2048 + k0) = wh; *(GAS u32x2*)(xr + (size_t)(tok0 + rr) * 2048 + 1024 + k0) = wl; } }
}
struct SchedRoute { const char* A; const char* B; int pm;
    DI bool next(int i, Unit& u) const { if (i > 0) return false; u.pm = pm; u.pn = 0; u.aux = 0; u.pad = 0; u.a = A + (size_t)pm * 128 * 2048 * 2; u.b = B; return true; } };
struct EpiRoute { float* rlog;
    DI void operator()(const f32x4 (&acc)[2][2][4][2], const Unit& u, int wr, int wc, int fr, int fq) const {
        const int row0 = u.pm * 128 + wr * 64 + fr; const int col = wc * 32 + 8 * fq;
#pragma unroll
        for (int m = 0; m < 4; ++m) { float* rp = rlog + (size_t)(row0 + m * 16) * 128 + col; *(f32x4*)rp = acc[0][0][m][0]; *(f32x4*)(rp + 4) = acc[0][0][m][1]; }
    }
};
DI void route_decide(const KA& a, int l, const float* rl_row, int* rec_e, int* rec_slot, float* rec_w, unsigned* cnt, int tok) {
    float lg[36];
    const float* bg = a.in[30] + l * 4; const float* be = a.in[32] + l * 32;
#pragma unroll
    for (int q = 0; q < 9; ++q) { const f32x4 h = *(const f32x4*)(rl_row + 4 * q), lo = *(const f32x4*)(rl_row + 64 + 4 * q);
        lg[4 * q + 0] = h[0] + lo[0]; lg[4 * q + 1] = h[1] + lo[1]; lg[4 * q + 2] = h[2] + lo[2]; lg[4 * q + 3] = h[3] + lo[3]; }
#pragma unroll
    for (int i = 0; i < 4; ++i) lg[i] += bg[i];
#pragma unroll
    for (int i = 0; i < 32; ++i) lg[4 + i] += be[i];
    int gsel = 0; float gm = lg[0];
#pragma unroll
    for (int i = 1; i < 4; ++i) if (lg[i] > gm) { gm = lg[i]; gsel = i; }
    float gs = 0.f;
#pragma unroll
    for (int i = 0; i < 4; ++i) gs += __expf(lg[i] - gm);
    const float gwt = 1.f / gs;
    float v8[8];
#pragma unroll
    for (int i = 0; i < 8; ++i) { float x = lg[4 + i];
#pragma unroll
        for (int gq = 1; gq < 4; ++gq) x = (gsel == gq) ? lg[4 + gq * 8 + i] : x;
        v8[i] = x; }
    int i0 = 0; float m0 = v8[0];
#pragma unroll
    for (int i = 1; i < 8; ++i) if (v8[i] > m0) { m0 = v8[i]; i0 = i; }
    int i1 = -1; float m1 = -3e38f;
#pragma unroll
    for (int i = 0; i < 8; ++i) if (i != i0 && v8[i] > m1) { m1 = v8[i]; i1 = i; }
    const float w0 = 1.f / (1.f + __expf(m1 - m0)); const float w1 = 1.f - w0;
    const int e0 = gsel * 8 + i0, e1 = gsel * 8 + i1;
    const unsigned s0 = __hip_atomic_fetch_add(cnt + e0, 1u, __ATOMIC_RELAXED, __HIP_MEMORY_SCOPE_AGENT);
    const unsigned s1 = __hip_atomic_fetch_add(cnt + e1, 1u, __ATOMIC_RELAXED, __HIP_MEMORY_SCOPE_AGENT);
    rec_e[tok * 2] = e0; rec_e[tok * 2 + 1] = e1; rec_slot[tok * 2] = (int)s0; rec_slot[tok * 2 + 1] = (int)s1; rec_w[tok * 2] = w0 * gwt; rec_w[tok * 2 + 1] = w1 * gwt;
}
DI void expert_weights(const KA& a, int l, LAS unsigned char* lds, int it0, int it1, int gw, int NGW, int wave, int lane) {
    LAS float* scr = (LAS float*)(lds + wave * 16384);
    const float* wgt = a.in[33] + (size_t)l * 32 * 1024 * 256; const float* wup = a.in[34] + (size_t)l * 32 * 1024 * 256; const float* wdn = a.in[35] + (size_t)l * 32 * 256 * 1024;
    bf16* Wgu = (bf16*)(a.ws + WS_WGU); bf16* Wd = (bf16*)(a.ws + WS_WD);
    constexpr int I_E = 16 * 8, I_D = 4 * 32;
    constexpr int NIT = 32 * (2 * I_E + I_D);
    (void)NIT;
    for (int it = it0 + gw; it < it1; it += NGW) {
        const int e = it / (2 * I_E + I_D); int r = it % (2 * I_E + I_D);
        if (r < 2 * I_E) { const int up = r / I_E, q = r % I_E, kb = q / 8, nb = q % 8; const int n0 = nb * 32;
            const int drow = (n0 >> 7) * 256 + up * 128 + (n0 & 127);
            transpose_item((up ? wup : wgt) + (size_t)e * 1024 * 256, 256, 256, Wgu + (size_t)e * 512 * 1024, 1024, kb * 64, n0, drow, scr, lane);
        } else { r -= 2 * I_E; const int kb = r / 32, nb = r % 32;
            transpose_item(wdn + (size_t)e * 256 * 1024, 1024, 1024, Wd + (size_t)e * 1024 * 256, 256, kb * 64, nb * 32, nb * 32, scr, lane); }
    }
}
DI void build_offsets(const unsigned* cnt, LAS int* offt, int tid) {
    if (tid == 0) { int o = 0; for (int e = 0; e < 32; ++e) { offt[e] = o; const int c = (int)__hip_atomic_load(cnt + e, __ATOMIC_RELAXED, __HIP_MEMORY_SCOPE_AGENT); o += (c + 255) & ~255; } offt[32] = o; }
    __syncthreads();
    for (int rt = tid; rt < (MOE_ROWS >> 8); rt += 512) { int e = 0; for (int j = 1; j < 32; ++j) e += (offt[j] <= rt * 256) ? 1 : 0; offt[40 + rt] = e; }
    __syncthreads();
}

template <unsigned PM>
__global__ void __launch_bounds__(512, 2) mk_fwd(Args a_) {
    extern __shared__ __attribute__((aligned(16))) unsigned char lds_raw[];
    LAS unsigned char* lds = (LAS unsigned char*)lds_raw;
    const int wave0 = __builtin_amdgcn_readfirstlane((int)threadIdx.x >> 6);
    if (threadIdx.x < 36) ((LAS unsigned long long*)(lds + PTAB_OFF))[threadIdx.x] = (unsigned long long)a_.in[threadIdx.x];
    __syncthreads();
    KA a; a.in.base = (unsigned)(size_t)(lds + PTAB_OFF); a.out = a_.out; a.ws = a_.ws;
    const int G = gridDim.x, bid = blockIdx.x, NGW = G * 8;
#define PHASE_IDS() int wave = wave0; asm volatile("" : "+s"(wave)); const int lane = my_lane(); const int tid_ = wave * 64 + lane, gw = bid * 8 + wave; (void)tid_; (void)gw; \
    KA ap = a; asm volatile("" : "+s"(ap.ws), "+s"(ap.out), "+s"(ap.in.base)); \
    bf16* hb = (bf16*)(ap.ws + WS_HB); bf16* proj = (bf16*)(ap.ws + WS_PROJ); bf16* gates = (bf16*)(ap.ws + WS_GATES); \
    bf16* ys = hb; bf16* x2b = hb; bf16* merged = proj; bf16* eo = proj; \
    bf16* kcb = (bf16*)(ap.ws + WS_KCVC); float* lrusum = (float*)(ap.ws + WS_LRUSUM); \
    int* rec_e = (int*)(ap.ws + WS_REC); int* rec_slot = rec_e + T * 2; float* rec_w = (float*)(rec_slot + T * 2); \
    int* rowtok = (int*)(ap.ws + WS_ROWTOK); float* roww = (float*)(ap.ws + WS_ROWW); \
    bf16* xs = (bf16*)(ap.ws + WS_XS); bf16* hmid = (bf16*)(ap.ws + WS_HMID); unsigned* ctl = (unsigned*)(ap.ws + WS_CTL); \
    (void)hb; (void)proj; (void)gates; (void)ys; (void)x2b; (void)merged; (void)eo; (void)kcb; (void)lrusum; (void)rec_e; (void)rec_slot; (void)rec_w; (void)rowtok; (void)roww; (void)xs; (void)hmid; (void)ctl
    volatile LAS unsigned* MISC = (volatile LAS unsigned*)(lds + MISC_OFF);
    LAS float* biasd = (LAS float*)(lds + BIAS_OFF);
    LAS int* offt = (LAS int*)(lds + OFFT_OFF);
    { PHASE_IDS();
    if (tid_ < 64) MISC[tid_] = 0u;
    for (int i = tid_; i < 129 * 12; i += 512) { const int d = i / 12, hd = i % 12; const int bk = d < 128 ? T5_BUCKET[d] : 31; const float* rb = a.in[1]; biasd[i] = rb[bk * 12 + hd]; ((LAS float*)(lds + BIAS2_OFF))[i] = (rb[bk * 12 + hd] - rb[31 * 12 + hd]) * 1.4426950408889634f; } }
    __syncthreads();
    const int lo = a_.ph_lo, hi = a_.ph_hi;
    XcdBarrier bar; bar.bar = (unsigned*)(a.ws + WS_CTL) + CW_BAR; bar.x = 0; bar.st = nullptr;
    if (hi - lo > 1) { PHASE_IDS(); bar = xcd_barrier_post(ctl + CW_BAR, MISC + 8, tid_ == 0); }
#ifndef SUB_MASK
#define SUB_MASK 0xFFu
#endif
#define SUB(k) ((SUB_MASK >> (k)) & 1u)
#define HASP(k) ((PM >> ((k) % PPL + ((k) >= 2 * PPL ? PPL : 0))) & 1u)
#define IN(k) (HASP(k) && lo <= (k) && (k) < hi)
#define SEAM(k) do { if ((k) + 1 < hi) { const int sl_ = my_lane(); int sw_ = wave0; asm volatile("" : "+s"(sw_)); xcd_barrier(bar, sw_ == 0 && sl_ == 0); } } while (0)
    for (int l = 0; l < DEPTH; ++l) {
        const int pb = l * PPL;
        if (IN(pb + 0)) { PHASE_IDS(); router_weights(ap, l, gw, NGW, lane); cmp_weights(ap, l, lds, gw, NGW, wave, lane); phase0_weights(ap, l, lds, gw, NGW, wave, lane); phase0_rows(ap, l, 0, gw, NGW, lane); SEAM(pb + 0); }
        if (IN(pb + 1)) {
            PHASE_IDS();
            pg8::Gemm g{1024, 1024, 1024, 128, -1}; SchedP1 S{(const char*)hb, (const char*)(ap.ws + WS_WIN), G, bid};
            EpiP1 E{proj, gates, ap.in[25] + (size_t)l * 4096};
            pg8::gemm_phase<EpiP1, SchedP1>(lds, g, S, E, tid_); SEAM(pb + 1);
        }
        if (IN(pb + 2)) {
            PHASE_IDS();
            float s1 = 0.f, s2 = 0.f;
            for (int i = 0; i < 32; ++i) { s1 += ap.in[13][l * 32 + i] * ap.in[14][l * 32 + i]; s2 += ap.in[15][l * 32 + i] * ap.in[16][l * 32 + i]; }
            const float lam_init = 0.8f - 0.6f * __expf(-0.3f * (float)l); const float lam = __expf(s1) - __expf(s2) + lam_init;
            if (SUB(0)) { const LAS float* bias2 = (const LAS float*)(lds + BIAS2_OFF); const GAS float* subg = (const GAS float*)(ap.in[17] + l * 64);
                for (int pi = bid; pi < 256; pi += G) { const int bh = pi >> 4, qlo = pi & 15;
                    diff_unit((const GAS bf16*)proj, (GAS bf16*)ys, lds, bias2, subg, lam, lam_init, bh >> 2, bh & 3, 31 - qlo, tid_, lane, wave);
                    diff_unit((const GAS bf16*)proj, (GAS bf16*)ys, lds, bias2, subg, lam, lam_init, bh >> 2, bh & 3, qlo, tid_, lane, wave); } }
            if (SUB(3)) { __syncthreads(); const LAS float* bias2 = (const LAS float*)(lds + BIAS2_OFF); const GAS float* sinks = (const GAS float*)(ap.in[12] + l * 4);
                for (int pi = bid; pi < 512; pi += G) swa_unit((const GAS bf16*)proj, (GAS bf16*)ys, lds, bias2, biasd, sinks, pi >> 7, pi & 127, tid_, lane, wave); }
            if (SUB(2)) { pg8::Gemm g{1024, 16 * PLD, 1024, PLD * 2, -1}; SchedCmp S{(const char*)proj, (const char*)(ap.ws + WS_WCMP), G, bid}; EpiCmp E{(float*)(ap.ws + WS_CMPAB)};
                pg8::gemm_phase<EpiCmp, SchedCmp>(lds, g, S, E, tid_); }
            if (SUB(1)) { __syncthreads(); for (int task = bid; task < 512; task += G) lru_unit(ap, l, (const GAS bf16*)proj, (GAS bf16*)ys, (GAS float*)lrusum, lds, task, lane, wave, false); }
            SEAM(pb + 2);
        }
        if (IN(pb + 3)) {
            PHASE_IDS();
            for (int task = gw; task < 2 * BATCH * NCMP; task += NGW) cmp_finish(ap, l, (const float*)(ap.ws + WS_CMPAB), kcb, task, lane);
            __syncthreads();
            for (int task = bid; task < 512; task += G) lru_unit(ap, l, (const GAS bf16*)proj, (GAS bf16*)ys, (GAS float*)lrusum, lds, task, lane, wave, true);
            SEAM(pb + 3);
        }
        if (IN(pb + 4)) {
            PHASE_IDS();
            if (SUB(4)) { const LAS float* bias2 = (const LAS float*)(lds + BIAS2_OFF);
                for (int pi = bid; pi < 256; pi += G) { const int bb = pi >> 6, ulo = pi & 63;
                    nsa_unit((const GAS bf16*)proj, (GAS bf16*)ys, (const GAS bf16*)kcb, lds, bias2, bb, 127 - ulo, tid_, lane, wave);
                    nsa_unit((const GAS bf16*)proj, (GAS bf16*)ys, (const GAS bf16*)kcb, lds, bias2, bb, ulo, tid_, lane, wave); } }
            SEAM(pb + 4);
        }
        if (IN(pb + 5)) {
            PHASE_IDS();
            pg8::Gemm g{256, 1024, 256, 128, -1}; SchedP3a S{(const char*)ys, (const char*)(ap.ws + WS_WBR), G, bid};
            EpiP3a E{merged, gates};
            pg8::gemm_phase<EpiP3a, SchedP3a>(lds, g, S, E, tid_); SEAM(pb + 5);
        }
        if (IN(pb + 6)) {
            PHASE_IDS();
            pg8::Gemm g{1024, 1024, 1024, 128, -1}; SchedP3b S{(const char*)merged, (const char*)(ap.ws + WS_WOUT), G, bid};
            EpiP3b E{(l == 0) ? ap.in[0] : ap.out, ap.out};
            pg8::gemm_phase<EpiP3b, SchedP3b>(lds, g, S, E, tid_); SEAM(pb + 6);
        }
        if (IN(pb + 7)) {
            PHASE_IDS();
            bf16* xr = (bf16*)(ap.ws + WS_XR); float* rlog = (float*)(ap.ws + WS_RLOG);
            constexpr int NITW = 32 * (2 * 16 * 8 + 4 * 32);
            { const int pm = bid;
                for (int r = wave * 4; r < 128; r += 32) route_rows4(ap, l, xr, pm * 128 + r, lane);
                asm volatile("s_waitcnt vmcnt(0)" ::: "memory"); __syncthreads();
                { pg8::Gemm g{2048, 2048, 2048, 128, 0}; SchedRoute S{(const char*)xr, (const char*)(ap.ws + WS_WR), pm}; EpiRoute E{rlog};
                  pg8::gemm_phase<EpiRoute, SchedRoute>(lds, g, S, E, tid_); }
                asm volatile("s_waitcnt vmcnt(0)" ::: "memory"); __syncthreads();
                if (tid_ < 128) route_decide(ap, l, rlog + (size_t)(pm * 128 + tid_) * 128, rec_e, rec_slot, rec_w, ctl + CW_CNT + l * 32, pm * 128 + tid_);
                __syncthreads();
            }
            expert_weights(ap, l, lds, 0, NITW, gw, NGW, wave, lane);
            SEAM(pb + 7);
        }
        if (IN(pb + 8)) {
            PHASE_IDS();
            build_offsets(ctl + CW_CNT + l * 32, offt, tid_);
            if (bid < 32) { const int e = bid; const int c = (int)__hip_atomic_load(ctl + CW_CNT + l * 32 + e, __ATOMIC_RELAXED, __HIP_MEMORY_SCOPE_AGENT);
                for (int p = offt[e] + c + tid_; p < offt[e + 1]; p += 512) rowtok[p] = -1; }
            {   const GAS bf16* xr = (const GAS bf16*)(ap.ws + WS_XR); GAS bf16* xsg = (GAS bf16*)xs;
                for (int tok0 = gw * 4; tok0 < T; tok0 += NGW * 4) {
                    u32x4 v0[4], v1[4]; int pos[4][2];
#pragma unroll
                    for (int rr = 0; rr < 4; ++rr) { v0[rr] = *(const GAS u32x4*)(xr + (size_t)(tok0 + rr) * 2048 + lane * 8); v1[rr] = *(const GAS u32x4*)(xr + (size_t)(tok0 + rr) * 2048 + 512 + lane * 8);
#pragma unroll
                        for (int k = 0; k < 2; ++k) pos[rr][k] = offt[rec_e[(tok0 + rr) * 2 + k]] + rec_slot[(tok0 + rr) * 2 + k]; }
#pragma unroll
                    for (int rr = 0; rr < 4; ++rr)
#pragma unroll
                        for (int k = 0; k < 2; ++k) { const int p = pos[rr][k];
                            *(GAS u32x4*)(xsg + (size_t)p * 1024 + lane * 8) = v0[rr]; *(GAS u32x4*)(xsg + (size_t)p * 1024 + 512 + lane * 8) = v1[rr];
                            if (lane == 0) { rowtok[p] = (tok0 + rr) * 2 + k; roww[p] = rec_w[(tok0 + rr) * 2 + k]; } } } }
            SEAM(pb + 8);
        }
        if (IN(pb + 9)) {
            PHASE_IDS();
            build_offsets(ctl + CW_CNT + l * 32, offt, tid_);
            pg8::Gemm g{1024, 1024, 1024, 128, -1}; SchedM2 S{(const char*)xs, (const char*)(ap.ws + WS_WGU), offt, G, bid};
            EpiM2 E{hmid};
            pg8::gemm_phase<EpiM2, SchedM2>(lds, g, S, E, tid_); SEAM(pb + 9);
        }
        if (IN(pb + 10)) {
            PHASE_IDS();
            build_offsets(ctl + CW_CNT + l * 32, offt, tid_);
            pg8::Gemm g{256, 256, 256, 128, -1}; SchedM3 S{(const char*)hmid, (const char*)(ap.ws + WS_WD), offt, G, bid};
            EpiM3 E{eo, rowtok, roww};
            pg8::gemm_phase<EpiM3, SchedM3>(lds, g, S, E, tid_); SEAM(pb + 10);
        }
    }
    if (IN(2 * PPL)) { PHASE_IDS(); phase0_rows(ap, DEPTH, 1, gw, NGW, lane); }
#undef IN
#undef SEAM
}

typedef void (*kern_t)(Args);
template <unsigned PM> static bool setup_kernel() {
    if (hipFuncSetAttribute((const void*)mk_fwd<PM>, hipFuncAttributeMaxDynamicSharedMemorySize, LDS_BYTES) != hipSuccess) { fprintf(stderr, "kernel_launch: hipFuncSetAttribute failed\n"); return false; }
    return true;
}
extern "C" void kernel_launch(void* const* d_in, const int* in_sizes, int n_in, void* d_out, int out_size, void* d_ws, size_t ws_size, hipStream_t stream) {
    static int grid = 0;
    if (grid == 0) {
        if (n_in != 36 || out_size != T * D || ws_size < WS_END) { fprintf(stderr, "kernel_launch: unexpected shapes (n_in %d out %d ws %zu)\n", n_in, out_size, ws_size); grid = -1; return; }
        int dev = 0, cus = 0;
        if (hipGetDevice(&dev) != hipSuccess || hipDeviceGetAttribute(&cus, hipDeviceAttributeMultiprocessorCount, dev) != hipSuccess) { grid = -1; return; }
        bool ok = true;
#if MK_ONE_LAUNCH
        ok = setup_kernel<0xFFFu>();
#endif
        if (!ok) { grid = -1; return; }
        (void)hipGetLastError();
        grid = cus;
        if (grid != 256) { fprintf(stderr, "kernel_launch: built for a 256-CU device (got %d)\n", cus); grid = -1; return; }
    }
    if (grid < 0) return;
    if (hipMemsetAsync((char*)d_ws + WS_CTL, 0, CTL_ZERO_BYTES, stream) != hipSuccess) return;
    Args a{};
    for (int i = 0; i < 36; ++i) a.in[i] = (const float*)d_in[i];
    a.out = (float*)d_out; a.ws = (unsigned char*)d_ws;
#if MK_ONE_LAUNCH
    a.ph_lo = 0; a.ph_hi = NPH;
    hipLaunchKernelGGL(mk_fwd<0xFFFu>, dim3(grid), dim3(512), LDS_BYTES, stream, a);
#endif
}
```

```cpp
#include <hip/hip_runtime.h>
#include <cstdio>
#include <cstdint>

#ifndef MK_ONE_LAUNCH
#define MK_ONE_LAUNCH 1
#endif

#define DI __device__ __forceinline__
#define GAS __attribute__((address_space(1)))
#define LAS __attribute__((address_space(3)))
typedef unsigned short bf16;
typedef short bf16x8 __attribute__((ext_vector_type(8)));
typedef float f32x4 __attribute__((ext_vector_type(4)));
typedef unsigned u32x4 __attribute__((ext_vector_type(4)));
typedef unsigned u32x2 __attribute__((ext_vector_type(2)));
typedef float f32x16 __attribute__((ext_vector_type(16)));
typedef float f32x2 __attribute__((ext_vector_type(2)));
typedef short s16x4 __attribute__((ext_vector_type(4)));
typedef __bf16 bf16x2_t __attribute__((ext_vector_type(2)));
typedef short v4i16_t __attribute__((__vector_size__(4 * sizeof(short))));
#define MFMA32(a, b, c) __builtin_amdgcn_mfma_f32_32x32x16_bf16((a), (b), (c), 0, 0, 0)

constexpr int BATCH = 4, SEQ = 8192, T = BATCH * SEQ, D = 1024, DEPTH = 2;
constexpr int NIN = 2444, PLD = 2560, N1 = 6656, GLD = 4096;
constexpr int C_AX = 0, C_AG = 256, C_BQ = 512, C_BK = 768, C_BV = 896, C_CQ = 1024, C_CK = 1280, C_CV = 1536, C_DQ = 1792,
              C_KC = 2048, C_VC = 2112, C_KS = 2176, C_VS = 2240, C_KW = 2304, C_VW = 2368, C_DG = 2432;
constexpr int NCMP = 511;
constexpr int MOE_ROWS = 73728;
constexpr int PPL = 11;
constexpr int NPH = 2 * PPL + 1;

constexpr size_t MiB = 1u << 20;
constexpr size_t WS_CTL = 0, CTL_ZERO_BYTES = 1 * MiB;
constexpr size_t WS_KCVC = 1 * MiB;
constexpr size_t WS_LRUSUM = 2 * MiB;
constexpr size_t WS_REC = 2 * MiB + 256 * 1024;
constexpr size_t WS_ROWTOK = 3 * MiB;
constexpr size_t WS_ROWW = 3 * MiB + 512 * 1024;
constexpr size_t WS_WIN = 4 * MiB;
constexpr size_t WS_WBR = 17 * MiB;
constexpr size_t WS_WOUT = 19 * MiB;
constexpr size_t WS_HB = 21 * MiB;
constexpr size_t WS_PROJ = 85 * MiB;
constexpr size_t WS_GATES = 245 * MiB;
constexpr size_t WS_WGU = 245 * MiB;
constexpr size_t WS_WD = 277 * MiB;
constexpr size_t WS_XS = 293 * MiB;
constexpr size_t WS_HMID = 437 * MiB;
constexpr size_t WS_XR = 85 * MiB;
constexpr size_t WS_RLOG = 213 * MiB;
constexpr size_t WS_WR = 501 * MiB;
constexpr size_t WS_WCMP = 502 * MiB;
constexpr size_t WS_CMPAB = 503 * MiB;
constexpr size_t WS_LRUW = 505 * MiB + 65536;
constexpr size_t WS_END = 506 * MiB;
constexpr int CW_BAR = 4096;
constexpr int CW_CNT = 16384;

constexpr int RING_BYTES = 131072;
constexpr int MISC_OFF = RING_BYTES;
constexpr int BIAS_OFF = MISC_OFF + 256;
constexpr int OFFT_OFF = BIAS_OFF + 129 * 12 * 4;
constexpr int PTAB_OFF = OFFT_OFF + (40 + 288) * 4;
constexpr int BIAS2_OFF = PTAB_OFF + 36 * 8;
constexpr int LRUEX_OFF = BIAS2_OFF + 129 * 12 * 4;
constexpr int LDS_BYTES = 163840;
constexpr int LRUCST_OFF = LRUEX_OFF + 8 * 64 * 2 * 4;
constexpr int LRUCAR_OFF = LRUCST_OFF + 3 * 64 * 4;
static_assert(PTAB_OFF % 8 == 0 && LRUCAR_OFF + 8 * 64 * 4 <= LDS_BYTES, "LDS map");

DI float bf2f(bf16 v) { return __builtin_bit_cast(float, (unsigned)v << 16); }
DI float lo_bf(unsigned w) { return __builtin_bit_cast(float, w << 16); }
DI float hi_bf(unsigned w) { return __builtin_bit_cast(float, w & 0xffff0000u); }
DI unsigned f2bf(float f) { unsigned u = __builtin_bit_cast(unsigned, f); return (u + 0x7fffu + ((u >> 16) & 1u)) >> 16; }
DI unsigned pk2(float lo, float hi) { return f2bf(lo) | (f2bf(hi) << 16); }
DI float rl(float v, int i) { return __builtin_bit_cast(float, __builtin_amdgcn_readlane(__builtin_bit_cast(int, v), i)); }
DI int rli(int v, int i) { return __builtin_amdgcn_readlane(v, i); }
DI int my_lane() { int l; asm volatile("v_mbcnt_lo_u32_b32 %0, -1, 0\n\tv_mbcnt_hi_u32_b32 %0, -1, %0" : "=v"(l)); return l; }
template <int O> DI int xshfl_i(int v) {
    if constexpr (O < 32) return __builtin_amdgcn_ds_swizzle(v, (O << 10) | 0x1f);
    else { const int l = my_lane(); return __builtin_amdgcn_ds_bpermute((l ^ 32) << 2, v); }
}
template <int O> DI float xshfl(float v) { return __builtin_bit_cast(float, xshfl_i<O>(__builtin_bit_cast(int, v))); }
DI float wave_sum(float v) { v += xshfl<1>(v); v += xshfl<2>(v); v += xshfl<4>(v); v += xshfl<8>(v); v += xshfl<16>(v); v += xshfl<32>(v); return v; }
DI float wave_max(float v) { v = fmaxf(v, xshfl<1>(v)); v = fmaxf(v, xshfl<2>(v)); v = fmaxf(v, xshfl<4>(v)); v = fmaxf(v, xshfl<8>(v)); v = fmaxf(v, xshfl<16>(v)); v = fmaxf(v, xshfl<32>(v)); return v; }
DI float sigmoidf_(float x) { return 1.f / (1.f + __expf(-x)); }
DI float gelu_tanh(float x) { const float u = 0.7978845608028654f * (x + 0.044715f * x * x * x); const float e = __expf(2.f * u); const float th = 1.f - 2.f * __builtin_amdgcn_rcpf(e + 1.f); return 0.5f * x * (1.f + th); }
DI float softplusf_(float x) { return fmaxf(x, 0.f) + log1pf(__expf(-fabsf(x))); }
#define LDS_WAIT() asm volatile("s_waitcnt lgkmcnt(0)" ::: "memory")
#define VM_WAIT() asm volatile("s_waitcnt vmcnt(0)" ::: "memory")

__device__ const unsigned char T5_BUCKET[128] = {
0,1,2,3,4,5,6,7,8,9,10,11,12,13,14,15,16,16,16,17,17,18,18,18,19,19,19,20,20,20,20,21,21,21,21,22,22,22,22,22,23,23,23,23,23,23,24,24,24,24,24,24,25,25,25,25,25,25,25,26,26,26,26,26,26,26,26,27,27,27,27,27,27,27,27,27,27,28,28,28,28,28,28,28,28,28,28,29,29,29,29,29,29,29,29,29,29,29,29,30,30,30,30,30,30,30,30,30,30,30,30,30,30,31,31,31,31,31,31,31,31,31,31,31,31,31,31,31};

#define XB_TMO      128
#define XB_XCNT(j)  (256  + 64 * (j))
#define XB_XSUB(j)  (1280 + 64 * (j))
#define XB_XGEN(j)  (2304 + 64 * (j))
#define XB_TOP      3328
#define XB_TOPGEN   3392
#define XCD_BAR_WORDS 3456
#define XB_SPIN_CAP (1u << 22)
DI unsigned xb_ld(unsigned* p)              { return __hip_atomic_load(p, __ATOMIC_RELAXED, __HIP_MEMORY_SCOPE_AGENT); }
DI unsigned xb_add(unsigned* p, unsigned v) { return __hip_atomic_fetch_add(p, v, __ATOMIC_RELAXED, __HIP_MEMORY_SCOPE_AGENT); }
DI unsigned xb_xcc_id() { return (unsigned)__builtin_amdgcn_s_getreg((3 << 11) | 20) & 0xFu; }
#define XB_SPIN(cond, bar) do { unsigned _sp = 0; while (cond) { __builtin_amdgcn_s_sleep(1); \
    if ((++_sp & 255u) == 0u) { if (xb_ld(&(bar)[XB_TMO])) break; if (_sp > XB_SPIN_CAP) { atomicAdd(&(bar)[XB_TMO], 1u); break; } } } } while (0)
struct XcdBarrier { unsigned* bar; unsigned x; volatile LAS unsigned* st; };
DI XcdBarrier xcd_barrier_post(unsigned* bar, volatile LAS unsigned* st, bool leader) {
    XcdBarrier b; b.bar = bar; b.x = xb_xcc_id(); b.st = st;
    if (leader) (void)xb_add(&bar[XB_XCNT(b.x)], 1u);
    return b;
}
DI void xcd_barrier_complete(unsigned* bar, unsigned x, unsigned& nloc, unsigned& nx) {
    const unsigned G = gridDim.x * gridDim.y * gridDim.z;
    unsigned sum, cnt, mine, sp = 0u;
    for (;;) {
        sum = 0u; cnt = 0u; mine = 0u;
#pragma unroll
        for (unsigned j = 0; j < 16; ++j) { const unsigned c = xb_ld(&bar[XB_XCNT(j)]); sum += c; cnt += (c > 0u) ? 1u : 0u; mine = (j == x) ? c : mine; }
        if (sum == G) break;
        __builtin_amdgcn_s_sleep(1);
        if ((++sp & 255u) == 0u) { if (xb_ld(&bar[XB_TMO])) break; if (sp > XB_SPIN_CAP) { atomicAdd(&bar[XB_TMO], 1u); break; } }
    }
    nloc = mine > 0u ? mine : 1u; nx = cnt > 0u ? cnt : 1u;
}
DI void xcd_barrier(const XcdBarrier& b, bool leader) {
    asm volatile("s_waitcnt vmcnt(0)" ::: "memory");
    __syncthreads();
    if (leader) {
        unsigned* bar = b.bar;
        __builtin_amdgcn_s_waitcnt(0);
        unsigned nloc = b.st[0], nx = b.st[1];
        if (nloc == 0u) { xcd_barrier_complete(bar, b.x, nloc, nx); b.st[0] = nloc; b.st[1] = nx; }
        const unsigned old = xb_add(&bar[XB_XSUB(b.x)], 1u);
        const unsigned gen = old / nloc;
        if (old + 1u == (gen + 1u) * nloc) {
            __builtin_amdgcn_fence(__ATOMIC_RELEASE, "agent");
            asm volatile("s_waitcnt vmcnt(0)" ::: "memory");
            const unsigned og = xb_add(&bar[XB_TOP], 1u);
            const unsigned tg = og / nx;
            if (og + 1u == (tg + 1u) * nx) xb_add(&bar[XB_TOPGEN], 1u);
            else XB_SPIN(xb_ld(&bar[XB_TOPGEN]) == tg, bar);
            __builtin_amdgcn_fence(__ATOMIC_ACQUIRE, "agent");
            xb_add(&bar[XB_XGEN(b.x)], 1u);
            asm volatile("s_waitcnt vmcnt(0)" ::: "memory");
        } else {
            XB_SPIN(xb_ld(&bar[XB_XGEN(b.x)]) == gen, bar);
            __builtin_amdgcn_fence(__ATOMIC_ACQUIRE, "agent");
            asm volatile("s_waitcnt vmcnt(0)" ::: "memory");
        }
    }
    __syncthreads();
}

namespace pg8 {
constexpr int BM = 256, BK = 64, HALF = 128, HTB = HALF * BK * 2;
__host__ __device__ __forceinline__ int lds_byte(int r, int c) { const int st = (r >> 4) * 2 + (c >> 5), rr = r & 15, cc = c & 31, ob = rr * 64 + cc * 2; return st * 1024 + (ob ^ (((ob >> 9) & 1) << 5)); }
__host__ __device__ __forceinline__ void stage_rc(int b, int& R, int& C) { const int st = b / 1024, sb = b % 1024, swz = sb ^ (((sb >> 9) & 1) << 5); R = (st >> 1) * 16 + swz / 64; C = (st & 1) * 32 + (swz % 64) / 2; }
__host__ __device__ __forceinline__ int perm32(int rho) { const int n = rho >> 4, i = rho & 15; return 8 * (i >> 2) + 4 * n + (i & 3); }
struct Unit { const char* a; const char* b; int pm, pn, aux, pad; };
struct Gemm { int K, lda, ldb, kstepA, hstepA; };
template <class Epi, class Sched>
DI void gemm_phase(LAS unsigned char* lds, const Gemm g, const Sched& S, const Epi& E, int tid_in) {
    int tid = tid_in; asm volatile("" : "+v"(tid));
    const int wid = __builtin_amdgcn_readfirstlane(tid >> 6), lane = tid & 63, wr = wid >> 2, wc = wid & 3, fr = lane & 15, fq = lane >> 4;
    const int K = g.K, nt = K / BK;
    unsigned voffA[2], voffB[2];
#pragma unroll
    for (int i = 0; i < 2; ++i) { int R, C; stage_rc(tid * 16 + i * 8192, R, C); const int Rb = (R & ~31) + perm32(R & 31);
        voffA[i] = (unsigned)(R * g.lda + C) * 2u; voffB[i] = (unsigned)(Rb * g.ldb + C) * 2u; }
    const size_t kstep = (size_t)(BK * 2), kstepA = (size_t)g.kstepA;
    const size_t hstepA = g.hstepA < 0 ? (size_t)HALF * g.lda * 2 : (size_t)g.hstepA, hstepB = (size_t)HALF * g.ldb * 2;
    const unsigned ldsw = (unsigned)wid * 1024u;
    const int aoff = lds_byte(wr * 64 + fr, fq * 8), boff = lds_byte(wc * 32 + fr, fq * 8);
#define PG8_SA(b, h) (((b) * 2 + (h)) * HTB)
#define PG8_SB(b, h) ((4 + (b) * 2 + (h)) * HTB)
#define PG8_STAGE(bufoff, gbase, voff) do { _Pragma("unroll") for (int _i = 0; _i < 2; ++_i) \
        __builtin_amdgcn_global_load_lds((const unsigned*)((const char*)(gbase) + (voff)[_i]), (LAS unsigned*)(lds + (bufoff) + ldsw + _i * 8192), 16, 0, 0); } while (0)
#define PG8_LDA(dst, b, h) do { _Pragma("unroll") for (int m = 0; m < 4; ++m) _Pragma("unroll") for (int k = 0; k < 2; ++k) dst[m][k] = *(const LAS bf16x8*)(lds + PG8_SA(b, h) + aoff + m * 2048 + k * 1024); } while (0)
#define PG8_LDB(dst, b, h) do { _Pragma("unroll") for (int n = 0; n < 2; ++n) _Pragma("unroll") for (int k = 0; k < 2; ++k) dst[n][k] = *(const LAS bf16x8*)(lds + PG8_SB(b, h) + boff + n * 2048 + k * 1024); } while (0)
#define PG8_MMA(ai, bj, At, Bt) do { __builtin_amdgcn_s_setprio(1); _Pragma("unroll") for (int m = 0; m < 4; ++m) _Pragma("unroll") for (int n = 0; n < 2; ++n) _Pragma("unroll") for (int k = 0; k < 2; ++k) \
        acc[ai][bj][m][n] = __builtin_amdgcn_mfma_f32_16x16x32_bf16(Bt[n][k], At[m][k], acc[ai][bj][m][n], 0, 0, 0); __builtin_amdgcn_s_setprio(0); } while (0)
#define PG8_WAIT_V(n) asm volatile("s_waitcnt vmcnt(" #n ")" ::: "memory")
#define PG8_WAIT_L(n) asm volatile("s_waitcnt lgkmcnt(" #n ")" ::: "memory")
#define PG8_BAR __builtin_amdgcn_s_barrier()
#define PG8_SCHED __builtin_amdgcn_sched_barrier(0)
    Unit cur, nxt; int ui = 0;
    if (!S.next(0, cur)) return;
    f32x4 acc[2][2][4][2];
#pragma unroll
    for (int a = 0; a < 2; ++a)
#pragma unroll
        for (int b = 0; b < 2; ++b)
#pragma unroll
            for (int m = 0; m < 4; ++m)
#pragma unroll
                for (int n = 0; n < 2; ++n) acc[a][b][m][n] = (f32x4){0.f, 0.f, 0.f, 0.f};
    bf16x8 At[4][2], B0[2][2], B1[2][2];
    const char* cA = cur.a; const char* cB = cur.b;
    PG8_STAGE(PG8_SB(0, 0), cB, voffB); PG8_STAGE(PG8_SB(0, 1), cB + hstepB, voffB); PG8_STAGE(PG8_SA(0, 0), cA, voffA); PG8_STAGE(PG8_SA(0, 1), cA + hstepA, voffA);
    if (wr == 1) PG8_BAR;
    PG8_WAIT_V(2); PG8_BAR;
    PG8_STAGE(PG8_SB(1, 0), cB + kstep, voffB); PG8_STAGE(PG8_SA(1, 0), cA + kstepA, voffA); PG8_STAGE(PG8_SB(1, 1), cB + hstepB + kstep, voffB);
    PG8_WAIT_V(6); PG8_BAR;
    for (;;) {
        const bool has_next = S.next(ui + 1, nxt);
        const char* nA = has_next ? nxt.a : cA; const char* nB = has_next ? nxt.b : cB;
        for (int t = 0; t < nt; t += 2) {
            const bool last = (t == nt - 2);
            const char* a1 = cA + (size_t)(t + 1) * kstepA;
            const char* a2 = last ? nA : cA + (size_t)(t + 2) * kstepA; const char* b2 = last ? nB : cB + (size_t)(t + 2) * kstep;
            const char* a3 = a2 + kstepA; const char* b3 = b2 + kstep;
            PG8_LDB(B0, 0, 0); PG8_LDB(B1, 0, 1); PG8_SCHED; PG8_LDA(At, 0, 0); PG8_STAGE(PG8_SA(1, 1), a1 + hstepA, voffA);
            PG8_WAIT_V(8); PG8_WAIT_L(0); PG8_BAR; PG8_MMA(0, 0, At, B0); PG8_MMA(0, 1, At, B1); PG8_BAR; PG8_SCHED;
            PG8_LDA(At, 0, 1); PG8_STAGE(PG8_SB(0, 0), b2, voffB); PG8_STAGE(PG8_SB(0, 1), b2 + hstepB, voffB); PG8_STAGE(PG8_SA(0, 0), a2, voffA);
            PG8_WAIT_V(8); PG8_WAIT_L(0); PG8_BAR; PG8_MMA(1, 0, At, B0); PG8_MMA(1, 1, At, B1); PG8_BAR; PG8_SCHED;
            PG8_LDB(B0, 1, 0); PG8_LDB(B1, 1, 1); PG8_SCHED; PG8_LDA(At, 1, 0); PG8_STAGE(PG8_SA(0, 1), a2 + hstepA, voffA);
            PG8_WAIT_V(8); PG8_WAIT_L(0); PG8_BAR; PG8_MMA(0, 0, At, B0); PG8_MMA(0, 1, At, B1); PG8_BAR; PG8_SCHED;
            PG8_LDA(At, 1, 1); PG8_STAGE(PG8_SB(1, 0), b3, voffB); PG8_STAGE(PG8_SB(1, 1), b3 + hstepB, voffB); PG8_STAGE(PG8_SA(1, 0), a3, voffA);
            PG8_WAIT_V(8); PG8_WAIT_L(0); PG8_BAR; PG8_MMA(1, 0, At, B0); PG8_MMA(1, 1, At, B1); PG8_BAR; PG8_SCHED;
        }
        if (wr == 0) PG8_BAR;
        { const int el = my_lane(); E(acc, cur, wr, wc, el & 15, el >> 4); }
        if (!has_next) break;
#pragma unroll
        for (int a = 0; a < 2; ++a)
#pragma unroll
            for (int b = 0; b < 2; ++b)
#pragma unroll
                for (int m = 0; m < 4; ++m)
#pragma unroll
                    for (int n = 0; n < 2; ++n) acc[a][b][m][n] = (f32x4){0.f, 0.f, 0.f, 0.f};
        cur = nxt; cA = nA; cB = nB; ++ui;
        if (wr == 1) PG8_BAR;
    }
    PG8_WAIT_V(0);
    PG8_BAR;
#undef PG8_SA
#undef PG8_SB
#undef PG8_STAGE
#undef PG8_LDA
#undef PG8_LDB
#undef PG8_MMA
#undef PG8_WAIT_V
#undef PG8_WAIT_L
#undef PG8_BAR
#undef PG8_SCHED
}
}
using pg8::Unit;

DI unsigned cvt_pk_bf16(float lo, float hi) { unsigned r; asm volatile("v_cvt_pk_bf16_f32 %0, %1, %2" : "=v"(r) : "v"(lo), "v"(hi)); return r; }
DI u32x4 pack8(const f32x4& v0, const f32x4& v1) { u32x4 w; w.x = cvt_pk_bf16(v0[0], v0[1]); w.y = cvt_pk_bf16(v0[2], v0[3]); w.z = cvt_pk_bf16(v1[0], v1[1]); w.w = cvt_pk_bf16(v1[2], v1[3]); return w; }

struct SchedP1 {
    const char* A; const char* B; int G, c;
    DI bool next(int i, Unit& u) const {
        constexpr int nM = 128, nN = 26, nwg = nM * nN, NXCD = 8, WGM = 8;
        const long L = (long)i * G + c; if (L >= nwg) return false;
        int wgid = (int)L; { const int q = nwg / NXCD, r = nwg % NXCD, xcd = wgid % NXCD, off = wgid / NXCD; wgid = (xcd < r ? xcd * (q + 1) : r * (q + 1) + (xcd - r) * q) + off; }
        const int nig = WGM * nN, gid = wgid / nig, fm = gid * WGM, gsz = (nM - fm) < WGM ? (nM - fm) : WGM;
        u.pm = fm + ((wgid % nig) % gsz); u.pn = (wgid % nig) / gsz; u.aux = 0; u.pad = 0;
        u.a = A + (size_t)u.pm * 256 * 1024 * 2; u.b = B + (size_t)u.pn * 256 * 1024 * 2; return true;
    }
};
struct SchedP3a {
    const char* ys; const char* wbr; int G, c;
    DI bool next(int i, Unit& u) const {
        const int tile = (i >> 2) * G + c; if (tile >= 512) return false;
        const int br = i & 3; u.pm = tile >> 2; u.pn = tile & 3; u.aux = br; u.pad = 0;
        u.a = ys + ((size_t)u.pm * 256 * 1024 + br * 256) * 2; u.b = wbr + ((size_t)br * 1024 * 256 + (size_t)u.pn * 256 * 256) * 2; return true;
    }
};
struct SchedP3b {
    const char* A; const char* B; int G, c;
    DI bool next(int i, Unit& u) const {
        const int L = i * G + c; if (L >= 512) return false;
        u.pm = L >> 2; u.pn = L & 3; u.aux = 0; u.pad = 0;
        u.a = A + (size_t)u.pm * 256 * 1024 * 2; u.b = B + (size_t)u.pn * 256 * 1024 * 2; return true;
    }
};
struct SchedM2 {
    const char* xs; const char* wgu; const LAS int* offt; int G, c;
    DI bool next(int i, Unit& u) const {
        const int NT = __builtin_amdgcn_readfirstlane(offt[32]) >> 8; const int L = i * G + c; if (L >= NT * 2) return false;
        const int rt = L >> 1, pn = L & 1; const int e = __builtin_amdgcn_readfirstlane(offt[40 + rt]);
        u.pm = rt; u.pn = pn; u.aux = e; u.pad = 0;
        u.a = xs + (size_t)rt * 256 * 1024 * 2; u.b = wgu + ((size_t)e * 512 + pn * 256) * 1024 * 2; return true;
    }
};
struct SchedM3 {
    const char* hmid; const char* wd; const LAS int* offt; int G, c;
    DI bool next(int i, Unit& u) const {
        const int NT = __builtin_amdgcn_readfirstlane(offt[32]) >> 8; const int L = i * G + c; if (L >= NT * 4) return false;
        const int rt = L >> 2, pn = L & 3; const int e = __builtin_amdgcn_readfirstlane(offt[40 + rt]);
        u.pm = rt; u.pn = pn; u.aux = e; u.pad = 0;
        u.a = hmid + (size_t)rt * 256 * 256 * 2; u.b = wd + ((size_t)e * 1024 + pn * 256) * 256 * 2; return true;
    }
};

struct EpiP1 {
    bf16* proj; bf16* gates; const float* bgate;
    DI void operator()(const f32x4 (&acc)[2][2][4][2], const Unit& u, int wr, int wc, int fr, int fq) const {
        const int row0 = u.pm * 256 + wr * 64 + fr; const int colt = u.pn * 256 + wc * 32 + 8 * fq;
        if (u.pn < 10) {
#pragma unroll
            for (int ai = 0; ai < 2; ++ai)
#pragma unroll
                for (int m = 0; m < 4; ++m) { bf16* rowp = proj + (size_t)(row0 + ai * 128 + m * 16) * PLD + colt;
#pragma unroll
                    for (int bj = 0; bj < 2; ++bj) *(u32x4*)(rowp + bj * 128) = pack8(acc[ai][bj][m][0], acc[ai][bj][m][1]); }
        } else {
            const int gcol = colt - 2560;
            f32x4 bv[2][2];
#pragma unroll
            for (int bj = 0; bj < 2; ++bj)
#pragma unroll
                for (int n = 0; n < 2; ++n) bv[bj][n] = *(const f32x4*)(bgate + gcol + bj * 128 + 4 * n);
#pragma unroll
            for (int ai = 0; ai < 2; ++ai)
#pragma unroll
                for (int m = 0; m < 4; ++m) { bf16* rowp = gates + (size_t)(row0 + ai * 128 + m * 16) * GLD + gcol;
#pragma unroll
                    for (int bj = 0; bj < 2; ++bj) { f32x4 v0 = acc[ai][bj][m][0] + bv[bj][0], v1 = acc[ai][bj][m][1] + bv[bj][1];
#pragma unroll
                        for (int e = 0; e < 4; ++e) { v0[e] = sigmoidf_(v0[e]); v1[e] = sigmoidf_(v1[e]); }
                        *(u32x4*)(rowp + bj * 128) = pack8(v0, v1); }
                    __builtin_amdgcn_sched_barrier(0); }
        }
    }
};
struct EpiP3a {
    bf16* merged; const bf16* gates;
    DI void operator()(const f32x4 (&acc)[2][2][4][2], const Unit& u, int wr, int wc, int fr, int fq) const {
        const int row0 = u.pm * 256 + wr * 64 + fr; const int colt = u.pn * 256 + wc * 32 + 8 * fq; const int br = u.aux;
#pragma unroll
        for (int ai = 0; ai < 2; ++ai)
#pragma unroll
            for (int m = 0; m < 4; ++m) { const size_t row = (size_t)(row0 + ai * 128 + m * 16);
#pragma unroll
                for (int bj = 0; bj < 2; ++bj) {
                    const u32x4 gw = *(const u32x4*)(gates + row * GLD + br * 1024 + colt + bj * 128);
                    bf16* mp = merged + row * 1024 + colt + bj * 128;
                    f32x4 v0 = acc[ai][bj][m][0], v1 = acc[ai][bj][m][1];
                    v0[0] *= lo_bf(gw.x); v0[1] *= hi_bf(gw.x); v0[2] *= lo_bf(gw.y); v0[3] *= hi_bf(gw.y);
                    v1[0] *= lo_bf(gw.z); v1[1] *= hi_bf(gw.z); v1[2] *= lo_bf(gw.w); v1[3] *= hi_bf(gw.w);
                    if (br != 0) { const u32x4 mw = *(const u32x4*)mp;
                        v0[0] += lo_bf(mw.x); v0[1] += hi_bf(mw.x); v0[2] += lo_bf(mw.y); v0[3] += hi_bf(mw.y);
                        v1[0] += lo_bf(mw.z); v1[1] += hi_bf(mw.z); v1[2] += lo_bf(mw.w); v1[3] += hi_bf(mw.w); }
                    *(u32x4*)mp = pack8(v0, v1); }
                __builtin_amdgcn_sched_barrier(0); }
    }
};
struct EpiP3b {
    const float* xin; float* out;
    DI void operator()(const f32x4 (&acc)[2][2][4][2], const Unit& u, int wr, int wc, int fr, int fq) const {
        const int row0 = u.pm * 256 + wr * 64 + fr; const int colt = u.pn * 256 + wc * 32 + 8 * fq;
#pragma unroll
        for (int ai = 0; ai < 2; ++ai)
#pragma unroll
            for (int m = 0; m < 4; ++m) { const size_t off = (size_t)(row0 + ai * 128 + m * 16) * 1024 + colt;
#pragma unroll
                for (int bj = 0; bj < 2; ++bj)
#pragma unroll
                    for (int n = 0; n < 2; ++n) { const f32x4 xv = *(const f32x4*)(xin + off + bj * 128 + 4 * n); *(f32x4*)(out + off + bj * 128 + 4 * n) = xv + acc[ai][bj][m][n]; }
                __builtin_amdgcn_sched_barrier(0); }
    }
};
struct EpiM2 {
    bf16* hmid;
    DI void operator()(const f32x4 (&acc)[2][2][4][2], const Unit& u, int wr, int wc, int fr, int fq) const {
        const int row0 = u.pm * 256 + wr * 64 + fr; const int col = u.pn * 128 + wc * 32 + 8 * fq;
#pragma unroll
        for (int ai = 0; ai < 2; ++ai)
#pragma unroll
            for (int m = 0; m < 4; ++m) { f32x4 h0, h1;
#pragma unroll
                for (int e = 0; e < 4; ++e) { const float g0 = acc[ai][0][m][0][e], g1 = acc[ai][0][m][1][e];
                    h0[e] = g0 * sigmoidf_(g0) * acc[ai][1][m][0][e]; h1[e] = g1 * sigmoidf_(g1) * acc[ai][1][m][1][e]; }
                *(u32x4*)(hmid + (size_t)(row0 + ai * 128 + m * 16) * 256 + col) = pack8(h0, h1); }
    }
};
struct EpiM3 {
    bf16* eo; const int* rowtok; const float* roww;
    DI void operator()(const f32x4 (&acc)[2][2][4][2], const Unit& u, int wr, int wc, int fr, int fq) const {
        const int row0 = u.pm * 256 + wr * 64 + fr; const int colt = u.pn * 256 + wc * 32 + 8 * fq;
#pragma unroll
        for (int ai = 0; ai < 2; ++ai)
#pragma unroll
            for (int m = 0; m < 4; ++m) { const int row = row0 + ai * 128 + m * 16; const int tk = rowtok[row];
                if (tk >= 0) { const float w = roww[row]; bf16* op = eo + (size_t)tk * 1024 + colt;
#pragma unroll
                    for (int bj = 0; bj < 2; ++bj) *(u32x4*)(op + bj * 128) = pack8(acc[ai][bj][m][0] * w, acc[ai][bj][m][1] * w); }
                __builtin_amdgcn_sched_barrier(0); }
    }
};

struct Args { const float* in[36]; float* out; unsigned char* ws; int ph_lo, ph_hi; };
struct InTab { unsigned base;
    DI const float* operator[](int i) const { unsigned long long v; const unsigned addr = base + (unsigned)i * 8u;
        asm volatile("ds_read_b64 %0, %1\n\ts_waitcnt lgkmcnt(0)" : "=v"(v) : "v"(addr) : "memory");
        const unsigned lo = __builtin_amdgcn_readfirstlane((unsigned)v), hi = __builtin_amdgcn_readfirstlane((unsigned)(v >> 32));
        return (const float*)(((unsigned long long)hi << 32) | lo); } };
struct KA { InTab in; float* out; unsigned char* ws; };

DI void transpose_item(const float* W, int ldw, int nvalid, bf16* WT, int ldt, int k0, int n0, int dst_row0, LAS float* scr, int lane) {
    const bool nok = (n0 + (lane & 31)) < nvalid;
#pragma unroll 8
    for (int i = 0; i < 32; ++i) { const int kk = 2 * i + (lane >> 5); scr[kk * 33 + (lane & 31)] = nok ? W[(size_t)(k0 + kk) * ldw + n0 + (lane & 31)] : 0.f; }
    LDS_WAIT(); asm volatile("" ::: "memory");
    const int c = lane & 7;
#pragma unroll
    for (int j = 0; j < 4; ++j) { const int n = (lane >> 3) + 8 * j; const LAS float* s = scr + (8 * c) * 33 + n;
        u32x4 o; o.x = pk2(s[0 * 33], s[1 * 33]); o.y = pk2(s[2 * 33], s[3 * 33]); o.z = pk2(s[4 * 33], s[5 * 33]); o.w = pk2(s[6 * 33], s[7 * 33]);
        if (n0 + n < nvalid) *(u32x4*)(WT + (size_t)(dst_row0 + n) * ldt + k0 + 8 * c) = o; }
    LDS_WAIT(); asm volatile("" ::: "memory");
}
DI void phase0_weights(const KA& a, int l, LAS unsigned char* lds, int gw, int NGW, int wave, int lane) {
    LAS float* scr = (LAS float*)(lds + wave * 16384);
    const float* w_in = a.in[4] + (size_t)l * 1024 * NIN;
    const float* w_gate = a.in[24] + (size_t)l * 4 * 1024 * 1024;
    const float* w_br = a.in[26] + (size_t)l * 4 * 256 * 1024;
    const float* w_out = a.in[27] + (size_t)l * 1024 * 1024;
    bf16* Wt_in = (bf16*)(a.ws + WS_WIN); bf16* Wt_br = (bf16*)(a.ws + WS_WBR); bf16* Wt_out = (bf16*)(a.ws + WS_WOUT);
    constexpr int I_IN = 16 * 77, I_G = 4 * 16 * 32, I_B = 4 * 4 * 32, I_O = 16 * 32, NIT = I_IN + I_G + I_B + I_O;
    for (int it = gw; it < NIT; it += NGW) {
        int r = it;
        if (r < I_IN) { const int kb = r / 77, nb = r % 77; transpose_item(w_in, NIN, NIN, Wt_in, 1024, kb * 64, nb * 32, nb * 32, scr, lane); continue; } r -= I_IN;
        if (r < I_G) { const int br = r / 512, q = r % 512, kb = q / 32, nb = q % 32; transpose_item(w_gate + (size_t)br * 1024 * 1024, 1024, 1024, Wt_in, 1024, kb * 64, nb * 32, 2560 + br * 1024 + nb * 32, scr, lane); continue; } r -= I_G;
        if (r < I_B) { const int br = r / 128, q = r % 128, kb = q / 32, nb = q % 32; transpose_item(w_br + (size_t)br * 256 * 1024, 1024, 1024, Wt_br + (size_t)br * 1024 * 256, 256, kb * 64, nb * 32, nb * 32, scr, lane); continue; } r -= I_B;
        { const int kb = r / 32, nb = r % 32; transpose_item(w_out, 1024, 1024, Wt_out, 1024, kb * 64, nb * 32, nb * 32, scr, lane); }
    }
}

DI void router_weights(const KA& a, int l, int gw, int NGW, int lane) {
    bf16* Wr = (bf16*)(a.ws + WS_WR);
    const float* wg = a.in[29] + (size_t)l * 1024 * 4; const float* we = a.in[31] + (size_t)l * 1024 * 32;
    for (int n = gw; n < 36; n += NGW) {
        for (int i = 0; i < 16; ++i) { const int k = lane + 64 * i; const float w = (n < 4) ? wg[k * 4 + n] : we[k * 32 + (n - 4)];
            const unsigned hi = f2bf(w); const float hf = __builtin_bit_cast(float, hi << 16); const unsigned lo = f2bf(w - hf);
            Wr[(size_t)n * 2048 + k] = (bf16)hi; Wr[(size_t)n * 2048 + 1024 + k] = (bf16)hi; Wr[(size_t)(64 + n) * 2048 + k] = (bf16)lo; Wr[(size_t)(64 + n) * 2048 + 1024 + k] = 0; }
    }
}

DI void cmp_weights(const KA& a, int l, LAS unsigned char* lds, int gw, int NGW, int wave, int lane) {
    LAS float* scr = (LAS float*)(lds + wave * 16384);
    bf16* Wc = (bf16*)(a.ws + WS_WCMP); float* pt = (float*)(a.ws + WS_CMPAB + 2 * MiB);
    for (int it = gw; it < 2 * 32 * 2 + 2; it += NGW) {
        if (it < 128) { const int kv = it >> 6, q = it & 63, kb = q >> 1, nb = q & 1; const float* w1 = a.in[kv ? 22 : 19] + (size_t)l * 2048 * 64;
            bf16* dst = Wc + (size_t)kv * 256 * 1024 - (kb >= 16 ? 1024 : 0);
            transpose_item(w1, 64, 64, dst, 1024, kb * 64, nb * 32, (kb >= 16 ? 64 : 0) + nb * 32, scr, lane);
        } else { const int kv = it - 128; const float* w1 = a.in[kv ? 22 : 19] + (size_t)l * 2048 * 64; const float* pos = a.in[kv ? 21 : 18] + (size_t)l * 2048;
            float acc = 0.f;
            for (int k = 0; k < 2048; ++k) acc += pos[k] * w1[(size_t)k * 64 + lane];
            pt[kv * 64 + lane] = acc; }
    }
}

DI void lru_weights(const KA& a, int l, int gw, int NGW, int lane) {
    bf16* W = (bf16*)(a.ws + WS_LRUW); const float* wa = a.in[7] + (size_t)l * 4 * 4096; const float* wx = a.in[9] + (size_t)l * 4 * 4096;
    (void)NGW; { const int idx = gw * 64 + lane; if (idx < 32768) { const int i = idx & 63, j = (idx >> 6) & 63, mat = (idx >> 12) & 1, hbk = idx >> 13;
        W[idx] = (bf16)f2bf((mat ? wx : wa)[(size_t)hbk * 4096 + i * 64 + j]); } }
}
DI void phase0_rows(const KA& a, int l, int mode, int gw, int NGW, int lane) {
    const GAS float* xin = (const GAS float*)((l == 0) ? a.in[0] : a.out);
    const GAS bf16* eo = (const GAS bf16*)(a.ws + WS_PROJ);
    GAS bf16* hb = (GAS bf16*)(a.ws + WS_HB); GAS float* outp = (GAS float*)a.out;
    const GAS float* g = (const GAS float*)(mode ? a.in[2] : (a.in[3] + (size_t)l * 1024));
    f32x4 gv[4];
#pragma unroll
    for (int j = 0; j < 4; ++j) gv[j] = *(const GAS f32x4*)(g + 4 * (lane + 64 * j));
    for (int m0 = gw * 4; m0 < T; m0 += NGW * 4) {
        f32x4 v[4][4]; float ss[4];
#pragma unroll
        for (int rr = 0; rr < 4; ++rr)
#pragma unroll
            for (int j = 0; j < 4; ++j) v[rr][j] = *(const GAS f32x4*)(xin + (size_t)(m0 + rr) * 1024 + 4 * (lane + 64 * j));
        if (l > 0) {
#pragma unroll
            for (int rr = 0; rr < 4; ++rr)
#pragma unroll
                for (int j = 0; j < 4; ++j) {
                    const u32x2 e0 = *(const GAS u32x2*)(eo + (size_t)(2 * (m0 + rr)) * 1024 + 4 * (lane + 64 * j));
                    const u32x2 e1 = *(const GAS u32x2*)(eo + (size_t)(2 * (m0 + rr) + 1) * 1024 + 4 * (lane + 64 * j));
                    v[rr][j][0] += lo_bf(e0.x) + lo_bf(e1.x); v[rr][j][1] += hi_bf(e0.x) + hi_bf(e1.x); v[rr][j][2] += lo_bf(e0.y) + lo_bf(e1.y); v[rr][j][3] += hi_bf(e0.y) + hi_bf(e1.y); } }
#pragma unroll
        for (int rr = 0; rr < 4; ++rr) { float t = 0.f;
#pragma unroll
            for (int j = 0; j < 4; ++j) t += (v[rr][j][0] * v[rr][j][0] + v[rr][j][1] * v[rr][j][1]) + (v[rr][j][2] * v[rr][j][2] + v[rr][j][3] * v[rr][j][3]);
            ss[rr] = t; }
#pragma unroll
        for (int rr = 0; rr < 4; ++rr) ss[rr] = wave_sum(ss[rr]);
#pragma unroll
        for (int rr = 0; rr < 4; ++rr) { const float r = 1.f / sqrtf(ss[rr] * (1.f / 1024.f) + 1e-6f); const size_t m = (size_t)(m0 + rr);
#pragma unroll
            for (int j = 0; j < 4; ++j) { const f32x4 y = v[rr][j] * r * gv[j];
                if (mode) *(GAS f32x4*)(outp + m * 1024 + 4 * (lane + 64 * j)) = y;
                else { if (l > 0) *(GAS f32x4*)(outp + m * 1024 + 4 * (lane + 64 * j)) = v[rr][j];
                       u32x2 w; w.x = pk2(y[0], y[1]); w.y = pk2(y[2], y[3]); *(GAS u32x2*)(hb + m * 1024 + 4 * (lane + 64 * j)) = w; } } }
    }
}

DI int crow(int i, int hh) { return (i & 3) + 8 * (i >> 2) + 4 * hh; }
DI unsigned cvtpk(float lo, float hi) { f32x2 v = {lo, hi}; bf16x2_t b = __builtin_convertvector(v, bf16x2_t); return __builtin_bit_cast(unsigned, b); }
template <int CTRL, int RMASK> DI float dppf(float oldv, float v) { return __builtin_bit_cast(float, __builtin_amdgcn_update_dpp(__builtin_bit_cast(int, oldv), __builtin_bit_cast(int, v), CTRL, RMASK, 0xf, false)); }
template <int CTRL, int RMASK> DI void scan_step(float& a, float& b) {
    const float ap = dppf<CTRL, RMASK>(1.f, a), bp = dppf<CTRL, RMASK>(0.f, b); b = a * bp + b; a = a * ap; }
DI void lru_unit(const KA& a, int l, const GAS bf16* proj, GAS bf16* ys, GAS float* sums, LAS unsigned char* lds, int task, int lane_in, int wave_in, bool final) {
    int lane = lane_in, wave = wave_in; asm volatile("" : "+v"(lane), "+s"(wave));
    const int chunk = task & 31, hbk = (task >> 5) & 3, b = task >> 7;
    const int ts = chunk * 256 + wave * 32; const size_t rowb = (size_t)b * SEQ;
    LAS unsigned char* wl = lds + wave * 16384;
    LAS float* ex = (LAS float*)(lds + LRUEX_OFF); LAS float* cst = (LAS float*)(lds + LRUCST_OFF); LAS float* car = (LAS float*)(lds + LRUCAR_OFF) + wave * 64;
    {
        const int c = hbk * 64 + lane;
        const GAS float* cw = (const GAS float*)(a.in[5] + (size_t)l * 4 * 256);
        const float cw0 = cw[c], cw1 = cw[256 + c], cw2 = cw[512 + c], cw3 = cw[768 + c]; const float cb = a.in[6][l * 256 + c];
        if (wave == 0) { cst[lane] = a.in[8][l * 256 + c]; cst[64 + lane] = a.in[10][l * 256 + c]; cst[128 + lane] = -8.f * softplusf_(-a.in[11][l * 256 + c]); }
        const GAS bf16* xp = proj + (rowb + ts) * PLD + C_AX + c;
        float x3 = (ts >= 3) ? bf2f(*(xp - 3 * PLD)) : 0.f, x2 = (ts >= 2) ? bf2f(*(xp - 2 * PLD)) : 0.f, x1 = (ts >= 1) ? bf2f(*(xp - PLD)) : 0.f;
#pragma unroll 8
        for (int n = 0; n < 32; ++n) { const float x0 = bf2f(xp[(size_t)n * PLD]); const float xc = cb + cw0 * x3 + cw1 * x2 + cw2 * x1 + cw3 * x0;
            *(LAS bf16*)(wl + n * 144 + lane * 2) = (bf16)f2bf(xc); *(LAS float*)(wl + 4608 + n * 272 + lane * 4) = xc; x3 = x2; x2 = x1; x1 = x0; }
    }
    const int n = lane & 31, hh = lane >> 5;
    f32x16 D[4];
    {
        const GAS bf16* wt = (const GAS bf16*)(a.ws + WS_LRUW) + (size_t)hbk * 8192;
        bf16x8 bfr[4];
        LDS_WAIT();
#pragma unroll
        for (int s4 = 0; s4 < 4; ++s4) bfr[s4] = *(const LAS bf16x8*)(wl + n * 144 + hh * 16 + s4 * 32);
#pragma unroll
        for (int m = 0; m < 4; ++m) {
#pragma unroll
            for (int s4 = 0; s4 < 4; ++s4) { const bf16x8 af = *(const GAS bf16x8*)(wt + (size_t)(m >> 1) * 4096 + (32 * (m & 1) + n) * 64 + 8 * hh + 16 * s4);
                if (s4 == 0) { f32x16 z;
#pragma unroll
                    for (int i = 0; i < 16; ++i) z[i] = 0.f;
                    D[m] = MFMA32(af, bfr[s4], z); } else D[m] = MFMA32(af, bfr[s4], D[m]); } }
    }
    __syncthreads();
    const bool t0 = (ts + n) == 0;
#pragma unroll
    for (int mm = 0; mm < 2; ++mm)
#pragma unroll
        for (int g4 = 0; g4 < 4; ++g4) { const int c0 = 32 * mm + 8 * g4 + 4 * hh;
            const f32x4 vba = *(const LAS f32x4*)(cst + c0), vbx = *(const LAS f32x4*)(cst + 64 + c0), vc8 = *(const LAS f32x4*)(cst + 128 + c0);
            const f32x4 vxc = *(const LAS f32x4*)(wl + 4608 + n * 272 + c0 * 4);
#pragma unroll
            for (int e = 0; e < 4; ++e) { const int i = 4 * g4 + e;
                const float r = sigmoidf_(D[mm][i] + vba[e]), ig = sigmoidf_(D[2 + mm][i] + vbx[e]);
                const float la = vc8[e] * r; const float av = __expf(la);
                const float mult = t0 ? 1.f : sqrtf(fmaxf(1.f - __expf(2.f * la), 0.f));
                float aa = av, bb = mult * ig * vxc[e];
                scan_step<0x111, 0xf>(aa, bb); scan_step<0x112, 0xf>(aa, bb); scan_step<0x114, 0xf>(aa, bb); scan_step<0x118, 0xf>(aa, bb); scan_step<0x142, 0xa>(aa, bb);
                D[mm][i] = aa; D[2 + mm][i] = bb; } }
    if (n == 31) {
#pragma unroll
        for (int mm = 0; mm < 2; ++mm)
#pragma unroll
            for (int i = 0; i < 16; ++i) { const int c = 32 * mm + crow(i, hh); ex[(wave * 64 + c) * 2] = D[mm][i]; ex[(wave * 64 + c) * 2 + 1] = D[2 + mm][i]; } }
    __syncthreads();
    if (!final) {
        if (wave == 0) { float hv = 0.f, av = 1.f;
#pragma unroll
            for (int w = 0; w < 8; ++w) { const float A_ = ex[(w * 64 + lane) * 2], H_ = ex[(w * 64 + lane) * 2 + 1]; hv = A_ * hv + H_; av *= A_; }
            GAS float* sp = sums + ((size_t)((b * 4 + hbk) * 32 + chunk) * 64 + lane) * 2; sp[0] = av; sp[1] = hv; }
    } else {
        {   float hv = 0.f;
            for (int cc = 0; cc < chunk; ++cc) { const GAS float* sp = sums + ((size_t)((b * 4 + hbk) * 32 + cc) * 64 + lane) * 2; hv = sp[0] * hv + sp[1]; }
            for (int w = 0; w < wave; ++w) { const float A_ = ex[(w * 64 + lane) * 2], H_ = ex[(w * 64 + lane) * 2 + 1]; hv = A_ * hv + H_; }
            car[lane] = hv; }
        LDS_WAIT(); asm volatile("" ::: "memory");
        const GAS bf16* gp = proj + (rowb + ts + n) * PLD + C_AG + hbk * 64; GAS bf16* yp = ys + (rowb + ts + n) * 1024 + hbk * 64;
#pragma unroll
        for (int mm = 0; mm < 2; ++mm)
#pragma unroll
            for (int g4 = 0; g4 < 4; ++g4) { const int c0 = 32 * mm + 8 * g4 + 4 * hh; const f32x4 cv = *(const LAS f32x4*)(car + c0);
                float y[4];
#pragma unroll
                for (int e = 0; e < 4; ++e) { const int i = 4 * g4 + e; const float hv = D[2 + mm][i] + D[mm][i] * cv[e];
                    const float gt = bf2f(gp[c0 + e]); y[e] = hv * gelu_tanh(gt); }
#pragma unroll
                for (int e = 0; e < 4; ++e) yp[c0 + e] = (bf16)f2bf(y[e]); }
    }
    __syncthreads();
}

constexpr int DK_STR = 144, DV_STR = 192, DBUF_BYTES = 64 * DK_STR + 64 * DV_STR;
DI bf16x8 pack_half(const f32x16& x, int s2) { u32x4 p;
    if (s2 == 0) { p.x = cvtpk(x[0], x[1]); p.y = cvtpk(x[2], x[3]); p.z = cvtpk(x[4], x[5]); p.w = cvtpk(x[6], x[7]); }
    else { p.x = cvtpk(x[8], x[9]); p.y = cvtpk(x[10], x[11]); p.z = cvtpk(x[12], x[13]); p.w = cvtpk(x[14], x[15]); }
    return __builtin_bit_cast(bf16x8, p); }
DI s16x4 vtr(const LAS unsigned char* p) { return __builtin_bit_cast(s16x4, __builtin_amdgcn_ds_read_tr16_b64_v4i16((LAS v4i16_t*)p)); }
DI float max16(const f32x16& x) { float a = fmaxf(fmaxf(x[0], x[1]), fmaxf(x[2], x[3])), b = fmaxf(fmaxf(x[4], x[5]), fmaxf(x[6], x[7])), c = fmaxf(fmaxf(x[8], x[9]), fmaxf(x[10], x[11])), d = fmaxf(fmaxf(x[12], x[13]), fmaxf(x[14], x[15])); return fmaxf(fmaxf(a, b), fmaxf(c, d)); }
DI void diff_unit(const GAS bf16* proj, GAS bf16* ys, LAS unsigned char* lds, const LAS float* bias2, const GAS float* subg, float lam, float lam_init, int b, int h, int qb, int tid_in, int lane_in, int wave_in) {
    int tid = tid_in, lane = lane_in, wave = wave_in; asm volatile("" : "+v"(tid), "+v"(lane), "+s"(wave));
    const int q0 = qb * 256 + wave * 32; const int ql = lane & 31, hh = lane >> 5; const int q = q0 + ql;
    const size_t rowb = (size_t)b * SEQ;
    const float SC = 0.17677669529663687f * 1.4426950408889634f;
    bf16x8 qf[2][2];
    { const GAS bf16* qp = proj + (rowb + q) * PLD + C_CQ + h * 64 + hh * 8;
#pragma unroll
      for (int m = 0; m < 2; ++m)
#pragma unroll
        for (int s = 0; s < 2; ++s) { const u32x4 w = *(const GAS u32x4*)(qp + m * 32 + s * 16); u32x4 o;
            o.x = cvtpk(lo_bf(w.x) * SC, hi_bf(w.x) * SC); o.y = cvtpk(lo_bf(w.y) * SC, hi_bf(w.y) * SC); o.z = cvtpk(lo_bf(w.z) * SC, hi_bf(w.z) * SC); o.w = cvtpk(lo_bf(w.w) * SC, hi_bf(w.w) * SC);
            qf[m][s] = __builtin_bit_cast(bf16x8, o); } }
    f32x16 O[2][2], negm[2];
#pragma unroll
    for (int i = 0; i < 16; ++i) { O[0][0][i] = 0.f; O[0][1][i] = 0.f; O[1][0][i] = 0.f; O[1][1][i] = 0.f; negm[0][i] = 0.f; negm[1][i] = 0.f; }
    float lsum[2] = {0.f, 0.f};
    const int nsteps = 4 * qb + 4, mysteps = 4 * qb + (wave >> 1) + 1;
    const int skey = tid >> 3, sch = tid & 7;
    const GAS unsigned char* kgb = (const GAS unsigned char*)(proj + rowb * PLD + C_CK + h * 64);
    const GAS unsigned char* vgb = (const GAS unsigned char*)(proj + rowb * PLD + C_CV + h * 64);
    const unsigned soff = (unsigned)(skey * PLD + sch * 8) * 2u;
    u32x4 kr = *(const GAS u32x4*)(kgb + soff), vr = *(const GAS u32x4*)(vgb + soff);
    *(LAS u32x4*)(lds + skey * DK_STR + sch * 16) = kr; *(LAS u32x4*)(lds + 64 * DK_STR + skey * DV_STR + sch * 16) = vr;
    __syncthreads();
    const int i16 = lane & 15, blk = (lane >> 4) & 1;
    const int kboff = ql * DK_STR + hh * 16;
    const int vboff = 64 * DK_STR + (4 * hh + (i16 >> 2)) * DV_STR + (16 * blk + 4 * (i16 & 3)) * 2;
#pragma unroll 1
    for (int kt = 0; kt < nsteps; ++kt) {
        const LAS unsigned char* cur = lds + (kt & 1) * DBUF_BYTES; LAS unsigned char* nxt = lds + ((kt + 1) & 1) * DBUF_BYTES;
        if (kt + 1 < nsteps) { const unsigned so = soff + (unsigned)(kt + 1) * (64u * PLD * 2u); kr = *(const GAS u32x4*)(kgb + so); vr = *(const GAS u32x4*)(vgb + so); }
        if (kt < mysteps) {
            const int kbase = kt * 64;
            const bool near = (q0 - (kbase + 63) < 113);
#pragma unroll
            for (int m = 0; m < 2; ++m) {
                bf16x8 pk[2][2];
                f32x16 S[2];
                {   bf16x8 kf[2][2];
#pragma unroll
                    for (int t = 0; t < 2; ++t)
#pragma unroll
                        for (int s = 0; s < 2; ++s) kf[t][s] = *(const LAS bf16x8*)(cur + kboff + t * 32 * DK_STR + m * 64 + s * 32);
#pragma unroll
                    for (int t = 0; t < 2; ++t) { S[t] = MFMA32(kf[t][0], qf[m][0], negm[m]); S[t] = MFMA32(kf[t][1], qf[m][1], S[t]); } }
                if (near) {
#pragma unroll
                    for (int t = 0; t < 2; ++t)
#pragma unroll
                        for (int i = 0; i < 16; ++i) { const int dist = q - (kbase + 32 * t + crow(i, hh)); const int di = dist < 128 ? dist : 128;
                            const float bv = dist >= 0 ? bias2[di * 12 + 4 + h] : -1e30f; S[t][i] += bv; } }
                float tm = fmaxf(max16(S[0]), max16(S[1]));
                const bool need = (tm > 8.f) || (kt == 0);
                if (__builtin_amdgcn_ballot_w64(need) != 0ull) {
                    tm = fmaxf(tm, xshfl<32>(tm));
                    const float sh = (kt == 0) ? tm : fmaxf(tm, 0.f);
                    const float al = __builtin_amdgcn_exp2f(-sh);
                    lsum[m] *= al;
#pragma unroll
                    for (int i = 0; i < 16; ++i) { O[m][0][i] *= al; O[m][1][i] *= al; negm[m][i] -= sh; S[0][i] -= sh; S[1][i] -= sh; }
                }
#pragma unroll
                for (int t = 0; t < 2; ++t) {
#pragma unroll
                    for (int i = 0; i < 16; ++i) { const float p = __builtin_amdgcn_exp2f(S[t][i]); S[t][i] = p; lsum[m] += p; }
                    pk[t][0] = pack_half(S[t], 0); pk[t][1] = pack_half(S[t], 1); }
#pragma unroll
                for (int t = 0; t < 2; ++t)
#pragma unroll
                    for (int s2 = 0; s2 < 2; ++s2)
#pragma unroll
                        for (int db = 0; db < 2; ++db) {
                            const s16x4 lo = vtr(cur + vboff + (32 * t + 16 * s2) * DV_STR + db * 64), hi = vtr(cur + vboff + (32 * t + 16 * s2 + 8) * DV_STR + db * 64);
                            const bf16x8 vf = __builtin_shufflevector(lo, hi, 0, 1, 2, 3, 4, 5, 6, 7);
                            O[m][db] = MFMA32(vf, pk[t][s2], O[m][db]); }
                ;
            }
        }
        if (kt + 1 < nsteps) { *(LAS u32x4*)(nxt + skey * DK_STR + sch * 16) = kr; *(LAS u32x4*)(nxt + 64 * DK_STR + skey * DV_STR + sch * 16) = vr; }
        __syncthreads();
    }
    const float l0 = lsum[0] + xshfl<32>(lsum[0]), l1 = lsum[1] + xshfl<32>(lsum[1]);
    const float i0 = 1.f / fmaxf(l0, 1e-30f), i1 = lam / fmaxf(l1, 1e-30f);
    float ss = 0.f;
#pragma unroll
    for (int db = 0; db < 2; ++db)
#pragma unroll
        for (int i = 0; i < 16; ++i) { const float at = O[0][db][i] * i0 - O[1][db][i] * i1; O[0][db][i] = at; ss += at * at; }
    ss += xshfl<32>(ss);
    const float r = (1.f - lam_init) / sqrtf(ss * (1.f / 64.f) + 1e-5f);
    GAS bf16* op = ys + (rowb + q) * 1024 + 512 + h * 64;
#pragma unroll
    for (int db = 0; db < 2; ++db)
#pragma unroll
        for (int gq = 0; gq < 4; ++gq) { const int d0 = 32 * db + 8 * gq + 4 * hh; const f32x4 sg = *(const GAS f32x4*)(subg + d0);
            u32x2 w; w.x = cvtpk(O[0][db][4 * gq + 0] * r * sg[0], O[0][db][4 * gq + 1] * r * sg[1]); w.y = cvtpk(O[0][db][4 * gq + 2] * r * sg[2], O[0][db][4 * gq + 3] * r * sg[3]);
            *(GAS u32x2*)(op + d0) = w; }
}

struct SchedCmp { const char* proj; const char* wc; int G, c;
    DI bool next(int i, Unit& u) const { const int L = i * G + c; if (L >= 16) return false; const int kv = L >> 3, rt = L & 7;
        u.pm = rt; u.pn = 0; u.aux = kv; u.pad = 0; u.a = proj + ((size_t)rt * 256 * 16 * PLD + (kv ? C_VC : C_KC)) * 2; u.b = wc + (size_t)kv * 256 * 1024 * 2; return true; } };
struct EpiCmp { float* ab;
    DI void operator()(const f32x4 (&acc)[2][2][4][2], const Unit& u, int wr, int wc, int fr, int fq) const {
        const int row0 = u.pm * 256 + wr * 64 + fr; const int col = wc * 32 + 8 * fq;
#pragma unroll
        for (int ai = 0; ai < 2; ++ai)
#pragma unroll
            for (int m = 0; m < 4; ++m) { float* rp = ab + ((size_t)u.aux * 2048 + row0 + ai * 128 + m * 16) * 128 + col; *(f32x4*)rp = acc[ai][0][m][0]; *(f32x4*)(rp + 4) = acc[ai][0][m][1]; }
    }
};
DI void cmp_finish(const KA& a, int l, const float* ab, bf16* kcb, int task, int lane) {
    const int kv = task / (BATCH * NCMP), r = task % (BATCH * NCMP), b = r / NCMP, c = r % NCMP;
    const float* w2 = a.in[kv ? 23 : 20] + (size_t)l * 4096; const float* pt = ab + 2 * 2048 * 128;
    const size_t g = (size_t)kv * 2048 + b * 512 + c;
    const float h1 = ab[g * 128 + lane] + ab[(g + 1) * 128 + 64 + lane] + pt[kv * 64 + lane];
    const float gl = gelu_tanh(h1); float o = 0.f;
#pragma unroll
    for (int j = 0; j < 64; ++j) o += rl(gl, j) * w2[j * 64 + lane];
    kcb[((size_t)(kv * BATCH + b) * 512 + c) * 64 + lane] = (bf16)f2bf(o);
    if (c == NCMP - 1) kcb[((size_t)(kv * BATCH + b) * 512 + NCMP) * 64 + lane] = 0;
}

DI void st_load(const GAS unsigned char* kb, const GAS unsigned char* vb, unsigned off, u32x4& kr, u32x4& vr) { kr = *(const GAS u32x4*)(kb + off); vr = *(const GAS u32x4*)(vb + off); }
DI void st_write(LAS unsigned char* buf, int skey, int sch, const u32x4& kr, const u32x4& vr) { *(LAS u32x4*)(buf + skey * DK_STR + sch * 16) = kr; *(LAS u32x4*)(buf + 64 * DK_STR + skey * DV_STR + sch * 16) = vr; }
DI void qk64(const LAS unsigned char* cur, int kboff, const bf16x8 (&qf)[4], const f32x16& cinit, f32x16 (&S)[2]) {
#pragma unroll
    for (int t = 0; t < 2; ++t) { S[t] = cinit;
#pragma unroll
        for (int s = 0; s < 4; ++s) { const bf16x8 kf = *(const LAS bf16x8*)(cur + kboff + t * 32 * DK_STR + s * 32); S[t] = MFMA32(kf, qf[s], S[t]); } }
}
DI void qk32z(const LAS unsigned char* kt32, const bf16x8 (&qf)[4], f32x16& S) {
#pragma unroll
    for (int s = 0; s < 4; ++s) { const bf16x8 kf = *(const LAS bf16x8*)(kt32 + s * 32);
        if (s == 0) { f32x16 z;
#pragma unroll
            for (int i = 0; i < 16; ++i) z[i] = 0.f;
            S = MFMA32(kf, qf[s], z); } else S = MFMA32(kf, qf[s], S); }
}
DI void pv32(const LAS unsigned char* vt32, const bf16x8 (&pk)[2], f32x16 (&O)[2]) {
#pragma unroll
    for (int s2 = 0; s2 < 2; ++s2)
#pragma unroll
        for (int db = 0; db < 2; ++db) {
            const s16x4 lo = vtr(vt32 + (16 * s2) * DV_STR + db * 64), hi = vtr(vt32 + (16 * s2 + 8) * DV_STR + db * 64);
            const bf16x8 vf = __builtin_shufflevector(lo, hi, 0, 1, 2, 3, 4, 5, 6, 7);
            O[db] = MFMA32(vf, pk[s2], O[db]); }
}
DI void mask_bias_cmp32(f32x16& S, int tcol, int cbase, int hh, const LAS float* b2h, float msub) {
#pragma unroll
    for (int i = 0; i < 16; ++i) { const int c = cbase + crow(i, hh); const int dist = tcol - 31 - 16 * c; const bool ok = dist >= 0 && c < NCMP;
        const int di = dist < 0 ? 0 : (dist < 128 ? dist : 128); S[i] = ok ? S[i] + (b2h[di * 12] - msub) : -1e30f; }
}
DI void pv64(const LAS unsigned char* cur, int vboff, const bf16x8 (&pk)[2][2], f32x16 (&O)[2]) {
#pragma unroll
    for (int t = 0; t < 2; ++t)
#pragma unroll
        for (int s2 = 0; s2 < 2; ++s2)
#pragma unroll
            for (int db = 0; db < 2; ++db) {
                const s16x4 lo = vtr(cur + vboff + (32 * t + 16 * s2) * DV_STR + db * 64), hi = vtr(cur + vboff + (32 * t + 16 * s2 + 8) * DV_STR + db * 64);
                const bf16x8 vf = __builtin_shufflevector(lo, hi, 0, 1, 2, 3, 4, 5, 6, 7);
                O[db] = MFMA32(vf, pk[t][s2], O[db]); }
}
DI void softmax_step(f32x16 (&S)[2], f32x16 (&O)[2], f32x16& negm, float& lsum, bf16x8 (&pk)[2][2]) {
    float tm = fmaxf(max16(S[0]), max16(S[1]));
    if (__builtin_amdgcn_ballot_w64(tm > 8.f) != 0ull) {
        tm = fmaxf(tm, xshfl<32>(tm)); const float sh = fmaxf(tm, 0.f); const float al = __builtin_amdgcn_exp2f(-sh);
        lsum *= al;
#pragma unroll
        for (int i = 0; i < 16; ++i) { O[0][i] *= al; O[1][i] *= al; negm[i] -= sh; S[0][i] -= sh; S[1][i] -= sh; } }
#pragma unroll
    for (int t = 0; t < 2; ++t) {
#pragma unroll
        for (int i = 0; i < 16; ++i) { const float p = __builtin_amdgcn_exp2f(S[t][i]); S[t][i] = p; lsum += p; }
        pk[t][0] = pack_half(S[t], 0); pk[t][1] = pack_half(S[t], 1); }
}
DI void mask_bias(f32x16 (&S)[2], int tcol, int kbase, int hh, int W, bool colsel, const LAS float* b2h) {
#pragma unroll
    for (int t = 0; t < 2; ++t)
#pragma unroll
        for (int i = 0; i < 16; ++i) { const int dist = tcol - (kbase + 32 * t + crow(i, hh)); const bool ok = colsel && dist >= 0 && dist < W;
            const int di = dist < 0 ? 0 : (dist < 128 ? dist : 128); S[t][i] = ok ? S[t][i] + b2h[di * 12] : -1e30f; }
}
DI void nsa_unit(const GAS bf16* proj, GAS bf16* ys, const GAS bf16* kcb, LAS unsigned char* lds, const LAS float* bias2, int b, int u, int tid_in, int lane_in, int wave_in) {
    int tid = tid_in, lane = lane_in, wave = wave_in; asm volatile("" : "+v"(tid), "+v"(lane), "+s"(wave));
    const int t0 = u * 64; const int col = lane & 31, hh = lane >> 5, tl = col >> 2, head = col & 3;
    const int t = t0 + wave * 8 + tl; const int tw0 = t0 + wave * 8;
    const size_t rowb = (size_t)b * SEQ;
    const LAS float* b2h = bias2 + 8 + head;
    bf16x8 qf[4];
    { const float SC = 0.125f * 1.4426950408889634f; const GAS bf16* qp = proj + (rowb + t) * PLD + C_DQ + head * 64 + hh * 8;
#pragma unroll
      for (int s = 0; s < 4; ++s) { const u32x4 w = *(const GAS u32x4*)(qp + s * 16); u32x4 o;
          o.x = cvtpk(lo_bf(w.x) * SC, hi_bf(w.x) * SC); o.y = cvtpk(lo_bf(w.y) * SC, hi_bf(w.y) * SC); o.z = cvtpk(lo_bf(w.z) * SC, hi_bf(w.z) * SC); o.w = cvtpk(lo_bf(w.w) * SC, hi_bf(w.w) * SC);
          qf[s] = __builtin_bit_cast(bf16x8, o); } }
    const int skey = tid >> 3, sch = tid & 7;
    const int i16 = lane & 15, blk = (lane >> 4) & 1;
    const int kboff = col * DK_STR + hh * 16;
    const int vboff = 64 * DK_STR + (4 * hh + (i16 >> 2)) * DV_STR + (16 * blk + 4 * (i16 & 3)) * 2;
    u32x4 kr, vr;
    const int ncvm = (4 * u + 3) < NCMP ? (4 * u + 3) : NCMP;
    const int nsc = (ncvm + 63) >> 6;
    const GAS unsigned char* kcp = (const GAS unsigned char*)(kcb + (size_t)(0 * BATCH + b) * 512 * 64);
    const GAS unsigned char* vcp = (const GAS unsigned char*)(kcb + (size_t)(1 * BATCH + b) * 512 * 64);
    const unsigned soffc = (unsigned)(skey * 64 + sch * 8) * 2u;
    float m1 = -120.f, l1 = 0.f;
    st_load(kcp, vcp, soffc, kr, vr); st_write(lds, skey, sch, kr, vr); __syncthreads();
#pragma unroll 1
    for (int kt = 0; kt < nsc; ++kt) {
        const LAS unsigned char* cur = lds + (kt & 1) * DBUF_BYTES; LAS unsigned char* nxt = lds + ((kt + 1) & 1) * DBUF_BYTES;
        if (kt + 1 < nsc) st_load(kcp, vcp, soffc + (unsigned)(kt + 1) * 8192u, kr, vr);
#pragma unroll
        for (int tt = 0; tt < 2; ++tt) { f32x16 S; qk32z(cur + kboff + tt * 32 * DK_STR, qf, S); mask_bias_cmp32(S, t, kt * 64 + tt * 32, hh, b2h, 0.f);
          const float tm = max16(S); const float mn = fmaxf(m1, tm); float acc = 0.f;
#pragma unroll
          for (int i = 0; i < 16; ++i) acc += __builtin_amdgcn_exp2f(S[i] - mn);
          l1 = l1 * __builtin_amdgcn_exp2f(m1 - mn) + acc; m1 = mn; }
        if (kt + 1 < nsc) st_write(nxt, skey, sch, kr, vr);
        __syncthreads();
    }
    float mf, inv;
    { const float mo = xshfl<32>(m1), lo = xshfl<32>(l1); mf = fmaxf(m1, mo); const float lf = l1 * __builtin_amdgcn_exp2f(m1 - mf) + lo * __builtin_amdgcn_exp2f(mo - mf); inv = lf > 0.f ? 1.f / lf : 0.f; }
    f32x16 Oc[2], imp[4];
#pragma unroll
    for (int i = 0; i < 16; ++i) { Oc[0][i] = 0.f; Oc[1][i] = 0.f; imp[0][i] = 0.f; imp[1][i] = 0.f; imp[2][i] = 0.f; imp[3][i] = 0.f; }
    {   st_load(kcp, vcp, soffc, kr, vr); st_write(lds, skey, sch, kr, vr); __syncthreads();
#pragma unroll 1
        for (int kt = 0; kt < nsc; ++kt) {
            const LAS unsigned char* cur = lds + (kt & 1) * DBUF_BYTES; LAS unsigned char* nxt = lds + ((kt + 1) & 1) * DBUF_BYTES;
            if (kt + 1 < nsc) st_load(kcp, vcp, soffc + (unsigned)(kt + 1) * 8192u, kr, vr);
#pragma unroll
            for (int tt = 0; tt < 2; ++tt) {
                f32x16 S; qk32z(cur + kboff + tt * 32 * DK_STR, qf, S); mask_bias_cmp32(S, t, kt * 64 + tt * 32, hh, b2h, mf);
#pragma unroll
                for (int i = 0; i < 16; ++i) S[i] = __builtin_amdgcn_exp2f(S[i]) * inv;
                bf16x8 pk[2]; pk[0] = pack_half(S, 0); pk[1] = pack_half(S, 1);
                pv32(cur + vboff + tt * 32 * DV_STR, pk, Oc);
                const int Tq = (2 * kt + tt) & 3, MB = (2 * kt + tt) >> 2;
#pragma unroll
                for (int s2 = 0; s2 < 2; ++s2) { u32x4 aw; unsigned e[8];
#pragma unroll
                    for (int jj = 0; jj < 8; ++jj) { const int kk = 16 * s2 + 8 * (jj >> 2) + 4 * hh + (jj & 3); const int delta = 32 * Tq + kk - 4 * col;
                        e[jj] = (delta == -1 || delta == 3) ? 0x3F80u : ((unsigned)delta <= 2u ? 0x4000u : 0u); }
                    aw.x = e[0] | (e[1] << 16); aw.y = e[2] | (e[3] << 16); aw.z = e[4] | (e[5] << 16); aw.w = e[6] | (e[7] << 16);
                    const bf16x8 af = __builtin_bit_cast(bf16x8, aw);
                    if (MB == 0) imp[0] = MFMA32(af, pk[s2], imp[0]); else if (MB == 1) imp[1] = MFMA32(af, pk[s2], imp[1]); else if (MB == 2) imp[2] = MFMA32(af, pk[s2], imp[2]); else imp[3] = MFMA32(af, pk[s2], imp[3]); }
                if (Tq == 3 && MB < 3) { u32x4 aw; aw.x = 0u; aw.y = 0u; aw.z = 0u; aw.w = (lane == 32) ? 0x3F800000u : 0u;
                    const bf16x8 af = __builtin_bit_cast(bf16x8, aw);
                    if (MB == 0) imp[1] = MFMA32(af, pk[1], imp[1]); else if (MB == 1) imp[2] = MFMA32(af, pk[1], imp[2]); else imp[3] = MFMA32(af, pk[1], imp[3]); }
            }
            if (kt + 1 < nsc) st_write(nxt, skey, sch, kr, vr);
            __syncthreads();
        }
    }
    unsigned ocp[2][8];
#pragma unroll
    for (int db = 0; db < 2; ++db)
#pragma unroll
        for (int i = 0; i < 8; ++i) ocp[db][i] = cvtpk(Oc[db][2 * i], Oc[db][2 * i + 1]);
    unsigned sm0 = 0u, sm1 = 0u, sm2 = 0u, sm3 = 0u;
    {   const int cur_t = t >> 6; unsigned key[16];
#pragma unroll
        for (int i = 0; i < 16; ++i) {
            float v0 = imp[0][i], v1 = imp[1][i], v2 = imp[2][i], v3 = imp[3][i];
            v0 += xshfl<1>(v0); v0 += xshfl<2>(v0); v1 += xshfl<1>(v1); v1 += xshfl<2>(v1); v2 += xshfl<1>(v2); v2 += xshfl<2>(v2); v3 += xshfl<1>(v3); v3 += xshfl<2>(v3);
            const float val = head == 0 ? v0 : (head == 1 ? v1 : (head == 2 ? v2 : v3));
            const int j = 32 * head + crow(i, hh);
            const bool forced = (j == 0) || (j == cur_t) || (j == cur_t - 1);
            unsigned fx = (unsigned)(fminf(fmaxf(val, 0.f), 31.f) * 1048576.f) + 1u;
            fx = forced ? 0x1FFFFFFu : (j <= cur_t ? fx : 0u);
            key[i] = (fx << 7) | (unsigned)(127 - j); }
#pragma unroll 1
        for (int r = 0; r < 16; ++r) {
            unsigned w = key[0];
#pragma unroll
            for (int i = 1; i < 16; ++i) w = w > key[i] ? w : key[i];
            { unsigned o = (unsigned)xshfl_i<1>((int)w); w = w > o ? w : o; o = (unsigned)xshfl_i<2>((int)w); w = w > o ? w : o; o = (unsigned)xshfl_i<32>((int)w); w = w > o ? w : o; }
            if ((w >> 7) != 0u) { const int j = 127 - (int)(w & 127u); const unsigned bit = 1u << (j & 31); const int jb = j >> 5;
                sm0 |= (jb == 0) ? bit : 0u; sm1 |= (jb == 1) ? bit : 0u; sm2 |= (jb == 2) ? bit : 0u; sm3 |= (jb == 3) ? bit : 0u; }
#pragma unroll
            for (int i = 0; i < 16; ++i) key[i] = (key[i] == w) ? 0u : key[i];
        }
    }
    f32x16 Ow[2]; float lw = 0.f;
#pragma unroll
    for (int i = 0; i < 16; ++i) { Ow[0][i] = 0.f; Ow[1][i] = 0.f; }
    {   f32x16 negm;
#pragma unroll
        for (int i = 0; i < 16; ++i) negm[i] = 120.f;
        const GAS unsigned char* kwp = (const GAS unsigned char*)(proj + rowb * PLD + C_KW); const GAS unsigned char* vwp = (const GAS unsigned char*)(proj + rowb * PLD + C_VW);
        const unsigned soffp = (unsigned)(skey * PLD + sch * 8) * 2u;
        const int s0 = (u < 8) ? 8 - u : 0;
        st_load(kwp, vwp, soffp + (unsigned)(u - 8 + s0) * (64u * PLD * 2u), kr, vr); st_write(lds, skey, sch, kr, vr); __syncthreads();
#pragma unroll 1
        for (int s = s0; s < 9; ++s) {
            const int par = (s - s0) & 1; const LAS unsigned char* cur = lds + par * DBUF_BYTES; LAS unsigned char* nxt = lds + (par ^ 1) * DBUF_BYTES;
            if (s + 1 < 9) st_load(kwp, vwp, soffp + (unsigned)(u - 8 + s + 1) * (64u * PLD * 2u), kr, vr);
            {   f32x16 S[2]; qk64(cur, kboff, qf, negm, S);
                if (s == 0 || s >= 6) mask_bias(S, t, (u - 8 + s) * 64, hh, 512, true, b2h);
                bf16x8 pk[2][2]; softmax_step(S, Ow, negm, lw, pk); pv64(cur, vboff, pk, Ow); }
            if (s + 1 < 9) st_write(nxt, skey, sch, kr, vr);
            __syncthreads();
        }
    }
    unsigned owp[2][8];
#pragma unroll
    for (int db = 0; db < 2; ++db)
#pragma unroll
        for (int i = 0; i < 8; ++i) owp[db][i] = cvtpk(Ow[db][2 * i], Ow[db][2 * i + 1]);
    f32x16 Os[2]; float lsel = 0.f;
#pragma unroll
    for (int i = 0; i < 16; ++i) { Os[0][i] = 0.f; Os[1][i] = 0.f; }
    {   f32x16 negm;
#pragma unroll
        for (int i = 0; i < 16; ++i) negm[i] = 120.f;
        const GAS unsigned char* ksp = (const GAS unsigned char*)(proj + rowb * PLD + C_KS); const GAS unsigned char* vsp = (const GAS unsigned char*)(proj + rowb * PLD + C_VS);
        const unsigned soffp = (unsigned)(skey * PLD + sch * 8) * 2u;
        u32x4 kA, vA, kB, vB;
        st_load(ksp, vsp, soffp, kr, vr); st_write(lds, skey, sch, kr, vr);
        if (u >= 1) st_load(ksp, vsp, soffp + 64u * PLD * 2u, kA, vA);
        __syncthreads();
#define SEL_STEP(J, KX, VX, KY, VY) { const int j_ = (J); \
            const LAS unsigned char* cur = lds + (j_ & 1) * DBUF_BYTES; LAS unsigned char* nxt = lds + ((j_ + 1) & 1) * DBUF_BYTES; \
            if (j_ + 2 <= u) st_load(ksp, vsp, soffp + (unsigned)(j_ + 2) * (64u * PLD * 2u), KY, VY); \
            const int jb = j_ >> 5; const unsigned smw = jb == 0 ? sm0 : (jb == 1 ? sm1 : (jb == 2 ? sm2 : sm3)); \
            const bool bit = ((smw >> (j_ & 31)) & 1u) != 0u; \
            if (__builtin_amdgcn_ballot_w64(bit) != 0ull) { \
                f32x16 S[2]; qk64(cur, kboff, qf, negm, S); \
                if (64 * j_ + 63 > tw0 - 113) mask_bias(S, t, 64 * j_, hh, 1 << 30, bit, b2h); \
                else if (!bit) { _Pragma("unroll") for (int i = 0; i < 16; ++i) { S[0][i] = -1e30f; S[1][i] = -1e30f; } } \
                bf16x8 pk[2][2]; softmax_step(S, Os, negm, lsel, pk); pv64(cur, vboff, pk, Os); } \
            if (j_ + 1 <= u) st_write(nxt, skey, sch, KX, VX); \
            __syncthreads(); }
#pragma unroll 1
        for (int j = 0; j <= u; j += 2) {
            SEL_STEP(j, kA, vA, kB, vB)
            if (j + 1 <= u) SEL_STEP(j + 1, kB, vB, kA, vA)
        }
#undef SEL_STEP
    }
    {   const float lwt = lw + xshfl<32>(lw), lst = lsel + xshfl<32>(lsel);
        const GAS bf16* gp = proj + (rowb + t) * PLD + C_DG + head * 3;
        const float g0 = sigmoidf_(bf2f(gp[0])), g1 = sigmoidf_(bf2f(gp[1])) / fmaxf(lst, 1e-30f), g2 = sigmoidf_(bf2f(gp[2])) / fmaxf(lwt, 1e-30f);
        GAS bf16* op = ys + (rowb + t) * 1024 + 768 + head * 64;
#pragma unroll
        for (int db = 0; db < 2; ++db)
#pragma unroll
            for (int gq = 0; gq < 4; ++gq) { const int d0 = 32 * db + 8 * gq + 4 * hh; float y[4];
#pragma unroll
                for (int e = 0; e < 4; ++e) { const unsigned cw = ocp[db][2 * gq + (e >> 1)], ww = owp[db][2 * gq + (e >> 1)];
                    y[e] = g0 * ((e & 1) ? hi_bf(cw) : lo_bf(cw)) + g1 * Os[db][4 * gq + e] + g2 * ((e & 1) ? hi_bf(ww) : lo_bf(ww)); }
                u32x2 w; w.x = cvtpk(y[0], y[1]); w.y = cvtpk(y[2], y[3]); *(GAS u32x2*)(op + d0) = w; }
    }
}


DI void swa_unit(const GAS bf16* proj, GAS bf16* ys, LAS unsigned char* lds, const LAS float* bias2, const LAS float* biasd, const GAS float* sinks, int b, int u, int tid_in, int lane_in, int wave_in) {
    int tid = tid_in, lane = lane_in, wave = wave_in; asm volatile("" : "+v"(tid), "+v"(lane), "+s"(wave));
    const int t0 = u * 64; const int col = lane & 31, hh = lane >> 5, tl = col >> 1, kv = wave & 1, head = 2 * kv + (col & 1);
    const int t = t0 + (wave >> 1) * 16 + tl;
    const size_t rowb = (size_t)b * SEQ;
    const LAS float* b2h = bias2 + head;
    bf16x8 qf[4];
    { const float SC = 0.125f * 1.4426950408889634f; const GAS bf16* qp = proj + (rowb + t) * PLD + C_BQ + head * 64 + hh * 8;
#pragma unroll
      for (int s = 0; s < 4; ++s) { const u32x4 w = *(const GAS u32x4*)(qp + s * 16); u32x4 o;
          o.x = cvtpk(lo_bf(w.x) * SC, hi_bf(w.x) * SC); o.y = cvtpk(lo_bf(w.y) * SC, hi_bf(w.y) * SC); o.z = cvtpk(lo_bf(w.z) * SC, hi_bf(w.z) * SC); o.w = cvtpk(lo_bf(w.w) * SC, hi_bf(w.w) * SC);
          qf[s] = __builtin_bit_cast(bf16x8, o); } }
    const int skey = tid >> 3, sch = tid & 7;
    const int i16 = lane & 15, blk = (lane >> 4) & 1;
    const int kboff = kv * DBUF_BYTES + col * DK_STR + hh * 16;
    const int vboff = kv * DBUF_BYTES + 64 * DK_STR + (4 * hh + (i16 >> 2)) * DV_STR + (16 * blk + 4 * (i16 & 3)) * 2;
    const GAS unsigned char* kp = (const GAS unsigned char*)(proj + rowb * PLD + C_BK); const GAS unsigned char* vp = (const GAS unsigned char*)(proj + rowb * PLD + C_BV);
    const unsigned soffp = (unsigned)(skey * PLD + sch * 8) * 2u;
    u32x4 k0, v0, k1, v1;
    f32x16 O[2], negm; float lsum = 0.f;
#pragma unroll
    for (int i = 0; i < 16; ++i) { O[0][i] = 0.f; O[1][i] = 0.f; negm[i] = 120.f; }
    const int s0 = (u < 2) ? 2 - u : 0;
    { const unsigned so = soffp + (unsigned)(u - 2 + s0) * (64u * PLD * 2u); st_load(kp, vp, so, k0, v0); st_load(kp + 128, vp + 128, so, k1, v1);
      st_write(lds, skey, sch, k0, v0); st_write(lds + DBUF_BYTES, skey, sch, k1, v1); }
    __syncthreads();
#pragma unroll 1
    for (int s = s0; s < 3; ++s) {
        const int par = (s - s0) & 1; const LAS unsigned char* cur = lds + par * 2 * DBUF_BYTES; LAS unsigned char* nxt = lds + (par ^ 1) * 2 * DBUF_BYTES;
        if (s + 1 < 3) { const unsigned so = soffp + (unsigned)(u - 2 + s + 1) * (64u * PLD * 2u); st_load(kp, vp, so, k0, v0); st_load(kp + 128, vp + 128, so, k1, v1); }
        {   f32x16 S[2]; qk64(cur, kboff, qf, negm, S);
            mask_bias(S, t, (u - 2 + s) * 64, hh, 128, true, b2h);
            bf16x8 pk[2][2]; softmax_step(S, O, negm, lsum, pk); pv64(cur, vboff, pk, O); }
        if (s + 1 < 3) { st_write(nxt, skey, sch, k0, v0); st_write(nxt + DBUF_BYTES, skey, sch, k1, v1); }
        __syncthreads();
    }
    {   const float sinkp = (sinks[head] - biasd[128 * 12 + head]) * 1.4426950408889634f;
        const float lt = lsum + xshfl<32>(lsum) + __builtin_amdgcn_exp2f(sinkp + negm[0]);
        const float inv = 1.f / fmaxf(lt, 1e-30f);
        GAS bf16* op = ys + (rowb + t) * 1024 + 256 + head * 64;
#pragma unroll
        for (int db = 0; db < 2; ++db)
#pragma unroll
            for (int gq = 0; gq < 4; ++gq) { const int d0 = 32 * db + 8 * gq + 4 * hh;
                u32x2 w; w.x = cvtpk(O[db][4 * gq + 0] * inv, O[db][4 * gq + 1] * inv); w.y = cvtpk(O[db][4 * gq + 2] * inv, O[db][4 * gq + 3] * inv); *(GAS u32x2*)(op + d0) = w; }
    }
}

DI void route_rows4(const KA& a, int l, bf16* xr_, int tok0, int lane_) {
    int lane = lane_; asm volatile("" : "+v"(lane));
    const GAS float* xrow = (const GAS float*)a.out + (size_t)tok0 * 1024; const GAS float* g = (const GAS float*)(a.in[28] + (size_t)l * 1024); GAS bf16* xr = (GAS bf16*)xr_;
    f32x4 v[4][4]; float ss[4];
#pragma unroll
    for (int rr = 0; rr < 4; ++rr)
#pragma unroll
        for (int j = 0; j < 4; ++j) v[rr][j] = *(const GAS f32x4*)(xrow + (size_t)rr * 1024 + 4 * (lane + 64 * j));
#pragma unroll
    for (int rr = 0; rr < 4; ++rr) { float t = 0.f;
#pragma unroll
        for (int j = 0; j < 4; ++j) t += (v[rr][j][0] * v[rr][j][0] + v[rr][j][1] * v[rr][j][1]) + (v[rr][j][2] * v[rr][j][2] + v[rr][j][3] * v[rr][j][3]);
        ss[rr] = t; }
#pragma unroll
    for (int rr = 0; rr < 4; ++rr) ss[rr] = wave_sum(ss[rr]);
#pragma unroll
    for (int j = 0; j < 4; ++j) { const int k0 = 4 * (lane + 64 * j); const f32x4 gv = *(const GAS f32x4*)(g + k0);
#pragma unroll
        for (int rr = 0; rr < 4; ++rr) { const float r = 1.f / sqrtf(ss[rr] * (1.f / 1024.f) + 1e-6f); const f32x4 xn = v[rr][j] * r * gv;
            unsigned hi[4]; float lo[4];
#pragma unroll
            for (int e = 0; e < 4; ++e) { hi[e] = f2bf(xn[e]); lo[e] = xn[e] - __builtin_bit_cast(float, hi[e] << 16); }
            u32x2 wh, wl; wh.x = hi[0] | (hi[1] << 16); wh.y = hi[2] | (hi[3] << 16); wl.x = pk2(lo[0], lo[1]); wl.y = pk2(lo[2], lo[3]);
            *(GAS u32x2*)(xr + (size_t)(tok0 + rr) * 2048 + k0) = wh; *(GAS u32x2*)(xr + (size_t)(tok0 + rr) * 2048 + 1024 + k0) = wl; } }
}
struct SchedRoute { const char* A; const char* B; int pm;
    DI bool next(int i, Unit& u) const { if (i > 0) return false; u.pm = pm; u.pn = 0; u.aux = 0; u.pad = 0; u.a = A + (size_t)pm * 128 * 2048 * 2; u.b = B; return true; } };
struct EpiRoute { float* rlog;
    DI void operator()(const f32x4 (&acc)[2][2][4][2], const Unit& u, int wr, int wc, int fr, int fq) const {
        const int row0 = u.pm * 128 + wr * 64 + fr; const int col = wc * 32 + 8 * fq;
#pragma unroll
        for (int m = 0; m < 4; ++m) { float* rp = rlog + (size_t)(row0 + m * 16) * 128 + col; *(f32x4*)rp = acc[0][0][m][0]; *(f32x4*)(rp + 4) = acc[0][0][m][1]; }
    }
};
DI void route_decide(const KA& a, int l, const float* rl_row, int* rec_e, int* rec_slot, float* rec_w, unsigned* cnt, int tok) {
    float lg[36];
    const float* bg = a.in[30] + l * 4; const float* be = a.in[32] + l * 32;
#pragma unroll
    for (int q = 0; q < 9; ++q) { const f32x4 h = *(const f32x4*)(rl_row + 4 * q), lo = *(const f32x4*)(rl_row + 64 + 4 * q);
        lg[4 * q + 0] = h[0] + lo[0]; lg[4 * q + 1] = h[1] + lo[1]; lg[4 * q + 2] = h[2] + lo[2]; lg[4 * q + 3] = h[3] + lo[3]; }
#pragma unroll
    for (int i = 0; i < 4; ++i) lg[i] += bg[i];
#pragma unroll
    for (int i = 0; i < 32; ++i) lg[4 + i] += be[i];
    int gsel = 0; float gm = lg[0];
#pragma unroll
    for (int i = 1; i < 4; ++i) if (lg[i] > gm) { gm = lg[i]; gsel = i; }
    float gs = 0.f;
#pragma unroll
    for (int i = 0; i < 4; ++i) gs += __expf(lg[i] - gm);
    const float gwt = 1.f / gs;
    float v8[8];
#pragma unroll
    for (int i = 0; i < 8; ++i) { float x = lg[4 + i];
#pragma unroll
        for (int gq = 1; gq < 4; ++gq) x = (gsel == gq) ? lg[4 + gq * 8 + i] : x;
        v8[i] = x; }
    int i0 = 0; float m0 = v8[0];
#pragma unroll
    for (int i = 1; i < 8; ++i) if (v8[i] > m0) { m0 = v8[i]; i0 = i; }
    int i1 = -1; float m1 = -3e38f;
#pragma unroll
    for (int i = 0; i < 8; ++i) if (i != i0 && v8[i] > m1) { m1 = v8[i]; i1 = i; }
    const float w0 = 1.f / (1.f + __expf(m1 - m0)); const float w1 = 1.f - w0;
    const int e0 = gsel * 8 + i0, e1 = gsel * 8 + i1;
    const unsigned s0 = __hip_atomic_fetch_add(cnt + e0, 1u, __ATOMIC_RELAXED, __HIP_MEMORY_SCOPE_AGENT);
    const unsigned s1 = __hip_atomic_fetch_add(cnt + e1, 1u, __ATOMIC_RELAXED, __HIP_MEMORY_SCOPE_AGENT);
    rec_e[tok * 2] = e0; rec_e[tok * 2 + 1] = e1; rec_slot[tok * 2] = (int)s0; rec_slot[tok * 2 + 1] = (int)s1; rec_w[tok * 2] = w0 * gwt; rec_w[tok * 2 + 1] = w1 * gwt;
}
DI void expert_weights(const KA& a, int l, LAS unsigned char* lds, int it0, int it1, int gw, int NGW, int wave, int lane) {
    LAS float* scr = (LAS float*)(lds + wave * 16384);
    const float* wgt = a.in[33] + (size_t)l * 32 * 1024 * 256; const float* wup = a.in[34] + (size_t)l * 32 * 1024 * 256; const float* wdn = a.in[35] + (size_t)l * 32 * 256 * 1024;
    bf16* Wgu = (bf16*)(a.ws + WS_WGU); bf16* Wd = (bf16*)(a.ws + WS_WD);
    constexpr int I_E = 16 * 8, I_D = 4 * 32;
    constexpr int NIT = 32 * (2 * I_E + I_D);
    (void)NIT;
    for (int it = it0 + gw; it < it1; it += NGW) {
        const int e = it / (2 * I_E + I_D); int r = it % (2 * I_E + I_D);
        if (r < 2 * I_E) { const int up = r / I_E, q = r % I_E, kb = q / 8, nb = q % 8; const int n0 = nb * 32;
            const int drow = (n0 >> 7) * 256 + up * 128 + (n0 & 127);
            transpose_item((up ? wup : wgt) + (size_t)e * 1024 * 256, 256, 256, Wgu + (size_t)e * 512 * 1024, 1024, kb * 64, n0, drow, scr, lane);
        } else { r -= 2 * I_E; const int kb = r / 32, nb = r % 32;
            transpose_item(wdn + (size_t)e * 256 * 1024, 1024, 1024, Wd + (size_t)e * 1024 * 256, 256, kb * 64, nb * 32, nb * 32, scr, lane); }
    }
}
DI void build_offsets(const unsigned* cnt, LAS int* offt, int tid) {
    if (tid == 0) { int o = 0; for (int e = 0; e < 32; ++e) { offt[e] = o; const int c = (int)__hip_atomic_load(cnt + e, __ATOMIC_RELAXED, __HIP_MEMORY_SCOPE_AGENT); o += (c + 255) & ~255; } offt[32] = o; }
    __syncthreads();
    for (int rt = tid; rt < (MOE_ROWS >> 8); rt += 512) { int e = 0; for (int j = 1; j < 32; ++j) e += (offt[j] <= rt * 256) ? 1 : 0; offt[40 + rt] = e; }
    __syncthreads();
}

template <unsigned PM>
__global__ void __launch_bounds__(512, 2) mk_fwd(Args a_) {
    extern __shared__ __attribute__((aligned(16))) unsigned char lds_raw[];
    LAS unsigned char* lds = (LAS unsigned char*)lds_raw;
    const int wave0 = __builtin_amdgcn_readfirstlane((int)threadIdx.x >> 6);
    if (threadIdx.x < 36) ((LAS unsigned long long*)(lds + PTAB_OFF))[threadIdx.x] = (unsigned long long)a_.in[threadIdx.x];
    __syncthreads();
    KA a; a.in.base = (unsigned)(size_t)(lds + PTAB_OFF); a.out = a_.out; a.ws = a_.ws;
    const int G = gridDim.x, bid = blockIdx.x, NGW = G * 8;
#define PHASE_IDS() int wave = wave0; asm volatile("" : "+s"(wave)); const int lane = my_lane(); const int tid_ = wave * 64 + lane, gw = bid * 8 + wave; (void)tid_; (void)gw; \
    KA ap = a; asm volatile("" : "+s"(ap.ws), "+s"(ap.out), "+s"(ap.in.base)); \
    bf16* hb = (bf16*)(ap.ws + WS_HB); bf16* proj = (bf16*)(ap.ws + WS_PROJ); bf16* gates = (bf16*)(ap.ws + WS_GATES); \
    bf16* ys = hb; bf16* x2b = hb; bf16* merged = proj; bf16* eo = proj; \
    bf16* kcb = (bf16*)(ap.ws + WS_KCVC); float* lrusum = (float*)(ap.ws + WS_LRUSUM); \
    int* rec_e = (int*)(ap.ws + WS_REC); int* rec_slot = rec_e + T * 2; float* rec_w = (float*)(rec_slot + T * 2); \
    int* rowtok = (int*)(ap.ws + WS_ROWTOK); float* roww = (float*)(ap.ws + WS_ROWW); \
    bf16* xs = (bf16*)(ap.ws + WS_XS); bf16* hmid = (bf16*)(ap.ws + WS_HMID); unsigned* ctl = (unsigned*)(ap.ws + WS_CTL); \
    (void)hb; (void)proj; (void)gates; (void)ys; (void)x2b; (void)merged; (void)eo; (void)kcb; (void)lrusum; (void)rec_e; (void)rec_slot; (void)rec_w; (void)rowtok; (void)roww; (void)xs; (void)hmid; (void)ctl
    volatile LAS unsigned* MISC = (volatile LAS unsigned*)(lds + MISC_OFF);
    LAS float* biasd = (LAS float*)(lds + BIAS_OFF);
    LAS int* offt = (LAS int*)(lds + OFFT_OFF);
    { PHASE_IDS();
    if (tid_ < 64) MISC[tid_] = 0u;
    for (int i = tid_; i < 129 * 12; i += 512) { const int d = i / 12, hd = i % 12; const int bk = d < 128 ? T5_BUCKET[d] : 31; const float* rb = a.in[1]; biasd[i] = rb[bk * 12 + hd]; ((LAS float*)(lds + BIAS2_OFF))[i] = (rb[bk * 12 + hd] - rb[31 * 12 + hd]) * 1.4426950408889634f; } }
    __syncthreads();
    const int lo = a_.ph_lo, hi = a_.ph_hi;
    XcdBarrier bar; bar.bar = (unsigned*)(a.ws + WS_CTL) + CW_BAR; bar.x = 0; bar.st = nullptr;
    if (hi - lo > 1) { PHASE_IDS(); bar = xcd_barrier_post(ctl + CW_BAR, MISC + 8, tid_ == 0); }
#ifndef SUB_MASK
#define SUB_MASK 0xFFu
#endif
#define SUB(k) ((SUB_MASK >> (k)) & 1u)
#define HASP(k) ((PM >> ((k) % PPL + ((k) >= 2 * PPL ? PPL : 0))) & 1u)
#define IN(k) (HASP(k) && lo <= (k) && (k) < hi)
#define SEAM(k) do { if ((k) + 1 < hi) { const int sl_ = my_lane(); int sw_ = wave0; asm volatile("" : "+s"(sw_)); xcd_barrier(bar, sw_ == 0 && sl_ == 0); } } while (0)
    for (int l = 0; l < DEPTH; ++l) {
        const int pb = l * PPL;
        if (IN(pb + 0)) { PHASE_IDS(); router_weights(ap, l, gw, NGW, lane); lru_weights(ap, l, gw, NGW, lane); cmp_weights(ap, l, lds, gw, NGW, wave, lane); phase0_weights(ap, l, lds, gw, NGW, wave, lane); phase0_rows(ap, l, 0, gw, NGW, lane); SEAM(pb + 0); }
        if (IN(pb + 1)) {
            PHASE_IDS();
            pg8::Gemm g{1024, 1024, 1024, 128, -1}; SchedP1 S{(const char*)hb, (const char*)(ap.ws + WS_WIN), G, bid};
            EpiP1 E{proj, gates, ap.in[25] + (size_t)l * 4096};
            pg8::gemm_phase<EpiP1, SchedP1>(lds, g, S, E, tid_); SEAM(pb + 1);
        }
        if (IN(pb + 2)) {
            PHASE_IDS();
            float s1 = 0.f, s2 = 0.f;
            for (int i = 0; i < 32; ++i) { s1 += ap.in[13][l * 32 + i] * ap.in[14][l * 32 + i]; s2 += ap.in[15][l * 32 + i] * ap.in[16][l * 32 + i]; }
            const float lam_init = 0.8f - 0.6f * __expf(-0.3f * (float)l); const float lam = __expf(s1) - __expf(s2) + lam_init;
            if (SUB(0)) { const LAS float* bias2 = (const LAS float*)(lds + BIAS2_OFF); const GAS float* subg = (const GAS float*)(ap.in[17] + l * 64);
                for (int pi = bid; pi < 256; pi += G) { const int bh = pi >> 4, qlo = pi & 15;
                    diff_unit((const GAS bf16*)proj, (GAS bf16*)ys, lds, bias2, subg, lam, lam_init, bh >> 2, bh & 3, 31 - qlo, tid_, lane, wave);
                    diff_unit((const GAS bf16*)proj, (GAS bf16*)ys, lds, bias2, subg, lam, lam_init, bh >> 2, bh & 3, qlo, tid_, lane, wave); } }
            if (SUB(3)) { __syncthreads(); const LAS float* bias2 = (const LAS float*)(lds + BIAS2_OFF); const GAS float* sinks = (const GAS float*)(ap.in[12] + l * 4);
                for (int pi = bid; pi < 512; pi += G) swa_unit((const GAS bf16*)proj, (GAS bf16*)ys, lds, bias2, biasd, sinks, pi >> 7, pi & 127, tid_, lane, wave); }
            if (SUB(2)) { pg8::Gemm g{1024, 16 * PLD, 1024, PLD * 2, -1}; SchedCmp S{(const char*)proj, (const char*)(ap.ws + WS_WCMP), G, bid}; EpiCmp E{(float*)(ap.ws + WS_CMPAB)};
                pg8::gemm_phase<EpiCmp, SchedCmp>(lds, g, S, E, tid_); }
            if (SUB(1)) { __syncthreads(); for (int task = bid; task < 512; task += G) lru_unit(ap, l, (const GAS bf16*)proj, (GAS bf16*)ys, (GAS float*)lrusum, lds, task, lane, wave, false); }
            SEAM(pb + 2);
        }
        if (IN(pb + 3)) {
            PHASE_IDS();
            for (int task = gw; task < 2 * BATCH * NCMP; task += NGW) cmp_finish(ap, l, (const float*)(ap.ws + WS_CMPAB), kcb, task, lane);
            __syncthreads();
            for (int task = bid; task < 512; task += G) lru_unit(ap, l, (const GAS bf16*)proj, (GAS bf16*)ys, (GAS float*)lrusum, lds, task, lane, wave, true);
            SEAM(pb + 3);
        }
        if (IN(pb + 4)) {
            PHASE_IDS();
            if (SUB(4)) { const LAS float* bias2 = (const LAS float*)(lds + BIAS2_OFF);
                for (int pi = bid; pi < 256; pi += G) { const int bb = pi >> 6, ulo = pi & 63;
                    nsa_unit((const GAS bf16*)proj, (GAS bf16*)ys, (const GAS bf16*)kcb, lds, bias2, bb, 127 - ulo, tid_, lane, wave);
                    nsa_unit((const GAS bf16*)proj, (GAS bf16*)ys, (const GAS bf16*)kcb, lds, bias2, bb, ulo, tid_, lane, wave); } }
            SEAM(pb + 4);
        }
        if (IN(pb + 5)) {
            PHASE_IDS();
            pg8::Gemm g{256, 1024, 256, 128, -1}; SchedP3a S{(const char*)ys, (const char*)(ap.ws + WS_WBR), G, bid};
            EpiP3a E{merged, gates};
            pg8::gemm_phase<EpiP3a, SchedP3a>(lds, g, S, E, tid_); SEAM(pb + 5);
        }
        if (IN(pb + 6)) {
            PHASE_IDS();
            pg8::Gemm g{1024, 1024, 1024, 128, -1}; SchedP3b S{(const char*)merged, (const char*)(ap.ws + WS_WOUT), G, bid};
            EpiP3b E{(l == 0) ? ap.in[0] : ap.out, ap.out};
            pg8::gemm_phase<EpiP3b, SchedP3b>(lds, g, S, E, tid_); SEAM(pb + 6);
        }
        if (IN(pb + 7)) {
            PHASE_IDS();
            bf16* xr = (bf16*)(ap.ws + WS_XR); float* rlog = (float*)(ap.ws + WS_RLOG);
            constexpr int NITW = 32 * (2 * 16 * 8 + 4 * 32);
            { const int pm = bid;
                for (int r = wave * 4; r < 128; r += 32) route_rows4(ap, l, xr, pm * 128 + r, lane);
                asm volatile("s_waitcnt vmcnt(0)" ::: "memory"); __syncthreads();
                { pg8::Gemm g{2048, 2048, 2048, 128, 0}; SchedRoute S{(const char*)xr, (const char*)(ap.ws + WS_WR), pm}; EpiRoute E{rlog};
                  pg8::gemm_phase<EpiRoute, SchedRoute>(lds, g, S, E, tid_); }
                asm volatile("s_waitcnt vmcnt(0)" ::: "memory"); __syncthreads();
                if (tid_ < 128) route_decide(ap, l, rlog + (size_t)(pm * 128 + tid_) * 128, rec_e, rec_slot, rec_w, ctl + CW_CNT + l * 32, pm * 128 + tid_);
                __syncthreads();
            }
            expert_weights(ap, l, lds, 0, NITW, gw, NGW, wave, lane);
            SEAM(pb + 7);
        }
        if (IN(pb + 8)) {
            PHASE_IDS();
            build_offsets(ctl + CW_CNT + l * 32, offt, tid_);
            if (bid < 32) { const int e = bid; const int c = (int)__hip_atomic_load(ctl + CW_CNT + l * 32 + e, __ATOMIC_RELAXED, __HIP_MEMORY_SCOPE_AGENT);
                for (int p = offt[e] + c + tid_; p < offt[e + 1]; p += 512) rowtok[p] = -1; }
            {   const GAS bf16* xr = (const GAS bf16*)(ap.ws + WS_XR); GAS bf16* xsg = (GAS bf16*)xs;
                for (int tok0 = gw * 4; tok0 < T; tok0 += NGW * 4) {
                    u32x4 v0[4], v1[4]; int pos[4][2];
#pragma unroll
                    for (int rr = 0; rr < 4; ++rr) { v0[rr] = *(const GAS u32x4*)(xr + (size_t)(tok0 + rr) * 2048 + lane * 8); v1[rr] = *(const GAS u32x4*)(xr + (size_t)(tok0 + rr) * 2048 + 512 + lane * 8);
#pragma unroll
                        for (int k = 0; k < 2; ++k) pos[rr][k] = offt[rec_e[(tok0 + rr) * 2 + k]] + rec_slot[(tok0 + rr) * 2 + k]; }
#pragma unroll
                    for (int rr = 0; rr < 4; ++rr)
#pragma unroll
                        for (int k = 0; k < 2; ++k) { const int p = pos[rr][k];
                            *(GAS u32x4*)(xsg + (size_t)p * 1024 + lane * 8) = v0[rr]; *(GAS u32x4*)(xsg + (size_t)p * 1024 + 512 + lane * 8) = v1[rr];
                            if (lane == 0) { rowtok[p] = (tok0 + rr) * 2 + k; roww[p] = rec_w[(tok0 + rr) * 2 + k]; } } } }
            SEAM(pb + 8);
        }
        if (IN(pb + 9)) {
            PHASE_IDS();
            build_offsets(ctl + CW_CNT + l * 32, offt, tid_);
            pg8::Gemm g{1024, 1024, 1024, 128, -1}; SchedM2 S{(const char*)xs, (const char*)(ap.ws + WS_WGU), offt, G, bid};
            EpiM2 E{hmid};
            pg8::gemm_phase<EpiM2, SchedM2>(lds, g, S, E, tid_); SEAM(pb + 9);
        }
        if (IN(pb + 10)) {
            PHASE_IDS();
            build_offsets(ctl + CW_CNT + l * 32, offt, tid_);
            pg8::Gemm g{256, 256, 256, 128, -1}; SchedM3 S{(const char*)hmid, (const char*)(ap.ws + WS_WD), offt, G, bid};
            EpiM3 E{eo, rowtok, roww};
            pg8::gemm_phase<EpiM3, SchedM3>(lds, g, S, E, tid_); SEAM(pb + 10);
        }
    }
    if (IN(2 * PPL)) { PHASE_IDS(); phase0_rows(ap, DEPTH, 1, gw, NGW, lane); }
#undef IN
#undef SEAM
}

typedef void (*kern_t)(Args);
template <unsigned PM> static bool setup_kernel() {
    if (hipFuncSetAttribute((const void*)mk_fwd<PM>, hipFuncAttributeMaxDynamicSharedMemorySize, LDS_BYTES) != hipSuccess) { fprintf(stderr, "kernel_launch: hipFuncSetAttribute failed\n"); return false; }
    return true;
}
extern "C" void kernel_launch(void* const* d_in, const int* in_sizes, int n_in, void* d_out, int out_size, void* d_ws, size_t ws_size, hipStream_t stream) {
    static int grid = 0;
    if (grid == 0) {
        if (n_in != 36 || out_size != T * D || ws_size < WS_END) { fprintf(stderr, "kernel_launch: unexpected shapes (n_in %d out %d ws %zu)\n", n_in, out_size, ws_size); grid = -1; return; }
        int dev = 0, cus = 0;
        if (hipGetDevice(&dev) != hipSuccess || hipDeviceGetAttribute(&cus, hipDeviceAttributeMultiprocessorCount, dev) != hipSuccess) { grid = -1; return; }
        bool ok = true;
#if MK_ONE_LAUNCH
        ok = setup_kernel<0xFFFu>();
#endif
        if (!ok) { grid = -1; return; }
        (void)hipGetLastError();
        grid = cus;
        if (grid != 256) { fprintf(stderr, "kernel_launch: built for a 256-CU device (got %d)\n", cus); grid = -1; return; }
    }
    if (grid < 0) return;
    if (hipMemsetAsync((char*)d_ws + WS_CTL, 0, CTL_ZERO_BYTES, stream) != hipSuccess) return;
    Args a{};
    for (int i = 0; i < 36; ++i) a.in[i] = (const float*)d_in[i];
    a.out = (float*)d_out; a.ws = (unsigned char*)d_ws;
#if MK_ONE_LAUNCH
    a.ph_lo = 0; a.ph_hi = NPH;
    hipLaunchKernelGGL(mk_fwd<0xFFFu>, dim3(grid), dim3(512), LDS_BYTES, stream, a);
#endif
}
```

```cpp
#include <hip/hip_runtime.h>
#include <cstdio>
#include <cstdint>

#ifndef MK_ONE_LAUNCH
#define MK_ONE_LAUNCH 1
#endif

#define DI __device__ __forceinline__
#define GAS __attribute__((address_space(1)))
#define LAS __attribute__((address_space(3)))
typedef unsigned short bf16;
typedef short bf16x8 __attribute__((ext_vector_type(8)));
typedef float f32x4 __attribute__((ext_vector_type(4)));
typedef unsigned u32x4 __attribute__((ext_vector_type(4)));
typedef unsigned u32x2 __attribute__((ext_vector_type(2)));
typedef float f32x16 __attribute__((ext_vector_type(16)));
typedef float f32x2 __attribute__((ext_vector_type(2)));
typedef short s16x4 __attribute__((ext_vector_type(4)));
typedef __bf16 bf16x2_t __attribute__((ext_vector_type(2)));
typedef short v4i16_t __attribute__((__vector_size__(4 * sizeof(short))));
#define MFMA32(a, b, c) __builtin_amdgcn_mfma_f32_32x32x16_bf16((a), (b), (c), 0, 0, 0)

constexpr int BATCH = 4, SEQ = 8192, T = BATCH * SEQ, D = 1024, DEPTH = 2;
constexpr int NIN = 2444, PLD = 2560, N1 = 6656, GLD = 4096;
constexpr int C_AX = 0, C_AG = 256, C_BQ = 512, C_BK = 768, C_BV = 896, C_CQ = 1024, C_CK = 1280, C_CV = 1536, C_DQ = 1792,
              C_KC = 2048, C_VC = 2112, C_KS = 2176, C_VS = 2240, C_KW = 2304, C_VW = 2368, C_DG = 2432;
constexpr int NCMP = 511;
constexpr int MOE_ROWS = 73728;
constexpr int PPL = 11;
constexpr int NPH = 2 * PPL + 1;

constexpr size_t MiB = 1u << 20;
constexpr size_t WS_CTL = 0, CTL_ZERO_BYTES = 1 * MiB;
constexpr size_t WS_KCVC = 1 * MiB;
constexpr size_t WS_LRUSUM = 2 * MiB;
constexpr size_t WS_REC = 2 * MiB + 256 * 1024;
constexpr size_t WS_ROWTOK = 3 * MiB;
constexpr size_t WS_ROWW = 3 * MiB + 512 * 1024;
constexpr size_t WS_WIN = 4 * MiB;
constexpr size_t WS_WBR = 17 * MiB;
constexpr size_t WS_WOUT = 19 * MiB;
constexpr size_t WS_HB = 21 * MiB;
constexpr size_t WS_PROJ = 85 * MiB;
constexpr size_t WS_GATES = 245 * MiB;
constexpr size_t WS_WGU = 245 * MiB;
constexpr size_t WS_WD = 277 * MiB;
constexpr size_t WS_XS = 293 * MiB;
constexpr size_t WS_HMID = 437 * MiB;
constexpr size_t WS_XR = 85 * MiB;
constexpr size_t WS_RLOG = 213 * MiB;
constexpr size_t WS_WR = 501 * MiB;
constexpr size_t WS_WCMP = 502 * MiB;
constexpr size_t WS_CMPAB = 503 * MiB;
constexpr size_t WS_LRUW = 505 * MiB + 65536;
constexpr size_t WS_END = 506 * MiB;
constexpr int CW_BAR = 4096;
constexpr int CW_CNT = 16384;

constexpr int RING_BYTES = 131072;
constexpr int MISC_OFF = RING_BYTES;
constexpr int BIAS_OFF = MISC_OFF + 256;
constexpr int OFFT_OFF = BIAS_OFF + 129 * 12 * 4;
constexpr int PTAB_OFF = OFFT_OFF + (40 + 288) * 4;
constexpr int BIAS2_OFF = PTAB_OFF + 36 * 8;
constexpr int LRUEX_OFF = BIAS2_OFF + 129 * 12 * 4;
constexpr int LDS_BYTES = 163840;
constexpr int LRUCST_OFF = LRUEX_OFF + 8 * 64 * 2 * 4;
constexpr int LRUCAR_OFF = LRUCST_OFF + 3 * 64 * 4;
static_assert(PTAB_OFF % 8 == 0 && LRUCAR_OFF + 8 * 64 * 4 <= LDS_BYTES, "LDS map");

DI float bf2f(bf16 v) { return __builtin_bit_cast(float, (unsigned)v << 16); }
DI float lo_bf(unsigned w) { return __builtin_bit_cast(float, w << 16); }
DI float hi_bf(unsigned w) { return __builtin_bit_cast(float, w & 0xffff0000u); }
DI unsigned f2bf(float f) { unsigned u = __builtin_bit_cast(unsigned, f); return (u + 0x7fffu + ((u >> 16) & 1u)) >> 16; }
DI unsigned pk2(float lo, float hi) { return f2bf(lo) | (f2bf(hi) << 16); }
DI float rl(float v, int i) { return __builtin_bit_cast(float, __builtin_amdgcn_readlane(__builtin_bit_cast(int, v), i)); }
DI int rli(int v, int i) { return __builtin_amdgcn_readlane(v, i); }
DI int my_lane() { int l; asm volatile("v_mbcnt_lo_u32_b32 %0, -1, 0\n\tv_mbcnt_hi_u32_b32 %0, -1, %0" : "=v"(l)); return l; }
template <int O> DI int xshfl_i(int v) {
    if constexpr (O < 32) return __builtin_amdgcn_ds_swizzle(v, (O << 10) | 0x1f);
    else { const int l = my_lane(); return __builtin_amdgcn_ds_bpermute((l ^ 32) << 2, v); }
}
template <int O> DI float xshfl(float v) { return __builtin_bit_cast(float, xshfl_i<O>(__builtin_bit_cast(int, v))); }
DI float wave_sum(float v) { v += xshfl<1>(v); v += xshfl<2>(v); v += xshfl<4>(v); v += xshfl<8>(v); v += xshfl<16>(v); v += xshfl<32>(v); return v; }
DI float wave_max(float v) { v = fmaxf(v, xshfl<1>(v)); v = fmaxf(v, xshfl<2>(v)); v = fmaxf(v, xshfl<4>(v)); v = fmaxf(v, xshfl<8>(v)); v = fmaxf(v, xshfl<16>(v)); v = fmaxf(v, xshfl<32>(v)); return v; }
DI float sigmoidf_(float x) { return __builtin_amdgcn_rcpf(1.f + __builtin_amdgcn_exp2f(-1.4426950408889634f * x)); }
DI float gelu_tanh(float x) { const float u = 0.7978845608028654f * (x + 0.044715f * x * x * x); const float e = __expf(2.f * u); const float th = 1.f - 2.f * __builtin_amdgcn_rcpf(e + 1.f); return 0.5f * x * (1.f + th); }
DI float softplusf_(float x) { return fmaxf(x, 0.f) + log1pf(__expf(-fabsf(x))); }
#define LDS_WAIT() asm volatile("s_waitcnt lgkmcnt(0)" ::: "memory")
#define VM_WAIT() asm volatile("s_waitcnt vmcnt(0)" ::: "memory")

__device__ const unsigned char T5_BUCKET[128] = {
0,1,2,3,4,5,6,7,8,9,10,11,12,13,14,15,16,16,16,17,17,18,18,18,19,19,19,20,20,20,20,21,21,21,21,22,22,22,22,22,23,23,23,23,23,23,24,24,24,24,24,24,25,25,25,25,25,25,25,26,26,26,26,26,26,26,26,27,27,27,27,27,27,27,27,27,27,28,28,28,28,28,28,28,28,28,28,29,29,29,29,29,29,29,29,29,29,29,29,30,30,30,30,30,30,30,30,30,30,30,30,30,30,31,31,31,31,31,31,31,31,31,31,31,31,31,31,31};

#define XB_TMO      128
#define XB_XCNT(j)  (256  + 64 * (j))
#define XB_XSUB(j)  (1280 + 64 * (j))
#define XB_XGEN(j)  (2304 + 64 * (j))
#define XB_TOP      3328
#define XB_TOPGEN   3392
#define XCD_BAR_WORDS 3456
#define XB_SPIN_CAP (1u << 22)
DI unsigned xb_ld(unsigned* p)              { return __hip_atomic_load(p, __ATOMIC_RELAXED, __HIP_MEMORY_SCOPE_AGENT); }
DI unsigned xb_add(unsigned* p, unsigned v) { return __hip_atomic_fetch_add(p, v, __ATOMIC_RELAXED, __HIP_MEMORY_SCOPE_AGENT); }
DI unsigned xb_xcc_id() { return (unsigned)__builtin_amdgcn_s_getreg((3 << 11) | 20) & 0xFu; }
#define XB_SPIN(cond, bar) do { unsigned _sp = 0; while (cond) { __builtin_amdgcn_s_sleep(1); \
    if ((++_sp & 255u) == 0u) { if (xb_ld(&(bar)[XB_TMO])) break; if (_sp > XB_SPIN_CAP) { atomicAdd(&(bar)[XB_TMO], 1u); break; } } } } while (0)
struct XcdBarrier { unsigned* bar; unsigned x; volatile LAS unsigned* st; };
DI XcdBarrier xcd_barrier_post(unsigned* bar, volatile LAS unsigned* st, bool leader) {
    XcdBarrier b; b.bar = bar; b.x = xb_xcc_id(); b.st = st;
    if (leader) (void)xb_add(&bar[XB_XCNT(b.x)], 1u);
    return b;
}
DI void xcd_barrier_complete(unsigned* bar, unsigned x, unsigned& nloc, unsigned& nx) {
    const unsigned G = gridDim.x * gridDim.y * gridDim.z;
    unsigned sum, cnt, mine, sp = 0u;
    for (;;) {
        sum = 0u; cnt = 0u; mine = 0u;
#pragma unroll
        for (unsigned j = 0; j < 16; ++j) { const unsigned c = xb_ld(&bar[XB_XCNT(j)]); sum += c; cnt += (c > 0u) ? 1u : 0u; mine = (j == x) ? c : mine; }
        if (sum == G) break;
        __builtin_amdgcn_s_sleep(1);
        if ((++sp & 255u) == 0u) { if (xb_ld(&bar[XB_TMO])) break; if (sp > XB_SPIN_CAP) { atomicAdd(&bar[XB_TMO], 1u); break; } }
    }
    nloc = mine > 0u ? mine : 1u; nx = cnt > 0u ? cnt : 1u;
}
DI void xcd_barrier(const XcdBarrier& b, bool leader) {
    asm volatile("s_waitcnt vmcnt(0)" ::: "memory");
    __syncthreads();
    if (leader) {
        unsigned* bar = b.bar;
        __builtin_amdgcn_s_waitcnt(0);
        unsigned nloc = b.st[0], nx = b.st[1];
        if (nloc == 0u) { xcd_barrier_complete(bar, b.x, nloc, nx); b.st[0] = nloc; b.st[1] = nx; }
        const unsigned old = xb_add(&bar[XB_XSUB(b.x)], 1u);
        const unsigned gen = old / nloc;
        if (old + 1u == (gen + 1u) * nloc) {
            __builtin_amdgcn_fence(__ATOMIC_RELEASE, "agent");
            asm volatile("s_waitcnt vmcnt(0)" ::: "memory");
            const unsigned og = xb_add(&bar[XB_TOP], 1u);
            const unsigned tg = og / nx;
            if (og + 1u == (tg + 1u) * nx) xb_add(&bar[XB_TOPGEN], 1u);
            else XB_SPIN(xb_ld(&bar[XB_TOPGEN]) == tg, bar);
            __builtin_amdgcn_fence(__ATOMIC_ACQUIRE, "agent");
            xb_add(&bar[XB_XGEN(b.x)], 1u);
            asm volatile("s_waitcnt vmcnt(0)" ::: "memory");
        } else {
            XB_SPIN(xb_ld(&bar[XB_XGEN(b.x)]) == gen, bar);
            __builtin_amdgcn_fence(__ATOMIC_ACQUIRE, "agent");
            asm volatile("s_waitcnt vmcnt(0)" ::: "memory");
        }
    }
    __syncthreads();
}

namespace pg8 {
constexpr int BM = 256, BK = 64, HALF = 128, HTB = HALF * BK * 2;
__host__ __device__ __forceinline__ int lds_byte(int r, int c) { const int st = (r >> 4) * 2 + (c >> 5), rr = r & 15, cc = c & 31, ob = rr * 64 + cc * 2; return st * 1024 + (ob ^ (((ob >> 9) & 1) << 5)); }
__host__ __device__ __forceinline__ void stage_rc(int b, int& R, int& C) { const int st = b / 1024, sb = b % 1024, swz = sb ^ (((sb >> 9) & 1) << 5); R = (st >> 1) * 16 + swz / 64; C = (st & 1) * 32 + (swz % 64) / 2; }
__host__ __device__ __forceinline__ int perm32(int rho) { const int n = rho >> 4, i = rho & 15; return 8 * (i >> 2) + 4 * n + (i & 3); }
struct Unit { const char* a; const char* b; int pm, pn, aux, pad; };
struct Gemm { int K, lda, ldb, kstepA, hstepA; };
template <class Epi, class Sched>
DI void gemm_phase(LAS unsigned char* lds, const Gemm g, const Sched& S, const Epi& E, int tid_in) {
    int tid = tid_in; asm volatile("" : "+v"(tid));
    const int wid = __builtin_amdgcn_readfirstlane(tid >> 6), lane = tid & 63, wr = wid >> 2, wc = wid & 3, fr = lane & 15, fq = lane >> 4;
    const int K = g.K, nt = K / BK;
    unsigned voffA[2], voffB[2];
#pragma unroll
    for (int i = 0; i < 2; ++i) { int R, C; stage_rc(tid * 16 + i * 8192, R, C); const int Rb = (R & ~31) + perm32(R & 31);
        voffA[i] = (unsigned)(R * g.lda + C) * 2u; voffB[i] = (unsigned)(Rb * g.ldb + C) * 2u; }
    const size_t kstep = (size_t)(BK * 2), kstepA = (size_t)g.kstepA;
    const size_t hstepA = g.hstepA < 0 ? (size_t)HALF * g.lda * 2 : (size_t)g.hstepA, hstepB = (size_t)HALF * g.ldb * 2;
    const unsigned ldsw = (unsigned)wid * 1024u;
    const int aoff = lds_byte(wr * 64 + fr, fq * 8), boff = lds_byte(wc * 32 + fr, fq * 8);
#define PG8_SA(b, h) (((b) * 2 + (h)) * HTB)
#define PG8_SB(b, h) ((4 + (b) * 2 + (h)) * HTB)
#define PG8_STAGE(bufoff, gbase, voff) do { _Pragma("unroll") for (int _i = 0; _i < 2; ++_i) \
        __builtin_amdgcn_global_load_lds((const unsigned*)((const char*)(gbase) + (voff)[_i]), (LAS unsigned*)(lds + (bufoff) + ldsw + _i * 8192), 16, 0, 0); } while (0)
#define PG8_LDA(dst, b, h) do { _Pragma("unroll") for (int m = 0; m < 4; ++m) _Pragma("unroll") for (int k = 0; k < 2; ++k) dst[m][k] = *(const LAS bf16x8*)(lds + PG8_SA(b, h) + aoff + m * 2048 + k * 1024); } while (0)
#define PG8_LDB(dst, b, h) do { _Pragma("unroll") for (int n = 0; n < 2; ++n) _Pragma("unroll") for (int k = 0; k < 2; ++k) dst[n][k] = *(const LAS bf16x8*)(lds + PG8_SB(b, h) + boff + n * 2048 + k * 1024); } while (0)
#define PG8_MMA(ai, bj, At, Bt) do { __builtin_amdgcn_s_setprio(1); _Pragma("unroll") for (int m = 0; m < 4; ++m) _Pragma("unroll") for (int n = 0; n < 2; ++n) _Pragma("unroll") for (int k = 0; k < 2; ++k) \
        acc[ai][bj][m][n] = __builtin_amdgcn_mfma_f32_16x16x32_bf16(Bt[n][k], At[m][k], acc[ai][bj][m][n], 0, 0, 0); __builtin_amdgcn_s_setprio(0); } while (0)
#define PG8_WAIT_V(n) asm volatile("s_waitcnt vmcnt(" #n ")" ::: "memory")
#define PG8_WAIT_L(n) asm volatile("s_waitcnt lgkmcnt(" #n ")" ::: "memory")
#define PG8_BAR __builtin_amdgcn_s_barrier()
#define PG8_SCHED __builtin_amdgcn_sched_barrier(0)
    Unit cur, nxt; int ui = 0;
    if (!S.next(0, cur)) return;
    f32x4 acc[2][2][4][2];
#pragma unroll
    for (int a = 0; a < 2; ++a)
#pragma unroll
        for (int b = 0; b < 2; ++b)
#pragma unroll
            for (int m = 0; m < 4; ++m)
#pragma unroll
                for (int n = 0; n < 2; ++n) acc[a][b][m][n] = (f32x4){0.f, 0.f, 0.f, 0.f};
    bf16x8 At[4][2], B0[2][2], B1[2][2];
    const char* cA = cur.a; const char* cB = cur.b;
    PG8_STAGE(PG8_SB(0, 0), cB, voffB); PG8_STAGE(PG8_SB(0, 1), cB + hstepB, voffB); PG8_STAGE(PG8_SA(0, 0), cA, voffA); PG8_STAGE(PG8_SA(0, 1), cA + hstepA, voffA);
    if (wr == 1) PG8_BAR;
    PG8_WAIT_V(2); PG8_BAR;
    PG8_STAGE(PG8_SB(1, 0), cB + kstep, voffB); PG8_STAGE(PG8_SA(1, 0), cA + kstepA, voffA); PG8_STAGE(PG8_SB(1, 1), cB + hstepB + kstep, voffB);
    PG8_WAIT_V(6); PG8_BAR;
    for (;;) {
        const bool has_next = S.next(ui + 1, nxt);
        const char* nA = has_next ? nxt.a : cA; const char* nB = has_next ? nxt.b : cB;
        for (int t = 0; t < nt; t += 2) {
            const bool last = (t == nt - 2);
            const char* a1 = cA + (size_t)(t + 1) * kstepA;
            const char* a2 = last ? nA : cA + (size_t)(t + 2) * kstepA; const char* b2 = last ? nB : cB + (size_t)(t + 2) * kstep;
            const char* a3 = a2 + kstepA; const char* b3 = b2 + kstep;
            PG8_LDB(B0, 0, 0); PG8_LDB(B1, 0, 1); PG8_SCHED; PG8_LDA(At, 0, 0); PG8_STAGE(PG8_SA(1, 1), a1 + hstepA, voffA);
            PG8_WAIT_V(8); PG8_WAIT_L(0); PG8_BAR; PG8_MMA(0, 0, At, B0); PG8_MMA(0, 1, At, B1); PG8_BAR; PG8_SCHED;
            PG8_LDA(At, 0, 1); PG8_STAGE(PG8_SB(0, 0), b2, voffB); PG8_STAGE(PG8_SB(0, 1), b2 + hstepB, voffB); PG8_STAGE(PG8_SA(0, 0), a2, voffA);
            PG8_WAIT_V(8); PG8_WAIT_L(0); PG8_BAR; PG8_MMA(1, 0, At, B0); PG8_MMA(1, 1, At, B1); PG8_BAR; PG8_SCHED;
            PG8_LDB(B0, 1, 0); PG8_LDB(B1, 1, 1); PG8_SCHED; PG8_LDA(At, 1, 0); PG8_STAGE(PG8_SA(0, 1), a2 + hstepA, voffA);
            PG8_WAIT_V(8); PG8_WAIT_L(0); PG8_BAR; PG8_MMA(0, 0, At, B0); PG8_MMA(0, 1, At, B1); PG8_BAR; PG8_SCHED;
            PG8_LDA(At, 1, 1); PG8_STAGE(PG8_SB(1, 0), b3, voffB); PG8_STAGE(PG8_SB(1, 1), b3 + hstepB, voffB); PG8_STAGE(PG8_SA(1, 0), a3, voffA);
            PG8_WAIT_V(8); PG8_WAIT_L(0); PG8_BAR; PG8_MMA(1, 0, At, B0); PG8_MMA(1, 1, At, B1); PG8_BAR; PG8_SCHED;
        }
        if (wr == 0) PG8_BAR;
        { const int el = my_lane(); E(acc, cur, wr, wc, el & 15, el >> 4); }
        if (!has_next) break;
#pragma unroll
        for (int a = 0; a < 2; ++a)
#pragma unroll
            for (int b = 0; b < 2; ++b)
#pragma unroll
                for (int m = 0; m < 4; ++m)
#pragma unroll
                    for (int n = 0; n < 2; ++n) acc[a][b][m][n] = (f32x4){0.f, 0.f, 0.f, 0.f};
        cur = nxt; cA = nA; cB = nB; ++ui;
        if (wr == 1) PG8_BAR;
    }
    PG8_WAIT_V(0);
    PG8_BAR;
#undef PG8_SA
#undef PG8_SB
#undef PG8_STAGE
#undef PG8_LDA
#undef PG8_LDB
#undef PG8_MMA
#undef PG8_WAIT_V
#undef PG8_WAIT_L
#undef PG8_BAR
#undef PG8_SCHED
}
}
using pg8::Unit;

DI unsigned cvt_pk_bf16(float lo, float hi) { unsigned r; asm volatile("s_nop 1\n\tv_cvt_pk_bf16_f32 %0, %1, %2" : "=v"(r) : "v"(lo), "v"(hi)); return r; }
DI u32x4 pack8(const f32x4& v0, const f32x4& v1) { u32x4 w; w.x = cvt_pk_bf16(v0[0], v0[1]); w.y = cvt_pk_bf16(v0[2], v0[3]); w.z = cvt_pk_bf16(v1[0], v1[1]); w.w = cvt_pk_bf16(v1[2], v1[3]); return w; }

struct SchedP1 {
    const char* A; const char* B; int G, c;
    DI bool next(int i, Unit& u) const {
        constexpr int nM = 128, nN = 26, nwg = nM * nN, NXCD = 8, WGM = 8;
        const long L = (long)i * G + c; if (L >= nwg) return false;
        int wgid = (int)L; { const int q = nwg / NXCD, r = nwg % NXCD, xcd = wgid % NXCD, off = wgid / NXCD; wgid = (xcd < r ? xcd * (q + 1) : r * (q + 1) + (xcd - r) * q) + off; }
        const int nig = WGM * nN, gid = wgid / nig, fm = gid * WGM, gsz = (nM - fm) < WGM ? (nM - fm) : WGM;
        u.pm = fm + ((wgid % nig) % gsz); u.pn = (wgid % nig) / gsz; u.aux = 0; u.pad = 0;
        u.a = A + (size_t)u.pm * 256 * 1024 * 2; u.b = B + (size_t)u.pn * 256 * 1024 * 2; return true;
    }
};
struct SchedP3a {
    const char* ys; const char* wbr; int G, c;
    DI bool next(int i, Unit& u) const {
        const int tile = (i >> 2) * G + c; if (tile >= 512) return false;
        const int br = i & 3; u.pm = tile >> 2; u.pn = tile & 3; u.aux = br; u.pad = 0;
        u.a = ys + ((size_t)u.pm * 256 * 1024 + br * 256) * 2; u.b = wbr + ((size_t)br * 1024 * 256 + (size_t)u.pn * 256 * 256) * 2; return true;
    }
};
struct SchedP3b {
    const char* A; const char* B; int G, c;
    DI bool next(int i, Unit& u) const {
        const int L = i * G + c; if (L >= 512) return false;
        u.pm = L >> 2; u.pn = L & 3; u.aux = 0; u.pad = 0;
        u.a = A + (size_t)u.pm * 256 * 1024 * 2; u.b = B + (size_t)u.pn * 256 * 1024 * 2; return true;
    }
};
struct SchedM2 {
    const char* xs; const char* wgu; const LAS int* offt; int G, c;
    DI bool next(int i, Unit& u) const {
        const int NT = __builtin_amdgcn_readfirstlane(offt[32]) >> 8; const int L = i * G + c; if (L >= NT * 2) return false;
        const int rt = L >> 1, pn = L & 1; const int e = __builtin_amdgcn_readfirstlane(offt[40 + rt]);
        u.pm = rt; u.pn = pn; u.aux = e; u.pad = 0;
        u.a = xs + (size_t)rt * 256 * 1024 * 2; u.b = wgu + ((size_t)e * 512 + pn * 256) * 1024 * 2; return true;
    }
};
struct SchedM3 {
    const char* hmid; const char* wd; const LAS int* offt; int G, c;
    DI bool next(int i, Unit& u) const {
        const int NT = __builtin_amdgcn_readfirstlane(offt[32]) >> 8; const int L = i * G + c; if (L >= NT * 4) return false;
        const int rt = L >> 2, pn = L & 3; const int e = __builtin_amdgcn_readfirstlane(offt[40 + rt]);
        u.pm = rt; u.pn = pn; u.aux = e; u.pad = 0;
        u.a = hmid + (size_t)rt * 256 * 256 * 2; u.b = wd + ((size_t)e * 1024 + pn * 256) * 256 * 2; return true;
    }
};

struct EpiP1 {
    bf16* proj; bf16* gates; const float* bgate;
    DI void operator()(const f32x4 (&acc)[2][2][4][2], const Unit& u, int wr, int wc, int fr, int fq) const {
        const int row0 = u.pm * 256 + wr * 64 + fr; const int colt = u.pn * 256 + wc * 32 + 8 * fq;
        if (u.pn < 10) {
#pragma unroll
            for (int ai = 0; ai < 2; ++ai)
#pragma unroll
                for (int m = 0; m < 4; ++m) { bf16* rowp = proj + (size_t)(row0 + ai * 128 + m * 16) * PLD + colt;
#pragma unroll
                    for (int bj = 0; bj < 2; ++bj) *(u32x4*)(rowp + bj * 128) = pack8(acc[ai][bj][m][0], acc[ai][bj][m][1]); }
        } else {
            const int gcol = colt - 2560;
            f32x4 bv[2][2];
#pragma unroll
            for (int bj = 0; bj < 2; ++bj)
#pragma unroll
                for (int n = 0; n < 2; ++n) bv[bj][n] = *(const f32x4*)(bgate + gcol + bj * 128 + 4 * n);
#pragma unroll
            for (int ai = 0; ai < 2; ++ai)
#pragma unroll
                for (int m = 0; m < 4; ++m) { bf16* rowp = gates + (size_t)(row0 + ai * 128 + m * 16) * GLD + gcol;
#pragma unroll
                    for (int bj = 0; bj < 2; ++bj) { f32x4 v0 = acc[ai][bj][m][0] + bv[bj][0], v1 = acc[ai][bj][m][1] + bv[bj][1];
#pragma unroll
                        for (int e = 0; e < 4; ++e) { v0[e] = sigmoidf_(v0[e]); v1[e] = sigmoidf_(v1[e]); }
                        *(u32x4*)(rowp + bj * 128) = pack8(v0, v1); }
                    __builtin_amdgcn_sched_barrier(0); }
        }
    }
};
struct EpiP3a {
    bf16* merged; const bf16* gates;
    DI void operator()(const f32x4 (&acc)[2][2][4][2], const Unit& u, int wr, int wc, int fr, int fq) const {
        const int row0 = u.pm * 256 + wr * 64 + fr; const int colt = u.pn * 256 + wc * 32 + 8 * fq; const int br = u.aux;
#pragma unroll
        for (int ai = 0; ai < 2; ++ai)
#pragma unroll
            for (int m = 0; m < 4; ++m) { const size_t row = (size_t)(row0 + ai * 128 + m * 16);
#pragma unroll
                for (int bj = 0; bj < 2; ++bj) {
                    const u32x4 gw = *(const u32x4*)(gates + row * GLD + br * 1024 + colt + bj * 128);
                    bf16* mp = merged + row * 1024 + colt + bj * 128;
                    f32x4 v0 = acc[ai][bj][m][0], v1 = acc[ai][bj][m][1];
                    v0[0] *= lo_bf(gw.x); v0[1] *= hi_bf(gw.x); v0[2] *= lo_bf(gw.y); v0[3] *= hi_bf(gw.y);
                    v1[0] *= lo_bf(gw.z); v1[1] *= hi_bf(gw.z); v1[2] *= lo_bf(gw.w); v1[3] *= hi_bf(gw.w);
                    if (br != 0) { const u32x4 mw = *(const u32x4*)mp;
                        v0[0] += lo_bf(mw.x); v0[1] += hi_bf(mw.x); v0[2] += lo_bf(mw.y); v0[3] += hi_bf(mw.y);
                        v1[0] += lo_bf(mw.z); v1[1] += hi_bf(mw.z); v1[2] += lo_bf(mw.w); v1[3] += hi_bf(mw.w); }
                    *(u32x4*)mp = pack8(v0, v1); }
                __builtin_amdgcn_sched_barrier(0); }
    }
};
struct EpiP3b {
    const float* xin; float* out;
    DI void operator()(const f32x4 (&acc)[2][2][4][2], const Unit& u, int wr, int wc, int fr, int fq) const {
        const int row0 = u.pm * 256 + wr * 64 + fr; const int colt = u.pn * 256 + wc * 32 + 8 * fq;
#pragma unroll
        for (int ai = 0; ai < 2; ++ai)
#pragma unroll
            for (int m = 0; m < 4; ++m) { const size_t off = (size_t)(row0 + ai * 128 + m * 16) * 1024 + colt;
#pragma unroll
                for (int bj = 0; bj < 2; ++bj)
#pragma unroll
                    for (int n = 0; n < 2; ++n) { const f32x4 xv = *(const f32x4*)(xin + off + bj * 128 + 4 * n); *(f32x4*)(out + off + bj * 128 + 4 * n) = xv + acc[ai][bj][m][n]; }
                __builtin_amdgcn_sched_barrier(0); }
    }
};
struct EpiM2 {
    bf16* hmid;
    DI void operator()(const f32x4 (&acc)[2][2][4][2], const Unit& u, int wr, int wc, int fr, int fq) const {
        const int row0 = u.pm * 256 + wr * 64 + fr; const int col = u.pn * 128 + wc * 32 + 8 * fq;
#pragma unroll
        for (int ai = 0; ai < 2; ++ai)
#pragma unroll
            for (int m = 0; m < 4; ++m) { f32x4 h0, h1;
#pragma unroll
                for (int e = 0; e < 4; ++e) { const float g0 = acc[ai][0][m][0][e], g1 = acc[ai][0][m][1][e];
                    h0[e] = g0 * sigmoidf_(g0) * acc[ai][1][m][0][e]; h1[e] = g1 * sigmoidf_(g1) * acc[ai][1][m][1][e]; }
                *(u32x4*)(hmid + (size_t)(row0 + ai * 128 + m * 16) * 256 + col) = pack8(h0, h1); }
    }
};
struct EpiM3 {
    bf16* eo; const int* rowtok; const float* roww;
    DI void operator()(const f32x4 (&acc)[2][2][4][2], const Unit& u, int wr, int wc, int fr, int fq) const {
        const int row0 = u.pm * 256 + wr * 64 + fr; const int colt = u.pn * 256 + wc * 32 + 8 * fq;
#pragma unroll
        for (int ai = 0; ai < 2; ++ai)
#pragma unroll
            for (int m = 0; m < 4; ++m) { const int row = row0 + ai * 128 + m * 16; const int tk = rowtok[row];
                if (tk >= 0) { const float w = roww[row]; bf16* op = eo + (size_t)tk * 1024 + colt;
#pragma unroll
                    for (int bj = 0; bj < 2; ++bj) *(u32x4*)(op + bj * 128) = pack8(acc[ai][bj][m][0] * w, acc[ai][bj][m][1] * w); }
                __builtin_amdgcn_sched_barrier(0); }
    }
};

struct Args { const float* in[36]; float* out; unsigned char* ws; int ph_lo, ph_hi; };
struct InTab { unsigned base;
    DI const float* operator[](int i) const { unsigned long long v; const unsigned addr = base + (unsigned)i * 8u;
        asm volatile("ds_read_b64 %0, %1\n\ts_waitcnt lgkmcnt(0)" : "=v"(v) : "v"(addr) : "memory");
        const unsigned lo = __builtin_amdgcn_readfirstlane((unsigned)v), hi = __builtin_amdgcn_readfirstlane((unsigned)(v >> 32));
        return (const float*)(((unsigned long long)hi << 32) | lo); } };
struct KA { InTab in; float* out; unsigned char* ws; };

DI void transpose_item(const float* W, int ldw, int nvalid, bf16* WT, int ldt, int k0, int n0, int dst_row0, LAS float* scr, int lane) {
    const bool nok = (n0 + (lane & 31)) < nvalid;
#pragma unroll 8
    for (int i = 0; i < 32; ++i) { const int kk = 2 * i + (lane >> 5); scr[kk * 33 + (lane & 31)] = nok ? W[(size_t)(k0 + kk) * ldw + n0 + (lane & 31)] : 0.f; }
    LDS_WAIT(); asm volatile("" ::: "memory");
    const int c = lane & 7;
#pragma unroll
    for (int j = 0; j < 4; ++j) { const int n = (lane >> 3) + 8 * j; const LAS float* s = scr + (8 * c) * 33 + n;
        u32x4 o; o.x = pk2(s[0 * 33], s[1 * 33]); o.y = pk2(s[2 * 33], s[3 * 33]); o.z = pk2(s[4 * 33], s[5 * 33]); o.w = pk2(s[6 * 33], s[7 * 33]);
        if (n0 + n < nvalid) *(u32x4*)(WT + (size_t)(dst_row0 + n) * ldt + k0 + 8 * c) = o; }
    LDS_WAIT(); asm volatile("" ::: "memory");
}
DI void phase0_weights(const KA& a, int l, LAS unsigned char* lds, int gw, int NGW, int wave, int lane) {
    LAS float* scr = (LAS float*)(lds + wave * 16384);
    const float* w_in = a.in[4] + (size_t)l * 1024 * NIN;
    const float* w_gate = a.in[24] + (size_t)l * 4 * 1024 * 1024;
    const float* w_br = a.in[26] + (size_t)l * 4 * 256 * 1024;
    const float* w_out = a.in[27] + (size_t)l * 1024 * 1024;
    bf16* Wt_in = (bf16*)(a.ws + WS_WIN); bf16* Wt_br = (bf16*)(a.ws + WS_WBR); bf16* Wt_out = (bf16*)(a.ws + WS_WOUT);
    constexpr int I_IN = 16 * 77, I_G = 4 * 16 * 32, I_B = 4 * 4 * 32, I_O = 16 * 32, NIT = I_IN + I_G + I_B + I_O;
    for (int it = gw; it < NIT; it += NGW) {
        int r = it;
        if (r < I_IN) { const int kb = r / 77, nb = r % 77; transpose_item(w_in, NIN, NIN, Wt_in, 1024, kb * 64, nb * 32, nb * 32, scr, lane); continue; } r -= I_IN;
        if (r < I_G) { const int br = r / 512, q = r % 512, kb = q / 32, nb = q % 32; transpose_item(w_gate + (size_t)br * 1024 * 1024, 1024, 1024, Wt_in, 1024, kb * 64, nb * 32, 2560 + br * 1024 + nb * 32, scr, lane); continue; } r -= I_G;
        if (r < I_B) { const int br = r / 128, q = r % 128, kb = q / 32, nb = q % 32; transpose_item(w_br + (size_t)br * 256 * 1024, 1024, 1024, Wt_br + (size_t)br * 1024 * 256, 256, kb * 64, nb * 32, nb * 32, scr, lane); continue; } r -= I_B;
        { const int kb = r / 32, nb = r % 32; transpose_item(w_out, 1024, 1024, Wt_out, 1024, kb * 64, nb * 32, nb * 32, scr, lane); }
    }
}

DI void router_weights(const KA& a, int l, int gw, int NGW, int lane) {
    bf16* Wr = (bf16*)(a.ws + WS_WR);
    const float* wg = a.in[29] + (size_t)l * 1024 * 4; const float* we = a.in[31] + (size_t)l * 1024 * 32;
    for (int n = gw; n < 36; n += NGW) {
        for (int i = 0; i < 16; ++i) { const int k = lane + 64 * i; const float w = (n < 4) ? wg[k * 4 + n] : we[k * 32 + (n - 4)];
            const unsigned hi = f2bf(w); const float hf = __builtin_bit_cast(float, hi << 16); const unsigned lo = f2bf(w - hf);
            Wr[(size_t)n * 2048 + k] = (bf16)hi; Wr[(size_t)n * 2048 + 1024 + k] = (bf16)hi; Wr[(size_t)(64 + n) * 2048 + k] = (bf16)lo; Wr[(size_t)(64 + n) * 2048 + 1024 + k] = 0; }
    }
}

DI void cmp_weights(const KA& a, int l, LAS unsigned char* lds, int gw, int NGW, int wave, int lane) {
    LAS float* scr = (LAS float*)(lds + wave * 16384);
    bf16* Wc = (bf16*)(a.ws + WS_WCMP); float* pt = (float*)(a.ws + WS_CMPAB + 2 * MiB);
    for (int it = gw; it < 2 * 32 * 2 + 2; it += NGW) {
        if (it < 128) { const int kv = it >> 6, q = it & 63, kb = q >> 1, nb = q & 1; const float* w1 = a.in[kv ? 22 : 19] + (size_t)l * 2048 * 64;
            bf16* dst = Wc + (size_t)kv * 256 * 1024 - (kb >= 16 ? 1024 : 0);
            transpose_item(w1, 64, 64, dst, 1024, kb * 64, nb * 32, (kb >= 16 ? 64 : 0) + nb * 32, scr, lane);
        } else { const int kv = it - 128; const float* w1 = a.in[kv ? 22 : 19] + (size_t)l * 2048 * 64; const float* pos = a.in[kv ? 21 : 18] + (size_t)l * 2048;
            float acc = 0.f;
            for (int k = 0; k < 2048; ++k) acc += pos[k] * w1[(size_t)k * 64 + lane];
            pt[kv * 64 + lane] = acc; }
    }
}

DI void lru_weights(const KA& a, int l, int gw, int NGW, int lane) {
    bf16* W = (bf16*)(a.ws + WS_LRUW); const float* wa = a.in[7] + (size_t)l * 4 * 4096; const float* wx = a.in[9] + (size_t)l * 4 * 4096;
    (void)NGW; { const int idx = gw * 64 + lane; if (idx < 32768) { const int i = idx & 63, j = (idx >> 6) & 63, mat = (idx >> 12) & 1, hbk = idx >> 13;
        W[idx] = (bf16)f2bf((mat ? wx : wa)[(size_t)hbk * 4096 + i * 64 + j]); } }
}
DI void phase0_rows(const KA& a, int l, int mode, int gw, int NGW, int lane) {
    const GAS float* xin = (const GAS float*)((l == 0) ? a.in[0] : a.out);
    const GAS bf16* eo = (const GAS bf16*)(a.ws + WS_PROJ);
    GAS bf16* hb = (GAS bf16*)(a.ws + WS_HB); GAS float* outp = (GAS float*)a.out;
    const GAS float* g = (const GAS float*)(mode ? a.in[2] : (a.in[3] + (size_t)l * 1024));
    f32x4 gv[4];
#pragma unroll
    for (int j = 0; j < 4; ++j) gv[j] = *(const GAS f32x4*)(g + 4 * (lane + 64 * j));
    for (int m0 = gw * 4; m0 < T; m0 += NGW * 4) {
        f32x4 v[4][4]; float ss[4];
#pragma unroll
        for (int rr = 0; rr < 4; ++rr)
#pragma unroll
            for (int j = 0; j < 4; ++j) v[rr][j] = *(const GAS f32x4*)(xin + (size_t)(m0 + rr) * 1024 + 4 * (lane + 64 * j));
        if (l > 0) {
#pragma unroll
            for (int rr = 0; rr < 4; ++rr)
#pragma unroll
                for (int j = 0; j < 4; ++j) {
                    const u32x2 e0 = *(const GAS u32x2*)(eo + (size_t)(2 * (m0 + rr)) * 1024 + 4 * (lane + 64 * j));
                    const u32x2 e1 = *(const GAS u32x2*)(eo + (size_t)(2 * (m0 + rr) + 1) * 1024 + 4 * (lane + 64 * j));
                    v[rr][j][0] += lo_bf(e0.x) + lo_bf(e1.x); v[rr][j][1] += hi_bf(e0.x) + hi_bf(e1.x); v[rr][j][2] += lo_bf(e0.y) + lo_bf(e1.y); v[rr][j][3] += hi_bf(e0.y) + hi_bf(e1.y); } }
#pragma unroll
        for (int rr = 0; rr < 4; ++rr) { float t = 0.f;
#pragma unroll
            for (int j = 0; j < 4; ++j) t += (v[rr][j][0] * v[rr][j][0] + v[rr][j][1] * v[rr][j][1]) + (v[rr][j][2] * v[rr][j][2] + v[rr][j][3] * v[rr][j][3]);
            ss[rr] = t; }
#pragma unroll
        for (int rr = 0; rr < 4; ++rr) ss[rr] = wave_sum(ss[rr]);
#pragma unroll
        for (int rr = 0; rr < 4; ++rr) { const float r = 1.f / sqrtf(ss[rr] * (1.f / 1024.f) + 1e-6f); const size_t m = (size_t)(m0 + rr);
#pragma unroll
            for (int j = 0; j < 4; ++j) { const f32x4 y = v[rr][j] * r * gv[j];
                if (mode) *(GAS f32x4*)(outp + m * 1024 + 4 * (lane + 64 * j)) = y;
                else { if (l > 0) *(GAS f32x4*)(outp + m * 1024 + 4 * (lane + 64 * j)) = v[rr][j];
                       u32x2 w; w.x = pk2(y[0], y[1]); w.y = pk2(y[2], y[3]); *(GAS u32x2*)(hb + m * 1024 + 4 * (lane + 64 * j)) = w; } } }
    }
}

DI int crow(int i, int hh) { return (i & 3) + 8 * (i >> 2) + 4 * hh; }
DI unsigned cvtpk(float lo, float hi) { f32x2 v = {lo, hi}; bf16x2_t b = __builtin_convertvector(v, bf16x2_t); return __builtin_bit_cast(unsigned, b); }
template <int CTRL, int RMASK> DI float dppf(float oldv, float v) { return __builtin_bit_cast(float, __builtin_amdgcn_update_dpp(__builtin_bit_cast(int, oldv), __builtin_bit_cast(int, v), CTRL, RMASK, 0xf, false)); }
template <int CTRL, int RMASK> DI void scan_step(float& a, float& b) {
    const float ap = dppf<CTRL, RMASK>(1.f, a), bp = dppf<CTRL, RMASK>(0.f, b); b = a * bp + b; a = a * ap; }
DI void lru_unit(const KA& a, int l, const GAS bf16* proj, GAS bf16* ys, GAS float* sums, LAS unsigned char* lds, int task, int lane_in, int wave_in, bool final) {
    int lane = lane_in, wave = wave_in; asm volatile("" : "+v"(lane), "+s"(wave));
    const int chunk = task & 31, hbk = (task >> 5) & 3, b = task >> 7;
    const int ts = chunk * 256 + wave * 32; const size_t rowb = (size_t)b * SEQ;
    LAS unsigned char* wl = lds + wave * 16384;
    LAS float* ex = (LAS float*)(lds + LRUEX_OFF); LAS float* cst = (LAS float*)(lds + LRUCST_OFF); LAS float* car = (LAS float*)(lds + LRUCAR_OFF) + wave * 64;
    {
        const int c = hbk * 64 + lane;
        const GAS float* cw = (const GAS float*)(a.in[5] + (size_t)l * 4 * 256);
        const float cw0 = cw[c], cw1 = cw[256 + c], cw2 = cw[512 + c], cw3 = cw[768 + c]; const float cb = a.in[6][l * 256 + c];
        if (wave == 0) { cst[lane] = a.in[8][l * 256 + c]; cst[64 + lane] = a.in[10][l * 256 + c]; cst[128 + lane] = -8.f * softplusf_(-a.in[11][l * 256 + c]); }
        const GAS bf16* xp = proj + (rowb + ts) * PLD + C_AX + c;
        float x3 = (ts >= 3) ? bf2f(*(xp - 3 * PLD)) : 0.f, x2 = (ts >= 2) ? bf2f(*(xp - 2 * PLD)) : 0.f, x1 = (ts >= 1) ? bf2f(*(xp - PLD)) : 0.f;
#pragma unroll 8
        for (int n = 0; n < 32; ++n) { const float x0 = bf2f(xp[(size_t)n * PLD]); const float xc = cb + cw0 * x3 + cw1 * x2 + cw2 * x1 + cw3 * x0;
            *(LAS bf16*)(wl + n * 144 + lane * 2) = (bf16)f2bf(xc); *(LAS float*)(wl + 4608 + n * 272 + lane * 4) = xc; x3 = x2; x2 = x1; x1 = x0; }
    }
    const int n = lane & 31, hh = lane >> 5;
    f32x16 D[4];
    {
        const GAS bf16* wt = (const GAS bf16*)(a.ws + WS_LRUW) + (size_t)hbk * 8192;
        bf16x8 bfr[4];
        LDS_WAIT();
#pragma unroll
        for (int s4 = 0; s4 < 4; ++s4) bfr[s4] = *(const LAS bf16x8*)(wl + n * 144 + hh * 16 + s4 * 32);
#pragma unroll
        for (int m = 0; m < 4; ++m) {
#pragma unroll
            for (int s4 = 0; s4 < 4; ++s4) { const bf16x8 af = *(const GAS bf16x8*)(wt + (size_t)(m >> 1) * 4096 + (32 * (m & 1) + n) * 64 + 8 * hh + 16 * s4);
                if (s4 == 0) { f32x16 z;
#pragma unroll
                    for (int i = 0; i < 16; ++i) z[i] = 0.f;
                    D[m] = MFMA32(af, bfr[s4], z); } else D[m] = MFMA32(af, bfr[s4], D[m]); } }
    }
    __syncthreads();
    const bool t0 = (ts + n) == 0;
#pragma unroll
    for (int mm = 0; mm < 2; ++mm)
#pragma unroll
        for (int g4 = 0; g4 < 4; ++g4) { const int c0 = 32 * mm + 8 * g4 + 4 * hh;
            const f32x4 vba = *(const LAS f32x4*)(cst + c0), vbx = *(const LAS f32x4*)(cst + 64 + c0), vc8 = *(const LAS f32x4*)(cst + 128 + c0);
            const f32x4 vxc = *(const LAS f32x4*)(wl + 4608 + n * 272 + c0 * 4);
#pragma unroll
            for (int e = 0; e < 4; ++e) { const int i = 4 * g4 + e;
                const float r = sigmoidf_(D[mm][i] + vba[e]), ig = sigmoidf_(D[2 + mm][i] + vbx[e]);
                const float la = vc8[e] * r; const float av = __expf(la);
                const float mult = t0 ? 1.f : sqrtf(fmaxf(1.f - __expf(2.f * la), 0.f));
                float aa = av, bb = mult * ig * vxc[e];
                scan_step<0x111, 0xf>(aa, bb); scan_step<0x112, 0xf>(aa, bb); scan_step<0x114, 0xf>(aa, bb); scan_step<0x118, 0xf>(aa, bb); scan_step<0x142, 0xa>(aa, bb);
                D[mm][i] = aa; D[2 + mm][i] = bb; } }
    if (n == 31) {
#pragma unroll
        for (int mm = 0; mm < 2; ++mm)
#pragma unroll
            for (int i = 0; i < 16; ++i) { const int c = 32 * mm + crow(i, hh); ex[(wave * 64 + c) * 2] = D[mm][i]; ex[(wave * 64 + c) * 2 + 1] = D[2 + mm][i]; } }
    __syncthreads();
    if (!final) {
        if (wave == 0) { float hv = 0.f, av = 1.f;
#pragma unroll
            for (int w = 0; w < 8; ++w) { const float A_ = ex[(w * 64 + lane) * 2], H_ = ex[(w * 64 + lane) * 2 + 1]; hv = A_ * hv + H_; av *= A_; }
            GAS float* sp = sums + ((size_t)((b * 4 + hbk) * 32 + chunk) * 64 + lane) * 2; sp[0] = av; sp[1] = hv; }
    } else {
        {   float hv = 0.f;
            for (int cc = 0; cc < chunk; ++cc) { const GAS float* sp = sums + ((size_t)((b * 4 + hbk) * 32 + cc) * 64 + lane) * 2; hv = sp[0] * hv + sp[1]; }
            for (int w = 0; w < wave; ++w) { const float A_ = ex[(w * 64 + lane) * 2], H_ = ex[(w * 64 + lane) * 2 + 1]; hv = A_ * hv + H_; }
            car[lane] = hv; }
        LDS_WAIT(); asm volatile("" ::: "memory");
        const GAS bf16* gp = proj + (rowb + ts + n) * PLD + C_AG + hbk * 64; GAS bf16* yp = ys + (rowb + ts + n) * 1024 + hbk * 64;
#pragma unroll
        for (int mm = 0; mm < 2; ++mm)
#pragma unroll
            for (int g4 = 0; g4 < 4; ++g4) { const int c0 = 32 * mm + 8 * g4 + 4 * hh; const f32x4 cv = *(const LAS f32x4*)(car + c0);
                float y[4];
#pragma unroll
                for (int e = 0; e < 4; ++e) { const int i = 4 * g4 + e; const float hv = D[2 + mm][i] + D[mm][i] * cv[e];
                    const float gt = bf2f(gp[c0 + e]); y[e] = hv * gelu_tanh(gt); }
#pragma unroll
                for (int e = 0; e < 4; ++e) yp[c0 + e] = (bf16)f2bf(y[e]); }
    }
    __syncthreads();
}

constexpr int DK_STR = 144, DV_STR = 192, DBUF_BYTES = 64 * DK_STR + 64 * DV_STR;
DI bf16x8 pack_half(const f32x16& x, int s2) { u32x4 p;
    if (s2 == 0) { p.x = cvtpk(x[0], x[1]); p.y = cvtpk(x[2], x[3]); p.z = cvtpk(x[4], x[5]); p.w = cvtpk(x[6], x[7]); }
    else { p.x = cvtpk(x[8], x[9]); p.y = cvtpk(x[10], x[11]); p.z = cvtpk(x[12], x[13]); p.w = cvtpk(x[14], x[15]); }
    return __builtin_bit_cast(bf16x8, p); }
DI s16x4 vtr(const LAS unsigned char* p) { return __builtin_bit_cast(s16x4, __builtin_amdgcn_ds_read_tr16_b64_v4i16((LAS v4i16_t*)p)); }
DI float max16(const f32x16& x) { float a = fmaxf(fmaxf(x[0], x[1]), fmaxf(x[2], x[3])), b = fmaxf(fmaxf(x[4], x[5]), fmaxf(x[6], x[7])), c = fmaxf(fmaxf(x[8], x[9]), fmaxf(x[10], x[11])), d = fmaxf(fmaxf(x[12], x[13]), fmaxf(x[14], x[15])); return fmaxf(fmaxf(a, b), fmaxf(c, d)); }
DI void diff_unit(const GAS bf16* proj, GAS bf16* ys, LAS unsigned char* lds, const LAS float* bias2, const GAS float* subg, float lam, float lam_init, int b, int h, int qb, int tid_in, int lane_in, int wave_in) {
    int tid = tid_in, lane = lane_in, wave = wave_in; asm volatile("" : "+v"(tid), "+v"(lane), "+s"(wave));
    const int q0 = qb * 256 + wave * 32; const int ql = lane & 31, hh = lane >> 5; const int q = q0 + ql;
    const size_t rowb = (size_t)b * SEQ;
    const float SC = 0.17677669529663687f * 1.4426950408889634f;
    bf16x8 qf[2][2];
    { const GAS bf16* qp = proj + (rowb + q) * PLD + C_CQ + h * 64 + hh * 8;
#pragma unroll
      for (int m = 0; m < 2; ++m)
#pragma unroll
        for (int s = 0; s < 2; ++s) { const u32x4 w = *(const GAS u32x4*)(qp + m * 32 + s * 16); u32x4 o;
            o.x = cvtpk(lo_bf(w.x) * SC, hi_bf(w.x) * SC); o.y = cvtpk(lo_bf(w.y) * SC, hi_bf(w.y) * SC); o.z = cvtpk(lo_bf(w.z) * SC, hi_bf(w.z) * SC); o.w = cvtpk(lo_bf(w.w) * SC, hi_bf(w.w) * SC);
            qf[m][s] = __builtin_bit_cast(bf16x8, o); } }
    f32x16 O[2][2], negm[2];
#pragma unroll
    for (int i = 0; i < 16; ++i) { O[0][0][i] = 0.f; O[0][1][i] = 0.f; O[1][0][i] = 0.f; O[1][1][i] = 0.f; negm[0][i] = 0.f; negm[1][i] = 0.f; }
    float lsum[2] = {0.f, 0.f};
    const int nsteps = 4 * qb + 4, mysteps = 4 * qb + (wave >> 1) + 1;
    const int skey = tid >> 3, sch = tid & 7;
    const GAS unsigned char* kgb = (const GAS unsigned char*)(proj + rowb * PLD + C_CK + h * 64);
    const GAS unsigned char* vgb = (const GAS unsigned char*)(proj + rowb * PLD + C_CV + h * 64);
    const unsigned soff = (unsigned)(skey * PLD + sch * 8) * 2u;
    u32x4 kr = *(const GAS u32x4*)(kgb + soff), vr = *(const GAS u32x4*)(vgb + soff);
    *(LAS u32x4*)(lds + skey * DK_STR + sch * 16) = kr; *(LAS u32x4*)(lds + 64 * DK_STR + skey * DV_STR + sch * 16) = vr;
    __syncthreads();
    const int i16 = lane & 15, blk = (lane >> 4) & 1;
    const int kboff = ql * DK_STR + hh * 16;
    const int vboff = 64 * DK_STR + (4 * hh + (i16 >> 2)) * DV_STR + (16 * blk + 4 * (i16 & 3)) * 2;
#pragma unroll 1
    for (int kt = 0; kt < nsteps; ++kt) {
        const LAS unsigned char* cur = lds + (kt & 1) * DBUF_BYTES; LAS unsigned char* nxt = lds + ((kt + 1) & 1) * DBUF_BYTES;
        if (kt + 1 < nsteps) { const unsigned so = soff + (unsigned)(kt + 1) * (64u * PLD * 2u); kr = *(const GAS u32x4*)(kgb + so); vr = *(const GAS u32x4*)(vgb + so); }
        if (kt < mysteps) {
            const int kbase = kt * 64;
            const bool near = (q0 - (kbase + 63) < 113);
#pragma unroll
            for (int m = 0; m < 2; ++m) {
                bf16x8 pk[2][2];
                f32x16 S[2];
                {   bf16x8 kf[2][2];
#pragma unroll
                    for (int t = 0; t < 2; ++t)
#pragma unroll
                        for (int s = 0; s < 2; ++s) kf[t][s] = *(const LAS bf16x8*)(cur + kboff + t * 32 * DK_STR + m * 64 + s * 32);
#pragma unroll
                    for (int t = 0; t < 2; ++t) { S[t] = MFMA32(kf[t][0], qf[m][0], negm[m]); S[t] = MFMA32(kf[t][1], qf[m][1], S[t]); } }
                if (near) {
#pragma unroll
                    for (int t = 0; t < 2; ++t)
#pragma unroll
                        for (int i = 0; i < 16; ++i) { const int dist = q - (kbase + 32 * t + crow(i, hh)); const int di = dist < 128 ? dist : 128;
                            const float bv = dist >= 0 ? bias2[di * 12 + 4 + h] : -1e30f; S[t][i] += bv; } }
                float tm = fmaxf(max16(S[0]), max16(S[1]));
                const bool need = (tm > 8.f) || (kt == 0);
                if (__builtin_amdgcn_ballot_w64(need) != 0ull) {
                    tm = fmaxf(tm, xshfl<32>(tm));
                    const float sh = (kt == 0) ? tm : fmaxf(tm, 0.f);
                    const float al = __builtin_amdgcn_exp2f(-sh);
                    lsum[m] *= al;
#pragma unroll
                    for (int i = 0; i < 16; ++i) { O[m][0][i] *= al; O[m][1][i] *= al; negm[m][i] -= sh; S[0][i] -= sh; S[1][i] -= sh; }
                }
#pragma unroll
                for (int t = 0; t < 2; ++t) {
#pragma unroll
                    for (int i = 0; i < 16; ++i) { const float p = __builtin_amdgcn_exp2f(S[t][i]); S[t][i] = p; lsum[m] += p; }
                    pk[t][0] = pack_half(S[t], 0); pk[t][1] = pack_half(S[t], 1); }
#pragma unroll
                for (int t = 0; t < 2; ++t)
#pragma unroll
                    for (int s2 = 0; s2 < 2; ++s2)
#pragma unroll
                        for (int db = 0; db < 2; ++db) {
                            const s16x4 lo = vtr(cur + vboff + (32 * t + 16 * s2) * DV_STR + db * 64), hi = vtr(cur + vboff + (32 * t + 16 * s2 + 8) * DV_STR + db * 64);
                            const bf16x8 vf = __builtin_shufflevector(lo, hi, 0, 1, 2, 3, 4, 5, 6, 7);
                            O[m][db] = MFMA32(vf, pk[t][s2], O[m][db]); }
                ;
            }
        }
        if (kt + 1 < nsteps) { *(LAS u32x4*)(nxt + skey * DK_STR + sch * 16) = kr; *(LAS u32x4*)(nxt + 64 * DK_STR + skey * DV_STR + sch * 16) = vr; }
        __syncthreads();
    }
    const float l0 = lsum[0] + xshfl<32>(lsum[0]), l1 = lsum[1] + xshfl<32>(lsum[1]);
    const float i0 = 1.f / fmaxf(l0, 1e-30f), i1 = lam / fmaxf(l1, 1e-30f);
    float ss = 0.f;
#pragma unroll
    for (int db = 0; db < 2; ++db)
#pragma unroll
        for (int i = 0; i < 16; ++i) { const float at = O[0][db][i] * i0 - O[1][db][i] * i1; O[0][db][i] = at; ss += at * at; }
    ss += xshfl<32>(ss);
    const float r = (1.f - lam_init) / sqrtf(ss * (1.f / 64.f) + 1e-5f);
    GAS bf16* op = ys + (rowb + q) * 1024 + 512 + h * 64;
#pragma unroll
    for (int db = 0; db < 2; ++db)
#pragma unroll
        for (int gq = 0; gq < 4; ++gq) { const int d0 = 32 * db + 8 * gq + 4 * hh; const f32x4 sg = *(const GAS f32x4*)(subg + d0);
            u32x2 w; w.x = cvtpk(O[0][db][4 * gq + 0] * r * sg[0], O[0][db][4 * gq + 1] * r * sg[1]); w.y = cvtpk(O[0][db][4 * gq + 2] * r * sg[2], O[0][db][4 * gq + 3] * r * sg[3]);
            *(GAS u32x2*)(op + d0) = w; }
}

struct SchedCmp { const char* proj; const char* wc; int G, c;
    DI bool next(int i, Unit& u) const { const int L = i * G + c; if (L >= 16) return false; const int kv = L >> 3, rt = L & 7;
        u.pm = rt; u.pn = 0; u.aux = kv; u.pad = 0; u.a = proj + ((size_t)rt * 256 * 16 * PLD + (kv ? C_VC : C_KC)) * 2; u.b = wc + (size_t)kv * 256 * 1024 * 2; return true; } };
struct EpiCmp { float* ab;
    DI void operator()(const f32x4 (&acc)[2][2][4][2], const Unit& u, int wr, int wc, int fr, int fq) const {
        const int row0 = u.pm * 256 + wr * 64 + fr; const int col = wc * 32 + 8 * fq;
#pragma unroll
        for (int ai = 0; ai < 2; ++ai)
#pragma unroll
            for (int m = 0; m < 4; ++m) { float* rp = ab + ((size_t)u.aux * 2048 + row0 + ai * 128 + m * 16) * 128 + col; *(f32x4*)rp = acc[ai][0][m][0]; *(f32x4*)(rp + 4) = acc[ai][0][m][1]; }
    }
};
DI void cmp_finish(const KA& a, int l, const float* ab, bf16* kcb, int task, int lane) {
    const int kv = task / (BATCH * NCMP), r = task % (BATCH * NCMP), b = r / NCMP, c = r % NCMP;
    const float* w2 = a.in[kv ? 23 : 20] + (size_t)l * 4096; const float* pt = ab + 2 * 2048 * 128;
    const size_t g = (size_t)kv * 2048 + b * 512 + c;
    const float h1 = ab[g * 128 + lane] + ab[(g + 1) * 128 + 64 + lane] + pt[kv * 64 + lane];
    const float gl = gelu_tanh(h1); float o = 0.f;
#pragma unroll
    for (int j = 0; j < 64; ++j) o += rl(gl, j) * w2[j * 64 + lane];
    kcb[((size_t)(kv * BATCH + b) * 512 + c) * 64 + lane] = (bf16)f2bf(o);
    if (c == NCMP - 1) kcb[((size_t)(kv * BATCH + b) * 512 + NCMP) * 64 + lane] = 0;
}

DI void st_load(const GAS unsigned char* kb, const GAS unsigned char* vb, unsigned off, u32x4& kr, u32x4& vr) { kr = *(const GAS u32x4*)(kb + off); vr = *(const GAS u32x4*)(vb + off); }
DI void st_write(LAS unsigned char* buf, int skey, int sch, const u32x4& kr, const u32x4& vr) { *(LAS u32x4*)(buf + skey * DK_STR + sch * 16) = kr; *(LAS u32x4*)(buf + 64 * DK_STR + skey * DV_STR + sch * 16) = vr; }
DI void qk64(const LAS unsigned char* cur, int kboff, const bf16x8 (&qf)[4], const f32x16& cinit, f32x16 (&S)[2]) {
#pragma unroll
    for (int t = 0; t < 2; ++t) { S[t] = cinit;
#pragma unroll
        for (int s = 0; s < 4; ++s) { const bf16x8 kf = *(const LAS bf16x8*)(cur + kboff + t * 32 * DK_STR + s * 32); S[t] = MFMA32(kf, qf[s], S[t]); } }
}
DI void qk32z(const LAS unsigned char* kt32, const bf16x8 (&qf)[4], f32x16& S) {
#pragma unroll
    for (int s = 0; s < 4; ++s) { const bf16x8 kf = *(const LAS bf16x8*)(kt32 + s * 32);
        if (s == 0) { f32x16 z;
#pragma unroll
            for (int i = 0; i < 16; ++i) z[i] = 0.f;
            S = MFMA32(kf, qf[s], z); } else S = MFMA32(kf, qf[s], S); }
}
DI void pv32(const LAS unsigned char* vt32, const bf16x8 (&pk)[2], f32x16 (&O)[2]) {
#pragma unroll
    for (int s2 = 0; s2 < 2; ++s2)
#pragma unroll
        for (int db = 0; db < 2; ++db) {
            const s16x4 lo = vtr(vt32 + (16 * s2) * DV_STR + db * 64), hi = vtr(vt32 + (16 * s2 + 8) * DV_STR + db * 64);
            const bf16x8 vf = __builtin_shufflevector(lo, hi, 0, 1, 2, 3, 4, 5, 6, 7);
            O[db] = MFMA32(vf, pk[s2], O[db]); }
}
DI void mask_bias_cmp32(f32x16& S, int tcol, int cbase, int hh, const LAS float* b2h, float msub) {
#pragma unroll
    for (int i = 0; i < 16; ++i) { const int c = cbase + crow(i, hh); const int dist = tcol - 31 - 16 * c; const bool ok = dist >= 0 && c < NCMP;
        const int di = dist < 0 ? 0 : (dist < 128 ? dist : 128); S[i] = ok ? S[i] + (b2h[di * 12] - msub) : -1e30f; }
}
DI void pv64(const LAS unsigned char* cur, int vboff, const bf16x8 (&pk)[2][2], f32x16 (&O)[2]) {
#pragma unroll
    for (int t = 0; t < 2; ++t)
#pragma unroll
        for (int s2 = 0; s2 < 2; ++s2)
#pragma unroll
            for (int db = 0; db < 2; ++db) {
                const s16x4 lo = vtr(cur + vboff + (32 * t + 16 * s2) * DV_STR + db * 64), hi = vtr(cur + vboff + (32 * t + 16 * s2 + 8) * DV_STR + db * 64);
                const bf16x8 vf = __builtin_shufflevector(lo, hi, 0, 1, 2, 3, 4, 5, 6, 7);
                O[db] = MFMA32(vf, pk[t][s2], O[db]); }
}
DI void softmax_step(f32x16 (&S)[2], f32x16 (&O)[2], f32x16& negm, float& lsum, bf16x8 (&pk)[2][2]) {
    float tm = fmaxf(max16(S[0]), max16(S[1]));
    if (__builtin_amdgcn_ballot_w64(tm > 8.f) != 0ull) {
        tm = fmaxf(tm, xshfl<32>(tm)); const float sh = fmaxf(tm, 0.f); const float al = __builtin_amdgcn_exp2f(-sh);
        lsum *= al;
#pragma unroll
        for (int i = 0; i < 16; ++i) { O[0][i] *= al; O[1][i] *= al; negm[i] -= sh; S[0][i] -= sh; S[1][i] -= sh; } }
#pragma unroll
    for (int t = 0; t < 2; ++t) {
#pragma unroll
        for (int i = 0; i < 16; ++i) { const float p = __builtin_amdgcn_exp2f(S[t][i]); S[t][i] = p; lsum += p; }
        pk[t][0] = pack_half(S[t], 0); pk[t][1] = pack_half(S[t], 1); }
}
DI void mask_bias(f32x16 (&S)[2], int tcol, int kbase, int hh, int W, bool colsel, const LAS float* b2h) {
#pragma unroll
    for (int t = 0; t < 2; ++t)
#pragma unroll
        for (int i = 0; i < 16; ++i) { const int dist = tcol - (kbase + 32 * t + crow(i, hh)); const bool ok = colsel && dist >= 0 && dist < W;
            const int di = dist < 0 ? 0 : (dist < 128 ? dist : 128); S[t][i] = ok ? S[t][i] + b2h[di * 12] : -1e30f; }
}
DI void nsa_unit(const GAS bf16* proj, GAS bf16* ys, const GAS bf16* kcb, LAS unsigned char* lds, const LAS float* bias2, int b, int u, int tid_in, int lane_in, int wave_in) {
    int tid = tid_in, lane = lane_in, wave = wave_in; asm volatile("" : "+v"(tid), "+v"(lane), "+s"(wave));
    const int t0 = u * 64; const int col = lane & 31, hh = lane >> 5, tl = col >> 2, head = col & 3;
    const int t = t0 + wave * 8 + tl; const int tw0 = t0 + wave * 8;
    const size_t rowb = (size_t)b * SEQ;
    const LAS float* b2h = bias2 + 8 + head;
    bf16x8 qf[4];
    { const float SC = 0.125f * 1.4426950408889634f; const GAS bf16* qp = proj + (rowb + t) * PLD + C_DQ + head * 64 + hh * 8;
#pragma unroll
      for (int s = 0; s < 4; ++s) { const u32x4 w = *(const GAS u32x4*)(qp + s * 16); u32x4 o;
          o.x = cvtpk(lo_bf(w.x) * SC, hi_bf(w.x) * SC); o.y = cvtpk(lo_bf(w.y) * SC, hi_bf(w.y) * SC); o.z = cvtpk(lo_bf(w.z) * SC, hi_bf(w.z) * SC); o.w = cvtpk(lo_bf(w.w) * SC, hi_bf(w.w) * SC);
          qf[s] = __builtin_bit_cast(bf16x8, o); } }
    const int skey = tid >> 3, sch = tid & 7;
    const int i16 = lane & 15, blk = (lane >> 4) & 1;
    const int kboff = col * DK_STR + hh * 16;
    const int vboff = 64 * DK_STR + (4 * hh + (i16 >> 2)) * DV_STR + (16 * blk + 4 * (i16 & 3)) * 2;
    u32x4 kr, vr;
    const int ncvm = (4 * u + 3) < NCMP ? (4 * u + 3) : NCMP;
    const int nsc = (ncvm + 63) >> 6;
    const GAS unsigned char* kcp = (const GAS unsigned char*)(kcb + (size_t)(0 * BATCH + b) * 512 * 64);
    const GAS unsigned char* vcp = (const GAS unsigned char*)(kcb + (size_t)(1 * BATCH + b) * 512 * 64);
    const unsigned soffc = (unsigned)(skey * 64 + sch * 8) * 2u;
    float m1 = -120.f, l1 = 0.f;
    st_load(kcp, vcp, soffc, kr, vr); st_write(lds, skey, sch, kr, vr); __syncthreads();
#pragma unroll 1
    for (int kt = 0; kt < nsc; ++kt) {
        const LAS unsigned char* cur = lds + (kt & 1) * DBUF_BYTES; LAS unsigned char* nxt = lds + ((kt + 1) & 1) * DBUF_BYTES;
        if (kt + 1 < nsc) st_load(kcp, vcp, soffc + (unsigned)(kt + 1) * 8192u, kr, vr);
#pragma unroll
        for (int tt = 0; tt < 2; ++tt) { f32x16 S; qk32z(cur + kboff + tt * 32 * DK_STR, qf, S); mask_bias_cmp32(S, t, kt * 64 + tt * 32, hh, b2h, 0.f);
          const float tm = max16(S); const float mn = fmaxf(m1, tm); float acc = 0.f;
#pragma unroll
          for (int i = 0; i < 16; ++i) acc += __builtin_amdgcn_exp2f(S[i] - mn);
          l1 = l1 * __builtin_amdgcn_exp2f(m1 - mn) + acc; m1 = mn; }
        if (kt + 1 < nsc) st_write(nxt, skey, sch, kr, vr);
        __syncthreads();
    }
    float mf, inv;
    { const float mo = xshfl<32>(m1), lo = xshfl<32>(l1); mf = fmaxf(m1, mo); const float lf = l1 * __builtin_amdgcn_exp2f(m1 - mf) + lo * __builtin_amdgcn_exp2f(mo - mf); inv = lf > 0.f ? 1.f / lf : 0.f; }
    f32x16 Oc[2], imp[4];
#pragma unroll
    for (int i = 0; i < 16; ++i) { Oc[0][i] = 0.f; Oc[1][i] = 0.f; imp[0][i] = 0.f; imp[1][i] = 0.f; imp[2][i] = 0.f; imp[3][i] = 0.f; }
    {   st_load(kcp, vcp, soffc, kr, vr); st_write(lds, skey, sch, kr, vr); __syncthreads();
#pragma unroll 1
        for (int kt = 0; kt < nsc; ++kt) {
            const LAS unsigned char* cur = lds + (kt & 1) * DBUF_BYTES; LAS unsigned char* nxt = lds + ((kt + 1) & 1) * DBUF_BYTES;
            if (kt + 1 < nsc) st_load(kcp, vcp, soffc + (unsigned)(kt + 1) * 8192u, kr, vr);
#pragma unroll
            for (int tt = 0; tt < 2; ++tt) {
                f32x16 S; qk32z(cur + kboff + tt * 32 * DK_STR, qf, S); mask_bias_cmp32(S, t, kt * 64 + tt * 32, hh, b2h, mf);
#pragma unroll
                for (int i = 0; i < 16; ++i) S[i] = __builtin_amdgcn_exp2f(S[i]) * inv;
                bf16x8 pk[2]; pk[0] = pack_half(S, 0); pk[1] = pack_half(S, 1);
                pv32(cur + vboff + tt * 32 * DV_STR, pk, Oc);
                const int Tq = (2 * kt + tt) & 3, MB = (2 * kt + tt) >> 2;
#pragma unroll
                for (int s2 = 0; s2 < 2; ++s2) { u32x4 aw; unsigned e[8];
#pragma unroll
                    for (int jj = 0; jj < 8; ++jj) { const int kk = 16 * s2 + 8 * (jj >> 2) + 4 * hh + (jj & 3); const int delta = 32 * Tq + kk - 4 * col;
                        e[jj] = (delta == -1 || delta == 3) ? 0x3F80u : ((unsigned)delta <= 2u ? 0x4000u : 0u); }
                    aw.x = e[0] | (e[1] << 16); aw.y = e[2] | (e[3] << 16); aw.z = e[4] | (e[5] << 16); aw.w = e[6] | (e[7] << 16);
                    const bf16x8 af = __builtin_bit_cast(bf16x8, aw);
                    if (MB == 0) imp[0] = MFMA32(af, pk[s2], imp[0]); else if (MB == 1) imp[1] = MFMA32(af, pk[s2], imp[1]); else if (MB == 2) imp[2] = MFMA32(af, pk[s2], imp[2]); else imp[3] = MFMA32(af, pk[s2], imp[3]); }
                if (Tq == 3 && MB < 3) { u32x4 aw; aw.x = 0u; aw.y = 0u; aw.z = 0u; aw.w = (lane == 32) ? 0x3F800000u : 0u;
                    const bf16x8 af = __builtin_bit_cast(bf16x8, aw);
                    if (MB == 0) imp[1] = MFMA32(af, pk[1], imp[1]); else if (MB == 1) imp[2] = MFMA32(af, pk[1], imp[2]); else imp[3] = MFMA32(af, pk[1], imp[3]); }
            }
            if (kt + 1 < nsc) st_write(nxt, skey, sch, kr, vr);
            __syncthreads();
        }
    }
    unsigned ocp[2][8];
#pragma unroll
    for (int db = 0; db < 2; ++db)
#pragma unroll
        for (int i = 0; i < 8; ++i) ocp[db][i] = cvtpk(Oc[db][2 * i], Oc[db][2 * i + 1]);
    unsigned sm0 = 0u, sm1 = 0u, sm2 = 0u, sm3 = 0u;
    {   const int cur_t = t >> 6; unsigned key[16];
#pragma unroll
        for (int i = 0; i < 16; ++i) {
            float v0 = imp[0][i], v1 = imp[1][i], v2 = imp[2][i], v3 = imp[3][i];
            v0 += xshfl<1>(v0); v0 += xshfl<2>(v0); v1 += xshfl<1>(v1); v1 += xshfl<2>(v1); v2 += xshfl<1>(v2); v2 += xshfl<2>(v2); v3 += xshfl<1>(v3); v3 += xshfl<2>(v3);
            const float val = head == 0 ? v0 : (head == 1 ? v1 : (head == 2 ? v2 : v3));
            const int j = 32 * head + crow(i, hh);
            const bool forced = (j == 0) || (j == cur_t) || (j == cur_t - 1);
            unsigned fx = (unsigned)(fminf(fmaxf(val, 0.f), 31.f) * 1048576.f) + 1u;
            fx = forced ? 0x1FFFFFFu : (j <= cur_t ? fx : 0u);
            key[i] = (fx << 7) | (unsigned)(127 - j); }
#pragma unroll 1
        for (int r = 0; r < 16; ++r) {
            unsigned w = key[0];
#pragma unroll
            for (int i = 1; i < 16; ++i) w = w > key[i] ? w : key[i];
            { unsigned o = (unsigned)xshfl_i<1>((int)w); w = w > o ? w : o; o = (unsigned)xshfl_i<2>((int)w); w = w > o ? w : o; o = (unsigned)xshfl_i<32>((int)w); w = w > o ? w : o; }
            if ((w >> 7) != 0u) { const int j = 127 - (int)(w & 127u); const unsigned bit = 1u << (j & 31); const int jb = j >> 5;
                sm0 |= (jb == 0) ? bit : 0u; sm1 |= (jb == 1) ? bit : 0u; sm2 |= (jb == 2) ? bit : 0u; sm3 |= (jb == 3) ? bit : 0u; }
#pragma unroll
            for (int i = 0; i < 16; ++i) key[i] = (key[i] == w) ? 0u : key[i];
        }
    }
    f32x16 Ow[2]; float lw = 0.f;
#pragma unroll
    for (int i = 0; i < 16; ++i) { Ow[0][i] = 0.f; Ow[1][i] = 0.f; }
    {   f32x16 negm;
#pragma unroll
        for (int i = 0; i < 16; ++i) negm[i] = 120.f;
        const GAS unsigned char* kwp = (const GAS unsigned char*)(proj + rowb * PLD + C_KW); const GAS unsigned char* vwp = (const GAS unsigned char*)(proj + rowb * PLD + C_VW);
        const unsigned soffp = (unsigned)(skey * PLD + sch * 8) * 2u;
        const int s0 = (u < 8) ? 8 - u : 0;
        st_load(kwp, vwp, soffp + (unsigned)(u - 8 + s0) * (64u * PLD * 2u), kr, vr); st_write(lds, skey, sch, kr, vr); __syncthreads();
#pragma unroll 1
        for (int s = s0; s < 9; ++s) {
            const int par = (s - s0) & 1; const LAS unsigned char* cur = lds + par * DBUF_BYTES; LAS unsigned char* nxt = lds + (par ^ 1) * DBUF_BYTES;
            if (s + 1 < 9) st_load(kwp, vwp, soffp + (unsigned)(u - 8 + s + 1) * (64u * PLD * 2u), kr, vr);
            {   f32x16 S[2]; qk64(cur, kboff, qf, negm, S);
                if (s == 0 || s >= 6) mask_bias(S, t, (u - 8 + s) * 64, hh, 512, true, b2h);
                bf16x8 pk[2][2]; softmax_step(S, Ow, negm, lw, pk); pv64(cur, vboff, pk, Ow); }
            if (s + 1 < 9) st_write(nxt, skey, sch, kr, vr);
            __syncthreads();
        }
    }
    unsigned owp[2][8];
#pragma unroll
    for (int db = 0; db < 2; ++db)
#pragma unroll
        for (int i = 0; i < 8; ++i) owp[db][i] = cvtpk(Ow[db][2 * i], Ow[db][2 * i + 1]);
    f32x16 Os[2]; float lsel = 0.f;
#pragma unroll
    for (int i = 0; i < 16; ++i) { Os[0][i] = 0.f; Os[1][i] = 0.f; }
    {   f32x16 negm;
#pragma unroll
        for (int i = 0; i < 16; ++i) negm[i] = 120.f;
        const GAS unsigned char* ksp = (const GAS unsigned char*)(proj + rowb * PLD + C_KS); const GAS unsigned char* vsp = (const GAS unsigned char*)(proj + rowb * PLD + C_VS);
        const unsigned soffp = (unsigned)(skey * PLD + sch * 8) * 2u;
        u32x4 kA, vA, kB, vB;
        st_load(ksp, vsp, soffp, kr, vr); st_write(lds, skey, sch, kr, vr);
        if (u >= 1) st_load(ksp, vsp, soffp + 64u * PLD * 2u, kA, vA);
        __syncthreads();
#define SEL_STEP(J, KX, VX, KY, VY) { const int j_ = (J); \
            const LAS unsigned char* cur = lds + (j_ & 1) * DBUF_BYTES; LAS unsigned char* nxt = lds + ((j_ + 1) & 1) * DBUF_BYTES; \
            if (j_ + 2 <= u) st_load(ksp, vsp, soffp + (unsigned)(j_ + 2) * (64u * PLD * 2u), KY, VY); \
            const int jb = j_ >> 5; const unsigned smw = jb == 0 ? sm0 : (jb == 1 ? sm1 : (jb == 2 ? sm2 : sm3)); \
            const bool bit = ((smw >> (j_ & 31)) & 1u) != 0u; \
            if (__builtin_amdgcn_ballot_w64(bit) != 0ull) { \
                f32x16 S[2]; qk64(cur, kboff, qf, negm, S); \
                if (64 * j_ + 63 > tw0 - 113) mask_bias(S, t, 64 * j_, hh, 1 << 30, bit, b2h); \
                else if (!bit) { _Pragma("unroll") for (int i = 0; i < 16; ++i) { S[0][i] = -1e30f; S[1][i] = -1e30f; } } \
                bf16x8 pk[2][2]; softmax_step(S, Os, negm, lsel, pk); pv64(cur, vboff, pk, Os); } \
            if (j_ + 1 <= u) st_write(nxt, skey, sch, KX, VX); \
            __syncthreads(); }
#pragma unroll 1
        for (int j = 0; j <= u; j += 2) {
            SEL_STEP(j, kA, vA, kB, vB)
            if (j + 1 <= u) SEL_STEP(j + 1, kB, vB, kA, vA)
        }
#undef SEL_STEP
    }
    {   const float lwt = lw + xshfl<32>(lw), lst = lsel + xshfl<32>(lsel);
        const GAS bf16* gp = proj + (rowb + t) * PLD + C_DG + head * 3;
        const float g0 = sigmoidf_(bf2f(gp[0])), g1 = sigmoidf_(bf2f(gp[1])) / fmaxf(lst, 1e-30f), g2 = sigmoidf_(bf2f(gp[2])) / fmaxf(lwt, 1e-30f);
        GAS bf16* op = ys + (rowb + t) * 1024 + 768 + head * 64;
#pragma unroll
        for (int db = 0; db < 2; ++db)
#pragma unroll
            for (int gq = 0; gq < 4; ++gq) { const int d0 = 32 * db + 8 * gq + 4 * hh; float y[4];
#pragma unroll
                for (int e = 0; e < 4; ++e) { const unsigned cw = ocp[db][2 * gq + (e >> 1)], ww = owp[db][2 * gq + (e >> 1)];
                    y[e] = g0 * ((e & 1) ? hi_bf(cw) : lo_bf(cw)) + g1 * Os[db][4 * gq + e] + g2 * ((e & 1) ? hi_bf(ww) : lo_bf(ww)); }
                u32x2 w; w.x = cvtpk(y[0], y[1]); w.y = cvtpk(y[2], y[3]); *(GAS u32x2*)(op + d0) = w; }
    }
}


DI void swa_unit(const GAS bf16* proj, GAS bf16* ys, LAS unsigned char* lds, const LAS float* bias2, const LAS float* biasd, const GAS float* sinks, int b, int u, int tid_in, int lane_in, int wave_in) {
    int tid = tid_in, lane = lane_in, wave = wave_in; asm volatile("" : "+v"(tid), "+v"(lane), "+s"(wave));
    const int t0 = u * 64; const int col = lane & 31, hh = lane >> 5, tl = col >> 1, kv = wave & 1, head = 2 * kv + (col & 1);
    const int t = t0 + (wave >> 1) * 16 + tl;
    const size_t rowb = (size_t)b * SEQ;
    const LAS float* b2h = bias2 + head;
    bf16x8 qf[4];
    { const float SC = 0.125f * 1.4426950408889634f; const GAS bf16* qp = proj + (rowb + t) * PLD + C_BQ + head * 64 + hh * 8;
#pragma unroll
      for (int s = 0; s < 4; ++s) { const u32x4 w = *(const GAS u32x4*)(qp + s * 16); u32x4 o;
          o.x = cvtpk(lo_bf(w.x) * SC, hi_bf(w.x) * SC); o.y = cvtpk(lo_bf(w.y) * SC, hi_bf(w.y) * SC); o.z = cvtpk(lo_bf(w.z) * SC, hi_bf(w.z) * SC); o.w = cvtpk(lo_bf(w.w) * SC, hi_bf(w.w) * SC);
          qf[s] = __builtin_bit_cast(bf16x8, o); } }
    const int skey = tid >> 3, sch = tid & 7;
    const int i16 = lane & 15, blk = (lane >> 4) & 1;
    const int kboff = kv * DBUF_BYTES + col * DK_STR + hh * 16;
    const int vboff = kv * DBUF_BYTES + 64 * DK_STR + (4 * hh + (i16 >> 2)) * DV_STR + (16 * blk + 4 * (i16 & 3)) * 2;
    const GAS unsigned char* kp = (const GAS unsigned char*)(proj + rowb * PLD + C_BK); const GAS unsigned char* vp = (const GAS unsigned char*)(proj + rowb * PLD + C_BV);
    const unsigned soffp = (unsigned)(skey * PLD + sch * 8) * 2u;
    u32x4 k0, v0, k1, v1;
    f32x16 O[2], negm; float lsum = 0.f;
#pragma unroll
    for (int i = 0; i < 16; ++i) { O[0][i] = 0.f; O[1][i] = 0.f; negm[i] = 120.f; }
    const int s0 = (u < 2) ? 2 - u : 0;
    { const unsigned so = soffp + (unsigned)(u - 2 + s0) * (64u * PLD * 2u); st_load(kp, vp, so, k0, v0); st_load(kp + 128, vp + 128, so, k1, v1);
      st_write(lds, skey, sch, k0, v0); st_write(lds + DBUF_BYTES, skey, sch, k1, v1); }
    __syncthreads();
#pragma unroll 1
    for (int s = s0; s < 3; ++s) {
        const int par = (s - s0) & 1; const LAS unsigned char* cur = lds + par * 2 * DBUF_BYTES; LAS unsigned char* nxt = lds + (par ^ 1) * 2 * DBUF_BYTES;
        if (s + 1 < 3) { const unsigned so = soffp + (unsigned)(u - 2 + s + 1) * (64u * PLD * 2u); st_load(kp, vp, so, k0, v0); st_load(kp + 128, vp + 128, so, k1, v1); }
        {   f32x16 S[2]; qk64(cur, kboff, qf, negm, S);
            mask_bias(S, t, (u - 2 + s) * 64, hh, 128, true, b2h);
            bf16x8 pk[2][2]; softmax_step(S, O, negm, lsum, pk); pv64(cur, vboff, pk, O); }
        if (s + 1 < 3) { st_write(nxt, skey, sch, k0, v0); st_write(nxt + DBUF_BYTES, skey, sch, k1, v1); }
        __syncthreads();
    }
    {   const float sinkp = (sinks[head] - biasd[128 * 12 + head]) * 1.4426950408889634f;
        const float lt = lsum + xshfl<32>(lsum) + __builtin_amdgcn_exp2f(sinkp + negm[0]);
        const float inv = 1.f / fmaxf(lt, 1e-30f);
        GAS bf16* op = ys + (rowb + t) * 1024 + 256 + head * 64;
#pragma unroll
        for (int db = 0; db < 2; ++db)
#pragma unroll
            for (int gq = 0; gq < 4; ++gq) { const int d0 = 32 * db + 8 * gq + 4 * hh;
                u32x2 w; w.x = cvtpk(O[db][4 * gq + 0] * inv, O[db][4 * gq + 1] * inv); w.y = cvtpk(O[db][4 * gq + 2] * inv, O[db][4 * gq + 3] * inv); *(GAS u32x2*)(op + d0) = w; }
    }
}

DI void route_rows4(const KA& a, int l, bf16* xr_, int tok0, int lane_) {
    int lane = lane_; asm volatile("" : "+v"(lane));
    const GAS float* xrow = (const GAS float*)a.out + (size_t)tok0 * 1024; const GAS float* g = (const GAS float*)(a.in[28] + (size_t)l * 1024); GAS bf16* xr = (GAS bf16*)xr_;
    f32x4 v[4][4]; float ss[4];
#pragma unroll
    for (int rr = 0; rr < 4; ++rr)
#pragma unroll
        for (int j = 0; j < 4; ++j) v[rr][j] = *(const GAS f32x4*)(xrow + (size_t)rr * 1024 + 4 * (lane + 64 * j));
#pragma unroll
    for (int rr = 0; rr < 4; ++rr) { float t = 0.f;
#pragma unroll
        for (int j = 0; j < 4; ++j) t += (v[rr][j][0] * v[rr][j][0] + v[rr][j][1] * v[rr][j][1]) + (v[rr][j][2] * v[rr][j][2] + v[rr][j][3] * v[rr][j][3]);
        ss[rr] = t; }
#pragma unroll
    for (int rr = 0; rr < 4; ++rr) ss[rr] = wave_sum(ss[rr]);
#pragma unroll
    for (int j = 0; j < 4; ++j) { const int k0 = 4 * (lane + 64 * j); const f32x4 gv = *(const GAS f32x4*)(g + k0);
#pragma unroll
        for (int rr = 0; rr < 4; ++rr) { const float r = 1.f / sqrtf(ss[rr] * (1.f / 1024.f) + 1e-6f); const f32x4 xn = v[rr][j] * r * gv;
            unsigned hi[4]; float lo[4];
#pragma unroll
            for (int e = 0; e < 4; ++e) { hi[e] = f2bf(xn[e]); lo[e] = xn[e] - __builtin_bit_cast(float, hi[e] << 16); }
            u32x2 wh, wl; wh.x = hi[0] | (hi[1] << 16); wh.y = hi[2] | (hi[3] << 16); wl.x = pk2(lo[0], lo[1]); wl.y = pk2(lo[2], lo[3]);
            *(GAS u32x2*)(xr + (size_t)(tok0 + rr) * 2048 + k0) = wh; *(GAS u32x2*)(xr + (size_t)(tok0 + rr) * 2048 + 1024 + k0) = wl; } }
}
struct SchedRoute { const char* A; const char* B; int pm;
    DI bool next(int i, Unit& u) const { if (i > 0) return false; u.pm = pm; u.pn = 0; u.aux = 0; u.pad = 0; u.a = A + (size_t)pm * 128 * 2048 * 2; u.b = B; return true; } };
struct EpiRoute { float* rlog;
    DI void operator()(const f32x4 (&acc)[2][2][4][2], const Unit& u, int wr, int wc, int fr, int fq) const {
        const int row0 = u.pm * 128 + wr * 64 + fr; const int col = wc * 32 + 8 * fq;
#pragma unroll
        for (int m = 0; m < 4; ++m) { float* rp = rlog + (size_t)(row0 + m * 16) * 128 + col; *(f32x4*)rp = acc[0][0][m][0]; *(f32x4*)(rp + 4) = acc[0][0][m][1]; }
    }
};
DI void route_decide(const KA& a, int l, const float* rl_row, int* rec_e, int* rec_slot, float* rec_w, unsigned* cnt, int tok) {
    float lg[36];
    const float* bg = a.in[30] + l * 4; const float* be = a.in[32] + l * 32;
#pragma unroll
    for (int q = 0; q < 9; ++q) { const f32x4 h = *(const f32x4*)(rl_row + 4 * q), lo = *(const f32x4*)(rl_row + 64 + 4 * q);
        lg[4 * q + 0] = h[0] + lo[0]; lg[4 * q + 1] = h[1] + lo[1]; lg[4 * q + 2] = h[2] + lo[2]; lg[4 * q + 3] = h[3] + lo[3]; }
#pragma unroll
    for (int i = 0; i < 4; ++i) lg[i] += bg[i];
#pragma unroll
    for (int i = 0; i < 32; ++i) lg[4 + i] += be[i];
    int gsel = 0; float gm = lg[0];
#pragma unroll
    for (int i = 1; i < 4; ++i) if (lg[i] > gm) { gm = lg[i]; gsel = i; }
    float gs = 0.f;
#pragma unroll
    for (int i = 0; i < 4; ++i) gs += __expf(lg[i] - gm);
    const float gwt = 1.f / gs;
    float v8[8];
#pragma unroll
    for (int i = 0; i < 8; ++i) { float x = lg[4 + i];
#pragma unroll
        for (int gq = 1; gq < 4; ++gq) x = (gsel == gq) ? lg[4 + gq * 8 + i] : x;
        v8[i] = x; }
    int i0 = 0; float m0 = v8[0];
#pragma unroll
    for (int i = 1; i < 8; ++i) if (v8[i] > m0) { m0 = v8[i]; i0 = i; }
    int i1 = -1; float m1 = -3e38f;
#pragma unroll
    for (int i = 0; i < 8; ++i) if (i != i0 && v8[i] > m1) { m1 = v8[i]; i1 = i; }
    const float w0 = 1.f / (1.f + __expf(m1 - m0)); const float w1 = 1.f - w0;
    const int e0 = gsel * 8 + i0, e1 = gsel * 8 + i1;
    const unsigned s0 = __hip_atomic_fetch_add(cnt + e0, 1u, __ATOMIC_RELAXED, __HIP_MEMORY_SCOPE_AGENT);
    const unsigned s1 = __hip_atomic_fetch_add(cnt + e1, 1u, __ATOMIC_RELAXED, __HIP_MEMORY_SCOPE_AGENT);
    rec_e[tok * 2] = e0; rec_e[tok * 2 + 1] = e1; rec_slot[tok * 2] = (int)s0; rec_slot[tok * 2 + 1] = (int)s1; rec_w[tok * 2] = w0 * gwt; rec_w[tok * 2 + 1] = w1 * gwt;
}
DI void expert_weights(const KA& a, int l, LAS unsigned char* lds, int it0, int it1, int gw, int NGW, int wave, int lane) {
    LAS float* scr = (LAS float*)(lds + wave * 16384);
    const float* wgt = a.in[33] + (size_t)l * 32 * 1024 * 256; const float* wup = a.in[34] + (size_t)l * 32 * 1024 * 256; const float* wdn = a.in[35] + (size_t)l * 32 * 256 * 1024;
    bf16* Wgu = (bf16*)(a.ws + WS_WGU); bf16* Wd = (bf16*)(a.ws + WS_WD);
    constexpr int I_E = 16 * 8, I_D = 4 * 32;
    constexpr int NIT = 32 * (2 * I_E + I_D);
    (void)NIT;
    for (int it = it0 + gw; it < it1; it += NGW) {
        const int e = it / (2 * I_E + I_D); int r = it % (2 * I_E + I_D);
        if (r < 2 * I_E) { const int up = r / I_E, q = r % I_E, kb = q / 8, nb = q % 8; const int n0 = nb * 32;
            const int drow = (n0 >> 7) * 256 + up * 128 + (n0 & 127);
            transpose_item((up ? wup : wgt) + (size_t)e * 1024 * 256, 256, 256, Wgu + (size_t)e * 512 * 1024, 1024, kb * 64, n0, drow, scr, lane);
        } else { r -= 2 * I_E; const int kb = r / 32, nb = r % 32;
            transpose_item(wdn + (size_t)e * 256 * 1024, 1024, 1024, Wd + (size_t)e * 1024 * 256, 256, kb * 64, nb * 32, nb * 32, scr, lane); }
    }
}
DI void build_offsets(const unsigned* cnt, LAS int* offt, int tid) {
    if (tid == 0) { int o = 0; for (int e = 0; e < 32; ++e) { offt[e] = o; const int c = (int)__hip_atomic_load(cnt + e, __ATOMIC_RELAXED, __HIP_MEMORY_SCOPE_AGENT); o += (c + 255) & ~255; } offt[32] = o; }
    __syncthreads();
    for (int rt = tid; rt < (MOE_ROWS >> 8); rt += 512) { int e = 0; for (int j = 1; j < 32; ++j) e += (offt[j] <= rt * 256) ? 1 : 0; offt[40 + rt] = e; }
    __syncthreads();
}

template <unsigned PM>
__global__ void __launch_bounds__(512, 2) mk_fwd(Args a_) {
    extern __shared__ __attribute__((aligned(16))) unsigned char lds_raw[];
    LAS unsigned char* lds = (LAS unsigned char*)lds_raw;
    const int wave0 = __builtin_amdgcn_readfirstlane((int)threadIdx.x >> 6);
    if (threadIdx.x < 36) ((LAS unsigned long long*)(lds + PTAB_OFF))[threadIdx.x] = (unsigned long long)a_.in[threadIdx.x];
    __syncthreads();
    KA a; a.in.base = (unsigned)(size_t)(lds + PTAB_OFF); a.out = a_.out; a.ws = a_.ws;
    const int G = gridDim.x, bid = blockIdx.x, NGW = G * 8;
#define PHASE_IDS() int wave = wave0; asm volatile("" : "+s"(wave)); const int lane = my_lane(); const int tid_ = wave * 64 + lane, gw = bid * 8 + wave; (void)tid_; (void)gw; \
    KA ap = a; asm volatile("" : "+s"(ap.ws), "+s"(ap.out), "+s"(ap.in.base)); \
    bf16* hb = (bf16*)(ap.ws + WS_HB); bf16* proj = (bf16*)(ap.ws + WS_PROJ); bf16* gates = (bf16*)(ap.ws + WS_GATES); \
    bf16* ys = hb; bf16* x2b = hb; bf16* merged = proj; bf16* eo = proj; \
    bf16* kcb = (bf16*)(ap.ws + WS_KCVC); float* lrusum = (float*)(ap.ws + WS_LRUSUM); \
    int* rec_e = (int*)(ap.ws + WS_REC); int* rec_slot = rec_e + T * 2; float* rec_w = (float*)(rec_slot + T * 2); \
    int* rowtok = (int*)(ap.ws + WS_ROWTOK); float* roww = (float*)(ap.ws + WS_ROWW); \
    bf16* xs = (bf16*)(ap.ws + WS_XS); bf16* hmid = (bf16*)(ap.ws + WS_HMID); unsigned* ctl = (unsigned*)(ap.ws + WS_CTL); \
    (void)hb; (void)proj; (void)gates; (void)ys; (void)x2b; (void)merged; (void)eo; (void)kcb; (void)lrusum; (void)rec_e; (void)rec_slot; (void)rec_w; (void)rowtok; (void)roww; (void)xs; (void)hmid; (void)ctl
    volatile LAS unsigned* MISC = (volatile LAS unsigned*)(lds + MISC_OFF);
    LAS float* biasd = (LAS float*)(lds + BIAS_OFF);
    LAS int* offt = (LAS int*)(lds + OFFT_OFF);
    { PHASE_IDS();
    if (tid_ < 64) MISC[tid_] = 0u;
    for (int i = tid_; i < 129 * 12; i += 512) { const int d = i / 12, hd = i % 12; const int bk = d < 128 ? T5_BUCKET[d] : 31; const float* rb = a.in[1]; biasd[i] = rb[bk * 12 + hd]; ((LAS float*)(lds + BIAS2_OFF))[i] = (rb[bk * 12 + hd] - rb[31 * 12 + hd]) * 1.4426950408889634f; } }
    __syncthreads();
    const int lo = a_.ph_lo, hi = a_.ph_hi;
    XcdBarrier bar; bar.bar = (unsigned*)(a.ws + WS_CTL) + CW_BAR; bar.x = 0; bar.st = nullptr;
    if (hi - lo > 1) { PHASE_IDS(); bar = xcd_barrier_post(ctl + CW_BAR, MISC + 8, tid_ == 0); }
#ifndef SUB_MASK
#define SUB_MASK 0xFFu
#endif
#define SUB(k) ((SUB_MASK >> (k)) & 1u)
#define HASP(k) ((PM >> ((k) % PPL + ((k) >= 2 * PPL ? PPL : 0))) & 1u)
#define IN(k) (HASP(k) && lo <= (k) && (k) < hi)
#define SEAM(k) do { if ((k) + 1 < hi) { const int sl_ = my_lane(); int sw_ = wave0; asm volatile("" : "+s"(sw_)); xcd_barrier(bar, sw_ == 0 && sl_ == 0); } } while (0)
    for (int l = 0; l < DEPTH; ++l) {
        const int pb = l * PPL;
        if (IN(pb + 0)) { PHASE_IDS(); router_weights(ap, l, gw, NGW, lane); lru_weights(ap, l, gw, NGW, lane); cmp_weights(ap, l, lds, gw, NGW, wave, lane); phase0_weights(ap, l, lds, gw, NGW, wave, lane); phase0_rows(ap, l, 0, gw, NGW, lane); SEAM(pb + 0); }
        if (IN(pb + 1)) {
            PHASE_IDS();
            pg8::Gemm g{1024, 1024, 1024, 128, -1}; SchedP1 S{(const char*)hb, (const char*)(ap.ws + WS_WIN), G, bid};
            EpiP1 E{proj, gates, ap.in[25] + (size_t)l * 4096};
            pg8::gemm_phase<EpiP1, SchedP1>(lds, g, S, E, tid_); SEAM(pb + 1);
        }
        if (IN(pb + 2)) {
            PHASE_IDS();
            float s1 = 0.f, s2 = 0.f;
            for (int i = 0; i < 32; ++i) { s1 += ap.in[13][l * 32 + i] * ap.in[14][l * 32 + i]; s2 += ap.in[15][l * 32 + i] * ap.in[16][l * 32 + i]; }
            const float lam_init = 0.8f - 0.6f * __expf(-0.3f * (float)l); const float lam = __expf(s1) - __expf(s2) + lam_init;
            if (SUB(0)) { const LAS float* bias2 = (const LAS float*)(lds + BIAS2_OFF); const GAS float* subg = (const GAS float*)(ap.in[17] + l * 64);
                for (int pi = bid; pi < 256; pi += G) { const int bh = pi >> 4, qlo = pi & 15;
                    diff_unit((const GAS bf16*)proj, (GAS bf16*)ys, lds, bias2, subg, lam, lam_init, bh >> 2, bh & 3, 31 - qlo, tid_, lane, wave);
                    diff_unit((const GAS bf16*)proj, (GAS bf16*)ys, lds, bias2, subg, lam, lam_init, bh >> 2, bh & 3, qlo, tid_, lane, wave); } }
            if (SUB(3)) { __syncthreads(); const LAS float* bias2 = (const LAS float*)(lds + BIAS2_OFF); const GAS float* sinks = (const GAS float*)(ap.in[12] + l * 4);
                for (int pi = bid; pi < 512; pi += G) swa_unit((const GAS bf16*)proj, (GAS bf16*)ys, lds, bias2, biasd, sinks, pi >> 7, pi & 127, tid_, lane, wave); }
            if (SUB(2)) { pg8::Gemm g{1024, 16 * PLD, 1024, PLD * 2, -1}; SchedCmp S{(const char*)proj, (const char*)(ap.ws + WS_WCMP), G, bid}; EpiCmp E{(float*)(ap.ws + WS_CMPAB)};
                pg8::gemm_phase<EpiCmp, SchedCmp>(lds, g, S, E, tid_); }
            if (SUB(1)) { __syncthreads(); for (int task = bid; task < 512; task += G) lru_unit(ap, l, (const GAS bf16*)proj, (GAS bf16*)ys, (GAS float*)lrusum, lds, task, lane, wave, false); }
            SEAM(pb + 2);
        }
        if (IN(pb + 3)) {
            PHASE_IDS();
            for (int task = gw; task < 2 * BATCH * NCMP; task += NGW) cmp_finish(ap, l, (const float*)(ap.ws + WS_CMPAB), kcb, task, lane);
            __syncthreads();
            for (int task = bid; task < 512; task += G) lru_unit(ap, l, (const GAS bf16*)proj, (GAS bf16*)ys, (GAS float*)lrusum, lds, task, lane, wave, true);
            SEAM(pb + 3);
        }
        if (IN(pb + 4)) {
            PHASE_IDS();
            if (SUB(4)) { const LAS float* bias2 = (const LAS float*)(lds + BIAS2_OFF);
                for (int pi = bid; pi < 256; pi += G) { const int bb = pi >> 6, ulo = pi & 63;
                    nsa_unit((const GAS bf16*)proj, (GAS bf16*)ys, (const GAS bf16*)kcb, lds, bias2, bb, 127 - ulo, tid_, lane, wave);
                    nsa_unit((const GAS bf16*)proj, (GAS bf16*)ys, (const GAS bf16*)kcb, lds, bias2, bb, ulo, tid_, lane, wave); } }
            SEAM(pb + 4);
        }
        if (IN(pb + 5)) {
            PHASE_IDS();
            pg8::Gemm g{256, 1024, 256, 128, -1}; SchedP3a S{(const char*)ys, (const char*)(ap.ws + WS_WBR), G, bid};
            EpiP3a E{merged, gates};
            pg8::gemm_phase<EpiP3a, SchedP3a>(lds, g, S, E, tid_); SEAM(pb + 5);
        }
        if (IN(pb + 6)) {
            PHASE_IDS();
            pg8::Gemm g{1024, 1024, 1024, 128, -1}; SchedP3b S{(const char*)merged, (const char*)(ap.ws + WS_WOUT), G, bid};
            EpiP3b E{(l == 0) ? ap.in[0] : ap.out, ap.out};
            pg8::gemm_phase<EpiP3b, SchedP3b>(lds, g, S, E, tid_); SEAM(pb + 6);
        }
        if (IN(pb + 7)) {
            PHASE_IDS();
            bf16* xr = (bf16*)(ap.ws + WS_XR); float* rlog = (float*)(ap.ws + WS_RLOG);
            constexpr int NITW = 32 * (2 * 16 * 8 + 4 * 32);
            { const int pm = bid;
                for (int r = wave * 4; r < 128; r += 32) route_rows4(ap, l, xr, pm * 128 + r, lane);
                asm volatile("s_waitcnt vmcnt(0)" ::: "memory"); __syncthreads();
                { pg8::Gemm g{2048, 2048, 2048, 128, 0}; SchedRoute S{(const char*)xr, (const char*)(ap.ws + WS_WR), pm}; EpiRoute E{rlog};
                  pg8::gemm_phase<EpiRoute, SchedRoute>(lds, g, S, E, tid_); }
                asm volatile("s_waitcnt vmcnt(0)" ::: "memory"); __syncthreads();
                if (tid_ < 128) route_decide(ap, l, rlog + (size_t)(pm * 128 + tid_) * 128, rec_e, rec_slot, rec_w, ctl + CW_CNT + l * 32, pm * 128 + tid_);
                __syncthreads();
            }
            expert_weights(ap, l, lds, 0, NITW, gw, NGW, wave, lane);
            SEAM(pb + 7);
        }
        if (IN(pb + 8)) {
            PHASE_IDS();
            build_offsets(ctl + CW_CNT + l * 32, offt, tid_);
            if (bid < 32) { const int e = bid; const int c = (int)__hip_atomic_load(ctl + CW_CNT + l * 32 + e, __ATOMIC_RELAXED, __HIP_MEMORY_SCOPE_AGENT);
                for (int p = offt[e] + c + tid_; p < offt[e + 1]; p += 512) rowtok[p] = -1; }
            {   const GAS bf16* xr = (const GAS bf16*)(ap.ws + WS_XR); GAS bf16* xsg = (GAS bf16*)xs;
                for (int tok0 = gw * 4; tok0 < T; tok0 += NGW * 4) {
                    u32x4 v0[4], v1[4]; int pos[4][2];
#pragma unroll
                    for (int rr = 0; rr < 4; ++rr) { v0[rr] = *(const GAS u32x4*)(xr + (size_t)(tok0 + rr) * 2048 + lane * 8); v1[rr] = *(const GAS u32x4*)(xr + (size_t)(tok0 + rr) * 2048 + 512 + lane * 8);
#pragma unroll
                        for (int k = 0; k < 2; ++k) pos[rr][k] = offt[rec_e[(tok0 + rr) * 2 + k]] + rec_slot[(tok0 + rr) * 2 + k]; }
#pragma unroll
                    for (int rr = 0; rr < 4; ++rr)
#pragma unroll
                        for (int k = 0; k < 2; ++k) { const int p = pos[rr][k];
                            *(GAS u32x4*)(xsg + (size_t)p * 1024 + lane * 8) = v0[rr]; *(GAS u32x4*)(xsg + (size_t)p * 1024 + 512 + lane * 8) = v1[rr];
                            if (lane == 0) { rowtok[p] = (tok0 + rr) * 2 + k; roww[p] = rec_w[(tok0 + rr) * 2 + k]; } } } }
            SEAM(pb + 8);
        }
        if (IN(pb + 9)) {
            PHASE_IDS();
            build_offsets(ctl + CW_CNT + l * 32, offt, tid_);
            pg8::Gemm g{1024, 1024, 1024, 128, -1}; SchedM2 S{(const char*)xs, (const char*)(ap.ws + WS_WGU), offt, G, bid};
            EpiM2 E{hmid};
            pg8::gemm_phase<EpiM2, SchedM2>(lds, g, S, E, tid_); SEAM(pb + 9);
        }
        if (IN(pb + 10)) {
            PHASE_IDS();
            build_offsets(ctl + CW_CNT + l * 32, offt, tid_);
            pg8::Gemm g{256, 256, 256, 128, -1}; SchedM3 S{(const char*)hmid, (const char*)(ap.ws + WS_WD), offt, G, bid};
            EpiM3 E{eo, rowtok, roww};
            pg8::gemm_phase<EpiM3, SchedM3>(lds, g, S, E, tid_); SEAM(pb + 10);
        }
    }
    if (IN(2 * PPL)) { PHASE_IDS(); phase0_rows(ap, DEPTH, 1, gw, NGW, lane); }
#undef IN
#undef SEAM
}

typedef void (*kern_t)(Args);
template <unsigned PM> static bool setup_kernel() {
    if (hipFuncSetAttribute((const void*)mk_fwd<PM>, hipFuncAttributeMaxDynamicSharedMemorySize, LDS_BYTES) != hipSuccess) { fprintf(stderr, "kernel_launch: hipFuncSetAttribute failed\n"); return false; }
    return true;
}
extern "C" void kernel_launch(void* const* d_in, const int* in_sizes, int n_in, void* d_out, int out_size, void* d_ws, size_t ws_size, hipStream_t stream) {
    static int grid = 0;
    if (grid == 0) {
        if (n_in != 36 || out_size != T * D || ws_size < WS_END) { fprintf(stderr, "kernel_launch: unexpected shapes (n_in %d out %d ws %zu)\n", n_in, out_size, ws_size); grid = -1; return; }
        int dev = 0, cus = 0;
        if (hipGetDevice(&dev) != hipSuccess || hipDeviceGetAttribute(&cus, hipDeviceAttributeMultiprocessorCount, dev) != hipSuccess) { grid = -1; return; }
        bool ok = true;
#if MK_ONE_LAUNCH
        ok = setup_kernel<0xFFFu>();
#endif
        if (!ok) { grid = -1; return; }
        (void)hipGetLastError();
        grid = cus;
        if (grid != 256) { fprintf(stderr, "kernel_launch: built for a 256-CU device (got %d)\n", cus); grid = -1; return; }
    }
    if (grid < 0) return;
    if (hipMemsetAsync((char*)d_ws + WS_CTL, 0, CTL_ZERO_BYTES, stream) != hipSuccess) return;
    Args a{};
    for (int i = 0; i < 36; ++i) a.in[i] = (const float*)d_in[i];
    a.out = (float*)d_out; a.ws = (unsigned char*)d_ws;
#if MK_ONE_LAUNCH
    a.ph_lo = 0; a.ph_hi = NPH;
    hipLaunchKernelGGL(mk_fwd<0xFFFu>, dim3(grid), dim3(512), LDS_BYTES, stream, a);
#endif
}
```

```cpp
#include <hip/hip_runtime.h>
#include <cstdio>
#include <cstdint>

#ifndef MK_ONE_LAUNCH
#define MK_ONE_LAUNCH 1
#endif

#define DI __device__ __forceinline__
#define GAS __attribute__((address_space(1)))
#define LAS __attribute__((address_space(3)))
typedef unsigned short bf16;
typedef short bf16x8 __attribute__((ext_vector_type(8)));
typedef float f32x4 __attribute__((ext_vector_type(4)));
typedef unsigned u32x4 __attribute__((ext_vector_type(4)));
typedef unsigned u32x2 __attribute__((ext_vector_type(2)));
typedef float f32x16 __attribute__((ext_vector_type(16)));
typedef float f32x2 __attribute__((ext_vector_type(2)));
typedef short s16x4 __attribute__((ext_vector_type(4)));
typedef __bf16 bf16x2_t __attribute__((ext_vector_type(2)));
typedef short v4i16_t __attribute__((__vector_size__(4 * sizeof(short))));
#define MFMA32(a, b, c) __builtin_amdgcn_mfma_f32_32x32x16_bf16((a), (b), (c), 0, 0, 0)

constexpr int BATCH = 4, SEQ = 8192, T = BATCH * SEQ, D = 1024, DEPTH = 2;
constexpr int NIN = 2444, PLD = 2560, N1 = 6656, GLD = 4096;
constexpr int C_AX = 0, C_AG = 256, C_BQ = 512, C_BK = 768, C_BV = 896, C_CQ = 1024, C_CK = 1280, C_CV = 1536, C_DQ = 1792,
              C_KC = 2048, C_VC = 2112, C_KS = 2176, C_VS = 2240, C_KW = 2304, C_VW = 2368, C_DG = 2432;
constexpr int NCMP = 511;
constexpr int MOE_ROWS = 73728;
constexpr int PPL = 11;
constexpr int NPH = 2 * PPL + 1;

constexpr size_t MiB = 1u << 20;
constexpr size_t WS_CTL = 0, CTL_ZERO_BYTES = 1 * MiB;
constexpr size_t WS_KCVC = 1 * MiB;
constexpr size_t WS_LRUSUM = 2 * MiB;
constexpr size_t WS_REC = 2 * MiB + 256 * 1024;
constexpr size_t WS_ROWTOK = 3 * MiB;
constexpr size_t WS_ROWW = 3 * MiB + 512 * 1024;
constexpr size_t WS_WIN = 4 * MiB;
constexpr size_t WS_WBR = 17 * MiB;
constexpr size_t WS_WOUT = 19 * MiB;
constexpr size_t WS_HB = 21 * MiB;
constexpr size_t WS_PROJ = 85 * MiB;
constexpr size_t WS_GATES = 245 * MiB;
constexpr size_t WS_WGU = 245 * MiB;
constexpr size_t WS_WD = 277 * MiB;
constexpr size_t WS_XS = 293 * MiB;
constexpr size_t WS_HMID = 437 * MiB;
constexpr size_t WS_XR = 85 * MiB;
constexpr size_t WS_RLOG = 213 * MiB;
constexpr size_t WS_WR = 501 * MiB;
constexpr size_t WS_WCMP = 502 * MiB;
constexpr size_t WS_CMPAB = 503 * MiB;
constexpr size_t WS_LRUW = 505 * MiB + 65536;
constexpr size_t WS_END = 506 * MiB;
constexpr int CW_BAR = 4096;
constexpr int CW_CNT = 16384;

constexpr int RING_BYTES = 131072;
constexpr int MISC_OFF = RING_BYTES;
constexpr int BIAS_OFF = MISC_OFF + 256;
constexpr int OFFT_OFF = BIAS_OFF + 129 * 12 * 4;
constexpr int PTAB_OFF = OFFT_OFF + (40 + 288) * 4;
constexpr int BIAS2_OFF = PTAB_OFF + 36 * 8;
constexpr int LRUEX_OFF = BIAS2_OFF + 129 * 12 * 4;
constexpr int LDS_BYTES = 163840;
constexpr int LRUCST_OFF = LRUEX_OFF + 8 * 64 * 2 * 4;
constexpr int LRUCAR_OFF = LRUCST_OFF + 3 * 64 * 4;
static_assert(PTAB_OFF % 8 == 0 && LRUCAR_OFF + 8 * 64 * 4 <= LDS_BYTES, "LDS map");

DI float bf2f(bf16 v) { return __builtin_bit_cast(float, (unsigned)v << 16); }
DI float lo_bf(unsigned w) { return __builtin_bit_cast(float, w << 16); }
DI float hi_bf(unsigned w) { return __builtin_bit_cast(float, w & 0xffff0000u); }
DI unsigned f2bf(float f) { unsigned u = __builtin_bit_cast(unsigned, f); return (u + 0x7fffu + ((u >> 16) & 1u)) >> 16; }
DI unsigned pk2(float lo, float hi) { return f2bf(lo) | (f2bf(hi) << 16); }
DI float rl(float v, int i) { return __builtin_bit_cast(float, __builtin_amdgcn_readlane(__builtin_bit_cast(int, v), i)); }
DI int rli(int v, int i) { return __builtin_amdgcn_readlane(v, i); }
DI int my_lane() { int l; asm volatile("v_mbcnt_lo_u32_b32 %0, -1, 0\n\tv_mbcnt_hi_u32_b32 %0, -1, %0" : "=v"(l)); return l; }
template <int O> DI int xshfl_i(int v) {
    if constexpr (O < 32) return __builtin_amdgcn_ds_swizzle(v, (O << 10) | 0x1f);
    else { const int l = my_lane(); return __builtin_amdgcn_ds_bpermute((l ^ 32) << 2, v); }
}
template <int O> DI float xshfl(float v) { return __builtin_bit_cast(float, xshfl_i<O>(__builtin_bit_cast(int, v))); }
DI float wave_sum(float v) { v += xshfl<1>(v); v += xshfl<2>(v); v += xshfl<4>(v); v += xshfl<8>(v); v += xshfl<16>(v); v += xshfl<32>(v); return v; }
DI float wave_max(float v) { v = fmaxf(v, xshfl<1>(v)); v = fmaxf(v, xshfl<2>(v)); v = fmaxf(v, xshfl<4>(v)); v = fmaxf(v, xshfl<8>(v)); v = fmaxf(v, xshfl<16>(v)); v = fmaxf(v, xshfl<32>(v)); return v; }
DI float sigmoidf_(float x) { return __builtin_amdgcn_rcpf(1.f + __builtin_amdgcn_exp2f(-1.4426950408889634f * x)); }
DI float gelu_tanh(float x) { const float u = 0.7978845608028654f * (x + 0.044715f * x * x * x); const float e = __expf(2.f * u); const float th = 1.f - 2.f * __builtin_amdgcn_rcpf(e + 1.f); return 0.5f * x * (1.f + th); }
DI float softplusf_(float x) { return fmaxf(x, 0.f) + log1pf(__expf(-fabsf(x))); }
#define LDS_WAIT() asm volatile("s_waitcnt lgkmcnt(0)" ::: "memory")
#define VM_WAIT() asm volatile("s_waitcnt vmcnt(0)" ::: "memory")

__device__ const unsigned char T5_BUCKET[128] = {
0,1,2,3,4,5,6,7,8,9,10,11,12,13,14,15,16,16,16,17,17,18,18,18,19,19,19,20,20,20,20,21,21,21,21,22,22,22,22,22,23,23,23,23,23,23,24,24,24,24,24,24,25,25,25,25,25,25,25,26,26,26,26,26,26,26,26,27,27,27,27,27,27,27,27,27,27,28,28,28,28,28,28,28,28,28,28,29,29,29,29,29,29,29,29,29,29,29,29,30,30,30,30,30,30,30,30,30,30,30,30,30,30,31,31,31,31,31,31,31,31,31,31,31,31,31,31,31};

#define XB_TMO      128
#define XB_XCNT(j)  (256  + 64 * (j))
#define XB_XSUB(j)  (1280 + 64 * (j))
#define XB_XGEN(j)  (2304 + 64 * (j))
#define XB_TOP      3328
#define XB_TOPGEN   3392
#define XCD_BAR_WORDS 3456
#define XB_SPIN_CAP (1u << 22)
DI unsigned xb_ld(unsigned* p)              { return __hip_atomic_load(p, __ATOMIC_RELAXED, __HIP_MEMORY_SCOPE_AGENT); }
DI unsigned xb_add(unsigned* p, unsigned v) { return __hip_atomic_fetch_add(p, v, __ATOMIC_RELAXED, __HIP_MEMORY_SCOPE_AGENT); }
DI unsigned xb_xcc_id() { return (unsigned)__builtin_amdgcn_s_getreg((3 << 11) | 20) & 0xFu; }
#define XB_SPIN(cond, bar) do { unsigned _sp = 0; while (cond) { __builtin_amdgcn_s_sleep(1); \
    if ((++_sp & 255u) == 0u) { if (xb_ld(&(bar)[XB_TMO])) break; if (_sp > XB_SPIN_CAP) { atomicAdd(&(bar)[XB_TMO], 1u); break; } } } } while (0)
struct XcdBarrier { unsigned* bar; unsigned x; volatile LAS unsigned* st; };
DI XcdBarrier xcd_barrier_post(unsigned* bar, volatile LAS unsigned* st, bool leader) {
    XcdBarrier b; b.bar = bar; b.x = xb_xcc_id(); b.st = st;
    if (leader) (void)xb_add(&bar[XB_XCNT(b.x)], 1u);
    return b;
}
DI void xcd_barrier_complete(unsigned* bar, unsigned x, unsigned& nloc, unsigned& nx) {
    const unsigned G = gridDim.x * gridDim.y * gridDim.z;
    unsigned sum, cnt, mine, sp = 0u;
    for (;;) {
        sum = 0u; cnt = 0u; mine = 0u;
#pragma unroll
        for (unsigned j = 0; j < 16; ++j) { const unsigned c = xb_ld(&bar[XB_XCNT(j)]); sum += c; cnt += (c > 0u) ? 1u : 0u; mine = (j == x) ? c : mine; }
        if (sum == G) break;
        __builtin_amdgcn_s_sleep(1);
        if ((++sp & 255u) == 0u) { if (xb_ld(&bar[XB_TMO])) break; if (sp > XB_SPIN_CAP) { atomicAdd(&bar[XB_TMO], 1u); break; } }
    }
    nloc = mine > 0u ? mine : 1u; nx = cnt > 0u ? cnt : 1u;
}
DI void xcd_barrier(const XcdBarrier& b, bool leader) {
    asm volatile("s_waitcnt vmcnt(0)" ::: "memory");
    __syncthreads();
    if (leader) {
        unsigned* bar = b.bar;
        __builtin_amdgcn_s_waitcnt(0);
        unsigned nloc = b.st[0], nx = b.st[1];
        if (nloc == 0u) { xcd_barrier_complete(bar, b.x, nloc, nx); b.st[0] = nloc; b.st[1] = nx; }
        const unsigned old = xb_add(&bar[XB_XSUB(b.x)], 1u);
        const unsigned gen = old / nloc;
        if (old + 1u == (gen + 1u) * nloc) {
            __builtin_amdgcn_fence(__ATOMIC_RELEASE, "agent");
            asm volatile("s_waitcnt vmcnt(0)" ::: "memory");
            const unsigned og = xb_add(&bar[XB_TOP], 1u);
            const unsigned tg = og / nx;
            if (og + 1u == (tg + 1u) * nx) xb_add(&bar[XB_TOPGEN], 1u);
            else XB_SPIN(xb_ld(&bar[XB_TOPGEN]) == tg, bar);
            __builtin_amdgcn_fence(__ATOMIC_ACQUIRE, "agent");
            xb_add(&bar[XB_XGEN(b.x)], 1u);
            asm volatile("s_waitcnt vmcnt(0)" ::: "memory");
        } else {
            XB_SPIN(xb_ld(&bar[XB_XGEN(b.x)]) == gen, bar);
            __builtin_amdgcn_fence(__ATOMIC_ACQUIRE, "agent");
            asm volatile("s_waitcnt vmcnt(0)" ::: "memory");
        }
    }
    __syncthreads();
}

namespace pg8 {
constexpr int BM = 256, BK = 64, HALF = 128, HTB = HALF * BK * 2;
__host__ __device__ __forceinline__ int lds_byte(int r, int c) { const int st = (r >> 4) * 2 + (c >> 5), rr = r & 15, cc = c & 31, ob = rr * 64 + cc * 2; return st * 1024 + (ob ^ (((ob >> 9) & 1) << 5)); }
__host__ __device__ __forceinline__ void stage_rc(int b, int& R, int& C) { const int st = b / 1024, sb = b % 1024, swz = sb ^ (((sb >> 9) & 1) << 5); R = (st >> 1) * 16 + swz / 64; C = (st & 1) * 32 + (swz % 64) / 2; }
__host__ __device__ __forceinline__ int perm32(int rho) { const int n = rho >> 4, i = rho & 15; return 8 * (i >> 2) + 4 * n + (i & 3); }
struct Unit { const char* a; const char* b; int pm, pn, aux, pad; };
struct Gemm { int K, lda, ldb, kstepA, hstepA; };
template <class Epi, class Sched>
DI void gemm_phase(LAS unsigned char* lds, const Gemm g, const Sched& S, const Epi& E, int tid_in) {
    int tid = tid_in; asm volatile("" : "+v"(tid));
    const int wid = __builtin_amdgcn_readfirstlane(tid >> 6), lane = tid & 63, wr = wid >> 2, wc = wid & 3, fr = lane & 15, fq = lane >> 4;
    const int K = g.K, nt = K / BK;
    unsigned voffA[2], voffB[2];
#pragma unroll
    for (int i = 0; i < 2; ++i) { int R, C; stage_rc(tid * 16 + i * 8192, R, C); const int Rb = (R & ~31) + perm32(R & 31);
        voffA[i] = (unsigned)(R * g.lda + C) * 2u; voffB[i] = (unsigned)(Rb * g.ldb + C) * 2u; }
    const size_t kstep = (size_t)(BK * 2), kstepA = (size_t)g.kstepA;
    const size_t hstepA = g.hstepA < 0 ? (size_t)HALF * g.lda * 2 : (size_t)g.hstepA, hstepB = (size_t)HALF * g.ldb * 2;
    const unsigned ldsw = (unsigned)wid * 1024u;
    const int aoff = lds_byte(wr * 64 + fr, fq * 8), boff = lds_byte(wc * 32 + fr, fq * 8);
#define PG8_SA(b, h) (((b) * 2 + (h)) * HTB)
#define PG8_SB(b, h) ((4 + (b) * 2 + (h)) * HTB)
#define PG8_STAGE(bufoff, gbase, voff) do { _Pragma("unroll") for (int _i = 0; _i < 2; ++_i) \
        __builtin_amdgcn_global_load_lds((const unsigned*)((const char*)(gbase) + (voff)[_i]), (LAS unsigned*)(lds + (bufoff) + ldsw + _i * 8192), 16, 0, 0); } while (0)
#define PG8_LDA(dst, b, h) do { _Pragma("unroll") for (int m = 0; m < 4; ++m) _Pragma("unroll") for (int k = 0; k < 2; ++k) dst[m][k] = *(const LAS bf16x8*)(lds + PG8_SA(b, h) + aoff + m * 2048 + k * 1024); } while (0)
#define PG8_LDB(dst, b, h) do { _Pragma("unroll") for (int n = 0; n < 2; ++n) _Pragma("unroll") for (int k = 0; k < 2; ++k) dst[n][k] = *(const LAS bf16x8*)(lds + PG8_SB(b, h) + boff + n * 2048 + k * 1024); } while (0)
#define PG8_MMA(ai, bj, At, Bt) do { __builtin_amdgcn_s_setprio(1); _Pragma("unroll") for (int m = 0; m < 4; ++m) _Pragma("unroll") for (int n = 0; n < 2; ++n) _Pragma("unroll") for (int k = 0; k < 2; ++k) \
        acc[ai][bj][m][n] = __builtin_amdgcn_mfma_f32_16x16x32_bf16(Bt[n][k], At[m][k], acc[ai][bj][m][n], 0, 0, 0); __builtin_amdgcn_s_setprio(0); } while (0)
#define PG8_WAIT_V(n) asm volatile("s_waitcnt vmcnt(" #n ")" ::: "memory")
#define PG8_WAIT_L(n) asm volatile("s_waitcnt lgkmcnt(" #n ")" ::: "memory")
#define PG8_BAR __builtin_amdgcn_s_barrier()
#define PG8_SCHED __builtin_amdgcn_sched_barrier(0)
    Unit cur, nxt; int ui = 0;
    if (!S.next(0, cur)) return;
    f32x4 acc[2][2][4][2];
#pragma unroll
    for (int a = 0; a < 2; ++a)
#pragma unroll
        for (int b = 0; b < 2; ++b)
#pragma unroll
            for (int m = 0; m < 4; ++m)
#pragma unroll
                for (int n = 0; n < 2; ++n) acc[a][b][m][n] = (f32x4){0.f, 0.f, 0.f, 0.f};
    bf16x8 At[4][2], B0[2][2], B1[2][2];
    const char* cA = cur.a; const char* cB = cur.b;
    PG8_STAGE(PG8_SB(0, 0), cB, voffB); PG8_STAGE(PG8_SB(0, 1), cB + hstepB, voffB); PG8_STAGE(PG8_SA(0, 0), cA, voffA); PG8_STAGE(PG8_SA(0, 1), cA + hstepA, voffA);
    if (wr == 1) PG8_BAR;
    PG8_WAIT_V(2); PG8_BAR;
    PG8_STAGE(PG8_SB(1, 0), cB + kstep, voffB); PG8_STAGE(PG8_SA(1, 0), cA + kstepA, voffA); PG8_STAGE(PG8_SB(1, 1), cB + hstepB + kstep, voffB);
    PG8_WAIT_V(6); PG8_BAR;
    for (;;) {
        const bool has_next = S.next(ui + 1, nxt);
        const char* nA = has_next ? nxt.a : cA; const char* nB = has_next ? nxt.b : cB;
        for (int t = 0; t < nt; t += 2) {
            const bool last = (t == nt - 2);
            const char* a1 = cA + (size_t)(t + 1) * kstepA;
            const char* a2 = last ? nA : cA + (size_t)(t + 2) * kstepA; const char* b2 = last ? nB : cB + (size_t)(t + 2) * kstep;
            const char* a3 = a2 + kstepA; const char* b3 = b2 + kstep;
            PG8_LDB(B0, 0, 0); PG8_LDB(B1, 0, 1); PG8_SCHED; PG8_LDA(At, 0, 0); PG8_STAGE(PG8_SA(1, 1), a1 + hstepA, voffA);
            PG8_WAIT_V(8); PG8_WAIT_L(0); PG8_BAR; PG8_MMA(0, 0, At, B0); PG8_MMA(0, 1, At, B1); PG8_BAR; PG8_SCHED;
            PG8_LDA(At, 0, 1); PG8_STAGE(PG8_SB(0, 0), b2, voffB); PG8_STAGE(PG8_SB(0, 1), b2 + hstepB, voffB); PG8_STAGE(PG8_SA(0, 0), a2, voffA);
            PG8_WAIT_V(8); PG8_WAIT_L(0); PG8_BAR; PG8_MMA(1, 0, At, B0); PG8_MMA(1, 1, At, B1); PG8_BAR; PG8_SCHED;
            PG8_LDB(B0, 1, 0); PG8_LDB(B1, 1, 1); PG8_SCHED; PG8_LDA(At, 1, 0); PG8_STAGE(PG8_SA(0, 1), a2 + hstepA, voffA);
            PG8_WAIT_V(8); PG8_WAIT_L(0); PG8_BAR; PG8_MMA(0, 0, At, B0); PG8_MMA(0, 1, At, B1); PG8_BAR; PG8_SCHED;
            PG8_LDA(At, 1, 1); PG8_STAGE(PG8_SB(1, 0), b3, voffB); PG8_STAGE(PG8_SB(1, 1), b3 + hstepB, voffB); PG8_STAGE(PG8_SA(1, 0), a3, voffA);
            PG8_WAIT_V(8); PG8_WAIT_L(0); PG8_BAR; PG8_MMA(1, 0, At, B0); PG8_MMA(1, 1, At, B1); PG8_BAR; PG8_SCHED;
        }
        if (wr == 0) PG8_BAR;
        { const int el = my_lane(); E(acc, cur, wr, wc, el & 15, el >> 4); }
        if (!has_next) break;
#pragma unroll
        for (int a = 0; a < 2; ++a)
#pragma unroll
            for (int b = 0; b < 2; ++b)
#pragma unroll
                for (int m = 0; m < 4; ++m)
#pragma unroll
                    for (int n = 0; n < 2; ++n) acc[a][b][m][n] = (f32x4){0.f, 0.f, 0.f, 0.f};
        cur = nxt; cA = nA; cB = nB; ++ui;
        if (wr == 1) PG8_BAR;
    }
    PG8_WAIT_V(0);
    PG8_BAR;
#undef PG8_SA
#undef PG8_SB
#undef PG8_STAGE
#undef PG8_LDA
#undef PG8_LDB
#undef PG8_MMA
#undef PG8_WAIT_V
#undef PG8_WAIT_L
#undef PG8_BAR
#undef PG8_SCHED
}
}
using pg8::Unit;

DI unsigned cvt_pk_bf16(float lo, float hi) { unsigned r; asm volatile("s_nop 1\n\tv_cvt_pk_bf16_f32 %0, %1, %2" : "=v"(r) : "v"(lo), "v"(hi)); return r; }
DI u32x4 pack8(const f32x4& v0, const f32x4& v1) { u32x4 w; w.x = cvt_pk_bf16(v0[0], v0[1]); w.y = cvt_pk_bf16(v0[2], v0[3]); w.z = cvt_pk_bf16(v1[0], v1[1]); w.w = cvt_pk_bf16(v1[2], v1[3]); return w; }

struct SchedP1 {
    const char* A; const char* B; int G, c;
    DI bool next(int i, Unit& u) const {
        constexpr int nM = 128, nN = 26, nwg = nM * nN, NXCD = 8, WGM = 8;
        const long L = (long)i * G + c; if (L >= nwg) return false;
        int wgid = (int)L; { const int q = nwg / NXCD, r = nwg % NXCD, xcd = wgid % NXCD, off = wgid / NXCD; wgid = (xcd < r ? xcd * (q + 1) : r * (q + 1) + (xcd - r) * q) + off; }
        const int nig = WGM * nN, gid = wgid / nig, fm = gid * WGM, gsz = (nM - fm) < WGM ? (nM - fm) : WGM;
        u.pm = fm + ((wgid % nig) % gsz); u.pn = (wgid % nig) / gsz; u.aux = 0; u.pad = 0;
        u.a = A + (size_t)u.pm * 256 * 1024 * 2; u.b = B + (size_t)u.pn * 256 * 1024 * 2; return true;
    }
};
struct SchedP3a {
    const char* ys; const char* wbr; int G, c;
    DI bool next(int i, Unit& u) const {
        const int tile = (i >> 2) * G + c; if (tile >= 512) return false;
        const int br = i & 3; u.pm = tile >> 2; u.pn = tile & 3; u.aux = br; u.pad = 0;
        u.a = ys + ((size_t)u.pm * 256 * 1024 + br * 256) * 2; u.b = wbr + ((size_t)br * 1024 * 256 + (size_t)u.pn * 256 * 256) * 2; return true;
    }
};
struct SchedP3b {
    const char* A; const char* B; int G, c;
    DI bool next(int i, Unit& u) const {
        const int L = i * G + c; if (L >= 512) return false;
        u.pm = L >> 2; u.pn = L & 3; u.aux = 0; u.pad = 0;
        u.a = A + (size_t)u.pm * 256 * 1024 * 2; u.b = B + (size_t)u.pn * 256 * 1024 * 2; return true;
    }
};
struct SchedM2 {
    const char* xs; const char* wgu; const LAS int* offt; int G, c;
    DI bool next(int i, Unit& u) const {
        const int NT = __builtin_amdgcn_readfirstlane(offt[32]) >> 8; const int L = i * G + c; if (L >= NT * 2) return false;
        const int rt = L >> 1, pn = L & 1; const int e = __builtin_amdgcn_readfirstlane(offt[40 + rt]);
        u.pm = rt; u.pn = pn; u.aux = e; u.pad = 0;
        u.a = xs + (size_t)rt * 256 * 1024 * 2; u.b = wgu + ((size_t)e * 512 + pn * 256) * 1024 * 2; return true;
    }
};
struct SchedM3 {
    const char* hmid; const char* wd; const LAS int* offt; int G, c;
    DI bool next(int i, Unit& u) const {
        const int NT = __builtin_amdgcn_readfirstlane(offt[32]) >> 8; const int L = i * G + c; if (L >= NT * 4) return false;
        const int rt = L >> 2, pn = L & 3; const int e = __builtin_amdgcn_readfirstlane(offt[40 + rt]);
        u.pm = rt; u.pn = pn; u.aux = e; u.pad = 0;
        u.a = hmid + (size_t)rt * 256 * 256 * 2; u.b = wd + ((size_t)e * 1024 + pn * 256) * 256 * 2; return true;
    }
};

struct EpiP1 {
    bf16* proj; bf16* gates; const float* bgate;
    DI void operator()(const f32x4 (&acc)[2][2][4][2], const Unit& u, int wr, int wc, int fr, int fq) const {
        const int row0 = u.pm * 256 + wr * 64 + fr; const int colt = u.pn * 256 + wc * 32 + 8 * fq;
        if (u.pn < 10) {
#pragma unroll
            for (int ai = 0; ai < 2; ++ai)
#pragma unroll
                for (int m = 0; m < 4; ++m) { bf16* rowp = proj + (size_t)(row0 + ai * 128 + m * 16) * PLD + colt;
#pragma unroll
                    for (int bj = 0; bj < 2; ++bj) *(u32x4*)(rowp + bj * 128) = pack8(acc[ai][bj][m][0], acc[ai][bj][m][1]); }
        } else {
            const int gcol = colt - 2560;
            f32x4 bv[2][2];
#pragma unroll
            for (int bj = 0; bj < 2; ++bj)
#pragma unroll
                for (int n = 0; n < 2; ++n) bv[bj][n] = *(const f32x4*)(bgate + gcol + bj * 128 + 4 * n);
#pragma unroll
            for (int ai = 0; ai < 2; ++ai)
#pragma unroll
                for (int m = 0; m < 4; ++m) { bf16* rowp = gates + (size_t)(row0 + ai * 128 + m * 16) * GLD + gcol;
#pragma unroll
                    for (int bj = 0; bj < 2; ++bj) { f32x4 v0 = acc[ai][bj][m][0] + bv[bj][0], v1 = acc[ai][bj][m][1] + bv[bj][1];
#pragma unroll
                        for (int e = 0; e < 4; ++e) { v0[e] = sigmoidf_(v0[e]); v1[e] = sigmoidf_(v1[e]); }
                        *(u32x4*)(rowp + bj * 128) = pack8(v0, v1); }
                    __builtin_amdgcn_sched_barrier(0); }
        }
    }
};
struct EpiP3a {
    bf16* merged; const bf16* gates;
    DI void operator()(const f32x4 (&acc)[2][2][4][2], const Unit& u, int wr, int wc, int fr, int fq) const {
        const int row0 = u.pm * 256 + wr * 64 + fr; const int colt = u.pn * 256 + wc * 32 + 8 * fq; const int br = u.aux;
#pragma unroll
        for (int ai = 0; ai < 2; ++ai)
#pragma unroll
            for (int m = 0; m < 4; ++m) { const size_t row = (size_t)(row0 + ai * 128 + m * 16);
#pragma unroll
                for (int bj = 0; bj < 2; ++bj) {
                    const u32x4 gw = *(const u32x4*)(gates + row * GLD + br * 1024 + colt + bj * 128);
                    bf16* mp = merged + row * 1024 + colt + bj * 128;
                    f32x4 v0 = acc[ai][bj][m][0], v1 = acc[ai][bj][m][1];
                    v0[0] *= lo_bf(gw.x); v0[1] *= hi_bf(gw.x); v0[2] *= lo_bf(gw.y); v0[3] *= hi_bf(gw.y);
                    v1[0] *= lo_bf(gw.z); v1[1] *= hi_bf(gw.z); v1[2] *= lo_bf(gw.w); v1[3] *= hi_bf(gw.w);
                    if (br != 0) { const u32x4 mw = *(const u32x4*)mp;
                        v0[0] += lo_bf(mw.x); v0[1] += hi_bf(mw.x); v0[2] += lo_bf(mw.y); v0[3] += hi_bf(mw.y);
                        v1[0] += lo_bf(mw.z); v1[1] += hi_bf(mw.z); v1[2] += lo_bf(mw.w); v1[3] += hi_bf(mw.w); }
                    *(u32x4*)mp = pack8(v0, v1); }
                __builtin_amdgcn_sched_barrier(0); }
    }
};
struct EpiP3b {
    const float* xin; float* out;
    DI void operator()(const f32x4 (&acc)[2][2][4][2], const Unit& u, int wr, int wc, int fr, int fq) const {
        const int row0 = u.pm * 256 + wr * 64 + fr; const int colt = u.pn * 256 + wc * 32 + 8 * fq;
#pragma unroll
        for (int ai = 0; ai < 2; ++ai)
#pragma unroll
            for (int m = 0; m < 4; ++m) { const size_t off = (size_t)(row0 + ai * 128 + m * 16) * 1024 + colt;
#pragma unroll
                for (int bj = 0; bj < 2; ++bj)
#pragma unroll
                    for (int n = 0; n < 2; ++n) { const f32x4 xv = *(const f32x4*)(xin + off + bj * 128 + 4 * n); *(f32x4*)(out + off + bj * 128 + 4 * n) = xv + acc[ai][bj][m][n]; }
                __builtin_amdgcn_sched_barrier(0); }
    }
};
struct EpiM2 {
    bf16* hmid;
    DI void operator()(const f32x4 (&acc)[2][2][4][2], const Unit& u, int wr, int wc, int fr, int fq) const {
        const int row0 = u.pm * 256 + wr * 64 + fr; const int col = u.pn * 128 + wc * 32 + 8 * fq;
#pragma unroll
        for (int ai = 0; ai < 2; ++ai)
#pragma unroll
            for (int m = 0; m < 4; ++m) { f32x4 h0, h1;
#pragma unroll
                for (int e = 0; e < 4; ++e) { const float g0 = acc[ai][0][m][0][e], g1 = acc[ai][0][m][1][e];
                    h0[e] = g0 * sigmoidf_(g0) * acc[ai][1][m][0][e]; h1[e] = g1 * sigmoidf_(g1) * acc[ai][1][m][1][e]; }
                *(u32x4*)(hmid + (size_t)(row0 + ai * 128 + m * 16) * 256 + col) = pack8(h0, h1); }
    }
};
struct EpiM3 {
    bf16* eo; const int* rowtok; const float* roww;
    DI void operator()(const f32x4 (&acc)[2][2][4][2], const Unit& u, int wr, int wc, int fr, int fq) const {
        const int row0 = u.pm * 256 + wr * 64 + fr; const int colt = u.pn * 256 + wc * 32 + 8 * fq;
#pragma unroll
        for (int ai = 0; ai < 2; ++ai)
#pragma unroll
            for (int m = 0; m < 4; ++m) { const int row = row0 + ai * 128 + m * 16; const int tk = rowtok[row];
                if (tk >= 0) { const float w = roww[row]; bf16* op = eo + (size_t)tk * 1024 + colt;
#pragma unroll
                    for (int bj = 0; bj < 2; ++bj) *(u32x4*)(op + bj * 128) = pack8(acc[ai][bj][m][0] * w, acc[ai][bj][m][1] * w); }
                __builtin_amdgcn_sched_barrier(0); }
    }
};

struct Args { const float* in[36]; float* out; unsigned char* ws; int ph_lo, ph_hi; };
struct InTab { unsigned base;
    DI const float* operator[](int i) const { unsigned long long v; const unsigned addr = base + (unsigned)i * 8u;
        asm volatile("ds_read_b64 %0, %1\n\ts_waitcnt lgkmcnt(0)" : "=v"(v) : "v"(addr) : "memory");
        const unsigned lo = __builtin_amdgcn_readfirstlane((unsigned)v), hi = __builtin_amdgcn_readfirstlane((unsigned)(v >> 32));
        return (const float*)(((unsigned long long)hi << 32) | lo); } };
struct KA { InTab in; float* out; unsigned char* ws; };

DI void transpose_item(const float* W, int ldw, int nvalid, bf16* WT, int ldt, int k0, int n0, int dst_row0, LAS float* scr, int lane) {
    const bool nok = (n0 + (lane & 31)) < nvalid;
#pragma unroll 8
    for (int i = 0; i < 32; ++i) { const int kk = 2 * i + (lane >> 5); scr[kk * 33 + (lane & 31)] = nok ? W[(size_t)(k0 + kk) * ldw + n0 + (lane & 31)] : 0.f; }
    LDS_WAIT(); asm volatile("" ::: "memory");
    const int c = lane & 7;
#pragma unroll
    for (int j = 0; j < 4; ++j) { const int n = (lane >> 3) + 8 * j; const LAS float* s = scr + (8 * c) * 33 + n;
        u32x4 o; o.x = pk2(s[0 * 33], s[1 * 33]); o.y = pk2(s[2 * 33], s[3 * 33]); o.z = pk2(s[4 * 33], s[5 * 33]); o.w = pk2(s[6 * 33], s[7 * 33]);
        if (n0 + n < nvalid) *(u32x4*)(WT + (size_t)(dst_row0 + n) * ldt + k0 + 8 * c) = o; }
    LDS_WAIT(); asm volatile("" ::: "memory");
}
DI void phase0_weights(const KA& a, int l, LAS unsigned char* lds, int gw, int NGW, int wave, int lane) {
    LAS float* scr = (LAS float*)(lds + wave * 16384);
    const float* w_in = a.in[4] + (size_t)l * 1024 * NIN;
    const float* w_gate = a.in[24] + (size_t)l * 4 * 1024 * 1024;
    const float* w_br = a.in[26] + (size_t)l * 4 * 256 * 1024;
    const float* w_out = a.in[27] + (size_t)l * 1024 * 1024;
    bf16* Wt_in = (bf16*)(a.ws + WS_WIN); bf16* Wt_br = (bf16*)(a.ws + WS_WBR); bf16* Wt_out = (bf16*)(a.ws + WS_WOUT);
    constexpr int I_IN = 16 * 77, I_G = 4 * 16 * 32, I_B = 4 * 4 * 32, I_O = 16 * 32, NIT = I_IN + I_G + I_B + I_O;
    for (int it = gw; it < NIT; it += NGW) {
        int r = it;
        if (r < I_IN) { const int kb = r / 77, nb = r % 77; transpose_item(w_in, NIN, NIN, Wt_in, 1024, kb * 64, nb * 32, nb * 32, scr, lane); continue; } r -= I_IN;
        if (r < I_G) { const int br = r / 512, q = r % 512, kb = q / 32, nb = q % 32; transpose_item(w_gate + (size_t)br * 1024 * 1024, 1024, 1024, Wt_in, 1024, kb * 64, nb * 32, 2560 + br * 1024 + nb * 32, scr, lane); continue; } r -= I_G;
        if (r < I_B) { const int br = r / 128, q = r % 128, kb = q / 32, nb = q % 32; transpose_item(w_br + (size_t)br * 256 * 1024, 1024, 1024, Wt_br + (size_t)br * 1024 * 256, 256, kb * 64, nb * 32, nb * 32, scr, lane); continue; } r -= I_B;
        { const int kb = r / 32, nb = r % 32; transpose_item(w_out, 1024, 1024, Wt_out, 1024, kb * 64, nb * 32, nb * 32, scr, lane); }
    }
}

DI void router_weights(const KA& a, int l, int gw, int NGW, int lane) {
    bf16* Wr = (bf16*)(a.ws + WS_WR);
    const float* wg = a.in[29] + (size_t)l * 1024 * 4; const float* we = a.in[31] + (size_t)l * 1024 * 32;
    for (int n = gw; n < 36; n += NGW) {
        for (int i = 0; i < 16; ++i) { const int k = lane + 64 * i; const float w = (n < 4) ? wg[k * 4 + n] : we[k * 32 + (n - 4)];
            const unsigned hi = f2bf(w); const float hf = __builtin_bit_cast(float, hi << 16); const unsigned lo = f2bf(w - hf);
            Wr[(size_t)n * 2048 + k] = (bf16)hi; Wr[(size_t)n * 2048 + 1024 + k] = (bf16)hi; Wr[(size_t)(64 + n) * 2048 + k] = (bf16)lo; Wr[(size_t)(64 + n) * 2048 + 1024 + k] = 0; }
    }
}

DI void cmp_weights(const KA& a, int l, LAS unsigned char* lds, int gw, int NGW, int wave, int lane) {
    LAS float* scr = (LAS float*)(lds + wave * 16384);
    bf16* Wc = (bf16*)(a.ws + WS_WCMP); float* pt = (float*)(a.ws + WS_CMPAB + 2 * MiB);
    for (int it = gw; it < 2 * 32 * 2 + 2; it += NGW) {
        if (it < 128) { const int kv = it >> 6, q = it & 63, kb = q >> 1, nb = q & 1; const float* w1 = a.in[kv ? 22 : 19] + (size_t)l * 2048 * 64;
            bf16* dst = Wc + (size_t)kv * 256 * 1024 - (kb >= 16 ? 1024 : 0);
            transpose_item(w1, 64, 64, dst, 1024, kb * 64, nb * 32, (kb >= 16 ? 64 : 0) + nb * 32, scr, lane);
        } else { const int kv = it - 128; const float* w1 = a.in[kv ? 22 : 19] + (size_t)l * 2048 * 64; const float* pos = a.in[kv ? 21 : 18] + (size_t)l * 2048;
            float acc = 0.f;
            for (int k = 0; k < 2048; ++k) acc += pos[k] * w1[(size_t)k * 64 + lane];
            pt[kv * 64 + lane] = acc; }
    }
}

DI void lru_weights(const KA& a, int l, int gw, int NGW, int lane) {
    bf16* W = (bf16*)(a.ws + WS_LRUW); const float* wa = a.in[7] + (size_t)l * 4 * 4096; const float* wx = a.in[9] + (size_t)l * 4 * 4096;
    (void)NGW; { const int idx = gw * 64 + lane; if (idx < 32768) { const int i = idx & 63, j = (idx >> 6) & 63, mat = (idx >> 12) & 1, hbk = idx >> 13;
        W[idx] = (bf16)f2bf((mat ? wx : wa)[(size_t)hbk * 4096 + i * 64 + j]); } }
}
DI void phase0_rows(const KA& a, int l, int mode, int gw, int NGW, int lane) {
    const GAS float* xin = (const GAS float*)((l == 0) ? a.in[0] : a.out);
    const GAS bf16* eo = (const GAS bf16*)(a.ws + WS_PROJ);
    GAS bf16* hb = (GAS bf16*)(a.ws + WS_HB); GAS float* outp = (GAS float*)a.out;
    const GAS float* g = (const GAS float*)(mode ? a.in[2] : (a.in[3] + (size_t)l * 1024));
    f32x4 gv[4];
#pragma unroll
    for (int j = 0; j < 4; ++j) gv[j] = *(const GAS f32x4*)(g + 4 * (lane + 64 * j));
    for (int m0 = gw * 4; m0 < T; m0 += NGW * 4) {
        f32x4 v[4][4]; float ss[4];
#pragma unroll
        for (int rr = 0; rr < 4; ++rr)
#pragma unroll
            for (int j = 0; j < 4; ++j) v[rr][j] = *(const GAS f32x4*)(xin + (size_t)(m0 + rr) * 1024 + 4 * (lane + 64 * j));
        if (l > 0) {
#pragma unroll
            for (int rr = 0; rr < 4; ++rr)
#pragma unroll
                for (int j = 0; j < 4; ++j) {
                    const u32x2 e0 = *(const GAS u32x2*)(eo + (size_t)(2 * (m0 + rr)) * 1024 + 4 * (lane + 64 * j));
                    const u32x2 e1 = *(const GAS u32x2*)(eo + (size_t)(2 * (m0 + rr) + 1) * 1024 + 4 * (lane + 64 * j));
                    v[rr][j][0] += lo_bf(e0.x) + lo_bf(e1.x); v[rr][j][1] += hi_bf(e0.x) + hi_bf(e1.x); v[rr][j][2] += lo_bf(e0.y) + lo_bf(e1.y); v[rr][j][3] += hi_bf(e0.y) + hi_bf(e1.y); } }
#pragma unroll
        for (int rr = 0; rr < 4; ++rr) { float t = 0.f;
#pragma unroll
            for (int j = 0; j < 4; ++j) t += (v[rr][j][0] * v[rr][j][0] + v[rr][j][1] * v[rr][j][1]) + (v[rr][j][2] * v[rr][j][2] + v[rr][j][3] * v[rr][j][3]);
            ss[rr] = t; }
#pragma unroll
        for (int rr = 0; rr < 4; ++rr) ss[rr] = wave_sum(ss[rr]);
#pragma unroll
        for (int rr = 0; rr < 4; ++rr) { const float r = 1.f / sqrtf(ss[rr] * (1.f / 1024.f) + 1e-6f); const size_t m = (size_t)(m0 + rr);
#pragma unroll
            for (int j = 0; j < 4; ++j) { const f32x4 y = v[rr][j] * r * gv[j];
                if (mode) *(GAS f32x4*)(outp + m * 1024 + 4 * (lane + 64 * j)) = y;
                else { if (l > 0) *(GAS f32x4*)(outp + m * 1024 + 4 * (lane + 64 * j)) = v[rr][j];
                       u32x2 w; w.x = pk2(y[0], y[1]); w.y = pk2(y[2], y[3]); *(GAS u32x2*)(hb + m * 1024 + 4 * (lane + 64 * j)) = w; } } }
    }
}

DI int crow(int i, int hh) { return (i & 3) + 8 * (i >> 2) + 4 * hh; }
DI unsigned cvtpk(float lo, float hi) { f32x2 v = {lo, hi}; bf16x2_t b = __builtin_convertvector(v, bf16x2_t); return __builtin_bit_cast(unsigned, b); }
template <int CTRL, int RMASK> DI float dppf(float oldv, float v) { return __builtin_bit_cast(float, __builtin_amdgcn_update_dpp(__builtin_bit_cast(int, oldv), __builtin_bit_cast(int, v), CTRL, RMASK, 0xf, false)); }
template <int CTRL, int RMASK> DI void scan_step(float& a, float& b) {
    const float ap = dppf<CTRL, RMASK>(1.f, a), bp = dppf<CTRL, RMASK>(0.f, b); b = a * bp + b; a = a * ap; }
DI void lru_unit(const KA& a, int l, const GAS bf16* proj, GAS bf16* ys, GAS float* sums, LAS unsigned char* lds, int task, int lane_in, int wave_in, bool final) {
    int lane = lane_in, wave = wave_in; asm volatile("" : "+v"(lane), "+s"(wave));
    const int chunk = task & 31, hbk = (task >> 5) & 3, b = task >> 7;
    const int ts = chunk * 256 + wave * 32; const size_t rowb = (size_t)b * SEQ;
    LAS unsigned char* wl = lds + wave * 16384;
    LAS float* ex = (LAS float*)(lds + LRUEX_OFF); LAS float* cst = (LAS float*)(lds + LRUCST_OFF); LAS float* car = (LAS float*)(lds + LRUCAR_OFF) + wave * 64;
    {
        const int c = hbk * 64 + lane;
        const GAS float* cw = (const GAS float*)(a.in[5] + (size_t)l * 4 * 256);
        const float cw0 = cw[c], cw1 = cw[256 + c], cw2 = cw[512 + c], cw3 = cw[768 + c]; const float cb = a.in[6][l * 256 + c];
        if (wave == 0) { cst[lane] = a.in[8][l * 256 + c]; cst[64 + lane] = a.in[10][l * 256 + c]; cst[128 + lane] = -8.f * softplusf_(-a.in[11][l * 256 + c]); }
        const GAS bf16* xp = proj + (rowb + ts) * PLD + C_AX + c;
        float x3 = (ts >= 3) ? bf2f(*(xp - 3 * PLD)) : 0.f, x2 = (ts >= 2) ? bf2f(*(xp - 2 * PLD)) : 0.f, x1 = (ts >= 1) ? bf2f(*(xp - PLD)) : 0.f;
#pragma unroll 8
        for (int n = 0; n < 32; ++n) { const float x0 = bf2f(xp[(size_t)n * PLD]); const float xc = cb + cw0 * x3 + cw1 * x2 + cw2 * x1 + cw3 * x0;
            *(LAS bf16*)(wl + n * 144 + lane * 2) = (bf16)f2bf(xc); *(LAS float*)(wl + 4608 + n * 272 + lane * 4) = xc; x3 = x2; x2 = x1; x1 = x0; }
    }
    const int n = lane & 31, hh = lane >> 5;
    f32x16 D[4];
    {
        const GAS bf16* wt = (const GAS bf16*)(a.ws + WS_LRUW) + (size_t)hbk * 8192;
        bf16x8 bfr[4];
        LDS_WAIT();
#pragma unroll
        for (int s4 = 0; s4 < 4; ++s4) bfr[s4] = *(const LAS bf16x8*)(wl + n * 144 + hh * 16 + s4 * 32);
#pragma unroll
        for (int m = 0; m < 4; ++m) {
#pragma unroll
            for (int s4 = 0; s4 < 4; ++s4) { const bf16x8 af = *(const GAS bf16x8*)(wt + (size_t)(m >> 1) * 4096 + (32 * (m & 1) + n) * 64 + 8 * hh + 16 * s4);
                if (s4 == 0) { f32x16 z;
#pragma unroll
                    for (int i = 0; i < 16; ++i) z[i] = 0.f;
                    D[m] = MFMA32(af, bfr[s4], z); } else D[m] = MFMA32(af, bfr[s4], D[m]); } }
    }
    __syncthreads();
    const bool t0 = (ts + n) == 0;
#pragma unroll
    for (int mm = 0; mm < 2; ++mm)
#pragma unroll
        for (int g4 = 0; g4 < 4; ++g4) { const int c0 = 32 * mm + 8 * g4 + 4 * hh;
            const f32x4 vba = *(const LAS f32x4*)(cst + c0), vbx = *(const LAS f32x4*)(cst + 64 + c0), vc8 = *(const LAS f32x4*)(cst + 128 + c0);
            const f32x4 vxc = *(const LAS f32x4*)(wl + 4608 + n * 272 + c0 * 4);
#pragma unroll
            for (int e = 0; e < 4; ++e) { const int i = 4 * g4 + e;
                const float r = sigmoidf_(D[mm][i] + vba[e]), ig = sigmoidf_(D[2 + mm][i] + vbx[e]);
                const float la = vc8[e] * r; const float av = __expf(la);
                const float mult = t0 ? 1.f : sqrtf(fmaxf(1.f - __expf(2.f * la), 0.f));
                float aa = av, bb = mult * ig * vxc[e];
                scan_step<0x111, 0xf>(aa, bb); scan_step<0x112, 0xf>(aa, bb); scan_step<0x114, 0xf>(aa, bb); scan_step<0x118, 0xf>(aa, bb); scan_step<0x142, 0xa>(aa, bb);
                D[mm][i] = aa; D[2 + mm][i] = bb; } }
    if (n == 31) {
#pragma unroll
        for (int mm = 0; mm < 2; ++mm)
#pragma unroll
            for (int i = 0; i < 16; ++i) { const int c = 32 * mm + crow(i, hh); ex[(wave * 64 + c) * 2] = D[mm][i]; ex[(wave * 64 + c) * 2 + 1] = D[2 + mm][i]; } }
    __syncthreads();
    if (!final) {
        if (wave == 0) { float hv = 0.f, av = 1.f;
#pragma unroll
            for (int w = 0; w < 8; ++w) { const float A_ = ex[(w * 64 + lane) * 2], H_ = ex[(w * 64 + lane) * 2 + 1]; hv = A_ * hv + H_; av *= A_; }
            GAS float* sp = sums + ((size_t)((b * 4 + hbk) * 32 + chunk) * 64 + lane) * 2; sp[0] = av; sp[1] = hv; }
    } else {
        {   float hv = 0.f;
            for (int cc = 0; cc < chunk; ++cc) { const GAS float* sp = sums + ((size_t)((b * 4 + hbk) * 32 + cc) * 64 + lane) * 2; hv = sp[0] * hv + sp[1]; }
            for (int w = 0; w < wave; ++w) { const float A_ = ex[(w * 64 + lane) * 2], H_ = ex[(w * 64 + lane) * 2 + 1]; hv = A_ * hv + H_; }
            car[lane] = hv; }
        LDS_WAIT(); asm volatile("" ::: "memory");
        const GAS bf16* gp = proj + (rowb + ts + n) * PLD + C_AG + hbk * 64; GAS bf16* yp = ys + (rowb + ts + n) * 1024 + hbk * 64;
#pragma unroll
        for (int mm = 0; mm < 2; ++mm)
#pragma unroll
            for (int g4 = 0; g4 < 4; ++g4) { const int c0 = 32 * mm + 8 * g4 + 4 * hh; const f32x4 cv = *(const LAS f32x4*)(car + c0);
                float y[4];
#pragma unroll
                for (int e = 0; e < 4; ++e) { const int i = 4 * g4 + e; const float hv = D[2 + mm][i] + D[mm][i] * cv[e];
                    const float gt = bf2f(gp[c0 + e]); y[e] = hv * gelu_tanh(gt); }
#pragma unroll
                for (int e = 0; e < 4; ++e) yp[c0 + e] = (bf16)f2bf(y[e]); }
    }
    __syncthreads();
}

constexpr int DK_STR = 144, DV_STR = 192, DBUF_BYTES = 64 * DK_STR + 64 * DV_STR;
DI bf16x8 pack_half(const f32x16& x, int s2) { u32x4 p;
    if (s2 == 0) { p.x = cvtpk(x[0], x[1]); p.y = cvtpk(x[2], x[3]); p.z = cvtpk(x[4], x[5]); p.w = cvtpk(x[6], x[7]); }
    else { p.x = cvtpk(x[8], x[9]); p.y = cvtpk(x[10], x[11]); p.z = cvtpk(x[12], x[13]); p.w = cvtpk(x[14], x[15]); }
    return __builtin_bit_cast(bf16x8, p); }
DI s16x4 vtr(const LAS unsigned char* p) { return __builtin_bit_cast(s16x4, __builtin_amdgcn_ds_read_tr16_b64_v4i16((LAS v4i16_t*)p)); }
DI float max16(const f32x16& x) { float a = fmaxf(fmaxf(x[0], x[1]), fmaxf(x[2], x[3])), b = fmaxf(fmaxf(x[4], x[5]), fmaxf(x[6], x[7])), c = fmaxf(fmaxf(x[8], x[9]), fmaxf(x[10], x[11])), d = fmaxf(fmaxf(x[12], x[13]), fmaxf(x[14], x[15])); return fmaxf(fmaxf(a, b), fmaxf(c, d)); }
DI void diff_unit(const GAS bf16* proj, GAS bf16* ys, LAS unsigned char* lds, const LAS float* bias2, const GAS float* subg, const LAS float* lamp, int b, int h, int qb, int wave_in) {
    int wave = wave_in; asm volatile("" : "+s"(wave)); const int lane = my_lane(); const int tid = wave * 64 + lane;
    const int q0 = qb * 256 + wave * 32; const int ql = lane & 31, hh = lane >> 5; const int q = q0 + ql;
    const size_t rowb = (size_t)b * SEQ;
    const float SC = 0.17677669529663687f * 1.4426950408889634f;
    bf16x8 qf[2][2];
    { const GAS bf16* qp = proj + (rowb + q) * PLD + C_CQ + h * 64 + hh * 8;
#pragma unroll
      for (int m = 0; m < 2; ++m)
#pragma unroll
        for (int s = 0; s < 2; ++s) { const u32x4 w = *(const GAS u32x4*)(qp + m * 32 + s * 16); u32x4 o;
            o.x = cvtpk(lo_bf(w.x) * SC, hi_bf(w.x) * SC); o.y = cvtpk(lo_bf(w.y) * SC, hi_bf(w.y) * SC); o.z = cvtpk(lo_bf(w.z) * SC, hi_bf(w.z) * SC); o.w = cvtpk(lo_bf(w.w) * SC, hi_bf(w.w) * SC);
            qf[m][s] = __builtin_bit_cast(bf16x8, o); } }
    f32x16 O[2][2], negm[2];
#pragma unroll
    for (int i = 0; i < 16; ++i) { O[0][0][i] = 0.f; O[0][1][i] = 0.f; O[1][0][i] = 0.f; O[1][1][i] = 0.f; negm[0][i] = 120.f; negm[1][i] = 120.f; }
    float lsum[2] = {0.f, 0.f};
    const int nsteps = 4 * qb + 4, mysteps = 4 * qb + (wave >> 1) + 1;
    const int skey = tid >> 3, sch = tid & 7;
    const GAS unsigned char* kgb = (const GAS unsigned char*)(proj + rowb * PLD + C_CK + h * 64);
    const GAS unsigned char* vgb = (const GAS unsigned char*)(proj + rowb * PLD + C_CV + h * 64);
    const unsigned soff = (unsigned)(skey * PLD + sch * 8) * 2u;
    u32x4 kr = *(const GAS u32x4*)(kgb + soff), vr = *(const GAS u32x4*)(vgb + soff);
    *(LAS u32x4*)(lds + skey * DK_STR + sch * 16) = kr; *(LAS u32x4*)(lds + 64 * DK_STR + skey * DV_STR + sch * 16) = vr;
    __syncthreads();
    const int i16 = lane & 15, blk = (lane >> 4) & 1;
    const int kboff = ql * DK_STR + hh * 16;
    const int vboff = 64 * DK_STR + (4 * hh + (i16 >> 2)) * DV_STR + (16 * blk + 4 * (i16 & 3)) * 2;
#pragma unroll 1
    for (int kt = 0; kt < nsteps; ++kt) {
        const LAS unsigned char* cur = lds + (kt & 1) * DBUF_BYTES; LAS unsigned char* nxt = lds + ((kt + 1) & 1) * DBUF_BYTES;
        if (kt + 1 < nsteps) { const unsigned so = soff + (unsigned)(kt + 1) * (64u * PLD * 2u); kr = *(const GAS u32x4*)(kgb + so); vr = *(const GAS u32x4*)(vgb + so); }
        if (kt < mysteps) {
            const int kbase = kt * 64;
            const bool near = (q0 - (kbase + 63) < 113);
#pragma unroll
            for (int m = 0; m < 2; ++m) {
                bf16x8 pk[2][2];
                f32x16 S[2]; float ts = 0.f;
                {   bf16x8 kf[2][2];
#pragma unroll
                    for (int t = 0; t < 2; ++t)
#pragma unroll
                        for (int s = 0; s < 2; ++s) kf[t][s] = *(const LAS bf16x8*)(cur + kboff + t * 32 * DK_STR + m * 64 + s * 32);
#pragma unroll
                    for (int t = 0; t < 2; ++t) { S[t] = MFMA32(kf[t][0], qf[m][0], negm[m]); S[t] = MFMA32(kf[t][1], qf[m][1], S[t]); } }
                if (near) {
#pragma unroll
                    for (int t = 0; t < 2; ++t)
#pragma unroll
                        for (int i = 0; i < 16; ++i) { const int dist = q - (kbase + 32 * t + crow(i, hh)); const int di = dist < 128 ? dist : 128;
                            const float bv = dist >= 0 ? bias2[di * 12 + 4 + h] : -1e30f; S[t][i] += bv; } }
#pragma unroll
                for (int t = 0; t < 2; ++t)
#pragma unroll
                    for (int i = 0; i < 16; ++i) { const float p = __builtin_amdgcn_exp2f(S[t][i]); S[t][i] = p; ts += p; }
                if (__builtin_amdgcn_ballot_w64(!(ts < 1.0e30f)) != 0ull) {
                {   bf16x8 kf[2][2];
#pragma unroll
                        for (int t = 0; t < 2; ++t)
#pragma unroll
                            for (int s = 0; s < 2; ++s) kf[t][s] = *(const LAS bf16x8*)(cur + kboff + t * 32 * DK_STR + m * 64 + s * 32);
#pragma unroll
                        for (int t = 0; t < 2; ++t) { S[t] = MFMA32(kf[t][0], qf[m][0], negm[m]); S[t] = MFMA32(kf[t][1], qf[m][1], S[t]); } }
                    if (near) {
#pragma unroll
                        for (int t = 0; t < 2; ++t)
#pragma unroll
                            for (int i = 0; i < 16; ++i) { const int dist = q - (kbase + 32 * t + crow(i, hh)); const int di = dist < 128 ? dist : 128;
                                const float bv = dist >= 0 ? bias2[di * 12 + 4 + h] : -1e30f; S[t][i] += bv; } }
                    float tm = fmaxf(max16(S[0]), max16(S[1])); tm = fmaxf(tm, xshfl<32>(tm));
                    const float sh = fmaxf(tm, 0.f); const float al = __builtin_amdgcn_exp2f(-sh);
                    lsum[m] *= al; ts = 0.f;
#pragma unroll
                    for (int i = 0; i < 16; ++i) { O[m][0][i] *= al; O[m][1][i] *= al; negm[m][i] -= sh; }
#pragma unroll
                    for (int t = 0; t < 2; ++t)
#pragma unroll
                        for (int i = 0; i < 16; ++i) { const float p = __builtin_amdgcn_exp2f(S[t][i] - sh); S[t][i] = p; ts += p; }
                }
                lsum[m] += ts;
#pragma unroll
                for (int t = 0; t < 2; ++t) { pk[t][0] = pack_half(S[t], 0); pk[t][1] = pack_half(S[t], 1); }
#pragma unroll
                for (int t = 0; t < 2; ++t)
#pragma unroll
                    for (int s2 = 0; s2 < 2; ++s2)
#pragma unroll
                        for (int db = 0; db < 2; ++db) {
                            const s16x4 lo = vtr(cur + vboff + (32 * t + 16 * s2) * DV_STR + db * 64), hi = vtr(cur + vboff + (32 * t + 16 * s2 + 8) * DV_STR + db * 64);
                            const bf16x8 vf = __builtin_shufflevector(lo, hi, 0, 1, 2, 3, 4, 5, 6, 7);
                            O[m][db] = MFMA32(vf, pk[t][s2], O[m][db]); }
                ;
            }
        }
        if (kt + 1 < nsteps) { *(LAS u32x4*)(nxt + skey * DK_STR + sch * 16) = kr; *(LAS u32x4*)(nxt + 64 * DK_STR + skey * DV_STR + sch * 16) = vr; }
        __syncthreads();
    }
    const float l0 = lsum[0] + xshfl<32>(lsum[0]), l1 = lsum[1] + xshfl<32>(lsum[1]);
    const float lam = lamp[0], lam_init = lamp[1];
    const float i0 = 1.f / fmaxf(l0, 1e-30f), i1 = lam / fmaxf(l1, 1e-30f);
    float ss = 0.f;
#pragma unroll
    for (int db = 0; db < 2; ++db)
#pragma unroll
        for (int i = 0; i < 16; ++i) { const float at = O[0][db][i] * i0 - O[1][db][i] * i1; O[0][db][i] = at; ss += at * at; }
    ss += xshfl<32>(ss);
    const float r = (1.f - lam_init) / sqrtf(ss * (1.f / 64.f) + 1e-5f);
    GAS bf16* op = ys + (rowb + q) * 1024 + 512 + h * 64;
#pragma unroll
    for (int db = 0; db < 2; ++db)
#pragma unroll
        for (int gq = 0; gq < 4; ++gq) { const int d0 = 32 * db + 8 * gq + 4 * hh; const f32x4 sg = *(const GAS f32x4*)(subg + d0);
            u32x2 w; w.x = cvtpk(O[0][db][4 * gq + 0] * r * sg[0], O[0][db][4 * gq + 1] * r * sg[1]); w.y = cvtpk(O[0][db][4 * gq + 2] * r * sg[2], O[0][db][4 * gq + 3] * r * sg[3]);
            *(GAS u32x2*)(op + d0) = w; }
}

struct SchedCmp { const char* proj; const char* wc; int G, c;
    DI bool next(int i, Unit& u) const { const int L = i * G + c; if (L >= 16) return false; const int kv = L >> 3, rt = L & 7;
        u.pm = rt; u.pn = 0; u.aux = kv; u.pad = 0; u.a = proj + ((size_t)rt * 256 * 16 * PLD + (kv ? C_VC : C_KC)) * 2; u.b = wc + (size_t)kv * 256 * 1024 * 2; return true; } };
struct EpiCmp { float* ab;
    DI void operator()(const f32x4 (&acc)[2][2][4][2], const Unit& u, int wr, int wc, int fr, int fq) const {
        const int row0 = u.pm * 256 + wr * 64 + fr; const int col = wc * 32 + 8 * fq;
#pragma unroll
        for (int ai = 0; ai < 2; ++ai)
#pragma unroll
            for (int m = 0; m < 4; ++m) { float* rp = ab + ((size_t)u.aux * 2048 + row0 + ai * 128 + m * 16) * 128 + col; *(f32x4*)rp = acc[ai][0][m][0]; *(f32x4*)(rp + 4) = acc[ai][0][m][1]; }
    }
};
DI void cmp_finish(const KA& a, int l, const float* ab, bf16* kcb, int task, int lane) {
    const int kv = task / (BATCH * NCMP), r = task % (BATCH * NCMP), b = r / NCMP, c = r % NCMP;
    const float* w2 = a.in[kv ? 23 : 20] + (size_t)l * 4096; const float* pt = ab + 2 * 2048 * 128;
    const size_t g = (size_t)kv * 2048 + b * 512 + c;
    const float h1 = ab[g * 128 + lane] + ab[(g + 1) * 128 + 64 + lane] + pt[kv * 64 + lane];
    const float gl = gelu_tanh(h1); float o = 0.f;
#pragma unroll
    for (int j = 0; j < 64; ++j) o += rl(gl, j) * w2[j * 64 + lane];
    kcb[((size_t)(kv * BATCH + b) * 512 + c) * 64 + lane] = (bf16)f2bf(o);
    if (c == NCMP - 1) kcb[((size_t)(kv * BATCH + b) * 512 + NCMP) * 64 + lane] = 0;
}

DI void st_load(const GAS unsigned char* kb, const GAS unsigned char* vb, unsigned off, u32x4& kr, u32x4& vr) { kr = *(const GAS u32x4*)(kb + off); vr = *(const GAS u32x4*)(vb + off); }
DI void st_write(LAS unsigned char* buf, int skey, int sch, const u32x4& kr, const u32x4& vr) { *(LAS u32x4*)(buf + skey * DK_STR + sch * 16) = kr; *(LAS u32x4*)(buf + 64 * DK_STR + skey * DV_STR + sch * 16) = vr; }
DI void qk64(const LAS unsigned char* cur, int kboff, const bf16x8 (&qf)[4], const f32x16& cinit, f32x16 (&S)[2]) {
#pragma unroll
    for (int t = 0; t < 2; ++t) { S[t] = cinit;
#pragma unroll
        for (int s = 0; s < 4; ++s) { const bf16x8 kf = *(const LAS bf16x8*)(cur + kboff + t * 32 * DK_STR + s * 32); S[t] = MFMA32(kf, qf[s], S[t]); } }
}
DI void qk32z(const LAS unsigned char* kt32, const bf16x8 (&qf)[4], f32x16& S) {
#pragma unroll
    for (int s = 0; s < 4; ++s) { const bf16x8 kf = *(const LAS bf16x8*)(kt32 + s * 32);
        if (s == 0) { f32x16 z;
#pragma unroll
            for (int i = 0; i < 16; ++i) z[i] = 0.f;
            S = MFMA32(kf, qf[s], z); } else S = MFMA32(kf, qf[s], S); }
}
DI void pv32(const LAS unsigned char* vt32, const bf16x8 (&pk)[2], f32x16 (&O)[2]) {
#pragma unroll
    for (int s2 = 0; s2 < 2; ++s2)
#pragma unroll
        for (int db = 0; db < 2; ++db) {
            const s16x4 lo = vtr(vt32 + (16 * s2) * DV_STR + db * 64), hi = vtr(vt32 + (16 * s2 + 8) * DV_STR + db * 64);
            const bf16x8 vf = __builtin_shufflevector(lo, hi, 0, 1, 2, 3, 4, 5, 6, 7);
            O[db] = MFMA32(vf, pk[s2], O[db]); }
}
DI void mask_bias_cmp32(f32x16& S, int tcol, int cbase, int hh, const LAS float* b2h, float msub) {
#pragma unroll
    for (int i = 0; i < 16; ++i) { const int c = cbase + crow(i, hh); const int dist = tcol - 31 - 16 * c; const bool ok = dist >= 0 && c < NCMP;
        const int di = dist < 0 ? 0 : (dist < 128 ? dist : 128); S[i] = ok ? S[i] + (b2h[di * 12] - msub) : -1e30f; }
}
DI void pv64(const LAS unsigned char* cur, int vboff, const bf16x8 (&pk)[2][2], f32x16 (&O)[2]) {
#pragma unroll
    for (int t = 0; t < 2; ++t)
#pragma unroll
        for (int s2 = 0; s2 < 2; ++s2)
#pragma unroll
            for (int db = 0; db < 2; ++db) {
                const s16x4 lo = vtr(cur + vboff + (32 * t + 16 * s2) * DV_STR + db * 64), hi = vtr(cur + vboff + (32 * t + 16 * s2 + 8) * DV_STR + db * 64);
                const bf16x8 vf = __builtin_shufflevector(lo, hi, 0, 1, 2, 3, 4, 5, 6, 7);
                O[db] = MFMA32(vf, pk[t][s2], O[db]); }
}
DI void softmax_step(f32x16 (&S)[2], f32x16 (&O)[2], f32x16& negm, float& lsum, bf16x8 (&pk)[2][2]) {
    float tm = fmaxf(max16(S[0]), max16(S[1]));
    if (__builtin_amdgcn_ballot_w64(tm > 8.f) != 0ull) {
        tm = fmaxf(tm, xshfl<32>(tm)); const float sh = fmaxf(tm, 0.f); const float al = __builtin_amdgcn_exp2f(-sh);
        lsum *= al;
#pragma unroll
        for (int i = 0; i < 16; ++i) { O[0][i] *= al; O[1][i] *= al; negm[i] -= sh; S[0][i] -= sh; S[1][i] -= sh; } }
#pragma unroll
    for (int t = 0; t < 2; ++t) {
#pragma unroll
        for (int i = 0; i < 16; ++i) { const float p = __builtin_amdgcn_exp2f(S[t][i]); S[t][i] = p; lsum += p; }
        pk[t][0] = pack_half(S[t], 0); pk[t][1] = pack_half(S[t], 1); }
}
DI void mask_bias(f32x16 (&S)[2], int tcol, int kbase, int hh, int W, bool colsel, const LAS float* b2h) {
#pragma unroll
    for (int t = 0; t < 2; ++t)
#pragma unroll
        for (int i = 0; i < 16; ++i) { const int dist = tcol - (kbase + 32 * t + crow(i, hh)); const bool ok = colsel && dist >= 0 && dist < W;
            const int di = dist < 0 ? 0 : (dist < 128 ? dist : 128); S[t][i] = ok ? S[t][i] + b2h[di * 12] : -1e30f; }
}
DI void nsa_unit(const GAS bf16* proj, GAS bf16* ys, const GAS bf16* kcb, LAS unsigned char* lds, const LAS float* bias2, int b, int u, int tid_in, int lane_in, int wave_in) {
    int tid = tid_in, lane = lane_in, wave = wave_in; asm volatile("" : "+v"(tid), "+v"(lane), "+s"(wave));
    const int t0 = u * 64; const int col = lane & 31, hh = lane >> 5, tl = col >> 2, head = col & 3;
    const int t = t0 + wave * 8 + tl; const int tw0 = t0 + wave * 8;
    const size_t rowb = (size_t)b * SEQ;
    const LAS float* b2h = bias2 + 8 + head;
    bf16x8 qf[4];
    { const float SC = 0.125f * 1.4426950408889634f; const GAS bf16* qp = proj + (rowb + t) * PLD + C_DQ + head * 64 + hh * 8;
#pragma unroll
      for (int s = 0; s < 4; ++s) { const u32x4 w = *(const GAS u32x4*)(qp + s * 16); u32x4 o;
          o.x = cvtpk(lo_bf(w.x) * SC, hi_bf(w.x) * SC); o.y = cvtpk(lo_bf(w.y) * SC, hi_bf(w.y) * SC); o.z = cvtpk(lo_bf(w.z) * SC, hi_bf(w.z) * SC); o.w = cvtpk(lo_bf(w.w) * SC, hi_bf(w.w) * SC);
          qf[s] = __builtin_bit_cast(bf16x8, o); } }
    const int skey = tid >> 3, sch = tid & 7;
    const int i16 = lane & 15, blk = (lane >> 4) & 1;
    const int kboff = col * DK_STR + hh * 16;
    const int vboff = 64 * DK_STR + (4 * hh + (i16 >> 2)) * DV_STR + (16 * blk + 4 * (i16 & 3)) * 2;
    u32x4 kr, vr;
    const int ncvm = (4 * u + 3) < NCMP ? (4 * u + 3) : NCMP;
    const int nsc = (ncvm + 63) >> 6;
    const GAS unsigned char* kcp = (const GAS unsigned char*)(kcb + (size_t)(0 * BATCH + b) * 512 * 64);
    const GAS unsigned char* vcp = (const GAS unsigned char*)(kcb + (size_t)(1 * BATCH + b) * 512 * 64);
    const unsigned soffc = (unsigned)(skey * 64 + sch * 8) * 2u;
    float m1 = -120.f, l1 = 0.f;
    st_load(kcp, vcp, soffc, kr, vr); st_write(lds, skey, sch, kr, vr); __syncthreads();
#pragma unroll 1
    for (int kt = 0; kt < nsc; ++kt) {
        const LAS unsigned char* cur = lds + (kt & 1) * DBUF_BYTES; LAS unsigned char* nxt = lds + ((kt + 1) & 1) * DBUF_BYTES;
        if (kt + 1 < nsc) st_load(kcp, vcp, soffc + (unsigned)(kt + 1) * 8192u, kr, vr);
#pragma unroll
        for (int tt = 0; tt < 2; ++tt) { f32x16 S; qk32z(cur + kboff + tt * 32 * DK_STR, qf, S); mask_bias_cmp32(S, t, kt * 64 + tt * 32, hh, b2h, 0.f);
          const float tm = max16(S); const float mn = fmaxf(m1, tm); float acc = 0.f;
#pragma unroll
          for (int i = 0; i < 16; ++i) acc += __builtin_amdgcn_exp2f(S[i] - mn);
          l1 = l1 * __builtin_amdgcn_exp2f(m1 - mn) + acc; m1 = mn; }
        if (kt + 1 < nsc) st_write(nxt, skey, sch, kr, vr);
        __syncthreads();
    }
    float mf, inv;
    { const float mo = xshfl<32>(m1), lo = xshfl<32>(l1); mf = fmaxf(m1, mo); const float lf = l1 * __builtin_amdgcn_exp2f(m1 - mf) + lo * __builtin_amdgcn_exp2f(mo - mf); inv = lf > 0.f ? 1.f / lf : 0.f; }
    f32x16 Oc[2], imp[4];
#pragma unroll
    for (int i = 0; i < 16; ++i) { Oc[0][i] = 0.f; Oc[1][i] = 0.f; imp[0][i] = 0.f; imp[1][i] = 0.f; imp[2][i] = 0.f; imp[3][i] = 0.f; }
    {   st_load(kcp, vcp, soffc, kr, vr); st_write(lds, skey, sch, kr, vr); __syncthreads();
#pragma unroll 1
        for (int kt = 0; kt < nsc; ++kt) {
            const LAS unsigned char* cur = lds + (kt & 1) * DBUF_BYTES; LAS unsigned char* nxt = lds + ((kt + 1) & 1) * DBUF_BYTES;
            if (kt + 1 < nsc) st_load(kcp, vcp, soffc + (unsigned)(kt + 1) * 8192u, kr, vr);
#pragma unroll
            for (int tt = 0; tt < 2; ++tt) {
                f32x16 S; qk32z(cur + kboff + tt * 32 * DK_STR, qf, S); mask_bias_cmp32(S, t, kt * 64 + tt * 32, hh, b2h, mf);
#pragma unroll
                for (int i = 0; i < 16; ++i) S[i] = __builtin_amdgcn_exp2f(S[i]) * inv;
                bf16x8 pk[2]; pk[0] = pack_half(S, 0); pk[1] = pack_half(S, 1);
                pv32(cur + vboff + tt * 32 * DV_STR, pk, Oc);
                const int Tq = (2 * kt + tt) & 3, MB = (2 * kt + tt) >> 2;
#pragma unroll
                for (int s2 = 0; s2 < 2; ++s2) { u32x4 aw; unsigned e[8];
#pragma unroll
                    for (int jj = 0; jj < 8; ++jj) { const int kk = 16 * s2 + 8 * (jj >> 2) + 4 * hh + (jj & 3); const int delta = 32 * Tq + kk - 4 * col;
                        e[jj] = (delta == -1 || delta == 3) ? 0x3F80u : ((unsigned)delta <= 2u ? 0x4000u : 0u); }
                    aw.x = e[0] | (e[1] << 16); aw.y = e[2] | (e[3] << 16); aw.z = e[4] | (e[5] << 16); aw.w = e[6] | (e[7] << 16);
                    const bf16x8 af = __builtin_bit_cast(bf16x8, aw);
                    if (MB == 0) imp[0] = MFMA32(af, pk[s2], imp[0]); else if (MB == 1) imp[1] = MFMA32(af, pk[s2], imp[1]); else if (MB == 2) imp[2] = MFMA32(af, pk[s2], imp[2]); else imp[3] = MFMA32(af, pk[s2], imp[3]); }
                if (Tq == 3 && MB < 3) { u32x4 aw; aw.x = 0u; aw.y = 0u; aw.z = 0u; aw.w = (lane == 32) ? 0x3F800000u : 0u;
                    const bf16x8 af = __builtin_bit_cast(bf16x8, aw);
                    if (MB == 0) imp[1] = MFMA32(af, pk[1], imp[1]); else if (MB == 1) imp[2] = MFMA32(af, pk[1], imp[2]); else imp[3] = MFMA32(af, pk[1], imp[3]); }
            }
            if (kt + 1 < nsc) st_write(nxt, skey, sch, kr, vr);
            __syncthreads();
        }
    }
    unsigned ocp[2][8];
#pragma unroll
    for (int db = 0; db < 2; ++db)
#pragma unroll
        for (int i = 0; i < 8; ++i) ocp[db][i] = cvtpk(Oc[db][2 * i], Oc[db][2 * i + 1]);
    unsigned sm0 = 0u, sm1 = 0u, sm2 = 0u, sm3 = 0u;
    {   const int cur_t = t >> 6; unsigned key[16];
#pragma unroll
        for (int i = 0; i < 16; ++i) {
            float v0 = imp[0][i], v1 = imp[1][i], v2 = imp[2][i], v3 = imp[3][i];
            v0 += xshfl<1>(v0); v0 += xshfl<2>(v0); v1 += xshfl<1>(v1); v1 += xshfl<2>(v1); v2 += xshfl<1>(v2); v2 += xshfl<2>(v2); v3 += xshfl<1>(v3); v3 += xshfl<2>(v3);
            const float val = head == 0 ? v0 : (head == 1 ? v1 : (head == 2 ? v2 : v3));
            const int j = 32 * head + crow(i, hh);
            const bool forced = (j == 0) || (j == cur_t) || (j == cur_t - 1);
            unsigned fx = (unsigned)(fminf(fmaxf(val, 0.f), 31.f) * 1048576.f) + 1u;
            fx = forced ? 0x1FFFFFFu : (j <= cur_t ? fx : 0u);
            key[i] = (fx << 7) | (unsigned)(127 - j); }
#pragma unroll 1
        for (int r = 0; r < 16; ++r) {
            unsigned w = key[0];
#pragma unroll
            for (int i = 1; i < 16; ++i) w = w > key[i] ? w : key[i];
            { unsigned o = (unsigned)xshfl_i<1>((int)w); w = w > o ? w : o; o = (unsigned)xshfl_i<2>((int)w); w = w > o ? w : o; o = (unsigned)xshfl_i<32>((int)w); w = w > o ? w : o; }
            if ((w >> 7) != 0u) { const int j = 127 - (int)(w & 127u); const unsigned bit = 1u << (j & 31); const int jb = j >> 5;
                sm0 |= (jb == 0) ? bit : 0u; sm1 |= (jb == 1) ? bit : 0u; sm2 |= (jb == 2) ? bit : 0u; sm3 |= (jb == 3) ? bit : 0u; }
#pragma unroll
            for (int i = 0; i < 16; ++i) key[i] = (key[i] == w) ? 0u : key[i];
        }
    }
    f32x16 Ow[2]; float lw = 0.f;
#pragma unroll
    for (int i = 0; i < 16; ++i) { Ow[0][i] = 0.f; Ow[1][i] = 0.f; }
    {   f32x16 negm;
#pragma unroll
        for (int i = 0; i < 16; ++i) negm[i] = 120.f;
        const GAS unsigned char* kwp = (const GAS unsigned char*)(proj + rowb * PLD + C_KW); const GAS unsigned char* vwp = (const GAS unsigned char*)(proj + rowb * PLD + C_VW);
        const unsigned soffp = (unsigned)(skey * PLD + sch * 8) * 2u;
        const int s0 = (u < 8) ? 8 - u : 0;
        st_load(kwp, vwp, soffp + (unsigned)(u - 8 + s0) * (64u * PLD * 2u), kr, vr); st_write(lds, skey, sch, kr, vr); __syncthreads();
#pragma unroll 1
        for (int s = s0; s < 9; ++s) {
            const int par = (s - s0) & 1; const LAS unsigned char* cur = lds + par * DBUF_BYTES; LAS unsigned char* nxt = lds + (par ^ 1) * DBUF_BYTES;
            if (s + 1 < 9) st_load(kwp, vwp, soffp + (unsigned)(u - 8 + s + 1) * (64u * PLD * 2u), kr, vr);
            {   f32x16 S[2]; qk64(cur, kboff, qf, negm, S);
                if (s == 0 || s >= 6) mask_bias(S, t, (u - 8 + s) * 64, hh, 512, true, b2h);
                bf16x8 pk[2][2]; softmax_step(S, Ow, negm, lw, pk); pv64(cur, vboff, pk, Ow); }
            if (s + 1 < 9) st_write(nxt, skey, sch, kr, vr);
            __syncthreads();
        }
    }
    unsigned owp[2][8];
#pragma unroll
    for (int db = 0; db < 2; ++db)
#pragma unroll
        for (int i = 0; i < 8; ++i) owp[db][i] = cvtpk(Ow[db][2 * i], Ow[db][2 * i + 1]);
    f32x16 Os[2]; float lsel = 0.f;
#pragma unroll
    for (int i = 0; i < 16; ++i) { Os[0][i] = 0.f; Os[1][i] = 0.f; }
    {   f32x16 negm;
#pragma unroll
        for (int i = 0; i < 16; ++i) negm[i] = 120.f;
        const GAS unsigned char* ksp = (const GAS unsigned char*)(proj + rowb * PLD + C_KS); const GAS unsigned char* vsp = (const GAS unsigned char*)(proj + rowb * PLD + C_VS);
        const unsigned soffp = (unsigned)(skey * PLD + sch * 8) * 2u;
        u32x4 kA, vA, kB, vB;
        st_load(ksp, vsp, soffp, kr, vr); st_write(lds, skey, sch, kr, vr);
        if (u >= 1) st_load(ksp, vsp, soffp + 64u * PLD * 2u, kA, vA);
        __syncthreads();
#define SEL_STEP(J, KX, VX, KY, VY) { const int j_ = (J); \
            const LAS unsigned char* cur = lds + (j_ & 1) * DBUF_BYTES; LAS unsigned char* nxt = lds + ((j_ + 1) & 1) * DBUF_BYTES; \
            if (j_ + 2 <= u) st_load(ksp, vsp, soffp + (unsigned)(j_ + 2) * (64u * PLD * 2u), KY, VY); \
            const int jb = j_ >> 5; const unsigned smw = jb == 0 ? sm0 : (jb == 1 ? sm1 : (jb == 2 ? sm2 : sm3)); \
            const bool bit = ((smw >> (j_ & 31)) & 1u) != 0u; \
            if (__builtin_amdgcn_ballot_w64(bit) != 0ull) { \
                f32x16 S[2]; qk64(cur, kboff, qf, negm, S); \
                if (64 * j_ + 63 > tw0 - 113) mask_bias(S, t, 64 * j_, hh, 1 << 30, bit, b2h); \
                else if (!bit) { _Pragma("unroll") for (int i = 0; i < 16; ++i) { S[0][i] = -1e30f; S[1][i] = -1e30f; } } \
                bf16x8 pk[2][2]; softmax_step(S, Os, negm, lsel, pk); pv64(cur, vboff, pk, Os); } \
            if (j_ + 1 <= u) st_write(nxt, skey, sch, KX, VX); \
            __syncthreads(); }
#pragma unroll 1
        for (int j = 0; j <= u; j += 2) {
            SEL_STEP(j, kA, vA, kB, vB)
            if (j + 1 <= u) SEL_STEP(j + 1, kB, vB, kA, vA)
        }
#undef SEL_STEP
    }
    {   const float lwt = lw + xshfl<32>(lw), lst = lsel + xshfl<32>(lsel);
        const GAS bf16* gp = proj + (rowb + t) * PLD + C_DG + head * 3;
        const float g0 = sigmoidf_(bf2f(gp[0])), g1 = sigmoidf_(bf2f(gp[1])) / fmaxf(lst, 1e-30f), g2 = sigmoidf_(bf2f(gp[2])) / fmaxf(lwt, 1e-30f);
        GAS bf16* op = ys + (rowb + t) * 1024 + 768 + head * 64;
#pragma unroll
        for (int db = 0; db < 2; ++db)
#pragma unroll
            for (int gq = 0; gq < 4; ++gq) { const int d0 = 32 * db + 8 * gq + 4 * hh; float y[4];
#pragma unroll
                for (int e = 0; e < 4; ++e) { const unsigned cw = ocp[db][2 * gq + (e >> 1)], ww = owp[db][2 * gq + (e >> 1)];
                    y[e] = g0 * ((e & 1) ? hi_bf(cw) : lo_bf(cw)) + g1 * Os[db][4 * gq + e] + g2 * ((e & 1) ? hi_bf(ww) : lo_bf(ww)); }
                u32x2 w; w.x = cvtpk(y[0], y[1]); w.y = cvtpk(y[2], y[3]); *(GAS u32x2*)(op + d0) = w; }
    }
}


DI void swa_unit(const GAS bf16* proj, GAS bf16* ys, LAS unsigned char* lds, const LAS float* bias2, const LAS float* biasd, const GAS float* sinks, int b, int u, int tid_in, int lane_in, int wave_in) {
    int tid = tid_in, lane = lane_in, wave = wave_in; asm volatile("" : "+v"(tid), "+v"(lane), "+s"(wave));
    const int t0 = u * 64; const int col = lane & 31, hh = lane >> 5, tl = col >> 1, kv = wave & 1, head = 2 * kv + (col & 1);
    const int t = t0 + (wave >> 1) * 16 + tl;
    const size_t rowb = (size_t)b * SEQ;
    const LAS float* b2h = bias2 + head;
    bf16x8 qf[4];
    { const float SC = 0.125f * 1.4426950408889634f; const GAS bf16* qp = proj + (rowb + t) * PLD + C_BQ + head * 64 + hh * 8;
#pragma unroll
      for (int s = 0; s < 4; ++s) { const u32x4 w = *(const GAS u32x4*)(qp + s * 16); u32x4 o;
          o.x = cvtpk(lo_bf(w.x) * SC, hi_bf(w.x) * SC); o.y = cvtpk(lo_bf(w.y) * SC, hi_bf(w.y) * SC); o.z = cvtpk(lo_bf(w.z) * SC, hi_bf(w.z) * SC); o.w = cvtpk(lo_bf(w.w) * SC, hi_bf(w.w) * SC);
          qf[s] = __builtin_bit_cast(bf16x8, o); } }
    const int skey = tid >> 3, sch = tid & 7;
    const int i16 = lane & 15, blk = (lane >> 4) & 1;
    const int kboff = kv * DBUF_BYTES + col * DK_STR + hh * 16;
    const int vboff = kv * DBUF_BYTES + 64 * DK_STR + (4 * hh + (i16 >> 2)) * DV_STR + (16 * blk + 4 * (i16 & 3)) * 2;
    const GAS unsigned char* kp = (const GAS unsigned char*)(proj + rowb * PLD + C_BK); const GAS unsigned char* vp = (const GAS unsigned char*)(proj + rowb * PLD + C_BV);
    const unsigned soffp = (unsigned)(skey * PLD + sch * 8) * 2u;
    u32x4 k0, v0, k1, v1;
    f32x16 O[2], negm; float lsum = 0.f;
#pragma unroll
    for (int i = 0; i < 16; ++i) { O[0][i] = 0.f; O[1][i] = 0.f; negm[i] = 120.f; }
    const int s0 = (u < 2) ? 2 - u : 0;
    { const unsigned so = soffp + (unsigned)(u - 2 + s0) * (64u * PLD * 2u); st_load(kp, vp, so, k0, v0); st_load(kp + 128, vp + 128, so, k1, v1);
      st_write(lds, skey, sch, k0, v0); st_write(lds + DBUF_BYTES, skey, sch, k1, v1); }
    __syncthreads();
#pragma unroll 1
    for (int s = s0; s < 3; ++s) {
        const int par = (s - s0) & 1; const LAS unsigned char* cur = lds + par * 2 * DBUF_BYTES; LAS unsigned char* nxt = lds + (par ^ 1) * 2 * DBUF_BYTES;
        if (s + 1 < 3) { const unsigned so = soffp + (unsigned)(u - 2 + s + 1) * (64u * PLD * 2u); st_load(kp, vp, so, k0, v0); st_load(kp + 128, vp + 128, so, k1, v1); }
        {   f32x16 S[2]; qk64(cur, kboff, qf, negm, S);
            mask_bias(S, t, (u - 2 + s) * 64, hh, 128, true, b2h);
            bf16x8 pk[2][2]; softmax_step(S, O, negm, lsum, pk); pv64(cur, vboff, pk, O); }
        if (s + 1 < 3) { st_write(nxt, skey, sch, k0, v0); st_write(nxt + DBUF_BYTES, skey, sch, k1, v1); }
        __syncthreads();
    }
    {   const float sinkp = (sinks[head] - biasd[128 * 12 + head]) * 1.4426950408889634f;
        const float lt = lsum + xshfl<32>(lsum) + __builtin_amdgcn_exp2f(sinkp + negm[0]);
        const float inv = 1.f / fmaxf(lt, 1e-30f);
        GAS bf16* op = ys + (rowb + t) * 1024 + 256 + head * 64;
#pragma unroll
        for (int db = 0; db < 2; ++db)
#pragma unroll
            for (int gq = 0; gq < 4; ++gq) { const int d0 = 32 * db + 8 * gq + 4 * hh;
                u32x2 w; w.x = cvtpk(O[db][4 * gq + 0] * inv, O[db][4 * gq + 1] * inv); w.y = cvtpk(O[db][4 * gq + 2] * inv, O[db][4 * gq + 3] * inv); *(GAS u32x2*)(op + d0) = w; }
    }
}

DI void route_rows4(const KA& a, int l, bf16* xr_, int tok0, int lane_) {
    int lane = lane_; asm volatile("" : "+v"(lane));
    const GAS float* xrow = (const GAS float*)a.out + (size_t)tok0 * 1024; const GAS float* g = (const GAS float*)(a.in[28] + (size_t)l * 1024); GAS bf16* xr = (GAS bf16*)xr_;
    f32x4 v[4][4]; float ss[4];
#pragma unroll
    for (int rr = 0; rr < 4; ++rr)
#pragma unroll
        for (int j = 0; j < 4; ++j) v[rr][j] = *(const GAS f32x4*)(xrow + (size_t)rr * 1024 + 4 * (lane + 64 * j));
#pragma unroll
    for (int rr = 0; rr < 4; ++rr) { float t = 0.f;
#pragma unroll
        for (int j = 0; j < 4; ++j) t += (v[rr][j][0] * v[rr][j][0] + v[rr][j][1] * v[rr][j][1]) + (v[rr][j][2] * v[rr][j][2] + v[rr][j][3] * v[rr][j][3]);
        ss[rr] = t; }
#pragma unroll
    for (int rr = 0; rr < 4; ++rr) ss[rr] = wave_sum(ss[rr]);
#pragma unroll
    for (int j = 0; j < 4; ++j) { const int k0 = 4 * (lane + 64 * j); const f32x4 gv = *(const GAS f32x4*)(g + k0);
#pragma unroll
        for (int rr = 0; rr < 4; ++rr) { const float r = 1.f / sqrtf(ss[rr] * (1.f / 1024.f) + 1e-6f); const f32x4 xn = v[rr][j] * r * gv;
            unsigned hi[4]; float lo[4];
#pragma unroll
            for (int e = 0; e < 4; ++e) { hi[e] = f2bf(xn[e]); lo[e] = xn[e] - __builtin_bit_cast(float, hi[e] << 16); }
            u32x2 wh, wl; wh.x = hi[0] | (hi[1] << 16); wh.y = hi[2] | (hi[3] << 16); wl.x = pk2(lo[0], lo[1]); wl.y = pk2(lo[2], lo[3]);
            *(GAS u32x2*)(xr + (size_t)(tok0 + rr) * 2048 + k0) = wh; *(GAS u32x2*)(xr + (size_t)(tok0 + rr) * 2048 + 1024 + k0) = wl; } }
}
struct SchedRoute { const char* A; const char* B; int pm;
    DI bool next(int i, Unit& u) const { if (i > 0) return false; u.pm = pm; u.pn = 0; u.aux = 0; u.pad = 0; u.a = A + (size_t)pm * 128 * 2048 * 2; u.b = B; return true; } };
struct EpiRoute { float* rlog;
    DI void operator()(const f32x4 (&acc)[2][2][4][2], const Unit& u, int wr, int wc, int fr, int fq) const {
        const int row0 = u.pm * 128 + wr * 64 + fr; const int col = wc * 32 + 8 * fq;
#pragma unroll
        for (int m = 0; m < 4; ++m) { float* rp = rlog + (size_t)(row0 + m * 16) * 128 + col; *(f32x4*)rp = acc[0][0][m][0]; *(f32x4*)(rp + 4) = acc[0][0][m][1]; }
    }
};
DI void route_decide(const KA& a, int l, const float* rl_row, int* rec_e, int* rec_slot, float* rec_w, unsigned* cnt, int tok) {
    float lg[36];
    const float* bg = a.in[30] + l * 4; const float* be = a.in[32] + l * 32;
#pragma unroll
    for (int q = 0; q < 9; ++q) { const f32x4 h = *(const f32x4*)(rl_row + 4 * q), lo = *(const f32x4*)(rl_row + 64 + 4 * q);
        lg[4 * q + 0] = h[0] + lo[0]; lg[4 * q + 1] = h[1] + lo[1]; lg[4 * q + 2] = h[2] + lo[2]; lg[4 * q + 3] = h[3] + lo[3]; }
#pragma unroll
    for (int i = 0; i < 4; ++i) lg[i] += bg[i];
#pragma unroll
    for (int i = 0; i < 32; ++i) lg[4 + i] += be[i];
    int gsel = 0; float gm = lg[0];
#pragma unroll
    for (int i = 1; i < 4; ++i) if (lg[i] > gm) { gm = lg[i]; gsel = i; }
    float gs = 0.f;
#pragma unroll
    for (int i = 0; i < 4; ++i) gs += __expf(lg[i] - gm);
    const float gwt = 1.f / gs;
    float v8[8];
#pragma unroll
    for (int i = 0; i < 8; ++i) { float x = lg[4 + i];
#pragma unroll
        for (int gq = 1; gq < 4; ++gq) x = (gsel == gq) ? lg[4 + gq * 8 + i] : x;
        v8[i] = x; }
    int i0 = 0; float m0 = v8[0];
#pragma unroll
    for (int i = 1; i < 8; ++i) if (v8[i] > m0) { m0 = v8[i]; i0 = i; }
    int i1 = -1; float m1 = -3e38f;
#pragma unroll
    for (int i = 0; i < 8; ++i) if (i != i0 && v8[i] > m1) { m1 = v8[i]; i1 = i; }
    const float w0 = 1.f / (1.f + __expf(m1 - m0)); const float w1 = 1.f - w0;
    const int e0 = gsel * 8 + i0, e1 = gsel * 8 + i1;
    const unsigned s0 = __hip_atomic_fetch_add(cnt + e0, 1u, __ATOMIC_RELAXED, __HIP_MEMORY_SCOPE_AGENT);
    const unsigned s1 = __hip_atomic_fetch_add(cnt + e1, 1u, __ATOMIC_RELAXED, __HIP_MEMORY_SCOPE_AGENT);
    rec_e[tok * 2] = e0; rec_e[tok * 2 + 1] = e1; rec_slot[tok * 2] = (int)s0; rec_slot[tok * 2 + 1] = (int)s1; rec_w[tok * 2] = w0 * gwt; rec_w[tok * 2 + 1] = w1 * gwt;
}
DI void expert_weights(const KA& a, int l, LAS unsigned char* lds, int it0, int it1, int gw, int NGW, int wave, int lane) {
    LAS float* scr = (LAS float*)(lds + wave * 16384);
    const float* wgt = a.in[33] + (size_t)l * 32 * 1024 * 256; const float* wup = a.in[34] + (size_t)l * 32 * 1024 * 256; const float* wdn = a.in[35] + (size_t)l * 32 * 256 * 1024;
    bf16* Wgu = (bf16*)(a.ws + WS_WGU); bf16* Wd = (bf16*)(a.ws + WS_WD);
    constexpr int I_E = 16 * 8, I_D = 4 * 32;
    constexpr int NIT = 32 * (2 * I_E + I_D);
    (void)NIT;
    for (int it = it0 + gw; it < it1; it += NGW) {
        const int e = it / (2 * I_E + I_D); int r = it % (2 * I_E + I_D);
        if (r < 2 * I_E) { const int up = r / I_E, q = r % I_E, kb = q / 8, nb = q % 8; const int n0 = nb * 32;
            const int drow = (n0 >> 7) * 256 + up * 128 + (n0 & 127);
            transpose_item((up ? wup : wgt) + (size_t)e * 1024 * 256, 256, 256, Wgu + (size_t)e * 512 * 1024, 1024, kb * 64, n0, drow, scr, lane);
        } else { r -= 2 * I_E; const int kb = r / 32, nb = r % 32;
            transpose_item(wdn + (size_t)e * 256 * 1024, 1024, 1024, Wd + (size_t)e * 1024 * 256, 256, kb * 64, nb * 32, nb * 32, scr, lane); }
    }
}
DI void build_offsets(const unsigned* cnt, LAS int* offt, int tid) {
    if (tid == 0) { int o = 0; for (int e = 0; e < 32; ++e) { offt[e] = o; const int c = (int)__hip_atomic_load(cnt + e, __ATOMIC_RELAXED, __HIP_MEMORY_SCOPE_AGENT); o += (c + 255) & ~255; } offt[32] = o; }
    __syncthreads();
    for (int rt = tid; rt < (MOE_ROWS >> 8); rt += 512) { int e = 0; for (int j = 1; j < 32; ++j) e += (offt[j] <= rt * 256) ? 1 : 0; offt[40 + rt] = e; }
    __syncthreads();
}

template <unsigned PM>
__global__ void __launch_bounds__(512, 2) mk_fwd(Args a_) {
    extern __shared__ __attribute__((aligned(16))) unsigned char lds_raw[];
    LAS unsigned char* lds = (LAS unsigned char*)lds_raw;
    const int wave0 = __builtin_amdgcn_readfirstlane((int)threadIdx.x >> 6);
    if (threadIdx.x < 36) ((LAS unsigned long long*)(lds + PTAB_OFF))[threadIdx.x] = (unsigned long long)a_.in[threadIdx.x];
    __syncthreads();
    KA a; a.in.base = (unsigned)(size_t)(lds + PTAB_OFF); a.out = a_.out; a.ws = a_.ws;
    const int G = gridDim.x, bid = blockIdx.x, NGW = G * 8;
#define PHASE_IDS() int wave = wave0; asm volatile("" : "+s"(wave)); const int lane = my_lane(); const int tid_ = wave * 64 + lane, gw = bid * 8 + wave; (void)tid_; (void)gw; \
    KA ap = a; asm volatile("" : "+s"(ap.ws), "+s"(ap.out), "+s"(ap.in.base)); \
    bf16* hb = (bf16*)(ap.ws + WS_HB); bf16* proj = (bf16*)(ap.ws + WS_PROJ); bf16* gates = (bf16*)(ap.ws + WS_GATES); \
    bf16* ys = hb; bf16* x2b = hb; bf16* merged = proj; bf16* eo = proj; \
    bf16* kcb = (bf16*)(ap.ws + WS_KCVC); float* lrusum = (float*)(ap.ws + WS_LRUSUM); \
    int* rec_e = (int*)(ap.ws + WS_REC); int* rec_slot = rec_e + T * 2; float* rec_w = (float*)(rec_slot + T * 2); \
    int* rowtok = (int*)(ap.ws + WS_ROWTOK); float* roww = (float*)(ap.ws + WS_ROWW); \
    bf16* xs = (bf16*)(ap.ws + WS_XS); bf16* hmid = (bf16*)(ap.ws + WS_HMID); unsigned* ctl = (unsigned*)(ap.ws + WS_CTL); \
    (void)hb; (void)proj; (void)gates; (void)ys; (void)x2b; (void)merged; (void)eo; (void)kcb; (void)lrusum; (void)rec_e; (void)rec_slot; (void)rec_w; (void)rowtok; (void)roww; (void)xs; (void)hmid; (void)ctl
    volatile LAS unsigned* MISC = (volatile LAS unsigned*)(lds + MISC_OFF);
    LAS float* biasd = (LAS float*)(lds + BIAS_OFF);
    LAS int* offt = (LAS int*)(lds + OFFT_OFF);
    { PHASE_IDS();
    if (tid_ < 64) MISC[tid_] = 0u;
    for (int i = tid_; i < 129 * 12; i += 512) { const int d = i / 12, hd = i % 12; const int bk = d < 128 ? T5_BUCKET[d] : 31; const float* rb = a.in[1]; biasd[i] = rb[bk * 12 + hd]; ((LAS float*)(lds + BIAS2_OFF))[i] = (rb[bk * 12 + hd] - rb[31 * 12 + hd]) * 1.4426950408889634f; } }
    __syncthreads();
    const int lo = a_.ph_lo, hi = a_.ph_hi;
    XcdBarrier bar; bar.bar = (unsigned*)(a.ws + WS_CTL) + CW_BAR; bar.x = 0; bar.st = nullptr;
    if (hi - lo > 1) { PHASE_IDS(); bar = xcd_barrier_post(ctl + CW_BAR, MISC + 8, tid_ == 0); }
#ifndef SUB_MASK
#define SUB_MASK 0xFFu
#endif
#define SUB(k) ((SUB_MASK >> (k)) & 1u)
#define HASP(k) ((PM >> ((k) % PPL + ((k) >= 2 * PPL ? PPL : 0))) & 1u)
#define IN(k) (HASP(k) && lo <= (k) && (k) < hi)
#define SEAM(k) do { if ((k) + 1 < hi) { const int sl_ = my_lane(); int sw_ = wave0; asm volatile("" : "+s"(sw_)); xcd_barrier(bar, sw_ == 0 && sl_ == 0); } } while (0)
    for (int l = 0; l < DEPTH; ++l) {
        const int pb = l * PPL;
        if (IN(pb + 0)) { PHASE_IDS(); router_weights(ap, l, gw, NGW, lane); lru_weights(ap, l, gw, NGW, lane); cmp_weights(ap, l, lds, gw, NGW, wave, lane); phase0_weights(ap, l, lds, gw, NGW, wave, lane); phase0_rows(ap, l, 0, gw, NGW, lane); SEAM(pb + 0); }
        if (IN(pb + 1)) {
            PHASE_IDS();
            pg8::Gemm g{1024, 1024, 1024, 128, -1}; SchedP1 S{(const char*)hb, (const char*)(ap.ws + WS_WIN), G, bid};
            EpiP1 E{proj, gates, ap.in[25] + (size_t)l * 4096};
            pg8::gemm_phase<EpiP1, SchedP1>(lds, g, S, E, tid_); SEAM(pb + 1);
        }
        if (IN(pb + 2)) {
            PHASE_IDS();
            LAS float* lamp = (LAS float*)(lds + MISC_OFF + 64);
            if (tid_ == 0) { float s1 = 0.f, s2 = 0.f;
                for (int i = 0; i < 32; ++i) { s1 += ap.in[13][l * 32 + i] * ap.in[14][l * 32 + i]; s2 += ap.in[15][l * 32 + i] * ap.in[16][l * 32 + i]; }
                const float lam_init = 0.8f - 0.6f * __expf(-0.3f * (float)l); lamp[0] = __expf(s1) - __expf(s2) + lam_init; lamp[1] = lam_init; }
            __syncthreads();
            if (SUB(0)) { const LAS float* bias2 = (const LAS float*)(lds + BIAS2_OFF); const GAS float* subg = (const GAS float*)(ap.in[17] + l * 64);
                for (int pi = bid; pi < 256; pi += G) { const int bh = pi >> 4, qlo = pi & 15;
                    diff_unit((const GAS bf16*)proj, (GAS bf16*)ys, lds, bias2, subg, lamp, bh >> 2, bh & 3, 31 - qlo, wave);
                    diff_unit((const GAS bf16*)proj, (GAS bf16*)ys, lds, bias2, subg, lamp, bh >> 2, bh & 3, qlo, wave); } }
            { PHASE_IDS();
            if (SUB(3)) { __syncthreads(); const LAS float* bias2 = (const LAS float*)(lds + BIAS2_OFF); const GAS float* sinks = (const GAS float*)(ap.in[12] + l * 4);
                for (int pi = bid; pi < 512; pi += G) swa_unit((const GAS bf16*)proj, (GAS bf16*)ys, lds, bias2, biasd, sinks, pi >> 7, pi & 127, tid_, lane, wave); }
            if (SUB(2)) { pg8::Gemm g{1024, 16 * PLD, 1024, PLD * 2, -1}; SchedCmp S{(const char*)proj, (const char*)(ap.ws + WS_WCMP), G, bid}; EpiCmp E{(float*)(ap.ws + WS_CMPAB)};
                pg8::gemm_phase<EpiCmp, SchedCmp>(lds, g, S, E, tid_); }
            if (SUB(1)) { __syncthreads(); for (int task = bid; task < 512; task += G) lru_unit(ap, l, (const GAS bf16*)proj, (GAS bf16*)ys, (GAS float*)lrusum, lds, task, lane, wave, false); }
            }
            SEAM(pb + 2);
        }
        if (IN(pb + 3)) {
            PHASE_IDS();
            for (int task = gw; task < 2 * BATCH * NCMP; task += NGW) cmp_finish(ap, l, (const float*)(ap.ws + WS_CMPAB), kcb, task, lane);
            __syncthreads();
            for (int task = bid; task < 512; task += G) lru_unit(ap, l, (const GAS bf16*)proj, (GAS bf16*)ys, (GAS float*)lrusum, lds, task, lane, wave, true);
            SEAM(pb + 3);
        }
        if (IN(pb + 4)) {
            PHASE_IDS();
            if (SUB(4)) { const LAS float* bias2 = (const LAS float*)(lds + BIAS2_OFF);
                for (int pi = bid; pi < 256; pi += G) { const int bb = pi >> 6, ulo = pi & 63;
                    nsa_unit((const GAS bf16*)proj, (GAS bf16*)ys, (const GAS bf16*)kcb, lds, bias2, bb, 127 - ulo, tid_, lane, wave);
                    nsa_unit((const GAS bf16*)proj, (GAS bf16*)ys, (const GAS bf16*)kcb, lds, bias2, bb, ulo, tid_, lane, wave); } }
            SEAM(pb + 4);
        }
        if (IN(pb + 5)) {
            PHASE_IDS();
            pg8::Gemm g{256, 1024, 256, 128, -1}; SchedP3a S{(const char*)ys, (const char*)(ap.ws + WS_WBR), G, bid};
            EpiP3a E{merged, gates};
            pg8::gemm_phase<EpiP3a, SchedP3a>(lds, g, S, E, tid_); SEAM(pb + 5);
        }
        if (IN(pb + 6)) {
            PHASE_IDS();
            pg8::Gemm g{1024, 1024, 1024, 128, -1}; SchedP3b S{(const char*)merged, (const char*)(ap.ws + WS_WOUT), G, bid};
            EpiP3b E{(l == 0) ? ap.in[0] : ap.out, ap.out};
            pg8::gemm_phase<EpiP3b, SchedP3b>(lds, g, S, E, tid_); SEAM(pb + 6);
        }
        if (IN(pb + 7)) {
            PHASE_IDS();
            bf16* xr = (bf16*)(ap.ws + WS_XR); float* rlog = (float*)(ap.ws + WS_RLOG);
            constexpr int NITW = 32 * (2 * 16 * 8 + 4 * 32);
            { const int pm = bid;
                for (int r = wave * 4; r < 128; r += 32) route_rows4(ap, l, xr, pm * 128 + r, lane);
                asm volatile("s_waitcnt vmcnt(0)" ::: "memory"); __syncthreads();
                { pg8::Gemm g{2048, 2048, 2048, 128, 0}; SchedRoute S{(const char*)xr, (const char*)(ap.ws + WS_WR), pm}; EpiRoute E{rlog};
                  pg8::gemm_phase<EpiRoute, SchedRoute>(lds, g, S, E, tid_); }
                asm volatile("s_waitcnt vmcnt(0)" ::: "memory"); __syncthreads();
                if (tid_ < 128) route_decide(ap, l, rlog + (size_t)(pm * 128 + tid_) * 128, rec_e, rec_slot, rec_w, ctl + CW_CNT + l * 32, pm * 128 + tid_);
                __syncthreads();
            }
            expert_weights(ap, l, lds, 0, NITW, gw, NGW, wave, lane);
            SEAM(pb + 7);
        }
        if (IN(pb + 8)) {
            PHASE_IDS();
            build_offsets(ctl + CW_CNT + l * 32, offt, tid_);
            if (bid < 32) { const int e = bid; const int c = (int)__hip_atomic_load(ctl + CW_CNT + l * 32 + e, __ATOMIC_RELAXED, __HIP_MEMORY_SCOPE_AGENT);
                for (int p = offt[e] + c + tid_; p < offt[e + 1]; p += 512) rowtok[p] = -1; }
            {   const GAS bf16* xr = (const GAS bf16*)(ap.ws + WS_XR); GAS bf16* xsg = (GAS bf16*)xs;
                for (int tok0 = gw * 4; tok0 < T; tok0 += NGW * 4) {
                    u32x4 v0[4], v1[4]; int pos[4][2];
#pragma unroll
                    for (int rr = 0; rr < 4; ++rr) { v0[rr] = *(const GAS u32x4*)(xr + (size_t)(tok0 + rr) * 2048 + lane * 8); v1[rr] = *(const GAS u32x4*)(xr + (size_t)(tok0 + rr) * 2048 + 512 + lane * 8);
#pragma unroll
                        for (int k = 0; k < 2; ++k) pos[rr][k] = offt[rec_e[(tok0 + rr) * 2 + k]] + rec_slot[(tok0 + rr) * 2 + k]; }
#pragma unroll
                    for (int rr = 0; rr < 4; ++rr)
#pragma unroll
                        for (int k = 0; k < 2; ++k) { const int p = pos[rr][k];
                            *(GAS u32x4*)(xsg + (size_t)p * 1024 + lane * 8) = v0[rr]; *(GAS u32x4*)(xsg + (size_t)p * 1024 + 512 + lane * 8) = v1[rr];
                            if (lane == 0) { rowtok[p] = (tok0 + rr) * 2 + k; roww[p] = rec_w[(tok0 + rr) * 2 + k]; } } } }
            SEAM(pb + 8);
        }
        if (IN(pb + 9)) {
            PHASE_IDS();
            build_offsets(ctl + CW_CNT + l * 32, offt, tid_);
            pg8::Gemm g{1024, 1024, 1024, 128, -1}; SchedM2 S{(const char*)xs, (const char*)(ap.ws + WS_WGU), offt, G, bid};
            EpiM2 E{hmid};
            pg8::gemm_phase<EpiM2, SchedM2>(lds, g, S, E, tid_); SEAM(pb + 9);
        }
        if (IN(pb + 10)) {
            PHASE_IDS();
            build_offsets(ctl + CW_CNT + l * 32, offt, tid_);
            pg8::Gemm g{256, 256, 256, 128, -1}; SchedM3 S{(const char*)hmid, (const char*)(ap.ws + WS_WD), offt, G, bid};
            EpiM3 E{eo, rowtok, roww};
            pg8::gemm_phase<EpiM3, SchedM3>(lds, g, S, E, tid_); SEAM(pb + 10);
        }
    }
    if (IN(2 * PPL)) { PHASE_IDS(); phase0_rows(ap, DEPTH, 1, gw, NGW, lane); }
#undef IN
#undef SEAM
}

typedef void (*kern_t)(Args);
template <unsigned PM> static bool setup_kernel() {
    if (hipFuncSetAttribute((const void*)mk_fwd<PM>, hipFuncAttributeMaxDynamicSharedMemorySize, LDS_BYTES) != hipSuccess) { fprintf(stderr, "kernel_launch: hipFuncSetAttribute failed\n"); return false; }
    return true;
}
extern "C" void kernel_launch(void* const* d_in, const int* in_sizes, int n_in, void* d_out, int out_size, void* d_ws, size_t ws_size, hipStream_t stream) {
    static int grid = 0;
    if (grid == 0) {
        if (n_in != 36 || out_size != T * D || ws_size < WS_END) { fprintf(stderr, "kernel_launch: unexpected shapes (n_in %d out %d ws %zu)\n", n_in, out_size, ws_size); grid = -1; return; }
        int dev = 0, cus = 0;
        if (hipGetDevice(&dev) != hipSuccess || hipDeviceGetAttribute(&cus, hipDeviceAttributeMultiprocessorCount, dev) != hipSuccess) { grid = -1; return; }
        bool ok = true;
#if MK_ONE_LAUNCH
        ok = setup_kernel<0xFFFu>();
#endif
        if (!ok) { grid = -1; return; }
        (void)hipGetLastError();
        grid = cus;
        if (grid != 256) { fprintf(stderr, "kernel_launch: built for a 256-CU device (got %d)\n", cus); grid = -1; return; }
    }
    if (grid < 0) return;
    if (hipMemsetAsync((char*)d_ws + WS_CTL, 0, CTL_ZERO_BYTES, stream) != hipSuccess) return;
    Args a{};
    for (int i = 0; i < 36; ++i) a.in[i] = (const float*)d_in[i];
    a.out = (float*)d_out; a.ws = (unsigned char*)d_ws;
#if MK_ONE_LAUNCH
    a.ph_lo = 0; a.ph_hi = NPH;
    hipLaunchKernelGGL(mk_fwd<0xFFFu>, dim3(grid), dim3(512), LDS_BYTES, stream, a);
#endif
}
```

```cpp
#include <hip/hip_runtime.h>
#include <cstdio>
#include <cstdint>

#ifndef MK_ONE_LAUNCH
#define MK_ONE_LAUNCH 1
#endif

#define DI __device__ __forceinline__
#define GAS __attribute__((address_space(1)))
#define LAS __attribute__((address_space(3)))
typedef unsigned short bf16;
typedef short bf16x8 __attribute__((ext_vector_type(8)));
typedef float f32x4 __attribute__((ext_vector_type(4)));
typedef unsigned u32x4 __attribute__((ext_vector_type(4)));
typedef unsigned u32x2 __attribute__((ext_vector_type(2)));
typedef float f32x16 __attribute__((ext_vector_type(16)));
typedef float f32x2 __attribute__((ext_vector_type(2)));
typedef short s16x4 __attribute__((ext_vector_type(4)));
typedef __bf16 bf16x2_t __attribute__((ext_vector_type(2)));
typedef short v4i16_t __attribute__((__vector_size__(4 * sizeof(short))));
#define MFMA32(a, b, c) __builtin_amdgcn_mfma_f32_32x32x16_bf16((a), (b), (c), 0, 0, 0)

constexpr int BATCH = 4, SEQ = 8192, T = BATCH * SEQ, D = 1024, DEPTH = 2;
constexpr int NIN = 2444, PLD = 2560, N1 = 6656, GLD = 4096;
constexpr int C_AX = 0, C_AG = 256, C_BQ = 512, C_BK = 768, C_BV = 896, C_CQ = 1024, C_CK = 1280, C_CV = 1536, C_DQ = 1792,
              C_KC = 2048, C_VC = 2112, C_KS = 2176, C_VS = 2240, C_KW = 2304, C_VW = 2368, C_DG = 2432;
constexpr int NCMP = 511;
constexpr int MOE_ROWS = 73728;
constexpr int PPL = 11;
constexpr int NPH = 2 * PPL + 1;

constexpr size_t MiB = 1u << 20;
constexpr size_t WS_CTL = 0, CTL_ZERO_BYTES = 1 * MiB;
constexpr size_t WS_KCVC = 1 * MiB;
constexpr size_t WS_LRUSUM = 2 * MiB;
constexpr size_t WS_REC = 2 * MiB + 256 * 1024;
constexpr size_t WS_ROWTOK = 3 * MiB;
constexpr size_t WS_ROWW = 3 * MiB + 512 * 1024;
constexpr size_t WS_WIN = 4 * MiB;
constexpr size_t WS_WBR = 17 * MiB;
constexpr size_t WS_WOUT = 19 * MiB;
constexpr size_t WS_HB = 21 * MiB;
constexpr size_t WS_PROJ = 85 * MiB;
constexpr size_t WS_GATES = 245 * MiB;
constexpr size_t WS_WGU = 245 * MiB;
constexpr size_t WS_WD = 277 * MiB;
constexpr size_t WS_XS = 293 * MiB;
constexpr size_t WS_HMID = 437 * MiB;
constexpr size_t WS_XR = 85 * MiB;
constexpr size_t WS_RLOG = 213 * MiB;
constexpr size_t WS_WR = 501 * MiB;
constexpr size_t WS_WCMP = 502 * MiB;
constexpr size_t WS_CMPAB = 503 * MiB;
constexpr size_t WS_LRUW = 505 * MiB + 65536;
constexpr size_t WS_END = 506 * MiB;
constexpr int CW_BAR = 4096;
constexpr int CW_CNT = 16384;

constexpr int RING_BYTES = 131072;
constexpr int MISC_OFF = RING_BYTES;
constexpr int BIAS_OFF = MISC_OFF + 256;
constexpr int OFFT_OFF = BIAS_OFF + 129 * 12 * 4;
constexpr int PTAB_OFF = OFFT_OFF + (40 + 288) * 4;
constexpr int BIAS2_OFF = PTAB_OFF + 36 * 8;
constexpr int LRUEX_OFF = BIAS2_OFF + 129 * 12 * 4;
constexpr int LDS_BYTES = 163840;
constexpr int LRUCST_OFF = LRUEX_OFF + 8 * 64 * 2 * 4;
constexpr int LRUCAR_OFF = LRUCST_OFF + 3 * 64 * 4;
static_assert(PTAB_OFF % 8 == 0 && LRUCAR_OFF + 8 * 64 * 4 <= LDS_BYTES, "LDS map");

DI float bf2f(bf16 v) { return __builtin_bit_cast(float, (unsigned)v << 16); }
DI float lo_bf(unsigned w) { return __builtin_bit_cast(float, w << 16); }
DI float hi_bf(unsigned w) { return __builtin_bit_cast(float, w & 0xffff0000u); }
DI unsigned f2bf(float f) { unsigned u = __builtin_bit_cast(unsigned, f); return (u + 0x7fffu + ((u >> 16) & 1u)) >> 16; }
DI unsigned pk2(float lo, float hi) { return f2bf(lo) | (f2bf(hi) << 16); }
DI float rl(float v, int i) { return __builtin_bit_cast(float, __builtin_amdgcn_readlane(__builtin_bit_cast(int, v), i)); }
DI int rli(int v, int i) { return __builtin_amdgcn_readlane(v, i); }
DI int my_lane() { int l; asm volatile("v_mbcnt_lo_u32_b32 %0, -1, 0\n\tv_mbcnt_hi_u32_b32 %0, -1, %0" : "=v"(l)); return l; }
template <int O> DI int xshfl_i(int v) {
    if constexpr (O < 32) return __builtin_amdgcn_ds_swizzle(v, (O << 10) | 0x1f);
    else { const int l = my_lane(); return __builtin_amdgcn_ds_bpermute((l ^ 32) << 2, v); }
}
template <int O> DI float xshfl(float v) { return __builtin_bit_cast(float, xshfl_i<O>(__builtin_bit_cast(int, v))); }
DI float wave_sum(float v) { v += xshfl<1>(v); v += xshfl<2>(v); v += xshfl<4>(v); v += xshfl<8>(v); v += xshfl<16>(v); v += xshfl<32>(v); return v; }
DI float wave_max(float v) { v = fmaxf(v, xshfl<1>(v)); v = fmaxf(v, xshfl<2>(v)); v = fmaxf(v, xshfl<4>(v)); v = fmaxf(v, xshfl<8>(v)); v = fmaxf(v, xshfl<16>(v)); v = fmaxf(v, xshfl<32>(v)); return v; }
DI float sigmoidf_(float x) { return __builtin_amdgcn_rcpf(1.f + __builtin_amdgcn_exp2f(-1.4426950408889634f * x)); }
DI float gelu_tanh(float x) { const float u = 0.7978845608028654f * (x + 0.044715f * x * x * x); const float e = __expf(2.f * u); const float th = 1.f - 2.f * __builtin_amdgcn_rcpf(e + 1.f); return 0.5f * x * (1.f + th); }
DI float softplusf_(float x) { return fmaxf(x, 0.f) + log1pf(__expf(-fabsf(x))); }
#define LDS_WAIT() asm volatile("s_waitcnt lgkmcnt(0)" ::: "memory")
#define VM_WAIT() asm volatile("s_waitcnt vmcnt(0)" ::: "memory")

__device__ const unsigned char T5_BUCKET[128] = {
0,1,2,3,4,5,6,7,8,9,10,11,12,13,14,15,16,16,16,17,17,18,18,18,19,19,19,20,20,20,20,21,21,21,21,22,22,22,22,22,23,23,23,23,23,23,24,24,24,24,24,24,25,25,25,25,25,25,25,26,26,26,26,26,26,26,26,27,27,27,27,27,27,27,27,27,27,28,28,28,28,28,28,28,28,28,28,29,29,29,29,29,29,29,29,29,29,29,29,30,30,30,30,30,30,30,30,30,30,30,30,30,30,31,31,31,31,31,31,31,31,31,31,31,31,31,31,31};

#define XB_TMO      128
#define XB_XCNT(j)  (256  + 64 * (j))
#define XB_XSUB(j)  (1280 + 64 * (j))
#define XB_XGEN(j)  (2304 + 64 * (j))
#define XB_TOP      3328
#define XB_TOPGEN   3392
#define XCD_BAR_WORDS 3456
#define XB_SPIN_CAP (1u << 22)
DI unsigned xb_ld(unsigned* p)              { return __hip_atomic_load(p, __ATOMIC_RELAXED, __HIP_MEMORY_SCOPE_AGENT); }
DI unsigned xb_add(unsigned* p, unsigned v) { return __hip_atomic_fetch_add(p, v, __ATOMIC_RELAXED, __HIP_MEMORY_SCOPE_AGENT); }
DI unsigned xb_xcc_id() { return (unsigned)__builtin_amdgcn_s_getreg((3 << 11) | 20) & 0xFu; }
#define XB_SPIN(cond, bar) do { unsigned _sp = 0; while (cond) { __builtin_amdgcn_s_sleep(1); \
    if ((++_sp & 255u) == 0u) { if (xb_ld(&(bar)[XB_TMO])) break; if (_sp > XB_SPIN_CAP) { atomicAdd(&(bar)[XB_TMO], 1u); break; } } } } while (0)
struct XcdBarrier { unsigned* bar; unsigned x; volatile LAS unsigned* st; };
DI XcdBarrier xcd_barrier_post(unsigned* bar, volatile LAS unsigned* st, bool leader) {
    XcdBarrier b; b.bar = bar; b.x = xb_xcc_id(); b.st = st;
    if (leader) (void)xb_add(&bar[XB_XCNT(b.x)], 1u);
    return b;
}
DI void xcd_barrier_complete(unsigned* bar, unsigned x, unsigned& nloc, unsigned& nx) {
    const unsigned G = gridDim.x * gridDim.y * gridDim.z;
    unsigned sum, cnt, mine, sp = 0u;
    for (;;) {
        sum = 0u; cnt = 0u; mine = 0u;
#pragma unroll
        for (unsigned j = 0; j < 16; ++j) { const unsigned c = xb_ld(&bar[XB_XCNT(j)]); sum += c; cnt += (c > 0u) ? 1u : 0u; mine = (j == x) ? c : mine; }
        if (sum == G) break;
        __builtin_amdgcn_s_sleep(1);
        if ((++sp & 255u) == 0u) { if (xb_ld(&bar[XB_TMO])) break; if (sp > XB_SPIN_CAP) { atomicAdd(&bar[XB_TMO], 1u); break; } }
    }
    nloc = mine > 0u ? mine : 1u; nx = cnt > 0u ? cnt : 1u;
}
DI void xcd_barrier(const XcdBarrier& b, bool leader) {
    asm volatile("s_waitcnt vmcnt(0)" ::: "memory");
    __syncthreads();
    if (leader) {
        unsigned* bar = b.bar;
        __builtin_amdgcn_s_waitcnt(0);
        unsigned nloc = b.st[0], nx = b.st[1];
        if (nloc == 0u) { xcd_barrier_complete(bar, b.x, nloc, nx); b.st[0] = nloc; b.st[1] = nx; }
        const unsigned old = xb_add(&bar[XB_XSUB(b.x)], 1u);
        const unsigned gen = old / nloc;
        if (old + 1u == (gen + 1u) * nloc) {
            __builtin_amdgcn_fence(__ATOMIC_RELEASE, "agent");
            asm volatile("s_waitcnt vmcnt(0)" ::: "memory");
            const unsigned og = xb_add(&bar[XB_TOP], 1u);
            const unsigned tg = og / nx;
            if (og + 1u == (tg + 1u) * nx) xb_add(&bar[XB_TOPGEN], 1u);
            else XB_SPIN(xb_ld(&bar[XB_TOPGEN]) == tg, bar);
            __builtin_amdgcn_fence(__ATOMIC_ACQUIRE, "agent");
            xb_add(&bar[XB_XGEN(b.x)], 1u);
            asm volatile("s_waitcnt vmcnt(0)" ::: "memory");
        } else {
            XB_SPIN(xb_ld(&bar[XB_XGEN(b.x)]) == gen, bar);
            __builtin_amdgcn_fence(__ATOMIC_ACQUIRE, "agent");
            asm volatile("s_waitcnt vmcnt(0)" ::: "memory");
        }
    }
    __syncthreads();
}

namespace pg8 {
constexpr int BM = 256, BK = 64, HALF = 128, HTB = HALF * BK * 2;
__host__ __device__ __forceinline__ int lds_byte(int r, int c) { const int st = (r >> 4) * 2 + (c >> 5), rr = r & 15, cc = c & 31, ob = rr * 64 + cc * 2; return st * 1024 + (ob ^ (((ob >> 9) & 1) << 5)); }
__host__ __device__ __forceinline__ void stage_rc(int b, int& R, int& C) { const int st = b / 1024, sb = b % 1024, swz = sb ^ (((sb >> 9) & 1) << 5); R = (st >> 1) * 16 + swz / 64; C = (st & 1) * 32 + (swz % 64) / 2; }
__host__ __device__ __forceinline__ int perm32(int rho) { const int n = rho >> 4, i = rho & 15; return 8 * (i >> 2) + 4 * n + (i & 3); }
struct Unit { const char* a; const char* b; int pm, pn, aux, pad; };
struct Gemm { int K, lda, ldb, kstepA, hstepA; };
template <class Epi, class Sched>
DI void gemm_phase(LAS unsigned char* lds, const Gemm g, const Sched& S, const Epi& E, int tid_in) {
    int tid = tid_in; asm volatile("" : "+v"(tid));
    const int wid = __builtin_amdgcn_readfirstlane(tid >> 6), lane = tid & 63, wr = wid >> 2, wc = wid & 3, fr = lane & 15, fq = lane >> 4;
    const int K = g.K, nt = K / BK;
    unsigned voffA[2], voffB[2];
#pragma unroll
    for (int i = 0; i < 2; ++i) { int R, C; stage_rc(tid * 16 + i * 8192, R, C); const int Rb = (R & ~31) + perm32(R & 31);
        voffA[i] = (unsigned)(R * g.lda + C) * 2u; voffB[i] = (unsigned)(Rb * g.ldb + C) * 2u; }
    const size_t kstep = (size_t)(BK * 2), kstepA = (size_t)g.kstepA;
    const size_t hstepA = g.hstepA < 0 ? (size_t)HALF * g.lda * 2 : (size_t)g.hstepA, hstepB = (size_t)HALF * g.ldb * 2;
    const unsigned ldsw = (unsigned)wid * 1024u;
    const int aoff = lds_byte(wr * 64 + fr, fq * 8), boff = lds_byte(wc * 32 + fr, fq * 8);
#define PG8_SA(b, h) (((b) * 2 + (h)) * HTB)
#define PG8_SB(b, h) ((4 + (b) * 2 + (h)) * HTB)
#define PG8_STAGE(bufoff, gbase, voff) do { _Pragma("unroll") for (int _i = 0; _i < 2; ++_i) \
        __builtin_amdgcn_global_load_lds((const unsigned*)((const char*)(gbase) + (voff)[_i]), (LAS unsigned*)(lds + (bufoff) + ldsw + _i * 8192), 16, 0, 0); } while (0)
#define PG8_LDA(dst, b, h) do { _Pragma("unroll") for (int m = 0; m < 4; ++m) _Pragma("unroll") for (int k = 0; k < 2; ++k) dst[m][k] = *(const LAS bf16x8*)(lds + PG8_SA(b, h) + aoff + m * 2048 + k * 1024); } while (0)
#define PG8_LDB(dst, b, h) do { _Pragma("unroll") for (int n = 0; n < 2; ++n) _Pragma("unroll") for (int k = 0; k < 2; ++k) dst[n][k] = *(const LAS bf16x8*)(lds + PG8_SB(b, h) + boff + n * 2048 + k * 1024); } while (0)
#define PG8_MMA(ai, bj, At, Bt) do { __builtin_amdgcn_s_setprio(1); _Pragma("unroll") for (int m = 0; m < 4; ++m) _Pragma("unroll") for (int n = 0; n < 2; ++n) _Pragma("unroll") for (int k = 0; k < 2; ++k) \
        acc[ai][bj][m][n] = __builtin_amdgcn_mfma_f32_16x16x32_bf16(Bt[n][k], At[m][k], acc[ai][bj][m][n], 0, 0, 0); __builtin_amdgcn_s_setprio(0); } while (0)
#define PG8_WAIT_V(n) asm volatile("s_waitcnt vmcnt(" #n ")" ::: "memory")
#define PG8_WAIT_L(n) asm volatile("s_waitcnt lgkmcnt(" #n ")" ::: "memory")
#define PG8_BAR __builtin_amdgcn_s_barrier()
#define PG8_SCHED __builtin_amdgcn_sched_barrier(0)
    Unit cur, nxt; int ui = 0;
    if (!S.next(0, cur)) return;
    f32x4 acc[2][2][4][2];
#pragma unroll
    for (int a = 0; a < 2; ++a)
#pragma unroll
        for (int b = 0; b < 2; ++b)
#pragma unroll
            for (int m = 0; m < 4; ++m)
#pragma unroll
                for (int n = 0; n < 2; ++n) acc[a][b][m][n] = (f32x4){0.f, 0.f, 0.f, 0.f};
    bf16x8 At[4][2], B0[2][2], B1[2][2];
    const char* cA = cur.a; const char* cB = cur.b;
    PG8_STAGE(PG8_SB(0, 0), cB, voffB); PG8_STAGE(PG8_SB(0, 1), cB + hstepB, voffB); PG8_STAGE(PG8_SA(0, 0), cA, voffA); PG8_STAGE(PG8_SA(0, 1), cA + hstepA, voffA);
    if (wr == 1) PG8_BAR;
    PG8_WAIT_V(2); PG8_BAR;
    PG8_STAGE(PG8_SB(1, 0), cB + kstep, voffB); PG8_STAGE(PG8_SA(1, 0), cA + kstepA, voffA); PG8_STAGE(PG8_SB(1, 1), cB + hstepB + kstep, voffB);
    PG8_WAIT_V(6); PG8_BAR;
    for (;;) {
        const bool has_next = S.next(ui + 1, nxt);
        const char* nA = has_next ? nxt.a : cA; const char* nB = has_next ? nxt.b : cB;
        for (int t = 0; t < nt; t += 2) {
            const bool last = (t == nt - 2);
            const char* a1 = cA + (size_t)(t + 1) * kstepA;
            const char* a2 = last ? nA : cA + (size_t)(t + 2) * kstepA; const char* b2 = last ? nB : cB + (size_t)(t + 2) * kstep;
            const char* a3 = a2 + kstepA; const char* b3 = b2 + kstep;
            PG8_LDB(B0, 0, 0); PG8_LDB(B1, 0, 1); PG8_SCHED; PG8_LDA(At, 0, 0); PG8_STAGE(PG8_SA(1, 1), a1 + hstepA, voffA);
            PG8_WAIT_V(8); PG8_WAIT_L(0); PG8_BAR; PG8_MMA(0, 0, At, B0); PG8_MMA(0, 1, At, B1); PG8_BAR; PG8_SCHED;
            PG8_LDA(At, 0, 1); PG8_STAGE(PG8_SB(0, 0), b2, voffB); PG8_STAGE(PG8_SB(0, 1), b2 + hstepB, voffB); PG8_STAGE(PG8_SA(0, 0), a2, voffA);
            PG8_WAIT_V(8); PG8_WAIT_L(0); PG8_BAR; PG8_MMA(1, 0, At, B0); PG8_MMA(1, 1, At, B1); PG8_BAR; PG8_SCHED;
            PG8_LDB(B0, 1, 0); PG8_LDB(B1, 1, 1); PG8_SCHED; PG8_LDA(At, 1, 0); PG8_STAGE(PG8_SA(0, 1), a2 + hstepA, voffA);
            PG8_WAIT_V(8); PG8_WAIT_L(0); PG8_BAR; PG8_MMA(0, 0, At, B0); PG8_MMA(0, 1, At, B1); PG8_BAR; PG8_SCHED;
            PG8_LDA(At, 1, 1); PG8_STAGE(PG8_SB(1, 0), b3, voffB); PG8_STAGE(PG8_SB(1, 1), b3 + hstepB, voffB); PG8_STAGE(PG8_SA(1, 0), a3, voffA);
            PG8_WAIT_V(8); PG8_WAIT_L(0); PG8_BAR; PG8_MMA(1, 0, At, B0); PG8_MMA(1, 1, At, B1); PG8_BAR; PG8_SCHED;
        }
        if (wr == 0) PG8_BAR;
        { const int el = my_lane(); E(acc, cur, wr, wc, el & 15, el >> 4); }
        if (!has_next) break;
#pragma unroll
        for (int a = 0; a < 2; ++a)
#pragma unroll
            for (int b = 0; b < 2; ++b)
#pragma unroll
                for (int m = 0; m < 4; ++m)
#pragma unroll
                    for (int n = 0; n < 2; ++n) acc[a][b][m][n] = (f32x4){0.f, 0.f, 0.f, 0.f};
        cur = nxt; cA = nA; cB = nB; ++ui;
        if (wr == 1) PG8_BAR;
    }
    PG8_WAIT_V(0);
    PG8_BAR;
#undef PG8_SA
#undef PG8_SB
#undef PG8_STAGE
#undef PG8_LDA
#undef PG8_LDB
#undef PG8_MMA
#undef PG8_WAIT_V
#undef PG8_WAIT_L
#undef PG8_BAR
#undef PG8_SCHED
}
}
using pg8::Unit;

DI unsigned cvt_pk_bf16(float lo, float hi) { unsigned r; asm volatile("s_nop 1\n\tv_cvt_pk_bf16_f32 %0, %1, %2" : "=v"(r) : "v"(lo), "v"(hi)); return r; }
DI u32x4 pack8(const f32x4& v0, const f32x4& v1) { u32x4 w; w.x = cvt_pk_bf16(v0[0], v0[1]); w.y = cvt_pk_bf16(v0[2], v0[3]); w.z = cvt_pk_bf16(v1[0], v1[1]); w.w = cvt_pk_bf16(v1[2], v1[3]); return w; }

struct SchedP1 {
    const char* A; const char* B; int G, c;
    DI bool next(int i, Unit& u) const {
        constexpr int nM = 128, nN = 26, nwg = nM * nN, NXCD = 8, WGM = 8;
        const long L = (long)i * G + c; if (L >= nwg) return false;
        int wgid = (int)L; { const int q = nwg / NXCD, r = nwg % NXCD, xcd = wgid % NXCD, off = wgid / NXCD; wgid = (xcd < r ? xcd * (q + 1) : r * (q + 1) + (xcd - r) * q) + off; }
        const int nig = WGM * nN, gid = wgid / nig, fm = gid * WGM, gsz = (nM - fm) < WGM ? (nM - fm) : WGM;
        u.pm = fm + ((wgid % nig) % gsz); u.pn = (wgid % nig) / gsz; u.aux = 0; u.pad = 0;
        u.a = A + (size_t)u.pm * 256 * 1024 * 2; u.b = B + (size_t)u.pn * 256 * 1024 * 2; return true;
    }
};
struct SchedP3a {
    const char* ys; const char* wbr; int G, c;
    DI bool next(int i, Unit& u) const {
        const int tile = (i >> 2) * G + c; if (tile >= 512) return false;
        const int br = i & 3; u.pm = tile >> 2; u.pn = tile & 3; u.aux = br; u.pad = 0;
        u.a = ys + ((size_t)u.pm * 256 * 1024 + br * 256) * 2; u.b = wbr + ((size_t)br * 1024 * 256 + (size_t)u.pn * 256 * 256) * 2; return true;
    }
};
struct SchedP3b {
    const char* A; const char* B; int G, c;
    DI bool next(int i, Unit& u) const {
        const int L = i * G + c; if (L >= 512) return false;
        u.pm = L >> 2; u.pn = L & 3; u.aux = 0; u.pad = 0;
        u.a = A + (size_t)u.pm * 256 * 1024 * 2; u.b = B + (size_t)u.pn * 256 * 1024 * 2; return true;
    }
};
struct SchedM2 {
    const char* xs; const char* wgu; const LAS int* offt; int G, c;
    DI bool next(int i, Unit& u) const {
        const int NT = __builtin_amdgcn_readfirstlane(offt[32]) >> 8; const int L = i * G + c; if (L >= NT * 2) return false;
        const int rt = L >> 1, pn = L & 1; const int e = __builtin_amdgcn_readfirstlane(offt[40 + rt]);
        u.pm = rt; u.pn = pn; u.aux = e; u.pad = 0;
        u.a = xs + (size_t)rt * 256 * 1024 * 2; u.b = wgu + ((size_t)e * 512 + pn * 256) * 1024 * 2; return true;
    }
};
struct SchedM3 {
    const char* hmid; const char* wd; const LAS int* offt; int G, c;
    DI bool next(int i, Unit& u) const {
        const int NT = __builtin_amdgcn_readfirstlane(offt[32]) >> 8; const int L = i * G + c; if (L >= NT * 4) return false;
        const int rt = L >> 2, pn = L & 3; const int e = __builtin_amdgcn_readfirstlane(offt[40 + rt]);
        u.pm = rt; u.pn = pn; u.aux = e; u.pad = 0;
        u.a = hmid + (size_t)rt * 256 * 256 * 2; u.b = wd + ((size_t)e * 1024 + pn * 256) * 256 * 2; return true;
    }
};

struct EpiP1 {
    bf16* proj; bf16* gates; const float* bgate;
    DI void operator()(const f32x4 (&acc)[2][2][4][2], const Unit& u, int wr, int wc, int fr, int fq) const {
        const int row0 = u.pm * 256 + wr * 64 + fr; const int colt = u.pn * 256 + wc * 32 + 8 * fq;
        if (u.pn < 10) {
#pragma unroll
            for (int ai = 0; ai < 2; ++ai)
#pragma unroll
                for (int m = 0; m < 4; ++m) { bf16* rowp = proj + (size_t)(row0 + ai * 128 + m * 16) * PLD + colt;
#pragma unroll
                    for (int bj = 0; bj < 2; ++bj) *(u32x4*)(rowp + bj * 128) = pack8(acc[ai][bj][m][0], acc[ai][bj][m][1]); }
        } else {
            const int gcol = colt - 2560;
            f32x4 bv[2][2];
#pragma unroll
            for (int bj = 0; bj < 2; ++bj)
#pragma unroll
                for (int n = 0; n < 2; ++n) bv[bj][n] = *(const f32x4*)(bgate + gcol + bj * 128 + 4 * n);
#pragma unroll
            for (int ai = 0; ai < 2; ++ai)
#pragma unroll
                for (int m = 0; m < 4; ++m) { bf16* rowp = gates + (size_t)(row0 + ai * 128 + m * 16) * GLD + gcol;
#pragma unroll
                    for (int bj = 0; bj < 2; ++bj) { f32x4 v0 = acc[ai][bj][m][0] + bv[bj][0], v1 = acc[ai][bj][m][1] + bv[bj][1];
#pragma unroll
                        for (int e = 0; e < 4; ++e) { v0[e] = sigmoidf_(v0[e]); v1[e] = sigmoidf_(v1[e]); }
                        *(u32x4*)(rowp + bj * 128) = pack8(v0, v1); }
                    __builtin_amdgcn_sched_barrier(0); }
        }
    }
};
struct EpiP3a {
    bf16* merged; const bf16* gates;
    DI void operator()(const f32x4 (&acc)[2][2][4][2], const Unit& u, int wr, int wc, int fr, int fq) const {
        const int row0 = u.pm * 256 + wr * 64 + fr; const int colt = u.pn * 256 + wc * 32 + 8 * fq; const int br = u.aux;
#pragma unroll
        for (int ai = 0; ai < 2; ++ai)
#pragma unroll
            for (int m = 0; m < 4; ++m) { const size_t row = (size_t)(row0 + ai * 128 + m * 16);
#pragma unroll
                for (int bj = 0; bj < 2; ++bj) {
                    const u32x4 gw = *(const u32x4*)(gates + row * GLD + br * 1024 + colt + bj * 128);
                    bf16* mp = merged + row * 1024 + colt + bj * 128;
                    f32x4 v0 = acc[ai][bj][m][0], v1 = acc[ai][bj][m][1];
                    v0[0] *= lo_bf(gw.x); v0[1] *= hi_bf(gw.x); v0[2] *= lo_bf(gw.y); v0[3] *= hi_bf(gw.y);
                    v1[0] *= lo_bf(gw.z); v1[1] *= hi_bf(gw.z); v1[2] *= lo_bf(gw.w); v1[3] *= hi_bf(gw.w);
                    if (br != 0) { const u32x4 mw = *(const u32x4*)mp;
                        v0[0] += lo_bf(mw.x); v0[1] += hi_bf(mw.x); v0[2] += lo_bf(mw.y); v0[3] += hi_bf(mw.y);
                        v1[0] += lo_bf(mw.z); v1[1] += hi_bf(mw.z); v1[2] += lo_bf(mw.w); v1[3] += hi_bf(mw.w); }
                    *(u32x4*)mp = pack8(v0, v1); }
                __builtin_amdgcn_sched_barrier(0); }
    }
};
struct EpiP3b {
    const float* xin; float* out;
    DI void operator()(const f32x4 (&acc)[2][2][4][2], const Unit& u, int wr, int wc, int fr, int fq) const {
        const int row0 = u.pm * 256 + wr * 64 + fr; const int colt = u.pn * 256 + wc * 32 + 8 * fq;
#pragma unroll
        for (int ai = 0; ai < 2; ++ai)
#pragma unroll
            for (int m = 0; m < 4; ++m) { const size_t off = (size_t)(row0 + ai * 128 + m * 16) * 1024 + colt;
#pragma unroll
                for (int bj = 0; bj < 2; ++bj)
#pragma unroll
                    for (int n = 0; n < 2; ++n) { const f32x4 xv = *(const f32x4*)(xin + off + bj * 128 + 4 * n); *(f32x4*)(out + off + bj * 128 + 4 * n) = xv + acc[ai][bj][m][n]; }
                __builtin_amdgcn_sched_barrier(0); }
    }
};
struct EpiM2 {
    bf16* hmid;
    DI void operator()(const f32x4 (&acc)[2][2][4][2], const Unit& u, int wr, int wc, int fr, int fq) const {
        const int row0 = u.pm * 256 + wr * 64 + fr; const int col = u.pn * 128 + wc * 32 + 8 * fq;
#pragma unroll
        for (int ai = 0; ai < 2; ++ai)
#pragma unroll
            for (int m = 0; m < 4; ++m) { f32x4 h0, h1;
#pragma unroll
                for (int e = 0; e < 4; ++e) { const float g0 = acc[ai][0][m][0][e], g1 = acc[ai][0][m][1][e];
                    h0[e] = g0 * sigmoidf_(g0) * acc[ai][1][m][0][e]; h1[e] = g1 * sigmoidf_(g1) * acc[ai][1][m][1][e]; }
                *(u32x4*)(hmid + (size_t)(row0 + ai * 128 + m * 16) * 256 + col) = pack8(h0, h1); }
    }
};
struct EpiM3 {
    bf16* eo; const int* rowtok; const float* roww;
    DI void operator()(const f32x4 (&acc)[2][2][4][2], const Unit& u, int wr, int wc, int fr, int fq) const {
        const int row0 = u.pm * 256 + wr * 64 + fr; const int colt = u.pn * 256 + wc * 32 + 8 * fq;
#pragma unroll
        for (int ai = 0; ai < 2; ++ai)
#pragma unroll
            for (int m = 0; m < 4; ++m) { const int row = row0 + ai * 128 + m * 16; const int tk = rowtok[row];
                if (tk >= 0) { const float w = roww[row]; bf16* op = eo + (size_t)tk * 1024 + colt;
#pragma unroll
                    for (int bj = 0; bj < 2; ++bj) *(u32x4*)(op + bj * 128) = pack8(acc[ai][bj][m][0] * w, acc[ai][bj][m][1] * w); }
                __builtin_amdgcn_sched_barrier(0); }
    }
};

struct Args { const float* in[36]; float* out; unsigned char* ws; int ph_lo, ph_hi; };
struct InTab { unsigned base;
    DI const float* operator[](int i) const { unsigned long long v; const unsigned addr = base + (unsigned)i * 8u;
        asm volatile("ds_read_b64 %0, %1\n\ts_waitcnt lgkmcnt(0)" : "=v"(v) : "v"(addr) : "memory");
        const unsigned lo = __builtin_amdgcn_readfirstlane((unsigned)v), hi = __builtin_amdgcn_readfirstlane((unsigned)(v >> 32));
        return (const float*)(((unsigned long long)hi << 32) | lo); } };
struct KA { InTab in; float* out; unsigned char* ws; };

DI void transpose_item(const float* W_, int ldw, int nvalid, bf16* WT_, int ldt, int k0, int n0, int dst_row0, LAS float* scr, int lane) {
    const GAS float* W = (const GAS float*)W_; GAS bf16* WT = (GAS bf16*)WT_;
    const int nq = 4 * (lane & 7), kr8 = lane >> 3;
    f32x4 v[8];
#pragma unroll
    for (int i = 0; i < 8; ++i) { const int kk = 8 * i + kr8;
        if (n0 + nq + 3 < nvalid) v[i] = *(const GAS f32x4*)(W + (size_t)(k0 + kk) * ldw + n0 + nq);
        else {
#pragma unroll
            for (int e = 0; e < 4; ++e) v[i][e] = (n0 + nq + e < nvalid) ? W[(size_t)(k0 + kk) * ldw + n0 + nq + e] : 0.f; } }
#pragma unroll
    for (int i = 0; i < 8; ++i) { const int kk = 8 * i + kr8;
#pragma unroll
        for (int e = 0; e < 4; ++e) scr[kk * 33 + nq + e] = v[i][e]; }
    LDS_WAIT(); asm volatile("" ::: "memory");
    const int c = lane & 7;
#pragma unroll
    for (int j = 0; j < 4; ++j) { const int n = (lane >> 3) + 8 * j; const LAS float* s = scr + (8 * c) * 33 + n;
        u32x4 o; o.x = pk2(s[0 * 33], s[1 * 33]); o.y = pk2(s[2 * 33], s[3 * 33]); o.z = pk2(s[4 * 33], s[5 * 33]); o.w = pk2(s[6 * 33], s[7 * 33]);
        if (n0 + n < nvalid) *(GAS u32x4*)(WT + (size_t)(dst_row0 + n) * ldt + k0 + 8 * c) = o; }
    LDS_WAIT(); asm volatile("" ::: "memory");
}
DI void phase0_weights(const KA& a, int l, LAS unsigned char* lds, int gw, int NGW, int wave, int lane) {
    LAS float* scr = (LAS float*)(lds + wave * 16384);
    const float* w_in = a.in[4] + (size_t)l * 1024 * NIN;
    const float* w_gate = a.in[24] + (size_t)l * 4 * 1024 * 1024;
    const float* w_br = a.in[26] + (size_t)l * 4 * 256 * 1024;
    const float* w_out = a.in[27] + (size_t)l * 1024 * 1024;
    bf16* Wt_in = (bf16*)(a.ws + WS_WIN); bf16* Wt_br = (bf16*)(a.ws + WS_WBR); bf16* Wt_out = (bf16*)(a.ws + WS_WOUT);
    constexpr int I_IN = 16 * 77, I_G = 4 * 16 * 32, I_B = 4 * 4 * 32, I_O = 16 * 32, NIT = I_IN + I_G + I_B + I_O;
    for (int it = gw; it < NIT; it += NGW) {
        int r = it;
        if (r < I_IN) { const int kb = r / 77, nb = r % 77; transpose_item(w_in, NIN, NIN, Wt_in, 1024, kb * 64, nb * 32, nb * 32, scr, lane); continue; } r -= I_IN;
        if (r < I_G) { const int br = r / 512, q = r % 512, kb = q / 32, nb = q % 32; transpose_item(w_gate + (size_t)br * 1024 * 1024, 1024, 1024, Wt_in, 1024, kb * 64, nb * 32, 2560 + br * 1024 + nb * 32, scr, lane); continue; } r -= I_G;
        if (r < I_B) { const int br = r / 128, q = r % 128, kb = q / 32, nb = q % 32; transpose_item(w_br + (size_t)br * 256 * 1024, 1024, 1024, Wt_br + (size_t)br * 1024 * 256, 256, kb * 64, nb * 32, nb * 32, scr, lane); continue; } r -= I_B;
        { const int kb = r / 32, nb = r % 32; transpose_item(w_out, 1024, 1024, Wt_out, 1024, kb * 64, nb * 32, nb * 32, scr, lane); }
    }
}

DI void router_weights(const KA& a, int l, int gw, int NGW, int lane) {
    bf16* Wr = (bf16*)(a.ws + WS_WR);
    const float* wg = a.in[29] + (size_t)l * 1024 * 4; const float* we = a.in[31] + (size_t)l * 1024 * 32;
    for (int n = gw; n < 36; n += NGW) {
        for (int i = 0; i < 16; ++i) { const int k = lane + 64 * i; const float w = (n < 4) ? wg[k * 4 + n] : we[k * 32 + (n - 4)];
            const unsigned hi = f2bf(w); const float hf = __builtin_bit_cast(float, hi << 16); const unsigned lo = f2bf(w - hf);
            Wr[(size_t)n * 2048 + k] = (bf16)hi; Wr[(size_t)n * 2048 + 1024 + k] = (bf16)hi; Wr[(size_t)(64 + n) * 2048 + k] = (bf16)lo; Wr[(size_t)(64 + n) * 2048 + 1024 + k] = 0; }
    }
}

DI void cmp_weights(const KA& a, int l, LAS unsigned char* lds, int gw, int NGW, int wave, int lane) {
    LAS float* scr = (LAS float*)(lds + wave * 16384);
    bf16* Wc = (bf16*)(a.ws + WS_WCMP); float* pt = (float*)(a.ws + WS_CMPAB + 2 * MiB);
    for (int it = gw; it < 2 * 32 * 2 + 2; it += NGW) {
        if (it < 128) { const int kv = it >> 6, q = it & 63, kb = q >> 1, nb = q & 1; const float* w1 = a.in[kv ? 22 : 19] + (size_t)l * 2048 * 64;
            bf16* dst = Wc + (size_t)kv * 256 * 1024 - (kb >= 16 ? 1024 : 0);
            transpose_item(w1, 64, 64, dst, 1024, kb * 64, nb * 32, (kb >= 16 ? 64 : 0) + nb * 32, scr, lane);
        } else { const int kv = it - 128; const float* w1 = a.in[kv ? 22 : 19] + (size_t)l * 2048 * 64; const float* pos = a.in[kv ? 21 : 18] + (size_t)l * 2048;
            float acc = 0.f;
            for (int k = 0; k < 2048; ++k) acc += pos[k] * w1[(size_t)k * 64 + lane];
            pt[kv * 64 + lane] = acc; }
    }
}

DI void lru_weights(const KA& a, int l, int gw, int NGW, int lane) {
    bf16* W = (bf16*)(a.ws + WS_LRUW); const float* wa = a.in[7] + (size_t)l * 4 * 4096; const float* wx = a.in[9] + (size_t)l * 4 * 4096;
    (void)NGW; { const int idx = gw * 64 + lane; if (idx < 32768) { const int i = idx & 63, j = (idx >> 6) & 63, mat = (idx >> 12) & 1, hbk = idx >> 13;
        W[idx] = (bf16)f2bf((mat ? wx : wa)[(size_t)hbk * 4096 + i * 64 + j]); } }
}
DI void phase0_rows(const KA& a, int l, int mode, int gw, int NGW, int lane) {
    const GAS float* xin = (const GAS float*)((l == 0) ? a.in[0] : a.out);
    const GAS bf16* eo = (const GAS bf16*)(a.ws + WS_PROJ);
    GAS bf16* hb = (GAS bf16*)(a.ws + WS_HB); GAS float* outp = (GAS float*)a.out;
    const GAS float* g = (const GAS float*)(mode ? a.in[2] : (a.in[3] + (size_t)l * 1024));
    f32x4 gv[4];
#pragma unroll
    for (int j = 0; j < 4; ++j) gv[j] = *(const GAS f32x4*)(g + 4 * (lane + 64 * j));
    for (int m0 = gw * 4; m0 < T; m0 += NGW * 4) {
        f32x4 v[4][4]; float ss[4];
#pragma unroll
        for (int rr = 0; rr < 4; ++rr)
#pragma unroll
            for (int j = 0; j < 4; ++j) v[rr][j] = *(const GAS f32x4*)(xin + (size_t)(m0 + rr) * 1024 + 4 * (lane + 64 * j));
        if (l > 0) {
#pragma unroll
            for (int rr = 0; rr < 4; ++rr)
#pragma unroll
                for (int j = 0; j < 4; ++j) {
                    const u32x2 e0 = *(const GAS u32x2*)(eo + (size_t)(2 * (m0 + rr)) * 1024 + 4 * (lane + 64 * j));
                    const u32x2 e1 = *(const GAS u32x2*)(eo + (size_t)(2 * (m0 + rr) + 1) * 1024 + 4 * (lane + 64 * j));
                    v[rr][j][0] += lo_bf(e0.x) + lo_bf(e1.x); v[rr][j][1] += hi_bf(e0.x) + hi_bf(e1.x); v[rr][j][2] += lo_bf(e0.y) + lo_bf(e1.y); v[rr][j][3] += hi_bf(e0.y) + hi_bf(e1.y); } }
#pragma unroll
        for (int rr = 0; rr < 4; ++rr) { float t = 0.f;
#pragma unroll
            for (int j = 0; j < 4; ++j) t += (v[rr][j][0] * v[rr][j][0] + v[rr][j][1] * v[rr][j][1]) + (v[rr][j][2] * v[rr][j][2] + v[rr][j][3] * v[rr][j][3]);
            ss[rr] = t; }
#pragma unroll
        for (int rr = 0; rr < 4; ++rr) ss[rr] = wave_sum(ss[rr]);
#pragma unroll
        for (int rr = 0; rr < 4; ++rr) { const float r = 1.f / sqrtf(ss[rr] * (1.f / 1024.f) + 1e-6f); const size_t m = (size_t)(m0 + rr);
#pragma unroll
            for (int j = 0; j < 4; ++j) { const f32x4 y = v[rr][j] * r * gv[j];
                if (mode) *(GAS f32x4*)(outp + m * 1024 + 4 * (lane + 64 * j)) = y;
                else { if (l > 0) *(GAS f32x4*)(outp + m * 1024 + 4 * (lane + 64 * j)) = v[rr][j];
                       u32x2 w; w.x = pk2(y[0], y[1]); w.y = pk2(y[2], y[3]); *(GAS u32x2*)(hb + m * 1024 + 4 * (lane + 64 * j)) = w; } } }
    }
}

DI int crow(int i, int hh) { return (i & 3) + 8 * (i >> 2) + 4 * hh; }
DI unsigned cvtpk(float lo, float hi) { f32x2 v = {lo, hi}; bf16x2_t b = __builtin_convertvector(v, bf16x2_t); return __builtin_bit_cast(unsigned, b); }
template <int CTRL, int RMASK> DI float dppf(float oldv, float v) { return __builtin_bit_cast(float, __builtin_amdgcn_update_dpp(__builtin_bit_cast(int, oldv), __builtin_bit_cast(int, v), CTRL, RMASK, 0xf, false)); }
template <int CTRL, int RMASK> DI void scan_step(float& a, float& b) {
    const float ap = dppf<CTRL, RMASK>(1.f, a), bp = dppf<CTRL, RMASK>(0.f, b); b = a * bp + b; a = a * ap; }
DI void lru_unit(const KA& a, int l, const GAS bf16* proj, GAS bf16* ys, GAS float* sums, LAS unsigned char* lds, int task, int lane_in, int wave_in, bool final) {
    int lane = lane_in, wave = wave_in; asm volatile("" : "+v"(lane), "+s"(wave));
    const int chunk = task & 31, hbk = (task >> 5) & 3, b = task >> 7;
    const int ts = chunk * 256 + wave * 32; const size_t rowb = (size_t)b * SEQ;
    LAS unsigned char* wl = lds + wave * 16384;
    LAS float* ex = (LAS float*)(lds + LRUEX_OFF); LAS float* cst = (LAS float*)(lds + LRUCST_OFF); LAS float* car = (LAS float*)(lds + LRUCAR_OFF) + wave * 64;
    {
        const int c = hbk * 64 + lane;
        const GAS float* cw = (const GAS float*)(a.in[5] + (size_t)l * 4 * 256);
        const float cw0 = cw[c], cw1 = cw[256 + c], cw2 = cw[512 + c], cw3 = cw[768 + c]; const float cb = a.in[6][l * 256 + c];
        if (wave == 0) { cst[lane] = a.in[8][l * 256 + c]; cst[64 + lane] = a.in[10][l * 256 + c]; cst[128 + lane] = -8.f * softplusf_(-a.in[11][l * 256 + c]); }
        const GAS bf16* xp = proj + (rowb + ts) * PLD + C_AX + c;
        float x3 = (ts >= 3) ? bf2f(*(xp - 3 * PLD)) : 0.f, x2 = (ts >= 2) ? bf2f(*(xp - 2 * PLD)) : 0.f, x1 = (ts >= 1) ? bf2f(*(xp - PLD)) : 0.f;
#pragma unroll 8
        for (int n = 0; n < 32; ++n) { const float x0 = bf2f(xp[(size_t)n * PLD]); const float xc = cb + cw0 * x3 + cw1 * x2 + cw2 * x1 + cw3 * x0;
            *(LAS bf16*)(wl + n * 144 + lane * 2) = (bf16)f2bf(xc); *(LAS float*)(wl + 4608 + n * 272 + lane * 4) = xc; x3 = x2; x2 = x1; x1 = x0; }
    }
    const int n = lane & 31, hh = lane >> 5;
    f32x16 D[4];
    {
        const GAS bf16* wt = (const GAS bf16*)(a.ws + WS_LRUW) + (size_t)hbk * 8192;
        bf16x8 bfr[4];
        LDS_WAIT();
#pragma unroll
        for (int s4 = 0; s4 < 4; ++s4) bfr[s4] = *(const LAS bf16x8*)(wl + n * 144 + hh * 16 + s4 * 32);
#pragma unroll
        for (int m = 0; m < 4; ++m) {
#pragma unroll
            for (int s4 = 0; s4 < 4; ++s4) { const bf16x8 af = *(const GAS bf16x8*)(wt + (size_t)(m >> 1) * 4096 + (32 * (m & 1) + n) * 64 + 8 * hh + 16 * s4);
                if (s4 == 0) { f32x16 z;
#pragma unroll
                    for (int i = 0; i < 16; ++i) z[i] = 0.f;
                    D[m] = MFMA32(af, bfr[s4], z); } else D[m] = MFMA32(af, bfr[s4], D[m]); } }
    }
    __syncthreads();
    const bool t0 = (ts + n) == 0;
#pragma unroll
    for (int mm = 0; mm < 2; ++mm)
#pragma unroll
        for (int g4 = 0; g4 < 4; ++g4) { const int c0 = 32 * mm + 8 * g4 + 4 * hh;
            const f32x4 vba = *(const LAS f32x4*)(cst + c0), vbx = *(const LAS f32x4*)(cst + 64 + c0), vc8 = *(const LAS f32x4*)(cst + 128 + c0);
            const f32x4 vxc = *(const LAS f32x4*)(wl + 4608 + n * 272 + c0 * 4);
#pragma unroll
            for (int e = 0; e < 4; ++e) { const int i = 4 * g4 + e;
                const float r = sigmoidf_(D[mm][i] + vba[e]), ig = sigmoidf_(D[2 + mm][i] + vbx[e]);
                const float la = vc8[e] * r; const float av = __expf(la);
                const float mult = t0 ? 1.f : sqrtf(fmaxf(1.f - __expf(2.f * la), 0.f));
                float aa = av, bb = mult * ig * vxc[e];
                scan_step<0x111, 0xf>(aa, bb); scan_step<0x112, 0xf>(aa, bb); scan_step<0x114, 0xf>(aa, bb); scan_step<0x118, 0xf>(aa, bb); scan_step<0x142, 0xa>(aa, bb);
                D[mm][i] = aa; D[2 + mm][i] = bb; } }
    if (n == 31) {
#pragma unroll
        for (int mm = 0; mm < 2; ++mm)
#pragma unroll
            for (int i = 0; i < 16; ++i) { const int c = 32 * mm + crow(i, hh); ex[(wave * 64 + c) * 2] = D[mm][i]; ex[(wave * 64 + c) * 2 + 1] = D[2 + mm][i]; } }
    __syncthreads();
    if (!final) {
        if (wave == 0) { float hv = 0.f, av = 1.f;
#pragma unroll
            for (int w = 0; w < 8; ++w) { const float A_ = ex[(w * 64 + lane) * 2], H_ = ex[(w * 64 + lane) * 2 + 1]; hv = A_ * hv + H_; av *= A_; }
            GAS float* sp = sums + ((size_t)((b * 4 + hbk) * 32 + chunk) * 64 + lane) * 2; sp[0] = av; sp[1] = hv; }
    } else {
        {   float hv = 0.f;
            for (int cc = 0; cc < chunk; ++cc) { const GAS float* sp = sums + ((size_t)((b * 4 + hbk) * 32 + cc) * 64 + lane) * 2; hv = sp[0] * hv + sp[1]; }
            for (int w = 0; w < wave; ++w) { const float A_ = ex[(w * 64 + lane) * 2], H_ = ex[(w * 64 + lane) * 2 + 1]; hv = A_ * hv + H_; }
            car[lane] = hv; }
        LDS_WAIT(); asm volatile("" ::: "memory");
        const GAS bf16* gp = proj + (rowb + ts + n) * PLD + C_AG + hbk * 64; GAS bf16* yp = ys + (rowb + ts + n) * 1024 + hbk * 64;
#pragma unroll
        for (int mm = 0; mm < 2; ++mm)
#pragma unroll
            for (int g4 = 0; g4 < 4; ++g4) { const int c0 = 32 * mm + 8 * g4 + 4 * hh; const f32x4 cv = *(const LAS f32x4*)(car + c0);
                float y[4];
#pragma unroll
                for (int e = 0; e < 4; ++e) { const int i = 4 * g4 + e; const float hv = D[2 + mm][i] + D[mm][i] * cv[e];
                    const float gt = bf2f(gp[c0 + e]); y[e] = hv * gelu_tanh(gt); }
#pragma unroll
                for (int e = 0; e < 4; ++e) yp[c0 + e] = (bf16)f2bf(y[e]); }
    }
    __syncthreads();
}

constexpr int DK_STR = 144, DV_STR = 192, DBUF_BYTES = 64 * DK_STR + 64 * DV_STR;
DI bf16x8 pack_half(const f32x16& x, int s2) { u32x4 p;
    if (s2 == 0) { p.x = cvtpk(x[0], x[1]); p.y = cvtpk(x[2], x[3]); p.z = cvtpk(x[4], x[5]); p.w = cvtpk(x[6], x[7]); }
    else { p.x = cvtpk(x[8], x[9]); p.y = cvtpk(x[10], x[11]); p.z = cvtpk(x[12], x[13]); p.w = cvtpk(x[14], x[15]); }
    return __builtin_bit_cast(bf16x8, p); }
DI s16x4 vtr(const LAS unsigned char* p) { return __builtin_bit_cast(s16x4, __builtin_amdgcn_ds_read_tr16_b64_v4i16((LAS v4i16_t*)p)); }
DI float max16(const f32x16& x) { float a = fmaxf(fmaxf(x[0], x[1]), fmaxf(x[2], x[3])), b = fmaxf(fmaxf(x[4], x[5]), fmaxf(x[6], x[7])), c = fmaxf(fmaxf(x[8], x[9]), fmaxf(x[10], x[11])), d = fmaxf(fmaxf(x[12], x[13]), fmaxf(x[14], x[15])); return fmaxf(fmaxf(a, b), fmaxf(c, d)); }
DI void diff_unit(const GAS bf16* proj, GAS bf16* ys, LAS unsigned char* lds, const LAS float* bias2, const GAS float* subg, const LAS float* lamp, int b, int h, int qb, int wave_in) {
    int wave = wave_in; asm volatile("" : "+s"(wave)); const int lane = my_lane(); const int tid = wave * 64 + lane;
    const int q0 = qb * 256 + wave * 32; const int ql = lane & 31, hh = lane >> 5; const int q = q0 + ql;
    const size_t rowb = (size_t)b * SEQ;
    const float SC = 0.17677669529663687f * 1.4426950408889634f;
    bf16x8 qf[2][2];
    { const GAS bf16* qp = proj + (rowb + q) * PLD + C_CQ + h * 64 + hh * 8;
#pragma unroll
      for (int m = 0; m < 2; ++m)
#pragma unroll
        for (int s = 0; s < 2; ++s) { const u32x4 w = *(const GAS u32x4*)(qp + m * 32 + s * 16); u32x4 o;
            o.x = cvtpk(lo_bf(w.x) * SC, hi_bf(w.x) * SC); o.y = cvtpk(lo_bf(w.y) * SC, hi_bf(w.y) * SC); o.z = cvtpk(lo_bf(w.z) * SC, hi_bf(w.z) * SC); o.w = cvtpk(lo_bf(w.w) * SC, hi_bf(w.w) * SC);
            qf[m][s] = __builtin_bit_cast(bf16x8, o); } }
    f32x16 O[2][2], negm[2];
#pragma unroll
    for (int i = 0; i < 16; ++i) { O[0][0][i] = 0.f; O[0][1][i] = 0.f; O[1][0][i] = 0.f; O[1][1][i] = 0.f; negm[0][i] = 120.f; negm[1][i] = 120.f; }
    float lsum[2] = {0.f, 0.f};
    const int nsteps = 4 * qb + 4, mysteps = 4 * qb + (wave >> 1) + 1;
    const int skey = tid >> 3, sch = tid & 7;
    const GAS unsigned char* kgb = (const GAS unsigned char*)(proj + rowb * PLD + C_CK + h * 64);
    const GAS unsigned char* vgb = (const GAS unsigned char*)(proj + rowb * PLD + C_CV + h * 64);
    const unsigned soff = (unsigned)(skey * PLD + sch * 8) * 2u;
    u32x4 kr = *(const GAS u32x4*)(kgb + soff), vr = *(const GAS u32x4*)(vgb + soff);
    *(LAS u32x4*)(lds + skey * DK_STR + sch * 16) = kr; *(LAS u32x4*)(lds + 64 * DK_STR + skey * DV_STR + sch * 16) = vr;
    __syncthreads();
    const int i16 = lane & 15, blk = (lane >> 4) & 1;
    const int kboff = ql * DK_STR + hh * 16;
    const int vboff = 64 * DK_STR + (4 * hh + (i16 >> 2)) * DV_STR + (16 * blk + 4 * (i16 & 3)) * 2;
#pragma unroll 1
    for (int kt = 0; kt < nsteps; ++kt) {
        const LAS unsigned char* cur = lds + (kt & 1) * DBUF_BYTES; LAS unsigned char* nxt = lds + ((kt + 1) & 1) * DBUF_BYTES;
        if (kt + 1 < nsteps) { const unsigned so = soff + (unsigned)(kt + 1) * (64u * PLD * 2u); kr = *(const GAS u32x4*)(kgb + so); vr = *(const GAS u32x4*)(vgb + so); }
        if (kt < mysteps) {
            const int kbase = kt * 64;
            const bool near = (q0 - (kbase + 63) < 113);
#pragma unroll
            for (int m = 0; m < 2; ++m) {
                bf16x8 pk[2][2];
                f32x16 S[2]; float ts = 0.f;
                {   bf16x8 kf[2][2];
#pragma unroll
                    for (int t = 0; t < 2; ++t)
#pragma unroll
                        for (int s = 0; s < 2; ++s) kf[t][s] = *(const LAS bf16x8*)(cur + kboff + t * 32 * DK_STR + m * 64 + s * 32);
#pragma unroll
                    for (int t = 0; t < 2; ++t) { S[t] = MFMA32(kf[t][0], qf[m][0], negm[m]); S[t] = MFMA32(kf[t][1], qf[m][1], S[t]); } }
                if (near) {
#pragma unroll
                    for (int t = 0; t < 2; ++t)
#pragma unroll
                        for (int i = 0; i < 16; ++i) { const int dist = q - (kbase + 32 * t + crow(i, hh)); const int di = dist < 128 ? dist : 128;
                            const float bv = dist >= 0 ? bias2[di * 12 + 4 + h] : -1e30f; S[t][i] += bv; } }
#pragma unroll
                for (int t = 0; t < 2; ++t)
#pragma unroll
                    for (int i = 0; i < 16; ++i) { const float p = __builtin_amdgcn_exp2f(S[t][i]); S[t][i] = p; ts += p; }
                if (__builtin_amdgcn_ballot_w64(!(ts < 1.0e30f)) != 0ull) {
                {   bf16x8 kf[2][2];
#pragma unroll
                        for (int t = 0; t < 2; ++t)
#pragma unroll
                            for (int s = 0; s < 2; ++s) kf[t][s] = *(const LAS bf16x8*)(cur + kboff + t * 32 * DK_STR + m * 64 + s * 32);
#pragma unroll
                        for (int t = 0; t < 2; ++t) { S[t] = MFMA32(kf[t][0], qf[m][0], negm[m]); S[t] = MFMA32(kf[t][1], qf[m][1], S[t]); } }
                    if (near) {
#pragma unroll
                        for (int t = 0; t < 2; ++t)
#pragma unroll
                            for (int i = 0; i < 16; ++i) { const int dist = q - (kbase + 32 * t + crow(i, hh)); const int di = dist < 128 ? dist : 128;
                                const float bv = dist >= 0 ? bias2[di * 12 + 4 + h] : -1e30f; S[t][i] += bv; } }
                    float tm = fmaxf(max16(S[0]), max16(S[1])); tm = fmaxf(tm, xshfl<32>(tm));
                    const float sh = fmaxf(tm, 0.f); const float al = __builtin_amdgcn_exp2f(-sh);
                    lsum[m] *= al; ts = 0.f;
#pragma unroll
                    for (int i = 0; i < 16; ++i) { O[m][0][i] *= al; O[m][1][i] *= al; negm[m][i] -= sh; }
#pragma unroll
                    for (int t = 0; t < 2; ++t)
#pragma unroll
                        for (int i = 0; i < 16; ++i) { const float p = __builtin_amdgcn_exp2f(S[t][i] - sh); S[t][i] = p; ts += p; }
                }
                lsum[m] += ts;
#pragma unroll
                for (int t = 0; t < 2; ++t) { pk[t][0] = pack_half(S[t], 0); pk[t][1] = pack_half(S[t], 1); }
#pragma unroll
                for (int t = 0; t < 2; ++t)
#pragma unroll
                    for (int s2 = 0; s2 < 2; ++s2)
#pragma unroll
                        for (int db = 0; db < 2; ++db) {
                            const s16x4 lo = vtr(cur + vboff + (32 * t + 16 * s2) * DV_STR + db * 64), hi = vtr(cur + vboff + (32 * t + 16 * s2 + 8) * DV_STR + db * 64);
                            const bf16x8 vf = __builtin_shufflevector(lo, hi, 0, 1, 2, 3, 4, 5, 6, 7);
                            O[m][db] = MFMA32(vf, pk[t][s2], O[m][db]); }
                ;
            }
        }
        if (kt + 1 < nsteps) { *(LAS u32x4*)(nxt + skey * DK_STR + sch * 16) = kr; *(LAS u32x4*)(nxt + 64 * DK_STR + skey * DV_STR + sch * 16) = vr; }
        __syncthreads();
    }
    const float l0 = lsum[0] + xshfl<32>(lsum[0]), l1 = lsum[1] + xshfl<32>(lsum[1]);
    const float lam = lamp[0], lam_init = lamp[1];
    const float i0 = 1.f / fmaxf(l0, 1e-30f), i1 = lam / fmaxf(l1, 1e-30f);
    float ss = 0.f;
#pragma unroll
    for (int db = 0; db < 2; ++db)
#pragma unroll
        for (int i = 0; i < 16; ++i) { const float at = O[0][db][i] * i0 - O[1][db][i] * i1; O[0][db][i] = at; ss += at * at; }
    ss += xshfl<32>(ss);
    const float r = (1.f - lam_init) / sqrtf(ss * (1.f / 64.f) + 1e-5f);
    GAS bf16* op = ys + (rowb + q) * 1024 + 512 + h * 64;
#pragma unroll
    for (int db = 0; db < 2; ++db)
#pragma unroll
        for (int gq = 0; gq < 4; ++gq) { const int d0 = 32 * db + 8 * gq + 4 * hh; const f32x4 sg = *(const GAS f32x4*)(subg + d0);
            u32x2 w; w.x = cvtpk(O[0][db][4 * gq + 0] * r * sg[0], O[0][db][4 * gq + 1] * r * sg[1]); w.y = cvtpk(O[0][db][4 * gq + 2] * r * sg[2], O[0][db][4 * gq + 3] * r * sg[3]);
            *(GAS u32x2*)(op + d0) = w; }
}

struct SchedCmp { const char* proj; const char* wc; int G, c;
    DI bool next(int i, Unit& u) const { const int L = i * G + c; if (L >= 16) return false; const int kv = L >> 3, rt = L & 7;
        u.pm = rt; u.pn = 0; u.aux = kv; u.pad = 0; u.a = proj + ((size_t)rt * 256 * 16 * PLD + (kv ? C_VC : C_KC)) * 2; u.b = wc + (size_t)kv * 256 * 1024 * 2; return true; } };
struct EpiCmp { float* ab;
    DI void operator()(const f32x4 (&acc)[2][2][4][2], const Unit& u, int wr, int wc, int fr, int fq) const {
        const int row0 = u.pm * 256 + wr * 64 + fr; const int col = wc * 32 + 8 * fq;
#pragma unroll
        for (int ai = 0; ai < 2; ++ai)
#pragma unroll
            for (int m = 0; m < 4; ++m) { float* rp = ab + ((size_t)u.aux * 2048 + row0 + ai * 128 + m * 16) * 128 + col; *(f32x4*)rp = acc[ai][0][m][0]; *(f32x4*)(rp + 4) = acc[ai][0][m][1]; }
    }
};
DI void cmp_finish(const KA& a, int l, const float* ab, bf16* kcb, int task, int lane) {
    const int kv = task / (BATCH * NCMP), r = task % (BATCH * NCMP), b = r / NCMP, c = r % NCMP;
    const float* w2 = a.in[kv ? 23 : 20] + (size_t)l * 4096; const float* pt = ab + 2 * 2048 * 128;
    const size_t g = (size_t)kv * 2048 + b * 512 + c;
    const float h1 = ab[g * 128 + lane] + ab[(g + 1) * 128 + 64 + lane] + pt[kv * 64 + lane];
    const float gl = gelu_tanh(h1); float o = 0.f;
#pragma unroll
    for (int j = 0; j < 64; ++j) o += rl(gl, j) * w2[j * 64 + lane];
    kcb[((size_t)(kv * BATCH + b) * 512 + c) * 64 + lane] = (bf16)f2bf(o);
    if (c == NCMP - 1) kcb[((size_t)(kv * BATCH + b) * 512 + NCMP) * 64 + lane] = 0;
}

DI void st_load(const GAS unsigned char* kb, const GAS unsigned char* vb, unsigned off, u32x4& kr, u32x4& vr) { kr = *(const GAS u32x4*)(kb + off); vr = *(const GAS u32x4*)(vb + off); }
DI void st_write(LAS unsigned char* buf, int skey, int sch, const u32x4& kr, const u32x4& vr) { *(LAS u32x4*)(buf + skey * DK_STR + sch * 16) = kr; *(LAS u32x4*)(buf + 64 * DK_STR + skey * DV_STR + sch * 16) = vr; }
DI void qk64(const LAS unsigned char* cur, int kboff, const bf16x8 (&qf)[4], const f32x16& cinit, f32x16 (&S)[2]) {
#pragma unroll
    for (int t = 0; t < 2; ++t) { S[t] = cinit;
#pragma unroll
        for (int s = 0; s < 4; ++s) { const bf16x8 kf = *(const LAS bf16x8*)(cur + kboff + t * 32 * DK_STR + s * 32); S[t] = MFMA32(kf, qf[s], S[t]); } }
}
DI void qk32z(const LAS unsigned char* kt32, const bf16x8 (&qf)[4], f32x16& S) {
#pragma unroll
    for (int s = 0; s < 4; ++s) { const bf16x8 kf = *(const LAS bf16x8*)(kt32 + s * 32);
        if (s == 0) { f32x16 z;
#pragma unroll
            for (int i = 0; i < 16; ++i) z[i] = 0.f;
            S = MFMA32(kf, qf[s], z); } else S = MFMA32(kf, qf[s], S); }
}
DI void pv32(const LAS unsigned char* vt32, const bf16x8 (&pk)[2], f32x16 (&O)[2]) {
#pragma unroll
    for (int s2 = 0; s2 < 2; ++s2)
#pragma unroll
        for (int db = 0; db < 2; ++db) {
            const s16x4 lo = vtr(vt32 + (16 * s2) * DV_STR + db * 64), hi = vtr(vt32 + (16 * s2 + 8) * DV_STR + db * 64);
            const bf16x8 vf = __builtin_shufflevector(lo, hi, 0, 1, 2, 3, 4, 5, 6, 7);
            O[db] = MFMA32(vf, pk[s2], O[db]); }
}
DI void mask_bias_cmp32(f32x16& S, int tcol, int cbase, int hh, const LAS float* b2h, float msub) {
#pragma unroll
    for (int i = 0; i < 16; ++i) { const int c = cbase + crow(i, hh); const int dist = tcol - 31 - 16 * c; const bool ok = dist >= 0 && c < NCMP;
        const int di = dist < 0 ? 0 : (dist < 128 ? dist : 128); S[i] = ok ? S[i] + (b2h[di * 12] - msub) : -1e30f; }
}
DI void pv64(const LAS unsigned char* cur, int vboff, const bf16x8 (&pk)[2][2], f32x16 (&O)[2]) {
#pragma unroll
    for (int t = 0; t < 2; ++t)
#pragma unroll
        for (int s2 = 0; s2 < 2; ++s2)
#pragma unroll
            for (int db = 0; db < 2; ++db) {
                const s16x4 lo = vtr(cur + vboff + (32 * t + 16 * s2) * DV_STR + db * 64), hi = vtr(cur + vboff + (32 * t + 16 * s2 + 8) * DV_STR + db * 64);
                const bf16x8 vf = __builtin_shufflevector(lo, hi, 0, 1, 2, 3, 4, 5, 6, 7);
                O[db] = MFMA32(vf, pk[t][s2], O[db]); }
}
DI void softmax_step(f32x16 (&S)[2], f32x16 (&O)[2], f32x16& negm, float& lsum, bf16x8 (&pk)[2][2]) {
    float tm = fmaxf(max16(S[0]), max16(S[1]));
    if (__builtin_amdgcn_ballot_w64(tm > 8.f) != 0ull) {
        tm = fmaxf(tm, xshfl<32>(tm)); const float sh = fmaxf(tm, 0.f); const float al = __builtin_amdgcn_exp2f(-sh);
        lsum *= al;
#pragma unroll
        for (int i = 0; i < 16; ++i) { O[0][i] *= al; O[1][i] *= al; negm[i] -= sh; S[0][i] -= sh; S[1][i] -= sh; } }
#pragma unroll
    for (int t = 0; t < 2; ++t) {
#pragma unroll
        for (int i = 0; i < 16; ++i) { const float p = __builtin_amdgcn_exp2f(S[t][i]); S[t][i] = p; lsum += p; }
        pk[t][0] = pack_half(S[t], 0); pk[t][1] = pack_half(S[t], 1); }
}
DI void mask_bias(f32x16 (&S)[2], int tcol, int kbase, int hh, int W, bool colsel, const LAS float* b2h) {
#pragma unroll
    for (int t = 0; t < 2; ++t)
#pragma unroll
        for (int i = 0; i < 16; ++i) { const int dist = tcol - (kbase + 32 * t + crow(i, hh)); const bool ok = colsel && dist >= 0 && dist < W;
            const int di = dist < 0 ? 0 : (dist < 128 ? dist : 128); S[t][i] = ok ? S[t][i] + b2h[di * 12] : -1e30f; }
}
DI void nsa_unit(const GAS bf16* proj, GAS bf16* ys, const GAS bf16* kcb, LAS unsigned char* lds, const LAS float* bias2, int b, int u, int tid_in, int lane_in, int wave_in) {
    int tid = tid_in, lane = lane_in, wave = wave_in; asm volatile("" : "+v"(tid), "+v"(lane), "+s"(wave));
    const int t0 = u * 64; const int col = lane & 31, hh = lane >> 5, tl = col >> 2, head = col & 3;
    const int t = t0 + wave * 8 + tl; const int tw0 = t0 + wave * 8;
    const size_t rowb = (size_t)b * SEQ;
    const LAS float* b2h = bias2 + 8 + head;
    bf16x8 qf[4];
    { const float SC = 0.125f * 1.4426950408889634f; const GAS bf16* qp = proj + (rowb + t) * PLD + C_DQ + head * 64 + hh * 8;
#pragma unroll
      for (int s = 0; s < 4; ++s) { const u32x4 w = *(const GAS u32x4*)(qp + s * 16); u32x4 o;
          o.x = cvtpk(lo_bf(w.x) * SC, hi_bf(w.x) * SC); o.y = cvtpk(lo_bf(w.y) * SC, hi_bf(w.y) * SC); o.z = cvtpk(lo_bf(w.z) * SC, hi_bf(w.z) * SC); o.w = cvtpk(lo_bf(w.w) * SC, hi_bf(w.w) * SC);
          qf[s] = __builtin_bit_cast(bf16x8, o); } }
    const int skey = tid >> 3, sch = tid & 7;
    const int i16 = lane & 15, blk = (lane >> 4) & 1;
    const int kboff = col * DK_STR + hh * 16;
    const int vboff = 64 * DK_STR + (4 * hh + (i16 >> 2)) * DV_STR + (16 * blk + 4 * (i16 & 3)) * 2;
    u32x4 kr, vr;
    const int ncvm = (4 * u + 3) < NCMP ? (4 * u + 3) : NCMP;
    const int nsc = (ncvm + 63) >> 6;
    const GAS unsigned char* kcp = (const GAS unsigned char*)(kcb + (size_t)(0 * BATCH + b) * 512 * 64);
    const GAS unsigned char* vcp = (const GAS unsigned char*)(kcb + (size_t)(1 * BATCH + b) * 512 * 64);
    const unsigned soffc = (unsigned)(skey * 64 + sch * 8) * 2u;
    float m1 = -120.f, l1 = 0.f;
    st_load(kcp, vcp, soffc, kr, vr); st_write(lds, skey, sch, kr, vr); __syncthreads();
#pragma unroll 1
    for (int kt = 0; kt < nsc; ++kt) {
        const LAS unsigned char* cur = lds + (kt & 1) * DBUF_BYTES; LAS unsigned char* nxt = lds + ((kt + 1) & 1) * DBUF_BYTES;
        if (kt + 1 < nsc) st_load(kcp, vcp, soffc + (unsigned)(kt + 1) * 8192u, kr, vr);
#pragma unroll
        for (int tt = 0; tt < 2; ++tt) { f32x16 S; qk32z(cur + kboff + tt * 32 * DK_STR, qf, S); mask_bias_cmp32(S, t, kt * 64 + tt * 32, hh, b2h, 0.f);
          const float tm = max16(S); const float mn = fmaxf(m1, tm); float acc = 0.f;
#pragma unroll
          for (int i = 0; i < 16; ++i) acc += __builtin_amdgcn_exp2f(S[i] - mn);
          l1 = l1 * __builtin_amdgcn_exp2f(m1 - mn) + acc; m1 = mn; }
        if (kt + 1 < nsc) st_write(nxt, skey, sch, kr, vr);
        __syncthreads();
    }
    float mf, inv;
    { const float mo = xshfl<32>(m1), lo = xshfl<32>(l1); mf = fmaxf(m1, mo); const float lf = l1 * __builtin_amdgcn_exp2f(m1 - mf) + lo * __builtin_amdgcn_exp2f(mo - mf); inv = lf > 0.f ? 1.f / lf : 0.f; }
    f32x16 Oc[2], imp[4];
#pragma unroll
    for (int i = 0; i < 16; ++i) { Oc[0][i] = 0.f; Oc[1][i] = 0.f; imp[0][i] = 0.f; imp[1][i] = 0.f; imp[2][i] = 0.f; imp[3][i] = 0.f; }
    {   st_load(kcp, vcp, soffc, kr, vr); st_write(lds, skey, sch, kr, vr); __syncthreads();
#pragma unroll 1
        for (int kt = 0; kt < nsc; ++kt) {
            const LAS unsigned char* cur = lds + (kt & 1) * DBUF_BYTES; LAS unsigned char* nxt = lds + ((kt + 1) & 1) * DBUF_BYTES;
            if (kt + 1 < nsc) st_load(kcp, vcp, soffc + (unsigned)(kt + 1) * 8192u, kr, vr);
#pragma unroll
            for (int tt = 0; tt < 2; ++tt) {
                f32x16 S; qk32z(cur + kboff + tt * 32 * DK_STR, qf, S); mask_bias_cmp32(S, t, kt * 64 + tt * 32, hh, b2h, mf);
#pragma unroll
                for (int i = 0; i < 16; ++i) S[i] = __builtin_amdgcn_exp2f(S[i]) * inv;
                bf16x8 pk[2]; pk[0] = pack_half(S, 0); pk[1] = pack_half(S, 1);
                pv32(cur + vboff + tt * 32 * DV_STR, pk, Oc);
                const int Tq = (2 * kt + tt) & 3, MB = (2 * kt + tt) >> 2;
#pragma unroll
                for (int s2 = 0; s2 < 2; ++s2) { u32x4 aw; unsigned e[8];
#pragma unroll
                    for (int jj = 0; jj < 8; ++jj) { const int kk = 16 * s2 + 8 * (jj >> 2) + 4 * hh + (jj & 3); const int delta = 32 * Tq + kk - 4 * col;
                        e[jj] = (delta == -1 || delta == 3) ? 0x3F80u : ((unsigned)delta <= 2u ? 0x4000u : 0u); }
                    aw.x = e[0] | (e[1] << 16); aw.y = e[2] | (e[3] << 16); aw.z = e[4] | (e[5] << 16); aw.w = e[6] | (e[7] << 16);
                    const bf16x8 af = __builtin_bit_cast(bf16x8, aw);
                    if (MB == 0) imp[0] = MFMA32(af, pk[s2], imp[0]); else if (MB == 1) imp[1] = MFMA32(af, pk[s2], imp[1]); else if (MB == 2) imp[2] = MFMA32(af, pk[s2], imp[2]); else imp[3] = MFMA32(af, pk[s2], imp[3]); }
                if (Tq == 3 && MB < 3) { u32x4 aw; aw.x = 0u; aw.y = 0u; aw.z = 0u; aw.w = (lane == 32) ? 0x3F800000u : 0u;
                    const bf16x8 af = __builtin_bit_cast(bf16x8, aw);
                    if (MB == 0) imp[1] = MFMA32(af, pk[1], imp[1]); else if (MB == 1) imp[2] = MFMA32(af, pk[1], imp[2]); else imp[3] = MFMA32(af, pk[1], imp[3]); }
            }
            if (kt + 1 < nsc) st_write(nxt, skey, sch, kr, vr);
            __syncthreads();
        }
    }
    unsigned ocp[2][8];
#pragma unroll
    for (int db = 0; db < 2; ++db)
#pragma unroll
        for (int i = 0; i < 8; ++i) ocp[db][i] = cvtpk(Oc[db][2 * i], Oc[db][2 * i + 1]);
    unsigned sm0 = 0u, sm1 = 0u, sm2 = 0u, sm3 = 0u;
    {   const int cur_t = t >> 6; unsigned key[16];
#pragma unroll
        for (int i = 0; i < 16; ++i) {
            float v0 = imp[0][i], v1 = imp[1][i], v2 = imp[2][i], v3 = imp[3][i];
            v0 += xshfl<1>(v0); v0 += xshfl<2>(v0); v1 += xshfl<1>(v1); v1 += xshfl<2>(v1); v2 += xshfl<1>(v2); v2 += xshfl<2>(v2); v3 += xshfl<1>(v3); v3 += xshfl<2>(v3);
            const float val = head == 0 ? v0 : (head == 1 ? v1 : (head == 2 ? v2 : v3));
            const int j = 32 * head + crow(i, hh);
            const bool forced = (j == 0) || (j == cur_t) || (j == cur_t - 1);
            unsigned fx = (unsigned)(fminf(fmaxf(val, 0.f), 31.f) * 1048576.f) + 1u;
            fx = forced ? 0x1FFFFFFu : (j <= cur_t ? fx : 0u);
            key[i] = (fx << 7) | (unsigned)(127 - j); }
#pragma unroll 1
        for (int r = 0; r < 16; ++r) {
            unsigned w = key[0];
#pragma unroll
            for (int i = 1; i < 16; ++i) w = w > key[i] ? w : key[i];
            { unsigned o = (unsigned)xshfl_i<1>((int)w); w = w > o ? w : o; o = (unsigned)xshfl_i<2>((int)w); w = w > o ? w : o; o = (unsigned)xshfl_i<32>((int)w); w = w > o ? w : o; }
            if ((w >> 7) != 0u) { const int j = 127 - (int)(w & 127u); const unsigned bit = 1u << (j & 31); const int jb = j >> 5;
                sm0 |= (jb == 0) ? bit : 0u; sm1 |= (jb == 1) ? bit : 0u; sm2 |= (jb == 2) ? bit : 0u; sm3 |= (jb == 3) ? bit : 0u; }
#pragma unroll
            for (int i = 0; i < 16; ++i) key[i] = (key[i] == w) ? 0u : key[i];
        }
    }
    f32x16 Ow[2]; float lw = 0.f;
#pragma unroll
    for (int i = 0; i < 16; ++i) { Ow[0][i] = 0.f; Ow[1][i] = 0.f; }
    {   f32x16 negm;
#pragma unroll
        for (int i = 0; i < 16; ++i) negm[i] = 120.f;
        const GAS unsigned char* kwp = (const GAS unsigned char*)(proj + rowb * PLD + C_KW); const GAS unsigned char* vwp = (const GAS unsigned char*)(proj + rowb * PLD + C_VW);
        const unsigned soffp = (unsigned)(skey * PLD + sch * 8) * 2u;
        const int s0 = (u < 8) ? 8 - u : 0;
        st_load(kwp, vwp, soffp + (unsigned)(u - 8 + s0) * (64u * PLD * 2u), kr, vr); st_write(lds, skey, sch, kr, vr); __syncthreads();
#pragma unroll 1
        for (int s = s0; s < 9; ++s) {
            const int par = (s - s0) & 1; const LAS unsigned char* cur = lds + par * DBUF_BYTES; LAS unsigned char* nxt = lds + (par ^ 1) * DBUF_BYTES;
            if (s + 1 < 9) st_load(kwp, vwp, soffp + (unsigned)(u - 8 + s + 1) * (64u * PLD * 2u), kr, vr);
            {   f32x16 S[2]; qk64(cur, kboff, qf, negm, S);
                if (s == 0 || s >= 6) mask_bias(S, t, (u - 8 + s) * 64, hh, 512, true, b2h);
                bf16x8 pk[2][2]; softmax_step(S, Ow, negm, lw, pk); pv64(cur, vboff, pk, Ow); }
            if (s + 1 < 9) st_write(nxt, skey, sch, kr, vr);
            __syncthreads();
        }
    }
    unsigned owp[2][8];
#pragma unroll
    for (int db = 0; db < 2; ++db)
#pragma unroll
        for (int i = 0; i < 8; ++i) owp[db][i] = cvtpk(Ow[db][2 * i], Ow[db][2 * i + 1]);
    f32x16 Os[2]; float lsel = 0.f;
#pragma unroll
    for (int i = 0; i < 16; ++i) { Os[0][i] = 0.f; Os[1][i] = 0.f; }
    {   f32x16 negm;
#pragma unroll
        for (int i = 0; i < 16; ++i) negm[i] = 120.f;
        const GAS unsigned char* ksp = (const GAS unsigned char*)(proj + rowb * PLD + C_KS); const GAS unsigned char* vsp = (const GAS unsigned char*)(proj + rowb * PLD + C_VS);
        const unsigned soffp = (unsigned)(skey * PLD + sch * 8) * 2u;
        u32x4 kA, vA, kB, vB;
        st_load(ksp, vsp, soffp, kr, vr); st_write(lds, skey, sch, kr, vr);
        if (u >= 1) st_load(ksp, vsp, soffp + 64u * PLD * 2u, kA, vA);
        __syncthreads();
#define SEL_STEP(J, KX, VX, KY, VY) { const int j_ = (J); \
            const LAS unsigned char* cur = lds + (j_ & 1) * DBUF_BYTES; LAS unsigned char* nxt = lds + ((j_ + 1) & 1) * DBUF_BYTES; \
            if (j_ + 2 <= u) st_load(ksp, vsp, soffp + (unsigned)(j_ + 2) * (64u * PLD * 2u), KY, VY); \
            const int jb = j_ >> 5; const unsigned smw = jb == 0 ? sm0 : (jb == 1 ? sm1 : (jb == 2 ? sm2 : sm3)); \
            const bool bit = ((smw >> (j_ & 31)) & 1u) != 0u; \
            if (__builtin_amdgcn_ballot_w64(bit) != 0ull) { \
                f32x16 S[2]; qk64(cur, kboff, qf, negm, S); \
                if (64 * j_ + 63 > tw0 - 113) mask_bias(S, t, 64 * j_, hh, 1 << 30, bit, b2h); \
                else if (!bit) { _Pragma("unroll") for (int i = 0; i < 16; ++i) { S[0][i] = -1e30f; S[1][i] = -1e30f; } } \
                bf16x8 pk[2][2]; softmax_step(S, Os, negm, lsel, pk); pv64(cur, vboff, pk, Os); } \
            if (j_ + 1 <= u) st_write(nxt, skey, sch, KX, VX); \
            __syncthreads(); }
#pragma unroll 1
        for (int j = 0; j <= u; j += 2) {
            SEL_STEP(j, kA, vA, kB, vB)
            if (j + 1 <= u) SEL_STEP(j + 1, kB, vB, kA, vA)
        }
#undef SEL_STEP
    }
    {   const float lwt = lw + xshfl<32>(lw), lst = lsel + xshfl<32>(lsel);
        const GAS bf16* gp = proj + (rowb + t) * PLD + C_DG + head * 3;
        const float g0 = sigmoidf_(bf2f(gp[0])), g1 = sigmoidf_(bf2f(gp[1])) / fmaxf(lst, 1e-30f), g2 = sigmoidf_(bf2f(gp[2])) / fmaxf(lwt, 1e-30f);
        GAS bf16* op = ys + (rowb + t) * 1024 + 768 + head * 64;
#pragma unroll
        for (int db = 0; db < 2; ++db)
#pragma unroll
            for (int gq = 0; gq < 4; ++gq) { const int d0 = 32 * db + 8 * gq + 4 * hh; float y[4];
#pragma unroll
                for (int e = 0; e < 4; ++e) { const unsigned cw = ocp[db][2 * gq + (e >> 1)], ww = owp[db][2 * gq + (e >> 1)];
                    y[e] = g0 * ((e & 1) ? hi_bf(cw) : lo_bf(cw)) + g1 * Os[db][4 * gq + e] + g2 * ((e & 1) ? hi_bf(ww) : lo_bf(ww)); }
                u32x2 w; w.x = cvtpk(y[0], y[1]); w.y = cvtpk(y[2], y[3]); *(GAS u32x2*)(op + d0) = w; }
    }
}


DI void swa_unit(const GAS bf16* proj, GAS bf16* ys, LAS unsigned char* lds, const LAS float* bias2, const LAS float* biasd, const GAS float* sinks, int b, int u, int tid_in, int lane_in, int wave_in) {
    int tid = tid_in, lane = lane_in, wave = wave_in; asm volatile("" : "+v"(tid), "+v"(lane), "+s"(wave));
    const int t0 = u * 64; const int col = lane & 31, hh = lane >> 5, tl = col >> 1, kv = wave & 1, head = 2 * kv + (col & 1);
    const int t = t0 + (wave >> 1) * 16 + tl;
    const size_t rowb = (size_t)b * SEQ;
    const LAS float* b2h = bias2 + head;
    bf16x8 qf[4];
    { const float SC = 0.125f * 1.4426950408889634f; const GAS bf16* qp = proj + (rowb + t) * PLD + C_BQ + head * 64 + hh * 8;
#pragma unroll
      for (int s = 0; s < 4; ++s) { const u32x4 w = *(const GAS u32x4*)(qp + s * 16); u32x4 o;
          o.x = cvtpk(lo_bf(w.x) * SC, hi_bf(w.x) * SC); o.y = cvtpk(lo_bf(w.y) * SC, hi_bf(w.y) * SC); o.z = cvtpk(lo_bf(w.z) * SC, hi_bf(w.z) * SC); o.w = cvtpk(lo_bf(w.w) * SC, hi_bf(w.w) * SC);
          qf[s] = __builtin_bit_cast(bf16x8, o); } }
    const int skey = tid >> 3, sch = tid & 7;
    const int i16 = lane & 15, blk = (lane >> 4) & 1;
    const int kboff = kv * DBUF_BYTES + col * DK_STR + hh * 16;
    const int vboff = kv * DBUF_BYTES + 64 * DK_STR + (4 * hh + (i16 >> 2)) * DV_STR + (16 * blk + 4 * (i16 & 3)) * 2;
    const GAS unsigned char* kp = (const GAS unsigned char*)(proj + rowb * PLD + C_BK); const GAS unsigned char* vp = (const GAS unsigned char*)(proj + rowb * PLD + C_BV);
    const unsigned soffp = (unsigned)(skey * PLD + sch * 8) * 2u;
    u32x4 k0, v0, k1, v1;
    f32x16 O[2], negm; float lsum = 0.f;
#pragma unroll
    for (int i = 0; i < 16; ++i) { O[0][i] = 0.f; O[1][i] = 0.f; negm[i] = 120.f; }
    const int s0 = (u < 2) ? 2 - u : 0;
    { const unsigned so = soffp + (unsigned)(u - 2 + s0) * (64u * PLD * 2u); st_load(kp, vp, so, k0, v0); st_load(kp + 128, vp + 128, so, k1, v1);
      st_write(lds, skey, sch, k0, v0); st_write(lds + DBUF_BYTES, skey, sch, k1, v1); }
    __syncthreads();
#pragma unroll 1
    for (int s = s0; s < 3; ++s) {
        const int par = (s - s0) & 1; const LAS unsigned char* cur = lds + par * 2 * DBUF_BYTES; LAS unsigned char* nxt = lds + (par ^ 1) * 2 * DBUF_BYTES;
        if (s + 1 < 3) { const unsigned so = soffp + (unsigned)(u - 2 + s + 1) * (64u * PLD * 2u); st_load(kp, vp, so, k0, v0); st_load(kp + 128, vp + 128, so, k1, v1); }
        {   f32x16 S[2]; qk64(cur, kboff, qf, negm, S);
            mask_bias(S, t, (u - 2 + s) * 64, hh, 128, true, b2h);
            bf16x8 pk[2][2]; softmax_step(S, O, negm, lsum, pk); pv64(cur, vboff, pk, O); }
        if (s + 1 < 3) { st_write(nxt, skey, sch, k0, v0); st_write(nxt + DBUF_BYTES, skey, sch, k1, v1); }
        __syncthreads();
    }
    {   const float sinkp = (sinks[head] - biasd[128 * 12 + head]) * 1.4426950408889634f;
        const float lt = lsum + xshfl<32>(lsum) + __builtin_amdgcn_exp2f(sinkp + negm[0]);
        const float inv = 1.f / fmaxf(lt, 1e-30f);
        GAS bf16* op = ys + (rowb + t) * 1024 + 256 + head * 64;
#pragma unroll
        for (int db = 0; db < 2; ++db)
#pragma unroll
            for (int gq = 0; gq < 4; ++gq) { const int d0 = 32 * db + 8 * gq + 4 * hh;
                u32x2 w; w.x = cvtpk(O[db][4 * gq + 0] * inv, O[db][4 * gq + 1] * inv); w.y = cvtpk(O[db][4 * gq + 2] * inv, O[db][4 * gq + 3] * inv); *(GAS u32x2*)(op + d0) = w; }
    }
}

DI void route_rows4(const KA& a, int l, bf16* xr_, int tok0, int lane_) {
    int lane = lane_; asm volatile("" : "+v"(lane));
    const GAS float* xrow = (const GAS float*)a.out + (size_t)tok0 * 1024; const GAS float* g = (const GAS float*)(a.in[28] + (size_t)l * 1024); GAS bf16* xr = (GAS bf16*)xr_;
    f32x4 v[4][4]; float ss[4];
#pragma unroll
    for (int rr = 0; rr < 4; ++rr)
#pragma unroll
        for (int j = 0; j < 4; ++j) v[rr][j] = *(const GAS f32x4*)(xrow + (size_t)rr * 1024 + 4 * (lane + 64 * j));
#pragma unroll
    for (int rr = 0; rr < 4; ++rr) { float t = 0.f;
#pragma unroll
        for (int j = 0; j < 4; ++j) t += (v[rr][j][0] * v[rr][j][0] + v[rr][j][1] * v[rr][j][1]) + (v[rr][j][2] * v[rr][j][2] + v[rr][j][3] * v[rr][j][3]);
        ss[rr] = t; }
#pragma unroll
    for (int rr = 0; rr < 4; ++rr) ss[rr] = wave_sum(ss[rr]);
#pragma unroll
    for (int j = 0; j < 4; ++j) { const int k0 = 4 * (lane + 64 * j); const f32x4 gv = *(const GAS f32x4*)(g + k0);
#pragma unroll
        for (int rr = 0; rr < 4; ++rr) { const float r = 1.f / sqrtf(ss[rr] * (1.f / 1024.f) + 1e-6f); const f32x4 xn = v[rr][j] * r * gv;
            unsigned hi[4]; float lo[4];
#pragma unroll
            for (int e = 0; e < 4; ++e) { hi[e] = f2bf(xn[e]); lo[e] = xn[e] - __builtin_bit_cast(float, hi[e] << 16); }
            u32x2 wh, wl; wh.x = hi[0] | (hi[1] << 16); wh.y = hi[2] | (hi[3] << 16); wl.x = pk2(lo[0], lo[1]); wl.y = pk2(lo[2], lo[3]);
            *(GAS u32x2*)(xr + (size_t)(tok0 + rr) * 2048 + k0) = wh; *(GAS u32x2*)(xr + (size_t)(tok0 + rr) * 2048 + 1024 + k0) = wl; } }
}
struct SchedRoute { const char* A; const char* B; int pm;
    DI bool next(int i, Unit& u) const { if (i > 0) return false; u.pm = pm; u.pn = 0; u.aux = 0; u.pad = 0; u.a = A + (size_t)pm * 128 * 2048 * 2; u.b = B; return true; } };
struct EpiRoute { float* rlog;
    DI void operator()(const f32x4 (&acc)[2][2][4][2], const Unit& u, int wr, int wc, int fr, int fq) const {
        const int row0 = u.pm * 128 + wr * 64 + fr; const int col = wc * 32 + 8 * fq;
#pragma unroll
        for (int m = 0; m < 4; ++m) { float* rp = rlog + (size_t)(row0 + m * 16) * 128 + col; *(f32x4*)rp = acc[0][0][m][0]; *(f32x4*)(rp + 4) = acc[0][0][m][1]; }
    }
};
DI void route_decide(const KA& a, int l, const float* rl_row, int* rec_e, int* rec_slot, float* rec_w, unsigned* cnt, int tok) {
    float lg[36];
    const float* bg = a.in[30] + l * 4; const float* be = a.in[32] + l * 32;
#pragma unroll
    for (int q = 0; q < 9; ++q) { const f32x4 h = *(const f32x4*)(rl_row + 4 * q), lo = *(const f32x4*)(rl_row + 64 + 4 * q);
        lg[4 * q + 0] = h[0] + lo[0]; lg[4 * q + 1] = h[1] + lo[1]; lg[4 * q + 2] = h[2] + lo[2]; lg[4 * q + 3] = h[3] + lo[3]; }
#pragma unroll
    for (int i = 0; i < 4; ++i) lg[i] += bg[i];
#pragma unroll
    for (int i = 0; i < 32; ++i) lg[4 + i] += be[i];
    int gsel = 0; float gm = lg[0];
#pragma unroll
    for (int i = 1; i < 4; ++i) if (lg[i] > gm) { gm = lg[i]; gsel = i; }
    float gs = 0.f;
#pragma unroll
    for (int i = 0; i < 4; ++i) gs += __expf(lg[i] - gm);
    const float gwt = 1.f / gs;
    float v8[8];
#pragma unroll
    for (int i = 0; i < 8; ++i) { float x = lg[4 + i];
#pragma unroll
        for (int gq = 1; gq < 4; ++gq) x = (gsel == gq) ? lg[4 + gq * 8 + i] : x;
        v8[i] = x; }
    int i0 = 0; float m0 = v8[0];
#pragma unroll
    for (int i = 1; i < 8; ++i) if (v8[i] > m0) { m0 = v8[i]; i0 = i; }
    int i1 = -1; float m1 = -3e38f;
#pragma unroll
    for (int i = 0; i < 8; ++i) if (i != i0 && v8[i] > m1) { m1 = v8[i]; i1 = i; }
    const float w0 = 1.f / (1.f + __expf(m1 - m0)); const float w1 = 1.f - w0;
    const int e0 = gsel * 8 + i0, e1 = gsel * 8 + i1;
    const unsigned s0 = __hip_atomic_fetch_add(cnt + e0, 1u, __ATOMIC_RELAXED, __HIP_MEMORY_SCOPE_AGENT);
    const unsigned s1 = __hip_atomic_fetch_add(cnt + e1, 1u, __ATOMIC_RELAXED, __HIP_MEMORY_SCOPE_AGENT);
    rec_e[tok * 2] = e0; rec_e[tok * 2 + 1] = e1; rec_slot[tok * 2] = (int)s0; rec_slot[tok * 2 + 1] = (int)s1; rec_w[tok * 2] = w0 * gwt; rec_w[tok * 2 + 1] = w1 * gwt;
}
DI void expert_weights(const KA& a, int l, LAS unsigned char* lds, int it0, int it1, int gw, int NGW, int wave, int lane) {
    LAS float* scr = (LAS float*)(lds + wave * 16384);
    const float* wgt = a.in[33] + (size_t)l * 32 * 1024 * 256; const float* wup = a.in[34] + (size_t)l * 32 * 1024 * 256; const float* wdn = a.in[35] + (size_t)l * 32 * 256 * 1024;
    bf16* Wgu = (bf16*)(a.ws + WS_WGU); bf16* Wd = (bf16*)(a.ws + WS_WD);
    constexpr int I_E = 16 * 8, I_D = 4 * 32;
    constexpr int NIT = 32 * (2 * I_E + I_D);
    (void)NIT;
    for (int it = it0 + gw; it < it1; it += NGW) {
        const int e = it / (2 * I_E + I_D); int r = it % (2 * I_E + I_D);
        if (r < 2 * I_E) { const int up = r / I_E, q = r % I_E, kb = q / 8, nb = q % 8; const int n0 = nb * 32;
            const int drow = (n0 >> 7) * 256 + up * 128 + (n0 & 127);
            transpose_item((up ? wup : wgt) + (size_t)e * 1024 * 256, 256, 256, Wgu + (size_t)e * 512 * 1024, 1024, kb * 64, n0, drow, scr, lane);
        } else { r -= 2 * I_E; const int kb = r / 32, nb = r % 32;
            transpose_item(wdn + (size_t)e * 256 * 1024, 1024, 1024, Wd + (size_t)e * 1024 * 256, 256, kb * 64, nb * 32, nb * 32, scr, lane); }
    }
}
DI void build_offsets(const unsigned* cnt, LAS int* offt, int tid) {
    if (tid == 0) { int o = 0; for (int e = 0; e < 32; ++e) { offt[e] = o; const int c = (int)__hip_atomic_load(cnt + e, __ATOMIC_RELAXED, __HIP_MEMORY_SCOPE_AGENT); o += (c + 255) & ~255; } offt[32] = o; }
    __syncthreads();
    for (int rt = tid; rt < (MOE_ROWS >> 8); rt += 512) { int e = 0; for (int j = 1; j < 32; ++j) e += (offt[j] <= rt * 256) ? 1 : 0; offt[40 + rt] = e; }
    __syncthreads();
}

template <unsigned PM>
__global__ void __launch_bounds__(512, 2) mk_fwd(Args a_) {
    extern __shared__ __attribute__((aligned(16))) unsigned char lds_raw[];
    LAS unsigned char* lds = (LAS unsigned char*)lds_raw;
    const int wave0 = __builtin_amdgcn_readfirstlane((int)threadIdx.x >> 6);
    if (threadIdx.x < 36) ((LAS unsigned long long*)(lds + PTAB_OFF))[threadIdx.x] = (unsigned long long)a_.in[threadIdx.x];
    __syncthreads();
    KA a; a.in.base = (unsigned)(size_t)(lds + PTAB_OFF); a.out = a_.out; a.ws = a_.ws;
    const int G = gridDim.x, bid = blockIdx.x, NGW = G * 8;
#define PHASE_IDS() int wave = wave0; asm volatile("" : "+s"(wave)); const int lane = my_lane(); const int tid_ = wave * 64 + lane, gw = bid * 8 + wave; (void)tid_; (void)gw; \
    KA ap = a; asm volatile("" : "+s"(ap.ws), "+s"(ap.out), "+s"(ap.in.base)); \
    bf16* hb = (bf16*)(ap.ws + WS_HB); bf16* proj = (bf16*)(ap.ws + WS_PROJ); bf16* gates = (bf16*)(ap.ws + WS_GATES); \
    bf16* ys = hb; bf16* x2b = hb; bf16* merged = proj; bf16* eo = proj; \
    bf16* kcb = (bf16*)(ap.ws + WS_KCVC); float* lrusum = (float*)(ap.ws + WS_LRUSUM); \
    int* rec_e = (int*)(ap.ws + WS_REC); int* rec_slot = rec_e + T * 2; float* rec_w = (float*)(rec_slot + T * 2); \
    int* rowtok = (int*)(ap.ws + WS_ROWTOK); float* roww = (float*)(ap.ws + WS_ROWW); \
    bf16* xs = (bf16*)(ap.ws + WS_XS); bf16* hmid = (bf16*)(ap.ws + WS_HMID); unsigned* ctl = (unsigned*)(ap.ws + WS_CTL); \
    (void)hb; (void)proj; (void)gates; (void)ys; (void)x2b; (void)merged; (void)eo; (void)kcb; (void)lrusum; (void)rec_e; (void)rec_slot; (void)rec_w; (void)rowtok; (void)roww; (void)xs; (void)hmid; (void)ctl
    volatile LAS unsigned* MISC = (volatile LAS unsigned*)(lds + MISC_OFF);
    LAS float* biasd = (LAS float*)(lds + BIAS_OFF);
    LAS int* offt = (LAS int*)(lds + OFFT_OFF);
    { PHASE_IDS();
    if (tid_ < 64) MISC[tid_] = 0u;
    for (int i = tid_; i < 129 * 12; i += 512) { const int d = i / 12, hd = i % 12; const int bk = d < 128 ? T5_BUCKET[d] : 31; const float* rb = a.in[1]; biasd[i] = rb[bk * 12 + hd]; ((LAS float*)(lds + BIAS2_OFF))[i] = (rb[bk * 12 + hd] - rb[31 * 12 + hd]) * 1.4426950408889634f; } }
    __syncthreads();
    const int lo = a_.ph_lo, hi = a_.ph_hi;
    XcdBarrier bar; bar.bar = (unsigned*)(a.ws + WS_CTL) + CW_BAR; bar.x = 0; bar.st = nullptr;
    if (hi - lo > 1) { PHASE_IDS(); bar = xcd_barrier_post(ctl + CW_BAR, MISC + 8, tid_ == 0); }
#ifndef SUB_MASK
#define SUB_MASK 0xFFu
#endif
#define SUB(k) ((SUB_MASK >> (k)) & 1u)
#define HASP(k) ((PM >> ((k) % PPL + ((k) >= 2 * PPL ? PPL : 0))) & 1u)
#define IN(k) (HASP(k) && lo <= (k) && (k) < hi)
#define SEAM(k) do { if ((k) + 1 < hi) { const int sl_ = my_lane(); int sw_ = wave0; asm volatile("" : "+s"(sw_)); xcd_barrier(bar, sw_ == 0 && sl_ == 0); } } while (0)
    for (int l = 0; l < DEPTH; ++l) {
        const int pb = l * PPL;
        if (IN(pb + 0)) { PHASE_IDS(); router_weights(ap, l, gw, NGW, lane); lru_weights(ap, l, gw, NGW, lane); cmp_weights(ap, l, lds, gw, NGW, wave, lane); phase0_weights(ap, l, lds, gw, NGW, wave, lane); phase0_rows(ap, l, 0, gw, NGW, lane); SEAM(pb + 0); }
        if (IN(pb + 1)) {
            PHASE_IDS();
            pg8::Gemm g{1024, 1024, 1024, 128, -1}; SchedP1 S{(const char*)hb, (const char*)(ap.ws + WS_WIN), G, bid};
            EpiP1 E{proj, gates, ap.in[25] + (size_t)l * 4096};
            pg8::gemm_phase<EpiP1, SchedP1>(lds, g, S, E, tid_); SEAM(pb + 1);
        }
        if (IN(pb + 2)) {
            PHASE_IDS();
            LAS float* lamp = (LAS float*)(lds + MISC_OFF + 64);
            if (tid_ == 0) { float s1 = 0.f, s2 = 0.f;
                for (int i = 0; i < 32; ++i) { s1 += ap.in[13][l * 32 + i] * ap.in[14][l * 32 + i]; s2 += ap.in[15][l * 32 + i] * ap.in[16][l * 32 + i]; }
                const float lam_init = 0.8f - 0.6f * __expf(-0.3f * (float)l); lamp[0] = __expf(s1) - __expf(s2) + lam_init; lamp[1] = lam_init; }
            __syncthreads();
            if (SUB(0)) { const LAS float* bias2 = (const LAS float*)(lds + BIAS2_OFF); const GAS float* subg = (const GAS float*)(ap.in[17] + l * 64);
                for (int pi = bid; pi < 256; pi += G) { const int bh = pi >> 4, qlo = pi & 15;
                    diff_unit((const GAS bf16*)proj, (GAS bf16*)ys, lds, bias2, subg, lamp, bh >> 2, bh & 3, 31 - qlo, wave);
                    diff_unit((const GAS bf16*)proj, (GAS bf16*)ys, lds, bias2, subg, lamp, bh >> 2, bh & 3, qlo, wave); } }
            { PHASE_IDS();
            if (SUB(3)) { __syncthreads(); const LAS float* bias2 = (const LAS float*)(lds + BIAS2_OFF); const GAS float* sinks = (const GAS float*)(ap.in[12] + l * 4);
                for (int pi = bid; pi < 512; pi += G) swa_unit((const GAS bf16*)proj, (GAS bf16*)ys, lds, bias2, biasd, sinks, pi >> 7, pi & 127, tid_, lane, wave); }
            if (SUB(2)) { pg8::Gemm g{1024, 16 * PLD, 1024, PLD * 2, -1}; SchedCmp S{(const char*)proj, (const char*)(ap.ws + WS_WCMP), G, bid}; EpiCmp E{(float*)(ap.ws + WS_CMPAB)};
                pg8::gemm_phase<EpiCmp, SchedCmp>(lds, g, S, E, tid_); }
            if (SUB(1)) { __syncthreads(); for (int task = bid; task < 512; task += G) lru_unit(ap, l, (const GAS bf16*)proj, (GAS bf16*)ys, (GAS float*)lrusum, lds, task, lane, wave, false); }
            }
            SEAM(pb + 2);
        }
        if (IN(pb + 3)) {
            PHASE_IDS();
            for (int task = gw; task < 2 * BATCH * NCMP; task += NGW) cmp_finish(ap, l, (const float*)(ap.ws + WS_CMPAB), kcb, task, lane);
            __syncthreads();
            for (int task = bid; task < 512; task += G) lru_unit(ap, l, (const GAS bf16*)proj, (GAS bf16*)ys, (GAS float*)lrusum, lds, task, lane, wave, true);
            SEAM(pb + 3);
        }
        if (IN(pb + 4)) {
            PHASE_IDS();
            if (SUB(4)) { const LAS float* bias2 = (const LAS float*)(lds + BIAS2_OFF);
                for (int pi = bid; pi < 256; pi += G) { const int bb = pi >> 6, ulo = pi & 63;
                    nsa_unit((const GAS bf16*)proj, (GAS bf16*)ys, (const GAS bf16*)kcb, lds, bias2, bb, 127 - ulo, tid_, lane, wave);
                    nsa_unit((const GAS bf16*)proj, (GAS bf16*)ys, (const GAS bf16*)kcb, lds, bias2, bb, ulo, tid_, lane, wave); } }
            SEAM(pb + 4);
        }
        if (IN(pb + 5)) {
            PHASE_IDS();
            pg8::Gemm g{256, 1024, 256, 128, -1}; SchedP3a S{(const char*)ys, (const char*)(ap.ws + WS_WBR), G, bid};
            EpiP3a E{merged, gates};
            pg8::gemm_phase<EpiP3a, SchedP3a>(lds, g, S, E, tid_); SEAM(pb + 5);
        }
        if (IN(pb + 6)) {
            PHASE_IDS();
            pg8::Gemm g{1024, 1024, 1024, 128, -1}; SchedP3b S{(const char*)merged, (const char*)(ap.ws + WS_WOUT), G, bid};
            EpiP3b E{(l == 0) ? ap.in[0] : ap.out, ap.out};
            pg8::gemm_phase<EpiP3b, SchedP3b>(lds, g, S, E, tid_); SEAM(pb + 6);
        }
        if (IN(pb + 7)) {
            PHASE_IDS();
            bf16* xr = (bf16*)(ap.ws + WS_XR); float* rlog = (float*)(ap.ws + WS_RLOG);
            constexpr int NITW = 32 * (2 * 16 * 8 + 4 * 32);
            { const int pm = bid;
                for (int r = wave * 4; r < 128; r += 32) route_rows4(ap, l, xr, pm * 128 + r, lane);
                asm volatile("s_waitcnt vmcnt(0)" ::: "memory"); __syncthreads();
                { pg8::Gemm g{2048, 2048, 2048, 128, 0}; SchedRoute S{(const char*)xr, (const char*)(ap.ws + WS_WR), pm}; EpiRoute E{rlog};
                  pg8::gemm_phase<EpiRoute, SchedRoute>(lds, g, S, E, tid_); }
                asm volatile("s_waitcnt vmcnt(0)" ::: "memory"); __syncthreads();
                if (tid_ < 128) route_decide(ap, l, rlog + (size_t)(pm * 128 + tid_) * 128, rec_e, rec_slot, rec_w, ctl + CW_CNT + l * 32, pm * 128 + tid_);
                __syncthreads();
            }
            expert_weights(ap, l, lds, 0, NITW, gw, NGW, wave, lane);
            SEAM(pb + 7);
        }
        if (IN(pb + 8)) {
            PHASE_IDS();
            build_offsets(ctl + CW_CNT + l * 32, offt, tid_);
            if (bid < 32) { const int e = bid; const int c = (int)__hip_atomic_load(ctl + CW_CNT + l * 32 + e, __ATOMIC_RELAXED, __HIP_MEMORY_SCOPE_AGENT);
                for (int p = offt[e] + c + tid_; p < offt[e + 1]; p += 512) rowtok[p] = -1; }
            {   const GAS bf16* xr = (const GAS bf16*)(ap.ws + WS_XR); GAS bf16* xsg = (GAS bf16*)xs;
                for (int tok0 = gw * 4; tok0 < T; tok0 += NGW * 4) {
                    u32x4 v0[4], v1[4]; int pos[4][2];
#pragma unroll
                    for (int rr = 0; rr < 4; ++rr) { v0[rr] = *(const GAS u32x4*)(xr + (size_t)(tok0 + rr) * 2048 + lane * 8); v1[rr] = *(const GAS u32x4*)(xr + (size_t)(tok0 + rr) * 2048 + 512 + lane * 8);
#pragma unroll
                        for (int k = 0; k < 2; ++k) pos[rr][k] = offt[rec_e[(tok0 + rr) * 2 + k]] + rec_slot[(tok0 + rr) * 2 + k]; }
#pragma unroll
                    for (int rr = 0; rr < 4; ++rr)
#pragma unroll
                        for (int k = 0; k < 2; ++k) { const int p = pos[rr][k];
                            *(GAS u32x4*)(xsg + (size_t)p * 1024 + lane * 8) = v0[rr]; *(GAS u32x4*)(xsg + (size_t)p * 1024 + 512 + lane * 8) = v1[rr];
                            if (lane == 0) { rowtok[p] = (tok0 + rr) * 2 + k; roww[p] = rec_w[(tok0 + rr) * 2 + k]; } } } }
            SEAM(pb + 8);
        }
        if (IN(pb + 9)) {
            PHASE_IDS();
            build_offsets(ctl + CW_CNT + l * 32, offt, tid_);
            pg8::Gemm g{1024, 1024, 1024, 128, -1}; SchedM2 S{(const char*)xs, (const char*)(ap.ws + WS_WGU), offt, G, bid};
            EpiM2 E{hmid};
            pg8::gemm_phase<EpiM2, SchedM2>(lds, g, S, E, tid_); SEAM(pb + 9);
        }
        if (IN(pb + 10)) {
            PHASE_IDS();
            build_offsets(ctl + CW_CNT + l * 32, offt, tid_);
            pg8::Gemm g{256, 256, 256, 128, -1}; SchedM3 S{(const char*)hmid, (const char*)(ap.ws + WS_WD), offt, G, bid};
            EpiM3 E{eo, rowtok, roww};
            pg8::gemm_phase<EpiM3, SchedM3>(lds, g, S, E, tid_); SEAM(pb + 10);
        }
    }
    if (IN(2 * PPL)) { PHASE_IDS(); phase0_rows(ap, DEPTH, 1, gw, NGW, lane); }
#undef IN
#undef SEAM
}

typedef void (*kern_t)(Args);
template <unsigned PM> static bool setup_kernel() {
    if (hipFuncSetAttribute((const void*)mk_fwd<PM>, hipFuncAttributeMaxDynamicSharedMemorySize, LDS_BYTES) != hipSuccess) { fprintf(stderr, "kernel_launch: hipFuncSetAttribute failed\n"); return false; }
    return true;
}
extern "C" void kernel_launch(void* const* d_in, const int* in_sizes, int n_in, void* d_out, int out_size, void* d_ws, size_t ws_size, hipStream_t stream) {
    static int grid = 0;
    if (grid == 0) {
        if (n_in != 36 || out_size != T * D || ws_size < WS_END) { fprintf(stderr, "kernel_launch: unexpected shapes (n_in %d out %d ws %zu)\n", n_in, out_size, ws_size); grid = -1; return; }
        int dev = 0, cus = 0;
        if (hipGetDevice(&dev) != hipSuccess || hipDeviceGetAttribute(&cus, hipDeviceAttributeMultiprocessorCount, dev) != hipSuccess) { grid = -1; return; }
        bool ok = true;
#if MK_ONE_LAUNCH
        ok = setup_kernel<0xFFFu>();
#endif
        if (!ok) { grid = -1; return; }
        (void)hipGetLastError();
        grid = cus;
        if (grid != 256) { fprintf(stderr, "kernel_launch: built for a 256-CU device (got %d)\n", cus); grid = -1; return; }
    }
    if (grid < 0) return;
    if (hipMemsetAsync((char*)d_ws + WS_CTL, 0, CTL_ZERO_BYTES, stream) != hipSuccess) return;
    Args a{};
    for (int i = 0; i < 36; ++i) a.in[i] = (const float*)d_in[i];
    a.out = (float*)d_out; a.ws = (unsigned char*)d_ws;
#if MK_ONE_LAUNCH
    a.ph_lo = 0; a.ph_hi = NPH;
    hipLaunchKernelGGL(mk_fwd<0xFFFu>, dim3(grid), dim3(512), LDS_BYTES, stream, a);
#endif
}
```

```cpp
#include <hip/hip_runtime.h>
#include <cstdio>
#include <cstdint>

#ifndef MK_ONE_LAUNCH
#define MK_ONE_LAUNCH 1
#endif

#define DI __device__ __forceinline__
#define GAS __attribute__((address_space(1)))
#define LAS __attribute__((address_space(3)))
typedef unsigned short bf16;
typedef short bf16x8 __attribute__((ext_vector_type(8)));
typedef float f32x4 __attribute__((ext_vector_type(4)));
typedef unsigned u32x4 __attribute__((ext_vector_type(4)));
typedef unsigned u32x2 __attribute__((ext_vector_type(2)));
typedef float f32x16 __attribute__((ext_vector_type(16)));
typedef float f32x2 __attribute__((ext_vector_type(2)));
typedef short s16x4 __attribute__((ext_vector_type(4)));
typedef __bf16 bf16x2_t __attribute__((ext_vector_type(2)));
typedef short v4i16_t __attribute__((__vector_size__(4 * sizeof(short))));
#define MFMA32(a, b, c) __builtin_amdgcn_mfma_f32_32x32x16_bf16((a), (b), (c), 0, 0, 0)

constexpr int BATCH = 4, SEQ = 8192, T = BATCH * SEQ, D = 1024, DEPTH = 2;
constexpr int NIN = 2444, PLD = 2560, N1 = 6656, GLD = 4096;
constexpr int C_AX = 0, C_AG = 256, C_BQ = 512, C_BK = 768, C_BV = 896, C_CQ = 1024, C_CK = 1280, C_CV = 1536, C_DQ = 1792,
              C_KC = 2048, C_VC = 2112, C_KS = 2176, C_VS = 2240, C_KW = 2304, C_VW = 2368, C_DG = 2432;
constexpr int NCMP = 511;
constexpr int MOE_ROWS = 73728;
constexpr int PPL = 11;
constexpr int NPH = 2 * PPL + 1;

constexpr size_t MiB = 1u << 20;
constexpr size_t WS_CTL = 0, CTL_ZERO_BYTES = 1 * MiB;
constexpr size_t WS_KCVC = 1 * MiB;
constexpr size_t WS_LRUSUM = 2 * MiB;
constexpr size_t WS_REC = 2 * MiB + 256 * 1024;
constexpr size_t WS_ROWTOK = 3 * MiB;
constexpr size_t WS_ROWW = 3 * MiB + 512 * 1024;
constexpr size_t WS_WIN = 4 * MiB;
constexpr size_t WS_WBR = 17 * MiB;
constexpr size_t WS_WOUT = 19 * MiB;
constexpr size_t WS_HB = 21 * MiB;
constexpr size_t WS_PROJ = 85 * MiB;
constexpr size_t WS_GATES = 245 * MiB;
constexpr size_t WS_WGU = 245 * MiB;
constexpr size_t WS_WD = 277 * MiB;
constexpr size_t WS_XS = 293 * MiB;
constexpr size_t WS_HMID = 437 * MiB;
constexpr size_t WS_XR = 85 * MiB;
constexpr size_t WS_RLOG = 213 * MiB;
constexpr size_t WS_WR = 501 * MiB;
constexpr size_t WS_WCMP = 502 * MiB;
constexpr size_t WS_CMPAB = 503 * MiB;
constexpr size_t WS_LRUW = 505 * MiB + 65536;
constexpr size_t WS_END = 506 * MiB;
constexpr int CW_BAR = 4096;
constexpr int CW_CNT = 16384;

constexpr int RING_BYTES = 131072;
constexpr int MISC_OFF = RING_BYTES;
constexpr int BIAS_OFF = MISC_OFF + 256;
constexpr int OFFT_OFF = BIAS_OFF + 129 * 12 * 4;
constexpr int PTAB_OFF = OFFT_OFF + (40 + 288 + 40) * 4;
constexpr int BIAS2_OFF = PTAB_OFF + 36 * 8;
constexpr int LRUEX_OFF = BIAS2_OFF + 129 * 12 * 4;
constexpr int LDS_BYTES = 163840;
constexpr int LRUCST_OFF = LRUEX_OFF + 8 * 64 * 2 * 4;
constexpr int LRUCAR_OFF = LRUCST_OFF + 3 * 64 * 4;
static_assert(PTAB_OFF % 8 == 0 && LRUCAR_OFF + 8 * 64 * 4 <= LDS_BYTES, "LDS map");

DI float bf2f(bf16 v) { return __builtin_bit_cast(float, (unsigned)v << 16); }
DI float lo_bf(unsigned w) { return __builtin_bit_cast(float, w << 16); }
DI float hi_bf(unsigned w) { return __builtin_bit_cast(float, w & 0xffff0000u); }
DI unsigned f2bf(float f) { unsigned u = __builtin_bit_cast(unsigned, f); return (u + 0x7fffu + ((u >> 16) & 1u)) >> 16; }
DI unsigned pk2(float lo, float hi) { return f2bf(lo) | (f2bf(hi) << 16); }
DI float rl(float v, int i) { return __builtin_bit_cast(float, __builtin_amdgcn_readlane(__builtin_bit_cast(int, v), i)); }
DI int rli(int v, int i) { return __builtin_amdgcn_readlane(v, i); }
DI int my_lane() { int l; asm volatile("v_mbcnt_lo_u32_b32 %0, -1, 0\n\tv_mbcnt_hi_u32_b32 %0, -1, %0" : "=v"(l)); return l; }
template <int O> DI int xshfl_i(int v) {
    if constexpr (O < 32) return __builtin_amdgcn_ds_swizzle(v, (O << 10) | 0x1f);
    else { const int l = my_lane(); return __builtin_amdgcn_ds_bpermute((l ^ 32) << 2, v); }
}
template <int O> DI float xshfl(float v) { return __builtin_bit_cast(float, xshfl_i<O>(__builtin_bit_cast(int, v))); }
DI float wave_sum(float v) { v += xshfl<1>(v); v += xshfl<2>(v); v += xshfl<4>(v); v += xshfl<8>(v); v += xshfl<16>(v); v += xshfl<32>(v); return v; }
DI float wave_max(float v) { v = fmaxf(v, xshfl<1>(v)); v = fmaxf(v, xshfl<2>(v)); v = fmaxf(v, xshfl<4>(v)); v = fmaxf(v, xshfl<8>(v)); v = fmaxf(v, xshfl<16>(v)); v = fmaxf(v, xshfl<32>(v)); return v; }
DI float sigmoidf_(float x) { return __builtin_amdgcn_rcpf(1.f + __builtin_amdgcn_exp2f(-1.4426950408889634f * x)); }
DI float gelu_tanh(float x) { const float u = 0.7978845608028654f * (x + 0.044715f * x * x * x); const float e = __expf(2.f * u); const float th = 1.f - 2.f * __builtin_amdgcn_rcpf(e + 1.f); return 0.5f * x * (1.f + th); }
DI float softplusf_(float x) { return fmaxf(x, 0.f) + log1pf(__expf(-fabsf(x))); }
#define LDS_WAIT() asm volatile("s_waitcnt lgkmcnt(0)" ::: "memory")
#define VM_WAIT() asm volatile("s_waitcnt vmcnt(0)" ::: "memory")

__device__ const unsigned char T5_BUCKET[128] = {
0,1,2,3,4,5,6,7,8,9,10,11,12,13,14,15,16,16,16,17,17,18,18,18,19,19,19,20,20,20,20,21,21,21,21,22,22,22,22,22,23,23,23,23,23,23,24,24,24,24,24,24,25,25,25,25,25,25,25,26,26,26,26,26,26,26,26,27,27,27,27,27,27,27,27,27,27,28,28,28,28,28,28,28,28,28,28,29,29,29,29,29,29,29,29,29,29,29,29,30,30,30,30,30,30,30,30,30,30,30,30,30,30,31,31,31,31,31,31,31,31,31,31,31,31,31,31,31};

#define XB_TMO      128
#define XB_XCNT(j)  (256  + 64 * (j))
#define XB_XSUB(j)  (1280 + 64 * (j))
#define XB_XGEN(j)  (2304 + 64 * (j))
#define XB_TOP      3328
#define XB_TOPGEN   3392
#define XCD_BAR_WORDS 3456
#define XB_SPIN_CAP (1u << 22)
DI unsigned xb_ld(unsigned* p)              { return __hip_atomic_load(p, __ATOMIC_RELAXED, __HIP_MEMORY_SCOPE_AGENT); }
DI unsigned xb_add(unsigned* p, unsigned v) { return __hip_atomic_fetch_add(p, v, __ATOMIC_RELAXED, __HIP_MEMORY_SCOPE_AGENT); }
DI unsigned xb_xcc_id() { return (unsigned)__builtin_amdgcn_s_getreg((3 << 11) | 20) & 0xFu; }
#define XB_SPIN(cond, bar) do { unsigned _sp = 0; while (cond) { __builtin_amdgcn_s_sleep(1); \
    if ((++_sp & 255u) == 0u) { if (xb_ld(&(bar)[XB_TMO])) break; if (_sp > XB_SPIN_CAP) { atomicAdd(&(bar)[XB_TMO], 1u); break; } } } } while (0)
struct XcdBarrier { unsigned* bar; unsigned x; volatile LAS unsigned* st; };
DI XcdBarrier xcd_barrier_post(unsigned* bar, volatile LAS unsigned* st, bool leader) {
    XcdBarrier b; b.bar = bar; b.x = xb_xcc_id(); b.st = st;
    if (leader) (void)xb_add(&bar[XB_XCNT(b.x)], 1u);
    return b;
}
DI void xcd_barrier_complete(unsigned* bar, unsigned x, unsigned& nloc, unsigned& nx) {
    const unsigned G = gridDim.x * gridDim.y * gridDim.z;
    unsigned sum, cnt, mine, sp = 0u;
    for (;;) {
        sum = 0u; cnt = 0u; mine = 0u;
#pragma unroll
        for (unsigned j = 0; j < 16; ++j) { const unsigned c = xb_ld(&bar[XB_XCNT(j)]); sum += c; cnt += (c > 0u) ? 1u : 0u; mine = (j == x) ? c : mine; }
        if (sum == G) break;
        __builtin_amdgcn_s_sleep(1);
        if ((++sp & 255u) == 0u) { if (xb_ld(&bar[XB_TMO])) break; if (sp > XB_SPIN_CAP) { atomicAdd(&bar[XB_TMO], 1u); break; } }
    }
    nloc = mine > 0u ? mine : 1u; nx = cnt > 0u ? cnt : 1u;
}
DI void xcd_barrier(const XcdBarrier& b, bool leader) {
    asm volatile("s_waitcnt vmcnt(0)" ::: "memory");
    __syncthreads();
    if (leader) {
        unsigned* bar = b.bar;
        __builtin_amdgcn_s_waitcnt(0);
        unsigned nloc = b.st[0], nx = b.st[1];
        if (nloc == 0u) { xcd_barrier_complete(bar, b.x, nloc, nx); b.st[0] = nloc; b.st[1] = nx; }
        const unsigned old = xb_add(&bar[XB_XSUB(b.x)], 1u);
        const unsigned gen = old / nloc;
        if (old + 1u == (gen + 1u) * nloc) {
            __builtin_amdgcn_fence(__ATOMIC_RELEASE, "agent");
            asm volatile("s_waitcnt vmcnt(0)" ::: "memory");
            const unsigned og = xb_add(&bar[XB_TOP], 1u);
            const unsigned tg = og / nx;
            if (og + 1u == (tg + 1u) * nx) xb_add(&bar[XB_TOPGEN], 1u);
            else XB_SPIN(xb_ld(&bar[XB_TOPGEN]) == tg, bar);
            __builtin_amdgcn_fence(__ATOMIC_ACQUIRE, "agent");
            xb_add(&bar[XB_XGEN(b.x)], 1u);
            asm volatile("s_waitcnt vmcnt(0)" ::: "memory");
        } else {
            XB_SPIN(xb_ld(&bar[XB_XGEN(b.x)]) == gen, bar);
            __builtin_amdgcn_fence(__ATOMIC_ACQUIRE, "agent");
            asm volatile("s_waitcnt vmcnt(0)" ::: "memory");
        }
    }
    __syncthreads();
}

namespace pg8 {
constexpr int BM = 256, BK = 64, HALF = 128, HTB = HALF * BK * 2;
__host__ __device__ __forceinline__ int lds_byte(int r, int c) { const int st = (r >> 4) * 2 + (c >> 5), rr = r & 15, cc = c & 31, ob = rr * 64 + cc * 2; return st * 1024 + (ob ^ (((ob >> 9) & 1) << 5)); }
__host__ __device__ __forceinline__ void stage_rc(int b, int& R, int& C) { const int st = b / 1024, sb = b % 1024, swz = sb ^ (((sb >> 9) & 1) << 5); R = (st >> 1) * 16 + swz / 64; C = (st & 1) * 32 + (swz % 64) / 2; }
__host__ __device__ __forceinline__ int perm32(int rho) { const int n = rho >> 4, i = rho & 15; return 8 * (i >> 2) + 4 * n + (i & 3); }
struct Unit { const char* a; const char* b; int pm, pn, aux, pad; };
struct Gemm { int K, lda, ldb, kstepA, hstepA; };
template <class Epi, class Sched>
DI void gemm_phase(LAS unsigned char* lds, const Gemm g, const Sched& S, const Epi& E, int tid_in) {
    int tid = tid_in; asm volatile("" : "+v"(tid));
    const int wid = __builtin_amdgcn_readfirstlane(tid >> 6), lane = tid & 63, wr = wid >> 2, wc = wid & 3, fr = lane & 15, fq = lane >> 4;
    const int K = g.K, nt = K / BK;
    unsigned voffA[2], voffB[2];
#pragma unroll
    for (int i = 0; i < 2; ++i) { int R, C; stage_rc(tid * 16 + i * 8192, R, C); const int Rb = (R & ~31) + perm32(R & 31);
        voffA[i] = (unsigned)(R * g.lda + C) * 2u; voffB[i] = (unsigned)(Rb * g.ldb + C) * 2u; }
    const size_t kstep = (size_t)(BK * 2), kstepA = (size_t)g.kstepA;
    const size_t hstepA = g.hstepA < 0 ? (size_t)HALF * g.lda * 2 : (size_t)g.hstepA, hstepB = (size_t)HALF * g.ldb * 2;
    const unsigned ldsw = (unsigned)wid * 1024u;
    const int aoff = lds_byte(wr * 64 + fr, fq * 8), boff = lds_byte(wc * 32 + fr, fq * 8);
#define PG8_SA(b, h) (((b) * 2 + (h)) * HTB)
#define PG8_SB(b, h) ((4 + (b) * 2 + (h)) * HTB)
#define PG8_STAGE(bufoff, gbase, voff) do { _Pragma("unroll") for (int _i = 0; _i < 2; ++_i) \
        __builtin_amdgcn_global_load_lds((const unsigned*)((const char*)(gbase) + (voff)[_i]), (LAS unsigned*)(lds + (bufoff) + ldsw + _i * 8192), 16, 0, 0); } while (0)
#define PG8_LDA(dst, b, h) do { _Pragma("unroll") for (int m = 0; m < 4; ++m) _Pragma("unroll") for (int k = 0; k < 2; ++k) dst[m][k] = *(const LAS bf16x8*)(lds + PG8_SA(b, h) + aoff + m * 2048 + k * 1024); } while (0)
#define PG8_LDB(dst, b, h) do { _Pragma("unroll") for (int n = 0; n < 2; ++n) _Pragma("unroll") for (int k = 0; k < 2; ++k) dst[n][k] = *(const LAS bf16x8*)(lds + PG8_SB(b, h) + boff + n * 2048 + k * 1024); } while (0)
#define PG8_MMA(ai, bj, At, Bt) do { __builtin_amdgcn_s_setprio(1); _Pragma("unroll") for (int m = 0; m < 4; ++m) _Pragma("unroll") for (int n = 0; n < 2; ++n) _Pragma("unroll") for (int k = 0; k < 2; ++k) \
        acc[ai][bj][m][n] = __builtin_amdgcn_mfma_f32_16x16x32_bf16(Bt[n][k], At[m][k], acc[ai][bj][m][n], 0, 0, 0); __builtin_amdgcn_s_setprio(0); } while (0)
#define PG8_WAIT_V(n) asm volatile("s_waitcnt vmcnt(" #n ")" ::: "memory")
#define PG8_WAIT_L(n) asm volatile("s_waitcnt lgkmcnt(" #n ")" ::: "memory")
#define PG8_BAR __builtin_amdgcn_s_barrier()
#define PG8_SCHED __builtin_amdgcn_sched_barrier(0)
    Unit cur, nxt; int ui = 0;
    if (!S.next(0, cur)) return;
    f32x4 acc[2][2][4][2];
#pragma unroll
    for (int a = 0; a < 2; ++a)
#pragma unroll
        for (int b = 0; b < 2; ++b)
#pragma unroll
            for (int m = 0; m < 4; ++m)
#pragma unroll
                for (int n = 0; n < 2; ++n) acc[a][b][m][n] = (f32x4){0.f, 0.f, 0.f, 0.f};
    bf16x8 At[4][2], B0[2][2], B1[2][2];
    const char* cA = cur.a; const char* cB = cur.b;
    PG8_STAGE(PG8_SB(0, 0), cB, voffB); PG8_STAGE(PG8_SB(0, 1), cB + hstepB, voffB); PG8_STAGE(PG8_SA(0, 0), cA, voffA); PG8_STAGE(PG8_SA(0, 1), cA + hstepA, voffA);
    if (wr == 1) PG8_BAR;
    PG8_WAIT_V(2); PG8_BAR;
    PG8_STAGE(PG8_SB(1, 0), cB + kstep, voffB); PG8_STAGE(PG8_SA(1, 0), cA + kstepA, voffA); PG8_STAGE(PG8_SB(1, 1), cB + hstepB + kstep, voffB);
    PG8_WAIT_V(6); PG8_BAR;
    for (;;) {
        const bool has_next = S.next(ui + 1, nxt);
        const char* nA = has_next ? nxt.a : cA; const char* nB = has_next ? nxt.b : cB;
        for (int t = 0; t < nt; t += 2) {
            const bool last = (t == nt - 2);
            const char* a1 = cA + (size_t)(t + 1) * kstepA;
            const char* a2 = last ? nA : cA + (size_t)(t + 2) * kstepA; const char* b2 = last ? nB : cB + (size_t)(t + 2) * kstep;
            const char* a3 = a2 + kstepA; const char* b3 = b2 + kstep;
            PG8_LDB(B0, 0, 0); PG8_LDB(B1, 0, 1); PG8_SCHED; PG8_LDA(At, 0, 0); PG8_STAGE(PG8_SA(1, 1), a1 + hstepA, voffA);
            PG8_WAIT_V(8); PG8_WAIT_L(0); PG8_BAR; PG8_MMA(0, 0, At, B0); PG8_MMA(0, 1, At, B1); PG8_BAR; PG8_SCHED;
            PG8_LDA(At, 0, 1); PG8_STAGE(PG8_SB(0, 0), b2, voffB); PG8_STAGE(PG8_SB(0, 1), b2 + hstepB, voffB); PG8_STAGE(PG8_SA(0, 0), a2, voffA);
            PG8_WAIT_V(8); PG8_WAIT_L(0); PG8_BAR; PG8_MMA(1, 0, At, B0); PG8_MMA(1, 1, At, B1); PG8_BAR; PG8_SCHED;
            PG8_LDB(B0, 1, 0); PG8_LDB(B1, 1, 1); PG8_SCHED; PG8_LDA(At, 1, 0); PG8_STAGE(PG8_SA(0, 1), a2 + hstepA, voffA);
            PG8_WAIT_V(8); PG8_WAIT_L(0); PG8_BAR; PG8_MMA(0, 0, At, B0); PG8_MMA(0, 1, At, B1); PG8_BAR; PG8_SCHED;
            PG8_LDA(At, 1, 1); PG8_STAGE(PG8_SB(1, 0), b3, voffB); PG8_STAGE(PG8_SB(1, 1), b3 + hstepB, voffB); PG8_STAGE(PG8_SA(1, 0), a3, voffA);
            PG8_WAIT_V(8); PG8_WAIT_L(0); PG8_BAR; PG8_MMA(1, 0, At, B0); PG8_MMA(1, 1, At, B1); PG8_BAR; PG8_SCHED;
        }
        if (wr == 0) PG8_BAR;
        { const int el = my_lane(); E(acc, cur, wr, wc, el & 15, el >> 4); }
        if (!has_next) break;
#pragma unroll
        for (int a = 0; a < 2; ++a)
#pragma unroll
            for (int b = 0; b < 2; ++b)
#pragma unroll
                for (int m = 0; m < 4; ++m)
#pragma unroll
                    for (int n = 0; n < 2; ++n) acc[a][b][m][n] = (f32x4){0.f, 0.f, 0.f, 0.f};
        cur = nxt; cA = nA; cB = nB; ++ui;
        if (wr == 1) PG8_BAR;
    }
    PG8_WAIT_V(0);
    PG8_BAR;
#undef PG8_SA
#undef PG8_SB
#undef PG8_STAGE
#undef PG8_LDA
#undef PG8_LDB
#undef PG8_MMA
#undef PG8_WAIT_V
#undef PG8_WAIT_L
#undef PG8_BAR
#undef PG8_SCHED
}
}
using pg8::Unit;

DI unsigned cvt_pk_bf16(float lo, float hi) { unsigned r; asm volatile("s_nop 1\n\tv_cvt_pk_bf16_f32 %0, %1, %2" : "=v"(r) : "v"(lo), "v"(hi)); return r; }
DI u32x4 pack8(const f32x4& v0, const f32x4& v1) { u32x4 w; w.x = cvt_pk_bf16(v0[0], v0[1]); w.y = cvt_pk_bf16(v0[2], v0[3]); w.z = cvt_pk_bf16(v1[0], v1[1]); w.w = cvt_pk_bf16(v1[2], v1[3]); return w; }

struct SchedP1 {
    const char* A; const char* B; int G, c;
    DI bool next(int i, Unit& u) const {
        constexpr int nM = 128, nN = 26, nwg = nM * nN, NXCD = 8, WGM = 8;
        const long L = (long)i * G + c; if (L >= nwg) return false;
        int wgid = (int)L; { const int q = nwg / NXCD, r = nwg % NXCD, xcd = wgid % NXCD, off = wgid / NXCD; wgid = (xcd < r ? xcd * (q + 1) : r * (q + 1) + (xcd - r) * q) + off; }
        const int nig = WGM * nN, gid = wgid / nig, fm = gid * WGM, gsz = (nM - fm) < WGM ? (nM - fm) : WGM;
        u.pm = fm + ((wgid % nig) % gsz); u.pn = (wgid % nig) / gsz; u.aux = 0; u.pad = 0;
        u.a = A + (size_t)u.pm * 256 * 1024 * 2; u.b = B + (size_t)u.pn * 256 * 1024 * 2; return true;
    }
};
struct SchedP3a {
    const char* ys; const char* wbr; int G, c;
    DI bool next(int i, Unit& u) const {
        const int tile = (i >> 2) * G + c; if (tile >= 512) return false;
        const int br = i & 3; u.pm = tile >> 2; u.pn = tile & 3; u.aux = br; u.pad = 0;
        u.a = ys + ((size_t)u.pm * 256 * 1024 + br * 256) * 2; u.b = wbr + ((size_t)br * 1024 * 256 + (size_t)u.pn * 256 * 256) * 2; return true;
    }
};
struct SchedP3b {
    const char* A; const char* B; int G, c;
    DI bool next(int i, Unit& u) const {
        const int L = i * G + c; if (L >= 512) return false;
        u.pm = L >> 2; u.pn = L & 3; u.aux = 0; u.pad = 0;
        u.a = A + (size_t)u.pm * 256 * 1024 * 2; u.b = B + (size_t)u.pn * 256 * 1024 * 2; return true;
    }
};
struct SchedM2 {
    const char* xs; const char* wgu; const LAS int* offt; int G, c;
    DI bool next(int i, Unit& u) const {
        const int NT = __builtin_amdgcn_readfirstlane(offt[32]) >> 8; const int L = i * G + c; if (L >= NT * 2) return false;
        const int rt = L >> 1, pn = L & 1; const int e = __builtin_amdgcn_readfirstlane(offt[40 + rt]);
        u.pm = rt; u.pn = pn; u.aux = e; u.pad = 0;
        u.a = xs + (size_t)rt * 256 * 1024 * 2; u.b = wgu + ((size_t)e * 512 + pn * 256) * 1024 * 2; return true;
    }
};
struct SchedM3 {
    const char* hmid; const char* wd; const LAS int* offt; int G, c;
    DI bool next(int i, Unit& u) const {
        const int NT = __builtin_amdgcn_readfirstlane(offt[32]) >> 8; const int L = i * G + c; if (L >= NT * 4) return false;
        const int rt = L >> 2, pn = L & 3; const int e = __builtin_amdgcn_readfirstlane(offt[40 + rt]);
        u.pm = rt; u.pn = pn; u.aux = e; u.pad = 0;
        u.a = hmid + (size_t)rt * 256 * 256 * 2; u.b = wd + ((size_t)e * 1024 + pn * 256) * 256 * 2; return true;
    }
};

struct EpiP1 {
    bf16* proj; bf16* gates; const float* bgate;
    DI void operator()(const f32x4 (&acc)[2][2][4][2], const Unit& u, int wr, int wc, int fr, int fq) const {
        const int row0 = u.pm * 256 + wr * 64 + fr; const int colt = u.pn * 256 + wc * 32 + 8 * fq;
        if (u.pn < 10) {
#pragma unroll
            for (int ai = 0; ai < 2; ++ai)
#pragma unroll
                for (int m = 0; m < 4; ++m) { bf16* rowp = proj + (size_t)(row0 + ai * 128 + m * 16) * PLD + colt;
#pragma unroll
                    for (int bj = 0; bj < 2; ++bj) *(u32x4*)(rowp + bj * 128) = pack8(acc[ai][bj][m][0], acc[ai][bj][m][1]); }
        } else {
            const int gcol = colt - 2560;
            f32x4 bv[2][2];
#pragma unroll
            for (int bj = 0; bj < 2; ++bj)
#pragma unroll
                for (int n = 0; n < 2; ++n) bv[bj][n] = *(const f32x4*)(bgate + gcol + bj * 128 + 4 * n);
#pragma unroll
            for (int ai = 0; ai < 2; ++ai)
#pragma unroll
                for (int m = 0; m < 4; ++m) { bf16* rowp = gates + (size_t)(row0 + ai * 128 + m * 16) * GLD + gcol;
#pragma unroll
                    for (int bj = 0; bj < 2; ++bj) { f32x4 v0 = acc[ai][bj][m][0] + bv[bj][0], v1 = acc[ai][bj][m][1] + bv[bj][1];
#pragma unroll
                        for (int e = 0; e < 4; ++e) { v0[e] = sigmoidf_(v0[e]); v1[e] = sigmoidf_(v1[e]); }
                        *(u32x4*)(rowp + bj * 128) = pack8(v0, v1); }
                    __builtin_amdgcn_sched_barrier(0); }
        }
    }
};
struct EpiP3a {
    bf16* merged; const bf16* gates;
    DI void operator()(const f32x4 (&acc)[2][2][4][2], const Unit& u, int wr, int wc, int fr, int fq) const {
        const int row0 = u.pm * 256 + wr * 64 + fr; const int colt = u.pn * 256 + wc * 32 + 8 * fq; const int br = u.aux;
#pragma unroll
        for (int ai = 0; ai < 2; ++ai)
#pragma unroll
            for (int m = 0; m < 4; ++m) { const size_t row = (size_t)(row0 + ai * 128 + m * 16);
#pragma unroll
                for (int bj = 0; bj < 2; ++bj) {
                    const u32x4 gw = *(const u32x4*)(gates + row * GLD + br * 1024 + colt + bj * 128);
                    bf16* mp = merged + row * 1024 + colt + bj * 128;
                    f32x4 v0 = acc[ai][bj][m][0], v1 = acc[ai][bj][m][1];
                    v0[0] *= lo_bf(gw.x); v0[1] *= hi_bf(gw.x); v0[2] *= lo_bf(gw.y); v0[3] *= hi_bf(gw.y);
                    v1[0] *= lo_bf(gw.z); v1[1] *= hi_bf(gw.z); v1[2] *= lo_bf(gw.w); v1[3] *= hi_bf(gw.w);
                    if (br != 0) { const u32x4 mw = *(const u32x4*)mp;
                        v0[0] += lo_bf(mw.x); v0[1] += hi_bf(mw.x); v0[2] += lo_bf(mw.y); v0[3] += hi_bf(mw.y);
                        v1[0] += lo_bf(mw.z); v1[1] += hi_bf(mw.z); v1[2] += lo_bf(mw.w); v1[3] += hi_bf(mw.w); }
                    *(u32x4*)mp = pack8(v0, v1); }
                __builtin_amdgcn_sched_barrier(0); }
    }
};
struct EpiP3b {
    const float* xin; float* out;
    DI void operator()(const f32x4 (&acc)[2][2][4][2], const Unit& u, int wr, int wc, int fr, int fq) const {
        const int row0 = u.pm * 256 + wr * 64 + fr; const int colt = u.pn * 256 + wc * 32 + 8 * fq;
#pragma unroll
        for (int ai = 0; ai < 2; ++ai)
#pragma unroll
            for (int m = 0; m < 4; ++m) { const size_t off = (size_t)(row0 + ai * 128 + m * 16) * 1024 + colt;
#pragma unroll
                for (int bj = 0; bj < 2; ++bj)
#pragma unroll
                    for (int n = 0; n < 2; ++n) { const f32x4 xv = *(const f32x4*)(xin + off + bj * 128 + 4 * n); *(f32x4*)(out + off + bj * 128 + 4 * n) = xv + acc[ai][bj][m][n]; }
                __builtin_amdgcn_sched_barrier(0); }
    }
};
struct EpiM2 {
    bf16* hmid;
    DI void operator()(const f32x4 (&acc)[2][2][4][2], const Unit& u, int wr, int wc, int fr, int fq) const {
        const int row0 = u.pm * 256 + wr * 64 + fr; const int col = u.pn * 128 + wc * 32 + 8 * fq;
#pragma unroll
        for (int ai = 0; ai < 2; ++ai)
#pragma unroll
            for (int m = 0; m < 4; ++m) { f32x4 h0, h1;
#pragma unroll
                for (int e = 0; e < 4; ++e) { const float g0 = acc[ai][0][m][0][e], g1 = acc[ai][0][m][1][e];
                    h0[e] = g0 * sigmoidf_(g0) * acc[ai][1][m][0][e]; h1[e] = g1 * sigmoidf_(g1) * acc[ai][1][m][1][e]; }
                *(u32x4*)(hmid + (size_t)(row0 + ai * 128 + m * 16) * 256 + col) = pack8(h0, h1); }
    }
};
struct EpiM3 {
    bf16* eo; const int* rowtok; const float* roww;
    DI void operator()(const f32x4 (&acc)[2][2][4][2], const Unit& u, int wr, int wc, int fr, int fq) const {
        const int row0 = u.pm * 256 + wr * 64 + fr; const int colt = u.pn * 256 + wc * 32 + 8 * fq;
#pragma unroll
        for (int ai = 0; ai < 2; ++ai)
#pragma unroll
            for (int m = 0; m < 4; ++m) { const int row = row0 + ai * 128 + m * 16; const int tk = rowtok[row];
                if (tk >= 0) { const float w = roww[row]; bf16* op = eo + (size_t)tk * 1024 + colt;
#pragma unroll
                    for (int bj = 0; bj < 2; ++bj) *(u32x4*)(op + bj * 128) = pack8(acc[ai][bj][m][0] * w, acc[ai][bj][m][1] * w); }
                __builtin_amdgcn_sched_barrier(0); }
    }
};

struct Args { const float* in[36]; float* out; unsigned char* ws; int ph_lo, ph_hi; };
struct InTab { unsigned base;
    DI const float* operator[](int i) const { unsigned long long v; const unsigned addr = base + (unsigned)i * 8u;
        asm volatile("ds_read_b64 %0, %1\n\ts_waitcnt lgkmcnt(0)" : "=v"(v) : "v"(addr) : "memory");
        const unsigned lo = __builtin_amdgcn_readfirstlane((unsigned)v), hi = __builtin_amdgcn_readfirstlane((unsigned)(v >> 32));
        return (const float*)(((unsigned long long)hi << 32) | lo); } };
struct KA { InTab in; float* out; unsigned char* ws; };

DI void transpose_item(const float* W_, int ldw, int nvalid, bf16* WT_, int ldt, int k0, int n0, int dst_row0, LAS float* scr, int lane) {
    const GAS float* W = (const GAS float*)W_; GAS bf16* WT = (GAS bf16*)WT_;
    const int nq = 4 * (lane & 7), kr8 = lane >> 3;
    f32x4 v[8];
#pragma unroll
    for (int i = 0; i < 8; ++i) { const int kk = 8 * i + kr8;
        if (n0 + nq + 3 < nvalid) v[i] = *(const GAS f32x4*)(W + (size_t)(k0 + kk) * ldw + n0 + nq);
        else {
#pragma unroll
            for (int e = 0; e < 4; ++e) v[i][e] = (n0 + nq + e < nvalid) ? W[(size_t)(k0 + kk) * ldw + n0 + nq + e] : 0.f; } }
#pragma unroll
    for (int i = 0; i < 8; ++i) { const int kk = 8 * i + kr8;
#pragma unroll
        for (int e = 0; e < 4; ++e) scr[kk * 33 + nq + e] = v[i][e]; }
    LDS_WAIT(); asm volatile("" ::: "memory");
    const int c = lane & 7;
#pragma unroll
    for (int j = 0; j < 4; ++j) { const int n = (lane >> 3) + 8 * j; const LAS float* s = scr + (8 * c) * 33 + n;
        u32x4 o; o.x = pk2(s[0 * 33], s[1 * 33]); o.y = pk2(s[2 * 33], s[3 * 33]); o.z = pk2(s[4 * 33], s[5 * 33]); o.w = pk2(s[6 * 33], s[7 * 33]);
        if (n0 + n < nvalid) *(GAS u32x4*)(WT + (size_t)(dst_row0 + n) * ldt + k0 + 8 * c) = o; }
    LDS_WAIT(); asm volatile("" ::: "memory");
}
DI void phase0_weights(const KA& a, int l, LAS unsigned char* lds, int gw, int NGW, int wave, int lane) {
    LAS float* scr = (LAS float*)(lds + wave * 16384);
    const float* w_in = a.in[4] + (size_t)l * 1024 * NIN;
    const float* w_gate = a.in[24] + (size_t)l * 4 * 1024 * 1024;
    const float* w_br = a.in[26] + (size_t)l * 4 * 256 * 1024;
    const float* w_out = a.in[27] + (size_t)l * 1024 * 1024;
    bf16* Wt_in = (bf16*)(a.ws + WS_WIN); bf16* Wt_br = (bf16*)(a.ws + WS_WBR); bf16* Wt_out = (bf16*)(a.ws + WS_WOUT);
    constexpr int I_IN = 16 * 77, I_G = 4 * 16 * 32, I_B = 4 * 4 * 32, I_O = 16 * 32, NIT = I_IN + I_G + I_B + I_O;
    for (int it = gw; it < NIT; it += NGW) {
        int r = it;
        if (r < I_IN) { const int kb = r / 77, nb = r % 77; transpose_item(w_in, NIN, NIN, Wt_in, 1024, kb * 64, nb * 32, nb * 32, scr, lane); continue; } r -= I_IN;
        if (r < I_G) { const int br = r / 512, q = r % 512, kb = q / 32, nb = q % 32; transpose_item(w_gate + (size_t)br * 1024 * 1024, 1024, 1024, Wt_in, 1024, kb * 64, nb * 32, 2560 + br * 1024 + nb * 32, scr, lane); continue; } r -= I_G;
        if (r < I_B) { const int br = r / 128, q = r % 128, kb = q / 32, nb = q % 32; transpose_item(w_br + (size_t)br * 256 * 1024, 1024, 1024, Wt_br + (size_t)br * 1024 * 256, 256, kb * 64, nb * 32, nb * 32, scr, lane); continue; } r -= I_B;
        { const int kb = r / 32, nb = r % 32; transpose_item(w_out, 1024, 1024, Wt_out, 1024, kb * 64, nb * 32, nb * 32, scr, lane); }
    }
}

DI void router_weights(const KA& a, int l, int gw, int NGW, int lane) {
    bf16* Wr = (bf16*)(a.ws + WS_WR);
    const float* wg = a.in[29] + (size_t)l * 1024 * 4; const float* we = a.in[31] + (size_t)l * 1024 * 32;
    for (int n = gw; n < 36; n += NGW) {
        for (int i = 0; i < 16; ++i) { const int k = lane + 64 * i; const float w = (n < 4) ? wg[k * 4 + n] : we[k * 32 + (n - 4)];
            const unsigned hi = f2bf(w); const float hf = __builtin_bit_cast(float, hi << 16); const unsigned lo = f2bf(w - hf);
            Wr[(size_t)n * 2048 + k] = (bf16)hi; Wr[(size_t)n * 2048 + 1024 + k] = (bf16)hi; Wr[(size_t)(64 + n) * 2048 + k] = (bf16)lo; Wr[(size_t)(64 + n) * 2048 + 1024 + k] = 0; }
    }
}

DI void cmp_weights(const KA& a, int l, LAS unsigned char* lds, int gw, int NGW, int wave, int lane) {
    LAS float* scr = (LAS float*)(lds + wave * 16384);
    bf16* Wc = (bf16*)(a.ws + WS_WCMP); float* pt = (float*)(a.ws + WS_CMPAB + 2 * MiB);
    for (int it = gw; it < 128 + 64; it += NGW) {
        if (it < 128) { const int kv = it >> 6, q = it & 63, kb = q >> 1, nb = q & 1; const float* w1 = a.in[kv ? 22 : 19] + (size_t)l * 2048 * 64;
            bf16* dst = Wc + (size_t)kv * 256 * 1024 - (kb >= 16 ? 1024 : 0);
            transpose_item(w1, 64, 64, dst, 1024, kb * 64, nb * 32, (kb >= 16 ? 64 : 0) + nb * 32, scr, lane);
        } else { const int kv = (it - 128) >> 5, part = (it - 128) & 31;
            const GAS float* w1 = (const GAS float*)(a.in[kv ? 22 : 19] + (size_t)l * 2048 * 64) + (size_t)part * 64 * 64; const GAS float* pos = (const GAS float*)(a.in[kv ? 21 : 18] + (size_t)l * 2048) + part * 64;
            float acc = 0.f;
#pragma unroll 16
            for (int k = 0; k < 64; ++k) acc += pos[k] * w1[(size_t)k * 64 + lane];
            pt[(kv * 32 + part) * 64 + lane] = acc; }
    }
}

DI void lru_weights(const KA& a, int l, int gw, int NGW, int lane) {
    bf16* W = (bf16*)(a.ws + WS_LRUW); const float* wa = a.in[7] + (size_t)l * 4 * 4096; const float* wx = a.in[9] + (size_t)l * 4 * 4096;
    (void)NGW; { const int idx = gw * 64 + lane; if (idx < 32768) { const int i = idx & 63, j = (idx >> 6) & 63, mat = (idx >> 12) & 1, hbk = idx >> 13;
        W[idx] = (bf16)f2bf((mat ? wx : wa)[(size_t)hbk * 4096 + i * 64 + j]); } }
}
DI void phase0_rows(const KA& a, int l, int mode, int gw, int NGW, int lane) {
    const GAS float* xin = (const GAS float*)((l == 0) ? a.in[0] : a.out);
    const GAS bf16* eo = (const GAS bf16*)(a.ws + WS_PROJ);
    GAS bf16* hb = (GAS bf16*)(a.ws + WS_HB); GAS float* outp = (GAS float*)a.out;
    const GAS float* g = (const GAS float*)(mode ? a.in[2] : (a.in[3] + (size_t)l * 1024));
    f32x4 gv[4];
#pragma unroll
    for (int j = 0; j < 4; ++j) gv[j] = *(const GAS f32x4*)(g + 4 * (lane + 64 * j));
    for (int m0 = gw * 4; m0 < T; m0 += NGW * 4) {
        f32x4 v[4][4]; float ss[4];
#pragma unroll
        for (int rr = 0; rr < 4; ++rr)
#pragma unroll
            for (int j = 0; j < 4; ++j) v[rr][j] = *(const GAS f32x4*)(xin + (size_t)(m0 + rr) * 1024 + 4 * (lane + 64 * j));
        if (l > 0) {
#pragma unroll
            for (int rr = 0; rr < 4; ++rr)
#pragma unroll
                for (int j = 0; j < 4; ++j) {
                    const u32x2 e0 = *(const GAS u32x2*)(eo + (size_t)(2 * (m0 + rr)) * 1024 + 4 * (lane + 64 * j));
                    const u32x2 e1 = *(const GAS u32x2*)(eo + (size_t)(2 * (m0 + rr) + 1) * 1024 + 4 * (lane + 64 * j));
                    v[rr][j][0] += lo_bf(e0.x) + lo_bf(e1.x); v[rr][j][1] += hi_bf(e0.x) + hi_bf(e1.x); v[rr][j][2] += lo_bf(e0.y) + lo_bf(e1.y); v[rr][j][3] += hi_bf(e0.y) + hi_bf(e1.y); } }
#pragma unroll
        for (int rr = 0; rr < 4; ++rr) { float t = 0.f;
#pragma unroll
            for (int j = 0; j < 4; ++j) t += (v[rr][j][0] * v[rr][j][0] + v[rr][j][1] * v[rr][j][1]) + (v[rr][j][2] * v[rr][j][2] + v[rr][j][3] * v[rr][j][3]);
            ss[rr] = t; }
#pragma unroll
        for (int rr = 0; rr < 4; ++rr) ss[rr] = wave_sum(ss[rr]);
#pragma unroll
        for (int rr = 0; rr < 4; ++rr) { const float r = 1.f / sqrtf(ss[rr] * (1.f / 1024.f) + 1e-6f); const size_t m = (size_t)(m0 + rr);
#pragma unroll
            for (int j = 0; j < 4; ++j) { const f32x4 y = v[rr][j] * r * gv[j];
                if (mode) *(GAS f32x4*)(outp + m * 1024 + 4 * (lane + 64 * j)) = y;
                else { if (l > 0) *(GAS f32x4*)(outp + m * 1024 + 4 * (lane + 64 * j)) = v[rr][j];
                       u32x2 w; w.x = pk2(y[0], y[1]); w.y = pk2(y[2], y[3]); *(GAS u32x2*)(hb + m * 1024 + 4 * (lane + 64 * j)) = w; } } }
    }
}

DI int crow(int i, int hh) { return (i & 3) + 8 * (i >> 2) + 4 * hh; }
DI unsigned cvtpk(float lo, float hi) { f32x2 v = {lo, hi}; bf16x2_t b = __builtin_convertvector(v, bf16x2_t); return __builtin_bit_cast(unsigned, b); }
template <int CTRL, int RMASK> DI float dppf(float oldv, float v) { return __builtin_bit_cast(float, __builtin_amdgcn_update_dpp(__builtin_bit_cast(int, oldv), __builtin_bit_cast(int, v), CTRL, RMASK, 0xf, false)); }
template <int CTRL, int RMASK> DI void scan_step(float& a, float& b) {
    const float ap = dppf<CTRL, RMASK>(1.f, a), bp = dppf<CTRL, RMASK>(0.f, b); b = a * bp + b; a = a * ap; }
DI void lru_unit(const KA& a, int l, const GAS bf16* proj, GAS bf16* ys, GAS float* sums, LAS unsigned char* lds, int task, int lane_in, int wave_in, bool final) {
    int lane = lane_in, wave = wave_in; asm volatile("" : "+v"(lane), "+s"(wave));
    const int chunk = task & 31, hbk = (task >> 5) & 3, b = task >> 7;
    const int ts = chunk * 256 + wave * 32; const size_t rowb = (size_t)b * SEQ;
    LAS unsigned char* wl = lds + wave * 16384;
    LAS float* ex = (LAS float*)(lds + LRUEX_OFF); LAS float* cst = (LAS float*)(lds + LRUCST_OFF); LAS float* car = (LAS float*)(lds + LRUCAR_OFF) + wave * 64;
    {
        const int c = hbk * 64 + lane;
        const GAS float* cw = (const GAS float*)(a.in[5] + (size_t)l * 4 * 256);
        const float cw0 = cw[c], cw1 = cw[256 + c], cw2 = cw[512 + c], cw3 = cw[768 + c]; const float cb = a.in[6][l * 256 + c];
        if (wave == 0) { cst[lane] = a.in[8][l * 256 + c]; cst[64 + lane] = a.in[10][l * 256 + c]; cst[128 + lane] = -8.f * softplusf_(-a.in[11][l * 256 + c]); }
        const GAS bf16* xp = proj + (rowb + ts) * PLD + C_AX + c;
        float x3 = (ts >= 3) ? bf2f(*(xp - 3 * PLD)) : 0.f, x2 = (ts >= 2) ? bf2f(*(xp - 2 * PLD)) : 0.f, x1 = (ts >= 1) ? bf2f(*(xp - PLD)) : 0.f;
#pragma unroll 8
        for (int n = 0; n < 32; ++n) { const float x0 = bf2f(xp[(size_t)n * PLD]); const float xc = cb + cw0 * x3 + cw1 * x2 + cw2 * x1 + cw3 * x0;
            *(LAS bf16*)(wl + n * 144 + lane * 2) = (bf16)f2bf(xc); *(LAS float*)(wl + 4608 + n * 272 + lane * 4) = xc; x3 = x2; x2 = x1; x1 = x0; }
    }
    const int n = lane & 31, hh = lane >> 5;
    f32x16 D[4];
    {
        const GAS bf16* wt = (const GAS bf16*)(a.ws + WS_LRUW) + (size_t)hbk * 8192;
        bf16x8 bfr[4];
        LDS_WAIT();
#pragma unroll
        for (int s4 = 0; s4 < 4; ++s4) bfr[s4] = *(const LAS bf16x8*)(wl + n * 144 + hh * 16 + s4 * 32);
#pragma unroll
        for (int m = 0; m < 4; ++m) {
#pragma unroll
            for (int s4 = 0; s4 < 4; ++s4) { const bf16x8 af = *(const GAS bf16x8*)(wt + (size_t)(m >> 1) * 4096 + (32 * (m & 1) + n) * 64 + 8 * hh + 16 * s4);
                if (s4 == 0) { f32x16 z;
#pragma unroll
                    for (int i = 0; i < 16; ++i) z[i] = 0.f;
                    D[m] = MFMA32(af, bfr[s4], z); } else D[m] = MFMA32(af, bfr[s4], D[m]); } }
    }
    __syncthreads();
    const bool t0 = (ts + n) == 0;
#pragma unroll
    for (int mm = 0; mm < 2; ++mm)
#pragma unroll
        for (int g4 = 0; g4 < 4; ++g4) { const int c0 = 32 * mm + 8 * g4 + 4 * hh;
            const f32x4 vba = *(const LAS f32x4*)(cst + c0), vbx = *(const LAS f32x4*)(cst + 64 + c0), vc8 = *(const LAS f32x4*)(cst + 128 + c0);
            const f32x4 vxc = *(const LAS f32x4*)(wl + 4608 + n * 272 + c0 * 4);
#pragma unroll
            for (int e = 0; e < 4; ++e) { const int i = 4 * g4 + e;
                const float r = sigmoidf_(D[mm][i] + vba[e]), ig = sigmoidf_(D[2 + mm][i] + vbx[e]);
                const float la = vc8[e] * r; const float av = __expf(la);
                const float mult = t0 ? 1.f : sqrtf(fmaxf(1.f - __expf(2.f * la), 0.f));
                float aa = av, bb = mult * ig * vxc[e];
                scan_step<0x111, 0xf>(aa, bb); scan_step<0x112, 0xf>(aa, bb); scan_step<0x114, 0xf>(aa, bb); scan_step<0x118, 0xf>(aa, bb); scan_step<0x142, 0xa>(aa, bb);
                D[mm][i] = aa; D[2 + mm][i] = bb; } }
    if (n == 31) {
#pragma unroll
        for (int mm = 0; mm < 2; ++mm)
#pragma unroll
            for (int i = 0; i < 16; ++i) { const int c = 32 * mm + crow(i, hh); ex[(wave * 64 + c) * 2] = D[mm][i]; ex[(wave * 64 + c) * 2 + 1] = D[2 + mm][i]; } }
    __syncthreads();
    if (!final) {
        if (wave == 0) { float hv = 0.f, av = 1.f;
#pragma unroll
            for (int w = 0; w < 8; ++w) { const float A_ = ex[(w * 64 + lane) * 2], H_ = ex[(w * 64 + lane) * 2 + 1]; hv = A_ * hv + H_; av *= A_; }
            GAS float* sp = sums + ((size_t)((b * 4 + hbk) * 32 + chunk) * 64 + lane) * 2; sp[0] = av; sp[1] = hv; }
    } else {
        {   float hv = 0.f;
            {   const GAS f32x2* sp = (const GAS f32x2*)(sums + ((size_t)((b * 4 + hbk) * 32) * 64 + lane) * 2);
                int cc = 0;
                for (; cc + 8 <= chunk; cc += 8) { f32x2 v[8];
#pragma unroll
                    for (int e = 0; e < 8; ++e) v[e] = sp[(size_t)(cc + e) * 64];
#pragma unroll
                    for (int e = 0; e < 8; ++e) hv = v[e][0] * hv + v[e][1]; }
                for (; cc < chunk; ++cc) { const f32x2 v = sp[(size_t)cc * 64]; hv = v[0] * hv + v[1]; } }
            for (int w = 0; w < wave; ++w) { const float A_ = ex[(w * 64 + lane) * 2], H_ = ex[(w * 64 + lane) * 2 + 1]; hv = A_ * hv + H_; }
            car[lane] = hv; }
        LDS_WAIT(); asm volatile("" ::: "memory");
        const GAS bf16* gp = proj + (rowb + ts + n) * PLD + C_AG + hbk * 64; GAS bf16* yp = ys + (rowb + ts + n) * 1024 + hbk * 64;
#pragma unroll
        for (int mm = 0; mm < 2; ++mm)
#pragma unroll
            for (int g4 = 0; g4 < 4; ++g4) { const int c0 = 32 * mm + 8 * g4 + 4 * hh; const f32x4 cv = *(const LAS f32x4*)(car + c0);
                float y[4];
#pragma unroll
                for (int e = 0; e < 4; ++e) { const int i = 4 * g4 + e; const float hv = D[2 + mm][i] + D[mm][i] * cv[e];
                    const float gt = bf2f(gp[c0 + e]); y[e] = hv * gelu_tanh(gt); }
#pragma unroll
                for (int e = 0; e < 4; ++e) yp[c0 + e] = (bf16)f2bf(y[e]); }
    }
    __syncthreads();
}

constexpr int DK_STR = 144, DV_STR = 192, DBUF_BYTES = 64 * DK_STR + 64 * DV_STR;
DI bf16x8 pack_half(const f32x16& x, int s2) { u32x4 p;
    if (s2 == 0) { p.x = cvtpk(x[0], x[1]); p.y = cvtpk(x[2], x[3]); p.z = cvtpk(x[4], x[5]); p.w = cvtpk(x[6], x[7]); }
    else { p.x = cvtpk(x[8], x[9]); p.y = cvtpk(x[10], x[11]); p.z = cvtpk(x[12], x[13]); p.w = cvtpk(x[14], x[15]); }
    return __builtin_bit_cast(bf16x8, p); }
DI s16x4 vtr(const LAS unsigned char* p) { return __builtin_bit_cast(s16x4, __builtin_amdgcn_ds_read_tr16_b64_v4i16((LAS v4i16_t*)p)); }
DI float max16(const f32x16& x) { float a = fmaxf(fmaxf(x[0], x[1]), fmaxf(x[2], x[3])), b = fmaxf(fmaxf(x[4], x[5]), fmaxf(x[6], x[7])), c = fmaxf(fmaxf(x[8], x[9]), fmaxf(x[10], x[11])), d = fmaxf(fmaxf(x[12], x[13]), fmaxf(x[14], x[15])); return fmaxf(fmaxf(a, b), fmaxf(c, d)); }
DI void diff_unit(const GAS bf16* proj, GAS bf16* ys, LAS unsigned char* lds, const LAS float* bias2, const GAS float* subg, const LAS float* lamp, int b, int h, int qb, int wave_in) {
    int wave = wave_in; asm volatile("" : "+s"(wave)); const int lane = my_lane(); const int tid = wave * 64 + lane;
    const int q0 = qb * 256 + wave * 32; const int ql = lane & 31, hh = lane >> 5; const int q = q0 + ql;
    const size_t rowb = (size_t)b * SEQ;
    const float SC = 0.17677669529663687f * 1.4426950408889634f;
    bf16x8 qf[2][2];
    { const GAS bf16* qp = proj + (rowb + q) * PLD + C_CQ + h * 64 + hh * 8;
#pragma unroll
      for (int m = 0; m < 2; ++m)
#pragma unroll
        for (int s = 0; s < 2; ++s) { const u32x4 w = *(const GAS u32x4*)(qp + m * 32 + s * 16); u32x4 o;
            o.x = cvtpk(lo_bf(w.x) * SC, hi_bf(w.x) * SC); o.y = cvtpk(lo_bf(w.y) * SC, hi_bf(w.y) * SC); o.z = cvtpk(lo_bf(w.z) * SC, hi_bf(w.z) * SC); o.w = cvtpk(lo_bf(w.w) * SC, hi_bf(w.w) * SC);
            qf[m][s] = __builtin_bit_cast(bf16x8, o); } }
    f32x16 O[2][2], negm[2];
#pragma unroll
    for (int i = 0; i < 16; ++i) { O[0][0][i] = 0.f; O[0][1][i] = 0.f; O[1][0][i] = 0.f; O[1][1][i] = 0.f; negm[0][i] = 120.f; negm[1][i] = 120.f; }
    float lsum[2] = {0.f, 0.f};
    const int nsteps = 4 * qb + 4, mysteps = 4 * qb + (wave >> 1) + 1;
    const int skey = tid >> 3, sch = tid & 7;
    const GAS unsigned char* kgb = (const GAS unsigned char*)(proj + rowb * PLD + C_CK + h * 64);
    const GAS unsigned char* vgb = (const GAS unsigned char*)(proj + rowb * PLD + C_CV + h * 64);
    const unsigned soff = (unsigned)(skey * PLD + sch * 8) * 2u;
    u32x4 kr = *(const GAS u32x4*)(kgb + soff), vr = *(const GAS u32x4*)(vgb + soff);
    *(LAS u32x4*)(lds + skey * DK_STR + sch * 16) = kr; *(LAS u32x4*)(lds + 64 * DK_STR + skey * DV_STR + sch * 16) = vr;
    __syncthreads();
    const int i16 = lane & 15, blk = (lane >> 4) & 1;
    const int kboff = ql * DK_STR + hh * 16;
    const int vboff = 64 * DK_STR + (4 * hh + (i16 >> 2)) * DV_STR + (16 * blk + 4 * (i16 & 3)) * 2;
#pragma unroll 1
    for (int kt = 0; kt < nsteps; ++kt) {
        const LAS unsigned char* cur = lds + (kt & 1) * DBUF_BYTES; LAS unsigned char* nxt = lds + ((kt + 1) & 1) * DBUF_BYTES;
        if (kt + 1 < nsteps) { const unsigned so = soff + (unsigned)(kt + 1) * (64u * PLD * 2u); kr = *(const GAS u32x4*)(kgb + so); vr = *(const GAS u32x4*)(vgb + so); }
        if (kt < mysteps) {
            const int kbase = kt * 64;
            const bool near = (q0 - (kbase + 63) < 113);
#pragma unroll
            for (int m = 0; m < 2; ++m) {
                bf16x8 pk[2][2];
                f32x16 S[2]; float ts = 0.f;
                {   bf16x8 kf[2][2];
#pragma unroll
                    for (int t = 0; t < 2; ++t)
#pragma unroll
                        for (int s = 0; s < 2; ++s) kf[t][s] = *(const LAS bf16x8*)(cur + kboff + t * 32 * DK_STR + m * 64 + s * 32);
#pragma unroll
                    for (int t = 0; t < 2; ++t) { S[t] = MFMA32(kf[t][0], qf[m][0], negm[m]); S[t] = MFMA32(kf[t][1], qf[m][1], S[t]); } }
                if (near) {
#pragma unroll
                    for (int t = 0; t < 2; ++t)
#pragma unroll
                        for (int i = 0; i < 16; ++i) { const int dist = q - (kbase + 32 * t + crow(i, hh)); const int di = dist < 128 ? dist : 128;
                            const float bv = dist >= 0 ? bias2[di * 12 + 4 + h] : -1e30f; S[t][i] += bv; } }
#pragma unroll
                for (int t = 0; t < 2; ++t)
#pragma unroll
                    for (int i = 0; i < 16; ++i) { const float p = __builtin_amdgcn_exp2f(S[t][i]); S[t][i] = p; ts += p; }
                if (__builtin_amdgcn_ballot_w64(!(ts < 1.0e30f)) != 0ull) {
                {   bf16x8 kf[2][2];
#pragma unroll
                        for (int t = 0; t < 2; ++t)
#pragma unroll
                            for (int s = 0; s < 2; ++s) kf[t][s] = *(const LAS bf16x8*)(cur + kboff + t * 32 * DK_STR + m * 64 + s * 32);
#pragma unroll
                        for (int t = 0; t < 2; ++t) { S[t] = MFMA32(kf[t][0], qf[m][0], negm[m]); S[t] = MFMA32(kf[t][1], qf[m][1], S[t]); } }
                    if (near) {
#pragma unroll
                        for (int t = 0; t < 2; ++t)
#pragma unroll
                            for (int i = 0; i < 16; ++i) { const int dist = q - (kbase + 32 * t + crow(i, hh)); const int di = dist < 128 ? dist : 128;
                                const float bv = dist >= 0 ? bias2[di * 12 + 4 + h] : -1e30f; S[t][i] += bv; } }
                    float tm = fmaxf(max16(S[0]), max16(S[1])); tm = fmaxf(tm, xshfl<32>(tm));
                    const float sh = fmaxf(tm, 0.f); const float al = __builtin_amdgcn_exp2f(-sh);
                    lsum[m] *= al; ts = 0.f;
#pragma unroll
                    for (int i = 0; i < 16; ++i) { O[m][0][i] *= al; O[m][1][i] *= al; negm[m][i] -= sh; }
#pragma unroll
                    for (int t = 0; t < 2; ++t)
#pragma unroll
                        for (int i = 0; i < 16; ++i) { const float p = __builtin_amdgcn_exp2f(S[t][i] - sh); S[t][i] = p; ts += p; }
                }
                lsum[m] += ts;
#pragma unroll
                for (int t = 0; t < 2; ++t) { pk[t][0] = pack_half(S[t], 0); pk[t][1] = pack_half(S[t], 1); }
#pragma unroll
                for (int t = 0; t < 2; ++t)
#pragma unroll
                    for (int s2 = 0; s2 < 2; ++s2)
#pragma unroll
                        for (int db = 0; db < 2; ++db) {
                            const s16x4 lo = vtr(cur + vboff + (32 * t + 16 * s2) * DV_STR + db * 64), hi = vtr(cur + vboff + (32 * t + 16 * s2 + 8) * DV_STR + db * 64);
                            const bf16x8 vf = __builtin_shufflevector(lo, hi, 0, 1, 2, 3, 4, 5, 6, 7);
                            O[m][db] = MFMA32(vf, pk[t][s2], O[m][db]); }
                ;
            }
        }
        if (kt + 1 < nsteps) { *(LAS u32x4*)(nxt + skey * DK_STR + sch * 16) = kr; *(LAS u32x4*)(nxt + 64 * DK_STR + skey * DV_STR + sch * 16) = vr; }
        __syncthreads();
    }
    const float l0 = lsum[0] + xshfl<32>(lsum[0]), l1 = lsum[1] + xshfl<32>(lsum[1]);
    const float lam = lamp[0], lam_init = lamp[1];
    const float i0 = 1.f / fmaxf(l0, 1e-30f), i1 = lam / fmaxf(l1, 1e-30f);
    float ss = 0.f;
#pragma unroll
    for (int db = 0; db < 2; ++db)
#pragma unroll
        for (int i = 0; i < 16; ++i) { const float at = O[0][db][i] * i0 - O[1][db][i] * i1; O[0][db][i] = at; ss += at * at; }
    ss += xshfl<32>(ss);
    const float r = (1.f - lam_init) / sqrtf(ss * (1.f / 64.f) + 1e-5f);
    GAS bf16* op = ys + (rowb + q) * 1024 + 512 + h * 64;
#pragma unroll
    for (int db = 0; db < 2; ++db)
#pragma unroll
        for (int gq = 0; gq < 4; ++gq) { const int d0 = 32 * db + 8 * gq + 4 * hh; const f32x4 sg = *(const GAS f32x4*)(subg + d0);
            u32x2 w; w.x = cvtpk(O[0][db][4 * gq + 0] * r * sg[0], O[0][db][4 * gq + 1] * r * sg[1]); w.y = cvtpk(O[0][db][4 * gq + 2] * r * sg[2], O[0][db][4 * gq + 3] * r * sg[3]);
            *(GAS u32x2*)(op + d0) = w; }
}

struct SchedCmp { const char* proj; const char* wc; int G, c;
    DI bool next(int i, Unit& u) const { const int L = i * G + c; if (L >= 16) return false; const int kv = L >> 3, rt = L & 7;
        u.pm = rt; u.pn = 0; u.aux = kv; u.pad = 0; u.a = proj + ((size_t)rt * 256 * 16 * PLD + (kv ? C_VC : C_KC)) * 2; u.b = wc + (size_t)kv * 256 * 1024 * 2; return true; } };
struct EpiCmp { float* ab;
    DI void operator()(const f32x4 (&acc)[2][2][4][2], const Unit& u, int wr, int wc, int fr, int fq) const {
        const int row0 = u.pm * 256 + wr * 64 + fr; const int col = wc * 32 + 8 * fq;
#pragma unroll
        for (int ai = 0; ai < 2; ++ai)
#pragma unroll
            for (int m = 0; m < 4; ++m) { float* rp = ab + ((size_t)u.aux * 2048 + row0 + ai * 128 + m * 16) * 128 + col; *(f32x4*)rp = acc[ai][0][m][0]; *(f32x4*)(rp + 4) = acc[ai][0][m][1]; }
    }
};
DI void cmp_finish(const KA& a, int l, const float* ab, bf16* kcb, int task, int lane) {
    const int kv = task / (BATCH * NCMP), r = task % (BATCH * NCMP), b = r / NCMP, c = r % NCMP;
    const float* w2 = a.in[kv ? 23 : 20] + (size_t)l * 4096; const float* pt = ab + 2 * 2048 * 128;
    const size_t g = (size_t)kv * 2048 + b * 512 + c;
    float ptv = 0.f;
#pragma unroll 8
    for (int part = 0; part < 32; ++part) ptv += pt[(kv * 32 + part) * 64 + lane];
    const float h1 = ab[g * 128 + lane] + ab[(g + 1) * 128 + 64 + lane] + ptv;
    const float gl = gelu_tanh(h1); float o = 0.f;
#pragma unroll
    for (int j = 0; j < 64; ++j) o += rl(gl, j) * w2[j * 64 + lane];
    kcb[((size_t)(kv * BATCH + b) * 512 + c) * 64 + lane] = (bf16)f2bf(o);
    if (c == NCMP - 1) kcb[((size_t)(kv * BATCH + b) * 512 + NCMP) * 64 + lane] = 0;
}

DI void st_load(const GAS unsigned char* kb, const GAS unsigned char* vb, unsigned off, u32x4& kr, u32x4& vr) { kr = *(const GAS u32x4*)(kb + off); vr = *(const GAS u32x4*)(vb + off); }
DI void st_write(LAS unsigned char* buf, int skey, int sch, const u32x4& kr, const u32x4& vr) { *(LAS u32x4*)(buf + skey * DK_STR + sch * 16) = kr; *(LAS u32x4*)(buf + 64 * DK_STR + skey * DV_STR + sch * 16) = vr; }
DI void qk64(const LAS unsigned char* cur, int kboff, const bf16x8 (&qf)[4], const f32x16& cinit, f32x16 (&S)[2]) {
#pragma unroll
    for (int t = 0; t < 2; ++t) { S[t] = cinit;
#pragma unroll
        for (int s = 0; s < 4; ++s) { const bf16x8 kf = *(const LAS bf16x8*)(cur + kboff + t * 32 * DK_STR + s * 32); S[t] = MFMA32(kf, qf[s], S[t]); } }
}
DI void qk32z(const LAS unsigned char* kt32, const bf16x8 (&qf)[4], f32x16& S) {
#pragma unroll
    for (int s = 0; s < 4; ++s) { const bf16x8 kf = *(const LAS bf16x8*)(kt32 + s * 32);
        if (s == 0) { f32x16 z;
#pragma unroll
            for (int i = 0; i < 16; ++i) z[i] = 0.f;
            S = MFMA32(kf, qf[s], z); } else S = MFMA32(kf, qf[s], S); }
}
DI void pv32(const LAS unsigned char* vt32, const bf16x8 (&pk)[2], f32x16 (&O)[2]) {
#pragma unroll
    for (int s2 = 0; s2 < 2; ++s2)
#pragma unroll
        for (int db = 0; db < 2; ++db) {
            const s16x4 lo = vtr(vt32 + (16 * s2) * DV_STR + db * 64), hi = vtr(vt32 + (16 * s2 + 8) * DV_STR + db * 64);
            const bf16x8 vf = __builtin_shufflevector(lo, hi, 0, 1, 2, 3, 4, 5, 6, 7);
            O[db] = MFMA32(vf, pk[s2], O[db]); }
}
DI void mask_bias_cmp32(f32x16& S, int tcol, int cbase, int hh, const LAS float* b2h, float msub) {
#pragma unroll
    for (int i = 0; i < 16; ++i) { const int c = cbase + crow(i, hh); const int dist = tcol - 31 - 16 * c; const bool ok = dist >= 0 && c < NCMP;
        const int di = dist < 0 ? 0 : (dist < 128 ? dist : 128); S[i] = ok ? S[i] + (b2h[di * 12] - msub) : -1e30f; }
}
DI void pv64(const LAS unsigned char* cur, int vboff, const bf16x8 (&pk)[2][2], f32x16 (&O)[2]) {
#pragma unroll
    for (int t = 0; t < 2; ++t)
#pragma unroll
        for (int s2 = 0; s2 < 2; ++s2)
#pragma unroll
            for (int db = 0; db < 2; ++db) {
                const s16x4 lo = vtr(cur + vboff + (32 * t + 16 * s2) * DV_STR + db * 64), hi = vtr(cur + vboff + (32 * t + 16 * s2 + 8) * DV_STR + db * 64);
                const bf16x8 vf = __builtin_shufflevector(lo, hi, 0, 1, 2, 3, 4, 5, 6, 7);
                O[db] = MFMA32(vf, pk[t][s2], O[db]); }
}
DI void softmax_step(f32x16 (&S)[2], f32x16 (&O)[2], f32x16& negm, float& lsum, bf16x8 (&pk)[2][2]) {
    float tm = fmaxf(max16(S[0]), max16(S[1]));
    if (__builtin_amdgcn_ballot_w64(tm > 8.f) != 0ull) {
        tm = fmaxf(tm, xshfl<32>(tm)); const float sh = fmaxf(tm, 0.f); const float al = __builtin_amdgcn_exp2f(-sh);
        lsum *= al;
#pragma unroll
        for (int i = 0; i < 16; ++i) { O[0][i] *= al; O[1][i] *= al; negm[i] -= sh; S[0][i] -= sh; S[1][i] -= sh; } }
#pragma unroll
    for (int t = 0; t < 2; ++t) {
#pragma unroll
        for (int i = 0; i < 16; ++i) { const float p = __builtin_amdgcn_exp2f(S[t][i]); S[t][i] = p; lsum += p; }
        pk[t][0] = pack_half(S[t], 0); pk[t][1] = pack_half(S[t], 1); }
}
DI void mask_bias(f32x16 (&S)[2], int tcol, int kbase, int hh, int W, bool colsel, const LAS float* b2h) {
#pragma unroll
    for (int t = 0; t < 2; ++t)
#pragma unroll
        for (int i = 0; i < 16; ++i) { const int dist = tcol - (kbase + 32 * t + crow(i, hh)); const bool ok = colsel && dist >= 0 && dist < W;
            const int di = dist < 0 ? 0 : (dist < 128 ? dist : 128); S[t][i] = ok ? S[t][i] + b2h[di * 12] : -1e30f; }
}
DI void nsa_unit(const GAS bf16* proj, GAS bf16* ys, const GAS bf16* kcb, LAS unsigned char* lds, const LAS float* bias2, int b, int u, int tid_in, int lane_in, int wave_in) {
    int tid = tid_in, lane = lane_in, wave = wave_in; asm volatile("" : "+v"(tid), "+v"(lane), "+s"(wave));
    const int t0 = u * 64; const int col = lane & 31, hh = lane >> 5, tl = col >> 2, head = col & 3;
    const int t = t0 + wave * 8 + tl; const int tw0 = t0 + wave * 8;
    const size_t rowb = (size_t)b * SEQ;
    const LAS float* b2h = bias2 + 8 + head;
    bf16x8 qf[4];
    { const float SC = 0.125f * 1.4426950408889634f; const GAS bf16* qp = proj + (rowb + t) * PLD + C_DQ + head * 64 + hh * 8;
#pragma unroll
      for (int s = 0; s < 4; ++s) { const u32x4 w = *(const GAS u32x4*)(qp + s * 16); u32x4 o;
          o.x = cvtpk(lo_bf(w.x) * SC, hi_bf(w.x) * SC); o.y = cvtpk(lo_bf(w.y) * SC, hi_bf(w.y) * SC); o.z = cvtpk(lo_bf(w.z) * SC, hi_bf(w.z) * SC); o.w = cvtpk(lo_bf(w.w) * SC, hi_bf(w.w) * SC);
          qf[s] = __builtin_bit_cast(bf16x8, o); } }
    const int skey = tid >> 3, sch = tid & 7;
    const int i16 = lane & 15, blk = (lane >> 4) & 1;
    const int kboff = col * DK_STR + hh * 16;
    const int vboff = 64 * DK_STR + (4 * hh + (i16 >> 2)) * DV_STR + (16 * blk + 4 * (i16 & 3)) * 2;
    u32x4 kr, vr;
    const int ncvm = (4 * u + 3) < NCMP ? (4 * u + 3) : NCMP;
    const int nsc = (ncvm + 63) >> 6;
    const GAS unsigned char* kcp = (const GAS unsigned char*)(kcb + (size_t)(0 * BATCH + b) * 512 * 64);
    const GAS unsigned char* vcp = (const GAS unsigned char*)(kcb + (size_t)(1 * BATCH + b) * 512 * 64);
    const unsigned soffc = (unsigned)(skey * 64 + sch * 8) * 2u;
    float m1 = -120.f, l1 = 0.f;
    st_load(kcp, vcp, soffc, kr, vr); st_write(lds, skey, sch, kr, vr); __syncthreads();
#pragma unroll 1
    for (int kt = 0; kt < nsc; ++kt) {
        const LAS unsigned char* cur = lds + (kt & 1) * DBUF_BYTES; LAS unsigned char* nxt = lds + ((kt + 1) & 1) * DBUF_BYTES;
        if (kt + 1 < nsc) st_load(kcp, vcp, soffc + (unsigned)(kt + 1) * 8192u, kr, vr);
#pragma unroll
        for (int tt = 0; tt < 2; ++tt) { f32x16 S; qk32z(cur + kboff + tt * 32 * DK_STR, qf, S); mask_bias_cmp32(S, t, kt * 64 + tt * 32, hh, b2h, 0.f);
          const float tm = max16(S); const float mn = fmaxf(m1, tm); float acc = 0.f;
#pragma unroll
          for (int i = 0; i < 16; ++i) acc += __builtin_amdgcn_exp2f(S[i] - mn);
          l1 = l1 * __builtin_amdgcn_exp2f(m1 - mn) + acc; m1 = mn; }
        if (kt + 1 < nsc) st_write(nxt, skey, sch, kr, vr);
        __syncthreads();
    }
    float mf, inv;
    { const float mo = xshfl<32>(m1), lo = xshfl<32>(l1); mf = fmaxf(m1, mo); const float lf = l1 * __builtin_amdgcn_exp2f(m1 - mf) + lo * __builtin_amdgcn_exp2f(mo - mf); inv = lf > 0.f ? 1.f / lf : 0.f; }
    f32x16 Oc[2], imp[4];
#pragma unroll
    for (int i = 0; i < 16; ++i) { Oc[0][i] = 0.f; Oc[1][i] = 0.f; imp[0][i] = 0.f; imp[1][i] = 0.f; imp[2][i] = 0.f; imp[3][i] = 0.f; }
    {   st_load(kcp, vcp, soffc, kr, vr); st_write(lds, skey, sch, kr, vr); __syncthreads();
#pragma unroll 1
        for (int kt = 0; kt < nsc; ++kt) {
            const LAS unsigned char* cur = lds + (kt & 1) * DBUF_BYTES; LAS unsigned char* nxt = lds + ((kt + 1) & 1) * DBUF_BYTES;
            if (kt + 1 < nsc) st_load(kcp, vcp, soffc + (unsigned)(kt + 1) * 8192u, kr, vr);
#pragma unroll
            for (int tt = 0; tt < 2; ++tt) {
                f32x16 S; qk32z(cur + kboff + tt * 32 * DK_STR, qf, S); mask_bias_cmp32(S, t, kt * 64 + tt * 32, hh, b2h, mf);
#pragma unroll
                for (int i = 0; i < 16; ++i) S[i] = __builtin_amdgcn_exp2f(S[i]) * inv;
                bf16x8 pk[2]; pk[0] = pack_half(S, 0); pk[1] = pack_half(S, 1);
                pv32(cur + vboff + tt * 32 * DV_STR, pk, Oc);
                const int Tq = (2 * kt + tt) & 3, MB = (2 * kt + tt) >> 2;
#pragma unroll
                for (int s2 = 0; s2 < 2; ++s2) { u32x4 aw; unsigned e[8];
#pragma unroll
                    for (int jj = 0; jj < 8; ++jj) { const int kk = 16 * s2 + 8 * (jj >> 2) + 4 * hh + (jj & 3); const int delta = 32 * Tq + kk - 4 * col;
                        e[jj] = (delta == -1 || delta == 3) ? 0x3F80u : ((unsigned)delta <= 2u ? 0x4000u : 0u); }
                    aw.x = e[0] | (e[1] << 16); aw.y = e[2] | (e[3] << 16); aw.z = e[4] | (e[5] << 16); aw.w = e[6] | (e[7] << 16);
                    const bf16x8 af = __builtin_bit_cast(bf16x8, aw);
                    if (MB == 0) imp[0] = MFMA32(af, pk[s2], imp[0]); else if (MB == 1) imp[1] = MFMA32(af, pk[s2], imp[1]); else if (MB == 2) imp[2] = MFMA32(af, pk[s2], imp[2]); else imp[3] = MFMA32(af, pk[s2], imp[3]); }
                if (Tq == 3 && MB < 3) { u32x4 aw; aw.x = 0u; aw.y = 0u; aw.z = 0u; aw.w = (lane == 32) ? 0x3F800000u : 0u;
                    const bf16x8 af = __builtin_bit_cast(bf16x8, aw);
                    if (MB == 0) imp[1] = MFMA32(af, pk[1], imp[1]); else if (MB == 1) imp[2] = MFMA32(af, pk[1], imp[2]); else imp[3] = MFMA32(af, pk[1], imp[3]); }
            }
            if (kt + 1 < nsc) st_write(nxt, skey, sch, kr, vr);
            __syncthreads();
        }
    }
    unsigned ocp[2][8];
#pragma unroll
    for (int db = 0; db < 2; ++db)
#pragma unroll
        for (int i = 0; i < 8; ++i) ocp[db][i] = cvtpk(Oc[db][2 * i], Oc[db][2 * i + 1]);
    unsigned sm0 = 0u, sm1 = 0u, sm2 = 0u, sm3 = 0u;
    {   const int cur_t = t >> 6; unsigned key[16];
#pragma unroll
        for (int i = 0; i < 16; ++i) {
            float v0 = imp[0][i], v1 = imp[1][i], v2 = imp[2][i], v3 = imp[3][i];
            v0 += xshfl<1>(v0); v0 += xshfl<2>(v0); v1 += xshfl<1>(v1); v1 += xshfl<2>(v1); v2 += xshfl<1>(v2); v2 += xshfl<2>(v2); v3 += xshfl<1>(v3); v3 += xshfl<2>(v3);
            const float val = head == 0 ? v0 : (head == 1 ? v1 : (head == 2 ? v2 : v3));
            const int j = 32 * head + crow(i, hh);
            const bool forced = (j == 0) || (j == cur_t) || (j == cur_t - 1);
            unsigned fx = (unsigned)(fminf(fmaxf(val, 0.f), 31.f) * 1048576.f) + 1u;
            fx = forced ? 0x1FFFFFFu : (j <= cur_t ? fx : 0u);
            key[i] = (fx << 7) | (unsigned)(127 - j); }
#pragma unroll 1
        for (int r = 0; r < 16; ++r) {
            unsigned w = key[0];
#pragma unroll
            for (int i = 1; i < 16; ++i) w = w > key[i] ? w : key[i];
            { unsigned o = (unsigned)xshfl_i<1>((int)w); w = w > o ? w : o; o = (unsigned)xshfl_i<2>((int)w); w = w > o ? w : o; o = (unsigned)xshfl_i<32>((int)w); w = w > o ? w : o; }
            if ((w >> 7) != 0u) { const int j = 127 - (int)(w & 127u); const unsigned bit = 1u << (j & 31); const int jb = j >> 5;
                sm0 |= (jb == 0) ? bit : 0u; sm1 |= (jb == 1) ? bit : 0u; sm2 |= (jb == 2) ? bit : 0u; sm3 |= (jb == 3) ? bit : 0u; }
#pragma unroll
            for (int i = 0; i < 16; ++i) key[i] = (key[i] == w) ? 0u : key[i];
        }
    }
    f32x16 Ow[2]; float lw = 0.f;
#pragma unroll
    for (int i = 0; i < 16; ++i) { Ow[0][i] = 0.f; Ow[1][i] = 0.f; }
    {   f32x16 negm;
#pragma unroll
        for (int i = 0; i < 16; ++i) negm[i] = 120.f;
        const GAS unsigned char* kwp = (const GAS unsigned char*)(proj + rowb * PLD + C_KW); const GAS unsigned char* vwp = (const GAS unsigned char*)(proj + rowb * PLD + C_VW);
        const unsigned soffp = (unsigned)(skey * PLD + sch * 8) * 2u;
        const int s0 = (u < 8) ? 8 - u : 0;
        st_load(kwp, vwp, soffp + (unsigned)(u - 8 + s0) * (64u * PLD * 2u), kr, vr); st_write(lds, skey, sch, kr, vr); __syncthreads();
#pragma unroll 1
        for (int s = s0; s < 9; ++s) {
            const int par = (s - s0) & 1; const LAS unsigned char* cur = lds + par * DBUF_BYTES; LAS unsigned char* nxt = lds + (par ^ 1) * DBUF_BYTES;
            if (s + 1 < 9) st_load(kwp, vwp, soffp + (unsigned)(u - 8 + s + 1) * (64u * PLD * 2u), kr, vr);
            {   f32x16 S[2]; qk64(cur, kboff, qf, negm, S);
                if (s == 0 || s >= 6) mask_bias(S, t, (u - 8 + s) * 64, hh, 512, true, b2h);
                bf16x8 pk[2][2]; softmax_step(S, Ow, negm, lw, pk); pv64(cur, vboff, pk, Ow); }
            if (s + 1 < 9) st_write(nxt, skey, sch, kr, vr);
            __syncthreads();
        }
    }
    unsigned owp[2][8];
#pragma unroll
    for (int db = 0; db < 2; ++db)
#pragma unroll
        for (int i = 0; i < 8; ++i) owp[db][i] = cvtpk(Ow[db][2 * i], Ow[db][2 * i + 1]);
    f32x16 Os[2]; float lsel = 0.f;
#pragma unroll
    for (int i = 0; i < 16; ++i) { Os[0][i] = 0.f; Os[1][i] = 0.f; }
    {   f32x16 negm;
#pragma unroll
        for (int i = 0; i < 16; ++i) negm[i] = 120.f;
        const GAS unsigned char* ksp = (const GAS unsigned char*)(proj + rowb * PLD + C_KS); const GAS unsigned char* vsp = (const GAS unsigned char*)(proj + rowb * PLD + C_VS);
        const unsigned soffp = (unsigned)(skey * PLD + sch * 8) * 2u;
        u32x4 kA, vA, kB, vB;
        st_load(ksp, vsp, soffp, kr, vr); st_write(lds, skey, sch, kr, vr);
        if (u >= 1) st_load(ksp, vsp, soffp + 64u * PLD * 2u, kA, vA);
        __syncthreads();
#define SEL_STEP(J, KX, VX, KY, VY) { const int j_ = (J); \
            const LAS unsigned char* cur = lds + (j_ & 1) * DBUF_BYTES; LAS unsigned char* nxt = lds + ((j_ + 1) & 1) * DBUF_BYTES; \
            if (j_ + 2 <= u) st_load(ksp, vsp, soffp + (unsigned)(j_ + 2) * (64u * PLD * 2u), KY, VY); \
            const int jb = j_ >> 5; const unsigned smw = jb == 0 ? sm0 : (jb == 1 ? sm1 : (jb == 2 ? sm2 : sm3)); \
            const bool bit = ((smw >> (j_ & 31)) & 1u) != 0u; \
            if (__builtin_amdgcn_ballot_w64(bit) != 0ull) { \
                f32x16 S[2]; qk64(cur, kboff, qf, negm, S); \
                if (64 * j_ + 63 > tw0 - 113) mask_bias(S, t, 64 * j_, hh, 1 << 30, bit, b2h); \
                else if (!bit) { _Pragma("unroll") for (int i = 0; i < 16; ++i) { S[0][i] = -1e30f; S[1][i] = -1e30f; } } \
                bf16x8 pk[2][2]; softmax_step(S, Os, negm, lsel, pk); pv64(cur, vboff, pk, Os); } \
            if (j_ + 1 <= u) st_write(nxt, skey, sch, KX, VX); \
            __syncthreads(); }
#pragma unroll 1
        for (int j = 0; j <= u; j += 2) {
            SEL_STEP(j, kA, vA, kB, vB)
            if (j + 1 <= u) SEL_STEP(j + 1, kB, vB, kA, vA)
        }
#undef SEL_STEP
    }
    {   const float lwt = lw + xshfl<32>(lw), lst = lsel + xshfl<32>(lsel);
        const GAS bf16* gp = proj + (rowb + t) * PLD + C_DG + head * 3;
        const float g0 = sigmoidf_(bf2f(gp[0])), g1 = sigmoidf_(bf2f(gp[1])) / fmaxf(lst, 1e-30f), g2 = sigmoidf_(bf2f(gp[2])) / fmaxf(lwt, 1e-30f);
        GAS bf16* op = ys + (rowb + t) * 1024 + 768 + head * 64;
#pragma unroll
        for (int db = 0; db < 2; ++db)
#pragma unroll
            for (int gq = 0; gq < 4; ++gq) { const int d0 = 32 * db + 8 * gq + 4 * hh; float y[4];
#pragma unroll
                for (int e = 0; e < 4; ++e) { const unsigned cw = ocp[db][2 * gq + (e >> 1)], ww = owp[db][2 * gq + (e >> 1)];
                    y[e] = g0 * ((e & 1) ? hi_bf(cw) : lo_bf(cw)) + g1 * Os[db][4 * gq + e] + g2 * ((e & 1) ? hi_bf(ww) : lo_bf(ww)); }
                u32x2 w; w.x = cvtpk(y[0], y[1]); w.y = cvtpk(y[2], y[3]); *(GAS u32x2*)(op + d0) = w; }
    }
}


DI void swa_unit(const GAS bf16* proj, GAS bf16* ys, LAS unsigned char* lds, const LAS float* bias2, const LAS float* biasd, const GAS float* sinks, int b, int u, int tid_in, int lane_in, int wave_in) {
    int tid = tid_in, lane = lane_in, wave = wave_in; asm volatile("" : "+v"(tid), "+v"(lane), "+s"(wave));
    const int t0 = u * 64; const int col = lane & 31, hh = lane >> 5, tl = col >> 1, kv = wave & 1, head = 2 * kv + (col & 1);
    const int t = t0 + (wave >> 1) * 16 + tl;
    const size_t rowb = (size_t)b * SEQ;
    const LAS float* b2h = bias2 + head;
    bf16x8 qf[4];
    { const float SC = 0.125f * 1.4426950408889634f; const GAS bf16* qp = proj + (rowb + t) * PLD + C_BQ + head * 64 + hh * 8;
#pragma unroll
      for (int s = 0; s < 4; ++s) { const u32x4 w = *(const GAS u32x4*)(qp + s * 16); u32x4 o;
          o.x = cvtpk(lo_bf(w.x) * SC, hi_bf(w.x) * SC); o.y = cvtpk(lo_bf(w.y) * SC, hi_bf(w.y) * SC); o.z = cvtpk(lo_bf(w.z) * SC, hi_bf(w.z) * SC); o.w = cvtpk(lo_bf(w.w) * SC, hi_bf(w.w) * SC);
          qf[s] = __builtin_bit_cast(bf16x8, o); } }
    const int skey = tid >> 3, sch = tid & 7;
    const int i16 = lane & 15, blk = (lane >> 4) & 1;
    const int kboff = kv * DBUF_BYTES + col * DK_STR + hh * 16;
    const int vboff = kv * DBUF_BYTES + 64 * DK_STR + (4 * hh + (i16 >> 2)) * DV_STR + (16 * blk + 4 * (i16 & 3)) * 2;
    const GAS unsigned char* kp = (const GAS unsigned char*)(proj + rowb * PLD + C_BK); const GAS unsigned char* vp = (const GAS unsigned char*)(proj + rowb * PLD + C_BV);
    const unsigned soffp = (unsigned)(skey * PLD + sch * 8) * 2u;
    u32x4 k0, v0, k1, v1;
    f32x16 O[2], negm; float lsum = 0.f;
#pragma unroll
    for (int i = 0; i < 16; ++i) { O[0][i] = 0.f; O[1][i] = 0.f; negm[i] = 120.f; }
    const int s0 = (u < 2) ? 2 - u : 0;
    { const unsigned so = soffp + (unsigned)(u - 2 + s0) * (64u * PLD * 2u); st_load(kp, vp, so, k0, v0); st_load(kp + 128, vp + 128, so, k1, v1);
      st_write(lds, skey, sch, k0, v0); st_write(lds + DBUF_BYTES, skey, sch, k1, v1); }
    __syncthreads();
#pragma unroll 1
    for (int s = s0; s < 3; ++s) {
        const int par = (s - s0) & 1; const LAS unsigned char* cur = lds + par * 2 * DBUF_BYTES; LAS unsigned char* nxt = lds + (par ^ 1) * 2 * DBUF_BYTES;
        if (s + 1 < 3) { const unsigned so = soffp + (unsigned)(u - 2 + s + 1) * (64u * PLD * 2u); st_load(kp, vp, so, k0, v0); st_load(kp + 128, vp + 128, so, k1, v1); }
        {   f32x16 S[2]; qk64(cur, kboff, qf, negm, S);
            mask_bias(S, t, (u - 2 + s) * 64, hh, 128, true, b2h);
            bf16x8 pk[2][2]; softmax_step(S, O, negm, lsum, pk); pv64(cur, vboff, pk, O); }
        if (s + 1 < 3) { st_write(nxt, skey, sch, k0, v0); st_write(nxt + DBUF_BYTES, skey, sch, k1, v1); }
        __syncthreads();
    }
    {   const float sinkp = (sinks[head] - biasd[128 * 12 + head]) * 1.4426950408889634f;
        const float lt = lsum + xshfl<32>(lsum) + __builtin_amdgcn_exp2f(sinkp + negm[0]);
        const float inv = 1.f / fmaxf(lt, 1e-30f);
        GAS bf16* op = ys + (rowb + t) * 1024 + 256 + head * 64;
#pragma unroll
        for (int db = 0; db < 2; ++db)
#pragma unroll
            for (int gq = 0; gq < 4; ++gq) { const int d0 = 32 * db + 8 * gq + 4 * hh;
                u32x2 w; w.x = cvtpk(O[db][4 * gq + 0] * inv, O[db][4 * gq + 1] * inv); w.y = cvtpk(O[db][4 * gq + 2] * inv, O[db][4 * gq + 3] * inv); *(GAS u32x2*)(op + d0) = w; }
    }
}

DI void route_rows4(const KA& a, int l, bf16* xr_, int tok0, int lane_) {
    int lane = lane_; asm volatile("" : "+v"(lane));
    const GAS float* xrow = (const GAS float*)a.out + (size_t)tok0 * 1024; const GAS float* g = (const GAS float*)(a.in[28] + (size_t)l * 1024); GAS bf16* xr = (GAS bf16*)xr_;
    f32x4 v[4][4]; float ss[4];
#pragma unroll
    for (int rr = 0; rr < 4; ++rr)
#pragma unroll
        for (int j = 0; j < 4; ++j) v[rr][j] = *(const GAS f32x4*)(xrow + (size_t)rr * 1024 + 4 * (lane + 64 * j));
#pragma unroll
    for (int rr = 0; rr < 4; ++rr) { float t = 0.f;
#pragma unroll
        for (int j = 0; j < 4; ++j) t += (v[rr][j][0] * v[rr][j][0] + v[rr][j][1] * v[rr][j][1]) + (v[rr][j][2] * v[rr][j][2] + v[rr][j][3] * v[rr][j][3]);
        ss[rr] = t; }
#pragma unroll
    for (int rr = 0; rr < 4; ++rr) ss[rr] = wave_sum(ss[rr]);
#pragma unroll
    for (int j = 0; j < 4; ++j) { const int k0 = 4 * (lane + 64 * j); const f32x4 gv = *(const GAS f32x4*)(g + k0);
#pragma unroll
        for (int rr = 0; rr < 4; ++rr) { const float r = 1.f / sqrtf(ss[rr] * (1.f / 1024.f) + 1e-6f); const f32x4 xn = v[rr][j] * r * gv;
            unsigned hi[4]; float lo[4];
#pragma unroll
            for (int e = 0; e < 4; ++e) { hi[e] = f2bf(xn[e]); lo[e] = xn[e] - __builtin_bit_cast(float, hi[e] << 16); }
            u32x2 wh, wl; wh.x = hi[0] | (hi[1] << 16); wh.y = hi[2] | (hi[3] << 16); wl.x = pk2(lo[0], lo[1]); wl.y = pk2(lo[2], lo[3]);
            *(GAS u32x2*)(xr + (size_t)(tok0 + rr) * 2048 + k0) = wh; *(GAS u32x2*)(xr + (size_t)(tok0 + rr) * 2048 + 1024 + k0) = wl; } }
}
struct SchedRoute { const char* A; const char* B; int pm;
    DI bool next(int i, Unit& u) const { if (i > 0) return false; u.pm = pm; u.pn = 0; u.aux = 0; u.pad = 0; u.a = A + (size_t)pm * 128 * 2048 * 2; u.b = B; return true; } };
struct EpiRoute { float* rlog;
    DI void operator()(const f32x4 (&acc)[2][2][4][2], const Unit& u, int wr, int wc, int fr, int fq) const {
        const int row0 = u.pm * 128 + wr * 64 + fr; const int col = wc * 32 + 8 * fq;
#pragma unroll
        for (int m = 0; m < 4; ++m) { float* rp = rlog + (size_t)(row0 + m * 16) * 128 + col; *(f32x4*)rp = acc[0][0][m][0]; *(f32x4*)(rp + 4) = acc[0][0][m][1]; }
    }
};
DI void route_decide(const KA& a, int l, const float* rl_row, int* rec_e, int* rec_slot, float* rec_w, unsigned* cnt, int tok) {
    float lg[36];
    const float* bg = a.in[30] + l * 4; const float* be = a.in[32] + l * 32;
#pragma unroll
    for (int q = 0; q < 9; ++q) { const f32x4 h = *(const f32x4*)(rl_row + 4 * q), lo = *(const f32x4*)(rl_row + 64 + 4 * q);
        lg[4 * q + 0] = h[0] + lo[0]; lg[4 * q + 1] = h[1] + lo[1]; lg[4 * q + 2] = h[2] + lo[2]; lg[4 * q + 3] = h[3] + lo[3]; }
#pragma unroll
    for (int i = 0; i < 4; ++i) lg[i] += bg[i];
#pragma unroll
    for (int i = 0; i < 32; ++i) lg[4 + i] += be[i];
    int gsel = 0; float gm = lg[0];
#pragma unroll
    for (int i = 1; i < 4; ++i) if (lg[i] > gm) { gm = lg[i]; gsel = i; }
    float gs = 0.f;
#pragma unroll
    for (int i = 0; i < 4; ++i) gs += __expf(lg[i] - gm);
    const float gwt = 1.f / gs;
    float v8[8];
#pragma unroll
    for (int i = 0; i < 8; ++i) { float x = lg[4 + i];
#pragma unroll
        for (int gq = 1; gq < 4; ++gq) x = (gsel == gq) ? lg[4 + gq * 8 + i] : x;
        v8[i] = x; }
    int i0 = 0; float m0 = v8[0];
#pragma unroll
    for (int i = 1; i < 8; ++i) if (v8[i] > m0) { m0 = v8[i]; i0 = i; }
    int i1 = -1; float m1 = -3e38f;
#pragma unroll
    for (int i = 0; i < 8; ++i) if (i != i0 && v8[i] > m1) { m1 = v8[i]; i1 = i; }
    const float w0 = 1.f / (1.f + __expf(m1 - m0)); const float w1 = 1.f - w0;
    const int e0 = gsel * 8 + i0, e1 = gsel * 8 + i1;
    const unsigned s0 = __hip_atomic_fetch_add(cnt + e0, 1u, __ATOMIC_RELAXED, __HIP_MEMORY_SCOPE_AGENT);
    const unsigned s1 = __hip_atomic_fetch_add(cnt + e1, 1u, __ATOMIC_RELAXED, __HIP_MEMORY_SCOPE_AGENT);
    rec_e[tok * 2] = e0; rec_e[tok * 2 + 1] = e1; rec_slot[tok * 2] = (int)s0; rec_slot[tok * 2 + 1] = (int)s1; rec_w[tok * 2] = w0 * gwt; rec_w[tok * 2 + 1] = w1 * gwt;
}
DI void expert_weights(const KA& a, int l, LAS unsigned char* lds, int it0, int it1, int gw, int NGW, int wave, int lane) {
    LAS float* scr = (LAS float*)(lds + wave * 16384);
    const float* wgt = a.in[33] + (size_t)l * 32 * 1024 * 256; const float* wup = a.in[34] + (size_t)l * 32 * 1024 * 256; const float* wdn = a.in[35] + (size_t)l * 32 * 256 * 1024;
    bf16* Wgu = (bf16*)(a.ws + WS_WGU); bf16* Wd = (bf16*)(a.ws + WS_WD);
    constexpr int I_E = 16 * 8, I_D = 4 * 32;
    constexpr int NIT = 32 * (2 * I_E + I_D);
    (void)NIT;
    for (int it = it0 + gw; it < it1; it += NGW) {
        const int e = it / (2 * I_E + I_D); int r = it % (2 * I_E + I_D);
        if (r < 2 * I_E) { const int up = r / I_E, q = r % I_E, kb = q / 8, nb = q % 8; const int n0 = nb * 32;
            const int drow = (n0 >> 7) * 256 + up * 128 + (n0 & 127);
            transpose_item((up ? wup : wgt) + (size_t)e * 1024 * 256, 256, 256, Wgu + (size_t)e * 512 * 1024, 1024, kb * 64, n0, drow, scr, lane);
        } else { r -= 2 * I_E; const int kb = r / 32, nb = r % 32;
            transpose_item(wdn + (size_t)e * 256 * 1024, 1024, 1024, Wd + (size_t)e * 1024 * 256, 256, kb * 64, nb * 32, nb * 32, scr, lane); }
    }
}
DI void build_offsets(const unsigned* cnt, LAS int* offt, int tid) {
    if (tid < 32) { const int c = (int)__hip_atomic_load(cnt + tid, __ATOMIC_RELAXED, __HIP_MEMORY_SCOPE_AGENT); offt[330 + tid] = (c + 255) & ~255; }
    __syncthreads();
    if (tid == 0) { int o = 0;
#pragma unroll
        for (int e = 0; e < 32; ++e) { offt[e] = o; o += offt[330 + e]; } offt[32] = o; }
    __syncthreads();
    for (int rt = tid; rt < (MOE_ROWS >> 8); rt += 512) { int e = 0; for (int j = 1; j < 32; ++j) e += (offt[j] <= rt * 256) ? 1 : 0; offt[40 + rt] = e; }
    __syncthreads();
}

template <unsigned PM>
__global__ void __launch_bounds__(512, 2) mk_fwd(Args a_) {
    extern __shared__ __attribute__((aligned(16))) unsigned char lds_raw[];
    LAS unsigned char* lds = (LAS unsigned char*)lds_raw;
    const int wave0 = __builtin_amdgcn_readfirstlane((int)threadIdx.x >> 6);
    if (threadIdx.x < 36) ((LAS unsigned long long*)(lds + PTAB_OFF))[threadIdx.x] = (unsigned long long)a_.in[threadIdx.x];
    __syncthreads();
    KA a; a.in.base = (unsigned)(size_t)(lds + PTAB_OFF); a.out = a_.out; a.ws = a_.ws;
    const int G = gridDim.x, bid = blockIdx.x, NGW = G * 8;
#define PHASE_IDS() int wave = wave0; asm volatile("" : "+s"(wave)); const int lane = my_lane(); const int tid_ = wave * 64 + lane, gw = bid * 8 + wave; (void)tid_; (void)gw; \
    KA ap = a; asm volatile("" : "+s"(ap.ws), "+s"(ap.out), "+s"(ap.in.base)); \
    bf16* hb = (bf16*)(ap.ws + WS_HB); bf16* proj = (bf16*)(ap.ws + WS_PROJ); bf16* gates = (bf16*)(ap.ws + WS_GATES); \
    bf16* ys = hb; bf16* x2b = hb; bf16* merged = proj; bf16* eo = proj; \
    bf16* kcb = (bf16*)(ap.ws + WS_KCVC); float* lrusum = (float*)(ap.ws + WS_LRUSUM); \
    int* rec_e = (int*)(ap.ws + WS_REC); int* rec_slot = rec_e + T * 2; float* rec_w = (float*)(rec_slot + T * 2); \
    int* rowtok = (int*)(ap.ws + WS_ROWTOK); float* roww = (float*)(ap.ws + WS_ROWW); \
    bf16* xs = (bf16*)(ap.ws + WS_XS); bf16* hmid = (bf16*)(ap.ws + WS_HMID); unsigned* ctl = (unsigned*)(ap.ws + WS_CTL); \
    (void)hb; (void)proj; (void)gates; (void)ys; (void)x2b; (void)merged; (void)eo; (void)kcb; (void)lrusum; (void)rec_e; (void)rec_slot; (void)rec_w; (void)rowtok; (void)roww; (void)xs; (void)hmid; (void)ctl
    volatile LAS unsigned* MISC = (volatile LAS unsigned*)(lds + MISC_OFF);
    LAS float* biasd = (LAS float*)(lds + BIAS_OFF);
    LAS int* offt = (LAS int*)(lds + OFFT_OFF);
    { PHASE_IDS();
    if (tid_ < 64) MISC[tid_] = 0u;
    for (int i = tid_; i < 129 * 12; i += 512) { const int d = i / 12, hd = i % 12; const int bk = d < 128 ? T5_BUCKET[d] : 31; const float* rb = a.in[1]; biasd[i] = rb[bk * 12 + hd]; ((LAS float*)(lds + BIAS2_OFF))[i] = (rb[bk * 12 + hd] - rb[31 * 12 + hd]) * 1.4426950408889634f; } }
    __syncthreads();
    const int lo = a_.ph_lo, hi = a_.ph_hi;
    XcdBarrier bar; bar.bar = (unsigned*)(a.ws + WS_CTL) + CW_BAR; bar.x = 0; bar.st = nullptr;
    if (hi - lo > 1) { PHASE_IDS(); bar = xcd_barrier_post(ctl + CW_BAR, MISC + 8, tid_ == 0); }
#ifndef SUB_MASK
#define SUB_MASK 0xFFu
#endif
#define SUB(k) ((SUB_MASK >> (k)) & 1u)
#define HASP(k) ((PM >> ((k) % PPL + ((k) >= 2 * PPL ? PPL : 0))) & 1u)
#define IN(k) (HASP(k) && lo <= (k) && (k) < hi)
#define SEAM(k) do { if ((k) + 1 < hi) { const int sl_ = my_lane(); int sw_ = wave0; asm volatile("" : "+s"(sw_)); xcd_barrier(bar, sw_ == 0 && sl_ == 0); } } while (0)
    for (int l = 0; l < DEPTH; ++l) {
        const int pb = l * PPL;
        if (IN(pb + 0)) { PHASE_IDS(); router_weights(ap, l, gw, NGW, lane); lru_weights(ap, l, gw, NGW, lane); cmp_weights(ap, l, lds, gw, NGW, wave, lane); phase0_weights(ap, l, lds, gw, NGW, wave, lane); phase0_rows(ap, l, 0, gw, NGW, lane); SEAM(pb + 0); }
        if (IN(pb + 1)) {
            PHASE_IDS();
            pg8::Gemm g{1024, 1024, 1024, 128, -1}; SchedP1 S{(const char*)hb, (const char*)(ap.ws + WS_WIN), G, bid};
            EpiP1 E{proj, gates, ap.in[25] + (size_t)l * 4096};
            pg8::gemm_phase<EpiP1, SchedP1>(lds, g, S, E, tid_); SEAM(pb + 1);
        }
        if (IN(pb + 2)) {
            PHASE_IDS();
            LAS float* lamp = (LAS float*)(lds + MISC_OFF + 64);
            if (tid_ < 64) { const float* q1 = ap.in[13] + l * 32; const float* k1 = ap.in[14] + l * 32; const float* q2 = ap.in[15] + l * 32; const float* k2 = ap.in[16] + l * 32;
                float s1 = (lane < 32) ? q1[lane] * k1[lane] : 0.f, s2 = (lane < 32) ? q2[lane] * k2[lane] : 0.f; s1 = wave_sum(s1); s2 = wave_sum(s2);
                const float lam_init = 0.8f - 0.6f * __expf(-0.3f * (float)l); if (lane == 0) { lamp[0] = __expf(s1) - __expf(s2) + lam_init; lamp[1] = lam_init; } }
            __syncthreads();
            if (SUB(0)) { const LAS float* bias2 = (const LAS float*)(lds + BIAS2_OFF); const GAS float* subg = (const GAS float*)(ap.in[17] + l * 64);
                for (int pi = bid; pi < 256; pi += G) { const int bh = pi >> 4, qlo = pi & 15;
                    diff_unit((const GAS bf16*)proj, (GAS bf16*)ys, lds, bias2, subg, lamp, bh >> 2, bh & 3, 31 - qlo, wave);
                    diff_unit((const GAS bf16*)proj, (GAS bf16*)ys, lds, bias2, subg, lamp, bh >> 2, bh & 3, qlo, wave); } }
            { PHASE_IDS();
            if (SUB(3)) { __syncthreads(); const LAS float* bias2 = (const LAS float*)(lds + BIAS2_OFF); const GAS float* sinks = (const GAS float*)(ap.in[12] + l * 4);
                for (int pi = bid; pi < 512; pi += G) swa_unit((const GAS bf16*)proj, (GAS bf16*)ys, lds, bias2, biasd, sinks, pi >> 7, pi & 127, tid_, lane, wave); }
            if (SUB(2)) { pg8::Gemm g{1024, 16 * PLD, 1024, PLD * 2, -1}; SchedCmp S{(const char*)proj, (const char*)(ap.ws + WS_WCMP), G, bid}; EpiCmp E{(float*)(ap.ws + WS_CMPAB)};
                pg8::gemm_phase<EpiCmp, SchedCmp>(lds, g, S, E, tid_); }
            if (SUB(1)) { __syncthreads(); for (int task = bid; task < 512; task += G) lru_unit(ap, l, (const GAS bf16*)proj, (GAS bf16*)ys, (GAS float*)lrusum, lds, task, lane, wave, false); }
            }
            SEAM(pb + 2);
        }
        if (IN(pb + 3)) {
            PHASE_IDS();
            for (int task = gw; task < 2 * BATCH * NCMP; task += NGW) cmp_finish(ap, l, (const float*)(ap.ws + WS_CMPAB), kcb, task, lane);
            __syncthreads();
            for (int task = bid; task < 512; task += G) lru_unit(ap, l, (const GAS bf16*)proj, (GAS bf16*)ys, (GAS float*)lrusum, lds, task, lane, wave, true);
            SEAM(pb + 3);
        }
        if (IN(pb + 4)) {
            PHASE_IDS();
            if (SUB(4)) { const LAS float* bias2 = (const LAS float*)(lds + BIAS2_OFF);
                for (int pi = bid; pi < 256; pi += G) { const int bb = pi >> 6, ulo = pi & 63;
                    nsa_unit((const GAS bf16*)proj, (GAS bf16*)ys, (const GAS bf16*)kcb, lds, bias2, bb, 127 - ulo, tid_, lane, wave);
                    nsa_unit((const GAS bf16*)proj, (GAS bf16*)ys, (const GAS bf16*)kcb, lds, bias2, bb, ulo, tid_, lane, wave); } }
            SEAM(pb + 4);
        }
        if (IN(pb + 5)) {
            PHASE_IDS();
            pg8::Gemm g{256, 1024, 256, 128, -1}; SchedP3a S{(const char*)ys, (const char*)(ap.ws + WS_WBR), G, bid};
            EpiP3a E{merged, gates};
            pg8::gemm_phase<EpiP3a, SchedP3a>(lds, g, S, E, tid_); SEAM(pb + 5);
        }
        if (IN(pb + 6)) {
            PHASE_IDS();
            pg8::Gemm g{1024, 1024, 1024, 128, -1}; SchedP3b S{(const char*)merged, (const char*)(ap.ws + WS_WOUT), G, bid};
            EpiP3b E{(l == 0) ? ap.in[0] : ap.out, ap.out};
            pg8::gemm_phase<EpiP3b, SchedP3b>(lds, g, S, E, tid_); SEAM(pb + 6);
        }
        if (IN(pb + 7)) {
            PHASE_IDS();
            bf16* xr = (bf16*)(ap.ws + WS_XR); float* rlog = (float*)(ap.ws + WS_RLOG);
            constexpr int NITW = 32 * (2 * 16 * 8 + 4 * 32);
            { const int pm = bid;
                for (int r = wave * 4; r < 128; r += 32) route_rows4(ap, l, xr, pm * 128 + r, lane);
                asm volatile("s_waitcnt vmcnt(0)" ::: "memory"); __syncthreads();
                { pg8::Gemm g{2048, 2048, 2048, 128, 0}; SchedRoute S{(const char*)xr, (const char*)(ap.ws + WS_WR), pm}; EpiRoute E{rlog};
                  pg8::gemm_phase<EpiRoute, SchedRoute>(lds, g, S, E, tid_); }
                asm volatile("s_waitcnt vmcnt(0)" ::: "memory"); __syncthreads();
                if (tid_ < 128) route_decide(ap, l, rlog + (size_t)(pm * 128 + tid_) * 128, rec_e, rec_slot, rec_w, ctl + CW_CNT + l * 32, pm * 128 + tid_);
                __syncthreads();
            }
            expert_weights(ap, l, lds, 0, NITW, gw, NGW, wave, lane);
            SEAM(pb + 7);
        }
        if (IN(pb + 8)) {
            PHASE_IDS();
            build_offsets(ctl + CW_CNT + l * 32, offt, tid_);
            if (bid < 32) { const int e = bid; const int c = (int)__hip_atomic_load(ctl + CW_CNT + l * 32 + e, __ATOMIC_RELAXED, __HIP_MEMORY_SCOPE_AGENT);
                for (int p = offt[e] + c + tid_; p < offt[e + 1]; p += 512) rowtok[p] = -1; }
            {   const GAS bf16* xr = (const GAS bf16*)(ap.ws + WS_XR); GAS bf16* xsg = (GAS bf16*)xs;
                for (int tok0 = gw * 4; tok0 < T; tok0 += NGW * 4) {
                    u32x4 v0[4], v1[4]; int pos[4][2];
#pragma unroll
                    for (int rr = 0; rr < 4; ++rr) { v0[rr] = *(const GAS u32x4*)(xr + (size_t)(tok0 + rr) * 2048 + lane * 8); v1[rr] = *(const GAS u32x4*)(xr + (size_t)(tok0 + rr) * 2048 + 512 + lane * 8);
#pragma unroll
                        for (int k = 0; k < 2; ++k) pos[rr][k] = offt[rec_e[(tok0 + rr) * 2 + k]] + rec_slot[(tok0 + rr) * 2 + k]; }
#pragma unroll
                    for (int rr = 0; rr < 4; ++rr)
#pragma unroll
                        for (int k = 0; k < 2; ++k) { const int p = pos[rr][k];
                            *(GAS u32x4*)(xsg + (size_t)p * 1024 + lane * 8) = v0[rr]; *(GAS u32x4*)(xsg + (size_t)p * 1024 + 512 + lane * 8) = v1[rr];
                            if (lane == 0) { rowtok[p] = (tok0 + rr) * 2 + k; roww[p] = rec_w[(tok0 + rr) * 2 + k]; } } } }
            SEAM(pb + 8);
        }
        if (IN(pb + 9)) {
            PHASE_IDS();
            build_offsets(ctl + CW_CNT + l * 32, offt, tid_);
            pg8::Gemm g{1024, 1024, 1024, 128, -1}; SchedM2 S{(const char*)xs, (const char*)(ap.ws + WS_WGU), offt, G, bid};
            EpiM2 E{hmid};
            pg8::gemm_phase<EpiM2, SchedM2>(lds, g, S, E, tid_); SEAM(pb + 9);
        }
        if (IN(pb + 10)) {
            PHASE_IDS();
            build_offsets(ctl + CW_CNT + l * 32, offt, tid_);
            pg8::Gemm g{256, 256, 256, 128, -1}; SchedM3 S{(const char*)hmid, (const char*)(ap.ws + WS_WD), offt, G, bid};
            EpiM3 E{eo, rowtok, roww};
            pg8::gemm_phase<EpiM3, SchedM3>(lds, g, S, E, tid_); SEAM(pb + 10);
        }
    }
    if (IN(2 * PPL)) { PHASE_IDS(); phase0_rows(ap, DEPTH, 1, gw, NGW, lane); }
#undef IN
#undef SEAM
}

typedef void (*kern_t)(Args);
template <unsigned PM> static bool setup_kernel() {
    if (hipFuncSetAttribute((const void*)mk_fwd<PM>, hipFuncAttributeMaxDynamicSharedMemorySize, LDS_BYTES) != hipSuccess) { fprintf(stderr, "kernel_launch: hipFuncSetAttribute failed\n"); return false; }
    return true;
}
extern "C" void kernel_launch(void* const* d_in, const int* in_sizes, int n_in, void* d_out, int out_size, void* d_ws, size_t ws_size, hipStream_t stream) {
    static int grid = 0;
    if (grid == 0) {
        if (n_in != 36 || out_size != T * D || ws_size < WS_END) { fprintf(stderr, "kernel_launch: unexpected shapes (n_in %d out %d ws %zu)\n", n_in, out_size, ws_size); grid = -1; return; }
        int dev = 0, cus = 0;
        if (hipGetDevice(&dev) != hipSuccess || hipDeviceGetAttribute(&cus, hipDeviceAttributeMultiprocessorCount, dev) != hipSuccess) { grid = -1; return; }
        bool ok = true;
#if MK_ONE_LAUNCH
        ok = setup_kernel<0xFFFu>();
#endif
        if (!ok) { grid = -1; return; }
        (void)hipGetLastError();
        grid = cus;
        if (grid != 256) { fprintf(stderr, "kernel_launch: built for a 256-CU device (got %d)\n", cus); grid = -1; return; }
    }
    if (grid < 0) return;
    if (hipMemsetAsync((char*)d_ws + WS_CTL, 0, CTL_ZERO_BYTES, stream) != hipSuccess) return;
    Args a{};
    for (int i = 0; i < 36; ++i) a.in[i] = (const float*)d_in[i];
    a.out = (float*)d_out; a.ws = (unsigned char*)d_ws;
#if MK_ONE_LAUNCH
    a.ph_lo = 0; a.ph_hi = NPH;
    hipLaunchKernelGGL(mk_fwd<0xFFFu>, dim3(grid), dim3(512), LDS_BYTES, stream, a);
#endif
}
```

```cpp
#include <hip/hip_runtime.h>
#include <cstdio>
#include <cstdint>

#ifndef MK_ONE_LAUNCH
#define MK_ONE_LAUNCH 1
#endif

#define DI __device__ __forceinline__
#define GAS __attribute__((address_space(1)))
#define LAS __attribute__((address_space(3)))
typedef unsigned short bf16;
typedef short bf16x8 __attribute__((ext_vector_type(8)));
typedef float f32x4 __attribute__((ext_vector_type(4)));
typedef unsigned u32x4 __attribute__((ext_vector_type(4)));
typedef unsigned u32x2 __attribute__((ext_vector_type(2)));
typedef float f32x16 __attribute__((ext_vector_type(16)));
typedef float f32x2 __attribute__((ext_vector_type(2)));
typedef short s16x4 __attribute__((ext_vector_type(4)));
typedef __bf16 bf16x2_t __attribute__((ext_vector_type(2)));
typedef short v4i16_t __attribute__((__vector_size__(4 * sizeof(short))));
#define MFMA32(a, b, c) __builtin_amdgcn_mfma_f32_32x32x16_bf16((a), (b), (c), 0, 0, 0)

constexpr int BATCH = 4, SEQ = 8192, T = BATCH * SEQ, D = 1024, DEPTH = 2;
constexpr int NIN = 2444, PLD = 2560, N1 = 6656, GLD = 4096;
constexpr int C_AX = 0, C_AG = 256, C_BQ = 512, C_BK = 768, C_BV = 896, C_CQ = 1024, C_CK = 1280, C_CV = 1536, C_DQ = 1792,
              C_KC = 2048, C_VC = 2112, C_KS = 2176, C_VS = 2240, C_KW = 2304, C_VW = 2368, C_DG = 2432;
constexpr int NCMP = 511;
constexpr int MOE_ROWS = 73728;
constexpr int PPL = 11;
constexpr int NPH = 2 * PPL + 1;

constexpr size_t MiB = 1u << 20;
constexpr size_t WS_CTL = 0, CTL_ZERO_BYTES = 1 * MiB;
constexpr size_t WS_KCVC = 1 * MiB;
constexpr size_t WS_LRUSUM = 2 * MiB;
constexpr size_t WS_REC = 2 * MiB + 256 * 1024;
constexpr size_t WS_ROWTOK = 3 * MiB;
constexpr size_t WS_ROWW = 3 * MiB + 512 * 1024;
constexpr size_t WS_WIN = 4 * MiB;
constexpr size_t WS_WBR = 17 * MiB;
constexpr size_t WS_WOUT = 19 * MiB;
constexpr size_t WS_HB = 21 * MiB;
constexpr size_t WS_PROJ = 85 * MiB;
constexpr size_t WS_GATES = 245 * MiB;
constexpr size_t WS_WGU = 245 * MiB;
constexpr size_t WS_WD = 277 * MiB;
constexpr size_t WS_XS = 293 * MiB;
constexpr size_t WS_HMID = 437 * MiB;
constexpr size_t WS_XR = 85 * MiB;
constexpr size_t WS_RLOG = 213 * MiB;
constexpr size_t WS_WR = 501 * MiB;
constexpr size_t WS_WCMP = 502 * MiB;
constexpr size_t WS_CMPAB = 503 * MiB;
constexpr size_t WS_LRUW = 505 * MiB + 65536;
constexpr size_t WS_END = 506 * MiB;
constexpr int CW_BAR = 4096;
constexpr int CW_CNT = 16384;

constexpr int RING_BYTES = 131072;
constexpr int MISC_OFF = RING_BYTES;
constexpr int BIAS_OFF = MISC_OFF + 256;
constexpr int OFFT_OFF = BIAS_OFF + 129 * 12 * 4;
constexpr int PTAB_OFF = OFFT_OFF + (40 + 288 + 40) * 4;
constexpr int BIAS2_OFF = PTAB_OFF + 36 * 8;
constexpr int LRUEX_OFF = BIAS2_OFF + 129 * 12 * 4;
constexpr int LDS_BYTES = 163840;
constexpr int LRUCST_OFF = LRUEX_OFF + 8 * 64 * 2 * 4;
constexpr int LRUCAR_OFF = LRUCST_OFF + 3 * 64 * 4;
static_assert(PTAB_OFF % 8 == 0 && LRUCAR_OFF + 8 * 64 * 4 <= LDS_BYTES, "LDS map");

DI float bf2f(bf16 v) { return __builtin_bit_cast(float, (unsigned)v << 16); }
DI float lo_bf(unsigned w) { return __builtin_bit_cast(float, w << 16); }
DI float hi_bf(unsigned w) { return __builtin_bit_cast(float, w & 0xffff0000u); }
DI unsigned f2bf(float f) { unsigned u = __builtin_bit_cast(unsigned, f); return (u + 0x7fffu + ((u >> 16) & 1u)) >> 16; }
DI unsigned pk2(float lo, float hi) { return f2bf(lo) | (f2bf(hi) << 16); }
DI float rl(float v, int i) { return __builtin_bit_cast(float, __builtin_amdgcn_readlane(__builtin_bit_cast(int, v), i)); }
DI int rli(int v, int i) { return __builtin_amdgcn_readlane(v, i); }
DI int my_lane() { int l; asm volatile("v_mbcnt_lo_u32_b32 %0, -1, 0\n\tv_mbcnt_hi_u32_b32 %0, -1, %0" : "=v"(l)); return l; }
template <int O> DI int xshfl_i(int v) {
    if constexpr (O < 32) return __builtin_amdgcn_ds_swizzle(v, (O << 10) | 0x1f);
    else { const int l = my_lane(); return __builtin_amdgcn_ds_bpermute((l ^ 32) << 2, v); }
}
template <int O> DI float xshfl(float v) { return __builtin_bit_cast(float, xshfl_i<O>(__builtin_bit_cast(int, v))); }
DI float wave_sum(float v) { v += xshfl<1>(v); v += xshfl<2>(v); v += xshfl<4>(v); v += xshfl<8>(v); v += xshfl<16>(v); v += xshfl<32>(v); return v; }
DI float wave_max(float v) { v = fmaxf(v, xshfl<1>(v)); v = fmaxf(v, xshfl<2>(v)); v = fmaxf(v, xshfl<4>(v)); v = fmaxf(v, xshfl<8>(v)); v = fmaxf(v, xshfl<16>(v)); v = fmaxf(v, xshfl<32>(v)); return v; }
DI float sigmoidf_(float x) { return __builtin_amdgcn_rcpf(1.f + __builtin_amdgcn_exp2f(-1.4426950408889634f * x)); }
DI float gelu_tanh(float x) { const float u = 0.7978845608028654f * (x + 0.044715f * x * x * x); const float e = __expf(2.f * u); const float th = 1.f - 2.f * __builtin_amdgcn_rcpf(e + 1.f); return 0.5f * x * (1.f + th); }
DI float softplusf_(float x) { return fmaxf(x, 0.f) + log1pf(__expf(-fabsf(x))); }
#define LDS_WAIT() asm volatile("s_waitcnt lgkmcnt(0)" ::: "memory")
#define VM_WAIT() asm volatile("s_waitcnt vmcnt(0)" ::: "memory")

__device__ const unsigned char T5_BUCKET[128] = {
0,1,2,3,4,5,6,7,8,9,10,11,12,13,14,15,16,16,16,17,17,18,18,18,19,19,19,20,20,20,20,21,21,21,21,22,22,22,22,22,23,23,23,23,23,23,24,24,24,24,24,24,25,25,25,25,25,25,25,26,26,26,26,26,26,26,26,27,27,27,27,27,27,27,27,27,27,28,28,28,28,28,28,28,28,28,28,29,29,29,29,29,29,29,29,29,29,29,29,30,30,30,30,30,30,30,30,30,30,30,30,30,30,31,31,31,31,31,31,31,31,31,31,31,31,31,31,31};

#define XB_TMO      128
#define XB_XCNT(j)  (256  + 64 * (j))
#define XB_XSUB(j)  (1280 + 64 * (j))
#define XB_XGEN(j)  (2304 + 64 * (j))
#define XB_TOP      3328
#define XB_TOPGEN   3392
#define XCD_BAR_WORDS 3456
#define XB_SPIN_CAP (1u << 22)
DI unsigned xb_ld(unsigned* p)              { return __hip_atomic_load(p, __ATOMIC_RELAXED, __HIP_MEMORY_SCOPE_AGENT); }
DI unsigned xb_add(unsigned* p, unsigned v) { return __hip_atomic_fetch_add(p, v, __ATOMIC_RELAXED, __HIP_MEMORY_SCOPE_AGENT); }
DI unsigned xb_xcc_id() { return (unsigned)__builtin_amdgcn_s_getreg((3 << 11) | 20) & 0xFu; }
#define XB_SPIN(cond, bar) do { unsigned _sp = 0; while (cond) { __builtin_amdgcn_s_sleep(1); \
    if ((++_sp & 255u) == 0u) { if (xb_ld(&(bar)[XB_TMO])) break; if (_sp > XB_SPIN_CAP) { atomicAdd(&(bar)[XB_TMO], 1u); break; } } } } while (0)
struct XcdBarrier { unsigned* bar; unsigned x; volatile LAS unsigned* st; };
DI XcdBarrier xcd_barrier_post(unsigned* bar, volatile LAS unsigned* st, bool leader) {
    XcdBarrier b; b.bar = bar; b.x = xb_xcc_id(); b.st = st;
    if (leader) (void)xb_add(&bar[XB_XCNT(b.x)], 1u);
    return b;
}
DI void xcd_barrier_complete(unsigned* bar, unsigned x, unsigned& nloc, unsigned& nx) {
    const unsigned G = gridDim.x * gridDim.y * gridDim.z;
    unsigned sum, cnt, mine, sp = 0u;
    for (;;) {
        sum = 0u; cnt = 0u; mine = 0u;
#pragma unroll
        for (unsigned j = 0; j < 16; ++j) { const unsigned c = xb_ld(&bar[XB_XCNT(j)]); sum += c; cnt += (c > 0u) ? 1u : 0u; mine = (j == x) ? c : mine; }
        if (sum == G) break;
        __builtin_amdgcn_s_sleep(1);
        if ((++sp & 255u) == 0u) { if (xb_ld(&bar[XB_TMO])) break; if (sp > XB_SPIN_CAP) { atomicAdd(&bar[XB_TMO], 1u); break; } }
    }
    nloc = mine > 0u ? mine : 1u; nx = cnt > 0u ? cnt : 1u;
}
DI void xcd_barrier(const XcdBarrier& b, bool leader) {
    asm volatile("s_waitcnt vmcnt(0)" ::: "memory");
    __syncthreads();
    if (leader) {
        unsigned* bar = b.bar;
        __builtin_amdgcn_s_waitcnt(0);
        unsigned nloc = b.st[0], nx = b.st[1];
        if (nloc == 0u) { xcd_barrier_complete(bar, b.x, nloc, nx); b.st[0] = nloc; b.st[1] = nx; }
        const unsigned old = xb_add(&bar[XB_XSUB(b.x)], 1u);
        const unsigned gen = old / nloc;
        if (old + 1u == (gen + 1u) * nloc) {
            __builtin_amdgcn_fence(__ATOMIC_RELEASE, "agent");
            asm volatile("s_waitcnt vmcnt(0)" ::: "memory");
            const unsigned og = xb_add(&bar[XB_TOP], 1u);
            const unsigned tg = og / nx;
            if (og + 1u == (tg + 1u) * nx) xb_add(&bar[XB_TOPGEN], 1u);
            else XB_SPIN(xb_ld(&bar[XB_TOPGEN]) == tg, bar);
            __builtin_amdgcn_fence(__ATOMIC_ACQUIRE, "agent");
            xb_add(&bar[XB_XGEN(b.x)], 1u);
            asm volatile("s_waitcnt vmcnt(0)" ::: "memory");
        } else {
            XB_SPIN(xb_ld(&bar[XB_XGEN(b.x)]) == gen, bar);
            __builtin_amdgcn_fence(__ATOMIC_ACQUIRE, "agent");
            asm volatile("s_waitcnt vmcnt(0)" ::: "memory");
        }
    }
    __syncthreads();
}

namespace pg8 {
constexpr int BM = 256, BK = 64, HALF = 128, HTB = HALF * BK * 2;
__host__ __device__ __forceinline__ int lds_byte(int r, int c) { const int st = (r >> 4) * 2 + (c >> 5), rr = r & 15, cc = c & 31, ob = rr * 64 + cc * 2; return st * 1024 + (ob ^ (((ob >> 9) & 1) << 5)); }
__host__ __device__ __forceinline__ void stage_rc(int b, int& R, int& C) { const int st = b / 1024, sb = b % 1024, swz = sb ^ (((sb >> 9) & 1) << 5); R = (st >> 1) * 16 + swz / 64; C = (st & 1) * 32 + (swz % 64) / 2; }
__host__ __device__ __forceinline__ int perm32(int rho) { const int n = rho >> 4, i = rho & 15; return 8 * (i >> 2) + 4 * n + (i & 3); }
struct Unit { const char* a; const char* b; int pm, pn, aux, pad; };
struct Gemm { int K, lda, ldb, kstepA, hstepA; };
template <class Epi, class Sched, bool GATHER = false>
DI void gemm_phase(LAS unsigned char* lds, const Gemm g, const Sched& S, const Epi& E, int tid_in) {
    int tid = tid_in; asm volatile("" : "+v"(tid));
    const int wid = __builtin_amdgcn_readfirstlane(tid >> 6), lane = tid & 63, wr = wid >> 2, wc = wid & 3, fr = lane & 15, fq = lane >> 4;
    const int K = g.K, nt = K / BK;
    unsigned voffA[2], voffB[2];
#pragma unroll
    for (int i = 0; i < 2; ++i) { int R, C; stage_rc(tid * 16 + i * 8192, R, C); const int Rb = (R & ~31) + perm32(R & 31);
        voffA[i] = (unsigned)(R * g.lda + C) * 2u; voffB[i] = (unsigned)(Rb * g.ldb + C) * 2u; }
    const size_t kstep = (size_t)(BK * 2), kstepA = (size_t)g.kstepA;
    const size_t hstepA = g.hstepA < 0 ? (size_t)HALF * g.lda * 2 : (size_t)g.hstepA, hstepB = (size_t)HALF * g.ldb * 2;
    const unsigned hstepA32 = (unsigned)hstepA;
    unsigned gC[2][2] = {{0u, 0u}, {0u, 0u}}, gN[2][2] = {{0u, 0u}, {0u, 0u}};
    const unsigned ldsw = (unsigned)wid * 1024u;
    const int aoff = lds_byte(wr * 64 + fr, fq * 8), boff = lds_byte(wc * 32 + fr, fq * 8);
#define PG8_SA(b, h) (((b) * 2 + (h)) * HTB)
#define PG8_SB(b, h) ((4 + (b) * 2 + (h)) * HTB)
#define PG8_STAGE(bufoff, gbase, voff) do { _Pragma("unroll") for (int _i = 0; _i < 2; ++_i) \
        __builtin_amdgcn_global_load_lds((const unsigned*)((const char*)(gbase) + (voff)[_i]), (LAS unsigned*)(lds + (bufoff) + ldsw + _i * 8192), 16, 0, 0); } while (0)
#define PG8_STAGEA(bufoff, gbase, h, nextsel) do { _Pragma("unroll") for (int _i = 0; _i < 2; ++_i) { \
        const unsigned _o = GATHER ? ((nextsel) ? gN[h][_i] : gC[h][_i]) : (voffA[_i] + (unsigned)(h) * hstepA32); \
        __builtin_amdgcn_global_load_lds((const unsigned*)((const char*)(gbase) + _o), (LAS unsigned*)(lds + (bufoff) + ldsw + _i * 8192), 16, 0, 0); } } while (0)
#define PG8_LDA(dst, b, h) do { _Pragma("unroll") for (int m = 0; m < 4; ++m) _Pragma("unroll") for (int k = 0; k < 2; ++k) dst[m][k] = *(const LAS bf16x8*)(lds + PG8_SA(b, h) + aoff + m * 2048 + k * 1024); } while (0)
#define PG8_LDB(dst, b, h) do { _Pragma("unroll") for (int n = 0; n < 2; ++n) _Pragma("unroll") for (int k = 0; k < 2; ++k) dst[n][k] = *(const LAS bf16x8*)(lds + PG8_SB(b, h) + boff + n * 2048 + k * 1024); } while (0)
#define PG8_MMA(ai, bj, At, Bt) do { __builtin_amdgcn_s_setprio(1); _Pragma("unroll") for (int m = 0; m < 4; ++m) _Pragma("unroll") for (int n = 0; n < 2; ++n) _Pragma("unroll") for (int k = 0; k < 2; ++k) \
        acc[ai][bj][m][n] = __builtin_amdgcn_mfma_f32_16x16x32_bf16(Bt[n][k], At[m][k], acc[ai][bj][m][n], 0, 0, 0); __builtin_amdgcn_s_setprio(0); } while (0)
#define PG8_WAIT_V(n) asm volatile("s_waitcnt vmcnt(" #n ")" ::: "memory")
#define PG8_WAIT_L(n) asm volatile("s_waitcnt lgkmcnt(" #n ")" ::: "memory")
#define PG8_BAR __builtin_amdgcn_s_barrier()
#define PG8_SCHED __builtin_amdgcn_sched_barrier(0)
    Unit cur, nxt; int ui = 0;
    if (!S.next(0, cur)) return;
    f32x4 acc[2][2][4][2];
#pragma unroll
    for (int a = 0; a < 2; ++a)
#pragma unroll
        for (int b = 0; b < 2; ++b)
#pragma unroll
            for (int m = 0; m < 4; ++m)
#pragma unroll
                for (int n = 0; n < 2; ++n) acc[a][b][m][n] = (f32x4){0.f, 0.f, 0.f, 0.f};
    bf16x8 At[4][2], B0[2][2], B1[2][2];
    const char* cA = cur.a; const char* cB = cur.b;
    if constexpr (GATHER) S.rows(cur, tid, gC);
    PG8_STAGE(PG8_SB(0, 0), cB, voffB); PG8_STAGE(PG8_SB(0, 1), cB + hstepB, voffB); PG8_STAGEA(PG8_SA(0, 0), cA, 0, false); PG8_STAGEA(PG8_SA(0, 1), cA, 1, false);
    if (wr == 1) PG8_BAR;
    PG8_WAIT_V(2); PG8_BAR;
    PG8_STAGE(PG8_SB(1, 0), cB + kstep, voffB); PG8_STAGEA(PG8_SA(1, 0), cA + kstepA, 0, false); PG8_STAGE(PG8_SB(1, 1), cB + hstepB + kstep, voffB);
    PG8_WAIT_V(6); PG8_BAR;
    for (;;) {
        const bool has_next = S.next(ui + 1, nxt);
        const char* nA = has_next ? nxt.a : cA; const char* nB = has_next ? nxt.b : cB;
        if constexpr (GATHER) { if (has_next) S.rows(nxt, tid, gN); else {
#pragma unroll
            for (int h = 0; h < 2; ++h) { gN[h][0] = gC[h][0]; gN[h][1] = gC[h][1]; } } }
        for (int t = 0; t < nt; t += 2) {
            const bool last = (t == nt - 2);
            const char* a1 = cA + (size_t)(t + 1) * kstepA;
            const char* a2 = last ? nA : cA + (size_t)(t + 2) * kstepA; const char* b2 = last ? nB : cB + (size_t)(t + 2) * kstep;
            const char* a3 = a2 + kstepA; const char* b3 = b2 + kstep;
            PG8_LDB(B0, 0, 0); PG8_LDB(B1, 0, 1); PG8_SCHED; PG8_LDA(At, 0, 0); PG8_STAGEA(PG8_SA(1, 1), a1, 1, false);
            PG8_WAIT_V(8); PG8_WAIT_L(0); PG8_BAR; PG8_MMA(0, 0, At, B0); PG8_MMA(0, 1, At, B1); PG8_BAR; PG8_SCHED;
            PG8_LDA(At, 0, 1); PG8_STAGE(PG8_SB(0, 0), b2, voffB); PG8_STAGE(PG8_SB(0, 1), b2 + hstepB, voffB); PG8_STAGEA(PG8_SA(0, 0), a2, 0, last);
            PG8_WAIT_V(8); PG8_WAIT_L(0); PG8_BAR; PG8_MMA(1, 0, At, B0); PG8_MMA(1, 1, At, B1); PG8_BAR; PG8_SCHED;
            PG8_LDB(B0, 1, 0); PG8_LDB(B1, 1, 1); PG8_SCHED; PG8_LDA(At, 1, 0); PG8_STAGEA(PG8_SA(0, 1), a2, 1, last);
            PG8_WAIT_V(8); PG8_WAIT_L(0); PG8_BAR; PG8_MMA(0, 0, At, B0); PG8_MMA(0, 1, At, B1); PG8_BAR; PG8_SCHED;
            PG8_LDA(At, 1, 1); PG8_STAGE(PG8_SB(1, 0), b3, voffB); PG8_STAGE(PG8_SB(1, 1), b3 + hstepB, voffB); PG8_STAGEA(PG8_SA(1, 0), a3, 0, last);
            PG8_WAIT_V(8); PG8_WAIT_L(0); PG8_BAR; PG8_MMA(1, 0, At, B0); PG8_MMA(1, 1, At, B1); PG8_BAR; PG8_SCHED;
        }
        if (wr == 0) PG8_BAR;
        { const int el = my_lane(); E(acc, cur, wr, wc, el & 15, el >> 4); }
        if (!has_next) break;
#pragma unroll
        for (int a = 0; a < 2; ++a)
#pragma unroll
            for (int b = 0; b < 2; ++b)
#pragma unroll
                for (int m = 0; m < 4; ++m)
#pragma unroll
                    for (int n = 0; n < 2; ++n) acc[a][b][m][n] = (f32x4){0.f, 0.f, 0.f, 0.f};
        cur = nxt; cA = nA; cB = nB; ++ui;
        if constexpr (GATHER) {
#pragma unroll
            for (int h = 0; h < 2; ++h) { gC[h][0] = gN[h][0]; gC[h][1] = gN[h][1]; } }
        if (wr == 1) PG8_BAR;
    }
    PG8_WAIT_V(0);
    PG8_BAR;
#undef PG8_SA
#undef PG8_SB
#undef PG8_STAGE
#undef PG8_STAGEA
#undef PG8_LDA
#undef PG8_LDB
#undef PG8_MMA
#undef PG8_WAIT_V
#undef PG8_WAIT_L
#undef PG8_BAR
#undef PG8_SCHED
}
}
using pg8::Unit;

DI unsigned cvt_pk_bf16(float lo, float hi) { unsigned r; asm volatile("s_nop 1\n\tv_cvt_pk_bf16_f32 %0, %1, %2" : "=v"(r) : "v"(lo), "v"(hi)); return r; }
DI u32x4 pack8(const f32x4& v0, const f32x4& v1) { u32x4 w; w.x = cvt_pk_bf16(v0[0], v0[1]); w.y = cvt_pk_bf16(v0[2], v0[3]); w.z = cvt_pk_bf16(v1[0], v1[1]); w.w = cvt_pk_bf16(v1[2], v1[3]); return w; }

struct SchedP1 {
    const char* A; const char* B; int G, c;
    DI bool next(int i, Unit& u) const {
        constexpr int nM = 128, nN = 26, nwg = nM * nN, NXCD = 8, WGM = 8;
        const long L = (long)i * G + c; if (L >= nwg) return false;
        int wgid = (int)L; { const int q = nwg / NXCD, r = nwg % NXCD, xcd = wgid % NXCD, off = wgid / NXCD; wgid = (xcd < r ? xcd * (q + 1) : r * (q + 1) + (xcd - r) * q) + off; }
        const int nig = WGM * nN, gid = wgid / nig, fm = gid * WGM, gsz = (nM - fm) < WGM ? (nM - fm) : WGM;
        u.pm = fm + ((wgid % nig) % gsz); u.pn = (wgid % nig) / gsz; u.aux = 0; u.pad = 0;
        u.a = A + (size_t)u.pm * 256 * 1024 * 2; u.b = B + (size_t)u.pn * 256 * 1024 * 2; return true;
    }
};
struct SchedP3a {
    const char* ys; const char* wbr; int G, c;
    DI bool next(int i, Unit& u) const {
        const int tile = (i >> 2) * G + c; if (tile >= 512) return false;
        const int br = i & 3; u.pm = tile >> 2; u.pn = tile & 3; u.aux = br; u.pad = 0;
        u.a = ys + ((size_t)u.pm * 256 * 1024 + br * 256) * 2; u.b = wbr + ((size_t)br * 1024 * 256 + (size_t)u.pn * 256 * 256) * 2; return true;
    }
};
struct SchedP3b {
    const char* A; const char* B; int G, c;
    DI bool next(int i, Unit& u) const {
        const int L = i * G + c; if (L >= 512) return false;
        u.pm = L >> 2; u.pn = L & 3; u.aux = 0; u.pad = 0;
        u.a = A + (size_t)u.pm * 256 * 1024 * 2; u.b = B + (size_t)u.pn * 256 * 1024 * 2; return true;
    }
};
struct SchedM2 {
    const char* xr; const char* wgu; const LAS int* offt; const int* rowsrc; int G, c;
    DI bool next(int i, Unit& u) const {
        const int NT = __builtin_amdgcn_readfirstlane(offt[32]) >> 8; const int L = i * G + c; if (L >= NT * 2) return false;
        const int rt = L >> 1, pn = L & 1; const int e = __builtin_amdgcn_readfirstlane(offt[40 + rt]);
        u.pm = rt; u.pn = pn; u.aux = e; u.pad = 0;
        u.a = xr; u.b = wgu + ((size_t)e * 512 + pn * 256) * 1024 * 2; return true;
    }
    DI void rows(const Unit& u, int tid, unsigned (&g)[2][2]) const {
#pragma unroll
        for (int i = 0; i < 2; ++i) { int R, C; pg8::stage_rc(tid * 16 + i * 8192, R, C);
#pragma unroll
            for (int h = 0; h < 2; ++h) g[h][i] = (unsigned)rowsrc[u.pm * 256 + h * 128 + R] * 4096u + (unsigned)C * 2u; }
    }
};
struct SchedM3 {
    const char* hmid; const char* wd; const LAS int* offt; int G, c;
    DI bool next(int i, Unit& u) const {
        const int NT = __builtin_amdgcn_readfirstlane(offt[32]) >> 8; const int L = i * G + c; if (L >= NT * 4) return false;
        const int rt = L >> 2, pn = L & 3; const int e = __builtin_amdgcn_readfirstlane(offt[40 + rt]);
        u.pm = rt; u.pn = pn; u.aux = e; u.pad = 0;
        u.a = hmid + (size_t)rt * 256 * 256 * 2; u.b = wd + ((size_t)e * 1024 + pn * 256) * 256 * 2; return true;
    }
};

struct EpiP1 {
    bf16* proj; bf16* gates; const float* bgate;
    DI void operator()(const f32x4 (&acc)[2][2][4][2], const Unit& u, int wr, int wc, int fr, int fq) const {
        const int row0 = u.pm * 256 + wr * 64 + fr; const int colt = u.pn * 256 + wc * 32 + 8 * fq;
        if (u.pn < 10) {
#pragma unroll
            for (int ai = 0; ai < 2; ++ai)
#pragma unroll
                for (int m = 0; m < 4; ++m) { bf16* rowp = proj + (size_t)(row0 + ai * 128 + m * 16) * PLD + colt;
#pragma unroll
                    for (int bj = 0; bj < 2; ++bj) *(u32x4*)(rowp + bj * 128) = pack8(acc[ai][bj][m][0], acc[ai][bj][m][1]); }
        } else {
            const int gcol = colt - 2560;
            f32x4 bv[2][2];
#pragma unroll
            for (int bj = 0; bj < 2; ++bj)
#pragma unroll
                for (int n = 0; n < 2; ++n) bv[bj][n] = *(const f32x4*)(bgate + gcol + bj * 128 + 4 * n);
#pragma unroll
            for (int ai = 0; ai < 2; ++ai)
#pragma unroll
                for (int m = 0; m < 4; ++m) { bf16* rowp = gates + (size_t)(row0 + ai * 128 + m * 16) * GLD + gcol;
#pragma unroll
                    for (int bj = 0; bj < 2; ++bj) { f32x4 v0 = acc[ai][bj][m][0] + bv[bj][0], v1 = acc[ai][bj][m][1] + bv[bj][1];
#pragma unroll
                        for (int e = 0; e < 4; ++e) { v0[e] = sigmoidf_(v0[e]); v1[e] = sigmoidf_(v1[e]); }
                        *(u32x4*)(rowp + bj * 128) = pack8(v0, v1); }
                    __builtin_amdgcn_sched_barrier(0); }
        }
    }
};
struct EpiP3a {
    bf16* merged; const bf16* gates;
    DI void operator()(const f32x4 (&acc)[2][2][4][2], const Unit& u, int wr, int wc, int fr, int fq) const {
        const int row0 = u.pm * 256 + wr * 64 + fr; const int colt = u.pn * 256 + wc * 32 + 8 * fq; const int br = u.aux;
#pragma unroll
        for (int ai = 0; ai < 2; ++ai)
#pragma unroll
            for (int m = 0; m < 4; ++m) { const size_t row = (size_t)(row0 + ai * 128 + m * 16);
#pragma unroll
                for (int bj = 0; bj < 2; ++bj) {
                    const u32x4 gw = *(const u32x4*)(gates + row * GLD + br * 1024 + colt + bj * 128);
                    bf16* mp = merged + row * 1024 + colt + bj * 128;
                    f32x4 v0 = acc[ai][bj][m][0], v1 = acc[ai][bj][m][1];
                    v0[0] *= lo_bf(gw.x); v0[1] *= hi_bf(gw.x); v0[2] *= lo_bf(gw.y); v0[3] *= hi_bf(gw.y);
                    v1[0] *= lo_bf(gw.z); v1[1] *= hi_bf(gw.z); v1[2] *= lo_bf(gw.w); v1[3] *= hi_bf(gw.w);
                    if (br != 0) { const u32x4 mw = *(const u32x4*)mp;
                        v0[0] += lo_bf(mw.x); v0[1] += hi_bf(mw.x); v0[2] += lo_bf(mw.y); v0[3] += hi_bf(mw.y);
                        v1[0] += lo_bf(mw.z); v1[1] += hi_bf(mw.z); v1[2] += lo_bf(mw.w); v1[3] += hi_bf(mw.w); }
                    *(u32x4*)mp = pack8(v0, v1); }
                __builtin_amdgcn_sched_barrier(0); }
    }
};
struct EpiP3b {
    const float* xin; float* out;
    DI void operator()(const f32x4 (&acc)[2][2][4][2], const Unit& u, int wr, int wc, int fr, int fq) const {
        const int row0 = u.pm * 256 + wr * 64 + fr; const int colt = u.pn * 256 + wc * 32 + 8 * fq;
#pragma unroll
        for (int ai = 0; ai < 2; ++ai)
#pragma unroll
            for (int m = 0; m < 4; ++m) { const size_t off = (size_t)(row0 + ai * 128 + m * 16) * 1024 + colt;
#pragma unroll
                for (int bj = 0; bj < 2; ++bj)
#pragma unroll
                    for (int n = 0; n < 2; ++n) { const f32x4 xv = *(const f32x4*)(xin + off + bj * 128 + 4 * n); *(f32x4*)(out + off + bj * 128 + 4 * n) = xv + acc[ai][bj][m][n]; }
                __builtin_amdgcn_sched_barrier(0); }
    }
};
struct EpiM2 {
    bf16* hmid;
    DI void operator()(const f32x4 (&acc)[2][2][4][2], const Unit& u, int wr, int wc, int fr, int fq) const {
        const int row0 = u.pm * 256 + wr * 64 + fr; const int col = u.pn * 128 + wc * 32 + 8 * fq;
#pragma unroll
        for (int ai = 0; ai < 2; ++ai)
#pragma unroll
            for (int m = 0; m < 4; ++m) { f32x4 h0, h1;
#pragma unroll
                for (int e = 0; e < 4; ++e) { const float g0 = acc[ai][0][m][0][e], g1 = acc[ai][0][m][1][e];
                    h0[e] = g0 * sigmoidf_(g0) * acc[ai][1][m][0][e]; h1[e] = g1 * sigmoidf_(g1) * acc[ai][1][m][1][e]; }
                *(u32x4*)(hmid + (size_t)(row0 + ai * 128 + m * 16) * 256 + col) = pack8(h0, h1); }
    }
};
struct EpiM3 {
    bf16* eo; const int* rowtok; const float* roww;
    DI void operator()(const f32x4 (&acc)[2][2][4][2], const Unit& u, int wr, int wc, int fr, int fq) const {
        const int row0 = u.pm * 256 + wr * 64 + fr; const int colt = u.pn * 256 + wc * 32 + 8 * fq;
#pragma unroll
        for (int ai = 0; ai < 2; ++ai)
#pragma unroll
            for (int m = 0; m < 4; ++m) { const int row = row0 + ai * 128 + m * 16; const int tk = rowtok[row];
                if (tk >= 0) { const float w = roww[row]; bf16* op = eo + (size_t)tk * 1024 + colt;
#pragma unroll
                    for (int bj = 0; bj < 2; ++bj) *(u32x4*)(op + bj * 128) = pack8(acc[ai][bj][m][0] * w, acc[ai][bj][m][1] * w); }
                __builtin_amdgcn_sched_barrier(0); }
    }
};

struct Args { const float* in[36]; float* out; unsigned char* ws; int ph_lo, ph_hi; };
struct InTab { unsigned base;
    DI const float* operator[](int i) const { unsigned long long v; const unsigned addr = base + (unsigned)i * 8u;
        asm volatile("ds_read_b64 %0, %1\n\ts_waitcnt lgkmcnt(0)" : "=v"(v) : "v"(addr) : "memory");
        const unsigned lo = __builtin_amdgcn_readfirstlane((unsigned)v), hi = __builtin_amdgcn_readfirstlane((unsigned)(v >> 32));
        return (const float*)(((unsigned long long)hi << 32) | lo); } };
struct KA { InTab in; float* out; unsigned char* ws; };

DI void transpose_item(const float* W_, int ldw, int nvalid, bf16* WT_, int ldt, int k0, int n0, int dst_row0, LAS float* scr, int lane) {
    const GAS float* W = (const GAS float*)W_; GAS bf16* WT = (GAS bf16*)WT_;
    const int nq = 4 * (lane & 7), kr8 = lane >> 3;
    f32x4 v[8];
#pragma unroll
    for (int i = 0; i < 8; ++i) { const int kk = 8 * i + kr8;
        if (n0 + nq + 3 < nvalid) v[i] = *(const GAS f32x4*)(W + (size_t)(k0 + kk) * ldw + n0 + nq);
        else {
#pragma unroll
            for (int e = 0; e < 4; ++e) v[i][e] = (n0 + nq + e < nvalid) ? W[(size_t)(k0 + kk) * ldw + n0 + nq + e] : 0.f; } }
#pragma unroll
    for (int i = 0; i < 8; ++i) { const int kk = 8 * i + kr8;
#pragma unroll
        for (int e = 0; e < 4; ++e) scr[kk * 33 + nq + e] = v[i][e]; }
    LDS_WAIT(); asm volatile("" ::: "memory");
    const int c = lane & 7;
#pragma unroll
    for (int j = 0; j < 4; ++j) { const int n = (lane >> 3) + 8 * j; const LAS float* s = scr + (8 * c) * 33 + n;
        u32x4 o; o.x = pk2(s[0 * 33], s[1 * 33]); o.y = pk2(s[2 * 33], s[3 * 33]); o.z = pk2(s[4 * 33], s[5 * 33]); o.w = pk2(s[6 * 33], s[7 * 33]);
        if (n0 + n < nvalid) *(GAS u32x4*)(WT + (size_t)(dst_row0 + n) * ldt + k0 + 8 * c) = o; }
    LDS_WAIT(); asm volatile("" ::: "memory");
}
DI void phase0_weights(const KA& a, int l, LAS unsigned char* lds, int gw, int NGW, int wave, int lane) {
    LAS float* scr = (LAS float*)(lds + wave * 16384);
    const float* w_in = a.in[4] + (size_t)l * 1024 * NIN;
    const float* w_gate = a.in[24] + (size_t)l * 4 * 1024 * 1024;
    const float* w_br = a.in[26] + (size_t)l * 4 * 256 * 1024;
    const float* w_out = a.in[27] + (size_t)l * 1024 * 1024;
    bf16* Wt_in = (bf16*)(a.ws + WS_WIN); bf16* Wt_br = (bf16*)(a.ws + WS_WBR); bf16* Wt_out = (bf16*)(a.ws + WS_WOUT);
    constexpr int I_IN = 16 * 77, I_G = 4 * 16 * 32, I_B = 4 * 4 * 32, I_O = 16 * 32, NIT = I_IN + I_G + I_B + I_O;
    for (int it = gw; it < NIT; it += NGW) {
        int r = it;
        if (r < I_IN) { const int kb = r / 77, nb = r % 77; transpose_item(w_in, NIN, NIN, Wt_in, 1024, kb * 64, nb * 32, nb * 32, scr, lane); continue; } r -= I_IN;
        if (r < I_G) { const int br = r / 512, q = r % 512, kb = q / 32, nb = q % 32; transpose_item(w_gate + (size_t)br * 1024 * 1024, 1024, 1024, Wt_in, 1024, kb * 64, nb * 32, 2560 + br * 1024 + nb * 32, scr, lane); continue; } r -= I_G;
        if (r < I_B) { const int br = r / 128, q = r % 128, kb = q / 32, nb = q % 32; transpose_item(w_br + (size_t)br * 256 * 1024, 1024, 1024, Wt_br + (size_t)br * 1024 * 256, 256, kb * 64, nb * 32, nb * 32, scr, lane); continue; } r -= I_B;
        { const int kb = r / 32, nb = r % 32; transpose_item(w_out, 1024, 1024, Wt_out, 1024, kb * 64, nb * 32, nb * 32, scr, lane); }
    }
}

DI void router_weights(const KA& a, int l, int gw, int NGW, int lane) {
    bf16* Wr = (bf16*)(a.ws + WS_WR);
    const float* wg = a.in[29] + (size_t)l * 1024 * 4; const float* we = a.in[31] + (size_t)l * 1024 * 32;
    for (int n = gw; n < 36; n += NGW) {
        for (int i = 0; i < 16; ++i) { const int k = lane + 64 * i; const float w = (n < 4) ? wg[k * 4 + n] : we[k * 32 + (n - 4)];
            const unsigned hi = f2bf(w); const float hf = __builtin_bit_cast(float, hi << 16); const unsigned lo = f2bf(w - hf);
            Wr[(size_t)n * 2048 + k] = (bf16)hi; Wr[(size_t)n * 2048 + 1024 + k] = (bf16)hi; Wr[(size_t)(64 + n) * 2048 + k] = (bf16)lo; Wr[(size_t)(64 + n) * 2048 + 1024 + k] = 0; }
    }
}

DI void cmp_weights(const KA& a, int l, LAS unsigned char* lds, int gw, int NGW, int wave, int lane) {
    LAS float* scr = (LAS float*)(lds + wave * 16384);
    bf16* Wc = (bf16*)(a.ws + WS_WCMP); float* pt = (float*)(a.ws + WS_CMPAB + 2 * MiB);
    for (int it = gw; it < 128 + 64; it += NGW) {
        if (it < 128) { const int kv = it >> 6, q = it & 63, kb = q >> 1, nb = q & 1; const float* w1 = a.in[kv ? 22 : 19] + (size_t)l * 2048 * 64;
            bf16* dst = Wc + (size_t)kv * 256 * 1024 - (kb >= 16 ? 1024 : 0);
            transpose_item(w1, 64, 64, dst, 1024, kb * 64, nb * 32, (kb >= 16 ? 64 : 0) + nb * 32, scr, lane);
        } else { const int kv = (it - 128) >> 5, part = (it - 128) & 31;
            const GAS float* w1 = (const GAS float*)(a.in[kv ? 22 : 19] + (size_t)l * 2048 * 64) + (size_t)part * 64 * 64; const GAS float* pos = (const GAS float*)(a.in[kv ? 21 : 18] + (size_t)l * 2048) + part * 64;
            float acc = 0.f;
#pragma unroll 16
            for (int k = 0; k < 64; ++k) acc += pos[k] * w1[(size_t)k * 64 + lane];
            pt[(kv * 32 + part) * 64 + lane] = acc; }
    }
}

DI void lru_weights(const KA& a, int l, int gw, int NGW, int lane) {
    bf16* W = (bf16*)(a.ws + WS_LRUW); const float* wa = a.in[7] + (size_t)l * 4 * 4096; const float* wx = a.in[9] + (size_t)l * 4 * 4096;
    (void)NGW; { const int idx = gw * 64 + lane; if (idx < 32768) { const int i = idx & 63, j = (idx >> 6) & 63, mat = (idx >> 12) & 1, hbk = idx >> 13;
        W[idx] = (bf16)f2bf((mat ? wx : wa)[(size_t)hbk * 4096 + i * 64 + j]); } }
}
DI void phase0_rows(const KA& a, int l, int mode, int gw, int NGW, int lane) {
    const GAS float* xin = (const GAS float*)((l == 0) ? a.in[0] : a.out);
    const GAS bf16* eo = (const GAS bf16*)(a.ws + WS_PROJ);
    GAS bf16* hb = (GAS bf16*)(a.ws + WS_HB); GAS float* outp = (GAS float*)a.out;
    const GAS float* g = (const GAS float*)(mode ? a.in[2] : (a.in[3] + (size_t)l * 1024));
    f32x4 gv[4];
#pragma unroll
    for (int j = 0; j < 4; ++j) gv[j] = *(const GAS f32x4*)(g + 4 * (lane + 64 * j));
    for (int m0 = gw * 4; m0 < T; m0 += NGW * 4) {
        f32x4 v[4][4]; float ss[4];
#pragma unroll
        for (int rr = 0; rr < 4; ++rr)
#pragma unroll
            for (int j = 0; j < 4; ++j) v[rr][j] = *(const GAS f32x4*)(xin + (size_t)(m0 + rr) * 1024 + 4 * (lane + 64 * j));
        if (l > 0) {
#pragma unroll
            for (int rr = 0; rr < 4; ++rr)
#pragma unroll
                for (int j = 0; j < 4; ++j) {
                    const u32x2 e0 = *(const GAS u32x2*)(eo + (size_t)(2 * (m0 + rr)) * 1024 + 4 * (lane + 64 * j));
                    const u32x2 e1 = *(const GAS u32x2*)(eo + (size_t)(2 * (m0 + rr) + 1) * 1024 + 4 * (lane + 64 * j));
                    v[rr][j][0] += lo_bf(e0.x) + lo_bf(e1.x); v[rr][j][1] += hi_bf(e0.x) + hi_bf(e1.x); v[rr][j][2] += lo_bf(e0.y) + lo_bf(e1.y); v[rr][j][3] += hi_bf(e0.y) + hi_bf(e1.y); } }
#pragma unroll
        for (int rr = 0; rr < 4; ++rr) { float t = 0.f;
#pragma unroll
            for (int j = 0; j < 4; ++j) t += (v[rr][j][0] * v[rr][j][0] + v[rr][j][1] * v[rr][j][1]) + (v[rr][j][2] * v[rr][j][2] + v[rr][j][3] * v[rr][j][3]);
            ss[rr] = t; }
#pragma unroll
        for (int rr = 0; rr < 4; ++rr) ss[rr] = wave_sum(ss[rr]);
#pragma unroll
        for (int rr = 0; rr < 4; ++rr) { const float r = 1.f / sqrtf(ss[rr] * (1.f / 1024.f) + 1e-6f); const size_t m = (size_t)(m0 + rr);
#pragma unroll
            for (int j = 0; j < 4; ++j) { const f32x4 y = v[rr][j] * r * gv[j];
                if (mode) *(GAS f32x4*)(outp + m * 1024 + 4 * (lane + 64 * j)) = y;
                else { if (l > 0) *(GAS f32x4*)(outp + m * 1024 + 4 * (lane + 64 * j)) = v[rr][j];
                       u32x2 w; w.x = pk2(y[0], y[1]); w.y = pk2(y[2], y[3]); *(GAS u32x2*)(hb + m * 1024 + 4 * (lane + 64 * j)) = w; } } }
    }
}

DI int crow(int i, int hh) { return (i & 3) + 8 * (i >> 2) + 4 * hh; }
DI unsigned cvtpk(float lo, float hi) { f32x2 v = {lo, hi}; bf16x2_t b = __builtin_convertvector(v, bf16x2_t); return __builtin_bit_cast(unsigned, b); }
template <int CTRL, int RMASK> DI float dppf(float oldv, float v) { return __builtin_bit_cast(float, __builtin_amdgcn_update_dpp(__builtin_bit_cast(int, oldv), __builtin_bit_cast(int, v), CTRL, RMASK, 0xf, false)); }
template <int CTRL, int RMASK> DI void scan_step(float& a, float& b) {
    const float ap = dppf<CTRL, RMASK>(1.f, a), bp = dppf<CTRL, RMASK>(0.f, b); b = a * bp + b; a = a * ap; }
DI void lru_unit(const KA& a, int l, const GAS bf16* proj, GAS bf16* ys, GAS float* sums, LAS unsigned char* lds, int task, int lane_in, int wave_in, bool final) {
    int lane = lane_in, wave = wave_in; asm volatile("" : "+v"(lane), "+s"(wave));
    const int chunk = task & 31, hbk = (task >> 5) & 3, b = task >> 7;
    const int ts = chunk * 256 + wave * 32; const size_t rowb = (size_t)b * SEQ;
    LAS unsigned char* wl = lds + wave * 16384;
    LAS float* ex = (LAS float*)(lds + LRUEX_OFF); LAS float* cst = (LAS float*)(lds + LRUCST_OFF); LAS float* car = (LAS float*)(lds + LRUCAR_OFF) + wave * 64;
    {
        const int c = hbk * 64 + lane;
        const GAS float* cw = (const GAS float*)(a.in[5] + (size_t)l * 4 * 256);
        const float cw0 = cw[c], cw1 = cw[256 + c], cw2 = cw[512 + c], cw3 = cw[768 + c]; const float cb = a.in[6][l * 256 + c];
        if (wave == 0) { cst[lane] = a.in[8][l * 256 + c]; cst[64 + lane] = a.in[10][l * 256 + c]; cst[128 + lane] = -8.f * softplusf_(-a.in[11][l * 256 + c]); }
        const GAS bf16* xp = proj + (rowb + ts) * PLD + C_AX + c;
        float x3 = (ts >= 3) ? bf2f(*(xp - 3 * PLD)) : 0.f, x2 = (ts >= 2) ? bf2f(*(xp - 2 * PLD)) : 0.f, x1 = (ts >= 1) ? bf2f(*(xp - PLD)) : 0.f;
#pragma unroll 8
        for (int n = 0; n < 32; ++n) { const float x0 = bf2f(xp[(size_t)n * PLD]); const float xc = cb + cw0 * x3 + cw1 * x2 + cw2 * x1 + cw3 * x0;
            *(LAS bf16*)(wl + n * 144 + lane * 2) = (bf16)f2bf(xc); *(LAS float*)(wl + 4608 + n * 272 + lane * 4) = xc; x3 = x2; x2 = x1; x1 = x0; }
    }
    const int n = lane & 31, hh = lane >> 5;
    f32x16 D[4];
    {
        const GAS bf16* wt = (const GAS bf16*)(a.ws + WS_LRUW) + (size_t)hbk * 8192;
        bf16x8 bfr[4];
        LDS_WAIT();
#pragma unroll
        for (int s4 = 0; s4 < 4; ++s4) bfr[s4] = *(const LAS bf16x8*)(wl + n * 144 + hh * 16 + s4 * 32);
#pragma unroll
        for (int m = 0; m < 4; ++m) {
#pragma unroll
            for (int s4 = 0; s4 < 4; ++s4) { const bf16x8 af = *(const GAS bf16x8*)(wt + (size_t)(m >> 1) * 4096 + (32 * (m & 1) + n) * 64 + 8 * hh + 16 * s4);
                if (s4 == 0) { f32x16 z;
#pragma unroll
                    for (int i = 0; i < 16; ++i) z[i] = 0.f;
                    D[m] = MFMA32(af, bfr[s4], z); } else D[m] = MFMA32(af, bfr[s4], D[m]); } }
    }
    __syncthreads();
    const bool t0 = (ts + n) == 0;
#pragma unroll
    for (int mm = 0; mm < 2; ++mm)
#pragma unroll
        for (int g4 = 0; g4 < 4; ++g4) { const int c0 = 32 * mm + 8 * g4 + 4 * hh;
            const f32x4 vba = *(const LAS f32x4*)(cst + c0), vbx = *(const LAS f32x4*)(cst + 64 + c0), vc8 = *(const LAS f32x4*)(cst + 128 + c0);
            const f32x4 vxc = *(const LAS f32x4*)(wl + 4608 + n * 272 + c0 * 4);
#pragma unroll
            for (int e = 0; e < 4; ++e) { const int i = 4 * g4 + e;
                const float r = sigmoidf_(D[mm][i] + vba[e]), ig = sigmoidf_(D[2 + mm][i] + vbx[e]);
                const float la = vc8[e] * r; const float av = __expf(la);
                const float mult = t0 ? 1.f : sqrtf(fmaxf(1.f - __expf(2.f * la), 0.f));
                float aa = av, bb = mult * ig * vxc[e];
                scan_step<0x111, 0xf>(aa, bb); scan_step<0x112, 0xf>(aa, bb); scan_step<0x114, 0xf>(aa, bb); scan_step<0x118, 0xf>(aa, bb); scan_step<0x142, 0xa>(aa, bb);
                D[mm][i] = aa; D[2 + mm][i] = bb; } }
    if (n == 31) {
#pragma unroll
        for (int mm = 0; mm < 2; ++mm)
#pragma unroll
            for (int i = 0; i < 16; ++i) { const int c = 32 * mm + crow(i, hh); ex[(wave * 64 + c) * 2] = D[mm][i]; ex[(wave * 64 + c) * 2 + 1] = D[2 + mm][i]; } }
    __syncthreads();
    if (!final) {
        if (wave == 0) { float hv = 0.f, av = 1.f;
#pragma unroll
            for (int w = 0; w < 8; ++w) { const float A_ = ex[(w * 64 + lane) * 2], H_ = ex[(w * 64 + lane) * 2 + 1]; hv = A_ * hv + H_; av *= A_; }
            GAS float* sp = sums + ((size_t)((b * 4 + hbk) * 32 + chunk) * 64 + lane) * 2; sp[0] = av; sp[1] = hv; }
    } else {
        {   float hv = 0.f;
            {   const GAS f32x2* sp = (const GAS f32x2*)(sums + ((size_t)((b * 4 + hbk) * 32) * 64 + lane) * 2);
                int cc = 0;
                for (; cc + 8 <= chunk; cc += 8) { f32x2 v[8];
#pragma unroll
                    for (int e = 0; e < 8; ++e) v[e] = sp[(size_t)(cc + e) * 64];
#pragma unroll
                    for (int e = 0; e < 8; ++e) hv = v[e][0] * hv + v[e][1]; }
                for (; cc < chunk; ++cc) { const f32x2 v = sp[(size_t)cc * 64]; hv = v[0] * hv + v[1]; } }
            for (int w = 0; w < wave; ++w) { const float A_ = ex[(w * 64 + lane) * 2], H_ = ex[(w * 64 + lane) * 2 + 1]; hv = A_ * hv + H_; }
            car[lane] = hv; }
        LDS_WAIT(); asm volatile("" ::: "memory");
        const GAS bf16* gp = proj + (rowb + ts + n) * PLD + C_AG + hbk * 64; GAS bf16* yp = ys + (rowb + ts + n) * 1024 + hbk * 64;
#pragma unroll
        for (int mm = 0; mm < 2; ++mm)
#pragma unroll
            for (int g4 = 0; g4 < 4; ++g4) { const int c0 = 32 * mm + 8 * g4 + 4 * hh; const f32x4 cv = *(const LAS f32x4*)(car + c0);
                const u32x2 gt2 = *(const GAS u32x2*)(gp + c0); float y[4];
#pragma unroll
                for (int e = 0; e < 4; ++e) { const int i = 4 * g4 + e; const float hv = D[2 + mm][i] + D[mm][i] * cv[e];
                    const float gt = (e == 0) ? lo_bf(gt2.x) : (e == 1) ? hi_bf(gt2.x) : (e == 2) ? lo_bf(gt2.y) : hi_bf(gt2.y); y[e] = hv * gelu_tanh(gt); }
                u32x2 yo; yo.x = cvtpk(y[0], y[1]); yo.y = cvtpk(y[2], y[3]); *(GAS u32x2*)(yp + c0) = yo; }
    }
    __syncthreads();
}

constexpr int DK_STR = 144, DV_STR = 192, DBUF_BYTES = 64 * DK_STR + 64 * DV_STR;
DI bf16x8 pack_half(const f32x16& x, int s2) { u32x4 p;
    if (s2 == 0) { p.x = cvtpk(x[0], x[1]); p.y = cvtpk(x[2], x[3]); p.z = cvtpk(x[4], x[5]); p.w = cvtpk(x[6], x[7]); }
    else { p.x = cvtpk(x[8], x[9]); p.y = cvtpk(x[10], x[11]); p.z = cvtpk(x[12], x[13]); p.w = cvtpk(x[14], x[15]); }
    return __builtin_bit_cast(bf16x8, p); }
DI s16x4 vtr(const LAS unsigned char* p) { return __builtin_bit_cast(s16x4, __builtin_amdgcn_ds_read_tr16_b64_v4i16((LAS v4i16_t*)p)); }
DI float max16(const f32x16& x) { float a = fmaxf(fmaxf(x[0], x[1]), fmaxf(x[2], x[3])), b = fmaxf(fmaxf(x[4], x[5]), fmaxf(x[6], x[7])), c = fmaxf(fmaxf(x[8], x[9]), fmaxf(x[10], x[11])), d = fmaxf(fmaxf(x[12], x[13]), fmaxf(x[14], x[15])); return fmaxf(fmaxf(a, b), fmaxf(c, d)); }
DI void diff_unit(const GAS bf16* proj, GAS bf16* ys, LAS unsigned char* lds, const LAS float* bias2, const GAS float* subg, const LAS float* lamp, int b, int h, int qb, int wave_in) {
    int wave = wave_in; asm volatile("" : "+s"(wave)); const int lane = my_lane(); const int tid = wave * 64 + lane;
    const int q0 = qb * 256 + wave * 32; const int ql = lane & 31, hh = lane >> 5; const int q = q0 + ql;
    const size_t rowb = (size_t)b * SEQ;
    const float SC = 0.17677669529663687f * 1.4426950408889634f;
    bf16x8 qf[2][2];
    { const GAS bf16* qp = proj + (rowb + q) * PLD + C_CQ + h * 64 + hh * 8;
#pragma unroll
      for (int m = 0; m < 2; ++m)
#pragma unroll
        for (int s = 0; s < 2; ++s) { const u32x4 w = *(const GAS u32x4*)(qp + m * 32 + s * 16); u32x4 o;
            o.x = cvtpk(lo_bf(w.x) * SC, hi_bf(w.x) * SC); o.y = cvtpk(lo_bf(w.y) * SC, hi_bf(w.y) * SC); o.z = cvtpk(lo_bf(w.z) * SC, hi_bf(w.z) * SC); o.w = cvtpk(lo_bf(w.w) * SC, hi_bf(w.w) * SC);
            qf[m][s] = __builtin_bit_cast(bf16x8, o); } }
    f32x16 O[2][2], negm[2];
#pragma unroll
    for (int i = 0; i < 16; ++i) { O[0][0][i] = 0.f; O[0][1][i] = 0.f; O[1][0][i] = 0.f; O[1][1][i] = 0.f; negm[0][i] = 120.f; negm[1][i] = 120.f; }
    float lsum[2] = {0.f, 0.f};
    const int nsteps = 4 * qb + 4, mysteps = 4 * qb + (wave >> 1) + 1;
    const int skey = tid >> 3, sch = tid & 7;
    const GAS unsigned char* kgb = (const GAS unsigned char*)(proj + rowb * PLD + C_CK + h * 64);
    const GAS unsigned char* vgb = (const GAS unsigned char*)(proj + rowb * PLD + C_CV + h * 64);
    const unsigned soff = (unsigned)(skey * PLD + sch * 8) * 2u;
    u32x4 kr = *(const GAS u32x4*)(kgb + soff), vr = *(const GAS u32x4*)(vgb + soff);
    *(LAS u32x4*)(lds + skey * DK_STR + sch * 16) = kr; *(LAS u32x4*)(lds + 64 * DK_STR + skey * DV_STR + sch * 16) = vr;
    __syncthreads();
    const int i16 = lane & 15, blk = (lane >> 4) & 1;
    const int kboff = ql * DK_STR + hh * 16;
    const int vboff = 64 * DK_STR + (4 * hh + (i16 >> 2)) * DV_STR + (16 * blk + 4 * (i16 & 3)) * 2;
#pragma unroll 1
    for (int kt = 0; kt < nsteps; ++kt) {
        const LAS unsigned char* cur = lds + (kt & 1) * DBUF_BYTES; LAS unsigned char* nxt = lds + ((kt + 1) & 1) * DBUF_BYTES;
        if (kt + 1 < nsteps) { const unsigned so = soff + (unsigned)(kt + 1) * (64u * PLD * 2u); kr = *(const GAS u32x4*)(kgb + so); vr = *(const GAS u32x4*)(vgb + so); }
        if (kt < mysteps) {
            const int kbase = kt * 64;
            const bool near = (q0 - (kbase + 63) < 113);
#pragma unroll
            for (int m = 0; m < 2; ++m) {
                bf16x8 pk[2][2];
                f32x16 S[2]; float ts = 0.f;
                {   bf16x8 kf[2][2];
#pragma unroll
                    for (int t = 0; t < 2; ++t)
#pragma unroll
                        for (int s = 0; s < 2; ++s) kf[t][s] = *(const LAS bf16x8*)(cur + kboff + t * 32 * DK_STR + m * 64 + s * 32);
#pragma unroll
                    for (int t = 0; t < 2; ++t) { S[t] = MFMA32(kf[t][0], qf[m][0], negm[m]); S[t] = MFMA32(kf[t][1], qf[m][1], S[t]); } }
                if (near) {
#pragma unroll
                    for (int t = 0; t < 2; ++t)
#pragma unroll
                        for (int i = 0; i < 16; ++i) { const int dist = q - (kbase + 32 * t + crow(i, hh)); const int di = dist < 128 ? dist : 128;
                            const float bv = dist >= 0 ? bias2[di * 12 + 4 + h] : -1e30f; S[t][i] += bv; } }
#pragma unroll
                for (int t = 0; t < 2; ++t)
#pragma unroll
                    for (int i = 0; i < 16; ++i) { const float p = __builtin_amdgcn_exp2f(S[t][i]); S[t][i] = p; ts += p; }
                if (__builtin_amdgcn_ballot_w64(!(ts < 1.0e30f)) != 0ull) {
                {   bf16x8 kf[2][2];
#pragma unroll
                        for (int t = 0; t < 2; ++t)
#pragma unroll
                            for (int s = 0; s < 2; ++s) kf[t][s] = *(const LAS bf16x8*)(cur + kboff + t * 32 * DK_STR + m * 64 + s * 32);
#pragma unroll
                        for (int t = 0; t < 2; ++t) { S[t] = MFMA32(kf[t][0], qf[m][0], negm[m]); S[t] = MFMA32(kf[t][1], qf[m][1], S[t]); } }
                    if (near) {
#pragma unroll
                        for (int t = 0; t < 2; ++t)
#pragma unroll
                            for (int i = 0; i < 16; ++i) { const int dist = q - (kbase + 32 * t + crow(i, hh)); const int di = dist < 128 ? dist : 128;
                                const float bv = dist >= 0 ? bias2[di * 12 + 4 + h] : -1e30f; S[t][i] += bv; } }
                    float tm = fmaxf(max16(S[0]), max16(S[1])); tm = fmaxf(tm, xshfl<32>(tm));
                    const float sh = fmaxf(tm, 0.f); const float al = __builtin_amdgcn_exp2f(-sh);
                    lsum[m] *= al; ts = 0.f;
#pragma unroll
                    for (int i = 0; i < 16; ++i) { O[m][0][i] *= al; O[m][1][i] *= al; negm[m][i] -= sh; }
#pragma unroll
                    for (int t = 0; t < 2; ++t)
#pragma unroll
                        for (int i = 0; i < 16; ++i) { const float p = __builtin_amdgcn_exp2f(S[t][i] - sh); S[t][i] = p; ts += p; }
                }
                lsum[m] += ts;
#pragma unroll
                for (int t = 0; t < 2; ++t) { pk[t][0] = pack_half(S[t], 0); pk[t][1] = pack_half(S[t], 1); }
#pragma unroll
                for (int t = 0; t < 2; ++t)
#pragma unroll
                    for (int s2 = 0; s2 < 2; ++s2)
#pragma unroll
                        for (int db = 0; db < 2; ++db) {
                            const s16x4 lo = vtr(cur + vboff + (32 * t + 16 * s2) * DV_STR + db * 64), hi = vtr(cur + vboff + (32 * t + 16 * s2 + 8) * DV_STR + db * 64);
                            const bf16x8 vf = __builtin_shufflevector(lo, hi, 0, 1, 2, 3, 4, 5, 6, 7);
                            O[m][db] = MFMA32(vf, pk[t][s2], O[m][db]); }
                ;
            }
        }
        if (kt + 1 < nsteps) { *(LAS u32x4*)(nxt + skey * DK_STR + sch * 16) = kr; *(LAS u32x4*)(nxt + 64 * DK_STR + skey * DV_STR + sch * 16) = vr; }
        __syncthreads();
    }
    const float l0 = lsum[0] + xshfl<32>(lsum[0]), l1 = lsum[1] + xshfl<32>(lsum[1]);
    const float lam = lamp[0], lam_init = lamp[1];
    const float i0 = 1.f / fmaxf(l0, 1e-30f), i1 = lam / fmaxf(l1, 1e-30f);
    float ss = 0.f;
#pragma unroll
    for (int db = 0; db < 2; ++db)
#pragma unroll
        for (int i = 0; i < 16; ++i) { const float at = O[0][db][i] * i0 - O[1][db][i] * i1; O[0][db][i] = at; ss += at * at; }
    ss += xshfl<32>(ss);
    const float r = (1.f - lam_init) / sqrtf(ss * (1.f / 64.f) + 1e-5f);
    GAS bf16* op = ys + (rowb + q) * 1024 + 512 + h * 64;
#pragma unroll
    for (int db = 0; db < 2; ++db)
#pragma unroll
        for (int gq = 0; gq < 4; ++gq) { const int d0 = 32 * db + 8 * gq + 4 * hh; const f32x4 sg = *(const GAS f32x4*)(subg + d0);
            u32x2 w; w.x = cvtpk(O[0][db][4 * gq + 0] * r * sg[0], O[0][db][4 * gq + 1] * r * sg[1]); w.y = cvtpk(O[0][db][4 * gq + 2] * r * sg[2], O[0][db][4 * gq + 3] * r * sg[3]);
            *(GAS u32x2*)(op + d0) = w; }
}

struct SchedCmp { const char* proj; const char* wc; int G, c;
    DI bool next(int i, Unit& u) const { const int L = i * G + c; if (L >= 16) return false; const int kv = L >> 3, rt = L & 7;
        u.pm = rt; u.pn = 0; u.aux = kv; u.pad = 0; u.a = proj + ((size_t)rt * 256 * 16 * PLD + (kv ? C_VC : C_KC)) * 2; u.b = wc + (size_t)kv * 256 * 1024 * 2; return true; } };
struct EpiCmp { float* ab;
    DI void operator()(const f32x4 (&acc)[2][2][4][2], const Unit& u, int wr, int wc, int fr, int fq) const {
        const int row0 = u.pm * 256 + wr * 64 + fr; const int col = wc * 32 + 8 * fq;
#pragma unroll
        for (int ai = 0; ai < 2; ++ai)
#pragma unroll
            for (int m = 0; m < 4; ++m) { float* rp = ab + ((size_t)u.aux * 2048 + row0 + ai * 128 + m * 16) * 128 + col; *(f32x4*)rp = acc[ai][0][m][0]; *(f32x4*)(rp + 4) = acc[ai][0][m][1]; }
    }
};
DI void cmp_finish(const KA& a, int l, const float* ab, bf16* kcb, int task, int lane) {
    const int kv = task / (BATCH * NCMP), r = task % (BATCH * NCMP), b = r / NCMP, c = r % NCMP;
    const float* w2 = a.in[kv ? 23 : 20] + (size_t)l * 4096; const float* pt = ab + 2 * 2048 * 128;
    const size_t g = (size_t)kv * 2048 + b * 512 + c;
    float ptv = 0.f;
#pragma unroll 8
    for (int part = 0; part < 32; ++part) ptv += pt[(kv * 32 + part) * 64 + lane];
    const float h1 = ab[g * 128 + lane] + ab[(g + 1) * 128 + 64 + lane] + ptv;
    const float gl = gelu_tanh(h1); float o = 0.f;
#pragma unroll
    for (int j = 0; j < 64; ++j) o += rl(gl, j) * w2[j * 64 + lane];
    kcb[((size_t)(kv * BATCH + b) * 512 + c) * 64 + lane] = (bf16)f2bf(o);
    if (c == NCMP - 1) kcb[((size_t)(kv * BATCH + b) * 512 + NCMP) * 64 + lane] = 0;
}

DI void st_load(const GAS unsigned char* kb, const GAS unsigned char* vb, unsigned off, u32x4& kr, u32x4& vr) { kr = *(const GAS u32x4*)(kb + off); vr = *(const GAS u32x4*)(vb + off); }
DI void st_write(LAS unsigned char* buf, int skey, int sch, const u32x4& kr, const u32x4& vr) { *(LAS u32x4*)(buf + skey * DK_STR + sch * 16) = kr; *(LAS u32x4*)(buf + 64 * DK_STR + skey * DV_STR + sch * 16) = vr; }
DI void qk64(const LAS unsigned char* cur, int kboff, const bf16x8 (&qf)[4], const f32x16& cinit, f32x16 (&S)[2]) {
#pragma unroll
    for (int t = 0; t < 2; ++t) { S[t] = cinit;
#pragma unroll
        for (int s = 0; s < 4; ++s) { const bf16x8 kf = *(const LAS bf16x8*)(cur + kboff + t * 32 * DK_STR + s * 32); S[t] = MFMA32(kf, qf[s], S[t]); } }
}
DI void qk32z(const LAS unsigned char* kt32, const bf16x8 (&qf)[4], f32x16& S) {
#pragma unroll
    for (int s = 0; s < 4; ++s) { const bf16x8 kf = *(const LAS bf16x8*)(kt32 + s * 32);
        if (s == 0) { f32x16 z;
#pragma unroll
            for (int i = 0; i < 16; ++i) z[i] = 0.f;
            S = MFMA32(kf, qf[s], z); } else S = MFMA32(kf, qf[s], S); }
}
DI void pv32(const LAS unsigned char* vt32, const bf16x8 (&pk)[2], f32x16 (&O)[2]) {
#pragma unroll
    for (int s2 = 0; s2 < 2; ++s2)
#pragma unroll
        for (int db = 0; db < 2; ++db) {
            const s16x4 lo = vtr(vt32 + (16 * s2) * DV_STR + db * 64), hi = vtr(vt32 + (16 * s2 + 8) * DV_STR + db * 64);
            const bf16x8 vf = __builtin_shufflevector(lo, hi, 0, 1, 2, 3, 4, 5, 6, 7);
            O[db] = MFMA32(vf, pk[s2], O[db]); }
}
DI void mask_bias_cmp32(f32x16& S, int tcol, int cbase, int hh, const LAS float* b2h, float msub) {
#pragma unroll
    for (int i = 0; i < 16; ++i) { const int c = cbase + crow(i, hh); const int dist = tcol - 31 - 16 * c; const bool ok = dist >= 0 && c < NCMP;
        const int di = dist < 0 ? 0 : (dist < 128 ? dist : 128); S[i] = ok ? S[i] + (b2h[di * 12] - msub) : -1e30f; }
}
DI void pv64(const LAS unsigned char* cur, int vboff, const bf16x8 (&pk)[2][2], f32x16 (&O)[2]) {
#pragma unroll
    for (int t = 0; t < 2; ++t)
#pragma unroll
        for (int s2 = 0; s2 < 2; ++s2)
#pragma unroll
            for (int db = 0; db < 2; ++db) {
                const s16x4 lo = vtr(cur + vboff + (32 * t + 16 * s2) * DV_STR + db * 64), hi = vtr(cur + vboff + (32 * t + 16 * s2 + 8) * DV_STR + db * 64);
                const bf16x8 vf = __builtin_shufflevector(lo, hi, 0, 1, 2, 3, 4, 5, 6, 7);
                O[db] = MFMA32(vf, pk[t][s2], O[db]); }
}
DI void softmax_step(f32x16 (&S)[2], f32x16 (&O)[2], f32x16& negm, float& lsum, bf16x8 (&pk)[2][2]) {
    float tm = fmaxf(max16(S[0]), max16(S[1]));
    if (__builtin_amdgcn_ballot_w64(tm > 8.f) != 0ull) {
        tm = fmaxf(tm, xshfl<32>(tm)); const float sh = fmaxf(tm, 0.f); const float al = __builtin_amdgcn_exp2f(-sh);
        lsum *= al;
#pragma unroll
        for (int i = 0; i < 16; ++i) { O[0][i] *= al; O[1][i] *= al; negm[i] -= sh; S[0][i] -= sh; S[1][i] -= sh; } }
#pragma unroll
    for (int t = 0; t < 2; ++t) {
#pragma unroll
        for (int i = 0; i < 16; ++i) { const float p = __builtin_amdgcn_exp2f(S[t][i]); S[t][i] = p; lsum += p; }
        pk[t][0] = pack_half(S[t], 0); pk[t][1] = pack_half(S[t], 1); }
}
DI void mask_bias(f32x16 (&S)[2], int tcol, int kbase, int hh, int W, bool colsel, const LAS float* b2h) {
#pragma unroll
    for (int t = 0; t < 2; ++t)
#pragma unroll
        for (int i = 0; i < 16; ++i) { const int dist = tcol - (kbase + 32 * t + crow(i, hh)); const bool ok = colsel && dist >= 0 && dist < W;
            const int di = dist < 0 ? 0 : (dist < 128 ? dist : 128); S[t][i] = ok ? S[t][i] + b2h[di * 12] : -1e30f; }
}
DI void nsa_unit(const GAS bf16* proj, GAS bf16* ys, const GAS bf16* kcb, LAS unsigned char* lds, const LAS float* bias2, int b, int u, int tid_in, int lane_in, int wave_in) {
    int tid = tid_in, lane = lane_in, wave = wave_in; asm volatile("" : "+v"(tid), "+v"(lane), "+s"(wave));
    const int t0 = u * 64; const int col = lane & 31, hh = lane >> 5, tl = col >> 2, head = col & 3;
    const int t = t0 + wave * 8 + tl; const int tw0 = t0 + wave * 8;
    const size_t rowb = (size_t)b * SEQ;
    const LAS float* b2h = bias2 + 8 + head;
    bf16x8 qf[4];
    { const float SC = 0.125f * 1.4426950408889634f; const GAS bf16* qp = proj + (rowb + t) * PLD + C_DQ + head * 64 + hh * 8;
#pragma unroll
      for (int s = 0; s < 4; ++s) { const u32x4 w = *(const GAS u32x4*)(qp + s * 16); u32x4 o;
          o.x = cvtpk(lo_bf(w.x) * SC, hi_bf(w.x) * SC); o.y = cvtpk(lo_bf(w.y) * SC, hi_bf(w.y) * SC); o.z = cvtpk(lo_bf(w.z) * SC, hi_bf(w.z) * SC); o.w = cvtpk(lo_bf(w.w) * SC, hi_bf(w.w) * SC);
          qf[s] = __builtin_bit_cast(bf16x8, o); } }
    const int skey = tid >> 3, sch = tid & 7;
    const int i16 = lane & 15, blk = (lane >> 4) & 1;
    const int kboff = col * DK_STR + hh * 16;
    const int vboff = 64 * DK_STR + (4 * hh + (i16 >> 2)) * DV_STR + (16 * blk + 4 * (i16 & 3)) * 2;
    u32x4 kr, vr;
    const int ncvm = (4 * u + 3) < NCMP ? (4 * u + 3) : NCMP;
    const int nsc = (ncvm + 63) >> 6;
    const GAS unsigned char* kcp = (const GAS unsigned char*)(kcb + (size_t)(0 * BATCH + b) * 512 * 64);
    const GAS unsigned char* vcp = (const GAS unsigned char*)(kcb + (size_t)(1 * BATCH + b) * 512 * 64);
    const unsigned soffc = (unsigned)(skey * 64 + sch * 8) * 2u;
    float m1 = -120.f, l1 = 0.f;
    st_load(kcp, vcp, soffc, kr, vr); st_write(lds, skey, sch, kr, vr); __syncthreads();
#pragma unroll 1
    for (int kt = 0; kt < nsc; ++kt) {
        const LAS unsigned char* cur = lds + (kt & 1) * DBUF_BYTES; LAS unsigned char* nxt = lds + ((kt + 1) & 1) * DBUF_BYTES;
        if (kt + 1 < nsc) st_load(kcp, vcp, soffc + (unsigned)(kt + 1) * 8192u, kr, vr);
#pragma unroll
        for (int tt = 0; tt < 2; ++tt) { f32x16 S; qk32z(cur + kboff + tt * 32 * DK_STR, qf, S); mask_bias_cmp32(S, t, kt * 64 + tt * 32, hh, b2h, 0.f);
          const float tm = max16(S); const float mn = fmaxf(m1, tm); float acc = 0.f;
#pragma unroll
          for (int i = 0; i < 16; ++i) acc += __builtin_amdgcn_exp2f(S[i] - mn);
          l1 = l1 * __builtin_amdgcn_exp2f(m1 - mn) + acc; m1 = mn; }
        if (kt + 1 < nsc) st_write(nxt, skey, sch, kr, vr);
        __syncthreads();
    }
    float mf, inv;
    { const float mo = xshfl<32>(m1), lo = xshfl<32>(l1); mf = fmaxf(m1, mo); const float lf = l1 * __builtin_amdgcn_exp2f(m1 - mf) + lo * __builtin_amdgcn_exp2f(mo - mf); inv = lf > 0.f ? 1.f / lf : 0.f; }
    f32x16 Oc[2], imp[4];
#pragma unroll
    for (int i = 0; i < 16; ++i) { Oc[0][i] = 0.f; Oc[1][i] = 0.f; imp[0][i] = 0.f; imp[1][i] = 0.f; imp[2][i] = 0.f; imp[3][i] = 0.f; }
    {   st_load(kcp, vcp, soffc, kr, vr); st_write(lds, skey, sch, kr, vr); __syncthreads();
#pragma unroll 1
        for (int kt = 0; kt < nsc; ++kt) {
            const LAS unsigned char* cur = lds + (kt & 1) * DBUF_BYTES; LAS unsigned char* nxt = lds + ((kt + 1) & 1) * DBUF_BYTES;
            if (kt + 1 < nsc) st_load(kcp, vcp, soffc + (unsigned)(kt + 1) * 8192u, kr, vr);
#pragma unroll
            for (int tt = 0; tt < 2; ++tt) {
                f32x16 S; qk32z(cur + kboff + tt * 32 * DK_STR, qf, S); mask_bias_cmp32(S, t, kt * 64 + tt * 32, hh, b2h, mf);
#pragma unroll
                for (int i = 0; i < 16; ++i) S[i] = __builtin_amdgcn_exp2f(S[i]) * inv;
                bf16x8 pk[2]; pk[0] = pack_half(S, 0); pk[1] = pack_half(S, 1);
                pv32(cur + vboff + tt * 32 * DV_STR, pk, Oc);
                const int Tq = (2 * kt + tt) & 3, MB = (2 * kt + tt) >> 2;
#pragma unroll
                for (int s2 = 0; s2 < 2; ++s2) { u32x4 aw; unsigned e[8];
#pragma unroll
                    for (int jj = 0; jj < 8; ++jj) { const int kk = 16 * s2 + 8 * (jj >> 2) + 4 * hh + (jj & 3); const int delta = 32 * Tq + kk - 4 * col;
                        e[jj] = (delta == -1 || delta == 3) ? 0x3F80u : ((unsigned)delta <= 2u ? 0x4000u : 0u); }
                    aw.x = e[0] | (e[1] << 16); aw.y = e[2] | (e[3] << 16); aw.z = e[4] | (e[5] << 16); aw.w = e[6] | (e[7] << 16);
                    const bf16x8 af = __builtin_bit_cast(bf16x8, aw);
                    if (MB == 0) imp[0] = MFMA32(af, pk[s2], imp[0]); else if (MB == 1) imp[1] = MFMA32(af, pk[s2], imp[1]); else if (MB == 2) imp[2] = MFMA32(af, pk[s2], imp[2]); else imp[3] = MFMA32(af, pk[s2], imp[3]); }
                if (Tq == 3 && MB < 3) { u32x4 aw; aw.x = 0u; aw.y = 0u; aw.z = 0u; aw.w = (lane == 32) ? 0x3F800000u : 0u;
                    const bf16x8 af = __builtin_bit_cast(bf16x8, aw);
                    if (MB == 0) imp[1] = MFMA32(af, pk[1], imp[1]); else if (MB == 1) imp[2] = MFMA32(af, pk[1], imp[2]); else imp[3] = MFMA32(af, pk[1], imp[3]); }
            }
            if (kt + 1 < nsc) st_write(nxt, skey, sch, kr, vr);
            __syncthreads();
        }
    }
    unsigned ocp[2][8];
#pragma unroll
    for (int db = 0; db < 2; ++db)
#pragma unroll
        for (int i = 0; i < 8; ++i) ocp[db][i] = cvtpk(Oc[db][2 * i], Oc[db][2 * i + 1]);
    unsigned sm0 = 0u, sm1 = 0u, sm2 = 0u, sm3 = 0u;
    {   const int cur_t = t >> 6; unsigned key[16];
#pragma unroll
        for (int i = 0; i < 16; ++i) {
            float v0 = imp[0][i], v1 = imp[1][i], v2 = imp[2][i], v3 = imp[3][i];
            v0 += xshfl<1>(v0); v0 += xshfl<2>(v0); v1 += xshfl<1>(v1); v1 += xshfl<2>(v1); v2 += xshfl<1>(v2); v2 += xshfl<2>(v2); v3 += xshfl<1>(v3); v3 += xshfl<2>(v3);
            const float val = head == 0 ? v0 : (head == 1 ? v1 : (head == 2 ? v2 : v3));
            const int j = 32 * head + crow(i, hh);
            const bool forced = (j == 0) || (j == cur_t) || (j == cur_t - 1);
            unsigned fx = (unsigned)(fminf(fmaxf(val, 0.f), 31.f) * 1048576.f) + 1u;
            fx = forced ? 0x1FFFFFFu : (j <= cur_t ? fx : 0u);
            key[i] = (fx << 7) | (unsigned)(127 - j); }
#pragma unroll 1
        for (int r = 0; r < 16; ++r) {
            unsigned w = key[0];
#pragma unroll
            for (int i = 1; i < 16; ++i) w = w > key[i] ? w : key[i];
            { unsigned o = (unsigned)xshfl_i<1>((int)w); w = w > o ? w : o; o = (unsigned)xshfl_i<2>((int)w); w = w > o ? w : o; o = (unsigned)xshfl_i<32>((int)w); w = w > o ? w : o; }
            if ((w >> 7) != 0u) { const int j = 127 - (int)(w & 127u); const unsigned bit = 1u << (j & 31); const int jb = j >> 5;
                sm0 |= (jb == 0) ? bit : 0u; sm1 |= (jb == 1) ? bit : 0u; sm2 |= (jb == 2) ? bit : 0u; sm3 |= (jb == 3) ? bit : 0u; }
#pragma unroll
            for (int i = 0; i < 16; ++i) key[i] = (key[i] == w) ? 0u : key[i];
        }
    }
    f32x16 Ow[2]; float lw = 0.f;
#pragma unroll
    for (int i = 0; i < 16; ++i) { Ow[0][i] = 0.f; Ow[1][i] = 0.f; }
    {   f32x16 negm;
#pragma unroll
        for (int i = 0; i < 16; ++i) negm[i] = 120.f;
        const GAS unsigned char* kwp = (const GAS unsigned char*)(proj + rowb * PLD + C_KW); const GAS unsigned char* vwp = (const GAS unsigned char*)(proj + rowb * PLD + C_VW);
        const unsigned soffp = (unsigned)(skey * PLD + sch * 8) * 2u;
        const int s0 = (u < 8) ? 8 - u : 0;
        st_load(kwp, vwp, soffp + (unsigned)(u - 8 + s0) * (64u * PLD * 2u), kr, vr); st_write(lds, skey, sch, kr, vr); __syncthreads();
#pragma unroll 1
        for (int s = s0; s < 9; ++s) {
            const int par = (s - s0) & 1; const LAS unsigned char* cur = lds + par * DBUF_BYTES; LAS unsigned char* nxt = lds + (par ^ 1) * DBUF_BYTES;
            if (s + 1 < 9) st_load(kwp, vwp, soffp + (unsigned)(u - 8 + s + 1) * (64u * PLD * 2u), kr, vr);
            {   f32x16 S[2]; qk64(cur, kboff, qf, negm, S);
                if (s == 0 || s >= 6) mask_bias(S, t, (u - 8 + s) * 64, hh, 512, true, b2h);
                bf16x8 pk[2][2]; softmax_step(S, Ow, negm, lw, pk); pv64(cur, vboff, pk, Ow); }
            if (s + 1 < 9) st_write(nxt, skey, sch, kr, vr);
            __syncthreads();
        }
    }
    unsigned owp[2][8];
#pragma unroll
    for (int db = 0; db < 2; ++db)
#pragma unroll
        for (int i = 0; i < 8; ++i) owp[db][i] = cvtpk(Ow[db][2 * i], Ow[db][2 * i + 1]);
    f32x16 Os[2]; float lsel = 0.f;
#pragma unroll
    for (int i = 0; i < 16; ++i) { Os[0][i] = 0.f; Os[1][i] = 0.f; }
    {   f32x16 negm;
#pragma unroll
        for (int i = 0; i < 16; ++i) negm[i] = 120.f;
        const GAS unsigned char* ksp = (const GAS unsigned char*)(proj + rowb * PLD + C_KS); const GAS unsigned char* vsp = (const GAS unsigned char*)(proj + rowb * PLD + C_VS);
        const unsigned soffp = (unsigned)(skey * PLD + sch * 8) * 2u;
        u32x4 kA, vA, kB, vB;
        st_load(ksp, vsp, soffp, kr, vr); st_write(lds, skey, sch, kr, vr);
        if (u >= 1) st_load(ksp, vsp, soffp + 64u * PLD * 2u, kA, vA);
        __syncthreads();
#define SEL_STEP(J, KX, VX, KY, VY) { const int j_ = (J); \
            const LAS unsigned char* cur = lds + (j_ & 1) * DBUF_BYTES; LAS unsigned char* nxt = lds + ((j_ + 1) & 1) * DBUF_BYTES; \
            if (j_ + 2 <= u) st_load(ksp, vsp, soffp + (unsigned)(j_ + 2) * (64u * PLD * 2u), KY, VY); \
            const int jb = j_ >> 5; const unsigned smw = jb == 0 ? sm0 : (jb == 1 ? sm1 : (jb == 2 ? sm2 : sm3)); \
            const bool bit = ((smw >> (j_ & 31)) & 1u) != 0u; \
            if (__builtin_amdgcn_ballot_w64(bit) != 0ull) { \
                f32x16 S[2]; qk64(cur, kboff, qf, negm, S); \
                if (64 * j_ + 63 > tw0 - 113) mask_bias(S, t, 64 * j_, hh, 1 << 30, bit, b2h); \
                else if (!bit) { _Pragma("unroll") for (int i = 0; i < 16; ++i) { S[0][i] = -1e30f; S[1][i] = -1e30f; } } \
                bf16x8 pk[2][2]; softmax_step(S, Os, negm, lsel, pk); pv64(cur, vboff, pk, Os); } \
            if (j_ + 1 <= u) st_write(nxt, skey, sch, KX, VX); \
            __syncthreads(); }
#pragma unroll 1
        for (int j = 0; j <= u; j += 2) {
            SEL_STEP(j, kA, vA, kB, vB)
            if (j + 1 <= u) SEL_STEP(j + 1, kB, vB, kA, vA)
        }
#undef SEL_STEP
    }
    {   const float lwt = lw + xshfl<32>(lw), lst = lsel + xshfl<32>(lsel);
        const GAS bf16* gp = proj + (rowb + t) * PLD + C_DG + head * 3;
        const float g0 = sigmoidf_(bf2f(gp[0])), g1 = sigmoidf_(bf2f(gp[1])) / fmaxf(lst, 1e-30f), g2 = sigmoidf_(bf2f(gp[2])) / fmaxf(lwt, 1e-30f);
        GAS bf16* op = ys + (rowb + t) * 1024 + 768 + head * 64;
#pragma unroll
        for (int db = 0; db < 2; ++db)
#pragma unroll
            for (int gq = 0; gq < 4; ++gq) { const int d0 = 32 * db + 8 * gq + 4 * hh; float y[4];
#pragma unroll
                for (int e = 0; e < 4; ++e) { const unsigned cw = ocp[db][2 * gq + (e >> 1)], ww = owp[db][2 * gq + (e >> 1)];
                    y[e] = g0 * ((e & 1) ? hi_bf(cw) : lo_bf(cw)) + g1 * Os[db][4 * gq + e] + g2 * ((e & 1) ? hi_bf(ww) : lo_bf(ww)); }
                u32x2 w; w.x = cvtpk(y[0], y[1]); w.y = cvtpk(y[2], y[3]); *(GAS u32x2*)(op + d0) = w; }
    }
}


DI void swa_unit(const GAS bf16* proj, GAS bf16* ys, LAS unsigned char* lds, const LAS float* bias2, const LAS float* biasd, const GAS float* sinks, int b, int u, int tid_in, int lane_in, int wave_in) {
    int tid = tid_in, lane = lane_in, wave = wave_in; asm volatile("" : "+v"(tid), "+v"(lane), "+s"(wave));
    const int t0 = u * 64; const int col = lane & 31, hh = lane >> 5, tl = col >> 1, kv = wave & 1, head = 2 * kv + (col & 1);
    const int t = t0 + (wave >> 1) * 16 + tl;
    const size_t rowb = (size_t)b * SEQ;
    const LAS float* b2h = bias2 + head;
    bf16x8 qf[4];
    { const float SC = 0.125f * 1.4426950408889634f; const GAS bf16* qp = proj + (rowb + t) * PLD + C_BQ + head * 64 + hh * 8;
#pragma unroll
      for (int s = 0; s < 4; ++s) { const u32x4 w = *(const GAS u32x4*)(qp + s * 16); u32x4 o;
          o.x = cvtpk(lo_bf(w.x) * SC, hi_bf(w.x) * SC); o.y = cvtpk(lo_bf(w.y) * SC, hi_bf(w.y) * SC); o.z = cvtpk(lo_bf(w.z) * SC, hi_bf(w.z) * SC); o.w = cvtpk(lo_bf(w.w) * SC, hi_bf(w.w) * SC);
          qf[s] = __builtin_bit_cast(bf16x8, o); } }
    const int skey = tid >> 3, sch = tid & 7;
    const int i16 = lane & 15, blk = (lane >> 4) & 1;
    const int kboff = kv * DBUF_BYTES + col * DK_STR + hh * 16;
    const int vboff = kv * DBUF_BYTES + 64 * DK_STR + (4 * hh + (i16 >> 2)) * DV_STR + (16 * blk + 4 * (i16 & 3)) * 2;
    const GAS unsigned char* kp = (const GAS unsigned char*)(proj + rowb * PLD + C_BK); const GAS unsigned char* vp = (const GAS unsigned char*)(proj + rowb * PLD + C_BV);
    const unsigned soffp = (unsigned)(skey * PLD + sch * 8) * 2u;
    u32x4 k0, v0, k1, v1;
    f32x16 O[2], negm; float lsum = 0.f;
#pragma unroll
    for (int i = 0; i < 16; ++i) { O[0][i] = 0.f; O[1][i] = 0.f; negm[i] = 120.f; }
    const int s0 = (u < 2) ? 2 - u : 0;
    { const unsigned so = soffp + (unsigned)(u - 2 + s0) * (64u * PLD * 2u); st_load(kp, vp, so, k0, v0); st_load(kp + 128, vp + 128, so, k1, v1);
      st_write(lds, skey, sch, k0, v0); st_write(lds + DBUF_BYTES, skey, sch, k1, v1); }
    __syncthreads();
#pragma unroll 1
    for (int s = s0; s < 3; ++s) {
        const int par = (s - s0) & 1; const LAS unsigned char* cur = lds + par * 2 * DBUF_BYTES; LAS unsigned char* nxt = lds + (par ^ 1) * 2 * DBUF_BYTES;
        if (s + 1 < 3) { const unsigned so = soffp + (unsigned)(u - 2 + s + 1) * (64u * PLD * 2u); st_load(kp, vp, so, k0, v0); st_load(kp + 128, vp + 128, so, k1, v1); }
        {   f32x16 S[2]; qk64(cur, kboff, qf, negm, S);
            mask_bias(S, t, (u - 2 + s) * 64, hh, 128, true, b2h);
            bf16x8 pk[2][2]; softmax_step(S, O, negm, lsum, pk); pv64(cur, vboff, pk, O); }
        if (s + 1 < 3) { st_write(nxt, skey, sch, k0, v0); st_write(nxt + DBUF_BYTES, skey, sch, k1, v1); }
        __syncthreads();
    }
    {   const float sinkp = (sinks[head] - biasd[128 * 12 + head]) * 1.4426950408889634f;
        const float lt = lsum + xshfl<32>(lsum) + __builtin_amdgcn_exp2f(sinkp + negm[0]);
        const float inv = 1.f / fmaxf(lt, 1e-30f);
        GAS bf16* op = ys + (rowb + t) * 1024 + 256 + head * 64;
#pragma unroll
        for (int db = 0; db < 2; ++db)
#pragma unroll
            for (int gq = 0; gq < 4; ++gq) { const int d0 = 32 * db + 8 * gq + 4 * hh;
                u32x2 w; w.x = cvtpk(O[db][4 * gq + 0] * inv, O[db][4 * gq + 1] * inv); w.y = cvtpk(O[db][4 * gq + 2] * inv, O[db][4 * gq + 3] * inv); *(GAS u32x2*)(op + d0) = w; }
    }
}

DI void route_rows4(const KA& a, int l, bf16* xr_, int tok0, int lane_) {
    int lane = lane_; asm volatile("" : "+v"(lane));
    const GAS float* xrow = (const GAS float*)a.out + (size_t)tok0 * 1024; const GAS float* g = (const GAS float*)(a.in[28] + (size_t)l * 1024); GAS bf16* xr = (GAS bf16*)xr_;
    f32x4 v[4][4]; float ss[4];
#pragma unroll
    for (int rr = 0; rr < 4; ++rr)
#pragma unroll
        for (int j = 0; j < 4; ++j) v[rr][j] = *(const GAS f32x4*)(xrow + (size_t)rr * 1024 + 4 * (lane + 64 * j));
#pragma unroll
    for (int rr = 0; rr < 4; ++rr) { float t = 0.f;
#pragma unroll
        for (int j = 0; j < 4; ++j) t += (v[rr][j][0] * v[rr][j][0] + v[rr][j][1] * v[rr][j][1]) + (v[rr][j][2] * v[rr][j][2] + v[rr][j][3] * v[rr][j][3]);
        ss[rr] = t; }
#pragma unroll
    for (int rr = 0; rr < 4; ++rr) ss[rr] = wave_sum(ss[rr]);
#pragma unroll
    for (int j = 0; j < 4; ++j) { const int k0 = 4 * (lane + 64 * j); const f32x4 gv = *(const GAS f32x4*)(g + k0);
#pragma unroll
        for (int rr = 0; rr < 4; ++rr) { const float r = 1.f / sqrtf(ss[rr] * (1.f / 1024.f) + 1e-6f); const f32x4 xn = v[rr][j] * r * gv;
            unsigned hi[4]; float lo[4];
#pragma unroll
            for (int e = 0; e < 4; ++e) { hi[e] = f2bf(xn[e]); lo[e] = xn[e] - __builtin_bit_cast(float, hi[e] << 16); }
            u32x2 wh, wl; wh.x = hi[0] | (hi[1] << 16); wh.y = hi[2] | (hi[3] << 16); wl.x = pk2(lo[0], lo[1]); wl.y = pk2(lo[2], lo[3]);
            *(GAS u32x2*)(xr + (size_t)(tok0 + rr) * 2048 + k0) = wh; *(GAS u32x2*)(xr + (size_t)(tok0 + rr) * 2048 + 1024 + k0) = wl; } }
}
struct SchedRoute { const char* A; const char* B; int pm;
    DI bool next(int i, Unit& u) const { if (i > 0) return false; u.pm = pm; u.pn = 0; u.aux = 0; u.pad = 0; u.a = A + (size_t)pm * 128 * 2048 * 2; u.b = B; return true; } };
struct EpiRoute { float* rlog;
    DI void operator()(const f32x4 (&acc)[2][2][4][2], const Unit& u, int wr, int wc, int fr, int fq) const {
        const int row0 = u.pm * 128 + wr * 64 + fr; const int col = wc * 32 + 8 * fq;
#pragma unroll
        for (int m = 0; m < 4; ++m) { float* rp = rlog + (size_t)(row0 + m * 16) * 128 + col; *(f32x4*)rp = acc[0][0][m][0]; *(f32x4*)(rp + 4) = acc[0][0][m][1]; }
    }
};
DI void route_decide(const KA& a, int l, const float* rl_row, int* rec_e, int* rec_slot, float* rec_w, unsigned* cnt, int tok) {
    float lg[36];
    const float* bg = a.in[30] + l * 4; const float* be = a.in[32] + l * 32;
#pragma unroll
    for (int q = 0; q < 9; ++q) { const f32x4 h = *(const f32x4*)(rl_row + 4 * q), lo = *(const f32x4*)(rl_row + 64 + 4 * q);
        lg[4 * q + 0] = h[0] + lo[0]; lg[4 * q + 1] = h[1] + lo[1]; lg[4 * q + 2] = h[2] + lo[2]; lg[4 * q + 3] = h[3] + lo[3]; }
#pragma unroll
    for (int i = 0; i < 4; ++i) lg[i] += bg[i];
#pragma unroll
    for (int i = 0; i < 32; ++i) lg[4 + i] += be[i];
    int gsel = 0; float gm = lg[0];
#pragma unroll
    for (int i = 1; i < 4; ++i) if (lg[i] > gm) { gm = lg[i]; gsel = i; }
    float gs = 0.f;
#pragma unroll
    for (int i = 0; i < 4; ++i) gs += __expf(lg[i] - gm);
    const float gwt = 1.f / gs;
    float v8[8];
#pragma unroll
    for (int i = 0; i < 8; ++i) { float x = lg[4 + i];
#pragma unroll
        for (int gq = 1; gq < 4; ++gq) x = (gsel == gq) ? lg[4 + gq * 8 + i] : x;
        v8[i] = x; }
    int i0 = 0; float m0 = v8[0];
#pragma unroll
    for (int i = 1; i < 8; ++i) if (v8[i] > m0) { m0 = v8[i]; i0 = i; }
    int i1 = -1; float m1 = -3e38f;
#pragma unroll
    for (int i = 0; i < 8; ++i) if (i != i0 && v8[i] > m1) { m1 = v8[i]; i1 = i; }
    if (i1 < 0) i1 = (i0 == 0) ? 1 : 0;
    const float w0 = 1.f / (1.f + __expf(m1 - m0)); const float w1 = 1.f - w0;
    const int e0 = gsel * 8 + i0, e1 = gsel * 8 + i1;
    const unsigned s0 = __hip_atomic_fetch_add(cnt + e0, 1u, __ATOMIC_RELAXED, __HIP_MEMORY_SCOPE_AGENT);
    const unsigned s1 = __hip_atomic_fetch_add(cnt + e1, 1u, __ATOMIC_RELAXED, __HIP_MEMORY_SCOPE_AGENT);
    rec_e[tok * 2] = e0; rec_e[tok * 2 + 1] = e1; rec_slot[tok * 2] = (int)s0; rec_slot[tok * 2 + 1] = (int)s1; rec_w[tok * 2] = w0 * gwt; rec_w[tok * 2 + 1] = w1 * gwt;
}
DI void expert_weights(const KA& a, int l, LAS unsigned char* lds, int it0, int it1, int gw, int NGW, int wave, int lane) {
    LAS float* scr = (LAS float*)(lds + wave * 16384);
    const float* wgt = a.in[33] + (size_t)l * 32 * 1024 * 256; const float* wup = a.in[34] + (size_t)l * 32 * 1024 * 256; const float* wdn = a.in[35] + (size_t)l * 32 * 256 * 1024;
    bf16* Wgu = (bf16*)(a.ws + WS_WGU); bf16* Wd = (bf16*)(a.ws + WS_WD);
    constexpr int I_E = 16 * 8, I_D = 4 * 32;
    constexpr int NIT = 32 * (2 * I_E + I_D);
    (void)NIT;
    for (int it = it0 + gw; it < it1; it += NGW) {
        const int e = it / (2 * I_E + I_D); int r = it % (2 * I_E + I_D);
        if (r < 2 * I_E) { const int up = r / I_E, q = r % I_E, kb = q / 8, nb = q % 8; const int n0 = nb * 32;
            const int drow = (n0 >> 7) * 256 + up * 128 + (n0 & 127);
            transpose_item((up ? wup : wgt) + (size_t)e * 1024 * 256, 256, 256, Wgu + (size_t)e * 512 * 1024, 1024, kb * 64, n0, drow, scr, lane);
        } else { r -= 2 * I_E; const int kb = r / 32, nb = r % 32;
            transpose_item(wdn + (size_t)e * 256 * 1024, 1024, 1024, Wd + (size_t)e * 1024 * 256, 256, kb * 64, nb * 32, nb * 32, scr, lane); }
    }
}
DI void build_offsets(const unsigned* cnt, LAS int* offt, int tid) {
    if (tid < 32) { const int c = (int)__hip_atomic_load(cnt + tid, __ATOMIC_RELAXED, __HIP_MEMORY_SCOPE_AGENT); offt[330 + tid] = (c + 255) & ~255; }
    __syncthreads();
    if (tid == 0) { int o = 0;
#pragma unroll
        for (int e = 0; e < 32; ++e) { offt[e] = o; o += offt[330 + e]; } offt[32] = o; }
    __syncthreads();
    for (int rt = tid; rt < (MOE_ROWS >> 8); rt += 512) { int e = 0; for (int j = 1; j < 32; ++j) e += (offt[j] <= rt * 256) ? 1 : 0; offt[40 + rt] = e; }
    __syncthreads();
}

template <unsigned PM>
__global__ void __launch_bounds__(512, 2) mk_fwd(Args a_) {
    extern __shared__ __attribute__((aligned(16))) unsigned char lds_raw[];
    LAS unsigned char* lds = (LAS unsigned char*)lds_raw;
    const int wave0 = __builtin_amdgcn_readfirstlane((int)threadIdx.x >> 6);
    if (threadIdx.x < 36) ((LAS unsigned long long*)(lds + PTAB_OFF))[threadIdx.x] = (unsigned long long)a_.in[threadIdx.x];
    __syncthreads();
    KA a; a.in.base = (unsigned)(size_t)(lds + PTAB_OFF); a.out = a_.out; a.ws = a_.ws;
    const int G = gridDim.x, bid = blockIdx.x, NGW = G * 8;
#define PHASE_IDS() int wave = wave0; asm volatile("" : "+s"(wave)); const int lane = my_lane(); const int tid_ = wave * 64 + lane, gw = bid * 8 + wave; (void)tid_; (void)gw; \
    KA ap = a; asm volatile("" : "+s"(ap.ws), "+s"(ap.out), "+s"(ap.in.base)); \
    bf16* hb = (bf16*)(ap.ws + WS_HB); bf16* proj = (bf16*)(ap.ws + WS_PROJ); bf16* gates = (bf16*)(ap.ws + WS_GATES); \
    bf16* ys = hb; bf16* x2b = hb; bf16* merged = proj; bf16* eo = proj; \
    bf16* kcb = (bf16*)(ap.ws + WS_KCVC); float* lrusum = (float*)(ap.ws + WS_LRUSUM); \
    int* rec_e = (int*)(ap.ws + WS_REC); int* rec_slot = rec_e + T * 2; float* rec_w = (float*)(rec_slot + T * 2); \
    int* rowtok = (int*)(ap.ws + WS_ROWTOK); float* roww = (float*)(ap.ws + WS_ROWW); \
    bf16* xs = (bf16*)(ap.ws + WS_XS); bf16* hmid = (bf16*)(ap.ws + WS_HMID); unsigned* ctl = (unsigned*)(ap.ws + WS_CTL); \
    (void)hb; (void)proj; (void)gates; (void)ys; (void)x2b; (void)merged; (void)eo; (void)kcb; (void)lrusum; (void)rec_e; (void)rec_slot; (void)rec_w; (void)rowtok; (void)roww; (void)xs; (void)hmid; (void)ctl
    volatile LAS unsigned* MISC = (volatile LAS unsigned*)(lds + MISC_OFF);
    LAS float* biasd = (LAS float*)(lds + BIAS_OFF);
    LAS int* offt = (LAS int*)(lds + OFFT_OFF);
    { PHASE_IDS();
    if (tid_ < 64) MISC[tid_] = 0u;
    for (int i = tid_; i < 129 * 12; i += 512) { const int d = i / 12, hd = i % 12; const int bk = d < 128 ? T5_BUCKET[d] : 31; const float* rb = a.in[1]; biasd[i] = rb[bk * 12 + hd]; ((LAS float*)(lds + BIAS2_OFF))[i] = (rb[bk * 12 + hd] - rb[31 * 12 + hd]) * 1.4426950408889634f; } }
    __syncthreads();
    const int lo = a_.ph_lo, hi = a_.ph_hi;
    XcdBarrier bar; bar.bar = (unsigned*)(a.ws + WS_CTL) + CW_BAR; bar.x = 0; bar.st = nullptr;
    if (hi - lo > 1) { PHASE_IDS(); bar = xcd_barrier_post(ctl + CW_BAR, MISC + 8, tid_ == 0); }
#ifndef SUB_MASK
#define SUB_MASK 0xFFu
#endif
#define SUB(k) ((SUB_MASK >> (k)) & 1u)
#define HASP(k) ((PM >> ((k) % PPL + ((k) >= 2 * PPL ? PPL : 0))) & 1u)
#define IN(k) (HASP(k) && lo <= (k) && (k) < hi)
#define SEAM(k) do { if ((k) + 1 < hi) { const int sl_ = my_lane(); int sw_ = wave0; asm volatile("" : "+s"(sw_)); xcd_barrier(bar, sw_ == 0 && sl_ == 0); } } while (0)
    for (int l = 0; l < DEPTH; ++l) {
        const int pb = l * PPL;
        if (IN(pb + 0)) { PHASE_IDS(); router_weights(ap, l, gw, NGW, lane); lru_weights(ap, l, gw, NGW, lane); cmp_weights(ap, l, lds, gw, NGW, wave, lane); phase0_weights(ap, l, lds, gw, NGW, wave, lane); phase0_rows(ap, l, 0, gw, NGW, lane); SEAM(pb + 0); }
        if (IN(pb + 1)) {
            PHASE_IDS();
            pg8::Gemm g{1024, 1024, 1024, 128, -1}; SchedP1 S{(const char*)hb, (const char*)(ap.ws + WS_WIN), G, bid};
            EpiP1 E{proj, gates, ap.in[25] + (size_t)l * 4096};
            pg8::gemm_phase<EpiP1, SchedP1>(lds, g, S, E, tid_); SEAM(pb + 1);
        }
        if (IN(pb + 2)) {
            PHASE_IDS();
            LAS float* lamp = (LAS float*)(lds + MISC_OFF + 64);
            if (tid_ < 64) { const float* q1 = ap.in[13] + l * 32; const float* k1 = ap.in[14] + l * 32; const float* q2 = ap.in[15] + l * 32; const float* k2 = ap.in[16] + l * 32;
                float s1 = (lane < 32) ? q1[lane] * k1[lane] : 0.f, s2 = (lane < 32) ? q2[lane] * k2[lane] : 0.f; s1 = wave_sum(s1); s2 = wave_sum(s2);
                const float lam_init = 0.8f - 0.6f * __expf(-0.3f * (float)l); if (lane == 0) { lamp[0] = __expf(s1) - __expf(s2) + lam_init; lamp[1] = lam_init; } }
            __syncthreads();
            if (SUB(0)) { const LAS float* bias2 = (const LAS float*)(lds + BIAS2_OFF); const GAS float* subg = (const GAS float*)(ap.in[17] + l * 64);
                for (int pi = bid; pi < 256; pi += G) { const int bh = pi >> 4, qlo = pi & 15;
                    diff_unit((const GAS bf16*)proj, (GAS bf16*)ys, lds, bias2, subg, lamp, bh >> 2, bh & 3, 31 - qlo, wave);
                    diff_unit((const GAS bf16*)proj, (GAS bf16*)ys, lds, bias2, subg, lamp, bh >> 2, bh & 3, qlo, wave); } }
            { PHASE_IDS();
            if (SUB(3)) { __syncthreads(); const LAS float* bias2 = (const LAS float*)(lds + BIAS2_OFF); const GAS float* sinks = (const GAS float*)(ap.in[12] + l * 4);
                for (int pi = bid; pi < 512; pi += G) swa_unit((const GAS bf16*)proj, (GAS bf16*)ys, lds, bias2, biasd, sinks, pi >> 7, pi & 127, tid_, lane, wave); }
            if (SUB(2)) { pg8::Gemm g{1024, 16 * PLD, 1024, PLD * 2, -1}; SchedCmp S{(const char*)proj, (const char*)(ap.ws + WS_WCMP), G, bid}; EpiCmp E{(float*)(ap.ws + WS_CMPAB)};
                pg8::gemm_phase<EpiCmp, SchedCmp>(lds, g, S, E, tid_); }
            if (SUB(1)) { __syncthreads(); for (int task = bid; task < 512; task += G) lru_unit(ap, l, (const GAS bf16*)proj, (GAS bf16*)ys, (GAS float*)lrusum, lds, task, lane, wave, false); }
            }
            SEAM(pb + 2);
        }
        if (IN(pb + 3)) {
            PHASE_IDS();
            for (int task = gw; task < 2 * BATCH * NCMP; task += NGW) cmp_finish(ap, l, (const float*)(ap.ws + WS_CMPAB), kcb, task, lane);
            __syncthreads();
            for (int task = bid; task < 512; task += G) lru_unit(ap, l, (const GAS bf16*)proj, (GAS bf16*)ys, (GAS float*)lrusum, lds, task, lane, wave, true);
            SEAM(pb + 3);
        }
        if (IN(pb + 4)) {
            PHASE_IDS();
            if (SUB(4)) { const LAS float* bias2 = (const LAS float*)(lds + BIAS2_OFF);
                for (int pi = bid; pi < 256; pi += G) { const int bb = pi >> 6, ulo = pi & 63;
                    nsa_unit((const GAS bf16*)proj, (GAS bf16*)ys, (const GAS bf16*)kcb, lds, bias2, bb, 127 - ulo, tid_, lane, wave);
                    nsa_unit((const GAS bf16*)proj, (GAS bf16*)ys, (const GAS bf16*)kcb, lds, bias2, bb, ulo, tid_, lane, wave); } }
            SEAM(pb + 4);
        }
        if (IN(pb + 5)) {
            PHASE_IDS();
            pg8::Gemm g{256, 1024, 256, 128, -1}; SchedP3a S{(const char*)ys, (const char*)(ap.ws + WS_WBR), G, bid};
            EpiP3a E{merged, gates};
            pg8::gemm_phase<EpiP3a, SchedP3a>(lds, g, S, E, tid_); SEAM(pb + 5);
        }
        if (IN(pb + 6)) {
            PHASE_IDS();
            pg8::Gemm g{1024, 1024, 1024, 128, -1}; SchedP3b S{(const char*)merged, (const char*)(ap.ws + WS_WOUT), G, bid};
            EpiP3b E{(l == 0) ? ap.in[0] : ap.out, ap.out};
            pg8::gemm_phase<EpiP3b, SchedP3b>(lds, g, S, E, tid_); SEAM(pb + 6);
        }
        if (IN(pb + 7)) {
            PHASE_IDS();
            bf16* xr = (bf16*)(ap.ws + WS_XR); float* rlog = (float*)(ap.ws + WS_RLOG);
            constexpr int NITW = 32 * (2 * 16 * 8 + 4 * 32);
            { const int pm = bid;
                for (int r = wave * 4; r < 128; r += 32) route_rows4(ap, l, xr, pm * 128 + r, lane);
                asm volatile("s_waitcnt vmcnt(0)" ::: "memory"); __syncthreads();
                { pg8::Gemm g{2048, 2048, 2048, 128, 0}; SchedRoute S{(const char*)xr, (const char*)(ap.ws + WS_WR), pm}; EpiRoute E{rlog};
                  pg8::gemm_phase<EpiRoute, SchedRoute>(lds, g, S, E, tid_); }
                asm volatile("s_waitcnt vmcnt(0)" ::: "memory"); __syncthreads();
                if (tid_ < 128) route_decide(ap, l, rlog + (size_t)(pm * 128 + tid_) * 128, rec_e, rec_slot, rec_w, ctl + CW_CNT + l * 32, pm * 128 + tid_);
                __syncthreads();
            }
            expert_weights(ap, l, lds, 0, NITW, gw, NGW, wave, lane);
            SEAM(pb + 7);
        }
        if (IN(pb + 8)) {
            PHASE_IDS();
            build_offsets(ctl + CW_CNT + l * 32, offt, tid_);
            if (bid < 32) { const int e = bid; const int c = (int)__hip_atomic_load(ctl + CW_CNT + l * 32 + e, __ATOMIC_RELAXED, __HIP_MEMORY_SCOPE_AGENT);
                for (int p = offt[e] + c + tid_; p < offt[e + 1]; p += 512) rowtok[p] = -1; }
            {   int* rowsrc = (int*)xs;
                if (bid < 32) { const int e = bid; const int c = (int)__hip_atomic_load(ctl + CW_CNT + l * 32 + e, __ATOMIC_RELAXED, __HIP_MEMORY_SCOPE_AGENT);
                    for (int p = offt[e] + c + tid_; p < offt[e + 1]; p += 512) rowsrc[p] = 0; }
                for (int as = bid * 512 + tid_; as < 2 * T; as += G * 512) { const int p = offt[rec_e[as]] + rec_slot[as];
                    rowtok[p] = as; roww[p] = rec_w[as]; rowsrc[p] = as >> 1; } }
            SEAM(pb + 8);
        }
        if (IN(pb + 9)) {
            PHASE_IDS();
            build_offsets(ctl + CW_CNT + l * 32, offt, tid_);
            pg8::Gemm g{1024, 2048, 1024, 128, -1}; SchedM2 S{(const char*)(ap.ws + WS_XR), (const char*)(ap.ws + WS_WGU), offt, (const int*)xs, G, bid};
            EpiM2 E{hmid};
            pg8::gemm_phase<EpiM2, SchedM2, true>(lds, g, S, E, tid_); SEAM(pb + 9);
        }
        if (IN(pb + 10)) {
            PHASE_IDS();
            build_offsets(ctl + CW_CNT + l * 32, offt, tid_);
            int K3 = 256; asm volatile("" : "+s"(K3));
            pg8::Gemm g{K3, 256, 256, 128, -1}; SchedM3 S{(const char*)hmid, (const char*)(ap.ws + WS_WD), offt, G, bid};
            EpiM3 E{eo, rowtok, roww};
            pg8::gemm_phase<EpiM3, SchedM3>(lds, g, S, E, tid_); SEAM(pb + 10);
        }
    }
    if (IN(2 * PPL)) { PHASE_IDS(); phase0_rows(ap, DEPTH, 1, gw, NGW, lane); }
#undef IN
#undef SEAM
}

typedef void (*kern_t)(Args);
template <unsigned PM> static bool setup_kernel() {
    if (hipFuncSetAttribute((const void*)mk_fwd<PM>, hipFuncAttributeMaxDynamicSharedMemorySize, LDS_BYTES) != hipSuccess) { fprintf(stderr, "kernel_launch: hipFuncSetAttribute failed\n"); return false; }
    return true;
}
extern "C" void kernel_launch(void* const* d_in, const int* in_sizes, int n_in, void* d_out, int out_size, void* d_ws, size_t ws_size, hipStream_t stream) {
    static int grid = 0;
    if (grid == 0) {
        if (n_in != 36 || out_size != T * D || ws_size < WS_END) { fprintf(stderr, "kernel_launch: unexpected shapes (n_in %d out %d ws %zu)\n", n_in, out_size, ws_size); grid = -1; return; }
        int dev = 0, cus = 0;
        if (hipGetDevice(&dev) != hipSuccess || hipDeviceGetAttribute(&cus, hipDeviceAttributeMultiprocessorCount, dev) != hipSuccess) { grid = -1; return; }
        bool ok = true;
#if MK_ONE_LAUNCH
        ok = setup_kernel<0xFFFu>();
#endif
        if (!ok) { grid = -1; return; }
        (void)hipGetLastError();
        grid = cus;
        if (grid != 256) { fprintf(stderr, "kernel_launch: built for a 256-CU device (got %d)\n", cus); grid = -1; return; }
    }
    if (grid < 0) return;
    if (hipMemsetAsync((char*)d_ws + WS_CTL, 0, CTL_ZERO_BYTES, stream) != hipSuccess) return;
    Args a{};
    for (int i = 0; i < 36; ++i) a.in[i] = (const float*)d_in[i];
    a.out = (float*)d_out; a.ws = (unsigned char*)d_ws;
#if MK_ONE_LAUNCH
    a.ph_lo = 0; a.ph_hi = NPH;
    hipLaunchKernelGGL(mk_fwd<0xFFFu>, dim3(grid), dim3(512), LDS_BYTES, stream, a);
#endif
}
```

```cpp
#include <hip/hip_runtime.h>
#include <cstdio>
#include <cstdint>

#ifndef MK_ONE_LAUNCH
#define MK_ONE_LAUNCH 1
#endif

#define DI __device__ __forceinline__
#define GAS __attribute__((address_space(1)))
#define LAS __attribute__((address_space(3)))
typedef unsigned short bf16;
typedef short bf16x8 __attribute__((ext_vector_type(8)));
typedef float f32x4 __attribute__((ext_vector_type(4)));
typedef int i32x4 __attribute__((ext_vector_type(4)));
typedef unsigned u32x4 __attribute__((ext_vector_type(4)));
typedef unsigned u32x2 __attribute__((ext_vector_type(2)));
typedef float f32x16 __attribute__((ext_vector_type(16)));
typedef float f32x2 __attribute__((ext_vector_type(2)));
typedef short s16x4 __attribute__((ext_vector_type(4)));
typedef __bf16 bf16x2_t __attribute__((ext_vector_type(2)));
typedef short v4i16_t __attribute__((__vector_size__(4 * sizeof(short))));
#define MFMA32(a, b, c) __builtin_amdgcn_mfma_f32_32x32x16_bf16((a), (b), (c), 0, 0, 0)

constexpr int BATCH = 4, SEQ = 8192, T = BATCH * SEQ, D = 1024, DEPTH = 2;
constexpr int NIN = 2444, PLD = 2560, N1 = 6656, GLD = 4096;
constexpr int C_AX = 0, C_AG = 256, C_BQ = 512, C_BK = 768, C_BV = 896, C_CQ = 1024, C_CK = 1280, C_CV = 1536, C_DQ = 1792,
              C_KC = 2048, C_VC = 2112, C_KS = 2176, C_VS = 2240, C_KW = 2304, C_VW = 2368, C_DG = 2432;
constexpr int NCMP = 511;
constexpr int MOE_ROWS = 73728;
constexpr int PPL = 11;
constexpr int NPH = 2 * PPL + 1;

constexpr size_t MiB = 1u << 20;
constexpr size_t WS_CTL = 0, CTL_ZERO_BYTES = 1 * MiB;
constexpr size_t WS_KCVC = 1 * MiB;
constexpr size_t WS_LRUSUM = 2 * MiB;
constexpr size_t WS_REC = 2 * MiB + 256 * 1024;
constexpr size_t WS_ROWTOK = 3 * MiB;
constexpr size_t WS_ROWW = 3 * MiB + 512 * 1024;
constexpr size_t WS_WIN = 4 * MiB;
constexpr size_t WS_WQ = 4 * MiB;
constexpr size_t WS_WSC = 13 * MiB;
constexpr size_t WS_HSC = 13 * MiB + 65536;
constexpr size_t WS_HQ = 373 * MiB;
constexpr size_t WS_WBR = 17 * MiB;
constexpr size_t WS_WOUT = 19 * MiB;
constexpr size_t WS_HB = 21 * MiB;
constexpr size_t WS_PROJ = 85 * MiB;
constexpr size_t WS_GATES = 245 * MiB;
constexpr size_t WS_WGU = 245 * MiB;
constexpr size_t WS_WD = 277 * MiB;
constexpr size_t WS_XS = 293 * MiB;
constexpr size_t WS_HMID = 437 * MiB;
constexpr size_t WS_XR = 85 * MiB;
constexpr size_t WS_RLOG = 213 * MiB;
constexpr size_t WS_WR = 501 * MiB;
constexpr size_t WS_WCMP = 502 * MiB;
constexpr size_t WS_CMPAB = 503 * MiB;
constexpr size_t WS_LRUW = 505 * MiB + 65536;
constexpr size_t WS_END = 506 * MiB;
constexpr int CW_BAR = 4096;
constexpr int CW_CNT = 16384;

constexpr int RING_BYTES = 131072;
constexpr int MISC_OFF = RING_BYTES;
constexpr int BIAS_OFF = MISC_OFF + 256;
constexpr int OFFT_OFF = BIAS_OFF + 129 * 12 * 4;
constexpr int PTAB_OFF = OFFT_OFF + (40 + 288 + 40) * 4;
constexpr int BIAS2_OFF = PTAB_OFF + 36 * 8;
constexpr int LRUEX_OFF = BIAS2_OFF + 129 * 12 * 4;
constexpr int LDS_BYTES = 163840;
constexpr int LRUCST_OFF = LRUEX_OFF + 8 * 64 * 2 * 4;
constexpr int LRUCAR_OFF = LRUCST_OFF + 3 * 64 * 4;
static_assert(PTAB_OFF % 8 == 0 && LRUCAR_OFF + 8 * 64 * 4 <= LDS_BYTES, "LDS map");

DI float bf2f(bf16 v) { return __builtin_bit_cast(float, (unsigned)v << 16); }
DI float lo_bf(unsigned w) { return __builtin_bit_cast(float, w << 16); }
DI float hi_bf(unsigned w) { return __builtin_bit_cast(float, w & 0xffff0000u); }
DI unsigned f2bf(float f) { unsigned u = __builtin_bit_cast(unsigned, f); return (u + 0x7fffu + ((u >> 16) & 1u)) >> 16; }
DI unsigned pk2(float lo, float hi) { return f2bf(lo) | (f2bf(hi) << 16); }
DI float rl(float v, int i) { return __builtin_bit_cast(float, __builtin_amdgcn_readlane(__builtin_bit_cast(int, v), i)); }
DI int rli(int v, int i) { return __builtin_amdgcn_readlane(v, i); }
DI int my_lane() { int l; asm volatile("v_mbcnt_lo_u32_b32 %0, -1, 0\n\tv_mbcnt_hi_u32_b32 %0, -1, %0" : "=v"(l)); return l; }
template <int O> DI int xshfl_i(int v) {
    if constexpr (O < 32) return __builtin_amdgcn_ds_swizzle(v, (O << 10) | 0x1f);
    else { const int l = my_lane(); return __builtin_amdgcn_ds_bpermute((l ^ 32) << 2, v); }
}
template <int O> DI float xshfl(float v) { return __builtin_bit_cast(float, xshfl_i<O>(__builtin_bit_cast(int, v))); }
DI float wave_sum(float v) { v += xshfl<1>(v); v += xshfl<2>(v); v += xshfl<4>(v); v += xshfl<8>(v); v += xshfl<16>(v); v += xshfl<32>(v); return v; }
DI float wave_max(float v) { v = fmaxf(v, xshfl<1>(v)); v = fmaxf(v, xshfl<2>(v)); v = fmaxf(v, xshfl<4>(v)); v = fmaxf(v, xshfl<8>(v)); v = fmaxf(v, xshfl<16>(v)); v = fmaxf(v, xshfl<32>(v)); return v; }
DI float sigmoidf_(float x) { return __builtin_amdgcn_rcpf(1.f + __builtin_amdgcn_exp2f(-1.4426950408889634f * x)); }
DI float gelu_tanh(float x) { const float u = 0.7978845608028654f * (x + 0.044715f * x * x * x); const float e = __expf(2.f * u); const float th = 1.f - 2.f * __builtin_amdgcn_rcpf(e + 1.f); return 0.5f * x * (1.f + th); }
DI float softplusf_(float x) { return fmaxf(x, 0.f) + log1pf(__expf(-fabsf(x))); }
#define LDS_WAIT() asm volatile("s_waitcnt lgkmcnt(0)" ::: "memory")
#define VM_WAIT() asm volatile("s_waitcnt vmcnt(0)" ::: "memory")

__device__ const unsigned char T5_BUCKET[128] = {
0,1,2,3,4,5,6,7,8,9,10,11,12,13,14,15,16,16,16,17,17,18,18,18,19,19,19,20,20,20,20,21,21,21,21,22,22,22,22,22,23,23,23,23,23,23,24,24,24,24,24,24,25,25,25,25,25,25,25,26,26,26,26,26,26,26,26,27,27,27,27,27,27,27,27,27,27,28,28,28,28,28,28,28,28,28,28,29,29,29,29,29,29,29,29,29,29,29,29,30,30,30,30,30,30,30,30,30,30,30,30,30,30,31,31,31,31,31,31,31,31,31,31,31,31,31,31,31};

#define XB_TMO      128
#define XB_XCNT(j)  (256  + 64 * (j))
#define XB_XSUB(j)  (1280 + 64 * (j))
#define XB_XGEN(j)  (2304 + 64 * (j))
#define XB_TOP      3328
#define XB_TOPGEN   3392
#define XCD_BAR_WORDS 3456
#define XB_SPIN_CAP (1u << 22)
DI unsigned xb_ld(unsigned* p)              { return __hip_atomic_load(p, __ATOMIC_RELAXED, __HIP_MEMORY_SCOPE_AGENT); }
DI unsigned xb_add(unsigned* p, unsigned v) { return __hip_atomic_fetch_add(p, v, __ATOMIC_RELAXED, __HIP_MEMORY_SCOPE_AGENT); }
DI unsigned xb_xcc_id() { return (unsigned)__builtin_amdgcn_s_getreg((3 << 11) | 20) & 0xFu; }
#define XB_SPIN(cond, bar) do { unsigned _sp = 0; while (cond) { __builtin_amdgcn_s_sleep(1); \
    if ((++_sp & 255u) == 0u) { if (xb_ld(&(bar)[XB_TMO])) break; if (_sp > XB_SPIN_CAP) { atomicAdd(&(bar)[XB_TMO], 1u); break; } } } } while (0)
struct XcdBarrier { unsigned* bar; unsigned x; volatile LAS unsigned* st; };
DI XcdBarrier xcd_barrier_post(unsigned* bar, volatile LAS unsigned* st, bool leader) {
    XcdBarrier b; b.bar = bar; b.x = xb_xcc_id(); b.st = st;
    if (leader) (void)xb_add(&bar[XB_XCNT(b.x)], 1u);
    return b;
}
DI void xcd_barrier_complete(unsigned* bar, unsigned x, unsigned& nloc, unsigned& nx) {
    const unsigned G = gridDim.x * gridDim.y * gridDim.z;
    unsigned sum, cnt, mine, sp = 0u;
    for (;;) {
        sum = 0u; cnt = 0u; mine = 0u;
#pragma unroll
        for (unsigned j = 0; j < 16; ++j) { const unsigned c = xb_ld(&bar[XB_XCNT(j)]); sum += c; cnt += (c > 0u) ? 1u : 0u; mine = (j == x) ? c : mine; }
        if (sum == G) break;
        __builtin_amdgcn_s_sleep(1);
        if ((++sp & 255u) == 0u) { if (xb_ld(&bar[XB_TMO])) break; if (sp > XB_SPIN_CAP) { atomicAdd(&bar[XB_TMO], 1u); break; } }
    }
    nloc = mine > 0u ? mine : 1u; nx = cnt > 0u ? cnt : 1u;
}
DI void xcd_barrier(const XcdBarrier& b, bool leader) {
    asm volatile("s_waitcnt vmcnt(0)" ::: "memory");
    __syncthreads();
    if (leader) {
        unsigned* bar = b.bar;
        __builtin_amdgcn_s_waitcnt(0);
        unsigned nloc = b.st[0], nx = b.st[1];
        if (nloc == 0u) { xcd_barrier_complete(bar, b.x, nloc, nx); b.st[0] = nloc; b.st[1] = nx; }
        const unsigned old = xb_add(&bar[XB_XSUB(b.x)], 1u);
        const unsigned gen = old / nloc;
        if (old + 1u == (gen + 1u) * nloc) {
            __builtin_amdgcn_fence(__ATOMIC_RELEASE, "agent");
            asm volatile("s_waitcnt vmcnt(0)" ::: "memory");
            const unsigned og = xb_add(&bar[XB_TOP], 1u);
            const unsigned tg = og / nx;
            if (og + 1u == (tg + 1u) * nx) xb_add(&bar[XB_TOPGEN], 1u);
            else XB_SPIN(xb_ld(&bar[XB_TOPGEN]) == tg, bar);
            __builtin_amdgcn_fence(__ATOMIC_ACQUIRE, "agent");
            xb_add(&bar[XB_XGEN(b.x)], 1u);
            asm volatile("s_waitcnt vmcnt(0)" ::: "memory");
        } else {
            XB_SPIN(xb_ld(&bar[XB_XGEN(b.x)]) == gen, bar);
            __builtin_amdgcn_fence(__ATOMIC_ACQUIRE, "agent");
            asm volatile("s_waitcnt vmcnt(0)" ::: "memory");
        }
    }
    __syncthreads();
}

namespace pg8 {
constexpr int BM = 256, BK = 64, HALF = 128, HTB = HALF * BK * 2;
__host__ __device__ __forceinline__ int lds_byte(int r, int c) { const int st = (r >> 4) * 2 + (c >> 5), rr = r & 15, cc = c & 31, ob = rr * 64 + cc * 2; return st * 1024 + (ob ^ (((ob >> 9) & 1) << 5)); }
__host__ __device__ __forceinline__ void stage_rc(int b, int& R, int& C) { const int st = b / 1024, sb = b % 1024, swz = sb ^ (((sb >> 9) & 1) << 5); R = (st >> 1) * 16 + swz / 64; C = (st & 1) * 32 + (swz % 64) / 2; }
__host__ __device__ __forceinline__ int perm32(int rho) { const int n = rho >> 4, i = rho & 15; return 8 * (i >> 2) + 4 * n + (i & 3); }
struct Unit { const char* a; const char* b; int pm, pn, aux, pad; };
struct Gemm { int K, lda, ldb, kstepA, hstepA; };
template <bool I8> struct AccT { typedef f32x4 type; };
template <> struct AccT<true> { typedef i32x4 type; };
template <class Epi, class Sched, bool GATHER = false, bool I8 = false>
DI void gemm_phase(LAS unsigned char* lds, const Gemm g, const Sched& S, const Epi& E, int tid_in) {
    int tid = tid_in; asm volatile("" : "+v"(tid));
    const int wid = __builtin_amdgcn_readfirstlane(tid >> 6), lane = tid & 63, wr = wid >> 2, wc = wid & 3, fr = lane & 15, fq = lane >> 4;
    const int K = g.K, nt = K / BK;
    unsigned voffA[2], voffB[2];
#pragma unroll
    for (int i = 0; i < 2; ++i) { int R, C; stage_rc(tid * 16 + i * 8192, R, C); const int Rb = (R & ~31) + perm32(R & 31);
        voffA[i] = (unsigned)(R * g.lda + C) * 2u; voffB[i] = (unsigned)(Rb * g.ldb + C) * 2u; }
    const size_t kstep = (size_t)(BK * 2), kstepA = (size_t)g.kstepA;
    const size_t hstepA = g.hstepA < 0 ? (size_t)HALF * g.lda * 2 : (size_t)g.hstepA, hstepB = (size_t)HALF * g.ldb * 2;
    const unsigned hstepA32 = (unsigned)hstepA;
    unsigned gC[2][2] = {{0u, 0u}, {0u, 0u}}, gN[2][2] = {{0u, 0u}, {0u, 0u}};
    const unsigned ldsw = (unsigned)wid * 1024u;
    const int aoff = lds_byte(wr * 64 + fr, fq * 8), boff = lds_byte(wc * 32 + fr, fq * 8);
#define PG8_SA(b, h) (((b) * 2 + (h)) * HTB)
#define PG8_SB(b, h) ((4 + (b) * 2 + (h)) * HTB)
#define PG8_STAGE(bufoff, gbase, voff) do { _Pragma("unroll") for (int _i = 0; _i < 2; ++_i) \
        __builtin_amdgcn_global_load_lds((const unsigned*)((const char*)(gbase) + (voff)[_i]), (LAS unsigned*)(lds + (bufoff) + ldsw + _i * 8192), 16, 0, 0); } while (0)
#define PG8_STAGEA(bufoff, gbase, h, nextsel) do { _Pragma("unroll") for (int _i = 0; _i < 2; ++_i) { \
        const unsigned _o = GATHER ? ((nextsel) ? gN[h][_i] : gC[h][_i]) : (voffA[_i] + (unsigned)(h) * hstepA32); \
        __builtin_amdgcn_global_load_lds((const unsigned*)((const char*)(gbase) + _o), (LAS unsigned*)(lds + (bufoff) + ldsw + _i * 8192), 16, 0, 0); } } while (0)
#define PG8_LDA(dst, b, h) do { _Pragma("unroll") for (int m = 0; m < 4; ++m) _Pragma("unroll") for (int k = 0; k < 2; ++k) dst[m][k] = *(const LAS bf16x8*)(lds + PG8_SA(b, h) + aoff + m * 2048 + k * 1024); } while (0)
#define PG8_LDB(dst, b, h) do { _Pragma("unroll") for (int n = 0; n < 2; ++n) _Pragma("unroll") for (int k = 0; k < 2; ++k) dst[n][k] = *(const LAS bf16x8*)(lds + PG8_SB(b, h) + boff + n * 2048 + k * 1024); } while (0)
#define PG8_MMA(ai, bj, At, Bt) do { __builtin_amdgcn_s_setprio(1); _Pragma("unroll") for (int m = 0; m < 4; ++m) _Pragma("unroll") for (int n = 0; n < 2; ++n) _Pragma("unroll") for (int k = 0; k < 2; ++k) \
        { if constexpr (I8) acc[ai][bj][m][n] = __builtin_amdgcn_mfma_i32_16x16x64_i8(__builtin_bit_cast(i32x4, Bt[n][k]), __builtin_bit_cast(i32x4, At[m][k]), acc[ai][bj][m][n], 0, 0, 0); \
          else acc[ai][bj][m][n] = __builtin_amdgcn_mfma_f32_16x16x32_bf16(Bt[n][k], At[m][k], acc[ai][bj][m][n], 0, 0, 0); } __builtin_amdgcn_s_setprio(0); } while (0)
#define PG8_WAIT_V(n) asm volatile("s_waitcnt vmcnt(" #n ")" ::: "memory")
#define PG8_WAIT_L(n) asm volatile("s_waitcnt lgkmcnt(" #n ")" ::: "memory")
#define PG8_BAR __builtin_amdgcn_s_barrier()
#define PG8_SCHED __builtin_amdgcn_sched_barrier(0)
    Unit cur, nxt; int ui = 0;
    if (!S.next(0, cur)) return;
    typedef typename AccT<I8>::type ACC;
    ACC acc[2][2][4][2];
#pragma unroll
    for (int a = 0; a < 2; ++a)
#pragma unroll
        for (int b = 0; b < 2; ++b)
#pragma unroll
            for (int m = 0; m < 4; ++m)
#pragma unroll
                for (int n = 0; n < 2; ++n) acc[a][b][m][n] = (ACC){0, 0, 0, 0};
    bf16x8 At[4][2], B0[2][2], B1[2][2];
    const char* cA = cur.a; const char* cB = cur.b;
    if constexpr (GATHER) S.rows(cur, tid, gC);
    PG8_STAGE(PG8_SB(0, 0), cB, voffB); PG8_STAGE(PG8_SB(0, 1), cB + hstepB, voffB); PG8_STAGEA(PG8_SA(0, 0), cA, 0, false); PG8_STAGEA(PG8_SA(0, 1), cA, 1, false);
    if (wr == 1) PG8_BAR;
    PG8_WAIT_V(2); PG8_BAR;
    PG8_STAGE(PG8_SB(1, 0), cB + kstep, voffB); PG8_STAGEA(PG8_SA(1, 0), cA + kstepA, 0, false); PG8_STAGE(PG8_SB(1, 1), cB + hstepB + kstep, voffB);
    PG8_WAIT_V(6); PG8_BAR;
    for (;;) {
        const bool has_next = S.next(ui + 1, nxt);
        const char* nA = has_next ? nxt.a : cA; const char* nB = has_next ? nxt.b : cB;
        if constexpr (GATHER) { if (has_next) S.rows(nxt, tid, gN); else {
#pragma unroll
            for (int h = 0; h < 2; ++h) { gN[h][0] = gC[h][0]; gN[h][1] = gC[h][1]; } } }
        for (int t = 0; t < nt; t += 2) {
            const bool last = (t == nt - 2);
            const char* a1 = cA + (size_t)(t + 1) * kstepA;
            const char* a2 = last ? nA : cA + (size_t)(t + 2) * kstepA; const char* b2 = last ? nB : cB + (size_t)(t + 2) * kstep;
            const char* a3 = a2 + kstepA; const char* b3 = b2 + kstep;
            PG8_LDB(B0, 0, 0); PG8_LDB(B1, 0, 1); PG8_SCHED; PG8_LDA(At, 0, 0); PG8_STAGEA(PG8_SA(1, 1), a1, 1, false);
            PG8_WAIT_V(8); PG8_WAIT_L(0); PG8_BAR; PG8_MMA(0, 0, At, B0); PG8_MMA(0, 1, At, B1); PG8_BAR; PG8_SCHED;
            PG8_LDA(At, 0, 1); PG8_STAGE(PG8_SB(0, 0), b2, voffB); PG8_STAGE(PG8_SB(0, 1), b2 + hstepB, voffB); PG8_STAGEA(PG8_SA(0, 0), a2, 0, last);
            PG8_WAIT_V(8); PG8_WAIT_L(0); PG8_BAR; PG8_MMA(1, 0, At, B0); PG8_MMA(1, 1, At, B1); PG8_BAR; PG8_SCHED;
            PG8_LDB(B0, 1, 0); PG8_LDB(B1, 1, 1); PG8_SCHED; PG8_LDA(At, 1, 0); PG8_STAGEA(PG8_SA(0, 1), a2, 1, last);
            PG8_WAIT_V(8); PG8_WAIT_L(0); PG8_BAR; PG8_MMA(0, 0, At, B0); PG8_MMA(0, 1, At, B1); PG8_BAR; PG8_SCHED;
            PG8_LDA(At, 1, 1); PG8_STAGE(PG8_SB(1, 0), b3, voffB); PG8_STAGE(PG8_SB(1, 1), b3 + hstepB, voffB); PG8_STAGEA(PG8_SA(1, 0), a3, 0, last);
            PG8_WAIT_V(8); PG8_WAIT_L(0); PG8_BAR; PG8_MMA(1, 0, At, B0); PG8_MMA(1, 1, At, B1); PG8_BAR; PG8_SCHED;
        }
        if (wr == 0) PG8_BAR;
        { const int el = my_lane(); E(acc, cur, wr, wc, el & 15, el >> 4); }
        if (!has_next) break;
#pragma unroll
        for (int a = 0; a < 2; ++a)
#pragma unroll
            for (int b = 0; b < 2; ++b)
#pragma unroll
                for (int m = 0; m < 4; ++m)
#pragma unroll
                    for (int n = 0; n < 2; ++n) acc[a][b][m][n] = (ACC){0, 0, 0, 0};
        cur = nxt; cA = nA; cB = nB; ++ui;
        if constexpr (GATHER) {
#pragma unroll
            for (int h = 0; h < 2; ++h) { gC[h][0] = gN[h][0]; gC[h][1] = gN[h][1]; } }
        if (wr == 1) PG8_BAR;
    }
    PG8_WAIT_V(0);
    PG8_BAR;
#undef PG8_SA
#undef PG8_SB
#undef PG8_STAGE
#undef PG8_STAGEA
#undef PG8_LDA
#undef PG8_LDB
#undef PG8_MMA
#undef PG8_WAIT_V
#undef PG8_WAIT_L
#undef PG8_BAR
#undef PG8_SCHED
}
}
using pg8::Unit;

DI unsigned cvt_pk_bf16(float lo, float hi) { unsigned r; asm volatile("s_nop 1\n\tv_cvt_pk_bf16_f32 %0, %1, %2" : "=v"(r) : "v"(lo), "v"(hi)); return r; }
DI u32x4 pack8(const f32x4& v0, const f32x4& v1) { u32x4 w; w.x = cvt_pk_bf16(v0[0], v0[1]); w.y = cvt_pk_bf16(v0[2], v0[3]); w.z = cvt_pk_bf16(v1[0], v1[1]); w.w = cvt_pk_bf16(v1[2], v1[3]); return w; }

struct SchedP1 {
    const char* A; const char* B; int nM, nN, rbA, rbB, G, c;
    DI bool next(int i, Unit& u) const {
        constexpr int NXCD = 8, WGM = 8; const int nwg = nM * nN;
        const long L = (long)i * G + c; if (L >= nwg) return false;
        int wgid = (int)L; { const int q = nwg / NXCD, r = nwg % NXCD, xcd = wgid % NXCD, off = wgid / NXCD; wgid = (xcd < r ? xcd * (q + 1) : r * (q + 1) + (xcd - r) * q) + off; }
        const int nig = WGM * nN, gid = wgid / nig, fm = gid * WGM, gsz = (nM - fm) < WGM ? (nM - fm) : WGM;
        u.pm = fm + ((wgid % nig) % gsz); u.pn = (wgid % nig) / gsz; u.aux = 0; u.pad = 0;
        u.a = A + (size_t)u.pm * 256 * rbA; u.b = B + (size_t)u.pn * 256 * rbB; return true;
    }
};
struct SchedP3a {
    const char* ys; const char* wbr; int G, c;
    DI bool next(int i, Unit& u) const {
        const int tile = (i >> 2) * G + c; if (tile >= 512) return false;
        const int br = i & 3; u.pm = tile >> 2; u.pn = tile & 3; u.aux = br; u.pad = 0;
        u.a = ys + ((size_t)u.pm * 256 * 1024 + br * 256) * 2; u.b = wbr + ((size_t)br * 1024 * 256 + (size_t)u.pn * 256 * 256) * 2; return true;
    }
};
struct SchedP3b {
    const char* A; const char* B; int G, c;
    DI bool next(int i, Unit& u) const {
        const int L = i * G + c; if (L >= 512) return false;
        u.pm = L >> 2; u.pn = L & 3; u.aux = 0; u.pad = 0;
        u.a = A + (size_t)u.pm * 256 * 1024 * 2; u.b = B + (size_t)u.pn * 256 * 1024 * 2; return true;
    }
};
struct SchedM2 {
    const char* xr; const char* wgu; const LAS int* offt; const int* rowsrc; int G, c;
    DI bool next(int i, Unit& u) const {
        const int NT = __builtin_amdgcn_readfirstlane(offt[32]) >> 8; const int L = i * G + c; if (L >= NT * 2) return false;
        const int rt = L >> 1, pn = L & 1; const int e = __builtin_amdgcn_readfirstlane(offt[40 + rt]);
        u.pm = rt; u.pn = pn; u.aux = e; u.pad = 0;
        u.a = xr; u.b = wgu + ((size_t)e * 512 + pn * 256) * 1024 * 2; return true;
    }
    DI void rows(const Unit& u, int tid, unsigned (&g)[2][2]) const {
#pragma unroll
        for (int i = 0; i < 2; ++i) { int R, C; pg8::stage_rc(tid * 16 + i * 8192, R, C);
#pragma unroll
            for (int h = 0; h < 2; ++h) g[h][i] = (unsigned)rowsrc[u.pm * 256 + h * 128 + R] * 4096u + (unsigned)C * 2u; }
    }
};
struct SchedM3 {
    const char* hmid; const char* wd; const LAS int* offt; int G, c;
    DI bool next(int i, Unit& u) const {
        const int NT = __builtin_amdgcn_readfirstlane(offt[32]) >> 8; const int L = i * G + c; if (L >= NT * 4) return false;
        const int rt = L >> 2, pn = L & 3; const int e = __builtin_amdgcn_readfirstlane(offt[40 + rt]);
        u.pm = rt; u.pn = pn; u.aux = e; u.pad = 0;
        u.a = hmid + (size_t)rt * 256 * 256 * 2; u.b = wd + ((size_t)e * 1024 + pn * 256) * 256 * 2; return true;
    }
};

struct EpiP1I8 {
    bf16* proj; unsigned char* gates; const float* bgate; const float* hsc; const float* wsc;
    DI void operator()(const i32x4 (&acc)[2][2][4][2], const Unit& u, int wr, int wc, int fr, int fq) const {
        const int row0 = u.pm * 256 + wr * 64 + fr;
        if (u.pn < 10) { const int colt = u.pn * 256 + wc * 32 + 8 * fq;
            f32x4 sv[2][2]; float rsv[2][4];
#pragma unroll
            for (int bj = 0; bj < 2; ++bj)
#pragma unroll
                for (int n = 0; n < 2; ++n) sv[bj][n] = *(const GAS f32x4*)((const GAS float*)wsc + colt + bj * 128 + 4 * n);
#pragma unroll
            for (int ai = 0; ai < 2; ++ai)
#pragma unroll
                for (int m = 0; m < 4; ++m) rsv[ai][m] = ((const GAS float*)hsc)[row0 + ai * 128 + m * 16];
#pragma unroll
            for (int ai = 0; ai < 2; ++ai)
#pragma unroll
                for (int m = 0; m < 4; ++m) { bf16* rowp = proj + (size_t)(row0 + ai * 128 + m * 16) * PLD + colt; const float rs = rsv[ai][m];
#pragma unroll
                    for (int bj = 0; bj < 2; ++bj) { f32x4 v0, v1;
#pragma unroll
                        for (int e = 0; e < 4; ++e) { v0[e] = (float)acc[ai][bj][m][0][e] * (rs * sv[bj][0][e]); v1[e] = (float)acc[ai][bj][m][1][e] * (rs * sv[bj][1][e]); }
                        *(u32x4*)(rowp + bj * 128) = pack8(v0, v1); } }
            return; }
        const int gcol = (u.pn - 10) * 256 + wc * 32 + 8 * fq; const float* wsc = this->wsc + 2560;
        f32x4 bv[2][2], sv[2][2];
#pragma unroll
        for (int bj = 0; bj < 2; ++bj)
#pragma unroll
            for (int n = 0; n < 2; ++n) { bv[bj][n] = *(const f32x4*)(bgate + gcol + bj * 128 + 4 * n); sv[bj][n] = *(const f32x4*)(wsc + gcol + bj * 128 + 4 * n); }
        float rsv[2][4];
#pragma unroll
        for (int ai = 0; ai < 2; ++ai)
#pragma unroll
            for (int m = 0; m < 4; ++m) rsv[ai][m] = ((const GAS float*)hsc)[row0 + ai * 128 + m * 16];
#pragma unroll
        for (int ai = 0; ai < 2; ++ai)
#pragma unroll
            for (int m = 0; m < 4; ++m) { const int row = row0 + ai * 128 + m * 16; const float rs = rsv[ai][m]; unsigned char* rowp = gates + (size_t)row * 4096 + gcol;
#pragma unroll
                for (int bj = 0; bj < 2; ++bj) { unsigned q[8];
#pragma unroll
                    for (int n = 0; n < 2; ++n)
#pragma unroll
                        for (int e = 0; e < 4; ++e) { const float pre = (float)acc[ai][bj][m][n][e] * (rs * sv[bj][n][e]) + bv[bj][n][e];
                            q[4 * n + e] = (unsigned)__builtin_rintf(255.f * sigmoidf_(pre)); }
                    u32x2 w; w.x = q[0] | (q[1] << 8) | (q[2] << 16) | (q[3] << 24); w.y = q[4] | (q[5] << 8) | (q[6] << 16) | (q[7] << 24);
                    *(u32x2*)(rowp + bj * 128) = w; }
                __builtin_amdgcn_sched_barrier(0); }
    }
};
struct EpiP3a {
    bf16* merged; const unsigned char* gates;
    DI void operator()(const f32x4 (&acc)[2][2][4][2], const Unit& u, int wr, int wc, int fr, int fq) const {
        const int br = u.aux;
        const GAS unsigned char* gb = (const GAS unsigned char*)gates + ((size_t)(u.pm * 256) * 4096 + br * 1024 + u.pn * 256);
        GAS unsigned char* mb = (GAS unsigned char*)merged + ((size_t)(u.pm * 256) * 1024 + u.pn * 256) * 2;
        const unsigned go = (unsigned)((wr * 64 + fr) * 4096 + wc * 32 + 8 * fq), mo = (unsigned)((wr * 64 + fr) * 1024 + wc * 32 + 8 * fq) * 2u;
#pragma unroll
        for (int ai = 0; ai < 2; ++ai) {
            u32x2 gw[4][2]; u32x4 mw[4][2];
#pragma unroll
            for (int m = 0; m < 4; ++m)
#pragma unroll
                for (int bj = 0; bj < 2; ++bj) { gw[m][bj] = *(const GAS u32x2*)(gb + go + (unsigned)((ai * 128 + m * 16) * 4096 + bj * 128));
                    if (br != 0) mw[m][bj] = *(const GAS u32x4*)(mb + mo + (unsigned)((ai * 128 + m * 16) * 1024 + bj * 128) * 2u); }
#pragma unroll
            for (int m = 0; m < 4; ++m)
#pragma unroll
                for (int bj = 0; bj < 2; ++bj) {
                    f32x4 v0 = acc[ai][bj][m][0], v1 = acc[ai][bj][m][1]; const u32x2 g2 = gw[m][bj]; const float k255 = 0.00392156862745098f;
                    v0[0] *= (float)(g2.x & 255u) * k255; v0[1] *= (float)((g2.x >> 8) & 255u) * k255; v0[2] *= (float)((g2.x >> 16) & 255u) * k255; v0[3] *= (float)(g2.x >> 24) * k255;
                    v1[0] *= (float)(g2.y & 255u) * k255; v1[1] *= (float)((g2.y >> 8) & 255u) * k255; v1[2] *= (float)((g2.y >> 16) & 255u) * k255; v1[3] *= (float)(g2.y >> 24) * k255;
                    if (br != 0) { const u32x4 m4 = mw[m][bj];
                        v0[0] += lo_bf(m4.x); v0[1] += hi_bf(m4.x); v0[2] += lo_bf(m4.y); v0[3] += hi_bf(m4.y);
                        v1[0] += lo_bf(m4.z); v1[1] += hi_bf(m4.z); v1[2] += lo_bf(m4.w); v1[3] += hi_bf(m4.w); }
                    *(GAS u32x4*)(mb + mo + (unsigned)((ai * 128 + m * 16) * 1024 + bj * 128) * 2u) = pack8(v0, v1); }
            __builtin_amdgcn_sched_barrier(0); }
    }
};
struct EpiP3b {
    const float* xin; float* out;
    DI void operator()(const f32x4 (&acc)[2][2][4][2], const Unit& u, int wr, int wc, int fr, int fq) const {
        const GAS unsigned char* xb = (const GAS unsigned char*)xin + ((size_t)(u.pm * 256) * 1024 + u.pn * 256) * 4; GAS unsigned char* ob = (GAS unsigned char*)out + ((size_t)(u.pm * 256) * 1024 + u.pn * 256) * 4;
        const unsigned lo = (unsigned)((wr * 64 + fr) * 1024 + wc * 32 + 8 * fq) * 4u;
#pragma unroll
        for (int ai = 0; ai < 2; ++ai)
#pragma unroll
            for (int mh = 0; mh < 2; ++mh) {
                f32x4 xv[2][2][2];
#pragma unroll
                for (int m2 = 0; m2 < 2; ++m2)
#pragma unroll
                    for (int bj = 0; bj < 2; ++bj)
#pragma unroll
                        for (int n = 0; n < 2; ++n) xv[m2][bj][n] = *(const GAS f32x4*)(xb + lo + (unsigned)((ai * 128 + (mh * 2 + m2) * 16) * 1024 + bj * 128 + 4 * n) * 4u);
#pragma unroll
                for (int m2 = 0; m2 < 2; ++m2)
#pragma unroll
                    for (int bj = 0; bj < 2; ++bj)
#pragma unroll
                        for (int n = 0; n < 2; ++n) *(GAS f32x4*)(ob + lo + (unsigned)((ai * 128 + (mh * 2 + m2) * 16) * 1024 + bj * 128 + 4 * n) * 4u) = xv[m2][bj][n] + acc[ai][bj][mh * 2 + m2][n];
                __builtin_amdgcn_sched_barrier(0); }
    }
};
struct EpiM2 {
    bf16* hmid;
    DI void operator()(const f32x4 (&acc)[2][2][4][2], const Unit& u, int wr, int wc, int fr, int fq) const {
        const int row0 = u.pm * 256 + wr * 64 + fr; const int col = u.pn * 128 + wc * 32 + 8 * fq;
#pragma unroll
        for (int ai = 0; ai < 2; ++ai)
#pragma unroll
            for (int m = 0; m < 4; ++m) { f32x4 h0, h1;
#pragma unroll
                for (int e = 0; e < 4; ++e) { const float g0 = acc[ai][0][m][0][e], g1 = acc[ai][0][m][1][e];
                    h0[e] = g0 * sigmoidf_(g0) * acc[ai][1][m][0][e]; h1[e] = g1 * sigmoidf_(g1) * acc[ai][1][m][1][e]; }
                *(u32x4*)(hmid + (size_t)(row0 + ai * 128 + m * 16) * 256 + col) = pack8(h0, h1); }
    }
};
struct EpiM3 {
    bf16* eo; const int* rowtok; const float* roww;
    DI void operator()(const f32x4 (&acc)[2][2][4][2], const Unit& u, int wr, int wc, int fr, int fq) const {
        const int row0 = u.pm * 256 + wr * 64 + fr; const int colt = u.pn * 256 + wc * 32 + 8 * fq;
        int tk[2][4]; float wv[2][4];
#pragma unroll
        for (int ai = 0; ai < 2; ++ai)
#pragma unroll
            for (int m = 0; m < 4; ++m) { tk[ai][m] = ((const GAS int*)rowtok)[row0 + ai * 128 + m * 16]; wv[ai][m] = ((const GAS float*)roww)[row0 + ai * 128 + m * 16]; }
#pragma unroll
        for (int ai = 0; ai < 2; ++ai)
#pragma unroll
            for (int m = 0; m < 4; ++m) {
                if (tk[ai][m] >= 0) { const float w = wv[ai][m]; GAS bf16* op = (GAS bf16*)eo + (size_t)tk[ai][m] * 1024 + colt;
#pragma unroll
                    for (int bj = 0; bj < 2; ++bj) *(GAS u32x4*)(op + bj * 128) = pack8(acc[ai][bj][m][0] * w, acc[ai][bj][m][1] * w); }
                __builtin_amdgcn_sched_barrier(0); }
    }
};

struct Args { const float* in[36]; float* out; unsigned char* ws; int ph_lo, ph_hi; };
struct InTab { unsigned base;
    DI const float* operator[](int i) const { unsigned long long v; const unsigned addr = base + (unsigned)i * 8u;
        asm volatile("ds_read_b64 %0, %1\n\ts_waitcnt lgkmcnt(0)" : "=v"(v) : "v"(addr) : "memory");
        const unsigned lo = __builtin_amdgcn_readfirstlane((unsigned)v), hi = __builtin_amdgcn_readfirstlane((unsigned)(v >> 32));
        return (const float*)(((unsigned long long)hi << 32) | lo); } };
struct KA { InTab in; float* out; unsigned char* ws; };

DI void transpose_item(const float* W_, int ldw, int nvalid, bf16* WT_, int ldt, int k0, int n0, int dst_row0, LAS float* scr, int lane) {
    const GAS float* W = (const GAS float*)W_; GAS bf16* WT = (GAS bf16*)WT_;
    const int nq = 4 * (lane & 7), kr8 = lane >> 3;
    f32x4 v[8];
#pragma unroll
    for (int i = 0; i < 8; ++i) { const int kk = 8 * i + kr8;
        if (n0 + nq + 3 < nvalid) v[i] = *(const GAS f32x4*)(W + (size_t)(k0 + kk) * ldw + n0 + nq);
        else {
#pragma unroll
            for (int e = 0; e < 4; ++e) v[i][e] = (n0 + nq + e < nvalid) ? W[(size_t)(k0 + kk) * ldw + n0 + nq + e] : 0.f; } }
#pragma unroll
    for (int i = 0; i < 8; ++i) { const int kk = 8 * i + kr8;
#pragma unroll
        for (int e = 0; e < 4; ++e) scr[kk * 33 + nq + e] = v[i][e]; }
    LDS_WAIT(); asm volatile("" ::: "memory");
    const int c = lane & 7;
#pragma unroll
    for (int j = 0; j < 4; ++j) { const int n = (lane >> 3) + 8 * j; const LAS float* s = scr + (8 * c) * 33 + n;
        u32x4 o; o.x = pk2(s[0 * 33], s[1 * 33]); o.y = pk2(s[2 * 33], s[3 * 33]); o.z = pk2(s[4 * 33], s[5 * 33]); o.w = pk2(s[6 * 33], s[7 * 33]);
        if (n0 + n < nvalid) *(GAS u32x4*)(WT + (size_t)(dst_row0 + n) * ldt + k0 + 8 * c) = o; }
    LDS_WAIT(); asm volatile("" ::: "memory");
}
DI void phase0_weights(const KA& a, int l, LAS unsigned char* lds, int gw, int NGW, int wave, int lane) {
    LAS float* scr = (LAS float*)(lds + wave * 16384);
    const float* w_in = a.in[4] + (size_t)l * 1024 * NIN;
    const float* w_gate = a.in[24] + (size_t)l * 4 * 1024 * 1024;
    const float* w_br = a.in[26] + (size_t)l * 4 * 256 * 1024;
    const float* w_out = a.in[27] + (size_t)l * 1024 * 1024;
    bf16* Wt_in = (bf16*)(a.ws + WS_WIN); bf16* Wt_br = (bf16*)(a.ws + WS_WBR); bf16* Wt_out = (bf16*)(a.ws + WS_WOUT);
    constexpr int I_B = 4 * 4 * 32, I_O = 16 * 32, NIT = I_B + I_O;
    (void)w_gate; (void)w_in; (void)Wt_in;
    for (int it = gw; it < NIT; it += NGW) {
        int r = it;
        if (r < I_B) { const int br = r / 128, q = r % 128, kb = q / 32, nb = q % 32; transpose_item(w_br + (size_t)br * 256 * 1024, 1024, 1024, Wt_br + (size_t)br * 1024 * 256, 256, kb * 64, nb * 32, nb * 32, scr, lane); continue; } r -= I_B;
        { const int kb = r / 32, nb = r % 32; transpose_item(w_out, 1024, 1024, Wt_out, 1024, kb * 64, nb * 32, nb * 32, scr, lane); }
    }
}
DI void p1_weights_i8(const KA& a, int l, LAS unsigned char* lds, int gw, int NGW, int wave, int lane) {
    LAS float* scr = (LAS float*)(lds + wave * 16384);
    const GAS float* wgt = (const GAS float*)(a.in[24] + (size_t)l * 4 * 1024 * 1024); const GAS float* win = (const GAS float*)(a.in[4] + (size_t)l * 1024 * NIN);
    GAS unsigned char* Wq = (GAS unsigned char*)(a.ws + WS_WQ); GAS float* wsc = (GAS float*)(a.ws + WS_WSC);
    const int nq = 4 * (lane & 7), kr8 = lane >> 3;
    for (int it = NGW - 1 - gw; it < 128 + 77; it += NGW) {
        const bool isg = it < 128; const int br = it >> 5; const int n0 = isg ? (it & 31) * 32 : (it - 128) * 32;
        const int ldw = isg ? 1024 : NIN; const int nval = isg ? 1024 : NIN; const int drow0 = isg ? 2560 + br * 1024 + n0 : n0;
        const bool lok = (n0 + nq) < nval;
        const GAS float* W = (isg ? wgt + (size_t)br * 1024 * 1024 : win) + n0 + nq;
        f32x4 mx = {0.f, 0.f, 0.f, 0.f};
#pragma unroll 8
        for (int i = 0; i < 128; ++i) { f32x4 v = {0.f, 0.f, 0.f, 0.f}; if (lok) v = *(const GAS f32x4*)(W + (size_t)(8 * i + kr8) * ldw);
            mx[0] = fmaxf(mx[0], fabsf(v[0])); mx[1] = fmaxf(mx[1], fabsf(v[1])); mx[2] = fmaxf(mx[2], fabsf(v[2])); mx[3] = fmaxf(mx[3], fabsf(v[3])); }
#pragma unroll
        for (int e = 0; e < 4; ++e) { float m = mx[e]; m = fmaxf(m, xshfl<8>(m)); m = fmaxf(m, xshfl<16>(m)); m = fmaxf(m, xshfl<32>(m)); mx[e] = fmaxf(m, 1e-20f); }
        if (kr8 == 0 && lok) *(GAS f32x4*)(wsc + drow0 + nq) = mx * (1.f / 127.f);
        const f32x4 qs = {127.f / mx[0], 127.f / mx[1], 127.f / mx[2], 127.f / mx[3]};
#pragma unroll 1
        for (int kb = 0; kb < 16; ++kb) {
            f32x4 v[8];
#pragma unroll
            for (int i = 0; i < 8; ++i) { v[i] = (f32x4){0.f, 0.f, 0.f, 0.f}; if (lok) v[i] = *(const GAS f32x4*)(W + (size_t)(kb * 64 + 8 * i + kr8) * ldw); }
#pragma unroll
            for (int i = 0; i < 8; ++i) { const int kk = 8 * i + kr8;
#pragma unroll
                for (int e = 0; e < 4; ++e) scr[kk * 33 + nq + e] = __builtin_rintf(v[i][e] * qs[e]); }
            LDS_WAIT(); asm volatile("" ::: "memory");
            const int n = lane >> 1, kh = lane & 1; u32x4 o[2];
#pragma unroll
            for (int h2 = 0; h2 < 2; ++h2) { unsigned w4[4];
#pragma unroll
                for (int d = 0; d < 4; ++d) { unsigned wv = 0u;
#pragma unroll
                    for (int e = 0; e < 4; ++e) wv |= ((unsigned)(int)scr[(32 * kh + 16 * h2 + 4 * d + e) * 33 + n] & 255u) << (8 * e);
                    w4[d] = wv; }
                o[h2].x = w4[0]; o[h2].y = w4[1]; o[h2].z = w4[2]; o[h2].w = w4[3]; }
            if (n0 + n < nval) { GAS unsigned char* dst = Wq + (size_t)(drow0 + n) * 1024 + kb * 64 + 32 * kh; *(GAS u32x4*)dst = o[0]; *(GAS u32x4*)(dst + 16) = o[1]; }
            LDS_WAIT(); asm volatile("" ::: "memory");
        }
    }
}

DI void router_weights(const KA& a, int l, int gw, int NGW, int lane) {
    bf16* Wr = (bf16*)(a.ws + WS_WR);
    const float* wg = a.in[29] + (size_t)l * 1024 * 4; const float* we = a.in[31] + (size_t)l * 1024 * 32;
    for (int n = gw; n < 36; n += NGW) {
        for (int i = 0; i < 16; ++i) { const int k = lane + 64 * i; const float w = (n < 4) ? wg[k * 4 + n] : we[k * 32 + (n - 4)];
            const unsigned hi = f2bf(w); const float hf = __builtin_bit_cast(float, hi << 16); const unsigned lo = f2bf(w - hf);
            Wr[(size_t)n * 2048 + k] = (bf16)hi; Wr[(size_t)n * 2048 + 1024 + k] = (bf16)hi; Wr[(size_t)(64 + n) * 2048 + k] = (bf16)lo; Wr[(size_t)(64 + n) * 2048 + 1024 + k] = 0; }
    }
}

DI void cmp_weights(const KA& a, int l, LAS unsigned char* lds, int gw, int NGW, int wave, int lane) {
    LAS float* scr = (LAS float*)(lds + wave * 16384);
    bf16* Wc = (bf16*)(a.ws + WS_WCMP); float* pt = (float*)(a.ws + WS_CMPAB + 2 * MiB);
    for (int it = gw; it < 128 + 64; it += NGW) {
        if (it < 128) { const int kv = it >> 6, q = it & 63, kb = q >> 1, nb = q & 1; const float* w1 = a.in[kv ? 22 : 19] + (size_t)l * 2048 * 64;
            bf16* dst = Wc + (size_t)kv * 256 * 1024 - (kb >= 16 ? 1024 : 0);
            transpose_item(w1, 64, 64, dst, 1024, kb * 64, nb * 32, (kb >= 16 ? 64 : 0) + nb * 32, scr, lane);
        } else { const int kv = (it - 128) >> 5, part = (it - 128) & 31;
            const GAS float* w1 = (const GAS float*)(a.in[kv ? 22 : 19] + (size_t)l * 2048 * 64) + (size_t)part * 64 * 64; const GAS float* pos = (const GAS float*)(a.in[kv ? 21 : 18] + (size_t)l * 2048) + part * 64;
            float acc = 0.f;
#pragma unroll 16
            for (int k = 0; k < 64; ++k) acc += pos[k] * w1[(size_t)k * 64 + lane];
            pt[(kv * 32 + part) * 64 + lane] = acc; }
    }
}

DI void lru_weights(const KA& a, int l, int gw, int NGW, int lane) {
    bf16* W = (bf16*)(a.ws + WS_LRUW); const float* wa = a.in[7] + (size_t)l * 4 * 4096; const float* wx = a.in[9] + (size_t)l * 4 * 4096;
    (void)NGW; { const int idx = gw * 64 + lane; if (idx < 32768) { const int i = idx & 63, j = (idx >> 6) & 63, mat = (idx >> 12) & 1, hbk = idx >> 13;
        W[idx] = (bf16)f2bf((mat ? wx : wa)[(size_t)hbk * 4096 + i * 64 + j]); } }
}
DI void phase0_rows(const KA& a, int l, int mode, int gw, int NGW, int lane) {
    const GAS float* xin = (const GAS float*)((l == 0) ? a.in[0] : a.out);
    const GAS bf16* eo = (const GAS bf16*)(a.ws + WS_PROJ);
    GAS bf16* hb = (GAS bf16*)(a.ws + WS_HB); GAS float* outp = (GAS float*)a.out;
    const GAS float* g = (const GAS float*)(mode ? a.in[2] : (a.in[3] + (size_t)l * 1024));
    f32x4 gv[4];
#pragma unroll
    for (int j = 0; j < 4; ++j) gv[j] = *(const GAS f32x4*)(g + 4 * (lane + 64 * j));
    for (int m0 = gw * 4; m0 < T; m0 += NGW * 4) {
        f32x4 v[4][4]; float ss[4];
#pragma unroll
        for (int rr = 0; rr < 4; ++rr)
#pragma unroll
            for (int j = 0; j < 4; ++j) v[rr][j] = *(const GAS f32x4*)(xin + (size_t)(m0 + rr) * 1024 + 4 * (lane + 64 * j));
        if (l > 0) {
#pragma unroll
            for (int rr = 0; rr < 4; ++rr)
#pragma unroll
                for (int j = 0; j < 4; ++j) {
                    const u32x2 e0 = *(const GAS u32x2*)(eo + (size_t)(2 * (m0 + rr)) * 1024 + 4 * (lane + 64 * j));
                    const u32x2 e1 = *(const GAS u32x2*)(eo + (size_t)(2 * (m0 + rr) + 1) * 1024 + 4 * (lane + 64 * j));
                    v[rr][j][0] += lo_bf(e0.x) + lo_bf(e1.x); v[rr][j][1] += hi_bf(e0.x) + hi_bf(e1.x); v[rr][j][2] += lo_bf(e0.y) + lo_bf(e1.y); v[rr][j][3] += hi_bf(e0.y) + hi_bf(e1.y); } }
#pragma unroll
        for (int rr = 0; rr < 4; ++rr) { float t = 0.f;
#pragma unroll
            for (int j = 0; j < 4; ++j) t += (v[rr][j][0] * v[rr][j][0] + v[rr][j][1] * v[rr][j][1]) + (v[rr][j][2] * v[rr][j][2] + v[rr][j][3] * v[rr][j][3]);
            ss[rr] = t; }
#pragma unroll
        for (int rr = 0; rr < 4; ++rr) ss[rr] = wave_sum(ss[rr]);
        if (mode) {
#pragma unroll
            for (int rr = 0; rr < 4; ++rr) { const float r = 1.f / sqrtf(ss[rr] * (1.f / 1024.f) + 1e-6f); const size_t m = (size_t)(m0 + rr);
#pragma unroll
                for (int j = 0; j < 4; ++j) *(GAS f32x4*)(outp + m * 1024 + 4 * (lane + 64 * j)) = v[rr][j] * r * gv[j]; }
        } else {
            GAS unsigned char* hq = (GAS unsigned char*)(a.ws + WS_HQ); GAS float* hsc = (GAS float*)(a.ws + WS_HSC);
            float am[4];
#pragma unroll
            for (int rr = 0; rr < 4; ++rr) { const float r = 1.f / sqrtf(ss[rr] * (1.f / 1024.f) + 1e-6f); const size_t m = (size_t)(m0 + rr); float t = 0.f;
#pragma unroll
                for (int j = 0; j < 4; ++j) { if (l > 0) *(GAS f32x4*)(outp + m * 1024 + 4 * (lane + 64 * j)) = v[rr][j];
                    const f32x4 y = v[rr][j] * r * gv[j]; v[rr][j] = y;
                    t = fmaxf(t, fmaxf(fmaxf(fabsf(y[0]), fabsf(y[1])), fmaxf(fabsf(y[2]), fabsf(y[3])))); }
                am[rr] = t; }
#pragma unroll
            for (int rr = 0; rr < 4; ++rr) am[rr] = fmaxf(wave_max(am[rr]), 1e-20f);
#pragma unroll
            for (int rr = 0; rr < 4; ++rr) { const size_t m = (size_t)(m0 + rr); const float qs = 127.f / am[rr];
                if (lane == 0) hsc[m] = am[rr] * (1.f / 127.f);
#pragma unroll
                for (int j = 0; j < 4; ++j) { const f32x4 y = v[rr][j] * qs;
                    const unsigned q = ((unsigned)(int)__builtin_rintf(y[0]) & 255u) | (((unsigned)(int)__builtin_rintf(y[1]) & 255u) << 8) | (((unsigned)(int)__builtin_rintf(y[2]) & 255u) << 16) | (((unsigned)(int)__builtin_rintf(y[3]) & 255u) << 24);
                    *(GAS unsigned*)(hq + m * 1024 + 4 * (lane + 64 * j)) = q; } }
        }
    }
}

DI int crow(int i, int hh) { return (i & 3) + 8 * (i >> 2) + 4 * hh; }
DI unsigned cvtpk(float lo, float hi) { f32x2 v = {lo, hi}; bf16x2_t b = __builtin_convertvector(v, bf16x2_t); return __builtin_bit_cast(unsigned, b); }
template <int CTRL, int RMASK> DI float dppf(float oldv, float v) { return __builtin_bit_cast(float, __builtin_amdgcn_update_dpp(__builtin_bit_cast(int, oldv), __builtin_bit_cast(int, v), CTRL, RMASK, 0xf, false)); }
template <int CTRL, int RMASK> DI void scan_step(float& a, float& b) {
    const float ap = dppf<CTRL, RMASK>(1.f, a), bp = dppf<CTRL, RMASK>(0.f, b); b = a * bp + b; a = a * ap; }
DI void lru_unit(const KA& a, int l, const GAS bf16* proj, GAS bf16* ys, GAS float* sums, LAS unsigned char* lds, int task, int lane_in, int wave_in, bool final) {
    int lane = lane_in, wave = wave_in; asm volatile("" : "+v"(lane), "+s"(wave));
    const int chunk = task & 31, hbk = (task >> 5) & 3, b = task >> 7;
    const int ts = chunk * 256 + wave * 32; const size_t rowb = (size_t)b * SEQ;
    LAS unsigned char* wl = lds + wave * 16384;
    LAS float* ex = (LAS float*)(lds + LRUEX_OFF); LAS float* cst = (LAS float*)(lds + LRUCST_OFF); LAS float* car = (LAS float*)(lds + LRUCAR_OFF) + wave * 64;
    {
        const int c = hbk * 64 + lane;
        const GAS float* cw = (const GAS float*)(a.in[5] + (size_t)l * 4 * 256);
        const float cw0 = cw[c], cw1 = cw[256 + c], cw2 = cw[512 + c], cw3 = cw[768 + c]; const float cb = a.in[6][l * 256 + c];
        if (wave == 0) { cst[lane] = a.in[8][l * 256 + c]; cst[64 + lane] = a.in[10][l * 256 + c]; cst[128 + lane] = -8.f * softplusf_(-a.in[11][l * 256 + c]); }
        const GAS bf16* xp = proj + (rowb + ts) * PLD + C_AX + c;
        float x3 = (ts >= 3) ? bf2f(*(xp - 3 * PLD)) : 0.f, x2 = (ts >= 2) ? bf2f(*(xp - 2 * PLD)) : 0.f, x1 = (ts >= 1) ? bf2f(*(xp - PLD)) : 0.f;
#pragma unroll 8
        for (int n = 0; n < 32; ++n) { const float x0 = bf2f(xp[(size_t)n * PLD]); const float xc = cb + cw0 * x3 + cw1 * x2 + cw2 * x1 + cw3 * x0;
            *(LAS bf16*)(wl + n * 144 + lane * 2) = (bf16)f2bf(xc); *(LAS float*)(wl + 4608 + n * 272 + lane * 4) = xc; x3 = x2; x2 = x1; x1 = x0; }
    }
    const int n = lane & 31, hh = lane >> 5;
    f32x16 D[4];
    {
        const GAS bf16* wt = (const GAS bf16*)(a.ws + WS_LRUW) + (size_t)hbk * 8192;
        bf16x8 bfr[4];
        LDS_WAIT();
#pragma unroll
        for (int s4 = 0; s4 < 4; ++s4) bfr[s4] = *(const LAS bf16x8*)(wl + n * 144 + hh * 16 + s4 * 32);
#pragma unroll
        for (int m = 0; m < 4; ++m) {
#pragma unroll
            for (int s4 = 0; s4 < 4; ++s4) { const bf16x8 af = *(const GAS bf16x8*)(wt + (size_t)(m >> 1) * 4096 + (32 * (m & 1) + n) * 64 + 8 * hh + 16 * s4);
                if (s4 == 0) { f32x16 z;
#pragma unroll
                    for (int i = 0; i < 16; ++i) z[i] = 0.f;
                    D[m] = MFMA32(af, bfr[s4], z); } else D[m] = MFMA32(af, bfr[s4], D[m]); } }
    }
    __syncthreads();
    const bool t0 = (ts + n) == 0;
#pragma unroll
    for (int mm = 0; mm < 2; ++mm)
#pragma unroll
        for (int g4 = 0; g4 < 4; ++g4) { const int c0 = 32 * mm + 8 * g4 + 4 * hh;
            const f32x4 vba = *(const LAS f32x4*)(cst + c0), vbx = *(const LAS f32x4*)(cst + 64 + c0), vc8 = *(const LAS f32x4*)(cst + 128 + c0);
            const f32x4 vxc = *(const LAS f32x4*)(wl + 4608 + n * 272 + c0 * 4);
#pragma unroll
            for (int e = 0; e < 4; ++e) { const int i = 4 * g4 + e;
                const float r = sigmoidf_(D[mm][i] + vba[e]), ig = sigmoidf_(D[2 + mm][i] + vbx[e]);
                const float la = vc8[e] * r; const float av = __expf(la);
                const float mult = t0 ? 1.f : sqrtf(fmaxf(1.f - __expf(2.f * la), 0.f));
                float aa = av, bb = mult * ig * vxc[e];
                scan_step<0x111, 0xf>(aa, bb); scan_step<0x112, 0xf>(aa, bb); scan_step<0x114, 0xf>(aa, bb); scan_step<0x118, 0xf>(aa, bb); scan_step<0x142, 0xa>(aa, bb);
                D[mm][i] = aa; D[2 + mm][i] = bb; } }
    if (n == 31) {
#pragma unroll
        for (int mm = 0; mm < 2; ++mm)
#pragma unroll
            for (int i = 0; i < 16; ++i) { const int c = 32 * mm + crow(i, hh); ex[(wave * 64 + c) * 2] = D[mm][i]; ex[(wave * 64 + c) * 2 + 1] = D[2 + mm][i]; } }
    __syncthreads();
    if (!final) {
        if (wave == 0) { float hv = 0.f, av = 1.f;
#pragma unroll
            for (int w = 0; w < 8; ++w) { const float A_ = ex[(w * 64 + lane) * 2], H_ = ex[(w * 64 + lane) * 2 + 1]; hv = A_ * hv + H_; av *= A_; }
            GAS float* sp = sums + ((size_t)((b * 4 + hbk) * 32 + chunk) * 64 + lane) * 2; sp[0] = av; sp[1] = hv; }
    } else {
        {   float hv = 0.f;
            {   const GAS f32x2* sp = (const GAS f32x2*)(sums + ((size_t)((b * 4 + hbk) * 32) * 64 + lane) * 2);
                int cc = 0;
                for (; cc + 8 <= chunk; cc += 8) { f32x2 v[8];
#pragma unroll
                    for (int e = 0; e < 8; ++e) v[e] = sp[(size_t)(cc + e) * 64];
#pragma unroll
                    for (int e = 0; e < 8; ++e) hv = v[e][0] * hv + v[e][1]; }
                for (; cc < chunk; ++cc) { const f32x2 v = sp[(size_t)cc * 64]; hv = v[0] * hv + v[1]; } }
            for (int w = 0; w < wave; ++w) { const float A_ = ex[(w * 64 + lane) * 2], H_ = ex[(w * 64 + lane) * 2 + 1]; hv = A_ * hv + H_; }
            car[lane] = hv; }
        LDS_WAIT(); asm volatile("" ::: "memory");
        const GAS bf16* gp = proj + (rowb + ts + n) * PLD + C_AG + hbk * 64; GAS bf16* yp = ys + (rowb + ts + n) * 1024 + hbk * 64;
#pragma unroll
        for (int mm = 0; mm < 2; ++mm)
#pragma unroll
            for (int g4 = 0; g4 < 4; ++g4) { const int c0 = 32 * mm + 8 * g4 + 4 * hh; const f32x4 cv = *(const LAS f32x4*)(car + c0);
                const u32x2 gt2 = *(const GAS u32x2*)(gp + c0); float y[4];
#pragma unroll
                for (int e = 0; e < 4; ++e) { const int i = 4 * g4 + e; const float hv = D[2 + mm][i] + D[mm][i] * cv[e];
                    const float gt = (e == 0) ? lo_bf(gt2.x) : (e == 1) ? hi_bf(gt2.x) : (e == 2) ? lo_bf(gt2.y) : hi_bf(gt2.y); y[e] = hv * gelu_tanh(gt); }
                u32x2 yo; yo.x = cvtpk(y[0], y[1]); yo.y = cvtpk(y[2], y[3]); *(GAS u32x2*)(yp + c0) = yo; }
    }
    __syncthreads();
}

constexpr int DK_STR = 144, DV_STR = 192, DBUF_BYTES = 64 * DK_STR + 64 * DV_STR;
DI bf16x8 pack_half(const f32x16& x, int s2) { u32x4 p;
    if (s2 == 0) { p.x = cvtpk(x[0], x[1]); p.y = cvtpk(x[2], x[3]); p.z = cvtpk(x[4], x[5]); p.w = cvtpk(x[6], x[7]); }
    else { p.x = cvtpk(x[8], x[9]); p.y = cvtpk(x[10], x[11]); p.z = cvtpk(x[12], x[13]); p.w = cvtpk(x[14], x[15]); }
    return __builtin_bit_cast(bf16x8, p); }
DI s16x4 vtr(const LAS unsigned char* p) { return __builtin_bit_cast(s16x4, __builtin_amdgcn_ds_read_tr16_b64_v4i16((LAS v4i16_t*)p)); }
DI float max16(const f32x16& x) { float a = fmaxf(fmaxf(x[0], x[1]), fmaxf(x[2], x[3])), b = fmaxf(fmaxf(x[4], x[5]), fmaxf(x[6], x[7])), c = fmaxf(fmaxf(x[8], x[9]), fmaxf(x[10], x[11])), d = fmaxf(fmaxf(x[12], x[13]), fmaxf(x[14], x[15])); return fmaxf(fmaxf(a, b), fmaxf(c, d)); }
DI void diff_unit(const GAS bf16* proj, GAS bf16* ys, LAS unsigned char* lds, const LAS float* bias2, const GAS float* subg, const LAS float* lamp, int b, int h, int qb, int wave_in) {
    int wave = wave_in; asm volatile("" : "+s"(wave)); const int lane = my_lane(); const int tid = wave * 64 + lane;
    const int q0 = qb * 256 + wave * 32; const int ql = lane & 31, hh = lane >> 5; const int q = q0 + ql;
    const size_t rowb = (size_t)b * SEQ;
    const float SC = 0.17677669529663687f * 1.4426950408889634f;
    bf16x8 qf[2][2];
    { const GAS bf16* qp = proj + (rowb + q) * PLD + C_CQ + h * 64 + hh * 8;
#pragma unroll
      for (int m = 0; m < 2; ++m)
#pragma unroll
        for (int s = 0; s < 2; ++s) { const u32x4 w = *(const GAS u32x4*)(qp + m * 32 + s * 16); u32x4 o;
            o.x = cvtpk(lo_bf(w.x) * SC, hi_bf(w.x) * SC); o.y = cvtpk(lo_bf(w.y) * SC, hi_bf(w.y) * SC); o.z = cvtpk(lo_bf(w.z) * SC, hi_bf(w.z) * SC); o.w = cvtpk(lo_bf(w.w) * SC, hi_bf(w.w) * SC);
            qf[m][s] = __builtin_bit_cast(bf16x8, o); } }
    f32x16 O[2][2], negm[2];
#pragma unroll
    for (int i = 0; i < 16; ++i) { O[0][0][i] = 0.f; O[0][1][i] = 0.f; O[1][0][i] = 0.f; O[1][1][i] = 0.f; negm[0][i] = 120.f; negm[1][i] = 120.f; }
    float lsum[2] = {0.f, 0.f};
    const int nsteps = 4 * qb + 4, mysteps = 4 * qb + (wave >> 1) + 1;
    const int skey = tid >> 3, sch = tid & 7;
    const GAS unsigned char* kgb = (const GAS unsigned char*)(proj + rowb * PLD + C_CK + h * 64);
    const GAS unsigned char* vgb = (const GAS unsigned char*)(proj + rowb * PLD + C_CV + h * 64);
    const unsigned soff = (unsigned)(skey * PLD + sch * 8) * 2u;
    u32x4 kr = *(const GAS u32x4*)(kgb + soff), vr = *(const GAS u32x4*)(vgb + soff);
    *(LAS u32x4*)(lds + skey * DK_STR + sch * 16) = kr; *(LAS u32x4*)(lds + 64 * DK_STR + skey * DV_STR + sch * 16) = vr;
    __syncthreads();
    const int i16 = lane & 15, blk = (lane >> 4) & 1;
    const int kboff = ql * DK_STR + hh * 16;
    const int vboff = 64 * DK_STR + (4 * hh + (i16 >> 2)) * DV_STR + (16 * blk + 4 * (i16 & 3)) * 2;
#pragma unroll 1
    for (int kt = 0; kt < nsteps; ++kt) {
        const LAS unsigned char* cur = lds + (kt & 1) * DBUF_BYTES; LAS unsigned char* nxt = lds + ((kt + 1) & 1) * DBUF_BYTES;
        if (kt + 1 < nsteps) { const unsigned so = soff + (unsigned)(kt + 1) * (64u * PLD * 2u); kr = *(const GAS u32x4*)(kgb + so); vr = *(const GAS u32x4*)(vgb + so); }
        if (kt < mysteps) {
            const int kbase = kt * 64;
            const bool near = (q0 - (kbase + 63) < 113);
#pragma unroll
            for (int m = 0; m < 2; ++m) {
                bf16x8 pk[2][2];
                f32x16 S[2]; float ts = 0.f;
                {   bf16x8 kf[2][2];
#pragma unroll
                    for (int t = 0; t < 2; ++t)
#pragma unroll
                        for (int s = 0; s < 2; ++s) kf[t][s] = *(const LAS bf16x8*)(cur + kboff + t * 32 * DK_STR + m * 64 + s * 32);
#pragma unroll
                    for (int t = 0; t < 2; ++t) { S[t] = MFMA32(kf[t][0], qf[m][0], negm[m]); S[t] = MFMA32(kf[t][1], qf[m][1], S[t]); } }
                if (near) {
#pragma unroll
                    for (int t = 0; t < 2; ++t)
#pragma unroll
                        for (int i = 0; i < 16; ++i) { const int dist = q - (kbase + 32 * t + crow(i, hh)); const int di = dist < 128 ? dist : 128;
                            const float bv = dist >= 0 ? bias2[di * 12 + 4 + h] : -1e30f; S[t][i] += bv; } }
#pragma unroll
                for (int t = 0; t < 2; ++t)
#pragma unroll
                    for (int i = 0; i < 16; ++i) { const float p = __builtin_amdgcn_exp2f(S[t][i]); S[t][i] = p; ts += p; }
                if (__builtin_amdgcn_ballot_w64(!(ts < 1.0e30f)) != 0ull) {
                {   bf16x8 kf[2][2];
#pragma unroll
                        for (int t = 0; t < 2; ++t)
#pragma unroll
                            for (int s = 0; s < 2; ++s) kf[t][s] = *(const LAS bf16x8*)(cur + kboff + t * 32 * DK_STR + m * 64 + s * 32);
#pragma unroll
                        for (int t = 0; t < 2; ++t) { S[t] = MFMA32(kf[t][0], qf[m][0], negm[m]); S[t] = MFMA32(kf[t][1], qf[m][1], S[t]); } }
                    if (near) {
#pragma unroll
                        for (int t = 0; t < 2; ++t)
#pragma unroll
                            for (int i = 0; i < 16; ++i) { const int dist = q - (kbase + 32 * t + crow(i, hh)); const int di = dist < 128 ? dist : 128;
                                const float bv = dist >= 0 ? bias2[di * 12 + 4 + h] : -1e30f; S[t][i] += bv; } }
                    float tm = fmaxf(max16(S[0]), max16(S[1])); tm = fmaxf(tm, xshfl<32>(tm));
                    const float sh = fmaxf(tm, 0.f); const float al = __builtin_amdgcn_exp2f(-sh);
                    lsum[m] *= al; ts = 0.f;
#pragma unroll
                    for (int i = 0; i < 16; ++i) { O[m][0][i] *= al; O[m][1][i] *= al; negm[m][i] -= sh; }
#pragma unroll
                    for (int t = 0; t < 2; ++t)
#pragma unroll
                        for (int i = 0; i < 16; ++i) { const float p = __builtin_amdgcn_exp2f(S[t][i] - sh); S[t][i] = p; ts += p; }
                }
                lsum[m] += ts;
#pragma unroll
                for (int t = 0; t < 2; ++t) { pk[t][0] = pack_half(S[t], 0); pk[t][1] = pack_half(S[t], 1); }
#pragma unroll
                for (int t = 0; t < 2; ++t)
#pragma unroll
                    for (int s2 = 0; s2 < 2; ++s2)
#pragma unroll
                        for (int db = 0; db < 2; ++db) {
                            const s16x4 lo = vtr(cur + vboff + (32 * t + 16 * s2) * DV_STR + db * 64), hi = vtr(cur + vboff + (32 * t + 16 * s2 + 8) * DV_STR + db * 64);
                            const bf16x8 vf = __builtin_shufflevector(lo, hi, 0, 1, 2, 3, 4, 5, 6, 7);
                            O[m][db] = MFMA32(vf, pk[t][s2], O[m][db]); }
                ;
            }
        }
        if (kt + 1 < nsteps) { *(LAS u32x4*)(nxt + skey * DK_STR + sch * 16) = kr; *(LAS u32x4*)(nxt + 64 * DK_STR + skey * DV_STR + sch * 16) = vr; }
        __syncthreads();
    }
    const float l0 = lsum[0] + xshfl<32>(lsum[0]), l1 = lsum[1] + xshfl<32>(lsum[1]);
    const float lam = lamp[0], lam_init = lamp[1];
    const float i0 = 1.f / fmaxf(l0, 1e-30f), i1 = lam / fmaxf(l1, 1e-30f);
    float ss = 0.f;
#pragma unroll
    for (int db = 0; db < 2; ++db)
#pragma unroll
        for (int i = 0; i < 16; ++i) { const float at = O[0][db][i] * i0 - O[1][db][i] * i1; O[0][db][i] = at; ss += at * at; }
    ss += xshfl<32>(ss);
    const float r = (1.f - lam_init) / sqrtf(ss * (1.f / 64.f) + 1e-5f);
    GAS bf16* op = ys + (rowb + q) * 1024 + 512 + h * 64;
#pragma unroll
    for (int db = 0; db < 2; ++db)
#pragma unroll
        for (int gq = 0; gq < 4; ++gq) { const int d0 = 32 * db + 8 * gq + 4 * hh; const f32x4 sg = *(const GAS f32x4*)(subg + d0);
            u32x2 w; w.x = cvtpk(O[0][db][4 * gq + 0] * r * sg[0], O[0][db][4 * gq + 1] * r * sg[1]); w.y = cvtpk(O[0][db][4 * gq + 2] * r * sg[2], O[0][db][4 * gq + 3] * r * sg[3]);
            *(GAS u32x2*)(op + d0) = w; }
}

struct SchedCmp { const char* proj; const char* wc; int G, c;
    DI bool next(int i, Unit& u) const { const int L = i * G + c; if (L >= 16) return false; const int kv = L >> 3, rt = L & 7;
        u.pm = rt; u.pn = 0; u.aux = kv; u.pad = 0; u.a = proj + ((size_t)rt * 256 * 16 * PLD + (kv ? C_VC : C_KC)) * 2; u.b = wc + (size_t)kv * 256 * 1024 * 2; return true; } };
struct EpiCmp { float* ab;
    DI void operator()(const f32x4 (&acc)[2][2][4][2], const Unit& u, int wr, int wc, int fr, int fq) const {
        const int row0 = u.pm * 256 + wr * 64 + fr; const int col = wc * 32 + 8 * fq;
#pragma unroll
        for (int ai = 0; ai < 2; ++ai)
#pragma unroll
            for (int m = 0; m < 4; ++m) { float* rp = ab + ((size_t)u.aux * 2048 + row0 + ai * 128 + m * 16) * 128 + col; *(f32x4*)rp = acc[ai][0][m][0]; *(f32x4*)(rp + 4) = acc[ai][0][m][1]; }
    }
};
DI void cmp_finish(const KA& a, int l, const float* ab, bf16* kcb, int task, int lane) {
    const int kv = task / (BATCH * NCMP), r = task % (BATCH * NCMP), b = r / NCMP, c = r % NCMP;
    const float* w2 = a.in[kv ? 23 : 20] + (size_t)l * 4096; const float* pt = ab + 2 * 2048 * 128;
    const size_t g = (size_t)kv * 2048 + b * 512 + c;
    float ptv = 0.f;
#pragma unroll 8
    for (int part = 0; part < 32; ++part) ptv += pt[(kv * 32 + part) * 64 + lane];
    const float h1 = ab[g * 128 + lane] + ab[(g + 1) * 128 + 64 + lane] + ptv;
    const float gl = gelu_tanh(h1); float o = 0.f;
#pragma unroll
    for (int j = 0; j < 64; ++j) o += rl(gl, j) * w2[j * 64 + lane];
    kcb[((size_t)(kv * BATCH + b) * 512 + c) * 64 + lane] = (bf16)f2bf(o);
    if (c == NCMP - 1) kcb[((size_t)(kv * BATCH + b) * 512 + NCMP) * 64 + lane] = 0;
}

DI void st_load(const GAS unsigned char* kb, const GAS unsigned char* vb, unsigned off, u32x4& kr, u32x4& vr) { kr = *(const GAS u32x4*)(kb + off); vr = *(const GAS u32x4*)(vb + off); }
DI void st_write(LAS unsigned char* buf, int skey, int sch, const u32x4& kr, const u32x4& vr) { *(LAS u32x4*)(buf + skey * DK_STR + sch * 16) = kr; *(LAS u32x4*)(buf + 64 * DK_STR + skey * DV_STR + sch * 16) = vr; }
DI void qk64(const LAS unsigned char* cur, int kboff, const bf16x8 (&qf)[4], const f32x16& cinit, f32x16 (&S)[2]) {
#pragma unroll
    for (int t = 0; t < 2; ++t) { S[t] = cinit;
#pragma unroll
        for (int s = 0; s < 4; ++s) { const bf16x8 kf = *(const LAS bf16x8*)(cur + kboff + t * 32 * DK_STR + s * 32); S[t] = MFMA32(kf, qf[s], S[t]); } }
}
DI void qk32z(const LAS unsigned char* kt32, const bf16x8 (&qf)[4], f32x16& S) {
#pragma unroll
    for (int s = 0; s < 4; ++s) { const bf16x8 kf = *(const LAS bf16x8*)(kt32 + s * 32);
        if (s == 0) { f32x16 z;
#pragma unroll
            for (int i = 0; i < 16; ++i) z[i] = 0.f;
            S = MFMA32(kf, qf[s], z); } else S = MFMA32(kf, qf[s], S); }
}
DI void pv32(const LAS unsigned char* vt32, const bf16x8 (&pk)[2], f32x16 (&O)[2]) {
#pragma unroll
    for (int s2 = 0; s2 < 2; ++s2)
#pragma unroll
        for (int db = 0; db < 2; ++db) {
            const s16x4 lo = vtr(vt32 + (16 * s2) * DV_STR + db * 64), hi = vtr(vt32 + (16 * s2 + 8) * DV_STR + db * 64);
            const bf16x8 vf = __builtin_shufflevector(lo, hi, 0, 1, 2, 3, 4, 5, 6, 7);
            O[db] = MFMA32(vf, pk[s2], O[db]); }
}
DI void mask_bias_cmp32(f32x16& S, int tcol, int cbase, int hh, const LAS float* b2h, float msub) {
#pragma unroll
    for (int i = 0; i < 16; ++i) { const int c = cbase + crow(i, hh); const int dist = tcol - 31 - 16 * c; const bool ok = dist >= 0 && c < NCMP;
        const int di = dist < 0 ? 0 : (dist < 128 ? dist : 128); S[i] = ok ? S[i] + (b2h[di * 12] - msub) : -1e30f; }
}
DI void pv64(const LAS unsigned char* cur, int vboff, const bf16x8 (&pk)[2][2], f32x16 (&O)[2]) {
#pragma unroll
    for (int t = 0; t < 2; ++t)
#pragma unroll
        for (int s2 = 0; s2 < 2; ++s2)
#pragma unroll
            for (int db = 0; db < 2; ++db) {
                const s16x4 lo = vtr(cur + vboff + (32 * t + 16 * s2) * DV_STR + db * 64), hi = vtr(cur + vboff + (32 * t + 16 * s2 + 8) * DV_STR + db * 64);
                const bf16x8 vf = __builtin_shufflevector(lo, hi, 0, 1, 2, 3, 4, 5, 6, 7);
                O[db] = MFMA32(vf, pk[t][s2], O[db]); }
}
DI void softmax_step(f32x16 (&S)[2], f32x16 (&O)[2], f32x16& negm, float& lsum, bf16x8 (&pk)[2][2]) {
    float tm = fmaxf(max16(S[0]), max16(S[1]));
    if (__builtin_amdgcn_ballot_w64(tm > 8.f) != 0ull) {
        tm = fmaxf(tm, xshfl<32>(tm)); const float sh = fmaxf(tm, 0.f); const float al = __builtin_amdgcn_exp2f(-sh);
        lsum *= al;
#pragma unroll
        for (int i = 0; i < 16; ++i) { O[0][i] *= al; O[1][i] *= al; negm[i] -= sh; S[0][i] -= sh; S[1][i] -= sh; } }
#pragma unroll
    for (int t = 0; t < 2; ++t) {
#pragma unroll
        for (int i = 0; i < 16; ++i) { const float p = __builtin_amdgcn_exp2f(S[t][i]); S[t][i] = p; lsum += p; }
        pk[t][0] = pack_half(S[t], 0); pk[t][1] = pack_half(S[t], 1); }
}
DI void mask_bias(f32x16 (&S)[2], int tcol, int kbase, int hh, int W, bool colsel, const LAS float* b2h) {
#pragma unroll
    for (int t = 0; t < 2; ++t)
#pragma unroll
        for (int i = 0; i < 16; ++i) { const int dist = tcol - (kbase + 32 * t + crow(i, hh)); const bool ok = colsel && dist >= 0 && dist < W;
            const int di = dist < 0 ? 0 : (dist < 128 ? dist : 128); S[t][i] = ok ? S[t][i] + b2h[di * 12] : -1e30f; }
}
DI void nsa_unit(const GAS bf16* proj, GAS bf16* ys, const GAS bf16* kcb, LAS unsigned char* lds, const LAS float* bias2, int b, int u, int tid_in, int lane_in, int wave_in) {
    int tid = tid_in, lane = lane_in, wave = wave_in; asm volatile("" : "+v"(tid), "+v"(lane), "+s"(wave));
    const int t0 = u * 64; const int col = lane & 31, hh = lane >> 5, tl = col >> 2, head = col & 3;
    const int t = t0 + wave * 8 + tl; const int tw0 = t0 + wave * 8;
    const size_t rowb = (size_t)b * SEQ;
    const LAS float* b2h = bias2 + 8 + head;
    bf16x8 qf[4];
    { const float SC = 0.125f * 1.4426950408889634f; const GAS bf16* qp = proj + (rowb + t) * PLD + C_DQ + head * 64 + hh * 8;
#pragma unroll
      for (int s = 0; s < 4; ++s) { const u32x4 w = *(const GAS u32x4*)(qp + s * 16); u32x4 o;
          o.x = cvtpk(lo_bf(w.x) * SC, hi_bf(w.x) * SC); o.y = cvtpk(lo_bf(w.y) * SC, hi_bf(w.y) * SC); o.z = cvtpk(lo_bf(w.z) * SC, hi_bf(w.z) * SC); o.w = cvtpk(lo_bf(w.w) * SC, hi_bf(w.w) * SC);
          qf[s] = __builtin_bit_cast(bf16x8, o); } }
    const int skey = tid >> 3, sch = tid & 7;
    const int i16 = lane & 15, blk = (lane >> 4) & 1;
    const int kboff = col * DK_STR + hh * 16;
    const int vboff = 64 * DK_STR + (4 * hh + (i16 >> 2)) * DV_STR + (16 * blk + 4 * (i16 & 3)) * 2;
    u32x4 kr, vr;
    const int ncvm = (4 * u + 3) < NCMP ? (4 * u + 3) : NCMP;
    const int nsc = (ncvm + 63) >> 6;
    const GAS unsigned char* kcp = (const GAS unsigned char*)(kcb + (size_t)(0 * BATCH + b) * 512 * 64);
    const GAS unsigned char* vcp = (const GAS unsigned char*)(kcb + (size_t)(1 * BATCH + b) * 512 * 64);
    const unsigned soffc = (unsigned)(skey * 64 + sch * 8) * 2u;
    float m1 = -120.f, l1 = 0.f;
    st_load(kcp, vcp, soffc, kr, vr); st_write(lds, skey, sch, kr, vr); __syncthreads();
#pragma unroll 1
    for (int kt = 0; kt < nsc; ++kt) {
        const LAS unsigned char* cur = lds + (kt & 1) * DBUF_BYTES; LAS unsigned char* nxt = lds + ((kt + 1) & 1) * DBUF_BYTES;
        if (kt + 1 < nsc) st_load(kcp, vcp, soffc + (unsigned)(kt + 1) * 8192u, kr, vr);
#pragma unroll
        for (int tt = 0; tt < 2; ++tt) { f32x16 S; qk32z(cur + kboff + tt * 32 * DK_STR, qf, S); mask_bias_cmp32(S, t, kt * 64 + tt * 32, hh, b2h, 0.f);
          const float tm = max16(S); const float mn = fmaxf(m1, tm); float acc = 0.f;
#pragma unroll
          for (int i = 0; i < 16; ++i) acc += __builtin_amdgcn_exp2f(S[i] - mn);
          l1 = l1 * __builtin_amdgcn_exp2f(m1 - mn) + acc; m1 = mn; }
        if (kt + 1 < nsc) st_write(nxt, skey, sch, kr, vr);
        __syncthreads();
    }
    float mf, inv;
    { const float mo = xshfl<32>(m1), lo = xshfl<32>(l1); mf = fmaxf(m1, mo); const float lf = l1 * __builtin_amdgcn_exp2f(m1 - mf) + lo * __builtin_amdgcn_exp2f(mo - mf); inv = lf > 0.f ? 1.f / lf : 0.f; }
    f32x16 Oc[2], imp[4];
#pragma unroll
    for (int i = 0; i < 16; ++i) { Oc[0][i] = 0.f; Oc[1][i] = 0.f; imp[0][i] = 0.f; imp[1][i] = 0.f; imp[2][i] = 0.f; imp[3][i] = 0.f; }
    {   st_load(kcp, vcp, soffc, kr, vr); st_write(lds, skey, sch, kr, vr); __syncthreads();
#pragma unroll 1
        for (int kt = 0; kt < nsc; ++kt) {
            const LAS unsigned char* cur = lds + (kt & 1) * DBUF_BYTES; LAS unsigned char* nxt = lds + ((kt + 1) & 1) * DBUF_BYTES;
            if (kt + 1 < nsc) st_load(kcp, vcp, soffc + (unsigned)(kt + 1) * 8192u, kr, vr);
#pragma unroll
            for (int tt = 0; tt < 2; ++tt) {
                f32x16 S; qk32z(cur + kboff + tt * 32 * DK_STR, qf, S); mask_bias_cmp32(S, t, kt * 64 + tt * 32, hh, b2h, mf);
#pragma unroll
                for (int i = 0; i < 16; ++i) S[i] = __builtin_amdgcn_exp2f(S[i]) * inv;
                bf16x8 pk[2]; pk[0] = pack_half(S, 0); pk[1] = pack_half(S, 1);
                pv32(cur + vboff + tt * 32 * DV_STR, pk, Oc);
                const int Tq = (2 * kt + tt) & 3, MB = (2 * kt + tt) >> 2;
#pragma unroll
                for (int s2 = 0; s2 < 2; ++s2) { u32x4 aw; unsigned e[8];
#pragma unroll
                    for (int jj = 0; jj < 8; ++jj) { const int kk = 16 * s2 + 8 * (jj >> 2) + 4 * hh + (jj & 3); const int delta = 32 * Tq + kk - 4 * col;
                        e[jj] = (delta == -1 || delta == 3) ? 0x3F80u : ((unsigned)delta <= 2u ? 0x4000u : 0u); }
                    aw.x = e[0] | (e[1] << 16); aw.y = e[2] | (e[3] << 16); aw.z = e[4] | (e[5] << 16); aw.w = e[6] | (e[7] << 16);
                    const bf16x8 af = __builtin_bit_cast(bf16x8, aw);
                    if (MB == 0) imp[0] = MFMA32(af, pk[s2], imp[0]); else if (MB == 1) imp[1] = MFMA32(af, pk[s2], imp[1]); else if (MB == 2) imp[2] = MFMA32(af, pk[s2], imp[2]); else imp[3] = MFMA32(af, pk[s2], imp[3]); }
                if (Tq == 3 && MB < 3) { u32x4 aw; aw.x = 0u; aw.y = 0u; aw.z = 0u; aw.w = (lane == 32) ? 0x3F800000u : 0u;
                    const bf16x8 af = __builtin_bit_cast(bf16x8, aw);
                    if (MB == 0) imp[1] = MFMA32(af, pk[1], imp[1]); else if (MB == 1) imp[2] = MFMA32(af, pk[1], imp[2]); else imp[3] = MFMA32(af, pk[1], imp[3]); }
            }
            if (kt + 1 < nsc) st_write(nxt, skey, sch, kr, vr);
            __syncthreads();
        }
    }
    unsigned ocp[2][8];
#pragma unroll
    for (int db = 0; db < 2; ++db)
#pragma unroll
        for (int i = 0; i < 8; ++i) ocp[db][i] = cvtpk(Oc[db][2 * i], Oc[db][2 * i + 1]);
    unsigned sm0 = 0u, sm1 = 0u, sm2 = 0u, sm3 = 0u;
    {   const int cur_t = t >> 6; unsigned key[16];
#pragma unroll
        for (int i = 0; i < 16; ++i) {
            float v0 = imp[0][i], v1 = imp[1][i], v2 = imp[2][i], v3 = imp[3][i];
            v0 += xshfl<1>(v0); v0 += xshfl<2>(v0); v1 += xshfl<1>(v1); v1 += xshfl<2>(v1); v2 += xshfl<1>(v2); v2 += xshfl<2>(v2); v3 += xshfl<1>(v3); v3 += xshfl<2>(v3);
            const float val = head == 0 ? v0 : (head == 1 ? v1 : (head == 2 ? v2 : v3));
            const int j = 32 * head + crow(i, hh);
            const bool forced = (j == 0) || (j == cur_t) || (j == cur_t - 1);
            unsigned fx = (unsigned)(fminf(fmaxf(val, 0.f), 31.f) * 1048576.f) + 1u;
            fx = forced ? 0x1FFFFFFu : (j <= cur_t ? fx : 0u);
            key[i] = (fx << 7) | (unsigned)(127 - j); }
#pragma unroll 1
        for (int r = 0; r < 16; ++r) {
            unsigned w = key[0];
#pragma unroll
            for (int i = 1; i < 16; ++i) w = w > key[i] ? w : key[i];
            { unsigned o = (unsigned)xshfl_i<1>((int)w); w = w > o ? w : o; o = (unsigned)xshfl_i<2>((int)w); w = w > o ? w : o; o = (unsigned)xshfl_i<32>((int)w); w = w > o ? w : o; }
            if ((w >> 7) != 0u) { const int j = 127 - (int)(w & 127u); const unsigned bit = 1u << (j & 31); const int jb = j >> 5;
                sm0 |= (jb == 0) ? bit : 0u; sm1 |= (jb == 1) ? bit : 0u; sm2 |= (jb == 2) ? bit : 0u; sm3 |= (jb == 3) ? bit : 0u; }
#pragma unroll
            for (int i = 0; i < 16; ++i) key[i] = (key[i] == w) ? 0u : key[i];
        }
    }
    f32x16 Ow[2]; float lw = 0.f;
#pragma unroll
    for (int i = 0; i < 16; ++i) { Ow[0][i] = 0.f; Ow[1][i] = 0.f; }
    {   f32x16 negm;
#pragma unroll
        for (int i = 0; i < 16; ++i) negm[i] = 120.f;
        const GAS unsigned char* kwp = (const GAS unsigned char*)(proj + rowb * PLD + C_KW); const GAS unsigned char* vwp = (const GAS unsigned char*)(proj + rowb * PLD + C_VW);
        const unsigned soffp = (unsigned)(skey * PLD + sch * 8) * 2u;
        const int s0 = (u < 8) ? 8 - u : 0;
        st_load(kwp, vwp, soffp + (unsigned)(u - 8 + s0) * (64u * PLD * 2u), kr, vr); st_write(lds, skey, sch, kr, vr); __syncthreads();
#pragma unroll 1
        for (int s = s0; s < 9; ++s) {
            const int par = (s - s0) & 1; const LAS unsigned char* cur = lds + par * DBUF_BYTES; LAS unsigned char* nxt = lds + (par ^ 1) * DBUF_BYTES;
            if (s + 1 < 9) st_load(kwp, vwp, soffp + (unsigned)(u - 8 + s + 1) * (64u * PLD * 2u), kr, vr);
            {   f32x16 S[2]; qk64(cur, kboff, qf, negm, S);
                if (s == 0 || s >= 6) mask_bias(S, t, (u - 8 + s) * 64, hh, 512, true, b2h);
                bf16x8 pk[2][2]; softmax_step(S, Ow, negm, lw, pk); pv64(cur, vboff, pk, Ow); }
            if (s + 1 < 9) st_write(nxt, skey, sch, kr, vr);
            __syncthreads();
        }
    }
    unsigned owp[2][8];
#pragma unroll
    for (int db = 0; db < 2; ++db)
#pragma unroll
        for (int i = 0; i < 8; ++i) owp[db][i] = cvtpk(Ow[db][2 * i], Ow[db][2 * i + 1]);
    f32x16 Os[2]; float lsel = 0.f;
#pragma unroll
    for (int i = 0; i < 16; ++i) { Os[0][i] = 0.f; Os[1][i] = 0.f; }
    {   f32x16 negm;
#pragma unroll
        for (int i = 0; i < 16; ++i) negm[i] = 120.f;
        const GAS unsigned char* ksp = (const GAS unsigned char*)(proj + rowb * PLD + C_KS); const GAS unsigned char* vsp = (const GAS unsigned char*)(proj + rowb * PLD + C_VS);
        const unsigned soffp = (unsigned)(skey * PLD + sch * 8) * 2u;
        u32x4 kA, vA, kB, vB;
        st_load(ksp, vsp, soffp, kr, vr); st_write(lds, skey, sch, kr, vr);
        if (u >= 1) st_load(ksp, vsp, soffp + 64u * PLD * 2u, kA, vA);
        __syncthreads();
#define SEL_STEP(J, KX, VX, KY, VY) { const int j_ = (J); \
            const LAS unsigned char* cur = lds + (j_ & 1) * DBUF_BYTES; LAS unsigned char* nxt = lds + ((j_ + 1) & 1) * DBUF_BYTES; \
            if (j_ + 2 <= u) st_load(ksp, vsp, soffp + (unsigned)(j_ + 2) * (64u * PLD * 2u), KY, VY); \
            const int jb = j_ >> 5; const unsigned smw = jb == 0 ? sm0 : (jb == 1 ? sm1 : (jb == 2 ? sm2 : sm3)); \
            const bool bit = ((smw >> (j_ & 31)) & 1u) != 0u; \
            if (__builtin_amdgcn_ballot_w64(bit) != 0ull) { \
                f32x16 S[2]; qk64(cur, kboff, qf, negm, S); \
                if (64 * j_ + 63 > tw0 - 113) mask_bias(S, t, 64 * j_, hh, 1 << 30, bit, b2h); \
                else if (!bit) { _Pragma("unroll") for (int i = 0; i < 16; ++i) { S[0][i] = -1e30f; S[1][i] = -1e30f; } } \
                bf16x8 pk[2][2]; softmax_step(S, Os, negm, lsel, pk); pv64(cur, vboff, pk, Os); } \
            if (j_ + 1 <= u) st_write(nxt, skey, sch, KX, VX); \
            __syncthreads(); }
#pragma unroll 1
        for (int j = 0; j <= u; j += 2) {
            SEL_STEP(j, kA, vA, kB, vB)
            if (j + 1 <= u) SEL_STEP(j + 1, kB, vB, kA, vA)
        }
#undef SEL_STEP
    }
    {   const float lwt = lw + xshfl<32>(lw), lst = lsel + xshfl<32>(lsel);
        const GAS bf16* gp = proj + (rowb + t) * PLD + C_DG + head * 3;
        const float g0 = sigmoidf_(bf2f(gp[0])), g1 = sigmoidf_(bf2f(gp[1])) / fmaxf(lst, 1e-30f), g2 = sigmoidf_(bf2f(gp[2])) / fmaxf(lwt, 1e-30f);
        GAS bf16* op = ys + (rowb + t) * 1024 + 768 + head * 64;
#pragma unroll
        for (int db = 0; db < 2; ++db)
#pragma unroll
            for (int gq = 0; gq < 4; ++gq) { const int d0 = 32 * db + 8 * gq + 4 * hh; float y[4];
#pragma unroll
                for (int e = 0; e < 4; ++e) { const unsigned cw = ocp[db][2 * gq + (e >> 1)], ww = owp[db][2 * gq + (e >> 1)];
                    y[e] = g0 * ((e & 1) ? hi_bf(cw) : lo_bf(cw)) + g1 * Os[db][4 * gq + e] + g2 * ((e & 1) ? hi_bf(ww) : lo_bf(ww)); }
                u32x2 w; w.x = cvtpk(y[0], y[1]); w.y = cvtpk(y[2], y[3]); *(GAS u32x2*)(op + d0) = w; }
    }
}


DI void swa_unit(const GAS bf16* proj, GAS bf16* ys, LAS unsigned char* lds, const LAS float* bias2, const LAS float* biasd, const GAS float* sinks, int b, int u, int tid_in, int lane_in, int wave_in) {
    int tid = tid_in, lane = lane_in, wave = wave_in; asm volatile("" : "+v"(tid), "+v"(lane), "+s"(wave));
    const int t0 = u * 64; const int col = lane & 31, hh = lane >> 5, tl = col >> 1, kv = wave & 1, head = 2 * kv + (col & 1);
    const int t = t0 + (wave >> 1) * 16 + tl;
    const size_t rowb = (size_t)b * SEQ;
    const LAS float* b2h = bias2 + head;
    bf16x8 qf[4];
    { const float SC = 0.125f * 1.4426950408889634f; const GAS bf16* qp = proj + (rowb + t) * PLD + C_BQ + head * 64 + hh * 8;
#pragma unroll
      for (int s = 0; s < 4; ++s) { const u32x4 w = *(const GAS u32x4*)(qp + s * 16); u32x4 o;
          o.x = cvtpk(lo_bf(w.x) * SC, hi_bf(w.x) * SC); o.y = cvtpk(lo_bf(w.y) * SC, hi_bf(w.y) * SC); o.z = cvtpk(lo_bf(w.z) * SC, hi_bf(w.z) * SC); o.w = cvtpk(lo_bf(w.w) * SC, hi_bf(w.w) * SC);
          qf[s] = __builtin_bit_cast(bf16x8, o); } }
    const int skey = tid >> 3, sch = tid & 7;
    const int i16 = lane & 15, blk = (lane >> 4) & 1;
    const int kboff = kv * DBUF_BYTES + col * DK_STR + hh * 16;
    const int vboff = kv * DBUF_BYTES + 64 * DK_STR + (4 * hh + (i16 >> 2)) * DV_STR + (16 * blk + 4 * (i16 & 3)) * 2;
    const GAS unsigned char* kp = (const GAS unsigned char*)(proj + rowb * PLD + C_BK); const GAS unsigned char* vp = (const GAS unsigned char*)(proj + rowb * PLD + C_BV);
    const unsigned soffp = (unsigned)(skey * PLD + sch * 8) * 2u;
    u32x4 k0, v0, k1, v1;
    f32x16 O[2], negm; float lsum = 0.f;
#pragma unroll
    for (int i = 0; i < 16; ++i) { O[0][i] = 0.f; O[1][i] = 0.f; negm[i] = 120.f; }
    const int s0 = (u < 2) ? 2 - u : 0;
    { const unsigned so = soffp + (unsigned)(u - 2 + s0) * (64u * PLD * 2u); st_load(kp, vp, so, k0, v0); st_load(kp + 128, vp + 128, so, k1, v1);
      st_write(lds, skey, sch, k0, v0); st_write(lds + DBUF_BYTES, skey, sch, k1, v1); }
    __syncthreads();
#pragma unroll 1
    for (int s = s0; s < 3; ++s) {
        const int par = (s - s0) & 1; const LAS unsigned char* cur = lds + par * 2 * DBUF_BYTES; LAS unsigned char* nxt = lds + (par ^ 1) * 2 * DBUF_BYTES;
        if (s + 1 < 3) { const unsigned so = soffp + (unsigned)(u - 2 + s + 1) * (64u * PLD * 2u); st_load(kp, vp, so, k0, v0); st_load(kp + 128, vp + 128, so, k1, v1); }
        {   f32x16 S[2]; qk64(cur, kboff, qf, negm, S);
            mask_bias(S, t, (u - 2 + s) * 64, hh, 128, true, b2h);
            bf16x8 pk[2][2]; softmax_step(S, O, negm, lsum, pk); pv64(cur, vboff, pk, O); }
        if (s + 1 < 3) { st_write(nxt, skey, sch, k0, v0); st_write(nxt + DBUF_BYTES, skey, sch, k1, v1); }
        __syncthreads();
    }
    {   const float sinkp = (sinks[head] - biasd[128 * 12 + head]) * 1.4426950408889634f;
        const float lt = lsum + xshfl<32>(lsum) + __builtin_amdgcn_exp2f(sinkp + negm[0]);
        const float inv = 1.f / fmaxf(lt, 1e-30f);
        GAS bf16* op = ys + (rowb + t) * 1024 + 256 + head * 64;
#pragma unroll
        for (int db = 0; db < 2; ++db)
#pragma unroll
            for (int gq = 0; gq < 4; ++gq) { const int d0 = 32 * db + 8 * gq + 4 * hh;
                u32x2 w; w.x = cvtpk(O[db][4 * gq + 0] * inv, O[db][4 * gq + 1] * inv); w.y = cvtpk(O[db][4 * gq + 2] * inv, O[db][4 * gq + 3] * inv); *(GAS u32x2*)(op + d0) = w; }
    }
}

DI void route_rows4(const KA& a, int l, bf16* xr_, int tok0, int lane_) {
    int lane = lane_; asm volatile("" : "+v"(lane));
    const GAS float* xrow = (const GAS float*)a.out + (size_t)tok0 * 1024; const GAS float* g = (const GAS float*)(a.in[28] + (size_t)l * 1024); GAS bf16* xr = (GAS bf16*)xr_;
    f32x4 v[4][4]; float ss[4];
#pragma unroll
    for (int rr = 0; rr < 4; ++rr)
#pragma unroll
        for (int j = 0; j < 4; ++j) v[rr][j] = *(const GAS f32x4*)(xrow + (size_t)rr * 1024 + 4 * (lane + 64 * j));
#pragma unroll
    for (int rr = 0; rr < 4; ++rr) { float t = 0.f;
#pragma unroll
        for (int j = 0; j < 4; ++j) t += (v[rr][j][0] * v[rr][j][0] + v[rr][j][1] * v[rr][j][1]) + (v[rr][j][2] * v[rr][j][2] + v[rr][j][3] * v[rr][j][3]);
        ss[rr] = t; }
#pragma unroll
    for (int rr = 0; rr < 4; ++rr) ss[rr] = wave_sum(ss[rr]);
#pragma unroll
    for (int j = 0; j < 4; ++j) { const int k0 = 4 * (lane + 64 * j); const f32x4 gv = *(const GAS f32x4*)(g + k0);
#pragma unroll
        for (int rr = 0; rr < 4; ++rr) { const float r = 1.f / sqrtf(ss[rr] * (1.f / 1024.f) + 1e-6f); const f32x4 xn = v[rr][j] * r * gv;
            unsigned hi[4]; float lo[4];
#pragma unroll
            for (int e = 0; e < 4; ++e) { hi[e] = f2bf(xn[e]); lo[e] = xn[e] - __builtin_bit_cast(float, hi[e] << 16); }
            u32x2 wh, wl; wh.x = hi[0] | (hi[1] << 16); wh.y = hi[2] | (hi[3] << 16); wl.x = pk2(lo[0], lo[1]); wl.y = pk2(lo[2], lo[3]);
            *(GAS u32x2*)(xr + (size_t)(tok0 + rr) * 2048 + k0) = wh; *(GAS u32x2*)(xr + (size_t)(tok0 + rr) * 2048 + 1024 + k0) = wl; } }
}
struct SchedRoute { const char* A; const char* B; int pm;
    DI bool next(int i, Unit& u) const { if (i > 0) return false; u.pm = pm; u.pn = 0; u.aux = 0; u.pad = 0; u.a = A + (size_t)pm * 128 * 2048 * 2; u.b = B; return true; } };
struct EpiRoute { float* rlog;
    DI void operator()(const f32x4 (&acc)[2][2][4][2], const Unit& u, int wr, int wc, int fr, int fq) const {
        const int row0 = u.pm * 128 + wr * 64 + fr; const int col = wc * 32 + 8 * fq;
#pragma unroll
        for (int m = 0; m < 4; ++m) { float* rp = rlog + (size_t)(row0 + m * 16) * 128 + col; *(f32x4*)rp = acc[0][0][m][0]; *(f32x4*)(rp + 4) = acc[0][0][m][1]; }
    }
};
DI void route_decide(const KA& a, int l, const float* rl_row, int* rec_e, int* rec_slot, float* rec_w, unsigned* cnt, int tok) {
    float lg[36];
    const float* bg = a.in[30] + l * 4; const float* be = a.in[32] + l * 32;
#pragma unroll
    for (int q = 0; q < 9; ++q) { const f32x4 h = *(const f32x4*)(rl_row + 4 * q), lo = *(const f32x4*)(rl_row + 64 + 4 * q);
        lg[4 * q + 0] = h[0] + lo[0]; lg[4 * q + 1] = h[1] + lo[1]; lg[4 * q + 2] = h[2] + lo[2]; lg[4 * q + 3] = h[3] + lo[3]; }
#pragma unroll
    for (int i = 0; i < 4; ++i) lg[i] += bg[i];
#pragma unroll
    for (int i = 0; i < 32; ++i) lg[4 + i] += be[i];
    int gsel = 0; float gm = lg[0];
#pragma unroll
    for (int i = 1; i < 4; ++i) if (lg[i] > gm) { gm = lg[i]; gsel = i; }
    float gs = 0.f;
#pragma unroll
    for (int i = 0; i < 4; ++i) gs += __expf(lg[i] - gm);
    const float gwt = 1.f / gs;
    float v8[8];
#pragma unroll
    for (int i = 0; i < 8; ++i) { float x = lg[4 + i];
#pragma unroll
        for (int gq = 1; gq < 4; ++gq) x = (gsel == gq) ? lg[4 + gq * 8 + i] : x;
        v8[i] = x; }
    int i0 = 0; float m0 = v8[0];
#pragma unroll
    for (int i = 1; i < 8; ++i) if (v8[i] > m0) { m0 = v8[i]; i0 = i; }
    int i1 = -1; float m1 = -3e38f;
#pragma unroll
    for (int i = 0; i < 8; ++i) if (i != i0 && v8[i] > m1) { m1 = v8[i]; i1 = i; }
    if (i1 < 0) i1 = (i0 == 0) ? 1 : 0;
    const float w0 = 1.f / (1.f + __expf(m1 - m0)); const float w1 = 1.f - w0;
    const int e0 = gsel * 8 + i0, e1 = gsel * 8 + i1;
    const unsigned s0 = __hip_atomic_fetch_add(cnt + e0, 1u, __ATOMIC_RELAXED, __HIP_MEMORY_SCOPE_AGENT);
    const unsigned s1 = __hip_atomic_fetch_add(cnt + e1, 1u, __ATOMIC_RELAXED, __HIP_MEMORY_SCOPE_AGENT);
    rec_e[tok * 2] = e0; rec_e[tok * 2 + 1] = e1; rec_slot[tok * 2] = (int)s0; rec_slot[tok * 2 + 1] = (int)s1; rec_w[tok * 2] = w0 * gwt; rec_w[tok * 2 + 1] = w1 * gwt;
}
DI void expert_weights(const KA& a, int l, LAS unsigned char* lds, int it0, int it1, int gw, int NGW, int wave, int lane) {
    LAS float* scr = (LAS float*)(lds + wave * 16384);
    const float* wgt = a.in[33] + (size_t)l * 32 * 1024 * 256; const float* wup = a.in[34] + (size_t)l * 32 * 1024 * 256; const float* wdn = a.in[35] + (size_t)l * 32 * 256 * 1024;
    bf16* Wgu = (bf16*)(a.ws + WS_WGU); bf16* Wd = (bf16*)(a.ws + WS_WD);
    constexpr int I_E = 16 * 8, I_D = 4 * 32;
    constexpr int NIT = 32 * (2 * I_E + I_D);
    (void)NIT;
    for (int it = it0 + gw; it < it1; it += NGW) {
        const int e = it / (2 * I_E + I_D); int r = it % (2 * I_E + I_D);
        if (r < 2 * I_E) { const int up = r / I_E, q = r % I_E, kb = q / 8, nb = q % 8; const int n0 = nb * 32;
            const int drow = (n0 >> 7) * 256 + up * 128 + (n0 & 127);
            transpose_item((up ? wup : wgt) + (size_t)e * 1024 * 256, 256, 256, Wgu + (size_t)e * 512 * 1024, 1024, kb * 64, n0, drow, scr, lane);
        } else { r -= 2 * I_E; const int kb = r / 32, nb = r % 32;
            transpose_item(wdn + (size_t)e * 256 * 1024, 1024, 1024, Wd + (size_t)e * 1024 * 256, 256, kb * 64, nb * 32, nb * 32, scr, lane); }
    }
}
DI void build_offsets(const unsigned* cnt, LAS int* offt, int tid) {
    if (tid < 32) { const int c = (int)__hip_atomic_load(cnt + tid, __ATOMIC_RELAXED, __HIP_MEMORY_SCOPE_AGENT); offt[330 + tid] = (c + 255) & ~255; }
    __syncthreads();
    if (tid == 0) { int o = 0;
#pragma unroll
        for (int e = 0; e < 32; ++e) { offt[e] = o; o += offt[330 + e]; } offt[32] = o; }
    __syncthreads();
    for (int rt = tid; rt < (MOE_ROWS >> 8); rt += 512) { int e = 0; for (int j = 1; j < 32; ++j) e += (offt[j] <= rt * 256) ? 1 : 0; offt[40 + rt] = e; }
    __syncthreads();
}

template <unsigned PM>
__global__ void __launch_bounds__(512, 2) mk_fwd(Args a_) {
    extern __shared__ __attribute__((aligned(16))) unsigned char lds_raw[];
    LAS unsigned char* lds = (LAS unsigned char*)lds_raw;
    const int wave0 = __builtin_amdgcn_readfirstlane((int)threadIdx.x >> 6);
    if (threadIdx.x < 36) ((LAS unsigned long long*)(lds + PTAB_OFF))[threadIdx.x] = (unsigned long long)a_.in[threadIdx.x];
    __syncthreads();
    KA a; a.in.base = (unsigned)(size_t)(lds + PTAB_OFF); a.out = a_.out; a.ws = a_.ws;
    const int G = gridDim.x, bid = blockIdx.x, NGW = G * 8;
#define PHASE_IDS() int wave = wave0; asm volatile("" : "+s"(wave)); const int lane = my_lane(); const int tid_ = wave * 64 + lane, gw = bid * 8 + wave; (void)tid_; (void)gw; \
    KA ap = a; asm volatile("" : "+s"(ap.ws), "+s"(ap.out), "+s"(ap.in.base)); \
    bf16* hb = (bf16*)(ap.ws + WS_HB); bf16* proj = (bf16*)(ap.ws + WS_PROJ); bf16* gates = (bf16*)(ap.ws + WS_GATES); \
    bf16* ys = hb; bf16* x2b = hb; bf16* merged = proj; bf16* eo = proj; \
    bf16* kcb = (bf16*)(ap.ws + WS_KCVC); float* lrusum = (float*)(ap.ws + WS_LRUSUM); \
    int* rec_e = (int*)(ap.ws + WS_REC); int* rec_slot = rec_e + T * 2; float* rec_w = (float*)(rec_slot + T * 2); \
    int* rowtok = (int*)(ap.ws + WS_ROWTOK); float* roww = (float*)(ap.ws + WS_ROWW); \
    bf16* xs = (bf16*)(ap.ws + WS_XS); bf16* hmid = (bf16*)(ap.ws + WS_HMID); unsigned* ctl = (unsigned*)(ap.ws + WS_CTL); \
    (void)hb; (void)proj; (void)gates; (void)ys; (void)x2b; (void)merged; (void)eo; (void)kcb; (void)lrusum; (void)rec_e; (void)rec_slot; (void)rec_w; (void)rowtok; (void)roww; (void)xs; (void)hmid; (void)ctl
    volatile LAS unsigned* MISC = (volatile LAS unsigned*)(lds + MISC_OFF);
    LAS float* biasd = (LAS float*)(lds + BIAS_OFF);
    LAS int* offt = (LAS int*)(lds + OFFT_OFF);
    { PHASE_IDS();
    if (tid_ < 64) MISC[tid_] = 0u;
    for (int i = tid_; i < 129 * 12; i += 512) { const int d = i / 12, hd = i % 12; const int bk = d < 128 ? T5_BUCKET[d] : 31; const float* rb = a.in[1]; biasd[i] = rb[bk * 12 + hd]; ((LAS float*)(lds + BIAS2_OFF))[i] = (rb[bk * 12 + hd] - rb[31 * 12 + hd]) * 1.4426950408889634f; } }
    __syncthreads();
    const int lo = a_.ph_lo, hi = a_.ph_hi;
    XcdBarrier bar; bar.bar = (unsigned*)(a.ws + WS_CTL) + CW_BAR; bar.x = 0; bar.st = nullptr;
    if (hi - lo > 1) { PHASE_IDS(); bar = xcd_barrier_post(ctl + CW_BAR, MISC + 8, tid_ == 0); }
#ifndef SUB_MASK
#define SUB_MASK 0xFFu
#endif
#define SUB(k) ((SUB_MASK >> (k)) & 1u)
#define HASP(k) ((PM >> ((k) % PPL + ((k) >= 2 * PPL ? PPL : 0))) & 1u)
#define IN(k) (HASP(k) && lo <= (k) && (k) < hi)
#define SEAM(k) do { if ((k) + 1 < hi) { const int sl_ = my_lane(); int sw_ = wave0; asm volatile("" : "+s"(sw_)); xcd_barrier(bar, sw_ == 0 && sl_ == 0); } } while (0)
    for (int l = 0; l < DEPTH; ++l) {
        const int pb = l * PPL;
        if (IN(pb + 0)) { PHASE_IDS(); p1_weights_i8(ap, l, lds, gw, NGW, wave, lane); router_weights(ap, l, gw, NGW, lane); lru_weights(ap, l, gw, NGW, lane); cmp_weights(ap, l, lds, gw, NGW, wave, lane); phase0_weights(ap, l, lds, gw, NGW, wave, lane); phase0_rows(ap, l, 0, gw, NGW, lane); SEAM(pb + 0); }
        if (IN(pb + 1)) {
            PHASE_IDS();
            {   int K1q = 512; asm volatile("" : "+s"(K1q));
                pg8::Gemm g{K1q, 512, 512, 128, -1}; SchedP1 S{(const char*)(ap.ws + WS_HQ), (const char*)(ap.ws + WS_WQ), 128, 26, 1024, 1024, G, bid};
                EpiP1I8 E{proj, (unsigned char*)gates, ap.in[25] + (size_t)l * 4096, (const float*)(ap.ws + WS_HSC), (const float*)(ap.ws + WS_WSC)};
                pg8::gemm_phase<EpiP1I8, SchedP1, false, true>(lds, g, S, E, tid_); }
            SEAM(pb + 1);
        }
        if (IN(pb + 2)) {
            PHASE_IDS();
            LAS float* lamp = (LAS float*)(lds + MISC_OFF + 64);
            if (tid_ < 64) { const float* q1 = ap.in[13] + l * 32; const float* k1 = ap.in[14] + l * 32; const float* q2 = ap.in[15] + l * 32; const float* k2 = ap.in[16] + l * 32;
                float s1 = (lane < 32) ? q1[lane] * k1[lane] : 0.f, s2 = (lane < 32) ? q2[lane] * k2[lane] : 0.f; s1 = wave_sum(s1); s2 = wave_sum(s2);
                const float lam_init = 0.8f - 0.6f * __expf(-0.3f * (float)l); if (lane == 0) { lamp[0] = __expf(s1) - __expf(s2) + lam_init; lamp[1] = lam_init; } }
            __syncthreads();
            if (SUB(0)) { const LAS float* bias2 = (const LAS float*)(lds + BIAS2_OFF); const GAS float* subg = (const GAS float*)(ap.in[17] + l * 64);
                for (int pi = bid; pi < 256; pi += G) { const int bh = pi >> 4, qlo = pi & 15;
                    diff_unit((const GAS bf16*)proj, (GAS bf16*)ys, lds, bias2, subg, lamp, bh >> 2, bh & 3, 31 - qlo, wave);
                    diff_unit((const GAS bf16*)proj, (GAS bf16*)ys, lds, bias2, subg, lamp, bh >> 2, bh & 3, qlo, wave); } }
            { PHASE_IDS();
            if (SUB(3)) { __syncthreads(); const LAS float* bias2 = (const LAS float*)(lds + BIAS2_OFF); const GAS float* sinks = (const GAS float*)(ap.in[12] + l * 4);
                for (int pi = bid; pi < 512; pi += G) swa_unit((const GAS bf16*)proj, (GAS bf16*)ys, lds, bias2, biasd, sinks, pi >> 7, pi & 127, tid_, lane, wave); }
            if (SUB(2)) { pg8::Gemm g{1024, 16 * PLD, 1024, PLD * 2, -1}; SchedCmp S{(const char*)proj, (const char*)(ap.ws + WS_WCMP), G, bid}; EpiCmp E{(float*)(ap.ws + WS_CMPAB)};
                pg8::gemm_phase<EpiCmp, SchedCmp>(lds, g, S, E, tid_); }
            if (SUB(1)) { __syncthreads(); for (int task = bid; task < 512; task += G) lru_unit(ap, l, (const GAS bf16*)proj, (GAS bf16*)ys, (GAS float*)lrusum, lds, task, lane, wave, false); }
            }
            SEAM(pb + 2);
        }
        if (IN(pb + 3)) {
            PHASE_IDS();
            for (int task = gw; task < 2 * BATCH * NCMP; task += NGW) cmp_finish(ap, l, (const float*)(ap.ws + WS_CMPAB), kcb, task, lane);
            __syncthreads();
            for (int task = bid; task < 512; task += G) lru_unit(ap, l, (const GAS bf16*)proj, (GAS bf16*)ys, (GAS float*)lrusum, lds, task, lane, wave, true);
            SEAM(pb + 3);
        }
        if (IN(pb + 4)) {
            PHASE_IDS();
            if (SUB(4)) { const LAS float* bias2 = (const LAS float*)(lds + BIAS2_OFF);
                for (int pi = bid; pi < 256; pi += G) { const int bb = pi >> 6, ulo = pi & 63;
                    nsa_unit((const GAS bf16*)proj, (GAS bf16*)ys, (const GAS bf16*)kcb, lds, bias2, bb, 127 - ulo, tid_, lane, wave);
                    nsa_unit((const GAS bf16*)proj, (GAS bf16*)ys, (const GAS bf16*)kcb, lds, bias2, bb, ulo, tid_, lane, wave); } }
            SEAM(pb + 4);
        }
        if (IN(pb + 5)) {
            PHASE_IDS();
            int K5 = 256; asm volatile("" : "+s"(K5));
            pg8::Gemm g{K5, 1024, 256, 128, -1}; SchedP3a S{(const char*)ys, (const char*)(ap.ws + WS_WBR), G, bid};
            EpiP3a E{merged, (const unsigned char*)gates};
            pg8::gemm_phase<EpiP3a, SchedP3a>(lds, g, S, E, tid_); SEAM(pb + 5);
        }
        if (IN(pb + 6)) {
            PHASE_IDS();
            int K6 = 1024; asm volatile("" : "+s"(K6));
            pg8::Gemm g{K6, 1024, 1024, 128, -1}; SchedP3b S{(const char*)merged, (const char*)(ap.ws + WS_WOUT), G, bid};
            EpiP3b E{(l == 0) ? ap.in[0] : ap.out, ap.out};
            pg8::gemm_phase<EpiP3b, SchedP3b>(lds, g, S, E, tid_); SEAM(pb + 6);
        }
        if (IN(pb + 7)) {
            PHASE_IDS();
            bf16* xr = (bf16*)(ap.ws + WS_XR); float* rlog = (float*)(ap.ws + WS_RLOG);
            constexpr int NITW = 32 * (2 * 16 * 8 + 4 * 32);
            { const int pm = bid;
                for (int r = wave * 4; r < 128; r += 32) route_rows4(ap, l, xr, pm * 128 + r, lane);
                asm volatile("s_waitcnt vmcnt(0)" ::: "memory"); __syncthreads();
                { pg8::Gemm g{2048, 2048, 2048, 128, 0}; SchedRoute S{(const char*)xr, (const char*)(ap.ws + WS_WR), pm}; EpiRoute E{rlog};
                  pg8::gemm_phase<EpiRoute, SchedRoute>(lds, g, S, E, tid_); }
                asm volatile("s_waitcnt vmcnt(0)" ::: "memory"); __syncthreads();
                if (tid_ < 128) route_decide(ap, l, rlog + (size_t)(pm * 128 + tid_) * 128, rec_e, rec_slot, rec_w, ctl + CW_CNT + l * 32, pm * 128 + tid_);
                __syncthreads();
            }
            expert_weights(ap, l, lds, 0, NITW, gw, NGW, wave, lane);
            SEAM(pb + 7);
        }
        if (IN(pb + 8)) {
            PHASE_IDS();
            build_offsets(ctl + CW_CNT + l * 32, offt, tid_);
            if (bid < 32) { const int e = bid; const int c = (int)__hip_atomic_load(ctl + CW_CNT + l * 32 + e, __ATOMIC_RELAXED, __HIP_MEMORY_SCOPE_AGENT);
                for (int p = offt[e] + c + tid_; p < offt[e + 1]; p += 512) rowtok[p] = -1; }
            {   int* rowsrc = (int*)xs;
                if (bid < 32) { const int e = bid; const int c = (int)__hip_atomic_load(ctl + CW_CNT + l * 32 + e, __ATOMIC_RELAXED, __HIP_MEMORY_SCOPE_AGENT);
                    for (int p = offt[e] + c + tid_; p < offt[e + 1]; p += 512) rowsrc[p] = 0; }
                for (int as = bid * 512 + tid_; as < 2 * T; as += G * 512) { const int p = offt[rec_e[as]] + rec_slot[as];
                    rowtok[p] = as; roww[p] = rec_w[as]; rowsrc[p] = as >> 1; } }
            SEAM(pb + 8);
        }
        if (IN(pb + 9)) {
            PHASE_IDS();
            build_offsets(ctl + CW_CNT + l * 32, offt, tid_);
            int K9 = 1024; asm volatile("" : "+s"(K9));
            pg8::Gemm g{K9, 2048, 1024, 128, -1}; SchedM2 S{(const char*)(ap.ws + WS_XR), (const char*)(ap.ws + WS_WGU), offt, (const int*)xs, G, bid};
            EpiM2 E{hmid};
            pg8::gemm_phase<EpiM2, SchedM2, true>(lds, g, S, E, tid_); SEAM(pb + 9);
        }
        if (IN(pb + 10)) {
            PHASE_IDS();
            build_offsets(ctl + CW_CNT + l * 32, offt, tid_);
            int K3 = 256; asm volatile("" : "+s"(K3));
            pg8::Gemm g{K3, 256, 256, 128, -1}; SchedM3 S{(const char*)hmid, (const char*)(ap.ws + WS_WD), offt, G, bid};
            EpiM3 E{eo, rowtok, roww};
            pg8::gemm_phase<EpiM3, SchedM3>(lds, g, S, E, tid_); SEAM(pb + 10);
        }
    }
    if (IN(2 * PPL)) { PHASE_IDS(); phase0_rows(ap, DEPTH, 1, gw, NGW, lane); }
#undef IN
#undef SEAM
}

typedef void (*kern_t)(Args);
template <unsigned PM> static bool setup_kernel() {
    if (hipFuncSetAttribute((const void*)mk_fwd<PM>, hipFuncAttributeMaxDynamicSharedMemorySize, LDS_BYTES) != hipSuccess) { fprintf(stderr, "kernel_launch: hipFuncSetAttribute failed\n"); return false; }
    return true;
}
extern "C" void kernel_launch(void* const* d_in, const int* in_sizes, int n_in, void* d_out, int out_size, void* d_ws, size_t ws_size, hipStream_t stream) {
    static int grid = 0;
    if (grid == 0) {
        if (n_in != 36 || out_size != T * D || ws_size < WS_END) { fprintf(stderr, "kernel_launch: unexpected shapes (n_in %d out %d ws %zu)\n", n_in, out_size, ws_size); grid = -1; return; }
        int dev = 0, cus = 0;
        if (hipGetDevice(&dev) != hipSuccess || hipDeviceGetAttribute(&cus, hipDeviceAttributeMultiprocessorCount, dev) != hipSuccess) { grid = -1; return; }
        bool ok = true;
#if MK_ONE_LAUNCH
        ok = setup_kernel<0xFFFu>();
#endif
        if (!ok) { grid = -1; return; }
        (void)hipGetLastError();
        grid = cus;
        if (grid != 256) { fprintf(stderr, "kernel_launch: built for a 256-CU device (got %d)\n", cus); grid = -1; return; }
    }
    if (grid < 0) return;
    if (hipMemsetAsync((char*)d_ws + WS_CTL, 0, CTL_ZERO_BYTES, stream) != hipSuccess) return;
    Args a{};
    for (int i = 0; i < 36; ++i) a.in[i] = (const float*)d_in[i];
    a.out = (float*)d_out; a.ws = (unsigned char*)d_ws;
#if MK_ONE_LAUNCH
    a.ph_lo = 0; a.ph_hi = NPH;
    hipLaunchKernelGGL(mk_fwd<0xFFFu>, dim3(grid), dim3(512), LDS_BYTES, stream, a);
#endif
}
```

```cpp
#include <hip/hip_runtime.h>
#include <cstdio>
#include <cstdint>

#ifndef MK_ONE_LAUNCH
#define MK_ONE_LAUNCH 1
#endif

#define DI __device__ __forceinline__
#define GAS __attribute__((address_space(1)))
#define LAS __attribute__((address_space(3)))
typedef unsigned short bf16;
typedef short bf16x8 __attribute__((ext_vector_type(8)));
typedef float f32x4 __attribute__((ext_vector_type(4)));
typedef int i32x4 __attribute__((ext_vector_type(4)));
typedef unsigned u32x4 __attribute__((ext_vector_type(4)));
typedef unsigned u32x2 __attribute__((ext_vector_type(2)));
typedef float f32x16 __attribute__((ext_vector_type(16)));
typedef float f32x2 __attribute__((ext_vector_type(2)));
typedef short s16x4 __attribute__((ext_vector_type(4)));
typedef __bf16 bf16x2_t __attribute__((ext_vector_type(2)));
typedef short v4i16_t __attribute__((__vector_size__(4 * sizeof(short))));
#define MFMA32(a, b, c) __builtin_amdgcn_mfma_f32_32x32x16_bf16((a), (b), (c), 0, 0, 0)

constexpr int BATCH = 4, SEQ = 8192, T = BATCH * SEQ, D = 1024, DEPTH = 2;
constexpr int NIN = 2444, PLD = 2560, N1 = 6656, GLD = 4096;
constexpr int C_AX = 0, C_AG = 256, C_BQ = 512, C_BK = 768, C_BV = 896, C_CQ = 1024, C_CK = 1280, C_CV = 1536, C_DQ = 1792,
              C_KC = 2048, C_VC = 2112, C_KS = 2176, C_VS = 2240, C_KW = 2304, C_VW = 2368, C_DG = 2432;
constexpr int NCMP = 511;
constexpr int MOE_ROWS = 73728;
constexpr int PPL = 11;
constexpr int NPH = 2 * PPL + 1;

constexpr size_t MiB = 1u << 20;
constexpr size_t WS_CTL = 0, CTL_ZERO_BYTES = 1 * MiB;
constexpr size_t WS_KCVC = 1 * MiB;
constexpr size_t WS_LRUSUM = 2 * MiB;
constexpr size_t WS_REC = 2 * MiB + 256 * 1024;
constexpr size_t WS_ROWTOK = 3 * MiB;
constexpr size_t WS_ROWW = 3 * MiB + 512 * 1024;
constexpr size_t WS_WIN = 4 * MiB;
constexpr size_t WS_WQ = 4 * MiB;
constexpr size_t WS_WSC = 13 * MiB;
constexpr size_t WS_HSC = 13 * MiB + 65536;
constexpr size_t WS_HQ = 373 * MiB;
constexpr size_t WS_WBR = 17 * MiB;
constexpr size_t WS_WOUT = 19 * MiB;
constexpr size_t WS_HB = 21 * MiB;
constexpr size_t WS_PROJ = 85 * MiB;
constexpr size_t WS_GATES = 245 * MiB;
constexpr size_t WS_WGU = 245 * MiB;
constexpr size_t WS_WD = 277 * MiB;
constexpr size_t WS_XS = 293 * MiB;
constexpr size_t WS_HMID = 437 * MiB;
constexpr size_t WS_XR = 85 * MiB;
constexpr size_t WS_RLOG = 213 * MiB;
constexpr size_t WS_WR = 501 * MiB;
constexpr size_t WS_WCMP = 502 * MiB;
constexpr size_t WS_CMPAB = 503 * MiB;
constexpr size_t WS_LRUW = 505 * MiB + 65536;
constexpr size_t WS_END = 506 * MiB;
constexpr int CW_BAR = 4096;
constexpr int CW_CNT = 16384;

constexpr int RING_BYTES = 131072;
constexpr int MISC_OFF = RING_BYTES;
constexpr int BIAS_OFF = MISC_OFF + 256;
constexpr int OFFT_OFF = BIAS_OFF + 129 * 12 * 4;
constexpr int PTAB_OFF = OFFT_OFF + (40 + 288 + 40) * 4;
constexpr int BIAS2_OFF = PTAB_OFF + 36 * 8;
constexpr int LRUEX_OFF = BIAS2_OFF + 129 * 12 * 4;
constexpr int LDS_BYTES = 163840;
constexpr int LRUCST_OFF = LRUEX_OFF + 8 * 64 * 2 * 4;
constexpr int LRUCAR_OFF = LRUCST_OFF + 3 * 64 * 4;
static_assert(PTAB_OFF % 8 == 0 && LRUCAR_OFF + 8 * 64 * 4 <= LDS_BYTES, "LDS map");

DI float bf2f(bf16 v) { return __builtin_bit_cast(float, (unsigned)v << 16); }
DI float lo_bf(unsigned w) { return __builtin_bit_cast(float, w << 16); }
DI float hi_bf(unsigned w) { return __builtin_bit_cast(float, w & 0xffff0000u); }
DI unsigned f2bf(float f) { unsigned u = __builtin_bit_cast(unsigned, f); return (u + 0x7fffu + ((u >> 16) & 1u)) >> 16; }
DI unsigned pk2(float lo, float hi) { return f2bf(lo) | (f2bf(hi) << 16); }
DI float rl(float v, int i) { return __builtin_bit_cast(float, __builtin_amdgcn_readlane(__builtin_bit_cast(int, v), i)); }
DI int rli(int v, int i) { return __builtin_amdgcn_readlane(v, i); }
DI int my_lane() { int l; asm volatile("v_mbcnt_lo_u32_b32 %0, -1, 0\n\tv_mbcnt_hi_u32_b32 %0, -1, %0" : "=v"(l)); return l; }
template <int O> DI int xshfl_i(int v) {
    if constexpr (O < 32) return __builtin_amdgcn_ds_swizzle(v, (O << 10) | 0x1f);
    else { const int l = my_lane(); return __builtin_amdgcn_ds_bpermute((l ^ 32) << 2, v); }
}
template <int O> DI float xshfl(float v) { return __builtin_bit_cast(float, xshfl_i<O>(__builtin_bit_cast(int, v))); }
DI float wave_sum(float v) { v += xshfl<1>(v); v += xshfl<2>(v); v += xshfl<4>(v); v += xshfl<8>(v); v += xshfl<16>(v); v += xshfl<32>(v); return v; }
DI float wave_max(float v) { v = fmaxf(v, xshfl<1>(v)); v = fmaxf(v, xshfl<2>(v)); v = fmaxf(v, xshfl<4>(v)); v = fmaxf(v, xshfl<8>(v)); v = fmaxf(v, xshfl<16>(v)); v = fmaxf(v, xshfl<32>(v)); return v; }
DI float sigmoidf_(float x) { return __builtin_amdgcn_rcpf(1.f + __builtin_amdgcn_exp2f(-1.4426950408889634f * x)); }
DI float gelu_tanh(float x) { const float u = 0.7978845608028654f * (x + 0.044715f * x * x * x); const float e = __expf(2.f * u); const float th = 1.f - 2.f * __builtin_amdgcn_rcpf(e + 1.f); return 0.5f * x * (1.f + th); }
DI float softplusf_(float x) { return fmaxf(x, 0.f) + log1pf(__expf(-fabsf(x))); }
#define LDS_WAIT() asm volatile("s_waitcnt lgkmcnt(0)" ::: "memory")
#define VM_WAIT() asm volatile("s_waitcnt vmcnt(0)" ::: "memory")

__device__ const unsigned char T5_BUCKET[128] = {
0,1,2,3,4,5,6,7,8,9,10,11,12,13,14,15,16,16,16,17,17,18,18,18,19,19,19,20,20,20,20,21,21,21,21,22,22,22,22,22,23,23,23,23,23,23,24,24,24,24,24,24,25,25,25,25,25,25,25,26,26,26,26,26,26,26,26,27,27,27,27,27,27,27,27,27,27,28,28,28,28,28,28,28,28,28,28,29,29,29,29,29,29,29,29,29,29,29,29,30,30,30,30,30,30,30,30,30,30,30,30,30,30,31,31,31,31,31,31,31,31,31,31,31,31,31,31,31};

#define XB_TMO      128
#define XB_XCNT(j)  (256  + 64 * (j))
#define XB_XSUB(j)  (1280 + 64 * (j))
#define XB_XGEN(j)  (2304 + 64 * (j))
#define XB_TOP      3328
#define XB_TOPGEN   3392
#define XCD_BAR_WORDS 3456
#define XB_SPIN_CAP (1u << 22)
DI unsigned xb_ld(unsigned* p)              { return __hip_atomic_load(p, __ATOMIC_RELAXED, __HIP_MEMORY_SCOPE_AGENT); }
DI unsigned xb_add(unsigned* p, unsigned v) { return __hip_atomic_fetch_add(p, v, __ATOMIC_RELAXED, __HIP_MEMORY_SCOPE_AGENT); }
DI unsigned xb_xcc_id() { return (unsigned)__builtin_amdgcn_s_getreg((3 << 11) | 20) & 0xFu; }
#define XB_SPIN(cond, bar) do { unsigned _sp = 0; while (cond) { __builtin_amdgcn_s_sleep(1); \
    if ((++_sp & 255u) == 0u) { if (xb_ld(&(bar)[XB_TMO])) break; if (_sp > XB_SPIN_CAP) { atomicAdd(&(bar)[XB_TMO], 1u); break; } } } } while (0)
struct XcdBarrier { unsigned* bar; unsigned x; volatile LAS unsigned* st; };
DI XcdBarrier xcd_barrier_post(unsigned* bar, volatile LAS unsigned* st, bool leader) {
    XcdBarrier b; b.bar = bar; b.x = xb_xcc_id(); b.st = st;
    if (leader) (void)xb_add(&bar[XB_XCNT(b.x)], 1u);
    return b;
}
DI void xcd_barrier_complete(unsigned* bar, unsigned x, unsigned& nloc, unsigned& nx) {
    const unsigned G = gridDim.x * gridDim.y * gridDim.z;
    unsigned sum, cnt, mine, sp = 0u;
    for (;;) {
        sum = 0u; cnt = 0u; mine = 0u;
#pragma unroll
        for (unsigned j = 0; j < 16; ++j) { const unsigned c = xb_ld(&bar[XB_XCNT(j)]); sum += c; cnt += (c > 0u) ? 1u : 0u; mine = (j == x) ? c : mine; }
        if (sum == G) break;
        __builtin_amdgcn_s_sleep(1);
        if ((++sp & 255u) == 0u) { if (xb_ld(&bar[XB_TMO])) break; if (sp > XB_SPIN_CAP) { atomicAdd(&bar[XB_TMO], 1u); break; } }
    }
    nloc = mine > 0u ? mine : 1u; nx = cnt > 0u ? cnt : 1u;
}
DI void xcd_barrier(const XcdBarrier& b, bool leader) {
    asm volatile("s_waitcnt vmcnt(0)" ::: "memory");
    __syncthreads();
    if (leader) {
        unsigned* bar = b.bar;
        __builtin_amdgcn_s_waitcnt(0);
        unsigned nloc = b.st[0], nx = b.st[1];
        if (nloc == 0u) { xcd_barrier_complete(bar, b.x, nloc, nx); b.st[0] = nloc; b.st[1] = nx; }
        const unsigned old = xb_add(&bar[XB_XSUB(b.x)], 1u);
        const unsigned gen = old / nloc;
        if (old + 1u == (gen + 1u) * nloc) {
            __builtin_amdgcn_fence(__ATOMIC_RELEASE, "agent");
            asm volatile("s_waitcnt vmcnt(0)" ::: "memory");
            const unsigned og = xb_add(&bar[XB_TOP], 1u);
            const unsigned tg = og / nx;
            if (og + 1u == (tg + 1u) * nx) xb_add(&bar[XB_TOPGEN], 1u);
            else XB_SPIN(xb_ld(&bar[XB_TOPGEN]) == tg, bar);
            __builtin_amdgcn_fence(__ATOMIC_ACQUIRE, "agent");
            xb_add(&bar[XB_XGEN(b.x)], 1u);
            asm volatile("s_waitcnt vmcnt(0)" ::: "memory");
        } else {
            XB_SPIN(xb_ld(&bar[XB_XGEN(b.x)]) == gen, bar);
            __builtin_amdgcn_fence(__ATOMIC_ACQUIRE, "agent");
            asm volatile("s_waitcnt vmcnt(0)" ::: "memory");
        }
    }
    __syncthreads();
}

namespace pg8 {
constexpr int BM = 256, BK = 64, HALF = 128, HTB = HALF * BK * 2;
__host__ __device__ __forceinline__ int lds_byte(int r, int c) { const int st = (r >> 4) * 2 + (c >> 5), rr = r & 15, cc = c & 31, ob = rr * 64 + cc * 2; return st * 1024 + (ob ^ (((ob >> 9) & 1) << 5)); }
__host__ __device__ __forceinline__ void stage_rc(int b, int& R, int& C) { const int st = b / 1024, sb = b % 1024, swz = sb ^ (((sb >> 9) & 1) << 5); R = (st >> 1) * 16 + swz / 64; C = (st & 1) * 32 + (swz % 64) / 2; }
__host__ __device__ __forceinline__ int perm32(int rho) { const int n = rho >> 4, i = rho & 15; return 8 * (i >> 2) + 4 * n + (i & 3); }
struct Unit { const char* a; const char* b; int pm, pn, aux, pad; };
struct Gemm { int K, lda, ldb, kstepA, hstepA; };
template <bool I8> struct AccT { typedef f32x4 type; };
template <> struct AccT<true> { typedef i32x4 type; };
template <class Epi, class Sched, bool GATHER = false, bool I8 = false>
DI void gemm_phase(LAS unsigned char* lds, const Gemm g, const Sched& S, const Epi& E, int tid_in) {
    int tid = tid_in; asm volatile("" : "+v"(tid));
    const int wid = __builtin_amdgcn_readfirstlane(tid >> 6), lane = tid & 63, wr = wid >> 2, wc = wid & 3, fr = lane & 15, fq = lane >> 4;
    const int K = g.K, nt = K / BK;
    unsigned voffA[2], voffB[2];
#pragma unroll
    for (int i = 0; i < 2; ++i) { int R, C; stage_rc(tid * 16 + i * 8192, R, C); const int Rb = (R & ~31) + perm32(R & 31);
        voffA[i] = (unsigned)(R * g.lda + C) * 2u; voffB[i] = (unsigned)(Rb * g.ldb + C) * 2u; }
    const size_t kstep = (size_t)(BK * 2), kstepA = (size_t)g.kstepA;
    const size_t hstepA = g.hstepA < 0 ? (size_t)HALF * g.lda * 2 : (size_t)g.hstepA, hstepB = (size_t)HALF * g.ldb * 2;
    const unsigned hstepA32 = (unsigned)hstepA;
    unsigned gC[2][2] = {{0u, 0u}, {0u, 0u}}, gN[2][2] = {{0u, 0u}, {0u, 0u}};
    const unsigned ldsw = (unsigned)wid * 1024u;
    const int aoff = lds_byte(wr * 64 + fr, fq * 8), boff = lds_byte(wc * 32 + fr, fq * 8);
#define PG8_SA(b, h) (((b) * 2 + (h)) * HTB)
#define PG8_SB(b, h) ((4 + (b) * 2 + (h)) * HTB)
#define PG8_STAGE(bufoff, gbase, voff) do { _Pragma("unroll") for (int _i = 0; _i < 2; ++_i) \
        __builtin_amdgcn_global_load_lds((const unsigned*)((const char*)(gbase) + (voff)[_i]), (LAS unsigned*)(lds + (bufoff) + ldsw + _i * 8192), 16, 0, 0); } while (0)
#define PG8_STAGEA(bufoff, gbase, h, nextsel) do { _Pragma("unroll") for (int _i = 0; _i < 2; ++_i) { \
        const unsigned _o = GATHER ? ((nextsel) ? gN[h][_i] : gC[h][_i]) : (voffA[_i] + (unsigned)(h) * hstepA32); \
        __builtin_amdgcn_global_load_lds((const unsigned*)((const char*)(gbase) + _o), (LAS unsigned*)(lds + (bufoff) + ldsw + _i * 8192), 16, 0, 0); } } while (0)
#define PG8_LDA(dst, b, h) do { _Pragma("unroll") for (int m = 0; m < 4; ++m) _Pragma("unroll") for (int k = 0; k < 2; ++k) dst[m][k] = *(const LAS bf16x8*)(lds + PG8_SA(b, h) + aoff + m * 2048 + k * 1024); } while (0)
#define PG8_LDB(dst, b, h) do { _Pragma("unroll") for (int n = 0; n < 2; ++n) _Pragma("unroll") for (int k = 0; k < 2; ++k) dst[n][k] = *(const LAS bf16x8*)(lds + PG8_SB(b, h) + boff + n * 2048 + k * 1024); } while (0)
#define PG8_MMA(ai, bj, At, Bt) do { __builtin_amdgcn_s_setprio(1); _Pragma("unroll") for (int m = 0; m < 4; ++m) _Pragma("unroll") for (int n = 0; n < 2; ++n) _Pragma("unroll") for (int k = 0; k < 2; ++k) \
        { if constexpr (I8) acc[ai][bj][m][n] = __builtin_amdgcn_mfma_i32_16x16x64_i8(__builtin_bit_cast(i32x4, Bt[n][k]), __builtin_bit_cast(i32x4, At[m][k]), acc[ai][bj][m][n], 0, 0, 0); \
          else acc[ai][bj][m][n] = __builtin_amdgcn_mfma_f32_16x16x32_bf16(Bt[n][k], At[m][k], acc[ai][bj][m][n], 0, 0, 0); } __builtin_amdgcn_s_setprio(0); } while (0)
#define PG8_WAIT_V(n) asm volatile("s_waitcnt vmcnt(" #n ")" ::: "memory")
#define PG8_WAIT_L(n) asm volatile("s_waitcnt lgkmcnt(" #n ")" ::: "memory")
#define PG8_BAR __builtin_amdgcn_s_barrier()
#define PG8_SCHED __builtin_amdgcn_sched_barrier(0)
    Unit cur, nxt; int ui = 0;
    if (!S.next(0, cur)) return;
    typedef typename AccT<I8>::type ACC;
    ACC acc[2][2][4][2];
#pragma unroll
    for (int a = 0; a < 2; ++a)
#pragma unroll
        for (int b = 0; b < 2; ++b)
#pragma unroll
            for (int m = 0; m < 4; ++m)
#pragma unroll
                for (int n = 0; n < 2; ++n) acc[a][b][m][n] = (ACC){0, 0, 0, 0};
    bf16x8 At[4][2], B0[2][2], B1[2][2];
    const char* cA = cur.a; const char* cB = cur.b;
    if constexpr (GATHER) S.rows(cur, tid, gC);
    PG8_STAGE(PG8_SB(0, 0), cB, voffB); PG8_STAGE(PG8_SB(0, 1), cB + hstepB, voffB); PG8_STAGEA(PG8_SA(0, 0), cA, 0, false); PG8_STAGEA(PG8_SA(0, 1), cA, 1, false);
    if (wr == 1) PG8_BAR;
    PG8_WAIT_V(2); PG8_BAR;
    PG8_STAGE(PG8_SB(1, 0), cB + kstep, voffB); PG8_STAGEA(PG8_SA(1, 0), cA + kstepA, 0, false); PG8_STAGE(PG8_SB(1, 1), cB + hstepB + kstep, voffB);
    PG8_WAIT_V(6); PG8_BAR;
    for (;;) {
        const bool has_next = S.next(ui + 1, nxt);
        const char* nA = has_next ? nxt.a : cA; const char* nB = has_next ? nxt.b : cB;
        if constexpr (GATHER) { if (has_next) S.rows(nxt, tid, gN); else {
#pragma unroll
            for (int h = 0; h < 2; ++h) { gN[h][0] = gC[h][0]; gN[h][1] = gC[h][1]; } } }
        for (int t = 0; t < nt; t += 2) {
            const bool last = (t == nt - 2);
            const char* a1 = cA + (size_t)(t + 1) * kstepA;
            const char* a2 = last ? nA : cA + (size_t)(t + 2) * kstepA; const char* b2 = last ? nB : cB + (size_t)(t + 2) * kstep;
            const char* a3 = a2 + kstepA; const char* b3 = b2 + kstep;
            PG8_LDB(B0, 0, 0); PG8_LDB(B1, 0, 1); PG8_SCHED; PG8_LDA(At, 0, 0); PG8_STAGEA(PG8_SA(1, 1), a1, 1, false);
            PG8_WAIT_V(8); PG8_WAIT_L(0); PG8_BAR; PG8_MMA(0, 0, At, B0); PG8_MMA(0, 1, At, B1); PG8_BAR; PG8_SCHED;
            PG8_LDA(At, 0, 1); PG8_STAGE(PG8_SB(0, 0), b2, voffB); PG8_STAGE(PG8_SB(0, 1), b2 + hstepB, voffB); PG8_STAGEA(PG8_SA(0, 0), a2, 0, last);
            PG8_WAIT_V(8); PG8_WAIT_L(0); PG8_BAR; PG8_MMA(1, 0, At, B0); PG8_MMA(1, 1, At, B1); PG8_BAR; PG8_SCHED;
            PG8_LDB(B0, 1, 0); PG8_LDB(B1, 1, 1); PG8_SCHED; PG8_LDA(At, 1, 0); PG8_STAGEA(PG8_SA(0, 1), a2, 1, last);
            PG8_WAIT_V(8); PG8_WAIT_L(0); PG8_BAR; PG8_MMA(0, 0, At, B0); PG8_MMA(0, 1, At, B1); PG8_BAR; PG8_SCHED;
            PG8_LDA(At, 1, 1); PG8_STAGE(PG8_SB(1, 0), b3, voffB); PG8_STAGE(PG8_SB(1, 1), b3 + hstepB, voffB); PG8_STAGEA(PG8_SA(1, 0), a3, 0, last);
            PG8_WAIT_V(8); PG8_WAIT_L(0); PG8_BAR; PG8_MMA(1, 0, At, B0); PG8_MMA(1, 1, At, B1); PG8_BAR; PG8_SCHED;
        }
        if (wr == 0) PG8_BAR;
        { const int el = my_lane(); E(acc, cur, wr, wc, el & 15, el >> 4); }
        if (!has_next) break;
        bool carried = false;
        if constexpr (Epi::CARRY) { if (nxt.aux != 0) { const int el = my_lane(); E.carry(acc, nxt, wr, wc, el & 15, el >> 4); carried = true; } }
        if (!carried) {
#pragma unroll
        for (int a = 0; a < 2; ++a)
#pragma unroll
            for (int b = 0; b < 2; ++b)
#pragma unroll
                for (int m = 0; m < 4; ++m)
#pragma unroll
                    for (int n = 0; n < 2; ++n) acc[a][b][m][n] = (ACC){0, 0, 0, 0};
        }
        cur = nxt; cA = nA; cB = nB; ++ui;
        if constexpr (GATHER) {
#pragma unroll
            for (int h = 0; h < 2; ++h) { gC[h][0] = gN[h][0]; gC[h][1] = gN[h][1]; } }
        if (wr == 1) PG8_BAR;
    }
    PG8_WAIT_V(0);
    PG8_BAR;
#undef PG8_SA
#undef PG8_SB
#undef PG8_STAGE
#undef PG8_STAGEA
#undef PG8_LDA
#undef PG8_LDB
#undef PG8_MMA
#undef PG8_WAIT_V
#undef PG8_WAIT_L
#undef PG8_BAR
#undef PG8_SCHED
}
}
using pg8::Unit;

DI unsigned cvt_pk_bf16(float lo, float hi) { unsigned r; asm volatile("s_nop 1\n\tv_cvt_pk_bf16_f32 %0, %1, %2" : "=v"(r) : "v"(lo), "v"(hi)); return r; }
DI u32x4 pack8(const f32x4& v0, const f32x4& v1) { u32x4 w; w.x = cvt_pk_bf16(v0[0], v0[1]); w.y = cvt_pk_bf16(v0[2], v0[3]); w.z = cvt_pk_bf16(v1[0], v1[1]); w.w = cvt_pk_bf16(v1[2], v1[3]); return w; }

struct SchedP1 {
    const char* A; const char* B; int nM, nN, rbA, rbB, G, c;
    DI bool next(int i, Unit& u) const {
        constexpr int NXCD = 8, WGM = 8; const int nwg = nM * nN;
        const long L = (long)i * G + c; if (L >= nwg) return false;
        int wgid = (int)L; { const int q = nwg / NXCD, r = nwg % NXCD, xcd = wgid % NXCD, off = wgid / NXCD; wgid = (xcd < r ? xcd * (q + 1) : r * (q + 1) + (xcd - r) * q) + off; }
        const int nig = WGM * nN, gid = wgid / nig, fm = gid * WGM, gsz = (nM - fm) < WGM ? (nM - fm) : WGM;
        u.pm = fm + ((wgid % nig) % gsz); u.pn = (wgid % nig) / gsz; u.aux = 0; u.pad = 0;
        u.a = A + (size_t)u.pm * 256 * rbA; u.b = B + (size_t)u.pn * 256 * rbB; return true;
    }
};
struct SchedP3a {
    const char* ys; const char* wbr; int G, c;
    DI bool next(int i, Unit& u) const {
        const int tile = (i >> 2) * G + c; if (tile >= 512) return false;
        const int br = i & 3; u.pm = tile >> 2; u.pn = tile & 3; u.aux = br; u.pad = 0;
        u.a = ys + ((size_t)u.pm * 256 * 1024 + br * 256) * 2; u.b = wbr + ((size_t)br * 1024 * 256 + (size_t)u.pn * 256 * 256) * 2; return true;
    }
};
struct SchedP3b {
    const char* A; const char* B; int G, c;
    DI bool next(int i, Unit& u) const {
        const int L = i * G + c; if (L >= 512) return false;
        u.pm = L >> 2; u.pn = L & 3; u.aux = 0; u.pad = 0;
        u.a = A + (size_t)u.pm * 256 * 1024 * 2; u.b = B + (size_t)u.pn * 256 * 1024 * 2; return true;
    }
};
struct SchedM2 {
    const char* xr; const char* wgu; const LAS int* offt; const int* rowsrc; int G, c;
    DI bool next(int i, Unit& u) const {
        const int NT = __builtin_amdgcn_readfirstlane(offt[32]) >> 8; const int L = i * G + c; if (L >= NT * 2) return false;
        const int rt = L >> 1, pn = L & 1; const int e = __builtin_amdgcn_readfirstlane(offt[40 + rt]);
        u.pm = rt; u.pn = pn; u.aux = e; u.pad = 0;
        u.a = xr; u.b = wgu + ((size_t)e * 512 + pn * 256) * 1024 * 2; return true;
    }
    DI void rows(const Unit& u, int tid, unsigned (&g)[2][2]) const {
#pragma unroll
        for (int i = 0; i < 2; ++i) { int R, C; pg8::stage_rc(tid * 16 + i * 8192, R, C);
#pragma unroll
            for (int h = 0; h < 2; ++h) g[h][i] = (unsigned)rowsrc[u.pm * 256 + h * 128 + R] * 4096u + (unsigned)C * 2u; }
    }
};
struct SchedM3 {
    const char* hmid; const char* wd; const LAS int* offt; int G, c;
    DI bool next(int i, Unit& u) const {
        const int NT = __builtin_amdgcn_readfirstlane(offt[32]) >> 8; const int L = i * G + c; if (L >= NT * 4) return false;
        const int rt = L >> 2, pn = L & 3; const int e = __builtin_amdgcn_readfirstlane(offt[40 + rt]);
        u.pm = rt; u.pn = pn; u.aux = e; u.pad = 0;
        u.a = hmid + (size_t)rt * 256 * 256 * 2; u.b = wd + ((size_t)e * 1024 + pn * 256) * 256 * 2; return true;
    }
};

struct EpiP1I8 {
    static constexpr bool CARRY = false;
    bf16* proj; unsigned char* gates; const float* bgate; const float* hsc; const float* wsc;
    DI void operator()(const i32x4 (&acc)[2][2][4][2], const Unit& u, int wr, int wc, int fr, int fq) const {
        const int row0 = u.pm * 256 + wr * 64 + fr;
        if (u.pn < 10) { const int colt = u.pn * 256 + wc * 32 + 8 * fq;
            f32x4 sv[2][2]; float rsv[2][4];
#pragma unroll
            for (int bj = 0; bj < 2; ++bj)
#pragma unroll
                for (int n = 0; n < 2; ++n) sv[bj][n] = *(const GAS f32x4*)((const GAS float*)wsc + colt + bj * 128 + 4 * n);
#pragma unroll
            for (int ai = 0; ai < 2; ++ai)
#pragma unroll
                for (int m = 0; m < 4; ++m) rsv[ai][m] = ((const GAS float*)hsc)[row0 + ai * 128 + m * 16];
#pragma unroll
            for (int ai = 0; ai < 2; ++ai)
#pragma unroll
                for (int m = 0; m < 4; ++m) { bf16* rowp = proj + (size_t)(row0 + ai * 128 + m * 16) * PLD + colt; const float rs = rsv[ai][m];
#pragma unroll
                    for (int bj = 0; bj < 2; ++bj) { f32x4 v0, v1;
#pragma unroll
                        for (int e = 0; e < 4; ++e) { v0[e] = (float)acc[ai][bj][m][0][e] * (rs * sv[bj][0][e]); v1[e] = (float)acc[ai][bj][m][1][e] * (rs * sv[bj][1][e]); }
                        *(u32x4*)(rowp + bj * 128) = pack8(v0, v1); } }
            return; }
        const int gcol = (u.pn - 10) * 256 + wc * 32 + 8 * fq; const float* wsc = this->wsc + 2560;
        f32x4 bv[2][2], sv[2][2];
#pragma unroll
        for (int bj = 0; bj < 2; ++bj)
#pragma unroll
            for (int n = 0; n < 2; ++n) { bv[bj][n] = *(const f32x4*)(bgate + gcol + bj * 128 + 4 * n); sv[bj][n] = *(const f32x4*)(wsc + gcol + bj * 128 + 4 * n); }
        float rsv[2][4];
#pragma unroll
        for (int ai = 0; ai < 2; ++ai)
#pragma unroll
            for (int m = 0; m < 4; ++m) rsv[ai][m] = ((const GAS float*)hsc)[row0 + ai * 128 + m * 16];
#pragma unroll
        for (int ai = 0; ai < 2; ++ai)
#pragma unroll
            for (int m = 0; m < 4; ++m) { const float rs = rsv[ai][m];
                unsigned char* rowp = gates + ((size_t)(u.pm * 16 + (u.pn - 10)) * 65536 + (size_t)((ai * 4 + m) * 8192 + (wr * 4 + wc) * 512 + (fq * 16 + fr) * 8));
#pragma unroll
                for (int bj = 0; bj < 2; ++bj) { unsigned q[8];
#pragma unroll
                    for (int n = 0; n < 2; ++n)
#pragma unroll
                        for (int e = 0; e < 4; ++e) { const float pre = (float)acc[ai][bj][m][n][e] * (rs * sv[bj][n][e]) + bv[bj][n][e];
                            q[4 * n + e] = (unsigned)fminf(256.f * sigmoidf_(pre), 255.5f); }
                    u32x2 w; w.x = q[0] | (q[1] << 8) | (q[2] << 16) | (q[3] << 24); w.y = q[4] | (q[5] << 8) | (q[6] << 16) | (q[7] << 24);
                    *(u32x2*)(rowp + bj * 4096) = w; }
                __builtin_amdgcn_sched_barrier(0); }
    }
};
struct EpiP3a {
    static constexpr bool CARRY = true;
    bf16* merged; const unsigned char* gates;
    DI void carry(f32x4 (&acc)[2][2][4][2], const Unit& u, int wr, int wc, int fr, int fq) const {
        const GAS unsigned char* gb = (const GAS unsigned char*)gates + (size_t)(u.pm * 16 + (u.aux - 1) * 4 + u.pn) * 65536;
        const unsigned go = (unsigned)((wr * 4 + wc) * 512 + (fq * 16 + fr) * 8);
        u32x2 gp[2][4][2], gn[2][4][2];
#pragma unroll
        for (int ai = 0; ai < 2; ++ai)
#pragma unroll
            for (int m = 0; m < 4; ++m)
#pragma unroll
                for (int bj = 0; bj < 2; ++bj) { gp[ai][m][bj] = *(const GAS u32x2*)(gb + go + (unsigned)(((ai * 4 + m) * 2 + bj) * 4096));
                    gn[ai][m][bj] = *(const GAS u32x2*)(gb + go + (unsigned)(((ai * 4 + m) * 2 + bj) * 4096 + 4 * 65536)); }
#pragma unroll
        for (int ai = 0; ai < 2; ++ai) {
#pragma unroll
            for (int m = 0; m < 4; ++m)
#pragma unroll
                for (int bj = 0; bj < 2; ++bj) {
#pragma unroll
                    for (int n = 0; n < 2; ++n) { const unsigned p4 = n ? gp[ai][m][bj].y : gp[ai][m][bj].x, n4 = n ? gn[ai][m][bj].y : gn[ai][m][bj].x;
#pragma unroll
                        for (int e = 0; e < 4; ++e) acc[ai][bj][m][n][e] *= ((float)((p4 >> (8 * e)) & 255u) + 0.5f) * __builtin_amdgcn_rcpf((float)((n4 >> (8 * e)) & 255u) + 0.5f); } }
            __builtin_amdgcn_sched_barrier(0); }
    }
    DI void operator()(const f32x4 (&acc)[2][2][4][2], const Unit& u, int wr, int wc, int fr, int fq) const {
        if (u.aux != 3) return;
        const GAS unsigned char* gb = (const GAS unsigned char*)gates + (size_t)(u.pm * 16 + 3 * 4 + u.pn) * 65536;
        GAS unsigned char* mb = (GAS unsigned char*)merged + ((size_t)(u.pm * 256) * 1024 + u.pn * 256) * 2;
        const unsigned go = (unsigned)((wr * 4 + wc) * 512 + (fq * 16 + fr) * 8), mo = (unsigned)((wr * 64 + fr) * 1024 + wc * 32 + 8 * fq) * 2u;
        u32x2 gw[2][4][2];
#pragma unroll
        for (int ai = 0; ai < 2; ++ai)
#pragma unroll
            for (int m = 0; m < 4; ++m)
#pragma unroll
                for (int bj = 0; bj < 2; ++bj) gw[ai][m][bj] = *(const GAS u32x2*)(gb + go + (unsigned)(((ai * 4 + m) * 2 + bj) * 4096));
#pragma unroll
        for (int ai = 0; ai < 2; ++ai) {
#pragma unroll
            for (int m = 0; m < 4; ++m)
#pragma unroll
                for (int bj = 0; bj < 2; ++bj) {
                    f32x4 v0 = acc[ai][bj][m][0], v1 = acc[ai][bj][m][1]; const u32x2 g2 = gw[ai][m][bj]; const float k256 = 0.00390625f;
#pragma unroll
                    for (int e = 0; e < 4; ++e) { v0[e] *= ((float)((g2.x >> (8 * e)) & 255u) + 0.5f) * k256; v1[e] *= ((float)((g2.y >> (8 * e)) & 255u) + 0.5f) * k256; }
                    *(GAS u32x4*)(mb + mo + (unsigned)((ai * 128 + m * 16) * 1024 + bj * 128) * 2u) = pack8(v0, v1); }
            __builtin_amdgcn_sched_barrier(0); }
    }
};
struct EpiP3b {
    static constexpr bool CARRY = false;
    const float* xin; float* out;
    DI void operator()(const f32x4 (&acc)[2][2][4][2], const Unit& u, int wr, int wc, int fr, int fq) const {
        const GAS unsigned char* xb = (const GAS unsigned char*)xin + ((size_t)(u.pm * 256) * 1024 + u.pn * 256) * 4; GAS unsigned char* ob = (GAS unsigned char*)out + ((size_t)(u.pm * 256) * 1024 + u.pn * 256) * 4;
        const unsigned lo = (unsigned)((wr * 64 + fr) * 1024 + wc * 32 + 8 * fq) * 4u;
#pragma unroll
        for (int ai = 0; ai < 2; ++ai)
#pragma unroll
            for (int mh = 0; mh < 2; ++mh) {
                f32x4 xv[2][2][2];
#pragma unroll
                for (int m2 = 0; m2 < 2; ++m2)
#pragma unroll
                    for (int bj = 0; bj < 2; ++bj)
#pragma unroll
                        for (int n = 0; n < 2; ++n) xv[m2][bj][n] = *(const GAS f32x4*)(xb + lo + (unsigned)((ai * 128 + (mh * 2 + m2) * 16) * 1024 + bj * 128 + 4 * n) * 4u);
#pragma unroll
                for (int m2 = 0; m2 < 2; ++m2)
#pragma unroll
                    for (int bj = 0; bj < 2; ++bj)
#pragma unroll
                        for (int n = 0; n < 2; ++n) *(GAS f32x4*)(ob + lo + (unsigned)((ai * 128 + (mh * 2 + m2) * 16) * 1024 + bj * 128 + 4 * n) * 4u) = xv[m2][bj][n] + acc[ai][bj][mh * 2 + m2][n];
                __builtin_amdgcn_sched_barrier(0); }
    }
};
struct EpiM2 {
    static constexpr bool CARRY = false;
    bf16* hmid;
    DI void operator()(const f32x4 (&acc)[2][2][4][2], const Unit& u, int wr, int wc, int fr, int fq) const {
        const int row0 = u.pm * 256 + wr * 64 + fr; const int col = u.pn * 128 + wc * 32 + 8 * fq;
#pragma unroll
        for (int ai = 0; ai < 2; ++ai)
#pragma unroll
            for (int m = 0; m < 4; ++m) { f32x4 h0, h1;
#pragma unroll
                for (int e = 0; e < 4; ++e) { const float g0 = acc[ai][0][m][0][e], g1 = acc[ai][0][m][1][e];
                    h0[e] = g0 * sigmoidf_(g0) * acc[ai][1][m][0][e]; h1[e] = g1 * sigmoidf_(g1) * acc[ai][1][m][1][e]; }
                *(u32x4*)(hmid + (size_t)(row0 + ai * 128 + m * 16) * 256 + col) = pack8(h0, h1); }
    }
};
struct EpiM3 {
    static constexpr bool CARRY = false;
    bf16* eo; const int* rowtok; const float* roww;
    DI void operator()(const f32x4 (&acc)[2][2][4][2], const Unit& u, int wr, int wc, int fr, int fq) const {
        const int row0 = u.pm * 256 + wr * 64 + fr; const int colt = u.pn * 256 + wc * 32 + 8 * fq;
        int tk[2][4]; float wv[2][4];
#pragma unroll
        for (int ai = 0; ai < 2; ++ai)
#pragma unroll
            for (int m = 0; m < 4; ++m) { tk[ai][m] = ((const GAS int*)rowtok)[row0 + ai * 128 + m * 16]; wv[ai][m] = ((const GAS float*)roww)[row0 + ai * 128 + m * 16]; }
#pragma unroll
        for (int ai = 0; ai < 2; ++ai)
#pragma unroll
            for (int m = 0; m < 4; ++m) {
                if (tk[ai][m] >= 0) { const float w = wv[ai][m]; GAS bf16* op = (GAS bf16*)eo + (size_t)tk[ai][m] * 1024 + colt;
#pragma unroll
                    for (int bj = 0; bj < 2; ++bj) *(GAS u32x4*)(op + bj * 128) = pack8(acc[ai][bj][m][0] * w, acc[ai][bj][m][1] * w); }
                __builtin_amdgcn_sched_barrier(0); }
    }
};

struct Args { const float* in[36]; float* out; unsigned char* ws; int ph_lo, ph_hi; };
struct InTab { unsigned base;
    DI const float* operator[](int i) const { unsigned long long v; const unsigned addr = base + (unsigned)i * 8u;
        asm volatile("ds_read_b64 %0, %1\n\ts_waitcnt lgkmcnt(0)" : "=v"(v) : "v"(addr) : "memory");
        const unsigned lo = __builtin_amdgcn_readfirstlane((unsigned)v), hi = __builtin_amdgcn_readfirstlane((unsigned)(v >> 32));
        return (const float*)(((unsigned long long)hi << 32) | lo); } };
struct KA { InTab in; float* out; unsigned char* ws; };

DI void transpose_item(const float* W_, int ldw, int nvalid, bf16* WT_, int ldt, int k0, int n0, int dst_row0, LAS float* scr, int lane) {
    const GAS float* W = (const GAS float*)W_; GAS bf16* WT = (GAS bf16*)WT_;
    const int nq = 4 * (lane & 7), kr8 = lane >> 3;
    f32x4 v[8];
#pragma unroll
    for (int i = 0; i < 8; ++i) { const int kk = 8 * i + kr8;
        if (n0 + nq + 3 < nvalid) v[i] = *(const GAS f32x4*)(W + (size_t)(k0 + kk) * ldw + n0 + nq);
        else {
#pragma unroll
            for (int e = 0; e < 4; ++e) v[i][e] = (n0 + nq + e < nvalid) ? W[(size_t)(k0 + kk) * ldw + n0 + nq + e] : 0.f; } }
#pragma unroll
    for (int i = 0; i < 8; ++i) { const int kk = 8 * i + kr8;
#pragma unroll
        for (int e = 0; e < 4; ++e) scr[kk * 33 + nq + e] = v[i][e]; }
    LDS_WAIT(); asm volatile("" ::: "memory");
    const int c = lane & 7;
#pragma unroll
    for (int j = 0; j < 4; ++j) { const int n = (lane >> 3) + 8 * j; const LAS float* s = scr + (8 * c) * 33 + n;
        u32x4 o; o.x = pk2(s[0 * 33], s[1 * 33]); o.y = pk2(s[2 * 33], s[3 * 33]); o.z = pk2(s[4 * 33], s[5 * 33]); o.w = pk2(s[6 * 33], s[7 * 33]);
        if (n0 + n < nvalid) *(GAS u32x4*)(WT + (size_t)(dst_row0 + n) * ldt + k0 + 8 * c) = o; }
    LDS_WAIT(); asm volatile("" ::: "memory");
}
DI void phase0_weights(const KA& a, int l, LAS unsigned char* lds, int gw, int NGW, int wave, int lane) {
    LAS float* scr = (LAS float*)(lds + wave * 16384);
    const float* w_in = a.in[4] + (size_t)l * 1024 * NIN;
    const float* w_gate = a.in[24] + (size_t)l * 4 * 1024 * 1024;
    const float* w_br = a.in[26] + (size_t)l * 4 * 256 * 1024;
    const float* w_out = a.in[27] + (size_t)l * 1024 * 1024;
    bf16* Wt_in = (bf16*)(a.ws + WS_WIN); bf16* Wt_br = (bf16*)(a.ws + WS_WBR); bf16* Wt_out = (bf16*)(a.ws + WS_WOUT);
    constexpr int I_B = 4 * 4 * 32, I_O = 16 * 32, NIT = I_B + I_O;
    (void)w_gate; (void)w_in; (void)Wt_in;
    for (int it = gw; it < NIT; it += NGW) {
        int r = it;
        if (r < I_B) { const int br = r / 128, q = r % 128, kb = q / 32, nb = q % 32; transpose_item(w_br + (size_t)br * 256 * 1024, 1024, 1024, Wt_br + (size_t)br * 1024 * 256, 256, kb * 64, nb * 32, nb * 32, scr, lane); continue; } r -= I_B;
        { const int kb = r / 32, nb = r % 32; transpose_item(w_out, 1024, 1024, Wt_out, 1024, kb * 64, nb * 32, nb * 32, scr, lane); }
    }
}
DI void p1_weights_i8(const KA& a, int l, LAS unsigned char* lds, int gw, int NGW, int wave, int lane) {
    LAS float* scr = (LAS float*)(lds + wave * 16384);
    const GAS float* wgt = (const GAS float*)(a.in[24] + (size_t)l * 4 * 1024 * 1024); const GAS float* win = (const GAS float*)(a.in[4] + (size_t)l * 1024 * NIN);
    GAS unsigned char* Wq = (GAS unsigned char*)(a.ws + WS_WQ); GAS float* wsc = (GAS float*)(a.ws + WS_WSC);
    const int nq = 4 * (lane & 7), kr8 = lane >> 3;
    for (int it = NGW - 1 - gw; it < 128 + 77; it += NGW) {
        const bool isg = it < 128; const int br = it >> 5; const int n0 = isg ? (it & 31) * 32 : (it - 128) * 32;
        const int ldw = isg ? 1024 : NIN; const int nval = isg ? 1024 : NIN; const int drow0 = isg ? 2560 + br * 1024 + n0 : n0;
        const bool lok = (n0 + nq) < nval;
        const GAS float* W = (isg ? wgt + (size_t)br * 1024 * 1024 : win) + n0 + nq;
        f32x4 mx = {0.f, 0.f, 0.f, 0.f};
#pragma unroll 8
        for (int i = 0; i < 128; ++i) { f32x4 v = {0.f, 0.f, 0.f, 0.f}; if (lok) v = *(const GAS f32x4*)(W + (size_t)(8 * i + kr8) * ldw);
            mx[0] = fmaxf(mx[0], fabsf(v[0])); mx[1] = fmaxf(mx[1], fabsf(v[1])); mx[2] = fmaxf(mx[2], fabsf(v[2])); mx[3] = fmaxf(mx[3], fabsf(v[3])); }
#pragma unroll
        for (int e = 0; e < 4; ++e) { float m = mx[e]; m = fmaxf(m, xshfl<8>(m)); m = fmaxf(m, xshfl<16>(m)); m = fmaxf(m, xshfl<32>(m)); mx[e] = fmaxf(m, 1e-20f); }
        if (kr8 == 0 && lok) *(GAS f32x4*)(wsc + drow0 + nq) = mx * (1.f / 127.f);
        const f32x4 qs = {127.f / mx[0], 127.f / mx[1], 127.f / mx[2], 127.f / mx[3]};
#pragma unroll 1
        for (int kb = 0; kb < 16; ++kb) {
            f32x4 v[8];
#pragma unroll
            for (int i = 0; i < 8; ++i) { v[i] = (f32x4){0.f, 0.f, 0.f, 0.f}; if (lok) v[i] = *(const GAS f32x4*)(W + (size_t)(kb * 64 + 8 * i + kr8) * ldw); }
#pragma unroll
            for (int i = 0; i < 8; ++i) { const int kk = 8 * i + kr8;
#pragma unroll
                for (int e = 0; e < 4; ++e) scr[kk * 33 + nq + e] = __builtin_rintf(v[i][e] * qs[e]); }
            LDS_WAIT(); asm volatile("" ::: "memory");
            const int n = lane >> 1, kh = lane & 1; u32x4 o[2];
#pragma unroll
            for (int h2 = 0; h2 < 2; ++h2) { unsigned w4[4];
#pragma unroll
                for (int d = 0; d < 4; ++d) { unsigned wv = 0u;
#pragma unroll
                    for (int e = 0; e < 4; ++e) wv |= ((unsigned)(int)scr[(32 * kh + 16 * h2 + 4 * d + e) * 33 + n] & 255u) << (8 * e);
                    w4[d] = wv; }
                o[h2].x = w4[0]; o[h2].y = w4[1]; o[h2].z = w4[2]; o[h2].w = w4[3]; }
            if (n0 + n < nval) { GAS unsigned char* dst = Wq + (size_t)(drow0 + n) * 1024 + kb * 64 + 32 * kh; *(GAS u32x4*)dst = o[0]; *(GAS u32x4*)(dst + 16) = o[1]; }
            LDS_WAIT(); asm volatile("" ::: "memory");
        }
    }
}

DI void router_weights(const KA& a, int l, int gw, int NGW, int lane) {
    bf16* Wr = (bf16*)(a.ws + WS_WR);
    const float* wg = a.in[29] + (size_t)l * 1024 * 4; const float* we = a.in[31] + (size_t)l * 1024 * 32;
    for (int n = gw; n < 36; n += NGW) {
        for (int i = 0; i < 16; ++i) { const int k = lane + 64 * i; const float w = (n < 4) ? wg[k * 4 + n] : we[k * 32 + (n - 4)];
            const unsigned hi = f2bf(w); const float hf = __builtin_bit_cast(float, hi << 16); const unsigned lo = f2bf(w - hf);
            Wr[(size_t)n * 2048 + k] = (bf16)hi; Wr[(size_t)n * 2048 + 1024 + k] = (bf16)hi; Wr[(size_t)(64 + n) * 2048 + k] = (bf16)lo; Wr[(size_t)(64 + n) * 2048 + 1024 + k] = 0; }
    }
}

DI void cmp_weights(const KA& a, int l, LAS unsigned char* lds, int gw, int NGW, int wave, int lane) {
    LAS float* scr = (LAS float*)(lds + wave * 16384);
    bf16* Wc = (bf16*)(a.ws + WS_WCMP); float* pt = (float*)(a.ws + WS_CMPAB + 2 * MiB);
    for (int it = gw; it < 128 + 64; it += NGW) {
        if (it < 128) { const int kv = it >> 6, q = it & 63, kb = q >> 1, nb = q & 1; const float* w1 = a.in[kv ? 22 : 19] + (size_t)l * 2048 * 64;
            bf16* dst = Wc + (size_t)kv * 256 * 1024 - (kb >= 16 ? 1024 : 0);
            transpose_item(w1, 64, 64, dst, 1024, kb * 64, nb * 32, (kb >= 16 ? 64 : 0) + nb * 32, scr, lane);
        } else { const int kv = (it - 128) >> 5, part = (it - 128) & 31;
            const GAS float* w1 = (const GAS float*)(a.in[kv ? 22 : 19] + (size_t)l * 2048 * 64) + (size_t)part * 64 * 64; const GAS float* pos = (const GAS float*)(a.in[kv ? 21 : 18] + (size_t)l * 2048) + part * 64;
            float acc = 0.f;
#pragma unroll 16
            for (int k = 0; k < 64; ++k) acc += pos[k] * w1[(size_t)k * 64 + lane];
            pt[(kv * 32 + part) * 64 + lane] = acc; }
    }
}

DI void lru_weights(const KA& a, int l, int gw, int NGW, int lane) {
    bf16* W = (bf16*)(a.ws + WS_LRUW); const float* wa = a.in[7] + (size_t)l * 4 * 4096; const float* wx = a.in[9] + (size_t)l * 4 * 4096;
    (void)NGW; { const int idx = gw * 64 + lane; if (idx < 32768) { const int i = idx & 63, j = (idx >> 6) & 63, mat = (idx >> 12) & 1, hbk = idx >> 13;
        W[idx] = (bf16)f2bf((mat ? wx : wa)[(size_t)hbk * 4096 + i * 64 + j]); } }
}
DI void phase0_rows(const KA& a, int l, int mode, int gw, int NGW, int lane) {
    const GAS float* xin = (const GAS float*)((l == 0) ? a.in[0] : a.out);
    const GAS bf16* eo = (const GAS bf16*)(a.ws + WS_PROJ);
    GAS bf16* hb = (GAS bf16*)(a.ws + WS_HB); GAS float* outp = (GAS float*)a.out;
    const GAS float* g = (const GAS float*)(mode ? a.in[2] : (a.in[3] + (size_t)l * 1024));
    f32x4 gv[4];
#pragma unroll
    for (int j = 0; j < 4; ++j) gv[j] = *(const GAS f32x4*)(g + 4 * (lane + 64 * j));
    for (int m0 = gw * 4; m0 < T; m0 += NGW * 4) {
        f32x4 v[4][4]; float ss[4];
#pragma unroll
        for (int rr = 0; rr < 4; ++rr)
#pragma unroll
            for (int j = 0; j < 4; ++j) v[rr][j] = *(const GAS f32x4*)(xin + (size_t)(m0 + rr) * 1024 + 4 * (lane + 64 * j));
        if (l > 0) {
#pragma unroll
            for (int rr = 0; rr < 4; ++rr)
#pragma unroll
                for (int j = 0; j < 4; ++j) {
                    const u32x2 e0 = *(const GAS u32x2*)(eo + (size_t)(2 * (m0 + rr)) * 1024 + 4 * (lane + 64 * j));
                    const u32x2 e1 = *(const GAS u32x2*)(eo + (size_t)(2 * (m0 + rr) + 1) * 1024 + 4 * (lane + 64 * j));
                    v[rr][j][0] += lo_bf(e0.x) + lo_bf(e1.x); v[rr][j][1] += hi_bf(e0.x) + hi_bf(e1.x); v[rr][j][2] += lo_bf(e0.y) + lo_bf(e1.y); v[rr][j][3] += hi_bf(e0.y) + hi_bf(e1.y); } }
#pragma unroll
        for (int rr = 0; rr < 4; ++rr) { float t = 0.f;
#pragma unroll
            for (int j = 0; j < 4; ++j) t += (v[rr][j][0] * v[rr][j][0] + v[rr][j][1] * v[rr][j][1]) + (v[rr][j][2] * v[rr][j][2] + v[rr][j][3] * v[rr][j][3]);
            ss[rr] = t; }
#pragma unroll
        for (int rr = 0; rr < 4; ++rr) ss[rr] = wave_sum(ss[rr]);
        if (mode) {
#pragma unroll
            for (int rr = 0; rr < 4; ++rr) { const float r = 1.f / sqrtf(ss[rr] * (1.f / 1024.f) + 1e-6f); const size_t m = (size_t)(m0 + rr);
#pragma unroll
                for (int j = 0; j < 4; ++j) *(GAS f32x4*)(outp + m * 1024 + 4 * (lane + 64 * j)) = v[rr][j] * r * gv[j]; }
        } else {
            GAS unsigned char* hq = (GAS unsigned char*)(a.ws + WS_HQ); GAS float* hsc = (GAS float*)(a.ws + WS_HSC);
            float am[4];
#pragma unroll
            for (int rr = 0; rr < 4; ++rr) { const float r = 1.f / sqrtf(ss[rr] * (1.f / 1024.f) + 1e-6f); const size_t m = (size_t)(m0 + rr); float t = 0.f;
#pragma unroll
                for (int j = 0; j < 4; ++j) { if (l > 0) *(GAS f32x4*)(outp + m * 1024 + 4 * (lane + 64 * j)) = v[rr][j];
                    const f32x4 y = v[rr][j] * r * gv[j]; v[rr][j] = y;
                    t = fmaxf(t, fmaxf(fmaxf(fabsf(y[0]), fabsf(y[1])), fmaxf(fabsf(y[2]), fabsf(y[3])))); }
                am[rr] = t; }
#pragma unroll
            for (int rr = 0; rr < 4; ++rr) am[rr] = fmaxf(wave_max(am[rr]), 1e-20f);
#pragma unroll
            for (int rr = 0; rr < 4; ++rr) { const size_t m = (size_t)(m0 + rr); const float qs = 127.f / am[rr];
                if (lane == 0) hsc[m] = am[rr] * (1.f / 127.f);
#pragma unroll
                for (int j = 0; j < 4; ++j) { const f32x4 y = v[rr][j] * qs;
                    const unsigned q = ((unsigned)(int)__builtin_rintf(y[0]) & 255u) | (((unsigned)(int)__builtin_rintf(y[1]) & 255u) << 8) | (((unsigned)(int)__builtin_rintf(y[2]) & 255u) << 16) | (((unsigned)(int)__builtin_rintf(y[3]) & 255u) << 24);
                    *(GAS unsigned*)(hq + m * 1024 + 4 * (lane + 64 * j)) = q; } }
        }
    }
}

DI int crow(int i, int hh) { return (i & 3) + 8 * (i >> 2) + 4 * hh; }
DI unsigned cvtpk(float lo, float hi) { f32x2 v = {lo, hi}; bf16x2_t b = __builtin_convertvector(v, bf16x2_t); return __builtin_bit_cast(unsigned, b); }
template <int CTRL, int RMASK> DI float dppf(float oldv, float v) { return __builtin_bit_cast(float, __builtin_amdgcn_update_dpp(__builtin_bit_cast(int, oldv), __builtin_bit_cast(int, v), CTRL, RMASK, 0xf, false)); }
template <int CTRL, int RMASK> DI void scan_step(float& a, float& b) {
    const float ap = dppf<CTRL, RMASK>(1.f, a), bp = dppf<CTRL, RMASK>(0.f, b); b = a * bp + b; a = a * ap; }
DI void lru_unit(const KA& a, int l, const GAS bf16* proj, GAS bf16* ys, GAS float* sums, LAS unsigned char* lds, int task, int lane_in, int wave_in, bool final) {
    int lane = lane_in, wave = wave_in; asm volatile("" : "+v"(lane), "+s"(wave));
    const int chunk = task & 31, hbk = (task >> 5) & 3, b = task >> 7;
    const int ts = chunk * 256 + wave * 32; const size_t rowb = (size_t)b * SEQ;
    LAS unsigned char* wl = lds + wave * 16384;
    LAS float* ex = (LAS float*)(lds + LRUEX_OFF); LAS float* cst = (LAS float*)(lds + LRUCST_OFF); LAS float* car = (LAS float*)(lds + LRUCAR_OFF) + wave * 64;
    {
        const int c = hbk * 64 + lane;
        const GAS float* cw = (const GAS float*)(a.in[5] + (size_t)l * 4 * 256);
        const float cw0 = cw[c], cw1 = cw[256 + c], cw2 = cw[512 + c], cw3 = cw[768 + c]; const float cb = a.in[6][l * 256 + c];
        if (wave == 0) { cst[lane] = a.in[8][l * 256 + c]; cst[64 + lane] = a.in[10][l * 256 + c]; cst[128 + lane] = -8.f * softplusf_(-a.in[11][l * 256 + c]); }
        const GAS bf16* xp = proj + (rowb + ts) * PLD + C_AX + c;
        float x3 = (ts >= 3) ? bf2f(*(xp - 3 * PLD)) : 0.f, x2 = (ts >= 2) ? bf2f(*(xp - 2 * PLD)) : 0.f, x1 = (ts >= 1) ? bf2f(*(xp - PLD)) : 0.f;
#pragma unroll 8
        for (int n = 0; n < 32; ++n) { const float x0 = bf2f(xp[(size_t)n * PLD]); const float xc = cb + cw0 * x3 + cw1 * x2 + cw2 * x1 + cw3 * x0;
            *(LAS bf16*)(wl + n * 144 + lane * 2) = (bf16)f2bf(xc); *(LAS float*)(wl + 4608 + n * 272 + lane * 4) = xc; x3 = x2; x2 = x1; x1 = x0; }
    }
    const int n = lane & 31, hh = lane >> 5;
    f32x16 D[4];
    {
        const GAS bf16* wt = (const GAS bf16*)(a.ws + WS_LRUW) + (size_t)hbk * 8192;
        bf16x8 bfr[4];
        LDS_WAIT();
#pragma unroll
        for (int s4 = 0; s4 < 4; ++s4) bfr[s4] = *(const LAS bf16x8*)(wl + n * 144 + hh * 16 + s4 * 32);
#pragma unroll
        for (int m = 0; m < 4; ++m) {
#pragma unroll
            for (int s4 = 0; s4 < 4; ++s4) { const bf16x8 af = *(const GAS bf16x8*)(wt + (size_t)(m >> 1) * 4096 + (32 * (m & 1) + n) * 64 + 8 * hh + 16 * s4);
                if (s4 == 0) { f32x16 z;
#pragma unroll
                    for (int i = 0; i < 16; ++i) z[i] = 0.f;
                    D[m] = MFMA32(af, bfr[s4], z); } else D[m] = MFMA32(af, bfr[s4], D[m]); } }
    }
    __syncthreads();
    const bool t0 = (ts + n) == 0;
#pragma unroll
    for (int mm = 0; mm < 2; ++mm)
#pragma unroll
        for (int g4 = 0; g4 < 4; ++g4) { const int c0 = 32 * mm + 8 * g4 + 4 * hh;
            const f32x4 vba = *(const LAS f32x4*)(cst + c0), vbx = *(const LAS f32x4*)(cst + 64 + c0), vc8 = *(const LAS f32x4*)(cst + 128 + c0);
            const f32x4 vxc = *(const LAS f32x4*)(wl + 4608 + n * 272 + c0 * 4);
#pragma unroll
            for (int e = 0; e < 4; ++e) { const int i = 4 * g4 + e;
                const float r = sigmoidf_(D[mm][i] + vba[e]), ig = sigmoidf_(D[2 + mm][i] + vbx[e]);
                const float la = vc8[e] * r; const float av = __expf(la);
                const float mult = t0 ? 1.f : sqrtf(fmaxf(1.f - __expf(2.f * la), 0.f));
                float aa = av, bb = mult * ig * vxc[e];
                scan_step<0x111, 0xf>(aa, bb); scan_step<0x112, 0xf>(aa, bb); scan_step<0x114, 0xf>(aa, bb); scan_step<0x118, 0xf>(aa, bb); scan_step<0x142, 0xa>(aa, bb);
                D[mm][i] = aa; D[2 + mm][i] = bb; } }
    if (n == 31) {
#pragma unroll
        for (int mm = 0; mm < 2; ++mm)
#pragma unroll
            for (int i = 0; i < 16; ++i) { const int c = 32 * mm + crow(i, hh); ex[(wave * 64 + c) * 2] = D[mm][i]; ex[(wave * 64 + c) * 2 + 1] = D[2 + mm][i]; } }
    __syncthreads();
    if (!final) {
        if (wave == 0) { float hv = 0.f, av = 1.f;
#pragma unroll
            for (int w = 0; w < 8; ++w) { const float A_ = ex[(w * 64 + lane) * 2], H_ = ex[(w * 64 + lane) * 2 + 1]; hv = A_ * hv + H_; av *= A_; }
            GAS float* sp = sums + ((size_t)((b * 4 + hbk) * 32 + chunk) * 64 + lane) * 2; sp[0] = av; sp[1] = hv; }
    } else {
        {   float hv = 0.f;
            {   const GAS f32x2* sp = (const GAS f32x2*)(sums + ((size_t)((b * 4 + hbk) * 32) * 64 + lane) * 2);
                int cc = 0;
                for (; cc + 8 <= chunk; cc += 8) { f32x2 v[8];
#pragma unroll
                    for (int e = 0; e < 8; ++e) v[e] = sp[(size_t)(cc + e) * 64];
#pragma unroll
                    for (int e = 0; e < 8; ++e) hv = v[e][0] * hv + v[e][1]; }
                for (; cc < chunk; ++cc) { const f32x2 v = sp[(size_t)cc * 64]; hv = v[0] * hv + v[1]; } }
            for (int w = 0; w < wave; ++w) { const float A_ = ex[(w * 64 + lane) * 2], H_ = ex[(w * 64 + lane) * 2 + 1]; hv = A_ * hv + H_; }
            car[lane] = hv; }
        LDS_WAIT(); asm volatile("" ::: "memory");
        const GAS bf16* gp = proj + (rowb + ts + n) * PLD + C_AG + hbk * 64; GAS bf16* yp = ys + (rowb + ts + n) * 1024 + hbk * 64;
#pragma unroll
        for (int mm = 0; mm < 2; ++mm)
#pragma unroll
            for (int g4 = 0; g4 < 4; ++g4) { const int c0 = 32 * mm + 8 * g4 + 4 * hh; const f32x4 cv = *(const LAS f32x4*)(car + c0);
                const u32x2 gt2 = *(const GAS u32x2*)(gp + c0); float y[4];
#pragma unroll
                for (int e = 0; e < 4; ++e) { const int i = 4 * g4 + e; const float hv = D[2 + mm][i] + D[mm][i] * cv[e];
                    const float gt = (e == 0) ? lo_bf(gt2.x) : (e == 1) ? hi_bf(gt2.x) : (e == 2) ? lo_bf(gt2.y) : hi_bf(gt2.y); y[e] = hv * gelu_tanh(gt); }
                u32x2 yo; yo.x = cvtpk(y[0], y[1]); yo.y = cvtpk(y[2], y[3]); *(GAS u32x2*)(yp + c0) = yo; }
    }
    __syncthreads();
}

constexpr int DK_STR = 144, DV_STR = 192, DBUF_BYTES = 64 * DK_STR + 64 * DV_STR;
DI bf16x8 pack_half(const f32x16& x, int s2) { u32x4 p;
    if (s2 == 0) { p.x = cvtpk(x[0], x[1]); p.y = cvtpk(x[2], x[3]); p.z = cvtpk(x[4], x[5]); p.w = cvtpk(x[6], x[7]); }
    else { p.x = cvtpk(x[8], x[9]); p.y = cvtpk(x[10], x[11]); p.z = cvtpk(x[12], x[13]); p.w = cvtpk(x[14], x[15]); }
    return __builtin_bit_cast(bf16x8, p); }
DI s16x4 vtr(const LAS unsigned char* p) { return __builtin_bit_cast(s16x4, __builtin_amdgcn_ds_read_tr16_b64_v4i16((LAS v4i16_t*)p)); }
DI float max16(const f32x16& x) { float a = fmaxf(fmaxf(x[0], x[1]), fmaxf(x[2], x[3])), b = fmaxf(fmaxf(x[4], x[5]), fmaxf(x[6], x[7])), c = fmaxf(fmaxf(x[8], x[9]), fmaxf(x[10], x[11])), d = fmaxf(fmaxf(x[12], x[13]), fmaxf(x[14], x[15])); return fmaxf(fmaxf(a, b), fmaxf(c, d)); }
DI void diff_unit(const GAS bf16* proj, GAS bf16* ys, LAS unsigned char* lds, const LAS float* bias2, const GAS float* subg, const LAS float* lamp, int b, int h, int qb, int wave_in) {
    int wave = wave_in; asm volatile("" : "+s"(wave)); const int lane = my_lane(); const int tid = wave * 64 + lane;
    const int q0 = qb * 256 + wave * 32; const int ql = lane & 31, hh = lane >> 5; const int q = q0 + ql;
    const size_t rowb = (size_t)b * SEQ;
    const float SC = 0.17677669529663687f * 1.4426950408889634f;
    bf16x8 qf[2][2];
    { const GAS bf16* qp = proj + (rowb + q) * PLD + C_CQ + h * 64 + hh * 8;
#pragma unroll
      for (int m = 0; m < 2; ++m)
#pragma unroll
        for (int s = 0; s < 2; ++s) { const u32x4 w = *(const GAS u32x4*)(qp + m * 32 + s * 16); u32x4 o;
            o.x = cvtpk(lo_bf(w.x) * SC, hi_bf(w.x) * SC); o.y = cvtpk(lo_bf(w.y) * SC, hi_bf(w.y) * SC); o.z = cvtpk(lo_bf(w.z) * SC, hi_bf(w.z) * SC); o.w = cvtpk(lo_bf(w.w) * SC, hi_bf(w.w) * SC);
            qf[m][s] = __builtin_bit_cast(bf16x8, o); } }
    f32x16 O[2][2], negm[2];
#pragma unroll
    for (int i = 0; i < 16; ++i) { O[0][0][i] = 0.f; O[0][1][i] = 0.f; O[1][0][i] = 0.f; O[1][1][i] = 0.f; negm[0][i] = 120.f; negm[1][i] = 120.f; }
    float lsum[2] = {0.f, 0.f};
    const int nsteps = 4 * qb + 4, mysteps = 4 * qb + (wave >> 1) + 1;
    const int skey = tid >> 3, sch = tid & 7;
    const GAS unsigned char* kgb = (const GAS unsigned char*)(proj + rowb * PLD + C_CK + h * 64);
    const GAS unsigned char* vgb = (const GAS unsigned char*)(proj + rowb * PLD + C_CV + h * 64);
    const unsigned soff = (unsigned)(skey * PLD + sch * 8) * 2u;
    u32x4 kr = *(const GAS u32x4*)(kgb + soff), vr = *(const GAS u32x4*)(vgb + soff);
    *(LAS u32x4*)(lds + skey * DK_STR + sch * 16) = kr; *(LAS u32x4*)(lds + 64 * DK_STR + skey * DV_STR + sch * 16) = vr;
    __syncthreads();
    const int i16 = lane & 15, blk = (lane >> 4) & 1;
    const int kboff = ql * DK_STR + hh * 16;
    const int vboff = 64 * DK_STR + (4 * hh + (i16 >> 2)) * DV_STR + (16 * blk + 4 * (i16 & 3)) * 2;
#pragma unroll 1
    for (int kt = 0; kt < nsteps; ++kt) {
        const LAS unsigned char* cur = lds + (kt & 1) * DBUF_BYTES; LAS unsigned char* nxt = lds + ((kt + 1) & 1) * DBUF_BYTES;
        if (kt + 1 < nsteps) { const unsigned so = soff + (unsigned)(kt + 1) * (64u * PLD * 2u); kr = *(const GAS u32x4*)(kgb + so); vr = *(const GAS u32x4*)(vgb + so); }
        if (kt < mysteps) {
            const int kbase = kt * 64;
            const bool near = (q0 - (kbase + 63) < 113);
#pragma unroll
            for (int m = 0; m < 2; ++m) {
                bf16x8 pk[2][2];
                f32x16 S[2]; float ts = 0.f;
                {   bf16x8 kf[2][2];
#pragma unroll
                    for (int t = 0; t < 2; ++t)
#pragma unroll
                        for (int s = 0; s < 2; ++s) kf[t][s] = *(const LAS bf16x8*)(cur + kboff + t * 32 * DK_STR + m * 64 + s * 32);
#pragma unroll
                    for (int t = 0; t < 2; ++t) { S[t] = MFMA32(kf[t][0], qf[m][0], negm[m]); S[t] = MFMA32(kf[t][1], qf[m][1], S[t]); } }
                if (near) {
#pragma unroll
                    for (int t = 0; t < 2; ++t)
#pragma unroll
                        for (int i = 0; i < 16; ++i) { const int dist = q - (kbase + 32 * t + crow(i, hh)); const int di = dist < 128 ? dist : 128;
                            const float bv = dist >= 0 ? bias2[di * 12 + 4 + h] : -1e30f; S[t][i] += bv; } }
#pragma unroll
                for (int t = 0; t < 2; ++t)
#pragma unroll
                    for (int i = 0; i < 16; ++i) { const float p = __builtin_amdgcn_exp2f(S[t][i]); S[t][i] = p; ts += p; }
                if (__builtin_amdgcn_ballot_w64(!(ts < 1.0e30f)) != 0ull) {
                {   bf16x8 kf[2][2];
#pragma unroll
                        for (int t = 0; t < 2; ++t)
#pragma unroll
                            for (int s = 0; s < 2; ++s) kf[t][s] = *(const LAS bf16x8*)(cur + kboff + t * 32 * DK_STR + m * 64 + s * 32);
#pragma unroll
                        for (int t = 0; t < 2; ++t) { S[t] = MFMA32(kf[t][0], qf[m][0], negm[m]); S[t] = MFMA32(kf[t][1], qf[m][1], S[t]); } }
                    if (near) {
#pragma unroll
                        for (int t = 0; t < 2; ++t)
#pragma unroll
                            for (int i = 0; i < 16; ++i) { const int dist = q - (kbase + 32 * t + crow(i, hh)); const int di = dist < 128 ? dist : 128;
                                const float bv = dist >= 0 ? bias2[di * 12 + 4 + h] : -1e30f; S[t][i] += bv; } }
                    float tm = fmaxf(max16(S[0]), max16(S[1])); tm = fmaxf(tm, xshfl<32>(tm));
                    const float sh = fmaxf(tm, 0.f); const float al = __builtin_amdgcn_exp2f(-sh);
                    lsum[m] *= al; ts = 0.f;
#pragma unroll
                    for (int i = 0; i < 16; ++i) { O[m][0][i] *= al; O[m][1][i] *= al; negm[m][i] -= sh; }
#pragma unroll
                    for (int t = 0; t < 2; ++t)
#pragma unroll
                        for (int i = 0; i < 16; ++i) { const float p = __builtin_amdgcn_exp2f(S[t][i] - sh); S[t][i] = p; ts += p; }
                }
                lsum[m] += ts;
#pragma unroll
                for (int t = 0; t < 2; ++t) { pk[t][0] = pack_half(S[t], 0); pk[t][1] = pack_half(S[t], 1); }
#pragma unroll
                for (int t = 0; t < 2; ++t)
#pragma unroll
                    for (int s2 = 0; s2 < 2; ++s2)
#pragma unroll
                        for (int db = 0; db < 2; ++db) {
                            const s16x4 lo = vtr(cur + vboff + (32 * t + 16 * s2) * DV_STR + db * 64), hi = vtr(cur + vboff + (32 * t + 16 * s2 + 8) * DV_STR + db * 64);
                            const bf16x8 vf = __builtin_shufflevector(lo, hi, 0, 1, 2, 3, 4, 5, 6, 7);
                            O[m][db] = MFMA32(vf, pk[t][s2], O[m][db]); }
                ;
            }
        }
        if (kt + 1 < nsteps) { *(LAS u32x4*)(nxt + skey * DK_STR + sch * 16) = kr; *(LAS u32x4*)(nxt + 64 * DK_STR + skey * DV_STR + sch * 16) = vr; }
        __syncthreads();
    }
    const float l0 = lsum[0] + xshfl<32>(lsum[0]), l1 = lsum[1] + xshfl<32>(lsum[1]);
    const float lam = lamp[0], lam_init = lamp[1];
    const float i0 = 1.f / fmaxf(l0, 1e-30f), i1 = lam / fmaxf(l1, 1e-30f);
    float ss = 0.f;
#pragma unroll
    for (int db = 0; db < 2; ++db)
#pragma unroll
        for (int i = 0; i < 16; ++i) { const float at = O[0][db][i] * i0 - O[1][db][i] * i1; O[0][db][i] = at; ss += at * at; }
    ss += xshfl<32>(ss);
    const float r = (1.f - lam_init) / sqrtf(ss * (1.f / 64.f) + 1e-5f);
    GAS bf16* op = ys + (rowb + q) * 1024 + 512 + h * 64;
#pragma unroll
    for (int db = 0; db < 2; ++db)
#pragma unroll
        for (int gq = 0; gq < 4; ++gq) { const int d0 = 32 * db + 8 * gq + 4 * hh; const f32x4 sg = *(const GAS f32x4*)(subg + d0);
            u32x2 w; w.x = cvtpk(O[0][db][4 * gq + 0] * r * sg[0], O[0][db][4 * gq + 1] * r * sg[1]); w.y = cvtpk(O[0][db][4 * gq + 2] * r * sg[2], O[0][db][4 * gq + 3] * r * sg[3]);
            *(GAS u32x2*)(op + d0) = w; }
}

struct SchedCmp { const char* proj; const char* wc; int G, c;
    DI bool next(int i, Unit& u) const { const int L = i * G + c; if (L >= 16) return false; const int kv = L >> 3, rt = L & 7;
        u.pm = rt; u.pn = 0; u.aux = kv; u.pad = 0; u.a = proj + ((size_t)rt * 256 * 16 * PLD + (kv ? C_VC : C_KC)) * 2; u.b = wc + (size_t)kv * 256 * 1024 * 2; return true; } };
struct EpiCmp { static constexpr bool CARRY = false; float* ab;
    DI void operator()(const f32x4 (&acc)[2][2][4][2], const Unit& u, int wr, int wc, int fr, int fq) const {
        const int row0 = u.pm * 256 + wr * 64 + fr; const int col = wc * 32 + 8 * fq;
#pragma unroll
        for (int ai = 0; ai < 2; ++ai)
#pragma unroll
            for (int m = 0; m < 4; ++m) { float* rp = ab + ((size_t)u.aux * 2048 + row0 + ai * 128 + m * 16) * 128 + col; *(f32x4*)rp = acc[ai][0][m][0]; *(f32x4*)(rp + 4) = acc[ai][0][m][1]; }
    }
};
DI void cmp_finish(const KA& a, int l, const float* ab, bf16* kcb, int task, int lane) {
    const int kv = task / (BATCH * NCMP), r = task % (BATCH * NCMP), b = r / NCMP, c = r % NCMP;
    const float* w2 = a.in[kv ? 23 : 20] + (size_t)l * 4096; const float* pt = ab + 2 * 2048 * 128;
    const size_t g = (size_t)kv * 2048 + b * 512 + c;
    float ptv = 0.f;
#pragma unroll 8
    for (int part = 0; part < 32; ++part) ptv += pt[(kv * 32 + part) * 64 + lane];
    const float h1 = ab[g * 128 + lane] + ab[(g + 1) * 128 + 64 + lane] + ptv;
    const float gl = gelu_tanh(h1); float o = 0.f;
#pragma unroll
    for (int j = 0; j < 64; ++j) o += rl(gl, j) * w2[j * 64 + lane];
    kcb[((size_t)(kv * BATCH + b) * 512 + c) * 64 + lane] = (bf16)f2bf(o);
    if (c == NCMP - 1) kcb[((size_t)(kv * BATCH + b) * 512 + NCMP) * 64 + lane] = 0;
}

DI void st_load(const GAS unsigned char* kb, const GAS unsigned char* vb, unsigned off, u32x4& kr, u32x4& vr) { kr = *(const GAS u32x4*)(kb + off); vr = *(const GAS u32x4*)(vb + off); }
DI void st_write(LAS unsigned char* buf, int skey, int sch, const u32x4& kr, const u32x4& vr) { *(LAS u32x4*)(buf + skey * DK_STR + sch * 16) = kr; *(LAS u32x4*)(buf + 64 * DK_STR + skey * DV_STR + sch * 16) = vr; }
DI void qk64(const LAS unsigned char* cur, int kboff, const bf16x8 (&qf)[4], const f32x16& cinit, f32x16 (&S)[2]) {
#pragma unroll
    for (int t = 0; t < 2; ++t) { S[t] = cinit;
#pragma unroll
        for (int s = 0; s < 4; ++s) { const bf16x8 kf = *(const LAS bf16x8*)(cur + kboff + t * 32 * DK_STR + s * 32); S[t] = MFMA32(kf, qf[s], S[t]); } }
}
DI void qk32z(const LAS unsigned char* kt32, const bf16x8 (&qf)[4], f32x16& S) {
#pragma unroll
    for (int s = 0; s < 4; ++s) { const bf16x8 kf = *(const LAS bf16x8*)(kt32 + s * 32);
        if (s == 0) { f32x16 z;
#pragma unroll
            for (int i = 0; i < 16; ++i) z[i] = 0.f;
            S = MFMA32(kf, qf[s], z); } else S = MFMA32(kf, qf[s], S); }
}
DI void pv32(const LAS unsigned char* vt32, const bf16x8 (&pk)[2], f32x16 (&O)[2]) {
#pragma unroll
    for (int s2 = 0; s2 < 2; ++s2)
#pragma unroll
        for (int db = 0; db < 2; ++db) {
            const s16x4 lo = vtr(vt32 + (16 * s2) * DV_STR + db * 64), hi = vtr(vt32 + (16 * s2 + 8) * DV_STR + db * 64);
            const bf16x8 vf = __builtin_shufflevector(lo, hi, 0, 1, 2, 3, 4, 5, 6, 7);
            O[db] = MFMA32(vf, pk[s2], O[db]); }
}
DI void mask_bias_cmp32(f32x16& S, int tcol, int cbase, int hh, const LAS float* b2h, float msub) {
#pragma unroll
    for (int i = 0; i < 16; ++i) { const int c = cbase + crow(i, hh); const int dist = tcol - 31 - 16 * c; const bool ok = dist >= 0 && c < NCMP;
        const int di = dist < 0 ? 0 : (dist < 128 ? dist : 128); S[i] = ok ? S[i] + (b2h[di * 12] - msub) : -1e30f; }
}
DI void pv64(const LAS unsigned char* cur, int vboff, const bf16x8 (&pk)[2][2], f32x16 (&O)[2]) {
#pragma unroll
    for (int t = 0; t < 2; ++t)
#pragma unroll
        for (int s2 = 0; s2 < 2; ++s2)
#pragma unroll
            for (int db = 0; db < 2; ++db) {
                const s16x4 lo = vtr(cur + vboff + (32 * t + 16 * s2) * DV_STR + db * 64), hi = vtr(cur + vboff + (32 * t + 16 * s2 + 8) * DV_STR + db * 64);
                const bf16x8 vf = __builtin_shufflevector(lo, hi, 0, 1, 2, 3, 4, 5, 6, 7);
                O[db] = MFMA32(vf, pk[t][s2], O[db]); }
}
DI void softmax_step(f32x16 (&S)[2], f32x16 (&O)[2], f32x16& negm, float& lsum, bf16x8 (&pk)[2][2]) {
    float tm = fmaxf(max16(S[0]), max16(S[1]));
    if (__builtin_amdgcn_ballot_w64(tm > 8.f) != 0ull) {
        tm = fmaxf(tm, xshfl<32>(tm)); const float sh = fmaxf(tm, 0.f); const float al = __builtin_amdgcn_exp2f(-sh);
        lsum *= al;
#pragma unroll
        for (int i = 0; i < 16; ++i) { O[0][i] *= al; O[1][i] *= al; negm[i] -= sh; S[0][i] -= sh; S[1][i] -= sh; } }
#pragma unroll
    for (int t = 0; t < 2; ++t) {
#pragma unroll
        for (int i = 0; i < 16; ++i) { const float p = __builtin_amdgcn_exp2f(S[t][i]); S[t][i] = p; lsum += p; }
        pk[t][0] = pack_half(S[t], 0); pk[t][1] = pack_half(S[t], 1); }
}
DI void mask_bias(f32x16 (&S)[2], int tcol, int kbase, int hh, int W, bool colsel, const LAS float* b2h) {
#pragma unroll
    for (int t = 0; t < 2; ++t)
#pragma unroll
        for (int i = 0; i < 16; ++i) { const int dist = tcol - (kbase + 32 * t + crow(i, hh)); const bool ok = colsel && dist >= 0 && dist < W;
            const int di = dist < 0 ? 0 : (dist < 128 ? dist : 128); S[t][i] = ok ? S[t][i] + b2h[di * 12] : -1e30f; }
}
DI void nsa_unit(const GAS bf16* proj, GAS bf16* ys, const GAS bf16* kcb, LAS unsigned char* lds, const LAS float* bias2, int b, int u, int tid_in, int lane_in, int wave_in) {
    int tid = tid_in, lane = lane_in, wave = wave_in; asm volatile("" : "+v"(tid), "+v"(lane), "+s"(wave));
    const int t0 = u * 64; const int col = lane & 31, hh = lane >> 5, tl = col >> 2, head = col & 3;
    const int t = t0 + wave * 8 + tl; const int tw0 = t0 + wave * 8;
    const size_t rowb = (size_t)b * SEQ;
    const LAS float* b2h = bias2 + 8 + head;
    bf16x8 qf[4];
    { const float SC = 0.125f * 1.4426950408889634f; const GAS bf16* qp = proj + (rowb + t) * PLD + C_DQ + head * 64 + hh * 8;
#pragma unroll
      for (int s = 0; s < 4; ++s) { const u32x4 w = *(const GAS u32x4*)(qp + s * 16); u32x4 o;
          o.x = cvtpk(lo_bf(w.x) * SC, hi_bf(w.x) * SC); o.y = cvtpk(lo_bf(w.y) * SC, hi_bf(w.y) * SC); o.z = cvtpk(lo_bf(w.z) * SC, hi_bf(w.z) * SC); o.w = cvtpk(lo_bf(w.w) * SC, hi_bf(w.w) * SC);
          qf[s] = __builtin_bit_cast(bf16x8, o); } }
    const int skey = tid >> 3, sch = tid & 7;
    const int i16 = lane & 15, blk = (lane >> 4) & 1;
    const int kboff = col * DK_STR + hh * 16;
    const int vboff = 64 * DK_STR + (4 * hh + (i16 >> 2)) * DV_STR + (16 * blk + 4 * (i16 & 3)) * 2;
    u32x4 kr, vr;
    const int ncvm = (4 * u + 3) < NCMP ? (4 * u + 3) : NCMP;
    const int nsc = (ncvm + 63) >> 6;
    const GAS unsigned char* kcp = (const GAS unsigned char*)(kcb + (size_t)(0 * BATCH + b) * 512 * 64);
    const GAS unsigned char* vcp = (const GAS unsigned char*)(kcb + (size_t)(1 * BATCH + b) * 512 * 64);
    const unsigned soffc = (unsigned)(skey * 64 + sch * 8) * 2u;
    float m1 = -120.f, l1 = 0.f;
    st_load(kcp, vcp, soffc, kr, vr); st_write(lds, skey, sch, kr, vr); __syncthreads();
#pragma unroll 1
    for (int kt = 0; kt < nsc; ++kt) {
        const LAS unsigned char* cur = lds + (kt & 1) * DBUF_BYTES; LAS unsigned char* nxt = lds + ((kt + 1) & 1) * DBUF_BYTES;
        if (kt + 1 < nsc) st_load(kcp, vcp, soffc + (unsigned)(kt + 1) * 8192u, kr, vr);
#pragma unroll
        for (int tt = 0; tt < 2; ++tt) { f32x16 S; qk32z(cur + kboff + tt * 32 * DK_STR, qf, S); mask_bias_cmp32(S, t, kt * 64 + tt * 32, hh, b2h, 0.f);
          const float tm = max16(S); const float mn = fmaxf(m1, tm); float acc = 0.f;
#pragma unroll
          for (int i = 0; i < 16; ++i) acc += __builtin_amdgcn_exp2f(S[i] - mn);
          l1 = l1 * __builtin_amdgcn_exp2f(m1 - mn) + acc; m1 = mn; }
        if (kt + 1 < nsc) st_write(nxt, skey, sch, kr, vr);
        __syncthreads();
    }
    float mf, inv;
    { const float mo = xshfl<32>(m1), lo = xshfl<32>(l1); mf = fmaxf(m1, mo); const float lf = l1 * __builtin_amdgcn_exp2f(m1 - mf) + lo * __builtin_amdgcn_exp2f(mo - mf); inv = lf > 0.f ? 1.f / lf : 0.f; }
    f32x16 Oc[2], imp[4];
#pragma unroll
    for (int i = 0; i < 16; ++i) { Oc[0][i] = 0.f; Oc[1][i] = 0.f; imp[0][i] = 0.f; imp[1][i] = 0.f; imp[2][i] = 0.f; imp[3][i] = 0.f; }
    {   st_load(kcp, vcp, soffc, kr, vr); st_write(lds, skey, sch, kr, vr); __syncthreads();
#pragma unroll 1
        for (int kt = 0; kt < nsc; ++kt) {
            const LAS unsigned char* cur = lds + (kt & 1) * DBUF_BYTES; LAS unsigned char* nxt = lds + ((kt + 1) & 1) * DBUF_BYTES;
            if (kt + 1 < nsc) st_load(kcp, vcp, soffc + (unsigned)(kt + 1) * 8192u, kr, vr);
#pragma unroll
            for (int tt = 0; tt < 2; ++tt) {
                f32x16 S; qk32z(cur + kboff + tt * 32 * DK_STR, qf, S); mask_bias_cmp32(S, t, kt * 64 + tt * 32, hh, b2h, mf);
#pragma unroll
                for (int i = 0; i < 16; ++i) S[i] = __builtin_amdgcn_exp2f(S[i]) * inv;
                bf16x8 pk[2]; pk[0] = pack_half(S, 0); pk[1] = pack_half(S, 1);
                pv32(cur + vboff + tt * 32 * DV_STR, pk, Oc);
                const int Tq = (2 * kt + tt) & 3, MB = (2 * kt + tt) >> 2;
#pragma unroll
                for (int s2 = 0; s2 < 2; ++s2) { u32x4 aw; unsigned e[8];
#pragma unroll
                    for (int jj = 0; jj < 8; ++jj) { const int kk = 16 * s2 + 8 * (jj >> 2) + 4 * hh + (jj & 3); const int delta = 32 * Tq + kk - 4 * col;
                        e[jj] = (delta == -1 || delta == 3) ? 0x3F80u : ((unsigned)delta <= 2u ? 0x4000u : 0u); }
                    aw.x = e[0] | (e[1] << 16); aw.y = e[2] | (e[3] << 16); aw.z = e[4] | (e[5] << 16); aw.w = e[6] | (e[7] << 16);
                    const bf16x8 af = __builtin_bit_cast(bf16x8, aw);
                    if (MB == 0) imp[0] = MFMA32(af, pk[s2], imp[0]); else if (MB == 1) imp[1] = MFMA32(af, pk[s2], imp[1]); else if (MB == 2) imp[2] = MFMA32(af, pk[s2], imp[2]); else imp[3] = MFMA32(af, pk[s2], imp[3]); }
                if (Tq == 3 && MB < 3) { u32x4 aw; aw.x = 0u; aw.y = 0u; aw.z = 0u; aw.w = (lane == 32) ? 0x3F800000u : 0u;
                    const bf16x8 af = __builtin_bit_cast(bf16x8, aw);
                    if (MB == 0) imp[1] = MFMA32(af, pk[1], imp[1]); else if (MB == 1) imp[2] = MFMA32(af, pk[1], imp[2]); else imp[3] = MFMA32(af, pk[1], imp[3]); }
            }
            if (kt + 1 < nsc) st_write(nxt, skey, sch, kr, vr);
            __syncthreads();
        }
    }
    unsigned ocp[2][8];
#pragma unroll
    for (int db = 0; db < 2; ++db)
#pragma unroll
        for (int i = 0; i < 8; ++i) ocp[db][i] = cvtpk(Oc[db][2 * i], Oc[db][2 * i + 1]);
    unsigned sm0 = 0u, sm1 = 0u, sm2 = 0u, sm3 = 0u;
    {   const int cur_t = t >> 6; unsigned key[16];
#pragma unroll
        for (int i = 0; i < 16; ++i) {
            float v0 = imp[0][i], v1 = imp[1][i], v2 = imp[2][i], v3 = imp[3][i];
            v0 += xshfl<1>(v0); v0 += xshfl<2>(v0); v1 += xshfl<1>(v1); v1 += xshfl<2>(v1); v2 += xshfl<1>(v2); v2 += xshfl<2>(v2); v3 += xshfl<1>(v3); v3 += xshfl<2>(v3);
            const float val = head == 0 ? v0 : (head == 1 ? v1 : (head == 2 ? v2 : v3));
            const int j = 32 * head + crow(i, hh);
            const bool forced = (j == 0) || (j == cur_t) || (j == cur_t - 1);
            unsigned fx = (unsigned)(fminf(fmaxf(val, 0.f), 31.f) * 1048576.f) + 1u;
            fx = forced ? 0x1FFFFFFu : (j <= cur_t ? fx : 0u);
            key[i] = (fx << 7) | (unsigned)(127 - j); }
#pragma unroll 1
        for (int r = 0; r < 16; ++r) {
            unsigned w = key[0];
#pragma unroll
            for (int i = 1; i < 16; ++i) w = w > key[i] ? w : key[i];
            { unsigned o = (unsigned)xshfl_i<1>((int)w); w = w > o ? w : o; o = (unsigned)xshfl_i<2>((int)w); w = w > o ? w : o; o = (unsigned)xshfl_i<32>((int)w); w = w > o ? w : o; }
            if ((w >> 7) != 0u) { const int j = 127 - (int)(w & 127u); const unsigned bit = 1u << (j & 31); const int jb = j >> 5;
                sm0 |= (jb == 0) ? bit : 0u; sm1 |= (jb == 1) ? bit : 0u; sm2 |= (jb == 2) ? bit : 0u; sm3 |= (jb == 3) ? bit : 0u; }
#pragma unroll
            for (int i = 0; i < 16; ++i) key[i] = (key[i] == w) ? 0u : key[i];
        }
    }
    f32x16 Ow[2]; float lw = 0.f;
#pragma unroll
    for (int i = 0; i < 16; ++i) { Ow[0][i] = 0.f; Ow[1][i] = 0.f; }
    {   f32x16 negm;
#pragma unroll
        for (int i = 0; i < 16; ++i) negm[i] = 120.f;
        const GAS unsigned char* kwp = (const GAS unsigned char*)(proj + rowb * PLD + C_KW); const GAS unsigned char* vwp = (const GAS unsigned char*)(proj + rowb * PLD + C_VW);
        const unsigned soffp = (unsigned)(skey * PLD + sch * 8) * 2u;
        const int s0 = (u < 8) ? 8 - u : 0;
        st_load(kwp, vwp, soffp + (unsigned)(u - 8 + s0) * (64u * PLD * 2u), kr, vr); st_write(lds, skey, sch, kr, vr); __syncthreads();
#pragma unroll 1
        for (int s = s0; s < 9; ++s) {
            const int par = (s - s0) & 1; const LAS unsigned char* cur = lds + par * DBUF_BYTES; LAS unsigned char* nxt = lds + (par ^ 1) * DBUF_BYTES;
            if (s + 1 < 9) st_load(kwp, vwp, soffp + (unsigned)(u - 8 + s + 1) * (64u * PLD * 2u), kr, vr);
            {   f32x16 S[2]; qk64(cur, kboff, qf, negm, S);
                if (s == 0 || s >= 6) mask_bias(S, t, (u - 8 + s) * 64, hh, 512, true, b2h);
                bf16x8 pk[2][2]; softmax_step(S, Ow, negm, lw, pk); pv64(cur, vboff, pk, Ow); }
            if (s + 1 < 9) st_write(nxt, skey, sch, kr, vr);
            __syncthreads();
        }
    }
    unsigned owp[2][8];
#pragma unroll
    for (int db = 0; db < 2; ++db)
#pragma unroll
        for (int i = 0; i < 8; ++i) owp[db][i] = cvtpk(Ow[db][2 * i], Ow[db][2 * i + 1]);
    f32x16 Os[2]; float lsel = 0.f;
#pragma unroll
    for (int i = 0; i < 16; ++i) { Os[0][i] = 0.f; Os[1][i] = 0.f; }
    {   f32x16 negm;
#pragma unroll
        for (int i = 0; i < 16; ++i) negm[i] = 120.f;
        const GAS unsigned char* ksp = (const GAS unsigned char*)(proj + rowb * PLD + C_KS); const GAS unsigned char* vsp = (const GAS unsigned char*)(proj + rowb * PLD + C_VS);
        const unsigned soffp = (unsigned)(skey * PLD + sch * 8) * 2u;
        u32x4 kA, vA, kB, vB;
        st_load(ksp, vsp, soffp, kr, vr); st_write(lds, skey, sch, kr, vr);
        if (u >= 1) st_load(ksp, vsp, soffp + 64u * PLD * 2u, kA, vA);
        __syncthreads();
#define SEL_STEP(J, KX, VX, KY, VY) { const int j_ = (J); \
            const LAS unsigned char* cur = lds + (j_ & 1) * DBUF_BYTES; LAS unsigned char* nxt = lds + ((j_ + 1) & 1) * DBUF_BYTES; \
            if (j_ + 2 <= u) st_load(ksp, vsp, soffp + (unsigned)(j_ + 2) * (64u * PLD * 2u), KY, VY); \
            const int jb = j_ >> 5; const unsigned smw = jb == 0 ? sm0 : (jb == 1 ? sm1 : (jb == 2 ? sm2 : sm3)); \
            const bool bit = ((smw >> (j_ & 31)) & 1u) != 0u; \
            if (__builtin_amdgcn_ballot_w64(bit) != 0ull) { \
                f32x16 S[2]; qk64(cur, kboff, qf, negm, S); \
                if (64 * j_ + 63 > tw0 - 113) mask_bias(S, t, 64 * j_, hh, 1 << 30, bit, b2h); \
                else if (!bit) { _Pragma("unroll") for (int i = 0; i < 16; ++i) { S[0][i] = -1e30f; S[1][i] = -1e30f; } } \
                bf16x8 pk[2][2]; softmax_step(S, Os, negm, lsel, pk); pv64(cur, vboff, pk, Os); } \
            if (j_ + 1 <= u) st_write(nxt, skey, sch, KX, VX); \
            __syncthreads(); }
#pragma unroll 1
        for (int j = 0; j <= u; j += 2) {
            SEL_STEP(j, kA, vA, kB, vB)
            if (j + 1 <= u) SEL_STEP(j + 1, kB, vB, kA, vA)
        }
#undef SEL_STEP
    }
    {   const float lwt = lw + xshfl<32>(lw), lst = lsel + xshfl<32>(lsel);
        const GAS bf16* gp = proj + (rowb + t) * PLD + C_DG + head * 3;
        const float g0 = sigmoidf_(bf2f(gp[0])), g1 = sigmoidf_(bf2f(gp[1])) / fmaxf(lst, 1e-30f), g2 = sigmoidf_(bf2f(gp[2])) / fmaxf(lwt, 1e-30f);
        GAS bf16* op = ys + (rowb + t) * 1024 + 768 + head * 64;
#pragma unroll
        for (int db = 0; db < 2; ++db)
#pragma unroll
            for (int gq = 0; gq < 4; ++gq) { const int d0 = 32 * db + 8 * gq + 4 * hh; float y[4];
#pragma unroll
                for (int e = 0; e < 4; ++e) { const unsigned cw = ocp[db][2 * gq + (e >> 1)], ww = owp[db][2 * gq + (e >> 1)];
                    y[e] = g0 * ((e & 1) ? hi_bf(cw) : lo_bf(cw)) + g1 * Os[db][4 * gq + e] + g2 * ((e & 1) ? hi_bf(ww) : lo_bf(ww)); }
                u32x2 w; w.x = cvtpk(y[0], y[1]); w.y = cvtpk(y[2], y[3]); *(GAS u32x2*)(op + d0) = w; }
    }
}


DI void swa_unit(const GAS bf16* proj, GAS bf16* ys, LAS unsigned char* lds, const LAS float* bias2, const LAS float* biasd, const GAS float* sinks, int b, int u, int tid_in, int lane_in, int wave_in) {
    int tid = tid_in, lane = lane_in, wave = wave_in; asm volatile("" : "+v"(tid), "+v"(lane), "+s"(wave));
    const int t0 = u * 64; const int col = lane & 31, hh = lane >> 5, tl = col >> 1, kv = wave & 1, head = 2 * kv + (col & 1);
    const int t = t0 + (wave >> 1) * 16 + tl;
    const size_t rowb = (size_t)b * SEQ;
    const LAS float* b2h = bias2 + head;
    bf16x8 qf[4];
    { const float SC = 0.125f * 1.4426950408889634f; const GAS bf16* qp = proj + (rowb + t) * PLD + C_BQ + head * 64 + hh * 8;
#pragma unroll
      for (int s = 0; s < 4; ++s) { const u32x4 w = *(const GAS u32x4*)(qp + s * 16); u32x4 o;
          o.x = cvtpk(lo_bf(w.x) * SC, hi_bf(w.x) * SC); o.y = cvtpk(lo_bf(w.y) * SC, hi_bf(w.y) * SC); o.z = cvtpk(lo_bf(w.z) * SC, hi_bf(w.z) * SC); o.w = cvtpk(lo_bf(w.w) * SC, hi_bf(w.w) * SC);
          qf[s] = __builtin_bit_cast(bf16x8, o); } }
    const int skey = tid >> 3, sch = tid & 7;
    const int i16 = lane & 15, blk = (lane >> 4) & 1;
    const int kboff = kv * DBUF_BYTES + col * DK_STR + hh * 16;
    const int vboff = kv * DBUF_BYTES + 64 * DK_STR + (4 * hh + (i16 >> 2)) * DV_STR + (16 * blk + 4 * (i16 & 3)) * 2;
    const GAS unsigned char* kp = (const GAS unsigned char*)(proj + rowb * PLD + C_BK); const GAS unsigned char* vp = (const GAS unsigned char*)(proj + rowb * PLD + C_BV);
    const unsigned soffp = (unsigned)(skey * PLD + sch * 8) * 2u;
    u32x4 k0, v0, k1, v1;
    f32x16 O[2], negm; float lsum = 0.f;
#pragma unroll
    for (int i = 0; i < 16; ++i) { O[0][i] = 0.f; O[1][i] = 0.f; negm[i] = 120.f; }
    const int s0 = (u < 2) ? 2 - u : 0;
    { const unsigned so = soffp + (unsigned)(u - 2 + s0) * (64u * PLD * 2u); st_load(kp, vp, so, k0, v0); st_load(kp + 128, vp + 128, so, k1, v1);
      st_write(lds, skey, sch, k0, v0); st_write(lds + DBUF_BYTES, skey, sch, k1, v1); }
    __syncthreads();
#pragma unroll 1
    for (int s = s0; s < 3; ++s) {
        const int par = (s - s0) & 1; const LAS unsigned char* cur = lds + par * 2 * DBUF_BYTES; LAS unsigned char* nxt = lds + (par ^ 1) * 2 * DBUF_BYTES;
        if (s + 1 < 3) { const unsigned so = soffp + (unsigned)(u - 2 + s + 1) * (64u * PLD * 2u); st_load(kp, vp, so, k0, v0); st_load(kp + 128, vp + 128, so, k1, v1); }
        {   f32x16 S[2]; qk64(cur, kboff, qf, negm, S);
            mask_bias(S, t, (u - 2 + s) * 64, hh, 128, true, b2h);
            bf16x8 pk[2][2]; softmax_step(S, O, negm, lsum, pk); pv64(cur, vboff, pk, O); }
        if (s + 1 < 3) { st_write(nxt, skey, sch, k0, v0); st_write(nxt + DBUF_BYTES, skey, sch, k1, v1); }
        __syncthreads();
    }
    {   const float sinkp = (sinks[head] - biasd[128 * 12 + head]) * 1.4426950408889634f;
        const float lt = lsum + xshfl<32>(lsum) + __builtin_amdgcn_exp2f(sinkp + negm[0]);
        const float inv = 1.f / fmaxf(lt, 1e-30f);
        GAS bf16* op = ys + (rowb + t) * 1024 + 256 + head * 64;
#pragma unroll
        for (int db = 0; db < 2; ++db)
#pragma unroll
            for (int gq = 0; gq < 4; ++gq) { const int d0 = 32 * db + 8 * gq + 4 * hh;
                u32x2 w; w.x = cvtpk(O[db][4 * gq + 0] * inv, O[db][4 * gq + 1] * inv); w.y = cvtpk(O[db][4 * gq + 2] * inv, O[db][4 * gq + 3] * inv); *(GAS u32x2*)(op + d0) = w; }
    }
}

DI void route_rows4(const KA& a, int l, bf16* xr_, int tok0, int lane_) {
    int lane = lane_; asm volatile("" : "+v"(lane));
    const GAS float* xrow = (const GAS float*)a.out + (size_t)tok0 * 1024; const GAS float* g = (const GAS float*)(a.in[28] + (size_t)l * 1024); GAS bf16* xr = (GAS bf16*)xr_;
    f32x4 v[4][4]; float ss[4];
#pragma unroll
    for (int rr = 0; rr < 4; ++rr)
#pragma unroll
        for (int j = 0; j < 4; ++j) v[rr][j] = *(const GAS f32x4*)(xrow + (size_t)rr * 1024 + 4 * (lane + 64 * j));
#pragma unroll
    for (int rr = 0; rr < 4; ++rr) { float t = 0.f;
#pragma unroll
        for (int j = 0; j < 4; ++j) t += (v[rr][j][0] * v[rr][j][0] + v[rr][j][1] * v[rr][j][1]) + (v[rr][j][2] * v[rr][j][2] + v[rr][j][3] * v[rr][j][3]);
        ss[rr] = t; }
#pragma unroll
    for (int rr = 0; rr < 4; ++rr) ss[rr] = wave_sum(ss[rr]);
#pragma unroll
    for (int j = 0; j < 4; ++j) { const int k0 = 4 * (lane + 64 * j); const f32x4 gv = *(const GAS f32x4*)(g + k0);
#pragma unroll
        for (int rr = 0; rr < 4; ++rr) { const float r = 1.f / sqrtf(ss[rr] * (1.f / 1024.f) + 1e-6f); const f32x4 xn = v[rr][j] * r * gv;
            unsigned hi[4]; float lo[4];
#pragma unroll
            for (int e = 0; e < 4; ++e) { hi[e] = f2bf(xn[e]); lo[e] = xn[e] - __builtin_bit_cast(float, hi[e] << 16); }
            u32x2 wh, wl; wh.x = hi[0] | (hi[1] << 16); wh.y = hi[2] | (hi[3] << 16); wl.x = pk2(lo[0], lo[1]); wl.y = pk2(lo[2], lo[3]);
            *(GAS u32x2*)(xr + (size_t)(tok0 + rr) * 2048 + k0) = wh; *(GAS u32x2*)(xr + (size_t)(tok0 + rr) * 2048 + 1024 + k0) = wl; } }
}
struct SchedRoute { const char* A; const char* B; int pm;
    DI bool next(int i, Unit& u) const { if (i > 0) return false; u.pm = pm; u.pn = 0; u.aux = 0; u.pad = 0; u.a = A + (size_t)pm * 128 * 2048 * 2; u.b = B; return true; } };
struct EpiRoute { static constexpr bool CARRY = false; float* rlog;
    DI void operator()(const f32x4 (&acc)[2][2][4][2], const Unit& u, int wr, int wc, int fr, int fq) const {
        const int row0 = u.pm * 128 + wr * 64 + fr; const int col = wc * 32 + 8 * fq;
#pragma unroll
        for (int m = 0; m < 4; ++m) { float* rp = rlog + (size_t)(row0 + m * 16) * 128 + col; *(f32x4*)rp = acc[0][0][m][0]; *(f32x4*)(rp + 4) = acc[0][0][m][1]; }
    }
};
DI void route_decide(const KA& a, int l, const float* rl_row, int* rec_e, int* rec_slot, float* rec_w, unsigned* cnt, int tok) {
    float lg[36];
    const float* bg = a.in[30] + l * 4; const float* be = a.in[32] + l * 32;
#pragma unroll
    for (int q = 0; q < 9; ++q) { const f32x4 h = *(const f32x4*)(rl_row + 4 * q), lo = *(const f32x4*)(rl_row + 64 + 4 * q);
        lg[4 * q + 0] = h[0] + lo[0]; lg[4 * q + 1] = h[1] + lo[1]; lg[4 * q + 2] = h[2] + lo[2]; lg[4 * q + 3] = h[3] + lo[3]; }
#pragma unroll
    for (int i = 0; i < 4; ++i) lg[i] += bg[i];
#pragma unroll
    for (int i = 0; i < 32; ++i) lg[4 + i] += be[i];
    int gsel = 0; float gm = lg[0];
#pragma unroll
    for (int i = 1; i < 4; ++i) if (lg[i] > gm) { gm = lg[i]; gsel = i; }
    float gs = 0.f;
#pragma unroll
    for (int i = 0; i < 4; ++i) gs += __expf(lg[i] - gm);
    const float gwt = 1.f / gs;
    float v8[8];
#pragma unroll
    for (int i = 0; i < 8; ++i) { float x = lg[4 + i];
#pragma unroll
        for (int gq = 1; gq < 4; ++gq) x = (gsel == gq) ? lg[4 + gq * 8 + i] : x;
        v8[i] = x; }
    int i0 = 0; float m0 = v8[0];
#pragma unroll
    for (int i = 1; i < 8; ++i) if (v8[i] > m0) { m0 = v8[i]; i0 = i; }
    int i1 = -1; float m1 = -3e38f;
#pragma unroll
    for (int i = 0; i < 8; ++i) if (i != i0 && v8[i] > m1) { m1 = v8[i]; i1 = i; }
    if (i1 < 0) i1 = (i0 == 0) ? 1 : 0;
    const float w0 = 1.f / (1.f + __expf(m1 - m0)); const float w1 = 1.f - w0;
    const int e0 = gsel * 8 + i0, e1 = gsel * 8 + i1;
    const unsigned s0 = __hip_atomic_fetch_add(cnt + e0, 1u, __ATOMIC_RELAXED, __HIP_MEMORY_SCOPE_AGENT);
    const unsigned s1 = __hip_atomic_fetch_add(cnt + e1, 1u, __ATOMIC_RELAXED, __HIP_MEMORY_SCOPE_AGENT);
    rec_e[tok * 2] = e0; rec_e[tok * 2 + 1] = e1; rec_slot[tok * 2] = (int)s0; rec_slot[tok * 2 + 1] = (int)s1; rec_w[tok * 2] = w0 * gwt; rec_w[tok * 2 + 1] = w1 * gwt;
}
DI void expert_weights(const KA& a, int l, LAS unsigned char* lds, int it0, int it1, int gw, int NGW, int wave, int lane) {
    LAS float* scr = (LAS float*)(lds + wave * 16384);
    const float* wgt = a.in[33] + (size_t)l * 32 * 1024 * 256; const float* wup = a.in[34] + (size_t)l * 32 * 1024 * 256; const float* wdn = a.in[35] + (size_t)l * 32 * 256 * 1024;
    bf16* Wgu = (bf16*)(a.ws + WS_WGU); bf16* Wd = (bf16*)(a.ws + WS_WD);
    constexpr int I_E = 16 * 8, I_D = 4 * 32;
    constexpr int NIT = 32 * (2 * I_E + I_D);
    (void)NIT;
    for (int it = it0 + gw; it < it1; it += NGW) {
        const int e = it / (2 * I_E + I_D); int r = it % (2 * I_E + I_D);
        if (r < 2 * I_E) { const int up = r / I_E, q = r % I_E, kb = q / 8, nb = q % 8; const int n0 = nb * 32;
            const int drow = (n0 >> 7) * 256 + up * 128 + (n0 & 127);
            transpose_item((up ? wup : wgt) + (size_t)e * 1024 * 256, 256, 256, Wgu + (size_t)e * 512 * 1024, 1024, kb * 64, n0, drow, scr, lane);
        } else { r -= 2 * I_E; const int kb = r / 32, nb = r % 32;
            transpose_item(wdn + (size_t)e * 256 * 1024, 1024, 1024, Wd + (size_t)e * 1024 * 256, 256, kb * 64, nb * 32, nb * 32, scr, lane); }
    }
}
DI void build_offsets(const unsigned* cnt, LAS int* offt, int tid) {
    if (tid < 32) { const int c = (int)__hip_atomic_load(cnt + tid, __ATOMIC_RELAXED, __HIP_MEMORY_SCOPE_AGENT); offt[330 + tid] = (c + 255) & ~255; }
    __syncthreads();
    if (tid == 0) { int o = 0;
#pragma unroll
        for (int e = 0; e < 32; ++e) { offt[e] = o; o += offt[330 + e]; } offt[32] = o; }
    __syncthreads();
    for (int rt = tid; rt < (MOE_ROWS >> 8); rt += 512) { int e = 0; for (int j = 1; j < 32; ++j) e += (offt[j] <= rt * 256) ? 1 : 0; offt[40 + rt] = e; }
    __syncthreads();
}

template <unsigned PM>
__global__ void __launch_bounds__(512, 2) mk_fwd(Args a_) {
    extern __shared__ __attribute__((aligned(16))) unsigned char lds_raw[];
    LAS unsigned char* lds = (LAS unsigned char*)lds_raw;
    const int wave0 = __builtin_amdgcn_readfirstlane((int)threadIdx.x >> 6);
    if (threadIdx.x < 36) ((LAS unsigned long long*)(lds + PTAB_OFF))[threadIdx.x] = (unsigned long long)a_.in[threadIdx.x];
    __syncthreads();
    KA a; a.in.base = (unsigned)(size_t)(lds + PTAB_OFF); a.out = a_.out; a.ws = a_.ws;
    const int G = gridDim.x, bid = blockIdx.x, NGW = G * 8;
#define PHASE_IDS() int wave = wave0; asm volatile("" : "+s"(wave)); const int lane = my_lane(); const int tid_ = wave * 64 + lane, gw = bid * 8 + wave; (void)tid_; (void)gw; \
    KA ap = a; asm volatile("" : "+s"(ap.ws), "+s"(ap.out), "+s"(ap.in.base)); \
    bf16* hb = (bf16*)(ap.ws + WS_HB); bf16* proj = (bf16*)(ap.ws + WS_PROJ); bf16* gates = (bf16*)(ap.ws + WS_GATES); \
    bf16* ys = hb; bf16* x2b = hb; bf16* merged = proj; bf16* eo = proj; \
    bf16* kcb = (bf16*)(ap.ws + WS_KCVC); float* lrusum = (float*)(ap.ws + WS_LRUSUM); \
    int* rec_e = (int*)(ap.ws + WS_REC); int* rec_slot = rec_e + T * 2; float* rec_w = (float*)(rec_slot + T * 2); \
    int* rowtok = (int*)(ap.ws + WS_ROWTOK); float* roww = (float*)(ap.ws + WS_ROWW); \
    bf16* xs = (bf16*)(ap.ws + WS_XS); bf16* hmid = (bf16*)(ap.ws + WS_HMID); unsigned* ctl = (unsigned*)(ap.ws + WS_CTL); \
    (void)hb; (void)proj; (void)gates; (void)ys; (void)x2b; (void)merged; (void)eo; (void)kcb; (void)lrusum; (void)rec_e; (void)rec_slot; (void)rec_w; (void)rowtok; (void)roww; (void)xs; (void)hmid; (void)ctl
    volatile LAS unsigned* MISC = (volatile LAS unsigned*)(lds + MISC_OFF);
    LAS float* biasd = (LAS float*)(lds + BIAS_OFF);
    LAS int* offt = (LAS int*)(lds + OFFT_OFF);
    { PHASE_IDS();
    if (tid_ < 64) MISC[tid_] = 0u;
    for (int i = tid_; i < 129 * 12; i += 512) { const int d = i / 12, hd = i % 12; const int bk = d < 128 ? T5_BUCKET[d] : 31; const float* rb = a.in[1]; biasd[i] = rb[bk * 12 + hd]; ((LAS float*)(lds + BIAS2_OFF))[i] = (rb[bk * 12 + hd] - rb[31 * 12 + hd]) * 1.4426950408889634f; } }
    __syncthreads();
    const int lo = a_.ph_lo, hi = a_.ph_hi;
    XcdBarrier bar; bar.bar = (unsigned*)(a.ws + WS_CTL) + CW_BAR; bar.x = 0; bar.st = nullptr;
    if (hi - lo > 1) { PHASE_IDS(); bar = xcd_barrier_post(ctl + CW_BAR, MISC + 8, tid_ == 0); }
#ifndef SUB_MASK
#define SUB_MASK 0xFFu
#endif
#define SUB(k) ((SUB_MASK >> (k)) & 1u)
#define HASP(k) ((PM >> ((k) % PPL + ((k) >= 2 * PPL ? PPL : 0))) & 1u)
#define IN(k) (HASP(k) && lo <= (k) && (k) < hi)
#define SEAM(k) do { if ((k) + 1 < hi) { const int sl_ = my_lane(); int sw_ = wave0; asm volatile("" : "+s"(sw_)); xcd_barrier(bar, sw_ == 0 && sl_ == 0); } } while (0)
    for (int l = 0; l < DEPTH; ++l) {
        const int pb = l * PPL;
        if (IN(pb + 0)) { PHASE_IDS(); p1_weights_i8(ap, l, lds, gw, NGW, wave, lane); router_weights(ap, l, gw, NGW, lane); lru_weights(ap, l, gw, NGW, lane); cmp_weights(ap, l, lds, gw, NGW, wave, lane); phase0_weights(ap, l, lds, gw, NGW, wave, lane); phase0_rows(ap, l, 0, gw, NGW, lane); SEAM(pb + 0); }
        if (IN(pb + 1)) {
            PHASE_IDS();
            {   int K1q = 512; asm volatile("" : "+s"(K1q));
                pg8::Gemm g{K1q, 512, 512, 128, -1}; SchedP1 S{(const char*)(ap.ws + WS_HQ), (const char*)(ap.ws + WS_WQ), 128, 26, 1024, 1024, G, bid};
                EpiP1I8 E{proj, (unsigned char*)gates, ap.in[25] + (size_t)l * 4096, (const float*)(ap.ws + WS_HSC), (const float*)(ap.ws + WS_WSC)};
                pg8::gemm_phase<EpiP1I8, SchedP1, false, true>(lds, g, S, E, tid_); }
            SEAM(pb + 1);
        }
        if (IN(pb + 2)) {
            PHASE_IDS();
            LAS float* lamp = (LAS float*)(lds + MISC_OFF + 64);
            if (tid_ < 64) { const float* q1 = ap.in[13] + l * 32; const float* k1 = ap.in[14] + l * 32; const float* q2 = ap.in[15] + l * 32; const float* k2 = ap.in[16] + l * 32;
                float s1 = (lane < 32) ? q1[lane] * k1[lane] : 0.f, s2 = (lane < 32) ? q2[lane] * k2[lane] : 0.f; s1 = wave_sum(s1); s2 = wave_sum(s2);
                const float lam_init = 0.8f - 0.6f * __expf(-0.3f * (float)l); if (lane == 0) { lamp[0] = __expf(s1) - __expf(s2) + lam_init; lamp[1] = lam_init; } }
            __syncthreads();
            if (SUB(0)) { const LAS float* bias2 = (const LAS float*)(lds + BIAS2_OFF); const GAS float* subg = (const GAS float*)(ap.in[17] + l * 64);
                for (int pi = bid; pi < 256; pi += G) { const int bh = pi >> 4, qlo = pi & 15;
                    diff_unit((const GAS bf16*)proj, (GAS bf16*)ys, lds, bias2, subg, lamp, bh >> 2, bh & 3, 31 - qlo, wave);
                    diff_unit((const GAS bf16*)proj, (GAS bf16*)ys, lds, bias2, subg, lamp, bh >> 2, bh & 3, qlo, wave); } }
            { PHASE_IDS();
            if (SUB(3)) { __syncthreads(); const LAS float* bias2 = (const LAS float*)(lds + BIAS2_OFF); const GAS float* sinks = (const GAS float*)(ap.in[12] + l * 4);
                for (int pi = bid; pi < 512; pi += G) swa_unit((const GAS bf16*)proj, (GAS bf16*)ys, lds, bias2, biasd, sinks, pi >> 7, pi & 127, tid_, lane, wave); }
            if (SUB(2)) { pg8::Gemm g{1024, 16 * PLD, 1024, PLD * 2, -1}; SchedCmp S{(const char*)proj, (const char*)(ap.ws + WS_WCMP), G, bid}; EpiCmp E{(float*)(ap.ws + WS_CMPAB)};
                pg8::gemm_phase<EpiCmp, SchedCmp>(lds, g, S, E, tid_); }
            if (SUB(1)) { __syncthreads(); for (int task = bid; task < 512; task += G) lru_unit(ap, l, (const GAS bf16*)proj, (GAS bf16*)ys, (GAS float*)lrusum, lds, task, lane, wave, false); }
            }
            SEAM(pb + 2);
        }
        if (IN(pb + 3)) {
            PHASE_IDS();
            for (int task = gw; task < 2 * BATCH * NCMP; task += NGW) cmp_finish(ap, l, (const float*)(ap.ws + WS_CMPAB), kcb, task, lane);
            __syncthreads();
            for (int task = bid; task < 512; task += G) lru_unit(ap, l, (const GAS bf16*)proj, (GAS bf16*)ys, (GAS float*)lrusum, lds, task, lane, wave, true);
            SEAM(pb + 3);
        }
        if (IN(pb + 4)) {
            PHASE_IDS();
            if (SUB(4)) { const LAS float* bias2 = (const LAS float*)(lds + BIAS2_OFF);
                for (int pi = bid; pi < 256; pi += G) { const int bb = pi >> 6, ulo = pi & 63;
                    nsa_unit((const GAS bf16*)proj, (GAS bf16*)ys, (const GAS bf16*)kcb, lds, bias2, bb, 127 - ulo, tid_, lane, wave);
                    nsa_unit((const GAS bf16*)proj, (GAS bf16*)ys, (const GAS bf16*)kcb, lds, bias2, bb, ulo, tid_, lane, wave); } }
            SEAM(pb + 4);
        }
        if (IN(pb + 5)) {
            PHASE_IDS();
            int K5 = 256; asm volatile("" : "+s"(K5));
            pg8::Gemm g{K5, 1024, 256, 128, -1}; SchedP3a S{(const char*)ys, (const char*)(ap.ws + WS_WBR), G, bid};
            EpiP3a E{merged, (const unsigned char*)gates};
            pg8::gemm_phase<EpiP3a, SchedP3a>(lds, g, S, E, tid_); SEAM(pb + 5);
        }
        if (IN(pb + 6)) {
            PHASE_IDS();
            int K6 = 1024; asm volatile("" : "+s"(K6));
            pg8::Gemm g{K6, 1024, 1024, 128, -1}; SchedP3b S{(const char*)merged, (const char*)(ap.ws + WS_WOUT), G, bid};
            EpiP3b E{(l == 0) ? ap.in[0] : ap.out, ap.out};
            pg8::gemm_phase<EpiP3b, SchedP3b>(lds, g, S, E, tid_); SEAM(pb + 6);
        }
        if (IN(pb + 7)) {
            PHASE_IDS();
            bf16* xr = (bf16*)(ap.ws + WS_XR); float* rlog = (float*)(ap.ws + WS_RLOG);
            constexpr int NITW = 32 * (2 * 16 * 8 + 4 * 32);
            { const int pm = bid;
                for (int r = wave * 4; r < 128; r += 32) route_rows4(ap, l, xr, pm * 128 + r, lane);
                asm volatile("s_waitcnt vmcnt(0)" ::: "memory"); __syncthreads();
                { pg8::Gemm g{2048, 2048, 2048, 128, 0}; SchedRoute S{(const char*)xr, (const char*)(ap.ws + WS_WR), pm}; EpiRoute E{rlog};
                  pg8::gemm_phase<EpiRoute, SchedRoute>(lds, g, S, E, tid_); }
                asm volatile("s_waitcnt vmcnt(0)" ::: "memory"); __syncthreads();
                if (tid_ < 128) route_decide(ap, l, rlog + (size_t)(pm * 128 + tid_) * 128, rec_e, rec_slot, rec_w, ctl + CW_CNT + l * 32, pm * 128 + tid_);
                __syncthreads();
            }
            expert_weights(ap, l, lds, 0, NITW, gw, NGW, wave, lane);
            SEAM(pb + 7);
        }
        if (IN(pb + 8)) {
            PHASE_IDS();
            build_offsets(ctl + CW_CNT + l * 32, offt, tid_);
            if (bid < 32) { const int e = bid; const int c = (int)__hip_atomic_load(ctl + CW_CNT + l * 32 + e, __ATOMIC_RELAXED, __HIP_MEMORY_SCOPE_AGENT);
                for (int p = offt[e] + c + tid_; p < offt[e + 1]; p += 512) rowtok[p] = -1; }
            {   int* rowsrc = (int*)xs;
                if (bid < 32) { const int e = bid; const int c = (int)__hip_atomic_load(ctl + CW_CNT + l * 32 + e, __ATOMIC_RELAXED, __HIP_MEMORY_SCOPE_AGENT);
                    for (int p = offt[e] + c + tid_; p < offt[e + 1]; p += 512) rowsrc[p] = 0; }
                for (int as = bid * 512 + tid_; as < 2 * T; as += G * 512) { const int p = offt[rec_e[as]] + rec_slot[as];
                    rowtok[p] = as; roww[p] = rec_w[as]; rowsrc[p] = as >> 1; } }
            SEAM(pb + 8);
        }
        if (IN(pb + 9)) {
            PHASE_IDS();
            build_offsets(ctl + CW_CNT + l * 32, offt, tid_);
            int K9 = 1024; asm volatile("" : "+s"(K9));
            pg8::Gemm g{K9, 2048, 1024, 128, -1}; SchedM2 S{(const char*)(ap.ws + WS_XR), (const char*)(ap.ws + WS_WGU), offt, (const int*)xs, G, bid};
            EpiM2 E{hmid};
            pg8::gemm_phase<EpiM2, SchedM2, true>(lds, g, S, E, tid_); SEAM(pb + 9);
        }
        if (IN(pb + 10)) {
            PHASE_IDS();
            build_offsets(ctl + CW_CNT + l * 32, offt, tid_);
            int K3 = 256; asm volatile("" : "+s"(K3));
            pg8::Gemm g{K3, 256, 256, 128, -1}; SchedM3 S{(const char*)hmid, (const char*)(ap.ws + WS_WD), offt, G, bid};
            EpiM3 E{eo, rowtok, roww};
            pg8::gemm_phase<EpiM3, SchedM3>(lds, g, S, E, tid_); SEAM(pb + 10);
        }
    }
    if (IN(2 * PPL)) { PHASE_IDS(); phase0_rows(ap, DEPTH, 1, gw, NGW, lane); }
#undef IN
#undef SEAM
}

typedef void (*kern_t)(Args);
template <unsigned PM> static bool setup_kernel() {
    if (hipFuncSetAttribute((const void*)mk_fwd<PM>, hipFuncAttributeMaxDynamicSharedMemorySize, LDS_BYTES) != hipSuccess) { fprintf(stderr, "kernel_launch: hipFuncSetAttribute failed\n"); return false; }
    return true;
}
extern "C" void kernel_launch(void* const* d_in, const int* in_sizes, int n_in, void* d_out, int out_size, void* d_ws, size_t ws_size, hipStream_t stream) {
    static int grid = 0;
    if (grid == 0) {
        if (n_in != 36 || out_size != T * D || ws_size < WS_END) { fprintf(stderr, "kernel_launch: unexpected shapes (n_in %d out %d ws %zu)\n", n_in, out_size, ws_size); grid = -1; return; }
        int dev = 0, cus = 0;
        if (hipGetDevice(&dev) != hipSuccess || hipDeviceGetAttribute(&cus, hipDeviceAttributeMultiprocessorCount, dev) != hipSuccess) { grid = -1; return; }
        bool ok = true;
#if MK_ONE_LAUNCH
        ok = setup_kernel<0xFFFu>();
#endif
        if (!ok) { grid = -1; return; }
        (void)hipGetLastError();
        grid = cus;
        if (grid != 256) { fprintf(stderr, "kernel_launch: built for a 256-CU device (got %d)\n", cus); grid = -1; return; }
    }
    if (grid < 0) return;
    if (hipMemsetAsync((char*)d_ws + WS_CTL, 0, CTL_ZERO_BYTES, stream) != hipSuccess) return;
    Args a{};
    for (int i = 0; i < 36; ++i) a.in[i] = (const float*)d_in[i];
    a.out = (float*)d_out; a.ws = (unsigned char*)d_ws;
#if MK_ONE_LAUNCH
    a.ph_lo = 0; a.ph_hi = NPH;
    hipLaunchKernelGGL(mk_fwd<0xFFFu>, dim3(grid), dim3(512), LDS_BYTES, stream, a);
#endif
}
```

```cpp
#include <hip/hip_runtime.h>
#include <cstdio>
#include <cstdint>

#ifndef MK_ONE_LAUNCH
#define MK_ONE_LAUNCH 1
#endif

#define DI __device__ __forceinline__
#define GAS __attribute__((address_space(1)))
#define LAS __attribute__((address_space(3)))
typedef unsigned short bf16;
typedef short bf16x8 __attribute__((ext_vector_type(8)));
typedef float f32x4 __attribute__((ext_vector_type(4)));
typedef int i32x4 __attribute__((ext_vector_type(4)));
typedef unsigned u32x4 __attribute__((ext_vector_type(4)));
typedef unsigned u32x2 __attribute__((ext_vector_type(2)));
typedef float f32x16 __attribute__((ext_vector_type(16)));
typedef float f32x2 __attribute__((ext_vector_type(2)));
typedef short s16x4 __attribute__((ext_vector_type(4)));
typedef __bf16 bf16x2_t __attribute__((ext_vector_type(2)));
typedef short v4i16_t __attribute__((__vector_size__(4 * sizeof(short))));
#define MFMA32(a, b, c) __builtin_amdgcn_mfma_f32_32x32x16_bf16((a), (b), (c), 0, 0, 0)

constexpr int BATCH = 4, SEQ = 8192, T = BATCH * SEQ, D = 1024, DEPTH = 2;
constexpr int NIN = 2444, PLD = 2560, N1 = 6656, GLD = 4096;
constexpr int C_AX = 0, C_AG = 256, C_BQ = 512, C_BK = 768, C_BV = 896, C_CQ = 1024, C_CK = 1280, C_CV = 1536, C_DQ = 1792,
              C_KC = 2048, C_VC = 2112, C_KS = 2176, C_VS = 2240, C_KW = 2304, C_VW = 2368, C_DG = 2432;
constexpr int NCMP = 511;
constexpr int MOE_ROWS = 73728;
constexpr int PPL = 11;
constexpr int NPH = 2 * PPL + 1;

constexpr size_t MiB = 1u << 20;
constexpr size_t WS_CTL = 0, CTL_ZERO_BYTES = 1 * MiB;
constexpr size_t WS_KCVC = 1 * MiB;
constexpr size_t WS_LRUSUM = 2 * MiB;
constexpr size_t WS_REC = 2 * MiB + 256 * 1024;
constexpr size_t WS_ROWTOK = 3 * MiB;
constexpr size_t WS_ROWW = 3 * MiB + 512 * 1024;
constexpr size_t WS_WIN = 4 * MiB;
constexpr size_t WS_WQ = 4 * MiB;
constexpr size_t WS_WSC = 13 * MiB;
constexpr size_t WS_HSC = 13 * MiB + 65536;
constexpr size_t WS_HQ = 373 * MiB;
constexpr size_t WS_WBR = 17 * MiB;
constexpr size_t WS_WOUT = 19 * MiB;
constexpr size_t WS_HB = 21 * MiB;
constexpr size_t WS_PROJ = 85 * MiB;
constexpr size_t WS_GATES = 245 * MiB;
constexpr size_t WS_WGU = 245 * MiB;
constexpr size_t WS_WD = 277 * MiB;
constexpr size_t WS_XS = 293 * MiB;
constexpr size_t WS_HMID = 437 * MiB;
constexpr size_t WS_XR = 85 * MiB;
constexpr size_t WS_RLOG = 213 * MiB;
constexpr size_t WS_WR = 501 * MiB;
constexpr size_t WS_WCMP = 502 * MiB;
constexpr size_t WS_CMPAB = 503 * MiB;
constexpr size_t WS_LRUW = 505 * MiB + 65536;
constexpr size_t WS_END = 506 * MiB;
constexpr int CW_BAR = 4096;
constexpr int CW_CNT = 16384;

constexpr int RING_BYTES = 131072;
constexpr int MISC_OFF = RING_BYTES;
constexpr int BIAS_OFF = MISC_OFF + 256;
constexpr int OFFT_OFF = BIAS_OFF + 129 * 12 * 4;
constexpr int PTAB_OFF = OFFT_OFF + (40 + 288 + 40) * 4;
constexpr int BIAS2_OFF = PTAB_OFF + 36 * 8;
constexpr int LRUEX_OFF = BIAS2_OFF + 129 * 12 * 4;
constexpr int LDS_BYTES = 163840;
constexpr int LRUCST_OFF = LRUEX_OFF + 8 * 64 * 2 * 4;
constexpr int LRUCAR_OFF = LRUCST_OFF + 3 * 64 * 4;
static_assert(PTAB_OFF % 8 == 0 && LRUCAR_OFF + 8 * 64 * 4 <= LDS_BYTES, "LDS map");

DI float bf2f(bf16 v) { return __builtin_bit_cast(float, (unsigned)v << 16); }
DI float lo_bf(unsigned w) { return __builtin_bit_cast(float, w << 16); }
DI float hi_bf(unsigned w) { return __builtin_bit_cast(float, w & 0xffff0000u); }
DI unsigned f2bf(float f) { unsigned u = __builtin_bit_cast(unsigned, f); return (u + 0x7fffu + ((u >> 16) & 1u)) >> 16; }
DI unsigned pk2(float lo, float hi) { return f2bf(lo) | (f2bf(hi) << 16); }
DI float rl(float v, int i) { return __builtin_bit_cast(float, __builtin_amdgcn_readlane(__builtin_bit_cast(int, v), i)); }
DI int rli(int v, int i) { return __builtin_amdgcn_readlane(v, i); }
DI int my_lane() { int l; asm volatile("v_mbcnt_lo_u32_b32 %0, -1, 0\n\tv_mbcnt_hi_u32_b32 %0, -1, %0" : "=v"(l)); return l; }
template <int O> DI int xshfl_i(int v) {
    if constexpr (O < 32) return __builtin_amdgcn_ds_swizzle(v, (O << 10) | 0x1f);
    else { const int l = my_lane(); return __builtin_amdgcn_ds_bpermute((l ^ 32) << 2, v); }
}
template <int O> DI float xshfl(float v) { return __builtin_bit_cast(float, xshfl_i<O>(__builtin_bit_cast(int, v))); }
DI float wave_sum(float v) { v += xshfl<1>(v); v += xshfl<2>(v); v += xshfl<4>(v); v += xshfl<8>(v); v += xshfl<16>(v); v += xshfl<32>(v); return v; }
DI float wave_max(float v) { v = fmaxf(v, xshfl<1>(v)); v = fmaxf(v, xshfl<2>(v)); v = fmaxf(v, xshfl<4>(v)); v = fmaxf(v, xshfl<8>(v)); v = fmaxf(v, xshfl<16>(v)); v = fmaxf(v, xshfl<32>(v)); return v; }
DI float sigmoidf_(float x) { return __builtin_amdgcn_rcpf(1.f + __builtin_amdgcn_exp2f(-1.4426950408889634f * x)); }
DI float gelu_tanh(float x) { const float u = 0.7978845608028654f * (x + 0.044715f * x * x * x); const float e = __expf(2.f * u); const float th = 1.f - 2.f * __builtin_amdgcn_rcpf(e + 1.f); return 0.5f * x * (1.f + th); }
DI float softplusf_(float x) { return fmaxf(x, 0.f) + log1pf(__expf(-fabsf(x))); }
#define LDS_WAIT() asm volatile("s_waitcnt lgkmcnt(0)" ::: "memory")
#define VM_WAIT() asm volatile("s_waitcnt vmcnt(0)" ::: "memory")

__device__ const unsigned char T5_BUCKET[128] = {
0,1,2,3,4,5,6,7,8,9,10,11,12,13,14,15,16,16,16,17,17,18,18,18,19,19,19,20,20,20,20,21,21,21,21,22,22,22,22,22,23,23,23,23,23,23,24,24,24,24,24,24,25,25,25,25,25,25,25,26,26,26,26,26,26,26,26,27,27,27,27,27,27,27,27,27,27,28,28,28,28,28,28,28,28,28,28,29,29,29,29,29,29,29,29,29,29,29,29,30,30,30,30,30,30,30,30,30,30,30,30,30,30,31,31,31,31,31,31,31,31,31,31,31,31,31,31,31};

#define XB_TMO      128
#define XB_XCNT(j)  (256  + 64 * (j))
#define XB_XSUB(j)  (1280 + 64 * (j))
#define XB_XGEN(j)  (2304 + 64 * (j))
#define XB_TOP      3328
#define XB_TOPGEN   3392
#define XCD_BAR_WORDS 3456
#define XB_SPIN_CAP (1u << 22)
DI unsigned xb_ld(unsigned* p)              { return __hip_atomic_load(p, __ATOMIC_RELAXED, __HIP_MEMORY_SCOPE_AGENT); }
DI unsigned xb_add(unsigned* p, unsigned v) { return __hip_atomic_fetch_add(p, v, __ATOMIC_RELAXED, __HIP_MEMORY_SCOPE_AGENT); }
DI unsigned xb_xcc_id() { return (unsigned)__builtin_amdgcn_s_getreg((3 << 11) | 20) & 0xFu; }
#define XB_SPIN(cond, bar) do { unsigned _sp = 0; while (cond) { __builtin_amdgcn_s_sleep(1); \
    if ((++_sp & 255u) == 0u) { if (xb_ld(&(bar)[XB_TMO])) break; if (_sp > XB_SPIN_CAP) { atomicAdd(&(bar)[XB_TMO], 1u); break; } } } } while (0)
struct XcdBarrier { unsigned* bar; unsigned x; volatile LAS unsigned* st; };
DI XcdBarrier xcd_barrier_post(unsigned* bar, volatile LAS unsigned* st, bool leader) {
    XcdBarrier b; b.bar = bar; b.x = xb_xcc_id(); b.st = st;
    if (leader) (void)xb_add(&bar[XB_XCNT(b.x)], 1u);
    return b;
}
DI void xcd_barrier_complete(unsigned* bar, unsigned x, unsigned& nloc, unsigned& nx) {
    const unsigned G = gridDim.x * gridDim.y * gridDim.z;
    unsigned sum, cnt, mine, sp = 0u;
    for (;;) {
        sum = 0u; cnt = 0u; mine = 0u;
#pragma unroll
        for (unsigned j = 0; j < 16; ++j) { const unsigned c = xb_ld(&bar[XB_XCNT(j)]); sum += c; cnt += (c > 0u) ? 1u : 0u; mine = (j == x) ? c : mine; }
        if (sum == G) break;
        __builtin_amdgcn_s_sleep(1);
        if ((++sp & 255u) == 0u) { if (xb_ld(&bar[XB_TMO])) break; if (sp > XB_SPIN_CAP) { atomicAdd(&bar[XB_TMO], 1u); break; } }
    }
    nloc = mine > 0u ? mine : 1u; nx = cnt > 0u ? cnt : 1u;
}
DI void xcd_barrier(const XcdBarrier& b, bool leader) {
    asm volatile("s_waitcnt vmcnt(0)" ::: "memory");
    __syncthreads();
    if (leader) {
        unsigned* bar = b.bar;
        __builtin_amdgcn_s_waitcnt(0);
        unsigned nloc = b.st[0], nx = b.st[1];
        if (nloc == 0u) { xcd_barrier_complete(bar, b.x, nloc, nx); b.st[0] = nloc; b.st[1] = nx; }
        const unsigned old = xb_add(&bar[XB_XSUB(b.x)], 1u);
        const unsigned gen = old / nloc;
        if (old + 1u == (gen + 1u) * nloc) {
            __builtin_amdgcn_fence(__ATOMIC_RELEASE, "agent");
            asm volatile("s_waitcnt vmcnt(0)" ::: "memory");
            const unsigned og = xb_add(&bar[XB_TOP], 1u);
            const unsigned tg = og / nx;
            if (og + 1u == (tg + 1u) * nx) xb_add(&bar[XB_TOPGEN], 1u);
            else XB_SPIN(xb_ld(&bar[XB_TOPGEN]) == tg, bar);
            __builtin_amdgcn_fence(__ATOMIC_ACQUIRE, "agent");
            xb_add(&bar[XB_XGEN(b.x)], 1u);
            asm volatile("s_waitcnt vmcnt(0)" ::: "memory");
        } else {
            XB_SPIN(xb_ld(&bar[XB_XGEN(b.x)]) == gen, bar);
            __builtin_amdgcn_fence(__ATOMIC_ACQUIRE, "agent");
            asm volatile("s_waitcnt vmcnt(0)" ::: "memory");
        }
    }
    __syncthreads();
}

namespace pg8 {
constexpr int BM = 256, BK = 64, HALF = 128, HTB = HALF * BK * 2;
__host__ __device__ __forceinline__ int lds_byte(int r, int c) { const int st = (r >> 4) * 2 + (c >> 5), rr = r & 15, cc = c & 31, ob = rr * 64 + cc * 2; return st * 1024 + (ob ^ (((ob >> 9) & 1) << 5)); }
__host__ __device__ __forceinline__ void stage_rc(int b, int& R, int& C) { const int st = b / 1024, sb = b % 1024, swz = sb ^ (((sb >> 9) & 1) << 5); R = (st >> 1) * 16 + swz / 64; C = (st & 1) * 32 + (swz % 64) / 2; }
__host__ __device__ __forceinline__ int perm32(int rho) { const int n = rho >> 4, i = rho & 15; return 8 * (i >> 2) + 4 * n + (i & 3); }
struct Unit { const char* a; const char* b; int pm, pn, aux, pad; };
struct Gemm { int K, lda, ldb, kstepA, hstepA; };
template <bool I8> struct AccT { typedef f32x4 type; };
template <> struct AccT<true> { typedef i32x4 type; };
template <class Epi, class Sched, bool GATHER = false, bool I8 = false>
DI void gemm_phase(LAS unsigned char* lds, const Gemm g, const Sched& S, const Epi& E, int tid_in) {
    int tid = tid_in; asm volatile("" : "+v"(tid));
    const int wid = __builtin_amdgcn_readfirstlane(tid >> 6), lane = tid & 63, wr = wid >> 2, wc = wid & 3, fr = lane & 15, fq = lane >> 4;
    const int K = g.K, nt = K / BK;
    unsigned voffA[2], voffB[2];
#pragma unroll
    for (int i = 0; i < 2; ++i) { int R, C; stage_rc(tid * 16 + i * 8192, R, C); const int Rb = (R & ~31) + perm32(R & 31);
        voffA[i] = (unsigned)(R * g.lda + C) * 2u; voffB[i] = (unsigned)(Rb * g.ldb + C) * 2u; }
    const size_t kstep = (size_t)(BK * 2), kstepA = (size_t)g.kstepA;
    const size_t hstepA = g.hstepA < 0 ? (size_t)HALF * g.lda * 2 : (size_t)g.hstepA, hstepB = (size_t)HALF * g.ldb * 2;
    const unsigned hstepA32 = (unsigned)hstepA;
    unsigned gC[2][2] = {{0u, 0u}, {0u, 0u}}, gN[2][2] = {{0u, 0u}, {0u, 0u}};
    const unsigned ldsw = (unsigned)wid * 1024u;
    const int aoff = lds_byte(wr * 64 + fr, fq * 8), boff = lds_byte(wc * 32 + fr, fq * 8);
#define PG8_SA(b, h) (((b) * 2 + (h)) * HTB)
#define PG8_SB(b, h) ((4 + (b) * 2 + (h)) * HTB)
#define PG8_STAGE(bufoff, gbase, voff) do { _Pragma("unroll") for (int _i = 0; _i < 2; ++_i) \
        __builtin_amdgcn_global_load_lds((const unsigned*)((const char*)(gbase) + (voff)[_i]), (LAS unsigned*)(lds + (bufoff) + ldsw + _i * 8192), 16, 0, 0); } while (0)
#define PG8_STAGEA(bufoff, gbase, h, nextsel) do { _Pragma("unroll") for (int _i = 0; _i < 2; ++_i) { \
        const unsigned _o = GATHER ? ((nextsel) ? gN[h][_i] : gC[h][_i]) : (voffA[_i] + (unsigned)(h) * hstepA32); \
        __builtin_amdgcn_global_load_lds((const unsigned*)((const char*)(gbase) + _o), (LAS unsigned*)(lds + (bufoff) + ldsw + _i * 8192), 16, 0, 0); } } while (0)
#define PG8_LDA(dst, b, h) do { _Pragma("unroll") for (int m = 0; m < 4; ++m) _Pragma("unroll") for (int k = 0; k < 2; ++k) dst[m][k] = *(const LAS bf16x8*)(lds + PG8_SA(b, h) + aoff + m * 2048 + k * 1024); } while (0)
#define PG8_LDB(dst, b, h) do { _Pragma("unroll") for (int n = 0; n < 2; ++n) _Pragma("unroll") for (int k = 0; k < 2; ++k) dst[n][k] = *(const LAS bf16x8*)(lds + PG8_SB(b, h) + boff + n * 2048 + k * 1024); } while (0)
#define PG8_MMA(ai, bj, At, Bt) do { __builtin_amdgcn_s_setprio(1); _Pragma("unroll") for (int m = 0; m < 4; ++m) _Pragma("unroll") for (int n = 0; n < 2; ++n) _Pragma("unroll") for (int k = 0; k < 2; ++k) \
        { if constexpr (I8) acc[ai][bj][m][n] = __builtin_amdgcn_mfma_i32_16x16x64_i8(__builtin_bit_cast(i32x4, Bt[n][k]), __builtin_bit_cast(i32x4, At[m][k]), acc[ai][bj][m][n], 0, 0, 0); \
          else acc[ai][bj][m][n] = __builtin_amdgcn_mfma_f32_16x16x32_bf16(Bt[n][k], At[m][k], acc[ai][bj][m][n], 0, 0, 0); } __builtin_amdgcn_s_setprio(0); } while (0)
#define PG8_WAIT_V(n) asm volatile("s_waitcnt vmcnt(" #n ")" ::: "memory")
#define PG8_WAIT_L(n) asm volatile("s_waitcnt lgkmcnt(" #n ")" ::: "memory")
#define PG8_BAR __builtin_amdgcn_s_barrier()
#define PG8_SCHED __builtin_amdgcn_sched_barrier(0)
    Unit cur, nxt; int ui = 0;
    if (!S.next(0, cur)) return;
    typedef typename AccT<I8>::type ACC;
    ACC acc[2][2][4][2];
#pragma unroll
    for (int a = 0; a < 2; ++a)
#pragma unroll
        for (int b = 0; b < 2; ++b)
#pragma unroll
            for (int m = 0; m < 4; ++m)
#pragma unroll
                for (int n = 0; n < 2; ++n) acc[a][b][m][n] = (ACC){0, 0, 0, 0};
    bf16x8 At[4][2], B0[2][2], B1[2][2];
    const char* cA = cur.a; const char* cB = cur.b;
    if constexpr (GATHER) S.rows(cur, tid, gC);
    PG8_STAGE(PG8_SB(0, 0), cB, voffB); PG8_STAGE(PG8_SB(0, 1), cB + hstepB, voffB); PG8_STAGEA(PG8_SA(0, 0), cA, 0, false); PG8_STAGEA(PG8_SA(0, 1), cA, 1, false);
    if (wr == 1) PG8_BAR;
    PG8_WAIT_V(2); PG8_BAR;
    PG8_STAGE(PG8_SB(1, 0), cB + kstep, voffB); PG8_STAGEA(PG8_SA(1, 0), cA + kstepA, 0, false); PG8_STAGE(PG8_SB(1, 1), cB + hstepB + kstep, voffB);
    PG8_WAIT_V(6); PG8_BAR;
    for (;;) {
        const bool has_next = S.next(ui + 1, nxt);
        const char* nA = has_next ? nxt.a : cA; const char* nB = has_next ? nxt.b : cB;
        if constexpr (GATHER) { if (has_next) S.rows(nxt, tid, gN); else {
#pragma unroll
            for (int h = 0; h < 2; ++h) { gN[h][0] = gC[h][0]; gN[h][1] = gC[h][1]; } } }
        for (int t = 0; t < nt; t += 2) {
            const bool last = (t == nt - 2);
            const char* a1 = cA + (size_t)(t + 1) * kstepA;
            const char* a2 = last ? nA : cA + (size_t)(t + 2) * kstepA; const char* b2 = last ? nB : cB + (size_t)(t + 2) * kstep;
            const char* a3 = a2 + kstepA; const char* b3 = b2 + kstep;
            PG8_LDB(B0, 0, 0); PG8_LDB(B1, 0, 1); PG8_SCHED; PG8_LDA(At, 0, 0); PG8_STAGEA(PG8_SA(1, 1), a1, 1, false);
            PG8_WAIT_V(8); PG8_WAIT_L(0); PG8_BAR; PG8_MMA(0, 0, At, B0); PG8_MMA(0, 1, At, B1); PG8_BAR; PG8_SCHED;
            PG8_LDA(At, 0, 1); PG8_STAGE(PG8_SB(0, 0), b2, voffB); PG8_STAGE(PG8_SB(0, 1), b2 + hstepB, voffB); PG8_STAGEA(PG8_SA(0, 0), a2, 0, last);
            PG8_WAIT_V(8); PG8_WAIT_L(0); PG8_BAR; PG8_MMA(1, 0, At, B0); PG8_MMA(1, 1, At, B1); PG8_BAR; PG8_SCHED;
            PG8_LDB(B0, 1, 0); PG8_LDB(B1, 1, 1); PG8_SCHED; PG8_LDA(At, 1, 0); PG8_STAGEA(PG8_SA(0, 1), a2, 1, last);
            PG8_WAIT_V(8); PG8_WAIT_L(0); PG8_BAR; PG8_MMA(0, 0, At, B0); PG8_MMA(0, 1, At, B1); PG8_BAR; PG8_SCHED;
            PG8_LDA(At, 1, 1); PG8_STAGE(PG8_SB(1, 0), b3, voffB); PG8_STAGE(PG8_SB(1, 1), b3 + hstepB, voffB); PG8_STAGEA(PG8_SA(1, 0), a3, 0, last);
            PG8_WAIT_V(8); PG8_WAIT_L(0); PG8_BAR; PG8_MMA(1, 0, At, B0); PG8_MMA(1, 1, At, B1); PG8_BAR; PG8_SCHED;
        }
        if (wr == 0) PG8_BAR;
        { const int el = my_lane(); E(acc, cur, wr, wc, el & 15, el >> 4); }
        if (!has_next) break;
        bool carried = false;
        if constexpr (Epi::CARRY) { if (nxt.aux != 0) { const int el = my_lane(); E.carry(acc, nxt, wr, wc, el & 15, el >> 4); carried = true; } }
        if (!carried) {
#pragma unroll
        for (int a = 0; a < 2; ++a)
#pragma unroll
            for (int b = 0; b < 2; ++b)
#pragma unroll
                for (int m = 0; m < 4; ++m)
#pragma unroll
                    for (int n = 0; n < 2; ++n) acc[a][b][m][n] = (ACC){0, 0, 0, 0};
        }
        cur = nxt; cA = nA; cB = nB; ++ui;
        if constexpr (GATHER) {
#pragma unroll
            for (int h = 0; h < 2; ++h) { gC[h][0] = gN[h][0]; gC[h][1] = gN[h][1]; } }
        if (wr == 1) PG8_BAR;
    }
    PG8_WAIT_V(0);
    PG8_BAR;
#undef PG8_SA
#undef PG8_SB
#undef PG8_STAGE
#undef PG8_STAGEA
#undef PG8_LDA
#undef PG8_LDB
#undef PG8_MMA
#undef PG8_WAIT_V
#undef PG8_WAIT_L
#undef PG8_BAR
#undef PG8_SCHED
}
}
using pg8::Unit;

DI unsigned cvt_pk_bf16(float lo, float hi) { unsigned r; asm volatile("s_nop 1\n\tv_cvt_pk_bf16_f32 %0, %1, %2" : "=v"(r) : "v"(lo), "v"(hi)); return r; }
DI u32x4 pack8(const f32x4& v0, const f32x4& v1) { u32x4 w; w.x = cvt_pk_bf16(v0[0], v0[1]); w.y = cvt_pk_bf16(v0[2], v0[3]); w.z = cvt_pk_bf16(v1[0], v1[1]); w.w = cvt_pk_bf16(v1[2], v1[3]); return w; }

struct SchedP1 {
    const char* A; const char* B; int nM, nN, rbA, rbB, G, c;
    DI bool next(int i, Unit& u) const {
        constexpr int NXCD = 8, WGM = 8; const int nwg = nM * nN;
        const long L = (long)i * G + c; if (L >= nwg) return false;
        int wgid = (int)L; { const int q = nwg / NXCD, r = nwg % NXCD, xcd = wgid % NXCD, off = wgid / NXCD; wgid = (xcd < r ? xcd * (q + 1) : r * (q + 1) + (xcd - r) * q) + off; }
        const int nig = WGM * nN, gid = wgid / nig, fm = gid * WGM, gsz = (nM - fm) < WGM ? (nM - fm) : WGM;
        u.pm = fm + ((wgid % nig) % gsz); u.pn = (wgid % nig) / gsz; u.aux = 0; u.pad = 0;
        u.a = A + (size_t)u.pm * 256 * rbA; u.b = B + (size_t)u.pn * 256 * rbB; return true;
    }
};
struct SchedP3a {
    const char* ys; const char* wbr; int G, c;
    DI bool next(int i, Unit& u) const {
        const int tile = (i >> 2) * G + c; if (tile >= 512) return false;
        const int br = i & 3; u.pm = tile >> 2; u.pn = tile & 3; u.aux = br; u.pad = 0;
        u.a = ys + ((size_t)u.pm * 256 * 1024 + br * 256) * 2; u.b = wbr + ((size_t)br * 1024 * 256 + (size_t)u.pn * 256 * 256) * 2; return true;
    }
};
struct SchedP3b {
    const char* A; const char* B; int G, c;
    DI bool next(int i, Unit& u) const {
        const int L = i * G + c; if (L >= 512) return false;
        u.pm = L >> 2; u.pn = L & 3; u.aux = 0; u.pad = 0;
        u.a = A + (size_t)u.pm * 256 * 1024 * 2; u.b = B + (size_t)u.pn * 256 * 1024 * 2; return true;
    }
};
struct SchedM2 {
    const char* xr; const char* wgu; const LAS int* offt; const int* rowsrc; int G, c;
    DI bool next(int i, Unit& u) const {
        const int NT = __builtin_amdgcn_readfirstlane(offt[32]) >> 8; const int L = i * G + c; if (L >= NT * 2) return false;
        const int rt = L >> 1, pn = L & 1; const int e = __builtin_amdgcn_readfirstlane(offt[40 + rt]);
        u.pm = rt; u.pn = pn; u.aux = e; u.pad = 0;
        u.a = xr; u.b = wgu + ((size_t)e * 512 + pn * 256) * 1024 * 2; return true;
    }
    DI void rows(const Unit& u, int tid, unsigned (&g)[2][2]) const {
#pragma unroll
        for (int i = 0; i < 2; ++i) { int R, C; pg8::stage_rc(tid * 16 + i * 8192, R, C);
#pragma unroll
            for (int h = 0; h < 2; ++h) g[h][i] = (unsigned)rowsrc[u.pm * 256 + h * 128 + R] * 4096u + (unsigned)C * 2u; }
    }
};
struct SchedM3 {
    const char* hmid; const char* wd; const LAS int* offt; int G, c;
    DI bool next(int i, Unit& u) const {
        const int NT = __builtin_amdgcn_readfirstlane(offt[32]) >> 8; const int L = i * G + c; if (L >= NT * 4) return false;
        const int rt = L >> 2, pn = L & 3; const int e = __builtin_amdgcn_readfirstlane(offt[40 + rt]);
        u.pm = rt; u.pn = pn; u.aux = e; u.pad = 0;
        u.a = hmid + (size_t)rt * 256 * 256 * 2; u.b = wd + ((size_t)e * 1024 + pn * 256) * 256 * 2; return true;
    }
};

struct EpiP1I8 {
    static constexpr bool CARRY = false;
    bf16* proj; unsigned char* gates; const float* bgate; const float* hsc; const float* wsc;
    DI void operator()(const i32x4 (&acc)[2][2][4][2], const Unit& u, int wr, int wc, int fr, int fq) const {
        const int row0 = u.pm * 256 + wr * 64 + fr;
        if (u.pn < 10) { const int colt = u.pn * 256 + wc * 32 + 8 * fq;
            f32x4 sv[2][2]; float rsv[2][4];
#pragma unroll
            for (int bj = 0; bj < 2; ++bj)
#pragma unroll
                for (int n = 0; n < 2; ++n) sv[bj][n] = *(const GAS f32x4*)((const GAS float*)wsc + colt + bj * 128 + 4 * n);
#pragma unroll
            for (int ai = 0; ai < 2; ++ai)
#pragma unroll
                for (int m = 0; m < 4; ++m) rsv[ai][m] = ((const GAS float*)hsc)[row0 + ai * 128 + m * 16];
#pragma unroll
            for (int ai = 0; ai < 2; ++ai)
#pragma unroll
                for (int m = 0; m < 4; ++m) { bf16* rowp = proj + (size_t)(row0 + ai * 128 + m * 16) * PLD + colt; const float rs = rsv[ai][m];
#pragma unroll
                    for (int bj = 0; bj < 2; ++bj) { f32x4 v0, v1;
#pragma unroll
                        for (int e = 0; e < 4; ++e) { v0[e] = (float)acc[ai][bj][m][0][e] * (rs * sv[bj][0][e]); v1[e] = (float)acc[ai][bj][m][1][e] * (rs * sv[bj][1][e]); }
                        *(u32x4*)(rowp + bj * 128) = pack8(v0, v1); } }
            return; }
        const int gcol = (u.pn - 10) * 256 + wc * 32 + 8 * fq; const float* wsc = this->wsc + 2560;
        f32x4 bv[2][2], sv[2][2];
#pragma unroll
        for (int bj = 0; bj < 2; ++bj)
#pragma unroll
            for (int n = 0; n < 2; ++n) { bv[bj][n] = *(const f32x4*)(bgate + gcol + bj * 128 + 4 * n); sv[bj][n] = *(const f32x4*)(wsc + gcol + bj * 128 + 4 * n); }
        float rsv[2][4];
#pragma unroll
        for (int ai = 0; ai < 2; ++ai)
#pragma unroll
            for (int m = 0; m < 4; ++m) rsv[ai][m] = ((const GAS float*)hsc)[row0 + ai * 128 + m * 16];
#pragma unroll
        for (int ai = 0; ai < 2; ++ai)
#pragma unroll
            for (int m = 0; m < 4; ++m) { const float rs = rsv[ai][m];
                unsigned char* rowp = gates + ((size_t)(u.pm * 16 + (u.pn - 10)) * 65536 + (size_t)((ai * 4 + m) * 8192 + (wr * 4 + wc) * 512 + (fq * 16 + fr) * 8));
#pragma unroll
                for (int bj = 0; bj < 2; ++bj) { unsigned q[8];
#pragma unroll
                    for (int n = 0; n < 2; ++n)
#pragma unroll
                        for (int e = 0; e < 4; ++e) { const float pre = (float)acc[ai][bj][m][n][e] * (rs * sv[bj][n][e]) + bv[bj][n][e];
                            q[4 * n + e] = (unsigned)fminf(256.f * sigmoidf_(pre), 255.5f); }
                    u32x2 w; w.x = q[0] | (q[1] << 8) | (q[2] << 16) | (q[3] << 24); w.y = q[4] | (q[5] << 8) | (q[6] << 16) | (q[7] << 24);
                    *(u32x2*)(rowp + bj * 4096) = w; }
                __builtin_amdgcn_sched_barrier(0); }
    }
};
struct EpiP3a {
    static constexpr bool CARRY = true;
    bf16* merged; const unsigned char* gates;
    DI void carry(f32x4 (&acc)[2][2][4][2], const Unit& u, int wr, int wc, int fr, int fq) const {
        const GAS unsigned char* gb = (const GAS unsigned char*)gates + (size_t)(u.pm * 16 + (u.aux - 1) * 4 + u.pn) * 65536;
        const unsigned go = (unsigned)((wr * 4 + wc) * 512 + (fq * 16 + fr) * 8);
        u32x2 gp[2][4][2], gn[2][4][2];
#pragma unroll
        for (int ai = 0; ai < 2; ++ai)
#pragma unroll
            for (int m = 0; m < 4; ++m)
#pragma unroll
                for (int bj = 0; bj < 2; ++bj) { gp[ai][m][bj] = *(const GAS u32x2*)(gb + go + (unsigned)(((ai * 4 + m) * 2 + bj) * 4096));
                    gn[ai][m][bj] = *(const GAS u32x2*)(gb + go + (unsigned)(((ai * 4 + m) * 2 + bj) * 4096 + 4 * 65536)); }
#pragma unroll
        for (int ai = 0; ai < 2; ++ai) {
#pragma unroll
            for (int m = 0; m < 4; ++m)
#pragma unroll
                for (int bj = 0; bj < 2; ++bj) {
#pragma unroll
                    for (int n = 0; n < 2; ++n) { const unsigned p4 = n ? gp[ai][m][bj].y : gp[ai][m][bj].x, n4 = n ? gn[ai][m][bj].y : gn[ai][m][bj].x;
#pragma unroll
                        for (int e = 0; e < 4; ++e) acc[ai][bj][m][n][e] *= ((float)((p4 >> (8 * e)) & 255u) + 0.5f) * __builtin_amdgcn_rcpf((float)((n4 >> (8 * e)) & 255u) + 0.5f); } }
            __builtin_amdgcn_sched_barrier(0); }
    }
    DI void operator()(const f32x4 (&acc)[2][2][4][2], const Unit& u, int wr, int wc, int fr, int fq) const {
        if (u.aux != 3) return;
        const GAS unsigned char* gb = (const GAS unsigned char*)gates + (size_t)(u.pm * 16 + 3 * 4 + u.pn) * 65536;
        GAS unsigned char* mb = (GAS unsigned char*)merged + ((size_t)(u.pm * 256) * 1024 + u.pn * 256) * 2;
        const unsigned go = (unsigned)((wr * 4 + wc) * 512 + (fq * 16 + fr) * 8), mo = (unsigned)((wr * 64 + fr) * 1024 + wc * 32 + 8 * fq) * 2u;
        u32x2 gw[2][4][2];
#pragma unroll
        for (int ai = 0; ai < 2; ++ai)
#pragma unroll
            for (int m = 0; m < 4; ++m)
#pragma unroll
                for (int bj = 0; bj < 2; ++bj) gw[ai][m][bj] = *(const GAS u32x2*)(gb + go + (unsigned)(((ai * 4 + m) * 2 + bj) * 4096));
#pragma unroll
        for (int ai = 0; ai < 2; ++ai) {
#pragma unroll
            for (int m = 0; m < 4; ++m)
#pragma unroll
                for (int bj = 0; bj < 2; ++bj) {
                    f32x4 v0 = acc[ai][bj][m][0], v1 = acc[ai][bj][m][1]; const u32x2 g2 = gw[ai][m][bj]; const float k256 = 0.00390625f;
#pragma unroll
                    for (int e = 0; e < 4; ++e) { v0[e] *= ((float)((g2.x >> (8 * e)) & 255u) + 0.5f) * k256; v1[e] *= ((float)((g2.y >> (8 * e)) & 255u) + 0.5f) * k256; }
                    *(GAS u32x4*)(mb + mo + (unsigned)((ai * 128 + m * 16) * 1024 + bj * 128) * 2u) = pack8(v0, v1); }
            __builtin_amdgcn_sched_barrier(0); }
    }
};
struct EpiP3b {
    static constexpr bool CARRY = false;
    const float* xin; float* out;
    DI void operator()(const f32x4 (&acc)[2][2][4][2], const Unit& u, int wr, int wc, int fr, int fq) const {
        const GAS unsigned char* xb = (const GAS unsigned char*)xin + ((size_t)(u.pm * 256) * 1024 + u.pn * 256) * 4; GAS unsigned char* ob = (GAS unsigned char*)out + ((size_t)(u.pm * 256) * 1024 + u.pn * 256) * 4;
        const unsigned lo = (unsigned)((wr * 64 + fr) * 1024 + wc * 32 + 8 * fq) * 4u;
#pragma unroll
        for (int ai = 0; ai < 2; ++ai)
#pragma unroll
            for (int mh = 0; mh < 2; ++mh) {
                f32x4 xv[2][2][2];
#pragma unroll
                for (int m2 = 0; m2 < 2; ++m2)
#pragma unroll
                    for (int bj = 0; bj < 2; ++bj)
#pragma unroll
                        for (int n = 0; n < 2; ++n) xv[m2][bj][n] = *(const GAS f32x4*)(xb + lo + (unsigned)((ai * 128 + (mh * 2 + m2) * 16) * 1024 + bj * 128 + 4 * n) * 4u);
#pragma unroll
                for (int m2 = 0; m2 < 2; ++m2)
#pragma unroll
                    for (int bj = 0; bj < 2; ++bj)
#pragma unroll
                        for (int n = 0; n < 2; ++n) *(GAS f32x4*)(ob + lo + (unsigned)((ai * 128 + (mh * 2 + m2) * 16) * 1024 + bj * 128 + 4 * n) * 4u) = xv[m2][bj][n] + acc[ai][bj][mh * 2 + m2][n];
                __builtin_amdgcn_sched_barrier(0); }
    }
};
struct EpiM2 {
    static constexpr bool CARRY = false;
    bf16* hmid;
    DI void operator()(const f32x4 (&acc)[2][2][4][2], const Unit& u, int wr, int wc, int fr, int fq) const {
        const int row0 = u.pm * 256 + wr * 64 + fr; const int col = u.pn * 128 + wc * 32 + 8 * fq;
#pragma unroll
        for (int ai = 0; ai < 2; ++ai)
#pragma unroll
            for (int m = 0; m < 4; ++m) { f32x4 h0, h1;
#pragma unroll
                for (int e = 0; e < 4; ++e) { const float g0 = acc[ai][0][m][0][e], g1 = acc[ai][0][m][1][e];
                    h0[e] = g0 * sigmoidf_(g0) * acc[ai][1][m][0][e]; h1[e] = g1 * sigmoidf_(g1) * acc[ai][1][m][1][e]; }
                *(u32x4*)(hmid + (size_t)(row0 + ai * 128 + m * 16) * 256 + col) = pack8(h0, h1); }
    }
};
struct EpiM3 {
    static constexpr bool CARRY = false;
    bf16* eo; const int* rowtok; const float* roww;
    DI void operator()(const f32x4 (&acc)[2][2][4][2], const Unit& u, int wr, int wc, int fr, int fq) const {
        const int row0 = u.pm * 256 + wr * 64 + fr; const int colt = u.pn * 256 + wc * 32 + 8 * fq;
        int tk[2][4]; float wv[2][4];
#pragma unroll
        for (int ai = 0; ai < 2; ++ai)
#pragma unroll
            for (int m = 0; m < 4; ++m) { tk[ai][m] = ((const GAS int*)rowtok)[row0 + ai * 128 + m * 16]; wv[ai][m] = ((const GAS float*)roww)[row0 + ai * 128 + m * 16]; }
#pragma unroll
        for (int ai = 0; ai < 2; ++ai)
#pragma unroll
            for (int m = 0; m < 4; ++m) {
                if (tk[ai][m] >= 0) { const float w = wv[ai][m]; GAS bf16* op = (GAS bf16*)eo + (size_t)tk[ai][m] * 1024 + colt;
#pragma unroll
                    for (int bj = 0; bj < 2; ++bj) *(GAS u32x4*)(op + bj * 128) = pack8(acc[ai][bj][m][0] * w, acc[ai][bj][m][1] * w); }
                __builtin_amdgcn_sched_barrier(0); }
    }
};

struct Args { const float* in[36]; float* out; unsigned char* ws; int ph_lo, ph_hi; };
struct InTab { unsigned base;
    DI const float* operator[](int i) const { unsigned long long v; const unsigned addr = base + (unsigned)i * 8u;
        asm volatile("ds_read_b64 %0, %1\n\ts_waitcnt lgkmcnt(0)" : "=v"(v) : "v"(addr) : "memory");
        const unsigned lo = __builtin_amdgcn_readfirstlane((unsigned)v), hi = __builtin_amdgcn_readfirstlane((unsigned)(v >> 32));
        return (const float*)(((unsigned long long)hi << 32) | lo); } };
struct KA { InTab in; float* out; unsigned char* ws; };

DI void transpose_item(const float* W_, int ldw, int nvalid, bf16* WT_, int ldt, int k0, int n0, int dst_row0, LAS float* scr, int lane) {
    const GAS float* W = (const GAS float*)W_; GAS bf16* WT = (GAS bf16*)WT_;
    const int nq = 4 * (lane & 7), kr8 = lane >> 3;
    f32x4 v[8];
#pragma unroll
    for (int i = 0; i < 8; ++i) { const int kk = 8 * i + kr8;
        if (n0 + nq + 3 < nvalid) v[i] = *(const GAS f32x4*)(W + (size_t)(k0 + kk) * ldw + n0 + nq);
        else {
#pragma unroll
            for (int e = 0; e < 4; ++e) v[i][e] = (n0 + nq + e < nvalid) ? W[(size_t)(k0 + kk) * ldw + n0 + nq + e] : 0.f; } }
#pragma unroll
    for (int i = 0; i < 8; ++i) { const int kk = 8 * i + kr8;
#pragma unroll
        for (int e = 0; e < 4; ++e) scr[kk * 33 + nq + e] = v[i][e]; }
    LDS_WAIT(); asm volatile("" ::: "memory");
    const int c = lane & 7;
#pragma unroll
    for (int j = 0; j < 4; ++j) { const int n = (lane >> 3) + 8 * j; const LAS float* s = scr + (8 * c) * 33 + n;
        u32x4 o; o.x = pk2(s[0 * 33], s[1 * 33]); o.y = pk2(s[2 * 33], s[3 * 33]); o.z = pk2(s[4 * 33], s[5 * 33]); o.w = pk2(s[6 * 33], s[7 * 33]);
        if (n0 + n < nvalid) *(GAS u32x4*)(WT + (size_t)(dst_row0 + n) * ldt + k0 + 8 * c) = o; }
    LDS_WAIT(); asm volatile("" ::: "memory");
}
DI void phase0_weights(const KA& a, int l, LAS unsigned char* lds, int gw, int NGW, int wave, int lane) {
    LAS float* scr = (LAS float*)(lds + wave * 16384);
    const float* w_in = a.in[4] + (size_t)l * 1024 * NIN;
    const float* w_gate = a.in[24] + (size_t)l * 4 * 1024 * 1024;
    const float* w_br = a.in[26] + (size_t)l * 4 * 256 * 1024;
    const float* w_out = a.in[27] + (size_t)l * 1024 * 1024;
    bf16* Wt_in = (bf16*)(a.ws + WS_WIN); bf16* Wt_br = (bf16*)(a.ws + WS_WBR); bf16* Wt_out = (bf16*)(a.ws + WS_WOUT);
    constexpr int I_B = 4 * 4 * 32, I_O = 16 * 32, NIT = I_B + I_O;
    (void)w_gate; (void)w_in; (void)Wt_in;
    for (int it = gw; it < NIT; it += NGW) {
        int r = it;
        if (r < I_B) { const int br = r / 128, q = r % 128, kb = q / 32, nb = q % 32; transpose_item(w_br + (size_t)br * 256 * 1024, 1024, 1024, Wt_br + (size_t)br * 1024 * 256, 256, kb * 64, nb * 32, nb * 32, scr, lane); continue; } r -= I_B;
        { const int kb = r / 32, nb = r % 32; transpose_item(w_out, 1024, 1024, Wt_out, 1024, kb * 64, nb * 32, nb * 32, scr, lane); }
    }
}
DI void p1_weights_i8(const KA& a, int l, LAS unsigned char* lds, int gw, int NGW, int wave, int lane) {
    LAS float* scr = (LAS float*)(lds + wave * 16384);
    const GAS float* wgt = (const GAS float*)(a.in[24] + (size_t)l * 4 * 1024 * 1024); const GAS float* win = (const GAS float*)(a.in[4] + (size_t)l * 1024 * NIN);
    GAS unsigned char* Wq = (GAS unsigned char*)(a.ws + WS_WQ); GAS float* wsc = (GAS float*)(a.ws + WS_WSC);
    const int nq = 4 * (lane & 7), kr8 = lane >> 3;
    for (int it = NGW - 1 - gw; it < 128 + 77; it += NGW) {
        const bool isg = it < 128; const int br = it >> 5; const int n0 = isg ? (it & 31) * 32 : (it - 128) * 32;
        const int ldw = isg ? 1024 : NIN; const int nval = isg ? 1024 : NIN; const int drow0 = isg ? 2560 + br * 1024 + n0 : n0;
        const bool lok = (n0 + nq) < nval;
        const GAS float* W = (isg ? wgt + (size_t)br * 1024 * 1024 : win) + n0 + nq;
        f32x4 mx = {0.f, 0.f, 0.f, 0.f};
#pragma unroll 8
        for (int i = 0; i < 128; ++i) { f32x4 v = {0.f, 0.f, 0.f, 0.f}; if (lok) v = *(const GAS f32x4*)(W + (size_t)(8 * i + kr8) * ldw);
            mx[0] = fmaxf(mx[0], fabsf(v[0])); mx[1] = fmaxf(mx[1], fabsf(v[1])); mx[2] = fmaxf(mx[2], fabsf(v[2])); mx[3] = fmaxf(mx[3], fabsf(v[3])); }
#pragma unroll
        for (int e = 0; e < 4; ++e) { float m = mx[e]; m = fmaxf(m, xshfl<8>(m)); m = fmaxf(m, xshfl<16>(m)); m = fmaxf(m, xshfl<32>(m)); mx[e] = fmaxf(m, 1e-20f); }
        if (kr8 == 0 && lok) *(GAS f32x4*)(wsc + drow0 + nq) = mx * (1.f / 127.f);
        const f32x4 qs = {127.f / mx[0], 127.f / mx[1], 127.f / mx[2], 127.f / mx[3]};
#pragma unroll 1
        for (int kb = 0; kb < 16; ++kb) {
            f32x4 v[8];
#pragma unroll
            for (int i = 0; i < 8; ++i) { v[i] = (f32x4){0.f, 0.f, 0.f, 0.f}; if (lok) v[i] = *(const GAS f32x4*)(W + (size_t)(kb * 64 + 8 * i + kr8) * ldw); }
#pragma unroll
            for (int i = 0; i < 8; ++i) { const int kk = 8 * i + kr8;
#pragma unroll
                for (int e = 0; e < 4; ++e) scr[kk * 33 + nq + e] = __builtin_rintf(v[i][e] * qs[e]); }
            LDS_WAIT(); asm volatile("" ::: "memory");
            const int n = lane >> 1, kh = lane & 1; u32x4 o[2];
#pragma unroll
            for (int h2 = 0; h2 < 2; ++h2) { unsigned w4[4];
#pragma unroll
                for (int d = 0; d < 4; ++d) { unsigned wv = 0u;
#pragma unroll
                    for (int e = 0; e < 4; ++e) wv |= ((unsigned)(int)scr[(32 * kh + 16 * h2 + 4 * d + e) * 33 + n] & 255u) << (8 * e);
                    w4[d] = wv; }
                o[h2].x = w4[0]; o[h2].y = w4[1]; o[h2].z = w4[2]; o[h2].w = w4[3]; }
            if (n0 + n < nval) { GAS unsigned char* dst = Wq + (size_t)(drow0 + n) * 1024 + kb * 64 + 32 * kh; *(GAS u32x4*)dst = o[0]; *(GAS u32x4*)(dst + 16) = o[1]; }
            LDS_WAIT(); asm volatile("" ::: "memory");
        }
    }
}

DI void router_weights(const KA& a, int l, int gw, int NGW, int lane) {
    bf16* Wr = (bf16*)(a.ws + WS_WR);
    const float* wg = a.in[29] + (size_t)l * 1024 * 4; const float* we = a.in[31] + (size_t)l * 1024 * 32;
    for (int n = gw; n < 36; n += NGW) {
        for (int i = 0; i < 16; ++i) { const int k = lane + 64 * i; const float w = (n < 4) ? wg[k * 4 + n] : we[k * 32 + (n - 4)];
            const unsigned hi = f2bf(w); const float hf = __builtin_bit_cast(float, hi << 16); const unsigned lo = f2bf(w - hf);
            Wr[(size_t)n * 2048 + k] = (bf16)hi; Wr[(size_t)n * 2048 + 1024 + k] = (bf16)hi; Wr[(size_t)(64 + n) * 2048 + k] = (bf16)lo; Wr[(size_t)(64 + n) * 2048 + 1024 + k] = 0; }
    }
}

DI void cmp_weights(const KA& a, int l, LAS unsigned char* lds, int gw, int NGW, int wave, int lane) {
    LAS float* scr = (LAS float*)(lds + wave * 16384);
    bf16* Wc = (bf16*)(a.ws + WS_WCMP); float* pt = (float*)(a.ws + WS_CMPAB + 2 * MiB);
    for (int it = gw; it < 128 + 64; it += NGW) {
        if (it < 128) { const int kv = it >> 6, q = it & 63, kb = q >> 1, nb = q & 1; const float* w1 = a.in[kv ? 22 : 19] + (size_t)l * 2048 * 64;
            bf16* dst = Wc + (size_t)kv * 256 * 1024 - (kb >= 16 ? 1024 : 0);
            transpose_item(w1, 64, 64, dst, 1024, kb * 64, nb * 32, (kb >= 16 ? 64 : 0) + nb * 32, scr, lane);
        } else { const int kv = (it - 128) >> 5, part = (it - 128) & 31;
            const GAS float* w1 = (const GAS float*)(a.in[kv ? 22 : 19] + (size_t)l * 2048 * 64) + (size_t)part * 64 * 64; const GAS float* pos = (const GAS float*)(a.in[kv ? 21 : 18] + (size_t)l * 2048) + part * 64;
            float acc = 0.f;
#pragma unroll 16
            for (int k = 0; k < 64; ++k) acc += pos[k] * w1[(size_t)k * 64 + lane];
            pt[(kv * 32 + part) * 64 + lane] = acc; }
    }
}

DI void lru_weights(const KA& a, int l, int gw, int NGW, int lane) {
    bf16* W = (bf16*)(a.ws + WS_LRUW); const float* wa = a.in[7] + (size_t)l * 4 * 4096; const float* wx = a.in[9] + (size_t)l * 4 * 4096;
    (void)NGW; { const int idx = gw * 64 + lane; if (idx < 32768) { const int i = idx & 63, j = (idx >> 6) & 63, mat = (idx >> 12) & 1, hbk = idx >> 13;
        W[idx] = (bf16)f2bf((mat ? wx : wa)[(size_t)hbk * 4096 + i * 64 + j]); } }
}
DI void phase0_rows(const KA& a, int l, int mode, int gw, int NGW, int lane) {
    const GAS float* xin = (const GAS float*)((l == 0) ? a.in[0] : a.out);
    const GAS bf16* eo = (const GAS bf16*)(a.ws + WS_PROJ);
    GAS bf16* hb = (GAS bf16*)(a.ws + WS_HB); GAS float* outp = (GAS float*)a.out;
    const GAS float* g = (const GAS float*)(mode ? a.in[2] : (a.in[3] + (size_t)l * 1024));
    f32x4 gv[4];
#pragma unroll
    for (int j = 0; j < 4; ++j) gv[j] = *(const GAS f32x4*)(g + 4 * (lane + 64 * j));
    for (int m0 = gw * 4; m0 < T; m0 += NGW * 4) {
        f32x4 v[4][4]; float ss[4];
#pragma unroll
        for (int rr = 0; rr < 4; ++rr)
#pragma unroll
            for (int j = 0; j < 4; ++j) v[rr][j] = *(const GAS f32x4*)(xin + (size_t)(m0 + rr) * 1024 + 4 * (lane + 64 * j));
        if (l > 0) {
#pragma unroll
            for (int rr = 0; rr < 4; ++rr)
#pragma unroll
                for (int j = 0; j < 4; ++j) {
                    const u32x2 e0 = *(const GAS u32x2*)(eo + (size_t)(2 * (m0 + rr)) * 1024 + 4 * (lane + 64 * j));
                    const u32x2 e1 = *(const GAS u32x2*)(eo + (size_t)(2 * (m0 + rr) + 1) * 1024 + 4 * (lane + 64 * j));
                    v[rr][j][0] += lo_bf(e0.x) + lo_bf(e1.x); v[rr][j][1] += hi_bf(e0.x) + hi_bf(e1.x); v[rr][j][2] += lo_bf(e0.y) + lo_bf(e1.y); v[rr][j][3] += hi_bf(e0.y) + hi_bf(e1.y); } }
#pragma unroll
        for (int rr = 0; rr < 4; ++rr) { float t = 0.f;
#pragma unroll
            for (int j = 0; j < 4; ++j) t += (v[rr][j][0] * v[rr][j][0] + v[rr][j][1] * v[rr][j][1]) + (v[rr][j][2] * v[rr][j][2] + v[rr][j][3] * v[rr][j][3]);
            ss[rr] = t; }
#pragma unroll
        for (int rr = 0; rr < 4; ++rr) ss[rr] = wave_sum(ss[rr]);
        if (mode) {
#pragma unroll
            for (int rr = 0; rr < 4; ++rr) { const float r = 1.f / sqrtf(ss[rr] * (1.f / 1024.f) + 1e-6f); const size_t m = (size_t)(m0 + rr);
#pragma unroll
                for (int j = 0; j < 4; ++j) *(GAS f32x4*)(outp + m * 1024 + 4 * (lane + 64 * j)) = v[rr][j] * r * gv[j]; }
        } else {
            GAS unsigned char* hq = (GAS unsigned char*)(a.ws + WS_HQ); GAS float* hsc = (GAS float*)(a.ws + WS_HSC);
            float am[4];
#pragma unroll
            for (int rr = 0; rr < 4; ++rr) { const float r = 1.f / sqrtf(ss[rr] * (1.f / 1024.f) + 1e-6f); const size_t m = (size_t)(m0 + rr); float t = 0.f;
#pragma unroll
                for (int j = 0; j < 4; ++j) { if (l > 0) *(GAS f32x4*)(outp + m * 1024 + 4 * (lane + 64 * j)) = v[rr][j];
                    const f32x4 y = v[rr][j] * r * gv[j]; v[rr][j] = y;
                    t = fmaxf(t, fmaxf(fmaxf(fabsf(y[0]), fabsf(y[1])), fmaxf(fabsf(y[2]), fabsf(y[3])))); }
                am[rr] = t; }
#pragma unroll
            for (int rr = 0; rr < 4; ++rr) am[rr] = fmaxf(wave_max(am[rr]), 1e-20f);
#pragma unroll
            for (int rr = 0; rr < 4; ++rr) { const size_t m = (size_t)(m0 + rr); const float qs = 127.f / am[rr];
                if (lane == 0) hsc[m] = am[rr] * (1.f / 127.f);
#pragma unroll
                for (int j = 0; j < 4; ++j) { const f32x4 y = v[rr][j] * qs;
                    const unsigned q = ((unsigned)(int)__builtin_rintf(y[0]) & 255u) | (((unsigned)(int)__builtin_rintf(y[1]) & 255u) << 8) | (((unsigned)(int)__builtin_rintf(y[2]) & 255u) << 16) | (((unsigned)(int)__builtin_rintf(y[3]) & 255u) << 24);
                    *(GAS unsigned*)(hq + m * 1024 + 4 * (lane + 64 * j)) = q; } }
        }
    }
}

DI int crow(int i, int hh) { return (i & 3) + 8 * (i >> 2) + 4 * hh; }
DI unsigned cvtpk(float lo, float hi) { f32x2 v = {lo, hi}; bf16x2_t b = __builtin_convertvector(v, bf16x2_t); return __builtin_bit_cast(unsigned, b); }
template <int CTRL, int RMASK> DI float dppf(float oldv, float v) { return __builtin_bit_cast(float, __builtin_amdgcn_update_dpp(__builtin_bit_cast(int, oldv), __builtin_bit_cast(int, v), CTRL, RMASK, 0xf, false)); }
template <int CTRL, int RMASK> DI void scan_step(float& a, float& b) {
    const float ap = dppf<CTRL, RMASK>(1.f, a), bp = dppf<CTRL, RMASK>(0.f, b); b = a * bp + b; a = a * ap; }
DI void lru_unit(const KA& a, int l, const GAS bf16* proj, GAS bf16* ys, GAS float* sums, LAS unsigned char* lds, int task, int lane_in, int wave_in, bool final) {
    int lane = lane_in, wave = wave_in; asm volatile("" : "+v"(lane), "+s"(wave));
    const int chunk = task & 31, hbk = (task >> 5) & 3, b = task >> 7;
    const int ts = chunk * 256 + wave * 32; const size_t rowb = (size_t)b * SEQ;
    LAS unsigned char* wl = lds + wave * 16384;
    LAS float* ex = (LAS float*)(lds + LRUEX_OFF); LAS float* cst = (LAS float*)(lds + LRUCST_OFF); LAS float* car = (LAS float*)(lds + LRUCAR_OFF) + wave * 64;
    {
        const int c = hbk * 64 + lane;
        const GAS float* cw = (const GAS float*)(a.in[5] + (size_t)l * 4 * 256);
        const float cw0 = cw[c], cw1 = cw[256 + c], cw2 = cw[512 + c], cw3 = cw[768 + c]; const float cb = a.in[6][l * 256 + c];
        if (wave == 0) { cst[lane] = a.in[8][l * 256 + c]; cst[64 + lane] = a.in[10][l * 256 + c]; cst[128 + lane] = -8.f * softplusf_(-a.in[11][l * 256 + c]); }
        const GAS bf16* xp = proj + (rowb + ts) * PLD + C_AX + c;
        float x3 = (ts >= 3) ? bf2f(*(xp - 3 * PLD)) : 0.f, x2 = (ts >= 2) ? bf2f(*(xp - 2 * PLD)) : 0.f, x1 = (ts >= 1) ? bf2f(*(xp - PLD)) : 0.f;
#pragma unroll 8
        for (int n = 0; n < 32; ++n) { const float x0 = bf2f(xp[(size_t)n * PLD]); const float xc = cb + cw0 * x3 + cw1 * x2 + cw2 * x1 + cw3 * x0;
            *(LAS bf16*)(wl + n * 144 + lane * 2) = (bf16)f2bf(xc); *(LAS float*)(wl + 4608 + n * 272 + lane * 4) = xc; x3 = x2; x2 = x1; x1 = x0; }
    }
    const int n = lane & 31, hh = lane >> 5;
    f32x16 D[4];
    {
        const GAS bf16* wt = (const GAS bf16*)(a.ws + WS_LRUW) + (size_t)hbk * 8192;
        bf16x8 bfr[4];
        LDS_WAIT();
#pragma unroll
        for (int s4 = 0; s4 < 4; ++s4) bfr[s4] = *(const LAS bf16x8*)(wl + n * 144 + hh * 16 + s4 * 32);
#pragma unroll
        for (int m = 0; m < 4; ++m) {
#pragma unroll
            for (int s4 = 0; s4 < 4; ++s4) { const bf16x8 af = *(const GAS bf16x8*)(wt + (size_t)(m >> 1) * 4096 + (32 * (m & 1) + n) * 64 + 8 * hh + 16 * s4);
                if (s4 == 0) { f32x16 z;
#pragma unroll
                    for (int i = 0; i < 16; ++i) z[i] = 0.f;
                    D[m] = MFMA32(af, bfr[s4], z); } else D[m] = MFMA32(af, bfr[s4], D[m]); } }
    }
    __syncthreads();
    const bool t0 = (ts + n) == 0;
#pragma unroll
    for (int mm = 0; mm < 2; ++mm)
#pragma unroll
        for (int g4 = 0; g4 < 4; ++g4) { const int c0 = 32 * mm + 8 * g4 + 4 * hh;
            const f32x4 vba = *(const LAS f32x4*)(cst + c0), vbx = *(const LAS f32x4*)(cst + 64 + c0), vc8 = *(const LAS f32x4*)(cst + 128 + c0);
            const f32x4 vxc = *(const LAS f32x4*)(wl + 4608 + n * 272 + c0 * 4);
#pragma unroll
            for (int e = 0; e < 4; ++e) { const int i = 4 * g4 + e;
                const float r = sigmoidf_(D[mm][i] + vba[e]), ig = sigmoidf_(D[2 + mm][i] + vbx[e]);
                const float la = vc8[e] * r; const float av = __expf(la);
                const float mult = t0 ? 1.f : sqrtf(fmaxf(1.f - __expf(2.f * la), 0.f));
                float aa = av, bb = mult * ig * vxc[e];
                scan_step<0x111, 0xf>(aa, bb); scan_step<0x112, 0xf>(aa, bb); scan_step<0x114, 0xf>(aa, bb); scan_step<0x118, 0xf>(aa, bb); scan_step<0x142, 0xa>(aa, bb);
                D[mm][i] = aa; D[2 + mm][i] = bb; } }
    if (n == 31) {
#pragma unroll
        for (int mm = 0; mm < 2; ++mm)
#pragma unroll
            for (int i = 0; i < 16; ++i) { const int c = 32 * mm + crow(i, hh); ex[(wave * 64 + c) * 2] = D[mm][i]; ex[(wave * 64 + c) * 2 + 1] = D[2 + mm][i]; } }
    __syncthreads();
    if (!final) {
        if (wave == 0) { float hv = 0.f, av = 1.f;
#pragma unroll
            for (int w = 0; w < 8; ++w) { const float A_ = ex[(w * 64 + lane) * 2], H_ = ex[(w * 64 + lane) * 2 + 1]; hv = A_ * hv + H_; av *= A_; }
            GAS float* sp = sums + ((size_t)((b * 4 + hbk) * 32 + chunk) * 64 + lane) * 2; sp[0] = av; sp[1] = hv; }
    } else {
        {   float hv = 0.f;
            {   const GAS f32x2* sp = (const GAS f32x2*)(sums + ((size_t)((b * 4 + hbk) * 32) * 64 + lane) * 2);
                int cc = 0;
                for (; cc + 8 <= chunk; cc += 8) { f32x2 v[8];
#pragma unroll
                    for (int e = 0; e < 8; ++e) v[e] = sp[(size_t)(cc + e) * 64];
#pragma unroll
                    for (int e = 0; e < 8; ++e) hv = v[e][0] * hv + v[e][1]; }
                for (; cc < chunk; ++cc) { const f32x2 v = sp[(size_t)cc * 64]; hv = v[0] * hv + v[1]; } }
            for (int w = 0; w < wave; ++w) { const float A_ = ex[(w * 64 + lane) * 2], H_ = ex[(w * 64 + lane) * 2 + 1]; hv = A_ * hv + H_; }
            car[lane] = hv; }
        LDS_WAIT(); asm volatile("" ::: "memory");
        const GAS bf16* gp = proj + (rowb + ts + n) * PLD + C_AG + hbk * 64; GAS bf16* yp = ys + (rowb + ts + n) * 1024 + hbk * 64;
#pragma unroll
        for (int mm = 0; mm < 2; ++mm)
#pragma unroll
            for (int g4 = 0; g4 < 4; ++g4) { const int c0 = 32 * mm + 8 * g4 + 4 * hh; const f32x4 cv = *(const LAS f32x4*)(car + c0);
                const u32x2 gt2 = *(const GAS u32x2*)(gp + c0); float y[4];
#pragma unroll
                for (int e = 0; e < 4; ++e) { const int i = 4 * g4 + e; const float hv = D[2 + mm][i] + D[mm][i] * cv[e];
                    const float gt = (e == 0) ? lo_bf(gt2.x) : (e == 1) ? hi_bf(gt2.x) : (e == 2) ? lo_bf(gt2.y) : hi_bf(gt2.y); y[e] = hv * gelu_tanh(gt); }
                u32x2 yo; yo.x = cvtpk(y[0], y[1]); yo.y = cvtpk(y[2], y[3]); *(GAS u32x2*)(yp + c0) = yo; }
    }
    __syncthreads();
}

constexpr int DK_STR = 144, DV_STR = 192, DBUF_BYTES = 64 * DK_STR + 64 * DV_STR;
DI bf16x8 pack_half(const f32x16& x, int s2) { u32x4 p;
    if (s2 == 0) { p.x = cvtpk(x[0], x[1]); p.y = cvtpk(x[2], x[3]); p.z = cvtpk(x[4], x[5]); p.w = cvtpk(x[6], x[7]); }
    else { p.x = cvtpk(x[8], x[9]); p.y = cvtpk(x[10], x[11]); p.z = cvtpk(x[12], x[13]); p.w = cvtpk(x[14], x[15]); }
    return __builtin_bit_cast(bf16x8, p); }
DI s16x4 vtr(const LAS unsigned char* p) { return __builtin_bit_cast(s16x4, __builtin_amdgcn_ds_read_tr16_b64_v4i16((LAS v4i16_t*)p)); }
DI float max16(const f32x16& x) { float a = fmaxf(fmaxf(x[0], x[1]), fmaxf(x[2], x[3])), b = fmaxf(fmaxf(x[4], x[5]), fmaxf(x[6], x[7])), c = fmaxf(fmaxf(x[8], x[9]), fmaxf(x[10], x[11])), d = fmaxf(fmaxf(x[12], x[13]), fmaxf(x[14], x[15])); return fmaxf(fmaxf(a, b), fmaxf(c, d)); }
DI void diff_unit(const GAS bf16* proj, GAS bf16* ys, LAS unsigned char* lds, const LAS float* bias2, const GAS float* subg, const LAS float* lamp, int b, int h, int qb, int wave_in) {
    int wave = wave_in; asm volatile("" : "+s"(wave)); const int lane = my_lane(); const int tid = wave * 64 + lane;
    const int q0 = qb * 256 + wave * 32; const int ql = lane & 31, hh = lane >> 5; const int q = q0 + ql;
    const size_t rowb = (size_t)b * SEQ;
    const float SC = 0.17677669529663687f * 1.4426950408889634f;
    bf16x8 qf[2][2];
    { const GAS bf16* qp = proj + (rowb + q) * PLD + C_CQ + h * 64 + hh * 8;
#pragma unroll
      for (int m = 0; m < 2; ++m)
#pragma unroll
        for (int s = 0; s < 2; ++s) { const u32x4 w = *(const GAS u32x4*)(qp + m * 32 + s * 16); u32x4 o;
            o.x = cvtpk(lo_bf(w.x) * SC, hi_bf(w.x) * SC); o.y = cvtpk(lo_bf(w.y) * SC, hi_bf(w.y) * SC); o.z = cvtpk(lo_bf(w.z) * SC, hi_bf(w.z) * SC); o.w = cvtpk(lo_bf(w.w) * SC, hi_bf(w.w) * SC);
            qf[m][s] = __builtin_bit_cast(bf16x8, o); } }
    f32x16 O[2][2], negm[2];
#pragma unroll
    for (int i = 0; i < 16; ++i) { O[0][0][i] = 0.f; O[0][1][i] = 0.f; O[1][0][i] = 0.f; O[1][1][i] = 0.f; negm[0][i] = 120.f; negm[1][i] = 120.f; }
    float lsum[2] = {0.f, 0.f};
    const int nsteps = 4 * qb + 4, mysteps = 4 * qb + (wave >> 1) + 1;
    const int skey = tid >> 3, sch = tid & 7;
    const GAS unsigned char* kgb = (const GAS unsigned char*)(proj + rowb * PLD + C_CK + h * 64);
    const GAS unsigned char* vgb = (const GAS unsigned char*)(proj + rowb * PLD + C_CV + h * 64);
    const unsigned soff = (unsigned)(skey * PLD + sch * 8) * 2u;
    u32x4 kr = *(const GAS u32x4*)(kgb + soff), vr = *(const GAS u32x4*)(vgb + soff);
    *(LAS u32x4*)(lds + skey * DK_STR + sch * 16) = kr; *(LAS u32x4*)(lds + 64 * DK_STR + skey * DV_STR + sch * 16) = vr;
    __syncthreads();
    const int i16 = lane & 15, blk = (lane >> 4) & 1;
    const int kboff = ql * DK_STR + hh * 16;
    const int vboff = 64 * DK_STR + (4 * hh + (i16 >> 2)) * DV_STR + (16 * blk + 4 * (i16 & 3)) * 2;
#pragma unroll 1
    for (int kt = 0; kt < nsteps; ++kt) {
        const LAS unsigned char* cur = lds + (kt & 1) * DBUF_BYTES; LAS unsigned char* nxt = lds + ((kt + 1) & 1) * DBUF_BYTES;
        if (kt + 1 < nsteps) { const unsigned so = soff + (unsigned)(kt + 1) * (64u * PLD * 2u); kr = *(const GAS u32x4*)(kgb + so); vr = *(const GAS u32x4*)(vgb + so); }
        if (kt < mysteps) {
            const int kbase = kt * 64;
            const bool near = (q0 - (kbase + 63) < 113);
#pragma unroll
            for (int m = 0; m < 2; ++m) {
                bf16x8 pk[2][2];
                f32x16 S[2]; float ts = 0.f;
                {   bf16x8 kf[2][2];
#pragma unroll
                    for (int t = 0; t < 2; ++t)
#pragma unroll
                        for (int s = 0; s < 2; ++s) kf[t][s] = *(const LAS bf16x8*)(cur + kboff + t * 32 * DK_STR + m * 64 + s * 32);
#pragma unroll
                    for (int t = 0; t < 2; ++t) { S[t] = MFMA32(kf[t][0], qf[m][0], negm[m]); S[t] = MFMA32(kf[t][1], qf[m][1], S[t]); } }
                if (near) {
#pragma unroll
                    for (int t = 0; t < 2; ++t)
#pragma unroll
                        for (int i = 0; i < 16; ++i) { const int dist = q - (kbase + 32 * t + crow(i, hh)); const int di = dist < 128 ? dist : 128;
                            const float bv = dist >= 0 ? bias2[di * 12 + 4 + h] : -1e30f; S[t][i] += bv; } }
#pragma unroll
                for (int t = 0; t < 2; ++t)
#pragma unroll
                    for (int i = 0; i < 16; ++i) { const float p = __builtin_amdgcn_exp2f(S[t][i]); S[t][i] = p; ts += p; }
                if (__builtin_amdgcn_ballot_w64(!(ts < 1.0e30f)) != 0ull) {
                {   bf16x8 kf[2][2];
#pragma unroll
                        for (int t = 0; t < 2; ++t)
#pragma unroll
                            for (int s = 0; s < 2; ++s) kf[t][s] = *(const LAS bf16x8*)(cur + kboff + t * 32 * DK_STR + m * 64 + s * 32);
#pragma unroll
                        for (int t = 0; t < 2; ++t) { S[t] = MFMA32(kf[t][0], qf[m][0], negm[m]); S[t] = MFMA32(kf[t][1], qf[m][1], S[t]); } }
                    if (near) {
#pragma unroll
                        for (int t = 0; t < 2; ++t)
#pragma unroll
                            for (int i = 0; i < 16; ++i) { const int dist = q - (kbase + 32 * t + crow(i, hh)); const int di = dist < 128 ? dist : 128;
                                const float bv = dist >= 0 ? bias2[di * 12 + 4 + h] : -1e30f; S[t][i] += bv; } }
                    float tm = fmaxf(max16(S[0]), max16(S[1])); tm = fmaxf(tm, xshfl<32>(tm));
                    const float sh = fmaxf(tm, 0.f); const float al = __builtin_amdgcn_exp2f(-sh);
                    lsum[m] *= al; ts = 0.f;
#pragma unroll
                    for (int i = 0; i < 16; ++i) { O[m][0][i] *= al; O[m][1][i] *= al; negm[m][i] -= sh; }
#pragma unroll
                    for (int t = 0; t < 2; ++t)
#pragma unroll
                        for (int i = 0; i < 16; ++i) { const float p = __builtin_amdgcn_exp2f(S[t][i] - sh); S[t][i] = p; ts += p; }
                }
                lsum[m] += ts;
#pragma unroll
                for (int t = 0; t < 2; ++t) { pk[t][0] = pack_half(S[t], 0); pk[t][1] = pack_half(S[t], 1); }
#pragma unroll
                for (int t = 0; t < 2; ++t)
#pragma unroll
                    for (int s2 = 0; s2 < 2; ++s2)
#pragma unroll
                        for (int db = 0; db < 2; ++db) {
                            const s16x4 lo = vtr(cur + vboff + (32 * t + 16 * s2) * DV_STR + db * 64), hi = vtr(cur + vboff + (32 * t + 16 * s2 + 8) * DV_STR + db * 64);
                            const bf16x8 vf = __builtin_shufflevector(lo, hi, 0, 1, 2, 3, 4, 5, 6, 7);
                            O[m][db] = MFMA32(vf, pk[t][s2], O[m][db]); }
                ;
            }
        }
        if (kt + 1 < nsteps) { *(LAS u32x4*)(nxt + skey * DK_STR + sch * 16) = kr; *(LAS u32x4*)(nxt + 64 * DK_STR + skey * DV_STR + sch * 16) = vr; }
        __syncthreads();
    }
    const float l0 = lsum[0] + xshfl<32>(lsum[0]), l1 = lsum[1] + xshfl<32>(lsum[1]);
    const float lam = lamp[0], lam_init = lamp[1];
    const float i0 = 1.f / fmaxf(l0, 1e-30f), i1 = lam / fmaxf(l1, 1e-30f);
    float ss = 0.f;
#pragma unroll
    for (int db = 0; db < 2; ++db)
#pragma unroll
        for (int i = 0; i < 16; ++i) { const float at = O[0][db][i] * i0 - O[1][db][i] * i1; O[0][db][i] = at; ss += at * at; }
    ss += xshfl<32>(ss);
    const float r = (1.f - lam_init) / sqrtf(ss * (1.f / 64.f) + 1e-5f);
    GAS bf16* op = ys + (rowb + q) * 1024 + 512 + h * 64;
#pragma unroll
    for (int db = 0; db < 2; ++db)
#pragma unroll
        for (int gq = 0; gq < 4; ++gq) { const int d0 = 32 * db + 8 * gq + 4 * hh; const f32x4 sg = *(const GAS f32x4*)(subg + d0);
            u32x2 w; w.x = cvtpk(O[0][db][4 * gq + 0] * r * sg[0], O[0][db][4 * gq + 1] * r * sg[1]); w.y = cvtpk(O[0][db][4 * gq + 2] * r * sg[2], O[0][db][4 * gq + 3] * r * sg[3]);
            *(GAS u32x2*)(op + d0) = w; }
}

struct SchedCmp { const char* proj; const char* wc; int G, c;
    DI bool next(int i, Unit& u) const { const int L = i * G + c; if (L >= 16) return false; const int kv = L >> 3, rt = L & 7;
        u.pm = rt; u.pn = 0; u.aux = kv; u.pad = 0; u.a = proj + ((size_t)rt * 256 * 16 * PLD + (kv ? C_VC : C_KC)) * 2; u.b = wc + (size_t)kv * 256 * 1024 * 2; return true; } };
struct EpiCmp { static constexpr bool CARRY = false; float* ab;
    DI void operator()(const f32x4 (&acc)[2][2][4][2], const Unit& u, int wr, int wc, int fr, int fq) const {
        const int row0 = u.pm * 256 + wr * 64 + fr; const int col = wc * 32 + 8 * fq;
#pragma unroll
        for (int ai = 0; ai < 2; ++ai)
#pragma unroll
            for (int m = 0; m < 4; ++m) { float* rp = ab + ((size_t)u.aux * 2048 + row0 + ai * 128 + m * 16) * 128 + col; *(f32x4*)rp = acc[ai][0][m][0]; *(f32x4*)(rp + 4) = acc[ai][0][m][1]; }
    }
};
DI void cmp_rows16(const GAS bf16* proj, const GAS bf16* wcT, GAS float* ab, int bid, int wave, int lane) {
    const int kv = bid >> 7, g0 = (bid & 127) * 16, r = lane & 15, q = lane >> 4;
    const GAS bf16* apn = proj + (size_t)(g0 + r) * 16 * PLD + (kv ? C_VC : C_KC) + 8 * q;
    const GAS bf16* bpn = wcT + ((size_t)kv * 256 + wave * 16 + r) * 1024 + 8 * q;
    f32x4 acc = {0.f, 0.f, 0.f, 0.f};
#pragma unroll 8
    for (int s = 0; s < 32; ++s) {
        const bf16x8 av = *(const GAS bf16x8*)(apn + (size_t)(s >> 1) * PLD + 32 * (s & 1));
        const bf16x8 bv = *(const GAS bf16x8*)(bpn + 32 * s);
        acc = __builtin_amdgcn_mfma_f32_16x16x32_bf16(bv, av, acc, 0, 0, 0);
    }
    *(GAS f32x4*)(ab + ((size_t)kv * 2048 + g0 + r) * 128 + wave * 16 + 4 * q) = acc;
}
DI void cmp_finish(const KA& a, int l, const float* ab, bf16* kcb, int task, int lane) {
    const int kv = task / (BATCH * NCMP), r = task % (BATCH * NCMP), b = r / NCMP, c = r % NCMP;
    const float* w2 = a.in[kv ? 23 : 20] + (size_t)l * 4096; const float* pt = ab + 2 * 2048 * 128;
    const size_t g = (size_t)kv * 2048 + b * 512 + c;
    float ptv = 0.f;
#pragma unroll 8
    for (int part = 0; part < 32; ++part) ptv += pt[(kv * 32 + part) * 64 + lane];
    const float h1 = ab[g * 128 + lane] + ab[(g + 1) * 128 + 64 + lane] + ptv;
    const float gl = gelu_tanh(h1); float o = 0.f;
#pragma unroll
    for (int j = 0; j < 64; ++j) o += rl(gl, j) * w2[j * 64 + lane];
    kcb[((size_t)(kv * BATCH + b) * 512 + c) * 64 + lane] = (bf16)f2bf(o);
    if (c == NCMP - 1) kcb[((size_t)(kv * BATCH + b) * 512 + NCMP) * 64 + lane] = 0;
}

DI void st_load(const GAS unsigned char* kb, const GAS unsigned char* vb, unsigned off, u32x4& kr, u32x4& vr) { kr = *(const GAS u32x4*)(kb + off); vr = *(const GAS u32x4*)(vb + off); }
DI void st_write(LAS unsigned char* buf, int skey, int sch, const u32x4& kr, const u32x4& vr) { *(LAS u32x4*)(buf + skey * DK_STR + sch * 16) = kr; *(LAS u32x4*)(buf + 64 * DK_STR + skey * DV_STR + sch * 16) = vr; }
DI void qk64(const LAS unsigned char* cur, int kboff, const bf16x8 (&qf)[4], const f32x16& cinit, f32x16 (&S)[2]) {
#pragma unroll
    for (int t = 0; t < 2; ++t) { S[t] = cinit;
#pragma unroll
        for (int s = 0; s < 4; ++s) { const bf16x8 kf = *(const LAS bf16x8*)(cur + kboff + t * 32 * DK_STR + s * 32); S[t] = MFMA32(kf, qf[s], S[t]); } }
}
DI void qk32z(const LAS unsigned char* kt32, const bf16x8 (&qf)[4], f32x16& S) {
#pragma unroll
    for (int s = 0; s < 4; ++s) { const bf16x8 kf = *(const LAS bf16x8*)(kt32 + s * 32);
        if (s == 0) { f32x16 z;
#pragma unroll
            for (int i = 0; i < 16; ++i) z[i] = 0.f;
            S = MFMA32(kf, qf[s], z); } else S = MFMA32(kf, qf[s], S); }
}
DI void pv32(const LAS unsigned char* vt32, const bf16x8 (&pk)[2], f32x16 (&O)[2]) {
#pragma unroll
    for (int s2 = 0; s2 < 2; ++s2)
#pragma unroll
        for (int db = 0; db < 2; ++db) {
            const s16x4 lo = vtr(vt32 + (16 * s2) * DV_STR + db * 64), hi = vtr(vt32 + (16 * s2 + 8) * DV_STR + db * 64);
            const bf16x8 vf = __builtin_shufflevector(lo, hi, 0, 1, 2, 3, 4, 5, 6, 7);
            O[db] = MFMA32(vf, pk[s2], O[db]); }
}
DI void mask_bias_cmp32(f32x16& S, int tcol, int cbase, int hh, const LAS float* b2h, float msub) {
#pragma unroll
    for (int i = 0; i < 16; ++i) { const int c = cbase + crow(i, hh); const int dist = tcol - 31 - 16 * c; const bool ok = dist >= 0 && c < NCMP;
        const int di = dist < 0 ? 0 : (dist < 128 ? dist : 128); S[i] = ok ? S[i] + (b2h[di * 12] - msub) : -1e30f; }
}
DI void pv64(const LAS unsigned char* cur, int vboff, const bf16x8 (&pk)[2][2], f32x16 (&O)[2]) {
#pragma unroll
    for (int t = 0; t < 2; ++t)
#pragma unroll
        for (int s2 = 0; s2 < 2; ++s2)
#pragma unroll
            for (int db = 0; db < 2; ++db) {
                const s16x4 lo = vtr(cur + vboff + (32 * t + 16 * s2) * DV_STR + db * 64), hi = vtr(cur + vboff + (32 * t + 16 * s2 + 8) * DV_STR + db * 64);
                const bf16x8 vf = __builtin_shufflevector(lo, hi, 0, 1, 2, 3, 4, 5, 6, 7);
                O[db] = MFMA32(vf, pk[t][s2], O[db]); }
}
DI void softmax_step(f32x16 (&S)[2], f32x16 (&O)[2], f32x16& negm, float& lsum, bf16x8 (&pk)[2][2]) {
    float tm = fmaxf(max16(S[0]), max16(S[1]));
    if (__builtin_amdgcn_ballot_w64(tm > 8.f) != 0ull) {
        tm = fmaxf(tm, xshfl<32>(tm)); const float sh = fmaxf(tm, 0.f); const float al = __builtin_amdgcn_exp2f(-sh);
        lsum *= al;
#pragma unroll
        for (int i = 0; i < 16; ++i) { O[0][i] *= al; O[1][i] *= al; negm[i] -= sh; S[0][i] -= sh; S[1][i] -= sh; } }
#pragma unroll
    for (int t = 0; t < 2; ++t) {
#pragma unroll
        for (int i = 0; i < 16; ++i) { const float p = __builtin_amdgcn_exp2f(S[t][i]); S[t][i] = p; lsum += p; }
        pk[t][0] = pack_half(S[t], 0); pk[t][1] = pack_half(S[t], 1); }
}
DI void mask_bias(f32x16 (&S)[2], int tcol, int kbase, int hh, int W, bool colsel, const LAS float* b2h) {
#pragma unroll
    for (int t = 0; t < 2; ++t)
#pragma unroll
        for (int i = 0; i < 16; ++i) { const int dist = tcol - (kbase + 32 * t + crow(i, hh)); const bool ok = colsel && dist >= 0 && dist < W;
            const int di = dist < 0 ? 0 : (dist < 128 ? dist : 128); S[t][i] = ok ? S[t][i] + b2h[di * 12] : -1e30f; }
}
DI void nsa_unit(const GAS bf16* proj, GAS bf16* ys, const GAS bf16* kcb, LAS unsigned char* lds, const LAS float* bias2, int b, int u, int tid_in, int lane_in, int wave_in) {
    int tid = tid_in, lane = lane_in, wave = wave_in; asm volatile("" : "+v"(tid), "+v"(lane), "+s"(wave));
    const int t0 = u * 64; const int col = lane & 31, hh = lane >> 5, tl = col >> 2, head = col & 3;
    const int t = t0 + wave * 8 + tl; const int tw0 = t0 + wave * 8;
    const size_t rowb = (size_t)b * SEQ;
    const LAS float* b2h = bias2 + 8 + head;
    bf16x8 qf[4];
    { const float SC = 0.125f * 1.4426950408889634f; const GAS bf16* qp = proj + (rowb + t) * PLD + C_DQ + head * 64 + hh * 8;
#pragma unroll
      for (int s = 0; s < 4; ++s) { const u32x4 w = *(const GAS u32x4*)(qp + s * 16); u32x4 o;
          o.x = cvtpk(lo_bf(w.x) * SC, hi_bf(w.x) * SC); o.y = cvtpk(lo_bf(w.y) * SC, hi_bf(w.y) * SC); o.z = cvtpk(lo_bf(w.z) * SC, hi_bf(w.z) * SC); o.w = cvtpk(lo_bf(w.w) * SC, hi_bf(w.w) * SC);
          qf[s] = __builtin_bit_cast(bf16x8, o); } }
    const int skey = tid >> 3, sch = tid & 7;
    const int i16 = lane & 15, blk = (lane >> 4) & 1;
    const int kboff = col * DK_STR + hh * 16;
    const int vboff = 64 * DK_STR + (4 * hh + (i16 >> 2)) * DV_STR + (16 * blk + 4 * (i16 & 3)) * 2;
    u32x4 kr, vr;
    const int ncvm = (4 * u + 3) < NCMP ? (4 * u + 3) : NCMP;
    const int nsc = (ncvm + 63) >> 6;
    const GAS unsigned char* kcp = (const GAS unsigned char*)(kcb + (size_t)(0 * BATCH + b) * 512 * 64);
    const GAS unsigned char* vcp = (const GAS unsigned char*)(kcb + (size_t)(1 * BATCH + b) * 512 * 64);
    const unsigned soffc = (unsigned)(skey * 64 + sch * 8) * 2u;
    float m1 = -120.f, l1 = 0.f;
    st_load(kcp, vcp, soffc, kr, vr); st_write(lds, skey, sch, kr, vr); __syncthreads();
#pragma unroll 1
    for (int kt = 0; kt < nsc; ++kt) {
        const LAS unsigned char* cur = lds + (kt & 1) * DBUF_BYTES; LAS unsigned char* nxt = lds + ((kt + 1) & 1) * DBUF_BYTES;
        if (kt + 1 < nsc) st_load(kcp, vcp, soffc + (unsigned)(kt + 1) * 8192u, kr, vr);
#pragma unroll
        for (int tt = 0; tt < 2; ++tt) { f32x16 S; qk32z(cur + kboff + tt * 32 * DK_STR, qf, S); mask_bias_cmp32(S, t, kt * 64 + tt * 32, hh, b2h, 0.f);
          const float tm = max16(S); const float mn = fmaxf(m1, tm); float acc = 0.f;
#pragma unroll
          for (int i = 0; i < 16; ++i) acc += __builtin_amdgcn_exp2f(S[i] - mn);
          l1 = l1 * __builtin_amdgcn_exp2f(m1 - mn) + acc; m1 = mn; }
        if (kt + 1 < nsc) st_write(nxt, skey, sch, kr, vr);
        __syncthreads();
    }
    float mf, inv;
    { const float mo = xshfl<32>(m1), lo = xshfl<32>(l1); mf = fmaxf(m1, mo); const float lf = l1 * __builtin_amdgcn_exp2f(m1 - mf) + lo * __builtin_amdgcn_exp2f(mo - mf); inv = lf > 0.f ? 1.f / lf : 0.f; }
    f32x16 Oc[2], imp[4];
#pragma unroll
    for (int i = 0; i < 16; ++i) { Oc[0][i] = 0.f; Oc[1][i] = 0.f; imp[0][i] = 0.f; imp[1][i] = 0.f; imp[2][i] = 0.f; imp[3][i] = 0.f; }
    {   st_load(kcp, vcp, soffc, kr, vr); st_write(lds, skey, sch, kr, vr); __syncthreads();
#pragma unroll 1
        for (int kt = 0; kt < nsc; ++kt) {
            const LAS unsigned char* cur = lds + (kt & 1) * DBUF_BYTES; LAS unsigned char* nxt = lds + ((kt + 1) & 1) * DBUF_BYTES;
            if (kt + 1 < nsc) st_load(kcp, vcp, soffc + (unsigned)(kt + 1) * 8192u, kr, vr);
#pragma unroll
            for (int tt = 0; tt < 2; ++tt) {
                f32x16 S; qk32z(cur + kboff + tt * 32 * DK_STR, qf, S); mask_bias_cmp32(S, t, kt * 64 + tt * 32, hh, b2h, mf);
#pragma unroll
                for (int i = 0; i < 16; ++i) S[i] = __builtin_amdgcn_exp2f(S[i]) * inv;
                bf16x8 pk[2]; pk[0] = pack_half(S, 0); pk[1] = pack_half(S, 1);
                pv32(cur + vboff + tt * 32 * DV_STR, pk, Oc);
                const int Tq = (2 * kt + tt) & 3, MB = (2 * kt + tt) >> 2;
#pragma unroll
                for (int s2 = 0; s2 < 2; ++s2) { u32x4 aw; unsigned e[8];
#pragma unroll
                    for (int jj = 0; jj < 8; ++jj) { const int kk = 16 * s2 + 8 * (jj >> 2) + 4 * hh + (jj & 3); const int delta = 32 * Tq + kk - 4 * col;
                        e[jj] = (delta == -1 || delta == 3) ? 0x3F80u : ((unsigned)delta <= 2u ? 0x4000u : 0u); }
                    aw.x = e[0] | (e[1] << 16); aw.y = e[2] | (e[3] << 16); aw.z = e[4] | (e[5] << 16); aw.w = e[6] | (e[7] << 16);
                    const bf16x8 af = __builtin_bit_cast(bf16x8, aw);
                    if (MB == 0) imp[0] = MFMA32(af, pk[s2], imp[0]); else if (MB == 1) imp[1] = MFMA32(af, pk[s2], imp[1]); else if (MB == 2) imp[2] = MFMA32(af, pk[s2], imp[2]); else imp[3] = MFMA32(af, pk[s2], imp[3]); }
                if (Tq == 3 && MB < 3) { u32x4 aw; aw.x = 0u; aw.y = 0u; aw.z = 0u; aw.w = (lane == 32) ? 0x3F800000u : 0u;
                    const bf16x8 af = __builtin_bit_cast(bf16x8, aw);
                    if (MB == 0) imp[1] = MFMA32(af, pk[1], imp[1]); else if (MB == 1) imp[2] = MFMA32(af, pk[1], imp[2]); else imp[3] = MFMA32(af, pk[1], imp[3]); }
            }
            if (kt + 1 < nsc) st_write(nxt, skey, sch, kr, vr);
            __syncthreads();
        }
    }
    unsigned ocp[2][8];
#pragma unroll
    for (int db = 0; db < 2; ++db)
#pragma unroll
        for (int i = 0; i < 8; ++i) ocp[db][i] = cvtpk(Oc[db][2 * i], Oc[db][2 * i + 1]);
    unsigned sm0 = 0u, sm1 = 0u, sm2 = 0u, sm3 = 0u;
    {   const int cur_t = t >> 6; unsigned key[16];
#pragma unroll
        for (int i = 0; i < 16; ++i) {
            float v0 = imp[0][i], v1 = imp[1][i], v2 = imp[2][i], v3 = imp[3][i];
            v0 += xshfl<1>(v0); v0 += xshfl<2>(v0); v1 += xshfl<1>(v1); v1 += xshfl<2>(v1); v2 += xshfl<1>(v2); v2 += xshfl<2>(v2); v3 += xshfl<1>(v3); v3 += xshfl<2>(v3);
            const float val = head == 0 ? v0 : (head == 1 ? v1 : (head == 2 ? v2 : v3));
            const int j = 32 * head + crow(i, hh);
            const bool forced = (j == 0) || (j == cur_t) || (j == cur_t - 1);
            unsigned fx = (unsigned)(fminf(fmaxf(val, 0.f), 31.f) * 1048576.f) + 1u;
            fx = forced ? 0x1FFFFFFu : (j <= cur_t ? fx : 0u);
            key[i] = (fx << 7) | (unsigned)(127 - j); }
#pragma unroll 1
        for (int r = 0; r < 16; ++r) {
            unsigned w = key[0];
#pragma unroll
            for (int i = 1; i < 16; ++i) w = w > key[i] ? w : key[i];
            { unsigned o = (unsigned)xshfl_i<1>((int)w); w = w > o ? w : o; o = (unsigned)xshfl_i<2>((int)w); w = w > o ? w : o; o = (unsigned)xshfl_i<32>((int)w); w = w > o ? w : o; }
            if ((w >> 7) != 0u) { const int j = 127 - (int)(w & 127u); const unsigned bit = 1u << (j & 31); const int jb = j >> 5;
                sm0 |= (jb == 0) ? bit : 0u; sm1 |= (jb == 1) ? bit : 0u; sm2 |= (jb == 2) ? bit : 0u; sm3 |= (jb == 3) ? bit : 0u; }
#pragma unroll
            for (int i = 0; i < 16; ++i) key[i] = (key[i] == w) ? 0u : key[i];
        }
    }
    f32x16 Ow[2]; float lw = 0.f;
#pragma unroll
    for (int i = 0; i < 16; ++i) { Ow[0][i] = 0.f; Ow[1][i] = 0.f; }
    {   f32x16 negm;
#pragma unroll
        for (int i = 0; i < 16; ++i) negm[i] = 120.f;
        const GAS unsigned char* kwp = (const GAS unsigned char*)(proj + rowb * PLD + C_KW); const GAS unsigned char* vwp = (const GAS unsigned char*)(proj + rowb * PLD + C_VW);
        const unsigned soffp = (unsigned)(skey * PLD + sch * 8) * 2u;
        const int s0 = (u < 8) ? 8 - u : 0;
        st_load(kwp, vwp, soffp + (unsigned)(u - 8 + s0) * (64u * PLD * 2u), kr, vr); st_write(lds, skey, sch, kr, vr); __syncthreads();
#pragma unroll 1
        for (int s = s0; s < 9; ++s) {
            const int par = (s - s0) & 1; const LAS unsigned char* cur = lds + par * DBUF_BYTES; LAS unsigned char* nxt = lds + (par ^ 1) * DBUF_BYTES;
            if (s + 1 < 9) st_load(kwp, vwp, soffp + (unsigned)(u - 8 + s + 1) * (64u * PLD * 2u), kr, vr);
            {   f32x16 S[2]; qk64(cur, kboff, qf, negm, S);
                if (s == 0 || s >= 6) mask_bias(S, t, (u - 8 + s) * 64, hh, 512, true, b2h);
                bf16x8 pk[2][2]; softmax_step(S, Ow, negm, lw, pk); pv64(cur, vboff, pk, Ow); }
            if (s + 1 < 9) st_write(nxt, skey, sch, kr, vr);
            __syncthreads();
        }
    }
    unsigned owp[2][8];
#pragma unroll
    for (int db = 0; db < 2; ++db)
#pragma unroll
        for (int i = 0; i < 8; ++i) owp[db][i] = cvtpk(Ow[db][2 * i], Ow[db][2 * i + 1]);
    f32x16 Os[2]; float lsel = 0.f;
#pragma unroll
    for (int i = 0; i < 16; ++i) { Os[0][i] = 0.f; Os[1][i] = 0.f; }
    {   f32x16 negm;
#pragma unroll
        for (int i = 0; i < 16; ++i) negm[i] = 120.f;
        const GAS unsigned char* ksp = (const GAS unsigned char*)(proj + rowb * PLD + C_KS); const GAS unsigned char* vsp = (const GAS unsigned char*)(proj + rowb * PLD + C_VS);
        const unsigned soffp = (unsigned)(skey * PLD + sch * 8) * 2u;
        u32x4 kA, vA, kB, vB;
        st_load(ksp, vsp, soffp, kr, vr); st_write(lds, skey, sch, kr, vr);
        if (u >= 1) st_load(ksp, vsp, soffp + 64u * PLD * 2u, kA, vA);
        __syncthreads();
#define SEL_STEP(J, KX, VX, KY, VY) { const int j_ = (J); \
            const LAS unsigned char* cur = lds + (j_ & 1) * DBUF_BYTES; LAS unsigned char* nxt = lds + ((j_ + 1) & 1) * DBUF_BYTES; \
            if (j_ + 2 <= u) st_load(ksp, vsp, soffp + (unsigned)(j_ + 2) * (64u * PLD * 2u), KY, VY); \
            const int jb = j_ >> 5; const unsigned smw = jb == 0 ? sm0 : (jb == 1 ? sm1 : (jb == 2 ? sm2 : sm3)); \
            const bool bit = ((smw >> (j_ & 31)) & 1u) != 0u; \
            if (__builtin_amdgcn_ballot_w64(bit) != 0ull) { \
                f32x16 S[2]; qk64(cur, kboff, qf, negm, S); \
                if (64 * j_ + 63 > tw0 - 113) mask_bias(S, t, 64 * j_, hh, 1 << 30, bit, b2h); \
                else if (!bit) { _Pragma("unroll") for (int i = 0; i < 16; ++i) { S[0][i] = -1e30f; S[1][i] = -1e30f; } } \
                bf16x8 pk[2][2]; softmax_step(S, Os, negm, lsel, pk); pv64(cur, vboff, pk, Os); } \
            if (j_ + 1 <= u) st_write(nxt, skey, sch, KX, VX); \
            __syncthreads(); }
#pragma unroll 1
        for (int j = 0; j <= u; j += 2) {
            SEL_STEP(j, kA, vA, kB, vB)
            if (j + 1 <= u) SEL_STEP(j + 1, kB, vB, kA, vA)
        }
#undef SEL_STEP
    }
    {   const float lwt = lw + xshfl<32>(lw), lst = lsel + xshfl<32>(lsel);
        const GAS bf16* gp = proj + (rowb + t) * PLD + C_DG + head * 3;
        const float g0 = sigmoidf_(bf2f(gp[0])), g1 = sigmoidf_(bf2f(gp[1])) / fmaxf(lst, 1e-30f), g2 = sigmoidf_(bf2f(gp[2])) / fmaxf(lwt, 1e-30f);
        GAS bf16* op = ys + (rowb + t) * 1024 + 768 + head * 64;
#pragma unroll
        for (int db = 0; db < 2; ++db)
#pragma unroll
            for (int gq = 0; gq < 4; ++gq) { const int d0 = 32 * db + 8 * gq + 4 * hh; float y[4];
#pragma unroll
                for (int e = 0; e < 4; ++e) { const unsigned cw = ocp[db][2 * gq + (e >> 1)], ww = owp[db][2 * gq + (e >> 1)];
                    y[e] = g0 * ((e & 1) ? hi_bf(cw) : lo_bf(cw)) + g1 * Os[db][4 * gq + e] + g2 * ((e & 1) ? hi_bf(ww) : lo_bf(ww)); }
                u32x2 w; w.x = cvtpk(y[0], y[1]); w.y = cvtpk(y[2], y[3]); *(GAS u32x2*)(op + d0) = w; }
    }
}


DI void swa_unit(const GAS bf16* proj, GAS bf16* ys, LAS unsigned char* lds, const LAS float* bias2, const LAS float* biasd, const GAS float* sinks, int b, int u, int tid_in, int lane_in, int wave_in) {
    int tid = tid_in, lane = lane_in, wave = wave_in; asm volatile("" : "+v"(tid), "+v"(lane), "+s"(wave));
    const int t0 = u * 64; const int col = lane & 31, hh = lane >> 5, tl = col >> 1, kv = wave & 1, head = 2 * kv + (col & 1);
    const int t = t0 + (wave >> 1) * 16 + tl;
    const size_t rowb = (size_t)b * SEQ;
    const LAS float* b2h = bias2 + head;
    bf16x8 qf[4];
    { const float SC = 0.125f * 1.4426950408889634f; const GAS bf16* qp = proj + (rowb + t) * PLD + C_BQ + head * 64 + hh * 8;
#pragma unroll
      for (int s = 0; s < 4; ++s) { const u32x4 w = *(const GAS u32x4*)(qp + s * 16); u32x4 o;
          o.x = cvtpk(lo_bf(w.x) * SC, hi_bf(w.x) * SC); o.y = cvtpk(lo_bf(w.y) * SC, hi_bf(w.y) * SC); o.z = cvtpk(lo_bf(w.z) * SC, hi_bf(w.z) * SC); o.w = cvtpk(lo_bf(w.w) * SC, hi_bf(w.w) * SC);
          qf[s] = __builtin_bit_cast(bf16x8, o); } }
    const int skey = tid >> 3, sch = tid & 7;
    const int i16 = lane & 15, blk = (lane >> 4) & 1;
    const int kboff = kv * DBUF_BYTES + col * DK_STR + hh * 16;
    const int vboff = kv * DBUF_BYTES + 64 * DK_STR + (4 * hh + (i16 >> 2)) * DV_STR + (16 * blk + 4 * (i16 & 3)) * 2;
    const GAS unsigned char* kp = (const GAS unsigned char*)(proj + rowb * PLD + C_BK); const GAS unsigned char* vp = (const GAS unsigned char*)(proj + rowb * PLD + C_BV);
    const unsigned soffp = (unsigned)(skey * PLD + sch * 8) * 2u;
    u32x4 k0, v0, k1, v1;
    f32x16 O[2], negm; float lsum = 0.f;
#pragma unroll
    for (int i = 0; i < 16; ++i) { O[0][i] = 0.f; O[1][i] = 0.f; negm[i] = 120.f; }
    const int s0 = (u < 2) ? 2 - u : 0;
    { const unsigned so = soffp + (unsigned)(u - 2 + s0) * (64u * PLD * 2u); st_load(kp, vp, so, k0, v0); st_load(kp + 128, vp + 128, so, k1, v1);
      st_write(lds, skey, sch, k0, v0); st_write(lds + DBUF_BYTES, skey, sch, k1, v1); }
    __syncthreads();
#pragma unroll 1
    for (int s = s0; s < 3; ++s) {
        const int par = (s - s0) & 1; const LAS unsigned char* cur = lds + par * 2 * DBUF_BYTES; LAS unsigned char* nxt = lds + (par ^ 1) * 2 * DBUF_BYTES;
        if (s + 1 < 3) { const unsigned so = soffp + (unsigned)(u - 2 + s + 1) * (64u * PLD * 2u); st_load(kp, vp, so, k0, v0); st_load(kp + 128, vp + 128, so, k1, v1); }
        {   f32x16 S[2]; qk64(cur, kboff, qf, negm, S);
            mask_bias(S, t, (u - 2 + s) * 64, hh, 128, true, b2h);
            bf16x8 pk[2][2]; softmax_step(S, O, negm, lsum, pk); pv64(cur, vboff, pk, O); }
        if (s + 1 < 3) { st_write(nxt, skey, sch, k0, v0); st_write(nxt + DBUF_BYTES, skey, sch, k1, v1); }
        __syncthreads();
    }
    {   const float sinkp = (sinks[head] - biasd[128 * 12 + head]) * 1.4426950408889634f;
        const float lt = lsum + xshfl<32>(lsum) + __builtin_amdgcn_exp2f(sinkp + negm[0]);
        const float inv = 1.f / fmaxf(lt, 1e-30f);
        GAS bf16* op = ys + (rowb + t) * 1024 + 256 + head * 64;
#pragma unroll
        for (int db = 0; db < 2; ++db)
#pragma unroll
            for (int gq = 0; gq < 4; ++gq) { const int d0 = 32 * db + 8 * gq + 4 * hh;
                u32x2 w; w.x = cvtpk(O[db][4 * gq + 0] * inv, O[db][4 * gq + 1] * inv); w.y = cvtpk(O[db][4 * gq + 2] * inv, O[db][4 * gq + 3] * inv); *(GAS u32x2*)(op + d0) = w; }
    }
}

DI void route_rows4(const KA& a, int l, bf16* xr_, int tok0, int lane_) {
    int lane = lane_; asm volatile("" : "+v"(lane));
    const GAS float* xrow = (const GAS float*)a.out + (size_t)tok0 * 1024; const GAS float* g = (const GAS float*)(a.in[28] + (size_t)l * 1024); GAS bf16* xr = (GAS bf16*)xr_;
    f32x4 v[4][4]; float ss[4];
#pragma unroll
    for (int rr = 0; rr < 4; ++rr)
#pragma unroll
        for (int j = 0; j < 4; ++j) v[rr][j] = *(const GAS f32x4*)(xrow + (size_t)rr * 1024 + 4 * (lane + 64 * j));
#pragma unroll
    for (int rr = 0; rr < 4; ++rr) { float t = 0.f;
#pragma unroll
        for (int j = 0; j < 4; ++j) t += (v[rr][j][0] * v[rr][j][0] + v[rr][j][1] * v[rr][j][1]) + (v[rr][j][2] * v[rr][j][2] + v[rr][j][3] * v[rr][j][3]);
        ss[rr] = t; }
#pragma unroll
    for (int rr = 0; rr < 4; ++rr) ss[rr] = wave_sum(ss[rr]);
#pragma unroll
    for (int j = 0; j < 4; ++j) { const int k0 = 4 * (lane + 64 * j); const f32x4 gv = *(const GAS f32x4*)(g + k0);
#pragma unroll
        for (int rr = 0; rr < 4; ++rr) { const float r = 1.f / sqrtf(ss[rr] * (1.f / 1024.f) + 1e-6f); const f32x4 xn = v[rr][j] * r * gv;
            unsigned hi[4]; float lo[4];
#pragma unroll
            for (int e = 0; e < 4; ++e) { hi[e] = f2bf(xn[e]); lo[e] = xn[e] - __builtin_bit_cast(float, hi[e] << 16); }
            u32x2 wh, wl; wh.x = hi[0] | (hi[1] << 16); wh.y = hi[2] | (hi[3] << 16); wl.x = pk2(lo[0], lo[1]); wl.y = pk2(lo[2], lo[3]);
            *(GAS u32x2*)(xr + (size_t)(tok0 + rr) * 2048 + k0) = wh; *(GAS u32x2*)(xr + (size_t)(tok0 + rr) * 2048 + 1024 + k0) = wl; } }
}
struct SchedRoute { const char* A; const char* B; int pm;
    DI bool next(int i, Unit& u) const { if (i > 0) return false; u.pm = pm; u.pn = 0; u.aux = 0; u.pad = 0; u.a = A + (size_t)pm * 128 * 2048 * 2; u.b = B; return true; } };
struct EpiRoute { static constexpr bool CARRY = false; float* rlog;
    DI void operator()(const f32x4 (&acc)[2][2][4][2], const Unit& u, int wr, int wc, int fr, int fq) const {
        const int row0 = u.pm * 128 + wr * 64 + fr; const int col = wc * 32 + 8 * fq;
#pragma unroll
        for (int m = 0; m < 4; ++m) { float* rp = rlog + (size_t)(row0 + m * 16) * 128 + col; *(f32x4*)rp = acc[0][0][m][0]; *(f32x4*)(rp + 4) = acc[0][0][m][1]; }
    }
};
DI void route_decide(const KA& a, int l, const float* rl_row, int* rec_e, int* rec_slot, float* rec_w, unsigned* cnt, int tok) {
    float lg[36];
    const float* bg = a.in[30] + l * 4; const float* be = a.in[32] + l * 32;
#pragma unroll
    for (int q = 0; q < 9; ++q) { const f32x4 h = *(const f32x4*)(rl_row + 4 * q), lo = *(const f32x4*)(rl_row + 64 + 4 * q);
        lg[4 * q + 0] = h[0] + lo[0]; lg[4 * q + 1] = h[1] + lo[1]; lg[4 * q + 2] = h[2] + lo[2]; lg[4 * q + 3] = h[3] + lo[3]; }
#pragma unroll
    for (int i = 0; i < 4; ++i) lg[i] += bg[i];
#pragma unroll
    for (int i = 0; i < 32; ++i) lg[4 + i] += be[i];
    int gsel = 0; float gm = lg[0];
#pragma unroll
    for (int i = 1; i < 4; ++i) if (lg[i] > gm) { gm = lg[i]; gsel = i; }
    float gs = 0.f;
#pragma unroll
    for (int i = 0; i < 4; ++i) gs += __expf(lg[i] - gm);
    const float gwt = 1.f / gs;
    float v8[8];
#pragma unroll
    for (int i = 0; i < 8; ++i) { float x = lg[4 + i];
#pragma unroll
        for (int gq = 1; gq < 4; ++gq) x = (gsel == gq) ? lg[4 + gq * 8 + i] : x;
        v8[i] = x; }
    int i0 = 0; float m0 = v8[0];
#pragma unroll
    for (int i = 1; i < 8; ++i) if (v8[i] > m0) { m0 = v8[i]; i0 = i; }
    int i1 = -1; float m1 = -3e38f;
#pragma unroll
    for (int i = 0; i < 8; ++i) if (i != i0 && v8[i] > m1) { m1 = v8[i]; i1 = i; }
    if (i1 < 0) i1 = (i0 == 0) ? 1 : 0;
    const float w0 = 1.f / (1.f + __expf(m1 - m0)); const float w1 = 1.f - w0;
    const int e0 = gsel * 8 + i0, e1 = gsel * 8 + i1;
    const unsigned s0 = __hip_atomic_fetch_add(cnt + e0, 1u, __ATOMIC_RELAXED, __HIP_MEMORY_SCOPE_AGENT);
    const unsigned s1 = __hip_atomic_fetch_add(cnt + e1, 1u, __ATOMIC_RELAXED, __HIP_MEMORY_SCOPE_AGENT);
    rec_e[tok * 2] = e0; rec_e[tok * 2 + 1] = e1; rec_slot[tok * 2] = (int)s0; rec_slot[tok * 2 + 1] = (int)s1; rec_w[tok * 2] = w0 * gwt; rec_w[tok * 2 + 1] = w1 * gwt;
}
DI void expert_weights(const KA& a, int l, LAS unsigned char* lds, int it0, int it1, int gw, int NGW, int wave, int lane) {
    LAS float* scr = (LAS float*)(lds + wave * 16384);
    const float* wgt = a.in[33] + (size_t)l * 32 * 1024 * 256; const float* wup = a.in[34] + (size_t)l * 32 * 1024 * 256; const float* wdn = a.in[35] + (size_t)l * 32 * 256 * 1024;
    bf16* Wgu = (bf16*)(a.ws + WS_WGU); bf16* Wd = (bf16*)(a.ws + WS_WD);
    constexpr int I_E = 16 * 8, I_D = 4 * 32;
    constexpr int NIT = 32 * (2 * I_E + I_D);
    (void)NIT;
    for (int it = it0 + gw; it < it1; it += NGW) {
        const int e = it / (2 * I_E + I_D); int r = it % (2 * I_E + I_D);
        if (r < 2 * I_E) { const int up = r / I_E, q = r % I_E, kb = q / 8, nb = q % 8; const int n0 = nb * 32;
            const int drow = (n0 >> 7) * 256 + up * 128 + (n0 & 127);
            transpose_item((up ? wup : wgt) + (size_t)e * 1024 * 256, 256, 256, Wgu + (size_t)e * 512 * 1024, 1024, kb * 64, n0, drow, scr, lane);
        } else { r -= 2 * I_E; const int kb = r / 32, nb = r % 32;
            transpose_item(wdn + (size_t)e * 256 * 1024, 1024, 1024, Wd + (size_t)e * 1024 * 256, 256, kb * 64, nb * 32, nb * 32, scr, lane); }
    }
}
DI void build_offsets(const unsigned* cnt, LAS int* offt, int tid) {
    if (tid < 32) { const int c = (int)__hip_atomic_load(cnt + tid, __ATOMIC_RELAXED, __HIP_MEMORY_SCOPE_AGENT); offt[330 + tid] = (c + 255) & ~255; }
    __syncthreads();
    if (tid == 0) { int o = 0;
#pragma unroll
        for (int e = 0; e < 32; ++e) { offt[e] = o; o += offt[330 + e]; } offt[32] = o; }
    __syncthreads();
    for (int rt = tid; rt < (MOE_ROWS >> 8); rt += 512) { int e = 0; for (int j = 1; j < 32; ++j) e += (offt[j] <= rt * 256) ? 1 : 0; offt[40 + rt] = e; }
    __syncthreads();
}

template <unsigned PM>
__global__ void __launch_bounds__(512, 2) mk_fwd(Args a_) {
    extern __shared__ __attribute__((aligned(16))) unsigned char lds_raw[];
    LAS unsigned char* lds = (LAS unsigned char*)lds_raw;
    const int wave0 = __builtin_amdgcn_readfirstlane((int)threadIdx.x >> 6);
    if (threadIdx.x < 36) ((LAS unsigned long long*)(lds + PTAB_OFF))[threadIdx.x] = (unsigned long long)a_.in[threadIdx.x];
    __syncthreads();
    KA a; a.in.base = (unsigned)(size_t)(lds + PTAB_OFF); a.out = a_.out; a.ws = a_.ws;
    const int G = gridDim.x, bid = blockIdx.x, NGW = G * 8;
#define PHASE_IDS() int wave = wave0; asm volatile("" : "+s"(wave)); const int lane = my_lane(); const int tid_ = wave * 64 + lane, gw = bid * 8 + wave; (void)tid_; (void)gw; \
    const int xb = ((bid & 7) << 5) | (bid >> 3); (void)xb;        \
    KA ap = a; asm volatile("" : "+s"(ap.ws), "+s"(ap.out), "+s"(ap.in.base)); \
    bf16* hb = (bf16*)(ap.ws + WS_HB); bf16* proj = (bf16*)(ap.ws + WS_PROJ); bf16* gates = (bf16*)(ap.ws + WS_GATES); \
    bf16* ys = hb; bf16* x2b = hb; bf16* merged = proj; bf16* eo = proj; \
    bf16* kcb = (bf16*)(ap.ws + WS_KCVC); float* lrusum = (float*)(ap.ws + WS_LRUSUM); \
    int* rec_e = (int*)(ap.ws + WS_REC); int* rec_slot = rec_e + T * 2; float* rec_w = (float*)(rec_slot + T * 2); \
    int* rowtok = (int*)(ap.ws + WS_ROWTOK); float* roww = (float*)(ap.ws + WS_ROWW); \
    bf16* xs = (bf16*)(ap.ws + WS_XS); bf16* hmid = (bf16*)(ap.ws + WS_HMID); unsigned* ctl = (unsigned*)(ap.ws + WS_CTL); \
    (void)hb; (void)proj; (void)gates; (void)ys; (void)x2b; (void)merged; (void)eo; (void)kcb; (void)lrusum; (void)rec_e; (void)rec_slot; (void)rec_w; (void)rowtok; (void)roww; (void)xs; (void)hmid; (void)ctl
    volatile LAS unsigned* MISC = (volatile LAS unsigned*)(lds + MISC_OFF);
    LAS float* biasd = (LAS float*)(lds + BIAS_OFF);
    LAS int* offt = (LAS int*)(lds + OFFT_OFF);
    { PHASE_IDS();
    if (tid_ < 64) MISC[tid_] = 0u;
    for (int i = tid_; i < 129 * 12; i += 512) { const int d = i / 12, hd = i % 12; const int bk = d < 128 ? T5_BUCKET[d] : 31; const float* rb = a.in[1]; biasd[i] = rb[bk * 12 + hd]; ((LAS float*)(lds + BIAS2_OFF))[i] = (rb[bk * 12 + hd] - rb[31 * 12 + hd]) * 1.4426950408889634f; } }
    __syncthreads();
    const int lo = a_.ph_lo, hi = a_.ph_hi;
    XcdBarrier bar; bar.bar = (unsigned*)(a.ws + WS_CTL) + CW_BAR; bar.x = 0; bar.st = nullptr;
    if (hi - lo > 1) { PHASE_IDS(); bar = xcd_barrier_post(ctl + CW_BAR, MISC + 8, tid_ == 0); }
#ifndef SUB_MASK
#define SUB_MASK 0xFFu
#endif
#define SUB(k) ((SUB_MASK >> (k)) & 1u)
#define HASP(k) ((PM >> ((k) % PPL + ((k) >= 2 * PPL ? PPL : 0))) & 1u)
#define IN(k) (HASP(k) && lo <= (k) && (k) < hi)
#define SEAM(k) do { if ((k) + 1 < hi) { const int sl_ = my_lane(); int sw_ = wave0; asm volatile("" : "+s"(sw_)); xcd_barrier(bar, sw_ == 0 && sl_ == 0); } } while (0)
    for (int l = 0; l < DEPTH; ++l) {
        const int pb = l * PPL;
        if (IN(pb + 0)) { PHASE_IDS(); p1_weights_i8(ap, l, lds, gw, NGW, wave, lane); router_weights(ap, l, gw, NGW, lane); lru_weights(ap, l, gw, NGW, lane); cmp_weights(ap, l, lds, gw, NGW, wave, lane); phase0_weights(ap, l, lds, gw, NGW, wave, lane); phase0_rows(ap, l, 0, gw, NGW, lane); SEAM(pb + 0); }
        if (IN(pb + 1)) {
            PHASE_IDS();
            {   int K1q = 512; asm volatile("" : "+s"(K1q));
                pg8::Gemm g{K1q, 512, 512, 128, -1}; SchedP1 S{(const char*)(ap.ws + WS_HQ), (const char*)(ap.ws + WS_WQ), 128, 26, 1024, 1024, G, bid};
                EpiP1I8 E{proj, (unsigned char*)gates, ap.in[25] + (size_t)l * 4096, (const float*)(ap.ws + WS_HSC), (const float*)(ap.ws + WS_WSC)};
                pg8::gemm_phase<EpiP1I8, SchedP1, false, true>(lds, g, S, E, tid_); }
            SEAM(pb + 1);
        }
        if (IN(pb + 2)) {
            PHASE_IDS();
            LAS float* lamp = (LAS float*)(lds + MISC_OFF + 64);
            if (tid_ < 64) { const float* q1 = ap.in[13] + l * 32; const float* k1 = ap.in[14] + l * 32; const float* q2 = ap.in[15] + l * 32; const float* k2 = ap.in[16] + l * 32;
                float s1 = (lane < 32) ? q1[lane] * k1[lane] : 0.f, s2 = (lane < 32) ? q2[lane] * k2[lane] : 0.f; s1 = wave_sum(s1); s2 = wave_sum(s2);
                const float lam_init = 0.8f - 0.6f * __expf(-0.3f * (float)l); if (lane == 0) { lamp[0] = __expf(s1) - __expf(s2) + lam_init; lamp[1] = lam_init; } }
            __syncthreads();
            if (SUB(0)) { const LAS float* bias2 = (const LAS float*)(lds + BIAS2_OFF); const GAS float* subg = (const GAS float*)(ap.in[17] + l * 64);
                for (int pi = xb; pi < 256; pi += G) { const int bh = pi >> 4, qlo = pi & 15;
                    diff_unit((const GAS bf16*)proj, (GAS bf16*)ys, lds, bias2, subg, lamp, bh >> 2, bh & 3, 31 - qlo, wave);
                    diff_unit((const GAS bf16*)proj, (GAS bf16*)ys, lds, bias2, subg, lamp, bh >> 2, bh & 3, qlo, wave); } }
            { PHASE_IDS();
            if (SUB(3)) { __syncthreads(); const LAS float* bias2 = (const LAS float*)(lds + BIAS2_OFF); const GAS float* sinks = (const GAS float*)(ap.in[12] + l * 4);
                for (int pi = xb; pi < 512; pi += G) swa_unit((const GAS bf16*)proj, (GAS bf16*)ys, lds, bias2, biasd, sinks, pi >> 7, pi & 127, tid_, lane, wave); }
            if (SUB(2)) cmp_rows16((const GAS bf16*)proj, (const GAS bf16*)(ap.ws + WS_WCMP), (GAS float*)(ap.ws + WS_CMPAB), bid, wave, lane);
            if (SUB(1)) { __syncthreads(); for (int task = xb; task < 512; task += G) lru_unit(ap, l, (const GAS bf16*)proj, (GAS bf16*)ys, (GAS float*)lrusum, lds, task, lane, wave, false); }
            }
            SEAM(pb + 2);
        }
        if (IN(pb + 3)) {
            PHASE_IDS();
            for (int task = gw; task < 2 * BATCH * NCMP; task += NGW) cmp_finish(ap, l, (const float*)(ap.ws + WS_CMPAB), kcb, task, lane);
            __syncthreads();
            for (int task = xb; task < 512; task += G) lru_unit(ap, l, (const GAS bf16*)proj, (GAS bf16*)ys, (GAS float*)lrusum, lds, task, lane, wave, true);
            SEAM(pb + 3);
        }
        if (IN(pb + 4)) {
            PHASE_IDS();
            if (SUB(4)) { const LAS float* bias2 = (const LAS float*)(lds + BIAS2_OFF);
                for (int pi = xb; pi < 256; pi += G) { const int bb = pi >> 6, ulo = pi & 63;
                    nsa_unit((const GAS bf16*)proj, (GAS bf16*)ys, (const GAS bf16*)kcb, lds, bias2, bb, 127 - ulo, tid_, lane, wave);
                    nsa_unit((const GAS bf16*)proj, (GAS bf16*)ys, (const GAS bf16*)kcb, lds, bias2, bb, ulo, tid_, lane, wave); } }
            SEAM(pb + 4);
        }
        if (IN(pb + 5)) {
            PHASE_IDS();
            int K5 = 256; asm volatile("" : "+s"(K5));
            pg8::Gemm g{K5, 1024, 256, 128, -1}; SchedP3a S{(const char*)ys, (const char*)(ap.ws + WS_WBR), G, xb};
            EpiP3a E{merged, (const unsigned char*)gates};
            pg8::gemm_phase<EpiP3a, SchedP3a>(lds, g, S, E, tid_); SEAM(pb + 5);
        }
        if (IN(pb + 6)) {
            PHASE_IDS();
            int K6 = 1024; asm volatile("" : "+s"(K6));
            pg8::Gemm g{K6, 1024, 1024, 128, -1}; SchedP3b S{(const char*)merged, (const char*)(ap.ws + WS_WOUT), G, xb};
            EpiP3b E{(l == 0) ? ap.in[0] : ap.out, ap.out};
            pg8::gemm_phase<EpiP3b, SchedP3b>(lds, g, S, E, tid_); SEAM(pb + 6);
        }
        if (IN(pb + 7)) {
            PHASE_IDS();
            bf16* xr = (bf16*)(ap.ws + WS_XR); float* rlog = (float*)(ap.ws + WS_RLOG);
            constexpr int NITW = 32 * (2 * 16 * 8 + 4 * 32);
            { const int pm = bid;
                for (int r = wave * 4; r < 128; r += 32) route_rows4(ap, l, xr, pm * 128 + r, lane);
                asm volatile("s_waitcnt vmcnt(0)" ::: "memory"); __syncthreads();
                { pg8::Gemm g{2048, 2048, 2048, 128, 0}; SchedRoute S{(const char*)xr, (const char*)(ap.ws + WS_WR), pm}; EpiRoute E{rlog};
                  pg8::gemm_phase<EpiRoute, SchedRoute>(lds, g, S, E, tid_); }
                asm volatile("s_waitcnt vmcnt(0)" ::: "memory"); __syncthreads();
                if (tid_ < 128) route_decide(ap, l, rlog + (size_t)(pm * 128 + tid_) * 128, rec_e, rec_slot, rec_w, ctl + CW_CNT + l * 32, pm * 128 + tid_);
                __syncthreads();
            }
            expert_weights(ap, l, lds, 0, NITW, gw, NGW, wave, lane);
            SEAM(pb + 7);
        }
        if (IN(pb + 8)) {
            PHASE_IDS();
            build_offsets(ctl + CW_CNT + l * 32, offt, tid_);
            if (bid < 32) { const int e = bid; const int c = (int)__hip_atomic_load(ctl + CW_CNT + l * 32 + e, __ATOMIC_RELAXED, __HIP_MEMORY_SCOPE_AGENT);
                for (int p = offt[e] + c + tid_; p < offt[e + 1]; p += 512) rowtok[p] = -1; }
            {   int* rowsrc = (int*)xs;
                if (bid < 32) { const int e = bid; const int c = (int)__hip_atomic_load(ctl + CW_CNT + l * 32 + e, __ATOMIC_RELAXED, __HIP_MEMORY_SCOPE_AGENT);
                    for (int p = offt[e] + c + tid_; p < offt[e + 1]; p += 512) rowsrc[p] = 0; }
                for (int as = bid * 512 + tid_; as < 2 * T; as += G * 512) { const int p = offt[rec_e[as]] + rec_slot[as];
                    rowtok[p] = as; roww[p] = rec_w[as]; rowsrc[p] = as >> 1; } }
            SEAM(pb + 8);
        }
        if (IN(pb + 9)) {
            PHASE_IDS();
            build_offsets(ctl + CW_CNT + l * 32, offt, tid_);
            int K9 = 1024; asm volatile("" : "+s"(K9));
            pg8::Gemm g{K9, 2048, 1024, 128, -1}; SchedM2 S{(const char*)(ap.ws + WS_XR), (const char*)(ap.ws + WS_WGU), offt, (const int*)xs, G, xb};
            EpiM2 E{hmid};
            pg8::gemm_phase<EpiM2, SchedM2, true>(lds, g, S, E, tid_); SEAM(pb + 9);
        }
        if (IN(pb + 10)) {
            PHASE_IDS();
            build_offsets(ctl + CW_CNT + l * 32, offt, tid_);
            int K3 = 256; asm volatile("" : "+s"(K3));
            pg8::Gemm g{K3, 256, 256, 128, -1}; SchedM3 S{(const char*)hmid, (const char*)(ap.ws + WS_WD), offt, G, xb};
            EpiM3 E{eo, rowtok, roww};
            pg8::gemm_phase<EpiM3, SchedM3>(lds, g, S, E, tid_); SEAM(pb + 10);
        }
    }
    if (IN(2 * PPL)) { PHASE_IDS(); phase0_rows(ap, DEPTH, 1, gw, NGW, lane); }
#undef IN
#undef SEAM
}

typedef void (*kern_t)(Args);
template <unsigned PM> static bool setup_kernel() {
    if (hipFuncSetAttribute((const void*)mk_fwd<PM>, hipFuncAttributeMaxDynamicSharedMemorySize, LDS_BYTES) != hipSuccess) { fprintf(stderr, "kernel_launch: hipFuncSetAttribute failed\n"); return false; }
    return true;
}
extern "C" void kernel_launch(void* const* d_in, const int* in_sizes, int n_in, void* d_out, int out_size, void* d_ws, size_t ws_size, hipStream_t stream) {
    static int grid = 0;
    if (grid == 0) {
        if (n_in != 36 || out_size != T * D || ws_size < WS_END) { fprintf(stderr, "kernel_launch: unexpected shapes (n_in %d out %d ws %zu)\n", n_in, out_size, ws_size); grid = -1; return; }
        int dev = 0, cus = 0;
        if (hipGetDevice(&dev) != hipSuccess || hipDeviceGetAttribute(&cus, hipDeviceAttributeMultiprocessorCount, dev) != hipSuccess) { grid = -1; return; }
        bool ok = true;
#if MK_ONE_LAUNCH
        ok = setup_kernel<0xFFFu>();
#endif
        if (!ok) { grid = -1; return; }
        (void)hipGetLastError();
        grid = cus;
        if (grid != 256) { fprintf(stderr, "kernel_launch: built for a 256-CU device (got %d)\n", cus); grid = -1; return; }
    }
    if (grid < 0) return;
    if (hipMemsetAsync((char*)d_ws + WS_CTL, 0, CTL_ZERO_BYTES, stream) != hipSuccess) return;
    Args a{};
    for (int i = 0; i < 36; ++i) a.in[i] = (const float*)d_in[i];
    a.out = (float*)d_out; a.ws = (unsigned char*)d_ws;
#if MK_ONE_LAUNCH
    a.ph_lo = 0; a.ph_hi = NPH;
    hipLaunchKernelGGL(mk_fwd<0xFFFu>, dim3(grid), dim3(512), LDS_BYTES, stream, a);
#endif
}
```

```cpp
#include <hip/hip_runtime.h>
#include <cstdio>
#include <cstdint>

#ifndef MK_ONE_LAUNCH
#define MK_ONE_LAUNCH 1
#endif

#define DI __device__ __forceinline__
#define GAS __attribute__((address_space(1)))
#define LAS __attribute__((address_space(3)))
typedef unsigned short bf16;
typedef short bf16x8 __attribute__((ext_vector_type(8)));
typedef float f32x4 __attribute__((ext_vector_type(4)));
typedef int i32x4 __attribute__((ext_vector_type(4)));
typedef unsigned u32x4 __attribute__((ext_vector_type(4)));
typedef unsigned u32x2 __attribute__((ext_vector_type(2)));
typedef float f32x16 __attribute__((ext_vector_type(16)));
typedef float f32x2 __attribute__((ext_vector_type(2)));
typedef short s16x4 __attribute__((ext_vector_type(4)));
typedef __bf16 bf16x2_t __attribute__((ext_vector_type(2)));
typedef short v4i16_t __attribute__((__vector_size__(4 * sizeof(short))));
#define MFMA32(a, b, c) __builtin_amdgcn_mfma_f32_32x32x16_bf16((a), (b), (c), 0, 0, 0)

constexpr int BATCH = 4, SEQ = 8192, T = BATCH * SEQ, D = 1024, DEPTH = 2;
constexpr int NIN = 2444, PLD = 2560, N1 = 6656, GLD = 4096;
constexpr int C_AX = 0, C_AG = 256, C_BQ = 512, C_BK = 768, C_BV = 896, C_CQ = 1024, C_CK = 1280, C_CV = 1536, C_DQ = 1792,
              C_KC = 2048, C_VC = 2112, C_KS = 2176, C_VS = 2240, C_KW = 2304, C_VW = 2368, C_DG = 2432;
constexpr int NCMP = 511;
constexpr int MOE_ROWS = 73728;
constexpr int PPL = 11;
constexpr int NPH = 2 * PPL + 1;

constexpr size_t MiB = 1u << 20;
constexpr size_t WS_CTL = 0, CTL_ZERO_BYTES = 1 * MiB;
constexpr size_t WS_KCVC = 1 * MiB;
constexpr size_t WS_LRUSUM = 2 * MiB;
constexpr size_t WS_REC = 2 * MiB + 256 * 1024;
constexpr size_t WS_ROWTOK = 3 * MiB;
constexpr size_t WS_ROWW = 3 * MiB + 512 * 1024;
constexpr size_t WS_WIN = 4 * MiB;
constexpr size_t WS_WQ = 4 * MiB;
constexpr size_t WS_WSC = 13 * MiB;
constexpr size_t WS_HSC = 13 * MiB + 65536;
constexpr size_t WS_HQ = 21 * MiB;
constexpr size_t WS_XB = 373 * MiB;
constexpr size_t WS_WBR = 17 * MiB;
constexpr size_t WS_WOUT = 19 * MiB;
constexpr size_t WS_HB = 21 * MiB;
constexpr size_t WS_PROJ = 85 * MiB;
constexpr size_t WS_GATES = 245 * MiB;
constexpr size_t WS_WGU = 245 * MiB;
constexpr size_t WS_WD = 277 * MiB;
constexpr size_t WS_XS = 293 * MiB;
constexpr size_t WS_HMID = 437 * MiB;
constexpr size_t WS_XR = 85 * MiB;
constexpr size_t WS_RLOG = 213 * MiB;
constexpr size_t WS_WR = 501 * MiB;
constexpr size_t WS_WCMP = 502 * MiB;
constexpr size_t WS_CMPAB = 503 * MiB;
constexpr size_t WS_LRUW = 505 * MiB + 65536;
constexpr size_t WS_END = 506 * MiB;
constexpr int CW_BAR = 4096;
constexpr int CW_CNT = 16384;

constexpr int RING_BYTES = 131072;
constexpr int MISC_OFF = RING_BYTES;
constexpr int BIAS_OFF = MISC_OFF + 256;
constexpr int OFFT_OFF = BIAS_OFF + 129 * 12 * 4;
constexpr int PTAB_OFF = OFFT_OFF + (40 + 288 + 40) * 4;
constexpr int BIAS2_OFF = PTAB_OFF + 36 * 8;
constexpr int LRUEX_OFF = BIAS2_OFF + 129 * 12 * 4;
constexpr int LDS_BYTES = 163840;
constexpr int LRUCST_OFF = LRUEX_OFF + 8 * 64 * 2 * 4;
constexpr int LRUCAR_OFF = LRUCST_OFF + 3 * 64 * 4;
static_assert(PTAB_OFF % 8 == 0 && LRUCAR_OFF + 8 * 64 * 4 <= LDS_BYTES, "LDS map");

DI float bf2f(bf16 v) { return __builtin_bit_cast(float, (unsigned)v << 16); }
DI float lo_bf(unsigned w) { return __builtin_bit_cast(float, w << 16); }
DI float hi_bf(unsigned w) { return __builtin_bit_cast(float, w & 0xffff0000u); }
DI unsigned f2bf(float f) { unsigned u = __builtin_bit_cast(unsigned, f); return (u + 0x7fffu + ((u >> 16) & 1u)) >> 16; }
DI unsigned pk2(float lo, float hi) { return f2bf(lo) | (f2bf(hi) << 16); }
DI float rl(float v, int i) { return __builtin_bit_cast(float, __builtin_amdgcn_readlane(__builtin_bit_cast(int, v), i)); }
DI int rli(int v, int i) { return __builtin_amdgcn_readlane(v, i); }
DI int my_lane() { int l; asm volatile("v_mbcnt_lo_u32_b32 %0, -1, 0\n\tv_mbcnt_hi_u32_b32 %0, -1, %0" : "=v"(l)); return l; }
template <int O> DI int xshfl_i(int v) {
    if constexpr (O < 32) return __builtin_amdgcn_ds_swizzle(v, (O << 10) | 0x1f);
    else { const int l = my_lane(); return __builtin_amdgcn_ds_bpermute((l ^ 32) << 2, v); }
}
template <int O> DI float xshfl(float v) { return __builtin_bit_cast(float, xshfl_i<O>(__builtin_bit_cast(int, v))); }
DI float wave_sum(float v) { v += xshfl<1>(v); v += xshfl<2>(v); v += xshfl<4>(v); v += xshfl<8>(v); v += xshfl<16>(v); v += xshfl<32>(v); return v; }
DI float wave_max(float v) { v = fmaxf(v, xshfl<1>(v)); v = fmaxf(v, xshfl<2>(v)); v = fmaxf(v, xshfl<4>(v)); v = fmaxf(v, xshfl<8>(v)); v = fmaxf(v, xshfl<16>(v)); v = fmaxf(v, xshfl<32>(v)); return v; }
DI float sigmoidf_(float x) { return __builtin_amdgcn_rcpf(1.f + __builtin_amdgcn_exp2f(-1.4426950408889634f * x)); }
DI float gelu_tanh(float x) { const float u = 0.7978845608028654f * (x + 0.044715f * x * x * x); const float e = __expf(2.f * u); const float th = 1.f - 2.f * __builtin_amdgcn_rcpf(e + 1.f); return 0.5f * x * (1.f + th); }
DI float softplusf_(float x) { return fmaxf(x, 0.f) + log1pf(__expf(-fabsf(x))); }
#define LDS_WAIT() asm volatile("s_waitcnt lgkmcnt(0)" ::: "memory")
#define VM_WAIT() asm volatile("s_waitcnt vmcnt(0)" ::: "memory")

__device__ const unsigned char T5_BUCKET[128] = {
0,1,2,3,4,5,6,7,8,9,10,11,12,13,14,15,16,16,16,17,17,18,18,18,19,19,19,20,20,20,20,21,21,21,21,22,22,22,22,22,23,23,23,23,23,23,24,24,24,24,24,24,25,25,25,25,25,25,25,26,26,26,26,26,26,26,26,27,27,27,27,27,27,27,27,27,27,28,28,28,28,28,28,28,28,28,28,29,29,29,29,29,29,29,29,29,29,29,29,30,30,30,30,30,30,30,30,30,30,30,30,30,30,31,31,31,31,31,31,31,31,31,31,31,31,31,31,31};

#define XB_TMO      128
#define XB_XCNT(j)  (256  + 64 * (j))
#define XB_XSUB(j)  (1280 + 64 * (j))
#define XB_XGEN(j)  (2304 + 64 * (j))
#define XB_TOP      3328
#define XB_TOPGEN   3392
#define XCD_BAR_WORDS 3456
#define XB_SPIN_CAP (1u << 22)
DI unsigned xb_ld(unsigned* p)              { return __hip_atomic_load(p, __ATOMIC_RELAXED, __HIP_MEMORY_SCOPE_AGENT); }
DI unsigned xb_add(unsigned* p, unsigned v) { return __hip_atomic_fetch_add(p, v, __ATOMIC_RELAXED, __HIP_MEMORY_SCOPE_AGENT); }
DI unsigned xb_xcc_id() { return (unsigned)__builtin_amdgcn_s_getreg((3 << 11) | 20) & 0xFu; }
#define XB_SPIN(cond, bar) do { unsigned _sp = 0; while (cond) { __builtin_amdgcn_s_sleep(1); \
    if ((++_sp & 255u) == 0u) { if (xb_ld(&(bar)[XB_TMO])) break; if (_sp > XB_SPIN_CAP) { atomicAdd(&(bar)[XB_TMO], 1u); break; } } } } while (0)
struct XcdBarrier { unsigned* bar; unsigned x; volatile LAS unsigned* st; };
DI XcdBarrier xcd_barrier_post(unsigned* bar, volatile LAS unsigned* st, bool leader) {
    XcdBarrier b; b.bar = bar; b.x = xb_xcc_id(); b.st = st;
    if (leader) (void)xb_add(&bar[XB_XCNT(b.x)], 1u);
    return b;
}
DI void xcd_barrier_complete(unsigned* bar, unsigned x, unsigned& nloc, unsigned& nx) {
    const unsigned G = gridDim.x * gridDim.y * gridDim.z;
    unsigned sum, cnt, mine, sp = 0u;
    for (;;) {
        sum = 0u; cnt = 0u; mine = 0u;
#pragma unroll
        for (unsigned j = 0; j < 16; ++j) { const unsigned c = xb_ld(&bar[XB_XCNT(j)]); sum += c; cnt += (c > 0u) ? 1u : 0u; mine = (j == x) ? c : mine; }
        if (sum == G) break;
        __builtin_amdgcn_s_sleep(1);
        if ((++sp & 255u) == 0u) { if (xb_ld(&bar[XB_TMO])) break; if (sp > XB_SPIN_CAP) { atomicAdd(&bar[XB_TMO], 1u); break; } }
    }
    nloc = mine > 0u ? mine : 1u; nx = cnt > 0u ? cnt : 1u;
}
DI void xcd_barrier(const XcdBarrier& b, bool leader) {
    asm volatile("s_waitcnt vmcnt(0)" ::: "memory");
    __syncthreads();
    if (leader) {
        unsigned* bar = b.bar;
        __builtin_amdgcn_s_waitcnt(0);
        unsigned nloc = b.st[0], nx = b.st[1];
        if (nloc == 0u) { xcd_barrier_complete(bar, b.x, nloc, nx); b.st[0] = nloc; b.st[1] = nx; }
        const unsigned old = xb_add(&bar[XB_XSUB(b.x)], 1u);
        const unsigned gen = old / nloc;
        if (old + 1u == (gen + 1u) * nloc) {
            __builtin_amdgcn_fence(__ATOMIC_RELEASE, "agent");
            asm volatile("s_waitcnt vmcnt(0)" ::: "memory");
            const unsigned og = xb_add(&bar[XB_TOP], 1u);
            const unsigned tg = og / nx;
            if (og + 1u == (tg + 1u) * nx) xb_add(&bar[XB_TOPGEN], 1u);
            else XB_SPIN(xb_ld(&bar[XB_TOPGEN]) == tg, bar);
            __builtin_amdgcn_fence(__ATOMIC_ACQUIRE, "agent");
            xb_add(&bar[XB_XGEN(b.x)], 1u);
            asm volatile("s_waitcnt vmcnt(0)" ::: "memory");
        } else {
            XB_SPIN(xb_ld(&bar[XB_XGEN(b.x)]) == gen, bar);
            __builtin_amdgcn_fence(__ATOMIC_ACQUIRE, "agent");
            asm volatile("s_waitcnt vmcnt(0)" ::: "memory");
        }
    }
    __syncthreads();
}

namespace pg8 {
constexpr int BM = 256, BK = 64, HALF = 128, HTB = HALF * BK * 2;
__host__ __device__ __forceinline__ int lds_byte(int r, int c) { const int st = (r >> 4) * 2 + (c >> 5), rr = r & 15, cc = c & 31, ob = rr * 64 + cc * 2; return st * 1024 + (ob ^ (((ob >> 9) & 1) << 5)); }
__host__ __device__ __forceinline__ void stage_rc(int b, int& R, int& C) { const int st = b / 1024, sb = b % 1024, swz = sb ^ (((sb >> 9) & 1) << 5); R = (st >> 1) * 16 + swz / 64; C = (st & 1) * 32 + (swz % 64) / 2; }
__host__ __device__ __forceinline__ int perm32(int rho) { const int n = rho >> 4, i = rho & 15; return 8 * (i >> 2) + 4 * n + (i & 3); }
struct Unit { const char* a; const char* b; int pm, pn, aux, pad; };
struct Gemm { int K, lda, ldb, kstepA, hstepA; };
template <bool I8> struct AccT { typedef f32x4 type; };
template <> struct AccT<true> { typedef i32x4 type; };
template <class Epi, class Sched, bool GATHER = false, bool I8 = false>
DI void gemm_phase(LAS unsigned char* lds, const Gemm g, const Sched& S, const Epi& E, int tid_in) {
    int tid = tid_in; asm volatile("" : "+v"(tid));
    const int wid = __builtin_amdgcn_readfirstlane(tid >> 6), lane = tid & 63, wr = wid >> 2, wc = wid & 3, fr = lane & 15, fq = lane >> 4;
    const int K = g.K, nt = K / BK;
    unsigned voffA[2], voffB[2];
#pragma unroll
    for (int i = 0; i < 2; ++i) { int R, C; stage_rc(tid * 16 + i * 8192, R, C); const int Rb = (R & ~31) + perm32(R & 31);
        voffA[i] = (unsigned)(R * g.lda + C) * 2u; voffB[i] = (unsigned)(Rb * g.ldb + C) * 2u; }
    const size_t kstep = (size_t)(BK * 2), kstepA = (size_t)g.kstepA;
    const size_t hstepA = g.hstepA < 0 ? (size_t)HALF * g.lda * 2 : (size_t)g.hstepA, hstepB = (size_t)HALF * g.ldb * 2;
    const unsigned hstepA32 = (unsigned)hstepA;
    unsigned gC[2][2] = {{0u, 0u}, {0u, 0u}}, gN[2][2] = {{0u, 0u}, {0u, 0u}};
    const unsigned ldsw = (unsigned)wid * 1024u;
    const int aoff = lds_byte(wr * 64 + fr, fq * 8), boff = lds_byte(wc * 32 + fr, fq * 8);
#define PG8_SA(b, h) (((b) * 2 + (h)) * HTB)
#define PG8_SB(b, h) ((4 + (b) * 2 + (h)) * HTB)
#define PG8_STAGE(bufoff, gbase, voff) do { _Pragma("unroll") for (int _i = 0; _i < 2; ++_i) \
        __builtin_amdgcn_global_load_lds((const unsigned*)((const char*)(gbase) + (voff)[_i]), (LAS unsigned*)(lds + (bufoff) + ldsw + _i * 8192), 16, 0, 0); } while (0)
#define PG8_STAGEA(bufoff, gbase, h, nextsel) do { _Pragma("unroll") for (int _i = 0; _i < 2; ++_i) { \
        const unsigned _o = GATHER ? ((nextsel) ? gN[h][_i] : gC[h][_i]) : (voffA[_i] + (unsigned)(h) * hstepA32); \
        __builtin_amdgcn_global_load_lds((const unsigned*)((const char*)(gbase) + _o), (LAS unsigned*)(lds + (bufoff) + ldsw + _i * 8192), 16, 0, 0); } } while (0)
#define PG8_LDA(dst, b, h) do { _Pragma("unroll") for (int m = 0; m < 4; ++m) _Pragma("unroll") for (int k = 0; k < 2; ++k) dst[m][k] = *(const LAS bf16x8*)(lds + PG8_SA(b, h) + aoff + m * 2048 + k * 1024); } while (0)
#define PG8_LDB(dst, b, h) do { _Pragma("unroll") for (int n = 0; n < 2; ++n) _Pragma("unroll") for (int k = 0; k < 2; ++k) dst[n][k] = *(const LAS bf16x8*)(lds + PG8_SB(b, h) + boff + n * 2048 + k * 1024); } while (0)
#define PG8_MMA(ai, bj, At, Bt) do { __builtin_amdgcn_s_setprio(1); _Pragma("unroll") for (int m = 0; m < 4; ++m) _Pragma("unroll") for (int n = 0; n < 2; ++n) _Pragma("unroll") for (int k = 0; k < 2; ++k) \
        { if constexpr (I8) acc[ai][bj][m][n] = __builtin_amdgcn_mfma_i32_16x16x64_i8(__builtin_bit_cast(i32x4, Bt[n][k]), __builtin_bit_cast(i32x4, At[m][k]), acc[ai][bj][m][n], 0, 0, 0); \
          else acc[ai][bj][m][n] = __builtin_amdgcn_mfma_f32_16x16x32_bf16(Bt[n][k], At[m][k], acc[ai][bj][m][n], 0, 0, 0); } __builtin_amdgcn_s_setprio(0); } while (0)
#define PG8_WAIT_V(n) asm volatile("s_waitcnt vmcnt(" #n ")" ::: "memory")
#define PG8_WAIT_L(n) asm volatile("s_waitcnt lgkmcnt(" #n ")" ::: "memory")
#define PG8_BAR __builtin_amdgcn_s_barrier()
#define PG8_SCHED __builtin_amdgcn_sched_barrier(0)
    Unit cur, nxt; int ui = 0;
    if (!S.next(0, cur)) return;
    typedef typename AccT<I8>::type ACC;
    ACC acc[2][2][4][2];
#pragma unroll
    for (int a = 0; a < 2; ++a)
#pragma unroll
        for (int b = 0; b < 2; ++b)
#pragma unroll
            for (int m = 0; m < 4; ++m)
#pragma unroll
                for (int n = 0; n < 2; ++n) acc[a][b][m][n] = (ACC){0, 0, 0, 0};
    bf16x8 At[4][2], B0[2][2], B1[2][2];
    const char* cA = cur.a; const char* cB = cur.b;
    if constexpr (GATHER) S.rows(cur, tid, gC);
    PG8_STAGE(PG8_SB(0, 0), cB, voffB); PG8_STAGE(PG8_SB(0, 1), cB + hstepB, voffB); PG8_STAGEA(PG8_SA(0, 0), cA, 0, false); PG8_STAGEA(PG8_SA(0, 1), cA, 1, false);
    if (wr == 1) PG8_BAR;
    PG8_WAIT_V(2); PG8_BAR;
    PG8_STAGE(PG8_SB(1, 0), cB + kstep, voffB); PG8_STAGEA(PG8_SA(1, 0), cA + kstepA, 0, false); PG8_STAGE(PG8_SB(1, 1), cB + hstepB + kstep, voffB);
    PG8_WAIT_V(6); PG8_BAR;
    for (;;) {
        const bool has_next = S.next(ui + 1, nxt);
        const char* nA = has_next ? nxt.a : cA; const char* nB = has_next ? nxt.b : cB;
        if constexpr (GATHER) { if (has_next) S.rows(nxt, tid, gN); else {
#pragma unroll
            for (int h = 0; h < 2; ++h) { gN[h][0] = gC[h][0]; gN[h][1] = gC[h][1]; } } }
        for (int t = 0; t < nt; t += 2) {
            const bool last = (t == nt - 2);
            const char* a1 = cA + (size_t)(t + 1) * kstepA;
            const char* a2 = last ? nA : cA + (size_t)(t + 2) * kstepA; const char* b2 = last ? nB : cB + (size_t)(t + 2) * kstep;
            const char* a3 = a2 + kstepA; const char* b3 = b2 + kstep;
            PG8_LDB(B0, 0, 0); PG8_LDB(B1, 0, 1); PG8_SCHED; PG8_LDA(At, 0, 0); PG8_STAGEA(PG8_SA(1, 1), a1, 1, false);
            PG8_WAIT_V(8); PG8_WAIT_L(0); PG8_BAR; PG8_MMA(0, 0, At, B0); PG8_MMA(0, 1, At, B1); PG8_BAR; PG8_SCHED;
            PG8_LDA(At, 0, 1); PG8_STAGE(PG8_SB(0, 0), b2, voffB); PG8_STAGE(PG8_SB(0, 1), b2 + hstepB, voffB); PG8_STAGEA(PG8_SA(0, 0), a2, 0, last);
            PG8_WAIT_V(8); PG8_WAIT_L(0); PG8_BAR; PG8_MMA(1, 0, At, B0); PG8_MMA(1, 1, At, B1); PG8_BAR; PG8_SCHED;
            PG8_LDB(B0, 1, 0); PG8_LDB(B1, 1, 1); PG8_SCHED; PG8_LDA(At, 1, 0); PG8_STAGEA(PG8_SA(0, 1), a2, 1, last);
            PG8_WAIT_V(8); PG8_WAIT_L(0); PG8_BAR; PG8_MMA(0, 0, At, B0); PG8_MMA(0, 1, At, B1); PG8_BAR; PG8_SCHED;
            PG8_LDA(At, 1, 1); PG8_STAGE(PG8_SB(1, 0), b3, voffB); PG8_STAGE(PG8_SB(1, 1), b3 + hstepB, voffB); PG8_STAGEA(PG8_SA(1, 0), a3, 0, last);
            PG8_WAIT_V(8); PG8_WAIT_L(0); PG8_BAR; PG8_MMA(1, 0, At, B0); PG8_MMA(1, 1, At, B1); PG8_BAR; PG8_SCHED;
        }
        if (wr == 0) PG8_BAR;
        { const int el = my_lane(); E(acc, cur, wr, wc, el & 15, el >> 4); }
        if (!has_next) break;
        bool carried = false;
        if constexpr (Epi::CARRY) { if (nxt.aux != 0) { const int el = my_lane(); E.carry(acc, nxt, wr, wc, el & 15, el >> 4); carried = true; } }
        if (!carried) {
#pragma unroll
        for (int a = 0; a < 2; ++a)
#pragma unroll
            for (int b = 0; b < 2; ++b)
#pragma unroll
                for (int m = 0; m < 4; ++m)
#pragma unroll
                    for (int n = 0; n < 2; ++n) acc[a][b][m][n] = (ACC){0, 0, 0, 0};
        }
        cur = nxt; cA = nA; cB = nB; ++ui;
        if constexpr (GATHER) {
#pragma unroll
            for (int h = 0; h < 2; ++h) { gC[h][0] = gN[h][0]; gC[h][1] = gN[h][1]; } }
        if (wr == 1) PG8_BAR;
    }
    PG8_WAIT_V(0);
    PG8_BAR;
#undef PG8_SA
#undef PG8_SB
#undef PG8_STAGE
#undef PG8_STAGEA
#undef PG8_LDA
#undef PG8_LDB
#undef PG8_MMA
#undef PG8_WAIT_V
#undef PG8_WAIT_L
#undef PG8_BAR
#undef PG8_SCHED
}
}
using pg8::Unit;

DI unsigned cvt_pk_bf16(float lo, float hi) { unsigned r; asm volatile("s_nop 1\n\tv_cvt_pk_bf16_f32 %0, %1, %2" : "=v"(r) : "v"(lo), "v"(hi)); return r; }
DI u32x4 pack8(const f32x4& v0, const f32x4& v1) { u32x4 w; w.x = cvt_pk_bf16(v0[0], v0[1]); w.y = cvt_pk_bf16(v0[2], v0[3]); w.z = cvt_pk_bf16(v1[0], v1[1]); w.w = cvt_pk_bf16(v1[2], v1[3]); return w; }

struct SchedP1 {
    const char* A; const char* B; int nM, nN, rbA, rbB, G, c;
    DI bool next(int i, Unit& u) const {
        constexpr int NXCD = 8, WGM = 8; const int nwg = nM * nN;
        const long L = (long)i * G + c; if (L >= nwg) return false;
        int wgid = (int)L; { const int q = nwg / NXCD, r = nwg % NXCD, xcd = wgid % NXCD, off = wgid / NXCD; wgid = (xcd < r ? xcd * (q + 1) : r * (q + 1) + (xcd - r) * q) + off; }
        const int nig = WGM * nN, gid = wgid / nig, fm = gid * WGM, gsz = (nM - fm) < WGM ? (nM - fm) : WGM;
        u.pm = fm + ((wgid % nig) % gsz); u.pn = (wgid % nig) / gsz; u.aux = 0; u.pad = 0;
        u.a = A + (size_t)u.pm * 256 * rbA; u.b = B + (size_t)u.pn * 256 * rbB; return true;
    }
};
struct SchedP3a {
    const char* ys; const char* wbr; int G, c;
    DI bool next(int i, Unit& u) const {
        const int tile = (i >> 2) * G + c; if (tile >= 512) return false;
        const int br = i & 3; u.pm = tile >> 2; u.pn = tile & 3; u.aux = br; u.pad = 0;
        u.a = ys + ((size_t)u.pm * 256 * 1024 + br * 256) * 2; u.b = wbr + ((size_t)br * 1024 * 256 + (size_t)u.pn * 256 * 256) * 2; return true;
    }
};
struct SchedP3b {
    const char* A; const char* B; int G, c;
    DI bool next(int i, Unit& u) const {
        const int L = i * G + c; if (L >= 512) return false;
        u.pm = L >> 2; u.pn = L & 3; u.aux = 0; u.pad = 0;
        u.a = A + (size_t)u.pm * 256 * 1024 * 2; u.b = B + (size_t)u.pn * 256 * 1024 * 2; return true;
    }
};
struct SchedM2 {
    const char* xr; const char* wgu; const LAS int* offt; const int* rowsrc; int G, c;
    DI bool next(int i, Unit& u) const {
        const int NT = __builtin_amdgcn_readfirstlane(offt[32]) >> 8; const int L = i * G + c; if (L >= NT * 2) return false;
        const int rt = L >> 1, pn = L & 1; const int e = __builtin_amdgcn_readfirstlane(offt[40 + rt]);
        u.pm = rt; u.pn = pn; u.aux = e; u.pad = 0;
        u.a = xr; u.b = wgu + ((size_t)e * 512 + pn * 256) * 1024 * 2; return true;
    }
    DI void rows(const Unit& u, int tid, unsigned (&g)[2][2]) const {
#pragma unroll
        for (int i = 0; i < 2; ++i) { int R, C; pg8::stage_rc(tid * 16 + i * 8192, R, C);
#pragma unroll
            for (int h = 0; h < 2; ++h) g[h][i] = (unsigned)rowsrc[u.pm * 256 + h * 128 + R] * 4096u + (unsigned)C * 2u; }
    }
};
struct SchedM3 {
    const char* hmid; const char* wd; const LAS int* offt; int G, c;
    DI bool next(int i, Unit& u) const {
        const int NT = __builtin_amdgcn_readfirstlane(offt[32]) >> 8; const int L = i * G + c; if (L >= NT * 4) return false;
        const int rt = L >> 2, pn = L & 3; const int e = __builtin_amdgcn_readfirstlane(offt[40 + rt]);
        u.pm = rt; u.pn = pn; u.aux = e; u.pad = 0;
        u.a = hmid + (size_t)rt * 256 * 256 * 2; u.b = wd + ((size_t)e * 1024 + pn * 256) * 256 * 2; return true;
    }
};

struct EpiP1I8 {
    static constexpr bool CARRY = false;
    bf16* proj; unsigned char* gates; const float* bgate; const float* hsc; const float* wsc;
    DI void operator()(const i32x4 (&acc)[2][2][4][2], const Unit& u, int wr, int wc, int fr, int fq) const {
        const int row0 = u.pm * 256 + wr * 64 + fr;
        if (u.pn < 10) { const int colt = u.pn * 256 + wc * 32 + 8 * fq;
            f32x4 sv[2][2]; float rsv[2][4];
#pragma unroll
            for (int bj = 0; bj < 2; ++bj)
#pragma unroll
                for (int n = 0; n < 2; ++n) sv[bj][n] = *(const GAS f32x4*)((const GAS float*)wsc + colt + bj * 128 + 4 * n);
#pragma unroll
            for (int ai = 0; ai < 2; ++ai)
#pragma unroll
                for (int m = 0; m < 4; ++m) rsv[ai][m] = ((const GAS float*)hsc)[row0 + ai * 128 + m * 16];
#pragma unroll
            for (int ai = 0; ai < 2; ++ai)
#pragma unroll
                for (int m = 0; m < 4; ++m) { bf16* rowp = proj + (size_t)(row0 + ai * 128 + m * 16) * PLD + colt; const float rs = rsv[ai][m];
#pragma unroll
                    for (int bj = 0; bj < 2; ++bj) { f32x4 v0, v1;
#pragma unroll
                        for (int e = 0; e < 4; ++e) { v0[e] = (float)acc[ai][bj][m][0][e] * (rs * sv[bj][0][e]); v1[e] = (float)acc[ai][bj][m][1][e] * (rs * sv[bj][1][e]); }
                        *(u32x4*)(rowp + bj * 128) = pack8(v0, v1); } }
            return; }
        const int gcol = (u.pn - 10) * 256 + wc * 32 + 8 * fq; const float* wsc = this->wsc + 2560;
        f32x4 bv[2][2], sv[2][2];
#pragma unroll
        for (int bj = 0; bj < 2; ++bj)
#pragma unroll
            for (int n = 0; n < 2; ++n) { bv[bj][n] = *(const f32x4*)(bgate + gcol + bj * 128 + 4 * n); sv[bj][n] = *(const f32x4*)(wsc + gcol + bj * 128 + 4 * n); }
        float rsv[2][4];
#pragma unroll
        for (int ai = 0; ai < 2; ++ai)
#pragma unroll
            for (int m = 0; m < 4; ++m) rsv[ai][m] = ((const GAS float*)hsc)[row0 + ai * 128 + m * 16];
#pragma unroll
        for (int ai = 0; ai < 2; ++ai)
#pragma unroll
            for (int m = 0; m < 4; ++m) { const float rs = rsv[ai][m];
                unsigned char* rowp = gates + ((size_t)(u.pm * 16 + (u.pn - 10)) * 65536 + (size_t)((ai * 4 + m) * 8192 + (wr * 4 + wc) * 512 + (fq * 16 + fr) * 8));
#pragma unroll
                for (int bj = 0; bj < 2; ++bj) { unsigned q[8];
#pragma unroll
                    for (int n = 0; n < 2; ++n)
#pragma unroll
                        for (int e = 0; e < 4; ++e) { const float pre = (float)acc[ai][bj][m][n][e] * (rs * sv[bj][n][e]) + bv[bj][n][e];
                            q[4 * n + e] = (unsigned)fminf(256.f * sigmoidf_(pre), 255.5f); }
                    u32x2 w; w.x = q[0] | (q[1] << 8) | (q[2] << 16) | (q[3] << 24); w.y = q[4] | (q[5] << 8) | (q[6] << 16) | (q[7] << 24);
                    *(u32x2*)(rowp + bj * 4096) = w; }
                __builtin_amdgcn_sched_barrier(0); }
    }
};
struct EpiP3a {
    static constexpr bool CARRY = true;
    bf16* merged; const unsigned char* gates;
    DI void carry(f32x4 (&acc)[2][2][4][2], const Unit& u, int wr, int wc, int fr, int fq) const {
        const GAS unsigned char* gb = (const GAS unsigned char*)gates + (size_t)(u.pm * 16 + (u.aux - 1) * 4 + u.pn) * 65536;
        const unsigned go = (unsigned)((wr * 4 + wc) * 512 + (fq * 16 + fr) * 8);
        u32x2 gp[2][4][2], gn[2][4][2];
#pragma unroll
        for (int ai = 0; ai < 2; ++ai)
#pragma unroll
            for (int m = 0; m < 4; ++m)
#pragma unroll
                for (int bj = 0; bj < 2; ++bj) { gp[ai][m][bj] = *(const GAS u32x2*)(gb + go + (unsigned)(((ai * 4 + m) * 2 + bj) * 4096));
                    gn[ai][m][bj] = *(const GAS u32x2*)(gb + go + (unsigned)(((ai * 4 + m) * 2 + bj) * 4096 + 4 * 65536)); }
#pragma unroll
        for (int ai = 0; ai < 2; ++ai) {
#pragma unroll
            for (int m = 0; m < 4; ++m)
#pragma unroll
                for (int bj = 0; bj < 2; ++bj) {
#pragma unroll
                    for (int n = 0; n < 2; ++n) { const unsigned p4 = n ? gp[ai][m][bj].y : gp[ai][m][bj].x, n4 = n ? gn[ai][m][bj].y : gn[ai][m][bj].x;
#pragma unroll
                        for (int e = 0; e < 4; ++e) acc[ai][bj][m][n][e] *= ((float)((p4 >> (8 * e)) & 255u) + 0.5f) * __builtin_amdgcn_rcpf((float)((n4 >> (8 * e)) & 255u) + 0.5f); } }
            __builtin_amdgcn_sched_barrier(0); }
    }
    DI void operator()(const f32x4 (&acc)[2][2][4][2], const Unit& u, int wr, int wc, int fr, int fq) const {
        if (u.aux != 3) return;
        const GAS unsigned char* gb = (const GAS unsigned char*)gates + (size_t)(u.pm * 16 + 3 * 4 + u.pn) * 65536;
        GAS unsigned char* mb = (GAS unsigned char*)merged + ((size_t)(u.pm * 256) * 1024 + u.pn * 256) * 2;
        const unsigned go = (unsigned)((wr * 4 + wc) * 512 + (fq * 16 + fr) * 8), mo = (unsigned)((wr * 64 + fr) * 1024 + wc * 32 + 8 * fq) * 2u;
        u32x2 gw[2][4][2];
#pragma unroll
        for (int ai = 0; ai < 2; ++ai)
#pragma unroll
            for (int m = 0; m < 4; ++m)
#pragma unroll
                for (int bj = 0; bj < 2; ++bj) gw[ai][m][bj] = *(const GAS u32x2*)(gb + go + (unsigned)(((ai * 4 + m) * 2 + bj) * 4096));
#pragma unroll
        for (int ai = 0; ai < 2; ++ai) {
#pragma unroll
            for (int m = 0; m < 4; ++m)
#pragma unroll
                for (int bj = 0; bj < 2; ++bj) {
                    f32x4 v0 = acc[ai][bj][m][0], v1 = acc[ai][bj][m][1]; const u32x2 g2 = gw[ai][m][bj]; const float k256 = 0.00390625f;
#pragma unroll
                    for (int e = 0; e < 4; ++e) { v0[e] *= ((float)((g2.x >> (8 * e)) & 255u) + 0.5f) * k256; v1[e] *= ((float)((g2.y >> (8 * e)) & 255u) + 0.5f) * k256; }
                    *(GAS u32x4*)(mb + mo + (unsigned)((ai * 128 + m * 16) * 1024 + bj * 128) * 2u) = pack8(v0, v1); }
            __builtin_amdgcn_sched_barrier(0); }
    }
};
template <bool XF32> struct EpiP3b {
    static constexpr bool CARRY = false;
    const float* xin; bf16* xb_;
    DI void operator()(const f32x4 (&acc)[2][2][4][2], const Unit& u, int wr, int wc, int fr, int fq) const {
        GAS unsigned char* ob = (GAS unsigned char*)xb_ + ((size_t)(u.pm * 256) * 1024 + u.pn * 256) * 2;
        const unsigned lo = (unsigned)((wr * 64 + fr) * 1024 + wc * 32 + 8 * fq);
        if constexpr (XF32) {
            const GAS unsigned char* xb = (const GAS unsigned char*)xin + ((size_t)(u.pm * 256) * 1024 + u.pn * 256) * 4;
#pragma unroll
            for (int ai = 0; ai < 2; ++ai)
#pragma unroll
                for (int mh = 0; mh < 2; ++mh) {
                    f32x4 xv[2][2][2];
#pragma unroll
                    for (int m2 = 0; m2 < 2; ++m2)
#pragma unroll
                        for (int bj = 0; bj < 2; ++bj)
#pragma unroll
                            for (int n = 0; n < 2; ++n) xv[m2][bj][n] = *(const GAS f32x4*)(xb + (lo + (unsigned)((ai * 128 + (mh * 2 + m2) * 16) * 1024 + bj * 128 + 4 * n)) * 4u);
#pragma unroll
                    for (int m2 = 0; m2 < 2; ++m2)
#pragma unroll
                        for (int bj = 0; bj < 2; ++bj)
                            *(GAS u32x4*)(ob + (lo + (unsigned)((ai * 128 + (mh * 2 + m2) * 16) * 1024 + bj * 128)) * 2u) = pack8(xv[m2][bj][0] + acc[ai][bj][mh * 2 + m2][0], xv[m2][bj][1] + acc[ai][bj][mh * 2 + m2][1]);
                    __builtin_amdgcn_sched_barrier(0); }
        } else {
#pragma unroll
            for (int ai = 0; ai < 2; ++ai) {
                u32x4 xv[4][2];
#pragma unroll
                for (int m = 0; m < 4; ++m)
#pragma unroll
                    for (int bj = 0; bj < 2; ++bj) xv[m][bj] = *(const GAS u32x4*)(ob + (lo + (unsigned)((ai * 128 + m * 16) * 1024 + bj * 128)) * 2u);
#pragma unroll
                for (int m = 0; m < 4; ++m)
#pragma unroll
                    for (int bj = 0; bj < 2; ++bj) { const u32x4 x4 = xv[m][bj]; f32x4 v0 = acc[ai][bj][m][0], v1 = acc[ai][bj][m][1];
                        v0[0] += lo_bf(x4.x); v0[1] += hi_bf(x4.x); v0[2] += lo_bf(x4.y); v0[3] += hi_bf(x4.y); v1[0] += lo_bf(x4.z); v1[1] += hi_bf(x4.z); v1[2] += lo_bf(x4.w); v1[3] += hi_bf(x4.w);
                        *(GAS u32x4*)(ob + (lo + (unsigned)((ai * 128 + m * 16) * 1024 + bj * 128)) * 2u) = pack8(v0, v1); }
                __builtin_amdgcn_sched_barrier(0); }
        }
    }
};
struct EpiM2 {
    static constexpr bool CARRY = false;
    bf16* hmid;
    DI void operator()(const f32x4 (&acc)[2][2][4][2], const Unit& u, int wr, int wc, int fr, int fq) const {
        const int row0 = u.pm * 256 + wr * 64 + fr; const int col = u.pn * 128 + wc * 32 + 8 * fq;
#pragma unroll
        for (int ai = 0; ai < 2; ++ai)
#pragma unroll
            for (int m = 0; m < 4; ++m) { f32x4 h0, h1;
#pragma unroll
                for (int e = 0; e < 4; ++e) { const float g0 = acc[ai][0][m][0][e], g1 = acc[ai][0][m][1][e];
                    h0[e] = g0 * sigmoidf_(g0) * acc[ai][1][m][0][e]; h1[e] = g1 * sigmoidf_(g1) * acc[ai][1][m][1][e]; }
                *(u32x4*)(hmid + (size_t)(row0 + ai * 128 + m * 16) * 256 + col) = pack8(h0, h1); }
    }
};
struct EpiM3 {
    static constexpr bool CARRY = false;
    bf16* eo; const int* rowtok; const float* roww;
    DI void operator()(const f32x4 (&acc)[2][2][4][2], const Unit& u, int wr, int wc, int fr, int fq) const {
        const int row0 = u.pm * 256 + wr * 64 + fr; const int colt = u.pn * 256 + wc * 32 + 8 * fq;
        int tk[2][4]; float wv[2][4];
#pragma unroll
        for (int ai = 0; ai < 2; ++ai)
#pragma unroll
            for (int m = 0; m < 4; ++m) { tk[ai][m] = ((const GAS int*)rowtok)[row0 + ai * 128 + m * 16]; wv[ai][m] = ((const GAS float*)roww)[row0 + ai * 128 + m * 16]; }
#pragma unroll
        for (int ai = 0; ai < 2; ++ai)
#pragma unroll
            for (int m = 0; m < 4; ++m) {
                if (tk[ai][m] >= 0) { const float w = wv[ai][m]; GAS bf16* op = (GAS bf16*)eo + (size_t)tk[ai][m] * 1024 + colt;
#pragma unroll
                    for (int bj = 0; bj < 2; ++bj) *(GAS u32x4*)(op + bj * 128) = pack8(acc[ai][bj][m][0] * w, acc[ai][bj][m][1] * w); }
                __builtin_amdgcn_sched_barrier(0); }
    }
};

struct Args { const float* in[36]; float* out; unsigned char* ws; int ph_lo, ph_hi; };
struct InTab { unsigned base;
    DI const float* operator[](int i) const { unsigned long long v; const unsigned addr = base + (unsigned)i * 8u;
        asm volatile("ds_read_b64 %0, %1\n\ts_waitcnt lgkmcnt(0)" : "=v"(v) : "v"(addr) : "memory");
        const unsigned lo = __builtin_amdgcn_readfirstlane((unsigned)v), hi = __builtin_amdgcn_readfirstlane((unsigned)(v >> 32));
        return (const float*)(((unsigned long long)hi << 32) | lo); } };
struct KA { InTab in; float* out; unsigned char* ws; };

DI void transpose_item(const float* W_, int ldw, int nvalid, bf16* WT_, int ldt, int k0, int n0, int dst_row0, LAS float* scr, int lane) {
    const GAS float* W = (const GAS float*)W_; GAS bf16* WT = (GAS bf16*)WT_;
    const int nq = 4 * (lane & 7), kr8 = lane >> 3;
    f32x4 v[8];
#pragma unroll
    for (int i = 0; i < 8; ++i) { const int kk = 8 * i + kr8;
        if (n0 + nq + 3 < nvalid) v[i] = *(const GAS f32x4*)(W + (size_t)(k0 + kk) * ldw + n0 + nq);
        else {
#pragma unroll
            for (int e = 0; e < 4; ++e) v[i][e] = (n0 + nq + e < nvalid) ? W[(size_t)(k0 + kk) * ldw + n0 + nq + e] : 0.f; } }
#pragma unroll
    for (int i = 0; i < 8; ++i) { const int kk = 8 * i + kr8;
#pragma unroll
        for (int e = 0; e < 4; ++e) scr[kk * 33 + nq + e] = v[i][e]; }
    LDS_WAIT(); asm volatile("" ::: "memory");
    const int c = lane & 7;
#pragma unroll
    for (int j = 0; j < 4; ++j) { const int n = (lane >> 3) + 8 * j; const LAS float* s = scr + (8 * c) * 33 + n;
        u32x4 o; o.x = pk2(s[0 * 33], s[1 * 33]); o.y = pk2(s[2 * 33], s[3 * 33]); o.z = pk2(s[4 * 33], s[5 * 33]); o.w = pk2(s[6 * 33], s[7 * 33]);
        if (n0 + n < nvalid) *(GAS u32x4*)(WT + (size_t)(dst_row0 + n) * ldt + k0 + 8 * c) = o; }
    LDS_WAIT(); asm volatile("" ::: "memory");
}
DI void phase0_weights(const KA& a, int l, LAS unsigned char* lds, int gw, int NGW, int wave, int lane) {
    LAS float* scr = (LAS float*)(lds + wave * 16384);
    const float* w_in = a.in[4] + (size_t)l * 1024 * NIN;
    const float* w_gate = a.in[24] + (size_t)l * 4 * 1024 * 1024;
    const float* w_br = a.in[26] + (size_t)l * 4 * 256 * 1024;
    const float* w_out = a.in[27] + (size_t)l * 1024 * 1024;
    bf16* Wt_in = (bf16*)(a.ws + WS_WIN); bf16* Wt_br = (bf16*)(a.ws + WS_WBR); bf16* Wt_out = (bf16*)(a.ws + WS_WOUT);
    constexpr int I_B = 4 * 4 * 32, I_O = 16 * 32, NIT = I_B + I_O;
    (void)w_gate; (void)w_in; (void)Wt_in;
    for (int it = gw; it < NIT; it += NGW) {
        int r = it;
        if (r < I_B) { const int br = r / 128, q = r % 128, kb = q / 32, nb = q % 32; transpose_item(w_br + (size_t)br * 256 * 1024, 1024, 1024, Wt_br + (size_t)br * 1024 * 256, 256, kb * 64, nb * 32, nb * 32, scr, lane); continue; } r -= I_B;
        { const int kb = r / 32, nb = r % 32; transpose_item(w_out, 1024, 1024, Wt_out, 1024, kb * 64, nb * 32, nb * 32, scr, lane); }
    }
}
DI void p1_weights_i8(const KA& a, int l, LAS unsigned char* lds, int gw, int NGW, int wave, int lane) {
    LAS float* scr = (LAS float*)(lds + wave * 16384);
    const GAS float* wgt = (const GAS float*)(a.in[24] + (size_t)l * 4 * 1024 * 1024); const GAS float* win = (const GAS float*)(a.in[4] + (size_t)l * 1024 * NIN);
    GAS unsigned char* Wq = (GAS unsigned char*)(a.ws + WS_WQ); GAS float* wsc = (GAS float*)(a.ws + WS_WSC);
    const int nq = 4 * (lane & 7), kr8 = lane >> 3;
    for (int it = NGW - 1 - gw; it < 128 + 77; it += NGW) {
        const bool isg = it < 128; const int br = it >> 5; const int n0 = isg ? (it & 31) * 32 : (it - 128) * 32;
        const int ldw = isg ? 1024 : NIN; const int nval = isg ? 1024 : NIN; const int drow0 = isg ? 2560 + br * 1024 + n0 : n0;
        const bool lok = (n0 + nq) < nval;
        const GAS float* W = (isg ? wgt + (size_t)br * 1024 * 1024 : win) + n0 + nq;
        f32x4 mx = {0.f, 0.f, 0.f, 0.f};
#pragma unroll 8
        for (int i = 0; i < 128; ++i) { f32x4 v = {0.f, 0.f, 0.f, 0.f}; if (lok) v = *(const GAS f32x4*)(W + (size_t)(8 * i + kr8) * ldw);
            mx[0] = fmaxf(mx[0], fabsf(v[0])); mx[1] = fmaxf(mx[1], fabsf(v[1])); mx[2] = fmaxf(mx[2], fabsf(v[2])); mx[3] = fmaxf(mx[3], fabsf(v[3])); }
#pragma unroll
        for (int e = 0; e < 4; ++e) { float m = mx[e]; m = fmaxf(m, xshfl<8>(m)); m = fmaxf(m, xshfl<16>(m)); m = fmaxf(m, xshfl<32>(m)); mx[e] = fmaxf(m, 1e-20f); }
        if (kr8 == 0 && lok) *(GAS f32x4*)(wsc + drow0 + nq) = mx * (1.f / 127.f);
        const f32x4 qs = {127.f / mx[0], 127.f / mx[1], 127.f / mx[2], 127.f / mx[3]};
#pragma unroll 1
        for (int kb = 0; kb < 16; ++kb) {
            f32x4 v[8];
#pragma unroll
            for (int i = 0; i < 8; ++i) { v[i] = (f32x4){0.f, 0.f, 0.f, 0.f}; if (lok) v[i] = *(const GAS f32x4*)(W + (size_t)(kb * 64 + 8 * i + kr8) * ldw); }
#pragma unroll
            for (int i = 0; i < 8; ++i) { const int kk = 8 * i + kr8;
#pragma unroll
                for (int e = 0; e < 4; ++e) scr[kk * 33 + nq + e] = __builtin_rintf(v[i][e] * qs[e]); }
            LDS_WAIT(); asm volatile("" ::: "memory");
            const int n = lane >> 1, kh = lane & 1; u32x4 o[2];
#pragma unroll
            for (int h2 = 0; h2 < 2; ++h2) { unsigned w4[4];
#pragma unroll
                for (int d = 0; d < 4; ++d) { unsigned wv = 0u;
#pragma unroll
                    for (int e = 0; e < 4; ++e) wv |= ((unsigned)(int)scr[(32 * kh + 16 * h2 + 4 * d + e) * 33 + n] & 255u) << (8 * e);
                    w4[d] = wv; }
                o[h2].x = w4[0]; o[h2].y = w4[1]; o[h2].z = w4[2]; o[h2].w = w4[3]; }
            if (n0 + n < nval) { GAS unsigned char* dst = Wq + (size_t)(drow0 + n) * 1024 + kb * 64 + 32 * kh; *(GAS u32x4*)dst = o[0]; *(GAS u32x4*)(dst + 16) = o[1]; }
            LDS_WAIT(); asm volatile("" ::: "memory");
        }
    }
}

DI void router_weights(const KA& a, int l, int gw, int NGW, int lane) {
    bf16* Wr = (bf16*)(a.ws + WS_WR);
    const float* wg = a.in[29] + (size_t)l * 1024 * 4; const float* we = a.in[31] + (size_t)l * 1024 * 32;
    for (int n = gw; n < 36; n += NGW) {
        for (int i = 0; i < 16; ++i) { const int k = lane + 64 * i; const float w = (n < 4) ? wg[k * 4 + n] : we[k * 32 + (n - 4)];
            const unsigned hi = f2bf(w); const float hf = __builtin_bit_cast(float, hi << 16); const unsigned lo = f2bf(w - hf);
            Wr[(size_t)n * 2048 + k] = (bf16)hi; Wr[(size_t)n * 2048 + 1024 + k] = (bf16)hi; Wr[(size_t)(64 + n) * 2048 + k] = (bf16)lo; Wr[(size_t)(64 + n) * 2048 + 1024 + k] = 0; }
    }
}

DI void cmp_weights(const KA& a, int l, LAS unsigned char* lds, int gw, int NGW, int wave, int lane) {
    LAS float* scr = (LAS float*)(lds + wave * 16384);
    bf16* Wc = (bf16*)(a.ws + WS_WCMP); float* pt = (float*)(a.ws + WS_CMPAB + 2 * MiB);
    for (int it = gw; it < 128 + 64; it += NGW) {
        if (it < 128) { const int kv = it >> 6, q = it & 63, kb = q >> 1, nb = q & 1; const float* w1 = a.in[kv ? 22 : 19] + (size_t)l * 2048 * 64;
            bf16* dst = Wc + (size_t)kv * 256 * 1024 - (kb >= 16 ? 1024 : 0);
            transpose_item(w1, 64, 64, dst, 1024, kb * 64, nb * 32, (kb >= 16 ? 64 : 0) + nb * 32, scr, lane);
        } else { const int kv = (it - 128) >> 5, part = (it - 128) & 31;
            const GAS float* w1 = (const GAS float*)(a.in[kv ? 22 : 19] + (size_t)l * 2048 * 64) + (size_t)part * 64 * 64; const GAS float* pos = (const GAS float*)(a.in[kv ? 21 : 18] + (size_t)l * 2048) + part * 64;
            float acc = 0.f;
#pragma unroll 16
            for (int k = 0; k < 64; ++k) acc += pos[k] * w1[(size_t)k * 64 + lane];
            pt[(kv * 32 + part) * 64 + lane] = acc; }
    }
}

DI void lru_weights(const KA& a, int l, int gw, int NGW, int lane) {
    bf16* W = (bf16*)(a.ws + WS_LRUW); const float* wa = a.in[7] + (size_t)l * 4 * 4096; const float* wx = a.in[9] + (size_t)l * 4 * 4096;
    (void)NGW; { const int idx = gw * 64 + lane; if (idx < 32768) { const int i = idx & 63, j = (idx >> 6) & 63, mat = (idx >> 12) & 1, hbk = idx >> 13;
        W[idx] = (bf16)f2bf((mat ? wx : wa)[(size_t)hbk * 4096 + i * 64 + j]); } }
}
DI void phase0_rows(const KA& a, int l, int mode, int gw, int NGW, int lane) {
    const GAS float* xin = (const GAS float*)a.in[0]; GAS bf16* xb = (GAS bf16*)(a.ws + WS_XB);
    const GAS bf16* eo = (const GAS bf16*)(a.ws + WS_PROJ);
    GAS float* outp = (GAS float*)a.out;
    const GAS float* g = (const GAS float*)(mode ? a.in[2] : (a.in[3] + (size_t)l * 1024));
    f32x4 gv[4];
#pragma unroll
    for (int j = 0; j < 4; ++j) gv[j] = *(const GAS f32x4*)(g + 4 * (lane + 64 * j));
    for (int m0 = gw * 4; m0 < T; m0 += NGW * 4) {
        f32x4 v[4][4]; float ss[4];
#pragma unroll
        for (int rr = 0; rr < 4; ++rr)
#pragma unroll
            for (int j = 0; j < 4; ++j) { if (l == 0) v[rr][j] = *(const GAS f32x4*)(xin + (size_t)(m0 + rr) * 1024 + 4 * (lane + 64 * j));
                else { const u32x2 xw = *(const GAS u32x2*)(xb + (size_t)(m0 + rr) * 1024 + 4 * (lane + 64 * j)); v[rr][j][0] = lo_bf(xw.x); v[rr][j][1] = hi_bf(xw.x); v[rr][j][2] = lo_bf(xw.y); v[rr][j][3] = hi_bf(xw.y); } }
        if (l > 0) {
#pragma unroll
            for (int rr = 0; rr < 4; ++rr)
#pragma unroll
                for (int j = 0; j < 4; ++j) {
                    const u32x2 e0 = *(const GAS u32x2*)(eo + (size_t)(2 * (m0 + rr)) * 1024 + 4 * (lane + 64 * j));
                    const u32x2 e1 = *(const GAS u32x2*)(eo + (size_t)(2 * (m0 + rr) + 1) * 1024 + 4 * (lane + 64 * j));
                    v[rr][j][0] += lo_bf(e0.x) + lo_bf(e1.x); v[rr][j][1] += hi_bf(e0.x) + hi_bf(e1.x); v[rr][j][2] += lo_bf(e0.y) + lo_bf(e1.y); v[rr][j][3] += hi_bf(e0.y) + hi_bf(e1.y); } }
#pragma unroll
        for (int rr = 0; rr < 4; ++rr) { float t = 0.f;
#pragma unroll
            for (int j = 0; j < 4; ++j) t += (v[rr][j][0] * v[rr][j][0] + v[rr][j][1] * v[rr][j][1]) + (v[rr][j][2] * v[rr][j][2] + v[rr][j][3] * v[rr][j][3]);
            ss[rr] = t; }
#pragma unroll
        for (int rr = 0; rr < 4; ++rr) ss[rr] = wave_sum(ss[rr]);
        if (mode) {
#pragma unroll
            for (int rr = 0; rr < 4; ++rr) { const float r = 1.f / sqrtf(ss[rr] * (1.f / 1024.f) + 1e-6f); const size_t m = (size_t)(m0 + rr);
#pragma unroll
                for (int j = 0; j < 4; ++j) *(GAS f32x4*)(outp + m * 1024 + 4 * (lane + 64 * j)) = v[rr][j] * r * gv[j]; }
        } else {
            GAS unsigned char* hq = (GAS unsigned char*)(a.ws + WS_HQ); GAS float* hsc = (GAS float*)(a.ws + WS_HSC);
            float am[4];
#pragma unroll
            for (int rr = 0; rr < 4; ++rr) { const float r = 1.f / sqrtf(ss[rr] * (1.f / 1024.f) + 1e-6f); const size_t m = (size_t)(m0 + rr); float t = 0.f;
#pragma unroll
                for (int j = 0; j < 4; ++j) { if (l > 0) { u32x2 w; w.x = pk2(v[rr][j][0], v[rr][j][1]); w.y = pk2(v[rr][j][2], v[rr][j][3]); *(GAS u32x2*)(xb + m * 1024 + 4 * (lane + 64 * j)) = w; }
                    const f32x4 y = v[rr][j] * r * gv[j]; v[rr][j] = y;
                    t = fmaxf(t, fmaxf(fmaxf(fabsf(y[0]), fabsf(y[1])), fmaxf(fabsf(y[2]), fabsf(y[3])))); }
                am[rr] = t; }
#pragma unroll
            for (int rr = 0; rr < 4; ++rr) am[rr] = fmaxf(wave_max(am[rr]), 1e-20f);
#pragma unroll
            for (int rr = 0; rr < 4; ++rr) { const size_t m = (size_t)(m0 + rr); const float qs = 127.f / am[rr];
                if (lane == 0) hsc[m] = am[rr] * (1.f / 127.f);
#pragma unroll
                for (int j = 0; j < 4; ++j) { const f32x4 y = v[rr][j] * qs;
                    const unsigned q = ((unsigned)(int)__builtin_rintf(y[0]) & 255u) | (((unsigned)(int)__builtin_rintf(y[1]) & 255u) << 8) | (((unsigned)(int)__builtin_rintf(y[2]) & 255u) << 16) | (((unsigned)(int)__builtin_rintf(y[3]) & 255u) << 24);
                    *(GAS unsigned*)(hq + m * 1024 + 4 * (lane + 64 * j)) = q; } }
        }
    }
}

DI int crow(int i, int hh) { return (i & 3) + 8 * (i >> 2) + 4 * hh; }
DI unsigned cvtpk(float lo, float hi) { f32x2 v = {lo, hi}; bf16x2_t b = __builtin_convertvector(v, bf16x2_t); return __builtin_bit_cast(unsigned, b); }
template <int CTRL, int RMASK> DI float dppf(float oldv, float v) { return __builtin_bit_cast(float, __builtin_amdgcn_update_dpp(__builtin_bit_cast(int, oldv), __builtin_bit_cast(int, v), CTRL, RMASK, 0xf, false)); }
template <int CTRL, int RMASK> DI void scan_step(float& a, float& b) {
    const float ap = dppf<CTRL, RMASK>(1.f, a), bp = dppf<CTRL, RMASK>(0.f, b); b = a * bp + b; a = a * ap; }
DI void lru_unit(const KA& a, int l, const GAS bf16* proj, GAS bf16* ys, GAS float* sums, LAS unsigned char* lds, int task, int lane_in, int wave_in, bool final) {
    int lane = lane_in, wave = wave_in; asm volatile("" : "+v"(lane), "+s"(wave));
    const int chunk = task & 31, hbk = (task >> 5) & 3, b = task >> 7;
    const int ts = chunk * 256 + wave * 32; const size_t rowb = (size_t)b * SEQ;
    LAS unsigned char* wl = lds + wave * 16384;
    LAS float* ex = (LAS float*)(lds + LRUEX_OFF); LAS float* cst = (LAS float*)(lds + LRUCST_OFF); LAS float* car = (LAS float*)(lds + LRUCAR_OFF) + wave * 64;
    {
        const int c = hbk * 64 + lane;
        const GAS float* cw = (const GAS float*)(a.in[5] + (size_t)l * 4 * 256);
        const float cw0 = cw[c], cw1 = cw[256 + c], cw2 = cw[512 + c], cw3 = cw[768 + c]; const float cb = a.in[6][l * 256 + c];
        if (wave == 0) { cst[lane] = a.in[8][l * 256 + c]; cst[64 + lane] = a.in[10][l * 256 + c]; cst[128 + lane] = -8.f * softplusf_(-a.in[11][l * 256 + c]); }
        const GAS bf16* xp = proj + (rowb + ts) * PLD + C_AX + c;
        float x3 = (ts >= 3) ? bf2f(*(xp - 3 * PLD)) : 0.f, x2 = (ts >= 2) ? bf2f(*(xp - 2 * PLD)) : 0.f, x1 = (ts >= 1) ? bf2f(*(xp - PLD)) : 0.f;
#pragma unroll 8
        for (int n = 0; n < 32; ++n) { const float x0 = bf2f(xp[(size_t)n * PLD]); const float xc = cb + cw0 * x3 + cw1 * x2 + cw2 * x1 + cw3 * x0;
            *(LAS bf16*)(wl + n * 144 + lane * 2) = (bf16)f2bf(xc); *(LAS float*)(wl + 4608 + n * 272 + lane * 4) = xc; x3 = x2; x2 = x1; x1 = x0; }
    }
    const int n = lane & 31, hh = lane >> 5;
    f32x16 D[4];
    {
        const GAS bf16* wt = (const GAS bf16*)(a.ws + WS_LRUW) + (size_t)hbk * 8192;
        bf16x8 bfr[4];
        LDS_WAIT();
#pragma unroll
        for (int s4 = 0; s4 < 4; ++s4) bfr[s4] = *(const LAS bf16x8*)(wl + n * 144 + hh * 16 + s4 * 32);
#pragma unroll
        for (int m = 0; m < 4; ++m) {
#pragma unroll
            for (int s4 = 0; s4 < 4; ++s4) { const bf16x8 af = *(const GAS bf16x8*)(wt + (size_t)(m >> 1) * 4096 + (32 * (m & 1) + n) * 64 + 8 * hh + 16 * s4);
                if (s4 == 0) { f32x16 z;
#pragma unroll
                    for (int i = 0; i < 16; ++i) z[i] = 0.f;
                    D[m] = MFMA32(af, bfr[s4], z); } else D[m] = MFMA32(af, bfr[s4], D[m]); } }
    }
    __syncthreads();
    const bool t0 = (ts + n) == 0;
#pragma unroll
    for (int mm = 0; mm < 2; ++mm)
#pragma unroll
        for (int g4 = 0; g4 < 4; ++g4) { const int c0 = 32 * mm + 8 * g4 + 4 * hh;
            const f32x4 vba = *(const LAS f32x4*)(cst + c0), vbx = *(const LAS f32x4*)(cst + 64 + c0), vc8 = *(const LAS f32x4*)(cst + 128 + c0);
            const f32x4 vxc = *(const LAS f32x4*)(wl + 4608 + n * 272 + c0 * 4);
#pragma unroll
            for (int e = 0; e < 4; ++e) { const int i = 4 * g4 + e;
                const float r = sigmoidf_(D[mm][i] + vba[e]), ig = sigmoidf_(D[2 + mm][i] + vbx[e]);
                const float la = vc8[e] * r; const float av = __expf(la);
                const float mult = t0 ? 1.f : sqrtf(fmaxf(1.f - __expf(2.f * la), 0.f));
                float aa = av, bb = mult * ig * vxc[e];
                scan_step<0x111, 0xf>(aa, bb); scan_step<0x112, 0xf>(aa, bb); scan_step<0x114, 0xf>(aa, bb); scan_step<0x118, 0xf>(aa, bb); scan_step<0x142, 0xa>(aa, bb);
                D[mm][i] = aa; D[2 + mm][i] = bb; } }
    if (n == 31) {
#pragma unroll
        for (int mm = 0; mm < 2; ++mm)
#pragma unroll
            for (int i = 0; i < 16; ++i) { const int c = 32 * mm + crow(i, hh); ex[(wave * 64 + c) * 2] = D[mm][i]; ex[(wave * 64 + c) * 2 + 1] = D[2 + mm][i]; } }
    __syncthreads();
    if (!final) {
        if (wave == 0) { float hv = 0.f, av = 1.f;
#pragma unroll
            for (int w = 0; w < 8; ++w) { const float A_ = ex[(w * 64 + lane) * 2], H_ = ex[(w * 64 + lane) * 2 + 1]; hv = A_ * hv + H_; av *= A_; }
            GAS float* sp = sums + ((size_t)((b * 4 + hbk) * 32 + chunk) * 64 + lane) * 2; sp[0] = av; sp[1] = hv; }
    } else {
        {   float hv = 0.f;
            {   const GAS f32x2* sp = (const GAS f32x2*)(sums + ((size_t)((b * 4 + hbk) * 32) * 64 + lane) * 2);
                int cc = 0;
                for (; cc + 8 <= chunk; cc += 8) { f32x2 v[8];
#pragma unroll
                    for (int e = 0; e < 8; ++e) v[e] = sp[(size_t)(cc + e) * 64];
#pragma unroll
                    for (int e = 0; e < 8; ++e) hv = v[e][0] * hv + v[e][1]; }
                for (; cc < chunk; ++cc) { const f32x2 v = sp[(size_t)cc * 64]; hv = v[0] * hv + v[1]; } }
            for (int w = 0; w < wave; ++w) { const float A_ = ex[(w * 64 + lane) * 2], H_ = ex[(w * 64 + lane) * 2 + 1]; hv = A_ * hv + H_; }
            car[lane] = hv; }
        LDS_WAIT(); asm volatile("" ::: "memory");
        const GAS bf16* gp = proj + (rowb + ts + n) * PLD + C_AG + hbk * 64; GAS bf16* yp = ys + (rowb + ts + n) * 1024 + hbk * 64;
#pragma unroll
        for (int mm = 0; mm < 2; ++mm)
#pragma unroll
            for (int g4 = 0; g4 < 4; ++g4) { const int c0 = 32 * mm + 8 * g4 + 4 * hh; const f32x4 cv = *(const LAS f32x4*)(car + c0);
                const u32x2 gt2 = *(const GAS u32x2*)(gp + c0); float y[4];
#pragma unroll
                for (int e = 0; e < 4; ++e) { const int i = 4 * g4 + e; const float hv = D[2 + mm][i] + D[mm][i] * cv[e];
                    const float gt = (e == 0) ? lo_bf(gt2.x) : (e == 1) ? hi_bf(gt2.x) : (e == 2) ? lo_bf(gt2.y) : hi_bf(gt2.y); y[e] = hv * gelu_tanh(gt); }
                u32x2 yo; yo.x = cvtpk(y[0], y[1]); yo.y = cvtpk(y[2], y[3]); *(GAS u32x2*)(yp + c0) = yo; }
    }
    __syncthreads();
}

constexpr int DK_STR = 144, DV_STR = 192, DBUF_BYTES = 64 * DK_STR + 64 * DV_STR;
DI bf16x8 pack_half(const f32x16& x, int s2) { u32x4 p;
    if (s2 == 0) { p.x = cvtpk(x[0], x[1]); p.y = cvtpk(x[2], x[3]); p.z = cvtpk(x[4], x[5]); p.w = cvtpk(x[6], x[7]); }
    else { p.x = cvtpk(x[8], x[9]); p.y = cvtpk(x[10], x[11]); p.z = cvtpk(x[12], x[13]); p.w = cvtpk(x[14], x[15]); }
    return __builtin_bit_cast(bf16x8, p); }
DI s16x4 vtr(const LAS unsigned char* p) { return __builtin_bit_cast(s16x4, __builtin_amdgcn_ds_read_tr16_b64_v4i16((LAS v4i16_t*)p)); }
DI float max16(const f32x16& x) { float a = fmaxf(fmaxf(x[0], x[1]), fmaxf(x[2], x[3])), b = fmaxf(fmaxf(x[4], x[5]), fmaxf(x[6], x[7])), c = fmaxf(fmaxf(x[8], x[9]), fmaxf(x[10], x[11])), d = fmaxf(fmaxf(x[12], x[13]), fmaxf(x[14], x[15])); return fmaxf(fmaxf(a, b), fmaxf(c, d)); }
DI void diff_unit(const GAS bf16* proj, GAS bf16* ys, LAS unsigned char* lds, const LAS float* bias2, const GAS float* subg, const LAS float* lamp, int b, int h, int qb, int wave_in) {
    int wave = wave_in; asm volatile("" : "+s"(wave)); const int lane = my_lane(); const int tid = wave * 64 + lane;
    const int q0 = qb * 256 + wave * 32; const int ql = lane & 31, hh = lane >> 5; const int q = q0 + ql;
    const size_t rowb = (size_t)b * SEQ;
    const float SC = 0.17677669529663687f * 1.4426950408889634f;
    bf16x8 qf[2][2];
    { const GAS bf16* qp = proj + (rowb + q) * PLD + C_CQ + h * 64 + hh * 8;
#pragma unroll
      for (int m = 0; m < 2; ++m)
#pragma unroll
        for (int s = 0; s < 2; ++s) { const u32x4 w = *(const GAS u32x4*)(qp + m * 32 + s * 16); u32x4 o;
            o.x = cvtpk(lo_bf(w.x) * SC, hi_bf(w.x) * SC); o.y = cvtpk(lo_bf(w.y) * SC, hi_bf(w.y) * SC); o.z = cvtpk(lo_bf(w.z) * SC, hi_bf(w.z) * SC); o.w = cvtpk(lo_bf(w.w) * SC, hi_bf(w.w) * SC);
            qf[m][s] = __builtin_bit_cast(bf16x8, o); } }
    f32x16 O[2][2], negm[2];
#pragma unroll
    for (int i = 0; i < 16; ++i) { O[0][0][i] = 0.f; O[0][1][i] = 0.f; O[1][0][i] = 0.f; O[1][1][i] = 0.f; negm[0][i] = 120.f; negm[1][i] = 120.f; }
    float lsum[2] = {0.f, 0.f};
    const int nsteps = 4 * qb + 4, mysteps = 4 * qb + (wave >> 1) + 1;
    const int skey = tid >> 3, sch = tid & 7;
    const GAS unsigned char* kgb = (const GAS unsigned char*)(proj + rowb * PLD + C_CK + h * 64);
    const GAS unsigned char* vgb = (const GAS unsigned char*)(proj + rowb * PLD + C_CV + h * 64);
    const unsigned soff = (unsigned)(skey * PLD + sch * 8) * 2u;
    u32x4 kr = *(const GAS u32x4*)(kgb + soff), vr = *(const GAS u32x4*)(vgb + soff);
    *(LAS u32x4*)(lds + skey * DK_STR + sch * 16) = kr; *(LAS u32x4*)(lds + 64 * DK_STR + skey * DV_STR + sch * 16) = vr;
    __syncthreads();
    const int i16 = lane & 15, blk = (lane >> 4) & 1;
    const int kboff = ql * DK_STR + hh * 16;
    const int vboff = 64 * DK_STR + (4 * hh + (i16 >> 2)) * DV_STR + (16 * blk + 4 * (i16 & 3)) * 2;
#pragma unroll 1
    for (int kt = 0; kt < nsteps; ++kt) {
        const LAS unsigned char* cur = lds + (kt & 1) * DBUF_BYTES; LAS unsigned char* nxt = lds + ((kt + 1) & 1) * DBUF_BYTES;
        if (kt + 1 < nsteps) { const unsigned so = soff + (unsigned)(kt + 1) * (64u * PLD * 2u); kr = *(const GAS u32x4*)(kgb + so); vr = *(const GAS u32x4*)(vgb + so); }
        if (kt < mysteps) {
            const int kbase = kt * 64;
            const bool near = (q0 - (kbase + 63) < 113);
#pragma unroll
            for (int m = 0; m < 2; ++m) {
                bf16x8 pk[2][2];
                f32x16 S[2]; float ts = 0.f;
                {   bf16x8 kf[2][2];
#pragma unroll
                    for (int t = 0; t < 2; ++t)
#pragma unroll
                        for (int s = 0; s < 2; ++s) kf[t][s] = *(const LAS bf16x8*)(cur + kboff + t * 32 * DK_STR + m * 64 + s * 32);
#pragma unroll
                    for (int t = 0; t < 2; ++t) { S[t] = MFMA32(kf[t][0], qf[m][0], negm[m]); S[t] = MFMA32(kf[t][1], qf[m][1], S[t]); } }
                if (near) {
#pragma unroll
                    for (int t = 0; t < 2; ++t)
#pragma unroll
                        for (int i = 0; i < 16; ++i) { const int dist = q - (kbase + 32 * t + crow(i, hh)); const int di = dist < 128 ? dist : 128;
                            const float bv = dist >= 0 ? bias2[di * 12 + 4 + h] : -1e30f; S[t][i] += bv; } }
#pragma unroll
                for (int t = 0; t < 2; ++t)
#pragma unroll
                    for (int i = 0; i < 16; ++i) { const float p = __builtin_amdgcn_exp2f(S[t][i]); S[t][i] = p; ts += p; }
                if (__builtin_amdgcn_ballot_w64(!(ts < 1.0e30f)) != 0ull) {
                {   bf16x8 kf[2][2];
#pragma unroll
                        for (int t = 0; t < 2; ++t)
#pragma unroll
                            for (int s = 0; s < 2; ++s) kf[t][s] = *(const LAS bf16x8*)(cur + kboff + t * 32 * DK_STR + m * 64 + s * 32);
#pragma unroll
                        for (int t = 0; t < 2; ++t) { S[t] = MFMA32(kf[t][0], qf[m][0], negm[m]); S[t] = MFMA32(kf[t][1], qf[m][1], S[t]); } }
                    if (near) {
#pragma unroll
                        for (int t = 0; t < 2; ++t)
#pragma unroll
                            for (int i = 0; i < 16; ++i) { const int dist = q - (kbase + 32 * t + crow(i, hh)); const int di = dist < 128 ? dist : 128;
                                const float bv = dist >= 0 ? bias2[di * 12 + 4 + h] : -1e30f; S[t][i] += bv; } }
                    float tm = fmaxf(max16(S[0]), max16(S[1])); tm = fmaxf(tm, xshfl<32>(tm));
                    const float sh = fmaxf(tm, 0.f); const float al = __builtin_amdgcn_exp2f(-sh);
                    lsum[m] *= al; ts = 0.f;
#pragma unroll
                    for (int i = 0; i < 16; ++i) { O[m][0][i] *= al; O[m][1][i] *= al; negm[m][i] -= sh; }
#pragma unroll
                    for (int t = 0; t < 2; ++t)
#pragma unroll
                        for (int i = 0; i < 16; ++i) { const float p = __builtin_amdgcn_exp2f(S[t][i] - sh); S[t][i] = p; ts += p; }
                }
                lsum[m] += ts;
#pragma unroll
                for (int t = 0; t < 2; ++t) { pk[t][0] = pack_half(S[t], 0); pk[t][1] = pack_half(S[t], 1); }
#pragma unroll
                for (int t = 0; t < 2; ++t)
#pragma unroll
                    for (int s2 = 0; s2 < 2; ++s2)
#pragma unroll
                        for (int db = 0; db < 2; ++db) {
                            const s16x4 lo = vtr(cur + vboff + (32 * t + 16 * s2) * DV_STR + db * 64), hi = vtr(cur + vboff + (32 * t + 16 * s2 + 8) * DV_STR + db * 64);
                            const bf16x8 vf = __builtin_shufflevector(lo, hi, 0, 1, 2, 3, 4, 5, 6, 7);
                            O[m][db] = MFMA32(vf, pk[t][s2], O[m][db]); }
                ;
            }
        }
        if (kt + 1 < nsteps) { *(LAS u32x4*)(nxt + skey * DK_STR + sch * 16) = kr; *(LAS u32x4*)(nxt + 64 * DK_STR + skey * DV_STR + sch * 16) = vr; }
        __syncthreads();
    }
    const float l0 = lsum[0] + xshfl<32>(lsum[0]), l1 = lsum[1] + xshfl<32>(lsum[1]);
    const float lam = lamp[0], lam_init = lamp[1];
    const float i0 = 1.f / fmaxf(l0, 1e-30f), i1 = lam / fmaxf(l1, 1e-30f);
    float ss = 0.f;
#pragma unroll
    for (int db = 0; db < 2; ++db)
#pragma unroll
        for (int i = 0; i < 16; ++i) { const float at = O[0][db][i] * i0 - O[1][db][i] * i1; O[0][db][i] = at; ss += at * at; }
    ss += xshfl<32>(ss);
    const float r = (1.f - lam_init) / sqrtf(ss * (1.f / 64.f) + 1e-5f);
    GAS bf16* op = ys + (rowb + q) * 1024 + 512 + h * 64;
#pragma unroll
    for (int db = 0; db < 2; ++db)
#pragma unroll
        for (int gq = 0; gq < 4; ++gq) { const int d0 = 32 * db + 8 * gq + 4 * hh; const f32x4 sg = *(const GAS f32x4*)(subg + d0);
            u32x2 w; w.x = cvtpk(O[0][db][4 * gq + 0] * r * sg[0], O[0][db][4 * gq + 1] * r * sg[1]); w.y = cvtpk(O[0][db][4 * gq + 2] * r * sg[2], O[0][db][4 * gq + 3] * r * sg[3]);
            *(GAS u32x2*)(op + d0) = w; }
}

struct SchedCmp { const char* proj; const char* wc; int G, c;
    DI bool next(int i, Unit& u) const { const int L = i * G + c; if (L >= 16) return false; const int kv = L >> 3, rt = L & 7;
        u.pm = rt; u.pn = 0; u.aux = kv; u.pad = 0; u.a = proj + ((size_t)rt * 256 * 16 * PLD + (kv ? C_VC : C_KC)) * 2; u.b = wc + (size_t)kv * 256 * 1024 * 2; return true; } };
struct EpiCmp { static constexpr bool CARRY = false; float* ab;
    DI void operator()(const f32x4 (&acc)[2][2][4][2], const Unit& u, int wr, int wc, int fr, int fq) const {
        const int row0 = u.pm * 256 + wr * 64 + fr; const int col = wc * 32 + 8 * fq;
#pragma unroll
        for (int ai = 0; ai < 2; ++ai)
#pragma unroll
            for (int m = 0; m < 4; ++m) { float* rp = ab + ((size_t)u.aux * 2048 + row0 + ai * 128 + m * 16) * 128 + col; *(f32x4*)rp = acc[ai][0][m][0]; *(f32x4*)(rp + 4) = acc[ai][0][m][1]; }
    }
};
DI void cmp_rows16(const GAS bf16* proj, const GAS bf16* wcT, GAS float* ab, int bid, int wave, int lane) {
    const int kv = bid >> 7, g0 = (bid & 127) * 16, r = lane & 15, q = lane >> 4;
    const GAS bf16* apn = proj + (size_t)(g0 + r) * 16 * PLD + (kv ? C_VC : C_KC) + 8 * q;
    const GAS bf16* bpn = wcT + ((size_t)kv * 256 + wave * 16 + r) * 1024 + 8 * q;
    f32x4 acc = {0.f, 0.f, 0.f, 0.f};
#pragma unroll 8
    for (int s = 0; s < 32; ++s) {
        const bf16x8 av = *(const GAS bf16x8*)(apn + (size_t)(s >> 1) * PLD + 32 * (s & 1));
        const bf16x8 bv = *(const GAS bf16x8*)(bpn + 32 * s);
        acc = __builtin_amdgcn_mfma_f32_16x16x32_bf16(bv, av, acc, 0, 0, 0);
    }
    *(GAS f32x4*)(ab + ((size_t)kv * 2048 + g0 + r) * 128 + wave * 16 + 4 * q) = acc;
}
DI void cmp_finish(const KA& a, int l, const float* ab, bf16* kcb, int task, int lane) {
    const int kv = task / (BATCH * NCMP), r = task % (BATCH * NCMP), b = r / NCMP, c = r % NCMP;
    const float* w2 = a.in[kv ? 23 : 20] + (size_t)l * 4096; const float* pt = ab + 2 * 2048 * 128;
    const size_t g = (size_t)kv * 2048 + b * 512 + c;
    float ptv = 0.f;
#pragma unroll 8
    for (int part = 0; part < 32; ++part) ptv += pt[(kv * 32 + part) * 64 + lane];
    const float h1 = ab[g * 128 + lane] + ab[(g + 1) * 128 + 64 + lane] + ptv;
    const float gl = gelu_tanh(h1); float o = 0.f;
#pragma unroll
    for (int j = 0; j < 64; ++j) o += rl(gl, j) * w2[j * 64 + lane];
    kcb[((size_t)(kv * BATCH + b) * 512 + c) * 64 + lane] = (bf16)f2bf(o);
    if (c == NCMP - 1) kcb[((size_t)(kv * BATCH + b) * 512 + NCMP) * 64 + lane] = 0;
}

DI void st_load(const GAS unsigned char* kb, const GAS unsigned char* vb, unsigned off, u32x4& kr, u32x4& vr) { kr = *(const GAS u32x4*)(kb + off); vr = *(const GAS u32x4*)(vb + off); }
DI void st_write(LAS unsigned char* buf, int skey, int sch, const u32x4& kr, const u32x4& vr) { *(LAS u32x4*)(buf + skey * DK_STR + sch * 16) = kr; *(LAS u32x4*)(buf + 64 * DK_STR + skey * DV_STR + sch * 16) = vr; }
DI void qk64(const LAS unsigned char* cur, int kboff, const bf16x8 (&qf)[4], const f32x16& cinit, f32x16 (&S)[2]) {
#pragma unroll
    for (int t = 0; t < 2; ++t) { S[t] = cinit;
#pragma unroll
        for (int s = 0; s < 4; ++s) { const bf16x8 kf = *(const LAS bf16x8*)(cur + kboff + t * 32 * DK_STR + s * 32); S[t] = MFMA32(kf, qf[s], S[t]); } }
}
DI void qk32z(const LAS unsigned char* kt32, const bf16x8 (&qf)[4], f32x16& S) {
#pragma unroll
    for (int s = 0; s < 4; ++s) { const bf16x8 kf = *(const LAS bf16x8*)(kt32 + s * 32);
        if (s == 0) { f32x16 z;
#pragma unroll
            for (int i = 0; i < 16; ++i) z[i] = 0.f;
            S = MFMA32(kf, qf[s], z); } else S = MFMA32(kf, qf[s], S); }
}
DI void pv32(const LAS unsigned char* vt32, const bf16x8 (&pk)[2], f32x16 (&O)[2]) {
#pragma unroll
    for (int s2 = 0; s2 < 2; ++s2)
#pragma unroll
        for (int db = 0; db < 2; ++db) {
            const s16x4 lo = vtr(vt32 + (16 * s2) * DV_STR + db * 64), hi = vtr(vt32 + (16 * s2 + 8) * DV_STR + db * 64);
            const bf16x8 vf = __builtin_shufflevector(lo, hi, 0, 1, 2, 3, 4, 5, 6, 7);
            O[db] = MFMA32(vf, pk[s2], O[db]); }
}
DI void mask_bias_cmp32(f32x16& S, int tcol, int cbase, int hh, const LAS float* b2h, float msub) {
#pragma unroll
    for (int i = 0; i < 16; ++i) { const int c = cbase + crow(i, hh); const int dist = tcol - 31 - 16 * c; const bool ok = dist >= 0 && c < NCMP;
        const int di = dist < 0 ? 0 : (dist < 128 ? dist : 128); S[i] = ok ? S[i] + (b2h[di * 12] - msub) : -1e30f; }
}
DI void pv64(const LAS unsigned char* cur, int vboff, const bf16x8 (&pk)[2][2], f32x16 (&O)[2]) {
#pragma unroll
    for (int t = 0; t < 2; ++t)
#pragma unroll
        for (int s2 = 0; s2 < 2; ++s2)
#pragma unroll
            for (int db = 0; db < 2; ++db) {
                const s16x4 lo = vtr(cur + vboff + (32 * t + 16 * s2) * DV_STR + db * 64), hi = vtr(cur + vboff + (32 * t + 16 * s2 + 8) * DV_STR + db * 64);
                const bf16x8 vf = __builtin_shufflevector(lo, hi, 0, 1, 2, 3, 4, 5, 6, 7);
                O[db] = MFMA32(vf, pk[t][s2], O[db]); }
}
DI void softmax_step(f32x16 (&S)[2], f32x16 (&O)[2], f32x16& negm, float& lsum, bf16x8 (&pk)[2][2]) {
    float tm = fmaxf(max16(S[0]), max16(S[1]));
    if (__builtin_amdgcn_ballot_w64(tm > 8.f) != 0ull) {
        tm = fmaxf(tm, xshfl<32>(tm)); const float sh = fmaxf(tm, 0.f); const float al = __builtin_amdgcn_exp2f(-sh);
        lsum *= al;
#pragma unroll
        for (int i = 0; i < 16; ++i) { O[0][i] *= al; O[1][i] *= al; negm[i] -= sh; S[0][i] -= sh; S[1][i] -= sh; } }
#pragma unroll
    for (int t = 0; t < 2; ++t) {
#pragma unroll
        for (int i = 0; i < 16; ++i) { const float p = __builtin_amdgcn_exp2f(S[t][i]); S[t][i] = p; lsum += p; }
        pk[t][0] = pack_half(S[t], 0); pk[t][1] = pack_half(S[t], 1); }
}
DI void mask_bias(f32x16 (&S)[2], int tcol, int kbase, int hh, int W, bool colsel, const LAS float* b2h) {
#pragma unroll
    for (int t = 0; t < 2; ++t)
#pragma unroll
        for (int i = 0; i < 16; ++i) { const int dist = tcol - (kbase + 32 * t + crow(i, hh)); const bool ok = colsel && dist >= 0 && dist < W;
            const int di = dist < 0 ? 0 : (dist < 128 ? dist : 128); S[t][i] = ok ? S[t][i] + b2h[di * 12] : -1e30f; }
}
DI void nsa_unit(const GAS bf16* proj, GAS bf16* ys, const GAS bf16* kcb, LAS unsigned char* lds, const LAS float* bias2, int b, int u, int tid_in, int lane_in, int wave_in) {
    int tid = tid_in, lane = lane_in, wave = wave_in; asm volatile("" : "+v"(tid), "+v"(lane), "+s"(wave));
    const int t0 = u * 64; const int col = lane & 31, hh = lane >> 5, tl = col >> 2, head = col & 3;
    const int t = t0 + wave * 8 + tl; const int tw0 = t0 + wave * 8;
    const size_t rowb = (size_t)b * SEQ;
    const LAS float* b2h = bias2 + 8 + head;
    bf16x8 qf[4];
    { const float SC = 0.125f * 1.4426950408889634f; const GAS bf16* qp = proj + (rowb + t) * PLD + C_DQ + head * 64 + hh * 8;
#pragma unroll
      for (int s = 0; s < 4; ++s) { const u32x4 w = *(const GAS u32x4*)(qp + s * 16); u32x4 o;
          o.x = cvtpk(lo_bf(w.x) * SC, hi_bf(w.x) * SC); o.y = cvtpk(lo_bf(w.y) * SC, hi_bf(w.y) * SC); o.z = cvtpk(lo_bf(w.z) * SC, hi_bf(w.z) * SC); o.w = cvtpk(lo_bf(w.w) * SC, hi_bf(w.w) * SC);
          qf[s] = __builtin_bit_cast(bf16x8, o); } }
    const int skey = tid >> 3, sch = tid & 7;
    const int i16 = lane & 15, blk = (lane >> 4) & 1;
    const int kboff = col * DK_STR + hh * 16;
    const int vboff = 64 * DK_STR + (4 * hh + (i16 >> 2)) * DV_STR + (16 * blk + 4 * (i16 & 3)) * 2;
    u32x4 kr, vr;
    const int ncvm = (4 * u + 3) < NCMP ? (4 * u + 3) : NCMP;
    const int nsc = (ncvm + 63) >> 6;
    const GAS unsigned char* kcp = (const GAS unsigned char*)(kcb + (size_t)(0 * BATCH + b) * 512 * 64);
    const GAS unsigned char* vcp = (const GAS unsigned char*)(kcb + (size_t)(1 * BATCH + b) * 512 * 64);
    const unsigned soffc = (unsigned)(skey * 64 + sch * 8) * 2u;
    float m1 = -120.f, l1 = 0.f;
    st_load(kcp, vcp, soffc, kr, vr); st_write(lds, skey, sch, kr, vr); __syncthreads();
#pragma unroll 1
    for (int kt = 0; kt < nsc; ++kt) {
        const LAS unsigned char* cur = lds + (kt & 1) * DBUF_BYTES; LAS unsigned char* nxt = lds + ((kt + 1) & 1) * DBUF_BYTES;
        if (kt + 1 < nsc) st_load(kcp, vcp, soffc + (unsigned)(kt + 1) * 8192u, kr, vr);
#pragma unroll
        for (int tt = 0; tt < 2; ++tt) { f32x16 S; qk32z(cur + kboff + tt * 32 * DK_STR, qf, S); mask_bias_cmp32(S, t, kt * 64 + tt * 32, hh, b2h, 0.f);
          const float tm = max16(S); const float mn = fmaxf(m1, tm); float acc = 0.f;
#pragma unroll
          for (int i = 0; i < 16; ++i) acc += __builtin_amdgcn_exp2f(S[i] - mn);
          l1 = l1 * __builtin_amdgcn_exp2f(m1 - mn) + acc; m1 = mn; }
        if (kt + 1 < nsc) st_write(nxt, skey, sch, kr, vr);
        __syncthreads();
    }
    float mf, inv;
    { const float mo = xshfl<32>(m1), lo = xshfl<32>(l1); mf = fmaxf(m1, mo); const float lf = l1 * __builtin_amdgcn_exp2f(m1 - mf) + lo * __builtin_amdgcn_exp2f(mo - mf); inv = lf > 0.f ? 1.f / lf : 0.f; }
    f32x16 Oc[2], imp[4];
#pragma unroll
    for (int i = 0; i < 16; ++i) { Oc[0][i] = 0.f; Oc[1][i] = 0.f; imp[0][i] = 0.f; imp[1][i] = 0.f; imp[2][i] = 0.f; imp[3][i] = 0.f; }
    {   st_load(kcp, vcp, soffc, kr, vr); st_write(lds, skey, sch, kr, vr); __syncthreads();
#pragma unroll 1
        for (int kt = 0; kt < nsc; ++kt) {
            const LAS unsigned char* cur = lds + (kt & 1) * DBUF_BYTES; LAS unsigned char* nxt = lds + ((kt + 1) & 1) * DBUF_BYTES;
            if (kt + 1 < nsc) st_load(kcp, vcp, soffc + (unsigned)(kt + 1) * 8192u, kr, vr);
#pragma unroll
            for (int tt = 0; tt < 2; ++tt) {
                f32x16 S; qk32z(cur + kboff + tt * 32 * DK_STR, qf, S); mask_bias_cmp32(S, t, kt * 64 + tt * 32, hh, b2h, mf);
#pragma unroll
                for (int i = 0; i < 16; ++i) S[i] = __builtin_amdgcn_exp2f(S[i]) * inv;
                bf16x8 pk[2]; pk[0] = pack_half(S, 0); pk[1] = pack_half(S, 1);
                pv32(cur + vboff + tt * 32 * DV_STR, pk, Oc);
                const int Tq = (2 * kt + tt) & 3, MB = (2 * kt + tt) >> 2;
#pragma unroll
                for (int s2 = 0; s2 < 2; ++s2) { u32x4 aw; unsigned e[8];
#pragma unroll
                    for (int jj = 0; jj < 8; ++jj) { const int kk = 16 * s2 + 8 * (jj >> 2) + 4 * hh + (jj & 3); const int delta = 32 * Tq + kk - 4 * col;
                        e[jj] = (delta == -1 || delta == 3) ? 0x3F80u : ((unsigned)delta <= 2u ? 0x4000u : 0u); }
                    aw.x = e[0] | (e[1] << 16); aw.y = e[2] | (e[3] << 16); aw.z = e[4] | (e[5] << 16); aw.w = e[6] | (e[7] << 16);
                    const bf16x8 af = __builtin_bit_cast(bf16x8, aw);
                    if (MB == 0) imp[0] = MFMA32(af, pk[s2], imp[0]); else if (MB == 1) imp[1] = MFMA32(af, pk[s2], imp[1]); else if (MB == 2) imp[2] = MFMA32(af, pk[s2], imp[2]); else imp[3] = MFMA32(af, pk[s2], imp[3]); }
                if (Tq == 3 && MB < 3) { u32x4 aw; aw.x = 0u; aw.y = 0u; aw.z = 0u; aw.w = (lane == 32) ? 0x3F800000u : 0u;
                    const bf16x8 af = __builtin_bit_cast(bf16x8, aw);
                    if (MB == 0) imp[1] = MFMA32(af, pk[1], imp[1]); else if (MB == 1) imp[2] = MFMA32(af, pk[1], imp[2]); else imp[3] = MFMA32(af, pk[1], imp[3]); }
            }
            if (kt + 1 < nsc) st_write(nxt, skey, sch, kr, vr);
            __syncthreads();
        }
    }
    unsigned ocp[2][8];
#pragma unroll
    for (int db = 0; db < 2; ++db)
#pragma unroll
        for (int i = 0; i < 8; ++i) ocp[db][i] = cvtpk(Oc[db][2 * i], Oc[db][2 * i + 1]);
    unsigned sm0 = 0u, sm1 = 0u, sm2 = 0u, sm3 = 0u;
    {   const int cur_t = t >> 6; unsigned key[16];
#pragma unroll
        for (int i = 0; i < 16; ++i) {
            float v0 = imp[0][i], v1 = imp[1][i], v2 = imp[2][i], v3 = imp[3][i];
            v0 += xshfl<1>(v0); v0 += xshfl<2>(v0); v1 += xshfl<1>(v1); v1 += xshfl<2>(v1); v2 += xshfl<1>(v2); v2 += xshfl<2>(v2); v3 += xshfl<1>(v3); v3 += xshfl<2>(v3);
            const float val = head == 0 ? v0 : (head == 1 ? v1 : (head == 2 ? v2 : v3));
            const int j = 32 * head + crow(i, hh);
            const bool forced = (j == 0) || (j == cur_t) || (j == cur_t - 1);
            unsigned fx = (unsigned)(fminf(fmaxf(val, 0.f), 31.f) * 1048576.f) + 1u;
            fx = forced ? 0x1FFFFFFu : (j <= cur_t ? fx : 0u);
            key[i] = (fx << 7) | (unsigned)(127 - j); }
#pragma unroll 1
        for (int r = 0; r < 16; ++r) {
            unsigned w = key[0];
#pragma unroll
            for (int i = 1; i < 16; ++i) w = w > key[i] ? w : key[i];
            { unsigned o = (unsigned)xshfl_i<1>((int)w); w = w > o ? w : o; o = (unsigned)xshfl_i<2>((int)w); w = w > o ? w : o; o = (unsigned)xshfl_i<32>((int)w); w = w > o ? w : o; }
            if ((w >> 7) != 0u) { const int j = 127 - (int)(w & 127u); const unsigned bit = 1u << (j & 31); const int jb = j >> 5;
                sm0 |= (jb == 0) ? bit : 0u; sm1 |= (jb == 1) ? bit : 0u; sm2 |= (jb == 2) ? bit : 0u; sm3 |= (jb == 3) ? bit : 0u; }
#pragma unroll
            for (int i = 0; i < 16; ++i) key[i] = (key[i] == w) ? 0u : key[i];
        }
    }
    f32x16 Ow[2]; float lw = 0.f;
#pragma unroll
    for (int i = 0; i < 16; ++i) { Ow[0][i] = 0.f; Ow[1][i] = 0.f; }
    {   f32x16 negm;
#pragma unroll
        for (int i = 0; i < 16; ++i) negm[i] = 120.f;
        const GAS unsigned char* kwp = (const GAS unsigned char*)(proj + rowb * PLD + C_KW); const GAS unsigned char* vwp = (const GAS unsigned char*)(proj + rowb * PLD + C_VW);
        const unsigned soffp = (unsigned)(skey * PLD + sch * 8) * 2u;
        const int s0 = (u < 8) ? 8 - u : 0;
        st_load(kwp, vwp, soffp + (unsigned)(u - 8 + s0) * (64u * PLD * 2u), kr, vr); st_write(lds, skey, sch, kr, vr); __syncthreads();
#pragma unroll 1
        for (int s = s0; s < 9; ++s) {
            const int par = (s - s0) & 1; const LAS unsigned char* cur = lds + par * DBUF_BYTES; LAS unsigned char* nxt = lds + (par ^ 1) * DBUF_BYTES;
            if (s + 1 < 9) st_load(kwp, vwp, soffp + (unsigned)(u - 8 + s + 1) * (64u * PLD * 2u), kr, vr);
            {   f32x16 S[2]; qk64(cur, kboff, qf, negm, S);
                if (s == 0 || s >= 6) mask_bias(S, t, (u - 8 + s) * 64, hh, 512, true, b2h);
                bf16x8 pk[2][2]; softmax_step(S, Ow, negm, lw, pk); pv64(cur, vboff, pk, Ow); }
            if (s + 1 < 9) st_write(nxt, skey, sch, kr, vr);
            __syncthreads();
        }
    }
    unsigned owp[2][8];
#pragma unroll
    for (int db = 0; db < 2; ++db)
#pragma unroll
        for (int i = 0; i < 8; ++i) owp[db][i] = cvtpk(Ow[db][2 * i], Ow[db][2 * i + 1]);
    f32x16 Os[2]; float lsel = 0.f;
#pragma unroll
    for (int i = 0; i < 16; ++i) { Os[0][i] = 0.f; Os[1][i] = 0.f; }
    {   f32x16 negm;
#pragma unroll
        for (int i = 0; i < 16; ++i) negm[i] = 120.f;
        const GAS unsigned char* ksp = (const GAS unsigned char*)(proj + rowb * PLD + C_KS); const GAS unsigned char* vsp = (const GAS unsigned char*)(proj + rowb * PLD + C_VS);
        const unsigned soffp = (unsigned)(skey * PLD + sch * 8) * 2u;
        u32x4 kA, vA, kB, vB;
        st_load(ksp, vsp, soffp, kr, vr); st_write(lds, skey, sch, kr, vr);
        if (u >= 1) st_load(ksp, vsp, soffp + 64u * PLD * 2u, kA, vA);
        __syncthreads();
#define SEL_STEP(J, KX, VX, KY, VY) { const int j_ = (J); \
            const LAS unsigned char* cur = lds + (j_ & 1) * DBUF_BYTES; LAS unsigned char* nxt = lds + ((j_ + 1) & 1) * DBUF_BYTES; \
            if (j_ + 2 <= u) st_load(ksp, vsp, soffp + (unsigned)(j_ + 2) * (64u * PLD * 2u), KY, VY); \
            const int jb = j_ >> 5; const unsigned smw = jb == 0 ? sm0 : (jb == 1 ? sm1 : (jb == 2 ? sm2 : sm3)); \
            const bool bit = ((smw >> (j_ & 31)) & 1u) != 0u; \
            if (__builtin_amdgcn_ballot_w64(bit) != 0ull) { \
                f32x16 S[2]; qk64(cur, kboff, qf, negm, S); \
                if (64 * j_ + 63 > tw0 - 113) mask_bias(S, t, 64 * j_, hh, 1 << 30, bit, b2h); \
                else if (!bit) { _Pragma("unroll") for (int i = 0; i < 16; ++i) { S[0][i] = -1e30f; S[1][i] = -1e30f; } } \
                bf16x8 pk[2][2]; softmax_step(S, Os, negm, lsel, pk); pv64(cur, vboff, pk, Os); } \
            if (j_ + 1 <= u) st_write(nxt, skey, sch, KX, VX); \
            __syncthreads(); }
#pragma unroll 1
        for (int j = 0; j <= u; j += 2) {
            SEL_STEP(j, kA, vA, kB, vB)
            if (j + 1 <= u) SEL_STEP(j + 1, kB, vB, kA, vA)
        }
#undef SEL_STEP
    }
    {   const float lwt = lw + xshfl<32>(lw), lst = lsel + xshfl<32>(lsel);
        const GAS bf16* gp = proj + (rowb + t) * PLD + C_DG + head * 3;
        const float g0 = sigmoidf_(bf2f(gp[0])), g1 = sigmoidf_(bf2f(gp[1])) / fmaxf(lst, 1e-30f), g2 = sigmoidf_(bf2f(gp[2])) / fmaxf(lwt, 1e-30f);
        GAS bf16* op = ys + (rowb + t) * 1024 + 768 + head * 64;
#pragma unroll
        for (int db = 0; db < 2; ++db)
#pragma unroll
            for (int gq = 0; gq < 4; ++gq) { const int d0 = 32 * db + 8 * gq + 4 * hh; float y[4];
#pragma unroll
                for (int e = 0; e < 4; ++e) { const unsigned cw = ocp[db][2 * gq + (e >> 1)], ww = owp[db][2 * gq + (e >> 1)];
                    y[e] = g0 * ((e & 1) ? hi_bf(cw) : lo_bf(cw)) + g1 * Os[db][4 * gq + e] + g2 * ((e & 1) ? hi_bf(ww) : lo_bf(ww)); }
                u32x2 w; w.x = cvtpk(y[0], y[1]); w.y = cvtpk(y[2], y[3]); *(GAS u32x2*)(op + d0) = w; }
    }
}


DI void swa_unit(const GAS bf16* proj, GAS bf16* ys, LAS unsigned char* lds, const LAS float* bias2, const LAS float* biasd, const GAS float* sinks, int b, int u, int tid_in, int lane_in, int wave_in) {
    int tid = tid_in, lane = lane_in, wave = wave_in; asm volatile("" : "+v"(tid), "+v"(lane), "+s"(wave));
    const int t0 = u * 64; const int col = lane & 31, hh = lane >> 5, tl = col >> 1, kv = wave & 1, head = 2 * kv + (col & 1);
    const int t = t0 + (wave >> 1) * 16 + tl;
    const size_t rowb = (size_t)b * SEQ;
    const LAS float* b2h = bias2 + head;
    bf16x8 qf[4];
    { const float SC = 0.125f * 1.4426950408889634f; const GAS bf16* qp = proj + (rowb + t) * PLD + C_BQ + head * 64 + hh * 8;
#pragma unroll
      for (int s = 0; s < 4; ++s) { const u32x4 w = *(const GAS u32x4*)(qp + s * 16); u32x4 o;
          o.x = cvtpk(lo_bf(w.x) * SC, hi_bf(w.x) * SC); o.y = cvtpk(lo_bf(w.y) * SC, hi_bf(w.y) * SC); o.z = cvtpk(lo_bf(w.z) * SC, hi_bf(w.z) * SC); o.w = cvtpk(lo_bf(w.w) * SC, hi_bf(w.w) * SC);
          qf[s] = __builtin_bit_cast(bf16x8, o); } }
    const int skey = tid >> 3, sch = tid & 7;
    const int i16 = lane & 15, blk = (lane >> 4) & 1;
    const int kboff = kv * DBUF_BYTES + col * DK_STR + hh * 16;
    const int vboff = kv * DBUF_BYTES + 64 * DK_STR + (4 * hh + (i16 >> 2)) * DV_STR + (16 * blk + 4 * (i16 & 3)) * 2;
    const GAS unsigned char* kp = (const GAS unsigned char*)(proj + rowb * PLD + C_BK); const GAS unsigned char* vp = (const GAS unsigned char*)(proj + rowb * PLD + C_BV);
    const unsigned soffp = (unsigned)(skey * PLD + sch * 8) * 2u;
    u32x4 k0, v0, k1, v1;
    f32x16 O[2], negm; float lsum = 0.f;
#pragma unroll
    for (int i = 0; i < 16; ++i) { O[0][i] = 0.f; O[1][i] = 0.f; negm[i] = 120.f; }
    const int s0 = (u < 2) ? 2 - u : 0;
    { const unsigned so = soffp + (unsigned)(u - 2 + s0) * (64u * PLD * 2u); st_load(kp, vp, so, k0, v0); st_load(kp + 128, vp + 128, so, k1, v1);
      st_write(lds, skey, sch, k0, v0); st_write(lds + DBUF_BYTES, skey, sch, k1, v1); }
    __syncthreads();
#pragma unroll 1
    for (int s = s0; s < 3; ++s) {
        const int par = (s - s0) & 1; const LAS unsigned char* cur = lds + par * 2 * DBUF_BYTES; LAS unsigned char* nxt = lds + (par ^ 1) * 2 * DBUF_BYTES;
        if (s + 1 < 3) { const unsigned so = soffp + (unsigned)(u - 2 + s + 1) * (64u * PLD * 2u); st_load(kp, vp, so, k0, v0); st_load(kp + 128, vp + 128, so, k1, v1); }
        {   f32x16 S[2]; qk64(cur, kboff, qf, negm, S);
            mask_bias(S, t, (u - 2 + s) * 64, hh, 128, true, b2h);
            bf16x8 pk[2][2]; softmax_step(S, O, negm, lsum, pk); pv64(cur, vboff, pk, O); }
        if (s + 1 < 3) { st_write(nxt, skey, sch, k0, v0); st_write(nxt + DBUF_BYTES, skey, sch, k1, v1); }
        __syncthreads();
    }
    {   const float sinkp = (sinks[head] - biasd[128 * 12 + head]) * 1.4426950408889634f;
        const float lt = lsum + xshfl<32>(lsum) + __builtin_amdgcn_exp2f(sinkp + negm[0]);
        const float inv = 1.f / fmaxf(lt, 1e-30f);
        GAS bf16* op = ys + (rowb + t) * 1024 + 256 + head * 64;
#pragma unroll
        for (int db = 0; db < 2; ++db)
#pragma unroll
            for (int gq = 0; gq < 4; ++gq) { const int d0 = 32 * db + 8 * gq + 4 * hh;
                u32x2 w; w.x = cvtpk(O[db][4 * gq + 0] * inv, O[db][4 * gq + 1] * inv); w.y = cvtpk(O[db][4 * gq + 2] * inv, O[db][4 * gq + 3] * inv); *(GAS u32x2*)(op + d0) = w; }
    }
}

DI void route_rows4(const KA& a, int l, bf16* xr_, int tok0, int lane_) {
    int lane = lane_; asm volatile("" : "+v"(lane));
    const GAS bf16* xrow = (const GAS bf16*)(a.ws + WS_XB) + (size_t)tok0 * 1024; const GAS float* g = (const GAS float*)(a.in[28] + (size_t)l * 1024); GAS bf16* xr = (GAS bf16*)xr_;
    f32x4 v[4][4]; float ss[4]; u32x2 raw[4][4];
#pragma unroll
    for (int rr = 0; rr < 4; ++rr)
#pragma unroll
        for (int j = 0; j < 4; ++j) raw[rr][j] = *(const GAS u32x2*)(xrow + (size_t)rr * 1024 + 4 * (lane + 64 * j));
#pragma unroll
    for (int rr = 0; rr < 4; ++rr)
#pragma unroll
        for (int j = 0; j < 4; ++j) { v[rr][j][0] = lo_bf(raw[rr][j].x); v[rr][j][1] = hi_bf(raw[rr][j].x); v[rr][j][2] = lo_bf(raw[rr][j].y); v[rr][j][3] = hi_bf(raw[rr][j].y); }
#pragma unroll
    for (int rr = 0; rr < 4; ++rr) { float t = 0.f;
#pragma unroll
        for (int j = 0; j < 4; ++j) t += (v[rr][j][0] * v[rr][j][0] + v[rr][j][1] * v[rr][j][1]) + (v[rr][j][2] * v[rr][j][2] + v[rr][j][3] * v[rr][j][3]);
        ss[rr] = t; }
#pragma unroll
    for (int rr = 0; rr < 4; ++rr) ss[rr] = wave_sum(ss[rr]);
#pragma unroll
    for (int j = 0; j < 4; ++j) { const int k0 = 4 * (lane + 64 * j); const f32x4 gv = *(const GAS f32x4*)(g + k0);
#pragma unroll
        for (int rr = 0; rr < 4; ++rr) { const float r = 1.f / sqrtf(ss[rr] * (1.f / 1024.f) + 1e-6f); const f32x4 xn = v[rr][j] * r * gv;
            unsigned hi[4]; float lo[4];
#pragma unroll
            for (int e = 0; e < 4; ++e) { hi[e] = f2bf(xn[e]); lo[e] = xn[e] - __builtin_bit_cast(float, hi[e] << 16); }
            u32x2 wh, wl; wh.x = hi[0] | (hi[1] << 16); wh.y = hi[2] | (hi[3] << 16); wl.x = pk2(lo[0], lo[1]); wl.y = pk2(lo[2], lo[3]);
            *(GAS u32x2*)(xr + (size_t)(tok0 + rr) * 2048 + k0) = wh; *(GAS u32x2*)(xr + (size_t)(tok0 + rr) * 2048 + 1024 + k0) = wl; } }
}
struct SchedRoute { const char* A; const char* B; int pm;
    DI bool next(int i, Unit& u) const { if (i > 0) return false; u.pm = pm; u.pn = 0; u.aux = 0; u.pad = 0; u.a = A + (size_t)pm * 128 * 2048 * 2; u.b = B; return true; } };
struct EpiRoute { static constexpr bool CARRY = false; float* rlog;
    DI void operator()(const f32x4 (&acc)[2][2][4][2], const Unit& u, int wr, int wc, int fr, int fq) const {
        const int row0 = u.pm * 128 + wr * 64 + fr; const int col = wc * 32 + 8 * fq;
#pragma unroll
        for (int m = 0; m < 4; ++m) { float* rp = rlog + (size_t)(row0 + m * 16) * 128 + col; *(f32x4*)rp = acc[0][0][m][0]; *(f32x4*)(rp + 4) = acc[0][0][m][1]; }
    }
};
DI void route_decide(const KA& a, int l, const float* rl_row, int* rec_e, int* rec_slot, float* rec_w, unsigned* cnt, int tok) {
    float lg[36];
    const float* bg = a.in[30] + l * 4; const float* be = a.in[32] + l * 32;
#pragma unroll
    for (int q = 0; q < 9; ++q) { const f32x4 h = *(const f32x4*)(rl_row + 4 * q), lo = *(const f32x4*)(rl_row + 64 + 4 * q);
        lg[4 * q + 0] = h[0] + lo[0]; lg[4 * q + 1] = h[1] + lo[1]; lg[4 * q + 2] = h[2] + lo[2]; lg[4 * q + 3] = h[3] + lo[3]; }
#pragma unroll
    for (int i = 0; i < 4; ++i) lg[i] += bg[i];
#pragma unroll
    for (int i = 0; i < 32; ++i) lg[4 + i] += be[i];
    int gsel = 0; float gm = lg[0];
#pragma unroll
    for (int i = 1; i < 4; ++i) if (lg[i] > gm) { gm = lg[i]; gsel = i; }
    float gs = 0.f;
#pragma unroll
    for (int i = 0; i < 4; ++i) gs += __expf(lg[i] - gm);
    const float gwt = 1.f / gs;
    float v8[8];
#pragma unroll
    for (int i = 0; i < 8; ++i) { float x = lg[4 + i];
#pragma unroll
        for (int gq = 1; gq < 4; ++gq) x = (gsel == gq) ? lg[4 + gq * 8 + i] : x;
        v8[i] = x; }
    int i0 = 0; float m0 = v8[0];
#pragma unroll
    for (int i = 1; i < 8; ++i) if (v8[i] > m0) { m0 = v8[i]; i0 = i; }
    int i1 = -1; float m1 = -3e38f;
#pragma unroll
    for (int i = 0; i < 8; ++i) if (i != i0 && v8[i] > m1) { m1 = v8[i]; i1 = i; }
    if (i1 < 0) i1 = (i0 == 0) ? 1 : 0;
    const float w0 = 1.f / (1.f + __expf(m1 - m0)); const float w1 = 1.f - w0;
    const int e0 = gsel * 8 + i0, e1 = gsel * 8 + i1;
    const unsigned s0 = __hip_atomic_fetch_add(cnt + e0, 1u, __ATOMIC_RELAXED, __HIP_MEMORY_SCOPE_AGENT);
    const unsigned s1 = __hip_atomic_fetch_add(cnt + e1, 1u, __ATOMIC_RELAXED, __HIP_MEMORY_SCOPE_AGENT);
    rec_e[tok * 2] = e0; rec_e[tok * 2 + 1] = e1; rec_slot[tok * 2] = (int)s0; rec_slot[tok * 2 + 1] = (int)s1; rec_w[tok * 2] = w0 * gwt; rec_w[tok * 2 + 1] = w1 * gwt;
}
DI void expert_weights(const KA& a, int l, LAS unsigned char* lds, int it0, int it1, int gw, int NGW, int wave, int lane) {
    LAS float* scr = (LAS float*)(lds + wave * 16384);
    const float* wgt = a.in[33] + (size_t)l * 32 * 1024 * 256; const float* wup = a.in[34] + (size_t)l * 32 * 1024 * 256; const float* wdn = a.in[35] + (size_t)l * 32 * 256 * 1024;
    bf16* Wgu = (bf16*)(a.ws + WS_WGU); bf16* Wd = (bf16*)(a.ws + WS_WD);
    constexpr int I_E = 16 * 8, I_D = 4 * 32;
    constexpr int NIT = 32 * (2 * I_E + I_D);
    (void)NIT;
    for (int it = it0 + gw; it < it1; it += NGW) {
        const int e = it / (2 * I_E + I_D); int r = it % (2 * I_E + I_D);
        if (r < 2 * I_E) { const int up = r / I_E, q = r % I_E, kb = q / 8, nb = q % 8; const int n0 = nb * 32;
            const int drow = (n0 >> 7) * 256 + up * 128 + (n0 & 127);
            transpose_item((up ? wup : wgt) + (size_t)e * 1024 * 256, 256, 256, Wgu + (size_t)e * 512 * 1024, 1024, kb * 64, n0, drow, scr, lane);
        } else { r -= 2 * I_E; const int kb = r / 32, nb = r % 32;
            transpose_item(wdn + (size_t)e * 256 * 1024, 1024, 1024, Wd + (size_t)e * 1024 * 256, 256, kb * 64, nb * 32, nb * 32, scr, lane); }
    }
}
DI void build_offsets(const unsigned* cnt, LAS int* offt, int tid) {
    if (tid < 32) { const int c = (int)__hip_atomic_load(cnt + tid, __ATOMIC_RELAXED, __HIP_MEMORY_SCOPE_AGENT); offt[330 + tid] = (c + 255) & ~255; }
    __syncthreads();
    if (tid == 0) { int o = 0;
#pragma unroll
        for (int e = 0; e < 32; ++e) { offt[e] = o; o += offt[330 + e]; } offt[32] = o; }
    __syncthreads();
    for (int rt = tid; rt < (MOE_ROWS >> 8); rt += 512) { int e = 0; for (int j = 1; j < 32; ++j) e += (offt[j] <= rt * 256) ? 1 : 0; offt[40 + rt] = e; }
    __syncthreads();
}

template <unsigned PM>
__global__ void __launch_bounds__(512, 2) mk_fwd(Args a_) {
    extern __shared__ __attribute__((aligned(16))) unsigned char lds_raw[];
    LAS unsigned char* lds = (LAS unsigned char*)lds_raw;
    const int wave0 = __builtin_amdgcn_readfirstlane((int)threadIdx.x >> 6);
    if (threadIdx.x < 36) ((LAS unsigned long long*)(lds + PTAB_OFF))[threadIdx.x] = (unsigned long long)a_.in[threadIdx.x];
    __syncthreads();
    KA a; a.in.base = (unsigned)(size_t)(lds + PTAB_OFF); a.out = a_.out; a.ws = a_.ws;
    const int G = gridDim.x, bid = blockIdx.x, NGW = G * 8;
#define PHASE_IDS() int wave = wave0; asm volatile("" : "+s"(wave)); const int lane = my_lane(); const int tid_ = wave * 64 + lane, gw = bid * 8 + wave; (void)tid_; (void)gw; \
    const int xb = ((bid & 7) << 5) | (bid >> 3); (void)xb;        \
    KA ap = a; asm volatile("" : "+s"(ap.ws), "+s"(ap.out), "+s"(ap.in.base)); \
    bf16* hb = (bf16*)(ap.ws + WS_HB); bf16* proj = (bf16*)(ap.ws + WS_PROJ); bf16* gates = (bf16*)(ap.ws + WS_GATES); \
    bf16* ys = hb; bf16* x2b = hb; bf16* merged = proj; bf16* eo = proj; \
    bf16* kcb = (bf16*)(ap.ws + WS_KCVC); float* lrusum = (float*)(ap.ws + WS_LRUSUM); \
    int* rec_e = (int*)(ap.ws + WS_REC); int* rec_slot = rec_e + T * 2; float* rec_w = (float*)(rec_slot + T * 2); \
    int* rowtok = (int*)(ap.ws + WS_ROWTOK); float* roww = (float*)(ap.ws + WS_ROWW); \
    bf16* xs = (bf16*)(ap.ws + WS_XS); bf16* hmid = (bf16*)(ap.ws + WS_HMID); unsigned* ctl = (unsigned*)(ap.ws + WS_CTL); \
    (void)hb; (void)proj; (void)gates; (void)ys; (void)x2b; (void)merged; (void)eo; (void)kcb; (void)lrusum; (void)rec_e; (void)rec_slot; (void)rec_w; (void)rowtok; (void)roww; (void)xs; (void)hmid; (void)ctl
    volatile LAS unsigned* MISC = (volatile LAS unsigned*)(lds + MISC_OFF);
    LAS float* biasd = (LAS float*)(lds + BIAS_OFF);
    LAS int* offt = (LAS int*)(lds + OFFT_OFF);
    { PHASE_IDS();
    if (tid_ < 64) MISC[tid_] = 0u;
    for (int i = tid_; i < 129 * 12; i += 512) { const int d = i / 12, hd = i % 12; const int bk = d < 128 ? T5_BUCKET[d] : 31; const float* rb = a.in[1]; biasd[i] = rb[bk * 12 + hd]; ((LAS float*)(lds + BIAS2_OFF))[i] = (rb[bk * 12 + hd] - rb[31 * 12 + hd]) * 1.4426950408889634f; } }
    __syncthreads();
    const int lo = a_.ph_lo, hi = a_.ph_hi;
    XcdBarrier bar; bar.bar = (unsigned*)(a.ws + WS_CTL) + CW_BAR; bar.x = 0; bar.st = nullptr;
    if (hi - lo > 1) { PHASE_IDS(); bar = xcd_barrier_post(ctl + CW_BAR, MISC + 8, tid_ == 0); }
#ifndef SUB_MASK
#define SUB_MASK 0xFFu
#endif
#define SUB(k) ((SUB_MASK >> (k)) & 1u)
#define HASP(k) ((PM >> ((k) % PPL + ((k) >= 2 * PPL ? PPL : 0))) & 1u)
#define IN(k) (HASP(k) && lo <= (k) && (k) < hi)
#define SEAM(k) do { if ((k) + 1 < hi) { const int sl_ = my_lane(); int sw_ = wave0; asm volatile("" : "+s"(sw_)); xcd_barrier(bar, sw_ == 0 && sl_ == 0); } } while (0)
    for (int l = 0; l < DEPTH; ++l) {
        const int pb = l * PPL;
        if (IN(pb + 0)) { PHASE_IDS(); p1_weights_i8(ap, l, lds, gw, NGW, wave, lane); router_weights(ap, l, gw, NGW, lane); lru_weights(ap, l, gw, NGW, lane); cmp_weights(ap, l, lds, gw, NGW, wave, lane); phase0_weights(ap, l, lds, gw, NGW, wave, lane); phase0_rows(ap, l, 0, gw, NGW, lane); SEAM(pb + 0); }
        if (IN(pb + 1)) {
            PHASE_IDS();
            {   int K1q = 512; asm volatile("" : "+s"(K1q));
                pg8::Gemm g{K1q, 512, 512, 128, -1}; SchedP1 S{(const char*)(ap.ws + WS_HQ), (const char*)(ap.ws + WS_WQ), 128, 26, 1024, 1024, G, bid};
                EpiP1I8 E{proj, (unsigned char*)gates, ap.in[25] + (size_t)l * 4096, (const float*)(ap.ws + WS_HSC), (const float*)(ap.ws + WS_WSC)};
                pg8::gemm_phase<EpiP1I8, SchedP1, false, true>(lds, g, S, E, tid_); }
            SEAM(pb + 1);
        }
        if (IN(pb + 2)) {
            PHASE_IDS();
            LAS float* lamp = (LAS float*)(lds + MISC_OFF + 64);
            if (tid_ < 64) { const float* q1 = ap.in[13] + l * 32; const float* k1 = ap.in[14] + l * 32; const float* q2 = ap.in[15] + l * 32; const float* k2 = ap.in[16] + l * 32;
                float s1 = (lane < 32) ? q1[lane] * k1[lane] : 0.f, s2 = (lane < 32) ? q2[lane] * k2[lane] : 0.f; s1 = wave_sum(s1); s2 = wave_sum(s2);
                const float lam_init = 0.8f - 0.6f * __expf(-0.3f * (float)l); if (lane == 0) { lamp[0] = __expf(s1) - __expf(s2) + lam_init; lamp[1] = lam_init; } }
            __syncthreads();
            if (SUB(0)) { const LAS float* bias2 = (const LAS float*)(lds + BIAS2_OFF); const GAS float* subg = (const GAS float*)(ap.in[17] + l * 64);
                for (int pi = xb; pi < 256; pi += G) { const int bh = pi >> 4, qlo = pi & 15;
                    diff_unit((const GAS bf16*)proj, (GAS bf16*)ys, lds, bias2, subg, lamp, bh >> 2, bh & 3, 31 - qlo, wave);
                    diff_unit((const GAS bf16*)proj, (GAS bf16*)ys, lds, bias2, subg, lamp, bh >> 2, bh & 3, qlo, wave); } }
            { PHASE_IDS();
            if (SUB(3)) { __syncthreads(); const LAS float* bias2 = (const LAS float*)(lds + BIAS2_OFF); const GAS float* sinks = (const GAS float*)(ap.in[12] + l * 4);
                for (int pi = xb; pi < 512; pi += G) swa_unit((const GAS bf16*)proj, (GAS bf16*)ys, lds, bias2, biasd, sinks, pi >> 7, pi & 127, tid_, lane, wave); }
            if (SUB(2)) cmp_rows16((const GAS bf16*)proj, (const GAS bf16*)(ap.ws + WS_WCMP), (GAS float*)(ap.ws + WS_CMPAB), bid, wave, lane);
            if (SUB(1)) { __syncthreads(); for (int task = xb; task < 512; task += G) lru_unit(ap, l, (const GAS bf16*)proj, (GAS bf16*)ys, (GAS float*)lrusum, lds, task, lane, wave, false); }
            }
            SEAM(pb + 2);
        }
        if (IN(pb + 3)) {
            PHASE_IDS();
            for (int task = gw; task < 2 * BATCH * NCMP; task += NGW) cmp_finish(ap, l, (const float*)(ap.ws + WS_CMPAB), kcb, task, lane);
            __syncthreads();
            for (int task = xb; task < 512; task += G) lru_unit(ap, l, (const GAS bf16*)proj, (GAS bf16*)ys, (GAS float*)lrusum, lds, task, lane, wave, true);
            SEAM(pb + 3);
        }
        if (IN(pb + 4)) {
            PHASE_IDS();
            if (SUB(4)) { const LAS float* bias2 = (const LAS float*)(lds + BIAS2_OFF);
                for (int pi = xb; pi < 256; pi += G) { const int bb = pi >> 6, ulo = pi & 63;
                    nsa_unit((const GAS bf16*)proj, (GAS bf16*)ys, (const GAS bf16*)kcb, lds, bias2, bb, 127 - ulo, tid_, lane, wave);
                    nsa_unit((const GAS bf16*)proj, (GAS bf16*)ys, (const GAS bf16*)kcb, lds, bias2, bb, ulo, tid_, lane, wave); } }
            SEAM(pb + 4);
        }
        if (IN(pb + 5)) {
            PHASE_IDS();
            int K5 = 256; asm volatile("" : "+s"(K5));
            pg8::Gemm g{K5, 1024, 256, 128, -1}; SchedP3a S{(const char*)ys, (const char*)(ap.ws + WS_WBR), G, xb};
            EpiP3a E{merged, (const unsigned char*)gates};
            pg8::gemm_phase<EpiP3a, SchedP3a>(lds, g, S, E, tid_); SEAM(pb + 5);
        }
        if (IN(pb + 6)) {
            PHASE_IDS();
            int K6 = 1024; asm volatile("" : "+s"(K6));
            pg8::Gemm g{K6, 1024, 1024, 128, -1}; SchedP3b S{(const char*)merged, (const char*)(ap.ws + WS_WOUT), G, xb};
            if (l == 0) { EpiP3b<true> E{ap.in[0], (bf16*)(ap.ws + WS_XB)}; pg8::gemm_phase<EpiP3b<true>, SchedP3b>(lds, g, S, E, tid_); }
            else { EpiP3b<false> E{nullptr, (bf16*)(ap.ws + WS_XB)}; pg8::gemm_phase<EpiP3b<false>, SchedP3b>(lds, g, S, E, tid_); }
            SEAM(pb + 6);
        }
        if (IN(pb + 7)) {
            PHASE_IDS();
            bf16* xr = (bf16*)(ap.ws + WS_XR); float* rlog = (float*)(ap.ws + WS_RLOG);
            constexpr int NITW = 32 * (2 * 16 * 8 + 4 * 32);
            { const int pm = bid;
                for (int r = wave * 4; r < 128; r += 32) route_rows4(ap, l, xr, pm * 128 + r, lane);
                asm volatile("s_waitcnt vmcnt(0)" ::: "memory"); __syncthreads();
                { pg8::Gemm g{2048, 2048, 2048, 128, 0}; SchedRoute S{(const char*)xr, (const char*)(ap.ws + WS_WR), pm}; EpiRoute E{rlog};
                  pg8::gemm_phase<EpiRoute, SchedRoute>(lds, g, S, E, tid_); }
                asm volatile("s_waitcnt vmcnt(0)" ::: "memory"); __syncthreads();
                if (tid_ < 128) route_decide(ap, l, rlog + (size_t)(pm * 128 + tid_) * 128, rec_e, rec_slot, rec_w, ctl + CW_CNT + l * 32, pm * 128 + tid_);
                __syncthreads();
            }
            expert_weights(ap, l, lds, 0, NITW, gw, NGW, wave, lane);
            SEAM(pb + 7);
        }
        if (IN(pb + 8)) {
            PHASE_IDS();
            build_offsets(ctl + CW_CNT + l * 32, offt, tid_);
            if (bid < 32) { const int e = bid; const int c = (int)__hip_atomic_load(ctl + CW_CNT + l * 32 + e, __ATOMIC_RELAXED, __HIP_MEMORY_SCOPE_AGENT);
                for (int p = offt[e] + c + tid_; p < offt[e + 1]; p += 512) rowtok[p] = -1; }
            {   int* rowsrc = (int*)xs;
                if (bid < 32) { const int e = bid; const int c = (int)__hip_atomic_load(ctl + CW_CNT + l * 32 + e, __ATOMIC_RELAXED, __HIP_MEMORY_SCOPE_AGENT);
                    for (int p = offt[e] + c + tid_; p < offt[e + 1]; p += 512) rowsrc[p] = 0; }
                for (int as = bid * 512 + tid_; as < 2 * T; as += G * 512) { const int p = offt[rec_e[as]] + rec_slot[as];
                    rowtok[p] = as; roww[p] = rec_w[as]; rowsrc[p] = as >> 1; } }
            SEAM(pb + 8);
        }
        if (IN(pb + 9)) {
            PHASE_IDS();
            build_offsets(ctl + CW_CNT + l * 32, offt, tid_);
            int K9 = 1024; asm volatile("" : "+s"(K9));
            pg8::Gemm g{K9, 2048, 1024, 128, -1}; SchedM2 S{(const char*)(ap.ws + WS_XR), (const char*)(ap.ws + WS_WGU), offt, (const int*)xs, G, xb};
            EpiM2 E{hmid};
            pg8::gemm_phase<EpiM2, SchedM2, true>(lds, g, S, E, tid_); SEAM(pb + 9);
        }
        if (IN(pb + 10)) {
            PHASE_IDS();
            build_offsets(ctl + CW_CNT + l * 32, offt, tid_);
            int K3 = 256; asm volatile("" : "+s"(K3));
            pg8::Gemm g{K3, 256, 256, 128, -1}; SchedM3 S{(const char*)hmid, (const char*)(ap.ws + WS_WD), offt, G, xb};
            EpiM3 E{eo, rowtok, roww};
            pg8::gemm_phase<EpiM3, SchedM3>(lds, g, S, E, tid_); SEAM(pb + 10);
        }
    }
    if (IN(2 * PPL)) { PHASE_IDS(); phase0_rows(ap, DEPTH, 1, gw, NGW, lane); }
#undef IN
#undef SEAM
}

typedef void (*kern_t)(Args);
template <unsigned PM> static bool setup_kernel() {
    if (hipFuncSetAttribute((const void*)mk_fwd<PM>, hipFuncAttributeMaxDynamicSharedMemorySize, LDS_BYTES) != hipSuccess) { fprintf(stderr, "kernel_launch: hipFuncSetAttribute failed\n"); return false; }
    return true;
}
extern "C" void kernel_launch(void* const* d_in, const int* in_sizes, int n_in, void* d_out, int out_size, void* d_ws, size_t ws_size, hipStream_t stream) {
    static int grid = 0;
    if (grid == 0) {
        if (n_in != 36 || out_size != T * D || ws_size < WS_END) { fprintf(stderr, "kernel_launch: unexpected shapes (n_in %d out %d ws %zu)\n", n_in, out_size, ws_size); grid = -1; return; }
        int dev = 0, cus = 0;
        if (hipGetDevice(&dev) != hipSuccess || hipDeviceGetAttribute(&cus, hipDeviceAttributeMultiprocessorCount, dev) != hipSuccess) { grid = -1; return; }
        bool ok = true;
#if MK_ONE_LAUNCH
        ok = setup_kernel<0xFFFu>();
#endif
        if (!ok) { grid = -1; return; }
        (void)hipGetLastError();
        grid = cus;
        if (grid != 256) { fprintf(stderr, "kernel_launch: built for a 256-CU device (got %d)\n", cus); grid = -1; return; }
    }
    if (grid < 0) return;
    if (hipMemsetAsync((char*)d_ws + WS_CTL, 0, CTL_ZERO_BYTES, stream) != hipSuccess) return;
    Args a{};
    for (int i = 0; i < 36; ++i) a.in[i] = (const float*)d_in[i];
    a.out = (float*)d_out; a.ws = (unsigned char*)d_ws;
#if MK_ONE_LAUNCH
    a.ph_lo = 0; a.ph_hi = NPH;
    hipLaunchKernelGGL(mk_fwd<0xFFFu>, dim3(grid), dim3(512), LDS_BYTES, stream, a);
#endif
}
```

```cpp
#include <hip/hip_runtime.h>
#include <cstdio>
#include <cstdint>

#ifndef MK_ONE_LAUNCH
#define MK_ONE_LAUNCH 1
#endif

#define DI __device__ __forceinline__
#define GAS __attribute__((address_space(1)))
#define LAS __attribute__((address_space(3)))
typedef unsigned short bf16;
typedef short bf16x8 __attribute__((ext_vector_type(8)));
typedef float f32x4 __attribute__((ext_vector_type(4)));
typedef int i32x4 __attribute__((ext_vector_type(4)));
typedef unsigned u32x4 __attribute__((ext_vector_type(4)));
typedef unsigned u32x2 __attribute__((ext_vector_type(2)));
typedef float f32x16 __attribute__((ext_vector_type(16)));
typedef float f32x2 __attribute__((ext_vector_type(2)));
typedef short s16x4 __attribute__((ext_vector_type(4)));
typedef __bf16 bf16x2_t __attribute__((ext_vector_type(2)));
typedef short v4i16_t __attribute__((__vector_size__(4 * sizeof(short))));
#define MFMA32(a, b, c) __builtin_amdgcn_mfma_f32_32x32x16_bf16((a), (b), (c), 0, 0, 0)

constexpr int BATCH = 4, SEQ = 8192, T = BATCH * SEQ, D = 1024, DEPTH = 2;
constexpr int NIN = 2444, PLD = 2560, N1 = 6656, GLD = 4096;
constexpr int C_AX = 0, C_AG = 256, C_BQ = 512, C_BK = 768, C_BV = 896, C_CQ = 1024, C_CK = 1280, C_CV = 1536, C_DQ = 1792,
              C_KC = 2048, C_VC = 2112, C_KS = 2176, C_VS = 2240, C_KW = 2304, C_VW = 2368, C_DG = 2432;
constexpr int NCMP = 511;
constexpr int MOE_ROWS = 73728;
constexpr int PPL = 11;
constexpr int NPH = 2 * PPL + 1;

constexpr size_t MiB = 1u << 20;
constexpr size_t WS_CTL = 0, CTL_ZERO_BYTES = 1 * MiB;
constexpr size_t WS_KCVC = 1 * MiB;
constexpr size_t WS_LRUSUM = 2 * MiB;
constexpr size_t WS_REC = 2 * MiB + 256 * 1024;
constexpr size_t WS_ROWTOK = 3 * MiB;
constexpr size_t WS_ROWW = 3 * MiB + 512 * 1024;
constexpr size_t WS_WIN = 4 * MiB;
constexpr size_t WS_WQ = 4 * MiB;
constexpr size_t WS_WSC = 13 * MiB;
constexpr size_t WS_HSC = 13 * MiB + 65536;
constexpr size_t WS_HQ = 21 * MiB;
constexpr size_t WS_INVAS = 296 * MiB;
constexpr size_t WS_INVW = 300 * MiB;
constexpr size_t WS_XB = 373 * MiB;
constexpr size_t WS_WBR = 17 * MiB;
constexpr size_t WS_WOUT = 19 * MiB;
constexpr size_t WS_HB = 21 * MiB;
constexpr size_t WS_PROJ = 85 * MiB;
constexpr size_t WS_GATES = 245 * MiB;
constexpr size_t WS_WGU = 245 * MiB;
constexpr size_t WS_WD = 277 * MiB;
constexpr size_t WS_XS = 293 * MiB;
constexpr size_t WS_HMID = 437 * MiB;
constexpr size_t WS_XR = 85 * MiB;
constexpr size_t WS_RLOG = 213 * MiB;
constexpr size_t WS_WR = 501 * MiB;
constexpr size_t WS_WCMP = 502 * MiB;
constexpr size_t WS_CMPAB = 503 * MiB;
constexpr size_t WS_LRUW = 505 * MiB + 65536;
constexpr size_t WS_END = 506 * MiB;
constexpr int CW_BAR = 4096;
constexpr int CW_CNT = 16384;

constexpr int RING_BYTES = 131072;
constexpr int MISC_OFF = RING_BYTES;
constexpr int BIAS_OFF = MISC_OFF + 256;
constexpr int OFFT_OFF = BIAS_OFF + 129 * 12 * 4;
constexpr int PTAB_OFF = OFFT_OFF + (40 + 288 + 40) * 4;
constexpr int BIAS2_OFF = PTAB_OFF + 36 * 8;
constexpr int LRUEX_OFF = BIAS2_OFF + 129 * 12 * 4;
constexpr int LDS_BYTES = 163840;
constexpr int LRUCST_OFF = LRUEX_OFF + 8 * 64 * 2 * 4;
constexpr int LRUCAR_OFF = LRUCST_OFF + 3 * 64 * 4;
static_assert(PTAB_OFF % 8 == 0 && LRUCAR_OFF + 8 * 64 * 4 <= LDS_BYTES, "LDS map");

DI float bf2f(bf16 v) { return __builtin_bit_cast(float, (unsigned)v << 16); }
DI float lo_bf(unsigned w) { return __builtin_bit_cast(float, w << 16); }
DI float hi_bf(unsigned w) { return __builtin_bit_cast(float, w & 0xffff0000u); }
DI unsigned f2bf(float f) { unsigned u = __builtin_bit_cast(unsigned, f); return (u + 0x7fffu + ((u >> 16) & 1u)) >> 16; }
DI unsigned pk2(float lo, float hi) { return f2bf(lo) | (f2bf(hi) << 16); }
DI float rl(float v, int i) { return __builtin_bit_cast(float, __builtin_amdgcn_readlane(__builtin_bit_cast(int, v), i)); }
DI int rli(int v, int i) { return __builtin_amdgcn_readlane(v, i); }
DI int my_lane() { int l; asm volatile("v_mbcnt_lo_u32_b32 %0, -1, 0\n\tv_mbcnt_hi_u32_b32 %0, -1, %0" : "=v"(l)); return l; }
template <int O> DI int xshfl_i(int v) {
    if constexpr (O < 32) return __builtin_amdgcn_ds_swizzle(v, (O << 10) | 0x1f);
    else { const int l = my_lane(); return __builtin_amdgcn_ds_bpermute((l ^ 32) << 2, v); }
}
template <int O> DI float xshfl(float v) { return __builtin_bit_cast(float, xshfl_i<O>(__builtin_bit_cast(int, v))); }
DI float wave_sum(float v) { v += xshfl<1>(v); v += xshfl<2>(v); v += xshfl<4>(v); v += xshfl<8>(v); v += xshfl<16>(v); v += xshfl<32>(v); return v; }
DI float wave_max(float v) { v = fmaxf(v, xshfl<1>(v)); v = fmaxf(v, xshfl<2>(v)); v = fmaxf(v, xshfl<4>(v)); v = fmaxf(v, xshfl<8>(v)); v = fmaxf(v, xshfl<16>(v)); v = fmaxf(v, xshfl<32>(v)); return v; }
DI float sigmoidf_(float x) { return __builtin_amdgcn_rcpf(1.f + __builtin_amdgcn_exp2f(-1.4426950408889634f * x)); }
DI float gelu_tanh(float x) { const float u = 0.7978845608028654f * (x + 0.044715f * x * x * x); const float e = __expf(2.f * u); const float th = 1.f - 2.f * __builtin_amdgcn_rcpf(e + 1.f); return 0.5f * x * (1.f + th); }
DI float softplusf_(float x) { return fmaxf(x, 0.f) + log1pf(__expf(-fabsf(x))); }
#define LDS_WAIT() asm volatile("s_waitcnt lgkmcnt(0)" ::: "memory")
#define VM_WAIT() asm volatile("s_waitcnt vmcnt(0)" ::: "memory")

__device__ const unsigned char T5_BUCKET[128] = {
0,1,2,3,4,5,6,7,8,9,10,11,12,13,14,15,16,16,16,17,17,18,18,18,19,19,19,20,20,20,20,21,21,21,21,22,22,22,22,22,23,23,23,23,23,23,24,24,24,24,24,24,25,25,25,25,25,25,25,26,26,26,26,26,26,26,26,27,27,27,27,27,27,27,27,27,27,28,28,28,28,28,28,28,28,28,28,29,29,29,29,29,29,29,29,29,29,29,29,30,30,30,30,30,30,30,30,30,30,30,30,30,30,31,31,31,31,31,31,31,31,31,31,31,31,31,31,31};

#define XB_TMO      128
#define XB_XCNT(j)  (256  + 64 * (j))
#define XB_XSUB(j)  (1280 + 64 * (j))
#define XB_XGEN(j)  (2304 + 64 * (j))
#define XB_TOP      3328
#define XB_TOPGEN   3392
#define XCD_BAR_WORDS 3456
#define XB_SPIN_CAP (1u << 22)
DI unsigned xb_ld(unsigned* p)              { return __hip_atomic_load(p, __ATOMIC_RELAXED, __HIP_MEMORY_SCOPE_AGENT); }
DI unsigned xb_add(unsigned* p, unsigned v) { return __hip_atomic_fetch_add(p, v, __ATOMIC_RELAXED, __HIP_MEMORY_SCOPE_AGENT); }
DI unsigned xb_xcc_id() { return (unsigned)__builtin_amdgcn_s_getreg((3 << 11) | 20) & 0xFu; }
#define XB_SPIN(cond, bar) do { unsigned _sp = 0; while (cond) { __builtin_amdgcn_s_sleep(1); \
    if ((++_sp & 255u) == 0u) { if (xb_ld(&(bar)[XB_TMO])) break; if (_sp > XB_SPIN_CAP) { atomicAdd(&(bar)[XB_TMO], 1u); break; } } } } while (0)
struct XcdBarrier { unsigned* bar; unsigned x; volatile LAS unsigned* st; };
DI XcdBarrier xcd_barrier_post(unsigned* bar, volatile LAS unsigned* st, bool leader) {
    XcdBarrier b; b.bar = bar; b.x = xb_xcc_id(); b.st = st;
    if (leader) (void)xb_add(&bar[XB_XCNT(b.x)], 1u);
    return b;
}
DI void xcd_barrier_complete(unsigned* bar, unsigned x, unsigned& nloc, unsigned& nx) {
    const unsigned G = gridDim.x * gridDim.y * gridDim.z;
    unsigned sum, cnt, mine, sp = 0u;
    for (;;) {
        sum = 0u; cnt = 0u; mine = 0u;
#pragma unroll
        for (unsigned j = 0; j < 16; ++j) { const unsigned c = xb_ld(&bar[XB_XCNT(j)]); sum += c; cnt += (c > 0u) ? 1u : 0u; mine = (j == x) ? c : mine; }
        if (sum == G) break;
        __builtin_amdgcn_s_sleep(1);
        if ((++sp & 255u) == 0u) { if (xb_ld(&bar[XB_TMO])) break; if (sp > XB_SPIN_CAP) { atomicAdd(&bar[XB_TMO], 1u); break; } }
    }
    nloc = mine > 0u ? mine : 1u; nx = cnt > 0u ? cnt : 1u;
}
DI void xcd_barrier(const XcdBarrier& b, bool leader) {
    asm volatile("s_waitcnt vmcnt(0)" ::: "memory");
    __syncthreads();
    if (leader) {
        unsigned* bar = b.bar;
        __builtin_amdgcn_s_waitcnt(0);
        unsigned nloc = b.st[0], nx = b.st[1];
        if (nloc == 0u) { xcd_barrier_complete(bar, b.x, nloc, nx); b.st[0] = nloc; b.st[1] = nx; }
        const unsigned old = xb_add(&bar[XB_XSUB(b.x)], 1u);
        const unsigned gen = old / nloc;
        if (old + 1u == (gen + 1u) * nloc) {
            __builtin_amdgcn_fence(__ATOMIC_RELEASE, "agent");
            asm volatile("s_waitcnt vmcnt(0)" ::: "memory");
            const unsigned og = xb_add(&bar[XB_TOP], 1u);
            const unsigned tg = og / nx;
            if (og + 1u == (tg + 1u) * nx) xb_add(&bar[XB_TOPGEN], 1u);
            else XB_SPIN(xb_ld(&bar[XB_TOPGEN]) == tg, bar);
            __builtin_amdgcn_fence(__ATOMIC_ACQUIRE, "agent");
            xb_add(&bar[XB_XGEN(b.x)], 1u);
            asm volatile("s_waitcnt vmcnt(0)" ::: "memory");
        } else {
            XB_SPIN(xb_ld(&bar[XB_XGEN(b.x)]) == gen, bar);
            __builtin_amdgcn_fence(__ATOMIC_ACQUIRE, "agent");
            asm volatile("s_waitcnt vmcnt(0)" ::: "memory");
        }
    }
    __syncthreads();
}

namespace pg8 {
constexpr int BM = 256, BK = 64, HALF = 128, HTB = HALF * BK * 2;
__host__ __device__ __forceinline__ int lds_byte(int r, int c) { const int st = (r >> 4) * 2 + (c >> 5), rr = r & 15, cc = c & 31, ob = rr * 64 + cc * 2; return st * 1024 + (ob ^ (((ob >> 9) & 1) << 5)); }
__host__ __device__ __forceinline__ void stage_rc(int b, int& R, int& C) { const int st = b / 1024, sb = b % 1024, swz = sb ^ (((sb >> 9) & 1) << 5); R = (st >> 1) * 16 + swz / 64; C = (st & 1) * 32 + (swz % 64) / 2; }
__host__ __device__ __forceinline__ int perm32(int rho) { const int n = rho >> 4, i = rho & 15; return 8 * (i >> 2) + 4 * n + (i & 3); }
struct Unit { const char* a; const char* b; int pm, pn, aux, pad; };
struct Gemm { int K, lda, ldb, kstepA, hstepA; };
template <bool I8> struct AccT { typedef f32x4 type; };
template <> struct AccT<true> { typedef i32x4 type; };
template <class Epi, class Sched, bool GATHER = false, bool I8 = false>
DI void gemm_phase(LAS unsigned char* lds, const Gemm g, const Sched& S, const Epi& E, int tid_in) {
    int tid = tid_in; asm volatile("" : "+v"(tid));
    const int wid = __builtin_amdgcn_readfirstlane(tid >> 6), lane = tid & 63, wr = wid >> 2, wc = wid & 3, fr = lane & 15, fq = lane >> 4;
    const int K = g.K, nt = K / BK;
    unsigned voffA[2], voffB[2];
#pragma unroll
    for (int i = 0; i < 2; ++i) { int R, C; stage_rc(tid * 16 + i * 8192, R, C); const int Rb = (R & ~31) + perm32(R & 31);
        voffA[i] = (unsigned)(R * g.lda + C) * 2u; voffB[i] = (unsigned)(Rb * g.ldb + C) * 2u; }
    const size_t kstep = (size_t)(BK * 2), kstepA = (size_t)g.kstepA;
    const size_t hstepA = g.hstepA < 0 ? (size_t)HALF * g.lda * 2 : (size_t)g.hstepA, hstepB = (size_t)HALF * g.ldb * 2;
    const unsigned hstepA32 = (unsigned)hstepA;
    unsigned gC[2][2] = {{0u, 0u}, {0u, 0u}}, gN[2][2] = {{0u, 0u}, {0u, 0u}};
    const unsigned ldsw = (unsigned)wid * 1024u;
    const int aoff = lds_byte(wr * 64 + fr, fq * 8), boff = lds_byte(wc * 32 + fr, fq * 8);
#define PG8_SA(b, h) (((b) * 2 + (h)) * HTB)
#define PG8_SB(b, h) ((4 + (b) * 2 + (h)) * HTB)
#define PG8_STAGE(bufoff, gbase, voff) do { _Pragma("unroll") for (int _i = 0; _i < 2; ++_i) \
        __builtin_amdgcn_global_load_lds((const unsigned*)((const char*)(gbase) + (voff)[_i]), (LAS unsigned*)(lds + (bufoff) + ldsw + _i * 8192), 16, 0, 0); } while (0)
#define PG8_STAGEA(bufoff, gbase, h, nextsel) do { _Pragma("unroll") for (int _i = 0; _i < 2; ++_i) { \
        const unsigned _o = GATHER ? ((nextsel) ? gN[h][_i] : gC[h][_i]) : (voffA[_i] + (unsigned)(h) * hstepA32); \
        __builtin_amdgcn_global_load_lds((const unsigned*)((const char*)(gbase) + _o), (LAS unsigned*)(lds + (bufoff) + ldsw + _i * 8192), 16, 0, 0); } } while (0)
#define PG8_LDA(dst, b, h) do { _Pragma("unroll") for (int m = 0; m < 4; ++m) _Pragma("unroll") for (int k = 0; k < 2; ++k) dst[m][k] = *(const LAS bf16x8*)(lds + PG8_SA(b, h) + aoff + m * 2048 + k * 1024); } while (0)
#define PG8_LDB(dst, b, h) do { _Pragma("unroll") for (int n = 0; n < 2; ++n) _Pragma("unroll") for (int k = 0; k < 2; ++k) dst[n][k] = *(const LAS bf16x8*)(lds + PG8_SB(b, h) + boff + n * 2048 + k * 1024); } while (0)
#define PG8_MMA(ai, bj, At, Bt) do { __builtin_amdgcn_s_setprio(1); _Pragma("unroll") for (int m = 0; m < 4; ++m) _Pragma("unroll") for (int n = 0; n < 2; ++n) _Pragma("unroll") for (int k = 0; k < 2; ++k) \
        { if constexpr (I8) acc[ai][bj][m][n] = __builtin_amdgcn_mfma_i32_16x16x64_i8(__builtin_bit_cast(i32x4, Bt[n][k]), __builtin_bit_cast(i32x4, At[m][k]), acc[ai][bj][m][n], 0, 0, 0); \
          else acc[ai][bj][m][n] = __builtin_amdgcn_mfma_f32_16x16x32_bf16(Bt[n][k], At[m][k], acc[ai][bj][m][n], 0, 0, 0); } __builtin_amdgcn_s_setprio(0); } while (0)
#define PG8_WAIT_V(n) asm volatile("s_waitcnt vmcnt(" #n ")" ::: "memory")
#define PG8_WAIT_L(n) asm volatile("s_waitcnt lgkmcnt(" #n ")" ::: "memory")
#define PG8_BAR __builtin_amdgcn_s_barrier()
#define PG8_SCHED __builtin_amdgcn_sched_barrier(0)
    Unit cur, nxt; int ui = 0;
    if (!S.next(0, cur)) return;
    typedef typename AccT<I8>::type ACC;
    ACC acc[2][2][4][2];
#pragma unroll
    for (int a = 0; a < 2; ++a)
#pragma unroll
        for (int b = 0; b < 2; ++b)
#pragma unroll
            for (int m = 0; m < 4; ++m)
#pragma unroll
                for (int n = 0; n < 2; ++n) acc[a][b][m][n] = (ACC){0, 0, 0, 0};
    bf16x8 At[4][2], B0[2][2], B1[2][2];
    const char* cA = cur.a; const char* cB = cur.b;
    if constexpr (GATHER) S.rows(cur, tid, gC);
    PG8_STAGE(PG8_SB(0, 0), cB, voffB); PG8_STAGE(PG8_SB(0, 1), cB + hstepB, voffB); PG8_STAGEA(PG8_SA(0, 0), cA, 0, false); PG8_STAGEA(PG8_SA(0, 1), cA, 1, false);
    if (wr == 1) PG8_BAR;
    PG8_WAIT_V(2); PG8_BAR;
    PG8_STAGE(PG8_SB(1, 0), cB + kstep, voffB); PG8_STAGEA(PG8_SA(1, 0), cA + kstepA, 0, false); PG8_STAGE(PG8_SB(1, 1), cB + hstepB + kstep, voffB);
    PG8_WAIT_V(6); PG8_BAR;
    for (;;) {
        const bool has_next = S.next(ui + 1, nxt);
        const char* nA = has_next ? nxt.a : cA; const char* nB = has_next ? nxt.b : cB;
        if constexpr (GATHER) { if (has_next) S.rows(nxt, tid, gN); else {
#pragma unroll
            for (int h = 0; h < 2; ++h) { gN[h][0] = gC[h][0]; gN[h][1] = gC[h][1]; } } }
        for (int t = 0; t < nt; t += 2) {
            const bool last = (t == nt - 2);
            const char* a1 = cA + (size_t)(t + 1) * kstepA;
            const char* a2 = last ? nA : cA + (size_t)(t + 2) * kstepA; const char* b2 = last ? nB : cB + (size_t)(t + 2) * kstep;
            const char* a3 = a2 + kstepA; const char* b3 = b2 + kstep;
            PG8_LDB(B0, 0, 0); PG8_LDB(B1, 0, 1); PG8_SCHED; PG8_LDA(At, 0, 0); PG8_STAGEA(PG8_SA(1, 1), a1, 1, false);
            PG8_WAIT_V(8); PG8_WAIT_L(0); PG8_BAR; PG8_MMA(0, 0, At, B0); PG8_MMA(0, 1, At, B1); PG8_BAR; PG8_SCHED;
            PG8_LDA(At, 0, 1); PG8_STAGE(PG8_SB(0, 0), b2, voffB); PG8_STAGE(PG8_SB(0, 1), b2 + hstepB, voffB); PG8_STAGEA(PG8_SA(0, 0), a2, 0, last);
            PG8_WAIT_V(8); PG8_WAIT_L(0); PG8_BAR; PG8_MMA(1, 0, At, B0); PG8_MMA(1, 1, At, B1); PG8_BAR; PG8_SCHED;
            PG8_LDB(B0, 1, 0); PG8_LDB(B1, 1, 1); PG8_SCHED; PG8_LDA(At, 1, 0); PG8_STAGEA(PG8_SA(0, 1), a2, 1, last);
            PG8_WAIT_V(8); PG8_WAIT_L(0); PG8_BAR; PG8_MMA(0, 0, At, B0); PG8_MMA(0, 1, At, B1); PG8_BAR; PG8_SCHED;
            PG8_LDA(At, 1, 1); PG8_STAGE(PG8_SB(1, 0), b3, voffB); PG8_STAGE(PG8_SB(1, 1), b3 + hstepB, voffB); PG8_STAGEA(PG8_SA(1, 0), a3, 0, last);
            PG8_WAIT_V(8); PG8_WAIT_L(0); PG8_BAR; PG8_MMA(1, 0, At, B0); PG8_MMA(1, 1, At, B1); PG8_BAR; PG8_SCHED;
        }
        if (wr == 0) PG8_BAR;
        { const int el = my_lane(); E(acc, cur, wr, wc, el & 15, el >> 4); }
        if (!has_next) break;
        bool carried = false;
        if constexpr (Epi::CARRY) { if (nxt.aux != 0) { const int el = my_lane(); E.carry(acc, nxt, wr, wc, el & 15, el >> 4); carried = true; } }
        if (!carried) {
#pragma unroll
        for (int a = 0; a < 2; ++a)
#pragma unroll
            for (int b = 0; b < 2; ++b)
#pragma unroll
                for (int m = 0; m < 4; ++m)
#pragma unroll
                    for (int n = 0; n < 2; ++n) acc[a][b][m][n] = (ACC){0, 0, 0, 0};
        }
        cur = nxt; cA = nA; cB = nB; ++ui;
        if constexpr (GATHER) {
#pragma unroll
            for (int h = 0; h < 2; ++h) { gC[h][0] = gN[h][0]; gC[h][1] = gN[h][1]; } }
        if (wr == 1) PG8_BAR;
    }
    PG8_WAIT_V(0);
    PG8_BAR;
#undef PG8_SA
#undef PG8_SB
#undef PG8_STAGE
#undef PG8_STAGEA
#undef PG8_LDA
#undef PG8_LDB
#undef PG8_MMA
#undef PG8_WAIT_V
#undef PG8_WAIT_L
#undef PG8_BAR
#undef PG8_SCHED
}
}
using pg8::Unit;

DI unsigned cvt_pk_bf16(float lo, float hi) { unsigned r; asm volatile("s_nop 1\n\tv_cvt_pk_bf16_f32 %0, %1, %2" : "=v"(r) : "v"(lo), "v"(hi)); return r; }
DI u32x4 pack8(const f32x4& v0, const f32x4& v1) { u32x4 w; w.x = cvt_pk_bf16(v0[0], v0[1]); w.y = cvt_pk_bf16(v0[2], v0[3]); w.z = cvt_pk_bf16(v1[0], v1[1]); w.w = cvt_pk_bf16(v1[2], v1[3]); return w; }

struct SchedP1 {
    const char* A; const char* B; int nM, nN, rbA, rbB, G, c;
    DI bool next(int i, Unit& u) const {
        constexpr int NXCD = 8, WGM = 8; const int nwg = nM * nN;
        const long L = (long)i * G + c; if (L >= nwg) return false;
        int wgid = (int)L; { const int q = nwg / NXCD, r = nwg % NXCD, xcd = wgid % NXCD, off = wgid / NXCD; wgid = (xcd < r ? xcd * (q + 1) : r * (q + 1) + (xcd - r) * q) + off; }
        const int nig = WGM * nN, gid = wgid / nig, fm = gid * WGM, gsz = (nM - fm) < WGM ? (nM - fm) : WGM;
        u.pm = fm + ((wgid % nig) % gsz); u.pn = (wgid % nig) / gsz; u.aux = 0; u.pad = 0;
        u.a = A + (size_t)u.pm * 256 * rbA; u.b = B + (size_t)u.pn * 256 * rbB; return true;
    }
};
struct SchedP3a {
    const char* ys; const char* wbr; int G, c;
    DI bool next(int i, Unit& u) const {
        const int tile = (i >> 2) * G + c; if (tile >= 512) return false;
        const int br = i & 3; u.pm = tile >> 2; u.pn = tile & 3; u.aux = br; u.pad = 0;
        u.a = ys + ((size_t)u.pm * 256 * 1024 + br * 256) * 2; u.b = wbr + ((size_t)br * 1024 * 256 + (size_t)u.pn * 256 * 256) * 2; return true;
    }
};
struct SchedP3b {
    const char* A; const char* B; int G, c;
    DI bool next(int i, Unit& u) const {
        const int L = i * G + c; if (L >= 512) return false;
        u.pm = L >> 2; u.pn = L & 3; u.aux = 0; u.pad = 0;
        u.a = A + (size_t)u.pm * 256 * 1024 * 2; u.b = B + (size_t)u.pn * 256 * 1024 * 2; return true;
    }
};
struct SchedM2 {
    const char* xr; const char* wgu; const LAS int* offt; const int* rowsrc; int G, c;
    DI bool next(int i, Unit& u) const {
        const int NT = __builtin_amdgcn_readfirstlane(offt[32]) >> 8; const int L = i * G + c; if (L >= NT * 2) return false;
        const int rt = L >> 1, pn = L & 1; const int e = __builtin_amdgcn_readfirstlane(offt[40 + rt]);
        u.pm = rt; u.pn = pn; u.aux = e; u.pad = 0;
        u.a = xr; u.b = wgu + ((size_t)e * 512 + pn * 256) * 1024 * 2; return true;
    }
    DI void rows(const Unit& u, int tid, unsigned (&g)[2][2]) const {
        const int e = u.aux; const int base = u.pm * 256 - __builtin_amdgcn_readfirstlane(offt[e]), cnt = __builtin_amdgcn_readfirstlane(offt[330 + e]);
#pragma unroll
        for (int i = 0; i < 2; ++i) { int R, C; pg8::stage_rc(tid * 16 + i * 8192, R, C);
#pragma unroll
            for (int h = 0; h < 2; ++h) { const int lr = base + h * 128 + R; const int as = lr < cnt ? rowsrc[e * 32768 + lr] : 0;
                g[h][i] = (unsigned)(as >> 1) * 4096u + (unsigned)C * 2u; } }
    }
};
struct SchedM3 {
    const char* hmid; const char* wd; const LAS int* offt; int G, c;
    DI bool next(int i, Unit& u) const {
        const int NT = __builtin_amdgcn_readfirstlane(offt[32]) >> 8; const int L = i * G + c; if (L >= NT * 4) return false;
        const int rt = L >> 2, pn = L & 3; const int e = __builtin_amdgcn_readfirstlane(offt[40 + rt]);
        u.pm = rt; u.pn = pn; u.aux = e; u.pad = 0;
        u.a = hmid + (size_t)rt * 256 * 256 * 2; u.b = wd + ((size_t)e * 1024 + pn * 256) * 256 * 2; return true;
    }
};

struct EpiP1I8 {
    static constexpr bool CARRY = false;
    bf16* proj; unsigned char* gates; const float* bgate; const float* hsc; const float* wsc;
    DI void operator()(const i32x4 (&acc)[2][2][4][2], const Unit& u, int wr, int wc, int fr, int fq) const {
        const int row0 = u.pm * 256 + wr * 64 + fr;
        if (u.pn < 10) { const int colt = u.pn * 256 + wc * 32 + 8 * fq;
            f32x4 sv[2][2]; float rsv[2][4];
#pragma unroll
            for (int bj = 0; bj < 2; ++bj)
#pragma unroll
                for (int n = 0; n < 2; ++n) sv[bj][n] = *(const GAS f32x4*)((const GAS float*)wsc + colt + bj * 128 + 4 * n);
#pragma unroll
            for (int ai = 0; ai < 2; ++ai)
#pragma unroll
                for (int m = 0; m < 4; ++m) rsv[ai][m] = ((const GAS float*)hsc)[row0 + ai * 128 + m * 16];
#pragma unroll
            for (int ai = 0; ai < 2; ++ai)
#pragma unroll
                for (int m = 0; m < 4; ++m) { bf16* rowp = proj + (size_t)(row0 + ai * 128 + m * 16) * PLD + colt; const float rs = rsv[ai][m];
#pragma unroll
                    for (int bj = 0; bj < 2; ++bj) { f32x4 v0, v1;
#pragma unroll
                        for (int e = 0; e < 4; ++e) { v0[e] = (float)acc[ai][bj][m][0][e] * (rs * sv[bj][0][e]); v1[e] = (float)acc[ai][bj][m][1][e] * (rs * sv[bj][1][e]); }
                        *(u32x4*)(rowp + bj * 128) = pack8(v0, v1); } }
            return; }
        const int gcol = (u.pn - 10) * 256 + wc * 32 + 8 * fq; const float* wsc = this->wsc + 2560;
        f32x4 bv[2][2], sv[2][2];
#pragma unroll
        for (int bj = 0; bj < 2; ++bj)
#pragma unroll
            for (int n = 0; n < 2; ++n) { bv[bj][n] = *(const f32x4*)(bgate + gcol + bj * 128 + 4 * n); sv[bj][n] = *(const f32x4*)(wsc + gcol + bj * 128 + 4 * n); }
        float rsv[2][4];
#pragma unroll
        for (int ai = 0; ai < 2; ++ai)
#pragma unroll
            for (int m = 0; m < 4; ++m) rsv[ai][m] = ((const GAS float*)hsc)[row0 + ai * 128 + m * 16];
#pragma unroll
        for (int ai = 0; ai < 2; ++ai)
#pragma unroll
            for (int m = 0; m < 4; ++m) { const float rs = rsv[ai][m];
                unsigned char* rowp = gates + ((size_t)(u.pm * 16 + (u.pn - 10)) * 65536 + (size_t)((ai * 4 + m) * 8192 + (wr * 4 + wc) * 512 + (fq * 16 + fr) * 8));
#pragma unroll
                for (int bj = 0; bj < 2; ++bj) { unsigned q[8];
#pragma unroll
                    for (int n = 0; n < 2; ++n)
#pragma unroll
                        for (int e = 0; e < 4; ++e) { const float pre = (float)acc[ai][bj][m][n][e] * (rs * sv[bj][n][e]) + bv[bj][n][e];
                            q[4 * n + e] = (unsigned)fminf(256.f * sigmoidf_(pre), 255.5f); }
                    u32x2 w; w.x = q[0] | (q[1] << 8) | (q[2] << 16) | (q[3] << 24); w.y = q[4] | (q[5] << 8) | (q[6] << 16) | (q[7] << 24);
                    *(u32x2*)(rowp + bj * 4096) = w; }
                __builtin_amdgcn_sched_barrier(0); }
    }
};
struct EpiP3a {
    static constexpr bool CARRY = true;
    bf16* merged; const unsigned char* gates;
    DI void carry(f32x4 (&acc)[2][2][4][2], const Unit& u, int wr, int wc, int fr, int fq) const {
        const GAS unsigned char* gb = (const GAS unsigned char*)gates + (size_t)(u.pm * 16 + (u.aux - 1) * 4 + u.pn) * 65536;
        const unsigned go = (unsigned)((wr * 4 + wc) * 512 + (fq * 16 + fr) * 8);
        u32x2 gp[2][4][2], gn[2][4][2];
#pragma unroll
        for (int ai = 0; ai < 2; ++ai)
#pragma unroll
            for (int m = 0; m < 4; ++m)
#pragma unroll
                for (int bj = 0; bj < 2; ++bj) { gp[ai][m][bj] = *(const GAS u32x2*)(gb + go + (unsigned)(((ai * 4 + m) * 2 + bj) * 4096));
                    gn[ai][m][bj] = *(const GAS u32x2*)(gb + go + (unsigned)(((ai * 4 + m) * 2 + bj) * 4096 + 4 * 65536)); }
#pragma unroll
        for (int ai = 0; ai < 2; ++ai) {
#pragma unroll
            for (int m = 0; m < 4; ++m)
#pragma unroll
                for (int bj = 0; bj < 2; ++bj) {
#pragma unroll
                    for (int n = 0; n < 2; ++n) { const unsigned p4 = n ? gp[ai][m][bj].y : gp[ai][m][bj].x, n4 = n ? gn[ai][m][bj].y : gn[ai][m][bj].x;
#pragma unroll
                        for (int e = 0; e < 4; ++e) acc[ai][bj][m][n][e] *= ((float)((p4 >> (8 * e)) & 255u) + 0.5f) * __builtin_amdgcn_rcpf((float)((n4 >> (8 * e)) & 255u) + 0.5f); } }
            __builtin_amdgcn_sched_barrier(0); }
    }
    DI void operator()(const f32x4 (&acc)[2][2][4][2], const Unit& u, int wr, int wc, int fr, int fq) const {
        if (u.aux != 3) return;
        const GAS unsigned char* gb = (const GAS unsigned char*)gates + (size_t)(u.pm * 16 + 3 * 4 + u.pn) * 65536;
        GAS unsigned char* mb = (GAS unsigned char*)merged + ((size_t)(u.pm * 256) * 1024 + u.pn * 256) * 2;
        const unsigned go = (unsigned)((wr * 4 + wc) * 512 + (fq * 16 + fr) * 8), mo = (unsigned)((wr * 64 + fr) * 1024 + wc * 32 + 8 * fq) * 2u;
        u32x2 gw[2][4][2];
#pragma unroll
        for (int ai = 0; ai < 2; ++ai)
#pragma unroll
            for (int m = 0; m < 4; ++m)
#pragma unroll
                for (int bj = 0; bj < 2; ++bj) gw[ai][m][bj] = *(const GAS u32x2*)(gb + go + (unsigned)(((ai * 4 + m) * 2 + bj) * 4096));
#pragma unroll
        for (int ai = 0; ai < 2; ++ai) {
#pragma unroll
            for (int m = 0; m < 4; ++m)
#pragma unroll
                for (int bj = 0; bj < 2; ++bj) {
                    f32x4 v0 = acc[ai][bj][m][0], v1 = acc[ai][bj][m][1]; const u32x2 g2 = gw[ai][m][bj]; const float k256 = 0.00390625f;
#pragma unroll
                    for (int e = 0; e < 4; ++e) { v0[e] *= ((float)((g2.x >> (8 * e)) & 255u) + 0.5f) * k256; v1[e] *= ((float)((g2.y >> (8 * e)) & 255u) + 0.5f) * k256; }
                    *(GAS u32x4*)(mb + mo + (unsigned)((ai * 128 + m * 16) * 1024 + bj * 128) * 2u) = pack8(v0, v1); }
            __builtin_amdgcn_sched_barrier(0); }
    }
};
template <bool XF32> struct EpiP3b {
    static constexpr bool CARRY = false;
    const float* xin; bf16* xb_;
    DI void operator()(const f32x4 (&acc)[2][2][4][2], const Unit& u, int wr, int wc, int fr, int fq) const {
        GAS unsigned char* ob = (GAS unsigned char*)xb_ + ((size_t)(u.pm * 256) * 1024 + u.pn * 256) * 2;
        const unsigned lo = (unsigned)((wr * 64 + fr) * 1024 + wc * 32 + 8 * fq);
        if constexpr (XF32) {
            const GAS unsigned char* xb = (const GAS unsigned char*)xin + ((size_t)(u.pm * 256) * 1024 + u.pn * 256) * 4;
#pragma unroll
            for (int ai = 0; ai < 2; ++ai)
#pragma unroll
                for (int mh = 0; mh < 2; ++mh) {
                    f32x4 xv[2][2][2];
#pragma unroll
                    for (int m2 = 0; m2 < 2; ++m2)
#pragma unroll
                        for (int bj = 0; bj < 2; ++bj)
#pragma unroll
                            for (int n = 0; n < 2; ++n) xv[m2][bj][n] = *(const GAS f32x4*)(xb + (lo + (unsigned)((ai * 128 + (mh * 2 + m2) * 16) * 1024 + bj * 128 + 4 * n)) * 4u);
#pragma unroll
                    for (int m2 = 0; m2 < 2; ++m2)
#pragma unroll
                        for (int bj = 0; bj < 2; ++bj)
                            *(GAS u32x4*)(ob + (lo + (unsigned)((ai * 128 + (mh * 2 + m2) * 16) * 1024 + bj * 128)) * 2u) = pack8(xv[m2][bj][0] + acc[ai][bj][mh * 2 + m2][0], xv[m2][bj][1] + acc[ai][bj][mh * 2 + m2][1]);
                    __builtin_amdgcn_sched_barrier(0); }
        } else {
#pragma unroll
            for (int ai = 0; ai < 2; ++ai) {
                u32x4 xv[4][2];
#pragma unroll
                for (int m = 0; m < 4; ++m)
#pragma unroll
                    for (int bj = 0; bj < 2; ++bj) xv[m][bj] = *(const GAS u32x4*)(ob + (lo + (unsigned)((ai * 128 + m * 16) * 1024 + bj * 128)) * 2u);
#pragma unroll
                for (int m = 0; m < 4; ++m)
#pragma unroll
                    for (int bj = 0; bj < 2; ++bj) { const u32x4 x4 = xv[m][bj]; f32x4 v0 = acc[ai][bj][m][0], v1 = acc[ai][bj][m][1];
                        v0[0] += lo_bf(x4.x); v0[1] += hi_bf(x4.x); v0[2] += lo_bf(x4.y); v0[3] += hi_bf(x4.y); v1[0] += lo_bf(x4.z); v1[1] += hi_bf(x4.z); v1[2] += lo_bf(x4.w); v1[3] += hi_bf(x4.w);
                        *(GAS u32x4*)(ob + (lo + (unsigned)((ai * 128 + m * 16) * 1024 + bj * 128)) * 2u) = pack8(v0, v1); }
                __builtin_amdgcn_sched_barrier(0); }
        }
    }
};
struct EpiM2 {
    static constexpr bool CARRY = false;
    bf16* hmid;
    DI void operator()(const f32x4 (&acc)[2][2][4][2], const Unit& u, int wr, int wc, int fr, int fq) const {
        const int row0 = u.pm * 256 + wr * 64 + fr; const int col = u.pn * 128 + wc * 32 + 8 * fq;
#pragma unroll
        for (int ai = 0; ai < 2; ++ai)
#pragma unroll
            for (int m = 0; m < 4; ++m) { f32x4 h0, h1;
#pragma unroll
                for (int e = 0; e < 4; ++e) { const float g0 = acc[ai][0][m][0][e], g1 = acc[ai][0][m][1][e];
                    h0[e] = g0 * sigmoidf_(g0) * acc[ai][1][m][0][e]; h1[e] = g1 * sigmoidf_(g1) * acc[ai][1][m][1][e]; }
                *(u32x4*)(hmid + (size_t)(row0 + ai * 128 + m * 16) * 256 + col) = pack8(h0, h1); }
    }
};
struct EpiM3 {
    static constexpr bool CARRY = false;
    bf16* eo; const int* rowtok; const float* roww; const LAS int* offt;
    DI void operator()(const f32x4 (&acc)[2][2][4][2], const Unit& u, int wr, int wc, int fr, int fq) const {
        const int e = u.aux; const int cnt = __builtin_amdgcn_readfirstlane(offt[330 + e]);
        const int lr0 = u.pm * 256 - __builtin_amdgcn_readfirstlane(offt[e]) + wr * 64 + fr; const int colt = u.pn * 256 + wc * 32 + 8 * fq;
        int tk[2][4]; float wv[2][4];
#pragma unroll
        for (int ai = 0; ai < 2; ++ai)
#pragma unroll
            for (int m = 0; m < 4; ++m) { const int lr = lr0 + ai * 128 + m * 16; tk[ai][m] = -1; wv[ai][m] = 0.f;
                if (lr < cnt) { tk[ai][m] = ((const GAS int*)rowtok)[e * 32768 + lr]; wv[ai][m] = ((const GAS float*)roww)[e * 32768 + lr]; } }
#pragma unroll
        for (int ai = 0; ai < 2; ++ai)
#pragma unroll
            for (int m = 0; m < 4; ++m) {
                if (tk[ai][m] >= 0) { const float w = wv[ai][m]; GAS bf16* op = (GAS bf16*)eo + (size_t)tk[ai][m] * 1024 + colt;
#pragma unroll
                    for (int bj = 0; bj < 2; ++bj) *(GAS u32x4*)(op + bj * 128) = pack8(acc[ai][bj][m][0] * w, acc[ai][bj][m][1] * w); }
                __builtin_amdgcn_sched_barrier(0); }
    }
};

struct Args { const float* in[36]; float* out; unsigned char* ws; int ph_lo, ph_hi; };
struct InTab { unsigned base;
    DI const float* operator[](int i) const { unsigned long long v; const unsigned addr = base + (unsigned)i * 8u;
        asm volatile("ds_read_b64 %0, %1\n\ts_waitcnt lgkmcnt(0)" : "=v"(v) : "v"(addr) : "memory");
        const unsigned lo = __builtin_amdgcn_readfirstlane((unsigned)v), hi = __builtin_amdgcn_readfirstlane((unsigned)(v >> 32));
        return (const float*)(((unsigned long long)hi << 32) | lo); } };
struct KA { InTab in; float* out; unsigned char* ws; };

DI void transpose_item(const float* W_, int ldw, int nvalid, bf16* WT_, int ldt, int k0, int n0, int dst_row0, LAS float* scr, int lane) {
    const GAS float* W = (const GAS float*)W_; GAS bf16* WT = (GAS bf16*)WT_;
    const int nq = 4 * (lane & 7), kr8 = lane >> 3;
    f32x4 v[8];
#pragma unroll
    for (int i = 0; i < 8; ++i) { const int kk = 8 * i + kr8;
        if (n0 + nq + 3 < nvalid) v[i] = *(const GAS f32x4*)(W + (size_t)(k0 + kk) * ldw + n0 + nq);
        else {
#pragma unroll
            for (int e = 0; e < 4; ++e) v[i][e] = (n0 + nq + e < nvalid) ? W[(size_t)(k0 + kk) * ldw + n0 + nq + e] : 0.f; } }
#pragma unroll
    for (int i = 0; i < 8; ++i) { const int kk = 8 * i + kr8;
#pragma unroll
        for (int e = 0; e < 4; ++e) scr[kk * 33 + nq + e] = v[i][e]; }
    LDS_WAIT(); asm volatile("" ::: "memory");
    const int c = lane & 7;
#pragma unroll
    for (int j = 0; j < 4; ++j) { const int n = (lane >> 3) + 8 * j; const LAS float* s = scr + (8 * c) * 33 + n;
        u32x4 o; o.x = pk2(s[0 * 33], s[1 * 33]); o.y = pk2(s[2 * 33], s[3 * 33]); o.z = pk2(s[4 * 33], s[5 * 33]); o.w = pk2(s[6 * 33], s[7 * 33]);
        if (n0 + n < nvalid) *(GAS u32x4*)(WT + (size_t)(dst_row0 + n) * ldt + k0 + 8 * c) = o; }
    LDS_WAIT(); asm volatile("" ::: "memory");
}
DI void phase0_weights(const KA& a, int l, LAS unsigned char* lds, int gw, int NGW, int wave, int lane) {
    LAS float* scr = (LAS float*)(lds + wave * 16384);
    const float* w_in = a.in[4] + (size_t)l * 1024 * NIN;
    const float* w_gate = a.in[24] + (size_t)l * 4 * 1024 * 1024;
    const float* w_br = a.in[26] + (size_t)l * 4 * 256 * 1024;
    const float* w_out = a.in[27] + (size_t)l * 1024 * 1024;
    bf16* Wt_in = (bf16*)(a.ws + WS_WIN); bf16* Wt_br = (bf16*)(a.ws + WS_WBR); bf16* Wt_out = (bf16*)(a.ws + WS_WOUT);
    constexpr int I_B = 4 * 4 * 32, I_O = 16 * 32, NIT = I_B + I_O;
    (void)w_gate; (void)w_in; (void)Wt_in;
    for (int it = gw; it < NIT; it += NGW) {
        int r = it;
        if (r < I_B) { const int br = r / 128, q = r % 128, kb = q / 32, nb = q % 32; transpose_item(w_br + (size_t)br * 256 * 1024, 1024, 1024, Wt_br + (size_t)br * 1024 * 256, 256, kb * 64, nb * 32, nb * 32, scr, lane); continue; } r -= I_B;
        { const int kb = r / 32, nb = r % 32; transpose_item(w_out, 1024, 1024, Wt_out, 1024, kb * 64, nb * 32, nb * 32, scr, lane); }
    }
}
DI void p1_weights_i8(const KA& a, int l, LAS unsigned char* lds, int gw, int NGW, int wave, int lane) {
    LAS float* scr = (LAS float*)(lds + wave * 16384);
    const GAS float* wgt = (const GAS float*)(a.in[24] + (size_t)l * 4 * 1024 * 1024); const GAS float* win = (const GAS float*)(a.in[4] + (size_t)l * 1024 * NIN);
    GAS unsigned char* Wq = (GAS unsigned char*)(a.ws + WS_WQ); GAS float* wsc = (GAS float*)(a.ws + WS_WSC);
    const int nq = 4 * (lane & 7), kr8 = lane >> 3;
    for (int it = NGW - 1 - gw; it < 128 + 77; it += NGW) {
        const bool isg = it < 128; const int br = it >> 5; const int n0 = isg ? (it & 31) * 32 : (it - 128) * 32;
        const int ldw = isg ? 1024 : NIN; const int nval = isg ? 1024 : NIN; const int drow0 = isg ? 2560 + br * 1024 + n0 : n0;
        const bool lok = (n0 + nq) < nval;
        const GAS float* W = (isg ? wgt + (size_t)br * 1024 * 1024 : win) + n0 + nq;
        f32x4 mx = {0.f, 0.f, 0.f, 0.f};
#pragma unroll 8
        for (int i = 0; i < 128; ++i) { f32x4 v = {0.f, 0.f, 0.f, 0.f}; if (lok) v = *(const GAS f32x4*)(W + (size_t)(8 * i + kr8) * ldw);
            mx[0] = fmaxf(mx[0], fabsf(v[0])); mx[1] = fmaxf(mx[1], fabsf(v[1])); mx[2] = fmaxf(mx[2], fabsf(v[2])); mx[3] = fmaxf(mx[3], fabsf(v[3])); }
#pragma unroll
        for (int e = 0; e < 4; ++e) { float m = mx[e]; m = fmaxf(m, xshfl<8>(m)); m = fmaxf(m, xshfl<16>(m)); m = fmaxf(m, xshfl<32>(m)); mx[e] = fmaxf(m, 1e-20f); }
        if (kr8 == 0 && lok) *(GAS f32x4*)(wsc + drow0 + nq) = mx * (1.f / 127.f);
        const f32x4 qs = {127.f / mx[0], 127.f / mx[1], 127.f / mx[2], 127.f / mx[3]};
#pragma unroll 1
        for (int kb = 0; kb < 16; ++kb) {
            f32x4 v[8];
#pragma unroll
            for (int i = 0; i < 8; ++i) { v[i] = (f32x4){0.f, 0.f, 0.f, 0.f}; if (lok) v[i] = *(const GAS f32x4*)(W + (size_t)(kb * 64 + 8 * i + kr8) * ldw); }
#pragma unroll
            for (int i = 0; i < 8; ++i) { const int kk = 8 * i + kr8;
#pragma unroll
                for (int e = 0; e < 4; ++e) scr[kk * 33 + nq + e] = __builtin_rintf(v[i][e] * qs[e]); }
            LDS_WAIT(); asm volatile("" ::: "memory");
            const int n = lane >> 1, kh = lane & 1; u32x4 o[2];
#pragma unroll
            for (int h2 = 0; h2 < 2; ++h2) { unsigned w4[4];
#pragma unroll
                for (int d = 0; d < 4; ++d) { unsigned wv = 0u;
#pragma unroll
                    for (int e = 0; e < 4; ++e) wv |= ((unsigned)(int)scr[(32 * kh + 16 * h2 + 4 * d + e) * 33 + n] & 255u) << (8 * e);
                    w4[d] = wv; }
                o[h2].x = w4[0]; o[h2].y = w4[1]; o[h2].z = w4[2]; o[h2].w = w4[3]; }
            if (n0 + n < nval) { GAS unsigned char* dst = Wq + (size_t)(drow0 + n) * 1024 + kb * 64 + 32 * kh; *(GAS u32x4*)dst = o[0]; *(GAS u32x4*)(dst + 16) = o[1]; }
            LDS_WAIT(); asm volatile("" ::: "memory");
        }
    }
}

DI void router_weights(const KA& a, int l, int gw, int NGW, int lane) {
    bf16* Wr = (bf16*)(a.ws + WS_WR);
    const float* wg = a.in[29] + (size_t)l * 1024 * 4; const float* we = a.in[31] + (size_t)l * 1024 * 32;
    for (int n = gw; n < 36; n += NGW) {
        for (int i = 0; i < 16; ++i) { const int k = lane + 64 * i; const float w = (n < 4) ? wg[k * 4 + n] : we[k * 32 + (n - 4)];
            const unsigned hi = f2bf(w); const float hf = __builtin_bit_cast(float, hi << 16); const unsigned lo = f2bf(w - hf);
            Wr[(size_t)n * 2048 + k] = (bf16)hi; Wr[(size_t)n * 2048 + 1024 + k] = (bf16)hi; Wr[(size_t)(64 + n) * 2048 + k] = (bf16)lo; Wr[(size_t)(64 + n) * 2048 + 1024 + k] = 0; }
    }
}

DI void cmp_weights(const KA& a, int l, LAS unsigned char* lds, int gw, int NGW, int wave, int lane) {
    LAS float* scr = (LAS float*)(lds + wave * 16384);
    bf16* Wc = (bf16*)(a.ws + WS_WCMP); float* pt = (float*)(a.ws + WS_CMPAB + 2 * MiB);
    for (int it = gw; it < 128 + 64; it += NGW) {
        if (it < 128) { const int kv = it >> 6, q = it & 63, kb = q >> 1, nb = q & 1; const float* w1 = a.in[kv ? 22 : 19] + (size_t)l * 2048 * 64;
            bf16* dst = Wc + (size_t)kv * 256 * 1024 - (kb >= 16 ? 1024 : 0);
            transpose_item(w1, 64, 64, dst, 1024, kb * 64, nb * 32, (kb >= 16 ? 64 : 0) + nb * 32, scr, lane);
        } else { const int kv = (it - 128) >> 5, part = (it - 128) & 31;
            const GAS float* w1 = (const GAS float*)(a.in[kv ? 22 : 19] + (size_t)l * 2048 * 64) + (size_t)part * 64 * 64; const GAS float* pos = (const GAS float*)(a.in[kv ? 21 : 18] + (size_t)l * 2048) + part * 64;
            float acc = 0.f;
#pragma unroll 16
            for (int k = 0; k < 64; ++k) acc += pos[k] * w1[(size_t)k * 64 + lane];
            pt[(kv * 32 + part) * 64 + lane] = acc; }
    }
}

DI void lru_weights(const KA& a, int l, int gw, int NGW, int lane) {
    bf16* W = (bf16*)(a.ws + WS_LRUW); const float* wa = a.in[7] + (size_t)l * 4 * 4096; const float* wx = a.in[9] + (size_t)l * 4 * 4096;
    (void)NGW; { const int idx = gw * 64 + lane; if (idx < 32768) { const int i = idx & 63, j = (idx >> 6) & 63, mat = (idx >> 12) & 1, hbk = idx >> 13;
        W[idx] = (bf16)f2bf((mat ? wx : wa)[(size_t)hbk * 4096 + i * 64 + j]); } }
}
DI void phase0_rows(const KA& a, int l, int mode, int gw, int NGW, int lane) {
    const GAS float* xin = (const GAS float*)a.in[0]; GAS bf16* xb = (GAS bf16*)(a.ws + WS_XB);
    const GAS bf16* eo = (const GAS bf16*)(a.ws + WS_PROJ);
    GAS float* outp = (GAS float*)a.out;
    const GAS float* g = (const GAS float*)(mode ? a.in[2] : (a.in[3] + (size_t)l * 1024));
    f32x4 gv[4];
#pragma unroll
    for (int j = 0; j < 4; ++j) gv[j] = *(const GAS f32x4*)(g + 4 * (lane + 64 * j));
    for (int m0 = gw * 4; m0 < T; m0 += NGW * 4) {
        f32x4 v[4][4]; float ss[4];
#pragma unroll
        for (int rr = 0; rr < 4; ++rr)
#pragma unroll
            for (int j = 0; j < 4; ++j) { if (l == 0) v[rr][j] = *(const GAS f32x4*)(xin + (size_t)(m0 + rr) * 1024 + 4 * (lane + 64 * j));
                else { const u32x2 xw = *(const GAS u32x2*)(xb + (size_t)(m0 + rr) * 1024 + 4 * (lane + 64 * j)); v[rr][j][0] = lo_bf(xw.x); v[rr][j][1] = hi_bf(xw.x); v[rr][j][2] = lo_bf(xw.y); v[rr][j][3] = hi_bf(xw.y); } }
        if (l > 0) {
#pragma unroll
            for (int rr = 0; rr < 4; ++rr)
#pragma unroll
                for (int j = 0; j < 4; ++j) {
                    const u32x2 e0 = *(const GAS u32x2*)(eo + (size_t)(2 * (m0 + rr)) * 1024 + 4 * (lane + 64 * j));
                    const u32x2 e1 = *(const GAS u32x2*)(eo + (size_t)(2 * (m0 + rr) + 1) * 1024 + 4 * (lane + 64 * j));
                    v[rr][j][0] += lo_bf(e0.x) + lo_bf(e1.x); v[rr][j][1] += hi_bf(e0.x) + hi_bf(e1.x); v[rr][j][2] += lo_bf(e0.y) + lo_bf(e1.y); v[rr][j][3] += hi_bf(e0.y) + hi_bf(e1.y); } }
#pragma unroll
        for (int rr = 0; rr < 4; ++rr) { float t = 0.f;
#pragma unroll
            for (int j = 0; j < 4; ++j) t += (v[rr][j][0] * v[rr][j][0] + v[rr][j][1] * v[rr][j][1]) + (v[rr][j][2] * v[rr][j][2] + v[rr][j][3] * v[rr][j][3]);
            ss[rr] = t; }
#pragma unroll
        for (int rr = 0; rr < 4; ++rr) ss[rr] = wave_sum(ss[rr]);
        if (mode) {
#pragma unroll
            for (int rr = 0; rr < 4; ++rr) { const float r = 1.f / sqrtf(ss[rr] * (1.f / 1024.f) + 1e-6f); const size_t m = (size_t)(m0 + rr);
#pragma unroll
                for (int j = 0; j < 4; ++j) *(GAS f32x4*)(outp + m * 1024 + 4 * (lane + 64 * j)) = v[rr][j] * r * gv[j]; }
        } else {
            GAS unsigned char* hq = (GAS unsigned char*)(a.ws + WS_HQ); GAS float* hsc = (GAS float*)(a.ws + WS_HSC);
            float am[4];
#pragma unroll
            for (int rr = 0; rr < 4; ++rr) { const float r = 1.f / sqrtf(ss[rr] * (1.f / 1024.f) + 1e-6f); const size_t m = (size_t)(m0 + rr); float t = 0.f;
#pragma unroll
                for (int j = 0; j < 4; ++j) { if (l > 0) { u32x2 w; w.x = pk2(v[rr][j][0], v[rr][j][1]); w.y = pk2(v[rr][j][2], v[rr][j][3]); *(GAS u32x2*)(xb + m * 1024 + 4 * (lane + 64 * j)) = w; }
                    const f32x4 y = v[rr][j] * r * gv[j]; v[rr][j] = y;
                    t = fmaxf(t, fmaxf(fmaxf(fabsf(y[0]), fabsf(y[1])), fmaxf(fabsf(y[2]), fabsf(y[3])))); }
                am[rr] = t; }
#pragma unroll
            for (int rr = 0; rr < 4; ++rr) am[rr] = fmaxf(wave_max(am[rr]), 1e-20f);
#pragma unroll
            for (int rr = 0; rr < 4; ++rr) { const size_t m = (size_t)(m0 + rr); const float qs = 127.f / am[rr];
                if (lane == 0) hsc[m] = am[rr] * (1.f / 127.f);
#pragma unroll
                for (int j = 0; j < 4; ++j) { const f32x4 y = v[rr][j] * qs;
                    const unsigned q = ((unsigned)(int)__builtin_rintf(y[0]) & 255u) | (((unsigned)(int)__builtin_rintf(y[1]) & 255u) << 8) | (((unsigned)(int)__builtin_rintf(y[2]) & 255u) << 16) | (((unsigned)(int)__builtin_rintf(y[3]) & 255u) << 24);
                    *(GAS unsigned*)(hq + m * 1024 + 4 * (lane + 64 * j)) = q; } }
        }
    }
}

DI int crow(int i, int hh) { return (i & 3) + 8 * (i >> 2) + 4 * hh; }
DI unsigned cvtpk(float lo, float hi) { f32x2 v = {lo, hi}; bf16x2_t b = __builtin_convertvector(v, bf16x2_t); return __builtin_bit_cast(unsigned, b); }
template <int CTRL, int RMASK> DI float dppf(float oldv, float v) { return __builtin_bit_cast(float, __builtin_amdgcn_update_dpp(__builtin_bit_cast(int, oldv), __builtin_bit_cast(int, v), CTRL, RMASK, 0xf, false)); }
template <int CTRL, int RMASK> DI void scan_step(float& a, float& b) {
    const float ap = dppf<CTRL, RMASK>(1.f, a), bp = dppf<CTRL, RMASK>(0.f, b); b = a * bp + b; a = a * ap; }
DI void lru_unit(const KA& a, int l, const GAS bf16* proj, GAS bf16* ys, GAS float* sums, LAS unsigned char* lds, int task, int lane_in, int wave_in, bool final) {
    int lane = lane_in, wave = wave_in; asm volatile("" : "+v"(lane), "+s"(wave));
    const int chunk = task & 31, hbk = (task >> 5) & 3, b = task >> 7;
    const int ts = chunk * 256 + wave * 32; const size_t rowb = (size_t)b * SEQ;
    LAS unsigned char* wl = lds + wave * 16384;
    LAS float* ex = (LAS float*)(lds + LRUEX_OFF); LAS float* cst = (LAS float*)(lds + LRUCST_OFF); LAS float* car = (LAS float*)(lds + LRUCAR_OFF) + wave * 64;
    {
        const int c = hbk * 64 + lane;
        const GAS float* cw = (const GAS float*)(a.in[5] + (size_t)l * 4 * 256);
        const float cw0 = cw[c], cw1 = cw[256 + c], cw2 = cw[512 + c], cw3 = cw[768 + c]; const float cb = a.in[6][l * 256 + c];
        if (wave == 0) { cst[lane] = a.in[8][l * 256 + c]; cst[64 + lane] = a.in[10][l * 256 + c]; cst[128 + lane] = -8.f * softplusf_(-a.in[11][l * 256 + c]); }
        const GAS bf16* xp = proj + (rowb + ts) * PLD + C_AX + c;
        float x3 = (ts >= 3) ? bf2f(*(xp - 3 * PLD)) : 0.f, x2 = (ts >= 2) ? bf2f(*(xp - 2 * PLD)) : 0.f, x1 = (ts >= 1) ? bf2f(*(xp - PLD)) : 0.f;
#pragma unroll 8
        for (int n = 0; n < 32; ++n) { const float x0 = bf2f(xp[(size_t)n * PLD]); const float xc = cb + cw0 * x3 + cw1 * x2 + cw2 * x1 + cw3 * x0;
            *(LAS bf16*)(wl + n * 144 + lane * 2) = (bf16)f2bf(xc); *(LAS float*)(wl + 4608 + n * 272 + lane * 4) = xc; x3 = x2; x2 = x1; x1 = x0; }
    }
    const int n = lane & 31, hh = lane >> 5;
    f32x16 D[4];
    {
        const GAS bf16* wt = (const GAS bf16*)(a.ws + WS_LRUW) + (size_t)hbk * 8192;
        bf16x8 bfr[4];
        LDS_WAIT();
#pragma unroll
        for (int s4 = 0; s4 < 4; ++s4) bfr[s4] = *(const LAS bf16x8*)(wl + n * 144 + hh * 16 + s4 * 32);
#pragma unroll
        for (int m = 0; m < 4; ++m) {
#pragma unroll
            for (int s4 = 0; s4 < 4; ++s4) { const bf16x8 af = *(const GAS bf16x8*)(wt + (size_t)(m >> 1) * 4096 + (32 * (m & 1) + n) * 64 + 8 * hh + 16 * s4);
                if (s4 == 0) { f32x16 z;
#pragma unroll
                    for (int i = 0; i < 16; ++i) z[i] = 0.f;
                    D[m] = MFMA32(af, bfr[s4], z); } else D[m] = MFMA32(af, bfr[s4], D[m]); } }
    }
    __syncthreads();
    const bool t0 = (ts + n) == 0;
#pragma unroll
    for (int mm = 0; mm < 2; ++mm)
#pragma unroll
        for (int g4 = 0; g4 < 4; ++g4) { const int c0 = 32 * mm + 8 * g4 + 4 * hh;
            const f32x4 vba = *(const LAS f32x4*)(cst + c0), vbx = *(const LAS f32x4*)(cst + 64 + c0), vc8 = *(const LAS f32x4*)(cst + 128 + c0);
            const f32x4 vxc = *(const LAS f32x4*)(wl + 4608 + n * 272 + c0 * 4);
#pragma unroll
            for (int e = 0; e < 4; ++e) { const int i = 4 * g4 + e;
                const float r = sigmoidf_(D[mm][i] + vba[e]), ig = sigmoidf_(D[2 + mm][i] + vbx[e]);
                const float la = vc8[e] * r; const float av = __expf(la);
                const float mult = t0 ? 1.f : sqrtf(fmaxf(1.f - __expf(2.f * la), 0.f));
                float aa = av, bb = mult * ig * vxc[e];
                scan_step<0x111, 0xf>(aa, bb); scan_step<0x112, 0xf>(aa, bb); scan_step<0x114, 0xf>(aa, bb); scan_step<0x118, 0xf>(aa, bb); scan_step<0x142, 0xa>(aa, bb);
                D[mm][i] = aa; D[2 + mm][i] = bb; } }
    if (n == 31) {
#pragma unroll
        for (int mm = 0; mm < 2; ++mm)
#pragma unroll
            for (int i = 0; i < 16; ++i) { const int c = 32 * mm + crow(i, hh); ex[(wave * 64 + c) * 2] = D[mm][i]; ex[(wave * 64 + c) * 2 + 1] = D[2 + mm][i]; } }
    __syncthreads();
    if (!final) {
        if (wave == 0) { float hv = 0.f, av = 1.f;
#pragma unroll
            for (int w = 0; w < 8; ++w) { const float A_ = ex[(w * 64 + lane) * 2], H_ = ex[(w * 64 + lane) * 2 + 1]; hv = A_ * hv + H_; av *= A_; }
            GAS float* sp = sums + ((size_t)((b * 4 + hbk) * 32 + chunk) * 64 + lane) * 2; sp[0] = av; sp[1] = hv; }
    } else {
        {   float hv = 0.f;
            {   const GAS f32x2* sp = (const GAS f32x2*)(sums + ((size_t)((b * 4 + hbk) * 32) * 64 + lane) * 2);
                int cc = 0;
                for (; cc + 8 <= chunk; cc += 8) { f32x2 v[8];
#pragma unroll
                    for (int e = 0; e < 8; ++e) v[e] = sp[(size_t)(cc + e) * 64];
#pragma unroll
                    for (int e = 0; e < 8; ++e) hv = v[e][0] * hv + v[e][1]; }
                for (; cc < chunk; ++cc) { const f32x2 v = sp[(size_t)cc * 64]; hv = v[0] * hv + v[1]; } }
            for (int w = 0; w < wave; ++w) { const float A_ = ex[(w * 64 + lane) * 2], H_ = ex[(w * 64 + lane) * 2 + 1]; hv = A_ * hv + H_; }
            car[lane] = hv; }
        LDS_WAIT(); asm volatile("" ::: "memory");
        const GAS bf16* gp = proj + (rowb + ts + n) * PLD + C_AG + hbk * 64; GAS bf16* yp = ys + (rowb + ts + n) * 1024 + hbk * 64;
#pragma unroll
        for (int mm = 0; mm < 2; ++mm)
#pragma unroll
            for (int g4 = 0; g4 < 4; ++g4) { const int c0 = 32 * mm + 8 * g4 + 4 * hh; const f32x4 cv = *(const LAS f32x4*)(car + c0);
                const u32x2 gt2 = *(const GAS u32x2*)(gp + c0); float y[4];
#pragma unroll
                for (int e = 0; e < 4; ++e) { const int i = 4 * g4 + e; const float hv = D[2 + mm][i] + D[mm][i] * cv[e];
                    const float gt = (e == 0) ? lo_bf(gt2.x) : (e == 1) ? hi_bf(gt2.x) : (e == 2) ? lo_bf(gt2.y) : hi_bf(gt2.y); y[e] = hv * gelu_tanh(gt); }
                u32x2 yo; yo.x = cvtpk(y[0], y[1]); yo.y = cvtpk(y[2], y[3]); *(GAS u32x2*)(yp + c0) = yo; }
    }
    __syncthreads();
}

constexpr int DK_STR = 144, DV_STR = 192, DBUF_BYTES = 64 * DK_STR + 64 * DV_STR;
DI bf16x8 pack_half(const f32x16& x, int s2) { u32x4 p;
    if (s2 == 0) { p.x = cvtpk(x[0], x[1]); p.y = cvtpk(x[2], x[3]); p.z = cvtpk(x[4], x[5]); p.w = cvtpk(x[6], x[7]); }
    else { p.x = cvtpk(x[8], x[9]); p.y = cvtpk(x[10], x[11]); p.z = cvtpk(x[12], x[13]); p.w = cvtpk(x[14], x[15]); }
    return __builtin_bit_cast(bf16x8, p); }
DI s16x4 vtr(const LAS unsigned char* p) { return __builtin_bit_cast(s16x4, __builtin_amdgcn_ds_read_tr16_b64_v4i16((LAS v4i16_t*)p)); }
DI float max16(const f32x16& x) { float a = fmaxf(fmaxf(x[0], x[1]), fmaxf(x[2], x[3])), b = fmaxf(fmaxf(x[4], x[5]), fmaxf(x[6], x[7])), c = fmaxf(fmaxf(x[8], x[9]), fmaxf(x[10], x[11])), d = fmaxf(fmaxf(x[12], x[13]), fmaxf(x[14], x[15])); return fmaxf(fmaxf(a, b), fmaxf(c, d)); }
DI void diff_unit(const GAS bf16* proj, GAS bf16* ys, LAS unsigned char* lds, const LAS float* bias2, const GAS float* subg, const LAS float* lamp, int b, int h, int qb, int wave_in) {
    int wave = wave_in; asm volatile("" : "+s"(wave)); const int lane = my_lane(); const int tid = wave * 64 + lane;
    const int q0 = qb * 256 + wave * 32; const int ql = lane & 31, hh = lane >> 5; const int q = q0 + ql;
    const size_t rowb = (size_t)b * SEQ;
    const float SC = 0.17677669529663687f * 1.4426950408889634f;
    bf16x8 qf[2][2];
    { const GAS bf16* qp = proj + (rowb + q) * PLD + C_CQ + h * 64 + hh * 8;
#pragma unroll
      for (int m = 0; m < 2; ++m)
#pragma unroll
        for (int s = 0; s < 2; ++s) { const u32x4 w = *(const GAS u32x4*)(qp + m * 32 + s * 16); u32x4 o;
            o.x = cvtpk(lo_bf(w.x) * SC, hi_bf(w.x) * SC); o.y = cvtpk(lo_bf(w.y) * SC, hi_bf(w.y) * SC); o.z = cvtpk(lo_bf(w.z) * SC, hi_bf(w.z) * SC); o.w = cvtpk(lo_bf(w.w) * SC, hi_bf(w.w) * SC);
            qf[m][s] = __builtin_bit_cast(bf16x8, o); } }
    f32x16 O[2][2], negm[2];
#pragma unroll
    for (int i = 0; i < 16; ++i) { O[0][0][i] = 0.f; O[0][1][i] = 0.f; O[1][0][i] = 0.f; O[1][1][i] = 0.f; negm[0][i] = 120.f; negm[1][i] = 120.f; }
    float lsum[2] = {0.f, 0.f};
    const int nsteps = 4 * qb + 4, mysteps = 4 * qb + (wave >> 1) + 1;
    const int skey = tid >> 3, sch = tid & 7;
    const GAS unsigned char* kgb = (const GAS unsigned char*)(proj + rowb * PLD + C_CK + h * 64);
    const GAS unsigned char* vgb = (const GAS unsigned char*)(proj + rowb * PLD + C_CV + h * 64);
    const unsigned soff = (unsigned)(skey * PLD + sch * 8) * 2u;
    u32x4 kr = *(const GAS u32x4*)(kgb + soff), vr = *(const GAS u32x4*)(vgb + soff);
    *(LAS u32x4*)(lds + skey * DK_STR + sch * 16) = kr; *(LAS u32x4*)(lds + 64 * DK_STR + skey * DV_STR + sch * 16) = vr;
    __syncthreads();
    const int i16 = lane & 15, blk = (lane >> 4) & 1;
    const int kboff = ql * DK_STR + hh * 16;
    const int vboff = 64 * DK_STR + (4 * hh + (i16 >> 2)) * DV_STR + (16 * blk + 4 * (i16 & 3)) * 2;
#pragma unroll 1
    for (int kt = 0; kt < nsteps; ++kt) {
        const LAS unsigned char* cur = lds + (kt & 1) * DBUF_BYTES; LAS unsigned char* nxt = lds + ((kt + 1) & 1) * DBUF_BYTES;
        if (kt + 1 < nsteps) { const unsigned so = soff + (unsigned)(kt + 1) * (64u * PLD * 2u); kr = *(const GAS u32x4*)(kgb + so); vr = *(const GAS u32x4*)(vgb + so); }
        if (kt < mysteps) {
            const int kbase = kt * 64;
            const bool near = (q0 - (kbase + 63) < 113);
#pragma unroll
            for (int m = 0; m < 2; ++m) {
                bf16x8 pk[2][2];
                f32x16 S[2]; float ts = 0.f;
                {   bf16x8 kf[2][2];
#pragma unroll
                    for (int t = 0; t < 2; ++t)
#pragma unroll
                        for (int s = 0; s < 2; ++s) kf[t][s] = *(const LAS bf16x8*)(cur + kboff + t * 32 * DK_STR + m * 64 + s * 32);
#pragma unroll
                    for (int t = 0; t < 2; ++t) { S[t] = MFMA32(kf[t][0], qf[m][0], negm[m]); S[t] = MFMA32(kf[t][1], qf[m][1], S[t]); } }
                if (near) {
#pragma unroll
                    for (int t = 0; t < 2; ++t)
#pragma unroll
                        for (int i = 0; i < 16; ++i) { const int dist = q - (kbase + 32 * t + crow(i, hh)); const int di = dist < 128 ? dist : 128;
                            const float bv = dist >= 0 ? bias2[di * 12 + 4 + h] : -1e30f; S[t][i] += bv; } }
#pragma unroll
                for (int t = 0; t < 2; ++t)
#pragma unroll
                    for (int i = 0; i < 16; ++i) { const float p = __builtin_amdgcn_exp2f(S[t][i]); S[t][i] = p; ts += p; }
                if (__builtin_amdgcn_ballot_w64(!(ts < 1.0e30f)) != 0ull) {
                {   bf16x8 kf[2][2];
#pragma unroll
                        for (int t = 0; t < 2; ++t)
#pragma unroll
                            for (int s = 0; s < 2; ++s) kf[t][s] = *(const LAS bf16x8*)(cur + kboff + t * 32 * DK_STR + m * 64 + s * 32);
#pragma unroll
                        for (int t = 0; t < 2; ++t) { S[t] = MFMA32(kf[t][0], qf[m][0], negm[m]); S[t] = MFMA32(kf[t][1], qf[m][1], S[t]); } }
                    if (near) {
#pragma unroll
                        for (int t = 0; t < 2; ++t)
#pragma unroll
                            for (int i = 0; i < 16; ++i) { const int dist = q - (kbase + 32 * t + crow(i, hh)); const int di = dist < 128 ? dist : 128;
                                const float bv = dist >= 0 ? bias2[di * 12 + 4 + h] : -1e30f; S[t][i] += bv; } }
                    float tm = fmaxf(max16(S[0]), max16(S[1])); tm = fmaxf(tm, xshfl<32>(tm));
                    const float sh = fmaxf(tm, 0.f); const float al = __builtin_amdgcn_exp2f(-sh);
                    lsum[m] *= al; ts = 0.f;
#pragma unroll
                    for (int i = 0; i < 16; ++i) { O[m][0][i] *= al; O[m][1][i] *= al; negm[m][i] -= sh; }
#pragma unroll
                    for (int t = 0; t < 2; ++t)
#pragma unroll
                        for (int i = 0; i < 16; ++i) { const float p = __builtin_amdgcn_exp2f(S[t][i] - sh); S[t][i] = p; ts += p; }
                }
                lsum[m] += ts;
#pragma unroll
                for (int t = 0; t < 2; ++t) { pk[t][0] = pack_half(S[t], 0); pk[t][1] = pack_half(S[t], 1); }
#pragma unroll
                for (int t = 0; t < 2; ++t)
#pragma unroll
                    for (int s2 = 0; s2 < 2; ++s2)
#pragma unroll
                        for (int db = 0; db < 2; ++db) {
                            const s16x4 lo = vtr(cur + vboff + (32 * t + 16 * s2) * DV_STR + db * 64), hi = vtr(cur + vboff + (32 * t + 16 * s2 + 8) * DV_STR + db * 64);
                            const bf16x8 vf = __builtin_shufflevector(lo, hi, 0, 1, 2, 3, 4, 5, 6, 7);
                            O[m][db] = MFMA32(vf, pk[t][s2], O[m][db]); }
                ;
            }
        }
        if (kt + 1 < nsteps) { *(LAS u32x4*)(nxt + skey * DK_STR + sch * 16) = kr; *(LAS u32x4*)(nxt + 64 * DK_STR + skey * DV_STR + sch * 16) = vr; }
        __syncthreads();
    }
    const float l0 = lsum[0] + xshfl<32>(lsum[0]), l1 = lsum[1] + xshfl<32>(lsum[1]);
    const float lam = lamp[0], lam_init = lamp[1];
    const float i0 = 1.f / fmaxf(l0, 1e-30f), i1 = lam / fmaxf(l1, 1e-30f);
    float ss = 0.f;
#pragma unroll
    for (int db = 0; db < 2; ++db)
#pragma unroll
        for (int i = 0; i < 16; ++i) { const float at = O[0][db][i] * i0 - O[1][db][i] * i1; O[0][db][i] = at; ss += at * at; }
    ss += xshfl<32>(ss);
    const float r = (1.f - lam_init) / sqrtf(ss * (1.f / 64.f) + 1e-5f);
    GAS bf16* op = ys + (rowb + q) * 1024 + 512 + h * 64;
#pragma unroll
    for (int db = 0; db < 2; ++db)
#pragma unroll
        for (int gq = 0; gq < 4; ++gq) { const int d0 = 32 * db + 8 * gq + 4 * hh; const f32x4 sg = *(const GAS f32x4*)(subg + d0);
            u32x2 w; w.x = cvtpk(O[0][db][4 * gq + 0] * r * sg[0], O[0][db][4 * gq + 1] * r * sg[1]); w.y = cvtpk(O[0][db][4 * gq + 2] * r * sg[2], O[0][db][4 * gq + 3] * r * sg[3]);
            *(GAS u32x2*)(op + d0) = w; }
}

struct SchedCmp { const char* proj; const char* wc; int G, c;
    DI bool next(int i, Unit& u) const { const int L = i * G + c; if (L >= 16) return false; const int kv = L >> 3, rt = L & 7;
        u.pm = rt; u.pn = 0; u.aux = kv; u.pad = 0; u.a = proj + ((size_t)rt * 256 * 16 * PLD + (kv ? C_VC : C_KC)) * 2; u.b = wc + (size_t)kv * 256 * 1024 * 2; return true; } };
struct EpiCmp { static constexpr bool CARRY = false; float* ab;
    DI void operator()(const f32x4 (&acc)[2][2][4][2], const Unit& u, int wr, int wc, int fr, int fq) const {
        const int row0 = u.pm * 256 + wr * 64 + fr; const int col = wc * 32 + 8 * fq;
#pragma unroll
        for (int ai = 0; ai < 2; ++ai)
#pragma unroll
            for (int m = 0; m < 4; ++m) { float* rp = ab + ((size_t)u.aux * 2048 + row0 + ai * 128 + m * 16) * 128 + col; *(f32x4*)rp = acc[ai][0][m][0]; *(f32x4*)(rp + 4) = acc[ai][0][m][1]; }
    }
};
DI void cmp_finish(const KA& a, int l, const float* ab, bf16* kcb, int task, int lane) {
    const int kv = task / (BATCH * NCMP), r = task % (BATCH * NCMP), b = r / NCMP, c = r % NCMP;
    const float* w2 = a.in[kv ? 23 : 20] + (size_t)l * 4096; const float* pt = ab + 2 * 2048 * 128;
    const size_t g = (size_t)kv * 2048 + b * 512 + c;
    float ptv = 0.f;
#pragma unroll 8
    for (int part = 0; part < 32; ++part) ptv += pt[(kv * 32 + part) * 64 + lane];
    const float h1 = ab[g * 128 + lane] + ab[(g + 1) * 128 + 64 + lane] + ptv;
    const float gl = gelu_tanh(h1); float o = 0.f;
#pragma unroll
    for (int j = 0; j < 64; ++j) o += rl(gl, j) * w2[j * 64 + lane];
    kcb[((size_t)(kv * BATCH + b) * 512 + c) * 64 + lane] = (bf16)f2bf(o);
    if (c == NCMP - 1) kcb[((size_t)(kv * BATCH + b) * 512 + NCMP) * 64 + lane] = 0;
}

DI void cmp_block(const KA& a, int l, const GAS bf16* proj, const GAS bf16* wcT, float* ab, bf16* kcb, int bid, int wave, int lane) {
    const int kv = bid >> 7, g0 = (bid & 127) * 16, r = lane & 15, q = lane >> 4, sh = wave >> 2;
    const int grow = g0 + r + sh; const bool st_ok = !(sh != 0 && (grow & 511) == 0);
    const int gld = grow > 2047 ? 2047 : grow;
    const GAS bf16* apn = proj + (size_t)gld * 16 * PLD + (kv ? C_VC : C_KC) + 8 * q;
    const GAS bf16* bpn = wcT + ((size_t)kv * 256 + wave * 16 + r) * 1024 + 8 * q;
    f32x4 acc = {0.f, 0.f, 0.f, 0.f};
#pragma unroll 8
    for (int s = 0; s < 32; ++s) {
        const bf16x8 av = *(const GAS bf16x8*)(apn + (size_t)(s >> 1) * PLD + 32 * (s & 1));
        const bf16x8 bv = *(const GAS bf16x8*)(bpn + 32 * s);
        acc = __builtin_amdgcn_mfma_f32_16x16x32_bf16(bv, av, acc, 0, 0, 0);
    }
    if (st_ok) *(GAS f32x4*)((GAS float*)ab + ((size_t)kv * 2048 + grow) * 128 + wave * 16 + 4 * q) = acc;
    VM_WAIT(); __syncthreads();
#pragma unroll 1
    for (int i = 0; i < 2; ++i) { const int g = g0 + 2 * wave + i, c = g & 511, b = g >> 9;
        if (c < NCMP) cmp_finish(a, l, ab, kcb, kv * (BATCH * NCMP) + b * NCMP + c, lane); }
}

DI void st_load(const GAS unsigned char* kb, const GAS unsigned char* vb, unsigned off, u32x4& kr, u32x4& vr) { kr = *(const GAS u32x4*)(kb + off); vr = *(const GAS u32x4*)(vb + off); }
DI void st_write(LAS unsigned char* buf, int skey, int sch, const u32x4& kr, const u32x4& vr) { *(LAS u32x4*)(buf + skey * DK_STR + sch * 16) = kr; *(LAS u32x4*)(buf + 64 * DK_STR + skey * DV_STR + sch * 16) = vr; }
DI void qk64(const LAS unsigned char* cur, int kboff, const bf16x8 (&qf)[4], const f32x16& cinit, f32x16 (&S)[2]) {
#pragma unroll
    for (int t = 0; t < 2; ++t) { S[t] = cinit;
#pragma unroll
        for (int s = 0; s < 4; ++s) { const bf16x8 kf = *(const LAS bf16x8*)(cur + kboff + t * 32 * DK_STR + s * 32); S[t] = MFMA32(kf, qf[s], S[t]); } }
}
DI void qk32z(const LAS unsigned char* kt32, const bf16x8 (&qf)[4], f32x16& S) {
#pragma unroll
    for (int s = 0; s < 4; ++s) { const bf16x8 kf = *(const LAS bf16x8*)(kt32 + s * 32);
        if (s == 0) { f32x16 z;
#pragma unroll
            for (int i = 0; i < 16; ++i) z[i] = 0.f;
            S = MFMA32(kf, qf[s], z); } else S = MFMA32(kf, qf[s], S); }
}
DI void pv32(const LAS unsigned char* vt32, const bf16x8 (&pk)[2], f32x16 (&O)[2]) {
#pragma unroll
    for (int s2 = 0; s2 < 2; ++s2)
#pragma unroll
        for (int db = 0; db < 2; ++db) {
            const s16x4 lo = vtr(vt32 + (16 * s2) * DV_STR + db * 64), hi = vtr(vt32 + (16 * s2 + 8) * DV_STR + db * 64);
            const bf16x8 vf = __builtin_shufflevector(lo, hi, 0, 1, 2, 3, 4, 5, 6, 7);
            O[db] = MFMA32(vf, pk[s2], O[db]); }
}
DI void mask_bias_cmp32(f32x16& S, int tcol, int cbase, int hh, const LAS float* b2h, float msub) {
#pragma unroll
    for (int i = 0; i < 16; ++i) { const int c = cbase + crow(i, hh); const int dist = tcol - 31 - 16 * c; const bool ok = dist >= 0 && c < NCMP;
        const int di = dist < 0 ? 0 : (dist < 128 ? dist : 128); S[i] = ok ? S[i] + (b2h[di * 12] - msub) : -1e30f; }
}
DI void pv64(const LAS unsigned char* cur, int vboff, const bf16x8 (&pk)[2][2], f32x16 (&O)[2]) {
#pragma unroll
    for (int t = 0; t < 2; ++t)
#pragma unroll
        for (int s2 = 0; s2 < 2; ++s2)
#pragma unroll
            for (int db = 0; db < 2; ++db) {
                const s16x4 lo = vtr(cur + vboff + (32 * t + 16 * s2) * DV_STR + db * 64), hi = vtr(cur + vboff + (32 * t + 16 * s2 + 8) * DV_STR + db * 64);
                const bf16x8 vf = __builtin_shufflevector(lo, hi, 0, 1, 2, 3, 4, 5, 6, 7);
                O[db] = MFMA32(vf, pk[t][s2], O[db]); }
}
DI void softmax_step(f32x16 (&S)[2], f32x16 (&O)[2], f32x16& negm, float& lsum, bf16x8 (&pk)[2][2]) {
    float tm = fmaxf(max16(S[0]), max16(S[1]));
    if (__builtin_amdgcn_ballot_w64(tm > 8.f) != 0ull) {
        tm = fmaxf(tm, xshfl<32>(tm)); const float sh = fmaxf(tm, 0.f); const float al = __builtin_amdgcn_exp2f(-sh);
        lsum *= al;
#pragma unroll
        for (int i = 0; i < 16; ++i) { O[0][i] *= al; O[1][i] *= al; negm[i] -= sh; S[0][i] -= sh; S[1][i] -= sh; } }
#pragma unroll
    for (int t = 0; t < 2; ++t) {
#pragma unroll
        for (int i = 0; i < 16; ++i) { const float p = __builtin_amdgcn_exp2f(S[t][i]); S[t][i] = p; lsum += p; }
        pk[t][0] = pack_half(S[t], 0); pk[t][1] = pack_half(S[t], 1); }
}
DI void mask_bias(f32x16 (&S)[2], int tcol, int kbase, int hh, int W, bool colsel, const LAS float* b2h) {
#pragma unroll
    for (int t = 0; t < 2; ++t)
#pragma unroll
        for (int i = 0; i < 16; ++i) { const int dist = tcol - (kbase + 32 * t + crow(i, hh)); const bool ok = colsel && dist >= 0 && dist < W;
            const int di = dist < 0 ? 0 : (dist < 128 ? dist : 128); S[t][i] = ok ? S[t][i] + b2h[di * 12] : -1e30f; }
}
DI void nsa_unit(const GAS bf16* proj, GAS bf16* ys, const GAS bf16* kcb, LAS unsigned char* lds, const LAS float* bias2, int b, int u, int tid_in, int lane_in, int wave_in) {
    int tid = tid_in, lane = lane_in, wave = wave_in; asm volatile("" : "+v"(tid), "+v"(lane), "+s"(wave));
    const int t0 = u * 64; const int col = lane & 31, hh = lane >> 5, tl = col >> 2, head = col & 3;
    const int t = t0 + wave * 8 + tl; const int tw0 = t0 + wave * 8;
    const size_t rowb = (size_t)b * SEQ;
    const LAS float* b2h = bias2 + 8 + head;
    bf16x8 qf[4];
    { const float SC = 0.125f * 1.4426950408889634f; const GAS bf16* qp = proj + (rowb + t) * PLD + C_DQ + head * 64 + hh * 8;
#pragma unroll
      for (int s = 0; s < 4; ++s) { const u32x4 w = *(const GAS u32x4*)(qp + s * 16); u32x4 o;
          o.x = cvtpk(lo_bf(w.x) * SC, hi_bf(w.x) * SC); o.y = cvtpk(lo_bf(w.y) * SC, hi_bf(w.y) * SC); o.z = cvtpk(lo_bf(w.z) * SC, hi_bf(w.z) * SC); o.w = cvtpk(lo_bf(w.w) * SC, hi_bf(w.w) * SC);
          qf[s] = __builtin_bit_cast(bf16x8, o); } }
    const int skey = tid >> 3, sch = tid & 7;
    const int i16 = lane & 15, blk = (lane >> 4) & 1;
    const int kboff = col * DK_STR + hh * 16;
    const int vboff = 64 * DK_STR + (4 * hh + (i16 >> 2)) * DV_STR + (16 * blk + 4 * (i16 & 3)) * 2;
    u32x4 kr, vr;
    const int ncvm = (4 * u + 3) < NCMP ? (4 * u + 3) : NCMP;
    const int nsc = (ncvm + 63) >> 6;
    const GAS unsigned char* kcp = (const GAS unsigned char*)(kcb + (size_t)(0 * BATCH + b) * 512 * 64);
    const GAS unsigned char* vcp = (const GAS unsigned char*)(kcb + (size_t)(1 * BATCH + b) * 512 * 64);
    const unsigned soffc = (unsigned)(skey * 64 + sch * 8) * 2u;
    float m1 = -120.f, l1 = 0.f;
    st_load(kcp, vcp, soffc, kr, vr); st_write(lds, skey, sch, kr, vr); __syncthreads();
#pragma unroll 1
    for (int kt = 0; kt < nsc; ++kt) {
        const LAS unsigned char* cur = lds + (kt & 1) * DBUF_BYTES; LAS unsigned char* nxt = lds + ((kt + 1) & 1) * DBUF_BYTES;
        if (kt + 1 < nsc) st_load(kcp, vcp, soffc + (unsigned)(kt + 1) * 8192u, kr, vr);
#pragma unroll
        for (int tt = 0; tt < 2; ++tt) { f32x16 S; qk32z(cur + kboff + tt * 32 * DK_STR, qf, S); mask_bias_cmp32(S, t, kt * 64 + tt * 32, hh, b2h, 0.f);
          const float tm = max16(S); const float mn = fmaxf(m1, tm); float acc = 0.f;
#pragma unroll
          for (int i = 0; i < 16; ++i) acc += __builtin_amdgcn_exp2f(S[i] - mn);
          l1 = l1 * __builtin_amdgcn_exp2f(m1 - mn) + acc; m1 = mn; }
        if (kt + 1 < nsc) st_write(nxt, skey, sch, kr, vr);
        __syncthreads();
    }
    float mf, inv;
    { const float mo = xshfl<32>(m1), lo = xshfl<32>(l1); mf = fmaxf(m1, mo); const float lf = l1 * __builtin_amdgcn_exp2f(m1 - mf) + lo * __builtin_amdgcn_exp2f(mo - mf); inv = lf > 0.f ? 1.f / lf : 0.f; }
    f32x16 Oc[2], imp[4];
#pragma unroll
    for (int i = 0; i < 16; ++i) { Oc[0][i] = 0.f; Oc[1][i] = 0.f; imp[0][i] = 0.f; imp[1][i] = 0.f; imp[2][i] = 0.f; imp[3][i] = 0.f; }
    {   st_load(kcp, vcp, soffc, kr, vr); st_write(lds, skey, sch, kr, vr); __syncthreads();
#pragma unroll 1
        for (int kt = 0; kt < nsc; ++kt) {
            const LAS unsigned char* cur = lds + (kt & 1) * DBUF_BYTES; LAS unsigned char* nxt = lds + ((kt + 1) & 1) * DBUF_BYTES;
            if (kt + 1 < nsc) st_load(kcp, vcp, soffc + (unsigned)(kt + 1) * 8192u, kr, vr);
#pragma unroll
            for (int tt = 0; tt < 2; ++tt) {
                f32x16 S; qk32z(cur + kboff + tt * 32 * DK_STR, qf, S); mask_bias_cmp32(S, t, kt * 64 + tt * 32, hh, b2h, mf);
#pragma unroll
                for (int i = 0; i < 16; ++i) S[i] = __builtin_amdgcn_exp2f(S[i]) * inv;
                bf16x8 pk[2]; pk[0] = pack_half(S, 0); pk[1] = pack_half(S, 1);
                pv32(cur + vboff + tt * 32 * DV_STR, pk, Oc);
                const int Tq = (2 * kt + tt) & 3, MB = (2 * kt + tt) >> 2;
#pragma unroll
                for (int s2 = 0; s2 < 2; ++s2) { u32x4 aw; unsigned e[8];
#pragma unroll
                    for (int jj = 0; jj < 8; ++jj) { const int kk = 16 * s2 + 8 * (jj >> 2) + 4 * hh + (jj & 3); const int delta = 32 * Tq + kk - 4 * col;
                        e[jj] = (delta == -1 || delta == 3) ? 0x3F80u : ((unsigned)delta <= 2u ? 0x4000u : 0u); }
                    aw.x = e[0] | (e[1] << 16); aw.y = e[2] | (e[3] << 16); aw.z = e[4] | (e[5] << 16); aw.w = e[6] | (e[7] << 16);
                    const bf16x8 af = __builtin_bit_cast(bf16x8, aw);
                    if (MB == 0) imp[0] = MFMA32(af, pk[s2], imp[0]); else if (MB == 1) imp[1] = MFMA32(af, pk[s2], imp[1]); else if (MB == 2) imp[2] = MFMA32(af, pk[s2], imp[2]); else imp[3] = MFMA32(af, pk[s2], imp[3]); }
                if (Tq == 3 && MB < 3) { u32x4 aw; aw.x = 0u; aw.y = 0u; aw.z = 0u; aw.w = (lane == 32) ? 0x3F800000u : 0u;
                    const bf16x8 af = __builtin_bit_cast(bf16x8, aw);
                    if (MB == 0) imp[1] = MFMA32(af, pk[1], imp[1]); else if (MB == 1) imp[2] = MFMA32(af, pk[1], imp[2]); else imp[3] = MFMA32(af, pk[1], imp[3]); }
            }
            if (kt + 1 < nsc) st_write(nxt, skey, sch, kr, vr);
            __syncthreads();
        }
    }
    unsigned ocp[2][8];
#pragma unroll
    for (int db = 0; db < 2; ++db)
#pragma unroll
        for (int i = 0; i < 8; ++i) ocp[db][i] = cvtpk(Oc[db][2 * i], Oc[db][2 * i + 1]);
    unsigned sm0 = 0u, sm1 = 0u, sm2 = 0u, sm3 = 0u;
    {   const int cur_t = t >> 6; unsigned key[16];
#pragma unroll
        for (int i = 0; i < 16; ++i) {
            float v0 = imp[0][i], v1 = imp[1][i], v2 = imp[2][i], v3 = imp[3][i];
            v0 += xshfl<1>(v0); v0 += xshfl<2>(v0); v1 += xshfl<1>(v1); v1 += xshfl<2>(v1); v2 += xshfl<1>(v2); v2 += xshfl<2>(v2); v3 += xshfl<1>(v3); v3 += xshfl<2>(v3);
            const float val = head == 0 ? v0 : (head == 1 ? v1 : (head == 2 ? v2 : v3));
            const int j = 32 * head + crow(i, hh);
            const bool forced = (j == 0) || (j == cur_t) || (j == cur_t - 1);
            unsigned fx = (unsigned)(fminf(fmaxf(val, 0.f), 31.f) * 1048576.f) + 1u;
            fx = forced ? 0x1FFFFFFu : (j <= cur_t ? fx : 0u);
            key[i] = (fx << 7) | (unsigned)(127 - j); }
#pragma unroll 1
        for (int r = 0; r < 16; ++r) {
            unsigned w = key[0];
#pragma unroll
            for (int i = 1; i < 16; ++i) w = w > key[i] ? w : key[i];
            { unsigned o = (unsigned)xshfl_i<1>((int)w); w = w > o ? w : o; o = (unsigned)xshfl_i<2>((int)w); w = w > o ? w : o; o = (unsigned)xshfl_i<32>((int)w); w = w > o ? w : o; }
            if ((w >> 7) != 0u) { const int j = 127 - (int)(w & 127u); const unsigned bit = 1u << (j & 31); const int jb = j >> 5;
                sm0 |= (jb == 0) ? bit : 0u; sm1 |= (jb == 1) ? bit : 0u; sm2 |= (jb == 2) ? bit : 0u; sm3 |= (jb == 3) ? bit : 0u; }
#pragma unroll
            for (int i = 0; i < 16; ++i) key[i] = (key[i] == w) ? 0u : key[i];
        }
    }
    f32x16 Ow[2]; float lw = 0.f;
#pragma unroll
    for (int i = 0; i < 16; ++i) { Ow[0][i] = 0.f; Ow[1][i] = 0.f; }
    {   f32x16 negm;
#pragma unroll
        for (int i = 0; i < 16; ++i) negm[i] = 120.f;
        const GAS unsigned char* kwp = (const GAS unsigned char*)(proj + rowb * PLD + C_KW); const GAS unsigned char* vwp = (const GAS unsigned char*)(proj + rowb * PLD + C_VW);
        const unsigned soffp = (unsigned)(skey * PLD + sch * 8) * 2u;
        const int s0 = (u < 8) ? 8 - u : 0;
        st_load(kwp, vwp, soffp + (unsigned)(u - 8 + s0) * (64u * PLD * 2u), kr, vr); st_write(lds, skey, sch, kr, vr); __syncthreads();
#pragma unroll 1
        for (int s = s0; s < 9; ++s) {
            const int par = (s - s0) & 1; const LAS unsigned char* cur = lds + par * DBUF_BYTES; LAS unsigned char* nxt = lds + (par ^ 1) * DBUF_BYTES;
            if (s + 1 < 9) st_load(kwp, vwp, soffp + (unsigned)(u - 8 + s + 1) * (64u * PLD * 2u), kr, vr);
            {   f32x16 S[2]; qk64(cur, kboff, qf, negm, S);
                if (s == 0 || s >= 6) mask_bias(S, t, (u - 8 + s) * 64, hh, 512, true, b2h);
                bf16x8 pk[2][2]; softmax_step(S, Ow, negm, lw, pk); pv64(cur, vboff, pk, Ow); }
            if (s + 1 < 9) st_write(nxt, skey, sch, kr, vr);
            __syncthreads();
        }
    }
    unsigned owp[2][8];
#pragma unroll
    for (int db = 0; db < 2; ++db)
#pragma unroll
        for (int i = 0; i < 8; ++i) owp[db][i] = cvtpk(Ow[db][2 * i], Ow[db][2 * i + 1]);
    f32x16 Os[2]; float lsel = 0.f;
#pragma unroll
    for (int i = 0; i < 16; ++i) { Os[0][i] = 0.f; Os[1][i] = 0.f; }
    {   f32x16 negm;
#pragma unroll
        for (int i = 0; i < 16; ++i) negm[i] = 120.f;
        const GAS unsigned char* ksp = (const GAS unsigned char*)(proj + rowb * PLD + C_KS); const GAS unsigned char* vsp = (const GAS unsigned char*)(proj + rowb * PLD + C_VS);
        const unsigned soffp = (unsigned)(skey * PLD + sch * 8) * 2u;
        u32x4 kA, vA, kB, vB;
        st_load(ksp, vsp, soffp, kr, vr); st_write(lds, skey, sch, kr, vr);
        if (u >= 1) st_load(ksp, vsp, soffp + 64u * PLD * 2u, kA, vA);
        __syncthreads();
#define SEL_STEP(J, KX, VX, KY, VY) { const int j_ = (J); \
            const LAS unsigned char* cur = lds + (j_ & 1) * DBUF_BYTES; LAS unsigned char* nxt = lds + ((j_ + 1) & 1) * DBUF_BYTES; \
            if (j_ + 2 <= u) st_load(ksp, vsp, soffp + (unsigned)(j_ + 2) * (64u * PLD * 2u), KY, VY); \
            const int jb = j_ >> 5; const unsigned smw = jb == 0 ? sm0 : (jb == 1 ? sm1 : (jb == 2 ? sm2 : sm3)); \
            const bool bit = ((smw >> (j_ & 31)) & 1u) != 0u; \
            if (__builtin_amdgcn_ballot_w64(bit) != 0ull) { \
                f32x16 S[2]; qk64(cur, kboff, qf, negm, S); \
                if (64 * j_ + 63 > tw0 - 113) mask_bias(S, t, 64 * j_, hh, 1 << 30, bit, b2h); \
                else if (!bit) { _Pragma("unroll") for (int i = 0; i < 16; ++i) { S[0][i] = -1e30f; S[1][i] = -1e30f; } } \
                bf16x8 pk[2][2]; softmax_step(S, Os, negm, lsel, pk); pv64(cur, vboff, pk, Os); } \
            if (j_ + 1 <= u) st_write(nxt, skey, sch, KX, VX); \
            __syncthreads(); }
#pragma unroll 1
        for (int j = 0; j <= u; j += 2) {
            SEL_STEP(j, kA, vA, kB, vB)
            if (j + 1 <= u) SEL_STEP(j + 1, kB, vB, kA, vA)
        }
#undef SEL_STEP
    }
    {   const float lwt = lw + xshfl<32>(lw), lst = lsel + xshfl<32>(lsel);
        const GAS bf16* gp = proj + (rowb + t) * PLD + C_DG + head * 3;
        const float g0 = sigmoidf_(bf2f(gp[0])), g1 = sigmoidf_(bf2f(gp[1])) / fmaxf(lst, 1e-30f), g2 = sigmoidf_(bf2f(gp[2])) / fmaxf(lwt, 1e-30f);
        GAS bf16* op = ys + (rowb + t) * 1024 + 768 + head * 64;
#pragma unroll
        for (int db = 0; db < 2; ++db)
#pragma unroll
            for (int gq = 0; gq < 4; ++gq) { const int d0 = 32 * db + 8 * gq + 4 * hh; float y[4];
#pragma unroll
                for (int e = 0; e < 4; ++e) { const unsigned cw = ocp[db][2 * gq + (e >> 1)], ww = owp[db][2 * gq + (e >> 1)];
                    y[e] = g0 * ((e & 1) ? hi_bf(cw) : lo_bf(cw)) + g1 * Os[db][4 * gq + e] + g2 * ((e & 1) ? hi_bf(ww) : lo_bf(ww)); }
                u32x2 w; w.x = cvtpk(y[0], y[1]); w.y = cvtpk(y[2], y[3]); *(GAS u32x2*)(op + d0) = w; }
    }
}


DI void swa_unit(const GAS bf16* proj, GAS bf16* ys, LAS unsigned char* lds, const LAS float* bias2, const LAS float* biasd, const GAS float* sinks, int b, int u, int tid_in, int lane_in, int wave_in) {
    int tid = tid_in, lane = lane_in, wave = wave_in; asm volatile("" : "+v"(tid), "+v"(lane), "+s"(wave));
    const int t0 = u * 64; const int col = lane & 31, hh = lane >> 5, tl = col >> 1, kv = wave & 1, head = 2 * kv + (col & 1);
    const int t = t0 + (wave >> 1) * 16 + tl;
    const size_t rowb = (size_t)b * SEQ;
    const LAS float* b2h = bias2 + head;
    bf16x8 qf[4];
    { const float SC = 0.125f * 1.4426950408889634f; const GAS bf16* qp = proj + (rowb + t) * PLD + C_BQ + head * 64 + hh * 8;
#pragma unroll
      for (int s = 0; s < 4; ++s) { const u32x4 w = *(const GAS u32x4*)(qp + s * 16); u32x4 o;
          o.x = cvtpk(lo_bf(w.x) * SC, hi_bf(w.x) * SC); o.y = cvtpk(lo_bf(w.y) * SC, hi_bf(w.y) * SC); o.z = cvtpk(lo_bf(w.z) * SC, hi_bf(w.z) * SC); o.w = cvtpk(lo_bf(w.w) * SC, hi_bf(w.w) * SC);
          qf[s] = __builtin_bit_cast(bf16x8, o); } }
    const int skey = tid >> 3, sch = tid & 7;
    const int i16 = lane & 15, blk = (lane >> 4) & 1;
    const int kboff = kv * DBUF_BYTES + col * DK_STR + hh * 16;
    const int vboff = kv * DBUF_BYTES + 64 * DK_STR + (4 * hh + (i16 >> 2)) * DV_STR + (16 * blk + 4 * (i16 & 3)) * 2;
    const GAS unsigned char* kp = (const GAS unsigned char*)(proj + rowb * PLD + C_BK); const GAS unsigned char* vp = (const GAS unsigned char*)(proj + rowb * PLD + C_BV);
    const unsigned soffp = (unsigned)(skey * PLD + sch * 8) * 2u;
    u32x4 k0, v0, k1, v1;
    f32x16 O[2], negm; float lsum = 0.f;
#pragma unroll
    for (int i = 0; i < 16; ++i) { O[0][i] = 0.f; O[1][i] = 0.f; negm[i] = 120.f; }
    const int s0 = (u < 2) ? 2 - u : 0;
    { const unsigned so = soffp + (unsigned)(u - 2 + s0) * (64u * PLD * 2u); st_load(kp, vp, so, k0, v0); st_load(kp + 128, vp + 128, so, k1, v1);
      st_write(lds, skey, sch, k0, v0); st_write(lds + DBUF_BYTES, skey, sch, k1, v1); }
    __syncthreads();
#pragma unroll 1
    for (int s = s0; s < 3; ++s) {
        const int par = (s - s0) & 1; const LAS unsigned char* cur = lds + par * 2 * DBUF_BYTES; LAS unsigned char* nxt = lds + (par ^ 1) * 2 * DBUF_BYTES;
        if (s + 1 < 3) { const unsigned so = soffp + (unsigned)(u - 2 + s + 1) * (64u * PLD * 2u); st_load(kp, vp, so, k0, v0); st_load(kp + 128, vp + 128, so, k1, v1); }
        {   f32x16 S[2]; qk64(cur, kboff, qf, negm, S);
            mask_bias(S, t, (u - 2 + s) * 64, hh, 128, true, b2h);
            bf16x8 pk[2][2]; softmax_step(S, O, negm, lsum, pk); pv64(cur, vboff, pk, O); }
        if (s + 1 < 3) { st_write(nxt, skey, sch, k0, v0); st_write(nxt + DBUF_BYTES, skey, sch, k1, v1); }
        __syncthreads();
    }
    {   const float sinkp = (sinks[head] - biasd[128 * 12 + head]) * 1.4426950408889634f;
        const float lt = lsum + xshfl<32>(lsum) + __builtin_amdgcn_exp2f(sinkp + negm[0]);
        const float inv = 1.f / fmaxf(lt, 1e-30f);
        GAS bf16* op = ys + (rowb + t) * 1024 + 256 + head * 64;
#pragma unroll
        for (int db = 0; db < 2; ++db)
#pragma unroll
            for (int gq = 0; gq < 4; ++gq) { const int d0 = 32 * db + 8 * gq + 4 * hh;
                u32x2 w; w.x = cvtpk(O[db][4 * gq + 0] * inv, O[db][4 * gq + 1] * inv); w.y = cvtpk(O[db][4 * gq + 2] * inv, O[db][4 * gq + 3] * inv); *(GAS u32x2*)(op + d0) = w; }
    }
}

DI void route_rows4(const KA& a, int l, bf16* xr_, int tok0, int lane_) {
    int lane = lane_; asm volatile("" : "+v"(lane));
    const GAS bf16* xrow = (const GAS bf16*)(a.ws + WS_XB) + (size_t)tok0 * 1024; const GAS float* g = (const GAS float*)(a.in[28] + (size_t)l * 1024); GAS bf16* xr = (GAS bf16*)xr_;
    f32x4 v[4][4]; float ss[4]; u32x2 raw[4][4];
#pragma unroll
    for (int rr = 0; rr < 4; ++rr)
#pragma unroll
        for (int j = 0; j < 4; ++j) raw[rr][j] = *(const GAS u32x2*)(xrow + (size_t)rr * 1024 + 4 * (lane + 64 * j));
#pragma unroll
    for (int rr = 0; rr < 4; ++rr)
#pragma unroll
        for (int j = 0; j < 4; ++j) { v[rr][j][0] = lo_bf(raw[rr][j].x); v[rr][j][1] = hi_bf(raw[rr][j].x); v[rr][j][2] = lo_bf(raw[rr][j].y); v[rr][j][3] = hi_bf(raw[rr][j].y); }
#pragma unroll
    for (int rr = 0; rr < 4; ++rr) { float t = 0.f;
#pragma unroll
        for (int j = 0; j < 4; ++j) t += (v[rr][j][0] * v[rr][j][0] + v[rr][j][1] * v[rr][j][1]) + (v[rr][j][2] * v[rr][j][2] + v[rr][j][3] * v[rr][j][3]);
        ss[rr] = t; }
#pragma unroll
    for (int rr = 0; rr < 4; ++rr) ss[rr] = wave_sum(ss[rr]);
#pragma unroll
    for (int j = 0; j < 4; ++j) { const int k0 = 4 * (lane + 64 * j); const f32x4 gv = *(const GAS f32x4*)(g + k0);
#pragma unroll
        for (int rr = 0; rr < 4; ++rr) { const float r = 1.f / sqrtf(ss[rr] * (1.f / 1024.f) + 1e-6f); const f32x4 xn = v[rr][j] * r * gv;
            unsigned hi[4]; float lo[4];
#pragma unroll
            for (int e = 0; e < 4; ++e) { hi[e] = f2bf(xn[e]); lo[e] = xn[e] - __builtin_bit_cast(float, hi[e] << 16); }
            u32x2 wh, wl; wh.x = hi[0] | (hi[1] << 16); wh.y = hi[2] | (hi[3] << 16); wl.x = pk2(lo[0], lo[1]); wl.y = pk2(lo[2], lo[3]);
            *(GAS u32x2*)(xr + (size_t)(tok0 + rr) * 2048 + k0) = wh; *(GAS u32x2*)(xr + (size_t)(tok0 + rr) * 2048 + 1024 + k0) = wl; } }
}
struct SchedRoute { const char* A; const char* B; int pm;
    DI bool next(int i, Unit& u) const { if (i > 0) return false; u.pm = pm; u.pn = 0; u.aux = 0; u.pad = 0; u.a = A + (size_t)pm * 128 * 2048 * 2; u.b = B; return true; } };
struct EpiRoute { static constexpr bool CARRY = false; float* rlog;
    DI void operator()(const f32x4 (&acc)[2][2][4][2], const Unit& u, int wr, int wc, int fr, int fq) const {
        const int row0 = u.pm * 128 + wr * 64 + fr; const int col = wc * 32 + 8 * fq;
#pragma unroll
        for (int m = 0; m < 4; ++m) { float* rp = rlog + (size_t)(row0 + m * 16) * 128 + col; *(f32x4*)rp = acc[0][0][m][0]; *(f32x4*)(rp + 4) = acc[0][0][m][1]; }
    }
};
DI void route_decide(const KA& a, int l, const float* rl_row, int* rec_e, int* rec_slot, float* rec_w, unsigned* cnt, int tok) {
    float lg[36];
    const float* bg = a.in[30] + l * 4; const float* be = a.in[32] + l * 32;
#pragma unroll
    for (int q = 0; q < 9; ++q) { const f32x4 h = *(const f32x4*)(rl_row + 4 * q), lo = *(const f32x4*)(rl_row + 64 + 4 * q);
        lg[4 * q + 0] = h[0] + lo[0]; lg[4 * q + 1] = h[1] + lo[1]; lg[4 * q + 2] = h[2] + lo[2]; lg[4 * q + 3] = h[3] + lo[3]; }
#pragma unroll
    for (int i = 0; i < 4; ++i) lg[i] += bg[i];
#pragma unroll
    for (int i = 0; i < 32; ++i) lg[4 + i] += be[i];
    int gsel = 0; float gm = lg[0];
#pragma unroll
    for (int i = 1; i < 4; ++i) if (lg[i] > gm) { gm = lg[i]; gsel = i; }
    float gs = 0.f;
#pragma unroll
    for (int i = 0; i < 4; ++i) gs += __expf(lg[i] - gm);
    const float gwt = 1.f / gs;
    float v8[8];
#pragma unroll
    for (int i = 0; i < 8; ++i) { float x = lg[4 + i];
#pragma unroll
        for (int gq = 1; gq < 4; ++gq) x = (gsel == gq) ? lg[4 + gq * 8 + i] : x;
        v8[i] = x; }
    int i0 = 0; float m0 = v8[0];
#pragma unroll
    for (int i = 1; i < 8; ++i) if (v8[i] > m0) { m0 = v8[i]; i0 = i; }
    int i1 = -1; float m1 = -3e38f;
#pragma unroll
    for (int i = 0; i < 8; ++i) if (i != i0 && v8[i] > m1) { m1 = v8[i]; i1 = i; }
    if (i1 < 0) i1 = (i0 == 0) ? 1 : 0;
    const float w0 = 1.f / (1.f + __expf(m1 - m0)); const float w1 = 1.f - w0;
    const int e0 = gsel * 8 + i0, e1 = gsel * 8 + i1;
    const unsigned s0 = __hip_atomic_fetch_add(cnt + e0, 1u, __ATOMIC_RELAXED, __HIP_MEMORY_SCOPE_AGENT);
    const unsigned s1 = __hip_atomic_fetch_add(cnt + e1, 1u, __ATOMIC_RELAXED, __HIP_MEMORY_SCOPE_AGENT);
    (void)rec_e; (void)rec_slot; (void)rec_w;
    int* inv_as = (int*)(a.ws + WS_INVAS); float* inv_w = (float*)(a.ws + WS_INVW);
    inv_as[e0 * 32768 + (int)s0] = tok * 2; inv_w[e0 * 32768 + (int)s0] = w0 * gwt; inv_as[e1 * 32768 + (int)s1] = tok * 2 + 1; inv_w[e1 * 32768 + (int)s1] = w1 * gwt;
}
DI void expert_weights(const KA& a, int l, LAS unsigned char* lds, int it0, int it1, int gw, int NGW, int wave, int lane) {
    LAS float* scr = (LAS float*)(lds + wave * 16384);
    const float* wgt = a.in[33] + (size_t)l * 32 * 1024 * 256; const float* wup = a.in[34] + (size_t)l * 32 * 1024 * 256; const float* wdn = a.in[35] + (size_t)l * 32 * 256 * 1024;
    bf16* Wgu = (bf16*)(a.ws + WS_WGU); bf16* Wd = (bf16*)(a.ws + WS_WD);
    constexpr int I_E = 16 * 8, I_D = 4 * 32;
    constexpr int NIT = 32 * (2 * I_E + I_D);
    (void)NIT;
    for (int it = it0 + gw; it < it1; it += NGW) {
        const int e = it / (2 * I_E + I_D); int r = it % (2 * I_E + I_D);
        if (r < 2 * I_E) { const int up = r / I_E, q = r % I_E, kb = q / 8, nb = q % 8; const int n0 = nb * 32;
            const int drow = (n0 >> 7) * 256 + up * 128 + (n0 & 127);
            transpose_item((up ? wup : wgt) + (size_t)e * 1024 * 256, 256, 256, Wgu + (size_t)e * 512 * 1024, 1024, kb * 64, n0, drow, scr, lane);
        } else { r -= 2 * I_E; const int kb = r / 32, nb = r % 32;
            transpose_item(wdn + (size_t)e * 256 * 1024, 1024, 1024, Wd + (size_t)e * 1024 * 256, 256, kb * 64, nb * 32, nb * 32, scr, lane); }
    }
}
DI void build_offsets(const unsigned* cnt, LAS int* offt, int tid) {
    int c = 0;
    if (tid < 32) { c = (int)__hip_atomic_load(cnt + tid, __ATOMIC_RELAXED, __HIP_MEMORY_SCOPE_AGENT); offt[330 + tid] = (c + 255) & ~255; }
    __syncthreads();
    if (tid == 0) { int o = 0;
#pragma unroll
        for (int e = 0; e < 32; ++e) { offt[e] = o; o += offt[330 + e]; } offt[32] = o; }
    __syncthreads();
    if (tid < 32) offt[330 + tid] = c;
    for (int rt = tid; rt < (MOE_ROWS >> 8); rt += 512) { int e = 0; for (int j = 1; j < 32; ++j) e += (offt[j] <= rt * 256) ? 1 : 0; offt[40 + rt] = e; }
    __syncthreads();
}

template <unsigned PM>
__global__ void __launch_bounds__(512, 2) mk_fwd(Args a_) {
    extern __shared__ __attribute__((aligned(16))) unsigned char lds_raw[];
    LAS unsigned char* lds = (LAS unsigned char*)lds_raw;
    const int wave0 = __builtin_amdgcn_readfirstlane((int)threadIdx.x >> 6);
    if (threadIdx.x < 36) ((LAS unsigned long long*)(lds + PTAB_OFF))[threadIdx.x] = (unsigned long long)a_.in[threadIdx.x];
    __syncthreads();
    KA a; a.in.base = (unsigned)(size_t)(lds + PTAB_OFF); a.out = a_.out; a.ws = a_.ws;
    const int G = gridDim.x, bid = blockIdx.x, NGW = G * 8;
#define PHASE_IDS() int wave = wave0; asm volatile("" : "+s"(wave)); const int lane = my_lane(); const int tid_ = wave * 64 + lane, gw = bid * 8 + wave; (void)tid_; (void)gw; \
    const int xb = ((bid & 7) << 5) | (bid >> 3); (void)xb;        \
    KA ap = a; asm volatile("" : "+s"(ap.ws), "+s"(ap.out), "+s"(ap.in.base)); \
    bf16* hb = (bf16*)(ap.ws + WS_HB); bf16* proj = (bf16*)(ap.ws + WS_PROJ); bf16* gates = (bf16*)(ap.ws + WS_GATES); \
    bf16* ys = hb; bf16* x2b = hb; bf16* merged = proj; bf16* eo = proj; \
    bf16* kcb = (bf16*)(ap.ws + WS_KCVC); float* lrusum = (float*)(ap.ws + WS_LRUSUM); \
    int* rec_e = (int*)(ap.ws + WS_REC); int* rec_slot = rec_e + T * 2; float* rec_w = (float*)(rec_slot + T * 2); \
    int* rowtok = (int*)(ap.ws + WS_ROWTOK); float* roww = (float*)(ap.ws + WS_ROWW); \
    bf16* xs = (bf16*)(ap.ws + WS_XS); bf16* hmid = (bf16*)(ap.ws + WS_HMID); unsigned* ctl = (unsigned*)(ap.ws + WS_CTL); \
    (void)hb; (void)proj; (void)gates; (void)ys; (void)x2b; (void)merged; (void)eo; (void)kcb; (void)lrusum; (void)rec_e; (void)rec_slot; (void)rec_w; (void)rowtok; (void)roww; (void)xs; (void)hmid; (void)ctl
    volatile LAS unsigned* MISC = (volatile LAS unsigned*)(lds + MISC_OFF);
    LAS float* biasd = (LAS float*)(lds + BIAS_OFF);
    LAS int* offt = (LAS int*)(lds + OFFT_OFF);
    { PHASE_IDS();
    if (tid_ < 64) MISC[tid_] = 0u;
    for (int i = tid_; i < 129 * 12; i += 512) { const int d = i / 12, hd = i % 12; const int bk = d < 128 ? T5_BUCKET[d] : 31; const float* rb = a.in[1]; biasd[i] = rb[bk * 12 + hd]; ((LAS float*)(lds + BIAS2_OFF))[i] = (rb[bk * 12 + hd] - rb[31 * 12 + hd]) * 1.4426950408889634f; } }
    __syncthreads();
    const int lo = a_.ph_lo, hi = a_.ph_hi;
    XcdBarrier bar; bar.bar = (unsigned*)(a.ws + WS_CTL) + CW_BAR; bar.x = 0; bar.st = nullptr;
    if (hi - lo > 1) { PHASE_IDS(); bar = xcd_barrier_post(ctl + CW_BAR, MISC + 8, tid_ == 0); }
#ifndef SUB_MASK
#define SUB_MASK 0xFFu
#endif
#define SUB(k) ((SUB_MASK >> (k)) & 1u)
#define HASP(k) ((PM >> ((k) % PPL + ((k) >= 2 * PPL ? PPL : 0))) & 1u)
#define IN(k) (HASP(k) && lo <= (k) && (k) < hi)
#define SEAM(k) do { if ((k) + 1 < hi) { const int sl_ = my_lane(); int sw_ = wave0; asm volatile("" : "+s"(sw_)); xcd_barrier(bar, sw_ == 0 && sl_ == 0); } } while (0)
    for (int l = 0; l < DEPTH; ++l) {
        const int pb = l * PPL;
        if (IN(pb + 0)) { PHASE_IDS(); p1_weights_i8(ap, l, lds, gw, NGW, wave, lane); router_weights(ap, l, gw, NGW, lane); lru_weights(ap, l, gw, NGW, lane); cmp_weights(ap, l, lds, gw, NGW, wave, lane); phase0_weights(ap, l, lds, gw, NGW, wave, lane); phase0_rows(ap, l, 0, gw, NGW, lane); SEAM(pb + 0); }
        if (IN(pb + 1)) {
            PHASE_IDS();
            {   int K1q = 512; asm volatile("" : "+s"(K1q));
                pg8::Gemm g{K1q, 512, 512, 128, -1}; SchedP1 S{(const char*)(ap.ws + WS_HQ), (const char*)(ap.ws + WS_WQ), 128, 26, 1024, 1024, G, bid};
                EpiP1I8 E{proj, (unsigned char*)gates, ap.in[25] + (size_t)l * 4096, (const float*)(ap.ws + WS_HSC), (const float*)(ap.ws + WS_WSC)};
                pg8::gemm_phase<EpiP1I8, SchedP1, false, true>(lds, g, S, E, tid_); }
            SEAM(pb + 1);
        }
        if (IN(pb + 2)) {
            PHASE_IDS();
            LAS float* lamp = (LAS float*)(lds + MISC_OFF + 64);
            if (tid_ < 64) { const float* q1 = ap.in[13] + l * 32; const float* k1 = ap.in[14] + l * 32; const float* q2 = ap.in[15] + l * 32; const float* k2 = ap.in[16] + l * 32;
                float s1 = (lane < 32) ? q1[lane] * k1[lane] : 0.f, s2 = (lane < 32) ? q2[lane] * k2[lane] : 0.f; s1 = wave_sum(s1); s2 = wave_sum(s2);
                const float lam_init = 0.8f - 0.6f * __expf(-0.3f * (float)l); if (lane == 0) { lamp[0] = __expf(s1) - __expf(s2) + lam_init; lamp[1] = lam_init; } }
            __syncthreads();
            if (SUB(0)) { const LAS float* bias2 = (const LAS float*)(lds + BIAS2_OFF); const GAS float* subg = (const GAS float*)(ap.in[17] + l * 64);
                for (int pi = xb; pi < 256; pi += G) { const int bh = pi >> 4, qlo = pi & 15;
                    diff_unit((const GAS bf16*)proj, (GAS bf16*)ys, lds, bias2, subg, lamp, bh >> 2, bh & 3, 31 - qlo, wave);
                    diff_unit((const GAS bf16*)proj, (GAS bf16*)ys, lds, bias2, subg, lamp, bh >> 2, bh & 3, qlo, wave); } }
            { PHASE_IDS();
            if (SUB(3)) { __syncthreads(); const LAS float* bias2 = (const LAS float*)(lds + BIAS2_OFF); const GAS float* sinks = (const GAS float*)(ap.in[12] + l * 4);
                for (int pi = xb; pi < 512; pi += G) swa_unit((const GAS bf16*)proj, (GAS bf16*)ys, lds, bias2, biasd, sinks, pi >> 7, pi & 127, tid_, lane, wave); }
            if (SUB(2)) cmp_block(ap, l, (const GAS bf16*)proj, (const GAS bf16*)(ap.ws + WS_WCMP), (float*)(ap.ws + WS_CMPAB), kcb, bid, wave, lane);
            if (SUB(1)) { __syncthreads(); for (int task = xb; task < 512; task += G) lru_unit(ap, l, (const GAS bf16*)proj, (GAS bf16*)ys, (GAS float*)lrusum, lds, task, lane, wave, false); }
            }
            SEAM(pb + 2);
        }
        if (IN(pb + 4)) {
            PHASE_IDS();
            for (int task = xb; task < 512; task += G) lru_unit(ap, l, (const GAS bf16*)proj, (GAS bf16*)ys, (GAS float*)lrusum, lds, task, lane, wave, true);
            __syncthreads();
            if (SUB(4)) { const LAS float* bias2 = (const LAS float*)(lds + BIAS2_OFF);
                for (int pi = xb; pi < 256; pi += G) { const int bb = pi >> 6, ulo = pi & 63;
                    nsa_unit((const GAS bf16*)proj, (GAS bf16*)ys, (const GAS bf16*)kcb, lds, bias2, bb, 127 - ulo, tid_, lane, wave);
                    nsa_unit((const GAS bf16*)proj, (GAS bf16*)ys, (const GAS bf16*)kcb, lds, bias2, bb, ulo, tid_, lane, wave); } }
            SEAM(pb + 4);
        }
        if (IN(pb + 5)) {
            PHASE_IDS();
            int K5 = 256; asm volatile("" : "+s"(K5));
            pg8::Gemm g{K5, 1024, 256, 128, -1}; SchedP3a S{(const char*)ys, (const char*)(ap.ws + WS_WBR), G, xb};
            EpiP3a E{merged, (const unsigned char*)gates};
            pg8::gemm_phase<EpiP3a, SchedP3a>(lds, g, S, E, tid_); SEAM(pb + 5);
        }
        if (IN(pb + 6)) {
            PHASE_IDS();
            int K6 = 1024; asm volatile("" : "+s"(K6));
            pg8::Gemm g{K6, 1024, 1024, 128, -1}; SchedP3b S{(const char*)merged, (const char*)(ap.ws + WS_WOUT), G, xb};
            if (l == 0) { EpiP3b<true> E{ap.in[0], (bf16*)(ap.ws + WS_XB)}; pg8::gemm_phase<EpiP3b<true>, SchedP3b>(lds, g, S, E, tid_); }
            else { EpiP3b<false> E{nullptr, (bf16*)(ap.ws + WS_XB)}; pg8::gemm_phase<EpiP3b<false>, SchedP3b>(lds, g, S, E, tid_); }
            SEAM(pb + 6);
        }
        if (IN(pb + 7)) {
            PHASE_IDS();
            bf16* xr = (bf16*)(ap.ws + WS_XR); float* rlog = (float*)(ap.ws + WS_RLOG);
            constexpr int NITW = 32 * (2 * 16 * 8 + 4 * 32);
            { const int pm = bid;
                for (int r = wave * 4; r < 128; r += 32) route_rows4(ap, l, xr, pm * 128 + r, lane);
                asm volatile("s_waitcnt vmcnt(0)" ::: "memory"); __syncthreads();
                { pg8::Gemm g{2048, 2048, 2048, 128, 0}; SchedRoute S{(const char*)xr, (const char*)(ap.ws + WS_WR), pm}; EpiRoute E{rlog};
                  pg8::gemm_phase<EpiRoute, SchedRoute>(lds, g, S, E, tid_); }
                asm volatile("s_waitcnt vmcnt(0)" ::: "memory"); __syncthreads();
                if (tid_ < 128) route_decide(ap, l, rlog + (size_t)(pm * 128 + tid_) * 128, rec_e, rec_slot, rec_w, ctl + CW_CNT + l * 32, pm * 128 + tid_);
                __syncthreads();
            }
            expert_weights(ap, l, lds, 0, NITW, gw, NGW, wave, lane);
            SEAM(pb + 7);
        }
        if (IN(pb + 9)) {
            PHASE_IDS();
            build_offsets(ctl + CW_CNT + l * 32, offt, tid_);
            int K9 = 1024; asm volatile("" : "+s"(K9));
            pg8::Gemm g{K9, 2048, 1024, 128, -1}; SchedM2 S{(const char*)(ap.ws + WS_XR), (const char*)(ap.ws + WS_WGU), offt, (const int*)(ap.ws + WS_INVAS), G, xb};
            EpiM2 E{hmid};
            pg8::gemm_phase<EpiM2, SchedM2, true>(lds, g, S, E, tid_); SEAM(pb + 9);
        }
        if (IN(pb + 10)) {
            PHASE_IDS();
            build_offsets(ctl + CW_CNT + l * 32, offt, tid_);
            int K3 = 256; asm volatile("" : "+s"(K3));
            pg8::Gemm g{K3, 256, 256, 128, -1}; SchedM3 S{(const char*)hmid, (const char*)(ap.ws + WS_WD), offt, G, xb};
            EpiM3 E{eo, (const int*)(ap.ws + WS_INVAS), (const float*)(ap.ws + WS_INVW), offt};
            pg8::gemm_phase<EpiM3, SchedM3>(lds, g, S, E, tid_); SEAM(pb + 10);
        }
    }
    if (IN(2 * PPL)) { PHASE_IDS(); phase0_rows(ap, DEPTH, 1, gw, NGW, lane); }
#undef IN
#undef SEAM
}

typedef void (*kern_t)(Args);
template <unsigned PM> static bool setup_kernel() {
    if (hipFuncSetAttribute((const void*)mk_fwd<PM>, hipFuncAttributeMaxDynamicSharedMemorySize, LDS_BYTES) != hipSuccess) { fprintf(stderr, "kernel_launch: hipFuncSetAttribute failed\n"); return false; }
    return true;
}
extern "C" void kernel_launch(void* const* d_in, const int* in_sizes, int n_in, void* d_out, int out_size, void* d_ws, size_t ws_size, hipStream_t stream) {
    static int grid = 0;
    if (grid == 0) {
        if (n_in != 36 || out_size != T * D || ws_size < WS_END) { fprintf(stderr, "kernel_launch: unexpected shapes (n_in %d out %d ws %zu)\n", n_in, out_size, ws_size); grid = -1; return; }
        int dev = 0, cus = 0;
        if (hipGetDevice(&dev) != hipSuccess || hipDeviceGetAttribute(&cus, hipDeviceAttributeMultiprocessorCount, dev) != hipSuccess) { grid = -1; return; }
        bool ok = true;
#if MK_ONE_LAUNCH
        ok = setup_kernel<0xFFFu>();
#endif
        if (!ok) { grid = -1; return; }
        (void)hipGetLastError();
        grid = cus;
        if (grid != 256) { fprintf(stderr, "kernel_launch: built for a 256-CU device (got %d)\n", cus); grid = -1; return; }
    }
    if (grid < 0) return;
    if (hipMemsetAsync((char*)d_ws + WS_CTL, 0, CTL_ZERO_BYTES, stream) != hipSuccess) return;
    Args a{};
    for (int i = 0; i < 36; ++i) a.in[i] = (const float*)d_in[i];
    a.out = (float*)d_out; a.ws = (unsigned char*)d_ws;
#if MK_ONE_LAUNCH
    a.ph_lo = 0; a.ph_hi = NPH;
    hipLaunchKernelGGL(mk_fwd<0xFFFu>, dim3(grid), dim3(512), LDS_BYTES, stream, a);
#endif
}
```

```cpp
#include <hip/hip_runtime.h>
#include <cstdio>
#include <cstdint>

#ifndef MK_ONE_LAUNCH
#define MK_ONE_LAUNCH 1
#endif

#define DI __device__ __forceinline__
#define GAS __attribute__((address_space(1)))
#define LAS __attribute__((address_space(3)))
typedef unsigned short bf16;
typedef short bf16x8 __attribute__((ext_vector_type(8)));
typedef float f32x4 __attribute__((ext_vector_type(4)));
typedef int i32x4 __attribute__((ext_vector_type(4)));
typedef unsigned u32x4 __attribute__((ext_vector_type(4)));
typedef unsigned u32x2 __attribute__((ext_vector_type(2)));
typedef float f32x16 __attribute__((ext_vector_type(16)));
typedef float f32x2 __attribute__((ext_vector_type(2)));
typedef short s16x4 __attribute__((ext_vector_type(4)));
typedef __bf16 bf16x2_t __attribute__((ext_vector_type(2)));
typedef short v4i16_t __attribute__((__vector_size__(4 * sizeof(short))));
#define MFMA32(a, b, c) __builtin_amdgcn_mfma_f32_32x32x16_bf16((a), (b), (c), 0, 0, 0)

constexpr int BATCH = 4, SEQ = 8192, T = BATCH * SEQ, D = 1024, DEPTH = 2;
constexpr int NIN = 2444, PLD = 2560, N1 = 6656, GLD = 4096;
constexpr int C_AX = 0, C_AG = 256, C_BQ = 512, C_BK = 768, C_BV = 896, C_CQ = 1024, C_CK = 1280, C_CV = 1536, C_DQ = 1792,
              C_KC = 2048, C_VC = 2112, C_KS = 2176, C_VS = 2240, C_KW = 2304, C_VW = 2368, C_DG = 2432;
constexpr int NCMP = 511;
constexpr int MOE_ROWS = 73728;
constexpr int PPL = 11;
constexpr int NPH = 2 * PPL + 1;

constexpr size_t MiB = 1u << 20;
constexpr size_t WS_CTL = 0, CTL_ZERO_BYTES = 1 * MiB;
constexpr size_t WS_KCVC = 1 * MiB;
constexpr size_t WS_LRUSUM = 2 * MiB;
constexpr size_t WS_REC = 2 * MiB + 256 * 1024;
constexpr size_t WS_ROWTOK = 3 * MiB;
constexpr size_t WS_ROWW = 3 * MiB + 512 * 1024;
constexpr size_t WS_WIN = 4 * MiB;
constexpr size_t WS_WQ = 4 * MiB;
constexpr size_t WS_WSC = 13 * MiB;
constexpr size_t WS_HSC = 13 * MiB + 65536;
constexpr size_t WS_HQ = 21 * MiB;
constexpr size_t WS_INVAS = 296 * MiB;
constexpr size_t WS_INVW = 300 * MiB;
constexpr size_t WS_XB = 373 * MiB;
constexpr size_t WS_WBR = 17 * MiB;
constexpr size_t WS_WOUT = 19 * MiB;
constexpr size_t WS_HB = 21 * MiB;
constexpr size_t WS_PROJ = 85 * MiB;
constexpr size_t WS_GATES = 245 * MiB;
constexpr size_t WS_WGU = 245 * MiB;
constexpr size_t WS_WD = 277 * MiB;
constexpr size_t WS_XS = 293 * MiB;
constexpr size_t WS_HMID = 437 * MiB;
constexpr size_t WS_XR = 85 * MiB;
constexpr size_t WS_RLOG = 213 * MiB;
constexpr size_t WS_WR = 501 * MiB;
constexpr size_t WS_WCMP = 502 * MiB;
constexpr size_t WS_CMPAB = 503 * MiB;
constexpr size_t WS_LRUW = 505 * MiB + 65536;
constexpr size_t WS_END = 506 * MiB;
constexpr int CW_BAR = 4096;
constexpr int CW_CNT = 16384;

constexpr int RING_BYTES = 131072;
constexpr int MISC_OFF = RING_BYTES;
constexpr int BIAS_OFF = MISC_OFF + 256;
constexpr int OFFT_OFF = BIAS_OFF + 129 * 12 * 4;
constexpr int PTAB_OFF = OFFT_OFF + (40 + 288 + 40) * 4;
constexpr int BIAS2_OFF = PTAB_OFF + 36 * 8;
constexpr int LRUEX_OFF = BIAS2_OFF + 129 * 12 * 4;
constexpr int LDS_BYTES = 163840;
constexpr int LRUCST_OFF = LRUEX_OFF + 8 * 64 * 2 * 4;
constexpr int LRUCAR_OFF = LRUCST_OFF + 3 * 64 * 4;
static_assert(PTAB_OFF % 8 == 0 && LRUCAR_OFF + 8 * 64 * 4 <= LDS_BYTES, "LDS map");

DI float bf2f(bf16 v) { return __builtin_bit_cast(float, (unsigned)v << 16); }
DI float lo_bf(unsigned w) { return __builtin_bit_cast(float, w << 16); }
DI float hi_bf(unsigned w) { return __builtin_bit_cast(float, w & 0xffff0000u); }
DI unsigned f2bf(float f) { unsigned u = __builtin_bit_cast(unsigned, f); return (u + 0x7fffu + ((u >> 16) & 1u)) >> 16; }
DI unsigned pk2(float lo, float hi) { return f2bf(lo) | (f2bf(hi) << 16); }
DI float rl(float v, int i) { return __builtin_bit_cast(float, __builtin_amdgcn_readlane(__builtin_bit_cast(int, v), i)); }
DI int rli(int v, int i) { return __builtin_amdgcn_readlane(v, i); }
DI int my_lane() { int l; asm volatile("v_mbcnt_lo_u32_b32 %0, -1, 0\n\tv_mbcnt_hi_u32_b32 %0, -1, %0" : "=v"(l)); return l; }
template <int O> DI int xshfl_i(int v) {
    if constexpr (O < 32) return __builtin_amdgcn_ds_swizzle(v, (O << 10) | 0x1f);
    else { const int l = my_lane(); return __builtin_amdgcn_ds_bpermute((l ^ 32) << 2, v); }
}
template <int O> DI float xshfl(float v) { return __builtin_bit_cast(float, xshfl_i<O>(__builtin_bit_cast(int, v))); }
DI float wave_sum(float v) { v += xshfl<1>(v); v += xshfl<2>(v); v += xshfl<4>(v); v += xshfl<8>(v); v += xshfl<16>(v); v += xshfl<32>(v); return v; }
DI float wave_max(float v) { v = fmaxf(v, xshfl<1>(v)); v = fmaxf(v, xshfl<2>(v)); v = fmaxf(v, xshfl<4>(v)); v = fmaxf(v, xshfl<8>(v)); v = fmaxf(v, xshfl<16>(v)); v = fmaxf(v, xshfl<32>(v)); return v; }
DI float sigmoidf_(float x) { return __builtin_amdgcn_rcpf(1.f + __builtin_amdgcn_exp2f(-1.4426950408889634f * x)); }
DI float gelu_tanh(float x) { const float u = 0.7978845608028654f * (x + 0.044715f * x * x * x); const float e = __expf(2.f * u); const float th = 1.f - 2.f * __builtin_amdgcn_rcpf(e + 1.f); return 0.5f * x * (1.f + th); }
DI float softplusf_(float x) { return fmaxf(x, 0.f) + log1pf(__expf(-fabsf(x))); }
#define LDS_WAIT() asm volatile("s_waitcnt lgkmcnt(0)" ::: "memory")
#define VM_WAIT() asm volatile("s_waitcnt vmcnt(0)" ::: "memory")

__device__ const unsigned char T5_BUCKET[128] = {
0,1,2,3,4,5,6,7,8,9,10,11,12,13,14,15,16,16,16,17,17,18,18,18,19,19,19,20,20,20,20,21,21,21,21,22,22,22,22,22,23,23,23,23,23,23,24,24,24,24,24,24,25,25,25,25,25,25,25,26,26,26,26,26,26,26,26,27,27,27,27,27,27,27,27,27,27,28,28,28,28,28,28,28,28,28,28,29,29,29,29,29,29,29,29,29,29,29,29,30,30,30,30,30,30,30,30,30,30,30,30,30,30,31,31,31,31,31,31,31,31,31,31,31,31,31,31,31};

#define XB_TMO      128
#define XB_XCNT(j)  (256  + 64 * (j))
#define XB_XSUB(j)  (1280 + 64 * (j))
#define XB_XGEN(j)  (2304 + 64 * (j))
#define XB_TOP      3328
#define XB_TOPGEN   3392
#define XCD_BAR_WORDS 3456
#define XB_SPIN_CAP (1u << 22)
DI unsigned xb_ld(unsigned* p)              { return __hip_atomic_load(p, __ATOMIC_RELAXED, __HIP_MEMORY_SCOPE_AGENT); }
DI unsigned xb_add(unsigned* p, unsigned v) { return __hip_atomic_fetch_add(p, v, __ATOMIC_RELAXED, __HIP_MEMORY_SCOPE_AGENT); }
DI unsigned xb_xcc_id() { return (unsigned)__builtin_amdgcn_s_getreg((3 << 11) | 20) & 0xFu; }
#define XB_SPIN(cond, bar) do { unsigned _sp = 0; while (cond) { __builtin_amdgcn_s_sleep(1); \
    if ((++_sp & 255u) == 0u) { if (xb_ld(&(bar)[XB_TMO])) break; if (_sp > XB_SPIN_CAP) { atomicAdd(&(bar)[XB_TMO], 1u); break; } } } } while (0)
struct XcdBarrier { unsigned* bar; unsigned x; volatile LAS unsigned* st; };
DI XcdBarrier xcd_barrier_post(unsigned* bar, volatile LAS unsigned* st, bool leader) {
    XcdBarrier b; b.bar = bar; b.x = xb_xcc_id(); b.st = st;
    if (leader) (void)xb_add(&bar[XB_XCNT(b.x)], 1u);
    return b;
}
DI void xcd_barrier_complete(unsigned* bar, unsigned x, unsigned& nloc, unsigned& nx) {
    const unsigned G = gridDim.x * gridDim.y * gridDim.z;
    unsigned sum, cnt, mine, sp = 0u;
    for (;;) {
        sum = 0u; cnt = 0u; mine = 0u;
#pragma unroll
        for (unsigned j = 0; j < 16; ++j) { const unsigned c = xb_ld(&bar[XB_XCNT(j)]); sum += c; cnt += (c > 0u) ? 1u : 0u; mine = (j == x) ? c : mine; }
        if (sum == G) break;
        __builtin_amdgcn_s_sleep(1);
        if ((++sp & 255u) == 0u) { if (xb_ld(&bar[XB_TMO])) break; if (sp > XB_SPIN_CAP) { atomicAdd(&bar[XB_TMO], 1u); break; } }
    }
    nloc = mine > 0u ? mine : 1u; nx = cnt > 0u ? cnt : 1u;
}
DI void xcd_barrier(const XcdBarrier& b, bool leader) {
    asm volatile("s_waitcnt vmcnt(0)" ::: "memory");
    __syncthreads();
    if (leader) {
        unsigned* bar = b.bar;
        __builtin_amdgcn_s_waitcnt(0);
        unsigned nloc = b.st[0], nx = b.st[1];
        if (nloc == 0u) { xcd_barrier_complete(bar, b.x, nloc, nx); b.st[0] = nloc; b.st[1] = nx; }
        const unsigned old = xb_add(&bar[XB_XSUB(b.x)], 1u);
        const unsigned gen = old / nloc;
        if (old + 1u == (gen + 1u) * nloc) {
            __builtin_amdgcn_fence(__ATOMIC_RELEASE, "agent");
            asm volatile("s_waitcnt vmcnt(0)" ::: "memory");
            const unsigned og = xb_add(&bar[XB_TOP], 1u);
            const unsigned tg = og / nx;
            if (og + 1u == (tg + 1u) * nx) xb_add(&bar[XB_TOPGEN], 1u);
            else XB_SPIN(xb_ld(&bar[XB_TOPGEN]) == tg, bar);
            __builtin_amdgcn_fence(__ATOMIC_ACQUIRE, "agent");
            xb_add(&bar[XB_XGEN(b.x)], 1u);
            asm volatile("s_waitcnt vmcnt(0)" ::: "memory");
        } else {
            XB_SPIN(xb_ld(&bar[XB_XGEN(b.x)]) == gen, bar);
            __builtin_amdgcn_fence(__ATOMIC_ACQUIRE, "agent");
            asm volatile("s_waitcnt vmcnt(0)" ::: "memory");
        }
    }
    __syncthreads();
}

namespace pg8 {
constexpr int BM = 256, BK = 64, HALF = 128, HTB = HALF * BK * 2;
__host__ __device__ __forceinline__ int lds_byte(int r, int c) { const int st = (r >> 4) * 2 + (c >> 5), rr = r & 15, cc = c & 31, ob = rr * 64 + cc * 2; return st * 1024 + (ob ^ (((ob >> 9) & 1) << 5)); }
__host__ __device__ __forceinline__ void stage_rc(int b, int& R, int& C) { const int st = b / 1024, sb = b % 1024, swz = sb ^ (((sb >> 9) & 1) << 5); R = (st >> 1) * 16 + swz / 64; C = (st & 1) * 32 + (swz % 64) / 2; }
__host__ __device__ __forceinline__ int perm32(int rho) { const int n = rho >> 4, i = rho & 15; return 8 * (i >> 2) + 4 * n + (i & 3); }
struct Unit { const char* a; const char* b; int pm, pn, aux, pad; };
struct Gemm { int K, lda, ldb, kstepA, hstepA; };
template <bool I8> struct AccT { typedef f32x4 type; };
template <> struct AccT<true> { typedef i32x4 type; };
template <class Epi, class Sched, bool GATHER = false, bool I8 = false>
DI void gemm_phase(LAS unsigned char* lds, const Gemm g, const Sched& S, const Epi& E, int tid_in) {
    int tid = tid_in; asm volatile("" : "+v"(tid));
    const int wid = __builtin_amdgcn_readfirstlane(tid >> 6), lane = tid & 63, wr = wid >> 2, wc = wid & 3, fr = lane & 15, fq = lane >> 4;
    const int K = g.K, nt = K / BK;
    unsigned voffA[2], voffB[2];
#pragma unroll
    for (int i = 0; i < 2; ++i) { int R, C; stage_rc(tid * 16 + i * 8192, R, C); const int Rb = (R & ~31) + perm32(R & 31);
        voffA[i] = (unsigned)(R * g.lda + C) * 2u; voffB[i] = (unsigned)(Rb * g.ldb + C) * 2u; }
    const size_t kstep = (size_t)(BK * 2), kstepA = (size_t)g.kstepA;
    const size_t hstepA = g.hstepA < 0 ? (size_t)HALF * g.lda * 2 : (size_t)g.hstepA, hstepB = (size_t)HALF * g.ldb * 2;
    const unsigned hstepA32 = (unsigned)hstepA;
    unsigned gC[2][2] = {{0u, 0u}, {0u, 0u}}, gN[2][2] = {{0u, 0u}, {0u, 0u}};
    const unsigned ldsw = (unsigned)wid * 1024u;
    const int aoff = lds_byte(wr * 64 + fr, fq * 8), boff = lds_byte(wc * 32 + fr, fq * 8);
#define PG8_SA(b, h) (((b) * 2 + (h)) * HTB)
#define PG8_SB(b, h) ((4 + (b) * 2 + (h)) * HTB)
#define PG8_STAGE(bufoff, gbase, voff) do { _Pragma("unroll") for (int _i = 0; _i < 2; ++_i) \
        __builtin_amdgcn_global_load_lds((const unsigned*)((const char*)(gbase) + (voff)[_i]), (LAS unsigned*)(lds + (bufoff) + ldsw + _i * 8192), 16, 0, 0); } while (0)
#define PG8_STAGEA(bufoff, gbase, h, nextsel) do { _Pragma("unroll") for (int _i = 0; _i < 2; ++_i) { \
        const unsigned _o = GATHER ? ((nextsel) ? gN[h][_i] : gC[h][_i]) : (voffA[_i] + (unsigned)(h) * hstepA32); \
        __builtin_amdgcn_global_load_lds((const unsigned*)((const char*)(gbase) + _o), (LAS unsigned*)(lds + (bufoff) + ldsw + _i * 8192), 16, 0, 0); } } while (0)
#define PG8_LDA(dst, b, h) do { _Pragma("unroll") for (int m = 0; m < 4; ++m) _Pragma("unroll") for (int k = 0; k < 2; ++k) dst[m][k] = *(const LAS bf16x8*)(lds + PG8_SA(b, h) + aoff + m * 2048 + k * 1024); } while (0)
#define PG8_LDB(dst, b, h) do { _Pragma("unroll") for (int n = 0; n < 2; ++n) _Pragma("unroll") for (int k = 0; k < 2; ++k) dst[n][k] = *(const LAS bf16x8*)(lds + PG8_SB(b, h) + boff + n * 2048 + k * 1024); } while (0)
#define PG8_MMA(ai, bj, At, Bt) do { __builtin_amdgcn_s_setprio(1); _Pragma("unroll") for (int m = 0; m < 4; ++m) _Pragma("unroll") for (int n = 0; n < 2; ++n) _Pragma("unroll") for (int k = 0; k < 2; ++k) \
        { if constexpr (I8) acc[ai][bj][m][n] = __builtin_amdgcn_mfma_i32_16x16x64_i8(__builtin_bit_cast(i32x4, Bt[n][k]), __builtin_bit_cast(i32x4, At[m][k]), acc[ai][bj][m][n], 0, 0, 0); \
          else acc[ai][bj][m][n] = __builtin_amdgcn_mfma_f32_16x16x32_bf16(Bt[n][k], At[m][k], acc[ai][bj][m][n], 0, 0, 0); } __builtin_amdgcn_s_setprio(0); } while (0)
#define PG8_WAIT_V(n) asm volatile("s_waitcnt vmcnt(" #n ")" ::: "memory")
#define PG8_WAIT_L(n) asm volatile("s_waitcnt lgkmcnt(" #n ")" ::: "memory")
#define PG8_BAR __builtin_amdgcn_s_barrier()
#define PG8_SCHED __builtin_amdgcn_sched_barrier(0)
    Unit cur, nxt; int ui = 0;
    if (!S.next(0, cur)) return;
    typedef typename AccT<I8>::type ACC;
    ACC acc[2][2][4][2];
#pragma unroll
    for (int a = 0; a < 2; ++a)
#pragma unroll
        for (int b = 0; b < 2; ++b)
#pragma unroll
            for (int m = 0; m < 4; ++m)
#pragma unroll
                for (int n = 0; n < 2; ++n) acc[a][b][m][n] = (ACC){0, 0, 0, 0};
    bf16x8 At[4][2], B0[2][2], B1[2][2];
    const char* cA = cur.a; const char* cB = cur.b;
    if constexpr (GATHER) S.rows(cur, tid, gC);
    PG8_STAGE(PG8_SB(0, 0), cB, voffB); PG8_STAGE(PG8_SB(0, 1), cB + hstepB, voffB); PG8_STAGEA(PG8_SA(0, 0), cA, 0, false); PG8_STAGEA(PG8_SA(0, 1), cA, 1, false);
    if (wr == 1) PG8_BAR;
    PG8_WAIT_V(2); PG8_BAR;
    PG8_STAGE(PG8_SB(1, 0), cB + kstep, voffB); PG8_STAGEA(PG8_SA(1, 0), cA + kstepA, 0, false); PG8_STAGE(PG8_SB(1, 1), cB + hstepB + kstep, voffB);
    PG8_WAIT_V(6); PG8_BAR;
    for (;;) {
        const bool has_next = S.next(ui + 1, nxt);
        const char* nA = has_next ? nxt.a : cA; const char* nB = has_next ? nxt.b : cB;
        if constexpr (GATHER) { if (has_next) S.rows(nxt, tid, gN); else {
#pragma unroll
            for (int h = 0; h < 2; ++h) { gN[h][0] = gC[h][0]; gN[h][1] = gC[h][1]; } } }
        for (int t = 0; t < nt; t += 2) {
            const bool last = (t == nt - 2);
            const char* a1 = cA + (size_t)(t + 1) * kstepA;
            const char* a2 = last ? nA : cA + (size_t)(t + 2) * kstepA; const char* b2 = last ? nB : cB + (size_t)(t + 2) * kstep;
            const char* a3 = a2 + kstepA; const char* b3 = b2 + kstep;
            PG8_LDB(B0, 0, 0); PG8_LDB(B1, 0, 1); PG8_SCHED; PG8_LDA(At, 0, 0); PG8_STAGEA(PG8_SA(1, 1), a1, 1, false);
            PG8_WAIT_V(8); PG8_WAIT_L(0); PG8_BAR; PG8_MMA(0, 0, At, B0); PG8_MMA(0, 1, At, B1); PG8_BAR; PG8_SCHED;
            PG8_LDA(At, 0, 1); PG8_STAGE(PG8_SB(0, 0), b2, voffB); PG8_STAGE(PG8_SB(0, 1), b2 + hstepB, voffB); PG8_STAGEA(PG8_SA(0, 0), a2, 0, last);
            PG8_WAIT_V(8); PG8_WAIT_L(0); PG8_BAR; PG8_MMA(1, 0, At, B0); PG8_MMA(1, 1, At, B1); PG8_BAR; PG8_SCHED;
            PG8_LDB(B0, 1, 0); PG8_LDB(B1, 1, 1); PG8_SCHED; PG8_LDA(At, 1, 0); PG8_STAGEA(PG8_SA(0, 1), a2, 1, last);
            PG8_WAIT_V(8); PG8_WAIT_L(0); PG8_BAR; PG8_MMA(0, 0, At, B0); PG8_MMA(0, 1, At, B1); PG8_BAR; PG8_SCHED;
            PG8_LDA(At, 1, 1); PG8_STAGE(PG8_SB(1, 0), b3, voffB); PG8_STAGE(PG8_SB(1, 1), b3 + hstepB, voffB); PG8_STAGEA(PG8_SA(1, 0), a3, 0, last);
            PG8_WAIT_V(8); PG8_WAIT_L(0); PG8_BAR; PG8_MMA(1, 0, At, B0); PG8_MMA(1, 1, At, B1); PG8_BAR; PG8_SCHED;
        }
        if (wr == 0) PG8_BAR;
        { const int el = my_lane(); E(acc, cur, wr, wc, el & 15, el >> 4); }
        if (!has_next) break;
        bool carried = false;
        if constexpr (Epi::CARRY) { if (nxt.aux != 0) { const int el = my_lane(); E.carry(acc, nxt, wr, wc, el & 15, el >> 4); carried = true; } }
        if (!carried) {
#pragma unroll
        for (int a = 0; a < 2; ++a)
#pragma unroll
            for (int b = 0; b < 2; ++b)
#pragma unroll
                for (int m = 0; m < 4; ++m)
#pragma unroll
                    for (int n = 0; n < 2; ++n) acc[a][b][m][n] = (ACC){0, 0, 0, 0};
        }
        cur = nxt; cA = nA; cB = nB; ++ui;
        if constexpr (GATHER) {
#pragma unroll
            for (int h = 0; h < 2; ++h) { gC[h][0] = gN[h][0]; gC[h][1] = gN[h][1]; } }
        if (wr == 1) PG8_BAR;
    }
    PG8_WAIT_V(0);
    PG8_BAR;
#undef PG8_SA
#undef PG8_SB
#undef PG8_STAGE
#undef PG8_STAGEA
#undef PG8_LDA
#undef PG8_LDB
#undef PG8_MMA
#undef PG8_WAIT_V
#undef PG8_WAIT_L
#undef PG8_BAR
#undef PG8_SCHED
}
}
using pg8::Unit;

DI unsigned cvt_pk_bf16(float lo, float hi) { unsigned r; asm volatile("s_nop 1\n\tv_cvt_pk_bf16_f32 %0, %1, %2" : "=v"(r) : "v"(lo), "v"(hi)); return r; }
DI u32x4 pack8(const f32x4& v0, const f32x4& v1) { u32x4 w; w.x = cvt_pk_bf16(v0[0], v0[1]); w.y = cvt_pk_bf16(v0[2], v0[3]); w.z = cvt_pk_bf16(v1[0], v1[1]); w.w = cvt_pk_bf16(v1[2], v1[3]); return w; }

struct SchedP1 {
    const char* A; const char* B; int nM, nN, rbA, rbB, G, c;
    DI bool next(int i, Unit& u) const {
        constexpr int NXCD = 8, WGM = 8; const int nwg = nM * nN;
        const long L = (long)i * G + c; if (L >= nwg) return false;
        int wgid = (int)L; { const int q = nwg / NXCD, r = nwg % NXCD, xcd = wgid % NXCD, off = wgid / NXCD; wgid = (xcd < r ? xcd * (q + 1) : r * (q + 1) + (xcd - r) * q) + off; }
        const int nig = WGM * nN, gid = wgid / nig, fm = gid * WGM, gsz = (nM - fm) < WGM ? (nM - fm) : WGM;
        u.pm = fm + ((wgid % nig) % gsz); u.pn = (wgid % nig) / gsz; u.aux = 0; u.pad = 0;
        u.a = A + (size_t)u.pm * 256 * rbA; u.b = B + (size_t)u.pn * 256 * rbB; return true;
    }
};
struct SchedP3a {
    const char* ys; const char* wbr; int G, c;
    DI bool next(int i, Unit& u) const {
        const int tile = (i >> 2) * G + c; if (tile >= 512) return false;
        const int br = i & 3; u.pm = tile >> 2; u.pn = tile & 3; u.aux = br; u.pad = 0;
        u.a = ys + ((size_t)u.pm * 256 * 1024 + br * 256) * 2; u.b = wbr + ((size_t)br * 1024 * 256 + (size_t)u.pn * 256 * 256) * 2; return true;
    }
};
struct SchedP3b {
    const char* A; const char* B; int G, c;
    DI bool next(int i, Unit& u) const {
        const int L = i * G + c; if (L >= 512) return false;
        u.pm = L >> 2; u.pn = L & 3; u.aux = 0; u.pad = 0;
        u.a = A + (size_t)u.pm * 256 * 1024 * 2; u.b = B + (size_t)u.pn * 256 * 1024 * 2; return true;
    }
};
struct SchedM2 {
    const char* xr; const char* wgu; const LAS int* offt; const int* rowsrc; int G, c;
    DI bool next(int i, Unit& u) const {
        const int NT = __builtin_amdgcn_readfirstlane(offt[32]) >> 8; const int L = i * G + c; if (L >= NT * 2) return false;
        const int rt = L >> 1, pn = L & 1; const int e = __builtin_amdgcn_readfirstlane(offt[40 + rt]);
        u.pm = rt; u.pn = pn; u.aux = e; u.pad = 0;
        u.a = xr; u.b = wgu + ((size_t)e * 512 + pn * 256) * 1024 * 2; return true;
    }
    DI void rows(const Unit& u, int tid, unsigned (&g)[2][2]) const {
        const int e = u.aux; const int base = u.pm * 256 - __builtin_amdgcn_readfirstlane(offt[e]), cnt = __builtin_amdgcn_readfirstlane(offt[330 + e]);
#pragma unroll
        for (int i = 0; i < 2; ++i) { int R, C; pg8::stage_rc(tid * 16 + i * 8192, R, C);
#pragma unroll
            for (int h = 0; h < 2; ++h) { const int lr = base + h * 128 + R; const int as = lr < cnt ? rowsrc[e * 32768 + lr] : 0;
                g[h][i] = (unsigned)(as >> 1) * 4096u + (unsigned)C * 2u; } }
    }
};
struct SchedM3 {
    const char* hmid; const char* wd; const LAS int* offt; int G, c;
    DI bool next(int i, Unit& u) const {
        const int NT = __builtin_amdgcn_readfirstlane(offt[32]) >> 8; const int L = i * G + c; if (L >= NT * 4) return false;
        const int rt = L >> 2, pn = L & 3; const int e = __builtin_amdgcn_readfirstlane(offt[40 + rt]);
        u.pm = rt; u.pn = pn; u.aux = e; u.pad = 0;
        u.a = hmid + (size_t)rt * 256 * 256 * 2; u.b = wd + ((size_t)e * 1024 + pn * 256) * 256 * 2; return true;
    }
};

struct EpiP1I8 {
    static constexpr bool CARRY = false;
    bf16* proj; unsigned char* gates; const float* bgate; const float* hsc; const float* wsc;
    DI void operator()(const i32x4 (&acc)[2][2][4][2], const Unit& u, int wr, int wc, int fr, int fq) const {
        const int row0 = u.pm * 256 + wr * 64 + fr;
        if (u.pn < 10) { const int colt = u.pn * 256 + wc * 32 + 8 * fq;
            f32x4 sv[2][2]; float rsv[2][4];
#pragma unroll
            for (int bj = 0; bj < 2; ++bj)
#pragma unroll
                for (int n = 0; n < 2; ++n) sv[bj][n] = *(const GAS f32x4*)((const GAS float*)wsc + colt + bj * 128 + 4 * n);
#pragma unroll
            for (int ai = 0; ai < 2; ++ai)
#pragma unroll
                for (int m = 0; m < 4; ++m) rsv[ai][m] = ((const GAS float*)hsc)[row0 + ai * 128 + m * 16];
#pragma unroll
            for (int ai = 0; ai < 2; ++ai)
#pragma unroll
                for (int m = 0; m < 4; ++m) { bf16* rowp = proj + (size_t)(row0 + ai * 128 + m * 16) * PLD + colt; const float rs = rsv[ai][m];
#pragma unroll
                    for (int bj = 0; bj < 2; ++bj) { f32x4 v0, v1;
#pragma unroll
                        for (int e = 0; e < 4; ++e) { v0[e] = (float)acc[ai][bj][m][0][e] * (rs * sv[bj][0][e]); v1[e] = (float)acc[ai][bj][m][1][e] * (rs * sv[bj][1][e]); }
                        *(u32x4*)(rowp + bj * 128) = pack8(v0, v1); } }
            return; }
        const int gcol = (u.pn - 10) * 256 + wc * 32 + 8 * fq; const float* wsc = this->wsc + 2560;
        f32x4 bv[2][2], sv[2][2];
#pragma unroll
        for (int bj = 0; bj < 2; ++bj)
#pragma unroll
            for (int n = 0; n < 2; ++n) { bv[bj][n] = *(const f32x4*)(bgate + gcol + bj * 128 + 4 * n); sv[bj][n] = *(const f32x4*)(wsc + gcol + bj * 128 + 4 * n); }
        float rsv[2][4];
#pragma unroll
        for (int ai = 0; ai < 2; ++ai)
#pragma unroll
            for (int m = 0; m < 4; ++m) rsv[ai][m] = ((const GAS float*)hsc)[row0 + ai * 128 + m * 16];
#pragma unroll
        for (int ai = 0; ai < 2; ++ai)
#pragma unroll
            for (int m = 0; m < 4; ++m) { const float rs = rsv[ai][m];
                unsigned char* rowp = gates + ((size_t)(u.pm * 16 + (u.pn - 10)) * 65536 + (size_t)((ai * 4 + m) * 8192 + (wr * 4 + wc) * 512 + (fq * 16 + fr) * 8));
#pragma unroll
                for (int bj = 0; bj < 2; ++bj) { unsigned q[8];
#pragma unroll
                    for (int n = 0; n < 2; ++n)
#pragma unroll
                        for (int e = 0; e < 4; ++e) { const float pre = (float)acc[ai][bj][m][n][e] * (rs * sv[bj][n][e]) + bv[bj][n][e];
                            q[4 * n + e] = (unsigned)fminf(256.f * sigmoidf_(pre), 255.5f); }
                    u32x2 w; w.x = q[0] | (q[1] << 8) | (q[2] << 16) | (q[3] << 24); w.y = q[4] | (q[5] << 8) | (q[6] << 16) | (q[7] << 24);
                    *(u32x2*)(rowp + bj * 4096) = w; }
                __builtin_amdgcn_sched_barrier(0); }
    }
};
struct EpiP3a {
    static constexpr bool CARRY = true;
    bf16* merged; const unsigned char* gates;
    DI void carry(f32x4 (&acc)[2][2][4][2], const Unit& u, int wr, int wc, int fr, int fq) const {
        const GAS unsigned char* gb = (const GAS unsigned char*)gates + (size_t)(u.pm * 16 + (u.aux - 1) * 4 + u.pn) * 65536;
        const unsigned go = (unsigned)((wr * 4 + wc) * 512 + (fq * 16 + fr) * 8);
        u32x2 gp[2][4][2], gn[2][4][2];
#pragma unroll
        for (int ai = 0; ai < 2; ++ai)
#pragma unroll
            for (int m = 0; m < 4; ++m)
#pragma unroll
                for (int bj = 0; bj < 2; ++bj) { gp[ai][m][bj] = *(const GAS u32x2*)(gb + go + (unsigned)(((ai * 4 + m) * 2 + bj) * 4096));
                    gn[ai][m][bj] = *(const GAS u32x2*)(gb + go + (unsigned)(((ai * 4 + m) * 2 + bj) * 4096 + 4 * 65536)); }
#pragma unroll
        for (int ai = 0; ai < 2; ++ai) {
#pragma unroll
            for (int m = 0; m < 4; ++m)
#pragma unroll
                for (int bj = 0; bj < 2; ++bj) {
#pragma unroll
                    for (int n = 0; n < 2; ++n) { const unsigned p4 = n ? gp[ai][m][bj].y : gp[ai][m][bj].x, n4 = n ? gn[ai][m][bj].y : gn[ai][m][bj].x;
#pragma unroll
                        for (int e = 0; e < 4; ++e) acc[ai][bj][m][n][e] *= ((float)((p4 >> (8 * e)) & 255u) + 0.5f) * __builtin_amdgcn_rcpf((float)((n4 >> (8 * e)) & 255u) + 0.5f); } }
            __builtin_amdgcn_sched_barrier(0); }
    }
    DI void operator()(const f32x4 (&acc)[2][2][4][2], const Unit& u, int wr, int wc, int fr, int fq) const {
        if (u.aux != 3) return;
        const GAS unsigned char* gb = (const GAS unsigned char*)gates + (size_t)(u.pm * 16 + 3 * 4 + u.pn) * 65536;
        GAS unsigned char* mb = (GAS unsigned char*)merged + ((size_t)(u.pm * 256) * 1024 + u.pn * 256) * 2;
        const unsigned go = (unsigned)((wr * 4 + wc) * 512 + (fq * 16 + fr) * 8), mo = (unsigned)((wr * 64 + fr) * 1024 + wc * 32 + 8 * fq) * 2u;
        u32x2 gw[2][4][2];
#pragma unroll
        for (int ai = 0; ai < 2; ++ai)
#pragma unroll
            for (int m = 0; m < 4; ++m)
#pragma unroll
                for (int bj = 0; bj < 2; ++bj) gw[ai][m][bj] = *(const GAS u32x2*)(gb + go + (unsigned)(((ai * 4 + m) * 2 + bj) * 4096));
#pragma unroll
        for (int ai = 0; ai < 2; ++ai) {
#pragma unroll
            for (int m = 0; m < 4; ++m)
#pragma unroll
                for (int bj = 0; bj < 2; ++bj) {
                    f32x4 v0 = acc[ai][bj][m][0], v1 = acc[ai][bj][m][1]; const u32x2 g2 = gw[ai][m][bj]; const float k256 = 0.00390625f;
#pragma unroll
                    for (int e = 0; e < 4; ++e) { v0[e] *= ((float)((g2.x >> (8 * e)) & 255u) + 0.5f) * k256; v1[e] *= ((float)((g2.y >> (8 * e)) & 255u) + 0.5f) * k256; }
                    *(GAS u32x4*)(mb + mo + (unsigned)((ai * 128 + m * 16) * 1024 + bj * 128) * 2u) = pack8(v0, v1); }
            __builtin_amdgcn_sched_barrier(0); }
    }
};
template <bool XF32> struct EpiP3b {
    static constexpr bool CARRY = false;
    const float* xin; bf16* xb_;
    DI void operator()(const f32x4 (&acc)[2][2][4][2], const Unit& u, int wr, int wc, int fr, int fq) const {
        GAS unsigned char* ob = (GAS unsigned char*)xb_ + ((size_t)(u.pm * 256) * 1024 + u.pn * 256) * 2;
        const unsigned lo = (unsigned)((wr * 64 + fr) * 1024 + wc * 32 + 8 * fq);
        if constexpr (XF32) {
            const GAS unsigned char* xb = (const GAS unsigned char*)xin + ((size_t)(u.pm * 256) * 1024 + u.pn * 256) * 4;
#pragma unroll
            for (int ai = 0; ai < 2; ++ai)
#pragma unroll
                for (int mh = 0; mh < 2; ++mh) {
                    f32x4 xv[2][2][2];
#pragma unroll
                    for (int m2 = 0; m2 < 2; ++m2)
#pragma unroll
                        for (int bj = 0; bj < 2; ++bj)
#pragma unroll
                            for (int n = 0; n < 2; ++n) xv[m2][bj][n] = *(const GAS f32x4*)(xb + (lo + (unsigned)((ai * 128 + (mh * 2 + m2) * 16) * 1024 + bj * 128 + 4 * n)) * 4u);
#pragma unroll
                    for (int m2 = 0; m2 < 2; ++m2)
#pragma unroll
                        for (int bj = 0; bj < 2; ++bj)
                            *(GAS u32x4*)(ob + (lo + (unsigned)((ai * 128 + (mh * 2 + m2) * 16) * 1024 + bj * 128)) * 2u) = pack8(xv[m2][bj][0] + acc[ai][bj][mh * 2 + m2][0], xv[m2][bj][1] + acc[ai][bj][mh * 2 + m2][1]);
                    __builtin_amdgcn_sched_barrier(0); }
        } else {
#pragma unroll
            for (int ai = 0; ai < 2; ++ai) {
                u32x4 xv[4][2];
#pragma unroll
                for (int m = 0; m < 4; ++m)
#pragma unroll
                    for (int bj = 0; bj < 2; ++bj) xv[m][bj] = *(const GAS u32x4*)(ob + (lo + (unsigned)((ai * 128 + m * 16) * 1024 + bj * 128)) * 2u);
#pragma unroll
                for (int m = 0; m < 4; ++m)
#pragma unroll
                    for (int bj = 0; bj < 2; ++bj) { const u32x4 x4 = xv[m][bj]; f32x4 v0 = acc[ai][bj][m][0], v1 = acc[ai][bj][m][1];
                        v0[0] += lo_bf(x4.x); v0[1] += hi_bf(x4.x); v0[2] += lo_bf(x4.y); v0[3] += hi_bf(x4.y); v1[0] += lo_bf(x4.z); v1[1] += hi_bf(x4.z); v1[2] += lo_bf(x4.w); v1[3] += hi_bf(x4.w);
                        *(GAS u32x4*)(ob + (lo + (unsigned)((ai * 128 + m * 16) * 1024 + bj * 128)) * 2u) = pack8(v0, v1); }
                __builtin_amdgcn_sched_barrier(0); }
        }
    }
};
struct EpiM2 {
    static constexpr bool CARRY = false;
    bf16* hmid;
    DI void operator()(const f32x4 (&acc)[2][2][4][2], const Unit& u, int wr, int wc, int fr, int fq) const {
        const int row0 = u.pm * 256 + wr * 64 + fr; const int col = u.pn * 128 + wc * 32 + 8 * fq;
#pragma unroll
        for (int ai = 0; ai < 2; ++ai)
#pragma unroll
            for (int m = 0; m < 4; ++m) { f32x4 h0, h1;
#pragma unroll
                for (int e = 0; e < 4; ++e) { const float g0 = acc[ai][0][m][0][e], g1 = acc[ai][0][m][1][e];
                    h0[e] = g0 * sigmoidf_(g0) * acc[ai][1][m][0][e]; h1[e] = g1 * sigmoidf_(g1) * acc[ai][1][m][1][e]; }
                *(u32x4*)(hmid + (size_t)(row0 + ai * 128 + m * 16) * 256 + col) = pack8(h0, h1); }
    }
};
struct EpiM3 {
    static constexpr bool CARRY = false;
    bf16* eo; const int* rowtok; const float* roww; const LAS int* offt;
    DI void operator()(const f32x4 (&acc)[2][2][4][2], const Unit& u, int wr, int wc, int fr, int fq) const {
        const int e = u.aux; const int cnt = __builtin_amdgcn_readfirstlane(offt[330 + e]);
        const int lr0 = u.pm * 256 - __builtin_amdgcn_readfirstlane(offt[e]) + wr * 64 + fr; const int colt = u.pn * 256 + wc * 32 + 8 * fq;
        int tk[2][4]; float wv[2][4];
#pragma unroll
        for (int ai = 0; ai < 2; ++ai)
#pragma unroll
            for (int m = 0; m < 4; ++m) { const int lr = lr0 + ai * 128 + m * 16; tk[ai][m] = -1; wv[ai][m] = 0.f;
                if (lr < cnt) { tk[ai][m] = ((const GAS int*)rowtok)[e * 32768 + lr]; wv[ai][m] = ((const GAS float*)roww)[e * 32768 + lr]; } }
#pragma unroll
        for (int ai = 0; ai < 2; ++ai)
#pragma unroll
            for (int m = 0; m < 4; ++m) {
                if (tk[ai][m] >= 0) { const float w = wv[ai][m]; GAS bf16* op = (GAS bf16*)eo + (size_t)tk[ai][m] * 1024 + colt;
#pragma unroll
                    for (int bj = 0; bj < 2; ++bj) *(GAS u32x4*)(op + bj * 128) = pack8(acc[ai][bj][m][0] * w, acc[ai][bj][m][1] * w); }
                __builtin_amdgcn_sched_barrier(0); }
    }
};

struct Args { const float* in[36]; float* out; unsigned char* ws; int ph_lo, ph_hi; };
struct InTab { unsigned base;
    DI const float* operator[](int i) const { unsigned long long v; const unsigned addr = base + (unsigned)i * 8u;
        asm volatile("ds_read_b64 %0, %1\n\ts_waitcnt lgkmcnt(0)" : "=v"(v) : "v"(addr) : "memory");
        const unsigned lo = __builtin_amdgcn_readfirstlane((unsigned)v), hi = __builtin_amdgcn_readfirstlane((unsigned)(v >> 32));
        return (const float*)(((unsigned long long)hi << 32) | lo); } };
struct KA { InTab in; float* out; unsigned char* ws; };

DI void transpose_item(const float* W_, int ldw, int nvalid, bf16* WT_, int ldt, int k0, int n0, int dst_row0, LAS float* scr, int lane) {
    const GAS float* W = (const GAS float*)W_; GAS bf16* WT = (GAS bf16*)WT_;
    const int nq = 4 * (lane & 7), kr8 = lane >> 3;
    f32x4 v[8];
#pragma unroll
    for (int i = 0; i < 8; ++i) { const int kk = 8 * i + kr8;
        if (n0 + nq + 3 < nvalid) v[i] = *(const GAS f32x4*)(W + (size_t)(k0 + kk) * ldw + n0 + nq);
        else {
#pragma unroll
            for (int e = 0; e < 4; ++e) v[i][e] = (n0 + nq + e < nvalid) ? W[(size_t)(k0 + kk) * ldw + n0 + nq + e] : 0.f; } }
#pragma unroll
    for (int i = 0; i < 8; ++i) { const int kk = 8 * i + kr8;
#pragma unroll
        for (int e = 0; e < 4; ++e) scr[kk * 33 + nq + e] = v[i][e]; }
    LDS_WAIT(); asm volatile("" ::: "memory");
    const int c = lane & 7;
#pragma unroll
    for (int j = 0; j < 4; ++j) { const int n = (lane >> 3) + 8 * j; const LAS float* s = scr + (8 * c) * 33 + n;
        u32x4 o; o.x = pk2(s[0 * 33], s[1 * 33]); o.y = pk2(s[2 * 33], s[3 * 33]); o.z = pk2(s[4 * 33], s[5 * 33]); o.w = pk2(s[6 * 33], s[7 * 33]);
        if (n0 + n < nvalid) *(GAS u32x4*)(WT + (size_t)(dst_row0 + n) * ldt + k0 + 8 * c) = o; }
    LDS_WAIT(); asm volatile("" ::: "memory");
}
DI void phase0_weights(const KA& a, int l, LAS unsigned char* lds, int gw, int NGW, int wave, int lane) {
    LAS float* scr = (LAS float*)(lds + wave * 16384);
    const float* w_in = a.in[4] + (size_t)l * 1024 * NIN;
    const float* w_gate = a.in[24] + (size_t)l * 4 * 1024 * 1024;
    const float* w_br = a.in[26] + (size_t)l * 4 * 256 * 1024;
    const float* w_out = a.in[27] + (size_t)l * 1024 * 1024;
    bf16* Wt_in = (bf16*)(a.ws + WS_WIN); bf16* Wt_br = (bf16*)(a.ws + WS_WBR); bf16* Wt_out = (bf16*)(a.ws + WS_WOUT);
    constexpr int I_B = 4 * 4 * 32, I_O = 16 * 32, NIT = I_B + I_O;
    (void)w_gate; (void)w_in; (void)Wt_in;
    for (int it = gw; it < NIT; it += NGW) {
        int r = it;
        if (r < I_B) { const int br = r / 128, q = r % 128, kb = q / 32, nb = q % 32; transpose_item(w_br + (size_t)br * 256 * 1024, 1024, 1024, Wt_br + (size_t)br * 1024 * 256, 256, kb * 64, nb * 32, nb * 32, scr, lane); continue; } r -= I_B;
        { const int kb = r / 32, nb = r % 32; transpose_item(w_out, 1024, 1024, Wt_out, 1024, kb * 64, nb * 32, nb * 32, scr, lane); }
    }
}
DI void p1_weights_i8(const KA& a, int l, LAS unsigned char* lds, int gw, int NGW, int wave, int lane) {
    LAS float* scr = (LAS float*)(lds + wave * 16384);
    const GAS float* wgt = (const GAS float*)(a.in[24] + (size_t)l * 4 * 1024 * 1024); const GAS float* win = (const GAS float*)(a.in[4] + (size_t)l * 1024 * NIN);
    GAS unsigned char* Wq = (GAS unsigned char*)(a.ws + WS_WQ); GAS float* wsc = (GAS float*)(a.ws + WS_WSC);
    const int nq = 4 * (lane & 7), kr8 = lane >> 3;
    for (int it = NGW - 1 - gw; it < 128 + 77; it += NGW) {
        const bool isg = it < 128; const int br = it >> 5; const int n0 = isg ? (it & 31) * 32 : (it - 128) * 32;
        const int ldw = isg ? 1024 : NIN; const int nval = isg ? 1024 : NIN; const int drow0 = isg ? 2560 + br * 1024 + n0 : n0;
        const bool lok = (n0 + nq) < nval;
        const GAS float* W = (isg ? wgt + (size_t)br * 1024 * 1024 : win) + n0 + nq;
        f32x4 mx = {0.f, 0.f, 0.f, 0.f};
#pragma unroll 8
        for (int i = 0; i < 128; ++i) { f32x4 v = {0.f, 0.f, 0.f, 0.f}; if (lok) v = *(const GAS f32x4*)(W + (size_t)(8 * i + kr8) * ldw);
            mx[0] = fmaxf(mx[0], fabsf(v[0])); mx[1] = fmaxf(mx[1], fabsf(v[1])); mx[2] = fmaxf(mx[2], fabsf(v[2])); mx[3] = fmaxf(mx[3], fabsf(v[3])); }
#pragma unroll
        for (int e = 0; e < 4; ++e) { float m = mx[e]; m = fmaxf(m, xshfl<8>(m)); m = fmaxf(m, xshfl<16>(m)); m = fmaxf(m, xshfl<32>(m)); mx[e] = fmaxf(m, 1e-20f); }
        if (kr8 == 0 && lok) *(GAS f32x4*)(wsc + drow0 + nq) = mx * (1.f / 127.f);
        const f32x4 qs = {127.f / mx[0], 127.f / mx[1], 127.f / mx[2], 127.f / mx[3]};
#pragma unroll 1
        for (int kb = 0; kb < 16; ++kb) {
            f32x4 v[8];
#pragma unroll
            for (int i = 0; i < 8; ++i) { v[i] = (f32x4){0.f, 0.f, 0.f, 0.f}; if (lok) v[i] = *(const GAS f32x4*)(W + (size_t)(kb * 64 + 8 * i + kr8) * ldw); }
#pragma unroll
            for (int i = 0; i < 8; ++i) { const int kk = 8 * i + kr8;
#pragma unroll
                for (int e = 0; e < 4; ++e) scr[kk * 33 + nq + e] = __builtin_rintf(v[i][e] * qs[e]); }
            LDS_WAIT(); asm volatile("" ::: "memory");
            const int n = lane >> 1, kh = lane & 1; u32x4 o[2];
#pragma unroll
            for (int h2 = 0; h2 < 2; ++h2) { unsigned w4[4];
#pragma unroll
                for (int d = 0; d < 4; ++d) { unsigned wv = 0u;
#pragma unroll
                    for (int e = 0; e < 4; ++e) wv |= ((unsigned)(int)scr[(32 * kh + 16 * h2 + 4 * d + e) * 33 + n] & 255u) << (8 * e);
                    w4[d] = wv; }
                o[h2].x = w4[0]; o[h2].y = w4[1]; o[h2].z = w4[2]; o[h2].w = w4[3]; }
            if (n0 + n < nval) { GAS unsigned char* dst = Wq + (size_t)(drow0 + n) * 1024 + kb * 64 + 32 * kh; *(GAS u32x4*)dst = o[0]; *(GAS u32x4*)(dst + 16) = o[1]; }
            LDS_WAIT(); asm volatile("" ::: "memory");
        }
    }
}

DI void router_weights(const KA& a, int l, int gw, int NGW, int lane) {
    bf16* Wr = (bf16*)(a.ws + WS_WR);
    const float* wg = a.in[29] + (size_t)l * 1024 * 4; const float* we = a.in[31] + (size_t)l * 1024 * 32;
    for (int n = gw; n < 36; n += NGW) {
        for (int i = 0; i < 16; ++i) { const int k = lane + 64 * i; const float w = (n < 4) ? wg[k * 4 + n] : we[k * 32 + (n - 4)];
            const unsigned hi = f2bf(w); const float hf = __builtin_bit_cast(float, hi << 16); const unsigned lo = f2bf(w - hf);
            Wr[(size_t)n * 2048 + k] = (bf16)hi; Wr[(size_t)n * 2048 + 1024 + k] = (bf16)hi; Wr[(size_t)(64 + n) * 2048 + k] = (bf16)lo; Wr[(size_t)(64 + n) * 2048 + 1024 + k] = 0; }
    }
}

DI void cmp_weights(const KA& a, int l, LAS unsigned char* lds, int gw, int NGW, int wave, int lane) {
    LAS float* scr = (LAS float*)(lds + wave * 16384);
    bf16* Wc = (bf16*)(a.ws + WS_WCMP); float* pt = (float*)(a.ws + WS_CMPAB + 2 * MiB);
    for (int it = gw; it < 128 + 64; it += NGW) {
        if (it < 128) { const int kv = it >> 6, q = it & 63, kb = q >> 1, nb = q & 1; const float* w1 = a.in[kv ? 22 : 19] + (size_t)l * 2048 * 64;
            bf16* dst = Wc + (size_t)kv * 256 * 1024 - (kb >= 16 ? 1024 : 0);
            transpose_item(w1, 64, 64, dst, 1024, kb * 64, nb * 32, (kb >= 16 ? 64 : 0) + nb * 32, scr, lane);
        } else { const int kv = (it - 128) >> 5, part = (it - 128) & 31;
            const GAS float* w1 = (const GAS float*)(a.in[kv ? 22 : 19] + (size_t)l * 2048 * 64) + (size_t)part * 64 * 64; const GAS float* pos = (const GAS float*)(a.in[kv ? 21 : 18] + (size_t)l * 2048) + part * 64;
            float acc = 0.f;
#pragma unroll 16
            for (int k = 0; k < 64; ++k) acc += pos[k] * w1[(size_t)k * 64 + lane];
            pt[(kv * 32 + part) * 64 + lane] = acc; }
    }
}

DI void lru_weights(const KA& a, int l, int gw, int NGW, int lane) {
    bf16* W = (bf16*)(a.ws + WS_LRUW); const float* wa = a.in[7] + (size_t)l * 4 * 4096; const float* wx = a.in[9] + (size_t)l * 4 * 4096;
    (void)NGW; { const int idx = gw * 64 + lane; if (idx < 32768) { const int i = idx & 63, j = (idx >> 6) & 63, mat = (idx >> 12) & 1, hbk = idx >> 13;
        W[idx] = (bf16)f2bf((mat ? wx : wa)[(size_t)hbk * 4096 + i * 64 + j]); } }
}
DI void phase0_rows(const KA& a, int l, int mode, int gw, int NGW, int lane) {
    const GAS float* xin = (const GAS float*)a.in[0]; GAS bf16* xb = (GAS bf16*)(a.ws + WS_XB);
    const GAS bf16* eo = (const GAS bf16*)(a.ws + WS_PROJ);
    GAS float* outp = (GAS float*)a.out;
    const GAS float* g = (const GAS float*)(mode ? a.in[2] : (a.in[3] + (size_t)l * 1024));
    f32x4 gv[4];
#pragma unroll
    for (int j = 0; j < 4; ++j) gv[j] = *(const GAS f32x4*)(g + 4 * (lane + 64 * j));
    for (int m0 = gw * 4; m0 < T; m0 += NGW * 4) {
        f32x4 v[4][4]; float ss[4];
#pragma unroll
        for (int rr = 0; rr < 4; ++rr)
#pragma unroll
            for (int j = 0; j < 4; ++j) { if (l == 0) v[rr][j] = *(const GAS f32x4*)(xin + (size_t)(m0 + rr) * 1024 + 4 * (lane + 64 * j));
                else { const u32x2 xw = *(const GAS u32x2*)(xb + (size_t)(m0 + rr) * 1024 + 4 * (lane + 64 * j)); v[rr][j][0] = lo_bf(xw.x); v[rr][j][1] = hi_bf(xw.x); v[rr][j][2] = lo_bf(xw.y); v[rr][j][3] = hi_bf(xw.y); } }
        if (l > 0) {
#pragma unroll
            for (int rr = 0; rr < 4; ++rr)
#pragma unroll
                for (int j = 0; j < 4; ++j) {
                    const u32x2 e0 = *(const GAS u32x2*)(eo + (size_t)(2 * (m0 + rr)) * 1024 + 4 * (lane + 64 * j));
                    const u32x2 e1 = *(const GAS u32x2*)(eo + (size_t)(2 * (m0 + rr) + 1) * 1024 + 4 * (lane + 64 * j));
                    v[rr][j][0] += lo_bf(e0.x) + lo_bf(e1.x); v[rr][j][1] += hi_bf(e0.x) + hi_bf(e1.x); v[rr][j][2] += lo_bf(e0.y) + lo_bf(e1.y); v[rr][j][3] += hi_bf(e0.y) + hi_bf(e1.y); } }
#pragma unroll
        for (int rr = 0; rr < 4; ++rr) { float t = 0.f;
#pragma unroll
            for (int j = 0; j < 4; ++j) t += (v[rr][j][0] * v[rr][j][0] + v[rr][j][1] * v[rr][j][1]) + (v[rr][j][2] * v[rr][j][2] + v[rr][j][3] * v[rr][j][3]);
            ss[rr] = t; }
#pragma unroll
        for (int rr = 0; rr < 4; ++rr) ss[rr] = wave_sum(ss[rr]);
        if (mode) {
#pragma unroll
            for (int rr = 0; rr < 4; ++rr) { const float r = 1.f / sqrtf(ss[rr] * (1.f / 1024.f) + 1e-6f); const size_t m = (size_t)(m0 + rr);
#pragma unroll
                for (int j = 0; j < 4; ++j) *(GAS f32x4*)(outp + m * 1024 + 4 * (lane + 64 * j)) = v[rr][j] * r * gv[j]; }
        } else {
            GAS unsigned char* hq = (GAS unsigned char*)(a.ws + WS_HQ); GAS float* hsc = (GAS float*)(a.ws + WS_HSC);
            float am[4];
#pragma unroll
            for (int rr = 0; rr < 4; ++rr) { const float r = 1.f / sqrtf(ss[rr] * (1.f / 1024.f) + 1e-6f); const size_t m = (size_t)(m0 + rr); float t = 0.f;
#pragma unroll
                for (int j = 0; j < 4; ++j) { if (l > 0) { u32x2 w; w.x = pk2(v[rr][j][0], v[rr][j][1]); w.y = pk2(v[rr][j][2], v[rr][j][3]); *(GAS u32x2*)(xb + m * 1024 + 4 * (lane + 64 * j)) = w; }
                    const f32x4 y = v[rr][j] * r * gv[j]; v[rr][j] = y;
                    t = fmaxf(t, fmaxf(fmaxf(fabsf(y[0]), fabsf(y[1])), fmaxf(fabsf(y[2]), fabsf(y[3])))); }
                am[rr] = t; }
#pragma unroll
            for (int rr = 0; rr < 4; ++rr) am[rr] = fmaxf(wave_max(am[rr]), 1e-20f);
#pragma unroll
            for (int rr = 0; rr < 4; ++rr) { const size_t m = (size_t)(m0 + rr); const float qs = 127.f / am[rr];
                if (lane == 0) hsc[m] = am[rr] * (1.f / 127.f);
#pragma unroll
                for (int j = 0; j < 4; ++j) { const f32x4 y = v[rr][j] * qs;
                    const unsigned q = ((unsigned)(int)__builtin_rintf(y[0]) & 255u) | (((unsigned)(int)__builtin_rintf(y[1]) & 255u) << 8) | (((unsigned)(int)__builtin_rintf(y[2]) & 255u) << 16) | (((unsigned)(int)__builtin_rintf(y[3]) & 255u) << 24);
                    *(GAS unsigned*)(hq + m * 1024 + 4 * (lane + 64 * j)) = q; } }
        }
    }
}

DI int crow(int i, int hh) { return (i & 3) + 8 * (i >> 2) + 4 * hh; }
DI unsigned cvtpk(float lo, float hi) { f32x2 v = {lo, hi}; bf16x2_t b = __builtin_convertvector(v, bf16x2_t); return __builtin_bit_cast(unsigned, b); }
template <int CTRL, int RMASK> DI float dppf(float oldv, float v) { return __builtin_bit_cast(float, __builtin_amdgcn_update_dpp(__builtin_bit_cast(int, oldv), __builtin_bit_cast(int, v), CTRL, RMASK, 0xf, false)); }
template <int CTRL, int RMASK> DI void scan_step(float& a, float& b) {
    const float ap = dppf<CTRL, RMASK>(1.f, a), bp = dppf<CTRL, RMASK>(0.f, b); b = a * bp + b; a = a * ap; }
DI void lru_unit(const KA& a, int l, const GAS bf16* proj, GAS bf16* ys, GAS float* sums, LAS unsigned char* lds, int task, int lane_in, int wave_in, bool final) {
    int lane = lane_in, wave = wave_in; asm volatile("" : "+v"(lane), "+s"(wave));
    const int chunk = task & 31, hbk = (task >> 5) & 3, b = task >> 7;
    const int ts = chunk * 256 + wave * 32; const size_t rowb = (size_t)b * SEQ;
    LAS unsigned char* wl = lds + wave * 16384;
    LAS float* ex = (LAS float*)(lds + LRUEX_OFF); LAS float* cst = (LAS float*)(lds + LRUCST_OFF); LAS float* car = (LAS float*)(lds + LRUCAR_OFF) + wave * 64;
    {
        const int c = hbk * 64 + lane;
        const GAS float* cw = (const GAS float*)(a.in[5] + (size_t)l * 4 * 256);
        const float cw0 = cw[c], cw1 = cw[256 + c], cw2 = cw[512 + c], cw3 = cw[768 + c]; const float cb = a.in[6][l * 256 + c];
        if (wave == 0) { cst[lane] = a.in[8][l * 256 + c]; cst[64 + lane] = a.in[10][l * 256 + c]; cst[128 + lane] = -8.f * softplusf_(-a.in[11][l * 256 + c]); }
        const GAS bf16* xp = proj + (rowb + ts) * PLD + C_AX + c;
        float x3 = (ts >= 3) ? bf2f(*(xp - 3 * PLD)) : 0.f, x2 = (ts >= 2) ? bf2f(*(xp - 2 * PLD)) : 0.f, x1 = (ts >= 1) ? bf2f(*(xp - PLD)) : 0.f;
#pragma unroll 8
        for (int n = 0; n < 32; ++n) { const float x0 = bf2f(xp[(size_t)n * PLD]); const float xc = cb + cw0 * x3 + cw1 * x2 + cw2 * x1 + cw3 * x0;
            *(LAS bf16*)(wl + n * 144 + lane * 2) = (bf16)f2bf(xc); *(LAS float*)(wl + 4608 + n * 272 + lane * 4) = xc; x3 = x2; x2 = x1; x1 = x0; }
    }
    const int n = lane & 31, hh = lane >> 5;
    f32x16 D[4];
    {
        const GAS bf16* wt = (const GAS bf16*)(a.ws + WS_LRUW) + (size_t)hbk * 8192;
        bf16x8 bfr[4];
        LDS_WAIT();
#pragma unroll
        for (int s4 = 0; s4 < 4; ++s4) bfr[s4] = *(const LAS bf16x8*)(wl + n * 144 + hh * 16 + s4 * 32);
#pragma unroll
        for (int m = 0; m < 4; ++m) {
#pragma unroll
            for (int s4 = 0; s4 < 4; ++s4) { const bf16x8 af = *(const GAS bf16x8*)(wt + (size_t)(m >> 1) * 4096 + (32 * (m & 1) + n) * 64 + 8 * hh + 16 * s4);
                if (s4 == 0) { f32x16 z;
#pragma unroll
                    for (int i = 0; i < 16; ++i) z[i] = 0.f;
                    D[m] = MFMA32(af, bfr[s4], z); } else D[m] = MFMA32(af, bfr[s4], D[m]); } }
    }
    __syncthreads();
    const bool t0 = (ts + n) == 0;
#pragma unroll
    for (int mm = 0; mm < 2; ++mm)
#pragma unroll
        for (int g4 = 0; g4 < 4; ++g4) { const int c0 = 32 * mm + 8 * g4 + 4 * hh;
            const f32x4 vba = *(const LAS f32x4*)(cst + c0), vbx = *(const LAS f32x4*)(cst + 64 + c0), vc8 = *(const LAS f32x4*)(cst + 128 + c0);
            const f32x4 vxc = *(const LAS f32x4*)(wl + 4608 + n * 272 + c0 * 4);
#pragma unroll
            for (int e = 0; e < 4; ++e) { const int i = 4 * g4 + e;
                const float r = sigmoidf_(D[mm][i] + vba[e]), ig = sigmoidf_(D[2 + mm][i] + vbx[e]);
                const float la = vc8[e] * r; const float av = __expf(la);
                const float mult = t0 ? 1.f : sqrtf(fmaxf(1.f - __expf(2.f * la), 0.f));
                float aa = av, bb = mult * ig * vxc[e];
                scan_step<0x111, 0xf>(aa, bb); scan_step<0x112, 0xf>(aa, bb); scan_step<0x114, 0xf>(aa, bb); scan_step<0x118, 0xf>(aa, bb); scan_step<0x142, 0xa>(aa, bb);
                D[mm][i] = aa; D[2 + mm][i] = bb; } }
    if (n == 31) {
#pragma unroll
        for (int mm = 0; mm < 2; ++mm)
#pragma unroll
            for (int i = 0; i < 16; ++i) { const int c = 32 * mm + crow(i, hh); ex[(wave * 64 + c) * 2] = D[mm][i]; ex[(wave * 64 + c) * 2 + 1] = D[2 + mm][i]; } }
    __syncthreads();
    if (!final) {
        if (wave == 0) { float hv = 0.f, av = 1.f;
#pragma unroll
            for (int w = 0; w < 8; ++w) { const float A_ = ex[(w * 64 + lane) * 2], H_ = ex[(w * 64 + lane) * 2 + 1]; hv = A_ * hv + H_; av *= A_; }
            GAS float* sp = sums + ((size_t)((b * 4 + hbk) * 32 + chunk) * 64 + lane) * 2; sp[0] = av; sp[1] = hv; }
    } else {
        {   float hv = 0.f;
            {   const GAS f32x2* sp = (const GAS f32x2*)(sums + ((size_t)((b * 4 + hbk) * 32) * 64 + lane) * 2);
                int cc = 0;
                for (; cc + 8 <= chunk; cc += 8) { f32x2 v[8];
#pragma unroll
                    for (int e = 0; e < 8; ++e) v[e] = sp[(size_t)(cc + e) * 64];
#pragma unroll
                    for (int e = 0; e < 8; ++e) hv = v[e][0] * hv + v[e][1]; }
                for (; cc < chunk; ++cc) { const f32x2 v = sp[(size_t)cc * 64]; hv = v[0] * hv + v[1]; } }
            for (int w = 0; w < wave; ++w) { const float A_ = ex[(w * 64 + lane) * 2], H_ = ex[(w * 64 + lane) * 2 + 1]; hv = A_ * hv + H_; }
            car[lane] = hv; }
        LDS_WAIT(); asm volatile("" ::: "memory");
        const GAS bf16* gp = proj + (rowb + ts + n) * PLD + C_AG + hbk * 64; GAS bf16* yp = ys + (rowb + ts + n) * 1024 + hbk * 64;
#pragma unroll
        for (int mm = 0; mm < 2; ++mm)
#pragma unroll
            for (int g4 = 0; g4 < 4; ++g4) { const int c0 = 32 * mm + 8 * g4 + 4 * hh; const f32x4 cv = *(const LAS f32x4*)(car + c0);
                const u32x2 gt2 = *(const GAS u32x2*)(gp + c0); float y[4];
#pragma unroll
                for (int e = 0; e < 4; ++e) { const int i = 4 * g4 + e; const float hv = D[2 + mm][i] + D[mm][i] * cv[e];
                    const float gt = (e == 0) ? lo_bf(gt2.x) : (e == 1) ? hi_bf(gt2.x) : (e == 2) ? lo_bf(gt2.y) : hi_bf(gt2.y); y[e] = hv * gelu_tanh(gt); }
                u32x2 yo; yo.x = cvtpk(y[0], y[1]); yo.y = cvtpk(y[2], y[3]); *(GAS u32x2*)(yp + c0) = yo; }
    }
    __syncthreads();
}

constexpr int DK_STR = 144, DV_STR = 192, DBUF_BYTES = 64 * DK_STR + 64 * DV_STR;
DI bf16x8 pack_half(const f32x16& x, int s2) { u32x4 p;
    if (s2 == 0) { p.x = cvtpk(x[0], x[1]); p.y = cvtpk(x[2], x[3]); p.z = cvtpk(x[4], x[5]); p.w = cvtpk(x[6], x[7]); }
    else { p.x = cvtpk(x[8], x[9]); p.y = cvtpk(x[10], x[11]); p.z = cvtpk(x[12], x[13]); p.w = cvtpk(x[14], x[15]); }
    return __builtin_bit_cast(bf16x8, p); }
DI s16x4 vtr(const LAS unsigned char* p) { return __builtin_bit_cast(s16x4, __builtin_amdgcn_ds_read_tr16_b64_v4i16((LAS v4i16_t*)p)); }
DI float max16(const f32x16& x) { float a = fmaxf(fmaxf(x[0], x[1]), fmaxf(x[2], x[3])), b = fmaxf(fmaxf(x[4], x[5]), fmaxf(x[6], x[7])), c = fmaxf(fmaxf(x[8], x[9]), fmaxf(x[10], x[11])), d = fmaxf(fmaxf(x[12], x[13]), fmaxf(x[14], x[15])); return fmaxf(fmaxf(a, b), fmaxf(c, d)); }
DI void diff_unit(const GAS bf16* proj, GAS bf16* ys, LAS unsigned char* lds, const LAS float* bias2, const GAS float* subg, const LAS float* lamp, int b, int h, int qb, int wave_in) {
    int wave = wave_in; asm volatile("" : "+s"(wave)); const int lane = my_lane(); const int tid = wave * 64 + lane;
    const int q0 = qb * 256 + wave * 32; const int ql = lane & 31, hh = lane >> 5; const int q = q0 + ql;
    const size_t rowb = (size_t)b * SEQ;
    const float SC = 0.17677669529663687f * 1.4426950408889634f;
    bf16x8 qf[2][2];
    { const GAS bf16* qp = proj + (rowb + q) * PLD + C_CQ + h * 64 + hh * 8;
#pragma unroll
      for (int m = 0; m < 2; ++m)
#pragma unroll
        for (int s = 0; s < 2; ++s) { const u32x4 w = *(const GAS u32x4*)(qp + m * 32 + s * 16); u32x4 o;
            o.x = cvtpk(lo_bf(w.x) * SC, hi_bf(w.x) * SC); o.y = cvtpk(lo_bf(w.y) * SC, hi_bf(w.y) * SC); o.z = cvtpk(lo_bf(w.z) * SC, hi_bf(w.z) * SC); o.w = cvtpk(lo_bf(w.w) * SC, hi_bf(w.w) * SC);
            qf[m][s] = __builtin_bit_cast(bf16x8, o); } }
    f32x16 O[2][2], negm[2];
#pragma unroll
    for (int i = 0; i < 16; ++i) { O[0][0][i] = 0.f; O[0][1][i] = 0.f; O[1][0][i] = 0.f; O[1][1][i] = 0.f; negm[0][i] = 120.f; negm[1][i] = 120.f; }
    float lsum[2] = {0.f, 0.f};
    const int nsteps = 4 * qb + 4, mysteps = 4 * qb + (wave >> 1) + 1;
    const int skey = tid >> 3, sch = tid & 7;
    const GAS unsigned char* kgb = (const GAS unsigned char*)(proj + rowb * PLD + C_CK + h * 64);
    const GAS unsigned char* vgb = (const GAS unsigned char*)(proj + rowb * PLD + C_CV + h * 64);
    const unsigned soff = (unsigned)(skey * PLD + sch * 8) * 2u;
    u32x4 kr = *(const GAS u32x4*)(kgb + soff), vr = *(const GAS u32x4*)(vgb + soff);
    *(LAS u32x4*)(lds + skey * DK_STR + sch * 16) = kr; *(LAS u32x4*)(lds + 64 * DK_STR + skey * DV_STR + sch * 16) = vr;
    __syncthreads();
    const int i16 = lane & 15, blk = (lane >> 4) & 1;
    const int kboff = ql * DK_STR + hh * 16;
    const int vboff = 64 * DK_STR + (4 * hh + (i16 >> 2)) * DV_STR + (16 * blk + 4 * (i16 & 3)) * 2;
#pragma unroll 1
    for (int kt = 0; kt < nsteps; ++kt) {
        const LAS unsigned char* cur = lds + (kt & 1) * DBUF_BYTES; LAS unsigned char* nxt = lds + ((kt + 1) & 1) * DBUF_BYTES;
        if (kt + 1 < nsteps) { const unsigned so = soff + (unsigned)(kt + 1) * (64u * PLD * 2u); kr = *(const GAS u32x4*)(kgb + so); vr = *(const GAS u32x4*)(vgb + so); }
        if (kt < mysteps) {
            const int kbase = kt * 64;
            const bool near = (q0 - (kbase + 63) < 113);
#pragma unroll
            for (int m = 0; m < 2; ++m) {
                bf16x8 pk[2][2];
                f32x16 S[2]; float ts = 0.f;
                {   bf16x8 kf[2][2];
#pragma unroll
                    for (int t = 0; t < 2; ++t)
#pragma unroll
                        for (int s = 0; s < 2; ++s) kf[t][s] = *(const LAS bf16x8*)(cur + kboff + t * 32 * DK_STR + m * 64 + s * 32);
#pragma unroll
                    for (int t = 0; t < 2; ++t) { S[t] = MFMA32(kf[t][0], qf[m][0], negm[m]); S[t] = MFMA32(kf[t][1], qf[m][1], S[t]); } }
                if (near) {
#pragma unroll
                    for (int t = 0; t < 2; ++t)
#pragma unroll
                        for (int g = 0; g < 2; ++g) { float tb[8];
#pragma unroll
                            for (int j = 0; j < 8; ++j) { const int dist = q - (kbase + 32 * t + crow(8 * g + j, hh)); const int di = dist < 0 ? 0 : (dist < 128 ? dist : 128); tb[j] = bias2[di * 12 + 4 + h]; }
#pragma unroll
                            for (int j = 0; j < 8; ++j) { const int dist = q - (kbase + 32 * t + crow(8 * g + j, hh)); S[t][8 * g + j] += dist >= 0 ? tb[j] : -1e30f; }
                            __builtin_amdgcn_sched_barrier(0); } }
#pragma unroll
                for (int t = 0; t < 2; ++t)
#pragma unroll
                    for (int i = 0; i < 16; ++i) { const float p = __builtin_amdgcn_exp2f(S[t][i]); S[t][i] = p; ts += p; }
                if (__builtin_amdgcn_ballot_w64(!(ts < 1.0e30f)) != 0ull) {
                {   bf16x8 kf[2][2];
#pragma unroll
                        for (int t = 0; t < 2; ++t)
#pragma unroll
                            for (int s = 0; s < 2; ++s) kf[t][s] = *(const LAS bf16x8*)(cur + kboff + t * 32 * DK_STR + m * 64 + s * 32);
#pragma unroll
                        for (int t = 0; t < 2; ++t) { S[t] = MFMA32(kf[t][0], qf[m][0], negm[m]); S[t] = MFMA32(kf[t][1], qf[m][1], S[t]); } }
                    if (near) {
#pragma unroll
                        for (int t = 0; t < 2; ++t)
#pragma unroll
                            for (int g = 0; g < 2; ++g) { float tb[8];
#pragma unroll
                                for (int j = 0; j < 8; ++j) { const int dist = q - (kbase + 32 * t + crow(8 * g + j, hh)); const int di = dist < 0 ? 0 : (dist < 128 ? dist : 128); tb[j] = bias2[di * 12 + 4 + h]; }
#pragma unroll
                                for (int j = 0; j < 8; ++j) { const int dist = q - (kbase + 32 * t + crow(8 * g + j, hh)); S[t][8 * g + j] += dist >= 0 ? tb[j] : -1e30f; }
                                __builtin_amdgcn_sched_barrier(0); } }
                    float tm = fmaxf(max16(S[0]), max16(S[1])); tm = fmaxf(tm, xshfl<32>(tm));
                    const float sh = fmaxf(tm, 0.f); const float al = __builtin_amdgcn_exp2f(-sh);
                    lsum[m] *= al; ts = 0.f;
#pragma unroll
                    for (int i = 0; i < 16; ++i) { O[m][0][i] *= al; O[m][1][i] *= al; negm[m][i] -= sh; }
#pragma unroll
                    for (int t = 0; t < 2; ++t)
#pragma unroll
                        for (int i = 0; i < 16; ++i) { const float p = __builtin_amdgcn_exp2f(S[t][i] - sh); S[t][i] = p; ts += p; }
                }
                lsum[m] += ts;
#pragma unroll
                for (int t = 0; t < 2; ++t) { pk[t][0] = pack_half(S[t], 0); pk[t][1] = pack_half(S[t], 1); }
#pragma unroll
                for (int t = 0; t < 2; ++t)
#pragma unroll
                    for (int s2 = 0; s2 < 2; ++s2)
#pragma unroll
                        for (int db = 0; db < 2; ++db) {
                            const s16x4 lo = vtr(cur + vboff + (32 * t + 16 * s2) * DV_STR + db * 64), hi = vtr(cur + vboff + (32 * t + 16 * s2 + 8) * DV_STR + db * 64);
                            const bf16x8 vf = __builtin_shufflevector(lo, hi, 0, 1, 2, 3, 4, 5, 6, 7);
                            O[m][db] = MFMA32(vf, pk[t][s2], O[m][db]); }
                ;
            }
        }
        if (kt + 1 < nsteps) { *(LAS u32x4*)(nxt + skey * DK_STR + sch * 16) = kr; *(LAS u32x4*)(nxt + 64 * DK_STR + skey * DV_STR + sch * 16) = vr; }
        __syncthreads();
    }
    const float l0 = lsum[0] + xshfl<32>(lsum[0]), l1 = lsum[1] + xshfl<32>(lsum[1]);
    const float lam = lamp[0], lam_init = lamp[1];
    const float i0 = 1.f / fmaxf(l0, 1e-30f), i1 = lam / fmaxf(l1, 1e-30f);
    float ss = 0.f;
#pragma unroll
    for (int db = 0; db < 2; ++db)
#pragma unroll
        for (int i = 0; i < 16; ++i) { const float at = O[0][db][i] * i0 - O[1][db][i] * i1; O[0][db][i] = at; ss += at * at; }
    ss += xshfl<32>(ss);
    const float r = (1.f - lam_init) / sqrtf(ss * (1.f / 64.f) + 1e-5f);
    GAS bf16* op = ys + (rowb + q) * 1024 + 512 + h * 64;
#pragma unroll
    for (int db = 0; db < 2; ++db)
#pragma unroll
        for (int gq = 0; gq < 4; ++gq) { const int d0 = 32 * db + 8 * gq + 4 * hh; const f32x4 sg = *(const GAS f32x4*)(subg + d0);
            u32x2 w; w.x = cvtpk(O[0][db][4 * gq + 0] * r * sg[0], O[0][db][4 * gq + 1] * r * sg[1]); w.y = cvtpk(O[0][db][4 * gq + 2] * r * sg[2], O[0][db][4 * gq + 3] * r * sg[3]);
            *(GAS u32x2*)(op + d0) = w; }
}

struct SchedCmp { const char* proj; const char* wc; int G, c;
    DI bool next(int i, Unit& u) const { const int L = i * G + c; if (L >= 16) return false; const int kv = L >> 3, rt = L & 7;
        u.pm = rt; u.pn = 0; u.aux = kv; u.pad = 0; u.a = proj + ((size_t)rt * 256 * 16 * PLD + (kv ? C_VC : C_KC)) * 2; u.b = wc + (size_t)kv * 256 * 1024 * 2; return true; } };
struct EpiCmp { static constexpr bool CARRY = false; float* ab;
    DI void operator()(const f32x4 (&acc)[2][2][4][2], const Unit& u, int wr, int wc, int fr, int fq) const {
        const int row0 = u.pm * 256 + wr * 64 + fr; const int col = wc * 32 + 8 * fq;
#pragma unroll
        for (int ai = 0; ai < 2; ++ai)
#pragma unroll
            for (int m = 0; m < 4; ++m) { float* rp = ab + ((size_t)u.aux * 2048 + row0 + ai * 128 + m * 16) * 128 + col; *(f32x4*)rp = acc[ai][0][m][0]; *(f32x4*)(rp + 4) = acc[ai][0][m][1]; }
    }
};
DI void cmp_finish(const KA& a, int l, const float* ab, bf16* kcb, int task, int lane) {
    const int kv = task / (BATCH * NCMP), r = task % (BATCH * NCMP), b = r / NCMP, c = r % NCMP;
    const float* w2 = a.in[kv ? 23 : 20] + (size_t)l * 4096; const float* pt = ab + 2 * 2048 * 128;
    const size_t g = (size_t)kv * 2048 + b * 512 + c;
    float ptv = 0.f;
#pragma unroll 8
    for (int part = 0; part < 32; ++part) ptv += pt[(kv * 32 + part) * 64 + lane];
    const float h1 = ab[g * 128 + lane] + ab[(g + 1) * 128 + 64 + lane] + ptv;
    const float gl = gelu_tanh(h1); float o = 0.f;
#pragma unroll
    for (int j = 0; j < 64; ++j) o += rl(gl, j) * w2[j * 64 + lane];
    kcb[((size_t)(kv * BATCH + b) * 512 + c) * 64 + lane] = (bf16)f2bf(o);
    if (c == NCMP - 1) kcb[((size_t)(kv * BATCH + b) * 512 + NCMP) * 64 + lane] = 0;
}

DI void cmp_block(const KA& a, int l, const GAS bf16* proj, const GAS bf16* wcT, float* ab, bf16* kcb, int bid, int wave, int lane) {
    const int kv = bid >> 7, g0 = (bid & 127) * 16, r = lane & 15, q = lane >> 4, sh = wave >> 2;
    const int grow = g0 + r + sh; const bool st_ok = !(sh != 0 && (grow & 511) == 0);
    const int gld = grow > 2047 ? 2047 : grow;
    const GAS bf16* apn = proj + (size_t)gld * 16 * PLD + (kv ? C_VC : C_KC) + 8 * q;
    const GAS bf16* bpn = wcT + ((size_t)kv * 256 + wave * 16 + r) * 1024 + 8 * q;
    f32x4 acc = {0.f, 0.f, 0.f, 0.f};
#pragma unroll 8
    for (int s = 0; s < 32; ++s) {
        const bf16x8 av = *(const GAS bf16x8*)(apn + (size_t)(s >> 1) * PLD + 32 * (s & 1));
        const bf16x8 bv = *(const GAS bf16x8*)(bpn + 32 * s);
        acc = __builtin_amdgcn_mfma_f32_16x16x32_bf16(bv, av, acc, 0, 0, 0);
    }
    if (st_ok) *(GAS f32x4*)((GAS float*)ab + ((size_t)kv * 2048 + grow) * 128 + wave * 16 + 4 * q) = acc;
    VM_WAIT(); __syncthreads();
#pragma unroll 1
    for (int i = 0; i < 2; ++i) { const int g = g0 + 2 * wave + i, c = g & 511, b = g >> 9;
        if (c < NCMP) cmp_finish(a, l, ab, kcb, kv * (BATCH * NCMP) + b * NCMP + c, lane); }
}

DI void st_load(const GAS unsigned char* kb, const GAS unsigned char* vb, unsigned off, u32x4& kr, u32x4& vr) { kr = *(const GAS u32x4*)(kb + off); vr = *(const GAS u32x4*)(vb + off); }
DI void st_write(LAS unsigned char* buf, int skey, int sch, const u32x4& kr, const u32x4& vr) { *(LAS u32x4*)(buf + skey * DK_STR + sch * 16) = kr; *(LAS u32x4*)(buf + 64 * DK_STR + skey * DV_STR + sch * 16) = vr; }
DI void qk64(const LAS unsigned char* cur, int kboff, const bf16x8 (&qf)[4], const f32x16& cinit, f32x16 (&S)[2]) {
#pragma unroll
    for (int t = 0; t < 2; ++t) { S[t] = cinit;
#pragma unroll
        for (int s = 0; s < 4; ++s) { const bf16x8 kf = *(const LAS bf16x8*)(cur + kboff + t * 32 * DK_STR + s * 32); S[t] = MFMA32(kf, qf[s], S[t]); } }
}
DI void qk32z(const LAS unsigned char* kt32, const bf16x8 (&qf)[4], f32x16& S) {
#pragma unroll
    for (int s = 0; s < 4; ++s) { const bf16x8 kf = *(const LAS bf16x8*)(kt32 + s * 32);
        if (s == 0) { f32x16 z;
#pragma unroll
            for (int i = 0; i < 16; ++i) z[i] = 0.f;
            S = MFMA32(kf, qf[s], z); } else S = MFMA32(kf, qf[s], S); }
}
DI void pv32(const LAS unsigned char* vt32, const bf16x8 (&pk)[2], f32x16 (&O)[2]) {
#pragma unroll
    for (int s2 = 0; s2 < 2; ++s2)
#pragma unroll
        for (int db = 0; db < 2; ++db) {
            const s16x4 lo = vtr(vt32 + (16 * s2) * DV_STR + db * 64), hi = vtr(vt32 + (16 * s2 + 8) * DV_STR + db * 64);
            const bf16x8 vf = __builtin_shufflevector(lo, hi, 0, 1, 2, 3, 4, 5, 6, 7);
            O[db] = MFMA32(vf, pk[s2], O[db]); }
}
DI void mask_bias_cmp32(f32x16& S, int tcol_in, int cbase, int hh, const LAS float* b2h, float msub) {
    int tcol = tcol_in; asm volatile("" : "+v"(tcol));
#pragma unroll
    for (int g = 0; g < 2; ++g) {
        float bv[8];
#pragma unroll
        for (int j = 0; j < 8; ++j) { const int i = 8 * g + j; const int c = cbase + crow(i, hh); const int dist = tcol - 31 - 16 * c; const int di = dist < 0 ? 0 : (dist < 128 ? dist : 128); bv[j] = b2h[di * 12]; }
#pragma unroll
        for (int j = 0; j < 8; ++j) { const int i = 8 * g + j; const int c = cbase + crow(i, hh); const int dist = tcol - 31 - 16 * c; const bool ok = dist >= 0 && c < NCMP;
            const float sb = S[i] + (bv[j] - msub); S[i] = ok ? sb : -1e30f; }
        __builtin_amdgcn_sched_barrier(0); }
}
DI void pv64(const LAS unsigned char* cur, int vboff, const bf16x8 (&pk)[2][2], f32x16 (&O)[2]) {
#pragma unroll
    for (int t = 0; t < 2; ++t)
#pragma unroll
        for (int s2 = 0; s2 < 2; ++s2)
#pragma unroll
            for (int db = 0; db < 2; ++db) {
                const s16x4 lo = vtr(cur + vboff + (32 * t + 16 * s2) * DV_STR + db * 64), hi = vtr(cur + vboff + (32 * t + 16 * s2 + 8) * DV_STR + db * 64);
                const bf16x8 vf = __builtin_shufflevector(lo, hi, 0, 1, 2, 3, 4, 5, 6, 7);
                O[db] = MFMA32(vf, pk[t][s2], O[db]); }
}
DI void softmax_step(f32x16 (&S)[2], f32x16 (&O)[2], f32x16& negm, float& lsum, bf16x8 (&pk)[2][2]) {
    float tm = fmaxf(max16(S[0]), max16(S[1]));
    if (__builtin_amdgcn_ballot_w64(tm > 8.f) != 0ull) {
        tm = fmaxf(tm, xshfl<32>(tm)); const float sh = fmaxf(tm, 0.f); const float al = __builtin_amdgcn_exp2f(-sh);
        lsum *= al;
#pragma unroll
        for (int i = 0; i < 16; ++i) { O[0][i] *= al; O[1][i] *= al; negm[i] -= sh; S[0][i] -= sh; S[1][i] -= sh; } }
#pragma unroll
    for (int t = 0; t < 2; ++t) {
#pragma unroll
        for (int i = 0; i < 16; ++i) { const float p = __builtin_amdgcn_exp2f(S[t][i]); S[t][i] = p; lsum += p; }
        pk[t][0] = pack_half(S[t], 0); pk[t][1] = pack_half(S[t], 1); }
}
DI void mask_bias(f32x16 (&S)[2], int tcol_in, int kbase, int hh, int W, bool colsel, const LAS float* b2h) {
    int tcol = tcol_in; asm volatile("" : "+v"(tcol));
#pragma unroll
    for (int t = 0; t < 2; ++t)
#pragma unroll
        for (int g = 0; g < 2; ++g) {
            float bv[8];
#pragma unroll
            for (int j = 0; j < 8; ++j) { const int i = 8 * g + j; const int dist = tcol - (kbase + 32 * t + crow(i, hh)); const int di = dist < 0 ? 0 : (dist < 128 ? dist : 128); bv[j] = b2h[di * 12]; }
#pragma unroll
            for (int j = 0; j < 8; ++j) { const int i = 8 * g + j; const int dist = tcol - (kbase + 32 * t + crow(i, hh)); const bool ok = colsel && dist >= 0 && dist < W;
                const float sb = S[t][i] + bv[j]; S[t][i] = ok ? sb : -1e30f; }
            __builtin_amdgcn_sched_barrier(0); }
}
DI void nsa_unit(const GAS bf16* proj, GAS bf16* ys, const GAS bf16* kcb, LAS unsigned char* lds, const LAS float* bias2, int b, int u, int tid_in, int lane_in, int wave_in) {
    (void)tid_in; (void)lane_in; int wave = wave_in; asm volatile("" : "+s"(wave)); const int lane = my_lane(); const int tid = wave * 64 + lane;
    const int t0 = u * 64; const int col = lane & 31, hh = lane >> 5, tl = col >> 2, head = col & 3;
    const int t = t0 + wave * 8 + tl; const int tw0 = t0 + wave * 8;
    const size_t rowb = (size_t)b * SEQ;
    const LAS float* b2h = bias2 + 8 + head;
    bf16x8 qf[4];
    { const float SC = 0.125f * 1.4426950408889634f; const GAS bf16* qp = proj + (rowb + t) * PLD + C_DQ + head * 64 + hh * 8;
#pragma unroll
      for (int s = 0; s < 4; ++s) { const u32x4 w = *(const GAS u32x4*)(qp + s * 16); u32x4 o;
          o.x = cvtpk(lo_bf(w.x) * SC, hi_bf(w.x) * SC); o.y = cvtpk(lo_bf(w.y) * SC, hi_bf(w.y) * SC); o.z = cvtpk(lo_bf(w.z) * SC, hi_bf(w.z) * SC); o.w = cvtpk(lo_bf(w.w) * SC, hi_bf(w.w) * SC);
          qf[s] = __builtin_bit_cast(bf16x8, o); } }
    const int skey = tid >> 3, sch = tid & 7;
    const int i16 = lane & 15, blk = (lane >> 4) & 1;
    const int kboff = col * DK_STR + hh * 16;
    const int vboff = 64 * DK_STR + (4 * hh + (i16 >> 2)) * DV_STR + (16 * blk + 4 * (i16 & 3)) * 2;
    u32x4 kr, vr;
    const int ncvm = (4 * u + 3) < NCMP ? (4 * u + 3) : NCMP;
    const int nsc = (ncvm + 63) >> 6;
    const GAS unsigned char* kcp = (const GAS unsigned char*)(kcb + (size_t)(0 * BATCH + b) * 512 * 64);
    const GAS unsigned char* vcp = (const GAS unsigned char*)(kcb + (size_t)(1 * BATCH + b) * 512 * 64);
    const unsigned soffc = (unsigned)(skey * 64 + sch * 8) * 2u;
    float m1 = -120.f, l1 = 0.f;
    st_load(kcp, vcp, soffc, kr, vr); st_write(lds, skey, sch, kr, vr); __syncthreads();
#pragma unroll 1
    for (int kt = 0; kt < nsc; ++kt) {
        const LAS unsigned char* cur = lds + (kt & 1) * DBUF_BYTES; LAS unsigned char* nxt = lds + ((kt + 1) & 1) * DBUF_BYTES;
        if (kt + 1 < nsc) st_load(kcp, vcp, soffc + (unsigned)(kt + 1) * 8192u, kr, vr);
#pragma unroll
        for (int tt = 0; tt < 2; ++tt) { f32x16 S; qk32z(cur + kboff + tt * 32 * DK_STR, qf, S); mask_bias_cmp32(S, t, kt * 64 + tt * 32, hh, b2h, 0.f);
          const float tm = max16(S); const float mn = fmaxf(m1, tm); float acc = 0.f;
#pragma unroll
          for (int i = 0; i < 16; ++i) acc += __builtin_amdgcn_exp2f(S[i] - mn);
          l1 = l1 * __builtin_amdgcn_exp2f(m1 - mn) + acc; m1 = mn; }
        if (kt + 1 < nsc) st_write(nxt, skey, sch, kr, vr);
        __syncthreads();
    }
    float mf, inv;
    { const float mo = xshfl<32>(m1), lo = xshfl<32>(l1); mf = fmaxf(m1, mo); const float lf = l1 * __builtin_amdgcn_exp2f(m1 - mf) + lo * __builtin_amdgcn_exp2f(mo - mf); inv = lf > 0.f ? 1.f / lf : 0.f; }
    f32x16 Oc[2], imp[4];
#pragma unroll
    for (int i = 0; i < 16; ++i) { Oc[0][i] = 0.f; Oc[1][i] = 0.f; imp[0][i] = 0.f; imp[1][i] = 0.f; imp[2][i] = 0.f; imp[3][i] = 0.f; }
    {   st_load(kcp, vcp, soffc, kr, vr); st_write(lds, skey, sch, kr, vr); __syncthreads();
#pragma unroll 1
        for (int kt = 0; kt < nsc; ++kt) {
            const LAS unsigned char* cur = lds + (kt & 1) * DBUF_BYTES; LAS unsigned char* nxt = lds + ((kt + 1) & 1) * DBUF_BYTES;
            if (kt + 1 < nsc) st_load(kcp, vcp, soffc + (unsigned)(kt + 1) * 8192u, kr, vr);
#pragma unroll
            for (int tt = 0; tt < 2; ++tt) {
                f32x16 S; qk32z(cur + kboff + tt * 32 * DK_STR, qf, S); mask_bias_cmp32(S, t, kt * 64 + tt * 32, hh, b2h, mf);
#pragma unroll
                for (int i = 0; i < 16; ++i) S[i] = __builtin_amdgcn_exp2f(S[i]) * inv;
                bf16x8 pk[2]; pk[0] = pack_half(S, 0); pk[1] = pack_half(S, 1);
                pv32(cur + vboff + tt * 32 * DV_STR, pk, Oc);
                const int Tq = (2 * kt + tt) & 3, MB = (2 * kt + tt) >> 2;
#pragma unroll
                for (int s2 = 0; s2 < 2; ++s2) { u32x4 aw; unsigned e[8];
#pragma unroll
                    for (int jj = 0; jj < 8; ++jj) { const int kk = 16 * s2 + 8 * (jj >> 2) + 4 * hh + (jj & 3); const int delta = 32 * Tq + kk - 4 * col;
                        e[jj] = (delta == -1 || delta == 3) ? 0x3F80u : ((unsigned)delta <= 2u ? 0x4000u : 0u); }
                    aw.x = e[0] | (e[1] << 16); aw.y = e[2] | (e[3] << 16); aw.z = e[4] | (e[5] << 16); aw.w = e[6] | (e[7] << 16);
                    const bf16x8 af = __builtin_bit_cast(bf16x8, aw);
                    if (MB == 0) imp[0] = MFMA32(af, pk[s2], imp[0]); else if (MB == 1) imp[1] = MFMA32(af, pk[s2], imp[1]); else if (MB == 2) imp[2] = MFMA32(af, pk[s2], imp[2]); else imp[3] = MFMA32(af, pk[s2], imp[3]); }
                if (Tq == 3 && MB < 3) { u32x4 aw; aw.x = 0u; aw.y = 0u; aw.z = 0u; aw.w = (lane == 32) ? 0x3F800000u : 0u;
                    const bf16x8 af = __builtin_bit_cast(bf16x8, aw);
                    if (MB == 0) imp[1] = MFMA32(af, pk[1], imp[1]); else if (MB == 1) imp[2] = MFMA32(af, pk[1], imp[2]); else imp[3] = MFMA32(af, pk[1], imp[3]); }
            }
            if (kt + 1 < nsc) st_write(nxt, skey, sch, kr, vr);
            __syncthreads();
        }
    }
    unsigned ocp[2][8];
#pragma unroll
    for (int db = 0; db < 2; ++db)
#pragma unroll
        for (int i = 0; i < 8; ++i) ocp[db][i] = cvtpk(Oc[db][2 * i], Oc[db][2 * i + 1]);
    unsigned sm0 = 0u, sm1 = 0u, sm2 = 0u, sm3 = 0u;
    {   const int cur_t = t >> 6; unsigned key[16];
#pragma unroll
        for (int i = 0; i < 16; ++i) {
            float v0 = imp[0][i], v1 = imp[1][i], v2 = imp[2][i], v3 = imp[3][i];
            v0 += xshfl<1>(v0); v0 += xshfl<2>(v0); v1 += xshfl<1>(v1); v1 += xshfl<2>(v1); v2 += xshfl<1>(v2); v2 += xshfl<2>(v2); v3 += xshfl<1>(v3); v3 += xshfl<2>(v3);
            const float val = head == 0 ? v0 : (head == 1 ? v1 : (head == 2 ? v2 : v3));
            const int j = 32 * head + crow(i, hh);
            const bool forced = (j == 0) || (j == cur_t) || (j == cur_t - 1);
            unsigned fx = (unsigned)(fminf(fmaxf(val, 0.f), 31.f) * 1048576.f) + 1u;
            fx = forced ? 0x1FFFFFFu : (j <= cur_t ? fx : 0u);
            key[i] = (fx << 7) | (unsigned)(127 - j); }
#pragma unroll 1
        for (int r = 0; r < 16; ++r) {
            unsigned w = key[0];
#pragma unroll
            for (int i = 1; i < 16; ++i) w = w > key[i] ? w : key[i];
            { unsigned o = (unsigned)xshfl_i<1>((int)w); w = w > o ? w : o; o = (unsigned)xshfl_i<2>((int)w); w = w > o ? w : o; o = (unsigned)xshfl_i<32>((int)w); w = w > o ? w : o; }
            if ((w >> 7) != 0u) { const int j = 127 - (int)(w & 127u); const unsigned bit = 1u << (j & 31); const int jb = j >> 5;
                sm0 |= (jb == 0) ? bit : 0u; sm1 |= (jb == 1) ? bit : 0u; sm2 |= (jb == 2) ? bit : 0u; sm3 |= (jb == 3) ? bit : 0u; }
#pragma unroll
            for (int i = 0; i < 16; ++i) key[i] = (key[i] == w) ? 0u : key[i];
        }
    }
    f32x16 Ow[2]; float lw = 0.f;
#pragma unroll
    for (int i = 0; i < 16; ++i) { Ow[0][i] = 0.f; Ow[1][i] = 0.f; }
    {   f32x16 negm;
#pragma unroll
        for (int i = 0; i < 16; ++i) negm[i] = 120.f;
        const GAS unsigned char* kwp = (const GAS unsigned char*)(proj + rowb * PLD + C_KW); const GAS unsigned char* vwp = (const GAS unsigned char*)(proj + rowb * PLD + C_VW);
        const unsigned soffp = (unsigned)(skey * PLD + sch * 8) * 2u;
        const int s0 = (u < 8) ? 8 - u : 0;
        st_load(kwp, vwp, soffp + (unsigned)(u - 8 + s0) * (64u * PLD * 2u), kr, vr); st_write(lds, skey, sch, kr, vr); __syncthreads();
#pragma unroll 1
        for (int s = s0; s < 9; ++s) {
            const int par = (s - s0) & 1; const LAS unsigned char* cur = lds + par * DBUF_BYTES; LAS unsigned char* nxt = lds + (par ^ 1) * DBUF_BYTES;
            if (s + 1 < 9) st_load(kwp, vwp, soffp + (unsigned)(u - 8 + s + 1) * (64u * PLD * 2u), kr, vr);
            {   f32x16 S[2]; qk64(cur, kboff, qf, negm, S);
                if (s == 0 || s >= 6) mask_bias(S, t, (u - 8 + s) * 64, hh, 512, true, b2h);
                bf16x8 pk[2][2]; softmax_step(S, Ow, negm, lw, pk); pv64(cur, vboff, pk, Ow); }
            if (s + 1 < 9) st_write(nxt, skey, sch, kr, vr);
            __syncthreads();
        }
    }
    unsigned owp[2][8];
#pragma unroll
    for (int db = 0; db < 2; ++db)
#pragma unroll
        for (int i = 0; i < 8; ++i) owp[db][i] = cvtpk(Ow[db][2 * i], Ow[db][2 * i + 1]);
    f32x16 Os[2]; float lsel = 0.f;
#pragma unroll
    for (int i = 0; i < 16; ++i) { Os[0][i] = 0.f; Os[1][i] = 0.f; }
    {   f32x16 negm;
#pragma unroll
        for (int i = 0; i < 16; ++i) negm[i] = 120.f;
        const GAS unsigned char* ksp = (const GAS unsigned char*)(proj + rowb * PLD + C_KS); const GAS unsigned char* vsp = (const GAS unsigned char*)(proj + rowb * PLD + C_VS);
        const unsigned soffp = (unsigned)(skey * PLD + sch * 8) * 2u;
        u32x4 kA, vA, kB, vB;
        st_load(ksp, vsp, soffp, kr, vr); st_write(lds, skey, sch, kr, vr);
        if (u >= 1) st_load(ksp, vsp, soffp + 64u * PLD * 2u, kA, vA);
        __syncthreads();
#define SEL_STEP(J, KX, VX, KY, VY) { const int j_ = (J); \
            const LAS unsigned char* cur = lds + (j_ & 1) * DBUF_BYTES; LAS unsigned char* nxt = lds + ((j_ + 1) & 1) * DBUF_BYTES; \
            if (j_ + 2 <= u) st_load(ksp, vsp, soffp + (unsigned)(j_ + 2) * (64u * PLD * 2u), KY, VY); \
            const int jb = j_ >> 5; const unsigned smw = jb == 0 ? sm0 : (jb == 1 ? sm1 : (jb == 2 ? sm2 : sm3)); \
            const bool bit = ((smw >> (j_ & 31)) & 1u) != 0u; \
            if (__builtin_amdgcn_ballot_w64(bit) != 0ull) { \
                f32x16 S[2]; qk64(cur, kboff, qf, negm, S); \
                if (64 * j_ + 63 > tw0 - 113) mask_bias(S, t, 64 * j_, hh, 1 << 30, bit, b2h); \
                else if (!bit) { _Pragma("unroll") for (int i = 0; i < 16; ++i) { S[0][i] = -1e30f; S[1][i] = -1e30f; } } \
                bf16x8 pk[2][2]; softmax_step(S, Os, negm, lsel, pk); pv64(cur, vboff, pk, Os); } \
            if (j_ + 1 <= u) st_write(nxt, skey, sch, KX, VX); \
            __syncthreads(); }
#pragma unroll 1
        for (int j = 0; j <= u; j += 2) {
            SEL_STEP(j, kA, vA, kB, vB)
            if (j + 1 <= u) SEL_STEP(j + 1, kB, vB, kA, vA)
        }
#undef SEL_STEP
    }
    {   const float lwt = lw + xshfl<32>(lw), lst = lsel + xshfl<32>(lsel);
        const GAS bf16* gp = proj + (rowb + t) * PLD + C_DG + head * 3;
        const float g0 = sigmoidf_(bf2f(gp[0])), g1 = sigmoidf_(bf2f(gp[1])) / fmaxf(lst, 1e-30f), g2 = sigmoidf_(bf2f(gp[2])) / fmaxf(lwt, 1e-30f);
        GAS bf16* op = ys + (rowb + t) * 1024 + 768 + head * 64;
#pragma unroll
        for (int db = 0; db < 2; ++db)
#pragma unroll
            for (int gq = 0; gq < 4; ++gq) { const int d0 = 32 * db + 8 * gq + 4 * hh; float y[4];
#pragma unroll
                for (int e = 0; e < 4; ++e) { const unsigned cw = ocp[db][2 * gq + (e >> 1)], ww = owp[db][2 * gq + (e >> 1)];
                    y[e] = g0 * ((e & 1) ? hi_bf(cw) : lo_bf(cw)) + g1 * Os[db][4 * gq + e] + g2 * ((e & 1) ? hi_bf(ww) : lo_bf(ww)); }
                u32x2 w; w.x = cvtpk(y[0], y[1]); w.y = cvtpk(y[2], y[3]); *(GAS u32x2*)(op + d0) = w; }
    }
}


DI void swa_unit(const GAS bf16* proj, GAS bf16* ys, LAS unsigned char* lds, const LAS float* bias2, const LAS float* biasd, const GAS float* sinks, int b, int u, int tid_in, int lane_in, int wave_in) {
    int tid = tid_in, lane = lane_in, wave = wave_in; asm volatile("" : "+v"(tid), "+v"(lane), "+s"(wave));
    const int t0 = u * 64; const int col = lane & 31, hh = lane >> 5, tl = col >> 1, kv = wave & 1, head = 2 * kv + (col & 1);
    const int t = t0 + (wave >> 1) * 16 + tl;
    const size_t rowb = (size_t)b * SEQ;
    const LAS float* b2h = bias2 + head;
    bf16x8 qf[4];
    { const float SC = 0.125f * 1.4426950408889634f; const GAS bf16* qp = proj + (rowb + t) * PLD + C_BQ + head * 64 + hh * 8;
#pragma unroll
      for (int s = 0; s < 4; ++s) { const u32x4 w = *(const GAS u32x4*)(qp + s * 16); u32x4 o;
          o.x = cvtpk(lo_bf(w.x) * SC, hi_bf(w.x) * SC); o.y = cvtpk(lo_bf(w.y) * SC, hi_bf(w.y) * SC); o.z = cvtpk(lo_bf(w.z) * SC, hi_bf(w.z) * SC); o.w = cvtpk(lo_bf(w.w) * SC, hi_bf(w.w) * SC);
          qf[s] = __builtin_bit_cast(bf16x8, o); } }
    const int skey = tid >> 3, sch = tid & 7;
    const int i16 = lane & 15, blk = (lane >> 4) & 1;
    const int kboff = kv * DBUF_BYTES + col * DK_STR + hh * 16;
    const int vboff = kv * DBUF_BYTES + 64 * DK_STR + (4 * hh + (i16 >> 2)) * DV_STR + (16 * blk + 4 * (i16 & 3)) * 2;
    const GAS unsigned char* kp = (const GAS unsigned char*)(proj + rowb * PLD + C_BK); const GAS unsigned char* vp = (const GAS unsigned char*)(proj + rowb * PLD + C_BV);
    const unsigned soffp = (unsigned)(skey * PLD + sch * 8) * 2u;
    u32x4 k0, v0, k1, v1;
    f32x16 O[2], negm; float lsum = 0.f;
#pragma unroll
    for (int i = 0; i < 16; ++i) { O[0][i] = 0.f; O[1][i] = 0.f; negm[i] = 120.f; }
    const int s0 = (u < 2) ? 2 - u : 0;
    { const unsigned so = soffp + (unsigned)(u - 2 + s0) * (64u * PLD * 2u); st_load(kp, vp, so, k0, v0); st_load(kp + 128, vp + 128, so, k1, v1);
      st_write(lds, skey, sch, k0, v0); st_write(lds + DBUF_BYTES, skey, sch, k1, v1); }
    __syncthreads();
#pragma unroll 1
    for (int s = s0; s < 3; ++s) {
        const int par = (s - s0) & 1; const LAS unsigned char* cur = lds + par * 2 * DBUF_BYTES; LAS unsigned char* nxt = lds + (par ^ 1) * 2 * DBUF_BYTES;
        if (s + 1 < 3) { const unsigned so = soffp + (unsigned)(u - 2 + s + 1) * (64u * PLD * 2u); st_load(kp, vp, so, k0, v0); st_load(kp + 128, vp + 128, so, k1, v1); }
        {   f32x16 S[2]; qk64(cur, kboff, qf, negm, S);
            mask_bias(S, t, (u - 2 + s) * 64, hh, 128, true, b2h);
            bf16x8 pk[2][2]; softmax_step(S, O, negm, lsum, pk); pv64(cur, vboff, pk, O); }
        if (s + 1 < 3) { st_write(nxt, skey, sch, k0, v0); st_write(nxt + DBUF_BYTES, skey, sch, k1, v1); }
        __syncthreads();
    }
    {   const float sinkp = (sinks[head] - biasd[128 * 12 + head]) * 1.4426950408889634f;
        const float lt = lsum + xshfl<32>(lsum) + __builtin_amdgcn_exp2f(sinkp + negm[0]);
        const float inv = 1.f / fmaxf(lt, 1e-30f);
        GAS bf16* op = ys + (rowb + t) * 1024 + 256 + head * 64;
#pragma unroll
        for (int db = 0; db < 2; ++db)
#pragma unroll
            for (int gq = 0; gq < 4; ++gq) { const int d0 = 32 * db + 8 * gq + 4 * hh;
                u32x2 w; w.x = cvtpk(O[db][4 * gq + 0] * inv, O[db][4 * gq + 1] * inv); w.y = cvtpk(O[db][4 * gq + 2] * inv, O[db][4 * gq + 3] * inv); *(GAS u32x2*)(op + d0) = w; }
    }
}

DI void route_rows4(const KA& a, int l, bf16* xr_, int tok0, int lane_) {
    int lane = lane_; asm volatile("" : "+v"(lane));
    const GAS bf16* xrow = (const GAS bf16*)(a.ws + WS_XB) + (size_t)tok0 * 1024; const GAS float* g = (const GAS float*)(a.in[28] + (size_t)l * 1024); GAS bf16* xr = (GAS bf16*)xr_;
    f32x4 v[4][4]; float ss[4]; u32x2 raw[4][4];
#pragma unroll
    for (int rr = 0; rr < 4; ++rr)
#pragma unroll
        for (int j = 0; j < 4; ++j) raw[rr][j] = *(const GAS u32x2*)(xrow + (size_t)rr * 1024 + 4 * (lane + 64 * j));
#pragma unroll
    for (int rr = 0; rr < 4; ++rr)
#pragma unroll
        for (int j = 0; j < 4; ++j) { v[rr][j][0] = lo_bf(raw[rr][j].x); v[rr][j][1] = hi_bf(raw[rr][j].x); v[rr][j][2] = lo_bf(raw[rr][j].y); v[rr][j][3] = hi_bf(raw[rr][j].y); }
#pragma unroll
    for (int rr = 0; rr < 4; ++rr) { float t = 0.f;
#pragma unroll
        for (int j = 0; j < 4; ++j) t += (v[rr][j][0] * v[rr][j][0] + v[rr][j][1] * v[rr][j][1]) + (v[rr][j][2] * v[rr][j][2] + v[rr][j][3] * v[rr][j][3]);
        ss[rr] = t; }
#pragma unroll
    for (int rr = 0; rr < 4; ++rr) ss[rr] = wave_sum(ss[rr]);
#pragma unroll
    for (int j = 0; j < 4; ++j) { const int k0 = 4 * (lane + 64 * j); const f32x4 gv = *(const GAS f32x4*)(g + k0);
#pragma unroll
        for (int rr = 0; rr < 4; ++rr) { const float r = 1.f / sqrtf(ss[rr] * (1.f / 1024.f) + 1e-6f); const f32x4 xn = v[rr][j] * r * gv;
            unsigned hi[4]; float lo[4];
#pragma unroll
            for (int e = 0; e < 4; ++e) { hi[e] = f2bf(xn[e]); lo[e] = xn[e] - __builtin_bit_cast(float, hi[e] << 16); }
            u32x2 wh, wl; wh.x = hi[0] | (hi[1] << 16); wh.y = hi[2] | (hi[3] << 16); wl.x = pk2(lo[0], lo[1]); wl.y = pk2(lo[2], lo[3]);
            *(GAS u32x2*)(xr + (size_t)(tok0 + rr) * 2048 + k0) = wh; *(GAS u32x2*)(xr + (size_t)(tok0 + rr) * 2048 + 1024 + k0) = wl; } }
}
struct SchedRoute { const char* A; const char* B; int pm;
    DI bool next(int i, Unit& u) const { if (i > 0) return false; u.pm = pm; u.pn = 0; u.aux = 0; u.pad = 0; u.a = A + (size_t)pm * 128 * 2048 * 2; u.b = B; return true; } };
struct EpiRoute { static constexpr bool CARRY = false; float* rlog;
    DI void operator()(const f32x4 (&acc)[2][2][4][2], const Unit& u, int wr, int wc, int fr, int fq) const {
        const int row0 = u.pm * 128 + wr * 64 + fr; const int col = wc * 32 + 8 * fq;
#pragma unroll
        for (int m = 0; m < 4; ++m) { float* rp = rlog + (size_t)(row0 + m * 16) * 128 + col; *(f32x4*)rp = acc[0][0][m][0]; *(f32x4*)(rp + 4) = acc[0][0][m][1]; }
    }
};
DI void route_decide(const KA& a, int l, const float* rl_row, int* rec_e, int* rec_slot, float* rec_w, unsigned* cnt, int tok) {
    float lg[36];
    const float* bg = a.in[30] + l * 4; const float* be = a.in[32] + l * 32;
#pragma unroll
    for (int q = 0; q < 9; ++q) { const f32x4 h = *(const f32x4*)(rl_row + 4 * q), lo = *(const f32x4*)(rl_row + 64 + 4 * q);
        lg[4 * q + 0] = h[0] + lo[0]; lg[4 * q + 1] = h[1] + lo[1]; lg[4 * q + 2] = h[2] + lo[2]; lg[4 * q + 3] = h[3] + lo[3]; }
#pragma unroll
    for (int i = 0; i < 4; ++i) lg[i] += bg[i];
#pragma unroll
    for (int i = 0; i < 32; ++i) lg[4 + i] += be[i];
    int gsel = 0; float gm = lg[0];
#pragma unroll
    for (int i = 1; i < 4; ++i) if (lg[i] > gm) { gm = lg[i]; gsel = i; }
    float gs = 0.f;
#pragma unroll
    for (int i = 0; i < 4; ++i) gs += __expf(lg[i] - gm);
    const float gwt = 1.f / gs;
    float v8[8];
#pragma unroll
    for (int i = 0; i < 8; ++i) { float x = lg[4 + i];
#pragma unroll
        for (int gq = 1; gq < 4; ++gq) x = (gsel == gq) ? lg[4 + gq * 8 + i] : x;
        v8[i] = x; }
    int i0 = 0; float m0 = v8[0];
#pragma unroll
    for (int i = 1; i < 8; ++i) if (v8[i] > m0) { m0 = v8[i]; i0 = i; }
    int i1 = -1; float m1 = -3e38f;
#pragma unroll
    for (int i = 0; i < 8; ++i) if (i != i0 && v8[i] > m1) { m1 = v8[i]; i1 = i; }
    if (i1 < 0) i1 = (i0 == 0) ? 1 : 0;
    const float w0 = 1.f / (1.f + __expf(m1 - m0)); const float w1 = 1.f - w0;
    const int e0 = gsel * 8 + i0, e1 = gsel * 8 + i1;
    const unsigned s0 = __hip_atomic_fetch_add(cnt + e0, 1u, __ATOMIC_RELAXED, __HIP_MEMORY_SCOPE_AGENT);
    const unsigned s1 = __hip_atomic_fetch_add(cnt + e1, 1u, __ATOMIC_RELAXED, __HIP_MEMORY_SCOPE_AGENT);
    (void)rec_e; (void)rec_slot; (void)rec_w;
    int* inv_as = (int*)(a.ws + WS_INVAS); float* inv_w = (float*)(a.ws + WS_INVW);
    inv_as[e0 * 32768 + (int)s0] = tok * 2; inv_w[e0 * 32768 + (int)s0] = w0 * gwt; inv_as[e1 * 32768 + (int)s1] = tok * 2 + 1; inv_w[e1 * 32768 + (int)s1] = w1 * gwt;
}
DI void expert_weights(const KA& a, int l, LAS unsigned char* lds, int it0, int it1, int gw, int NGW, int wave, int lane) {
    LAS float* scr = (LAS float*)(lds + wave * 16384);
    const float* wgt = a.in[33] + (size_t)l * 32 * 1024 * 256; const float* wup = a.in[34] + (size_t)l * 32 * 1024 * 256; const float* wdn = a.in[35] + (size_t)l * 32 * 256 * 1024;
    bf16* Wgu = (bf16*)(a.ws + WS_WGU); bf16* Wd = (bf16*)(a.ws + WS_WD);
    constexpr int I_E = 16 * 8, I_D = 4 * 32;
    constexpr int NIT = 32 * (2 * I_E + I_D);
    (void)NIT;
    for (int it = it0 + gw; it < it1; it += NGW) {
        const int e = it / (2 * I_E + I_D); int r = it % (2 * I_E + I_D);
        if (r < 2 * I_E) { const int up = r / I_E, q = r % I_E, kb = q / 8, nb = q % 8; const int n0 = nb * 32;
            const int drow = (n0 >> 7) * 256 + up * 128 + (n0 & 127);
            transpose_item((up ? wup : wgt) + (size_t)e * 1024 * 256, 256, 256, Wgu + (size_t)e * 512 * 1024, 1024, kb * 64, n0, drow, scr, lane);
        } else { r -= 2 * I_E; const int kb = r / 32, nb = r % 32;
            transpose_item(wdn + (size_t)e * 256 * 1024, 1024, 1024, Wd + (size_t)e * 1024 * 256, 256, kb * 64, nb * 32, nb * 32, scr, lane); }
    }
}
DI void build_offsets(const unsigned* cnt, LAS int* offt, int tid) {
    int c = 0;
    if (tid < 32) { c = (int)__hip_atomic_load(cnt + tid, __ATOMIC_RELAXED, __HIP_MEMORY_SCOPE_AGENT); offt[330 + tid] = (c + 255) & ~255; }
    __syncthreads();
    if (tid == 0) { int o = 0;
#pragma unroll
        for (int e = 0; e < 32; ++e) { offt[e] = o; o += offt[330 + e]; } offt[32] = o; }
    __syncthreads();
    if (tid < 32) offt[330 + tid] = c;
    for (int rt = tid; rt < (MOE_ROWS >> 8); rt += 512) { int e = 0; for (int j = 1; j < 32; ++j) e += (offt[j] <= rt * 256) ? 1 : 0; offt[40 + rt] = e; }
    __syncthreads();
}

template <unsigned PM>
__global__ void __launch_bounds__(512, 2) mk_fwd(Args a_) {
    extern __shared__ __attribute__((aligned(16))) unsigned char lds_raw[];
    LAS unsigned char* lds = (LAS unsigned char*)lds_raw;
    const int wave0 = __builtin_amdgcn_readfirstlane((int)threadIdx.x >> 6);
    if (threadIdx.x < 36) ((LAS unsigned long long*)(lds + PTAB_OFF))[threadIdx.x] = (unsigned long long)a_.in[threadIdx.x];
    __syncthreads();
    KA a; a.in.base = (unsigned)(size_t)(lds + PTAB_OFF); a.out = a_.out; a.ws = a_.ws;
    const int G = gridDim.x, bid = blockIdx.x, NGW = G * 8;
#define PHASE_IDS() int wave = wave0; asm volatile("" : "+s"(wave)); const int lane = my_lane(); const int tid_ = wave * 64 + lane, gw = bid * 8 + wave; (void)tid_; (void)gw; \
    const int xb = ((bid & 7) << 5) | (bid >> 3); (void)xb;        \
    KA ap = a; asm volatile("" : "+s"(ap.ws), "+s"(ap.out), "+s"(ap.in.base)); \
    bf16* hb = (bf16*)(ap.ws + WS_HB); bf16* proj = (bf16*)(ap.ws + WS_PROJ); bf16* gates = (bf16*)(ap.ws + WS_GATES); \
    bf16* ys = hb; bf16* x2b = hb; bf16* merged = proj; bf16* eo = proj; \
    bf16* kcb = (bf16*)(ap.ws + WS_KCVC); float* lrusum = (float*)(ap.ws + WS_LRUSUM); \
    int* rec_e = (int*)(ap.ws + WS_REC); int* rec_slot = rec_e + T * 2; float* rec_w = (float*)(rec_slot + T * 2); \
    int* rowtok = (int*)(ap.ws + WS_ROWTOK); float* roww = (float*)(ap.ws + WS_ROWW); \
    bf16* xs = (bf16*)(ap.ws + WS_XS); bf16* hmid = (bf16*)(ap.ws + WS_HMID); unsigned* ctl = (unsigned*)(ap.ws + WS_CTL); \
    (void)hb; (void)proj; (void)gates; (void)ys; (void)x2b; (void)merged; (void)eo; (void)kcb; (void)lrusum; (void)rec_e; (void)rec_slot; (void)rec_w; (void)rowtok; (void)roww; (void)xs; (void)hmid; (void)ctl
    volatile LAS unsigned* MISC = (volatile LAS unsigned*)(lds + MISC_OFF);
    LAS float* biasd = (LAS float*)(lds + BIAS_OFF);
    LAS int* offt = (LAS int*)(lds + OFFT_OFF);
    { PHASE_IDS();
    if (tid_ < 64) MISC[tid_] = 0u;
    for (int i = tid_; i < 129 * 12; i += 512) { const int d = i / 12, hd = i % 12; const int bk = d < 128 ? T5_BUCKET[d] : 31; const float* rb = a.in[1]; biasd[i] = rb[bk * 12 + hd]; ((LAS float*)(lds + BIAS2_OFF))[i] = (rb[bk * 12 + hd] - rb[31 * 12 + hd]) * 1.4426950408889634f; } }
    __syncthreads();
    const int lo = a_.ph_lo, hi = a_.ph_hi;
    XcdBarrier bar; bar.bar = (unsigned*)(a.ws + WS_CTL) + CW_BAR; bar.x = 0; bar.st = nullptr;
    if (hi - lo > 1) { PHASE_IDS(); bar = xcd_barrier_post(ctl + CW_BAR, MISC + 8, tid_ == 0); }
#ifndef SUB_MASK
#define SUB_MASK 0xFFu
#endif
#define SUB(k) ((SUB_MASK >> (k)) & 1u)
#define HASP(k) ((PM >> ((k) % PPL + ((k) >= 2 * PPL ? PPL : 0))) & 1u)
#define IN(k) (HASP(k) && lo <= (k) && (k) < hi)
#define SEAM(k) do { if ((k) + 1 < hi) { const int sl_ = my_lane(); int sw_ = wave0; asm volatile("" : "+s"(sw_)); xcd_barrier(bar, sw_ == 0 && sl_ == 0); } } while (0)
    for (int l = 0; l < DEPTH; ++l) {
        const int pb = l * PPL;
        if (IN(pb + 0)) { PHASE_IDS(); p1_weights_i8(ap, l, lds, gw, NGW, wave, lane); router_weights(ap, l, gw, NGW, lane); lru_weights(ap, l, gw, NGW, lane); cmp_weights(ap, l, lds, gw, NGW, wave, lane); phase0_weights(ap, l, lds, gw, NGW, wave, lane); phase0_rows(ap, l, 0, gw, NGW, lane); SEAM(pb + 0); }
        if (IN(pb + 1)) {
            PHASE_IDS();
            {   int K1q = 512; asm volatile("" : "+s"(K1q));
                pg8::Gemm g{K1q, 512, 512, 128, -1}; SchedP1 S{(const char*)(ap.ws + WS_HQ), (const char*)(ap.ws + WS_WQ), 128, 26, 1024, 1024, G, bid};
                EpiP1I8 E{proj, (unsigned char*)gates, ap.in[25] + (size_t)l * 4096, (const float*)(ap.ws + WS_HSC), (const float*)(ap.ws + WS_WSC)};
                pg8::gemm_phase<EpiP1I8, SchedP1, false, true>(lds, g, S, E, tid_); }
            SEAM(pb + 1);
        }
        if (IN(pb + 2)) {
            PHASE_IDS();
            LAS float* lamp = (LAS float*)(lds + MISC_OFF + 64);
            if (tid_ < 64) { const float* q1 = ap.in[13] + l * 32; const float* k1 = ap.in[14] + l * 32; const float* q2 = ap.in[15] + l * 32; const float* k2 = ap.in[16] + l * 32;
                float s1 = (lane < 32) ? q1[lane] * k1[lane] : 0.f, s2 = (lane < 32) ? q2[lane] * k2[lane] : 0.f; s1 = wave_sum(s1); s2 = wave_sum(s2);
                const float lam_init = 0.8f - 0.6f * __expf(-0.3f * (float)l); if (lane == 0) { lamp[0] = __expf(s1) - __expf(s2) + lam_init; lamp[1] = lam_init; } }
            __syncthreads();
            if (SUB(0)) { const LAS float* bias2 = (const LAS float*)(lds + BIAS2_OFF); const GAS float* subg = (const GAS float*)(ap.in[17] + l * 64);
                for (int pi = xb; pi < 256; pi += G) { const int bh = pi >> 4, qlo = pi & 15;
                    diff_unit((const GAS bf16*)proj, (GAS bf16*)ys, lds, bias2, subg, lamp, bh >> 2, bh & 3, 31 - qlo, wave);
                    diff_unit((const GAS bf16*)proj, (GAS bf16*)ys, lds, bias2, subg, lamp, bh >> 2, bh & 3, qlo, wave); } }
            { PHASE_IDS();
            if (SUB(3)) { __syncthreads(); const LAS float* bias2 = (const LAS float*)(lds + BIAS2_OFF); const GAS float* sinks = (const GAS float*)(ap.in[12] + l * 4);
                for (int pi = xb; pi < 512; pi += G) swa_unit((const GAS bf16*)proj, (GAS bf16*)ys, lds, bias2, biasd, sinks, pi >> 7, pi & 127, tid_, lane, wave); }
            if (SUB(2)) cmp_block(ap, l, (const GAS bf16*)proj, (const GAS bf16*)(ap.ws + WS_WCMP), (float*)(ap.ws + WS_CMPAB), kcb, bid, wave, lane);
            if (SUB(1)) { __syncthreads(); for (int task = xb; task < 512; task += G) lru_unit(ap, l, (const GAS bf16*)proj, (GAS bf16*)ys, (GAS float*)lrusum, lds, task, lane, wave, false); }
            }
            SEAM(pb + 2);
        }
        if (IN(pb + 4)) {
            PHASE_IDS();
            for (int task = xb; task < 512; task += G) lru_unit(ap, l, (const GAS bf16*)proj, (GAS bf16*)ys, (GAS float*)lrusum, lds, task, lane, wave, true);
            __syncthreads();
            if (SUB(4)) { const LAS float* bias2 = (const LAS float*)(lds + BIAS2_OFF);
                for (int pi = xb; pi < 256; pi += G) { const int bb = pi >> 6, ulo = pi & 63;
                    nsa_unit((const GAS bf16*)proj, (GAS bf16*)ys, (const GAS bf16*)kcb, lds, bias2, bb, 127 - ulo, tid_, lane, wave);
                    nsa_unit((const GAS bf16*)proj, (GAS bf16*)ys, (const GAS bf16*)kcb, lds, bias2, bb, ulo, tid_, lane, wave); } }
            SEAM(pb + 4);
        }
        if (IN(pb + 5)) {
            PHASE_IDS();
            int K5 = 256; asm volatile("" : "+s"(K5));
            pg8::Gemm g{K5, 1024, 256, 128, -1}; SchedP3a S{(const char*)ys, (const char*)(ap.ws + WS_WBR), G, xb};
            EpiP3a E{merged, (const unsigned char*)gates};
            pg8::gemm_phase<EpiP3a, SchedP3a>(lds, g, S, E, tid_); SEAM(pb + 5);
        }
        if (IN(pb + 6)) {
            PHASE_IDS();
            int K6 = 1024; asm volatile("" : "+s"(K6));
            pg8::Gemm g{K6, 1024, 1024, 128, -1}; SchedP3b S{(const char*)merged, (const char*)(ap.ws + WS_WOUT), G, xb};
            if (l == 0) { EpiP3b<true> E{ap.in[0], (bf16*)(ap.ws + WS_XB)}; pg8::gemm_phase<EpiP3b<true>, SchedP3b>(lds, g, S, E, tid_); }
            else { EpiP3b<false> E{nullptr, (bf16*)(ap.ws + WS_XB)}; pg8::gemm_phase<EpiP3b<false>, SchedP3b>(lds, g, S, E, tid_); }
            SEAM(pb + 6);
        }
        if (IN(pb + 7)) {
            PHASE_IDS();
            bf16* xr = (bf16*)(ap.ws + WS_XR); float* rlog = (float*)(ap.ws + WS_RLOG);
            constexpr int NITW = 32 * (2 * 16 * 8 + 4 * 32);
            { const int pm = bid;
                for (int r = wave * 4; r < 128; r += 32) route_rows4(ap, l, xr, pm * 128 + r, lane);
                asm volatile("s_waitcnt vmcnt(0)" ::: "memory"); __syncthreads();
                { pg8::Gemm g{2048, 2048, 2048, 128, 0}; SchedRoute S{(const char*)xr, (const char*)(ap.ws + WS_WR), pm}; EpiRoute E{rlog};
                  pg8::gemm_phase<EpiRoute, SchedRoute>(lds, g, S, E, tid_); }
                asm volatile("s_waitcnt vmcnt(0)" ::: "memory"); __syncthreads();
                if (tid_ < 128) route_decide(ap, l, rlog + (size_t)(pm * 128 + tid_) * 128, rec_e, rec_slot, rec_w, ctl + CW_CNT + l * 32, pm * 128 + tid_);
                __syncthreads();
            }
            expert_weights(ap, l, lds, 0, NITW, gw, NGW, wave, lane);
            SEAM(pb + 7);
        }
        if (IN(pb + 9)) {
            PHASE_IDS();
            build_offsets(ctl + CW_CNT + l * 32, offt, tid_);
            int K9 = 1024; asm volatile("" : "+s"(K9));
            pg8::Gemm g{K9, 2048, 1024, 128, -1}; SchedM2 S{(const char*)(ap.ws + WS_XR), (const char*)(ap.ws + WS_WGU), offt, (const int*)(ap.ws + WS_INVAS), G, xb};
            EpiM2 E{hmid};
            pg8::gemm_phase<EpiM2, SchedM2, true>(lds, g, S, E, tid_); SEAM(pb + 9);
        }
        if (IN(pb + 10)) {
            PHASE_IDS();
            build_offsets(ctl + CW_CNT + l * 32, offt, tid_);
            int K3 = 256; asm volatile("" : "+s"(K3));
            pg8::Gemm g{K3, 256, 256, 128, -1}; SchedM3 S{(const char*)hmid, (const char*)(ap.ws + WS_WD), offt, G, xb};
            EpiM3 E{eo, (const int*)(ap.ws + WS_INVAS), (const float*)(ap.ws + WS_INVW), offt};
            pg8::gemm_phase<EpiM3, SchedM3>(lds, g, S, E, tid_); SEAM(pb + 10);
        }
    }
    if (IN(2 * PPL)) { PHASE_IDS(); phase0_rows(ap, DEPTH, 1, gw, NGW, lane); }
#undef IN
#undef SEAM
}

typedef void (*kern_t)(Args);
template <unsigned PM> static bool setup_kernel() {
    if (hipFuncSetAttribute((const void*)mk_fwd<PM>, hipFuncAttributeMaxDynamicSharedMemorySize, LDS_BYTES) != hipSuccess) { fprintf(stderr, "kernel_launch: hipFuncSetAttribute failed\n"); return false; }
    return true;
}
extern "C" void kernel_launch(void* const* d_in, const int* in_sizes, int n_in, void* d_out, int out_size, void* d_ws, size_t ws_size, hipStream_t stream) {
    static int grid = 0;
    if (grid == 0) {
        if (n_in != 36 || out_size != T * D || ws_size < WS_END) { fprintf(stderr, "kernel_launch: unexpected shapes (n_in %d out %d ws %zu)\n", n_in, out_size, ws_size); grid = -1; return; }
        int dev = 0, cus = 0;
        if (hipGetDevice(&dev) != hipSuccess || hipDeviceGetAttribute(&cus, hipDeviceAttributeMultiprocessorCount, dev) != hipSuccess) { grid = -1; return; }
        bool ok = true;
#if MK_ONE_LAUNCH
        ok = setup_kernel<0xFFFu>();
#endif
        if (!ok) { grid = -1; return; }
        (void)hipGetLastError();
        grid = cus;
        if (grid != 256) { fprintf(stderr, "kernel_launch: built for a 256-CU device (got %d)\n", cus); grid = -1; return; }
    }
    if (grid < 0) return;
    if (hipMemsetAsync((char*)d_ws + WS_CTL, 0, CTL_ZERO_BYTES, stream) != hipSuccess) return;
    Args a{};
    for (int i = 0; i < 36; ++i) a.in[i] = (const float*)d_in[i];
    a.out = (float*)d_out; a.ws = (unsigned char*)d_ws;
#if MK_ONE_LAUNCH
    a.ph_lo = 0; a.ph_hi = NPH;
    hipLaunchKernelGGL(mk_fwd<0xFFFu>, dim3(grid), dim3(512), LDS_BYTES, stream, a);
#endif
}
```

```cpp
#include <hip/hip_runtime.h>
#include <cstdio>
#include <cstdint>

#ifndef MK_ONE_LAUNCH
#define MK_ONE_LAUNCH 1
#endif

#define DI __device__ __forceinline__
#define GAS __attribute__((address_space(1)))
#define LAS __attribute__((address_space(3)))
typedef unsigned short bf16;
typedef short bf16x8 __attribute__((ext_vector_type(8)));
typedef float f32x4 __attribute__((ext_vector_type(4)));
typedef int i32x4 __attribute__((ext_vector_type(4)));
typedef unsigned u32x4 __attribute__((ext_vector_type(4)));
typedef unsigned u32x2 __attribute__((ext_vector_type(2)));
typedef float f32x16 __attribute__((ext_vector_type(16)));
typedef float f32x2 __attribute__((ext_vector_type(2)));
typedef short s16x4 __attribute__((ext_vector_type(4)));
typedef __bf16 bf16x2_t __attribute__((ext_vector_type(2)));
typedef short v4i16_t __attribute__((__vector_size__(4 * sizeof(short))));
#define MFMA32(a, b, c) __builtin_amdgcn_mfma_f32_32x32x16_bf16((a), (b), (c), 0, 0, 0)

constexpr int BATCH = 4, SEQ = 8192, T = BATCH * SEQ, D = 1024, DEPTH = 2;
constexpr int NIN = 2444, PLD = 2560, N1 = 6656, GLD = 4096;
constexpr int C_AX = 0, C_AG = 256, C_BQ = 512, C_BK = 768, C_BV = 896, C_CQ = 1024, C_CK = 1280, C_CV = 1536, C_DQ = 1792,
              C_KC = 2048, C_VC = 2112, C_KS = 2176, C_VS = 2240, C_KW = 2304, C_VW = 2368, C_DG = 2432;
constexpr int NCMP = 511;
constexpr int MOE_ROWS = 73728;
constexpr int PPL = 11;
constexpr int NPH = 2 * PPL + 1;

constexpr size_t MiB = 1u << 20;
constexpr size_t WS_CTL = 0, CTL_ZERO_BYTES = 1 * MiB;
constexpr size_t WS_KCVC = 1 * MiB;
constexpr size_t WS_LRUSUM = 2 * MiB;
constexpr size_t WS_REC = 2 * MiB + 256 * 1024;
constexpr size_t WS_ROWTOK = 3 * MiB;
constexpr size_t WS_ROWW = 3 * MiB + 512 * 1024;
constexpr size_t WS_WIN = 4 * MiB;
constexpr size_t WS_WQ = 4 * MiB;
constexpr size_t WS_WSC = 13 * MiB;
constexpr size_t WS_HSC = 13 * MiB + 65536;
constexpr size_t WS_HQ = 21 * MiB;
constexpr size_t WS_INVAS = 296 * MiB;
constexpr size_t WS_INVW = 300 * MiB;
constexpr size_t WS_XB = 373 * MiB;
constexpr size_t WS_WBR = 17 * MiB;
constexpr size_t WS_WOUT = 19 * MiB;
constexpr size_t WS_HB = 21 * MiB;
constexpr size_t WS_PROJ = 85 * MiB;
constexpr size_t WS_GATES = 245 * MiB;
constexpr size_t WS_WGU = 245 * MiB;
constexpr size_t WS_WD = 277 * MiB;
constexpr size_t WS_XS = 293 * MiB;
constexpr size_t WS_HMID = 437 * MiB;
constexpr size_t WS_XR = 85 * MiB;
constexpr size_t WS_RLOG = 213 * MiB;
constexpr size_t WS_WR = 501 * MiB;
constexpr size_t WS_WCMP = 502 * MiB;
constexpr size_t WS_CMPAB = 503 * MiB;
constexpr size_t WS_LRUW = 505 * MiB + 65536;
constexpr size_t WS_END = 506 * MiB;
constexpr int CW_BAR = 4096;
constexpr int CW_CNT = 16384;

constexpr int RING_BYTES = 131072;
constexpr int MISC_OFF = RING_BYTES;
constexpr int BIAS_OFF = MISC_OFF + 256;
constexpr int OFFT_OFF = BIAS_OFF + 129 * 12 * 4;
constexpr int PTAB_OFF = OFFT_OFF + (40 + 288 + 40) * 4;
constexpr int BIAS2_OFF = PTAB_OFF + 36 * 8;
constexpr int LRUEX_OFF = BIAS2_OFF + 129 * 12 * 4;
constexpr int LDS_BYTES = 163840;
constexpr int LRUCST_OFF = LRUEX_OFF + 8 * 64 * 2 * 4;
constexpr int LRUCAR_OFF = LRUCST_OFF + 3 * 64 * 4;
static_assert(PTAB_OFF % 8 == 0 && LRUCAR_OFF + 8 * 64 * 4 <= LDS_BYTES, "LDS map");

DI float bf2f(bf16 v) { return __builtin_bit_cast(float, (unsigned)v << 16); }
DI float lo_bf(unsigned w) { return __builtin_bit_cast(float, w << 16); }
DI float hi_bf(unsigned w) { return __builtin_bit_cast(float, w & 0xffff0000u); }
DI unsigned f2bf(float f) { unsigned u = __builtin_bit_cast(unsigned, f); return (u + 0x7fffu + ((u >> 16) & 1u)) >> 16; }
DI unsigned pk2(float lo, float hi) { return f2bf(lo) | (f2bf(hi) << 16); }
DI float rl(float v, int i) { return __builtin_bit_cast(float, __builtin_amdgcn_readlane(__builtin_bit_cast(int, v), i)); }
DI int rli(int v, int i) { return __builtin_amdgcn_readlane(v, i); }
DI int my_lane() { int l; asm volatile("v_mbcnt_lo_u32_b32 %0, -1, 0\n\tv_mbcnt_hi_u32_b32 %0, -1, %0" : "=v"(l)); return l; }
template <int O> DI int xshfl_i(int v) {
    if constexpr (O < 32) return __builtin_amdgcn_ds_swizzle(v, (O << 10) | 0x1f);
    else { const int l = my_lane(); return __builtin_amdgcn_ds_bpermute((l ^ 32) << 2, v); }
}
template <int O> DI float xshfl(float v) { return __builtin_bit_cast(float, xshfl_i<O>(__builtin_bit_cast(int, v))); }
DI float wave_sum(float v) { v += xshfl<1>(v); v += xshfl<2>(v); v += xshfl<4>(v); v += xshfl<8>(v); v += xshfl<16>(v); v += xshfl<32>(v); return v; }
DI float wave_max(float v) { v = fmaxf(v, xshfl<1>(v)); v = fmaxf(v, xshfl<2>(v)); v = fmaxf(v, xshfl<4>(v)); v = fmaxf(v, xshfl<8>(v)); v = fmaxf(v, xshfl<16>(v)); v = fmaxf(v, xshfl<32>(v)); return v; }
DI float sigmoidf_(float x) { return __builtin_amdgcn_rcpf(1.f + __builtin_amdgcn_exp2f(-1.4426950408889634f * x)); }
DI float gelu_tanh(float x) { const float u = 0.7978845608028654f * (x + 0.044715f * x * x * x); const float e = __expf(2.f * u); const float th = 1.f - 2.f * __builtin_amdgcn_rcpf(e + 1.f); return 0.5f * x * (1.f + th); }
DI float softplusf_(float x) { return fmaxf(x, 0.f) + log1pf(__expf(-fabsf(x))); }
#define LDS_WAIT() asm volatile("s_waitcnt lgkmcnt(0)" ::: "memory")
#define VM_WAIT() asm volatile("s_waitcnt vmcnt(0)" ::: "memory")

__device__ const unsigned char T5_BUCKET[128] = {
0,1,2,3,4,5,6,7,8,9,10,11,12,13,14,15,16,16,16,17,17,18,18,18,19,19,19,20,20,20,20,21,21,21,21,22,22,22,22,22,23,23,23,23,23,23,24,24,24,24,24,24,25,25,25,25,25,25,25,26,26,26,26,26,26,26,26,27,27,27,27,27,27,27,27,27,27,28,28,28,28,28,28,28,28,28,28,29,29,29,29,29,29,29,29,29,29,29,29,30,30,30,30,30,30,30,30,30,30,30,30,30,30,31,31,31,31,31,31,31,31,31,31,31,31,31,31,31};

#define XB_TMO      128
#define XB_XCNT(j)  (256  + 64 * (j))
#define XB_XSUB(j)  (1280 + 64 * (j))
#define XB_XGEN(j)  (2304 + 64 * (j))
#define XB_TOP      3328
#define XB_TOPGEN   3392
#define XCD_BAR_WORDS 3456
#define XB_SPIN_CAP (1u << 22)
DI unsigned xb_ld(unsigned* p)              { return __hip_atomic_load(p, __ATOMIC_RELAXED, __HIP_MEMORY_SCOPE_AGENT); }
DI unsigned xb_add(unsigned* p, unsigned v) { return __hip_atomic_fetch_add(p, v, __ATOMIC_RELAXED, __HIP_MEMORY_SCOPE_AGENT); }
DI unsigned xb_xcc_id() { return (unsigned)__builtin_amdgcn_s_getreg((3 << 11) | 20) & 0xFu; }
#define XB_SPIN(cond, bar) do { unsigned _sp = 0; while (cond) { __builtin_amdgcn_s_sleep(1); \
    if ((++_sp & 255u) == 0u) { if (xb_ld(&(bar)[XB_TMO])) break; if (_sp > XB_SPIN_CAP) { atomicAdd(&(bar)[XB_TMO], 1u); break; } } } } while (0)
struct XcdBarrier { unsigned* bar; unsigned x; volatile LAS unsigned* st; };
DI XcdBarrier xcd_barrier_post(unsigned* bar, volatile LAS unsigned* st, bool leader) {
    XcdBarrier b; b.bar = bar; b.x = xb_xcc_id(); b.st = st;
    if (leader) (void)xb_add(&bar[XB_XCNT(b.x)], 1u);
    return b;
}
DI void xcd_barrier_complete(unsigned* bar, unsigned x, unsigned& nloc, unsigned& nx) {
    const unsigned G = gridDim.x * gridDim.y * gridDim.z;
    unsigned sum, cnt, mine, sp = 0u;
    for (;;) {
        sum = 0u; cnt = 0u; mine = 0u;
#pragma unroll
        for (unsigned j = 0; j < 16; ++j) { const unsigned c = xb_ld(&bar[XB_XCNT(j)]); sum += c; cnt += (c > 0u) ? 1u : 0u; mine = (j == x) ? c : mine; }
        if (sum == G) break;
        __builtin_amdgcn_s_sleep(1);
        if ((++sp & 255u) == 0u) { if (xb_ld(&bar[XB_TMO])) break; if (sp > XB_SPIN_CAP) { atomicAdd(&bar[XB_TMO], 1u); break; } }
    }
    nloc = mine > 0u ? mine : 1u; nx = cnt > 0u ? cnt : 1u;
}
DI void xcd_barrier(const XcdBarrier& b, bool leader) {
    asm volatile("s_waitcnt vmcnt(0)" ::: "memory");
    __syncthreads();
    if (leader) {
        unsigned* bar = b.bar;
        __builtin_amdgcn_s_waitcnt(0);
        unsigned nloc = b.st[0], nx = b.st[1];
        if (nloc == 0u) { xcd_barrier_complete(bar, b.x, nloc, nx); b.st[0] = nloc; b.st[1] = nx; }
        const unsigned old = xb_add(&bar[XB_XSUB(b.x)], 1u);
        const unsigned gen = old / nloc;
        if (old + 1u == (gen + 1u) * nloc) {
            __builtin_amdgcn_fence(__ATOMIC_RELEASE, "agent");
            asm volatile("s_waitcnt vmcnt(0)" ::: "memory");
            const unsigned og = xb_add(&bar[XB_TOP], 1u);
            const unsigned tg = og / nx;
            if (og + 1u == (tg + 1u) * nx) xb_add(&bar[XB_TOPGEN], 1u);
            else XB_SPIN(xb_ld(&bar[XB_TOPGEN]) == tg, bar);
            __builtin_amdgcn_fence(__ATOMIC_ACQUIRE, "agent");
            xb_add(&bar[XB_XGEN(b.x)], 1u);
            asm volatile("s_waitcnt vmcnt(0)" ::: "memory");
        } else {
            XB_SPIN(xb_ld(&bar[XB_XGEN(b.x)]) == gen, bar);
            __builtin_amdgcn_fence(__ATOMIC_ACQUIRE, "agent");
            asm volatile("s_waitcnt vmcnt(0)" ::: "memory");
        }
    }
    __syncthreads();
}

namespace pg8 {
constexpr int BM = 256, BK = 64, HALF = 128, HTB = HALF * BK * 2;
__host__ __device__ __forceinline__ int lds_byte(int r, int c) { const int st = (r >> 4) * 2 + (c >> 5), rr = r & 15, cc = c & 31, ob = rr * 64 + cc * 2; return st * 1024 + (ob ^ (((ob >> 9) & 1) << 5)); }
__host__ __device__ __forceinline__ void stage_rc(int b, int& R, int& C) { const int st = b / 1024, sb = b % 1024, swz = sb ^ (((sb >> 9) & 1) << 5); R = (st >> 1) * 16 + swz / 64; C = (st & 1) * 32 + (swz % 64) / 2; }
__host__ __device__ __forceinline__ int perm32(int rho) { const int n = rho >> 4, i = rho & 15; return 8 * (i >> 2) + 4 * n + (i & 3); }
struct Unit { const char* a; const char* b; int pm, pn, aux, pad; };
struct Gemm { int K, lda, ldb, kstepA, hstepA; };
template <bool I8> struct AccT { typedef f32x4 type; };
template <> struct AccT<true> { typedef i32x4 type; };
template <class Epi, class Sched, bool GATHER = false, bool I8 = false>
DI void gemm_phase(LAS unsigned char* lds, const Gemm g, const Sched& S, const Epi& E, int tid_in) {
    int tid = tid_in; asm volatile("" : "+v"(tid));
    const int wid = __builtin_amdgcn_readfirstlane(tid >> 6), lane = tid & 63, wr = wid >> 2, wc = wid & 3, fr = lane & 15, fq = lane >> 4;
    const int K = g.K, nt = K / BK;
    unsigned voffA[2], voffB[2];
#pragma unroll
    for (int i = 0; i < 2; ++i) { int R, C; stage_rc(tid * 16 + i * 8192, R, C); const int Rb = (R & ~31) + perm32(R & 31);
        voffA[i] = (unsigned)(R * g.lda + C) * 2u; voffB[i] = (unsigned)(Rb * g.ldb + C) * 2u; }
    const size_t kstep = (size_t)(BK * 2), kstepA = (size_t)g.kstepA;
    const size_t hstepA = g.hstepA < 0 ? (size_t)HALF * g.lda * 2 : (size_t)g.hstepA, hstepB = (size_t)HALF * g.ldb * 2;
    const unsigned hstepA32 = (unsigned)hstepA;
    unsigned gC[2][2] = {{0u, 0u}, {0u, 0u}}, gN[2][2] = {{0u, 0u}, {0u, 0u}};
    const unsigned ldsw = (unsigned)wid * 1024u;
    const int aoff = lds_byte(wr * 64 + fr, fq * 8), boff = lds_byte(wc * 32 + fr, fq * 8);
#define PG8_SA(b, h) (((b) * 2 + (h)) * HTB)
#define PG8_SB(b, h) ((4 + (b) * 2 + (h)) * HTB)
#define PG8_STAGE(bufoff, gbase, voff) do { _Pragma("unroll") for (int _i = 0; _i < 2; ++_i) \
        __builtin_amdgcn_global_load_lds((const unsigned*)((const char*)(gbase) + (voff)[_i]), (LAS unsigned*)(lds + (bufoff) + ldsw + _i * 8192), 16, 0, 0); } while (0)
#define PG8_STAGEA(bufoff, gbase, h, nextsel) do { _Pragma("unroll") for (int _i = 0; _i < 2; ++_i) { \
        const unsigned _o = GATHER ? ((nextsel) ? gN[h][_i] : gC[h][_i]) : (voffA[_i] + (unsigned)(h) * hstepA32); \
        __builtin_amdgcn_global_load_lds((const unsigned*)((const char*)(gbase) + _o), (LAS unsigned*)(lds + (bufoff) + ldsw + _i * 8192), 16, 0, 0); } } while (0)
#define PG8_LDA(dst, b, h) do { _Pragma("unroll") for (int m = 0; m < 4; ++m) _Pragma("unroll") for (int k = 0; k < 2; ++k) dst[m][k] = *(const LAS bf16x8*)(lds + PG8_SA(b, h) + aoff + m * 2048 + k * 1024); } while (0)
#define PG8_LDB(dst, b, h) do { _Pragma("unroll") for (int n = 0; n < 2; ++n) _Pragma("unroll") for (int k = 0; k < 2; ++k) dst[n][k] = *(const LAS bf16x8*)(lds + PG8_SB(b, h) + boff + n * 2048 + k * 1024); } while (0)
#define PG8_MMA(ai, bj, At, Bt) do { __builtin_amdgcn_s_setprio(1); _Pragma("unroll") for (int m = 0; m < 4; ++m) _Pragma("unroll") for (int n = 0; n < 2; ++n) _Pragma("unroll") for (int k = 0; k < 2; ++k) \
        { if constexpr (I8) acc[ai][bj][m][n] = __builtin_amdgcn_mfma_i32_16x16x64_i8(__builtin_bit_cast(i32x4, Bt[n][k]), __builtin_bit_cast(i32x4, At[m][k]), acc[ai][bj][m][n], 0, 0, 0); \
          else acc[ai][bj][m][n] = __builtin_amdgcn_mfma_f32_16x16x32_bf16(Bt[n][k], At[m][k], acc[ai][bj][m][n], 0, 0, 0); } __builtin_amdgcn_s_setprio(0); } while (0)
#define PG8_WAIT_V(n) asm volatile("s_waitcnt vmcnt(" #n ")" ::: "memory")
#define PG8_WAIT_L(n) asm volatile("s_waitcnt lgkmcnt(" #n ")" ::: "memory")
#define PG8_BAR __builtin_amdgcn_s_barrier()
#define PG8_SCHED __builtin_amdgcn_sched_barrier(0)
    Unit cur, nxt; int ui = 0;
    if (!S.next(0, cur)) return;
    typedef typename AccT<I8>::type ACC;
    ACC acc[2][2][4][2];
#pragma unroll
    for (int a = 0; a < 2; ++a)
#pragma unroll
        for (int b = 0; b < 2; ++b)
#pragma unroll
            for (int m = 0; m < 4; ++m)
#pragma unroll
                for (int n = 0; n < 2; ++n) acc[a][b][m][n] = (ACC){0, 0, 0, 0};
    bf16x8 At[4][2], B0[2][2], B1[2][2];
    const char* cA = cur.a; const char* cB = cur.b;
    if constexpr (GATHER) S.rows(cur, tid, gC);
    PG8_STAGE(PG8_SB(0, 0), cB, voffB); PG8_STAGE(PG8_SB(0, 1), cB + hstepB, voffB); PG8_STAGEA(PG8_SA(0, 0), cA, 0, false); PG8_STAGEA(PG8_SA(0, 1), cA, 1, false);
    if (wr == 1) PG8_BAR;
    PG8_WAIT_V(2); PG8_BAR;
    PG8_STAGE(PG8_SB(1, 0), cB + kstep, voffB); PG8_STAGEA(PG8_SA(1, 0), cA + kstepA, 0, false); PG8_STAGE(PG8_SB(1, 1), cB + hstepB + kstep, voffB);
    PG8_WAIT_V(6); PG8_BAR;
    for (;;) {
        const bool has_next = S.next(ui + 1, nxt);
        const char* nA = has_next ? nxt.a : cA; const char* nB = has_next ? nxt.b : cB;
        if constexpr (GATHER) { if (has_next) S.rows(nxt, tid, gN); else {
#pragma unroll
            for (int h = 0; h < 2; ++h) { gN[h][0] = gC[h][0]; gN[h][1] = gC[h][1]; } } }
        for (int t = 0; t < nt; t += 2) {
            const bool last = (t == nt - 2);
            const char* a1 = cA + (size_t)(t + 1) * kstepA;
            const char* a2 = last ? nA : cA + (size_t)(t + 2) * kstepA; const char* b2 = last ? nB : cB + (size_t)(t + 2) * kstep;
            const char* a3 = a2 + kstepA; const char* b3 = b2 + kstep;
            PG8_LDB(B0, 0, 0); PG8_LDB(B1, 0, 1); PG8_SCHED; PG8_LDA(At, 0, 0); PG8_STAGEA(PG8_SA(1, 1), a1, 1, false);
            PG8_WAIT_V(8); PG8_WAIT_L(0); PG8_BAR; PG8_MMA(0, 0, At, B0); PG8_MMA(0, 1, At, B1); PG8_BAR; PG8_SCHED;
            PG8_LDA(At, 0, 1); PG8_STAGE(PG8_SB(0, 0), b2, voffB); PG8_STAGE(PG8_SB(0, 1), b2 + hstepB, voffB); PG8_STAGEA(PG8_SA(0, 0), a2, 0, last);
            PG8_WAIT_V(8); PG8_WAIT_L(0); PG8_BAR; PG8_MMA(1, 0, At, B0); PG8_MMA(1, 1, At, B1); PG8_BAR; PG8_SCHED;
            PG8_LDB(B0, 1, 0); PG8_LDB(B1, 1, 1); PG8_SCHED; PG8_LDA(At, 1, 0); PG8_STAGEA(PG8_SA(0, 1), a2, 1, last);
            PG8_WAIT_V(8); PG8_WAIT_L(0); PG8_BAR; PG8_MMA(0, 0, At, B0); PG8_MMA(0, 1, At, B1); PG8_BAR; PG8_SCHED;
            PG8_LDA(At, 1, 1); PG8_STAGE(PG8_SB(1, 0), b3, voffB); PG8_STAGE(PG8_SB(1, 1), b3 + hstepB, voffB); PG8_STAGEA(PG8_SA(1, 0), a3, 0, last);
            PG8_WAIT_V(8); PG8_WAIT_L(0); PG8_BAR; PG8_MMA(1, 0, At, B0); PG8_MMA(1, 1, At, B1); PG8_BAR; PG8_SCHED;
        }
        if (wr == 0) PG8_BAR;
        { const int el = my_lane(); E(acc, cur, wr, wc, el & 15, el >> 4); }
        if (!has_next) break;
        bool carried = false;
        if constexpr (Epi::CARRY) { if (nxt.aux != 0) { const int el = my_lane(); E.carry(acc, nxt, wr, wc, el & 15, el >> 4); carried = true; } }
        if (!carried) {
#pragma unroll
        for (int a = 0; a < 2; ++a)
#pragma unroll
            for (int b = 0; b < 2; ++b)
#pragma unroll
                for (int m = 0; m < 4; ++m)
#pragma unroll
                    for (int n = 0; n < 2; ++n) acc[a][b][m][n] = (ACC){0, 0, 0, 0};
        }
        cur = nxt; cA = nA; cB = nB; ++ui;
        if constexpr (GATHER) {
#pragma unroll
            for (int h = 0; h < 2; ++h) { gC[h][0] = gN[h][0]; gC[h][1] = gN[h][1]; } }
        if (wr == 1) PG8_BAR;
    }
    PG8_WAIT_V(0);
    PG8_BAR;
#undef PG8_SA
#undef PG8_SB
#undef PG8_STAGE
#undef PG8_STAGEA
#undef PG8_LDA
#undef PG8_LDB
#undef PG8_MMA
#undef PG8_WAIT_V
#undef PG8_WAIT_L
#undef PG8_BAR
#undef PG8_SCHED
}
}
using pg8::Unit;

DI unsigned cvt_pk_bf16(float lo, float hi) { unsigned r; asm volatile("s_nop 1\n\tv_cvt_pk_bf16_f32 %0, %1, %2" : "=v"(r) : "v"(lo), "v"(hi)); return r; }
DI u32x4 pack8(const f32x4& v0, const f32x4& v1) { u32x4 w; w.x = cvt_pk_bf16(v0[0], v0[1]); w.y = cvt_pk_bf16(v0[2], v0[3]); w.z = cvt_pk_bf16(v1[0], v1[1]); w.w = cvt_pk_bf16(v1[2], v1[3]); return w; }

struct SchedP1 {
    const char* A; const char* B; int nM, nN, rbA, rbB, G, c;
    DI bool next(int i, Unit& u) const {
        constexpr int NXCD = 8, WGM = 8; const int nwg = nM * nN;
        const long L = (long)i * G + c; if (L >= nwg) return false;
        int wgid = (int)L; { const int q = nwg / NXCD, r = nwg % NXCD, xcd = wgid % NXCD, off = wgid / NXCD; wgid = (xcd < r ? xcd * (q + 1) : r * (q + 1) + (xcd - r) * q) + off; }
        const int nig = WGM * nN, gid = wgid / nig, fm = gid * WGM, gsz = (nM - fm) < WGM ? (nM - fm) : WGM;
        u.pm = fm + ((wgid % nig) % gsz); u.pn = (wgid % nig) / gsz; u.aux = 0; u.pad = 0;
        u.a = A + (size_t)u.pm * 256 * rbA; u.b = B + (size_t)u.pn * 256 * rbB; return true;
    }
};
struct SchedP3a {
    const char* ys; const char* wbr; int G, c;
    DI bool next(int i, Unit& u) const {
        const int tile = (i >> 2) * G + c; if (tile >= 512) return false;
        const int br = i & 3; u.pm = tile >> 2; u.pn = tile & 3; u.aux = br; u.pad = 0;
        u.a = ys + ((size_t)u.pm * 256 * 1024 + br * 256) * 2; u.b = wbr + ((size_t)br * 1024 * 256 + (size_t)u.pn * 256 * 256) * 2; return true;
    }
};
struct SchedP3b {
    const char* A; const char* B; int G, c;
    DI bool next(int i, Unit& u) const {
        const int L = i * G + c; if (L >= 512) return false;
        u.pm = L >> 2; u.pn = L & 3; u.aux = 0; u.pad = 0;
        u.a = A + (size_t)u.pm * 256 * 1024 * 2; u.b = B + (size_t)u.pn * 256 * 1024 * 2; return true;
    }
};
struct SchedM2 {
    const char* xr; const char* wgu; const LAS int* offt; const int* rowsrc; int G, c;
    DI bool next(int i, Unit& u) const {
        const int NT = __builtin_amdgcn_readfirstlane(offt[32]) >> 8; const int L = i * G + c; if (L >= NT * 2) return false;
        const int rt = L >> 1, pn = L & 1; const int e = __builtin_amdgcn_readfirstlane(offt[40 + rt]);
        u.pm = rt; u.pn = pn; u.aux = e; u.pad = 0;
        u.a = xr; u.b = wgu + ((size_t)e * 512 + pn * 256) * 1024 * 2; return true;
    }
    DI void rows(const Unit& u, int tid, unsigned (&g)[2][2]) const {
        const int e = u.aux; const int base = u.pm * 256 - __builtin_amdgcn_readfirstlane(offt[e]), cnt = __builtin_amdgcn_readfirstlane(offt[330 + e]);
#pragma unroll
        for (int i = 0; i < 2; ++i) { int R, C; pg8::stage_rc(tid * 16 + i * 8192, R, C);
#pragma unroll
            for (int h = 0; h < 2; ++h) { const int lr = base + h * 128 + R; const int as = lr < cnt ? rowsrc[e * 32768 + lr] : 0;
                g[h][i] = (unsigned)(as >> 1) * 4096u + (unsigned)C * 2u; } }
    }
};
struct SchedM3 {
    const char* hmid; const char* wd; const LAS int* offt; int G, c;
    DI bool next(int i, Unit& u) const {
        const int NT = __builtin_amdgcn_readfirstlane(offt[32]) >> 8; const int L = i * G + c; if (L >= NT * 4) return false;
        const int rt = L >> 2, pn = L & 3; const int e = __builtin_amdgcn_readfirstlane(offt[40 + rt]);
        u.pm = rt; u.pn = pn; u.aux = e; u.pad = 0;
        u.a = hmid + (size_t)rt * 256 * 256 * 2; u.b = wd + ((size_t)e * 1024 + pn * 256) * 256 * 2; return true;
    }
};

struct EpiP1I8 {
    static constexpr bool CARRY = false;
    bf16* proj; unsigned char* gates; const float* bgate; const float* hsc; const float* wsc;
    DI void operator()(const i32x4 (&acc)[2][2][4][2], const Unit& u, int wr, int wc, int fr, int fq) const {
        const int row0 = u.pm * 256 + wr * 64 + fr;
        if (u.pn < 10) { const int colt = u.pn * 256 + wc * 32 + 8 * fq;
            f32x4 sv[2][2]; float rsv[2][4];
#pragma unroll
            for (int bj = 0; bj < 2; ++bj)
#pragma unroll
                for (int n = 0; n < 2; ++n) sv[bj][n] = *(const GAS f32x4*)((const GAS float*)wsc + colt + bj * 128 + 4 * n);
#pragma unroll
            for (int ai = 0; ai < 2; ++ai)
#pragma unroll
                for (int m = 0; m < 4; ++m) rsv[ai][m] = ((const GAS float*)hsc)[row0 + ai * 128 + m * 16];
#pragma unroll
            for (int ai = 0; ai < 2; ++ai)
#pragma unroll
                for (int m = 0; m < 4; ++m) { bf16* rowp = proj + (size_t)(row0 + ai * 128 + m * 16) * PLD + colt; const float rs = rsv[ai][m];
#pragma unroll
                    for (int bj = 0; bj < 2; ++bj) { f32x4 v0, v1;
#pragma unroll
                        for (int e = 0; e < 4; ++e) { v0[e] = (float)acc[ai][bj][m][0][e] * (rs * sv[bj][0][e]); v1[e] = (float)acc[ai][bj][m][1][e] * (rs * sv[bj][1][e]); }
                        *(u32x4*)(rowp + bj * 128) = pack8(v0, v1); } }
            return; }
        const int gcol = (u.pn - 10) * 256 + wc * 32 + 8 * fq; const float* wsc = this->wsc + 2560;
        f32x4 bv[2][2], sv[2][2];
#pragma unroll
        for (int bj = 0; bj < 2; ++bj)
#pragma unroll
            for (int n = 0; n < 2; ++n) { bv[bj][n] = *(const f32x4*)(bgate + gcol + bj * 128 + 4 * n); sv[bj][n] = *(const f32x4*)(wsc + gcol + bj * 128 + 4 * n); }
        float rsv[2][4];
#pragma unroll
        for (int ai = 0; ai < 2; ++ai)
#pragma unroll
            for (int m = 0; m < 4; ++m) rsv[ai][m] = ((const GAS float*)hsc)[row0 + ai * 128 + m * 16];
#pragma unroll
        for (int ai = 0; ai < 2; ++ai)
#pragma unroll
            for (int m = 0; m < 4; ++m) { const float rs = rsv[ai][m];
                unsigned char* rowp = gates + ((size_t)(u.pm * 16 + (u.pn - 10)) * 65536 + (size_t)((ai * 4 + m) * 8192 + (wr * 4 + wc) * 512 + (fq * 16 + fr) * 8));
#pragma unroll
                for (int bj = 0; bj < 2; ++bj) { unsigned q[8];
#pragma unroll
                    for (int n = 0; n < 2; ++n)
#pragma unroll
                        for (int e = 0; e < 4; ++e) { const float pre = (float)acc[ai][bj][m][n][e] * (rs * sv[bj][n][e]) + bv[bj][n][e];
                            q[4 * n + e] = (unsigned)fminf(256.f * sigmoidf_(pre), 255.5f); }
                    u32x2 w; w.x = q[0] | (q[1] << 8) | (q[2] << 16) | (q[3] << 24); w.y = q[4] | (q[5] << 8) | (q[6] << 16) | (q[7] << 24);
                    *(u32x2*)(rowp + bj * 4096) = w; }
                __builtin_amdgcn_sched_barrier(0); }
    }
};
struct EpiP3a {
    static constexpr bool CARRY = true;
    bf16* merged; const unsigned char* gates;
    DI void carry(f32x4 (&acc)[2][2][4][2], const Unit& u, int wr, int wc, int fr, int fq) const {
        const GAS unsigned char* gb = (const GAS unsigned char*)gates + (size_t)(u.pm * 16 + (u.aux - 1) * 4 + u.pn) * 65536;
        const unsigned go = (unsigned)((wr * 4 + wc) * 512 + (fq * 16 + fr) * 8);
        u32x2 gp[2][4][2], gn[2][4][2];
#pragma unroll
        for (int ai = 0; ai < 2; ++ai)
#pragma unroll
            for (int m = 0; m < 4; ++m)
#pragma unroll
                for (int bj = 0; bj < 2; ++bj) { gp[ai][m][bj] = *(const GAS u32x2*)(gb + go + (unsigned)(((ai * 4 + m) * 2 + bj) * 4096));
                    gn[ai][m][bj] = *(const GAS u32x2*)(gb + go + (unsigned)(((ai * 4 + m) * 2 + bj) * 4096 + 4 * 65536)); }
#pragma unroll
        for (int ai = 0; ai < 2; ++ai) {
#pragma unroll
            for (int m = 0; m < 4; ++m)
#pragma unroll
                for (int bj = 0; bj < 2; ++bj) {
#pragma unroll
                    for (int n = 0; n < 2; ++n) { const unsigned p4 = n ? gp[ai][m][bj].y : gp[ai][m][bj].x, n4 = n ? gn[ai][m][bj].y : gn[ai][m][bj].x;
#pragma unroll
                        for (int e = 0; e < 4; ++e) acc[ai][bj][m][n][e] *= ((float)((p4 >> (8 * e)) & 255u) + 0.5f) * __builtin_amdgcn_rcpf((float)((n4 >> (8 * e)) & 255u) + 0.5f); } }
            __builtin_amdgcn_sched_barrier(0); }
    }
    DI void operator()(const f32x4 (&acc)[2][2][4][2], const Unit& u, int wr, int wc, int fr, int fq) const {
        if (u.aux != 3) return;
        const GAS unsigned char* gb = (const GAS unsigned char*)gates + (size_t)(u.pm * 16 + 3 * 4 + u.pn) * 65536;
        GAS unsigned char* mb = (GAS unsigned char*)merged + ((size_t)(u.pm * 256) * 1024 + u.pn * 256) * 2;
        const unsigned go = (unsigned)((wr * 4 + wc) * 512 + (fq * 16 + fr) * 8), mo = (unsigned)((wr * 64 + fr) * 1024 + wc * 32 + 8 * fq) * 2u;
        u32x2 gw[2][4][2];
#pragma unroll
        for (int ai = 0; ai < 2; ++ai)
#pragma unroll
            for (int m = 0; m < 4; ++m)
#pragma unroll
                for (int bj = 0; bj < 2; ++bj) gw[ai][m][bj] = *(const GAS u32x2*)(gb + go + (unsigned)(((ai * 4 + m) * 2 + bj) * 4096));
#pragma unroll
        for (int ai = 0; ai < 2; ++ai) {
#pragma unroll
            for (int m = 0; m < 4; ++m)
#pragma unroll
                for (int bj = 0; bj < 2; ++bj) {
                    f32x4 v0 = acc[ai][bj][m][0], v1 = acc[ai][bj][m][1]; const u32x2 g2 = gw[ai][m][bj]; const float k256 = 0.00390625f;
#pragma unroll
                    for (int e = 0; e < 4; ++e) { v0[e] *= ((float)((g2.x >> (8 * e)) & 255u) + 0.5f) * k256; v1[e] *= ((float)((g2.y >> (8 * e)) & 255u) + 0.5f) * k256; }
                    *(GAS u32x4*)(mb + mo + (unsigned)((ai * 128 + m * 16) * 1024 + bj * 128) * 2u) = pack8(v0, v1); }
            __builtin_amdgcn_sched_barrier(0); }
    }
};
template <bool XF32> struct EpiP3b {
    static constexpr bool CARRY = false;
    const float* xin; bf16* xb_;
    DI void operator()(const f32x4 (&acc)[2][2][4][2], const Unit& u, int wr, int wc, int fr, int fq) const {
        GAS unsigned char* ob = (GAS unsigned char*)xb_ + ((size_t)(u.pm * 256) * 1024 + u.pn * 256) * 2;
        const unsigned lo = (unsigned)((wr * 64 + fr) * 1024 + wc * 32 + 8 * fq);
        if constexpr (XF32) {
            const GAS unsigned char* xb = (const GAS unsigned char*)xin + ((size_t)(u.pm * 256) * 1024 + u.pn * 256) * 4;
#pragma unroll
            for (int ai = 0; ai < 2; ++ai)
#pragma unroll
                for (int mh = 0; mh < 2; ++mh) {
                    f32x4 xv[2][2][2];
#pragma unroll
                    for (int m2 = 0; m2 < 2; ++m2)
#pragma unroll
                        for (int bj = 0; bj < 2; ++bj)
#pragma unroll
                            for (int n = 0; n < 2; ++n) xv[m2][bj][n] = *(const GAS f32x4*)(xb + (lo + (unsigned)((ai * 128 + (mh * 2 + m2) * 16) * 1024 + bj * 128 + 4 * n)) * 4u);
#pragma unroll
                    for (int m2 = 0; m2 < 2; ++m2)
#pragma unroll
                        for (int bj = 0; bj < 2; ++bj)
                            *(GAS u32x4*)(ob + (lo + (unsigned)((ai * 128 + (mh * 2 + m2) * 16) * 1024 + bj * 128)) * 2u) = pack8(xv[m2][bj][0] + acc[ai][bj][mh * 2 + m2][0], xv[m2][bj][1] + acc[ai][bj][mh * 2 + m2][1]);
                    __builtin_amdgcn_sched_barrier(0); }
        } else {
#pragma unroll
            for (int ai = 0; ai < 2; ++ai) {
                u32x4 xv[4][2];
#pragma unroll
                for (int m = 0; m < 4; ++m)
#pragma unroll
                    for (int bj = 0; bj < 2; ++bj) xv[m][bj] = *(const GAS u32x4*)(ob + (lo + (unsigned)((ai * 128 + m * 16) * 1024 + bj * 128)) * 2u);
#pragma unroll
                for (int m = 0; m < 4; ++m)
#pragma unroll
                    for (int bj = 0; bj < 2; ++bj) { const u32x4 x4 = xv[m][bj]; f32x4 v0 = acc[ai][bj][m][0], v1 = acc[ai][bj][m][1];
                        v0[0] += lo_bf(x4.x); v0[1] += hi_bf(x4.x); v0[2] += lo_bf(x4.y); v0[3] += hi_bf(x4.y); v1[0] += lo_bf(x4.z); v1[1] += hi_bf(x4.z); v1[2] += lo_bf(x4.w); v1[3] += hi_bf(x4.w);
                        *(GAS u32x4*)(ob + (lo + (unsigned)((ai * 128 + m * 16) * 1024 + bj * 128)) * 2u) = pack8(v0, v1); }
                __builtin_amdgcn_sched_barrier(0); }
        }
    }
};
struct EpiM2 {
    static constexpr bool CARRY = false;
    bf16* hmid;
    DI void operator()(const f32x4 (&acc)[2][2][4][2], const Unit& u, int wr, int wc, int fr, int fq) const {
        const int row0 = u.pm * 256 + wr * 64 + fr; const int col = u.pn * 128 + wc * 32 + 8 * fq;
#pragma unroll
        for (int ai = 0; ai < 2; ++ai)
#pragma unroll
            for (int m = 0; m < 4; ++m) { f32x4 h0, h1;
#pragma unroll
                for (int e = 0; e < 4; ++e) { const float g0 = acc[ai][0][m][0][e], g1 = acc[ai][0][m][1][e];
                    h0[e] = g0 * sigmoidf_(g0) * acc[ai][1][m][0][e]; h1[e] = g1 * sigmoidf_(g1) * acc[ai][1][m][1][e]; }
                *(u32x4*)(hmid + (size_t)(row0 + ai * 128 + m * 16) * 256 + col) = pack8(h0, h1); }
    }
};
struct EpiM3 {
    static constexpr bool CARRY = false;
    bf16* eo; const int* rowtok; const float* roww; const LAS int* offt;
    DI void operator()(const f32x4 (&acc)[2][2][4][2], const Unit& u, int wr, int wc, int fr, int fq) const {
        const int e = u.aux; const int cnt = __builtin_amdgcn_readfirstlane(offt[330 + e]);
        const int lr0 = u.pm * 256 - __builtin_amdgcn_readfirstlane(offt[e]) + wr * 64 + fr; const int colt = u.pn * 256 + wc * 32 + 8 * fq;
        int tk[2][4]; float wv[2][4];
#pragma unroll
        for (int ai = 0; ai < 2; ++ai)
#pragma unroll
            for (int m = 0; m < 4; ++m) { const int lr = lr0 + ai * 128 + m * 16; tk[ai][m] = -1; wv[ai][m] = 0.f;
                if (lr < cnt) { tk[ai][m] = ((const GAS int*)rowtok)[e * 32768 + lr]; wv[ai][m] = ((const GAS float*)roww)[e * 32768 + lr]; } }
#pragma unroll
        for (int ai = 0; ai < 2; ++ai)
#pragma unroll
            for (int m = 0; m < 4; ++m) {
                if (tk[ai][m] >= 0) { const float w = wv[ai][m]; GAS bf16* op = (GAS bf16*)eo + (size_t)tk[ai][m] * 1024 + colt;
#pragma unroll
                    for (int bj = 0; bj < 2; ++bj) *(GAS u32x4*)(op + bj * 128) = pack8(acc[ai][bj][m][0] * w, acc[ai][bj][m][1] * w); }
                __builtin_amdgcn_sched_barrier(0); }
    }
};

struct Args { const float* in[36]; float* out; unsigned char* ws; int ph_lo, ph_hi; };
struct InTab { unsigned base;
    DI const float* operator[](int i) const { unsigned long long v; const unsigned addr = base + (unsigned)i * 8u;
        asm volatile("ds_read_b64 %0, %1\n\ts_waitcnt lgkmcnt(0)" : "=v"(v) : "v"(addr) : "memory");
        const unsigned lo = __builtin_amdgcn_readfirstlane((unsigned)v), hi = __builtin_amdgcn_readfirstlane((unsigned)(v >> 32));
        return (const float*)(((unsigned long long)hi << 32) | lo); } };
struct KA { InTab in; float* out; unsigned char* ws; };

DI void transpose_item(const float* W_, int ldw, int nvalid, bf16* WT_, int ldt, int k0, int n0, int dst_row0, LAS float* scr, int lane) {
    const GAS float* W = (const GAS float*)W_; GAS bf16* WT = (GAS bf16*)WT_;
    const int nq = 4 * (lane & 7), kr8 = lane >> 3;
    f32x4 v[8];
#pragma unroll
    for (int i = 0; i < 8; ++i) { const int kk = 8 * i + kr8;
        if (n0 + nq + 3 < nvalid) v[i] = *(const GAS f32x4*)(W + (size_t)(k0 + kk) * ldw + n0 + nq);
        else {
#pragma unroll
            for (int e = 0; e < 4; ++e) v[i][e] = (n0 + nq + e < nvalid) ? W[(size_t)(k0 + kk) * ldw + n0 + nq + e] : 0.f; } }
#pragma unroll
    for (int i = 0; i < 8; ++i) { const int kk = 8 * i + kr8;
#pragma unroll
        for (int e = 0; e < 4; ++e) scr[kk * 33 + nq + e] = v[i][e]; }
    LDS_WAIT(); asm volatile("" ::: "memory");
    const int c = lane & 7;
#pragma unroll
    for (int j = 0; j < 4; ++j) { const int n = (lane >> 3) + 8 * j; const LAS float* s = scr + (8 * c) * 33 + n;
        u32x4 o; o.x = pk2(s[0 * 33], s[1 * 33]); o.y = pk2(s[2 * 33], s[3 * 33]); o.z = pk2(s[4 * 33], s[5 * 33]); o.w = pk2(s[6 * 33], s[7 * 33]);
        if (n0 + n < nvalid) *(GAS u32x4*)(WT + (size_t)(dst_row0 + n) * ldt + k0 + 8 * c) = o; }
    LDS_WAIT(); asm volatile("" ::: "memory");
}
DI void phase0_weights(const KA& a, int l, LAS unsigned char* lds, int gw, int NGW, int wave, int lane) {
    LAS float* scr = (LAS float*)(lds + wave * 16384);
    const float* w_in = a.in[4] + (size_t)l * 1024 * NIN;
    const float* w_gate = a.in[24] + (size_t)l * 4 * 1024 * 1024;
    const float* w_br = a.in[26] + (size_t)l * 4 * 256 * 1024;
    const float* w_out = a.in[27] + (size_t)l * 1024 * 1024;
    bf16* Wt_in = (bf16*)(a.ws + WS_WIN); bf16* Wt_br = (bf16*)(a.ws + WS_WBR); bf16* Wt_out = (bf16*)(a.ws + WS_WOUT);
    constexpr int I_B = 4 * 4 * 32, I_O = 16 * 32, NIT = I_B + I_O;
    (void)w_gate; (void)w_in; (void)Wt_in;
    for (int it = gw; it < NIT; it += NGW) {
        int r = it;
        if (r < I_B) { const int br = r / 128, q = r % 128, kb = q / 32, nb = q % 32; transpose_item(w_br + (size_t)br * 256 * 1024, 1024, 1024, Wt_br + (size_t)br * 1024 * 256, 256, kb * 64, nb * 32, nb * 32, scr, lane); continue; } r -= I_B;
        { const int kb = r / 32, nb = r % 32; transpose_item(w_out, 1024, 1024, Wt_out, 1024, kb * 64, nb * 32, nb * 32, scr, lane); }
    }
}
DI void p1_weights_i8(const KA& a, int l, LAS unsigned char* lds, int gw, int NGW, int wave, int lane) {
    LAS float* scr = (LAS float*)(lds + wave * 16384);
    const GAS float* wgt = (const GAS float*)(a.in[24] + (size_t)l * 4 * 1024 * 1024); const GAS float* win = (const GAS float*)(a.in[4] + (size_t)l * 1024 * NIN);
    GAS unsigned char* Wq = (GAS unsigned char*)(a.ws + WS_WQ); GAS float* wsc = (GAS float*)(a.ws + WS_WSC);
    const int nq = 4 * (lane & 7), kr8 = lane >> 3;
    for (int it = NGW - 1 - gw; it < 128 + 77; it += NGW) {
        const bool isg = it < 128; const int br = it >> 5; const int n0 = isg ? (it & 31) * 32 : (it - 128) * 32;
        const int ldw = isg ? 1024 : NIN; const int nval = isg ? 1024 : NIN; const int drow0 = isg ? 2560 + br * 1024 + n0 : n0;
        const bool lok = (n0 + nq) < nval;
        const GAS float* W = (isg ? wgt + (size_t)br * 1024 * 1024 : win) + n0 + nq;
        f32x4 mx = {0.f, 0.f, 0.f, 0.f};
#pragma unroll 8
        for (int i = 0; i < 128; ++i) { f32x4 v = {0.f, 0.f, 0.f, 0.f}; if (lok) v = *(const GAS f32x4*)(W + (size_t)(8 * i + kr8) * ldw);
            mx[0] = fmaxf(mx[0], fabsf(v[0])); mx[1] = fmaxf(mx[1], fabsf(v[1])); mx[2] = fmaxf(mx[2], fabsf(v[2])); mx[3] = fmaxf(mx[3], fabsf(v[3])); }
#pragma unroll
        for (int e = 0; e < 4; ++e) { float m = mx[e]; m = fmaxf(m, xshfl<8>(m)); m = fmaxf(m, xshfl<16>(m)); m = fmaxf(m, xshfl<32>(m)); mx[e] = fmaxf(m, 1e-20f); }
        if (kr8 == 0 && lok) *(GAS f32x4*)(wsc + drow0 + nq) = mx * (1.f / 127.f);
        const f32x4 qs = {127.f / mx[0], 127.f / mx[1], 127.f / mx[2], 127.f / mx[3]};
#pragma unroll 1
        for (int kb = 0; kb < 16; ++kb) {
            f32x4 v[8];
#pragma unroll
            for (int i = 0; i < 8; ++i) { v[i] = (f32x4){0.f, 0.f, 0.f, 0.f}; if (lok) v[i] = *(const GAS f32x4*)(W + (size_t)(kb * 64 + 8 * i + kr8) * ldw); }
#pragma unroll
            for (int i = 0; i < 8; ++i) { const int kk = 8 * i + kr8;
#pragma unroll
                for (int e = 0; e < 4; ++e) scr[kk * 33 + nq + e] = __builtin_rintf(v[i][e] * qs[e]); }
            LDS_WAIT(); asm volatile("" ::: "memory");
            const int n = lane >> 1, kh = lane & 1; u32x4 o[2];
#pragma unroll
            for (int h2 = 0; h2 < 2; ++h2) { unsigned w4[4];
#pragma unroll
                for (int d = 0; d < 4; ++d) { unsigned wv = 0u;
#pragma unroll
                    for (int e = 0; e < 4; ++e) wv |= ((unsigned)(int)scr[(32 * kh + 16 * h2 + 4 * d + e) * 33 + n] & 255u) << (8 * e);
                    w4[d] = wv; }
                o[h2].x = w4[0]; o[h2].y = w4[1]; o[h2].z = w4[2]; o[h2].w = w4[3]; }
            if (n0 + n < nval) { GAS unsigned char* dst = Wq + (size_t)(drow0 + n) * 1024 + kb * 64 + 32 * kh; *(GAS u32x4*)dst = o[0]; *(GAS u32x4*)(dst + 16) = o[1]; }
            LDS_WAIT(); asm volatile("" ::: "memory");
        }
    }
}

DI void router_weights(const KA& a, int l, int gw, int NGW, int lane) {
    bf16* Wr = (bf16*)(a.ws + WS_WR);
    const float* wg = a.in[29] + (size_t)l * 1024 * 4; const float* we = a.in[31] + (size_t)l * 1024 * 32;
    for (int n = gw; n < 36; n += NGW) {
        for (int i = 0; i < 16; ++i) { const int k = lane + 64 * i; const float w = (n < 4) ? wg[k * 4 + n] : we[k * 32 + (n - 4)];
            const unsigned hi = f2bf(w); const float hf = __builtin_bit_cast(float, hi << 16); const unsigned lo = f2bf(w - hf);
            Wr[(size_t)n * 2048 + k] = (bf16)hi; Wr[(size_t)n * 2048 + 1024 + k] = (bf16)hi; Wr[(size_t)(64 + n) * 2048 + k] = (bf16)lo; Wr[(size_t)(64 + n) * 2048 + 1024 + k] = 0; }
    }
}

DI void cmp_weights(const KA& a, int l, LAS unsigned char* lds, int gw, int NGW, int wave, int lane) {
    LAS float* scr = (LAS float*)(lds + wave * 16384);
    bf16* Wc = (bf16*)(a.ws + WS_WCMP); float* pt = (float*)(a.ws + WS_CMPAB + 2 * MiB);
    for (int it = gw; it < 128 + 64; it += NGW) {
        if (it < 128) { const int kv = it >> 6, q = it & 63, kb = q >> 1, nb = q & 1; const float* w1 = a.in[kv ? 22 : 19] + (size_t)l * 2048 * 64;
            bf16* dst = Wc + (size_t)kv * 256 * 1024 - (kb >= 16 ? 1024 : 0);
            transpose_item(w1, 64, 64, dst, 1024, kb * 64, nb * 32, (kb >= 16 ? 64 : 0) + nb * 32, scr, lane);
        } else { const int kv = (it - 128) >> 5, part = (it - 128) & 31;
            const GAS float* w1 = (const GAS float*)(a.in[kv ? 22 : 19] + (size_t)l * 2048 * 64) + (size_t)part * 64 * 64; const GAS float* pos = (const GAS float*)(a.in[kv ? 21 : 18] + (size_t)l * 2048) + part * 64;
            float acc = 0.f;
#pragma unroll 16
            for (int k = 0; k < 64; ++k) acc += pos[k] * w1[(size_t)k * 64 + lane];
            pt[(kv * 32 + part) * 64 + lane] = acc; }
    }
}

DI void lru_weights(const KA& a, int l, int gw, int NGW, int lane) {
    bf16* W = (bf16*)(a.ws + WS_LRUW); const float* wa = a.in[7] + (size_t)l * 4 * 4096; const float* wx = a.in[9] + (size_t)l * 4 * 4096;
    (void)NGW; { const int idx = gw * 64 + lane; if (idx < 32768) { const int i = idx & 63, j = (idx >> 6) & 63, mat = (idx >> 12) & 1, hbk = idx >> 13;
        W[idx] = (bf16)f2bf((mat ? wx : wa)[(size_t)hbk * 4096 + i * 64 + j]); } }
}
DI void phase0_rows(const KA& a, int l, int mode, int gw, int NGW, int lane) {
    const GAS float* xin = (const GAS float*)a.in[0]; GAS bf16* xb = (GAS bf16*)(a.ws + WS_XB);
    const GAS bf16* eo = (const GAS bf16*)(a.ws + WS_PROJ);
    GAS float* outp = (GAS float*)a.out;
    const GAS float* g = (const GAS float*)(mode ? a.in[2] : (a.in[3] + (size_t)l * 1024));
    f32x4 gv[4];
#pragma unroll
    for (int j = 0; j < 4; ++j) gv[j] = *(const GAS f32x4*)(g + 4 * (lane + 64 * j));
    for (int m0 = gw * 4; m0 < T; m0 += NGW * 4) {
        f32x4 v[4][4]; float ss[4];
#pragma unroll
        for (int rr = 0; rr < 4; ++rr)
#pragma unroll
            for (int j = 0; j < 4; ++j) { if (l == 0) v[rr][j] = *(const GAS f32x4*)(xin + (size_t)(m0 + rr) * 1024 + 4 * (lane + 64 * j));
                else { const u32x2 xw = *(const GAS u32x2*)(xb + (size_t)(m0 + rr) * 1024 + 4 * (lane + 64 * j)); v[rr][j][0] = lo_bf(xw.x); v[rr][j][1] = hi_bf(xw.x); v[rr][j][2] = lo_bf(xw.y); v[rr][j][3] = hi_bf(xw.y); } }
        if (l > 0) {
#pragma unroll
            for (int rr = 0; rr < 4; ++rr)
#pragma unroll
                for (int j = 0; j < 4; ++j) {
                    const u32x2 e0 = *(const GAS u32x2*)(eo + (size_t)(2 * (m0 + rr)) * 1024 + 4 * (lane + 64 * j));
                    const u32x2 e1 = *(const GAS u32x2*)(eo + (size_t)(2 * (m0 + rr) + 1) * 1024 + 4 * (lane + 64 * j));
                    v[rr][j][0] += lo_bf(e0.x) + lo_bf(e1.x); v[rr][j][1] += hi_bf(e0.x) + hi_bf(e1.x); v[rr][j][2] += lo_bf(e0.y) + lo_bf(e1.y); v[rr][j][3] += hi_bf(e0.y) + hi_bf(e1.y); } }
#pragma unroll
        for (int rr = 0; rr < 4; ++rr) { float t = 0.f;
#pragma unroll
            for (int j = 0; j < 4; ++j) t += (v[rr][j][0] * v[rr][j][0] + v[rr][j][1] * v[rr][j][1]) + (v[rr][j][2] * v[rr][j][2] + v[rr][j][3] * v[rr][j][3]);
            ss[rr] = t; }
#pragma unroll
        for (int rr = 0; rr < 4; ++rr) ss[rr] = wave_sum(ss[rr]);
        if (mode) {
#pragma unroll
            for (int rr = 0; rr < 4; ++rr) { const float r = 1.f / sqrtf(ss[rr] * (1.f / 1024.f) + 1e-6f); const size_t m = (size_t)(m0 + rr);
#pragma unroll
                for (int j = 0; j < 4; ++j) *(GAS f32x4*)(outp + m * 1024 + 4 * (lane + 64 * j)) = v[rr][j] * r * gv[j]; }
        } else {
            GAS unsigned char* hq = (GAS unsigned char*)(a.ws + WS_HQ); GAS float* hsc = (GAS float*)(a.ws + WS_HSC);
            float am[4];
#pragma unroll
            for (int rr = 0; rr < 4; ++rr) { const float r = 1.f / sqrtf(ss[rr] * (1.f / 1024.f) + 1e-6f); const size_t m = (size_t)(m0 + rr); float t = 0.f;
#pragma unroll
                for (int j = 0; j < 4; ++j) { if (l > 0) { u32x2 w; w.x = pk2(v[rr][j][0], v[rr][j][1]); w.y = pk2(v[rr][j][2], v[rr][j][3]); *(GAS u32x2*)(xb + m * 1024 + 4 * (lane + 64 * j)) = w; }
                    const f32x4 y = v[rr][j] * r * gv[j]; v[rr][j] = y;
                    t = fmaxf(t, fmaxf(fmaxf(fabsf(y[0]), fabsf(y[1])), fmaxf(fabsf(y[2]), fabsf(y[3])))); }
                am[rr] = t; }
#pragma unroll
            for (int rr = 0; rr < 4; ++rr) am[rr] = fmaxf(wave_max(am[rr]), 1e-20f);
#pragma unroll
            for (int rr = 0; rr < 4; ++rr) { const size_t m = (size_t)(m0 + rr); const float qs = 127.f / am[rr];
                if (lane == 0) hsc[m] = am[rr] * (1.f / 127.f);
#pragma unroll
                for (int j = 0; j < 4; ++j) { const f32x4 y = v[rr][j] * qs;
                    const unsigned q = ((unsigned)(int)__builtin_rintf(y[0]) & 255u) | (((unsigned)(int)__builtin_rintf(y[1]) & 255u) << 8) | (((unsigned)(int)__builtin_rintf(y[2]) & 255u) << 16) | (((unsigned)(int)__builtin_rintf(y[3]) & 255u) << 24);
                    *(GAS unsigned*)(hq + m * 1024 + 4 * (lane + 64 * j)) = q; } }
        }
    }
}

DI int crow(int i, int hh) { return (i & 3) + 8 * (i >> 2) + 4 * hh; }
DI unsigned cvtpk(float lo, float hi) { f32x2 v = {lo, hi}; bf16x2_t b = __builtin_convertvector(v, bf16x2_t); return __builtin_bit_cast(unsigned, b); }
template <int CTRL, int RMASK> DI float dppf(float oldv, float v) { return __builtin_bit_cast(float, __builtin_amdgcn_update_dpp(__builtin_bit_cast(int, oldv), __builtin_bit_cast(int, v), CTRL, RMASK, 0xf, false)); }
template <int CTRL, int RMASK> DI void scan_step(float& a, float& b) {
    const float ap = dppf<CTRL, RMASK>(1.f, a), bp = dppf<CTRL, RMASK>(0.f, b); b = a * bp + b; a = a * ap; }
DI void lru_unit(const KA& a, int l, const GAS bf16* proj, GAS bf16* ys, GAS float* sums, LAS unsigned char* lds, int task, int lane_in, int wave_in, bool final) {
    int lane = lane_in, wave = wave_in; asm volatile("" : "+v"(lane), "+s"(wave));
    const int chunk = task & 31, hbk = (task >> 5) & 3, b = task >> 7;
    const int ts = chunk * 256 + wave * 32; const size_t rowb = (size_t)b * SEQ;
    LAS unsigned char* wl = lds + wave * 16384;
    LAS float* ex = (LAS float*)(lds + LRUEX_OFF); LAS float* cst = (LAS float*)(lds + LRUCST_OFF); LAS float* car = (LAS float*)(lds + LRUCAR_OFF) + wave * 64;
    {
        const int c = hbk * 64 + lane;
        const GAS float* cw = (const GAS float*)(a.in[5] + (size_t)l * 4 * 256);
        const float cw0 = cw[c], cw1 = cw[256 + c], cw2 = cw[512 + c], cw3 = cw[768 + c]; const float cb = a.in[6][l * 256 + c];
        if (wave == 0) { cst[lane] = a.in[8][l * 256 + c]; cst[64 + lane] = a.in[10][l * 256 + c]; cst[128 + lane] = -8.f * softplusf_(-a.in[11][l * 256 + c]); }
        const GAS bf16* xp = proj + (rowb + ts) * PLD + C_AX + c;
        float x3 = (ts >= 3) ? bf2f(*(xp - 3 * PLD)) : 0.f, x2 = (ts >= 2) ? bf2f(*(xp - 2 * PLD)) : 0.f, x1 = (ts >= 1) ? bf2f(*(xp - PLD)) : 0.f;
#pragma unroll 8
        for (int n = 0; n < 32; ++n) { const float x0 = bf2f(xp[(size_t)n * PLD]); const float xc = cb + cw0 * x3 + cw1 * x2 + cw2 * x1 + cw3 * x0;
            *(LAS bf16*)(wl + n * 144 + lane * 2) = (bf16)f2bf(xc); *(LAS float*)(wl + 4608 + n * 272 + lane * 4) = xc; x3 = x2; x2 = x1; x1 = x0; }
    }
    const int n = lane & 31, hh = lane >> 5;
    f32x16 D[4];
    {
        const GAS bf16* wt = (const GAS bf16*)(a.ws + WS_LRUW) + (size_t)hbk * 8192;
        bf16x8 bfr[4];
        LDS_WAIT();
#pragma unroll
        for (int s4 = 0; s4 < 4; ++s4) bfr[s4] = *(const LAS bf16x8*)(wl + n * 144 + hh * 16 + s4 * 32);
#pragma unroll
        for (int m = 0; m < 4; ++m) {
#pragma unroll
            for (int s4 = 0; s4 < 4; ++s4) { const bf16x8 af = *(const GAS bf16x8*)(wt + (size_t)(m >> 1) * 4096 + (32 * (m & 1) + n) * 64 + 8 * hh + 16 * s4);
                if (s4 == 0) { f32x16 z;
#pragma unroll
                    for (int i = 0; i < 16; ++i) z[i] = 0.f;
                    D[m] = MFMA32(af, bfr[s4], z); } else D[m] = MFMA32(af, bfr[s4], D[m]); } }
    }
    __syncthreads();
    const bool t0 = (ts + n) == 0;
#pragma unroll
    for (int mm = 0; mm < 2; ++mm)
#pragma unroll
        for (int g4 = 0; g4 < 4; ++g4) { const int c0 = 32 * mm + 8 * g4 + 4 * hh;
            const f32x4 vba = *(const LAS f32x4*)(cst + c0), vbx = *(const LAS f32x4*)(cst + 64 + c0), vc8 = *(const LAS f32x4*)(cst + 128 + c0);
            const f32x4 vxc = *(const LAS f32x4*)(wl + 4608 + n * 272 + c0 * 4);
#pragma unroll
            for (int e = 0; e < 4; ++e) { const int i = 4 * g4 + e;
                const float r = sigmoidf_(D[mm][i] + vba[e]), ig = sigmoidf_(D[2 + mm][i] + vbx[e]);
                const float la = vc8[e] * r; const float av = __expf(la);
                const float mult = t0 ? 1.f : sqrtf(fmaxf(1.f - __expf(2.f * la), 0.f));
                float aa = av, bb = mult * ig * vxc[e];
                scan_step<0x111, 0xf>(aa, bb); scan_step<0x112, 0xf>(aa, bb); scan_step<0x114, 0xf>(aa, bb); scan_step<0x118, 0xf>(aa, bb); scan_step<0x142, 0xa>(aa, bb);
                D[mm][i] = aa; D[2 + mm][i] = bb; } }
    if (n == 31) {
#pragma unroll
        for (int mm = 0; mm < 2; ++mm)
#pragma unroll
            for (int i = 0; i < 16; ++i) { const int c = 32 * mm + crow(i, hh); ex[(wave * 64 + c) * 2] = D[mm][i]; ex[(wave * 64 + c) * 2 + 1] = D[2 + mm][i]; } }
    __syncthreads();
    if (!final) {
        if (wave == 0) { float hv = 0.f, av = 1.f;
#pragma unroll
            for (int w = 0; w < 8; ++w) { const float A_ = ex[(w * 64 + lane) * 2], H_ = ex[(w * 64 + lane) * 2 + 1]; hv = A_ * hv + H_; av *= A_; }
            GAS float* sp = sums + ((size_t)((b * 4 + hbk) * 32 + chunk) * 64 + lane) * 2; sp[0] = av; sp[1] = hv; }
    } else {
        {   float hv = 0.f;
            {   const GAS f32x2* sp = (const GAS f32x2*)(sums + ((size_t)((b * 4 + hbk) * 32) * 64 + lane) * 2);
                int cc = 0;
                for (; cc + 8 <= chunk; cc += 8) { f32x2 v[8];
#pragma unroll
                    for (int e = 0; e < 8; ++e) v[e] = sp[(size_t)(cc + e) * 64];
#pragma unroll
                    for (int e = 0; e < 8; ++e) hv = v[e][0] * hv + v[e][1]; }
                for (; cc < chunk; ++cc) { const f32x2 v = sp[(size_t)cc * 64]; hv = v[0] * hv + v[1]; } }
            for (int w = 0; w < wave; ++w) { const float A_ = ex[(w * 64 + lane) * 2], H_ = ex[(w * 64 + lane) * 2 + 1]; hv = A_ * hv + H_; }
            car[lane] = hv; }
        LDS_WAIT(); asm volatile("" ::: "memory");
        const GAS bf16* gp = proj + (rowb + ts + n) * PLD + C_AG + hbk * 64; GAS bf16* yp = ys + (rowb + ts + n) * 1024 + hbk * 64;
#pragma unroll
        for (int mm = 0; mm < 2; ++mm)
#pragma unroll
            for (int g4 = 0; g4 < 4; ++g4) { const int c0 = 32 * mm + 8 * g4 + 4 * hh; const f32x4 cv = *(const LAS f32x4*)(car + c0);
                const u32x2 gt2 = *(const GAS u32x2*)(gp + c0); float y[4];
#pragma unroll
                for (int e = 0; e < 4; ++e) { const int i = 4 * g4 + e; const float hv = D[2 + mm][i] + D[mm][i] * cv[e];
                    const float gt = (e == 0) ? lo_bf(gt2.x) : (e == 1) ? hi_bf(gt2.x) : (e == 2) ? lo_bf(gt2.y) : hi_bf(gt2.y); y[e] = hv * gelu_tanh(gt); }
                u32x2 yo; yo.x = cvtpk(y[0], y[1]); yo.y = cvtpk(y[2], y[3]); *(GAS u32x2*)(yp + c0) = yo; }
    }
    __syncthreads();
}

constexpr int DK_STR = 144, DV_STR = 192, DBUF_BYTES = 64 * DK_STR + 64 * DV_STR;
DI bf16x8 pack_half(const f32x16& x, int s2) { u32x4 p;
    if (s2 == 0) { p.x = cvtpk(x[0], x[1]); p.y = cvtpk(x[2], x[3]); p.z = cvtpk(x[4], x[5]); p.w = cvtpk(x[6], x[7]); }
    else { p.x = cvtpk(x[8], x[9]); p.y = cvtpk(x[10], x[11]); p.z = cvtpk(x[12], x[13]); p.w = cvtpk(x[14], x[15]); }
    return __builtin_bit_cast(bf16x8, p); }
DI s16x4 vtr(const LAS unsigned char* p) { return __builtin_bit_cast(s16x4, __builtin_amdgcn_ds_read_tr16_b64_v4i16((LAS v4i16_t*)p)); }
DI float max16(const f32x16& x) { float a = fmaxf(fmaxf(x[0], x[1]), fmaxf(x[2], x[3])), b = fmaxf(fmaxf(x[4], x[5]), fmaxf(x[6], x[7])), c = fmaxf(fmaxf(x[8], x[9]), fmaxf(x[10], x[11])), d = fmaxf(fmaxf(x[12], x[13]), fmaxf(x[14], x[15])); return fmaxf(fmaxf(a, b), fmaxf(c, d)); }
DI void diff_unit(const GAS bf16* proj, GAS bf16* ys, LAS unsigned char* lds, const LAS float* bias2, const GAS float* subg, const LAS float* lamp, int b, int h, int qb, int wave_in) {
    int wave = wave_in; asm volatile("" : "+s"(wave)); const int lane = my_lane(); const int tid = wave * 64 + lane;
    const int q0 = qb * 256 + wave * 32; const int ql = lane & 31, hh = lane >> 5; const int q = q0 + ql;
    const size_t rowb = (size_t)b * SEQ;
    const float SC = 0.17677669529663687f * 1.4426950408889634f;
    bf16x8 qf[2][2];
    { const GAS bf16* qp = proj + (rowb + q) * PLD + C_CQ + h * 64 + hh * 8;
#pragma unroll
      for (int m = 0; m < 2; ++m)
#pragma unroll
        for (int s = 0; s < 2; ++s) { const u32x4 w = *(const GAS u32x4*)(qp + m * 32 + s * 16); u32x4 o;
            o.x = cvtpk(lo_bf(w.x) * SC, hi_bf(w.x) * SC); o.y = cvtpk(lo_bf(w.y) * SC, hi_bf(w.y) * SC); o.z = cvtpk(lo_bf(w.z) * SC, hi_bf(w.z) * SC); o.w = cvtpk(lo_bf(w.w) * SC, hi_bf(w.w) * SC);
            qf[m][s] = __builtin_bit_cast(bf16x8, o); } }
    f32x16 O[2][2], negm[2];
#pragma unroll
    for (int i = 0; i < 16; ++i) { O[0][0][i] = 0.f; O[0][1][i] = 0.f; O[1][0][i] = 0.f; O[1][1][i] = 0.f; negm[0][i] = 120.f; negm[1][i] = 120.f; }
    float lsum[2] = {0.f, 0.f};
    const int nsteps = 4 * qb + 4, mysteps = 4 * qb + (wave >> 1) + 1;
    const int skey = tid >> 3, sch = tid & 7;
    const GAS unsigned char* kgb = (const GAS unsigned char*)(proj + rowb * PLD + C_CK + h * 64);
    const GAS unsigned char* vgb = (const GAS unsigned char*)(proj + rowb * PLD + C_CV + h * 64);
    const unsigned soff = (unsigned)(skey * PLD + sch * 8) * 2u;
    u32x4 kr = *(const GAS u32x4*)(kgb + soff), vr = *(const GAS u32x4*)(vgb + soff);
    *(LAS u32x4*)(lds + skey * DK_STR + sch * 16) = kr; *(LAS u32x4*)(lds + 64 * DK_STR + skey * DV_STR + sch * 16) = vr;
    __syncthreads();
    const int i16 = lane & 15, blk = (lane >> 4) & 1;
    const int kboff = ql * DK_STR + hh * 16;
    const int vboff = 64 * DK_STR + (4 * hh + (i16 >> 2)) * DV_STR + (16 * blk + 4 * (i16 & 3)) * 2;
#pragma unroll 1
    for (int kt = 0; kt < nsteps; ++kt) {
        const LAS unsigned char* cur = lds + (kt & 1) * DBUF_BYTES; LAS unsigned char* nxt = lds + ((kt + 1) & 1) * DBUF_BYTES;
        if (kt + 1 < nsteps) { const unsigned so = soff + (unsigned)(kt + 1) * (64u * PLD * 2u); kr = *(const GAS u32x4*)(kgb + so); vr = *(const GAS u32x4*)(vgb + so); }
        if (kt < mysteps) {
            const int kbase = kt * 64;
            const bool near = (q0 - (kbase + 63) < 113);
#pragma unroll
            for (int m = 0; m < 2; ++m) {
                bf16x8 pk[2][2];
                f32x16 S[2]; float ts = 0.f;
                {   bf16x8 kf[2][2];
#pragma unroll
                    for (int t = 0; t < 2; ++t)
#pragma unroll
                        for (int s = 0; s < 2; ++s) kf[t][s] = *(const LAS bf16x8*)(cur + kboff + t * 32 * DK_STR + m * 64 + s * 32);
#pragma unroll
                    for (int t = 0; t < 2; ++t) { S[t] = MFMA32(kf[t][0], qf[m][0], negm[m]); S[t] = MFMA32(kf[t][1], qf[m][1], S[t]); } }
                if (near) {
#pragma unroll
                    for (int t = 0; t < 2; ++t)
#pragma unroll
                        for (int g = 0; g < 2; ++g) { float tb[8];
#pragma unroll
                            for (int j = 0; j < 8; ++j) { const int dist = q - (kbase + 32 * t + crow(8 * g + j, hh)); const int di = dist < 0 ? 0 : (dist < 128 ? dist : 128); tb[j] = bias2[di * 12 + 4 + h]; }
#pragma unroll
                            for (int j = 0; j < 8; ++j) { const int dist = q - (kbase + 32 * t + crow(8 * g + j, hh)); S[t][8 * g + j] += dist >= 0 ? tb[j] : -1e30f; }
                            __builtin_amdgcn_sched_barrier(0); } }
#pragma unroll
                for (int t = 0; t < 2; ++t)
#pragma unroll
                    for (int i = 0; i < 16; ++i) { const float p = __builtin_amdgcn_exp2f(S[t][i]); S[t][i] = p; ts += p; }
                if (__builtin_amdgcn_ballot_w64(!(ts < 1.0e30f)) != 0ull) {
                {   bf16x8 kf[2][2];
#pragma unroll
                        for (int t = 0; t < 2; ++t)
#pragma unroll
                            for (int s = 0; s < 2; ++s) kf[t][s] = *(const LAS bf16x8*)(cur + kboff + t * 32 * DK_STR + m * 64 + s * 32);
#pragma unroll
                        for (int t = 0; t < 2; ++t) { S[t] = MFMA32(kf[t][0], qf[m][0], negm[m]); S[t] = MFMA32(kf[t][1], qf[m][1], S[t]); } }
                    if (near) {
#pragma unroll
                        for (int t = 0; t < 2; ++t)
#pragma unroll
                            for (int g = 0; g < 2; ++g) { float tb[8];
#pragma unroll
                                for (int j = 0; j < 8; ++j) { const int dist = q - (kbase + 32 * t + crow(8 * g + j, hh)); const int di = dist < 0 ? 0 : (dist < 128 ? dist : 128); tb[j] = bias2[di * 12 + 4 + h]; }
#pragma unroll
                                for (int j = 0; j < 8; ++j) { const int dist = q - (kbase + 32 * t + crow(8 * g + j, hh)); S[t][8 * g + j] += dist >= 0 ? tb[j] : -1e30f; }
                                __builtin_amdgcn_sched_barrier(0); } }
                    float tm = fmaxf(max16(S[0]), max16(S[1])); tm = fmaxf(tm, xshfl<32>(tm));
                    const float sh = fmaxf(tm, 0.f); const float al = __builtin_amdgcn_exp2f(-sh);
                    lsum[m] *= al; ts = 0.f;
#pragma unroll
                    for (int i = 0; i < 16; ++i) { O[m][0][i] *= al; O[m][1][i] *= al; negm[m][i] -= sh; }
#pragma unroll
                    for (int t = 0; t < 2; ++t)
#pragma unroll
                        for (int i = 0; i < 16; ++i) { const float p = __builtin_amdgcn_exp2f(S[t][i] - sh); S[t][i] = p; ts += p; }
                }
                lsum[m] += ts;
#pragma unroll
                for (int t = 0; t < 2; ++t) { pk[t][0] = pack_half(S[t], 0); pk[t][1] = pack_half(S[t], 1); }
#pragma unroll
                for (int t = 0; t < 2; ++t)
#pragma unroll
                    for (int s2 = 0; s2 < 2; ++s2)
#pragma unroll
                        for (int db = 0; db < 2; ++db) {
                            const s16x4 lo = vtr(cur + vboff + (32 * t + 16 * s2) * DV_STR + db * 64), hi = vtr(cur + vboff + (32 * t + 16 * s2 + 8) * DV_STR + db * 64);
                            const bf16x8 vf = __builtin_shufflevector(lo, hi, 0, 1, 2, 3, 4, 5, 6, 7);
                            O[m][db] = MFMA32(vf, pk[t][s2], O[m][db]); }
                ;
            }
        }
        if (kt + 1 < nsteps) { *(LAS u32x4*)(nxt + skey * DK_STR + sch * 16) = kr; *(LAS u32x4*)(nxt + 64 * DK_STR + skey * DV_STR + sch * 16) = vr; }
        __syncthreads();
    }
    const float l0 = lsum[0] + xshfl<32>(lsum[0]), l1 = lsum[1] + xshfl<32>(lsum[1]);
    const float lam = lamp[0], lam_init = lamp[1];
    const float i0 = 1.f / fmaxf(l0, 1e-30f), i1 = lam / fmaxf(l1, 1e-30f);
    float ss = 0.f;
#pragma unroll
    for (int db = 0; db < 2; ++db)
#pragma unroll
        for (int i = 0; i < 16; ++i) { const float at = O[0][db][i] * i0 - O[1][db][i] * i1; O[0][db][i] = at; ss += at * at; }
    ss += xshfl<32>(ss);
    const float r = (1.f - lam_init) / sqrtf(ss * (1.f / 64.f) + 1e-5f);
    GAS bf16* op = ys + (rowb + q) * 1024 + 512 + h * 64;
#pragma unroll
    for (int db = 0; db < 2; ++db)
#pragma unroll
        for (int gq = 0; gq < 4; ++gq) { const int d0 = 32 * db + 8 * gq + 4 * hh; const f32x4 sg = *(const GAS f32x4*)(subg + d0);
            u32x2 w; w.x = cvtpk(O[0][db][4 * gq + 0] * r * sg[0], O[0][db][4 * gq + 1] * r * sg[1]); w.y = cvtpk(O[0][db][4 * gq + 2] * r * sg[2], O[0][db][4 * gq + 3] * r * sg[3]);
            *(GAS u32x2*)(op + d0) = w; }
}

struct SchedCmp { const char* proj; const char* wc; int G, c;
    DI bool next(int i, Unit& u) const { const int L = i * G + c; if (L >= 16) return false; const int kv = L >> 3, rt = L & 7;
        u.pm = rt; u.pn = 0; u.aux = kv; u.pad = 0; u.a = proj + ((size_t)rt * 256 * 16 * PLD + (kv ? C_VC : C_KC)) * 2; u.b = wc + (size_t)kv * 256 * 1024 * 2; return true; } };
struct EpiCmp { static constexpr bool CARRY = false; float* ab;
    DI void operator()(const f32x4 (&acc)[2][2][4][2], const Unit& u, int wr, int wc, int fr, int fq) const {
        const int row0 = u.pm * 256 + wr * 64 + fr; const int col = wc * 32 + 8 * fq;
#pragma unroll
        for (int ai = 0; ai < 2; ++ai)
#pragma unroll
            for (int m = 0; m < 4; ++m) { float* rp = ab + ((size_t)u.aux * 2048 + row0 + ai * 128 + m * 16) * 128 + col; *(f32x4*)rp = acc[ai][0][m][0]; *(f32x4*)(rp + 4) = acc[ai][0][m][1]; }
    }
};
DI void cmp_finish(const KA& a, int l, const float* ab, bf16* kcb, int task, int lane) {
    const int kv = task / (BATCH * NCMP), r = task % (BATCH * NCMP), b = r / NCMP, c = r % NCMP;
    const float* w2 = a.in[kv ? 23 : 20] + (size_t)l * 4096; const float* pt = ab + 2 * 2048 * 128;
    const size_t g = (size_t)kv * 2048 + b * 512 + c;
    float ptv = 0.f;
#pragma unroll 8
    for (int part = 0; part < 32; ++part) ptv += pt[(kv * 32 + part) * 64 + lane];
    const float h1 = ab[g * 128 + lane] + ab[(g + 1) * 128 + 64 + lane] + ptv;
    const float gl = gelu_tanh(h1); float o = 0.f;
#pragma unroll
    for (int j = 0; j < 64; ++j) o += rl(gl, j) * w2[j * 64 + lane];
    kcb[((size_t)(kv * BATCH + b) * 512 + c) * 64 + lane] = (bf16)f2bf(o);
    if (c == NCMP - 1) kcb[((size_t)(kv * BATCH + b) * 512 + NCMP) * 64 + lane] = 0;
}

DI void cmp_block(const KA& a, int l, const GAS bf16* proj, const GAS bf16* wcT, float* ab, bf16* kcb, int bid, int wave, int lane) {
    const int kv = bid >> 7, g0 = (bid & 127) * 16, r = lane & 15, q = lane >> 4, sh = wave >> 2;
    const int grow = g0 + r + sh; const bool st_ok = !(sh != 0 && (grow & 511) == 0);
    const int gld = grow > 2047 ? 2047 : grow;
    const GAS bf16* apn = proj + (size_t)gld * 16 * PLD + (kv ? C_VC : C_KC) + 8 * q;
    const GAS bf16* bpn = wcT + ((size_t)kv * 256 + wave * 16 + r) * 1024 + 8 * q;
    f32x4 acc = {0.f, 0.f, 0.f, 0.f};
#pragma unroll 8
    for (int s = 0; s < 32; ++s) {
        const bf16x8 av = *(const GAS bf16x8*)(apn + (size_t)(s >> 1) * PLD + 32 * (s & 1));
        const bf16x8 bv = *(const GAS bf16x8*)(bpn + 32 * s);
        acc = __builtin_amdgcn_mfma_f32_16x16x32_bf16(bv, av, acc, 0, 0, 0);
    }
    if (st_ok) *(GAS f32x4*)((GAS float*)ab + ((size_t)kv * 2048 + grow) * 128 + wave * 16 + 4 * q) = acc;
    VM_WAIT(); __syncthreads();
#pragma unroll 1
    for (int i = 0; i < 2; ++i) { const int g = g0 + 2 * wave + i, c = g & 511, b = g >> 9;
        if (c < NCMP) cmp_finish(a, l, ab, kcb, kv * (BATCH * NCMP) + b * NCMP + c, lane); }
}

DI void st_load(const GAS unsigned char* kb, const GAS unsigned char* vb, unsigned off, u32x4& kr, u32x4& vr) { kr = *(const GAS u32x4*)(kb + off); vr = *(const GAS u32x4*)(vb + off); }
DI void st_write(LAS unsigned char* buf, int skey, int sch, const u32x4& kr, const u32x4& vr) { *(LAS u32x4*)(buf + skey * DK_STR + sch * 16) = kr; *(LAS u32x4*)(buf + 64 * DK_STR + skey * DV_STR + sch * 16) = vr; }
DI void qk64(const LAS unsigned char* cur, int kboff, const bf16x8 (&qf)[4], const f32x16& cinit, f32x16 (&S)[2]) {
#pragma unroll
    for (int t = 0; t < 2; ++t) { S[t] = cinit;
#pragma unroll
        for (int s = 0; s < 4; ++s) { const bf16x8 kf = *(const LAS bf16x8*)(cur + kboff + t * 32 * DK_STR + s * 32); S[t] = MFMA32(kf, qf[s], S[t]); } }
}
DI void qk32z(const LAS unsigned char* kt32, const bf16x8 (&qf)[4], f32x16& S) {
#pragma unroll
    for (int s = 0; s < 4; ++s) { const bf16x8 kf = *(const LAS bf16x8*)(kt32 + s * 32);
        if (s == 0) { f32x16 z;
#pragma unroll
            for (int i = 0; i < 16; ++i) z[i] = 0.f;
            S = MFMA32(kf, qf[s], z); } else S = MFMA32(kf, qf[s], S); }
}
DI void pv32(const LAS unsigned char* vt32, const bf16x8 (&pk)[2], f32x16 (&O)[2]) {
#pragma unroll
    for (int s2 = 0; s2 < 2; ++s2)
#pragma unroll
        for (int db = 0; db < 2; ++db) {
            const s16x4 lo = vtr(vt32 + (16 * s2) * DV_STR + db * 64), hi = vtr(vt32 + (16 * s2 + 8) * DV_STR + db * 64);
            const bf16x8 vf = __builtin_shufflevector(lo, hi, 0, 1, 2, 3, 4, 5, 6, 7);
            O[db] = MFMA32(vf, pk[s2], O[db]); }
}
DI void mask_bias_cmp32(f32x16& S, int tcol_in, int cbase, int hh, const LAS float* b2h, float msub) {
    int tcol = tcol_in; asm volatile("" : "+v"(tcol));
#pragma unroll
    for (int g = 0; g < 2; ++g) {
        float bv[8];
#pragma unroll
        for (int j = 0; j < 8; ++j) { const int i = 8 * g + j; const int c = cbase + crow(i, hh); const int dist = tcol - 31 - 16 * c; const int di = dist < 0 ? 0 : (dist < 128 ? dist : 128); bv[j] = b2h[di * 12]; }
#pragma unroll
        for (int j = 0; j < 8; ++j) { const int i = 8 * g + j; const int c = cbase + crow(i, hh); const int dist = tcol - 31 - 16 * c; const bool ok = dist >= 0 && c < NCMP;
            const float sb = S[i] + (bv[j] - msub); S[i] = ok ? sb : -1e30f; }
        __builtin_amdgcn_sched_barrier(0); }
}
DI void pv64(const LAS unsigned char* cur, int vboff, const bf16x8 (&pk)[2][2], f32x16 (&O)[2]) {
#pragma unroll
    for (int t = 0; t < 2; ++t)
#pragma unroll
        for (int s2 = 0; s2 < 2; ++s2)
#pragma unroll
            for (int db = 0; db < 2; ++db) {
                const s16x4 lo = vtr(cur + vboff + (32 * t + 16 * s2) * DV_STR + db * 64), hi = vtr(cur + vboff + (32 * t + 16 * s2 + 8) * DV_STR + db * 64);
                const bf16x8 vf = __builtin_shufflevector(lo, hi, 0, 1, 2, 3, 4, 5, 6, 7);
                O[db] = MFMA32(vf, pk[t][s2], O[db]); }
}
DI void softmax_step(f32x16 (&S)[2], f32x16 (&O)[2], f32x16& negm, float& lsum, bf16x8 (&pk)[2][2]) {
    float tm = fmaxf(max16(S[0]), max16(S[1]));
    if (__builtin_amdgcn_ballot_w64(tm > 8.f) != 0ull) {
        tm = fmaxf(tm, xshfl<32>(tm)); const float sh = fmaxf(tm, 0.f); const float al = __builtin_amdgcn_exp2f(-sh);
        lsum *= al;
#pragma unroll
        for (int i = 0; i < 16; ++i) { O[0][i] *= al; O[1][i] *= al; negm[i] -= sh; S[0][i] -= sh; S[1][i] -= sh; } }
#pragma unroll
    for (int t = 0; t < 2; ++t) {
#pragma unroll
        for (int i = 0; i < 16; ++i) { const float p = __builtin_amdgcn_exp2f(S[t][i]); S[t][i] = p; lsum += p; }
        pk[t][0] = pack_half(S[t], 0); pk[t][1] = pack_half(S[t], 1); }
}
DI void mask_bias(f32x16 (&S)[2], int tcol_in, int kbase, int hh, int W, bool colsel, const LAS float* b2h) {
    int tcol = tcol_in; asm volatile("" : "+v"(tcol));
#pragma unroll
    for (int t = 0; t < 2; ++t)
#pragma unroll
        for (int g = 0; g < 2; ++g) {
            float bv[8];
#pragma unroll
            for (int j = 0; j < 8; ++j) { const int i = 8 * g + j; const int dist = tcol - (kbase + 32 * t + crow(i, hh)); const int di = dist < 0 ? 0 : (dist < 128 ? dist : 128); bv[j] = b2h[di * 12]; }
#pragma unroll
            for (int j = 0; j < 8; ++j) { const int i = 8 * g + j; const int dist = tcol - (kbase + 32 * t + crow(i, hh)); const bool ok = colsel && dist >= 0 && dist < W;
                const float sb = S[t][i] + bv[j]; S[t][i] = ok ? sb : -1e30f; }
            __builtin_amdgcn_sched_barrier(0); }
}
DI void sel_tile(const LAS unsigned char* cur, int kboff, int vboff, const bf16x8 (&qf)[4], f32x16 (&Os)[2], f32x16& negm, float& lsel, bool near, bool bit, int t, int kbase, int hh, int W, const LAS float* b2h) {
    f32x16 S[2]; qk64(cur, kboff, qf, negm, S);
    if (near) mask_bias(S, t, kbase, hh, W, bit, b2h);
    float ts = 0.f;
#pragma unroll
    for (int tt = 0; tt < 2; ++tt)
#pragma unroll
        for (int i = 0; i < 16; ++i) { const float p = __builtin_amdgcn_exp2f(S[tt][i]); S[tt][i] = p; ts += p; }
    ts = bit ? ts : 0.f;
    if (__builtin_amdgcn_ballot_w64(!(ts < 1.0e30f)) != 0ull) {
        qk64(cur, kboff, qf, negm, S);
        if (near) mask_bias(S, t, kbase, hh, W, bit, b2h);
        float tm = fmaxf(max16(S[0]), max16(S[1])); tm = bit ? tm : -1e30f; tm = fmaxf(tm, xshfl<32>(tm));
        const float sh = fmaxf(tm, 0.f); const float al = __builtin_amdgcn_exp2f(-sh);
        lsel *= al; ts = 0.f;
#pragma unroll
        for (int i = 0; i < 16; ++i) { Os[0][i] *= al; Os[1][i] *= al; negm[i] -= sh; }
#pragma unroll
        for (int tt = 0; tt < 2; ++tt)
#pragma unroll
            for (int i = 0; i < 16; ++i) { const float p = __builtin_amdgcn_exp2f(S[tt][i] - sh); S[tt][i] = p; ts += p; }
        ts = bit ? ts : 0.f;
    }
    lsel += ts;
    const unsigned km = bit ? 0xFFFFFFFFu : 0u; bf16x8 pk[2][2];
#pragma unroll
    for (int tt = 0; tt < 2; ++tt)
#pragma unroll
        for (int hf = 0; hf < 2; ++hf) { u32x4 w = __builtin_bit_cast(u32x4, pack_half(S[tt], hf)); w.x &= km; w.y &= km; w.z &= km; w.w &= km; pk[tt][hf] = __builtin_bit_cast(bf16x8, w); }
    pv64(cur, vboff, pk, Os);
}
DI void nsa_unit(const GAS bf16* proj, GAS bf16* ys, const GAS bf16* kcb, LAS unsigned char* lds, const LAS float* bias2, int b, int u, int tid_in, int lane_in, int wave_in) {
    (void)tid_in; (void)lane_in; int wave = wave_in; asm volatile("" : "+s"(wave)); const int lane = my_lane(); const int tid = wave * 64 + lane;
    const int t0 = u * 64; const int col = lane & 31, hh = lane >> 5, tl = col >> 2, head = col & 3;
    const int t = t0 + wave * 8 + tl; const int tw0 = t0 + wave * 8;
    const size_t rowb = (size_t)b * SEQ;
    const LAS float* b2h = bias2 + 8 + head;
    bf16x8 qf[4];
    { const float SC = 0.125f * 1.4426950408889634f; const GAS bf16* qp = proj + (rowb + t) * PLD + C_DQ + head * 64 + hh * 8;
#pragma unroll
      for (int s = 0; s < 4; ++s) { const u32x4 w = *(const GAS u32x4*)(qp + s * 16); u32x4 o;
          o.x = cvtpk(lo_bf(w.x) * SC, hi_bf(w.x) * SC); o.y = cvtpk(lo_bf(w.y) * SC, hi_bf(w.y) * SC); o.z = cvtpk(lo_bf(w.z) * SC, hi_bf(w.z) * SC); o.w = cvtpk(lo_bf(w.w) * SC, hi_bf(w.w) * SC);
          qf[s] = __builtin_bit_cast(bf16x8, o); } }
    const int skey = tid >> 3, sch = tid & 7;
    const int i16 = lane & 15, blk = (lane >> 4) & 1;
    const int kboff = col * DK_STR + hh * 16;
    const int vboff = 64 * DK_STR + (4 * hh + (i16 >> 2)) * DV_STR + (16 * blk + 4 * (i16 & 3)) * 2;
    u32x4 kr, vr;
    const int ncvm = (4 * u + 3) < NCMP ? (4 * u + 3) : NCMP;
    const int nsc = (ncvm + 63) >> 6;
    const GAS unsigned char* kcp = (const GAS unsigned char*)(kcb + (size_t)(0 * BATCH + b) * 512 * 64);
    const GAS unsigned char* vcp = (const GAS unsigned char*)(kcb + (size_t)(1 * BATCH + b) * 512 * 64);
    const unsigned soffc = (unsigned)(skey * 64 + sch * 8) * 2u;
    float m1 = -120.f, l1 = 0.f;
    st_load(kcp, vcp, soffc, kr, vr); st_write(lds, skey, sch, kr, vr); __syncthreads();
#pragma unroll 1
    for (int kt = 0; kt < nsc; ++kt) {
        const LAS unsigned char* cur = lds + (kt & 1) * DBUF_BYTES; LAS unsigned char* nxt = lds + ((kt + 1) & 1) * DBUF_BYTES;
        if (kt + 1 < nsc) st_load(kcp, vcp, soffc + (unsigned)(kt + 1) * 8192u, kr, vr);
#pragma unroll
        for (int tt = 0; tt < 2; ++tt) { f32x16 S; qk32z(cur + kboff + tt * 32 * DK_STR, qf, S); mask_bias_cmp32(S, t, kt * 64 + tt * 32, hh, b2h, 0.f);
          const float tm = max16(S); const float mn = fmaxf(m1, tm); float acc = 0.f;
#pragma unroll
          for (int i = 0; i < 16; ++i) acc += __builtin_amdgcn_exp2f(S[i] - mn);
          l1 = l1 * __builtin_amdgcn_exp2f(m1 - mn) + acc; m1 = mn; }
        if (kt + 1 < nsc) st_write(nxt, skey, sch, kr, vr);
        __syncthreads();
    }
    float mf, inv;
    { const float mo = xshfl<32>(m1), lo = xshfl<32>(l1); mf = fmaxf(m1, mo); const float lf = l1 * __builtin_amdgcn_exp2f(m1 - mf) + lo * __builtin_amdgcn_exp2f(mo - mf); inv = lf > 0.f ? 1.f / lf : 0.f; }
    f32x16 Oc[2], imp[4];
#pragma unroll
    for (int i = 0; i < 16; ++i) { Oc[0][i] = 0.f; Oc[1][i] = 0.f; imp[0][i] = 0.f; imp[1][i] = 0.f; imp[2][i] = 0.f; imp[3][i] = 0.f; }
    {   st_load(kcp, vcp, soffc, kr, vr); st_write(lds, skey, sch, kr, vr); __syncthreads();
#pragma unroll 1
        for (int kt = 0; kt < nsc; ++kt) {
            const LAS unsigned char* cur = lds + (kt & 1) * DBUF_BYTES; LAS unsigned char* nxt = lds + ((kt + 1) & 1) * DBUF_BYTES;
            if (kt + 1 < nsc) st_load(kcp, vcp, soffc + (unsigned)(kt + 1) * 8192u, kr, vr);
#pragma unroll
            for (int tt = 0; tt < 2; ++tt) {
                f32x16 S; qk32z(cur + kboff + tt * 32 * DK_STR, qf, S); mask_bias_cmp32(S, t, kt * 64 + tt * 32, hh, b2h, mf);
#pragma unroll
                for (int i = 0; i < 16; ++i) S[i] = __builtin_amdgcn_exp2f(S[i]) * inv;
                bf16x8 pk[2]; pk[0] = pack_half(S, 0); pk[1] = pack_half(S, 1);
                pv32(cur + vboff + tt * 32 * DV_STR, pk, Oc);
                const int Tq = (2 * kt + tt) & 3, MB = (2 * kt + tt) >> 2;
#pragma unroll
                for (int s2 = 0; s2 < 2; ++s2) { u32x4 aw; unsigned e[8];
#pragma unroll
                    for (int jj = 0; jj < 8; ++jj) { const int kk = 16 * s2 + 8 * (jj >> 2) + 4 * hh + (jj & 3); const int delta = 32 * Tq + kk - 4 * col;
                        e[jj] = (delta == -1 || delta == 3) ? 0x3F80u : ((unsigned)delta <= 2u ? 0x4000u : 0u); }
                    aw.x = e[0] | (e[1] << 16); aw.y = e[2] | (e[3] << 16); aw.z = e[4] | (e[5] << 16); aw.w = e[6] | (e[7] << 16);
                    const bf16x8 af = __builtin_bit_cast(bf16x8, aw);
                    if (MB == 0) imp[0] = MFMA32(af, pk[s2], imp[0]); else if (MB == 1) imp[1] = MFMA32(af, pk[s2], imp[1]); else if (MB == 2) imp[2] = MFMA32(af, pk[s2], imp[2]); else imp[3] = MFMA32(af, pk[s2], imp[3]); }
                if (Tq == 3 && MB < 3) { u32x4 aw; aw.x = 0u; aw.y = 0u; aw.z = 0u; aw.w = (lane == 32) ? 0x3F800000u : 0u;
                    const bf16x8 af = __builtin_bit_cast(bf16x8, aw);
                    if (MB == 0) imp[1] = MFMA32(af, pk[1], imp[1]); else if (MB == 1) imp[2] = MFMA32(af, pk[1], imp[2]); else imp[3] = MFMA32(af, pk[1], imp[3]); }
            }
            if (kt + 1 < nsc) st_write(nxt, skey, sch, kr, vr);
            __syncthreads();
        }
    }
    unsigned ocp[2][8];
#pragma unroll
    for (int db = 0; db < 2; ++db)
#pragma unroll
        for (int i = 0; i < 8; ++i) ocp[db][i] = cvtpk(Oc[db][2 * i], Oc[db][2 * i + 1]);
    unsigned sm0 = 0u, sm1 = 0u, sm2 = 0u, sm3 = 0u;
    {   const int cur_t = t >> 6; unsigned key[16];
#pragma unroll
        for (int i = 0; i < 16; ++i) {
            float v0 = imp[0][i], v1 = imp[1][i], v2 = imp[2][i], v3 = imp[3][i];
            v0 += xshfl<1>(v0); v0 += xshfl<2>(v0); v1 += xshfl<1>(v1); v1 += xshfl<2>(v1); v2 += xshfl<1>(v2); v2 += xshfl<2>(v2); v3 += xshfl<1>(v3); v3 += xshfl<2>(v3);
            const float val = head == 0 ? v0 : (head == 1 ? v1 : (head == 2 ? v2 : v3));
            const int j = 32 * head + crow(i, hh);
            const bool forced = (j == 0) || (j == cur_t) || (j == cur_t - 1);
            unsigned fx = (unsigned)(fminf(fmaxf(val, 0.f), 31.f) * 1048576.f) + 1u;
            fx = forced ? 0x1FFFFFFu : (j <= cur_t ? fx : 0u);
            key[i] = (fx << 7) | (unsigned)(127 - j); }
#pragma unroll 1
        for (int r = 0; r < 16; ++r) {
            unsigned w = key[0];
#pragma unroll
            for (int i = 1; i < 16; ++i) w = w > key[i] ? w : key[i];
            { unsigned o = (unsigned)xshfl_i<1>((int)w); w = w > o ? w : o; o = (unsigned)xshfl_i<2>((int)w); w = w > o ? w : o; o = (unsigned)xshfl_i<32>((int)w); w = w > o ? w : o; }
            if ((w >> 7) != 0u) { const int j = 127 - (int)(w & 127u); const unsigned bit = 1u << (j & 31); const int jb = j >> 5;
                sm0 |= (jb == 0) ? bit : 0u; sm1 |= (jb == 1) ? bit : 0u; sm2 |= (jb == 2) ? bit : 0u; sm3 |= (jb == 3) ? bit : 0u; }
#pragma unroll
            for (int i = 0; i < 16; ++i) key[i] = (key[i] == w) ? 0u : key[i];
        }
    }
    f32x16 Ow[2]; float lw = 0.f;
#pragma unroll
    for (int i = 0; i < 16; ++i) { Ow[0][i] = 0.f; Ow[1][i] = 0.f; }
    {   f32x16 negm;
#pragma unroll
        for (int i = 0; i < 16; ++i) negm[i] = 120.f;
        const GAS unsigned char* kwp = (const GAS unsigned char*)(proj + rowb * PLD + C_KW); const GAS unsigned char* vwp = (const GAS unsigned char*)(proj + rowb * PLD + C_VW);
        const unsigned soffp = (unsigned)(skey * PLD + sch * 8) * 2u;
        const int s0 = (u < 8) ? 8 - u : 0;
        st_load(kwp, vwp, soffp + (unsigned)(u - 8 + s0) * (64u * PLD * 2u), kr, vr); st_write(lds, skey, sch, kr, vr); __syncthreads();
#pragma unroll 1
        for (int s = s0; s < 9; ++s) {
            const int par = (s - s0) & 1; const LAS unsigned char* cur = lds + par * DBUF_BYTES; LAS unsigned char* nxt = lds + (par ^ 1) * DBUF_BYTES;
            if (s + 1 < 9) st_load(kwp, vwp, soffp + (unsigned)(u - 8 + s + 1) * (64u * PLD * 2u), kr, vr);
            sel_tile(cur, kboff, vboff, qf, Ow, negm, lw, s == 0 || s >= 6, true, t, (u - 8 + s) * 64, hh, 512, b2h);
            if (s + 1 < 9) st_write(nxt, skey, sch, kr, vr);
            __syncthreads();
        }
    }
    unsigned owp[2][8];
#pragma unroll
    for (int db = 0; db < 2; ++db)
#pragma unroll
        for (int i = 0; i < 8; ++i) owp[db][i] = cvtpk(Ow[db][2 * i], Ow[db][2 * i + 1]);
    f32x16 Os[2]; float lsel = 0.f;
#pragma unroll
    for (int i = 0; i < 16; ++i) { Os[0][i] = 0.f; Os[1][i] = 0.f; }
    {   f32x16 negm;
#pragma unroll
        for (int i = 0; i < 16; ++i) negm[i] = 120.f;
        const GAS unsigned char* ksp = (const GAS unsigned char*)(proj + rowb * PLD + C_KS); const GAS unsigned char* vsp = (const GAS unsigned char*)(proj + rowb * PLD + C_VS);
        const unsigned soffp = (unsigned)(skey * PLD + sch * 8) * 2u;
        u32x4 kA, vA, kB, vB;
        st_load(ksp, vsp, soffp, kr, vr); st_write(lds, skey, sch, kr, vr);
        if (u >= 1) st_load(ksp, vsp, soffp + 64u * PLD * 2u, kA, vA);
        __syncthreads();
#define SEL_STEP(J, KX, VX, KY, VY) { const int j_ = (J); \
            const LAS unsigned char* cur = lds + (j_ & 1) * DBUF_BYTES; LAS unsigned char* nxt = lds + ((j_ + 1) & 1) * DBUF_BYTES; \
            if (j_ + 2 <= u) st_load(ksp, vsp, soffp + (unsigned)(j_ + 2) * (64u * PLD * 2u), KY, VY); \
            const int jb = j_ >> 5; const unsigned smw = jb == 0 ? sm0 : (jb == 1 ? sm1 : (jb == 2 ? sm2 : sm3)); \
            const bool bit = ((smw >> (j_ & 31)) & 1u) != 0u; \
            if (__builtin_amdgcn_ballot_w64(bit) != 0ull) sel_tile(cur, kboff, vboff, qf, Os, negm, lsel, 64 * j_ + 63 > tw0 - 113, bit, t, 64 * j_, hh, 1 << 30, b2h); \
            if (j_ + 1 <= u) st_write(nxt, skey, sch, KX, VX); \
            __syncthreads(); }
#pragma unroll 1
        for (int j = 0; j <= u; j += 2) {
            SEL_STEP(j, kA, vA, kB, vB)
            if (j + 1 <= u) SEL_STEP(j + 1, kB, vB, kA, vA)
        }
#undef SEL_STEP
    }
    {   const float lwt = lw + xshfl<32>(lw), lst = lsel + xshfl<32>(lsel);
        const GAS bf16* gp = proj + (rowb + t) * PLD + C_DG + head * 3;
        const float g0 = sigmoidf_(bf2f(gp[0])), g1 = sigmoidf_(bf2f(gp[1])) / fmaxf(lst, 1e-30f), g2 = sigmoidf_(bf2f(gp[2])) / fmaxf(lwt, 1e-30f);
        GAS bf16* op = ys + (rowb + t) * 1024 + 768 + head * 64;
#pragma unroll
        for (int db = 0; db < 2; ++db)
#pragma unroll
            for (int gq = 0; gq < 4; ++gq) { const int d0 = 32 * db + 8 * gq + 4 * hh; float y[4];
#pragma unroll
                for (int e = 0; e < 4; ++e) { const unsigned cw = ocp[db][2 * gq + (e >> 1)], ww = owp[db][2 * gq + (e >> 1)];
                    y[e] = g0 * ((e & 1) ? hi_bf(cw) : lo_bf(cw)) + g1 * Os[db][4 * gq + e] + g2 * ((e & 1) ? hi_bf(ww) : lo_bf(ww)); }
                u32x2 w; w.x = cvtpk(y[0], y[1]); w.y = cvtpk(y[2], y[3]); *(GAS u32x2*)(op + d0) = w; }
    }
}


DI void swa_unit(const GAS bf16* proj, GAS bf16* ys, LAS unsigned char* lds, const LAS float* bias2, const LAS float* biasd, const GAS float* sinks, int b, int u, int tid_in, int lane_in, int wave_in) {
    int tid = tid_in, lane = lane_in, wave = wave_in; asm volatile("" : "+v"(tid), "+v"(lane), "+s"(wave));
    const int t0 = u * 64; const int col = lane & 31, hh = lane >> 5, tl = col >> 1, kv = wave & 1, head = 2 * kv + (col & 1);
    const int t = t0 + (wave >> 1) * 16 + tl;
    const size_t rowb = (size_t)b * SEQ;
    const LAS float* b2h = bias2 + head;
    bf16x8 qf[4];
    { const float SC = 0.125f * 1.4426950408889634f; const GAS bf16* qp = proj + (rowb + t) * PLD + C_BQ + head * 64 + hh * 8;
#pragma unroll
      for (int s = 0; s < 4; ++s) { const u32x4 w = *(const GAS u32x4*)(qp + s * 16); u32x4 o;
          o.x = cvtpk(lo_bf(w.x) * SC, hi_bf(w.x) * SC); o.y = cvtpk(lo_bf(w.y) * SC, hi_bf(w.y) * SC); o.z = cvtpk(lo_bf(w.z) * SC, hi_bf(w.z) * SC); o.w = cvtpk(lo_bf(w.w) * SC, hi_bf(w.w) * SC);
          qf[s] = __builtin_bit_cast(bf16x8, o); } }
    const int skey = tid >> 3, sch = tid & 7;
    const int i16 = lane & 15, blk = (lane >> 4) & 1;
    const int kboff = kv * DBUF_BYTES + col * DK_STR + hh * 16;
    const int vboff = kv * DBUF_BYTES + 64 * DK_STR + (4 * hh + (i16 >> 2)) * DV_STR + (16 * blk + 4 * (i16 & 3)) * 2;
    const GAS unsigned char* kp = (const GAS unsigned char*)(proj + rowb * PLD + C_BK); const GAS unsigned char* vp = (const GAS unsigned char*)(proj + rowb * PLD + C_BV);
    const unsigned soffp = (unsigned)(skey * PLD + sch * 8) * 2u;
    u32x4 k0, v0, k1, v1;
    f32x16 O[2], negm; float lsum = 0.f;
#pragma unroll
    for (int i = 0; i < 16; ++i) { O[0][i] = 0.f; O[1][i] = 0.f; negm[i] = 120.f; }
    const int s0 = (u < 2) ? 2 - u : 0;
    { const unsigned so = soffp + (unsigned)(u - 2 + s0) * (64u * PLD * 2u); st_load(kp, vp, so, k0, v0); st_load(kp + 128, vp + 128, so, k1, v1);
      st_write(lds, skey, sch, k0, v0); st_write(lds + DBUF_BYTES, skey, sch, k1, v1); }
    __syncthreads();
#pragma unroll 1
    for (int s = s0; s < 3; ++s) {
        const int par = (s - s0) & 1; const LAS unsigned char* cur = lds + par * 2 * DBUF_BYTES; LAS unsigned char* nxt = lds + (par ^ 1) * 2 * DBUF_BYTES;
        if (s + 1 < 3) { const unsigned so = soffp + (unsigned)(u - 2 + s + 1) * (64u * PLD * 2u); st_load(kp, vp, so, k0, v0); st_load(kp + 128, vp + 128, so, k1, v1); }
        sel_tile(cur, kboff, vboff, qf, O, negm, lsum, true, true, t, (u - 2 + s) * 64, hh, 128, b2h);
        if (s + 1 < 3) { st_write(nxt, skey, sch, k0, v0); st_write(nxt + DBUF_BYTES, skey, sch, k1, v1); }
        __syncthreads();
    }
    {   const float sinkp = (sinks[head] - biasd[128 * 12 + head]) * 1.4426950408889634f;
        const float lt = lsum + xshfl<32>(lsum) + __builtin_amdgcn_exp2f(sinkp + negm[0]);
        const float inv = 1.f / fmaxf(lt, 1e-30f);
        GAS bf16* op = ys + (rowb + t) * 1024 + 256 + head * 64;
#pragma unroll
        for (int db = 0; db < 2; ++db)
#pragma unroll
            for (int gq = 0; gq < 4; ++gq) { const int d0 = 32 * db + 8 * gq + 4 * hh;
                u32x2 w; w.x = cvtpk(O[db][4 * gq + 0] * inv, O[db][4 * gq + 1] * inv); w.y = cvtpk(O[db][4 * gq + 2] * inv, O[db][4 * gq + 3] * inv); *(GAS u32x2*)(op + d0) = w; }
    }
}

DI void route_rows4(const KA& a, int l, bf16* xr_, int tok0, int lane_) {
    int lane = lane_; asm volatile("" : "+v"(lane));
    const GAS bf16* xrow = (const GAS bf16*)(a.ws + WS_XB) + (size_t)tok0 * 1024; const GAS float* g = (const GAS float*)(a.in[28] + (size_t)l * 1024); GAS bf16* xr = (GAS bf16*)xr_;
    f32x4 v[4][4]; float ss[4]; u32x2 raw[4][4];
#pragma unroll
    for (int rr = 0; rr < 4; ++rr)
#pragma unroll
        for (int j = 0; j < 4; ++j) raw[rr][j] = *(const GAS u32x2*)(xrow + (size_t)rr * 1024 + 4 * (lane + 64 * j));
#pragma unroll
    for (int rr = 0; rr < 4; ++rr)
#pragma unroll
        for (int j = 0; j < 4; ++j) { v[rr][j][0] = lo_bf(raw[rr][j].x); v[rr][j][1] = hi_bf(raw[rr][j].x); v[rr][j][2] = lo_bf(raw[rr][j].y); v[rr][j][3] = hi_bf(raw[rr][j].y); }
#pragma unroll
    for (int rr = 0; rr < 4; ++rr) { float t = 0.f;
#pragma unroll
        for (int j = 0; j < 4; ++j) t += (v[rr][j][0] * v[rr][j][0] + v[rr][j][1] * v[rr][j][1]) + (v[rr][j][2] * v[rr][j][2] + v[rr][j][3] * v[rr][j][3]);
        ss[rr] = t; }
#pragma unroll
    for (int rr = 0; rr < 4; ++rr) ss[rr] = wave_sum(ss[rr]);
#pragma unroll
    for (int j = 0; j < 4; ++j) { const int k0 = 4 * (lane + 64 * j); const f32x4 gv = *(const GAS f32x4*)(g + k0);
#pragma unroll
        for (int rr = 0; rr < 4; ++rr) { const float r = 1.f / sqrtf(ss[rr] * (1.f / 1024.f) + 1e-6f); const f32x4 xn = v[rr][j] * r * gv;
            unsigned hi[4]; float lo[4];
#pragma unroll
            for (int e = 0; e < 4; ++e) { hi[e] = f2bf(xn[e]); lo[e] = xn[e] - __builtin_bit_cast(float, hi[e] << 16); }
            u32x2 wh, wl; wh.x = hi[0] | (hi[1] << 16); wh.y = hi[2] | (hi[3] << 16); wl.x = pk2(lo[0], lo[1]); wl.y = pk2(lo[2], lo[3]);
            *(GAS u32x2*)(xr + (size_t)(tok0 + rr) * 2048 + k0) = wh; *(GAS u32x2*)(xr + (size_t)(tok0 + rr) * 2048 + 1024 + k0) = wl; } }
}
struct SchedRoute { const char* A; const char* B; int pm;
    DI bool next(int i, Unit& u) const { if (i > 0) return false; u.pm = pm; u.pn = 0; u.aux = 0; u.pad = 0; u.a = A + (size_t)pm * 128 * 2048 * 2; u.b = B; return true; } };
struct EpiRoute { static constexpr bool CARRY = false; float* rlog;
    DI void operator()(const f32x4 (&acc)[2][2][4][2], const Unit& u, int wr, int wc, int fr, int fq) const {
        const int row0 = u.pm * 128 + wr * 64 + fr; const int col = wc * 32 + 8 * fq;
#pragma unroll
        for (int m = 0; m < 4; ++m) { float* rp = rlog + (size_t)(row0 + m * 16) * 128 + col; *(f32x4*)rp = acc[0][0][m][0]; *(f32x4*)(rp + 4) = acc[0][0][m][1]; }
    }
};
DI void route_decide(const KA& a, int l, const float* rl_row, int* rec_e, int* rec_slot, float* rec_w, unsigned* cnt, int tok) {
    float lg[36];
    const float* bg = a.in[30] + l * 4; const float* be = a.in[32] + l * 32;
#pragma unroll
    for (int q = 0; q < 9; ++q) { const f32x4 h = *(const f32x4*)(rl_row + 4 * q), lo = *(const f32x4*)(rl_row + 64 + 4 * q);
        lg[4 * q + 0] = h[0] + lo[0]; lg[4 * q + 1] = h[1] + lo[1]; lg[4 * q + 2] = h[2] + lo[2]; lg[4 * q + 3] = h[3] + lo[3]; }
#pragma unroll
    for (int i = 0; i < 4; ++i) lg[i] += bg[i];
#pragma unroll
    for (int i = 0; i < 32; ++i) lg[4 + i] += be[i];
    int gsel = 0; float gm = lg[0];
#pragma unroll
    for (int i = 1; i < 4; ++i) if (lg[i] > gm) { gm = lg[i]; gsel = i; }
    float gs = 0.f;
#pragma unroll
    for (int i = 0; i < 4; ++i) gs += __expf(lg[i] - gm);
    const float gwt = 1.f / gs;
    float v8[8];
#pragma unroll
    for (int i = 0; i < 8; ++i) { float x = lg[4 + i];
#pragma unroll
        for (int gq = 1; gq < 4; ++gq) x = (gsel == gq) ? lg[4 + gq * 8 + i] : x;
        v8[i] = x; }
    int i0 = 0; float m0 = v8[0];
#pragma unroll
    for (int i = 1; i < 8; ++i) if (v8[i] > m0) { m0 = v8[i]; i0 = i; }
    int i1 = -1; float m1 = -3e38f;
#pragma unroll
    for (int i = 0; i < 8; ++i) if (i != i0 && v8[i] > m1) { m1 = v8[i]; i1 = i; }
    if (i1 < 0) i1 = (i0 == 0) ? 1 : 0;
    const float w0 = 1.f / (1.f + __expf(m1 - m0)); const float w1 = 1.f - w0;
    const int e0 = gsel * 8 + i0, e1 = gsel * 8 + i1;
    const unsigned s0 = __hip_atomic_fetch_add(cnt + e0, 1u, __ATOMIC_RELAXED, __HIP_MEMORY_SCOPE_AGENT);
    const unsigned s1 = __hip_atomic_fetch_add(cnt + e1, 1u, __ATOMIC_RELAXED, __HIP_MEMORY_SCOPE_AGENT);
    (void)rec_e; (void)rec_slot; (void)rec_w;
    int* inv_as = (int*)(a.ws + WS_INVAS); float* inv_w = (float*)(a.ws + WS_INVW);
    inv_as[e0 * 32768 + (int)s0] = tok * 2; inv_w[e0 * 32768 + (int)s0] = w0 * gwt; inv_as[e1 * 32768 + (int)s1] = tok * 2 + 1; inv_w[e1 * 32768 + (int)s1] = w1 * gwt;
}
DI void expert_weights(const KA& a, int l, LAS unsigned char* lds, int it0, int it1, int gw, int NGW, int wave, int lane) {
    LAS float* scr = (LAS float*)(lds + wave * 16384);
    const float* wgt = a.in[33] + (size_t)l * 32 * 1024 * 256; const float* wup = a.in[34] + (size_t)l * 32 * 1024 * 256; const float* wdn = a.in[35] + (size_t)l * 32 * 256 * 1024;
    bf16* Wgu = (bf16*)(a.ws + WS_WGU); bf16* Wd = (bf16*)(a.ws + WS_WD);
    constexpr int I_E = 16 * 8, I_D = 4 * 32;
    constexpr int NIT = 32 * (2 * I_E + I_D);
    (void)NIT;
    for (int it = it0 + gw; it < it1; it += NGW) {
        const int e = it / (2 * I_E + I_D); int r = it % (2 * I_E + I_D);
        if (r < 2 * I_E) { const int up = r / I_E, q = r % I_E, kb = q / 8, nb = q % 8; const int n0 = nb * 32;
            const int drow = (n0 >> 7) * 256 + up * 128 + (n0 & 127);
            transpose_item((up ? wup : wgt) + (size_t)e * 1024 * 256, 256, 256, Wgu + (size_t)e * 512 * 1024, 1024, kb * 64, n0, drow, scr, lane);
        } else { r -= 2 * I_E; const int kb = r / 32, nb = r % 32;
            transpose_item(wdn + (size_t)e * 256 * 1024, 1024, 1024, Wd + (size_t)e * 1024 * 256, 256, kb * 64, nb * 32, nb * 32, scr, lane); }
    }
}
DI void build_offsets(const unsigned* cnt, LAS int* offt, int tid) {
    int c = 0;
    if (tid < 32) { c = (int)__hip_atomic_load(cnt + tid, __ATOMIC_RELAXED, __HIP_MEMORY_SCOPE_AGENT); offt[330 + tid] = (c + 255) & ~255; }
    __syncthreads();
    if (tid == 0) { int o = 0;
#pragma unroll
        for (int e = 0; e < 32; ++e) { offt[e] = o; o += offt[330 + e]; } offt[32] = o; }
    __syncthreads();
    if (tid < 32) offt[330 + tid] = c;
    for (int rt = tid; rt < (MOE_ROWS >> 8); rt += 512) { int e = 0; for (int j = 1; j < 32; ++j) e += (offt[j] <= rt * 256) ? 1 : 0; offt[40 + rt] = e; }
    __syncthreads();
}

template <unsigned PM>
__global__ void __launch_bounds__(512, 2) mk_fwd(Args a_) {
    extern __shared__ __attribute__((aligned(16))) unsigned char lds_raw[];
    LAS unsigned char* lds = (LAS unsigned char*)lds_raw;
    const int wave0 = __builtin_amdgcn_readfirstlane((int)threadIdx.x >> 6);
    if (threadIdx.x < 36) ((LAS unsigned long long*)(lds + PTAB_OFF))[threadIdx.x] = (unsigned long long)a_.in[threadIdx.x];
    __syncthreads();
    KA a; a.in.base = (unsigned)(size_t)(lds + PTAB_OFF); a.out = a_.out; a.ws = a_.ws;
    const int G = gridDim.x, bid = blockIdx.x, NGW = G * 8;
#define PHASE_IDS() int wave = wave0; asm volatile("" : "+s"(wave)); const int lane = my_lane(); const int tid_ = wave * 64 + lane, gw = bid * 8 + wave; (void)tid_; (void)gw; \
    const int xb = ((bid & 7) << 5) | (bid >> 3); (void)xb;        \
    KA ap = a; asm volatile("" : "+s"(ap.ws), "+s"(ap.out), "+s"(ap.in.base)); \
    bf16* hb = (bf16*)(ap.ws + WS_HB); bf16* proj = (bf16*)(ap.ws + WS_PROJ); bf16* gates = (bf16*)(ap.ws + WS_GATES); \
    bf16* ys = hb; bf16* x2b = hb; bf16* merged = proj; bf16* eo = proj; \
    bf16* kcb = (bf16*)(ap.ws + WS_KCVC); float* lrusum = (float*)(ap.ws + WS_LRUSUM); \
    int* rec_e = (int*)(ap.ws + WS_REC); int* rec_slot = rec_e + T * 2; float* rec_w = (float*)(rec_slot + T * 2); \
    int* rowtok = (int*)(ap.ws + WS_ROWTOK); float* roww = (float*)(ap.ws + WS_ROWW); \
    bf16* xs = (bf16*)(ap.ws + WS_XS); bf16* hmid = (bf16*)(ap.ws + WS_HMID); unsigned* ctl = (unsigned*)(ap.ws + WS_CTL); \
    (void)hb; (void)proj; (void)gates; (void)ys; (void)x2b; (void)merged; (void)eo; (void)kcb; (void)lrusum; (void)rec_e; (void)rec_slot; (void)rec_w; (void)rowtok; (void)roww; (void)xs; (void)hmid; (void)ctl
    volatile LAS unsigned* MISC = (volatile LAS unsigned*)(lds + MISC_OFF);
    LAS float* biasd = (LAS float*)(lds + BIAS_OFF);
    LAS int* offt = (LAS int*)(lds + OFFT_OFF);
    { PHASE_IDS();
    if (tid_ < 64) MISC[tid_] = 0u;
    for (int i = tid_; i < 129 * 12; i += 512) { const int d = i / 12, hd = i % 12; const int bk = d < 128 ? T5_BUCKET[d] : 31; const float* rb = a.in[1]; biasd[i] = rb[bk * 12 + hd]; ((LAS float*)(lds + BIAS2_OFF))[i] = (rb[bk * 12 + hd] - rb[31 * 12 + hd]) * 1.4426950408889634f; } }
    __syncthreads();
    const int lo = a_.ph_lo, hi = a_.ph_hi;
    XcdBarrier bar; bar.bar = (unsigned*)(a.ws + WS_CTL) + CW_BAR; bar.x = 0; bar.st = nullptr;
    if (hi - lo > 1) { PHASE_IDS(); bar = xcd_barrier_post(ctl + CW_BAR, MISC + 8, tid_ == 0); }
#ifndef SUB_MASK
#define SUB_MASK 0xFFu
#endif
#define SUB(k) ((SUB_MASK >> (k)) & 1u)
#define HASP(k) ((PM >> ((k) % PPL + ((k) >= 2 * PPL ? PPL : 0))) & 1u)
#define IN(k) (HASP(k) && lo <= (k) && (k) < hi)
#define SEAM(k) do { if ((k) + 1 < hi) { const int sl_ = my_lane(); int sw_ = wave0; asm volatile("" : "+s"(sw_)); xcd_barrier(bar, sw_ == 0 && sl_ == 0); } } while (0)
    for (int l = 0; l < DEPTH; ++l) {
        const int pb = l * PPL;
        if (IN(pb + 0)) { PHASE_IDS(); p1_weights_i8(ap, l, lds, gw, NGW, wave, lane); router_weights(ap, l, gw, NGW, lane); lru_weights(ap, l, gw, NGW, lane); cmp_weights(ap, l, lds, gw, NGW, wave, lane); phase0_weights(ap, l, lds, gw, NGW, wave, lane); phase0_rows(ap, l, 0, gw, NGW, lane); SEAM(pb + 0); }
        if (IN(pb + 1)) {
            PHASE_IDS();
            {   int K1q = 512; asm volatile("" : "+s"(K1q));
                pg8::Gemm g{K1q, 512, 512, 128, -1}; SchedP1 S{(const char*)(ap.ws + WS_HQ), (const char*)(ap.ws + WS_WQ), 128, 26, 1024, 1024, G, bid};
                EpiP1I8 E{proj, (unsigned char*)gates, ap.in[25] + (size_t)l * 4096, (const float*)(ap.ws + WS_HSC), (const float*)(ap.ws + WS_WSC)};
                pg8::gemm_phase<EpiP1I8, SchedP1, false, true>(lds, g, S, E, tid_); }
            SEAM(pb + 1);
        }
        if (IN(pb + 2)) {
            PHASE_IDS();
            LAS float* lamp = (LAS float*)(lds + MISC_OFF + 64);
            if (tid_ < 64) { const float* q1 = ap.in[13] + l * 32; const float* k1 = ap.in[14] + l * 32; const float* q2 = ap.in[15] + l * 32; const float* k2 = ap.in[16] + l * 32;
                float s1 = (lane < 32) ? q1[lane] * k1[lane] : 0.f, s2 = (lane < 32) ? q2[lane] * k2[lane] : 0.f; s1 = wave_sum(s1); s2 = wave_sum(s2);
                const float lam_init = 0.8f - 0.6f * __expf(-0.3f * (float)l); if (lane == 0) { lamp[0] = __expf(s1) - __expf(s2) + lam_init; lamp[1] = lam_init; } }
            __syncthreads();
            if (SUB(0)) { const LAS float* bias2 = (const LAS float*)(lds + BIAS2_OFF); const GAS float* subg = (const GAS float*)(ap.in[17] + l * 64);
                for (int pi = xb; pi < 256; pi += G) { const int bh = pi >> 4, qlo = pi & 15;
                    diff_unit((const GAS bf16*)proj, (GAS bf16*)ys, lds, bias2, subg, lamp, bh >> 2, bh & 3, 31 - qlo, wave);
                    diff_unit((const GAS bf16*)proj, (GAS bf16*)ys, lds, bias2, subg, lamp, bh >> 2, bh & 3, qlo, wave); } }
            { PHASE_IDS();
            if (SUB(3)) { __syncthreads(); const LAS float* bias2 = (const LAS float*)(lds + BIAS2_OFF); const GAS float* sinks = (const GAS float*)(ap.in[12] + l * 4);
                for (int pi = xb; pi < 512; pi += G) swa_unit((const GAS bf16*)proj, (GAS bf16*)ys, lds, bias2, biasd, sinks, pi >> 7, pi & 127, tid_, lane, wave); }
            if (SUB(2)) cmp_block(ap, l, (const GAS bf16*)proj, (const GAS bf16*)(ap.ws + WS_WCMP), (float*)(ap.ws + WS_CMPAB), kcb, bid, wave, lane);
            if (SUB(1)) { __syncthreads(); for (int task = xb; task < 512; task += G) lru_unit(ap, l, (const GAS bf16*)proj, (GAS bf16*)ys, (GAS float*)lrusum, lds, task, lane, wave, false); }
            }
            SEAM(pb + 2);
        }
        if (IN(pb + 4)) {
            PHASE_IDS();
            for (int task = xb; task < 512; task += G) lru_unit(ap, l, (const GAS bf16*)proj, (GAS bf16*)ys, (GAS float*)lrusum, lds, task, lane, wave, true);
            __syncthreads();
            if (SUB(4)) { const LAS float* bias2 = (const LAS float*)(lds + BIAS2_OFF);
                for (int pi = xb; pi < 256; pi += G) { const int bb = pi >> 6, ulo = pi & 63;
                    nsa_unit((const GAS bf16*)proj, (GAS bf16*)ys, (const GAS bf16*)kcb, lds, bias2, bb, 127 - ulo, tid_, lane, wave);
                    nsa_unit((const GAS bf16*)proj, (GAS bf16*)ys, (const GAS bf16*)kcb, lds, bias2, bb, ulo, tid_, lane, wave); } }
            SEAM(pb + 4);
        }
        if (IN(pb + 5)) {
            PHASE_IDS();
            int K5 = 256; asm volatile("" : "+s"(K5));
            pg8::Gemm g{K5, 1024, 256, 128, -1}; SchedP3a S{(const char*)ys, (const char*)(ap.ws + WS_WBR), G, xb};
            EpiP3a E{merged, (const unsigned char*)gates};
            pg8::gemm_phase<EpiP3a, SchedP3a>(lds, g, S, E, tid_); SEAM(pb + 5);
        }
        if (IN(pb + 6)) {
            PHASE_IDS();
            int K6 = 1024; asm volatile("" : "+s"(K6));
            pg8::Gemm g{K6, 1024, 1024, 128, -1}; SchedP3b S{(const char*)merged, (const char*)(ap.ws + WS_WOUT), G, xb};
            if (l == 0) { EpiP3b<true> E{ap.in[0], (bf16*)(ap.ws + WS_XB)}; pg8::gemm_phase<EpiP3b<true>, SchedP3b>(lds, g, S, E, tid_); }
            else { EpiP3b<false> E{nullptr, (bf16*)(ap.ws + WS_XB)}; pg8::gemm_phase<EpiP3b<false>, SchedP3b>(lds, g, S, E, tid_); }
            SEAM(pb + 6);
        }
        if (IN(pb + 7)) {
            PHASE_IDS();
            bf16* xr = (bf16*)(ap.ws + WS_XR); float* rlog = (float*)(ap.ws + WS_RLOG);
            constexpr int NITW = 32 * (2 * 16 * 8 + 4 * 32);
            { const int pm = bid;
                for (int r = wave * 4; r < 128; r += 32) route_rows4(ap, l, xr, pm * 128 + r, lane);
                asm volatile("s_waitcnt vmcnt(0)" ::: "memory"); __syncthreads();
                { pg8::Gemm g{2048, 2048, 2048, 128, 0}; SchedRoute S{(const char*)xr, (const char*)(ap.ws + WS_WR), pm}; EpiRoute E{rlog};
                  pg8::gemm_phase<EpiRoute, SchedRoute>(lds, g, S, E, tid_); }
                asm volatile("s_waitcnt vmcnt(0)" ::: "memory"); __syncthreads();
                if (tid_ < 128) route_decide(ap, l, rlog + (size_t)(pm * 128 + tid_) * 128, rec_e, rec_slot, rec_w, ctl + CW_CNT + l * 32, pm * 128 + tid_);
                __syncthreads();
            }
            expert_weights(ap, l, lds, 0, NITW, gw, NGW, wave, lane);
            SEAM(pb + 7);
        }
        if (IN(pb + 9)) {
            PHASE_IDS();
            build_offsets(ctl + CW_CNT + l * 32, offt, tid_);
            int K9 = 1024; asm volatile("" : "+s"(K9));
            pg8::Gemm g{K9, 2048, 1024, 128, -1}; SchedM2 S{(const char*)(ap.ws + WS_XR), (const char*)(ap.ws + WS_WGU), offt, (const int*)(ap.ws + WS_INVAS), G, xb};
            EpiM2 E{hmid};
            pg8::gemm_phase<EpiM2, SchedM2, true>(lds, g, S, E, tid_); SEAM(pb + 9);
        }
        if (IN(pb + 10)) {
            PHASE_IDS();
            build_offsets(ctl + CW_CNT + l * 32, offt, tid_);
            int K3 = 256; asm volatile("" : "+s"(K3));
            pg8::Gemm g{K3, 256, 256, 128, -1}; SchedM3 S{(const char*)hmid, (const char*)(ap.ws + WS_WD), offt, G, xb};
            EpiM3 E{eo, (const int*)(ap.ws + WS_INVAS), (const float*)(ap.ws + WS_INVW), offt};
            pg8::gemm_phase<EpiM3, SchedM3>(lds, g, S, E, tid_); SEAM(pb + 10);
        }
    }
    if (IN(2 * PPL)) { PHASE_IDS(); phase0_rows(ap, DEPTH, 1, gw, NGW, lane); }
#undef IN
#undef SEAM
}

typedef void (*kern_t)(Args);
template <unsigned PM> static bool setup_kernel() {
    if (hipFuncSetAttribute((const void*)mk_fwd<PM>, hipFuncAttributeMaxDynamicSharedMemorySize, LDS_BYTES) != hipSuccess) { fprintf(stderr, "kernel_launch: hipFuncSetAttribute failed\n"); return false; }
    return true;
}
extern "C" void kernel_launch(void* const* d_in, const int* in_sizes, int n_in, void* d_out, int out_size, void* d_ws, size_t ws_size, hipStream_t stream) {
    static int grid = 0;
    if (grid == 0) {
        if (n_in != 36 || out_size != T * D || ws_size < WS_END) { fprintf(stderr, "kernel_launch: unexpected shapes (n_in %d out %d ws %zu)\n", n_in, out_size, ws_size); grid = -1; return; }
        int dev = 0, cus = 0;
        if (hipGetDevice(&dev) != hipSuccess || hipDeviceGetAttribute(&cus, hipDeviceAttributeMultiprocessorCount, dev) != hipSuccess) { grid = -1; return; }
        bool ok = true;
#if MK_ONE_LAUNCH
        ok = setup_kernel<0xFFFu>();
#endif
        if (!ok) { grid = -1; return; }
        (void)hipGetLastError();
        grid = cus;
        if (grid != 256) { fprintf(stderr, "kernel_launch: built for a 256-CU device (got %d)\n", cus); grid = -1; return; }
    }
    if (grid < 0) return;
    if (hipMemsetAsync((char*)d_ws + WS_CTL, 0, CTL_ZERO_BYTES, stream) != hipSuccess) return;
    Args a{};
    for (int i = 0; i < 36; ++i) a.in[i] = (const float*)d_in[i];
    a.out = (float*)d_out; a.ws = (unsigned char*)d_ws;
#if MK_ONE_LAUNCH
    a.ph_lo = 0; a.ph_hi = NPH;
    hipLaunchKernelGGL(mk_fwd<0xFFFu>, dim3(grid), dim3(512), LDS_BYTES, stream, a);
#endif
}
```

```cpp
#include <hip/hip_runtime.h>
#include <cstdio>
#include <cstdint>

#ifndef MK_ONE_LAUNCH
#define MK_ONE_LAUNCH 1
#endif

#define DI __device__ __forceinline__
#define GAS __attribute__((address_space(1)))
#define LAS __attribute__((address_space(3)))
typedef unsigned short bf16;
typedef short bf16x8 __attribute__((ext_vector_type(8)));
typedef float f32x4 __attribute__((ext_vector_type(4)));
typedef int i32x4 __attribute__((ext_vector_type(4)));
typedef unsigned u32x4 __attribute__((ext_vector_type(4)));
typedef unsigned u32x2 __attribute__((ext_vector_type(2)));
typedef float f32x16 __attribute__((ext_vector_type(16)));
typedef float f32x2 __attribute__((ext_vector_type(2)));
typedef short s16x4 __attribute__((ext_vector_type(4)));
typedef __bf16 bf16x2_t __attribute__((ext_vector_type(2)));
typedef short v4i16_t __attribute__((__vector_size__(4 * sizeof(short))));
#define MFMA32(a, b, c) __builtin_amdgcn_mfma_f32_32x32x16_bf16((a), (b), (c), 0, 0, 0)

constexpr int BATCH = 4, SEQ = 8192, T = BATCH * SEQ, D = 1024, DEPTH = 2;
constexpr int NIN = 2444, PLD = 2560, N1 = 6656, GLD = 4096;
constexpr int C_AX = 0, C_AG = 256, C_BQ = 512, C_BK = 768, C_BV = 896, C_CQ = 1024, C_CK = 1280, C_CV = 1536, C_DQ = 1792,
              C_KC = 2048, C_VC = 2112, C_KS = 2176, C_VS = 2240, C_KW = 2304, C_VW = 2368, C_DG = 2432;
constexpr int NCMP = 511;
constexpr int MOE_ROWS = 73728;
constexpr int PPL = 11;
constexpr int NPH = 2 * PPL + 1;

constexpr size_t MiB = 1u << 20;
constexpr size_t WS_CTL = 0, CTL_ZERO_BYTES = 1 * MiB;
constexpr size_t WS_KCVC = 1 * MiB;
constexpr size_t WS_LRUSUM = 2 * MiB;
constexpr size_t WS_REC = 2 * MiB + 256 * 1024;
constexpr size_t WS_ROWTOK = 3 * MiB;
constexpr size_t WS_ROWW = 3 * MiB + 512 * 1024;
constexpr size_t WS_WIN = 4 * MiB;
constexpr size_t WS_WQ = 4 * MiB;
constexpr size_t WS_WSC = 13 * MiB;
constexpr size_t WS_HSC = 13 * MiB + 65536;
constexpr size_t WS_HQ = 21 * MiB;
constexpr size_t WS_INVAS = 296 * MiB;
constexpr size_t WS_INVW = 300 * MiB;
constexpr size_t WS_XB = 373 * MiB;
constexpr size_t WS_WBR = 17 * MiB;
constexpr size_t WS_WOUT = 19 * MiB;
constexpr size_t WS_HB = 21 * MiB;
constexpr size_t WS_PROJ = 85 * MiB;
constexpr size_t WS_GATES = 245 * MiB;
constexpr size_t WS_WGU = 245 * MiB;
constexpr size_t WS_WD = 277 * MiB;
constexpr size_t WS_XS = 293 * MiB;
constexpr size_t WS_HMID = 437 * MiB;
constexpr size_t WS_XR = 85 * MiB;
constexpr size_t WS_RLOG = 213 * MiB;
constexpr size_t WS_WR = 501 * MiB;
constexpr size_t WS_WCMP = 502 * MiB;
constexpr size_t WS_CMPAB = 503 * MiB;
constexpr size_t WS_LRUW = 505 * MiB + 65536;
constexpr size_t WS_END = 506 * MiB;
constexpr int CW_BAR = 4096;
constexpr int CW_CNT = 16384;

constexpr int RING_BYTES = 131072;
constexpr int MISC_OFF = RING_BYTES;
constexpr int BIAS_OFF = MISC_OFF + 256;
constexpr int OFFT_OFF = BIAS_OFF + 129 * 12 * 4;
constexpr int PTAB_OFF = OFFT_OFF + (40 + 288 + 40) * 4;
constexpr int BIAS2_OFF = PTAB_OFF + 36 * 8;
constexpr int LRUEX_OFF = BIAS2_OFF + 129 * 12 * 4;
constexpr int LDS_BYTES = 163840;
constexpr int LRUCST_OFF = LRUEX_OFF + 8 * 64 * 2 * 4;
constexpr int LRUCAR_OFF = LRUCST_OFF + 3 * 64 * 4;
static_assert(PTAB_OFF % 8 == 0 && LRUCAR_OFF + 8 * 64 * 4 <= LDS_BYTES, "LDS map");

DI float bf2f(bf16 v) { return __builtin_bit_cast(float, (unsigned)v << 16); }
DI float lo_bf(unsigned w) { return __builtin_bit_cast(float, w << 16); }
DI float hi_bf(unsigned w) { return __builtin_bit_cast(float, w & 0xffff0000u); }
DI unsigned f2bf(float f) { unsigned u = __builtin_bit_cast(unsigned, f); return (u + 0x7fffu + ((u >> 16) & 1u)) >> 16; }
DI unsigned pk2(float lo, float hi) { return f2bf(lo) | (f2bf(hi) << 16); }
DI float rl(float v, int i) { return __builtin_bit_cast(float, __builtin_amdgcn_readlane(__builtin_bit_cast(int, v), i)); }
DI int rli(int v, int i) { return __builtin_amdgcn_readlane(v, i); }
DI int my_lane() { int l; asm volatile("v_mbcnt_lo_u32_b32 %0, -1, 0\n\tv_mbcnt_hi_u32_b32 %0, -1, %0" : "=v"(l)); return l; }
template <int O> DI int xshfl_i(int v) {
    if constexpr (O < 32) return __builtin_amdgcn_ds_swizzle(v, (O << 10) | 0x1f);
    else { const int l = my_lane(); return __builtin_amdgcn_ds_bpermute((l ^ 32) << 2, v); }
}
template <int O> DI float xshfl(float v) { return __builtin_bit_cast(float, xshfl_i<O>(__builtin_bit_cast(int, v))); }
DI float wave_sum(float v) { v += xshfl<1>(v); v += xshfl<2>(v); v += xshfl<4>(v); v += xshfl<8>(v); v += xshfl<16>(v); v += xshfl<32>(v); return v; }
DI float wave_max(float v) { v = fmaxf(v, xshfl<1>(v)); v = fmaxf(v, xshfl<2>(v)); v = fmaxf(v, xshfl<4>(v)); v = fmaxf(v, xshfl<8>(v)); v = fmaxf(v, xshfl<16>(v)); v = fmaxf(v, xshfl<32>(v)); return v; }
DI float sigmoidf_(float x) { return __builtin_amdgcn_rcpf(1.f + __builtin_amdgcn_exp2f(-1.4426950408889634f * x)); }
DI float gelu_tanh(float x) { const float u = 0.7978845608028654f * (x + 0.044715f * x * x * x); const float e = __expf(2.f * u); const float th = 1.f - 2.f * __builtin_amdgcn_rcpf(e + 1.f); return 0.5f * x * (1.f + th); }
DI float softplusf_(float x) { return fmaxf(x, 0.f) + log1pf(__expf(-fabsf(x))); }
#define LDS_WAIT() asm volatile("s_waitcnt lgkmcnt(0)" ::: "memory")
#define VM_WAIT() asm volatile("s_waitcnt vmcnt(0)" ::: "memory")

__device__ const unsigned char T5_BUCKET[128] = {
0,1,2,3,4,5,6,7,8,9,10,11,12,13,14,15,16,16,16,17,17,18,18,18,19,19,19,20,20,20,20,21,21,21,21,22,22,22,22,22,23,23,23,23,23,23,24,24,24,24,24,24,25,25,25,25,25,25,25,26,26,26,26,26,26,26,26,27,27,27,27,27,27,27,27,27,27,28,28,28,28,28,28,28,28,28,28,29,29,29,29,29,29,29,29,29,29,29,29,30,30,30,30,30,30,30,30,30,30,30,30,30,30,31,31,31,31,31,31,31,31,31,31,31,31,31,31,31};

#define XB_TMO      128
#define XB_XCNT(j)  (256  + 64 * (j))
#define XB_XSUB(j)  (1280 + 64 * (j))
#define XB_XGEN(j)  (2304 + 64 * (j))
#define XB_TOP      3328
#define XB_TOPGEN   3392
#define XCD_BAR_WORDS 3456
#define XB_SPIN_CAP (1u << 22)
DI unsigned xb_ld(unsigned* p)              { return __hip_atomic_load(p, __ATOMIC_RELAXED, __HIP_MEMORY_SCOPE_AGENT); }
DI unsigned xb_add(unsigned* p, unsigned v) { return __hip_atomic_fetch_add(p, v, __ATOMIC_RELAXED, __HIP_MEMORY_SCOPE_AGENT); }
DI unsigned xb_xcc_id() { return (unsigned)__builtin_amdgcn_s_getreg((3 << 11) | 20) & 0xFu; }
#define XB_SPIN(cond, bar) do { unsigned _sp = 0; while (cond) { __builtin_amdgcn_s_sleep(1); \
    if ((++_sp & 255u) == 0u) { if (xb_ld(&(bar)[XB_TMO])) break; if (_sp > XB_SPIN_CAP) { atomicAdd(&(bar)[XB_TMO], 1u); break; } } } } while (0)
struct XcdBarrier { unsigned* bar; unsigned x; volatile LAS unsigned* st; };
DI XcdBarrier xcd_barrier_post(unsigned* bar, volatile LAS unsigned* st, bool leader) {
    XcdBarrier b; b.bar = bar; b.x = xb_xcc_id(); b.st = st;
    if (leader) (void)xb_add(&bar[XB_XCNT(b.x)], 1u);
    return b;
}
DI void xcd_barrier_complete(unsigned* bar, unsigned x, unsigned& nloc, unsigned& nx) {
    const unsigned G = gridDim.x * gridDim.y * gridDim.z;
    unsigned sum, cnt, mine, sp = 0u;
    for (;;) {
        sum = 0u; cnt = 0u; mine = 0u;
#pragma unroll
        for (unsigned j = 0; j < 16; ++j) { const unsigned c = xb_ld(&bar[XB_XCNT(j)]); sum += c; cnt += (c > 0u) ? 1u : 0u; mine = (j == x) ? c : mine; }
        if (sum == G) break;
        __builtin_amdgcn_s_sleep(1);
        if ((++sp & 255u) == 0u) { if (xb_ld(&bar[XB_TMO])) break; if (sp > XB_SPIN_CAP) { atomicAdd(&bar[XB_TMO], 1u); break; } }
    }
    nloc = mine > 0u ? mine : 1u; nx = cnt > 0u ? cnt : 1u;
}
DI void xcd_barrier(const XcdBarrier& b, bool leader) {
    asm volatile("s_waitcnt vmcnt(0)" ::: "memory");
    __syncthreads();
    if (leader) {
        unsigned* bar = b.bar;
        __builtin_amdgcn_s_waitcnt(0);
        unsigned nloc = b.st[0], nx = b.st[1];
        if (nloc == 0u) { xcd_barrier_complete(bar, b.x, nloc, nx); b.st[0] = nloc; b.st[1] = nx; }
        const unsigned old = xb_add(&bar[XB_XSUB(b.x)], 1u);
        const unsigned gen = old / nloc;
        if (old + 1u == (gen + 1u) * nloc) {
            __builtin_amdgcn_fence(__ATOMIC_RELEASE, "agent");
            asm volatile("s_waitcnt vmcnt(0)" ::: "memory");
            const unsigned og = xb_add(&bar[XB_TOP], 1u);
            const unsigned tg = og / nx;
            if (og + 1u == (tg + 1u) * nx) xb_add(&bar[XB_TOPGEN], 1u);
            else XB_SPIN(xb_ld(&bar[XB_TOPGEN]) == tg, bar);
            __builtin_amdgcn_fence(__ATOMIC_ACQUIRE, "agent");
            xb_add(&bar[XB_XGEN(b.x)], 1u);
            asm volatile("s_waitcnt vmcnt(0)" ::: "memory");
        } else {
            XB_SPIN(xb_ld(&bar[XB_XGEN(b.x)]) == gen, bar);
            __builtin_amdgcn_fence(__ATOMIC_ACQUIRE, "agent");
            asm volatile("s_waitcnt vmcnt(0)" ::: "memory");
        }
    }
    __syncthreads();
}

namespace pg8 {
constexpr int BM = 256, BK = 64, HALF = 128, HTB = HALF * BK * 2;
__host__ __device__ __forceinline__ int lds_byte(int r, int c) { const int st = (r >> 4) * 2 + (c >> 5), rr = r & 15, cc = c & 31, ob = rr * 64 + cc * 2; return st * 1024 + (ob ^ (((ob >> 9) & 1) << 5)); }
__host__ __device__ __forceinline__ void stage_rc(int b, int& R, int& C) { const int st = b / 1024, sb = b % 1024, swz = sb ^ (((sb >> 9) & 1) << 5); R = (st >> 1) * 16 + swz / 64; C = (st & 1) * 32 + (swz % 64) / 2; }
__host__ __device__ __forceinline__ int perm32(int rho) { const int n = rho >> 4, i = rho & 15; return 8 * (i >> 2) + 4 * n + (i & 3); }
struct Unit { const char* a; const char* b; int pm, pn, aux, pad; };
struct Gemm { int K, lda, ldb, kstepA, hstepA; };
template <bool I8> struct AccT { typedef f32x4 type; };
template <> struct AccT<true> { typedef i32x4 type; };
template <class Epi, class Sched, bool GATHER = false, bool I8 = false>
DI void gemm_phase(LAS unsigned char* lds, const Gemm g, const Sched& S, const Epi& E, int tid_in) {
    int tid = tid_in; asm volatile("" : "+v"(tid));
    const int wid = __builtin_amdgcn_readfirstlane(tid >> 6), lane = tid & 63, wr = wid >> 2, wc = wid & 3, fr = lane & 15, fq = lane >> 4;
    const int K = g.K, nt = K / BK;
    unsigned voffA[2], voffB[2];
#pragma unroll
    for (int i = 0; i < 2; ++i) { int R, C; stage_rc(tid * 16 + i * 8192, R, C); const int Rb = (R & ~31) + perm32(R & 31);
        voffA[i] = (unsigned)(R * g.lda + C) * 2u; voffB[i] = (unsigned)(Rb * g.ldb + C) * 2u; }
    const size_t kstep = (size_t)(BK * 2), kstepA = (size_t)g.kstepA;
    const size_t hstepA = g.hstepA < 0 ? (size_t)HALF * g.lda * 2 : (size_t)g.hstepA, hstepB = (size_t)HALF * g.ldb * 2;
    const unsigned hstepA32 = (unsigned)hstepA;
    unsigned gC[2][2] = {{0u, 0u}, {0u, 0u}}, gN[2][2] = {{0u, 0u}, {0u, 0u}};
    const unsigned ldsw = (unsigned)wid * 1024u;
    const int aoff = lds_byte(wr * 64 + fr, fq * 8), boff = lds_byte(wc * 32 + fr, fq * 8);
#define PG8_SA(b, h) (((b) * 2 + (h)) * HTB)
#define PG8_SB(b, h) ((4 + (b) * 2 + (h)) * HTB)
#define PG8_STAGE(bufoff, gbase, voff) do { _Pragma("unroll") for (int _i = 0; _i < 2; ++_i) \
        __builtin_amdgcn_global_load_lds((const unsigned*)((const char*)(gbase) + (voff)[_i]), (LAS unsigned*)(lds + (bufoff) + ldsw + _i * 8192), 16, 0, 0); } while (0)
#define PG8_STAGEA(bufoff, gbase, h, nextsel) do { _Pragma("unroll") for (int _i = 0; _i < 2; ++_i) { \
        const unsigned _o = GATHER ? ((nextsel) ? gN[h][_i] : gC[h][_i]) : (voffA[_i] + (unsigned)(h) * hstepA32); \
        __builtin_amdgcn_global_load_lds((const unsigned*)((const char*)(gbase) + _o), (LAS unsigned*)(lds + (bufoff) + ldsw + _i * 8192), 16, 0, 0); } } while (0)
#define PG8_LDA(dst, b, h) do { _Pragma("unroll") for (int m = 0; m < 4; ++m) _Pragma("unroll") for (int k = 0; k < 2; ++k) dst[m][k] = *(const LAS bf16x8*)(lds + PG8_SA(b, h) + aoff + m * 2048 + k * 1024); } while (0)
#define PG8_LDB(dst, b, h) do { _Pragma("unroll") for (int n = 0; n < 2; ++n) _Pragma("unroll") for (int k = 0; k < 2; ++k) dst[n][k] = *(const LAS bf16x8*)(lds + PG8_SB(b, h) + boff + n * 2048 + k * 1024); } while (0)
#define PG8_MMA(ai, bj, At, Bt) do { __builtin_amdgcn_s_setprio(1); _Pragma("unroll") for (int m = 0; m < 4; ++m) _Pragma("unroll") for (int n = 0; n < 2; ++n) _Pragma("unroll") for (int k = 0; k < 2; ++k) \
        { if constexpr (I8) acc[ai][bj][m][n] = __builtin_amdgcn_mfma_i32_16x16x64_i8(__builtin_bit_cast(i32x4, Bt[n][k]), __builtin_bit_cast(i32x4, At[m][k]), acc[ai][bj][m][n], 0, 0, 0); \
          else acc[ai][bj][m][n] = __builtin_amdgcn_mfma_f32_16x16x32_bf16(Bt[n][k], At[m][k], acc[ai][bj][m][n], 0, 0, 0); } __builtin_amdgcn_s_setprio(0); } while (0)
#define PG8_WAIT_V(n) asm volatile("s_waitcnt vmcnt(" #n ")" ::: "memory")
#define PG8_WAIT_L(n) asm volatile("s_waitcnt lgkmcnt(" #n ")" ::: "memory")
#define PG8_BAR __builtin_amdgcn_s_barrier()
#define PG8_SCHED __builtin_amdgcn_sched_barrier(0)
    Unit cur, nxt; int ui = 0;
    if (!S.next(0, cur)) return;
    typedef typename AccT<I8>::type ACC;
    ACC acc[2][2][4][2];
#pragma unroll
    for (int a = 0; a < 2; ++a)
#pragma unroll
        for (int b = 0; b < 2; ++b)
#pragma unroll
            for (int m = 0; m < 4; ++m)
#pragma unroll
                for (int n = 0; n < 2; ++n) acc[a][b][m][n] = (ACC){0, 0, 0, 0};
    bf16x8 At[4][2], B0[2][2], B1[2][2];
    const char* cA = cur.a; const char* cB = cur.b;
    if constexpr (GATHER) S.rows(cur, tid, gC);
    PG8_STAGE(PG8_SB(0, 0), cB, voffB); PG8_STAGE(PG8_SB(0, 1), cB + hstepB, voffB); PG8_STAGEA(PG8_SA(0, 0), cA, 0, false); PG8_STAGEA(PG8_SA(0, 1), cA, 1, false);
    if (wr == 1) PG8_BAR;
    PG8_WAIT_V(2); PG8_BAR;
    PG8_STAGE(PG8_SB(1, 0), cB + kstep, voffB); PG8_STAGEA(PG8_SA(1, 0), cA + kstepA, 0, false); PG8_STAGE(PG8_SB(1, 1), cB + hstepB + kstep, voffB);
    PG8_WAIT_V(6); PG8_BAR;
    for (;;) {
        const bool has_next = S.next(ui + 1, nxt);
        const char* nA = has_next ? nxt.a : cA; const char* nB = has_next ? nxt.b : cB;
        if constexpr (GATHER) { if (has_next) S.rows(nxt, tid, gN); else {
#pragma unroll
            for (int h = 0; h < 2; ++h) { gN[h][0] = gC[h][0]; gN[h][1] = gC[h][1]; } } }
        for (int t = 0; t < nt; t += 2) {
            const bool last = (t == nt - 2);
            const char* a1 = cA + (size_t)(t + 1) * kstepA;
            const char* a2 = last ? nA : cA + (size_t)(t + 2) * kstepA; const char* b2 = last ? nB : cB + (size_t)(t + 2) * kstep;
            const char* a3 = a2 + kstepA; const char* b3 = b2 + kstep;
            PG8_LDB(B0, 0, 0); PG8_LDB(B1, 0, 1); PG8_SCHED; PG8_LDA(At, 0, 0); PG8_STAGEA(PG8_SA(1, 1), a1, 1, false);
            PG8_WAIT_V(8); PG8_WAIT_L(0); PG8_BAR; PG8_MMA(0, 0, At, B0); PG8_MMA(0, 1, At, B1); PG8_BAR; PG8_SCHED;
            PG8_LDA(At, 0, 1); PG8_STAGE(PG8_SB(0, 0), b2, voffB); PG8_STAGE(PG8_SB(0, 1), b2 + hstepB, voffB); PG8_STAGEA(PG8_SA(0, 0), a2, 0, last);
            PG8_WAIT_V(8); PG8_WAIT_L(0); PG8_BAR; PG8_MMA(1, 0, At, B0); PG8_MMA(1, 1, At, B1); PG8_BAR; PG8_SCHED;
            PG8_LDB(B0, 1, 0); PG8_LDB(B1, 1, 1); PG8_SCHED; PG8_LDA(At, 1, 0); PG8_STAGEA(PG8_SA(0, 1), a2, 1, last);
            PG8_WAIT_V(8); PG8_WAIT_L(0); PG8_BAR; PG8_MMA(0, 0, At, B0); PG8_MMA(0, 1, At, B1); PG8_BAR; PG8_SCHED;
            PG8_LDA(At, 1, 1); PG8_STAGE(PG8_SB(1, 0), b3, voffB); PG8_STAGE(PG8_SB(1, 1), b3 + hstepB, voffB); PG8_STAGEA(PG8_SA(1, 0), a3, 0, last);
            PG8_WAIT_V(8); PG8_WAIT_L(0); PG8_BAR; PG8_MMA(1, 0, At, B0); PG8_MMA(1, 1, At, B1); PG8_BAR; PG8_SCHED;
        }
        if (wr == 0) PG8_BAR;
        { const int el = my_lane(); E(acc, cur, wr, wc, el & 15, el >> 4); }
        if (!has_next) break;
        bool carried = false;
        if constexpr (Epi::CARRY) { if (nxt.aux != 0) { const int el = my_lane(); E.carry(acc, nxt, wr, wc, el & 15, el >> 4); carried = true; } }
        if (!carried) {
#pragma unroll
        for (int a = 0; a < 2; ++a)
#pragma unroll
            for (int b = 0; b < 2; ++b)
#pragma unroll
                for (int m = 0; m < 4; ++m)
#pragma unroll
                    for (int n = 0; n < 2; ++n) acc[a][b][m][n] = (ACC){0, 0, 0, 0};
        }
        cur = nxt; cA = nA; cB = nB; ++ui;
        if constexpr (GATHER) {
#pragma unroll
            for (int h = 0; h < 2; ++h) { gC[h][0] = gN[h][0]; gC[h][1] = gN[h][1]; } }
        if (wr == 1) PG8_BAR;
    }
    PG8_WAIT_V(0);
    PG8_BAR;
#undef PG8_SA
#undef PG8_SB
#undef PG8_STAGE
#undef PG8_STAGEA
#undef PG8_LDA
#undef PG8_LDB
#undef PG8_MMA
#undef PG8_WAIT_V
#undef PG8_WAIT_L
#undef PG8_BAR
#undef PG8_SCHED
}
}
using pg8::Unit;

DI unsigned cvt_pk_bf16(float lo, float hi) { unsigned r; asm volatile("s_nop 1\n\tv_cvt_pk_bf16_f32 %0, %1, %2" : "=v"(r) : "v"(lo), "v"(hi)); return r; }
DI u32x4 pack8(const f32x4& v0, const f32x4& v1) { u32x4 w; w.x = cvt_pk_bf16(v0[0], v0[1]); w.y = cvt_pk_bf16(v0[2], v0[3]); w.z = cvt_pk_bf16(v1[0], v1[1]); w.w = cvt_pk_bf16(v1[2], v1[3]); return w; }

struct SchedP1 {
    const char* A; const char* B; int nM, nN, rbA, rbB, G, c;
    DI bool next(int i, Unit& u) const {
        constexpr int NXCD = 8, WGM = 8; const int nwg = nM * nN;
        const long L = (long)i * G + c; if (L >= nwg) return false;
        int wgid = (int)L; { const int q = nwg / NXCD, r = nwg % NXCD, xcd = wgid % NXCD, off = wgid / NXCD; wgid = (xcd < r ? xcd * (q + 1) : r * (q + 1) + (xcd - r) * q) + off; }
        const int nig = WGM * nN, gid = wgid / nig, fm = gid * WGM, gsz = (nM - fm) < WGM ? (nM - fm) : WGM;
        u.pm = fm + ((wgid % nig) % gsz); u.pn = (wgid % nig) / gsz; u.aux = 0; u.pad = 0;
        u.a = A + (size_t)u.pm * 256 * rbA; u.b = B + (size_t)u.pn * 256 * rbB; return true;
    }
};
struct SchedP3a {
    const char* ys; const char* wbr; int G, c;
    DI bool next(int i, Unit& u) const {
        const int tile = (i >> 2) * G + c; if (tile >= 512) return false;
        const int br = i & 3; u.pm = tile >> 2; u.pn = tile & 3; u.aux = br; u.pad = 0;
        u.a = ys + ((size_t)u.pm * 256 * 1024 + br * 256) * 2; u.b = wbr + ((size_t)br * 1024 * 256 + (size_t)u.pn * 256 * 256) * 2; return true;
    }
};
struct SchedP3b {
    const char* A; const char* B; int G, c;
    DI bool next(int i, Unit& u) const {
        const int L = i * G + c; if (L >= 512) return false;
        u.pm = L >> 2; u.pn = L & 3; u.aux = 0; u.pad = 0;
        u.a = A + (size_t)u.pm * 256 * 1024 * 2; u.b = B + (size_t)u.pn * 256 * 1024 * 2; return true;
    }
};
struct SchedM2 {
    const char* xr; const char* wgu; const LAS int* offt; const int* rowsrc; int G, c;
    DI bool next(int i, Unit& u) const {
        const int NT = __builtin_amdgcn_readfirstlane(offt[32]) >> 8; const int L = i * G + c; if (L >= NT * 2) return false;
        const int rt = L >> 1, pn = L & 1; const int e = __builtin_amdgcn_readfirstlane(offt[40 + rt]);
        u.pm = rt; u.pn = pn; u.aux = e; u.pad = 0;
        u.a = xr; u.b = wgu + ((size_t)e * 512 + pn * 256) * 1024 * 2; return true;
    }
    DI void rows(const Unit& u, int tid, unsigned (&g)[2][2]) const {
        const int e = u.aux; const int base = u.pm * 256 - __builtin_amdgcn_readfirstlane(offt[e]), cnt = __builtin_amdgcn_readfirstlane(offt[330 + e]);
#pragma unroll
        for (int i = 0; i < 2; ++i) { int R, C; pg8::stage_rc(tid * 16 + i * 8192, R, C);
#pragma unroll
            for (int h = 0; h < 2; ++h) { const int lr = base + h * 128 + R; const int as = lr < cnt ? rowsrc[e * 32768 + lr] : 0;
                g[h][i] = (unsigned)(as >> 1) * 4096u + (unsigned)C * 2u; } }
    }
};
struct SchedM3 {
    const char* hmid; const char* wd; const LAS int* offt; int G, c;
    DI bool next(int i, Unit& u) const {
        const int NT = __builtin_amdgcn_readfirstlane(offt[32]) >> 8; const int L = i * G + c; if (L >= NT * 4) return false;
        const int rt = L >> 2, pn = L & 3; const int e = __builtin_amdgcn_readfirstlane(offt[40 + rt]);
        u.pm = rt; u.pn = pn; u.aux = e; u.pad = 0;
        u.a = hmid + (size_t)rt * 256 * 256 * 2; u.b = wd + ((size_t)e * 1024 + pn * 256) * 256 * 2; return true;
    }
};

struct EpiP1I8 {
    static constexpr bool CARRY = false;
    bf16* proj; unsigned char* gates; const float* bgate; const float* hsc; const float* wsc;
    DI void operator()(const i32x4 (&acc)[2][2][4][2], const Unit& u, int wr, int wc, int fr, int fq) const {
        const int row0 = u.pm * 256 + wr * 64 + fr;
        if (u.pn < 10) { const int colt = u.pn * 256 + wc * 32 + 8 * fq;
            f32x4 sv[2][2]; float rsv[2][4];
#pragma unroll
            for (int bj = 0; bj < 2; ++bj)
#pragma unroll
                for (int n = 0; n < 2; ++n) sv[bj][n] = *(const GAS f32x4*)((const GAS float*)wsc + colt + bj * 128 + 4 * n);
#pragma unroll
            for (int ai = 0; ai < 2; ++ai)
#pragma unroll
                for (int m = 0; m < 4; ++m) rsv[ai][m] = ((const GAS float*)hsc)[row0 + ai * 128 + m * 16];
#pragma unroll
            for (int ai = 0; ai < 2; ++ai)
#pragma unroll
                for (int m = 0; m < 4; ++m) { bf16* rowp = proj + (size_t)(row0 + ai * 128 + m * 16) * PLD + colt; const float rs = rsv[ai][m];
#pragma unroll
                    for (int bj = 0; bj < 2; ++bj) { f32x4 v0, v1;
#pragma unroll
                        for (int e = 0; e < 4; ++e) { v0[e] = (float)acc[ai][bj][m][0][e] * (rs * sv[bj][0][e]); v1[e] = (float)acc[ai][bj][m][1][e] * (rs * sv[bj][1][e]); }
                        *(u32x4*)(rowp + bj * 128) = pack8(v0, v1); } }
            return; }
        const int gcol = (u.pn - 10) * 256 + wc * 32 + 8 * fq; const float* wsc = this->wsc + 2560;
        f32x4 bv[2][2], sv[2][2];
#pragma unroll
        for (int bj = 0; bj < 2; ++bj)
#pragma unroll
            for (int n = 0; n < 2; ++n) { bv[bj][n] = *(const f32x4*)(bgate + gcol + bj * 128 + 4 * n); sv[bj][n] = *(const f32x4*)(wsc + gcol + bj * 128 + 4 * n);
                sv[bj][n] = sv[bj][n] * -1.4426950408889634f; bv[bj][n] = bv[bj][n] * -1.4426950408889634f + (-8.f + 2.2e-5f); }
        float rsv[2][4];
#pragma unroll
        for (int ai = 0; ai < 2; ++ai)
#pragma unroll
            for (int m = 0; m < 4; ++m) rsv[ai][m] = ((const GAS float*)hsc)[row0 + ai * 128 + m * 16];
#pragma unroll
        for (int ai = 0; ai < 2; ++ai)
#pragma unroll
            for (int m = 0; m < 4; ++m) { const float rs = rsv[ai][m];
                unsigned char* rowp = gates + ((size_t)(u.pm * 16 + (u.pn - 10)) * 65536 + (size_t)((ai * 4 + m) * 8192 + (wr * 4 + wc) * 512 + (fq * 16 + fr) * 8));
#pragma unroll
                for (int bj = 0; bj < 2; ++bj) { unsigned q[8];
#pragma unroll
                    for (int n = 0; n < 2; ++n)
#pragma unroll
                        for (int e = 0; e < 4; ++e) { const float xe = ((float)acc[ai][bj][m][n][e] * rs) * sv[bj][n][e] + bv[bj][n][e];
                            q[4 * n + e] = (unsigned)__builtin_amdgcn_rcpf(0.00390631f + __builtin_amdgcn_exp2f(xe)); }
                    u32x2 w; w.x = q[0] | (q[1] << 8) | (q[2] << 16) | (q[3] << 24); w.y = q[4] | (q[5] << 8) | (q[6] << 16) | (q[7] << 24);
                    *(u32x2*)(rowp + bj * 4096) = w; }
                __builtin_amdgcn_sched_barrier(0); }
    }
};
struct EpiP3a {
    static constexpr bool CARRY = true;
    bf16* merged; const unsigned char* gates;
    DI void carry(f32x4 (&acc)[2][2][4][2], const Unit& u, int wr, int wc, int fr, int fq) const {
        const GAS unsigned char* gb = (const GAS unsigned char*)gates + (size_t)(u.pm * 16 + (u.aux - 1) * 4 + u.pn) * 65536;
        const unsigned go = (unsigned)((wr * 4 + wc) * 512 + (fq * 16 + fr) * 8);
        u32x2 gp[2][4][2], gn[2][4][2];
#pragma unroll
        for (int ai = 0; ai < 2; ++ai)
#pragma unroll
            for (int m = 0; m < 4; ++m)
#pragma unroll
                for (int bj = 0; bj < 2; ++bj) { gp[ai][m][bj] = *(const GAS u32x2*)(gb + go + (unsigned)(((ai * 4 + m) * 2 + bj) * 4096));
                    gn[ai][m][bj] = *(const GAS u32x2*)(gb + go + (unsigned)(((ai * 4 + m) * 2 + bj) * 4096 + 4 * 65536)); }
#pragma unroll
        for (int ai = 0; ai < 2; ++ai) {
#pragma unroll
            for (int m = 0; m < 4; ++m)
#pragma unroll
                for (int bj = 0; bj < 2; ++bj) {
#pragma unroll
                    for (int n = 0; n < 2; ++n) { const unsigned p4 = n ? gp[ai][m][bj].y : gp[ai][m][bj].x, n4 = n ? gn[ai][m][bj].y : gn[ai][m][bj].x;
#pragma unroll
                        for (int e = 0; e < 4; ++e) acc[ai][bj][m][n][e] *= ((float)((p4 >> (8 * e)) & 255u) + 0.5f) * __builtin_amdgcn_rcpf((float)((n4 >> (8 * e)) & 255u) + 0.5f); } }
            __builtin_amdgcn_sched_barrier(0); }
    }
    DI void operator()(const f32x4 (&acc)[2][2][4][2], const Unit& u, int wr, int wc, int fr, int fq) const {
        if (u.aux != 3) return;
        const GAS unsigned char* gb = (const GAS unsigned char*)gates + (size_t)(u.pm * 16 + 3 * 4 + u.pn) * 65536;
        GAS unsigned char* mb = (GAS unsigned char*)merged + ((size_t)(u.pm * 256) * 1024 + u.pn * 256) * 2;
        const unsigned go = (unsigned)((wr * 4 + wc) * 512 + (fq * 16 + fr) * 8), mo = (unsigned)((wr * 64 + fr) * 1024 + wc * 32 + 8 * fq) * 2u;
        u32x2 gw[2][4][2];
#pragma unroll
        for (int ai = 0; ai < 2; ++ai)
#pragma unroll
            for (int m = 0; m < 4; ++m)
#pragma unroll
                for (int bj = 0; bj < 2; ++bj) gw[ai][m][bj] = *(const GAS u32x2*)(gb + go + (unsigned)(((ai * 4 + m) * 2 + bj) * 4096));
#pragma unroll
        for (int ai = 0; ai < 2; ++ai) {
#pragma unroll
            for (int m = 0; m < 4; ++m)
#pragma unroll
                for (int bj = 0; bj < 2; ++bj) {
                    f32x4 v0 = acc[ai][bj][m][0], v1 = acc[ai][bj][m][1]; const u32x2 g2 = gw[ai][m][bj]; const float k256 = 0.00390625f;
#pragma unroll
                    for (int e = 0; e < 4; ++e) { v0[e] *= ((float)((g2.x >> (8 * e)) & 255u) + 0.5f) * k256; v1[e] *= ((float)((g2.y >> (8 * e)) & 255u) + 0.5f) * k256; }
                    *(GAS u32x4*)(mb + mo + (unsigned)((ai * 128 + m * 16) * 1024 + bj * 128) * 2u) = pack8(v0, v1); }
            __builtin_amdgcn_sched_barrier(0); }
    }
};
template <bool XF32> struct EpiP3b {
    static constexpr bool CARRY = false;
    const float* xin; bf16* xb_;
    DI void operator()(const f32x4 (&acc)[2][2][4][2], const Unit& u, int wr, int wc, int fr, int fq) const {
        GAS unsigned char* ob = (GAS unsigned char*)xb_ + ((size_t)(u.pm * 256) * 1024 + u.pn * 256) * 2;
        const unsigned lo = (unsigned)((wr * 64 + fr) * 1024 + wc * 32 + 8 * fq);
        if constexpr (XF32) {
            const GAS unsigned char* xb = (const GAS unsigned char*)xin + ((size_t)(u.pm * 256) * 1024 + u.pn * 256) * 4;
#pragma unroll
            for (int ai = 0; ai < 2; ++ai)
#pragma unroll
                for (int mh = 0; mh < 2; ++mh) {
                    f32x4 xv[2][2][2];
#pragma unroll
                    for (int m2 = 0; m2 < 2; ++m2)
#pragma unroll
                        for (int bj = 0; bj < 2; ++bj)
#pragma unroll
                            for (int n = 0; n < 2; ++n) xv[m2][bj][n] = *(const GAS f32x4*)(xb + (lo + (unsigned)((ai * 128 + (mh * 2 + m2) * 16) * 1024 + bj * 128 + 4 * n)) * 4u);
#pragma unroll
                    for (int m2 = 0; m2 < 2; ++m2)
#pragma unroll
                        for (int bj = 0; bj < 2; ++bj)
                            *(GAS u32x4*)(ob + (lo + (unsigned)((ai * 128 + (mh * 2 + m2) * 16) * 1024 + bj * 128)) * 2u) = pack8(xv[m2][bj][0] + acc[ai][bj][mh * 2 + m2][0], xv[m2][bj][1] + acc[ai][bj][mh * 2 + m2][1]);
                    __builtin_amdgcn_sched_barrier(0); }
        } else {
#pragma unroll
            for (int ai = 0; ai < 2; ++ai) {
                u32x4 xv[4][2];
#pragma unroll
                for (int m = 0; m < 4; ++m)
#pragma unroll
                    for (int bj = 0; bj < 2; ++bj) xv[m][bj] = *(const GAS u32x4*)(ob + (lo + (unsigned)((ai * 128 + m * 16) * 1024 + bj * 128)) * 2u);
#pragma unroll
                for (int m = 0; m < 4; ++m)
#pragma unroll
                    for (int bj = 0; bj < 2; ++bj) { const u32x4 x4 = xv[m][bj]; f32x4 v0 = acc[ai][bj][m][0], v1 = acc[ai][bj][m][1];
                        v0[0] += lo_bf(x4.x); v0[1] += hi_bf(x4.x); v0[2] += lo_bf(x4.y); v0[3] += hi_bf(x4.y); v1[0] += lo_bf(x4.z); v1[1] += hi_bf(x4.z); v1[2] += lo_bf(x4.w); v1[3] += hi_bf(x4.w);
                        *(GAS u32x4*)(ob + (lo + (unsigned)((ai * 128 + m * 16) * 1024 + bj * 128)) * 2u) = pack8(v0, v1); }
                __builtin_amdgcn_sched_barrier(0); }
        }
    }
};
struct EpiM2 {
    static constexpr bool CARRY = false;
    bf16* hmid;
    DI void operator()(const f32x4 (&acc)[2][2][4][2], const Unit& u, int wr, int wc, int fr, int fq) const {
        const int row0 = u.pm * 256 + wr * 64 + fr; const int col = u.pn * 128 + wc * 32 + 8 * fq;
#pragma unroll
        for (int ai = 0; ai < 2; ++ai)
#pragma unroll
            for (int m = 0; m < 4; ++m) { f32x4 h0, h1;
#pragma unroll
                for (int e = 0; e < 4; ++e) { const float g0 = acc[ai][0][m][0][e], g1 = acc[ai][0][m][1][e];
                    h0[e] = g0 * sigmoidf_(g0) * acc[ai][1][m][0][e]; h1[e] = g1 * sigmoidf_(g1) * acc[ai][1][m][1][e]; }
                *(u32x4*)(hmid + (size_t)(row0 + ai * 128 + m * 16) * 256 + col) = pack8(h0, h1); }
    }
};
struct EpiM3 {
    static constexpr bool CARRY = false;
    bf16* eo; const int* rowtok; const float* roww; const LAS int* offt;
    DI void operator()(const f32x4 (&acc)[2][2][4][2], const Unit& u, int wr, int wc, int fr, int fq) const {
        const int e = u.aux; const int cnt = __builtin_amdgcn_readfirstlane(offt[330 + e]);
        const int lr0 = u.pm * 256 - __builtin_amdgcn_readfirstlane(offt[e]) + wr * 64 + fr; const int colt = u.pn * 256 + wc * 32 + 8 * fq;
        int tk[2][4]; float wv[2][4];
#pragma unroll
        for (int ai = 0; ai < 2; ++ai)
#pragma unroll
            for (int m = 0; m < 4; ++m) { const int lr = lr0 + ai * 128 + m * 16; tk[ai][m] = -1; wv[ai][m] = 0.f;
                if (lr < cnt) { tk[ai][m] = ((const GAS int*)rowtok)[e * 32768 + lr]; wv[ai][m] = ((const GAS float*)roww)[e * 32768 + lr]; } }
#pragma unroll
        for (int ai = 0; ai < 2; ++ai)
#pragma unroll
            for (int m = 0; m < 4; ++m) {
                if (tk[ai][m] >= 0) { const float w = wv[ai][m]; GAS bf16* op = (GAS bf16*)eo + (size_t)tk[ai][m] * 1024 + colt;
#pragma unroll
                    for (int bj = 0; bj < 2; ++bj) *(GAS u32x4*)(op + bj * 128) = pack8(acc[ai][bj][m][0] * w, acc[ai][bj][m][1] * w); }
                __builtin_amdgcn_sched_barrier(0); }
    }
};

struct Args { const float* in[36]; float* out; unsigned char* ws; int ph_lo, ph_hi; };
struct InTab { unsigned base;
    DI const float* operator[](int i) const { unsigned long long v; const unsigned addr = base + (unsigned)i * 8u;
        asm volatile("ds_read_b64 %0, %1\n\ts_waitcnt lgkmcnt(0)" : "=v"(v) : "v"(addr) : "memory");
        const unsigned lo = __builtin_amdgcn_readfirstlane((unsigned)v), hi = __builtin_amdgcn_readfirstlane((unsigned)(v >> 32));
        return (const float*)(((unsigned long long)hi << 32) | lo); } };
struct KA { InTab in; float* out; unsigned char* ws; };

DI void transpose_item(const float* W_, int ldw, int nvalid, bf16* WT_, int ldt, int k0, int n0, int dst_row0, LAS float* scr, int lane) {
    const GAS float* W = (const GAS float*)W_; GAS bf16* WT = (GAS bf16*)WT_;
    const int nq = 4 * (lane & 7), kr8 = lane >> 3;
    f32x4 v[8];
#pragma unroll
    for (int i = 0; i < 8; ++i) { const int kk = 8 * i + kr8;
        if (n0 + nq + 3 < nvalid) v[i] = *(const GAS f32x4*)(W + (size_t)(k0 + kk) * ldw + n0 + nq);
        else {
#pragma unroll
            for (int e = 0; e < 4; ++e) v[i][e] = (n0 + nq + e < nvalid) ? W[(size_t)(k0 + kk) * ldw + n0 + nq + e] : 0.f; } }
#pragma unroll
    for (int i = 0; i < 8; ++i) { const int kk = 8 * i + kr8;
#pragma unroll
        for (int e = 0; e < 4; ++e) scr[kk * 33 + nq + e] = v[i][e]; }
    LDS_WAIT(); asm volatile("" ::: "memory");
    const int c = lane & 7;
#pragma unroll
    for (int j = 0; j < 4; ++j) { const int n = (lane >> 3) + 8 * j; const LAS float* s = scr + (8 * c) * 33 + n;
        u32x4 o; o.x = pk2(s[0 * 33], s[1 * 33]); o.y = pk2(s[2 * 33], s[3 * 33]); o.z = pk2(s[4 * 33], s[5 * 33]); o.w = pk2(s[6 * 33], s[7 * 33]);
        if (n0 + n < nvalid) *(GAS u32x4*)(WT + (size_t)(dst_row0 + n) * ldt + k0 + 8 * c) = o; }
    LDS_WAIT(); asm volatile("" ::: "memory");
}
DI void phase0_weights(const KA& a, int l, LAS unsigned char* lds, int gw, int NGW, int wave, int lane) {
    LAS float* scr = (LAS float*)(lds + wave * 16384);
    const float* w_in = a.in[4] + (size_t)l * 1024 * NIN;
    const float* w_gate = a.in[24] + (size_t)l * 4 * 1024 * 1024;
    const float* w_br = a.in[26] + (size_t)l * 4 * 256 * 1024;
    const float* w_out = a.in[27] + (size_t)l * 1024 * 1024;
    bf16* Wt_in = (bf16*)(a.ws + WS_WIN); bf16* Wt_br = (bf16*)(a.ws + WS_WBR); bf16* Wt_out = (bf16*)(a.ws + WS_WOUT);
    constexpr int I_B = 4 * 4 * 32, I_O = 16 * 32, NIT = I_B + I_O;
    (void)w_gate; (void)w_in; (void)Wt_in;
    for (int it = gw; it < NIT; it += NGW) {
        int r = it;
        if (r < I_B) { const int br = r / 128, q = r % 128, kb = q / 32, nb = q % 32; transpose_item(w_br + (size_t)br * 256 * 1024, 1024, 1024, Wt_br + (size_t)br * 1024 * 256, 256, kb * 64, nb * 32, nb * 32, scr, lane); continue; } r -= I_B;
        { const int kb = r / 32, nb = r % 32; transpose_item(w_out, 1024, 1024, Wt_out, 1024, kb * 64, nb * 32, nb * 32, scr, lane); }
    }
}
DI void p1_weights_i8(const KA& a, int l, LAS unsigned char* lds, int gw, int NGW, int wave, int lane) {
    LAS float* scr = (LAS float*)(lds + wave * 16384);
    const GAS float* wgt = (const GAS float*)(a.in[24] + (size_t)l * 4 * 1024 * 1024); const GAS float* win = (const GAS float*)(a.in[4] + (size_t)l * 1024 * NIN);
    GAS unsigned char* Wq = (GAS unsigned char*)(a.ws + WS_WQ); GAS float* wsc = (GAS float*)(a.ws + WS_WSC);
    const int nq = 4 * (lane & 7), kr8 = lane >> 3;
    for (int it = NGW - 1 - gw; it < 128 + 77; it += NGW) {
        const bool isg = it < 128; const int br = it >> 5; const int n0 = isg ? (it & 31) * 32 : (it - 128) * 32;
        const int ldw = isg ? 1024 : NIN; const int nval = isg ? 1024 : NIN; const int drow0 = isg ? 2560 + br * 1024 + n0 : n0;
        const bool lok = (n0 + nq) < nval;
        const GAS float* W = (isg ? wgt + (size_t)br * 1024 * 1024 : win) + n0 + nq;
        f32x4 mx = {0.f, 0.f, 0.f, 0.f};
#pragma unroll 8
        for (int i = 0; i < 128; ++i) { f32x4 v = {0.f, 0.f, 0.f, 0.f}; if (lok) v = *(const GAS f32x4*)(W + (size_t)(8 * i + kr8) * ldw);
            mx[0] = fmaxf(mx[0], fabsf(v[0])); mx[1] = fmaxf(mx[1], fabsf(v[1])); mx[2] = fmaxf(mx[2], fabsf(v[2])); mx[3] = fmaxf(mx[3], fabsf(v[3])); }
#pragma unroll
        for (int e = 0; e < 4; ++e) { float m = mx[e]; m = fmaxf(m, xshfl<8>(m)); m = fmaxf(m, xshfl<16>(m)); m = fmaxf(m, xshfl<32>(m)); mx[e] = fmaxf(m, 1e-20f); }
        if (kr8 == 0 && lok) *(GAS f32x4*)(wsc + drow0 + nq) = mx * (1.f / 127.f);
        const f32x4 qs = {127.f / mx[0], 127.f / mx[1], 127.f / mx[2], 127.f / mx[3]};
#pragma unroll 1
        for (int kb = 0; kb < 16; ++kb) {
            f32x4 v[8];
#pragma unroll
            for (int i = 0; i < 8; ++i) { v[i] = (f32x4){0.f, 0.f, 0.f, 0.f}; if (lok) v[i] = *(const GAS f32x4*)(W + (size_t)(kb * 64 + 8 * i + kr8) * ldw); }
#pragma unroll
            for (int i = 0; i < 8; ++i) { const int kk = 8 * i + kr8;
#pragma unroll
                for (int e = 0; e < 4; ++e) scr[kk * 33 + nq + e] = __builtin_rintf(v[i][e] * qs[e]); }
            LDS_WAIT(); asm volatile("" ::: "memory");
            const int n = lane >> 1, kh = lane & 1; u32x4 o[2];
#pragma unroll
            for (int h2 = 0; h2 < 2; ++h2) { unsigned w4[4];
#pragma unroll
                for (int d = 0; d < 4; ++d) { unsigned wv = 0u;
#pragma unroll
                    for (int e = 0; e < 4; ++e) wv |= ((unsigned)(int)scr[(32 * kh + 16 * h2 + 4 * d + e) * 33 + n] & 255u) << (8 * e);
                    w4[d] = wv; }
                o[h2].x = w4[0]; o[h2].y = w4[1]; o[h2].z = w4[2]; o[h2].w = w4[3]; }
            if (n0 + n < nval) { GAS unsigned char* dst = Wq + (size_t)(drow0 + n) * 1024 + kb * 64 + 32 * kh; *(GAS u32x4*)dst = o[0]; *(GAS u32x4*)(dst + 16) = o[1]; }
            LDS_WAIT(); asm volatile("" ::: "memory");
        }
    }
}

DI void router_weights(const KA& a, int l, int gw, int NGW, int lane) {
    bf16* Wr = (bf16*)(a.ws + WS_WR);
    const float* wg = a.in[29] + (size_t)l * 1024 * 4; const float* we = a.in[31] + (size_t)l * 1024 * 32;
    for (int n = gw; n < 36; n += NGW) {
        for (int i = 0; i < 16; ++i) { const int k = lane + 64 * i; const float w = (n < 4) ? wg[k * 4 + n] : we[k * 32 + (n - 4)];
            const unsigned hi = f2bf(w); const float hf = __builtin_bit_cast(float, hi << 16); const unsigned lo = f2bf(w - hf);
            Wr[(size_t)n * 2048 + k] = (bf16)hi; Wr[(size_t)n * 2048 + 1024 + k] = (bf16)hi; Wr[(size_t)(64 + n) * 2048 + k] = (bf16)lo; Wr[(size_t)(64 + n) * 2048 + 1024 + k] = 0; }
    }
}

DI void cmp_weights(const KA& a, int l, LAS unsigned char* lds, int gw, int NGW, int wave, int lane) {
    LAS float* scr = (LAS float*)(lds + wave * 16384);
    bf16* Wc = (bf16*)(a.ws + WS_WCMP); float* pt = (float*)(a.ws + WS_CMPAB + 2 * MiB);
    for (int it = gw; it < 128 + 64; it += NGW) {
        if (it < 128) { const int kv = it >> 6, q = it & 63, kb = q >> 1, nb = q & 1; const float* w1 = a.in[kv ? 22 : 19] + (size_t)l * 2048 * 64;
            bf16* dst = Wc + (size_t)kv * 256 * 1024 - (kb >= 16 ? 1024 : 0);
            transpose_item(w1, 64, 64, dst, 1024, kb * 64, nb * 32, (kb >= 16 ? 64 : 0) + nb * 32, scr, lane);
        } else { const int kv = (it - 128) >> 5, part = (it - 128) & 31;
            const GAS float* w1 = (const GAS float*)(a.in[kv ? 22 : 19] + (size_t)l * 2048 * 64) + (size_t)part * 64 * 64; const GAS float* pos = (const GAS float*)(a.in[kv ? 21 : 18] + (size_t)l * 2048) + part * 64;
            float acc = 0.f;
#pragma unroll 16
            for (int k = 0; k < 64; ++k) acc += pos[k] * w1[(size_t)k * 64 + lane];
            pt[(kv * 32 + part) * 64 + lane] = acc; }
    }
}

DI void lru_weights(const KA& a, int l, int gw, int NGW, int lane) {
    bf16* W = (bf16*)(a.ws + WS_LRUW); const float* wa = a.in[7] + (size_t)l * 4 * 4096; const float* wx = a.in[9] + (size_t)l * 4 * 4096;
    (void)NGW; { const int idx = gw * 64 + lane; if (idx < 32768) { const int i = idx & 63, j = (idx >> 6) & 63, mat = (idx >> 12) & 1, hbk = idx >> 13;
        W[idx] = (bf16)f2bf((mat ? wx : wa)[(size_t)hbk * 4096 + i * 64 + j]); } }
}
DI void phase0_rows(const KA& a, int l, int mode, int gw, int NGW, int lane) {
    const GAS float* xin = (const GAS float*)a.in[0]; GAS bf16* xb = (GAS bf16*)(a.ws + WS_XB);
    const GAS bf16* eo = (const GAS bf16*)(a.ws + WS_PROJ);
    GAS float* outp = (GAS float*)a.out;
    const GAS float* g = (const GAS float*)(mode ? a.in[2] : (a.in[3] + (size_t)l * 1024));
    f32x4 gv[4];
#pragma unroll
    for (int j = 0; j < 4; ++j) gv[j] = *(const GAS f32x4*)(g + 4 * (lane + 64 * j));
    for (int m0 = gw * 4; m0 < T; m0 += NGW * 4) {
        f32x4 v[4][4]; float ss[4];
#pragma unroll
        for (int rr = 0; rr < 4; ++rr)
#pragma unroll
            for (int j = 0; j < 4; ++j) { if (l == 0) v[rr][j] = *(const GAS f32x4*)(xin + (size_t)(m0 + rr) * 1024 + 4 * (lane + 64 * j));
                else { const u32x2 xw = *(const GAS u32x2*)(xb + (size_t)(m0 + rr) * 1024 + 4 * (lane + 64 * j)); v[rr][j][0] = lo_bf(xw.x); v[rr][j][1] = hi_bf(xw.x); v[rr][j][2] = lo_bf(xw.y); v[rr][j][3] = hi_bf(xw.y); } }
        if (l > 0) {
#pragma unroll
            for (int rr = 0; rr < 4; ++rr)
#pragma unroll
                for (int j = 0; j < 4; ++j) {
                    const u32x2 e0 = *(const GAS u32x2*)(eo + (size_t)(2 * (m0 + rr)) * 1024 + 4 * (lane + 64 * j));
                    const u32x2 e1 = *(const GAS u32x2*)(eo + (size_t)(2 * (m0 + rr) + 1) * 1024 + 4 * (lane + 64 * j));
                    v[rr][j][0] += lo_bf(e0.x) + lo_bf(e1.x); v[rr][j][1] += hi_bf(e0.x) + hi_bf(e1.x); v[rr][j][2] += lo_bf(e0.y) + lo_bf(e1.y); v[rr][j][3] += hi_bf(e0.y) + hi_bf(e1.y); } }
#pragma unroll
        for (int rr = 0; rr < 4; ++rr) { float t = 0.f;
#pragma unroll
            for (int j = 0; j < 4; ++j) t += (v[rr][j][0] * v[rr][j][0] + v[rr][j][1] * v[rr][j][1]) + (v[rr][j][2] * v[rr][j][2] + v[rr][j][3] * v[rr][j][3]);
            ss[rr] = t; }
#pragma unroll
        for (int rr = 0; rr < 4; ++rr) ss[rr] = wave_sum(ss[rr]);
        if (mode) {
#pragma unroll
            for (int rr = 0; rr < 4; ++rr) { const float r = 1.f / sqrtf(ss[rr] * (1.f / 1024.f) + 1e-6f); const size_t m = (size_t)(m0 + rr);
#pragma unroll
                for (int j = 0; j < 4; ++j) *(GAS f32x4*)(outp + m * 1024 + 4 * (lane + 64 * j)) = v[rr][j] * r * gv[j]; }
        } else {
            GAS unsigned char* hq = (GAS unsigned char*)(a.ws + WS_HQ); GAS float* hsc = (GAS float*)(a.ws + WS_HSC);
            float am[4];
#pragma unroll
            for (int rr = 0; rr < 4; ++rr) { const float r = 1.f / sqrtf(ss[rr] * (1.f / 1024.f) + 1e-6f); const size_t m = (size_t)(m0 + rr); float t = 0.f;
#pragma unroll
                for (int j = 0; j < 4; ++j) { if (l > 0) { u32x2 w; w.x = pk2(v[rr][j][0], v[rr][j][1]); w.y = pk2(v[rr][j][2], v[rr][j][3]); *(GAS u32x2*)(xb + m * 1024 + 4 * (lane + 64 * j)) = w; }
                    const f32x4 y = v[rr][j] * r * gv[j]; v[rr][j] = y;
                    t = fmaxf(t, fmaxf(fmaxf(fabsf(y[0]), fabsf(y[1])), fmaxf(fabsf(y[2]), fabsf(y[3])))); }
                am[rr] = t; }
#pragma unroll
            for (int rr = 0; rr < 4; ++rr) am[rr] = fmaxf(wave_max(am[rr]), 1e-20f);
#pragma unroll
            for (int rr = 0; rr < 4; ++rr) { const size_t m = (size_t)(m0 + rr); const float qs = 127.f / am[rr];
                if (lane == 0) hsc[m] = am[rr] * (1.f / 127.f);
#pragma unroll
                for (int j = 0; j < 4; ++j) { const f32x4 y = v[rr][j] * qs;
                    const unsigned q = ((unsigned)(int)__builtin_rintf(y[0]) & 255u) | (((unsigned)(int)__builtin_rintf(y[1]) & 255u) << 8) | (((unsigned)(int)__builtin_rintf(y[2]) & 255u) << 16) | (((unsigned)(int)__builtin_rintf(y[3]) & 255u) << 24);
                    *(GAS unsigned*)(hq + m * 1024 + 4 * (lane + 64 * j)) = q; } }
        }
    }
}

DI int crow(int i, int hh) { return (i & 3) + 8 * (i >> 2) + 4 * hh; }
DI unsigned cvtpk(float lo, float hi) { f32x2 v = {lo, hi}; bf16x2_t b = __builtin_convertvector(v, bf16x2_t); return __builtin_bit_cast(unsigned, b); }
template <int CTRL, int RMASK> DI float dppf(float oldv, float v) { return __builtin_bit_cast(float, __builtin_amdgcn_update_dpp(__builtin_bit_cast(int, oldv), __builtin_bit_cast(int, v), CTRL, RMASK, 0xf, false)); }
template <int CTRL, int RMASK> DI void scan_step(float& a, float& b) {
    const float ap = dppf<CTRL, RMASK>(1.f, a), bp = dppf<CTRL, RMASK>(0.f, b); b = a * bp + b; a = a * ap; }
DI void lru_unit(const KA& a, int l, const GAS bf16* proj, GAS bf16* ys, GAS float* sums, LAS unsigned char* lds, int task, int lane_in, int wave_in, bool final) {
    int lane = lane_in, wave = wave_in; asm volatile("" : "+v"(lane), "+s"(wave));
    const int chunk = task & 31, hbk = (task >> 5) & 3, b = task >> 7;
    const int ts = chunk * 256 + wave * 32; const size_t rowb = (size_t)b * SEQ;
    LAS unsigned char* wl = lds + wave * 16384;
    LAS float* ex = (LAS float*)(lds + LRUEX_OFF); LAS float* cst = (LAS float*)(lds + LRUCST_OFF); LAS float* car = (LAS float*)(lds + LRUCAR_OFF) + wave * 64;
    {
        const int c = hbk * 64 + lane;
        const GAS float* cw = (const GAS float*)(a.in[5] + (size_t)l * 4 * 256);
        const float cw0 = cw[c], cw1 = cw[256 + c], cw2 = cw[512 + c], cw3 = cw[768 + c]; const float cb = a.in[6][l * 256 + c];
        if (wave == 0) { cst[lane] = a.in[8][l * 256 + c]; cst[64 + lane] = a.in[10][l * 256 + c]; cst[128 + lane] = -8.f * softplusf_(-a.in[11][l * 256 + c]); }
        const GAS bf16* xp = proj + (rowb + ts) * PLD + C_AX + c;
        float x3 = (ts >= 3) ? bf2f(*(xp - 3 * PLD)) : 0.f, x2 = (ts >= 2) ? bf2f(*(xp - 2 * PLD)) : 0.f, x1 = (ts >= 1) ? bf2f(*(xp - PLD)) : 0.f;
#pragma unroll 8
        for (int n = 0; n < 32; ++n) { const float x0 = bf2f(xp[(size_t)n * PLD]); const float xc = cb + cw0 * x3 + cw1 * x2 + cw2 * x1 + cw3 * x0;
            *(LAS bf16*)(wl + n * 144 + lane * 2) = (bf16)f2bf(xc); *(LAS float*)(wl + 4608 + n * 272 + lane * 4) = xc; x3 = x2; x2 = x1; x1 = x0; }
    }
    const int n = lane & 31, hh = lane >> 5;
    f32x16 D[4];
    {
        const GAS bf16* wt = (const GAS bf16*)(a.ws + WS_LRUW) + (size_t)hbk * 8192;
        bf16x8 bfr[4];
        LDS_WAIT();
#pragma unroll
        for (int s4 = 0; s4 < 4; ++s4) bfr[s4] = *(const LAS bf16x8*)(wl + n * 144 + hh * 16 + s4 * 32);
#pragma unroll
        for (int m = 0; m < 4; ++m) {
#pragma unroll
            for (int s4 = 0; s4 < 4; ++s4) { const bf16x8 af = *(const GAS bf16x8*)(wt + (size_t)(m >> 1) * 4096 + (32 * (m & 1) + n) * 64 + 8 * hh + 16 * s4);
                if (s4 == 0) { f32x16 z;
#pragma unroll
                    for (int i = 0; i < 16; ++i) z[i] = 0.f;
                    D[m] = MFMA32(af, bfr[s4], z); } else D[m] = MFMA32(af, bfr[s4], D[m]); } }
    }
    __syncthreads();
    const bool t0 = (ts + n) == 0;
#pragma unroll
    for (int mm = 0; mm < 2; ++mm)
#pragma unroll
        for (int g4 = 0; g4 < 4; ++g4) { const int c0 = 32 * mm + 8 * g4 + 4 * hh;
            const f32x4 vba = *(const LAS f32x4*)(cst + c0), vbx = *(const LAS f32x4*)(cst + 64 + c0), vc8 = *(const LAS f32x4*)(cst + 128 + c0);
            const f32x4 vxc = *(const LAS f32x4*)(wl + 4608 + n * 272 + c0 * 4);
#pragma unroll
            for (int e = 0; e < 4; ++e) { const int i = 4 * g4 + e;
                const float r = sigmoidf_(D[mm][i] + vba[e]), ig = sigmoidf_(D[2 + mm][i] + vbx[e]);
                const float la = vc8[e] * r; const float av = __expf(la);
                const float mult = t0 ? 1.f : sqrtf(fmaxf(1.f - __expf(2.f * la), 0.f));
                float aa = av, bb = mult * ig * vxc[e];
                scan_step<0x111, 0xf>(aa, bb); scan_step<0x112, 0xf>(aa, bb); scan_step<0x114, 0xf>(aa, bb); scan_step<0x118, 0xf>(aa, bb); scan_step<0x142, 0xa>(aa, bb);
                D[mm][i] = aa; D[2 + mm][i] = bb; } }
    if (n == 31) {
#pragma unroll
        for (int mm = 0; mm < 2; ++mm)
#pragma unroll
            for (int i = 0; i < 16; ++i) { const int c = 32 * mm + crow(i, hh); ex[(wave * 64 + c) * 2] = D[mm][i]; ex[(wave * 64 + c) * 2 + 1] = D[2 + mm][i]; } }
    __syncthreads();
    if (!final) {
        if (wave == 0) { float hv = 0.f, av = 1.f;
#pragma unroll
            for (int w = 0; w < 8; ++w) { const float A_ = ex[(w * 64 + lane) * 2], H_ = ex[(w * 64 + lane) * 2 + 1]; hv = A_ * hv + H_; av *= A_; }
            GAS float* sp = sums + ((size_t)((b * 4 + hbk) * 32 + chunk) * 64 + lane) * 2; sp[0] = av; sp[1] = hv; }
    } else {
        {   float hv = 0.f;
            {   const GAS f32x2* sp = (const GAS f32x2*)(sums + ((size_t)((b * 4 + hbk) * 32) * 64 + lane) * 2);
                int cc = 0;
                for (; cc + 8 <= chunk; cc += 8) { f32x2 v[8];
#pragma unroll
                    for (int e = 0; e < 8; ++e) v[e] = sp[(size_t)(cc + e) * 64];
#pragma unroll
                    for (int e = 0; e < 8; ++e) hv = v[e][0] * hv + v[e][1]; }
                for (; cc < chunk; ++cc) { const f32x2 v = sp[(size_t)cc * 64]; hv = v[0] * hv + v[1]; } }
            for (int w = 0; w < wave; ++w) { const float A_ = ex[(w * 64 + lane) * 2], H_ = ex[(w * 64 + lane) * 2 + 1]; hv = A_ * hv + H_; }
            car[lane] = hv; }
        LDS_WAIT(); asm volatile("" ::: "memory");
        const GAS bf16* gp = proj + (rowb + ts + n) * PLD + C_AG + hbk * 64; GAS bf16* yp = ys + (rowb + ts + n) * 1024 + hbk * 64;
#pragma unroll
        for (int mm = 0; mm < 2; ++mm)
#pragma unroll
            for (int g4 = 0; g4 < 4; ++g4) { const int c0 = 32 * mm + 8 * g4 + 4 * hh; const f32x4 cv = *(const LAS f32x4*)(car + c0);
                const u32x2 gt2 = *(const GAS u32x2*)(gp + c0); float y[4];
#pragma unroll
                for (int e = 0; e < 4; ++e) { const int i = 4 * g4 + e; const float hv = D[2 + mm][i] + D[mm][i] * cv[e];
                    const float gt = (e == 0) ? lo_bf(gt2.x) : (e == 1) ? hi_bf(gt2.x) : (e == 2) ? lo_bf(gt2.y) : hi_bf(gt2.y); y[e] = hv * gelu_tanh(gt); }
                u32x2 yo; yo.x = cvtpk(y[0], y[1]); yo.y = cvtpk(y[2], y[3]); *(GAS u32x2*)(yp + c0) = yo; }
    }
    __syncthreads();
}

constexpr int DK_STR = 144, DV_STR = 192, DBUF_BYTES = 64 * DK_STR + 64 * DV_STR;
DI bf16x8 pack_half(const f32x16& x, int s2) { u32x4 p;
    if (s2 == 0) { p.x = cvtpk(x[0], x[1]); p.y = cvtpk(x[2], x[3]); p.z = cvtpk(x[4], x[5]); p.w = cvtpk(x[6], x[7]); }
    else { p.x = cvtpk(x[8], x[9]); p.y = cvtpk(x[10], x[11]); p.z = cvtpk(x[12], x[13]); p.w = cvtpk(x[14], x[15]); }
    return __builtin_bit_cast(bf16x8, p); }
DI s16x4 vtr(const LAS unsigned char* p) { return __builtin_bit_cast(s16x4, __builtin_amdgcn_ds_read_tr16_b64_v4i16((LAS v4i16_t*)p)); }
DI float max16(const f32x16& x) { float a = fmaxf(fmaxf(x[0], x[1]), fmaxf(x[2], x[3])), b = fmaxf(fmaxf(x[4], x[5]), fmaxf(x[6], x[7])), c = fmaxf(fmaxf(x[8], x[9]), fmaxf(x[10], x[11])), d = fmaxf(fmaxf(x[12], x[13]), fmaxf(x[14], x[15])); return fmaxf(fmaxf(a, b), fmaxf(c, d)); }
DI void diff_unit(const GAS bf16* proj, GAS bf16* ys, LAS unsigned char* lds, const LAS float* bias2, const GAS float* subg, const LAS float* lamp, int b, int h, int qb, int wave_in) {
    int wave = wave_in; asm volatile("" : "+s"(wave)); const int lane = my_lane(); const int tid = wave * 64 + lane;
    const int q0 = qb * 256 + wave * 32; const int ql = lane & 31, hh = lane >> 5; const int q = q0 + ql;
    const size_t rowb = (size_t)b * SEQ;
    const float SC = 0.17677669529663687f * 1.4426950408889634f;
    bf16x8 qf[2][2];
    { const GAS bf16* qp = proj + (rowb + q) * PLD + C_CQ + h * 64 + hh * 8;
#pragma unroll
      for (int m = 0; m < 2; ++m)
#pragma unroll
        for (int s = 0; s < 2; ++s) { const u32x4 w = *(const GAS u32x4*)(qp + m * 32 + s * 16); u32x4 o;
            o.x = cvtpk(lo_bf(w.x) * SC, hi_bf(w.x) * SC); o.y = cvtpk(lo_bf(w.y) * SC, hi_bf(w.y) * SC); o.z = cvtpk(lo_bf(w.z) * SC, hi_bf(w.z) * SC); o.w = cvtpk(lo_bf(w.w) * SC, hi_bf(w.w) * SC);
            qf[m][s] = __builtin_bit_cast(bf16x8, o); } }
    f32x16 O[2][2], negm[2];
#pragma unroll
    for (int i = 0; i < 16; ++i) { O[0][0][i] = 0.f; O[0][1][i] = 0.f; O[1][0][i] = 0.f; O[1][1][i] = 0.f; negm[0][i] = 120.f; negm[1][i] = 120.f; }
    float lsum[2] = {0.f, 0.f};
    const int nsteps = 4 * qb + 4, mysteps = 4 * qb + (wave >> 1) + 1;
    const int skey = tid >> 3, sch = tid & 7;
    const GAS unsigned char* kgb = (const GAS unsigned char*)(proj + rowb * PLD + C_CK + h * 64);
    const GAS unsigned char* vgb = (const GAS unsigned char*)(proj + rowb * PLD + C_CV + h * 64);
    const unsigned soff = (unsigned)(skey * PLD + sch * 8) * 2u;
    u32x4 kr = *(const GAS u32x4*)(kgb + soff), vr = *(const GAS u32x4*)(vgb + soff);
    *(LAS u32x4*)(lds + skey * DK_STR + sch * 16) = kr; *(LAS u32x4*)(lds + 64 * DK_STR + skey * DV_STR + sch * 16) = vr;
    __syncthreads();
    const int i16 = lane & 15, blk = (lane >> 4) & 1;
    const int kboff = ql * DK_STR + hh * 16;
    const int vboff = 64 * DK_STR + (4 * hh + (i16 >> 2)) * DV_STR + (16 * blk + 4 * (i16 & 3)) * 2;
#pragma unroll 1
    for (int kt = 0; kt < nsteps; ++kt) {
        const LAS unsigned char* cur = lds + (kt & 1) * DBUF_BYTES; LAS unsigned char* nxt = lds + ((kt + 1) & 1) * DBUF_BYTES;
        if (kt + 1 < nsteps) { const unsigned so = soff + (unsigned)(kt + 1) * (64u * PLD * 2u); kr = *(const GAS u32x4*)(kgb + so); vr = *(const GAS u32x4*)(vgb + so); }
        if (kt < mysteps) {
            const int kbase = kt * 64;
            const bool near = (q0 - (kbase + 63) < 113);
#pragma unroll
            for (int m = 0; m < 2; ++m) {
                bf16x8 pk[2][2];
                f32x16 S[2]; float ts = 0.f;
                {   bf16x8 kf[2][2];
#pragma unroll
                    for (int t = 0; t < 2; ++t)
#pragma unroll
                        for (int s = 0; s < 2; ++s) kf[t][s] = *(const LAS bf16x8*)(cur + kboff + t * 32 * DK_STR + m * 64 + s * 32);
#pragma unroll
                    for (int t = 0; t < 2; ++t) { S[t] = MFMA32(kf[t][0], qf[m][0], negm[m]); S[t] = MFMA32(kf[t][1], qf[m][1], S[t]); } }
                if (near) {
#pragma unroll
                    for (int t = 0; t < 2; ++t)
#pragma unroll
                        for (int g = 0; g < 2; ++g) { float tb[8];
#pragma unroll
                            for (int j = 0; j < 8; ++j) { const int dist = q - (kbase + 32 * t + crow(8 * g + j, hh)); const int di = dist < 0 ? 0 : (dist < 128 ? dist : 128); tb[j] = bias2[di * 12 + 4 + h]; }
#pragma unroll
                            for (int j = 0; j < 8; ++j) { const int dist = q - (kbase + 32 * t + crow(8 * g + j, hh)); S[t][8 * g + j] += dist >= 0 ? tb[j] : -1e30f; }
                            __builtin_amdgcn_sched_barrier(0); } }
#pragma unroll
                for (int t = 0; t < 2; ++t)
#pragma unroll
                    for (int i = 0; i < 16; ++i) { const float p = __builtin_amdgcn_exp2f(S[t][i]); S[t][i] = p; ts += p; }
                if (__builtin_amdgcn_ballot_w64(!(ts < 1.0e30f)) != 0ull) {
                {   bf16x8 kf[2][2];
#pragma unroll
                        for (int t = 0; t < 2; ++t)
#pragma unroll
                            for (int s = 0; s < 2; ++s) kf[t][s] = *(const LAS bf16x8*)(cur + kboff + t * 32 * DK_STR + m * 64 + s * 32);
#pragma unroll
                        for (int t = 0; t < 2; ++t) { S[t] = MFMA32(kf[t][0], qf[m][0], negm[m]); S[t] = MFMA32(kf[t][1], qf[m][1], S[t]); } }
                    if (near) {
#pragma unroll
                        for (int t = 0; t < 2; ++t)
#pragma unroll
                            for (int g = 0; g < 2; ++g) { float tb[8];
#pragma unroll
                                for (int j = 0; j < 8; ++j) { const int dist = q - (kbase + 32 * t + crow(8 * g + j, hh)); const int di = dist < 0 ? 0 : (dist < 128 ? dist : 128); tb[j] = bias2[di * 12 + 4 + h]; }
#pragma unroll
                                for (int j = 0; j < 8; ++j) { const int dist = q - (kbase + 32 * t + crow(8 * g + j, hh)); S[t][8 * g + j] += dist >= 0 ? tb[j] : -1e30f; }
                                __builtin_amdgcn_sched_barrier(0); } }
                    float tm = fmaxf(max16(S[0]), max16(S[1])); tm = fmaxf(tm, xshfl<32>(tm));
                    const float sh = fmaxf(tm, 0.f); const float al = __builtin_amdgcn_exp2f(-sh);
                    lsum[m] *= al; ts = 0.f;
#pragma unroll
                    for (int i = 0; i < 16; ++i) { O[m][0][i] *= al; O[m][1][i] *= al; negm[m][i] -= sh; }
#pragma unroll
                    for (int t = 0; t < 2; ++t)
#pragma unroll
                        for (int i = 0; i < 16; ++i) { const float p = __builtin_amdgcn_exp2f(S[t][i] - sh); S[t][i] = p; ts += p; }
                }
                lsum[m] += ts;
#pragma unroll
                for (int t = 0; t < 2; ++t) { pk[t][0] = pack_half(S[t], 0); pk[t][1] = pack_half(S[t], 1); }
#pragma unroll
                for (int t = 0; t < 2; ++t)
#pragma unroll
                    for (int s2 = 0; s2 < 2; ++s2)
#pragma unroll
                        for (int db = 0; db < 2; ++db) {
                            const s16x4 lo = vtr(cur + vboff + (32 * t + 16 * s2) * DV_STR + db * 64), hi = vtr(cur + vboff + (32 * t + 16 * s2 + 8) * DV_STR + db * 64);
                            const bf16x8 vf = __builtin_shufflevector(lo, hi, 0, 1, 2, 3, 4, 5, 6, 7);
                            O[m][db] = MFMA32(vf, pk[t][s2], O[m][db]); }
                ;
            }
        }
        if (kt + 1 < nsteps) { *(LAS u32x4*)(nxt + skey * DK_STR + sch * 16) = kr; *(LAS u32x4*)(nxt + 64 * DK_STR + skey * DV_STR + sch * 16) = vr; }
        __syncthreads();
    }
    const float l0 = lsum[0] + xshfl<32>(lsum[0]), l1 = lsum[1] + xshfl<32>(lsum[1]);
    const float lam = lamp[0], lam_init = lamp[1];
    const float i0 = 1.f / fmaxf(l0, 1e-30f), i1 = lam / fmaxf(l1, 1e-30f);
    float ss = 0.f;
#pragma unroll
    for (int db = 0; db < 2; ++db)
#pragma unroll
        for (int i = 0; i < 16; ++i) { const float at = O[0][db][i] * i0 - O[1][db][i] * i1; O[0][db][i] = at; ss += at * at; }
    ss += xshfl<32>(ss);
    const float r = (1.f - lam_init) / sqrtf(ss * (1.f / 64.f) + 1e-5f);
    GAS bf16* op = ys + (rowb + q) * 1024 + 512 + h * 64;
#pragma unroll
    for (int db = 0; db < 2; ++db)
#pragma unroll
        for (int gq = 0; gq < 4; ++gq) { const int d0 = 32 * db + 8 * gq + 4 * hh; const f32x4 sg = *(const GAS f32x4*)(subg + d0);
            u32x2 w; w.x = cvtpk(O[0][db][4 * gq + 0] * r * sg[0], O[0][db][4 * gq + 1] * r * sg[1]); w.y = cvtpk(O[0][db][4 * gq + 2] * r * sg[2], O[0][db][4 * gq + 3] * r * sg[3]);
            *(GAS u32x2*)(op + d0) = w; }
}

struct SchedCmp { const char* proj; const char* wc; int G, c;
    DI bool next(int i, Unit& u) const { const int L = i * G + c; if (L >= 16) return false; const int kv = L >> 3, rt = L & 7;
        u.pm = rt; u.pn = 0; u.aux = kv; u.pad = 0; u.a = proj + ((size_t)rt * 256 * 16 * PLD + (kv ? C_VC : C_KC)) * 2; u.b = wc + (size_t)kv * 256 * 1024 * 2; return true; } };
struct EpiCmp { static constexpr bool CARRY = false; float* ab;
    DI void operator()(const f32x4 (&acc)[2][2][4][2], const Unit& u, int wr, int wc, int fr, int fq) const {
        const int row0 = u.pm * 256 + wr * 64 + fr; const int col = wc * 32 + 8 * fq;
#pragma unroll
        for (int ai = 0; ai < 2; ++ai)
#pragma unroll
            for (int m = 0; m < 4; ++m) { float* rp = ab + ((size_t)u.aux * 2048 + row0 + ai * 128 + m * 16) * 128 + col; *(f32x4*)rp = acc[ai][0][m][0]; *(f32x4*)(rp + 4) = acc[ai][0][m][1]; }
    }
};
DI void cmp_finish(const KA& a, int l, const float* ab, bf16* kcb, int task, int lane) {
    const int kv = task / (BATCH * NCMP), r = task % (BATCH * NCMP), b = r / NCMP, c = r % NCMP;
    const float* w2 = a.in[kv ? 23 : 20] + (size_t)l * 4096; const float* pt = ab + 2 * 2048 * 128;
    const size_t g = (size_t)kv * 2048 + b * 512 + c;
    float ptv = 0.f;
#pragma unroll 8
    for (int part = 0; part < 32; ++part) ptv += pt[(kv * 32 + part) * 64 + lane];
    const float h1 = ab[g * 128 + lane] + ab[(g + 1) * 128 + 64 + lane] + ptv;
    const float gl = gelu_tanh(h1); float o = 0.f;
#pragma unroll
    for (int j = 0; j < 64; ++j) o += rl(gl, j) * w2[j * 64 + lane];
    kcb[((size_t)(kv * BATCH + b) * 512 + c) * 64 + lane] = (bf16)f2bf(o);
    if (c == NCMP - 1) kcb[((size_t)(kv * BATCH + b) * 512 + NCMP) * 64 + lane] = 0;
}

DI void cmp_block(const KA& a, int l, const GAS bf16* proj, const GAS bf16* wcT, float* ab, bf16* kcb, int bid, int wave, int lane) {
    const int kv = bid >> 7, g0 = (bid & 127) * 16, r = lane & 15, q = lane >> 4, sh = wave >> 2;
    const int grow = g0 + r + sh; const bool st_ok = !(sh != 0 && (grow & 511) == 0);
    const int gld = grow > 2047 ? 2047 : grow;
    const GAS bf16* apn = proj + (size_t)gld * 16 * PLD + (kv ? C_VC : C_KC) + 8 * q;
    const GAS bf16* bpn = wcT + ((size_t)kv * 256 + wave * 16 + r) * 1024 + 8 * q;
    f32x4 acc = {0.f, 0.f, 0.f, 0.f};
#pragma unroll 8
    for (int s = 0; s < 32; ++s) {
        const bf16x8 av = *(const GAS bf16x8*)(apn + (size_t)(s >> 1) * PLD + 32 * (s & 1));
        const bf16x8 bv = *(const GAS bf16x8*)(bpn + 32 * s);
        acc = __builtin_amdgcn_mfma_f32_16x16x32_bf16(bv, av, acc, 0, 0, 0);
    }
    if (st_ok) *(GAS f32x4*)((GAS float*)ab + ((size_t)kv * 2048 + grow) * 128 + wave * 16 + 4 * q) = acc;
    VM_WAIT(); __syncthreads();
#pragma unroll 1
    for (int i = 0; i < 2; ++i) { const int g = g0 + 2 * wave + i, c = g & 511, b = g >> 9;
        if (c < NCMP) cmp_finish(a, l, ab, kcb, kv * (BATCH * NCMP) + b * NCMP + c, lane); }
}

DI void st_load(const GAS unsigned char* kb, const GAS unsigned char* vb, unsigned off, u32x4& kr, u32x4& vr) { kr = *(const GAS u32x4*)(kb + off); vr = *(const GAS u32x4*)(vb + off); }
DI void st_write(LAS unsigned char* buf, int skey, int sch, const u32x4& kr, const u32x4& vr) { *(LAS u32x4*)(buf + skey * DK_STR + sch * 16) = kr; *(LAS u32x4*)(buf + 64 * DK_STR + skey * DV_STR + sch * 16) = vr; }
DI void qk64(const LAS unsigned char* cur, int kboff, const bf16x8 (&qf)[4], const f32x16& cinit, f32x16 (&S)[2]) {
#pragma unroll
    for (int t = 0; t < 2; ++t) { S[t] = cinit;
#pragma unroll
        for (int s = 0; s < 4; ++s) { const bf16x8 kf = *(const LAS bf16x8*)(cur + kboff + t * 32 * DK_STR + s * 32); S[t] = MFMA32(kf, qf[s], S[t]); } }
}
DI void qk32z(const LAS unsigned char* kt32, const bf16x8 (&qf)[4], f32x16& S) {
#pragma unroll
    for (int s = 0; s < 4; ++s) { const bf16x8 kf = *(const LAS bf16x8*)(kt32 + s * 32);
        if (s == 0) { f32x16 z;
#pragma unroll
            for (int i = 0; i < 16; ++i) z[i] = 0.f;
            S = MFMA32(kf, qf[s], z); } else S = MFMA32(kf, qf[s], S); }
}
DI void pv32(const LAS unsigned char* vt32, const bf16x8 (&pk)[2], f32x16 (&O)[2]) {
#pragma unroll
    for (int s2 = 0; s2 < 2; ++s2)
#pragma unroll
        for (int db = 0; db < 2; ++db) {
            const s16x4 lo = vtr(vt32 + (16 * s2) * DV_STR + db * 64), hi = vtr(vt32 + (16 * s2 + 8) * DV_STR + db * 64);
            const bf16x8 vf = __builtin_shufflevector(lo, hi, 0, 1, 2, 3, 4, 5, 6, 7);
            O[db] = MFMA32(vf, pk[s2], O[db]); }
}
DI void mask_bias_cmp32(f32x16& S, int tcol_in, int cbase, int hh, const LAS float* b2h, float msub) {
    int tcol = tcol_in; asm volatile("" : "+v"(tcol));
#pragma unroll
    for (int g = 0; g < 2; ++g) {
        float bv[8];
#pragma unroll
        for (int j = 0; j < 8; ++j) { const int i = 8 * g + j; const int c = cbase + crow(i, hh); const int dist = tcol - 31 - 16 * c; const int di = dist < 0 ? 0 : (dist < 128 ? dist : 128); bv[j] = b2h[di * 12]; }
#pragma unroll
        for (int j = 0; j < 8; ++j) { const int i = 8 * g + j; const int c = cbase + crow(i, hh); const int dist = tcol - 31 - 16 * c; const bool ok = dist >= 0 && c < NCMP;
            const float sb = S[i] + (bv[j] - msub); S[i] = ok ? sb : -1e30f; }
        __builtin_amdgcn_sched_barrier(0); }
}
DI void pv64(const LAS unsigned char* cur, int vboff, const bf16x8 (&pk)[2][2], f32x16 (&O)[2]) {
#pragma unroll
    for (int t = 0; t < 2; ++t)
#pragma unroll
        for (int s2 = 0; s2 < 2; ++s2)
#pragma unroll
            for (int db = 0; db < 2; ++db) {
                const s16x4 lo = vtr(cur + vboff + (32 * t + 16 * s2) * DV_STR + db * 64), hi = vtr(cur + vboff + (32 * t + 16 * s2 + 8) * DV_STR + db * 64);
                const bf16x8 vf = __builtin_shufflevector(lo, hi, 0, 1, 2, 3, 4, 5, 6, 7);
                O[db] = MFMA32(vf, pk[t][s2], O[db]); }
}
DI void softmax_step(f32x16 (&S)[2], f32x16 (&O)[2], f32x16& negm, float& lsum, bf16x8 (&pk)[2][2]) {
    float tm = fmaxf(max16(S[0]), max16(S[1]));
    if (__builtin_amdgcn_ballot_w64(tm > 8.f) != 0ull) {
        tm = fmaxf(tm, xshfl<32>(tm)); const float sh = fmaxf(tm, 0.f); const float al = __builtin_amdgcn_exp2f(-sh);
        lsum *= al;
#pragma unroll
        for (int i = 0; i < 16; ++i) { O[0][i] *= al; O[1][i] *= al; negm[i] -= sh; S[0][i] -= sh; S[1][i] -= sh; } }
#pragma unroll
    for (int t = 0; t < 2; ++t) {
#pragma unroll
        for (int i = 0; i < 16; ++i) { const float p = __builtin_amdgcn_exp2f(S[t][i]); S[t][i] = p; lsum += p; }
        pk[t][0] = pack_half(S[t], 0); pk[t][1] = pack_half(S[t], 1); }
}
DI void mask_bias(f32x16 (&S)[2], int tcol_in, int kbase, int hh, int W, bool colsel, const LAS float* b2h) {
    int tcol = tcol_in; asm volatile("" : "+v"(tcol));
#pragma unroll
    for (int t = 0; t < 2; ++t)
#pragma unroll
        for (int g = 0; g < 2; ++g) {
            float bv[8];
#pragma unroll
            for (int j = 0; j < 8; ++j) { const int i = 8 * g + j; const int dist = tcol - (kbase + 32 * t + crow(i, hh)); const int di = dist < 0 ? 0 : (dist < 128 ? dist : 128); bv[j] = b2h[di * 12]; }
#pragma unroll
            for (int j = 0; j < 8; ++j) { const int i = 8 * g + j; const int dist = tcol - (kbase + 32 * t + crow(i, hh)); const bool ok = colsel && dist >= 0 && dist < W;
                const float sb = S[t][i] + bv[j]; S[t][i] = ok ? sb : -1e30f; }
            __builtin_amdgcn_sched_barrier(0); }
}
DI void sel_tile(const LAS unsigned char* cur, int kboff, int vboff, const bf16x8 (&qf)[4], f32x16 (&Os)[2], f32x16& negm, float& lsel, bool near, bool bit, int t, int kbase, int hh, int W, const LAS float* b2h) {
    f32x16 S[2]; qk64(cur, kboff, qf, negm, S);
    if (near) mask_bias(S, t, kbase, hh, W, bit, b2h);
    float ts = 0.f;
#pragma unroll
    for (int tt = 0; tt < 2; ++tt)
#pragma unroll
        for (int i = 0; i < 16; ++i) { const float p = __builtin_amdgcn_exp2f(S[tt][i]); S[tt][i] = p; ts += p; }
    ts = bit ? ts : 0.f;
    if (__builtin_amdgcn_ballot_w64(!(ts < 1.0e30f)) != 0ull) {
        qk64(cur, kboff, qf, negm, S);
        if (near) mask_bias(S, t, kbase, hh, W, bit, b2h);
        float tm = fmaxf(max16(S[0]), max16(S[1])); tm = bit ? tm : -1e30f; tm = fmaxf(tm, xshfl<32>(tm));
        const float sh = fmaxf(tm, 0.f); const float al = __builtin_amdgcn_exp2f(-sh);
        lsel *= al; ts = 0.f;
#pragma unroll
        for (int i = 0; i < 16; ++i) { Os[0][i] *= al; Os[1][i] *= al; negm[i] -= sh; }
#pragma unroll
        for (int tt = 0; tt < 2; ++tt)
#pragma unroll
            for (int i = 0; i < 16; ++i) { const float p = __builtin_amdgcn_exp2f(S[tt][i] - sh); S[tt][i] = p; ts += p; }
        ts = bit ? ts : 0.f;
    }
    lsel += ts;
    const unsigned km = bit ? 0xFFFFFFFFu : 0u; bf16x8 pk[2][2];
#pragma unroll
    for (int tt = 0; tt < 2; ++tt)
#pragma unroll
        for (int hf = 0; hf < 2; ++hf) { u32x4 w = __builtin_bit_cast(u32x4, pack_half(S[tt], hf)); w.x &= km; w.y &= km; w.z &= km; w.w &= km; pk[tt][hf] = __builtin_bit_cast(bf16x8, w); }
    pv64(cur, vboff, pk, Os);
}
DI void nsa_unit(const GAS bf16* proj, GAS bf16* ys, const GAS bf16* kcb, LAS unsigned char* lds, const LAS float* bias2, int b, int u, int tid_in, int lane_in, int wave_in) {
    (void)tid_in; (void)lane_in; int wave = wave_in; asm volatile("" : "+s"(wave)); const int lane = my_lane(); const int tid = wave * 64 + lane;
    const int t0 = u * 64; const int col = lane & 31, hh = lane >> 5, tl = col >> 2, head = col & 3;
    const int t = t0 + wave * 8 + tl; const int tw0 = t0 + wave * 8;
    const size_t rowb = (size_t)b * SEQ;
    const LAS float* b2h = bias2 + 8 + head;
    bf16x8 qf[4];
    { const float SC = 0.125f * 1.4426950408889634f; const GAS bf16* qp = proj + (rowb + t) * PLD + C_DQ + head * 64 + hh * 8;
#pragma unroll
      for (int s = 0; s < 4; ++s) { const u32x4 w = *(const GAS u32x4*)(qp + s * 16); u32x4 o;
          o.x = cvtpk(lo_bf(w.x) * SC, hi_bf(w.x) * SC); o.y = cvtpk(lo_bf(w.y) * SC, hi_bf(w.y) * SC); o.z = cvtpk(lo_bf(w.z) * SC, hi_bf(w.z) * SC); o.w = cvtpk(lo_bf(w.w) * SC, hi_bf(w.w) * SC);
          qf[s] = __builtin_bit_cast(bf16x8, o); } }
    const int skey = tid >> 3, sch = tid & 7;
    const int i16 = lane & 15, blk = (lane >> 4) & 1;
    const int kboff = col * DK_STR + hh * 16;
    const int vboff = 64 * DK_STR + (4 * hh + (i16 >> 2)) * DV_STR + (16 * blk + 4 * (i16 & 3)) * 2;
    u32x4 kr, vr;
    const int ncvm = (4 * u + 3) < NCMP ? (4 * u + 3) : NCMP;
    const int nsc = (ncvm + 63) >> 6;
    const GAS unsigned char* kcp = (const GAS unsigned char*)(kcb + (size_t)(0 * BATCH + b) * 512 * 64);
    const GAS unsigned char* vcp = (const GAS unsigned char*)(kcb + (size_t)(1 * BATCH + b) * 512 * 64);
    const unsigned soffc = (unsigned)(skey * 64 + sch * 8) * 2u;
    float m1 = -120.f, l1 = 0.f;
    st_load(kcp, vcp, soffc, kr, vr); st_write(lds, skey, sch, kr, vr); __syncthreads();
#pragma unroll 1
    for (int kt = 0; kt < nsc; ++kt) {
        const LAS unsigned char* cur = lds + (kt & 1) * DBUF_BYTES; LAS unsigned char* nxt = lds + ((kt + 1) & 1) * DBUF_BYTES;
        if (kt + 1 < nsc) st_load(kcp, vcp, soffc + (unsigned)(kt + 1) * 8192u, kr, vr);
#pragma unroll
        for (int tt = 0; tt < 2; ++tt) { f32x16 S; qk32z(cur + kboff + tt * 32 * DK_STR, qf, S); mask_bias_cmp32(S, t, kt * 64 + tt * 32, hh, b2h, 0.f);
          const float tm = max16(S); const float mn = fmaxf(m1, tm); float acc = 0.f;
#pragma unroll
          for (int i = 0; i < 16; ++i) acc += __builtin_amdgcn_exp2f(S[i] - mn);
          l1 = l1 * __builtin_amdgcn_exp2f(m1 - mn) + acc; m1 = mn; }
        if (kt + 1 < nsc) st_write(nxt, skey, sch, kr, vr);
        __syncthreads();
    }
    float mf, inv;
    { const float mo = xshfl<32>(m1), lo = xshfl<32>(l1); mf = fmaxf(m1, mo); const float lf = l1 * __builtin_amdgcn_exp2f(m1 - mf) + lo * __builtin_amdgcn_exp2f(mo - mf); inv = lf > 0.f ? 1.f / lf : 0.f; }
    f32x16 Oc[2], imp[4];
#pragma unroll
    for (int i = 0; i < 16; ++i) { Oc[0][i] = 0.f; Oc[1][i] = 0.f; imp[0][i] = 0.f; imp[1][i] = 0.f; imp[2][i] = 0.f; imp[3][i] = 0.f; }
    {   st_load(kcp, vcp, soffc, kr, vr); st_write(lds, skey, sch, kr, vr); __syncthreads();
#pragma unroll 1
        for (int kt = 0; kt < nsc; ++kt) {
            const LAS unsigned char* cur = lds + (kt & 1) * DBUF_BYTES; LAS unsigned char* nxt = lds + ((kt + 1) & 1) * DBUF_BYTES;
            if (kt + 1 < nsc) st_load(kcp, vcp, soffc + (unsigned)(kt + 1) * 8192u, kr, vr);
#pragma unroll
            for (int tt = 0; tt < 2; ++tt) {
                f32x16 S; qk32z(cur + kboff + tt * 32 * DK_STR, qf, S); mask_bias_cmp32(S, t, kt * 64 + tt * 32, hh, b2h, mf);
#pragma unroll
                for (int i = 0; i < 16; ++i) S[i] = __builtin_amdgcn_exp2f(S[i]) * inv;
                bf16x8 pk[2]; pk[0] = pack_half(S, 0); pk[1] = pack_half(S, 1);
                pv32(cur + vboff + tt * 32 * DV_STR, pk, Oc);
                const int Tq = (2 * kt + tt) & 3, MB = (2 * kt + tt) >> 2;
#pragma unroll
                for (int s2 = 0; s2 < 2; ++s2) { u32x4 aw; unsigned e[8];
#pragma unroll
                    for (int jj = 0; jj < 8; ++jj) { const int kk = 16 * s2 + 8 * (jj >> 2) + 4 * hh + (jj & 3); const int delta = 32 * Tq + kk - 4 * col;
                        e[jj] = (delta == -1 || delta == 3) ? 0x3F80u : ((unsigned)delta <= 2u ? 0x4000u : 0u); }
                    aw.x = e[0] | (e[1] << 16); aw.y = e[2] | (e[3] << 16); aw.z = e[4] | (e[5] << 16); aw.w = e[6] | (e[7] << 16);
                    const bf16x8 af = __builtin_bit_cast(bf16x8, aw);
                    if (MB == 0) imp[0] = MFMA32(af, pk[s2], imp[0]); else if (MB == 1) imp[1] = MFMA32(af, pk[s2], imp[1]); else if (MB == 2) imp[2] = MFMA32(af, pk[s2], imp[2]); else imp[3] = MFMA32(af, pk[s2], imp[3]); }
                if (Tq == 3 && MB < 3) { u32x4 aw; aw.x = 0u; aw.y = 0u; aw.z = 0u; aw.w = (lane == 32) ? 0x3F800000u : 0u;
                    const bf16x8 af = __builtin_bit_cast(bf16x8, aw);
                    if (MB == 0) imp[1] = MFMA32(af, pk[1], imp[1]); else if (MB == 1) imp[2] = MFMA32(af, pk[1], imp[2]); else imp[3] = MFMA32(af, pk[1], imp[3]); }
            }
            if (kt + 1 < nsc) st_write(nxt, skey, sch, kr, vr);
            __syncthreads();
        }
    }
    unsigned ocp[2][8];
#pragma unroll
    for (int db = 0; db < 2; ++db)
#pragma unroll
        for (int i = 0; i < 8; ++i) ocp[db][i] = cvtpk(Oc[db][2 * i], Oc[db][2 * i + 1]);
    unsigned sm0 = 0u, sm1 = 0u, sm2 = 0u, sm3 = 0u;
    {   const int cur_t = t >> 6; unsigned key[16];
#pragma unroll
        for (int i = 0; i < 16; ++i) {
            float v0 = imp[0][i], v1 = imp[1][i], v2 = imp[2][i], v3 = imp[3][i];
            v0 += xshfl<1>(v0); v0 += xshfl<2>(v0); v1 += xshfl<1>(v1); v1 += xshfl<2>(v1); v2 += xshfl<1>(v2); v2 += xshfl<2>(v2); v3 += xshfl<1>(v3); v3 += xshfl<2>(v3);
            const float val = head == 0 ? v0 : (head == 1 ? v1 : (head == 2 ? v2 : v3));
            const int j = 32 * head + crow(i, hh);
            const bool forced = (j == 0) || (j == cur_t) || (j == cur_t - 1);
            unsigned fx = (unsigned)(fminf(fmaxf(val, 0.f), 31.f) * 1048576.f) + 1u;
            fx = forced ? 0x1FFFFFFu : (j <= cur_t ? fx : 0u);
            key[i] = (fx << 7) | (unsigned)(127 - j); }
#pragma unroll 1
        for (int r = 0; r < 16; ++r) {
            unsigned w = key[0];
#pragma unroll
            for (int i = 1; i < 16; ++i) w = w > key[i] ? w : key[i];
            { unsigned o = (unsigned)xshfl_i<1>((int)w); w = w > o ? w : o; o = (unsigned)xshfl_i<2>((int)w); w = w > o ? w : o; o = (unsigned)xshfl_i<32>((int)w); w = w > o ? w : o; }
            if ((w >> 7) != 0u) { const int j = 127 - (int)(w & 127u); const unsigned bit = 1u << (j & 31); const int jb = j >> 5;
                sm0 |= (jb == 0) ? bit : 0u; sm1 |= (jb == 1) ? bit : 0u; sm2 |= (jb == 2) ? bit : 0u; sm3 |= (jb == 3) ? bit : 0u; }
#pragma unroll
            for (int i = 0; i < 16; ++i) key[i] = (key[i] == w) ? 0u : key[i];
        }
    }
    f32x16 Ow[2]; float lw = 0.f;
#pragma unroll
    for (int i = 0; i < 16; ++i) { Ow[0][i] = 0.f; Ow[1][i] = 0.f; }
    {   f32x16 negm;
#pragma unroll
        for (int i = 0; i < 16; ++i) negm[i] = 120.f;
        const GAS unsigned char* kwp = (const GAS unsigned char*)(proj + rowb * PLD + C_KW); const GAS unsigned char* vwp = (const GAS unsigned char*)(proj + rowb * PLD + C_VW);
        const unsigned soffp = (unsigned)(skey * PLD + sch * 8) * 2u;
        const int s0 = (u < 8) ? 8 - u : 0;
        st_load(kwp, vwp, soffp + (unsigned)(u - 8 + s0) * (64u * PLD * 2u), kr, vr); st_write(lds, skey, sch, kr, vr); __syncthreads();
#pragma unroll 1
        for (int s = s0; s < 9; ++s) {
            const int par = (s - s0) & 1; const LAS unsigned char* cur = lds + par * DBUF_BYTES; LAS unsigned char* nxt = lds + (par ^ 1) * DBUF_BYTES;
            if (s + 1 < 9) st_load(kwp, vwp, soffp + (unsigned)(u - 8 + s + 1) * (64u * PLD * 2u), kr, vr);
            sel_tile(cur, kboff, vboff, qf, Ow, negm, lw, s == 0 || s >= 6, true, t, (u - 8 + s) * 64, hh, 512, b2h);
            if (s + 1 < 9) st_write(nxt, skey, sch, kr, vr);
            __syncthreads();
        }
    }
    unsigned owp[2][8];
#pragma unroll
    for (int db = 0; db < 2; ++db)
#pragma unroll
        for (int i = 0; i < 8; ++i) owp[db][i] = cvtpk(Ow[db][2 * i], Ow[db][2 * i + 1]);
    f32x16 Os[2]; float lsel = 0.f;
#pragma unroll
    for (int i = 0; i < 16; ++i) { Os[0][i] = 0.f; Os[1][i] = 0.f; }
    {   f32x16 negm;
#pragma unroll
        for (int i = 0; i < 16; ++i) negm[i] = 120.f;
        const GAS unsigned char* ksp = (const GAS unsigned char*)(proj + rowb * PLD + C_KS); const GAS unsigned char* vsp = (const GAS unsigned char*)(proj + rowb * PLD + C_VS);
        const unsigned soffp = (unsigned)(skey * PLD + sch * 8) * 2u;
        u32x4 kA, vA, kB, vB;
        st_load(ksp, vsp, soffp, kr, vr); st_write(lds, skey, sch, kr, vr);
        if (u >= 1) st_load(ksp, vsp, soffp + 64u * PLD * 2u, kA, vA);
        __syncthreads();
#define SEL_STEP(J, KX, VX, KY, VY) { const int j_ = (J); \
            const LAS unsigned char* cur = lds + (j_ & 1) * DBUF_BYTES; LAS unsigned char* nxt = lds + ((j_ + 1) & 1) * DBUF_BYTES; \
            if (j_ + 2 <= u) st_load(ksp, vsp, soffp + (unsigned)(j_ + 2) * (64u * PLD * 2u), KY, VY); \
            const int jb = j_ >> 5; const unsigned smw = jb == 0 ? sm0 : (jb == 1 ? sm1 : (jb == 2 ? sm2 : sm3)); \
            const bool bit = ((smw >> (j_ & 31)) & 1u) != 0u; \
            if (__builtin_amdgcn_ballot_w64(bit) != 0ull) sel_tile(cur, kboff, vboff, qf, Os, negm, lsel, 64 * j_ + 63 > tw0 - 113, bit, t, 64 * j_, hh, 1 << 30, b2h); \
            if (j_ + 1 <= u) st_write(nxt, skey, sch, KX, VX); \
            __syncthreads(); }
#pragma unroll 1
        for (int j = 0; j <= u; j += 2) {
            SEL_STEP(j, kA, vA, kB, vB)
            if (j + 1 <= u) SEL_STEP(j + 1, kB, vB, kA, vA)
        }
#undef SEL_STEP
    }
    {   const float lwt = lw + xshfl<32>(lw), lst = lsel + xshfl<32>(lsel);
        const GAS bf16* gp = proj + (rowb + t) * PLD + C_DG + head * 3;
        const float g0 = sigmoidf_(bf2f(gp[0])), g1 = sigmoidf_(bf2f(gp[1])) / fmaxf(lst, 1e-30f), g2 = sigmoidf_(bf2f(gp[2])) / fmaxf(lwt, 1e-30f);
        GAS bf16* op = ys + (rowb + t) * 1024 + 768 + head * 64;
#pragma unroll
        for (int db = 0; db < 2; ++db)
#pragma unroll
            for (int gq = 0; gq < 4; ++gq) { const int d0 = 32 * db + 8 * gq + 4 * hh; float y[4];
#pragma unroll
                for (int e = 0; e < 4; ++e) { const unsigned cw = ocp[db][2 * gq + (e >> 1)], ww = owp[db][2 * gq + (e >> 1)];
                    y[e] = g0 * ((e & 1) ? hi_bf(cw) : lo_bf(cw)) + g1 * Os[db][4 * gq + e] + g2 * ((e & 1) ? hi_bf(ww) : lo_bf(ww)); }
                u32x2 w; w.x = cvtpk(y[0], y[1]); w.y = cvtpk(y[2], y[3]); *(GAS u32x2*)(op + d0) = w; }
    }
}


DI void swa_unit(const GAS bf16* proj, GAS bf16* ys, LAS unsigned char* lds, const LAS float* bias2, const LAS float* biasd, const GAS float* sinks, int b, int u, int tid_in, int lane_in, int wave_in) {
    int tid = tid_in, lane = lane_in, wave = wave_in; asm volatile("" : "+v"(tid), "+v"(lane), "+s"(wave));
    const int t0 = u * 64; const int col = lane & 31, hh = lane >> 5, tl = col >> 1, kv = wave & 1, head = 2 * kv + (col & 1);
    const int t = t0 + (wave >> 1) * 16 + tl;
    const size_t rowb = (size_t)b * SEQ;
    const LAS float* b2h = bias2 + head;
    bf16x8 qf[4];
    { const float SC = 0.125f * 1.4426950408889634f; const GAS bf16* qp = proj + (rowb + t) * PLD + C_BQ + head * 64 + hh * 8;
#pragma unroll
      for (int s = 0; s < 4; ++s) { const u32x4 w = *(const GAS u32x4*)(qp + s * 16); u32x4 o;
          o.x = cvtpk(lo_bf(w.x) * SC, hi_bf(w.x) * SC); o.y = cvtpk(lo_bf(w.y) * SC, hi_bf(w.y) * SC); o.z = cvtpk(lo_bf(w.z) * SC, hi_bf(w.z) * SC); o.w = cvtpk(lo_bf(w.w) * SC, hi_bf(w.w) * SC);
          qf[s] = __builtin_bit_cast(bf16x8, o); } }
    const int skey = tid >> 3, sch = tid & 7;
    const int i16 = lane & 15, blk = (lane >> 4) & 1;
    const int kboff = kv * DBUF_BYTES + col * DK_STR + hh * 16;
    const int vboff = kv * DBUF_BYTES + 64 * DK_STR + (4 * hh + (i16 >> 2)) * DV_STR + (16 * blk + 4 * (i16 & 3)) * 2;
    const GAS unsigned char* kp = (const GAS unsigned char*)(proj + rowb * PLD + C_BK); const GAS unsigned char* vp = (const GAS unsigned char*)(proj + rowb * PLD + C_BV);
    const unsigned soffp = (unsigned)(skey * PLD + sch * 8) * 2u;
    u32x4 k0, v0, k1, v1;
    f32x16 O[2], negm; float lsum = 0.f;
#pragma unroll
    for (int i = 0; i < 16; ++i) { O[0][i] = 0.f; O[1][i] = 0.f; negm[i] = 120.f; }
    const int s0 = (u < 2) ? 2 - u : 0;
    { const unsigned so = soffp + (unsigned)(u - 2 + s0) * (64u * PLD * 2u); st_load(kp, vp, so, k0, v0); st_load(kp + 128, vp + 128, so, k1, v1);
      st_write(lds, skey, sch, k0, v0); st_write(lds + DBUF_BYTES, skey, sch, k1, v1); }
    __syncthreads();
#pragma unroll 1
    for (int s = s0; s < 3; ++s) {
        const int par = (s - s0) & 1; const LAS unsigned char* cur = lds + par * 2 * DBUF_BYTES; LAS unsigned char* nxt = lds + (par ^ 1) * 2 * DBUF_BYTES;
        if (s + 1 < 3) { const unsigned so = soffp + (unsigned)(u - 2 + s + 1) * (64u * PLD * 2u); st_load(kp, vp, so, k0, v0); st_load(kp + 128, vp + 128, so, k1, v1); }
        sel_tile(cur, kboff, vboff, qf, O, negm, lsum, true, true, t, (u - 2 + s) * 64, hh, 128, b2h);
        if (s + 1 < 3) { st_write(nxt, skey, sch, k0, v0); st_write(nxt + DBUF_BYTES, skey, sch, k1, v1); }
        __syncthreads();
    }
    {   const float sinkp = (sinks[head] - biasd[128 * 12 + head]) * 1.4426950408889634f;
        const float lt = lsum + xshfl<32>(lsum) + __builtin_amdgcn_exp2f(sinkp + negm[0]);
        const float inv = 1.f / fmaxf(lt, 1e-30f);
        GAS bf16* op = ys + (rowb + t) * 1024 + 256 + head * 64;
#pragma unroll
        for (int db = 0; db < 2; ++db)
#pragma unroll
            for (int gq = 0; gq < 4; ++gq) { const int d0 = 32 * db + 8 * gq + 4 * hh;
                u32x2 w; w.x = cvtpk(O[db][4 * gq + 0] * inv, O[db][4 * gq + 1] * inv); w.y = cvtpk(O[db][4 * gq + 2] * inv, O[db][4 * gq + 3] * inv); *(GAS u32x2*)(op + d0) = w; }
    }
}

DI void route_rows4(const KA& a, int l, bf16* xr_, int tok0, int lane_) {
    int lane = lane_; asm volatile("" : "+v"(lane));
    const GAS bf16* xrow = (const GAS bf16*)(a.ws + WS_XB) + (size_t)tok0 * 1024; const GAS float* g = (const GAS float*)(a.in[28] + (size_t)l * 1024); GAS bf16* xr = (GAS bf16*)xr_;
    f32x4 v[4][4]; float ss[4]; u32x2 raw[4][4];
#pragma unroll
    for (int rr = 0; rr < 4; ++rr)
#pragma unroll
        for (int j = 0; j < 4; ++j) raw[rr][j] = *(const GAS u32x2*)(xrow + (size_t)rr * 1024 + 4 * (lane + 64 * j));
#pragma unroll
    for (int rr = 0; rr < 4; ++rr)
#pragma unroll
        for (int j = 0; j < 4; ++j) { v[rr][j][0] = lo_bf(raw[rr][j].x); v[rr][j][1] = hi_bf(raw[rr][j].x); v[rr][j][2] = lo_bf(raw[rr][j].y); v[rr][j][3] = hi_bf(raw[rr][j].y); }
#pragma unroll
    for (int rr = 0; rr < 4; ++rr) { float t = 0.f;
#pragma unroll
        for (int j = 0; j < 4; ++j) t += (v[rr][j][0] * v[rr][j][0] + v[rr][j][1] * v[rr][j][1]) + (v[rr][j][2] * v[rr][j][2] + v[rr][j][3] * v[rr][j][3]);
        ss[rr] = t; }
#pragma unroll
    for (int rr = 0; rr < 4; ++rr) ss[rr] = wave_sum(ss[rr]);
#pragma unroll
    for (int j = 0; j < 4; ++j) { const int k0 = 4 * (lane + 64 * j); const f32x4 gv = *(const GAS f32x4*)(g + k0);
#pragma unroll
        for (int rr = 0; rr < 4; ++rr) { const float r = 1.f / sqrtf(ss[rr] * (1.f / 1024.f) + 1e-6f); const f32x4 xn = v[rr][j] * r * gv;
            unsigned hi[4]; float lo[4];
#pragma unroll
            for (int e = 0; e < 4; ++e) { hi[e] = f2bf(xn[e]); lo[e] = xn[e] - __builtin_bit_cast(float, hi[e] << 16); }
            u32x2 wh, wl; wh.x = hi[0] | (hi[1] << 16); wh.y = hi[2] | (hi[3] << 16); wl.x = pk2(lo[0], lo[1]); wl.y = pk2(lo[2], lo[3]);
            *(GAS u32x2*)(xr + (size_t)(tok0 + rr) * 2048 + k0) = wh; *(GAS u32x2*)(xr + (size_t)(tok0 + rr) * 2048 + 1024 + k0) = wl; } }
}
struct SchedRoute { const char* A; const char* B; int pm;
    DI bool next(int i, Unit& u) const { if (i > 0) return false; u.pm = pm; u.pn = 0; u.aux = 0; u.pad = 0; u.a = A + (size_t)pm * 128 * 2048 * 2; u.b = B; return true; } };
struct EpiRoute { static constexpr bool CARRY = false; float* rlog;
    DI void operator()(const f32x4 (&acc)[2][2][4][2], const Unit& u, int wr, int wc, int fr, int fq) const {
        const int row0 = u.pm * 128 + wr * 64 + fr; const int col = wc * 32 + 8 * fq;
#pragma unroll
        for (int m = 0; m < 4; ++m) { float* rp = rlog + (size_t)(row0 + m * 16) * 128 + col; *(f32x4*)rp = acc[0][0][m][0]; *(f32x4*)(rp + 4) = acc[0][0][m][1]; }
    }
};
DI void route_decide(const KA& a, int l, const float* rl_row, int* rec_e, int* rec_slot, float* rec_w, unsigned* cnt, int tok) {
    float lg[36];
    const float* bg = a.in[30] + l * 4; const float* be = a.in[32] + l * 32;
#pragma unroll
    for (int q = 0; q < 9; ++q) { const f32x4 h = *(const f32x4*)(rl_row + 4 * q), lo = *(const f32x4*)(rl_row + 64 + 4 * q);
        lg[4 * q + 0] = h[0] + lo[0]; lg[4 * q + 1] = h[1] + lo[1]; lg[4 * q + 2] = h[2] + lo[2]; lg[4 * q + 3] = h[3] + lo[3]; }
#pragma unroll
    for (int i = 0; i < 4; ++i) lg[i] += bg[i];
#pragma unroll
    for (int i = 0; i < 32; ++i) lg[4 + i] += be[i];
    int gsel = 0; float gm = lg[0];
#pragma unroll
    for (int i = 1; i < 4; ++i) if (lg[i] > gm) { gm = lg[i]; gsel = i; }
    float gs = 0.f;
#pragma unroll
    for (int i = 0; i < 4; ++i) gs += __expf(lg[i] - gm);
    const float gwt = 1.f / gs;
    float v8[8];
#pragma unroll
    for (int i = 0; i < 8; ++i) { float x = lg[4 + i];
#pragma unroll
        for (int gq = 1; gq < 4; ++gq) x = (gsel == gq) ? lg[4 + gq * 8 + i] : x;
        v8[i] = x; }
    int i0 = 0; float m0 = v8[0];
#pragma unroll
    for (int i = 1; i < 8; ++i) if (v8[i] > m0) { m0 = v8[i]; i0 = i; }
    int i1 = -1; float m1 = -3e38f;
#pragma unroll
    for (int i = 0; i < 8; ++i) if (i != i0 && v8[i] > m1) { m1 = v8[i]; i1 = i; }
    if (i1 < 0) i1 = (i0 == 0) ? 1 : 0;
    const float w0 = 1.f / (1.f + __expf(m1 - m0)); const float w1 = 1.f - w0;
    const int e0 = gsel * 8 + i0, e1 = gsel * 8 + i1;
    const unsigned s0 = __hip_atomic_fetch_add(cnt + e0, 1u, __ATOMIC_RELAXED, __HIP_MEMORY_SCOPE_AGENT);
    const unsigned s1 = __hip_atomic_fetch_add(cnt + e1, 1u, __ATOMIC_RELAXED, __HIP_MEMORY_SCOPE_AGENT);
    (void)rec_e; (void)rec_slot; (void)rec_w;
    int* inv_as = (int*)(a.ws + WS_INVAS); float* inv_w = (float*)(a.ws + WS_INVW);
    inv_as[e0 * 32768 + (int)s0] = tok * 2; inv_w[e0 * 32768 + (int)s0] = w0 * gwt; inv_as[e1 * 32768 + (int)s1] = tok * 2 + 1; inv_w[e1 * 32768 + (int)s1] = w1 * gwt;
}
DI void expert_weights(const KA& a, int l, LAS unsigned char* lds, int it0, int it1, int gw, int NGW, int wave, int lane) {
    LAS float* scr = (LAS float*)(lds + wave * 16384);
    const float* wgt = a.in[33] + (size_t)l * 32 * 1024 * 256; const float* wup = a.in[34] + (size_t)l * 32 * 1024 * 256; const float* wdn = a.in[35] + (size_t)l * 32 * 256 * 1024;
    bf16* Wgu = (bf16*)(a.ws + WS_WGU); bf16* Wd = (bf16*)(a.ws + WS_WD);
    constexpr int I_E = 16 * 8, I_D = 4 * 32;
    constexpr int NIT = 32 * (2 * I_E + I_D);
    (void)NIT;
    for (int it = it0 + gw; it < it1; it += NGW) {
        const int e = it / (2 * I_E + I_D); int r = it % (2 * I_E + I_D);
        if (r < 2 * I_E) { const int up = r / I_E, q = r % I_E, kb = q / 8, nb = q % 8; const int n0 = nb * 32;
            const int drow = (n0 >> 7) * 256 + up * 128 + (n0 & 127);
            transpose_item((up ? wup : wgt) + (size_t)e * 1024 * 256, 256, 256, Wgu + (size_t)e * 512 * 1024, 1024, kb * 64, n0, drow, scr, lane);
        } else { r -= 2 * I_E; const int kb = r / 32, nb = r % 32;
            transpose_item(wdn + (size_t)e * 256 * 1024, 1024, 1024, Wd + (size_t)e * 1024 * 256, 256, kb * 64, nb * 32, nb * 32, scr, lane); }
    }
}
DI void build_offsets(const unsigned* cnt, LAS int* offt, int tid) {
    int c = 0;
    if (tid < 32) { c = (int)__hip_atomic_load(cnt + tid, __ATOMIC_RELAXED, __HIP_MEMORY_SCOPE_AGENT); offt[330 + tid] = (c + 255) & ~255; }
    __syncthreads();
    if (tid == 0) { int o = 0;
#pragma unroll
        for (int e = 0; e < 32; ++e) { offt[e] = o; o += offt[330 + e]; } offt[32] = o; }
    __syncthreads();
    if (tid < 32) offt[330 + tid] = c;
    for (int rt = tid; rt < (MOE_ROWS >> 8); rt += 512) { int e = 0; for (int j = 1; j < 32; ++j) e += (offt[j] <= rt * 256) ? 1 : 0; offt[40 + rt] = e; }
    __syncthreads();
}

template <unsigned PM>
__global__ void __launch_bounds__(512, 2) mk_fwd(Args a_) {
    extern __shared__ __attribute__((aligned(16))) unsigned char lds_raw[];
    LAS unsigned char* lds = (LAS unsigned char*)lds_raw;
    const int wave0 = __builtin_amdgcn_readfirstlane((int)threadIdx.x >> 6);
    if (threadIdx.x < 36) ((LAS unsigned long long*)(lds + PTAB_OFF))[threadIdx.x] = (unsigned long long)a_.in[threadIdx.x];
    __syncthreads();
    KA a; a.in.base = (unsigned)(size_t)(lds + PTAB_OFF); a.out = a_.out; a.ws = a_.ws;
    const int G = gridDim.x, bid = blockIdx.x, NGW = G * 8;
#define PHASE_IDS() int wave = wave0; asm volatile("" : "+s"(wave)); const int lane = my_lane(); const int tid_ = wave * 64 + lane, gw = bid * 8 + wave; (void)tid_; (void)gw; \
    const int xb = ((bid & 7) << 5) | (bid >> 3); (void)xb;        \
    KA ap = a; asm volatile("" : "+s"(ap.ws), "+s"(ap.out), "+s"(ap.in.base)); \
    bf16* hb = (bf16*)(ap.ws + WS_HB); bf16* proj = (bf16*)(ap.ws + WS_PROJ); bf16* gates = (bf16*)(ap.ws + WS_GATES); \
    bf16* ys = hb; bf16* x2b = hb; bf16* merged = proj; bf16* eo = proj; \
    bf16* kcb = (bf16*)(ap.ws + WS_KCVC); float* lrusum = (float*)(ap.ws + WS_LRUSUM); \
    int* rec_e = (int*)(ap.ws + WS_REC); int* rec_slot = rec_e + T * 2; float* rec_w = (float*)(rec_slot + T * 2); \
    int* rowtok = (int*)(ap.ws + WS_ROWTOK); float* roww = (float*)(ap.ws + WS_ROWW); \
    bf16* xs = (bf16*)(ap.ws + WS_XS); bf16* hmid = (bf16*)(ap.ws + WS_HMID); unsigned* ctl = (unsigned*)(ap.ws + WS_CTL); \
    (void)hb; (void)proj; (void)gates; (void)ys; (void)x2b; (void)merged; (void)eo; (void)kcb; (void)lrusum; (void)rec_e; (void)rec_slot; (void)rec_w; (void)rowtok; (void)roww; (void)xs; (void)hmid; (void)ctl
    volatile LAS unsigned* MISC = (volatile LAS unsigned*)(lds + MISC_OFF);
    LAS float* biasd = (LAS float*)(lds + BIAS_OFF);
    LAS int* offt = (LAS int*)(lds + OFFT_OFF);
    { PHASE_IDS();
    if (tid_ < 64) MISC[tid_] = 0u;
    for (int i = tid_; i < 129 * 12; i += 512) { const int d = i / 12, hd = i % 12; const int bk = d < 128 ? T5_BUCKET[d] : 31; const float* rb = a.in[1]; biasd[i] = rb[bk * 12 + hd]; ((LAS float*)(lds + BIAS2_OFF))[i] = (rb[bk * 12 + hd] - rb[31 * 12 + hd]) * 1.4426950408889634f; } }
    __syncthreads();
    const int lo = a_.ph_lo, hi = a_.ph_hi;
    XcdBarrier bar; bar.bar = (unsigned*)(a.ws + WS_CTL) + CW_BAR; bar.x = 0; bar.st = nullptr;
    if (hi - lo > 1) { PHASE_IDS(); bar = xcd_barrier_post(ctl + CW_BAR, MISC + 8, tid_ == 0); }
#ifndef SUB_MASK
#define SUB_MASK 0xFFu
#endif
#define SUB(k) ((SUB_MASK >> (k)) & 1u)
#define HASP(k) ((PM >> ((k) % PPL + ((k) >= 2 * PPL ? PPL : 0))) & 1u)
#define IN(k) (HASP(k) && lo <= (k) && (k) < hi)
#define SEAM(k) do { if ((k) + 1 < hi) { const int sl_ = my_lane(); int sw_ = wave0; asm volatile("" : "+s"(sw_)); xcd_barrier(bar, sw_ == 0 && sl_ == 0); } } while (0)
    for (int l = 0; l < DEPTH; ++l) {
        const int pb = l * PPL;
        if (IN(pb + 0)) { PHASE_IDS(); p1_weights_i8(ap, l, lds, gw, NGW, wave, lane); router_weights(ap, l, gw, NGW, lane); lru_weights(ap, l, gw, NGW, lane); cmp_weights(ap, l, lds, gw, NGW, wave, lane); phase0_weights(ap, l, lds, gw, NGW, wave, lane); phase0_rows(ap, l, 0, gw, NGW, lane); SEAM(pb + 0); }
        if (IN(pb + 1)) {
            PHASE_IDS();
            {   int K1q = 512; asm volatile("" : "+s"(K1q));
                pg8::Gemm g{K1q, 512, 512, 128, -1}; SchedP1 S{(const char*)(ap.ws + WS_HQ), (const char*)(ap.ws + WS_WQ), 128, 26, 1024, 1024, G, bid};
                EpiP1I8 E{proj, (unsigned char*)gates, ap.in[25] + (size_t)l * 4096, (const float*)(ap.ws + WS_HSC), (const float*)(ap.ws + WS_WSC)};
                pg8::gemm_phase<EpiP1I8, SchedP1, false, true>(lds, g, S, E, tid_); }
            SEAM(pb + 1);
        }
        if (IN(pb + 2)) {
            PHASE_IDS();
            LAS float* lamp = (LAS float*)(lds + MISC_OFF + 64);
            if (tid_ < 64) { const float* q1 = ap.in[13] + l * 32; const float* k1 = ap.in[14] + l * 32; const float* q2 = ap.in[15] + l * 32; const float* k2 = ap.in[16] + l * 32;
                float s1 = (lane < 32) ? q1[lane] * k1[lane] : 0.f, s2 = (lane < 32) ? q2[lane] * k2[lane] : 0.f; s1 = wave_sum(s1); s2 = wave_sum(s2);
                const float lam_init = 0.8f - 0.6f * __expf(-0.3f * (float)l); if (lane == 0) { lamp[0] = __expf(s1) - __expf(s2) + lam_init; lamp[1] = lam_init; } }
            __syncthreads();
            if (SUB(0)) { const LAS float* bias2 = (const LAS float*)(lds + BIAS2_OFF); const GAS float* subg = (const GAS float*)(ap.in[17] + l * 64);
                for (int pi = xb; pi < 256; pi += G) { const int bh = pi >> 4, qlo = pi & 15;
                    diff_unit((const GAS bf16*)proj, (GAS bf16*)ys, lds, bias2, subg, lamp, bh >> 2, bh & 3, 31 - qlo, wave);
                    diff_unit((const GAS bf16*)proj, (GAS bf16*)ys, lds, bias2, subg, lamp, bh >> 2, bh & 3, qlo, wave); } }
            { PHASE_IDS();
            if (SUB(3)) { __syncthreads(); const LAS float* bias2 = (const LAS float*)(lds + BIAS2_OFF); const GAS float* sinks = (const GAS float*)(ap.in[12] + l * 4);
                for (int pi = xb; pi < 512; pi += G) swa_unit((const GAS bf16*)proj, (GAS bf16*)ys, lds, bias2, biasd, sinks, pi >> 7, pi & 127, tid_, lane, wave); }
            if (SUB(2)) cmp_block(ap, l, (const GAS bf16*)proj, (const GAS bf16*)(ap.ws + WS_WCMP), (float*)(ap.ws + WS_CMPAB), kcb, bid, wave, lane);
            if (SUB(1)) { __syncthreads(); for (int task = xb; task < 512; task += G) lru_unit(ap, l, (const GAS bf16*)proj, (GAS bf16*)ys, (GAS float*)lrusum, lds, task, lane, wave, false); }
            }
            SEAM(pb + 2);
        }
        if (IN(pb + 4)) {
            PHASE_IDS();
            for (int task = xb; task < 512; task += G) lru_unit(ap, l, (const GAS bf16*)proj, (GAS bf16*)ys, (GAS float*)lrusum, lds, task, lane, wave, true);
            __syncthreads();
            if (SUB(4)) { const LAS float* bias2 = (const LAS float*)(lds + BIAS2_OFF);
                for (int pi = xb; pi < 256; pi += G) { const int bb = pi >> 6, ulo = pi & 63;
                    nsa_unit((const GAS bf16*)proj, (GAS bf16*)ys, (const GAS bf16*)kcb, lds, bias2, bb, 127 - ulo, tid_, lane, wave);
                    nsa_unit((const GAS bf16*)proj, (GAS bf16*)ys, (const GAS bf16*)kcb, lds, bias2, bb, ulo, tid_, lane, wave); } }
            SEAM(pb + 4);
        }
        if (IN(pb + 5)) {
            PHASE_IDS();
            int K5 = 256; asm volatile("" : "+s"(K5));
            pg8::Gemm g{K5, 1024, 256, 128, -1}; SchedP3a S{(const char*)ys, (const char*)(ap.ws + WS_WBR), G, xb};
            EpiP3a E{merged, (const unsigned char*)gates};
            pg8::gemm_phase<EpiP3a, SchedP3a>(lds, g, S, E, tid_); SEAM(pb + 5);
        }
        if (IN(pb + 6)) {
            PHASE_IDS();
            int K6 = 1024; asm volatile("" : "+s"(K6));
            pg8::Gemm g{K6, 1024, 1024, 128, -1}; SchedP3b S{(const char*)merged, (const char*)(ap.ws + WS_WOUT), G, xb};
            if (l == 0) { EpiP3b<true> E{ap.in[0], (bf16*)(ap.ws + WS_XB)}; pg8::gemm_phase<EpiP3b<true>, SchedP3b>(lds, g, S, E, tid_); }
            else { EpiP3b<false> E{nullptr, (bf16*)(ap.ws + WS_XB)}; pg8::gemm_phase<EpiP3b<false>, SchedP3b>(lds, g, S, E, tid_); }
            SEAM(pb + 6);
        }
        if (IN(pb + 7)) {
            PHASE_IDS();
            bf16* xr = (bf16*)(ap.ws + WS_XR); float* rlog = (float*)(ap.ws + WS_RLOG);
            constexpr int NITW = 32 * (2 * 16 * 8 + 4 * 32);
            { const int pm = bid;
                for (int r = wave * 4; r < 128; r += 32) route_rows4(ap, l, xr, pm * 128 + r, lane);
                asm volatile("s_waitcnt vmcnt(0)" ::: "memory"); __syncthreads();
                { pg8::Gemm g{2048, 2048, 2048, 128, 0}; SchedRoute S{(const char*)xr, (const char*)(ap.ws + WS_WR), pm}; EpiRoute E{rlog};
                  pg8::gemm_phase<EpiRoute, SchedRoute>(lds, g, S, E, tid_); }
                asm volatile("s_waitcnt vmcnt(0)" ::: "memory"); __syncthreads();
                if (tid_ < 128) route_decide(ap, l, rlog + (size_t)(pm * 128 + tid_) * 128, rec_e, rec_slot, rec_w, ctl + CW_CNT + l * 32, pm * 128 + tid_);
                __syncthreads();
            }
            expert_weights(ap, l, lds, 0, NITW, gw, NGW, wave, lane);
            SEAM(pb + 7);
        }
        if (IN(pb + 9)) {
            PHASE_IDS();
            build_offsets(ctl + CW_CNT + l * 32, offt, tid_);
            int K9 = 1024; asm volatile("" : "+s"(K9));
            pg8::Gemm g{K9, 2048, 1024, 128, -1}; SchedM2 S{(const char*)(ap.ws + WS_XR), (const char*)(ap.ws + WS_WGU), offt, (const int*)(ap.ws + WS_INVAS), G, xb};
            EpiM2 E{hmid};
            pg8::gemm_phase<EpiM2, SchedM2, true>(lds, g, S, E, tid_); SEAM(pb + 9);
        }
        if (IN(pb + 10)) {
            PHASE_IDS();
            build_offsets(ctl + CW_CNT + l * 32, offt, tid_);
            int K3 = 256; asm volatile("" : "+s"(K3));
            pg8::Gemm g{K3, 256, 256, 128, -1}; SchedM3 S{(const char*)hmid, (const char*)(ap.ws + WS_WD), offt, G, xb};
            EpiM3 E{eo, (const int*)(ap.ws + WS_INVAS), (const float*)(ap.ws + WS_INVW), offt};
            pg8::gemm_phase<EpiM3, SchedM3>(lds, g, S, E, tid_); SEAM(pb + 10);
        }
    }
    if (IN(2 * PPL)) { PHASE_IDS(); phase0_rows(ap, DEPTH, 1, gw, NGW, lane); }
#undef IN
#undef SEAM
}

typedef void (*kern_t)(Args);
template <unsigned PM> static bool setup_kernel() {
    if (hipFuncSetAttribute((const void*)mk_fwd<PM>, hipFuncAttributeMaxDynamicSharedMemorySize, LDS_BYTES) != hipSuccess) { fprintf(stderr, "kernel_launch: hipFuncSetAttribute failed\n"); return false; }
    return true;
}
extern "C" void kernel_launch(void* const* d_in, const int* in_sizes, int n_in, void* d_out, int out_size, void* d_ws, size_t ws_size, hipStream_t stream) {
    static int grid = 0;
    if (grid == 0) {
        if (n_in != 36 || out_size != T * D || ws_size < WS_END) { fprintf(stderr, "kernel_launch: unexpected shapes (n_in %d out %d ws %zu)\n", n_in, out_size, ws_size); grid = -1; return; }
        int dev = 0, cus = 0;
        if (hipGetDevice(&dev) != hipSuccess || hipDeviceGetAttribute(&cus, hipDeviceAttributeMultiprocessorCount, dev) != hipSuccess) { grid = -1; return; }
        bool ok = true;
#if MK_ONE_LAUNCH
        ok = setup_kernel<0xFFFu>();
#endif
        if (!ok) { grid = -1; return; }
        (void)hipGetLastError();
        grid = cus;
        if (grid != 256) { fprintf(stderr, "kernel_launch: built for a 256-CU device (got %d)\n", cus); grid = -1; return; }
    }
    if (grid < 0) return;
    if (hipMemsetAsync((char*)d_ws + WS_CTL, 0, CTL_ZERO_BYTES, stream) != hipSuccess) return;
    Args a{};
    for (int i = 0; i < 36; ++i) a.in[i] = (const float*)d_in[i];
    a.out = (float*)d_out; a.ws = (unsigned char*)d_ws;
#if MK_ONE_LAUNCH
    a.ph_lo = 0; a.ph_hi = NPH;
    hipLaunchKernelGGL(mk_fwd<0xFFFu>, dim3(grid), dim3(512), LDS_BYTES, stream, a);
#endif
}
```

```cpp
#include <hip/hip_runtime.h>
#include <cstdio>
#include <cstdint>

#ifndef MK_ONE_LAUNCH
#define MK_ONE_LAUNCH 1
#endif

#define DI __device__ __forceinline__
#define GAS __attribute__((address_space(1)))
#define LAS __attribute__((address_space(3)))
typedef unsigned short bf16;
typedef short bf16x8 __attribute__((ext_vector_type(8)));
typedef float f32x4 __attribute__((ext_vector_type(4)));
typedef int i32x4 __attribute__((ext_vector_type(4)));
typedef unsigned u32x4 __attribute__((ext_vector_type(4)));
typedef unsigned u32x2 __attribute__((ext_vector_type(2)));
typedef float f32x16 __attribute__((ext_vector_type(16)));
typedef float f32x2 __attribute__((ext_vector_type(2)));
typedef short s16x4 __attribute__((ext_vector_type(4)));
typedef __bf16 bf16x2_t __attribute__((ext_vector_type(2)));
typedef short v4i16_t __attribute__((__vector_size__(4 * sizeof(short))));
#define MFMA32(a, b, c) __builtin_amdgcn_mfma_f32_32x32x16_bf16((a), (b), (c), 0, 0, 0)

constexpr int BATCH = 4, SEQ = 8192, T = BATCH * SEQ, D = 1024, DEPTH = 2;
constexpr int NIN = 2444, PLD = 2560, N1 = 6656, GLD = 4096;
constexpr int C_AX = 0, C_AG = 256, C_BQ = 512, C_BK = 768, C_BV = 896, C_CQ = 1024, C_CK = 1280, C_CV = 1536, C_DQ = 1792,
              C_KC = 2048, C_VC = 2112, C_KS = 2176, C_VS = 2240, C_KW = 2304, C_VW = 2368, C_DG = 2432;
constexpr int NCMP = 511;
constexpr int MOE_ROWS = 73728;
constexpr int PPL = 11;
constexpr int NPH = 2 * PPL + 1;

constexpr size_t MiB = 1u << 20;
constexpr size_t WS_CTL = 0, CTL_ZERO_BYTES = 1 * MiB;
constexpr size_t WS_KCVC = 1 * MiB;
constexpr size_t WS_LRUSUM = 2 * MiB;
constexpr size_t WS_REC = 2 * MiB + 256 * 1024;
constexpr size_t WS_ROWTOK = 3 * MiB;
constexpr size_t WS_ROWW = 3 * MiB + 512 * 1024;
constexpr size_t WS_WIN = 4 * MiB;
constexpr size_t WS_WQ = 4 * MiB;
constexpr size_t WS_WSC = 13 * MiB;
constexpr size_t WS_HSC = 13 * MiB + 65536;
constexpr size_t WS_HQ = 21 * MiB;
constexpr size_t WS_INVAS = 296 * MiB;
constexpr size_t WS_INVW = 300 * MiB;
constexpr size_t WS_XB = 373 * MiB;
constexpr size_t WS_WBR = 17 * MiB;
constexpr size_t WS_WOUT = 19 * MiB;
constexpr size_t WS_HB = 21 * MiB;
constexpr size_t WS_PROJ = 85 * MiB;
constexpr size_t WS_GATES = 245 * MiB;
constexpr size_t WS_WGU = 245 * MiB;
constexpr size_t WS_WD = 277 * MiB;
constexpr size_t WS_XS = 293 * MiB;
constexpr size_t WS_HMID = 437 * MiB;
constexpr size_t WS_XR = 85 * MiB;
constexpr size_t WS_RLOG = 213 * MiB;
constexpr size_t WS_WR = 501 * MiB;
constexpr size_t WS_WCMP = 502 * MiB;
constexpr size_t WS_CMPAB = 503 * MiB;
constexpr size_t WS_LRUW = 505 * MiB + 65536;
constexpr size_t WS_END = 506 * MiB;
constexpr int CW_BAR = 4096;
constexpr int CW_CNT = 16384;

constexpr int RING_BYTES = 131072;
constexpr int MISC_OFF = RING_BYTES;
constexpr int BIAS_OFF = MISC_OFF + 256;
constexpr int OFFT_OFF = BIAS_OFF + 129 * 12 * 4;
constexpr int PTAB_OFF = OFFT_OFF + (40 + 288 + 40) * 4;
constexpr int BIAS2_OFF = PTAB_OFF + 36 * 8;
constexpr int LRUEX_OFF = BIAS2_OFF + 129 * 12 * 4;
constexpr int LDS_BYTES = 163840;
constexpr int LRUCST_OFF = LRUEX_OFF + 8 * 64 * 2 * 4;
constexpr int LRUCAR_OFF = LRUCST_OFF + 3 * 64 * 4;
static_assert(PTAB_OFF % 8 == 0 && LRUCAR_OFF + 8 * 64 * 4 <= LDS_BYTES, "LDS map");

DI float bf2f(bf16 v) { return __builtin_bit_cast(float, (unsigned)v << 16); }
DI float lo_bf(unsigned w) { return __builtin_bit_cast(float, w << 16); }
DI float hi_bf(unsigned w) { return __builtin_bit_cast(float, w & 0xffff0000u); }
DI unsigned f2bf(float f) { unsigned u = __builtin_bit_cast(unsigned, f); return (u + 0x7fffu + ((u >> 16) & 1u)) >> 16; }
DI unsigned pk2(float lo, float hi) { return f2bf(lo) | (f2bf(hi) << 16); }
DI float rl(float v, int i) { return __builtin_bit_cast(float, __builtin_amdgcn_readlane(__builtin_bit_cast(int, v), i)); }
DI int rli(int v, int i) { return __builtin_amdgcn_readlane(v, i); }
DI int my_lane() { int l; asm volatile("v_mbcnt_lo_u32_b32 %0, -1, 0\n\tv_mbcnt_hi_u32_b32 %0, -1, %0" : "=v"(l)); return l; }
template <int O> DI int xshfl_i(int v) {
    if constexpr (O < 32) return __builtin_amdgcn_ds_swizzle(v, (O << 10) | 0x1f);
    else { const int l = my_lane(); return __builtin_amdgcn_ds_bpermute((l ^ 32) << 2, v); }
}
template <int O> DI float xshfl(float v) { return __builtin_bit_cast(float, xshfl_i<O>(__builtin_bit_cast(int, v))); }
DI float wave_sum(float v) { v += xshfl<1>(v); v += xshfl<2>(v); v += xshfl<4>(v); v += xshfl<8>(v); v += xshfl<16>(v); v += xshfl<32>(v); return v; }
DI float wave_max(float v) { v = fmaxf(v, xshfl<1>(v)); v = fmaxf(v, xshfl<2>(v)); v = fmaxf(v, xshfl<4>(v)); v = fmaxf(v, xshfl<8>(v)); v = fmaxf(v, xshfl<16>(v)); v = fmaxf(v, xshfl<32>(v)); return v; }
DI float sigmoidf_(float x) { return __builtin_amdgcn_rcpf(1.f + __builtin_amdgcn_exp2f(-1.4426950408889634f * x)); }
DI float gelu_tanh(float x) { const float u = 0.7978845608028654f * (x + 0.044715f * x * x * x); const float e = __expf(2.f * u); const float th = 1.f - 2.f * __builtin_amdgcn_rcpf(e + 1.f); return 0.5f * x * (1.f + th); }
DI float softplusf_(float x) { return fmaxf(x, 0.f) + log1pf(__expf(-fabsf(x))); }
#define LDS_WAIT() asm volatile("s_waitcnt lgkmcnt(0)" ::: "memory")
#define VM_WAIT() asm volatile("s_waitcnt vmcnt(0)" ::: "memory")

__device__ const unsigned char T5_BUCKET[128] = {
0,1,2,3,4,5,6,7,8,9,10,11,12,13,14,15,16,16,16,17,17,18,18,18,19,19,19,20,20,20,20,21,21,21,21,22,22,22,22,22,23,23,23,23,23,23,24,24,24,24,24,24,25,25,25,25,25,25,25,26,26,26,26,26,26,26,26,27,27,27,27,27,27,27,27,27,27,28,28,28,28,28,28,28,28,28,28,29,29,29,29,29,29,29,29,29,29,29,29,30,30,30,30,30,30,30,30,30,30,30,30,30,30,31,31,31,31,31,31,31,31,31,31,31,31,31,31,31};

#define XB_TMO      128
#define XB_XCNT(j)  (256  + 64 * (j))
#define XB_XSUB(j)  (1280 + 64 * (j))
#define XB_XGEN(j)  (2304 + 64 * (j))
#define XB_TOP      3328
#define XB_TOPGEN   3392
#define XCD_BAR_WORDS 3456
#define XB_SPIN_CAP (1u << 22)
DI unsigned xb_ld(unsigned* p)              { return __hip_atomic_load(p, __ATOMIC_RELAXED, __HIP_MEMORY_SCOPE_AGENT); }
DI unsigned xb_add(unsigned* p, unsigned v) { return __hip_atomic_fetch_add(p, v, __ATOMIC_RELAXED, __HIP_MEMORY_SCOPE_AGENT); }
DI unsigned xb_xcc_id() { return (unsigned)__builtin_amdgcn_s_getreg((3 << 11) | 20) & 0xFu; }
#define XB_SPIN(cond, bar) do { unsigned _sp = 0; while (cond) { __builtin_amdgcn_s_sleep(1); \
    if ((++_sp & 255u) == 0u) { if (xb_ld(&(bar)[XB_TMO])) break; if (_sp > XB_SPIN_CAP) { atomicAdd(&(bar)[XB_TMO], 1u); break; } } } } while (0)
struct XcdBarrier { unsigned* bar; unsigned x; volatile LAS unsigned* st; };
DI XcdBarrier xcd_barrier_post(unsigned* bar, volatile LAS unsigned* st, bool leader) {
    XcdBarrier b; b.bar = bar; b.x = xb_xcc_id(); b.st = st;
    if (leader) (void)xb_add(&bar[XB_XCNT(b.x)], 1u);
    return b;
}
DI void xcd_barrier_complete(unsigned* bar, unsigned x, unsigned& nloc, unsigned& nx) {
    const unsigned G = gridDim.x * gridDim.y * gridDim.z;
    unsigned sum, cnt, mine, sp = 0u;
    for (;;) {
        sum = 0u; cnt = 0u; mine = 0u;
#pragma unroll
        for (unsigned j = 0; j < 16; ++j) { const unsigned c = xb_ld(&bar[XB_XCNT(j)]); sum += c; cnt += (c > 0u) ? 1u : 0u; mine = (j == x) ? c : mine; }
        if (sum == G) break;
        __builtin_amdgcn_s_sleep(1);
        if ((++sp & 255u) == 0u) { if (xb_ld(&bar[XB_TMO])) break; if (sp > XB_SPIN_CAP) { atomicAdd(&bar[XB_TMO], 1u); break; } }
    }
    nloc = mine > 0u ? mine : 1u; nx = cnt > 0u ? cnt : 1u;
}
DI void xcd_barrier(const XcdBarrier& b, bool leader) {
    asm volatile("s_waitcnt vmcnt(0)" ::: "memory");
    __syncthreads();
    if (leader) {
        unsigned* bar = b.bar;
        __builtin_amdgcn_s_waitcnt(0);
        unsigned nloc = b.st[0], nx = b.st[1];
        if (nloc == 0u) { xcd_barrier_complete(bar, b.x, nloc, nx); b.st[0] = nloc; b.st[1] = nx; }
        const unsigned old = xb_add(&bar[XB_XSUB(b.x)], 1u);
        const unsigned gen = old / nloc;
        if (old + 1u == (gen + 1u) * nloc) {
            __builtin_amdgcn_fence(__ATOMIC_RELEASE, "agent");
            asm volatile("s_waitcnt vmcnt(0)" ::: "memory");
            const unsigned og = xb_add(&bar[XB_TOP], 1u);
            const unsigned tg = og / nx;
            if (og + 1u == (tg + 1u) * nx) xb_add(&bar[XB_TOPGEN], 1u);
            else XB_SPIN(xb_ld(&bar[XB_TOPGEN]) == tg, bar);
            __builtin_amdgcn_fence(__ATOMIC_ACQUIRE, "agent");
            xb_add(&bar[XB_XGEN(b.x)], 1u);
            asm volatile("s_waitcnt vmcnt(0)" ::: "memory");
        } else {
            XB_SPIN(xb_ld(&bar[XB_XGEN(b.x)]) == gen, bar);
            __builtin_amdgcn_fence(__ATOMIC_ACQUIRE, "agent");
            asm volatile("s_waitcnt vmcnt(0)" ::: "memory");
        }
    }
    __syncthreads();
}

namespace pg8 {
constexpr int BM = 256, BK = 64, HALF = 128, HTB = HALF * BK * 2;
__host__ __device__ __forceinline__ int lds_byte(int r, int c) { const int st = (r >> 4) * 2 + (c >> 5), rr = r & 15, cc = c & 31, ob = rr * 64 + cc * 2; return st * 1024 + (ob ^ (((ob >> 9) & 1) << 5)); }
__host__ __device__ __forceinline__ void stage_rc(int b, int& R, int& C) { const int st = b / 1024, sb = b % 1024, swz = sb ^ (((sb >> 9) & 1) << 5); R = (st >> 1) * 16 + swz / 64; C = (st & 1) * 32 + (swz % 64) / 2; }
__host__ __device__ __forceinline__ int perm32(int rho) { const int n = rho >> 4, i = rho & 15; return 8 * (i >> 2) + 4 * n + (i & 3); }
struct Unit { const char* a; const char* b; int pm, pn, aux, pad; };
struct Gemm { int K, lda, ldb, kstepA, hstepA; };
template <bool I8> struct AccT { typedef f32x4 type; };
template <> struct AccT<true> { typedef i32x4 type; };
template <class Epi, class Sched, bool GATHER = false, bool I8 = false>
DI void gemm_phase(LAS unsigned char* lds, const Gemm g, const Sched& S, const Epi& E, int tid_in) {
    int tid = tid_in; asm volatile("" : "+v"(tid));
    const int wid = __builtin_amdgcn_readfirstlane(tid >> 6), lane = tid & 63, wr = wid >> 2, wc = wid & 3, fr = lane & 15, fq = lane >> 4;
    const int K = g.K, nt = K / BK;
    unsigned voffA[2], voffB[2];
#pragma unroll
    for (int i = 0; i < 2; ++i) { int R, C; stage_rc(tid * 16 + i * 8192, R, C); const int Rb = (R & ~31) + perm32(R & 31);
        voffA[i] = (unsigned)(R * g.lda + C) * 2u; voffB[i] = (unsigned)(Rb * g.ldb + C) * 2u; }
    const size_t kstep = (size_t)(BK * 2), kstepA = (size_t)g.kstepA;
    const size_t hstepA = g.hstepA < 0 ? (size_t)HALF * g.lda * 2 : (size_t)g.hstepA, hstepB = (size_t)HALF * g.ldb * 2;
    const unsigned hstepA32 = (unsigned)hstepA;
    unsigned gC[2][2] = {{0u, 0u}, {0u, 0u}}, gN[2][2] = {{0u, 0u}, {0u, 0u}};
    const unsigned ldsw = (unsigned)wid * 1024u;
    const int aoff = lds_byte(wr * 64 + fr, fq * 8), boff = lds_byte(wc * 32 + fr, fq * 8);
#define PG8_SA(b, h) (((b) * 2 + (h)) * HTB)
#define PG8_SB(b, h) ((4 + (b) * 2 + (h)) * HTB)
#define PG8_STAGE(bufoff, gbase, voff) do { _Pragma("unroll") for (int _i = 0; _i < 2; ++_i) \
        __builtin_amdgcn_global_load_lds((const unsigned*)((const char*)(gbase) + (voff)[_i]), (LAS unsigned*)(lds + (bufoff) + ldsw + _i * 8192), 16, 0, 0); } while (0)
#define PG8_STAGEA(bufoff, gbase, h, nextsel) do { _Pragma("unroll") for (int _i = 0; _i < 2; ++_i) { \
        const unsigned _o = GATHER ? ((nextsel) ? gN[h][_i] : gC[h][_i]) : (voffA[_i] + (unsigned)(h) * hstepA32); \
        __builtin_amdgcn_global_load_lds((const unsigned*)((const char*)(gbase) + _o), (LAS unsigned*)(lds + (bufoff) + ldsw + _i * 8192), 16, 0, 0); } } while (0)
#define PG8_LDA(dst, b, h) do { _Pragma("unroll") for (int m = 0; m < 4; ++m) _Pragma("unroll") for (int k = 0; k < 2; ++k) dst[m][k] = *(const LAS bf16x8*)(lds + PG8_SA(b, h) + aoff + m * 2048 + k * 1024); } while (0)
#define PG8_LDB(dst, b, h) do { _Pragma("unroll") for (int n = 0; n < 2; ++n) _Pragma("unroll") for (int k = 0; k < 2; ++k) dst[n][k] = *(const LAS bf16x8*)(lds + PG8_SB(b, h) + boff + n * 2048 + k * 1024); } while (0)
#define PG8_MMA(ai, bj, At, Bt) do { __builtin_amdgcn_s_setprio(1); _Pragma("unroll") for (int m = 0; m < 4; ++m) _Pragma("unroll") for (int n = 0; n < 2; ++n) _Pragma("unroll") for (int k = 0; k < 2; ++k) \
        { if constexpr (I8) acc[ai][bj][m][n] = __builtin_amdgcn_mfma_i32_16x16x64_i8(__builtin_bit_cast(i32x4, Bt[n][k]), __builtin_bit_cast(i32x4, At[m][k]), acc[ai][bj][m][n], 0, 0, 0); \
          else acc[ai][bj][m][n] = __builtin_amdgcn_mfma_f32_16x16x32_bf16(Bt[n][k], At[m][k], acc[ai][bj][m][n], 0, 0, 0); } __builtin_amdgcn_s_setprio(0); } while (0)
#define PG8_WAIT_V(n) asm volatile("s_waitcnt vmcnt(" #n ")" ::: "memory")
#define PG8_WAIT_L(n) asm volatile("s_waitcnt lgkmcnt(" #n ")" ::: "memory")
#define PG8_BAR __builtin_amdgcn_s_barrier()
#define PG8_SCHED __builtin_amdgcn_sched_barrier(0)
    Unit cur, nxt; int ui = 0;
    if (!S.next(0, cur)) return;
    typedef typename AccT<I8>::type ACC;
    ACC acc[2][2][4][2];
#pragma unroll
    for (int a = 0; a < 2; ++a)
#pragma unroll
        for (int b = 0; b < 2; ++b)
#pragma unroll
            for (int m = 0; m < 4; ++m)
#pragma unroll
                for (int n = 0; n < 2; ++n) acc[a][b][m][n] = (ACC){0, 0, 0, 0};
    bf16x8 At[4][2], B0[2][2], B1[2][2];
    const char* cA = cur.a; const char* cB = cur.b;
    if constexpr (GATHER) S.rows(cur, tid, gC);
    PG8_STAGE(PG8_SB(0, 0), cB, voffB); PG8_STAGE(PG8_SB(0, 1), cB + hstepB, voffB); PG8_STAGEA(PG8_SA(0, 0), cA, 0, false); PG8_STAGEA(PG8_SA(0, 1), cA, 1, false);
    if (wr == 1) PG8_BAR;
    PG8_WAIT_V(2); PG8_BAR;
    PG8_STAGE(PG8_SB(1, 0), cB + kstep, voffB); PG8_STAGEA(PG8_SA(1, 0), cA + kstepA, 0, false); PG8_STAGE(PG8_SB(1, 1), cB + hstepB + kstep, voffB);
    PG8_WAIT_V(6); PG8_BAR;
    for (;;) {
        const bool has_next = S.next(ui + 1, nxt);
        const char* nA = has_next ? nxt.a : cA; const char* nB = has_next ? nxt.b : cB;
        if constexpr (GATHER) { if (has_next) S.rows(nxt, tid, gN); else {
#pragma unroll
            for (int h = 0; h < 2; ++h) { gN[h][0] = gC[h][0]; gN[h][1] = gC[h][1]; } } }
        for (int t = 0; t < nt; t += 2) {
            const bool last = (t == nt - 2);
            const char* a1 = cA + (size_t)(t + 1) * kstepA;
            const char* a2 = last ? nA : cA + (size_t)(t + 2) * kstepA; const char* b2 = last ? nB : cB + (size_t)(t + 2) * kstep;
            const char* a3 = a2 + kstepA; const char* b3 = b2 + kstep;
            PG8_LDB(B0, 0, 0); PG8_LDB(B1, 0, 1); PG8_SCHED; PG8_LDA(At, 0, 0); PG8_STAGEA(PG8_SA(1, 1), a1, 1, false);
            PG8_WAIT_V(8); PG8_WAIT_L(0); PG8_BAR; PG8_MMA(0, 0, At, B0); PG8_MMA(0, 1, At, B1); PG8_BAR; PG8_SCHED;
            PG8_LDA(At, 0, 1); PG8_STAGE(PG8_SB(0, 0), b2, voffB); PG8_STAGE(PG8_SB(0, 1), b2 + hstepB, voffB); PG8_STAGEA(PG8_SA(0, 0), a2, 0, last);
            PG8_WAIT_V(8); PG8_WAIT_L(0); PG8_BAR; PG8_MMA(1, 0, At, B0); PG8_MMA(1, 1, At, B1); PG8_BAR; PG8_SCHED;
            PG8_LDB(B0, 1, 0); PG8_LDB(B1, 1, 1); PG8_SCHED; PG8_LDA(At, 1, 0); PG8_STAGEA(PG8_SA(0, 1), a2, 1, last);
            PG8_WAIT_V(8); PG8_WAIT_L(0); PG8_BAR; PG8_MMA(0, 0, At, B0); PG8_MMA(0, 1, At, B1); PG8_BAR; PG8_SCHED;
            PG8_LDA(At, 1, 1); PG8_STAGE(PG8_SB(1, 0), b3, voffB); PG8_STAGE(PG8_SB(1, 1), b3 + hstepB, voffB); PG8_STAGEA(PG8_SA(1, 0), a3, 0, last);
            PG8_WAIT_V(8); PG8_WAIT_L(0); PG8_BAR; PG8_MMA(1, 0, At, B0); PG8_MMA(1, 1, At, B1); PG8_BAR; PG8_SCHED;
        }
        if (wr == 0) PG8_BAR;
        { const int el = my_lane(); E(acc, cur, wr, wc, el & 15, el >> 4); }
        if (!has_next) break;
        bool carried = false;
        if constexpr (Epi::CARRY) { if (nxt.aux != 0) { const int el = my_lane(); E.carry(acc, nxt, wr, wc, el & 15, el >> 4); carried = true; } }
        if (!carried) {
#pragma unroll
        for (int a = 0; a < 2; ++a)
#pragma unroll
            for (int b = 0; b < 2; ++b)
#pragma unroll
                for (int m = 0; m < 4; ++m)
#pragma unroll
                    for (int n = 0; n < 2; ++n) acc[a][b][m][n] = (ACC){0, 0, 0, 0};
        }
        cur = nxt; cA = nA; cB = nB; ++ui;
        if constexpr (GATHER) {
#pragma unroll
            for (int h = 0; h < 2; ++h) { gC[h][0] = gN[h][0]; gC[h][1] = gN[h][1]; } }
        if (wr == 1) PG8_BAR;
    }
    PG8_WAIT_V(0);
    PG8_BAR;
#undef PG8_SA
#undef PG8_SB
#undef PG8_STAGE
#undef PG8_STAGEA
#undef PG8_LDA
#undef PG8_LDB
#undef PG8_MMA
#undef PG8_WAIT_V
#undef PG8_WAIT_L
#undef PG8_BAR
#undef PG8_SCHED
}
}
using pg8::Unit;

DI unsigned cvt_pk_bf16(float lo, float hi) { unsigned r; asm volatile("s_nop 1\n\tv_cvt_pk_bf16_f32 %0, %1, %2" : "=v"(r) : "v"(lo), "v"(hi)); return r; }
DI u32x4 pack8(const f32x4& v0, const f32x4& v1) { u32x4 w; w.x = cvt_pk_bf16(v0[0], v0[1]); w.y = cvt_pk_bf16(v0[2], v0[3]); w.z = cvt_pk_bf16(v1[0], v1[1]); w.w = cvt_pk_bf16(v1[2], v1[3]); return w; }

struct SchedP1 {
    const char* A; const char* B; int nM, nN, rbA, rbB, G, c;
    DI bool next(int i, Unit& u) const {
        constexpr int NXCD = 8, WGM = 8; const int nwg = nM * nN;
        const long L = (long)i * G + c; if (L >= nwg) return false;
        int wgid = (int)L; { const int q = nwg / NXCD, r = nwg % NXCD, xcd = wgid % NXCD, off = wgid / NXCD; wgid = (xcd < r ? xcd * (q + 1) : r * (q + 1) + (xcd - r) * q) + off; }
        const int nig = WGM * nN, gid = wgid / nig, fm = gid * WGM, gsz = (nM - fm) < WGM ? (nM - fm) : WGM;
        u.pm = fm + ((wgid % nig) % gsz); u.pn = (wgid % nig) / gsz; u.aux = 0; u.pad = 0;
        u.a = A + (size_t)u.pm * 256 * rbA; u.b = B + (size_t)u.pn * 256 * rbB; return true;
    }
};
struct SchedP3a {
    const char* ys; const char* wbr; int G, c;
    DI bool next(int i, Unit& u) const {
        const int tile = (i >> 2) * G + c; if (tile >= 512) return false;
        const int br = i & 3; u.pm = tile >> 2; u.pn = tile & 3; u.aux = br; u.pad = 0;
        u.a = ys + ((size_t)u.pm * 256 * 1024 + br * 256) * 2; u.b = wbr + ((size_t)br * 1024 * 256 + (size_t)u.pn * 256 * 256) * 2; return true;
    }
};
struct SchedP3b {
    const char* A; const char* B; int G, c;
    DI bool next(int i, Unit& u) const {
        const int L = i * G + c; if (L >= 512) return false;
        u.pm = L >> 2; u.pn = L & 3; u.aux = 0; u.pad = 0;
        u.a = A + (size_t)u.pm * 256 * 1024 * 2; u.b = B + (size_t)u.pn * 256 * 1024 * 2; return true;
    }
};
struct SchedM2 {
    const char* xr; const char* wgu; const LAS int* offt; const int* rowsrc; int G, c;
    DI bool next(int i, Unit& u) const {
        const int NT = __builtin_amdgcn_readfirstlane(offt[32]) >> 8; const int L = i * G + c; if (L >= NT * 2) return false;
        const int rt = L >> 1, pn = L & 1; const int e = __builtin_amdgcn_readfirstlane(offt[40 + rt]);
        u.pm = rt; u.pn = pn; u.aux = e; u.pad = 0;
        u.a = xr; u.b = wgu + ((size_t)e * 512 + pn * 256) * 1024 * 2; return true;
    }
    DI void rows(const Unit& u, int tid, unsigned (&g)[2][2]) const {
        const int e = u.aux; const int base = u.pm * 256 - __builtin_amdgcn_readfirstlane(offt[e]), cnt = __builtin_amdgcn_readfirstlane(offt[330 + e]);
#pragma unroll
        for (int i = 0; i < 2; ++i) { int R, C; pg8::stage_rc(tid * 16 + i * 8192, R, C);
#pragma unroll
            for (int h = 0; h < 2; ++h) { const int lr = base + h * 128 + R; const int as = lr < cnt ? rowsrc[e * 32768 + lr] : 0;
                g[h][i] = (unsigned)(as >> 1) * 4096u + (unsigned)C * 2u; } }
    }
};
struct SchedM3 {
    const char* hmid; const char* wd; const LAS int* offt; int G, c;
    DI bool next(int i, Unit& u) const {
        const int NT = __builtin_amdgcn_readfirstlane(offt[32]) >> 8; const int L = i * G + c; if (L >= NT * 4) return false;
        const int rt = L >> 2, pn = L & 3; const int e = __builtin_amdgcn_readfirstlane(offt[40 + rt]);
        u.pm = rt; u.pn = pn; u.aux = e; u.pad = 0;
        u.a = hmid + (size_t)rt * 256 * 256 * 2; u.b = wd + ((size_t)e * 1024 + pn * 256) * 256 * 2; return true;
    }
};

struct EpiP1I8 {
    static constexpr bool CARRY = false;
    bf16* proj; unsigned char* gates; const float* bgate; const float* hsc; const float* wsc;
    DI void operator()(const i32x4 (&acc)[2][2][4][2], const Unit& u, int wr, int wc, int fr, int fq) const {
        const int row0 = u.pm * 256 + wr * 64 + fr;
        if (u.pn < 10) { const int colt = u.pn * 256 + wc * 32 + 8 * fq;
            f32x4 sv[2][2]; float rsv[2][4];
#pragma unroll
            for (int bj = 0; bj < 2; ++bj)
#pragma unroll
                for (int n = 0; n < 2; ++n) sv[bj][n] = *(const GAS f32x4*)((const GAS float*)wsc + colt + bj * 128 + 4 * n);
#pragma unroll
            for (int ai = 0; ai < 2; ++ai)
#pragma unroll
                for (int m = 0; m < 4; ++m) rsv[ai][m] = ((const GAS float*)hsc)[row0 + ai * 128 + m * 16];
#pragma unroll
            for (int ai = 0; ai < 2; ++ai)
#pragma unroll
                for (int m = 0; m < 4; ++m) { bf16* rowp = proj + (size_t)(row0 + ai * 128 + m * 16) * PLD + colt; const float rs = rsv[ai][m];
#pragma unroll
                    for (int bj = 0; bj < 2; ++bj) { f32x4 v0, v1;
#pragma unroll
                        for (int e = 0; e < 4; ++e) { v0[e] = (float)acc[ai][bj][m][0][e] * (rs * sv[bj][0][e]); v1[e] = (float)acc[ai][bj][m][1][e] * (rs * sv[bj][1][e]); }
                        *(u32x4*)(rowp + bj * 128) = pack8(v0, v1); } }
            return; }
        const int gcol = (u.pn - 10) * 256 + wc * 32 + 8 * fq; const float* wsc = this->wsc + 2560;
        f32x4 bv[2][2], sv[2][2];
#pragma unroll
        for (int bj = 0; bj < 2; ++bj)
#pragma unroll
            for (int n = 0; n < 2; ++n) { bv[bj][n] = *(const f32x4*)(bgate + gcol + bj * 128 + 4 * n); sv[bj][n] = *(const f32x4*)(wsc + gcol + bj * 128 + 4 * n);
                sv[bj][n] = sv[bj][n] * -1.4426950408889634f; bv[bj][n] = bv[bj][n] * -1.4426950408889634f + (-8.f + 2.2e-5f); }
        float rsv[2][4];
#pragma unroll
        for (int ai = 0; ai < 2; ++ai)
#pragma unroll
            for (int m = 0; m < 4; ++m) rsv[ai][m] = ((const GAS float*)hsc)[row0 + ai * 128 + m * 16];
#pragma unroll
        for (int ai = 0; ai < 2; ++ai)
#pragma unroll
            for (int m = 0; m < 4; ++m) { const float rs = rsv[ai][m];
                unsigned char* rowp = gates + ((size_t)(u.pm * 16 + (u.pn - 10)) * 65536 + (size_t)((ai * 4 + m) * 8192 + (wr * 4 + wc) * 512 + (fq * 16 + fr) * 8));
#pragma unroll
                for (int bj = 0; bj < 2; ++bj) { unsigned q[8];
#pragma unroll
                    for (int n = 0; n < 2; ++n)
#pragma unroll
                        for (int e = 0; e < 4; ++e) { const float xe = ((float)acc[ai][bj][m][n][e] * rs) * sv[bj][n][e] + bv[bj][n][e];
                            q[4 * n + e] = (unsigned)__builtin_amdgcn_rcpf(0.00390631f + __builtin_amdgcn_exp2f(xe)); }
                    u32x2 w; w.x = q[0] | (q[1] << 8) | (q[2] << 16) | (q[3] << 24); w.y = q[4] | (q[5] << 8) | (q[6] << 16) | (q[7] << 24);
                    *(u32x2*)(rowp + bj * 4096) = w; }
                __builtin_amdgcn_sched_barrier(0); }
    }
};
struct EpiP3a {
    static constexpr bool CARRY = true;
    bf16* merged; const unsigned char* gates;
    DI void carry(f32x4 (&acc)[2][2][4][2], const Unit& u, int wr, int wc, int fr, int fq) const {
        const GAS unsigned char* gb = (const GAS unsigned char*)gates + (size_t)(u.pm * 16 + (u.aux - 1) * 4 + u.pn) * 65536;
        const unsigned go = (unsigned)((wr * 4 + wc) * 512 + (fq * 16 + fr) * 8);
        u32x2 gp[2][4][2], gn[2][4][2];
#pragma unroll
        for (int ai = 0; ai < 2; ++ai)
#pragma unroll
            for (int m = 0; m < 4; ++m)
#pragma unroll
                for (int bj = 0; bj < 2; ++bj) { gp[ai][m][bj] = *(const GAS u32x2*)(gb + go + (unsigned)(((ai * 4 + m) * 2 + bj) * 4096));
                    gn[ai][m][bj] = *(const GAS u32x2*)(gb + go + (unsigned)(((ai * 4 + m) * 2 + bj) * 4096 + 4 * 65536)); }
#pragma unroll
        for (int ai = 0; ai < 2; ++ai) {
#pragma unroll
            for (int m = 0; m < 4; ++m)
#pragma unroll
                for (int bj = 0; bj < 2; ++bj) {
#pragma unroll
                    for (int n = 0; n < 2; ++n) { const unsigned p4 = n ? gp[ai][m][bj].y : gp[ai][m][bj].x, n4 = n ? gn[ai][m][bj].y : gn[ai][m][bj].x;
#pragma unroll
                        for (int e = 0; e < 4; ++e) acc[ai][bj][m][n][e] *= ((float)((p4 >> (8 * e)) & 255u) + 0.5f) * __builtin_amdgcn_rcpf((float)((n4 >> (8 * e)) & 255u) + 0.5f); } }
            __builtin_amdgcn_sched_barrier(0); }
    }
    DI void operator()(const f32x4 (&acc)[2][2][4][2], const Unit& u, int wr, int wc, int fr, int fq) const {
        if (u.aux != 3) return;
        const GAS unsigned char* gb = (const GAS unsigned char*)gates + (size_t)(u.pm * 16 + 3 * 4 + u.pn) * 65536;
        GAS unsigned char* mb = (GAS unsigned char*)merged + ((size_t)(u.pm * 256) * 1024 + u.pn * 256) * 2;
        const unsigned go = (unsigned)((wr * 4 + wc) * 512 + (fq * 16 + fr) * 8), mo = (unsigned)((wr * 64 + fr) * 1024 + wc * 32 + 8 * fq) * 2u;
        u32x2 gw[2][4][2];
#pragma unroll
        for (int ai = 0; ai < 2; ++ai)
#pragma unroll
            for (int m = 0; m < 4; ++m)
#pragma unroll
                for (int bj = 0; bj < 2; ++bj) gw[ai][m][bj] = *(const GAS u32x2*)(gb + go + (unsigned)(((ai * 4 + m) * 2 + bj) * 4096));
#pragma unroll
        for (int ai = 0; ai < 2; ++ai) {
#pragma unroll
            for (int m = 0; m < 4; ++m)
#pragma unroll
                for (int bj = 0; bj < 2; ++bj) {
                    f32x4 v0 = acc[ai][bj][m][0], v1 = acc[ai][bj][m][1]; const u32x2 g2 = gw[ai][m][bj]; const float k256 = 0.00390625f;
#pragma unroll
                    for (int e = 0; e < 4; ++e) { v0[e] *= ((float)((g2.x >> (8 * e)) & 255u) + 0.5f) * k256; v1[e] *= ((float)((g2.y >> (8 * e)) & 255u) + 0.5f) * k256; }
                    *(GAS u32x4*)(mb + mo + (unsigned)((ai * 128 + m * 16) * 1024 + bj * 128) * 2u) = pack8(v0, v1); }
            __builtin_amdgcn_sched_barrier(0); }
    }
};
template <bool XF32> struct EpiP3b {
    static constexpr bool CARRY = false;
    const float* xin; bf16* xb_;
    DI void operator()(const f32x4 (&acc)[2][2][4][2], const Unit& u, int wr, int wc, int fr, int fq) const {
        GAS unsigned char* ob = (GAS unsigned char*)xb_ + ((size_t)(u.pm * 256) * 1024 + u.pn * 256) * 2;
        const unsigned lo = (unsigned)((wr * 64 + fr) * 1024 + wc * 32 + 8 * fq);
        if constexpr (XF32) {
            const GAS unsigned char* xb = (const GAS unsigned char*)xin + ((size_t)(u.pm * 256) * 1024 + u.pn * 256) * 4;
#pragma unroll
            for (int ai = 0; ai < 2; ++ai)
#pragma unroll
                for (int mh = 0; mh < 2; ++mh) {
                    f32x4 xv[2][2][2];
#pragma unroll
                    for (int m2 = 0; m2 < 2; ++m2)
#pragma unroll
                        for (int bj = 0; bj < 2; ++bj)
#pragma unroll
                            for (int n = 0; n < 2; ++n) xv[m2][bj][n] = *(const GAS f32x4*)(xb + (lo + (unsigned)((ai * 128 + (mh * 2 + m2) * 16) * 1024 + bj * 128 + 4 * n)) * 4u);
#pragma unroll
                    for (int m2 = 0; m2 < 2; ++m2)
#pragma unroll
                        for (int bj = 0; bj < 2; ++bj)
                            *(GAS u32x4*)(ob + (lo + (unsigned)((ai * 128 + (mh * 2 + m2) * 16) * 1024 + bj * 128)) * 2u) = pack8(xv[m2][bj][0] + acc[ai][bj][mh * 2 + m2][0], xv[m2][bj][1] + acc[ai][bj][mh * 2 + m2][1]);
                    __builtin_amdgcn_sched_barrier(0); }
        } else {
#pragma unroll
            for (int ai = 0; ai < 2; ++ai) {
                u32x4 xv[4][2];
#pragma unroll
                for (int m = 0; m < 4; ++m)
#pragma unroll
                    for (int bj = 0; bj < 2; ++bj) xv[m][bj] = *(const GAS u32x4*)(ob + (lo + (unsigned)((ai * 128 + m * 16) * 1024 + bj * 128)) * 2u);
#pragma unroll
                for (int m = 0; m < 4; ++m)
#pragma unroll
                    for (int bj = 0; bj < 2; ++bj) { const u32x4 x4 = xv[m][bj]; f32x4 v0 = acc[ai][bj][m][0], v1 = acc[ai][bj][m][1];
                        v0[0] += lo_bf(x4.x); v0[1] += hi_bf(x4.x); v0[2] += lo_bf(x4.y); v0[3] += hi_bf(x4.y); v1[0] += lo_bf(x4.z); v1[1] += hi_bf(x4.z); v1[2] += lo_bf(x4.w); v1[3] += hi_bf(x4.w);
                        *(GAS u32x4*)(ob + (lo + (unsigned)((ai * 128 + m * 16) * 1024 + bj * 128)) * 2u) = pack8(v0, v1); }
                __builtin_amdgcn_sched_barrier(0); }
        }
    }
};
struct EpiM2 {
    static constexpr bool CARRY = false;
    bf16* hmid;
    DI void operator()(const f32x4 (&acc)[2][2][4][2], const Unit& u, int wr, int wc, int fr, int fq) const {
        const int row0 = u.pm * 256 + wr * 64 + fr; const int col = u.pn * 128 + wc * 32 + 8 * fq;
#pragma unroll
        for (int ai = 0; ai < 2; ++ai)
#pragma unroll
            for (int m = 0; m < 4; ++m) { f32x4 h0, h1;
#pragma unroll
                for (int e = 0; e < 4; ++e) { const float g0 = acc[ai][0][m][0][e], g1 = acc[ai][0][m][1][e];
                    h0[e] = g0 * sigmoidf_(g0) * acc[ai][1][m][0][e]; h1[e] = g1 * sigmoidf_(g1) * acc[ai][1][m][1][e]; }
                *(u32x4*)(hmid + (size_t)(row0 + ai * 128 + m * 16) * 256 + col) = pack8(h0, h1); }
    }
};
struct EpiM3 {
    static constexpr bool CARRY = false;
    bf16* eo; const int* rowtok; const float* roww; const LAS int* offt;
    DI void operator()(const f32x4 (&acc)[2][2][4][2], const Unit& u, int wr, int wc, int fr, int fq) const {
        const int e = u.aux; const int cnt = __builtin_amdgcn_readfirstlane(offt[330 + e]);
        const int lr0 = u.pm * 256 - __builtin_amdgcn_readfirstlane(offt[e]) + wr * 64 + fr; const int colt = u.pn * 256 + wc * 32 + 8 * fq;
        int tk[2][4]; float wv[2][4];
#pragma unroll
        for (int ai = 0; ai < 2; ++ai)
#pragma unroll
            for (int m = 0; m < 4; ++m) { const int lr = lr0 + ai * 128 + m * 16; tk[ai][m] = -1; wv[ai][m] = 0.f;
                if (lr < cnt) { tk[ai][m] = ((const GAS int*)rowtok)[e * 32768 + lr]; wv[ai][m] = ((const GAS float*)roww)[e * 32768 + lr]; } }
#pragma unroll
        for (int ai = 0; ai < 2; ++ai)
#pragma unroll
            for (int m = 0; m < 4; ++m) {
                if (tk[ai][m] >= 0) { const float w = wv[ai][m]; GAS bf16* op = (GAS bf16*)eo + (size_t)tk[ai][m] * 1024 + colt;
#pragma unroll
                    for (int bj = 0; bj < 2; ++bj) *(GAS u32x4*)(op + bj * 128) = pack8(acc[ai][bj][m][0] * w, acc[ai][bj][m][1] * w); }
                __builtin_amdgcn_sched_barrier(0); }
    }
};

struct Args { const float* in[36]; float* out; unsigned char* ws; int ph_lo, ph_hi; };
struct InTab { unsigned base;
    DI const float* operator[](int i) const { unsigned long long v; const unsigned addr = base + (unsigned)i * 8u;
        asm volatile("ds_read_b64 %0, %1\n\ts_waitcnt lgkmcnt(0)" : "=v"(v) : "v"(addr) : "memory");
        const unsigned lo = __builtin_amdgcn_readfirstlane((unsigned)v), hi = __builtin_amdgcn_readfirstlane((unsigned)(v >> 32));
        return (const float*)(((unsigned long long)hi << 32) | lo); } };
struct KA { InTab in; float* out; unsigned char* ws; };

DI void transpose_item(const float* W_, int ldw, int nvalid, bf16* WT_, int ldt, int k0, int n0, int dst_row0, LAS float* scr, int lane) {
    const GAS float* W = (const GAS float*)W_; GAS bf16* WT = (GAS bf16*)WT_;
    const int nq = 4 * (lane & 7), kr8 = lane >> 3;
    f32x4 v[8];
#pragma unroll
    for (int i = 0; i < 8; ++i) { const int kk = 8 * i + kr8;
        if (n0 + nq + 3 < nvalid) v[i] = *(const GAS f32x4*)(W + (size_t)(k0 + kk) * ldw + n0 + nq);
        else {
#pragma unroll
            for (int e = 0; e < 4; ++e) v[i][e] = (n0 + nq + e < nvalid) ? W[(size_t)(k0 + kk) * ldw + n0 + nq + e] : 0.f; } }
#pragma unroll
    for (int i = 0; i < 8; ++i) { const int kk = 8 * i + kr8;
#pragma unroll
        for (int e = 0; e < 4; ++e) scr[kk * 33 + nq + e] = v[i][e]; }
    LDS_WAIT(); asm volatile("" ::: "memory");
    const int c = lane & 7;
#pragma unroll
    for (int j = 0; j < 4; ++j) { const int n = (lane >> 3) + 8 * j; const LAS float* s = scr + (8 * c) * 33 + n;
        u32x4 o; o.x = pk2(s[0 * 33], s[1 * 33]); o.y = pk2(s[2 * 33], s[3 * 33]); o.z = pk2(s[4 * 33], s[5 * 33]); o.w = pk2(s[6 * 33], s[7 * 33]);
        if (n0 + n < nvalid) *(GAS u32x4*)(WT + (size_t)(dst_row0 + n) * ldt + k0 + 8 * c) = o; }
    LDS_WAIT(); asm volatile("" ::: "memory");
}
DI void phase0_weights(const KA& a, int l, LAS unsigned char* lds, int gw, int NGW, int wave, int lane) {
    LAS float* scr = (LAS float*)(lds + wave * 16384);
    const float* w_in = a.in[4] + (size_t)l * 1024 * NIN;
    const float* w_gate = a.in[24] + (size_t)l * 4 * 1024 * 1024;
    const float* w_br = a.in[26] + (size_t)l * 4 * 256 * 1024;
    const float* w_out = a.in[27] + (size_t)l * 1024 * 1024;
    bf16* Wt_in = (bf16*)(a.ws + WS_WIN); bf16* Wt_br = (bf16*)(a.ws + WS_WBR); bf16* Wt_out = (bf16*)(a.ws + WS_WOUT);
    constexpr int I_B = 4 * 4 * 32, I_O = 16 * 32, NIT = I_B + I_O;
    (void)w_gate; (void)w_in; (void)Wt_in;
    for (int it = gw; it < NIT; it += NGW) {
        int r = it;
        if (r < I_B) { const int br = r / 128, q = r % 128, kb = q / 32, nb = q % 32; transpose_item(w_br + (size_t)br * 256 * 1024, 1024, 1024, Wt_br + (size_t)br * 1024 * 256, 256, kb * 64, nb * 32, nb * 32, scr, lane); continue; } r -= I_B;
        { const int kb = r / 32, nb = r % 32; transpose_item(w_out, 1024, 1024, Wt_out, 1024, kb * 64, nb * 32, nb * 32, scr, lane); }
    }
}
DI void p1_weights_i8(const KA& a, int l, LAS unsigned char* lds, int bid, int G, int wave, int lane) {
    LAS float* scr = (LAS float*)(lds + wave * 16384); LAS float* red = (LAS float*)(lds + 7 * 16384 + 12288);
    const GAS float* wgt = (const GAS float*)(a.in[24] + (size_t)l * 4 * 1024 * 1024); const GAS float* win = (const GAS float*)(a.in[4] + (size_t)l * 1024 * NIN);
    GAS unsigned char* Wq = (GAS unsigned char*)(a.ws + WS_WQ); GAS float* wsc = (GAS float*)(a.ws + WS_WSC);
    const int nq = 4 * (lane & 7), kr8 = lane >> 3;
    for (int it = G - 1 - bid; it < 128 + 77; it += G) {
        const bool isg = it < 128; const int br = it >> 5; const int n0 = isg ? (it & 31) * 32 : (it - 128) * 32;
        const int ldw = isg ? 1024 : NIN; const int nval = isg ? 1024 : NIN; const int drow0 = isg ? 2560 + br * 1024 + n0 : n0;
        const bool lok = (n0 + nq) < nval;
        const GAS float* W = (isg ? wgt + (size_t)br * 1024 * 1024 : win) + n0 + nq + (size_t)(128 * wave) * ldw;
        f32x4 v[16];
#pragma unroll
        for (int i = 0; i < 16; ++i) { v[i] = (f32x4){0.f, 0.f, 0.f, 0.f}; if (lok) v[i] = *(const GAS f32x4*)(W + (size_t)(8 * i + kr8) * ldw); }
        f32x4 mx = {0.f, 0.f, 0.f, 0.f};
#pragma unroll
        for (int i = 0; i < 16; ++i) { mx[0] = fmaxf(mx[0], fabsf(v[i][0])); mx[1] = fmaxf(mx[1], fabsf(v[i][1])); mx[2] = fmaxf(mx[2], fabsf(v[i][2])); mx[3] = fmaxf(mx[3], fabsf(v[i][3])); }
#pragma unroll
        for (int e = 0; e < 4; ++e) { float m = mx[e]; m = fmaxf(m, xshfl<8>(m)); m = fmaxf(m, xshfl<16>(m)); m = fmaxf(m, xshfl<32>(m)); mx[e] = m; }
        if (kr8 == 0) {
#pragma unroll
            for (int e = 0; e < 4; ++e) red[wave * 32 + nq + e] = mx[e]; }
        __syncthreads();
#pragma unroll
        for (int e = 0; e < 4; ++e) { float m = red[nq + e];
#pragma unroll
            for (int w = 1; w < 8; ++w) m = fmaxf(m, red[w * 32 + nq + e]);
            mx[e] = fmaxf(m, 1e-20f); }
        if (wave == 0 && kr8 == 0 && lok) *(GAS f32x4*)(wsc + drow0 + nq) = mx * (1.f / 127.f);
        const f32x4 qs = {127.f / mx[0], 127.f / mx[1], 127.f / mx[2], 127.f / mx[3]};
#pragma unroll
        for (int hb = 0; hb < 2; ++hb) {
#pragma unroll
            for (int i = 0; i < 8; ++i) { const int kk = 8 * i + kr8;
#pragma unroll
                for (int e = 0; e < 4; ++e) scr[kk * 33 + nq + e] = __builtin_rintf(v[8 * hb + i][e] * qs[e]); }
            LDS_WAIT(); asm volatile("" ::: "memory");
            const int n = lane >> 1, kh = lane & 1; u32x4 o[2];
#pragma unroll
            for (int h2 = 0; h2 < 2; ++h2) { unsigned w4[4];
#pragma unroll
                for (int d = 0; d < 4; ++d) { unsigned wv = 0u;
#pragma unroll
                    for (int e = 0; e < 4; ++e) wv |= ((unsigned)(int)scr[(32 * kh + 16 * h2 + 4 * d + e) * 33 + n] & 255u) << (8 * e);
                    w4[d] = wv; }
                o[h2].x = w4[0]; o[h2].y = w4[1]; o[h2].z = w4[2]; o[h2].w = w4[3]; }
            if (n0 + n < nval) { GAS unsigned char* dst = Wq + (size_t)(drow0 + n) * 1024 + 128 * wave + 64 * hb + 32 * kh; *(GAS u32x4*)dst = o[0]; *(GAS u32x4*)(dst + 16) = o[1]; }
            LDS_WAIT(); asm volatile("" ::: "memory");
        }
        __syncthreads();
    }
}

DI void router_weights(const KA& a, int l, int gw, int NGW, int lane) {
    bf16* Wr = (bf16*)(a.ws + WS_WR);
    const float* wg = a.in[29] + (size_t)l * 1024 * 4; const float* we = a.in[31] + (size_t)l * 1024 * 32;
    for (int n = gw; n < 36; n += NGW) {
        for (int i = 0; i < 16; ++i) { const int k = lane + 64 * i; const float w = (n < 4) ? wg[k * 4 + n] : we[k * 32 + (n - 4)];
            const unsigned hi = f2bf(w); const float hf = __builtin_bit_cast(float, hi << 16); const unsigned lo = f2bf(w - hf);
            Wr[(size_t)n * 2048 + k] = (bf16)hi; Wr[(size_t)n * 2048 + 1024 + k] = (bf16)hi; Wr[(size_t)(64 + n) * 2048 + k] = (bf16)lo; Wr[(size_t)(64 + n) * 2048 + 1024 + k] = 0; }
    }
}

DI void cmp_weights(const KA& a, int l, LAS unsigned char* lds, int gw, int NGW, int wave, int lane) {
    LAS float* scr = (LAS float*)(lds + wave * 16384);
    bf16* Wc = (bf16*)(a.ws + WS_WCMP); float* pt = (float*)(a.ws + WS_CMPAB + 2 * MiB);
    for (int it = gw; it < 128 + 64; it += NGW) {
        if (it < 128) { const int kv = it >> 6, q = it & 63, kb = q >> 1, nb = q & 1; const float* w1 = a.in[kv ? 22 : 19] + (size_t)l * 2048 * 64;
            bf16* dst = Wc + (size_t)kv * 256 * 1024 - (kb >= 16 ? 1024 : 0);
            transpose_item(w1, 64, 64, dst, 1024, kb * 64, nb * 32, (kb >= 16 ? 64 : 0) + nb * 32, scr, lane);
        } else { const int kv = (it - 128) >> 5, part = (it - 128) & 31;
            const GAS float* w1 = (const GAS float*)(a.in[kv ? 22 : 19] + (size_t)l * 2048 * 64) + (size_t)part * 64 * 64; const GAS float* pos = (const GAS float*)(a.in[kv ? 21 : 18] + (size_t)l * 2048) + part * 64;
            float acc = 0.f;
#pragma unroll 16
            for (int k = 0; k < 64; ++k) acc += pos[k] * w1[(size_t)k * 64 + lane];
            pt[(kv * 32 + part) * 64 + lane] = acc; }
    }
}

DI void lru_weights(const KA& a, int l, int gw, int NGW, int lane) {
    bf16* W = (bf16*)(a.ws + WS_LRUW); const float* wa = a.in[7] + (size_t)l * 4 * 4096; const float* wx = a.in[9] + (size_t)l * 4 * 4096;
    (void)NGW; { const int idx = gw * 64 + lane; if (idx < 32768) { const int i = idx & 63, j = (idx >> 6) & 63, mat = (idx >> 12) & 1, hbk = idx >> 13;
        W[idx] = (bf16)f2bf((mat ? wx : wa)[(size_t)hbk * 4096 + i * 64 + j]); } }
}
DI void phase0_rows(const KA& a, int l, int mode, int gw, int NGW, int lane) {
    const GAS float* xin = (const GAS float*)a.in[0]; GAS bf16* xb = (GAS bf16*)(a.ws + WS_XB);
    const GAS bf16* eo = (const GAS bf16*)(a.ws + WS_PROJ);
    GAS float* outp = (GAS float*)a.out;
    const GAS float* g = (const GAS float*)(mode ? a.in[2] : (a.in[3] + (size_t)l * 1024));
    f32x4 gv[4];
#pragma unroll
    for (int j = 0; j < 4; ++j) gv[j] = *(const GAS f32x4*)(g + 4 * (lane + 64 * j));
    for (int m0 = gw * 4; m0 < T; m0 += NGW * 4) {
        f32x4 v[4][4]; float ss[4];
#pragma unroll
        for (int rr = 0; rr < 4; ++rr)
#pragma unroll
            for (int j = 0; j < 4; ++j) { if (l == 0) v[rr][j] = *(const GAS f32x4*)(xin + (size_t)(m0 + rr) * 1024 + 4 * (lane + 64 * j));
                else { const u32x2 xw = *(const GAS u32x2*)(xb + (size_t)(m0 + rr) * 1024 + 4 * (lane + 64 * j)); v[rr][j][0] = lo_bf(xw.x); v[rr][j][1] = hi_bf(xw.x); v[rr][j][2] = lo_bf(xw.y); v[rr][j][3] = hi_bf(xw.y); } }
        if (l > 0) {
#pragma unroll
            for (int rr = 0; rr < 4; ++rr)
#pragma unroll
                for (int j = 0; j < 4; ++j) {
                    const u32x2 e0 = *(const GAS u32x2*)(eo + (size_t)(2 * (m0 + rr)) * 1024 + 4 * (lane + 64 * j));
                    const u32x2 e1 = *(const GAS u32x2*)(eo + (size_t)(2 * (m0 + rr) + 1) * 1024 + 4 * (lane + 64 * j));
                    v[rr][j][0] += lo_bf(e0.x) + lo_bf(e1.x); v[rr][j][1] += hi_bf(e0.x) + hi_bf(e1.x); v[rr][j][2] += lo_bf(e0.y) + lo_bf(e1.y); v[rr][j][3] += hi_bf(e0.y) + hi_bf(e1.y); } }
#pragma unroll
        for (int rr = 0; rr < 4; ++rr) { float t = 0.f;
#pragma unroll
            for (int j = 0; j < 4; ++j) t += (v[rr][j][0] * v[rr][j][0] + v[rr][j][1] * v[rr][j][1]) + (v[rr][j][2] * v[rr][j][2] + v[rr][j][3] * v[rr][j][3]);
            ss[rr] = t; }
#pragma unroll
        for (int rr = 0; rr < 4; ++rr) ss[rr] = wave_sum(ss[rr]);
        if (mode) {
#pragma unroll
            for (int rr = 0; rr < 4; ++rr) { const float r = 1.f / sqrtf(ss[rr] * (1.f / 1024.f) + 1e-6f); const size_t m = (size_t)(m0 + rr);
#pragma unroll
                for (int j = 0; j < 4; ++j) *(GAS f32x4*)(outp + m * 1024 + 4 * (lane + 64 * j)) = v[rr][j] * r * gv[j]; }
        } else {
            GAS unsigned char* hq = (GAS unsigned char*)(a.ws + WS_HQ); GAS float* hsc = (GAS float*)(a.ws + WS_HSC);
            float am[4];
#pragma unroll
            for (int rr = 0; rr < 4; ++rr) { const float r = 1.f / sqrtf(ss[rr] * (1.f / 1024.f) + 1e-6f); const size_t m = (size_t)(m0 + rr); float t = 0.f;
#pragma unroll
                for (int j = 0; j < 4; ++j) { if (l > 0) { u32x2 w; w.x = pk2(v[rr][j][0], v[rr][j][1]); w.y = pk2(v[rr][j][2], v[rr][j][3]); *(GAS u32x2*)(xb + m * 1024 + 4 * (lane + 64 * j)) = w; }
                    const f32x4 y = v[rr][j] * r * gv[j]; v[rr][j] = y;
                    t = fmaxf(t, fmaxf(fmaxf(fabsf(y[0]), fabsf(y[1])), fmaxf(fabsf(y[2]), fabsf(y[3])))); }
                am[rr] = t; }
#pragma unroll
            for (int rr = 0; rr < 4; ++rr) am[rr] = fmaxf(wave_max(am[rr]), 1e-20f);
#pragma unroll
            for (int rr = 0; rr < 4; ++rr) { const size_t m = (size_t)(m0 + rr); const float qs = 127.f / am[rr];
                if (lane == 0) hsc[m] = am[rr] * (1.f / 127.f);
#pragma unroll
                for (int j = 0; j < 4; ++j) { const f32x4 y = v[rr][j] * qs;
                    const unsigned q = ((unsigned)(int)__builtin_rintf(y[0]) & 255u) | (((unsigned)(int)__builtin_rintf(y[1]) & 255u) << 8) | (((unsigned)(int)__builtin_rintf(y[2]) & 255u) << 16) | (((unsigned)(int)__builtin_rintf(y[3]) & 255u) << 24);
                    *(GAS unsigned*)(hq + m * 1024 + 4 * (lane + 64 * j)) = q; } }
        }
    }
}

DI int crow(int i, int hh) { return (i & 3) + 8 * (i >> 2) + 4 * hh; }
DI unsigned cvtpk(float lo, float hi) { f32x2 v = {lo, hi}; bf16x2_t b = __builtin_convertvector(v, bf16x2_t); return __builtin_bit_cast(unsigned, b); }
template <int CTRL, int RMASK> DI float dppf(float oldv, float v) { return __builtin_bit_cast(float, __builtin_amdgcn_update_dpp(__builtin_bit_cast(int, oldv), __builtin_bit_cast(int, v), CTRL, RMASK, 0xf, false)); }
template <int CTRL, int RMASK> DI void scan_step(float& a, float& b) {
    const float ap = dppf<CTRL, RMASK>(1.f, a), bp = dppf<CTRL, RMASK>(0.f, b); b = a * bp + b; a = a * ap; }
DI void lru_unit(const KA& a, int l, const GAS bf16* proj, GAS bf16* ys, GAS float* sums, LAS unsigned char* lds, int task, int lane_in, int wave_in, bool final) {
    int lane = lane_in, wave = wave_in; asm volatile("" : "+v"(lane), "+s"(wave));
    const int chunk = task & 31, hbk = (task >> 5) & 3, b = task >> 7;
    const int ts = chunk * 256 + wave * 32; const size_t rowb = (size_t)b * SEQ;
    LAS unsigned char* wl = lds + wave * 16384;
    LAS float* ex = (LAS float*)(lds + LRUEX_OFF); LAS float* cst = (LAS float*)(lds + LRUCST_OFF); LAS float* car = (LAS float*)(lds + LRUCAR_OFF) + wave * 64;
    {
        const int c = hbk * 64 + lane;
        const GAS float* cw = (const GAS float*)(a.in[5] + (size_t)l * 4 * 256);
        const float cw0 = cw[c], cw1 = cw[256 + c], cw2 = cw[512 + c], cw3 = cw[768 + c]; const float cb = a.in[6][l * 256 + c];
        if (wave == 0) { cst[lane] = a.in[8][l * 256 + c]; cst[64 + lane] = a.in[10][l * 256 + c]; cst[128 + lane] = -8.f * softplusf_(-a.in[11][l * 256 + c]); }
        const GAS bf16* xp = proj + (rowb + ts) * PLD + C_AX + c;
        float x3 = (ts >= 3) ? bf2f(*(xp - 3 * PLD)) : 0.f, x2 = (ts >= 2) ? bf2f(*(xp - 2 * PLD)) : 0.f, x1 = (ts >= 1) ? bf2f(*(xp - PLD)) : 0.f;
#pragma unroll 8
        for (int n = 0; n < 32; ++n) { const float x0 = bf2f(xp[(size_t)n * PLD]); const float xc = cb + cw0 * x3 + cw1 * x2 + cw2 * x1 + cw3 * x0;
            *(LAS bf16*)(wl + n * 144 + lane * 2) = (bf16)f2bf(xc); *(LAS float*)(wl + 4608 + n * 272 + lane * 4) = xc; x3 = x2; x2 = x1; x1 = x0; }
    }
    const int n = lane & 31, hh = lane >> 5;
    f32x16 D[4];
    {
        const GAS bf16* wt = (const GAS bf16*)(a.ws + WS_LRUW) + (size_t)hbk * 8192;
        bf16x8 bfr[4];
        LDS_WAIT();
#pragma unroll
        for (int s4 = 0; s4 < 4; ++s4) bfr[s4] = *(const LAS bf16x8*)(wl + n * 144 + hh * 16 + s4 * 32);
#pragma unroll
        for (int m = 0; m < 4; ++m) {
#pragma unroll
            for (int s4 = 0; s4 < 4; ++s4) { const bf16x8 af = *(const GAS bf16x8*)(wt + (size_t)(m >> 1) * 4096 + (32 * (m & 1) + n) * 64 + 8 * hh + 16 * s4);
                if (s4 == 0) { f32x16 z;
#pragma unroll
                    for (int i = 0; i < 16; ++i) z[i] = 0.f;
                    D[m] = MFMA32(af, bfr[s4], z); } else D[m] = MFMA32(af, bfr[s4], D[m]); } }
    }
    __syncthreads();
    const bool t0 = (ts + n) == 0;
#pragma unroll
    for (int mm = 0; mm < 2; ++mm)
#pragma unroll
        for (int g4 = 0; g4 < 4; ++g4) { const int c0 = 32 * mm + 8 * g4 + 4 * hh;
            const f32x4 vba = *(const LAS f32x4*)(cst + c0), vbx = *(const LAS f32x4*)(cst + 64 + c0), vc8 = *(const LAS f32x4*)(cst + 128 + c0);
            const f32x4 vxc = *(const LAS f32x4*)(wl + 4608 + n * 272 + c0 * 4);
#pragma unroll
            for (int e = 0; e < 4; ++e) { const int i = 4 * g4 + e;
                const float r = sigmoidf_(D[mm][i] + vba[e]), ig = sigmoidf_(D[2 + mm][i] + vbx[e]);
                const float la = vc8[e] * r; const float av = __expf(la);
                const float mult = t0 ? 1.f : sqrtf(fmaxf(1.f - __expf(2.f * la), 0.f));
                float aa = av, bb = mult * ig * vxc[e];
                scan_step<0x111, 0xf>(aa, bb); scan_step<0x112, 0xf>(aa, bb); scan_step<0x114, 0xf>(aa, bb); scan_step<0x118, 0xf>(aa, bb); scan_step<0x142, 0xa>(aa, bb);
                D[mm][i] = aa; D[2 + mm][i] = bb; } }
    if (n == 31) {
#pragma unroll
        for (int mm = 0; mm < 2; ++mm)
#pragma unroll
            for (int i = 0; i < 16; ++i) { const int c = 32 * mm + crow(i, hh); ex[(wave * 64 + c) * 2] = D[mm][i]; ex[(wave * 64 + c) * 2 + 1] = D[2 + mm][i]; } }
    __syncthreads();
    if (!final) {
        if (wave == 0) { float hv = 0.f, av = 1.f;
#pragma unroll
            for (int w = 0; w < 8; ++w) { const float A_ = ex[(w * 64 + lane) * 2], H_ = ex[(w * 64 + lane) * 2 + 1]; hv = A_ * hv + H_; av *= A_; }
            GAS float* sp = sums + ((size_t)((b * 4 + hbk) * 32 + chunk) * 64 + lane) * 2; sp[0] = av; sp[1] = hv; }
    } else {
        {   float hv = 0.f;
            {   const GAS f32x2* sp = (const GAS f32x2*)(sums + ((size_t)((b * 4 + hbk) * 32) * 64 + lane) * 2);
                int cc = 0;
                for (; cc + 8 <= chunk; cc += 8) { f32x2 v[8];
#pragma unroll
                    for (int e = 0; e < 8; ++e) v[e] = sp[(size_t)(cc + e) * 64];
#pragma unroll
                    for (int e = 0; e < 8; ++e) hv = v[e][0] * hv + v[e][1]; }
                for (; cc < chunk; ++cc) { const f32x2 v = sp[(size_t)cc * 64]; hv = v[0] * hv + v[1]; } }
            for (int w = 0; w < wave; ++w) { const float A_ = ex[(w * 64 + lane) * 2], H_ = ex[(w * 64 + lane) * 2 + 1]; hv = A_ * hv + H_; }
            car[lane] = hv; }
        LDS_WAIT(); asm volatile("" ::: "memory");
        const GAS bf16* gp = proj + (rowb + ts + n) * PLD + C_AG + hbk * 64; GAS bf16* yp = ys + (rowb + ts + n) * 1024 + hbk * 64;
#pragma unroll
        for (int mm = 0; mm < 2; ++mm)
#pragma unroll
            for (int g4 = 0; g4 < 4; ++g4) { const int c0 = 32 * mm + 8 * g4 + 4 * hh; const f32x4 cv = *(const LAS f32x4*)(car + c0);
                const u32x2 gt2 = *(const GAS u32x2*)(gp + c0); float y[4];
#pragma unroll
                for (int e = 0; e < 4; ++e) { const int i = 4 * g4 + e; const float hv = D[2 + mm][i] + D[mm][i] * cv[e];
                    const float gt = (e == 0) ? lo_bf(gt2.x) : (e == 1) ? hi_bf(gt2.x) : (e == 2) ? lo_bf(gt2.y) : hi_bf(gt2.y); y[e] = hv * gelu_tanh(gt); }
                u32x2 yo; yo.x = cvtpk(y[0], y[1]); yo.y = cvtpk(y[2], y[3]); *(GAS u32x2*)(yp + c0) = yo; }
    }
    __syncthreads();
}

constexpr int DK_STR = 144, DV_STR = 192, DBUF_BYTES = 64 * DK_STR + 64 * DV_STR;
DI bf16x8 pack_half(const f32x16& x, int s2) { u32x4 p;
    if (s2 == 0) { p.x = cvtpk(x[0], x[1]); p.y = cvtpk(x[2], x[3]); p.z = cvtpk(x[4], x[5]); p.w = cvtpk(x[6], x[7]); }
    else { p.x = cvtpk(x[8], x[9]); p.y = cvtpk(x[10], x[11]); p.z = cvtpk(x[12], x[13]); p.w = cvtpk(x[14], x[15]); }
    return __builtin_bit_cast(bf16x8, p); }
DI s16x4 vtr(const LAS unsigned char* p) { return __builtin_bit_cast(s16x4, __builtin_amdgcn_ds_read_tr16_b64_v4i16((LAS v4i16_t*)p)); }
DI float max16(const f32x16& x) { float a = fmaxf(fmaxf(x[0], x[1]), fmaxf(x[2], x[3])), b = fmaxf(fmaxf(x[4], x[5]), fmaxf(x[6], x[7])), c = fmaxf(fmaxf(x[8], x[9]), fmaxf(x[10], x[11])), d = fmaxf(fmaxf(x[12], x[13]), fmaxf(x[14], x[15])); return fmaxf(fmaxf(a, b), fmaxf(c, d)); }
DI void diff_unit(const GAS bf16* proj, GAS bf16* ys, LAS unsigned char* lds, const LAS float* bias2, const GAS float* subg, const LAS float* lamp, int b, int h, int qb, int wave_in) {
    int wave = wave_in; asm volatile("" : "+s"(wave)); const int lane = my_lane(); const int tid = wave * 64 + lane;
    const int q0 = qb * 256 + wave * 32; const int ql = lane & 31, hh = lane >> 5; const int q = q0 + ql;
    const size_t rowb = (size_t)b * SEQ;
    const float SC = 0.17677669529663687f * 1.4426950408889634f;
    bf16x8 qf[2][2];
    { const GAS bf16* qp = proj + (rowb + q) * PLD + C_CQ + h * 64 + hh * 8;
#pragma unroll
      for (int m = 0; m < 2; ++m)
#pragma unroll
        for (int s = 0; s < 2; ++s) { const u32x4 w = *(const GAS u32x4*)(qp + m * 32 + s * 16); u32x4 o;
            o.x = cvtpk(lo_bf(w.x) * SC, hi_bf(w.x) * SC); o.y = cvtpk(lo_bf(w.y) * SC, hi_bf(w.y) * SC); o.z = cvtpk(lo_bf(w.z) * SC, hi_bf(w.z) * SC); o.w = cvtpk(lo_bf(w.w) * SC, hi_bf(w.w) * SC);
            qf[m][s] = __builtin_bit_cast(bf16x8, o); } }
    f32x16 O[2][2], negm[2];
#pragma unroll
    for (int i = 0; i < 16; ++i) { O[0][0][i] = 0.f; O[0][1][i] = 0.f; O[1][0][i] = 0.f; O[1][1][i] = 0.f; negm[0][i] = 120.f; negm[1][i] = 120.f; }
    float lsum[2] = {0.f, 0.f};
    const int nsteps = 4 * qb + 4, mysteps = 4 * qb + (wave >> 1) + 1;
    const int skey = tid >> 3, sch = tid & 7;
    const GAS unsigned char* kgb = (const GAS unsigned char*)(proj + rowb * PLD + C_CK + h * 64);
    const GAS unsigned char* vgb = (const GAS unsigned char*)(proj + rowb * PLD + C_CV + h * 64);
    const unsigned soff = (unsigned)(skey * PLD + sch * 8) * 2u;
    u32x4 kr = *(const GAS u32x4*)(kgb + soff), vr = *(const GAS u32x4*)(vgb + soff);
    *(LAS u32x4*)(lds + skey * DK_STR + sch * 16) = kr; *(LAS u32x4*)(lds + 64 * DK_STR + skey * DV_STR + sch * 16) = vr;
    __syncthreads();
    const int i16 = lane & 15, blk = (lane >> 4) & 1;
    const int kboff = ql * DK_STR + hh * 16;
    const int vboff = 64 * DK_STR + (4 * hh + (i16 >> 2)) * DV_STR + (16 * blk + 4 * (i16 & 3)) * 2;
#pragma unroll 1
    for (int kt = 0; kt < nsteps; ++kt) {
        const LAS unsigned char* cur = lds + (kt & 1) * DBUF_BYTES; LAS unsigned char* nxt = lds + ((kt + 1) & 1) * DBUF_BYTES;
        if (kt + 1 < nsteps) { const unsigned so = soff + (unsigned)(kt + 1) * (64u * PLD * 2u); kr = *(const GAS u32x4*)(kgb + so); vr = *(const GAS u32x4*)(vgb + so); }
        if (kt < mysteps) {
            const int kbase = kt * 64;
            const bool near = (q0 - (kbase + 63) < 113);
#pragma unroll
            for (int m = 0; m < 2; ++m) {
                bf16x8 pk[2][2];
                f32x16 S[2]; float ts = 0.f;
                {   bf16x8 kf[2][2];
#pragma unroll
                    for (int t = 0; t < 2; ++t)
#pragma unroll
                        for (int s = 0; s < 2; ++s) kf[t][s] = *(const LAS bf16x8*)(cur + kboff + t * 32 * DK_STR + m * 64 + s * 32);
#pragma unroll
                    for (int t = 0; t < 2; ++t) { S[t] = MFMA32(kf[t][0], qf[m][0], negm[m]); S[t] = MFMA32(kf[t][1], qf[m][1], S[t]); } }
                if (near) {
#pragma unroll
                    for (int t = 0; t < 2; ++t)
#pragma unroll
                        for (int g = 0; g < 2; ++g) { float tb[8];
#pragma unroll
                            for (int j = 0; j < 8; ++j) { const int dist = q - (kbase + 32 * t + crow(8 * g + j, hh)); const int di = dist < 0 ? 0 : (dist < 128 ? dist : 128); tb[j] = bias2[di * 12 + 4 + h]; }
#pragma unroll
                            for (int j = 0; j < 8; ++j) { const int dist = q - (kbase + 32 * t + crow(8 * g + j, hh)); S[t][8 * g + j] += dist >= 0 ? tb[j] : -1e30f; }
                            __builtin_amdgcn_sched_barrier(0); } }
#pragma unroll
                for (int t = 0; t < 2; ++t)
#pragma unroll
                    for (int i = 0; i < 16; ++i) { const float p = __builtin_amdgcn_exp2f(S[t][i]); S[t][i] = p; ts += p; }
                if (__builtin_amdgcn_ballot_w64(!(ts < 1.0e30f)) != 0ull) {
                {   bf16x8 kf[2][2];
#pragma unroll
                        for (int t = 0; t < 2; ++t)
#pragma unroll
                            for (int s = 0; s < 2; ++s) kf[t][s] = *(const LAS bf16x8*)(cur + kboff + t * 32 * DK_STR + m * 64 + s * 32);
#pragma unroll
                        for (int t = 0; t < 2; ++t) { S[t] = MFMA32(kf[t][0], qf[m][0], negm[m]); S[t] = MFMA32(kf[t][1], qf[m][1], S[t]); } }
                    if (near) {
#pragma unroll
                        for (int t = 0; t < 2; ++t)
#pragma unroll
                            for (int g = 0; g < 2; ++g) { float tb[8];
#pragma unroll
                                for (int j = 0; j < 8; ++j) { const int dist = q - (kbase + 32 * t + crow(8 * g + j, hh)); const int di = dist < 0 ? 0 : (dist < 128 ? dist : 128); tb[j] = bias2[di * 12 + 4 + h]; }
#pragma unroll
                                for (int j = 0; j < 8; ++j) { const int dist = q - (kbase + 32 * t + crow(8 * g + j, hh)); S[t][8 * g + j] += dist >= 0 ? tb[j] : -1e30f; }
                                __builtin_amdgcn_sched_barrier(0); } }
                    float tm = fmaxf(max16(S[0]), max16(S[1])); tm = fmaxf(tm, xshfl<32>(tm));
                    const float sh = fmaxf(tm, 0.f); const float al = __builtin_amdgcn_exp2f(-sh);
                    lsum[m] *= al; ts = 0.f;
#pragma unroll
                    for (int i = 0; i < 16; ++i) { O[m][0][i] *= al; O[m][1][i] *= al; negm[m][i] -= sh; }
#pragma unroll
                    for (int t = 0; t < 2; ++t)
#pragma unroll
                        for (int i = 0; i < 16; ++i) { const float p = __builtin_amdgcn_exp2f(S[t][i] - sh); S[t][i] = p; ts += p; }
                }
                lsum[m] += ts;
#pragma unroll
                for (int t = 0; t < 2; ++t) { pk[t][0] = pack_half(S[t], 0); pk[t][1] = pack_half(S[t], 1); }
#pragma unroll
                for (int t = 0; t < 2; ++t)
#pragma unroll
                    for (int s2 = 0; s2 < 2; ++s2)
#pragma unroll
                        for (int db = 0; db < 2; ++db) {
                            const s16x4 lo = vtr(cur + vboff + (32 * t + 16 * s2) * DV_STR + db * 64), hi = vtr(cur + vboff + (32 * t + 16 * s2 + 8) * DV_STR + db * 64);
                            const bf16x8 vf = __builtin_shufflevector(lo, hi, 0, 1, 2, 3, 4, 5, 6, 7);
                            O[m][db] = MFMA32(vf, pk[t][s2], O[m][db]); }
                ;
            }
        }
        if (kt + 1 < nsteps) { *(LAS u32x4*)(nxt + skey * DK_STR + sch * 16) = kr; *(LAS u32x4*)(nxt + 64 * DK_STR + skey * DV_STR + sch * 16) = vr; }
        __syncthreads();
    }
    const float l0 = lsum[0] + xshfl<32>(lsum[0]), l1 = lsum[1] + xshfl<32>(lsum[1]);
    const float lam = lamp[0], lam_init = lamp[1];
    const float i0 = 1.f / fmaxf(l0, 1e-30f), i1 = lam / fmaxf(l1, 1e-30f);
    float ss = 0.f;
#pragma unroll
    for (int db = 0; db < 2; ++db)
#pragma unroll
        for (int i = 0; i < 16; ++i) { const float at = O[0][db][i] * i0 - O[1][db][i] * i1; O[0][db][i] = at; ss += at * at; }
    ss += xshfl<32>(ss);
    const float r = (1.f - lam_init) / sqrtf(ss * (1.f / 64.f) + 1e-5f);
    GAS bf16* op = ys + (rowb + q) * 1024 + 512 + h * 64;
#pragma unroll
    for (int db = 0; db < 2; ++db)
#pragma unroll
        for (int gq = 0; gq < 4; ++gq) { const int d0 = 32 * db + 8 * gq + 4 * hh; const f32x4 sg = *(const GAS f32x4*)(subg + d0);
            u32x2 w; w.x = cvtpk(O[0][db][4 * gq + 0] * r * sg[0], O[0][db][4 * gq + 1] * r * sg[1]); w.y = cvtpk(O[0][db][4 * gq + 2] * r * sg[2], O[0][db][4 * gq + 3] * r * sg[3]);
            *(GAS u32x2*)(op + d0) = w; }
}

struct SchedCmp { const char* proj; const char* wc; int G, c;
    DI bool next(int i, Unit& u) const { const int L = i * G + c; if (L >= 16) return false; const int kv = L >> 3, rt = L & 7;
        u.pm = rt; u.pn = 0; u.aux = kv; u.pad = 0; u.a = proj + ((size_t)rt * 256 * 16 * PLD + (kv ? C_VC : C_KC)) * 2; u.b = wc + (size_t)kv * 256 * 1024 * 2; return true; } };
struct EpiCmp { static constexpr bool CARRY = false; float* ab;
    DI void operator()(const f32x4 (&acc)[2][2][4][2], const Unit& u, int wr, int wc, int fr, int fq) const {
        const int row0 = u.pm * 256 + wr * 64 + fr; const int col = wc * 32 + 8 * fq;
#pragma unroll
        for (int ai = 0; ai < 2; ++ai)
#pragma unroll
            for (int m = 0; m < 4; ++m) { float* rp = ab + ((size_t)u.aux * 2048 + row0 + ai * 128 + m * 16) * 128 + col; *(f32x4*)rp = acc[ai][0][m][0]; *(f32x4*)(rp + 4) = acc[ai][0][m][1]; }
    }
};
DI void cmp_finish(const KA& a, int l, const float* ab, bf16* kcb, int task, int lane) {
    const int kv = task / (BATCH * NCMP), r = task % (BATCH * NCMP), b = r / NCMP, c = r % NCMP;
    const float* w2 = a.in[kv ? 23 : 20] + (size_t)l * 4096; const float* pt = ab + 2 * 2048 * 128;
    const size_t g = (size_t)kv * 2048 + b * 512 + c;
    float ptv = 0.f;
#pragma unroll 8
    for (int part = 0; part < 32; ++part) ptv += pt[(kv * 32 + part) * 64 + lane];
    const float h1 = ab[g * 128 + lane] + ab[(g + 1) * 128 + 64 + lane] + ptv;
    const float gl = gelu_tanh(h1); float o = 0.f;
#pragma unroll
    for (int j = 0; j < 64; ++j) o += rl(gl, j) * w2[j * 64 + lane];
    kcb[((size_t)(kv * BATCH + b) * 512 + c) * 64 + lane] = (bf16)f2bf(o);
    if (c == NCMP - 1) kcb[((size_t)(kv * BATCH + b) * 512 + NCMP) * 64 + lane] = 0;
}

DI void cmp_block(const KA& a, int l, const GAS bf16* proj, const GAS bf16* wcT, float* ab, bf16* kcb, int bid, int wave, int lane) {
    const int kv = bid >> 7, g0 = (bid & 127) * 16, r = lane & 15, q = lane >> 4, sh = wave >> 2;
    const int grow = g0 + r + sh; const bool st_ok = !(sh != 0 && (grow & 511) == 0);
    const int gld = grow > 2047 ? 2047 : grow;
    const GAS bf16* apn = proj + (size_t)gld * 16 * PLD + (kv ? C_VC : C_KC) + 8 * q;
    const GAS bf16* bpn = wcT + ((size_t)kv * 256 + wave * 16 + r) * 1024 + 8 * q;
    f32x4 acc = {0.f, 0.f, 0.f, 0.f};
#pragma unroll 8
    for (int s = 0; s < 32; ++s) {
        const bf16x8 av = *(const GAS bf16x8*)(apn + (size_t)(s >> 1) * PLD + 32 * (s & 1));
        const bf16x8 bv = *(const GAS bf16x8*)(bpn + 32 * s);
        acc = __builtin_amdgcn_mfma_f32_16x16x32_bf16(bv, av, acc, 0, 0, 0);
    }
    if (st_ok) *(GAS f32x4*)((GAS float*)ab + ((size_t)kv * 2048 + grow) * 128 + wave * 16 + 4 * q) = acc;
    VM_WAIT(); __syncthreads();
#pragma unroll 1
    for (int i = 0; i < 2; ++i) { const int g = g0 + 2 * wave + i, c = g & 511, b = g >> 9;
        if (c < NCMP) cmp_finish(a, l, ab, kcb, kv * (BATCH * NCMP) + b * NCMP + c, lane); }
}

DI void st_load(const GAS unsigned char* kb, const GAS unsigned char* vb, unsigned off, u32x4& kr, u32x4& vr) { kr = *(const GAS u32x4*)(kb + off); vr = *(const GAS u32x4*)(vb + off); }
DI void st_write(LAS unsigned char* buf, int skey, int sch, const u32x4& kr, const u32x4& vr) { *(LAS u32x4*)(buf + skey * DK_STR + sch * 16) = kr; *(LAS u32x4*)(buf + 64 * DK_STR + skey * DV_STR + sch * 16) = vr; }
DI void qk64(const LAS unsigned char* cur, int kboff, const bf16x8 (&qf)[4], const f32x16& cinit, f32x16 (&S)[2]) {
#pragma unroll
    for (int t = 0; t < 2; ++t) { S[t] = cinit;
#pragma unroll
        for (int s = 0; s < 4; ++s) { const bf16x8 kf = *(const LAS bf16x8*)(cur + kboff + t * 32 * DK_STR + s * 32); S[t] = MFMA32(kf, qf[s], S[t]); } }
}
DI void qk32z(const LAS unsigned char* kt32, const bf16x8 (&qf)[4], f32x16& S) {
#pragma unroll
    for (int s = 0; s < 4; ++s) { const bf16x8 kf = *(const LAS bf16x8*)(kt32 + s * 32);
        if (s == 0) { f32x16 z;
#pragma unroll
            for (int i = 0; i < 16; ++i) z[i] = 0.f;
            S = MFMA32(kf, qf[s], z); } else S = MFMA32(kf, qf[s], S); }
}
DI void pv32(const LAS unsigned char* vt32, const bf16x8 (&pk)[2], f32x16 (&O)[2]) {
#pragma unroll
    for (int s2 = 0; s2 < 2; ++s2)
#pragma unroll
        for (int db = 0; db < 2; ++db) {
            const s16x4 lo = vtr(vt32 + (16 * s2) * DV_STR + db * 64), hi = vtr(vt32 + (16 * s2 + 8) * DV_STR + db * 64);
            const bf16x8 vf = __builtin_shufflevector(lo, hi, 0, 1, 2, 3, 4, 5, 6, 7);
            O[db] = MFMA32(vf, pk[s2], O[db]); }
}
DI void mask_bias_cmp32(f32x16& S, int tcol_in, int cbase, int hh, const LAS float* b2h, float msub) {
    int tcol = tcol_in; asm volatile("" : "+v"(tcol));
#pragma unroll
    for (int g = 0; g < 2; ++g) {
        float bv[8];
#pragma unroll
        for (int j = 0; j < 8; ++j) { const int i = 8 * g + j; const int c = cbase + crow(i, hh); const int dist = tcol - 31 - 16 * c; const int di = dist < 0 ? 0 : (dist < 128 ? dist : 128); bv[j] = b2h[di * 12]; }
#pragma unroll
        for (int j = 0; j < 8; ++j) { const int i = 8 * g + j; const int c = cbase + crow(i, hh); const int dist = tcol - 31 - 16 * c; const bool ok = dist >= 0 && c < NCMP;
            const float sb = S[i] + (bv[j] - msub); S[i] = ok ? sb : -1e30f; }
        __builtin_amdgcn_sched_barrier(0); }
}
DI void pv64(const LAS unsigned char* cur, int vboff, const bf16x8 (&pk)[2][2], f32x16 (&O)[2]) {
#pragma unroll
    for (int t = 0; t < 2; ++t)
#pragma unroll
        for (int s2 = 0; s2 < 2; ++s2)
#pragma unroll
            for (int db = 0; db < 2; ++db) {
                const s16x4 lo = vtr(cur + vboff + (32 * t + 16 * s2) * DV_STR + db * 64), hi = vtr(cur + vboff + (32 * t + 16 * s2 + 8) * DV_STR + db * 64);
                const bf16x8 vf = __builtin_shufflevector(lo, hi, 0, 1, 2, 3, 4, 5, 6, 7);
                O[db] = MFMA32(vf, pk[t][s2], O[db]); }
}
DI void softmax_step(f32x16 (&S)[2], f32x16 (&O)[2], f32x16& negm, float& lsum, bf16x8 (&pk)[2][2]) {
    float tm = fmaxf(max16(S[0]), max16(S[1]));
    if (__builtin_amdgcn_ballot_w64(tm > 8.f) != 0ull) {
        tm = fmaxf(tm, xshfl<32>(tm)); const float sh = fmaxf(tm, 0.f); const float al = __builtin_amdgcn_exp2f(-sh);
        lsum *= al;
#pragma unroll
        for (int i = 0; i < 16; ++i) { O[0][i] *= al; O[1][i] *= al; negm[i] -= sh; S[0][i] -= sh; S[1][i] -= sh; } }
#pragma unroll
    for (int t = 0; t < 2; ++t) {
#pragma unroll
        for (int i = 0; i < 16; ++i) { const float p = __builtin_amdgcn_exp2f(S[t][i]); S[t][i] = p; lsum += p; }
        pk[t][0] = pack_half(S[t], 0); pk[t][1] = pack_half(S[t], 1); }
}
DI void mask_bias(f32x16 (&S)[2], int tcol_in, int kbase, int hh, int W, bool colsel, const LAS float* b2h) {
    int tcol = tcol_in; asm volatile("" : "+v"(tcol));
#pragma unroll
    for (int t = 0; t < 2; ++t)
#pragma unroll
        for (int g = 0; g < 2; ++g) {
            float bv[8];
#pragma unroll
            for (int j = 0; j < 8; ++j) { const int i = 8 * g + j; const int dist = tcol - (kbase + 32 * t + crow(i, hh)); const int di = dist < 0 ? 0 : (dist < 128 ? dist : 128); bv[j] = b2h[di * 12]; }
#pragma unroll
            for (int j = 0; j < 8; ++j) { const int i = 8 * g + j; const int dist = tcol - (kbase + 32 * t + crow(i, hh)); const bool ok = colsel && dist >= 0 && dist < W;
                const float sb = S[t][i] + bv[j]; S[t][i] = ok ? sb : -1e30f; }
            __builtin_amdgcn_sched_barrier(0); }
}
DI void sel_tile(const LAS unsigned char* cur, int kboff, int vboff, const bf16x8 (&qf)[4], f32x16 (&Os)[2], f32x16& negm, float& lsel, bool near, bool bit, int t, int kbase, int hh, int W, const LAS float* b2h) {
    f32x16 S[2]; qk64(cur, kboff, qf, negm, S);
    if (near) mask_bias(S, t, kbase, hh, W, bit, b2h);
    float ts = 0.f;
#pragma unroll
    for (int tt = 0; tt < 2; ++tt)
#pragma unroll
        for (int i = 0; i < 16; ++i) { const float p = __builtin_amdgcn_exp2f(S[tt][i]); S[tt][i] = p; ts += p; }
    ts = bit ? ts : 0.f;
    if (__builtin_amdgcn_ballot_w64(!(ts < 1.0e30f)) != 0ull) {
        qk64(cur, kboff, qf, negm, S);
        if (near) mask_bias(S, t, kbase, hh, W, bit, b2h);
        float tm = fmaxf(max16(S[0]), max16(S[1])); tm = bit ? tm : -1e30f; tm = fmaxf(tm, xshfl<32>(tm));
        const float sh = fmaxf(tm, 0.f); const float al = __builtin_amdgcn_exp2f(-sh);
        lsel *= al; ts = 0.f;
#pragma unroll
        for (int i = 0; i < 16; ++i) { Os[0][i] *= al; Os[1][i] *= al; negm[i] -= sh; }
#pragma unroll
        for (int tt = 0; tt < 2; ++tt)
#pragma unroll
            for (int i = 0; i < 16; ++i) { const float p = __builtin_amdgcn_exp2f(S[tt][i] - sh); S[tt][i] = p; ts += p; }
        ts = bit ? ts : 0.f;
    }
    lsel += ts;
    const unsigned km = bit ? 0xFFFFFFFFu : 0u; bf16x8 pk[2][2];
#pragma unroll
    for (int tt = 0; tt < 2; ++tt)
#pragma unroll
        for (int hf = 0; hf < 2; ++hf) { u32x4 w = __builtin_bit_cast(u32x4, pack_half(S[tt], hf)); w.x &= km; w.y &= km; w.z &= km; w.w &= km; pk[tt][hf] = __builtin_bit_cast(bf16x8, w); }
    pv64(cur, vboff, pk, Os);
}
DI void nsa_unit(const GAS bf16* proj, GAS bf16* ys, const GAS bf16* kcb, LAS unsigned char* lds, const LAS float* bias2, int b, int u, int tid_in, int lane_in, int wave_in) {
    (void)tid_in; (void)lane_in; int wave = wave_in; asm volatile("" : "+s"(wave)); const int lane = my_lane(); const int tid = wave * 64 + lane;
    const int t0 = u * 64; const int col = lane & 31, hh = lane >> 5, tl = col >> 2, head = col & 3;
    const int t = t0 + wave * 8 + tl; const int tw0 = t0 + wave * 8;
    const size_t rowb = (size_t)b * SEQ;
    const LAS float* b2h = bias2 + 8 + head;
    bf16x8 qf[4];
    { const float SC = 0.125f * 1.4426950408889634f; const GAS bf16* qp = proj + (rowb + t) * PLD + C_DQ + head * 64 + hh * 8;
#pragma unroll
      for (int s = 0; s < 4; ++s) { const u32x4 w = *(const GAS u32x4*)(qp + s * 16); u32x4 o;
          o.x = cvtpk(lo_bf(w.x) * SC, hi_bf(w.x) * SC); o.y = cvtpk(lo_bf(w.y) * SC, hi_bf(w.y) * SC); o.z = cvtpk(lo_bf(w.z) * SC, hi_bf(w.z) * SC); o.w = cvtpk(lo_bf(w.w) * SC, hi_bf(w.w) * SC);
          qf[s] = __builtin_bit_cast(bf16x8, o); } }
    const int skey = tid >> 3, sch = tid & 7;
    const int i16 = lane & 15, blk = (lane >> 4) & 1;
    const int kboff = col * DK_STR + hh * 16;
    const int vboff = 64 * DK_STR + (4 * hh + (i16 >> 2)) * DV_STR + (16 * blk + 4 * (i16 & 3)) * 2;
    u32x4 kr, vr;
    const int ncvm = (4 * u + 3) < NCMP ? (4 * u + 3) : NCMP;
    const int nsc = (ncvm + 63) >> 6;
    const GAS unsigned char* kcp = (const GAS unsigned char*)(kcb + (size_t)(0 * BATCH + b) * 512 * 64);
    const GAS unsigned char* vcp = (const GAS unsigned char*)(kcb + (size_t)(1 * BATCH + b) * 512 * 64);
    const unsigned soffc = (unsigned)(skey * 64 + sch * 8) * 2u;
    float m1 = -120.f, l1 = 0.f;
    st_load(kcp, vcp, soffc, kr, vr); st_write(lds, skey, sch, kr, vr); __syncthreads();
#pragma unroll 1
    for (int kt = 0; kt < nsc; ++kt) {
        const LAS unsigned char* cur = lds + (kt & 1) * DBUF_BYTES; LAS unsigned char* nxt = lds + ((kt + 1) & 1) * DBUF_BYTES;
        if (kt + 1 < nsc) st_load(kcp, vcp, soffc + (unsigned)(kt + 1) * 8192u, kr, vr);
#pragma unroll
        for (int tt = 0; tt < 2; ++tt) { f32x16 S; qk32z(cur + kboff + tt * 32 * DK_STR, qf, S); mask_bias_cmp32(S, t, kt * 64 + tt * 32, hh, b2h, 0.f);
          const float tm = max16(S); const float mn = fmaxf(m1, tm); float acc = 0.f;
#pragma unroll
          for (int i = 0; i < 16; ++i) acc += __builtin_amdgcn_exp2f(S[i] - mn);
          l1 = l1 * __builtin_amdgcn_exp2f(m1 - mn) + acc; m1 = mn; }
        if (kt + 1 < nsc) st_write(nxt, skey, sch, kr, vr);
        __syncthreads();
    }
    float mf, inv;
    { const float mo = xshfl<32>(m1), lo = xshfl<32>(l1); mf = fmaxf(m1, mo); const float lf = l1 * __builtin_amdgcn_exp2f(m1 - mf) + lo * __builtin_amdgcn_exp2f(mo - mf); inv = lf > 0.f ? 1.f / lf : 0.f; }
    f32x16 Oc[2], imp[4];
#pragma unroll
    for (int i = 0; i < 16; ++i) { Oc[0][i] = 0.f; Oc[1][i] = 0.f; imp[0][i] = 0.f; imp[1][i] = 0.f; imp[2][i] = 0.f; imp[3][i] = 0.f; }
    {   st_load(kcp, vcp, soffc, kr, vr); st_write(lds, skey, sch, kr, vr); __syncthreads();
#pragma unroll 1
        for (int kt = 0; kt < nsc; ++kt) {
            const LAS unsigned char* cur = lds + (kt & 1) * DBUF_BYTES; LAS unsigned char* nxt = lds + ((kt + 1) & 1) * DBUF_BYTES;
            if (kt + 1 < nsc) st_load(kcp, vcp, soffc + (unsigned)(kt + 1) * 8192u, kr, vr);
#pragma unroll
            for (int tt = 0; tt < 2; ++tt) {
                f32x16 S; qk32z(cur + kboff + tt * 32 * DK_STR, qf, S); mask_bias_cmp32(S, t, kt * 64 + tt * 32, hh, b2h, mf);
#pragma unroll
                for (int i = 0; i < 16; ++i) S[i] = __builtin_amdgcn_exp2f(S[i]) * inv;
                bf16x8 pk[2]; pk[0] = pack_half(S, 0); pk[1] = pack_half(S, 1);
                pv32(cur + vboff + tt * 32 * DV_STR, pk, Oc);
                const int Tq = (2 * kt + tt) & 3, MB = (2 * kt + tt) >> 2;
#pragma unroll
                for (int s2 = 0; s2 < 2; ++s2) { u32x4 aw; unsigned e[8];
#pragma unroll
                    for (int jj = 0; jj < 8; ++jj) { const int kk = 16 * s2 + 8 * (jj >> 2) + 4 * hh + (jj & 3); const int delta = 32 * Tq + kk - 4 * col;
                        e[jj] = (delta == -1 || delta == 3) ? 0x3F80u : ((unsigned)delta <= 2u ? 0x4000u : 0u); }
                    aw.x = e[0] | (e[1] << 16); aw.y = e[2] | (e[3] << 16); aw.z = e[4] | (e[5] << 16); aw.w = e[6] | (e[7] << 16);
                    const bf16x8 af = __builtin_bit_cast(bf16x8, aw);
                    if (MB == 0) imp[0] = MFMA32(af, pk[s2], imp[0]); else if (MB == 1) imp[1] = MFMA32(af, pk[s2], imp[1]); else if (MB == 2) imp[2] = MFMA32(af, pk[s2], imp[2]); else imp[3] = MFMA32(af, pk[s2], imp[3]); }
                if (Tq == 3 && MB < 3) { u32x4 aw; aw.x = 0u; aw.y = 0u; aw.z = 0u; aw.w = (lane == 32) ? 0x3F800000u : 0u;
                    const bf16x8 af = __builtin_bit_cast(bf16x8, aw);
                    if (MB == 0) imp[1] = MFMA32(af, pk[1], imp[1]); else if (MB == 1) imp[2] = MFMA32(af, pk[1], imp[2]); else imp[3] = MFMA32(af, pk[1], imp[3]); }
            }
            if (kt + 1 < nsc) st_write(nxt, skey, sch, kr, vr);
            __syncthreads();
        }
    }
    unsigned ocp[2][8];
#pragma unroll
    for (int db = 0; db < 2; ++db)
#pragma unroll
        for (int i = 0; i < 8; ++i) ocp[db][i] = cvtpk(Oc[db][2 * i], Oc[db][2 * i + 1]);
    unsigned sm0 = 0u, sm1 = 0u, sm2 = 0u, sm3 = 0u;
    {   const int cur_t = t >> 6; unsigned key[16];
#pragma unroll
        for (int i = 0; i < 16; ++i) {
            float v0 = imp[0][i], v1 = imp[1][i], v2 = imp[2][i], v3 = imp[3][i];
            v0 += xshfl<1>(v0); v0 += xshfl<2>(v0); v1 += xshfl<1>(v1); v1 += xshfl<2>(v1); v2 += xshfl<1>(v2); v2 += xshfl<2>(v2); v3 += xshfl<1>(v3); v3 += xshfl<2>(v3);
            const float val = head == 0 ? v0 : (head == 1 ? v1 : (head == 2 ? v2 : v3));
            const int j = 32 * head + crow(i, hh);
            const bool forced = (j == 0) || (j == cur_t) || (j == cur_t - 1);
            unsigned fx = (unsigned)(fminf(fmaxf(val, 0.f), 31.f) * 1048576.f) + 1u;
            fx = forced ? 0x1FFFFFFu : (j <= cur_t ? fx : 0u);
            key[i] = (fx << 7) | (unsigned)(127 - j); }
#pragma unroll 1
        for (int r = 0; r < 16; ++r) {
            unsigned w = key[0];
#pragma unroll
            for (int i = 1; i < 16; ++i) w = w > key[i] ? w : key[i];
            { unsigned o = (unsigned)xshfl_i<1>((int)w); w = w > o ? w : o; o = (unsigned)xshfl_i<2>((int)w); w = w > o ? w : o; o = (unsigned)xshfl_i<32>((int)w); w = w > o ? w : o; }
            if ((w >> 7) != 0u) { const int j = 127 - (int)(w & 127u); const unsigned bit = 1u << (j & 31); const int jb = j >> 5;
                sm0 |= (jb == 0) ? bit : 0u; sm1 |= (jb == 1) ? bit : 0u; sm2 |= (jb == 2) ? bit : 0u; sm3 |= (jb == 3) ? bit : 0u; }
#pragma unroll
            for (int i = 0; i < 16; ++i) key[i] = (key[i] == w) ? 0u : key[i];
        }
    }
    f32x16 Ow[2]; float lw = 0.f;
#pragma unroll
    for (int i = 0; i < 16; ++i) { Ow[0][i] = 0.f; Ow[1][i] = 0.f; }
    {   f32x16 negm;
#pragma unroll
        for (int i = 0; i < 16; ++i) negm[i] = 120.f;
        const GAS unsigned char* kwp = (const GAS unsigned char*)(proj + rowb * PLD + C_KW); const GAS unsigned char* vwp = (const GAS unsigned char*)(proj + rowb * PLD + C_VW);
        const unsigned soffp = (unsigned)(skey * PLD + sch * 8) * 2u;
        const int s0 = (u < 8) ? 8 - u : 0;
        st_load(kwp, vwp, soffp + (unsigned)(u - 8 + s0) * (64u * PLD * 2u), kr, vr); st_write(lds, skey, sch, kr, vr); __syncthreads();
#pragma unroll 1
        for (int s = s0; s < 9; ++s) {
            const int par = (s - s0) & 1; const LAS unsigned char* cur = lds + par * DBUF_BYTES; LAS unsigned char* nxt = lds + (par ^ 1) * DBUF_BYTES;
            if (s + 1 < 9) st_load(kwp, vwp, soffp + (unsigned)(u - 8 + s + 1) * (64u * PLD * 2u), kr, vr);
            sel_tile(cur, kboff, vboff, qf, Ow, negm, lw, s == 0 || s >= 6, true, t, (u - 8 + s) * 64, hh, 512, b2h);
            if (s + 1 < 9) st_write(nxt, skey, sch, kr, vr);
            __syncthreads();
        }
    }
    unsigned owp[2][8];
#pragma unroll
    for (int db = 0; db < 2; ++db)
#pragma unroll
        for (int i = 0; i < 8; ++i) owp[db][i] = cvtpk(Ow[db][2 * i], Ow[db][2 * i + 1]);
    f32x16 Os[2]; float lsel = 0.f;
#pragma unroll
    for (int i = 0; i < 16; ++i) { Os[0][i] = 0.f; Os[1][i] = 0.f; }
    {   f32x16 negm;
#pragma unroll
        for (int i = 0; i < 16; ++i) negm[i] = 120.f;
        const GAS unsigned char* ksp = (const GAS unsigned char*)(proj + rowb * PLD + C_KS); const GAS unsigned char* vsp = (const GAS unsigned char*)(proj + rowb * PLD + C_VS);
        const unsigned soffp = (unsigned)(skey * PLD + sch * 8) * 2u;
        u32x4 kA, vA, kB, vB;
        st_load(ksp, vsp, soffp, kr, vr); st_write(lds, skey, sch, kr, vr);
        if (u >= 1) st_load(ksp, vsp, soffp + 64u * PLD * 2u, kA, vA);
        __syncthreads();
#define SEL_STEP(J, KX, VX, KY, VY) { const int j_ = (J); \
            const LAS unsigned char* cur = lds + (j_ & 1) * DBUF_BYTES; LAS unsigned char* nxt = lds + ((j_ + 1) & 1) * DBUF_BYTES; \
            if (j_ + 2 <= u) st_load(ksp, vsp, soffp + (unsigned)(j_ + 2) * (64u * PLD * 2u), KY, VY); \
            const int jb = j_ >> 5; const unsigned smw = jb == 0 ? sm0 : (jb == 1 ? sm1 : (jb == 2 ? sm2 : sm3)); \
            const bool bit = ((smw >> (j_ & 31)) & 1u) != 0u; \
            if (__builtin_amdgcn_ballot_w64(bit) != 0ull) sel_tile(cur, kboff, vboff, qf, Os, negm, lsel, 64 * j_ + 63 > tw0 - 113, bit, t, 64 * j_, hh, 1 << 30, b2h); \
            if (j_ + 1 <= u) st_write(nxt, skey, sch, KX, VX); \
            __syncthreads(); }
#pragma unroll 1
        for (int j = 0; j <= u; j += 2) {
            SEL_STEP(j, kA, vA, kB, vB)
            if (j + 1 <= u) SEL_STEP(j + 1, kB, vB, kA, vA)
        }
#undef SEL_STEP
    }
    {   const float lwt = lw + xshfl<32>(lw), lst = lsel + xshfl<32>(lsel);
        const GAS bf16* gp = proj + (rowb + t) * PLD + C_DG + head * 3;
        const float g0 = sigmoidf_(bf2f(gp[0])), g1 = sigmoidf_(bf2f(gp[1])) / fmaxf(lst, 1e-30f), g2 = sigmoidf_(bf2f(gp[2])) / fmaxf(lwt, 1e-30f);
        GAS bf16* op = ys + (rowb + t) * 1024 + 768 + head * 64;
#pragma unroll
        for (int db = 0; db < 2; ++db)
#pragma unroll
            for (int gq = 0; gq < 4; ++gq) { const int d0 = 32 * db + 8 * gq + 4 * hh; float y[4];
#pragma unroll
                for (int e = 0; e < 4; ++e) { const unsigned cw = ocp[db][2 * gq + (e >> 1)], ww = owp[db][2 * gq + (e >> 1)];
                    y[e] = g0 * ((e & 1) ? hi_bf(cw) : lo_bf(cw)) + g1 * Os[db][4 * gq + e] + g2 * ((e & 1) ? hi_bf(ww) : lo_bf(ww)); }
                u32x2 w; w.x = cvtpk(y[0], y[1]); w.y = cvtpk(y[2], y[3]); *(GAS u32x2*)(op + d0) = w; }
    }
}


DI void swa_unit(const GAS bf16* proj, GAS bf16* ys, LAS unsigned char* lds, const LAS float* bias2, const LAS float* biasd, const GAS float* sinks, int b, int u, int tid_in, int lane_in, int wave_in) {
    int tid = tid_in, lane = lane_in, wave = wave_in; asm volatile("" : "+v"(tid), "+v"(lane), "+s"(wave));
    const int t0 = u * 64; const int col = lane & 31, hh = lane >> 5, tl = col >> 1, kv = wave & 1, head = 2 * kv + (col & 1);
    const int t = t0 + (wave >> 1) * 16 + tl;
    const size_t rowb = (size_t)b * SEQ;
    const LAS float* b2h = bias2 + head;
    bf16x8 qf[4];
    { const float SC = 0.125f * 1.4426950408889634f; const GAS bf16* qp = proj + (rowb + t) * PLD + C_BQ + head * 64 + hh * 8;
#pragma unroll
      for (int s = 0; s < 4; ++s) { const u32x4 w = *(const GAS u32x4*)(qp + s * 16); u32x4 o;
          o.x = cvtpk(lo_bf(w.x) * SC, hi_bf(w.x) * SC); o.y = cvtpk(lo_bf(w.y) * SC, hi_bf(w.y) * SC); o.z = cvtpk(lo_bf(w.z) * SC, hi_bf(w.z) * SC); o.w = cvtpk(lo_bf(w.w) * SC, hi_bf(w.w) * SC);
          qf[s] = __builtin_bit_cast(bf16x8, o); } }
    const int skey = tid >> 3, sch = tid & 7;
    const int i16 = lane & 15, blk = (lane >> 4) & 1;
    const int kboff = kv * DBUF_BYTES + col * DK_STR + hh * 16;
    const int vboff = kv * DBUF_BYTES + 64 * DK_STR + (4 * hh + (i16 >> 2)) * DV_STR + (16 * blk + 4 * (i16 & 3)) * 2;
    const GAS unsigned char* kp = (const GAS unsigned char*)(proj + rowb * PLD + C_BK); const GAS unsigned char* vp = (const GAS unsigned char*)(proj + rowb * PLD + C_BV);
    const unsigned soffp = (unsigned)(skey * PLD + sch * 8) * 2u;
    u32x4 k0, v0, k1, v1;
    f32x16 O[2], negm; float lsum = 0.f;
#pragma unroll
    for (int i = 0; i < 16; ++i) { O[0][i] = 0.f; O[1][i] = 0.f; negm[i] = 120.f; }
    const int s0 = (u < 2) ? 2 - u : 0;
    { const unsigned so = soffp + (unsigned)(u - 2 + s0) * (64u * PLD * 2u); st_load(kp, vp, so, k0, v0); st_load(kp + 128, vp + 128, so, k1, v1);
      st_write(lds, skey, sch, k0, v0); st_write(lds + DBUF_BYTES, skey, sch, k1, v1); }
    __syncthreads();
#pragma unroll 1
    for (int s = s0; s < 3; ++s) {
        const int par = (s - s0) & 1; const LAS unsigned char* cur = lds + par * 2 * DBUF_BYTES; LAS unsigned char* nxt = lds + (par ^ 1) * 2 * DBUF_BYTES;
        if (s + 1 < 3) { const unsigned so = soffp + (unsigned)(u - 2 + s + 1) * (64u * PLD * 2u); st_load(kp, vp, so, k0, v0); st_load(kp + 128, vp + 128, so, k1, v1); }
        sel_tile(cur, kboff, vboff, qf, O, negm, lsum, true, true, t, (u - 2 + s) * 64, hh, 128, b2h);
        if (s + 1 < 3) { st_write(nxt, skey, sch, k0, v0); st_write(nxt + DBUF_BYTES, skey, sch, k1, v1); }
        __syncthreads();
    }
    {   const float sinkp = (sinks[head] - biasd[128 * 12 + head]) * 1.4426950408889634f;
        const float lt = lsum + xshfl<32>(lsum) + __builtin_amdgcn_exp2f(sinkp + negm[0]);
        const float inv = 1.f / fmaxf(lt, 1e-30f);
        GAS bf16* op = ys + (rowb + t) * 1024 + 256 + head * 64;
#pragma unroll
        for (int db = 0; db < 2; ++db)
#pragma unroll
            for (int gq = 0; gq < 4; ++gq) { const int d0 = 32 * db + 8 * gq + 4 * hh;
                u32x2 w; w.x = cvtpk(O[db][4 * gq + 0] * inv, O[db][4 * gq + 1] * inv); w.y = cvtpk(O[db][4 * gq + 2] * inv, O[db][4 * gq + 3] * inv); *(GAS u32x2*)(op + d0) = w; }
    }
}

DI void route_rows4(const KA& a, int l, bf16* xr_, int tok0, int lane_) {
    int lane = lane_; asm volatile("" : "+v"(lane));
    const GAS bf16* xrow = (const GAS bf16*)(a.ws + WS_XB) + (size_t)tok0 * 1024; const GAS float* g = (const GAS float*)(a.in[28] + (size_t)l * 1024); GAS bf16* xr = (GAS bf16*)xr_;
    f32x4 v[4][4]; float ss[4]; u32x2 raw[4][4];
#pragma unroll
    for (int rr = 0; rr < 4; ++rr)
#pragma unroll
        for (int j = 0; j < 4; ++j) raw[rr][j] = *(const GAS u32x2*)(xrow + (size_t)rr * 1024 + 4 * (lane + 64 * j));
#pragma unroll
    for (int rr = 0; rr < 4; ++rr)
#pragma unroll
        for (int j = 0; j < 4; ++j) { v[rr][j][0] = lo_bf(raw[rr][j].x); v[rr][j][1] = hi_bf(raw[rr][j].x); v[rr][j][2] = lo_bf(raw[rr][j].y); v[rr][j][3] = hi_bf(raw[rr][j].y); }
#pragma unroll
    for (int rr = 0; rr < 4; ++rr) { float t = 0.f;
#pragma unroll
        for (int j = 0; j < 4; ++j) t += (v[rr][j][0] * v[rr][j][0] + v[rr][j][1] * v[rr][j][1]) + (v[rr][j][2] * v[rr][j][2] + v[rr][j][3] * v[rr][j][3]);
        ss[rr] = t; }
#pragma unroll
    for (int rr = 0; rr < 4; ++rr) ss[rr] = wave_sum(ss[rr]);
#pragma unroll
    for (int j = 0; j < 4; ++j) { const int k0 = 4 * (lane + 64 * j); const f32x4 gv = *(const GAS f32x4*)(g + k0);
#pragma unroll
        for (int rr = 0; rr < 4; ++rr) { const float r = 1.f / sqrtf(ss[rr] * (1.f / 1024.f) + 1e-6f); const f32x4 xn = v[rr][j] * r * gv;
            unsigned hi[4]; float lo[4];
#pragma unroll
            for (int e = 0; e < 4; ++e) { hi[e] = f2bf(xn[e]); lo[e] = xn[e] - __builtin_bit_cast(float, hi[e] << 16); }
            u32x2 wh, wl; wh.x = hi[0] | (hi[1] << 16); wh.y = hi[2] | (hi[3] << 16); wl.x = pk2(lo[0], lo[1]); wl.y = pk2(lo[2], lo[3]);
            *(GAS u32x2*)(xr + (size_t)(tok0 + rr) * 2048 + k0) = wh; *(GAS u32x2*)(xr + (size_t)(tok0 + rr) * 2048 + 1024 + k0) = wl; } }
}
struct SchedRoute { const char* A; const char* B; int pm;
    DI bool next(int i, Unit& u) const { if (i > 0) return false; u.pm = pm; u.pn = 0; u.aux = 0; u.pad = 0; u.a = A + (size_t)pm * 128 * 2048 * 2; u.b = B; return true; } };
struct EpiRoute { static constexpr bool CARRY = false; float* rlog;
    DI void operator()(const f32x4 (&acc)[2][2][4][2], const Unit& u, int wr, int wc, int fr, int fq) const {
        const int row0 = u.pm * 128 + wr * 64 + fr; const int col = wc * 32 + 8 * fq;
#pragma unroll
        for (int m = 0; m < 4; ++m) { float* rp = rlog + (size_t)(row0 + m * 16) * 128 + col; *(f32x4*)rp = acc[0][0][m][0]; *(f32x4*)(rp + 4) = acc[0][0][m][1]; }
    }
};
DI void route_decide(const KA& a, int l, const float* rl_row, int* rec_e, int* rec_slot, float* rec_w, unsigned* cnt, int tok) {
    float lg[36];
    const float* bg = a.in[30] + l * 4; const float* be = a.in[32] + l * 32;
#pragma unroll
    for (int q = 0; q < 9; ++q) { const f32x4 h = *(const f32x4*)(rl_row + 4 * q), lo = *(const f32x4*)(rl_row + 64 + 4 * q);
        lg[4 * q + 0] = h[0] + lo[0]; lg[4 * q + 1] = h[1] + lo[1]; lg[4 * q + 2] = h[2] + lo[2]; lg[4 * q + 3] = h[3] + lo[3]; }
#pragma unroll
    for (int i = 0; i < 4; ++i) lg[i] += bg[i];
#pragma unroll
    for (int i = 0; i < 32; ++i) lg[4 + i] += be[i];
    int gsel = 0; float gm = lg[0];
#pragma unroll
    for (int i = 1; i < 4; ++i) if (lg[i] > gm) { gm = lg[i]; gsel = i; }
    float gs = 0.f;
#pragma unroll
    for (int i = 0; i < 4; ++i) gs += __expf(lg[i] - gm);
    const float gwt = 1.f / gs;
    float v8[8];
#pragma unroll
    for (int i = 0; i < 8; ++i) { float x = lg[4 + i];
#pragma unroll
        for (int gq = 1; gq < 4; ++gq) x = (gsel == gq) ? lg[4 + gq * 8 + i] : x;
        v8[i] = x; }
    int i0 = 0; float m0 = v8[0];
#pragma unroll
    for (int i = 1; i < 8; ++i) if (v8[i] > m0) { m0 = v8[i]; i0 = i; }
    int i1 = -1; float m1 = -3e38f;
#pragma unroll
    for (int i = 0; i < 8; ++i) if (i != i0 && v8[i] > m1) { m1 = v8[i]; i1 = i; }
    if (i1 < 0) i1 = (i0 == 0) ? 1 : 0;
    const float w0 = 1.f / (1.f + __expf(m1 - m0)); const float w1 = 1.f - w0;
    const int e0 = gsel * 8 + i0, e1 = gsel * 8 + i1;
    const unsigned s0 = __hip_atomic_fetch_add(cnt + e0, 1u, __ATOMIC_RELAXED, __HIP_MEMORY_SCOPE_AGENT);
    const unsigned s1 = __hip_atomic_fetch_add(cnt + e1, 1u, __ATOMIC_RELAXED, __HIP_MEMORY_SCOPE_AGENT);
    (void)rec_e; (void)rec_slot; (void)rec_w;
    int* inv_as = (int*)(a.ws + WS_INVAS); float* inv_w = (float*)(a.ws + WS_INVW);
    inv_as[e0 * 32768 + (int)s0] = tok * 2; inv_w[e0 * 32768 + (int)s0] = w0 * gwt; inv_as[e1 * 32768 + (int)s1] = tok * 2 + 1; inv_w[e1 * 32768 + (int)s1] = w1 * gwt;
}
DI void expert_weights(const KA& a, int l, LAS unsigned char* lds, int it0, int it1, int gw, int NGW, int wave, int lane) {
    LAS float* scr = (LAS float*)(lds + wave * 16384);
    const float* wgt = a.in[33] + (size_t)l * 32 * 1024 * 256; const float* wup = a.in[34] + (size_t)l * 32 * 1024 * 256; const float* wdn = a.in[35] + (size_t)l * 32 * 256 * 1024;
    bf16* Wgu = (bf16*)(a.ws + WS_WGU); bf16* Wd = (bf16*)(a.ws + WS_WD);
    constexpr int I_E = 16 * 8, I_D = 4 * 32;
    constexpr int NIT = 32 * (2 * I_E + I_D);
    (void)NIT;
    for (int it = it0 + gw; it < it1; it += NGW) {
        const int e = it / (2 * I_E + I_D); int r = it % (2 * I_E + I_D);
        if (r < 2 * I_E) { const int up = r / I_E, q = r % I_E, kb = q / 8, nb = q % 8; const int n0 = nb * 32;
            const int drow = (n0 >> 7) * 256 + up * 128 + (n0 & 127);
            transpose_item((up ? wup : wgt) + (size_t)e * 1024 * 256, 256, 256, Wgu + (size_t)e * 512 * 1024, 1024, kb * 64, n0, drow, scr, lane);
        } else { r -= 2 * I_E; const int kb = r / 32, nb = r % 32;
            transpose_item(wdn + (size_t)e * 256 * 1024, 1024, 1024, Wd + (size_t)e * 1024 * 256, 256, kb * 64, nb * 32, nb * 32, scr, lane); }
    }
}
DI void build_offsets(const unsigned* cnt, LAS int* offt, int tid) {
    int c = 0;
    if (tid < 32) { c = (int)__hip_atomic_load(cnt + tid, __ATOMIC_RELAXED, __HIP_MEMORY_SCOPE_AGENT); offt[330 + tid] = (c + 255) & ~255; }
    __syncthreads();
    if (tid == 0) { int o = 0;
#pragma unroll
        for (int e = 0; e < 32; ++e) { offt[e] = o; o += offt[330 + e]; } offt[32] = o; }
    __syncthreads();
    if (tid < 32) offt[330 + tid] = c;
    for (int rt = tid; rt < (MOE_ROWS >> 8); rt += 512) { int e = 0; for (int j = 1; j < 32; ++j) e += (offt[j] <= rt * 256) ? 1 : 0; offt[40 + rt] = e; }
    __syncthreads();
}

template <unsigned PM>
__global__ void __launch_bounds__(512, 2) mk_fwd(Args a_) {
    extern __shared__ __attribute__((aligned(16))) unsigned char lds_raw[];
    LAS unsigned char* lds = (LAS unsigned char*)lds_raw;
    const int wave0 = __builtin_amdgcn_readfirstlane((int)threadIdx.x >> 6);
    if (threadIdx.x < 36) ((LAS unsigned long long*)(lds + PTAB_OFF))[threadIdx.x] = (unsigned long long)a_.in[threadIdx.x];
    __syncthreads();
    KA a; a.in.base = (unsigned)(size_t)(lds + PTAB_OFF); a.out = a_.out; a.ws = a_.ws;
    const int G = gridDim.x, bid = blockIdx.x, NGW = G * 8;
#define PHASE_IDS() int wave = wave0; asm volatile("" : "+s"(wave)); const int lane = my_lane(); const int tid_ = wave * 64 + lane, gw = bid * 8 + wave; (void)tid_; (void)gw; \
    const int xb = ((bid & 7) << 5) | (bid >> 3); (void)xb;        \
    KA ap = a; asm volatile("" : "+s"(ap.ws), "+s"(ap.out), "+s"(ap.in.base)); \
    bf16* hb = (bf16*)(ap.ws + WS_HB); bf16* proj = (bf16*)(ap.ws + WS_PROJ); bf16* gates = (bf16*)(ap.ws + WS_GATES); \
    bf16* ys = hb; bf16* x2b = hb; bf16* merged = proj; bf16* eo = proj; \
    bf16* kcb = (bf16*)(ap.ws + WS_KCVC); float* lrusum = (float*)(ap.ws + WS_LRUSUM); \
    int* rec_e = (int*)(ap.ws + WS_REC); int* rec_slot = rec_e + T * 2; float* rec_w = (float*)(rec_slot + T * 2); \
    int* rowtok = (int*)(ap.ws + WS_ROWTOK); float* roww = (float*)(ap.ws + WS_ROWW); \
    bf16* xs = (bf16*)(ap.ws + WS_XS); bf16* hmid = (bf16*)(ap.ws + WS_HMID); unsigned* ctl = (unsigned*)(ap.ws + WS_CTL); \
    (void)hb; (void)proj; (void)gates; (void)ys; (void)x2b; (void)merged; (void)eo; (void)kcb; (void)lrusum; (void)rec_e; (void)rec_slot; (void)rec_w; (void)rowtok; (void)roww; (void)xs; (void)hmid; (void)ctl
    volatile LAS unsigned* MISC = (volatile LAS unsigned*)(lds + MISC_OFF);
    LAS float* biasd = (LAS float*)(lds + BIAS_OFF);
    LAS int* offt = (LAS int*)(lds + OFFT_OFF);
    { PHASE_IDS();
    if (tid_ < 64) MISC[tid_] = 0u;
    for (int i = tid_; i < 129 * 12; i += 512) { const int d = i / 12, hd = i % 12; const int bk = d < 128 ? T5_BUCKET[d] : 31; const float* rb = a.in[1]; biasd[i] = rb[bk * 12 + hd]; ((LAS float*)(lds + BIAS2_OFF))[i] = (rb[bk * 12 + hd] - rb[31 * 12 + hd]) * 1.4426950408889634f; } }
    __syncthreads();
    const int lo = a_.ph_lo, hi = a_.ph_hi;
    XcdBarrier bar; bar.bar = (unsigned*)(a.ws + WS_CTL) + CW_BAR; bar.x = 0; bar.st = nullptr;
    if (hi - lo > 1) { PHASE_IDS(); bar = xcd_barrier_post(ctl + CW_BAR, MISC + 8, tid_ == 0); }
#ifndef SUB_MASK
#define SUB_MASK 0xFFu
#endif
#define SUB(k) ((SUB_MASK >> (k)) & 1u)
#define HASP(k) ((PM >> ((k) % PPL + ((k) >= 2 * PPL ? PPL : 0))) & 1u)
#define IN(k) (HASP(k) && lo <= (k) && (k) < hi)
#define SEAM(k) do { if ((k) + 1 < hi) { const int sl_ = my_lane(); int sw_ = wave0; asm volatile("" : "+s"(sw_)); xcd_barrier(bar, sw_ == 0 && sl_ == 0); } } while (0)
    for (int l = 0; l < DEPTH; ++l) {
        const int pb = l * PPL;
        if (IN(pb + 0)) { PHASE_IDS(); p1_weights_i8(ap, l, lds, bid, G, wave, lane); router_weights(ap, l, gw, NGW, lane); lru_weights(ap, l, gw, NGW, lane); cmp_weights(ap, l, lds, gw, NGW, wave, lane); phase0_weights(ap, l, lds, gw, NGW, wave, lane); phase0_rows(ap, l, 0, gw, NGW, lane); SEAM(pb + 0); }
        if (IN(pb + 1)) {
            PHASE_IDS();
            {   int K1q = 512; asm volatile("" : "+s"(K1q));
                pg8::Gemm g{K1q, 512, 512, 128, -1}; SchedP1 S{(const char*)(ap.ws + WS_HQ), (const char*)(ap.ws + WS_WQ), 128, 26, 1024, 1024, G, bid};
                EpiP1I8 E{proj, (unsigned char*)gates, ap.in[25] + (size_t)l * 4096, (const float*)(ap.ws + WS_HSC), (const float*)(ap.ws + WS_WSC)};
                pg8::gemm_phase<EpiP1I8, SchedP1, false, true>(lds, g, S, E, tid_); }
            SEAM(pb + 1);
        }
        if (IN(pb + 2)) {
            PHASE_IDS();
            LAS float* lamp = (LAS float*)(lds + MISC_OFF + 64);
            if (tid_ < 64) { const float* q1 = ap.in[13] + l * 32; const float* k1 = ap.in[14] + l * 32; const float* q2 = ap.in[15] + l * 32; const float* k2 = ap.in[16] + l * 32;
                float s1 = (lane < 32) ? q1[lane] * k1[lane] : 0.f, s2 = (lane < 32) ? q2[lane] * k2[lane] : 0.f; s1 = wave_sum(s1); s2 = wave_sum(s2);
                const float lam_init = 0.8f - 0.6f * __expf(-0.3f * (float)l); if (lane == 0) { lamp[0] = __expf(s1) - __expf(s2) + lam_init; lamp[1] = lam_init; } }
            __syncthreads();
            if (SUB(0)) { const LAS float* bias2 = (const LAS float*)(lds + BIAS2_OFF); const GAS float* subg = (const GAS float*)(ap.in[17] + l * 64);
                for (int pi = xb; pi < 256; pi += G) { const int bh = pi >> 4, qlo = pi & 15;
                    diff_unit((const GAS bf16*)proj, (GAS bf16*)ys, lds, bias2, subg, lamp, bh >> 2, bh & 3, 31 - qlo, wave);
                    diff_unit((const GAS bf16*)proj, (GAS bf16*)ys, lds, bias2, subg, lamp, bh >> 2, bh & 3, qlo, wave); } }
            { PHASE_IDS();
            if (SUB(3)) { __syncthreads(); const LAS float* bias2 = (const LAS float*)(lds + BIAS2_OFF); const GAS float* sinks = (const GAS float*)(ap.in[12] + l * 4);
                for (int pi = xb; pi < 512; pi += G) swa_unit((const GAS bf16*)proj, (GAS bf16*)ys, lds, bias2, biasd, sinks, pi >> 7, pi & 127, tid_, lane, wave); }
            if (SUB(2)) cmp_block(ap, l, (const GAS bf16*)proj, (const GAS bf16*)(ap.ws + WS_WCMP), (float*)(ap.ws + WS_CMPAB), kcb, bid, wave, lane);
            if (SUB(1)) { __syncthreads(); for (int task = xb; task < 512; task += G) lru_unit(ap, l, (const GAS bf16*)proj, (GAS bf16*)ys, (GAS float*)lrusum, lds, task, lane, wave, false); }
            }
            SEAM(pb + 2);
        }
        if (IN(pb + 4)) {
            PHASE_IDS();
            for (int task = xb; task < 512; task += G) lru_unit(ap, l, (const GAS bf16*)proj, (GAS bf16*)ys, (GAS float*)lrusum, lds, task, lane, wave, true);
            __syncthreads();
            if (SUB(4)) { const LAS float* bias2 = (const LAS float*)(lds + BIAS2_OFF);
                for (int pi = xb; pi < 256; pi += G) { const int bb = pi >> 6, ulo = pi & 63;
                    nsa_unit((const GAS bf16*)proj, (GAS bf16*)ys, (const GAS bf16*)kcb, lds, bias2, bb, 127 - ulo, tid_, lane, wave);
                    nsa_unit((const GAS bf16*)proj, (GAS bf16*)ys, (const GAS bf16*)kcb, lds, bias2, bb, ulo, tid_, lane, wave); } }
            SEAM(pb + 4);
        }
        if (IN(pb + 5)) {
            PHASE_IDS();
            int K5 = 256; asm volatile("" : "+s"(K5));
            pg8::Gemm g{K5, 1024, 256, 128, -1}; SchedP3a S{(const char*)ys, (const char*)(ap.ws + WS_WBR), G, xb};
            EpiP3a E{merged, (const unsigned char*)gates};
            pg8::gemm_phase<EpiP3a, SchedP3a>(lds, g, S, E, tid_); SEAM(pb + 5);
        }
        if (IN(pb + 6)) {
            PHASE_IDS();
            int K6 = 1024; asm volatile("" : "+s"(K6));
            pg8::Gemm g{K6, 1024, 1024, 128, -1}; SchedP3b S{(const char*)merged, (const char*)(ap.ws + WS_WOUT), G, xb};
            if (l == 0) { EpiP3b<true> E{ap.in[0], (bf16*)(ap.ws + WS_XB)}; pg8::gemm_phase<EpiP3b<true>, SchedP3b>(lds, g, S, E, tid_); }
            else { EpiP3b<false> E{nullptr, (bf16*)(ap.ws + WS_XB)}; pg8::gemm_phase<EpiP3b<false>, SchedP3b>(lds, g, S, E, tid_); }
            SEAM(pb + 6);
        }
        if (IN(pb + 7)) {
            PHASE_IDS();
            bf16* xr = (bf16*)(ap.ws + WS_XR); float* rlog = (float*)(ap.ws + WS_RLOG);
            constexpr int NITW = 32 * (2 * 16 * 8 + 4 * 32);
            { const int pm = bid;
                for (int r = wave * 4; r < 128; r += 32) route_rows4(ap, l, xr, pm * 128 + r, lane);
                asm volatile("s_waitcnt vmcnt(0)" ::: "memory"); __syncthreads();
                { pg8::Gemm g{2048, 2048, 2048, 128, 0}; SchedRoute S{(const char*)xr, (const char*)(ap.ws + WS_WR), pm}; EpiRoute E{rlog};
                  pg8::gemm_phase<EpiRoute, SchedRoute>(lds, g, S, E, tid_); }
                asm volatile("s_waitcnt vmcnt(0)" ::: "memory"); __syncthreads();
                if (tid_ < 128) route_decide(ap, l, rlog + (size_t)(pm * 128 + tid_) * 128, rec_e, rec_slot, rec_w, ctl + CW_CNT + l * 32, pm * 128 + tid_);
                __syncthreads();
            }
            expert_weights(ap, l, lds, 0, NITW, gw, NGW, wave, lane);
            SEAM(pb + 7);
        }
        if (IN(pb + 9)) {
            PHASE_IDS();
            build_offsets(ctl + CW_CNT + l * 32, offt, tid_);
            int K9 = 1024; asm volatile("" : "+s"(K9));
            pg8::Gemm g{K9, 2048, 1024, 128, -1}; SchedM2 S{(const char*)(ap.ws + WS_XR), (const char*)(ap.ws + WS_WGU), offt, (const int*)(ap.ws + WS_INVAS), G, xb};
            EpiM2 E{hmid};
            pg8::gemm_phase<EpiM2, SchedM2, true>(lds, g, S, E, tid_); SEAM(pb + 9);
        }
        if (IN(pb + 10)) {
            PHASE_IDS();
            build_offsets(ctl + CW_CNT + l * 32, offt, tid_);
            int K3 = 256; asm volatile("" : "+s"(K3));
            pg8::Gemm g{K3, 256, 256, 128, -1}; SchedM3 S{(const char*)hmid, (const char*)(ap.ws + WS_WD), offt, G, xb};
            EpiM3 E{eo, (const int*)(ap.ws + WS_INVAS), (const float*)(ap.ws + WS_INVW), offt};
            pg8::gemm_phase<EpiM3, SchedM3>(lds, g, S, E, tid_); SEAM(pb + 10);
        }
    }
    if (IN(2 * PPL)) { PHASE_IDS(); phase0_rows(ap, DEPTH, 1, gw, NGW, lane); }
#undef IN
#undef SEAM
}

typedef void (*kern_t)(Args);
template <unsigned PM> static bool setup_kernel() {
    if (hipFuncSetAttribute((const void*)mk_fwd<PM>, hipFuncAttributeMaxDynamicSharedMemorySize, LDS_BYTES) != hipSuccess) { fprintf(stderr, "kernel_launch: hipFuncSetAttribute failed\n"); return false; }
    return true;
}
extern "C" void kernel_launch(void* const* d_in, const int* in_sizes, int n_in, void* d_out, int out_size, void* d_ws, size_t ws_size, hipStream_t stream) {
    static int grid = 0;
    if (grid == 0) {
        if (n_in != 36 || out_size != T * D || ws_size < WS_END) { fprintf(stderr, "kernel_launch: unexpected shapes (n_in %d out %d ws %zu)\n", n_in, out_size, ws_size); grid = -1; return; }
        int dev = 0, cus = 0;
        if (hipGetDevice(&dev) != hipSuccess || hipDeviceGetAttribute(&cus, hipDeviceAttributeMultiprocessorCount, dev) != hipSuccess) { grid = -1; return; }
        bool ok = true;
#if MK_ONE_LAUNCH
        ok = setup_kernel<0xFFFu>();
#endif
        if (!ok) { grid = -1; return; }
        (void)hipGetLastError();
        grid = cus;
        if (grid != 256) { fprintf(stderr, "kernel_launch: built for a 256-CU device (got %d)\n", cus); grid = -1; return; }
    }
    if (grid < 0) return;
    if (hipMemsetAsync((char*)d_ws + WS_CTL, 0, CTL_ZERO_BYTES, stream) != hipSuccess) return;
    Args a{};
    for (int i = 0; i < 36; ++i) a.in[i] = (const float*)d_in[i];
    a.out = (float*)d_out; a.ws = (unsigned char*)d_ws;
#if MK_ONE_LAUNCH
    a.ph_lo = 0; a.ph_hi = NPH;
    hipLaunchKernelGGL(mk_fwd<0xFFFu>, dim3(grid), dim3(512), LDS_BYTES, stream, a);
#endif
}
```

```cpp
#include <hip/hip_runtime.h>
#include <cstdio>
#include <cstdint>

#ifndef MK_ONE_LAUNCH
#define MK_ONE_LAUNCH 1
#endif

#define DI __device__ __forceinline__
#define GAS __attribute__((address_space(1)))
#define LAS __attribute__((address_space(3)))
typedef unsigned short bf16;
typedef short bf16x8 __attribute__((ext_vector_type(8)));
typedef float f32x4 __attribute__((ext_vector_type(4)));
typedef int i32x4 __attribute__((ext_vector_type(4)));
typedef unsigned u32x4 __attribute__((ext_vector_type(4)));
typedef unsigned u32x2 __attribute__((ext_vector_type(2)));
typedef float f32x16 __attribute__((ext_vector_type(16)));
typedef float f32x2 __attribute__((ext_vector_type(2)));
typedef short s16x4 __attribute__((ext_vector_type(4)));
typedef __bf16 bf16x2_t __attribute__((ext_vector_type(2)));
typedef short v4i16_t __attribute__((__vector_size__(4 * sizeof(short))));
#define MFMA32(a, b, c) __builtin_amdgcn_mfma_f32_32x32x16_bf16((a), (b), (c), 0, 0, 0)

constexpr int BATCH = 4, SEQ = 8192, T = BATCH * SEQ, D = 1024, DEPTH = 2;
constexpr int NIN = 2444, PLD = 2560, N1 = 6656, GLD = 4096;
constexpr int C_AX = 0, C_AG = 256, C_BQ = 512, C_BK = 768, C_BV = 896, C_CQ = 1024, C_CK = 1280, C_CV = 1536, C_DQ = 1792,
              C_KC = 2048, C_VC = 2112, C_KS = 2176, C_VS = 2240, C_KW = 2304, C_VW = 2368, C_DG = 2432;
constexpr int NCMP = 511;
constexpr int MOE_ROWS = 73728;
constexpr int PPL = 11;
constexpr int NPH = 2 * PPL + 1;

constexpr size_t MiB = 1u << 20;
constexpr size_t WS_CTL = 0, CTL_ZERO_BYTES = 1 * MiB;
constexpr size_t WS_KCVC = 1 * MiB;
constexpr size_t WS_LRUSUM = 2 * MiB;
constexpr size_t WS_REC = 2 * MiB + 256 * 1024;
constexpr size_t WS_ROWTOK = 3 * MiB;
constexpr size_t WS_ROWW = 3 * MiB + 512 * 1024;
constexpr size_t WS_WIN = 4 * MiB;
constexpr size_t WS_WQ = 4 * MiB;
constexpr size_t WS_WSC = 13 * MiB;
constexpr size_t WS_HSC = 13 * MiB + 65536;
constexpr size_t WS_HQ = 21 * MiB;
constexpr size_t WS_INVAS = 296 * MiB;
constexpr size_t WS_INVW = 300 * MiB;
constexpr size_t WS_XB = 373 * MiB;
constexpr size_t WS_WBR = 17 * MiB;
constexpr size_t WS_WOUT = 19 * MiB;
constexpr size_t WS_HB = 21 * MiB;
constexpr size_t WS_PROJ = 85 * MiB;
constexpr size_t WS_GATES = 245 * MiB;
constexpr size_t WS_WGU = 245 * MiB;
constexpr size_t WS_WD = 277 * MiB;
constexpr size_t WS_XS = 293 * MiB;
constexpr size_t WS_HMID = 437 * MiB;
constexpr size_t WS_XR = 85 * MiB;
constexpr size_t WS_RLOG = 213 * MiB;
constexpr size_t WS_WR = 501 * MiB;
constexpr size_t WS_WCMP = 502 * MiB;
constexpr size_t WS_CMPAB = 503 * MiB;
constexpr size_t WS_LRUW = 505 * MiB + 65536;
constexpr size_t WS_END = 506 * MiB;
constexpr int CW_BAR = 4096;
constexpr int CW_CNT = 16384;

constexpr int RING_BYTES = 131072;
constexpr int MISC_OFF = RING_BYTES;
constexpr int BIAS_OFF = MISC_OFF + 256;
constexpr int OFFT_OFF = BIAS_OFF + 129 * 12 * 4;
constexpr int PTAB_OFF = OFFT_OFF + (40 + 288 + 40) * 4;
constexpr int BIAS2_OFF = PTAB_OFF + 36 * 8;
constexpr int LRUEX_OFF = BIAS2_OFF + 129 * 12 * 4;
constexpr int LDS_BYTES = 163840;
constexpr int LRUCST_OFF = LRUEX_OFF + 8 * 64 * 2 * 4;
constexpr int LRUCAR_OFF = LRUCST_OFF + 3 * 64 * 4;
static_assert(PTAB_OFF % 8 == 0 && LRUCAR_OFF + 8 * 64 * 4 <= LDS_BYTES, "LDS map");

DI float bf2f(bf16 v) { return __builtin_bit_cast(float, (unsigned)v << 16); }
DI float lo_bf(unsigned w) { return __builtin_bit_cast(float, w << 16); }
DI float hi_bf(unsigned w) { return __builtin_bit_cast(float, w & 0xffff0000u); }
DI unsigned f2bf(float f) { unsigned u = __builtin_bit_cast(unsigned, f); return (u + 0x7fffu + ((u >> 16) & 1u)) >> 16; }
DI unsigned pk2(float lo, float hi) { return f2bf(lo) | (f2bf(hi) << 16); }
DI float rl(float v, int i) { return __builtin_bit_cast(float, __builtin_amdgcn_readlane(__builtin_bit_cast(int, v), i)); }
DI int rli(int v, int i) { return __builtin_amdgcn_readlane(v, i); }
DI int my_lane() { int l; asm volatile("v_mbcnt_lo_u32_b32 %0, -1, 0\n\tv_mbcnt_hi_u32_b32 %0, -1, %0" : "=v"(l)); return l; }
template <int O> DI int xshfl_i(int v) {
    if constexpr (O < 32) return __builtin_amdgcn_ds_swizzle(v, (O << 10) | 0x1f);
    else { const int l = my_lane(); return __builtin_amdgcn_ds_bpermute((l ^ 32) << 2, v); }
}
template <int O> DI float xshfl(float v) { return __builtin_bit_cast(float, xshfl_i<O>(__builtin_bit_cast(int, v))); }
DI float wave_sum(float v) { v += xshfl<1>(v); v += xshfl<2>(v); v += xshfl<4>(v); v += xshfl<8>(v); v += xshfl<16>(v); v += xshfl<32>(v); return v; }
DI float wave_max(float v) { v = fmaxf(v, xshfl<1>(v)); v = fmaxf(v, xshfl<2>(v)); v = fmaxf(v, xshfl<4>(v)); v = fmaxf(v, xshfl<8>(v)); v = fmaxf(v, xshfl<16>(v)); v = fmaxf(v, xshfl<32>(v)); return v; }
DI float sigmoidf_(float x) { return __builtin_amdgcn_rcpf(1.f + __builtin_amdgcn_exp2f(-1.4426950408889634f * x)); }
DI float gelu_tanh(float x) { const float u = 0.7978845608028654f * (x + 0.044715f * x * x * x); const float e = __expf(2.f * u); const float th = 1.f - 2.f * __builtin_amdgcn_rcpf(e + 1.f); return 0.5f * x * (1.f + th); }
DI float softplusf_(float x) { return fmaxf(x, 0.f) + log1pf(__expf(-fabsf(x))); }
#define LDS_WAIT() asm volatile("s_waitcnt lgkmcnt(0)" ::: "memory")
#define VM_WAIT() asm volatile("s_waitcnt vmcnt(0)" ::: "memory")

__device__ const unsigned char T5_BUCKET[128] = {
0,1,2,3,4,5,6,7,8,9,10,11,12,13,14,15,16,16,16,17,17,18,18,18,19,19,19,20,20,20,20,21,21,21,21,22,22,22,22,22,23,23,23,23,23,23,24,24,24,24,24,24,25,25,25,25,25,25,25,26,26,26,26,26,26,26,26,27,27,27,27,27,27,27,27,27,27,28,28,28,28,28,28,28,28,28,28,29,29,29,29,29,29,29,29,29,29,29,29,30,30,30,30,30,30,30,30,30,30,30,30,30,30,31,31,31,31,31,31,31,31,31,31,31,31,31,31,31};

#define XB_TMO      128
#define XB_XCNT(j)  (256  + 64 * (j))
#define XB_XSUB(j)  (1280 + 64 * (j))
#define XB_XGEN(j)  (2304 + 64 * (j))
#define XB_TOP      3328
#define XB_TOPGEN   3392
#define XCD_BAR_WORDS 3456
#define XB_SPIN_CAP (1u << 22)
DI unsigned xb_ld(unsigned* p)              { return __hip_atomic_load(p, __ATOMIC_RELAXED, __HIP_MEMORY_SCOPE_AGENT); }
DI unsigned xb_add(unsigned* p, unsigned v) { return __hip_atomic_fetch_add(p, v, __ATOMIC_RELAXED, __HIP_MEMORY_SCOPE_AGENT); }
DI unsigned xb_xcc_id() { return (unsigned)__builtin_amdgcn_s_getreg((3 << 11) | 20) & 0xFu; }
#define XB_SPIN(cond, bar) do { unsigned _sp = 0; while (cond) { __builtin_amdgcn_s_sleep(1); \
    if ((++_sp & 255u) == 0u) { if (xb_ld(&(bar)[XB_TMO])) break; if (_sp > XB_SPIN_CAP) { atomicAdd(&(bar)[XB_TMO], 1u); break; } } } } while (0)
struct XcdBarrier { unsigned* bar; unsigned x; volatile LAS unsigned* st; };
DI XcdBarrier xcd_barrier_post(unsigned* bar, volatile LAS unsigned* st, bool leader) {
    XcdBarrier b; b.bar = bar; b.x = xb_xcc_id(); b.st = st;
    if (leader) (void)xb_add(&bar[XB_XCNT(b.x)], 1u);
    return b;
}
DI void xcd_barrier_complete(unsigned* bar, unsigned x, unsigned& nloc, unsigned& nx) {
    const unsigned G = gridDim.x * gridDim.y * gridDim.z;
    unsigned sum, cnt, mine, sp = 0u;
    for (;;) {
        sum = 0u; cnt = 0u; mine = 0u;
#pragma unroll
        for (unsigned j = 0; j < 16; ++j) { const unsigned c = xb_ld(&bar[XB_XCNT(j)]); sum += c; cnt += (c > 0u) ? 1u : 0u; mine = (j == x) ? c : mine; }
        if (sum == G) break;
        __builtin_amdgcn_s_sleep(1);
        if ((++sp & 255u) == 0u) { if (xb_ld(&bar[XB_TMO])) break; if (sp > XB_SPIN_CAP) { atomicAdd(&bar[XB_TMO], 1u); break; } }
    }
    nloc = mine > 0u ? mine : 1u; nx = cnt > 0u ? cnt : 1u;
}
DI void xcd_barrier(const XcdBarrier& b, bool leader) {
    asm volatile("s_waitcnt vmcnt(0)" ::: "memory");
    __syncthreads();
    if (leader) {
        unsigned* bar = b.bar;
        __builtin_amdgcn_s_waitcnt(0);
        unsigned nloc = b.st[0], nx = b.st[1];
        if (nloc == 0u) { xcd_barrier_complete(bar, b.x, nloc, nx); b.st[0] = nloc; b.st[1] = nx; }
        const unsigned old = xb_add(&bar[XB_XSUB(b.x)], 1u);
        const unsigned gen = old / nloc;
        if (old + 1u == (gen + 1u) * nloc) {
            __builtin_amdgcn_fence(__ATOMIC_RELEASE, "agent");
            asm volatile("s_waitcnt vmcnt(0)" ::: "memory");
            const unsigned og = xb_add(&bar[XB_TOP], 1u);
            const unsigned tg = og / nx;
            if (og + 1u == (tg + 1u) * nx) xb_add(&bar[XB_TOPGEN], 1u);
            else XB_SPIN(xb_ld(&bar[XB_TOPGEN]) == tg, bar);
            __builtin_amdgcn_fence(__ATOMIC_ACQUIRE, "agent");
            xb_add(&bar[XB_XGEN(b.x)], 1u);
            asm volatile("s_waitcnt vmcnt(0)" ::: "memory");
        } else {
            XB_SPIN(xb_ld(&bar[XB_XGEN(b.x)]) == gen, bar);
            __builtin_amdgcn_fence(__ATOMIC_ACQUIRE, "agent");
            asm volatile("s_waitcnt vmcnt(0)" ::: "memory");
        }
    }
    __syncthreads();
}

namespace pg8 {
constexpr int BM = 256, BK = 64, HALF = 128, HTB = HALF * BK * 2;
__host__ __device__ __forceinline__ int lds_byte(int r, int c) { const int st = (r >> 4) * 2 + (c >> 5), rr = r & 15, cc = c & 31, ob = rr * 64 + cc * 2; return st * 1024 + (ob ^ (((ob >> 9) & 1) << 5)); }
__host__ __device__ __forceinline__ void stage_rc(int b, int& R, int& C) { const int st = b / 1024, sb = b % 1024, swz = sb ^ (((sb >> 9) & 1) << 5); R = (st >> 1) * 16 + swz / 64; C = (st & 1) * 32 + (swz % 64) / 2; }
__host__ __device__ __forceinline__ int perm32(int rho) { const int n = rho >> 4, i = rho & 15; return 8 * (i >> 2) + 4 * n + (i & 3); }
struct Unit { const char* a; const char* b; int pm, pn, aux, pad; };
struct Gemm { int K, lda, ldb, kstepA, hstepA; };
template <bool I8> struct AccT { typedef f32x4 type; };
template <> struct AccT<true> { typedef i32x4 type; };
template <class Epi, class Sched, bool GATHER = false, bool I8 = false>
DI void gemm_phase(LAS unsigned char* lds, const Gemm g, const Sched& S, const Epi& E, int tid_in) {
    int tid = tid_in; asm volatile("" : "+v"(tid));
    const int wid = __builtin_amdgcn_readfirstlane(tid >> 6), lane = tid & 63, wr = wid >> 2, wc = wid & 3, fr = lane & 15, fq = lane >> 4;
    const int K = g.K, nt = K / BK;
    unsigned voffA[2], voffB[2];
#pragma unroll
    for (int i = 0; i < 2; ++i) { int R, C; stage_rc(tid * 16 + i * 8192, R, C); const int Rb = (R & ~31) + perm32(R & 31);
        voffA[i] = (unsigned)(R * g.lda + C) * 2u; voffB[i] = (unsigned)(Rb * g.ldb + C) * 2u; }
    const size_t kstep = (size_t)(BK * 2), kstepA = (size_t)g.kstepA;
    const size_t hstepA = g.hstepA < 0 ? (size_t)HALF * g.lda * 2 : (size_t)g.hstepA, hstepB = (size_t)HALF * g.ldb * 2;
    const unsigned hstepA32 = (unsigned)hstepA;
    unsigned gC[2][2] = {{0u, 0u}, {0u, 0u}}, gN[2][2] = {{0u, 0u}, {0u, 0u}};
    const unsigned ldsw = (unsigned)wid * 1024u;
    const int aoff = lds_byte(wr * 64 + fr, fq * 8), boff = lds_byte(wc * 32 + fr, fq * 8);
#define PG8_SA(b, h) (((b) * 2 + (h)) * HTB)
#define PG8_SB(b, h) ((4 + (b) * 2 + (h)) * HTB)
#define PG8_STAGE(bufoff, gbase, voff) do { _Pragma("unroll") for (int _i = 0; _i < 2; ++_i) \
        __builtin_amdgcn_global_load_lds((const unsigned*)((const char*)(gbase) + (voff)[_i]), (LAS unsigned*)(lds + (bufoff) + ldsw + _i * 8192), 16, 0, 0); } while (0)
#define PG8_STAGEA(bufoff, gbase, h, nextsel) do { _Pragma("unroll") for (int _i = 0; _i < 2; ++_i) { \
        const unsigned _o = GATHER ? ((nextsel) ? gN[h][_i] : gC[h][_i]) : (voffA[_i] + (unsigned)(h) * hstepA32); \
        __builtin_amdgcn_global_load_lds((const unsigned*)((const char*)(gbase) + _o), (LAS unsigned*)(lds + (bufoff) + ldsw + _i * 8192), 16, 0, 0); } } while (0)
#define PG8_LDA(dst, b, h) do { _Pragma("unroll") for (int m = 0; m < 4; ++m) _Pragma("unroll") for (int k = 0; k < 2; ++k) dst[m][k] = *(const LAS bf16x8*)(lds + PG8_SA(b, h) + aoff + m * 2048 + k * 1024); } while (0)
#define PG8_LDB(dst, b, h) do { _Pragma("unroll") for (int n = 0; n < 2; ++n) _Pragma("unroll") for (int k = 0; k < 2; ++k) dst[n][k] = *(const LAS bf16x8*)(lds + PG8_SB(b, h) + boff + n * 2048 + k * 1024); } while (0)
#define PG8_MMA(ai, bj, At, Bt) do { __builtin_amdgcn_s_setprio(1); _Pragma("unroll") for (int m = 0; m < 4; ++m) _Pragma("unroll") for (int n = 0; n < 2; ++n) _Pragma("unroll") for (int k = 0; k < 2; ++k) \
        { if constexpr (I8) acc[ai][bj][m][n] = __builtin_amdgcn_mfma_i32_16x16x64_i8(__builtin_bit_cast(i32x4, Bt[n][k]), __builtin_bit_cast(i32x4, At[m][k]), acc[ai][bj][m][n], 0, 0, 0); \
          else acc[ai][bj][m][n] = __builtin_amdgcn_mfma_f32_16x16x32_bf16(Bt[n][k], At[m][k], acc[ai][bj][m][n], 0, 0, 0); } __builtin_amdgcn_s_setprio(0); } while (0)
#define PG8_WAIT_V(n) asm volatile("s_waitcnt vmcnt(" #n ")" ::: "memory")
#define PG8_WAIT_L(n) asm volatile("s_waitcnt lgkmcnt(" #n ")" ::: "memory")
#define PG8_BAR __builtin_amdgcn_s_barrier()
#define PG8_SCHED __builtin_amdgcn_sched_barrier(0)
    Unit cur, nxt; int ui = 0;
    if (!S.next(0, cur)) return;
    typedef typename AccT<I8>::type ACC;
    ACC acc[2][2][4][2];
#pragma unroll
    for (int a = 0; a < 2; ++a)
#pragma unroll
        for (int b = 0; b < 2; ++b)
#pragma unroll
            for (int m = 0; m < 4; ++m)
#pragma unroll
                for (int n = 0; n < 2; ++n) acc[a][b][m][n] = (ACC){0, 0, 0, 0};
    bf16x8 At[4][2], B0[2][2], B1[2][2];
    const char* cA = cur.a; const char* cB = cur.b;
    if constexpr (GATHER) S.rows(cur, tid, gC);
    PG8_STAGE(PG8_SB(0, 0), cB, voffB); PG8_STAGE(PG8_SB(0, 1), cB + hstepB, voffB); PG8_STAGEA(PG8_SA(0, 0), cA, 0, false); PG8_STAGEA(PG8_SA(0, 1), cA, 1, false);
    if (wr == 1) PG8_BAR;
    PG8_WAIT_V(2); PG8_BAR;
    PG8_STAGE(PG8_SB(1, 0), cB + kstep, voffB); PG8_STAGEA(PG8_SA(1, 0), cA + kstepA, 0, false); PG8_STAGE(PG8_SB(1, 1), cB + hstepB + kstep, voffB);
    PG8_WAIT_V(6); PG8_BAR;
    for (;;) {
        const bool has_next = S.next(ui + 1, nxt);
        const char* nA = has_next ? nxt.a : cA; const char* nB = has_next ? nxt.b : cB;
        if constexpr (GATHER) { if (has_next) S.rows(nxt, tid, gN); else {
#pragma unroll
            for (int h = 0; h < 2; ++h) { gN[h][0] = gC[h][0]; gN[h][1] = gC[h][1]; } } }
        for (int t = 0; t < nt; t += 2) {
            const bool last = (t == nt - 2);
            const char* a1 = cA + (size_t)(t + 1) * kstepA;
            const char* a2 = last ? nA : cA + (size_t)(t + 2) * kstepA; const char* b2 = last ? nB : cB + (size_t)(t + 2) * kstep;
            const char* a3 = a2 + kstepA; const char* b3 = b2 + kstep;
            PG8_LDB(B0, 0, 0); PG8_LDB(B1, 0, 1); PG8_SCHED; PG8_LDA(At, 0, 0); PG8_STAGEA(PG8_SA(1, 1), a1, 1, false);
            PG8_WAIT_V(8); PG8_WAIT_L(0); PG8_BAR; PG8_MMA(0, 0, At, B0); PG8_MMA(0, 1, At, B1); PG8_BAR; PG8_SCHED;
            PG8_LDA(At, 0, 1); PG8_STAGE(PG8_SB(0, 0), b2, voffB); PG8_STAGE(PG8_SB(0, 1), b2 + hstepB, voffB); PG8_STAGEA(PG8_SA(0, 0), a2, 0, last);
            PG8_WAIT_V(8); PG8_WAIT_L(0); PG8_BAR; PG8_MMA(1, 0, At, B0); PG8_MMA(1, 1, At, B1); PG8_BAR; PG8_SCHED;
            PG8_LDB(B0, 1, 0); PG8_LDB(B1, 1, 1); PG8_SCHED; PG8_LDA(At, 1, 0); PG8_STAGEA(PG8_SA(0, 1), a2, 1, last);
            PG8_WAIT_V(8); PG8_WAIT_L(0); PG8_BAR; PG8_MMA(0, 0, At, B0); PG8_MMA(0, 1, At, B1); PG8_BAR; PG8_SCHED;
            PG8_LDA(At, 1, 1); PG8_STAGE(PG8_SB(1, 0), b3, voffB); PG8_STAGE(PG8_SB(1, 1), b3 + hstepB, voffB); PG8_STAGEA(PG8_SA(1, 0), a3, 0, last);
            PG8_WAIT_V(8); PG8_WAIT_L(0); PG8_BAR; PG8_MMA(1, 0, At, B0); PG8_MMA(1, 1, At, B1); PG8_BAR; PG8_SCHED;
        }
        if (wr == 0) PG8_BAR;
        { const int el = my_lane(); E(acc, cur, wr, wc, el & 15, el >> 4); }
        if (!has_next) break;
        bool carried = false;
        if constexpr (Epi::CARRY) { if (nxt.aux != 0) { const int el = my_lane(); E.carry(acc, nxt, wr, wc, el & 15, el >> 4); carried = true; } }
        if (!carried) {
#pragma unroll
        for (int a = 0; a < 2; ++a)
#pragma unroll
            for (int b = 0; b < 2; ++b)
#pragma unroll
                for (int m = 0; m < 4; ++m)
#pragma unroll
                    for (int n = 0; n < 2; ++n) acc[a][b][m][n] = (ACC){0, 0, 0, 0};
        }
        cur = nxt; cA = nA; cB = nB; ++ui;
        if constexpr (GATHER) {
#pragma unroll
            for (int h = 0; h < 2; ++h) { gC[h][0] = gN[h][0]; gC[h][1] = gN[h][1]; } }
        if (wr == 1) PG8_BAR;
    }
    PG8_WAIT_V(0);
    PG8_BAR;
#undef PG8_SA
#undef PG8_SB
#undef PG8_STAGE
#undef PG8_STAGEA
#undef PG8_LDA
#undef PG8_LDB
#undef PG8_MMA
#undef PG8_WAIT_V
#undef PG8_WAIT_L
#undef PG8_BAR
#undef PG8_SCHED
}
}
using pg8::Unit;

DI unsigned cvt_pk_bf16(float lo, float hi) { unsigned r; asm volatile("s_nop 1\n\tv_cvt_pk_bf16_f32 %0, %1, %2" : "=v"(r) : "v"(lo), "v"(hi)); return r; }
DI u32x4 pack8(const f32x4& v0, const f32x4& v1) { u32x4 w; w.x = cvt_pk_bf16(v0[0], v0[1]); w.y = cvt_pk_bf16(v0[2], v0[3]); w.z = cvt_pk_bf16(v1[0], v1[1]); w.w = cvt_pk_bf16(v1[2], v1[3]); return w; }

struct SchedP1 {
    const char* A; const char* B; int nM, nN, rbA, rbB, G, c;
    DI bool next(int i, Unit& u) const {
        constexpr int NXCD = 8, WGM = 8; const int nwg = nM * nN;
        const long L = (long)i * G + c; if (L >= nwg) return false;
        int wgid = (int)L; { const int q = nwg / NXCD, r = nwg % NXCD, xcd = wgid % NXCD, off = wgid / NXCD; wgid = (xcd < r ? xcd * (q + 1) : r * (q + 1) + (xcd - r) * q) + off; }
        const int nig = WGM * nN, gid = wgid / nig, fm = gid * WGM, gsz = (nM - fm) < WGM ? (nM - fm) : WGM;
        u.pm = fm + ((wgid % nig) % gsz); u.pn = (wgid % nig) / gsz; u.aux = 0; u.pad = 0;
        u.a = A + (size_t)u.pm * 256 * rbA; u.b = B + (size_t)u.pn * 256 * rbB; return true;
    }
};
struct SchedP3a {
    const char* ys; const char* wbr; int G, c;
    DI bool next(int i, Unit& u) const {
        const int tile = (i >> 2) * G + c; if (tile >= 512) return false;
        const int br = i & 3; u.pm = tile >> 2; u.pn = tile & 3; u.aux = br; u.pad = 0;
        u.a = ys + ((size_t)u.pm * 256 * 1024 + br * 256) * 2; u.b = wbr + ((size_t)br * 1024 * 256 + (size_t)u.pn * 256 * 256) * 2; return true;
    }
};
struct SchedP3b {
    const char* A; const char* B; int G, c;
    DI bool next(int i, Unit& u) const {
        const int L = i * G + c; if (L >= 512) return false;
        u.pm = L >> 2; u.pn = L & 3; u.aux = 0; u.pad = 0;
        u.a = A + (size_t)u.pm * 256 * 1024 * 2; u.b = B + (size_t)u.pn * 256 * 1024 * 2; return true;
    }
};
struct SchedM2 {
    const char* xr; const char* wgu; const LAS int* offt; const int* rowsrc; int G, c;
    DI bool next(int i, Unit& u) const {
        const int NT = __builtin_amdgcn_readfirstlane(offt[32]) >> 8; const int L = i * G + c; if (L >= NT * 2) return false;
        const int rt = L >> 1, pn = L & 1; const int e = __builtin_amdgcn_readfirstlane(offt[40 + rt]);
        u.pm = rt; u.pn = pn; u.aux = e; u.pad = 0;
        u.a = xr; u.b = wgu + ((size_t)e * 512 + pn * 256) * 1024 * 2; return true;
    }
    DI void rows(const Unit& u, int tid, unsigned (&g)[2][2]) const {
        const int e = u.aux; const int base = u.pm * 256 - __builtin_amdgcn_readfirstlane(offt[e]), cnt = __builtin_amdgcn_readfirstlane(offt[330 + e]);
#pragma unroll
        for (int i = 0; i < 2; ++i) { int R, C; pg8::stage_rc(tid * 16 + i * 8192, R, C);
#pragma unroll
            for (int h = 0; h < 2; ++h) { const int lr = base + h * 128 + R; const int as = lr < cnt ? rowsrc[e * 32768 + lr] : 0;
                g[h][i] = (unsigned)(as >> 1) * 4096u + (unsigned)C * 2u; } }
    }
};
struct SchedM3 {
    const char* hmid; const char* wd; const LAS int* offt; int G, c;
    DI bool next(int i, Unit& u) const {
        const int NT = __builtin_amdgcn_readfirstlane(offt[32]) >> 8; const int L = i * G + c; if (L >= NT * 4) return false;
        const int rt = L >> 2, pn = L & 3; const int e = __builtin_amdgcn_readfirstlane(offt[40 + rt]);
        u.pm = rt; u.pn = pn; u.aux = e; u.pad = 0;
        u.a = hmid + (size_t)rt * 256 * 256 * 2; u.b = wd + ((size_t)e * 1024 + pn * 256) * 256 * 2; return true;
    }
};

struct EpiP1I8 {
    static constexpr bool CARRY = false;
    bf16* proj; unsigned char* gates; const float* bgate; const float* hsc; const float* wsc;
    DI void operator()(const i32x4 (&acc)[2][2][4][2], const Unit& u, int wr, int wc, int fr, int fq) const {
        const int row0 = u.pm * 256 + wr * 64 + fr;
        if (u.pn < 10) { const int colt = u.pn * 256 + wc * 32 + 8 * fq;
            f32x4 sv[2][2]; float rsv[2][4];
#pragma unroll
            for (int bj = 0; bj < 2; ++bj)
#pragma unroll
                for (int n = 0; n < 2; ++n) sv[bj][n] = *(const GAS f32x4*)((const GAS float*)wsc + colt + bj * 128 + 4 * n);
#pragma unroll
            for (int ai = 0; ai < 2; ++ai)
#pragma unroll
                for (int m = 0; m < 4; ++m) rsv[ai][m] = ((const GAS float*)hsc)[row0 + ai * 128 + m * 16];
#pragma unroll
            for (int ai = 0; ai < 2; ++ai)
#pragma unroll
                for (int m = 0; m < 4; ++m) { bf16* rowp = proj + (size_t)(row0 + ai * 128 + m * 16) * PLD + colt; const float rs = rsv[ai][m];
#pragma unroll
                    for (int bj = 0; bj < 2; ++bj) { f32x4 v0, v1;
#pragma unroll
                        for (int e = 0; e < 4; ++e) { v0[e] = (float)acc[ai][bj][m][0][e] * (rs * sv[bj][0][e]); v1[e] = (float)acc[ai][bj][m][1][e] * (rs * sv[bj][1][e]); }
                        *(u32x4*)(rowp + bj * 128) = pack8(v0, v1); } }
            return; }
        const int gcol = (u.pn - 10) * 256 + wc * 32 + 8 * fq; const float* wsc = this->wsc + 2560;
        f32x4 bv[2][2], sv[2][2];
#pragma unroll
        for (int bj = 0; bj < 2; ++bj)
#pragma unroll
            for (int n = 0; n < 2; ++n) { bv[bj][n] = *(const f32x4*)(bgate + gcol + bj * 128 + 4 * n); sv[bj][n] = *(const f32x4*)(wsc + gcol + bj * 128 + 4 * n);
                sv[bj][n] = sv[bj][n] * -1.4426950408889634f; bv[bj][n] = bv[bj][n] * -1.4426950408889634f + (-8.f + 2.2e-5f); }
        float rsv[2][4];
#pragma unroll
        for (int ai = 0; ai < 2; ++ai)
#pragma unroll
            for (int m = 0; m < 4; ++m) rsv[ai][m] = ((const GAS float*)hsc)[row0 + ai * 128 + m * 16];
#pragma unroll
        for (int ai = 0; ai < 2; ++ai)
#pragma unroll
            for (int m = 0; m < 4; ++m) { const float rs = rsv[ai][m];
                unsigned char* rowp = gates + ((size_t)(u.pm * 16 + (u.pn - 10)) * 65536 + (size_t)((ai * 4 + m) * 8192 + (wr * 4 + wc) * 512 + (fq * 16 + fr) * 8));
#pragma unroll
                for (int bj = 0; bj < 2; ++bj) { unsigned q[8];
#pragma unroll
                    for (int n = 0; n < 2; ++n)
#pragma unroll
                        for (int e = 0; e < 4; ++e) { const float xe = ((float)acc[ai][bj][m][n][e] * rs) * sv[bj][n][e] + bv[bj][n][e];
                            q[4 * n + e] = (unsigned)__builtin_amdgcn_rcpf(0.00390631f + __builtin_amdgcn_exp2f(xe)); }
                    u32x2 w; w.x = q[0] | (q[1] << 8) | (q[2] << 16) | (q[3] << 24); w.y = q[4] | (q[5] << 8) | (q[6] << 16) | (q[7] << 24);
                    *(u32x2*)(rowp + bj * 4096) = w; }
                __builtin_amdgcn_sched_barrier(0); }
    }
};
struct EpiP3a {
    static constexpr bool CARRY = true;
    bf16* merged; const unsigned char* gates;
    DI void carry(f32x4 (&acc)[2][2][4][2], const Unit& u, int wr, int wc, int fr, int fq) const {
        const GAS unsigned char* gb = (const GAS unsigned char*)gates + (size_t)(u.pm * 16 + (u.aux - 1) * 4 + u.pn) * 65536;
        const unsigned go = (unsigned)((wr * 4 + wc) * 512 + (fq * 16 + fr) * 8);
        u32x2 gp[2][4][2], gn[2][4][2];
#pragma unroll
        for (int ai = 0; ai < 2; ++ai)
#pragma unroll
            for (int m = 0; m < 4; ++m)
#pragma unroll
                for (int bj = 0; bj < 2; ++bj) { gp[ai][m][bj] = *(const GAS u32x2*)(gb + go + (unsigned)(((ai * 4 + m) * 2 + bj) * 4096));
                    gn[ai][m][bj] = *(const GAS u32x2*)(gb + go + (unsigned)(((ai * 4 + m) * 2 + bj) * 4096 + 4 * 65536)); }
#pragma unroll
        for (int ai = 0; ai < 2; ++ai) {
#pragma unroll
            for (int m = 0; m < 4; ++m)
#pragma unroll
                for (int bj = 0; bj < 2; ++bj) {
#pragma unroll
                    for (int n = 0; n < 2; ++n) { const unsigned p4 = n ? gp[ai][m][bj].y : gp[ai][m][bj].x, n4 = n ? gn[ai][m][bj].y : gn[ai][m][bj].x;
#pragma unroll
                        for (int e = 0; e < 4; ++e) acc[ai][bj][m][n][e] *= ((float)((p4 >> (8 * e)) & 255u) + 0.5f) * __builtin_amdgcn_rcpf((float)((n4 >> (8 * e)) & 255u) + 0.5f); } }
            __builtin_amdgcn_sched_barrier(0); }
    }
    DI void operator()(const f32x4 (&acc)[2][2][4][2], const Unit& u, int wr, int wc, int fr, int fq) const {
        if (u.aux != 3) return;
        const GAS unsigned char* gb = (const GAS unsigned char*)gates + (size_t)(u.pm * 16 + 3 * 4 + u.pn) * 65536;
        GAS unsigned char* mb = (GAS unsigned char*)merged + ((size_t)(u.pm * 256) * 1024 + u.pn * 256) * 2;
        const unsigned go = (unsigned)((wr * 4 + wc) * 512 + (fq * 16 + fr) * 8), mo = (unsigned)((wr * 64 + fr) * 1024 + wc * 32 + 8 * fq) * 2u;
        u32x2 gw[2][4][2];
#pragma unroll
        for (int ai = 0; ai < 2; ++ai)
#pragma unroll
            for (int m = 0; m < 4; ++m)
#pragma unroll
                for (int bj = 0; bj < 2; ++bj) gw[ai][m][bj] = *(const GAS u32x2*)(gb + go + (unsigned)(((ai * 4 + m) * 2 + bj) * 4096));
#pragma unroll
        for (int ai = 0; ai < 2; ++ai) {
#pragma unroll
            for (int m = 0; m < 4; ++m)
#pragma unroll
                for (int bj = 0; bj < 2; ++bj) {
                    f32x4 v0 = acc[ai][bj][m][0], v1 = acc[ai][bj][m][1]; const u32x2 g2 = gw[ai][m][bj]; const float k256 = 0.00390625f;
#pragma unroll
                    for (int e = 0; e < 4; ++e) { v0[e] *= ((float)((g2.x >> (8 * e)) & 255u) + 0.5f) * k256; v1[e] *= ((float)((g2.y >> (8 * e)) & 255u) + 0.5f) * k256; }
                    *(GAS u32x4*)(mb + mo + (unsigned)((ai * 128 + m * 16) * 1024 + bj * 128) * 2u) = pack8(v0, v1); }
            __builtin_amdgcn_sched_barrier(0); }
    }
};
template <bool XF32> struct EpiP3b {
    static constexpr bool CARRY = false;
    const float* xin; bf16* xb_;
    DI void operator()(const f32x4 (&acc)[2][2][4][2], const Unit& u, int wr, int wc, int fr, int fq) const {
        GAS unsigned char* ob = (GAS unsigned char*)xb_ + ((size_t)(u.pm * 256) * 1024 + u.pn * 256) * 2;
        const unsigned lo = (unsigned)((wr * 64 + fr) * 1024 + wc * 32 + 8 * fq);
        if constexpr (XF32) {
            const GAS unsigned char* xb = (const GAS unsigned char*)xin + ((size_t)(u.pm * 256) * 1024 + u.pn * 256) * 4;
#pragma unroll
            for (int ai = 0; ai < 2; ++ai)
#pragma unroll
                for (int mh = 0; mh < 2; ++mh) {
                    f32x4 xv[2][2][2];
#pragma unroll
                    for (int m2 = 0; m2 < 2; ++m2)
#pragma unroll
                        for (int bj = 0; bj < 2; ++bj)
#pragma unroll
                            for (int n = 0; n < 2; ++n) xv[m2][bj][n] = *(const GAS f32x4*)(xb + (lo + (unsigned)((ai * 128 + (mh * 2 + m2) * 16) * 1024 + bj * 128 + 4 * n)) * 4u);
#pragma unroll
                    for (int m2 = 0; m2 < 2; ++m2)
#pragma unroll
                        for (int bj = 0; bj < 2; ++bj)
                            *(GAS u32x4*)(ob + (lo + (unsigned)((ai * 128 + (mh * 2 + m2) * 16) * 1024 + bj * 128)) * 2u) = pack8(xv[m2][bj][0] + acc[ai][bj][mh * 2 + m2][0], xv[m2][bj][1] + acc[ai][bj][mh * 2 + m2][1]);
                    __builtin_amdgcn_sched_barrier(0); }
        } else {
#pragma unroll
            for (int ai = 0; ai < 2; ++ai) {
                u32x4 xv[4][2];
#pragma unroll
                for (int m = 0; m < 4; ++m)
#pragma unroll
                    for (int bj = 0; bj < 2; ++bj) xv[m][bj] = *(const GAS u32x4*)(ob + (lo + (unsigned)((ai * 128 + m * 16) * 1024 + bj * 128)) * 2u);
#pragma unroll
                for (int m = 0; m < 4; ++m)
#pragma unroll
                    for (int bj = 0; bj < 2; ++bj) { const u32x4 x4 = xv[m][bj]; f32x4 v0 = acc[ai][bj][m][0], v1 = acc[ai][bj][m][1];
                        v0[0] += lo_bf(x4.x); v0[1] += hi_bf(x4.x); v0[2] += lo_bf(x4.y); v0[3] += hi_bf(x4.y); v1[0] += lo_bf(x4.z); v1[1] += hi_bf(x4.z); v1[2] += lo_bf(x4.w); v1[3] += hi_bf(x4.w);
                        *(GAS u32x4*)(ob + (lo + (unsigned)((ai * 128 + m * 16) * 1024 + bj * 128)) * 2u) = pack8(v0, v1); }
                __builtin_amdgcn_sched_barrier(0); }
        }
    }
};
struct EpiM2 {
    static constexpr bool CARRY = false;
    bf16* hmid;
    DI void operator()(const f32x4 (&acc)[2][2][4][2], const Unit& u, int wr, int wc, int fr, int fq) const {
        const int row0 = u.pm * 256 + wr * 64 + fr; const int col = u.pn * 128 + wc * 32 + 8 * fq;
#pragma unroll
        for (int ai = 0; ai < 2; ++ai)
#pragma unroll
            for (int m = 0; m < 4; ++m) { f32x4 h0, h1;
#pragma unroll
                for (int e = 0; e < 4; ++e) { const float g0 = acc[ai][0][m][0][e], g1 = acc[ai][0][m][1][e];
                    h0[e] = g0 * sigmoidf_(g0) * acc[ai][1][m][0][e]; h1[e] = g1 * sigmoidf_(g1) * acc[ai][1][m][1][e]; }
                *(u32x4*)(hmid + (size_t)(row0 + ai * 128 + m * 16) * 256 + col) = pack8(h0, h1); }
    }
};
struct EpiM3 {
    static constexpr bool CARRY = false;
    bf16* eo; const int* rowtok; const float* roww; const LAS int* offt;
    DI void operator()(const f32x4 (&acc)[2][2][4][2], const Unit& u, int wr, int wc, int fr, int fq) const {
        const int e = u.aux; const int cnt = __builtin_amdgcn_readfirstlane(offt[330 + e]);
        const int lr0 = u.pm * 256 - __builtin_amdgcn_readfirstlane(offt[e]) + wr * 64 + fr; const int colt = u.pn * 256 + wc * 32 + 8 * fq;
        int tk[2][4]; float wv[2][4];
#pragma unroll
        for (int ai = 0; ai < 2; ++ai)
#pragma unroll
            for (int m = 0; m < 4; ++m) { const int lr = lr0 + ai * 128 + m * 16; tk[ai][m] = -1; wv[ai][m] = 0.f;
                if (lr < cnt) { tk[ai][m] = ((const GAS int*)rowtok)[e * 32768 + lr]; wv[ai][m] = ((const GAS float*)roww)[e * 32768 + lr]; } }
#pragma unroll
        for (int ai = 0; ai < 2; ++ai)
#pragma unroll
            for (int m = 0; m < 4; ++m) {
                if (tk[ai][m] >= 0) { const float w = wv[ai][m]; GAS bf16* op = (GAS bf16*)eo + (size_t)tk[ai][m] * 1024 + colt;
#pragma unroll
                    for (int bj = 0; bj < 2; ++bj) *(GAS u32x4*)(op + bj * 128) = pack8(acc[ai][bj][m][0] * w, acc[ai][bj][m][1] * w); }
                __builtin_amdgcn_sched_barrier(0); }
    }
};

struct Args { const float* in[36]; float* out; unsigned char* ws; int ph_lo, ph_hi; };
struct InTab { unsigned base;
    DI const float* operator[](int i) const { unsigned long long v; const unsigned addr = base + (unsigned)i * 8u;
        asm volatile("ds_read_b64 %0, %1\n\ts_waitcnt lgkmcnt(0)" : "=v"(v) : "v"(addr) : "memory");
        const unsigned lo = __builtin_amdgcn_readfirstlane((unsigned)v), hi = __builtin_amdgcn_readfirstlane((unsigned)(v >> 32));
        return (const float*)(((unsigned long long)hi << 32) | lo); } };
struct KA { InTab in; float* out; unsigned char* ws; };

DI void transpose_item(const float* W_, int ldw, int nvalid, bf16* WT_, int ldt, int k0, int n0, int dst_row0, LAS float* scr, int lane) {
    const GAS float* W = (const GAS float*)W_; GAS bf16* WT = (GAS bf16*)WT_;
    const int nq = 4 * (lane & 7), kr8 = lane >> 3;
    f32x4 v[8];
#pragma unroll
    for (int i = 0; i < 8; ++i) { const int kk = 8 * i + kr8;
        if (n0 + nq + 3 < nvalid) v[i] = *(const GAS f32x4*)(W + (size_t)(k0 + kk) * ldw + n0 + nq);
        else {
#pragma unroll
            for (int e = 0; e < 4; ++e) v[i][e] = (n0 + nq + e < nvalid) ? W[(size_t)(k0 + kk) * ldw + n0 + nq + e] : 0.f; } }
#pragma unroll
    for (int i = 0; i < 8; ++i) { const int kk = 8 * i + kr8;
#pragma unroll
        for (int e = 0; e < 4; ++e) scr[kk * 33 + nq + e] = v[i][e]; }
    LDS_WAIT(); asm volatile("" ::: "memory");
    const int c = lane & 7;
#pragma unroll
    for (int j = 0; j < 4; ++j) { const int n = (lane >> 3) + 8 * j; const LAS float* s = scr + (8 * c) * 33 + n;
        u32x4 o; o.x = pk2(s[0 * 33], s[1 * 33]); o.y = pk2(s[2 * 33], s[3 * 33]); o.z = pk2(s[4 * 33], s[5 * 33]); o.w = pk2(s[6 * 33], s[7 * 33]);
        if (n0 + n < nvalid) *(GAS u32x4*)(WT + (size_t)(dst_row0 + n) * ldt + k0 + 8 * c) = o; }
    LDS_WAIT(); asm volatile("" ::: "memory");
}
DI void phase0_weights(const KA& a, int l, LAS unsigned char* lds, int gw, int NGW, int wave, int lane) {
    LAS float* scr = (LAS float*)(lds + wave * 16384);
    const float* w_in = a.in[4] + (size_t)l * 1024 * NIN;
    const float* w_gate = a.in[24] + (size_t)l * 4 * 1024 * 1024;
    const float* w_br = a.in[26] + (size_t)l * 4 * 256 * 1024;
    const float* w_out = a.in[27] + (size_t)l * 1024 * 1024;
    bf16* Wt_in = (bf16*)(a.ws + WS_WIN); bf16* Wt_br = (bf16*)(a.ws + WS_WBR); bf16* Wt_out = (bf16*)(a.ws + WS_WOUT);
    constexpr int I_B = 4 * 4 * 32, I_O = 16 * 32, NIT = I_B + I_O;
    (void)w_gate; (void)w_in; (void)Wt_in;
    for (int it = gw; it < NIT; it += NGW) {
        int r = it;
        if (r < I_B) { const int br = r / 128, q = r % 128, kb = q / 32, nb = q % 32; transpose_item(w_br + (size_t)br * 256 * 1024, 1024, 1024, Wt_br + (size_t)br * 1024 * 256, 256, kb * 64, nb * 32, nb * 32, scr, lane); continue; } r -= I_B;
        { const int kb = r / 32, nb = r % 32; transpose_item(w_out, 1024, 1024, Wt_out, 1024, kb * 64, nb * 32, nb * 32, scr, lane); }
    }
}
DI void p1_weights_i8(const KA& a, int l, LAS unsigned char* lds, int bid, int G, int wave, int lane) {
    LAS float* scr = (LAS float*)(lds + wave * 16384); LAS float* red = (LAS float*)(lds + 7 * 16384 + 12288);
    const GAS float* wgt = (const GAS float*)(a.in[24] + (size_t)l * 4 * 1024 * 1024); const GAS float* win = (const GAS float*)(a.in[4] + (size_t)l * 1024 * NIN);
    GAS unsigned char* Wq = (GAS unsigned char*)(a.ws + WS_WQ); GAS float* wsc = (GAS float*)(a.ws + WS_WSC);
    const int nq = 4 * (lane & 7), kr8 = lane >> 3;
    for (int it = G - 1 - bid; it < 128 + 77; it += G) {
        const bool isg = it < 128; const int br = it >> 5; const int n0 = isg ? (it & 31) * 32 : (it - 128) * 32;
        const int ldw = isg ? 1024 : NIN; const int nval = isg ? 1024 : NIN; const int drow0 = isg ? 2560 + br * 1024 + n0 : n0;
        const bool lok = (n0 + nq) < nval;
        const GAS float* W = (isg ? wgt + (size_t)br * 1024 * 1024 : win) + n0 + nq + (size_t)(128 * wave) * ldw;
        f32x4 v[16];
#pragma unroll
        for (int i = 0; i < 16; ++i) { v[i] = (f32x4){0.f, 0.f, 0.f, 0.f}; if (lok) v[i] = *(const GAS f32x4*)(W + (size_t)(8 * i + kr8) * ldw); }
        f32x4 mx = {0.f, 0.f, 0.f, 0.f};
#pragma unroll
        for (int i = 0; i < 16; ++i) { mx[0] = fmaxf(mx[0], fabsf(v[i][0])); mx[1] = fmaxf(mx[1], fabsf(v[i][1])); mx[2] = fmaxf(mx[2], fabsf(v[i][2])); mx[3] = fmaxf(mx[3], fabsf(v[i][3])); }
#pragma unroll
        for (int e = 0; e < 4; ++e) { float m = mx[e]; m = fmaxf(m, xshfl<8>(m)); m = fmaxf(m, xshfl<16>(m)); m = fmaxf(m, xshfl<32>(m)); mx[e] = m; }
        if (kr8 == 0) {
#pragma unroll
            for (int e = 0; e < 4; ++e) red[wave * 32 + nq + e] = mx[e]; }
        __syncthreads();
#pragma unroll
        for (int e = 0; e < 4; ++e) { float m = red[nq + e];
#pragma unroll
            for (int w = 1; w < 8; ++w) m = fmaxf(m, red[w * 32 + nq + e]);
            mx[e] = fmaxf(m, 1e-20f); }
        if (wave == 0 && kr8 == 0 && lok) *(GAS f32x4*)(wsc + drow0 + nq) = mx * (1.f / 127.f);
        const f32x4 qs = {127.f / mx[0], 127.f / mx[1], 127.f / mx[2], 127.f / mx[3]};
#pragma unroll
        for (int hb = 0; hb < 2; ++hb) {
#pragma unroll
            for (int i = 0; i < 8; ++i) { const int kk = 8 * i + kr8;
#pragma unroll
                for (int e = 0; e < 4; ++e) scr[kk * 33 + nq + e] = __builtin_rintf(v[8 * hb + i][e] * qs[e]); }
            LDS_WAIT(); asm volatile("" ::: "memory");
            const int n = lane >> 1, kh = lane & 1; u32x4 o[2];
#pragma unroll
            for (int h2 = 0; h2 < 2; ++h2) { unsigned w4[4];
#pragma unroll
                for (int d = 0; d < 4; ++d) { unsigned wv = 0u;
#pragma unroll
                    for (int e = 0; e < 4; ++e) wv |= ((unsigned)(int)scr[(32 * kh + 16 * h2 + 4 * d + e) * 33 + n] & 255u) << (8 * e);
                    w4[d] = wv; }
                o[h2].x = w4[0]; o[h2].y = w4[1]; o[h2].z = w4[2]; o[h2].w = w4[3]; }
            if (n0 + n < nval) { GAS unsigned char* dst = Wq + (size_t)(drow0 + n) * 1024 + 128 * wave + 64 * hb + 32 * kh; *(GAS u32x4*)dst = o[0]; *(GAS u32x4*)(dst + 16) = o[1]; }
            LDS_WAIT(); asm volatile("" ::: "memory");
        }
        __syncthreads();
    }
}

DI void router_weights(const KA& a, int l, int gw, int NGW, int lane) {
    bf16* Wr = (bf16*)(a.ws + WS_WR);
    const float* wg = a.in[29] + (size_t)l * 1024 * 4; const float* we = a.in[31] + (size_t)l * 1024 * 32;
    for (int n = gw; n < 36; n += NGW) {
        for (int i = 0; i < 16; ++i) { const int k = lane + 64 * i; const float w = (n < 4) ? wg[k * 4 + n] : we[k * 32 + (n - 4)];
            const unsigned hi = f2bf(w); const float hf = __builtin_bit_cast(float, hi << 16); const unsigned lo = f2bf(w - hf);
            Wr[(size_t)n * 2048 + k] = (bf16)hi; Wr[(size_t)n * 2048 + 1024 + k] = (bf16)hi; Wr[(size_t)(64 + n) * 2048 + k] = (bf16)lo; Wr[(size_t)(64 + n) * 2048 + 1024 + k] = 0; }
    }
}

DI void cmp_weights(const KA& a, int l, LAS unsigned char* lds, int gw, int NGW, int wave, int lane) {
    LAS float* scr = (LAS float*)(lds + wave * 16384);
    bf16* Wc = (bf16*)(a.ws + WS_WCMP); float* pt = (float*)(a.ws + WS_CMPAB + 2 * MiB);
    for (int it = gw; it < 128 + 64; it += NGW) {
        if (it < 128) { const int kv = it >> 6, q = it & 63, kb = q >> 1, nb = q & 1; const float* w1 = a.in[kv ? 22 : 19] + (size_t)l * 2048 * 64;
            bf16* dst = Wc + (size_t)kv * 256 * 1024 - (kb >= 16 ? 1024 : 0);
            transpose_item(w1, 64, 64, dst, 1024, kb * 64, nb * 32, (kb >= 16 ? 64 : 0) + nb * 32, scr, lane);
        } else { const int kv = (it - 128) >> 5, part = (it - 128) & 31;
            const GAS float* w1 = (const GAS float*)(a.in[kv ? 22 : 19] + (size_t)l * 2048 * 64) + (size_t)part * 64 * 64; const GAS float* pos = (const GAS float*)(a.in[kv ? 21 : 18] + (size_t)l * 2048) + part * 64;
            float acc = 0.f;
#pragma unroll 16
            for (int k = 0; k < 64; ++k) acc += pos[k] * w1[(size_t)k * 64 + lane];
            pt[(kv * 32 + part) * 64 + lane] = acc; }
    }
}

DI void lru_weights(const KA& a, int l, int gw, int NGW, int lane) {
    bf16* W = (bf16*)(a.ws + WS_LRUW); const float* wa = a.in[7] + (size_t)l * 4 * 4096; const float* wx = a.in[9] + (size_t)l * 4 * 4096;
    (void)NGW; { const int idx = gw * 64 + lane; if (idx < 32768) { const int i = idx & 63, j = (idx >> 6) & 63, mat = (idx >> 12) & 1, hbk = idx >> 13;
        W[idx] = (bf16)f2bf((mat ? wx : wa)[(size_t)hbk * 4096 + i * 64 + j]); } }
}
DI void phase0_rows(const KA& a, int l, int mode, int gw, int NGW, int lane) {
    const GAS float* xin = (const GAS float*)a.in[0]; GAS bf16* xb = (GAS bf16*)(a.ws + WS_XB);
    const GAS bf16* eo = (const GAS bf16*)(a.ws + WS_PROJ);
    GAS float* outp = (GAS float*)a.out;
    const GAS float* g = (const GAS float*)(mode ? a.in[2] : (a.in[3] + (size_t)l * 1024));
    f32x4 gv[4];
#pragma unroll
    for (int j = 0; j < 4; ++j) gv[j] = *(const GAS f32x4*)(g + 4 * (lane + 64 * j));
    for (int m0 = gw * 4; m0 < T; m0 += NGW * 4) {
        f32x4 v[4][4]; float ss[4];
#pragma unroll
        for (int rr = 0; rr < 4; ++rr)
#pragma unroll
            for (int j = 0; j < 4; ++j) { if (l == 0) v[rr][j] = *(const GAS f32x4*)(xin + (size_t)(m0 + rr) * 1024 + 4 * (lane + 64 * j));
                else { const u32x2 xw = *(const GAS u32x2*)(xb + (size_t)(m0 + rr) * 1024 + 4 * (lane + 64 * j)); v[rr][j][0] = lo_bf(xw.x); v[rr][j][1] = hi_bf(xw.x); v[rr][j][2] = lo_bf(xw.y); v[rr][j][3] = hi_bf(xw.y); } }
        if (l > 0) {
#pragma unroll
            for (int rr = 0; rr < 4; ++rr)
#pragma unroll
                for (int j = 0; j < 4; ++j) {
                    const u32x2 e0 = *(const GAS u32x2*)(eo + (size_t)(2 * (m0 + rr)) * 1024 + 4 * (lane + 64 * j));
                    const u32x2 e1 = *(const GAS u32x2*)(eo + (size_t)(2 * (m0 + rr) + 1) * 1024 + 4 * (lane + 64 * j));
                    v[rr][j][0] += lo_bf(e0.x) + lo_bf(e1.x); v[rr][j][1] += hi_bf(e0.x) + hi_bf(e1.x); v[rr][j][2] += lo_bf(e0.y) + lo_bf(e1.y); v[rr][j][3] += hi_bf(e0.y) + hi_bf(e1.y); } }
#pragma unroll
        for (int rr = 0; rr < 4; ++rr) { float t = 0.f;
#pragma unroll
            for (int j = 0; j < 4; ++j) t += (v[rr][j][0] * v[rr][j][0] + v[rr][j][1] * v[rr][j][1]) + (v[rr][j][2] * v[rr][j][2] + v[rr][j][3] * v[rr][j][3]);
            ss[rr] = t; }
#pragma unroll
        for (int rr = 0; rr < 4; ++rr) ss[rr] = wave_sum(ss[rr]);
        if (mode) {
#pragma unroll
            for (int rr = 0; rr < 4; ++rr) { const float r = 1.f / sqrtf(ss[rr] * (1.f / 1024.f) + 1e-6f); const size_t m = (size_t)(m0 + rr);
#pragma unroll
                for (int j = 0; j < 4; ++j) *(GAS f32x4*)(outp + m * 1024 + 4 * (lane + 64 * j)) = v[rr][j] * r * gv[j]; }
        } else {
            GAS unsigned char* hq = (GAS unsigned char*)(a.ws + WS_HQ); GAS float* hsc = (GAS float*)(a.ws + WS_HSC);
            float am[4];
#pragma unroll
            for (int rr = 0; rr < 4; ++rr) { const float r = 1.f / sqrtf(ss[rr] * (1.f / 1024.f) + 1e-6f); const size_t m = (size_t)(m0 + rr); float t = 0.f;
#pragma unroll
                for (int j = 0; j < 4; ++j) { if (l > 0) { u32x2 w; w.x = pk2(v[rr][j][0], v[rr][j][1]); w.y = pk2(v[rr][j][2], v[rr][j][3]); *(GAS u32x2*)(xb + m * 1024 + 4 * (lane + 64 * j)) = w; }
                    const f32x4 y = v[rr][j] * r * gv[j]; v[rr][j] = y;
                    t = fmaxf(t, fmaxf(fmaxf(fabsf(y[0]), fabsf(y[1])), fmaxf(fabsf(y[2]), fabsf(y[3])))); }
                am[rr] = t; }
#pragma unroll
            for (int rr = 0; rr < 4; ++rr) am[rr] = fmaxf(wave_max(am[rr]), 1e-20f);
#pragma unroll
            for (int rr = 0; rr < 4; ++rr) { const size_t m = (size_t)(m0 + rr); const float qs = 127.f / am[rr];
                if (lane == 0) hsc[m] = am[rr] * (1.f / 127.f);
#pragma unroll
                for (int j = 0; j < 4; ++j) { const f32x4 y = v[rr][j] * qs;
                    const unsigned q = ((unsigned)(int)__builtin_rintf(y[0]) & 255u) | (((unsigned)(int)__builtin_rintf(y[1]) & 255u) << 8) | (((unsigned)(int)__builtin_rintf(y[2]) & 255u) << 16) | (((unsigned)(int)__builtin_rintf(y[3]) & 255u) << 24);
                    *(GAS unsigned*)(hq + m * 1024 + 4 * (lane + 64 * j)) = q; } }
        }
    }
}

DI int crow(int i, int hh) { return (i & 3) + 8 * (i >> 2) + 4 * hh; }
DI unsigned cvtpk(float lo, float hi) { f32x2 v = {lo, hi}; bf16x2_t b = __builtin_convertvector(v, bf16x2_t); return __builtin_bit_cast(unsigned, b); }
template <int CTRL, int RMASK> DI float dppf(float oldv, float v) { return __builtin_bit_cast(float, __builtin_amdgcn_update_dpp(__builtin_bit_cast(int, oldv), __builtin_bit_cast(int, v), CTRL, RMASK, 0xf, false)); }
template <int CTRL, int RMASK> DI void scan_step(float& a, float& b) {
    const float ap = dppf<CTRL, RMASK>(1.f, a), bp = dppf<CTRL, RMASK>(0.f, b); b = a * bp + b; a = a * ap; }
DI void lru_unit(const KA& a, int l, const GAS bf16* proj, GAS bf16* ys, GAS float* sums, LAS unsigned char* lds, int task, int lane_in, int wave_in, bool final) {
    int lane = lane_in, wave = wave_in; asm volatile("" : "+v"(lane), "+s"(wave));
    const int chunk = task & 31, hbk = (task >> 5) & 3, b = task >> 7;
    const int ts = chunk * 256 + wave * 32; const size_t rowb = (size_t)b * SEQ;
    LAS unsigned char* wl = lds + wave * 16384;
    LAS float* ex = (LAS float*)(lds + LRUEX_OFF); LAS float* cst = (LAS float*)(lds + LRUCST_OFF); LAS float* car = (LAS float*)(lds + LRUCAR_OFF) + wave * 64;
    const int n = lane & 31, hh = lane >> 5;
    const int c = hbk * 64 + lane;
    const GAS float* cw = (const GAS float*)(a.in[5] + (size_t)l * 4 * 256);
    const float cw0 = cw[c], cw1 = cw[256 + c], cw2 = cw[512 + c], cw3 = cw[768 + c]; const float cb = a.in[6][l * 256 + c];
    const GAS bf16* xp = proj + (rowb + ts) * PLD + C_AX + c;
    unsigned short xraw[35];
#pragma unroll
    for (int j = 0; j < 3; ++j) xraw[j] = (ts >= 3 - j) ? *(const GAS unsigned short*)(xp - (3 - j) * PLD) : (unsigned short)0;
#pragma unroll
    for (int j = 0; j < 32; ++j) xraw[3 + j] = *(const GAS unsigned short*)(xp + (size_t)j * PLD);
    const GAS bf16* wt = (const GAS bf16*)(a.ws + WS_LRUW) + (size_t)hbk * 8192;
    bf16x8 afr[4][4];
#pragma unroll
    for (int m = 0; m < 4; ++m)
#pragma unroll
        for (int s4 = 0; s4 < 4; ++s4) afr[m][s4] = *(const GAS bf16x8*)(wt + (size_t)(m >> 1) * 4096 + (32 * (m & 1) + n) * 64 + 8 * hh + 16 * s4);
    f32x2 sv[31]; u32x2 gt2[2][4];
    const GAS bf16* gp = proj + (rowb + ts + n) * PLD + C_AG + hbk * 64;
    if (final) {
        const GAS f32x2* sp = (const GAS f32x2*)(sums + ((size_t)((b * 4 + hbk) * 32) * 64 + lane) * 2);
#pragma unroll
        for (int cc = 0; cc < 31; ++cc) { const int ci = cc < chunk ? cc : 0; sv[cc] = sp[(size_t)ci * 64]; }
#pragma unroll
        for (int mm = 0; mm < 2; ++mm)
#pragma unroll
            for (int g4 = 0; g4 < 4; ++g4) gt2[mm][g4] = *(const GAS u32x2*)(gp + 32 * mm + 8 * g4 + 4 * hh);
    }
    {
        if (wave == 0) { cst[lane] = -1.4426950408889634f * a.in[8][l * 256 + c]; cst[64 + lane] = -1.4426950408889634f * a.in[10][l * 256 + c]; cst[128 + lane] = -8.f * 1.4426950408889634f * softplusf_(-a.in[11][l * 256 + c]); }
        float x3 = __builtin_bit_cast(float, (unsigned)xraw[0] << 16), x2 = __builtin_bit_cast(float, (unsigned)xraw[1] << 16), x1 = __builtin_bit_cast(float, (unsigned)xraw[2] << 16);
#pragma unroll
        for (int j = 0; j < 32; ++j) { const float x0 = __builtin_bit_cast(float, (unsigned)xraw[3 + j] << 16); const float xc = cb + cw0 * x3 + cw1 * x2 + cw2 * x1 + cw3 * x0;
            *(LAS bf16*)(wl + j * 144 + lane * 2) = (bf16)f2bf(xc); *(LAS float*)(wl + 4608 + j * 272 + lane * 4) = xc; x3 = x2; x2 = x1; x1 = x0; }
    }
    f32x16 D[4];
    {
        bf16x8 bfr[4];
        LDS_WAIT();
#pragma unroll
        for (int s4 = 0; s4 < 4; ++s4) bfr[s4] = *(const LAS bf16x8*)(wl + n * 144 + hh * 16 + s4 * 32);
#pragma unroll
        for (int m = 0; m < 4; ++m) {
#pragma unroll
            for (int s4 = 0; s4 < 4; ++s4) {
                if (s4 == 0) { f32x16 z;
#pragma unroll
                    for (int i = 0; i < 16; ++i) z[i] = 0.f;
                    D[m] = MFMA32(afr[m][s4], bfr[s4], z); } else D[m] = MFMA32(afr[m][s4], bfr[s4], D[m]); } }
    }
    __syncthreads();
    const bool t0 = (ts + n) == 0;
#pragma unroll
    for (int mm = 0; mm < 2; ++mm)
#pragma unroll
        for (int g4 = 0; g4 < 4; ++g4) { const int c0 = 32 * mm + 8 * g4 + 4 * hh;
            const f32x4 vba = *(const LAS f32x4*)(cst + c0), vbx = *(const LAS f32x4*)(cst + 64 + c0), vc8 = *(const LAS f32x4*)(cst + 128 + c0);
            const f32x4 vxc = *(const LAS f32x4*)(wl + 4608 + n * 272 + c0 * 4);
#pragma unroll
            for (int e = 0; e < 4; ++e) { const int i = 4 * g4 + e;
                const float r = __builtin_amdgcn_rcpf(1.f + __builtin_amdgcn_exp2f(D[mm][i] * -1.4426950408889634f + vba[e]));
                const float ig = __builtin_amdgcn_rcpf(1.f + __builtin_amdgcn_exp2f(D[2 + mm][i] * -1.4426950408889634f + vbx[e]));
                const float av = __builtin_amdgcn_exp2f(vc8[e] * r);
                const float mult = t0 ? 1.f : __builtin_amdgcn_sqrtf(fmaxf(1.f - av * av, 0.f));
                float aa = av, bb = mult * ig * vxc[e];
                scan_step<0x111, 0xf>(aa, bb); scan_step<0x112, 0xf>(aa, bb); scan_step<0x114, 0xf>(aa, bb); scan_step<0x118, 0xf>(aa, bb); scan_step<0x142, 0xa>(aa, bb);
                D[mm][i] = aa; D[2 + mm][i] = bb; } }
    if (n == 31) {
#pragma unroll
        for (int mm = 0; mm < 2; ++mm)
#pragma unroll
            for (int i = 0; i < 16; ++i) { const int c = 32 * mm + crow(i, hh); ex[(wave * 64 + c) * 2] = D[mm][i]; ex[(wave * 64 + c) * 2 + 1] = D[2 + mm][i]; } }
    __syncthreads();
    if (!final) {
        if (wave == 0) { float hv = 0.f, av = 1.f;
#pragma unroll
            for (int w = 0; w < 8; ++w) { const float A_ = ex[(w * 64 + lane) * 2], H_ = ex[(w * 64 + lane) * 2 + 1]; hv = A_ * hv + H_; av *= A_; }
            GAS float* sp = sums + ((size_t)((b * 4 + hbk) * 32 + chunk) * 64 + lane) * 2; sp[0] = av; sp[1] = hv; }
    } else {
        {   float hv = 0.f;
#pragma unroll
            for (int cc = 0; cc < 31; ++cc) { const float A_ = cc < chunk ? sv[cc][0] : 1.f, H_ = cc < chunk ? sv[cc][1] : 0.f; hv = A_ * hv + H_; }
            for (int w = 0; w < wave; ++w) { const float A_ = ex[(w * 64 + lane) * 2], H_ = ex[(w * 64 + lane) * 2 + 1]; hv = A_ * hv + H_; }
            car[lane] = hv; }
        LDS_WAIT(); asm volatile("" ::: "memory");
        GAS bf16* yp = ys + (rowb + ts + n) * 1024 + hbk * 64;
#pragma unroll
        for (int mm = 0; mm < 2; ++mm)
#pragma unroll
            for (int g4 = 0; g4 < 4; ++g4) { const int c0 = 32 * mm + 8 * g4 + 4 * hh; const f32x4 cv = *(const LAS f32x4*)(car + c0);
                const u32x2 gw2 = gt2[mm][g4]; float y[4];
#pragma unroll
                for (int e = 0; e < 4; ++e) { const int i = 4 * g4 + e; const float hv = D[2 + mm][i] + D[mm][i] * cv[e];
                    const float gt = (e == 0) ? lo_bf(gw2.x) : (e == 1) ? hi_bf(gw2.x) : (e == 2) ? lo_bf(gw2.y) : hi_bf(gw2.y); const float wv = gt * (2.302208198f + 0.102943240f * gt * gt);
                    y[e] = hv * (gt - gt * __builtin_amdgcn_rcpf(__builtin_amdgcn_exp2f(wv) + 1.f)); }
                u32x2 yo; yo.x = cvtpk(y[0], y[1]); yo.y = cvtpk(y[2], y[3]); *(GAS u32x2*)(yp + c0) = yo; }
    }
    __syncthreads();
}

constexpr int DK_STR = 144, DV_STR = 192, DBUF_BYTES = 64 * DK_STR + 64 * DV_STR;
DI bf16x8 pack_half(const f32x16& x, int s2) { u32x4 p;
    if (s2 == 0) { p.x = cvtpk(x[0], x[1]); p.y = cvtpk(x[2], x[3]); p.z = cvtpk(x[4], x[5]); p.w = cvtpk(x[6], x[7]); }
    else { p.x = cvtpk(x[8], x[9]); p.y = cvtpk(x[10], x[11]); p.z = cvtpk(x[12], x[13]); p.w = cvtpk(x[14], x[15]); }
    return __builtin_bit_cast(bf16x8, p); }
DI s16x4 vtr(const LAS unsigned char* p) { return __builtin_bit_cast(s16x4, __builtin_amdgcn_ds_read_tr16_b64_v4i16((LAS v4i16_t*)p)); }
DI float max16(const f32x16& x) { float a = fmaxf(fmaxf(x[0], x[1]), fmaxf(x[2], x[3])), b = fmaxf(fmaxf(x[4], x[5]), fmaxf(x[6], x[7])), c = fmaxf(fmaxf(x[8], x[9]), fmaxf(x[10], x[11])), d = fmaxf(fmaxf(x[12], x[13]), fmaxf(x[14], x[15])); return fmaxf(fmaxf(a, b), fmaxf(c, d)); }
DI void diff_unit(const GAS bf16* proj, GAS bf16* ys, LAS unsigned char* lds, const LAS float* bias2, const GAS float* subg, const LAS float* lamp, int b, int h, int qb, int wave_in) {
    int wave = wave_in; asm volatile("" : "+s"(wave)); const int lane = my_lane(); const int tid = wave * 64 + lane;
    const int q0 = qb * 256 + wave * 32; const int ql = lane & 31, hh = lane >> 5; const int q = q0 + ql;
    const size_t rowb = (size_t)b * SEQ;
    const float SC = 0.17677669529663687f * 1.4426950408889634f;
    bf16x8 qf[2][2];
    { const GAS bf16* qp = proj + (rowb + q) * PLD + C_CQ + h * 64 + hh * 8;
#pragma unroll
      for (int m = 0; m < 2; ++m)
#pragma unroll
        for (int s = 0; s < 2; ++s) { const u32x4 w = *(const GAS u32x4*)(qp + m * 32 + s * 16); u32x4 o;
            o.x = cvtpk(lo_bf(w.x) * SC, hi_bf(w.x) * SC); o.y = cvtpk(lo_bf(w.y) * SC, hi_bf(w.y) * SC); o.z = cvtpk(lo_bf(w.z) * SC, hi_bf(w.z) * SC); o.w = cvtpk(lo_bf(w.w) * SC, hi_bf(w.w) * SC);
            qf[m][s] = __builtin_bit_cast(bf16x8, o); } }
    f32x16 O[2][2], negm[2];
#pragma unroll
    for (int i = 0; i < 16; ++i) { O[0][0][i] = 0.f; O[0][1][i] = 0.f; O[1][0][i] = 0.f; O[1][1][i] = 0.f; negm[0][i] = 120.f; negm[1][i] = 120.f; }
    float lsum[2] = {0.f, 0.f};
    const int nsteps = 4 * qb + 4, mysteps = 4 * qb + (wave >> 1) + 1;
    const int skey = tid >> 3, sch = tid & 7;
    const GAS unsigned char* kgb = (const GAS unsigned char*)(proj + rowb * PLD + C_CK + h * 64);
    const GAS unsigned char* vgb = (const GAS unsigned char*)(proj + rowb * PLD + C_CV + h * 64);
    const unsigned soff = (unsigned)(skey * PLD + sch * 8) * 2u;
    u32x4 kr = *(const GAS u32x4*)(kgb + soff), vr = *(const GAS u32x4*)(vgb + soff);
    *(LAS u32x4*)(lds + skey * DK_STR + sch * 16) = kr; *(LAS u32x4*)(lds + 64 * DK_STR + skey * DV_STR + sch * 16) = vr;
    __syncthreads();
    const int i16 = lane & 15, blk = (lane >> 4) & 1;
    const int kboff = ql * DK_STR + hh * 16;
    const int vboff = 64 * DK_STR + (4 * hh + (i16 >> 2)) * DV_STR + (16 * blk + 4 * (i16 & 3)) * 2;
#pragma unroll 1
    for (int kt = 0; kt < nsteps; ++kt) {
        const LAS unsigned char* cur = lds + (kt & 1) * DBUF_BYTES; LAS unsigned char* nxt = lds + ((kt + 1) & 1) * DBUF_BYTES;
        if (kt + 1 < nsteps) { const unsigned so = soff + (unsigned)(kt + 1) * (64u * PLD * 2u); kr = *(const GAS u32x4*)(kgb + so); vr = *(const GAS u32x4*)(vgb + so); }
        if (kt < mysteps) {
            const int kbase = kt * 64;
            const bool near = (q0 - (kbase + 63) < 113);
#pragma unroll
            for (int m = 0; m < 2; ++m) {
                bf16x8 pk[2][2];
                f32x16 S[2]; float ts = 0.f;
                {   bf16x8 kf[2][2];
#pragma unroll
                    for (int t = 0; t < 2; ++t)
#pragma unroll
                        for (int s = 0; s < 2; ++s) kf[t][s] = *(const LAS bf16x8*)(cur + kboff + t * 32 * DK_STR + m * 64 + s * 32);
#pragma unroll
                    for (int t = 0; t < 2; ++t) { S[t] = MFMA32(kf[t][0], qf[m][0], negm[m]); S[t] = MFMA32(kf[t][1], qf[m][1], S[t]); } }
                if (near) {
#pragma unroll
                    for (int t = 0; t < 2; ++t)
#pragma unroll
                        for (int g = 0; g < 2; ++g) { float tb[8];
#pragma unroll
                            for (int j = 0; j < 8; ++j) { const int dist = q - (kbase + 32 * t + crow(8 * g + j, hh)); const int di = dist < 0 ? 0 : (dist < 128 ? dist : 128); tb[j] = bias2[di * 12 + 4 + h]; }
#pragma unroll
                            for (int j = 0; j < 8; ++j) { const int dist = q - (kbase + 32 * t + crow(8 * g + j, hh)); S[t][8 * g + j] += dist >= 0 ? tb[j] : -1e30f; }
                            __builtin_amdgcn_sched_barrier(0); } }
#pragma unroll
                for (int t = 0; t < 2; ++t)
#pragma unroll
                    for (int i = 0; i < 16; ++i) { const float p = __builtin_amdgcn_exp2f(S[t][i]); S[t][i] = p; ts += p; }
                if (__builtin_amdgcn_ballot_w64(!(ts < 1.0e30f)) != 0ull) {
                {   bf16x8 kf[2][2];
#pragma unroll
                        for (int t = 0; t < 2; ++t)
#pragma unroll
                            for (int s = 0; s < 2; ++s) kf[t][s] = *(const LAS bf16x8*)(cur + kboff + t * 32 * DK_STR + m * 64 + s * 32);
#pragma unroll
                        for (int t = 0; t < 2; ++t) { S[t] = MFMA32(kf[t][0], qf[m][0], negm[m]); S[t] = MFMA32(kf[t][1], qf[m][1], S[t]); } }
                    if (near) {
#pragma unroll
                        for (int t = 0; t < 2; ++t)
#pragma unroll
                            for (int g = 0; g < 2; ++g) { float tb[8];
#pragma unroll
                                for (int j = 0; j < 8; ++j) { const int dist = q - (kbase + 32 * t + crow(8 * g + j, hh)); const int di = dist < 0 ? 0 : (dist < 128 ? dist : 128); tb[j] = bias2[di * 12 + 4 + h]; }
#pragma unroll
                                for (int j = 0; j < 8; ++j) { const int dist = q - (kbase + 32 * t + crow(8 * g + j, hh)); S[t][8 * g + j] += dist >= 0 ? tb[j] : -1e30f; }
                                __builtin_amdgcn_sched_barrier(0); } }
                    float tm = fmaxf(max16(S[0]), max16(S[1])); tm = fmaxf(tm, xshfl<32>(tm));
                    const float sh = fmaxf(tm, 0.f); const float al = __builtin_amdgcn_exp2f(-sh);
                    lsum[m] *= al; ts = 0.f;
#pragma unroll
                    for (int i = 0; i < 16; ++i) { O[m][0][i] *= al; O[m][1][i] *= al; negm[m][i] -= sh; }
#pragma unroll
                    for (int t = 0; t < 2; ++t)
#pragma unroll
                        for (int i = 0; i < 16; ++i) { const float p = __builtin_amdgcn_exp2f(S[t][i] - sh); S[t][i] = p; ts += p; }
                }
                lsum[m] += ts;
#pragma unroll
                for (int t = 0; t < 2; ++t) { pk[t][0] = pack_half(S[t], 0); pk[t][1] = pack_half(S[t], 1); }
#pragma unroll
                for (int t = 0; t < 2; ++t)
#pragma unroll
                    for (int s2 = 0; s2 < 2; ++s2)
#pragma unroll
                        for (int db = 0; db < 2; ++db) {
                            const s16x4 lo = vtr(cur + vboff + (32 * t + 16 * s2) * DV_STR + db * 64), hi = vtr(cur + vboff + (32 * t + 16 * s2 + 8) * DV_STR + db * 64);
                            const bf16x8 vf = __builtin_shufflevector(lo, hi, 0, 1, 2, 3, 4, 5, 6, 7);
                            O[m][db] = MFMA32(vf, pk[t][s2], O[m][db]); }
                ;
            }
        }
        if (kt + 1 < nsteps) { *(LAS u32x4*)(nxt + skey * DK_STR + sch * 16) = kr; *(LAS u32x4*)(nxt + 64 * DK_STR + skey * DV_STR + sch * 16) = vr; }
        __syncthreads();
    }
    const float l0 = lsum[0] + xshfl<32>(lsum[0]), l1 = lsum[1] + xshfl<32>(lsum[1]);
    const float lam = lamp[0], lam_init = lamp[1];
    const float i0 = 1.f / fmaxf(l0, 1e-30f), i1 = lam / fmaxf(l1, 1e-30f);
    float ss = 0.f;
#pragma unroll
    for (int db = 0; db < 2; ++db)
#pragma unroll
        for (int i = 0; i < 16; ++i) { const float at = O[0][db][i] * i0 - O[1][db][i] * i1; O[0][db][i] = at; ss += at * at; }
    ss += xshfl<32>(ss);
    const float r = (1.f - lam_init) / sqrtf(ss * (1.f / 64.f) + 1e-5f);
    GAS bf16* op = ys + (rowb + q) * 1024 + 512 + h * 64;
#pragma unroll
    for (int db = 0; db < 2; ++db)
#pragma unroll
        for (int gq = 0; gq < 4; ++gq) { const int d0 = 32 * db + 8 * gq + 4 * hh; const f32x4 sg = *(const GAS f32x4*)(subg + d0);
            u32x2 w; w.x = cvtpk(O[0][db][4 * gq + 0] * r * sg[0], O[0][db][4 * gq + 1] * r * sg[1]); w.y = cvtpk(O[0][db][4 * gq + 2] * r * sg[2], O[0][db][4 * gq + 3] * r * sg[3]);
            *(GAS u32x2*)(op + d0) = w; }
}

struct SchedCmp { const char* proj; const char* wc; int G, c;
    DI bool next(int i, Unit& u) const { const int L = i * G + c; if (L >= 16) return false; const int kv = L >> 3, rt = L & 7;
        u.pm = rt; u.pn = 0; u.aux = kv; u.pad = 0; u.a = proj + ((size_t)rt * 256 * 16 * PLD + (kv ? C_VC : C_KC)) * 2; u.b = wc + (size_t)kv * 256 * 1024 * 2; return true; } };
struct EpiCmp { static constexpr bool CARRY = false; float* ab;
    DI void operator()(const f32x4 (&acc)[2][2][4][2], const Unit& u, int wr, int wc, int fr, int fq) const {
        const int row0 = u.pm * 256 + wr * 64 + fr; const int col = wc * 32 + 8 * fq;
#pragma unroll
        for (int ai = 0; ai < 2; ++ai)
#pragma unroll
            for (int m = 0; m < 4; ++m) { float* rp = ab + ((size_t)u.aux * 2048 + row0 + ai * 128 + m * 16) * 128 + col; *(f32x4*)rp = acc[ai][0][m][0]; *(f32x4*)(rp + 4) = acc[ai][0][m][1]; }
    }
};
DI void cmp_finish(const KA& a, int l, const float* ab, bf16* kcb, int task, int lane) {
    const int kv = task / (BATCH * NCMP), r = task % (BATCH * NCMP), b = r / NCMP, c = r % NCMP;
    const float* w2 = a.in[kv ? 23 : 20] + (size_t)l * 4096; const float* pt = ab + 2 * 2048 * 128;
    const size_t g = (size_t)kv * 2048 + b * 512 + c;
    float ptv = 0.f;
#pragma unroll
    for (int part = 0; part < 32; ++part) ptv += pt[(kv * 32 + part) * 64 + lane];
    const float h1 = ab[g * 128 + lane] + ab[(g + 1) * 128 + 64 + lane] + ptv;
    const float gl = gelu_tanh(h1); float o = 0.f;
#pragma unroll
    for (int j = 0; j < 64; ++j) o += rl(gl, j) * w2[j * 64 + lane];
    kcb[((size_t)(kv * BATCH + b) * 512 + c) * 64 + lane] = (bf16)f2bf(o);
    if (c == NCMP - 1) kcb[((size_t)(kv * BATCH + b) * 512 + NCMP) * 64 + lane] = 0;
}

DI void cmp_block(const KA& a, int l, const GAS bf16* proj, const GAS bf16* wcT, float* ab, bf16* kcb, int bid, int wave, int lane) {
    const int kv = bid >> 7, g0 = (bid & 127) * 16, r = lane & 15, q = lane >> 4, sh = wave >> 2;
    const int grow = g0 + r + sh; const bool st_ok = !(sh != 0 && (grow & 511) == 0);
    const int gld = grow > 2047 ? 2047 : grow;
    const GAS bf16* apn = proj + (size_t)gld * 16 * PLD + (kv ? C_VC : C_KC) + 8 * q;
    const GAS bf16* bpn = wcT + ((size_t)kv * 256 + wave * 16 + r) * 1024 + 8 * q;
    f32x4 acc = {0.f, 0.f, 0.f, 0.f};
#pragma unroll 16
    for (int s = 0; s < 32; ++s) {
        const bf16x8 av = *(const GAS bf16x8*)(apn + (size_t)(s >> 1) * PLD + 32 * (s & 1));
        const bf16x8 bv = *(const GAS bf16x8*)(bpn + 32 * s);
        acc = __builtin_amdgcn_mfma_f32_16x16x32_bf16(bv, av, acc, 0, 0, 0);
    }
    if (st_ok) *(GAS f32x4*)((GAS float*)ab + ((size_t)kv * 2048 + grow) * 128 + wave * 16 + 4 * q) = acc;
    VM_WAIT(); __syncthreads();
    {   const float* w2 = a.in[kv ? 23 : 20] + (size_t)l * 4096; const float* pt = ab + 2 * 2048 * 128;
        const int ga = g0 + 2 * wave; const size_t gA = (size_t)kv * 2048 + ga;
        float ptp[32], w2v[64], hA[3], hB[3];
#pragma unroll
        for (int part = 0; part < 32; ++part) ptp[part] = pt[(kv * 32 + part) * 64 + lane];
#pragma unroll
        for (int i = 0; i < 2; ++i) { hA[i] = ab[(gA + i) * 128 + lane]; hB[i] = ab[(gA + i + 1) * 128 + 64 + lane]; }
#pragma unroll
        for (int j = 0; j < 64; ++j) w2v[j] = w2[j * 64 + lane];
        float ptv = 0.f;
#pragma unroll
        for (int part = 0; part < 32; ++part) ptv += ptp[part];
#pragma unroll
        for (int i = 0; i < 2; ++i) { const int g = ga + i, c = g & 511, b = g >> 9;
            if (c < NCMP) {
                const float gl = gelu_tanh(hA[i] + hB[i] + ptv); float o = 0.f;
#pragma unroll
                for (int j = 0; j < 64; ++j) o += rl(gl, j) * w2v[j];
                kcb[((size_t)(kv * BATCH + b) * 512 + c) * 64 + lane] = (bf16)f2bf(o);
                if (c == NCMP - 1) kcb[((size_t)(kv * BATCH + b) * 512 + NCMP) * 64 + lane] = 0; } }
    }
}

DI void st_load(const GAS unsigned char* kb, const GAS unsigned char* vb, unsigned off, u32x4& kr, u32x4& vr) { kr = *(const GAS u32x4*)(kb + off); vr = *(const GAS u32x4*)(vb + off); }
DI void st_write(LAS unsigned char* buf, int skey, int sch, const u32x4& kr, const u32x4& vr) { *(LAS u32x4*)(buf + skey * DK_STR + sch * 16) = kr; *(LAS u32x4*)(buf + 64 * DK_STR + skey * DV_STR + sch * 16) = vr; }
DI void qk64(const LAS unsigned char* cur, int kboff, const bf16x8 (&qf)[4], const f32x16& cinit, f32x16 (&S)[2]) {
#pragma unroll
    for (int t = 0; t < 2; ++t) { S[t] = cinit;
#pragma unroll
        for (int s = 0; s < 4; ++s) { const bf16x8 kf = *(const LAS bf16x8*)(cur + kboff + t * 32 * DK_STR + s * 32); S[t] = MFMA32(kf, qf[s], S[t]); } }
}
DI void qk32z(const LAS unsigned char* kt32, const bf16x8 (&qf)[4], f32x16& S) {
#pragma unroll
    for (int s = 0; s < 4; ++s) { const bf16x8 kf = *(const LAS bf16x8*)(kt32 + s * 32);
        if (s == 0) { f32x16 z;
#pragma unroll
            for (int i = 0; i < 16; ++i) z[i] = 0.f;
            S = MFMA32(kf, qf[s], z); } else S = MFMA32(kf, qf[s], S); }
}
DI void pv32(const LAS unsigned char* vt32, const bf16x8 (&pk)[2], f32x16 (&O)[2]) {
#pragma unroll
    for (int s2 = 0; s2 < 2; ++s2)
#pragma unroll
        for (int db = 0; db < 2; ++db) {
            const s16x4 lo = vtr(vt32 + (16 * s2) * DV_STR + db * 64), hi = vtr(vt32 + (16 * s2 + 8) * DV_STR + db * 64);
            const bf16x8 vf = __builtin_shufflevector(lo, hi, 0, 1, 2, 3, 4, 5, 6, 7);
            O[db] = MFMA32(vf, pk[s2], O[db]); }
}
DI void mask_bias_cmp32(f32x16& S, int tcol_in, int cbase, int hh, const LAS float* b2h, float msub) {
    int tcol = tcol_in; asm volatile("" : "+v"(tcol));
#pragma unroll
    for (int g = 0; g < 2; ++g) {
        float bv[8];
#pragma unroll
        for (int j = 0; j < 8; ++j) { const int i = 8 * g + j; const int c = cbase + crow(i, hh); const int dist = tcol - 31 - 16 * c; const int di = dist < 0 ? 0 : (dist < 128 ? dist : 128); bv[j] = b2h[di * 12]; }
#pragma unroll
        for (int j = 0; j < 8; ++j) { const int i = 8 * g + j; const int c = cbase + crow(i, hh); const int dist = tcol - 31 - 16 * c; const bool ok = dist >= 0 && c < NCMP;
            const float sb = S[i] + (bv[j] - msub); S[i] = ok ? sb : -1e30f; }
        __builtin_amdgcn_sched_barrier(0); }
}
DI void pv64(const LAS unsigned char* cur, int vboff, const bf16x8 (&pk)[2][2], f32x16 (&O)[2]) {
#pragma unroll
    for (int t = 0; t < 2; ++t)
#pragma unroll
        for (int s2 = 0; s2 < 2; ++s2)
#pragma unroll
            for (int db = 0; db < 2; ++db) {
                const s16x4 lo = vtr(cur + vboff + (32 * t + 16 * s2) * DV_STR + db * 64), hi = vtr(cur + vboff + (32 * t + 16 * s2 + 8) * DV_STR + db * 64);
                const bf16x8 vf = __builtin_shufflevector(lo, hi, 0, 1, 2, 3, 4, 5, 6, 7);
                O[db] = MFMA32(vf, pk[t][s2], O[db]); }
}
DI void softmax_step(f32x16 (&S)[2], f32x16 (&O)[2], f32x16& negm, float& lsum, bf16x8 (&pk)[2][2]) {
    float tm = fmaxf(max16(S[0]), max16(S[1]));
    if (__builtin_amdgcn_ballot_w64(tm > 8.f) != 0ull) {
        tm = fmaxf(tm, xshfl<32>(tm)); const float sh = fmaxf(tm, 0.f); const float al = __builtin_amdgcn_exp2f(-sh);
        lsum *= al;
#pragma unroll
        for (int i = 0; i < 16; ++i) { O[0][i] *= al; O[1][i] *= al; negm[i] -= sh; S[0][i] -= sh; S[1][i] -= sh; } }
#pragma unroll
    for (int t = 0; t < 2; ++t) {
#pragma unroll
        for (int i = 0; i < 16; ++i) { const float p = __builtin_amdgcn_exp2f(S[t][i]); S[t][i] = p; lsum += p; }
        pk[t][0] = pack_half(S[t], 0); pk[t][1] = pack_half(S[t], 1); }
}
DI void mask_bias(f32x16 (&S)[2], int tcol_in, int kbase, int hh, int W, bool colsel, const LAS float* b2h) {
    int tcol = tcol_in; asm volatile("" : "+v"(tcol));
#pragma unroll
    for (int t = 0; t < 2; ++t)
#pragma unroll
        for (int g = 0; g < 2; ++g) {
            float bv[8];
#pragma unroll
            for (int j = 0; j < 8; ++j) { const int i = 8 * g + j; const int dist = tcol - (kbase + 32 * t + crow(i, hh)); const int di = dist < 0 ? 0 : (dist < 128 ? dist : 128); bv[j] = b2h[di * 12]; }
#pragma unroll
            for (int j = 0; j < 8; ++j) { const int i = 8 * g + j; const int dist = tcol - (kbase + 32 * t + crow(i, hh)); const bool ok = colsel && dist >= 0 && dist < W;
                const float sb = S[t][i] + bv[j]; S[t][i] = ok ? sb : -1e30f; }
            __builtin_amdgcn_sched_barrier(0); }
}
DI void sel_tile(const LAS unsigned char* cur, int kboff, int vboff, const bf16x8 (&qf)[4], f32x16 (&Os)[2], f32x16& negm, float& lsel, bool near, bool bit, int t, int kbase, int hh, int W, const LAS float* b2h) {
    f32x16 S[2]; qk64(cur, kboff, qf, negm, S);
    if (near) mask_bias(S, t, kbase, hh, W, bit, b2h);
    float ts = 0.f;
#pragma unroll
    for (int tt = 0; tt < 2; ++tt)
#pragma unroll
        for (int i = 0; i < 16; ++i) { const float p = __builtin_amdgcn_exp2f(S[tt][i]); S[tt][i] = p; ts += p; }
    ts = bit ? ts : 0.f;
    if (__builtin_amdgcn_ballot_w64(!(ts < 1.0e30f)) != 0ull) {
        qk64(cur, kboff, qf, negm, S);
        if (near) mask_bias(S, t, kbase, hh, W, bit, b2h);
        float tm = fmaxf(max16(S[0]), max16(S[1])); tm = bit ? tm : -1e30f; tm = fmaxf(tm, xshfl<32>(tm));
        const float sh = fmaxf(tm, 0.f); const float al = __builtin_amdgcn_exp2f(-sh);
        lsel *= al; ts = 0.f;
#pragma unroll
        for (int i = 0; i < 16; ++i) { Os[0][i] *= al; Os[1][i] *= al; negm[i] -= sh; }
#pragma unroll
        for (int tt = 0; tt < 2; ++tt)
#pragma unroll
            for (int i = 0; i < 16; ++i) { const float p = __builtin_amdgcn_exp2f(S[tt][i] - sh); S[tt][i] = p; ts += p; }
        ts = bit ? ts : 0.f;
    }
    lsel += ts;
    const unsigned km = bit ? 0xFFFFFFFFu : 0u; bf16x8 pk[2][2];
#pragma unroll
    for (int tt = 0; tt < 2; ++tt)
#pragma unroll
        for (int hf = 0; hf < 2; ++hf) { u32x4 w = __builtin_bit_cast(u32x4, pack_half(S[tt], hf)); w.x &= km; w.y &= km; w.z &= km; w.w &= km; pk[tt][hf] = __builtin_bit_cast(bf16x8, w); }
    pv64(cur, vboff, pk, Os);
}
DI void nsa_unit(const GAS bf16* proj, GAS bf16* ys, const GAS bf16* kcb, LAS unsigned char* lds, const LAS float* bias2, int b, int u, int tid_in, int lane_in, int wave_in) {
    (void)tid_in; (void)lane_in; int wave = wave_in; asm volatile("" : "+s"(wave)); const int lane = my_lane(); const int tid = wave * 64 + lane;
    const int t0 = u * 64; const int col = lane & 31, hh = lane >> 5, tl = col >> 2, head = col & 3;
    const int t = t0 + wave * 8 + tl; const int tw0 = t0 + wave * 8;
    const size_t rowb = (size_t)b * SEQ;
    const LAS float* b2h = bias2 + 8 + head;
    bf16x8 qf[4];
    { const float SC = 0.125f * 1.4426950408889634f; const GAS bf16* qp = proj + (rowb + t) * PLD + C_DQ + head * 64 + hh * 8;
#pragma unroll
      for (int s = 0; s < 4; ++s) { const u32x4 w = *(const GAS u32x4*)(qp + s * 16); u32x4 o;
          o.x = cvtpk(lo_bf(w.x) * SC, hi_bf(w.x) * SC); o.y = cvtpk(lo_bf(w.y) * SC, hi_bf(w.y) * SC); o.z = cvtpk(lo_bf(w.z) * SC, hi_bf(w.z) * SC); o.w = cvtpk(lo_bf(w.w) * SC, hi_bf(w.w) * SC);
          qf[s] = __builtin_bit_cast(bf16x8, o); } }
    const int skey = tid >> 3, sch = tid & 7;
    const int i16 = lane & 15, blk = (lane >> 4) & 1;
    const int kboff = col * DK_STR + hh * 16;
    const int vboff = 64 * DK_STR + (4 * hh + (i16 >> 2)) * DV_STR + (16 * blk + 4 * (i16 & 3)) * 2;
    u32x4 kr, vr;
    const int ncvm = (4 * u + 3) < NCMP ? (4 * u + 3) : NCMP;
    const int nsc = (ncvm + 63) >> 6;
    const GAS unsigned char* kcp = (const GAS unsigned char*)(kcb + (size_t)(0 * BATCH + b) * 512 * 64);
    const GAS unsigned char* vcp = (const GAS unsigned char*)(kcb + (size_t)(1 * BATCH + b) * 512 * 64);
    const unsigned soffc = (unsigned)(skey * 64 + sch * 8) * 2u;
    float m1 = -120.f, l1 = 0.f;
    st_load(kcp, vcp, soffc, kr, vr); st_write(lds, skey, sch, kr, vr); __syncthreads();
#pragma unroll 1
    for (int kt = 0; kt < nsc; ++kt) {
        const LAS unsigned char* cur = lds + (kt & 1) * DBUF_BYTES; LAS unsigned char* nxt = lds + ((kt + 1) & 1) * DBUF_BYTES;
        if (kt + 1 < nsc) st_load(kcp, vcp, soffc + (unsigned)(kt + 1) * 8192u, kr, vr);
#pragma unroll
        for (int tt = 0; tt < 2; ++tt) { f32x16 S; qk32z(cur + kboff + tt * 32 * DK_STR, qf, S); mask_bias_cmp32(S, t, kt * 64 + tt * 32, hh, b2h, 0.f);
          const float tm = max16(S); const float mn = fmaxf(m1, tm); float acc = 0.f;
#pragma unroll
          for (int i = 0; i < 16; ++i) acc += __builtin_amdgcn_exp2f(S[i] - mn);
          l1 = l1 * __builtin_amdgcn_exp2f(m1 - mn) + acc; m1 = mn; }
        if (kt + 1 < nsc) st_write(nxt, skey, sch, kr, vr);
        __syncthreads();
    }
    float mf, inv;
    { const float mo = xshfl<32>(m1), lo = xshfl<32>(l1); mf = fmaxf(m1, mo); const float lf = l1 * __builtin_amdgcn_exp2f(m1 - mf) + lo * __builtin_amdgcn_exp2f(mo - mf); inv = lf > 0.f ? 1.f / lf : 0.f; }
    f32x16 Oc[2], imp[4];
#pragma unroll
    for (int i = 0; i < 16; ++i) { Oc[0][i] = 0.f; Oc[1][i] = 0.f; imp[0][i] = 0.f; imp[1][i] = 0.f; imp[2][i] = 0.f; imp[3][i] = 0.f; }
    {   st_load(kcp, vcp, soffc, kr, vr); st_write(lds, skey, sch, kr, vr); __syncthreads();
#pragma unroll 1
        for (int kt = 0; kt < nsc; ++kt) {
            const LAS unsigned char* cur = lds + (kt & 1) * DBUF_BYTES; LAS unsigned char* nxt = lds + ((kt + 1) & 1) * DBUF_BYTES;
            if (kt + 1 < nsc) st_load(kcp, vcp, soffc + (unsigned)(kt + 1) * 8192u, kr, vr);
#pragma unroll
            for (int tt = 0; tt < 2; ++tt) {
                f32x16 S; qk32z(cur + kboff + tt * 32 * DK_STR, qf, S); mask_bias_cmp32(S, t, kt * 64 + tt * 32, hh, b2h, mf);
#pragma unroll
                for (int i = 0; i < 16; ++i) S[i] = __builtin_amdgcn_exp2f(S[i]) * inv;
                bf16x8 pk[2]; pk[0] = pack_half(S, 0); pk[1] = pack_half(S, 1);
                pv32(cur + vboff + tt * 32 * DV_STR, pk, Oc);
                const int Tq = (2 * kt + tt) & 3, MB = (2 * kt + tt) >> 2;
#pragma unroll
                for (int s2 = 0; s2 < 2; ++s2) { u32x4 aw; unsigned e[8];
#pragma unroll
                    for (int jj = 0; jj < 8; ++jj) { const int kk = 16 * s2 + 8 * (jj >> 2) + 4 * hh + (jj & 3); const int delta = 32 * Tq + kk - 4 * col;
                        e[jj] = (delta == -1 || delta == 3) ? 0x3F80u : ((unsigned)delta <= 2u ? 0x4000u : 0u); }
                    aw.x = e[0] | (e[1] << 16); aw.y = e[2] | (e[3] << 16); aw.z = e[4] | (e[5] << 16); aw.w = e[6] | (e[7] << 16);
                    const bf16x8 af = __builtin_bit_cast(bf16x8, aw);
                    if (MB == 0) imp[0] = MFMA32(af, pk[s2], imp[0]); else if (MB == 1) imp[1] = MFMA32(af, pk[s2], imp[1]); else if (MB == 2) imp[2] = MFMA32(af, pk[s2], imp[2]); else imp[3] = MFMA32(af, pk[s2], imp[3]); }
                if (Tq == 3 && MB < 3) { u32x4 aw; aw.x = 0u; aw.y = 0u; aw.z = 0u; aw.w = (lane == 32) ? 0x3F800000u : 0u;
                    const bf16x8 af = __builtin_bit_cast(bf16x8, aw);
                    if (MB == 0) imp[1] = MFMA32(af, pk[1], imp[1]); else if (MB == 1) imp[2] = MFMA32(af, pk[1], imp[2]); else imp[3] = MFMA32(af, pk[1], imp[3]); }
            }
            if (kt + 1 < nsc) st_write(nxt, skey, sch, kr, vr);
            __syncthreads();
        }
    }
    unsigned ocp[2][8];
#pragma unroll
    for (int db = 0; db < 2; ++db)
#pragma unroll
        for (int i = 0; i < 8; ++i) ocp[db][i] = cvtpk(Oc[db][2 * i], Oc[db][2 * i + 1]);
    unsigned sm0 = 0u, sm1 = 0u, sm2 = 0u, sm3 = 0u;
    {   const int cur_t = t >> 6; unsigned key[16];
#pragma unroll
        for (int i = 0; i < 16; ++i) {
            float v0 = imp[0][i], v1 = imp[1][i], v2 = imp[2][i], v3 = imp[3][i];
            v0 += xshfl<1>(v0); v0 += xshfl<2>(v0); v1 += xshfl<1>(v1); v1 += xshfl<2>(v1); v2 += xshfl<1>(v2); v2 += xshfl<2>(v2); v3 += xshfl<1>(v3); v3 += xshfl<2>(v3);
            const float val = head == 0 ? v0 : (head == 1 ? v1 : (head == 2 ? v2 : v3));
            const int j = 32 * head + crow(i, hh);
            const bool forced = (j == 0) || (j == cur_t) || (j == cur_t - 1);
            unsigned fx = (unsigned)(fminf(fmaxf(val, 0.f), 31.f) * 1048576.f) + 1u;
            fx = forced ? 0x1FFFFFFu : (j <= cur_t ? fx : 0u);
            key[i] = (fx << 7) | (unsigned)(127 - j); }
#pragma unroll 1
        for (int r = 0; r < 16; ++r) {
            unsigned w = key[0];
#pragma unroll
            for (int i = 1; i < 16; ++i) w = w > key[i] ? w : key[i];
            { unsigned o = (unsigned)xshfl_i<1>((int)w); w = w > o ? w : o; o = (unsigned)xshfl_i<2>((int)w); w = w > o ? w : o; o = (unsigned)xshfl_i<32>((int)w); w = w > o ? w : o; }
            if ((w >> 7) != 0u) { const int j = 127 - (int)(w & 127u); const unsigned bit = 1u << (j & 31); const int jb = j >> 5;
                sm0 |= (jb == 0) ? bit : 0u; sm1 |= (jb == 1) ? bit : 0u; sm2 |= (jb == 2) ? bit : 0u; sm3 |= (jb == 3) ? bit : 0u; }
#pragma unroll
            for (int i = 0; i < 16; ++i) key[i] = (key[i] == w) ? 0u : key[i];
        }
    }
    f32x16 Ow[2]; float lw = 0.f;
#pragma unroll
    for (int i = 0; i < 16; ++i) { Ow[0][i] = 0.f; Ow[1][i] = 0.f; }
    {   f32x16 negm;
#pragma unroll
        for (int i = 0; i < 16; ++i) negm[i] = 120.f;
        const GAS unsigned char* kwp = (const GAS unsigned char*)(proj + rowb * PLD + C_KW); const GAS unsigned char* vwp = (const GAS unsigned char*)(proj + rowb * PLD + C_VW);
        const unsigned soffp = (unsigned)(skey * PLD + sch * 8) * 2u;
        const int s0 = (u < 8) ? 8 - u : 0;
        st_load(kwp, vwp, soffp + (unsigned)(u - 8 + s0) * (64u * PLD * 2u), kr, vr); st_write(lds, skey, sch, kr, vr); __syncthreads();
#pragma unroll 1
        for (int s = s0; s < 9; ++s) {
            const int par = (s - s0) & 1; const LAS unsigned char* cur = lds + par * DBUF_BYTES; LAS unsigned char* nxt = lds + (par ^ 1) * DBUF_BYTES;
            if (s + 1 < 9) st_load(kwp, vwp, soffp + (unsigned)(u - 8 + s + 1) * (64u * PLD * 2u), kr, vr);
            sel_tile(cur, kboff, vboff, qf, Ow, negm, lw, s == 0 || s >= 6, true, t, (u - 8 + s) * 64, hh, 512, b2h);
            if (s + 1 < 9) st_write(nxt, skey, sch, kr, vr);
            __syncthreads();
        }
    }
    unsigned owp[2][8];
#pragma unroll
    for (int db = 0; db < 2; ++db)
#pragma unroll
        for (int i = 0; i < 8; ++i) owp[db][i] = cvtpk(Ow[db][2 * i], Ow[db][2 * i + 1]);
    f32x16 Os[2]; float lsel = 0.f;
#pragma unroll
    for (int i = 0; i < 16; ++i) { Os[0][i] = 0.f; Os[1][i] = 0.f; }
    {   f32x16 negm;
#pragma unroll
        for (int i = 0; i < 16; ++i) negm[i] = 120.f;
        const GAS unsigned char* ksp = (const GAS unsigned char*)(proj + rowb * PLD + C_KS); const GAS unsigned char* vsp = (const GAS unsigned char*)(proj + rowb * PLD + C_VS);
        const unsigned soffp = (unsigned)(skey * PLD + sch * 8) * 2u;
        u32x4 kA, vA, kB, vB;
        st_load(ksp, vsp, soffp, kr, vr); st_write(lds, skey, sch, kr, vr);
        if (u >= 1) st_load(ksp, vsp, soffp + 64u * PLD * 2u, kA, vA);
        __syncthreads();
#define SEL_STEP(J, KX, VX, KY, VY) { const int j_ = (J); \
            const LAS unsigned char* cur = lds + (j_ & 1) * DBUF_BYTES; LAS unsigned char* nxt = lds + ((j_ + 1) & 1) * DBUF_BYTES; \
            if (j_ + 2 <= u) st_load(ksp, vsp, soffp + (unsigned)(j_ + 2) * (64u * PLD * 2u), KY, VY); \
            const int jb = j_ >> 5; const unsigned smw = jb == 0 ? sm0 : (jb == 1 ? sm1 : (jb == 2 ? sm2 : sm3)); \
            const bool bit = ((smw >> (j_ & 31)) & 1u) != 0u; \
            if (__builtin_amdgcn_ballot_w64(bit) != 0ull) sel_tile(cur, kboff, vboff, qf, Os, negm, lsel, 64 * j_ + 63 > tw0 - 113, bit, t, 64 * j_, hh, 1 << 30, b2h); \
            if (j_ + 1 <= u) st_write(nxt, skey, sch, KX, VX); \
            __syncthreads(); }
#pragma unroll 1
        for (int j = 0; j <= u; j += 2) {
            SEL_STEP(j, kA, vA, kB, vB)
            if (j + 1 <= u) SEL_STEP(j + 1, kB, vB, kA, vA)
        }
#undef SEL_STEP
    }
    {   const float lwt = lw + xshfl<32>(lw), lst = lsel + xshfl<32>(lsel);
        const GAS bf16* gp = proj + (rowb + t) * PLD + C_DG + head * 3;
        const float g0 = sigmoidf_(bf2f(gp[0])), g1 = sigmoidf_(bf2f(gp[1])) / fmaxf(lst, 1e-30f), g2 = sigmoidf_(bf2f(gp[2])) / fmaxf(lwt, 1e-30f);
        GAS bf16* op = ys + (rowb + t) * 1024 + 768 + head * 64;
#pragma unroll
        for (int db = 0; db < 2; ++db)
#pragma unroll
            for (int gq = 0; gq < 4; ++gq) { const int d0 = 32 * db + 8 * gq + 4 * hh; float y[4];
#pragma unroll
                for (int e = 0; e < 4; ++e) { const unsigned cw = ocp[db][2 * gq + (e >> 1)], ww = owp[db][2 * gq + (e >> 1)];
                    y[e] = g0 * ((e & 1) ? hi_bf(cw) : lo_bf(cw)) + g1 * Os[db][4 * gq + e] + g2 * ((e & 1) ? hi_bf(ww) : lo_bf(ww)); }
                u32x2 w; w.x = cvtpk(y[0], y[1]); w.y = cvtpk(y[2], y[3]); *(GAS u32x2*)(op + d0) = w; }
    }
}


DI void swa_unit(const GAS bf16* proj, GAS bf16* ys, LAS unsigned char* lds, const LAS float* bias2, const LAS float* biasd, const GAS float* sinks, int b, int u, int tid_in, int lane_in, int wave_in) {
    int tid = tid_in, lane = lane_in, wave = wave_in; asm volatile("" : "+v"(tid), "+v"(lane), "+s"(wave));
    const int t0 = u * 64; const int col = lane & 31, hh = lane >> 5, tl = col >> 1, kv = wave & 1, head = 2 * kv + (col & 1);
    const int t = t0 + (wave >> 1) * 16 + tl;
    const size_t rowb = (size_t)b * SEQ;
    const LAS float* b2h = bias2 + head;
    bf16x8 qf[4];
    { const float SC = 0.125f * 1.4426950408889634f; const GAS bf16* qp = proj + (rowb + t) * PLD + C_BQ + head * 64 + hh * 8;
#pragma unroll
      for (int s = 0; s < 4; ++s) { const u32x4 w = *(const GAS u32x4*)(qp + s * 16); u32x4 o;
          o.x = cvtpk(lo_bf(w.x) * SC, hi_bf(w.x) * SC); o.y = cvtpk(lo_bf(w.y) * SC, hi_bf(w.y) * SC); o.z = cvtpk(lo_bf(w.z) * SC, hi_bf(w.z) * SC); o.w = cvtpk(lo_bf(w.w) * SC, hi_bf(w.w) * SC);
          qf[s] = __builtin_bit_cast(bf16x8, o); } }
    const int skey = tid >> 3, sch = tid & 7;
    const int i16 = lane & 15, blk = (lane >> 4) & 1;
    const int kboff = kv * DBUF_BYTES + col * DK_STR + hh * 16;
    const int vboff = kv * DBUF_BYTES + 64 * DK_STR + (4 * hh + (i16 >> 2)) * DV_STR + (16 * blk + 4 * (i16 & 3)) * 2;
    const GAS unsigned char* kp = (const GAS unsigned char*)(proj + rowb * PLD + C_BK); const GAS unsigned char* vp = (const GAS unsigned char*)(proj + rowb * PLD + C_BV);
    const unsigned soffp = (unsigned)(skey * PLD + sch * 8) * 2u;
    u32x4 k0, v0, k1, v1;
    f32x16 O[2], negm; float lsum = 0.f;
#pragma unroll
    for (int i = 0; i < 16; ++i) { O[0][i] = 0.f; O[1][i] = 0.f; negm[i] = 120.f; }
    const int s0 = (u < 2) ? 2 - u : 0;
    { const unsigned so = soffp + (unsigned)(u - 2 + s0) * (64u * PLD * 2u); st_load(kp, vp, so, k0, v0); st_load(kp + 128, vp + 128, so, k1, v1);
      st_write(lds, skey, sch, k0, v0); st_write(lds + DBUF_BYTES, skey, sch, k1, v1); }
    __syncthreads();
#pragma unroll 1
    for (int s = s0; s < 3; ++s) {
        const int par = (s - s0) & 1; const LAS unsigned char* cur = lds + par * 2 * DBUF_BYTES; LAS unsigned char* nxt = lds + (par ^ 1) * 2 * DBUF_BYTES;
        if (s + 1 < 3) { const unsigned so = soffp + (unsigned)(u - 2 + s + 1) * (64u * PLD * 2u); st_load(kp, vp, so, k0, v0); st_load(kp + 128, vp + 128, so, k1, v1); }
        sel_tile(cur, kboff, vboff, qf, O, negm, lsum, true, true, t, (u - 2 + s) * 64, hh, 128, b2h);
        if (s + 1 < 3) { st_write(nxt, skey, sch, k0, v0); st_write(nxt + DBUF_BYTES, skey, sch, k1, v1); }
        __syncthreads();
    }
    {   const float sinkp = (sinks[head] - biasd[128 * 12 + head]) * 1.4426950408889634f;
        const float lt = lsum + xshfl<32>(lsum) + __builtin_amdgcn_exp2f(sinkp + negm[0]);
        const float inv = 1.f / fmaxf(lt, 1e-30f);
        GAS bf16* op = ys + (rowb + t) * 1024 + 256 + head * 64;
#pragma unroll
        for (int db = 0; db < 2; ++db)
#pragma unroll
            for (int gq = 0; gq < 4; ++gq) { const int d0 = 32 * db + 8 * gq + 4 * hh;
                u32x2 w; w.x = cvtpk(O[db][4 * gq + 0] * inv, O[db][4 * gq + 1] * inv); w.y = cvtpk(O[db][4 * gq + 2] * inv, O[db][4 * gq + 3] * inv); *(GAS u32x2*)(op + d0) = w; }
    }
}

DI void route_rows4(const KA& a, int l, bf16* xr_, int tok0, int lane_) {
    int lane = lane_; asm volatile("" : "+v"(lane));
    const GAS bf16* xrow = (const GAS bf16*)(a.ws + WS_XB) + (size_t)tok0 * 1024; const GAS float* g = (const GAS float*)(a.in[28] + (size_t)l * 1024); GAS bf16* xr = (GAS bf16*)xr_;
    f32x4 v[4][4]; float ss[4]; u32x2 raw[4][4];
#pragma unroll
    for (int rr = 0; rr < 4; ++rr)
#pragma unroll
        for (int j = 0; j < 4; ++j) raw[rr][j] = *(const GAS u32x2*)(xrow + (size_t)rr * 1024 + 4 * (lane + 64 * j));
#pragma unroll
    for (int rr = 0; rr < 4; ++rr)
#pragma unroll
        for (int j = 0; j < 4; ++j) { v[rr][j][0] = lo_bf(raw[rr][j].x); v[rr][j][1] = hi_bf(raw[rr][j].x); v[rr][j][2] = lo_bf(raw[rr][j].y); v[rr][j][3] = hi_bf(raw[rr][j].y); }
#pragma unroll
    for (int rr = 0; rr < 4; ++rr) { float t = 0.f;
#pragma unroll
        for (int j = 0; j < 4; ++j) t += (v[rr][j][0] * v[rr][j][0] + v[rr][j][1] * v[rr][j][1]) + (v[rr][j][2] * v[rr][j][2] + v[rr][j][3] * v[rr][j][3]);
        ss[rr] = t; }
#pragma unroll
    for (int rr = 0; rr < 4; ++rr) ss[rr] = wave_sum(ss[rr]);
#pragma unroll
    for (int j = 0; j < 4; ++j) { const int k0 = 4 * (lane + 64 * j); const f32x4 gv = *(const GAS f32x4*)(g + k0);
#pragma unroll
        for (int rr = 0; rr < 4; ++rr) { const float r = 1.f / sqrtf(ss[rr] * (1.f / 1024.f) + 1e-6f); const f32x4 xn = v[rr][j] * r * gv;
            unsigned hi[4]; float lo[4];
#pragma unroll
            for (int e = 0; e < 4; ++e) { hi[e] = f2bf(xn[e]); lo[e] = xn[e] - __builtin_bit_cast(float, hi[e] << 16); }
            u32x2 wh, wl; wh.x = hi[0] | (hi[1] << 16); wh.y = hi[2] | (hi[3] << 16); wl.x = pk2(lo[0], lo[1]); wl.y = pk2(lo[2], lo[3]);
            *(GAS u32x2*)(xr + (size_t)(tok0 + rr) * 2048 + k0) = wh; *(GAS u32x2*)(xr + (size_t)(tok0 + rr) * 2048 + 1024 + k0) = wl; } }
}
struct SchedRoute { const char* A; const char* B; int pm;
    DI bool next(int i, Unit& u) const { if (i > 0) return false; u.pm = pm; u.pn = 0; u.aux = 0; u.pad = 0; u.a = A + (size_t)pm * 128 * 2048 * 2; u.b = B; return true; } };
struct EpiRoute { static constexpr bool CARRY = false; float* rlog;
    DI void operator()(const f32x4 (&acc)[2][2][4][2], const Unit& u, int wr, int wc, int fr, int fq) const {
        const int row0 = u.pm * 128 + wr * 64 + fr; const int col = wc * 32 + 8 * fq;
#pragma unroll
        for (int m = 0; m < 4; ++m) { float* rp = rlog + (size_t)(row0 + m * 16) * 128 + col; *(f32x4*)rp = acc[0][0][m][0]; *(f32x4*)(rp + 4) = acc[0][0][m][1]; }
    }
};
DI void route_decide(const KA& a, int l, const float* rl_row, int* rec_e, int* rec_slot, float* rec_w, unsigned* cnt, int tok) {
    float lg[36];
    const float* bg = a.in[30] + l * 4; const float* be = a.in[32] + l * 32;
#pragma unroll
    for (int q = 0; q < 9; ++q) { const f32x4 h = *(const f32x4*)(rl_row + 4 * q), lo = *(const f32x4*)(rl_row + 64 + 4 * q);
        lg[4 * q + 0] = h[0] + lo[0]; lg[4 * q + 1] = h[1] + lo[1]; lg[4 * q + 2] = h[2] + lo[2]; lg[4 * q + 3] = h[3] + lo[3]; }
#pragma unroll
    for (int i = 0; i < 4; ++i) lg[i] += bg[i];
#pragma unroll
    for (int i = 0; i < 32; ++i) lg[4 + i] += be[i];
    int gsel = 0; float gm = lg[0];
#pragma unroll
    for (int i = 1; i < 4; ++i) if (lg[i] > gm) { gm = lg[i]; gsel = i; }
    float gs = 0.f;
#pragma unroll
    for (int i = 0; i < 4; ++i) gs += __expf(lg[i] - gm);
    const float gwt = 1.f / gs;
    float v8[8];
#pragma unroll
    for (int i = 0; i < 8; ++i) { float x = lg[4 + i];
#pragma unroll
        for (int gq = 1; gq < 4; ++gq) x = (gsel == gq) ? lg[4 + gq * 8 + i] : x;
        v8[i] = x; }
    int i0 = 0; float m0 = v8[0];
#pragma unroll
    for (int i = 1; i < 8; ++i) if (v8[i] > m0) { m0 = v8[i]; i0 = i; }
    int i1 = -1; float m1 = -3e38f;
#pragma unroll
    for (int i = 0; i < 8; ++i) if (i != i0 && v8[i] > m1) { m1 = v8[i]; i1 = i; }
    if (i1 < 0) i1 = (i0 == 0) ? 1 : 0;
    const float w0 = 1.f / (1.f + __expf(m1 - m0)); const float w1 = 1.f - w0;
    const int e0 = gsel * 8 + i0, e1 = gsel * 8 + i1;
    const unsigned s0 = __hip_atomic_fetch_add(cnt + e0, 1u, __ATOMIC_RELAXED, __HIP_MEMORY_SCOPE_AGENT);
    const unsigned s1 = __hip_atomic_fetch_add(cnt + e1, 1u, __ATOMIC_RELAXED, __HIP_MEMORY_SCOPE_AGENT);
    (void)rec_e; (void)rec_slot; (void)rec_w;
    int* inv_as = (int*)(a.ws + WS_INVAS); float* inv_w = (float*)(a.ws + WS_INVW);
    inv_as[e0 * 32768 + (int)s0] = tok * 2; inv_w[e0 * 32768 + (int)s0] = w0 * gwt; inv_as[e1 * 32768 + (int)s1] = tok * 2 + 1; inv_w[e1 * 32768 + (int)s1] = w1 * gwt;
}
DI void expert_weights(const KA& a, int l, LAS unsigned char* lds, int it0, int it1, int gw, int NGW, int wave, int lane) {
    LAS float* scr = (LAS float*)(lds + wave * 16384);
    const float* wgt = a.in[33] + (size_t)l * 32 * 1024 * 256; const float* wup = a.in[34] + (size_t)l * 32 * 1024 * 256; const float* wdn = a.in[35] + (size_t)l * 32 * 256 * 1024;
    bf16* Wgu = (bf16*)(a.ws + WS_WGU); bf16* Wd = (bf16*)(a.ws + WS_WD);
    constexpr int I_E = 16 * 4, I_D = 4 * 16;
    const int nq = 4 * (lane & 15), kr4 = lane >> 4;
    for (int it = it0 + gw; it < it1; it += NGW) {
        const int e = it / (2 * I_E + I_D); int r = it % (2 * I_E + I_D);
        const GAS float* src; GAS bf16* dst; int ldw, ldt;
        if (r < 2 * I_E) { const int up = r / I_E, q = r % I_E, kb = q / 4, nb = q % 4; const int n0 = nb * 64;
            const int drow = (n0 >> 7) * 256 + up * 128 + (n0 & 127);
            src = (const GAS float*)((up ? wup : wgt) + (size_t)e * 1024 * 256) + (size_t)(kb * 64) * 256 + n0; ldw = 256;
            dst = (GAS bf16*)(Wgu + (size_t)e * 512 * 1024) + (size_t)drow * 1024 + kb * 64; ldt = 1024;
        } else { r -= 2 * I_E; const int kb = r / 16, nb = r % 16;
            src = (const GAS float*)(wdn + (size_t)e * 256 * 1024) + (size_t)(kb * 64) * 1024 + nb * 64; ldw = 1024;
            dst = (GAS bf16*)(Wd + (size_t)e * 1024 * 256) + (size_t)(nb * 64) * 256 + kb * 64; ldt = 256; }
        f32x4 v[16];
#pragma unroll
        for (int i = 0; i < 16; ++i) v[i] = *(const GAS f32x4*)(src + (size_t)(4 * i + kr4) * ldw + nq);
#pragma unroll
        for (int hn = 0; hn < 2; ++hn) {
            if (((lane >> 3) & 1) == hn) {
#pragma unroll
                for (int i = 0; i < 16; ++i) { const int kk = 4 * i + kr4;
#pragma unroll
                    for (int e2 = 0; e2 < 4; ++e2) scr[kk * 33 + (nq & 31) + e2] = v[i][e2]; } }
            LDS_WAIT(); asm volatile("" ::: "memory");
            const int c = lane & 7;
#pragma unroll
            for (int j = 0; j < 4; ++j) { const int n = (lane >> 3) + 8 * j; const LAS float* sp = scr + (8 * c) * 33 + n;
                u32x4 o; o.x = pk2(sp[0 * 33], sp[1 * 33]); o.y = pk2(sp[2 * 33], sp[3 * 33]); o.z = pk2(sp[4 * 33], sp[5 * 33]); o.w = pk2(sp[6 * 33], sp[7 * 33]);
                *(GAS u32x4*)(dst + (size_t)(32 * hn + n) * ldt + 8 * c) = o; }
            LDS_WAIT(); asm volatile("" ::: "memory");
        }
    }
}
DI void build_offsets(const unsigned* cnt, LAS int* offt, int tid) {
    int c = 0;
    if (tid < 32) { c = (int)__hip_atomic_load(cnt + tid, __ATOMIC_RELAXED, __HIP_MEMORY_SCOPE_AGENT); offt[330 + tid] = (c + 255) & ~255; }
    __syncthreads();
    if (tid == 0) { int o = 0;
#pragma unroll
        for (int e = 0; e < 32; ++e) { offt[e] = o; o += offt[330 + e]; } offt[32] = o; }
    __syncthreads();
    if (tid < 32) offt[330 + tid] = c;
    for (int rt = tid; rt < (MOE_ROWS >> 8); rt += 512) { int e = 0; for (int j = 1; j < 32; ++j) e += (offt[j] <= rt * 256) ? 1 : 0; offt[40 + rt] = e; }
    __syncthreads();
}

template <unsigned PM>
__global__ void __launch_bounds__(512, 2) mk_fwd(Args a_) {
    extern __shared__ __attribute__((aligned(16))) unsigned char lds_raw[];
    LAS unsigned char* lds = (LAS unsigned char*)lds_raw;
    const int wave0 = __builtin_amdgcn_readfirstlane((int)threadIdx.x >> 6);
    if (threadIdx.x < 36) ((LAS unsigned long long*)(lds + PTAB_OFF))[threadIdx.x] = (unsigned long long)a_.in[threadIdx.x];
    __syncthreads();
    KA a; a.in.base = (unsigned)(size_t)(lds + PTAB_OFF); a.out = a_.out; a.ws = a_.ws;
    const int G = gridDim.x, bid = blockIdx.x, NGW = G * 8;
#define PHASE_IDS() int wave = wave0; asm volatile("" : "+s"(wave)); const int lane = my_lane(); const int tid_ = wave * 64 + lane, gw = bid * 8 + wave; (void)tid_; (void)gw; \
    const int xb = ((bid & 7) << 5) | (bid >> 3); (void)xb;        \
    KA ap = a; asm volatile("" : "+s"(ap.ws), "+s"(ap.out), "+s"(ap.in.base)); \
    bf16* hb = (bf16*)(ap.ws + WS_HB); bf16* proj = (bf16*)(ap.ws + WS_PROJ); bf16* gates = (bf16*)(ap.ws + WS_GATES); \
    bf16* ys = hb; bf16* x2b = hb; bf16* merged = proj; bf16* eo = proj; \
    bf16* kcb = (bf16*)(ap.ws + WS_KCVC); float* lrusum = (float*)(ap.ws + WS_LRUSUM); \
    int* rec_e = (int*)(ap.ws + WS_REC); int* rec_slot = rec_e + T * 2; float* rec_w = (float*)(rec_slot + T * 2); \
    int* rowtok = (int*)(ap.ws + WS_ROWTOK); float* roww = (float*)(ap.ws + WS_ROWW); \
    bf16* xs = (bf16*)(ap.ws + WS_XS); bf16* hmid = (bf16*)(ap.ws + WS_HMID); unsigned* ctl = (unsigned*)(ap.ws + WS_CTL); \
    (void)hb; (void)proj; (void)gates; (void)ys; (void)x2b; (void)merged; (void)eo; (void)kcb; (void)lrusum; (void)rec_e; (void)rec_slot; (void)rec_w; (void)rowtok; (void)roww; (void)xs; (void)hmid; (void)ctl
    volatile LAS unsigned* MISC = (volatile LAS unsigned*)(lds + MISC_OFF);
    LAS float* biasd = (LAS float*)(lds + BIAS_OFF);
    LAS int* offt = (LAS int*)(lds + OFFT_OFF);
    { PHASE_IDS();
    if (tid_ < 64) MISC[tid_] = 0u;
    for (int i = tid_; i < 129 * 12; i += 512) { const int d = i / 12, hd = i % 12; const int bk = d < 128 ? T5_BUCKET[d] : 31; const float* rb = a.in[1]; biasd[i] = rb[bk * 12 + hd]; ((LAS float*)(lds + BIAS2_OFF))[i] = (rb[bk * 12 + hd] - rb[31 * 12 + hd]) * 1.4426950408889634f; } }
    __syncthreads();
    const int lo = a_.ph_lo, hi = a_.ph_hi;
    XcdBarrier bar; bar.bar = (unsigned*)(a.ws + WS_CTL) + CW_BAR; bar.x = 0; bar.st = nullptr;
    if (hi - lo > 1) { PHASE_IDS(); bar = xcd_barrier_post(ctl + CW_BAR, MISC + 8, tid_ == 0); }
#ifndef SUB_MASK
#define SUB_MASK 0xFFu
#endif
#define SUB(k) ((SUB_MASK >> (k)) & 1u)
#define HASP(k) ((PM >> ((k) % PPL + ((k) >= 2 * PPL ? PPL : 0))) & 1u)
#define IN(k) (HASP(k) && lo <= (k) && (k) < hi)
#define SEAM(k) do { if ((k) + 1 < hi) { const int sl_ = my_lane(); int sw_ = wave0; asm volatile("" : "+s"(sw_)); xcd_barrier(bar, sw_ == 0 && sl_ == 0); } } while (0)
    for (int l = 0; l < DEPTH; ++l) {
        const int pb = l * PPL;
        if (IN(pb + 0)) { PHASE_IDS(); p1_weights_i8(ap, l, lds, bid, G, wave, lane); router_weights(ap, l, gw, NGW, lane); lru_weights(ap, l, gw, NGW, lane); cmp_weights(ap, l, lds, gw, NGW, wave, lane); phase0_weights(ap, l, lds, gw, NGW, wave, lane); phase0_rows(ap, l, 0, gw, NGW, lane); SEAM(pb + 0); }
        if (IN(pb + 1)) {
            PHASE_IDS();
            {   int K1q = 512; asm volatile("" : "+s"(K1q));
                pg8::Gemm g{K1q, 512, 512, 128, -1}; SchedP1 S{(const char*)(ap.ws + WS_HQ), (const char*)(ap.ws + WS_WQ), 128, 26, 1024, 1024, G, bid};
                EpiP1I8 E{proj, (unsigned char*)gates, ap.in[25] + (size_t)l * 4096, (const float*)(ap.ws + WS_HSC), (const float*)(ap.ws + WS_WSC)};
                pg8::gemm_phase<EpiP1I8, SchedP1, false, true>(lds, g, S, E, tid_); }
            SEAM(pb + 1);
        }
        if (IN(pb + 2)) {
            PHASE_IDS();
            LAS float* lamp = (LAS float*)(lds + MISC_OFF + 64);
            if (tid_ < 64) { const float* q1 = ap.in[13] + l * 32; const float* k1 = ap.in[14] + l * 32; const float* q2 = ap.in[15] + l * 32; const float* k2 = ap.in[16] + l * 32;
                float s1 = (lane < 32) ? q1[lane] * k1[lane] : 0.f, s2 = (lane < 32) ? q2[lane] * k2[lane] : 0.f; s1 = wave_sum(s1); s2 = wave_sum(s2);
                const float lam_init = 0.8f - 0.6f * __expf(-0.3f * (float)l); if (lane == 0) { lamp[0] = __expf(s1) - __expf(s2) + lam_init; lamp[1] = lam_init; } }
            __syncthreads();
            if (SUB(0)) { const LAS float* bias2 = (const LAS float*)(lds + BIAS2_OFF); const GAS float* subg = (const GAS float*)(ap.in[17] + l * 64);
                for (int pi = xb; pi < 256; pi += G) { const int bh = pi >> 4, qlo = pi & 15;
                    diff_unit((const GAS bf16*)proj, (GAS bf16*)ys, lds, bias2, subg, lamp, bh >> 2, bh & 3, 31 - qlo, wave);
                    diff_unit((const GAS bf16*)proj, (GAS bf16*)ys, lds, bias2, subg, lamp, bh >> 2, bh & 3, qlo, wave); } }
            { PHASE_IDS();
            if (SUB(3)) { __syncthreads(); const LAS float* bias2 = (const LAS float*)(lds + BIAS2_OFF); const GAS float* sinks = (const GAS float*)(ap.in[12] + l * 4);
                for (int pi = xb; pi < 512; pi += G) swa_unit((const GAS bf16*)proj, (GAS bf16*)ys, lds, bias2, biasd, sinks, pi >> 7, pi & 127, tid_, lane, wave); }
            if (SUB(2)) cmp_block(ap, l, (const GAS bf16*)proj, (const GAS bf16*)(ap.ws + WS_WCMP), (float*)(ap.ws + WS_CMPAB), kcb, bid, wave, lane);
            if (SUB(1)) { __syncthreads(); for (int task = xb; task < 512; task += G) lru_unit(ap, l, (const GAS bf16*)proj, (GAS bf16*)ys, (GAS float*)lrusum, lds, task, lane, wave, false); }
            }
            SEAM(pb + 2);
        }
        if (IN(pb + 4)) {
            PHASE_IDS();
            for (int task = xb; task < 512; task += G) lru_unit(ap, l, (const GAS bf16*)proj, (GAS bf16*)ys, (GAS float*)lrusum, lds, task, lane, wave, true);
            __syncthreads();
            if (SUB(4)) { const LAS float* bias2 = (const LAS float*)(lds + BIAS2_OFF);
                for (int pi = xb; pi < 256; pi += G) { const int bb = pi >> 6, ulo = pi & 63;
                    nsa_unit((const GAS bf16*)proj, (GAS bf16*)ys, (const GAS bf16*)kcb, lds, bias2, bb, 127 - ulo, tid_, lane, wave);
                    nsa_unit((const GAS bf16*)proj, (GAS bf16*)ys, (const GAS bf16*)kcb, lds, bias2, bb, ulo, tid_, lane, wave); } }
            SEAM(pb + 4);
        }
        if (IN(pb + 5)) {
            PHASE_IDS();
            int K5 = 256; asm volatile("" : "+s"(K5));
            pg8::Gemm g{K5, 1024, 256, 128, -1}; SchedP3a S{(const char*)ys, (const char*)(ap.ws + WS_WBR), G, xb};
            EpiP3a E{merged, (const unsigned char*)gates};
            pg8::gemm_phase<EpiP3a, SchedP3a>(lds, g, S, E, tid_); SEAM(pb + 5);
        }
        if (IN(pb + 6)) {
            PHASE_IDS();
            int K6 = 1024; asm volatile("" : "+s"(K6));
            pg8::Gemm g{K6, 1024, 1024, 128, -1}; SchedP3b S{(const char*)merged, (const char*)(ap.ws + WS_WOUT), G, xb};
            if (l == 0) { EpiP3b<true> E{ap.in[0], (bf16*)(ap.ws + WS_XB)}; pg8::gemm_phase<EpiP3b<true>, SchedP3b>(lds, g, S, E, tid_); }
            else { EpiP3b<false> E{nullptr, (bf16*)(ap.ws + WS_XB)}; pg8::gemm_phase<EpiP3b<false>, SchedP3b>(lds, g, S, E, tid_); }
            SEAM(pb + 6);
        }
        if (IN(pb + 7)) {
            PHASE_IDS();
            bf16* xr = (bf16*)(ap.ws + WS_XR); float* rlog = (float*)(ap.ws + WS_RLOG);
            constexpr int NITW = 32 * (2 * 16 * 4 + 4 * 16);
            { const int pm = bid;
                for (int r = wave * 4; r < 128; r += 32) route_rows4(ap, l, xr, pm * 128 + r, lane);
                asm volatile("s_waitcnt vmcnt(0)" ::: "memory"); __syncthreads();
                { pg8::Gemm g{2048, 2048, 2048, 128, 0}; SchedRoute S{(const char*)xr, (const char*)(ap.ws + WS_WR), pm}; EpiRoute E{rlog};
                  pg8::gemm_phase<EpiRoute, SchedRoute>(lds, g, S, E, tid_); }
                asm volatile("s_waitcnt vmcnt(0)" ::: "memory"); __syncthreads();
                if (tid_ < 128) route_decide(ap, l, rlog + (size_t)(pm * 128 + tid_) * 128, rec_e, rec_slot, rec_w, ctl + CW_CNT + l * 32, pm * 128 + tid_);
                __syncthreads();
            }
            expert_weights(ap, l, lds, 0, NITW, gw, NGW, wave, lane);
            SEAM(pb + 7);
        }
        if (IN(pb + 9)) {
            PHASE_IDS();
            build_offsets(ctl + CW_CNT + l * 32, offt, tid_);
            int K9 = 1024; asm volatile("" : "+s"(K9));
            pg8::Gemm g{K9, 2048, 1024, 128, -1}; SchedM2 S{(const char*)(ap.ws + WS_XR), (const char*)(ap.ws + WS_WGU), offt, (const int*)(ap.ws + WS_INVAS), G, xb};
            EpiM2 E{hmid};
            pg8::gemm_phase<EpiM2, SchedM2, true>(lds, g, S, E, tid_); SEAM(pb + 9);
        }
        if (IN(pb + 10)) {
            PHASE_IDS();
            build_offsets(ctl + CW_CNT + l * 32, offt, tid_);
            int K3 = 256; asm volatile("" : "+s"(K3));
            pg8::Gemm g{K3, 256, 256, 128, -1}; SchedM3 S{(const char*)hmid, (const char*)(ap.ws + WS_WD), offt, G, xb};
            EpiM3 E{eo, (const int*)(ap.ws + WS_INVAS), (const float*)(ap.ws + WS_INVW), offt};
            pg8::gemm_phase<EpiM3, SchedM3>(lds, g, S, E, tid_); SEAM(pb + 10);
        }
    }
    if (IN(2 * PPL)) { PHASE_IDS(); phase0_rows(ap, DEPTH, 1, gw, NGW, lane); }
#undef IN
#undef SEAM
}

typedef void (*kern_t)(Args);
template <unsigned PM> static bool setup_kernel() {
    if (hipFuncSetAttribute((const void*)mk_fwd<PM>, hipFuncAttributeMaxDynamicSharedMemorySize, LDS_BYTES) != hipSuccess) { fprintf(stderr, "kernel_launch: hipFuncSetAttribute failed\n"); return false; }
    return true;
}
extern "C" void kernel_launch(void* const* d_in, const int* in_sizes, int n_in, void* d_out, int out_size, void* d_ws, size_t ws_size, hipStream_t stream) {
    static int grid = 0;
    if (grid == 0) {
        if (n_in != 36 || out_size != T * D || ws_size < WS_END) { fprintf(stderr, "kernel_launch: unexpected shapes (n_in %d out %d ws %zu)\n", n_in, out_size, ws_size); grid = -1; return; }
        int dev = 0, cus = 0;
        if (hipGetDevice(&dev) != hipSuccess || hipDeviceGetAttribute(&cus, hipDeviceAttributeMultiprocessorCount, dev) != hipSuccess) { grid = -1; return; }
        bool ok = true;
#if MK_ONE_LAUNCH
        ok = setup_kernel<0xFFFu>();
#endif
        if (!ok) { grid = -1; return; }
        (void)hipGetLastError();
        grid = cus;
        if (grid != 256) { fprintf(stderr, "kernel_launch: built for a 256-CU device (got %d)\n", cus); grid = -1; return; }
    }
    if (grid < 0) return;
    if (hipMemsetAsync((char*)d_ws + WS_CTL, 0, CTL_ZERO_BYTES, stream) != hipSuccess) return;
    Args a{};
    for (int i = 0; i < 36; ++i) a.in[i] = (const float*)d_in[i];
    a.out = (float*)d_out; a.ws = (unsigned char*)d_ws;
#if MK_ONE_LAUNCH
    a.ph_lo = 0; a.ph_hi = NPH;
    hipLaunchKernelGGL(mk_fwd<0xFFFu>, dim3(grid), dim3(512), LDS_BYTES, stream, a);
#endif
}
```

```cpp
#include <hip/hip_runtime.h>
#include <cstdio>
#include <cstdint>

#ifndef MK_ONE_LAUNCH
#define MK_ONE_LAUNCH 1
#endif

#define DI __device__ __forceinline__
#define GAS __attribute__((address_space(1)))
#define LAS __attribute__((address_space(3)))
typedef unsigned short bf16;
typedef short bf16x8 __attribute__((ext_vector_type(8)));
typedef float f32x4 __attribute__((ext_vector_type(4)));
typedef int i32x4 __attribute__((ext_vector_type(4)));
typedef unsigned u32x4 __attribute__((ext_vector_type(4)));
typedef unsigned u32x2 __attribute__((ext_vector_type(2)));
typedef float f32x16 __attribute__((ext_vector_type(16)));
typedef float f32x2 __attribute__((ext_vector_type(2)));
typedef short s16x4 __attribute__((ext_vector_type(4)));
typedef __bf16 bf16x2_t __attribute__((ext_vector_type(2)));
typedef short v4i16_t __attribute__((__vector_size__(4 * sizeof(short))));
#define MFMA32(a, b, c) __builtin_amdgcn_mfma_f32_32x32x16_bf16((a), (b), (c), 0, 0, 0)

constexpr int BATCH = 4, SEQ = 8192, T = BATCH * SEQ, D = 1024, DEPTH = 2;
constexpr int NIN = 2444, PLD = 2560, N1 = 6656, GLD = 4096;
constexpr int C_AX = 0, C_AG = 256, C_BQ = 512, C_BK = 768, C_BV = 896, C_CQ = 1024, C_CK = 1280, C_CV = 1536, C_DQ = 1792,
              C_KC = 2048, C_VC = 2112, C_KS = 2176, C_VS = 2240, C_KW = 2304, C_VW = 2368, C_DG = 2432;
constexpr int NCMP = 511;
constexpr int MOE_ROWS = 73728;
constexpr int PPL = 11;
constexpr int NPH = 2 * PPL + 1;

constexpr size_t MiB = 1u << 20;
constexpr size_t WS_CTL = 0, CTL_ZERO_BYTES = 1 * MiB;
constexpr size_t WS_KCVC = 1 * MiB;
constexpr size_t WS_LRUSUM = 2 * MiB;
constexpr size_t WS_REC = 2 * MiB + 256 * 1024;
constexpr size_t WS_ROWTOK = 3 * MiB;
constexpr size_t WS_ROWW = 3 * MiB + 512 * 1024;
constexpr size_t WS_WIN = 4 * MiB;
constexpr size_t WS_WQ = 4 * MiB;
constexpr size_t WS_WSC = 13 * MiB;
constexpr size_t WS_HSC = 13 * MiB + 65536;
constexpr size_t WS_HQ = 21 * MiB;
constexpr size_t WS_INVAS = 296 * MiB;
constexpr size_t WS_INVW = 300 * MiB;
constexpr size_t WS_XB = 373 * MiB;
constexpr size_t WS_WBR = 17 * MiB;
constexpr size_t WS_WOUT = 19 * MiB;
constexpr size_t WS_HB = 21 * MiB;
constexpr size_t WS_PROJ = 85 * MiB;
constexpr size_t WS_GATES = 245 * MiB;
constexpr size_t WS_WGU = 245 * MiB;
constexpr size_t WS_WD = 277 * MiB;
constexpr size_t WS_XS = 293 * MiB;
constexpr size_t WS_HMID = 437 * MiB;
constexpr size_t WS_XR = 85 * MiB;
constexpr size_t WS_RLOG = 213 * MiB;
constexpr size_t WS_WR = 501 * MiB;
constexpr size_t WS_WCMP = 502 * MiB;
constexpr size_t WS_CMPAB = 503 * MiB;
constexpr size_t WS_LRUW = 505 * MiB + 65536;
constexpr size_t WS_END = 506 * MiB;
constexpr int CW_BAR = 4096;
constexpr int CW_CNT = 16384;

constexpr int RING_BYTES = 131072;
constexpr int MISC_OFF = RING_BYTES;
constexpr int BIAS_OFF = MISC_OFF + 256;
constexpr int OFFT_OFF = BIAS_OFF + 129 * 12 * 4;
constexpr int PTAB_OFF = OFFT_OFF + (40 + 288 + 40) * 4;
constexpr int BIAS2_OFF = PTAB_OFF + 36 * 8;
constexpr int LRUEX_OFF = BIAS2_OFF + 129 * 12 * 4;
constexpr int LDS_BYTES = 163840;
constexpr int LRUCST_OFF = LRUEX_OFF + 8 * 64 * 2 * 4;
constexpr int LRUCAR_OFF = LRUCST_OFF + 3 * 64 * 4;
static_assert(PTAB_OFF % 8 == 0 && LRUCAR_OFF + 8 * 64 * 4 <= LDS_BYTES, "LDS map");

DI float bf2f(bf16 v) { return __builtin_bit_cast(float, (unsigned)v << 16); }
DI float lo_bf(unsigned w) { return __builtin_bit_cast(float, w << 16); }
DI float hi_bf(unsigned w) { return __builtin_bit_cast(float, w & 0xffff0000u); }
DI unsigned f2bf(float f) { unsigned u = __builtin_bit_cast(unsigned, f); return (u + 0x7fffu + ((u >> 16) & 1u)) >> 16; }
typedef __bf16 bf16x2_pk __attribute__((ext_vector_type(2)));
DI unsigned pk2(float lo, float hi) { typedef float f32x2_pk __attribute__((ext_vector_type(2))); f32x2_pk v = {lo, hi}; bf16x2_pk b = __builtin_convertvector(v, bf16x2_pk); return __builtin_bit_cast(unsigned, b); }
DI float rl(float v, int i) { return __builtin_bit_cast(float, __builtin_amdgcn_readlane(__builtin_bit_cast(int, v), i)); }
DI int rli(int v, int i) { return __builtin_amdgcn_readlane(v, i); }
DI int my_lane() { int l; asm volatile("v_mbcnt_lo_u32_b32 %0, -1, 0\n\tv_mbcnt_hi_u32_b32 %0, -1, %0" : "=v"(l)); return l; }
template <int O> DI int xshfl_i(int v) {
    if constexpr (O < 32) return __builtin_amdgcn_ds_swizzle(v, (O << 10) | 0x1f);
    else { const int l = my_lane(); return __builtin_amdgcn_ds_bpermute((l ^ 32) << 2, v); }
}
template <int O> DI float xshfl(float v) { return __builtin_bit_cast(float, xshfl_i<O>(__builtin_bit_cast(int, v))); }
DI float wave_sum(float v) { v += xshfl<1>(v); v += xshfl<2>(v); v += xshfl<4>(v); v += xshfl<8>(v); v += xshfl<16>(v); v += xshfl<32>(v); return v; }
DI float wave_max(float v) { v = fmaxf(v, xshfl<1>(v)); v = fmaxf(v, xshfl<2>(v)); v = fmaxf(v, xshfl<4>(v)); v = fmaxf(v, xshfl<8>(v)); v = fmaxf(v, xshfl<16>(v)); v = fmaxf(v, xshfl<32>(v)); return v; }
DI float sigmoidf_(float x) { return __builtin_amdgcn_rcpf(1.f + __builtin_amdgcn_exp2f(-1.4426950408889634f * x)); }
DI float gelu_tanh(float x) { const float u = 0.7978845608028654f * (x + 0.044715f * x * x * x); const float e = __expf(2.f * u); const float th = 1.f - 2.f * __builtin_amdgcn_rcpf(e + 1.f); return 0.5f * x * (1.f + th); }
DI float softplusf_(float x) { return fmaxf(x, 0.f) + log1pf(__expf(-fabsf(x))); }
#define LDS_WAIT() asm volatile("s_waitcnt lgkmcnt(0)" ::: "memory")
#define VM_WAIT() asm volatile("s_waitcnt vmcnt(0)" ::: "memory")

__device__ const unsigned char T5_BUCKET[128] = {
0,1,2,3,4,5,6,7,8,9,10,11,12,13,14,15,16,16,16,17,17,18,18,18,19,19,19,20,20,20,20,21,21,21,21,22,22,22,22,22,23,23,23,23,23,23,24,24,24,24,24,24,25,25,25,25,25,25,25,26,26,26,26,26,26,26,26,27,27,27,27,27,27,27,27,27,27,28,28,28,28,28,28,28,28,28,28,29,29,29,29,29,29,29,29,29,29,29,29,30,30,30,30,30,30,30,30,30,30,30,30,30,30,31,31,31,31,31,31,31,31,31,31,31,31,31,31,31};

#define XB_TMO      128
#define XB_XCNT(j)  (256  + 64 * (j))
#define XB_XSUB(j)  (1280 + 64 * (j))
#define XB_XGEN(j)  (2304 + 64 * (j))
#define XB_TOP      3328
#define XB_TOPGEN   3392
#define XCD_BAR_WORDS 3456
#define XB_SPIN_CAP (1u << 22)
DI unsigned xb_ld(unsigned* p)              { return __hip_atomic_load(p, __ATOMIC_RELAXED, __HIP_MEMORY_SCOPE_AGENT); }
DI unsigned xb_add(unsigned* p, unsigned v) { return __hip_atomic_fetch_add(p, v, __ATOMIC_RELAXED, __HIP_MEMORY_SCOPE_AGENT); }
DI unsigned xb_xcc_id() { return (unsigned)__builtin_amdgcn_s_getreg((3 << 11) | 20) & 0xFu; }
#define XB_SPIN(cond, bar) do { unsigned _sp = 0; while (cond) { __builtin_amdgcn_s_sleep(1); \
    if ((++_sp & 255u) == 0u) { if (xb_ld(&(bar)[XB_TMO])) break; if (_sp > XB_SPIN_CAP) { atomicAdd(&(bar)[XB_TMO], 1u); break; } } } } while (0)
struct XcdBarrier { unsigned* bar; unsigned x; volatile LAS unsigned* st; };
DI XcdBarrier xcd_barrier_post(unsigned* bar, volatile LAS unsigned* st, bool leader) {
    XcdBarrier b; b.bar = bar; b.x = xb_xcc_id(); b.st = st;
    if (leader) (void)xb_add(&bar[XB_XCNT(b.x)], 1u);
    return b;
}
DI void xcd_barrier_complete(unsigned* bar, unsigned x, unsigned& nloc, unsigned& nx) {
    const unsigned G = gridDim.x * gridDim.y * gridDim.z;
    unsigned sum, cnt, mine, sp = 0u;
    for (;;) {
        sum = 0u; cnt = 0u; mine = 0u;
#pragma unroll
        for (unsigned j = 0; j < 16; ++j) { const unsigned c = xb_ld(&bar[XB_XCNT(j)]); sum += c; cnt += (c > 0u) ? 1u : 0u; mine = (j == x) ? c : mine; }
        if (sum == G) break;
        __builtin_amdgcn_s_sleep(1);
        if ((++sp & 255u) == 0u) { if (xb_ld(&bar[XB_TMO])) break; if (sp > XB_SPIN_CAP) { atomicAdd(&bar[XB_TMO], 1u); break; } }
    }
    nloc = mine > 0u ? mine : 1u; nx = cnt > 0u ? cnt : 1u;
}
DI void xcd_barrier(const XcdBarrier& b, bool leader) {
    asm volatile("s_waitcnt vmcnt(0)" ::: "memory");
    __syncthreads();
    if (leader) {
        unsigned* bar = b.bar;
        __builtin_amdgcn_s_waitcnt(0);
        unsigned nloc = b.st[0], nx = b.st[1];
        if (nloc == 0u) { xcd_barrier_complete(bar, b.x, nloc, nx); b.st[0] = nloc; b.st[1] = nx; }
        const unsigned old = xb_add(&bar[XB_XSUB(b.x)], 1u);
        const unsigned gen = old / nloc;
        if (old + 1u == (gen + 1u) * nloc) {
            __builtin_amdgcn_fence(__ATOMIC_RELEASE, "agent");
            asm volatile("s_waitcnt vmcnt(0)" ::: "memory");
            const unsigned og = xb_add(&bar[XB_TOP], 1u);
            const unsigned tg = og / nx;
            if (og + 1u == (tg + 1u) * nx) xb_add(&bar[XB_TOPGEN], 1u);
            else XB_SPIN(xb_ld(&bar[XB_TOPGEN]) == tg, bar);
            __builtin_amdgcn_fence(__ATOMIC_ACQUIRE, "agent");
            xb_add(&bar[XB_XGEN(b.x)], 1u);
            asm volatile("s_waitcnt vmcnt(0)" ::: "memory");
        } else {
            XB_SPIN(xb_ld(&bar[XB_XGEN(b.x)]) == gen, bar);
            __builtin_amdgcn_fence(__ATOMIC_ACQUIRE, "agent");
            asm volatile("s_waitcnt vmcnt(0)" ::: "memory");
        }
    }
    __syncthreads();
}

namespace pg8 {
constexpr int BM = 256, BK = 64, HALF = 128, HTB = HALF * BK * 2;
__host__ __device__ __forceinline__ int lds_byte(int r, int c) { const int st = (r >> 4) * 2 + (c >> 5), rr = r & 15, cc = c & 31, ob = rr * 64 + cc * 2; return st * 1024 + (ob ^ (((ob >> 9) & 1) << 5)); }
__host__ __device__ __forceinline__ void stage_rc(int b, int& R, int& C) { const int st = b / 1024, sb = b % 1024, swz = sb ^ (((sb >> 9) & 1) << 5); R = (st >> 1) * 16 + swz / 64; C = (st & 1) * 32 + (swz % 64) / 2; }
__host__ __device__ __forceinline__ int perm32(int rho) { const int n = rho >> 4, i = rho & 15; return 8 * (i >> 2) + 4 * n + (i & 3); }
struct Unit { const char* a; const char* b; int pm, pn, aux, pad; };
struct Gemm { int K, lda, ldb, kstepA, hstepA; };
template <bool I8> struct AccT { typedef f32x4 type; };
template <> struct AccT<true> { typedef i32x4 type; };
template <class Epi, class Sched, bool GATHER = false, bool I8 = false>
DI void gemm_phase(LAS unsigned char* lds, const Gemm g, const Sched& S, const Epi& E, int tid_in) {
    int tid = tid_in; asm volatile("" : "+v"(tid));
    const int wid = __builtin_amdgcn_readfirstlane(tid >> 6), lane = tid & 63, wr = wid >> 2, wc = wid & 3, fr = lane & 15, fq = lane >> 4;
    const int K = g.K, nt = K / BK;
    unsigned voffA[2], voffB[2];
#pragma unroll
    for (int i = 0; i < 2; ++i) { int R, C; stage_rc(tid * 16 + i * 8192, R, C); const int Rb = (R & ~31) + perm32(R & 31);
        voffA[i] = (unsigned)(R * g.lda + C) * 2u; voffB[i] = (unsigned)(Rb * g.ldb + C) * 2u; }
    const size_t kstep = (size_t)(BK * 2), kstepA = (size_t)g.kstepA;
    const size_t hstepA = g.hstepA < 0 ? (size_t)HALF * g.lda * 2 : (size_t)g.hstepA, hstepB = (size_t)HALF * g.ldb * 2;
    const unsigned hstepA32 = (unsigned)hstepA;
    unsigned gC[2][2] = {{0u, 0u}, {0u, 0u}}, gN[2][2] = {{0u, 0u}, {0u, 0u}};
    const unsigned ldsw = (unsigned)wid * 1024u;
    const int aoff = lds_byte(wr * 64 + fr, fq * 8), boff = lds_byte(wc * 32 + fr, fq * 8);
#define PG8_SA(b, h) (((b) * 2 + (h)) * HTB)
#define PG8_SB(b, h) ((4 + (b) * 2 + (h)) * HTB)
#define PG8_STAGE(bufoff, gbase, voff) do { _Pragma("unroll") for (int _i = 0; _i < 2; ++_i) \
        __builtin_amdgcn_global_load_lds((const unsigned*)((const char*)(gbase) + (voff)[_i]), (LAS unsigned*)(lds + (bufoff) + ldsw + _i * 8192), 16, 0, 0); } while (0)
#define PG8_STAGEA(bufoff, gbase, h, nextsel) do { _Pragma("unroll") for (int _i = 0; _i < 2; ++_i) { \
        const unsigned _o = GATHER ? ((nextsel) ? gN[h][_i] : gC[h][_i]) : (voffA[_i] + (unsigned)(h) * hstepA32); \
        __builtin_amdgcn_global_load_lds((const unsigned*)((const char*)(gbase) + _o), (LAS unsigned*)(lds + (bufoff) + ldsw + _i * 8192), 16, 0, 0); } } while (0)
#define PG8_LDA(dst, b, h) do { _Pragma("unroll") for (int m = 0; m < 4; ++m) _Pragma("unroll") for (int k = 0; k < 2; ++k) dst[m][k] = *(const LAS bf16x8*)(lds + PG8_SA(b, h) + aoff + m * 2048 + k * 1024); } while (0)
#define PG8_LDB(dst, b, h) do { _Pragma("unroll") for (int n = 0; n < 2; ++n) _Pragma("unroll") for (int k = 0; k < 2; ++k) dst[n][k] = *(const LAS bf16x8*)(lds + PG8_SB(b, h) + boff + n * 2048 + k * 1024); } while (0)
#define PG8_MMA(ai, bj, At, Bt) do { __builtin_amdgcn_s_setprio(1); _Pragma("unroll") for (int m = 0; m < 4; ++m) _Pragma("unroll") for (int n = 0; n < 2; ++n) _Pragma("unroll") for (int k = 0; k < 2; ++k) \
        { if constexpr (I8) acc[ai][bj][m][n] = __builtin_amdgcn_mfma_i32_16x16x64_i8(__builtin_bit_cast(i32x4, Bt[n][k]), __builtin_bit_cast(i32x4, At[m][k]), acc[ai][bj][m][n], 0, 0, 0); \
          else acc[ai][bj][m][n] = __builtin_amdgcn_mfma_f32_16x16x32_bf16(Bt[n][k], At[m][k], acc[ai][bj][m][n], 0, 0, 0); } __builtin_amdgcn_s_setprio(0); } while (0)
#define PG8_WAIT_V(n) asm volatile("s_waitcnt vmcnt(" #n ")" ::: "memory")
#define PG8_WAIT_L(n) asm volatile("s_waitcnt lgkmcnt(" #n ")" ::: "memory")
#define PG8_BAR __builtin_amdgcn_s_barrier()
#define PG8_SCHED __builtin_amdgcn_sched_barrier(0)
    Unit cur, nxt; int ui = 0;
    if (!S.next(0, cur)) return;
    typedef typename AccT<I8>::type ACC;
    ACC acc[2][2][4][2];
#pragma unroll
    for (int a = 0; a < 2; ++a)
#pragma unroll
        for (int b = 0; b < 2; ++b)
#pragma unroll
            for (int m = 0; m < 4; ++m)
#pragma unroll
                for (int n = 0; n < 2; ++n) acc[a][b][m][n] = (ACC){0, 0, 0, 0};
    bf16x8 At[4][2], B0[2][2], B1[2][2];
    const char* cA = cur.a; const char* cB = cur.b;
    if constexpr (GATHER) S.rows(cur, tid, gC);
    PG8_STAGE(PG8_SB(0, 0), cB, voffB); PG8_STAGE(PG8_SB(0, 1), cB + hstepB, voffB); PG8_STAGEA(PG8_SA(0, 0), cA, 0, false); PG8_STAGEA(PG8_SA(0, 1), cA, 1, false);
    if (wr == 1) PG8_BAR;
    PG8_WAIT_V(2); PG8_BAR;
    PG8_STAGE(PG8_SB(1, 0), cB + kstep, voffB); PG8_STAGEA(PG8_SA(1, 0), cA + kstepA, 0, false); PG8_STAGE(PG8_SB(1, 1), cB + hstepB + kstep, voffB);
    PG8_WAIT_V(6); PG8_BAR;
    for (;;) {
        const bool has_next = S.next(ui + 1, nxt);
        const char* nA = has_next ? nxt.a : cA; const char* nB = has_next ? nxt.b : cB;
        if constexpr (GATHER) { if (has_next) S.rows(nxt, tid, gN); else {
#pragma unroll
            for (int h = 0; h < 2; ++h) { gN[h][0] = gC[h][0]; gN[h][1] = gC[h][1]; } } }
        for (int t = 0; t < nt; t += 2) {
            const bool last = (t == nt - 2);
            const char* a1 = cA + (size_t)(t + 1) * kstepA;
            const char* a2 = last ? nA : cA + (size_t)(t + 2) * kstepA; const char* b2 = last ? nB : cB + (size_t)(t + 2) * kstep;
            const char* a3 = a2 + kstepA; const char* b3 = b2 + kstep;
            PG8_LDB(B0, 0, 0); PG8_LDB(B1, 0, 1); PG8_SCHED; PG8_LDA(At, 0, 0); PG8_STAGEA(PG8_SA(1, 1), a1, 1, false);
            PG8_WAIT_V(8); PG8_WAIT_L(0); PG8_BAR; PG8_MMA(0, 0, At, B0); PG8_MMA(0, 1, At, B1); PG8_BAR; PG8_SCHED;
            PG8_LDA(At, 0, 1); PG8_STAGE(PG8_SB(0, 0), b2, voffB); PG8_STAGE(PG8_SB(0, 1), b2 + hstepB, voffB); PG8_STAGEA(PG8_SA(0, 0), a2, 0, last);
            PG8_WAIT_V(8); PG8_WAIT_L(0); PG8_BAR; PG8_MMA(1, 0, At, B0); PG8_MMA(1, 1, At, B1); PG8_BAR; PG8_SCHED;
            PG8_LDB(B0, 1, 0); PG8_LDB(B1, 1, 1); PG8_SCHED; PG8_LDA(At, 1, 0); PG8_STAGEA(PG8_SA(0, 1), a2, 1, last);
            PG8_WAIT_V(8); PG8_WAIT_L(0); PG8_BAR; PG8_MMA(0, 0, At, B0); PG8_MMA(0, 1, At, B1); PG8_BAR; PG8_SCHED;
            PG8_LDA(At, 1, 1); PG8_STAGE(PG8_SB(1, 0), b3, voffB); PG8_STAGE(PG8_SB(1, 1), b3 + hstepB, voffB); PG8_STAGEA(PG8_SA(1, 0), a3, 0, last);
            PG8_WAIT_V(8); PG8_WAIT_L(0); PG8_BAR; PG8_MMA(1, 0, At, B0); PG8_MMA(1, 1, At, B1); PG8_BAR; PG8_SCHED;
        }
        if (wr == 0) PG8_BAR;
        { const int el = my_lane(); E(acc, cur, wr, wc, el & 15, el >> 4); }
        if (!has_next) break;
        bool carried = false;
        if constexpr (Epi::CARRY) { if (nxt.aux != 0) { const int el = my_lane(); E.carry(acc, nxt, wr, wc, el & 15, el >> 4); carried = true; } }
        if (!carried) {
#pragma unroll
        for (int a = 0; a < 2; ++a)
#pragma unroll
            for (int b = 0; b < 2; ++b)
#pragma unroll
                for (int m = 0; m < 4; ++m)
#pragma unroll
                    for (int n = 0; n < 2; ++n) acc[a][b][m][n] = (ACC){0, 0, 0, 0};
        }
        cur = nxt; cA = nA; cB = nB; ++ui;
        if constexpr (GATHER) {
#pragma unroll
            for (int h = 0; h < 2; ++h) { gC[h][0] = gN[h][0]; gC[h][1] = gN[h][1]; } }
        if (wr == 1) PG8_BAR;
    }
    PG8_WAIT_V(0);
    PG8_BAR;
#undef PG8_SA
#undef PG8_SB
#undef PG8_STAGE
#undef PG8_STAGEA
#undef PG8_LDA
#undef PG8_LDB
#undef PG8_MMA
#undef PG8_WAIT_V
#undef PG8_WAIT_L
#undef PG8_BAR
#undef PG8_SCHED
}
}
using pg8::Unit;

DI unsigned cvt_pk_bf16(float lo, float hi) { unsigned r; asm volatile("s_nop 1\n\tv_cvt_pk_bf16_f32 %0, %1, %2" : "=v"(r) : "v"(lo), "v"(hi)); return r; }
DI u32x4 pack8(const f32x4& v0, const f32x4& v1) { u32x4 w; w.x = cvt_pk_bf16(v0[0], v0[1]); w.y = cvt_pk_bf16(v0[2], v0[3]); w.z = cvt_pk_bf16(v1[0], v1[1]); w.w = cvt_pk_bf16(v1[2], v1[3]); return w; }

struct SchedP1 {
    const char* A; const char* B; int nM, nN, rbA, rbB, G, c;
    DI bool next(int i, Unit& u) const {
        constexpr int NXCD = 8, WGM = 8; const int nwg = nM * nN;
        const long L = (long)i * G + c; if (L >= nwg) return false;
        int wgid = (int)L; { const int q = nwg / NXCD, r = nwg % NXCD, xcd = wgid % NXCD, off = wgid / NXCD; wgid = (xcd < r ? xcd * (q + 1) : r * (q + 1) + (xcd - r) * q) + off; }
        const int nig = WGM * nN, gid = wgid / nig, fm = gid * WGM, gsz = (nM - fm) < WGM ? (nM - fm) : WGM;
        u.pm = fm + ((wgid % nig) % gsz); u.pn = (wgid % nig) / gsz; u.aux = 0; u.pad = 0;
        u.a = A + (size_t)u.pm * 256 * rbA; u.b = B + (size_t)u.pn * 256 * rbB; return true;
    }
};
struct SchedP3a {
    const char* ys; const char* wbr; int G, c;
    DI bool next(int i, Unit& u) const {
        const int tile = (i >> 2) * G + c; if (tile >= 512) return false;
        const int br = i & 3; u.pm = tile >> 2; u.pn = tile & 3; u.aux = br; u.pad = 0;
        u.a = ys + ((size_t)u.pm * 256 * 1024 + br * 256) * 2; u.b = wbr + ((size_t)br * 1024 * 256 + (size_t)u.pn * 256 * 256) * 2; return true;
    }
};
struct SchedP3b {
    const char* A; const char* B; int G, c;
    DI bool next(int i, Unit& u) const {
        const int L = i * G + c; if (L >= 512) return false;
        u.pm = L >> 2; u.pn = L & 3; u.aux = 0; u.pad = 0;
        u.a = A + (size_t)u.pm * 256 * 1024 * 2; u.b = B + (size_t)u.pn * 256 * 1024 * 2; return true;
    }
};
struct SchedM2 {
    const char* xr; const char* wgu; const LAS int* offt; const int* rowsrc; int G, c;
    DI bool next(int i, Unit& u) const {
        const int NT = __builtin_amdgcn_readfirstlane(offt[32]) >> 8; const int L = i * G + c; if (L >= NT * 2) return false;
        const int rt = L >> 1, pn = L & 1; const int e = __builtin_amdgcn_readfirstlane(offt[40 + rt]);
        u.pm = rt; u.pn = pn; u.aux = e; u.pad = 0;
        u.a = xr; u.b = wgu + ((size_t)e * 512 + pn * 256) * 1024 * 2; return true;
    }
    DI void rows(const Unit& u, int tid, unsigned (&g)[2][2]) const {
        const int e = u.aux; const int base = u.pm * 256 - __builtin_amdgcn_readfirstlane(offt[e]), cnt = __builtin_amdgcn_readfirstlane(offt[330 + e]);
#pragma unroll
        for (int i = 0; i < 2; ++i) { int R, C; pg8::stage_rc(tid * 16 + i * 8192, R, C);
#pragma unroll
            for (int h = 0; h < 2; ++h) { const int lr = base + h * 128 + R; const int as = lr < cnt ? rowsrc[e * 32768 + lr] : 0;
                g[h][i] = (unsigned)(as >> 1) * 4096u + (unsigned)C * 2u; } }
    }
};
struct SchedM3 {
    const char* hmid; const char* wd; const LAS int* offt; int G, c;
    DI bool next(int i, Unit& u) const {
        const int NT = __builtin_amdgcn_readfirstlane(offt[32]) >> 8; const int L = i * G + c; if (L >= NT * 4) return false;
        const int rt = L >> 2, pn = L & 3; const int e = __builtin_amdgcn_readfirstlane(offt[40 + rt]);
        u.pm = rt; u.pn = pn; u.aux = e; u.pad = 0;
        u.a = hmid + (size_t)rt * 256 * 256 * 2; u.b = wd + ((size_t)e * 1024 + pn * 256) * 256 * 2; return true;
    }
};

struct EpiP1I8 {
    static constexpr bool CARRY = false;
    bf16* proj; unsigned char* gates; const float* bgate; const float* hsc; const float* wsc;
    DI void operator()(const i32x4 (&acc)[2][2][4][2], const Unit& u, int wr, int wc, int fr, int fq) const {
        const int row0 = u.pm * 256 + wr * 64 + fr;
        if (u.pn < 10) { const int colt = u.pn * 256 + wc * 32 + 8 * fq;
            f32x4 sv[2][2]; float rsv[2][4];
#pragma unroll
            for (int bj = 0; bj < 2; ++bj)
#pragma unroll
                for (int n = 0; n < 2; ++n) sv[bj][n] = *(const GAS f32x4*)((const GAS float*)wsc + colt + bj * 128 + 4 * n);
#pragma unroll
            for (int ai = 0; ai < 2; ++ai)
#pragma unroll
                for (int m = 0; m < 4; ++m) rsv[ai][m] = ((const GAS float*)hsc)[row0 + ai * 128 + m * 16];
#pragma unroll
            for (int ai = 0; ai < 2; ++ai)
#pragma unroll
                for (int m = 0; m < 4; ++m) { bf16* rowp = proj + (size_t)(row0 + ai * 128 + m * 16) * PLD + colt; const float rs = rsv[ai][m];
#pragma unroll
                    for (int bj = 0; bj < 2; ++bj) { f32x4 v0, v1;
#pragma unroll
                        for (int e = 0; e < 4; ++e) { v0[e] = (float)acc[ai][bj][m][0][e] * (rs * sv[bj][0][e]); v1[e] = (float)acc[ai][bj][m][1][e] * (rs * sv[bj][1][e]); }
                        *(u32x4*)(rowp + bj * 128) = pack8(v0, v1); } }
            return; }
        const int gcol = (u.pn - 10) * 256 + wc * 32 + 8 * fq; const float* wsc = this->wsc + 2560;
        f32x4 bv[2][2], sv[2][2];
#pragma unroll
        for (int bj = 0; bj < 2; ++bj)
#pragma unroll
            for (int n = 0; n < 2; ++n) { bv[bj][n] = *(const f32x4*)(bgate + gcol + bj * 128 + 4 * n); sv[bj][n] = *(const f32x4*)(wsc + gcol + bj * 128 + 4 * n);
                sv[bj][n] = sv[bj][n] * -1.4426950408889634f; bv[bj][n] = bv[bj][n] * -1.4426950408889634f + (-8.f + 2.2e-5f); }
        float rsv[2][4];
#pragma unroll
        for (int ai = 0; ai < 2; ++ai)
#pragma unroll
            for (int m = 0; m < 4; ++m) rsv[ai][m] = ((const GAS float*)hsc)[row0 + ai * 128 + m * 16];
#pragma unroll
        for (int ai = 0; ai < 2; ++ai)
#pragma unroll
            for (int m = 0; m < 4; ++m) { const float rs = rsv[ai][m];
                unsigned char* rowp = gates + ((size_t)(u.pm * 16 + (u.pn - 10)) * 65536 + (size_t)((ai * 4 + m) * 8192 + (wr * 4 + wc) * 512 + (fq * 16 + fr) * 8));
#pragma unroll
                for (int bj = 0; bj < 2; ++bj) { unsigned q[8];
#pragma unroll
                    for (int n = 0; n < 2; ++n)
#pragma unroll
                        for (int e = 0; e < 4; ++e) { const float xe = ((float)acc[ai][bj][m][n][e] * rs) * sv[bj][n][e] + bv[bj][n][e];
                            q[4 * n + e] = (unsigned)__builtin_amdgcn_rcpf(0.00390631f + __builtin_amdgcn_exp2f(xe)); }
                    u32x2 w; w.x = q[0] | (q[1] << 8) | (q[2] << 16) | (q[3] << 24); w.y = q[4] | (q[5] << 8) | (q[6] << 16) | (q[7] << 24);
                    *(u32x2*)(rowp + bj * 4096) = w; }
                __builtin_amdgcn_sched_barrier(0); }
    }
};
struct EpiP3a {
    static constexpr bool CARRY = true;
    bf16* merged; const unsigned char* gates;
    DI void carry(f32x4 (&acc)[2][2][4][2], const Unit& u, int wr, int wc, int fr, int fq) const {
        const GAS unsigned char* gb = (const GAS unsigned char*)gates + (size_t)(u.pm * 16 + (u.aux - 1) * 4 + u.pn) * 65536;
        const unsigned go = (unsigned)((wr * 4 + wc) * 512 + (fq * 16 + fr) * 8);
        u32x2 gp[2][4][2], gn[2][4][2];
#pragma unroll
        for (int ai = 0; ai < 2; ++ai)
#pragma unroll
            for (int m = 0; m < 4; ++m)
#pragma unroll
                for (int bj = 0; bj < 2; ++bj) { gp[ai][m][bj] = *(const GAS u32x2*)(gb + go + (unsigned)(((ai * 4 + m) * 2 + bj) * 4096));
                    gn[ai][m][bj] = *(const GAS u32x2*)(gb + go + (unsigned)(((ai * 4 + m) * 2 + bj) * 4096 + 4 * 65536)); }
#pragma unroll
        for (int ai = 0; ai < 2; ++ai) {
#pragma unroll
            for (int m = 0; m < 4; ++m)
#pragma unroll
                for (int bj = 0; bj < 2; ++bj) {
#pragma unroll
                    for (int n = 0; n < 2; ++n) { const unsigned p4 = n ? gp[ai][m][bj].y : gp[ai][m][bj].x, n4 = n ? gn[ai][m][bj].y : gn[ai][m][bj].x;
#pragma unroll
                        for (int e = 0; e < 4; ++e) acc[ai][bj][m][n][e] *= ((float)((p4 >> (8 * e)) & 255u) + 0.5f) * __builtin_amdgcn_rcpf((float)((n4 >> (8 * e)) & 255u) + 0.5f); } }
            __builtin_amdgcn_sched_barrier(0); }
    }
    DI void operator()(const f32x4 (&acc)[2][2][4][2], const Unit& u, int wr, int wc, int fr, int fq) const {
        if (u.aux != 3) return;
        const GAS unsigned char* gb = (const GAS unsigned char*)gates + (size_t)(u.pm * 16 + 3 * 4 + u.pn) * 65536;
        GAS unsigned char* mb = (GAS unsigned char*)merged + ((size_t)(u.pm * 256) * 1024 + u.pn * 256) * 2;
        const unsigned go = (unsigned)((wr * 4 + wc) * 512 + (fq * 16 + fr) * 8), mo = (unsigned)((wr * 64 + fr) * 1024 + wc * 32 + 8 * fq) * 2u;
        u32x2 gw[2][4][2];
#pragma unroll
        for (int ai = 0; ai < 2; ++ai)
#pragma unroll
            for (int m = 0; m < 4; ++m)
#pragma unroll
                for (int bj = 0; bj < 2; ++bj) gw[ai][m][bj] = *(const GAS u32x2*)(gb + go + (unsigned)(((ai * 4 + m) * 2 + bj) * 4096));
#pragma unroll
        for (int ai = 0; ai < 2; ++ai) {
#pragma unroll
            for (int m = 0; m < 4; ++m)
#pragma unroll
                for (int bj = 0; bj < 2; ++bj) {
                    f32x4 v0 = acc[ai][bj][m][0], v1 = acc[ai][bj][m][1]; const u32x2 g2 = gw[ai][m][bj]; const float k256 = 0.00390625f;
#pragma unroll
                    for (int e = 0; e < 4; ++e) { v0[e] *= ((float)((g2.x >> (8 * e)) & 255u) + 0.5f) * k256; v1[e] *= ((float)((g2.y >> (8 * e)) & 255u) + 0.5f) * k256; }
                    *(GAS u32x4*)(mb + mo + (unsigned)((ai * 128 + m * 16) * 1024 + bj * 128) * 2u) = pack8(v0, v1); }
            __builtin_amdgcn_sched_barrier(0); }
    }
};
template <bool XF32> struct EpiP3b {
    static constexpr bool CARRY = false;
    const float* xin; bf16* xb_;
    DI void operator()(const f32x4 (&acc)[2][2][4][2], const Unit& u, int wr, int wc, int fr, int fq) const {
        GAS unsigned char* ob = (GAS unsigned char*)xb_ + ((size_t)(u.pm * 256) * 1024 + u.pn * 256) * 2;
        const unsigned lo = (unsigned)((wr * 64 + fr) * 1024 + wc * 32 + 8 * fq);
        if constexpr (XF32) {
            const GAS unsigned char* xb = (const GAS unsigned char*)xin + ((size_t)(u.pm * 256) * 1024 + u.pn * 256) * 4;
#pragma unroll
            for (int ai = 0; ai < 2; ++ai)
#pragma unroll
                for (int mh = 0; mh < 2; ++mh) {
                    f32x4 xv[2][2][2];
#pragma unroll
                    for (int m2 = 0; m2 < 2; ++m2)
#pragma unroll
                        for (int bj = 0; bj < 2; ++bj)
#pragma unroll
                            for (int n = 0; n < 2; ++n) xv[m2][bj][n] = *(const GAS f32x4*)(xb + (lo + (unsigned)((ai * 128 + (mh * 2 + m2) * 16) * 1024 + bj * 128 + 4 * n)) * 4u);
#pragma unroll
                    for (int m2 = 0; m2 < 2; ++m2)
#pragma unroll
                        for (int bj = 0; bj < 2; ++bj)
                            *(GAS u32x4*)(ob + (lo + (unsigned)((ai * 128 + (mh * 2 + m2) * 16) * 1024 + bj * 128)) * 2u) = pack8(xv[m2][bj][0] + acc[ai][bj][mh * 2 + m2][0], xv[m2][bj][1] + acc[ai][bj][mh * 2 + m2][1]);
                    __builtin_amdgcn_sched_barrier(0); }
        } else {
#pragma unroll
            for (int ai = 0; ai < 2; ++ai) {
                u32x4 xv[4][2];
#pragma unroll
                for (int m = 0; m < 4; ++m)
#pragma unroll
                    for (int bj = 0; bj < 2; ++bj) xv[m][bj] = *(const GAS u32x4*)(ob + (lo + (unsigned)((ai * 128 + m * 16) * 1024 + bj * 128)) * 2u);
#pragma unroll
                for (int m = 0; m < 4; ++m)
#pragma unroll
                    for (int bj = 0; bj < 2; ++bj) { const u32x4 x4 = xv[m][bj]; f32x4 v0 = acc[ai][bj][m][0], v1 = acc[ai][bj][m][1];
                        v0[0] += lo_bf(x4.x); v0[1] += hi_bf(x4.x); v0[2] += lo_bf(x4.y); v0[3] += hi_bf(x4.y); v1[0] += lo_bf(x4.z); v1[1] += hi_bf(x4.z); v1[2] += lo_bf(x4.w); v1[3] += hi_bf(x4.w);
                        *(GAS u32x4*)(ob + (lo + (unsigned)((ai * 128 + m * 16) * 1024 + bj * 128)) * 2u) = pack8(v0, v1); }
                __builtin_amdgcn_sched_barrier(0); }
        }
    }
};
struct EpiM2 {
    static constexpr bool CARRY = false;
    bf16* hmid;
    DI void operator()(const f32x4 (&acc)[2][2][4][2], const Unit& u, int wr, int wc, int fr, int fq) const {
        const int row0 = u.pm * 256 + wr * 64 + fr; const int col = u.pn * 128 + wc * 32 + 8 * fq;
#pragma unroll
        for (int ai = 0; ai < 2; ++ai)
#pragma unroll
            for (int m = 0; m < 4; ++m) { f32x4 h0, h1;
#pragma unroll
                for (int e = 0; e < 4; ++e) { const float g0 = acc[ai][0][m][0][e], g1 = acc[ai][0][m][1][e];
                    h0[e] = g0 * sigmoidf_(g0) * acc[ai][1][m][0][e]; h1[e] = g1 * sigmoidf_(g1) * acc[ai][1][m][1][e]; }
                *(u32x4*)(hmid + (size_t)(row0 + ai * 128 + m * 16) * 256 + col) = pack8(h0, h1); }
    }
};
struct EpiM3 {
    static constexpr bool CARRY = false;
    bf16* eo; const int* rowtok; const float* roww; const LAS int* offt;
    DI void operator()(const f32x4 (&acc)[2][2][4][2], const Unit& u, int wr, int wc, int fr, int fq) const {
        const int e = u.aux; const int cnt = __builtin_amdgcn_readfirstlane(offt[330 + e]);
        const int lr0 = u.pm * 256 - __builtin_amdgcn_readfirstlane(offt[e]) + wr * 64 + fr; const int colt = u.pn * 256 + wc * 32 + 8 * fq;
        int tk[2][4]; float wv[2][4];
#pragma unroll
        for (int ai = 0; ai < 2; ++ai)
#pragma unroll
            for (int m = 0; m < 4; ++m) { const int lr = lr0 + ai * 128 + m * 16; tk[ai][m] = -1; wv[ai][m] = 0.f;
                if (lr < cnt) { tk[ai][m] = ((const GAS int*)rowtok)[e * 32768 + lr]; wv[ai][m] = ((const GAS float*)roww)[e * 32768 + lr]; } }
#pragma unroll
        for (int ai = 0; ai < 2; ++ai)
#pragma unroll
            for (int m = 0; m < 4; ++m) {
                if (tk[ai][m] >= 0) { const float w = wv[ai][m]; GAS bf16* op = (GAS bf16*)eo + (size_t)tk[ai][m] * 1024 + colt;
#pragma unroll
                    for (int bj = 0; bj < 2; ++bj) *(GAS u32x4*)(op + bj * 128) = pack8(acc[ai][bj][m][0] * w, acc[ai][bj][m][1] * w); }
                __builtin_amdgcn_sched_barrier(0); }
    }
};

struct Args { const float* in[36]; float* out; unsigned char* ws; int ph_lo, ph_hi; };
struct InTab { unsigned base;
    DI const float* operator[](int i) const { unsigned long long v; const unsigned addr = base + (unsigned)i * 8u;
        asm volatile("ds_read_b64 %0, %1\n\ts_waitcnt lgkmcnt(0)" : "=v"(v) : "v"(addr) : "memory");
        const unsigned lo = __builtin_amdgcn_readfirstlane((unsigned)v), hi = __builtin_amdgcn_readfirstlane((unsigned)(v >> 32));
        return (const float*)(((unsigned long long)hi << 32) | lo); } };
struct KA { InTab in; float* out; unsigned char* ws; };

DI void transpose_item(const float* W_, int ldw, int nvalid, bf16* WT_, int ldt, int k0, int n0, int dst_row0, LAS float* scr, int lane) {
    const GAS float* W = (const GAS float*)W_; GAS bf16* WT = (GAS bf16*)WT_;
    const int nq = 4 * (lane & 7), kr8 = lane >> 3;
    f32x4 v[8];
#pragma unroll
    for (int i = 0; i < 8; ++i) { const int kk = 8 * i + kr8;
        if (n0 + nq + 3 < nvalid) v[i] = *(const GAS f32x4*)(W + (size_t)(k0 + kk) * ldw + n0 + nq);
        else {
#pragma unroll
            for (int e = 0; e < 4; ++e) v[i][e] = (n0 + nq + e < nvalid) ? W[(size_t)(k0 + kk) * ldw + n0 + nq + e] : 0.f; } }
#pragma unroll
    for (int i = 0; i < 8; ++i) { const int kk = 8 * i + kr8;
#pragma unroll
        for (int e = 0; e < 4; ++e) scr[kk * 33 + nq + e] = v[i][e]; }
    LDS_WAIT(); asm volatile("" ::: "memory");
    const int c = lane & 7;
#pragma unroll
    for (int j = 0; j < 4; ++j) { const int n = (lane >> 3) + 8 * j; const LAS float* s = scr + (8 * c) * 33 + n;
        u32x4 o; o.x = pk2(s[0 * 33], s[1 * 33]); o.y = pk2(s[2 * 33], s[3 * 33]); o.z = pk2(s[4 * 33], s[5 * 33]); o.w = pk2(s[6 * 33], s[7 * 33]);
        if (n0 + n < nvalid) *(GAS u32x4*)(WT + (size_t)(dst_row0 + n) * ldt + k0 + 8 * c) = o; }
    LDS_WAIT(); asm volatile("" ::: "memory");
}
DI void phase0_weights(const KA& a, int l, LAS unsigned char* lds, int gw, int NGW, int wave, int lane) {
    LAS float* scr = (LAS float*)(lds + wave * 16384);
    const float* w_in = a.in[4] + (size_t)l * 1024 * NIN;
    const float* w_gate = a.in[24] + (size_t)l * 4 * 1024 * 1024;
    const float* w_br = a.in[26] + (size_t)l * 4 * 256 * 1024;
    const float* w_out = a.in[27] + (size_t)l * 1024 * 1024;
    bf16* Wt_in = (bf16*)(a.ws + WS_WIN); bf16* Wt_br = (bf16*)(a.ws + WS_WBR); bf16* Wt_out = (bf16*)(a.ws + WS_WOUT);
    constexpr int I_B = 4 * 4 * 32, I_O = 16 * 32, NIT = I_B + I_O;
    (void)w_gate; (void)w_in; (void)Wt_in;
    for (int it = gw; it < NIT; it += NGW) {
        int r = it;
        if (r < I_B) { const int br = r / 128, q = r % 128, kb = q / 32, nb = q % 32; transpose_item(w_br + (size_t)br * 256 * 1024, 1024, 1024, Wt_br + (size_t)br * 1024 * 256, 256, kb * 64, nb * 32, nb * 32, scr, lane); continue; } r -= I_B;
        { const int kb = r / 32, nb = r % 32; transpose_item(w_out, 1024, 1024, Wt_out, 1024, kb * 64, nb * 32, nb * 32, scr, lane); }
    }
}
DI void p1_weights_i8(const KA& a, int l, LAS unsigned char* lds, int bid, int G, int wave, int lane) {
    LAS float* scr = (LAS float*)(lds + wave * 16384); LAS float* red = (LAS float*)(lds + 7 * 16384 + 12288);
    const GAS float* wgt = (const GAS float*)(a.in[24] + (size_t)l * 4 * 1024 * 1024); const GAS float* win = (const GAS float*)(a.in[4] + (size_t)l * 1024 * NIN);
    GAS unsigned char* Wq = (GAS unsigned char*)(a.ws + WS_WQ); GAS float* wsc = (GAS float*)(a.ws + WS_WSC);
    const int nq = 4 * (lane & 7), kr8 = lane >> 3;
    for (int it = G - 1 - bid; it < 128 + 77; it += G) {
        const bool isg = it < 128; const int br = it >> 5; const int n0 = isg ? (it & 31) * 32 : (it - 128) * 32;
        const int ldw = isg ? 1024 : NIN; const int nval = isg ? 1024 : NIN; const int drow0 = isg ? 2560 + br * 1024 + n0 : n0;
        const bool lok = (n0 + nq) < nval;
        const GAS float* W = (isg ? wgt + (size_t)br * 1024 * 1024 : win) + n0 + nq + (size_t)(128 * wave) * ldw;
        f32x4 v[16];
#pragma unroll
        for (int i = 0; i < 16; ++i) { v[i] = (f32x4){0.f, 0.f, 0.f, 0.f}; if (lok) v[i] = *(const GAS f32x4*)(W + (size_t)(8 * i + kr8) * ldw); }
        f32x4 mx = {0.f, 0.f, 0.f, 0.f};
#pragma unroll
        for (int i = 0; i < 16; ++i) { mx[0] = fmaxf(mx[0], fabsf(v[i][0])); mx[1] = fmaxf(mx[1], fabsf(v[i][1])); mx[2] = fmaxf(mx[2], fabsf(v[i][2])); mx[3] = fmaxf(mx[3], fabsf(v[i][3])); }
#pragma unroll
        for (int e = 0; e < 4; ++e) { float m = mx[e]; m = fmaxf(m, xshfl<8>(m)); m = fmaxf(m, xshfl<16>(m)); m = fmaxf(m, xshfl<32>(m)); mx[e] = m; }
        if (kr8 == 0) {
#pragma unroll
            for (int e = 0; e < 4; ++e) red[wave * 32 + nq + e] = mx[e]; }
        __syncthreads();
#pragma unroll
        for (int e = 0; e < 4; ++e) { float m = red[nq + e];
#pragma unroll
            for (int w = 1; w < 8; ++w) m = fmaxf(m, red[w * 32 + nq + e]);
            mx[e] = fmaxf(m, 1e-20f); }
        if (wave == 0 && kr8 == 0 && lok) *(GAS f32x4*)(wsc + drow0 + nq) = mx * (1.f / 127.f);
        const f32x4 qs = {127.f / mx[0], 127.f / mx[1], 127.f / mx[2], 127.f / mx[3]};
#pragma unroll
        for (int hb = 0; hb < 2; ++hb) {
#pragma unroll
            for (int i = 0; i < 8; ++i) { const int kk = 8 * i + kr8;
#pragma unroll
                for (int e = 0; e < 4; ++e) scr[kk * 33 + nq + e] = __builtin_rintf(v[8 * hb + i][e] * qs[e]); }
            LDS_WAIT(); asm volatile("" ::: "memory");
            const int n = lane >> 1, kh = lane & 1; u32x4 o[2];
#pragma unroll
            for (int h2 = 0; h2 < 2; ++h2) { unsigned w4[4];
#pragma unroll
                for (int d = 0; d < 4; ++d) { unsigned wv = 0u;
#pragma unroll
                    for (int e = 0; e < 4; ++e) wv |= ((unsigned)(int)scr[(32 * kh + 16 * h2 + 4 * d + e) * 33 + n] & 255u) << (8 * e);
                    w4[d] = wv; }
                o[h2].x = w4[0]; o[h2].y = w4[1]; o[h2].z = w4[2]; o[h2].w = w4[3]; }
            if (n0 + n < nval) { GAS unsigned char* dst = Wq + (size_t)(drow0 + n) * 1024 + 128 * wave + 64 * hb + 32 * kh; *(GAS u32x4*)dst = o[0]; *(GAS u32x4*)(dst + 16) = o[1]; }
            LDS_WAIT(); asm volatile("" ::: "memory");
        }
        __syncthreads();
    }
}

DI void router_weights(const KA& a, int l, int gw, int NGW, int lane) {
    bf16* Wr = (bf16*)(a.ws + WS_WR);
    const float* wg = a.in[29] + (size_t)l * 1024 * 4; const float* we = a.in[31] + (size_t)l * 1024 * 32;
    for (int n = gw; n < 36; n += NGW) {
        for (int i = 0; i < 16; ++i) { const int k = lane + 64 * i; const float w = (n < 4) ? wg[k * 4 + n] : we[k * 32 + (n - 4)];
            const unsigned hi = f2bf(w); const float hf = __builtin_bit_cast(float, hi << 16); const unsigned lo = f2bf(w - hf);
            Wr[(size_t)n * 2048 + k] = (bf16)hi; Wr[(size_t)n * 2048 + 1024 + k] = (bf16)hi; Wr[(size_t)(64 + n) * 2048 + k] = (bf16)lo; Wr[(size_t)(64 + n) * 2048 + 1024 + k] = 0; }
    }
}

DI void cmp_weights(const KA& a, int l, LAS unsigned char* lds, int gw, int NGW, int wave, int lane) {
    LAS float* scr = (LAS float*)(lds + wave * 16384);
    bf16* Wc = (bf16*)(a.ws + WS_WCMP); float* pt = (float*)(a.ws + WS_CMPAB + 2 * MiB);
    for (int it = gw; it < 128 + 64; it += NGW) {
        if (it < 128) { const int kv = it >> 6, q = it & 63, kb = q >> 1, nb = q & 1; const float* w1 = a.in[kv ? 22 : 19] + (size_t)l * 2048 * 64;
            bf16* dst = Wc + (size_t)kv * 256 * 1024 - (kb >= 16 ? 1024 : 0);
            transpose_item(w1, 64, 64, dst, 1024, kb * 64, nb * 32, (kb >= 16 ? 64 : 0) + nb * 32, scr, lane);
        } else { const int kv = (it - 128) >> 5, part = (it - 128) & 31;
            const GAS float* w1 = (const GAS float*)(a.in[kv ? 22 : 19] + (size_t)l * 2048 * 64) + (size_t)part * 64 * 64; const GAS float* pos = (const GAS float*)(a.in[kv ? 21 : 18] + (size_t)l * 2048) + part * 64;
            float acc = 0.f;
#pragma unroll 16
            for (int k = 0; k < 64; ++k) acc += pos[k] * w1[(size_t)k * 64 + lane];
            pt[(kv * 32 + part) * 64 + lane] = acc; }
    }
}

DI void lru_weights(const KA& a, int l, int gw, int NGW, int lane) {
    bf16* W = (bf16*)(a.ws + WS_LRUW); const float* wa = a.in[7] + (size_t)l * 4 * 4096; const float* wx = a.in[9] + (size_t)l * 4 * 4096;
    (void)NGW; { const int idx = gw * 64 + lane; if (idx < 32768) { const int i = idx & 63, j = (idx >> 6) & 63, mat = (idx >> 12) & 1, hbk = idx >> 13;
        W[idx] = (bf16)f2bf((mat ? wx : wa)[(size_t)hbk * 4096 + i * 64 + j]); } }
}
DI void phase0_rows(const KA& a, int l, int mode, int gw, int NGW, int lane) {
    const GAS float* xin = (const GAS float*)a.in[0]; GAS bf16* xb = (GAS bf16*)(a.ws + WS_XB);
    const GAS bf16* eo = (const GAS bf16*)(a.ws + WS_PROJ);
    GAS float* outp = (GAS float*)a.out;
    const GAS float* g = (const GAS float*)(mode ? a.in[2] : (a.in[3] + (size_t)l * 1024));
    f32x4 gv[4];
#pragma unroll
    for (int j = 0; j < 4; ++j) gv[j] = *(const GAS f32x4*)(g + 4 * (lane + 64 * j));
    for (int m0 = gw * 4; m0 < T; m0 += NGW * 4) {
        f32x4 v[4][4]; float ss[4];
#pragma unroll
        for (int rr = 0; rr < 4; ++rr)
#pragma unroll
            for (int j = 0; j < 4; ++j) { if (l == 0) v[rr][j] = *(const GAS f32x4*)(xin + (size_t)(m0 + rr) * 1024 + 4 * (lane + 64 * j));
                else { const u32x2 xw = *(const GAS u32x2*)(xb + (size_t)(m0 + rr) * 1024 + 4 * (lane + 64 * j)); v[rr][j][0] = lo_bf(xw.x); v[rr][j][1] = hi_bf(xw.x); v[rr][j][2] = lo_bf(xw.y); v[rr][j][3] = hi_bf(xw.y); } }
        if (l > 0) {
#pragma unroll
            for (int rr = 0; rr < 4; ++rr)
#pragma unroll
                for (int j = 0; j < 4; ++j) {
                    const u32x2 e0 = *(const GAS u32x2*)(eo + (size_t)(2 * (m0 + rr)) * 1024 + 4 * (lane + 64 * j));
                    const u32x2 e1 = *(const GAS u32x2*)(eo + (size_t)(2 * (m0 + rr) + 1) * 1024 + 4 * (lane + 64 * j));
                    v[rr][j][0] += lo_bf(e0.x) + lo_bf(e1.x); v[rr][j][1] += hi_bf(e0.x) + hi_bf(e1.x); v[rr][j][2] += lo_bf(e0.y) + lo_bf(e1.y); v[rr][j][3] += hi_bf(e0.y) + hi_bf(e1.y); } }
#pragma unroll
        for (int rr = 0; rr < 4; ++rr) { float t = 0.f;
#pragma unroll
            for (int j = 0; j < 4; ++j) t += (v[rr][j][0] * v[rr][j][0] + v[rr][j][1] * v[rr][j][1]) + (v[rr][j][2] * v[rr][j][2] + v[rr][j][3] * v[rr][j][3]);
            ss[rr] = t; }
#pragma unroll
        for (int rr = 0; rr < 4; ++rr) ss[rr] = wave_sum(ss[rr]);
        if (mode) {
#pragma unroll
            for (int rr = 0; rr < 4; ++rr) { const float r = __builtin_amdgcn_rsqf(ss[rr] * (1.f / 1024.f) + 1e-6f); const size_t m = (size_t)(m0 + rr);
#pragma unroll
                for (int j = 0; j < 4; ++j) *(GAS f32x4*)(outp + m * 1024 + 4 * (lane + 64 * j)) = v[rr][j] * r * gv[j]; }
        } else {
            GAS unsigned char* hq = (GAS unsigned char*)(a.ws + WS_HQ); GAS float* hsc = (GAS float*)(a.ws + WS_HSC);
            float am[4];
#pragma unroll
            for (int rr = 0; rr < 4; ++rr) { const float r = __builtin_amdgcn_rsqf(ss[rr] * (1.f / 1024.f) + 1e-6f); const size_t m = (size_t)(m0 + rr); float t = 0.f;
#pragma unroll
                for (int j = 0; j < 4; ++j) { if (l > 0) { u32x2 w; w.x = pk2(v[rr][j][0], v[rr][j][1]); w.y = pk2(v[rr][j][2], v[rr][j][3]); *(GAS u32x2*)(xb + m * 1024 + 4 * (lane + 64 * j)) = w; }
                    const f32x4 y = v[rr][j] * r * gv[j]; v[rr][j] = y;
                    t = fmaxf(t, fmaxf(fmaxf(fabsf(y[0]), fabsf(y[1])), fmaxf(fabsf(y[2]), fabsf(y[3])))); }
                am[rr] = t; }
#pragma unroll
            for (int rr = 0; rr < 4; ++rr) am[rr] = fmaxf(wave_max(am[rr]), 1e-20f);
#pragma unroll
            for (int rr = 0; rr < 4; ++rr) { const size_t m = (size_t)(m0 + rr); const float qs = 127.f * __builtin_amdgcn_rcpf(am[rr]);
                if (lane == 0) hsc[m] = am[rr] * (1.f / 127.f);
#pragma unroll
                for (int j = 0; j < 4; ++j) { const f32x4 y = v[rr][j] * qs;
                    const unsigned q = ((unsigned)(int)__builtin_rintf(y[0]) & 255u) | (((unsigned)(int)__builtin_rintf(y[1]) & 255u) << 8) | (((unsigned)(int)__builtin_rintf(y[2]) & 255u) << 16) | (((unsigned)(int)__builtin_rintf(y[3]) & 255u) << 24);
                    *(GAS unsigned*)(hq + m * 1024 + 4 * (lane + 64 * j)) = q; } }
        }
    }
}

DI int crow(int i, int hh) { return (i & 3) + 8 * (i >> 2) + 4 * hh; }
DI unsigned cvtpk(float lo, float hi) { f32x2 v = {lo, hi}; bf16x2_t b = __builtin_convertvector(v, bf16x2_t); return __builtin_bit_cast(unsigned, b); }
template <int CTRL, int RMASK> DI float dppf(float oldv, float v) { return __builtin_bit_cast(float, __builtin_amdgcn_update_dpp(__builtin_bit_cast(int, oldv), __builtin_bit_cast(int, v), CTRL, RMASK, 0xf, false)); }
template <int CTRL, int RMASK> DI void scan_step(float& a, float& b) {
    const float ap = dppf<CTRL, RMASK>(1.f, a), bp = dppf<CTRL, RMASK>(0.f, b); b = a * bp + b; a = a * ap; }
DI void lru_unit(const KA& a, int l, const GAS bf16* proj, GAS bf16* ys, GAS float* sums, LAS unsigned char* lds, int task, int lane_in, int wave_in, bool final) {
    int lane = lane_in, wave = wave_in; asm volatile("" : "+v"(lane), "+s"(wave));
    const int chunk = task & 31, hbk = (task >> 5) & 3, b = task >> 7;
    const int ts = chunk * 256 + wave * 32; const size_t rowb = (size_t)b * SEQ;
    LAS unsigned char* wl = lds + wave * 16384;
    LAS float* ex = (LAS float*)(lds + LRUEX_OFF); LAS float* cst = (LAS float*)(lds + LRUCST_OFF); LAS float* car = (LAS float*)(lds + LRUCAR_OFF) + wave * 64;
    const int n = lane & 31, hh = lane >> 5;
    const int c = hbk * 64 + lane;
    const GAS float* cw = (const GAS float*)(a.in[5] + (size_t)l * 4 * 256);
    const GAS float* p6 = (const GAS float*)a.in[6]; const GAS float* p8 = (const GAS float*)a.in[8]; const GAS float* p10 = (const GAS float*)a.in[10]; const GAS float* p11 = (const GAS float*)a.in[11];
    const float cw0 = cw[c], cw1 = cw[256 + c], cw2 = cw[512 + c], cw3 = cw[768 + c]; const float cb = p6[l * 256 + c];
    const float k8 = p8[l * 256 + c], k10 = p10[l * 256 + c], k11 = p11[l * 256 + c];
    const GAS bf16* xp = proj + (rowb + ts) * PLD + C_AX + c;
    unsigned short xraw[35];
#pragma unroll
    for (int j = 0; j < 3; ++j) xraw[j] = (ts >= 3 - j) ? *(const GAS unsigned short*)(xp - (3 - j) * PLD) : (unsigned short)0;
#pragma unroll
    for (int j = 0; j < 32; ++j) xraw[3 + j] = *(const GAS unsigned short*)(xp + (size_t)j * PLD);
    const GAS bf16* wt = (const GAS bf16*)(a.ws + WS_LRUW) + (size_t)hbk * 8192;
    bf16x8 afr[4][4];
#pragma unroll
    for (int m = 0; m < 4; ++m)
#pragma unroll
        for (int s4 = 0; s4 < 4; ++s4) afr[m][s4] = *(const GAS bf16x8*)(wt + (size_t)(m >> 1) * 4096 + (32 * (m & 1) + n) * 64 + 8 * hh + 16 * s4);
    f32x2 sv[31]; u32x2 gt2[2][4];
    const GAS bf16* gp = proj + (rowb + ts + n) * PLD + C_AG + hbk * 64;
    if (final) {
        const GAS f32x2* sp = (const GAS f32x2*)(sums + ((size_t)((b * 4 + hbk) * 32) * 64 + lane) * 2);
#pragma unroll
        for (int cc = 0; cc < 31; ++cc) { const int ci = cc < chunk ? cc : 0; sv[cc] = sp[(size_t)ci * 64]; }
#pragma unroll
        for (int mm = 0; mm < 2; ++mm)
#pragma unroll
            for (int g4 = 0; g4 < 4; ++g4) gt2[mm][g4] = *(const GAS u32x2*)(gp + 32 * mm + 8 * g4 + 4 * hh);
    }
    {
        if (wave == 0) { cst[lane] = -1.4426950408889634f * k8; cst[64 + lane] = -1.4426950408889634f * k10; cst[128 + lane] = -8.f * 1.4426950408889634f * softplusf_(-k11); }
        float x3 = __builtin_bit_cast(float, (unsigned)xraw[0] << 16), x2 = __builtin_bit_cast(float, (unsigned)xraw[1] << 16), x1 = __builtin_bit_cast(float, (unsigned)xraw[2] << 16);
#pragma unroll
        for (int j = 0; j < 32; ++j) { const float x0 = __builtin_bit_cast(float, (unsigned)xraw[3 + j] << 16); const float xc = cb + cw0 * x3 + cw1 * x2 + cw2 * x1 + cw3 * x0;
            *(LAS bf16*)(wl + j * 144 + lane * 2) = (bf16)f2bf(xc); *(LAS float*)(wl + 4608 + j * 272 + lane * 4) = xc; x3 = x2; x2 = x1; x1 = x0; }
    }
    f32x16 D[4];
    {
        bf16x8 bfr[4];
        LDS_WAIT();
#pragma unroll
        for (int s4 = 0; s4 < 4; ++s4) bfr[s4] = *(const LAS bf16x8*)(wl + n * 144 + hh * 16 + s4 * 32);
#pragma unroll
        for (int m = 0; m < 4; ++m) {
#pragma unroll
            for (int s4 = 0; s4 < 4; ++s4) {
                if (s4 == 0) { f32x16 z;
#pragma unroll
                    for (int i = 0; i < 16; ++i) z[i] = 0.f;
                    D[m] = MFMA32(afr[m][s4], bfr[s4], z); } else D[m] = MFMA32(afr[m][s4], bfr[s4], D[m]); } }
    }
    __syncthreads();
    const bool t0 = (ts + n) == 0;
#pragma unroll
    for (int mm = 0; mm < 2; ++mm)
#pragma unroll
        for (int g4 = 0; g4 < 4; ++g4) { const int c0 = 32 * mm + 8 * g4 + 4 * hh;
            const f32x4 vba = *(const LAS f32x4*)(cst + c0), vbx = *(const LAS f32x4*)(cst + 64 + c0), vc8 = *(const LAS f32x4*)(cst + 128 + c0);
            const f32x4 vxc = *(const LAS f32x4*)(wl + 4608 + n * 272 + c0 * 4);
#pragma unroll
            for (int e = 0; e < 4; ++e) { const int i = 4 * g4 + e;
                const float r = __builtin_amdgcn_rcpf(1.f + __builtin_amdgcn_exp2f(D[mm][i] * -1.4426950408889634f + vba[e]));
                const float ig = __builtin_amdgcn_rcpf(1.f + __builtin_amdgcn_exp2f(D[2 + mm][i] * -1.4426950408889634f + vbx[e]));
                const float av = __builtin_amdgcn_exp2f(vc8[e] * r);
                const float mult = t0 ? 1.f : __builtin_amdgcn_sqrtf(fmaxf(1.f - av * av, 0.f));
                float aa = av, bb = mult * ig * vxc[e];
                scan_step<0x111, 0xf>(aa, bb); scan_step<0x112, 0xf>(aa, bb); scan_step<0x114, 0xf>(aa, bb); scan_step<0x118, 0xf>(aa, bb); scan_step<0x142, 0xa>(aa, bb);
                D[mm][i] = aa; D[2 + mm][i] = bb; } }
    if (n == 31) {
#pragma unroll
        for (int mm = 0; mm < 2; ++mm)
#pragma unroll
            for (int i = 0; i < 16; ++i) { const int c = 32 * mm + crow(i, hh); ex[(wave * 64 + c) * 2] = D[mm][i]; ex[(wave * 64 + c) * 2 + 1] = D[2 + mm][i]; } }
    __syncthreads();
    if (!final) {
        if (wave == 0) { float hv = 0.f, av = 1.f;
#pragma unroll
            for (int w = 0; w < 8; ++w) { const float A_ = ex[(w * 64 + lane) * 2], H_ = ex[(w * 64 + lane) * 2 + 1]; hv = A_ * hv + H_; av *= A_; }
            GAS float* sp = sums + ((size_t)((b * 4 + hbk) * 32 + chunk) * 64 + lane) * 2; sp[0] = av; sp[1] = hv; }
    } else {
        {   float hv = 0.f;
#pragma unroll
            for (int cc = 0; cc < 31; ++cc) { const float A_ = cc < chunk ? sv[cc][0] : 1.f, H_ = cc < chunk ? sv[cc][1] : 0.f; hv = A_ * hv + H_; }
            for (int w = 0; w < wave; ++w) { const float A_ = ex[(w * 64 + lane) * 2], H_ = ex[(w * 64 + lane) * 2 + 1]; hv = A_ * hv + H_; }
            car[lane] = hv; }
        LDS_WAIT(); asm volatile("" ::: "memory");
        GAS bf16* yp = ys + (rowb + ts + n) * 1024 + hbk * 64;
#pragma unroll
        for (int mm = 0; mm < 2; ++mm)
#pragma unroll
            for (int g4 = 0; g4 < 4; ++g4) { const int c0 = 32 * mm + 8 * g4 + 4 * hh; const f32x4 cv = *(const LAS f32x4*)(car + c0);
                const u32x2 gw2 = gt2[mm][g4]; float y[4];
#pragma unroll
                for (int e = 0; e < 4; ++e) { const int i = 4 * g4 + e; const float hv = D[2 + mm][i] + D[mm][i] * cv[e];
                    const float gt = (e == 0) ? lo_bf(gw2.x) : (e == 1) ? hi_bf(gw2.x) : (e == 2) ? lo_bf(gw2.y) : hi_bf(gw2.y); const float wv = gt * (2.302208198f + 0.102943240f * gt * gt);
                    y[e] = hv * (gt - gt * __builtin_amdgcn_rcpf(__builtin_amdgcn_exp2f(wv) + 1.f)); }
                u32x2 yo; yo.x = cvtpk(y[0], y[1]); yo.y = cvtpk(y[2], y[3]); *(GAS u32x2*)(yp + c0) = yo; }
    }
    __syncthreads();
}

constexpr int DK_STR = 144, DV_STR = 192, DBUF_BYTES = 64 * DK_STR + 64 * DV_STR;
DI bf16x8 pack_half(const f32x16& x, int s2) { u32x4 p;
    if (s2 == 0) { p.x = cvtpk(x[0], x[1]); p.y = cvtpk(x[2], x[3]); p.z = cvtpk(x[4], x[5]); p.w = cvtpk(x[6], x[7]); }
    else { p.x = cvtpk(x[8], x[9]); p.y = cvtpk(x[10], x[11]); p.z = cvtpk(x[12], x[13]); p.w = cvtpk(x[14], x[15]); }
    return __builtin_bit_cast(bf16x8, p); }
DI s16x4 vtr(const LAS unsigned char* p) { return __builtin_bit_cast(s16x4, __builtin_amdgcn_ds_read_tr16_b64_v4i16((LAS v4i16_t*)p)); }
DI float max16(const f32x16& x) { float a = fmaxf(fmaxf(x[0], x[1]), fmaxf(x[2], x[3])), b = fmaxf(fmaxf(x[4], x[5]), fmaxf(x[6], x[7])), c = fmaxf(fmaxf(x[8], x[9]), fmaxf(x[10], x[11])), d = fmaxf(fmaxf(x[12], x[13]), fmaxf(x[14], x[15])); return fmaxf(fmaxf(a, b), fmaxf(c, d)); }
DI void diff_unit(const GAS bf16* proj, GAS bf16* ys, LAS unsigned char* lds, const LAS float* bias2, const GAS float* subg, const LAS float* lamp, int b, int h, int qb, int wave_in) {
    int wave = wave_in; asm volatile("" : "+s"(wave)); const int lane = my_lane(); const int tid = wave * 64 + lane;
    const int q0 = qb * 256 + wave * 32; const int ql = lane & 31, hh = lane >> 5; const int q = q0 + ql;
    const size_t rowb = (size_t)b * SEQ;
    const float SC = 0.17677669529663687f * 1.4426950408889634f;
    bf16x8 qf[2][2];
    { const GAS bf16* qp = proj + (rowb + q) * PLD + C_CQ + h * 64 + hh * 8;
#pragma unroll
      for (int m = 0; m < 2; ++m)
#pragma unroll
        for (int s = 0; s < 2; ++s) { const u32x4 w = *(const GAS u32x4*)(qp + m * 32 + s * 16); u32x4 o;
            o.x = cvtpk(lo_bf(w.x) * SC, hi_bf(w.x) * SC); o.y = cvtpk(lo_bf(w.y) * SC, hi_bf(w.y) * SC); o.z = cvtpk(lo_bf(w.z) * SC, hi_bf(w.z) * SC); o.w = cvtpk(lo_bf(w.w) * SC, hi_bf(w.w) * SC);
            qf[m][s] = __builtin_bit_cast(bf16x8, o); } }
    f32x16 O[2][2], negm[2];
#pragma unroll
    for (int i = 0; i < 16; ++i) { O[0][0][i] = 0.f; O[0][1][i] = 0.f; O[1][0][i] = 0.f; O[1][1][i] = 0.f; negm[0][i] = 120.f; negm[1][i] = 120.f; }
    float lsum[2] = {0.f, 0.f};
    const int nsteps = 4 * qb + 4, mysteps = 4 * qb + (wave >> 1) + 1;
    const int skey = tid >> 3, sch = tid & 7;
    const GAS unsigned char* kgb = (const GAS unsigned char*)(proj + rowb * PLD + C_CK + h * 64);
    const GAS unsigned char* vgb = (const GAS unsigned char*)(proj + rowb * PLD + C_CV + h * 64);
    const unsigned soff = (unsigned)(skey * PLD + sch * 8) * 2u;
    u32x4 kr = *(const GAS u32x4*)(kgb + soff), vr = *(const GAS u32x4*)(vgb + soff);
    *(LAS u32x4*)(lds + skey * DK_STR + sch * 16) = kr; *(LAS u32x4*)(lds + 64 * DK_STR + skey * DV_STR + sch * 16) = vr;
    __syncthreads();
    const int i16 = lane & 15, blk = (lane >> 4) & 1;
    const int kboff = ql * DK_STR + hh * 16;
    const int vboff = 64 * DK_STR + (4 * hh + (i16 >> 2)) * DV_STR + (16 * blk + 4 * (i16 & 3)) * 2;
#pragma unroll 1
    for (int kt = 0; kt < nsteps; ++kt) {
        const LAS unsigned char* cur = lds + (kt & 1) * DBUF_BYTES; LAS unsigned char* nxt = lds + ((kt + 1) & 1) * DBUF_BYTES;
        if (kt + 1 < nsteps) { const unsigned so = soff + (unsigned)(kt + 1) * (64u * PLD * 2u); kr = *(const GAS u32x4*)(kgb + so); vr = *(const GAS u32x4*)(vgb + so); }
        if (kt < mysteps) {
            const int kbase = kt * 64;
            const bool near = (q0 - (kbase + 63) < 113);
#pragma unroll
            for (int m = 0; m < 2; ++m) {
                bf16x8 pk[2][2];
                f32x16 S[2]; float ts = 0.f;
                {   bf16x8 kf[2][2];
#pragma unroll
                    for (int t = 0; t < 2; ++t)
#pragma unroll
                        for (int s = 0; s < 2; ++s) kf[t][s] = *(const LAS bf16x8*)(cur + kboff + t * 32 * DK_STR + m * 64 + s * 32);
#pragma unroll
                    for (int t = 0; t < 2; ++t) { S[t] = MFMA32(kf[t][0], qf[m][0], negm[m]); S[t] = MFMA32(kf[t][1], qf[m][1], S[t]); } }
                if (near) {
#pragma unroll
                    for (int t = 0; t < 2; ++t)
#pragma unroll
                        for (int g = 0; g < 2; ++g) { float tb[8];
#pragma unroll
                            for (int j = 0; j < 8; ++j) { const int dist = q - (kbase + 32 * t + crow(8 * g + j, hh)); const int di = dist < 0 ? 0 : (dist < 128 ? dist : 128); tb[j] = bias2[di * 12 + 4 + h]; }
#pragma unroll
                            for (int j = 0; j < 8; ++j) { const int dist = q - (kbase + 32 * t + crow(8 * g + j, hh)); S[t][8 * g + j] += dist >= 0 ? tb[j] : -1e30f; }
                            __builtin_amdgcn_sched_barrier(0); } }
#pragma unroll
                for (int t = 0; t < 2; ++t)
#pragma unroll
                    for (int i = 0; i < 16; ++i) { const float p = __builtin_amdgcn_exp2f(S[t][i]); S[t][i] = p; ts += p; }
                if (__builtin_amdgcn_ballot_w64(!(ts < 1.0e30f)) != 0ull) {
                {   bf16x8 kf[2][2];
#pragma unroll
                        for (int t = 0; t < 2; ++t)
#pragma unroll
                            for (int s = 0; s < 2; ++s) kf[t][s] = *(const LAS bf16x8*)(cur + kboff + t * 32 * DK_STR + m * 64 + s * 32);
#pragma unroll
                        for (int t = 0; t < 2; ++t) { S[t] = MFMA32(kf[t][0], qf[m][0], negm[m]); S[t] = MFMA32(kf[t][1], qf[m][1], S[t]); } }
                    if (near) {
#pragma unroll
                        for (int t = 0; t < 2; ++t)
#pragma unroll
                            for (int g = 0; g < 2; ++g) { float tb[8];
#pragma unroll
                                for (int j = 0; j < 8; ++j) { const int dist = q - (kbase + 32 * t + crow(8 * g + j, hh)); const int di = dist < 0 ? 0 : (dist < 128 ? dist : 128); tb[j] = bias2[di * 12 + 4 + h]; }
#pragma unroll
                                for (int j = 0; j < 8; ++j) { const int dist = q - (kbase + 32 * t + crow(8 * g + j, hh)); S[t][8 * g + j] += dist >= 0 ? tb[j] : -1e30f; }
                                __builtin_amdgcn_sched_barrier(0); } }
                    float tm = fmaxf(max16(S[0]), max16(S[1])); tm = fmaxf(tm, xshfl<32>(tm));
                    const float sh = fmaxf(tm, 0.f); const float al = __builtin_amdgcn_exp2f(-sh);
                    lsum[m] *= al; ts = 0.f;
#pragma unroll
                    for (int i = 0; i < 16; ++i) { O[m][0][i] *= al; O[m][1][i] *= al; negm[m][i] -= sh; }
#pragma unroll
                    for (int t = 0; t < 2; ++t)
#pragma unroll
                        for (int i = 0; i < 16; ++i) { const float p = __builtin_amdgcn_exp2f(S[t][i] - sh); S[t][i] = p; ts += p; }
                }
                lsum[m] += ts;
#pragma unroll
                for (int t = 0; t < 2; ++t) { pk[t][0] = pack_half(S[t], 0); pk[t][1] = pack_half(S[t], 1); }
#pragma unroll
                for (int t = 0; t < 2; ++t)
#pragma unroll
                    for (int s2 = 0; s2 < 2; ++s2)
#pragma unroll
                        for (int db = 0; db < 2; ++db) {
                            const s16x4 lo = vtr(cur + vboff + (32 * t + 16 * s2) * DV_STR + db * 64), hi = vtr(cur + vboff + (32 * t + 16 * s2 + 8) * DV_STR + db * 64);
                            const bf16x8 vf = __builtin_shufflevector(lo, hi, 0, 1, 2, 3, 4, 5, 6, 7);
                            O[m][db] = MFMA32(vf, pk[t][s2], O[m][db]); }
                ;
            }
        }
        if (kt + 1 < nsteps) { *(LAS u32x4*)(nxt + skey * DK_STR + sch * 16) = kr; *(LAS u32x4*)(nxt + 64 * DK_STR + skey * DV_STR + sch * 16) = vr; }
        __syncthreads();
    }
    const float l0 = lsum[0] + xshfl<32>(lsum[0]), l1 = lsum[1] + xshfl<32>(lsum[1]);
    const float lam = lamp[0], lam_init = lamp[1];
    const float i0 = 1.f / fmaxf(l0, 1e-30f), i1 = lam / fmaxf(l1, 1e-30f);
    float ss = 0.f;
#pragma unroll
    for (int db = 0; db < 2; ++db)
#pragma unroll
        for (int i = 0; i < 16; ++i) { const float at = O[0][db][i] * i0 - O[1][db][i] * i1; O[0][db][i] = at; ss += at * at; }
    ss += xshfl<32>(ss);
    const float r = (1.f - lam_init) / sqrtf(ss * (1.f / 64.f) + 1e-5f);
    GAS bf16* op = ys + (rowb + q) * 1024 + 512 + h * 64;
#pragma unroll
    for (int db = 0; db < 2; ++db)
#pragma unroll
        for (int gq = 0; gq < 4; ++gq) { const int d0 = 32 * db + 8 * gq + 4 * hh; const f32x4 sg = *(const GAS f32x4*)(subg + d0);
            u32x2 w; w.x = cvtpk(O[0][db][4 * gq + 0] * r * sg[0], O[0][db][4 * gq + 1] * r * sg[1]); w.y = cvtpk(O[0][db][4 * gq + 2] * r * sg[2], O[0][db][4 * gq + 3] * r * sg[3]);
            *(GAS u32x2*)(op + d0) = w; }
}

struct SchedCmp { const char* proj; const char* wc; int G, c;
    DI bool next(int i, Unit& u) const { const int L = i * G + c; if (L >= 16) return false; const int kv = L >> 3, rt = L & 7;
        u.pm = rt; u.pn = 0; u.aux = kv; u.pad = 0; u.a = proj + ((size_t)rt * 256 * 16 * PLD + (kv ? C_VC : C_KC)) * 2; u.b = wc + (size_t)kv * 256 * 1024 * 2; return true; } };
struct EpiCmp { static constexpr bool CARRY = false; float* ab;
    DI void operator()(const f32x4 (&acc)[2][2][4][2], const Unit& u, int wr, int wc, int fr, int fq) const {
        const int row0 = u.pm * 256 + wr * 64 + fr; const int col = wc * 32 + 8 * fq;
#pragma unroll
        for (int ai = 0; ai < 2; ++ai)
#pragma unroll
            for (int m = 0; m < 4; ++m) { float* rp = ab + ((size_t)u.aux * 2048 + row0 + ai * 128 + m * 16) * 128 + col; *(f32x4*)rp = acc[ai][0][m][0]; *(f32x4*)(rp + 4) = acc[ai][0][m][1]; }
    }
};
DI void cmp_finish(const KA& a, int l, const float* ab, bf16* kcb, int task, int lane) {
    const int kv = task / (BATCH * NCMP), r = task % (BATCH * NCMP), b = r / NCMP, c = r % NCMP;
    const float* w2 = a.in[kv ? 23 : 20] + (size_t)l * 4096; const float* pt = ab + 2 * 2048 * 128;
    const size_t g = (size_t)kv * 2048 + b * 512 + c;
    float ptv = 0.f;
#pragma unroll
    for (int part = 0; part < 32; ++part) ptv += pt[(kv * 32 + part) * 64 + lane];
    const float h1 = ab[g * 128 + lane] + ab[(g + 1) * 128 + 64 + lane] + ptv;
    const float gl = gelu_tanh(h1); float o = 0.f;
#pragma unroll
    for (int j = 0; j < 64; ++j) o += rl(gl, j) * w2[j * 64 + lane];
    kcb[((size_t)(kv * BATCH + b) * 512 + c) * 64 + lane] = (bf16)f2bf(o);
    if (c == NCMP - 1) kcb[((size_t)(kv * BATCH + b) * 512 + NCMP) * 64 + lane] = 0;
}

DI void cmp_block(const KA& a, int l, const GAS bf16* proj, const GAS bf16* wcT, float* ab, bf16* kcb, int bid, int wave, int lane) {
    const int kv = bid >> 7, g0 = (bid & 127) * 16, r = lane & 15, q = lane >> 4, sh = wave >> 2;
    const int grow = g0 + r + sh; const bool st_ok = !(sh != 0 && (grow & 511) == 0);
    const int gld = grow > 2047 ? 2047 : grow;
    const GAS bf16* apn = proj + (size_t)gld * 16 * PLD + (kv ? C_VC : C_KC) + 8 * q;
    const GAS bf16* bpn = wcT + ((size_t)kv * 256 + wave * 16 + r) * 1024 + 8 * q;
    f32x4 acc = {0.f, 0.f, 0.f, 0.f};
#pragma unroll 16
    for (int s = 0; s < 32; ++s) {
        const bf16x8 av = *(const GAS bf16x8*)(apn + (size_t)(s >> 1) * PLD + 32 * (s & 1));
        const bf16x8 bv = *(const GAS bf16x8*)(bpn + 32 * s);
        acc = __builtin_amdgcn_mfma_f32_16x16x32_bf16(bv, av, acc, 0, 0, 0);
    }
    if (st_ok) *(GAS f32x4*)((GAS float*)ab + ((size_t)kv * 2048 + grow) * 128 + wave * 16 + 4 * q) = acc;
    VM_WAIT(); __syncthreads();
    {   const float* w2 = a.in[kv ? 23 : 20] + (size_t)l * 4096; const float* pt = ab + 2 * 2048 * 128;
        const int ga = g0 + 2 * wave; const size_t gA = (size_t)kv * 2048 + ga;
        float ptp[32], w2v[64], hA[3], hB[3];
#pragma unroll
        for (int part = 0; part < 32; ++part) ptp[part] = pt[(kv * 32 + part) * 64 + lane];
#pragma unroll
        for (int i = 0; i < 2; ++i) { hA[i] = ab[(gA + i) * 128 + lane]; hB[i] = ab[(gA + i + 1) * 128 + 64 + lane]; }
#pragma unroll
        for (int j = 0; j < 64; ++j) w2v[j] = w2[j * 64 + lane];
        float ptv = 0.f;
#pragma unroll
        for (int part = 0; part < 32; ++part) ptv += ptp[part];
#pragma unroll
        for (int i = 0; i < 2; ++i) { const int g = ga + i, c = g & 511, b = g >> 9;
            if (c < NCMP) {
                const float gl = gelu_tanh(hA[i] + hB[i] + ptv); float o = 0.f;
#pragma unroll
                for (int j = 0; j < 64; ++j) o += rl(gl, j) * w2v[j];
                kcb[((size_t)(kv * BATCH + b) * 512 + c) * 64 + lane] = (bf16)f2bf(o);
                if (c == NCMP - 1) kcb[((size_t)(kv * BATCH + b) * 512 + NCMP) * 64 + lane] = 0; } }
    }
}

DI void st_load(const GAS unsigned char* kb, const GAS unsigned char* vb, unsigned off, u32x4& kr, u32x4& vr) { kr = *(const GAS u32x4*)(kb + off); vr = *(const GAS u32x4*)(vb + off); }
DI void st_write(LAS unsigned char* buf, int skey, int sch, const u32x4& kr, const u32x4& vr) { *(LAS u32x4*)(buf + skey * DK_STR + sch * 16) = kr; *(LAS u32x4*)(buf + 64 * DK_STR + skey * DV_STR + sch * 16) = vr; }
DI void qk64(const LAS unsigned char* cur, int kboff, const bf16x8 (&qf)[4], const f32x16& cinit, f32x16 (&S)[2]) {
#pragma unroll
    for (int t = 0; t < 2; ++t) { S[t] = cinit;
#pragma unroll
        for (int s = 0; s < 4; ++s) { const bf16x8 kf = *(const LAS bf16x8*)(cur + kboff + t * 32 * DK_STR + s * 32); S[t] = MFMA32(kf, qf[s], S[t]); } }
}
DI void qk32z(const LAS unsigned char* kt32, const bf16x8 (&qf)[4], f32x16& S) {
#pragma unroll
    for (int s = 0; s < 4; ++s) { const bf16x8 kf = *(const LAS bf16x8*)(kt32 + s * 32);
        if (s == 0) { f32x16 z;
#pragma unroll
            for (int i = 0; i < 16; ++i) z[i] = 0.f;
            S = MFMA32(kf, qf[s], z); } else S = MFMA32(kf, qf[s], S); }
}
DI void pv32(const LAS unsigned char* vt32, const bf16x8 (&pk)[2], f32x16 (&O)[2]) {
#pragma unroll
    for (int s2 = 0; s2 < 2; ++s2)
#pragma unroll
        for (int db = 0; db < 2; ++db) {
            const s16x4 lo = vtr(vt32 + (16 * s2) * DV_STR + db * 64), hi = vtr(vt32 + (16 * s2 + 8) * DV_STR + db * 64);
            const bf16x8 vf = __builtin_shufflevector(lo, hi, 0, 1, 2, 3, 4, 5, 6, 7);
            O[db] = MFMA32(vf, pk[s2], O[db]); }
}
DI void mask_bias_cmp32(f32x16& S, int tcol_in, int cbase, int hh, const LAS float* b2h, float msub) {
    int tcol = tcol_in; asm volatile("" : "+v"(tcol));
#pragma unroll
    for (int g = 0; g < 2; ++g) {
        float bv[8];
#pragma unroll
        for (int j = 0; j < 8; ++j) { const int i = 8 * g + j; const int c = cbase + crow(i, hh); const int dist = tcol - 31 - 16 * c; const int di = dist < 0 ? 0 : (dist < 128 ? dist : 128); bv[j] = b2h[di * 12]; }
#pragma unroll
        for (int j = 0; j < 8; ++j) { const int i = 8 * g + j; const int c = cbase + crow(i, hh); const int dist = tcol - 31 - 16 * c; const bool ok = dist >= 0 && c < NCMP;
            const float sb = S[i] + (bv[j] - msub); S[i] = ok ? sb : -1e30f; }
        __builtin_amdgcn_sched_barrier(0); }
}
DI void pv64(const LAS unsigned char* cur, int vboff, const bf16x8 (&pk)[2][2], f32x16 (&O)[2]) {
#pragma unroll
    for (int t = 0; t < 2; ++t)
#pragma unroll
        for (int s2 = 0; s2 < 2; ++s2)
#pragma unroll
            for (int db = 0; db < 2; ++db) {
                const s16x4 lo = vtr(cur + vboff + (32 * t + 16 * s2) * DV_STR + db * 64), hi = vtr(cur + vboff + (32 * t + 16 * s2 + 8) * DV_STR + db * 64);
                const bf16x8 vf = __builtin_shufflevector(lo, hi, 0, 1, 2, 3, 4, 5, 6, 7);
                O[db] = MFMA32(vf, pk[t][s2], O[db]); }
}
DI void softmax_step(f32x16 (&S)[2], f32x16 (&O)[2], f32x16& negm, float& lsum, bf16x8 (&pk)[2][2]) {
    float tm = fmaxf(max16(S[0]), max16(S[1]));
    if (__builtin_amdgcn_ballot_w64(tm > 8.f) != 0ull) {
        tm = fmaxf(tm, xshfl<32>(tm)); const float sh = fmaxf(tm, 0.f); const float al = __builtin_amdgcn_exp2f(-sh);
        lsum *= al;
#pragma unroll
        for (int i = 0; i < 16; ++i) { O[0][i] *= al; O[1][i] *= al; negm[i] -= sh; S[0][i] -= sh; S[1][i] -= sh; } }
#pragma unroll
    for (int t = 0; t < 2; ++t) {
#pragma unroll
        for (int i = 0; i < 16; ++i) { const float p = __builtin_amdgcn_exp2f(S[t][i]); S[t][i] = p; lsum += p; }
        pk[t][0] = pack_half(S[t], 0); pk[t][1] = pack_half(S[t], 1); }
}
DI void mask_bias(f32x16 (&S)[2], int tcol_in, int kbase, int hh, int W, bool colsel, const LAS float* b2h) {
    int tcol = tcol_in; asm volatile("" : "+v"(tcol));
#pragma unroll
    for (int t = 0; t < 2; ++t)
#pragma unroll
        for (int g = 0; g < 2; ++g) {
            float bv[8];
#pragma unroll
            for (int j = 0; j < 8; ++j) { const int i = 8 * g + j; const int dist = tcol - (kbase + 32 * t + crow(i, hh)); const int di = dist < 0 ? 0 : (dist < 128 ? dist : 128); bv[j] = b2h[di * 12]; }
#pragma unroll
            for (int j = 0; j < 8; ++j) { const int i = 8 * g + j; const int dist = tcol - (kbase + 32 * t + crow(i, hh)); const bool ok = colsel && dist >= 0 && dist < W;
                const float sb = S[t][i] + bv[j]; S[t][i] = ok ? sb : -1e30f; }
            __builtin_amdgcn_sched_barrier(0); }
}
DI void sel_tile(const LAS unsigned char* cur, int kboff, int vboff, const bf16x8 (&qf)[4], f32x16 (&Os)[2], f32x16& negm, float& lsel, bool near, bool bit, int t, int kbase, int hh, int W, const LAS float* b2h) {
    f32x16 S[2]; qk64(cur, kboff, qf, negm, S);
    if (near) mask_bias(S, t, kbase, hh, W, bit, b2h);
    float ts = 0.f;
#pragma unroll
    for (int tt = 0; tt < 2; ++tt)
#pragma unroll
        for (int i = 0; i < 16; ++i) { const float p = __builtin_amdgcn_exp2f(S[tt][i]); S[tt][i] = p; ts += p; }
    ts = bit ? ts : 0.f;
    if (__builtin_amdgcn_ballot_w64(!(ts < 1.0e30f)) != 0ull) {
        qk64(cur, kboff, qf, negm, S);
        if (near) mask_bias(S, t, kbase, hh, W, bit, b2h);
        float tm = fmaxf(max16(S[0]), max16(S[1])); tm = bit ? tm : -1e30f; tm = fmaxf(tm, xshfl<32>(tm));
        const float sh = fmaxf(tm, 0.f); const float al = __builtin_amdgcn_exp2f(-sh);
        lsel *= al; ts = 0.f;
#pragma unroll
        for (int i = 0; i < 16; ++i) { Os[0][i] *= al; Os[1][i] *= al; negm[i] -= sh; }
#pragma unroll
        for (int tt = 0; tt < 2; ++tt)
#pragma unroll
            for (int i = 0; i < 16; ++i) { const float p = __builtin_amdgcn_exp2f(S[tt][i] - sh); S[tt][i] = p; ts += p; }
        ts = bit ? ts : 0.f;
    }
    lsel += ts;
    const unsigned km = bit ? 0xFFFFFFFFu : 0u; bf16x8 pk[2][2];
#pragma unroll
    for (int tt = 0; tt < 2; ++tt)
#pragma unroll
        for (int hf = 0; hf < 2; ++hf) { u32x4 w = __builtin_bit_cast(u32x4, pack_half(S[tt], hf)); w.x &= km; w.y &= km; w.z &= km; w.w &= km; pk[tt][hf] = __builtin_bit_cast(bf16x8, w); }
    pv64(cur, vboff, pk, Os);
}
DI void nsa_unit(const GAS bf16* proj, GAS bf16* ys, const GAS bf16* kcb, LAS unsigned char* lds, const LAS float* bias2, int b, int u, int tid_in, int lane_in, int wave_in) {
    (void)tid_in; (void)lane_in; int wave = wave_in; asm volatile("" : "+s"(wave)); const int lane = my_lane(); const int tid = wave * 64 + lane;
    const int t0 = u * 64; const int col = lane & 31, hh = lane >> 5, tl = col >> 2, head = col & 3;
    const int t = t0 + wave * 8 + tl; const int tw0 = t0 + wave * 8;
    const size_t rowb = (size_t)b * SEQ;
    const LAS float* b2h = bias2 + 8 + head;
    bf16x8 qf[4];
    { const float SC = 0.125f * 1.4426950408889634f; const GAS bf16* qp = proj + (rowb + t) * PLD + C_DQ + head * 64 + hh * 8;
#pragma unroll
      for (int s = 0; s < 4; ++s) { const u32x4 w = *(const GAS u32x4*)(qp + s * 16); u32x4 o;
          o.x = cvtpk(lo_bf(w.x) * SC, hi_bf(w.x) * SC); o.y = cvtpk(lo_bf(w.y) * SC, hi_bf(w.y) * SC); o.z = cvtpk(lo_bf(w.z) * SC, hi_bf(w.z) * SC); o.w = cvtpk(lo_bf(w.w) * SC, hi_bf(w.w) * SC);
          qf[s] = __builtin_bit_cast(bf16x8, o); } }
    const int skey = tid >> 3, sch = tid & 7;
    const int i16 = lane & 15, blk = (lane >> 4) & 1;
    const int kboff = col * DK_STR + hh * 16;
    const int vboff = 64 * DK_STR + (4 * hh + (i16 >> 2)) * DV_STR + (16 * blk + 4 * (i16 & 3)) * 2;
    u32x4 kr, vr;
    const int ncvm = (4 * u + 3) < NCMP ? (4 * u + 3) : NCMP;
    const int nsc = (ncvm + 63) >> 6;
    const GAS unsigned char* kcp = (const GAS unsigned char*)(kcb + (size_t)(0 * BATCH + b) * 512 * 64);
    const GAS unsigned char* vcp = (const GAS unsigned char*)(kcb + (size_t)(1 * BATCH + b) * 512 * 64);
    const unsigned soffc = (unsigned)(skey * 64 + sch * 8) * 2u;
    float m1 = -120.f, l1 = 0.f;
    st_load(kcp, vcp, soffc, kr, vr); st_write(lds, skey, sch, kr, vr); __syncthreads();
#pragma unroll 1
    for (int kt = 0; kt < nsc; ++kt) {
        const LAS unsigned char* cur = lds + (kt & 1) * DBUF_BYTES; LAS unsigned char* nxt = lds + ((kt + 1) & 1) * DBUF_BYTES;
        if (kt + 1 < nsc) st_load(kcp, vcp, soffc + (unsigned)(kt + 1) * 8192u, kr, vr);
#pragma unroll
        for (int tt = 0; tt < 2; ++tt) { f32x16 S; qk32z(cur + kboff + tt * 32 * DK_STR, qf, S); mask_bias_cmp32(S, t, kt * 64 + tt * 32, hh, b2h, 0.f);
          const float tm = max16(S); const float mn = fmaxf(m1, tm); float acc = 0.f;
#pragma unroll
          for (int i = 0; i < 16; ++i) acc += __builtin_amdgcn_exp2f(S[i] - mn);
          l1 = l1 * __builtin_amdgcn_exp2f(m1 - mn) + acc; m1 = mn; }
        if (kt + 1 < nsc) st_write(nxt, skey, sch, kr, vr);
        __syncthreads();
    }
    float mf, inv;
    { const float mo = xshfl<32>(m1), lo = xshfl<32>(l1); mf = fmaxf(m1, mo); const float lf = l1 * __builtin_amdgcn_exp2f(m1 - mf) + lo * __builtin_amdgcn_exp2f(mo - mf); inv = lf > 0.f ? 1.f / lf : 0.f; }
    f32x16 Oc[2], imp[4];
#pragma unroll
    for (int i = 0; i < 16; ++i) { Oc[0][i] = 0.f; Oc[1][i] = 0.f; imp[0][i] = 0.f; imp[1][i] = 0.f; imp[2][i] = 0.f; imp[3][i] = 0.f; }
    {   st_load(kcp, vcp, soffc, kr, vr); st_write(lds, skey, sch, kr, vr); __syncthreads();
#pragma unroll 1
        for (int kt = 0; kt < nsc; ++kt) {
            const LAS unsigned char* cur = lds + (kt & 1) * DBUF_BYTES; LAS unsigned char* nxt = lds + ((kt + 1) & 1) * DBUF_BYTES;
            if (kt + 1 < nsc) st_load(kcp, vcp, soffc + (unsigned)(kt + 1) * 8192u, kr, vr);
#pragma unroll
            for (int tt = 0; tt < 2; ++tt) {
                f32x16 S; qk32z(cur + kboff + tt * 32 * DK_STR, qf, S); mask_bias_cmp32(S, t, kt * 64 + tt * 32, hh, b2h, mf);
#pragma unroll
                for (int i = 0; i < 16; ++i) S[i] = __builtin_amdgcn_exp2f(S[i]) * inv;
                bf16x8 pk[2]; pk[0] = pack_half(S, 0); pk[1] = pack_half(S, 1);
                pv32(cur + vboff + tt * 32 * DV_STR, pk, Oc);
                const int Tq = (2 * kt + tt) & 3, MB = (2 * kt + tt) >> 2;
#pragma unroll
                for (int s2 = 0; s2 < 2; ++s2) { u32x4 aw; unsigned e[8];
#pragma unroll
                    for (int jj = 0; jj < 8; ++jj) { const int kk = 16 * s2 + 8 * (jj >> 2) + 4 * hh + (jj & 3); const int delta = 32 * Tq + kk - 4 * col;
                        e[jj] = (delta == -1 || delta == 3) ? 0x3F80u : ((unsigned)delta <= 2u ? 0x4000u : 0u); }
                    aw.x = e[0] | (e[1] << 16); aw.y = e[2] | (e[3] << 16); aw.z = e[4] | (e[5] << 16); aw.w = e[6] | (e[7] << 16);
                    const bf16x8 af = __builtin_bit_cast(bf16x8, aw);
                    if (MB == 0) imp[0] = MFMA32(af, pk[s2], imp[0]); else if (MB == 1) imp[1] = MFMA32(af, pk[s2], imp[1]); else if (MB == 2) imp[2] = MFMA32(af, pk[s2], imp[2]); else imp[3] = MFMA32(af, pk[s2], imp[3]); }
                if (Tq == 3 && MB < 3) { u32x4 aw; aw.x = 0u; aw.y = 0u; aw.z = 0u; aw.w = (lane == 32) ? 0x3F800000u : 0u;
                    const bf16x8 af = __builtin_bit_cast(bf16x8, aw);
                    if (MB == 0) imp[1] = MFMA32(af, pk[1], imp[1]); else if (MB == 1) imp[2] = MFMA32(af, pk[1], imp[2]); else imp[3] = MFMA32(af, pk[1], imp[3]); }
            }
            if (kt + 1 < nsc) st_write(nxt, skey, sch, kr, vr);
            __syncthreads();
        }
    }
    unsigned ocp[2][8];
#pragma unroll
    for (int db = 0; db < 2; ++db)
#pragma unroll
        for (int i = 0; i < 8; ++i) ocp[db][i] = cvtpk(Oc[db][2 * i], Oc[db][2 * i + 1]);
    unsigned sm0 = 0u, sm1 = 0u, sm2 = 0u, sm3 = 0u;
    {   const int cur_t = t >> 6; unsigned key[16];
#pragma unroll
        for (int i = 0; i < 16; ++i) {
            float v0 = imp[0][i], v1 = imp[1][i], v2 = imp[2][i], v3 = imp[3][i];
            v0 += xshfl<1>(v0); v0 += xshfl<2>(v0); v1 += xshfl<1>(v1); v1 += xshfl<2>(v1); v2 += xshfl<1>(v2); v2 += xshfl<2>(v2); v3 += xshfl<1>(v3); v3 += xshfl<2>(v3);
            const float val = head == 0 ? v0 : (head == 1 ? v1 : (head == 2 ? v2 : v3));
            const int j = 32 * head + crow(i, hh);
            const bool forced = (j == 0) || (j == cur_t) || (j == cur_t - 1);
            unsigned fx = (unsigned)(fminf(fmaxf(val, 0.f), 31.f) * 1048576.f) + 1u;
            fx = forced ? 0x1FFFFFFu : (j <= cur_t ? fx : 0u);
            key[i] = (fx << 7) | (unsigned)(127 - j); }
#pragma unroll 1
        for (int r = 0; r < 16; ++r) {
            unsigned w = key[0];
#pragma unroll
            for (int i = 1; i < 16; ++i) w = w > key[i] ? w : key[i];
            { unsigned o = (unsigned)xshfl_i<1>((int)w); w = w > o ? w : o; o = (unsigned)xshfl_i<2>((int)w); w = w > o ? w : o; o = (unsigned)xshfl_i<32>((int)w); w = w > o ? w : o; }
            if ((w >> 7) != 0u) { const int j = 127 - (int)(w & 127u); const unsigned bit = 1u << (j & 31); const int jb = j >> 5;
                sm0 |= (jb == 0) ? bit : 0u; sm1 |= (jb == 1) ? bit : 0u; sm2 |= (jb == 2) ? bit : 0u; sm3 |= (jb == 3) ? bit : 0u; }
#pragma unroll
            for (int i = 0; i < 16; ++i) key[i] = (key[i] == w) ? 0u : key[i];
        }
    }
    f32x16 Ow[2]; float lw = 0.f;
#pragma unroll
    for (int i = 0; i < 16; ++i) { Ow[0][i] = 0.f; Ow[1][i] = 0.f; }
    {   f32x16 negm;
#pragma unroll
        for (int i = 0; i < 16; ++i) negm[i] = 120.f;
        const GAS unsigned char* kwp = (const GAS unsigned char*)(proj + rowb * PLD + C_KW); const GAS unsigned char* vwp = (const GAS unsigned char*)(proj + rowb * PLD + C_VW);
        const unsigned soffp = (unsigned)(skey * PLD + sch * 8) * 2u;
        const int s0 = (u < 8) ? 8 - u : 0;
        st_load(kwp, vwp, soffp + (unsigned)(u - 8 + s0) * (64u * PLD * 2u), kr, vr); st_write(lds, skey, sch, kr, vr); __syncthreads();
#pragma unroll 1
        for (int s = s0; s < 9; ++s) {
            const int par = (s - s0) & 1; const LAS unsigned char* cur = lds + par * DBUF_BYTES; LAS unsigned char* nxt = lds + (par ^ 1) * DBUF_BYTES;
            if (s + 1 < 9) st_load(kwp, vwp, soffp + (unsigned)(u - 8 + s + 1) * (64u * PLD * 2u), kr, vr);
            sel_tile(cur, kboff, vboff, qf, Ow, negm, lw, s == 0 || s >= 6, true, t, (u - 8 + s) * 64, hh, 512, b2h);
            if (s + 1 < 9) st_write(nxt, skey, sch, kr, vr);
            __syncthreads();
        }
    }
    unsigned owp[2][8];
#pragma unroll
    for (int db = 0; db < 2; ++db)
#pragma unroll
        for (int i = 0; i < 8; ++i) owp[db][i] = cvtpk(Ow[db][2 * i], Ow[db][2 * i + 1]);
    f32x16 Os[2]; float lsel = 0.f;
#pragma unroll
    for (int i = 0; i < 16; ++i) { Os[0][i] = 0.f; Os[1][i] = 0.f; }
    {   f32x16 negm;
#pragma unroll
        for (int i = 0; i < 16; ++i) negm[i] = 120.f;
        const GAS unsigned char* ksp = (const GAS unsigned char*)(proj + rowb * PLD + C_KS); const GAS unsigned char* vsp = (const GAS unsigned char*)(proj + rowb * PLD + C_VS);
        const unsigned soffp = (unsigned)(skey * PLD + sch * 8) * 2u;
        u32x4 kA, vA, kB, vB;
        st_load(ksp, vsp, soffp, kr, vr); st_write(lds, skey, sch, kr, vr);
        if (u >= 1) st_load(ksp, vsp, soffp + 64u * PLD * 2u, kA, vA);
        __syncthreads();
#define SEL_STEP(J, KX, VX, KY, VY) { const int j_ = (J); \
            const LAS unsigned char* cur = lds + (j_ & 1) * DBUF_BYTES; LAS unsigned char* nxt = lds + ((j_ + 1) & 1) * DBUF_BYTES; \
            if (j_ + 2 <= u) st_load(ksp, vsp, soffp + (unsigned)(j_ + 2) * (64u * PLD * 2u), KY, VY); \
            const int jb = j_ >> 5; const unsigned smw = jb == 0 ? sm0 : (jb == 1 ? sm1 : (jb == 2 ? sm2 : sm3)); \
            const bool bit = ((smw >> (j_ & 31)) & 1u) != 0u; \
            if (__builtin_amdgcn_ballot_w64(bit) != 0ull) sel_tile(cur, kboff, vboff, qf, Os, negm, lsel, 64 * j_ + 63 > tw0 - 113, bit, t, 64 * j_, hh, 1 << 30, b2h); \
            if (j_ + 1 <= u) st_write(nxt, skey, sch, KX, VX); \
            __syncthreads(); }
#pragma unroll 1
        for (int j = 0; j <= u; j += 2) {
            SEL_STEP(j, kA, vA, kB, vB)
            if (j + 1 <= u) SEL_STEP(j + 1, kB, vB, kA, vA)
        }
#undef SEL_STEP
    }
    {   const float lwt = lw + xshfl<32>(lw), lst = lsel + xshfl<32>(lsel);
        const GAS bf16* gp = proj + (rowb + t) * PLD + C_DG + head * 3;
        const float g0 = sigmoidf_(bf2f(gp[0])), g1 = sigmoidf_(bf2f(gp[1])) / fmaxf(lst, 1e-30f), g2 = sigmoidf_(bf2f(gp[2])) / fmaxf(lwt, 1e-30f);
        GAS bf16* op = ys + (rowb + t) * 1024 + 768 + head * 64;
#pragma unroll
        for (int db = 0; db < 2; ++db)
#pragma unroll
            for (int gq = 0; gq < 4; ++gq) { const int d0 = 32 * db + 8 * gq + 4 * hh; float y[4];
#pragma unroll
                for (int e = 0; e < 4; ++e) { const unsigned cw = ocp[db][2 * gq + (e >> 1)], ww = owp[db][2 * gq + (e >> 1)];
                    y[e] = g0 * ((e & 1) ? hi_bf(cw) : lo_bf(cw)) + g1 * Os[db][4 * gq + e] + g2 * ((e & 1) ? hi_bf(ww) : lo_bf(ww)); }
                u32x2 w; w.x = cvtpk(y[0], y[1]); w.y = cvtpk(y[2], y[3]); *(GAS u32x2*)(op + d0) = w; }
    }
}


DI void swa_unit(const GAS bf16* proj, GAS bf16* ys, LAS unsigned char* lds, const LAS float* bias2, const LAS float* biasd, const GAS float* sinks, int b, int u, int tid_in, int lane_in, int wave_in) {
    int tid = tid_in, lane = lane_in, wave = wave_in; asm volatile("" : "+v"(tid), "+v"(lane), "+s"(wave));
    const int t0 = u * 64; const int col = lane & 31, hh = lane >> 5, tl = col >> 1, kv = wave & 1, head = 2 * kv + (col & 1);
    const int t = t0 + (wave >> 1) * 16 + tl;
    const size_t rowb = (size_t)b * SEQ;
    const LAS float* b2h = bias2 + head;
    bf16x8 qf[4];
    { const float SC = 0.125f * 1.4426950408889634f; const GAS bf16* qp = proj + (rowb + t) * PLD + C_BQ + head * 64 + hh * 8;
#pragma unroll
      for (int s = 0; s < 4; ++s) { const u32x4 w = *(const GAS u32x4*)(qp + s * 16); u32x4 o;
          o.x = cvtpk(lo_bf(w.x) * SC, hi_bf(w.x) * SC); o.y = cvtpk(lo_bf(w.y) * SC, hi_bf(w.y) * SC); o.z = cvtpk(lo_bf(w.z) * SC, hi_bf(w.z) * SC); o.w = cvtpk(lo_bf(w.w) * SC, hi_bf(w.w) * SC);
          qf[s] = __builtin_bit_cast(bf16x8, o); } }
    const int skey = tid >> 3, sch = tid & 7;
    const int i16 = lane & 15, blk = (lane >> 4) & 1;
    const int kboff = kv * DBUF_BYTES + col * DK_STR + hh * 16;
    const int vboff = kv * DBUF_BYTES + 64 * DK_STR + (4 * hh + (i16 >> 2)) * DV_STR + (16 * blk + 4 * (i16 & 3)) * 2;
    const GAS unsigned char* kp = (const GAS unsigned char*)(proj + rowb * PLD + C_BK); const GAS unsigned char* vp = (const GAS unsigned char*)(proj + rowb * PLD + C_BV);
    const unsigned soffp = (unsigned)(skey * PLD + sch * 8) * 2u;
    u32x4 k0, v0, k1, v1;
    f32x16 O[2], negm; float lsum = 0.f;
#pragma unroll
    for (int i = 0; i < 16; ++i) { O[0][i] = 0.f; O[1][i] = 0.f; negm[i] = 120.f; }
    const int s0 = (u < 2) ? 2 - u : 0;
    { const unsigned so = soffp + (unsigned)(u - 2 + s0) * (64u * PLD * 2u); st_load(kp, vp, so, k0, v0); st_load(kp + 128, vp + 128, so, k1, v1);
      st_write(lds, skey, sch, k0, v0); st_write(lds + DBUF_BYTES, skey, sch, k1, v1); }
    __syncthreads();
#pragma unroll 1
    for (int s = s0; s < 3; ++s) {
        const int par = (s - s0) & 1; const LAS unsigned char* cur = lds + par * 2 * DBUF_BYTES; LAS unsigned char* nxt = lds + (par ^ 1) * 2 * DBUF_BYTES;
        if (s + 1 < 3) { const unsigned so = soffp + (unsigned)(u - 2 + s + 1) * (64u * PLD * 2u); st_load(kp, vp, so, k0, v0); st_load(kp + 128, vp + 128, so, k1, v1); }
        sel_tile(cur, kboff, vboff, qf, O, negm, lsum, true, true, t, (u - 2 + s) * 64, hh, 128, b2h);
        if (s + 1 < 3) { st_write(nxt, skey, sch, k0, v0); st_write(nxt + DBUF_BYTES, skey, sch, k1, v1); }
        __syncthreads();
    }
    {   const float sinkp = (sinks[head] - biasd[128 * 12 + head]) * 1.4426950408889634f;
        const float lt = lsum + xshfl<32>(lsum) + __builtin_amdgcn_exp2f(sinkp + negm[0]);
        const float inv = 1.f / fmaxf(lt, 1e-30f);
        GAS bf16* op = ys + (rowb + t) * 1024 + 256 + head * 64;
#pragma unroll
        for (int db = 0; db < 2; ++db)
#pragma unroll
            for (int gq = 0; gq < 4; ++gq) { const int d0 = 32 * db + 8 * gq + 4 * hh;
                u32x2 w; w.x = cvtpk(O[db][4 * gq + 0] * inv, O[db][4 * gq + 1] * inv); w.y = cvtpk(O[db][4 * gq + 2] * inv, O[db][4 * gq + 3] * inv); *(GAS u32x2*)(op + d0) = w; }
    }
}

DI void route_rows_load(const KA& a, int tok0, int lane, u32x2 (&raw)[4][4]) {
    const GAS bf16* xrow = (const GAS bf16*)(a.ws + WS_XB) + (size_t)tok0 * 1024;
#pragma unroll
    for (int rr = 0; rr < 4; ++rr)
#pragma unroll
        for (int j = 0; j < 4; ++j) raw[rr][j] = *(const GAS u32x2*)(xrow + (size_t)rr * 1024 + 4 * (lane + 64 * j));
}
DI void route_rows4(const u32x2 (&raw)[4][4], const f32x4 (&gvv)[4], bf16* xr_, int tok0, int lane) {
    GAS bf16* xr = (GAS bf16*)xr_;
    f32x4 v[4][4]; float ss[4];
#pragma unroll
    for (int rr = 0; rr < 4; ++rr)
#pragma unroll
        for (int j = 0; j < 4; ++j) { v[rr][j][0] = lo_bf(raw[rr][j].x); v[rr][j][1] = hi_bf(raw[rr][j].x); v[rr][j][2] = lo_bf(raw[rr][j].y); v[rr][j][3] = hi_bf(raw[rr][j].y); }
#pragma unroll
    for (int rr = 0; rr < 4; ++rr) { float t = 0.f;
#pragma unroll
        for (int j = 0; j < 4; ++j) t += (v[rr][j][0] * v[rr][j][0] + v[rr][j][1] * v[rr][j][1]) + (v[rr][j][2] * v[rr][j][2] + v[rr][j][3] * v[rr][j][3]);
        ss[rr] = t; }
#pragma unroll
    for (int rr = 0; rr < 4; ++rr) { ss[rr] = wave_sum(ss[rr]); ss[rr] = __builtin_amdgcn_rsqf(ss[rr] * (1.f / 1024.f) + 1e-6f); }
#pragma unroll
    for (int j = 0; j < 4; ++j) { const int k0 = 4 * (lane + 64 * j); const f32x4 gv = gvv[j];
#pragma unroll
        for (int rr = 0; rr < 4; ++rr) { const f32x4 xn = v[rr][j] * ss[rr] * gv;
            u32x2 wh, wl; wh.x = pk2(xn[0], xn[1]); wh.y = pk2(xn[2], xn[3]);
            wl.x = pk2(xn[0] - __builtin_bit_cast(float, wh.x << 16), xn[1] - __builtin_bit_cast(float, wh.x & 0xFFFF0000u));
            wl.y = pk2(xn[2] - __builtin_bit_cast(float, wh.y << 16), xn[3] - __builtin_bit_cast(float, wh.y & 0xFFFF0000u));
            *(GAS u32x2*)(xr + (size_t)(tok0 + rr) * 2048 + k0) = wh; *(GAS u32x2*)(xr + (size_t)(tok0 + rr) * 2048 + 1024 + k0) = wl; } }
}
struct SchedRoute { const char* A; const char* B; int pm;
    DI bool next(int i, Unit& u) const { if (i > 0) return false; u.pm = pm; u.pn = 0; u.aux = 0; u.pad = 0; u.a = A + (size_t)pm * 128 * 2048 * 2; u.b = B; return true; } };
struct EpiRoute { static constexpr bool CARRY = false; float* rlog;
    DI void operator()(const f32x4 (&acc)[2][2][4][2], const Unit& u, int wr, int wc, int fr, int fq) const {
        const int row0 = u.pm * 128 + wr * 64 + fr; const int col = wc * 32 + 8 * fq;
#pragma unroll
        for (int m = 0; m < 4; ++m) { float* rp = rlog + (size_t)(row0 + m * 16) * 128 + col; *(f32x4*)rp = acc[0][0][m][0]; *(f32x4*)(rp + 4) = acc[0][0][m][1]; }
    }
};
DI void route_decide(const KA& a, int l, const float* rl_row, int* rec_e, int* rec_slot, float* rec_w, unsigned* cnt, int tok) {
    float lg[36];
    const float* bg = a.in[30] + l * 4; const float* be = a.in[32] + l * 32;
#pragma unroll
    for (int q = 0; q < 9; ++q) { const f32x4 h = *(const f32x4*)(rl_row + 4 * q), lo = *(const f32x4*)(rl_row + 64 + 4 * q);
        lg[4 * q + 0] = h[0] + lo[0]; lg[4 * q + 1] = h[1] + lo[1]; lg[4 * q + 2] = h[2] + lo[2]; lg[4 * q + 3] = h[3] + lo[3]; }
#pragma unroll
    for (int i = 0; i < 4; ++i) lg[i] += bg[i];
#pragma unroll
    for (int i = 0; i < 32; ++i) lg[4 + i] += be[i];
    int gsel = 0; float gm = lg[0];
#pragma unroll
    for (int i = 1; i < 4; ++i) if (lg[i] > gm) { gm = lg[i]; gsel = i; }
    float gs = 0.f;
#pragma unroll
    for (int i = 0; i < 4; ++i) gs += __expf(lg[i] - gm);
    const float gwt = 1.f / gs;
    float v8[8];
#pragma unroll
    for (int i = 0; i < 8; ++i) { float x = lg[4 + i];
#pragma unroll
        for (int gq = 1; gq < 4; ++gq) x = (gsel == gq) ? lg[4 + gq * 8 + i] : x;
        v8[i] = x; }
    int i0 = 0; float m0 = v8[0];
#pragma unroll
    for (int i = 1; i < 8; ++i) if (v8[i] > m0) { m0 = v8[i]; i0 = i; }
    int i1 = -1; float m1 = -3e38f;
#pragma unroll
    for (int i = 0; i < 8; ++i) if (i != i0 && v8[i] > m1) { m1 = v8[i]; i1 = i; }
    if (i1 < 0) i1 = (i0 == 0) ? 1 : 0;
    const float w0 = 1.f / (1.f + __expf(m1 - m0)); const float w1 = 1.f - w0;
    const int e0 = gsel * 8 + i0, e1 = gsel * 8 + i1;
    const unsigned s0 = __hip_atomic_fetch_add(cnt + e0, 1u, __ATOMIC_RELAXED, __HIP_MEMORY_SCOPE_AGENT);
    const unsigned s1 = __hip_atomic_fetch_add(cnt + e1, 1u, __ATOMIC_RELAXED, __HIP_MEMORY_SCOPE_AGENT);
    (void)rec_e; (void)rec_slot; (void)rec_w;
    int* inv_as = (int*)(a.ws + WS_INVAS); float* inv_w = (float*)(a.ws + WS_INVW);
    inv_as[e0 * 32768 + (int)s0] = tok * 2; inv_w[e0 * 32768 + (int)s0] = w0 * gwt; inv_as[e1 * 32768 + (int)s1] = tok * 2 + 1; inv_w[e1 * 32768 + (int)s1] = w1 * gwt;
}
DI void expert_weights(const KA& a, int l, LAS unsigned char* lds, int it0, int it1, int gw, int NGW, int wave, int lane) {
    LAS float* scr = (LAS float*)(lds + wave * 16384);
    const float* wgt = a.in[33] + (size_t)l * 32 * 1024 * 256; const float* wup = a.in[34] + (size_t)l * 32 * 1024 * 256; const float* wdn = a.in[35] + (size_t)l * 32 * 256 * 1024;
    bf16* Wgu = (bf16*)(a.ws + WS_WGU); bf16* Wd = (bf16*)(a.ws + WS_WD);
    constexpr int I_E = 16 * 4, I_D = 4 * 16;
    const int nq = 4 * (lane & 15), kr4 = lane >> 4;
    for (int it = it0 + gw; it < it1; it += NGW) {
        const int e = it / (2 * I_E + I_D); int r = it % (2 * I_E + I_D);
        const GAS float* src; GAS bf16* dst; int ldw, ldt;
        if (r < 2 * I_E) { const int up = r / I_E, q = r % I_E, kb = q / 4, nb = q % 4; const int n0 = nb * 64;
            const int drow = (n0 >> 7) * 256 + up * 128 + (n0 & 127);
            src = (const GAS float*)((up ? wup : wgt) + (size_t)e * 1024 * 256) + (size_t)(kb * 64) * 256 + n0; ldw = 256;
            dst = (GAS bf16*)(Wgu + (size_t)e * 512 * 1024) + (size_t)drow * 1024 + kb * 64; ldt = 1024;
        } else { r -= 2 * I_E; const int kb = r / 16, nb = r % 16;
            src = (const GAS float*)(wdn + (size_t)e * 256 * 1024) + (size_t)(kb * 64) * 1024 + nb * 64; ldw = 1024;
            dst = (GAS bf16*)(Wd + (size_t)e * 1024 * 256) + (size_t)(nb * 64) * 256 + kb * 64; ldt = 256; }
        f32x4 v[16];
#pragma unroll
        for (int i = 0; i < 16; ++i) v[i] = *(const GAS f32x4*)(src + (size_t)(4 * i + kr4) * ldw + nq);
#pragma unroll
        for (int hn = 0; hn < 2; ++hn) {
            if (((lane >> 3) & 1) == hn) {
#pragma unroll
                for (int i = 0; i < 16; ++i) { const int kk = 4 * i + kr4;
#pragma unroll
                    for (int e2 = 0; e2 < 4; ++e2) scr[kk * 33 + (nq & 31) + e2] = v[i][e2]; } }
            LDS_WAIT(); asm volatile("" ::: "memory");
            const int c = lane & 7;
#pragma unroll
            for (int j = 0; j < 4; ++j) { const int n = (lane >> 3) + 8 * j; const LAS float* sp = scr + (8 * c) * 33 + n;
                u32x4 o; o.x = pk2(sp[0 * 33], sp[1 * 33]); o.y = pk2(sp[2 * 33], sp[3 * 33]); o.z = pk2(sp[4 * 33], sp[5 * 33]); o.w = pk2(sp[6 * 33], sp[7 * 33]);
                *(GAS u32x4*)(dst + (size_t)(32 * hn + n) * ldt + 8 * c) = o; }
            LDS_WAIT(); asm volatile("" ::: "memory");
        }
    }
}
DI void build_offsets(const unsigned* cnt, LAS int* offt, int tid) {
    int c = 0;
    if (tid < 32) { c = (int)__hip_atomic_load(cnt + tid, __ATOMIC_RELAXED, __HIP_MEMORY_SCOPE_AGENT); offt[330 + tid] = (c + 255) & ~255; }
    __syncthreads();
    if (tid == 0) { int o = 0;
#pragma unroll
        for (int e = 0; e < 32; ++e) { offt[e] = o; o += offt[330 + e]; } offt[32] = o; }
    __syncthreads();
    if (tid < 32) offt[330 + tid] = c;
    for (int rt = tid; rt < (MOE_ROWS >> 8); rt += 512) { int e = 0; for (int j = 1; j < 32; ++j) e += (offt[j] <= rt * 256) ? 1 : 0; offt[40 + rt] = e; }
    __syncthreads();
}

template <unsigned PM>
__global__ void __launch_bounds__(512, 2) mk_fwd(Args a_) {
    extern __shared__ __attribute__((aligned(16))) unsigned char lds_raw[];
    LAS unsigned char* lds = (LAS unsigned char*)lds_raw;
    const int wave0 = __builtin_amdgcn_readfirstlane((int)threadIdx.x >> 6);
    if (threadIdx.x < 36) ((LAS unsigned long long*)(lds + PTAB_OFF))[threadIdx.x] = (unsigned long long)a_.in[threadIdx.x];
    __syncthreads();
    KA a; a.in.base = (unsigned)(size_t)(lds + PTAB_OFF); a.out = a_.out; a.ws = a_.ws;
    const int G = gridDim.x, bid = blockIdx.x, NGW = G * 8;
#define PHASE_IDS() int wave = wave0; asm volatile("" : "+s"(wave)); const int lane = my_lane(); const int tid_ = wave * 64 + lane, gw = bid * 8 + wave; (void)tid_; (void)gw; \
    const int xb = ((bid & 7) << 5) | (bid >> 3); (void)xb;        \
    KA ap = a; asm volatile("" : "+s"(ap.ws), "+s"(ap.out), "+s"(ap.in.base)); \
    bf16* hb = (bf16*)(ap.ws + WS_HB); bf16* proj = (bf16*)(ap.ws + WS_PROJ); bf16* gates = (bf16*)(ap.ws + WS_GATES); \
    bf16* ys = hb; bf16* x2b = hb; bf16* merged = proj; bf16* eo = proj; \
    bf16* kcb = (bf16*)(ap.ws + WS_KCVC); float* lrusum = (float*)(ap.ws + WS_LRUSUM); \
    int* rec_e = (int*)(ap.ws + WS_REC); int* rec_slot = rec_e + T * 2; float* rec_w = (float*)(rec_slot + T * 2); \
    int* rowtok = (int*)(ap.ws + WS_ROWTOK); float* roww = (float*)(ap.ws + WS_ROWW); \
    bf16* xs = (bf16*)(ap.ws + WS_XS); bf16* hmid = (bf16*)(ap.ws + WS_HMID); unsigned* ctl = (unsigned*)(ap.ws + WS_CTL); \
    (void)hb; (void)proj; (void)gates; (void)ys; (void)x2b; (void)merged; (void)eo; (void)kcb; (void)lrusum; (void)rec_e; (void)rec_slot; (void)rec_w; (void)rowtok; (void)roww; (void)xs; (void)hmid; (void)ctl
    volatile LAS unsigned* MISC = (volatile LAS unsigned*)(lds + MISC_OFF);
    LAS float* biasd = (LAS float*)(lds + BIAS_OFF);
    LAS int* offt = (LAS int*)(lds + OFFT_OFF);
    { PHASE_IDS();
    if (tid_ < 64) MISC[tid_] = 0u;
    for (int i = tid_; i < 129 * 12; i += 512) { const int d = i / 12, hd = i % 12; const int bk = d < 128 ? T5_BUCKET[d] : 31; const float* rb = a.in[1]; biasd[i] = rb[bk * 12 + hd]; ((LAS float*)(lds + BIAS2_OFF))[i] = (rb[bk * 12 + hd] - rb[31 * 12 + hd]) * 1.4426950408889634f; } }
    __syncthreads();
    const int lo = a_.ph_lo, hi = a_.ph_hi;
    XcdBarrier bar; bar.bar = (unsigned*)(a.ws + WS_CTL) + CW_BAR; bar.x = 0; bar.st = nullptr;
    if (hi - lo > 1) { PHASE_IDS(); bar = xcd_barrier_post(ctl + CW_BAR, MISC + 8, tid_ == 0); }
#ifndef SUB_MASK
#define SUB_MASK 0xFFu
#endif
#define SUB(k) ((SUB_MASK >> (k)) & 1u)
#define HASP(k) ((PM >> ((k) % PPL + ((k) >= 2 * PPL ? PPL : 0))) & 1u)
#define IN(k) (HASP(k) && lo <= (k) && (k) < hi)
#define SEAM(k) do { if ((k) + 1 < hi) { const int sl_ = my_lane(); int sw_ = wave0; asm volatile("" : "+s"(sw_)); xcd_barrier(bar, sw_ == 0 && sl_ == 0); } } while (0)
    for (int l = 0; l < DEPTH; ++l) {
        const int pb = l * PPL;
        if (IN(pb + 0)) { PHASE_IDS(); p1_weights_i8(ap, l, lds, bid, G, wave, lane); router_weights(ap, l, gw, NGW, lane); lru_weights(ap, l, gw, NGW, lane); cmp_weights(ap, l, lds, gw, NGW, wave, lane); phase0_weights(ap, l, lds, gw, NGW, wave, lane); phase0_rows(ap, l, 0, gw, NGW, lane); SEAM(pb + 0); }
        if (IN(pb + 1)) {
            PHASE_IDS();
            {   int K1q = 512; asm volatile("" : "+s"(K1q));
                pg8::Gemm g{K1q, 512, 512, 128, -1}; SchedP1 S{(const char*)(ap.ws + WS_HQ), (const char*)(ap.ws + WS_WQ), 128, 26, 1024, 1024, G, bid};
                EpiP1I8 E{proj, (unsigned char*)gates, ap.in[25] + (size_t)l * 4096, (const float*)(ap.ws + WS_HSC), (const float*)(ap.ws + WS_WSC)};
                pg8::gemm_phase<EpiP1I8, SchedP1, false, true>(lds, g, S, E, tid_); }
            SEAM(pb + 1);
        }
        if (IN(pb + 2)) {
            PHASE_IDS();
            LAS float* lamp = (LAS float*)(lds + MISC_OFF + 64);
            if (tid_ < 64) { const float* q1 = ap.in[13] + l * 32; const float* k1 = ap.in[14] + l * 32; const float* q2 = ap.in[15] + l * 32; const float* k2 = ap.in[16] + l * 32;
                float s1 = (lane < 32) ? q1[lane] * k1[lane] : 0.f, s2 = (lane < 32) ? q2[lane] * k2[lane] : 0.f; s1 = wave_sum(s1); s2 = wave_sum(s2);
                const float lam_init = 0.8f - 0.6f * __expf(-0.3f * (float)l); if (lane == 0) { lamp[0] = __expf(s1) - __expf(s2) + lam_init; lamp[1] = lam_init; } }
            __syncthreads();
            if (SUB(0)) { const LAS float* bias2 = (const LAS float*)(lds + BIAS2_OFF); const GAS float* subg = (const GAS float*)(ap.in[17] + l * 64);
                for (int pi = xb; pi < 256; pi += G) { const int bh = pi >> 4, qlo = pi & 15;
                    diff_unit((const GAS bf16*)proj, (GAS bf16*)ys, lds, bias2, subg, lamp, bh >> 2, bh & 3, 31 - qlo, wave);
                    diff_unit((const GAS bf16*)proj, (GAS bf16*)ys, lds, bias2, subg, lamp, bh >> 2, bh & 3, qlo, wave); } }
            { PHASE_IDS();
            if (SUB(3)) { __syncthreads(); const LAS float* bias2 = (const LAS float*)(lds + BIAS2_OFF); const GAS float* sinks = (const GAS float*)(ap.in[12] + l * 4);
                for (int pi = xb; pi < 512; pi += G) swa_unit((const GAS bf16*)proj, (GAS bf16*)ys, lds, bias2, biasd, sinks, pi >> 7, pi & 127, tid_, lane, wave); }
            if (SUB(2)) cmp_block(ap, l, (const GAS bf16*)proj, (const GAS bf16*)(ap.ws + WS_WCMP), (float*)(ap.ws + WS_CMPAB), kcb, bid, wave, lane);
            if (SUB(1)) { __syncthreads(); for (int task = xb; task < 512; task += G) lru_unit(ap, l, (const GAS bf16*)proj, (GAS bf16*)ys, (GAS float*)lrusum, lds, task, lane, wave, false); }
            }
            SEAM(pb + 2);
        }
        if (IN(pb + 4)) {
            PHASE_IDS();
            for (int task = xb; task < 512; task += G) lru_unit(ap, l, (const GAS bf16*)proj, (GAS bf16*)ys, (GAS float*)lrusum, lds, task, lane, wave, true);
            __syncthreads();
            if (SUB(4)) { const LAS float* bias2 = (const LAS float*)(lds + BIAS2_OFF);
                for (int pi = xb; pi < 256; pi += G) { const int bb = pi >> 6, ulo = pi & 63;
                    nsa_unit((const GAS bf16*)proj, (GAS bf16*)ys, (const GAS bf16*)kcb, lds, bias2, bb, 127 - ulo, tid_, lane, wave);
                    nsa_unit((const GAS bf16*)proj, (GAS bf16*)ys, (const GAS bf16*)kcb, lds, bias2, bb, ulo, tid_, lane, wave); } }
            SEAM(pb + 4);
        }
        if (IN(pb + 5)) {
            PHASE_IDS();
            int K5 = 256; asm volatile("" : "+s"(K5));
            pg8::Gemm g{K5, 1024, 256, 128, -1}; SchedP3a S{(const char*)ys, (const char*)(ap.ws + WS_WBR), G, xb};
            EpiP3a E{merged, (const unsigned char*)gates};
            pg8::gemm_phase<EpiP3a, SchedP3a>(lds, g, S, E, tid_); SEAM(pb + 5);
        }
        if (IN(pb + 6)) {
            PHASE_IDS();
            int K6 = 1024; asm volatile("" : "+s"(K6));
            pg8::Gemm g{K6, 1024, 1024, 128, -1}; SchedP3b S{(const char*)merged, (const char*)(ap.ws + WS_WOUT), G, xb};
            if (l == 0) { EpiP3b<true> E{ap.in[0], (bf16*)(ap.ws + WS_XB)}; pg8::gemm_phase<EpiP3b<true>, SchedP3b>(lds, g, S, E, tid_); }
            else { EpiP3b<false> E{nullptr, (bf16*)(ap.ws + WS_XB)}; pg8::gemm_phase<EpiP3b<false>, SchedP3b>(lds, g, S, E, tid_); }
            SEAM(pb + 6);
        }
        if (IN(pb + 7)) {
            PHASE_IDS();
            bf16* xr = (bf16*)(ap.ws + WS_XR); float* rlog = (float*)(ap.ws + WS_RLOG);
            constexpr int NITW = 32 * (2 * 16 * 4 + 4 * 16);
            { const int pm = bid;
                f32x4 gvv[4]; { const GAS float* g28 = (const GAS float*)(ap.in[28] + (size_t)l * 1024);
#pragma unroll
                    for (int j = 0; j < 4; ++j) gvv[j] = *(const GAS f32x4*)(g28 + 4 * (lane + 64 * j)); }
                {   u32x2 rw[4][4][4];
#pragma unroll
                    for (int q4 = 0; q4 < 4; ++q4) route_rows_load(ap, pm * 128 + wave * 4 + 32 * q4, lane, rw[q4]);
#pragma unroll
                    for (int q4 = 0; q4 < 4; ++q4) route_rows4(rw[q4], gvv, xr, pm * 128 + wave * 4 + 32 * q4, lane); }
                asm volatile("s_waitcnt vmcnt(0)" ::: "memory"); __syncthreads();
                { pg8::Gemm g{2048, 2048, 2048, 128, 0}; SchedRoute S{(const char*)xr, (const char*)(ap.ws + WS_WR), pm}; EpiRoute E{rlog};
                  pg8::gemm_phase<EpiRoute, SchedRoute>(lds, g, S, E, tid_); }
                asm volatile("s_waitcnt vmcnt(0)" ::: "memory"); __syncthreads();
                if (tid_ < 128) route_decide(ap, l, rlog + (size_t)(pm * 128 + tid_) * 128, rec_e, rec_slot, rec_w, ctl + CW_CNT + l * 32, pm * 128 + tid_);
                __syncthreads();
            }
            expert_weights(ap, l, lds, 0, NITW, gw, NGW, wave, lane);
            SEAM(pb + 7);
        }
        if (IN(pb + 9)) {
            PHASE_IDS();
            build_offsets(ctl + CW_CNT + l * 32, offt, tid_);
            int K9 = 1024; asm volatile("" : "+s"(K9));
            pg8::Gemm g{K9, 2048, 1024, 128, -1}; SchedM2 S{(const char*)(ap.ws + WS_XR), (const char*)(ap.ws + WS_WGU), offt, (const int*)(ap.ws + WS_INVAS), G, xb};
            EpiM2 E{hmid};
            pg8::gemm_phase<EpiM2, SchedM2, true>(lds, g, S, E, tid_); SEAM(pb + 9);
        }
        if (IN(pb + 10)) {
            PHASE_IDS();
            build_offsets(ctl + CW_CNT + l * 32, offt, tid_);
            int K3 = 256; asm volatile("" : "+s"(K3));
            pg8::Gemm g{K3, 256, 256, 128, -1}; SchedM3 S{(const char*)hmid, (const char*)(ap.ws + WS_WD), offt, G, xb};
            EpiM3 E{eo, (const int*)(ap.ws + WS_INVAS), (const float*)(ap.ws + WS_INVW), offt};
            pg8::gemm_phase<EpiM3, SchedM3>(lds, g, S, E, tid_); SEAM(pb + 10);
        }
    }
    if (IN(2 * PPL)) { PHASE_IDS(); phase0_rows(ap, DEPTH, 1, gw, NGW, lane); }
#undef IN
#undef SEAM
}

typedef void (*kern_t)(Args);
template <unsigned PM> static bool setup_kernel() {
    if (hipFuncSetAttribute((const void*)mk_fwd<PM>, hipFuncAttributeMaxDynamicSharedMemorySize, LDS_BYTES) != hipSuccess) { fprintf(stderr, "kernel_launch: hipFuncSetAttribute failed\n"); return false; }
    return true;
}
extern "C" void kernel_launch(void* const* d_in, const int* in_sizes, int n_in, void* d_out, int out_size, void* d_ws, size_t ws_size, hipStream_t stream) {
    static int grid = 0;
    if (grid == 0) {
        if (n_in != 36 || out_size != T * D || ws_size < WS_END) { fprintf(stderr, "kernel_launch: unexpected shapes (n_in %d out %d ws %zu)\n", n_in, out_size, ws_size); grid = -1; return; }
        int dev = 0, cus = 0;
        if (hipGetDevice(&dev) != hipSuccess || hipDeviceGetAttribute(&cus, hipDeviceAttributeMultiprocessorCount, dev) != hipSuccess) { grid = -1; return; }
        bool ok = true;
#if MK_ONE_LAUNCH
        ok = setup_kernel<0xFFFu>();
#endif
        if (!ok) { grid = -1; return; }
        (void)hipGetLastError();
        grid = cus;
        if (grid != 256) { fprintf(stderr, "kernel_launch: built for a 256-CU device (got %d)\n", cus); grid = -1; return; }
    }
    if (grid < 0) return;
    if (hipMemsetAsync((char*)d_ws + WS_CTL, 0, CTL_ZERO_BYTES, stream) != hipSuccess) return;
    Args a{};
    for (int i = 0; i < 36; ++i) a.in[i] = (const float*)d_in[i];
    a.out = (float*)d_out; a.ws = (unsigned char*)d_ws;
#if MK_ONE_LAUNCH
    a.ph_lo = 0; a.ph_hi = NPH;
    hipLaunchKernelGGL(mk_fwd<0xFFFu>, dim3(grid), dim3(512), LDS_BYTES, stream, a);
#endif
}
```

```cpp
#include <hip/hip_runtime.h>
#include <cstdio>
#include <cstdint>

#ifndef MK_ONE_LAUNCH
#define MK_ONE_LAUNCH 1
#endif

#define DI __device__ __forceinline__
#define GAS __attribute__((address_space(1)))
#define LAS __attribute__((address_space(3)))
typedef unsigned short bf16;
typedef short bf16x8 __attribute__((ext_vector_type(8)));
typedef float f32x4 __attribute__((ext_vector_type(4)));
typedef int i32x4 __attribute__((ext_vector_type(4)));
typedef unsigned u32x4 __attribute__((ext_vector_type(4)));
typedef unsigned u32x2 __attribute__((ext_vector_type(2)));
typedef float f32x16 __attribute__((ext_vector_type(16)));
typedef float f32x2 __attribute__((ext_vector_type(2)));
typedef short s16x4 __attribute__((ext_vector_type(4)));
typedef __bf16 bf16x2_t __attribute__((ext_vector_type(2)));
typedef short v4i16_t __attribute__((__vector_size__(4 * sizeof(short))));
#define MFMA32(a, b, c) __builtin_amdgcn_mfma_f32_32x32x16_bf16((a), (b), (c), 0, 0, 0)

constexpr int BATCH = 4, SEQ = 8192, T = BATCH * SEQ, D = 1024, DEPTH = 2;
constexpr int NIN = 2444, PLD = 2560, N1 = 6656, GLD = 4096;
constexpr int C_AX = 0, C_AG = 256, C_BQ = 512, C_BK = 768, C_BV = 896, C_CQ = 1024, C_CK = 1280, C_CV = 1536, C_DQ = 1792,
              C_KC = 2048, C_VC = 2112, C_KS = 2176, C_VS = 2240, C_KW = 2304, C_VW = 2368, C_DG = 2432;
constexpr int NCMP = 511;
constexpr int MOE_ROWS = 73728;
constexpr int PPL = 11;
constexpr int NPH = 2 * PPL + 1;

constexpr size_t MiB = 1u << 20;
constexpr size_t WS_CTL = 0, CTL_ZERO_BYTES = 1 * MiB;
constexpr size_t WS_KCVC = 1 * MiB;
constexpr size_t WS_LRUSUM = 2 * MiB;
constexpr size_t WS_REC = 2 * MiB + 256 * 1024;
constexpr size_t WS_ROWTOK = 3 * MiB;
constexpr size_t WS_ROWW = 3 * MiB + 512 * 1024;
constexpr size_t WS_WIN = 4 * MiB;
constexpr size_t WS_WQ = 4 * MiB;
constexpr size_t WS_WSC = 13 * MiB;
constexpr size_t WS_HSC = 13 * MiB + 65536;
constexpr size_t WS_HQ = 21 * MiB;
constexpr size_t WS_INVAS = 296 * MiB;
constexpr size_t WS_INVW = 300 * MiB;
constexpr size_t WS_XB = 373 * MiB;
constexpr size_t WS_WBR = 17 * MiB;
constexpr size_t WS_WOUT = 19 * MiB;
constexpr size_t WS_HB = 21 * MiB;
constexpr size_t WS_PROJ = 85 * MiB;
constexpr size_t WS_GATES = 245 * MiB;
constexpr size_t WS_WGU = 245 * MiB;
constexpr size_t WS_WD = 277 * MiB;
constexpr size_t WS_XS = 293 * MiB;
constexpr size_t WS_HMID = 437 * MiB;
constexpr size_t WS_XR = 85 * MiB;
constexpr size_t WS_RLOG = 213 * MiB;
constexpr size_t WS_WR = 501 * MiB;
constexpr size_t WS_WCMP = 502 * MiB;
constexpr size_t WS_CMPAB = 503 * MiB;
constexpr size_t WS_LRUW = 505 * MiB + 65536;
constexpr size_t WS_END = 506 * MiB;
constexpr int CW_BAR = 4096;
constexpr int CW_CNT = 16384;

constexpr int RING_BYTES = 131072;
constexpr int MISC_OFF = RING_BYTES;
constexpr int BIAS_OFF = MISC_OFF + 256;
constexpr int OFFT_OFF = BIAS_OFF + 129 * 12 * 4;
constexpr int PTAB_OFF = OFFT_OFF + (40 + 288 + 40) * 4;
constexpr int BIAS2_OFF = PTAB_OFF + 36 * 8;
constexpr int LRUEX_OFF = BIAS2_OFF + 129 * 12 * 4;
constexpr int LDS_BYTES = 163840;
constexpr int LRUCST_OFF = LRUEX_OFF + 8 * 64 * 2 * 4;
constexpr int LRUCAR_OFF = LRUCST_OFF + 3 * 64 * 4;
static_assert(PTAB_OFF % 8 == 0 && LRUCAR_OFF + 8 * 64 * 4 <= LDS_BYTES, "LDS map");

DI float bf2f(bf16 v) { return __builtin_bit_cast(float, (unsigned)v << 16); }
DI float lo_bf(unsigned w) { return __builtin_bit_cast(float, w << 16); }
DI float hi_bf(unsigned w) { return __builtin_bit_cast(float, w & 0xffff0000u); }
DI unsigned f2bf(float f) { unsigned u = __builtin_bit_cast(unsigned, f); return (u + 0x7fffu + ((u >> 16) & 1u)) >> 16; }
typedef __bf16 bf16x2_pk __attribute__((ext_vector_type(2)));
DI unsigned pk2(float lo, float hi) { typedef float f32x2_pk __attribute__((ext_vector_type(2))); f32x2_pk v = {lo, hi}; bf16x2_pk b = __builtin_convertvector(v, bf16x2_pk); return __builtin_bit_cast(unsigned, b); }
DI float rl(float v, int i) { return __builtin_bit_cast(float, __builtin_amdgcn_readlane(__builtin_bit_cast(int, v), i)); }
DI int rli(int v, int i) { return __builtin_amdgcn_readlane(v, i); }
DI int my_lane() { int l; asm volatile("v_mbcnt_lo_u32_b32 %0, -1, 0\n\tv_mbcnt_hi_u32_b32 %0, -1, %0" : "=v"(l)); return l; }
template <int O> DI int xshfl_i(int v) {
    if constexpr (O < 32) return __builtin_amdgcn_ds_swizzle(v, (O << 10) | 0x1f);
    else { const int l = my_lane(); return __builtin_amdgcn_ds_bpermute((l ^ 32) << 2, v); }
}
template <int O> DI float xshfl(float v) { return __builtin_bit_cast(float, xshfl_i<O>(__builtin_bit_cast(int, v))); }
DI float wave_sum(float v) { v += xshfl<1>(v); v += xshfl<2>(v); v += xshfl<4>(v); v += xshfl<8>(v); v += xshfl<16>(v); v += xshfl<32>(v); return v; }
DI float wave_max(float v) { v = fmaxf(v, xshfl<1>(v)); v = fmaxf(v, xshfl<2>(v)); v = fmaxf(v, xshfl<4>(v)); v = fmaxf(v, xshfl<8>(v)); v = fmaxf(v, xshfl<16>(v)); v = fmaxf(v, xshfl<32>(v)); return v; }
DI float sigmoidf_(float x) { return __builtin_amdgcn_rcpf(1.f + __builtin_amdgcn_exp2f(-1.4426950408889634f * x)); }
DI float gelu_tanh(float x) { const float u = 0.7978845608028654f * (x + 0.044715f * x * x * x); const float e = __expf(2.f * u); const float th = 1.f - 2.f * __builtin_amdgcn_rcpf(e + 1.f); return 0.5f * x * (1.f + th); }
DI float softplusf_(float x) { return fmaxf(x, 0.f) + log1pf(__expf(-fabsf(x))); }
#define LDS_WAIT() asm volatile("s_waitcnt lgkmcnt(0)" ::: "memory")
#define VM_WAIT() asm volatile("s_waitcnt vmcnt(0)" ::: "memory")

__device__ const unsigned char T5_BUCKET[128] = {
0,1,2,3,4,5,6,7,8,9,10,11,12,13,14,15,16,16,16,17,17,18,18,18,19,19,19,20,20,20,20,21,21,21,21,22,22,22,22,22,23,23,23,23,23,23,24,24,24,24,24,24,25,25,25,25,25,25,25,26,26,26,26,26,26,26,26,27,27,27,27,27,27,27,27,27,27,28,28,28,28,28,28,28,28,28,28,29,29,29,29,29,29,29,29,29,29,29,29,30,30,30,30,30,30,30,30,30,30,30,30,30,30,31,31,31,31,31,31,31,31,31,31,31,31,31,31,31};

#define XB_TMO      128
#define XB_XCNT(j)  (256  + 64 * (j))
#define XB_XSUB(j)  (1280 + 64 * (j))
#define XB_XGEN(j)  (2304 + 64 * (j))
#define XB_TOP      3328
#define XB_TOPGEN   3392
#define XCD_BAR_WORDS 3456
#define XB_SPIN_CAP (1u << 22)
DI unsigned xb_ld(unsigned* p)              { return __hip_atomic_load(p, __ATOMIC_RELAXED, __HIP_MEMORY_SCOPE_AGENT); }
DI unsigned xb_add(unsigned* p, unsigned v) { return __hip_atomic_fetch_add(p, v, __ATOMIC_RELAXED, __HIP_MEMORY_SCOPE_AGENT); }
DI unsigned xb_xcc_id() { return (unsigned)__builtin_amdgcn_s_getreg((3 << 11) | 20) & 0xFu; }
#define XB_SPIN(cond, bar) do { unsigned _sp = 0; while (cond) { __builtin_amdgcn_s_sleep(1); \
    if ((++_sp & 255u) == 0u) { if (xb_ld(&(bar)[XB_TMO])) break; if (_sp > XB_SPIN_CAP) { atomicAdd(&(bar)[XB_TMO], 1u); break; } } } } while (0)
struct XcdBarrier { unsigned* bar; unsigned x; volatile LAS unsigned* st; };
DI XcdBarrier xcd_barrier_post(unsigned* bar, volatile LAS unsigned* st, bool leader) {
    XcdBarrier b; b.bar = bar; b.x = xb_xcc_id(); b.st = st;
    if (leader) (void)xb_add(&bar[XB_XCNT(b.x)], 1u);
    return b;
}
DI void xcd_barrier_complete(unsigned* bar, unsigned x, unsigned& nloc, unsigned& nx) {
    const unsigned G = gridDim.x * gridDim.y * gridDim.z;
    unsigned sum, cnt, mine, sp = 0u;
    for (;;) {
        sum = 0u; cnt = 0u; mine = 0u;
#pragma unroll
        for (unsigned j = 0; j < 16; ++j) { const unsigned c = xb_ld(&bar[XB_XCNT(j)]); sum += c; cnt += (c > 0u) ? 1u : 0u; mine = (j == x) ? c : mine; }
        if (sum == G) break;
        __builtin_amdgcn_s_sleep(1);
        if ((++sp & 255u) == 0u) { if (xb_ld(&bar[XB_TMO])) break; if (sp > XB_SPIN_CAP) { atomicAdd(&bar[XB_TMO], 1u); break; } }
    }
    nloc = mine > 0u ? mine : 1u; nx = cnt > 0u ? cnt : 1u;
}
DI void xcd_barrier(const XcdBarrier& b, bool leader) {
    asm volatile("s_waitcnt vmcnt(0)" ::: "memory");
    __syncthreads();
    if (leader) {
        unsigned* bar = b.bar;
        __builtin_amdgcn_s_waitcnt(0);
        unsigned nloc = b.st[0], nx = b.st[1];
        if (nloc == 0u) { xcd_barrier_complete(bar, b.x, nloc, nx); b.st[0] = nloc; b.st[1] = nx; }
        const unsigned old = xb_add(&bar[XB_XSUB(b.x)], 1u);
        const unsigned gen = old / nloc;
        if (old + 1u == (gen + 1u) * nloc) {
            __builtin_amdgcn_fence(__ATOMIC_RELEASE, "agent");
            asm volatile("s_waitcnt vmcnt(0)" ::: "memory");
            const unsigned og = xb_add(&bar[XB_TOP], 1u);
            const unsigned tg = og / nx;
            if (og + 1u == (tg + 1u) * nx) xb_add(&bar[XB_TOPGEN], 1u);
            else XB_SPIN(xb_ld(&bar[XB_TOPGEN]) == tg, bar);
            __builtin_amdgcn_fence(__ATOMIC_ACQUIRE, "agent");
            xb_add(&bar[XB_XGEN(b.x)], 1u);
            asm volatile("s_waitcnt vmcnt(0)" ::: "memory");
        } else {
            XB_SPIN(xb_ld(&bar[XB_XGEN(b.x)]) == gen, bar);
            __builtin_amdgcn_fence(__ATOMIC_ACQUIRE, "agent");
            asm volatile("s_waitcnt vmcnt(0)" ::: "memory");
        }
    }
    __syncthreads();
}

namespace pg8 {
constexpr int BM = 256, BK = 64, HALF = 128, HTB = HALF * BK * 2;
__host__ __device__ __forceinline__ int lds_byte(int r, int c) { const int st = (r >> 4) * 2 + (c >> 5), rr = r & 15, cc = c & 31, ob = rr * 64 + cc * 2; return st * 1024 + (ob ^ (((ob >> 9) & 1) << 5)); }
__host__ __device__ __forceinline__ void stage_rc(int b, int& R, int& C) { const int st = b / 1024, sb = b % 1024, swz = sb ^ (((sb >> 9) & 1) << 5); R = (st >> 1) * 16 + swz / 64; C = (st & 1) * 32 + (swz % 64) / 2; }
__host__ __device__ __forceinline__ int perm32(int rho) { const int n = rho >> 4, i = rho & 15; return 8 * (i >> 2) + 4 * n + (i & 3); }
struct Unit { const char* a; const char* b; int pm, pn, aux, pad; };
struct Gemm { int K, lda, ldb, kstepA, hstepA; };
template <bool I8> struct AccT { typedef f32x4 type; };
template <> struct AccT<true> { typedef i32x4 type; };
template <class Epi, class Sched, bool GATHER = false, bool I8 = false>
DI void gemm_phase(LAS unsigned char* lds, const Gemm g, const Sched& S, const Epi& E, int tid_in) {
    int tid = tid_in; asm volatile("" : "+v"(tid));
    const int wid = __builtin_amdgcn_readfirstlane(tid >> 6), lane = tid & 63, wr = wid >> 2, wc = wid & 3, fr = lane & 15, fq = lane >> 4;
    const int K = g.K, nt = K / BK;
    unsigned voffA[2], voffB[2];
#pragma unroll
    for (int i = 0; i < 2; ++i) { int R, C; stage_rc(tid * 16 + i * 8192, R, C); const int Rb = (R & ~31) + perm32(R & 31);
        voffA[i] = (unsigned)(R * g.lda + C) * 2u; voffB[i] = (unsigned)(Rb * g.ldb + C) * 2u; }
    const size_t kstep = (size_t)(BK * 2), kstepA = (size_t)g.kstepA;
    const size_t hstepA = g.hstepA < 0 ? (size_t)HALF * g.lda * 2 : (size_t)g.hstepA, hstepB = (size_t)HALF * g.ldb * 2;
    const unsigned hstepA32 = (unsigned)hstepA;
    unsigned gC[2][2] = {{0u, 0u}, {0u, 0u}}, gN[2][2] = {{0u, 0u}, {0u, 0u}};
    const unsigned ldsw = (unsigned)wid * 1024u;
    const int aoff = lds_byte(wr * 64 + fr, fq * 8), boff = lds_byte(wc * 32 + fr, fq * 8);
#define PG8_SA(b, h) (((b) * 2 + (h)) * HTB)
#define PG8_SB(b, h) ((4 + (b) * 2 + (h)) * HTB)
#define PG8_STAGE(bufoff, gbase, voff) do { _Pragma("unroll") for (int _i = 0; _i < 2; ++_i) \
        __builtin_amdgcn_global_load_lds((const unsigned*)((const char*)(gbase) + (voff)[_i]), (LAS unsigned*)(lds + (bufoff) + ldsw + _i * 8192), 16, 0, 0); } while (0)
#define PG8_STAGEA(bufoff, gbase, h, nextsel) do { _Pragma("unroll") for (int _i = 0; _i < 2; ++_i) { \
        const unsigned _o = GATHER ? ((nextsel) ? gN[h][_i] : gC[h][_i]) : (voffA[_i] + (unsigned)(h) * hstepA32); \
        __builtin_amdgcn_global_load_lds((const unsigned*)((const char*)(gbase) + _o), (LAS unsigned*)(lds + (bufoff) + ldsw + _i * 8192), 16, 0, 0); } } while (0)
#define PG8_LDA(dst, b, h) do { _Pragma("unroll") for (int m = 0; m < 4; ++m) _Pragma("unroll") for (int k = 0; k < 2; ++k) dst[m][k] = *(const LAS bf16x8*)(lds + PG8_SA(b, h) + aoff + m * 2048 + k * 1024); } while (0)
#define PG8_LDB(dst, b, h) do { _Pragma("unroll") for (int n = 0; n < 2; ++n) _Pragma("unroll") for (int k = 0; k < 2; ++k) dst[n][k] = *(const LAS bf16x8*)(lds + PG8_SB(b, h) + boff + n * 2048 + k * 1024); } while (0)
#define PG8_MMA(ai, bj, At, Bt) do { __builtin_amdgcn_s_setprio(1); _Pragma("unroll") for (int m = 0; m < 4; ++m) _Pragma("unroll") for (int n = 0; n < 2; ++n) _Pragma("unroll") for (int k = 0; k < 2; ++k) \
        { if constexpr (I8) acc[ai][bj][m][n] = __builtin_amdgcn_mfma_i32_16x16x64_i8(__builtin_bit_cast(i32x4, Bt[n][k]), __builtin_bit_cast(i32x4, At[m][k]), acc[ai][bj][m][n], 0, 0, 0); \
          else acc[ai][bj][m][n] = __builtin_amdgcn_mfma_f32_16x16x32_bf16(Bt[n][k], At[m][k], acc[ai][bj][m][n], 0, 0, 0); } __builtin_amdgcn_s_setprio(0); } while (0)
#define PG8_WAIT_V(n) asm volatile("s_waitcnt vmcnt(" #n ")" ::: "memory")
#define PG8_WAIT_L(n) asm volatile("s_waitcnt lgkmcnt(" #n ")" ::: "memory")
#define PG8_BAR __builtin_amdgcn_s_barrier()
#define PG8_SCHED __builtin_amdgcn_sched_barrier(0)
    Unit cur, nxt; int ui = 0;
    if (!S.next(0, cur)) return;
    typedef typename AccT<I8>::type ACC;
    ACC acc[2][2][4][2];
#pragma unroll
    for (int a = 0; a < 2; ++a)
#pragma unroll
        for (int b = 0; b < 2; ++b)
#pragma unroll
            for (int m = 0; m < 4; ++m)
#pragma unroll
                for (int n = 0; n < 2; ++n) acc[a][b][m][n] = (ACC){0, 0, 0, 0};
    bf16x8 At[4][2], B0[2][2], B1[2][2];
    const char* cA = cur.a; const char* cB = cur.b;
    if constexpr (GATHER) S.rows(cur, tid, gC);
    PG8_STAGE(PG8_SB(0, 0), cB, voffB); PG8_STAGE(PG8_SB(0, 1), cB + hstepB, voffB); PG8_STAGEA(PG8_SA(0, 0), cA, 0, false); PG8_STAGEA(PG8_SA(0, 1), cA, 1, false);
    if (wr == 1) PG8_BAR;
    PG8_WAIT_V(2); PG8_BAR;
    PG8_STAGE(PG8_SB(1, 0), cB + kstep, voffB); PG8_STAGEA(PG8_SA(1, 0), cA + kstepA, 0, false); PG8_STAGE(PG8_SB(1, 1), cB + hstepB + kstep, voffB);
    PG8_WAIT_V(6); PG8_BAR;
    for (;;) {
        const bool has_next = S.next(ui + 1, nxt);
        const char* nA = has_next ? nxt.a : cA; const char* nB = has_next ? nxt.b : cB;
        if constexpr (GATHER) { if (has_next) S.rows(nxt, tid, gN); else {
#pragma unroll
            for (int h = 0; h < 2; ++h) { gN[h][0] = gC[h][0]; gN[h][1] = gC[h][1]; } } }
        for (int t = 0; t < nt; t += 2) {
            const bool last = (t == nt - 2);
            const char* a1 = cA + (size_t)(t + 1) * kstepA;
            const char* a2 = last ? nA : cA + (size_t)(t + 2) * kstepA; const char* b2 = last ? nB : cB + (size_t)(t + 2) * kstep;
            const char* a3 = a2 + kstepA; const char* b3 = b2 + kstep;
            PG8_LDB(B0, 0, 0); PG8_LDB(B1, 0, 1); PG8_SCHED; PG8_LDA(At, 0, 0); PG8_STAGEA(PG8_SA(1, 1), a1, 1, false);
            PG8_WAIT_V(8); PG8_WAIT_L(0); PG8_BAR; PG8_MMA(0, 0, At, B0); PG8_MMA(0, 1, At, B1); PG8_BAR; PG8_SCHED;
            PG8_LDA(At, 0, 1); PG8_STAGE(PG8_SB(0, 0), b2, voffB); PG8_STAGE(PG8_SB(0, 1), b2 + hstepB, voffB); PG8_STAGEA(PG8_SA(0, 0), a2, 0, last);
            PG8_WAIT_V(8); PG8_WAIT_L(0); PG8_BAR; PG8_MMA(1, 0, At, B0); PG8_MMA(1, 1, At, B1); PG8_BAR; PG8_SCHED;
            PG8_LDB(B0, 1, 0); PG8_LDB(B1, 1, 1); PG8_SCHED; PG8_LDA(At, 1, 0); PG8_STAGEA(PG8_SA(0, 1), a2, 1, last);
            PG8_WAIT_V(8); PG8_WAIT_L(0); PG8_BAR; PG8_MMA(0, 0, At, B0); PG8_MMA(0, 1, At, B1); PG8_BAR; PG8_SCHED;
            PG8_LDA(At, 1, 1); PG8_STAGE(PG8_SB(1, 0), b3, voffB); PG8_STAGE(PG8_SB(1, 1), b3 + hstepB, voffB); PG8_STAGEA(PG8_SA(1, 0), a3, 0, last);
            PG8_WAIT_V(8); PG8_WAIT_L(0); PG8_BAR; PG8_MMA(1, 0, At, B0); PG8_MMA(1, 1, At, B1); PG8_BAR; PG8_SCHED;
        }
        if (wr == 0) PG8_BAR;
        { const int el = my_lane(); E(acc, cur, wr, wc, el & 15, el >> 4); }
        if (!has_next) break;
        bool carried = false;
        if constexpr (Epi::CARRY) { if (nxt.aux != 0) { const int el = my_lane(); E.carry(acc, nxt, wr, wc, el & 15, el >> 4); carried = true; } }
        if (!carried) {
#pragma unroll
        for (int a = 0; a < 2; ++a)
#pragma unroll
            for (int b = 0; b < 2; ++b)
#pragma unroll
                for (int m = 0; m < 4; ++m)
#pragma unroll
                    for (int n = 0; n < 2; ++n) acc[a][b][m][n] = (ACC){0, 0, 0, 0};
        }
        cur = nxt; cA = nA; cB = nB; ++ui;
        if constexpr (GATHER) {
#pragma unroll
            for (int h = 0; h < 2; ++h) { gC[h][0] = gN[h][0]; gC[h][1] = gN[h][1]; } }
        if (wr == 1) PG8_BAR;
    }
    PG8_WAIT_V(0);
    PG8_BAR;
#undef PG8_SA
#undef PG8_SB
#undef PG8_STAGE
#undef PG8_STAGEA
#undef PG8_LDA
#undef PG8_LDB
#undef PG8_MMA
#undef PG8_WAIT_V
#undef PG8_WAIT_L
#undef PG8_BAR
#undef PG8_SCHED
}
}
using pg8::Unit;

DI unsigned cvt_pk_bf16(float lo, float hi) { unsigned r; asm volatile("s_nop 1\n\tv_cvt_pk_bf16_f32 %0, %1, %2" : "=v"(r) : "v"(lo), "v"(hi)); return r; }
DI u32x4 pack8(const f32x4& v0, const f32x4& v1) { u32x4 w; w.x = cvt_pk_bf16(v0[0], v0[1]); w.y = cvt_pk_bf16(v0[2], v0[3]); w.z = cvt_pk_bf16(v1[0], v1[1]); w.w = cvt_pk_bf16(v1[2], v1[3]); return w; }

struct SchedP1 {
    const char* A; const char* B; int nM, nN, rbA, rbB, G, c;
    DI bool next(int i, Unit& u) const {
        constexpr int NXCD = 8, WGM = 8; const int nwg = nM * nN;
        const long L = (long)i * G + c; if (L >= nwg) return false;
        int wgid = (int)L; { const int q = nwg / NXCD, r = nwg % NXCD, xcd = wgid % NXCD, off = wgid / NXCD; wgid = (xcd < r ? xcd * (q + 1) : r * (q + 1) + (xcd - r) * q) + off; }
        const int nig = WGM * nN, gid = wgid / nig, fm = gid * WGM, gsz = (nM - fm) < WGM ? (nM - fm) : WGM;
        u.pm = fm + ((wgid % nig) % gsz); u.pn = (wgid % nig) / gsz; u.aux = 0; u.pad = 0;
        u.a = A + (size_t)u.pm * 256 * rbA; u.b = B + (size_t)u.pn * 256 * rbB; return true;
    }
};
struct SchedP3a {
    const char* ys; const char* wbr; int G, c;
    DI bool next(int i, Unit& u) const {
        const int tile = (i >> 2) * G + c; if (tile >= 512) return false;
        const int br = i & 3; u.pm = tile >> 2; u.pn = tile & 3; u.aux = br; u.pad = 0;
        u.a = ys + ((size_t)u.pm * 256 * 1024 + br * 256) * 2; u.b = wbr + ((size_t)br * 1024 * 256 + (size_t)u.pn * 256 * 256) * 2; return true;
    }
};
struct SchedP3b {
    const char* A; const char* B; int G, c;
    DI bool next(int i, Unit& u) const {
        const int L = i * G + c; if (L >= 512) return false;
        u.pm = L >> 2; u.pn = L & 3; u.aux = 0; u.pad = 0;
        u.a = A + (size_t)u.pm * 256 * 1024 * 2; u.b = B + (size_t)u.pn * 256 * 1024 * 2; return true;
    }
};
struct SchedM2 {
    const char* xr; const char* wgu; const LAS int* offt; const int* rowsrc; int G, c;
    DI bool next(int i, Unit& u) const {
        const int NT = __builtin_amdgcn_readfirstlane(offt[32]) >> 8; const int L = i * G + c; if (L >= NT * 2) return false;
        const int rt = L >> 1, pn = L & 1; const int e = __builtin_amdgcn_readfirstlane(offt[40 + rt]);
        u.pm = rt; u.pn = pn; u.aux = e; u.pad = 0;
        u.a = xr; u.b = wgu + ((size_t)e * 512 + pn * 256) * 1024 * 2; return true;
    }
    DI void rows(const Unit& u, int tid, unsigned (&g)[2][2]) const {
        const int e = u.aux; const int base = u.pm * 256 - __builtin_amdgcn_readfirstlane(offt[e]), cnt = __builtin_amdgcn_readfirstlane(offt[330 + e]);
#pragma unroll
        for (int i = 0; i < 2; ++i) { int R, C; pg8::stage_rc(tid * 16 + i * 8192, R, C);
#pragma unroll
            for (int h = 0; h < 2; ++h) { const int lr = base + h * 128 + R; const int as = lr < cnt ? rowsrc[e * 32768 + lr] : 0;
                g[h][i] = (unsigned)(as >> 1) * 4096u + (unsigned)C * 2u; } }
    }
};
struct SchedM3 {
    const char* hmid; const char* wd; const LAS int* offt; int G, c;
    DI bool next(int i, Unit& u) const {
        const int NT = __builtin_amdgcn_readfirstlane(offt[32]) >> 8; const int L = i * G + c; if (L >= NT * 4) return false;
        const int rt = L >> 2, pn = L & 3; const int e = __builtin_amdgcn_readfirstlane(offt[40 + rt]);
        u.pm = rt; u.pn = pn; u.aux = e; u.pad = 0;
        u.a = hmid + (size_t)rt * 256 * 256 * 2; u.b = wd + ((size_t)e * 1024 + pn * 256) * 256 * 2; return true;
    }
};

struct EpiP1I8 {
    static constexpr bool CARRY = false;
    bf16* proj; unsigned char* gates; const float* bgate; const float* hsc; const float* wsc;
    DI void operator()(const i32x4 (&acc)[2][2][4][2], const Unit& u, int wr, int wc, int fr, int fq) const {
        const int row0 = u.pm * 256 + wr * 64 + fr;
        if (u.pn < 10) { const int colt = u.pn * 256 + wc * 32 + 8 * fq;
            f32x4 sv[2][2]; float rsv[2][4];
#pragma unroll
            for (int bj = 0; bj < 2; ++bj)
#pragma unroll
                for (int n = 0; n < 2; ++n) sv[bj][n] = *(const GAS f32x4*)((const GAS float*)wsc + colt + bj * 128 + 4 * n);
#pragma unroll
            for (int ai = 0; ai < 2; ++ai)
#pragma unroll
                for (int m = 0; m < 4; ++m) rsv[ai][m] = ((const GAS float*)hsc)[row0 + ai * 128 + m * 16];
#pragma unroll
            for (int ai = 0; ai < 2; ++ai)
#pragma unroll
                for (int m = 0; m < 4; ++m) { bf16* rowp = proj + (size_t)(row0 + ai * 128 + m * 16) * PLD + colt; const float rs = rsv[ai][m];
#pragma unroll
                    for (int bj = 0; bj < 2; ++bj) { f32x4 v0, v1;
#pragma unroll
                        for (int e = 0; e < 4; ++e) { v0[e] = (float)acc[ai][bj][m][0][e] * (rs * sv[bj][0][e]); v1[e] = (float)acc[ai][bj][m][1][e] * (rs * sv[bj][1][e]); }
                        *(u32x4*)(rowp + bj * 128) = pack8(v0, v1); } }
            return; }
        const int gcol = (u.pn - 10) * 256 + wc * 32 + 8 * fq; const float* wsc = this->wsc + 2560;
        f32x4 bv[2][2], sv[2][2];
#pragma unroll
        for (int bj = 0; bj < 2; ++bj)
#pragma unroll
            for (int n = 0; n < 2; ++n) { bv[bj][n] = *(const f32x4*)(bgate + gcol + bj * 128 + 4 * n); sv[bj][n] = *(const f32x4*)(wsc + gcol + bj * 128 + 4 * n);
                sv[bj][n] = sv[bj][n] * -1.4426950408889634f; bv[bj][n] = bv[bj][n] * -1.4426950408889634f + (-8.f + 2.2e-5f); }
        float rsv[2][4];
#pragma unroll
        for (int ai = 0; ai < 2; ++ai)
#pragma unroll
            for (int m = 0; m < 4; ++m) rsv[ai][m] = ((const GAS float*)hsc)[row0 + ai * 128 + m * 16];
#pragma unroll
        for (int ai = 0; ai < 2; ++ai)
#pragma unroll
            for (int m = 0; m < 4; ++m) { const float rs = rsv[ai][m];
                unsigned char* rowp = gates + ((size_t)(u.pm * 16 + (u.pn - 10)) * 65536 + (size_t)((ai * 4 + m) * 8192 + (wr * 4 + wc) * 1024 + (fq * 16 + fr) * 16));
                u32x4 w4;
#pragma unroll
                for (int bj = 0; bj < 2; ++bj) { unsigned q[8];
#pragma unroll
                    for (int n = 0; n < 2; ++n)
#pragma unroll
                        for (int e = 0; e < 4; ++e) { const float xe = ((float)acc[ai][bj][m][n][e] * rs) * sv[bj][n][e] + bv[bj][n][e];
                            q[4 * n + e] = (unsigned)__builtin_amdgcn_rcpf(0.00390631f + __builtin_amdgcn_exp2f(xe)); }
                    const unsigned w0 = q[0] | (q[1] << 8) | (q[2] << 16) | (q[3] << 24), w1 = q[4] | (q[5] << 8) | (q[6] << 16) | (q[7] << 24);
                    if (bj == 0) { w4.x = w0; w4.y = w1; } else { w4.z = w0; w4.w = w1; } }
                *(u32x4*)rowp = w4;
                __builtin_amdgcn_sched_barrier(0); }
    }
};
struct EpiP3a {
    static constexpr bool CARRY = true;
    bf16* merged; const unsigned char* gates;
    DI void carry(f32x4 (&acc)[2][2][4][2], const Unit& u, int wr, int wc, int fr, int fq) const {
        const GAS unsigned char* gb = (const GAS unsigned char*)gates + (size_t)(u.pm * 16 + (u.aux - 1) * 4 + u.pn) * 65536;
        const unsigned go = (unsigned)((wr * 4 + wc) * 1024 + (fq * 16 + fr) * 16);
        u32x4 gp[2][4], gn[2][4];
#pragma unroll
        for (int ai = 0; ai < 2; ++ai)
#pragma unroll
            for (int m = 0; m < 4; ++m) { gp[ai][m] = *(const GAS u32x4*)(gb + go + (unsigned)((ai * 4 + m) * 8192)); gn[ai][m] = *(const GAS u32x4*)(gb + go + (unsigned)((ai * 4 + m) * 8192 + 4 * 65536)); }
#pragma unroll
        for (int ai = 0; ai < 2; ++ai) {
#pragma unroll
            for (int m = 0; m < 4; ++m)
#pragma unroll
                for (int bj = 0; bj < 2; ++bj) {
#pragma unroll
                    for (int n = 0; n < 2; ++n) { const unsigned p4 = bj ? (n ? gp[ai][m].w : gp[ai][m].z) : (n ? gp[ai][m].y : gp[ai][m].x), n4 = bj ? (n ? gn[ai][m].w : gn[ai][m].z) : (n ? gn[ai][m].y : gn[ai][m].x);
#pragma unroll
                        for (int e = 0; e < 4; ++e) acc[ai][bj][m][n][e] *= ((float)((p4 >> (8 * e)) & 255u) + 0.5f) * __builtin_amdgcn_rcpf((float)((n4 >> (8 * e)) & 255u) + 0.5f); } }
            __builtin_amdgcn_sched_barrier(0); }
    }
    DI void operator()(const f32x4 (&acc)[2][2][4][2], const Unit& u, int wr, int wc, int fr, int fq) const {
        if (u.aux != 3) return;
        const GAS unsigned char* gb = (const GAS unsigned char*)gates + (size_t)(u.pm * 16 + 3 * 4 + u.pn) * 65536;
        GAS unsigned char* mb = (GAS unsigned char*)merged + ((size_t)(u.pm * 256) * 1024 + u.pn * 256) * 2;
        const unsigned go = (unsigned)((wr * 4 + wc) * 1024 + (fq * 16 + fr) * 16), mo = (unsigned)((wr * 64 + fr) * 1024 + wc * 32 + 8 * fq) * 2u;
        u32x4 gw[2][4];
#pragma unroll
        for (int ai = 0; ai < 2; ++ai)
#pragma unroll
            for (int m = 0; m < 4; ++m) gw[ai][m] = *(const GAS u32x4*)(gb + go + (unsigned)((ai * 4 + m) * 8192));
#pragma unroll
        for (int ai = 0; ai < 2; ++ai) {
#pragma unroll
            for (int m = 0; m < 4; ++m)
#pragma unroll
                for (int bj = 0; bj < 2; ++bj) {
                    f32x4 v0 = acc[ai][bj][m][0], v1 = acc[ai][bj][m][1]; u32x2 g2; g2.x = bj ? gw[ai][m].z : gw[ai][m].x; g2.y = bj ? gw[ai][m].w : gw[ai][m].y; const float k256 = 0.00390625f;
#pragma unroll
                    for (int e = 0; e < 4; ++e) { v0[e] *= ((float)((g2.x >> (8 * e)) & 255u) + 0.5f) * k256; v1[e] *= ((float)((g2.y >> (8 * e)) & 255u) + 0.5f) * k256; }
                    *(GAS u32x4*)(mb + mo + (unsigned)((ai * 128 + m * 16) * 1024 + bj * 128) * 2u) = pack8(v0, v1); }
            __builtin_amdgcn_sched_barrier(0); }
    }
};
template <bool XF32> struct EpiP3b {
    static constexpr bool CARRY = false;
    const float* xin; bf16* xb_;
    DI void operator()(const f32x4 (&acc)[2][2][4][2], const Unit& u, int wr, int wc, int fr, int fq) const {
        GAS unsigned char* ob = (GAS unsigned char*)xb_ + ((size_t)(u.pm * 256) * 1024 + u.pn * 256) * 2;
        const unsigned lo = (unsigned)((wr * 64 + fr) * 1024 + wc * 32 + 8 * fq);
        if constexpr (XF32) {
            const GAS unsigned char* xb = (const GAS unsigned char*)xin + ((size_t)(u.pm * 256) * 1024 + u.pn * 256) * 4;
#pragma unroll
            for (int ai = 0; ai < 2; ++ai)
#pragma unroll
                for (int mh = 0; mh < 2; ++mh) {
                    f32x4 xv[2][2][2];
#pragma unroll
                    for (int m2 = 0; m2 < 2; ++m2)
#pragma unroll
                        for (int bj = 0; bj < 2; ++bj)
#pragma unroll
                            for (int n = 0; n < 2; ++n) xv[m2][bj][n] = *(const GAS f32x4*)(xb + (lo + (unsigned)((ai * 128 + (mh * 2 + m2) * 16) * 1024 + bj * 128 + 4 * n)) * 4u);
#pragma unroll
                    for (int m2 = 0; m2 < 2; ++m2)
#pragma unroll
                        for (int bj = 0; bj < 2; ++bj)
                            *(GAS u32x4*)(ob + (lo + (unsigned)((ai * 128 + (mh * 2 + m2) * 16) * 1024 + bj * 128)) * 2u) = pack8(xv[m2][bj][0] + acc[ai][bj][mh * 2 + m2][0], xv[m2][bj][1] + acc[ai][bj][mh * 2 + m2][1]);
                    __builtin_amdgcn_sched_barrier(0); }
        } else {
#pragma unroll
            for (int ai = 0; ai < 2; ++ai) {
                u32x4 xv[4][2];
#pragma unroll
                for (int m = 0; m < 4; ++m)
#pragma unroll
                    for (int bj = 0; bj < 2; ++bj) xv[m][bj] = *(const GAS u32x4*)(ob + (lo + (unsigned)((ai * 128 + m * 16) * 1024 + bj * 128)) * 2u);
#pragma unroll
                for (int m = 0; m < 4; ++m)
#pragma unroll
                    for (int bj = 0; bj < 2; ++bj) { const u32x4 x4 = xv[m][bj]; f32x4 v0 = acc[ai][bj][m][0], v1 = acc[ai][bj][m][1];
                        v0[0] += lo_bf(x4.x); v0[1] += hi_bf(x4.x); v0[2] += lo_bf(x4.y); v0[3] += hi_bf(x4.y); v1[0] += lo_bf(x4.z); v1[1] += hi_bf(x4.z); v1[2] += lo_bf(x4.w); v1[3] += hi_bf(x4.w);
                        *(GAS u32x4*)(ob + (lo + (unsigned)((ai * 128 + m * 16) * 1024 + bj * 128)) * 2u) = pack8(v0, v1); }
                __builtin_amdgcn_sched_barrier(0); }
        }
    }
};
struct EpiM2 {
    static constexpr bool CARRY = false;
    bf16* hmid;
    DI void operator()(const f32x4 (&acc)[2][2][4][2], const Unit& u, int wr, int wc, int fr, int fq) const {
        const int row0 = u.pm * 256 + wr * 64 + fr; const int col = u.pn * 128 + wc * 32 + 8 * fq;
#pragma unroll
        for (int ai = 0; ai < 2; ++ai)
#pragma unroll
            for (int m = 0; m < 4; ++m) { f32x4 h0, h1;
#pragma unroll
                for (int e = 0; e < 4; ++e) { const float g0 = acc[ai][0][m][0][e], g1 = acc[ai][0][m][1][e];
                    h0[e] = g0 * sigmoidf_(g0) * acc[ai][1][m][0][e]; h1[e] = g1 * sigmoidf_(g1) * acc[ai][1][m][1][e]; }
                *(u32x4*)(hmid + (size_t)(row0 + ai * 128 + m * 16) * 256 + col) = pack8(h0, h1); }
    }
};
struct EpiM3 {
    static constexpr bool CARRY = false;
    bf16* eo; const int* rowtok; const float* roww; const LAS int* offt;
    DI void operator()(const f32x4 (&acc)[2][2][4][2], const Unit& u, int wr, int wc, int fr, int fq) const {
        const int e = u.aux; const int cnt = __builtin_amdgcn_readfirstlane(offt[330 + e]);
        const int lr0 = u.pm * 256 - __builtin_amdgcn_readfirstlane(offt[e]) + wr * 64 + fr; const int colt = u.pn * 256 + wc * 32 + 8 * fq;
        int tk[2][4]; float wv[2][4];
#pragma unroll
        for (int ai = 0; ai < 2; ++ai)
#pragma unroll
            for (int m = 0; m < 4; ++m) { const int lr = lr0 + ai * 128 + m * 16; tk[ai][m] = -1; wv[ai][m] = 0.f;
                if (lr < cnt) { tk[ai][m] = ((const GAS int*)rowtok)[e * 32768 + lr]; wv[ai][m] = ((const GAS float*)roww)[e * 32768 + lr]; } }
#pragma unroll
        for (int ai = 0; ai < 2; ++ai)
#pragma unroll
            for (int m = 0; m < 4; ++m) {
                if (tk[ai][m] >= 0) { const float w = wv[ai][m]; GAS bf16* op = (GAS bf16*)eo + (size_t)tk[ai][m] * 1024 + colt;
#pragma unroll
                    for (int bj = 0; bj < 2; ++bj) *(GAS u32x4*)(op + bj * 128) = pack8(acc[ai][bj][m][0] * w, acc[ai][bj][m][1] * w); }
                __builtin_amdgcn_sched_barrier(0); }
    }
};

struct Args { const float* in[36]; float* out; unsigned char* ws; int ph_lo, ph_hi; };
struct InTab { unsigned base;
    DI const float* operator[](int i) const { unsigned long long v; const unsigned addr = base + (unsigned)i * 8u;
        asm volatile("ds_read_b64 %0, %1\n\ts_waitcnt lgkmcnt(0)" : "=v"(v) : "v"(addr) : "memory");
        const unsigned lo = __builtin_amdgcn_readfirstlane((unsigned)v), hi = __builtin_amdgcn_readfirstlane((unsigned)(v >> 32));
        return (const float*)(((unsigned long long)hi << 32) | lo); } };
struct KA { InTab in; float* out; unsigned char* ws; };

DI void transpose_item(const float* W_, int ldw, int nvalid, bf16* WT_, int ldt, int k0, int n0, int dst_row0, LAS float* scr, int lane) {
    const GAS float* W = (const GAS float*)W_; GAS bf16* WT = (GAS bf16*)WT_;
    const int nq = 4 * (lane & 7), kr8 = lane >> 3;
    f32x4 v[8];
#pragma unroll
    for (int i = 0; i < 8; ++i) { const int kk = 8 * i + kr8;
        if (n0 + nq + 3 < nvalid) v[i] = *(const GAS f32x4*)(W + (size_t)(k0 + kk) * ldw + n0 + nq);
        else {
#pragma unroll
            for (int e = 0; e < 4; ++e) v[i][e] = (n0 + nq + e < nvalid) ? W[(size_t)(k0 + kk) * ldw + n0 + nq + e] : 0.f; } }
#pragma unroll
    for (int i = 0; i < 8; ++i) { const int kk = 8 * i + kr8;
#pragma unroll
        for (int e = 0; e < 4; ++e) scr[kk * 33 + nq + e] = v[i][e]; }
    LDS_WAIT(); asm volatile("" ::: "memory");
    const int c = lane & 7;
#pragma unroll
    for (int j = 0; j < 4; ++j) { const int n = (lane >> 3) + 8 * j; const LAS float* s = scr + (8 * c) * 33 + n;
        u32x4 o; o.x = pk2(s[0 * 33], s[1 * 33]); o.y = pk2(s[2 * 33], s[3 * 33]); o.z = pk2(s[4 * 33], s[5 * 33]); o.w = pk2(s[6 * 33], s[7 * 33]);
        if (n0 + n < nvalid) *(GAS u32x4*)(WT + (size_t)(dst_row0 + n) * ldt + k0 + 8 * c) = o; }
    LDS_WAIT(); asm volatile("" ::: "memory");
}
DI void phase0_weights(const KA& a, int l, LAS unsigned char* lds, int gw, int NGW, int wave, int lane) {
    LAS float* scr = (LAS float*)(lds + wave * 16384);
    const float* w_in = a.in[4] + (size_t)l * 1024 * NIN;
    const float* w_gate = a.in[24] + (size_t)l * 4 * 1024 * 1024;
    const float* w_br = a.in[26] + (size_t)l * 4 * 256 * 1024;
    const float* w_out = a.in[27] + (size_t)l * 1024 * 1024;
    bf16* Wt_in = (bf16*)(a.ws + WS_WIN); bf16* Wt_br = (bf16*)(a.ws + WS_WBR); bf16* Wt_out = (bf16*)(a.ws + WS_WOUT);
    constexpr int I_B = 4 * 4 * 32, I_O = 16 * 32, NIT = I_B + I_O;
    (void)w_gate; (void)w_in; (void)Wt_in;
    for (int it = gw; it < NIT; it += NGW) {
        int r = it;
        if (r < I_B) { const int br = r / 128, q = r % 128, kb = q / 32, nb = q % 32; transpose_item(w_br + (size_t)br * 256 * 1024, 1024, 1024, Wt_br + (size_t)br * 1024 * 256, 256, kb * 64, nb * 32, nb * 32, scr, lane); continue; } r -= I_B;
        { const int kb = r / 32, nb = r % 32; transpose_item(w_out, 1024, 1024, Wt_out, 1024, kb * 64, nb * 32, nb * 32, scr, lane); }
    }
}
DI void p1_weights_i8(const KA& a, int l, LAS unsigned char* lds, int bid, int G, int wave, int lane) {
    LAS float* scr = (LAS float*)(lds + wave * 16384); LAS float* red = (LAS float*)(lds + 7 * 16384 + 12288);
    const GAS float* wgt = (const GAS float*)(a.in[24] + (size_t)l * 4 * 1024 * 1024); const GAS float* win = (const GAS float*)(a.in[4] + (size_t)l * 1024 * NIN);
    GAS unsigned char* Wq = (GAS unsigned char*)(a.ws + WS_WQ); GAS float* wsc = (GAS float*)(a.ws + WS_WSC);
    const int nq = 4 * (lane & 7), kr8 = lane >> 3;
    for (int it = G - 1 - bid; it < 128 + 77; it += G) {
        const bool isg = it < 128; const int br = it >> 5; const int n0 = isg ? (it & 31) * 32 : (it - 128) * 32;
        const int ldw = isg ? 1024 : NIN; const int nval = isg ? 1024 : NIN; const int drow0 = isg ? 2560 + br * 1024 + n0 : n0;
        const bool lok = (n0 + nq) < nval;
        const GAS float* W = (isg ? wgt + (size_t)br * 1024 * 1024 : win) + n0 + nq + (size_t)(128 * wave) * ldw;
        f32x4 v[16];
#pragma unroll
        for (int i = 0; i < 16; ++i) { v[i] = (f32x4){0.f, 0.f, 0.f, 0.f}; if (lok) v[i] = *(const GAS f32x4*)(W + (size_t)(8 * i + kr8) * ldw); }
        f32x4 mx = {0.f, 0.f, 0.f, 0.f};
#pragma unroll
        for (int i = 0; i < 16; ++i) { mx[0] = fmaxf(mx[0], fabsf(v[i][0])); mx[1] = fmaxf(mx[1], fabsf(v[i][1])); mx[2] = fmaxf(mx[2], fabsf(v[i][2])); mx[3] = fmaxf(mx[3], fabsf(v[i][3])); }
#pragma unroll
        for (int e = 0; e < 4; ++e) { float m = mx[e]; m = fmaxf(m, xshfl<8>(m)); m = fmaxf(m, xshfl<16>(m)); m = fmaxf(m, xshfl<32>(m)); mx[e] = m; }
        if (kr8 == 0) {
#pragma unroll
            for (int e = 0; e < 4; ++e) red[wave * 32 + nq + e] = mx[e]; }
        __syncthreads();
#pragma unroll
        for (int e = 0; e < 4; ++e) { float m = red[nq + e];
#pragma unroll
            for (int w = 1; w < 8; ++w) m = fmaxf(m, red[w * 32 + nq + e]);
            mx[e] = fmaxf(m, 1e-20f); }
        if (wave == 0 && kr8 == 0 && lok) *(GAS f32x4*)(wsc + drow0 + nq) = mx * (1.f / 127.f);
        const f32x4 qs = {127.f / mx[0], 127.f / mx[1], 127.f / mx[2], 127.f / mx[3]};
#pragma unroll
        for (int hb = 0; hb < 2; ++hb) {
#pragma unroll
            for (int i = 0; i < 8; ++i) { const int kk = 8 * i + kr8;
#pragma unroll
                for (int e = 0; e < 4; ++e) scr[kk * 33 + nq + e] = __builtin_rintf(v[8 * hb + i][e] * qs[e]); }
            LDS_WAIT(); asm volatile("" ::: "memory");
            const int n = lane >> 1, kh = lane & 1; u32x4 o[2];
#pragma unroll
            for (int h2 = 0; h2 < 2; ++h2) { unsigned w4[4];
#pragma unroll
                for (int d = 0; d < 4; ++d) { unsigned wv = 0u;
#pragma unroll
                    for (int e = 0; e < 4; ++e) wv |= ((unsigned)(int)scr[(32 * kh + 16 * h2 + 4 * d + e) * 33 + n] & 255u) << (8 * e);
                    w4[d] = wv; }
                o[h2].x = w4[0]; o[h2].y = w4[1]; o[h2].z = w4[2]; o[h2].w = w4[3]; }
            if (n0 + n < nval) { GAS unsigned char* dst = Wq + (size_t)(drow0 + n) * 1024 + 128 * wave + 64 * hb + 32 * kh; *(GAS u32x4*)dst = o[0]; *(GAS u32x4*)(dst + 16) = o[1]; }
            LDS_WAIT(); asm volatile("" ::: "memory");
        }
        __syncthreads();
    }
}

DI void router_weights(const KA& a, int l, int gw, int NGW, int lane) {
    bf16* Wr = (bf16*)(a.ws + WS_WR);
    const float* wg = a.in[29] + (size_t)l * 1024 * 4; const float* we = a.in[31] + (size_t)l * 1024 * 32;
    for (int n = gw; n < 36; n += NGW) {
        for (int i = 0; i < 16; ++i) { const int k = lane + 64 * i; const float w = (n < 4) ? wg[k * 4 + n] : we[k * 32 + (n - 4)];
            const unsigned hi = f2bf(w); const float hf = __builtin_bit_cast(float, hi << 16); const unsigned lo = f2bf(w - hf);
            Wr[(size_t)n * 2048 + k] = (bf16)hi; Wr[(size_t)n * 2048 + 1024 + k] = (bf16)hi; Wr[(size_t)(64 + n) * 2048 + k] = (bf16)lo; Wr[(size_t)(64 + n) * 2048 + 1024 + k] = 0; }
    }
}

DI void cmp_weights(const KA& a, int l, LAS unsigned char* lds, int gw, int NGW, int wave, int lane) {
    LAS float* scr = (LAS float*)(lds + wave * 16384);
    bf16* Wc = (bf16*)(a.ws + WS_WCMP); float* pt = (float*)(a.ws + WS_CMPAB + 2 * MiB);
    for (int it = gw; it < 128 + 64; it += NGW) {
        if (it < 128) { const int kv = it >> 6, q = it & 63, kb = q >> 1, nb = q & 1; const float* w1 = a.in[kv ? 22 : 19] + (size_t)l * 2048 * 64;
            bf16* dst = Wc + (size_t)kv * 256 * 1024 - (kb >= 16 ? 1024 : 0);
            transpose_item(w1, 64, 64, dst, 1024, kb * 64, nb * 32, (kb >= 16 ? 64 : 0) + nb * 32, scr, lane);
        } else { const int kv = (it - 128) >> 5, part = (it - 128) & 31;
            const GAS float* w1 = (const GAS float*)(a.in[kv ? 22 : 19] + (size_t)l * 2048 * 64) + (size_t)part * 64 * 64; const GAS float* pos = (const GAS float*)(a.in[kv ? 21 : 18] + (size_t)l * 2048) + part * 64;
            float acc = 0.f;
#pragma unroll 16
            for (int k = 0; k < 64; ++k) acc += pos[k] * w1[(size_t)k * 64 + lane];
            pt[(kv * 32 + part) * 64 + lane] = acc; }
    }
}

DI void lru_weights(const KA& a, int l, int gw, int NGW, int lane) {
    bf16* W = (bf16*)(a.ws + WS_LRUW); const float* wa = a.in[7] + (size_t)l * 4 * 4096; const float* wx = a.in[9] + (size_t)l * 4 * 4096;
    (void)NGW; { const int idx = gw * 64 + lane; if (idx < 32768) { const int i = idx & 63, j = (idx >> 6) & 63, mat = (idx >> 12) & 1, hbk = idx >> 13;
        W[idx] = (bf16)f2bf((mat ? wx : wa)[(size_t)hbk * 4096 + i * 64 + j]); } }
}
DI void phase0_rows(const KA& a, int l, int mode, int gw, int NGW, int lane) {
    const GAS float* xin = (const GAS float*)a.in[0]; GAS bf16* xb = (GAS bf16*)(a.ws + WS_XB);
    const GAS bf16* eo = (const GAS bf16*)(a.ws + WS_PROJ);
    GAS float* outp = (GAS float*)a.out;
    const GAS float* g = (const GAS float*)(mode ? a.in[2] : (a.in[3] + (size_t)l * 1024));
    f32x4 gv[2][2];
#pragma unroll
    for (int j = 0; j < 2; ++j) { gv[j][0] = *(const GAS f32x4*)(g + 8 * (lane + 64 * j)); gv[j][1] = *(const GAS f32x4*)(g + 8 * (lane + 64 * j) + 4); }
    for (int m0 = gw * 4; m0 < T; m0 += NGW * 4) {
        f32x4 v[4][2][2]; float ss[4];
        if (l == 0) {
#pragma unroll
            for (int rr = 0; rr < 4; ++rr)
#pragma unroll
                for (int j = 0; j < 2; ++j) { const GAS float* xp = xin + (size_t)(m0 + rr) * 1024 + 8 * (lane + 64 * j); v[rr][j][0] = *(const GAS f32x4*)xp; v[rr][j][1] = *(const GAS f32x4*)(xp + 4); }
        } else {
            u32x4 xw[4][2], e0[4][2], e1[4][2];
#pragma unroll
            for (int rr = 0; rr < 4; ++rr)
#pragma unroll
                for (int j = 0; j < 2; ++j) { const size_t co = 8 * (lane + 64 * j);
                    xw[rr][j] = *(const GAS u32x4*)(xb + (size_t)(m0 + rr) * 1024 + co);
                    e0[rr][j] = *(const GAS u32x4*)(eo + (size_t)(2 * (m0 + rr)) * 1024 + co); e1[rr][j] = *(const GAS u32x4*)(eo + (size_t)(2 * (m0 + rr) + 1) * 1024 + co); }
#pragma unroll
            for (int rr = 0; rr < 4; ++rr)
#pragma unroll
                for (int j = 0; j < 2; ++j) { const u32x4 x4 = xw[rr][j], a4 = e0[rr][j], b4 = e1[rr][j];
                    v[rr][j][0][0] = lo_bf(x4.x) + (lo_bf(a4.x) + lo_bf(b4.x)); v[rr][j][0][1] = hi_bf(x4.x) + (hi_bf(a4.x) + hi_bf(b4.x));
                    v[rr][j][0][2] = lo_bf(x4.y) + (lo_bf(a4.y) + lo_bf(b4.y)); v[rr][j][0][3] = hi_bf(x4.y) + (hi_bf(a4.y) + hi_bf(b4.y));
                    v[rr][j][1][0] = lo_bf(x4.z) + (lo_bf(a4.z) + lo_bf(b4.z)); v[rr][j][1][1] = hi_bf(x4.z) + (hi_bf(a4.z) + hi_bf(b4.z));
                    v[rr][j][1][2] = lo_bf(x4.w) + (lo_bf(a4.w) + lo_bf(b4.w)); v[rr][j][1][3] = hi_bf(x4.w) + (hi_bf(a4.w) + hi_bf(b4.w)); }
        }
#pragma unroll
        for (int rr = 0; rr < 4; ++rr) { float t = 0.f;
#pragma unroll
            for (int j = 0; j < 2; ++j)
#pragma unroll
                for (int h = 0; h < 2; ++h) t += (v[rr][j][h][0] * v[rr][j][h][0] + v[rr][j][h][1] * v[rr][j][h][1]) + (v[rr][j][h][2] * v[rr][j][h][2] + v[rr][j][h][3] * v[rr][j][h][3]);
            ss[rr] = t; }
#pragma unroll
        for (int rr = 0; rr < 4; ++rr) ss[rr] = wave_sum(ss[rr]);
        if (mode) {
#pragma unroll
            for (int rr = 0; rr < 4; ++rr) { const float r = __builtin_amdgcn_rsqf(ss[rr] * (1.f / 1024.f) + 1e-6f); const size_t m = (size_t)(m0 + rr);
#pragma unroll
                for (int j = 0; j < 2; ++j) { GAS float* op = outp + m * 1024 + 8 * (lane + 64 * j); *(GAS f32x4*)op = v[rr][j][0] * r * gv[j][0]; *(GAS f32x4*)(op + 4) = v[rr][j][1] * r * gv[j][1]; } }
        } else {
            GAS unsigned char* hq = (GAS unsigned char*)(a.ws + WS_HQ); GAS float* hsc = (GAS float*)(a.ws + WS_HSC);
            float am[4];
#pragma unroll
            for (int rr = 0; rr < 4; ++rr) { const float r = __builtin_amdgcn_rsqf(ss[rr] * (1.f / 1024.f) + 1e-6f); const size_t m = (size_t)(m0 + rr); float t = 0.f;
#pragma unroll
                for (int j = 0; j < 2; ++j) {
                    if (l > 0) { u32x4 w; w.x = pk2(v[rr][j][0][0], v[rr][j][0][1]); w.y = pk2(v[rr][j][0][2], v[rr][j][0][3]); w.z = pk2(v[rr][j][1][0], v[rr][j][1][1]); w.w = pk2(v[rr][j][1][2], v[rr][j][1][3]);
                        *(GAS u32x4*)(xb + m * 1024 + 8 * (lane + 64 * j)) = w; }
#pragma unroll
                    for (int h = 0; h < 2; ++h) { const f32x4 y = v[rr][j][h] * r * gv[j][h]; v[rr][j][h] = y;
                        t = fmaxf(t, fmaxf(fmaxf(fabsf(y[0]), fabsf(y[1])), fmaxf(fabsf(y[2]), fabsf(y[3])))); } }
                am[rr] = t; }
#pragma unroll
            for (int rr = 0; rr < 4; ++rr) am[rr] = fmaxf(wave_max(am[rr]), 1e-20f);
#pragma unroll
            for (int rr = 0; rr < 4; ++rr) { const size_t m = (size_t)(m0 + rr); const float qs = 127.f * __builtin_amdgcn_rcpf(am[rr]);
                if (lane == 0) hsc[m] = am[rr] * (1.f / 127.f);
#pragma unroll
                for (int j = 0; j < 2; ++j) { u32x2 q2;
#pragma unroll
                    for (int h = 0; h < 2; ++h) { const f32x4 y = v[rr][j][h] * qs;
                        const unsigned q = ((unsigned)(int)__builtin_rintf(y[0]) & 255u) | (((unsigned)(int)__builtin_rintf(y[1]) & 255u) << 8) | (((unsigned)(int)__builtin_rintf(y[2]) & 255u) << 16) | (((unsigned)(int)__builtin_rintf(y[3]) & 255u) << 24);
                        if (h == 0) q2.x = q; else q2.y = q; }
                    *(GAS u32x2*)(hq + m * 1024 + 8 * (lane + 64 * j)) = q2; } }
        }
    }
}

DI int crow(int i, int hh) { return (i & 3) + 8 * (i >> 2) + 4 * hh; }
DI unsigned cvtpk(float lo, float hi) { f32x2 v = {lo, hi}; bf16x2_t b = __builtin_convertvector(v, bf16x2_t); return __builtin_bit_cast(unsigned, b); }
template <int CTRL, int RMASK> DI float dppf(float oldv, float v) { return __builtin_bit_cast(float, __builtin_amdgcn_update_dpp(__builtin_bit_cast(int, oldv), __builtin_bit_cast(int, v), CTRL, RMASK, 0xf, false)); }
template <int CTRL, int RMASK> DI void scan_step(float& a, float& b) {
    const float ap = dppf<CTRL, RMASK>(1.f, a), bp = dppf<CTRL, RMASK>(0.f, b); b = a * bp + b; a = a * ap; }
DI void lru_unit(const KA& a, int l, const GAS bf16* proj, GAS bf16* ys, GAS float* sums, LAS unsigned char* lds, int task, int lane_in, int wave_in, bool final) {
    int lane = lane_in, wave = wave_in; asm volatile("" : "+v"(lane), "+s"(wave));
    const int chunk = task & 31, hbk = (task >> 5) & 3, b = task >> 7;
    const int ts = chunk * 256 + wave * 32; const size_t rowb = (size_t)b * SEQ;
    LAS unsigned char* wl = lds + wave * 16384;
    LAS float* ex = (LAS float*)(lds + LRUEX_OFF); LAS float* cst = (LAS float*)(lds + LRUCST_OFF); LAS float* car = (LAS float*)(lds + LRUCAR_OFF) + wave * 64;
    const int n = lane & 31, hh = lane >> 5;
    const int c = hbk * 64 + lane;
    const GAS float* cw = (const GAS float*)(a.in[5] + (size_t)l * 4 * 256);
    const GAS float* p6 = (const GAS float*)a.in[6]; const GAS float* p8 = (const GAS float*)a.in[8]; const GAS float* p10 = (const GAS float*)a.in[10]; const GAS float* p11 = (const GAS float*)a.in[11];
    const float cw0 = cw[c], cw1 = cw[256 + c], cw2 = cw[512 + c], cw3 = cw[768 + c]; const float cb = p6[l * 256 + c];
    const float k8 = p8[l * 256 + c], k10 = p10[l * 256 + c], k11 = p11[l * 256 + c];
    const GAS bf16* xp = proj + (rowb + ts) * PLD + C_AX + c;
    unsigned short xraw[35];
#pragma unroll
    for (int j = 0; j < 3; ++j) xraw[j] = (ts >= 3 - j) ? *(const GAS unsigned short*)(xp - (3 - j) * PLD) : (unsigned short)0;
#pragma unroll
    for (int j = 0; j < 32; ++j) xraw[3 + j] = *(const GAS unsigned short*)(xp + (size_t)j * PLD);
    const GAS bf16* wt = (const GAS bf16*)(a.ws + WS_LRUW) + (size_t)hbk * 8192;
    bf16x8 afr[4][4];
#pragma unroll
    for (int m = 0; m < 4; ++m)
#pragma unroll
        for (int s4 = 0; s4 < 4; ++s4) afr[m][s4] = *(const GAS bf16x8*)(wt + (size_t)(m >> 1) * 4096 + (32 * (m & 1) + n) * 64 + 8 * hh + 16 * s4);
    f32x2 sv[31]; u32x2 gt2[2][4];
    const GAS bf16* gp = proj + (rowb + ts + n) * PLD + C_AG + hbk * 64;
    if (final) {
        const GAS f32x2* sp = (const GAS f32x2*)(sums + ((size_t)((b * 4 + hbk) * 32) * 64 + lane) * 2);
#pragma unroll
        for (int cc = 0; cc < 31; ++cc) { const int ci = cc < chunk ? cc : 0; sv[cc] = sp[(size_t)ci * 64]; }
#pragma unroll
        for (int mm = 0; mm < 2; ++mm)
#pragma unroll
            for (int g4 = 0; g4 < 4; ++g4) gt2[mm][g4] = *(const GAS u32x2*)(gp + 32 * mm + 8 * g4 + 4 * hh);
    }
    {
        if (wave == 0) { cst[lane] = -1.4426950408889634f * k8; cst[64 + lane] = -1.4426950408889634f * k10; cst[128 + lane] = -8.f * 1.4426950408889634f * softplusf_(-k11); }
        float x3 = __builtin_bit_cast(float, (unsigned)xraw[0] << 16), x2 = __builtin_bit_cast(float, (unsigned)xraw[1] << 16), x1 = __builtin_bit_cast(float, (unsigned)xraw[2] << 16);
#pragma unroll
        for (int j = 0; j < 32; ++j) { const float x0 = __builtin_bit_cast(float, (unsigned)xraw[3 + j] << 16); const float xc = cb + cw0 * x3 + cw1 * x2 + cw2 * x1 + cw3 * x0;
            *(LAS bf16*)(wl + j * 144 + lane * 2) = (bf16)f2bf(xc); *(LAS float*)(wl + 4608 + j * 272 + lane * 4) = xc; x3 = x2; x2 = x1; x1 = x0; }
    }
    f32x16 D[4];
    {
        bf16x8 bfr[4];
        LDS_WAIT();
#pragma unroll
        for (int s4 = 0; s4 < 4; ++s4) bfr[s4] = *(const LAS bf16x8*)(wl + n * 144 + hh * 16 + s4 * 32);
#pragma unroll
        for (int m = 0; m < 4; ++m) {
#pragma unroll
            for (int s4 = 0; s4 < 4; ++s4) {
                if (s4 == 0) { f32x16 z;
#pragma unroll
                    for (int i = 0; i < 16; ++i) z[i] = 0.f;
                    D[m] = MFMA32(afr[m][s4], bfr[s4], z); } else D[m] = MFMA32(afr[m][s4], bfr[s4], D[m]); } }
    }
    __syncthreads();
    const bool t0 = (ts + n) == 0;
#pragma unroll
    for (int mm = 0; mm < 2; ++mm)
#pragma unroll
        for (int g4 = 0; g4 < 4; ++g4) { const int c0 = 32 * mm + 8 * g4 + 4 * hh;
            const f32x4 vba = *(const LAS f32x4*)(cst + c0), vbx = *(const LAS f32x4*)(cst + 64 + c0), vc8 = *(const LAS f32x4*)(cst + 128 + c0);
            const f32x4 vxc = *(const LAS f32x4*)(wl + 4608 + n * 272 + c0 * 4);
#pragma unroll
            for (int e = 0; e < 4; ++e) { const int i = 4 * g4 + e;
                const float r = __builtin_amdgcn_rcpf(1.f + __builtin_amdgcn_exp2f(D[mm][i] * -1.4426950408889634f + vba[e]));
                const float ig = __builtin_amdgcn_rcpf(1.f + __builtin_amdgcn_exp2f(D[2 + mm][i] * -1.4426950408889634f + vbx[e]));
                const float av = __builtin_amdgcn_exp2f(vc8[e] * r);
                const float mult = t0 ? 1.f : __builtin_amdgcn_sqrtf(fmaxf(1.f - av * av, 0.f));
                float aa = av, bb = mult * ig * vxc[e];
                scan_step<0x111, 0xf>(aa, bb); scan_step<0x112, 0xf>(aa, bb); scan_step<0x114, 0xf>(aa, bb); scan_step<0x118, 0xf>(aa, bb); scan_step<0x142, 0xa>(aa, bb);
                D[mm][i] = aa; D[2 + mm][i] = bb; } }
    if (n == 31) {
#pragma unroll
        for (int mm = 0; mm < 2; ++mm)
#pragma unroll
            for (int i = 0; i < 16; ++i) { const int c = 32 * mm + crow(i, hh); ex[(wave * 64 + c) * 2] = D[mm][i]; ex[(wave * 64 + c) * 2 + 1] = D[2 + mm][i]; } }
    __syncthreads();
    if (!final) {
        if (wave == 0) { float hv = 0.f, av = 1.f;
#pragma unroll
            for (int w = 0; w < 8; ++w) { const float A_ = ex[(w * 64 + lane) * 2], H_ = ex[(w * 64 + lane) * 2 + 1]; hv = A_ * hv + H_; av *= A_; }
            GAS float* sp = sums + ((size_t)((b * 4 + hbk) * 32 + chunk) * 64 + lane) * 2; sp[0] = av; sp[1] = hv; }
    } else {
        {   float hv = 0.f;
#pragma unroll
            for (int cc = 0; cc < 31; ++cc) { const float A_ = cc < chunk ? sv[cc][0] : 1.f, H_ = cc < chunk ? sv[cc][1] : 0.f; hv = A_ * hv + H_; }
            for (int w = 0; w < wave; ++w) { const float A_ = ex[(w * 64 + lane) * 2], H_ = ex[(w * 64 + lane) * 2 + 1]; hv = A_ * hv + H_; }
            car[lane] = hv; }
        LDS_WAIT(); asm volatile("" ::: "memory");
        GAS bf16* yp = ys + (rowb + ts + n) * 1024 + hbk * 64;
#pragma unroll
        for (int mm = 0; mm < 2; ++mm)
#pragma unroll
            for (int g4 = 0; g4 < 4; ++g4) { const int c0 = 32 * mm + 8 * g4 + 4 * hh; const f32x4 cv = *(const LAS f32x4*)(car + c0);
                const u32x2 gw2 = gt2[mm][g4]; float y[4];
#pragma unroll
                for (int e = 0; e < 4; ++e) { const int i = 4 * g4 + e; const float hv = D[2 + mm][i] + D[mm][i] * cv[e];
                    const float gt = (e == 0) ? lo_bf(gw2.x) : (e == 1) ? hi_bf(gw2.x) : (e == 2) ? lo_bf(gw2.y) : hi_bf(gw2.y); const float wv = gt * (2.302208198f + 0.102943240f * gt * gt);
                    y[e] = hv * (gt - gt * __builtin_amdgcn_rcpf(__builtin_amdgcn_exp2f(wv) + 1.f)); }
                u32x2 yo; yo.x = cvtpk(y[0], y[1]); yo.y = cvtpk(y[2], y[3]); *(GAS u32x2*)(yp + c0) = yo; }
    }
    __syncthreads();
}

constexpr int DK_STR = 144, DV_STR = 192, DBUF_BYTES = 64 * DK_STR + 64 * DV_STR;
DI bf16x8 pack_half(const f32x16& x, int s2) { u32x4 p;
    if (s2 == 0) { p.x = cvtpk(x[0], x[1]); p.y = cvtpk(x[2], x[3]); p.z = cvtpk(x[4], x[5]); p.w = cvtpk(x[6], x[7]); }
    else { p.x = cvtpk(x[8], x[9]); p.y = cvtpk(x[10], x[11]); p.z = cvtpk(x[12], x[13]); p.w = cvtpk(x[14], x[15]); }
    return __builtin_bit_cast(bf16x8, p); }
DI s16x4 vtr(const LAS unsigned char* p) { return __builtin_bit_cast(s16x4, __builtin_amdgcn_ds_read_tr16_b64_v4i16((LAS v4i16_t*)p)); }
DI float max16(const f32x16& x) { float a = fmaxf(fmaxf(x[0], x[1]), fmaxf(x[2], x[3])), b = fmaxf(fmaxf(x[4], x[5]), fmaxf(x[6], x[7])), c = fmaxf(fmaxf(x[8], x[9]), fmaxf(x[10], x[11])), d = fmaxf(fmaxf(x[12], x[13]), fmaxf(x[14], x[15])); return fmaxf(fmaxf(a, b), fmaxf(c, d)); }
DI void diff_unit(const GAS bf16* proj, GAS bf16* ys, LAS unsigned char* lds, const LAS float* bias2, const GAS float* subg, const LAS float* lamp, int b, int h, int qb, int wave_in) {
    int wave = wave_in; asm volatile("" : "+s"(wave)); const int lane = my_lane(); const int tid = wave * 64 + lane;
    const int q0 = qb * 256 + wave * 32; const int ql = lane & 31, hh = lane >> 5; const int q = q0 + ql;
    const size_t rowb = (size_t)b * SEQ;
    const float SC = 0.17677669529663687f * 1.4426950408889634f;
    bf16x8 qf[2][2];
    { const GAS bf16* qp = proj + (rowb + q) * PLD + C_CQ + h * 64 + hh * 8;
#pragma unroll
      for (int m = 0; m < 2; ++m)
#pragma unroll
        for (int s = 0; s < 2; ++s) { const u32x4 w = *(const GAS u32x4*)(qp + m * 32 + s * 16); u32x4 o;
            o.x = cvtpk(lo_bf(w.x) * SC, hi_bf(w.x) * SC); o.y = cvtpk(lo_bf(w.y) * SC, hi_bf(w.y) * SC); o.z = cvtpk(lo_bf(w.z) * SC, hi_bf(w.z) * SC); o.w = cvtpk(lo_bf(w.w) * SC, hi_bf(w.w) * SC);
            qf[m][s] = __builtin_bit_cast(bf16x8, o); } }
    f32x16 O[2][2], negm[2];
#pragma unroll
    for (int i = 0; i < 16; ++i) { O[0][0][i] = 0.f; O[0][1][i] = 0.f; O[1][0][i] = 0.f; O[1][1][i] = 0.f; negm[0][i] = 120.f; negm[1][i] = 120.f; }
    float lsum[2] = {0.f, 0.f};
    const int nsteps = 4 * qb + 4, mysteps = 4 * qb + (wave >> 1) + 1;
    const int skey = tid >> 3, sch = tid & 7;
    const GAS unsigned char* kgb = (const GAS unsigned char*)(proj + rowb * PLD + C_CK + h * 64);
    const GAS unsigned char* vgb = (const GAS unsigned char*)(proj + rowb * PLD + C_CV + h * 64);
    const unsigned soff = (unsigned)(skey * PLD + sch * 8) * 2u;
    u32x4 kr = *(const GAS u32x4*)(kgb + soff), vr = *(const GAS u32x4*)(vgb + soff);
    *(LAS u32x4*)(lds + skey * DK_STR + sch * 16) = kr; *(LAS u32x4*)(lds + 64 * DK_STR + skey * DV_STR + sch * 16) = vr;
    __syncthreads();
    const int i16 = lane & 15, blk = (lane >> 4) & 1;
    const int kboff = ql * DK_STR + hh * 16;
    const int vboff = 64 * DK_STR + (4 * hh + (i16 >> 2)) * DV_STR + (16 * blk + 4 * (i16 & 3)) * 2;
#pragma unroll 1
    for (int kt = 0; kt < nsteps; ++kt) {
        const LAS unsigned char* cur = lds + (kt & 1) * DBUF_BYTES; LAS unsigned char* nxt = lds + ((kt + 1) & 1) * DBUF_BYTES;
        if (kt + 1 < nsteps) { const unsigned so = soff + (unsigned)(kt + 1) * (64u * PLD * 2u); kr = *(const GAS u32x4*)(kgb + so); vr = *(const GAS u32x4*)(vgb + so); }
        if (kt < mysteps) {
            const int kbase = kt * 64;
            const bool near = (q0 - (kbase + 63) < 113);
#pragma unroll
            for (int m = 0; m < 2; ++m) {
                bf16x8 pk[2][2];
                f32x16 S[2]; float ts = 0.f;
                {   bf16x8 kf[2][2];
#pragma unroll
                    for (int t = 0; t < 2; ++t)
#pragma unroll
                        for (int s = 0; s < 2; ++s) kf[t][s] = *(const LAS bf16x8*)(cur + kboff + t * 32 * DK_STR + m * 64 + s * 32);
#pragma unroll
                    for (int t = 0; t < 2; ++t) { S[t] = MFMA32(kf[t][0], qf[m][0], negm[m]); S[t] = MFMA32(kf[t][1], qf[m][1], S[t]); } }
                if (near) {
#pragma unroll
                    for (int t = 0; t < 2; ++t)
#pragma unroll
                        for (int g = 0; g < 2; ++g) { float tb[8];
#pragma unroll
                            for (int j = 0; j < 8; ++j) { const int dist = q - (kbase + 32 * t + crow(8 * g + j, hh)); const int di = dist < 0 ? 0 : (dist < 128 ? dist : 128); tb[j] = bias2[di * 12 + 4 + h]; }
#pragma unroll
                            for (int j = 0; j < 8; ++j) { const int dist = q - (kbase + 32 * t + crow(8 * g + j, hh)); S[t][8 * g + j] += dist >= 0 ? tb[j] : -1e30f; }
                            __builtin_amdgcn_sched_barrier(0); } }
#pragma unroll
                for (int t = 0; t < 2; ++t)
#pragma unroll
                    for (int i = 0; i < 16; ++i) { const float p = __builtin_amdgcn_exp2f(S[t][i]); S[t][i] = p; ts += p; }
                if (__builtin_amdgcn_ballot_w64(!(ts < 1.0e30f)) != 0ull) {
                {   bf16x8 kf[2][2];
#pragma unroll
                        for (int t = 0; t < 2; ++t)
#pragma unroll
                            for (int s = 0; s < 2; ++s) kf[t][s] = *(const LAS bf16x8*)(cur + kboff + t * 32 * DK_STR + m * 64 + s * 32);
#pragma unroll
                        for (int t = 0; t < 2; ++t) { S[t] = MFMA32(kf[t][0], qf[m][0], negm[m]); S[t] = MFMA32(kf[t][1], qf[m][1], S[t]); } }
                    if (near) {
#pragma unroll
                        for (int t = 0; t < 2; ++t)
#pragma unroll
                            for (int g = 0; g < 2; ++g) { float tb[8];
#pragma unroll
                                for (int j = 0; j < 8; ++j) { const int dist = q - (kbase + 32 * t + crow(8 * g + j, hh)); const int di = dist < 0 ? 0 : (dist < 128 ? dist : 128); tb[j] = bias2[di * 12 + 4 + h]; }
#pragma unroll
                                for (int j = 0; j < 8; ++j) { const int dist = q - (kbase + 32 * t + crow(8 * g + j, hh)); S[t][8 * g + j] += dist >= 0 ? tb[j] : -1e30f; }
                                __builtin_amdgcn_sched_barrier(0); } }
                    float tm = fmaxf(max16(S[0]), max16(S[1])); tm = fmaxf(tm, xshfl<32>(tm));
                    const float sh = fmaxf(tm, 0.f); const float al = __builtin_amdgcn_exp2f(-sh);
                    lsum[m] *= al; ts = 0.f;
#pragma unroll
                    for (int i = 0; i < 16; ++i) { O[m][0][i] *= al; O[m][1][i] *= al; negm[m][i] -= sh; }
#pragma unroll
                    for (int t = 0; t < 2; ++t)
#pragma unroll
                        for (int i = 0; i < 16; ++i) { const float p = __builtin_amdgcn_exp2f(S[t][i] - sh); S[t][i] = p; ts += p; }
                }
                lsum[m] += ts;
#pragma unroll
                for (int t = 0; t < 2; ++t) { pk[t][0] = pack_half(S[t], 0); pk[t][1] = pack_half(S[t], 1); }
#pragma unroll
                for (int t = 0; t < 2; ++t)
#pragma unroll
                    for (int s2 = 0; s2 < 2; ++s2)
#pragma unroll
                        for (int db = 0; db < 2; ++db) {
                            const s16x4 lo = vtr(cur + vboff + (32 * t + 16 * s2) * DV_STR + db * 64), hi = vtr(cur + vboff + (32 * t + 16 * s2 + 8) * DV_STR + db * 64);
                            const bf16x8 vf = __builtin_shufflevector(lo, hi, 0, 1, 2, 3, 4, 5, 6, 7);
                            O[m][db] = MFMA32(vf, pk[t][s2], O[m][db]); }
                ;
            }
        }
        if (kt + 1 < nsteps) { *(LAS u32x4*)(nxt + skey * DK_STR + sch * 16) = kr; *(LAS u32x4*)(nxt + 64 * DK_STR + skey * DV_STR + sch * 16) = vr; }
        __syncthreads();
    }
    const float l0 = lsum[0] + xshfl<32>(lsum[0]), l1 = lsum[1] + xshfl<32>(lsum[1]);
    const float lam = lamp[0], lam_init = lamp[1];
    const float i0 = 1.f / fmaxf(l0, 1e-30f), i1 = lam / fmaxf(l1, 1e-30f);
    float ss = 0.f;
#pragma unroll
    for (int db = 0; db < 2; ++db)
#pragma unroll
        for (int i = 0; i < 16; ++i) { const float at = O[0][db][i] * i0 - O[1][db][i] * i1; O[0][db][i] = at; ss += at * at; }
    ss += xshfl<32>(ss);
    const float r = (1.f - lam_init) / sqrtf(ss * (1.f / 64.f) + 1e-5f);
    GAS bf16* op = ys + (rowb + q) * 1024 + 512 + h * 64;
#pragma unroll
    for (int db = 0; db < 2; ++db)
#pragma unroll
        for (int gq = 0; gq < 4; ++gq) { const int d0 = 32 * db + 8 * gq + 4 * hh; const f32x4 sg = *(const GAS f32x4*)(subg + d0);
            u32x2 w; w.x = cvtpk(O[0][db][4 * gq + 0] * r * sg[0], O[0][db][4 * gq + 1] * r * sg[1]); w.y = cvtpk(O[0][db][4 * gq + 2] * r * sg[2], O[0][db][4 * gq + 3] * r * sg[3]);
            *(GAS u32x2*)(op + d0) = w; }
}

struct SchedCmp { const char* proj; const char* wc; int G, c;
    DI bool next(int i, Unit& u) const { const int L = i * G + c; if (L >= 16) return false; const int kv = L >> 3, rt = L & 7;
        u.pm = rt; u.pn = 0; u.aux = kv; u.pad = 0; u.a = proj + ((size_t)rt * 256 * 16 * PLD + (kv ? C_VC : C_KC)) * 2; u.b = wc + (size_t)kv * 256 * 1024 * 2; return true; } };
struct EpiCmp { static constexpr bool CARRY = false; float* ab;
    DI void operator()(const f32x4 (&acc)[2][2][4][2], const Unit& u, int wr, int wc, int fr, int fq) const {
        const int row0 = u.pm * 256 + wr * 64 + fr; const int col = wc * 32 + 8 * fq;
#pragma unroll
        for (int ai = 0; ai < 2; ++ai)
#pragma unroll
            for (int m = 0; m < 4; ++m) { float* rp = ab + ((size_t)u.aux * 2048 + row0 + ai * 128 + m * 16) * 128 + col; *(f32x4*)rp = acc[ai][0][m][0]; *(f32x4*)(rp + 4) = acc[ai][0][m][1]; }
    }
};
DI void cmp_finish(const KA& a, int l, const float* ab, bf16* kcb, int task, int lane) {
    const int kv = task / (BATCH * NCMP), r = task % (BATCH * NCMP), b = r / NCMP, c = r % NCMP;
    const float* w2 = a.in[kv ? 23 : 20] + (size_t)l * 4096; const float* pt = ab + 2 * 2048 * 128;
    const size_t g = (size_t)kv * 2048 + b * 512 + c;
    float ptv = 0.f;
#pragma unroll
    for (int part = 0; part < 32; ++part) ptv += pt[(kv * 32 + part) * 64 + lane];
    const float h1 = ab[g * 128 + lane] + ab[(g + 1) * 128 + 64 + lane] + ptv;
    const float gl = gelu_tanh(h1); float o = 0.f;
#pragma unroll
    for (int j = 0; j < 64; ++j) o += rl(gl, j) * w2[j * 64 + lane];
    kcb[((size_t)(kv * BATCH + b) * 512 + c) * 64 + lane] = (bf16)f2bf(o);
    if (c == NCMP - 1) kcb[((size_t)(kv * BATCH + b) * 512 + NCMP) * 64 + lane] = 0;
}

DI void cmp_block(const KA& a, int l, const GAS bf16* proj, const GAS bf16* wcT, float* ab, bf16* kcb, int bid, int wave, int lane) {
    const int kv = bid >> 7, g0 = (bid & 127) * 16, r = lane & 15, q = lane >> 4, sh = wave >> 2;
    const int grow = g0 + r + sh; const bool st_ok = !(sh != 0 && (grow & 511) == 0);
    const int gld = grow > 2047 ? 2047 : grow;
    const GAS bf16* apn = proj + (size_t)gld * 16 * PLD + (kv ? C_VC : C_KC) + 8 * q;
    const GAS bf16* bpn = wcT + ((size_t)kv * 256 + wave * 16 + r) * 1024 + 8 * q;
    f32x4 acc = {0.f, 0.f, 0.f, 0.f};
#pragma unroll 16
    for (int s = 0; s < 32; ++s) {
        const bf16x8 av = *(const GAS bf16x8*)(apn + (size_t)(s >> 1) * PLD + 32 * (s & 1));
        const bf16x8 bv = *(const GAS bf16x8*)(bpn + 32 * s);
        acc = __builtin_amdgcn_mfma_f32_16x16x32_bf16(bv, av, acc, 0, 0, 0);
    }
    if (st_ok) *(GAS f32x4*)((GAS float*)ab + ((size_t)kv * 2048 + grow) * 128 + wave * 16 + 4 * q) = acc;
    VM_WAIT(); __syncthreads();
    {   const float* w2 = a.in[kv ? 23 : 20] + (size_t)l * 4096; const float* pt = ab + 2 * 2048 * 128;
        const int ga = g0 + 2 * wave; const size_t gA = (size_t)kv * 2048 + ga;
        float ptp[32], w2v[64], hA[3], hB[3];
#pragma unroll
        for (int part = 0; part < 32; ++part) ptp[part] = pt[(kv * 32 + part) * 64 + lane];
#pragma unroll
        for (int i = 0; i < 2; ++i) { hA[i] = ab[(gA + i) * 128 + lane]; hB[i] = ab[(gA + i + 1) * 128 + 64 + lane]; }
#pragma unroll
        for (int j = 0; j < 64; ++j) w2v[j] = w2[j * 64 + lane];
        float ptv = 0.f;
#pragma unroll
        for (int part = 0; part < 32; ++part) ptv += ptp[part];
#pragma unroll
        for (int i = 0; i < 2; ++i) { const int g = ga + i, c = g & 511, b = g >> 9;
            if (c < NCMP) {
                const float gl = gelu_tanh(hA[i] + hB[i] + ptv); float o = 0.f;
#pragma unroll
                for (int j = 0; j < 64; ++j) o += rl(gl, j) * w2v[j];
                kcb[((size_t)(kv * BATCH + b) * 512 + c) * 64 + lane] = (bf16)f2bf(o);
                if (c == NCMP - 1) kcb[((size_t)(kv * BATCH + b) * 512 + NCMP) * 64 + lane] = 0; } }
    }
}

DI void st_load(const GAS unsigned char* kb, const GAS unsigned char* vb, unsigned off, u32x4& kr, u32x4& vr) { kr = *(const GAS u32x4*)(kb + off); vr = *(const GAS u32x4*)(vb + off); }
DI void st_write(LAS unsigned char* buf, int skey, int sch, const u32x4& kr, const u32x4& vr) { *(LAS u32x4*)(buf + skey * DK_STR + sch * 16) = kr; *(LAS u32x4*)(buf + 64 * DK_STR + skey * DV_STR + sch * 16) = vr; }
DI void qk64(const LAS unsigned char* cur, int kboff, const bf16x8 (&qf)[4], const f32x16& cinit, f32x16 (&S)[2]) {
#pragma unroll
    for (int t = 0; t < 2; ++t) { S[t] = cinit;
#pragma unroll
        for (int s = 0; s < 4; ++s) { const bf16x8 kf = *(const LAS bf16x8*)(cur + kboff + t * 32 * DK_STR + s * 32); S[t] = MFMA32(kf, qf[s], S[t]); } }
}
DI void qk32z(const LAS unsigned char* kt32, const bf16x8 (&qf)[4], f32x16& S) {
#pragma unroll
    for (int s = 0; s < 4; ++s) { const bf16x8 kf = *(const LAS bf16x8*)(kt32 + s * 32);
        if (s == 0) { f32x16 z;
#pragma unroll
            for (int i = 0; i < 16; ++i) z[i] = 0.f;
            S = MFMA32(kf, qf[s], z); } else S = MFMA32(kf, qf[s], S); }
}
DI void pv32(const LAS unsigned char* vt32, const bf16x8 (&pk)[2], f32x16 (&O)[2]) {
#pragma unroll
    for (int s2 = 0; s2 < 2; ++s2)
#pragma unroll
        for (int db = 0; db < 2; ++db) {
            const s16x4 lo = vtr(vt32 + (16 * s2) * DV_STR + db * 64), hi = vtr(vt32 + (16 * s2 + 8) * DV_STR + db * 64);
            const bf16x8 vf = __builtin_shufflevector(lo, hi, 0, 1, 2, 3, 4, 5, 6, 7);
            O[db] = MFMA32(vf, pk[s2], O[db]); }
}
DI void mask_bias_cmp32(f32x16& S, int tcol_in, int cbase, int hh, const LAS float* b2h, float msub) {
    int tcol = tcol_in; asm volatile("" : "+v"(tcol));
#pragma unroll
    for (int g = 0; g < 2; ++g) {
        float bv[8];
#pragma unroll
        for (int j = 0; j < 8; ++j) { const int i = 8 * g + j; const int c = cbase + crow(i, hh); const int dist = tcol - 31 - 16 * c; const int di = dist < 0 ? 0 : (dist < 128 ? dist : 128); bv[j] = b2h[di * 12]; }
#pragma unroll
        for (int j = 0; j < 8; ++j) { const int i = 8 * g + j; const int c = cbase + crow(i, hh); const int dist = tcol - 31 - 16 * c; const bool ok = dist >= 0 && c < NCMP;
            const float sb = S[i] + (bv[j] - msub); S[i] = ok ? sb : -1e30f; }
        __builtin_amdgcn_sched_barrier(0); }
}
DI void pv64(const LAS unsigned char* cur, int vboff, const bf16x8 (&pk)[2][2], f32x16 (&O)[2]) {
#pragma unroll
    for (int t = 0; t < 2; ++t)
#pragma unroll
        for (int s2 = 0; s2 < 2; ++s2)
#pragma unroll
            for (int db = 0; db < 2; ++db) {
                const s16x4 lo = vtr(cur + vboff + (32 * t + 16 * s2) * DV_STR + db * 64), hi = vtr(cur + vboff + (32 * t + 16 * s2 + 8) * DV_STR + db * 64);
                const bf16x8 vf = __builtin_shufflevector(lo, hi, 0, 1, 2, 3, 4, 5, 6, 7);
                O[db] = MFMA32(vf, pk[t][s2], O[db]); }
}
DI void softmax_step(f32x16 (&S)[2], f32x16 (&O)[2], f32x16& negm, float& lsum, bf16x8 (&pk)[2][2]) {
    float tm = fmaxf(max16(S[0]), max16(S[1]));
    if (__builtin_amdgcn_ballot_w64(tm > 8.f) != 0ull) {
        tm = fmaxf(tm, xshfl<32>(tm)); const float sh = fmaxf(tm, 0.f); const float al = __builtin_amdgcn_exp2f(-sh);
        lsum *= al;
#pragma unroll
        for (int i = 0; i < 16; ++i) { O[0][i] *= al; O[1][i] *= al; negm[i] -= sh; S[0][i] -= sh; S[1][i] -= sh; } }
#pragma unroll
    for (int t = 0; t < 2; ++t) {
#pragma unroll
        for (int i = 0; i < 16; ++i) { const float p = __builtin_amdgcn_exp2f(S[t][i]); S[t][i] = p; lsum += p; }
        pk[t][0] = pack_half(S[t], 0); pk[t][1] = pack_half(S[t], 1); }
}
DI void mask_bias(f32x16 (&S)[2], int tcol_in, int kbase, int hh, int W, bool colsel, const LAS float* b2h) {
    int tcol = tcol_in; asm volatile("" : "+v"(tcol));
#pragma unroll
    for (int t = 0; t < 2; ++t)
#pragma unroll
        for (int g = 0; g < 2; ++g) {
            float bv[8];
#pragma unroll
            for (int j = 0; j < 8; ++j) { const int i = 8 * g + j; const int dist = tcol - (kbase + 32 * t + crow(i, hh)); const int di = dist < 0 ? 0 : (dist < 128 ? dist : 128); bv[j] = b2h[di * 12]; }
#pragma unroll
            for (int j = 0; j < 8; ++j) { const int i = 8 * g + j; const int dist = tcol - (kbase + 32 * t + crow(i, hh)); const bool ok = colsel && dist >= 0 && dist < W;
                const float sb = S[t][i] + bv[j]; S[t][i] = ok ? sb : -1e30f; }
            __builtin_amdgcn_sched_barrier(0); }
}
DI void sel_tile(const LAS unsigned char* cur, int kboff, int vboff, const bf16x8 (&qf)[4], f32x16 (&Os)[2], f32x16& negm, float& lsel, bool near, bool bit, int t, int kbase, int hh, int W, const LAS float* b2h) {
    f32x16 S[2]; qk64(cur, kboff, qf, negm, S);
    if (near) mask_bias(S, t, kbase, hh, W, bit, b2h);
    float ts = 0.f;
#pragma unroll
    for (int tt = 0; tt < 2; ++tt)
#pragma unroll
        for (int i = 0; i < 16; ++i) { const float p = __builtin_amdgcn_exp2f(S[tt][i]); S[tt][i] = p; ts += p; }
    ts = bit ? ts : 0.f;
    if (__builtin_amdgcn_ballot_w64(!(ts < 1.0e30f)) != 0ull) {
        qk64(cur, kboff, qf, negm, S);
        if (near) mask_bias(S, t, kbase, hh, W, bit, b2h);
        float tm = fmaxf(max16(S[0]), max16(S[1])); tm = bit ? tm : -1e30f; tm = fmaxf(tm, xshfl<32>(tm));
        const float sh = fmaxf(tm, 0.f); const float al = __builtin_amdgcn_exp2f(-sh);
        lsel *= al; ts = 0.f;
#pragma unroll
        for (int i = 0; i < 16; ++i) { Os[0][i] *= al; Os[1][i] *= al; negm[i] -= sh; }
#pragma unroll
        for (int tt = 0; tt < 2; ++tt)
#pragma unroll
            for (int i = 0; i < 16; ++i) { const float p = __builtin_amdgcn_exp2f(S[tt][i] - sh); S[tt][i] = p; ts += p; }
        ts = bit ? ts : 0.f;
    }
    lsel += ts;
    const unsigned km = bit ? 0xFFFFFFFFu : 0u; bf16x8 pk[2][2];
#pragma unroll
    for (int tt = 0; tt < 2; ++tt)
#pragma unroll
        for (int hf = 0; hf < 2; ++hf) { u32x4 w = __builtin_bit_cast(u32x4, pack_half(S[tt], hf)); w.x &= km; w.y &= km; w.z &= km; w.w &= km; pk[tt][hf] = __builtin_bit_cast(bf16x8, w); }
    pv64(cur, vboff, pk, Os);
}
DI void nsa_unit(const GAS bf16* proj, GAS bf16* ys, const GAS bf16* kcb, LAS unsigned char* lds, const LAS float* bias2, int b, int u, int tid_in, int lane_in, int wave_in) {
    (void)tid_in; (void)lane_in; int wave = wave_in; asm volatile("" : "+s"(wave)); const int lane = my_lane(); const int tid = wave * 64 + lane;
    const int t0 = u * 64; const int col = lane & 31, hh = lane >> 5, tl = col >> 2, head = col & 3;
    const int t = t0 + wave * 8 + tl; const int tw0 = t0 + wave * 8;
    const size_t rowb = (size_t)b * SEQ;
    const LAS float* b2h = bias2 + 8 + head;
    bf16x8 qf[4];
    { const float SC = 0.125f * 1.4426950408889634f; const GAS bf16* qp = proj + (rowb + t) * PLD + C_DQ + head * 64 + hh * 8;
#pragma unroll
      for (int s = 0; s < 4; ++s) { const u32x4 w = *(const GAS u32x4*)(qp + s * 16); u32x4 o;
          o.x = cvtpk(lo_bf(w.x) * SC, hi_bf(w.x) * SC); o.y = cvtpk(lo_bf(w.y) * SC, hi_bf(w.y) * SC); o.z = cvtpk(lo_bf(w.z) * SC, hi_bf(w.z) * SC); o.w = cvtpk(lo_bf(w.w) * SC, hi_bf(w.w) * SC);
          qf[s] = __builtin_bit_cast(bf16x8, o); } }
    const int skey = tid >> 3, sch = tid & 7;
    const int i16 = lane & 15, blk = (lane >> 4) & 1;
    const int kboff = col * DK_STR + hh * 16;
    const int vboff = 64 * DK_STR + (4 * hh + (i16 >> 2)) * DV_STR + (16 * blk + 4 * (i16 & 3)) * 2;
    u32x4 kr, vr;
    const int ncvm = (4 * u + 3) < NCMP ? (4 * u + 3) : NCMP;
    const int nsc = (ncvm + 63) >> 6;
    const GAS unsigned char* kcp = (const GAS unsigned char*)(kcb + (size_t)(0 * BATCH + b) * 512 * 64);
    const GAS unsigned char* vcp = (const GAS unsigned char*)(kcb + (size_t)(1 * BATCH + b) * 512 * 64);
    const unsigned soffc = (unsigned)(skey * 64 + sch * 8) * 2u;
    float m1 = -120.f, l1 = 0.f;
    st_load(kcp, vcp, soffc, kr, vr); st_write(lds, skey, sch, kr, vr); __syncthreads();
#pragma unroll 1
    for (int kt = 0; kt < nsc; ++kt) {
        const LAS unsigned char* cur = lds + (kt & 1) * DBUF_BYTES; LAS unsigned char* nxt = lds + ((kt + 1) & 1) * DBUF_BYTES;
        if (kt + 1 < nsc) st_load(kcp, vcp, soffc + (unsigned)(kt + 1) * 8192u, kr, vr);
#pragma unroll
        for (int tt = 0; tt < 2; ++tt) { f32x16 S; qk32z(cur + kboff + tt * 32 * DK_STR, qf, S); mask_bias_cmp32(S, t, kt * 64 + tt * 32, hh, b2h, 0.f);
          const float tm = max16(S); const float mn = fmaxf(m1, tm); float acc = 0.f;
#pragma unroll
          for (int i = 0; i < 16; ++i) acc += __builtin_amdgcn_exp2f(S[i] - mn);
          l1 = l1 * __builtin_amdgcn_exp2f(m1 - mn) + acc; m1 = mn; }
        if (kt + 1 < nsc) st_write(nxt, skey, sch, kr, vr);
        __syncthreads();
    }
    float mf, inv;
    { const float mo = xshfl<32>(m1), lo = xshfl<32>(l1); mf = fmaxf(m1, mo); const float lf = l1 * __builtin_amdgcn_exp2f(m1 - mf) + lo * __builtin_amdgcn_exp2f(mo - mf); inv = lf > 0.f ? 1.f / lf : 0.f; }
    f32x16 Oc[2], imp[4];
#pragma unroll
    for (int i = 0; i < 16; ++i) { Oc[0][i] = 0.f; Oc[1][i] = 0.f; imp[0][i] = 0.f; imp[1][i] = 0.f; imp[2][i] = 0.f; imp[3][i] = 0.f; }
    {   st_load(kcp, vcp, soffc, kr, vr); st_write(lds, skey, sch, kr, vr); __syncthreads();
#pragma unroll 1
        for (int kt = 0; kt < nsc; ++kt) {
            const LAS unsigned char* cur = lds + (kt & 1) * DBUF_BYTES; LAS unsigned char* nxt = lds + ((kt + 1) & 1) * DBUF_BYTES;
            if (kt + 1 < nsc) st_load(kcp, vcp, soffc + (unsigned)(kt + 1) * 8192u, kr, vr);
#pragma unroll
            for (int tt = 0; tt < 2; ++tt) {
                f32x16 S; qk32z(cur + kboff + tt * 32 * DK_STR, qf, S); mask_bias_cmp32(S, t, kt * 64 + tt * 32, hh, b2h, mf);
#pragma unroll
                for (int i = 0; i < 16; ++i) S[i] = __builtin_amdgcn_exp2f(S[i]) * inv;
                bf16x8 pk[2]; pk[0] = pack_half(S, 0); pk[1] = pack_half(S, 1);
                pv32(cur + vboff + tt * 32 * DV_STR, pk, Oc);
                const int Tq = (2 * kt + tt) & 3, MB = (2 * kt + tt) >> 2;
#pragma unroll
                for (int s2 = 0; s2 < 2; ++s2) { u32x4 aw; unsigned e[8];
#pragma unroll
                    for (int jj = 0; jj < 8; ++jj) { const int kk = 16 * s2 + 8 * (jj >> 2) + 4 * hh + (jj & 3); const int delta = 32 * Tq + kk - 4 * col;
                        e[jj] = (delta == -1 || delta == 3) ? 0x3F80u : ((unsigned)delta <= 2u ? 0x4000u : 0u); }
                    aw.x = e[0] | (e[1] << 16); aw.y = e[2] | (e[3] << 16); aw.z = e[4] | (e[5] << 16); aw.w = e[6] | (e[7] << 16);
                    const bf16x8 af = __builtin_bit_cast(bf16x8, aw);
                    if (MB == 0) imp[0] = MFMA32(af, pk[s2], imp[0]); else if (MB == 1) imp[1] = MFMA32(af, pk[s2], imp[1]); else if (MB == 2) imp[2] = MFMA32(af, pk[s2], imp[2]); else imp[3] = MFMA32(af, pk[s2], imp[3]); }
                if (Tq == 3 && MB < 3) { u32x4 aw; aw.x = 0u; aw.y = 0u; aw.z = 0u; aw.w = (lane == 32) ? 0x3F800000u : 0u;
                    const bf16x8 af = __builtin_bit_cast(bf16x8, aw);
                    if (MB == 0) imp[1] = MFMA32(af, pk[1], imp[1]); else if (MB == 1) imp[2] = MFMA32(af, pk[1], imp[2]); else imp[3] = MFMA32(af, pk[1], imp[3]); }
            }
            if (kt + 1 < nsc) st_write(nxt, skey, sch, kr, vr);
            __syncthreads();
        }
    }
    unsigned ocp[2][8];
#pragma unroll
    for (int db = 0; db < 2; ++db)
#pragma unroll
        for (int i = 0; i < 8; ++i) ocp[db][i] = cvtpk(Oc[db][2 * i], Oc[db][2 * i + 1]);
    unsigned sm0 = 0u, sm1 = 0u, sm2 = 0u, sm3 = 0u;
    {   const int cur_t = t >> 6; unsigned key[16];
#pragma unroll
        for (int i = 0; i < 16; ++i) {
            float v0 = imp[0][i], v1 = imp[1][i], v2 = imp[2][i], v3 = imp[3][i];
            v0 += xshfl<1>(v0); v0 += xshfl<2>(v0); v1 += xshfl<1>(v1); v1 += xshfl<2>(v1); v2 += xshfl<1>(v2); v2 += xshfl<2>(v2); v3 += xshfl<1>(v3); v3 += xshfl<2>(v3);
            const float val = head == 0 ? v0 : (head == 1 ? v1 : (head == 2 ? v2 : v3));
            const int j = 32 * head + crow(i, hh);
            const bool forced = (j == 0) || (j == cur_t) || (j == cur_t - 1);
            unsigned fx = (unsigned)(fminf(fmaxf(val, 0.f), 31.f) * 1048576.f) + 1u;
            fx = forced ? 0x1FFFFFFu : (j <= cur_t ? fx : 0u);
            key[i] = (fx << 7) | (unsigned)(127 - j); }
#pragma unroll 1
        for (int r = 0; r < 16; ++r) {
            unsigned w = key[0];
#pragma unroll
            for (int i = 1; i < 16; ++i) w = w > key[i] ? w : key[i];
            { unsigned o = (unsigned)xshfl_i<1>((int)w); w = w > o ? w : o; o = (unsigned)xshfl_i<2>((int)w); w = w > o ? w : o; o = (unsigned)xshfl_i<32>((int)w); w = w > o ? w : o; }
            if ((w >> 7) != 0u) { const int j = 127 - (int)(w & 127u); const unsigned bit = 1u << (j & 31); const int jb = j >> 5;
                sm0 |= (jb == 0) ? bit : 0u; sm1 |= (jb == 1) ? bit : 0u; sm2 |= (jb == 2) ? bit : 0u; sm3 |= (jb == 3) ? bit : 0u; }
#pragma unroll
            for (int i = 0; i < 16; ++i) key[i] = (key[i] == w) ? 0u : key[i];
        }
    }
    f32x16 Ow[2]; float lw = 0.f;
#pragma unroll
    for (int i = 0; i < 16; ++i) { Ow[0][i] = 0.f; Ow[1][i] = 0.f; }
    {   f32x16 negm;
#pragma unroll
        for (int i = 0; i < 16; ++i) negm[i] = 120.f;
        const GAS unsigned char* kwp = (const GAS unsigned char*)(proj + rowb * PLD + C_KW); const GAS unsigned char* vwp = (const GAS unsigned char*)(proj + rowb * PLD + C_VW);
        const unsigned soffp = (unsigned)(skey * PLD + sch * 8) * 2u;
        const int s0 = (u < 8) ? 8 - u : 0;
        st_load(kwp, vwp, soffp + (unsigned)(u - 8 + s0) * (64u * PLD * 2u), kr, vr); st_write(lds, skey, sch, kr, vr); __syncthreads();
#pragma unroll 1
        for (int s = s0; s < 9; ++s) {
            const int par = (s - s0) & 1; const LAS unsigned char* cur = lds + par * DBUF_BYTES; LAS unsigned char* nxt = lds + (par ^ 1) * DBUF_BYTES;
            if (s + 1 < 9) st_load(kwp, vwp, soffp + (unsigned)(u - 8 + s + 1) * (64u * PLD * 2u), kr, vr);
            sel_tile(cur, kboff, vboff, qf, Ow, negm, lw, s == 0 || s >= 6, true, t, (u - 8 + s) * 64, hh, 512, b2h);
            if (s + 1 < 9) st_write(nxt, skey, sch, kr, vr);
            __syncthreads();
        }
    }
    unsigned owp[2][8];
#pragma unroll
    for (int db = 0; db < 2; ++db)
#pragma unroll
        for (int i = 0; i < 8; ++i) owp[db][i] = cvtpk(Ow[db][2 * i], Ow[db][2 * i + 1]);
    f32x16 Os[2]; float lsel = 0.f;
#pragma unroll
    for (int i = 0; i < 16; ++i) { Os[0][i] = 0.f; Os[1][i] = 0.f; }
    {   f32x16 negm;
#pragma unroll
        for (int i = 0; i < 16; ++i) negm[i] = 120.f;
        const GAS unsigned char* ksp = (const GAS unsigned char*)(proj + rowb * PLD + C_KS); const GAS unsigned char* vsp = (const GAS unsigned char*)(proj + rowb * PLD + C_VS);
        const unsigned soffp = (unsigned)(skey * PLD + sch * 8) * 2u;
        u32x4 kA, vA, kB, vB;
        st_load(ksp, vsp, soffp, kr, vr); st_write(lds, skey, sch, kr, vr);
        if (u >= 1) st_load(ksp, vsp, soffp + 64u * PLD * 2u, kA, vA);
        __syncthreads();
#define SEL_STEP(J, KX, VX, KY, VY) { const int j_ = (J); \
            const LAS unsigned char* cur = lds + (j_ & 1) * DBUF_BYTES; LAS unsigned char* nxt = lds + ((j_ + 1) & 1) * DBUF_BYTES; \
            if (j_ + 2 <= u) st_load(ksp, vsp, soffp + (unsigned)(j_ + 2) * (64u * PLD * 2u), KY, VY); \
            const int jb = j_ >> 5; const unsigned smw = jb == 0 ? sm0 : (jb == 1 ? sm1 : (jb == 2 ? sm2 : sm3)); \
            const bool bit = ((smw >> (j_ & 31)) & 1u) != 0u; \
            if (__builtin_amdgcn_ballot_w64(bit) != 0ull) sel_tile(cur, kboff, vboff, qf, Os, negm, lsel, 64 * j_ + 63 > tw0 - 113, bit, t, 64 * j_, hh, 1 << 30, b2h); \
            if (j_ + 1 <= u) st_write(nxt, skey, sch, KX, VX); \
            __syncthreads(); }
#pragma unroll 1
        for (int j = 0; j <= u; j += 2) {
            SEL_STEP(j, kA, vA, kB, vB)
            if (j + 1 <= u) SEL_STEP(j + 1, kB, vB, kA, vA)
        }
#undef SEL_STEP
    }
    {   const float lwt = lw + xshfl<32>(lw), lst = lsel + xshfl<32>(lsel);
        const GAS bf16* gp = proj + (rowb + t) * PLD + C_DG + head * 3;
        const float g0 = sigmoidf_(bf2f(gp[0])), g1 = sigmoidf_(bf2f(gp[1])) / fmaxf(lst, 1e-30f), g2 = sigmoidf_(bf2f(gp[2])) / fmaxf(lwt, 1e-30f);
        GAS bf16* op = ys + (rowb + t) * 1024 + 768 + head * 64;
#pragma unroll
        for (int db = 0; db < 2; ++db)
#pragma unroll
            for (int gq = 0; gq < 4; ++gq) { const int d0 = 32 * db + 8 * gq + 4 * hh; float y[4];
#pragma unroll
                for (int e = 0; e < 4; ++e) { const unsigned cw = ocp[db][2 * gq + (e >> 1)], ww = owp[db][2 * gq + (e >> 1)];
                    y[e] = g0 * ((e & 1) ? hi_bf(cw) : lo_bf(cw)) + g1 * Os[db][4 * gq + e] + g2 * ((e & 1) ? hi_bf(ww) : lo_bf(ww)); }
                u32x2 w; w.x = cvtpk(y[0], y[1]); w.y = cvtpk(y[2], y[3]); *(GAS u32x2*)(op + d0) = w; }
    }
}


DI void swa_unit(const GAS bf16* proj, GAS bf16* ys, LAS unsigned char* lds, const LAS float* bias2, const LAS float* biasd, const GAS float* sinks, int b, int u, int tid_in, int lane_in, int wave_in) {
    int tid = tid_in, lane = lane_in, wave = wave_in; asm volatile("" : "+v"(tid), "+v"(lane), "+s"(wave));
    const int t0 = u * 64; const int col = lane & 31, hh = lane >> 5, tl = col >> 1, kv = wave & 1, head = 2 * kv + (col & 1);
    const int t = t0 + (wave >> 1) * 16 + tl;
    const size_t rowb = (size_t)b * SEQ;
    const LAS float* b2h = bias2 + head;
    bf16x8 qf[4];
    { const float SC = 0.125f * 1.4426950408889634f; const GAS bf16* qp = proj + (rowb + t) * PLD + C_BQ + head * 64 + hh * 8;
#pragma unroll
      for (int s = 0; s < 4; ++s) { const u32x4 w = *(const GAS u32x4*)(qp + s * 16); u32x4 o;
          o.x = cvtpk(lo_bf(w.x) * SC, hi_bf(w.x) * SC); o.y = cvtpk(lo_bf(w.y) * SC, hi_bf(w.y) * SC); o.z = cvtpk(lo_bf(w.z) * SC, hi_bf(w.z) * SC); o.w = cvtpk(lo_bf(w.w) * SC, hi_bf(w.w) * SC);
          qf[s] = __builtin_bit_cast(bf16x8, o); } }
    const int skey = tid >> 3, sch = tid & 7;
    const int i16 = lane & 15, blk = (lane >> 4) & 1;
    const int kboff = kv * DBUF_BYTES + col * DK_STR + hh * 16;
    const int vboff = kv * DBUF_BYTES + 64 * DK_STR + (4 * hh + (i16 >> 2)) * DV_STR + (16 * blk + 4 * (i16 & 3)) * 2;
    const GAS unsigned char* kp = (const GAS unsigned char*)(proj + rowb * PLD + C_BK); const GAS unsigned char* vp = (const GAS unsigned char*)(proj + rowb * PLD + C_BV);
    const unsigned soffp = (unsigned)(skey * PLD + sch * 8) * 2u;
    u32x4 k0, v0, k1, v1;
    f32x16 O[2], negm; float lsum = 0.f;
#pragma unroll
    for (int i = 0; i < 16; ++i) { O[0][i] = 0.f; O[1][i] = 0.f; negm[i] = 120.f; }
    const int s0 = (u < 2) ? 2 - u : 0;
    { const unsigned so = soffp + (unsigned)(u - 2 + s0) * (64u * PLD * 2u); st_load(kp, vp, so, k0, v0); st_load(kp + 128, vp + 128, so, k1, v1);
      st_write(lds, skey, sch, k0, v0); st_write(lds + DBUF_BYTES, skey, sch, k1, v1); }
    __syncthreads();
#pragma unroll 1
    for (int s = s0; s < 3; ++s) {
        const int par = (s - s0) & 1; const LAS unsigned char* cur = lds + par * 2 * DBUF_BYTES; LAS unsigned char* nxt = lds + (par ^ 1) * 2 * DBUF_BYTES;
        if (s + 1 < 3) { const unsigned so = soffp + (unsigned)(u - 2 + s + 1) * (64u * PLD * 2u); st_load(kp, vp, so, k0, v0); st_load(kp + 128, vp + 128, so, k1, v1); }
        sel_tile(cur, kboff, vboff, qf, O, negm, lsum, true, true, t, (u - 2 + s) * 64, hh, 128, b2h);
        if (s + 1 < 3) { st_write(nxt, skey, sch, k0, v0); st_write(nxt + DBUF_BYTES, skey, sch, k1, v1); }
        __syncthreads();
    }
    {   const float sinkp = (sinks[head] - biasd[128 * 12 + head]) * 1.4426950408889634f;
        const float lt = lsum + xshfl<32>(lsum) + __builtin_amdgcn_exp2f(sinkp + negm[0]);
        const float inv = 1.f / fmaxf(lt, 1e-30f);
        GAS bf16* op = ys + (rowb + t) * 1024 + 256 + head * 64;
#pragma unroll
        for (int db = 0; db < 2; ++db)
#pragma unroll
            for (int gq = 0; gq < 4; ++gq) { const int d0 = 32 * db + 8 * gq + 4 * hh;
                u32x2 w; w.x = cvtpk(O[db][4 * gq + 0] * inv, O[db][4 * gq + 1] * inv); w.y = cvtpk(O[db][4 * gq + 2] * inv, O[db][4 * gq + 3] * inv); *(GAS u32x2*)(op + d0) = w; }
    }
}

DI void route_rows_load(const KA& a, int tok0, int lane, u32x4 (&raw)[4][2]) {
    const GAS bf16* xrow = (const GAS bf16*)(a.ws + WS_XB) + (size_t)tok0 * 1024;
#pragma unroll
    for (int rr = 0; rr < 4; ++rr)
#pragma unroll
        for (int j = 0; j < 2; ++j) raw[rr][j] = *(const GAS u32x4*)(xrow + (size_t)rr * 1024 + 8 * (lane + 64 * j));
}
DI void route_rows4(const u32x4 (&raw)[4][2], const f32x4 (&gvv)[2][2], bf16* xr_, int tok0, int lane) {
    GAS bf16* xr = (GAS bf16*)xr_;
    f32x4 v[4][2][2]; float ss[4];
#pragma unroll
    for (int rr = 0; rr < 4; ++rr)
#pragma unroll
        for (int j = 0; j < 2; ++j) { const u32x4 w = raw[rr][j];
            v[rr][j][0][0] = lo_bf(w.x); v[rr][j][0][1] = hi_bf(w.x); v[rr][j][0][2] = lo_bf(w.y); v[rr][j][0][3] = hi_bf(w.y); v[rr][j][1][0] = lo_bf(w.z); v[rr][j][1][1] = hi_bf(w.z); v[rr][j][1][2] = lo_bf(w.w); v[rr][j][1][3] = hi_bf(w.w); }
#pragma unroll
    for (int rr = 0; rr < 4; ++rr) { float t = 0.f;
#pragma unroll
        for (int j = 0; j < 2; ++j)
#pragma unroll
            for (int h = 0; h < 2; ++h) t += (v[rr][j][h][0] * v[rr][j][h][0] + v[rr][j][h][1] * v[rr][j][h][1]) + (v[rr][j][h][2] * v[rr][j][h][2] + v[rr][j][h][3] * v[rr][j][h][3]);
        ss[rr] = t; }
#pragma unroll
    for (int rr = 0; rr < 4; ++rr) { ss[rr] = wave_sum(ss[rr]); ss[rr] = __builtin_amdgcn_rsqf(ss[rr] * (1.f / 1024.f) + 1e-6f); }
#pragma unroll
    for (int j = 0; j < 2; ++j) { const int k0 = 8 * (lane + 64 * j);
#pragma unroll
        for (int rr = 0; rr < 4; ++rr) { u32x4 wh, wl;
#pragma unroll
            for (int h = 0; h < 2; ++h) { const f32x4 xn = v[rr][j][h] * ss[rr] * gvv[j][h];
                const unsigned h0 = pk2(xn[0], xn[1]), h1 = pk2(xn[2], xn[3]);
                const unsigned l0 = pk2(xn[0] - __builtin_bit_cast(float, h0 << 16), xn[1] - __builtin_bit_cast(float, h0 & 0xFFFF0000u));
                const unsigned l1 = pk2(xn[2] - __builtin_bit_cast(float, h1 << 16), xn[3] - __builtin_bit_cast(float, h1 & 0xFFFF0000u));
                if (h == 0) { wh.x = h0; wh.y = h1; wl.x = l0; wl.y = l1; } else { wh.z = h0; wh.w = h1; wl.z = l0; wl.w = l1; } }
            *(GAS u32x4*)(xr + (size_t)(tok0 + rr) * 2048 + k0) = wh; *(GAS u32x4*)(xr + (size_t)(tok0 + rr) * 2048 + 1024 + k0) = wl; } }
}
struct SchedRoute { const char* A; const char* B; int pm;
    DI bool next(int i, Unit& u) const { if (i > 0) return false; u.pm = pm; u.pn = 0; u.aux = 0; u.pad = 0; u.a = A + (size_t)pm * 128 * 2048 * 2; u.b = B; return true; } };
struct EpiRoute { static constexpr bool CARRY = false; float* rlog;
    DI void operator()(const f32x4 (&acc)[2][2][4][2], const Unit& u, int wr, int wc, int fr, int fq) const {
        const int row0 = u.pm * 128 + wr * 64 + fr; const int col = wc * 32 + 8 * fq;
#pragma unroll
        for (int m = 0; m < 4; ++m) { float* rp = rlog + (size_t)(row0 + m * 16) * 128 + col; *(f32x4*)rp = acc[0][0][m][0]; *(f32x4*)(rp + 4) = acc[0][0][m][1]; }
    }
};
DI void route_decide(const KA& a, int l, const float* rl_row, int* rec_e, int* rec_slot, float* rec_w, unsigned* cnt, int tok) {
    float lg[36];
    const float* bg = a.in[30] + l * 4; const float* be = a.in[32] + l * 32;
#pragma unroll
    for (int q = 0; q < 9; ++q) { const f32x4 h = *(const f32x4*)(rl_row + 4 * q), lo = *(const f32x4*)(rl_row + 64 + 4 * q);
        lg[4 * q + 0] = h[0] + lo[0]; lg[4 * q + 1] = h[1] + lo[1]; lg[4 * q + 2] = h[2] + lo[2]; lg[4 * q + 3] = h[3] + lo[3]; }
#pragma unroll
    for (int i = 0; i < 4; ++i) lg[i] += bg[i];
#pragma unroll
    for (int i = 0; i < 32; ++i) lg[4 + i] += be[i];
    int gsel = 0; float gm = lg[0];
#pragma unroll
    for (int i = 1; i < 4; ++i) if (lg[i] > gm) { gm = lg[i]; gsel = i; }
    float gs = 0.f;
#pragma unroll
    for (int i = 0; i < 4; ++i) gs += __expf(lg[i] - gm);
    const float gwt = 1.f / gs;
    float v8[8];
#pragma unroll
    for (int i = 0; i < 8; ++i) { float x = lg[4 + i];
#pragma unroll
        for (int gq = 1; gq < 4; ++gq) x = (gsel == gq) ? lg[4 + gq * 8 + i] : x;
        v8[i] = x; }
    int i0 = 0; float m0 = v8[0];
#pragma unroll
    for (int i = 1; i < 8; ++i) if (v8[i] > m0) { m0 = v8[i]; i0 = i; }
    int i1 = -1; float m1 = -3e38f;
#pragma unroll
    for (int i = 0; i < 8; ++i) if (i != i0 && v8[i] > m1) { m1 = v8[i]; i1 = i; }
    if (i1 < 0) i1 = (i0 == 0) ? 1 : 0;
    const float w0 = 1.f / (1.f + __expf(m1 - m0)); const float w1 = 1.f - w0;
    const int e0 = gsel * 8 + i0, e1 = gsel * 8 + i1;
    const unsigned s0 = __hip_atomic_fetch_add(cnt + e0, 1u, __ATOMIC_RELAXED, __HIP_MEMORY_SCOPE_AGENT);
    const unsigned s1 = __hip_atomic_fetch_add(cnt + e1, 1u, __ATOMIC_RELAXED, __HIP_MEMORY_SCOPE_AGENT);
    (void)rec_e; (void)rec_slot; (void)rec_w;
    int* inv_as = (int*)(a.ws + WS_INVAS); float* inv_w = (float*)(a.ws + WS_INVW);
    inv_as[e0 * 32768 + (int)s0] = tok * 2; inv_w[e0 * 32768 + (int)s0] = w0 * gwt; inv_as[e1 * 32768 + (int)s1] = tok * 2 + 1; inv_w[e1 * 32768 + (int)s1] = w1 * gwt;
}
DI void expert_weights(const KA& a, int l, LAS unsigned char* lds, int it0, int it1, int gw, int NGW, int wave, int lane) {
    LAS float* scr = (LAS float*)(lds + wave * 16384);
    const float* wgt = a.in[33] + (size_t)l * 32 * 1024 * 256; const float* wup = a.in[34] + (size_t)l * 32 * 1024 * 256; const float* wdn = a.in[35] + (size_t)l * 32 * 256 * 1024;
    bf16* Wgu = (bf16*)(a.ws + WS_WGU); bf16* Wd = (bf16*)(a.ws + WS_WD);
    constexpr int I_E = 16 * 4, I_D = 4 * 16;
    const int nq = 4 * (lane & 15), kr4 = lane >> 4;
    for (int it = it0 + gw; it < it1; it += NGW) {
        const int e = it / (2 * I_E + I_D); int r = it % (2 * I_E + I_D);
        const GAS float* src; GAS bf16* dst; int ldw, ldt;
        if (r < 2 * I_E) { const int up = r / I_E, q = r % I_E, kb = q / 4, nb = q % 4; const int n0 = nb * 64;
            const int drow = (n0 >> 7) * 256 + up * 128 + (n0 & 127);
            src = (const GAS float*)((up ? wup : wgt) + (size_t)e * 1024 * 256) + (size_t)(kb * 64) * 256 + n0; ldw = 256;
            dst = (GAS bf16*)(Wgu + (size_t)e * 512 * 1024) + (size_t)drow * 1024 + kb * 64; ldt = 1024;
        } else { r -= 2 * I_E; const int kb = r / 16, nb = r % 16;
            src = (const GAS float*)(wdn + (size_t)e * 256 * 1024) + (size_t)(kb * 64) * 1024 + nb * 64; ldw = 1024;
            dst = (GAS bf16*)(Wd + (size_t)e * 1024 * 256) + (size_t)(nb * 64) * 256 + kb * 64; ldt = 256; }
        f32x4 v[16];
#pragma unroll
        for (int i = 0; i < 16; ++i) v[i] = *(const GAS f32x4*)(src + (size_t)(4 * i + kr4) * ldw + nq);
#pragma unroll
        for (int hn = 0; hn < 2; ++hn) {
            if (((lane >> 3) & 1) == hn) {
#pragma unroll
                for (int i = 0; i < 16; ++i) { const int kk = 4 * i + kr4;
#pragma unroll
                    for (int e2 = 0; e2 < 4; ++e2) scr[kk * 33 + (nq & 31) + e2] = v[i][e2]; } }
            LDS_WAIT(); asm volatile("" ::: "memory");
            const int c = lane & 7;
#pragma unroll
            for (int j = 0; j < 4; ++j) { const int n = (lane >> 3) + 8 * j; const LAS float* sp = scr + (8 * c) * 33 + n;
                u32x4 o; o.x = pk2(sp[0 * 33], sp[1 * 33]); o.y = pk2(sp[2 * 33], sp[3 * 33]); o.z = pk2(sp[4 * 33], sp[5 * 33]); o.w = pk2(sp[6 * 33], sp[7 * 33]);
                *(GAS u32x4*)(dst + (size_t)(32 * hn + n) * ldt + 8 * c) = o; }
            LDS_WAIT(); asm volatile("" ::: "memory");
        }
    }
}
DI void build_offsets(const unsigned* cnt, LAS int* offt, int tid) {
    int c = 0;
    if (tid < 32) { c = (int)__hip_atomic_load(cnt + tid, __ATOMIC_RELAXED, __HIP_MEMORY_SCOPE_AGENT); offt[330 + tid] = (c + 255) & ~255; }
    __syncthreads();
    if (tid == 0) { int o = 0;
#pragma unroll
        for (int e = 0; e < 32; ++e) { offt[e] = o; o += offt[330 + e]; } offt[32] = o; }
    __syncthreads();
    if (tid < 32) offt[330 + tid] = c;
    for (int rt = tid; rt < (MOE_ROWS >> 8); rt += 512) { int e = 0; for (int j = 1; j < 32; ++j) e += (offt[j] <= rt * 256) ? 1 : 0; offt[40 + rt] = e; }
    __syncthreads();
}

template <unsigned PM>
__global__ void __launch_bounds__(512, 2) mk_fwd(Args a_) {
    extern __shared__ __attribute__((aligned(16))) unsigned char lds_raw[];
    LAS unsigned char* lds = (LAS unsigned char*)lds_raw;
    const int wave0 = __builtin_amdgcn_readfirstlane((int)threadIdx.x >> 6);
    if (threadIdx.x < 36) ((LAS unsigned long long*)(lds + PTAB_OFF))[threadIdx.x] = (unsigned long long)a_.in[threadIdx.x];
    __syncthreads();
    KA a; a.in.base = (unsigned)(size_t)(lds + PTAB_OFF); a.out = a_.out; a.ws = a_.ws;
    const int G = gridDim.x, bid = blockIdx.x, NGW = G * 8;
#define PHASE_IDS() int wave = wave0; asm volatile("" : "+s"(wave)); const int lane = my_lane(); const int tid_ = wave * 64 + lane, gw = bid * 8 + wave; (void)tid_; (void)gw; \
    const int xb = ((bid & 7) << 5) | (bid >> 3); (void)xb;        \
    KA ap = a; asm volatile("" : "+s"(ap.ws), "+s"(ap.out), "+s"(ap.in.base)); \
    bf16* hb = (bf16*)(ap.ws + WS_HB); bf16* proj = (bf16*)(ap.ws + WS_PROJ); bf16* gates = (bf16*)(ap.ws + WS_GATES); \
    bf16* ys = hb; bf16* x2b = hb; bf16* merged = proj; bf16* eo = proj; \
    bf16* kcb = (bf16*)(ap.ws + WS_KCVC); float* lrusum = (float*)(ap.ws + WS_LRUSUM); \
    int* rec_e = (int*)(ap.ws + WS_REC); int* rec_slot = rec_e + T * 2; float* rec_w = (float*)(rec_slot + T * 2); \
    int* rowtok = (int*)(ap.ws + WS_ROWTOK); float* roww = (float*)(ap.ws + WS_ROWW); \
    bf16* xs = (bf16*)(ap.ws + WS_XS); bf16* hmid = (bf16*)(ap.ws + WS_HMID); unsigned* ctl = (unsigned*)(ap.ws + WS_CTL); \
    (void)hb; (void)proj; (void)gates; (void)ys; (void)x2b; (void)merged; (void)eo; (void)kcb; (void)lrusum; (void)rec_e; (void)rec_slot; (void)rec_w; (void)rowtok; (void)roww; (void)xs; (void)hmid; (void)ctl
    volatile LAS unsigned* MISC = (volatile LAS unsigned*)(lds + MISC_OFF);
    LAS float* biasd = (LAS float*)(lds + BIAS_OFF);
    LAS int* offt = (LAS int*)(lds + OFFT_OFF);
    { PHASE_IDS();
    if (tid_ < 64) MISC[tid_] = 0u;
    for (int i = tid_; i < 129 * 12; i += 512) { const int d = i / 12, hd = i % 12; const int bk = d < 128 ? T5_BUCKET[d] : 31; const float* rb = a.in[1]; biasd[i] = rb[bk * 12 + hd]; ((LAS float*)(lds + BIAS2_OFF))[i] = (rb[bk * 12 + hd] - rb[31 * 12 + hd]) * 1.4426950408889634f; } }
    __syncthreads();
    const int lo = a_.ph_lo, hi = a_.ph_hi;
    XcdBarrier bar; bar.bar = (unsigned*)(a.ws + WS_CTL) + CW_BAR; bar.x = 0; bar.st = nullptr;
    if (hi - lo > 1) { PHASE_IDS(); bar = xcd_barrier_post(ctl + CW_BAR, MISC + 8, tid_ == 0); }
#ifndef SUB_MASK
#define SUB_MASK 0xFFu
#endif
#define SUB(k) ((SUB_MASK >> (k)) & 1u)
#define HASP(k) ((PM >> ((k) % PPL + ((k) >= 2 * PPL ? PPL : 0))) & 1u)
#define IN(k) (HASP(k) && lo <= (k) && (k) < hi)
#define SEAM(k) do { if ((k) + 1 < hi) { const int sl_ = my_lane(); int sw_ = wave0; asm volatile("" : "+s"(sw_)); xcd_barrier(bar, sw_ == 0 && sl_ == 0); } } while (0)
    for (int l = 0; l < DEPTH; ++l) {
        const int pb = l * PPL;
        if (IN(pb + 0)) { PHASE_IDS(); p1_weights_i8(ap, l, lds, bid, G, wave, lane); router_weights(ap, l, gw, NGW, lane); lru_weights(ap, l, gw, NGW, lane); cmp_weights(ap, l, lds, gw, NGW, wave, lane); phase0_weights(ap, l, lds, gw, NGW, wave, lane); phase0_rows(ap, l, 0, gw, NGW, lane); SEAM(pb + 0); }
        if (IN(pb + 1)) {
            PHASE_IDS();
            {   int K1q = 512; asm volatile("" : "+s"(K1q));
                pg8::Gemm g{K1q, 512, 512, 128, -1}; SchedP1 S{(const char*)(ap.ws + WS_HQ), (const char*)(ap.ws + WS_WQ), 128, 26, 1024, 1024, G, bid};
                EpiP1I8 E{proj, (unsigned char*)gates, ap.in[25] + (size_t)l * 4096, (const float*)(ap.ws + WS_HSC), (const float*)(ap.ws + WS_WSC)};
                pg8::gemm_phase<EpiP1I8, SchedP1, false, true>(lds, g, S, E, tid_); }
            SEAM(pb + 1);
        }
        if (IN(pb + 2)) {
            PHASE_IDS();
            LAS float* lamp = (LAS float*)(lds + MISC_OFF + 64);
            if (tid_ < 64) { const float* q1 = ap.in[13] + l * 32; const float* k1 = ap.in[14] + l * 32; const float* q2 = ap.in[15] + l * 32; const float* k2 = ap.in[16] + l * 32;
                float s1 = (lane < 32) ? q1[lane] * k1[lane] : 0.f, s2 = (lane < 32) ? q2[lane] * k2[lane] : 0.f; s1 = wave_sum(s1); s2 = wave_sum(s2);
                const float lam_init = 0.8f - 0.6f * __expf(-0.3f * (float)l); if (lane == 0) { lamp[0] = __expf(s1) - __expf(s2) + lam_init; lamp[1] = lam_init; } }
            __syncthreads();
            if (SUB(0)) { const LAS float* bias2 = (const LAS float*)(lds + BIAS2_OFF); const GAS float* subg = (const GAS float*)(ap.in[17] + l * 64);
                for (int pi = xb; pi < 256; pi += G) { const int bh = pi >> 4, qlo = pi & 15;
                    diff_unit((const GAS bf16*)proj, (GAS bf16*)ys, lds, bias2, subg, lamp, bh >> 2, bh & 3, 31 - qlo, wave);
                    diff_unit((const GAS bf16*)proj, (GAS bf16*)ys, lds, bias2, subg, lamp, bh >> 2, bh & 3, qlo, wave); } }
            { PHASE_IDS();
            if (SUB(3)) { __syncthreads(); const LAS float* bias2 = (const LAS float*)(lds + BIAS2_OFF); const GAS float* sinks = (const GAS float*)(ap.in[12] + l * 4);
                for (int pi = xb; pi < 512; pi += G) swa_unit((const GAS bf16*)proj, (GAS bf16*)ys, lds, bias2, biasd, sinks, pi >> 7, pi & 127, tid_, lane, wave); }
            if (SUB(2)) cmp_block(ap, l, (const GAS bf16*)proj, (const GAS bf16*)(ap.ws + WS_WCMP), (float*)(ap.ws + WS_CMPAB), kcb, bid, wave, lane);
            if (SUB(1)) { __syncthreads(); for (int task = xb; task < 512; task += G) lru_unit(ap, l, (const GAS bf16*)proj, (GAS bf16*)ys, (GAS float*)lrusum, lds, task, lane, wave, false); }
            }
            SEAM(pb + 2);
        }
        if (IN(pb + 4)) {
            PHASE_IDS();
            for (int task = xb; task < 512; task += G) lru_unit(ap, l, (const GAS bf16*)proj, (GAS bf16*)ys, (GAS float*)lrusum, lds, task, lane, wave, true);
            __syncthreads();
            if (SUB(4)) { const LAS float* bias2 = (const LAS float*)(lds + BIAS2_OFF);
                for (int pi = xb; pi < 256; pi += G) { const int bb = pi >> 6, ulo = pi & 63;
                    nsa_unit((const GAS bf16*)proj, (GAS bf16*)ys, (const GAS bf16*)kcb, lds, bias2, bb, 127 - ulo, tid_, lane, wave);
                    nsa_unit((const GAS bf16*)proj, (GAS bf16*)ys, (const GAS bf16*)kcb, lds, bias2, bb, ulo, tid_, lane, wave); } }
            SEAM(pb + 4);
        }
        if (IN(pb + 5)) {
            PHASE_IDS();
            int K5 = 256; asm volatile("" : "+s"(K5));
            pg8::Gemm g{K5, 1024, 256, 128, -1}; SchedP3a S{(const char*)ys, (const char*)(ap.ws + WS_WBR), G, xb};
            EpiP3a E{merged, (const unsigned char*)gates};
            pg8::gemm_phase<EpiP3a, SchedP3a>(lds, g, S, E, tid_); SEAM(pb + 5);
        }
        if (IN(pb + 6)) {
            PHASE_IDS();
            int K6 = 1024; asm volatile("" : "+s"(K6));
            pg8::Gemm g{K6, 1024, 1024, 128, -1}; SchedP3b S{(const char*)merged, (const char*)(ap.ws + WS_WOUT), G, xb};
            if (l == 0) { EpiP3b<true> E{ap.in[0], (bf16*)(ap.ws + WS_XB)}; pg8::gemm_phase<EpiP3b<true>, SchedP3b>(lds, g, S, E, tid_); }
            else { EpiP3b<false> E{nullptr, (bf16*)(ap.ws + WS_XB)}; pg8::gemm_phase<EpiP3b<false>, SchedP3b>(lds, g, S, E, tid_); }
            SEAM(pb + 6);
        }
        if (IN(pb + 7)) {
            PHASE_IDS();
            bf16* xr = (bf16*)(ap.ws + WS_XR); float* rlog = (float*)(ap.ws + WS_RLOG);
            constexpr int NITW = 32 * (2 * 16 * 4 + 4 * 16);
            { const int pm = bid;
                f32x4 gvv[2][2]; { const GAS float* g28 = (const GAS float*)(ap.in[28] + (size_t)l * 1024);
#pragma unroll
                    for (int j = 0; j < 2; ++j) { gvv[j][0] = *(const GAS f32x4*)(g28 + 8 * (lane + 64 * j)); gvv[j][1] = *(const GAS f32x4*)(g28 + 8 * (lane + 64 * j) + 4); } }
                {   u32x4 rw[4][4][2];
#pragma unroll
                    for (int q4 = 0; q4 < 4; ++q4) route_rows_load(ap, pm * 128 + wave * 4 + 32 * q4, lane, rw[q4]);
#pragma unroll
                    for (int q4 = 0; q4 < 4; ++q4) route_rows4(rw[q4], gvv, xr, pm * 128 + wave * 4 + 32 * q4, lane); }
                asm volatile("s_waitcnt vmcnt(0)" ::: "memory"); __syncthreads();
                { pg8::Gemm g{2048, 2048, 2048, 128, 0}; SchedRoute S{(const char*)xr, (const char*)(ap.ws + WS_WR), pm}; EpiRoute E{rlog};
                  pg8::gemm_phase<EpiRoute, SchedRoute>(lds, g, S, E, tid_); }
                asm volatile("s_waitcnt vmcnt(0)" ::: "memory"); __syncthreads();
                if (tid_ < 128) route_decide(ap, l, rlog + (size_t)(pm * 128 + tid_) * 128, rec_e, rec_slot, rec_w, ctl + CW_CNT + l * 32, pm * 128 + tid_);
                __syncthreads();
            }
            expert_weights(ap, l, lds, 0, NITW, gw, NGW, wave, lane);
            SEAM(pb + 7);
        }
        if (IN(pb + 9)) {
            PHASE_IDS();
            build_offsets(ctl + CW_CNT + l * 32, offt, tid_);
            int K9 = 1024; asm volatile("" : "+s"(K9));
            pg8::Gemm g{K9, 2048, 1024, 128, -1}; SchedM2 S{(const char*)(ap.ws + WS_XR), (const char*)(ap.ws + WS_WGU), offt, (const int*)(ap.ws + WS_INVAS), G, xb};
            EpiM2 E{hmid};
            pg8::gemm_phase<EpiM2, SchedM2, true>(lds, g, S, E, tid_); SEAM(pb + 9);
        }
        if (IN(pb + 10)) {
            PHASE_IDS();
            build_offsets(ctl + CW_CNT + l * 32, offt, tid_);
            int K3 = 256; asm volatile("" : "+s"(K3));
            pg8::Gemm g{K3, 256, 256, 128, -1}; SchedM3 S{(const char*)hmid, (const char*)(ap.ws + WS_WD), offt, G, xb};
            EpiM3 E{eo, (const int*)(ap.ws + WS_INVAS), (const float*)(ap.ws + WS_INVW), offt};
            pg8::gemm_phase<EpiM3, SchedM3>(lds, g, S, E, tid_); SEAM(pb + 10);
        }
    }
    if (IN(2 * PPL)) { PHASE_IDS(); phase0_rows(ap, DEPTH, 1, gw, NGW, lane); }
#undef IN
#undef SEAM
}

typedef void (*kern_t)(Args);
template <unsigned PM> static bool setup_kernel() {
    if (hipFuncSetAttribute((const void*)mk_fwd<PM>, hipFuncAttributeMaxDynamicSharedMemorySize, LDS_BYTES) != hipSuccess) { fprintf(stderr, "kernel_launch: hipFuncSetAttribute failed\n"); return false; }
    return true;
}
extern "C" void kernel_launch(void* const* d_in, const int* in_sizes, int n_in, void* d_out, int out_size, void* d_ws, size_t ws_size, hipStream_t stream) {
    static int grid = 0;
    if (grid == 0) {
        if (n_in != 36 || out_size != T * D || ws_size < WS_END) { fprintf(stderr, "kernel_launch: unexpected shapes (n_in %d out %d ws %zu)\n", n_in, out_size, ws_size); grid = -1; return; }
        int dev = 0, cus = 0;
        if (hipGetDevice(&dev) != hipSuccess || hipDeviceGetAttribute(&cus, hipDeviceAttributeMultiprocessorCount, dev) != hipSuccess) { grid = -1; return; }
        bool ok = true;
#if MK_ONE_LAUNCH
        ok = setup_kernel<0xFFFu>();
#endif
        if (!ok) { grid = -1; return; }
        (void)hipGetLastError();
        grid = cus;
        if (grid != 256) { fprintf(stderr, "kernel_launch: built for a 256-CU device (got %d)\n", cus); grid = -1; return; }
    }
    if (grid < 0) return;
    if (hipMemsetAsync((char*)d_ws + WS_CTL, 0, CTL_ZERO_BYTES, stream) != hipSuccess) return;
    Args a{};
    for (int i = 0; i < 36; ++i) a.in[i] = (const float*)d_in[i];
    a.out = (float*)d_out; a.ws = (unsigned char*)d_ws;
#if MK_ONE_LAUNCH
    a.ph_lo = 0; a.ph_hi = NPH;
    hipLaunchKernelGGL(mk_fwd<0xFFFu>, dim3(grid), dim3(512), LDS_BYTES, stream, a);
#endif
}
```

```cpp
#include <hip/hip_runtime.h>
#include <cstdio>
#include <cstdint>

#ifndef MK_ONE_LAUNCH
#define MK_ONE_LAUNCH 1
#endif

#define DI __device__ __forceinline__
#define GAS __attribute__((address_space(1)))
#define LAS __attribute__((address_space(3)))
typedef unsigned short bf16;
typedef short bf16x8 __attribute__((ext_vector_type(8)));
typedef float f32x4 __attribute__((ext_vector_type(4)));
typedef int i32x4 __attribute__((ext_vector_type(4)));
typedef unsigned u32x4 __attribute__((ext_vector_type(4)));
typedef unsigned u32x2 __attribute__((ext_vector_type(2)));
typedef float f32x16 __attribute__((ext_vector_type(16)));
typedef float f32x2 __attribute__((ext_vector_type(2)));
typedef short s16x4 __attribute__((ext_vector_type(4)));
typedef __bf16 bf16x2_t __attribute__((ext_vector_type(2)));
typedef short v4i16_t __attribute__((__vector_size__(4 * sizeof(short))));
#define MFMA32(a, b, c) __builtin_amdgcn_mfma_f32_32x32x16_bf16((a), (b), (c), 0, 0, 0)

constexpr int BATCH = 4, SEQ = 8192, T = BATCH * SEQ, D = 1024, DEPTH = 2;
constexpr int NIN = 2444, PLD = 2560, N1 = 6656, GLD = 4096;
constexpr int C_AX = 0, C_AG = 256, C_BQ = 512, C_BK = 768, C_BV = 896, C_CQ = 1024, C_CK = 1280, C_CV = 1536, C_DQ = 1792,
              C_KC = 2048, C_VC = 2112, C_KS = 2176, C_VS = 2240, C_KW = 2304, C_VW = 2368, C_DG = 2432;
constexpr int NCMP = 511;
constexpr int MOE_ROWS = 73728;
constexpr int PPL = 11;
constexpr int NPH = 2 * PPL + 1;

constexpr size_t MiB = 1u << 20;
constexpr size_t WS_CTL = 0, CTL_ZERO_BYTES = 1 * MiB;
constexpr size_t WS_KCVC = 1 * MiB;
constexpr size_t WS_LRUSUM = 2 * MiB;
constexpr size_t WS_REC = 2 * MiB + 256 * 1024;
constexpr size_t WS_ROWTOK = 3 * MiB;
constexpr size_t WS_ROWW = 3 * MiB + 512 * 1024;
constexpr size_t WS_WIN = 4 * MiB;
constexpr size_t WS_WQ = 4 * MiB;
constexpr size_t WS_WSC = 13 * MiB;
constexpr size_t WS_HSC = 13 * MiB + 65536;
constexpr size_t WS_HQ = 21 * MiB;
constexpr size_t WS_INVAS = 296 * MiB;
constexpr size_t WS_INVW = 300 * MiB;
constexpr size_t WS_XB = 373 * MiB;
constexpr size_t WS_WBR = 17 * MiB;
constexpr size_t WS_WOUT = 19 * MiB;
constexpr size_t WS_HB = 21 * MiB;
constexpr size_t WS_PROJ = 85 * MiB;
constexpr size_t WS_GATES = 245 * MiB;
constexpr size_t WS_WGU = 245 * MiB;
constexpr size_t WS_WD = 277 * MiB;
constexpr size_t WS_XS = 293 * MiB;
constexpr size_t WS_HMID = 437 * MiB;
constexpr size_t WS_XR = 85 * MiB;
constexpr size_t WS_RLOG = 213 * MiB;
constexpr size_t WS_WR = 501 * MiB;
constexpr size_t WS_WCMP = 502 * MiB;
constexpr size_t WS_CMPAB = 503 * MiB;
constexpr size_t WS_LRUW = 505 * MiB + 65536;
constexpr size_t WS_END = 506 * MiB;
constexpr int CW_BAR = 4096;
constexpr int CW_CNT = 16384, CNT_STRIDE = 64;

constexpr int RING_BYTES = 131072;
constexpr int MISC_OFF = RING_BYTES;
constexpr int BIAS_OFF = MISC_OFF + 256;
constexpr int OFFT_OFF = BIAS_OFF + 129 * 12 * 4;
constexpr int PTAB_OFF = OFFT_OFF + (40 + 288 + 40) * 4;
constexpr int BIAS2_OFF = PTAB_OFF + 36 * 8;
constexpr int LRUEX_OFF = BIAS2_OFF + 129 * 12 * 4;
constexpr int LDS_BYTES = 163840;
constexpr int LRUCST_OFF = LRUEX_OFF + 8 * 64 * 2 * 4;
constexpr int LRUCAR_OFF = LRUCST_OFF + 3 * 64 * 4;
static_assert(PTAB_OFF % 8 == 0 && LRUCAR_OFF + 8 * 64 * 4 <= LDS_BYTES, "LDS map");

DI float bf2f(bf16 v) { return __builtin_bit_cast(float, (unsigned)v << 16); }
DI float lo_bf(unsigned w) { return __builtin_bit_cast(float, w << 16); }
DI float hi_bf(unsigned w) { return __builtin_bit_cast(float, w & 0xffff0000u); }
DI unsigned f2bf(float f) { unsigned u = __builtin_bit_cast(unsigned, f); return (u + 0x7fffu + ((u >> 16) & 1u)) >> 16; }
typedef __bf16 bf16x2_pk __attribute__((ext_vector_type(2)));
DI unsigned pk2(float lo, float hi) { typedef float f32x2_pk __attribute__((ext_vector_type(2))); f32x2_pk v = {lo, hi}; bf16x2_pk b = __builtin_convertvector(v, bf16x2_pk); return __builtin_bit_cast(unsigned, b); }
DI float rl(float v, int i) { return __builtin_bit_cast(float, __builtin_amdgcn_readlane(__builtin_bit_cast(int, v), i)); }
DI int rli(int v, int i) { return __builtin_amdgcn_readlane(v, i); }
DI int my_lane() { int l; asm volatile("v_mbcnt_lo_u32_b32 %0, -1, 0\n\tv_mbcnt_hi_u32_b32 %0, -1, %0" : "=v"(l)); return l; }
template <int O> DI int xshfl_i(int v) {
    if constexpr (O < 32) return __builtin_amdgcn_ds_swizzle(v, (O << 10) | 0x1f);
    else { const int l = my_lane(); return __builtin_amdgcn_ds_bpermute((l ^ 32) << 2, v); }
}
template <int O> DI float xshfl(float v) { return __builtin_bit_cast(float, xshfl_i<O>(__builtin_bit_cast(int, v))); }
DI float wave_sum(float v) { v += xshfl<1>(v); v += xshfl<2>(v); v += xshfl<4>(v); v += xshfl<8>(v); v += xshfl<16>(v); v += xshfl<32>(v); return v; }
DI float wave_max(float v) { v = fmaxf(v, xshfl<1>(v)); v = fmaxf(v, xshfl<2>(v)); v = fmaxf(v, xshfl<4>(v)); v = fmaxf(v, xshfl<8>(v)); v = fmaxf(v, xshfl<16>(v)); v = fmaxf(v, xshfl<32>(v)); return v; }
DI float sigmoidf_(float x) { return __builtin_amdgcn_rcpf(1.f + __builtin_amdgcn_exp2f(-1.4426950408889634f * x)); }
DI float gelu_tanh(float x) { const float u = 0.7978845608028654f * (x + 0.044715f * x * x * x); const float e = __expf(2.f * u); const float th = 1.f - 2.f * __builtin_amdgcn_rcpf(e + 1.f); return 0.5f * x * (1.f + th); }
DI float softplusf_(float x) { return fmaxf(x, 0.f) + log1pf(__expf(-fabsf(x))); }
#define LDS_WAIT() asm volatile("s_waitcnt lgkmcnt(0)" ::: "memory")
#define VM_WAIT() asm volatile("s_waitcnt vmcnt(0)" ::: "memory")

__device__ const unsigned char T5_BUCKET[128] = {
0,1,2,3,4,5,6,7,8,9,10,11,12,13,14,15,16,16,16,17,17,18,18,18,19,19,19,20,20,20,20,21,21,21,21,22,22,22,22,22,23,23,23,23,23,23,24,24,24,24,24,24,25,25,25,25,25,25,25,26,26,26,26,26,26,26,26,27,27,27,27,27,27,27,27,27,27,28,28,28,28,28,28,28,28,28,28,29,29,29,29,29,29,29,29,29,29,29,29,30,30,30,30,30,30,30,30,30,30,30,30,30,30,31,31,31,31,31,31,31,31,31,31,31,31,31,31,31};

#define XB_TMO      128
#define XB_XCNT(j)  (256  + 64 * (j))
#define XB_XSUB(j)  (1280 + 64 * (j))
#define XB_XGEN(j)  (2304 + 64 * (j))
#define XB_TOP      3328
#define XB_TOPGEN   3392
#define XCD_BAR_WORDS 3456
#define XB_SPIN_CAP (1u << 22)
DI unsigned xb_ld(unsigned* p)              { return __hip_atomic_load(p, __ATOMIC_RELAXED, __HIP_MEMORY_SCOPE_AGENT); }
DI unsigned xb_add(unsigned* p, unsigned v) { return __hip_atomic_fetch_add(p, v, __ATOMIC_RELAXED, __HIP_MEMORY_SCOPE_AGENT); }
DI unsigned xb_xcc_id() { return (unsigned)__builtin_amdgcn_s_getreg((3 << 11) | 20) & 0xFu; }
#define XB_SPIN(cond, bar) do { unsigned _sp = 0; while (cond) { __builtin_amdgcn_s_sleep(1); \
    if ((++_sp & 255u) == 0u) { if (xb_ld(&(bar)[XB_TMO])) break; if (_sp > XB_SPIN_CAP) { atomicAdd(&(bar)[XB_TMO], 1u); break; } } } } while (0)
struct XcdBarrier { unsigned* bar; unsigned x; volatile LAS unsigned* st; };
DI XcdBarrier xcd_barrier_post(unsigned* bar, volatile LAS unsigned* st, bool leader) {
    XcdBarrier b; b.bar = bar; b.x = xb_xcc_id(); b.st = st;
    if (leader) (void)xb_add(&bar[XB_XCNT(b.x)], 1u);
    return b;
}
DI void xcd_barrier_complete(unsigned* bar, unsigned x, unsigned& nloc, unsigned& nx) {
    const unsigned G = gridDim.x * gridDim.y * gridDim.z;
    unsigned sum, cnt, mine, sp = 0u;
    for (;;) {
        sum = 0u; cnt = 0u; mine = 0u;
#pragma unroll
        for (unsigned j = 0; j < 16; ++j) { const unsigned c = xb_ld(&bar[XB_XCNT(j)]); sum += c; cnt += (c > 0u) ? 1u : 0u; mine = (j == x) ? c : mine; }
        if (sum == G) break;
        __builtin_amdgcn_s_sleep(1);
        if ((++sp & 255u) == 0u) { if (xb_ld(&bar[XB_TMO])) break; if (sp > XB_SPIN_CAP) { atomicAdd(&bar[XB_TMO], 1u); break; } }
    }
    nloc = mine > 0u ? mine : 1u; nx = cnt > 0u ? cnt : 1u;
}
DI void xcd_barrier(const XcdBarrier& b, bool leader) {
    asm volatile("s_waitcnt vmcnt(0)" ::: "memory");
    __syncthreads();
    if (leader) {
        unsigned* bar = b.bar;
        __builtin_amdgcn_s_waitcnt(0);
        unsigned nloc = b.st[0], nx = b.st[1];
        if (nloc == 0u) { xcd_barrier_complete(bar, b.x, nloc, nx); b.st[0] = nloc; b.st[1] = nx; }
        const unsigned old = xb_add(&bar[XB_XSUB(b.x)], 1u);
        const unsigned gen = old / nloc;
        if (old + 1u == (gen + 1u) * nloc) {
            __builtin_amdgcn_fence(__ATOMIC_RELEASE, "agent");
            asm volatile("s_waitcnt vmcnt(0)" ::: "memory");
            const unsigned og = xb_add(&bar[XB_TOP], 1u);
            const unsigned tg = og / nx;
            if (og + 1u == (tg + 1u) * nx) xb_add(&bar[XB_TOPGEN], 1u);
            else XB_SPIN(xb_ld(&bar[XB_TOPGEN]) == tg, bar);
            __builtin_amdgcn_fence(__ATOMIC_ACQUIRE, "agent");
            xb_add(&bar[XB_XGEN(b.x)], 1u);
            asm volatile("s_waitcnt vmcnt(0)" ::: "memory");
        } else {
            XB_SPIN(xb_ld(&bar[XB_XGEN(b.x)]) == gen, bar);
            __builtin_amdgcn_fence(__ATOMIC_ACQUIRE, "agent");
            asm volatile("s_waitcnt vmcnt(0)" ::: "memory");
        }
    }
    __syncthreads();
}

namespace pg8 {
constexpr int BM = 256, BK = 64, HALF = 128, HTB = HALF * BK * 2;
__host__ __device__ __forceinline__ int lds_byte(int r, int c) { const int st = (r >> 4) * 2 + (c >> 5), rr = r & 15, cc = c & 31, ob = rr * 64 + cc * 2; return st * 1024 + (ob ^ (((ob >> 9) & 1) << 5)); }
__host__ __device__ __forceinline__ void stage_rc(int b, int& R, int& C) { const int st = b / 1024, sb = b % 1024, swz = sb ^ (((sb >> 9) & 1) << 5); R = (st >> 1) * 16 + swz / 64; C = (st & 1) * 32 + (swz % 64) / 2; }
__host__ __device__ __forceinline__ int perm32(int rho) { const int n = rho >> 4, i = rho & 15; return 8 * (i >> 2) + 4 * n + (i & 3); }
struct Unit { const char* a; const char* b; int pm, pn, aux, pad; };
struct Gemm { int K, lda, ldb, kstepA, hstepA; };
template <bool I8> struct AccT { typedef f32x4 type; };
template <> struct AccT<true> { typedef i32x4 type; };
template <class Epi, class Sched, bool GATHER = false, bool I8 = false>
DI void gemm_phase(LAS unsigned char* lds, const Gemm g, const Sched& S, const Epi& E, int tid_in) {
    int tid = tid_in; asm volatile("" : "+v"(tid));
    const int wid = __builtin_amdgcn_readfirstlane(tid >> 6), lane = tid & 63, wr = wid >> 2, wc = wid & 3, fr = lane & 15, fq = lane >> 4;
    const int K = g.K, nt = K / BK;
    unsigned voffA[2], voffB[2];
#pragma unroll
    for (int i = 0; i < 2; ++i) { int R, C; stage_rc(tid * 16 + i * 8192, R, C); const int Rb = (R & ~31) + perm32(R & 31);
        voffA[i] = (unsigned)(R * g.lda + C) * 2u; voffB[i] = (unsigned)(Rb * g.ldb + C) * 2u; }
    const size_t kstep = (size_t)(BK * 2), kstepA = (size_t)g.kstepA;
    const size_t hstepA = g.hstepA < 0 ? (size_t)HALF * g.lda * 2 : (size_t)g.hstepA, hstepB = (size_t)HALF * g.ldb * 2;
    const unsigned hstepA32 = (unsigned)hstepA;
    unsigned gC[2][2] = {{0u, 0u}, {0u, 0u}}, gN[2][2] = {{0u, 0u}, {0u, 0u}};
    const unsigned ldsw = (unsigned)wid * 1024u;
    const int aoff = lds_byte(wr * 64 + fr, fq * 8), boff = lds_byte(wc * 32 + fr, fq * 8);
#define PG8_SA(b, h) (((b) * 2 + (h)) * HTB)
#define PG8_SB(b, h) ((4 + (b) * 2 + (h)) * HTB)
#define PG8_STAGE(bufoff, gbase, voff) do { _Pragma("unroll") for (int _i = 0; _i < 2; ++_i) \
        __builtin_amdgcn_global_load_lds((const unsigned*)((const char*)(gbase) + (voff)[_i]), (LAS unsigned*)(lds + (bufoff) + ldsw + _i * 8192), 16, 0, 0); } while (0)
#define PG8_STAGEA(bufoff, gbase, h, nextsel) do { _Pragma("unroll") for (int _i = 0; _i < 2; ++_i) { \
        const unsigned _o = GATHER ? ((nextsel) ? gN[h][_i] : gC[h][_i]) : (voffA[_i] + (unsigned)(h) * hstepA32); \
        __builtin_amdgcn_global_load_lds((const unsigned*)((const char*)(gbase) + _o), (LAS unsigned*)(lds + (bufoff) + ldsw + _i * 8192), 16, 0, 0); } } while (0)
#define PG8_LDA(dst, b, h) do { _Pragma("unroll") for (int m = 0; m < 4; ++m) _Pragma("unroll") for (int k = 0; k < 2; ++k) dst[m][k] = *(const LAS bf16x8*)(lds + PG8_SA(b, h) + aoff + m * 2048 + k * 1024); } while (0)
#define PG8_LDB(dst, b, h) do { _Pragma("unroll") for (int n = 0; n < 2; ++n) _Pragma("unroll") for (int k = 0; k < 2; ++k) dst[n][k] = *(const LAS bf16x8*)(lds + PG8_SB(b, h) + boff + n * 2048 + k * 1024); } while (0)
#define PG8_MMA(ai, bj, At, Bt) do { __builtin_amdgcn_s_setprio(1); _Pragma("unroll") for (int m = 0; m < 4; ++m) _Pragma("unroll") for (int n = 0; n < 2; ++n) _Pragma("unroll") for (int k = 0; k < 2; ++k) \
        { if constexpr (I8) acc[ai][bj][m][n] = __builtin_amdgcn_mfma_i32_16x16x64_i8(__builtin_bit_cast(i32x4, Bt[n][k]), __builtin_bit_cast(i32x4, At[m][k]), acc[ai][bj][m][n], 0, 0, 0); \
          else acc[ai][bj][m][n] = __builtin_amdgcn_mfma_f32_16x16x32_bf16(Bt[n][k], At[m][k], acc[ai][bj][m][n], 0, 0, 0); } __builtin_amdgcn_s_setprio(0); } while (0)
#define PG8_WAIT_V(n) asm volatile("s_waitcnt vmcnt(" #n ")" ::: "memory")
#define PG8_WAIT_L(n) asm volatile("s_waitcnt lgkmcnt(" #n ")" ::: "memory")
#define PG8_BAR __builtin_amdgcn_s_barrier()
#define PG8_SCHED __builtin_amdgcn_sched_barrier(0)
    Unit cur, nxt; int ui = 0;
    if (!S.next(0, cur)) return;
    typedef typename AccT<I8>::type ACC;
    ACC acc[2][2][4][2];
#pragma unroll
    for (int a = 0; a < 2; ++a)
#pragma unroll
        for (int b = 0; b < 2; ++b)
#pragma unroll
            for (int m = 0; m < 4; ++m)
#pragma unroll
                for (int n = 0; n < 2; ++n) acc[a][b][m][n] = (ACC){0, 0, 0, 0};
    bf16x8 At[4][2], B0[2][2], B1[2][2];
    const char* cA = cur.a; const char* cB = cur.b;
    if constexpr (GATHER) S.rows(cur, tid, gC);
    PG8_STAGE(PG8_SB(0, 0), cB, voffB); PG8_STAGE(PG8_SB(0, 1), cB + hstepB, voffB); PG8_STAGEA(PG8_SA(0, 0), cA, 0, false); PG8_STAGEA(PG8_SA(0, 1), cA, 1, false);
    if (wr == 1) PG8_BAR;
    PG8_WAIT_V(2); PG8_BAR;
    PG8_STAGE(PG8_SB(1, 0), cB + kstep, voffB); PG8_STAGEA(PG8_SA(1, 0), cA + kstepA, 0, false); PG8_STAGE(PG8_SB(1, 1), cB + hstepB + kstep, voffB);
    PG8_WAIT_V(6); PG8_BAR;
    for (;;) {
        const bool has_next = S.next(ui + 1, nxt);
        const char* nA = has_next ? nxt.a : cA; const char* nB = has_next ? nxt.b : cB;
        if constexpr (GATHER) { if (has_next) S.rows(nxt, tid, gN); else {
#pragma unroll
            for (int h = 0; h < 2; ++h) { gN[h][0] = gC[h][0]; gN[h][1] = gC[h][1]; } } }
        for (int t = 0; t < nt; t += 2) {
            const bool last = (t == nt - 2);
            const char* a1 = cA + (size_t)(t + 1) * kstepA;
            const char* a2 = last ? nA : cA + (size_t)(t + 2) * kstepA; const char* b2 = last ? nB : cB + (size_t)(t + 2) * kstep;
            const char* a3 = a2 + kstepA; const char* b3 = b2 + kstep;
            PG8_LDB(B0, 0, 0); PG8_LDB(B1, 0, 1); PG8_SCHED; PG8_LDA(At, 0, 0); PG8_STAGEA(PG8_SA(1, 1), a1, 1, false);
            PG8_WAIT_V(8); PG8_WAIT_L(0); PG8_BAR; PG8_MMA(0, 0, At, B0); PG8_MMA(0, 1, At, B1); PG8_BAR; PG8_SCHED;
            PG8_LDA(At, 0, 1); PG8_STAGE(PG8_SB(0, 0), b2, voffB); PG8_STAGE(PG8_SB(0, 1), b2 + hstepB, voffB); PG8_STAGEA(PG8_SA(0, 0), a2, 0, last);
            PG8_WAIT_V(8); PG8_WAIT_L(0); PG8_BAR; PG8_MMA(1, 0, At, B0); PG8_MMA(1, 1, At, B1); PG8_BAR; PG8_SCHED;
            PG8_LDB(B0, 1, 0); PG8_LDB(B1, 1, 1); PG8_SCHED; PG8_LDA(At, 1, 0); PG8_STAGEA(PG8_SA(0, 1), a2, 1, last);
            PG8_WAIT_V(8); PG8_WAIT_L(0); PG8_BAR; PG8_MMA(0, 0, At, B0); PG8_MMA(0, 1, At, B1); PG8_BAR; PG8_SCHED;
            PG8_LDA(At, 1, 1); PG8_STAGE(PG8_SB(1, 0), b3, voffB); PG8_STAGE(PG8_SB(1, 1), b3 + hstepB, voffB); PG8_STAGEA(PG8_SA(1, 0), a3, 0, last);
            PG8_WAIT_V(8); PG8_WAIT_L(0); PG8_BAR; PG8_MMA(1, 0, At, B0); PG8_MMA(1, 1, At, B1); PG8_BAR; PG8_SCHED;
        }
        if (wr == 0) PG8_BAR;
        { const int el = my_lane(); E(acc, cur, wr, wc, el & 15, el >> 4); }
        if (!has_next) break;
        bool carried = false;
        if constexpr (Epi::CARRY) { if (nxt.aux != 0) { const int el = my_lane(); E.carry(acc, nxt, wr, wc, el & 15, el >> 4); carried = true; } }
        if (!carried) {
#pragma unroll
        for (int a = 0; a < 2; ++a)
#pragma unroll
            for (int b = 0; b < 2; ++b)
#pragma unroll
                for (int m = 0; m < 4; ++m)
#pragma unroll
                    for (int n = 0; n < 2; ++n) acc[a][b][m][n] = (ACC){0, 0, 0, 0};
        }
        cur = nxt; cA = nA; cB = nB; ++ui;
        if constexpr (GATHER) {
#pragma unroll
            for (int h = 0; h < 2; ++h) { gC[h][0] = gN[h][0]; gC[h][1] = gN[h][1]; } }
        if (wr == 1) PG8_BAR;
    }
    PG8_WAIT_V(0);
    PG8_BAR;
#undef PG8_SA
#undef PG8_SB
#undef PG8_STAGE
#undef PG8_STAGEA
#undef PG8_LDA
#undef PG8_LDB
#undef PG8_MMA
#undef PG8_WAIT_V
#undef PG8_WAIT_L
#undef PG8_BAR
#undef PG8_SCHED
}
}
using pg8::Unit;

DI unsigned cvt_pk_bf16(float lo, float hi) { unsigned r; asm volatile("s_nop 1\n\tv_cvt_pk_bf16_f32 %0, %1, %2" : "=v"(r) : "v"(lo), "v"(hi)); return r; }
DI u32x4 pack8(const f32x4& v0, const f32x4& v1) { u32x4 w; w.x = cvt_pk_bf16(v0[0], v0[1]); w.y = cvt_pk_bf16(v0[2], v0[3]); w.z = cvt_pk_bf16(v1[0], v1[1]); w.w = cvt_pk_bf16(v1[2], v1[3]); return w; }

struct SchedP1 {
    const char* A; const char* B; int nM, nN, rbA, rbB, G, c;
    DI bool next(int i, Unit& u) const {
        constexpr int NXCD = 8, WGM = 8; const int nwg = nM * nN;
        const long L = (long)i * G + c; if (L >= nwg) return false;
        int wgid = (int)L; { const int q = nwg / NXCD, r = nwg % NXCD, xcd = wgid % NXCD, off = wgid / NXCD; wgid = (xcd < r ? xcd * (q + 1) : r * (q + 1) + (xcd - r) * q) + off; }
        const int nig = WGM * nN, gid = wgid / nig, fm = gid * WGM, gsz = (nM - fm) < WGM ? (nM - fm) : WGM;
        u.pm = fm + ((wgid % nig) % gsz); u.pn = (wgid % nig) / gsz; u.aux = 0; u.pad = 0;
        u.a = A + (size_t)u.pm * 256 * rbA; u.b = B + (size_t)u.pn * 256 * rbB; return true;
    }
};
struct SchedP3a {
    const char* ys; const char* wbr; int G, c;
    DI bool next(int i, Unit& u) const {
        const int tile = (i >> 2) * G + c; if (tile >= 512) return false;
        const int br = i & 3; u.pm = tile >> 2; u.pn = tile & 3; u.aux = br; u.pad = 0;
        u.a = ys + ((size_t)u.pm * 256 * 1024 + br * 256) * 2; u.b = wbr + ((size_t)br * 1024 * 256 + (size_t)u.pn * 256 * 256) * 2; return true;
    }
};
struct SchedP3b {
    const char* A; const char* B; int G, c;
    DI bool next(int i, Unit& u) const {
        const int L = i * G + c; if (L >= 512) return false;
        u.pm = L >> 2; u.pn = L & 3; u.aux = 0; u.pad = 0;
        u.a = A + (size_t)u.pm * 256 * 1024 * 2; u.b = B + (size_t)u.pn * 256 * 1024 * 2; return true;
    }
};
struct SchedM2 {
    const char* xr; const char* wgu; const LAS int* offt; const int* rowsrc; int G, c;
    DI bool next(int i, Unit& u) const {
        const int NT = __builtin_amdgcn_readfirstlane(offt[32]) >> 8; const int L = i * G + c; if (L >= NT * 2) return false;
        const int rt = L >> 1, pn = L & 1; const int e = __builtin_amdgcn_readfirstlane(offt[40 + rt]);
        u.pm = rt; u.pn = pn; u.aux = e; u.pad = 0;
        u.a = xr; u.b = wgu + ((size_t)e * 512 + pn * 256) * 1024 * 2; return true;
    }
    DI void rows(const Unit& u, int tid, unsigned (&g)[2][2]) const {
        const int e = u.aux; const int base = u.pm * 256 - __builtin_amdgcn_readfirstlane(offt[e]), cnt = __builtin_amdgcn_readfirstlane(offt[330 + e]);
#pragma unroll
        for (int i = 0; i < 2; ++i) { int R, C; pg8::stage_rc(tid * 16 + i * 8192, R, C);
#pragma unroll
            for (int h = 0; h < 2; ++h) { const int lr = base + h * 128 + R; const int as = lr < cnt ? rowsrc[e * 32768 + lr] : 0;
                g[h][i] = (unsigned)(as >> 1) * 4096u + (unsigned)C * 2u; } }
    }
};
struct SchedM3 {
    const char* hmid; const char* wd; const LAS int* offt; int G, c;
    DI bool next(int i, Unit& u) const {
        const int NT = __builtin_amdgcn_readfirstlane(offt[32]) >> 8; const int L = i * G + c; if (L >= NT * 4) return false;
        const int rt = L >> 2, pn = L & 3; const int e = __builtin_amdgcn_readfirstlane(offt[40 + rt]);
        u.pm = rt; u.pn = pn; u.aux = e; u.pad = 0;
        u.a = hmid + (size_t)rt * 256 * 256 * 2; u.b = wd + ((size_t)e * 1024 + pn * 256) * 256 * 2; return true;
    }
};

struct EpiP1I8 {
    static constexpr bool CARRY = false;
    bf16* proj; unsigned char* gates; const float* bgate; const float* hsc; const float* wsc;
    DI void operator()(const i32x4 (&acc)[2][2][4][2], const Unit& u, int wr, int wc, int fr, int fq) const {
        const int row0 = u.pm * 256 + wr * 64 + fr;
        if (u.pn < 10) { const int colt = u.pn * 256 + wc * 32 + 8 * fq;
            f32x4 sv[2][2]; float rsv[2][4];
#pragma unroll
            for (int bj = 0; bj < 2; ++bj)
#pragma unroll
                for (int n = 0; n < 2; ++n) sv[bj][n] = *(const GAS f32x4*)((const GAS float*)wsc + colt + bj * 128 + 4 * n);
#pragma unroll
            for (int ai = 0; ai < 2; ++ai)
#pragma unroll
                for (int m = 0; m < 4; ++m) rsv[ai][m] = ((const GAS float*)hsc)[row0 + ai * 128 + m * 16];
#pragma unroll
            for (int ai = 0; ai < 2; ++ai)
#pragma unroll
                for (int m = 0; m < 4; ++m) { bf16* rowp = proj + (size_t)(row0 + ai * 128 + m * 16) * PLD + colt; const float rs = rsv[ai][m];
#pragma unroll
                    for (int bj = 0; bj < 2; ++bj) { f32x4 v0, v1;
#pragma unroll
                        for (int e = 0; e < 4; ++e) { v0[e] = (float)acc[ai][bj][m][0][e] * (rs * sv[bj][0][e]); v1[e] = (float)acc[ai][bj][m][1][e] * (rs * sv[bj][1][e]); }
                        *(u32x4*)(rowp + bj * 128) = pack8(v0, v1); } }
            return; }
        const int gcol = (u.pn - 10) * 256 + wc * 32 + 8 * fq; const float* wsc = this->wsc + 2560;
        f32x4 bv[2][2], sv[2][2];
#pragma unroll
        for (int bj = 0; bj < 2; ++bj)
#pragma unroll
            for (int n = 0; n < 2; ++n) { bv[bj][n] = *(const f32x4*)(bgate + gcol + bj * 128 + 4 * n); sv[bj][n] = *(const f32x4*)(wsc + gcol + bj * 128 + 4 * n);
                sv[bj][n] = sv[bj][n] * -1.4426950408889634f; bv[bj][n] = bv[bj][n] * -1.4426950408889634f + (-8.f + 2.2e-5f); }
        float rsv[2][4];
#pragma unroll
        for (int ai = 0; ai < 2; ++ai)
#pragma unroll
            for (int m = 0; m < 4; ++m) rsv[ai][m] = ((const GAS float*)hsc)[row0 + ai * 128 + m * 16];
#pragma unroll
        for (int ai = 0; ai < 2; ++ai)
#pragma unroll
            for (int m = 0; m < 4; ++m) { const float rs = rsv[ai][m];
                unsigned char* rowp = gates + ((size_t)(u.pm * 16 + (u.pn - 10)) * 65536 + (size_t)((ai * 4 + m) * 8192 + (wr * 4 + wc) * 1024 + (fq * 16 + fr) * 16));
                u32x4 w4;
#pragma unroll
                for (int bj = 0; bj < 2; ++bj) { unsigned q[8];
#pragma unroll
                    for (int n = 0; n < 2; ++n)
#pragma unroll
                        for (int e = 0; e < 4; ++e) { const float xe = ((float)acc[ai][bj][m][n][e] * rs) * sv[bj][n][e] + bv[bj][n][e];
                            q[4 * n + e] = (unsigned)__builtin_amdgcn_rcpf(0.00390631f + __builtin_amdgcn_exp2f(xe)); }
                    const unsigned w0 = q[0] | (q[1] << 8) | (q[2] << 16) | (q[3] << 24), w1 = q[4] | (q[5] << 8) | (q[6] << 16) | (q[7] << 24);
                    if (bj == 0) { w4.x = w0; w4.y = w1; } else { w4.z = w0; w4.w = w1; } }
                *(u32x4*)rowp = w4;
                __builtin_amdgcn_sched_barrier(0); }
    }
};
struct EpiP3a {
    static constexpr bool CARRY = true;
    bf16* merged; const unsigned char* gates;
    DI void carry(f32x4 (&acc)[2][2][4][2], const Unit& u, int wr, int wc, int fr, int fq) const {
        const GAS unsigned char* gb = (const GAS unsigned char*)gates + (size_t)(u.pm * 16 + (u.aux - 1) * 4 + u.pn) * 65536;
        const unsigned go = (unsigned)((wr * 4 + wc) * 1024 + (fq * 16 + fr) * 16);
        u32x4 gp[2][4], gn[2][4];
#pragma unroll
        for (int ai = 0; ai < 2; ++ai)
#pragma unroll
            for (int m = 0; m < 4; ++m) { gp[ai][m] = *(const GAS u32x4*)(gb + go + (unsigned)((ai * 4 + m) * 8192)); gn[ai][m] = *(const GAS u32x4*)(gb + go + (unsigned)((ai * 4 + m) * 8192 + 4 * 65536)); }
#pragma unroll
        for (int ai = 0; ai < 2; ++ai) {
#pragma unroll
            for (int m = 0; m < 4; ++m)
#pragma unroll
                for (int bj = 0; bj < 2; ++bj) {
#pragma unroll
                    for (int n = 0; n < 2; ++n) { const unsigned p4 = bj ? (n ? gp[ai][m].w : gp[ai][m].z) : (n ? gp[ai][m].y : gp[ai][m].x), n4 = bj ? (n ? gn[ai][m].w : gn[ai][m].z) : (n ? gn[ai][m].y : gn[ai][m].x);
#pragma unroll
                        for (int e = 0; e < 4; ++e) acc[ai][bj][m][n][e] *= ((float)((p4 >> (8 * e)) & 255u) + 0.5f) * __builtin_amdgcn_rcpf((float)((n4 >> (8 * e)) & 255u) + 0.5f); } }
            __builtin_amdgcn_sched_barrier(0); }
    }
    DI void operator()(const f32x4 (&acc)[2][2][4][2], const Unit& u, int wr, int wc, int fr, int fq) const {
        if (u.aux != 3) return;
        const GAS unsigned char* gb = (const GAS unsigned char*)gates + (size_t)(u.pm * 16 + 3 * 4 + u.pn) * 65536;
        GAS unsigned char* mb = (GAS unsigned char*)merged + ((size_t)(u.pm * 256) * 1024 + u.pn * 256) * 2;
        const unsigned go = (unsigned)((wr * 4 + wc) * 1024 + (fq * 16 + fr) * 16), mo = (unsigned)((wr * 64 + fr) * 1024 + wc * 32 + 8 * fq) * 2u;
        u32x4 gw[2][4];
#pragma unroll
        for (int ai = 0; ai < 2; ++ai)
#pragma unroll
            for (int m = 0; m < 4; ++m) gw[ai][m] = *(const GAS u32x4*)(gb + go + (unsigned)((ai * 4 + m) * 8192));
#pragma unroll
        for (int ai = 0; ai < 2; ++ai) {
#pragma unroll
            for (int m = 0; m < 4; ++m)
#pragma unroll
                for (int bj = 0; bj < 2; ++bj) {
                    f32x4 v0 = acc[ai][bj][m][0], v1 = acc[ai][bj][m][1]; u32x2 g2; g2.x = bj ? gw[ai][m].z : gw[ai][m].x; g2.y = bj ? gw[ai][m].w : gw[ai][m].y; const float k256 = 0.00390625f;
#pragma unroll
                    for (int e = 0; e < 4; ++e) { v0[e] *= ((float)((g2.x >> (8 * e)) & 255u) + 0.5f) * k256; v1[e] *= ((float)((g2.y >> (8 * e)) & 255u) + 0.5f) * k256; }
                    *(GAS u32x4*)(mb + mo + (unsigned)((ai * 128 + m * 16) * 1024 + bj * 128) * 2u) = pack8(v0, v1); }
            __builtin_amdgcn_sched_barrier(0); }
    }
};
template <bool XF32> struct EpiP3b {
    static constexpr bool CARRY = false;
    const float* xin; bf16* xb_;
    DI void operator()(const f32x4 (&acc)[2][2][4][2], const Unit& u, int wr, int wc, int fr, int fq) const {
        GAS unsigned char* ob = (GAS unsigned char*)xb_ + ((size_t)(u.pm * 256) * 1024 + u.pn * 256) * 2;
        const unsigned lo = (unsigned)((wr * 64 + fr) * 1024 + wc * 32 + 8 * fq);
        if constexpr (XF32) {
            const GAS unsigned char* xb = (const GAS unsigned char*)xin + ((size_t)(u.pm * 256) * 1024 + u.pn * 256) * 4;
#pragma unroll
            for (int ai = 0; ai < 2; ++ai)
#pragma unroll
                for (int mh = 0; mh < 2; ++mh) {
                    f32x4 xv[2][2][2];
#pragma unroll
                    for (int m2 = 0; m2 < 2; ++m2)
#pragma unroll
                        for (int bj = 0; bj < 2; ++bj)
#pragma unroll
                            for (int n = 0; n < 2; ++n) xv[m2][bj][n] = *(const GAS f32x4*)(xb + (lo + (unsigned)((ai * 128 + (mh * 2 + m2) * 16) * 1024 + bj * 128 + 4 * n)) * 4u);
#pragma unroll
                    for (int m2 = 0; m2 < 2; ++m2)
#pragma unroll
                        for (int bj = 0; bj < 2; ++bj)
                            *(GAS u32x4*)(ob + (lo + (unsigned)((ai * 128 + (mh * 2 + m2) * 16) * 1024 + bj * 128)) * 2u) = pack8(xv[m2][bj][0] + acc[ai][bj][mh * 2 + m2][0], xv[m2][bj][1] + acc[ai][bj][mh * 2 + m2][1]);
                    __builtin_amdgcn_sched_barrier(0); }
        } else {
#pragma unroll
            for (int ai = 0; ai < 2; ++ai) {
                u32x4 xv[4][2];
#pragma unroll
                for (int m = 0; m < 4; ++m)
#pragma unroll
                    for (int bj = 0; bj < 2; ++bj) xv[m][bj] = *(const GAS u32x4*)(ob + (lo + (unsigned)((ai * 128 + m * 16) * 1024 + bj * 128)) * 2u);
#pragma unroll
                for (int m = 0; m < 4; ++m)
#pragma unroll
                    for (int bj = 0; bj < 2; ++bj) { const u32x4 x4 = xv[m][bj]; f32x4 v0 = acc[ai][bj][m][0], v1 = acc[ai][bj][m][1];
                        v0[0] += lo_bf(x4.x); v0[1] += hi_bf(x4.x); v0[2] += lo_bf(x4.y); v0[3] += hi_bf(x4.y); v1[0] += lo_bf(x4.z); v1[1] += hi_bf(x4.z); v1[2] += lo_bf(x4.w); v1[3] += hi_bf(x4.w);
                        *(GAS u32x4*)(ob + (lo + (unsigned)((ai * 128 + m * 16) * 1024 + bj * 128)) * 2u) = pack8(v0, v1); }
                __builtin_amdgcn_sched_barrier(0); }
        }
    }
};
struct EpiM2 {
    static constexpr bool CARRY = false;
    bf16* hmid;
    DI void operator()(const f32x4 (&acc)[2][2][4][2], const Unit& u, int wr, int wc, int fr, int fq) const {
        const int row0 = u.pm * 256 + wr * 64 + fr; const int col = u.pn * 128 + wc * 32 + 8 * fq;
#pragma unroll
        for (int ai = 0; ai < 2; ++ai)
#pragma unroll
            for (int m = 0; m < 4; ++m) { f32x4 h0, h1;
#pragma unroll
                for (int e = 0; e < 4; ++e) { const float g0 = acc[ai][0][m][0][e], g1 = acc[ai][0][m][1][e];
                    h0[e] = g0 * sigmoidf_(g0) * acc[ai][1][m][0][e]; h1[e] = g1 * sigmoidf_(g1) * acc[ai][1][m][1][e]; }
                *(u32x4*)(hmid + (size_t)(row0 + ai * 128 + m * 16) * 256 + col) = pack8(h0, h1); }
    }
};
struct EpiM3 {
    static constexpr bool CARRY = false;
    bf16* eo; const int* rowtok; const float* roww; const LAS int* offt;
    DI void operator()(const f32x4 (&acc)[2][2][4][2], const Unit& u, int wr, int wc, int fr, int fq) const {
        const int e = u.aux; const int cnt = __builtin_amdgcn_readfirstlane(offt[330 + e]);
        const int lr0 = u.pm * 256 - __builtin_amdgcn_readfirstlane(offt[e]) + wr * 64 + fr; const int colt = u.pn * 256 + wc * 32 + 8 * fq;
        int tk[2][4]; float wv[2][4];
#pragma unroll
        for (int ai = 0; ai < 2; ++ai)
#pragma unroll
            for (int m = 0; m < 4; ++m) { const int lr = lr0 + ai * 128 + m * 16; tk[ai][m] = -1; wv[ai][m] = 0.f;
                if (lr < cnt) { tk[ai][m] = ((const GAS int*)rowtok)[e * 32768 + lr]; wv[ai][m] = ((const GAS float*)roww)[e * 32768 + lr]; } }
#pragma unroll
        for (int ai = 0; ai < 2; ++ai)
#pragma unroll
            for (int m = 0; m < 4; ++m) {
                if (tk[ai][m] >= 0) { const float w = wv[ai][m]; GAS bf16* op = (GAS bf16*)eo + (size_t)tk[ai][m] * 1024 + colt;
#pragma unroll
                    for (int bj = 0; bj < 2; ++bj) *(GAS u32x4*)(op + bj * 128) = pack8(acc[ai][bj][m][0] * w, acc[ai][bj][m][1] * w); }
                __builtin_amdgcn_sched_barrier(0); }
    }
};

struct Args { const float* in[36]; float* out; unsigned char* ws; int ph_lo, ph_hi; };
struct InTab { unsigned base;
    DI const float* operator[](int i) const { unsigned long long v; const unsigned addr = base + (unsigned)i * 8u;
        asm volatile("ds_read_b64 %0, %1\n\ts_waitcnt lgkmcnt(0)" : "=v"(v) : "v"(addr) : "memory");
        const unsigned lo = __builtin_amdgcn_readfirstlane((unsigned)v), hi = __builtin_amdgcn_readfirstlane((unsigned)(v >> 32));
        return (const float*)(((unsigned long long)hi << 32) | lo); } };
struct KA { InTab in; float* out; unsigned char* ws; };

DI void transpose_item(const float* W_, int ldw, int nvalid, bf16* WT_, int ldt, int k0, int n0, int dst_row0, LAS float* scr, int lane) {
    const GAS float* W = (const GAS float*)W_; GAS bf16* WT = (GAS bf16*)WT_;
    const int nq = 4 * (lane & 7), kr8 = lane >> 3;
    f32x4 v[8];
#pragma unroll
    for (int i = 0; i < 8; ++i) { const int kk = 8 * i + kr8;
        if (n0 + nq + 3 < nvalid) v[i] = *(const GAS f32x4*)(W + (size_t)(k0 + kk) * ldw + n0 + nq);
        else {
#pragma unroll
            for (int e = 0; e < 4; ++e) v[i][e] = (n0 + nq + e < nvalid) ? W[(size_t)(k0 + kk) * ldw + n0 + nq + e] : 0.f; } }
#pragma unroll
    for (int i = 0; i < 8; ++i) { const int kk = 8 * i + kr8;
#pragma unroll
        for (int e = 0; e < 4; ++e) scr[kk * 33 + nq + e] = v[i][e]; }
    LDS_WAIT(); asm volatile("" ::: "memory");
    const int c = lane & 7;
#pragma unroll
    for (int j = 0; j < 4; ++j) { const int n = (lane >> 3) + 8 * j; const LAS float* s = scr + (8 * c) * 33 + n;
        u32x4 o; o.x = pk2(s[0 * 33], s[1 * 33]); o.y = pk2(s[2 * 33], s[3 * 33]); o.z = pk2(s[4 * 33], s[5 * 33]); o.w = pk2(s[6 * 33], s[7 * 33]);
        if (n0 + n < nvalid) *(GAS u32x4*)(WT + (size_t)(dst_row0 + n) * ldt + k0 + 8 * c) = o; }
    LDS_WAIT(); asm volatile("" ::: "memory");
}
DI void phase0_weights(const KA& a, int l, LAS unsigned char* lds, int gw, int NGW, int wave, int lane) {
    LAS float* scr = (LAS float*)(lds + wave * 16384);
    const float* w_in = a.in[4] + (size_t)l * 1024 * NIN;
    const float* w_gate = a.in[24] + (size_t)l * 4 * 1024 * 1024;
    const float* w_br = a.in[26] + (size_t)l * 4 * 256 * 1024;
    const float* w_out = a.in[27] + (size_t)l * 1024 * 1024;
    bf16* Wt_in = (bf16*)(a.ws + WS_WIN); bf16* Wt_br = (bf16*)(a.ws + WS_WBR); bf16* Wt_out = (bf16*)(a.ws + WS_WOUT);
    constexpr int I_B = 4 * 4 * 32, I_O = 16 * 32, NIT = I_B + I_O;
    (void)w_gate; (void)w_in; (void)Wt_in;
    for (int it = gw; it < NIT; it += NGW) {
        int r = it;
        if (r < I_B) { const int br = r / 128, q = r % 128, kb = q / 32, nb = q % 32; transpose_item(w_br + (size_t)br * 256 * 1024, 1024, 1024, Wt_br + (size_t)br * 1024 * 256, 256, kb * 64, nb * 32, nb * 32, scr, lane); continue; } r -= I_B;
        { const int kb = r / 32, nb = r % 32; transpose_item(w_out, 1024, 1024, Wt_out, 1024, kb * 64, nb * 32, nb * 32, scr, lane); }
    }
}
DI void p1_weights_i8(const KA& a, int l, LAS unsigned char* lds, int bid, int G, int wave, int lane) {
    LAS float* scr = (LAS float*)(lds + wave * 16384); LAS float* red = (LAS float*)(lds + 7 * 16384 + 12288);
    const GAS float* wgt = (const GAS float*)(a.in[24] + (size_t)l * 4 * 1024 * 1024); const GAS float* win = (const GAS float*)(a.in[4] + (size_t)l * 1024 * NIN);
    GAS unsigned char* Wq = (GAS unsigned char*)(a.ws + WS_WQ); GAS float* wsc = (GAS float*)(a.ws + WS_WSC);
    const int nq = 4 * (lane & 7), kr8 = lane >> 3;
    for (int it = G - 1 - bid; it < 128 + 77; it += G) {
        const bool isg = it < 128; const int br = it >> 5; const int n0 = isg ? (it & 31) * 32 : (it - 128) * 32;
        const int ldw = isg ? 1024 : NIN; const int nval = isg ? 1024 : NIN; const int drow0 = isg ? 2560 + br * 1024 + n0 : n0;
        const bool lok = (n0 + nq) < nval;
        const GAS float* W = (isg ? wgt + (size_t)br * 1024 * 1024 : win) + n0 + nq + (size_t)(128 * wave) * ldw;
        f32x4 v[16];
#pragma unroll
        for (int i = 0; i < 16; ++i) { v[i] = (f32x4){0.f, 0.f, 0.f, 0.f}; if (lok) v[i] = *(const GAS f32x4*)(W + (size_t)(8 * i + kr8) * ldw); }
        f32x4 mx = {0.f, 0.f, 0.f, 0.f};
#pragma unroll
        for (int i = 0; i < 16; ++i) { mx[0] = fmaxf(mx[0], fabsf(v[i][0])); mx[1] = fmaxf(mx[1], fabsf(v[i][1])); mx[2] = fmaxf(mx[2], fabsf(v[i][2])); mx[3] = fmaxf(mx[3], fabsf(v[i][3])); }
#pragma unroll
        for (int e = 0; e < 4; ++e) { float m = mx[e]; m = fmaxf(m, xshfl<8>(m)); m = fmaxf(m, xshfl<16>(m)); m = fmaxf(m, xshfl<32>(m)); mx[e] = m; }
        if (kr8 == 0) {
#pragma unroll
            for (int e = 0; e < 4; ++e) red[wave * 32 + nq + e] = mx[e]; }
        __syncthreads();
#pragma unroll
        for (int e = 0; e < 4; ++e) { float m = red[nq + e];
#pragma unroll
            for (int w = 1; w < 8; ++w) m = fmaxf(m, red[w * 32 + nq + e]);
            mx[e] = fmaxf(m, 1e-20f); }
        if (wave == 0 && kr8 == 0 && lok) *(GAS f32x4*)(wsc + drow0 + nq) = mx * (1.f / 127.f);
        const f32x4 qs = {127.f / mx[0], 127.f / mx[1], 127.f / mx[2], 127.f / mx[3]};
#pragma unroll
        for (int hb = 0; hb < 2; ++hb) {
#pragma unroll
            for (int i = 0; i < 8; ++i) { const int kk = 8 * i + kr8;
#pragma unroll
                for (int e = 0; e < 4; ++e) scr[kk * 33 + nq + e] = __builtin_rintf(v[8 * hb + i][e] * qs[e]); }
            LDS_WAIT(); asm volatile("" ::: "memory");
            const int n = lane >> 1, kh = lane & 1; u32x4 o[2];
#pragma unroll
            for (int h2 = 0; h2 < 2; ++h2) { unsigned w4[4];
#pragma unroll
                for (int d = 0; d < 4; ++d) { unsigned wv = 0u;
#pragma unroll
                    for (int e = 0; e < 4; ++e) wv |= ((unsigned)(int)scr[(32 * kh + 16 * h2 + 4 * d + e) * 33 + n] & 255u) << (8 * e);
                    w4[d] = wv; }
                o[h2].x = w4[0]; o[h2].y = w4[1]; o[h2].z = w4[2]; o[h2].w = w4[3]; }
            if (n0 + n < nval) { GAS unsigned char* dst = Wq + (size_t)(drow0 + n) * 1024 + 128 * wave + 64 * hb + 32 * kh; *(GAS u32x4*)dst = o[0]; *(GAS u32x4*)(dst + 16) = o[1]; }
            LDS_WAIT(); asm volatile("" ::: "memory");
        }
        __syncthreads();
    }
}

DI void router_weights(const KA& a, int l, int gw, int NGW, int lane) {
    bf16* Wr = (bf16*)(a.ws + WS_WR);
    const float* wg = a.in[29] + (size_t)l * 1024 * 4; const float* we = a.in[31] + (size_t)l * 1024 * 32;
    for (int n = gw; n < 36; n += NGW) {
        for (int i = 0; i < 16; ++i) { const int k = lane + 64 * i; const float w = (n < 4) ? wg[k * 4 + n] : we[k * 32 + (n - 4)];
            const unsigned hi = f2bf(w); const float hf = __builtin_bit_cast(float, hi << 16); const unsigned lo = f2bf(w - hf);
            Wr[(size_t)n * 2048 + k] = (bf16)hi; Wr[(size_t)n * 2048 + 1024 + k] = (bf16)hi; Wr[(size_t)(64 + n) * 2048 + k] = (bf16)lo; Wr[(size_t)(64 + n) * 2048 + 1024 + k] = 0; }
    }
}

DI void cmp_weights(const KA& a, int l, LAS unsigned char* lds, int gw, int NGW, int wave, int lane) {
    LAS float* scr = (LAS float*)(lds + wave * 16384);
    bf16* Wc = (bf16*)(a.ws + WS_WCMP); float* pt = (float*)(a.ws + WS_CMPAB + 2 * MiB);
    for (int it = gw; it < 128 + 64; it += NGW) {
        if (it < 128) { const int kv = it >> 6, q = it & 63, kb = q >> 1, nb = q & 1; const float* w1 = a.in[kv ? 22 : 19] + (size_t)l * 2048 * 64;
            bf16* dst = Wc + (size_t)kv * 256 * 1024 - (kb >= 16 ? 1024 : 0);
            transpose_item(w1, 64, 64, dst, 1024, kb * 64, nb * 32, (kb >= 16 ? 64 : 0) + nb * 32, scr, lane);
        } else { const int kv = (it - 128) >> 5, part = (it - 128) & 31;
            const GAS float* w1 = (const GAS float*)(a.in[kv ? 22 : 19] + (size_t)l * 2048 * 64) + (size_t)part * 64 * 64; const GAS float* pos = (const GAS float*)(a.in[kv ? 21 : 18] + (size_t)l * 2048) + part * 64;
            float acc = 0.f;
#pragma unroll 16
            for (int k = 0; k < 64; ++k) acc += pos[k] * w1[(size_t)k * 64 + lane];
            pt[(kv * 32 + part) * 64 + lane] = acc; }
    }
}

DI void lru_weights(const KA& a, int l, int gw, int NGW, int lane) {
    bf16* W = (bf16*)(a.ws + WS_LRUW); const float* wa = a.in[7] + (size_t)l * 4 * 4096; const float* wx = a.in[9] + (size_t)l * 4 * 4096;
    (void)NGW; { const int idx = gw * 64 + lane; if (idx < 32768) { const int i = idx & 63, j = (idx >> 6) & 63, mat = (idx >> 12) & 1, hbk = idx >> 13;
        W[idx] = (bf16)f2bf((mat ? wx : wa)[(size_t)hbk * 4096 + i * 64 + j]); } }
}
DI void phase0_rows(const KA& a, int l, int mode, int gw, int NGW, int lane) {
    const GAS float* xin = (const GAS float*)a.in[0]; GAS bf16* xb = (GAS bf16*)(a.ws + WS_XB);
    const GAS bf16* eo = (const GAS bf16*)(a.ws + WS_PROJ);
    GAS float* outp = (GAS float*)a.out;
    const GAS float* g = (const GAS float*)(mode ? a.in[2] : (a.in[3] + (size_t)l * 1024));
    f32x4 gv[2][2];
#pragma unroll
    for (int j = 0; j < 2; ++j) { gv[j][0] = *(const GAS f32x4*)(g + 8 * (lane + 64 * j)); gv[j][1] = *(const GAS f32x4*)(g + 8 * (lane + 64 * j) + 4); }
    for (int m0 = gw * 4; m0 < T; m0 += NGW * 4) {
        f32x4 v[4][2][2]; float ss[4];
        if (l == 0) {
#pragma unroll
            for (int rr = 0; rr < 4; ++rr)
#pragma unroll
                for (int j = 0; j < 2; ++j) { const GAS float* xp = xin + (size_t)(m0 + rr) * 1024 + 8 * (lane + 64 * j); v[rr][j][0] = *(const GAS f32x4*)xp; v[rr][j][1] = *(const GAS f32x4*)(xp + 4); }
        } else {
            u32x4 xw[4][2], e0[4][2], e1[4][2];
#pragma unroll
            for (int rr = 0; rr < 4; ++rr)
#pragma unroll
                for (int j = 0; j < 2; ++j) { const size_t co = 8 * (lane + 64 * j);
                    xw[rr][j] = *(const GAS u32x4*)(xb + (size_t)(m0 + rr) * 1024 + co);
                    e0[rr][j] = *(const GAS u32x4*)(eo + (size_t)(2 * (m0 + rr)) * 1024 + co); e1[rr][j] = *(const GAS u32x4*)(eo + (size_t)(2 * (m0 + rr) + 1) * 1024 + co); }
#pragma unroll
            for (int rr = 0; rr < 4; ++rr)
#pragma unroll
                for (int j = 0; j < 2; ++j) { const u32x4 x4 = xw[rr][j], a4 = e0[rr][j], b4 = e1[rr][j];
                    v[rr][j][0][0] = lo_bf(x4.x) + (lo_bf(a4.x) + lo_bf(b4.x)); v[rr][j][0][1] = hi_bf(x4.x) + (hi_bf(a4.x) + hi_bf(b4.x));
                    v[rr][j][0][2] = lo_bf(x4.y) + (lo_bf(a4.y) + lo_bf(b4.y)); v[rr][j][0][3] = hi_bf(x4.y) + (hi_bf(a4.y) + hi_bf(b4.y));
                    v[rr][j][1][0] = lo_bf(x4.z) + (lo_bf(a4.z) + lo_bf(b4.z)); v[rr][j][1][1] = hi_bf(x4.z) + (hi_bf(a4.z) + hi_bf(b4.z));
                    v[rr][j][1][2] = lo_bf(x4.w) + (lo_bf(a4.w) + lo_bf(b4.w)); v[rr][j][1][3] = hi_bf(x4.w) + (hi_bf(a4.w) + hi_bf(b4.w)); }
        }
#pragma unroll
        for (int rr = 0; rr < 4; ++rr) { float t = 0.f;
#pragma unroll
            for (int j = 0; j < 2; ++j)
#pragma unroll
                for (int h = 0; h < 2; ++h) t += (v[rr][j][h][0] * v[rr][j][h][0] + v[rr][j][h][1] * v[rr][j][h][1]) + (v[rr][j][h][2] * v[rr][j][h][2] + v[rr][j][h][3] * v[rr][j][h][3]);
            ss[rr] = t; }
#pragma unroll
        for (int rr = 0; rr < 4; ++rr) ss[rr] = wave_sum(ss[rr]);
        if (mode) {
#pragma unroll
            for (int rr = 0; rr < 4; ++rr) { const float r = __builtin_amdgcn_rsqf(ss[rr] * (1.f / 1024.f) + 1e-6f); const size_t m = (size_t)(m0 + rr);
#pragma unroll
                for (int j = 0; j < 2; ++j) { GAS float* op = outp + m * 1024 + 8 * (lane + 64 * j); *(GAS f32x4*)op = v[rr][j][0] * r * gv[j][0]; *(GAS f32x4*)(op + 4) = v[rr][j][1] * r * gv[j][1]; } }
        } else {
            GAS unsigned char* hq = (GAS unsigned char*)(a.ws + WS_HQ); GAS float* hsc = (GAS float*)(a.ws + WS_HSC);
            float am[4];
#pragma unroll
            for (int rr = 0; rr < 4; ++rr) { const float r = __builtin_amdgcn_rsqf(ss[rr] * (1.f / 1024.f) + 1e-6f); const size_t m = (size_t)(m0 + rr); float t = 0.f;
#pragma unroll
                for (int j = 0; j < 2; ++j) {
                    if (l > 0) { u32x4 w; w.x = pk2(v[rr][j][0][0], v[rr][j][0][1]); w.y = pk2(v[rr][j][0][2], v[rr][j][0][3]); w.z = pk2(v[rr][j][1][0], v[rr][j][1][1]); w.w = pk2(v[rr][j][1][2], v[rr][j][1][3]);
                        *(GAS u32x4*)(xb + m * 1024 + 8 * (lane + 64 * j)) = w; }
#pragma unroll
                    for (int h = 0; h < 2; ++h) { const f32x4 y = v[rr][j][h] * r * gv[j][h]; v[rr][j][h] = y;
                        t = fmaxf(t, fmaxf(fmaxf(fabsf(y[0]), fabsf(y[1])), fmaxf(fabsf(y[2]), fabsf(y[3])))); } }
                am[rr] = t; }
#pragma unroll
            for (int rr = 0; rr < 4; ++rr) am[rr] = fmaxf(wave_max(am[rr]), 1e-20f);
#pragma unroll
            for (int rr = 0; rr < 4; ++rr) { const size_t m = (size_t)(m0 + rr); const float qs = 127.f * __builtin_amdgcn_rcpf(am[rr]);
                if (lane == 0) hsc[m] = am[rr] * (1.f / 127.f);
#pragma unroll
                for (int j = 0; j < 2; ++j) { u32x2 q2;
#pragma unroll
                    for (int h = 0; h < 2; ++h) { const f32x4 y = v[rr][j][h] * qs;
                        const unsigned q = ((unsigned)(int)__builtin_rintf(y[0]) & 255u) | (((unsigned)(int)__builtin_rintf(y[1]) & 255u) << 8) | (((unsigned)(int)__builtin_rintf(y[2]) & 255u) << 16) | (((unsigned)(int)__builtin_rintf(y[3]) & 255u) << 24);
                        if (h == 0) q2.x = q; else q2.y = q; }
                    *(GAS u32x2*)(hq + m * 1024 + 8 * (lane + 64 * j)) = q2; } }
        }
    }
}

DI int crow(int i, int hh) { return (i & 3) + 8 * (i >> 2) + 4 * hh; }
DI unsigned cvtpk(float lo, float hi) { f32x2 v = {lo, hi}; bf16x2_t b = __builtin_convertvector(v, bf16x2_t); return __builtin_bit_cast(unsigned, b); }
template <int CTRL, int RMASK> DI float dppf(float oldv, float v) { return __builtin_bit_cast(float, __builtin_amdgcn_update_dpp(__builtin_bit_cast(int, oldv), __builtin_bit_cast(int, v), CTRL, RMASK, 0xf, false)); }
template <int CTRL, int RMASK> DI void scan_step(float& a, float& b) {
    const float ap = dppf<CTRL, RMASK>(1.f, a), bp = dppf<CTRL, RMASK>(0.f, b); b = a * bp + b; a = a * ap; }
DI void lru_unit(const KA& a, int l, const GAS bf16* proj, GAS bf16* ys, GAS float* sums, LAS unsigned char* lds, int task, int lane_in, int wave_in, bool final) {
    int lane = lane_in, wave = wave_in; asm volatile("" : "+v"(lane), "+s"(wave));
    const int chunk = task & 31, hbk = (task >> 5) & 3, b = task >> 7;
    const int ts = chunk * 256 + wave * 32; const size_t rowb = (size_t)b * SEQ;
    LAS unsigned char* wl = lds + wave * 16384;
    LAS float* ex = (LAS float*)(lds + LRUEX_OFF); LAS float* cst = (LAS float*)(lds + LRUCST_OFF); LAS float* car = (LAS float*)(lds + LRUCAR_OFF) + wave * 64;
    const int n = lane & 31, hh = lane >> 5;
    const int c = hbk * 64 + lane;
    const GAS float* cw = (const GAS float*)(a.in[5] + (size_t)l * 4 * 256);
    const GAS float* p6 = (const GAS float*)a.in[6]; const GAS float* p8 = (const GAS float*)a.in[8]; const GAS float* p10 = (const GAS float*)a.in[10]; const GAS float* p11 = (const GAS float*)a.in[11];
    const float cw0 = cw[c], cw1 = cw[256 + c], cw2 = cw[512 + c], cw3 = cw[768 + c]; const float cb = p6[l * 256 + c];
    const float k8 = p8[l * 256 + c], k10 = p10[l * 256 + c], k11 = p11[l * 256 + c];
    const GAS bf16* xp = proj + (rowb + ts) * PLD + C_AX + c;
    unsigned short xraw[35];
#pragma unroll
    for (int j = 0; j < 3; ++j) xraw[j] = (ts >= 3 - j) ? *(const GAS unsigned short*)(xp - (3 - j) * PLD) : (unsigned short)0;
#pragma unroll
    for (int j = 0; j < 32; ++j) xraw[3 + j] = *(const GAS unsigned short*)(xp + (size_t)j * PLD);
    const GAS bf16* wt = (const GAS bf16*)(a.ws + WS_LRUW) + (size_t)hbk * 8192;
    bf16x8 afr[4][4];
#pragma unroll
    for (int m = 0; m < 4; ++m)
#pragma unroll
        for (int s4 = 0; s4 < 4; ++s4) afr[m][s4] = *(const GAS bf16x8*)(wt + (size_t)(m >> 1) * 4096 + (32 * (m & 1) + n) * 64 + 8 * hh + 16 * s4);
    f32x2 sv[31]; u32x2 gt2[2][4];
    const GAS bf16* gp = proj + (rowb + ts + n) * PLD + C_AG + hbk * 64;
    if (final) {
        const GAS f32x2* sp = (const GAS f32x2*)(sums + ((size_t)((b * 4 + hbk) * 32) * 64 + lane) * 2);
#pragma unroll
        for (int cc = 0; cc < 31; ++cc) { const int ci = cc < chunk ? cc : 0; sv[cc] = sp[(size_t)ci * 64]; }
#pragma unroll
        for (int mm = 0; mm < 2; ++mm)
#pragma unroll
            for (int g4 = 0; g4 < 4; ++g4) gt2[mm][g4] = *(const GAS u32x2*)(gp + 32 * mm + 8 * g4 + 4 * hh);
    }
    {
        if (wave == 0) { cst[lane] = -1.4426950408889634f * k8; cst[64 + lane] = -1.4426950408889634f * k10; cst[128 + lane] = -8.f * 1.4426950408889634f * softplusf_(-k11); }
        float x3 = __builtin_bit_cast(float, (unsigned)xraw[0] << 16), x2 = __builtin_bit_cast(float, (unsigned)xraw[1] << 16), x1 = __builtin_bit_cast(float, (unsigned)xraw[2] << 16);
#pragma unroll
        for (int j = 0; j < 32; ++j) { const float x0 = __builtin_bit_cast(float, (unsigned)xraw[3 + j] << 16); const float xc = cb + cw0 * x3 + cw1 * x2 + cw2 * x1 + cw3 * x0;
            *(LAS bf16*)(wl + j * 144 + lane * 2) = (bf16)f2bf(xc); *(LAS float*)(wl + 4608 + j * 272 + lane * 4) = xc; x3 = x2; x2 = x1; x1 = x0; }
    }
    f32x16 D[4];
    {
        bf16x8 bfr[4];
        LDS_WAIT();
#pragma unroll
        for (int s4 = 0; s4 < 4; ++s4) bfr[s4] = *(const LAS bf16x8*)(wl + n * 144 + hh * 16 + s4 * 32);
#pragma unroll
        for (int m = 0; m < 4; ++m) {
#pragma unroll
            for (int s4 = 0; s4 < 4; ++s4) {
                if (s4 == 0) { f32x16 z;
#pragma unroll
                    for (int i = 0; i < 16; ++i) z[i] = 0.f;
                    D[m] = MFMA32(afr[m][s4], bfr[s4], z); } else D[m] = MFMA32(afr[m][s4], bfr[s4], D[m]); } }
    }
    __syncthreads();
    const bool t0 = (ts + n) == 0;
#pragma unroll
    for (int mm = 0; mm < 2; ++mm)
#pragma unroll
        for (int g4 = 0; g4 < 4; ++g4) { const int c0 = 32 * mm + 8 * g4 + 4 * hh;
            const f32x4 vba = *(const LAS f32x4*)(cst + c0), vbx = *(const LAS f32x4*)(cst + 64 + c0), vc8 = *(const LAS f32x4*)(cst + 128 + c0);
            const f32x4 vxc = *(const LAS f32x4*)(wl + 4608 + n * 272 + c0 * 4);
#pragma unroll
            for (int e = 0; e < 4; ++e) { const int i = 4 * g4 + e;
                const float r = __builtin_amdgcn_rcpf(1.f + __builtin_amdgcn_exp2f(D[mm][i] * -1.4426950408889634f + vba[e]));
                const float ig = __builtin_amdgcn_rcpf(1.f + __builtin_amdgcn_exp2f(D[2 + mm][i] * -1.4426950408889634f + vbx[e]));
                const float av = __builtin_amdgcn_exp2f(vc8[e] * r);
                const float mult = t0 ? 1.f : __builtin_amdgcn_sqrtf(fmaxf(1.f - av * av, 0.f));
                float aa = av, bb = mult * ig * vxc[e];
                scan_step<0x111, 0xf>(aa, bb); scan_step<0x112, 0xf>(aa, bb); scan_step<0x114, 0xf>(aa, bb); scan_step<0x118, 0xf>(aa, bb); scan_step<0x142, 0xa>(aa, bb);
                D[mm][i] = aa; D[2 + mm][i] = bb; } }
    if (n == 31) {
#pragma unroll
        for (int mm = 0; mm < 2; ++mm)
#pragma unroll
            for (int i = 0; i < 16; ++i) { const int c = 32 * mm + crow(i, hh); ex[(wave * 64 + c) * 2] = D[mm][i]; ex[(wave * 64 + c) * 2 + 1] = D[2 + mm][i]; } }
    __syncthreads();
    if (!final) {
        if (wave == 0) { float hv = 0.f, av = 1.f;
#pragma unroll
            for (int w = 0; w < 8; ++w) { const float A_ = ex[(w * 64 + lane) * 2], H_ = ex[(w * 64 + lane) * 2 + 1]; hv = A_ * hv + H_; av *= A_; }
            GAS float* sp = sums + ((size_t)((b * 4 + hbk) * 32 + chunk) * 64 + lane) * 2; sp[0] = av; sp[1] = hv; }
    } else {
        {   float hv = 0.f;
#pragma unroll
            for (int cc = 0; cc < 31; ++cc) { const float A_ = cc < chunk ? sv[cc][0] : 1.f, H_ = cc < chunk ? sv[cc][1] : 0.f; hv = A_ * hv + H_; }
            for (int w = 0; w < wave; ++w) { const float A_ = ex[(w * 64 + lane) * 2], H_ = ex[(w * 64 + lane) * 2 + 1]; hv = A_ * hv + H_; }
            car[lane] = hv; }
        LDS_WAIT(); asm volatile("" ::: "memory");
        GAS bf16* yp = ys + (rowb + ts + n) * 1024 + hbk * 64;
#pragma unroll
        for (int mm = 0; mm < 2; ++mm)
#pragma unroll
            for (int g4 = 0; g4 < 4; ++g4) { const int c0 = 32 * mm + 8 * g4 + 4 * hh; const f32x4 cv = *(const LAS f32x4*)(car + c0);
                const u32x2 gw2 = gt2[mm][g4]; float y[4];
#pragma unroll
                for (int e = 0; e < 4; ++e) { const int i = 4 * g4 + e; const float hv = D[2 + mm][i] + D[mm][i] * cv[e];
                    const float gt = (e == 0) ? lo_bf(gw2.x) : (e == 1) ? hi_bf(gw2.x) : (e == 2) ? lo_bf(gw2.y) : hi_bf(gw2.y); const float wv = gt * (2.302208198f + 0.102943240f * gt * gt);
                    y[e] = hv * (gt - gt * __builtin_amdgcn_rcpf(__builtin_amdgcn_exp2f(wv) + 1.f)); }
                u32x2 yo; yo.x = cvtpk(y[0], y[1]); yo.y = cvtpk(y[2], y[3]); *(GAS u32x2*)(yp + c0) = yo; }
    }
    __syncthreads();
}

constexpr int DK_STR = 144, DV_STR = 192, DBUF_BYTES = 64 * DK_STR + 64 * DV_STR;
DI bf16x8 pack_half(const f32x16& x, int s2) { u32x4 p;
    if (s2 == 0) { p.x = cvtpk(x[0], x[1]); p.y = cvtpk(x[2], x[3]); p.z = cvtpk(x[4], x[5]); p.w = cvtpk(x[6], x[7]); }
    else { p.x = cvtpk(x[8], x[9]); p.y = cvtpk(x[10], x[11]); p.z = cvtpk(x[12], x[13]); p.w = cvtpk(x[14], x[15]); }
    return __builtin_bit_cast(bf16x8, p); }
DI s16x4 vtr(const LAS unsigned char* p) { return __builtin_bit_cast(s16x4, __builtin_amdgcn_ds_read_tr16_b64_v4i16((LAS v4i16_t*)p)); }
DI float max16(const f32x16& x) { float a = fmaxf(fmaxf(x[0], x[1]), fmaxf(x[2], x[3])), b = fmaxf(fmaxf(x[4], x[5]), fmaxf(x[6], x[7])), c = fmaxf(fmaxf(x[8], x[9]), fmaxf(x[10], x[11])), d = fmaxf(fmaxf(x[12], x[13]), fmaxf(x[14], x[15])); return fmaxf(fmaxf(a, b), fmaxf(c, d)); }
DI void diff_unit(const GAS bf16* proj, GAS bf16* ys, LAS unsigned char* lds, const LAS float* bias2, const GAS float* subg, const LAS float* lamp, int b, int h, int qb, int wave_in) {
    int wave = wave_in; asm volatile("" : "+s"(wave)); const int lane = my_lane(); const int tid = wave * 64 + lane;
    const int q0 = qb * 256 + wave * 32; const int ql = lane & 31, hh = lane >> 5; const int q = q0 + ql;
    const size_t rowb = (size_t)b * SEQ;
    const float SC = 0.17677669529663687f * 1.4426950408889634f;
    bf16x8 qf[2][2];
    { const GAS bf16* qp = proj + (rowb + q) * PLD + C_CQ + h * 64 + hh * 8;
#pragma unroll
      for (int m = 0; m < 2; ++m)
#pragma unroll
        for (int s = 0; s < 2; ++s) { const u32x4 w = *(const GAS u32x4*)(qp + m * 32 + s * 16); u32x4 o;
            o.x = cvtpk(lo_bf(w.x) * SC, hi_bf(w.x) * SC); o.y = cvtpk(lo_bf(w.y) * SC, hi_bf(w.y) * SC); o.z = cvtpk(lo_bf(w.z) * SC, hi_bf(w.z) * SC); o.w = cvtpk(lo_bf(w.w) * SC, hi_bf(w.w) * SC);
            qf[m][s] = __builtin_bit_cast(bf16x8, o); } }
    f32x16 O[2][2], negm[2];
#pragma unroll
    for (int i = 0; i < 16; ++i) { O[0][0][i] = 0.f; O[0][1][i] = 0.f; O[1][0][i] = 0.f; O[1][1][i] = 0.f; negm[0][i] = 120.f; negm[1][i] = 120.f; }
    float lsum[2] = {0.f, 0.f};
    const int nsteps = 4 * qb + 4, mysteps = 4 * qb + (wave >> 1) + 1;
    const int skey = tid >> 3, sch = tid & 7;
    const GAS unsigned char* kgb = (const GAS unsigned char*)(proj + rowb * PLD + C_CK + h * 64);
    const GAS unsigned char* vgb = (const GAS unsigned char*)(proj + rowb * PLD + C_CV + h * 64);
    const unsigned soff = (unsigned)(skey * PLD + sch * 8) * 2u;
    u32x4 kr = *(const GAS u32x4*)(kgb + soff), vr = *(const GAS u32x4*)(vgb + soff);
    *(LAS u32x4*)(lds + skey * DK_STR + sch * 16) = kr; *(LAS u32x4*)(lds + 64 * DK_STR + skey * DV_STR + sch * 16) = vr;
    __syncthreads();
    const int i16 = lane & 15, blk = (lane >> 4) & 1;
    const int kboff = ql * DK_STR + hh * 16;
    const int vboff = 64 * DK_STR + (4 * hh + (i16 >> 2)) * DV_STR + (16 * blk + 4 * (i16 & 3)) * 2;
#pragma unroll 1
    for (int kt = 0; kt < nsteps; ++kt) {
        const LAS unsigned char* cur = lds + (kt & 1) * DBUF_BYTES; LAS unsigned char* nxt = lds + ((kt + 1) & 1) * DBUF_BYTES;
        if (kt + 1 < nsteps) { const unsigned so = soff + (unsigned)(kt + 1) * (64u * PLD * 2u); kr = *(const GAS u32x4*)(kgb + so); vr = *(const GAS u32x4*)(vgb + so); }
        if (kt < mysteps) {
            const int kbase = kt * 64;
            const bool near = (q0 - (kbase + 63) < 113);
#pragma unroll
            for (int m = 0; m < 2; ++m) {
                bf16x8 pk[2][2];
                f32x16 S[2]; float ts = 0.f;
                {   bf16x8 kf[2][2];
#pragma unroll
                    for (int t = 0; t < 2; ++t)
#pragma unroll
                        for (int s = 0; s < 2; ++s) kf[t][s] = *(const LAS bf16x8*)(cur + kboff + t * 32 * DK_STR + m * 64 + s * 32);
#pragma unroll
                    for (int t = 0; t < 2; ++t) { S[t] = MFMA32(kf[t][0], qf[m][0], negm[m]); S[t] = MFMA32(kf[t][1], qf[m][1], S[t]); } }
                if (near) {
#pragma unroll
                    for (int t = 0; t < 2; ++t)
#pragma unroll
                        for (int g = 0; g < 2; ++g) { float tb[8];
#pragma unroll
                            for (int j = 0; j < 8; ++j) { const int dist = q - (kbase + 32 * t + crow(8 * g + j, hh)); const int di = dist < 0 ? 0 : (dist < 128 ? dist : 128); tb[j] = bias2[di * 12 + 4 + h]; }
#pragma unroll
                            for (int j = 0; j < 8; ++j) { const int dist = q - (kbase + 32 * t + crow(8 * g + j, hh)); S[t][8 * g + j] += dist >= 0 ? tb[j] : -1e30f; }
                            __builtin_amdgcn_sched_barrier(0); } }
#pragma unroll
                for (int t = 0; t < 2; ++t)
#pragma unroll
                    for (int i = 0; i < 16; ++i) { const float p = __builtin_amdgcn_exp2f(S[t][i]); S[t][i] = p; ts += p; }
                if (__builtin_amdgcn_ballot_w64(!(ts < 1.0e30f)) != 0ull) {
                {   bf16x8 kf[2][2];
#pragma unroll
                        for (int t = 0; t < 2; ++t)
#pragma unroll
                            for (int s = 0; s < 2; ++s) kf[t][s] = *(const LAS bf16x8*)(cur + kboff + t * 32 * DK_STR + m * 64 + s * 32);
#pragma unroll
                        for (int t = 0; t < 2; ++t) { S[t] = MFMA32(kf[t][0], qf[m][0], negm[m]); S[t] = MFMA32(kf[t][1], qf[m][1], S[t]); } }
                    if (near) {
#pragma unroll
                        for (int t = 0; t < 2; ++t)
#pragma unroll
                            for (int g = 0; g < 2; ++g) { float tb[8];
#pragma unroll
                                for (int j = 0; j < 8; ++j) { const int dist = q - (kbase + 32 * t + crow(8 * g + j, hh)); const int di = dist < 0 ? 0 : (dist < 128 ? dist : 128); tb[j] = bias2[di * 12 + 4 + h]; }
#pragma unroll
                                for (int j = 0; j < 8; ++j) { const int dist = q - (kbase + 32 * t + crow(8 * g + j, hh)); S[t][8 * g + j] += dist >= 0 ? tb[j] : -1e30f; }
                                __builtin_amdgcn_sched_barrier(0); } }
                    float tm = fmaxf(max16(S[0]), max16(S[1])); tm = fmaxf(tm, xshfl<32>(tm));
                    const float sh = fmaxf(tm, 0.f); const float al = __builtin_amdgcn_exp2f(-sh);
                    lsum[m] *= al; ts = 0.f;
#pragma unroll
                    for (int i = 0; i < 16; ++i) { O[m][0][i] *= al; O[m][1][i] *= al; negm[m][i] -= sh; }
#pragma unroll
                    for (int t = 0; t < 2; ++t)
#pragma unroll
                        for (int i = 0; i < 16; ++i) { const float p = __builtin_amdgcn_exp2f(S[t][i] - sh); S[t][i] = p; ts += p; }
                }
                lsum[m] += ts;
#pragma unroll
                for (int t = 0; t < 2; ++t) { pk[t][0] = pack_half(S[t], 0); pk[t][1] = pack_half(S[t], 1); }
#pragma unroll
                for (int t = 0; t < 2; ++t)
#pragma unroll
                    for (int s2 = 0; s2 < 2; ++s2)
#pragma unroll
                        for (int db = 0; db < 2; ++db) {
                            const s16x4 lo = vtr(cur + vboff + (32 * t + 16 * s2) * DV_STR + db * 64), hi = vtr(cur + vboff + (32 * t + 16 * s2 + 8) * DV_STR + db * 64);
                            const bf16x8 vf = __builtin_shufflevector(lo, hi, 0, 1, 2, 3, 4, 5, 6, 7);
                            O[m][db] = MFMA32(vf, pk[t][s2], O[m][db]); }
                ;
            }
        }
        if (kt + 1 < nsteps) { *(LAS u32x4*)(nxt + skey * DK_STR + sch * 16) = kr; *(LAS u32x4*)(nxt + 64 * DK_STR + skey * DV_STR + sch * 16) = vr; }
        __syncthreads();
    }
    const float l0 = lsum[0] + xshfl<32>(lsum[0]), l1 = lsum[1] + xshfl<32>(lsum[1]);
    const float lam = lamp[0], lam_init = lamp[1];
    const float i0 = 1.f / fmaxf(l0, 1e-30f), i1 = lam / fmaxf(l1, 1e-30f);
    float ss = 0.f;
#pragma unroll
    for (int db = 0; db < 2; ++db)
#pragma unroll
        for (int i = 0; i < 16; ++i) { const float at = O[0][db][i] * i0 - O[1][db][i] * i1; O[0][db][i] = at; ss += at * at; }
    ss += xshfl<32>(ss);
    const float r = (1.f - lam_init) / sqrtf(ss * (1.f / 64.f) + 1e-5f);
    GAS bf16* op = ys + (rowb + q) * 1024 + 512 + h * 64;
#pragma unroll
    for (int db = 0; db < 2; ++db)
#pragma unroll
        for (int gq = 0; gq < 4; ++gq) { const int d0 = 32 * db + 8 * gq + 4 * hh; const f32x4 sg = *(const GAS f32x4*)(subg + d0);
            u32x2 w; w.x = cvtpk(O[0][db][4 * gq + 0] * r * sg[0], O[0][db][4 * gq + 1] * r * sg[1]); w.y = cvtpk(O[0][db][4 * gq + 2] * r * sg[2], O[0][db][4 * gq + 3] * r * sg[3]);
            *(GAS u32x2*)(op + d0) = w; }
}

struct SchedCmp { const char* proj; const char* wc; int G, c;
    DI bool next(int i, Unit& u) const { const int L = i * G + c; if (L >= 16) return false; const int kv = L >> 3, rt = L & 7;
        u.pm = rt; u.pn = 0; u.aux = kv; u.pad = 0; u.a = proj + ((size_t)rt * 256 * 16 * PLD + (kv ? C_VC : C_KC)) * 2; u.b = wc + (size_t)kv * 256 * 1024 * 2; return true; } };
struct EpiCmp { static constexpr bool CARRY = false; float* ab;
    DI void operator()(const f32x4 (&acc)[2][2][4][2], const Unit& u, int wr, int wc, int fr, int fq) const {
        const int row0 = u.pm * 256 + wr * 64 + fr; const int col = wc * 32 + 8 * fq;
#pragma unroll
        for (int ai = 0; ai < 2; ++ai)
#pragma unroll
            for (int m = 0; m < 4; ++m) { float* rp = ab + ((size_t)u.aux * 2048 + row0 + ai * 128 + m * 16) * 128 + col; *(f32x4*)rp = acc[ai][0][m][0]; *(f32x4*)(rp + 4) = acc[ai][0][m][1]; }
    }
};
DI void cmp_finish(const KA& a, int l, const float* ab, bf16* kcb, int task, int lane) {
    const int kv = task / (BATCH * NCMP), r = task % (BATCH * NCMP), b = r / NCMP, c = r % NCMP;
    const float* w2 = a.in[kv ? 23 : 20] + (size_t)l * 4096; const float* pt = ab + 2 * 2048 * 128;
    const size_t g = (size_t)kv * 2048 + b * 512 + c;
    float ptv = 0.f;
#pragma unroll
    for (int part = 0; part < 32; ++part) ptv += pt[(kv * 32 + part) * 64 + lane];
    const float h1 = ab[g * 128 + lane] + ab[(g + 1) * 128 + 64 + lane] + ptv;
    const float gl = gelu_tanh(h1); float o = 0.f;
#pragma unroll
    for (int j = 0; j < 64; ++j) o += rl(gl, j) * w2[j * 64 + lane];
    kcb[((size_t)(kv * BATCH + b) * 512 + c) * 64 + lane] = (bf16)f2bf(o);
    if (c == NCMP - 1) kcb[((size_t)(kv * BATCH + b) * 512 + NCMP) * 64 + lane] = 0;
}

DI void cmp_block(const KA& a, int l, const GAS bf16* proj, const GAS bf16* wcT, float* ab, bf16* kcb, int bid, int wave, int lane) {
    const int kv = bid >> 7, g0 = (bid & 127) * 16, r = lane & 15, q = lane >> 4, sh = wave >> 2;
    const int grow = g0 + r + sh; const bool st_ok = !(sh != 0 && (grow & 511) == 0);
    const int gld = grow > 2047 ? 2047 : grow;
    const GAS bf16* apn = proj + (size_t)gld * 16 * PLD + (kv ? C_VC : C_KC) + 8 * q;
    const GAS bf16* bpn = wcT + ((size_t)kv * 256 + wave * 16 + r) * 1024 + 8 * q;
    f32x4 acc = {0.f, 0.f, 0.f, 0.f};
#pragma unroll 16
    for (int s = 0; s < 32; ++s) {
        const bf16x8 av = *(const GAS bf16x8*)(apn + (size_t)(s >> 1) * PLD + 32 * (s & 1));
        const bf16x8 bv = *(const GAS bf16x8*)(bpn + 32 * s);
        acc = __builtin_amdgcn_mfma_f32_16x16x32_bf16(bv, av, acc, 0, 0, 0);
    }
    if (st_ok) *(GAS f32x4*)((GAS float*)ab + ((size_t)kv * 2048 + grow) * 128 + wave * 16 + 4 * q) = acc;
    VM_WAIT(); __syncthreads();
    {   const float* w2 = a.in[kv ? 23 : 20] + (size_t)l * 4096; const float* pt = ab + 2 * 2048 * 128;
        const int ga = g0 + 2 * wave; const size_t gA = (size_t)kv * 2048 + ga;
        float ptp[32], w2v[64], hA[3], hB[3];
#pragma unroll
        for (int part = 0; part < 32; ++part) ptp[part] = pt[(kv * 32 + part) * 64 + lane];
#pragma unroll
        for (int i = 0; i < 2; ++i) { hA[i] = ab[(gA + i) * 128 + lane]; hB[i] = ab[(gA + i + 1) * 128 + 64 + lane]; }
#pragma unroll
        for (int j = 0; j < 64; ++j) w2v[j] = w2[j * 64 + lane];
        float ptv = 0.f;
#pragma unroll
        for (int part = 0; part < 32; ++part) ptv += ptp[part];
#pragma unroll
        for (int i = 0; i < 2; ++i) { const int g = ga + i, c = g & 511, b = g >> 9;
            if (c < NCMP) {
                const float gl = gelu_tanh(hA[i] + hB[i] + ptv); float o = 0.f;
#pragma unroll
                for (int j = 0; j < 64; ++j) o += rl(gl, j) * w2v[j];
                kcb[((size_t)(kv * BATCH + b) * 512 + c) * 64 + lane] = (bf16)f2bf(o);
                if (c == NCMP - 1) kcb[((size_t)(kv * BATCH + b) * 512 + NCMP) * 64 + lane] = 0; } }
    }
}

DI void st_load(const GAS unsigned char* kb, const GAS unsigned char* vb, unsigned off, u32x4& kr, u32x4& vr) { kr = *(const GAS u32x4*)(kb + off); vr = *(const GAS u32x4*)(vb + off); }
DI void st_write(LAS unsigned char* buf, int skey, int sch, const u32x4& kr, const u32x4& vr) { *(LAS u32x4*)(buf + skey * DK_STR + sch * 16) = kr; *(LAS u32x4*)(buf + 64 * DK_STR + skey * DV_STR + sch * 16) = vr; }
DI void qk64(const LAS unsigned char* cur, int kboff, const bf16x8 (&qf)[4], const f32x16& cinit, f32x16 (&S)[2]) {
#pragma unroll
    for (int t = 0; t < 2; ++t) { S[t] = cinit;
#pragma unroll
        for (int s = 0; s < 4; ++s) { const bf16x8 kf = *(const LAS bf16x8*)(cur + kboff + t * 32 * DK_STR + s * 32); S[t] = MFMA32(kf, qf[s], S[t]); } }
}
DI void qk32z(const LAS unsigned char* kt32, const bf16x8 (&qf)[4], f32x16& S) {
#pragma unroll
    for (int s = 0; s < 4; ++s) { const bf16x8 kf = *(const LAS bf16x8*)(kt32 + s * 32);
        if (s == 0) { f32x16 z;
#pragma unroll
            for (int i = 0; i < 16; ++i) z[i] = 0.f;
            S = MFMA32(kf, qf[s], z); } else S = MFMA32(kf, qf[s], S); }
}
DI void pv32(const LAS unsigned char* vt32, const bf16x8 (&pk)[2], f32x16 (&O)[2]) {
#pragma unroll
    for (int s2 = 0; s2 < 2; ++s2)
#pragma unroll
        for (int db = 0; db < 2; ++db) {
            const s16x4 lo = vtr(vt32 + (16 * s2) * DV_STR + db * 64), hi = vtr(vt32 + (16 * s2 + 8) * DV_STR + db * 64);
            const bf16x8 vf = __builtin_shufflevector(lo, hi, 0, 1, 2, 3, 4, 5, 6, 7);
            O[db] = MFMA32(vf, pk[s2], O[db]); }
}
DI void mask_bias_cmp32(f32x16& S, int tcol_in, int cbase, int hh, const LAS float* b2h, float msub) {
    int tcol = tcol_in; asm volatile("" : "+v"(tcol));
#pragma unroll
    for (int g = 0; g < 2; ++g) {
        float bv[8];
#pragma unroll
        for (int j = 0; j < 8; ++j) { const int i = 8 * g + j; const int c = cbase + crow(i, hh); const int dist = tcol - 31 - 16 * c; const int di = dist < 0 ? 0 : (dist < 128 ? dist : 128); bv[j] = b2h[di * 12]; }
#pragma unroll
        for (int j = 0; j < 8; ++j) { const int i = 8 * g + j; const int c = cbase + crow(i, hh); const int dist = tcol - 31 - 16 * c; const bool ok = dist >= 0 && c < NCMP;
            const float sb = S[i] + (bv[j] - msub); S[i] = ok ? sb : -1e30f; }
        __builtin_amdgcn_sched_barrier(0); }
}
DI void pv64(const LAS unsigned char* cur, int vboff, const bf16x8 (&pk)[2][2], f32x16 (&O)[2]) {
#pragma unroll
    for (int t = 0; t < 2; ++t)
#pragma unroll
        for (int s2 = 0; s2 < 2; ++s2)
#pragma unroll
            for (int db = 0; db < 2; ++db) {
                const s16x4 lo = vtr(cur + vboff + (32 * t + 16 * s2) * DV_STR + db * 64), hi = vtr(cur + vboff + (32 * t + 16 * s2 + 8) * DV_STR + db * 64);
                const bf16x8 vf = __builtin_shufflevector(lo, hi, 0, 1, 2, 3, 4, 5, 6, 7);
                O[db] = MFMA32(vf, pk[t][s2], O[db]); }
}
DI void softmax_step(f32x16 (&S)[2], f32x16 (&O)[2], f32x16& negm, float& lsum, bf16x8 (&pk)[2][2]) {
    float tm = fmaxf(max16(S[0]), max16(S[1]));
    if (__builtin_amdgcn_ballot_w64(tm > 8.f) != 0ull) {
        tm = fmaxf(tm, xshfl<32>(tm)); const float sh = fmaxf(tm, 0.f); const float al = __builtin_amdgcn_exp2f(-sh);
        lsum *= al;
#pragma unroll
        for (int i = 0; i < 16; ++i) { O[0][i] *= al; O[1][i] *= al; negm[i] -= sh; S[0][i] -= sh; S[1][i] -= sh; } }
#pragma unroll
    for (int t = 0; t < 2; ++t) {
#pragma unroll
        for (int i = 0; i < 16; ++i) { const float p = __builtin_amdgcn_exp2f(S[t][i]); S[t][i] = p; lsum += p; }
        pk[t][0] = pack_half(S[t], 0); pk[t][1] = pack_half(S[t], 1); }
}
DI void mask_bias(f32x16 (&S)[2], int tcol_in, int kbase, int hh, int W, bool colsel, const LAS float* b2h) {
    int tcol = tcol_in; asm volatile("" : "+v"(tcol));
#pragma unroll
    for (int t = 0; t < 2; ++t)
#pragma unroll
        for (int g = 0; g < 2; ++g) {
            float bv[8];
#pragma unroll
            for (int j = 0; j < 8; ++j) { const int i = 8 * g + j; const int dist = tcol - (kbase + 32 * t + crow(i, hh)); const int di = dist < 0 ? 0 : (dist < 128 ? dist : 128); bv[j] = b2h[di * 12]; }
#pragma unroll
            for (int j = 0; j < 8; ++j) { const int i = 8 * g + j; const int dist = tcol - (kbase + 32 * t + crow(i, hh)); const bool ok = colsel && dist >= 0 && dist < W;
                const float sb = S[t][i] + bv[j]; S[t][i] = ok ? sb : -1e30f; }
            __builtin_amdgcn_sched_barrier(0); }
}
DI void sel_tile(const LAS unsigned char* cur, int kboff, int vboff, const bf16x8 (&qf)[4], f32x16 (&Os)[2], f32x16& negm, float& lsel, bool near, bool bit, int t, int kbase, int hh, int W, const LAS float* b2h) {
    f32x16 S[2]; qk64(cur, kboff, qf, negm, S);
    if (near) mask_bias(S, t, kbase, hh, W, bit, b2h);
    float ts = 0.f;
#pragma unroll
    for (int tt = 0; tt < 2; ++tt)
#pragma unroll
        for (int i = 0; i < 16; ++i) { const float p = __builtin_amdgcn_exp2f(S[tt][i]); S[tt][i] = p; ts += p; }
    ts = bit ? ts : 0.f;
    if (__builtin_amdgcn_ballot_w64(!(ts < 1.0e30f)) != 0ull) {
        qk64(cur, kboff, qf, negm, S);
        if (near) mask_bias(S, t, kbase, hh, W, bit, b2h);
        float tm = fmaxf(max16(S[0]), max16(S[1])); tm = bit ? tm : -1e30f; tm = fmaxf(tm, xshfl<32>(tm));
        const float sh = fmaxf(tm, 0.f); const float al = __builtin_amdgcn_exp2f(-sh);
        lsel *= al; ts = 0.f;
#pragma unroll
        for (int i = 0; i < 16; ++i) { Os[0][i] *= al; Os[1][i] *= al; negm[i] -= sh; }
#pragma unroll
        for (int tt = 0; tt < 2; ++tt)
#pragma unroll
            for (int i = 0; i < 16; ++i) { const float p = __builtin_amdgcn_exp2f(S[tt][i] - sh); S[tt][i] = p; ts += p; }
        ts = bit ? ts : 0.f;
    }
    lsel += ts;
    const unsigned km = bit ? 0xFFFFFFFFu : 0u; bf16x8 pk[2][2];
#pragma unroll
    for (int tt = 0; tt < 2; ++tt)
#pragma unroll
        for (int hf = 0; hf < 2; ++hf) { u32x4 w = __builtin_bit_cast(u32x4, pack_half(S[tt], hf)); w.x &= km; w.y &= km; w.z &= km; w.w &= km; pk[tt][hf] = __builtin_bit_cast(bf16x8, w); }
    pv64(cur, vboff, pk, Os);
}
DI void nsa_unit(const GAS bf16* proj, GAS bf16* ys, const GAS bf16* kcb, LAS unsigned char* lds, const LAS float* bias2, int b, int u, int tid_in, int lane_in, int wave_in) {
    (void)tid_in; (void)lane_in; int wave = wave_in; asm volatile("" : "+s"(wave)); const int lane = my_lane(); const int tid = wave * 64 + lane;
    const int t0 = u * 64; const int col = lane & 31, hh = lane >> 5, tl = col >> 2, head = col & 3;
    const int t = t0 + wave * 8 + tl; const int tw0 = t0 + wave * 8;
    const size_t rowb = (size_t)b * SEQ;
    const LAS float* b2h = bias2 + 8 + head;
    bf16x8 qf[4];
    { const float SC = 0.125f * 1.4426950408889634f; const GAS bf16* qp = proj + (rowb + t) * PLD + C_DQ + head * 64 + hh * 8;
#pragma unroll
      for (int s = 0; s < 4; ++s) { const u32x4 w = *(const GAS u32x4*)(qp + s * 16); u32x4 o;
          o.x = cvtpk(lo_bf(w.x) * SC, hi_bf(w.x) * SC); o.y = cvtpk(lo_bf(w.y) * SC, hi_bf(w.y) * SC); o.z = cvtpk(lo_bf(w.z) * SC, hi_bf(w.z) * SC); o.w = cvtpk(lo_bf(w.w) * SC, hi_bf(w.w) * SC);
          qf[s] = __builtin_bit_cast(bf16x8, o); } }
    const int skey = tid >> 3, sch = tid & 7;
    const int i16 = lane & 15, blk = (lane >> 4) & 1;
    const int kboff = col * DK_STR + hh * 16;
    const int vboff = 64 * DK_STR + (4 * hh + (i16 >> 2)) * DV_STR + (16 * blk + 4 * (i16 & 3)) * 2;
    u32x4 kr, vr;
    const int ncvm = (4 * u + 3) < NCMP ? (4 * u + 3) : NCMP;
    const int nsc = (ncvm + 63) >> 6;
    const GAS unsigned char* kcp = (const GAS unsigned char*)(kcb + (size_t)(0 * BATCH + b) * 512 * 64);
    const GAS unsigned char* vcp = (const GAS unsigned char*)(kcb + (size_t)(1 * BATCH + b) * 512 * 64);
    const unsigned soffc = (unsigned)(skey * 64 + sch * 8) * 2u;
    float m1 = -120.f, l1 = 0.f;
    st_load(kcp, vcp, soffc, kr, vr); st_write(lds, skey, sch, kr, vr); __syncthreads();
#pragma unroll 1
    for (int kt = 0; kt < nsc; ++kt) {
        const LAS unsigned char* cur = lds + (kt & 1) * DBUF_BYTES; LAS unsigned char* nxt = lds + ((kt + 1) & 1) * DBUF_BYTES;
        if (kt + 1 < nsc) st_load(kcp, vcp, soffc + (unsigned)(kt + 1) * 8192u, kr, vr);
#pragma unroll
        for (int tt = 0; tt < 2; ++tt) { f32x16 S; qk32z(cur + kboff + tt * 32 * DK_STR, qf, S); mask_bias_cmp32(S, t, kt * 64 + tt * 32, hh, b2h, 0.f);
          const float tm = max16(S); const float mn = fmaxf(m1, tm); float acc = 0.f;
#pragma unroll
          for (int i = 0; i < 16; ++i) acc += __builtin_amdgcn_exp2f(S[i] - mn);
          l1 = l1 * __builtin_amdgcn_exp2f(m1 - mn) + acc; m1 = mn; }
        if (kt + 1 < nsc) st_write(nxt, skey, sch, kr, vr);
        __syncthreads();
    }
    float mf, inv;
    { const float mo = xshfl<32>(m1), lo = xshfl<32>(l1); mf = fmaxf(m1, mo); const float lf = l1 * __builtin_amdgcn_exp2f(m1 - mf) + lo * __builtin_amdgcn_exp2f(mo - mf); inv = lf > 0.f ? 1.f / lf : 0.f; }
    f32x16 Oc[2], imp[4];
#pragma unroll
    for (int i = 0; i < 16; ++i) { Oc[0][i] = 0.f; Oc[1][i] = 0.f; imp[0][i] = 0.f; imp[1][i] = 0.f; imp[2][i] = 0.f; imp[3][i] = 0.f; }
    {   st_load(kcp, vcp, soffc, kr, vr); st_write(lds, skey, sch, kr, vr); __syncthreads();
#pragma unroll 1
        for (int kt = 0; kt < nsc; ++kt) {
            const LAS unsigned char* cur = lds + (kt & 1) * DBUF_BYTES; LAS unsigned char* nxt = lds + ((kt + 1) & 1) * DBUF_BYTES;
            if (kt + 1 < nsc) st_load(kcp, vcp, soffc + (unsigned)(kt + 1) * 8192u, kr, vr);
#pragma unroll
            for (int tt = 0; tt < 2; ++tt) {
                f32x16 S; qk32z(cur + kboff + tt * 32 * DK_STR, qf, S); mask_bias_cmp32(S, t, kt * 64 + tt * 32, hh, b2h, mf);
#pragma unroll
                for (int i = 0; i < 16; ++i) S[i] = __builtin_amdgcn_exp2f(S[i]) * inv;
                bf16x8 pk[2]; pk[0] = pack_half(S, 0); pk[1] = pack_half(S, 1);
                pv32(cur + vboff + tt * 32 * DV_STR, pk, Oc);
                const int Tq = (2 * kt + tt) & 3, MB = (2 * kt + tt) >> 2;
#pragma unroll
                for (int s2 = 0; s2 < 2; ++s2) { u32x4 aw; unsigned e[8];
#pragma unroll
                    for (int jj = 0; jj < 8; ++jj) { const int kk = 16 * s2 + 8 * (jj >> 2) + 4 * hh + (jj & 3); const int delta = 32 * Tq + kk - 4 * col;
                        e[jj] = (delta == -1 || delta == 3) ? 0x3F80u : ((unsigned)delta <= 2u ? 0x4000u : 0u); }
                    aw.x = e[0] | (e[1] << 16); aw.y = e[2] | (e[3] << 16); aw.z = e[4] | (e[5] << 16); aw.w = e[6] | (e[7] << 16);
                    const bf16x8 af = __builtin_bit_cast(bf16x8, aw);
                    if (MB == 0) imp[0] = MFMA32(af, pk[s2], imp[0]); else if (MB == 1) imp[1] = MFMA32(af, pk[s2], imp[1]); else if (MB == 2) imp[2] = MFMA32(af, pk[s2], imp[2]); else imp[3] = MFMA32(af, pk[s2], imp[3]); }
                if (Tq == 3 && MB < 3) { u32x4 aw; aw.x = 0u; aw.y = 0u; aw.z = 0u; aw.w = (lane == 32) ? 0x3F800000u : 0u;
                    const bf16x8 af = __builtin_bit_cast(bf16x8, aw);
                    if (MB == 0) imp[1] = MFMA32(af, pk[1], imp[1]); else if (MB == 1) imp[2] = MFMA32(af, pk[1], imp[2]); else imp[3] = MFMA32(af, pk[1], imp[3]); }
            }
            if (kt + 1 < nsc) st_write(nxt, skey, sch, kr, vr);
            __syncthreads();
        }
    }
    unsigned ocp[2][8];
#pragma unroll
    for (int db = 0; db < 2; ++db)
#pragma unroll
        for (int i = 0; i < 8; ++i) ocp[db][i] = cvtpk(Oc[db][2 * i], Oc[db][2 * i + 1]);
    unsigned sm0 = 0u, sm1 = 0u, sm2 = 0u, sm3 = 0u;
    {   const int cur_t = t >> 6; unsigned key[16];
#pragma unroll
        for (int i = 0; i < 16; ++i) {
            float v0 = imp[0][i], v1 = imp[1][i], v2 = imp[2][i], v3 = imp[3][i];
            v0 += xshfl<1>(v0); v0 += xshfl<2>(v0); v1 += xshfl<1>(v1); v1 += xshfl<2>(v1); v2 += xshfl<1>(v2); v2 += xshfl<2>(v2); v3 += xshfl<1>(v3); v3 += xshfl<2>(v3);
            const float val = head == 0 ? v0 : (head == 1 ? v1 : (head == 2 ? v2 : v3));
            const int j = 32 * head + crow(i, hh);
            const bool forced = (j == 0) || (j == cur_t) || (j == cur_t - 1);
            unsigned fx = (unsigned)(fminf(fmaxf(val, 0.f), 31.f) * 1048576.f) + 1u;
            fx = forced ? 0x1FFFFFFu : (j <= cur_t ? fx : 0u);
            key[i] = (fx << 7) | (unsigned)(127 - j); }
#pragma unroll 1
        for (int r = 0; r < 16; ++r) {
            unsigned w = key[0];
#pragma unroll
            for (int i = 1; i < 16; ++i) w = w > key[i] ? w : key[i];
            { unsigned o = (unsigned)xshfl_i<1>((int)w); w = w > o ? w : o; o = (unsigned)xshfl_i<2>((int)w); w = w > o ? w : o; o = (unsigned)xshfl_i<32>((int)w); w = w > o ? w : o; }
            if ((w >> 7) != 0u) { const int j = 127 - (int)(w & 127u); const unsigned bit = 1u << (j & 31); const int jb = j >> 5;
                sm0 |= (jb == 0) ? bit : 0u; sm1 |= (jb == 1) ? bit : 0u; sm2 |= (jb == 2) ? bit : 0u; sm3 |= (jb == 3) ? bit : 0u; }
#pragma unroll
            for (int i = 0; i < 16; ++i) key[i] = (key[i] == w) ? 0u : key[i];
        }
    }
    f32x16 Ow[2]; float lw = 0.f;
#pragma unroll
    for (int i = 0; i < 16; ++i) { Ow[0][i] = 0.f; Ow[1][i] = 0.f; }
    {   f32x16 negm;
#pragma unroll
        for (int i = 0; i < 16; ++i) negm[i] = 120.f;
        const GAS unsigned char* kwp = (const GAS unsigned char*)(proj + rowb * PLD + C_KW); const GAS unsigned char* vwp = (const GAS unsigned char*)(proj + rowb * PLD + C_VW);
        const unsigned soffp = (unsigned)(skey * PLD + sch * 8) * 2u;
        const int s0 = (u < 8) ? 8 - u : 0;
        st_load(kwp, vwp, soffp + (unsigned)(u - 8 + s0) * (64u * PLD * 2u), kr, vr); st_write(lds, skey, sch, kr, vr); __syncthreads();
#pragma unroll 1
        for (int s = s0; s < 9; ++s) {
            const int par = (s - s0) & 1; const LAS unsigned char* cur = lds + par * DBUF_BYTES; LAS unsigned char* nxt = lds + (par ^ 1) * DBUF_BYTES;
            if (s + 1 < 9) st_load(kwp, vwp, soffp + (unsigned)(u - 8 + s + 1) * (64u * PLD * 2u), kr, vr);
            sel_tile(cur, kboff, vboff, qf, Ow, negm, lw, s == 0 || s >= 6, true, t, (u - 8 + s) * 64, hh, 512, b2h);
            if (s + 1 < 9) st_write(nxt, skey, sch, kr, vr);
            __syncthreads();
        }
    }
    unsigned owp[2][8];
#pragma unroll
    for (int db = 0; db < 2; ++db)
#pragma unroll
        for (int i = 0; i < 8; ++i) owp[db][i] = cvtpk(Ow[db][2 * i], Ow[db][2 * i + 1]);
    f32x16 Os[2]; float lsel = 0.f;
#pragma unroll
    for (int i = 0; i < 16; ++i) { Os[0][i] = 0.f; Os[1][i] = 0.f; }
    {   f32x16 negm;
#pragma unroll
        for (int i = 0; i < 16; ++i) negm[i] = 120.f;
        const GAS unsigned char* ksp = (const GAS unsigned char*)(proj + rowb * PLD + C_KS); const GAS unsigned char* vsp = (const GAS unsigned char*)(proj + rowb * PLD + C_VS);
        const unsigned soffp = (unsigned)(skey * PLD + sch * 8) * 2u;
        u32x4 kA, vA, kB, vB;
        st_load(ksp, vsp, soffp, kr, vr); st_write(lds, skey, sch, kr, vr);
        if (u >= 1) st_load(ksp, vsp, soffp + 64u * PLD * 2u, kA, vA);
        __syncthreads();
#define SEL_STEP(J, KX, VX, KY, VY) { const int j_ = (J); \
            const LAS unsigned char* cur = lds + (j_ & 1) * DBUF_BYTES; LAS unsigned char* nxt = lds + ((j_ + 1) & 1) * DBUF_BYTES; \
            if (j_ + 2 <= u) st_load(ksp, vsp, soffp + (unsigned)(j_ + 2) * (64u * PLD * 2u), KY, VY); \
            const int jb = j_ >> 5; const unsigned smw = jb == 0 ? sm0 : (jb == 1 ? sm1 : (jb == 2 ? sm2 : sm3)); \
            const bool bit = ((smw >> (j_ & 31)) & 1u) != 0u; \
            if (__builtin_amdgcn_ballot_w64(bit) != 0ull) sel_tile(cur, kboff, vboff, qf, Os, negm, lsel, 64 * j_ + 63 > tw0 - 113, bit, t, 64 * j_, hh, 1 << 30, b2h); \
            if (j_ + 1 <= u) st_write(nxt, skey, sch, KX, VX); \
            __syncthreads(); }
#pragma unroll 1
        for (int j = 0; j <= u; j += 2) {
            SEL_STEP(j, kA, vA, kB, vB)
            if (j + 1 <= u) SEL_STEP(j + 1, kB, vB, kA, vA)
        }
#undef SEL_STEP
    }
    {   const float lwt = lw + xshfl<32>(lw), lst = lsel + xshfl<32>(lsel);
        const GAS bf16* gp = proj + (rowb + t) * PLD + C_DG + head * 3;
        const float g0 = sigmoidf_(bf2f(gp[0])), g1 = sigmoidf_(bf2f(gp[1])) / fmaxf(lst, 1e-30f), g2 = sigmoidf_(bf2f(gp[2])) / fmaxf(lwt, 1e-30f);
        GAS bf16* op = ys + (rowb + t) * 1024 + 768 + head * 64;
#pragma unroll
        for (int db = 0; db < 2; ++db)
#pragma unroll
            for (int gq = 0; gq < 4; ++gq) { const int d0 = 32 * db + 8 * gq + 4 * hh; float y[4];
#pragma unroll
                for (int e = 0; e < 4; ++e) { const unsigned cw = ocp[db][2 * gq + (e >> 1)], ww = owp[db][2 * gq + (e >> 1)];
                    y[e] = g0 * ((e & 1) ? hi_bf(cw) : lo_bf(cw)) + g1 * Os[db][4 * gq + e] + g2 * ((e & 1) ? hi_bf(ww) : lo_bf(ww)); }
                u32x2 w; w.x = cvtpk(y[0], y[1]); w.y = cvtpk(y[2], y[3]); *(GAS u32x2*)(op + d0) = w; }
    }
}


DI void swa_unit(const GAS bf16* proj, GAS bf16* ys, LAS unsigned char* lds, const LAS float* bias2, const LAS float* biasd, const GAS float* sinks, int b, int u, int tid_in, int lane_in, int wave_in) {
    int tid = tid_in, lane = lane_in, wave = wave_in; asm volatile("" : "+v"(tid), "+v"(lane), "+s"(wave));
    const int t0 = u * 64; const int col = lane & 31, hh = lane >> 5, tl = col >> 1, kv = wave & 1, head = 2 * kv + (col & 1);
    const int t = t0 + (wave >> 1) * 16 + tl;
    const size_t rowb = (size_t)b * SEQ;
    const LAS float* b2h = bias2 + head;
    bf16x8 qf[4];
    { const float SC = 0.125f * 1.4426950408889634f; const GAS bf16* qp = proj + (rowb + t) * PLD + C_BQ + head * 64 + hh * 8;
#pragma unroll
      for (int s = 0; s < 4; ++s) { const u32x4 w = *(const GAS u32x4*)(qp + s * 16); u32x4 o;
          o.x = cvtpk(lo_bf(w.x) * SC, hi_bf(w.x) * SC); o.y = cvtpk(lo_bf(w.y) * SC, hi_bf(w.y) * SC); o.z = cvtpk(lo_bf(w.z) * SC, hi_bf(w.z) * SC); o.w = cvtpk(lo_bf(w.w) * SC, hi_bf(w.w) * SC);
          qf[s] = __builtin_bit_cast(bf16x8, o); } }
    const int skey = tid >> 3, sch = tid & 7;
    const int i16 = lane & 15, blk = (lane >> 4) & 1;
    const int kboff = kv * DBUF_BYTES + col * DK_STR + hh * 16;
    const int vboff = kv * DBUF_BYTES + 64 * DK_STR + (4 * hh + (i16 >> 2)) * DV_STR + (16 * blk + 4 * (i16 & 3)) * 2;
    const GAS unsigned char* kp = (const GAS unsigned char*)(proj + rowb * PLD + C_BK); const GAS unsigned char* vp = (const GAS unsigned char*)(proj + rowb * PLD + C_BV);
    const unsigned soffp = (unsigned)(skey * PLD + sch * 8) * 2u;
    u32x4 k0, v0, k1, v1;
    f32x16 O[2], negm; float lsum = 0.f;
#pragma unroll
    for (int i = 0; i < 16; ++i) { O[0][i] = 0.f; O[1][i] = 0.f; negm[i] = 120.f; }
    const int s0 = (u < 2) ? 2 - u : 0;
    { const unsigned so = soffp + (unsigned)(u - 2 + s0) * (64u * PLD * 2u); st_load(kp, vp, so, k0, v0); st_load(kp + 128, vp + 128, so, k1, v1);
      st_write(lds, skey, sch, k0, v0); st_write(lds + DBUF_BYTES, skey, sch, k1, v1); }
    __syncthreads();
#pragma unroll 1
    for (int s = s0; s < 3; ++s) {
        const int par = (s - s0) & 1; const LAS unsigned char* cur = lds + par * 2 * DBUF_BYTES; LAS unsigned char* nxt = lds + (par ^ 1) * 2 * DBUF_BYTES;
        if (s + 1 < 3) { const unsigned so = soffp + (unsigned)(u - 2 + s + 1) * (64u * PLD * 2u); st_load(kp, vp, so, k0, v0); st_load(kp + 128, vp + 128, so, k1, v1); }
        sel_tile(cur, kboff, vboff, qf, O, negm, lsum, true, true, t, (u - 2 + s) * 64, hh, 128, b2h);
        if (s + 1 < 3) { st_write(nxt, skey, sch, k0, v0); st_write(nxt + DBUF_BYTES, skey, sch, k1, v1); }
        __syncthreads();
    }
    {   const float sinkp = (sinks[head] - biasd[128 * 12 + head]) * 1.4426950408889634f;
        const float lt = lsum + xshfl<32>(lsum) + __builtin_amdgcn_exp2f(sinkp + negm[0]);
        const float inv = 1.f / fmaxf(lt, 1e-30f);
        GAS bf16* op = ys + (rowb + t) * 1024 + 256 + head * 64;
#pragma unroll
        for (int db = 0; db < 2; ++db)
#pragma unroll
            for (int gq = 0; gq < 4; ++gq) { const int d0 = 32 * db + 8 * gq + 4 * hh;
                u32x2 w; w.x = cvtpk(O[db][4 * gq + 0] * inv, O[db][4 * gq + 1] * inv); w.y = cvtpk(O[db][4 * gq + 2] * inv, O[db][4 * gq + 3] * inv); *(GAS u32x2*)(op + d0) = w; }
    }
}

DI void route_rows_load(const KA& a, int tok0, int lane, u32x4 (&raw)[4][2]) {
    const GAS bf16* xrow = (const GAS bf16*)(a.ws + WS_XB) + (size_t)tok0 * 1024;
#pragma unroll
    for (int rr = 0; rr < 4; ++rr)
#pragma unroll
        for (int j = 0; j < 2; ++j) raw[rr][j] = *(const GAS u32x4*)(xrow + (size_t)rr * 1024 + 8 * (lane + 64 * j));
}
DI void route_rows4(const u32x4 (&raw)[4][2], const f32x4 (&gvv)[2][2], bf16* xr_, int tok0, int lane) {
    GAS bf16* xr = (GAS bf16*)xr_;
    f32x4 v[4][2][2]; float ss[4];
#pragma unroll
    for (int rr = 0; rr < 4; ++rr)
#pragma unroll
        for (int j = 0; j < 2; ++j) { const u32x4 w = raw[rr][j];
            v[rr][j][0][0] = lo_bf(w.x); v[rr][j][0][1] = hi_bf(w.x); v[rr][j][0][2] = lo_bf(w.y); v[rr][j][0][3] = hi_bf(w.y); v[rr][j][1][0] = lo_bf(w.z); v[rr][j][1][1] = hi_bf(w.z); v[rr][j][1][2] = lo_bf(w.w); v[rr][j][1][3] = hi_bf(w.w); }
#pragma unroll
    for (int rr = 0; rr < 4; ++rr) { float t = 0.f;
#pragma unroll
        for (int j = 0; j < 2; ++j)
#pragma unroll
            for (int h = 0; h < 2; ++h) t += (v[rr][j][h][0] * v[rr][j][h][0] + v[rr][j][h][1] * v[rr][j][h][1]) + (v[rr][j][h][2] * v[rr][j][h][2] + v[rr][j][h][3] * v[rr][j][h][3]);
        ss[rr] = t; }
#pragma unroll
    for (int rr = 0; rr < 4; ++rr) { ss[rr] = wave_sum(ss[rr]); ss[rr] = __builtin_amdgcn_rsqf(ss[rr] * (1.f / 1024.f) + 1e-6f); }
#pragma unroll
    for (int j = 0; j < 2; ++j) { const int k0 = 8 * (lane + 64 * j);
#pragma unroll
        for (int rr = 0; rr < 4; ++rr) { u32x4 wh, wl;
#pragma unroll
            for (int h = 0; h < 2; ++h) { const f32x4 xn = v[rr][j][h] * ss[rr] * gvv[j][h];
                const unsigned h0 = pk2(xn[0], xn[1]), h1 = pk2(xn[2], xn[3]);
                const unsigned l0 = pk2(xn[0] - __builtin_bit_cast(float, h0 << 16), xn[1] - __builtin_bit_cast(float, h0 & 0xFFFF0000u));
                const unsigned l1 = pk2(xn[2] - __builtin_bit_cast(float, h1 << 16), xn[3] - __builtin_bit_cast(float, h1 & 0xFFFF0000u));
                if (h == 0) { wh.x = h0; wh.y = h1; wl.x = l0; wl.y = l1; } else { wh.z = h0; wh.w = h1; wl.z = l0; wl.w = l1; } }
            *(GAS u32x4*)(xr + (size_t)(tok0 + rr) * 2048 + k0) = wh; *(GAS u32x4*)(xr + (size_t)(tok0 + rr) * 2048 + 1024 + k0) = wl; } }
}
struct SchedRoute { const char* A; const char* B; int pm;
    DI bool next(int i, Unit& u) const { if (i > 0) return false; u.pm = pm; u.pn = 0; u.aux = 0; u.pad = 0; u.a = A + (size_t)pm * 128 * 2048 * 2; u.b = B; return true; } };
struct EpiRoute { static constexpr bool CARRY = false; float* rlog;
    DI void operator()(const f32x4 (&acc)[2][2][4][2], const Unit& u, int wr, int wc, int fr, int fq) const {
        const int row0 = u.pm * 128 + wr * 64 + fr; const int col = wc * 32 + 8 * fq;
#pragma unroll
        for (int m = 0; m < 4; ++m) { float* rp = rlog + (size_t)(row0 + m * 16) * 128 + col; *(f32x4*)rp = acc[0][0][m][0]; *(f32x4*)(rp + 4) = acc[0][0][m][1]; }
    }
};
DI void route_decide(const KA& a, int l, const float* rl_row, int& oe0, int& oe1, float& ow0, float& ow1) {
    float lg[36];
    const float* bg = a.in[30] + l * 4; const float* be = a.in[32] + l * 32;
#pragma unroll
    for (int q = 0; q < 9; ++q) { const f32x4 h = *(const f32x4*)(rl_row + 4 * q), lo = *(const f32x4*)(rl_row + 64 + 4 * q);
        lg[4 * q + 0] = h[0] + lo[0]; lg[4 * q + 1] = h[1] + lo[1]; lg[4 * q + 2] = h[2] + lo[2]; lg[4 * q + 3] = h[3] + lo[3]; }
#pragma unroll
    for (int i = 0; i < 4; ++i) lg[i] += bg[i];
#pragma unroll
    for (int i = 0; i < 32; ++i) lg[4 + i] += be[i];
    int gsel = 0; float gm = lg[0];
#pragma unroll
    for (int i = 1; i < 4; ++i) if (lg[i] > gm) { gm = lg[i]; gsel = i; }
    float gs = 0.f;
#pragma unroll
    for (int i = 0; i < 4; ++i) gs += __expf(lg[i] - gm);
    const float gwt = 1.f / gs;
    float v8[8];
#pragma unroll
    for (int i = 0; i < 8; ++i) { float x = lg[4 + i];
#pragma unroll
        for (int gq = 1; gq < 4; ++gq) x = (gsel == gq) ? lg[4 + gq * 8 + i] : x;
        v8[i] = x; }
    int i0 = 0; float m0 = v8[0];
#pragma unroll
    for (int i = 1; i < 8; ++i) if (v8[i] > m0) { m0 = v8[i]; i0 = i; }
    int i1 = -1; float m1 = -3e38f;
#pragma unroll
    for (int i = 0; i < 8; ++i) if (i != i0 && v8[i] > m1) { m1 = v8[i]; i1 = i; }
    if (i1 < 0) i1 = (i0 == 0) ? 1 : 0;
    const float w0 = 1.f / (1.f + __expf(m1 - m0)); const float w1 = 1.f - w0;
    const int e0 = gsel * 8 + i0, e1 = gsel * 8 + i1;
    oe0 = e0; oe1 = e1; ow0 = w0 * gwt; ow1 = w1 * gwt;
}
DI void expert_weights(const KA& a, int l, LAS unsigned char* lds, int it0, int it1, int gw, int NGW, int wave, int lane) {
    LAS float* scr = (LAS float*)(lds + wave * 16384);
    const float* wgt = a.in[33] + (size_t)l * 32 * 1024 * 256; const float* wup = a.in[34] + (size_t)l * 32 * 1024 * 256; const float* wdn = a.in[35] + (size_t)l * 32 * 256 * 1024;
    bf16* Wgu = (bf16*)(a.ws + WS_WGU); bf16* Wd = (bf16*)(a.ws + WS_WD);
    constexpr int I_E = 16 * 4, I_D = 4 * 16;
    const int nq = 4 * (lane & 15), kr4 = lane >> 4;
    for (int it = it0 + gw; it < it1; it += NGW) {
        const int e = it / (2 * I_E + I_D); int r = it % (2 * I_E + I_D);
        const GAS float* src; GAS bf16* dst; int ldw, ldt;
        if (r < 2 * I_E) { const int up = r / I_E, q = r % I_E, kb = q / 4, nb = q % 4; const int n0 = nb * 64;
            const int drow = (n0 >> 7) * 256 + up * 128 + (n0 & 127);
            src = (const GAS float*)((up ? wup : wgt) + (size_t)e * 1024 * 256) + (size_t)(kb * 64) * 256 + n0; ldw = 256;
            dst = (GAS bf16*)(Wgu + (size_t)e * 512 * 1024) + (size_t)drow * 1024 + kb * 64; ldt = 1024;
        } else { r -= 2 * I_E; const int kb = r / 16, nb = r % 16;
            src = (const GAS float*)(wdn + (size_t)e * 256 * 1024) + (size_t)(kb * 64) * 1024 + nb * 64; ldw = 1024;
            dst = (GAS bf16*)(Wd + (size_t)e * 1024 * 256) + (size_t)(nb * 64) * 256 + kb * 64; ldt = 256; }
        f32x4 v[16];
#pragma unroll
        for (int i = 0; i < 16; ++i) v[i] = *(const GAS f32x4*)(src + (size_t)(4 * i + kr4) * ldw + nq);
#pragma unroll
        for (int hn = 0; hn < 2; ++hn) {
            if (((lane >> 3) & 1) == hn) {
#pragma unroll
                for (int i = 0; i < 16; ++i) { const int kk = 4 * i + kr4;
#pragma unroll
                    for (int e2 = 0; e2 < 4; ++e2) scr[kk * 33 + (nq & 31) + e2] = v[i][e2]; } }
            LDS_WAIT(); asm volatile("" ::: "memory");
            const int c = lane & 7;
#pragma unroll
            for (int j = 0; j < 4; ++j) { const int n = (lane >> 3) + 8 * j; const LAS float* sp = scr + (8 * c) * 33 + n;
                u32x4 o; o.x = pk2(sp[0 * 33], sp[1 * 33]); o.y = pk2(sp[2 * 33], sp[3 * 33]); o.z = pk2(sp[4 * 33], sp[5 * 33]); o.w = pk2(sp[6 * 33], sp[7 * 33]);
                *(GAS u32x4*)(dst + (size_t)(32 * hn + n) * ldt + 8 * c) = o; }
            LDS_WAIT(); asm volatile("" ::: "memory");
        }
    }
}
DI void build_offsets(const unsigned* cnt, LAS int* offt, int tid) {
    int c = 0;
    if (tid < 32) { c = (int)__hip_atomic_load(cnt + tid * CNT_STRIDE, __ATOMIC_RELAXED, __HIP_MEMORY_SCOPE_AGENT); offt[330 + tid] = (c + 255) & ~255; }
    __syncthreads();
    if (tid == 0) { int o = 0;
#pragma unroll
        for (int e = 0; e < 32; ++e) { offt[e] = o; o += offt[330 + e]; } offt[32] = o; }
    __syncthreads();
    if (tid < 32) offt[330 + tid] = c;
    for (int rt = tid; rt < (MOE_ROWS >> 8); rt += 512) { int e = 0; for (int j = 1; j < 32; ++j) e += (offt[j] <= rt * 256) ? 1 : 0; offt[40 + rt] = e; }
    __syncthreads();
}

template <unsigned PM>
__global__ void __launch_bounds__(512, 2) mk_fwd(Args a_) {
    extern __shared__ __attribute__((aligned(16))) unsigned char lds_raw[];
    LAS unsigned char* lds = (LAS unsigned char*)lds_raw;
    const int wave0 = __builtin_amdgcn_readfirstlane((int)threadIdx.x >> 6);
    if (threadIdx.x < 36) ((LAS unsigned long long*)(lds + PTAB_OFF))[threadIdx.x] = (unsigned long long)a_.in[threadIdx.x];
    __syncthreads();
    KA a; a.in.base = (unsigned)(size_t)(lds + PTAB_OFF); a.out = a_.out; a.ws = a_.ws;
    const int G = gridDim.x, bid = blockIdx.x, NGW = G * 8;
#define PHASE_IDS() int wave = wave0; asm volatile("" : "+s"(wave)); const int lane = my_lane(); const int tid_ = wave * 64 + lane, gw = bid * 8 + wave; (void)tid_; (void)gw; \
    const int xb = ((bid & 7) << 5) | (bid >> 3); (void)xb;        \
    KA ap = a; asm volatile("" : "+s"(ap.ws), "+s"(ap.out), "+s"(ap.in.base)); \
    bf16* hb = (bf16*)(ap.ws + WS_HB); bf16* proj = (bf16*)(ap.ws + WS_PROJ); bf16* gates = (bf16*)(ap.ws + WS_GATES); \
    bf16* ys = hb; bf16* x2b = hb; bf16* merged = proj; bf16* eo = proj; \
    bf16* kcb = (bf16*)(ap.ws + WS_KCVC); float* lrusum = (float*)(ap.ws + WS_LRUSUM); \
    int* rec_e = (int*)(ap.ws + WS_REC); int* rec_slot = rec_e + T * 2; float* rec_w = (float*)(rec_slot + T * 2); \
    int* rowtok = (int*)(ap.ws + WS_ROWTOK); float* roww = (float*)(ap.ws + WS_ROWW); \
    bf16* xs = (bf16*)(ap.ws + WS_XS); bf16* hmid = (bf16*)(ap.ws + WS_HMID); unsigned* ctl = (unsigned*)(ap.ws + WS_CTL); \
    (void)hb; (void)proj; (void)gates; (void)ys; (void)x2b; (void)merged; (void)eo; (void)kcb; (void)lrusum; (void)rec_e; (void)rec_slot; (void)rec_w; (void)rowtok; (void)roww; (void)xs; (void)hmid; (void)ctl
    volatile LAS unsigned* MISC = (volatile LAS unsigned*)(lds + MISC_OFF);
    LAS float* biasd = (LAS float*)(lds + BIAS_OFF);
    LAS int* offt = (LAS int*)(lds + OFFT_OFF);
    { PHASE_IDS();
    if (tid_ < 64) MISC[tid_] = 0u;
    for (int i = tid_; i < 129 * 12; i += 512) { const int d = i / 12, hd = i % 12; const int bk = d < 128 ? T5_BUCKET[d] : 31; const float* rb = a.in[1]; biasd[i] = rb[bk * 12 + hd]; ((LAS float*)(lds + BIAS2_OFF))[i] = (rb[bk * 12 + hd] - rb[31 * 12 + hd]) * 1.4426950408889634f; } }
    __syncthreads();
    const int lo = a_.ph_lo, hi = a_.ph_hi;
    XcdBarrier bar; bar.bar = (unsigned*)(a.ws + WS_CTL) + CW_BAR; bar.x = 0; bar.st = nullptr;
    if (hi - lo > 1) { PHASE_IDS(); bar = xcd_barrier_post(ctl + CW_BAR, MISC + 8, tid_ == 0); }
#ifndef SUB_MASK
#define SUB_MASK 0xFFu
#endif
#define SUB(k) ((SUB_MASK >> (k)) & 1u)
#define HASP(k) ((PM >> ((k) % PPL + ((k) >= 2 * PPL ? PPL : 0))) & 1u)
#define IN(k) (HASP(k) && lo <= (k) && (k) < hi)
#define SEAM(k) do { if ((k) + 1 < hi) { const int sl_ = my_lane(); int sw_ = wave0; asm volatile("" : "+s"(sw_)); xcd_barrier(bar, sw_ == 0 && sl_ == 0); } } while (0)
    for (int l = 0; l < DEPTH; ++l) {
        const int pb = l * PPL;
        if (IN(pb + 0)) { PHASE_IDS(); p1_weights_i8(ap, l, lds, bid, G, wave, lane); router_weights(ap, l, gw, NGW, lane); lru_weights(ap, l, gw, NGW, lane); cmp_weights(ap, l, lds, gw, NGW, wave, lane); phase0_weights(ap, l, lds, gw, NGW, wave, lane); phase0_rows(ap, l, 0, gw, NGW, lane); SEAM(pb + 0); }
        if (IN(pb + 1)) {
            PHASE_IDS();
            {   int K1q = 512; asm volatile("" : "+s"(K1q));
                pg8::Gemm g{K1q, 512, 512, 128, -1}; SchedP1 S{(const char*)(ap.ws + WS_HQ), (const char*)(ap.ws + WS_WQ), 128, 26, 1024, 1024, G, bid};
                EpiP1I8 E{proj, (unsigned char*)gates, ap.in[25] + (size_t)l * 4096, (const float*)(ap.ws + WS_HSC), (const float*)(ap.ws + WS_WSC)};
                pg8::gemm_phase<EpiP1I8, SchedP1, false, true>(lds, g, S, E, tid_); }
            SEAM(pb + 1);
        }
        if (IN(pb + 2)) {
            PHASE_IDS();
            LAS float* lamp = (LAS float*)(lds + MISC_OFF + 64);
            if (tid_ < 64) { const float* q1 = ap.in[13] + l * 32; const float* k1 = ap.in[14] + l * 32; const float* q2 = ap.in[15] + l * 32; const float* k2 = ap.in[16] + l * 32;
                float s1 = (lane < 32) ? q1[lane] * k1[lane] : 0.f, s2 = (lane < 32) ? q2[lane] * k2[lane] : 0.f; s1 = wave_sum(s1); s2 = wave_sum(s2);
                const float lam_init = 0.8f - 0.6f * __expf(-0.3f * (float)l); if (lane == 0) { lamp[0] = __expf(s1) - __expf(s2) + lam_init; lamp[1] = lam_init; } }
            __syncthreads();
            if (SUB(0)) { const LAS float* bias2 = (const LAS float*)(lds + BIAS2_OFF); const GAS float* subg = (const GAS float*)(ap.in[17] + l * 64);
                for (int pi = xb; pi < 256; pi += G) { const int bh = pi >> 4, qlo = pi & 15;
                    diff_unit((const GAS bf16*)proj, (GAS bf16*)ys, lds, bias2, subg, lamp, bh >> 2, bh & 3, 31 - qlo, wave);
                    diff_unit((const GAS bf16*)proj, (GAS bf16*)ys, lds, bias2, subg, lamp, bh >> 2, bh & 3, qlo, wave); } }
            { PHASE_IDS();
            if (SUB(3)) { __syncthreads(); const LAS float* bias2 = (const LAS float*)(lds + BIAS2_OFF); const GAS float* sinks = (const GAS float*)(ap.in[12] + l * 4);
                for (int pi = xb; pi < 512; pi += G) swa_unit((const GAS bf16*)proj, (GAS bf16*)ys, lds, bias2, biasd, sinks, pi >> 7, pi & 127, tid_, lane, wave); }
            if (SUB(2)) cmp_block(ap, l, (const GAS bf16*)proj, (const GAS bf16*)(ap.ws + WS_WCMP), (float*)(ap.ws + WS_CMPAB), kcb, bid, wave, lane);
            if (SUB(1)) { __syncthreads(); for (int task = xb; task < 512; task += G) lru_unit(ap, l, (const GAS bf16*)proj, (GAS bf16*)ys, (GAS float*)lrusum, lds, task, lane, wave, false); }
            }
            SEAM(pb + 2);
        }
        if (IN(pb + 4)) {
            PHASE_IDS();
            for (int task = xb; task < 512; task += G) lru_unit(ap, l, (const GAS bf16*)proj, (GAS bf16*)ys, (GAS float*)lrusum, lds, task, lane, wave, true);
            __syncthreads();
            if (SUB(4)) { const LAS float* bias2 = (const LAS float*)(lds + BIAS2_OFF);
                for (int pi = xb; pi < 256; pi += G) { const int bb = pi >> 6, ulo = pi & 63;
                    nsa_unit((const GAS bf16*)proj, (GAS bf16*)ys, (const GAS bf16*)kcb, lds, bias2, bb, 127 - ulo, tid_, lane, wave);
                    nsa_unit((const GAS bf16*)proj, (GAS bf16*)ys, (const GAS bf16*)kcb, lds, bias2, bb, ulo, tid_, lane, wave); } }
            SEAM(pb + 4);
        }
        if (IN(pb + 5)) {
            PHASE_IDS();
            int K5 = 256; asm volatile("" : "+s"(K5));
            pg8::Gemm g{K5, 1024, 256, 128, -1}; SchedP3a S{(const char*)ys, (const char*)(ap.ws + WS_WBR), G, xb};
            EpiP3a E{merged, (const unsigned char*)gates};
            pg8::gemm_phase<EpiP3a, SchedP3a>(lds, g, S, E, tid_); SEAM(pb + 5);
        }
        if (IN(pb + 6)) {
            PHASE_IDS();
            int K6 = 1024; asm volatile("" : "+s"(K6));
            pg8::Gemm g{K6, 1024, 1024, 128, -1}; SchedP3b S{(const char*)merged, (const char*)(ap.ws + WS_WOUT), G, xb};
            if (l == 0) { EpiP3b<true> E{ap.in[0], (bf16*)(ap.ws + WS_XB)}; pg8::gemm_phase<EpiP3b<true>, SchedP3b>(lds, g, S, E, tid_); }
            else { EpiP3b<false> E{nullptr, (bf16*)(ap.ws + WS_XB)}; pg8::gemm_phase<EpiP3b<false>, SchedP3b>(lds, g, S, E, tid_); }
            SEAM(pb + 6);
        }
        if (IN(pb + 7)) {
            PHASE_IDS();
            bf16* xr = (bf16*)(ap.ws + WS_XR); float* rlog = (float*)(ap.ws + WS_RLOG);
            constexpr int NITW = 32 * (2 * 16 * 4 + 4 * 16);
            { const int pm = bid;
                f32x4 gvv[2][2]; { const GAS float* g28 = (const GAS float*)(ap.in[28] + (size_t)l * 1024);
#pragma unroll
                    for (int j = 0; j < 2; ++j) { gvv[j][0] = *(const GAS f32x4*)(g28 + 8 * (lane + 64 * j)); gvv[j][1] = *(const GAS f32x4*)(g28 + 8 * (lane + 64 * j) + 4); } }
                {   u32x4 rw[4][4][2];
#pragma unroll
                    for (int q4 = 0; q4 < 4; ++q4) route_rows_load(ap, pm * 128 + wave * 4 + 32 * q4, lane, rw[q4]);
#pragma unroll
                    for (int q4 = 0; q4 < 4; ++q4) route_rows4(rw[q4], gvv, xr, pm * 128 + wave * 4 + 32 * q4, lane); }
                asm volatile("s_waitcnt vmcnt(0)" ::: "memory"); __syncthreads();
                { pg8::Gemm g{2048, 2048, 2048, 128, 0}; SchedRoute S{(const char*)xr, (const char*)(ap.ws + WS_WR), pm}; EpiRoute E{rlog};
                  pg8::gemm_phase<EpiRoute, SchedRoute>(lds, g, S, E, tid_); }
                asm volatile("s_waitcnt vmcnt(0)" ::: "memory"); __syncthreads();
                {
                    LAS unsigned* lc = (LAS unsigned*)(lds + 64);
                    if (tid_ < 32) lc[tid_] = 0u;
                    int e0 = 0, e1 = 0; float w0 = 0.f, w1 = 0.f; unsigned r0 = 0u, r1 = 0u;
                    if (tid_ < 128) route_decide(ap, l, rlog + (size_t)(pm * 128 + tid_) * 128, e0, e1, w0, w1);
                    __syncthreads();
                    if (tid_ < 128) { r0 = __hip_atomic_fetch_add(lc + e0, 1u, __ATOMIC_RELAXED, __HIP_MEMORY_SCOPE_WORKGROUP); r1 = __hip_atomic_fetch_add(lc + e1, 1u, __ATOMIC_RELAXED, __HIP_MEMORY_SCOPE_WORKGROUP); }
                    __syncthreads();
                    if (tid_ < 32) { const unsigned c = lc[tid_]; lc[32 + tid_] = c ? __hip_atomic_fetch_add(ctl + CW_CNT + (l * 32 + tid_) * CNT_STRIDE, c, __ATOMIC_RELAXED, __HIP_MEMORY_SCOPE_AGENT) : 0u; }
                    __syncthreads();
                    if (tid_ < 128) { const int tok = pm * 128 + tid_; const int s0 = (int)(lc[32 + e0] + r0), s1 = (int)(lc[32 + e1] + r1);
                        int* inv_as = (int*)(ap.ws + WS_INVAS); float* inv_w = (float*)(ap.ws + WS_INVW);
                        inv_as[e0 * 32768 + s0] = tok * 2; inv_w[e0 * 32768 + s0] = w0; inv_as[e1 * 32768 + s1] = tok * 2 + 1; inv_w[e1 * 32768 + s1] = w1; }
                    __syncthreads();
                }
            }
            expert_weights(ap, l, lds, 0, NITW, gw, NGW, wave, lane);
            SEAM(pb + 7);
        }
        if (IN(pb + 9)) {
            PHASE_IDS();
            build_offsets(ctl + CW_CNT + l * 32 * CNT_STRIDE, offt, tid_);
            int K9 = 1024; asm volatile("" : "+s"(K9));
            pg8::Gemm g{K9, 2048, 1024, 128, -1}; SchedM2 S{(const char*)(ap.ws + WS_XR), (const char*)(ap.ws + WS_WGU), offt, (const int*)(ap.ws + WS_INVAS), G, xb};
            EpiM2 E{hmid};
            pg8::gemm_phase<EpiM2, SchedM2, true>(lds, g, S, E, tid_); SEAM(pb + 9);
        }
        if (IN(pb + 10)) {
            PHASE_IDS();
            build_offsets(ctl + CW_CNT + l * 32 * CNT_STRIDE, offt, tid_);
            int K3 = 256; asm volatile("" : "+s"(K3));
            pg8::Gemm g{K3, 256, 256, 128, -1}; SchedM3 S{(const char*)hmid, (const char*)(ap.ws + WS_WD), offt, G, xb};
            EpiM3 E{eo, (const int*)(ap.ws + WS_INVAS), (const float*)(ap.ws + WS_INVW), offt};
            pg8::gemm_phase<EpiM3, SchedM3>(lds, g, S, E, tid_); SEAM(pb + 10);
        }
    }
    if (IN(2 * PPL)) { PHASE_IDS(); phase0_rows(ap, DEPTH, 1, gw, NGW, lane); }
#undef IN
#undef SEAM
}

typedef void (*kern_t)(Args);
template <unsigned PM> static bool setup_kernel() {
    if (hipFuncSetAttribute((const void*)mk_fwd<PM>, hipFuncAttributeMaxDynamicSharedMemorySize, LDS_BYTES) != hipSuccess) { fprintf(stderr, "kernel_launch: hipFuncSetAttribute failed\n"); return false; }
    return true;
}
extern "C" void kernel_launch(void* const* d_in, const int* in_sizes, int n_in, void* d_out, int out_size, void* d_ws, size_t ws_size, hipStream_t stream) {
    static int grid = 0;
    if (grid == 0) {
        if (n_in != 36 || out_size != T * D || ws_size < WS_END) { fprintf(stderr, "kernel_launch: unexpected shapes (n_in %d out %d ws %zu)\n", n_in, out_size, ws_size); grid = -1; return; }
        int dev = 0, cus = 0;
        if (hipGetDevice(&dev) != hipSuccess || hipDeviceGetAttribute(&cus, hipDeviceAttributeMultiprocessorCount, dev) != hipSuccess) { grid = -1; return; }
        bool ok = true;
#if MK_ONE_LAUNCH
        ok = setup_kernel<0xFFFu>();
#endif
        if (!ok) { grid = -1; return; }
        (void)hipGetLastError();
        grid = cus;
        if (grid != 256) { fprintf(stderr, "kernel_launch: built for a 256-CU device (got %d)\n", cus); grid = -1; return; }
    }
    if (grid < 0) return;
    if (hipMemsetAsync((char*)d_ws + WS_CTL, 0, CTL_ZERO_BYTES, stream) != hipSuccess) return;
    Args a{};
    for (int i = 0; i < 36; ++i) a.in[i] = (const float*)d_in[i];
    a.out = (float*)d_out; a.ws = (unsigned char*)d_ws;
#if MK_ONE_LAUNCH
    a.ph_lo = 0; a.ph_hi = NPH;
    hipLaunchKernelGGL(mk_fwd<0xFFFu>, dim3(grid), dim3(512), LDS_BYTES, stream, a);
#endif
}
```

```cpp
#include <hip/hip_runtime.h>
#include <cstdio>
#include <cstdint>

#ifndef MK_ONE_LAUNCH
#define MK_ONE_LAUNCH 1
#endif

#define DI __device__ __forceinline__
#define GAS __attribute__((address_space(1)))
#define LAS __attribute__((address_space(3)))
typedef unsigned short bf16;
typedef short bf16x8 __attribute__((ext_vector_type(8)));
typedef float f32x4 __attribute__((ext_vector_type(4)));
typedef int i32x4 __attribute__((ext_vector_type(4)));
typedef unsigned u32x4 __attribute__((ext_vector_type(4)));
typedef unsigned u32x2 __attribute__((ext_vector_type(2)));
typedef float f32x16 __attribute__((ext_vector_type(16)));
typedef float f32x2 __attribute__((ext_vector_type(2)));
typedef short s16x4 __attribute__((ext_vector_type(4)));
typedef __bf16 bf16x2_t __attribute__((ext_vector_type(2)));
typedef short v4i16_t __attribute__((__vector_size__(4 * sizeof(short))));
#define MFMA32(a, b, c) __builtin_amdgcn_mfma_f32_32x32x16_bf16((a), (b), (c), 0, 0, 0)

constexpr int BATCH = 4, SEQ = 8192, T = BATCH * SEQ, D = 1024, DEPTH = 2;
constexpr int NIN = 2444, PLD = 2560, N1 = 6656, GLD = 4096;
constexpr int C_AX = 0, C_AG = 256, C_BQ = 512, C_BK = 768, C_BV = 896, C_CQ = 1024, C_CK = 1280, C_CV = 1536, C_DQ = 1792,
              C_KC = 2048, C_VC = 2112, C_KS = 2176, C_VS = 2240, C_KW = 2304, C_VW = 2368, C_DG = 2432;
constexpr int NCMP = 511;
constexpr int MOE_ROWS = 73728;
constexpr int PPL = 11;
constexpr int NPH = 2 * PPL + 1;

constexpr size_t MiB = 1u << 20;
constexpr size_t WS_CTL = 0, CTL_ZERO_BYTES = 1 * MiB;
constexpr size_t WS_KCVC = 1 * MiB;
constexpr size_t WS_LRUSUM = 2 * MiB;
constexpr size_t WS_REC = 2 * MiB + 256 * 1024;
constexpr size_t WS_ROWTOK = 3 * MiB;
constexpr size_t WS_ROWW = 3 * MiB + 512 * 1024;
constexpr size_t WS_WIN = 4 * MiB;
constexpr size_t WS_WQ = 4 * MiB;
constexpr size_t WS_WSC = 13 * MiB;
constexpr size_t WS_HSC = 13 * MiB + 65536;
constexpr size_t WS_HQ = 21 * MiB;
constexpr size_t WS_INVAS = 296 * MiB;
constexpr size_t WS_INVW = 300 * MiB;
constexpr size_t WS_XB = 373 * MiB;
constexpr size_t WS_WBR = 17 * MiB;
constexpr size_t WS_WOUT = 19 * MiB;
constexpr size_t WS_HB = 21 * MiB;
constexpr size_t WS_PROJ = 85 * MiB;
constexpr size_t WS_GATES = 245 * MiB;
constexpr size_t WS_WGU = 245 * MiB;
constexpr size_t WS_WD = 277 * MiB;
constexpr size_t WS_XS = 293 * MiB;
constexpr size_t WS_HMID = 437 * MiB;
constexpr size_t WS_XR = 85 * MiB;
constexpr size_t WS_RLOG = 213 * MiB;
constexpr size_t WS_WR = 501 * MiB;
constexpr size_t WS_WCMP = 502 * MiB;
constexpr size_t WS_CMPAB = 503 * MiB;
constexpr size_t WS_LRUW = 505 * MiB + 65536;
constexpr size_t WS_END = 506 * MiB;
constexpr int CW_BAR = 4096;
constexpr int CW_CNT = 16384, CNT_STRIDE = 64;

constexpr int RING_BYTES = 131072;
constexpr int MISC_OFF = RING_BYTES;
constexpr int BIAS_OFF = MISC_OFF + 256;
constexpr int OFFT_OFF = BIAS_OFF + 129 * 12 * 4;
constexpr int PTAB_OFF = OFFT_OFF + (40 + 288 + 40) * 4;
constexpr int BIAS2_OFF = PTAB_OFF + 36 * 8;
constexpr int LRUEX_OFF = BIAS2_OFF + 129 * 12 * 4;
constexpr int LDS_BYTES = 163840;
constexpr int LRUCST_OFF = LRUEX_OFF + 8 * 64 * 2 * 4;
constexpr int LRUCAR_OFF = LRUCST_OFF + 3 * 64 * 4;
static_assert(PTAB_OFF % 8 == 0 && LRUCAR_OFF + 8 * 64 * 4 <= LDS_BYTES, "LDS map");

DI float bf2f(bf16 v) { return __builtin_bit_cast(float, (unsigned)v << 16); }
DI float lo_bf(unsigned w) { return __builtin_bit_cast(float, w << 16); }
DI float hi_bf(unsigned w) { return __builtin_bit_cast(float, w & 0xffff0000u); }
DI unsigned f2bf(float f) { unsigned u = __builtin_bit_cast(unsigned, f); return (u + 0x7fffu + ((u >> 16) & 1u)) >> 16; }
typedef __bf16 bf16x2_pk __attribute__((ext_vector_type(2)));
DI unsigned pk2(float lo, float hi) { typedef float f32x2_pk __attribute__((ext_vector_type(2))); f32x2_pk v = {lo, hi}; bf16x2_pk b = __builtin_convertvector(v, bf16x2_pk); return __builtin_bit_cast(unsigned, b); }
DI float rl(float v, int i) { return __builtin_bit_cast(float, __builtin_amdgcn_readlane(__builtin_bit_cast(int, v), i)); }
DI int rli(int v, int i) { return __builtin_amdgcn_readlane(v, i); }
DI int my_lane() { int l; asm volatile("v_mbcnt_lo_u32_b32 %0, -1, 0\n\tv_mbcnt_hi_u32_b32 %0, -1, %0" : "=v"(l)); return l; }
template <int O> DI int xshfl_i(int v) {
    if constexpr (O < 32) return __builtin_amdgcn_ds_swizzle(v, (O << 10) | 0x1f);
    else { const int l = my_lane(); return __builtin_amdgcn_ds_bpermute((l ^ 32) << 2, v); }
}
template <int O> DI float xshfl(float v) { return __builtin_bit_cast(float, xshfl_i<O>(__builtin_bit_cast(int, v))); }
DI float wave_sum(float v) { v += xshfl<1>(v); v += xshfl<2>(v); v += xshfl<4>(v); v += xshfl<8>(v); v += xshfl<16>(v); v += xshfl<32>(v); return v; }
DI float wave_max(float v) { v = fmaxf(v, xshfl<1>(v)); v = fmaxf(v, xshfl<2>(v)); v = fmaxf(v, xshfl<4>(v)); v = fmaxf(v, xshfl<8>(v)); v = fmaxf(v, xshfl<16>(v)); v = fmaxf(v, xshfl<32>(v)); return v; }
DI float sigmoidf_(float x) { return __builtin_amdgcn_rcpf(1.f + __builtin_amdgcn_exp2f(-1.4426950408889634f * x)); }
DI float gelu_tanh(float x) { const float u = 0.7978845608028654f * (x + 0.044715f * x * x * x); const float e = __expf(2.f * u); const float th = 1.f - 2.f * __builtin_amdgcn_rcpf(e + 1.f); return 0.5f * x * (1.f + th); }
DI float softplusf_(float x) { return fmaxf(x, 0.f) + log1pf(__expf(-fabsf(x))); }
#define LDS_WAIT() asm volatile("s_waitcnt lgkmcnt(0)" ::: "memory")
#define VM_WAIT() asm volatile("s_waitcnt vmcnt(0)" ::: "memory")

__device__ const unsigned char T5_BUCKET[128] = {
0,1,2,3,4,5,6,7,8,9,10,11,12,13,14,15,16,16,16,17,17,18,18,18,19,19,19,20,20,20,20,21,21,21,21,22,22,22,22,22,23,23,23,23,23,23,24,24,24,24,24,24,25,25,25,25,25,25,25,26,26,26,26,26,26,26,26,27,27,27,27,27,27,27,27,27,27,28,28,28,28,28,28,28,28,28,28,29,29,29,29,29,29,29,29,29,29,29,29,30,30,30,30,30,30,30,30,30,30,30,30,30,30,31,31,31,31,31,31,31,31,31,31,31,31,31,31,31};

#define XB_TMO      128
#define XB_XCNT(j)  (256  + 64 * (j))
#define XB_XSUB(j)  (1280 + 64 * (j))
#define XB_XGEN(j)  (2304 + 64 * (j))
#define XB_TOP      3328
#define XB_TOPGEN   3392
#define XCD_BAR_WORDS 3456
#define XB_SPIN_CAP (1u << 22)
DI unsigned xb_ld(unsigned* p)              { return __hip_atomic_load(p, __ATOMIC_RELAXED, __HIP_MEMORY_SCOPE_AGENT); }
DI unsigned xb_add(unsigned* p, unsigned v) { return __hip_atomic_fetch_add(p, v, __ATOMIC_RELAXED, __HIP_MEMORY_SCOPE_AGENT); }
DI unsigned xb_xcc_id() { return (unsigned)__builtin_amdgcn_s_getreg((3 << 11) | 20) & 0xFu; }
#define XB_SPIN(cond, bar) do { unsigned _sp = 0; while (cond) { __builtin_amdgcn_s_sleep(1); \
    if ((++_sp & 255u) == 0u) { if (xb_ld(&(bar)[XB_TMO])) break; if (_sp > XB_SPIN_CAP) { atomicAdd(&(bar)[XB_TMO], 1u); break; } } } } while (0)
struct XcdBarrier { unsigned* bar; unsigned x; volatile LAS unsigned* st; };
DI XcdBarrier xcd_barrier_post(unsigned* bar, volatile LAS unsigned* st, bool leader) {
    XcdBarrier b; b.bar = bar; b.x = xb_xcc_id(); b.st = st;
    if (leader) (void)xb_add(&bar[XB_XCNT(b.x)], 1u);
    return b;
}
DI void xcd_barrier_complete(unsigned* bar, unsigned x, unsigned& nloc, unsigned& nx) {
    const unsigned G = gridDim.x * gridDim.y * gridDim.z;
    unsigned sum, cnt, mine, sp = 0u;
    for (;;) {
        sum = 0u; cnt = 0u; mine = 0u;
#pragma unroll
        for (unsigned j = 0; j < 16; ++j) { const unsigned c = xb_ld(&bar[XB_XCNT(j)]); sum += c; cnt += (c > 0u) ? 1u : 0u; mine = (j == x) ? c : mine; }
        if (sum == G) break;
        __builtin_amdgcn_s_sleep(1);
        if ((++sp & 255u) == 0u) { if (xb_ld(&bar[XB_TMO])) break; if (sp > XB_SPIN_CAP) { atomicAdd(&bar[XB_TMO], 1u); break; } }
    }
    nloc = mine > 0u ? mine : 1u; nx = cnt > 0u ? cnt : 1u;
}
DI void xcd_barrier(const XcdBarrier& b, bool leader) {
    asm volatile("s_waitcnt vmcnt(0)" ::: "memory");
    __syncthreads();
    if (leader) {
        unsigned* bar = b.bar;
        __builtin_amdgcn_s_waitcnt(0);
        unsigned nloc = b.st[0], nx = b.st[1];
        if (nloc == 0u) { xcd_barrier_complete(bar, b.x, nloc, nx); b.st[0] = nloc; b.st[1] = nx; }
        const unsigned old = xb_add(&bar[XB_XSUB(b.x)], 1u);
        const unsigned gen = old / nloc;
        if (old + 1u == (gen + 1u) * nloc) {
            __builtin_amdgcn_fence(__ATOMIC_RELEASE, "agent");
            asm volatile("s_waitcnt vmcnt(0)" ::: "memory");
            const unsigned og = xb_add(&bar[XB_TOP], 1u);
            const unsigned tg = og / nx;
            if (og + 1u == (tg + 1u) * nx) xb_add(&bar[XB_TOPGEN], 1u);
            else XB_SPIN(xb_ld(&bar[XB_TOPGEN]) == tg, bar);
            __builtin_amdgcn_fence(__ATOMIC_ACQUIRE, "agent");
            xb_add(&bar[XB_XGEN(b.x)], 1u);
            asm volatile("s_waitcnt vmcnt(0)" ::: "memory");
        } else {
            XB_SPIN(xb_ld(&bar[XB_XGEN(b.x)]) == gen, bar);
            __builtin_amdgcn_fence(__ATOMIC_ACQUIRE, "agent");
            asm volatile("s_waitcnt vmcnt(0)" ::: "memory");
        }
    }
    __syncthreads();
}

namespace pg8 {
constexpr int BM = 256, BK = 64, HALF = 128, HTB = HALF * BK * 2;
__host__ __device__ __forceinline__ int lds_byte(int r, int c) { const int st = (r >> 4) * 2 + (c >> 5), rr = r & 15, cc = c & 31, ob = rr * 64 + cc * 2; return st * 1024 + (ob ^ (((ob >> 9) & 1) << 5)); }
__host__ __device__ __forceinline__ void stage_rc(int b, int& R, int& C) { const int st = b / 1024, sb = b % 1024, swz = sb ^ (((sb >> 9) & 1) << 5); R = (st >> 1) * 16 + swz / 64; C = (st & 1) * 32 + (swz % 64) / 2; }
__host__ __device__ __forceinline__ int perm32(int rho) { const int n = rho >> 4, i = rho & 15; return 8 * (i >> 2) + 4 * n + (i & 3); }
struct Unit { const char* a; const char* b; int pm, pn, aux, pad; };
struct Gemm { int K, lda, ldb, kstepA, hstepA; };
template <bool I8> struct AccT { typedef f32x4 type; };
template <> struct AccT<true> { typedef i32x4 type; };
template <class Epi, class Sched, bool GATHER = false, bool I8 = false>
DI void gemm_phase(LAS unsigned char* lds, const Gemm g, const Sched& S, const Epi& E, int tid_in) {
    int tid = tid_in; asm volatile("" : "+v"(tid));
    const int wid = __builtin_amdgcn_readfirstlane(tid >> 6), lane = tid & 63, wr = wid >> 2, wc = wid & 3, fr = lane & 15, fq = lane >> 4;
    const int K = g.K, nt = K / BK;
    unsigned voffA[2], voffB[2];
#pragma unroll
    for (int i = 0; i < 2; ++i) { int R, C; stage_rc(tid * 16 + i * 8192, R, C); const int Rb = (R & ~31) + perm32(R & 31);
        voffA[i] = (unsigned)(R * g.lda + C) * 2u; voffB[i] = (unsigned)(Rb * g.ldb + C) * 2u; }
    const size_t kstep = (size_t)(BK * 2), kstepA = (size_t)g.kstepA;
    const size_t hstepA = g.hstepA < 0 ? (size_t)HALF * g.lda * 2 : (size_t)g.hstepA, hstepB = (size_t)HALF * g.ldb * 2;
    const unsigned hstepA32 = (unsigned)hstepA;
    unsigned gC[2][2] = {{0u, 0u}, {0u, 0u}}, gN[2][2] = {{0u, 0u}, {0u, 0u}};
    const unsigned ldsw = (unsigned)wid * 1024u;
    const int aoff = lds_byte(wr * 64 + fr, fq * 8), boff = lds_byte(wc * 32 + fr, fq * 8);
#define PG8_SA(b, h) (((b) * 2 + (h)) * HTB)
#define PG8_SB(b, h) ((4 + (b) * 2 + (h)) * HTB)
#define PG8_STAGE(bufoff, gbase, voff) do { _Pragma("unroll") for (int _i = 0; _i < 2; ++_i) \
        __builtin_amdgcn_global_load_lds((const unsigned*)((const char*)(gbase) + (voff)[_i]), (LAS unsigned*)(lds + (bufoff) + ldsw + _i * 8192), 16, 0, 0); } while (0)
#define PG8_STAGEA(bufoff, gbase, h, nextsel) do { _Pragma("unroll") for (int _i = 0; _i < 2; ++_i) { \
        const unsigned _o = GATHER ? ((nextsel) ? gN[h][_i] : gC[h][_i]) : (voffA[_i] + (unsigned)(h) * hstepA32); \
        __builtin_amdgcn_global_load_lds((const unsigned*)((const char*)(gbase) + _o), (LAS unsigned*)(lds + (bufoff) + ldsw + _i * 8192), 16, 0, 0); } } while (0)
#define PG8_LDA(dst, b, h) do { _Pragma("unroll") for (int m = 0; m < 4; ++m) _Pragma("unroll") for (int k = 0; k < 2; ++k) dst[m][k] = *(const LAS bf16x8*)(lds + PG8_SA(b, h) + aoff + m * 2048 + k * 1024); } while (0)
#define PG8_LDB(dst, b, h) do { _Pragma("unroll") for (int n = 0; n < 2; ++n) _Pragma("unroll") for (int k = 0; k < 2; ++k) dst[n][k] = *(const LAS bf16x8*)(lds + PG8_SB(b, h) + boff + n * 2048 + k * 1024); } while (0)
#define PG8_MMA(ai, bj, At, Bt) do { __builtin_amdgcn_s_setprio(1); _Pragma("unroll") for (int m = 0; m < 4; ++m) _Pragma("unroll") for (int n = 0; n < 2; ++n) _Pragma("unroll") for (int k = 0; k < 2; ++k) \
        { if constexpr (I8) acc[ai][bj][m][n] = __builtin_amdgcn_mfma_i32_16x16x64_i8(__builtin_bit_cast(i32x4, Bt[n][k]), __builtin_bit_cast(i32x4, At[m][k]), acc[ai][bj][m][n], 0, 0, 0); \
          else acc[ai][bj][m][n] = __builtin_amdgcn_mfma_f32_16x16x32_bf16(Bt[n][k], At[m][k], acc[ai][bj][m][n], 0, 0, 0); } __builtin_amdgcn_s_setprio(0); } while (0)
#define PG8_WAIT_V(n) asm volatile("s_waitcnt vmcnt(" #n ")" ::: "memory")
#define PG8_WAIT_L(n) asm volatile("s_waitcnt lgkmcnt(" #n ")" ::: "memory")
#define PG8_BAR __builtin_amdgcn_s_barrier()
#define PG8_SCHED __builtin_amdgcn_sched_barrier(0)
    Unit cur, nxt; int ui = 0;
    if (!S.next(0, cur)) return;
    typedef typename AccT<I8>::type ACC;
    ACC acc[2][2][4][2];
#pragma unroll
    for (int a = 0; a < 2; ++a)
#pragma unroll
        for (int b = 0; b < 2; ++b)
#pragma unroll
            for (int m = 0; m < 4; ++m)
#pragma unroll
                for (int n = 0; n < 2; ++n) acc[a][b][m][n] = (ACC){0, 0, 0, 0};
    bf16x8 At[4][2], B0[2][2], B1[2][2];
    const char* cA = cur.a; const char* cB = cur.b;
    if constexpr (GATHER) S.rows(cur, tid, gC);
    PG8_STAGE(PG8_SB(0, 0), cB, voffB); PG8_STAGE(PG8_SB(0, 1), cB + hstepB, voffB); PG8_STAGEA(PG8_SA(0, 0), cA, 0, false); PG8_STAGEA(PG8_SA(0, 1), cA, 1, false);
    if (wr == 1) PG8_BAR;
    PG8_WAIT_V(2); PG8_BAR;
    PG8_STAGE(PG8_SB(1, 0), cB + kstep, voffB); PG8_STAGEA(PG8_SA(1, 0), cA + kstepA, 0, false); PG8_STAGE(PG8_SB(1, 1), cB + hstepB + kstep, voffB);
    PG8_WAIT_V(6); PG8_BAR;
    for (;;) {
        const bool has_next = S.next(ui + 1, nxt);
        const char* nA = has_next ? nxt.a : cA; const char* nB = has_next ? nxt.b : cB;
        if constexpr (GATHER) { if (has_next) S.rows(nxt, tid, gN); else {
#pragma unroll
            for (int h = 0; h < 2; ++h) { gN[h][0] = gC[h][0]; gN[h][1] = gC[h][1]; } } }
        for (int t = 0; t < nt; t += 2) {
            const bool last = (t == nt - 2);
            const char* a1 = cA + (size_t)(t + 1) * kstepA;
            const char* a2 = last ? nA : cA + (size_t)(t + 2) * kstepA; const char* b2 = last ? nB : cB + (size_t)(t + 2) * kstep;
            const char* a3 = a2 + kstepA; const char* b3 = b2 + kstep;
            PG8_LDB(B0, 0, 0); PG8_LDB(B1, 0, 1); PG8_SCHED; PG8_LDA(At, 0, 0); PG8_STAGEA(PG8_SA(1, 1), a1, 1, false);
            PG8_WAIT_V(8); PG8_WAIT_L(0); PG8_BAR; PG8_MMA(0, 0, At, B0); PG8_MMA(0, 1, At, B1); PG8_BAR; PG8_SCHED;
            PG8_LDA(At, 0, 1); PG8_STAGE(PG8_SB(0, 0), b2, voffB); PG8_STAGE(PG8_SB(0, 1), b2 + hstepB, voffB); PG8_STAGEA(PG8_SA(0, 0), a2, 0, last);
            PG8_WAIT_V(8); PG8_WAIT_L(0); PG8_BAR; PG8_MMA(1, 0, At, B0); PG8_MMA(1, 1, At, B1); PG8_BAR; PG8_SCHED;
            PG8_LDB(B0, 1, 0); PG8_LDB(B1, 1, 1); PG8_SCHED; PG8_LDA(At, 1, 0); PG8_STAGEA(PG8_SA(0, 1), a2, 1, last);
            PG8_WAIT_V(8); PG8_WAIT_L(0); PG8_BAR; PG8_MMA(0, 0, At, B0); PG8_MMA(0, 1, At, B1); PG8_BAR; PG8_SCHED;
            PG8_LDA(At, 1, 1); PG8_STAGE(PG8_SB(1, 0), b3, voffB); PG8_STAGE(PG8_SB(1, 1), b3 + hstepB, voffB); PG8_STAGEA(PG8_SA(1, 0), a3, 0, last);
            PG8_WAIT_V(8); PG8_WAIT_L(0); PG8_BAR; PG8_MMA(1, 0, At, B0); PG8_MMA(1, 1, At, B1); PG8_BAR; PG8_SCHED;
        }
        if (wr == 0) PG8_BAR;
        { const int el = my_lane(); E(acc, cur, wr, wc, el & 15, el >> 4); }
        if (!has_next) break;
        bool carried = false;
        if constexpr (Epi::CARRY) { if (nxt.aux != 0) { const int el = my_lane(); E.carry(acc, nxt, wr, wc, el & 15, el >> 4); carried = true; } }
        if (!carried) {
#pragma unroll
        for (int a = 0; a < 2; ++a)
#pragma unroll
            for (int b = 0; b < 2; ++b)
#pragma unroll
                for (int m = 0; m < 4; ++m)
#pragma unroll
                    for (int n = 0; n < 2; ++n) acc[a][b][m][n] = (ACC){0, 0, 0, 0};
        }
        cur = nxt; cA = nA; cB = nB; ++ui;
        if constexpr (GATHER) {
#pragma unroll
            for (int h = 0; h < 2; ++h) { gC[h][0] = gN[h][0]; gC[h][1] = gN[h][1]; } }
        if (wr == 1) PG8_BAR;
    }
    PG8_WAIT_V(0);
    PG8_BAR;
#undef PG8_SA
#undef PG8_SB
#undef PG8_STAGE
#undef PG8_STAGEA
#undef PG8_LDA
#undef PG8_LDB
#undef PG8_MMA
#undef PG8_WAIT_V
#undef PG8_WAIT_L
#undef PG8_BAR
#undef PG8_SCHED
}
}
using pg8::Unit;

DI unsigned cvt_pk_bf16(float lo, float hi) { unsigned r; asm volatile("s_nop 1\n\tv_cvt_pk_bf16_f32 %0, %1, %2" : "=v"(r) : "v"(lo), "v"(hi)); return r; }
DI u32x4 pack8(const f32x4& v0, const f32x4& v1) { u32x4 w; w.x = cvt_pk_bf16(v0[0], v0[1]); w.y = cvt_pk_bf16(v0[2], v0[3]); w.z = cvt_pk_bf16(v1[0], v1[1]); w.w = cvt_pk_bf16(v1[2], v1[3]); return w; }

struct SchedP1 {
    const char* A; const char* B; int nM, nN, rbA, rbB, G, c;
    DI bool next(int i, Unit& u) const {
        constexpr int NXCD = 8, WGM = 8; const int nwg = nM * nN;
        const long L = (long)i * G + c; if (L >= nwg) return false;
        int wgid = (int)L; { const int q = nwg / NXCD, r = nwg % NXCD, xcd = wgid % NXCD, off = wgid / NXCD; wgid = (xcd < r ? xcd * (q + 1) : r * (q + 1) + (xcd - r) * q) + off; }
        const int nig = WGM * nN, gid = wgid / nig, fm = gid * WGM, gsz = (nM - fm) < WGM ? (nM - fm) : WGM;
        u.pm = fm + ((wgid % nig) % gsz); u.pn = (wgid % nig) / gsz; u.aux = 0; u.pad = 0;
        u.a = A + (size_t)u.pm * 256 * rbA; u.b = B + (size_t)u.pn * 256 * rbB; return true;
    }
};
struct SchedP3a {
    const char* ys; const char* wbr; int G, c;
    DI bool next(int i, Unit& u) const {
        const int tile = (i >> 2) * G + c; if (tile >= 512) return false;
        const int br = i & 3; u.pm = tile >> 2; u.pn = tile & 3; u.aux = br; u.pad = 0;
        u.a = ys + ((size_t)u.pm * 256 * 1024 + br * 256) * 2; u.b = wbr + ((size_t)br * 1024 * 256 + (size_t)u.pn * 256 * 256) * 2; return true;
    }
};
struct SchedP3b {
    const char* A; const char* B; int G, c;
    DI bool next(int i, Unit& u) const {
        const int L = i * G + c; if (L >= 512) return false;
        u.pm = L >> 2; u.pn = L & 3; u.aux = 0; u.pad = 0;
        u.a = A + (size_t)u.pm * 256 * 1024 * 2; u.b = B + (size_t)u.pn * 256 * 1024 * 2; return true;
    }
};
struct SchedM2 {
    const char* xr; const char* wgu; const LAS int* offt; const int* rowsrc; int G, c;
    DI bool next(int i, Unit& u) const {
        const int NT = __builtin_amdgcn_readfirstlane(offt[32]) >> 8; const int L = i * G + c; if (L >= NT * 2) return false;
        const int rt = L >> 1, pn = L & 1; const int e = __builtin_amdgcn_readfirstlane(offt[40 + rt]);
        u.pm = rt; u.pn = pn; u.aux = e; u.pad = 0;
        u.a = xr; u.b = wgu + ((size_t)e * 512 + pn * 256) * 1024 * 2; return true;
    }
    DI void rows(const Unit& u, int tid, unsigned (&g)[2][2]) const {
        const int e = u.aux; const int base = u.pm * 256 - __builtin_amdgcn_readfirstlane(offt[e]), cnt = __builtin_amdgcn_readfirstlane(offt[330 + e]);
#pragma unroll
        for (int i = 0; i < 2; ++i) { int R, C; pg8::stage_rc(tid * 16 + i * 8192, R, C);
#pragma unroll
            for (int h = 0; h < 2; ++h) { const int lr = base + h * 128 + R; const int as = lr < cnt ? rowsrc[e * 32768 + lr] : 0;
                g[h][i] = (unsigned)(as >> 1) * 4096u + (unsigned)C * 2u; } }
    }
};
struct SchedM3 {
    const char* hmid; const char* wd; const LAS int* offt; int G, c;
    DI bool next(int i, Unit& u) const {
        const int NT = __builtin_amdgcn_readfirstlane(offt[32]) >> 8; const int L = i * G + c; if (L >= NT * 4) return false;
        const int rt = L >> 2, pn = L & 3; const int e = __builtin_amdgcn_readfirstlane(offt[40 + rt]);
        u.pm = rt; u.pn = pn; u.aux = e; u.pad = 0;
        u.a = hmid + (size_t)rt * 256 * 256 * 2; u.b = wd + ((size_t)e * 1024 + pn * 256) * 256 * 2; return true;
    }
};

struct EpiP1I8 {
    static constexpr bool CARRY = false;
    bf16* proj; unsigned char* gates; const float* bgate; const float* hsc; const float* wsc;
    DI void operator()(const i32x4 (&acc)[2][2][4][2], const Unit& u, int wr, int wc, int fr, int fq) const {
        const int row0 = u.pm * 256 + wr * 64 + fr;
        if (u.pn < 10) { const int colt = u.pn * 256 + wc * 32 + 8 * fq;
            f32x4 sv[2][2]; float rsv[2][4];
#pragma unroll
            for (int bj = 0; bj < 2; ++bj)
#pragma unroll
                for (int n = 0; n < 2; ++n) sv[bj][n] = *(const GAS f32x4*)((const GAS float*)wsc + colt + bj * 128 + 4 * n);
#pragma unroll
            for (int ai = 0; ai < 2; ++ai)
#pragma unroll
                for (int m = 0; m < 4; ++m) rsv[ai][m] = ((const GAS float*)hsc)[row0 + ai * 128 + m * 16];
#pragma unroll
            for (int ai = 0; ai < 2; ++ai)
#pragma unroll
                for (int m = 0; m < 4; ++m) { bf16* rowp = proj + (size_t)(row0 + ai * 128 + m * 16) * PLD + colt; const float rs = rsv[ai][m];
#pragma unroll
                    for (int bj = 0; bj < 2; ++bj) { f32x4 v0, v1;
#pragma unroll
                        for (int e = 0; e < 4; ++e) { v0[e] = (float)acc[ai][bj][m][0][e] * (rs * sv[bj][0][e]); v1[e] = (float)acc[ai][bj][m][1][e] * (rs * sv[bj][1][e]); }
                        *(u32x4*)(rowp + bj * 128) = pack8(v0, v1); } }
            return; }
        const int gcol = (u.pn - 10) * 256 + wc * 32 + 8 * fq; const float* wsc = this->wsc + 2560;
        f32x4 bv[2][2], sv[2][2];
#pragma unroll
        for (int bj = 0; bj < 2; ++bj)
#pragma unroll
            for (int n = 0; n < 2; ++n) { bv[bj][n] = *(const f32x4*)(bgate + gcol + bj * 128 + 4 * n); sv[bj][n] = *(const f32x4*)(wsc + gcol + bj * 128 + 4 * n);
                sv[bj][n] = sv[bj][n] * -1.4426950408889634f; bv[bj][n] = bv[bj][n] * -1.4426950408889634f + (-8.f + 2.2e-5f); }
        float rsv[2][4];
#pragma unroll
        for (int ai = 0; ai < 2; ++ai)
#pragma unroll
            for (int m = 0; m < 4; ++m) rsv[ai][m] = ((const GAS float*)hsc)[row0 + ai * 128 + m * 16];
#pragma unroll
        for (int ai = 0; ai < 2; ++ai)
#pragma unroll
            for (int m = 0; m < 4; ++m) { const float rs = rsv[ai][m];
                unsigned char* rowp = gates + ((size_t)(u.pm * 16 + (u.pn - 10)) * 65536 + (size_t)((ai * 4 + m) * 8192 + (wr * 4 + wc) * 1024 + (fq * 16 + fr) * 16));
                u32x4 w4;
#pragma unroll
                for (int bj = 0; bj < 2; ++bj) { unsigned q[8];
#pragma unroll
                    for (int n = 0; n < 2; ++n)
#pragma unroll
                        for (int e = 0; e < 4; ++e) { const float xe = ((float)acc[ai][bj][m][n][e] * rs) * sv[bj][n][e] + bv[bj][n][e];
                            q[4 * n + e] = (unsigned)__builtin_amdgcn_rcpf(0.00390631f + __builtin_amdgcn_exp2f(xe)); }
                    const unsigned w0 = q[0] | (q[1] << 8) | (q[2] << 16) | (q[3] << 24), w1 = q[4] | (q[5] << 8) | (q[6] << 16) | (q[7] << 24);
                    if (bj == 0) { w4.x = w0; w4.y = w1; } else { w4.z = w0; w4.w = w1; } }
                *(u32x4*)rowp = w4;
                __builtin_amdgcn_sched_barrier(0); }
    }
};
struct EpiP3a {
    static constexpr bool CARRY = true;
    bf16* merged; const unsigned char* gates;
    DI void carry(f32x4 (&acc)[2][2][4][2], const Unit& u, int wr, int wc, int fr, int fq) const {
        const GAS unsigned char* gb = (const GAS unsigned char*)gates + (size_t)(u.pm * 16 + (u.aux - 1) * 4 + u.pn) * 65536;
        const unsigned go = (unsigned)((wr * 4 + wc) * 1024 + (fq * 16 + fr) * 16);
        u32x4 gp[2][4], gn[2][4];
#pragma unroll
        for (int ai = 0; ai < 2; ++ai)
#pragma unroll
            for (int m = 0; m < 4; ++m) { gp[ai][m] = *(const GAS u32x4*)(gb + go + (unsigned)((ai * 4 + m) * 8192)); gn[ai][m] = *(const GAS u32x4*)(gb + go + (unsigned)((ai * 4 + m) * 8192 + 4 * 65536)); }
#pragma unroll
        for (int ai = 0; ai < 2; ++ai) {
#pragma unroll
            for (int m = 0; m < 4; ++m)
#pragma unroll
                for (int bj = 0; bj < 2; ++bj) {
#pragma unroll
                    for (int n = 0; n < 2; ++n) { const unsigned p4 = bj ? (n ? gp[ai][m].w : gp[ai][m].z) : (n ? gp[ai][m].y : gp[ai][m].x), n4 = bj ? (n ? gn[ai][m].w : gn[ai][m].z) : (n ? gn[ai][m].y : gn[ai][m].x);
#pragma unroll
                        for (int e = 0; e < 4; ++e) acc[ai][bj][m][n][e] *= ((float)((p4 >> (8 * e)) & 255u) + 0.5f) * __builtin_amdgcn_rcpf((float)((n4 >> (8 * e)) & 255u) + 0.5f); } }
            __builtin_amdgcn_sched_barrier(0); }
    }
    DI void operator()(const f32x4 (&acc)[2][2][4][2], const Unit& u, int wr, int wc, int fr, int fq) const {
        if (u.aux != 3) return;
        const GAS unsigned char* gb = (const GAS unsigned char*)gates + (size_t)(u.pm * 16 + 3 * 4 + u.pn) * 65536;
        GAS unsigned char* mb = (GAS unsigned char*)merged + ((size_t)(u.pm * 256) * 1024 + u.pn * 256) * 2;
        const unsigned go = (unsigned)((wr * 4 + wc) * 1024 + (fq * 16 + fr) * 16), mo = (unsigned)((wr * 64 + fr) * 1024 + wc * 32 + 8 * fq) * 2u;
        u32x4 gw[2][4];
#pragma unroll
        for (int ai = 0; ai < 2; ++ai)
#pragma unroll
            for (int m = 0; m < 4; ++m) gw[ai][m] = *(const GAS u32x4*)(gb + go + (unsigned)((ai * 4 + m) * 8192));
#pragma unroll
        for (int ai = 0; ai < 2; ++ai) {
#pragma unroll
            for (int m = 0; m < 4; ++m)
#pragma unroll
                for (int bj = 0; bj < 2; ++bj) {
                    f32x4 v0 = acc[ai][bj][m][0], v1 = acc[ai][bj][m][1]; u32x2 g2; g2.x = bj ? gw[ai][m].z : gw[ai][m].x; g2.y = bj ? gw[ai][m].w : gw[ai][m].y; const float k256 = 0.00390625f;
#pragma unroll
                    for (int e = 0; e < 4; ++e) { v0[e] *= ((float)((g2.x >> (8 * e)) & 255u) + 0.5f) * k256; v1[e] *= ((float)((g2.y >> (8 * e)) & 255u) + 0.5f) * k256; }
                    *(GAS u32x4*)(mb + mo + (unsigned)((ai * 128 + m * 16) * 1024 + bj * 128) * 2u) = pack8(v0, v1); }
            __builtin_amdgcn_sched_barrier(0); }
    }
};
template <bool XF32> struct EpiP3b {
    static constexpr bool CARRY = false;
    const float* xin; bf16* xb_;
    DI void operator()(const f32x4 (&acc)[2][2][4][2], const Unit& u, int wr, int wc, int fr, int fq) const {
        GAS unsigned char* ob = (GAS unsigned char*)xb_ + ((size_t)(u.pm * 256) * 1024 + u.pn * 256) * 2;
        const unsigned lo = (unsigned)((wr * 64 + fr) * 1024 + wc * 32 + 8 * fq);
        if constexpr (XF32) {
            const GAS unsigned char* xb = (const GAS unsigned char*)xin + ((size_t)(u.pm * 256) * 1024 + u.pn * 256) * 4;
#pragma unroll
            for (int ai = 0; ai < 2; ++ai)
#pragma unroll
                for (int mh = 0; mh < 2; ++mh) {
                    f32x4 xv[2][2][2];
#pragma unroll
                    for (int m2 = 0; m2 < 2; ++m2)
#pragma unroll
                        for (int bj = 0; bj < 2; ++bj)
#pragma unroll
                            for (int n = 0; n < 2; ++n) xv[m2][bj][n] = *(const GAS f32x4*)(xb + (lo + (unsigned)((ai * 128 + (mh * 2 + m2) * 16) * 1024 + bj * 128 + 4 * n)) * 4u);
#pragma unroll
                    for (int m2 = 0; m2 < 2; ++m2)
#pragma unroll
                        for (int bj = 0; bj < 2; ++bj)
                            *(GAS u32x4*)(ob + (lo + (unsigned)((ai * 128 + (mh * 2 + m2) * 16) * 1024 + bj * 128)) * 2u) = pack8(xv[m2][bj][0] + acc[ai][bj][mh * 2 + m2][0], xv[m2][bj][1] + acc[ai][bj][mh * 2 + m2][1]);
                    __builtin_amdgcn_sched_barrier(0); }
        } else {
#pragma unroll
            for (int ai = 0; ai < 2; ++ai) {
                u32x4 xv[4][2];
#pragma unroll
                for (int m = 0; m < 4; ++m)
#pragma unroll
                    for (int bj = 0; bj < 2; ++bj) xv[m][bj] = *(const GAS u32x4*)(ob + (lo + (unsigned)((ai * 128 + m * 16) * 1024 + bj * 128)) * 2u);
#pragma unroll
                for (int m = 0; m < 4; ++m)
#pragma unroll
                    for (int bj = 0; bj < 2; ++bj) { const u32x4 x4 = xv[m][bj]; f32x4 v0 = acc[ai][bj][m][0], v1 = acc[ai][bj][m][1];
                        v0[0] += lo_bf(x4.x); v0[1] += hi_bf(x4.x); v0[2] += lo_bf(x4.y); v0[3] += hi_bf(x4.y); v1[0] += lo_bf(x4.z); v1[1] += hi_bf(x4.z); v1[2] += lo_bf(x4.w); v1[3] += hi_bf(x4.w);
                        *(GAS u32x4*)(ob + (lo + (unsigned)((ai * 128 + m * 16) * 1024 + bj * 128)) * 2u) = pack8(v0, v1); }
                __builtin_amdgcn_sched_barrier(0); }
        }
    }
};
struct EpiM2 {
    static constexpr bool CARRY = false;
    bf16* hmid;
    DI void operator()(const f32x4 (&acc)[2][2][4][2], const Unit& u, int wr, int wc, int fr, int fq) const {
        const int row0 = u.pm * 256 + wr * 64 + fr; const int col = u.pn * 128 + wc * 32 + 8 * fq;
#pragma unroll
        for (int ai = 0; ai < 2; ++ai)
#pragma unroll
            for (int m = 0; m < 4; ++m) { f32x4 h0, h1;
#pragma unroll
                for (int e = 0; e < 4; ++e) { const float g0 = acc[ai][0][m][0][e], g1 = acc[ai][0][m][1][e];
                    h0[e] = g0 * sigmoidf_(g0) * acc[ai][1][m][0][e]; h1[e] = g1 * sigmoidf_(g1) * acc[ai][1][m][1][e]; }
                *(u32x4*)(hmid + (size_t)(row0 + ai * 128 + m * 16) * 256 + col) = pack8(h0, h1); }
    }
};
struct EpiM3 {
    static constexpr bool CARRY = false;
    bf16* eo; const int* rowtok; const float* roww; const LAS int* offt;
    DI void operator()(const f32x4 (&acc)[2][2][4][2], const Unit& u, int wr, int wc, int fr, int fq) const {
        const int e = u.aux; const int cnt = __builtin_amdgcn_readfirstlane(offt[330 + e]);
        const int lr0 = u.pm * 256 - __builtin_amdgcn_readfirstlane(offt[e]) + wr * 64 + fr; const int colt = u.pn * 256 + wc * 32 + 8 * fq;
        int tk[2][4]; float wv[2][4];
#pragma unroll
        for (int ai = 0; ai < 2; ++ai)
#pragma unroll
            for (int m = 0; m < 4; ++m) { const int lr = lr0 + ai * 128 + m * 16; tk[ai][m] = -1; wv[ai][m] = 0.f;
                if (lr < cnt) { tk[ai][m] = ((const GAS int*)rowtok)[e * 32768 + lr]; wv[ai][m] = ((const GAS float*)roww)[e * 32768 + lr]; } }
#pragma unroll
        for (int ai = 0; ai < 2; ++ai)
#pragma unroll
            for (int m = 0; m < 4; ++m) {
                if (tk[ai][m] >= 0) { const float w = wv[ai][m]; GAS bf16* op = (GAS bf16*)eo + (size_t)tk[ai][m] * 1024 + colt;
#pragma unroll
                    for (int bj = 0; bj < 2; ++bj) *(GAS u32x4*)(op + bj * 128) = pack8(acc[ai][bj][m][0] * w, acc[ai][bj][m][1] * w); }
                __builtin_amdgcn_sched_barrier(0); }
    }
};

struct Args { const float* in[36]; float* out; unsigned char* ws; int ph_lo, ph_hi; };
struct InTab { unsigned base;
    DI const float* operator[](int i) const { unsigned long long v; const unsigned addr = base + (unsigned)i * 8u;
        asm volatile("ds_read_b64 %0, %1\n\ts_waitcnt lgkmcnt(0)" : "=v"(v) : "v"(addr) : "memory");
        const unsigned lo = __builtin_amdgcn_readfirstlane((unsigned)v), hi = __builtin_amdgcn_readfirstlane((unsigned)(v >> 32));
        return (const float*)(((unsigned long long)hi << 32) | lo); } };
struct KA { InTab in; float* out; unsigned char* ws; };

DI void transpose_item(const float* W_, int ldw, int nvalid, bf16* WT_, int ldt, int k0, int n0, int dst_row0, LAS float* scr, int lane) {
    const GAS float* W = (const GAS float*)W_; GAS bf16* WT = (GAS bf16*)WT_;
    const int nq = 4 * (lane & 7), kr8 = lane >> 3;
    f32x4 v[8];
#pragma unroll
    for (int i = 0; i < 8; ++i) { const int kk = 8 * i + kr8;
        if (n0 + nq + 3 < nvalid) v[i] = *(const GAS f32x4*)(W + (size_t)(k0 + kk) * ldw + n0 + nq);
        else {
#pragma unroll
            for (int e = 0; e < 4; ++e) v[i][e] = (n0 + nq + e < nvalid) ? W[(size_t)(k0 + kk) * ldw + n0 + nq + e] : 0.f; } }
#pragma unroll
    for (int i = 0; i < 8; ++i) { const int kk = 8 * i + kr8;
#pragma unroll
        for (int e = 0; e < 4; ++e) scr[kk * 33 + nq + e] = v[i][e]; }
    LDS_WAIT(); asm volatile("" ::: "memory");
    const int c = lane & 7;
#pragma unroll
    for (int j = 0; j < 4; ++j) { const int n = (lane >> 3) + 8 * j; const LAS float* s = scr + (8 * c) * 33 + n;
        u32x4 o; o.x = pk2(s[0 * 33], s[1 * 33]); o.y = pk2(s[2 * 33], s[3 * 33]); o.z = pk2(s[4 * 33], s[5 * 33]); o.w = pk2(s[6 * 33], s[7 * 33]);
        if (n0 + n < nvalid) *(GAS u32x4*)(WT + (size_t)(dst_row0 + n) * ldt + k0 + 8 * c) = o; }
    LDS_WAIT(); asm volatile("" ::: "memory");
}
DI void phase0_weights(const KA& a, int l, LAS unsigned char* lds, int gw, int NGW, int wave, int lane) {
    LAS float* scr = (LAS float*)(lds + wave * 16384);
    const float* w_in = a.in[4] + (size_t)l * 1024 * NIN;
    const float* w_gate = a.in[24] + (size_t)l * 4 * 1024 * 1024;
    const float* w_br = a.in[26] + (size_t)l * 4 * 256 * 1024;
    const float* w_out = a.in[27] + (size_t)l * 1024 * 1024;
    bf16* Wt_in = (bf16*)(a.ws + WS_WIN); bf16* Wt_br = (bf16*)(a.ws + WS_WBR); bf16* Wt_out = (bf16*)(a.ws + WS_WOUT);
    constexpr int I_B = 4 * 4 * 32, I_O = 16 * 32, NIT = I_B + I_O;
    (void)w_gate; (void)w_in; (void)Wt_in;
    for (int it = gw; it < NIT; it += NGW) {
        int r = it;
        if (r < I_B) { const int br = r / 128, q = r % 128, kb = q / 32, nb = q % 32; transpose_item(w_br + (size_t)br * 256 * 1024, 1024, 1024, Wt_br + (size_t)br * 1024 * 256, 256, kb * 64, nb * 32, nb * 32, scr, lane); continue; } r -= I_B;
        { const int kb = r / 32, nb = r % 32; transpose_item(w_out, 1024, 1024, Wt_out, 1024, kb * 64, nb * 32, nb * 32, scr, lane); }
    }
}
DI void p1_weights_i8(const KA& a, int l, LAS unsigned char* lds, int bid, int G, int wave, int lane) {
    LAS float* scr = (LAS float*)(lds + wave * 16384); LAS float* red = (LAS float*)(lds + 7 * 16384 + 12288);
    const GAS float* wgt = (const GAS float*)(a.in[24] + (size_t)l * 4 * 1024 * 1024); const GAS float* win = (const GAS float*)(a.in[4] + (size_t)l * 1024 * NIN);
    GAS unsigned char* Wq = (GAS unsigned char*)(a.ws + WS_WQ); GAS float* wsc = (GAS float*)(a.ws + WS_WSC);
    const int nq = 4 * (lane & 7), kr8 = lane >> 3;
    for (int it = G - 1 - bid; it < 128 + 77; it += G) {
        const bool isg = it < 128; const int br = it >> 5; const int n0 = isg ? (it & 31) * 32 : (it - 128) * 32;
        const int ldw = isg ? 1024 : NIN; const int nval = isg ? 1024 : NIN; const int drow0 = isg ? 2560 + br * 1024 + n0 : n0;
        const bool lok = (n0 + nq) < nval;
        const GAS float* W = (isg ? wgt + (size_t)br * 1024 * 1024 : win) + n0 + nq + (size_t)(128 * wave) * ldw;
        f32x4 v[16];
#pragma unroll
        for (int i = 0; i < 16; ++i) { v[i] = (f32x4){0.f, 0.f, 0.f, 0.f}; if (lok) v[i] = *(const GAS f32x4*)(W + (size_t)(8 * i + kr8) * ldw); }
        f32x4 mx = {0.f, 0.f, 0.f, 0.f};
#pragma unroll
        for (int i = 0; i < 16; ++i) { mx[0] = fmaxf(mx[0], fabsf(v[i][0])); mx[1] = fmaxf(mx[1], fabsf(v[i][1])); mx[2] = fmaxf(mx[2], fabsf(v[i][2])); mx[3] = fmaxf(mx[3], fabsf(v[i][3])); }
#pragma unroll
        for (int e = 0; e < 4; ++e) { float m = mx[e]; m = fmaxf(m, xshfl<8>(m)); m = fmaxf(m, xshfl<16>(m)); m = fmaxf(m, xshfl<32>(m)); mx[e] = m; }
        if (kr8 == 0) {
#pragma unroll
            for (int e = 0; e < 4; ++e) red[wave * 32 + nq + e] = mx[e]; }
        __syncthreads();
#pragma unroll
        for (int e = 0; e < 4; ++e) { float m = red[nq + e];
#pragma unroll
            for (int w = 1; w < 8; ++w) m = fmaxf(m, red[w * 32 + nq + e]);
            mx[e] = fmaxf(m, 1e-20f); }
        if (wave == 0 && kr8 == 0 && lok) *(GAS f32x4*)(wsc + drow0 + nq) = mx * (1.f / 127.f);
        const f32x4 qs = {127.f / mx[0], 127.f / mx[1], 127.f / mx[2], 127.f / mx[3]};
#pragma unroll
        for (int hb = 0; hb < 2; ++hb) {
#pragma unroll
            for (int i = 0; i < 8; ++i) { const int kk = 8 * i + kr8;
#pragma unroll
                for (int e = 0; e < 4; ++e) scr[kk * 33 + nq + e] = __builtin_rintf(v[8 * hb + i][e] * qs[e]); }
            LDS_WAIT(); asm volatile("" ::: "memory");
            const int n = lane >> 1, kh = lane & 1; u32x4 o[2];
#pragma unroll
            for (int h2 = 0; h2 < 2; ++h2) { unsigned w4[4];
#pragma unroll
                for (int d = 0; d < 4; ++d) { unsigned wv = 0u;
#pragma unroll
                    for (int e = 0; e < 4; ++e) wv |= ((unsigned)(int)scr[(32 * kh + 16 * h2 + 4 * d + e) * 33 + n] & 255u) << (8 * e);
                    w4[d] = wv; }
                o[h2].x = w4[0]; o[h2].y = w4[1]; o[h2].z = w4[2]; o[h2].w = w4[3]; }
            if (n0 + n < nval) { GAS unsigned char* dst = Wq + (size_t)(drow0 + n) * 1024 + 128 * wave + 64 * hb + 32 * kh; *(GAS u32x4*)dst = o[0]; *(GAS u32x4*)(dst + 16) = o[1]; }
            LDS_WAIT(); asm volatile("" ::: "memory");
        }
        __syncthreads();
    }
}

DI void router_weights(const KA& a, int l, int gw, int NGW, int lane) {
    bf16* Wr = (bf16*)(a.ws + WS_WR);
    const float* wg = a.in[29] + (size_t)l * 1024 * 4; const float* we = a.in[31] + (size_t)l * 1024 * 32;
    for (int n = gw; n < 36; n += NGW) {
        for (int i = 0; i < 16; ++i) { const int k = lane + 64 * i; const float w = (n < 4) ? wg[k * 4 + n] : we[k * 32 + (n - 4)];
            const unsigned hi = f2bf(w); const float hf = __builtin_bit_cast(float, hi << 16); const unsigned lo = f2bf(w - hf);
            Wr[(size_t)n * 2048 + k] = (bf16)hi; Wr[(size_t)n * 2048 + 1024 + k] = (bf16)hi; Wr[(size_t)(64 + n) * 2048 + k] = (bf16)lo; Wr[(size_t)(64 + n) * 2048 + 1024 + k] = 0; }
    }
}

DI void cmp_weights(const KA& a, int l, LAS unsigned char* lds, int gw, int NGW, int wave, int lane) {
    LAS float* scr = (LAS float*)(lds + wave * 16384);
    bf16* Wc = (bf16*)(a.ws + WS_WCMP); float* pt = (float*)(a.ws + WS_CMPAB + 2 * MiB);
    for (int it = gw; it < 128 + 64; it += NGW) {
        if (it < 128) { const int kv = it >> 6, q = it & 63, kb = q >> 1, nb = q & 1; const float* w1 = a.in[kv ? 22 : 19] + (size_t)l * 2048 * 64;
            bf16* dst = Wc + (size_t)kv * 256 * 1024 - (kb >= 16 ? 1024 : 0);
            transpose_item(w1, 64, 64, dst, 1024, kb * 64, nb * 32, (kb >= 16 ? 64 : 0) + nb * 32, scr, lane);
        } else { const int kv = (it - 128) >> 5, part = (it - 128) & 31;
            const GAS float* w1 = (const GAS float*)(a.in[kv ? 22 : 19] + (size_t)l * 2048 * 64) + (size_t)part * 64 * 64; const GAS float* pos = (const GAS float*)(a.in[kv ? 21 : 18] + (size_t)l * 2048) + part * 64;
            float acc = 0.f;
#pragma unroll 16
            for (int k = 0; k < 64; ++k) acc += pos[k] * w1[(size_t)k * 64 + lane];
            pt[(kv * 32 + part) * 64 + lane] = acc; }
    }
}

DI void lru_weights(const KA& a, int l, int gw, int NGW, int lane) {
    bf16* W = (bf16*)(a.ws + WS_LRUW); const float* wa = a.in[7] + (size_t)l * 4 * 4096; const float* wx = a.in[9] + (size_t)l * 4 * 4096;
    (void)NGW; { const int idx = gw * 64 + lane; if (idx < 32768) { const int i = idx & 63, j = (idx >> 6) & 63, mat = (idx >> 12) & 1, hbk = idx >> 13;
        W[idx] = (bf16)f2bf((mat ? wx : wa)[(size_t)hbk * 4096 + i * 64 + j]); } }
}
DI void phase0_rows(const KA& a, int l, int mode, int gw, int NGW, int lane) {
    const GAS float* xin = (const GAS float*)a.in[0]; GAS bf16* xb = (GAS bf16*)(a.ws + WS_XB);
    const GAS bf16* eo = (const GAS bf16*)(a.ws + WS_PROJ);
    GAS float* outp = (GAS float*)a.out;
    const GAS float* g = (const GAS float*)(mode ? a.in[2] : (a.in[3] + (size_t)l * 1024));
    f32x4 gv[2][2];
#pragma unroll
    for (int j = 0; j < 2; ++j) { gv[j][0] = *(const GAS f32x4*)(g + 8 * (lane + 64 * j)); gv[j][1] = *(const GAS f32x4*)(g + 8 * (lane + 64 * j) + 4); }
    for (int m0 = gw * 4; m0 < T; m0 += NGW * 4) {
        f32x4 v[4][2][2]; float ss[4];
        if (l == 0) {
#pragma unroll
            for (int rr = 0; rr < 4; ++rr)
#pragma unroll
                for (int j = 0; j < 2; ++j) { const GAS float* xp = xin + (size_t)(m0 + rr) * 1024 + 8 * (lane + 64 * j); v[rr][j][0] = *(const GAS f32x4*)xp; v[rr][j][1] = *(const GAS f32x4*)(xp + 4); }
        } else {
            u32x4 xw[4][2], e0[4][2], e1[4][2];
#pragma unroll
            for (int rr = 0; rr < 4; ++rr)
#pragma unroll
                for (int j = 0; j < 2; ++j) { const size_t co = 8 * (lane + 64 * j);
                    xw[rr][j] = *(const GAS u32x4*)(xb + (size_t)(m0 + rr) * 1024 + co);
                    e0[rr][j] = *(const GAS u32x4*)(eo + (size_t)(2 * (m0 + rr)) * 1024 + co); e1[rr][j] = *(const GAS u32x4*)(eo + (size_t)(2 * (m0 + rr) + 1) * 1024 + co); }
#pragma unroll
            for (int rr = 0; rr < 4; ++rr)
#pragma unroll
                for (int j = 0; j < 2; ++j) { const u32x4 x4 = xw[rr][j], a4 = e0[rr][j], b4 = e1[rr][j];
                    v[rr][j][0][0] = lo_bf(x4.x) + (lo_bf(a4.x) + lo_bf(b4.x)); v[rr][j][0][1] = hi_bf(x4.x) + (hi_bf(a4.x) + hi_bf(b4.x));
                    v[rr][j][0][2] = lo_bf(x4.y) + (lo_bf(a4.y) + lo_bf(b4.y)); v[rr][j][0][3] = hi_bf(x4.y) + (hi_bf(a4.y) + hi_bf(b4.y));
                    v[rr][j][1][0] = lo_bf(x4.z) + (lo_bf(a4.z) + lo_bf(b4.z)); v[rr][j][1][1] = hi_bf(x4.z) + (hi_bf(a4.z) + hi_bf(b4.z));
                    v[rr][j][1][2] = lo_bf(x4.w) + (lo_bf(a4.w) + lo_bf(b4.w)); v[rr][j][1][3] = hi_bf(x4.w) + (hi_bf(a4.w) + hi_bf(b4.w)); }
        }
#pragma unroll
        for (int rr = 0; rr < 4; ++rr) { float t = 0.f;
#pragma unroll
            for (int j = 0; j < 2; ++j)
#pragma unroll
                for (int h = 0; h < 2; ++h) t += (v[rr][j][h][0] * v[rr][j][h][0] + v[rr][j][h][1] * v[rr][j][h][1]) + (v[rr][j][h][2] * v[rr][j][h][2] + v[rr][j][h][3] * v[rr][j][h][3]);
            ss[rr] = t; }
#pragma unroll
        for (int rr = 0; rr < 4; ++rr) ss[rr] = wave_sum(ss[rr]);
        if (mode) {
#pragma unroll
            for (int rr = 0; rr < 4; ++rr) { const float r = __builtin_amdgcn_rsqf(ss[rr] * (1.f / 1024.f) + 1e-6f); const size_t m = (size_t)(m0 + rr);
#pragma unroll
                for (int j = 0; j < 2; ++j) { GAS float* op = outp + m * 1024 + 8 * (lane + 64 * j); *(GAS f32x4*)op = v[rr][j][0] * r * gv[j][0]; *(GAS f32x4*)(op + 4) = v[rr][j][1] * r * gv[j][1]; } }
        } else {
            GAS unsigned char* hq = (GAS unsigned char*)(a.ws + WS_HQ); GAS float* hsc = (GAS float*)(a.ws + WS_HSC);
            float am[4];
#pragma unroll
            for (int rr = 0; rr < 4; ++rr) { const float r = __builtin_amdgcn_rsqf(ss[rr] * (1.f / 1024.f) + 1e-6f); const size_t m = (size_t)(m0 + rr); float t = 0.f;
#pragma unroll
                for (int j = 0; j < 2; ++j) {
                    if (l > 0) { u32x4 w; w.x = pk2(v[rr][j][0][0], v[rr][j][0][1]); w.y = pk2(v[rr][j][0][2], v[rr][j][0][3]); w.z = pk2(v[rr][j][1][0], v[rr][j][1][1]); w.w = pk2(v[rr][j][1][2], v[rr][j][1][3]);
                        *(GAS u32x4*)(xb + m * 1024 + 8 * (lane + 64 * j)) = w; }
#pragma unroll
                    for (int h = 0; h < 2; ++h) { const f32x4 y = v[rr][j][h] * r * gv[j][h]; v[rr][j][h] = y;
                        t = fmaxf(t, fmaxf(fmaxf(fabsf(y[0]), fabsf(y[1])), fmaxf(fabsf(y[2]), fabsf(y[3])))); } }
                am[rr] = t; }
#pragma unroll
            for (int rr = 0; rr < 4; ++rr) am[rr] = fmaxf(wave_max(am[rr]), 1e-20f);
#pragma unroll
            for (int rr = 0; rr < 4; ++rr) { const size_t m = (size_t)(m0 + rr); const float qs = 127.f * __builtin_amdgcn_rcpf(am[rr]);
                if (lane == 0) hsc[m] = am[rr] * (1.f / 127.f);
#pragma unroll
                for (int j = 0; j < 2; ++j) { u32x2 q2;
#pragma unroll
                    for (int h = 0; h < 2; ++h) { const f32x4 y = v[rr][j][h] * qs;
                        const unsigned q = ((unsigned)(int)__builtin_rintf(y[0]) & 255u) | (((unsigned)(int)__builtin_rintf(y[1]) & 255u) << 8) | (((unsigned)(int)__builtin_rintf(y[2]) & 255u) << 16) | (((unsigned)(int)__builtin_rintf(y[3]) & 255u) << 24);
                        if (h == 0) q2.x = q; else q2.y = q; }
                    *(GAS u32x2*)(hq + m * 1024 + 8 * (lane + 64 * j)) = q2; } }
        }
    }
}

DI int crow(int i, int hh) { return (i & 3) + 8 * (i >> 2) + 4 * hh; }
DI unsigned cvtpk(float lo, float hi) { f32x2 v = {lo, hi}; bf16x2_t b = __builtin_convertvector(v, bf16x2_t); return __builtin_bit_cast(unsigned, b); }
template <int CTRL, int RMASK> DI float dppf(float oldv, float v) { return __builtin_bit_cast(float, __builtin_amdgcn_update_dpp(__builtin_bit_cast(int, oldv), __builtin_bit_cast(int, v), CTRL, RMASK, 0xf, false)); }
template <int CTRL, int RMASK> DI void scan_step(float& a, float& b) {
    const float ap = dppf<CTRL, RMASK>(1.f, a), bp = dppf<CTRL, RMASK>(0.f, b); b = a * bp + b; a = a * ap; }
DI void lru_unit(const KA& a, int l, const GAS bf16* proj, GAS bf16* ys, GAS float* sums, LAS unsigned char* lds, int task, int lane_in, int wave_in, bool final) {
    int lane = lane_in, wave = wave_in; asm volatile("" : "+v"(lane), "+s"(wave));
    const int chunk = task & 31, hbk = (task >> 5) & 3, b = task >> 7;
    const int ts = chunk * 256 + wave * 32; const size_t rowb = (size_t)b * SEQ;
    LAS unsigned char* wl = lds + wave * 16384;
    LAS float* ex = (LAS float*)(lds + LRUEX_OFF); LAS float* cst = (LAS float*)(lds + LRUCST_OFF); LAS float* car = (LAS float*)(lds + LRUCAR_OFF) + wave * 64;
    const int n = lane & 31, hh = lane >> 5;
    const int c = hbk * 64 + lane;
    const GAS float* cw = (const GAS float*)(a.in[5] + (size_t)l * 4 * 256);
    const GAS float* p6 = (const GAS float*)a.in[6]; const GAS float* p8 = (const GAS float*)a.in[8]; const GAS float* p10 = (const GAS float*)a.in[10]; const GAS float* p11 = (const GAS float*)a.in[11];
    const float cw0 = cw[c], cw1 = cw[256 + c], cw2 = cw[512 + c], cw3 = cw[768 + c]; const float cb = p6[l * 256 + c];
    const float k8 = p8[l * 256 + c], k10 = p10[l * 256 + c], k11 = p11[l * 256 + c];
    const GAS bf16* xp = proj + (rowb + ts) * PLD + C_AX + c;
    unsigned short xraw[35];
#pragma unroll
    for (int j = 0; j < 3; ++j) xraw[j] = (ts >= 3 - j) ? *(const GAS unsigned short*)(xp - (3 - j) * PLD) : (unsigned short)0;
#pragma unroll
    for (int j = 0; j < 32; ++j) xraw[3 + j] = *(const GAS unsigned short*)(xp + (size_t)j * PLD);
    const GAS bf16* wt = (const GAS bf16*)(a.ws + WS_LRUW) + (size_t)hbk * 8192;
    bf16x8 afr[4][4];
#pragma unroll
    for (int m = 0; m < 4; ++m)
#pragma unroll
        for (int s4 = 0; s4 < 4; ++s4) afr[m][s4] = *(const GAS bf16x8*)(wt + (size_t)(m >> 1) * 4096 + (32 * (m & 1) + n) * 64 + 8 * hh + 16 * s4);
    f32x2 sv[31]; u32x2 gt2[2][4];
    const GAS bf16* gp = proj + (rowb + ts + n) * PLD + C_AG + hbk * 64;
    if (final) {
        const GAS f32x2* sp = (const GAS f32x2*)(sums + ((size_t)((b * 4 + hbk) * 32) * 64 + lane) * 2);
#pragma unroll
        for (int cc = 0; cc < 31; ++cc) { const int ci = cc < chunk ? cc : 0; sv[cc] = sp[(size_t)ci * 64]; }
#pragma unroll
        for (int mm = 0; mm < 2; ++mm)
#pragma unroll
            for (int g4 = 0; g4 < 4; ++g4) gt2[mm][g4] = *(const GAS u32x2*)(gp + 32 * mm + 8 * g4 + 4 * hh);
    }
    {
        if (wave == 0) { cst[lane] = -1.4426950408889634f * k8; cst[64 + lane] = -1.4426950408889634f * k10; cst[128 + lane] = -8.f * 1.4426950408889634f * softplusf_(-k11); }
        float x3 = __builtin_bit_cast(float, (unsigned)xraw[0] << 16), x2 = __builtin_bit_cast(float, (unsigned)xraw[1] << 16), x1 = __builtin_bit_cast(float, (unsigned)xraw[2] << 16);
#pragma unroll
        for (int j = 0; j < 32; ++j) { const float x0 = __builtin_bit_cast(float, (unsigned)xraw[3 + j] << 16); const float xc = cb + cw0 * x3 + cw1 * x2 + cw2 * x1 + cw3 * x0;
            *(LAS bf16*)(wl + j * 144 + lane * 2) = (bf16)f2bf(xc); *(LAS float*)(wl + 4608 + j * 272 + lane * 4) = xc; x3 = x2; x2 = x1; x1 = x0; }
    }
    f32x16 D[4];
    {
        bf16x8 bfr[4];
        LDS_WAIT();
#pragma unroll
        for (int s4 = 0; s4 < 4; ++s4) bfr[s4] = *(const LAS bf16x8*)(wl + n * 144 + hh * 16 + s4 * 32);
#pragma unroll
        for (int m = 0; m < 4; ++m) {
#pragma unroll
            for (int s4 = 0; s4 < 4; ++s4) {
                if (s4 == 0) { f32x16 z;
#pragma unroll
                    for (int i = 0; i < 16; ++i) z[i] = 0.f;
                    D[m] = MFMA32(afr[m][s4], bfr[s4], z); } else D[m] = MFMA32(afr[m][s4], bfr[s4], D[m]); } }
    }
    __syncthreads();
    const bool t0 = (ts + n) == 0;
#pragma unroll
    for (int mm = 0; mm < 2; ++mm)
#pragma unroll
        for (int g4 = 0; g4 < 4; ++g4) { const int c0 = 32 * mm + 8 * g4 + 4 * hh;
            const f32x4 vba = *(const LAS f32x4*)(cst + c0), vbx = *(const LAS f32x4*)(cst + 64 + c0), vc8 = *(const LAS f32x4*)(cst + 128 + c0);
            const f32x4 vxc = *(const LAS f32x4*)(wl + 4608 + n * 272 + c0 * 4);
            float aa[4], bb[4];
#pragma unroll
            for (int e = 0; e < 4; ++e) { const int i = 4 * g4 + e;
                const float r = __builtin_amdgcn_rcpf(1.f + __builtin_amdgcn_exp2f(D[mm][i] * -1.4426950408889634f + vba[e]));
                const float ig = __builtin_amdgcn_rcpf(1.f + __builtin_amdgcn_exp2f(D[2 + mm][i] * -1.4426950408889634f + vbx[e]));
                const float av = __builtin_amdgcn_exp2f(vc8[e] * r);
                const float mult = t0 ? 1.f : __builtin_amdgcn_sqrtf(fmaxf(1.f - av * av, 0.f));
                aa[e] = av; bb[e] = mult * ig * vxc[e]; }
#define LRU_SCAN_STEP(CTRL) \
                "v_fmac_f32_dpp %4, %4, %0 " CTRL "\n\tv_fmac_f32_dpp %5, %5, %1 " CTRL "\n\tv_fmac_f32_dpp %6, %6, %2 " CTRL "\n\tv_fmac_f32_dpp %7, %7, %3 " CTRL "\n\t" \
                "v_mul_f32_dpp %0, %0, %0 " CTRL "\n\tv_mul_f32_dpp %1, %1, %1 " CTRL "\n\tv_mul_f32_dpp %2, %2, %2 " CTRL "\n\tv_mul_f32_dpp %3, %3, %3 " CTRL "\n\t"
            asm volatile("s_nop 1\n\t"
                LRU_SCAN_STEP("row_shr:1 row_mask:0xf bank_mask:0xf") LRU_SCAN_STEP("row_shr:2 row_mask:0xf bank_mask:0xf") LRU_SCAN_STEP("row_shr:4 row_mask:0xf bank_mask:0xf")
                LRU_SCAN_STEP("row_shr:8 row_mask:0xf bank_mask:0xf") LRU_SCAN_STEP("row_bcast:15 row_mask:0xa bank_mask:0xf")
                : "+v"(aa[0]), "+v"(aa[1]), "+v"(aa[2]), "+v"(aa[3]), "+v"(bb[0]), "+v"(bb[1]), "+v"(bb[2]), "+v"(bb[3]));
#undef LRU_SCAN_STEP
#pragma unroll
            for (int e = 0; e < 4; ++e) { D[mm][4 * g4 + e] = aa[e]; D[2 + mm][4 * g4 + e] = bb[e]; } }
    if (n == 31) {
#pragma unroll
        for (int mm = 0; mm < 2; ++mm)
#pragma unroll
            for (int i = 0; i < 16; ++i) { const int c = 32 * mm + crow(i, hh); ex[(wave * 64 + c) * 2] = D[mm][i]; ex[(wave * 64 + c) * 2 + 1] = D[2 + mm][i]; } }
    __syncthreads();
    if (!final) {
        if (wave == 0) { float hv = 0.f, av = 1.f;
#pragma unroll
            for (int w = 0; w < 8; ++w) { const float A_ = ex[(w * 64 + lane) * 2], H_ = ex[(w * 64 + lane) * 2 + 1]; hv = A_ * hv + H_; av *= A_; }
            GAS float* sp = sums + ((size_t)((b * 4 + hbk) * 32 + chunk) * 64 + lane) * 2; sp[0] = av; sp[1] = hv; }
    } else {
        {   float hv = 0.f;
#pragma unroll
            for (int cc = 0; cc < 31; ++cc) { const float A_ = cc < chunk ? sv[cc][0] : 1.f, H_ = cc < chunk ? sv[cc][1] : 0.f; hv = A_ * hv + H_; }
            for (int w = 0; w < wave; ++w) { const float A_ = ex[(w * 64 + lane) * 2], H_ = ex[(w * 64 + lane) * 2 + 1]; hv = A_ * hv + H_; }
            car[lane] = hv; }
        LDS_WAIT(); asm volatile("" ::: "memory");
        GAS bf16* yp = ys + (rowb + ts + n) * 1024 + hbk * 64;
#pragma unroll
        for (int mm = 0; mm < 2; ++mm)
#pragma unroll
            for (int g4 = 0; g4 < 4; ++g4) { const int c0 = 32 * mm + 8 * g4 + 4 * hh; const f32x4 cv = *(const LAS f32x4*)(car + c0);
                const u32x2 gw2 = gt2[mm][g4]; float y[4];
#pragma unroll
                for (int e = 0; e < 4; ++e) { const int i = 4 * g4 + e; const float hv = D[2 + mm][i] + D[mm][i] * cv[e];
                    const float gt = (e == 0) ? lo_bf(gw2.x) : (e == 1) ? hi_bf(gw2.x) : (e == 2) ? lo_bf(gw2.y) : hi_bf(gw2.y); const float wv = gt * (2.302208198f + 0.102943240f * gt * gt);
                    y[e] = hv * (gt - gt * __builtin_amdgcn_rcpf(__builtin_amdgcn_exp2f(wv) + 1.f)); }
                u32x2 yo; yo.x = cvtpk(y[0], y[1]); yo.y = cvtpk(y[2], y[3]); *(GAS u32x2*)(yp + c0) = yo; }
    }
    __syncthreads();
}

constexpr int DK_STR = 144, DV_STR = 192, DBUF_BYTES = 64 * DK_STR + 64 * DV_STR;
DI bf16x8 pack_half(const f32x16& x, int s2) { u32x4 p;
    if (s2 == 0) { p.x = cvtpk(x[0], x[1]); p.y = cvtpk(x[2], x[3]); p.z = cvtpk(x[4], x[5]); p.w = cvtpk(x[6], x[7]); }
    else { p.x = cvtpk(x[8], x[9]); p.y = cvtpk(x[10], x[11]); p.z = cvtpk(x[12], x[13]); p.w = cvtpk(x[14], x[15]); }
    return __builtin_bit_cast(bf16x8, p); }
DI s16x4 vtr(const LAS unsigned char* p) { return __builtin_bit_cast(s16x4, __builtin_amdgcn_ds_read_tr16_b64_v4i16((LAS v4i16_t*)p)); }
DI float max16(const f32x16& x) { float a = fmaxf(fmaxf(x[0], x[1]), fmaxf(x[2], x[3])), b = fmaxf(fmaxf(x[4], x[5]), fmaxf(x[6], x[7])), c = fmaxf(fmaxf(x[8], x[9]), fmaxf(x[10], x[11])), d = fmaxf(fmaxf(x[12], x[13]), fmaxf(x[14], x[15])); return fmaxf(fmaxf(a, b), fmaxf(c, d)); }
DI void diff_unit(const GAS bf16* proj, GAS bf16* ys, LAS unsigned char* lds, const LAS float* bias2, const GAS float* subg, const LAS float* lamp, int b, int h, int qb, int wave_in) {
    int wave = wave_in; asm volatile("" : "+s"(wave)); const int lane = my_lane(); const int tid = wave * 64 + lane;
    const int q0 = qb * 256 + wave * 32; const int ql = lane & 31, hh = lane >> 5; const int q = q0 + ql;
    const size_t rowb = (size_t)b * SEQ;
    const float SC = 0.17677669529663687f * 1.4426950408889634f;
    bf16x8 qf[2][2];
    { const GAS bf16* qp = proj + (rowb + q) * PLD + C_CQ + h * 64 + hh * 8;
#pragma unroll
      for (int m = 0; m < 2; ++m)
#pragma unroll
        for (int s = 0; s < 2; ++s) { const u32x4 w = *(const GAS u32x4*)(qp + m * 32 + s * 16); u32x4 o;
            o.x = cvtpk(lo_bf(w.x) * SC, hi_bf(w.x) * SC); o.y = cvtpk(lo_bf(w.y) * SC, hi_bf(w.y) * SC); o.z = cvtpk(lo_bf(w.z) * SC, hi_bf(w.z) * SC); o.w = cvtpk(lo_bf(w.w) * SC, hi_bf(w.w) * SC);
            qf[m][s] = __builtin_bit_cast(bf16x8, o); } }
    f32x16 O[2][2], negm[2];
#pragma unroll
    for (int i = 0; i < 16; ++i) { O[0][0][i] = 0.f; O[0][1][i] = 0.f; O[1][0][i] = 0.f; O[1][1][i] = 0.f; negm[0][i] = 120.f; negm[1][i] = 120.f; }
    float lsum[2] = {0.f, 0.f};
    const int nsteps = 4 * qb + 4, mysteps = 4 * qb + (wave >> 1) + 1;
    const int skey = tid >> 3, sch = tid & 7;
    const GAS unsigned char* kgb = (const GAS unsigned char*)(proj + rowb * PLD + C_CK + h * 64);
    const GAS unsigned char* vgb = (const GAS unsigned char*)(proj + rowb * PLD + C_CV + h * 64);
    const unsigned soff = (unsigned)(skey * PLD + sch * 8) * 2u;
    u32x4 kr = *(const GAS u32x4*)(kgb + soff), vr = *(const GAS u32x4*)(vgb + soff);
    *(LAS u32x4*)(lds + skey * DK_STR + sch * 16) = kr; *(LAS u32x4*)(lds + 64 * DK_STR + skey * DV_STR + sch * 16) = vr;
    __syncthreads();
    const int i16 = lane & 15, blk = (lane >> 4) & 1;
    const int kboff = ql * DK_STR + hh * 16;
    const int vboff = 64 * DK_STR + (4 * hh + (i16 >> 2)) * DV_STR + (16 * blk + 4 * (i16 & 3)) * 2;
#pragma unroll 1
    for (int kt = 0; kt < nsteps; ++kt) {
        const LAS unsigned char* cur = lds + (kt & 1) * DBUF_BYTES; LAS unsigned char* nxt = lds + ((kt + 1) & 1) * DBUF_BYTES;
        if (kt + 1 < nsteps) { const unsigned so = soff + (unsigned)(kt + 1) * (64u * PLD * 2u); kr = *(const GAS u32x4*)(kgb + so); vr = *(const GAS u32x4*)(vgb + so); }
        if (kt < mysteps) {
            const int kbase = kt * 64;
            const bool near = (q0 - (kbase + 63) < 113);
#pragma unroll
            for (int m = 0; m < 2; ++m) {
                bf16x8 pk[2][2];
                f32x16 S[2]; float ts = 0.f;
                {   bf16x8 kf[2][2];
#pragma unroll
                    for (int t = 0; t < 2; ++t)
#pragma unroll
                        for (int s = 0; s < 2; ++s) kf[t][s] = *(const LAS bf16x8*)(cur + kboff + t * 32 * DK_STR + m * 64 + s * 32);
#pragma unroll
                    for (int t = 0; t < 2; ++t) { S[t] = MFMA32(kf[t][0], qf[m][0], negm[m]); S[t] = MFMA32(kf[t][1], qf[m][1], S[t]); } }
                if (near) {
#pragma unroll
                    for (int t = 0; t < 2; ++t)
#pragma unroll
                        for (int g = 0; g < 2; ++g) { float tb[8];
#pragma unroll
                            for (int j = 0; j < 8; ++j) { const int dist = q - (kbase + 32 * t + crow(8 * g + j, hh)); const int di = dist < 0 ? 0 : (dist < 128 ? dist : 128); tb[j] = bias2[di * 12 + 4 + h]; }
#pragma unroll
                            for (int j = 0; j < 8; ++j) { const int dist = q - (kbase + 32 * t + crow(8 * g + j, hh)); S[t][8 * g + j] += dist >= 0 ? tb[j] : -1e30f; }
                            __builtin_amdgcn_sched_barrier(0); } }
#pragma unroll
                for (int t = 0; t < 2; ++t)
#pragma unroll
                    for (int i = 0; i < 16; ++i) { const float p = __builtin_amdgcn_exp2f(S[t][i]); S[t][i] = p; ts += p; }
                if (__builtin_amdgcn_ballot_w64(!(ts < 1.0e30f)) != 0ull) {
                {   bf16x8 kf[2][2];
#pragma unroll
                        for (int t = 0; t < 2; ++t)
#pragma unroll
                            for (int s = 0; s < 2; ++s) kf[t][s] = *(const LAS bf16x8*)(cur + kboff + t * 32 * DK_STR + m * 64 + s * 32);
#pragma unroll
                        for (int t = 0; t < 2; ++t) { S[t] = MFMA32(kf[t][0], qf[m][0], negm[m]); S[t] = MFMA32(kf[t][1], qf[m][1], S[t]); } }
                    if (near) {
#pragma unroll
                        for (int t = 0; t < 2; ++t)
#pragma unroll
                            for (int g = 0; g < 2; ++g) { float tb[8];
#pragma unroll
                                for (int j = 0; j < 8; ++j) { const int dist = q - (kbase + 32 * t + crow(8 * g + j, hh)); const int di = dist < 0 ? 0 : (dist < 128 ? dist : 128); tb[j] = bias2[di * 12 + 4 + h]; }
#pragma unroll
                                for (int j = 0; j < 8; ++j) { const int dist = q - (kbase + 32 * t + crow(8 * g + j, hh)); S[t][8 * g + j] += dist >= 0 ? tb[j] : -1e30f; }
                                __builtin_amdgcn_sched_barrier(0); } }
                    float tm = fmaxf(max16(S[0]), max16(S[1])); tm = fmaxf(tm, xshfl<32>(tm));
                    const float sh = fmaxf(tm, 0.f); const float al = __builtin_amdgcn_exp2f(-sh);
                    lsum[m] *= al; ts = 0.f;
#pragma unroll
                    for (int i = 0; i < 16; ++i) { O[m][0][i] *= al; O[m][1][i] *= al; negm[m][i] -= sh; }
#pragma unroll
                    for (int t = 0; t < 2; ++t)
#pragma unroll
                        for (int i = 0; i < 16; ++i) { const float p = __builtin_amdgcn_exp2f(S[t][i] - sh); S[t][i] = p; ts += p; }
                }
                lsum[m] += ts;
#pragma unroll
                for (int t = 0; t < 2; ++t) { pk[t][0] = pack_half(S[t], 0); pk[t][1] = pack_half(S[t], 1); }
#pragma unroll
                for (int t = 0; t < 2; ++t)
#pragma unroll
                    for (int s2 = 0; s2 < 2; ++s2)
#pragma unroll
                        for (int db = 0; db < 2; ++db) {
                            const s16x4 lo = vtr(cur + vboff + (32 * t + 16 * s2) * DV_STR + db * 64), hi = vtr(cur + vboff + (32 * t + 16 * s2 + 8) * DV_STR + db * 64);
                            const bf16x8 vf = __builtin_shufflevector(lo, hi, 0, 1, 2, 3, 4, 5, 6, 7);
                            O[m][db] = MFMA32(vf, pk[t][s2], O[m][db]); }
                ;
            }
        }
        if (kt + 1 < nsteps) { *(LAS u32x4*)(nxt + skey * DK_STR + sch * 16) = kr; *(LAS u32x4*)(nxt + 64 * DK_STR + skey * DV_STR + sch * 16) = vr; }
        __syncthreads();
    }
    const float l0 = lsum[0] + xshfl<32>(lsum[0]), l1 = lsum[1] + xshfl<32>(lsum[1]);
    const float lam = lamp[0], lam_init = lamp[1];
    const float i0 = 1.f / fmaxf(l0, 1e-30f), i1 = lam / fmaxf(l1, 1e-30f);
    float ss = 0.f;
#pragma unroll
    for (int db = 0; db < 2; ++db)
#pragma unroll
        for (int i = 0; i < 16; ++i) { const float at = O[0][db][i] * i0 - O[1][db][i] * i1; O[0][db][i] = at; ss += at * at; }
    ss += xshfl<32>(ss);
    const float r = (1.f - lam_init) / sqrtf(ss * (1.f / 64.f) + 1e-5f);
    GAS bf16* op = ys + (rowb + q) * 1024 + 512 + h * 64;
#pragma unroll
    for (int db = 0; db < 2; ++db)
#pragma unroll
        for (int gq = 0; gq < 4; ++gq) { const int d0 = 32 * db + 8 * gq + 4 * hh; const f32x4 sg = *(const GAS f32x4*)(subg + d0);
            u32x2 w; w.x = cvtpk(O[0][db][4 * gq + 0] * r * sg[0], O[0][db][4 * gq + 1] * r * sg[1]); w.y = cvtpk(O[0][db][4 * gq + 2] * r * sg[2], O[0][db][4 * gq + 3] * r * sg[3]);
            *(GAS u32x2*)(op + d0) = w; }
}

struct SchedCmp { const char* proj; const char* wc; int G, c;
    DI bool next(int i, Unit& u) const { const int L = i * G + c; if (L >= 16) return false; const int kv = L >> 3, rt = L & 7;
        u.pm = rt; u.pn = 0; u.aux = kv; u.pad = 0; u.a = proj + ((size_t)rt * 256 * 16 * PLD + (kv ? C_VC : C_KC)) * 2; u.b = wc + (size_t)kv * 256 * 1024 * 2; return true; } };
struct EpiCmp { static constexpr bool CARRY = false; float* ab;
    DI void operator()(const f32x4 (&acc)[2][2][4][2], const Unit& u, int wr, int wc, int fr, int fq) const {
        const int row0 = u.pm * 256 + wr * 64 + fr; const int col = wc * 32 + 8 * fq;
#pragma unroll
        for (int ai = 0; ai < 2; ++ai)
#pragma unroll
            for (int m = 0; m < 4; ++m) { float* rp = ab + ((size_t)u.aux * 2048 + row0 + ai * 128 + m * 16) * 128 + col; *(f32x4*)rp = acc[ai][0][m][0]; *(f32x4*)(rp + 4) = acc[ai][0][m][1]; }
    }
};
DI void cmp_finish(const KA& a, int l, const float* ab, bf16* kcb, int task, int lane) {
    const int kv = task / (BATCH * NCMP), r = task % (BATCH * NCMP), b = r / NCMP, c = r % NCMP;
    const float* w2 = a.in[kv ? 23 : 20] + (size_t)l * 4096; const float* pt = ab + 2 * 2048 * 128;
    const size_t g = (size_t)kv * 2048 + b * 512 + c;
    float ptv = 0.f;
#pragma unroll
    for (int part = 0; part < 32; ++part) ptv += pt[(kv * 32 + part) * 64 + lane];
    const float h1 = ab[g * 128 + lane] + ab[(g + 1) * 128 + 64 + lane] + ptv;
    const float gl = gelu_tanh(h1); float o = 0.f;
#pragma unroll
    for (int j = 0; j < 64; ++j) o += rl(gl, j) * w2[j * 64 + lane];
    kcb[((size_t)(kv * BATCH + b) * 512 + c) * 64 + lane] = (bf16)f2bf(o);
    if (c == NCMP - 1) kcb[((size_t)(kv * BATCH + b) * 512 + NCMP) * 64 + lane] = 0;
}

DI void cmp_block(const KA& a, int l, const GAS bf16* proj, const GAS bf16* wcT, float* ab, bf16* kcb, int bid, int wave, int lane) {
    const int kv = bid >> 7, g0 = (bid & 127) * 16, r = lane & 15, q = lane >> 4, sh = wave >> 2;
    const int grow = g0 + r + sh; const bool st_ok = !(sh != 0 && (grow & 511) == 0);
    const int gld = grow > 2047 ? 2047 : grow;
    const GAS bf16* apn = proj + (size_t)gld * 16 * PLD + (kv ? C_VC : C_KC) + 8 * q;
    const GAS bf16* bpn = wcT + ((size_t)kv * 256 + wave * 16 + r) * 1024 + 8 * q;
    f32x4 acc = {0.f, 0.f, 0.f, 0.f};
#pragma unroll 16
    for (int s = 0; s < 32; ++s) {
        const bf16x8 av = *(const GAS bf16x8*)(apn + (size_t)(s >> 1) * PLD + 32 * (s & 1));
        const bf16x8 bv = *(const GAS bf16x8*)(bpn + 32 * s);
        acc = __builtin_amdgcn_mfma_f32_16x16x32_bf16(bv, av, acc, 0, 0, 0);
    }
    if (st_ok) *(GAS f32x4*)((GAS float*)ab + ((size_t)kv * 2048 + grow) * 128 + wave * 16 + 4 * q) = acc;
    VM_WAIT(); __syncthreads();
    {   const float* w2 = a.in[kv ? 23 : 20] + (size_t)l * 4096; const float* pt = ab + 2 * 2048 * 128;
        const int ga = g0 + 2 * wave; const size_t gA = (size_t)kv * 2048 + ga;
        float ptp[32], w2v[64], hA[3], hB[3];
#pragma unroll
        for (int part = 0; part < 32; ++part) ptp[part] = pt[(kv * 32 + part) * 64 + lane];
#pragma unroll
        for (int i = 0; i < 2; ++i) { hA[i] = ab[(gA + i) * 128 + lane]; hB[i] = ab[(gA + i + 1) * 128 + 64 + lane]; }
#pragma unroll
        for (int j = 0; j < 64; ++j) w2v[j] = w2[j * 64 + lane];
        float ptv = 0.f;
#pragma unroll
        for (int part = 0; part < 32; ++part) ptv += ptp[part];
#pragma unroll
        for (int i = 0; i < 2; ++i) { const int g = ga + i, c = g & 511, b = g >> 9;
            if (c < NCMP) {
                const float gl = gelu_tanh(hA[i] + hB[i] + ptv); float o = 0.f;
#pragma unroll
                for (int j = 0; j < 64; ++j) o += rl(gl, j) * w2v[j];
                kcb[((size_t)(kv * BATCH + b) * 512 + c) * 64 + lane] = (bf16)f2bf(o);
                if (c == NCMP - 1) kcb[((size_t)(kv * BATCH + b) * 512 + NCMP) * 64 + lane] = 0; } }
    }
}

DI void st_load(const GAS unsigned char* kb, const GAS unsigned char* vb, unsigned off, u32x4& kr, u32x4& vr) { kr = *(const GAS u32x4*)(kb + off); vr = *(const GAS u32x4*)(vb + off); }
DI void st_write(LAS unsigned char* buf, int skey, int sch, const u32x4& kr, const u32x4& vr) { *(LAS u32x4*)(buf + skey * DK_STR + sch * 16) = kr; *(LAS u32x4*)(buf + 64 * DK_STR + skey * DV_STR + sch * 16) = vr; }
DI void qk64(const LAS unsigned char* cur, int kboff, const bf16x8 (&qf)[4], const f32x16& cinit, f32x16 (&S)[2]) {
#pragma unroll
    for (int t = 0; t < 2; ++t) { S[t] = cinit;
#pragma unroll
        for (int s = 0; s < 4; ++s) { const bf16x8 kf = *(const LAS bf16x8*)(cur + kboff + t * 32 * DK_STR + s * 32); S[t] = MFMA32(kf, qf[s], S[t]); } }
}
DI void qk32z(const LAS unsigned char* kt32, const bf16x8 (&qf)[4], f32x16& S) {
#pragma unroll
    for (int s = 0; s < 4; ++s) { const bf16x8 kf = *(const LAS bf16x8*)(kt32 + s * 32);
        if (s == 0) { f32x16 z;
#pragma unroll
            for (int i = 0; i < 16; ++i) z[i] = 0.f;
            S = MFMA32(kf, qf[s], z); } else S = MFMA32(kf, qf[s], S); }
}
DI void pv32(const LAS unsigned char* vt32, const bf16x8 (&pk)[2], f32x16 (&O)[2]) {
#pragma unroll
    for (int s2 = 0; s2 < 2; ++s2)
#pragma unroll
        for (int db = 0; db < 2; ++db) {
            const s16x4 lo = vtr(vt32 + (16 * s2) * DV_STR + db * 64), hi = vtr(vt32 + (16 * s2 + 8) * DV_STR + db * 64);
            const bf16x8 vf = __builtin_shufflevector(lo, hi, 0, 1, 2, 3, 4, 5, 6, 7);
            O[db] = MFMA32(vf, pk[s2], O[db]); }
}
DI void mask_bias_cmp32(f32x16& S, int tcol_in, int cbase, int hh, const LAS float* b2h, float msub) {
    int tcol = tcol_in; asm volatile("" : "+v"(tcol));
#pragma unroll
    for (int g = 0; g < 2; ++g) {
        float bv[8];
#pragma unroll
        for (int j = 0; j < 8; ++j) { const int i = 8 * g + j; const int c = cbase + crow(i, hh); const int dist = tcol - 31 - 16 * c; const int di = dist < 0 ? 0 : (dist < 128 ? dist : 128); bv[j] = b2h[di * 12]; }
#pragma unroll
        for (int j = 0; j < 8; ++j) { const int i = 8 * g + j; const int c = cbase + crow(i, hh); const int dist = tcol - 31 - 16 * c; const bool ok = dist >= 0 && c < NCMP;
            const float sb = S[i] + (bv[j] - msub); S[i] = ok ? sb : -1e30f; }
        __builtin_amdgcn_sched_barrier(0); }
}
DI void pv64(const LAS unsigned char* cur, int vboff, const bf16x8 (&pk)[2][2], f32x16 (&O)[2]) {
#pragma unroll
    for (int t = 0; t < 2; ++t)
#pragma unroll
        for (int s2 = 0; s2 < 2; ++s2)
#pragma unroll
            for (int db = 0; db < 2; ++db) {
                const s16x4 lo = vtr(cur + vboff + (32 * t + 16 * s2) * DV_STR + db * 64), hi = vtr(cur + vboff + (32 * t + 16 * s2 + 8) * DV_STR + db * 64);
                const bf16x8 vf = __builtin_shufflevector(lo, hi, 0, 1, 2, 3, 4, 5, 6, 7);
                O[db] = MFMA32(vf, pk[t][s2], O[db]); }
}
DI void softmax_step(f32x16 (&S)[2], f32x16 (&O)[2], f32x16& negm, float& lsum, bf16x8 (&pk)[2][2]) {
    float tm = fmaxf(max16(S[0]), max16(S[1]));
    if (__builtin_amdgcn_ballot_w64(tm > 8.f) != 0ull) {
        tm = fmaxf(tm, xshfl<32>(tm)); const float sh = fmaxf(tm, 0.f); const float al = __builtin_amdgcn_exp2f(-sh);
        lsum *= al;
#pragma unroll
        for (int i = 0; i < 16; ++i) { O[0][i] *= al; O[1][i] *= al; negm[i] -= sh; S[0][i] -= sh; S[1][i] -= sh; } }
#pragma unroll
    for (int t = 0; t < 2; ++t) {
#pragma unroll
        for (int i = 0; i < 16; ++i) { const float p = __builtin_amdgcn_exp2f(S[t][i]); S[t][i] = p; lsum += p; }
        pk[t][0] = pack_half(S[t], 0); pk[t][1] = pack_half(S[t], 1); }
}
DI void mask_bias(f32x16 (&S)[2], int tcol_in, int kbase, int hh, int W, bool colsel, const LAS float* b2h) {
    int tcol = tcol_in; asm volatile("" : "+v"(tcol));
#pragma unroll
    for (int t = 0; t < 2; ++t)
#pragma unroll
        for (int g = 0; g < 2; ++g) {
            float bv[8];
#pragma unroll
            for (int j = 0; j < 8; ++j) { const int i = 8 * g + j; const int dist = tcol - (kbase + 32 * t + crow(i, hh)); const int di = dist < 0 ? 0 : (dist < 128 ? dist : 128); bv[j] = b2h[di * 12]; }
#pragma unroll
            for (int j = 0; j < 8; ++j) { const int i = 8 * g + j; const int dist = tcol - (kbase + 32 * t + crow(i, hh)); const bool ok = colsel && dist >= 0 && dist < W;
                const float sb = S[t][i] + bv[j]; S[t][i] = ok ? sb : -1e30f; }
            __builtin_amdgcn_sched_barrier(0); }
}
DI void sel_tile(const LAS unsigned char* cur, int kboff, int vboff, const bf16x8 (&qf)[4], f32x16 (&Os)[2], f32x16& negm, float& lsel, bool near, bool bit, int t, int kbase, int hh, int W, const LAS float* b2h) {
    f32x16 S[2]; qk64(cur, kboff, qf, negm, S);
    if (near) mask_bias(S, t, kbase, hh, W, bit, b2h);
    float ts = 0.f;
#pragma unroll
    for (int tt = 0; tt < 2; ++tt)
#pragma unroll
        for (int i = 0; i < 16; ++i) { const float p = __builtin_amdgcn_exp2f(S[tt][i]); S[tt][i] = p; ts += p; }
    ts = bit ? ts : 0.f;
    if (__builtin_amdgcn_ballot_w64(!(ts < 1.0e30f)) != 0ull) {
        qk64(cur, kboff, qf, negm, S);
        if (near) mask_bias(S, t, kbase, hh, W, bit, b2h);
        float tm = fmaxf(max16(S[0]), max16(S[1])); tm = bit ? tm : -1e30f; tm = fmaxf(tm, xshfl<32>(tm));
        const float sh = fmaxf(tm, 0.f); const float al = __builtin_amdgcn_exp2f(-sh);
        lsel *= al; ts = 0.f;
#pragma unroll
        for (int i = 0; i < 16; ++i) { Os[0][i] *= al; Os[1][i] *= al; negm[i] -= sh; }
#pragma unroll
        for (int tt = 0; tt < 2; ++tt)
#pragma unroll
            for (int i = 0; i < 16; ++i) { const float p = __builtin_amdgcn_exp2f(S[tt][i] - sh); S[tt][i] = p; ts += p; }
        ts = bit ? ts : 0.f;
    }
    lsel += ts;
    const unsigned km = bit ? 0xFFFFFFFFu : 0u; bf16x8 pk[2][2];
#pragma unroll
    for (int tt = 0; tt < 2; ++tt)
#pragma unroll
        for (int hf = 0; hf < 2; ++hf) { u32x4 w = __builtin_bit_cast(u32x4, pack_half(S[tt], hf)); w.x &= km; w.y &= km; w.z &= km; w.w &= km; pk[tt][hf] = __builtin_bit_cast(bf16x8, w); }
    pv64(cur, vboff, pk, Os);
}
DI void nsa_unit(const GAS bf16* proj, GAS bf16* ys, const GAS bf16* kcb, LAS unsigned char* lds, const LAS float* bias2, int b, int u, int tid_in, int lane_in, int wave_in) {
    (void)tid_in; (void)lane_in; int wave = wave_in; asm volatile("" : "+s"(wave)); const int lane = my_lane(); const int tid = wave * 64 + lane;
    const int t0 = u * 64; const int col = lane & 31, hh = lane >> 5, tl = col >> 2, head = col & 3;
    const int t = t0 + wave * 8 + tl; const int tw0 = t0 + wave * 8;
    const size_t rowb = (size_t)b * SEQ;
    const LAS float* b2h = bias2 + 8 + head;
    bf16x8 qf[4];
    { const float SC = 0.125f * 1.4426950408889634f; const GAS bf16* qp = proj + (rowb + t) * PLD + C_DQ + head * 64 + hh * 8;
#pragma unroll
      for (int s = 0; s < 4; ++s) { const u32x4 w = *(const GAS u32x4*)(qp + s * 16); u32x4 o;
          o.x = cvtpk(lo_bf(w.x) * SC, hi_bf(w.x) * SC); o.y = cvtpk(lo_bf(w.y) * SC, hi_bf(w.y) * SC); o.z = cvtpk(lo_bf(w.z) * SC, hi_bf(w.z) * SC); o.w = cvtpk(lo_bf(w.w) * SC, hi_bf(w.w) * SC);
          qf[s] = __builtin_bit_cast(bf16x8, o); } }
    const int skey = tid >> 3, sch = tid & 7;
    const int i16 = lane & 15, blk = (lane >> 4) & 1;
    const int kboff = col * DK_STR + hh * 16;
    const int vboff = 64 * DK_STR + (4 * hh + (i16 >> 2)) * DV_STR + (16 * blk + 4 * (i16 & 3)) * 2;
    u32x4 kr, vr;
    const int ncvm = (4 * u + 3) < NCMP ? (4 * u + 3) : NCMP;
    const int nsc = (ncvm + 63) >> 6;
    const GAS unsigned char* kcp = (const GAS unsigned char*)(kcb + (size_t)(0 * BATCH + b) * 512 * 64);
    const GAS unsigned char* vcp = (const GAS unsigned char*)(kcb + (size_t)(1 * BATCH + b) * 512 * 64);
    const unsigned soffc = (unsigned)(skey * 64 + sch * 8) * 2u;
    float m1 = -120.f, l1 = 0.f;
    st_load(kcp, vcp, soffc, kr, vr); st_write(lds, skey, sch, kr, vr); __syncthreads();
#pragma unroll 1
    for (int kt = 0; kt < nsc; ++kt) {
        const LAS unsigned char* cur = lds + (kt & 1) * DBUF_BYTES; LAS unsigned char* nxt = lds + ((kt + 1) & 1) * DBUF_BYTES;
        if (kt + 1 < nsc) st_load(kcp, vcp, soffc + (unsigned)(kt + 1) * 8192u, kr, vr);
#pragma unroll
        for (int tt = 0; tt < 2; ++tt) { f32x16 S; qk32z(cur + kboff + tt * 32 * DK_STR, qf, S); mask_bias_cmp32(S, t, kt * 64 + tt * 32, hh, b2h, 0.f);
          const float tm = max16(S); const float mn = fmaxf(m1, tm); float acc = 0.f;
#pragma unroll
          for (int i = 0; i < 16; ++i) acc += __builtin_amdgcn_exp2f(S[i] - mn);
          l1 = l1 * __builtin_amdgcn_exp2f(m1 - mn) + acc; m1 = mn; }
        if (kt + 1 < nsc) st_write(nxt, skey, sch, kr, vr);
        __syncthreads();
    }
    float mf, inv;
    { const float mo = xshfl<32>(m1), lo = xshfl<32>(l1); mf = fmaxf(m1, mo); const float lf = l1 * __builtin_amdgcn_exp2f(m1 - mf) + lo * __builtin_amdgcn_exp2f(mo - mf); inv = lf > 0.f ? 1.f / lf : 0.f; }
    f32x16 Oc[2], imp[4];
#pragma unroll
    for (int i = 0; i < 16; ++i) { Oc[0][i] = 0.f; Oc[1][i] = 0.f; imp[0][i] = 0.f; imp[1][i] = 0.f; imp[2][i] = 0.f; imp[3][i] = 0.f; }
    {   st_load(kcp, vcp, soffc, kr, vr); st_write(lds, skey, sch, kr, vr); __syncthreads();
#pragma unroll 1
        for (int kt = 0; kt < nsc; ++kt) {
            const LAS unsigned char* cur = lds + (kt & 1) * DBUF_BYTES; LAS unsigned char* nxt = lds + ((kt + 1) & 1) * DBUF_BYTES;
            if (kt + 1 < nsc) st_load(kcp, vcp, soffc + (unsigned)(kt + 1) * 8192u, kr, vr);
#pragma unroll
            for (int tt = 0; tt < 2; ++tt) {
                f32x16 S; qk32z(cur + kboff + tt * 32 * DK_STR, qf, S); mask_bias_cmp32(S, t, kt * 64 + tt * 32, hh, b2h, mf);
#pragma unroll
                for (int i = 0; i < 16; ++i) S[i] = __builtin_amdgcn_exp2f(S[i]) * inv;
                bf16x8 pk[2]; pk[0] = pack_half(S, 0); pk[1] = pack_half(S, 1);
                pv32(cur + vboff + tt * 32 * DV_STR, pk, Oc);
                const int Tq = (2 * kt + tt) & 3, MB = (2 * kt + tt) >> 2;
#pragma unroll
                for (int s2 = 0; s2 < 2; ++s2) { u32x4 aw; unsigned e[8];
#pragma unroll
                    for (int jj = 0; jj < 8; ++jj) { const int kk = 16 * s2 + 8 * (jj >> 2) + 4 * hh + (jj & 3); const int delta = 32 * Tq + kk - 4 * col;
                        e[jj] = (delta == -1 || delta == 3) ? 0x3F80u : ((unsigned)delta <= 2u ? 0x4000u : 0u); }
                    aw.x = e[0] | (e[1] << 16); aw.y = e[2] | (e[3] << 16); aw.z = e[4] | (e[5] << 16); aw.w = e[6] | (e[7] << 16);
                    const bf16x8 af = __builtin_bit_cast(bf16x8, aw);
                    if (MB == 0) imp[0] = MFMA32(af, pk[s2], imp[0]); else if (MB == 1) imp[1] = MFMA32(af, pk[s2], imp[1]); else if (MB == 2) imp[2] = MFMA32(af, pk[s2], imp[2]); else imp[3] = MFMA32(af, pk[s2], imp[3]); }
                if (Tq == 3 && MB < 3) { u32x4 aw; aw.x = 0u; aw.y = 0u; aw.z = 0u; aw.w = (lane == 32) ? 0x3F800000u : 0u;
                    const bf16x8 af = __builtin_bit_cast(bf16x8, aw);
                    if (MB == 0) imp[1] = MFMA32(af, pk[1], imp[1]); else if (MB == 1) imp[2] = MFMA32(af, pk[1], imp[2]); else imp[3] = MFMA32(af, pk[1], imp[3]); }
            }
            if (kt + 1 < nsc) st_write(nxt, skey, sch, kr, vr);
            __syncthreads();
        }
    }
    unsigned ocp[2][8];
#pragma unroll
    for (int db = 0; db < 2; ++db)
#pragma unroll
        for (int i = 0; i < 8; ++i) ocp[db][i] = cvtpk(Oc[db][2 * i], Oc[db][2 * i + 1]);
    unsigned sm0 = 0u, sm1 = 0u, sm2 = 0u, sm3 = 0u;
    {   const int cur_t = t >> 6; unsigned key[16];
#pragma unroll
        for (int i = 0; i < 16; ++i) {
            float v0 = imp[0][i], v1 = imp[1][i], v2 = imp[2][i], v3 = imp[3][i];
            v0 += xshfl<1>(v0); v0 += xshfl<2>(v0); v1 += xshfl<1>(v1); v1 += xshfl<2>(v1); v2 += xshfl<1>(v2); v2 += xshfl<2>(v2); v3 += xshfl<1>(v3); v3 += xshfl<2>(v3);
            const float val = head == 0 ? v0 : (head == 1 ? v1 : (head == 2 ? v2 : v3));
            const int j = 32 * head + crow(i, hh);
            const bool forced = (j == 0) || (j == cur_t) || (j == cur_t - 1);
            unsigned fx = (unsigned)(fminf(fmaxf(val, 0.f), 31.f) * 1048576.f) + 1u;
            fx = forced ? 0x1FFFFFFu : (j <= cur_t ? fx : 0u);
            key[i] = (fx << 7) | (unsigned)(127 - j); }
#pragma unroll 1
        for (int r = 0; r < 16; ++r) {
            unsigned w = key[0];
#pragma unroll
            for (int i = 1; i < 16; ++i) w = w > key[i] ? w : key[i];
            { unsigned o = (unsigned)xshfl_i<1>((int)w); w = w > o ? w : o; o = (unsigned)xshfl_i<2>((int)w); w = w > o ? w : o; o = (unsigned)xshfl_i<32>((int)w); w = w > o ? w : o; }
            if ((w >> 7) != 0u) { const int j = 127 - (int)(w & 127u); const unsigned bit = 1u << (j & 31); const int jb = j >> 5;
                sm0 |= (jb == 0) ? bit : 0u; sm1 |= (jb == 1) ? bit : 0u; sm2 |= (jb == 2) ? bit : 0u; sm3 |= (jb == 3) ? bit : 0u; }
#pragma unroll
            for (int i = 0; i < 16; ++i) key[i] = (key[i] == w) ? 0u : key[i];
        }
    }
    f32x16 Ow[2]; float lw = 0.f;
#pragma unroll
    for (int i = 0; i < 16; ++i) { Ow[0][i] = 0.f; Ow[1][i] = 0.f; }
    {   f32x16 negm;
#pragma unroll
        for (int i = 0; i < 16; ++i) negm[i] = 120.f;
        const GAS unsigned char* kwp = (const GAS unsigned char*)(proj + rowb * PLD + C_KW); const GAS unsigned char* vwp = (const GAS unsigned char*)(proj + rowb * PLD + C_VW);
        const unsigned soffp = (unsigned)(skey * PLD + sch * 8) * 2u;
        const int s0 = (u < 8) ? 8 - u : 0;
        st_load(kwp, vwp, soffp + (unsigned)(u - 8 + s0) * (64u * PLD * 2u), kr, vr); st_write(lds, skey, sch, kr, vr); __syncthreads();
#pragma unroll 1
        for (int s = s0; s < 9; ++s) {
            const int par = (s - s0) & 1; const LAS unsigned char* cur = lds + par * DBUF_BYTES; LAS unsigned char* nxt = lds + (par ^ 1) * DBUF_BYTES;
            if (s + 1 < 9) st_load(kwp, vwp, soffp + (unsigned)(u - 8 + s + 1) * (64u * PLD * 2u), kr, vr);
            sel_tile(cur, kboff, vboff, qf, Ow, negm, lw, s == 0 || s >= 6, true, t, (u - 8 + s) * 64, hh, 512, b2h);
            if (s + 1 < 9) st_write(nxt, skey, sch, kr, vr);
            __syncthreads();
        }
    }
    unsigned owp[2][8];
#pragma unroll
    for (int db = 0; db < 2; ++db)
#pragma unroll
        for (int i = 0; i < 8; ++i) owp[db][i] = cvtpk(Ow[db][2 * i], Ow[db][2 * i + 1]);
    f32x16 Os[2]; float lsel = 0.f;
#pragma unroll
    for (int i = 0; i < 16; ++i) { Os[0][i] = 0.f; Os[1][i] = 0.f; }
    {   f32x16 negm;
#pragma unroll
        for (int i = 0; i < 16; ++i) negm[i] = 120.f;
        const GAS unsigned char* ksp = (const GAS unsigned char*)(proj + rowb * PLD + C_KS); const GAS unsigned char* vsp = (const GAS unsigned char*)(proj + rowb * PLD + C_VS);
        const unsigned soffp = (unsigned)(skey * PLD + sch * 8) * 2u;
        u32x4 kA, vA, kB, vB;
        st_load(ksp, vsp, soffp, kr, vr); st_write(lds, skey, sch, kr, vr);
        if (u >= 1) st_load(ksp, vsp, soffp + 64u * PLD * 2u, kA, vA);
        __syncthreads();
#define SEL_STEP(J, KX, VX, KY, VY) { const int j_ = (J); \
            const LAS unsigned char* cur = lds + (j_ & 1) * DBUF_BYTES; LAS unsigned char* nxt = lds + ((j_ + 1) & 1) * DBUF_BYTES; \
            if (j_ + 2 <= u) st_load(ksp, vsp, soffp + (unsigned)(j_ + 2) * (64u * PLD * 2u), KY, VY); \
            const int jb = j_ >> 5; const unsigned smw = jb == 0 ? sm0 : (jb == 1 ? sm1 : (jb == 2 ? sm2 : sm3)); \
            const bool bit = ((smw >> (j_ & 31)) & 1u) != 0u; \
            if (__builtin_amdgcn_ballot_w64(bit) != 0ull) sel_tile(cur, kboff, vboff, qf, Os, negm, lsel, 64 * j_ + 63 > tw0 - 113, bit, t, 64 * j_, hh, 1 << 30, b2h); \
            if (j_ + 1 <= u) st_write(nxt, skey, sch, KX, VX); \
            __syncthreads(); }
#pragma unroll 1
        for (int j = 0; j <= u; j += 2) {
            SEL_STEP(j, kA, vA, kB, vB)
            if (j + 1 <= u) SEL_STEP(j + 1, kB, vB, kA, vA)
        }
#undef SEL_STEP
    }
    {   const float lwt = lw + xshfl<32>(lw), lst = lsel + xshfl<32>(lsel);
        const GAS bf16* gp = proj + (rowb + t) * PLD + C_DG + head * 3;
        const float g0 = sigmoidf_(bf2f(gp[0])), g1 = sigmoidf_(bf2f(gp[1])) / fmaxf(lst, 1e-30f), g2 = sigmoidf_(bf2f(gp[2])) / fmaxf(lwt, 1e-30f);
        GAS bf16* op = ys + (rowb + t) * 1024 + 768 + head * 64;
#pragma unroll
        for (int db = 0; db < 2; ++db)
#pragma unroll
            for (int gq = 0; gq < 4; ++gq) { const int d0 = 32 * db + 8 * gq + 4 * hh; float y[4];
#pragma unroll
                for (int e = 0; e < 4; ++e) { const unsigned cw = ocp[db][2 * gq + (e >> 1)], ww = owp[db][2 * gq + (e >> 1)];
                    y[e] = g0 * ((e & 1) ? hi_bf(cw) : lo_bf(cw)) + g1 * Os[db][4 * gq + e] + g2 * ((e & 1) ? hi_bf(ww) : lo_bf(ww)); }
                u32x2 w; w.x = cvtpk(y[0], y[1]); w.y = cvtpk(y[2], y[3]); *(GAS u32x2*)(op + d0) = w; }
    }
}


DI void swa_unit(const GAS bf16* proj, GAS bf16* ys, LAS unsigned char* lds, const LAS float* bias2, const LAS float* biasd, const GAS float* sinks, int b, int u, int tid_in, int lane_in, int wave_in) {
    int tid = tid_in, lane = lane_in, wave = wave_in; asm volatile("" : "+v"(tid), "+v"(lane), "+s"(wave));
    const int t0 = u * 64; const int col = lane & 31, hh = lane >> 5, tl = col >> 1, kv = wave & 1, head = 2 * kv + (col & 1);
    const int t = t0 + (wave >> 1) * 16 + tl;
    const size_t rowb = (size_t)b * SEQ;
    const LAS float* b2h = bias2 + head;
    bf16x8 qf[4];
    { const float SC = 0.125f * 1.4426950408889634f; const GAS bf16* qp = proj + (rowb + t) * PLD + C_BQ + head * 64 + hh * 8;
#pragma unroll
      for (int s = 0; s < 4; ++s) { const u32x4 w = *(const GAS u32x4*)(qp + s * 16); u32x4 o;
          o.x = cvtpk(lo_bf(w.x) * SC, hi_bf(w.x) * SC); o.y = cvtpk(lo_bf(w.y) * SC, hi_bf(w.y) * SC); o.z = cvtpk(lo_bf(w.z) * SC, hi_bf(w.z) * SC); o.w = cvtpk(lo_bf(w.w) * SC, hi_bf(w.w) * SC);
          qf[s] = __builtin_bit_cast(bf16x8, o); } }
    const int skey = tid >> 3, sch = tid & 7;
    const int i16 = lane & 15, blk = (lane >> 4) & 1;
    const int kboff = kv * DBUF_BYTES + col * DK_STR + hh * 16;
    const int vboff = kv * DBUF_BYTES + 64 * DK_STR + (4 * hh + (i16 >> 2)) * DV_STR + (16 * blk + 4 * (i16 & 3)) * 2;
    const GAS unsigned char* kp = (const GAS unsigned char*)(proj + rowb * PLD + C_BK); const GAS unsigned char* vp = (const GAS unsigned char*)(proj + rowb * PLD + C_BV);
    const unsigned soffp = (unsigned)(skey * PLD + sch * 8) * 2u;
    u32x4 k0, v0, k1, v1;
    f32x16 O[2], negm; float lsum = 0.f;
#pragma unroll
    for (int i = 0; i < 16; ++i) { O[0][i] = 0.f; O[1][i] = 0.f; negm[i] = 120.f; }
    const int s0 = (u < 2) ? 2 - u : 0;
    { const unsigned so = soffp + (unsigned)(u - 2 + s0) * (64u * PLD * 2u); st_load(kp, vp, so, k0, v0); st_load(kp + 128, vp + 128, so, k1, v1);
      st_write(lds, skey, sch, k0, v0); st_write(lds + DBUF_BYTES, skey, sch, k1, v1); }
    __syncthreads();
#pragma unroll 1
    for (int s = s0; s < 3; ++s) {
        const int par = (s - s0) & 1; const LAS unsigned char* cur = lds + par * 2 * DBUF_BYTES; LAS unsigned char* nxt = lds + (par ^ 1) * 2 * DBUF_BYTES;
        if (s + 1 < 3) { const unsigned so = soffp + (unsigned)(u - 2 + s + 1) * (64u * PLD * 2u); st_load(kp, vp, so, k0, v0); st_load(kp + 128, vp + 128, so, k1, v1); }
        sel_tile(cur, kboff, vboff, qf, O, negm, lsum, true, true, t, (u - 2 + s) * 64, hh, 128, b2h);
        if (s + 1 < 3) { st_write(nxt, skey, sch, k0, v0); st_write(nxt + DBUF_BYTES, skey, sch, k1, v1); }
        __syncthreads();
    }
    {   const float sinkp = (sinks[head] - biasd[128 * 12 + head]) * 1.4426950408889634f;
        const float lt = lsum + xshfl<32>(lsum) + __builtin_amdgcn_exp2f(sinkp + negm[0]);
        const float inv = 1.f / fmaxf(lt, 1e-30f);
        GAS bf16* op = ys + (rowb + t) * 1024 + 256 + head * 64;
#pragma unroll
        for (int db = 0; db < 2; ++db)
#pragma unroll
            for (int gq = 0; gq < 4; ++gq) { const int d0 = 32 * db + 8 * gq + 4 * hh;
                u32x2 w; w.x = cvtpk(O[db][4 * gq + 0] * inv, O[db][4 * gq + 1] * inv); w.y = cvtpk(O[db][4 * gq + 2] * inv, O[db][4 * gq + 3] * inv); *(GAS u32x2*)(op + d0) = w; }
    }
}

DI void route_rows_load(const KA& a, int tok0, int lane, u32x4 (&raw)[4][2]) {
    const GAS bf16* xrow = (const GAS bf16*)(a.ws + WS_XB) + (size_t)tok0 * 1024;
#pragma unroll
    for (int rr = 0; rr < 4; ++rr)
#pragma unroll
        for (int j = 0; j < 2; ++j) raw[rr][j] = *(const GAS u32x4*)(xrow + (size_t)rr * 1024 + 8 * (lane + 64 * j));
}
DI void route_rows4(const u32x4 (&raw)[4][2], const f32x4 (&gvv)[2][2], bf16* xr_, int tok0, int lane) {
    GAS bf16* xr = (GAS bf16*)xr_;
    f32x4 v[4][2][2]; float ss[4];
#pragma unroll
    for (int rr = 0; rr < 4; ++rr)
#pragma unroll
        for (int j = 0; j < 2; ++j) { const u32x4 w = raw[rr][j];
            v[rr][j][0][0] = lo_bf(w.x); v[rr][j][0][1] = hi_bf(w.x); v[rr][j][0][2] = lo_bf(w.y); v[rr][j][0][3] = hi_bf(w.y); v[rr][j][1][0] = lo_bf(w.z); v[rr][j][1][1] = hi_bf(w.z); v[rr][j][1][2] = lo_bf(w.w); v[rr][j][1][3] = hi_bf(w.w); }
#pragma unroll
    for (int rr = 0; rr < 4; ++rr) { float t = 0.f;
#pragma unroll
        for (int j = 0; j < 2; ++j)
#pragma unroll
            for (int h = 0; h < 2; ++h) t += (v[rr][j][h][0] * v[rr][j][h][0] + v[rr][j][h][1] * v[rr][j][h][1]) + (v[rr][j][h][2] * v[rr][j][h][2] + v[rr][j][h][3] * v[rr][j][h][3]);
        ss[rr] = t; }
#pragma unroll
    for (int rr = 0; rr < 4; ++rr) { ss[rr] = wave_sum(ss[rr]); ss[rr] = __builtin_amdgcn_rsqf(ss[rr] * (1.f / 1024.f) + 1e-6f); }
#pragma unroll
    for (int j = 0; j < 2; ++j) { const int k0 = 8 * (lane + 64 * j);
#pragma unroll
        for (int rr = 0; rr < 4; ++rr) { u32x4 wh, wl;
#pragma unroll
            for (int h = 0; h < 2; ++h) { const f32x4 xn = v[rr][j][h] * ss[rr] * gvv[j][h];
                const unsigned h0 = pk2(xn[0], xn[1]), h1 = pk2(xn[2], xn[3]);
                const unsigned l0 = pk2(xn[0] - __builtin_bit_cast(float, h0 << 16), xn[1] - __builtin_bit_cast(float, h0 & 0xFFFF0000u));
                const unsigned l1 = pk2(xn[2] - __builtin_bit_cast(float, h1 << 16), xn[3] - __builtin_bit_cast(float, h1 & 0xFFFF0000u));
                if (h == 0) { wh.x = h0; wh.y = h1; wl.x = l0; wl.y = l1; } else { wh.z = h0; wh.w = h1; wl.z = l0; wl.w = l1; } }
            *(GAS u32x4*)(xr + (size_t)(tok0 + rr) * 2048 + k0) = wh; *(GAS u32x4*)(xr + (size_t)(tok0 + rr) * 2048 + 1024 + k0) = wl; } }
}
struct SchedRoute { const char* A; const char* B; int pm;
    DI bool next(int i, Unit& u) const { if (i > 0) return false; u.pm = pm; u.pn = 0; u.aux = 0; u.pad = 0; u.a = A + (size_t)pm * 128 * 2048 * 2; u.b = B; return true; } };
struct EpiRoute { static constexpr bool CARRY = false; float* rlog;
    DI void operator()(const f32x4 (&acc)[2][2][4][2], const Unit& u, int wr, int wc, int fr, int fq) const {
        const int row0 = u.pm * 128 + wr * 64 + fr; const int col = wc * 32 + 8 * fq;
#pragma unroll
        for (int m = 0; m < 4; ++m) { float* rp = rlog + (size_t)(row0 + m * 16) * 128 + col; *(f32x4*)rp = acc[0][0][m][0]; *(f32x4*)(rp + 4) = acc[0][0][m][1]; }
    }
};
DI void route_decide(const KA& a, int l, const float* rl_row, int& oe0, int& oe1, float& ow0, float& ow1) {
    float lg[36];
    const float* bg = a.in[30] + l * 4; const float* be = a.in[32] + l * 32;
#pragma unroll
    for (int q = 0; q < 9; ++q) { const f32x4 h = *(const f32x4*)(rl_row + 4 * q), lo = *(const f32x4*)(rl_row + 64 + 4 * q);
        lg[4 * q + 0] = h[0] + lo[0]; lg[4 * q + 1] = h[1] + lo[1]; lg[4 * q + 2] = h[2] + lo[2]; lg[4 * q + 3] = h[3] + lo[3]; }
#pragma unroll
    for (int i = 0; i < 4; ++i) lg[i] += bg[i];
#pragma unroll
    for (int i = 0; i < 32; ++i) lg[4 + i] += be[i];
    int gsel = 0; float gm = lg[0];
#pragma unroll
    for (int i = 1; i < 4; ++i) if (lg[i] > gm) { gm = lg[i]; gsel = i; }
    float gs = 0.f;
#pragma unroll
    for (int i = 0; i < 4; ++i) gs += __expf(lg[i] - gm);
    const float gwt = 1.f / gs;
    float v8[8];
#pragma unroll
    for (int i = 0; i < 8; ++i) { float x = lg[4 + i];
#pragma unroll
        for (int gq = 1; gq < 4; ++gq) x = (gsel == gq) ? lg[4 + gq * 8 + i] : x;
        v8[i] = x; }
    int i0 = 0; float m0 = v8[0];
#pragma unroll
    for (int i = 1; i < 8; ++i) if (v8[i] > m0) { m0 = v8[i]; i0 = i; }
    int i1 = -1; float m1 = -3e38f;
#pragma unroll
    for (int i = 0; i < 8; ++i) if (i != i0 && v8[i] > m1) { m1 = v8[i]; i1 = i; }
    if (i1 < 0) i1 = (i0 == 0) ? 1 : 0;
    const float w0 = 1.f / (1.f + __expf(m1 - m0)); const float w1 = 1.f - w0;
    const int e0 = gsel * 8 + i0, e1 = gsel * 8 + i1;
    oe0 = e0; oe1 = e1; ow0 = w0 * gwt; ow1 = w1 * gwt;
}
DI void expert_weights(const KA& a, int l, LAS unsigned char* lds, int it0, int it1, int gw, int NGW, int wave, int lane) {
    LAS float* scr = (LAS float*)(lds + wave * 16384);
    const float* wgt = a.in[33] + (size_t)l * 32 * 1024 * 256; const float* wup = a.in[34] + (size_t)l * 32 * 1024 * 256; const float* wdn = a.in[35] + (size_t)l * 32 * 256 * 1024;
    bf16* Wgu = (bf16*)(a.ws + WS_WGU); bf16* Wd = (bf16*)(a.ws + WS_WD);
    constexpr int I_E = 16 * 4, I_D = 4 * 16;
    const int nq = 4 * (lane & 15), kr4 = lane >> 4;
    for (int it = it0 + gw; it < it1; it += NGW) {
        const int e = it / (2 * I_E + I_D); int r = it % (2 * I_E + I_D);
        const GAS float* src; GAS bf16* dst; int ldw, ldt;
        if (r < 2 * I_E) { const int up = r / I_E, q = r % I_E, kb = q / 4, nb = q % 4; const int n0 = nb * 64;
            const int drow = (n0 >> 7) * 256 + up * 128 + (n0 & 127);
            src = (const GAS float*)((up ? wup : wgt) + (size_t)e * 1024 * 256) + (size_t)(kb * 64) * 256 + n0; ldw = 256;
            dst = (GAS bf16*)(Wgu + (size_t)e * 512 * 1024) + (size_t)drow * 1024 + kb * 64; ldt = 1024;
        } else { r -= 2 * I_E; const int kb = r / 16, nb = r % 16;
            src = (const GAS float*)(wdn + (size_t)e * 256 * 1024) + (size_t)(kb * 64) * 1024 + nb * 64; ldw = 1024;
            dst = (GAS bf16*)(Wd + (size_t)e * 1024 * 256) + (size_t)(nb * 64) * 256 + kb * 64; ldt = 256; }
        f32x4 v[16];
#pragma unroll
        for (int i = 0; i < 16; ++i) v[i] = *(const GAS f32x4*)(src + (size_t)(4 * i + kr4) * ldw + nq);
#pragma unroll
        for (int hn = 0; hn < 2; ++hn) {
            if (((lane >> 3) & 1) == hn) {
#pragma unroll
                for (int i = 0; i < 16; ++i) { const int kk = 4 * i + kr4;
#pragma unroll
                    for (int e2 = 0; e2 < 4; ++e2) scr[kk * 33 + (nq & 31) + e2] = v[i][e2]; } }
            LDS_WAIT(); asm volatile("" ::: "memory");
            const int c = lane & 7;
#pragma unroll
            for (int j = 0; j < 4; ++j) { const int n = (lane >> 3) + 8 * j; const LAS float* sp = scr + (8 * c) * 33 + n;
                u32x4 o; o.x = pk2(sp[0 * 33], sp[1 * 33]); o.y = pk2(sp[2 * 33], sp[3 * 33]); o.z = pk2(sp[4 * 33], sp[5 * 33]); o.w = pk2(sp[6 * 33], sp[7 * 33]);
                *(GAS u32x4*)(dst + (size_t)(32 * hn + n) * ldt + 8 * c) = o; }
            LDS_WAIT(); asm volatile("" ::: "memory");
        }
    }
}
DI void build_offsets(const unsigned* cnt, LAS int* offt, int tid) {
    int c = 0;
    if (tid < 32) { c = (int)__hip_atomic_load(cnt + tid * CNT_STRIDE, __ATOMIC_RELAXED, __HIP_MEMORY_SCOPE_AGENT); offt[330 + tid] = (c + 255) & ~255; }
    __syncthreads();
    if (tid == 0) { int o = 0;
#pragma unroll
        for (int e = 0; e < 32; ++e) { offt[e] = o; o += offt[330 + e]; } offt[32] = o; }
    __syncthreads();
    if (tid < 32) offt[330 + tid] = c;
    for (int rt = tid; rt < (MOE_ROWS >> 8); rt += 512) { int e = 0; for (int j = 1; j < 32; ++j) e += (offt[j] <= rt * 256) ? 1 : 0; offt[40 + rt] = e; }
    __syncthreads();
}

template <unsigned PM>
__global__ void __launch_bounds__(512, 2) mk_fwd(Args a_) {
    extern __shared__ __attribute__((aligned(16))) unsigned char lds_raw[];
    LAS unsigned char* lds = (LAS unsigned char*)lds_raw;
    const int wave0 = __builtin_amdgcn_readfirstlane((int)threadIdx.x >> 6);
    if (threadIdx.x < 36) ((LAS unsigned long long*)(lds + PTAB_OFF))[threadIdx.x] = (unsigned long long)a_.in[threadIdx.x];
    __syncthreads();
    KA a; a.in.base = (unsigned)(size_t)(lds + PTAB_OFF); a.out = a_.out; a.ws = a_.ws;
    const int G = gridDim.x, bid = blockIdx.x, NGW = G * 8;
#define PHASE_IDS() int wave = wave0; asm volatile("" : "+s"(wave)); const int lane = my_lane(); const int tid_ = wave * 64 + lane, gw = bid * 8 + wave; (void)tid_; (void)gw; \
    const int xb = ((bid & 7) << 5) | (bid >> 3); (void)xb;        \
    KA ap = a; asm volatile("" : "+s"(ap.ws), "+s"(ap.out), "+s"(ap.in.base)); \
    bf16* hb = (bf16*)(ap.ws + WS_HB); bf16* proj = (bf16*)(ap.ws + WS_PROJ); bf16* gates = (bf16*)(ap.ws + WS_GATES); \
    bf16* ys = hb; bf16* x2b = hb; bf16* merged = proj; bf16* eo = proj; \
    bf16* kcb = (bf16*)(ap.ws + WS_KCVC); float* lrusum = (float*)(ap.ws + WS_LRUSUM); \
    int* rec_e = (int*)(ap.ws + WS_REC); int* rec_slot = rec_e + T * 2; float* rec_w = (float*)(rec_slot + T * 2); \
    int* rowtok = (int*)(ap.ws + WS_ROWTOK); float* roww = (float*)(ap.ws + WS_ROWW); \
    bf16* xs = (bf16*)(ap.ws + WS_XS); bf16* hmid = (bf16*)(ap.ws + WS_HMID); unsigned* ctl = (unsigned*)(ap.ws + WS_CTL); \
    (void)hb; (void)proj; (void)gates; (void)ys; (void)x2b; (void)merged; (void)eo; (void)kcb; (void)lrusum; (void)rec_e; (void)rec_slot; (void)rec_w; (void)rowtok; (void)roww; (void)xs; (void)hmid; (void)ctl
    volatile LAS unsigned* MISC = (volatile LAS unsigned*)(lds + MISC_OFF);
    LAS float* biasd = (LAS float*)(lds + BIAS_OFF);
    LAS int* offt = (LAS int*)(lds + OFFT_OFF);
    { PHASE_IDS();
    if (tid_ < 64) MISC[tid_] = 0u;
    for (int i = tid_; i < 129 * 12; i += 512) { const int d = i / 12, hd = i % 12; const int bk = d < 128 ? T5_BUCKET[d] : 31; const float* rb = a.in[1]; biasd[i] = rb[bk * 12 + hd]; ((LAS float*)(lds + BIAS2_OFF))[i] = (rb[bk * 12 + hd] - rb[31 * 12 + hd]) * 1.4426950408889634f; } }
    __syncthreads();
    const int lo = a_.ph_lo, hi = a_.ph_hi;
    XcdBarrier bar; bar.bar = (unsigned*)(a.ws + WS_CTL) + CW_BAR; bar.x = 0; bar.st = nullptr;
    if (hi - lo > 1) { PHASE_IDS(); bar = xcd_barrier_post(ctl + CW_BAR, MISC + 8, tid_ == 0); }
#ifndef SUB_MASK
#define SUB_MASK 0xFFu
#endif
#define SUB(k) ((SUB_MASK >> (k)) & 1u)
#define HASP(k) ((PM >> ((k) % PPL + ((k) >= 2 * PPL ? PPL : 0))) & 1u)
#define IN(k) (HASP(k) && lo <= (k) && (k) < hi)
#define SEAM(k) do { if ((k) + 1 < hi) { const int sl_ = my_lane(); int sw_ = wave0; asm volatile("" : "+s"(sw_)); xcd_barrier(bar, sw_ == 0 && sl_ == 0); } } while (0)
    for (int l = 0; l < DEPTH; ++l) {
        const int pb = l * PPL;
        if (IN(pb + 0)) { PHASE_IDS(); p1_weights_i8(ap, l, lds, bid, G, wave, lane); router_weights(ap, l, gw, NGW, lane); lru_weights(ap, l, gw, NGW, lane); cmp_weights(ap, l, lds, gw, NGW, wave, lane); phase0_weights(ap, l, lds, gw, NGW, wave, lane); phase0_rows(ap, l, 0, gw, NGW, lane); SEAM(pb + 0); }
        if (IN(pb + 1)) {
            PHASE_IDS();
            {   int K1q = 512; asm volatile("" : "+s"(K1q));
                pg8::Gemm g{K1q, 512, 512, 128, -1}; SchedP1 S{(const char*)(ap.ws + WS_HQ), (const char*)(ap.ws + WS_WQ), 128, 26, 1024, 1024, G, bid};
                EpiP1I8 E{proj, (unsigned char*)gates, ap.in[25] + (size_t)l * 4096, (const float*)(ap.ws + WS_HSC), (const float*)(ap.ws + WS_WSC)};
                pg8::gemm_phase<EpiP1I8, SchedP1, false, true>(lds, g, S, E, tid_); }
            SEAM(pb + 1);
        }
        if (IN(pb + 2)) {
            PHASE_IDS();
            LAS float* lamp = (LAS float*)(lds + MISC_OFF + 64);
            if (tid_ < 64) { const float* q1 = ap.in[13] + l * 32; const float* k1 = ap.in[14] + l * 32; const float* q2 = ap.in[15] + l * 32; const float* k2 = ap.in[16] + l * 32;
                float s1 = (lane < 32) ? q1[lane] * k1[lane] : 0.f, s2 = (lane < 32) ? q2[lane] * k2[lane] : 0.f; s1 = wave_sum(s1); s2 = wave_sum(s2);
                const float lam_init = 0.8f - 0.6f * __expf(-0.3f * (float)l); if (lane == 0) { lamp[0] = __expf(s1) - __expf(s2) + lam_init; lamp[1] = lam_init; } }
            __syncthreads();
            if (SUB(0)) { const LAS float* bias2 = (const LAS float*)(lds + BIAS2_OFF); const GAS float* subg = (const GAS float*)(ap.in[17] + l * 64);
                for (int pi = xb; pi < 256; pi += G) { const int bh = pi >> 4, qlo = pi & 15;
                    diff_unit((const GAS bf16*)proj, (GAS bf16*)ys, lds, bias2, subg, lamp, bh >> 2, bh & 3, 31 - qlo, wave);
                    diff_unit((const GAS bf16*)proj, (GAS bf16*)ys, lds, bias2, subg, lamp, bh >> 2, bh & 3, qlo, wave); } }
            { PHASE_IDS();
            if (SUB(3)) { __syncthreads(); const LAS float* bias2 = (const LAS float*)(lds + BIAS2_OFF); const GAS float* sinks = (const GAS float*)(ap.in[12] + l * 4);
                for (int pi = xb; pi < 512; pi += G) swa_unit((const GAS bf16*)proj, (GAS bf16*)ys, lds, bias2, biasd, sinks, pi >> 7, pi & 127, tid_, lane, wave); }
            if (SUB(2)) cmp_block(ap, l, (const GAS bf16*)proj, (const GAS bf16*)(ap.ws + WS_WCMP), (float*)(ap.ws + WS_CMPAB), kcb, bid, wave, lane);
            if (SUB(1)) { __syncthreads(); for (int task = xb; task < 512; task += G) lru_unit(ap, l, (const GAS bf16*)proj, (GAS bf16*)ys, (GAS float*)lrusum, lds, task, lane, wave, false); }
            }
            SEAM(pb + 2);
        }
        if (IN(pb + 4)) {
            PHASE_IDS();
            for (int task = xb; task < 512; task += G) lru_unit(ap, l, (const GAS bf16*)proj, (GAS bf16*)ys, (GAS float*)lrusum, lds, task, lane, wave, true);
            __syncthreads();
            if (SUB(4)) { const LAS float* bias2 = (const LAS float*)(lds + BIAS2_OFF);
                for (int pi = xb; pi < 256; pi += G) { const int bb = pi >> 6, ulo = pi & 63;
                    nsa_unit((const GAS bf16*)proj, (GAS bf16*)ys, (const GAS bf16*)kcb, lds, bias2, bb, 127 - ulo, tid_, lane, wave);
                    nsa_unit((const GAS bf16*)proj, (GAS bf16*)ys, (const GAS bf16*)kcb, lds, bias2, bb, ulo, tid_, lane, wave); } }
            SEAM(pb + 4);
        }
        if (IN(pb + 5)) {
            PHASE_IDS();
            int K5 = 256; asm volatile("" : "+s"(K5));
            pg8::Gemm g{K5, 1024, 256, 128, -1}; SchedP3a S{(const char*)ys, (const char*)(ap.ws + WS_WBR), G, xb};
            EpiP3a E{merged, (const unsigned char*)gates};
            pg8::gemm_phase<EpiP3a, SchedP3a>(lds, g, S, E, tid_); SEAM(pb + 5);
        }
        if (IN(pb + 6)) {
            PHASE_IDS();
            int K6 = 1024; asm volatile("" : "+s"(K6));
            pg8::Gemm g{K6, 1024, 1024, 128, -1}; SchedP3b S{(const char*)merged, (const char*)(ap.ws + WS_WOUT), G, xb};
            if (l == 0) { EpiP3b<true> E{ap.in[0], (bf16*)(ap.ws + WS_XB)}; pg8::gemm_phase<EpiP3b<true>, SchedP3b>(lds, g, S, E, tid_); }
            else { EpiP3b<false> E{nullptr, (bf16*)(ap.ws + WS_XB)}; pg8::gemm_phase<EpiP3b<false>, SchedP3b>(lds, g, S, E, tid_); }
            SEAM(pb + 6);
        }
        if (IN(pb + 7)) {
            PHASE_IDS();
            bf16* xr = (bf16*)(ap.ws + WS_XR); float* rlog = (float*)(ap.ws + WS_RLOG);
            constexpr int NITW = 32 * (2 * 16 * 4 + 4 * 16);
            { const int pm = bid;
                f32x4 gvv[2][2]; { const GAS float* g28 = (const GAS float*)(ap.in[28] + (size_t)l * 1024);
#pragma unroll
                    for (int j = 0; j < 2; ++j) { gvv[j][0] = *(const GAS f32x4*)(g28 + 8 * (lane + 64 * j)); gvv[j][1] = *(const GAS f32x4*)(g28 + 8 * (lane + 64 * j) + 4); } }
                {   u32x4 rw[4][4][2];
#pragma unroll
                    for (int q4 = 0; q4 < 4; ++q4) route_rows_load(ap, pm * 128 + wave * 4 + 32 * q4, lane, rw[q4]);
#pragma unroll
                    for (int q4 = 0; q4 < 4; ++q4) route_rows4(rw[q4], gvv, xr, pm * 128 + wave * 4 + 32 * q4, lane); }
                asm volatile("s_waitcnt vmcnt(0)" ::: "memory"); __syncthreads();
                { pg8::Gemm g{2048, 2048, 2048, 128, 0}; SchedRoute S{(const char*)xr, (const char*)(ap.ws + WS_WR), pm}; EpiRoute E{rlog};
                  pg8::gemm_phase<EpiRoute, SchedRoute>(lds, g, S, E, tid_); }
                asm volatile("s_waitcnt vmcnt(0)" ::: "memory"); __syncthreads();
                {
                    LAS unsigned* lc = (LAS unsigned*)(lds + 64);
                    if (tid_ < 32) lc[tid_] = 0u;
                    int e0 = 0, e1 = 0; float w0 = 0.f, w1 = 0.f; unsigned r0 = 0u, r1 = 0u;
                    if (tid_ < 128) route_decide(ap, l, rlog + (size_t)(pm * 128 + tid_) * 128, e0, e1, w0, w1);
                    __syncthreads();
                    if (tid_ < 128) { r0 = __hip_atomic_fetch_add(lc + e0, 1u, __ATOMIC_RELAXED, __HIP_MEMORY_SCOPE_WORKGROUP); r1 = __hip_atomic_fetch_add(lc + e1, 1u, __ATOMIC_RELAXED, __HIP_MEMORY_SCOPE_WORKGROUP); }
                    __syncthreads();
                    if (tid_ < 32) { const unsigned c = lc[tid_]; lc[32 + tid_] = c ? __hip_atomic_fetch_add(ctl + CW_CNT + (l * 32 + tid_) * CNT_STRIDE, c, __ATOMIC_RELAXED, __HIP_MEMORY_SCOPE_AGENT) : 0u; }
                    __syncthreads();
                    if (tid_ < 128) { const int tok = pm * 128 + tid_; const int s0 = (int)(lc[32 + e0] + r0), s1 = (int)(lc[32 + e1] + r1);
                        int* inv_as = (int*)(ap.ws + WS_INVAS); float* inv_w = (float*)(ap.ws + WS_INVW);
                        inv_as[e0 * 32768 + s0] = tok * 2; inv_w[e0 * 32768 + s0] = w0; inv_as[e1 * 32768 + s1] = tok * 2 + 1; inv_w[e1 * 32768 + s1] = w1; }
                    __syncthreads();
                }
            }
            expert_weights(ap, l, lds, 0, NITW, gw, NGW, wave, lane);
            SEAM(pb + 7);
        }
        if (IN(pb + 9)) {
            PHASE_IDS();
            build_offsets(ctl + CW_CNT + l * 32 * CNT_STRIDE, offt, tid_);
            int K9 = 1024; asm volatile("" : "+s"(K9));
            pg8::Gemm g{K9, 2048, 1024, 128, -1}; SchedM2 S{(const char*)(ap.ws + WS_XR), (const char*)(ap.ws + WS_WGU), offt, (const int*)(ap.ws + WS_INVAS), G, xb};
            EpiM2 E{hmid};
            pg8::gemm_phase<EpiM2, SchedM2, true>(lds, g, S, E, tid_); SEAM(pb + 9);
        }
        if (IN(pb + 10)) {
            PHASE_IDS();
            build_offsets(ctl + CW_CNT + l * 32 * CNT_STRIDE, offt, tid_);
            int K3 = 256; asm volatile("" : "+s"(K3));
            pg8::Gemm g{K3, 256, 256, 128, -1}; SchedM3 S{(const char*)hmid, (const char*)(ap.ws + WS_WD), offt, G, xb};
            EpiM3 E{eo, (const int*)(ap.ws + WS_INVAS), (const float*)(ap.ws + WS_INVW), offt};
            pg8::gemm_phase<EpiM3, SchedM3>(lds, g, S, E, tid_); SEAM(pb + 10);
        }
    }
    if (IN(2 * PPL)) { PHASE_IDS(); phase0_rows(ap, DEPTH, 1, gw, NGW, lane); }
#undef IN
#undef SEAM
}

typedef void (*kern_t)(Args);
template <unsigned PM> static bool setup_kernel() {
    if (hipFuncSetAttribute((const void*)mk_fwd<PM>, hipFuncAttributeMaxDynamicSharedMemorySize, LDS_BYTES) != hipSuccess) { fprintf(stderr, "kernel_launch: hipFuncSetAttribute failed\n"); return false; }
    return true;
}
extern "C" void kernel_launch(void* const* d_in, const int* in_sizes, int n_in, void* d_out, int out_size, void* d_ws, size_t ws_size, hipStream_t stream) {
    static int grid = 0;
    if (grid == 0) {
        if (n_in != 36 || out_size != T * D || ws_size < WS_END) { fprintf(stderr, "kernel_launch: unexpected shapes (n_in %d out %d ws %zu)\n", n_in, out_size, ws_size); grid = -1; return; }
        int dev = 0, cus = 0;
        if (hipGetDevice(&dev) != hipSuccess || hipDeviceGetAttribute(&cus, hipDeviceAttributeMultiprocessorCount, dev) != hipSuccess) { grid = -1; return; }
        bool ok = true;
#if MK_ONE_LAUNCH
        ok = setup_kernel<0xFFFu>();
#endif
        if (!ok) { grid = -1; return; }
        (void)hipGetLastError();
        grid = cus;
        if (grid != 256) { fprintf(stderr, "kernel_launch: built for a 256-CU device (got %d)\n", cus); grid = -1; return; }
    }
    if (grid < 0) return;
    if (hipMemsetAsync((char*)d_ws + WS_CTL, 0, CTL_ZERO_BYTES, stream) != hipSuccess) return;
    Args a{};
    for (int i = 0; i < 36; ++i) a.in[i] = (const float*)d_in[i];
    a.out = (float*)d_out; a.ws = (unsigned char*)d_ws;
#if MK_ONE_LAUNCH
    a.ph_lo = 0; a.ph_hi = NPH;
    hipLaunchKernelGGL(mk_fwd<0xFFFu>, dim3(grid), dim3(512), LDS_BYTES, stream, a);
#endif
}
```

```cpp
#include <hip/hip_runtime.h>
#include <cstdio>
#include <cstdint>

#ifndef MK_ONE_LAUNCH
#define MK_ONE_LAUNCH 1
#endif

#define DI __device__ __forceinline__
#define GAS __attribute__((address_space(1)))
#define LAS __attribute__((address_space(3)))
typedef unsigned short bf16;
typedef short bf16x8 __attribute__((ext_vector_type(8)));
typedef float f32x4 __attribute__((ext_vector_type(4)));
typedef int i32x4 __attribute__((ext_vector_type(4)));
typedef unsigned u32x4 __attribute__((ext_vector_type(4)));
typedef unsigned u32x2 __attribute__((ext_vector_type(2)));
typedef float f32x16 __attribute__((ext_vector_type(16)));
typedef float f32x2 __attribute__((ext_vector_type(2)));
typedef short s16x4 __attribute__((ext_vector_type(4)));
typedef __bf16 bf16x2_t __attribute__((ext_vector_type(2)));
typedef short v4i16_t __attribute__((__vector_size__(4 * sizeof(short))));
#define MFMA32(a, b, c) __builtin_amdgcn_mfma_f32_32x32x16_bf16((a), (b), (c), 0, 0, 0)

constexpr int BATCH = 4, SEQ = 8192, T = BATCH * SEQ, D = 1024, DEPTH = 2;
constexpr int NIN = 2444, PLD = 2560, N1 = 6656, GLD = 4096;
constexpr size_t PGS = (size_t)32768 * 64;
constexpr int C_AX = 0, C_AG = 256, C_BQ = 512, C_BK = 768, C_BV = 896, C_CQ = 1024, C_CK = 1280, C_CV = 1536, C_DQ = 1792,
              C_KC = 2048, C_VC = 2112, C_KS = 2176, C_VS = 2240, C_KW = 2304, C_VW = 2368, C_DG = 2432;
constexpr int NCMP = 511;
constexpr int MOE_ROWS = 73728;
constexpr int PPL = 11;
constexpr int NPH = 2 * PPL + 1;

constexpr size_t MiB = 1u << 20;
constexpr size_t WS_CTL = 0, CTL_ZERO_BYTES = 128 * 1024;
constexpr size_t WS_KCVC = 1 * MiB;
constexpr size_t WS_LRUSUM = 2 * MiB;
constexpr size_t WS_REC = 2 * MiB + 256 * 1024;
constexpr size_t WS_ROWTOK = 3 * MiB;
constexpr size_t WS_ROWW = 3 * MiB + 512 * 1024;
constexpr size_t WS_WIN = 4 * MiB;
constexpr size_t WS_WQ = 4 * MiB;
constexpr size_t WS_WSC = 13 * MiB;
constexpr size_t WS_HSC = 13 * MiB + 65536;
constexpr size_t WS_HQ = 21 * MiB;
constexpr size_t WS_INVAS = 296 * MiB;
constexpr size_t WS_XQ2 = 304 * MiB;
constexpr size_t WS_INVSC = 336 * MiB;
constexpr size_t WS_XSC2 = 14 * MiB;
constexpr size_t WS_WGSC = 14 * MiB + 256 * 1024;
constexpr size_t WS_INVW = 300 * MiB;
constexpr size_t WS_XB = 373 * MiB;
constexpr size_t WS_WBR = 17 * MiB;
constexpr size_t WS_WOUT = 19 * MiB;
constexpr size_t WS_HB = 21 * MiB;
constexpr size_t WS_PROJ = 85 * MiB;
constexpr size_t WS_GATES = 245 * MiB;
constexpr size_t WS_WGU = 245 * MiB;
constexpr size_t WS_WD = 277 * MiB;
constexpr size_t WS_XS = 293 * MiB;
constexpr size_t WS_HMID = 437 * MiB;
constexpr size_t WS_XR = 85 * MiB;
constexpr size_t WS_RLOG = 213 * MiB;
constexpr size_t WS_WR = 501 * MiB;
constexpr size_t WS_WCMP = 502 * MiB;
constexpr size_t WS_CMPAB = 503 * MiB;
constexpr size_t WS_LRUW = 505 * MiB + 65536;
constexpr size_t WS_END = 506 * MiB;
constexpr int CW_BAR = 4096;
constexpr int CW_CNT = 16384, CNT_STRIDE = 64;

constexpr int RING_BYTES = 131072;
constexpr int MISC_OFF = RING_BYTES;
constexpr int BIAS_OFF = MISC_OFF + 256;
constexpr int OFFT_OFF = BIAS_OFF + 129 * 12 * 4;
constexpr int PTAB_OFF = OFFT_OFF + (40 + 288 + 40) * 4;
constexpr int BIAS2_OFF = PTAB_OFF + 36 * 8;
constexpr int LRUEX_OFF = BIAS2_OFF + 129 * 12 * 4;
constexpr int LDS_BYTES = 163840;
constexpr int LRUCST_OFF = LRUEX_OFF + 8 * 64 * 2 * 4;
constexpr int LRUCAR_OFF = LRUCST_OFF + 3 * 64 * 4;
static_assert(PTAB_OFF % 8 == 0 && LRUCAR_OFF + 8 * 64 * 4 <= LDS_BYTES, "LDS map");

DI float bf2f(bf16 v) { return __builtin_bit_cast(float, (unsigned)v << 16); }
DI float lo_bf(unsigned w) { return __builtin_bit_cast(float, w << 16); }
DI float hi_bf(unsigned w) { return __builtin_bit_cast(float, w & 0xffff0000u); }
DI unsigned f2bf(float f) { unsigned u = __builtin_bit_cast(unsigned, f); return (u + 0x7fffu + ((u >> 16) & 1u)) >> 16; }
typedef __bf16 bf16x2_pk __attribute__((ext_vector_type(2)));
DI unsigned pk2(float lo, float hi) { typedef float f32x2_pk __attribute__((ext_vector_type(2))); f32x2_pk v = {lo, hi}; bf16x2_pk b = __builtin_convertvector(v, bf16x2_pk); return __builtin_bit_cast(unsigned, b); }
DI float rl(float v, int i) { return __builtin_bit_cast(float, __builtin_amdgcn_readlane(__builtin_bit_cast(int, v), i)); }
DI int rli(int v, int i) { return __builtin_amdgcn_readlane(v, i); }
DI int my_lane() { int l; asm volatile("v_mbcnt_lo_u32_b32 %0, -1, 0\n\tv_mbcnt_hi_u32_b32 %0, -1, %0" : "=v"(l)); return l; }
template <int O> DI int xshfl_i(int v) {
    if constexpr (O == 1) return __builtin_amdgcn_update_dpp(v, v, 0xB1, 0xf, 0xf, false);
    else if constexpr (O == 2) return __builtin_amdgcn_update_dpp(v, v, 0x4E, 0xf, 0xf, false);
    else if constexpr (O == 8) return __builtin_amdgcn_update_dpp(v, v, 0x128, 0xf, 0xf, false);
    else if constexpr (O < 32) return __builtin_amdgcn_ds_swizzle(v, (O << 10) | 0x1f);
    else { const auto r = __builtin_amdgcn_permlane32_swap(v, v, false, false);
        const int l = my_lane(); return l < 32 ? (int)r[1] : (int)r[0]; }
}
template <int O> DI float xshfl(float v) { return __builtin_bit_cast(float, xshfl_i<O>(__builtin_bit_cast(int, v))); }
template <int CTRL, int RMASK> DI float dpp_get(float oldv, float v) { return __builtin_bit_cast(float, __builtin_amdgcn_update_dpp(__builtin_bit_cast(int, oldv), __builtin_bit_cast(int, v), CTRL, RMASK, 0xf, false)); }
DI float wave_sum(float v) {
    v += dpp_get<0x111, 0xf>(0.f, v); v += dpp_get<0x112, 0xf>(0.f, v); v += dpp_get<0x114, 0xf>(0.f, v); v += dpp_get<0x118, 0xf>(0.f, v);
    v += dpp_get<0x142, 0xa>(0.f, v); v += dpp_get<0x143, 0xc>(0.f, v);
    return __builtin_bit_cast(float, __builtin_amdgcn_readlane(__builtin_bit_cast(int, v), 63)); }
DI float wave_max(float v) {
    v = fmaxf(v, dpp_get<0x111, 0xf>(v, v)); v = fmaxf(v, dpp_get<0x112, 0xf>(v, v)); v = fmaxf(v, dpp_get<0x114, 0xf>(v, v)); v = fmaxf(v, dpp_get<0x118, 0xf>(v, v));
    v = fmaxf(v, dpp_get<0x142, 0xa>(v, v)); v = fmaxf(v, dpp_get<0x143, 0xc>(v, v));
    return __builtin_bit_cast(float, __builtin_amdgcn_readlane(__builtin_bit_cast(int, v), 63)); }
DI float sigmoidf_(float x) { return __builtin_amdgcn_rcpf(1.f + __builtin_amdgcn_exp2f(-1.4426950408889634f * x)); }
DI float gelu_tanh(float x) { const float u = 0.7978845608028654f * (x + 0.044715f * x * x * x); const float e = __expf(2.f * u); const float th = 1.f - 2.f * __builtin_amdgcn_rcpf(e + 1.f); return 0.5f * x * (1.f + th); }
DI float softplusf_(float x) { return fmaxf(x, 0.f) + log1pf(__expf(-fabsf(x))); }
#define LDS_WAIT() asm volatile("s_waitcnt lgkmcnt(0)" ::: "memory")
#define VM_WAIT() asm volatile("s_waitcnt vmcnt(0)" ::: "memory")

__device__ const unsigned char T5_BUCKET[128] = {
0,1,2,3,4,5,6,7,8,9,10,11,12,13,14,15,16,16,16,17,17,18,18,18,19,19,19,20,20,20,20,21,21,21,21,22,22,22,22,22,23,23,23,23,23,23,24,24,24,24,24,24,25,25,25,25,25,25,25,26,26,26,26,26,26,26,26,27,27,27,27,27,27,27,27,27,27,28,28,28,28,28,28,28,28,28,28,29,29,29,29,29,29,29,29,29,29,29,29,30,30,30,30,30,30,30,30,30,30,30,30,30,30,31,31,31,31,31,31,31,31,31,31,31,31,31,31,31};

#define XB_TMO      128
#define XB_XCNT(j)  (256  + 64 * (j))
#define XB_XSUB(j)  (1280 + 64 * (j))
#define XB_XGEN(j)  (2304 + 64 * (j))
#define XB_TOP      3328
#define XB_TOPGEN   3392
#define XCD_BAR_WORDS 3456
#define XB_SPIN_CAP (1u << 22)
DI unsigned xb_ld(unsigned* p)              { return __hip_atomic_load(p, __ATOMIC_RELAXED, __HIP_MEMORY_SCOPE_AGENT); }
DI unsigned xb_add(unsigned* p, unsigned v) { return __hip_atomic_fetch_add(p, v, __ATOMIC_RELAXED, __HIP_MEMORY_SCOPE_AGENT); }
DI unsigned xb_xcc_id() { return (unsigned)__builtin_amdgcn_s_getreg((3 << 11) | 20) & 0xFu; }
#define XB_SPIN(cond, bar) do { unsigned _sp = 0; while (cond) { __builtin_amdgcn_s_sleep(1); \
    if ((++_sp & 255u) == 0u) { if (xb_ld(&(bar)[XB_TMO])) break; if (_sp > XB_SPIN_CAP) { atomicAdd(&(bar)[XB_TMO], 1u); break; } } } } while (0)
struct XcdBarrier { unsigned* bar; unsigned x; volatile LAS unsigned* st; };
DI XcdBarrier xcd_barrier_post(unsigned* bar, volatile LAS unsigned* st, bool leader) {
    XcdBarrier b; b.bar = bar; b.x = xb_xcc_id(); b.st = st;
    if (leader) (void)xb_add(&bar[XB_XCNT(b.x)], 1u);
    return b;
}
DI void xcd_barrier_complete(unsigned* bar, unsigned x, unsigned& nloc, unsigned& nx) {
    const unsigned G = gridDim.x * gridDim.y * gridDim.z;
    unsigned sum, cnt, mine, sp = 0u;
    for (;;) {
        sum = 0u; cnt = 0u; mine = 0u;
#pragma unroll
        for (unsigned j = 0; j < 16; ++j) { const unsigned c = xb_ld(&bar[XB_XCNT(j)]); sum += c; cnt += (c > 0u) ? 1u : 0u; mine = (j == x) ? c : mine; }
        if (sum == G) break;
        __builtin_amdgcn_s_sleep(1);
        if ((++sp & 255u) == 0u) { if (xb_ld(&bar[XB_TMO])) break; if (sp > XB_SPIN_CAP) { atomicAdd(&bar[XB_TMO], 1u); break; } }
    }
    nloc = mine > 0u ? mine : 1u; nx = cnt > 0u ? cnt : 1u;
}
DI void xcd_barrier(const XcdBarrier& b, bool leader) {
    asm volatile("s_waitcnt vmcnt(0)" ::: "memory");
    __syncthreads();
    if (leader) {
        unsigned* bar = b.bar;
        __builtin_amdgcn_s_waitcnt(0);
        unsigned nloc = b.st[0], nx = b.st[1];
        if (nloc == 0u) { xcd_barrier_complete(bar, b.x, nloc, nx); b.st[0] = nloc; b.st[1] = nx; }
        const unsigned old = xb_add(&bar[XB_XSUB(b.x)], 1u);
        const unsigned gen = old / nloc;
        if (old + 1u == (gen + 1u) * nloc) {
            __builtin_amdgcn_fence(__ATOMIC_RELEASE, "agent");
            asm volatile("s_waitcnt vmcnt(0)" ::: "memory");
            const unsigned og = xb_add(&bar[XB_TOP], 1u);
            const unsigned tg = og / nx;
            if (og + 1u == (tg + 1u) * nx) xb_add(&bar[XB_TOPGEN], 1u);
            else XB_SPIN(xb_ld(&bar[XB_TOPGEN]) == tg, bar);
            __builtin_amdgcn_fence(__ATOMIC_ACQUIRE, "agent");
            xb_add(&bar[XB_XGEN(b.x)], 1u);
            asm volatile("s_waitcnt vmcnt(0)" ::: "memory");
        } else {
            XB_SPIN(xb_ld(&bar[XB_XGEN(b.x)]) == gen, bar);
            __builtin_amdgcn_fence(__ATOMIC_ACQUIRE, "agent");
            asm volatile("s_waitcnt vmcnt(0)" ::: "memory");
        }
    }
    __syncthreads();
}

namespace pg8 {
constexpr int BM = 256, BK = 64, HALF = 128, HTB = HALF * BK * 2;
__host__ __device__ __forceinline__ int lds_byte(int r, int c) { const int st = (r >> 4) * 2 + (c >> 5), rr = r & 15, cc = c & 31, ob = rr * 64 + cc * 2; return st * 1024 + (ob ^ (((ob >> 9) & 1) << 5)); }
__host__ __device__ __forceinline__ void stage_rc(int b, int& R, int& C) { const int st = b / 1024, sb = b % 1024, swz = sb ^ (((sb >> 9) & 1) << 5); R = (st >> 1) * 16 + swz / 64; C = (st & 1) * 32 + (swz % 64) / 2; }
__host__ __device__ __forceinline__ int perm32(int rho) { const int n = rho >> 4, i = rho & 15; return 8 * (i >> 2) + 4 * n + (i & 3); }
struct Unit { const char* a; const char* b; int pm, pn, aux, pad; };
struct Gemm { int K, lda, ldb, kstepA, hstepA; };
template <bool I8> struct AccT { typedef f32x4 type; };
template <> struct AccT<true> { typedef i32x4 type; };
template <class Epi, class Sched, bool GATHER = false, bool I8 = false>
DI void gemm_phase(LAS unsigned char* lds, const Gemm g, const Sched& S, const Epi& E, int tid_in) {
    int tid = tid_in; asm volatile("" : "+v"(tid));
    const int wid = __builtin_amdgcn_readfirstlane(tid >> 6), lane = tid & 63, wr = wid >> 2, wc = wid & 3, fr = lane & 15, fq = lane >> 4;
    const int K = g.K, nt = K / BK;
    unsigned voffA[2], voffB[2];
#pragma unroll
    for (int i = 0; i < 2; ++i) { int R, C; stage_rc(tid * 16 + i * 8192, R, C); const int Rb = (R & ~31) + perm32(R & 31);
        voffA[i] = (unsigned)(R * g.lda + C) * 2u; voffB[i] = (unsigned)(Rb * g.ldb + C) * 2u; }
    const size_t kstep = (size_t)(BK * 2), kstepA = (size_t)g.kstepA;
    const size_t hstepA = g.hstepA < 0 ? (size_t)HALF * g.lda * 2 : (size_t)g.hstepA, hstepB = (size_t)HALF * g.ldb * 2;
    const unsigned hstepA32 = (unsigned)hstepA;
    unsigned gC[2][2] = {{0u, 0u}, {0u, 0u}}, gN[2][2] = {{0u, 0u}, {0u, 0u}};
    const unsigned ldsw = (unsigned)wid * 1024u;
    const int aoff = lds_byte(wr * 64 + fr, fq * 8), boff = lds_byte(wc * 32 + fr, fq * 8);
#define PG8_SA(b, h) (((b) * 2 + (h)) * HTB)
#define PG8_SB(b, h) ((4 + (b) * 2 + (h)) * HTB)
#define PG8_STAGE(bufoff, gbase, voff) do { _Pragma("unroll") for (int _i = 0; _i < 2; ++_i) \
        __builtin_amdgcn_global_load_lds((const unsigned*)((const char*)(gbase) + (voff)[_i]), (LAS unsigned*)(lds + (bufoff) + ldsw + _i * 8192), 16, 0, 0); } while (0)
#define PG8_STAGEA(bufoff, gbase, h, nextsel) do { _Pragma("unroll") for (int _i = 0; _i < 2; ++_i) { \
        const unsigned _o = GATHER ? ((nextsel) ? gN[h][_i] : gC[h][_i]) : (voffA[_i] + (unsigned)(h) * hstepA32); \
        __builtin_amdgcn_global_load_lds((const unsigned*)((const char*)(gbase) + _o), (LAS unsigned*)(lds + (bufoff) + ldsw + _i * 8192), 16, 0, 0); } } while (0)
#define PG8_LDA(dst, b, h) do { _Pragma("unroll") for (int m = 0; m < 4; ++m) _Pragma("unroll") for (int k = 0; k < 2; ++k) dst[m][k] = *(const LAS bf16x8*)(lds + PG8_SA(b, h) + aoff + m * 2048 + k * 1024); } while (0)
#define PG8_LDB(dst, b, h) do { _Pragma("unroll") for (int n = 0; n < 2; ++n) _Pragma("unroll") for (int k = 0; k < 2; ++k) dst[n][k] = *(const LAS bf16x8*)(lds + PG8_SB(b, h) + boff + n * 2048 + k * 1024); } while (0)
#define PG8_MMA(ai, bj, At, Bt) do { __builtin_amdgcn_s_setprio(1); _Pragma("unroll") for (int m = 0; m < 4; ++m) _Pragma("unroll") for (int n = 0; n < 2; ++n) _Pragma("unroll") for (int k = 0; k < 2; ++k) \
        { if constexpr (I8) acc[ai][bj][m][n] = __builtin_amdgcn_mfma_i32_16x16x64_i8(__builtin_bit_cast(i32x4, Bt[n][k]), __builtin_bit_cast(i32x4, At[m][k]), acc[ai][bj][m][n], 0, 0, 0); \
          else acc[ai][bj][m][n] = __builtin_amdgcn_mfma_f32_16x16x32_bf16(Bt[n][k], At[m][k], acc[ai][bj][m][n], 0, 0, 0); } __builtin_amdgcn_s_setprio(0); } while (0)
#define PG8_WAIT_V(n) asm volatile("s_waitcnt vmcnt(" #n ")" ::: "memory")
#define PG8_WAIT_L(n) asm volatile("s_waitcnt lgkmcnt(" #n ")" ::: "memory")
#define PG8_BAR __builtin_amdgcn_s_barrier()
#define PG8_SCHED __builtin_amdgcn_sched_barrier(0)
    Unit cur, nxt; int ui = 0;
    if (!S.next(0, cur)) return;
    typedef typename AccT<I8>::type ACC;
    ACC acc[2][2][4][2];
#pragma unroll
    for (int a = 0; a < 2; ++a)
#pragma unroll
        for (int b = 0; b < 2; ++b)
#pragma unroll
            for (int m = 0; m < 4; ++m)
#pragma unroll
                for (int n = 0; n < 2; ++n) acc[a][b][m][n] = (ACC){0, 0, 0, 0};
    bf16x8 At[4][2], B0[2][2], B1[2][2];
    const char* cA = cur.a; const char* cB = cur.b;
    if constexpr (GATHER) S.rows(cur, tid, gC);
    PG8_STAGE(PG8_SB(0, 0), cB, voffB); PG8_STAGE(PG8_SB(0, 1), cB + hstepB, voffB); PG8_STAGEA(PG8_SA(0, 0), cA, 0, false); PG8_STAGEA(PG8_SA(0, 1), cA, 1, false);
    if (wr == 1) PG8_BAR;
    PG8_WAIT_V(2); PG8_BAR;
    PG8_STAGE(PG8_SB(1, 0), cB + kstep, voffB); PG8_STAGEA(PG8_SA(1, 0), cA + kstepA, 0, false); PG8_STAGE(PG8_SB(1, 1), cB + hstepB + kstep, voffB);
    PG8_WAIT_V(6); PG8_BAR;
    for (;;) {
        const bool has_next = S.next(ui + 1, nxt);
        const char* nA = has_next ? nxt.a : cA; const char* nB = has_next ? nxt.b : cB;
        if constexpr (GATHER) { if (has_next) S.rows(nxt, tid, gN); else {
#pragma unroll
            for (int h = 0; h < 2; ++h) { gN[h][0] = gC[h][0]; gN[h][1] = gC[h][1]; } } }
        for (int t = 0; t < nt; t += 2) {
            const bool last = (t == nt - 2);
            const char* a1 = cA + (size_t)(t + 1) * kstepA;
            const char* a2 = last ? nA : cA + (size_t)(t + 2) * kstepA; const char* b2 = last ? nB : cB + (size_t)(t + 2) * kstep;
            const char* a3 = a2 + kstepA; const char* b3 = b2 + kstep;
            PG8_LDB(B0, 0, 0); PG8_LDB(B1, 0, 1); PG8_SCHED; PG8_LDA(At, 0, 0); PG8_STAGEA(PG8_SA(1, 1), a1, 1, false);
            PG8_WAIT_V(8); PG8_WAIT_L(0); PG8_BAR; PG8_MMA(0, 0, At, B0); PG8_MMA(0, 1, At, B1); PG8_BAR; PG8_SCHED;
            PG8_LDA(At, 0, 1); PG8_STAGE(PG8_SB(0, 0), b2, voffB); PG8_STAGE(PG8_SB(0, 1), b2 + hstepB, voffB); PG8_STAGEA(PG8_SA(0, 0), a2, 0, last);
            PG8_WAIT_V(8); PG8_WAIT_L(0); PG8_BAR; PG8_MMA(1, 0, At, B0); PG8_MMA(1, 1, At, B1); PG8_BAR; PG8_SCHED;
            PG8_LDB(B0, 1, 0); PG8_LDB(B1, 1, 1); PG8_SCHED; PG8_LDA(At, 1, 0); PG8_STAGEA(PG8_SA(0, 1), a2, 1, last);
            PG8_WAIT_V(8); PG8_WAIT_L(0); PG8_BAR; PG8_MMA(0, 0, At, B0); PG8_MMA(0, 1, At, B1); PG8_BAR; PG8_SCHED;
            PG8_LDA(At, 1, 1); PG8_STAGE(PG8_SB(1, 0), b3, voffB); PG8_STAGE(PG8_SB(1, 1), b3 + hstepB, voffB); PG8_STAGEA(PG8_SA(1, 0), a3, 0, last);
            PG8_WAIT_V(8); PG8_WAIT_L(0); PG8_BAR; PG8_MMA(1, 0, At, B0); PG8_MMA(1, 1, At, B1); PG8_BAR; PG8_SCHED;
        }
        if (wr == 0) PG8_BAR;
        { const int el = my_lane(); E(acc, cur, wr, wc, el & 15, el >> 4); }
        if (!has_next) break;
        bool carried = false;
        if constexpr (Epi::CARRY) { if (nxt.aux != 0) { const int el = my_lane(); E.carry(acc, nxt, wr, wc, el & 15, el >> 4); carried = true; } }
        if (!carried) {
#pragma unroll
        for (int a = 0; a < 2; ++a)
#pragma unroll
            for (int b = 0; b < 2; ++b)
#pragma unroll
                for (int m = 0; m < 4; ++m)
#pragma unroll
                    for (int n = 0; n < 2; ++n) acc[a][b][m][n] = (ACC){0, 0, 0, 0};
        }
        cur = nxt; cA = nA; cB = nB; ++ui;
        if constexpr (GATHER) {
#pragma unroll
            for (int h = 0; h < 2; ++h) { gC[h][0] = gN[h][0]; gC[h][1] = gN[h][1]; } }
        if (wr == 1) PG8_BAR;
    }
    PG8_WAIT_V(0);
    PG8_BAR;
#undef PG8_SA
#undef PG8_SB
#undef PG8_STAGE
#undef PG8_STAGEA
#undef PG8_LDA
#undef PG8_LDB
#undef PG8_MMA
#undef PG8_WAIT_V
#undef PG8_WAIT_L
#undef PG8_BAR
#undef PG8_SCHED
}
}
using pg8::Unit;

DI unsigned cvt_pk_bf16(float lo, float hi) { unsigned r; asm volatile("s_nop 1\n\tv_cvt_pk_bf16_f32 %0, %1, %2" : "=v"(r) : "v"(lo), "v"(hi)); return r; }
DI u32x4 pack8(const f32x4& v0, const f32x4& v1) { u32x4 w; w.x = cvt_pk_bf16(v0[0], v0[1]); w.y = cvt_pk_bf16(v0[2], v0[3]); w.z = cvt_pk_bf16(v1[0], v1[1]); w.w = cvt_pk_bf16(v1[2], v1[3]); return w; }

struct SchedP1 {
    const char* A; const char* B; int nM, nN, rbA, rbB, G, c;
    DI bool next(int i, Unit& u) const {
        constexpr int NXCD = 8, WGM = 8; const int nwg = nM * nN;
        const long L = (long)i * G + c; if (L >= nwg) return false;
        int wgid = (int)L; { const int q = nwg / NXCD, r = nwg % NXCD, xcd = wgid % NXCD, off = wgid / NXCD; wgid = (xcd < r ? xcd * (q + 1) : r * (q + 1) + (xcd - r) * q) + off; }
        const int nig = WGM * nN, gid = wgid / nig, fm = gid * WGM, gsz = (nM - fm) < WGM ? (nM - fm) : WGM;
        u.pm = fm + ((wgid % nig) % gsz); u.pn = (wgid % nig) / gsz; u.aux = 0; u.pad = 0;
        u.a = A + (size_t)u.pm * 256 * rbA; u.b = B + (size_t)u.pn * 256 * rbB; return true;
    }
};
struct SchedP3a {
    const char* ys; const char* wbr; int G, c;
    DI bool next(int i, Unit& u) const {
        const int tile = (i >> 2) * G + c; if (tile >= 512) return false;
        const int br = i & 3; u.pm = tile >> 2; u.pn = tile & 3; u.aux = br; u.pad = 0;
        u.a = ys + ((size_t)u.pm * 256 * 1024 + br * 256) * 2; u.b = wbr + ((size_t)br * 1024 * 256 + (size_t)u.pn * 256 * 256) * 2; return true;
    }
};
struct SchedP3b {
    const char* A; const char* B; int G, c;
    DI bool next(int i, Unit& u) const {
        const int L = i * G + c; if (L >= 512) return false;
        u.pm = L >> 2; u.pn = L & 3; u.aux = 0; u.pad = 0;
        u.a = A + (size_t)u.pm * 256 * 1024 * 2; u.b = B + (size_t)u.pn * 256 * 1024 * 2; return true;
    }
};
struct SchedM2 {
    const char* xr; const char* wgu; const LAS int* offt; const int* rowsrc; int G, c;
    DI bool next(int i, Unit& u) const {
        const int NT = __builtin_amdgcn_readfirstlane(offt[32]) >> 8; const int L = i * G + c; if (L >= NT * 2) return false;
        const int rt = L >> 1, pn = L & 1; const int e = __builtin_amdgcn_readfirstlane(offt[40 + rt]);
        u.pm = rt; u.pn = pn; u.aux = e; u.pad = 0;
        u.a = xr; u.b = wgu + ((size_t)e * 512 + pn * 256) * 1024; return true;
    }
    DI void rows(const Unit& u, int tid, unsigned (&g)[2][2]) const {
        const int e = u.aux; const int base = u.pm * 256 - __builtin_amdgcn_readfirstlane(offt[e]), cnt = __builtin_amdgcn_readfirstlane(offt[330 + e]);
#pragma unroll
        for (int i = 0; i < 2; ++i) { int R, C; pg8::stage_rc(tid * 16 + i * 8192, R, C);
#pragma unroll
            for (int h = 0; h < 2; ++h) { const int lr = base + h * 128 + R; const int as = lr < cnt ? rowsrc[e * 32768 + lr] : 0;
                g[h][i] = (unsigned)(as >> 1) * 1024u + (unsigned)C * 2u; } }
    }
};
struct SchedM3 {
    const char* hmid; const char* wd; const LAS int* offt; int G, c;
    DI bool next(int i, Unit& u) const {
        const int NT = __builtin_amdgcn_readfirstlane(offt[32]) >> 8; const int L = i * G + c; if (L >= NT * 4) return false;
        const int rt = L >> 2, pn = L & 3; const int e = __builtin_amdgcn_readfirstlane(offt[40 + rt]);
        u.pm = rt; u.pn = pn; u.aux = e; u.pad = 0;
        u.a = hmid + (size_t)rt * 256 * 256 * 2; u.b = wd + ((size_t)e * 1024 + pn * 256) * 256 * 2; return true;
    }
};

struct EpiP1I8 {
    static constexpr bool CARRY = false;
    bf16* proj; unsigned char* gates; const float* bgate; const float* hsc; const float* wsc;
    DI void operator()(const i32x4 (&acc)[2][2][4][2], const Unit& u, int wr, int wc, int fr, int fq) const {
        const int row0 = u.pm * 256 + wr * 64 + fr;
        if (u.pn < 10) { const int colt = u.pn * 256 + wc * 32 + 8 * fq;
            f32x4 sv[2][2]; float rsv[2][4];
#pragma unroll
            for (int bj = 0; bj < 2; ++bj)
#pragma unroll
                for (int n = 0; n < 2; ++n) sv[bj][n] = *(const GAS f32x4*)((const GAS float*)wsc + colt + bj * 128 + 4 * n);
#pragma unroll
            for (int ai = 0; ai < 2; ++ai)
#pragma unroll
                for (int m = 0; m < 4; ++m) rsv[ai][m] = ((const GAS float*)hsc)[row0 + ai * 128 + m * 16];
#pragma unroll
            for (int ai = 0; ai < 2; ++ai)
#pragma unroll
                for (int m = 0; m < 4; ++m) { GAS bf16* rowp = (GAS bf16*)proj + (size_t)(4 * u.pn + (wc >> 1)) * PGS + (size_t)(row0 + ai * 128 + m * 16) * 64 + 32 * (wc & 1) + 8 * fq; const float rs = rsv[ai][m];
#pragma unroll
                    for (int bj = 0; bj < 2; ++bj) { f32x4 v0, v1;
#pragma unroll
                        for (int e = 0; e < 4; ++e) { v0[e] = (float)acc[ai][bj][m][0][e] * (rs * sv[bj][0][e]); v1[e] = (float)acc[ai][bj][m][1][e] * (rs * sv[bj][1][e]); }
                        *(GAS u32x4*)(rowp + (size_t)(2 * bj) * PGS) = pack8(v0, v1); } }
            return; }
        const int gcol = (u.pn - 10) * 256 + wc * 32 + 8 * fq; const float* wsc = this->wsc + 2560;
        f32x4 bv[2][2], sv[2][2];
#pragma unroll
        for (int bj = 0; bj < 2; ++bj)
#pragma unroll
            for (int n = 0; n < 2; ++n) { bv[bj][n] = *(const GAS f32x4*)((const GAS float*)bgate + gcol + bj * 128 + 4 * n); sv[bj][n] = *(const GAS f32x4*)((const GAS float*)wsc + gcol + bj * 128 + 4 * n);
                sv[bj][n] = sv[bj][n] * -1.4426950408889634f; bv[bj][n] = bv[bj][n] * -1.4426950408889634f + (-8.f + 2.2e-5f); }
        float rsv[2][4];
#pragma unroll
        for (int ai = 0; ai < 2; ++ai)
#pragma unroll
            for (int m = 0; m < 4; ++m) rsv[ai][m] = ((const GAS float*)hsc)[row0 + ai * 128 + m * 16];
#pragma unroll
        for (int ai = 0; ai < 2; ++ai)
#pragma unroll
            for (int m = 0; m < 4; ++m) { const float rs = rsv[ai][m];
                GAS unsigned char* rowp = (GAS unsigned char*)gates + ((size_t)(u.pm * 16 + (u.pn - 10)) * 65536 + (size_t)((ai * 4 + m) * 8192 + (wr * 4 + wc) * 1024 + (fq * 16 + fr) * 16));
                u32x4 w4;
#pragma unroll
                for (int bj = 0; bj < 2; ++bj) { unsigned q[8];
#pragma unroll
                    for (int n = 0; n < 2; ++n)
#pragma unroll
                        for (int e = 0; e < 4; ++e) { const float xe = ((float)acc[ai][bj][m][n][e] * rs) * sv[bj][n][e] + bv[bj][n][e];
                            q[4 * n + e] = (unsigned)__builtin_amdgcn_rcpf(0.00390631f + __builtin_amdgcn_exp2f(xe)); }
                    const unsigned w0 = q[0] | (q[1] << 8) | (q[2] << 16) | (q[3] << 24), w1 = q[4] | (q[5] << 8) | (q[6] << 16) | (q[7] << 24);
                    if (bj == 0) { w4.x = w0; w4.y = w1; } else { w4.z = w0; w4.w = w1; } }
                *(GAS u32x4*)rowp = w4;
                __builtin_amdgcn_sched_barrier(0); }
    }
};
struct EpiP3a {
    static constexpr bool CARRY = true;
    bf16* merged; const unsigned char* gates;
    DI void carry(f32x4 (&acc)[2][2][4][2], const Unit& u, int wr, int wc, int fr, int fq) const {
        const GAS unsigned char* gb = (const GAS unsigned char*)gates + (size_t)(u.pm * 16 + (u.aux - 1) * 4 + u.pn) * 65536;
        const unsigned go = (unsigned)((wr * 4 + wc) * 1024 + (fq * 16 + fr) * 16);
        u32x4 gp[2][4], gn[2][4];
#pragma unroll
        for (int ai = 0; ai < 2; ++ai)
#pragma unroll
            for (int m = 0; m < 4; ++m) { gp[ai][m] = *(const GAS u32x4*)(gb + go + (unsigned)((ai * 4 + m) * 8192)); gn[ai][m] = *(const GAS u32x4*)(gb + go + (unsigned)((ai * 4 + m) * 8192 + 4 * 65536)); }
#pragma unroll
        for (int ai = 0; ai < 2; ++ai) {
#pragma unroll
            for (int m = 0; m < 4; ++m)
#pragma unroll
                for (int bj = 0; bj < 2; ++bj) {
#pragma unroll
                    for (int n = 0; n < 2; ++n) { const unsigned p4 = bj ? (n ? gp[ai][m].w : gp[ai][m].z) : (n ? gp[ai][m].y : gp[ai][m].x), n4 = bj ? (n ? gn[ai][m].w : gn[ai][m].z) : (n ? gn[ai][m].y : gn[ai][m].x);
#pragma unroll
                        for (int e = 0; e < 4; ++e) acc[ai][bj][m][n][e] *= ((float)((p4 >> (8 * e)) & 255u) + 0.5f) * __builtin_amdgcn_rcpf((float)((n4 >> (8 * e)) & 255u) + 0.5f); } }
            __builtin_amdgcn_sched_barrier(0); }
    }
    DI void operator()(const f32x4 (&acc)[2][2][4][2], const Unit& u, int wr, int wc, int fr, int fq) const {
        if (u.aux != 3) return;
        const GAS unsigned char* gb = (const GAS unsigned char*)gates + (size_t)(u.pm * 16 + 3 * 4 + u.pn) * 65536;
        GAS unsigned char* mb = (GAS unsigned char*)merged + ((size_t)(u.pm * 256) * 1024 + u.pn * 256) * 2;
        const unsigned go = (unsigned)((wr * 4 + wc) * 1024 + (fq * 16 + fr) * 16), mo = (unsigned)((wr * 64 + fr) * 1024 + wc * 32 + 8 * fq) * 2u;
        u32x4 gw[2][4];
#pragma unroll
        for (int ai = 0; ai < 2; ++ai)
#pragma unroll
            for (int m = 0; m < 4; ++m) gw[ai][m] = *(const GAS u32x4*)(gb + go + (unsigned)((ai * 4 + m) * 8192));
#pragma unroll
        for (int ai = 0; ai < 2; ++ai) {
#pragma unroll
            for (int m = 0; m < 4; ++m)
#pragma unroll
                for (int bj = 0; bj < 2; ++bj) {
                    f32x4 v0 = acc[ai][bj][m][0], v1 = acc[ai][bj][m][1]; u32x2 g2; g2.x = bj ? gw[ai][m].z : gw[ai][m].x; g2.y = bj ? gw[ai][m].w : gw[ai][m].y; const float k256 = 0.00390625f;
#pragma unroll
                    for (int e = 0; e < 4; ++e) { v0[e] *= ((float)((g2.x >> (8 * e)) & 255u) + 0.5f) * k256; v1[e] *= ((float)((g2.y >> (8 * e)) & 255u) + 0.5f) * k256; }
                    *(GAS u32x4*)(mb + mo + (unsigned)((ai * 128 + m * 16) * 1024 + bj * 128) * 2u) = pack8(v0, v1); }
            __builtin_amdgcn_sched_barrier(0); }
    }
};
template <bool XF32> struct EpiP3b {
    static constexpr bool CARRY = false;
    const float* xin; bf16* xb_;
    DI void operator()(const f32x4 (&acc)[2][2][4][2], const Unit& u, int wr, int wc, int fr, int fq) const {
        GAS unsigned char* ob = (GAS unsigned char*)xb_ + ((size_t)(u.pm * 256) * 1024 + u.pn * 256) * 2;
        const unsigned lo = (unsigned)((wr * 64 + fr) * 1024 + wc * 32 + 8 * fq);
        if constexpr (XF32) {
            const GAS unsigned char* xb = (const GAS unsigned char*)xin + ((size_t)(u.pm * 256) * 1024 + u.pn * 256) * 4;
#pragma unroll
            for (int ai = 0; ai < 2; ++ai)
#pragma unroll
                for (int mh = 0; mh < 2; ++mh) {
                    f32x4 xv[2][2][2];
#pragma unroll
                    for (int m2 = 0; m2 < 2; ++m2)
#pragma unroll
                        for (int bj = 0; bj < 2; ++bj)
#pragma unroll
                            for (int n = 0; n < 2; ++n) xv[m2][bj][n] = *(const GAS f32x4*)(xb + (lo + (unsigned)((ai * 128 + (mh * 2 + m2) * 16) * 1024 + bj * 128 + 4 * n)) * 4u);
#pragma unroll
                    for (int m2 = 0; m2 < 2; ++m2)
#pragma unroll
                        for (int bj = 0; bj < 2; ++bj)
                            *(GAS u32x4*)(ob + (lo + (unsigned)((ai * 128 + (mh * 2 + m2) * 16) * 1024 + bj * 128)) * 2u) = pack8(xv[m2][bj][0] + acc[ai][bj][mh * 2 + m2][0], xv[m2][bj][1] + acc[ai][bj][mh * 2 + m2][1]);
                    __builtin_amdgcn_sched_barrier(0); }
        } else {
#pragma unroll
            for (int ai = 0; ai < 2; ++ai) {
                u32x4 xv[4][2];
#pragma unroll
                for (int m = 0; m < 4; ++m)
#pragma unroll
                    for (int bj = 0; bj < 2; ++bj) xv[m][bj] = *(const GAS u32x4*)(ob + (lo + (unsigned)((ai * 128 + m * 16) * 1024 + bj * 128)) * 2u);
#pragma unroll
                for (int m = 0; m < 4; ++m)
#pragma unroll
                    for (int bj = 0; bj < 2; ++bj) { const u32x4 x4 = xv[m][bj]; f32x4 v0 = acc[ai][bj][m][0], v1 = acc[ai][bj][m][1];
                        v0[0] += lo_bf(x4.x); v0[1] += hi_bf(x4.x); v0[2] += lo_bf(x4.y); v0[3] += hi_bf(x4.y); v1[0] += lo_bf(x4.z); v1[1] += hi_bf(x4.z); v1[2] += lo_bf(x4.w); v1[3] += hi_bf(x4.w);
                        *(GAS u32x4*)(ob + (lo + (unsigned)((ai * 128 + m * 16) * 1024 + bj * 128)) * 2u) = pack8(v0, v1); }
                __builtin_amdgcn_sched_barrier(0); }
        }
    }
};
struct EpiM2 {
    static constexpr bool CARRY = false;
    bf16* hmid; const float* invsc; const float* wgsc; const LAS int* offt;
    DI void operator()(const i32x4 (&acc)[2][2][4][2], const Unit& u, int wr, int wc, int fr, int fq) const {
        const int e = u.aux; const int cnt = __builtin_amdgcn_readfirstlane(offt[330 + e]);
        const int lr0 = u.pm * 256 - __builtin_amdgcn_readfirstlane(offt[e]) + wr * 64 + fr;
        const int row0 = u.pm * 256 + wr * 64 + fr; const int col = u.pn * 128 + wc * 32 + 8 * fq;
        const GAS float* cs = (const GAS float*)wgsc + e * 512 + u.pn * 256 + wc * 32 + 8 * fq;
        f32x4 cg[2], cu[2]; float rsv[2][4];
#pragma unroll
        for (int n = 0; n < 2; ++n) { cg[n] = *(const GAS f32x4*)(cs + 4 * n); cu[n] = *(const GAS f32x4*)(cs + 128 + 4 * n); }
#pragma unroll
        for (int ai = 0; ai < 2; ++ai)
#pragma unroll
            for (int m = 0; m < 4; ++m) { const int lr = lr0 + ai * 128 + m * 16; rsv[ai][m] = 0.f; if (lr < cnt) rsv[ai][m] = ((const GAS float*)invsc)[e * 32768 + lr]; }
#pragma unroll
        for (int ai = 0; ai < 2; ++ai)
#pragma unroll
            for (int m = 0; m < 4; ++m) { f32x4 h0, h1; const float rs = rsv[ai][m];
#pragma unroll
                for (int e4 = 0; e4 < 4; ++e4) { const float g0 = (float)acc[ai][0][m][0][e4] * (rs * cg[0][e4]), g1 = (float)acc[ai][0][m][1][e4] * (rs * cg[1][e4]);
                    h0[e4] = g0 * sigmoidf_(g0) * ((float)acc[ai][1][m][0][e4] * (rs * cu[0][e4])); h1[e4] = g1 * sigmoidf_(g1) * ((float)acc[ai][1][m][1][e4] * (rs * cu[1][e4])); }
                *(GAS u32x4*)((GAS bf16*)hmid + (size_t)(row0 + ai * 128 + m * 16) * 256 + col) = pack8(h0, h1); }
    }
};
struct EpiM3 {
    static constexpr bool CARRY = false;
    bf16* eo; const int* rowtok; const float* roww; const LAS int* offt;
    DI void operator()(const f32x4 (&acc)[2][2][4][2], const Unit& u, int wr, int wc, int fr, int fq) const {
        const int e = u.aux; const int cnt = __builtin_amdgcn_readfirstlane(offt[330 + e]);
        const int lr0 = u.pm * 256 - __builtin_amdgcn_readfirstlane(offt[e]) + wr * 64 + fr; const int colt = u.pn * 256 + wc * 32 + 8 * fq;
        int tk[2][4]; float wv[2][4];
#pragma unroll
        for (int ai = 0; ai < 2; ++ai)
#pragma unroll
            for (int m = 0; m < 4; ++m) { const int lr = lr0 + ai * 128 + m * 16; tk[ai][m] = -1; wv[ai][m] = 0.f;
                if (lr < cnt) { tk[ai][m] = ((const GAS int*)rowtok)[e * 32768 + lr]; wv[ai][m] = ((const GAS float*)roww)[e * 32768 + lr]; } }
#pragma unroll
        for (int ai = 0; ai < 2; ++ai)
#pragma unroll
            for (int m = 0; m < 4; ++m) {
                if (tk[ai][m] >= 0) { const float w = wv[ai][m]; GAS bf16* op = (GAS bf16*)eo + (size_t)tk[ai][m] * 1024 + colt;
#pragma unroll
                    for (int bj = 0; bj < 2; ++bj) *(GAS u32x4*)(op + bj * 128) = pack8(acc[ai][bj][m][0] * w, acc[ai][bj][m][1] * w); }
                __builtin_amdgcn_sched_barrier(0); }
    }
};

struct Args { const float* in[36]; float* out; unsigned char* ws; int ph_lo, ph_hi; };
struct InTab { unsigned base;
    DI const float* operator[](int i) const { unsigned long long v; const unsigned addr = base + (unsigned)i * 8u;
        asm volatile("ds_read_b64 %0, %1\n\ts_waitcnt lgkmcnt(0)" : "=v"(v) : "v"(addr) : "memory");
        const unsigned lo = __builtin_amdgcn_readfirstlane((unsigned)v), hi = __builtin_amdgcn_readfirstlane((unsigned)(v >> 32));
        return (const float*)(((unsigned long long)hi << 32) | lo); } };
struct KA { InTab in; float* out; unsigned char* ws; };

DI void transpose_item(const float* W_, int ldw, int nvalid, bf16* WT_, int ldt, int k0, int n0, int dst_row0, LAS float* scr, int lane) {
    const GAS float* W = (const GAS float*)W_; GAS bf16* WT = (GAS bf16*)WT_;
    const int nq = 4 * (lane & 7), kr8 = lane >> 3;
    f32x4 v[8];
#pragma unroll
    for (int i = 0; i < 8; ++i) { const int kk = 8 * i + kr8;
        if (n0 + nq + 3 < nvalid) v[i] = *(const GAS f32x4*)(W + (size_t)(k0 + kk) * ldw + n0 + nq);
        else {
#pragma unroll
            for (int e = 0; e < 4; ++e) v[i][e] = (n0 + nq + e < nvalid) ? W[(size_t)(k0 + kk) * ldw + n0 + nq + e] : 0.f; } }
#pragma unroll
    for (int i = 0; i < 8; ++i) { const int kk = 8 * i + kr8;
#pragma unroll
        for (int e = 0; e < 4; ++e) scr[kk * 33 + nq + e] = v[i][e]; }
    LDS_WAIT(); asm volatile("" ::: "memory");
    const int c = lane & 7;
#pragma unroll
    for (int j = 0; j < 4; ++j) { const int n = (lane >> 3) + 8 * j; const LAS float* s = scr + (8 * c) * 33 + n;
        u32x4 o; o.x = pk2(s[0 * 33], s[1 * 33]); o.y = pk2(s[2 * 33], s[3 * 33]); o.z = pk2(s[4 * 33], s[5 * 33]); o.w = pk2(s[6 * 33], s[7 * 33]);
        if (n0 + n < nvalid) *(GAS u32x4*)(WT + (size_t)(dst_row0 + n) * ldt + k0 + 8 * c) = o; }
    LDS_WAIT(); asm volatile("" ::: "memory");
}
DI void phase0_weights(const KA& a, int l, LAS unsigned char* lds, int gw, int NGW, int wave, int lane) {
    LAS float* scr = (LAS float*)(lds + wave * 16384);
    const float* w_in = a.in[4] + (size_t)l * 1024 * NIN;
    const float* w_gate = a.in[24] + (size_t)l * 4 * 1024 * 1024;
    const float* w_br = a.in[26] + (size_t)l * 4 * 256 * 1024;
    const float* w_out = a.in[27] + (size_t)l * 1024 * 1024;
    bf16* Wt_in = (bf16*)(a.ws + WS_WIN); bf16* Wt_br = (bf16*)(a.ws + WS_WBR); bf16* Wt_out = (bf16*)(a.ws + WS_WOUT);
    constexpr int I_B = 4 * 4 * 32, I_O = 16 * 32, NIT = I_B + I_O;
    (void)w_gate; (void)w_in; (void)Wt_in;
    for (int it = gw; it < NIT; it += NGW) {
        int r = it;
        if (r < I_B) { const int br = r / 128, q = r % 128, kb = q / 32, nb = q % 32; transpose_item(w_br + (size_t)br * 256 * 1024, 1024, 1024, Wt_br + (size_t)br * 1024 * 256, 256, kb * 64, nb * 32, nb * 32, scr, lane); continue; } r -= I_B;
        { const int kb = r / 32, nb = r % 32; transpose_item(w_out, 1024, 1024, Wt_out, 1024, kb * 64, nb * 32, nb * 32, scr, lane); }
    }
}
DI void p1_weights_i8(const KA& a, int l, LAS unsigned char* lds, int bid, int G, int wave, int lane) {
    LAS float* scr = (LAS float*)(lds + wave * 16384); LAS float* red = (LAS float*)(lds + 7 * 16384 + 12288);
    const GAS float* wgt = (const GAS float*)(a.in[24] + (size_t)l * 4 * 1024 * 1024); const GAS float* win = (const GAS float*)(a.in[4] + (size_t)l * 1024 * NIN);
    GAS unsigned char* Wq = (GAS unsigned char*)(a.ws + WS_WQ); GAS float* wsc = (GAS float*)(a.ws + WS_WSC);
    const int nq = 4 * (lane & 7), kr8 = lane >> 3;
    for (int it = G - 1 - bid; it < 128 + 77; it += G) {
        const bool isg = it < 128; const int br = it >> 5; const int n0 = isg ? (it & 31) * 32 : (it - 128) * 32;
        const int ldw = isg ? 1024 : NIN; const int nval = isg ? 1024 : NIN; const int drow0 = isg ? 2560 + br * 1024 + n0 : n0;
        const bool lok = (n0 + nq) < nval;
        const GAS float* W = (isg ? wgt + (size_t)br * 1024 * 1024 : win) + n0 + nq + (size_t)(128 * wave) * ldw;
        f32x4 v[16];
#pragma unroll
        for (int i = 0; i < 16; ++i) { v[i] = (f32x4){0.f, 0.f, 0.f, 0.f}; if (lok) v[i] = *(const GAS f32x4*)(W + (size_t)(8 * i + kr8) * ldw); }
        f32x4 mx = {0.f, 0.f, 0.f, 0.f};
#pragma unroll
        for (int i = 0; i < 16; ++i) { mx[0] = fmaxf(mx[0], fabsf(v[i][0])); mx[1] = fmaxf(mx[1], fabsf(v[i][1])); mx[2] = fmaxf(mx[2], fabsf(v[i][2])); mx[3] = fmaxf(mx[3], fabsf(v[i][3])); }
#pragma unroll
        for (int e = 0; e < 4; ++e) { float m = mx[e]; m = fmaxf(m, xshfl<8>(m)); m = fmaxf(m, xshfl<16>(m)); m = fmaxf(m, xshfl<32>(m)); mx[e] = m; }
        if (kr8 == 0) {
#pragma unroll
            for (int e = 0; e < 4; ++e) red[wave * 32 + nq + e] = mx[e]; }
        __syncthreads();
#pragma unroll
        for (int e = 0; e < 4; ++e) { float m = red[nq + e];
#pragma unroll
            for (int w = 1; w < 8; ++w) m = fmaxf(m, red[w * 32 + nq + e]);
            mx[e] = fmaxf(m, 1e-20f); }
        if (wave == 0 && kr8 == 0 && lok) *(GAS f32x4*)(wsc + drow0 + nq) = mx * (1.f / 127.f);
        const f32x4 qs = {127.f / mx[0], 127.f / mx[1], 127.f / mx[2], 127.f / mx[3]};
#pragma unroll
        for (int hb = 0; hb < 2; ++hb) {
#pragma unroll
            for (int i = 0; i < 8; ++i) { const int kk = 8 * i + kr8;
#pragma unroll
                for (int e = 0; e < 4; ++e) scr[kk * 33 + nq + e] = __builtin_rintf(v[8 * hb + i][e] * qs[e]); }
            LDS_WAIT(); asm volatile("" ::: "memory");
            const int n = lane >> 1, kh = lane & 1; u32x4 o[2];
#pragma unroll
            for (int h2 = 0; h2 < 2; ++h2) { unsigned w4[4];
#pragma unroll
                for (int d = 0; d < 4; ++d) { unsigned wv = 0u;
#pragma unroll
                    for (int e = 0; e < 4; ++e) wv |= ((unsigned)(int)scr[(32 * kh + 16 * h2 + 4 * d + e) * 33 + n] & 255u) << (8 * e);
                    w4[d] = wv; }
                o[h2].x = w4[0]; o[h2].y = w4[1]; o[h2].z = w4[2]; o[h2].w = w4[3]; }
            if (n0 + n < nval) { GAS unsigned char* dst = Wq + (size_t)(drow0 + n) * 1024 + 128 * wave + 64 * hb + 32 * kh; *(GAS u32x4*)dst = o[0]; *(GAS u32x4*)(dst + 16) = o[1]; }
            LDS_WAIT(); asm volatile("" ::: "memory");
        }
        __syncthreads();
    }
}

DI void router_weights(const KA& a, int l, int gw, int NGW, int lane) {
    bf16* Wr = (bf16*)(a.ws + WS_WR);
    const float* wg = a.in[29] + (size_t)l * 1024 * 4; const float* we = a.in[31] + (size_t)l * 1024 * 32;
    for (int n = gw; n < 36; n += NGW) {
        for (int i = 0; i < 16; ++i) { const int k = lane + 64 * i; const float w = (n < 4) ? wg[k * 4 + n] : we[k * 32 + (n - 4)];
            const unsigned hi = f2bf(w); const float hf = __builtin_bit_cast(float, hi << 16); const unsigned lo = f2bf(w - hf);
            Wr[(size_t)n * 2048 + k] = (bf16)hi; Wr[(size_t)n * 2048 + 1024 + k] = (bf16)hi; Wr[(size_t)(64 + n) * 2048 + k] = (bf16)lo; Wr[(size_t)(64 + n) * 2048 + 1024 + k] = 0; }
    }
}

DI void cmp_weights(const KA& a, int l, LAS unsigned char* lds, int gw, int NGW, int wave, int lane) {
    LAS float* scr = (LAS float*)(lds + wave * 16384);
    bf16* Wc = (bf16*)(a.ws + WS_WCMP); float* pt = (float*)(a.ws + WS_CMPAB + 2 * MiB);
    for (int it = gw; it < 128 + 64; it += NGW) {
        if (it < 128) { const int kv = it >> 6, q = it & 63, kb = q >> 1, nb = q & 1; const float* w1 = a.in[kv ? 22 : 19] + (size_t)l * 2048 * 64;
            bf16* dst = Wc + (size_t)kv * 256 * 1024 - (kb >= 16 ? 1024 : 0);
            transpose_item(w1, 64, 64, dst, 1024, kb * 64, nb * 32, (kb >= 16 ? 64 : 0) + nb * 32, scr, lane);
        } else { const int kv = (it - 128) >> 5, part = (it - 128) & 31;
            const GAS float* w1 = (const GAS float*)(a.in[kv ? 22 : 19] + (size_t)l * 2048 * 64) + (size_t)part * 64 * 64; const GAS float* pos = (const GAS float*)(a.in[kv ? 21 : 18] + (size_t)l * 2048) + part * 64;
            float acc = 0.f;
#pragma unroll 16
            for (int k = 0; k < 64; ++k) acc += pos[k] * w1[(size_t)k * 64 + lane];
            pt[(kv * 32 + part) * 64 + lane] = acc; }
    }
}

DI void lru_weights(const KA& a, int l, int gw, int NGW, int lane) {
    bf16* W = (bf16*)(a.ws + WS_LRUW); const float* wa = a.in[7] + (size_t)l * 4 * 4096; const float* wx = a.in[9] + (size_t)l * 4 * 4096;
    (void)NGW; { const int idx = gw * 64 + lane; if (idx < 32768) { const int i = idx & 63, j = (idx >> 6) & 63, mat = (idx >> 12) & 1, hbk = idx >> 13;
        W[idx] = (bf16)f2bf((mat ? wx : wa)[(size_t)hbk * 4096 + i * 64 + j]); } }
}
DI void phase0_rows(const KA& a, int l, int mode, int gw, int NGW, int lane) {
    const GAS float* xin = (const GAS float*)a.in[0]; GAS bf16* xb = (GAS bf16*)(a.ws + WS_XB);
    const GAS bf16* eo = (const GAS bf16*)(a.ws + WS_PROJ);
    GAS float* outp = (GAS float*)a.out;
    const GAS float* g = (const GAS float*)(mode ? a.in[2] : (a.in[3] + (size_t)l * 1024));
    f32x4 gv[2][2];
#pragma unroll
    for (int j = 0; j < 2; ++j) { gv[j][0] = *(const GAS f32x4*)(g + 8 * (lane + 64 * j)); gv[j][1] = *(const GAS f32x4*)(g + 8 * (lane + 64 * j) + 4); }
    for (int m0 = gw * 4; m0 < T; m0 += NGW * 4) {
        f32x4 v[4][2][2]; float ss[4];
        if (l == 0) {
#pragma unroll
            for (int rr = 0; rr < 4; ++rr)
#pragma unroll
                for (int j = 0; j < 2; ++j) { const GAS float* xp = xin + (size_t)(m0 + rr) * 1024 + 8 * (lane + 64 * j); v[rr][j][0] = *(const GAS f32x4*)xp; v[rr][j][1] = *(const GAS f32x4*)(xp + 4); }
        } else {
            u32x4 xw[4][2], e0[4][2], e1[4][2];
#pragma unroll
            for (int rr = 0; rr < 4; ++rr)
#pragma unroll
                for (int j = 0; j < 2; ++j) { const size_t co = 8 * (lane + 64 * j);
                    xw[rr][j] = *(const GAS u32x4*)(xb + (size_t)(m0 + rr) * 1024 + co);
                    e0[rr][j] = *(const GAS u32x4*)(eo + (size_t)(2 * (m0 + rr)) * 1024 + co); e1[rr][j] = *(const GAS u32x4*)(eo + (size_t)(2 * (m0 + rr) + 1) * 1024 + co); }
#pragma unroll
            for (int rr = 0; rr < 4; ++rr)
#pragma unroll
                for (int j = 0; j < 2; ++j) { const u32x4 x4 = xw[rr][j], a4 = e0[rr][j], b4 = e1[rr][j];
                    v[rr][j][0][0] = lo_bf(x4.x) + (lo_bf(a4.x) + lo_bf(b4.x)); v[rr][j][0][1] = hi_bf(x4.x) + (hi_bf(a4.x) + hi_bf(b4.x));
                    v[rr][j][0][2] = lo_bf(x4.y) + (lo_bf(a4.y) + lo_bf(b4.y)); v[rr][j][0][3] = hi_bf(x4.y) + (hi_bf(a4.y) + hi_bf(b4.y));
                    v[rr][j][1][0] = lo_bf(x4.z) + (lo_bf(a4.z) + lo_bf(b4.z)); v[rr][j][1][1] = hi_bf(x4.z) + (hi_bf(a4.z) + hi_bf(b4.z));
                    v[rr][j][1][2] = lo_bf(x4.w) + (lo_bf(a4.w) + lo_bf(b4.w)); v[rr][j][1][3] = hi_bf(x4.w) + (hi_bf(a4.w) + hi_bf(b4.w)); }
        }
#pragma unroll
        for (int rr = 0; rr < 4; ++rr) { float t = 0.f;
#pragma unroll
            for (int j = 0; j < 2; ++j)
#pragma unroll
                for (int h = 0; h < 2; ++h) t += (v[rr][j][h][0] * v[rr][j][h][0] + v[rr][j][h][1] * v[rr][j][h][1]) + (v[rr][j][h][2] * v[rr][j][h][2] + v[rr][j][h][3] * v[rr][j][h][3]);
            ss[rr] = t; }
#pragma unroll
        for (int rr = 0; rr < 4; ++rr) ss[rr] = wave_sum(ss[rr]);
        if (mode) {
#pragma unroll
            for (int rr = 0; rr < 4; ++rr) { const float r = __builtin_amdgcn_rsqf(ss[rr] * (1.f / 1024.f) + 1e-6f); const size_t m = (size_t)(m0 + rr);
#pragma unroll
                for (int j = 0; j < 2; ++j) { GAS float* op = outp + m * 1024 + 8 * (lane + 64 * j); *(GAS f32x4*)op = v[rr][j][0] * r * gv[j][0]; *(GAS f32x4*)(op + 4) = v[rr][j][1] * r * gv[j][1]; } }
        } else {
            GAS unsigned char* hq = (GAS unsigned char*)(a.ws + WS_HQ); GAS float* hsc = (GAS float*)(a.ws + WS_HSC);
            float am[4];
#pragma unroll
            for (int rr = 0; rr < 4; ++rr) { const float r = __builtin_amdgcn_rsqf(ss[rr] * (1.f / 1024.f) + 1e-6f); const size_t m = (size_t)(m0 + rr); float t = 0.f;
#pragma unroll
                for (int j = 0; j < 2; ++j) {
                    if (l > 0) { u32x4 w; w.x = pk2(v[rr][j][0][0], v[rr][j][0][1]); w.y = pk2(v[rr][j][0][2], v[rr][j][0][3]); w.z = pk2(v[rr][j][1][0], v[rr][j][1][1]); w.w = pk2(v[rr][j][1][2], v[rr][j][1][3]);
                        *(GAS u32x4*)(xb + m * 1024 + 8 * (lane + 64 * j)) = w; }
#pragma unroll
                    for (int h = 0; h < 2; ++h) { const f32x4 y = v[rr][j][h] * r * gv[j][h]; v[rr][j][h] = y;
                        t = fmaxf(t, fmaxf(fmaxf(fabsf(y[0]), fabsf(y[1])), fmaxf(fabsf(y[2]), fabsf(y[3])))); } }
                am[rr] = t; }
#pragma unroll
            for (int rr = 0; rr < 4; ++rr) am[rr] = fmaxf(wave_max(am[rr]), 1e-20f);
#pragma unroll
            for (int rr = 0; rr < 4; ++rr) { const size_t m = (size_t)(m0 + rr); const float qs = 127.f * __builtin_amdgcn_rcpf(am[rr]);
                if (lane == 0) hsc[m] = am[rr] * (1.f / 127.f);
#pragma unroll
                for (int j = 0; j < 2; ++j) { u32x2 q2;
#pragma unroll
                    for (int h = 0; h < 2; ++h) { const f32x4 y = v[rr][j][h] * qs;
                        const unsigned q = ((unsigned)(int)__builtin_rintf(y[0]) & 255u) | (((unsigned)(int)__builtin_rintf(y[1]) & 255u) << 8) | (((unsigned)(int)__builtin_rintf(y[2]) & 255u) << 16) | (((unsigned)(int)__builtin_rintf(y[3]) & 255u) << 24);
                        if (h == 0) q2.x = q; else q2.y = q; }
                    *(GAS u32x2*)(hq + m * 1024 + 8 * (lane + 64 * j)) = q2; } }
        }
    }
}

DI int crow(int i, int hh) { return (i & 3) + 8 * (i >> 2) + 4 * hh; }
DI unsigned cvtpk(float lo, float hi) { f32x2 v = {lo, hi}; bf16x2_t b = __builtin_convertvector(v, bf16x2_t); return __builtin_bit_cast(unsigned, b); }
template <int CTRL, int RMASK> DI float dppf(float oldv, float v) { return __builtin_bit_cast(float, __builtin_amdgcn_update_dpp(__builtin_bit_cast(int, oldv), __builtin_bit_cast(int, v), CTRL, RMASK, 0xf, false)); }
template <int CTRL, int RMASK> DI void scan_step(float& a, float& b) {
    const float ap = dppf<CTRL, RMASK>(1.f, a), bp = dppf<CTRL, RMASK>(0.f, b); b = a * bp + b; a = a * ap; }
DI void lru_consts(const KA& a, int l, int hbk, LAS unsigned char* lds, int wave, int lane) {
    if (wave == 0) { LAS float* cst = (LAS float*)(lds + LRUCST_OFF); const int c = hbk * 64 + lane;
        const GAS float* q8 = (const GAS float*)a.in[8]; const GAS float* q10 = (const GAS float*)a.in[10]; const GAS float* q11 = (const GAS float*)a.in[11];
        const float c8 = q8[l * 256 + c], c10 = q10[l * 256 + c], c11 = q11[l * 256 + c];
        cst[lane] = -1.4426950408889634f * c8; cst[64 + lane] = -1.4426950408889634f * c10; cst[128 + lane] = -8.f * 1.4426950408889634f * softplusf_(-c11); }
}
DI void lru_unit(const KA& a, int l, const GAS bf16* proj, GAS bf16* ys, GAS float* sums, LAS unsigned char* lds, int task, int lane_in, int wave_in, bool final) {
    int lane = lane_in, wave = wave_in; asm volatile("" : "+v"(lane), "+s"(wave));
    const int chunk = task & 31, hbk = (task >> 5) & 3, b = task >> 7;
    const int ts = chunk * 256 + wave * 32; const size_t rowb = (size_t)b * SEQ;
    LAS unsigned char* wl = lds + wave * 16384;
    LAS float* ex = (LAS float*)(lds + LRUEX_OFF); LAS float* cst = (LAS float*)(lds + LRUCST_OFF); LAS float* car = (LAS float*)(lds + LRUCAR_OFF) + wave * 64;
    const int n = lane & 31, hh = lane >> 5;
    const int c = hbk * 64 + lane;
    const GAS float* cw = (const GAS float*)(a.in[5] + (size_t)l * 4 * 256);
    const GAS float* p6 = (const GAS float*)a.in[6];
    const float cw0 = cw[c], cw1 = cw[256 + c], cw2 = cw[512 + c], cw3 = cw[768 + c]; const float cb = p6[l * 256 + c];
    const GAS bf16* xp = proj + (size_t)((C_AX >> 6) + hbk) * PGS + (rowb + ts) * 64 + lane;
    unsigned short xraw[35];
#pragma unroll
    for (int j = 0; j < 3; ++j) { const unsigned short xv = *(const GAS unsigned short*)(xp - (ts >= 3 - j ? (3 - j) * 64 : 0)); xraw[j] = (ts >= 3 - j) ? xv : (unsigned short)0; }
#pragma unroll
    for (int j = 0; j < 32; ++j) xraw[3 + j] = *(const GAS unsigned short*)(xp + (size_t)j * 64);
    const GAS bf16* wt = (const GAS bf16*)(a.ws + WS_LRUW) + (size_t)hbk * 8192;
    bf16x8 afr[4][4];
#pragma unroll
    for (int m = 0; m < 4; ++m)
#pragma unroll
        for (int s4 = 0; s4 < 4; ++s4) afr[m][s4] = *(const GAS bf16x8*)(wt + (size_t)(m >> 1) * 4096 + (32 * (m & 1) + n) * 64 + 8 * hh + 16 * s4);
    f32x2 sv[31]; u32x2 gt2[2][4];
    const GAS bf16* gp = proj + (size_t)((C_AG >> 6) + hbk) * PGS + (rowb + ts + n) * 64;
    if (final) {
        const GAS f32x2* sp = (const GAS f32x2*)(sums + ((size_t)((b * 4 + hbk) * 32) * 64 + lane) * 2);
#pragma unroll
        for (int cc = 0; cc < 31; ++cc) { const int ci = cc < chunk ? cc : 0; sv[cc] = sp[(size_t)ci * 64]; }
#pragma unroll
        for (int mm = 0; mm < 2; ++mm)
#pragma unroll
            for (int g4 = 0; g4 < 4; ++g4) gt2[mm][g4] = *(const GAS u32x2*)(gp + 32 * mm + 8 * g4 + 4 * hh);
    }
    {
        float x3 = __builtin_bit_cast(float, (unsigned)xraw[0] << 16), x2 = __builtin_bit_cast(float, (unsigned)xraw[1] << 16), x1 = __builtin_bit_cast(float, (unsigned)xraw[2] << 16);
#pragma unroll
        for (int j = 0; j < 32; ++j) { const float x0 = __builtin_bit_cast(float, (unsigned)xraw[3 + j] << 16); const float xc = cb + cw0 * x3 + cw1 * x2 + cw2 * x1 + cw3 * x0;
            *(LAS bf16*)(wl + j * 144 + lane * 2) = (bf16)f2bf(xc); *(LAS float*)(wl + 4608 + j * 272 + lane * 4) = xc; x3 = x2; x2 = x1; x1 = x0; }
    }
    f32x16 D[4];
    {
        bf16x8 bfr[4];
        LDS_WAIT();
#pragma unroll
        for (int s4 = 0; s4 < 4; ++s4) bfr[s4] = *(const LAS bf16x8*)(wl + n * 144 + hh * 16 + s4 * 32);
#pragma unroll
        for (int m = 0; m < 4; ++m) {
#pragma unroll
            for (int s4 = 0; s4 < 4; ++s4) {
                if (s4 == 0) { f32x16 z;
#pragma unroll
                    for (int i = 0; i < 16; ++i) z[i] = 0.f;
                    D[m] = MFMA32(afr[m][s4], bfr[s4], z); } else D[m] = MFMA32(afr[m][s4], bfr[s4], D[m]); } }
    }
    const bool t0 = (ts + n) == 0;
#pragma unroll
    for (int mm = 0; mm < 2; ++mm)
#pragma unroll
        for (int g4 = 0; g4 < 4; ++g4) { const int c0 = 32 * mm + 8 * g4 + 4 * hh;
            const f32x4 vba = *(const LAS f32x4*)(cst + c0), vbx = *(const LAS f32x4*)(cst + 64 + c0), vc8 = *(const LAS f32x4*)(cst + 128 + c0);
            const f32x4 vxc = *(const LAS f32x4*)(wl + 4608 + n * 272 + c0 * 4);
            float aa[4], bb[4];
#pragma unroll
            for (int e = 0; e < 4; ++e) { const int i = 4 * g4 + e;
                const float r = __builtin_amdgcn_rcpf(1.f + __builtin_amdgcn_exp2f(D[mm][i] * -1.4426950408889634f + vba[e]));
                const float ig = __builtin_amdgcn_rcpf(1.f + __builtin_amdgcn_exp2f(D[2 + mm][i] * -1.4426950408889634f + vbx[e]));
                const float av = __builtin_amdgcn_exp2f(vc8[e] * r);
                const float mult = t0 ? 1.f : __builtin_amdgcn_sqrtf(fmaxf(1.f - av * av, 0.f));
                aa[e] = av; bb[e] = mult * ig * vxc[e]; }
#define LRU_SCAN_STEP(CTRL) \
                "v_fmac_f32_dpp %4, %4, %0 " CTRL "\n\tv_fmac_f32_dpp %5, %5, %1 " CTRL "\n\tv_fmac_f32_dpp %6, %6, %2 " CTRL "\n\tv_fmac_f32_dpp %7, %7, %3 " CTRL "\n\t" \
                "v_mul_f32_dpp %0, %0, %0 " CTRL "\n\tv_mul_f32_dpp %1, %1, %1 " CTRL "\n\tv_mul_f32_dpp %2, %2, %2 " CTRL "\n\tv_mul_f32_dpp %3, %3, %3 " CTRL "\n\t"
            asm volatile("s_nop 1\n\t"
                LRU_SCAN_STEP("row_shr:1 row_mask:0xf bank_mask:0xf") LRU_SCAN_STEP("row_shr:2 row_mask:0xf bank_mask:0xf") LRU_SCAN_STEP("row_shr:4 row_mask:0xf bank_mask:0xf")
                LRU_SCAN_STEP("row_shr:8 row_mask:0xf bank_mask:0xf") LRU_SCAN_STEP("row_bcast:15 row_mask:0xa bank_mask:0xf")
                : "+v"(aa[0]), "+v"(aa[1]), "+v"(aa[2]), "+v"(aa[3]), "+v"(bb[0]), "+v"(bb[1]), "+v"(bb[2]), "+v"(bb[3]));
#undef LRU_SCAN_STEP
#pragma unroll
            for (int e = 0; e < 4; ++e) { D[mm][4 * g4 + e] = aa[e]; D[2 + mm][4 * g4 + e] = bb[e]; } }
    if (n == 31) {
#pragma unroll
        for (int mm = 0; mm < 2; ++mm)
#pragma unroll
            for (int i = 0; i < 16; ++i) { const int c = 32 * mm + crow(i, hh); ex[(wave * 64 + c) * 2] = D[mm][i]; ex[(wave * 64 + c) * 2 + 1] = D[2 + mm][i]; } }
    __syncthreads();
    if (!final) {
        if (wave == 0) { float hv = 0.f, av = 1.f;
#pragma unroll
            for (int w = 0; w < 8; ++w) { const float A_ = ex[(w * 64 + lane) * 2], H_ = ex[(w * 64 + lane) * 2 + 1]; hv = A_ * hv + H_; av *= A_; }
            GAS float* sp = sums + ((size_t)((b * 4 + hbk) * 32 + chunk) * 64 + lane) * 2; sp[0] = av; sp[1] = hv; }
    } else {
        {   float hv = 0.f;
#pragma unroll
            for (int cc = 0; cc < 31; ++cc) { const float A_ = cc < chunk ? sv[cc][0] : 1.f, H_ = cc < chunk ? sv[cc][1] : 0.f; hv = A_ * hv + H_; }
            for (int w = 0; w < wave; ++w) { const float A_ = ex[(w * 64 + lane) * 2], H_ = ex[(w * 64 + lane) * 2 + 1]; hv = A_ * hv + H_; }
            car[lane] = hv; }
        LDS_WAIT(); asm volatile("" ::: "memory");
        GAS bf16* yp = ys + (rowb + ts + n) * 1024 + hbk * 64;
#pragma unroll
        for (int mm = 0; mm < 2; ++mm)
#pragma unroll
            for (int g4 = 0; g4 < 4; ++g4) { const int c0 = 32 * mm + 8 * g4 + 4 * hh; const f32x4 cv = *(const LAS f32x4*)(car + c0);
                const u32x2 gw2 = gt2[mm][g4]; float y[4];
#pragma unroll
                for (int e = 0; e < 4; ++e) { const int i = 4 * g4 + e; const float hv = D[2 + mm][i] + D[mm][i] * cv[e];
                    const float gt = (e == 0) ? lo_bf(gw2.x) : (e == 1) ? hi_bf(gw2.x) : (e == 2) ? lo_bf(gw2.y) : hi_bf(gw2.y); const float wv = gt * (2.302208198f + 0.102943240f * gt * gt);
                    y[e] = hv * (gt - gt * __builtin_amdgcn_rcpf(__builtin_amdgcn_exp2f(wv) + 1.f)); }
                u32x2 yo; yo.x = cvtpk(y[0], y[1]); yo.y = cvtpk(y[2], y[3]); *(GAS u32x2*)(yp + c0) = yo; }
    }
    __syncthreads();
}

constexpr int DK_STR = 144, DV_STR = 192, DBUF_BYTES = 64 * DK_STR + 64 * DV_STR;
DI bf16x8 pack_half(const f32x16& x, int s2) { u32x4 p;
    if (s2 == 0) { p.x = cvtpk(x[0], x[1]); p.y = cvtpk(x[2], x[3]); p.z = cvtpk(x[4], x[5]); p.w = cvtpk(x[6], x[7]); }
    else { p.x = cvtpk(x[8], x[9]); p.y = cvtpk(x[10], x[11]); p.z = cvtpk(x[12], x[13]); p.w = cvtpk(x[14], x[15]); }
    return __builtin_bit_cast(bf16x8, p); }
DI s16x4 vtr(const LAS unsigned char* p) { return __builtin_bit_cast(s16x4, __builtin_amdgcn_ds_read_tr16_b64_v4i16((LAS v4i16_t*)p)); }
DI float max16(const f32x16& x) { float a = fmaxf(fmaxf(x[0], x[1]), fmaxf(x[2], x[3])), b = fmaxf(fmaxf(x[4], x[5]), fmaxf(x[6], x[7])), c = fmaxf(fmaxf(x[8], x[9]), fmaxf(x[10], x[11])), d = fmaxf(fmaxf(x[12], x[13]), fmaxf(x[14], x[15])); return fmaxf(fmaxf(a, b), fmaxf(c, d)); }
DI void diff_unit(const GAS bf16* proj, GAS bf16* ys, LAS unsigned char* lds, const LAS float* bias2, const GAS float* subg, const LAS float* lamp, int b, int h, int qb, int wave_in) {
    int wave = wave_in; asm volatile("" : "+s"(wave)); const int lane = my_lane(); const int tid = wave * 64 + lane;
    const int q0 = qb * 256 + wave * 32; const int ql = lane & 31, hh = lane >> 5; const int q = q0 + ql;
    const size_t rowb = (size_t)b * SEQ;
    const float SC = 0.17677669529663687f * 1.4426950408889634f;
    bf16x8 qf[2][2];
    { const GAS bf16* qp = proj + (size_t)((C_CQ >> 6) + h) * PGS + (rowb + q) * 64 + hh * 8;
#pragma unroll
      for (int m = 0; m < 2; ++m)
#pragma unroll
        for (int s = 0; s < 2; ++s) { const u32x4 w = *(const GAS u32x4*)(qp + m * 32 + s * 16); u32x4 o;
            o.x = cvtpk(lo_bf(w.x) * SC, hi_bf(w.x) * SC); o.y = cvtpk(lo_bf(w.y) * SC, hi_bf(w.y) * SC); o.z = cvtpk(lo_bf(w.z) * SC, hi_bf(w.z) * SC); o.w = cvtpk(lo_bf(w.w) * SC, hi_bf(w.w) * SC);
            qf[m][s] = __builtin_bit_cast(bf16x8, o); } }
    f32x16 O[2][2], negm[2];
#pragma unroll
    for (int i = 0; i < 16; ++i) { O[0][0][i] = 0.f; O[0][1][i] = 0.f; O[1][0][i] = 0.f; O[1][1][i] = 0.f; negm[0][i] = 120.f; negm[1][i] = 120.f; }
    float lsum[2] = {0.f, 0.f};
    const int nsteps = 4 * qb + 4, mysteps = 4 * qb + (wave >> 1) + 1;
    constexpr int DSLOT = 16384;
    const GAS unsigned char* kgb = (const GAS unsigned char*)(proj + (size_t)((C_CK >> 6) + h) * PGS + rowb * 64);
    const GAS unsigned char* vgb = (const GAS unsigned char*)(proj + (size_t)((C_CV >> 6) + h) * PGS + rowb * 64);
    const int dr = 8 * wave + (lane >> 3), dp = lane & 7;
    const unsigned koffl = (unsigned)(dr * 128 + ((dp ^ ((dr >> 1) & 7)) << 4)), voffl = (unsigned)(dr * 128 + ((dp ^ (((dr >> 1) & 1) << 2)) << 4));
    const unsigned ldsw = (unsigned)wave * 1024u;
#define DIFF_DMA(TILE, SLOT) do { \
        __builtin_amdgcn_global_load_lds((const unsigned*)((const char*)kgb + (koffl + (unsigned)(TILE) * 8192u)), (LAS unsigned*)(lds + (SLOT) * DSLOT + ldsw), 16, 0, 0); \
        __builtin_amdgcn_global_load_lds((const unsigned*)((const char*)vgb + (voffl + (unsigned)(TILE) * 8192u)), (LAS unsigned*)(lds + (SLOT) * DSLOT + 8192 + ldsw), 16, 0, 0); } while (0)
    DIFF_DMA(0, 0); DIFF_DMA(1, 1);
    asm volatile("s_waitcnt vmcnt(2)\n\ts_barrier" ::: "memory");
    const int i16 = lane & 15, blk = (lane >> 4) & 1;
    int kaddr[2][2], vaddr[2];
    { const int swk = (ql >> 1) & 7, fv = (i16 >> 3) & 1;
#pragma unroll
      for (int m = 0; m < 2; ++m)
#pragma unroll
        for (int s2 = 0; s2 < 2; ++s2) kaddr[m][s2] = ql * 128 + (((4 * m + 2 * s2 + hh) ^ swk) << 4);
#pragma unroll
      for (int db = 0; db < 2; ++db) vaddr[db] = 8192 + (4 * hh + (i16 >> 2)) * 128 + ((4 * (db ^ fv) + 2 * blk + ((i16 & 3) >> 1)) << 4) + 8 * (i16 & 1); }
    int ci = 0;
#pragma unroll 1
    for (int kt = 0; kt < nsteps; ++kt) {
        const LAS unsigned char* cur = lds + ci * DSLOT;
        if (kt + 2 < nsteps) { const int s2i = (ci == 0) ? 2 : ci - 1; DIFF_DMA(kt + 2, s2i); }
        if (kt < mysteps) {
            const int kbase = kt * 64;
            const bool near = (q0 - (kbase + 63) < 113);
#pragma unroll
            for (int m = 0; m < 2; ++m) {
                bf16x8 pk[2][2];
                f32x16 S[2]; float ts = 0.f;
                {   bf16x8 kf[2][2];
#pragma unroll
                    for (int t = 0; t < 2; ++t)
#pragma unroll
                        for (int s = 0; s < 2; ++s) kf[t][s] = *(const LAS bf16x8*)(cur + kaddr[m][s] + t * 4096);
#pragma unroll
                    for (int t = 0; t < 2; ++t) { S[t] = MFMA32(kf[t][0], qf[m][0], negm[m]); S[t] = MFMA32(kf[t][1], qf[m][1], S[t]); } }
                if (near) {
#pragma unroll
                    for (int t = 0; t < 2; ++t)
#pragma unroll
                        for (int g = 0; g < 2; ++g) { float tb[8];
#pragma unroll
                            for (int j = 0; j < 8; ++j) { const int dist = q - (kbase + 32 * t + crow(8 * g + j, hh)); const int di = dist < 0 ? 0 : (dist < 128 ? dist : 128); tb[j] = bias2[di * 12 + 4 + h]; }
#pragma unroll
                            for (int j = 0; j < 8; ++j) { const int dist = q - (kbase + 32 * t + crow(8 * g + j, hh)); S[t][8 * g + j] += dist >= 0 ? tb[j] : -1e30f; }
                            __builtin_amdgcn_sched_barrier(0); } }
#pragma unroll
                for (int t = 0; t < 2; ++t)
#pragma unroll
                    for (int i = 0; i < 16; ++i) { const float p = __builtin_amdgcn_exp2f(S[t][i]); S[t][i] = p; ts += p; }
                if (__builtin_amdgcn_ballot_w64(!(ts < 1.0e30f)) != 0ull) {
                {   bf16x8 kf[2][2];
#pragma unroll
                        for (int t = 0; t < 2; ++t)
#pragma unroll
                            for (int s = 0; s < 2; ++s) kf[t][s] = *(const LAS bf16x8*)(cur + kaddr[m][s] + t * 4096);
#pragma unroll
                        for (int t = 0; t < 2; ++t) { S[t] = MFMA32(kf[t][0], qf[m][0], negm[m]); S[t] = MFMA32(kf[t][1], qf[m][1], S[t]); } }
                    if (near) {
#pragma unroll
                        for (int t = 0; t < 2; ++t)
#pragma unroll
                            for (int g = 0; g < 2; ++g) { float tb[8];
#pragma unroll
                                for (int j = 0; j < 8; ++j) { const int dist = q - (kbase + 32 * t + crow(8 * g + j, hh)); const int di = dist < 0 ? 0 : (dist < 128 ? dist : 128); tb[j] = bias2[di * 12 + 4 + h]; }
#pragma unroll
                                for (int j = 0; j < 8; ++j) { const int dist = q - (kbase + 32 * t + crow(8 * g + j, hh)); S[t][8 * g + j] += dist >= 0 ? tb[j] : -1e30f; }
                                __builtin_amdgcn_sched_barrier(0); } }
                    float tm = fmaxf(max16(S[0]), max16(S[1])); tm = fmaxf(tm, xshfl<32>(tm));
                    const float sh = fmaxf(tm, 0.f); const float al = __builtin_amdgcn_exp2f(-sh);
                    lsum[m] *= al; ts = 0.f;
#pragma unroll
                    for (int i = 0; i < 16; ++i) { O[m][0][i] *= al; O[m][1][i] *= al; negm[m][i] -= sh; }
#pragma unroll
                    for (int t = 0; t < 2; ++t)
#pragma unroll
                        for (int i = 0; i < 16; ++i) { const float p = __builtin_amdgcn_exp2f(S[t][i] - sh); S[t][i] = p; ts += p; }
                }
                lsum[m] += ts;
#pragma unroll
                for (int t = 0; t < 2; ++t) { pk[t][0] = pack_half(S[t], 0); pk[t][1] = pack_half(S[t], 1); }
#pragma unroll
                for (int t = 0; t < 2; ++t)
#pragma unroll
                    for (int s2 = 0; s2 < 2; ++s2)
#pragma unroll
                        for (int db = 0; db < 2; ++db) {
                            const s16x4 lo = vtr(cur + vaddr[db] + (32 * t + 16 * s2) * 128), hi = vtr(cur + vaddr[db] + (32 * t + 16 * s2 + 8) * 128);
                            const bf16x8 vf = __builtin_shufflevector(lo, hi, 0, 1, 2, 3, 4, 5, 6, 7);
                            O[m][db] = MFMA32(vf, pk[t][s2], O[m][db]); }
                ;
            }
        }
        if (kt + 2 < nsteps) asm volatile("s_waitcnt vmcnt(2)\n\ts_barrier" ::: "memory"); else asm volatile("s_waitcnt vmcnt(0)\n\ts_barrier" ::: "memory");
        ci = (ci == 2) ? 0 : ci + 1;
    }
#undef DIFF_DMA
    const float l0 = lsum[0] + xshfl<32>(lsum[0]), l1 = lsum[1] + xshfl<32>(lsum[1]);
    const float lam = lamp[0], lam_init = lamp[1];
    const float i0 = 1.f / fmaxf(l0, 1e-30f), i1 = lam / fmaxf(l1, 1e-30f);
    float ss = 0.f;
#pragma unroll
    for (int db = 0; db < 2; ++db)
#pragma unroll
        for (int i = 0; i < 16; ++i) { const float at = O[0][db][i] * i0 - O[1][db][i] * i1; O[0][db][i] = at; ss += at * at; }
    ss += xshfl<32>(ss);
    const float r = (1.f - lam_init) / sqrtf(ss * (1.f / 64.f) + 1e-5f);
    GAS bf16* op = ys + (rowb + q) * 1024 + 512 + h * 64;
#pragma unroll
    for (int db = 0; db < 2; ++db)
#pragma unroll
        for (int gq = 0; gq < 4; ++gq) { const int d0 = 32 * db + 8 * gq + 4 * hh; const f32x4 sg = *(const GAS f32x4*)(subg + d0);
            u32x2 w; w.x = cvtpk(O[0][db][4 * gq + 0] * r * sg[0], O[0][db][4 * gq + 1] * r * sg[1]); w.y = cvtpk(O[0][db][4 * gq + 2] * r * sg[2], O[0][db][4 * gq + 3] * r * sg[3]);
            *(GAS u32x2*)(op + d0) = w; }
}

struct SchedCmp { const char* proj; const char* wc; int G, c;
    DI bool next(int i, Unit& u) const { const int L = i * G + c; if (L >= 16) return false; const int kv = L >> 3, rt = L & 7;
        u.pm = rt; u.pn = 0; u.aux = kv; u.pad = 0; u.a = proj + ((size_t)rt * 256 * 16 * PLD + (kv ? C_VC : C_KC)) * 2; u.b = wc + (size_t)kv * 256 * 1024 * 2; return true; } };
struct EpiCmp { static constexpr bool CARRY = false; float* ab;
    DI void operator()(const f32x4 (&acc)[2][2][4][2], const Unit& u, int wr, int wc, int fr, int fq) const {
        const int row0 = u.pm * 256 + wr * 64 + fr; const int col = wc * 32 + 8 * fq;
#pragma unroll
        for (int ai = 0; ai < 2; ++ai)
#pragma unroll
            for (int m = 0; m < 4; ++m) { float* rp = ab + ((size_t)u.aux * 2048 + row0 + ai * 128 + m * 16) * 128 + col; *(f32x4*)rp = acc[ai][0][m][0]; *(f32x4*)(rp + 4) = acc[ai][0][m][1]; }
    }
};
DI void cmp_finish(const KA& a, int l, const float* ab, bf16* kcb, int task, int lane) {
    const int kv = task / (BATCH * NCMP), r = task % (BATCH * NCMP), b = r / NCMP, c = r % NCMP;
    const float* w2 = a.in[kv ? 23 : 20] + (size_t)l * 4096; const float* pt = ab + 2 * 2048 * 128;
    const size_t g = (size_t)kv * 2048 + b * 512 + c;
    float ptv = 0.f;
#pragma unroll
    for (int part = 0; part < 32; ++part) ptv += pt[(kv * 32 + part) * 64 + lane];
    const float h1 = ab[g * 128 + lane] + ab[(g + 1) * 128 + 64 + lane] + ptv;
    const float gl = gelu_tanh(h1); float o = 0.f;
#pragma unroll
    for (int j = 0; j < 64; ++j) o += rl(gl, j) * w2[j * 64 + lane];
    kcb[((size_t)(kv * BATCH + b) * 512 + c) * 64 + lane] = (bf16)f2bf(o);
    if (c == NCMP - 1) kcb[((size_t)(kv * BATCH + b) * 512 + NCMP) * 64 + lane] = 0;
}

DI void cmp_block(const KA& a, int l, const GAS bf16* proj, const GAS bf16* wcT, float* ab, bf16* kcb, int bid, int wave, int lane) {
    const int kv = bid >> 7, g0 = (bid & 127) * 16, r = lane & 15, q = lane >> 4, sh = wave >> 2;
    const int grow = g0 + r + sh; const bool st_ok = !(sh != 0 && (grow & 511) == 0);
    const int gld = grow > 2047 ? 2047 : grow;
    const GAS bf16* apn = proj + (size_t)((kv ? C_VC : C_KC) >> 6) * PGS + (size_t)gld * 16 * 64 + 8 * q;
    const GAS bf16* bpn = wcT + ((size_t)kv * 256 + wave * 16 + r) * 1024 + 8 * q;
    f32x4 acc = {0.f, 0.f, 0.f, 0.f};
#pragma unroll 16
    for (int s = 0; s < 32; ++s) {
        const bf16x8 av = *(const GAS bf16x8*)(apn + 32 * s);
        const bf16x8 bv = *(const GAS bf16x8*)(bpn + 32 * s);
        acc = __builtin_amdgcn_mfma_f32_16x16x32_bf16(bv, av, acc, 0, 0, 0);
    }
    if (st_ok) *(GAS f32x4*)((GAS float*)ab + ((size_t)kv * 2048 + grow) * 128 + wave * 16 + 4 * q) = acc;
    VM_WAIT(); __syncthreads();
    {   const float* w2 = a.in[kv ? 23 : 20] + (size_t)l * 4096; const float* pt = ab + 2 * 2048 * 128;
        const int ga = g0 + 2 * wave; const size_t gA = (size_t)kv * 2048 + ga;
        float ptp[32], w2v[64], hA[3], hB[3];
#pragma unroll
        for (int part = 0; part < 32; ++part) ptp[part] = pt[(kv * 32 + part) * 64 + lane];
#pragma unroll
        for (int i = 0; i < 2; ++i) { hA[i] = ab[(gA + i) * 128 + lane]; hB[i] = ab[(gA + i + 1) * 128 + 64 + lane]; }
#pragma unroll
        for (int j = 0; j < 64; ++j) w2v[j] = w2[j * 64 + lane];
        float ptv = 0.f;
#pragma unroll
        for (int part = 0; part < 32; ++part) ptv += ptp[part];
#pragma unroll
        for (int i = 0; i < 2; ++i) { const int g = ga + i, c = g & 511, b = g >> 9;
            if (c < NCMP) {
                const float gl = gelu_tanh(hA[i] + hB[i] + ptv); float o = 0.f;
#pragma unroll
                for (int j = 0; j < 64; ++j) o += rl(gl, j) * w2v[j];
                kcb[((size_t)(kv * BATCH + b) * 512 + c) * 64 + lane] = (bf16)f2bf(o);
                if (c == NCMP - 1) kcb[((size_t)(kv * BATCH + b) * 512 + NCMP) * 64 + lane] = 0; } }
    }
}

DI void st_load(const GAS unsigned char* kb, const GAS unsigned char* vb, unsigned off, u32x4& kr, u32x4& vr) { kr = *(const GAS u32x4*)(kb + off); vr = *(const GAS u32x4*)(vb + off); }
DI void st_write(LAS unsigned char* buf, int skey, int sch, const u32x4& kr, const u32x4& vr) { *(LAS u32x4*)(buf + skey * DK_STR + sch * 16) = kr; *(LAS u32x4*)(buf + 64 * DK_STR + skey * DV_STR + sch * 16) = vr; }
struct KVAddr { int k[4]; int v[2]; };
DI KVAddr kv_addr_swz(int lane) { KVAddr A; const int col = lane & 31, hh = lane >> 5, i16 = lane & 15, blk = (lane >> 4) & 1, swk = (col >> 1) & 7, fv = (i16 >> 3) & 1;
#pragma unroll
    for (int s4 = 0; s4 < 4; ++s4) A.k[s4] = col * 128 + (((2 * s4 + hh) ^ swk) << 4);
#pragma unroll
    for (int db = 0; db < 2; ++db) A.v[db] = 8192 + (4 * hh + (i16 >> 2)) * 128 + ((4 * (db ^ fv) + 2 * blk + ((i16 & 3) >> 1)) << 4) + 8 * (i16 & 1);
    return A; }
DI KVAddr kv_addr_pad(int kboff, int vboff) { KVAddr A;
#pragma unroll
    for (int s4 = 0; s4 < 4; ++s4) A.k[s4] = kboff + s4 * 32;
    A.v[0] = vboff; A.v[1] = vboff + 64; return A; }
DI void kv_dma(const GAS unsigned char* kb, const GAS unsigned char* vb, unsigned koffl, unsigned voffl, unsigned tileoff, LAS unsigned char* slot, unsigned ldsw) {
    __builtin_amdgcn_global_load_lds((const unsigned*)((const char*)kb + (koffl + tileoff)), (LAS unsigned*)(slot + ldsw), 16, 0, 0);
    __builtin_amdgcn_global_load_lds((const unsigned*)((const char*)vb + (voffl + tileoff)), (LAS unsigned*)(slot + 8192 + ldsw), 16, 0, 0);
}
template <int KT> DI void qk64(const LAS unsigned char* cur, const KVAddr& A, const bf16x8 (&qf)[4], const f32x16& cinit, f32x16 (&S)[2]) {
#pragma unroll
    for (int t = 0; t < 2; ++t) { S[t] = cinit;
#pragma unroll
        for (int s = 0; s < 4; ++s) { const bf16x8 kf = *(const LAS bf16x8*)(cur + A.k[s] + t * KT); S[t] = MFMA32(kf, qf[s], S[t]); } }
}
DI void qk32z(const LAS unsigned char* kt32, const KVAddr& A, const bf16x8 (&qf)[4], f32x16& S) {
#pragma unroll
    for (int s = 0; s < 4; ++s) { const bf16x8 kf = *(const LAS bf16x8*)(kt32 + A.k[s]);
        if (s == 0) { f32x16 z;
#pragma unroll
            for (int i = 0; i < 16; ++i) z[i] = 0.f;
            S = MFMA32(kf, qf[s], z); } else S = MFMA32(kf, qf[s], S); }
}
template <int VRS> DI void pv32(const LAS unsigned char* vt32, const KVAddr& A, const bf16x8 (&pk)[2], f32x16 (&O)[2]) {
#pragma unroll
    for (int s2 = 0; s2 < 2; ++s2)
#pragma unroll
        for (int db = 0; db < 2; ++db) {
            const s16x4 lo = vtr(vt32 + A.v[db] + (16 * s2) * VRS), hi = vtr(vt32 + A.v[db] + (16 * s2 + 8) * VRS);
            const bf16x8 vf = __builtin_shufflevector(lo, hi, 0, 1, 2, 3, 4, 5, 6, 7);
            O[db] = MFMA32(vf, pk[s2], O[db]); }
}
DI void mask_bias_cmp32(f32x16& S, int tcol_in, int cbase, int hh, const LAS float* b2h, float msub) {
    int tcol = tcol_in; asm volatile("" : "+v"(tcol));
#pragma unroll
    for (int g = 0; g < 2; ++g) {
        float bv[8];
#pragma unroll
        for (int j = 0; j < 8; ++j) { const int i = 8 * g + j; const int c = cbase + crow(i, hh); const int dist = tcol - 31 - 16 * c; const int di = dist < 0 ? 0 : (dist < 128 ? dist : 128); bv[j] = b2h[di * 12]; }
#pragma unroll
        for (int j = 0; j < 8; ++j) { const int i = 8 * g + j; const int c = cbase + crow(i, hh); const int dist = tcol - 31 - 16 * c; const bool ok = dist >= 0 && c < NCMP;
            const float sb = S[i] + (bv[j] - msub); S[i] = ok ? sb : -1e30f; }
        __builtin_amdgcn_sched_barrier(0); }
}
template <int VRS> DI void pv64(const LAS unsigned char* cur, const KVAddr& A, const bf16x8 (&pk)[2][2], f32x16 (&O)[2]) {
#pragma unroll
    for (int t = 0; t < 2; ++t)
#pragma unroll
        for (int s2 = 0; s2 < 2; ++s2)
#pragma unroll
            for (int db = 0; db < 2; ++db) {
                const s16x4 lo = vtr(cur + A.v[db] + (32 * t + 16 * s2) * VRS), hi = vtr(cur + A.v[db] + (32 * t + 16 * s2 + 8) * VRS);
                const bf16x8 vf = __builtin_shufflevector(lo, hi, 0, 1, 2, 3, 4, 5, 6, 7);
                O[db] = MFMA32(vf, pk[t][s2], O[db]); }
}
DI void softmax_step(f32x16 (&S)[2], f32x16 (&O)[2], f32x16& negm, float& lsum, bf16x8 (&pk)[2][2]) {
    float tm = fmaxf(max16(S[0]), max16(S[1]));
    if (__builtin_amdgcn_ballot_w64(tm > 8.f) != 0ull) {
        tm = fmaxf(tm, xshfl<32>(tm)); const float sh = fmaxf(tm, 0.f); const float al = __builtin_amdgcn_exp2f(-sh);
        lsum *= al;
#pragma unroll
        for (int i = 0; i < 16; ++i) { O[0][i] *= al; O[1][i] *= al; negm[i] -= sh; S[0][i] -= sh; S[1][i] -= sh; } }
#pragma unroll
    for (int t = 0; t < 2; ++t) {
#pragma unroll
        for (int i = 0; i < 16; ++i) { const float p = __builtin_amdgcn_exp2f(S[t][i]); S[t][i] = p; lsum += p; }
        pk[t][0] = pack_half(S[t], 0); pk[t][1] = pack_half(S[t], 1); }
}
DI void mask_bias(f32x16 (&S)[2], int tcol_in, int kbase, int hh, int W, bool colsel, const LAS float* b2h) {
    int tcol = tcol_in; asm volatile("" : "+v"(tcol));
#pragma unroll
    for (int t = 0; t < 2; ++t)
#pragma unroll
        for (int g = 0; g < 2; ++g) {
            float bv[8];
#pragma unroll
            for (int j = 0; j < 8; ++j) { const int i = 8 * g + j; const int dist = tcol - (kbase + 32 * t + crow(i, hh)); const int di = dist < 0 ? 0 : (dist < 128 ? dist : 128); bv[j] = b2h[di * 12]; }
#pragma unroll
            for (int j = 0; j < 8; ++j) { const int i = 8 * g + j; const int dist = tcol - (kbase + 32 * t + crow(i, hh)); const bool ok = colsel && dist >= 0 && dist < W;
                const float sb = S[t][i] + bv[j]; S[t][i] = ok ? sb : -1e30f; }
            __builtin_amdgcn_sched_barrier(0); }
}
template <int KT, int VRS> DI void sel_tile(const LAS unsigned char* cur, const KVAddr& A, const bf16x8 (&qf)[4], f32x16 (&Os)[2], f32x16& negm, float& lsel, bool near, bool bit, int t, int kbase, int hh, int W, const LAS float* b2h) {
    f32x16 S[2]; qk64<KT>(cur, A, qf, negm, S);
    if (near) mask_bias(S, t, kbase, hh, W, bit, b2h);
    float ts = 0.f;
#pragma unroll
    for (int tt = 0; tt < 2; ++tt)
#pragma unroll
        for (int i = 0; i < 16; ++i) { const float p = __builtin_amdgcn_exp2f(S[tt][i]); S[tt][i] = p; ts += p; }
    ts = bit ? ts : 0.f;
    if (__builtin_amdgcn_ballot_w64(!(ts < 1.0e30f)) != 0ull) {
        qk64<KT>(cur, A, qf, negm, S);
        if (near) mask_bias(S, t, kbase, hh, W, bit, b2h);
        float tm = fmaxf(max16(S[0]), max16(S[1])); tm = bit ? tm : -1e30f; tm = fmaxf(tm, xshfl<32>(tm));
        const float sh = fmaxf(tm, 0.f); const float al = __builtin_amdgcn_exp2f(-sh);
        lsel *= al; ts = 0.f;
#pragma unroll
        for (int i = 0; i < 16; ++i) { Os[0][i] *= al; Os[1][i] *= al; negm[i] -= sh; }
#pragma unroll
        for (int tt = 0; tt < 2; ++tt)
#pragma unroll
            for (int i = 0; i < 16; ++i) { const float p = __builtin_amdgcn_exp2f(S[tt][i] - sh); S[tt][i] = p; ts += p; }
        ts = bit ? ts : 0.f;
    }
    lsel += ts;
    const unsigned km = bit ? 0xFFFFFFFFu : 0u; bf16x8 pk[2][2];
#pragma unroll
    for (int tt = 0; tt < 2; ++tt)
#pragma unroll
        for (int hf = 0; hf < 2; ++hf) { u32x4 w = __builtin_bit_cast(u32x4, pack_half(S[tt], hf)); w.x &= km; w.y &= km; w.z &= km; w.w &= km; pk[tt][hf] = __builtin_bit_cast(bf16x8, w); }
    pv64<VRS>(cur, A, pk, Os);
}
DI void nsa_unit(const GAS bf16* proj, GAS bf16* ys, const GAS bf16* kcb, LAS unsigned char* lds, const LAS float* bias2, int b, int u, int tid_in, int lane_in, int wave_in) {
    (void)tid_in; (void)lane_in; int wave = wave_in; asm volatile("" : "+s"(wave)); const int lane = my_lane(); const int tid = wave * 64 + lane;
    const int t0 = u * 64; const int col = lane & 31, hh = lane >> 5, tl = col >> 2, head = col & 3;
    const int t = t0 + wave * 8 + tl; const int tw0 = t0 + wave * 8;
    const size_t rowb = (size_t)b * SEQ;
    const LAS float* b2h = bias2 + 8 + head;
    bf16x8 qf[4];
    { const float SC = 0.125f * 1.4426950408889634f; const GAS bf16* qp = proj + (size_t)((C_DQ >> 6) + head) * PGS + (rowb + t) * 64 + hh * 8;
#pragma unroll
      for (int s = 0; s < 4; ++s) { const u32x4 w = *(const GAS u32x4*)(qp + s * 16); u32x4 o;
          o.x = cvtpk(lo_bf(w.x) * SC, hi_bf(w.x) * SC); o.y = cvtpk(lo_bf(w.y) * SC, hi_bf(w.y) * SC); o.z = cvtpk(lo_bf(w.z) * SC, hi_bf(w.z) * SC); o.w = cvtpk(lo_bf(w.w) * SC, hi_bf(w.w) * SC);
          qf[s] = __builtin_bit_cast(bf16x8, o); } }
    constexpr int DSLOT = 16384;
    const KVAddr A = kv_addr_swz(lane);
    const int dr = 8 * wave + (lane >> 3), dp = lane & 7;
    const unsigned koffl0 = (unsigned)(dr * 128 + ((dp ^ ((dr >> 1) & 7)) << 4)), voffl0 = (unsigned)(dr * 128 + ((dp ^ (((dr >> 1) & 1) << 2)) << 4));
    const unsigned ldsw = (unsigned)wave * 1024u;
    (void)tid;
    const int ncvm = (4 * u + 3) < NCMP ? (4 * u + 3) : NCMP;
    const int nsc = (ncvm + 63) >> 6;
    const GAS unsigned char* kcp = (const GAS unsigned char*)(kcb + (size_t)(0 * BATCH + b) * 512 * 64);
    const GAS unsigned char* vcp = (const GAS unsigned char*)(kcb + (size_t)(1 * BATCH + b) * 512 * 64);
    float mc = -120.f, lc = 0.f;
    const float bfar = b2h[128 * 12];
#pragma unroll 1
    for (int kt = 0; kt < nsc; ++kt) kv_dma(kcp, vcp, koffl0, voffl0, (unsigned)kt * 8192u, lds + kt * DSLOT, ldsw);
    asm volatile("s_waitcnt vmcnt(0)\n\ts_barrier" ::: "memory");
    int cvis = (tw0 - 24) >= 0 ? ((tw0 - 24) >> 4) + 1 : 0; cvis = cvis < NCMP ? cvis : NCMP;
    const int nscw = (cvis + 63) >> 6;
    f32x16 Oc[2], imp[4]; bool redo; int tries = 0;
    {
        int kfar = (tw0 - 159 - 16 * 63) >= 0 ? ((tw0 - 159 - 16 * 63) / 1024 + 1) : 0; kfar = kfar < nscw ? kfar : nscw;
#pragma unroll 1
      do { redo = false; lc = 0.f;
#pragma unroll
        for (int i = 0; i < 16; ++i) { Oc[0][i] = 0.f; Oc[1][i] = 0.f; imp[0][i] = 0.f; imp[1][i] = 0.f; imp[2][i] = 0.f; imp[3][i] = 0.f; }
#pragma unroll 1
        for (int kt = 0; kt < kfar && !redo; ++kt) {
            const LAS unsigned char* cur = lds + kt * DSLOT;
#pragma unroll
            for (int tt = 0; tt < 2; ++tt) {
                f32x16 S; qk32z(cur + tt * 4096, A, qf, S);
                { const float bm = bfar - mc;
#pragma unroll
                  for (int i = 0; i < 16; ++i) S[i] += bm; }
                __builtin_amdgcn_sched_barrier(0);
                float ts = 0.f;
#pragma unroll
                for (int i = 0; i < 16; ++i) { const float p = __builtin_amdgcn_exp2f(S[i]); S[i] = p; ts += p; }
                if (tries < 8 && __builtin_amdgcn_ballot_w64(!(ts < 1.0e30f)) != 0ull) {
                    qk32z(cur + tt * 4096, A, qf, S);
                { const float bm = bfar - mc;
#pragma unroll
                    for (int i = 0; i < 16; ++i) S[i] += bm; }
                    float tm = max16(S); tm = fmaxf(tm, xshfl<32>(tm));
                    mc += fmaxf(tm, 0.f); redo = true; ++tries; break;
                }
                lc += ts;
                bf16x8 pk[2]; pk[0] = pack_half(S, 0); pk[1] = pack_half(S, 1);
                pv32<128>(cur + tt * 4096, A, pk, Oc);
                const int Tq = (2 * kt + tt) & 3, MB = (2 * kt + tt) >> 2;
#pragma unroll
                for (int s2 = 0; s2 < 2; ++s2) { u32x4 aw; unsigned e[8];
#pragma unroll
                    for (int jj = 0; jj < 8; ++jj) { const int kk = 16 * s2 + 8 * (jj >> 2) + 4 * hh + (jj & 3); const int delta = 32 * Tq + kk - 4 * col;
                        e[jj] = (delta == -1 || delta == 3) ? 0x3F80u : ((unsigned)delta <= 2u ? 0x4000u : 0u); }
                    aw.x = e[0] | (e[1] << 16); aw.y = e[2] | (e[3] << 16); aw.z = e[4] | (e[5] << 16); aw.w = e[6] | (e[7] << 16);
                    const bf16x8 af = __builtin_bit_cast(bf16x8, aw);
                    if (MB == 0) imp[0] = MFMA32(af, pk[s2], imp[0]); else if (MB == 1) imp[1] = MFMA32(af, pk[s2], imp[1]); else if (MB == 2) imp[2] = MFMA32(af, pk[s2], imp[2]); else imp[3] = MFMA32(af, pk[s2], imp[3]); }
                if (Tq == 3 && MB < 3) { u32x4 aw; aw.x = 0u; aw.y = 0u; aw.z = 0u; aw.w = (lane == 32) ? 0x3F800000u : 0u;
                    const bf16x8 af = __builtin_bit_cast(bf16x8, aw);
                    if (MB == 0) imp[1] = MFMA32(af, pk[1], imp[1]); else if (MB == 1) imp[2] = MFMA32(af, pk[1], imp[2]); else imp[3] = MFMA32(af, pk[1], imp[3]); }
            }
        }
#pragma unroll 1
        for (int kt = kfar; kt < nscw && !redo; ++kt) {
            const LAS unsigned char* cur = lds + kt * DSLOT;
#pragma unroll
            for (int tt = 0; tt < 2; ++tt) {
                if (tt == 1 && kt * 64 + 32 >= cvis) break;
                f32x16 S; qk32z(cur + tt * 4096, A, qf, S);
                mask_bias_cmp32(S, t, kt * 64 + tt * 32, hh, b2h, mc);
                float ts = 0.f;
#pragma unroll
                for (int i = 0; i < 16; ++i) { const float p = __builtin_amdgcn_exp2f(S[i]); S[i] = p; ts += p; }
                if (tries < 8 && __builtin_amdgcn_ballot_w64(!(ts < 1.0e30f)) != 0ull) {
                    qk32z(cur + tt * 4096, A, qf, S);
                    mask_bias_cmp32(S, t, kt * 64 + tt * 32, hh, b2h, mc);
                    float tm = max16(S); tm = fmaxf(tm, xshfl<32>(tm));
                    mc += fmaxf(tm, 0.f); redo = true; ++tries; break;
                }
                lc += ts;
                bf16x8 pk[2]; pk[0] = pack_half(S, 0); pk[1] = pack_half(S, 1);
                pv32<128>(cur + tt * 4096, A, pk, Oc);
                const int Tq = (2 * kt + tt) & 3, MB = (2 * kt + tt) >> 2;
#pragma unroll
                for (int s2 = 0; s2 < 2; ++s2) { u32x4 aw; unsigned e[8];
#pragma unroll
                    for (int jj = 0; jj < 8; ++jj) { const int kk = 16 * s2 + 8 * (jj >> 2) + 4 * hh + (jj & 3); const int delta = 32 * Tq + kk - 4 * col;
                        e[jj] = (delta == -1 || delta == 3) ? 0x3F80u : ((unsigned)delta <= 2u ? 0x4000u : 0u); }
                    aw.x = e[0] | (e[1] << 16); aw.y = e[2] | (e[3] << 16); aw.z = e[4] | (e[5] << 16); aw.w = e[6] | (e[7] << 16);
                    const bf16x8 af = __builtin_bit_cast(bf16x8, aw);
                    if (MB == 0) imp[0] = MFMA32(af, pk[s2], imp[0]); else if (MB == 1) imp[1] = MFMA32(af, pk[s2], imp[1]); else if (MB == 2) imp[2] = MFMA32(af, pk[s2], imp[2]); else imp[3] = MFMA32(af, pk[s2], imp[3]); }
                if (Tq == 3 && MB < 3) { u32x4 aw; aw.x = 0u; aw.y = 0u; aw.z = 0u; aw.w = (lane == 32) ? 0x3F800000u : 0u;
                    const bf16x8 af = __builtin_bit_cast(bf16x8, aw);
                    if (MB == 0) imp[1] = MFMA32(af, pk[1], imp[1]); else if (MB == 1) imp[2] = MFMA32(af, pk[1], imp[2]); else imp[3] = MFMA32(af, pk[1], imp[3]); }
            }
        }
      } while (redo);
        {   const float lt = lc + xshfl<32>(lc); const float inv = lt > 0.f ? 1.f / lt : 0.f;
#pragma unroll
            for (int i = 0; i < 16; ++i) { Oc[0][i] *= inv; Oc[1][i] *= inv; imp[0][i] *= inv; imp[1][i] *= inv; imp[2][i] *= inv; imp[3][i] *= inv; } }
        asm volatile("s_barrier" ::: "memory");
    }
    unsigned ocp[2][8];
#pragma unroll
    for (int db = 0; db < 2; ++db)
#pragma unroll
        for (int i = 0; i < 8; ++i) ocp[db][i] = cvtpk(Oc[db][2 * i], Oc[db][2 * i + 1]);
    unsigned sm0 = 0u, sm1 = 0u, sm2 = 0u, sm3 = 0u;
    {   const int cur_t = t >> 6; unsigned key[16];
#pragma unroll
        for (int i = 0; i < 16; ++i) {
            float v0 = imp[0][i], v1 = imp[1][i], v2 = imp[2][i], v3 = imp[3][i];
            v0 += xshfl<1>(v0); v0 += xshfl<2>(v0); v1 += xshfl<1>(v1); v1 += xshfl<2>(v1); v2 += xshfl<1>(v2); v2 += xshfl<2>(v2); v3 += xshfl<1>(v3); v3 += xshfl<2>(v3);
            const float val = head == 0 ? v0 : (head == 1 ? v1 : (head == 2 ? v2 : v3));
            const int j = 32 * head + crow(i, hh);
            const bool forced = (j == 0) || (j == cur_t) || (j == cur_t - 1);
            unsigned fx = (unsigned)(fminf(fmaxf(val, 0.f), 31.f) * 1048576.f) + 1u;
            fx = forced ? 0x1FFFFFFu : (j <= cur_t ? fx : 0u);
            key[i] = (fx << 7) | (unsigned)(127 - j); }
#pragma unroll 1
        for (int r = 0; r < 16; ++r) {
            unsigned w = key[0];
#pragma unroll
            for (int i = 1; i < 16; ++i) w = w > key[i] ? w : key[i];
            { unsigned o = (unsigned)xshfl_i<1>((int)w); w = w > o ? w : o; o = (unsigned)xshfl_i<2>((int)w); w = w > o ? w : o; o = (unsigned)xshfl_i<32>((int)w); w = w > o ? w : o; }
            if ((w >> 7) != 0u) { const int j = 127 - (int)(w & 127u); const unsigned bit = 1u << (j & 31); const int jb = j >> 5;
                sm0 |= (jb == 0) ? bit : 0u; sm1 |= (jb == 1) ? bit : 0u; sm2 |= (jb == 2) ? bit : 0u; sm3 |= (jb == 3) ? bit : 0u; }
#pragma unroll
            for (int i = 0; i < 16; ++i) key[i] = (key[i] == w) ? 0u : key[i];
        }
    }
    int lane_w = my_lane(); asm volatile("" : "+v"(lane_w));
    const int drw = 8 * wave + (lane_w >> 3), dpw = lane_w & 7;
    const unsigned koffl = (unsigned)(drw * 128 + ((dpw ^ ((drw >> 1) & 7)) << 4)), voffl = (unsigned)(drw * 128 + ((dpw ^ (((drw >> 1) & 1) << 2)) << 4));
    f32x16 Ow[2]; float lw = 0.f;
#pragma unroll
    for (int i = 0; i < 16; ++i) { Ow[0][i] = 0.f; Ow[1][i] = 0.f; }
    {   f32x16 negm;
#pragma unroll
        for (int i = 0; i < 16; ++i) negm[i] = 120.f;
        const GAS unsigned char* kwp = (const GAS unsigned char*)(proj + (size_t)(C_KW >> 6) * PGS + rowb * 64); const GAS unsigned char* vwp = (const GAS unsigned char*)(proj + (size_t)(C_VW >> 6) * PGS + rowb * 64);
        const int s0 = (u < 8) ? 8 - u : 0; const int nw = 9 - s0; const unsigned t0off = (unsigned)(u - 8 + s0) * 8192u;
        kv_dma(kwp, vwp, koffl, voffl, t0off, lds, ldsw);
        if (nw > 1) { kv_dma(kwp, vwp, koffl, voffl, t0off + 8192u, lds + DSLOT, ldsw); asm volatile("s_waitcnt vmcnt(2)\n\ts_barrier" ::: "memory"); }
        else asm volatile("s_waitcnt vmcnt(0)\n\ts_barrier" ::: "memory");
        int ci = 0;
#pragma unroll 1
        for (int i = 0; i < nw; ++i) { const int s = s0 + i;
            const LAS unsigned char* cur = lds + ci * DSLOT;
            if (i + 2 < nw) kv_dma(kwp, vwp, koffl, voffl, t0off + (unsigned)(i + 2) * 8192u, lds + ((ci == 0) ? 2 : ci - 1) * DSLOT, ldsw);
            sel_tile<4096, 128>(cur, A, qf, Ow, negm, lw, s == 0 || s >= 6, true, t, (u - 8 + s) * 64, hh, 512, b2h);
            if (i + 2 < nw) asm volatile("s_waitcnt vmcnt(2)\n\ts_barrier" ::: "memory"); else asm volatile("s_waitcnt vmcnt(0)\n\ts_barrier" ::: "memory");
            ci = (ci == 2) ? 0 : ci + 1;
        }
    }
    unsigned owp[2][8];
#pragma unroll
    for (int db = 0; db < 2; ++db)
#pragma unroll
        for (int i = 0; i < 8; ++i) owp[db][i] = cvtpk(Ow[db][2 * i], Ow[db][2 * i + 1]);
    f32x16 Os[2]; float lsel = 0.f;
#pragma unroll
    for (int i = 0; i < 16; ++i) { Os[0][i] = 0.f; Os[1][i] = 0.f; }
    {   f32x16 negm;
#pragma unroll
        for (int i = 0; i < 16; ++i) negm[i] = 120.f;
        const GAS unsigned char* ksp = (const GAS unsigned char*)(proj + (size_t)(C_KS >> 6) * PGS + rowb * 64); const GAS unsigned char* vsp = (const GAS unsigned char*)(proj + (size_t)(C_VS >> 6) * PGS + rowb * 64);
        const int npair = (u + 2) >> 1;
#define SEL_DMA(P, SL) do { const int ta_ = 2 * (P), tb_ = (2 * (P) + 1 <= u) ? 2 * (P) + 1 : u; \
            kv_dma(ksp, vsp, koffl, voffl, (unsigned)ta_ * 8192u, lds + (SL) * 2 * DSLOT, ldsw); kv_dma(ksp, vsp, koffl, voffl, (unsigned)tb_ * 8192u, lds + (SL) * 2 * DSLOT + DSLOT, ldsw); } while (0)
        SEL_DMA(0, 0);
        if (npair > 1) { SEL_DMA(1, 1); asm volatile("s_waitcnt vmcnt(4)\n\ts_barrier" ::: "memory"); }
        else asm volatile("s_waitcnt vmcnt(0)\n\ts_barrier" ::: "memory");
        int ci = 0;
#pragma unroll 1
        for (int p = 0; p < npair; ++p) {
            if (p + 2 < npair) SEL_DMA(p + 2, (ci == 0) ? 2 : ci - 1);
#pragma unroll 1
            for (int tt = 0; tt < 2; ++tt) { const int j = 2 * p + tt;
                if (j <= u) {
                    const LAS unsigned char* cur = lds + ci * 2 * DSLOT + tt * DSLOT;
                    const int jb = j >> 5; const unsigned smw = jb == 0 ? sm0 : (jb == 1 ? sm1 : (jb == 2 ? sm2 : sm3));
                    const bool bit = ((smw >> (j & 31)) & 1u) != 0u;
                    if (__builtin_amdgcn_ballot_w64(bit) != 0ull) sel_tile<4096, 128>(cur, A, qf, Os, negm, lsel, 64 * j + 63 > tw0 - 113, bit, t, 64 * j, hh, 1 << 30, b2h); } }
            if (p + 2 < npair) asm volatile("s_waitcnt vmcnt(4)\n\ts_barrier" ::: "memory"); else asm volatile("s_waitcnt vmcnt(0)\n\ts_barrier" ::: "memory");
            ci = (ci == 2) ? 0 : ci + 1;
        }
#undef SEL_DMA
    }
    {   const float lwt = lw + xshfl<32>(lw), lst = lsel + xshfl<32>(lsel);
        const GAS bf16* gp = proj + (size_t)(C_DG >> 6) * PGS + (rowb + t) * 64 + head * 3;
        const float g0 = sigmoidf_(bf2f(gp[0])), g1 = sigmoidf_(bf2f(gp[1])) / fmaxf(lst, 1e-30f), g2 = sigmoidf_(bf2f(gp[2])) / fmaxf(lwt, 1e-30f);
        GAS bf16* op = ys + (rowb + t) * 1024 + 768 + head * 64;
#pragma unroll
        for (int db = 0; db < 2; ++db)
#pragma unroll
            for (int gq = 0; gq < 4; ++gq) { const int d0 = 32 * db + 8 * gq + 4 * hh; float y[4];
#pragma unroll
                for (int e = 0; e < 4; ++e) { const unsigned cw = ocp[db][2 * gq + (e >> 1)], ww = owp[db][2 * gq + (e >> 1)];
                    y[e] = g0 * ((e & 1) ? hi_bf(cw) : lo_bf(cw)) + g1 * Os[db][4 * gq + e] + g2 * ((e & 1) ? hi_bf(ww) : lo_bf(ww)); }
                u32x2 w; w.x = cvtpk(y[0], y[1]); w.y = cvtpk(y[2], y[3]); *(GAS u32x2*)(op + d0) = w; }
    }
}


DI void swa_unit(const GAS bf16* proj, GAS bf16* ys, LAS unsigned char* lds, const LAS float* bias2, const LAS float* biasd, const GAS float* sinks, int b, int u, int tid_in, int lane_in, int wave_in) {
    int tid = tid_in, lane = lane_in, wave = wave_in; asm volatile("" : "+v"(tid), "+v"(lane), "+s"(wave));
    const int t0 = u * 64; const int col = lane & 31, hh = lane >> 5, tl = col >> 1, kv = wave & 1, head = 2 * kv + (col & 1);
    const int t = t0 + (wave >> 1) * 16 + tl;
    const size_t rowb = (size_t)b * SEQ;
    const LAS float* b2h = bias2 + head;
    bf16x8 qf[4];
    { const float SC = 0.125f * 1.4426950408889634f; const GAS bf16* qp = proj + (size_t)((C_BQ >> 6) + head) * PGS + (rowb + t) * 64 + hh * 8;
#pragma unroll
      for (int s = 0; s < 4; ++s) { const u32x4 w = *(const GAS u32x4*)(qp + s * 16); u32x4 o;
          o.x = cvtpk(lo_bf(w.x) * SC, hi_bf(w.x) * SC); o.y = cvtpk(lo_bf(w.y) * SC, hi_bf(w.y) * SC); o.z = cvtpk(lo_bf(w.z) * SC, hi_bf(w.z) * SC); o.w = cvtpk(lo_bf(w.w) * SC, hi_bf(w.w) * SC);
          qf[s] = __builtin_bit_cast(bf16x8, o); } }
    const int skey = tid >> 3, sch = tid & 7;
    const int i16 = lane & 15, blk = (lane >> 4) & 1;
    const int kboff = kv * DBUF_BYTES + col * DK_STR + hh * 16;
    const int vboff = kv * DBUF_BYTES + 64 * DK_STR + (4 * hh + (i16 >> 2)) * DV_STR + (16 * blk + 4 * (i16 & 3)) * 2;
    const GAS unsigned char* kp = (const GAS unsigned char*)(proj + (size_t)(C_BK >> 6) * PGS + rowb * 64); const GAS unsigned char* vp = (const GAS unsigned char*)(proj + (size_t)(C_BV >> 6) * PGS + rowb * 64);
    const unsigned soffp = (unsigned)(skey * 64 + sch * 8) * 2u;
    u32x4 k0, v0, k1, v1;
    f32x16 O[2], negm; float lsum = 0.f;
#pragma unroll
    for (int i = 0; i < 16; ++i) { O[0][i] = 0.f; O[1][i] = 0.f; negm[i] = 120.f; }
    const int s0 = (u < 2) ? 2 - u : 0;
    { const unsigned so = soffp + (unsigned)(u - 2 + s0) * 8192u; st_load(kp, vp, so, k0, v0); st_load(kp + PGS * 2, vp + PGS * 2, so, k1, v1);
      st_write(lds, skey, sch, k0, v0); st_write(lds + DBUF_BYTES, skey, sch, k1, v1); }
    __syncthreads();
#pragma unroll 1
    for (int s = s0; s < 3; ++s) {
        const int par = (s - s0) & 1; const LAS unsigned char* cur = lds + par * 2 * DBUF_BYTES; LAS unsigned char* nxt = lds + (par ^ 1) * 2 * DBUF_BYTES;
        if (s + 1 < 3) { const unsigned so = soffp + (unsigned)(u - 2 + s + 1) * 8192u; st_load(kp, vp, so, k0, v0); st_load(kp + PGS * 2, vp + PGS * 2, so, k1, v1); }
        sel_tile<32 * DK_STR, DV_STR>(cur, kv_addr_pad(kboff, vboff), qf, O, negm, lsum, true, true, t, (u - 2 + s) * 64, hh, 128, b2h);
        if (s + 1 < 3) { st_write(nxt, skey, sch, k0, v0); st_write(nxt + DBUF_BYTES, skey, sch, k1, v1); }
        __syncthreads();
    }
    {   const float sinkp = (sinks[head] - biasd[128 * 12 + head]) * 1.4426950408889634f;
        const float lt = lsum + xshfl<32>(lsum) + __builtin_amdgcn_exp2f(sinkp + negm[0]);
        const float inv = 1.f / fmaxf(lt, 1e-30f);
        GAS bf16* op = ys + (rowb + t) * 1024 + 256 + head * 64;
#pragma unroll
        for (int db = 0; db < 2; ++db)
#pragma unroll
            for (int gq = 0; gq < 4; ++gq) { const int d0 = 32 * db + 8 * gq + 4 * hh;
                u32x2 w; w.x = cvtpk(O[db][4 * gq + 0] * inv, O[db][4 * gq + 1] * inv); w.y = cvtpk(O[db][4 * gq + 2] * inv, O[db][4 * gq + 3] * inv); *(GAS u32x2*)(op + d0) = w; }
    }
}

DI void route_rows_load(const KA& a, int tok0, int lane, u32x4 (&raw)[4][2]) {
    const GAS bf16* xrow = (const GAS bf16*)(a.ws + WS_XB) + (size_t)tok0 * 1024;
#pragma unroll
    for (int rr = 0; rr < 4; ++rr)
#pragma unroll
        for (int j = 0; j < 2; ++j) raw[rr][j] = *(const GAS u32x4*)(xrow + (size_t)rr * 1024 + 8 * (lane + 64 * j));
}
DI void route_rows4(const u32x4 (&raw)[4][2], const f32x4 (&gvv)[2][2], bf16* xr_, unsigned char* xq_, float* xsc_, int tok0, int lane) {
    GAS bf16* xr = (GAS bf16*)xr_;
    f32x4 v[4][2][2]; float ss[4];
#pragma unroll
    for (int rr = 0; rr < 4; ++rr)
#pragma unroll
        for (int j = 0; j < 2; ++j) { const u32x4 w = raw[rr][j];
            v[rr][j][0][0] = lo_bf(w.x); v[rr][j][0][1] = hi_bf(w.x); v[rr][j][0][2] = lo_bf(w.y); v[rr][j][0][3] = hi_bf(w.y); v[rr][j][1][0] = lo_bf(w.z); v[rr][j][1][1] = hi_bf(w.z); v[rr][j][1][2] = lo_bf(w.w); v[rr][j][1][3] = hi_bf(w.w); }
#pragma unroll
    for (int rr = 0; rr < 4; ++rr) { float t = 0.f;
#pragma unroll
        for (int j = 0; j < 2; ++j)
#pragma unroll
            for (int h = 0; h < 2; ++h) t += (v[rr][j][h][0] * v[rr][j][h][0] + v[rr][j][h][1] * v[rr][j][h][1]) + (v[rr][j][h][2] * v[rr][j][h][2] + v[rr][j][h][3] * v[rr][j][h][3]);
        ss[rr] = t; }
#pragma unroll
    for (int rr = 0; rr < 4; ++rr) { ss[rr] = wave_sum(ss[rr]); ss[rr] = __builtin_amdgcn_rsqf(ss[rr] * (1.f / 1024.f) + 1e-6f); }
    float am[4];
#pragma unroll
    for (int rr = 0; rr < 4; ++rr) { float t = 0.f;
#pragma unroll
        for (int j = 0; j < 2; ++j)
#pragma unroll
            for (int h = 0; h < 2; ++h) { const f32x4 xn = v[rr][j][h] * ss[rr] * gvv[j][h]; v[rr][j][h] = xn;
                t = fmaxf(t, fmaxf(fmaxf(fabsf(xn[0]), fabsf(xn[1])), fmaxf(fabsf(xn[2]), fabsf(xn[3])))); }
        am[rr] = fmaxf(wave_max(t), 1e-20f); }
#pragma unroll
    for (int rr = 0; rr < 4; ++rr) { const float qs = 127.f * __builtin_amdgcn_rcpf(am[rr]);
        if (lane == 0) ((GAS float*)xsc_)[tok0 + rr] = am[rr] * (1.f / 127.f);
#pragma unroll
        for (int j = 0; j < 2; ++j) { u32x2 q2;
#pragma unroll
            for (int h = 0; h < 2; ++h) { const f32x4 y = v[rr][j][h] * qs;
                const unsigned q = ((unsigned)(int)__builtin_rintf(y[0]) & 255u) | (((unsigned)(int)__builtin_rintf(y[1]) & 255u) << 8) | (((unsigned)(int)__builtin_rintf(y[2]) & 255u) << 16) | (((unsigned)(int)__builtin_rintf(y[3]) & 255u) << 24);
                if (h == 0) q2.x = q; else q2.y = q; }
            *(GAS u32x2*)((GAS unsigned char*)xq_ + (size_t)(tok0 + rr) * 1024 + 8 * (lane + 64 * j)) = q2; } }
#pragma unroll
    for (int j = 0; j < 2; ++j) { const int k0 = 8 * (lane + 64 * j);
#pragma unroll
        for (int rr = 0; rr < 4; ++rr) { u32x4 wh, wl;
#pragma unroll
            for (int h = 0; h < 2; ++h) { const f32x4 xn = v[rr][j][h];
                const unsigned h0 = pk2(xn[0], xn[1]), h1 = pk2(xn[2], xn[3]);
                const unsigned l0 = pk2(xn[0] - __builtin_bit_cast(float, h0 << 16), xn[1] - __builtin_bit_cast(float, h0 & 0xFFFF0000u));
                const unsigned l1 = pk2(xn[2] - __builtin_bit_cast(float, h1 << 16), xn[3] - __builtin_bit_cast(float, h1 & 0xFFFF0000u));
                if (h == 0) { wh.x = h0; wh.y = h1; wl.x = l0; wl.y = l1; } else { wh.z = h0; wh.w = h1; wl.z = l0; wl.w = l1; } }
            *(GAS u32x4*)(xr + (size_t)(tok0 + rr) * 2048 + k0) = wh; *(GAS u32x4*)(xr + (size_t)(tok0 + rr) * 2048 + 1024 + k0) = wl; } }
}
DI void route_logits(const GAS bf16* xr, const GAS bf16* Wr, GAS float* rlog, LAS unsigned char* lds, int pm, int tid, int wave, int lane) {
    constexpr int WST = 528, CHB = 96 * WST;
    const int r = lane & 15, q = lane >> 4;
    const GAS bf16* xrow = xr + (size_t)(pm * 128 + wave * 16 + r) * 2048 + 8 * q;
    f32x4 acc[3];
#pragma unroll
    for (int nb = 0; nb < 3; ++nb) acc[nb] = (f32x4){0.f, 0.f, 0.f, 0.f};
    u32x4 wst[6];
#define RL_LOAD(C) { _Pragma("unroll") for (int i = 0; i < 6; ++i) { const int pc = tid + 512 * i; const int row = pc >> 5, piece = pc & 31; \
        const int srow = row < 48 ? row : 64 + (row - 48); wst[i] = *(const GAS u32x4*)(Wr + (size_t)srow * 2048 + 256 * (C) + 8 * piece); } }
#define RL_STORE(B) { _Pragma("unroll") for (int i = 0; i < 6; ++i) { const int pc = tid + 512 * i; const int row = pc >> 5, piece = pc & 31; \
        *(LAS u32x4*)(lds + (B) * CHB + row * WST + piece * 16) = wst[i]; } }
    RL_LOAD(0) RL_STORE(0)
    __syncthreads();
#pragma unroll 1
    for (int c = 0; c < 4; ++c) {
        const LAS unsigned char* wb = lds + (c & 1) * CHB;
        if (c + 1 < 4) RL_LOAD(c + 1)
        bf16x8 xh[8], xl[8];
#pragma unroll
        for (int s8 = 0; s8 < 8; ++s8) { xh[s8] = *(const GAS bf16x8*)(xrow + 256 * c + 32 * s8); xl[s8] = *(const GAS bf16x8*)(xrow + 1024 + 256 * c + 32 * s8); }
#pragma unroll
        for (int s8 = 0; s8 < 8; ++s8) {
#pragma unroll
            for (int nb = 0; nb < 3; ++nb) {
                const bf16x8 wh = *(const LAS bf16x8*)(wb + (16 * nb + r) * WST + 64 * s8 + 16 * q), wl = *(const LAS bf16x8*)(wb + (48 + 16 * nb + r) * WST + 64 * s8 + 16 * q);
                acc[nb] = __builtin_amdgcn_mfma_f32_16x16x32_bf16(wh, xh[s8], acc[nb], 0, 0, 0);
                acc[nb] = __builtin_amdgcn_mfma_f32_16x16x32_bf16(wh, xl[s8], acc[nb], 0, 0, 0);
                acc[nb] = __builtin_amdgcn_mfma_f32_16x16x32_bf16(wl, xh[s8], acc[nb], 0, 0, 0); } }
        if (c + 1 < 4) RL_STORE((c + 1) & 1)
        __syncthreads();
    }
#undef RL_LOAD
#undef RL_STORE
    GAS float* op = rlog + (size_t)(pm * 128 + wave * 16 + r) * 128 + 4 * q;
#pragma unroll
    for (int nb = 0; nb < 3; ++nb) *(GAS f32x4*)(op + 16 * nb) = acc[nb];
}
struct SchedRoute { const char* A; const char* B; int pm;
    DI bool next(int i, Unit& u) const { if (i > 0) return false; u.pm = pm; u.pn = 0; u.aux = 0; u.pad = 0; u.a = A + (size_t)pm * 128 * 2048 * 2; u.b = B; return true; } };
struct EpiRoute { static constexpr bool CARRY = false; float* rlog;
    DI void operator()(const f32x4 (&acc)[2][2][4][2], const Unit& u, int wr, int wc, int fr, int fq) const {
        const int row0 = u.pm * 128 + wr * 64 + fr; const int col = wc * 32 + 8 * fq;
#pragma unroll
        for (int m = 0; m < 4; ++m) { float* rp = rlog + (size_t)(row0 + m * 16) * 128 + col; *(f32x4*)rp = acc[0][0][m][0]; *(f32x4*)(rp + 4) = acc[0][0][m][1]; }
    }
};
DI void route_decide(const KA& a, int l, const float* rl_row, int& oe0, int& oe1, float& ow0, float& ow1) {
    float lg[36];
    const float* bg = a.in[30] + l * 4; const float* be = a.in[32] + l * 32;
#pragma unroll
    for (int q = 0; q < 9; ++q) { const f32x4 h = *(const f32x4*)(rl_row + 4 * q);
        lg[4 * q + 0] = h[0]; lg[4 * q + 1] = h[1]; lg[4 * q + 2] = h[2]; lg[4 * q + 3] = h[3]; }
#pragma unroll
    for (int i = 0; i < 4; ++i) lg[i] += bg[i];
#pragma unroll
    for (int i = 0; i < 32; ++i) lg[4 + i] += be[i];
    int gsel = 0; float gm = lg[0];
#pragma unroll
    for (int i = 1; i < 4; ++i) if (lg[i] > gm) { gm = lg[i]; gsel = i; }
    float gs = 0.f;
#pragma unroll
    for (int i = 0; i < 4; ++i) gs += __expf(lg[i] - gm);
    const float gwt = 1.f / gs;
    float v8[8];
#pragma unroll
    for (int i = 0; i < 8; ++i) { float x = lg[4 + i];
#pragma unroll
        for (int gq = 1; gq < 4; ++gq) x = (gsel == gq) ? lg[4 + gq * 8 + i] : x;
        v8[i] = x; }
    int i0 = 0; float m0 = v8[0];
#pragma unroll
    for (int i = 1; i < 8; ++i) if (v8[i] > m0) { m0 = v8[i]; i0 = i; }
    int i1 = -1; float m1 = -3e38f;
#pragma unroll
    for (int i = 0; i < 8; ++i) if (i != i0 && v8[i] > m1) { m1 = v8[i]; i1 = i; }
    if (i1 < 0) i1 = (i0 == 0) ? 1 : 0;
    const float w0 = 1.f / (1.f + __expf(m1 - m0)); const float w1 = 1.f - w0;
    const int e0 = gsel * 8 + i0, e1 = gsel * 8 + i1;
    oe0 = e0; oe1 = e1; ow0 = w0 * gwt; ow1 = w1 * gwt;
}
DI void expert_gu_i8(const KA& a, int l, LAS unsigned char* lds, int bid, int G, int wave, int lane) {
    LAS float* scr = (LAS float*)(lds + wave * 16384); LAS float* red = (LAS float*)(lds + 7 * 16384 + 12288);
    const GAS float* wgt = (const GAS float*)(a.in[33] + (size_t)l * 32 * 1024 * 256); const GAS float* wup = (const GAS float*)(a.in[34] + (size_t)l * 32 * 1024 * 256);
    GAS unsigned char* Wq = (GAS unsigned char*)(a.ws + WS_WGU); GAS float* wsc = (GAS float*)(a.ws + WS_WGSC);
    const int nq = 4 * (lane & 7), kr8 = lane >> 3;
    for (int it = bid; it < 512; it += G) {
        const int e = it >> 4, up = (it >> 3) & 1, n0 = (it & 7) * 32;
        const int drow0 = e * 512 + (n0 >> 7) * 256 + up * 128 + (n0 & 127);
        const GAS float* W = (up ? wup : wgt) + (size_t)e * 1024 * 256 + n0 + nq + (size_t)(128 * wave) * 256;
        f32x4 v[16];
#pragma unroll
        for (int i = 0; i < 16; ++i) v[i] = *(const GAS f32x4*)(W + (size_t)(8 * i + kr8) * 256);
        f32x4 mx = {0.f, 0.f, 0.f, 0.f};
#pragma unroll
        for (int i = 0; i < 16; ++i) { mx[0] = fmaxf(mx[0], fabsf(v[i][0])); mx[1] = fmaxf(mx[1], fabsf(v[i][1])); mx[2] = fmaxf(mx[2], fabsf(v[i][2])); mx[3] = fmaxf(mx[3], fabsf(v[i][3])); }
#pragma unroll
        for (int e4 = 0; e4 < 4; ++e4) { float m = mx[e4]; m = fmaxf(m, xshfl<8>(m)); m = fmaxf(m, xshfl<16>(m)); m = fmaxf(m, xshfl<32>(m)); mx[e4] = m; }
        if (kr8 == 0) {
#pragma unroll
            for (int e4 = 0; e4 < 4; ++e4) red[wave * 32 + nq + e4] = mx[e4]; }
        __syncthreads();
#pragma unroll
        for (int e4 = 0; e4 < 4; ++e4) { float m = red[nq + e4];
#pragma unroll
            for (int w = 1; w < 8; ++w) m = fmaxf(m, red[w * 32 + nq + e4]);
            mx[e4] = fmaxf(m, 1e-20f); }
        if (wave == 0 && kr8 == 0) *(GAS f32x4*)(wsc + drow0 + nq) = mx * (1.f / 127.f);
        const f32x4 qs = {127.f / mx[0], 127.f / mx[1], 127.f / mx[2], 127.f / mx[3]};
#pragma unroll
        for (int hb = 0; hb < 2; ++hb) {
#pragma unroll
            for (int i = 0; i < 8; ++i) { const int kk = 8 * i + kr8;
#pragma unroll
                for (int e4 = 0; e4 < 4; ++e4) scr[kk * 33 + nq + e4] = __builtin_rintf(v[8 * hb + i][e4] * qs[e4]); }
            LDS_WAIT(); asm volatile("" ::: "memory");
            const int n = lane >> 1, kh = lane & 1; u32x4 o[2];
#pragma unroll
            for (int h2 = 0; h2 < 2; ++h2) { unsigned w4[4];
#pragma unroll
                for (int d = 0; d < 4; ++d) { unsigned wv = 0u;
#pragma unroll
                    for (int e4 = 0; e4 < 4; ++e4) wv |= ((unsigned)(int)scr[(32 * kh + 16 * h2 + 4 * d + e4) * 33 + n] & 255u) << (8 * e4);
                    w4[d] = wv; }
                o[h2].x = w4[0]; o[h2].y = w4[1]; o[h2].z = w4[2]; o[h2].w = w4[3]; }
            { GAS unsigned char* dst = Wq + (size_t)(drow0 + n) * 1024 + 128 * wave + 64 * hb + 32 * kh; *(GAS u32x4*)dst = o[0]; *(GAS u32x4*)(dst + 16) = o[1]; }
            LDS_WAIT(); asm volatile("" ::: "memory");
        }
        __syncthreads();
    }
}
DI void expert_weights(const KA& a, int l, LAS unsigned char* lds, int it0, int it1, int gw, int NGW, int wave, int lane) {
    LAS float* scr = (LAS float*)(lds + wave * 16384);
    const float* wdn = a.in[35] + (size_t)l * 32 * 256 * 1024;
    bf16* Wd = (bf16*)(a.ws + WS_WD);
    constexpr int I_D = 4 * 16;
    const int nq = 4 * (lane & 15), kr4 = lane >> 4;
    for (int it = it0 + gw; it < it1; it += NGW) {
        const int e = it / I_D; const int r = it % I_D;
        const GAS float* src; GAS bf16* dst; int ldw, ldt;
        { const int kb = r / 16, nb = r % 16;
            src = (const GAS float*)(wdn + (size_t)e * 256 * 1024) + (size_t)(kb * 64) * 1024 + nb * 64; ldw = 1024;
            dst = (GAS bf16*)(Wd + (size_t)e * 1024 * 256) + (size_t)(nb * 64) * 256 + kb * 64; ldt = 256; }
        f32x4 v[16];
#pragma unroll
        for (int i = 0; i < 16; ++i) v[i] = *(const GAS f32x4*)(src + (size_t)(4 * i + kr4) * ldw + nq);
#pragma unroll
        for (int hn = 0; hn < 2; ++hn) {
            if (((lane >> 3) & 1) == hn) {
#pragma unroll
                for (int i = 0; i < 16; ++i) { const int kk = 4 * i + kr4;
#pragma unroll
                    for (int e2 = 0; e2 < 4; ++e2) scr[kk * 33 + (nq & 31) + e2] = v[i][e2]; } }
            LDS_WAIT(); asm volatile("" ::: "memory");
            const int c = lane & 7;
#pragma unroll
            for (int j = 0; j < 4; ++j) { const int n = (lane >> 3) + 8 * j; const LAS float* sp = scr + (8 * c) * 33 + n;
                u32x4 o; o.x = pk2(sp[0 * 33], sp[1 * 33]); o.y = pk2(sp[2 * 33], sp[3 * 33]); o.z = pk2(sp[4 * 33], sp[5 * 33]); o.w = pk2(sp[6 * 33], sp[7 * 33]);
                *(GAS u32x4*)(dst + (size_t)(32 * hn + n) * ldt + 8 * c) = o; }
            LDS_WAIT(); asm volatile("" ::: "memory");
        }
    }
}
DI void build_offsets(const unsigned* cnt, LAS int* offt, int tid) {
    int c = 0;
    if (tid < 32) { c = (int)__hip_atomic_load(cnt + tid * CNT_STRIDE, __ATOMIC_RELAXED, __HIP_MEMORY_SCOPE_AGENT); offt[330 + tid] = (c + 255) & ~255; }
    __syncthreads();
    if (tid == 0) { int o = 0;
#pragma unroll
        for (int e = 0; e < 32; ++e) { offt[e] = o; o += offt[330 + e]; } offt[32] = o; }
    __syncthreads();
    if (tid < 32) offt[330 + tid] = c;
    for (int rt = tid; rt < (MOE_ROWS >> 8); rt += 512) { int e = 0; for (int j = 1; j < 32; ++j) e += (offt[j] <= rt * 256) ? 1 : 0; offt[40 + rt] = e; }
    __syncthreads();
}

template <unsigned PM>
__global__ void __launch_bounds__(512, 2) mk_fwd(Args a_) {
    extern __shared__ __attribute__((aligned(16))) unsigned char lds_raw[];
    LAS unsigned char* lds = (LAS unsigned char*)lds_raw;
    const int wave0 = __builtin_amdgcn_readfirstlane((int)threadIdx.x >> 6);
    if (threadIdx.x < 36) ((LAS unsigned long long*)(lds + PTAB_OFF))[threadIdx.x] = (unsigned long long)a_.in[threadIdx.x];
    __syncthreads();
    KA a; a.in.base = (unsigned)(size_t)(lds + PTAB_OFF); a.out = a_.out; a.ws = a_.ws;
    const int G = gridDim.x, bid = blockIdx.x, NGW = G * 8;
#define PHASE_IDS() int wave = wave0; asm volatile("" : "+s"(wave)); const int lane = my_lane(); const int tid_ = wave * 64 + lane, gw = bid * 8 + wave; (void)tid_; (void)gw; \
    const int xb = ((bid & 7) << 5) | (bid >> 3); (void)xb;        \
    KA ap = a; asm volatile("" : "+s"(ap.ws), "+s"(ap.out), "+s"(ap.in.base)); \
    bf16* hb = (bf16*)(ap.ws + WS_HB); bf16* proj = (bf16*)(ap.ws + WS_PROJ); bf16* gates = (bf16*)(ap.ws + WS_GATES); \
    bf16* ys = hb; bf16* x2b = hb; bf16* merged = proj; bf16* eo = proj; \
    bf16* kcb = (bf16*)(ap.ws + WS_KCVC); float* lrusum = (float*)(ap.ws + WS_LRUSUM); \
    int* rec_e = (int*)(ap.ws + WS_REC); int* rec_slot = rec_e + T * 2; float* rec_w = (float*)(rec_slot + T * 2); \
    int* rowtok = (int*)(ap.ws + WS_ROWTOK); float* roww = (float*)(ap.ws + WS_ROWW); \
    bf16* xs = (bf16*)(ap.ws + WS_XS); bf16* hmid = (bf16*)(ap.ws + WS_HMID); unsigned* ctl = (unsigned*)(ap.ws + WS_CTL); \
    (void)hb; (void)proj; (void)gates; (void)ys; (void)x2b; (void)merged; (void)eo; (void)kcb; (void)lrusum; (void)rec_e; (void)rec_slot; (void)rec_w; (void)rowtok; (void)roww; (void)xs; (void)hmid; (void)ctl
    volatile LAS unsigned* MISC = (volatile LAS unsigned*)(lds + MISC_OFF);
    LAS float* biasd = (LAS float*)(lds + BIAS_OFF);
    LAS int* offt = (LAS int*)(lds + OFFT_OFF);
    { PHASE_IDS();
    if (tid_ < 64) MISC[tid_] = 0u;
    for (int i = tid_; i < 129 * 12; i += 512) { const int d = i / 12, hd = i % 12; const int bk = d < 128 ? T5_BUCKET[d] : 31; const float* rb = a.in[1]; biasd[i] = rb[bk * 12 + hd]; ((LAS float*)(lds + BIAS2_OFF))[i] = (rb[bk * 12 + hd] - rb[31 * 12 + hd]) * 1.4426950408889634f; } }
    __syncthreads();
    const int lo = a_.ph_lo, hi = a_.ph_hi;
    XcdBarrier bar; bar.bar = (unsigned*)(a.ws + WS_CTL) + CW_BAR; bar.x = 0; bar.st = nullptr;
    if (hi - lo > 1) { PHASE_IDS(); bar = xcd_barrier_post(ctl + CW_BAR, MISC + 8, tid_ == 0); }
#ifndef SUB_MASK
#define SUB_MASK 0xFFu
#endif
#define SUB(k) ((SUB_MASK >> (k)) & 1u)
#define HASP(k) ((PM >> ((k) % PPL + ((k) >= 2 * PPL ? PPL : 0))) & 1u)
#define IN(k) (HASP(k) && lo <= (k) && (k) < hi)
#define SEAM(k) do { if ((k) + 1 < hi) { const int sl_ = my_lane(); int sw_ = wave0; asm volatile("" : "+s"(sw_)); xcd_barrier(bar, sw_ == 0 && sl_ == 0); } } while (0)
    for (int l = 0; l < DEPTH; ++l) {
        const int pb = l * PPL;
        if (IN(pb + 0)) { PHASE_IDS(); p1_weights_i8(ap, l, lds, bid, G, wave, lane); router_weights(ap, l, gw, NGW, lane); lru_weights(ap, l, gw, NGW, lane); cmp_weights(ap, l, lds, gw, NGW, wave, lane); phase0_weights(ap, l, lds, gw, NGW, wave, lane); phase0_rows(ap, l, 0, gw, NGW, lane); SEAM(pb + 0); }
        if (IN(pb + 1)) {
            PHASE_IDS();
            {   int K1q = 512; asm volatile("" : "+s"(K1q));
                pg8::Gemm g{K1q, 512, 512, 128, -1}; SchedP1 S{(const char*)(ap.ws + WS_HQ), (const char*)(ap.ws + WS_WQ), 128, 26, 1024, 1024, G, bid};
                EpiP1I8 E{proj, (unsigned char*)gates, ap.in[25] + (size_t)l * 4096, (const float*)(ap.ws + WS_HSC), (const float*)(ap.ws + WS_WSC)};
                pg8::gemm_phase<EpiP1I8, SchedP1, false, true>(lds, g, S, E, tid_); }
            SEAM(pb + 1);
        }
        if (IN(pb + 2)) {
            PHASE_IDS();
            LAS float* lamp = (LAS float*)(lds + MISC_OFF + 64);
            if (tid_ < 64) { const GAS float* q1 = (const GAS float*)(ap.in[13] + l * 32); const GAS float* k1 = (const GAS float*)(ap.in[14] + l * 32); const GAS float* q2 = (const GAS float*)(ap.in[15] + l * 32); const GAS float* k2 = (const GAS float*)(ap.in[16] + l * 32);
                const int li = lane & 31; const float a1 = q1[li], b1 = k1[li], a2 = q2[li], b2 = k2[li];
                float s1 = (lane < 32) ? a1 * b1 : 0.f, s2 = (lane < 32) ? a2 * b2 : 0.f; s1 = wave_sum(s1); s2 = wave_sum(s2);
                const float lam_init = 0.8f - 0.6f * __expf(-0.3f * (float)l); if (lane == 0) { lamp[0] = __expf(s1) - __expf(s2) + lam_init; lamp[1] = lam_init; } }
            __syncthreads();
            if (SUB(0)) { const LAS float* bias2 = (const LAS float*)(lds + BIAS2_OFF); const GAS float* subg = (const GAS float*)(ap.in[17] + l * 64);
                for (int pi = xb; pi < 256; pi += G) { const int bh = pi >> 4, qlo = pi & 15;
                    diff_unit((const GAS bf16*)proj, (GAS bf16*)ys, lds, bias2, subg, lamp, bh >> 2, bh & 3, 31 - qlo, wave);
                    diff_unit((const GAS bf16*)proj, (GAS bf16*)ys, lds, bias2, subg, lamp, bh >> 2, bh & 3, qlo, wave); } }
            { PHASE_IDS();
            if (SUB(3)) { __syncthreads(); const LAS float* bias2 = (const LAS float*)(lds + BIAS2_OFF); const GAS float* sinks = (const GAS float*)(ap.in[12] + l * 4);
                for (int pi = xb; pi < 512; pi += G) swa_unit((const GAS bf16*)proj, (GAS bf16*)ys, lds, bias2, biasd, sinks, pi >> 7, pi & 127, tid_, lane, wave); }
            if (SUB(2)) cmp_block(ap, l, (const GAS bf16*)proj, (const GAS bf16*)(ap.ws + WS_WCMP), (float*)(ap.ws + WS_CMPAB), kcb, bid, wave, lane);
            if (SUB(1)) { __syncthreads(); lru_consts(ap, l, (xb >> 5) & 3, lds, wave, lane); __syncthreads(); for (int task = xb; task < 512; task += G) lru_unit(ap, l, (const GAS bf16*)proj, (GAS bf16*)ys, (GAS float*)lrusum, lds, task, lane, wave, false); }
            }
            SEAM(pb + 2);
        }
        if (IN(pb + 4)) {
            PHASE_IDS();
            lru_consts(ap, l, (xb >> 5) & 3, lds, wave, lane); __syncthreads();
            for (int task = xb; task < 512; task += G) lru_unit(ap, l, (const GAS bf16*)proj, (GAS bf16*)ys, (GAS float*)lrusum, lds, task, lane, wave, true);
            __syncthreads();
            if (SUB(4)) { const LAS float* bias2 = (const LAS float*)(lds + BIAS2_OFF);
                for (int pi = xb; pi < 256; pi += G) { const int bb = pi >> 6, ulo = pi & 63;
                    nsa_unit((const GAS bf16*)proj, (GAS bf16*)ys, (const GAS bf16*)kcb, lds, bias2, bb, 127 - ulo, tid_, lane, wave);
                    nsa_unit((const GAS bf16*)proj, (GAS bf16*)ys, (const GAS bf16*)kcb, lds, bias2, bb, ulo, tid_, lane, wave); } }
            SEAM(pb + 4);
        }
        if (IN(pb + 5)) {
            PHASE_IDS();
            int K5 = 256; asm volatile("" : "+s"(K5));
            pg8::Gemm g{K5, 1024, 256, 128, -1}; SchedP3a S{(const char*)ys, (const char*)(ap.ws + WS_WBR), G, xb};
            EpiP3a E{merged, (const unsigned char*)gates};
            pg8::gemm_phase<EpiP3a, SchedP3a>(lds, g, S, E, tid_); SEAM(pb + 5);
        }
        if (IN(pb + 6)) {
            PHASE_IDS();
            int K6 = 1024; asm volatile("" : "+s"(K6));
            pg8::Gemm g{K6, 1024, 1024, 128, -1}; SchedP3b S{(const char*)merged, (const char*)(ap.ws + WS_WOUT), G, xb};
            if (l == 0) { EpiP3b<true> E{ap.in[0], (bf16*)(ap.ws + WS_XB)}; pg8::gemm_phase<EpiP3b<true>, SchedP3b>(lds, g, S, E, tid_); }
            else { EpiP3b<false> E{nullptr, (bf16*)(ap.ws + WS_XB)}; pg8::gemm_phase<EpiP3b<false>, SchedP3b>(lds, g, S, E, tid_); }
            SEAM(pb + 6);
        }
        if (IN(pb + 7)) {
            PHASE_IDS();
            bf16* xr = (bf16*)(ap.ws + WS_XR); float* rlog = (float*)(ap.ws + WS_RLOG);
            constexpr int NITW = 32 * (4 * 16);
            { const int pm = bid;
                f32x4 gvv[2][2]; { const GAS float* g28 = (const GAS float*)(ap.in[28] + (size_t)l * 1024);
#pragma unroll
                    for (int j = 0; j < 2; ++j) { gvv[j][0] = *(const GAS f32x4*)(g28 + 8 * (lane + 64 * j)); gvv[j][1] = *(const GAS f32x4*)(g28 + 8 * (lane + 64 * j) + 4); } }
                {   u32x4 rw[4][4][2];
#pragma unroll
                    for (int q4 = 0; q4 < 4; ++q4) route_rows_load(ap, pm * 128 + wave * 4 + 32 * q4, lane, rw[q4]);
#pragma unroll
                    for (int q4 = 0; q4 < 4; ++q4) route_rows4(rw[q4], gvv, xr, ap.ws + WS_XQ2, (float*)(ap.ws + WS_XSC2), pm * 128 + wave * 4 + 32 * q4, lane); }
                asm volatile("s_waitcnt vmcnt(0)" ::: "memory"); __syncthreads();
                route_logits((const GAS bf16*)xr, (const GAS bf16*)(ap.ws + WS_WR), (GAS float*)rlog, lds, pm, tid_, wave, lane);
                asm volatile("s_waitcnt vmcnt(0)" ::: "memory"); __syncthreads();
                if (wave >= 2) expert_weights(ap, l, lds, 0, NITW, gw, NGW, wave, lane);
                {
                    LAS unsigned* lc = (LAS unsigned*)(lds + 64);
                    if (tid_ < 32) lc[tid_] = 0u;
                    int e0 = 0, e1 = 0; float w0 = 0.f, w1 = 0.f; unsigned r0 = 0u, r1 = 0u;
                    if (tid_ < 128) route_decide(ap, l, rlog + (size_t)(pm * 128 + tid_) * 128, e0, e1, w0, w1);
                    __syncthreads();
                    if (tid_ < 128) { r0 = __hip_atomic_fetch_add(lc + e0, 1u, __ATOMIC_RELAXED, __HIP_MEMORY_SCOPE_WORKGROUP); r1 = __hip_atomic_fetch_add(lc + e1, 1u, __ATOMIC_RELAXED, __HIP_MEMORY_SCOPE_WORKGROUP); }
                    __syncthreads();
                    if (tid_ < 32) { const unsigned c = lc[tid_]; lc[32 + tid_] = c ? __hip_atomic_fetch_add(ctl + CW_CNT + (l * 32 + tid_) * CNT_STRIDE, c, __ATOMIC_RELAXED, __HIP_MEMORY_SCOPE_AGENT) : 0u; }
                    __syncthreads();
                    if (tid_ < 128) { const int tok = pm * 128 + tid_; const int s0 = (int)(lc[32 + e0] + r0), s1 = (int)(lc[32 + e1] + r1);
                        int* inv_as = (int*)(ap.ws + WS_INVAS); float* inv_w = (float*)(ap.ws + WS_INVW);
                        inv_as[e0 * 32768 + s0] = tok * 2; inv_w[e0 * 32768 + s0] = w0; inv_as[e1 * 32768 + s1] = tok * 2 + 1; inv_w[e1 * 32768 + s1] = w1;
                        float* inv_sc = (float*)(ap.ws + WS_INVSC); const float xs2 = ((const GAS float*)(ap.ws + WS_XSC2))[tok]; inv_sc[e0 * 32768 + s0] = xs2; inv_sc[e1 * 32768 + s1] = xs2; }
                    __syncthreads();
                }
            }
            if (wave < 2) expert_weights(ap, l, lds, 0, NITW, gw, NGW, wave, lane);
            __syncthreads();
            expert_gu_i8(ap, l, lds, bid, G, wave, lane);
            SEAM(pb + 7);
        }
        if (IN(pb + 9)) {
            PHASE_IDS();
            build_offsets(ctl + CW_CNT + l * 32 * CNT_STRIDE, offt, tid_);
            int K9 = 512; asm volatile("" : "+s"(K9));
            pg8::Gemm g{K9, 512, 512, 128, -1}; SchedM2 S{(const char*)(ap.ws + WS_XQ2), (const char*)(ap.ws + WS_WGU), offt, (const int*)(ap.ws + WS_INVAS), G, xb};
            EpiM2 E{hmid, (const float*)(ap.ws + WS_INVSC), (const float*)(ap.ws + WS_WGSC), offt};
            pg8::gemm_phase<EpiM2, SchedM2, true, true>(lds, g, S, E, tid_); SEAM(pb + 9);
        }
        if (IN(pb + 10)) {
            PHASE_IDS();
            int K3 = 256; asm volatile("" : "+s"(K3));
            pg8::Gemm g{K3, 256, 256, 128, -1}; SchedM3 S{(const char*)hmid, (const char*)(ap.ws + WS_WD), offt, G, xb};
            EpiM3 E{eo, (const int*)(ap.ws + WS_INVAS), (const float*)(ap.ws + WS_INVW), offt};
            pg8::gemm_phase<EpiM3, SchedM3>(lds, g, S, E, tid_); SEAM(pb + 10);
        }
    }
    if (IN(2 * PPL)) { PHASE_IDS(); phase0_rows(ap, DEPTH, 1, gw, NGW, lane); }
#undef IN
#undef SEAM
}

typedef void (*kern_t)(Args);
template <unsigned PM> static bool setup_kernel() {
    if (hipFuncSetAttribute((const void*)mk_fwd<PM>, hipFuncAttributeMaxDynamicSharedMemorySize, LDS_BYTES) != hipSuccess) { fprintf(stderr, "kernel_launch: hipFuncSetAttribute failed\n"); return false; }
    return true;
}
extern "C" void kernel_launch(void* const* d_in, const int* in_sizes, int n_in, void* d_out, int out_size, void* d_ws, size_t ws_size, hipStream_t stream) {
    static int grid = 0;
    if (grid == 0) {
        if (n_in != 36 || out_size != T * D || ws_size < WS_END) { fprintf(stderr, "kernel_launch: unexpected shapes (n_in %d out %d ws %zu)\n", n_in, out_size, ws_size); grid = -1; return; }
        int dev = 0, cus = 0;
        if (hipGetDevice(&dev) != hipSuccess || hipDeviceGetAttribute(&cus, hipDeviceAttributeMultiprocessorCount, dev) != hipSuccess) { grid = -1; return; }
        bool ok = true;
#if MK_ONE_LAUNCH
        ok = setup_kernel<0xFFFu>();
#endif
        if (!ok) { grid = -1; return; }
        (void)hipGetLastError();
        grid = cus;
        if (grid != 256) { fprintf(stderr, "kernel_launch: built for a 256-CU device (got %d)\n", cus); grid = -1; return; }
    }
    if (grid < 0) return;
    if (hipMemsetAsync((char*)d_ws + WS_CTL, 0, CTL_ZERO_BYTES, stream) != hipSuccess) return;
    Args a{};
    for (int i = 0; i < 36; ++i) a.in[i] = (const float*)d_in[i];
    a.out = (float*)d_out; a.ws = (unsigned char*)d_ws;
#if MK_ONE_LAUNCH
    a.ph_lo = 0; a.ph_hi = NPH;
    hipLaunchKernelGGL(mk_fwd<0xFFFu>, dim3(grid), dim3(512), LDS_BYTES, stream, a);
#endif
}
```
